# Optimizing an MI355X kernel written in HIP

```python
import math
import jax
import jax.numpy as jnp
from jax import lax
import numpy as np


D_MODEL = 1024
BATCH = 8
SEQ = 4096
DEPTH = 2

GRID_W = 64
CTX_LEN = 256
N_BRANCH = 3
MIX_W = 512
SHORT_CONV = 4
DN_H = 4
DN_DK = 128
DN_DV = MIX_W // DN_H
DN_W = DN_H * DN_DK
DN_CHUNK = 64
LRU_W = MIX_W
LRU_G = 8
LRU_BS = LRU_W // LRU_G
LRU_C = 8.0
DA_H = 4
DA_D = 64
DA_DV = MIX_W // DA_H
DA_QW = DA_H * 2 * DA_D
ATTN_BLOCK = 128
ROPE_BASE = 10000.0
ROPE_NF = DA_D // 4
D_FF = -(-8 * D_MODEL // (3 * 256)) * 256
SPLIT = (DN_W, DN_W, DN_H * DN_DV, DN_H * DN_DV, 2 * DN_H, 2 * DN_H, LRU_W, LRU_W, DA_QW, DA_QW, DA_H * DA_DV, N_BRANCH * D_MODEL)
IN_COLS = sum(SPLIT)

kernel_name = 'hybrid_gdn_rglru_diffattn_prefix_dit'


def rmsnorm(x, w, eps=1e-6):
    xf = x.astype(jnp.float32)
    y = xf * lax.rsqrt(jnp.mean(xf * xf, axis=-1, keepdims=True) + eps) * w.astype(jnp.float32)
    return y.astype(x.dtype)


def l2norm(x, eps=1e-6):
    xf = x.astype(jnp.float32)
    return xf * lax.rsqrt(jnp.sum(xf * xf, axis=-1, keepdims=True) + eps)


def modulate(h, shift, scale):
    return h * (1.0 + scale[:, None]) + shift[:, None]


def split_cols(p):
    out, start = [], 0
    for size in SPLIT:
        out.append(p[..., start:start + size])
        start += size
    return out


def flip_t(t):
    return jnp.flip(t, axis=1)


def ident_t(t):
    return t


def centred_dwconv(x, w):
    K = w.shape[0]
    left = (K - 1) // 2
    T = x.shape[1]
    xp = jnp.pad(x, ((0, 0), (left, K - 1 - left), (0, 0)))
    y = xp[:, 0:T] * w[0]
    for j in range(1, K):
        y = y + xp[:, j:j + T] * w[j]
    return y


def axial_angles(n_tokens):
    rows = n_tokens // GRID_W
    row = jnp.repeat(jnp.arange(rows, dtype=jnp.float32), GRID_W)
    col = jnp.tile(jnp.arange(GRID_W, dtype=jnp.float32), rows)
    inv = ROPE_BASE ** (-jnp.arange(ROPE_NF, dtype=jnp.float32) / ROPE_NF)
    return jnp.stack([row[:, None] * inv, col[:, None] * inv], axis=1)


def rope_2d(x, rope_cs):
    cos, sin = rope_cs
    B, T, H, Dh = x.shape
    xr = x.astype(jnp.float32).reshape(B, T, H, 2, 2, Dh // 4)
    x1, x2 = xr[..., 0, :], xr[..., 1, :]
    cos = cos[None, :, None]
    sin = sin[None, :, None]
    out = jnp.stack([x1 * cos - x2 * sin, x2 * cos + x1 * sin], axis=-2)
    return out.reshape(B, T, H, Dh).astype(x.dtype)


def gated_delta_chunked(q, k, v, g, beta, s0):
    B, T, H, DK = q.shape
    DV = v.shape[-1]
    C = DN_CHUNK
    N = T // C

    def to_chunks(t):
        t = t.astype(jnp.float32).reshape((B, N, C, H) + t.shape[3:])
        return jnp.moveaxis(t, (1, 3), (0, 2))

    q = to_chunks(q) * (DK ** -0.5)
    k = to_chunks(k)
    v = to_chunks(v)
    beta = to_chunks(beta)
    g = jnp.cumsum(to_chunks(g), axis=-1)
    incl = jnp.tril(jnp.ones((C, C), dtype=bool))
    strict = jnp.tril(jnp.ones((C, C), dtype=bool), -1)
    diff = g[..., :, None] - g[..., None, :]
    decay = jnp.where(incl, jnp.exp(jnp.where(incl, diff, 0.0)), 0.0)
    kb = k * beta[..., None]
    lower = jnp.where(strict, jnp.einsum('nbhid,nbhjd->nbhij', kb, k) * decay, 0.0)
    a_mat = lower + jnp.eye(C, dtype=jnp.float32)
    w = lax.linalg.triangular_solve(a_mat, kb * jnp.exp(g)[..., None], left_side=True, lower=True, unit_diagonal=True)
    u = lax.linalg.triangular_solve(a_mat, v * beta[..., None], left_side=True, lower=True, unit_diagonal=True)
    qk = jnp.where(incl, jnp.einsum('nbhid,nbhjd->nbhij', q, k) * decay, 0.0)
    q_in = q * jnp.exp(g)[..., None]
    k_out = k * jnp.exp(g[..., -1:] - g)[..., None]
    g_end = jnp.exp(g[..., -1])

    def step(s, inp):
        q_n, w_n, u_n, qk_n, ko_n, ge_n = inp
        v_new = u_n - jnp.einsum('bhck,bhkv->bhcv', w_n, s)
        o = jnp.einsum('bhck,bhkv->bhcv', q_n, s) + jnp.einsum('bhij,bhjv->bhiv', qk_n, v_new)
        s = s * ge_n[..., None, None] + jnp.einsum('bhck,bhcv->bhkv', ko_n, v_new)
        return s, o

    s_fin, o = lax.scan(step, s0.astype(jnp.float32), (q_in, w, u, qk, k_out, g_end))
    o = jnp.moveaxis(o, (0, 2), (1, 3)).reshape(B, T, H, DV)
    return o, s_fin


def deltanet_branch(pc, pl, conv_w, a_log, dt_bias, out_norm, need_ctx):
    def prep(q, k, v, a, b):
        B, T, _ = q.shape
        qkv = jax.nn.silu(centred_dwconv(jnp.concatenate([q, k, v], axis=-1), conv_w))
        q, k, v = jnp.split(qkv, [DN_W, 2 * DN_W], axis=-1)
        q = l2norm(q.reshape(B, T, DN_H, DN_DK))
        k = l2norm(k.reshape(B, T, DN_H, DN_DK))
        v = v.reshape(B, T, DN_H, DN_DV)
        g = -jnp.exp(a_log.astype(jnp.float32)) * jax.nn.softplus(a.reshape(B, T, 2, DN_H).astype(jnp.float32) + dt_bias.astype(jnp.float32))
        bt = jax.nn.sigmoid(b.reshape(B, T, 2, DN_H).astype(jnp.float32))
        return q, k, v, g, bt

    qc, kc, vc, gc, bc = prep(pc[0], pc[1], pc[2], pc[4], pc[5])
    ql, kl, vl, gl, bl = prep(pl[0], pl[1], pl[2], pl[4], pl[5])
    B = ql.shape[0]
    outs_c, outs_l = [], []
    for d in range(2):
        f = flip_t if d else ident_t
        s0 = jnp.zeros((B, DN_H, DN_DK, DN_DV), jnp.float32)
        oc, s_ctx = gated_delta_chunked(f(qc), f(kc), f(vc), f(gc[:, :, d]), f(bc[:, :, d]), s0)
        ol, _ = gated_delta_chunked(f(ql), f(kl), f(vl), f(gl[:, :, d]), f(bl[:, :, d]), s_ctx)
        outs_c.append(f(oc))
        outs_l.append(f(ol))

    def finish(o, z):
        B, T = z.shape[:2]
        o = rmsnorm(o, out_norm) * jax.nn.silu(z.reshape(B, T, DN_H, DN_DV).astype(jnp.float32))
        return o.reshape(B, T, DN_H * DN_DV).astype(z.dtype)

    y_l = finish(outs_l[0] + outs_l[1], pl[3])
    y_c = finish(outs_c[0] + outs_c[1], pc[3]) if need_ctx else None
    return y_c, y_l


def rglru_coeffs(xb, wa, ba, wi, bi, lam):
    B, T, W = xb.shape
    xg = xb.reshape(B, T, LRU_G, LRU_BS)
    r = jax.nn.sigmoid((jnp.einsum('btgi,gij->btgj', xg, wa).reshape(B, T, W) + ba).astype(jnp.float32))
    i = jax.nn.sigmoid((jnp.einsum('btgi,gij->btgj', xg, wi).reshape(B, T, W) + bi).astype(jnp.float32))
    log_a = -LRU_C * r * jax.nn.softplus(-lam.astype(jnp.float32))
    a = jnp.exp(log_a)
    b = jnp.sqrt(1.0 - jnp.exp(2.0 * log_a)) * (i * xb.astype(jnp.float32))
    return a, b


def linear_scan(a, b, h0):
    def combine(e1, e2):
        a1, b1 = e1
        a2, b2 = e2
        return a1 * a2, a2 * b1 + b2
    a_cum, b_cum = lax.associative_scan(combine, (a, b), axis=1)
    return b_cum + a_cum * h0[:, None, :]


def rglru_branch(pc, pl, conv_w, conv_b, wa, ba, wi, bi, lam, need_ctx):
    xc = centred_dwconv(pc[0], conv_w) + conv_b
    xl = centred_dwconv(pl[0], conv_w) + conv_b
    B = xl.shape[0]
    hs_c, hs_l = [], []
    for d in range(2):
        f = flip_t if d else ident_t
        a, b = rglru_coeffs(f(xc), wa[d], ba[d], wi[d], bi[d], lam[d])
        h_c = linear_scan(a, b, jnp.zeros((B, LRU_W), jnp.float32))
        a, b = rglru_coeffs(f(xl), wa[d], ba[d], wi[d], bi[d], lam[d])
        h_l = linear_scan(a, b, h_c[:, -1])
        hs_c.append(f(h_c))
        hs_l.append(f(h_l))

    def finish(h, y):
        return (h * jax.nn.gelu(y.astype(jnp.float32))).astype(y.dtype)

    y_l = finish(hs_l[0] + hs_l[1], pl[1])
    y_c = finish(hs_c[0] + hs_c[1], pc[1]) if need_ctx else None
    return y_c, y_l


def diff_attend(q1, q2, k1, k2, v, lam):
    scale = DA_D ** -0.5
    s1 = jnp.einsum('bqhd,bkhd->bhqk', q1.astype(jnp.float32), k1) * scale
    s2 = jnp.einsum('bqhd,bkhd->bhqk', q2.astype(jnp.float32), k2) * scale
    p = jax.nn.softmax(s1, axis=-1) - lam * jax.nn.softmax(s2, axis=-1)
    return jnp.einsum('bhqk,bkhv->bqhv', p, v)


def diffattn_branch(pc, pl, rope_cs, lam_vecs, sub_norm, lam_init, need_ctx):
    def heads(q, k, v):
        B, T, _ = q.shape
        q = q.reshape(B, T, DA_H, 2, DA_D)
        k = k.reshape(B, T, DA_H, 2, DA_D)
        return q[..., 0, :], q[..., 1, :], k[..., 0, :], k[..., 1, :], v.reshape(B, T, DA_H, DA_DV)

    q1c, q2c, k1c, k2c, vc = heads(pc[0], pc[1], pc[2])
    q1l, q2l, k1l, k2l, vl = heads(pl[0], pl[1], pl[2])
    q1l = rope_2d(q1l, rope_cs)
    q2l = rope_2d(q2l, rope_cs)
    k1l = rope_2d(k1l, rope_cs)
    k2l = rope_2d(k2l, rope_cs)
    lv = lam_vecs.astype(jnp.float32)
    lam = jnp.exp(jnp.sum(lv[0] * lv[1])) - jnp.exp(jnp.sum(lv[2] * lv[3])) + lam_init
    k1c32, k2c32, vc32 = k1c.astype(jnp.float32), k2c.astype(jnp.float32), vc.astype(jnp.float32)
    k1 = jnp.concatenate([k1c32, k1l.astype(jnp.float32)], axis=1)
    k2 = jnp.concatenate([k2c32, k2l.astype(jnp.float32)], axis=1)
    v = jnp.concatenate([vc32, vl.astype(jnp.float32)], axis=1)
    B, T = q1l.shape[:2]
    nb = T // ATTN_BLOCK

    def blocks(t):
        return jnp.moveaxis(t.reshape(B, nb, ATTN_BLOCK, DA_H, DA_D), 1, 0)

    o_l = lax.map(lambda qq: diff_attend(qq[0], qq[1], k1, k2, v, lam), (blocks(q1l), blocks(q2l)))
    o_l = jnp.moveaxis(o_l, 0, 1).reshape(B, T, DA_H, DA_DV)

    def finish(o, like):
        o = rmsnorm(o, sub_norm, 1e-5) * (1.0 - lam_init)
        return o.reshape(o.shape[0], o.shape[1], DA_H * DA_DV).astype(like.dtype)

    y_l = finish(o_l, pl[2])
    if need_ctx:
        y_c = finish(diff_attend(q1c, q2c, k1c32, k2c32, vc32, lam), pc[2])
    else:
        y_c = None
    return y_c, y_l


def merge_branches(ya, yb, yc, gate_logits, w_branch, w_out):
    B, T, _ = ya.shape
    up = jnp.einsum('btnm,nmd->btnd', jnp.stack([ya, yb, yc], axis=2), w_branch)
    gates = jax.nn.sigmoid(gate_logits.reshape(B, T, N_BRANCH, D_MODEL))
    return jnp.einsum('btnd,btnd->btd', gates, up) @ w_out


def mixer_sublayer(u_c, u_l, rope_cs, lam_init, need_ctx, w_in, dn_conv, dn_a_log, dn_dt_bias, dn_norm, lru_conv_w, lru_conv_b, lru_wa, lru_ba, lru_wi, lru_bi, lru_lambda, da_lambda, da_norm, w_branch, w_out):
    pc = split_cols(u_c @ w_in)
    pl = split_cols(u_l @ w_in)
    ya_c, ya_l = deltanet_branch(pc[0:6], pl[0:6], dn_conv, dn_a_log, dn_dt_bias, dn_norm, need_ctx)
    yb_c, yb_l = rglru_branch(pc[6:8], pl[6:8], lru_conv_w, lru_conv_b, lru_wa, lru_ba, lru_wi, lru_bi, lru_lambda, need_ctx)
    yc_c, yc_l = diffattn_branch(pc[8:11], pl[8:11], rope_cs, da_lambda, da_norm, lam_init, need_ctx)
    y_l = merge_branches(ya_l, yb_l, yc_l, pl[11], w_branch, w_out)
    y_c = merge_branches(ya_c, yb_c, yc_c, pc[11], w_branch, w_out) if need_ctx else None
    return y_c, y_l


def swiglu(h, wg, wu, wd):
    return (jax.nn.silu(h @ wg) * (h @ wu)) @ wd


def setup_inputs(seed: int = 0) -> dict:
    key = jax.random.key(seed)
    ks = jax.random.split(key, 28)
    L, D = DEPTH, D_MODEL
    f32 = jnp.float32

    def nrm(k, shape, scale):
        return jax.random.normal(k, shape, f32) * scale

    dt = jnp.exp(jax.random.uniform(ks[11], (L, 2, DN_H), f32, minval=math.log(1e-3), maxval=math.log(1e-1)))
    a_pow = jax.random.uniform(ks[19], (L, 2, LRU_W), f32, minval=0.9, maxval=0.999)
    a_base = a_pow ** (1.0 / LRU_C)
    return {
        'x': nrm(ks[0], (BATCH, SEQ, D), 1.0),
        'c': nrm(ks[1], (BATCH, D), 1.0),
        'ctx': nrm(ks[2], (BATCH, CTX_LEN, D), 1.0),
        'c_ctx': nrm(ks[3], (D,), 1.0),
        'w_mod': nrm(ks[4], (L, D, 6 * D), D ** -0.5),
        'b_mod': nrm(ks[5], (L, 6 * D), 0.02),
        'norm_mix': 1.0 + nrm(ks[6], (L, D), 0.02),
        'norm_ffn': 1.0 + nrm(ks[7], (L, D), 0.02),
        'w_in': nrm(ks[8], (L, D, IN_COLS), D ** -0.5),
        'dn_conv': nrm(ks[9], (L, SHORT_CONV, 3 * DN_W), SHORT_CONV ** -0.5),
        'dn_a_log': jnp.log(jax.random.uniform(ks[10], (L, 2, DN_H), f32, minval=1.0, maxval=16.0)),
        'dn_dt_bias': dt + jnp.log(-jnp.expm1(-dt)),
        'dn_norm': 1.0 + nrm(ks[12], (L, DN_DV), 0.02),
        'lru_conv_w': nrm(ks[13], (L, SHORT_CONV, LRU_W), SHORT_CONV ** -0.5),
        'lru_conv_b': nrm(ks[14], (L, LRU_W), 0.01),
        'lru_wa': nrm(ks[15], (L, 2, LRU_G, LRU_BS, LRU_BS), LRU_BS ** -0.5),
        'lru_ba': nrm(ks[16], (L, 2, LRU_W), 0.01),
        'lru_wi': nrm(ks[17], (L, 2, LRU_G, LRU_BS, LRU_BS), LRU_BS ** -0.5),
        'lru_bi': nrm(ks[18], (L, 2, LRU_W), 0.01),
        'lru_lambda': jnp.log(a_base) - jnp.log1p(-a_base),
        'da_lambda': nrm(ks[20], (L, 4, DA_D), 0.1),
        'da_norm': 1.0 + nrm(ks[21], (L, DA_DV), 0.02),
        'w_branch': nrm(ks[22], (L, N_BRANCH, MIX_W, D), MIX_W ** -0.5),
        'w_out': nrm(ks[23], (L, D, D), D ** -0.5),
        'w_ffn_gate': nrm(ks[24], (L, D, D_FF), D ** -0.5),
        'w_ffn_up': nrm(ks[25], (L, D, D_FF), D ** -0.5),
        'w_ffn_down': nrm(ks[26], (L, D_FF, D), D_FF ** -0.5),
        'norm_final': 1.0 + nrm(ks[27], (D,), 0.02),
    }


def reference(x, c, ctx, c_ctx, w_mod, b_mod, norm_mix, norm_ffn, w_in, dn_conv, dn_a_log, dn_dt_bias, dn_norm, lru_conv_w, lru_conv_b, lru_wa, lru_ba, lru_wi, lru_bi, lru_lambda, da_lambda, da_norm, w_branch, w_out, w_ffn_gate, w_ffn_up, w_ffn_down, norm_final):
    ang = axial_angles(x.shape[1])
    rope_cs = (jnp.cos(ang), jnp.sin(ang))
    s_lat = jax.nn.silu(c)
    s_ctx = jax.nn.silu(c_ctx)[None]
    h_lat, h_ctx = x, ctx
    for l in range(DEPTH):
        need_ctx = l < DEPTH - 1
        lam_init = 0.8 - 0.6 * math.exp(-0.3 * l)
        mod_l = jnp.split(s_lat @ w_mod[l] + b_mod[l], 6, axis=-1)
        mod_c = jnp.split(s_ctx @ w_mod[l] + b_mod[l], 6, axis=-1)
        u_l = modulate(rmsnorm(h_lat, norm_mix[l]), mod_l[0], mod_l[1])
        u_c = modulate(rmsnorm(h_ctx, norm_mix[l]), mod_c[0], mod_c[1])
        y_c, y_l = mixer_sublayer(u_c, u_l, rope_cs, lam_init, need_ctx, w_in[l], dn_conv[l], dn_a_log[l], dn_dt_bias[l], dn_norm[l], lru_conv_w[l], lru_conv_b[l], lru_wa[l], lru_ba[l], lru_wi[l], lru_bi[l], lru_lambda[l], da_lambda[l], da_norm[l], w_branch[l], w_out[l])
        h_lat = h_lat + mod_l[2][:, None] * y_l
        h_lat = h_lat + mod_l[5][:, None] * swiglu(modulate(rmsnorm(h_lat, norm_ffn[l]), mod_l[3], mod_l[4]), w_ffn_gate[l], w_ffn_up[l], w_ffn_down[l])
        if need_ctx:
            h_ctx = h_ctx + mod_c[2][:, None] * y_c
            h_ctx = h_ctx + mod_c[5][:, None] * swiglu(modulate(rmsnorm(h_ctx, norm_ffn[l]), mod_c[3], mod_c[4]), w_ffn_gate[l], w_ffn_up[l], w_ffn_down[l])
    return rmsnorm(h_lat, norm_final)
```

```cpp
#include <hip/hip_runtime.h>
#include <hip/hip_cooperative_groups.h>
#include <cstdio>
#include <cstdint>
namespace cg = cooperative_groups;

#ifndef MEGA
#define MEGA 1
#endif

typedef unsigned short bf16_t;
typedef short bf16x8 __attribute__((ext_vector_type(8)));
typedef float f32x4 __attribute__((ext_vector_type(4)));
typedef unsigned u32x4 __attribute__((ext_vector_type(4)));
typedef unsigned u32x2 __attribute__((ext_vector_type(2)));
#define DEV __device__ __forceinline__

constexpr int D = 1024, NB = 8, SEQ = 4096, CTXL = 256, SB = 4352, MR = NB * SB, PW = 4096, DFF = 2816;
constexpr int C_DNQ = 0, C_DNK = 512, C_DNV = 1024, C_DNZ = 1536, C_LX = 2048, C_LG = 2560, C_DAQ = 3072, C_DAK = 3584;
constexpr int NIN = 4736;
constexpr int GLD = 72;

enum { I_X = 0, I_C, I_CTX, I_CCTX, I_WMOD, I_BMOD, I_NMIX, I_NFFN, I_WIN, I_DNCONV, I_DNALOG, I_DNDT, I_DNNORM, I_LCW, I_LCB,
       I_LWA, I_LBA, I_LWI, I_LBI, I_LLAM, I_DALAM, I_DANORM, I_WBR, I_WOUT, I_WFG, I_WFU, I_WFD, I_NFIN };

constexpr size_t al256(size_t x) { return (x + 255) & ~(size_t)255; }
constexpr size_t O_CTL = 0;
constexpr size_t O_MOD = 4096;
constexpr size_t O_ROPE = al256(O_MOD + (size_t)2 * 9 * 6144 * 4);
constexpr size_t O_WT = al256(O_ROPE + 64 * 16 * 2 * 4);
constexpr size_t W_IN = 0, W_GATE = W_IN + (size_t)NIN * 1024, W_BR = W_GATE + (size_t)3072 * 1024, W_OUT = W_BR + (size_t)3 * 1024 * 512,
                 W_GU = W_OUT + (size_t)1024 * 1024, W_DN = W_GU + (size_t)5632 * 1024, W_END = W_DN + (size_t)1024 * 2816;
constexpr size_t O_HCTX = al256(O_WT + W_END * 2);
constexpr size_t O_U = al256(O_HCTX + (size_t)2048 * 1024 * 4);
constexpr size_t O_P = al256(O_U + (size_t)MR * 1024 * 2);
constexpr size_t O_AB = al256(O_P + (size_t)MR * PW * 2);
constexpr size_t O_TA = al256(O_AB + (size_t)MR * 16 * 4);
constexpr size_t O_TA2 = al256(O_TA + (size_t)MR * 512 * 2);
constexpr size_t O_VT = al256(O_TA2 + (size_t)MR * 512 * 2);
constexpr size_t WS_END = al256(O_VT + (size_t)MR * 512 * 2);

constexpr int LDS_BYTES = 140 * 1024;

struct Params {
    const float* in[28];
    float* out;
    unsigned char* ws;
};

DEV int get_tid() { int t = threadIdx.x; asm volatile("" : "+v"(t)); return t; }
DEV float bf2f(bf16_t h) { return __uint_as_float(((unsigned)h) << 16); }
DEV bf16_t f2bf(float f) { unsigned u = __float_as_uint(f); u += 0x7fffu + ((u >> 16) & 1u); return (bf16_t)(u >> 16); }
DEV unsigned pack2(float a, float b) { return (unsigned)f2bf(a) | ((unsigned)f2bf(b) << 16); }
DEV float sigm(float x) { return 1.f / (1.f + __expf(-x)); }
DEV float silu(float x) { return x / (1.f + __expf(-x)); }
DEV float softplus(float x) { return x > 20.f ? x : log1pf(expf(x)); }
DEV float softplus_fast(float x) { const float e = __expf(x); return x > 15.f ? x : (e < 0.01f ? e * (1.f - e * (0.5f - e * 0.33333333f)) : __logf(1.f + e)); }
DEV float gelu_tanh(float x) { float u = 0.7978845608028654f * (x + 0.044715f * x * x * x); float t = 1.f - 2.f / (1.f + __expf(2.f * u)); return 0.5f * x * (1.f + t); }
DEV f32x4 mfma16(bf16x8 a, bf16x8 b, f32x4 c) { return __builtin_amdgcn_mfma_f32_16x16x32_bf16(a, b, c, 0, 0, 0); }
DEV float lo16(unsigned v) { return __uint_as_float(v << 16); }
DEV float hi16(unsigned v) { return __uint_as_float(v & 0xffff0000u); }

DEV bf16_t* wsb(const Params& p, size_t off) { return (bf16_t*)(p.ws + off); }
DEV float* wsf(const Params& p, size_t off) { return (float*)(p.ws + off); }
DEV float* hrow(const Params& p, int r) { int b = r / SB, s = r - b * SB; return s < CTXL ? wsf(p, O_HCTX) + (size_t)(b * CTXL + s) * D : p.out + (size_t)(b * SEQ + s - CTXL) * D; }
DEV const float* xrow(const Params& p, int r) { int b = r / SB, s = r - b * SB; return s < CTXL ? p.in[I_CTX] + (size_t)(b * CTXL + s) * D : p.in[I_X] + (size_t)(b * SEQ + s - CTXL) * D; }
DEV int modrow(int r) { int b = r / SB, s = r - b * SB; return s < CTXL ? 8 : b; }

template <int MT, int NT>
DEV void gemm_core(const bf16_t* __restrict__ A, int lda, const bf16_t* __restrict__ Bt, int ldb, int K, f32x4 (&acc)[MT][NT], bf16_t* sA, bf16_t* sB) {
    const int tid = get_tid(), lane = tid & 63, wv = tid >> 6, wr = wv >> 1, wc = wv & 1, l15 = lane & 15, quad = lane >> 4;
    const int lr = tid >> 3, lc = (tid & 7) * 8;
    u32x4 ra[MT], rb[NT];
    const bf16_t* Ap = A + (size_t)lr * lda + lc;
    const bf16_t* Bp = Bt + (size_t)lr * ldb + lc;
#pragma unroll
    for (int i = 0; i < MT; ++i) ra[i] = *(const u32x4*)(Ap + (size_t)(32 * i) * lda);
#pragma unroll
    for (int i = 0; i < NT; ++i) rb[i] = *(const u32x4*)(Bp + (size_t)(32 * i) * ldb);
    const int nk = K >> 6;
    for (int kt = 0; kt < nk; ++kt) {
        __syncthreads();
#pragma unroll
        for (int i = 0; i < MT; ++i) *(u32x4*)(sA + (lr + 32 * i) * GLD + lc) = ra[i];
#pragma unroll
        for (int i = 0; i < NT; ++i) *(u32x4*)(sB + (lr + 32 * i) * GLD + lc) = rb[i];
        __syncthreads();
        if (kt + 1 < nk) {
            const int ko = (kt + 1) * 64;
#pragma unroll
            for (int i = 0; i < MT; ++i) ra[i] = *(const u32x4*)(Ap + (size_t)(32 * i) * lda + ko);
#pragma unroll
            for (int i = 0; i < NT; ++i) rb[i] = *(const u32x4*)(Bp + (size_t)(32 * i) * ldb + ko);
        }
#pragma unroll
        for (int ks = 0; ks < 2; ++ks) {
            bf16x8 af[MT], bfr[NT];
#pragma unroll
            for (int mt = 0; mt < MT; ++mt) af[mt] = *(const bf16x8*)(sA + (wr * MT * 16 + mt * 16 + l15) * GLD + ks * 32 + quad * 8);
#pragma unroll
            for (int nt = 0; nt < NT; ++nt) bfr[nt] = *(const bf16x8*)(sB + (wc * NT * 16 + nt * 16 + l15) * GLD + ks * 32 + quad * 8);
#pragma unroll
            for (int mt = 0; mt < MT; ++mt)
#pragma unroll
                for (int nt = 0; nt < NT; ++nt) acc[mt][nt] = mfma16(af[mt], bfr[nt], acc[mt][nt]);
        }
    }
}
template <int MT, int NT>
DEV void zero_acc(f32x4 (&acc)[MT][NT]) {
#pragma unroll
    for (int mt = 0; mt < MT; ++mt)
#pragma unroll
        for (int nt = 0; nt < NT; ++nt) acc[mt][nt] = (f32x4){0.f, 0.f, 0.f, 0.f};
}

DEV void phase_mod(const Params& p, unsigned char* smem) {
    float* s_s = (float*)smem;
    float* red = s_s + 9 * 1024;
    const int tid = get_tid();
    bool loaded = false;
    for (int it = blockIdx.x; it < 2 * 96; it += gridDim.x) {
        if (!loaded) {
            for (int e = tid; e < 9 * 1024; e += 256) { float v = e < 8192 ? p.in[I_C][e] : p.in[I_CCTX][e - 8192]; s_s[e] = silu(v); }
            loaded = true;
        }
        __syncthreads();
        const int l = it / 96, cg_ = it % 96, cq = tid & 63, kq = tid >> 6, col = cg_ * 64 + cq;
        float acc[9];
#pragma unroll
        for (int r = 0; r < 9; ++r) acc[r] = 0.f;
        const float* wp = p.in[I_WMOD] + ((size_t)l * 1024 + kq * 256) * 6144 + col;
#pragma unroll 8
        for (int k = 0; k < 256; ++k) {
            float wv = wp[(size_t)k * 6144];
#pragma unroll
            for (int r = 0; r < 9; ++r) acc[r] += s_s[r * 1024 + kq * 256 + k] * wv;
        }
#pragma unroll
        for (int r = 0; r < 9; ++r) red[(kq * 9 + r) * 64 + cq] = acc[r];
        __syncthreads();
        for (int e = tid; e < 9 * 64; e += 256) {
            int r = e >> 6, c2 = e & 63;
            float v = red[(0 * 9 + r) * 64 + c2] + red[(1 * 9 + r) * 64 + c2] + red[(2 * 9 + r) * 64 + c2] + red[(3 * 9 + r) * 64 + c2];
            wsf(p, O_MOD)[((size_t)l * 9 + r) * 6144 + cg_ * 64 + c2] = v + p.in[I_BMOD][l * 6144 + cg_ * 64 + c2];
        }
        __syncthreads();
    }
}
DEV void phase_rope(const Params& p) {
    if (blockIdx.x == (gridDim.x - 1)) {
        for (int e = threadIdx.x; e < 1024; e += 256) {
            int pos = e >> 4, i = e & 15;
            float inv = powf(10000.f, -(float)i / 16.f);
            float ang = (float)pos * inv;
            float n = rintf(ang * 0.15915494309189535f);
            float r = fmaf(-n, 6.28125f, ang);
            r = fmaf(-n, 1.9353071795864769e-3f, r);
            wsf(p, O_ROPE)[e * 2] = cosf(r);
            wsf(p, O_ROPE)[e * 2 + 1] = sinf(r);
        }
    }
}
DEV void wconv_tile(const float* src0, const float* src1, int lds_, int K, bf16_t* dst, int kind, int kt, int nt, bf16_t* tile) {
    const int tid = get_tid();
    const int kk = tid >> 2, grp = tid & 3;
    const int n0 = nt * 64, k0 = kt * 64;
    const int ng = n0 + grp * 16;
    const float* src = src0; int sc;
    if (kind == 0) { sc = ng < 2048 ? ng : (ng < 4608 ? ng + 16 : (ng < 4624 ? 2048 : -1)); }
    else if (kind == 1) { sc = 4624 + ng; }
    else if (kind == 2) { sc = ng; }
    else { int gd = ng >> 4; src = (gd & 1) ? src1 : src0; sc = (gd >> 1) * 16; }
    __syncthreads();
    if (sc >= 0) {
        const float4* sp = (const float4*)(src + (size_t)(k0 + kk) * lds_ + sc);
#pragma unroll
        for (int q = 0; q < 4; ++q) { float4 v = sp[q]; int e = grp * 16 + q * 4;
            tile[(e + 0) * GLD + kk] = f2bf(v.x); tile[(e + 1) * GLD + kk] = f2bf(v.y); tile[(e + 2) * GLD + kk] = f2bf(v.z); tile[(e + 3) * GLD + kk] = f2bf(v.w); }
    } else {
#pragma unroll
        for (int e = 0; e < 16; ++e) tile[(grp * 16 + e) * GLD + kk] = 0;
    }
    __syncthreads();
    const int n = tid >> 2, kseg = (tid & 3) * 16;
    u32x4 a = *(const u32x4*)(tile + n * GLD + kseg), b = *(const u32x4*)(tile + n * GLD + kseg + 8);
    bf16_t* dp = dst + (size_t)(n0 + n) * K + k0 + kseg;
    *(u32x4*)dp = a; *(u32x4*)(dp + 8) = b;
}
DEV void phase_wconv(const Params& p, int l, unsigned char* smem) {
    bf16_t* tile = (bf16_t*)smem;
    bf16_t* W = wsb(p, O_WT);
    constexpr int T0 = 74 * 16, T1 = T0 + 48 * 16, T2 = T1 + 3 * 16 * 8, T3 = T2 + 16 * 16, T4 = T3 + 88 * 16, T5 = T4 + 16 * 44;
    for (int t = blockIdx.x; t < T5; t += gridDim.x) {
        if (t < T0) { wconv_tile(p.in[I_WIN] + (size_t)l * 1024 * 7696, nullptr, 7696, 1024, W + W_IN, 0, t % 16, t / 16, tile); }
        else if (t < T1) { int u = t - T0; wconv_tile(p.in[I_WIN] + (size_t)l * 1024 * 7696, nullptr, 7696, 1024, W + W_GATE, 1, u % 16, u / 16, tile); }
        else if (t < T2) { int u = t - T1; int n = u / 128, v = u % 128; wconv_tile(p.in[I_WBR] + ((size_t)l * 3 + n) * 512 * 1024, nullptr, 1024, 512, W + W_BR + (size_t)n * 1024 * 512, 2, v % 8, v / 8, tile); }
        else if (t < T3) { int u = t - T2; wconv_tile(p.in[I_WOUT] + (size_t)l * 1024 * 1024, nullptr, 1024, 1024, W + W_OUT, 2, u % 16, u / 16, tile); }
        else if (t < T4) { int u = t - T3; wconv_tile(p.in[I_WFG] + (size_t)l * 1024 * DFF, p.in[I_WFU] + (size_t)l * 1024 * DFF, DFF, 1024, W + W_GU, 3, u % 16, u / 16, tile); }
        else { int u = t - T4; wconv_tile(p.in[I_WFD] + (size_t)l * DFF * 1024, nullptr, 1024, DFF, W + W_DN, 2, u % 44, u / 44, tile); }
    }
}

DEV void norm_row(const Params& p, int l, int which, bool first, int r, int lane) {
    const float* h = first ? xrow(p, r) : hrow(p, r);
    const float* nw = p.in[which ? I_NFFN : I_NMIX] + l * D;
    const float* md = wsf(p, O_MOD) + ((size_t)l * 9 + modrow(r)) * 6144 + (which ? 3 * D : 0);
    float4 v[4]; float ss = 0.f;
#pragma unroll
    for (int i = 0; i < 4; ++i) { v[i] = *(const float4*)(h + i * 256 + lane * 4); ss += v[i].x * v[i].x + v[i].y * v[i].y + v[i].z * v[i].z + v[i].w * v[i].w; }
#pragma unroll
    for (int o = 32; o >= 1; o >>= 1) ss += __shfl_xor(ss, o);
    const float rstd = rsqrtf(ss * (1.f / D) + 1e-6f);
    bf16_t* up = wsb(p, O_U) + (size_t)r * D;
#pragma unroll
    for (int i = 0; i < 4; ++i) {
        const int c = i * 256 + lane * 4;
        float4 w4 = *(const float4*)(nw + c), sh = *(const float4*)(md + c), sc = *(const float4*)(md + D + c);
        float a = v[i].x * rstd * w4.x * (1.f + sc.x) + sh.x, b = v[i].y * rstd * w4.y * (1.f + sc.y) + sh.y;
        float c2 = v[i].z * rstd * w4.z * (1.f + sc.z) + sh.z, d = v[i].w * rstd * w4.w * (1.f + sc.w) + sh.w;
        u32x2 o; o.x = pack2(a, b); o.y = pack2(c2, d);
        *(u32x2*)(up + c) = o;
    }
}
DEV void phase_norm(const Params& p, int l, int which, bool first, bool skip_ctx) {
    const int tid_ = get_tid(); const int lane = tid_ & 63, wv = tid_ >> 6;
    for (int r = blockIdx.x * 4 + wv; r < MR; r += gridDim.x * 4) {
        if (skip_ctx && (r % SB) < CTXL) continue;
        norm_row(p, l, which, first, r, lane);
    }
}
DEV void phase_fin_norm(const Params& p, int l, bool first, bool skip_ctx) {
    const int tid_ = get_tid(); const int lane = tid_ & 63, wv = tid_ >> 6;
    const float* dnn = p.in[I_DNNORM] + l * 128;
    for (int r = blockIdx.x * 4 + wv; r < MR; r += gridDim.x * 4) {
        if (skip_ctx && (r % SB) < CTXL) continue;
        norm_row(p, l, 0, first, r, lane);
        bf16_t* ta = wsb(p, O_TA) + (size_t)r * 512 + lane * 8;
        const bf16_t* tb = wsb(p, O_TA2) + (size_t)r * 512 + lane * 8;
        const bf16_t* zz = wsb(p, O_P) + (size_t)r * PW + C_DNZ + lane * 8;
        u32x4 a = *(const u32x4*)ta, b = *(const u32x4*)tb, z = *(const u32x4*)zz;
        float o[8]; float ss = 0.f;
#pragma unroll
        for (int i = 0; i < 4; ++i) { o[2 * i] = lo16(a[i]) + lo16(b[i]); o[2 * i + 1] = hi16(a[i]) + hi16(b[i]); ss += o[2 * i] * o[2 * i] + o[2 * i + 1] * o[2 * i + 1]; }
#pragma unroll
        for (int of = 8; of >= 1; of >>= 1) ss += __shfl_xor(ss, of);
        const float rstd = rsqrtf(ss * (1.f / 128.f) + 1e-6f);
        const int dv0 = (lane & 15) * 8;
        u32x4 y;
#pragma unroll
        for (int i = 0; i < 4; ++i) {
            float y0 = o[2 * i] * rstd * dnn[dv0 + 2 * i] * silu(lo16(z[i]));
            float y1 = o[2 * i + 1] * rstd * dnn[dv0 + 2 * i + 1] * silu(hi16(z[i]));
            y[i] = pack2(y0, y1);
        }
        *(u32x4*)ta = y;
    }
}
DEV void phase_final(const Params& p) {
    const int tid_ = get_tid(); const int lane = tid_ & 63, wv = tid_ >> 6;
    const float* nw = p.in[I_NFIN];
    for (int r = blockIdx.x * 4 + wv; r < NB * SEQ; r += gridDim.x * 4) {
        float* h = p.out + (size_t)r * D;
        float4 v[4]; float ss = 0.f;
#pragma unroll
        for (int i = 0; i < 4; ++i) { v[i] = *(const float4*)(h + i * 256 + lane * 4); ss += v[i].x * v[i].x + v[i].y * v[i].y + v[i].z * v[i].z + v[i].w * v[i].w; }
#pragma unroll
        for (int o = 32; o >= 1; o >>= 1) ss += __shfl_xor(ss, o);
        const float rstd = rsqrtf(ss * (1.f / D) + 1e-6f);
#pragma unroll
        for (int i = 0; i < 4; ++i) {
            const int c = i * 256 + lane * 4;
            float4 w4 = *(const float4*)(nw + c);
            float4 o4; o4.x = v[i].x * rstd * w4.x; o4.y = v[i].y * rstd * w4.y; o4.z = v[i].z * rstd * w4.z; o4.w = v[i].w * rstd * w4.w;
            *(float4*)(h + c) = o4;
        }
    }
}

DEV void phase_g1(const Params& p, unsigned char* smem) {
    bf16_t* sA = (bf16_t*)smem; bf16_t* sB = sA + 128 * GLD;
    const int tid = get_tid(), lane = tid & 63, wv = tid >> 6, wr = wv >> 1, wc = wv & 1, l15 = lane & 15, quad = lane >> 4;
    const bf16_t* U = wsb(p, O_U); const bf16_t* W = wsb(p, O_WT) + W_IN;
    bf16_t* P = wsb(p, O_P);
    const float* rope = wsf(p, O_ROPE);
    constexpr int NTN = NIN / 128;
    for (int t = blockIdx.x; t < (MR / 128) * NTN; t += gridDim.x) {
        const int tm = t / NTN, tn = t % NTN;
        const int row0 = tm * 128, col0 = tn * 128;
        f32x4 acc[4][4]; zero_acc(acc);
        gemm_core<4, 4>(U + (size_t)row0 * D, D, W + (size_t)col0 * D, D, D, acc, sA, sB);
        if (tn < 24) {
#pragma unroll
            for (int mt = 0; mt < 4; ++mt)
#pragma unroll
                for (int nt = 0; nt < 4; ++nt)
#pragma unroll
                    for (int j = 0; j < 4; ++j) {
                        const int row = row0 + wr * 64 + mt * 16 + quad * 4 + j, col = col0 + wc * 64 + nt * 16 + l15;
                        P[(size_t)row * PW + col] = f2bf(acc[mt][nt][j]);
                    }
        } else if (tn < 32) {
            const float qs = tn < 28 ? 0.125f : 1.f;
#pragma unroll
            for (int mt = 0; mt < 4; ++mt)
#pragma unroll
                for (int j = 0; j < 4; ++j) {
                    const int row = row0 + wr * 64 + mt * 16 + quad * 4 + j;
                    const int s = row % SB;
                    float c0 = 1.f, s0 = 0.f, c1 = 1.f, s1 = 0.f;
                    if (s >= CTXL) { const int tt = s - CTXL, pr = tt >> 6, pc = tt & 63;
                        c0 = rope[(pr * 16 + l15) * 2]; s0 = rope[(pr * 16 + l15) * 2 + 1]; c1 = rope[(pc * 16 + l15) * 2]; s1 = rope[(pc * 16 + l15) * 2 + 1]; }
                    const float x1 = acc[mt][0][j], x2 = acc[mt][1][j], y1 = acc[mt][2][j], y2 = acc[mt][3][j];
                    bf16_t* pp = P + (size_t)row * PW + col0 + wc * 64 + l15;
                    pp[0] = f2bf((x1 * c0 - x2 * s0) * qs);
                    pp[16] = f2bf((x2 * c0 + x1 * s0) * qs);
                    pp[32] = f2bf((y1 * c1 - y2 * s1) * qs);
                    pp[48] = f2bf((y2 * c1 + y1 * s1) * qs);
                }
        } else if (tn < 36) {
            bf16_t* VT = wsb(p, O_VT);
            const int b = row0 / SB, sbase = row0 - b * SB;
#pragma unroll
            for (int mt = 0; mt < 4; ++mt)
#pragma unroll
                for (int nt = 0; nt < 4; ++nt) {
                    const int cc = col0 - 4096 + wc * 64 + nt * 16 + l15;
                    const int s = sbase + wr * 64 + mt * 16 + quad * 4;
                    u32x2 o; o.x = pack2(acc[mt][nt][0], acc[mt][nt][1]); o.y = pack2(acc[mt][nt][2], acc[mt][nt][3]);
                    *(u32x2*)(VT + ((size_t)(b * 512 + cc)) * SB + s) = o;
                }
        } else {
            if (wc == 0) {
                float* AB = wsf(p, O_AB);
#pragma unroll
                for (int mt = 0; mt < 4; ++mt)
#pragma unroll
                    for (int j = 0; j < 4; ++j) {
                        const int row = row0 + wr * 64 + mt * 16 + quad * 4 + j;
                        AB[(size_t)row * 16 + l15] = acc[mt][0][j];
                    }
            }
        }
    }
}

DEV int rowtile0(int ti, bool latent_only) { if (!latent_only) return ti * 128; int b = ti >> 5, tt = ti & 31; return b * SB + CTXL + tt * 128; }

DEV void phase_merge(const Params& p, bool latent_only, unsigned char* smem) {
    bf16_t* sA = (bf16_t*)smem; bf16_t* sB = sA + 128 * GLD;
    const int tid = get_tid(), lane = tid & 63, wv = tid >> 6, wr = wv >> 1, wc = wv & 1, l15 = lane & 15, quad = lane >> 4;
    const bf16_t* U = wsb(p, O_U); const bf16_t* W = wsb(p, O_WT);
    bf16_t* P = wsb(p, O_P);
    const int nrt = latent_only ? 256 : 272;
    for (int t = blockIdx.x; t < nrt * 16; t += gridDim.x) {
        const int row0 = rowtile0(t >> 4, latent_only), col0 = (t & 15) * 64;
        f32x4 m[4][2]; zero_acc(m);
#pragma unroll 1
        for (int n = 0; n < 3; ++n) {
            f32x4 ag[4][2], au[4][2]; zero_acc(ag); zero_acc(au);
            gemm_core<4, 2>(U + (size_t)row0 * D, D, W + W_GATE + ((size_t)n * 1024 + col0) * D, D, D, ag, sA, sB);
            const bf16_t* Y; int ldy;
            if (n == 0) { Y = wsb(p, O_TA) + (size_t)row0 * 512; ldy = 512; }
            else if (n == 1) { Y = P + (size_t)row0 * PW + C_LG; ldy = PW; }
            else { Y = P + (size_t)row0 * PW + C_DAQ; ldy = PW; }
            gemm_core<4, 2>(Y, ldy, W + W_BR + ((size_t)n * 1024 + col0) * 512, 512, 512, au, sA, sB);
#pragma unroll
            for (int mt = 0; mt < 4; ++mt)
#pragma unroll
                for (int nt = 0; nt < 2; ++nt)
#pragma unroll
                    for (int j = 0; j < 4; ++j) m[mt][nt][j] += sigm(ag[mt][nt][j]) * au[mt][nt][j];
        }
#pragma unroll
        for (int mt = 0; mt < 4; ++mt)
#pragma unroll
            for (int nt = 0; nt < 2; ++nt)
#pragma unroll
                for (int j = 0; j < 4; ++j) {
                    const int row = row0 + wr * 64 + mt * 16 + quad * 4 + j, col = col0 + wc * 32 + nt * 16 + l15;
                    P[(size_t)row * PW + col] = f2bf(m[mt][nt][j]);
                }
    }
}

DEV void phase_resid(const Params& p, int l, const bf16_t* A, int lda, const bf16_t* Wt, int K, int chunk, bool first, bool latent_only, unsigned char* smem) {
    bf16_t* sA = (bf16_t*)smem; bf16_t* sB = sA + 128 * GLD;
    const int tid = get_tid(), lane = tid & 63, wv = tid >> 6, wr = wv >> 1, wc = wv & 1, l15 = lane & 15, quad = lane >> 4;
    const int nrt = latent_only ? 256 : 272;
    for (int t = blockIdx.x; t < nrt * 8; t += gridDim.x) {
        const int row0 = rowtile0(t >> 3, latent_only), col0 = (t & 7) * 128;
        f32x4 acc[4][4]; zero_acc(acc);
        gemm_core<4, 4>(A + (size_t)row0 * lda, lda, Wt + (size_t)col0 * K, K, K, acc, sA, sB);
        const float* md = wsf(p, O_MOD) + ((size_t)l * 9 + modrow(row0)) * 6144 + chunk * D;
#pragma unroll
        for (int mt = 0; mt < 4; ++mt)
#pragma unroll
            for (int j = 0; j < 4; ++j) {
                const int row = row0 + wr * 64 + mt * 16 + quad * 4 + j;
                const float* hs = first ? xrow(p, row) : hrow(p, row);
                float* hd = hrow(p, row);
#pragma unroll
                for (int nt = 0; nt < 4; ++nt) { const int col = col0 + wc * 64 + nt * 16 + l15; hd[col] = hs[col] + md[col] * acc[mt][nt][j]; }
            }
    }
}
DEV void phase_gu(const Params& p, bool latent_only, unsigned char* smem) {
    bf16_t* sA = (bf16_t*)smem; bf16_t* sB = sA + 128 * GLD;
    const int tid = get_tid(), lane = tid & 63, wv = tid >> 6, wr = wv >> 1, wc = wv & 1, l15 = lane & 15, quad = lane >> 4;
    const bf16_t* U = wsb(p, O_U); const bf16_t* W = wsb(p, O_WT) + W_GU;
    bf16_t* P = wsb(p, O_P);
    const int nrt = latent_only ? 256 : 272;
    for (int t = blockIdx.x; t < nrt * 44; t += gridDim.x) {
        const int row0 = rowtile0(t / 44, latent_only), tn = t % 44;
        f32x4 acc[4][4]; zero_acc(acc);
        gemm_core<4, 4>(U + (size_t)row0 * D, D, W + (size_t)tn * 128 * D, D, D, acc, sA, sB);
#pragma unroll
        for (int mt = 0; mt < 4; ++mt)
#pragma unroll
            for (int pr = 0; pr < 2; ++pr)
#pragma unroll
                for (int j = 0; j < 4; ++j) {
                    const int row = row0 + wr * 64 + mt * 16 + quad * 4 + j, hc = (tn * 4 + wc * 2 + pr) * 16 + l15;
                    P[(size_t)row * PW + hc] = f2bf(silu(acc[mt][2 * pr][j]) * acc[mt][2 * pr + 1][j]);
                }
    }
}

DEV int chunk_of(int dir, int n) { return dir ? (n < 4 ? 3 - n : 71 - n) : n; }

DEV void dn_solve(const float* __restrict__ L_s, const bf16_t* __restrict__ colp, const float* __restrict__ mulp, const float sg, bf16_t* __restrict__ outp) {
    float x0, x1, x2, x3, x4, x5, x6, x7, x8, x9, x10, x11, x12, x13, x14, x15, x16, x17, x18, x19, x20, x21, x22, x23, x24, x25, x26, x27, x28, x29, x30, x31, x32, x33, x34, x35, x36, x37, x38, x39, x40, x41, x42, x43, x44, x45, x46, x47, x48, x49, x50, x51, x52, x53, x54, x55, x56, x57, x58, x59, x60, x61, x62, x63;
    { float a0 = bf2f(colp[0]) * mulp[0]; float a1 = 0.f;
      x0 = a0 + a1; }
    { float a0 = bf2f(colp[136]) * mulp[1]; float a1 = 0.f;
      { const f32x4 Lv = *(const f32x4*)(L_s + 68);
        a0 -= Lv[0] * x0;
      }
      x1 = a0 + a1; } __builtin_amdgcn_sched_barrier(0);
    { float a0 = bf2f(colp[272]) * mulp[2]; float a1 = 0.f;
      { const f32x4 Lv = *(const f32x4*)(L_s + 136);
        a0 -= Lv[0] * x0;
        a1 -= Lv[1] * x1;
      }
      x2 = a0 + a1; }
    { float a0 = bf2f(colp[408]) * mulp[3]; float a1 = 0.f;
      { const f32x4 Lv = *(const f32x4*)(L_s + 204);
        a0 -= Lv[0] * x0;
        a1 -= Lv[1] * x1;
        a0 -= Lv[2] * x2;
      }
      x3 = a0 + a1; } __builtin_amdgcn_sched_barrier(0);
    { float a0 = bf2f(colp[544]) * mulp[4]; float a1 = 0.f;
      { const f32x4 Lv = *(const f32x4*)(L_s + 272);
        a0 -= Lv[0] * x0;
        a1 -= Lv[1] * x1;
        a0 -= Lv[2] * x2;
        a1 -= Lv[3] * x3;
      }
      x4 = a0 + a1; }
    { float a0 = bf2f(colp[680]) * mulp[5]; float a1 = 0.f;
      { const f32x4 Lv = *(const f32x4*)(L_s + 340);
        a0 -= Lv[0] * x0;
        a1 -= Lv[1] * x1;
        a0 -= Lv[2] * x2;
        a1 -= Lv[3] * x3;
      }
      { const f32x4 Lv = *(const f32x4*)(L_s + 344);
        a0 -= Lv[0] * x4;
      }
      x5 = a0 + a1; } __builtin_amdgcn_sched_barrier(0);
    { float a0 = bf2f(colp[816]) * mulp[6]; float a1 = 0.f;
      { const f32x4 Lv = *(const f32x4*)(L_s + 408);
        a0 -= Lv[0] * x0;
        a1 -= Lv[1] * x1;
        a0 -= Lv[2] * x2;
        a1 -= Lv[3] * x3;
      }
      { const f32x4 Lv = *(const f32x4*)(L_s + 412);
        a0 -= Lv[0] * x4;
        a1 -= Lv[1] * x5;
      }
      x6 = a0 + a1; }
    { float a0 = bf2f(colp[952]) * mulp[7]; float a1 = 0.f;
      { const f32x4 Lv = *(const f32x4*)(L_s + 476);
        a0 -= Lv[0] * x0;
        a1 -= Lv[1] * x1;
        a0 -= Lv[2] * x2;
        a1 -= Lv[3] * x3;
      }
      { const f32x4 Lv = *(const f32x4*)(L_s + 480);
        a0 -= Lv[0] * x4;
        a1 -= Lv[1] * x5;
        a0 -= Lv[2] * x6;
      }
      x7 = a0 + a1; } __builtin_amdgcn_sched_barrier(0);
    { float a0 = bf2f(colp[1088]) * mulp[8]; float a1 = 0.f;
      { const f32x4 Lv = *(const f32x4*)(L_s + 544);
        a0 -= Lv[0] * x0;
        a1 -= Lv[1] * x1;
        a0 -= Lv[2] * x2;
        a1 -= Lv[3] * x3;
      }
      { const f32x4 Lv = *(const f32x4*)(L_s + 548);
        a0 -= Lv[0] * x4;
        a1 -= Lv[1] * x5;
        a0 -= Lv[2] * x6;
        a1 -= Lv[3] * x7;
      }
      x8 = a0 + a1; }
    { float a0 = bf2f(colp[1224]) * mulp[9]; float a1 = 0.f;
      { const f32x4 Lv = *(const f32x4*)(L_s + 612);
        a0 -= Lv[0] * x0;
        a1 -= Lv[1] * x1;
        a0 -= Lv[2] * x2;
        a1 -= Lv[3] * x3;
      }
      { const f32x4 Lv = *(const f32x4*)(L_s + 616);
        a0 -= Lv[0] * x4;
        a1 -= Lv[1] * x5;
        a0 -= Lv[2] * x6;
        a1 -= Lv[3] * x7;
      }
      { const f32x4 Lv = *(const f32x4*)(L_s + 620);
        a0 -= Lv[0] * x8;
      }
      x9 = a0 + a1; } __builtin_amdgcn_sched_barrier(0);
    { float a0 = bf2f(colp[1360]) * mulp[10]; float a1 = 0.f;
      { const f32x4 Lv = *(const f32x4*)(L_s + 680);
        a0 -= Lv[0] * x0;
        a1 -= Lv[1] * x1;
        a0 -= Lv[2] * x2;
        a1 -= Lv[3] * x3;
      }
      { const f32x4 Lv = *(const f32x4*)(L_s + 684);
        a0 -= Lv[0] * x4;
        a1 -= Lv[1] * x5;
        a0 -= Lv[2] * x6;
        a1 -= Lv[3] * x7;
      }
      { const f32x4 Lv = *(const f32x4*)(L_s + 688);
        a0 -= Lv[0] * x8;
        a1 -= Lv[1] * x9;
      }
      x10 = a0 + a1; }
    { float a0 = bf2f(colp[1496]) * mulp[11]; float a1 = 0.f;
      { const f32x4 Lv = *(const f32x4*)(L_s + 748);
        a0 -= Lv[0] * x0;
        a1 -= Lv[1] * x1;
        a0 -= Lv[2] * x2;
        a1 -= Lv[3] * x3;
      }
      { const f32x4 Lv = *(const f32x4*)(L_s + 752);
        a0 -= Lv[0] * x4;
        a1 -= Lv[1] * x5;
        a0 -= Lv[2] * x6;
        a1 -= Lv[3] * x7;
      }
      { const f32x4 Lv = *(const f32x4*)(L_s + 756);
        a0 -= Lv[0] * x8;
        a1 -= Lv[1] * x9;
        a0 -= Lv[2] * x10;
      }
      x11 = a0 + a1; } __builtin_amdgcn_sched_barrier(0);
    { float a0 = bf2f(colp[1632]) * mulp[12]; float a1 = 0.f;
      { const f32x4 Lv = *(const f32x4*)(L_s + 816);
        a0 -= Lv[0] * x0;
        a1 -= Lv[1] * x1;
        a0 -= Lv[2] * x2;
        a1 -= Lv[3] * x3;
      }
      { const f32x4 Lv = *(const f32x4*)(L_s + 820);
        a0 -= Lv[0] * x4;
        a1 -= Lv[1] * x5;
        a0 -= Lv[2] * x6;
        a1 -= Lv[3] * x7;
      }
      { const f32x4 Lv = *(const f32x4*)(L_s + 824);
        a0 -= Lv[0] * x8;
        a1 -= Lv[1] * x9;
        a0 -= Lv[2] * x10;
        a1 -= Lv[3] * x11;
      }
      x12 = a0 + a1; }
    { float a0 = bf2f(colp[1768]) * mulp[13]; float a1 = 0.f;
      { const f32x4 Lv = *(const f32x4*)(L_s + 884);
        a0 -= Lv[0] * x0;
        a1 -= Lv[1] * x1;
        a0 -= Lv[2] * x2;
        a1 -= Lv[3] * x3;
      }
      { const f32x4 Lv = *(const f32x4*)(L_s + 888);
        a0 -= Lv[0] * x4;
        a1 -= Lv[1] * x5;
        a0 -= Lv[2] * x6;
        a1 -= Lv[3] * x7;
      }
      { const f32x4 Lv = *(const f32x4*)(L_s + 892);
        a0 -= Lv[0] * x8;
        a1 -= Lv[1] * x9;
        a0 -= Lv[2] * x10;
        a1 -= Lv[3] * x11;
      }
      { const f32x4 Lv = *(const f32x4*)(L_s + 896);
        a0 -= Lv[0] * x12;
      }
      x13 = a0 + a1; } __builtin_amdgcn_sched_barrier(0);
    { float a0 = bf2f(colp[1904]) * mulp[14]; float a1 = 0.f;
      { const f32x4 Lv = *(const f32x4*)(L_s + 952);
        a0 -= Lv[0] * x0;
        a1 -= Lv[1] * x1;
        a0 -= Lv[2] * x2;
        a1 -= Lv[3] * x3;
      }
      { const f32x4 Lv = *(const f32x4*)(L_s + 956);
        a0 -= Lv[0] * x4;
        a1 -= Lv[1] * x5;
        a0 -= Lv[2] * x6;
        a1 -= Lv[3] * x7;
      }
      { const f32x4 Lv = *(const f32x4*)(L_s + 960);
        a0 -= Lv[0] * x8;
        a1 -= Lv[1] * x9;
        a0 -= Lv[2] * x10;
        a1 -= Lv[3] * x11;
      }
      { const f32x4 Lv = *(const f32x4*)(L_s + 964);
        a0 -= Lv[0] * x12;
        a1 -= Lv[1] * x13;
      }
      x14 = a0 + a1; }
    { float a0 = bf2f(colp[2040]) * mulp[15]; float a1 = 0.f;
      { const f32x4 Lv = *(const f32x4*)(L_s + 1020);
        a0 -= Lv[0] * x0;
        a1 -= Lv[1] * x1;
        a0 -= Lv[2] * x2;
        a1 -= Lv[3] * x3;
      }
      { const f32x4 Lv = *(const f32x4*)(L_s + 1024);
        a0 -= Lv[0] * x4;
        a1 -= Lv[1] * x5;
        a0 -= Lv[2] * x6;
        a1 -= Lv[3] * x7;
      }
      { const f32x4 Lv = *(const f32x4*)(L_s + 1028);
        a0 -= Lv[0] * x8;
        a1 -= Lv[1] * x9;
        a0 -= Lv[2] * x10;
        a1 -= Lv[3] * x11;
      }
      { const f32x4 Lv = *(const f32x4*)(L_s + 1032);
        a0 -= Lv[0] * x12;
        a1 -= Lv[1] * x13;
        a0 -= Lv[2] * x14;
      }
      x15 = a0 + a1; } __builtin_amdgcn_sched_barrier(0);
    { float a0 = bf2f(colp[2176]) * mulp[16]; float a1 = 0.f;
      { const f32x4 Lv = *(const f32x4*)(L_s + 1088);
        a0 -= Lv[0] * x0;
        a1 -= Lv[1] * x1;
        a0 -= Lv[2] * x2;
        a1 -= Lv[3] * x3;
      }
      { const f32x4 Lv = *(const f32x4*)(L_s + 1092);
        a0 -= Lv[0] * x4;
        a1 -= Lv[1] * x5;
        a0 -= Lv[2] * x6;
        a1 -= Lv[3] * x7;
      }
      { const f32x4 Lv = *(const f32x4*)(L_s + 1096);
        a0 -= Lv[0] * x8;
        a1 -= Lv[1] * x9;
        a0 -= Lv[2] * x10;
        a1 -= Lv[3] * x11;
      }
      { const f32x4 Lv = *(const f32x4*)(L_s + 1100);
        a0 -= Lv[0] * x12;
        a1 -= Lv[1] * x13;
        a0 -= Lv[2] * x14;
        a1 -= Lv[3] * x15;
      }
      x16 = a0 + a1; }
    { float a0 = bf2f(colp[2312]) * mulp[17]; float a1 = 0.f;
      { const f32x4 Lv = *(const f32x4*)(L_s + 1156);
        a0 -= Lv[0] * x0;
        a1 -= Lv[1] * x1;
        a0 -= Lv[2] * x2;
        a1 -= Lv[3] * x3;
      }
      { const f32x4 Lv = *(const f32x4*)(L_s + 1160);
        a0 -= Lv[0] * x4;
        a1 -= Lv[1] * x5;
        a0 -= Lv[2] * x6;
        a1 -= Lv[3] * x7;
      }
      { const f32x4 Lv = *(const f32x4*)(L_s + 1164);
        a0 -= Lv[0] * x8;
        a1 -= Lv[1] * x9;
        a0 -= Lv[2] * x10;
        a1 -= Lv[3] * x11;
      }
      { const f32x4 Lv = *(const f32x4*)(L_s + 1168);
        a0 -= Lv[0] * x12;
        a1 -= Lv[1] * x13;
        a0 -= Lv[2] * x14;
        a1 -= Lv[3] * x15;
      }
      { const f32x4 Lv = *(const f32x4*)(L_s + 1172);
        a0 -= Lv[0] * x16;
      }
      x17 = a0 + a1; } __builtin_amdgcn_sched_barrier(0);
    { float a0 = bf2f(colp[2448]) * mulp[18]; float a1 = 0.f;
      { const f32x4 Lv = *(const f32x4*)(L_s + 1224);
        a0 -= Lv[0] * x0;
        a1 -= Lv[1] * x1;
        a0 -= Lv[2] * x2;
        a1 -= Lv[3] * x3;
      }
      { const f32x4 Lv = *(const f32x4*)(L_s + 1228);
        a0 -= Lv[0] * x4;
        a1 -= Lv[1] * x5;
        a0 -= Lv[2] * x6;
        a1 -= Lv[3] * x7;
      }
      { const f32x4 Lv = *(const f32x4*)(L_s + 1232);
        a0 -= Lv[0] * x8;
        a1 -= Lv[1] * x9;
        a0 -= Lv[2] * x10;
        a1 -= Lv[3] * x11;
      }
      { const f32x4 Lv = *(const f32x4*)(L_s + 1236);
        a0 -= Lv[0] * x12;
        a1 -= Lv[1] * x13;
        a0 -= Lv[2] * x14;
        a1 -= Lv[3] * x15;
      }
      { const f32x4 Lv = *(const f32x4*)(L_s + 1240);
        a0 -= Lv[0] * x16;
        a1 -= Lv[1] * x17;
      }
      x18 = a0 + a1; }
    { float a0 = bf2f(colp[2584]) * mulp[19]; float a1 = 0.f;
      { const f32x4 Lv = *(const f32x4*)(L_s + 1292);
        a0 -= Lv[0] * x0;
        a1 -= Lv[1] * x1;
        a0 -= Lv[2] * x2;
        a1 -= Lv[3] * x3;
      }
      { const f32x4 Lv = *(const f32x4*)(L_s + 1296);
        a0 -= Lv[0] * x4;
        a1 -= Lv[1] * x5;
        a0 -= Lv[2] * x6;
        a1 -= Lv[3] * x7;
      }
      { const f32x4 Lv = *(const f32x4*)(L_s + 1300);
        a0 -= Lv[0] * x8;
        a1 -= Lv[1] * x9;
        a0 -= Lv[2] * x10;
        a1 -= Lv[3] * x11;
      }
      { const f32x4 Lv = *(const f32x4*)(L_s + 1304);
        a0 -= Lv[0] * x12;
        a1 -= Lv[1] * x13;
        a0 -= Lv[2] * x14;
        a1 -= Lv[3] * x15;
      }
      { const f32x4 Lv = *(const f32x4*)(L_s + 1308);
        a0 -= Lv[0] * x16;
        a1 -= Lv[1] * x17;
        a0 -= Lv[2] * x18;
      }
      x19 = a0 + a1; } __builtin_amdgcn_sched_barrier(0);
    { float a0 = bf2f(colp[2720]) * mulp[20]; float a1 = 0.f;
      { const f32x4 Lv = *(const f32x4*)(L_s + 1360);
        a0 -= Lv[0] * x0;
        a1 -= Lv[1] * x1;
        a0 -= Lv[2] * x2;
        a1 -= Lv[3] * x3;
      }
      { const f32x4 Lv = *(const f32x4*)(L_s + 1364);
        a0 -= Lv[0] * x4;
        a1 -= Lv[1] * x5;
        a0 -= Lv[2] * x6;
        a1 -= Lv[3] * x7;
      }
      { const f32x4 Lv = *(const f32x4*)(L_s + 1368);
        a0 -= Lv[0] * x8;
        a1 -= Lv[1] * x9;
        a0 -= Lv[2] * x10;
        a1 -= Lv[3] * x11;
      }
      { const f32x4 Lv = *(const f32x4*)(L_s + 1372);
        a0 -= Lv[0] * x12;
        a1 -= Lv[1] * x13;
        a0 -= Lv[2] * x14;
        a1 -= Lv[3] * x15;
      }
      { const f32x4 Lv = *(const f32x4*)(L_s + 1376);
        a0 -= Lv[0] * x16;
        a1 -= Lv[1] * x17;
        a0 -= Lv[2] * x18;
        a1 -= Lv[3] * x19;
      }
      x20 = a0 + a1; }
    { float a0 = bf2f(colp[2856]) * mulp[21]; float a1 = 0.f;
      { const f32x4 Lv = *(const f32x4*)(L_s + 1428);
        a0 -= Lv[0] * x0;
        a1 -= Lv[1] * x1;
        a0 -= Lv[2] * x2;
        a1 -= Lv[3] * x3;
      }
      { const f32x4 Lv = *(const f32x4*)(L_s + 1432);
        a0 -= Lv[0] * x4;
        a1 -= Lv[1] * x5;
        a0 -= Lv[2] * x6;
        a1 -= Lv[3] * x7;
      }
      { const f32x4 Lv = *(const f32x4*)(L_s + 1436);
        a0 -= Lv[0] * x8;
        a1 -= Lv[1] * x9;
        a0 -= Lv[2] * x10;
        a1 -= Lv[3] * x11;
      }
      { const f32x4 Lv = *(const f32x4*)(L_s + 1440);
        a0 -= Lv[0] * x12;
        a1 -= Lv[1] * x13;
        a0 -= Lv[2] * x14;
        a1 -= Lv[3] * x15;
      }
      { const f32x4 Lv = *(const f32x4*)(L_s + 1444);
        a0 -= Lv[0] * x16;
        a1 -= Lv[1] * x17;
        a0 -= Lv[2] * x18;
        a1 -= Lv[3] * x19;
      }
      { const f32x4 Lv = *(const f32x4*)(L_s + 1448);
        a0 -= Lv[0] * x20;
      }
      x21 = a0 + a1; } __builtin_amdgcn_sched_barrier(0);
    { float a0 = bf2f(colp[2992]) * mulp[22]; float a1 = 0.f;
      { const f32x4 Lv = *(const f32x4*)(L_s + 1496);
        a0 -= Lv[0] * x0;
        a1 -= Lv[1] * x1;
        a0 -= Lv[2] * x2;
        a1 -= Lv[3] * x3;
      }
      { const f32x4 Lv = *(const f32x4*)(L_s + 1500);
        a0 -= Lv[0] * x4;
        a1 -= Lv[1] * x5;
        a0 -= Lv[2] * x6;
        a1 -= Lv[3] * x7;
      }
      { const f32x4 Lv = *(const f32x4*)(L_s + 1504);
        a0 -= Lv[0] * x8;
        a1 -= Lv[1] * x9;
        a0 -= Lv[2] * x10;
        a1 -= Lv[3] * x11;
      }
      { const f32x4 Lv = *(const f32x4*)(L_s + 1508);
        a0 -= Lv[0] * x12;
        a1 -= Lv[1] * x13;
        a0 -= Lv[2] * x14;
        a1 -= Lv[3] * x15;
      }
      { const f32x4 Lv = *(const f32x4*)(L_s + 1512);
        a0 -= Lv[0] * x16;
        a1 -= Lv[1] * x17;
        a0 -= Lv[2] * x18;
        a1 -= Lv[3] * x19;
      }
      { const f32x4 Lv = *(const f32x4*)(L_s + 1516);
        a0 -= Lv[0] * x20;
        a1 -= Lv[1] * x21;
      }
      x22 = a0 + a1; }
    { float a0 = bf2f(colp[3128]) * mulp[23]; float a1 = 0.f;
      { const f32x4 Lv = *(const f32x4*)(L_s + 1564);
        a0 -= Lv[0] * x0;
        a1 -= Lv[1] * x1;
        a0 -= Lv[2] * x2;
        a1 -= Lv[3] * x3;
      }
      { const f32x4 Lv = *(const f32x4*)(L_s + 1568);
        a0 -= Lv[0] * x4;
        a1 -= Lv[1] * x5;
        a0 -= Lv[2] * x6;
        a1 -= Lv[3] * x7;
      }
      { const f32x4 Lv = *(const f32x4*)(L_s + 1572);
        a0 -= Lv[0] * x8;
        a1 -= Lv[1] * x9;
        a0 -= Lv[2] * x10;
        a1 -= Lv[3] * x11;
      }
      { const f32x4 Lv = *(const f32x4*)(L_s + 1576);
        a0 -= Lv[0] * x12;
        a1 -= Lv[1] * x13;
        a0 -= Lv[2] * x14;
        a1 -= Lv[3] * x15;
      }
      { const f32x4 Lv = *(const f32x4*)(L_s + 1580);
        a0 -= Lv[0] * x16;
        a1 -= Lv[1] * x17;
        a0 -= Lv[2] * x18;
        a1 -= Lv[3] * x19;
      }
      { const f32x4 Lv = *(const f32x4*)(L_s + 1584);
        a0 -= Lv[0] * x20;
        a1 -= Lv[1] * x21;
        a0 -= Lv[2] * x22;
      }
      x23 = a0 + a1; } __builtin_amdgcn_sched_barrier(0);
    { float a0 = bf2f(colp[3264]) * mulp[24]; float a1 = 0.f;
      { const f32x4 Lv = *(const f32x4*)(L_s + 1632);
        a0 -= Lv[0] * x0;
        a1 -= Lv[1] * x1;
        a0 -= Lv[2] * x2;
        a1 -= Lv[3] * x3;
      }
      { const f32x4 Lv = *(const f32x4*)(L_s + 1636);
        a0 -= Lv[0] * x4;
        a1 -= Lv[1] * x5;
        a0 -= Lv[2] * x6;
        a1 -= Lv[3] * x7;
      }
      { const f32x4 Lv = *(const f32x4*)(L_s + 1640);
        a0 -= Lv[0] * x8;
        a1 -= Lv[1] * x9;
        a0 -= Lv[2] * x10;
        a1 -= Lv[3] * x11;
      }
      { const f32x4 Lv = *(const f32x4*)(L_s + 1644);
        a0 -= Lv[0] * x12;
        a1 -= Lv[1] * x13;
        a0 -= Lv[2] * x14;
        a1 -= Lv[3] * x15;
      }
      { const f32x4 Lv = *(const f32x4*)(L_s + 1648);
        a0 -= Lv[0] * x16;
        a1 -= Lv[1] * x17;
        a0 -= Lv[2] * x18;
        a1 -= Lv[3] * x19;
      }
      { const f32x4 Lv = *(const f32x4*)(L_s + 1652);
        a0 -= Lv[0] * x20;
        a1 -= Lv[1] * x21;
        a0 -= Lv[2] * x22;
        a1 -= Lv[3] * x23;
      }
      x24 = a0 + a1; }
    { float a0 = bf2f(colp[3400]) * mulp[25]; float a1 = 0.f;
      { const f32x4 Lv = *(const f32x4*)(L_s + 1700);
        a0 -= Lv[0] * x0;
        a1 -= Lv[1] * x1;
        a0 -= Lv[2] * x2;
        a1 -= Lv[3] * x3;
      }
      { const f32x4 Lv = *(const f32x4*)(L_s + 1704);
        a0 -= Lv[0] * x4;
        a1 -= Lv[1] * x5;
        a0 -= Lv[2] * x6;
        a1 -= Lv[3] * x7;
      }
      { const f32x4 Lv = *(const f32x4*)(L_s + 1708);
        a0 -= Lv[0] * x8;
        a1 -= Lv[1] * x9;
        a0 -= Lv[2] * x10;
        a1 -= Lv[3] * x11;
      }
      { const f32x4 Lv = *(const f32x4*)(L_s + 1712);
        a0 -= Lv[0] * x12;
        a1 -= Lv[1] * x13;
        a0 -= Lv[2] * x14;
        a1 -= Lv[3] * x15;
      }
      { const f32x4 Lv = *(const f32x4*)(L_s + 1716);
        a0 -= Lv[0] * x16;
        a1 -= Lv[1] * x17;
        a0 -= Lv[2] * x18;
        a1 -= Lv[3] * x19;
      }
      { const f32x4 Lv = *(const f32x4*)(L_s + 1720);
        a0 -= Lv[0] * x20;
        a1 -= Lv[1] * x21;
        a0 -= Lv[2] * x22;
        a1 -= Lv[3] * x23;
      }
      { const f32x4 Lv = *(const f32x4*)(L_s + 1724);
        a0 -= Lv[0] * x24;
      }
      x25 = a0 + a1; } __builtin_amdgcn_sched_barrier(0);
    { float a0 = bf2f(colp[3536]) * mulp[26]; float a1 = 0.f;
      { const f32x4 Lv = *(const f32x4*)(L_s + 1768);
        a0 -= Lv[0] * x0;
        a1 -= Lv[1] * x1;
        a0 -= Lv[2] * x2;
        a1 -= Lv[3] * x3;
      }
      { const f32x4 Lv = *(const f32x4*)(L_s + 1772);
        a0 -= Lv[0] * x4;
        a1 -= Lv[1] * x5;
        a0 -= Lv[2] * x6;
        a1 -= Lv[3] * x7;
      }
      { const f32x4 Lv = *(const f32x4*)(L_s + 1776);
        a0 -= Lv[0] * x8;
        a1 -= Lv[1] * x9;
        a0 -= Lv[2] * x10;
        a1 -= Lv[3] * x11;
      }
      { const f32x4 Lv = *(const f32x4*)(L_s + 1780);
        a0 -= Lv[0] * x12;
        a1 -= Lv[1] * x13;
        a0 -= Lv[2] * x14;
        a1 -= Lv[3] * x15;
      }
      { const f32x4 Lv = *(const f32x4*)(L_s + 1784);
        a0 -= Lv[0] * x16;
        a1 -= Lv[1] * x17;
        a0 -= Lv[2] * x18;
        a1 -= Lv[3] * x19;
      }
      { const f32x4 Lv = *(const f32x4*)(L_s + 1788);
        a0 -= Lv[0] * x20;
        a1 -= Lv[1] * x21;
        a0 -= Lv[2] * x22;
        a1 -= Lv[3] * x23;
      }
      { const f32x4 Lv = *(const f32x4*)(L_s + 1792);
        a0 -= Lv[0] * x24;
        a1 -= Lv[1] * x25;
      }
      x26 = a0 + a1; }
    { float a0 = bf2f(colp[3672]) * mulp[27]; float a1 = 0.f;
      { const f32x4 Lv = *(const f32x4*)(L_s + 1836);
        a0 -= Lv[0] * x0;
        a1 -= Lv[1] * x1;
        a0 -= Lv[2] * x2;
        a1 -= Lv[3] * x3;
      }
      { const f32x4 Lv = *(const f32x4*)(L_s + 1840);
        a0 -= Lv[0] * x4;
        a1 -= Lv[1] * x5;
        a0 -= Lv[2] * x6;
        a1 -= Lv[3] * x7;
      }
      { const f32x4 Lv = *(const f32x4*)(L_s + 1844);
        a0 -= Lv[0] * x8;
        a1 -= Lv[1] * x9;
        a0 -= Lv[2] * x10;
        a1 -= Lv[3] * x11;
      }
      { const f32x4 Lv = *(const f32x4*)(L_s + 1848);
        a0 -= Lv[0] * x12;
        a1 -= Lv[1] * x13;
        a0 -= Lv[2] * x14;
        a1 -= Lv[3] * x15;
      }
      { const f32x4 Lv = *(const f32x4*)(L_s + 1852);
        a0 -= Lv[0] * x16;
        a1 -= Lv[1] * x17;
        a0 -= Lv[2] * x18;
        a1 -= Lv[3] * x19;
      }
      { const f32x4 Lv = *(const f32x4*)(L_s + 1856);
        a0 -= Lv[0] * x20;
        a1 -= Lv[1] * x21;
        a0 -= Lv[2] * x22;
        a1 -= Lv[3] * x23;
      }
      { const f32x4 Lv = *(const f32x4*)(L_s + 1860);
        a0 -= Lv[0] * x24;
        a1 -= Lv[1] * x25;
        a0 -= Lv[2] * x26;
      }
      x27 = a0 + a1; } __builtin_amdgcn_sched_barrier(0);
    { float a0 = bf2f(colp[3808]) * mulp[28]; float a1 = 0.f;
      { const f32x4 Lv = *(const f32x4*)(L_s + 1904);
        a0 -= Lv[0] * x0;
        a1 -= Lv[1] * x1;
        a0 -= Lv[2] * x2;
        a1 -= Lv[3] * x3;
      }
      { const f32x4 Lv = *(const f32x4*)(L_s + 1908);
        a0 -= Lv[0] * x4;
        a1 -= Lv[1] * x5;
        a0 -= Lv[2] * x6;
        a1 -= Lv[3] * x7;
      }
      { const f32x4 Lv = *(const f32x4*)(L_s + 1912);
        a0 -= Lv[0] * x8;
        a1 -= Lv[1] * x9;
        a0 -= Lv[2] * x10;
        a1 -= Lv[3] * x11;
      }
      { const f32x4 Lv = *(const f32x4*)(L_s + 1916);
        a0 -= Lv[0] * x12;
        a1 -= Lv[1] * x13;
        a0 -= Lv[2] * x14;
        a1 -= Lv[3] * x15;
      }
      { const f32x4 Lv = *(const f32x4*)(L_s + 1920);
        a0 -= Lv[0] * x16;
        a1 -= Lv[1] * x17;
        a0 -= Lv[2] * x18;
        a1 -= Lv[3] * x19;
      }
      { const f32x4 Lv = *(const f32x4*)(L_s + 1924);
        a0 -= Lv[0] * x20;
        a1 -= Lv[1] * x21;
        a0 -= Lv[2] * x22;
        a1 -= Lv[3] * x23;
      }
      { const f32x4 Lv = *(const f32x4*)(L_s + 1928);
        a0 -= Lv[0] * x24;
        a1 -= Lv[1] * x25;
        a0 -= Lv[2] * x26;
        a1 -= Lv[3] * x27;
      }
      x28 = a0 + a1; }
    { float a0 = bf2f(colp[3944]) * mulp[29]; float a1 = 0.f;
      { const f32x4 Lv = *(const f32x4*)(L_s + 1972);
        a0 -= Lv[0] * x0;
        a1 -= Lv[1] * x1;
        a0 -= Lv[2] * x2;
        a1 -= Lv[3] * x3;
      }
      { const f32x4 Lv = *(const f32x4*)(L_s + 1976);
        a0 -= Lv[0] * x4;
        a1 -= Lv[1] * x5;
        a0 -= Lv[2] * x6;
        a1 -= Lv[3] * x7;
      }
      { const f32x4 Lv = *(const f32x4*)(L_s + 1980);
        a0 -= Lv[0] * x8;
        a1 -= Lv[1] * x9;
        a0 -= Lv[2] * x10;
        a1 -= Lv[3] * x11;
      }
      { const f32x4 Lv = *(const f32x4*)(L_s + 1984);
        a0 -= Lv[0] * x12;
        a1 -= Lv[1] * x13;
        a0 -= Lv[2] * x14;
        a1 -= Lv[3] * x15;
      }
      { const f32x4 Lv = *(const f32x4*)(L_s + 1988);
        a0 -= Lv[0] * x16;
        a1 -= Lv[1] * x17;
        a0 -= Lv[2] * x18;
        a1 -= Lv[3] * x19;
      }
      { const f32x4 Lv = *(const f32x4*)(L_s + 1992);
        a0 -= Lv[0] * x20;
        a1 -= Lv[1] * x21;
        a0 -= Lv[2] * x22;
        a1 -= Lv[3] * x23;
      }
      { const f32x4 Lv = *(const f32x4*)(L_s + 1996);
        a0 -= Lv[0] * x24;
        a1 -= Lv[1] * x25;
        a0 -= Lv[2] * x26;
        a1 -= Lv[3] * x27;
      }
      { const f32x4 Lv = *(const f32x4*)(L_s + 2000);
        a0 -= Lv[0] * x28;
      }
      x29 = a0 + a1; } __builtin_amdgcn_sched_barrier(0);
    { float a0 = bf2f(colp[4080]) * mulp[30]; float a1 = 0.f;
      { const f32x4 Lv = *(const f32x4*)(L_s + 2040);
        a0 -= Lv[0] * x0;
        a1 -= Lv[1] * x1;
        a0 -= Lv[2] * x2;
        a1 -= Lv[3] * x3;
      }
      { const f32x4 Lv = *(const f32x4*)(L_s + 2044);
        a0 -= Lv[0] * x4;
        a1 -= Lv[1] * x5;
        a0 -= Lv[2] * x6;
        a1 -= Lv[3] * x7;
      }
      { const f32x4 Lv = *(const f32x4*)(L_s + 2048);
        a0 -= Lv[0] * x8;
        a1 -= Lv[1] * x9;
        a0 -= Lv[2] * x10;
        a1 -= Lv[3] * x11;
      }
      { const f32x4 Lv = *(const f32x4*)(L_s + 2052);
        a0 -= Lv[0] * x12;
        a1 -= Lv[1] * x13;
        a0 -= Lv[2] * x14;
        a1 -= Lv[3] * x15;
      }
      { const f32x4 Lv = *(const f32x4*)(L_s + 2056);
        a0 -= Lv[0] * x16;
        a1 -= Lv[1] * x17;
        a0 -= Lv[2] * x18;
        a1 -= Lv[3] * x19;
      }
      { const f32x4 Lv = *(const f32x4*)(L_s + 2060);
        a0 -= Lv[0] * x20;
        a1 -= Lv[1] * x21;
        a0 -= Lv[2] * x22;
        a1 -= Lv[3] * x23;
      }
      { const f32x4 Lv = *(const f32x4*)(L_s + 2064);
        a0 -= Lv[0] * x24;
        a1 -= Lv[1] * x25;
        a0 -= Lv[2] * x26;
        a1 -= Lv[3] * x27;
      }
      { const f32x4 Lv = *(const f32x4*)(L_s + 2068);
        a0 -= Lv[0] * x28;
        a1 -= Lv[1] * x29;
      }
      x30 = a0 + a1; }
    { float a0 = bf2f(colp[4216]) * mulp[31]; float a1 = 0.f;
      { const f32x4 Lv = *(const f32x4*)(L_s + 2108);
        a0 -= Lv[0] * x0;
        a1 -= Lv[1] * x1;
        a0 -= Lv[2] * x2;
        a1 -= Lv[3] * x3;
      }
      { const f32x4 Lv = *(const f32x4*)(L_s + 2112);
        a0 -= Lv[0] * x4;
        a1 -= Lv[1] * x5;
        a0 -= Lv[2] * x6;
        a1 -= Lv[3] * x7;
      }
      { const f32x4 Lv = *(const f32x4*)(L_s + 2116);
        a0 -= Lv[0] * x8;
        a1 -= Lv[1] * x9;
        a0 -= Lv[2] * x10;
        a1 -= Lv[3] * x11;
      }
      { const f32x4 Lv = *(const f32x4*)(L_s + 2120);
        a0 -= Lv[0] * x12;
        a1 -= Lv[1] * x13;
        a0 -= Lv[2] * x14;
        a1 -= Lv[3] * x15;
      }
      { const f32x4 Lv = *(const f32x4*)(L_s + 2124);
        a0 -= Lv[0] * x16;
        a1 -= Lv[1] * x17;
        a0 -= Lv[2] * x18;
        a1 -= Lv[3] * x19;
      }
      { const f32x4 Lv = *(const f32x4*)(L_s + 2128);
        a0 -= Lv[0] * x20;
        a1 -= Lv[1] * x21;
        a0 -= Lv[2] * x22;
        a1 -= Lv[3] * x23;
      }
      { const f32x4 Lv = *(const f32x4*)(L_s + 2132);
        a0 -= Lv[0] * x24;
        a1 -= Lv[1] * x25;
        a0 -= Lv[2] * x26;
        a1 -= Lv[3] * x27;
      }
      { const f32x4 Lv = *(const f32x4*)(L_s + 2136);
        a0 -= Lv[0] * x28;
        a1 -= Lv[1] * x29;
        a0 -= Lv[2] * x30;
      }
      x31 = a0 + a1; } __builtin_amdgcn_sched_barrier(0);
    { float a0 = bf2f(colp[4352]) * mulp[32]; float a1 = 0.f;
      { const f32x4 Lv = *(const f32x4*)(L_s + 2176);
        a0 -= Lv[0] * x0;
        a1 -= Lv[1] * x1;
        a0 -= Lv[2] * x2;
        a1 -= Lv[3] * x3;
      }
      { const f32x4 Lv = *(const f32x4*)(L_s + 2180);
        a0 -= Lv[0] * x4;
        a1 -= Lv[1] * x5;
        a0 -= Lv[2] * x6;
        a1 -= Lv[3] * x7;
      }
      { const f32x4 Lv = *(const f32x4*)(L_s + 2184);
        a0 -= Lv[0] * x8;
        a1 -= Lv[1] * x9;
        a0 -= Lv[2] * x10;
        a1 -= Lv[3] * x11;
      }
      { const f32x4 Lv = *(const f32x4*)(L_s + 2188);
        a0 -= Lv[0] * x12;
        a1 -= Lv[1] * x13;
        a0 -= Lv[2] * x14;
        a1 -= Lv[3] * x15;
      }
      { const f32x4 Lv = *(const f32x4*)(L_s + 2192);
        a0 -= Lv[0] * x16;
        a1 -= Lv[1] * x17;
        a0 -= Lv[2] * x18;
        a1 -= Lv[3] * x19;
      }
      { const f32x4 Lv = *(const f32x4*)(L_s + 2196);
        a0 -= Lv[0] * x20;
        a1 -= Lv[1] * x21;
        a0 -= Lv[2] * x22;
        a1 -= Lv[3] * x23;
      }
      { const f32x4 Lv = *(const f32x4*)(L_s + 2200);
        a0 -= Lv[0] * x24;
        a1 -= Lv[1] * x25;
        a0 -= Lv[2] * x26;
        a1 -= Lv[3] * x27;
      }
      { const f32x4 Lv = *(const f32x4*)(L_s + 2204);
        a0 -= Lv[0] * x28;
        a1 -= Lv[1] * x29;
        a0 -= Lv[2] * x30;
        a1 -= Lv[3] * x31;
      }
      x32 = a0 + a1; }
    { float a0 = bf2f(colp[4488]) * mulp[33]; float a1 = 0.f;
      { const f32x4 Lv = *(const f32x4*)(L_s + 2244);
        a0 -= Lv[0] * x0;
        a1 -= Lv[1] * x1;
        a0 -= Lv[2] * x2;
        a1 -= Lv[3] * x3;
      }
      { const f32x4 Lv = *(const f32x4*)(L_s + 2248);
        a0 -= Lv[0] * x4;
        a1 -= Lv[1] * x5;
        a0 -= Lv[2] * x6;
        a1 -= Lv[3] * x7;
      }
      { const f32x4 Lv = *(const f32x4*)(L_s + 2252);
        a0 -= Lv[0] * x8;
        a1 -= Lv[1] * x9;
        a0 -= Lv[2] * x10;
        a1 -= Lv[3] * x11;
      }
      { const f32x4 Lv = *(const f32x4*)(L_s + 2256);
        a0 -= Lv[0] * x12;
        a1 -= Lv[1] * x13;
        a0 -= Lv[2] * x14;
        a1 -= Lv[3] * x15;
      }
      { const f32x4 Lv = *(const f32x4*)(L_s + 2260);
        a0 -= Lv[0] * x16;
        a1 -= Lv[1] * x17;
        a0 -= Lv[2] * x18;
        a1 -= Lv[3] * x19;
      }
      { const f32x4 Lv = *(const f32x4*)(L_s + 2264);
        a0 -= Lv[0] * x20;
        a1 -= Lv[1] * x21;
        a0 -= Lv[2] * x22;
        a1 -= Lv[3] * x23;
      }
      { const f32x4 Lv = *(const f32x4*)(L_s + 2268);
        a0 -= Lv[0] * x24;
        a1 -= Lv[1] * x25;
        a0 -= Lv[2] * x26;
        a1 -= Lv[3] * x27;
      }
      { const f32x4 Lv = *(const f32x4*)(L_s + 2272);
        a0 -= Lv[0] * x28;
        a1 -= Lv[1] * x29;
        a0 -= Lv[2] * x30;
        a1 -= Lv[3] * x31;
      }
      { const f32x4 Lv = *(const f32x4*)(L_s + 2276);
        a0 -= Lv[0] * x32;
      }
      x33 = a0 + a1; } __builtin_amdgcn_sched_barrier(0);
    { float a0 = bf2f(colp[4624]) * mulp[34]; float a1 = 0.f;
      { const f32x4 Lv = *(const f32x4*)(L_s + 2312);
        a0 -= Lv[0] * x0;
        a1 -= Lv[1] * x1;
        a0 -= Lv[2] * x2;
        a1 -= Lv[3] * x3;
      }
      { const f32x4 Lv = *(const f32x4*)(L_s + 2316);
        a0 -= Lv[0] * x4;
        a1 -= Lv[1] * x5;
        a0 -= Lv[2] * x6;
        a1 -= Lv[3] * x7;
      }
      { const f32x4 Lv = *(const f32x4*)(L_s + 2320);
        a0 -= Lv[0] * x8;
        a1 -= Lv[1] * x9;
        a0 -= Lv[2] * x10;
        a1 -= Lv[3] * x11;
      }
      { const f32x4 Lv = *(const f32x4*)(L_s + 2324);
        a0 -= Lv[0] * x12;
        a1 -= Lv[1] * x13;
        a0 -= Lv[2] * x14;
        a1 -= Lv[3] * x15;
      }
      { const f32x4 Lv = *(const f32x4*)(L_s + 2328);
        a0 -= Lv[0] * x16;
        a1 -= Lv[1] * x17;
        a0 -= Lv[2] * x18;
        a1 -= Lv[3] * x19;
      }
      { const f32x4 Lv = *(const f32x4*)(L_s + 2332);
        a0 -= Lv[0] * x20;
        a1 -= Lv[1] * x21;
        a0 -= Lv[2] * x22;
        a1 -= Lv[3] * x23;
      }
      { const f32x4 Lv = *(const f32x4*)(L_s + 2336);
        a0 -= Lv[0] * x24;
        a1 -= Lv[1] * x25;
        a0 -= Lv[2] * x26;
        a1 -= Lv[3] * x27;
      }
      { const f32x4 Lv = *(const f32x4*)(L_s + 2340);
        a0 -= Lv[0] * x28;
        a1 -= Lv[1] * x29;
        a0 -= Lv[2] * x30;
        a1 -= Lv[3] * x31;
      }
      { const f32x4 Lv = *(const f32x4*)(L_s + 2344);
        a0 -= Lv[0] * x32;
        a1 -= Lv[1] * x33;
      }
      x34 = a0 + a1; }
    { float a0 = bf2f(colp[4760]) * mulp[35]; float a1 = 0.f;
      { const f32x4 Lv = *(const f32x4*)(L_s + 2380);
        a0 -= Lv[0] * x0;
        a1 -= Lv[1] * x1;
        a0 -= Lv[2] * x2;
        a1 -= Lv[3] * x3;
      }
      { const f32x4 Lv = *(const f32x4*)(L_s + 2384);
        a0 -= Lv[0] * x4;
        a1 -= Lv[1] * x5;
        a0 -= Lv[2] * x6;
        a1 -= Lv[3] * x7;
      }
      { const f32x4 Lv = *(const f32x4*)(L_s + 2388);
        a0 -= Lv[0] * x8;
        a1 -= Lv[1] * x9;
        a0 -= Lv[2] * x10;
        a1 -= Lv[3] * x11;
      }
      { const f32x4 Lv = *(const f32x4*)(L_s + 2392);
        a0 -= Lv[0] * x12;
        a1 -= Lv[1] * x13;
        a0 -= Lv[2] * x14;
        a1 -= Lv[3] * x15;
      }
      { const f32x4 Lv = *(const f32x4*)(L_s + 2396);
        a0 -= Lv[0] * x16;
        a1 -= Lv[1] * x17;
        a0 -= Lv[2] * x18;
        a1 -= Lv[3] * x19;
      }
      { const f32x4 Lv = *(const f32x4*)(L_s + 2400);
        a0 -= Lv[0] * x20;
        a1 -= Lv[1] * x21;
        a0 -= Lv[2] * x22;
        a1 -= Lv[3] * x23;
      }
      { const f32x4 Lv = *(const f32x4*)(L_s + 2404);
        a0 -= Lv[0] * x24;
        a1 -= Lv[1] * x25;
        a0 -= Lv[2] * x26;
        a1 -= Lv[3] * x27;
      }
      { const f32x4 Lv = *(const f32x4*)(L_s + 2408);
        a0 -= Lv[0] * x28;
        a1 -= Lv[1] * x29;
        a0 -= Lv[2] * x30;
        a1 -= Lv[3] * x31;
      }
      { const f32x4 Lv = *(const f32x4*)(L_s + 2412);
        a0 -= Lv[0] * x32;
        a1 -= Lv[1] * x33;
        a0 -= Lv[2] * x34;
      }
      x35 = a0 + a1; } __builtin_amdgcn_sched_barrier(0);
    { float a0 = bf2f(colp[4896]) * mulp[36]; float a1 = 0.f;
      { const f32x4 Lv = *(const f32x4*)(L_s + 2448);
        a0 -= Lv[0] * x0;
        a1 -= Lv[1] * x1;
        a0 -= Lv[2] * x2;
        a1 -= Lv[3] * x3;
      }
      { const f32x4 Lv = *(const f32x4*)(L_s + 2452);
        a0 -= Lv[0] * x4;
        a1 -= Lv[1] * x5;
        a0 -= Lv[2] * x6;
        a1 -= Lv[3] * x7;
      }
      { const f32x4 Lv = *(const f32x4*)(L_s + 2456);
        a0 -= Lv[0] * x8;
        a1 -= Lv[1] * x9;
        a0 -= Lv[2] * x10;
        a1 -= Lv[3] * x11;
      }
      { const f32x4 Lv = *(const f32x4*)(L_s + 2460);
        a0 -= Lv[0] * x12;
        a1 -= Lv[1] * x13;
        a0 -= Lv[2] * x14;
        a1 -= Lv[3] * x15;
      }
      { const f32x4 Lv = *(const f32x4*)(L_s + 2464);
        a0 -= Lv[0] * x16;
        a1 -= Lv[1] * x17;
        a0 -= Lv[2] * x18;
        a1 -= Lv[3] * x19;
      }
      { const f32x4 Lv = *(const f32x4*)(L_s + 2468);
        a0 -= Lv[0] * x20;
        a1 -= Lv[1] * x21;
        a0 -= Lv[2] * x22;
        a1 -= Lv[3] * x23;
      }
      { const f32x4 Lv = *(const f32x4*)(L_s + 2472);
        a0 -= Lv[0] * x24;
        a1 -= Lv[1] * x25;
        a0 -= Lv[2] * x26;
        a1 -= Lv[3] * x27;
      }
      { const f32x4 Lv = *(const f32x4*)(L_s + 2476);
        a0 -= Lv[0] * x28;
        a1 -= Lv[1] * x29;
        a0 -= Lv[2] * x30;
        a1 -= Lv[3] * x31;
      }
      { const f32x4 Lv = *(const f32x4*)(L_s + 2480);
        a0 -= Lv[0] * x32;
        a1 -= Lv[1] * x33;
        a0 -= Lv[2] * x34;
        a1 -= Lv[3] * x35;
      }
      x36 = a0 + a1; }
    { float a0 = bf2f(colp[5032]) * mulp[37]; float a1 = 0.f;
      { const f32x4 Lv = *(const f32x4*)(L_s + 2516);
        a0 -= Lv[0] * x0;
        a1 -= Lv[1] * x1;
        a0 -= Lv[2] * x2;
        a1 -= Lv[3] * x3;
      }
      { const f32x4 Lv = *(const f32x4*)(L_s + 2520);
        a0 -= Lv[0] * x4;
        a1 -= Lv[1] * x5;
        a0 -= Lv[2] * x6;
        a1 -= Lv[3] * x7;
      }
      { const f32x4 Lv = *(const f32x4*)(L_s + 2524);
        a0 -= Lv[0] * x8;
        a1 -= Lv[1] * x9;
        a0 -= Lv[2] * x10;
        a1 -= Lv[3] * x11;
      }
      { const f32x4 Lv = *(const f32x4*)(L_s + 2528);
        a0 -= Lv[0] * x12;
        a1 -= Lv[1] * x13;
        a0 -= Lv[2] * x14;
        a1 -= Lv[3] * x15;
      }
      { const f32x4 Lv = *(const f32x4*)(L_s + 2532);
        a0 -= Lv[0] * x16;
        a1 -= Lv[1] * x17;
        a0 -= Lv[2] * x18;
        a1 -= Lv[3] * x19;
      }
      { const f32x4 Lv = *(const f32x4*)(L_s + 2536);
        a0 -= Lv[0] * x20;
        a1 -= Lv[1] * x21;
        a0 -= Lv[2] * x22;
        a1 -= Lv[3] * x23;
      }
      { const f32x4 Lv = *(const f32x4*)(L_s + 2540);
        a0 -= Lv[0] * x24;
        a1 -= Lv[1] * x25;
        a0 -= Lv[2] * x26;
        a1 -= Lv[3] * x27;
      }
      { const f32x4 Lv = *(const f32x4*)(L_s + 2544);
        a0 -= Lv[0] * x28;
        a1 -= Lv[1] * x29;
        a0 -= Lv[2] * x30;
        a1 -= Lv[3] * x31;
      }
      { const f32x4 Lv = *(const f32x4*)(L_s + 2548);
        a0 -= Lv[0] * x32;
        a1 -= Lv[1] * x33;
        a0 -= Lv[2] * x34;
        a1 -= Lv[3] * x35;
      }
      { const f32x4 Lv = *(const f32x4*)(L_s + 2552);
        a0 -= Lv[0] * x36;
      }
      x37 = a0 + a1; } __builtin_amdgcn_sched_barrier(0);
    { float a0 = bf2f(colp[5168]) * mulp[38]; float a1 = 0.f;
      { const f32x4 Lv = *(const f32x4*)(L_s + 2584);
        a0 -= Lv[0] * x0;
        a1 -= Lv[1] * x1;
        a0 -= Lv[2] * x2;
        a1 -= Lv[3] * x3;
      }
      { const f32x4 Lv = *(const f32x4*)(L_s + 2588);
        a0 -= Lv[0] * x4;
        a1 -= Lv[1] * x5;
        a0 -= Lv[2] * x6;
        a1 -= Lv[3] * x7;
      }
      { const f32x4 Lv = *(const f32x4*)(L_s + 2592);
        a0 -= Lv[0] * x8;
        a1 -= Lv[1] * x9;
        a0 -= Lv[2] * x10;
        a1 -= Lv[3] * x11;
      }
      { const f32x4 Lv = *(const f32x4*)(L_s + 2596);
        a0 -= Lv[0] * x12;
        a1 -= Lv[1] * x13;
        a0 -= Lv[2] * x14;
        a1 -= Lv[3] * x15;
      }
      { const f32x4 Lv = *(const f32x4*)(L_s + 2600);
        a0 -= Lv[0] * x16;
        a1 -= Lv[1] * x17;
        a0 -= Lv[2] * x18;
        a1 -= Lv[3] * x19;
      }
      { const f32x4 Lv = *(const f32x4*)(L_s + 2604);
        a0 -= Lv[0] * x20;
        a1 -= Lv[1] * x21;
        a0 -= Lv[2] * x22;
        a1 -= Lv[3] * x23;
      }
      { const f32x4 Lv = *(const f32x4*)(L_s + 2608);
        a0 -= Lv[0] * x24;
        a1 -= Lv[1] * x25;
        a0 -= Lv[2] * x26;
        a1 -= Lv[3] * x27;
      }
      { const f32x4 Lv = *(const f32x4*)(L_s + 2612);
        a0 -= Lv[0] * x28;
        a1 -= Lv[1] * x29;
        a0 -= Lv[2] * x30;
        a1 -= Lv[3] * x31;
      }
      { const f32x4 Lv = *(const f32x4*)(L_s + 2616);
        a0 -= Lv[0] * x32;
        a1 -= Lv[1] * x33;
        a0 -= Lv[2] * x34;
        a1 -= Lv[3] * x35;
      }
      { const f32x4 Lv = *(const f32x4*)(L_s + 2620);
        a0 -= Lv[0] * x36;
        a1 -= Lv[1] * x37;
      }
      x38 = a0 + a1; }
    { float a0 = bf2f(colp[5304]) * mulp[39]; float a1 = 0.f;
      { const f32x4 Lv = *(const f32x4*)(L_s + 2652);
        a0 -= Lv[0] * x0;
        a1 -= Lv[1] * x1;
        a0 -= Lv[2] * x2;
        a1 -= Lv[3] * x3;
      }
      { const f32x4 Lv = *(const f32x4*)(L_s + 2656);
        a0 -= Lv[0] * x4;
        a1 -= Lv[1] * x5;
        a0 -= Lv[2] * x6;
        a1 -= Lv[3] * x7;
      }
      { const f32x4 Lv = *(const f32x4*)(L_s + 2660);
        a0 -= Lv[0] * x8;
        a1 -= Lv[1] * x9;
        a0 -= Lv[2] * x10;
        a1 -= Lv[3] * x11;
      }
      { const f32x4 Lv = *(const f32x4*)(L_s + 2664);
        a0 -= Lv[0] * x12;
        a1 -= Lv[1] * x13;
        a0 -= Lv[2] * x14;
        a1 -= Lv[3] * x15;
      }
      { const f32x4 Lv = *(const f32x4*)(L_s + 2668);
        a0 -= Lv[0] * x16;
        a1 -= Lv[1] * x17;
        a0 -= Lv[2] * x18;
        a1 -= Lv[3] * x19;
      }
      { const f32x4 Lv = *(const f32x4*)(L_s + 2672);
        a0 -= Lv[0] * x20;
        a1 -= Lv[1] * x21;
        a0 -= Lv[2] * x22;
        a1 -= Lv[3] * x23;
      }
      { const f32x4 Lv = *(const f32x4*)(L_s + 2676);
        a0 -= Lv[0] * x24;
        a1 -= Lv[1] * x25;
        a0 -= Lv[2] * x26;
        a1 -= Lv[3] * x27;
      }
      { const f32x4 Lv = *(const f32x4*)(L_s + 2680);
        a0 -= Lv[0] * x28;
        a1 -= Lv[1] * x29;
        a0 -= Lv[2] * x30;
        a1 -= Lv[3] * x31;
      }
      { const f32x4 Lv = *(const f32x4*)(L_s + 2684);
        a0 -= Lv[0] * x32;
        a1 -= Lv[1] * x33;
        a0 -= Lv[2] * x34;
        a1 -= Lv[3] * x35;
      }
      { const f32x4 Lv = *(const f32x4*)(L_s + 2688);
        a0 -= Lv[0] * x36;
        a1 -= Lv[1] * x37;
        a0 -= Lv[2] * x38;
      }
      x39 = a0 + a1; } __builtin_amdgcn_sched_barrier(0);
    { float a0 = bf2f(colp[5440]) * mulp[40]; float a1 = 0.f;
      { const f32x4 Lv = *(const f32x4*)(L_s + 2720);
        a0 -= Lv[0] * x0;
        a1 -= Lv[1] * x1;
        a0 -= Lv[2] * x2;
        a1 -= Lv[3] * x3;
      }
      { const f32x4 Lv = *(const f32x4*)(L_s + 2724);
        a0 -= Lv[0] * x4;
        a1 -= Lv[1] * x5;
        a0 -= Lv[2] * x6;
        a1 -= Lv[3] * x7;
      }
      { const f32x4 Lv = *(const f32x4*)(L_s + 2728);
        a0 -= Lv[0] * x8;
        a1 -= Lv[1] * x9;
        a0 -= Lv[2] * x10;
        a1 -= Lv[3] * x11;
      }
      { const f32x4 Lv = *(const f32x4*)(L_s + 2732);
        a0 -= Lv[0] * x12;
        a1 -= Lv[1] * x13;
        a0 -= Lv[2] * x14;
        a1 -= Lv[3] * x15;
      }
      { const f32x4 Lv = *(const f32x4*)(L_s + 2736);
        a0 -= Lv[0] * x16;
        a1 -= Lv[1] * x17;
        a0 -= Lv[2] * x18;
        a1 -= Lv[3] * x19;
      }
      { const f32x4 Lv = *(const f32x4*)(L_s + 2740);
        a0 -= Lv[0] * x20;
        a1 -= Lv[1] * x21;
        a0 -= Lv[2] * x22;
        a1 -= Lv[3] * x23;
      }
      { const f32x4 Lv = *(const f32x4*)(L_s + 2744);
        a0 -= Lv[0] * x24;
        a1 -= Lv[1] * x25;
        a0 -= Lv[2] * x26;
        a1 -= Lv[3] * x27;
      }
      { const f32x4 Lv = *(const f32x4*)(L_s + 2748);
        a0 -= Lv[0] * x28;
        a1 -= Lv[1] * x29;
        a0 -= Lv[2] * x30;
        a1 -= Lv[3] * x31;
      }
      { const f32x4 Lv = *(const f32x4*)(L_s + 2752);
        a0 -= Lv[0] * x32;
        a1 -= Lv[1] * x33;
        a0 -= Lv[2] * x34;
        a1 -= Lv[3] * x35;
      }
      { const f32x4 Lv = *(const f32x4*)(L_s + 2756);
        a0 -= Lv[0] * x36;
        a1 -= Lv[1] * x37;
        a0 -= Lv[2] * x38;
        a1 -= Lv[3] * x39;
      }
      x40 = a0 + a1; }
    { float a0 = bf2f(colp[5576]) * mulp[41]; float a1 = 0.f;
      { const f32x4 Lv = *(const f32x4*)(L_s + 2788);
        a0 -= Lv[0] * x0;
        a1 -= Lv[1] * x1;
        a0 -= Lv[2] * x2;
        a1 -= Lv[3] * x3;
      }
      { const f32x4 Lv = *(const f32x4*)(L_s + 2792);
        a0 -= Lv[0] * x4;
        a1 -= Lv[1] * x5;
        a0 -= Lv[2] * x6;
        a1 -= Lv[3] * x7;
      }
      { const f32x4 Lv = *(const f32x4*)(L_s + 2796);
        a0 -= Lv[0] * x8;
        a1 -= Lv[1] * x9;
        a0 -= Lv[2] * x10;
        a1 -= Lv[3] * x11;
      }
      { const f32x4 Lv = *(const f32x4*)(L_s + 2800);
        a0 -= Lv[0] * x12;
        a1 -= Lv[1] * x13;
        a0 -= Lv[2] * x14;
        a1 -= Lv[3] * x15;
      }
      { const f32x4 Lv = *(const f32x4*)(L_s + 2804);
        a0 -= Lv[0] * x16;
        a1 -= Lv[1] * x17;
        a0 -= Lv[2] * x18;
        a1 -= Lv[3] * x19;
      }
      { const f32x4 Lv = *(const f32x4*)(L_s + 2808);
        a0 -= Lv[0] * x20;
        a1 -= Lv[1] * x21;
        a0 -= Lv[2] * x22;
        a1 -= Lv[3] * x23;
      }
      { const f32x4 Lv = *(const f32x4*)(L_s + 2812);
        a0 -= Lv[0] * x24;
        a1 -= Lv[1] * x25;
        a0 -= Lv[2] * x26;
        a1 -= Lv[3] * x27;
      }
      { const f32x4 Lv = *(const f32x4*)(L_s + 2816);
        a0 -= Lv[0] * x28;
        a1 -= Lv[1] * x29;
        a0 -= Lv[2] * x30;
        a1 -= Lv[3] * x31;
      }
      { const f32x4 Lv = *(const f32x4*)(L_s + 2820);
        a0 -= Lv[0] * x32;
        a1 -= Lv[1] * x33;
        a0 -= Lv[2] * x34;
        a1 -= Lv[3] * x35;
      }
      { const f32x4 Lv = *(const f32x4*)(L_s + 2824);
        a0 -= Lv[0] * x36;
        a1 -= Lv[1] * x37;
        a0 -= Lv[2] * x38;
        a1 -= Lv[3] * x39;
      }
      { const f32x4 Lv = *(const f32x4*)(L_s + 2828);
        a0 -= Lv[0] * x40;
      }
      x41 = a0 + a1; } __builtin_amdgcn_sched_barrier(0);
    { float a0 = bf2f(colp[5712]) * mulp[42]; float a1 = 0.f;
      { const f32x4 Lv = *(const f32x4*)(L_s + 2856);
        a0 -= Lv[0] * x0;
        a1 -= Lv[1] * x1;
        a0 -= Lv[2] * x2;
        a1 -= Lv[3] * x3;
      }
      { const f32x4 Lv = *(const f32x4*)(L_s + 2860);
        a0 -= Lv[0] * x4;
        a1 -= Lv[1] * x5;
        a0 -= Lv[2] * x6;
        a1 -= Lv[3] * x7;
      }
      { const f32x4 Lv = *(const f32x4*)(L_s + 2864);
        a0 -= Lv[0] * x8;
        a1 -= Lv[1] * x9;
        a0 -= Lv[2] * x10;
        a1 -= Lv[3] * x11;
      }
      { const f32x4 Lv = *(const f32x4*)(L_s + 2868);
        a0 -= Lv[0] * x12;
        a1 -= Lv[1] * x13;
        a0 -= Lv[2] * x14;
        a1 -= Lv[3] * x15;
      }
      { const f32x4 Lv = *(const f32x4*)(L_s + 2872);
        a0 -= Lv[0] * x16;
        a1 -= Lv[1] * x17;
        a0 -= Lv[2] * x18;
        a1 -= Lv[3] * x19;
      }
      { const f32x4 Lv = *(const f32x4*)(L_s + 2876);
        a0 -= Lv[0] * x20;
        a1 -= Lv[1] * x21;
        a0 -= Lv[2] * x22;
        a1 -= Lv[3] * x23;
      }
      { const f32x4 Lv = *(const f32x4*)(L_s + 2880);
        a0 -= Lv[0] * x24;
        a1 -= Lv[1] * x25;
        a0 -= Lv[2] * x26;
        a1 -= Lv[3] * x27;
      }
      { const f32x4 Lv = *(const f32x4*)(L_s + 2884);
        a0 -= Lv[0] * x28;
        a1 -= Lv[1] * x29;
        a0 -= Lv[2] * x30;
        a1 -= Lv[3] * x31;
      }
      { const f32x4 Lv = *(const f32x4*)(L_s + 2888);
        a0 -= Lv[0] * x32;
        a1 -= Lv[1] * x33;
        a0 -= Lv[2] * x34;
        a1 -= Lv[3] * x35;
      }
      { const f32x4 Lv = *(const f32x4*)(L_s + 2892);
        a0 -= Lv[0] * x36;
        a1 -= Lv[1] * x37;
        a0 -= Lv[2] * x38;
        a1 -= Lv[3] * x39;
      }
      { const f32x4 Lv = *(const f32x4*)(L_s + 2896);
        a0 -= Lv[0] * x40;
        a1 -= Lv[1] * x41;
      }
      x42 = a0 + a1; }
    { float a0 = bf2f(colp[5848]) * mulp[43]; float a1 = 0.f;
      { const f32x4 Lv = *(const f32x4*)(L_s + 2924);
        a0 -= Lv[0] * x0;
        a1 -= Lv[1] * x1;
        a0 -= Lv[2] * x2;
        a1 -= Lv[3] * x3;
      }
      { const f32x4 Lv = *(const f32x4*)(L_s + 2928);
        a0 -= Lv[0] * x4;
        a1 -= Lv[1] * x5;
        a0 -= Lv[2] * x6;
        a1 -= Lv[3] * x7;
      }
      { const f32x4 Lv = *(const f32x4*)(L_s + 2932);
        a0 -= Lv[0] * x8;
        a1 -= Lv[1] * x9;
        a0 -= Lv[2] * x10;
        a1 -= Lv[3] * x11;
      }
      { const f32x4 Lv = *(const f32x4*)(L_s + 2936);
        a0 -= Lv[0] * x12;
        a1 -= Lv[1] * x13;
        a0 -= Lv[2] * x14;
        a1 -= Lv[3] * x15;
      }
      { const f32x4 Lv = *(const f32x4*)(L_s + 2940);
        a0 -= Lv[0] * x16;
        a1 -= Lv[1] * x17;
        a0 -= Lv[2] * x18;
        a1 -= Lv[3] * x19;
      }
      { const f32x4 Lv = *(const f32x4*)(L_s + 2944);
        a0 -= Lv[0] * x20;
        a1 -= Lv[1] * x21;
        a0 -= Lv[2] * x22;
        a1 -= Lv[3] * x23;
      }
      { const f32x4 Lv = *(const f32x4*)(L_s + 2948);
        a0 -= Lv[0] * x24;
        a1 -= Lv[1] * x25;
        a0 -= Lv[2] * x26;
        a1 -= Lv[3] * x27;
      }
      { const f32x4 Lv = *(const f32x4*)(L_s + 2952);
        a0 -= Lv[0] * x28;
        a1 -= Lv[1] * x29;
        a0 -= Lv[2] * x30;
        a1 -= Lv[3] * x31;
      }
      { const f32x4 Lv = *(const f32x4*)(L_s + 2956);
        a0 -= Lv[0] * x32;
        a1 -= Lv[1] * x33;
        a0 -= Lv[2] * x34;
        a1 -= Lv[3] * x35;
      }
      { const f32x4 Lv = *(const f32x4*)(L_s + 2960);
        a0 -= Lv[0] * x36;
        a1 -= Lv[1] * x37;
        a0 -= Lv[2] * x38;
        a1 -= Lv[3] * x39;
      }
      { const f32x4 Lv = *(const f32x4*)(L_s + 2964);
        a0 -= Lv[0] * x40;
        a1 -= Lv[1] * x41;
        a0 -= Lv[2] * x42;
      }
      x43 = a0 + a1; } __builtin_amdgcn_sched_barrier(0);
    { float a0 = bf2f(colp[5984]) * mulp[44]; float a1 = 0.f;
      { const f32x4 Lv = *(const f32x4*)(L_s + 2992);
        a0 -= Lv[0] * x0;
        a1 -= Lv[1] * x1;
        a0 -= Lv[2] * x2;
        a1 -= Lv[3] * x3;
      }
      { const f32x4 Lv = *(const f32x4*)(L_s + 2996);
        a0 -= Lv[0] * x4;
        a1 -= Lv[1] * x5;
        a0 -= Lv[2] * x6;
        a1 -= Lv[3] * x7;
      }
      { const f32x4 Lv = *(const f32x4*)(L_s + 3000);
        a0 -= Lv[0] * x8;
        a1 -= Lv[1] * x9;
        a0 -= Lv[2] * x10;
        a1 -= Lv[3] * x11;
      }
      { const f32x4 Lv = *(const f32x4*)(L_s + 3004);
        a0 -= Lv[0] * x12;
        a1 -= Lv[1] * x13;
        a0 -= Lv[2] * x14;
        a1 -= Lv[3] * x15;
      }
      { const f32x4 Lv = *(const f32x4*)(L_s + 3008);
        a0 -= Lv[0] * x16;
        a1 -= Lv[1] * x17;
        a0 -= Lv[2] * x18;
        a1 -= Lv[3] * x19;
      }
      { const f32x4 Lv = *(const f32x4*)(L_s + 3012);
        a0 -= Lv[0] * x20;
        a1 -= Lv[1] * x21;
        a0 -= Lv[2] * x22;
        a1 -= Lv[3] * x23;
      }
      { const f32x4 Lv = *(const f32x4*)(L_s + 3016);
        a0 -= Lv[0] * x24;
        a1 -= Lv[1] * x25;
        a0 -= Lv[2] * x26;
        a1 -= Lv[3] * x27;
      }
      { const f32x4 Lv = *(const f32x4*)(L_s + 3020);
        a0 -= Lv[0] * x28;
        a1 -= Lv[1] * x29;
        a0 -= Lv[2] * x30;
        a1 -= Lv[3] * x31;
      }
      { const f32x4 Lv = *(const f32x4*)(L_s + 3024);
        a0 -= Lv[0] * x32;
        a1 -= Lv[1] * x33;
        a0 -= Lv[2] * x34;
        a1 -= Lv[3] * x35;
      }
      { const f32x4 Lv = *(const f32x4*)(L_s + 3028);
        a0 -= Lv[0] * x36;
        a1 -= Lv[1] * x37;
        a0 -= Lv[2] * x38;
        a1 -= Lv[3] * x39;
      }
      { const f32x4 Lv = *(const f32x4*)(L_s + 3032);
        a0 -= Lv[0] * x40;
        a1 -= Lv[1] * x41;
        a0 -= Lv[2] * x42;
        a1 -= Lv[3] * x43;
      }
      x44 = a0 + a1; }
    { float a0 = bf2f(colp[6120]) * mulp[45]; float a1 = 0.f;
      { const f32x4 Lv = *(const f32x4*)(L_s + 3060);
        a0 -= Lv[0] * x0;
        a1 -= Lv[1] * x1;
        a0 -= Lv[2] * x2;
        a1 -= Lv[3] * x3;
      }
      { const f32x4 Lv = *(const f32x4*)(L_s + 3064);
        a0 -= Lv[0] * x4;
        a1 -= Lv[1] * x5;
        a0 -= Lv[2] * x6;
        a1 -= Lv[3] * x7;
      }
      { const f32x4 Lv = *(const f32x4*)(L_s + 3068);
        a0 -= Lv[0] * x8;
        a1 -= Lv[1] * x9;
        a0 -= Lv[2] * x10;
        a1 -= Lv[3] * x11;
      }
      { const f32x4 Lv = *(const f32x4*)(L_s + 3072);
        a0 -= Lv[0] * x12;
        a1 -= Lv[1] * x13;
        a0 -= Lv[2] * x14;
        a1 -= Lv[3] * x15;
      }
      { const f32x4 Lv = *(const f32x4*)(L_s + 3076);
        a0 -= Lv[0] * x16;
        a1 -= Lv[1] * x17;
        a0 -= Lv[2] * x18;
        a1 -= Lv[3] * x19;
      }
      { const f32x4 Lv = *(const f32x4*)(L_s + 3080);
        a0 -= Lv[0] * x20;
        a1 -= Lv[1] * x21;
        a0 -= Lv[2] * x22;
        a1 -= Lv[3] * x23;
      }
      { const f32x4 Lv = *(const f32x4*)(L_s + 3084);
        a0 -= Lv[0] * x24;
        a1 -= Lv[1] * x25;
        a0 -= Lv[2] * x26;
        a1 -= Lv[3] * x27;
      }
      { const f32x4 Lv = *(const f32x4*)(L_s + 3088);
        a0 -= Lv[0] * x28;
        a1 -= Lv[1] * x29;
        a0 -= Lv[2] * x30;
        a1 -= Lv[3] * x31;
      }
      { const f32x4 Lv = *(const f32x4*)(L_s + 3092);
        a0 -= Lv[0] * x32;
        a1 -= Lv[1] * x33;
        a0 -= Lv[2] * x34;
        a1 -= Lv[3] * x35;
      }
      { const f32x4 Lv = *(const f32x4*)(L_s + 3096);
        a0 -= Lv[0] * x36;
        a1 -= Lv[1] * x37;
        a0 -= Lv[2] * x38;
        a1 -= Lv[3] * x39;
      }
      { const f32x4 Lv = *(const f32x4*)(L_s + 3100);
        a0 -= Lv[0] * x40;
        a1 -= Lv[1] * x41;
        a0 -= Lv[2] * x42;
        a1 -= Lv[3] * x43;
      }
      { const f32x4 Lv = *(const f32x4*)(L_s + 3104);
        a0 -= Lv[0] * x44;
      }
      x45 = a0 + a1; } __builtin_amdgcn_sched_barrier(0);
    { float a0 = bf2f(colp[6256]) * mulp[46]; float a1 = 0.f;
      { const f32x4 Lv = *(const f32x4*)(L_s + 3128);
        a0 -= Lv[0] * x0;
        a1 -= Lv[1] * x1;
        a0 -= Lv[2] * x2;
        a1 -= Lv[3] * x3;
      }
      { const f32x4 Lv = *(const f32x4*)(L_s + 3132);
        a0 -= Lv[0] * x4;
        a1 -= Lv[1] * x5;
        a0 -= Lv[2] * x6;
        a1 -= Lv[3] * x7;
      }
      { const f32x4 Lv = *(const f32x4*)(L_s + 3136);
        a0 -= Lv[0] * x8;
        a1 -= Lv[1] * x9;
        a0 -= Lv[2] * x10;
        a1 -= Lv[3] * x11;
      }
      { const f32x4 Lv = *(const f32x4*)(L_s + 3140);
        a0 -= Lv[0] * x12;
        a1 -= Lv[1] * x13;
        a0 -= Lv[2] * x14;
        a1 -= Lv[3] * x15;
      }
      { const f32x4 Lv = *(const f32x4*)(L_s + 3144);
        a0 -= Lv[0] * x16;
        a1 -= Lv[1] * x17;
        a0 -= Lv[2] * x18;
        a1 -= Lv[3] * x19;
      }
      { const f32x4 Lv = *(const f32x4*)(L_s + 3148);
        a0 -= Lv[0] * x20;
        a1 -= Lv[1] * x21;
        a0 -= Lv[2] * x22;
        a1 -= Lv[3] * x23;
      }
      { const f32x4 Lv = *(const f32x4*)(L_s + 3152);
        a0 -= Lv[0] * x24;
        a1 -= Lv[1] * x25;
        a0 -= Lv[2] * x26;
        a1 -= Lv[3] * x27;
      }
      { const f32x4 Lv = *(const f32x4*)(L_s + 3156);
        a0 -= Lv[0] * x28;
        a1 -= Lv[1] * x29;
        a0 -= Lv[2] * x30;
        a1 -= Lv[3] * x31;
      }
      { const f32x4 Lv = *(const f32x4*)(L_s + 3160);
        a0 -= Lv[0] * x32;
        a1 -= Lv[1] * x33;
        a0 -= Lv[2] * x34;
        a1 -= Lv[3] * x35;
      }
      { const f32x4 Lv = *(const f32x4*)(L_s + 3164);
        a0 -= Lv[0] * x36;
        a1 -= Lv[1] * x37;
        a0 -= Lv[2] * x38;
        a1 -= Lv[3] * x39;
      }
      { const f32x4 Lv = *(const f32x4*)(L_s + 3168);
        a0 -= Lv[0] * x40;
        a1 -= Lv[1] * x41;
        a0 -= Lv[2] * x42;
        a1 -= Lv[3] * x43;
      }
      { const f32x4 Lv = *(const f32x4*)(L_s + 3172);
        a0 -= Lv[0] * x44;
        a1 -= Lv[1] * x45;
      }
      x46 = a0 + a1; }
    { float a0 = bf2f(colp[6392]) * mulp[47]; float a1 = 0.f;
      { const f32x4 Lv = *(const f32x4*)(L_s + 3196);
        a0 -= Lv[0] * x0;
        a1 -= Lv[1] * x1;
        a0 -= Lv[2] * x2;
        a1 -= Lv[3] * x3;
      }
      { const f32x4 Lv = *(const f32x4*)(L_s + 3200);
        a0 -= Lv[0] * x4;
        a1 -= Lv[1] * x5;
        a0 -= Lv[2] * x6;
        a1 -= Lv[3] * x7;
      }
      { const f32x4 Lv = *(const f32x4*)(L_s + 3204);
        a0 -= Lv[0] * x8;
        a1 -= Lv[1] * x9;
        a0 -= Lv[2] * x10;
        a1 -= Lv[3] * x11;
      }
      { const f32x4 Lv = *(const f32x4*)(L_s + 3208);
        a0 -= Lv[0] * x12;
        a1 -= Lv[1] * x13;
        a0 -= Lv[2] * x14;
        a1 -= Lv[3] * x15;
      }
      { const f32x4 Lv = *(const f32x4*)(L_s + 3212);
        a0 -= Lv[0] * x16;
        a1 -= Lv[1] * x17;
        a0 -= Lv[2] * x18;
        a1 -= Lv[3] * x19;
      }
      { const f32x4 Lv = *(const f32x4*)(L_s + 3216);
        a0 -= Lv[0] * x20;
        a1 -= Lv[1] * x21;
        a0 -= Lv[2] * x22;
        a1 -= Lv[3] * x23;
      }
      { const f32x4 Lv = *(const f32x4*)(L_s + 3220);
        a0 -= Lv[0] * x24;
        a1 -= Lv[1] * x25;
        a0 -= Lv[2] * x26;
        a1 -= Lv[3] * x27;
      }
      { const f32x4 Lv = *(const f32x4*)(L_s + 3224);
        a0 -= Lv[0] * x28;
        a1 -= Lv[1] * x29;
        a0 -= Lv[2] * x30;
        a1 -= Lv[3] * x31;
      }
      { const f32x4 Lv = *(const f32x4*)(L_s + 3228);
        a0 -= Lv[0] * x32;
        a1 -= Lv[1] * x33;
        a0 -= Lv[2] * x34;
        a1 -= Lv[3] * x35;
      }
      { const f32x4 Lv = *(const f32x4*)(L_s + 3232);
        a0 -= Lv[0] * x36;
        a1 -= Lv[1] * x37;
        a0 -= Lv[2] * x38;
        a1 -= Lv[3] * x39;
      }
      { const f32x4 Lv = *(const f32x4*)(L_s + 3236);
        a0 -= Lv[0] * x40;
        a1 -= Lv[1] * x41;
        a0 -= Lv[2] * x42;
        a1 -= Lv[3] * x43;
      }
      { const f32x4 Lv = *(const f32x4*)(L_s + 3240);
        a0 -= Lv[0] * x44;
        a1 -= Lv[1] * x45;
        a0 -= Lv[2] * x46;
      }
      x47 = a0 + a1; } __builtin_amdgcn_sched_barrier(0);
    { float a0 = bf2f(colp[6528]) * mulp[48]; float a1 = 0.f;
      { const f32x4 Lv = *(const f32x4*)(L_s + 3264);
        a0 -= Lv[0] * x0;
        a1 -= Lv[1] * x1;
        a0 -= Lv[2] * x2;
        a1 -= Lv[3] * x3;
      }
      { const f32x4 Lv = *(const f32x4*)(L_s + 3268);
        a0 -= Lv[0] * x4;
        a1 -= Lv[1] * x5;
        a0 -= Lv[2] * x6;
        a1 -= Lv[3] * x7;
      }
      { const f32x4 Lv = *(const f32x4*)(L_s + 3272);
        a0 -= Lv[0] * x8;
        a1 -= Lv[1] * x9;
        a0 -= Lv[2] * x10;
        a1 -= Lv[3] * x11;
      }
      { const f32x4 Lv = *(const f32x4*)(L_s + 3276);
        a0 -= Lv[0] * x12;
        a1 -= Lv[1] * x13;
        a0 -= Lv[2] * x14;
        a1 -= Lv[3] * x15;
      }
      { const f32x4 Lv = *(const f32x4*)(L_s + 3280);
        a0 -= Lv[0] * x16;
        a1 -= Lv[1] * x17;
        a0 -= Lv[2] * x18;
        a1 -= Lv[3] * x19;
      }
      { const f32x4 Lv = *(const f32x4*)(L_s + 3284);
        a0 -= Lv[0] * x20;
        a1 -= Lv[1] * x21;
        a0 -= Lv[2] * x22;
        a1 -= Lv[3] * x23;
      }
      { const f32x4 Lv = *(const f32x4*)(L_s + 3288);
        a0 -= Lv[0] * x24;
        a1 -= Lv[1] * x25;
        a0 -= Lv[2] * x26;
        a1 -= Lv[3] * x27;
      }
      { const f32x4 Lv = *(const f32x4*)(L_s + 3292);
        a0 -= Lv[0] * x28;
        a1 -= Lv[1] * x29;
        a0 -= Lv[2] * x30;
        a1 -= Lv[3] * x31;
      }
      { const f32x4 Lv = *(const f32x4*)(L_s + 3296);
        a0 -= Lv[0] * x32;
        a1 -= Lv[1] * x33;
        a0 -= Lv[2] * x34;
        a1 -= Lv[3] * x35;
      }
      { const f32x4 Lv = *(const f32x4*)(L_s + 3300);
        a0 -= Lv[0] * x36;
        a1 -= Lv[1] * x37;
        a0 -= Lv[2] * x38;
        a1 -= Lv[3] * x39;
      }
      { const f32x4 Lv = *(const f32x4*)(L_s + 3304);
        a0 -= Lv[0] * x40;
        a1 -= Lv[1] * x41;
        a0 -= Lv[2] * x42;
        a1 -= Lv[3] * x43;
      }
      { const f32x4 Lv = *(const f32x4*)(L_s + 3308);
        a0 -= Lv[0] * x44;
        a1 -= Lv[1] * x45;
        a0 -= Lv[2] * x46;
        a1 -= Lv[3] * x47;
      }
      x48 = a0 + a1; }
    { float a0 = bf2f(colp[6664]) * mulp[49]; float a1 = 0.f;
      { const f32x4 Lv = *(const f32x4*)(L_s + 3332);
        a0 -= Lv[0] * x0;
        a1 -= Lv[1] * x1;
        a0 -= Lv[2] * x2;
        a1 -= Lv[3] * x3;
      }
      { const f32x4 Lv = *(const f32x4*)(L_s + 3336);
        a0 -= Lv[0] * x4;
        a1 -= Lv[1] * x5;
        a0 -= Lv[2] * x6;
        a1 -= Lv[3] * x7;
      }
      { const f32x4 Lv = *(const f32x4*)(L_s + 3340);
        a0 -= Lv[0] * x8;
        a1 -= Lv[1] * x9;
        a0 -= Lv[2] * x10;
        a1 -= Lv[3] * x11;
      }
      { const f32x4 Lv = *(const f32x4*)(L_s + 3344);
        a0 -= Lv[0] * x12;
        a1 -= Lv[1] * x13;
        a0 -= Lv[2] * x14;
        a1 -= Lv[3] * x15;
      }
      { const f32x4 Lv = *(const f32x4*)(L_s + 3348);
        a0 -= Lv[0] * x16;
        a1 -= Lv[1] * x17;
        a0 -= Lv[2] * x18;
        a1 -= Lv[3] * x19;
      }
      { const f32x4 Lv = *(const f32x4*)(L_s + 3352);
        a0 -= Lv[0] * x20;
        a1 -= Lv[1] * x21;
        a0 -= Lv[2] * x22;
        a1 -= Lv[3] * x23;
      }
      { const f32x4 Lv = *(const f32x4*)(L_s + 3356);
        a0 -= Lv[0] * x24;
        a1 -= Lv[1] * x25;
        a0 -= Lv[2] * x26;
        a1 -= Lv[3] * x27;
      }
      { const f32x4 Lv = *(const f32x4*)(L_s + 3360);
        a0 -= Lv[0] * x28;
        a1 -= Lv[1] * x29;
        a0 -= Lv[2] * x30;
        a1 -= Lv[3] * x31;
      }
      { const f32x4 Lv = *(const f32x4*)(L_s + 3364);
        a0 -= Lv[0] * x32;
        a1 -= Lv[1] * x33;
        a0 -= Lv[2] * x34;
        a1 -= Lv[3] * x35;
      }
      { const f32x4 Lv = *(const f32x4*)(L_s + 3368);
        a0 -= Lv[0] * x36;
        a1 -= Lv[1] * x37;
        a0 -= Lv[2] * x38;
        a1 -= Lv[3] * x39;
      }
      { const f32x4 Lv = *(const f32x4*)(L_s + 3372);
        a0 -= Lv[0] * x40;
        a1 -= Lv[1] * x41;
        a0 -= Lv[2] * x42;
        a1 -= Lv[3] * x43;
      }
      { const f32x4 Lv = *(const f32x4*)(L_s + 3376);
        a0 -= Lv[0] * x44;
        a1 -= Lv[1] * x45;
        a0 -= Lv[2] * x46;
        a1 -= Lv[3] * x47;
      }
      { const f32x4 Lv = *(const f32x4*)(L_s + 3380);
        a0 -= Lv[0] * x48;
      }
      x49 = a0 + a1; } __builtin_amdgcn_sched_barrier(0);
    { float a0 = bf2f(colp[6800]) * mulp[50]; float a1 = 0.f;
      { const f32x4 Lv = *(const f32x4*)(L_s + 3400);
        a0 -= Lv[0] * x0;
        a1 -= Lv[1] * x1;
        a0 -= Lv[2] * x2;
        a1 -= Lv[3] * x3;
      }
      { const f32x4 Lv = *(const f32x4*)(L_s + 3404);
        a0 -= Lv[0] * x4;
        a1 -= Lv[1] * x5;
        a0 -= Lv[2] * x6;
        a1 -= Lv[3] * x7;
      }
      { const f32x4 Lv = *(const f32x4*)(L_s + 3408);
        a0 -= Lv[0] * x8;
        a1 -= Lv[1] * x9;
        a0 -= Lv[2] * x10;
        a1 -= Lv[3] * x11;
      }
      { const f32x4 Lv = *(const f32x4*)(L_s + 3412);
        a0 -= Lv[0] * x12;
        a1 -= Lv[1] * x13;
        a0 -= Lv[2] * x14;
        a1 -= Lv[3] * x15;
      }
      { const f32x4 Lv = *(const f32x4*)(L_s + 3416);
        a0 -= Lv[0] * x16;
        a1 -= Lv[1] * x17;
        a0 -= Lv[2] * x18;
        a1 -= Lv[3] * x19;
      }
      { const f32x4 Lv = *(const f32x4*)(L_s + 3420);
        a0 -= Lv[0] * x20;
        a1 -= Lv[1] * x21;
        a0 -= Lv[2] * x22;
        a1 -= Lv[3] * x23;
      }
      { const f32x4 Lv = *(const f32x4*)(L_s + 3424);
        a0 -= Lv[0] * x24;
        a1 -= Lv[1] * x25;
        a0 -= Lv[2] * x26;
        a1 -= Lv[3] * x27;
      }
      { const f32x4 Lv = *(const f32x4*)(L_s + 3428);
        a0 -= Lv[0] * x28;
        a1 -= Lv[1] * x29;
        a0 -= Lv[2] * x30;
        a1 -= Lv[3] * x31;
      }
      { const f32x4 Lv = *(const f32x4*)(L_s + 3432);
        a0 -= Lv[0] * x32;
        a1 -= Lv[1] * x33;
        a0 -= Lv[2] * x34;
        a1 -= Lv[3] * x35;
      }
      { const f32x4 Lv = *(const f32x4*)(L_s + 3436);
        a0 -= Lv[0] * x36;
        a1 -= Lv[1] * x37;
        a0 -= Lv[2] * x38;
        a1 -= Lv[3] * x39;
      }
      { const f32x4 Lv = *(const f32x4*)(L_s + 3440);
        a0 -= Lv[0] * x40;
        a1 -= Lv[1] * x41;
        a0 -= Lv[2] * x42;
        a1 -= Lv[3] * x43;
      }
      { const f32x4 Lv = *(const f32x4*)(L_s + 3444);
        a0 -= Lv[0] * x44;
        a1 -= Lv[1] * x45;
        a0 -= Lv[2] * x46;
        a1 -= Lv[3] * x47;
      }
      { const f32x4 Lv = *(const f32x4*)(L_s + 3448);
        a0 -= Lv[0] * x48;
        a1 -= Lv[1] * x49;
      }
      x50 = a0 + a1; }
    { float a0 = bf2f(colp[6936]) * mulp[51]; float a1 = 0.f;
      { const f32x4 Lv = *(const f32x4*)(L_s + 3468);
        a0 -= Lv[0] * x0;
        a1 -= Lv[1] * x1;
        a0 -= Lv[2] * x2;
        a1 -= Lv[3] * x3;
      }
      { const f32x4 Lv = *(const f32x4*)(L_s + 3472);
        a0 -= Lv[0] * x4;
        a1 -= Lv[1] * x5;
        a0 -= Lv[2] * x6;
        a1 -= Lv[3] * x7;
      }
      { const f32x4 Lv = *(const f32x4*)(L_s + 3476);
        a0 -= Lv[0] * x8;
        a1 -= Lv[1] * x9;
        a0 -= Lv[2] * x10;
        a1 -= Lv[3] * x11;
      }
      { const f32x4 Lv = *(const f32x4*)(L_s + 3480);
        a0 -= Lv[0] * x12;
        a1 -= Lv[1] * x13;
        a0 -= Lv[2] * x14;
        a1 -= Lv[3] * x15;
      }
      { const f32x4 Lv = *(const f32x4*)(L_s + 3484);
        a0 -= Lv[0] * x16;
        a1 -= Lv[1] * x17;
        a0 -= Lv[2] * x18;
        a1 -= Lv[3] * x19;
      }
      { const f32x4 Lv = *(const f32x4*)(L_s + 3488);
        a0 -= Lv[0] * x20;
        a1 -= Lv[1] * x21;
        a0 -= Lv[2] * x22;
        a1 -= Lv[3] * x23;
      }
      { const f32x4 Lv = *(const f32x4*)(L_s + 3492);
        a0 -= Lv[0] * x24;
        a1 -= Lv[1] * x25;
        a0 -= Lv[2] * x26;
        a1 -= Lv[3] * x27;
      }
      { const f32x4 Lv = *(const f32x4*)(L_s + 3496);
        a0 -= Lv[0] * x28;
        a1 -= Lv[1] * x29;
        a0 -= Lv[2] * x30;
        a1 -= Lv[3] * x31;
      }
      { const f32x4 Lv = *(const f32x4*)(L_s + 3500);
        a0 -= Lv[0] * x32;
        a1 -= Lv[1] * x33;
        a0 -= Lv[2] * x34;
        a1 -= Lv[3] * x35;
      }
      { const f32x4 Lv = *(const f32x4*)(L_s + 3504);
        a0 -= Lv[0] * x36;
        a1 -= Lv[1] * x37;
        a0 -= Lv[2] * x38;
        a1 -= Lv[3] * x39;
      }
      { const f32x4 Lv = *(const f32x4*)(L_s + 3508);
        a0 -= Lv[0] * x40;
        a1 -= Lv[1] * x41;
        a0 -= Lv[2] * x42;
        a1 -= Lv[3] * x43;
      }
      { const f32x4 Lv = *(const f32x4*)(L_s + 3512);
        a0 -= Lv[0] * x44;
        a1 -= Lv[1] * x45;
        a0 -= Lv[2] * x46;
        a1 -= Lv[3] * x47;
      }
      { const f32x4 Lv = *(const f32x4*)(L_s + 3516);
        a0 -= Lv[0] * x48;
        a1 -= Lv[1] * x49;
        a0 -= Lv[2] * x50;
      }
      x51 = a0 + a1; } __builtin_amdgcn_sched_barrier(0);
    { float a0 = bf2f(colp[7072]) * mulp[52]; float a1 = 0.f;
      { const f32x4 Lv = *(const f32x4*)(L_s + 3536);
        a0 -= Lv[0] * x0;
        a1 -= Lv[1] * x1;
        a0 -= Lv[2] * x2;
        a1 -= Lv[3] * x3;
      }
      { const f32x4 Lv = *(const f32x4*)(L_s + 3540);
        a0 -= Lv[0] * x4;
        a1 -= Lv[1] * x5;
        a0 -= Lv[2] * x6;
        a1 -= Lv[3] * x7;
      }
      { const f32x4 Lv = *(const f32x4*)(L_s + 3544);
        a0 -= Lv[0] * x8;
        a1 -= Lv[1] * x9;
        a0 -= Lv[2] * x10;
        a1 -= Lv[3] * x11;
      }
      { const f32x4 Lv = *(const f32x4*)(L_s + 3548);
        a0 -= Lv[0] * x12;
        a1 -= Lv[1] * x13;
        a0 -= Lv[2] * x14;
        a1 -= Lv[3] * x15;
      }
      { const f32x4 Lv = *(const f32x4*)(L_s + 3552);
        a0 -= Lv[0] * x16;
        a1 -= Lv[1] * x17;
        a0 -= Lv[2] * x18;
        a1 -= Lv[3] * x19;
      }
      { const f32x4 Lv = *(const f32x4*)(L_s + 3556);
        a0 -= Lv[0] * x20;
        a1 -= Lv[1] * x21;
        a0 -= Lv[2] * x22;
        a1 -= Lv[3] * x23;
      }
      { const f32x4 Lv = *(const f32x4*)(L_s + 3560);
        a0 -= Lv[0] * x24;
        a1 -= Lv[1] * x25;
        a0 -= Lv[2] * x26;
        a1 -= Lv[3] * x27;
      }
      { const f32x4 Lv = *(const f32x4*)(L_s + 3564);
        a0 -= Lv[0] * x28;
        a1 -= Lv[1] * x29;
        a0 -= Lv[2] * x30;
        a1 -= Lv[3] * x31;
      }
      { const f32x4 Lv = *(const f32x4*)(L_s + 3568);
        a0 -= Lv[0] * x32;
        a1 -= Lv[1] * x33;
        a0 -= Lv[2] * x34;
        a1 -= Lv[3] * x35;
      }
      { const f32x4 Lv = *(const f32x4*)(L_s + 3572);
        a0 -= Lv[0] * x36;
        a1 -= Lv[1] * x37;
        a0 -= Lv[2] * x38;
        a1 -= Lv[3] * x39;
      }
      { const f32x4 Lv = *(const f32x4*)(L_s + 3576);
        a0 -= Lv[0] * x40;
        a1 -= Lv[1] * x41;
        a0 -= Lv[2] * x42;
        a1 -= Lv[3] * x43;
      }
      { const f32x4 Lv = *(const f32x4*)(L_s + 3580);
        a0 -= Lv[0] * x44;
        a1 -= Lv[1] * x45;
        a0 -= Lv[2] * x46;
        a1 -= Lv[3] * x47;
      }
      { const f32x4 Lv = *(const f32x4*)(L_s + 3584);
        a0 -= Lv[0] * x48;
        a1 -= Lv[1] * x49;
        a0 -= Lv[2] * x50;
        a1 -= Lv[3] * x51;
      }
      x52 = a0 + a1; }
    { float a0 = bf2f(colp[7208]) * mulp[53]; float a1 = 0.f;
      { const f32x4 Lv = *(const f32x4*)(L_s + 3604);
        a0 -= Lv[0] * x0;
        a1 -= Lv[1] * x1;
        a0 -= Lv[2] * x2;
        a1 -= Lv[3] * x3;
      }
      { const f32x4 Lv = *(const f32x4*)(L_s + 3608);
        a0 -= Lv[0] * x4;
        a1 -= Lv[1] * x5;
        a0 -= Lv[2] * x6;
        a1 -= Lv[3] * x7;
      }
      { const f32x4 Lv = *(const f32x4*)(L_s + 3612);
        a0 -= Lv[0] * x8;
        a1 -= Lv[1] * x9;
        a0 -= Lv[2] * x10;
        a1 -= Lv[3] * x11;
      }
      { const f32x4 Lv = *(const f32x4*)(L_s + 3616);
        a0 -= Lv[0] * x12;
        a1 -= Lv[1] * x13;
        a0 -= Lv[2] * x14;
        a1 -= Lv[3] * x15;
      }
      { const f32x4 Lv = *(const f32x4*)(L_s + 3620);
        a0 -= Lv[0] * x16;
        a1 -= Lv[1] * x17;
        a0 -= Lv[2] * x18;
        a1 -= Lv[3] * x19;
      }
      { const f32x4 Lv = *(const f32x4*)(L_s + 3624);
        a0 -= Lv[0] * x20;
        a1 -= Lv[1] * x21;
        a0 -= Lv[2] * x22;
        a1 -= Lv[3] * x23;
      }
      { const f32x4 Lv = *(const f32x4*)(L_s + 3628);
        a0 -= Lv[0] * x24;
        a1 -= Lv[1] * x25;
        a0 -= Lv[2] * x26;
        a1 -= Lv[3] * x27;
      }
      { const f32x4 Lv = *(const f32x4*)(L_s + 3632);
        a0 -= Lv[0] * x28;
        a1 -= Lv[1] * x29;
        a0 -= Lv[2] * x30;
        a1 -= Lv[3] * x31;
      }
      { const f32x4 Lv = *(const f32x4*)(L_s + 3636);
        a0 -= Lv[0] * x32;
        a1 -= Lv[1] * x33;
        a0 -= Lv[2] * x34;
        a1 -= Lv[3] * x35;
      }
      { const f32x4 Lv = *(const f32x4*)(L_s + 3640);
        a0 -= Lv[0] * x36;
        a1 -= Lv[1] * x37;
        a0 -= Lv[2] * x38;
        a1 -= Lv[3] * x39;
      }
      { const f32x4 Lv = *(const f32x4*)(L_s + 3644);
        a0 -= Lv[0] * x40;
        a1 -= Lv[1] * x41;
        a0 -= Lv[2] * x42;
        a1 -= Lv[3] * x43;
      }
      { const f32x4 Lv = *(const f32x4*)(L_s + 3648);
        a0 -= Lv[0] * x44;
        a1 -= Lv[1] * x45;
        a0 -= Lv[2] * x46;
        a1 -= Lv[3] * x47;
      }
      { const f32x4 Lv = *(const f32x4*)(L_s + 3652);
        a0 -= Lv[0] * x48;
        a1 -= Lv[1] * x49;
        a0 -= Lv[2] * x50;
        a1 -= Lv[3] * x51;
      }
      { const f32x4 Lv = *(const f32x4*)(L_s + 3656);
        a0 -= Lv[0] * x52;
      }
      x53 = a0 + a1; } __builtin_amdgcn_sched_barrier(0);
    { float a0 = bf2f(colp[7344]) * mulp[54]; float a1 = 0.f;
      { const f32x4 Lv = *(const f32x4*)(L_s + 3672);
        a0 -= Lv[0] * x0;
        a1 -= Lv[1] * x1;
        a0 -= Lv[2] * x2;
        a1 -= Lv[3] * x3;
      }
      { const f32x4 Lv = *(const f32x4*)(L_s + 3676);
        a0 -= Lv[0] * x4;
        a1 -= Lv[1] * x5;
        a0 -= Lv[2] * x6;
        a1 -= Lv[3] * x7;
      }
      { const f32x4 Lv = *(const f32x4*)(L_s + 3680);
        a0 -= Lv[0] * x8;
        a1 -= Lv[1] * x9;
        a0 -= Lv[2] * x10;
        a1 -= Lv[3] * x11;
      }
      { const f32x4 Lv = *(const f32x4*)(L_s + 3684);
        a0 -= Lv[0] * x12;
        a1 -= Lv[1] * x13;
        a0 -= Lv[2] * x14;
        a1 -= Lv[3] * x15;
      }
      { const f32x4 Lv = *(const f32x4*)(L_s + 3688);
        a0 -= Lv[0] * x16;
        a1 -= Lv[1] * x17;
        a0 -= Lv[2] * x18;
        a1 -= Lv[3] * x19;
      }
      { const f32x4 Lv = *(const f32x4*)(L_s + 3692);
        a0 -= Lv[0] * x20;
        a1 -= Lv[1] * x21;
        a0 -= Lv[2] * x22;
        a1 -= Lv[3] * x23;
      }
      { const f32x4 Lv = *(const f32x4*)(L_s + 3696);
        a0 -= Lv[0] * x24;
        a1 -= Lv[1] * x25;
        a0 -= Lv[2] * x26;
        a1 -= Lv[3] * x27;
      }
      { const f32x4 Lv = *(const f32x4*)(L_s + 3700);
        a0 -= Lv[0] * x28;
        a1 -= Lv[1] * x29;
        a0 -= Lv[2] * x30;
        a1 -= Lv[3] * x31;
      }
      { const f32x4 Lv = *(const f32x4*)(L_s + 3704);
        a0 -= Lv[0] * x32;
        a1 -= Lv[1] * x33;
        a0 -= Lv[2] * x34;
        a1 -= Lv[3] * x35;
      }
      { const f32x4 Lv = *(const f32x4*)(L_s + 3708);
        a0 -= Lv[0] * x36;
        a1 -= Lv[1] * x37;
        a0 -= Lv[2] * x38;
        a1 -= Lv[3] * x39;
      }
      { const f32x4 Lv = *(const f32x4*)(L_s + 3712);
        a0 -= Lv[0] * x40;
        a1 -= Lv[1] * x41;
        a0 -= Lv[2] * x42;
        a1 -= Lv[3] * x43;
      }
      { const f32x4 Lv = *(const f32x4*)(L_s + 3716);
        a0 -= Lv[0] * x44;
        a1 -= Lv[1] * x45;
        a0 -= Lv[2] * x46;
        a1 -= Lv[3] * x47;
      }
      { const f32x4 Lv = *(const f32x4*)(L_s + 3720);
        a0 -= Lv[0] * x48;
        a1 -= Lv[1] * x49;
        a0 -= Lv[2] * x50;
        a1 -= Lv[3] * x51;
      }
      { const f32x4 Lv = *(const f32x4*)(L_s + 3724);
        a0 -= Lv[0] * x52;
        a1 -= Lv[1] * x53;
      }
      x54 = a0 + a1; }
    { float a0 = bf2f(colp[7480]) * mulp[55]; float a1 = 0.f;
      { const f32x4 Lv = *(const f32x4*)(L_s + 3740);
        a0 -= Lv[0] * x0;
        a1 -= Lv[1] * x1;
        a0 -= Lv[2] * x2;
        a1 -= Lv[3] * x3;
      }
      { const f32x4 Lv = *(const f32x4*)(L_s + 3744);
        a0 -= Lv[0] * x4;
        a1 -= Lv[1] * x5;
        a0 -= Lv[2] * x6;
        a1 -= Lv[3] * x7;
      }
      { const f32x4 Lv = *(const f32x4*)(L_s + 3748);
        a0 -= Lv[0] * x8;
        a1 -= Lv[1] * x9;
        a0 -= Lv[2] * x10;
        a1 -= Lv[3] * x11;
      }
      { const f32x4 Lv = *(const f32x4*)(L_s + 3752);
        a0 -= Lv[0] * x12;
        a1 -= Lv[1] * x13;
        a0 -= Lv[2] * x14;
        a1 -= Lv[3] * x15;
      }
      { const f32x4 Lv = *(const f32x4*)(L_s + 3756);
        a0 -= Lv[0] * x16;
        a1 -= Lv[1] * x17;
        a0 -= Lv[2] * x18;
        a1 -= Lv[3] * x19;
      }
      { const f32x4 Lv = *(const f32x4*)(L_s + 3760);
        a0 -= Lv[0] * x20;
        a1 -= Lv[1] * x21;
        a0 -= Lv[2] * x22;
        a1 -= Lv[3] * x23;
      }
      { const f32x4 Lv = *(const f32x4*)(L_s + 3764);
        a0 -= Lv[0] * x24;
        a1 -= Lv[1] * x25;
        a0 -= Lv[2] * x26;
        a1 -= Lv[3] * x27;
      }
      { const f32x4 Lv = *(const f32x4*)(L_s + 3768);
        a0 -= Lv[0] * x28;
        a1 -= Lv[1] * x29;
        a0 -= Lv[2] * x30;
        a1 -= Lv[3] * x31;
      }
      { const f32x4 Lv = *(const f32x4*)(L_s + 3772);
        a0 -= Lv[0] * x32;
        a1 -= Lv[1] * x33;
        a0 -= Lv[2] * x34;
        a1 -= Lv[3] * x35;
      }
      { const f32x4 Lv = *(const f32x4*)(L_s + 3776);
        a0 -= Lv[0] * x36;
        a1 -= Lv[1] * x37;
        a0 -= Lv[2] * x38;
        a1 -= Lv[3] * x39;
      }
      { const f32x4 Lv = *(const f32x4*)(L_s + 3780);
        a0 -= Lv[0] * x40;
        a1 -= Lv[1] * x41;
        a0 -= Lv[2] * x42;
        a1 -= Lv[3] * x43;
      }
      { const f32x4 Lv = *(const f32x4*)(L_s + 3784);
        a0 -= Lv[0] * x44;
        a1 -= Lv[1] * x45;
        a0 -= Lv[2] * x46;
        a1 -= Lv[3] * x47;
      }
      { const f32x4 Lv = *(const f32x4*)(L_s + 3788);
        a0 -= Lv[0] * x48;
        a1 -= Lv[1] * x49;
        a0 -= Lv[2] * x50;
        a1 -= Lv[3] * x51;
      }
      { const f32x4 Lv = *(const f32x4*)(L_s + 3792);
        a0 -= Lv[0] * x52;
        a1 -= Lv[1] * x53;
        a0 -= Lv[2] * x54;
      }
      x55 = a0 + a1; } __builtin_amdgcn_sched_barrier(0);
    { float a0 = bf2f(colp[7616]) * mulp[56]; float a1 = 0.f;
      { const f32x4 Lv = *(const f32x4*)(L_s + 3808);
        a0 -= Lv[0] * x0;
        a1 -= Lv[1] * x1;
        a0 -= Lv[2] * x2;
        a1 -= Lv[3] * x3;
      }
      { const f32x4 Lv = *(const f32x4*)(L_s + 3812);
        a0 -= Lv[0] * x4;
        a1 -= Lv[1] * x5;
        a0 -= Lv[2] * x6;
        a1 -= Lv[3] * x7;
      }
      { const f32x4 Lv = *(const f32x4*)(L_s + 3816);
        a0 -= Lv[0] * x8;
        a1 -= Lv[1] * x9;
        a0 -= Lv[2] * x10;
        a1 -= Lv[3] * x11;
      }
      { const f32x4 Lv = *(const f32x4*)(L_s + 3820);
        a0 -= Lv[0] * x12;
        a1 -= Lv[1] * x13;
        a0 -= Lv[2] * x14;
        a1 -= Lv[3] * x15;
      }
      { const f32x4 Lv = *(const f32x4*)(L_s + 3824);
        a0 -= Lv[0] * x16;
        a1 -= Lv[1] * x17;
        a0 -= Lv[2] * x18;
        a1 -= Lv[3] * x19;
      }
      { const f32x4 Lv = *(const f32x4*)(L_s + 3828);
        a0 -= Lv[0] * x20;
        a1 -= Lv[1] * x21;
        a0 -= Lv[2] * x22;
        a1 -= Lv[3] * x23;
      }
      { const f32x4 Lv = *(const f32x4*)(L_s + 3832);
        a0 -= Lv[0] * x24;
        a1 -= Lv[1] * x25;
        a0 -= Lv[2] * x26;
        a1 -= Lv[3] * x27;
      }
      { const f32x4 Lv = *(const f32x4*)(L_s + 3836);
        a0 -= Lv[0] * x28;
        a1 -= Lv[1] * x29;
        a0 -= Lv[2] * x30;
        a1 -= Lv[3] * x31;
      }
      { const f32x4 Lv = *(const f32x4*)(L_s + 3840);
        a0 -= Lv[0] * x32;
        a1 -= Lv[1] * x33;
        a0 -= Lv[2] * x34;
        a1 -= Lv[3] * x35;
      }
      { const f32x4 Lv = *(const f32x4*)(L_s + 3844);
        a0 -= Lv[0] * x36;
        a1 -= Lv[1] * x37;
        a0 -= Lv[2] * x38;
        a1 -= Lv[3] * x39;
      }
      { const f32x4 Lv = *(const f32x4*)(L_s + 3848);
        a0 -= Lv[0] * x40;
        a1 -= Lv[1] * x41;
        a0 -= Lv[2] * x42;
        a1 -= Lv[3] * x43;
      }
      { const f32x4 Lv = *(const f32x4*)(L_s + 3852);
        a0 -= Lv[0] * x44;
        a1 -= Lv[1] * x45;
        a0 -= Lv[2] * x46;
        a1 -= Lv[3] * x47;
      }
      { const f32x4 Lv = *(const f32x4*)(L_s + 3856);
        a0 -= Lv[0] * x48;
        a1 -= Lv[1] * x49;
        a0 -= Lv[2] * x50;
        a1 -= Lv[3] * x51;
      }
      { const f32x4 Lv = *(const f32x4*)(L_s + 3860);
        a0 -= Lv[0] * x52;
        a1 -= Lv[1] * x53;
        a0 -= Lv[2] * x54;
        a1 -= Lv[3] * x55;
      }
      x56 = a0 + a1; }
    { float a0 = bf2f(colp[7752]) * mulp[57]; float a1 = 0.f;
      { const f32x4 Lv = *(const f32x4*)(L_s + 3876);
        a0 -= Lv[0] * x0;
        a1 -= Lv[1] * x1;
        a0 -= Lv[2] * x2;
        a1 -= Lv[3] * x3;
      }
      { const f32x4 Lv = *(const f32x4*)(L_s + 3880);
        a0 -= Lv[0] * x4;
        a1 -= Lv[1] * x5;
        a0 -= Lv[2] * x6;
        a1 -= Lv[3] * x7;
      }
      { const f32x4 Lv = *(const f32x4*)(L_s + 3884);
        a0 -= Lv[0] * x8;
        a1 -= Lv[1] * x9;
        a0 -= Lv[2] * x10;
        a1 -= Lv[3] * x11;
      }
      { const f32x4 Lv = *(const f32x4*)(L_s + 3888);
        a0 -= Lv[0] * x12;
        a1 -= Lv[1] * x13;
        a0 -= Lv[2] * x14;
        a1 -= Lv[3] * x15;
      }
      { const f32x4 Lv = *(const f32x4*)(L_s + 3892);
        a0 -= Lv[0] * x16;
        a1 -= Lv[1] * x17;
        a0 -= Lv[2] * x18;
        a1 -= Lv[3] * x19;
      }
      { const f32x4 Lv = *(const f32x4*)(L_s + 3896);
        a0 -= Lv[0] * x20;
        a1 -= Lv[1] * x21;
        a0 -= Lv[2] * x22;
        a1 -= Lv[3] * x23;
      }
      { const f32x4 Lv = *(const f32x4*)(L_s + 3900);
        a0 -= Lv[0] * x24;
        a1 -= Lv[1] * x25;
        a0 -= Lv[2] * x26;
        a1 -= Lv[3] * x27;
      }
      { const f32x4 Lv = *(const f32x4*)(L_s + 3904);
        a0 -= Lv[0] * x28;
        a1 -= Lv[1] * x29;
        a0 -= Lv[2] * x30;
        a1 -= Lv[3] * x31;
      }
      { const f32x4 Lv = *(const f32x4*)(L_s + 3908);
        a0 -= Lv[0] * x32;
        a1 -= Lv[1] * x33;
        a0 -= Lv[2] * x34;
        a1 -= Lv[3] * x35;
      }
      { const f32x4 Lv = *(const f32x4*)(L_s + 3912);
        a0 -= Lv[0] * x36;
        a1 -= Lv[1] * x37;
        a0 -= Lv[2] * x38;
        a1 -= Lv[3] * x39;
      }
      { const f32x4 Lv = *(const f32x4*)(L_s + 3916);
        a0 -= Lv[0] * x40;
        a1 -= Lv[1] * x41;
        a0 -= Lv[2] * x42;
        a1 -= Lv[3] * x43;
      }
      { const f32x4 Lv = *(const f32x4*)(L_s + 3920);
        a0 -= Lv[0] * x44;
        a1 -= Lv[1] * x45;
        a0 -= Lv[2] * x46;
        a1 -= Lv[3] * x47;
      }
      { const f32x4 Lv = *(const f32x4*)(L_s + 3924);
        a0 -= Lv[0] * x48;
        a1 -= Lv[1] * x49;
        a0 -= Lv[2] * x50;
        a1 -= Lv[3] * x51;
      }
      { const f32x4 Lv = *(const f32x4*)(L_s + 3928);
        a0 -= Lv[0] * x52;
        a1 -= Lv[1] * x53;
        a0 -= Lv[2] * x54;
        a1 -= Lv[3] * x55;
      }
      { const f32x4 Lv = *(const f32x4*)(L_s + 3932);
        a0 -= Lv[0] * x56;
      }
      x57 = a0 + a1; } __builtin_amdgcn_sched_barrier(0);
    { float a0 = bf2f(colp[7888]) * mulp[58]; float a1 = 0.f;
      { const f32x4 Lv = *(const f32x4*)(L_s + 3944);
        a0 -= Lv[0] * x0;
        a1 -= Lv[1] * x1;
        a0 -= Lv[2] * x2;
        a1 -= Lv[3] * x3;
      }
      { const f32x4 Lv = *(const f32x4*)(L_s + 3948);
        a0 -= Lv[0] * x4;
        a1 -= Lv[1] * x5;
        a0 -= Lv[2] * x6;
        a1 -= Lv[3] * x7;
      }
      { const f32x4 Lv = *(const f32x4*)(L_s + 3952);
        a0 -= Lv[0] * x8;
        a1 -= Lv[1] * x9;
        a0 -= Lv[2] * x10;
        a1 -= Lv[3] * x11;
      }
      { const f32x4 Lv = *(const f32x4*)(L_s + 3956);
        a0 -= Lv[0] * x12;
        a1 -= Lv[1] * x13;
        a0 -= Lv[2] * x14;
        a1 -= Lv[3] * x15;
      }
      { const f32x4 Lv = *(const f32x4*)(L_s + 3960);
        a0 -= Lv[0] * x16;
        a1 -= Lv[1] * x17;
        a0 -= Lv[2] * x18;
        a1 -= Lv[3] * x19;
      }
      { const f32x4 Lv = *(const f32x4*)(L_s + 3964);
        a0 -= Lv[0] * x20;
        a1 -= Lv[1] * x21;
        a0 -= Lv[2] * x22;
        a1 -= Lv[3] * x23;
      }
      { const f32x4 Lv = *(const f32x4*)(L_s + 3968);
        a0 -= Lv[0] * x24;
        a1 -= Lv[1] * x25;
        a0 -= Lv[2] * x26;
        a1 -= Lv[3] * x27;
      }
      { const f32x4 Lv = *(const f32x4*)(L_s + 3972);
        a0 -= Lv[0] * x28;
        a1 -= Lv[1] * x29;
        a0 -= Lv[2] * x30;
        a1 -= Lv[3] * x31;
      }
      { const f32x4 Lv = *(const f32x4*)(L_s + 3976);
        a0 -= Lv[0] * x32;
        a1 -= Lv[1] * x33;
        a0 -= Lv[2] * x34;
        a1 -= Lv[3] * x35;
      }
      { const f32x4 Lv = *(const f32x4*)(L_s + 3980);
        a0 -= Lv[0] * x36;
        a1 -= Lv[1] * x37;
        a0 -= Lv[2] * x38;
        a1 -= Lv[3] * x39;
      }
      { const f32x4 Lv = *(const f32x4*)(L_s + 3984);
        a0 -= Lv[0] * x40;
        a1 -= Lv[1] * x41;
        a0 -= Lv[2] * x42;
        a1 -= Lv[3] * x43;
      }
      { const f32x4 Lv = *(const f32x4*)(L_s + 3988);
        a0 -= Lv[0] * x44;
        a1 -= Lv[1] * x45;
        a0 -= Lv[2] * x46;
        a1 -= Lv[3] * x47;
      }
      { const f32x4 Lv = *(const f32x4*)(L_s + 3992);
        a0 -= Lv[0] * x48;
        a1 -= Lv[1] * x49;
        a0 -= Lv[2] * x50;
        a1 -= Lv[3] * x51;
      }
      { const f32x4 Lv = *(const f32x4*)(L_s + 3996);
        a0 -= Lv[0] * x52;
        a1 -= Lv[1] * x53;
        a0 -= Lv[2] * x54;
        a1 -= Lv[3] * x55;
      }
      { const f32x4 Lv = *(const f32x4*)(L_s + 4000);
        a0 -= Lv[0] * x56;
        a1 -= Lv[1] * x57;
      }
      x58 = a0 + a1; }
    { float a0 = bf2f(colp[8024]) * mulp[59]; float a1 = 0.f;
      { const f32x4 Lv = *(const f32x4*)(L_s + 4012);
        a0 -= Lv[0] * x0;
        a1 -= Lv[1] * x1;
        a0 -= Lv[2] * x2;
        a1 -= Lv[3] * x3;
      }
      { const f32x4 Lv = *(const f32x4*)(L_s + 4016);
        a0 -= Lv[0] * x4;
        a1 -= Lv[1] * x5;
        a0 -= Lv[2] * x6;
        a1 -= Lv[3] * x7;
      }
      { const f32x4 Lv = *(const f32x4*)(L_s + 4020);
        a0 -= Lv[0] * x8;
        a1 -= Lv[1] * x9;
        a0 -= Lv[2] * x10;
        a1 -= Lv[3] * x11;
      }
      { const f32x4 Lv = *(const f32x4*)(L_s + 4024);
        a0 -= Lv[0] * x12;
        a1 -= Lv[1] * x13;
        a0 -= Lv[2] * x14;
        a1 -= Lv[3] * x15;
      }
      { const f32x4 Lv = *(const f32x4*)(L_s + 4028);
        a0 -= Lv[0] * x16;
        a1 -= Lv[1] * x17;
        a0 -= Lv[2] * x18;
        a1 -= Lv[3] * x19;
      }
      { const f32x4 Lv = *(const f32x4*)(L_s + 4032);
        a0 -= Lv[0] * x20;
        a1 -= Lv[1] * x21;
        a0 -= Lv[2] * x22;
        a1 -= Lv[3] * x23;
      }
      { const f32x4 Lv = *(const f32x4*)(L_s + 4036);
        a0 -= Lv[0] * x24;
        a1 -= Lv[1] * x25;
        a0 -= Lv[2] * x26;
        a1 -= Lv[3] * x27;
      }
      { const f32x4 Lv = *(const f32x4*)(L_s + 4040);
        a0 -= Lv[0] * x28;
        a1 -= Lv[1] * x29;
        a0 -= Lv[2] * x30;
        a1 -= Lv[3] * x31;
      }
      { const f32x4 Lv = *(const f32x4*)(L_s + 4044);
        a0 -= Lv[0] * x32;
        a1 -= Lv[1] * x33;
        a0 -= Lv[2] * x34;
        a1 -= Lv[3] * x35;
      }
      { const f32x4 Lv = *(const f32x4*)(L_s + 4048);
        a0 -= Lv[0] * x36;
        a1 -= Lv[1] * x37;
        a0 -= Lv[2] * x38;
        a1 -= Lv[3] * x39;
      }
      { const f32x4 Lv = *(const f32x4*)(L_s + 4052);
        a0 -= Lv[0] * x40;
        a1 -= Lv[1] * x41;
        a0 -= Lv[2] * x42;
        a1 -= Lv[3] * x43;
      }
      { const f32x4 Lv = *(const f32x4*)(L_s + 4056);
        a0 -= Lv[0] * x44;
        a1 -= Lv[1] * x45;
        a0 -= Lv[2] * x46;
        a1 -= Lv[3] * x47;
      }
      { const f32x4 Lv = *(const f32x4*)(L_s + 4060);
        a0 -= Lv[0] * x48;
        a1 -= Lv[1] * x49;
        a0 -= Lv[2] * x50;
        a1 -= Lv[3] * x51;
      }
      { const f32x4 Lv = *(const f32x4*)(L_s + 4064);
        a0 -= Lv[0] * x52;
        a1 -= Lv[1] * x53;
        a0 -= Lv[2] * x54;
        a1 -= Lv[3] * x55;
      }
      { const f32x4 Lv = *(const f32x4*)(L_s + 4068);
        a0 -= Lv[0] * x56;
        a1 -= Lv[1] * x57;
        a0 -= Lv[2] * x58;
      }
      x59 = a0 + a1; } __builtin_amdgcn_sched_barrier(0);
    { float a0 = bf2f(colp[8160]) * mulp[60]; float a1 = 0.f;
      { const f32x4 Lv = *(const f32x4*)(L_s + 4080);
        a0 -= Lv[0] * x0;
        a1 -= Lv[1] * x1;
        a0 -= Lv[2] * x2;
        a1 -= Lv[3] * x3;
      }
      { const f32x4 Lv = *(const f32x4*)(L_s + 4084);
        a0 -= Lv[0] * x4;
        a1 -= Lv[1] * x5;
        a0 -= Lv[2] * x6;
        a1 -= Lv[3] * x7;
      }
      { const f32x4 Lv = *(const f32x4*)(L_s + 4088);
        a0 -= Lv[0] * x8;
        a1 -= Lv[1] * x9;
        a0 -= Lv[2] * x10;
        a1 -= Lv[3] * x11;
      }
      { const f32x4 Lv = *(const f32x4*)(L_s + 4092);
        a0 -= Lv[0] * x12;
        a1 -= Lv[1] * x13;
        a0 -= Lv[2] * x14;
        a1 -= Lv[3] * x15;
      }
      { const f32x4 Lv = *(const f32x4*)(L_s + 4096);
        a0 -= Lv[0] * x16;
        a1 -= Lv[1] * x17;
        a0 -= Lv[2] * x18;
        a1 -= Lv[3] * x19;
      }
      { const f32x4 Lv = *(const f32x4*)(L_s + 4100);
        a0 -= Lv[0] * x20;
        a1 -= Lv[1] * x21;
        a0 -= Lv[2] * x22;
        a1 -= Lv[3] * x23;
      }
      { const f32x4 Lv = *(const f32x4*)(L_s + 4104);
        a0 -= Lv[0] * x24;
        a1 -= Lv[1] * x25;
        a0 -= Lv[2] * x26;
        a1 -= Lv[3] * x27;
      }
      { const f32x4 Lv = *(const f32x4*)(L_s + 4108);
        a0 -= Lv[0] * x28;
        a1 -= Lv[1] * x29;
        a0 -= Lv[2] * x30;
        a1 -= Lv[3] * x31;
      }
      { const f32x4 Lv = *(const f32x4*)(L_s + 4112);
        a0 -= Lv[0] * x32;
        a1 -= Lv[1] * x33;
        a0 -= Lv[2] * x34;
        a1 -= Lv[3] * x35;
      }
      { const f32x4 Lv = *(const f32x4*)(L_s + 4116);
        a0 -= Lv[0] * x36;
        a1 -= Lv[1] * x37;
        a0 -= Lv[2] * x38;
        a1 -= Lv[3] * x39;
      }
      { const f32x4 Lv = *(const f32x4*)(L_s + 4120);
        a0 -= Lv[0] * x40;
        a1 -= Lv[1] * x41;
        a0 -= Lv[2] * x42;
        a1 -= Lv[3] * x43;
      }
      { const f32x4 Lv = *(const f32x4*)(L_s + 4124);
        a0 -= Lv[0] * x44;
        a1 -= Lv[1] * x45;
        a0 -= Lv[2] * x46;
        a1 -= Lv[3] * x47;
      }
      { const f32x4 Lv = *(const f32x4*)(L_s + 4128);
        a0 -= Lv[0] * x48;
        a1 -= Lv[1] * x49;
        a0 -= Lv[2] * x50;
        a1 -= Lv[3] * x51;
      }
      { const f32x4 Lv = *(const f32x4*)(L_s + 4132);
        a0 -= Lv[0] * x52;
        a1 -= Lv[1] * x53;
        a0 -= Lv[2] * x54;
        a1 -= Lv[3] * x55;
      }
      { const f32x4 Lv = *(const f32x4*)(L_s + 4136);
        a0 -= Lv[0] * x56;
        a1 -= Lv[1] * x57;
        a0 -= Lv[2] * x58;
        a1 -= Lv[3] * x59;
      }
      x60 = a0 + a1; }
    { float a0 = bf2f(colp[8296]) * mulp[61]; float a1 = 0.f;
      { const f32x4 Lv = *(const f32x4*)(L_s + 4148);
        a0 -= Lv[0] * x0;
        a1 -= Lv[1] * x1;
        a0 -= Lv[2] * x2;
        a1 -= Lv[3] * x3;
      }
      { const f32x4 Lv = *(const f32x4*)(L_s + 4152);
        a0 -= Lv[0] * x4;
        a1 -= Lv[1] * x5;
        a0 -= Lv[2] * x6;
        a1 -= Lv[3] * x7;
      }
      { const f32x4 Lv = *(const f32x4*)(L_s + 4156);
        a0 -= Lv[0] * x8;
        a1 -= Lv[1] * x9;
        a0 -= Lv[2] * x10;
        a1 -= Lv[3] * x11;
      }
      { const f32x4 Lv = *(const f32x4*)(L_s + 4160);
        a0 -= Lv[0] * x12;
        a1 -= Lv[1] * x13;
        a0 -= Lv[2] * x14;
        a1 -= Lv[3] * x15;
      }
      { const f32x4 Lv = *(const f32x4*)(L_s + 4164);
        a0 -= Lv[0] * x16;
        a1 -= Lv[1] * x17;
        a0 -= Lv[2] * x18;
        a1 -= Lv[3] * x19;
      }
      { const f32x4 Lv = *(const f32x4*)(L_s + 4168);
        a0 -= Lv[0] * x20;
        a1 -= Lv[1] * x21;
        a0 -= Lv[2] * x22;
        a1 -= Lv[3] * x23;
      }
      { const f32x4 Lv = *(const f32x4*)(L_s + 4172);
        a0 -= Lv[0] * x24;
        a1 -= Lv[1] * x25;
        a0 -= Lv[2] * x26;
        a1 -= Lv[3] * x27;
      }
      { const f32x4 Lv = *(const f32x4*)(L_s + 4176);
        a0 -= Lv[0] * x28;
        a1 -= Lv[1] * x29;
        a0 -= Lv[2] * x30;
        a1 -= Lv[3] * x31;
      }
      { const f32x4 Lv = *(const f32x4*)(L_s + 4180);
        a0 -= Lv[0] * x32;
        a1 -= Lv[1] * x33;
        a0 -= Lv[2] * x34;
        a1 -= Lv[3] * x35;
      }
      { const f32x4 Lv = *(const f32x4*)(L_s + 4184);
        a0 -= Lv[0] * x36;
        a1 -= Lv[1] * x37;
        a0 -= Lv[2] * x38;
        a1 -= Lv[3] * x39;
      }
      { const f32x4 Lv = *(const f32x4*)(L_s + 4188);
        a0 -= Lv[0] * x40;
        a1 -= Lv[1] * x41;
        a0 -= Lv[2] * x42;
        a1 -= Lv[3] * x43;
      }
      { const f32x4 Lv = *(const f32x4*)(L_s + 4192);
        a0 -= Lv[0] * x44;
        a1 -= Lv[1] * x45;
        a0 -= Lv[2] * x46;
        a1 -= Lv[3] * x47;
      }
      { const f32x4 Lv = *(const f32x4*)(L_s + 4196);
        a0 -= Lv[0] * x48;
        a1 -= Lv[1] * x49;
        a0 -= Lv[2] * x50;
        a1 -= Lv[3] * x51;
      }
      { const f32x4 Lv = *(const f32x4*)(L_s + 4200);
        a0 -= Lv[0] * x52;
        a1 -= Lv[1] * x53;
        a0 -= Lv[2] * x54;
        a1 -= Lv[3] * x55;
      }
      { const f32x4 Lv = *(const f32x4*)(L_s + 4204);
        a0 -= Lv[0] * x56;
        a1 -= Lv[1] * x57;
        a0 -= Lv[2] * x58;
        a1 -= Lv[3] * x59;
      }
      { const f32x4 Lv = *(const f32x4*)(L_s + 4208);
        a0 -= Lv[0] * x60;
      }
      x61 = a0 + a1; } __builtin_amdgcn_sched_barrier(0);
    { float a0 = bf2f(colp[8432]) * mulp[62]; float a1 = 0.f;
      { const f32x4 Lv = *(const f32x4*)(L_s + 4216);
        a0 -= Lv[0] * x0;
        a1 -= Lv[1] * x1;
        a0 -= Lv[2] * x2;
        a1 -= Lv[3] * x3;
      }
      { const f32x4 Lv = *(const f32x4*)(L_s + 4220);
        a0 -= Lv[0] * x4;
        a1 -= Lv[1] * x5;
        a0 -= Lv[2] * x6;
        a1 -= Lv[3] * x7;
      }
      { const f32x4 Lv = *(const f32x4*)(L_s + 4224);
        a0 -= Lv[0] * x8;
        a1 -= Lv[1] * x9;
        a0 -= Lv[2] * x10;
        a1 -= Lv[3] * x11;
      }
      { const f32x4 Lv = *(const f32x4*)(L_s + 4228);
        a0 -= Lv[0] * x12;
        a1 -= Lv[1] * x13;
        a0 -= Lv[2] * x14;
        a1 -= Lv[3] * x15;
      }
      { const f32x4 Lv = *(const f32x4*)(L_s + 4232);
        a0 -= Lv[0] * x16;
        a1 -= Lv[1] * x17;
        a0 -= Lv[2] * x18;
        a1 -= Lv[3] * x19;
      }
      { const f32x4 Lv = *(const f32x4*)(L_s + 4236);
        a0 -= Lv[0] * x20;
        a1 -= Lv[1] * x21;
        a0 -= Lv[2] * x22;
        a1 -= Lv[3] * x23;
      }
      { const f32x4 Lv = *(const f32x4*)(L_s + 4240);
        a0 -= Lv[0] * x24;
        a1 -= Lv[1] * x25;
        a0 -= Lv[2] * x26;
        a1 -= Lv[3] * x27;
      }
      { const f32x4 Lv = *(const f32x4*)(L_s + 4244);
        a0 -= Lv[0] * x28;
        a1 -= Lv[1] * x29;
        a0 -= Lv[2] * x30;
        a1 -= Lv[3] * x31;
      }
      { const f32x4 Lv = *(const f32x4*)(L_s + 4248);
        a0 -= Lv[0] * x32;
        a1 -= Lv[1] * x33;
        a0 -= Lv[2] * x34;
        a1 -= Lv[3] * x35;
      }
      { const f32x4 Lv = *(const f32x4*)(L_s + 4252);
        a0 -= Lv[0] * x36;
        a1 -= Lv[1] * x37;
        a0 -= Lv[2] * x38;
        a1 -= Lv[3] * x39;
      }
      { const f32x4 Lv = *(const f32x4*)(L_s + 4256);
        a0 -= Lv[0] * x40;
        a1 -= Lv[1] * x41;
        a0 -= Lv[2] * x42;
        a1 -= Lv[3] * x43;
      }
      { const f32x4 Lv = *(const f32x4*)(L_s + 4260);
        a0 -= Lv[0] * x44;
        a1 -= Lv[1] * x45;
        a0 -= Lv[2] * x46;
        a1 -= Lv[3] * x47;
      }
      { const f32x4 Lv = *(const f32x4*)(L_s + 4264);
        a0 -= Lv[0] * x48;
        a1 -= Lv[1] * x49;
        a0 -= Lv[2] * x50;
        a1 -= Lv[3] * x51;
      }
      { const f32x4 Lv = *(const f32x4*)(L_s + 4268);
        a0 -= Lv[0] * x52;
        a1 -= Lv[1] * x53;
        a0 -= Lv[2] * x54;
        a1 -= Lv[3] * x55;
      }
      { const f32x4 Lv = *(const f32x4*)(L_s + 4272);
        a0 -= Lv[0] * x56;
        a1 -= Lv[1] * x57;
        a0 -= Lv[2] * x58;
        a1 -= Lv[3] * x59;
      }
      { const f32x4 Lv = *(const f32x4*)(L_s + 4276);
        a0 -= Lv[0] * x60;
        a1 -= Lv[1] * x61;
      }
      x62 = a0 + a1; }
    { float a0 = bf2f(colp[8568]) * mulp[63]; float a1 = 0.f;
      { const f32x4 Lv = *(const f32x4*)(L_s + 4284);
        a0 -= Lv[0] * x0;
        a1 -= Lv[1] * x1;
        a0 -= Lv[2] * x2;
        a1 -= Lv[3] * x3;
      }
      { const f32x4 Lv = *(const f32x4*)(L_s + 4288);
        a0 -= Lv[0] * x4;
        a1 -= Lv[1] * x5;
        a0 -= Lv[2] * x6;
        a1 -= Lv[3] * x7;
      }
      { const f32x4 Lv = *(const f32x4*)(L_s + 4292);
        a0 -= Lv[0] * x8;
        a1 -= Lv[1] * x9;
        a0 -= Lv[2] * x10;
        a1 -= Lv[3] * x11;
      }
      { const f32x4 Lv = *(const f32x4*)(L_s + 4296);
        a0 -= Lv[0] * x12;
        a1 -= Lv[1] * x13;
        a0 -= Lv[2] * x14;
        a1 -= Lv[3] * x15;
      }
      { const f32x4 Lv = *(const f32x4*)(L_s + 4300);
        a0 -= Lv[0] * x16;
        a1 -= Lv[1] * x17;
        a0 -= Lv[2] * x18;
        a1 -= Lv[3] * x19;
      }
      { const f32x4 Lv = *(const f32x4*)(L_s + 4304);
        a0 -= Lv[0] * x20;
        a1 -= Lv[1] * x21;
        a0 -= Lv[2] * x22;
        a1 -= Lv[3] * x23;
      }
      { const f32x4 Lv = *(const f32x4*)(L_s + 4308);
        a0 -= Lv[0] * x24;
        a1 -= Lv[1] * x25;
        a0 -= Lv[2] * x26;
        a1 -= Lv[3] * x27;
      }
      { const f32x4 Lv = *(const f32x4*)(L_s + 4312);
        a0 -= Lv[0] * x28;
        a1 -= Lv[1] * x29;
        a0 -= Lv[2] * x30;
        a1 -= Lv[3] * x31;
      }
      { const f32x4 Lv = *(const f32x4*)(L_s + 4316);
        a0 -= Lv[0] * x32;
        a1 -= Lv[1] * x33;
        a0 -= Lv[2] * x34;
        a1 -= Lv[3] * x35;
      }
      { const f32x4 Lv = *(const f32x4*)(L_s + 4320);
        a0 -= Lv[0] * x36;
        a1 -= Lv[1] * x37;
        a0 -= Lv[2] * x38;
        a1 -= Lv[3] * x39;
      }
      { const f32x4 Lv = *(const f32x4*)(L_s + 4324);
        a0 -= Lv[0] * x40;
        a1 -= Lv[1] * x41;
        a0 -= Lv[2] * x42;
        a1 -= Lv[3] * x43;
      }
      { const f32x4 Lv = *(const f32x4*)(L_s + 4328);
        a0 -= Lv[0] * x44;
        a1 -= Lv[1] * x45;
        a0 -= Lv[2] * x46;
        a1 -= Lv[3] * x47;
      }
      { const f32x4 Lv = *(const f32x4*)(L_s + 4332);
        a0 -= Lv[0] * x48;
        a1 -= Lv[1] * x49;
        a0 -= Lv[2] * x50;
        a1 -= Lv[3] * x51;
      }
      { const f32x4 Lv = *(const f32x4*)(L_s + 4336);
        a0 -= Lv[0] * x52;
        a1 -= Lv[1] * x53;
        a0 -= Lv[2] * x54;
        a1 -= Lv[3] * x55;
      }
      { const f32x4 Lv = *(const f32x4*)(L_s + 4340);
        a0 -= Lv[0] * x56;
        a1 -= Lv[1] * x57;
        a0 -= Lv[2] * x58;
        a1 -= Lv[3] * x59;
      }
      { const f32x4 Lv = *(const f32x4*)(L_s + 4344);
        a0 -= Lv[0] * x60;
        a1 -= Lv[1] * x61;
        a0 -= Lv[2] * x62;
      }
      x63 = a0 + a1; } __builtin_amdgcn_sched_barrier(0);
    __syncthreads();
    outp[0] = f2bf(sg * x0);
    outp[136] = f2bf(sg * x1);
    outp[272] = f2bf(sg * x2);
    outp[408] = f2bf(sg * x3);
    outp[544] = f2bf(sg * x4);
    outp[680] = f2bf(sg * x5);
    outp[816] = f2bf(sg * x6);
    outp[952] = f2bf(sg * x7);
    outp[1088] = f2bf(sg * x8);
    outp[1224] = f2bf(sg * x9);
    outp[1360] = f2bf(sg * x10);
    outp[1496] = f2bf(sg * x11);
    outp[1632] = f2bf(sg * x12);
    outp[1768] = f2bf(sg * x13);
    outp[1904] = f2bf(sg * x14);
    outp[2040] = f2bf(sg * x15);
    outp[2176] = f2bf(sg * x16);
    outp[2312] = f2bf(sg * x17);
    outp[2448] = f2bf(sg * x18);
    outp[2584] = f2bf(sg * x19);
    outp[2720] = f2bf(sg * x20);
    outp[2856] = f2bf(sg * x21);
    outp[2992] = f2bf(sg * x22);
    outp[3128] = f2bf(sg * x23);
    outp[3264] = f2bf(sg * x24);
    outp[3400] = f2bf(sg * x25);
    outp[3536] = f2bf(sg * x26);
    outp[3672] = f2bf(sg * x27);
    outp[3808] = f2bf(sg * x28);
    outp[3944] = f2bf(sg * x29);
    outp[4080] = f2bf(sg * x30);
    outp[4216] = f2bf(sg * x31);
    outp[4352] = f2bf(sg * x32);
    outp[4488] = f2bf(sg * x33);
    outp[4624] = f2bf(sg * x34);
    outp[4760] = f2bf(sg * x35);
    outp[4896] = f2bf(sg * x36);
    outp[5032] = f2bf(sg * x37);
    outp[5168] = f2bf(sg * x38);
    outp[5304] = f2bf(sg * x39);
    outp[5440] = f2bf(sg * x40);
    outp[5576] = f2bf(sg * x41);
    outp[5712] = f2bf(sg * x42);
    outp[5848] = f2bf(sg * x43);
    outp[5984] = f2bf(sg * x44);
    outp[6120] = f2bf(sg * x45);
    outp[6256] = f2bf(sg * x46);
    outp[6392] = f2bf(sg * x47);
    outp[6528] = f2bf(sg * x48);
    outp[6664] = f2bf(sg * x49);
    outp[6800] = f2bf(sg * x50);
    outp[6936] = f2bf(sg * x51);
    outp[7072] = f2bf(sg * x52);
    outp[7208] = f2bf(sg * x53);
    outp[7344] = f2bf(sg * x54);
    outp[7480] = f2bf(sg * x55);
    outp[7616] = f2bf(sg * x56);
    outp[7752] = f2bf(sg * x57);
    outp[7888] = f2bf(sg * x58);
    outp[8024] = f2bf(sg * x59);
    outp[8160] = f2bf(sg * x60);
    outp[8296] = f2bf(sg * x61);
    outp[8432] = f2bf(sg * x62);
    outp[8568] = f2bf(sg * x63);
}

DEV void dn_item(const Params& p, int l, int item, unsigned char* smem) {
    const int dir = item & 1, hh = (item >> 1) & 3, b = item >> 3;
    bf16_t* q_s = (bf16_t*)(smem);
    bf16_t* k_s = (bf16_t*)(smem + 17408);
    bf16_t* vnT_s = k_s;
    bf16_t* kT_s = (bf16_t*)(smem + 35840);
    bf16_t* v_s = (bf16_t*)(smem + 54272);
    bf16_t* u_s = v_s;
    float* L_s = (float*)(smem + 71680);
    bf16_t* w_s = (bf16_t*)(smem + 71680);
    bf16_t* qk_s = (bf16_t*)(smem + 89088);
    bf16_t* St_s = (bf16_t*)(smem + 98304);
    float* G_s = (float*)(smem + 133120);
    float* beta_s = G_s + 64;
    float* eG_s = G_s + 128;
    float* bw_s = G_s + 192;
    float* cw_s = G_s + 256;
    const int tid = get_tid(), lane = tid & 63, wv = tid >> 6, l15 = lane & 15, quad = lane >> 4;
    const float Aneg = -expf(p.in[I_DNALOG][(l * 2 + dir) * 4 + hh]);
    const float dtb = p.in[I_DNDT][(l * 2 + dir) * 4 + hh];
    const bf16_t* P = wsb(p, O_P);
    const float* AB = wsf(p, O_AB);
    bf16_t* TO = wsb(p, dir ? O_TA2 : O_TA);
    __syncthreads();
    for (int e = tid; e < 4 * 384; e += 256) { int j = e / 384, c = e % 384, mat = c >> 7, cc = c & 127; cw_s[e] = p.in[I_DNCONV][((size_t)l * 4 + j) * 1536 + mat * 512 + hh * 128 + cc]; }
    for (int e = tid; e < 128 * 136 / 2; e += 256) ((unsigned*)St_s)[e] = 0u;
    f32x4 Sacc[2][8];
#pragma unroll
    for (int a = 0; a < 2; ++a)
#pragma unroll
        for (int c = 0; c < 8; ++c) Sacc[a][c] = (f32x4){0.f, 0.f, 0.f, 0.f};

#pragma unroll 1
    for (int n = 0; n < 68; ++n) {
        const int c = chunk_of(dir, n);
        const int seg_lo = c < 4 ? 0 : CTXL, seg_hi = c < 4 ? CTXL : SB;
        const int base = c * 64;
        __syncthreads();
        if (wv == 0) {
            const int s = dir ? base + 63 - lane : base + lane;
            const size_t row = (size_t)b * SB + s;
            const float al = AB[row * 16 + dir * 4 + hh], bb = AB[row * 16 + 8 + dir * 4 + hh];
            float g = Aneg * softplus_fast(al + dtb);
#pragma unroll
            for (int o = 1; o < 64; o <<= 1) { float t = __shfl_up(g, o); if (lane >= o) g += t; }
            const float eg_ = expf(g), bt_ = sigm(bb); G_s[lane] = g; beta_s[lane] = bt_; eG_s[lane] = eg_; bw_s[lane] = bt_ * eg_;
        }
        __syncthreads();
        const float Glast = G_s[63];
        {
            const int i = tid >> 2, seg = tid & 3;
            const int s = dir ? base + 63 - i : base + i;
            const float kscale = expf(Glast - G_s[i]);
#pragma unroll 1
            for (int mat = 0; mat < 3; ++mat) {
                float v[32];
#pragma unroll
                for (int e = 0; e < 32; ++e) v[e] = 0.f;
#pragma unroll
                for (int j = 0; j < 4; ++j) {
                    const int ss = s + j - 1;
                    if (ss >= seg_lo && ss < seg_hi) {
                        const u32x4* src = (const u32x4*)(P + ((size_t)b * SB + ss) * PW + mat * 512 + hh * 128 + seg * 32);
                        const float* cw = cw_s + j * 384 + mat * 128 + seg * 32;
#pragma unroll
                        for (int q = 0; q < 4; ++q) { u32x4 x = src[q];
#pragma unroll
                            for (int e = 0; e < 4; ++e) { v[q * 8 + 2 * e] += cw[q * 8 + 2 * e] * lo16(x[e]); v[q * 8 + 2 * e + 1] += cw[q * 8 + 2 * e + 1] * hi16(x[e]); } }
                    }
                }
                float ss2 = 0.f;
#pragma unroll
                for (int e = 0; e < 32; ++e) { v[e] = silu(v[e]); ss2 += v[e] * v[e]; }
                ss2 += __shfl_xor(ss2, 1); ss2 += __shfl_xor(ss2, 2);
                if (mat == 0) {
                    const float sc = rsqrtf(ss2 + 1e-6f) * 0.08838834764831845f;
#pragma unroll
                    for (int e = 0; e < 32; ++e) q_s[i * 136 + seg * 32 + e] = f2bf(v[e] * sc);
                } else if (mat == 1) {
                    const float sc = rsqrtf(ss2 + 1e-6f);
#pragma unroll
                    for (int e = 0; e < 32; ++e) { const float kv = v[e] * sc; k_s[i * 136 + seg * 32 + e] = f2bf(kv); kT_s[(seg * 32 + e) * 72 + i] = f2bf(kv * kscale); }
                } else {
#pragma unroll
                    for (int e = 0; e < 32; ++e) v_s[i * 136 + seg * 32 + e] = f2bf(v[e]);
                }
            }
        }
        __syncthreads();
        {
            bf16x8 ak[4], aq[4];
#pragma unroll
            for (int ks = 0; ks < 4; ++ks) { ak[ks] = *(const bf16x8*)(k_s + (wv * 16 + l15) * 136 + ks * 32 + quad * 8); aq[ks] = *(const bf16x8*)(q_s + (wv * 16 + l15) * 136 + ks * 32 + quad * 8); }
#pragma unroll
            for (int nt = 0; nt < 4; ++nt) {
                f32x4 kk = {0.f, 0.f, 0.f, 0.f}, qq = {0.f, 0.f, 0.f, 0.f};
#pragma unroll
                for (int ks = 0; ks < 4; ++ks) { bf16x8 bk = *(const bf16x8*)(k_s + (nt * 16 + l15) * 136 + ks * 32 + quad * 8); kk = mfma16(ak[ks], bk, kk); qq = mfma16(aq[ks], bk, qq); }
                const int jj = nt * 16 + l15; const float Gj = G_s[jj];
#pragma unroll
                for (int j = 0; j < 4; ++j) {
                    const int i = wv * 16 + quad * 4 + j;
                    const float dec = jj <= i ? expf(G_s[i] - Gj) : 0.f;
                    L_s[i * 68 + jj] = jj < i ? beta_s[i] * kk[j] * dec : 0.f;
                    qk_s[i * 72 + jj] = f2bf(qq[j] * dec);
                }
            }
        }
        __syncthreads();
        dn_solve(L_s, tid < 128 ? (k_s + tid) : (v_s + (tid - 128)), tid < 128 ? bw_s : beta_s, tid < 128 ? -1.f : 1.f, tid < 128 ? (w_s + tid) : (u_s + (tid - 128)));
        __syncthreads();
        {
            f32x4 vn[8], o1[8];
#pragma unroll
            for (int nt = 0; nt < 8; ++nt) {
#pragma unroll
                for (int j = 0; j < 4; ++j) vn[nt][j] = bf2f(u_s[(wv * 16 + quad * 4 + j) * 136 + nt * 16 + l15]);
                o1[nt] = (f32x4){0.f, 0.f, 0.f, 0.f};
            }
            bf16x8 aw[4], aq[4];
#pragma unroll
            for (int ks = 0; ks < 4; ++ks) { aw[ks] = *(const bf16x8*)(w_s + (wv * 16 + l15) * 136 + ks * 32 + quad * 8); aq[ks] = *(const bf16x8*)(q_s + (wv * 16 + l15) * 136 + ks * 32 + quad * 8); }
#pragma unroll
            for (int nt = 0; nt < 8; ++nt)
#pragma unroll
                for (int ks = 0; ks < 4; ++ks) { bf16x8 bs = *(const bf16x8*)(St_s + (nt * 16 + l15) * 136 + ks * 32 + quad * 8); vn[nt] = mfma16(aw[ks], bs, vn[nt]); o1[nt] = mfma16(aq[ks], bs, o1[nt]); }
#pragma unroll
            for (int nt = 0; nt < 8; ++nt) { u32x2 o; o.x = pack2(vn[nt][0], vn[nt][1]); o.y = pack2(vn[nt][2], vn[nt][3]); *(u32x2*)(vnT_s + (nt * 16 + l15) * 72 + wv * 16 + quad * 4) = o; }
            __syncthreads();
            float eg[4];
#pragma unroll
            for (int j = 0; j < 4; ++j) eg[j] = eG_s[wv * 16 + quad * 4 + j];
            bf16x8 aqk[2], akt[2][2];
#pragma unroll
            for (int ks = 0; ks < 2; ++ks) {
                aqk[ks] = *(const bf16x8*)(qk_s + (wv * 16 + l15) * 72 + ks * 32 + quad * 8);
                akt[0][ks] = *(const bf16x8*)(kT_s + (wv * 32 + l15) * 72 + ks * 32 + quad * 8);
                akt[1][ks] = *(const bf16x8*)(kT_s + (wv * 32 + 16 + l15) * 72 + ks * 32 + quad * 8);
            }
            const float gend = eG_s[63];
            const size_t orow0 = (size_t)b * SB;
#pragma unroll
            for (int nt = 0; nt < 8; ++nt) {
                f32x4 o;
#pragma unroll
                for (int j = 0; j < 4; ++j) { o[j] = o1[nt][j] * eg[j]; Sacc[0][nt][j] *= gend; Sacc[1][nt][j] *= gend; }
#pragma unroll
                for (int ks = 0; ks < 2; ++ks) {
                    bf16x8 bv = *(const bf16x8*)(vnT_s + (nt * 16 + l15) * 72 + ks * 32 + quad * 8);
                    o = mfma16(aqk[ks], bv, o);
                    Sacc[0][nt] = mfma16(akt[0][ks], bv, Sacc[0][nt]);
                    Sacc[1][nt] = mfma16(akt[1][ks], bv, Sacc[1][nt]);
                }
#pragma unroll
                for (int j = 0; j < 4; ++j) {
                    const int i = wv * 16 + quad * 4 + j;
                    const int s = dir ? base + 63 - i : base + i;
                    TO[(orow0 + s) * 512 + hh * 128 + nt * 16 + l15] = f2bf(o[j]);
                }
#pragma unroll
                for (int mt = 0; mt < 2; ++mt) { u32x2 sv; sv.x = pack2(Sacc[mt][nt][0], Sacc[mt][nt][1]); sv.y = pack2(Sacc[mt][nt][2], Sacc[mt][nt][3]);
                    *(u32x2*)(St_s + (nt * 16 + l15) * 136 + wv * 32 + mt * 16 + quad * 4) = sv; }
            }
        }
    }
}

DEV void lru_item(const Params& p, int l, int item, unsigned char* smem) {
    const int g = item & 7, b = item >> 3;
    float* Wa_s = (float*)smem;
    float* Wi_s = Wa_s + 4096;
    float* xb_s = Wi_s + 4096;
    float* a_s = xb_s + 64 * 65;
    float* b_s = a_s + 4096;
    float* cw_s = b_s + 4096;
    const int tid = get_tid();
    bf16_t* P = wsb(p, O_P);
    bf16_t* HF = wsb(p, O_U);
    __syncthreads();
    for (int e = tid; e < 320; e += 256) cw_s[e] = e < 256 ? p.in[I_LCW][((size_t)l * 4 + (e >> 6)) * 512 + g * 64 + (e & 63)] : p.in[I_LCB][l * 512 + g * 64 + (e - 256)];
#pragma unroll 1
    for (int d = 0; d < 2; ++d) {
        __syncthreads();
        for (int e = tid; e < 4096; e += 256) {
            Wa_s[e] = p.in[I_LWA][(((size_t)l * 2 + d) * 8 + g) * 4096 + e];
            Wi_s[e] = p.in[I_LWI][(((size_t)l * 2 + d) * 8 + g) * 4096 + e];
        }
        const int i = tid >> 2, seg = tid & 3, j0 = seg * 16;
        float ba[16], bi[16], sp[16];
#pragma unroll
        for (int e = 0; e < 16; ++e) {
            const int ch = (l * 2 + d) * 512 + g * 64 + j0 + e;
            ba[e] = p.in[I_LBA][ch]; bi[e] = p.in[I_LBI][ch]; sp[e] = softplus(-p.in[I_LLAM][ch]);
        }
        float hc = 0.f;
#pragma unroll 1
        for (int n = 0; n < 68; ++n) {
            const int c = chunk_of(d, n);
            const int seg_lo = c < 4 ? 0 : CTXL, seg_hi = c < 4 ? CTXL : SB;
            const int base = c * 64;
            const int s = d ? base + 63 - i : base + i;
            {
                float v[16];
#pragma unroll
                for (int e = 0; e < 16; ++e) v[e] = cw_s[256 + j0 + e];
#pragma unroll
                for (int j = 0; j < 4; ++j) {
                    const int ss = s + j - 1;
                    if (ss >= seg_lo && ss < seg_hi) {
                        const u32x4* src = (const u32x4*)(P + ((size_t)b * SB + ss) * PW + C_LX + g * 64 + j0);
                        const float* cw = cw_s + j * 64 + j0;
#pragma unroll
                        for (int q = 0; q < 2; ++q) { u32x4 x = src[q];
#pragma unroll
                            for (int e = 0; e < 4; ++e) { v[q * 8 + 2 * e] += cw[q * 8 + 2 * e] * lo16(x[e]); v[q * 8 + 2 * e + 1] += cw[q * 8 + 2 * e + 1] * hi16(x[e]); } }
                    }
                }
#pragma unroll
                for (int e = 0; e < 16; ++e) xb_s[i * 65 + j0 + e] = v[e];
            }
            __syncthreads();
            {
                float ra[16], ia[16];
#pragma unroll
                for (int e = 0; e < 16; ++e) { ra[e] = ba[e]; ia[e] = bi[e]; }
#pragma unroll 4
                for (int ch = 0; ch < 64; ++ch) {
                    const float xv = xb_s[i * 65 + ch];
#pragma unroll
                    for (int q = 0; q < 4; ++q) {
                        const f32x4 wa = *(const f32x4*)(Wa_s + ch * 64 + j0 + q * 4), wi = *(const f32x4*)(Wi_s + ch * 64 + j0 + q * 4);
#pragma unroll
                        for (int e = 0; e < 4; ++e) { ra[q * 4 + e] += xv * wa[e]; ia[q * 4 + e] += xv * wi[e]; }
                    }
                }
#pragma unroll
                for (int e = 0; e < 16; ++e) {
                    const float r = sigm(ra[e]), ig = sigm(ia[e]);
                    const float la = -8.f * r * sp[e];
                    a_s[i * 64 + j0 + e] = expf(la);
                    b_s[i * 64 + j0 + e] = sqrtf(fmaxf(1.f - expf(2.f * la), 0.f)) * (ig * xb_s[i * 65 + j0 + e]);
                }
            }
            __syncthreads();
            if (tid < 64) {
#pragma unroll 8
                for (int r = 0; r < 64; ++r) { hc = a_s[r * 64 + tid] * hc + b_s[r * 64 + tid]; b_s[r * 64 + tid] = hc; }
            }
            __syncthreads();
            {
                const size_t row = (size_t)b * SB + s;
                bf16_t* hf = HF + row * 512 + g * 64 + j0;
                if (d == 0) {
                    u32x4 o0, o1;
#pragma unroll
                    for (int e = 0; e < 4; ++e) { o0[e] = pack2(b_s[i * 64 + j0 + 2 * e], b_s[i * 64 + j0 + 2 * e + 1]); o1[e] = pack2(b_s[i * 64 + j0 + 8 + 2 * e], b_s[i * 64 + j0 + 8 + 2 * e + 1]); }
                    *(u32x4*)hf = o0; *(u32x4*)(hf + 8) = o1;
                } else {
                    bf16_t* gp = P + row * PW + C_LG + g * 64 + j0;
                    u32x4 f0 = *(const u32x4*)hf, f1 = *(const u32x4*)(hf + 8), g0 = *(const u32x4*)gp, g1 = *(const u32x4*)(gp + 8), o0, o1;
#pragma unroll
                    for (int e = 0; e < 4; ++e) {
                        o0[e] = pack2((lo16(f0[e]) + b_s[i * 64 + j0 + 2 * e]) * gelu_tanh(lo16(g0[e])), (hi16(f0[e]) + b_s[i * 64 + j0 + 2 * e + 1]) * gelu_tanh(hi16(g0[e])));
                        o1[e] = pack2((lo16(f1[e]) + b_s[i * 64 + j0 + 8 + 2 * e]) * gelu_tanh(lo16(g1[e])), (hi16(f1[e]) + b_s[i * 64 + j0 + 8 + 2 * e + 1]) * gelu_tanh(hi16(g1[e])));
                    }
                    *(u32x4*)gp = o0; *(u32x4*)(gp + 8) = o1;
                }
            }
        }
    }
}

DEV void att_item(const Params& p, int l, int b, int h, int qt, float lam_init, unsigned char* smem) {
    bf16_t* K_s = (bf16_t*)smem;
    bf16_t* V_s = (bf16_t*)(smem + 2 * 17408);
    const int tid = get_tid(), lane = tid & 63, wv = tid >> 6, l15 = lane & 15, quad = lane >> 4;
    bf16_t* P = wsb(p, O_P);
    const bf16_t* VT = wsb(p, O_VT) + (size_t)(b * 4 + h) * 128 * SB;
    const int nt_keys = (qt < 2 ? CTXL : SB) / 64;
    float lam;
    {
        const float* lv = p.in[I_DALAM] + l * 256;
        float s1 = lv[lane] * lv[64 + lane], s2 = lv[128 + lane] * lv[192 + lane];
#pragma unroll
        for (int o = 32; o >= 1; o >>= 1) { s1 += __shfl_xor(s1, o); s2 += __shfl_xor(s2, o); }
        lam = expf(s1) - expf(s2) + lam_init;
    }
    bf16x8* Qst = (bf16x8*)(smem + 71680) + (wv * 8) * 64 + lane;
#pragma unroll
    for (int qg = 0; qg < 2; ++qg) {
        const bf16_t* qp = P + ((size_t)b * SB + qt * 128 + wv * 32 + qg * 16 + l15) * PW + C_DAQ + h * 128;
#pragma unroll
        for (int wh = 0; wh < 2; ++wh)
#pragma unroll
            for (int ks = 0; ks < 2; ++ks) Qst[(wh * 4 + qg * 2 + ks) * 64] = *(const bf16x8*)(qp + wh * 64 + ks * 32 + quad * 8);
    }
    f32x4 O[2][8][2];
    float mrun[2][2], lrun[2][2];
#pragma unroll
    for (int wh = 0; wh < 2; ++wh)
#pragma unroll
        for (int qg = 0; qg < 2; ++qg) { mrun[wh][qg] = -1e30f; lrun[wh][qg] = 0.f;
#pragma unroll
            for (int dg = 0; dg < 8; ++dg) O[wh][dg][qg] = (f32x4){0.f, 0.f, 0.f, 0.f}; }
    const int kr = tid >> 2, kseg = (tid & 3) * 32;
    const int kpos = ((kr >> 5) * 2 + ((kr & 7) >> 2)) * 16 + ((kr & 31) >> 3) * 4 + (kr & 3);
    const bf16_t* kg_ = P + ((size_t)b * SB + kr) * PW + C_DAK + h * 128 + kseg;
    const int vr = tid >> 1, vh = (tid & 1) * 32;
    const bf16_t* vg_ = VT + (size_t)vr * SB + vh;
    u32x4 kreg[4], vreg[4];
#pragma unroll
    for (int i = 0; i < 4; ++i) { kreg[i] = *(const u32x4*)(kg_ + i * 8); vreg[i] = *(const u32x4*)(vg_ + i * 8); }
    __syncthreads();
#pragma unroll
    for (int i = 0; i < 4; ++i) { *(u32x4*)(K_s + kpos * 136 + kseg + i * 8) = kreg[i]; *(u32x4*)(V_s + vr * 72 + vh + i * 8) = vreg[i]; }
    __syncthreads();
    const float L2E = 1.4426950408889634f;
#pragma unroll 1
    for (int t = 0; t < nt_keys; ++t) {
        const bf16_t* Kb = K_s + (t & 1) * (64 * 136);
        const bf16_t* Vb = V_s + (t & 1) * (128 * 72);
        if (t + 1 < nt_keys) {
#pragma unroll
            for (int i = 0; i < 4; ++i) { kreg[i] = *(const u32x4*)(kg_ + (size_t)(t + 1) * 64 * PW + i * 8); vreg[i] = *(const u32x4*)(vg_ + (t + 1) * 64 + i * 8); }
        }
#pragma unroll
        for (int wh = 0; wh < 2; ++wh) {
            f32x4 S[4][2];
#pragma unroll
            for (int kg = 0; kg < 4; ++kg) { S[kg][0] = (f32x4){0.f, 0.f, 0.f, 0.f}; S[kg][1] = (f32x4){0.f, 0.f, 0.f, 0.f}; }
#pragma unroll
            for (int ks = 0; ks < 2; ++ks)
#pragma unroll
                for (int kg = 0; kg < 4; ++kg) {
                    bf16x8 kf = *(const bf16x8*)(Kb + (kg * 16 + l15) * 136 + wh * 64 + ks * 32 + quad * 8);
                    S[kg][0] = mfma16(kf, Qst[(wh * 4 + 0 + ks) * 64], S[kg][0]);
                    S[kg][1] = mfma16(kf, Qst[(wh * 4 + 2 + ks) * 64], S[kg][1]);
                }
            bf16x8 Pf[2][2];
#pragma unroll
            for (int qg = 0; qg < 2; ++qg) {
                float mx = -1e30f;
#pragma unroll
                for (int kg = 0; kg < 4; ++kg)
#pragma unroll
                    for (int j = 0; j < 4; ++j) mx = fmaxf(mx, S[kg][qg][j]);
                mx = fmaxf(mx, __shfl_xor(mx, 16)); mx = fmaxf(mx, __shfl_xor(mx, 32));
                const float mnew = fmaxf(mrun[wh][qg], mx * L2E);
                const float alpha = __builtin_amdgcn_exp2f(mrun[wh][qg] - mnew);
                mrun[wh][qg] = mnew;
                float ps = 0.f;
#pragma unroll
                for (int kg = 0; kg < 4; ++kg)
#pragma unroll
                    for (int j = 0; j < 4; ++j) { float pv = __builtin_amdgcn_exp2f(S[kg][qg][j] * L2E - mnew); ps += pv; S[kg][qg][j] = pv; }
                lrun[wh][qg] = lrun[wh][qg] * alpha + ps;
#pragma unroll
                for (int dg = 0; dg < 8; ++dg)
#pragma unroll
                    for (int j = 0; j < 4; ++j) O[wh][dg][qg][j] *= alpha;
#pragma unroll
                for (int s_ = 0; s_ < 2; ++s_) {
                    u32x4 pk; pk[0] = pack2(S[2 * s_][qg][0], S[2 * s_][qg][1]); pk[1] = pack2(S[2 * s_][qg][2], S[2 * s_][qg][3]);
                    pk[2] = pack2(S[2 * s_ + 1][qg][0], S[2 * s_ + 1][qg][1]); pk[3] = pack2(S[2 * s_ + 1][qg][2], S[2 * s_ + 1][qg][3]);
                    Pf[qg][s_] = __builtin_bit_cast(bf16x8, pk);
                }
            }
#pragma unroll
            for (int dg = 0; dg < 8; ++dg)
#pragma unroll
                for (int s_ = 0; s_ < 2; ++s_) {
                    bf16x8 vf = *(const bf16x8*)(Vb + (dg * 16 + l15) * 72 + s_ * 32 + quad * 8);
                    O[wh][dg][0] = mfma16(vf, Pf[0][s_], O[wh][dg][0]);
                    O[wh][dg][1] = mfma16(vf, Pf[1][s_], O[wh][dg][1]);
                }
        }
        if (t + 1 < nt_keys) {
            bf16_t* Kn = K_s + ((t + 1) & 1) * (64 * 136); bf16_t* Vn = V_s + ((t + 1) & 1) * (128 * 72);
#pragma unroll
            for (int i = 0; i < 4; ++i) { *(u32x4*)(Kn + kpos * 136 + kseg + i * 8) = kreg[i]; *(u32x4*)(Vn + vr * 72 + vh + i * 8) = vreg[i]; }
        }
        __syncthreads();
    }
    const float* dnw = p.in[I_DANORM] + l * 128;
#pragma unroll
    for (int qg = 0; qg < 2; ++qg) {
        float l1 = lrun[0][qg], l2 = lrun[1][qg];
        l1 += __shfl_xor(l1, 16); l1 += __shfl_xor(l1, 32); l2 += __shfl_xor(l2, 16); l2 += __shfl_xor(l2, 32);
        const float i1 = 1.f / l1, i2 = lam / l2;
        float ss = 0.f;
#pragma unroll
        for (int dg = 0; dg < 8; ++dg)
#pragma unroll
            for (int j = 0; j < 4; ++j) { float o = O[0][dg][qg][j] * i1 - O[1][dg][qg][j] * i2; O[0][dg][qg][j] = o; ss += o * o; }
        ss += __shfl_xor(ss, 16); ss += __shfl_xor(ss, 32);
        const float rstd = rsqrtf(ss * (1.f / 128.f) + 1e-5f) * (1.f - lam_init);
        bf16_t* op = P + ((size_t)b * SB + qt * 128 + wv * 32 + qg * 16 + l15) * PW + C_DAQ + h * 128;
#pragma unroll
        for (int dg = 0; dg < 8; ++dg) {
            const int dv0 = dg * 16 + quad * 4;
            u32x2 o; o.x = pack2(O[0][dg][qg][0] * rstd * dnw[dv0], O[0][dg][qg][1] * rstd * dnw[dv0 + 1]);
            o.y = pack2(O[0][dg][qg][2] * rstd * dnw[dv0 + 2], O[0][dg][qg][3] * rstd * dnw[dv0 + 3]);
            *(u32x2*)(op + dv0) = o;
        }
    }
}

DEV void phase_mix(const Params& p, int l, unsigned char* smem) {
    const bool need_ctx = l == 0;
    const float lam_init = l == 0 ? 0.2f : 0.35550906759096926f;
    unsigned* ctr = (unsigned*)(p.ws + O_CTL) + l;
    __shared__ int s_item;
    const int nqt = need_ctx ? 34 : 32;
    const int total = 64 + 64 + 32 * nqt;
    auto next = [&]() -> int {
        __syncthreads();
        if (threadIdx.x == 0) s_item = (int)atomicAdd(ctr, 1u);
        __syncthreads();
        return __builtin_amdgcn_readfirstlane(s_item);
    };
    int it = next();
#pragma unroll 1
    while (it < 64) { dn_item(p, l, it, smem); it = next(); }
#pragma unroll 1
    while (it < 128) { lru_item(p, l, it - 64, smem); it = next(); }
#pragma unroll 1
    while (it < total) {
        const int a = it - 128, bh = a / nqt, idx = a % nqt;
        const int qt = idx < 32 ? idx + 2 : idx - 32;
        att_item(p, l, bh >> 2, bh & 3, qt, lam_init, smem);
        it = next();
    }
}

constexpr int NPHASE = 1 + 2 * 9 + 1;
DEV void run_phase(const Params& p, int ph, unsigned char* smem) {
    if (ph == 0) { phase_mod(p, smem); phase_rope(p); __syncthreads(); phase_wconv(p, 0, smem); return; }
    if (ph == NPHASE - 1) { phase_final(p); return; }
    const int l = (ph - 1) / 9, q = (ph - 1) % 9;
    const bool first = l == 0, lat = l == 1;
    const bf16_t* W = wsb(p, O_WT);
    switch (q) {
        case 0: if (l == 1) phase_wconv(p, 1, smem); phase_norm(p, l, 0, first, false); break;
        case 1: phase_g1(p, smem); break;
        case 2: phase_mix(p, l, smem); break;
        case 3: phase_fin_norm(p, l, first, lat); break;
        case 4: phase_merge(p, lat, smem); break;
        case 5: phase_resid(p, l, wsb(p, O_P), PW, W + W_OUT, 1024, 2, first, lat, smem); break;
        case 6: phase_norm(p, l, 1, false, lat); break;
        case 7: phase_gu(p, lat, smem); break;
        case 8: phase_resid(p, l, wsb(p, O_P), PW, W + W_DN, DFF, 5, false, lat, smem); break;
    }
}

#if MEGA
__global__ void __launch_bounds__(256) mega_kernel(Params p) {
    extern __shared__ __align__(16) unsigned char smem[];
    cg::grid_group grid = cg::this_grid();
    phase_mod(p, smem); phase_rope(p); __syncthreads(); phase_wconv(p, 0, smem);
    grid.sync();
    const bf16_t* W = wsb(p, O_WT);
#pragma unroll
    for (int l = 0; l < 2; ++l) {
        const bool first = l == 0, lat = l == 1;
        if (l == 1) phase_wconv(p, 1, smem);
        phase_norm(p, l, 0, first, false);
        grid.sync();
        phase_g1(p, smem);
        grid.sync();
        phase_mix(p, l, smem);
        grid.sync();
        phase_fin_norm(p, l, first, lat);
        grid.sync();
        phase_merge(p, lat, smem);
        grid.sync();
        phase_resid(p, l, wsb(p, O_P), PW, W + W_OUT, 1024, 2, first, lat, smem);
        grid.sync();
        phase_norm(p, l, 1, false, lat);
        grid.sync();
        phase_gu(p, lat, smem);
        grid.sync();
        phase_resid(p, l, wsb(p, O_P), PW, W + W_DN, DFF, 5, false, lat, smem);
        grid.sync();
    }
    phase_final(p);
}
#else
__global__ void __launch_bounds__(256) phase_kernel(Params p, int ph) {
    extern __shared__ __align__(16) unsigned char smem[];
    run_phase(p, ph, smem);
}
#endif

extern "C" void kernel_launch(void* const* d_in, const int* in_sizes, int n_in, void* d_out, int out_size, void* d_ws, size_t ws_size, hipStream_t stream) {
    static int grid = 0;
    if (grid == 0) {
        if (n_in != 28 || ws_size < WS_END) { fprintf(stderr, "kernel_launch: unexpected n_in %d or ws_size %zu < %zu\n", n_in, ws_size, (size_t)WS_END); grid = -1; return; }
        int dev = 0, cus = 0, per_cu = 0;
        hipGetDevice(&dev);
        hipDeviceGetAttribute(&cus, hipDeviceAttributeMultiprocessorCount, dev);
#if MEGA
        hipFuncSetAttribute((const void*)mega_kernel, hipFuncAttributeMaxDynamicSharedMemorySize, LDS_BYTES);
        hipOccupancyMaxActiveBlocksPerMultiprocessor(&per_cu, (const void*)mega_kernel, 256, LDS_BYTES);
#else
        hipFuncSetAttribute((const void*)phase_kernel, hipFuncAttributeMaxDynamicSharedMemorySize, LDS_BYTES);
        hipOccupancyMaxActiveBlocksPerMultiprocessor(&per_cu, (const void*)phase_kernel, 256, LDS_BYTES);
#endif
        if (per_cu < 1) per_cu = 1;
        grid = cus * per_cu;
        fprintf(stderr, "kernel_launch: grid %d (%d CUs x %d)\n", grid, cus, per_cu);
    }
    if (grid < 0) return;
    hipMemsetAsync((char*)d_ws + O_CTL, 0, 4096, stream);
    Params p{};
    for (int i = 0; i < 28; ++i) p.in[i] = (const float*)d_in[i];
    p.out = (float*)d_out; p.ws = (unsigned char*)d_ws;
#if MEGA
    void* args[] = {&p};
    hipError_t e = hipLaunchCooperativeKernel((const void*)mega_kernel, dim3(grid), dim3(256), args, LDS_BYTES, stream);
    if (e != hipSuccess) fprintf(stderr, "cooperative launch failed: %s (grid %d)\n", hipGetErrorString(e), grid);
#else
    for (int ph = 0; ph < NPHASE; ++ph) hipLaunchKernelGGL(phase_kernel, dim3(grid), dim3(256), LDS_BYTES, stream, p, ph);
#endif
}
```

```cpp
#include <hip/hip_runtime.h>
#include <hip/hip_cooperative_groups.h>
#include <cstdio>
#include <cstdint>
namespace cg = cooperative_groups;

#ifndef MEGA
#define MEGA 1
#endif

typedef unsigned short bf16_t;
typedef short bf16x8 __attribute__((ext_vector_type(8)));
typedef float f32x4 __attribute__((ext_vector_type(4)));
typedef unsigned u32x4 __attribute__((ext_vector_type(4)));
typedef unsigned u32x2 __attribute__((ext_vector_type(2)));
#define DEV __device__ __forceinline__

constexpr int D = 1024, NB = 8, SEQ = 4096, CTXL = 256, SB = 4352, MR = NB * SB, PW = 4096, DFF = 2816;
constexpr int C_DNQ = 0, C_DNK = 512, C_DNV = 1024, C_DNZ = 1536, C_LX = 2048, C_LG = 2560, C_DAQ = 3072, C_DAK = 3584;
constexpr int NIN = 4736;
constexpr int GLD = 72;

enum { I_X = 0, I_C, I_CTX, I_CCTX, I_WMOD, I_BMOD, I_NMIX, I_NFFN, I_WIN, I_DNCONV, I_DNALOG, I_DNDT, I_DNNORM, I_LCW, I_LCB,
       I_LWA, I_LBA, I_LWI, I_LBI, I_LLAM, I_DALAM, I_DANORM, I_WBR, I_WOUT, I_WFG, I_WFU, I_WFD, I_NFIN };

constexpr size_t al256(size_t x) { return (x + 255) & ~(size_t)255; }
constexpr size_t O_CTL = 0;
constexpr size_t O_MOD = 4096;
constexpr size_t O_ROPE = al256(O_MOD + (size_t)2 * 9 * 6144 * 4);
constexpr size_t O_WT = al256(O_ROPE + 64 * 16 * 2 * 4);
constexpr size_t W_IN = 0, W_GATE = W_IN + (size_t)NIN * 1024, W_BR = W_GATE + (size_t)3072 * 1024, W_OUT = W_BR + (size_t)3 * 1024 * 512,
                 W_GU = W_OUT + (size_t)1024 * 1024, W_DN = W_GU + (size_t)5632 * 1024, W_END = W_DN + (size_t)1024 * 2816;
constexpr size_t O_HCTX = al256(O_WT + W_END * 2);
constexpr size_t O_U = al256(O_HCTX + (size_t)2048 * 1024 * 4);
constexpr size_t O_P = al256(O_U + (size_t)MR * 1024 * 2);
constexpr size_t O_AB = al256(O_P + (size_t)MR * PW * 2);
constexpr size_t O_TA = al256(O_AB + (size_t)MR * 16 * 4);
constexpr size_t O_TA2 = al256(O_TA + (size_t)MR * 512 * 2);
constexpr size_t O_VT = al256(O_TA2 + (size_t)MR * 512 * 2);
constexpr size_t WS_END = al256(O_VT + (size_t)MR * 512 * 2);

constexpr int LDS_BYTES = 140 * 1024;

struct Params {
    const float* in[28];
    float* out;
    unsigned char* ws;
};

DEV int get_tid() { int t = threadIdx.x; asm volatile("" : "+v"(t)); return t; }
DEV float bf2f(bf16_t h) { return __uint_as_float(((unsigned)h) << 16); }
DEV bf16_t f2bf(float f) { unsigned u = __float_as_uint(f); u += 0x7fffu + ((u >> 16) & 1u); return (bf16_t)(u >> 16); }
DEV unsigned pack2(float a, float b) { return (unsigned)f2bf(a) | ((unsigned)f2bf(b) << 16); }
DEV float sigm(float x) { return 1.f / (1.f + __expf(-x)); }
DEV float silu(float x) { return x / (1.f + __expf(-x)); }
DEV float softplus(float x) { return x > 20.f ? x : log1pf(expf(x)); }
DEV float softplus_fast(float x) { const float e = __expf(x); return x > 15.f ? x : (e < 0.01f ? e * (1.f - e * (0.5f - e * 0.33333333f)) : __logf(1.f + e)); }
DEV float gelu_tanh(float x) { float u = 0.7978845608028654f * (x + 0.044715f * x * x * x); float t = 1.f - 2.f / (1.f + __expf(2.f * u)); return 0.5f * x * (1.f + t); }
DEV f32x4 mfma16(bf16x8 a, bf16x8 b, f32x4 c) { return __builtin_amdgcn_mfma_f32_16x16x32_bf16(a, b, c, 0, 0, 0); }
DEV void mfma16a(f32x4& c, bf16x8 a, bf16x8 b) { asm volatile("v_mfma_f32_16x16x32_bf16 %0, %1, %2, %0" : "+a"(c) : "v"(a), "v"(b)); }
DEV float lo16(unsigned v) { return __uint_as_float(v << 16); }
DEV float hi16(unsigned v) { return __uint_as_float(v & 0xffff0000u); }

DEV bf16_t* wsb(const Params& p, size_t off) { return (bf16_t*)(p.ws + off); }
DEV float* wsf(const Params& p, size_t off) { return (float*)(p.ws + off); }
DEV float* hrow(const Params& p, int r) { int b = r / SB, s = r - b * SB; return s < CTXL ? wsf(p, O_HCTX) + (size_t)(b * CTXL + s) * D : p.out + (size_t)(b * SEQ + s - CTXL) * D; }
DEV const float* xrow(const Params& p, int r) { int b = r / SB, s = r - b * SB; return s < CTXL ? p.in[I_CTX] + (size_t)(b * CTXL + s) * D : p.in[I_X] + (size_t)(b * SEQ + s - CTXL) * D; }
DEV int modrow(int r) { int b = r / SB, s = r - b * SB; return s < CTXL ? 8 : b; }

template <int MT, int NT>
DEV void gemm_core(const bf16_t* __restrict__ A, int lda, const bf16_t* __restrict__ Bt, int ldb, int K, f32x4 (&acc)[MT][NT], bf16_t* smem_) {
    constexpr int SA = 32 * MT * GLD, SBB = 32 * NT * GLD;
    bf16_t* sA = smem_; bf16_t* sB = smem_ + 2 * SA;
    const int tid = get_tid(), lane = tid & 63, wv = tid >> 6, wr = wv >> 1, wc = wv & 1, l15 = lane & 15, quad = lane >> 4;
    const int lr = tid >> 3, lc = (tid & 7) * 8;
    u32x4 ra0[MT], rb0[NT], ra1[MT], rb1[NT];
    const bf16_t* Ap = A + (size_t)lr * lda + lc;
    const bf16_t* Bp = Bt + (size_t)lr * ldb + lc;
    const int nk = K >> 6;
#define GLOAD(RA, RB, KT) { const int ko_ = (KT) * 64; _Pragma("unroll") for (int i = 0; i < MT; ++i) RA[i] = *(const u32x4*)(Ap + (size_t)(32 * i) * lda + ko_); \
                            _Pragma("unroll") for (int i = 0; i < NT; ++i) RB[i] = *(const u32x4*)(Bp + (size_t)(32 * i) * ldb + ko_); }
#define LSTORE(RA, RB, BUF) { _Pragma("unroll") for (int i = 0; i < MT; ++i) *(u32x4*)(sA + (BUF) * SA + (lr + 32 * i) * GLD + lc) = RA[i]; \
                              _Pragma("unroll") for (int i = 0; i < NT; ++i) *(u32x4*)(sB + (BUF) * SBB + (lr + 32 * i) * GLD + lc) = RB[i]; }
#define COMPUTE(BUF) { _Pragma("unroll") for (int ks = 0; ks < 2; ++ks) { bf16x8 af[MT], bfr[NT]; \
        _Pragma("unroll") for (int mt = 0; mt < MT; ++mt) af[mt] = *(const bf16x8*)(sA + (BUF) * SA + (wr * MT * 16 + mt * 16 + l15) * GLD + ks * 32 + quad * 8); \
        _Pragma("unroll") for (int nt = 0; nt < NT; ++nt) bfr[nt] = *(const bf16x8*)(sB + (BUF) * SBB + (wc * NT * 16 + nt * 16 + l15) * GLD + ks * 32 + quad * 8); \
        _Pragma("unroll") for (int mt = 0; mt < MT; ++mt) _Pragma("unroll") for (int nt = 0; nt < NT; ++nt) mfma16a(acc[mt][nt], af[mt], bfr[nt]); } }
    GLOAD(ra0, rb0, 0);
    GLOAD(ra1, rb1, 1);
    __syncthreads();
    LSTORE(ra0, rb0, 0);
    GLOAD(ra0, rb0, 2);
    __syncthreads();
#pragma unroll 1
    for (int kt = 0; kt < nk; kt += 2) {
        COMPUTE(0);
        if (kt + 1 < nk) LSTORE(ra1, rb1, 1);
        if (kt + 3 < nk) GLOAD(ra1, rb1, kt + 3);
        __syncthreads();
        COMPUTE(1);
        if (kt + 2 < nk) LSTORE(ra0, rb0, 0);
        if (kt + 4 < nk) GLOAD(ra0, rb0, kt + 4);
        __syncthreads();
    }
#undef GLOAD
#undef LSTORE
#undef COMPUTE
    asm volatile("s_nop 15\n\ts_nop 15" ::: "memory");
}
template <int MT, int NT>
DEV void gemm_core1(const bf16_t* __restrict__ A, int lda, const bf16_t* __restrict__ Bt, int ldb, int K, f32x4 (&acc)[MT][NT], bf16_t* sA, bf16_t* sB) {
    const int tid = get_tid(), lane = tid & 63, wv = tid >> 6, wr = wv >> 1, wc = wv & 1, l15 = lane & 15, quad = lane >> 4;
    const int lr = tid >> 3, lc = (tid & 7) * 8;
    u32x4 ra[MT], rb[NT];
    const bf16_t* Ap = A + (size_t)lr * lda + lc;
    const bf16_t* Bp = Bt + (size_t)lr * ldb + lc;
#pragma unroll
    for (int i = 0; i < MT; ++i) ra[i] = *(const u32x4*)(Ap + (size_t)(32 * i) * lda);
#pragma unroll
    for (int i = 0; i < NT; ++i) rb[i] = *(const u32x4*)(Bp + (size_t)(32 * i) * ldb);
    const int nk = K >> 6;
    for (int kt = 0; kt < nk; ++kt) {
        __syncthreads();
#pragma unroll
        for (int i = 0; i < MT; ++i) *(u32x4*)(sA + (lr + 32 * i) * GLD + lc) = ra[i];
#pragma unroll
        for (int i = 0; i < NT; ++i) *(u32x4*)(sB + (lr + 32 * i) * GLD + lc) = rb[i];
        __syncthreads();
        if (kt + 1 < nk) {
            const int ko = (kt + 1) * 64;
#pragma unroll
            for (int i = 0; i < MT; ++i) ra[i] = *(const u32x4*)(Ap + (size_t)(32 * i) * lda + ko);
#pragma unroll
            for (int i = 0; i < NT; ++i) rb[i] = *(const u32x4*)(Bp + (size_t)(32 * i) * ldb + ko);
        }
#pragma unroll
        for (int ks = 0; ks < 2; ++ks) {
            bf16x8 af[MT], bfr[NT];
#pragma unroll
            for (int mt = 0; mt < MT; ++mt) af[mt] = *(const bf16x8*)(sA + (wr * MT * 16 + mt * 16 + l15) * GLD + ks * 32 + quad * 8);
#pragma unroll
            for (int nt = 0; nt < NT; ++nt) bfr[nt] = *(const bf16x8*)(sB + (wc * NT * 16 + nt * 16 + l15) * GLD + ks * 32 + quad * 8);
#pragma unroll
            for (int mt = 0; mt < MT; ++mt)
#pragma unroll
                for (int nt = 0; nt < NT; ++nt) mfma16a(acc[mt][nt], af[mt], bfr[nt]);
        }
    }
    asm volatile("s_nop 15\n\ts_nop 15" ::: "memory");
}
template <int MT, int NT>
DEV void zero_acc(f32x4 (&acc)[MT][NT]) {
#pragma unroll
    for (int mt = 0; mt < MT; ++mt)
#pragma unroll
        for (int nt = 0; nt < NT; ++nt) acc[mt][nt] = (f32x4){0.f, 0.f, 0.f, 0.f};
}

DEV void phase_mod(const Params& p, unsigned char* smem) {
    float* s_s = (float*)smem;
    float* red = s_s + 9 * 1024;
    const int tid = get_tid();
    bool loaded = false;
    for (int it = blockIdx.x; it < 2 * 96; it += gridDim.x) {
        if (!loaded) {
            for (int e = tid; e < 9 * 1024; e += 256) { float v = e < 8192 ? p.in[I_C][e] : p.in[I_CCTX][e - 8192]; s_s[e] = silu(v); }
            loaded = true;
        }
        __syncthreads();
        const int l = it / 96, cg_ = it % 96, cq = tid & 63, kq = tid >> 6, col = cg_ * 64 + cq;
        float acc[9];
#pragma unroll
        for (int r = 0; r < 9; ++r) acc[r] = 0.f;
        const float* wp = p.in[I_WMOD] + ((size_t)l * 1024 + kq * 256) * 6144 + col;
#pragma unroll 8
        for (int k = 0; k < 256; ++k) {
            float wv = wp[(size_t)k * 6144];
#pragma unroll
            for (int r = 0; r < 9; ++r) acc[r] += s_s[r * 1024 + kq * 256 + k] * wv;
        }
#pragma unroll
        for (int r = 0; r < 9; ++r) red[(kq * 9 + r) * 64 + cq] = acc[r];
        __syncthreads();
        for (int e = tid; e < 9 * 64; e += 256) {
            int r = e >> 6, c2 = e & 63;
            float v = red[(0 * 9 + r) * 64 + c2] + red[(1 * 9 + r) * 64 + c2] + red[(2 * 9 + r) * 64 + c2] + red[(3 * 9 + r) * 64 + c2];
            wsf(p, O_MOD)[((size_t)l * 9 + r) * 6144 + cg_ * 64 + c2] = v + p.in[I_BMOD][l * 6144 + cg_ * 64 + c2];
        }
        __syncthreads();
    }
}
DEV void phase_rope(const Params& p) {
    if (blockIdx.x == (gridDim.x - 1)) {
        for (int e = threadIdx.x; e < 1024; e += 256) {
            int pos = e >> 4, i = e & 15;
            float inv = powf(10000.f, -(float)i / 16.f);
            float ang = (float)pos * inv;
            float n = rintf(ang * 0.15915494309189535f);
            float r = fmaf(-n, 6.28125f, ang);
            r = fmaf(-n, 1.9353071795864769e-3f, r);
            wsf(p, O_ROPE)[e * 2] = cosf(r);
            wsf(p, O_ROPE)[e * 2 + 1] = sinf(r);
        }
    }
}
DEV void wconv_tile(const float* src0, const float* src1, int lds_, int K, bf16_t* dst, int kind, int kt, int nt, bf16_t* tile) {
    const int tid = get_tid();
    const int kk = tid >> 2, grp = tid & 3;
    const int n0 = nt * 64, k0 = kt * 64;
    const int ng = n0 + grp * 16;
    const float* src = src0; int sc;
    if (kind == 0) { sc = ng < 2048 ? ng : (ng < 4608 ? ng + 16 : (ng < 4624 ? 2048 : -1)); }
    else if (kind == 1) { sc = 4624 + ng; }
    else if (kind == 2) { sc = ng; }
    else { int gd = ng >> 4; src = (gd & 1) ? src1 : src0; sc = (gd >> 1) * 16; }
    __syncthreads();
    if (sc >= 0) {
        const float4* sp = (const float4*)(src + (size_t)(k0 + kk) * lds_ + sc);
#pragma unroll
        for (int q = 0; q < 4; ++q) { float4 v = sp[q]; int e = grp * 16 + q * 4;
            tile[(e + 0) * GLD + kk] = f2bf(v.x); tile[(e + 1) * GLD + kk] = f2bf(v.y); tile[(e + 2) * GLD + kk] = f2bf(v.z); tile[(e + 3) * GLD + kk] = f2bf(v.w); }
    } else {
#pragma unroll
        for (int e = 0; e < 16; ++e) tile[(grp * 16 + e) * GLD + kk] = 0;
    }
    __syncthreads();
    const int n = tid >> 2, kseg = (tid & 3) * 16;
    u32x4 a = *(const u32x4*)(tile + n * GLD + kseg), b = *(const u32x4*)(tile + n * GLD + kseg + 8);
    bf16_t* dp = dst + (size_t)(n0 + n) * K + k0 + kseg;
    *(u32x4*)dp = a; *(u32x4*)(dp + 8) = b;
}
DEV void phase_wconv(const Params& p, int l, unsigned char* smem) {
    bf16_t* tile = (bf16_t*)smem;
    bf16_t* W = wsb(p, O_WT);
    constexpr int T0 = 74 * 16, T1 = T0 + 48 * 16, T2 = T1 + 3 * 16 * 8, T3 = T2 + 16 * 16, T4 = T3 + 88 * 16, T5 = T4 + 16 * 44;
    for (int t = blockIdx.x; t < T5; t += gridDim.x) {
        if (t < T0) { wconv_tile(p.in[I_WIN] + (size_t)l * 1024 * 7696, nullptr, 7696, 1024, W + W_IN, 0, t % 16, t / 16, tile); }
        else if (t < T1) { int u = t - T0; wconv_tile(p.in[I_WIN] + (size_t)l * 1024 * 7696, nullptr, 7696, 1024, W + W_GATE, 1, u % 16, u / 16, tile); }
        else if (t < T2) { int u = t - T1; int n = u / 128, v = u % 128; wconv_tile(p.in[I_WBR] + ((size_t)l * 3 + n) * 512 * 1024, nullptr, 1024, 512, W + W_BR + (size_t)n * 1024 * 512, 2, v % 8, v / 8, tile); }
        else if (t < T3) { int u = t - T2; wconv_tile(p.in[I_WOUT] + (size_t)l * 1024 * 1024, nullptr, 1024, 1024, W + W_OUT, 2, u % 16, u / 16, tile); }
        else if (t < T4) { int u = t - T3; wconv_tile(p.in[I_WFG] + (size_t)l * 1024 * DFF, p.in[I_WFU] + (size_t)l * 1024 * DFF, DFF, 1024, W + W_GU, 3, u % 16, u / 16, tile); }
        else { int u = t - T4; wconv_tile(p.in[I_WFD] + (size_t)l * DFF * 1024, nullptr, 1024, DFF, W + W_DN, 2, u % 44, u / 44, tile); }
    }
}

DEV void norm_row(const Params& p, int l, int which, bool first, int r, int lane) {
    const float* h = first ? xrow(p, r) : hrow(p, r);
    const float* nw = p.in[which ? I_NFFN : I_NMIX] + l * D;
    const float* md = wsf(p, O_MOD) + ((size_t)l * 9 + modrow(r)) * 6144 + (which ? 3 * D : 0);
    float4 v[4]; float ss = 0.f;
#pragma unroll
    for (int i = 0; i < 4; ++i) { v[i] = *(const float4*)(h + i * 256 + lane * 4); ss += v[i].x * v[i].x + v[i].y * v[i].y + v[i].z * v[i].z + v[i].w * v[i].w; }
#pragma unroll
    for (int o = 32; o >= 1; o >>= 1) ss += __shfl_xor(ss, o);
    const float rstd = rsqrtf(ss * (1.f / D) + 1e-6f);
    bf16_t* up = wsb(p, O_U) + (size_t)r * D;
#pragma unroll
    for (int i = 0; i < 4; ++i) {
        const int c = i * 256 + lane * 4;
        float4 w4 = *(const float4*)(nw + c), sh = *(const float4*)(md + c), sc = *(const float4*)(md + D + c);
        float a = v[i].x * rstd * w4.x * (1.f + sc.x) + sh.x, b = v[i].y * rstd * w4.y * (1.f + sc.y) + sh.y;
        float c2 = v[i].z * rstd * w4.z * (1.f + sc.z) + sh.z, d = v[i].w * rstd * w4.w * (1.f + sc.w) + sh.w;
        u32x2 o; o.x = pack2(a, b); o.y = pack2(c2, d);
        *(u32x2*)(up + c) = o;
    }
}
DEV void phase_norm(const Params& p, int l, int which, bool first, bool skip_ctx) {
    const int tid_ = get_tid(); const int lane = tid_ & 63, wv = tid_ >> 6;
    for (int r = blockIdx.x * 4 + wv; r < MR; r += gridDim.x * 4) {
        if (skip_ctx && (r % SB) < CTXL) continue;
        norm_row(p, l, which, first, r, lane);
    }
}
DEV void phase_fin_norm(const Params& p, int l, bool first, bool skip_ctx) {
    const int tid_ = get_tid(); const int lane = tid_ & 63, wv = tid_ >> 6;
    const float* dnn = p.in[I_DNNORM] + l * 128;
    for (int r = blockIdx.x * 4 + wv; r < MR; r += gridDim.x * 4) {
        if (skip_ctx && (r % SB) < CTXL) continue;
        norm_row(p, l, 0, first, r, lane);
        bf16_t* ta = wsb(p, O_TA) + (size_t)r * 512 + lane * 8;
        const bf16_t* tb = wsb(p, O_TA2) + (size_t)r * 512 + lane * 8;
        const bf16_t* zz = wsb(p, O_P) + (size_t)r * PW + C_DNZ + lane * 8;
        u32x4 a = *(const u32x4*)ta, b = *(const u32x4*)tb, z = *(const u32x4*)zz;
        float o[8]; float ss = 0.f;
#pragma unroll
        for (int i = 0; i < 4; ++i) { o[2 * i] = lo16(a[i]) + lo16(b[i]); o[2 * i + 1] = hi16(a[i]) + hi16(b[i]); ss += o[2 * i] * o[2 * i] + o[2 * i + 1] * o[2 * i + 1]; }
#pragma unroll
        for (int of = 8; of >= 1; of >>= 1) ss += __shfl_xor(ss, of);
        const float rstd = rsqrtf(ss * (1.f / 128.f) + 1e-6f);
        const int dv0 = (lane & 15) * 8;
        u32x4 y;
#pragma unroll
        for (int i = 0; i < 4; ++i) {
            float y0 = o[2 * i] * rstd * dnn[dv0 + 2 * i] * silu(lo16(z[i]));
            float y1 = o[2 * i + 1] * rstd * dnn[dv0 + 2 * i + 1] * silu(hi16(z[i]));
            y[i] = pack2(y0, y1);
        }
        *(u32x4*)ta = y;
    }
}
DEV void phase_final(const Params& p) {
    const int tid_ = get_tid(); const int lane = tid_ & 63, wv = tid_ >> 6;
    const float* nw = p.in[I_NFIN];
    for (int r = blockIdx.x * 4 + wv; r < NB * SEQ; r += gridDim.x * 4) {
        float* h = p.out + (size_t)r * D;
        float4 v[4]; float ss = 0.f;
#pragma unroll
        for (int i = 0; i < 4; ++i) { v[i] = *(const float4*)(h + i * 256 + lane * 4); ss += v[i].x * v[i].x + v[i].y * v[i].y + v[i].z * v[i].z + v[i].w * v[i].w; }
#pragma unroll
        for (int o = 32; o >= 1; o >>= 1) ss += __shfl_xor(ss, o);
        const float rstd = rsqrtf(ss * (1.f / D) + 1e-6f);
#pragma unroll
        for (int i = 0; i < 4; ++i) {
            const int c = i * 256 + lane * 4;
            float4 w4 = *(const float4*)(nw + c);
            float4 o4; o4.x = v[i].x * rstd * w4.x; o4.y = v[i].y * rstd * w4.y; o4.z = v[i].z * rstd * w4.z; o4.w = v[i].w * rstd * w4.w;
            *(float4*)(h + c) = o4;
        }
    }
}

struct TileIter {
    int nn, total, nloc, L;
    DEV TileIter(int nm, int nn_) { nn = nn_; total = nm * nn_; nloc = gridDim.x >> 3; L = (blockIdx.x & 7) * nloc + (blockIdx.x >> 3); }
    DEV bool valid() const { return L < total; }
    DEV bool more() const { return (L - (int)(blockIdx.x >> 3)) < total; }
    DEV void next() { L += 8 * nloc; }
    DEV void get(int& tm, int& tn) const { const int pn = 4 * nn, panel = L / pn, rem = L - panel * pn; tn = rem >> 2; tm = panel * 4 + (rem & 3); }
};
DEV void phase_g1(const Params& p, unsigned char* smem) {
    bf16_t* sA = (bf16_t*)smem;
    const int tid = get_tid(), lane = tid & 63, wv = tid >> 6, wr = wv >> 1, wc = wv & 1, l15 = lane & 15, quad = lane >> 4;
    const bf16_t* U = wsb(p, O_U); const bf16_t* W = wsb(p, O_WT) + W_IN;
    bf16_t* P = wsb(p, O_P);
    const float* rope = wsf(p, O_ROPE);
    constexpr int NTN = NIN / 128;
    for (TileIter ti(MR / 256, NTN); ti.valid(); ti.next()) {
        int tm, tn; ti.get(tm, tn);
        const int row0 = tm * 256, col0 = tn * 128;
        f32x4 acc[8][4]; zero_acc(acc);
        gemm_core<8, 4>(U + (size_t)row0 * D, D, W + (size_t)col0 * D, D, D, acc, sA);
        if (tn < 24) {
#pragma unroll
            for (int mt = 0; mt < 8; ++mt)
#pragma unroll
                for (int nt = 0; nt < 4; ++nt)
#pragma unroll
                    for (int j = 0; j < 4; ++j) {
                        if (nt == 0 && j == 0) __builtin_amdgcn_sched_barrier(0);
                        const int row = row0 + wr * 128 + mt * 16 + quad * 4 + j, col = col0 + wc * 64 + nt * 16 + l15;
                        P[(size_t)row * PW + col] = f2bf(acc[mt][nt][j]);
                    }
        } else if (tn < 32) {
            const float qs = tn < 28 ? 0.125f : 1.f;
#pragma unroll
            for (int mt = 0; mt < 8; ++mt)
#pragma unroll
                for (int j = 0; j < 4; ++j) {
                    if (j == 0) __builtin_amdgcn_sched_barrier(0);
                    const int row = row0 + wr * 128 + mt * 16 + quad * 4 + j;
                    const int s = row % SB;
                    float c0 = 1.f, s0 = 0.f, c1 = 1.f, s1 = 0.f;
                    if (s >= CTXL) { const int tt = s - CTXL, pr = tt >> 6, pc = tt & 63;
                        c0 = rope[(pr * 16 + l15) * 2]; s0 = rope[(pr * 16 + l15) * 2 + 1]; c1 = rope[(pc * 16 + l15) * 2]; s1 = rope[(pc * 16 + l15) * 2 + 1]; }
                    const float x1 = acc[mt][0][j], x2 = acc[mt][1][j], y1 = acc[mt][2][j], y2 = acc[mt][3][j];
                    bf16_t* pp = P + (size_t)row * PW + col0 + wc * 64 + l15;
                    pp[0] = f2bf((x1 * c0 - x2 * s0) * qs);
                    pp[16] = f2bf((x2 * c0 + x1 * s0) * qs);
                    pp[32] = f2bf((y1 * c1 - y2 * s1) * qs);
                    pp[48] = f2bf((y2 * c1 + y1 * s1) * qs);
                }
        } else if (tn < 36) {
            bf16_t* VT = wsb(p, O_VT);
            const int b = row0 / SB, sbase = row0 - b * SB;
#pragma unroll
            for (int mt = 0; mt < 8; ++mt)
#pragma unroll
                for (int nt = 0; nt < 4; ++nt) {
                    if (nt == 0) __builtin_amdgcn_sched_barrier(0);
                    const int cc = col0 - 4096 + wc * 64 + nt * 16 + l15;
                    const int s = sbase + wr * 128 + mt * 16 + quad * 4;
                    u32x2 o; o.x = pack2(acc[mt][nt][0], acc[mt][nt][1]); o.y = pack2(acc[mt][nt][2], acc[mt][nt][3]);
                    *(u32x2*)(VT + ((size_t)(b * 512 + cc)) * SB + s) = o;
                }
        } else {
            if (wc == 0) {
                float* AB = wsf(p, O_AB);
#pragma unroll
                for (int mt = 0; mt < 8; ++mt)
#pragma unroll
                    for (int j = 0; j < 4; ++j) {
                        const int row = row0 + wr * 128 + mt * 16 + quad * 4 + j;
                        AB[(size_t)row * 16 + l15] = acc[mt][0][j];
                    }
            }
        }
    }
}

DEV int rowtile0(int ti, bool latent_only) { if (!latent_only) return ti * 256; int b = ti >> 4, tt = ti & 15; return b * SB + CTXL + tt * 256; }
DEV int sgcol(int n, int c) { return n < 2 ? n * 1024 + c : (c < 512 ? 2048 + c : 3584 + (c - 512)); }

DEV void phase_gate(const Params& p, bool latent_only, unsigned char* smem) {
    bf16_t* sA = (bf16_t*)smem;
    const int tid = get_tid(), lane = tid & 63, wv = tid >> 6, wr = wv >> 1, wc = wv & 1, l15 = lane & 15, quad = lane >> 4;
    const bf16_t* U = wsb(p, O_U); const bf16_t* W = wsb(p, O_WT) + W_GATE;
    bf16_t* P = wsb(p, O_P);
    const int nrt = latent_only ? 128 : 136;
    for (TileIter ti(nrt, 24); ti.valid(); ti.next()) {
        int tm, tn; ti.get(tm, tn);
        const int row0 = rowtile0(tm, latent_only);
        f32x4 acc[8][4]; zero_acc(acc);
        gemm_core<8, 4>(U + (size_t)row0 * D, D, W + (size_t)tn * 128 * D, D, D, acc, sA);
        const int dcol0 = sgcol(tn >> 3, (tn & 7) * 128);
#pragma unroll
        for (int mt = 0; mt < 8; ++mt)
#pragma unroll
            for (int nt = 0; nt < 4; ++nt)
#pragma unroll
                for (int j = 0; j < 4; ++j) {
                    if (nt == 0 && j == 0) __builtin_amdgcn_sched_barrier(0);
                    const int row = row0 + wr * 128 + mt * 16 + quad * 4 + j, col = dcol0 + wc * 64 + nt * 16 + l15;
                    P[(size_t)row * PW + col] = f2bf(sigm(acc[mt][nt][j]));
                }
    }
}

DEV void phase_merge(const Params& p, bool latent_only, unsigned char* smem) {
    bf16_t* sA = (bf16_t*)smem;
    const int tid = get_tid(), lane = tid & 63, wv = tid >> 6, wr = wv >> 1, wc = wv & 1, l15 = lane & 15, quad = lane >> 4;
    const bf16_t* W = wsb(p, O_WT);
    const bf16_t* P = wsb(p, O_P);
    bf16_t* U = wsb(p, O_U);
    const int nrt = latent_only ? 128 : 136;
    for (TileIter ti(nrt, 8); ti.valid(); ti.next()) {
        int tm, tn; ti.get(tm, tn);
        const int row0 = rowtile0(tm, latent_only), col0 = tn * 128;
        f32x4 m[8][4]; zero_acc(m);
#pragma unroll 1
        for (int n = 0; n < 3; ++n) {
            f32x4 au[8][4]; zero_acc(au);
            const bf16_t* Y; int ldy;
            if (n == 0) { Y = wsb(p, O_TA) + (size_t)row0 * 512; ldy = 512; }
            else if (n == 1) { Y = P + (size_t)row0 * PW + C_LG; ldy = PW; }
            else { Y = P + (size_t)row0 * PW + C_DAQ; ldy = PW; }
            gemm_core1<8, 4>(Y, ldy, W + W_BR + ((size_t)n * 1024 + col0) * 512, 512, 512, au, sA, sA + 256 * GLD);
            const int sc0 = sgcol(n, col0);
#pragma unroll
            for (int mt = 0; mt < 8; ++mt)
#pragma unroll
                for (int nt = 0; nt < 4; ++nt)
#pragma unroll
                    for (int j = 0; j < 4; ++j) {
                        if (nt == 0 && j == 0) __builtin_amdgcn_sched_barrier(0);
                        const int row = row0 + wr * 128 + mt * 16 + quad * 4 + j, col = sc0 + wc * 64 + nt * 16 + l15;
                        m[mt][nt][j] += bf2f(P[(size_t)row * PW + col]) * au[mt][nt][j];
                    }
        }
#pragma unroll
        for (int mt = 0; mt < 8; ++mt)
#pragma unroll
            for (int nt = 0; nt < 4; ++nt)
#pragma unroll
                for (int j = 0; j < 4; ++j) {
                    if (nt == 0 && j == 0) __builtin_amdgcn_sched_barrier(0);
                    const int row = row0 + wr * 128 + mt * 16 + quad * 4 + j, col = col0 + wc * 64 + nt * 16 + l15;
                    U[(size_t)row * D + col] = f2bf(m[mt][nt][j]);
                }
    }
}

DEV void phase_resid(const Params& p, int l, const bf16_t* A, int lda, const bf16_t* Wt, int K, int chunk, bool first, bool latent_only, unsigned char* smem) {
    bf16_t* sA = (bf16_t*)smem;
    const int tid = get_tid(), lane = tid & 63, wv = tid >> 6, wr = wv >> 1, wc = wv & 1, l15 = lane & 15, quad = lane >> 4;
    const int nrt = latent_only ? 128 : 136;
    for (TileIter ti(nrt, 8); ti.valid(); ti.next()) {
        int tm, tn; ti.get(tm, tn);
        const int row0 = rowtile0(tm, latent_only), col0 = tn * 128;
        f32x4 acc[8][4]; zero_acc(acc);
        gemm_core<8, 4>(A + (size_t)row0 * lda, lda, Wt + (size_t)col0 * K, K, K, acc, sA);
        const float* md = wsf(p, O_MOD) + ((size_t)l * 9 + modrow(row0)) * 6144 + chunk * D;
#pragma unroll
        for (int mt = 0; mt < 8; ++mt)
#pragma unroll
            for (int j = 0; j < 4; ++j) {
                if (j == 0) __builtin_amdgcn_sched_barrier(0);
                const int row = row0 + wr * 128 + mt * 16 + quad * 4 + j;
                const float* hs = first ? xrow(p, row) : hrow(p, row);
                float* hd = hrow(p, row);
#pragma unroll
                for (int nt = 0; nt < 4; ++nt) { const int col = col0 + wc * 64 + nt * 16 + l15; hd[col] = hs[col] + md[col] * acc[mt][nt][j]; }
            }
    }
}
DEV void phase_gu(const Params& p, bool latent_only, unsigned char* smem) {
    bf16_t* sA = (bf16_t*)smem;
    const int tid = get_tid(), lane = tid & 63, wv = tid >> 6, wr = wv >> 1, wc = wv & 1, l15 = lane & 15, quad = lane >> 4;
    const bf16_t* U = wsb(p, O_U); const bf16_t* W = wsb(p, O_WT) + W_GU;
    bf16_t* P = wsb(p, O_P);
    const int nrt = latent_only ? 128 : 136;
    for (TileIter ti(nrt, 44); ti.valid(); ti.next()) {
        int tm, tn; ti.get(tm, tn);
        const int row0 = rowtile0(tm, latent_only);
        f32x4 acc[8][4]; zero_acc(acc);
        gemm_core<8, 4>(U + (size_t)row0 * D, D, W + (size_t)tn * 128 * D, D, D, acc, sA);
#pragma unroll
        for (int mt = 0; mt < 8; ++mt)
#pragma unroll
            for (int pr = 0; pr < 2; ++pr)
#pragma unroll
                for (int j = 0; j < 4; ++j) {
                    if (pr == 0 && j == 0) __builtin_amdgcn_sched_barrier(0);
                    const int row = row0 + wr * 128 + mt * 16 + quad * 4 + j, hc = (tn * 4 + wc * 2 + pr) * 16 + l15;
                    P[(size_t)row * PW + hc] = f2bf(silu(acc[mt][2 * pr][j]) * acc[mt][2 * pr + 1][j]);
                }
    }
}

DEV int chunk_of(int dir, int n) { return dir ? (n < 4 ? 3 - n : 71 - n) : n; }

DEV void dn_solve(const float* __restrict__ L_s, const bf16_t* __restrict__ colp, const float* __restrict__ mulp, const float sg, bf16_t* __restrict__ outp) {
    float x0, x1, x2, x3, x4, x5, x6, x7, x8, x9, x10, x11, x12, x13, x14, x15, x16, x17, x18, x19, x20, x21, x22, x23, x24, x25, x26, x27, x28, x29, x30, x31, x32, x33, x34, x35, x36, x37, x38, x39, x40, x41, x42, x43, x44, x45, x46, x47, x48, x49, x50, x51, x52, x53, x54, x55, x56, x57, x58, x59, x60, x61, x62, x63;
    { float a0 = bf2f(colp[0]) * mulp[0]; float a1 = 0.f;
      x0 = a0 + a1; }
    { float a0 = bf2f(colp[136]) * mulp[1]; float a1 = 0.f;
      { const f32x4 Lv = *(const f32x4*)(L_s + 68);
        a0 -= Lv[0] * x0;
      }
      x1 = a0 + a1; } __builtin_amdgcn_sched_barrier(0);
    { float a0 = bf2f(colp[272]) * mulp[2]; float a1 = 0.f;
      { const f32x4 Lv = *(const f32x4*)(L_s + 136);
        a0 -= Lv[0] * x0;
        a1 -= Lv[1] * x1;
      }
      x2 = a0 + a1; }
    { float a0 = bf2f(colp[408]) * mulp[3]; float a1 = 0.f;
      { const f32x4 Lv = *(const f32x4*)(L_s + 204);
        a0 -= Lv[0] * x0;
        a1 -= Lv[1] * x1;
        a0 -= Lv[2] * x2;
      }
      x3 = a0 + a1; } __builtin_amdgcn_sched_barrier(0);
    { float a0 = bf2f(colp[544]) * mulp[4]; float a1 = 0.f;
      { const f32x4 Lv = *(const f32x4*)(L_s + 272);
        a0 -= Lv[0] * x0;
        a1 -= Lv[1] * x1;
        a0 -= Lv[2] * x2;
        a1 -= Lv[3] * x3;
      }
      x4 = a0 + a1; }
    { float a0 = bf2f(colp[680]) * mulp[5]; float a1 = 0.f;
      { const f32x4 Lv = *(const f32x4*)(L_s + 340);
        a0 -= Lv[0] * x0;
        a1 -= Lv[1] * x1;
        a0 -= Lv[2] * x2;
        a1 -= Lv[3] * x3;
      }
      { const f32x4 Lv = *(const f32x4*)(L_s + 344);
        a0 -= Lv[0] * x4;
      }
      x5 = a0 + a1; } __builtin_amdgcn_sched_barrier(0);
    { float a0 = bf2f(colp[816]) * mulp[6]; float a1 = 0.f;
      { const f32x4 Lv = *(const f32x4*)(L_s + 408);
        a0 -= Lv[0] * x0;
        a1 -= Lv[1] * x1;
        a0 -= Lv[2] * x2;
        a1 -= Lv[3] * x3;
      }
      { const f32x4 Lv = *(const f32x4*)(L_s + 412);
        a0 -= Lv[0] * x4;
        a1 -= Lv[1] * x5;
      }
      x6 = a0 + a1; }
    { float a0 = bf2f(colp[952]) * mulp[7]; float a1 = 0.f;
      { const f32x4 Lv = *(const f32x4*)(L_s + 476);
        a0 -= Lv[0] * x0;
        a1 -= Lv[1] * x1;
        a0 -= Lv[2] * x2;
        a1 -= Lv[3] * x3;
      }
      { const f32x4 Lv = *(const f32x4*)(L_s + 480);
        a0 -= Lv[0] * x4;
        a1 -= Lv[1] * x5;
        a0 -= Lv[2] * x6;
      }
      x7 = a0 + a1; } __builtin_amdgcn_sched_barrier(0);
    { float a0 = bf2f(colp[1088]) * mulp[8]; float a1 = 0.f;
      { const f32x4 Lv = *(const f32x4*)(L_s + 544);
        a0 -= Lv[0] * x0;
        a1 -= Lv[1] * x1;
        a0 -= Lv[2] * x2;
        a1 -= Lv[3] * x3;
      }
      { const f32x4 Lv = *(const f32x4*)(L_s + 548);
        a0 -= Lv[0] * x4;
        a1 -= Lv[1] * x5;
        a0 -= Lv[2] * x6;
        a1 -= Lv[3] * x7;
      }
      x8 = a0 + a1; }
    { float a0 = bf2f(colp[1224]) * mulp[9]; float a1 = 0.f;
      { const f32x4 Lv = *(const f32x4*)(L_s + 612);
        a0 -= Lv[0] * x0;
        a1 -= Lv[1] * x1;
        a0 -= Lv[2] * x2;
        a1 -= Lv[3] * x3;
      }
      { const f32x4 Lv = *(const f32x4*)(L_s + 616);
        a0 -= Lv[0] * x4;
        a1 -= Lv[1] * x5;
        a0 -= Lv[2] * x6;
        a1 -= Lv[3] * x7;
      }
      { const f32x4 Lv = *(const f32x4*)(L_s + 620);
        a0 -= Lv[0] * x8;
      }
      x9 = a0 + a1; } __builtin_amdgcn_sched_barrier(0);
    { float a0 = bf2f(colp[1360]) * mulp[10]; float a1 = 0.f;
      { const f32x4 Lv = *(const f32x4*)(L_s + 680);
        a0 -= Lv[0] * x0;
        a1 -= Lv[1] * x1;
        a0 -= Lv[2] * x2;
        a1 -= Lv[3] * x3;
      }
      { const f32x4 Lv = *(const f32x4*)(L_s + 684);
        a0 -= Lv[0] * x4;
        a1 -= Lv[1] * x5;
        a0 -= Lv[2] * x6;
        a1 -= Lv[3] * x7;
      }
      { const f32x4 Lv = *(const f32x4*)(L_s + 688);
        a0 -= Lv[0] * x8;
        a1 -= Lv[1] * x9;
      }
      x10 = a0 + a1; }
    { float a0 = bf2f(colp[1496]) * mulp[11]; float a1 = 0.f;
      { const f32x4 Lv = *(const f32x4*)(L_s + 748);
        a0 -= Lv[0] * x0;
        a1 -= Lv[1] * x1;
        a0 -= Lv[2] * x2;
        a1 -= Lv[3] * x3;
      }
      { const f32x4 Lv = *(const f32x4*)(L_s + 752);
        a0 -= Lv[0] * x4;
        a1 -= Lv[1] * x5;
        a0 -= Lv[2] * x6;
        a1 -= Lv[3] * x7;
      }
      { const f32x4 Lv = *(const f32x4*)(L_s + 756);
        a0 -= Lv[0] * x8;
        a1 -= Lv[1] * x9;
        a0 -= Lv[2] * x10;
      }
      x11 = a0 + a1; } __builtin_amdgcn_sched_barrier(0);
    { float a0 = bf2f(colp[1632]) * mulp[12]; float a1 = 0.f;
      { const f32x4 Lv = *(const f32x4*)(L_s + 816);
        a0 -= Lv[0] * x0;
        a1 -= Lv[1] * x1;
        a0 -= Lv[2] * x2;
        a1 -= Lv[3] * x3;
      }
      { const f32x4 Lv = *(const f32x4*)(L_s + 820);
        a0 -= Lv[0] * x4;
        a1 -= Lv[1] * x5;
        a0 -= Lv[2] * x6;
        a1 -= Lv[3] * x7;
      }
      { const f32x4 Lv = *(const f32x4*)(L_s + 824);
        a0 -= Lv[0] * x8;
        a1 -= Lv[1] * x9;
        a0 -= Lv[2] * x10;
        a1 -= Lv[3] * x11;
      }
      x12 = a0 + a1; }
    { float a0 = bf2f(colp[1768]) * mulp[13]; float a1 = 0.f;
      { const f32x4 Lv = *(const f32x4*)(L_s + 884);
        a0 -= Lv[0] * x0;
        a1 -= Lv[1] * x1;
        a0 -= Lv[2] * x2;
        a1 -= Lv[3] * x3;
      }
      { const f32x4 Lv = *(const f32x4*)(L_s + 888);
        a0 -= Lv[0] * x4;
        a1 -= Lv[1] * x5;
        a0 -= Lv[2] * x6;
        a1 -= Lv[3] * x7;
      }
      { const f32x4 Lv = *(const f32x4*)(L_s + 892);
        a0 -= Lv[0] * x8;
        a1 -= Lv[1] * x9;
        a0 -= Lv[2] * x10;
        a1 -= Lv[3] * x11;
      }
      { const f32x4 Lv = *(const f32x4*)(L_s + 896);
        a0 -= Lv[0] * x12;
      }
      x13 = a0 + a1; } __builtin_amdgcn_sched_barrier(0);
    { float a0 = bf2f(colp[1904]) * mulp[14]; float a1 = 0.f;
      { const f32x4 Lv = *(const f32x4*)(L_s + 952);
        a0 -= Lv[0] * x0;
        a1 -= Lv[1] * x1;
        a0 -= Lv[2] * x2;
        a1 -= Lv[3] * x3;
      }
      { const f32x4 Lv = *(const f32x4*)(L_s + 956);
        a0 -= Lv[0] * x4;
        a1 -= Lv[1] * x5;
        a0 -= Lv[2] * x6;
        a1 -= Lv[3] * x7;
      }
      { const f32x4 Lv = *(const f32x4*)(L_s + 960);
        a0 -= Lv[0] * x8;
        a1 -= Lv[1] * x9;
        a0 -= Lv[2] * x10;
        a1 -= Lv[3] * x11;
      }
      { const f32x4 Lv = *(const f32x4*)(L_s + 964);
        a0 -= Lv[0] * x12;
        a1 -= Lv[1] * x13;
      }
      x14 = a0 + a1; }
    { float a0 = bf2f(colp[2040]) * mulp[15]; float a1 = 0.f;
      { const f32x4 Lv = *(const f32x4*)(L_s + 1020);
        a0 -= Lv[0] * x0;
        a1 -= Lv[1] * x1;
        a0 -= Lv[2] * x2;
        a1 -= Lv[3] * x3;
      }
      { const f32x4 Lv = *(const f32x4*)(L_s + 1024);
        a0 -= Lv[0] * x4;
        a1 -= Lv[1] * x5;
        a0 -= Lv[2] * x6;
        a1 -= Lv[3] * x7;
      }
      { const f32x4 Lv = *(const f32x4*)(L_s + 1028);
        a0 -= Lv[0] * x8;
        a1 -= Lv[1] * x9;
        a0 -= Lv[2] * x10;
        a1 -= Lv[3] * x11;
      }
      { const f32x4 Lv = *(const f32x4*)(L_s + 1032);
        a0 -= Lv[0] * x12;
        a1 -= Lv[1] * x13;
        a0 -= Lv[2] * x14;
      }
      x15 = a0 + a1; } __builtin_amdgcn_sched_barrier(0);
    { float a0 = bf2f(colp[2176]) * mulp[16]; float a1 = 0.f;
      { const f32x4 Lv = *(const f32x4*)(L_s + 1088);
        a0 -= Lv[0] * x0;
        a1 -= Lv[1] * x1;
        a0 -= Lv[2] * x2;
        a1 -= Lv[3] * x3;
      }
      { const f32x4 Lv = *(const f32x4*)(L_s + 1092);
        a0 -= Lv[0] * x4;
        a1 -= Lv[1] * x5;
        a0 -= Lv[2] * x6;
        a1 -= Lv[3] * x7;
      }
      { const f32x4 Lv = *(const f32x4*)(L_s + 1096);
        a0 -= Lv[0] * x8;
        a1 -= Lv[1] * x9;
        a0 -= Lv[2] * x10;
        a1 -= Lv[3] * x11;
      }
      { const f32x4 Lv = *(const f32x4*)(L_s + 1100);
        a0 -= Lv[0] * x12;
        a1 -= Lv[1] * x13;
        a0 -= Lv[2] * x14;
        a1 -= Lv[3] * x15;
      }
      x16 = a0 + a1; }
    { float a0 = bf2f(colp[2312]) * mulp[17]; float a1 = 0.f;
      { const f32x4 Lv = *(const f32x4*)(L_s + 1156);
        a0 -= Lv[0] * x0;
        a1 -= Lv[1] * x1;
        a0 -= Lv[2] * x2;
        a1 -= Lv[3] * x3;
      }
      { const f32x4 Lv = *(const f32x4*)(L_s + 1160);
        a0 -= Lv[0] * x4;
        a1 -= Lv[1] * x5;
        a0 -= Lv[2] * x6;
        a1 -= Lv[3] * x7;
      }
      { const f32x4 Lv = *(const f32x4*)(L_s + 1164);
        a0 -= Lv[0] * x8;
        a1 -= Lv[1] * x9;
        a0 -= Lv[2] * x10;
        a1 -= Lv[3] * x11;
      }
      { const f32x4 Lv = *(const f32x4*)(L_s + 1168);
        a0 -= Lv[0] * x12;
        a1 -= Lv[1] * x13;
        a0 -= Lv[2] * x14;
        a1 -= Lv[3] * x15;
      }
      { const f32x4 Lv = *(const f32x4*)(L_s + 1172);
        a0 -= Lv[0] * x16;
      }
      x17 = a0 + a1; } __builtin_amdgcn_sched_barrier(0);
    { float a0 = bf2f(colp[2448]) * mulp[18]; float a1 = 0.f;
      { const f32x4 Lv = *(const f32x4*)(L_s + 1224);
        a0 -= Lv[0] * x0;
        a1 -= Lv[1] * x1;
        a0 -= Lv[2] * x2;
        a1 -= Lv[3] * x3;
      }
      { const f32x4 Lv = *(const f32x4*)(L_s + 1228);
        a0 -= Lv[0] * x4;
        a1 -= Lv[1] * x5;
        a0 -= Lv[2] * x6;
        a1 -= Lv[3] * x7;
      }
      { const f32x4 Lv = *(const f32x4*)(L_s + 1232);
        a0 -= Lv[0] * x8;
        a1 -= Lv[1] * x9;
        a0 -= Lv[2] * x10;
        a1 -= Lv[3] * x11;
      }
      { const f32x4 Lv = *(const f32x4*)(L_s + 1236);
        a0 -= Lv[0] * x12;
        a1 -= Lv[1] * x13;
        a0 -= Lv[2] * x14;
        a1 -= Lv[3] * x15;
      }
      { const f32x4 Lv = *(const f32x4*)(L_s + 1240);
        a0 -= Lv[0] * x16;
        a1 -= Lv[1] * x17;
      }
      x18 = a0 + a1; }
    { float a0 = bf2f(colp[2584]) * mulp[19]; float a1 = 0.f;
      { const f32x4 Lv = *(const f32x4*)(L_s + 1292);
        a0 -= Lv[0] * x0;
        a1 -= Lv[1] * x1;
        a0 -= Lv[2] * x2;
        a1 -= Lv[3] * x3;
      }
      { const f32x4 Lv = *(const f32x4*)(L_s + 1296);
        a0 -= Lv[0] * x4;
        a1 -= Lv[1] * x5;
        a0 -= Lv[2] * x6;
        a1 -= Lv[3] * x7;
      }
      { const f32x4 Lv = *(const f32x4*)(L_s + 1300);
        a0 -= Lv[0] * x8;
        a1 -= Lv[1] * x9;
        a0 -= Lv[2] * x10;
        a1 -= Lv[3] * x11;
      }
      { const f32x4 Lv = *(const f32x4*)(L_s + 1304);
        a0 -= Lv[0] * x12;
        a1 -= Lv[1] * x13;
        a0 -= Lv[2] * x14;
        a1 -= Lv[3] * x15;
      }
      { const f32x4 Lv = *(const f32x4*)(L_s + 1308);
        a0 -= Lv[0] * x16;
        a1 -= Lv[1] * x17;
        a0 -= Lv[2] * x18;
      }
      x19 = a0 + a1; } __builtin_amdgcn_sched_barrier(0);
    { float a0 = bf2f(colp[2720]) * mulp[20]; float a1 = 0.f;
      { const f32x4 Lv = *(const f32x4*)(L_s + 1360);
        a0 -= Lv[0] * x0;
        a1 -= Lv[1] * x1;
        a0 -= Lv[2] * x2;
        a1 -= Lv[3] * x3;
      }
      { const f32x4 Lv = *(const f32x4*)(L_s + 1364);
        a0 -= Lv[0] * x4;
        a1 -= Lv[1] * x5;
        a0 -= Lv[2] * x6;
        a1 -= Lv[3] * x7;
      }
      { const f32x4 Lv = *(const f32x4*)(L_s + 1368);
        a0 -= Lv[0] * x8;
        a1 -= Lv[1] * x9;
        a0 -= Lv[2] * x10;
        a1 -= Lv[3] * x11;
      }
      { const f32x4 Lv = *(const f32x4*)(L_s + 1372);
        a0 -= Lv[0] * x12;
        a1 -= Lv[1] * x13;
        a0 -= Lv[2] * x14;
        a1 -= Lv[3] * x15;
      }
      { const f32x4 Lv = *(const f32x4*)(L_s + 1376);
        a0 -= Lv[0] * x16;
        a1 -= Lv[1] * x17;
        a0 -= Lv[2] * x18;
        a1 -= Lv[3] * x19;
      }
      x20 = a0 + a1; }
    { float a0 = bf2f(colp[2856]) * mulp[21]; float a1 = 0.f;
      { const f32x4 Lv = *(const f32x4*)(L_s + 1428);
        a0 -= Lv[0] * x0;
        a1 -= Lv[1] * x1;
        a0 -= Lv[2] * x2;
        a1 -= Lv[3] * x3;
      }
      { const f32x4 Lv = *(const f32x4*)(L_s + 1432);
        a0 -= Lv[0] * x4;
        a1 -= Lv[1] * x5;
        a0 -= Lv[2] * x6;
        a1 -= Lv[3] * x7;
      }
      { const f32x4 Lv = *(const f32x4*)(L_s + 1436);
        a0 -= Lv[0] * x8;
        a1 -= Lv[1] * x9;
        a0 -= Lv[2] * x10;
        a1 -= Lv[3] * x11;
      }
      { const f32x4 Lv = *(const f32x4*)(L_s + 1440);
        a0 -= Lv[0] * x12;
        a1 -= Lv[1] * x13;
        a0 -= Lv[2] * x14;
        a1 -= Lv[3] * x15;
      }
      { const f32x4 Lv = *(const f32x4*)(L_s + 1444);
        a0 -= Lv[0] * x16;
        a1 -= Lv[1] * x17;
        a0 -= Lv[2] * x18;
        a1 -= Lv[3] * x19;
      }
      { const f32x4 Lv = *(const f32x4*)(L_s + 1448);
        a0 -= Lv[0] * x20;
      }
      x21 = a0 + a1; } __builtin_amdgcn_sched_barrier(0);
    { float a0 = bf2f(colp[2992]) * mulp[22]; float a1 = 0.f;
      { const f32x4 Lv = *(const f32x4*)(L_s + 1496);
        a0 -= Lv[0] * x0;
        a1 -= Lv[1] * x1;
        a0 -= Lv[2] * x2;
        a1 -= Lv[3] * x3;
      }
      { const f32x4 Lv = *(const f32x4*)(L_s + 1500);
        a0 -= Lv[0] * x4;
        a1 -= Lv[1] * x5;
        a0 -= Lv[2] * x6;
        a1 -= Lv[3] * x7;
      }
      { const f32x4 Lv = *(const f32x4*)(L_s + 1504);
        a0 -= Lv[0] * x8;
        a1 -= Lv[1] * x9;
        a0 -= Lv[2] * x10;
        a1 -= Lv[3] * x11;
      }
      { const f32x4 Lv = *(const f32x4*)(L_s + 1508);
        a0 -= Lv[0] * x12;
        a1 -= Lv[1] * x13;
        a0 -= Lv[2] * x14;
        a1 -= Lv[3] * x15;
      }
      { const f32x4 Lv = *(const f32x4*)(L_s + 1512);
        a0 -= Lv[0] * x16;
        a1 -= Lv[1] * x17;
        a0 -= Lv[2] * x18;
        a1 -= Lv[3] * x19;
      }
      { const f32x4 Lv = *(const f32x4*)(L_s + 1516);
        a0 -= Lv[0] * x20;
        a1 -= Lv[1] * x21;
      }
      x22 = a0 + a1; }
    { float a0 = bf2f(colp[3128]) * mulp[23]; float a1 = 0.f;
      { const f32x4 Lv = *(const f32x4*)(L_s + 1564);
        a0 -= Lv[0] * x0;
        a1 -= Lv[1] * x1;
        a0 -= Lv[2] * x2;
        a1 -= Lv[3] * x3;
      }
      { const f32x4 Lv = *(const f32x4*)(L_s + 1568);
        a0 -= Lv[0] * x4;
        a1 -= Lv[1] * x5;
        a0 -= Lv[2] * x6;
        a1 -= Lv[3] * x7;
      }
      { const f32x4 Lv = *(const f32x4*)(L_s + 1572);
        a0 -= Lv[0] * x8;
        a1 -= Lv[1] * x9;
        a0 -= Lv[2] * x10;
        a1 -= Lv[3] * x11;
      }
      { const f32x4 Lv = *(const f32x4*)(L_s + 1576);
        a0 -= Lv[0] * x12;
        a1 -= Lv[1] * x13;
        a0 -= Lv[2] * x14;
        a1 -= Lv[3] * x15;
      }
      { const f32x4 Lv = *(const f32x4*)(L_s + 1580);
        a0 -= Lv[0] * x16;
        a1 -= Lv[1] * x17;
        a0 -= Lv[2] * x18;
        a1 -= Lv[3] * x19;
      }
      { const f32x4 Lv = *(const f32x4*)(L_s + 1584);
        a0 -= Lv[0] * x20;
        a1 -= Lv[1] * x21;
        a0 -= Lv[2] * x22;
      }
      x23 = a0 + a1; } __builtin_amdgcn_sched_barrier(0);
    { float a0 = bf2f(colp[3264]) * mulp[24]; float a1 = 0.f;
      { const f32x4 Lv = *(const f32x4*)(L_s + 1632);
        a0 -= Lv[0] * x0;
        a1 -= Lv[1] * x1;
        a0 -= Lv[2] * x2;
        a1 -= Lv[3] * x3;
      }
      { const f32x4 Lv = *(const f32x4*)(L_s + 1636);
        a0 -= Lv[0] * x4;
        a1 -= Lv[1] * x5;
        a0 -= Lv[2] * x6;
        a1 -= Lv[3] * x7;
      }
      { const f32x4 Lv = *(const f32x4*)(L_s + 1640);
        a0 -= Lv[0] * x8;
        a1 -= Lv[1] * x9;
        a0 -= Lv[2] * x10;
        a1 -= Lv[3] * x11;
      }
      { const f32x4 Lv = *(const f32x4*)(L_s + 1644);
        a0 -= Lv[0] * x12;
        a1 -= Lv[1] * x13;
        a0 -= Lv[2] * x14;
        a1 -= Lv[3] * x15;
      }
      { const f32x4 Lv = *(const f32x4*)(L_s + 1648);
        a0 -= Lv[0] * x16;
        a1 -= Lv[1] * x17;
        a0 -= Lv[2] * x18;
        a1 -= Lv[3] * x19;
      }
      { const f32x4 Lv = *(const f32x4*)(L_s + 1652);
        a0 -= Lv[0] * x20;
        a1 -= Lv[1] * x21;
        a0 -= Lv[2] * x22;
        a1 -= Lv[3] * x23;
      }
      x24 = a0 + a1; }
    { float a0 = bf2f(colp[3400]) * mulp[25]; float a1 = 0.f;
      { const f32x4 Lv = *(const f32x4*)(L_s + 1700);
        a0 -= Lv[0] * x0;
        a1 -= Lv[1] * x1;
        a0 -= Lv[2] * x2;
        a1 -= Lv[3] * x3;
      }
      { const f32x4 Lv = *(const f32x4*)(L_s + 1704);
        a0 -= Lv[0] * x4;
        a1 -= Lv[1] * x5;
        a0 -= Lv[2] * x6;
        a1 -= Lv[3] * x7;
      }
      { const f32x4 Lv = *(const f32x4*)(L_s + 1708);
        a0 -= Lv[0] * x8;
        a1 -= Lv[1] * x9;
        a0 -= Lv[2] * x10;
        a1 -= Lv[3] * x11;
      }
      { const f32x4 Lv = *(const f32x4*)(L_s + 1712);
        a0 -= Lv[0] * x12;
        a1 -= Lv[1] * x13;
        a0 -= Lv[2] * x14;
        a1 -= Lv[3] * x15;
      }
      { const f32x4 Lv = *(const f32x4*)(L_s + 1716);
        a0 -= Lv[0] * x16;
        a1 -= Lv[1] * x17;
        a0 -= Lv[2] * x18;
        a1 -= Lv[3] * x19;
      }
      { const f32x4 Lv = *(const f32x4*)(L_s + 1720);
        a0 -= Lv[0] * x20;
        a1 -= Lv[1] * x21;
        a0 -= Lv[2] * x22;
        a1 -= Lv[3] * x23;
      }
      { const f32x4 Lv = *(const f32x4*)(L_s + 1724);
        a0 -= Lv[0] * x24;
      }
      x25 = a0 + a1; } __builtin_amdgcn_sched_barrier(0);
    { float a0 = bf2f(colp[3536]) * mulp[26]; float a1 = 0.f;
      { const f32x4 Lv = *(const f32x4*)(L_s + 1768);
        a0 -= Lv[0] * x0;
        a1 -= Lv[1] * x1;
        a0 -= Lv[2] * x2;
        a1 -= Lv[3] * x3;
      }
      { const f32x4 Lv = *(const f32x4*)(L_s + 1772);
        a0 -= Lv[0] * x4;
        a1 -= Lv[1] * x5;
        a0 -= Lv[2] * x6;
        a1 -= Lv[3] * x7;
      }
      { const f32x4 Lv = *(const f32x4*)(L_s + 1776);
        a0 -= Lv[0] * x8;
        a1 -= Lv[1] * x9;
        a0 -= Lv[2] * x10;
        a1 -= Lv[3] * x11;
      }
      { const f32x4 Lv = *(const f32x4*)(L_s + 1780);
        a0 -= Lv[0] * x12;
        a1 -= Lv[1] * x13;
        a0 -= Lv[2] * x14;
        a1 -= Lv[3] * x15;
      }
      { const f32x4 Lv = *(const f32x4*)(L_s + 1784);
        a0 -= Lv[0] * x16;
        a1 -= Lv[1] * x17;
        a0 -= Lv[2] * x18;
        a1 -= Lv[3] * x19;
      }
      { const f32x4 Lv = *(const f32x4*)(L_s + 1788);
        a0 -= Lv[0] * x20;
        a1 -= Lv[1] * x21;
        a0 -= Lv[2] * x22;
        a1 -= Lv[3] * x23;
      }
      { const f32x4 Lv = *(const f32x4*)(L_s + 1792);
        a0 -= Lv[0] * x24;
        a1 -= Lv[1] * x25;
      }
      x26 = a0 + a1; }
    { float a0 = bf2f(colp[3672]) * mulp[27]; float a1 = 0.f;
      { const f32x4 Lv = *(const f32x4*)(L_s + 1836);
        a0 -= Lv[0] * x0;
        a1 -= Lv[1] * x1;
        a0 -= Lv[2] * x2;
        a1 -= Lv[3] * x3;
      }
      { const f32x4 Lv = *(const f32x4*)(L_s + 1840);
        a0 -= Lv[0] * x4;
        a1 -= Lv[1] * x5;
        a0 -= Lv[2] * x6;
        a1 -= Lv[3] * x7;
      }
      { const f32x4 Lv = *(const f32x4*)(L_s + 1844);
        a0 -= Lv[0] * x8;
        a1 -= Lv[1] * x9;
        a0 -= Lv[2] * x10;
        a1 -= Lv[3] * x11;
      }
      { const f32x4 Lv = *(const f32x4*)(L_s + 1848);
        a0 -= Lv[0] * x12;
        a1 -= Lv[1] * x13;
        a0 -= Lv[2] * x14;
        a1 -= Lv[3] * x15;
      }
      { const f32x4 Lv = *(const f32x4*)(L_s + 1852);
        a0 -= Lv[0] * x16;
        a1 -= Lv[1] * x17;
        a0 -= Lv[2] * x18;
        a1 -= Lv[3] * x19;
      }
      { const f32x4 Lv = *(const f32x4*)(L_s + 1856);
        a0 -= Lv[0] * x20;
        a1 -= Lv[1] * x21;
        a0 -= Lv[2] * x22;
        a1 -= Lv[3] * x23;
      }
      { const f32x4 Lv = *(const f32x4*)(L_s + 1860);
        a0 -= Lv[0] * x24;
        a1 -= Lv[1] * x25;
        a0 -= Lv[2] * x26;
      }
      x27 = a0 + a1; } __builtin_amdgcn_sched_barrier(0);
    { float a0 = bf2f(colp[3808]) * mulp[28]; float a1 = 0.f;
      { const f32x4 Lv = *(const f32x4*)(L_s + 1904);
        a0 -= Lv[0] * x0;
        a1 -= Lv[1] * x1;
        a0 -= Lv[2] * x2;
        a1 -= Lv[3] * x3;
      }
      { const f32x4 Lv = *(const f32x4*)(L_s + 1908);
        a0 -= Lv[0] * x4;
        a1 -= Lv[1] * x5;
        a0 -= Lv[2] * x6;
        a1 -= Lv[3] * x7;
      }
      { const f32x4 Lv = *(const f32x4*)(L_s + 1912);
        a0 -= Lv[0] * x8;
        a1 -= Lv[1] * x9;
        a0 -= Lv[2] * x10;
        a1 -= Lv[3] * x11;
      }
      { const f32x4 Lv = *(const f32x4*)(L_s + 1916);
        a0 -= Lv[0] * x12;
        a1 -= Lv[1] * x13;
        a0 -= Lv[2] * x14;
        a1 -= Lv[3] * x15;
      }
      { const f32x4 Lv = *(const f32x4*)(L_s + 1920);
        a0 -= Lv[0] * x16;
        a1 -= Lv[1] * x17;
        a0 -= Lv[2] * x18;
        a1 -= Lv[3] * x19;
      }
      { const f32x4 Lv = *(const f32x4*)(L_s + 1924);
        a0 -= Lv[0] * x20;
        a1 -= Lv[1] * x21;
        a0 -= Lv[2] * x22;
        a1 -= Lv[3] * x23;
      }
      { const f32x4 Lv = *(const f32x4*)(L_s + 1928);
        a0 -= Lv[0] * x24;
        a1 -= Lv[1] * x25;
        a0 -= Lv[2] * x26;
        a1 -= Lv[3] * x27;
      }
      x28 = a0 + a1; }
    { float a0 = bf2f(colp[3944]) * mulp[29]; float a1 = 0.f;
      { const f32x4 Lv = *(const f32x4*)(L_s + 1972);
        a0 -= Lv[0] * x0;
        a1 -= Lv[1] * x1;
        a0 -= Lv[2] * x2;
        a1 -= Lv[3] * x3;
      }
      { const f32x4 Lv = *(const f32x4*)(L_s + 1976);
        a0 -= Lv[0] * x4;
        a1 -= Lv[1] * x5;
        a0 -= Lv[2] * x6;
        a1 -= Lv[3] * x7;
      }
      { const f32x4 Lv = *(const f32x4*)(L_s + 1980);
        a0 -= Lv[0] * x8;
        a1 -= Lv[1] * x9;
        a0 -= Lv[2] * x10;
        a1 -= Lv[3] * x11;
      }
      { const f32x4 Lv = *(const f32x4*)(L_s + 1984);
        a0 -= Lv[0] * x12;
        a1 -= Lv[1] * x13;
        a0 -= Lv[2] * x14;
        a1 -= Lv[3] * x15;
      }
      { const f32x4 Lv = *(const f32x4*)(L_s + 1988);
        a0 -= Lv[0] * x16;
        a1 -= Lv[1] * x17;
        a0 -= Lv[2] * x18;
        a1 -= Lv[3] * x19;
      }
      { const f32x4 Lv = *(const f32x4*)(L_s + 1992);
        a0 -= Lv[0] * x20;
        a1 -= Lv[1] * x21;
        a0 -= Lv[2] * x22;
        a1 -= Lv[3] * x23;
      }
      { const f32x4 Lv = *(const f32x4*)(L_s + 1996);
        a0 -= Lv[0] * x24;
        a1 -= Lv[1] * x25;
        a0 -= Lv[2] * x26;
        a1 -= Lv[3] * x27;
      }
      { const f32x4 Lv = *(const f32x4*)(L_s + 2000);
        a0 -= Lv[0] * x28;
      }
      x29 = a0 + a1; } __builtin_amdgcn_sched_barrier(0);
    { float a0 = bf2f(colp[4080]) * mulp[30]; float a1 = 0.f;
      { const f32x4 Lv = *(const f32x4*)(L_s + 2040);
        a0 -= Lv[0] * x0;
        a1 -= Lv[1] * x1;
        a0 -= Lv[2] * x2;
        a1 -= Lv[3] * x3;
      }
      { const f32x4 Lv = *(const f32x4*)(L_s + 2044);
        a0 -= Lv[0] * x4;
        a1 -= Lv[1] * x5;
        a0 -= Lv[2] * x6;
        a1 -= Lv[3] * x7;
      }
      { const f32x4 Lv = *(const f32x4*)(L_s + 2048);
        a0 -= Lv[0] * x8;
        a1 -= Lv[1] * x9;
        a0 -= Lv[2] * x10;
        a1 -= Lv[3] * x11;
      }
      { const f32x4 Lv = *(const f32x4*)(L_s + 2052);
        a0 -= Lv[0] * x12;
        a1 -= Lv[1] * x13;
        a0 -= Lv[2] * x14;
        a1 -= Lv[3] * x15;
      }
      { const f32x4 Lv = *(const f32x4*)(L_s + 2056);
        a0 -= Lv[0] * x16;
        a1 -= Lv[1] * x17;
        a0 -= Lv[2] * x18;
        a1 -= Lv[3] * x19;
      }
      { const f32x4 Lv = *(const f32x4*)(L_s + 2060);
        a0 -= Lv[0] * x20;
        a1 -= Lv[1] * x21;
        a0 -= Lv[2] * x22;
        a1 -= Lv[3] * x23;
      }
      { const f32x4 Lv = *(const f32x4*)(L_s + 2064);
        a0 -= Lv[0] * x24;
        a1 -= Lv[1] * x25;
        a0 -= Lv[2] * x26;
        a1 -= Lv[3] * x27;
      }
      { const f32x4 Lv = *(const f32x4*)(L_s + 2068);
        a0 -= Lv[0] * x28;
        a1 -= Lv[1] * x29;
      }
      x30 = a0 + a1; }
    { float a0 = bf2f(colp[4216]) * mulp[31]; float a1 = 0.f;
      { const f32x4 Lv = *(const f32x4*)(L_s + 2108);
        a0 -= Lv[0] * x0;
        a1 -= Lv[1] * x1;
        a0 -= Lv[2] * x2;
        a1 -= Lv[3] * x3;
      }
      { const f32x4 Lv = *(const f32x4*)(L_s + 2112);
        a0 -= Lv[0] * x4;
        a1 -= Lv[1] * x5;
        a0 -= Lv[2] * x6;
        a1 -= Lv[3] * x7;
      }
      { const f32x4 Lv = *(const f32x4*)(L_s + 2116);
        a0 -= Lv[0] * x8;
        a1 -= Lv[1] * x9;
        a0 -= Lv[2] * x10;
        a1 -= Lv[3] * x11;
      }
      { const f32x4 Lv = *(const f32x4*)(L_s + 2120);
        a0 -= Lv[0] * x12;
        a1 -= Lv[1] * x13;
        a0 -= Lv[2] * x14;
        a1 -= Lv[3] * x15;
      }
      { const f32x4 Lv = *(const f32x4*)(L_s + 2124);
        a0 -= Lv[0] * x16;
        a1 -= Lv[1] * x17;
        a0 -= Lv[2] * x18;
        a1 -= Lv[3] * x19;
      }
      { const f32x4 Lv = *(const f32x4*)(L_s + 2128);
        a0 -= Lv[0] * x20;
        a1 -= Lv[1] * x21;
        a0 -= Lv[2] * x22;
        a1 -= Lv[3] * x23;
      }
      { const f32x4 Lv = *(const f32x4*)(L_s + 2132);
        a0 -= Lv[0] * x24;
        a1 -= Lv[1] * x25;
        a0 -= Lv[2] * x26;
        a1 -= Lv[3] * x27;
      }
      { const f32x4 Lv = *(const f32x4*)(L_s + 2136);
        a0 -= Lv[0] * x28;
        a1 -= Lv[1] * x29;
        a0 -= Lv[2] * x30;
      }
      x31 = a0 + a1; } __builtin_amdgcn_sched_barrier(0);
    { float a0 = bf2f(colp[4352]) * mulp[32]; float a1 = 0.f;
      { const f32x4 Lv = *(const f32x4*)(L_s + 2176);
        a0 -= Lv[0] * x0;
        a1 -= Lv[1] * x1;
        a0 -= Lv[2] * x2;
        a1 -= Lv[3] * x3;
      }
      { const f32x4 Lv = *(const f32x4*)(L_s + 2180);
        a0 -= Lv[0] * x4;
        a1 -= Lv[1] * x5;
        a0 -= Lv[2] * x6;
        a1 -= Lv[3] * x7;
      }
      { const f32x4 Lv = *(const f32x4*)(L_s + 2184);
        a0 -= Lv[0] * x8;
        a1 -= Lv[1] * x9;
        a0 -= Lv[2] * x10;
        a1 -= Lv[3] * x11;
      }
      { const f32x4 Lv = *(const f32x4*)(L_s + 2188);
        a0 -= Lv[0] * x12;
        a1 -= Lv[1] * x13;
        a0 -= Lv[2] * x14;
        a1 -= Lv[3] * x15;
      }
      { const f32x4 Lv = *(const f32x4*)(L_s + 2192);
        a0 -= Lv[0] * x16;
        a1 -= Lv[1] * x17;
        a0 -= Lv[2] * x18;
        a1 -= Lv[3] * x19;
      }
      { const f32x4 Lv = *(const f32x4*)(L_s + 2196);
        a0 -= Lv[0] * x20;
        a1 -= Lv[1] * x21;
        a0 -= Lv[2] * x22;
        a1 -= Lv[3] * x23;
      }
      { const f32x4 Lv = *(const f32x4*)(L_s + 2200);
        a0 -= Lv[0] * x24;
        a1 -= Lv[1] * x25;
        a0 -= Lv[2] * x26;
        a1 -= Lv[3] * x27;
      }
      { const f32x4 Lv = *(const f32x4*)(L_s + 2204);
        a0 -= Lv[0] * x28;
        a1 -= Lv[1] * x29;
        a0 -= Lv[2] * x30;
        a1 -= Lv[3] * x31;
      }
      x32 = a0 + a1; }
    { float a0 = bf2f(colp[4488]) * mulp[33]; float a1 = 0.f;
      { const f32x4 Lv = *(const f32x4*)(L_s + 2244);
        a0 -= Lv[0] * x0;
        a1 -= Lv[1] * x1;
        a0 -= Lv[2] * x2;
        a1 -= Lv[3] * x3;
      }
      { const f32x4 Lv = *(const f32x4*)(L_s + 2248);
        a0 -= Lv[0] * x4;
        a1 -= Lv[1] * x5;
        a0 -= Lv[2] * x6;
        a1 -= Lv[3] * x7;
      }
      { const f32x4 Lv = *(const f32x4*)(L_s + 2252);
        a0 -= Lv[0] * x8;
        a1 -= Lv[1] * x9;
        a0 -= Lv[2] * x10;
        a1 -= Lv[3] * x11;
      }
      { const f32x4 Lv = *(const f32x4*)(L_s + 2256);
        a0 -= Lv[0] * x12;
        a1 -= Lv[1] * x13;
        a0 -= Lv[2] * x14;
        a1 -= Lv[3] * x15;
      }
      { const f32x4 Lv = *(const f32x4*)(L_s + 2260);
        a0 -= Lv[0] * x16;
        a1 -= Lv[1] * x17;
        a0 -= Lv[2] * x18;
        a1 -= Lv[3] * x19;
      }
      { const f32x4 Lv = *(const f32x4*)(L_s + 2264);
        a0 -= Lv[0] * x20;
        a1 -= Lv[1] * x21;
        a0 -= Lv[2] * x22;
        a1 -= Lv[3] * x23;
      }
      { const f32x4 Lv = *(const f32x4*)(L_s + 2268);
        a0 -= Lv[0] * x24;
        a1 -= Lv[1] * x25;
        a0 -= Lv[2] * x26;
        a1 -= Lv[3] * x27;
      }
      { const f32x4 Lv = *(const f32x4*)(L_s + 2272);
        a0 -= Lv[0] * x28;
        a1 -= Lv[1] * x29;
        a0 -= Lv[2] * x30;
        a1 -= Lv[3] * x31;
      }
      { const f32x4 Lv = *(const f32x4*)(L_s + 2276);
        a0 -= Lv[0] * x32;
      }
      x33 = a0 + a1; } __builtin_amdgcn_sched_barrier(0);
    { float a0 = bf2f(colp[4624]) * mulp[34]; float a1 = 0.f;
      { const f32x4 Lv = *(const f32x4*)(L_s + 2312);
        a0 -= Lv[0] * x0;
        a1 -= Lv[1] * x1;
        a0 -= Lv[2] * x2;
        a1 -= Lv[3] * x3;
      }
      { const f32x4 Lv = *(const f32x4*)(L_s + 2316);
        a0 -= Lv[0] * x4;
        a1 -= Lv[1] * x5;
        a0 -= Lv[2] * x6;
        a1 -= Lv[3] * x7;
      }
      { const f32x4 Lv = *(const f32x4*)(L_s + 2320);
        a0 -= Lv[0] * x8;
        a1 -= Lv[1] * x9;
        a0 -= Lv[2] * x10;
        a1 -= Lv[3] * x11;
      }
      { const f32x4 Lv = *(const f32x4*)(L_s + 2324);
        a0 -= Lv[0] * x12;
        a1 -= Lv[1] * x13;
        a0 -= Lv[2] * x14;
        a1 -= Lv[3] * x15;
      }
      { const f32x4 Lv = *(const f32x4*)(L_s + 2328);
        a0 -= Lv[0] * x16;
        a1 -= Lv[1] * x17;
        a0 -= Lv[2] * x18;
        a1 -= Lv[3] * x19;
      }
      { const f32x4 Lv = *(const f32x4*)(L_s + 2332);
        a0 -= Lv[0] * x20;
        a1 -= Lv[1] * x21;
        a0 -= Lv[2] * x22;
        a1 -= Lv[3] * x23;
      }
      { const f32x4 Lv = *(const f32x4*)(L_s + 2336);
        a0 -= Lv[0] * x24;
        a1 -= Lv[1] * x25;
        a0 -= Lv[2] * x26;
        a1 -= Lv[3] * x27;
      }
      { const f32x4 Lv = *(const f32x4*)(L_s + 2340);
        a0 -= Lv[0] * x28;
        a1 -= Lv[1] * x29;
        a0 -= Lv[2] * x30;
        a1 -= Lv[3] * x31;
      }
      { const f32x4 Lv = *(const f32x4*)(L_s + 2344);
        a0 -= Lv[0] * x32;
        a1 -= Lv[1] * x33;
      }
      x34 = a0 + a1; }
    { float a0 = bf2f(colp[4760]) * mulp[35]; float a1 = 0.f;
      { const f32x4 Lv = *(const f32x4*)(L_s + 2380);
        a0 -= Lv[0] * x0;
        a1 -= Lv[1] * x1;
        a0 -= Lv[2] * x2;
        a1 -= Lv[3] * x3;
      }
      { const f32x4 Lv = *(const f32x4*)(L_s + 2384);
        a0 -= Lv[0] * x4;
        a1 -= Lv[1] * x5;
        a0 -= Lv[2] * x6;
        a1 -= Lv[3] * x7;
      }
      { const f32x4 Lv = *(const f32x4*)(L_s + 2388);
        a0 -= Lv[0] * x8;
        a1 -= Lv[1] * x9;
        a0 -= Lv[2] * x10;
        a1 -= Lv[3] * x11;
      }
      { const f32x4 Lv = *(const f32x4*)(L_s + 2392);
        a0 -= Lv[0] * x12;
        a1 -= Lv[1] * x13;
        a0 -= Lv[2] * x14;
        a1 -= Lv[3] * x15;
      }
      { const f32x4 Lv = *(const f32x4*)(L_s + 2396);
        a0 -= Lv[0] * x16;
        a1 -= Lv[1] * x17;
        a0 -= Lv[2] * x18;
        a1 -= Lv[3] * x19;
      }
      { const f32x4 Lv = *(const f32x4*)(L_s + 2400);
        a0 -= Lv[0] * x20;
        a1 -= Lv[1] * x21;
        a0 -= Lv[2] * x22;
        a1 -= Lv[3] * x23;
      }
      { const f32x4 Lv = *(const f32x4*)(L_s + 2404);
        a0 -= Lv[0] * x24;
        a1 -= Lv[1] * x25;
        a0 -= Lv[2] * x26;
        a1 -= Lv[3] * x27;
      }
      { const f32x4 Lv = *(const f32x4*)(L_s + 2408);
        a0 -= Lv[0] * x28;
        a1 -= Lv[1] * x29;
        a0 -= Lv[2] * x30;
        a1 -= Lv[3] * x31;
      }
      { const f32x4 Lv = *(const f32x4*)(L_s + 2412);
        a0 -= Lv[0] * x32;
        a1 -= Lv[1] * x33;
        a0 -= Lv[2] * x34;
      }
      x35 = a0 + a1; } __builtin_amdgcn_sched_barrier(0);
    { float a0 = bf2f(colp[4896]) * mulp[36]; float a1 = 0.f;
      { const f32x4 Lv = *(const f32x4*)(L_s + 2448);
        a0 -= Lv[0] * x0;
        a1 -= Lv[1] * x1;
        a0 -= Lv[2] * x2;
        a1 -= Lv[3] * x3;
      }
      { const f32x4 Lv = *(const f32x4*)(L_s + 2452);
        a0 -= Lv[0] * x4;
        a1 -= Lv[1] * x5;
        a0 -= Lv[2] * x6;
        a1 -= Lv[3] * x7;
      }
      { const f32x4 Lv = *(const f32x4*)(L_s + 2456);
        a0 -= Lv[0] * x8;
        a1 -= Lv[1] * x9;
        a0 -= Lv[2] * x10;
        a1 -= Lv[3] * x11;
      }
      { const f32x4 Lv = *(const f32x4*)(L_s + 2460);
        a0 -= Lv[0] * x12;
        a1 -= Lv[1] * x13;
        a0 -= Lv[2] * x14;
        a1 -= Lv[3] * x15;
      }
      { const f32x4 Lv = *(const f32x4*)(L_s + 2464);
        a0 -= Lv[0] * x16;
        a1 -= Lv[1] * x17;
        a0 -= Lv[2] * x18;
        a1 -= Lv[3] * x19;
      }
      { const f32x4 Lv = *(const f32x4*)(L_s + 2468);
        a0 -= Lv[0] * x20;
        a1 -= Lv[1] * x21;
        a0 -= Lv[2] * x22;
        a1 -= Lv[3] * x23;
      }
      { const f32x4 Lv = *(const f32x4*)(L_s + 2472);
        a0 -= Lv[0] * x24;
        a1 -= Lv[1] * x25;
        a0 -= Lv[2] * x26;
        a1 -= Lv[3] * x27;
      }
      { const f32x4 Lv = *(const f32x4*)(L_s + 2476);
        a0 -= Lv[0] * x28;
        a1 -= Lv[1] * x29;
        a0 -= Lv[2] * x30;
        a1 -= Lv[3] * x31;
      }
      { const f32x4 Lv = *(const f32x4*)(L_s + 2480);
        a0 -= Lv[0] * x32;
        a1 -= Lv[1] * x33;
        a0 -= Lv[2] * x34;
        a1 -= Lv[3] * x35;
      }
      x36 = a0 + a1; }
    { float a0 = bf2f(colp[5032]) * mulp[37]; float a1 = 0.f;
      { const f32x4 Lv = *(const f32x4*)(L_s + 2516);
        a0 -= Lv[0] * x0;
        a1 -= Lv[1] * x1;
        a0 -= Lv[2] * x2;
        a1 -= Lv[3] * x3;
      }
      { const f32x4 Lv = *(const f32x4*)(L_s + 2520);
        a0 -= Lv[0] * x4;
        a1 -= Lv[1] * x5;
        a0 -= Lv[2] * x6;
        a1 -= Lv[3] * x7;
      }
      { const f32x4 Lv = *(const f32x4*)(L_s + 2524);
        a0 -= Lv[0] * x8;
        a1 -= Lv[1] * x9;
        a0 -= Lv[2] * x10;
        a1 -= Lv[3] * x11;
      }
      { const f32x4 Lv = *(const f32x4*)(L_s + 2528);
        a0 -= Lv[0] * x12;
        a1 -= Lv[1] * x13;
        a0 -= Lv[2] * x14;
        a1 -= Lv[3] * x15;
      }
      { const f32x4 Lv = *(const f32x4*)(L_s + 2532);
        a0 -= Lv[0] * x16;
        a1 -= Lv[1] * x17;
        a0 -= Lv[2] * x18;
        a1 -= Lv[3] * x19;
      }
      { const f32x4 Lv = *(const f32x4*)(L_s + 2536);
        a0 -= Lv[0] * x20;
        a1 -= Lv[1] * x21;
        a0 -= Lv[2] * x22;
        a1 -= Lv[3] * x23;
      }
      { const f32x4 Lv = *(const f32x4*)(L_s + 2540);
        a0 -= Lv[0] * x24;
        a1 -= Lv[1] * x25;
        a0 -= Lv[2] * x26;
        a1 -= Lv[3] * x27;
      }
      { const f32x4 Lv = *(const f32x4*)(L_s + 2544);
        a0 -= Lv[0] * x28;
        a1 -= Lv[1] * x29;
        a0 -= Lv[2] * x30;
        a1 -= Lv[3] * x31;
      }
      { const f32x4 Lv = *(const f32x4*)(L_s + 2548);
        a0 -= Lv[0] * x32;
        a1 -= Lv[1] * x33;
        a0 -= Lv[2] * x34;
        a1 -= Lv[3] * x35;
      }
      { const f32x4 Lv = *(const f32x4*)(L_s + 2552);
        a0 -= Lv[0] * x36;
      }
      x37 = a0 + a1; } __builtin_amdgcn_sched_barrier(0);
    { float a0 = bf2f(colp[5168]) * mulp[38]; float a1 = 0.f;
      { const f32x4 Lv = *(const f32x4*)(L_s + 2584);
        a0 -= Lv[0] * x0;
        a1 -= Lv[1] * x1;
        a0 -= Lv[2] * x2;
        a1 -= Lv[3] * x3;
      }
      { const f32x4 Lv = *(const f32x4*)(L_s + 2588);
        a0 -= Lv[0] * x4;
        a1 -= Lv[1] * x5;
        a0 -= Lv[2] * x6;
        a1 -= Lv[3] * x7;
      }
      { const f32x4 Lv = *(const f32x4*)(L_s + 2592);
        a0 -= Lv[0] * x8;
        a1 -= Lv[1] * x9;
        a0 -= Lv[2] * x10;
        a1 -= Lv[3] * x11;
      }
      { const f32x4 Lv = *(const f32x4*)(L_s + 2596);
        a0 -= Lv[0] * x12;
        a1 -= Lv[1] * x13;
        a0 -= Lv[2] * x14;
        a1 -= Lv[3] * x15;
      }
      { const f32x4 Lv = *(const f32x4*)(L_s + 2600);
        a0 -= Lv[0] * x16;
        a1 -= Lv[1] * x17;
        a0 -= Lv[2] * x18;
        a1 -= Lv[3] * x19;
      }
      { const f32x4 Lv = *(const f32x4*)(L_s + 2604);
        a0 -= Lv[0] * x20;
        a1 -= Lv[1] * x21;
        a0 -= Lv[2] * x22;
        a1 -= Lv[3] * x23;
      }
      { const f32x4 Lv = *(const f32x4*)(L_s + 2608);
        a0 -= Lv[0] * x24;
        a1 -= Lv[1] * x25;
        a0 -= Lv[2] * x26;
        a1 -= Lv[3] * x27;
      }
      { const f32x4 Lv = *(const f32x4*)(L_s + 2612);
        a0 -= Lv[0] * x28;
        a1 -= Lv[1] * x29;
        a0 -= Lv[2] * x30;
        a1 -= Lv[3] * x31;
      }
      { const f32x4 Lv = *(const f32x4*)(L_s + 2616);
        a0 -= Lv[0] * x32;
        a1 -= Lv[1] * x33;
        a0 -= Lv[2] * x34;
        a1 -= Lv[3] * x35;
      }
      { const f32x4 Lv = *(const f32x4*)(L_s + 2620);
        a0 -= Lv[0] * x36;
        a1 -= Lv[1] * x37;
      }
      x38 = a0 + a1; }
    { float a0 = bf2f(colp[5304]) * mulp[39]; float a1 = 0.f;
      { const f32x4 Lv = *(const f32x4*)(L_s + 2652);
        a0 -= Lv[0] * x0;
        a1 -= Lv[1] * x1;
        a0 -= Lv[2] * x2;
        a1 -= Lv[3] * x3;
      }
      { const f32x4 Lv = *(const f32x4*)(L_s + 2656);
        a0 -= Lv[0] * x4;
        a1 -= Lv[1] * x5;
        a0 -= Lv[2] * x6;
        a1 -= Lv[3] * x7;
      }
      { const f32x4 Lv = *(const f32x4*)(L_s + 2660);
        a0 -= Lv[0] * x8;
        a1 -= Lv[1] * x9;
        a0 -= Lv[2] * x10;
        a1 -= Lv[3] * x11;
      }
      { const f32x4 Lv = *(const f32x4*)(L_s + 2664);
        a0 -= Lv[0] * x12;
        a1 -= Lv[1] * x13;
        a0 -= Lv[2] * x14;
        a1 -= Lv[3] * x15;
      }
      { const f32x4 Lv = *(const f32x4*)(L_s + 2668);
        a0 -= Lv[0] * x16;
        a1 -= Lv[1] * x17;
        a0 -= Lv[2] * x18;
        a1 -= Lv[3] * x19;
      }
      { const f32x4 Lv = *(const f32x4*)(L_s + 2672);
        a0 -= Lv[0] * x20;
        a1 -= Lv[1] * x21;
        a0 -= Lv[2] * x22;
        a1 -= Lv[3] * x23;
      }
      { const f32x4 Lv = *(const f32x4*)(L_s + 2676);
        a0 -= Lv[0] * x24;
        a1 -= Lv[1] * x25;
        a0 -= Lv[2] * x26;
        a1 -= Lv[3] * x27;
      }
      { const f32x4 Lv = *(const f32x4*)(L_s + 2680);
        a0 -= Lv[0] * x28;
        a1 -= Lv[1] * x29;
        a0 -= Lv[2] * x30;
        a1 -= Lv[3] * x31;
      }
      { const f32x4 Lv = *(const f32x4*)(L_s + 2684);
        a0 -= Lv[0] * x32;
        a1 -= Lv[1] * x33;
        a0 -= Lv[2] * x34;
        a1 -= Lv[3] * x35;
      }
      { const f32x4 Lv = *(const f32x4*)(L_s + 2688);
        a0 -= Lv[0] * x36;
        a1 -= Lv[1] * x37;
        a0 -= Lv[2] * x38;
      }
      x39 = a0 + a1; } __builtin_amdgcn_sched_barrier(0);
    { float a0 = bf2f(colp[5440]) * mulp[40]; float a1 = 0.f;
      { const f32x4 Lv = *(const f32x4*)(L_s + 2720);
        a0 -= Lv[0] * x0;
        a1 -= Lv[1] * x1;
        a0 -= Lv[2] * x2;
        a1 -= Lv[3] * x3;
      }
      { const f32x4 Lv = *(const f32x4*)(L_s + 2724);
        a0 -= Lv[0] * x4;
        a1 -= Lv[1] * x5;
        a0 -= Lv[2] * x6;
        a1 -= Lv[3] * x7;
      }
      { const f32x4 Lv = *(const f32x4*)(L_s + 2728);
        a0 -= Lv[0] * x8;
        a1 -= Lv[1] * x9;
        a0 -= Lv[2] * x10;
        a1 -= Lv[3] * x11;
      }
      { const f32x4 Lv = *(const f32x4*)(L_s + 2732);
        a0 -= Lv[0] * x12;
        a1 -= Lv[1] * x13;
        a0 -= Lv[2] * x14;
        a1 -= Lv[3] * x15;
      }
      { const f32x4 Lv = *(const f32x4*)(L_s + 2736);
        a0 -= Lv[0] * x16;
        a1 -= Lv[1] * x17;
        a0 -= Lv[2] * x18;
        a1 -= Lv[3] * x19;
      }
      { const f32x4 Lv = *(const f32x4*)(L_s + 2740);
        a0 -= Lv[0] * x20;
        a1 -= Lv[1] * x21;
        a0 -= Lv[2] * x22;
        a1 -= Lv[3] * x23;
      }
      { const f32x4 Lv = *(const f32x4*)(L_s + 2744);
        a0 -= Lv[0] * x24;
        a1 -= Lv[1] * x25;
        a0 -= Lv[2] * x26;
        a1 -= Lv[3] * x27;
      }
      { const f32x4 Lv = *(const f32x4*)(L_s + 2748);
        a0 -= Lv[0] * x28;
        a1 -= Lv[1] * x29;
        a0 -= Lv[2] * x30;
        a1 -= Lv[3] * x31;
      }
      { const f32x4 Lv = *(const f32x4*)(L_s + 2752);
        a0 -= Lv[0] * x32;
        a1 -= Lv[1] * x33;
        a0 -= Lv[2] * x34;
        a1 -= Lv[3] * x35;
      }
      { const f32x4 Lv = *(const f32x4*)(L_s + 2756);
        a0 -= Lv[0] * x36;
        a1 -= Lv[1] * x37;
        a0 -= Lv[2] * x38;
        a1 -= Lv[3] * x39;
      }
      x40 = a0 + a1; }
    { float a0 = bf2f(colp[5576]) * mulp[41]; float a1 = 0.f;
      { const f32x4 Lv = *(const f32x4*)(L_s + 2788);
        a0 -= Lv[0] * x0;
        a1 -= Lv[1] * x1;
        a0 -= Lv[2] * x2;
        a1 -= Lv[3] * x3;
      }
      { const f32x4 Lv = *(const f32x4*)(L_s + 2792);
        a0 -= Lv[0] * x4;
        a1 -= Lv[1] * x5;
        a0 -= Lv[2] * x6;
        a1 -= Lv[3] * x7;
      }
      { const f32x4 Lv = *(const f32x4*)(L_s + 2796);
        a0 -= Lv[0] * x8;
        a1 -= Lv[1] * x9;
        a0 -= Lv[2] * x10;
        a1 -= Lv[3] * x11;
      }
      { const f32x4 Lv = *(const f32x4*)(L_s + 2800);
        a0 -= Lv[0] * x12;
        a1 -= Lv[1] * x13;
        a0 -= Lv[2] * x14;
        a1 -= Lv[3] * x15;
      }
      { const f32x4 Lv = *(const f32x4*)(L_s + 2804);
        a0 -= Lv[0] * x16;
        a1 -= Lv[1] * x17;
        a0 -= Lv[2] * x18;
        a1 -= Lv[3] * x19;
      }
      { const f32x4 Lv = *(const f32x4*)(L_s + 2808);
        a0 -= Lv[0] * x20;
        a1 -= Lv[1] * x21;
        a0 -= Lv[2] * x22;
        a1 -= Lv[3] * x23;
      }
      { const f32x4 Lv = *(const f32x4*)(L_s + 2812);
        a0 -= Lv[0] * x24;
        a1 -= Lv[1] * x25;
        a0 -= Lv[2] * x26;
        a1 -= Lv[3] * x27;
      }
      { const f32x4 Lv = *(const f32x4*)(L_s + 2816);
        a0 -= Lv[0] * x28;
        a1 -= Lv[1] * x29;
        a0 -= Lv[2] * x30;
        a1 -= Lv[3] * x31;
      }
      { const f32x4 Lv = *(const f32x4*)(L_s + 2820);
        a0 -= Lv[0] * x32;
        a1 -= Lv[1] * x33;
        a0 -= Lv[2] * x34;
        a1 -= Lv[3] * x35;
      }
      { const f32x4 Lv = *(const f32x4*)(L_s + 2824);
        a0 -= Lv[0] * x36;
        a1 -= Lv[1] * x37;
        a0 -= Lv[2] * x38;
        a1 -= Lv[3] * x39;
      }
      { const f32x4 Lv = *(const f32x4*)(L_s + 2828);
        a0 -= Lv[0] * x40;
      }
      x41 = a0 + a1; } __builtin_amdgcn_sched_barrier(0);
    { float a0 = bf2f(colp[5712]) * mulp[42]; float a1 = 0.f;
      { const f32x4 Lv = *(const f32x4*)(L_s + 2856);
        a0 -= Lv[0] * x0;
        a1 -= Lv[1] * x1;
        a0 -= Lv[2] * x2;
        a1 -= Lv[3] * x3;
      }
      { const f32x4 Lv = *(const f32x4*)(L_s + 2860);
        a0 -= Lv[0] * x4;
        a1 -= Lv[1] * x5;
        a0 -= Lv[2] * x6;
        a1 -= Lv[3] * x7;
      }
      { const f32x4 Lv = *(const f32x4*)(L_s + 2864);
        a0 -= Lv[0] * x8;
        a1 -= Lv[1] * x9;
        a0 -= Lv[2] * x10;
        a1 -= Lv[3] * x11;
      }
      { const f32x4 Lv = *(const f32x4*)(L_s + 2868);
        a0 -= Lv[0] * x12;
        a1 -= Lv[1] * x13;
        a0 -= Lv[2] * x14;
        a1 -= Lv[3] * x15;
      }
      { const f32x4 Lv = *(const f32x4*)(L_s + 2872);
        a0 -= Lv[0] * x16;
        a1 -= Lv[1] * x17;
        a0 -= Lv[2] * x18;
        a1 -= Lv[3] * x19;
      }
      { const f32x4 Lv = *(const f32x4*)(L_s + 2876);
        a0 -= Lv[0] * x20;
        a1 -= Lv[1] * x21;
        a0 -= Lv[2] * x22;
        a1 -= Lv[3] * x23;
      }
      { const f32x4 Lv = *(const f32x4*)(L_s + 2880);
        a0 -= Lv[0] * x24;
        a1 -= Lv[1] * x25;
        a0 -= Lv[2] * x26;
        a1 -= Lv[3] * x27;
      }
      { const f32x4 Lv = *(const f32x4*)(L_s + 2884);
        a0 -= Lv[0] * x28;
        a1 -= Lv[1] * x29;
        a0 -= Lv[2] * x30;
        a1 -= Lv[3] * x31;
      }
      { const f32x4 Lv = *(const f32x4*)(L_s + 2888);
        a0 -= Lv[0] * x32;
        a1 -= Lv[1] * x33;
        a0 -= Lv[2] * x34;
        a1 -= Lv[3] * x35;
      }
      { const f32x4 Lv = *(const f32x4*)(L_s + 2892);
        a0 -= Lv[0] * x36;
        a1 -= Lv[1] * x37;
        a0 -= Lv[2] * x38;
        a1 -= Lv[3] * x39;
      }
      { const f32x4 Lv = *(const f32x4*)(L_s + 2896);
        a0 -= Lv[0] * x40;
        a1 -= Lv[1] * x41;
      }
      x42 = a0 + a1; }
    { float a0 = bf2f(colp[5848]) * mulp[43]; float a1 = 0.f;
      { const f32x4 Lv = *(const f32x4*)(L_s + 2924);
        a0 -= Lv[0] * x0;
        a1 -= Lv[1] * x1;
        a0 -= Lv[2] * x2;
        a1 -= Lv[3] * x3;
      }
      { const f32x4 Lv = *(const f32x4*)(L_s + 2928);
        a0 -= Lv[0] * x4;
        a1 -= Lv[1] * x5;
        a0 -= Lv[2] * x6;
        a1 -= Lv[3] * x7;
      }
      { const f32x4 Lv = *(const f32x4*)(L_s + 2932);
        a0 -= Lv[0] * x8;
        a1 -= Lv[1] * x9;
        a0 -= Lv[2] * x10;
        a1 -= Lv[3] * x11;
      }
      { const f32x4 Lv = *(const f32x4*)(L_s + 2936);
        a0 -= Lv[0] * x12;
        a1 -= Lv[1] * x13;
        a0 -= Lv[2] * x14;
        a1 -= Lv[3] * x15;
      }
      { const f32x4 Lv = *(const f32x4*)(L_s + 2940);
        a0 -= Lv[0] * x16;
        a1 -= Lv[1] * x17;
        a0 -= Lv[2] * x18;
        a1 -= Lv[3] * x19;
      }
      { const f32x4 Lv = *(const f32x4*)(L_s + 2944);
        a0 -= Lv[0] * x20;
        a1 -= Lv[1] * x21;
        a0 -= Lv[2] * x22;
        a1 -= Lv[3] * x23;
      }
      { const f32x4 Lv = *(const f32x4*)(L_s + 2948);
        a0 -= Lv[0] * x24;
        a1 -= Lv[1] * x25;
        a0 -= Lv[2] * x26;
        a1 -= Lv[3] * x27;
      }
      { const f32x4 Lv = *(const f32x4*)(L_s + 2952);
        a0 -= Lv[0] * x28;
        a1 -= Lv[1] * x29;
        a0 -= Lv[2] * x30;
        a1 -= Lv[3] * x31;
      }
      { const f32x4 Lv = *(const f32x4*)(L_s + 2956);
        a0 -= Lv[0] * x32;
        a1 -= Lv[1] * x33;
        a0 -= Lv[2] * x34;
        a1 -= Lv[3] * x35;
      }
      { const f32x4 Lv = *(const f32x4*)(L_s + 2960);
        a0 -= Lv[0] * x36;
        a1 -= Lv[1] * x37;
        a0 -= Lv[2] * x38;
        a1 -= Lv[3] * x39;
      }
      { const f32x4 Lv = *(const f32x4*)(L_s + 2964);
        a0 -= Lv[0] * x40;
        a1 -= Lv[1] * x41;
        a0 -= Lv[2] * x42;
      }
      x43 = a0 + a1; } __builtin_amdgcn_sched_barrier(0);
    { float a0 = bf2f(colp[5984]) * mulp[44]; float a1 = 0.f;
      { const f32x4 Lv = *(const f32x4*)(L_s + 2992);
        a0 -= Lv[0] * x0;
        a1 -= Lv[1] * x1;
        a0 -= Lv[2] * x2;
        a1 -= Lv[3] * x3;
      }
      { const f32x4 Lv = *(const f32x4*)(L_s + 2996);
        a0 -= Lv[0] * x4;
        a1 -= Lv[1] * x5;
        a0 -= Lv[2] * x6;
        a1 -= Lv[3] * x7;
      }
      { const f32x4 Lv = *(const f32x4*)(L_s + 3000);
        a0 -= Lv[0] * x8;
        a1 -= Lv[1] * x9;
        a0 -= Lv[2] * x10;
        a1 -= Lv[3] * x11;
      }
      { const f32x4 Lv = *(const f32x4*)(L_s + 3004);
        a0 -= Lv[0] * x12;
        a1 -= Lv[1] * x13;
        a0 -= Lv[2] * x14;
        a1 -= Lv[3] * x15;
      }
      { const f32x4 Lv = *(const f32x4*)(L_s + 3008);
        a0 -= Lv[0] * x16;
        a1 -= Lv[1] * x17;
        a0 -= Lv[2] * x18;
        a1 -= Lv[3] * x19;
      }
      { const f32x4 Lv = *(const f32x4*)(L_s + 3012);
        a0 -= Lv[0] * x20;
        a1 -= Lv[1] * x21;
        a0 -= Lv[2] * x22;
        a1 -= Lv[3] * x23;
      }
      { const f32x4 Lv = *(const f32x4*)(L_s + 3016);
        a0 -= Lv[0] * x24;
        a1 -= Lv[1] * x25;
        a0 -= Lv[2] * x26;
        a1 -= Lv[3] * x27;
      }
      { const f32x4 Lv = *(const f32x4*)(L_s + 3020);
        a0 -= Lv[0] * x28;
        a1 -= Lv[1] * x29;
        a0 -= Lv[2] * x30;
        a1 -= Lv[3] * x31;
      }
      { const f32x4 Lv = *(const f32x4*)(L_s + 3024);
        a0 -= Lv[0] * x32;
        a1 -= Lv[1] * x33;
        a0 -= Lv[2] * x34;
        a1 -= Lv[3] * x35;
      }
      { const f32x4 Lv = *(const f32x4*)(L_s + 3028);
        a0 -= Lv[0] * x36;
        a1 -= Lv[1] * x37;
        a0 -= Lv[2] * x38;
        a1 -= Lv[3] * x39;
      }
      { const f32x4 Lv = *(const f32x4*)(L_s + 3032);
        a0 -= Lv[0] * x40;
        a1 -= Lv[1] * x41;
        a0 -= Lv[2] * x42;
        a1 -= Lv[3] * x43;
      }
      x44 = a0 + a1; }
    { float a0 = bf2f(colp[6120]) * mulp[45]; float a1 = 0.f;
      { const f32x4 Lv = *(const f32x4*)(L_s + 3060);
        a0 -= Lv[0] * x0;
        a1 -= Lv[1] * x1;
        a0 -= Lv[2] * x2;
        a1 -= Lv[3] * x3;
      }
      { const f32x4 Lv = *(const f32x4*)(L_s + 3064);
        a0 -= Lv[0] * x4;
        a1 -= Lv[1] * x5;
        a0 -= Lv[2] * x6;
        a1 -= Lv[3] * x7;
      }
      { const f32x4 Lv = *(const f32x4*)(L_s + 3068);
        a0 -= Lv[0] * x8;
        a1 -= Lv[1] * x9;
        a0 -= Lv[2] * x10;
        a1 -= Lv[3] * x11;
      }
      { const f32x4 Lv = *(const f32x4*)(L_s + 3072);
        a0 -= Lv[0] * x12;
        a1 -= Lv[1] * x13;
        a0 -= Lv[2] * x14;
        a1 -= Lv[3] * x15;
      }
      { const f32x4 Lv = *(const f32x4*)(L_s + 3076);
        a0 -= Lv[0] * x16;
        a1 -= Lv[1] * x17;
        a0 -= Lv[2] * x18;
        a1 -= Lv[3] * x19;
      }
      { const f32x4 Lv = *(const f32x4*)(L_s + 3080);
        a0 -= Lv[0] * x20;
        a1 -= Lv[1] * x21;
        a0 -= Lv[2] * x22;
        a1 -= Lv[3] * x23;
      }
      { const f32x4 Lv = *(const f32x4*)(L_s + 3084);
        a0 -= Lv[0] * x24;
        a1 -= Lv[1] * x25;
        a0 -= Lv[2] * x26;
        a1 -= Lv[3] * x27;
      }
      { const f32x4 Lv = *(const f32x4*)(L_s + 3088);
        a0 -= Lv[0] * x28;
        a1 -= Lv[1] * x29;
        a0 -= Lv[2] * x30;
        a1 -= Lv[3] * x31;
      }
      { const f32x4 Lv = *(const f32x4*)(L_s + 3092);
        a0 -= Lv[0] * x32;
        a1 -= Lv[1] * x33;
        a0 -= Lv[2] * x34;
        a1 -= Lv[3] * x35;
      }
      { const f32x4 Lv = *(const f32x4*)(L_s + 3096);
        a0 -= Lv[0] * x36;
        a1 -= Lv[1] * x37;
        a0 -= Lv[2] * x38;
        a1 -= Lv[3] * x39;
      }
      { const f32x4 Lv = *(const f32x4*)(L_s + 3100);
        a0 -= Lv[0] * x40;
        a1 -= Lv[1] * x41;
        a0 -= Lv[2] * x42;
        a1 -= Lv[3] * x43;
      }
      { const f32x4 Lv = *(const f32x4*)(L_s + 3104);
        a0 -= Lv[0] * x44;
      }
      x45 = a0 + a1; } __builtin_amdgcn_sched_barrier(0);
    { float a0 = bf2f(colp[6256]) * mulp[46]; float a1 = 0.f;
      { const f32x4 Lv = *(const f32x4*)(L_s + 3128);
        a0 -= Lv[0] * x0;
        a1 -= Lv[1] * x1;
        a0 -= Lv[2] * x2;
        a1 -= Lv[3] * x3;
      }
      { const f32x4 Lv = *(const f32x4*)(L_s + 3132);
        a0 -= Lv[0] * x4;
        a1 -= Lv[1] * x5;
        a0 -= Lv[2] * x6;
        a1 -= Lv[3] * x7;
      }
      { const f32x4 Lv = *(const f32x4*)(L_s + 3136);
        a0 -= Lv[0] * x8;
        a1 -= Lv[1] * x9;
        a0 -= Lv[2] * x10;
        a1 -= Lv[3] * x11;
      }
      { const f32x4 Lv = *(const f32x4*)(L_s + 3140);
        a0 -= Lv[0] * x12;
        a1 -= Lv[1] * x13;
        a0 -= Lv[2] * x14;
        a1 -= Lv[3] * x15;
      }
      { const f32x4 Lv = *(const f32x4*)(L_s + 3144);
        a0 -= Lv[0] * x16;
        a1 -= Lv[1] * x17;
        a0 -= Lv[2] * x18;
        a1 -= Lv[3] * x19;
      }
      { const f32x4 Lv = *(const f32x4*)(L_s + 3148);
        a0 -= Lv[0] * x20;
        a1 -= Lv[1] * x21;
        a0 -= Lv[2] * x22;
        a1 -= Lv[3] * x23;
      }
      { const f32x4 Lv = *(const f32x4*)(L_s + 3152);
        a0 -= Lv[0] * x24;
        a1 -= Lv[1] * x25;
        a0 -= Lv[2] * x26;
        a1 -= Lv[3] * x27;
      }
      { const f32x4 Lv = *(const f32x4*)(L_s + 3156);
        a0 -= Lv[0] * x28;
        a1 -= Lv[1] * x29;
        a0 -= Lv[2] * x30;
        a1 -= Lv[3] * x31;
      }
      { const f32x4 Lv = *(const f32x4*)(L_s + 3160);
        a0 -= Lv[0] * x32;
        a1 -= Lv[1] * x33;
        a0 -= Lv[2] * x34;
        a1 -= Lv[3] * x35;
      }
      { const f32x4 Lv = *(const f32x4*)(L_s + 3164);
        a0 -= Lv[0] * x36;
        a1 -= Lv[1] * x37;
        a0 -= Lv[2] * x38;
        a1 -= Lv[3] * x39;
      }
      { const f32x4 Lv = *(const f32x4*)(L_s + 3168);
        a0 -= Lv[0] * x40;
        a1 -= Lv[1] * x41;
        a0 -= Lv[2] * x42;
        a1 -= Lv[3] * x43;
      }
      { const f32x4 Lv = *(const f32x4*)(L_s + 3172);
        a0 -= Lv[0] * x44;
        a1 -= Lv[1] * x45;
      }
      x46 = a0 + a1; }
    { float a0 = bf2f(colp[6392]) * mulp[47]; float a1 = 0.f;
      { const f32x4 Lv = *(const f32x4*)(L_s + 3196);
        a0 -= Lv[0] * x0;
        a1 -= Lv[1] * x1;
        a0 -= Lv[2] * x2;
        a1 -= Lv[3] * x3;
      }
      { const f32x4 Lv = *(const f32x4*)(L_s + 3200);
        a0 -= Lv[0] * x4;
        a1 -= Lv[1] * x5;
        a0 -= Lv[2] * x6;
        a1 -= Lv[3] * x7;
      }
      { const f32x4 Lv = *(const f32x4*)(L_s + 3204);
        a0 -= Lv[0] * x8;
        a1 -= Lv[1] * x9;
        a0 -= Lv[2] * x10;
        a1 -= Lv[3] * x11;
      }
      { const f32x4 Lv = *(const f32x4*)(L_s + 3208);
        a0 -= Lv[0] * x12;
        a1 -= Lv[1] * x13;
        a0 -= Lv[2] * x14;
        a1 -= Lv[3] * x15;
      }
      { const f32x4 Lv = *(const f32x4*)(L_s + 3212);
        a0 -= Lv[0] * x16;
        a1 -= Lv[1] * x17;
        a0 -= Lv[2] * x18;
        a1 -= Lv[3] * x19;
      }
      { const f32x4 Lv = *(const f32x4*)(L_s + 3216);
        a0 -= Lv[0] * x20;
        a1 -= Lv[1] * x21;
        a0 -= Lv[2] * x22;
        a1 -= Lv[3] * x23;
      }
      { const f32x4 Lv = *(const f32x4*)(L_s + 3220);
        a0 -= Lv[0] * x24;
        a1 -= Lv[1] * x25;
        a0 -= Lv[2] * x26;
        a1 -= Lv[3] * x27;
      }
      { const f32x4 Lv = *(const f32x4*)(L_s + 3224);
        a0 -= Lv[0] * x28;
        a1 -= Lv[1] * x29;
        a0 -= Lv[2] * x30;
        a1 -= Lv[3] * x31;
      }
      { const f32x4 Lv = *(const f32x4*)(L_s + 3228);
        a0 -= Lv[0] * x32;
        a1 -= Lv[1] * x33;
        a0 -= Lv[2] * x34;
        a1 -= Lv[3] * x35;
      }
      { const f32x4 Lv = *(const f32x4*)(L_s + 3232);
        a0 -= Lv[0] * x36;
        a1 -= Lv[1] * x37;
        a0 -= Lv[2] * x38;
        a1 -= Lv[3] * x39;
      }
      { const f32x4 Lv = *(const f32x4*)(L_s + 3236);
        a0 -= Lv[0] * x40;
        a1 -= Lv[1] * x41;
        a0 -= Lv[2] * x42;
        a1 -= Lv[3] * x43;
      }
      { const f32x4 Lv = *(const f32x4*)(L_s + 3240);
        a0 -= Lv[0] * x44;
        a1 -= Lv[1] * x45;
        a0 -= Lv[2] * x46;
      }
      x47 = a0 + a1; } __builtin_amdgcn_sched_barrier(0);
    { float a0 = bf2f(colp[6528]) * mulp[48]; float a1 = 0.f;
      { const f32x4 Lv = *(const f32x4*)(L_s + 3264);
        a0 -= Lv[0] * x0;
        a1 -= Lv[1] * x1;
        a0 -= Lv[2] * x2;
        a1 -= Lv[3] * x3;
      }
      { const f32x4 Lv = *(const f32x4*)(L_s + 3268);
        a0 -= Lv[0] * x4;
        a1 -= Lv[1] * x5;
        a0 -= Lv[2] * x6;
        a1 -= Lv[3] * x7;
      }
      { const f32x4 Lv = *(const f32x4*)(L_s + 3272);
        a0 -= Lv[0] * x8;
        a1 -= Lv[1] * x9;
        a0 -= Lv[2] * x10;
        a1 -= Lv[3] * x11;
      }
      { const f32x4 Lv = *(const f32x4*)(L_s + 3276);
        a0 -= Lv[0] * x12;
        a1 -= Lv[1] * x13;
        a0 -= Lv[2] * x14;
        a1 -= Lv[3] * x15;
      }
      { const f32x4 Lv = *(const f32x4*)(L_s + 3280);
        a0 -= Lv[0] * x16;
        a1 -= Lv[1] * x17;
        a0 -= Lv[2] * x18;
        a1 -= Lv[3] * x19;
      }
      { const f32x4 Lv = *(const f32x4*)(L_s + 3284);
        a0 -= Lv[0] * x20;
        a1 -= Lv[1] * x21;
        a0 -= Lv[2] * x22;
        a1 -= Lv[3] * x23;
      }
      { const f32x4 Lv = *(const f32x4*)(L_s + 3288);
        a0 -= Lv[0] * x24;
        a1 -= Lv[1] * x25;
        a0 -= Lv[2] * x26;
        a1 -= Lv[3] * x27;
      }
      { const f32x4 Lv = *(const f32x4*)(L_s + 3292);
        a0 -= Lv[0] * x28;
        a1 -= Lv[1] * x29;
        a0 -= Lv[2] * x30;
        a1 -= Lv[3] * x31;
      }
      { const f32x4 Lv = *(const f32x4*)(L_s + 3296);
        a0 -= Lv[0] * x32;
        a1 -= Lv[1] * x33;
        a0 -= Lv[2] * x34;
        a1 -= Lv[3] * x35;
      }
      { const f32x4 Lv = *(const f32x4*)(L_s + 3300);
        a0 -= Lv[0] * x36;
        a1 -= Lv[1] * x37;
        a0 -= Lv[2] * x38;
        a1 -= Lv[3] * x39;
      }
      { const f32x4 Lv = *(const f32x4*)(L_s + 3304);
        a0 -= Lv[0] * x40;
        a1 -= Lv[1] * x41;
        a0 -= Lv[2] * x42;
        a1 -= Lv[3] * x43;
      }
      { const f32x4 Lv = *(const f32x4*)(L_s + 3308);
        a0 -= Lv[0] * x44;
        a1 -= Lv[1] * x45;
        a0 -= Lv[2] * x46;
        a1 -= Lv[3] * x47;
      }
      x48 = a0 + a1; }
    { float a0 = bf2f(colp[6664]) * mulp[49]; float a1 = 0.f;
      { const f32x4 Lv = *(const f32x4*)(L_s + 3332);
        a0 -= Lv[0] * x0;
        a1 -= Lv[1] * x1;
        a0 -= Lv[2] * x2;
        a1 -= Lv[3] * x3;
      }
      { const f32x4 Lv = *(const f32x4*)(L_s + 3336);
        a0 -= Lv[0] * x4;
        a1 -= Lv[1] * x5;
        a0 -= Lv[2] * x6;
        a1 -= Lv[3] * x7;
      }
      { const f32x4 Lv = *(const f32x4*)(L_s + 3340);
        a0 -= Lv[0] * x8;
        a1 -= Lv[1] * x9;
        a0 -= Lv[2] * x10;
        a1 -= Lv[3] * x11;
      }
      { const f32x4 Lv = *(const f32x4*)(L_s + 3344);
        a0 -= Lv[0] * x12;
        a1 -= Lv[1] * x13;
        a0 -= Lv[2] * x14;
        a1 -= Lv[3] * x15;
      }
      { const f32x4 Lv = *(const f32x4*)(L_s + 3348);
        a0 -= Lv[0] * x16;
        a1 -= Lv[1] * x17;
        a0 -= Lv[2] * x18;
        a1 -= Lv[3] * x19;
      }
      { const f32x4 Lv = *(const f32x4*)(L_s + 3352);
        a0 -= Lv[0] * x20;
        a1 -= Lv[1] * x21;
        a0 -= Lv[2] * x22;
        a1 -= Lv[3] * x23;
      }
      { const f32x4 Lv = *(const f32x4*)(L_s + 3356);
        a0 -= Lv[0] * x24;
        a1 -= Lv[1] * x25;
        a0 -= Lv[2] * x26;
        a1 -= Lv[3] * x27;
      }
      { const f32x4 Lv = *(const f32x4*)(L_s + 3360);
        a0 -= Lv[0] * x28;
        a1 -= Lv[1] * x29;
        a0 -= Lv[2] * x30;
        a1 -= Lv[3] * x31;
      }
      { const f32x4 Lv = *(const f32x4*)(L_s + 3364);
        a0 -= Lv[0] * x32;
        a1 -= Lv[1] * x33;
        a0 -= Lv[2] * x34;
        a1 -= Lv[3] * x35;
      }
      { const f32x4 Lv = *(const f32x4*)(L_s + 3368);
        a0 -= Lv[0] * x36;
        a1 -= Lv[1] * x37;
        a0 -= Lv[2] * x38;
        a1 -= Lv[3] * x39;
      }
      { const f32x4 Lv = *(const f32x4*)(L_s + 3372);
        a0 -= Lv[0] * x40;
        a1 -= Lv[1] * x41;
        a0 -= Lv[2] * x42;
        a1 -= Lv[3] * x43;
      }
      { const f32x4 Lv = *(const f32x4*)(L_s + 3376);
        a0 -= Lv[0] * x44;
        a1 -= Lv[1] * x45;
        a0 -= Lv[2] * x46;
        a1 -= Lv[3] * x47;
      }
      { const f32x4 Lv = *(const f32x4*)(L_s + 3380);
        a0 -= Lv[0] * x48;
      }
      x49 = a0 + a1; } __builtin_amdgcn_sched_barrier(0);
    { float a0 = bf2f(colp[6800]) * mulp[50]; float a1 = 0.f;
      { const f32x4 Lv = *(const f32x4*)(L_s + 3400);
        a0 -= Lv[0] * x0;
        a1 -= Lv[1] * x1;
        a0 -= Lv[2] * x2;
        a1 -= Lv[3] * x3;
      }
      { const f32x4 Lv = *(const f32x4*)(L_s + 3404);
        a0 -= Lv[0] * x4;
        a1 -= Lv[1] * x5;
        a0 -= Lv[2] * x6;
        a1 -= Lv[3] * x7;
      }
      { const f32x4 Lv = *(const f32x4*)(L_s + 3408);
        a0 -= Lv[0] * x8;
        a1 -= Lv[1] * x9;
        a0 -= Lv[2] * x10;
        a1 -= Lv[3] * x11;
      }
      { const f32x4 Lv = *(const f32x4*)(L_s + 3412);
        a0 -= Lv[0] * x12;
        a1 -= Lv[1] * x13;
        a0 -= Lv[2] * x14;
        a1 -= Lv[3] * x15;
      }
      { const f32x4 Lv = *(const f32x4*)(L_s + 3416);
        a0 -= Lv[0] * x16;
        a1 -= Lv[1] * x17;
        a0 -= Lv[2] * x18;
        a1 -= Lv[3] * x19;
      }
      { const f32x4 Lv = *(const f32x4*)(L_s + 3420);
        a0 -= Lv[0] * x20;
        a1 -= Lv[1] * x21;
        a0 -= Lv[2] * x22;
        a1 -= Lv[3] * x23;
      }
      { const f32x4 Lv = *(const f32x4*)(L_s + 3424);
        a0 -= Lv[0] * x24;
        a1 -= Lv[1] * x25;
        a0 -= Lv[2] * x26;
        a1 -= Lv[3] * x27;
      }
      { const f32x4 Lv = *(const f32x4*)(L_s + 3428);
        a0 -= Lv[0] * x28;
        a1 -= Lv[1] * x29;
        a0 -= Lv[2] * x30;
        a1 -= Lv[3] * x31;
      }
      { const f32x4 Lv = *(const f32x4*)(L_s + 3432);
        a0 -= Lv[0] * x32;
        a1 -= Lv[1] * x33;
        a0 -= Lv[2] * x34;
        a1 -= Lv[3] * x35;
      }
      { const f32x4 Lv = *(const f32x4*)(L_s + 3436);
        a0 -= Lv[0] * x36;
        a1 -= Lv[1] * x37;
        a0 -= Lv[2] * x38;
        a1 -= Lv[3] * x39;
      }
      { const f32x4 Lv = *(const f32x4*)(L_s + 3440);
        a0 -= Lv[0] * x40;
        a1 -= Lv[1] * x41;
        a0 -= Lv[2] * x42;
        a1 -= Lv[3] * x43;
      }
      { const f32x4 Lv = *(const f32x4*)(L_s + 3444);
        a0 -= Lv[0] * x44;
        a1 -= Lv[1] * x45;
        a0 -= Lv[2] * x46;
        a1 -= Lv[3] * x47;
      }
      { const f32x4 Lv = *(const f32x4*)(L_s + 3448);
        a0 -= Lv[0] * x48;
        a1 -= Lv[1] * x49;
      }
      x50 = a0 + a1; }
    { float a0 = bf2f(colp[6936]) * mulp[51]; float a1 = 0.f;
      { const f32x4 Lv = *(const f32x4*)(L_s + 3468);
        a0 -= Lv[0] * x0;
        a1 -= Lv[1] * x1;
        a0 -= Lv[2] * x2;
        a1 -= Lv[3] * x3;
      }
      { const f32x4 Lv = *(const f32x4*)(L_s + 3472);
        a0 -= Lv[0] * x4;
        a1 -= Lv[1] * x5;
        a0 -= Lv[2] * x6;
        a1 -= Lv[3] * x7;
      }
      { const f32x4 Lv = *(const f32x4*)(L_s + 3476);
        a0 -= Lv[0] * x8;
        a1 -= Lv[1] * x9;
        a0 -= Lv[2] * x10;
        a1 -= Lv[3] * x11;
      }
      { const f32x4 Lv = *(const f32x4*)(L_s + 3480);
        a0 -= Lv[0] * x12;
        a1 -= Lv[1] * x13;
        a0 -= Lv[2] * x14;
        a1 -= Lv[3] * x15;
      }
      { const f32x4 Lv = *(const f32x4*)(L_s + 3484);
        a0 -= Lv[0] * x16;
        a1 -= Lv[1] * x17;
        a0 -= Lv[2] * x18;
        a1 -= Lv[3] * x19;
      }
      { const f32x4 Lv = *(const f32x4*)(L_s + 3488);
        a0 -= Lv[0] * x20;
        a1 -= Lv[1] * x21;
        a0 -= Lv[2] * x22;
        a1 -= Lv[3] * x23;
      }
      { const f32x4 Lv = *(const f32x4*)(L_s + 3492);
        a0 -= Lv[0] * x24;
        a1 -= Lv[1] * x25;
        a0 -= Lv[2] * x26;
        a1 -= Lv[3] * x27;
      }
      { const f32x4 Lv = *(const f32x4*)(L_s + 3496);
        a0 -= Lv[0] * x28;
        a1 -= Lv[1] * x29;
        a0 -= Lv[2] * x30;
        a1 -= Lv[3] * x31;
      }
      { const f32x4 Lv = *(const f32x4*)(L_s + 3500);
        a0 -= Lv[0] * x32;
        a1 -= Lv[1] * x33;
        a0 -= Lv[2] * x34;
        a1 -= Lv[3] * x35;
      }
      { const f32x4 Lv = *(const f32x4*)(L_s + 3504);
        a0 -= Lv[0] * x36;
        a1 -= Lv[1] * x37;
        a0 -= Lv[2] * x38;
        a1 -= Lv[3] * x39;
      }
      { const f32x4 Lv = *(const f32x4*)(L_s + 3508);
        a0 -= Lv[0] * x40;
        a1 -= Lv[1] * x41;
        a0 -= Lv[2] * x42;
        a1 -= Lv[3] * x43;
      }
      { const f32x4 Lv = *(const f32x4*)(L_s + 3512);
        a0 -= Lv[0] * x44;
        a1 -= Lv[1] * x45;
        a0 -= Lv[2] * x46;
        a1 -= Lv[3] * x47;
      }
      { const f32x4 Lv = *(const f32x4*)(L_s + 3516);
        a0 -= Lv[0] * x48;
        a1 -= Lv[1] * x49;
        a0 -= Lv[2] * x50;
      }
      x51 = a0 + a1; } __builtin_amdgcn_sched_barrier(0);
    { float a0 = bf2f(colp[7072]) * mulp[52]; float a1 = 0.f;
      { const f32x4 Lv = *(const f32x4*)(L_s + 3536);
        a0 -= Lv[0] * x0;
        a1 -= Lv[1] * x1;
        a0 -= Lv[2] * x2;
        a1 -= Lv[3] * x3;
      }
      { const f32x4 Lv = *(const f32x4*)(L_s + 3540);
        a0 -= Lv[0] * x4;
        a1 -= Lv[1] * x5;
        a0 -= Lv[2] * x6;
        a1 -= Lv[3] * x7;
      }
      { const f32x4 Lv = *(const f32x4*)(L_s + 3544);
        a0 -= Lv[0] * x8;
        a1 -= Lv[1] * x9;
        a0 -= Lv[2] * x10;
        a1 -= Lv[3] * x11;
      }
      { const f32x4 Lv = *(const f32x4*)(L_s + 3548);
        a0 -= Lv[0] * x12;
        a1 -= Lv[1] * x13;
        a0 -= Lv[2] * x14;
        a1 -= Lv[3] * x15;
      }
      { const f32x4 Lv = *(const f32x4*)(L_s + 3552);
        a0 -= Lv[0] * x16;
        a1 -= Lv[1] * x17;
        a0 -= Lv[2] * x18;
        a1 -= Lv[3] * x19;
      }
      { const f32x4 Lv = *(const f32x4*)(L_s + 3556);
        a0 -= Lv[0] * x20;
        a1 -= Lv[1] * x21;
        a0 -= Lv[2] * x22;
        a1 -= Lv[3] * x23;
      }
      { const f32x4 Lv = *(const f32x4*)(L_s + 3560);
        a0 -= Lv[0] * x24;
        a1 -= Lv[1] * x25;
        a0 -= Lv[2] * x26;
        a1 -= Lv[3] * x27;
      }
      { const f32x4 Lv = *(const f32x4*)(L_s + 3564);
        a0 -= Lv[0] * x28;
        a1 -= Lv[1] * x29;
        a0 -= Lv[2] * x30;
        a1 -= Lv[3] * x31;
      }
      { const f32x4 Lv = *(const f32x4*)(L_s + 3568);
        a0 -= Lv[0] * x32;
        a1 -= Lv[1] * x33;
        a0 -= Lv[2] * x34;
        a1 -= Lv[3] * x35;
      }
      { const f32x4 Lv = *(const f32x4*)(L_s + 3572);
        a0 -= Lv[0] * x36;
        a1 -= Lv[1] * x37;
        a0 -= Lv[2] * x38;
        a1 -= Lv[3] * x39;
      }
      { const f32x4 Lv = *(const f32x4*)(L_s + 3576);
        a0 -= Lv[0] * x40;
        a1 -= Lv[1] * x41;
        a0 -= Lv[2] * x42;
        a1 -= Lv[3] * x43;
      }
      { const f32x4 Lv = *(const f32x4*)(L_s + 3580);
        a0 -= Lv[0] * x44;
        a1 -= Lv[1] * x45;
        a0 -= Lv[2] * x46;
        a1 -= Lv[3] * x47;
      }
      { const f32x4 Lv = *(const f32x4*)(L_s + 3584);
        a0 -= Lv[0] * x48;
        a1 -= Lv[1] * x49;
        a0 -= Lv[2] * x50;
        a1 -= Lv[3] * x51;
      }
      x52 = a0 + a1; }
    { float a0 = bf2f(colp[7208]) * mulp[53]; float a1 = 0.f;
      { const f32x4 Lv = *(const f32x4*)(L_s + 3604);
        a0 -= Lv[0] * x0;
        a1 -= Lv[1] * x1;
        a0 -= Lv[2] * x2;
        a1 -= Lv[3] * x3;
      }
      { const f32x4 Lv = *(const f32x4*)(L_s + 3608);
        a0 -= Lv[0] * x4;
        a1 -= Lv[1] * x5;
        a0 -= Lv[2] * x6;
        a1 -= Lv[3] * x7;
      }
      { const f32x4 Lv = *(const f32x4*)(L_s + 3612);
        a0 -= Lv[0] * x8;
        a1 -= Lv[1] * x9;
        a0 -= Lv[2] * x10;
        a1 -= Lv[3] * x11;
      }
      { const f32x4 Lv = *(const f32x4*)(L_s + 3616);
        a0 -= Lv[0] * x12;
        a1 -= Lv[1] * x13;
        a0 -= Lv[2] * x14;
        a1 -= Lv[3] * x15;
      }
      { const f32x4 Lv = *(const f32x4*)(L_s + 3620);
        a0 -= Lv[0] * x16;
        a1 -= Lv[1] * x17;
        a0 -= Lv[2] * x18;
        a1 -= Lv[3] * x19;
      }
      { const f32x4 Lv = *(const f32x4*)(L_s + 3624);
        a0 -= Lv[0] * x20;
        a1 -= Lv[1] * x21;
        a0 -= Lv[2] * x22;
        a1 -= Lv[3] * x23;
      }
      { const f32x4 Lv = *(const f32x4*)(L_s + 3628);
        a0 -= Lv[0] * x24;
        a1 -= Lv[1] * x25;
        a0 -= Lv[2] * x26;
        a1 -= Lv[3] * x27;
      }
      { const f32x4 Lv = *(const f32x4*)(L_s + 3632);
        a0 -= Lv[0] * x28;
        a1 -= Lv[1] * x29;
        a0 -= Lv[2] * x30;
        a1 -= Lv[3] * x31;
      }
      { const f32x4 Lv = *(const f32x4*)(L_s + 3636);
        a0 -= Lv[0] * x32;
        a1 -= Lv[1] * x33;
        a0 -= Lv[2] * x34;
        a1 -= Lv[3] * x35;
      }
      { const f32x4 Lv = *(const f32x4*)(L_s + 3640);
        a0 -= Lv[0] * x36;
        a1 -= Lv[1] * x37;
        a0 -= Lv[2] * x38;
        a1 -= Lv[3] * x39;
      }
      { const f32x4 Lv = *(const f32x4*)(L_s + 3644);
        a0 -= Lv[0] * x40;
        a1 -= Lv[1] * x41;
        a0 -= Lv[2] * x42;
        a1 -= Lv[3] * x43;
      }
      { const f32x4 Lv = *(const f32x4*)(L_s + 3648);
        a0 -= Lv[0] * x44;
        a1 -= Lv[1] * x45;
        a0 -= Lv[2] * x46;
        a1 -= Lv[3] * x47;
      }
      { const f32x4 Lv = *(const f32x4*)(L_s + 3652);
        a0 -= Lv[0] * x48;
        a1 -= Lv[1] * x49;
        a0 -= Lv[2] * x50;
        a1 -= Lv[3] * x51;
      }
      { const f32x4 Lv = *(const f32x4*)(L_s + 3656);
        a0 -= Lv[0] * x52;
      }
      x53 = a0 + a1; } __builtin_amdgcn_sched_barrier(0);
    { float a0 = bf2f(colp[7344]) * mulp[54]; float a1 = 0.f;
      { const f32x4 Lv = *(const f32x4*)(L_s + 3672);
        a0 -= Lv[0] * x0;
        a1 -= Lv[1] * x1;
        a0 -= Lv[2] * x2;
        a1 -= Lv[3] * x3;
      }
      { const f32x4 Lv = *(const f32x4*)(L_s + 3676);
        a0 -= Lv[0] * x4;
        a1 -= Lv[1] * x5;
        a0 -= Lv[2] * x6;
        a1 -= Lv[3] * x7;
      }
      { const f32x4 Lv = *(const f32x4*)(L_s + 3680);
        a0 -= Lv[0] * x8;
        a1 -= Lv[1] * x9;
        a0 -= Lv[2] * x10;
        a1 -= Lv[3] * x11;
      }
      { const f32x4 Lv = *(const f32x4*)(L_s + 3684);
        a0 -= Lv[0] * x12;
        a1 -= Lv[1] * x13;
        a0 -= Lv[2] * x14;
        a1 -= Lv[3] * x15;
      }
      { const f32x4 Lv = *(const f32x4*)(L_s + 3688);
        a0 -= Lv[0] * x16;
        a1 -= Lv[1] * x17;
        a0 -= Lv[2] * x18;
        a1 -= Lv[3] * x19;
      }
      { const f32x4 Lv = *(const f32x4*)(L_s + 3692);
        a0 -= Lv[0] * x20;
        a1 -= Lv[1] * x21;
        a0 -= Lv[2] * x22;
        a1 -= Lv[3] * x23;
      }
      { const f32x4 Lv = *(const f32x4*)(L_s + 3696);
        a0 -= Lv[0] * x24;
        a1 -= Lv[1] * x25;
        a0 -= Lv[2] * x26;
        a1 -= Lv[3] * x27;
      }
      { const f32x4 Lv = *(const f32x4*)(L_s + 3700);
        a0 -= Lv[0] * x28;
        a1 -= Lv[1] * x29;
        a0 -= Lv[2] * x30;
        a1 -= Lv[3] * x31;
      }
      { const f32x4 Lv = *(const f32x4*)(L_s + 3704);
        a0 -= Lv[0] * x32;
        a1 -= Lv[1] * x33;
        a0 -= Lv[2] * x34;
        a1 -= Lv[3] * x35;
      }
      { const f32x4 Lv = *(const f32x4*)(L_s + 3708);
        a0 -= Lv[0] * x36;
        a1 -= Lv[1] * x37;
        a0 -= Lv[2] * x38;
        a1 -= Lv[3] * x39;
      }
      { const f32x4 Lv = *(const f32x4*)(L_s + 3712);
        a0 -= Lv[0] * x40;
        a1 -= Lv[1] * x41;
        a0 -= Lv[2] * x42;
        a1 -= Lv[3] * x43;
      }
      { const f32x4 Lv = *(const f32x4*)(L_s + 3716);
        a0 -= Lv[0] * x44;
        a1 -= Lv[1] * x45;
        a0 -= Lv[2] * x46;
        a1 -= Lv[3] * x47;
      }
      { const f32x4 Lv = *(const f32x4*)(L_s + 3720);
        a0 -= Lv[0] * x48;
        a1 -= Lv[1] * x49;
        a0 -= Lv[2] * x50;
        a1 -= Lv[3] * x51;
      }
      { const f32x4 Lv = *(const f32x4*)(L_s + 3724);
        a0 -= Lv[0] * x52;
        a1 -= Lv[1] * x53;
      }
      x54 = a0 + a1; }
    { float a0 = bf2f(colp[7480]) * mulp[55]; float a1 = 0.f;
      { const f32x4 Lv = *(const f32x4*)(L_s + 3740);
        a0 -= Lv[0] * x0;
        a1 -= Lv[1] * x1;
        a0 -= Lv[2] * x2;
        a1 -= Lv[3] * x3;
      }
      { const f32x4 Lv = *(const f32x4*)(L_s + 3744);
        a0 -= Lv[0] * x4;
        a1 -= Lv[1] * x5;
        a0 -= Lv[2] * x6;
        a1 -= Lv[3] * x7;
      }
      { const f32x4 Lv = *(const f32x4*)(L_s + 3748);
        a0 -= Lv[0] * x8;
        a1 -= Lv[1] * x9;
        a0 -= Lv[2] * x10;
        a1 -= Lv[3] * x11;
      }
      { const f32x4 Lv = *(const f32x4*)(L_s + 3752);
        a0 -= Lv[0] * x12;
        a1 -= Lv[1] * x13;
        a0 -= Lv[2] * x14;
        a1 -= Lv[3] * x15;
      }
      { const f32x4 Lv = *(const f32x4*)(L_s + 3756);
        a0 -= Lv[0] * x16;
        a1 -= Lv[1] * x17;
        a0 -= Lv[2] * x18;
        a1 -= Lv[3] * x19;
      }
      { const f32x4 Lv = *(const f32x4*)(L_s + 3760);
        a0 -= Lv[0] * x20;
        a1 -= Lv[1] * x21;
        a0 -= Lv[2] * x22;
        a1 -= Lv[3] * x23;
      }
      { const f32x4 Lv = *(const f32x4*)(L_s + 3764);
        a0 -= Lv[0] * x24;
        a1 -= Lv[1] * x25;
        a0 -= Lv[2] * x26;
        a1 -= Lv[3] * x27;
      }
      { const f32x4 Lv = *(const f32x4*)(L_s + 3768);
        a0 -= Lv[0] * x28;
        a1 -= Lv[1] * x29;
        a0 -= Lv[2] * x30;
        a1 -= Lv[3] * x31;
      }
      { const f32x4 Lv = *(const f32x4*)(L_s + 3772);
        a0 -= Lv[0] * x32;
        a1 -= Lv[1] * x33;
        a0 -= Lv[2] * x34;
        a1 -= Lv[3] * x35;
      }
      { const f32x4 Lv = *(const f32x4*)(L_s + 3776);
        a0 -= Lv[0] * x36;
        a1 -= Lv[1] * x37;
        a0 -= Lv[2] * x38;
        a1 -= Lv[3] * x39;
      }
      { const f32x4 Lv = *(const f32x4*)(L_s + 3780);
        a0 -= Lv[0] * x40;
        a1 -= Lv[1] * x41;
        a0 -= Lv[2] * x42;
        a1 -= Lv[3] * x43;
      }
      { const f32x4 Lv = *(const f32x4*)(L_s + 3784);
        a0 -= Lv[0] * x44;
        a1 -= Lv[1] * x45;
        a0 -= Lv[2] * x46;
        a1 -= Lv[3] * x47;
      }
      { const f32x4 Lv = *(const f32x4*)(L_s + 3788);
        a0 -= Lv[0] * x48;
        a1 -= Lv[1] * x49;
        a0 -= Lv[2] * x50;
        a1 -= Lv[3] * x51;
      }
      { const f32x4 Lv = *(const f32x4*)(L_s + 3792);
        a0 -= Lv[0] * x52;
        a1 -= Lv[1] * x53;
        a0 -= Lv[2] * x54;
      }
      x55 = a0 + a1; } __builtin_amdgcn_sched_barrier(0);
    { float a0 = bf2f(colp[7616]) * mulp[56]; float a1 = 0.f;
      { const f32x4 Lv = *(const f32x4*)(L_s + 3808);
        a0 -= Lv[0] * x0;
        a1 -= Lv[1] * x1;
        a0 -= Lv[2] * x2;
        a1 -= Lv[3] * x3;
      }
      { const f32x4 Lv = *(const f32x4*)(L_s + 3812);
        a0 -= Lv[0] * x4;
        a1 -= Lv[1] * x5;
        a0 -= Lv[2] * x6;
        a1 -= Lv[3] * x7;
      }
      { const f32x4 Lv = *(const f32x4*)(L_s + 3816);
        a0 -= Lv[0] * x8;
        a1 -= Lv[1] * x9;
        a0 -= Lv[2] * x10;
        a1 -= Lv[3] * x11;
      }
      { const f32x4 Lv = *(const f32x4*)(L_s + 3820);
        a0 -= Lv[0] * x12;
        a1 -= Lv[1] * x13;
        a0 -= Lv[2] * x14;
        a1 -= Lv[3] * x15;
      }
      { const f32x4 Lv = *(const f32x4*)(L_s + 3824);
        a0 -= Lv[0] * x16;
        a1 -= Lv[1] * x17;
        a0 -= Lv[2] * x18;
        a1 -= Lv[3] * x19;
      }
      { const f32x4 Lv = *(const f32x4*)(L_s + 3828);
        a0 -= Lv[0] * x20;
        a1 -= Lv[1] * x21;
        a0 -= Lv[2] * x22;
        a1 -= Lv[3] * x23;
      }
      { const f32x4 Lv = *(const f32x4*)(L_s + 3832);
        a0 -= Lv[0] * x24;
        a1 -= Lv[1] * x25;
        a0 -= Lv[2] * x26;
        a1 -= Lv[3] * x27;
      }
      { const f32x4 Lv = *(const f32x4*)(L_s + 3836);
        a0 -= Lv[0] * x28;
        a1 -= Lv[1] * x29;
        a0 -= Lv[2] * x30;
        a1 -= Lv[3] * x31;
      }
      { const f32x4 Lv = *(const f32x4*)(L_s + 3840);
        a0 -= Lv[0] * x32;
        a1 -= Lv[1] * x33;
        a0 -= Lv[2] * x34;
        a1 -= Lv[3] * x35;
      }
      { const f32x4 Lv = *(const f32x4*)(L_s + 3844);
        a0 -= Lv[0] * x36;
        a1 -= Lv[1] * x37;
        a0 -= Lv[2] * x38;
        a1 -= Lv[3] * x39;
      }
      { const f32x4 Lv = *(const f32x4*)(L_s + 3848);
        a0 -= Lv[0] * x40;
        a1 -= Lv[1] * x41;
        a0 -= Lv[2] * x42;
        a1 -= Lv[3] * x43;
      }
      { const f32x4 Lv = *(const f32x4*)(L_s + 3852);
        a0 -= Lv[0] * x44;
        a1 -= Lv[1] * x45;
        a0 -= Lv[2] * x46;
        a1 -= Lv[3] * x47;
      }
      { const f32x4 Lv = *(const f32x4*)(L_s + 3856);
        a0 -= Lv[0] * x48;
        a1 -= Lv[1] * x49;
        a0 -= Lv[2] * x50;
        a1 -= Lv[3] * x51;
      }
      { const f32x4 Lv = *(const f32x4*)(L_s + 3860);
        a0 -= Lv[0] * x52;
        a1 -= Lv[1] * x53;
        a0 -= Lv[2] * x54;
        a1 -= Lv[3] * x55;
      }
      x56 = a0 + a1; }
    { float a0 = bf2f(colp[7752]) * mulp[57]; float a1 = 0.f;
      { const f32x4 Lv = *(const f32x4*)(L_s + 3876);
        a0 -= Lv[0] * x0;
        a1 -= Lv[1] * x1;
        a0 -= Lv[2] * x2;
        a1 -= Lv[3] * x3;
      }
      { const f32x4 Lv = *(const f32x4*)(L_s + 3880);
        a0 -= Lv[0] * x4;
        a1 -= Lv[1] * x5;
        a0 -= Lv[2] * x6;
        a1 -= Lv[3] * x7;
      }
      { const f32x4 Lv = *(const f32x4*)(L_s + 3884);
        a0 -= Lv[0] * x8;
        a1 -= Lv[1] * x9;
        a0 -= Lv[2] * x10;
        a1 -= Lv[3] * x11;
      }
      { const f32x4 Lv = *(const f32x4*)(L_s + 3888);
        a0 -= Lv[0] * x12;
        a1 -= Lv[1] * x13;
        a0 -= Lv[2] * x14;
        a1 -= Lv[3] * x15;
      }
      { const f32x4 Lv = *(const f32x4*)(L_s + 3892);
        a0 -= Lv[0] * x16;
        a1 -= Lv[1] * x17;
        a0 -= Lv[2] * x18;
        a1 -= Lv[3] * x19;
      }
      { const f32x4 Lv = *(const f32x4*)(L_s + 3896);
        a0 -= Lv[0] * x20;
        a1 -= Lv[1] * x21;
        a0 -= Lv[2] * x22;
        a1 -= Lv[3] * x23;
      }
      { const f32x4 Lv = *(const f32x4*)(L_s + 3900);
        a0 -= Lv[0] * x24;
        a1 -= Lv[1] * x25;
        a0 -= Lv[2] * x26;
        a1 -= Lv[3] * x27;
      }
      { const f32x4 Lv = *(const f32x4*)(L_s + 3904);
        a0 -= Lv[0] * x28;
        a1 -= Lv[1] * x29;
        a0 -= Lv[2] * x30;
        a1 -= Lv[3] * x31;
      }
      { const f32x4 Lv = *(const f32x4*)(L_s + 3908);
        a0 -= Lv[0] * x32;
        a1 -= Lv[1] * x33;
        a0 -= Lv[2] * x34;
        a1 -= Lv[3] * x35;
      }
      { const f32x4 Lv = *(const f32x4*)(L_s + 3912);
        a0 -= Lv[0] * x36;
        a1 -= Lv[1] * x37;
        a0 -= Lv[2] * x38;
        a1 -= Lv[3] * x39;
      }
      { const f32x4 Lv = *(const f32x4*)(L_s + 3916);
        a0 -= Lv[0] * x40;
        a1 -= Lv[1] * x41;
        a0 -= Lv[2] * x42;
        a1 -= Lv[3] * x43;
      }
      { const f32x4 Lv = *(const f32x4*)(L_s + 3920);
        a0 -= Lv[0] * x44;
        a1 -= Lv[1] * x45;
        a0 -= Lv[2] * x46;
        a1 -= Lv[3] * x47;
      }
      { const f32x4 Lv = *(const f32x4*)(L_s + 3924);
        a0 -= Lv[0] * x48;
        a1 -= Lv[1] * x49;
        a0 -= Lv[2] * x50;
        a1 -= Lv[3] * x51;
      }
      { const f32x4 Lv = *(const f32x4*)(L_s + 3928);
        a0 -= Lv[0] * x52;
        a1 -= Lv[1] * x53;
        a0 -= Lv[2] * x54;
        a1 -= Lv[3] * x55;
      }
      { const f32x4 Lv = *(const f32x4*)(L_s + 3932);
        a0 -= Lv[0] * x56;
      }
      x57 = a0 + a1; } __builtin_amdgcn_sched_barrier(0);
    { float a0 = bf2f(colp[7888]) * mulp[58]; float a1 = 0.f;
      { const f32x4 Lv = *(const f32x4*)(L_s + 3944);
        a0 -= Lv[0] * x0;
        a1 -= Lv[1] * x1;
        a0 -= Lv[2] * x2;
        a1 -= Lv[3] * x3;
      }
      { const f32x4 Lv = *(const f32x4*)(L_s + 3948);
        a0 -= Lv[0] * x4;
        a1 -= Lv[1] * x5;
        a0 -= Lv[2] * x6;
        a1 -= Lv[3] * x7;
      }
      { const f32x4 Lv = *(const f32x4*)(L_s + 3952);
        a0 -= Lv[0] * x8;
        a1 -= Lv[1] * x9;
        a0 -= Lv[2] * x10;
        a1 -= Lv[3] * x11;
      }
      { const f32x4 Lv = *(const f32x4*)(L_s + 3956);
        a0 -= Lv[0] * x12;
        a1 -= Lv[1] * x13;
        a0 -= Lv[2] * x14;
        a1 -= Lv[3] * x15;
      }
      { const f32x4 Lv = *(const f32x4*)(L_s + 3960);
        a0 -= Lv[0] * x16;
        a1 -= Lv[1] * x17;
        a0 -= Lv[2] * x18;
        a1 -= Lv[3] * x19;
      }
      { const f32x4 Lv = *(const f32x4*)(L_s + 3964);
        a0 -= Lv[0] * x20;
        a1 -= Lv[1] * x21;
        a0 -= Lv[2] * x22;
        a1 -= Lv[3] * x23;
      }
      { const f32x4 Lv = *(const f32x4*)(L_s + 3968);
        a0 -= Lv[0] * x24;
        a1 -= Lv[1] * x25;
        a0 -= Lv[2] * x26;
        a1 -= Lv[3] * x27;
      }
      { const f32x4 Lv = *(const f32x4*)(L_s + 3972);
        a0 -= Lv[0] * x28;
        a1 -= Lv[1] * x29;
        a0 -= Lv[2] * x30;
        a1 -= Lv[3] * x31;
      }
      { const f32x4 Lv = *(const f32x4*)(L_s + 3976);
        a0 -= Lv[0] * x32;
        a1 -= Lv[1] * x33;
        a0 -= Lv[2] * x34;
        a1 -= Lv[3] * x35;
      }
      { const f32x4 Lv = *(const f32x4*)(L_s + 3980);
        a0 -= Lv[0] * x36;
        a1 -= Lv[1] * x37;
        a0 -= Lv[2] * x38;
        a1 -= Lv[3] * x39;
      }
      { const f32x4 Lv = *(const f32x4*)(L_s + 3984);
        a0 -= Lv[0] * x40;
        a1 -= Lv[1] * x41;
        a0 -= Lv[2] * x42;
        a1 -= Lv[3] * x43;
      }
      { const f32x4 Lv = *(const f32x4*)(L_s + 3988);
        a0 -= Lv[0] * x44;
        a1 -= Lv[1] * x45;
        a0 -= Lv[2] * x46;
        a1 -= Lv[3] * x47;
      }
      { const f32x4 Lv = *(const f32x4*)(L_s + 3992);
        a0 -= Lv[0] * x48;
        a1 -= Lv[1] * x49;
        a0 -= Lv[2] * x50;
        a1 -= Lv[3] * x51;
      }
      { const f32x4 Lv = *(const f32x4*)(L_s + 3996);
        a0 -= Lv[0] * x52;
        a1 -= Lv[1] * x53;
        a0 -= Lv[2] * x54;
        a1 -= Lv[3] * x55;
      }
      { const f32x4 Lv = *(const f32x4*)(L_s + 4000);
        a0 -= Lv[0] * x56;
        a1 -= Lv[1] * x57;
      }
      x58 = a0 + a1; }
    { float a0 = bf2f(colp[8024]) * mulp[59]; float a1 = 0.f;
      { const f32x4 Lv = *(const f32x4*)(L_s + 4012);
        a0 -= Lv[0] * x0;
        a1 -= Lv[1] * x1;
        a0 -= Lv[2] * x2;
        a1 -= Lv[3] * x3;
      }
      { const f32x4 Lv = *(const f32x4*)(L_s + 4016);
        a0 -= Lv[0] * x4;
        a1 -= Lv[1] * x5;
        a0 -= Lv[2] * x6;
        a1 -= Lv[3] * x7;
      }
      { const f32x4 Lv = *(const f32x4*)(L_s + 4020);
        a0 -= Lv[0] * x8;
        a1 -= Lv[1] * x9;
        a0 -= Lv[2] * x10;
        a1 -= Lv[3] * x11;
      }
      { const f32x4 Lv = *(const f32x4*)(L_s + 4024);
        a0 -= Lv[0] * x12;
        a1 -= Lv[1] * x13;
        a0 -= Lv[2] * x14;
        a1 -= Lv[3] * x15;
      }
      { const f32x4 Lv = *(const f32x4*)(L_s + 4028);
        a0 -= Lv[0] * x16;
        a1 -= Lv[1] * x17;
        a0 -= Lv[2] * x18;
        a1 -= Lv[3] * x19;
      }
      { const f32x4 Lv = *(const f32x4*)(L_s + 4032);
        a0 -= Lv[0] * x20;
        a1 -= Lv[1] * x21;
        a0 -= Lv[2] * x22;
        a1 -= Lv[3] * x23;
      }
      { const f32x4 Lv = *(const f32x4*)(L_s + 4036);
        a0 -= Lv[0] * x24;
        a1 -= Lv[1] * x25;
        a0 -= Lv[2] * x26;
        a1 -= Lv[3] * x27;
      }
      { const f32x4 Lv = *(const f32x4*)(L_s + 4040);
        a0 -= Lv[0] * x28;
        a1 -= Lv[1] * x29;
        a0 -= Lv[2] * x30;
        a1 -= Lv[3] * x31;
      }
      { const f32x4 Lv = *(const f32x4*)(L_s + 4044);
        a0 -= Lv[0] * x32;
        a1 -= Lv[1] * x33;
        a0 -= Lv[2] * x34;
        a1 -= Lv[3] * x35;
      }
      { const f32x4 Lv = *(const f32x4*)(L_s + 4048);
        a0 -= Lv[0] * x36;
        a1 -= Lv[1] * x37;
        a0 -= Lv[2] * x38;
        a1 -= Lv[3] * x39;
      }
      { const f32x4 Lv = *(const f32x4*)(L_s + 4052);
        a0 -= Lv[0] * x40;
        a1 -= Lv[1] * x41;
        a0 -= Lv[2] * x42;
        a1 -= Lv[3] * x43;
      }
      { const f32x4 Lv = *(const f32x4*)(L_s + 4056);
        a0 -= Lv[0] * x44;
        a1 -= Lv[1] * x45;
        a0 -= Lv[2] * x46;
        a1 -= Lv[3] * x47;
      }
      { const f32x4 Lv = *(const f32x4*)(L_s + 4060);
        a0 -= Lv[0] * x48;
        a1 -= Lv[1] * x49;
        a0 -= Lv[2] * x50;
        a1 -= Lv[3] * x51;
      }
      { const f32x4 Lv = *(const f32x4*)(L_s + 4064);
        a0 -= Lv[0] * x52;
        a1 -= Lv[1] * x53;
        a0 -= Lv[2] * x54;
        a1 -= Lv[3] * x55;
      }
      { const f32x4 Lv = *(const f32x4*)(L_s + 4068);
        a0 -= Lv[0] * x56;
        a1 -= Lv[1] * x57;
        a0 -= Lv[2] * x58;
      }
      x59 = a0 + a1; } __builtin_amdgcn_sched_barrier(0);
    { float a0 = bf2f(colp[8160]) * mulp[60]; float a1 = 0.f;
      { const f32x4 Lv = *(const f32x4*)(L_s + 4080);
        a0 -= Lv[0] * x0;
        a1 -= Lv[1] * x1;
        a0 -= Lv[2] * x2;
        a1 -= Lv[3] * x3;
      }
      { const f32x4 Lv = *(const f32x4*)(L_s + 4084);
        a0 -= Lv[0] * x4;
        a1 -= Lv[1] * x5;
        a0 -= Lv[2] * x6;
        a1 -= Lv[3] * x7;
      }
      { const f32x4 Lv = *(const f32x4*)(L_s + 4088);
        a0 -= Lv[0] * x8;
        a1 -= Lv[1] * x9;
        a0 -= Lv[2] * x10;
        a1 -= Lv[3] * x11;
      }
      { const f32x4 Lv = *(const f32x4*)(L_s + 4092);
        a0 -= Lv[0] * x12;
        a1 -= Lv[1] * x13;
        a0 -= Lv[2] * x14;
        a1 -= Lv[3] * x15;
      }
      { const f32x4 Lv = *(const f32x4*)(L_s + 4096);
        a0 -= Lv[0] * x16;
        a1 -= Lv[1] * x17;
        a0 -= Lv[2] * x18;
        a1 -= Lv[3] * x19;
      }
      { const f32x4 Lv = *(const f32x4*)(L_s + 4100);
        a0 -= Lv[0] * x20;
        a1 -= Lv[1] * x21;
        a0 -= Lv[2] * x22;
        a1 -= Lv[3] * x23;
      }
      { const f32x4 Lv = *(const f32x4*)(L_s + 4104);
        a0 -= Lv[0] * x24;
        a1 -= Lv[1] * x25;
        a0 -= Lv[2] * x26;
        a1 -= Lv[3] * x27;
      }
      { const f32x4 Lv = *(const f32x4*)(L_s + 4108);
        a0 -= Lv[0] * x28;
        a1 -= Lv[1] * x29;
        a0 -= Lv[2] * x30;
        a1 -= Lv[3] * x31;
      }
      { const f32x4 Lv = *(const f32x4*)(L_s + 4112);
        a0 -= Lv[0] * x32;
        a1 -= Lv[1] * x33;
        a0 -= Lv[2] * x34;
        a1 -= Lv[3] * x35;
      }
      { const f32x4 Lv = *(const f32x4*)(L_s + 4116);
        a0 -= Lv[0] * x36;
        a1 -= Lv[1] * x37;
        a0 -= Lv[2] * x38;
        a1 -= Lv[3] * x39;
      }
      { const f32x4 Lv = *(const f32x4*)(L_s + 4120);
        a0 -= Lv[0] * x40;
        a1 -= Lv[1] * x41;
        a0 -= Lv[2] * x42;
        a1 -= Lv[3] * x43;
      }
      { const f32x4 Lv = *(const f32x4*)(L_s + 4124);
        a0 -= Lv[0] * x44;
        a1 -= Lv[1] * x45;
        a0 -= Lv[2] * x46;
        a1 -= Lv[3] * x47;
      }
      { const f32x4 Lv = *(const f32x4*)(L_s + 4128);
        a0 -= Lv[0] * x48;
        a1 -= Lv[1] * x49;
        a0 -= Lv[2] * x50;
        a1 -= Lv[3] * x51;
      }
      { const f32x4 Lv = *(const f32x4*)(L_s + 4132);
        a0 -= Lv[0] * x52;
        a1 -= Lv[1] * x53;
        a0 -= Lv[2] * x54;
        a1 -= Lv[3] * x55;
      }
      { const f32x4 Lv = *(const f32x4*)(L_s + 4136);
        a0 -= Lv[0] * x56;
        a1 -= Lv[1] * x57;
        a0 -= Lv[2] * x58;
        a1 -= Lv[3] * x59;
      }
      x60 = a0 + a1; }
    { float a0 = bf2f(colp[8296]) * mulp[61]; float a1 = 0.f;
      { const f32x4 Lv = *(const f32x4*)(L_s + 4148);
        a0 -= Lv[0] * x0;
        a1 -= Lv[1] * x1;
        a0 -= Lv[2] * x2;
        a1 -= Lv[3] * x3;
      }
      { const f32x4 Lv = *(const f32x4*)(L_s + 4152);
        a0 -= Lv[0] * x4;
        a1 -= Lv[1] * x5;
        a0 -= Lv[2] * x6;
        a1 -= Lv[3] * x7;
      }
      { const f32x4 Lv = *(const f32x4*)(L_s + 4156);
        a0 -= Lv[0] * x8;
        a1 -= Lv[1] * x9;
        a0 -= Lv[2] * x10;
        a1 -= Lv[3] * x11;
      }
      { const f32x4 Lv = *(const f32x4*)(L_s + 4160);
        a0 -= Lv[0] * x12;
        a1 -= Lv[1] * x13;
        a0 -= Lv[2] * x14;
        a1 -= Lv[3] * x15;
      }
      { const f32x4 Lv = *(const f32x4*)(L_s + 4164);
        a0 -= Lv[0] * x16;
        a1 -= Lv[1] * x17;
        a0 -= Lv[2] * x18;
        a1 -= Lv[3] * x19;
      }
      { const f32x4 Lv = *(const f32x4*)(L_s + 4168);
        a0 -= Lv[0] * x20;
        a1 -= Lv[1] * x21;
        a0 -= Lv[2] * x22;
        a1 -= Lv[3] * x23;
      }
      { const f32x4 Lv = *(const f32x4*)(L_s + 4172);
        a0 -= Lv[0] * x24;
        a1 -= Lv[1] * x25;
        a0 -= Lv[2] * x26;
        a1 -= Lv[3] * x27;
      }
      { const f32x4 Lv = *(const f32x4*)(L_s + 4176);
        a0 -= Lv[0] * x28;
        a1 -= Lv[1] * x29;
        a0 -= Lv[2] * x30;
        a1 -= Lv[3] * x31;
      }
      { const f32x4 Lv = *(const f32x4*)(L_s + 4180);
        a0 -= Lv[0] * x32;
        a1 -= Lv[1] * x33;
        a0 -= Lv[2] * x34;
        a1 -= Lv[3] * x35;
      }
      { const f32x4 Lv = *(const f32x4*)(L_s + 4184);
        a0 -= Lv[0] * x36;
        a1 -= Lv[1] * x37;
        a0 -= Lv[2] * x38;
        a1 -= Lv[3] * x39;
      }
      { const f32x4 Lv = *(const f32x4*)(L_s + 4188);
        a0 -= Lv[0] * x40;
        a1 -= Lv[1] * x41;
        a0 -= Lv[2] * x42;
        a1 -= Lv[3] * x43;
      }
      { const f32x4 Lv = *(const f32x4*)(L_s + 4192);
        a0 -= Lv[0] * x44;
        a1 -= Lv[1] * x45;
        a0 -= Lv[2] * x46;
        a1 -= Lv[3] * x47;
      }
      { const f32x4 Lv = *(const f32x4*)(L_s + 4196);
        a0 -= Lv[0] * x48;
        a1 -= Lv[1] * x49;
        a0 -= Lv[2] * x50;
        a1 -= Lv[3] * x51;
      }
      { const f32x4 Lv = *(const f32x4*)(L_s + 4200);
        a0 -= Lv[0] * x52;
        a1 -= Lv[1] * x53;
        a0 -= Lv[2] * x54;
        a1 -= Lv[3] * x55;
      }
      { const f32x4 Lv = *(const f32x4*)(L_s + 4204);
        a0 -= Lv[0] * x56;
        a1 -= Lv[1] * x57;
        a0 -= Lv[2] * x58;
        a1 -= Lv[3] * x59;
      }
      { const f32x4 Lv = *(const f32x4*)(L_s + 4208);
        a0 -= Lv[0] * x60;
      }
      x61 = a0 + a1; } __builtin_amdgcn_sched_barrier(0);
    { float a0 = bf2f(colp[8432]) * mulp[62]; float a1 = 0.f;
      { const f32x4 Lv = *(const f32x4*)(L_s + 4216);
        a0 -= Lv[0] * x0;
        a1 -= Lv[1] * x1;
        a0 -= Lv[2] * x2;
        a1 -= Lv[3] * x3;
      }
      { const f32x4 Lv = *(const f32x4*)(L_s + 4220);
        a0 -= Lv[0] * x4;
        a1 -= Lv[1] * x5;
        a0 -= Lv[2] * x6;
        a1 -= Lv[3] * x7;
      }
      { const f32x4 Lv = *(const f32x4*)(L_s + 4224);
        a0 -= Lv[0] * x8;
        a1 -= Lv[1] * x9;
        a0 -= Lv[2] * x10;
        a1 -= Lv[3] * x11;
      }
      { const f32x4 Lv = *(const f32x4*)(L_s + 4228);
        a0 -= Lv[0] * x12;
        a1 -= Lv[1] * x13;
        a0 -= Lv[2] * x14;
        a1 -= Lv[3] * x15;
      }
      { const f32x4 Lv = *(const f32x4*)(L_s + 4232);
        a0 -= Lv[0] * x16;
        a1 -= Lv[1] * x17;
        a0 -= Lv[2] * x18;
        a1 -= Lv[3] * x19;
      }
      { const f32x4 Lv = *(const f32x4*)(L_s + 4236);
        a0 -= Lv[0] * x20;
        a1 -= Lv[1] * x21;
        a0 -= Lv[2] * x22;
        a1 -= Lv[3] * x23;
      }
      { const f32x4 Lv = *(const f32x4*)(L_s + 4240);
        a0 -= Lv[0] * x24;
        a1 -= Lv[1] * x25;
        a0 -= Lv[2] * x26;
        a1 -= Lv[3] * x27;
      }
      { const f32x4 Lv = *(const f32x4*)(L_s + 4244);
        a0 -= Lv[0] * x28;
        a1 -= Lv[1] * x29;
        a0 -= Lv[2] * x30;
        a1 -= Lv[3] * x31;
      }
      { const f32x4 Lv = *(const f32x4*)(L_s + 4248);
        a0 -= Lv[0] * x32;
        a1 -= Lv[1] * x33;
        a0 -= Lv[2] * x34;
        a1 -= Lv[3] * x35;
      }
      { const f32x4 Lv = *(const f32x4*)(L_s + 4252);
        a0 -= Lv[0] * x36;
        a1 -= Lv[1] * x37;
        a0 -= Lv[2] * x38;
        a1 -= Lv[3] * x39;
      }
      { const f32x4 Lv = *(const f32x4*)(L_s + 4256);
        a0 -= Lv[0] * x40;
        a1 -= Lv[1] * x41;
        a0 -= Lv[2] * x42;
        a1 -= Lv[3] * x43;
      }
      { const f32x4 Lv = *(const f32x4*)(L_s + 4260);
        a0 -= Lv[0] * x44;
        a1 -= Lv[1] * x45;
        a0 -= Lv[2] * x46;
        a1 -= Lv[3] * x47;
      }
      { const f32x4 Lv = *(const f32x4*)(L_s + 4264);
        a0 -= Lv[0] * x48;
        a1 -= Lv[1] * x49;
        a0 -= Lv[2] * x50;
        a1 -= Lv[3] * x51;
      }
      { const f32x4 Lv = *(const f32x4*)(L_s + 4268);
        a0 -= Lv[0] * x52;
        a1 -= Lv[1] * x53;
        a0 -= Lv[2] * x54;
        a1 -= Lv[3] * x55;
      }
      { const f32x4 Lv = *(const f32x4*)(L_s + 4272);
        a0 -= Lv[0] * x56;
        a1 -= Lv[1] * x57;
        a0 -= Lv[2] * x58;
        a1 -= Lv[3] * x59;
      }
      { const f32x4 Lv = *(const f32x4*)(L_s + 4276);
        a0 -= Lv[0] * x60;
        a1 -= Lv[1] * x61;
      }
      x62 = a0 + a1; }
    { float a0 = bf2f(colp[8568]) * mulp[63]; float a1 = 0.f;
      { const f32x4 Lv = *(const f32x4*)(L_s + 4284);
        a0 -= Lv[0] * x0;
        a1 -= Lv[1] * x1;
        a0 -= Lv[2] * x2;
        a1 -= Lv[3] * x3;
      }
      { const f32x4 Lv = *(const f32x4*)(L_s + 4288);
        a0 -= Lv[0] * x4;
        a1 -= Lv[1] * x5;
        a0 -= Lv[2] * x6;
        a1 -= Lv[3] * x7;
      }
      { const f32x4 Lv = *(const f32x4*)(L_s + 4292);
        a0 -= Lv[0] * x8;
        a1 -= Lv[1] * x9;
        a0 -= Lv[2] * x10;
        a1 -= Lv[3] * x11;
      }
      { const f32x4 Lv = *(const f32x4*)(L_s + 4296);
        a0 -= Lv[0] * x12;
        a1 -= Lv[1] * x13;
        a0 -= Lv[2] * x14;
        a1 -= Lv[3] * x15;
      }
      { const f32x4 Lv = *(const f32x4*)(L_s + 4300);
        a0 -= Lv[0] * x16;
        a1 -= Lv[1] * x17;
        a0 -= Lv[2] * x18;
        a1 -= Lv[3] * x19;
      }
      { const f32x4 Lv = *(const f32x4*)(L_s + 4304);
        a0 -= Lv[0] * x20;
        a1 -= Lv[1] * x21;
        a0 -= Lv[2] * x22;
        a1 -= Lv[3] * x23;
      }
      { const f32x4 Lv = *(const f32x4*)(L_s + 4308);
        a0 -= Lv[0] * x24;
        a1 -= Lv[1] * x25;
        a0 -= Lv[2] * x26;
        a1 -= Lv[3] * x27;
      }
      { const f32x4 Lv = *(const f32x4*)(L_s + 4312);
        a0 -= Lv[0] * x28;
        a1 -= Lv[1] * x29;
        a0 -= Lv[2] * x30;
        a1 -= Lv[3] * x31;
      }
      { const f32x4 Lv = *(const f32x4*)(L_s + 4316);
        a0 -= Lv[0] * x32;
        a1 -= Lv[1] * x33;
        a0 -= Lv[2] * x34;
        a1 -= Lv[3] * x35;
      }
      { const f32x4 Lv = *(const f32x4*)(L_s + 4320);
        a0 -= Lv[0] * x36;
        a1 -= Lv[1] * x37;
        a0 -= Lv[2] * x38;
        a1 -= Lv[3] * x39;
      }
      { const f32x4 Lv = *(const f32x4*)(L_s + 4324);
        a0 -= Lv[0] * x40;
        a1 -= Lv[1] * x41;
        a0 -= Lv[2] * x42;
        a1 -= Lv[3] * x43;
      }
      { const f32x4 Lv = *(const f32x4*)(L_s + 4328);
        a0 -= Lv[0] * x44;
        a1 -= Lv[1] * x45;
        a0 -= Lv[2] * x46;
        a1 -= Lv[3] * x47;
      }
      { const f32x4 Lv = *(const f32x4*)(L_s + 4332);
        a0 -= Lv[0] * x48;
        a1 -= Lv[1] * x49;
        a0 -= Lv[2] * x50;
        a1 -= Lv[3] * x51;
      }
      { const f32x4 Lv = *(const f32x4*)(L_s + 4336);
        a0 -= Lv[0] * x52;
        a1 -= Lv[1] * x53;
        a0 -= Lv[2] * x54;
        a1 -= Lv[3] * x55;
      }
      { const f32x4 Lv = *(const f32x4*)(L_s + 4340);
        a0 -= Lv[0] * x56;
        a1 -= Lv[1] * x57;
        a0 -= Lv[2] * x58;
        a1 -= Lv[3] * x59;
      }
      { const f32x4 Lv = *(const f32x4*)(L_s + 4344);
        a0 -= Lv[0] * x60;
        a1 -= Lv[1] * x61;
        a0 -= Lv[2] * x62;
      }
      x63 = a0 + a1; } __builtin_amdgcn_sched_barrier(0);
    __syncthreads();
    outp[0] = f2bf(sg * x0);
    outp[136] = f2bf(sg * x1);
    outp[272] = f2bf(sg * x2);
    outp[408] = f2bf(sg * x3);
    outp[544] = f2bf(sg * x4);
    outp[680] = f2bf(sg * x5);
    outp[816] = f2bf(sg * x6);
    outp[952] = f2bf(sg * x7);
    outp[1088] = f2bf(sg * x8);
    outp[1224] = f2bf(sg * x9);
    outp[1360] = f2bf(sg * x10);
    outp[1496] = f2bf(sg * x11);
    outp[1632] = f2bf(sg * x12);
    outp[1768] = f2bf(sg * x13);
    outp[1904] = f2bf(sg * x14);
    outp[2040] = f2bf(sg * x15);
    outp[2176] = f2bf(sg * x16);
    outp[2312] = f2bf(sg * x17);
    outp[2448] = f2bf(sg * x18);
    outp[2584] = f2bf(sg * x19);
    outp[2720] = f2bf(sg * x20);
    outp[2856] = f2bf(sg * x21);
    outp[2992] = f2bf(sg * x22);
    outp[3128] = f2bf(sg * x23);
    outp[3264] = f2bf(sg * x24);
    outp[3400] = f2bf(sg * x25);
    outp[3536] = f2bf(sg * x26);
    outp[3672] = f2bf(sg * x27);
    outp[3808] = f2bf(sg * x28);
    outp[3944] = f2bf(sg * x29);
    outp[4080] = f2bf(sg * x30);
    outp[4216] = f2bf(sg * x31);
    outp[4352] = f2bf(sg * x32);
    outp[4488] = f2bf(sg * x33);
    outp[4624] = f2bf(sg * x34);
    outp[4760] = f2bf(sg * x35);
    outp[4896] = f2bf(sg * x36);
    outp[5032] = f2bf(sg * x37);
    outp[5168] = f2bf(sg * x38);
    outp[5304] = f2bf(sg * x39);
    outp[5440] = f2bf(sg * x40);
    outp[5576] = f2bf(sg * x41);
    outp[5712] = f2bf(sg * x42);
    outp[5848] = f2bf(sg * x43);
    outp[5984] = f2bf(sg * x44);
    outp[6120] = f2bf(sg * x45);
    outp[6256] = f2bf(sg * x46);
    outp[6392] = f2bf(sg * x47);
    outp[6528] = f2bf(sg * x48);
    outp[6664] = f2bf(sg * x49);
    outp[6800] = f2bf(sg * x50);
    outp[6936] = f2bf(sg * x51);
    outp[7072] = f2bf(sg * x52);
    outp[7208] = f2bf(sg * x53);
    outp[7344] = f2bf(sg * x54);
    outp[7480] = f2bf(sg * x55);
    outp[7616] = f2bf(sg * x56);
    outp[7752] = f2bf(sg * x57);
    outp[7888] = f2bf(sg * x58);
    outp[8024] = f2bf(sg * x59);
    outp[8160] = f2bf(sg * x60);
    outp[8296] = f2bf(sg * x61);
    outp[8432] = f2bf(sg * x62);
    outp[8568] = f2bf(sg * x63);
}

DEV void dn_item(const Params& p, int l, int item, unsigned char* smem) {
    const int dir = item & 1, hh = (item >> 1) & 3, b = item >> 3;
    bf16_t* q_s = (bf16_t*)(smem);
    bf16_t* k_s = (bf16_t*)(smem + 17408);
    bf16_t* vnT_s = k_s;
    bf16_t* kT_s = (bf16_t*)(smem + 35840);
    bf16_t* v_s = (bf16_t*)(smem + 54272);
    bf16_t* u_s = v_s;
    float* L_s = (float*)(smem + 71680);
    bf16_t* w_s = (bf16_t*)(smem + 71680);
    bf16_t* qk_s = (bf16_t*)(smem + 89088);
    bf16_t* St_s = (bf16_t*)(smem + 98304);
    float* G_s = (float*)(smem + 133120);
    float* beta_s = G_s + 64;
    float* eG_s = G_s + 128;
    float* bw_s = G_s + 192;
    float* cw_s = G_s + 256;
    const int tid = get_tid(), lane = tid & 63, wv = tid >> 6, l15 = lane & 15, quad = lane >> 4;
    const float Aneg = -expf(p.in[I_DNALOG][(l * 2 + dir) * 4 + hh]);
    const float dtb = p.in[I_DNDT][(l * 2 + dir) * 4 + hh];
    const bf16_t* P = wsb(p, O_P);
    const float* AB = wsf(p, O_AB);
    bf16_t* TO = wsb(p, dir ? O_TA2 : O_TA);
    __syncthreads();
    for (int e = tid; e < 4 * 384; e += 256) { int j = e / 384, c = e % 384, mat = c >> 7, cc = c & 127; cw_s[e] = p.in[I_DNCONV][((size_t)l * 4 + j) * 1536 + mat * 512 + hh * 128 + cc]; }
    for (int e = tid; e < 128 * 136 / 2; e += 256) ((unsigned*)St_s)[e] = 0u;
    f32x4 Sacc[2][8];
#pragma unroll
    for (int a = 0; a < 2; ++a)
#pragma unroll
        for (int c = 0; c < 8; ++c) Sacc[a][c] = (f32x4){0.f, 0.f, 0.f, 0.f};

#pragma unroll 1
    for (int n = 0; n < 68; ++n) {
        const int c = chunk_of(dir, n);
        const int seg_lo = c < 4 ? 0 : CTXL, seg_hi = c < 4 ? CTXL : SB;
        const int base = c * 64;
        __syncthreads();
        if (wv == 0) {
            const int s = dir ? base + 63 - lane : base + lane;
            const size_t row = (size_t)b * SB + s;
            const float al = AB[row * 16 + dir * 4 + hh], bb = AB[row * 16 + 8 + dir * 4 + hh];
            float g = Aneg * softplus_fast(al + dtb);
#pragma unroll
            for (int o = 1; o < 64; o <<= 1) { float t = __shfl_up(g, o); if (lane >= o) g += t; }
            const float eg_ = expf(g), bt_ = sigm(bb); G_s[lane] = g; beta_s[lane] = bt_; eG_s[lane] = eg_; bw_s[lane] = bt_ * eg_;
        }
        __syncthreads();
        const float Glast = G_s[63];
        {
            const int i = tid >> 2, seg = tid & 3;
            const int s = dir ? base + 63 - i : base + i;
            const float kscale = expf(Glast - G_s[i]);
#pragma unroll 1
            for (int mat = 0; mat < 3; ++mat) {
                float v[32];
#pragma unroll
                for (int e = 0; e < 32; ++e) v[e] = 0.f;
#pragma unroll
                for (int j = 0; j < 4; ++j) {
                    const int ss = s + j - 1;
                    if (ss >= seg_lo && ss < seg_hi) {
                        const u32x4* src = (const u32x4*)(P + ((size_t)b * SB + ss) * PW + mat * 512 + hh * 128 + seg * 32);
                        const float* cw = cw_s + j * 384 + mat * 128 + seg * 32;
#pragma unroll
                        for (int q = 0; q < 4; ++q) { u32x4 x = src[q];
#pragma unroll
                            for (int e = 0; e < 4; ++e) { v[q * 8 + 2 * e] += cw[q * 8 + 2 * e] * lo16(x[e]); v[q * 8 + 2 * e + 1] += cw[q * 8 + 2 * e + 1] * hi16(x[e]); } }
                    }
                }
                float ss2 = 0.f;
#pragma unroll
                for (int e = 0; e < 32; ++e) { v[e] = silu(v[e]); ss2 += v[e] * v[e]; }
                ss2 += __shfl_xor(ss2, 1); ss2 += __shfl_xor(ss2, 2);
                if (mat == 0) {
                    const float sc = rsqrtf(ss2 + 1e-6f) * 0.08838834764831845f;
#pragma unroll
                    for (int e = 0; e < 32; ++e) q_s[i * 136 + seg * 32 + e] = f2bf(v[e] * sc);
                } else if (mat == 1) {
                    const float sc = rsqrtf(ss2 + 1e-6f);
#pragma unroll
                    for (int e = 0; e < 32; ++e) { const float kv = v[e] * sc; k_s[i * 136 + seg * 32 + e] = f2bf(kv); kT_s[(seg * 32 + e) * 72 + i] = f2bf(kv * kscale); }
                } else {
#pragma unroll
                    for (int e = 0; e < 32; ++e) v_s[i * 136 + seg * 32 + e] = f2bf(v[e]);
                }
            }
        }
        __syncthreads();
        {
            bf16x8 ak[4], aq[4];
#pragma unroll
            for (int ks = 0; ks < 4; ++ks) { ak[ks] = *(const bf16x8*)(k_s + (wv * 16 + l15) * 136 + ks * 32 + quad * 8); aq[ks] = *(const bf16x8*)(q_s + (wv * 16 + l15) * 136 + ks * 32 + quad * 8); }
#pragma unroll
            for (int nt = 0; nt < 4; ++nt) {
                f32x4 kk = {0.f, 0.f, 0.f, 0.f}, qq = {0.f, 0.f, 0.f, 0.f};
#pragma unroll
                for (int ks = 0; ks < 4; ++ks) { bf16x8 bk = *(const bf16x8*)(k_s + (nt * 16 + l15) * 136 + ks * 32 + quad * 8); kk = mfma16(ak[ks], bk, kk); qq = mfma16(aq[ks], bk, qq); }
                const int jj = nt * 16 + l15; const float Gj = G_s[jj];
#pragma unroll
                for (int j = 0; j < 4; ++j) {
                    const int i = wv * 16 + quad * 4 + j;
                    const float dec = jj <= i ? expf(G_s[i] - Gj) : 0.f;
                    L_s[i * 68 + jj] = jj < i ? beta_s[i] * kk[j] * dec : 0.f;
                    qk_s[i * 72 + jj] = f2bf(qq[j] * dec);
                }
            }
        }
        __syncthreads();
        dn_solve(L_s, tid < 128 ? (k_s + tid) : (v_s + (tid - 128)), tid < 128 ? bw_s : beta_s, tid < 128 ? -1.f : 1.f, tid < 128 ? (w_s + tid) : (u_s + (tid - 128)));
        __syncthreads();
        {
            f32x4 vn[8], o1[8];
#pragma unroll
            for (int nt = 0; nt < 8; ++nt) {
#pragma unroll
                for (int j = 0; j < 4; ++j) vn[nt][j] = bf2f(u_s[(wv * 16 + quad * 4 + j) * 136 + nt * 16 + l15]);
                o1[nt] = (f32x4){0.f, 0.f, 0.f, 0.f};
            }
            bf16x8 aw[4], aq[4];
#pragma unroll
            for (int ks = 0; ks < 4; ++ks) { aw[ks] = *(const bf16x8*)(w_s + (wv * 16 + l15) * 136 + ks * 32 + quad * 8); aq[ks] = *(const bf16x8*)(q_s + (wv * 16 + l15) * 136 + ks * 32 + quad * 8); }
#pragma unroll
            for (int nt = 0; nt < 8; ++nt)
#pragma unroll
                for (int ks = 0; ks < 4; ++ks) { bf16x8 bs = *(const bf16x8*)(St_s + (nt * 16 + l15) * 136 + ks * 32 + quad * 8); vn[nt] = mfma16(aw[ks], bs, vn[nt]); o1[nt] = mfma16(aq[ks], bs, o1[nt]); }
#pragma unroll
            for (int nt = 0; nt < 8; ++nt) { u32x2 o; o.x = pack2(vn[nt][0], vn[nt][1]); o.y = pack2(vn[nt][2], vn[nt][3]); *(u32x2*)(vnT_s + (nt * 16 + l15) * 72 + wv * 16 + quad * 4) = o; }
            __syncthreads();
            float eg[4];
#pragma unroll
            for (int j = 0; j < 4; ++j) eg[j] = eG_s[wv * 16 + quad * 4 + j];
            bf16x8 aqk[2], akt[2][2];
#pragma unroll
            for (int ks = 0; ks < 2; ++ks) {
                aqk[ks] = *(const bf16x8*)(qk_s + (wv * 16 + l15) * 72 + ks * 32 + quad * 8);
                akt[0][ks] = *(const bf16x8*)(kT_s + (wv * 32 + l15) * 72 + ks * 32 + quad * 8);
                akt[1][ks] = *(const bf16x8*)(kT_s + (wv * 32 + 16 + l15) * 72 + ks * 32 + quad * 8);
            }
            const float gend = eG_s[63];
            const size_t orow0 = (size_t)b * SB;
#pragma unroll
            for (int nt = 0; nt < 8; ++nt) {
                f32x4 o;
#pragma unroll
                for (int j = 0; j < 4; ++j) { o[j] = o1[nt][j] * eg[j]; Sacc[0][nt][j] *= gend; Sacc[1][nt][j] *= gend; }
#pragma unroll
                for (int ks = 0; ks < 2; ++ks) {
                    bf16x8 bv = *(const bf16x8*)(vnT_s + (nt * 16 + l15) * 72 + ks * 32 + quad * 8);
                    o = mfma16(aqk[ks], bv, o);
                    Sacc[0][nt] = mfma16(akt[0][ks], bv, Sacc[0][nt]);
                    Sacc[1][nt] = mfma16(akt[1][ks], bv, Sacc[1][nt]);
                }
#pragma unroll
                for (int j = 0; j < 4; ++j) {
                    const int i = wv * 16 + quad * 4 + j;
                    const int s = dir ? base + 63 - i : base + i;
                    TO[(orow0 + s) * 512 + hh * 128 + nt * 16 + l15] = f2bf(o[j]);
                }
#pragma unroll
                for (int mt = 0; mt < 2; ++mt) { u32x2 sv; sv.x = pack2(Sacc[mt][nt][0], Sacc[mt][nt][1]); sv.y = pack2(Sacc[mt][nt][2], Sacc[mt][nt][3]);
                    *(u32x2*)(St_s + (nt * 16 + l15) * 136 + wv * 32 + mt * 16 + quad * 4) = sv; }
            }
        }
    }
}

DEV void lru_item(const Params& p, int l, int item, unsigned char* smem) {
    const int g = item & 7, b = item >> 3;
    float* Wa_s = (float*)smem;
    float* Wi_s = Wa_s + 4096;
    float* xb_s = Wi_s + 4096;
    float* a_s = xb_s + 64 * 65;
    float* b_s = a_s + 4096;
    float* cw_s = b_s + 4096;
    const int tid = get_tid();
    bf16_t* P = wsb(p, O_P);
    bf16_t* HF = wsb(p, O_U);
    __syncthreads();
    for (int e = tid; e < 320; e += 256) cw_s[e] = e < 256 ? p.in[I_LCW][((size_t)l * 4 + (e >> 6)) * 512 + g * 64 + (e & 63)] : p.in[I_LCB][l * 512 + g * 64 + (e - 256)];
#pragma unroll 1
    for (int d = 0; d < 2; ++d) {
        __syncthreads();
        for (int e = tid; e < 4096; e += 256) {
            Wa_s[e] = p.in[I_LWA][(((size_t)l * 2 + d) * 8 + g) * 4096 + e];
            Wi_s[e] = p.in[I_LWI][(((size_t)l * 2 + d) * 8 + g) * 4096 + e];
        }
        const int i = tid >> 2, seg = tid & 3, j0 = seg * 16;
        float ba[16], bi[16], sp[16];
#pragma unroll
        for (int e = 0; e < 16; ++e) {
            const int ch = (l * 2 + d) * 512 + g * 64 + j0 + e;
            ba[e] = p.in[I_LBA][ch]; bi[e] = p.in[I_LBI][ch]; sp[e] = softplus(-p.in[I_LLAM][ch]);
        }
        float hc = 0.f;
#pragma unroll 1
        for (int n = 0; n < 68; ++n) {
            const int c = chunk_of(d, n);
            const int seg_lo = c < 4 ? 0 : CTXL, seg_hi = c < 4 ? CTXL : SB;
            const int base = c * 64;
            const int s = d ? base + 63 - i : base + i;
            {
                float v[16];
#pragma unroll
                for (int e = 0; e < 16; ++e) v[e] = cw_s[256 + j0 + e];
#pragma unroll
                for (int j = 0; j < 4; ++j) {
                    const int ss = s + j - 1;
                    if (ss >= seg_lo && ss < seg_hi) {
                        const u32x4* src = (const u32x4*)(P + ((size_t)b * SB + ss) * PW + C_LX + g * 64 + j0);
                        const float* cw = cw_s + j * 64 + j0;
#pragma unroll
                        for (int q = 0; q < 2; ++q) { u32x4 x = src[q];
#pragma unroll
                            for (int e = 0; e < 4; ++e) { v[q * 8 + 2 * e] += cw[q * 8 + 2 * e] * lo16(x[e]); v[q * 8 + 2 * e + 1] += cw[q * 8 + 2 * e + 1] * hi16(x[e]); } }
                    }
                }
#pragma unroll
                for (int e = 0; e < 16; ++e) xb_s[i * 65 + j0 + e] = v[e];
            }
            __syncthreads();
            {
                float ra[16], ia[16];
#pragma unroll
                for (int e = 0; e < 16; ++e) { ra[e] = ba[e]; ia[e] = bi[e]; }
#pragma unroll 4
                for (int ch = 0; ch < 64; ++ch) {
                    const float xv = xb_s[i * 65 + ch];
#pragma unroll
                    for (int q = 0; q < 4; ++q) {
                        const f32x4 wa = *(const f32x4*)(Wa_s + ch * 64 + j0 + q * 4), wi = *(const f32x4*)(Wi_s + ch * 64 + j0 + q * 4);
#pragma unroll
                        for (int e = 0; e < 4; ++e) { ra[q * 4 + e] += xv * wa[e]; ia[q * 4 + e] += xv * wi[e]; }
                    }
                }
#pragma unroll
                for (int e = 0; e < 16; ++e) {
                    const float r = sigm(ra[e]), ig = sigm(ia[e]);
                    const float la = -8.f * r * sp[e];
                    a_s[i * 64 + j0 + e] = expf(la);
                    b_s[i * 64 + j0 + e] = sqrtf(fmaxf(1.f - expf(2.f * la), 0.f)) * (ig * xb_s[i * 65 + j0 + e]);
                }
            }
            __syncthreads();
            if (tid < 64) {
#pragma unroll 8
                for (int r = 0; r < 64; ++r) { hc = a_s[r * 64 + tid] * hc + b_s[r * 64 + tid]; b_s[r * 64 + tid] = hc; }
            }
            __syncthreads();
            {
                const size_t row = (size_t)b * SB + s;
                bf16_t* hf = HF + row * 512 + g * 64 + j0;
                if (d == 0) {
                    u32x4 o0, o1;
#pragma unroll
                    for (int e = 0; e < 4; ++e) { o0[e] = pack2(b_s[i * 64 + j0 + 2 * e], b_s[i * 64 + j0 + 2 * e + 1]); o1[e] = pack2(b_s[i * 64 + j0 + 8 + 2 * e], b_s[i * 64 + j0 + 8 + 2 * e + 1]); }
                    *(u32x4*)hf = o0; *(u32x4*)(hf + 8) = o1;
                } else {
                    bf16_t* gp = P + row * PW + C_LG + g * 64 + j0;
                    u32x4 f0 = *(const u32x4*)hf, f1 = *(const u32x4*)(hf + 8), g0 = *(const u32x4*)gp, g1 = *(const u32x4*)(gp + 8), o0, o1;
#pragma unroll
                    for (int e = 0; e < 4; ++e) {
                        o0[e] = pack2((lo16(f0[e]) + b_s[i * 64 + j0 + 2 * e]) * gelu_tanh(lo16(g0[e])), (hi16(f0[e]) + b_s[i * 64 + j0 + 2 * e + 1]) * gelu_tanh(hi16(g0[e])));
                        o1[e] = pack2((lo16(f1[e]) + b_s[i * 64 + j0 + 8 + 2 * e]) * gelu_tanh(lo16(g1[e])), (hi16(f1[e]) + b_s[i * 64 + j0 + 8 + 2 * e + 1]) * gelu_tanh(hi16(g1[e])));
                    }
                    *(u32x4*)gp = o0; *(u32x4*)(gp + 8) = o1;
                }
            }
        }
    }
}

DEV void att_item(const Params& p, int l, int b, int h, int qt, float lam_init, unsigned char* smem) {
    bf16_t* K_s = (bf16_t*)smem;
    bf16_t* V_s = (bf16_t*)(smem + 2 * 17408);
    const int tid = get_tid(), lane = tid & 63, wv = tid >> 6, l15 = lane & 15, quad = lane >> 4;
    bf16_t* P = wsb(p, O_P);
    const bf16_t* VT = wsb(p, O_VT) + (size_t)(b * 4 + h) * 128 * SB;
    const int nt_keys = (qt < 2 ? CTXL : SB) / 64;
    float lam;
    {
        const float* lv = p.in[I_DALAM] + l * 256;
        float s1 = lv[lane] * lv[64 + lane], s2 = lv[128 + lane] * lv[192 + lane];
#pragma unroll
        for (int o = 32; o >= 1; o >>= 1) { s1 += __shfl_xor(s1, o); s2 += __shfl_xor(s2, o); }
        lam = expf(s1) - expf(s2) + lam_init;
    }
    bf16x8* Qst = (bf16x8*)(smem + 71680) + (wv * 8) * 64 + lane;
#pragma unroll
    for (int qg = 0; qg < 2; ++qg) {
        const bf16_t* qp = P + ((size_t)b * SB + qt * 128 + wv * 32 + qg * 16 + l15) * PW + C_DAQ + h * 128;
#pragma unroll
        for (int wh = 0; wh < 2; ++wh)
#pragma unroll
            for (int ks = 0; ks < 2; ++ks) Qst[(wh * 4 + qg * 2 + ks) * 64] = *(const bf16x8*)(qp + wh * 64 + ks * 32 + quad * 8);
    }
    f32x4 O[2][8][2];
    float mrun[2][2], lrun[2][2];
#pragma unroll
    for (int wh = 0; wh < 2; ++wh)
#pragma unroll
        for (int qg = 0; qg < 2; ++qg) { mrun[wh][qg] = -1e30f; lrun[wh][qg] = 0.f;
#pragma unroll
            for (int dg = 0; dg < 8; ++dg) O[wh][dg][qg] = (f32x4){0.f, 0.f, 0.f, 0.f}; }
    const int kr = tid >> 2, kseg = (tid & 3) * 32;
    const int kpos = ((kr >> 5) * 2 + ((kr & 7) >> 2)) * 16 + ((kr & 31) >> 3) * 4 + (kr & 3);
    const bf16_t* kg_ = P + ((size_t)b * SB + kr) * PW + C_DAK + h * 128 + kseg;
    const int vr = tid >> 1, vh = (tid & 1) * 32;
    const bf16_t* vg_ = VT + (size_t)vr * SB + vh;
    u32x4 kreg[4], vreg[4];
#pragma unroll
    for (int i = 0; i < 4; ++i) { kreg[i] = *(const u32x4*)(kg_ + i * 8); vreg[i] = *(const u32x4*)(vg_ + i * 8); }
    __syncthreads();
#pragma unroll
    for (int i = 0; i < 4; ++i) { *(u32x4*)(K_s + kpos * 136 + kseg + i * 8) = kreg[i]; *(u32x4*)(V_s + vr * 72 + vh + i * 8) = vreg[i]; }
    __syncthreads();
    const float L2E = 1.4426950408889634f;
#pragma unroll 1
    for (int t = 0; t < nt_keys; ++t) {
        const bf16_t* Kb = K_s + (t & 1) * (64 * 136);
        const bf16_t* Vb = V_s + (t & 1) * (128 * 72);
        if (t + 1 < nt_keys) {
#pragma unroll
            for (int i = 0; i < 4; ++i) { kreg[i] = *(const u32x4*)(kg_ + (size_t)(t + 1) * 64 * PW + i * 8); vreg[i] = *(const u32x4*)(vg_ + (t + 1) * 64 + i * 8); }
        }
#pragma unroll
        for (int wh = 0; wh < 2; ++wh) {
            f32x4 S[4][2];
#pragma unroll
            for (int kg = 0; kg < 4; ++kg) { S[kg][0] = (f32x4){0.f, 0.f, 0.f, 0.f}; S[kg][1] = (f32x4){0.f, 0.f, 0.f, 0.f}; }
#pragma unroll
            for (int ks = 0; ks < 2; ++ks)
#pragma unroll
                for (int kg = 0; kg < 4; ++kg) {
                    bf16x8 kf = *(const bf16x8*)(Kb + (kg * 16 + l15) * 136 + wh * 64 + ks * 32 + quad * 8);
                    S[kg][0] = mfma16(kf, Qst[(wh * 4 + 0 + ks) * 64], S[kg][0]);
                    S[kg][1] = mfma16(kf, Qst[(wh * 4 + 2 + ks) * 64], S[kg][1]);
                }
            bf16x8 Pf[2][2];
#pragma unroll
            for (int qg = 0; qg < 2; ++qg) {
                float mx = -1e30f;
#pragma unroll
                for (int kg = 0; kg < 4; ++kg)
#pragma unroll
                    for (int j = 0; j < 4; ++j) mx = fmaxf(mx, S[kg][qg][j]);
                mx = fmaxf(mx, __shfl_xor(mx, 16)); mx = fmaxf(mx, __shfl_xor(mx, 32));
                const float mnew = fmaxf(mrun[wh][qg], mx * L2E);
                const float alpha = __builtin_amdgcn_exp2f(mrun[wh][qg] - mnew);
                mrun[wh][qg] = mnew;
                float ps = 0.f;
#pragma unroll
                for (int kg = 0; kg < 4; ++kg)
#pragma unroll
                    for (int j = 0; j < 4; ++j) { float pv = __builtin_amdgcn_exp2f(S[kg][qg][j] * L2E - mnew); ps += pv; S[kg][qg][j] = pv; }
                lrun[wh][qg] = lrun[wh][qg] * alpha + ps;
#pragma unroll
                for (int dg = 0; dg < 8; ++dg)
#pragma unroll
                    for (int j = 0; j < 4; ++j) O[wh][dg][qg][j] *= alpha;
#pragma unroll
                for (int s_ = 0; s_ < 2; ++s_) {
                    u32x4 pk; pk[0] = pack2(S[2 * s_][qg][0], S[2 * s_][qg][1]); pk[1] = pack2(S[2 * s_][qg][2], S[2 * s_][qg][3]);
                    pk[2] = pack2(S[2 * s_ + 1][qg][0], S[2 * s_ + 1][qg][1]); pk[3] = pack2(S[2 * s_ + 1][qg][2], S[2 * s_ + 1][qg][3]);
                    Pf[qg][s_] = __builtin_bit_cast(bf16x8, pk);
                }
            }
#pragma unroll
            for (int dg = 0; dg < 8; ++dg)
#pragma unroll
                for (int s_ = 0; s_ < 2; ++s_) {
                    bf16x8 vf = *(const bf16x8*)(Vb + (dg * 16 + l15) * 72 + s_ * 32 + quad * 8);
                    O[wh][dg][0] = mfma16(vf, Pf[0][s_], O[wh][dg][0]);
                    O[wh][dg][1] = mfma16(vf, Pf[1][s_], O[wh][dg][1]);
                }
        }
        if (t + 1 < nt_keys) {
            bf16_t* Kn = K_s + ((t + 1) & 1) * (64 * 136); bf16_t* Vn = V_s + ((t + 1) & 1) * (128 * 72);
#pragma unroll
            for (int i = 0; i < 4; ++i) { *(u32x4*)(Kn + kpos * 136 + kseg + i * 8) = kreg[i]; *(u32x4*)(Vn + vr * 72 + vh + i * 8) = vreg[i]; }
        }
        __syncthreads();
    }
    const float* dnw = p.in[I_DANORM] + l * 128;
#pragma unroll
    for (int qg = 0; qg < 2; ++qg) {
        float l1 = lrun[0][qg], l2 = lrun[1][qg];
        l1 += __shfl_xor(l1, 16); l1 += __shfl_xor(l1, 32); l2 += __shfl_xor(l2, 16); l2 += __shfl_xor(l2, 32);
        const float i1 = 1.f / l1, i2 = lam / l2;
        float ss = 0.f;
#pragma unroll
        for (int dg = 0; dg < 8; ++dg)
#pragma unroll
            for (int j = 0; j < 4; ++j) { float o = O[0][dg][qg][j] * i1 - O[1][dg][qg][j] * i2; O[0][dg][qg][j] = o; ss += o * o; }
        ss += __shfl_xor(ss, 16); ss += __shfl_xor(ss, 32);
        const float rstd = rsqrtf(ss * (1.f / 128.f) + 1e-5f) * (1.f - lam_init);
        bf16_t* op = P + ((size_t)b * SB + qt * 128 + wv * 32 + qg * 16 + l15) * PW + C_DAQ + h * 128;
#pragma unroll
        for (int dg = 0; dg < 8; ++dg) {
            const int dv0 = dg * 16 + quad * 4;
            u32x2 o; o.x = pack2(O[0][dg][qg][0] * rstd * dnw[dv0], O[0][dg][qg][1] * rstd * dnw[dv0 + 1]);
            o.y = pack2(O[0][dg][qg][2] * rstd * dnw[dv0 + 2], O[0][dg][qg][3] * rstd * dnw[dv0 + 3]);
            *(u32x2*)(op + dv0) = o;
        }
    }
}

DEV void phase_mix(const Params& p, int l, unsigned char* smem) {
    const bool need_ctx = l == 0;
    const float lam_init = l == 0 ? 0.2f : 0.35550906759096926f;
    unsigned* ctr = (unsigned*)(p.ws + O_CTL) + l;
    __shared__ int s_item;
    const int nqt = need_ctx ? 34 : 32;
    const int total = 64 + 64 + 32 * nqt;
    auto next = [&]() -> int {
        __syncthreads();
        if (threadIdx.x == 0) s_item = (int)atomicAdd(ctr, 1u);
        __syncthreads();
        return __builtin_amdgcn_readfirstlane(s_item);
    };
    int it = next();
#pragma unroll 1
    while (it < 64) { dn_item(p, l, it, smem); it = next(); }
#pragma unroll 1
    while (it < 128) { lru_item(p, l, it - 64, smem); it = next(); }
#pragma unroll 1
    while (it < total) {
        const int a = it - 128, bh = a / nqt, idx = a % nqt;
        const int qt = idx < 32 ? idx + 2 : idx - 32;
        att_item(p, l, bh >> 2, bh & 3, qt, lam_init, smem);
        it = next();
    }
}

constexpr int NPHASE = 1 + 2 * 9 + 1;
DEV void run_phase(const Params& p, int ph, unsigned char* smem) {
    if (ph == 0) { phase_mod(p, smem); phase_rope(p); __syncthreads(); phase_wconv(p, 0, smem); return; }
    if (ph == NPHASE - 1) { phase_final(p); return; }
    const int l = (ph - 1) / 9, q = (ph - 1) % 9;
    const bool first = l == 0, lat = l == 1;
    const bf16_t* W = wsb(p, O_WT);
    switch (q) {
        case 0: if (l == 1) phase_wconv(p, 1, smem); phase_norm(p, l, 0, first, false); break;
        case 1: phase_g1(p, smem); break;
        case 2: phase_mix(p, l, smem); break;
        case 3: phase_fin_norm(p, l, first, lat); break;
        case 4: phase_gate(p, lat, smem); break;
        case 5: phase_resid(p, l, wsb(p, O_U), D, W + W_OUT, 1024, 2, first, lat, smem); break;
        case 6: phase_norm(p, l, 1, false, lat); break;
        case 7: phase_gu(p, lat, smem); break;
        case 8: phase_resid(p, l, wsb(p, O_P), PW, W + W_DN, DFF, 5, false, lat, smem); break;
    }
}

#if MEGA
__global__ void __launch_bounds__(256) mega_kernel(Params p) {
    extern __shared__ __align__(16) unsigned char smem[];
    cg::grid_group grid = cg::this_grid();
    phase_mod(p, smem); phase_rope(p); __syncthreads(); phase_wconv(p, 0, smem);
    grid.sync();
    const bf16_t* W = wsb(p, O_WT);
#pragma unroll
    for (int l = 0; l < 2; ++l) {
        const bool first = l == 0, lat = l == 1;
        if (l == 1) phase_wconv(p, 1, smem);
        phase_norm(p, l, 0, first, false);
        grid.sync();
        phase_g1(p, smem);
        grid.sync();
        phase_mix(p, l, smem);
        grid.sync();
        phase_fin_norm(p, l, first, lat);
        grid.sync();
        phase_gate(p, lat, smem);
        grid.sync();
        phase_merge(p, lat, smem);
        grid.sync();
        phase_resid(p, l, wsb(p, O_U), D, W + W_OUT, 1024, 2, first, lat, smem);
        grid.sync();
        phase_norm(p, l, 1, false, lat);
        grid.sync();
        phase_gu(p, lat, smem);
        grid.sync();
        phase_resid(p, l, wsb(p, O_P), PW, W + W_DN, DFF, 5, false, lat, smem);
        grid.sync();
    }
    phase_final(p);
}
#else
__global__ void __launch_bounds__(256) phase_kernel(Params p, int ph) {
    extern __shared__ __align__(16) unsigned char smem[];
    run_phase(p, ph, smem);
}
#endif

extern "C" void kernel_launch(void* const* d_in, const int* in_sizes, int n_in, void* d_out, int out_size, void* d_ws, size_t ws_size, hipStream_t stream) {
    static int grid = 0;
    if (grid == 0) {
        if (n_in != 28 || ws_size < WS_END) { fprintf(stderr, "kernel_launch: unexpected n_in %d or ws_size %zu < %zu\n", n_in, ws_size, (size_t)WS_END); grid = -1; return; }
        int dev = 0, cus = 0, per_cu = 0;
        hipGetDevice(&dev);
        hipDeviceGetAttribute(&cus, hipDeviceAttributeMultiprocessorCount, dev);
#if MEGA
        hipFuncSetAttribute((const void*)mega_kernel, hipFuncAttributeMaxDynamicSharedMemorySize, LDS_BYTES);
        hipOccupancyMaxActiveBlocksPerMultiprocessor(&per_cu, (const void*)mega_kernel, 256, LDS_BYTES);
#else
        hipFuncSetAttribute((const void*)phase_kernel, hipFuncAttributeMaxDynamicSharedMemorySize, LDS_BYTES);
        hipOccupancyMaxActiveBlocksPerMultiprocessor(&per_cu, (const void*)phase_kernel, 256, LDS_BYTES);
#endif
        if (per_cu < 1) per_cu = 1;
        grid = cus * per_cu;
        fprintf(stderr, "kernel_launch: grid %d (%d CUs x %d)\n", grid, cus, per_cu);
    }
    if (grid < 0) return;
    hipMemsetAsync((char*)d_ws + O_CTL, 0, 4096, stream);
    Params p{};
    for (int i = 0; i < 28; ++i) p.in[i] = (const float*)d_in[i];
    p.out = (float*)d_out; p.ws = (unsigned char*)d_ws;
#if MEGA
    void* args[] = {&p};
    hipError_t e = hipLaunchCooperativeKernel((const void*)mega_kernel, dim3(grid), dim3(256), args, LDS_BYTES, stream);
    if (e != hipSuccess) fprintf(stderr, "cooperative launch failed: %s (grid %d)\n", hipGetErrorString(e), grid);
#else
    for (int ph = 0; ph < NPHASE; ++ph) hipLaunchKernelGGL(phase_kernel, dim3(grid), dim3(256), LDS_BYTES, stream, p, ph);
#endif
}
```

```cpp
#include <hip/hip_runtime.h>
#include <hip/hip_cooperative_groups.h>
#include <cstdio>
#include <cstdint>
namespace cg = cooperative_groups;

#ifndef MEGA
#define MEGA 1
#endif

typedef unsigned short bf16_t;
typedef short bf16x8 __attribute__((ext_vector_type(8)));
typedef float f32x4 __attribute__((ext_vector_type(4)));
typedef unsigned u32x4 __attribute__((ext_vector_type(4)));
typedef unsigned u32x2 __attribute__((ext_vector_type(2)));
#define DEV __device__ __forceinline__

constexpr int D = 1024, NB = 8, SEQ = 4096, CTXL = 256, SB = 4352, MR = NB * SB, PW = 4096, DFF = 2816;
constexpr int C_DNQ = 0, C_DNK = 512, C_DNV = 1024, C_DNZ = 1536, C_LX = 2048, C_LG = 2560, C_DAQ = 3072, C_DAK = 3584;
constexpr int NIN = 4736;
constexpr int GLD = 72;

enum { I_X = 0, I_C, I_CTX, I_CCTX, I_WMOD, I_BMOD, I_NMIX, I_NFFN, I_WIN, I_DNCONV, I_DNALOG, I_DNDT, I_DNNORM, I_LCW, I_LCB,
       I_LWA, I_LBA, I_LWI, I_LBI, I_LLAM, I_DALAM, I_DANORM, I_WBR, I_WOUT, I_WFG, I_WFU, I_WFD, I_NFIN };

constexpr size_t al256(size_t x) { return (x + 255) & ~(size_t)255; }
constexpr size_t O_CTL = 0;
constexpr size_t O_MOD = 4096;
constexpr size_t O_ROPE = al256(O_MOD + (size_t)2 * 9 * 6144 * 4);
constexpr size_t O_WT = al256(O_ROPE + 64 * 16 * 2 * 4);
constexpr size_t W_IN = 0, W_GATE = W_IN + (size_t)NIN * 1024, W_BR = W_GATE + (size_t)3072 * 1024, W_OUT = W_BR + (size_t)3 * 1024 * 512,
                 W_GU = W_OUT + (size_t)1024 * 1024, W_DN = W_GU + (size_t)5632 * 1024, W_END = W_DN + (size_t)1024 * 2816;
constexpr size_t O_HCTX = al256(O_WT + W_END * 2);
constexpr size_t O_U = al256(O_HCTX + (size_t)2048 * 1024 * 4);
constexpr size_t O_P = al256(O_U + (size_t)MR * 1024 * 2);
constexpr size_t O_AB = al256(O_P + (size_t)MR * PW * 2);
constexpr size_t O_TA = al256(O_AB + (size_t)MR * 16 * 4);
constexpr size_t O_TA2 = al256(O_TA + (size_t)MR * 512 * 2);
constexpr size_t O_VT = al256(O_TA2 + (size_t)MR * 512 * 2);
constexpr size_t WS_END = al256(O_VT + (size_t)MR * 512 * 2);

constexpr int LDS_BYTES = 140 * 1024;

struct Params {
    const float* in[28];
    float* out;
    unsigned char* ws;
};

DEV int get_tid() { int t = threadIdx.x; asm volatile("" : "+v"(t)); return t; }
DEV float bf2f(bf16_t h) { return __uint_as_float(((unsigned)h) << 16); }
DEV bf16_t f2bf(float f) { unsigned u = __float_as_uint(f); u += 0x7fffu + ((u >> 16) & 1u); return (bf16_t)(u >> 16); }
DEV unsigned pack2(float a, float b) { return (unsigned)f2bf(a) | ((unsigned)f2bf(b) << 16); }
DEV float sigm(float x) { return 1.f / (1.f + __expf(-x)); }
DEV float silu(float x) { return x / (1.f + __expf(-x)); }
DEV float softplus(float x) { return x > 20.f ? x : log1pf(expf(x)); }
DEV float softplus_fast(float x) { const float e = __expf(x); return x > 15.f ? x : (e < 0.01f ? e * (1.f - e * (0.5f - e * 0.33333333f)) : __logf(1.f + e)); }
DEV float gelu_tanh(float x) { float u = 0.7978845608028654f * (x + 0.044715f * x * x * x); float t = 1.f - 2.f / (1.f + __expf(2.f * u)); return 0.5f * x * (1.f + t); }
DEV f32x4 mfma16(bf16x8 a, bf16x8 b, f32x4 c) { return __builtin_amdgcn_mfma_f32_16x16x32_bf16(a, b, c, 0, 0, 0); }
DEV void mfma16a(f32x4& c, bf16x8 a, bf16x8 b) { asm volatile("v_mfma_f32_16x16x32_bf16 %0, %1, %2, %0" : "+a"(c) : "v"(a), "v"(b)); }
DEV float lo16(unsigned v) { return __uint_as_float(v << 16); }
DEV float hi16(unsigned v) { return __uint_as_float(v & 0xffff0000u); }

DEV bf16_t* wsb(const Params& p, size_t off) { return (bf16_t*)(p.ws + off); }
DEV float* wsf(const Params& p, size_t off) { return (float*)(p.ws + off); }
DEV float* hrow(const Params& p, int r) { int b = r / SB, s = r - b * SB; return s < CTXL ? wsf(p, O_HCTX) + (size_t)(b * CTXL + s) * D : p.out + (size_t)(b * SEQ + s - CTXL) * D; }
DEV const float* xrow(const Params& p, int r) { int b = r / SB, s = r - b * SB; return s < CTXL ? p.in[I_CTX] + (size_t)(b * CTXL + s) * D : p.in[I_X] + (size_t)(b * SEQ + s - CTXL) * D; }
DEV int modrow(int r) { int b = r / SB, s = r - b * SB; return s < CTXL ? 8 : b; }

template <int MT, int NT>
DEV void gemm_core(const bf16_t* __restrict__ A, int lda, const bf16_t* __restrict__ Bt, int ldb, int K, f32x4 (&acc)[MT][NT], bf16_t* smem_) {
    constexpr int SA = 32 * MT * GLD, SBB = 32 * NT * GLD;
    bf16_t* sA = smem_; bf16_t* sB = smem_ + 2 * SA;
    const int tid = get_tid(), lane = tid & 63, wv = tid >> 6, wr = wv >> 1, wc = wv & 1, l15 = lane & 15, quad = lane >> 4;
    const int lr = tid >> 3, lc = (tid & 7) * 8;
    u32x4 ra0[MT], rb0[NT], ra1[MT], rb1[NT];
    const bf16_t* Ap = A + (size_t)lr * lda + lc;
    const bf16_t* Bp = Bt + (size_t)lr * ldb + lc;
    const int nk = K >> 6;
#define GLOAD(RA, RB, KT) { const int ko_ = (KT) * 64; _Pragma("unroll") for (int i = 0; i < MT; ++i) RA[i] = *(const u32x4*)(Ap + (size_t)(32 * i) * lda + ko_); \
                            _Pragma("unroll") for (int i = 0; i < NT; ++i) RB[i] = *(const u32x4*)(Bp + (size_t)(32 * i) * ldb + ko_); }
#define LSTORE(RA, RB, BUF) { _Pragma("unroll") for (int i = 0; i < MT; ++i) *(u32x4*)(sA + (BUF) * SA + (lr + 32 * i) * GLD + lc) = RA[i]; \
                              _Pragma("unroll") for (int i = 0; i < NT; ++i) *(u32x4*)(sB + (BUF) * SBB + (lr + 32 * i) * GLD + lc) = RB[i]; }
#define COMPUTE(BUF) { _Pragma("unroll") for (int ks = 0; ks < 2; ++ks) { bf16x8 af[MT], bfr[NT]; \
        _Pragma("unroll") for (int mt = 0; mt < MT; ++mt) af[mt] = *(const bf16x8*)(sA + (BUF) * SA + (wr * MT * 16 + mt * 16 + l15) * GLD + ks * 32 + quad * 8); \
        _Pragma("unroll") for (int nt = 0; nt < NT; ++nt) bfr[nt] = *(const bf16x8*)(sB + (BUF) * SBB + (wc * NT * 16 + nt * 16 + l15) * GLD + ks * 32 + quad * 8); \
        _Pragma("unroll") for (int mt = 0; mt < MT; ++mt) _Pragma("unroll") for (int nt = 0; nt < NT; ++nt) mfma16a(acc[mt][nt], af[mt], bfr[nt]); } }
    GLOAD(ra0, rb0, 0);
    GLOAD(ra1, rb1, 1);
    __syncthreads();
    LSTORE(ra0, rb0, 0);
    GLOAD(ra0, rb0, 2);
    __syncthreads();
#pragma unroll 1
    for (int kt = 0; kt < nk; kt += 2) {
        COMPUTE(0);
        if (kt + 1 < nk) LSTORE(ra1, rb1, 1);
        if (kt + 3 < nk) GLOAD(ra1, rb1, kt + 3);
        __syncthreads();
        COMPUTE(1);
        if (kt + 2 < nk) LSTORE(ra0, rb0, 0);
        if (kt + 4 < nk) GLOAD(ra0, rb0, kt + 4);
        __syncthreads();
    }
#undef GLOAD
#undef LSTORE
#undef COMPUTE
    asm volatile("s_nop 15\n\ts_nop 15" ::: "memory");
}
template <int MT, int NT>
DEV void gemm_core1(const bf16_t* __restrict__ A, int lda, const bf16_t* __restrict__ Bt, int ldb, int K, f32x4 (&acc)[MT][NT], bf16_t* sA, bf16_t* sB) {
    const int tid = get_tid(), lane = tid & 63, wv = tid >> 6, wr = wv >> 1, wc = wv & 1, l15 = lane & 15, quad = lane >> 4;
    const int lr = tid >> 3, lc = (tid & 7) * 8;
    u32x4 ra[MT], rb[NT];
    const bf16_t* Ap = A + (size_t)lr * lda + lc;
    const bf16_t* Bp = Bt + (size_t)lr * ldb + lc;
#pragma unroll
    for (int i = 0; i < MT; ++i) ra[i] = *(const u32x4*)(Ap + (size_t)(32 * i) * lda);
#pragma unroll
    for (int i = 0; i < NT; ++i) rb[i] = *(const u32x4*)(Bp + (size_t)(32 * i) * ldb);
    const int nk = K >> 6;
    for (int kt = 0; kt < nk; ++kt) {
        __syncthreads();
#pragma unroll
        for (int i = 0; i < MT; ++i) *(u32x4*)(sA + (lr + 32 * i) * GLD + lc) = ra[i];
#pragma unroll
        for (int i = 0; i < NT; ++i) *(u32x4*)(sB + (lr + 32 * i) * GLD + lc) = rb[i];
        __syncthreads();
        if (kt + 1 < nk) {
            const int ko = (kt + 1) * 64;
#pragma unroll
            for (int i = 0; i < MT; ++i) ra[i] = *(const u32x4*)(Ap + (size_t)(32 * i) * lda + ko);
#pragma unroll
            for (int i = 0; i < NT; ++i) rb[i] = *(const u32x4*)(Bp + (size_t)(32 * i) * ldb + ko);
        }
#pragma unroll
        for (int ks = 0; ks < 2; ++ks) {
            bf16x8 af[MT], bfr[NT];
#pragma unroll
            for (int mt = 0; mt < MT; ++mt) af[mt] = *(const bf16x8*)(sA + (wr * MT * 16 + mt * 16 + l15) * GLD + ks * 32 + quad * 8);
#pragma unroll
            for (int nt = 0; nt < NT; ++nt) bfr[nt] = *(const bf16x8*)(sB + (wc * NT * 16 + nt * 16 + l15) * GLD + ks * 32 + quad * 8);
#pragma unroll
            for (int mt = 0; mt < MT; ++mt)
#pragma unroll
                for (int nt = 0; nt < NT; ++nt) mfma16a(acc[mt][nt], af[mt], bfr[nt]);
        }
    }
    asm volatile("s_nop 15\n\ts_nop 15" ::: "memory");
}
template <int MT, int NT>
DEV void zero_acc(f32x4 (&acc)[MT][NT]) {
#pragma unroll
    for (int mt = 0; mt < MT; ++mt)
#pragma unroll
        for (int nt = 0; nt < NT; ++nt) acc[mt][nt] = (f32x4){0.f, 0.f, 0.f, 0.f};
}

DEV void phase_mod(const Params& p, unsigned char* smem) {
    float* s_s = (float*)smem;
    float* red = s_s + 9 * 1024;
    const int tid = get_tid();
    bool loaded = false;
    for (int it = blockIdx.x; it < 2 * 96; it += gridDim.x) {
        if (!loaded) {
            for (int e = tid; e < 9 * 1024; e += 256) { float v = e < 8192 ? p.in[I_C][e] : p.in[I_CCTX][e - 8192]; s_s[e] = silu(v); }
            loaded = true;
        }
        __syncthreads();
        const int l = it / 96, cg_ = it % 96, cq = tid & 63, kq = tid >> 6, col = cg_ * 64 + cq;
        float acc[9];
#pragma unroll
        for (int r = 0; r < 9; ++r) acc[r] = 0.f;
        const float* wp = p.in[I_WMOD] + ((size_t)l * 1024 + kq * 256) * 6144 + col;
#pragma unroll 8
        for (int k = 0; k < 256; ++k) {
            float wv = wp[(size_t)k * 6144];
#pragma unroll
            for (int r = 0; r < 9; ++r) acc[r] += s_s[r * 1024 + kq * 256 + k] * wv;
        }
#pragma unroll
        for (int r = 0; r < 9; ++r) red[(kq * 9 + r) * 64 + cq] = acc[r];
        __syncthreads();
        for (int e = tid; e < 9 * 64; e += 256) {
            int r = e >> 6, c2 = e & 63;
            float v = red[(0 * 9 + r) * 64 + c2] + red[(1 * 9 + r) * 64 + c2] + red[(2 * 9 + r) * 64 + c2] + red[(3 * 9 + r) * 64 + c2];
            wsf(p, O_MOD)[((size_t)l * 9 + r) * 6144 + cg_ * 64 + c2] = v + p.in[I_BMOD][l * 6144 + cg_ * 64 + c2];
        }
        __syncthreads();
    }
}
DEV void phase_rope(const Params& p) {
    if (blockIdx.x == (gridDim.x - 1)) {
        for (int e = threadIdx.x; e < 1024; e += 256) {
            int pos = e >> 4, i = e & 15;
            float inv = powf(10000.f, -(float)i / 16.f);
            float ang = (float)pos * inv;
            float n = rintf(ang * 0.15915494309189535f);
            float r = fmaf(-n, 6.28125f, ang);
            r = fmaf(-n, 1.9353071795864769e-3f, r);
            wsf(p, O_ROPE)[e * 2] = cosf(r);
            wsf(p, O_ROPE)[e * 2 + 1] = sinf(r);
        }
    }
}
DEV void wconv_tile(const float* src0, const float* src1, int lds_, int K, bf16_t* dst, int kind, int kt, int nt, bf16_t* tile) {
    const int tid = get_tid();
    const int kk = tid >> 2, grp = tid & 3;
    const int n0 = nt * 64, k0 = kt * 64;
    const int ng = n0 + grp * 16;
    const float* src = src0; int sc;
    if (kind == 0) { sc = ng < 2048 ? ng : (ng < 4608 ? ng + 16 : (ng < 4624 ? 2048 : -1)); }
    else if (kind == 1) { sc = 4624 + ng; }
    else if (kind == 2) { sc = ng; }
    else { int gd = ng >> 4; src = (gd & 1) ? src1 : src0; sc = (gd >> 1) * 16; }
    __syncthreads();
    if (sc >= 0) {
        const float4* sp = (const float4*)(src + (size_t)(k0 + kk) * lds_ + sc);
#pragma unroll
        for (int q = 0; q < 4; ++q) { float4 v = sp[q]; int e = grp * 16 + q * 4;
            tile[(e + 0) * GLD + kk] = f2bf(v.x); tile[(e + 1) * GLD + kk] = f2bf(v.y); tile[(e + 2) * GLD + kk] = f2bf(v.z); tile[(e + 3) * GLD + kk] = f2bf(v.w); }
    } else {
#pragma unroll
        for (int e = 0; e < 16; ++e) tile[(grp * 16 + e) * GLD + kk] = 0;
    }
    __syncthreads();
    const int n = tid >> 2, kseg = (tid & 3) * 16;
    u32x4 a = *(const u32x4*)(tile + n * GLD + kseg), b = *(const u32x4*)(tile + n * GLD + kseg + 8);
    bf16_t* dp = dst + (size_t)(n0 + n) * K + k0 + kseg;
    *(u32x4*)dp = a; *(u32x4*)(dp + 8) = b;
}
DEV void phase_wconv(const Params& p, int l, unsigned char* smem) {
    bf16_t* tile = (bf16_t*)smem;
    bf16_t* W = wsb(p, O_WT);
    constexpr int T0 = 74 * 16, T1 = T0 + 48 * 16, T2 = T1 + 3 * 16 * 8, T3 = T2 + 16 * 16, T4 = T3 + 88 * 16, T5 = T4 + 16 * 44;
    for (int t = blockIdx.x; t < T5; t += gridDim.x) {
        if (t < T0) { wconv_tile(p.in[I_WIN] + (size_t)l * 1024 * 7696, nullptr, 7696, 1024, W + W_IN, 0, t % 16, t / 16, tile); }
        else if (t < T1) { int u = t - T0; wconv_tile(p.in[I_WIN] + (size_t)l * 1024 * 7696, nullptr, 7696, 1024, W + W_GATE, 1, u % 16, u / 16, tile); }
        else if (t < T2) { int u = t - T1; int n = u / 128, v = u % 128; wconv_tile(p.in[I_WBR] + ((size_t)l * 3 + n) * 512 * 1024, nullptr, 1024, 512, W + W_BR + (size_t)n * 1024 * 512, 2, v % 8, v / 8, tile); }
        else if (t < T3) { int u = t - T2; wconv_tile(p.in[I_WOUT] + (size_t)l * 1024 * 1024, nullptr, 1024, 1024, W + W_OUT, 2, u % 16, u / 16, tile); }
        else if (t < T4) { int u = t - T3; wconv_tile(p.in[I_WFG] + (size_t)l * 1024 * DFF, p.in[I_WFU] + (size_t)l * 1024 * DFF, DFF, 1024, W + W_GU, 3, u % 16, u / 16, tile); }
        else { int u = t - T4; wconv_tile(p.in[I_WFD] + (size_t)l * DFF * 1024, nullptr, 1024, DFF, W + W_DN, 2, u % 44, u / 44, tile); }
    }
}

DEV void norm_row(const Params& p, int l, int which, bool first, int r, int lane) {
    const float* h = first ? xrow(p, r) : hrow(p, r);
    const float* nw = p.in[which ? I_NFFN : I_NMIX] + l * D;
    const float* md = wsf(p, O_MOD) + ((size_t)l * 9 + modrow(r)) * 6144 + (which ? 3 * D : 0);
    float4 v[4]; float ss = 0.f;
#pragma unroll
    for (int i = 0; i < 4; ++i) { v[i] = *(const float4*)(h + i * 256 + lane * 4); ss += v[i].x * v[i].x + v[i].y * v[i].y + v[i].z * v[i].z + v[i].w * v[i].w; }
#pragma unroll
    for (int o = 32; o >= 1; o >>= 1) ss += __shfl_xor(ss, o);
    const float rstd = rsqrtf(ss * (1.f / D) + 1e-6f);
    bf16_t* up = wsb(p, O_U) + (size_t)r * D;
#pragma unroll
    for (int i = 0; i < 4; ++i) {
        const int c = i * 256 + lane * 4;
        float4 w4 = *(const float4*)(nw + c), sh = *(const float4*)(md + c), sc = *(const float4*)(md + D + c);
        float a = v[i].x * rstd * w4.x * (1.f + sc.x) + sh.x, b = v[i].y * rstd * w4.y * (1.f + sc.y) + sh.y;
        float c2 = v[i].z * rstd * w4.z * (1.f + sc.z) + sh.z, d = v[i].w * rstd * w4.w * (1.f + sc.w) + sh.w;
        u32x2 o; o.x = pack2(a, b); o.y = pack2(c2, d);
        *(u32x2*)(up + c) = o;
    }
}
DEV void phase_norm(const Params& p, int l, int which, bool first, bool skip_ctx) {
    const int tid_ = get_tid(); const int lane = tid_ & 63, wv = tid_ >> 6;
    for (int r = blockIdx.x * 4 + wv; r < MR; r += gridDim.x * 4) {
        if (skip_ctx && (r % SB) < CTXL) continue;
        norm_row(p, l, which, first, r, lane);
    }
}
DEV void phase_fin_norm(const Params& p, int l, bool first, bool skip_ctx) {
    const int tid_ = get_tid(); const int lane = tid_ & 63, wv = tid_ >> 6;
    const float* dnn = p.in[I_DNNORM] + l * 128;
    for (int r = blockIdx.x * 4 + wv; r < MR; r += gridDim.x * 4) {
        if (skip_ctx && (r % SB) < CTXL) continue;
        norm_row(p, l, 0, first, r, lane);
        bf16_t* ta = wsb(p, O_TA) + (size_t)r * 512 + lane * 8;
        const bf16_t* tb = wsb(p, O_TA2) + (size_t)r * 512 + lane * 8;
        const bf16_t* zz = wsb(p, O_P) + (size_t)r * PW + C_DNZ + lane * 8;
        u32x4 a = *(const u32x4*)ta, b = *(const u32x4*)tb, z = *(const u32x4*)zz;
        float o[8]; float ss = 0.f;
#pragma unroll
        for (int i = 0; i < 4; ++i) { o[2 * i] = lo16(a[i]) + lo16(b[i]); o[2 * i + 1] = hi16(a[i]) + hi16(b[i]); ss += o[2 * i] * o[2 * i] + o[2 * i + 1] * o[2 * i + 1]; }
#pragma unroll
        for (int of = 8; of >= 1; of >>= 1) ss += __shfl_xor(ss, of);
        const float rstd = rsqrtf(ss * (1.f / 128.f) + 1e-6f);
        const int dv0 = (lane & 15) * 8;
        u32x4 y;
#pragma unroll
        for (int i = 0; i < 4; ++i) {
            float y0 = o[2 * i] * rstd * dnn[dv0 + 2 * i] * silu(lo16(z[i]));
            float y1 = o[2 * i + 1] * rstd * dnn[dv0 + 2 * i + 1] * silu(hi16(z[i]));
            y[i] = pack2(y0, y1);
        }
        *(u32x4*)ta = y;
    }
}
DEV void phase_final(const Params& p) {
    const int tid_ = get_tid(); const int lane = tid_ & 63, wv = tid_ >> 6;
    const float* nw = p.in[I_NFIN];
    for (int r = blockIdx.x * 4 + wv; r < NB * SEQ; r += gridDim.x * 4) {
        float* h = p.out + (size_t)r * D;
        float4 v[4]; float ss = 0.f;
#pragma unroll
        for (int i = 0; i < 4; ++i) { v[i] = *(const float4*)(h + i * 256 + lane * 4); ss += v[i].x * v[i].x + v[i].y * v[i].y + v[i].z * v[i].z + v[i].w * v[i].w; }
#pragma unroll
        for (int o = 32; o >= 1; o >>= 1) ss += __shfl_xor(ss, o);
        const float rstd = rsqrtf(ss * (1.f / D) + 1e-6f);
#pragma unroll
        for (int i = 0; i < 4; ++i) {
            const int c = i * 256 + lane * 4;
            float4 w4 = *(const float4*)(nw + c);
            float4 o4; o4.x = v[i].x * rstd * w4.x; o4.y = v[i].y * rstd * w4.y; o4.z = v[i].z * rstd * w4.z; o4.w = v[i].w * rstd * w4.w;
            *(float4*)(h + c) = o4;
        }
    }
}

struct TileIter {
    int nn, total, nloc, L;
    DEV TileIter(int nm, int nn_) { nn = nn_; total = nm * nn_; nloc = gridDim.x >> 3; L = (blockIdx.x & 7) * nloc + (blockIdx.x >> 3); }
    DEV bool valid() const { return L < total; }
    DEV bool more() const { return (L - (int)(blockIdx.x >> 3)) < total; }
    DEV void next() { L += 8 * nloc; }
    DEV void get(int& tm, int& tn) const { const int pn = 4 * nn, panel = L / pn, rem = L - panel * pn; tn = rem >> 2; tm = panel * 4 + (rem & 3); }
};
DEV void phase_g1(const Params& p, unsigned char* smem) {
    bf16_t* sA = (bf16_t*)smem;
    const int tid = get_tid(), lane = tid & 63, wv = tid >> 6, wr = wv >> 1, wc = wv & 1, l15 = lane & 15, quad = lane >> 4;
    const bf16_t* U = wsb(p, O_U); const bf16_t* W = wsb(p, O_WT) + W_IN;
    bf16_t* P = wsb(p, O_P);
    const float* rope = wsf(p, O_ROPE);
    constexpr int NTN = NIN / 128;
    for (TileIter ti(MR / 256, NTN); ti.valid(); ti.next()) {
        int tm, tn; ti.get(tm, tn);
        const int row0 = tm * 256, col0 = tn * 128;
        f32x4 acc[8][4]; zero_acc(acc);
        gemm_core<8, 4>(U + (size_t)row0 * D, D, W + (size_t)col0 * D, D, D, acc, sA);
        if (tn < 24) {
#pragma unroll
            for (int mt = 0; mt < 8; ++mt)
#pragma unroll
                for (int nt = 0; nt < 4; ++nt)
#pragma unroll
                    for (int j = 0; j < 4; ++j) {
                        if (nt == 0 && j == 0) __builtin_amdgcn_sched_barrier(0);
                        const int row = row0 + wr * 128 + mt * 16 + quad * 4 + j, col = col0 + wc * 64 + nt * 16 + l15;
                        P[(size_t)row * PW + col] = f2bf(acc[mt][nt][j]);
                    }
        } else if (tn < 32) {
            const float qs = tn < 28 ? 0.125f : 1.f;
#pragma unroll
            for (int mt = 0; mt < 8; ++mt)
#pragma unroll
                for (int j = 0; j < 4; ++j) {
                    if (j == 0) __builtin_amdgcn_sched_barrier(0);
                    const int row = row0 + wr * 128 + mt * 16 + quad * 4 + j;
                    const int s = row % SB;
                    float c0 = 1.f, s0 = 0.f, c1 = 1.f, s1 = 0.f;
                    if (s >= CTXL) { const int tt = s - CTXL, pr = tt >> 6, pc = tt & 63;
                        c0 = rope[(pr * 16 + l15) * 2]; s0 = rope[(pr * 16 + l15) * 2 + 1]; c1 = rope[(pc * 16 + l15) * 2]; s1 = rope[(pc * 16 + l15) * 2 + 1]; }
                    const float x1 = acc[mt][0][j], x2 = acc[mt][1][j], y1 = acc[mt][2][j], y2 = acc[mt][3][j];
                    bf16_t* pp = P + (size_t)row * PW + col0 + wc * 64 + l15;
                    pp[0] = f2bf((x1 * c0 - x2 * s0) * qs);
                    pp[16] = f2bf((x2 * c0 + x1 * s0) * qs);
                    pp[32] = f2bf((y1 * c1 - y2 * s1) * qs);
                    pp[48] = f2bf((y2 * c1 + y1 * s1) * qs);
                }
        } else if (tn < 36) {
            bf16_t* VT = wsb(p, O_VT);
            const int b = row0 / SB, sbase = row0 - b * SB;
#pragma unroll
            for (int mt = 0; mt < 8; ++mt)
#pragma unroll
                for (int nt = 0; nt < 4; ++nt) {
                    if (nt == 0) __builtin_amdgcn_sched_barrier(0);
                    const int cc = col0 - 4096 + wc * 64 + nt * 16 + l15;
                    const int s = sbase + wr * 128 + mt * 16 + quad * 4;
                    u32x2 o; o.x = pack2(acc[mt][nt][0], acc[mt][nt][1]); o.y = pack2(acc[mt][nt][2], acc[mt][nt][3]);
                    *(u32x2*)(VT + ((size_t)(b * 512 + cc)) * SB + s) = o;
                }
        } else {
            if (wc == 0) {
                float* AB = wsf(p, O_AB);
#pragma unroll
                for (int mt = 0; mt < 8; ++mt)
#pragma unroll
                    for (int j = 0; j < 4; ++j) {
                        const int row = row0 + wr * 128 + mt * 16 + quad * 4 + j;
                        AB[(size_t)row * 16 + l15] = acc[mt][0][j];
                    }
            }
        }
    }
}

DEV int rowtile0(int ti, bool latent_only) { if (!latent_only) return ti * 256; int b = ti >> 4, tt = ti & 15; return b * SB + CTXL + tt * 256; }
DEV int sgcol(int n, int c) { return n < 2 ? n * 1024 + c : (c < 512 ? 2048 + c : 3584 + (c - 512)); }

DEV void phase_gate(const Params& p, bool latent_only, unsigned char* smem) {
    bf16_t* sA = (bf16_t*)smem;
    const int tid = get_tid(), lane = tid & 63, wv = tid >> 6, wr = wv >> 1, wc = wv & 1, l15 = lane & 15, quad = lane >> 4;
    const bf16_t* U = wsb(p, O_U); const bf16_t* W = wsb(p, O_WT) + W_GATE;
    bf16_t* P = wsb(p, O_P);
    const int nrt = latent_only ? 128 : 136;
    for (TileIter ti(nrt, 24); ti.valid(); ti.next()) {
        int tm, tn; ti.get(tm, tn);
        const int row0 = rowtile0(tm, latent_only);
        f32x4 acc[8][4]; zero_acc(acc);
        gemm_core<8, 4>(U + (size_t)row0 * D, D, W + (size_t)tn * 128 * D, D, D, acc, sA);
        const int dcol0 = sgcol(tn >> 3, (tn & 7) * 128);
#pragma unroll
        for (int mt = 0; mt < 8; ++mt)
#pragma unroll
            for (int nt = 0; nt < 4; ++nt)
#pragma unroll
                for (int j = 0; j < 4; ++j) {
                    if (nt == 0 && j == 0) __builtin_amdgcn_sched_barrier(0);
                    const int row = row0 + wr * 128 + mt * 16 + quad * 4 + j, col = dcol0 + wc * 64 + nt * 16 + l15;
                    P[(size_t)row * PW + col] = f2bf(sigm(acc[mt][nt][j]));
                }
    }
}

DEV void phase_merge(const Params& p, bool latent_only, unsigned char* smem) {
    bf16_t* sA = (bf16_t*)smem;
    const int tid = get_tid(), lane = tid & 63, wv = tid >> 6, wr = wv >> 1, wc = wv & 1, l15 = lane & 15, quad = lane >> 4;
    const bf16_t* W = wsb(p, O_WT);
    const bf16_t* P = wsb(p, O_P);
    bf16_t* U = wsb(p, O_U);
    const int nrt = latent_only ? 128 : 136;
    for (TileIter ti(nrt, 8); ti.valid(); ti.next()) {
        int tm, tn; ti.get(tm, tn);
        const int row0 = rowtile0(tm, latent_only), col0 = tn * 128;
        f32x4 m[8][4]; zero_acc(m);
#pragma unroll 1
        for (int n = 0; n < 3; ++n) {
            f32x4 au[8][4]; zero_acc(au);
            const bf16_t* Y; int ldy;
            if (n == 0) { Y = wsb(p, O_TA) + (size_t)row0 * 512; ldy = 512; }
            else if (n == 1) { Y = P + (size_t)row0 * PW + C_LG; ldy = PW; }
            else { Y = P + (size_t)row0 * PW + C_DAQ; ldy = PW; }
            gemm_core1<8, 4>(Y, ldy, W + W_BR + ((size_t)n * 1024 + col0) * 512, 512, 512, au, sA, sA + 256 * GLD);
            const int sc0 = sgcol(n, col0);
#pragma unroll
            for (int mt = 0; mt < 8; ++mt)
#pragma unroll
                for (int nt = 0; nt < 4; ++nt)
#pragma unroll
                    for (int j = 0; j < 4; ++j) {
                        if (nt == 0 && j == 0) __builtin_amdgcn_sched_barrier(0);
                        const int row = row0 + wr * 128 + mt * 16 + quad * 4 + j, col = sc0 + wc * 64 + nt * 16 + l15;
                        m[mt][nt][j] += bf2f(P[(size_t)row * PW + col]) * au[mt][nt][j];
                    }
        }
#pragma unroll
        for (int mt = 0; mt < 8; ++mt)
#pragma unroll
            for (int nt = 0; nt < 4; ++nt)
#pragma unroll
                for (int j = 0; j < 4; ++j) {
                    if (nt == 0 && j == 0) __builtin_amdgcn_sched_barrier(0);
                    const int row = row0 + wr * 128 + mt * 16 + quad * 4 + j, col = col0 + wc * 64 + nt * 16 + l15;
                    U[(size_t)row * D + col] = f2bf(m[mt][nt][j]);
                }
    }
}

DEV void phase_resid(const Params& p, int l, const bf16_t* A, int lda, const bf16_t* Wt, int K, int chunk, bool first, bool latent_only, unsigned char* smem) {
    bf16_t* sA = (bf16_t*)smem;
    const int tid = get_tid(), lane = tid & 63, wv = tid >> 6, wr = wv >> 1, wc = wv & 1, l15 = lane & 15, quad = lane >> 4;
    const int nrt = latent_only ? 128 : 136;
    for (TileIter ti(nrt, 8); ti.valid(); ti.next()) {
        int tm, tn; ti.get(tm, tn);
        const int row0 = rowtile0(tm, latent_only), col0 = tn * 128;
        f32x4 acc[8][4]; zero_acc(acc);
        gemm_core<8, 4>(A + (size_t)row0 * lda, lda, Wt + (size_t)col0 * K, K, K, acc, sA);
        const float* md = wsf(p, O_MOD) + ((size_t)l * 9 + modrow(row0)) * 6144 + chunk * D;
#pragma unroll
        for (int mt = 0; mt < 8; ++mt)
#pragma unroll
            for (int j = 0; j < 4; ++j) {
                if (j == 0) __builtin_amdgcn_sched_barrier(0);
                const int row = row0 + wr * 128 + mt * 16 + quad * 4 + j;
                const float* hs = first ? xrow(p, row) : hrow(p, row);
                float* hd = hrow(p, row);
#pragma unroll
                for (int nt = 0; nt < 4; ++nt) { const int col = col0 + wc * 64 + nt * 16 + l15; hd[col] = hs[col] + md[col] * acc[mt][nt][j]; }
            }
    }
}
DEV void phase_gu(const Params& p, bool latent_only, unsigned char* smem) {
    bf16_t* sA = (bf16_t*)smem;
    const int tid = get_tid(), lane = tid & 63, wv = tid >> 6, wr = wv >> 1, wc = wv & 1, l15 = lane & 15, quad = lane >> 4;
    const bf16_t* U = wsb(p, O_U); const bf16_t* W = wsb(p, O_WT) + W_GU;
    bf16_t* P = wsb(p, O_P);
    const int nrt = latent_only ? 128 : 136;
    for (TileIter ti(nrt, 44); ti.valid(); ti.next()) {
        int tm, tn; ti.get(tm, tn);
        const int row0 = rowtile0(tm, latent_only);
        f32x4 acc[8][4]; zero_acc(acc);
        gemm_core<8, 4>(U + (size_t)row0 * D, D, W + (size_t)tn * 128 * D, D, D, acc, sA);
#pragma unroll
        for (int mt = 0; mt < 8; ++mt)
#pragma unroll
            for (int pr = 0; pr < 2; ++pr)
#pragma unroll
                for (int j = 0; j < 4; ++j) {
                    if (pr == 0 && j == 0) __builtin_amdgcn_sched_barrier(0);
                    const int row = row0 + wr * 128 + mt * 16 + quad * 4 + j, hc = (tn * 4 + wc * 2 + pr) * 16 + l15;
                    P[(size_t)row * PW + hc] = f2bf(silu(acc[mt][2 * pr][j]) * acc[mt][2 * pr + 1][j]);
                }
    }
}

DEV int chunk_of(int dir, int n) { return dir ? (n < 4 ? 3 - n : 71 - n) : n; }

DEV void dn_solve(const float* __restrict__ Lt_s, const bf16_t* __restrict__ colp, const float* __restrict__ mulp, const float sg, bf16_t* __restrict__ outp) {
    float x0, x1, x2, x3, x4, x5, x6, x7, x8, x9, x10, x11, x12, x13, x14, x15, x16, x17, x18, x19, x20, x21, x22, x23, x24, x25, x26, x27, x28, x29, x30, x31, x32, x33, x34, x35, x36, x37, x38, x39, x40, x41, x42, x43, x44, x45, x46, x47, x48, x49, x50, x51, x52, x53, x54, x55, x56, x57, x58, x59, x60, x61, x62, x63;
    f32x4 La0, La1, La2, La3, La4, La5, La6, La7, La8, La9, La10, La11, La12, La13, La14, La15, Lb0, Lb1, Lb2, Lb3, Lb4, Lb5, Lb6, Lb7, Lb8, Lb9, Lb10, Lb11, Lb12, Lb13, Lb14, Lb15;
    x0 = bf2f(colp[0]) * mulp[0];
    x1 = bf2f(colp[136]) * mulp[1];
    x2 = bf2f(colp[272]) * mulp[2];
    x3 = bf2f(colp[408]) * mulp[3];
    x4 = bf2f(colp[544]) * mulp[4];
    x5 = bf2f(colp[680]) * mulp[5];
    x6 = bf2f(colp[816]) * mulp[6];
    x7 = bf2f(colp[952]) * mulp[7];
    x8 = bf2f(colp[1088]) * mulp[8];
    x9 = bf2f(colp[1224]) * mulp[9];
    x10 = bf2f(colp[1360]) * mulp[10];
    x11 = bf2f(colp[1496]) * mulp[11];
    x12 = bf2f(colp[1632]) * mulp[12];
    x13 = bf2f(colp[1768]) * mulp[13];
    x14 = bf2f(colp[1904]) * mulp[14];
    x15 = bf2f(colp[2040]) * mulp[15];
    x16 = bf2f(colp[2176]) * mulp[16];
    x17 = bf2f(colp[2312]) * mulp[17];
    x18 = bf2f(colp[2448]) * mulp[18];
    x19 = bf2f(colp[2584]) * mulp[19];
    x20 = bf2f(colp[2720]) * mulp[20];
    x21 = bf2f(colp[2856]) * mulp[21];
    x22 = bf2f(colp[2992]) * mulp[22];
    x23 = bf2f(colp[3128]) * mulp[23];
    x24 = bf2f(colp[3264]) * mulp[24];
    x25 = bf2f(colp[3400]) * mulp[25];
    x26 = bf2f(colp[3536]) * mulp[26];
    x27 = bf2f(colp[3672]) * mulp[27];
    x28 = bf2f(colp[3808]) * mulp[28];
    x29 = bf2f(colp[3944]) * mulp[29];
    x30 = bf2f(colp[4080]) * mulp[30];
    x31 = bf2f(colp[4216]) * mulp[31];
    x32 = bf2f(colp[4352]) * mulp[32];
    x33 = bf2f(colp[4488]) * mulp[33];
    x34 = bf2f(colp[4624]) * mulp[34];
    x35 = bf2f(colp[4760]) * mulp[35];
    x36 = bf2f(colp[4896]) * mulp[36];
    x37 = bf2f(colp[5032]) * mulp[37];
    x38 = bf2f(colp[5168]) * mulp[38];
    x39 = bf2f(colp[5304]) * mulp[39];
    x40 = bf2f(colp[5440]) * mulp[40];
    x41 = bf2f(colp[5576]) * mulp[41];
    x42 = bf2f(colp[5712]) * mulp[42];
    x43 = bf2f(colp[5848]) * mulp[43];
    x44 = bf2f(colp[5984]) * mulp[44];
    x45 = bf2f(colp[6120]) * mulp[45];
    x46 = bf2f(colp[6256]) * mulp[46];
    x47 = bf2f(colp[6392]) * mulp[47];
    x48 = bf2f(colp[6528]) * mulp[48];
    x49 = bf2f(colp[6664]) * mulp[49];
    x50 = bf2f(colp[6800]) * mulp[50];
    x51 = bf2f(colp[6936]) * mulp[51];
    x52 = bf2f(colp[7072]) * mulp[52];
    x53 = bf2f(colp[7208]) * mulp[53];
    x54 = bf2f(colp[7344]) * mulp[54];
    x55 = bf2f(colp[7480]) * mulp[55];
    x56 = bf2f(colp[7616]) * mulp[56];
    x57 = bf2f(colp[7752]) * mulp[57];
    x58 = bf2f(colp[7888]) * mulp[58];
    x59 = bf2f(colp[8024]) * mulp[59];
    x60 = bf2f(colp[8160]) * mulp[60];
    x61 = bf2f(colp[8296]) * mulp[61];
    x62 = bf2f(colp[8432]) * mulp[62];
    x63 = bf2f(colp[8568]) * mulp[63];
    La0 = *(const f32x4*)(Lt_s + 0);
    La1 = *(const f32x4*)(Lt_s + 4);
    La2 = *(const f32x4*)(Lt_s + 8);
    La3 = *(const f32x4*)(Lt_s + 12);
    La4 = *(const f32x4*)(Lt_s + 16);
    La5 = *(const f32x4*)(Lt_s + 20);
    La6 = *(const f32x4*)(Lt_s + 24);
    La7 = *(const f32x4*)(Lt_s + 28);
    La8 = *(const f32x4*)(Lt_s + 32);
    La9 = *(const f32x4*)(Lt_s + 36);
    La10 = *(const f32x4*)(Lt_s + 40);
    La11 = *(const f32x4*)(Lt_s + 44);
    La12 = *(const f32x4*)(Lt_s + 48);
    La13 = *(const f32x4*)(Lt_s + 52);
    La14 = *(const f32x4*)(Lt_s + 56);
    La15 = *(const f32x4*)(Lt_s + 60);
    Lb0 = *(const f32x4*)(Lt_s + 68);
    Lb1 = *(const f32x4*)(Lt_s + 72);
    Lb2 = *(const f32x4*)(Lt_s + 76);
    Lb3 = *(const f32x4*)(Lt_s + 80);
    Lb4 = *(const f32x4*)(Lt_s + 84);
    Lb5 = *(const f32x4*)(Lt_s + 88);
    Lb6 = *(const f32x4*)(Lt_s + 92);
    Lb7 = *(const f32x4*)(Lt_s + 96);
    Lb8 = *(const f32x4*)(Lt_s + 100);
    Lb9 = *(const f32x4*)(Lt_s + 104);
    Lb10 = *(const f32x4*)(Lt_s + 108);
    Lb11 = *(const f32x4*)(Lt_s + 112);
    Lb12 = *(const f32x4*)(Lt_s + 116);
    Lb13 = *(const f32x4*)(Lt_s + 120);
    Lb14 = *(const f32x4*)(Lt_s + 124);
    Lb15 = *(const f32x4*)(Lt_s + 128);
    __builtin_amdgcn_sched_barrier(0);
    x1 -= La0[1] * x0;
    x2 -= La0[2] * x0;
    x3 -= La0[3] * x0;
    x4 -= La1[0] * x0;
    x5 -= La1[1] * x0;
    x6 -= La1[2] * x0;
    x7 -= La1[3] * x0;
    x8 -= La2[0] * x0;
    x9 -= La2[1] * x0;
    x10 -= La2[2] * x0;
    x11 -= La2[3] * x0;
    x12 -= La3[0] * x0;
    x13 -= La3[1] * x0;
    x14 -= La3[2] * x0;
    x15 -= La3[3] * x0;
    x16 -= La4[0] * x0;
    x17 -= La4[1] * x0;
    x18 -= La4[2] * x0;
    x19 -= La4[3] * x0;
    x20 -= La5[0] * x0;
    x21 -= La5[1] * x0;
    x22 -= La5[2] * x0;
    x23 -= La5[3] * x0;
    x24 -= La6[0] * x0;
    x25 -= La6[1] * x0;
    x26 -= La6[2] * x0;
    x27 -= La6[3] * x0;
    x28 -= La7[0] * x0;
    x29 -= La7[1] * x0;
    x30 -= La7[2] * x0;
    x31 -= La7[3] * x0;
    x32 -= La8[0] * x0;
    x33 -= La8[1] * x0;
    x34 -= La8[2] * x0;
    x35 -= La8[3] * x0;
    x36 -= La9[0] * x0;
    x37 -= La9[1] * x0;
    x38 -= La9[2] * x0;
    x39 -= La9[3] * x0;
    x40 -= La10[0] * x0;
    x41 -= La10[1] * x0;
    x42 -= La10[2] * x0;
    x43 -= La10[3] * x0;
    x44 -= La11[0] * x0;
    x45 -= La11[1] * x0;
    x46 -= La11[2] * x0;
    x47 -= La11[3] * x0;
    x48 -= La12[0] * x0;
    x49 -= La12[1] * x0;
    x50 -= La12[2] * x0;
    x51 -= La12[3] * x0;
    x52 -= La13[0] * x0;
    x53 -= La13[1] * x0;
    x54 -= La13[2] * x0;
    x55 -= La13[3] * x0;
    x56 -= La14[0] * x0;
    x57 -= La14[1] * x0;
    x58 -= La14[2] * x0;
    x59 -= La14[3] * x0;
    x60 -= La15[0] * x0;
    x61 -= La15[1] * x0;
    x62 -= La15[2] * x0;
    x63 -= La15[3] * x0;
    __builtin_amdgcn_sched_barrier(0);
    La0 = *(const f32x4*)(Lt_s + 136);
    La1 = *(const f32x4*)(Lt_s + 140);
    La2 = *(const f32x4*)(Lt_s + 144);
    La3 = *(const f32x4*)(Lt_s + 148);
    La4 = *(const f32x4*)(Lt_s + 152);
    La5 = *(const f32x4*)(Lt_s + 156);
    La6 = *(const f32x4*)(Lt_s + 160);
    La7 = *(const f32x4*)(Lt_s + 164);
    La8 = *(const f32x4*)(Lt_s + 168);
    La9 = *(const f32x4*)(Lt_s + 172);
    La10 = *(const f32x4*)(Lt_s + 176);
    La11 = *(const f32x4*)(Lt_s + 180);
    La12 = *(const f32x4*)(Lt_s + 184);
    La13 = *(const f32x4*)(Lt_s + 188);
    La14 = *(const f32x4*)(Lt_s + 192);
    La15 = *(const f32x4*)(Lt_s + 196);
    __builtin_amdgcn_sched_barrier(0);
    x2 -= Lb0[2] * x1;
    x3 -= Lb0[3] * x1;
    x4 -= Lb1[0] * x1;
    x5 -= Lb1[1] * x1;
    x6 -= Lb1[2] * x1;
    x7 -= Lb1[3] * x1;
    x8 -= Lb2[0] * x1;
    x9 -= Lb2[1] * x1;
    x10 -= Lb2[2] * x1;
    x11 -= Lb2[3] * x1;
    x12 -= Lb3[0] * x1;
    x13 -= Lb3[1] * x1;
    x14 -= Lb3[2] * x1;
    x15 -= Lb3[3] * x1;
    x16 -= Lb4[0] * x1;
    x17 -= Lb4[1] * x1;
    x18 -= Lb4[2] * x1;
    x19 -= Lb4[3] * x1;
    x20 -= Lb5[0] * x1;
    x21 -= Lb5[1] * x1;
    x22 -= Lb5[2] * x1;
    x23 -= Lb5[3] * x1;
    x24 -= Lb6[0] * x1;
    x25 -= Lb6[1] * x1;
    x26 -= Lb6[2] * x1;
    x27 -= Lb6[3] * x1;
    x28 -= Lb7[0] * x1;
    x29 -= Lb7[1] * x1;
    x30 -= Lb7[2] * x1;
    x31 -= Lb7[3] * x1;
    x32 -= Lb8[0] * x1;
    x33 -= Lb8[1] * x1;
    x34 -= Lb8[2] * x1;
    x35 -= Lb8[3] * x1;
    x36 -= Lb9[0] * x1;
    x37 -= Lb9[1] * x1;
    x38 -= Lb9[2] * x1;
    x39 -= Lb9[3] * x1;
    x40 -= Lb10[0] * x1;
    x41 -= Lb10[1] * x1;
    x42 -= Lb10[2] * x1;
    x43 -= Lb10[3] * x1;
    x44 -= Lb11[0] * x1;
    x45 -= Lb11[1] * x1;
    x46 -= Lb11[2] * x1;
    x47 -= Lb11[3] * x1;
    x48 -= Lb12[0] * x1;
    x49 -= Lb12[1] * x1;
    x50 -= Lb12[2] * x1;
    x51 -= Lb12[3] * x1;
    x52 -= Lb13[0] * x1;
    x53 -= Lb13[1] * x1;
    x54 -= Lb13[2] * x1;
    x55 -= Lb13[3] * x1;
    x56 -= Lb14[0] * x1;
    x57 -= Lb14[1] * x1;
    x58 -= Lb14[2] * x1;
    x59 -= Lb14[3] * x1;
    x60 -= Lb15[0] * x1;
    x61 -= Lb15[1] * x1;
    x62 -= Lb15[2] * x1;
    x63 -= Lb15[3] * x1;
    __builtin_amdgcn_sched_barrier(0);
    Lb1 = *(const f32x4*)(Lt_s + 208);
    Lb2 = *(const f32x4*)(Lt_s + 212);
    Lb3 = *(const f32x4*)(Lt_s + 216);
    Lb4 = *(const f32x4*)(Lt_s + 220);
    Lb5 = *(const f32x4*)(Lt_s + 224);
    Lb6 = *(const f32x4*)(Lt_s + 228);
    Lb7 = *(const f32x4*)(Lt_s + 232);
    Lb8 = *(const f32x4*)(Lt_s + 236);
    Lb9 = *(const f32x4*)(Lt_s + 240);
    Lb10 = *(const f32x4*)(Lt_s + 244);
    Lb11 = *(const f32x4*)(Lt_s + 248);
    Lb12 = *(const f32x4*)(Lt_s + 252);
    Lb13 = *(const f32x4*)(Lt_s + 256);
    Lb14 = *(const f32x4*)(Lt_s + 260);
    Lb15 = *(const f32x4*)(Lt_s + 264);
    __builtin_amdgcn_sched_barrier(0);
    x3 -= La0[3] * x2;
    x4 -= La1[0] * x2;
    x5 -= La1[1] * x2;
    x6 -= La1[2] * x2;
    x7 -= La1[3] * x2;
    x8 -= La2[0] * x2;
    x9 -= La2[1] * x2;
    x10 -= La2[2] * x2;
    x11 -= La2[3] * x2;
    x12 -= La3[0] * x2;
    x13 -= La3[1] * x2;
    x14 -= La3[2] * x2;
    x15 -= La3[3] * x2;
    x16 -= La4[0] * x2;
    x17 -= La4[1] * x2;
    x18 -= La4[2] * x2;
    x19 -= La4[3] * x2;
    x20 -= La5[0] * x2;
    x21 -= La5[1] * x2;
    x22 -= La5[2] * x2;
    x23 -= La5[3] * x2;
    x24 -= La6[0] * x2;
    x25 -= La6[1] * x2;
    x26 -= La6[2] * x2;
    x27 -= La6[3] * x2;
    x28 -= La7[0] * x2;
    x29 -= La7[1] * x2;
    x30 -= La7[2] * x2;
    x31 -= La7[3] * x2;
    x32 -= La8[0] * x2;
    x33 -= La8[1] * x2;
    x34 -= La8[2] * x2;
    x35 -= La8[3] * x2;
    x36 -= La9[0] * x2;
    x37 -= La9[1] * x2;
    x38 -= La9[2] * x2;
    x39 -= La9[3] * x2;
    x40 -= La10[0] * x2;
    x41 -= La10[1] * x2;
    x42 -= La10[2] * x2;
    x43 -= La10[3] * x2;
    x44 -= La11[0] * x2;
    x45 -= La11[1] * x2;
    x46 -= La11[2] * x2;
    x47 -= La11[3] * x2;
    x48 -= La12[0] * x2;
    x49 -= La12[1] * x2;
    x50 -= La12[2] * x2;
    x51 -= La12[3] * x2;
    x52 -= La13[0] * x2;
    x53 -= La13[1] * x2;
    x54 -= La13[2] * x2;
    x55 -= La13[3] * x2;
    x56 -= La14[0] * x2;
    x57 -= La14[1] * x2;
    x58 -= La14[2] * x2;
    x59 -= La14[3] * x2;
    x60 -= La15[0] * x2;
    x61 -= La15[1] * x2;
    x62 -= La15[2] * x2;
    x63 -= La15[3] * x2;
    __builtin_amdgcn_sched_barrier(0);
    La1 = *(const f32x4*)(Lt_s + 276);
    La2 = *(const f32x4*)(Lt_s + 280);
    La3 = *(const f32x4*)(Lt_s + 284);
    La4 = *(const f32x4*)(Lt_s + 288);
    La5 = *(const f32x4*)(Lt_s + 292);
    La6 = *(const f32x4*)(Lt_s + 296);
    La7 = *(const f32x4*)(Lt_s + 300);
    La8 = *(const f32x4*)(Lt_s + 304);
    La9 = *(const f32x4*)(Lt_s + 308);
    La10 = *(const f32x4*)(Lt_s + 312);
    La11 = *(const f32x4*)(Lt_s + 316);
    La12 = *(const f32x4*)(Lt_s + 320);
    La13 = *(const f32x4*)(Lt_s + 324);
    La14 = *(const f32x4*)(Lt_s + 328);
    La15 = *(const f32x4*)(Lt_s + 332);
    __builtin_amdgcn_sched_barrier(0);
    x4 -= Lb1[0] * x3;
    x5 -= Lb1[1] * x3;
    x6 -= Lb1[2] * x3;
    x7 -= Lb1[3] * x3;
    x8 -= Lb2[0] * x3;
    x9 -= Lb2[1] * x3;
    x10 -= Lb2[2] * x3;
    x11 -= Lb2[3] * x3;
    x12 -= Lb3[0] * x3;
    x13 -= Lb3[1] * x3;
    x14 -= Lb3[2] * x3;
    x15 -= Lb3[3] * x3;
    x16 -= Lb4[0] * x3;
    x17 -= Lb4[1] * x3;
    x18 -= Lb4[2] * x3;
    x19 -= Lb4[3] * x3;
    x20 -= Lb5[0] * x3;
    x21 -= Lb5[1] * x3;
    x22 -= Lb5[2] * x3;
    x23 -= Lb5[3] * x3;
    x24 -= Lb6[0] * x3;
    x25 -= Lb6[1] * x3;
    x26 -= Lb6[2] * x3;
    x27 -= Lb6[3] * x3;
    x28 -= Lb7[0] * x3;
    x29 -= Lb7[1] * x3;
    x30 -= Lb7[2] * x3;
    x31 -= Lb7[3] * x3;
    x32 -= Lb8[0] * x3;
    x33 -= Lb8[1] * x3;
    x34 -= Lb8[2] * x3;
    x35 -= Lb8[3] * x3;
    x36 -= Lb9[0] * x3;
    x37 -= Lb9[1] * x3;
    x38 -= Lb9[2] * x3;
    x39 -= Lb9[3] * x3;
    x40 -= Lb10[0] * x3;
    x41 -= Lb10[1] * x3;
    x42 -= Lb10[2] * x3;
    x43 -= Lb10[3] * x3;
    x44 -= Lb11[0] * x3;
    x45 -= Lb11[1] * x3;
    x46 -= Lb11[2] * x3;
    x47 -= Lb11[3] * x3;
    x48 -= Lb12[0] * x3;
    x49 -= Lb12[1] * x3;
    x50 -= Lb12[2] * x3;
    x51 -= Lb12[3] * x3;
    x52 -= Lb13[0] * x3;
    x53 -= Lb13[1] * x3;
    x54 -= Lb13[2] * x3;
    x55 -= Lb13[3] * x3;
    x56 -= Lb14[0] * x3;
    x57 -= Lb14[1] * x3;
    x58 -= Lb14[2] * x3;
    x59 -= Lb14[3] * x3;
    x60 -= Lb15[0] * x3;
    x61 -= Lb15[1] * x3;
    x62 -= Lb15[2] * x3;
    x63 -= Lb15[3] * x3;
    __builtin_amdgcn_sched_barrier(0);
    Lb1 = *(const f32x4*)(Lt_s + 344);
    Lb2 = *(const f32x4*)(Lt_s + 348);
    Lb3 = *(const f32x4*)(Lt_s + 352);
    Lb4 = *(const f32x4*)(Lt_s + 356);
    Lb5 = *(const f32x4*)(Lt_s + 360);
    Lb6 = *(const f32x4*)(Lt_s + 364);
    Lb7 = *(const f32x4*)(Lt_s + 368);
    Lb8 = *(const f32x4*)(Lt_s + 372);
    Lb9 = *(const f32x4*)(Lt_s + 376);
    Lb10 = *(const f32x4*)(Lt_s + 380);
    Lb11 = *(const f32x4*)(Lt_s + 384);
    Lb12 = *(const f32x4*)(Lt_s + 388);
    Lb13 = *(const f32x4*)(Lt_s + 392);
    Lb14 = *(const f32x4*)(Lt_s + 396);
    Lb15 = *(const f32x4*)(Lt_s + 400);
    __builtin_amdgcn_sched_barrier(0);
    x5 -= La1[1] * x4;
    x6 -= La1[2] * x4;
    x7 -= La1[3] * x4;
    x8 -= La2[0] * x4;
    x9 -= La2[1] * x4;
    x10 -= La2[2] * x4;
    x11 -= La2[3] * x4;
    x12 -= La3[0] * x4;
    x13 -= La3[1] * x4;
    x14 -= La3[2] * x4;
    x15 -= La3[3] * x4;
    x16 -= La4[0] * x4;
    x17 -= La4[1] * x4;
    x18 -= La4[2] * x4;
    x19 -= La4[3] * x4;
    x20 -= La5[0] * x4;
    x21 -= La5[1] * x4;
    x22 -= La5[2] * x4;
    x23 -= La5[3] * x4;
    x24 -= La6[0] * x4;
    x25 -= La6[1] * x4;
    x26 -= La6[2] * x4;
    x27 -= La6[3] * x4;
    x28 -= La7[0] * x4;
    x29 -= La7[1] * x4;
    x30 -= La7[2] * x4;
    x31 -= La7[3] * x4;
    x32 -= La8[0] * x4;
    x33 -= La8[1] * x4;
    x34 -= La8[2] * x4;
    x35 -= La8[3] * x4;
    x36 -= La9[0] * x4;
    x37 -= La9[1] * x4;
    x38 -= La9[2] * x4;
    x39 -= La9[3] * x4;
    x40 -= La10[0] * x4;
    x41 -= La10[1] * x4;
    x42 -= La10[2] * x4;
    x43 -= La10[3] * x4;
    x44 -= La11[0] * x4;
    x45 -= La11[1] * x4;
    x46 -= La11[2] * x4;
    x47 -= La11[3] * x4;
    x48 -= La12[0] * x4;
    x49 -= La12[1] * x4;
    x50 -= La12[2] * x4;
    x51 -= La12[3] * x4;
    x52 -= La13[0] * x4;
    x53 -= La13[1] * x4;
    x54 -= La13[2] * x4;
    x55 -= La13[3] * x4;
    x56 -= La14[0] * x4;
    x57 -= La14[1] * x4;
    x58 -= La14[2] * x4;
    x59 -= La14[3] * x4;
    x60 -= La15[0] * x4;
    x61 -= La15[1] * x4;
    x62 -= La15[2] * x4;
    x63 -= La15[3] * x4;
    __builtin_amdgcn_sched_barrier(0);
    La1 = *(const f32x4*)(Lt_s + 412);
    La2 = *(const f32x4*)(Lt_s + 416);
    La3 = *(const f32x4*)(Lt_s + 420);
    La4 = *(const f32x4*)(Lt_s + 424);
    La5 = *(const f32x4*)(Lt_s + 428);
    La6 = *(const f32x4*)(Lt_s + 432);
    La7 = *(const f32x4*)(Lt_s + 436);
    La8 = *(const f32x4*)(Lt_s + 440);
    La9 = *(const f32x4*)(Lt_s + 444);
    La10 = *(const f32x4*)(Lt_s + 448);
    La11 = *(const f32x4*)(Lt_s + 452);
    La12 = *(const f32x4*)(Lt_s + 456);
    La13 = *(const f32x4*)(Lt_s + 460);
    La14 = *(const f32x4*)(Lt_s + 464);
    La15 = *(const f32x4*)(Lt_s + 468);
    __builtin_amdgcn_sched_barrier(0);
    x6 -= Lb1[2] * x5;
    x7 -= Lb1[3] * x5;
    x8 -= Lb2[0] * x5;
    x9 -= Lb2[1] * x5;
    x10 -= Lb2[2] * x5;
    x11 -= Lb2[3] * x5;
    x12 -= Lb3[0] * x5;
    x13 -= Lb3[1] * x5;
    x14 -= Lb3[2] * x5;
    x15 -= Lb3[3] * x5;
    x16 -= Lb4[0] * x5;
    x17 -= Lb4[1] * x5;
    x18 -= Lb4[2] * x5;
    x19 -= Lb4[3] * x5;
    x20 -= Lb5[0] * x5;
    x21 -= Lb5[1] * x5;
    x22 -= Lb5[2] * x5;
    x23 -= Lb5[3] * x5;
    x24 -= Lb6[0] * x5;
    x25 -= Lb6[1] * x5;
    x26 -= Lb6[2] * x5;
    x27 -= Lb6[3] * x5;
    x28 -= Lb7[0] * x5;
    x29 -= Lb7[1] * x5;
    x30 -= Lb7[2] * x5;
    x31 -= Lb7[3] * x5;
    x32 -= Lb8[0] * x5;
    x33 -= Lb8[1] * x5;
    x34 -= Lb8[2] * x5;
    x35 -= Lb8[3] * x5;
    x36 -= Lb9[0] * x5;
    x37 -= Lb9[1] * x5;
    x38 -= Lb9[2] * x5;
    x39 -= Lb9[3] * x5;
    x40 -= Lb10[0] * x5;
    x41 -= Lb10[1] * x5;
    x42 -= Lb10[2] * x5;
    x43 -= Lb10[3] * x5;
    x44 -= Lb11[0] * x5;
    x45 -= Lb11[1] * x5;
    x46 -= Lb11[2] * x5;
    x47 -= Lb11[3] * x5;
    x48 -= Lb12[0] * x5;
    x49 -= Lb12[1] * x5;
    x50 -= Lb12[2] * x5;
    x51 -= Lb12[3] * x5;
    x52 -= Lb13[0] * x5;
    x53 -= Lb13[1] * x5;
    x54 -= Lb13[2] * x5;
    x55 -= Lb13[3] * x5;
    x56 -= Lb14[0] * x5;
    x57 -= Lb14[1] * x5;
    x58 -= Lb14[2] * x5;
    x59 -= Lb14[3] * x5;
    x60 -= Lb15[0] * x5;
    x61 -= Lb15[1] * x5;
    x62 -= Lb15[2] * x5;
    x63 -= Lb15[3] * x5;
    __builtin_amdgcn_sched_barrier(0);
    Lb2 = *(const f32x4*)(Lt_s + 484);
    Lb3 = *(const f32x4*)(Lt_s + 488);
    Lb4 = *(const f32x4*)(Lt_s + 492);
    Lb5 = *(const f32x4*)(Lt_s + 496);
    Lb6 = *(const f32x4*)(Lt_s + 500);
    Lb7 = *(const f32x4*)(Lt_s + 504);
    Lb8 = *(const f32x4*)(Lt_s + 508);
    Lb9 = *(const f32x4*)(Lt_s + 512);
    Lb10 = *(const f32x4*)(Lt_s + 516);
    Lb11 = *(const f32x4*)(Lt_s + 520);
    Lb12 = *(const f32x4*)(Lt_s + 524);
    Lb13 = *(const f32x4*)(Lt_s + 528);
    Lb14 = *(const f32x4*)(Lt_s + 532);
    Lb15 = *(const f32x4*)(Lt_s + 536);
    __builtin_amdgcn_sched_barrier(0);
    x7 -= La1[3] * x6;
    x8 -= La2[0] * x6;
    x9 -= La2[1] * x6;
    x10 -= La2[2] * x6;
    x11 -= La2[3] * x6;
    x12 -= La3[0] * x6;
    x13 -= La3[1] * x6;
    x14 -= La3[2] * x6;
    x15 -= La3[3] * x6;
    x16 -= La4[0] * x6;
    x17 -= La4[1] * x6;
    x18 -= La4[2] * x6;
    x19 -= La4[3] * x6;
    x20 -= La5[0] * x6;
    x21 -= La5[1] * x6;
    x22 -= La5[2] * x6;
    x23 -= La5[3] * x6;
    x24 -= La6[0] * x6;
    x25 -= La6[1] * x6;
    x26 -= La6[2] * x6;
    x27 -= La6[3] * x6;
    x28 -= La7[0] * x6;
    x29 -= La7[1] * x6;
    x30 -= La7[2] * x6;
    x31 -= La7[3] * x6;
    x32 -= La8[0] * x6;
    x33 -= La8[1] * x6;
    x34 -= La8[2] * x6;
    x35 -= La8[3] * x6;
    x36 -= La9[0] * x6;
    x37 -= La9[1] * x6;
    x38 -= La9[2] * x6;
    x39 -= La9[3] * x6;
    x40 -= La10[0] * x6;
    x41 -= La10[1] * x6;
    x42 -= La10[2] * x6;
    x43 -= La10[3] * x6;
    x44 -= La11[0] * x6;
    x45 -= La11[1] * x6;
    x46 -= La11[2] * x6;
    x47 -= La11[3] * x6;
    x48 -= La12[0] * x6;
    x49 -= La12[1] * x6;
    x50 -= La12[2] * x6;
    x51 -= La12[3] * x6;
    x52 -= La13[0] * x6;
    x53 -= La13[1] * x6;
    x54 -= La13[2] * x6;
    x55 -= La13[3] * x6;
    x56 -= La14[0] * x6;
    x57 -= La14[1] * x6;
    x58 -= La14[2] * x6;
    x59 -= La14[3] * x6;
    x60 -= La15[0] * x6;
    x61 -= La15[1] * x6;
    x62 -= La15[2] * x6;
    x63 -= La15[3] * x6;
    __builtin_amdgcn_sched_barrier(0);
    La2 = *(const f32x4*)(Lt_s + 552);
    La3 = *(const f32x4*)(Lt_s + 556);
    La4 = *(const f32x4*)(Lt_s + 560);
    La5 = *(const f32x4*)(Lt_s + 564);
    La6 = *(const f32x4*)(Lt_s + 568);
    La7 = *(const f32x4*)(Lt_s + 572);
    La8 = *(const f32x4*)(Lt_s + 576);
    La9 = *(const f32x4*)(Lt_s + 580);
    La10 = *(const f32x4*)(Lt_s + 584);
    La11 = *(const f32x4*)(Lt_s + 588);
    La12 = *(const f32x4*)(Lt_s + 592);
    La13 = *(const f32x4*)(Lt_s + 596);
    La14 = *(const f32x4*)(Lt_s + 600);
    La15 = *(const f32x4*)(Lt_s + 604);
    __builtin_amdgcn_sched_barrier(0);
    x8 -= Lb2[0] * x7;
    x9 -= Lb2[1] * x7;
    x10 -= Lb2[2] * x7;
    x11 -= Lb2[3] * x7;
    x12 -= Lb3[0] * x7;
    x13 -= Lb3[1] * x7;
    x14 -= Lb3[2] * x7;
    x15 -= Lb3[3] * x7;
    x16 -= Lb4[0] * x7;
    x17 -= Lb4[1] * x7;
    x18 -= Lb4[2] * x7;
    x19 -= Lb4[3] * x7;
    x20 -= Lb5[0] * x7;
    x21 -= Lb5[1] * x7;
    x22 -= Lb5[2] * x7;
    x23 -= Lb5[3] * x7;
    x24 -= Lb6[0] * x7;
    x25 -= Lb6[1] * x7;
    x26 -= Lb6[2] * x7;
    x27 -= Lb6[3] * x7;
    x28 -= Lb7[0] * x7;
    x29 -= Lb7[1] * x7;
    x30 -= Lb7[2] * x7;
    x31 -= Lb7[3] * x7;
    x32 -= Lb8[0] * x7;
    x33 -= Lb8[1] * x7;
    x34 -= Lb8[2] * x7;
    x35 -= Lb8[3] * x7;
    x36 -= Lb9[0] * x7;
    x37 -= Lb9[1] * x7;
    x38 -= Lb9[2] * x7;
    x39 -= Lb9[3] * x7;
    x40 -= Lb10[0] * x7;
    x41 -= Lb10[1] * x7;
    x42 -= Lb10[2] * x7;
    x43 -= Lb10[3] * x7;
    x44 -= Lb11[0] * x7;
    x45 -= Lb11[1] * x7;
    x46 -= Lb11[2] * x7;
    x47 -= Lb11[3] * x7;
    x48 -= Lb12[0] * x7;
    x49 -= Lb12[1] * x7;
    x50 -= Lb12[2] * x7;
    x51 -= Lb12[3] * x7;
    x52 -= Lb13[0] * x7;
    x53 -= Lb13[1] * x7;
    x54 -= Lb13[2] * x7;
    x55 -= Lb13[3] * x7;
    x56 -= Lb14[0] * x7;
    x57 -= Lb14[1] * x7;
    x58 -= Lb14[2] * x7;
    x59 -= Lb14[3] * x7;
    x60 -= Lb15[0] * x7;
    x61 -= Lb15[1] * x7;
    x62 -= Lb15[2] * x7;
    x63 -= Lb15[3] * x7;
    __builtin_amdgcn_sched_barrier(0);
    Lb2 = *(const f32x4*)(Lt_s + 620);
    Lb3 = *(const f32x4*)(Lt_s + 624);
    Lb4 = *(const f32x4*)(Lt_s + 628);
    Lb5 = *(const f32x4*)(Lt_s + 632);
    Lb6 = *(const f32x4*)(Lt_s + 636);
    Lb7 = *(const f32x4*)(Lt_s + 640);
    Lb8 = *(const f32x4*)(Lt_s + 644);
    Lb9 = *(const f32x4*)(Lt_s + 648);
    Lb10 = *(const f32x4*)(Lt_s + 652);
    Lb11 = *(const f32x4*)(Lt_s + 656);
    Lb12 = *(const f32x4*)(Lt_s + 660);
    Lb13 = *(const f32x4*)(Lt_s + 664);
    Lb14 = *(const f32x4*)(Lt_s + 668);
    Lb15 = *(const f32x4*)(Lt_s + 672);
    __builtin_amdgcn_sched_barrier(0);
    x9 -= La2[1] * x8;
    x10 -= La2[2] * x8;
    x11 -= La2[3] * x8;
    x12 -= La3[0] * x8;
    x13 -= La3[1] * x8;
    x14 -= La3[2] * x8;
    x15 -= La3[3] * x8;
    x16 -= La4[0] * x8;
    x17 -= La4[1] * x8;
    x18 -= La4[2] * x8;
    x19 -= La4[3] * x8;
    x20 -= La5[0] * x8;
    x21 -= La5[1] * x8;
    x22 -= La5[2] * x8;
    x23 -= La5[3] * x8;
    x24 -= La6[0] * x8;
    x25 -= La6[1] * x8;
    x26 -= La6[2] * x8;
    x27 -= La6[3] * x8;
    x28 -= La7[0] * x8;
    x29 -= La7[1] * x8;
    x30 -= La7[2] * x8;
    x31 -= La7[3] * x8;
    x32 -= La8[0] * x8;
    x33 -= La8[1] * x8;
    x34 -= La8[2] * x8;
    x35 -= La8[3] * x8;
    x36 -= La9[0] * x8;
    x37 -= La9[1] * x8;
    x38 -= La9[2] * x8;
    x39 -= La9[3] * x8;
    x40 -= La10[0] * x8;
    x41 -= La10[1] * x8;
    x42 -= La10[2] * x8;
    x43 -= La10[3] * x8;
    x44 -= La11[0] * x8;
    x45 -= La11[1] * x8;
    x46 -= La11[2] * x8;
    x47 -= La11[3] * x8;
    x48 -= La12[0] * x8;
    x49 -= La12[1] * x8;
    x50 -= La12[2] * x8;
    x51 -= La12[3] * x8;
    x52 -= La13[0] * x8;
    x53 -= La13[1] * x8;
    x54 -= La13[2] * x8;
    x55 -= La13[3] * x8;
    x56 -= La14[0] * x8;
    x57 -= La14[1] * x8;
    x58 -= La14[2] * x8;
    x59 -= La14[3] * x8;
    x60 -= La15[0] * x8;
    x61 -= La15[1] * x8;
    x62 -= La15[2] * x8;
    x63 -= La15[3] * x8;
    __builtin_amdgcn_sched_barrier(0);
    La2 = *(const f32x4*)(Lt_s + 688);
    La3 = *(const f32x4*)(Lt_s + 692);
    La4 = *(const f32x4*)(Lt_s + 696);
    La5 = *(const f32x4*)(Lt_s + 700);
    La6 = *(const f32x4*)(Lt_s + 704);
    La7 = *(const f32x4*)(Lt_s + 708);
    La8 = *(const f32x4*)(Lt_s + 712);
    La9 = *(const f32x4*)(Lt_s + 716);
    La10 = *(const f32x4*)(Lt_s + 720);
    La11 = *(const f32x4*)(Lt_s + 724);
    La12 = *(const f32x4*)(Lt_s + 728);
    La13 = *(const f32x4*)(Lt_s + 732);
    La14 = *(const f32x4*)(Lt_s + 736);
    La15 = *(const f32x4*)(Lt_s + 740);
    __builtin_amdgcn_sched_barrier(0);
    x10 -= Lb2[2] * x9;
    x11 -= Lb2[3] * x9;
    x12 -= Lb3[0] * x9;
    x13 -= Lb3[1] * x9;
    x14 -= Lb3[2] * x9;
    x15 -= Lb3[3] * x9;
    x16 -= Lb4[0] * x9;
    x17 -= Lb4[1] * x9;
    x18 -= Lb4[2] * x9;
    x19 -= Lb4[3] * x9;
    x20 -= Lb5[0] * x9;
    x21 -= Lb5[1] * x9;
    x22 -= Lb5[2] * x9;
    x23 -= Lb5[3] * x9;
    x24 -= Lb6[0] * x9;
    x25 -= Lb6[1] * x9;
    x26 -= Lb6[2] * x9;
    x27 -= Lb6[3] * x9;
    x28 -= Lb7[0] * x9;
    x29 -= Lb7[1] * x9;
    x30 -= Lb7[2] * x9;
    x31 -= Lb7[3] * x9;
    x32 -= Lb8[0] * x9;
    x33 -= Lb8[1] * x9;
    x34 -= Lb8[2] * x9;
    x35 -= Lb8[3] * x9;
    x36 -= Lb9[0] * x9;
    x37 -= Lb9[1] * x9;
    x38 -= Lb9[2] * x9;
    x39 -= Lb9[3] * x9;
    x40 -= Lb10[0] * x9;
    x41 -= Lb10[1] * x9;
    x42 -= Lb10[2] * x9;
    x43 -= Lb10[3] * x9;
    x44 -= Lb11[0] * x9;
    x45 -= Lb11[1] * x9;
    x46 -= Lb11[2] * x9;
    x47 -= Lb11[3] * x9;
    x48 -= Lb12[0] * x9;
    x49 -= Lb12[1] * x9;
    x50 -= Lb12[2] * x9;
    x51 -= Lb12[3] * x9;
    x52 -= Lb13[0] * x9;
    x53 -= Lb13[1] * x9;
    x54 -= Lb13[2] * x9;
    x55 -= Lb13[3] * x9;
    x56 -= Lb14[0] * x9;
    x57 -= Lb14[1] * x9;
    x58 -= Lb14[2] * x9;
    x59 -= Lb14[3] * x9;
    x60 -= Lb15[0] * x9;
    x61 -= Lb15[1] * x9;
    x62 -= Lb15[2] * x9;
    x63 -= Lb15[3] * x9;
    __builtin_amdgcn_sched_barrier(0);
    Lb3 = *(const f32x4*)(Lt_s + 760);
    Lb4 = *(const f32x4*)(Lt_s + 764);
    Lb5 = *(const f32x4*)(Lt_s + 768);
    Lb6 = *(const f32x4*)(Lt_s + 772);
    Lb7 = *(const f32x4*)(Lt_s + 776);
    Lb8 = *(const f32x4*)(Lt_s + 780);
    Lb9 = *(const f32x4*)(Lt_s + 784);
    Lb10 = *(const f32x4*)(Lt_s + 788);
    Lb11 = *(const f32x4*)(Lt_s + 792);
    Lb12 = *(const f32x4*)(Lt_s + 796);
    Lb13 = *(const f32x4*)(Lt_s + 800);
    Lb14 = *(const f32x4*)(Lt_s + 804);
    Lb15 = *(const f32x4*)(Lt_s + 808);
    __builtin_amdgcn_sched_barrier(0);
    x11 -= La2[3] * x10;
    x12 -= La3[0] * x10;
    x13 -= La3[1] * x10;
    x14 -= La3[2] * x10;
    x15 -= La3[3] * x10;
    x16 -= La4[0] * x10;
    x17 -= La4[1] * x10;
    x18 -= La4[2] * x10;
    x19 -= La4[3] * x10;
    x20 -= La5[0] * x10;
    x21 -= La5[1] * x10;
    x22 -= La5[2] * x10;
    x23 -= La5[3] * x10;
    x24 -= La6[0] * x10;
    x25 -= La6[1] * x10;
    x26 -= La6[2] * x10;
    x27 -= La6[3] * x10;
    x28 -= La7[0] * x10;
    x29 -= La7[1] * x10;
    x30 -= La7[2] * x10;
    x31 -= La7[3] * x10;
    x32 -= La8[0] * x10;
    x33 -= La8[1] * x10;
    x34 -= La8[2] * x10;
    x35 -= La8[3] * x10;
    x36 -= La9[0] * x10;
    x37 -= La9[1] * x10;
    x38 -= La9[2] * x10;
    x39 -= La9[3] * x10;
    x40 -= La10[0] * x10;
    x41 -= La10[1] * x10;
    x42 -= La10[2] * x10;
    x43 -= La10[3] * x10;
    x44 -= La11[0] * x10;
    x45 -= La11[1] * x10;
    x46 -= La11[2] * x10;
    x47 -= La11[3] * x10;
    x48 -= La12[0] * x10;
    x49 -= La12[1] * x10;
    x50 -= La12[2] * x10;
    x51 -= La12[3] * x10;
    x52 -= La13[0] * x10;
    x53 -= La13[1] * x10;
    x54 -= La13[2] * x10;
    x55 -= La13[3] * x10;
    x56 -= La14[0] * x10;
    x57 -= La14[1] * x10;
    x58 -= La14[2] * x10;
    x59 -= La14[3] * x10;
    x60 -= La15[0] * x10;
    x61 -= La15[1] * x10;
    x62 -= La15[2] * x10;
    x63 -= La15[3] * x10;
    __builtin_amdgcn_sched_barrier(0);
    La3 = *(const f32x4*)(Lt_s + 828);
    La4 = *(const f32x4*)(Lt_s + 832);
    La5 = *(const f32x4*)(Lt_s + 836);
    La6 = *(const f32x4*)(Lt_s + 840);
    La7 = *(const f32x4*)(Lt_s + 844);
    La8 = *(const f32x4*)(Lt_s + 848);
    La9 = *(const f32x4*)(Lt_s + 852);
    La10 = *(const f32x4*)(Lt_s + 856);
    La11 = *(const f32x4*)(Lt_s + 860);
    La12 = *(const f32x4*)(Lt_s + 864);
    La13 = *(const f32x4*)(Lt_s + 868);
    La14 = *(const f32x4*)(Lt_s + 872);
    La15 = *(const f32x4*)(Lt_s + 876);
    __builtin_amdgcn_sched_barrier(0);
    x12 -= Lb3[0] * x11;
    x13 -= Lb3[1] * x11;
    x14 -= Lb3[2] * x11;
    x15 -= Lb3[3] * x11;
    x16 -= Lb4[0] * x11;
    x17 -= Lb4[1] * x11;
    x18 -= Lb4[2] * x11;
    x19 -= Lb4[3] * x11;
    x20 -= Lb5[0] * x11;
    x21 -= Lb5[1] * x11;
    x22 -= Lb5[2] * x11;
    x23 -= Lb5[3] * x11;
    x24 -= Lb6[0] * x11;
    x25 -= Lb6[1] * x11;
    x26 -= Lb6[2] * x11;
    x27 -= Lb6[3] * x11;
    x28 -= Lb7[0] * x11;
    x29 -= Lb7[1] * x11;
    x30 -= Lb7[2] * x11;
    x31 -= Lb7[3] * x11;
    x32 -= Lb8[0] * x11;
    x33 -= Lb8[1] * x11;
    x34 -= Lb8[2] * x11;
    x35 -= Lb8[3] * x11;
    x36 -= Lb9[0] * x11;
    x37 -= Lb9[1] * x11;
    x38 -= Lb9[2] * x11;
    x39 -= Lb9[3] * x11;
    x40 -= Lb10[0] * x11;
    x41 -= Lb10[1] * x11;
    x42 -= Lb10[2] * x11;
    x43 -= Lb10[3] * x11;
    x44 -= Lb11[0] * x11;
    x45 -= Lb11[1] * x11;
    x46 -= Lb11[2] * x11;
    x47 -= Lb11[3] * x11;
    x48 -= Lb12[0] * x11;
    x49 -= Lb12[1] * x11;
    x50 -= Lb12[2] * x11;
    x51 -= Lb12[3] * x11;
    x52 -= Lb13[0] * x11;
    x53 -= Lb13[1] * x11;
    x54 -= Lb13[2] * x11;
    x55 -= Lb13[3] * x11;
    x56 -= Lb14[0] * x11;
    x57 -= Lb14[1] * x11;
    x58 -= Lb14[2] * x11;
    x59 -= Lb14[3] * x11;
    x60 -= Lb15[0] * x11;
    x61 -= Lb15[1] * x11;
    x62 -= Lb15[2] * x11;
    x63 -= Lb15[3] * x11;
    __builtin_amdgcn_sched_barrier(0);
    Lb3 = *(const f32x4*)(Lt_s + 896);
    Lb4 = *(const f32x4*)(Lt_s + 900);
    Lb5 = *(const f32x4*)(Lt_s + 904);
    Lb6 = *(const f32x4*)(Lt_s + 908);
    Lb7 = *(const f32x4*)(Lt_s + 912);
    Lb8 = *(const f32x4*)(Lt_s + 916);
    Lb9 = *(const f32x4*)(Lt_s + 920);
    Lb10 = *(const f32x4*)(Lt_s + 924);
    Lb11 = *(const f32x4*)(Lt_s + 928);
    Lb12 = *(const f32x4*)(Lt_s + 932);
    Lb13 = *(const f32x4*)(Lt_s + 936);
    Lb14 = *(const f32x4*)(Lt_s + 940);
    Lb15 = *(const f32x4*)(Lt_s + 944);
    __builtin_amdgcn_sched_barrier(0);
    x13 -= La3[1] * x12;
    x14 -= La3[2] * x12;
    x15 -= La3[3] * x12;
    x16 -= La4[0] * x12;
    x17 -= La4[1] * x12;
    x18 -= La4[2] * x12;
    x19 -= La4[3] * x12;
    x20 -= La5[0] * x12;
    x21 -= La5[1] * x12;
    x22 -= La5[2] * x12;
    x23 -= La5[3] * x12;
    x24 -= La6[0] * x12;
    x25 -= La6[1] * x12;
    x26 -= La6[2] * x12;
    x27 -= La6[3] * x12;
    x28 -= La7[0] * x12;
    x29 -= La7[1] * x12;
    x30 -= La7[2] * x12;
    x31 -= La7[3] * x12;
    x32 -= La8[0] * x12;
    x33 -= La8[1] * x12;
    x34 -= La8[2] * x12;
    x35 -= La8[3] * x12;
    x36 -= La9[0] * x12;
    x37 -= La9[1] * x12;
    x38 -= La9[2] * x12;
    x39 -= La9[3] * x12;
    x40 -= La10[0] * x12;
    x41 -= La10[1] * x12;
    x42 -= La10[2] * x12;
    x43 -= La10[3] * x12;
    x44 -= La11[0] * x12;
    x45 -= La11[1] * x12;
    x46 -= La11[2] * x12;
    x47 -= La11[3] * x12;
    x48 -= La12[0] * x12;
    x49 -= La12[1] * x12;
    x50 -= La12[2] * x12;
    x51 -= La12[3] * x12;
    x52 -= La13[0] * x12;
    x53 -= La13[1] * x12;
    x54 -= La13[2] * x12;
    x55 -= La13[3] * x12;
    x56 -= La14[0] * x12;
    x57 -= La14[1] * x12;
    x58 -= La14[2] * x12;
    x59 -= La14[3] * x12;
    x60 -= La15[0] * x12;
    x61 -= La15[1] * x12;
    x62 -= La15[2] * x12;
    x63 -= La15[3] * x12;
    __builtin_amdgcn_sched_barrier(0);
    La3 = *(const f32x4*)(Lt_s + 964);
    La4 = *(const f32x4*)(Lt_s + 968);
    La5 = *(const f32x4*)(Lt_s + 972);
    La6 = *(const f32x4*)(Lt_s + 976);
    La7 = *(const f32x4*)(Lt_s + 980);
    La8 = *(const f32x4*)(Lt_s + 984);
    La9 = *(const f32x4*)(Lt_s + 988);
    La10 = *(const f32x4*)(Lt_s + 992);
    La11 = *(const f32x4*)(Lt_s + 996);
    La12 = *(const f32x4*)(Lt_s + 1000);
    La13 = *(const f32x4*)(Lt_s + 1004);
    La14 = *(const f32x4*)(Lt_s + 1008);
    La15 = *(const f32x4*)(Lt_s + 1012);
    __builtin_amdgcn_sched_barrier(0);
    x14 -= Lb3[2] * x13;
    x15 -= Lb3[3] * x13;
    x16 -= Lb4[0] * x13;
    x17 -= Lb4[1] * x13;
    x18 -= Lb4[2] * x13;
    x19 -= Lb4[3] * x13;
    x20 -= Lb5[0] * x13;
    x21 -= Lb5[1] * x13;
    x22 -= Lb5[2] * x13;
    x23 -= Lb5[3] * x13;
    x24 -= Lb6[0] * x13;
    x25 -= Lb6[1] * x13;
    x26 -= Lb6[2] * x13;
    x27 -= Lb6[3] * x13;
    x28 -= Lb7[0] * x13;
    x29 -= Lb7[1] * x13;
    x30 -= Lb7[2] * x13;
    x31 -= Lb7[3] * x13;
    x32 -= Lb8[0] * x13;
    x33 -= Lb8[1] * x13;
    x34 -= Lb8[2] * x13;
    x35 -= Lb8[3] * x13;
    x36 -= Lb9[0] * x13;
    x37 -= Lb9[1] * x13;
    x38 -= Lb9[2] * x13;
    x39 -= Lb9[3] * x13;
    x40 -= Lb10[0] * x13;
    x41 -= Lb10[1] * x13;
    x42 -= Lb10[2] * x13;
    x43 -= Lb10[3] * x13;
    x44 -= Lb11[0] * x13;
    x45 -= Lb11[1] * x13;
    x46 -= Lb11[2] * x13;
    x47 -= Lb11[3] * x13;
    x48 -= Lb12[0] * x13;
    x49 -= Lb12[1] * x13;
    x50 -= Lb12[2] * x13;
    x51 -= Lb12[3] * x13;
    x52 -= Lb13[0] * x13;
    x53 -= Lb13[1] * x13;
    x54 -= Lb13[2] * x13;
    x55 -= Lb13[3] * x13;
    x56 -= Lb14[0] * x13;
    x57 -= Lb14[1] * x13;
    x58 -= Lb14[2] * x13;
    x59 -= Lb14[3] * x13;
    x60 -= Lb15[0] * x13;
    x61 -= Lb15[1] * x13;
    x62 -= Lb15[2] * x13;
    x63 -= Lb15[3] * x13;
    __builtin_amdgcn_sched_barrier(0);
    Lb4 = *(const f32x4*)(Lt_s + 1036);
    Lb5 = *(const f32x4*)(Lt_s + 1040);
    Lb6 = *(const f32x4*)(Lt_s + 1044);
    Lb7 = *(const f32x4*)(Lt_s + 1048);
    Lb8 = *(const f32x4*)(Lt_s + 1052);
    Lb9 = *(const f32x4*)(Lt_s + 1056);
    Lb10 = *(const f32x4*)(Lt_s + 1060);
    Lb11 = *(const f32x4*)(Lt_s + 1064);
    Lb12 = *(const f32x4*)(Lt_s + 1068);
    Lb13 = *(const f32x4*)(Lt_s + 1072);
    Lb14 = *(const f32x4*)(Lt_s + 1076);
    Lb15 = *(const f32x4*)(Lt_s + 1080);
    __builtin_amdgcn_sched_barrier(0);
    x15 -= La3[3] * x14;
    x16 -= La4[0] * x14;
    x17 -= La4[1] * x14;
    x18 -= La4[2] * x14;
    x19 -= La4[3] * x14;
    x20 -= La5[0] * x14;
    x21 -= La5[1] * x14;
    x22 -= La5[2] * x14;
    x23 -= La5[3] * x14;
    x24 -= La6[0] * x14;
    x25 -= La6[1] * x14;
    x26 -= La6[2] * x14;
    x27 -= La6[3] * x14;
    x28 -= La7[0] * x14;
    x29 -= La7[1] * x14;
    x30 -= La7[2] * x14;
    x31 -= La7[3] * x14;
    x32 -= La8[0] * x14;
    x33 -= La8[1] * x14;
    x34 -= La8[2] * x14;
    x35 -= La8[3] * x14;
    x36 -= La9[0] * x14;
    x37 -= La9[1] * x14;
    x38 -= La9[2] * x14;
    x39 -= La9[3] * x14;
    x40 -= La10[0] * x14;
    x41 -= La10[1] * x14;
    x42 -= La10[2] * x14;
    x43 -= La10[3] * x14;
    x44 -= La11[0] * x14;
    x45 -= La11[1] * x14;
    x46 -= La11[2] * x14;
    x47 -= La11[3] * x14;
    x48 -= La12[0] * x14;
    x49 -= La12[1] * x14;
    x50 -= La12[2] * x14;
    x51 -= La12[3] * x14;
    x52 -= La13[0] * x14;
    x53 -= La13[1] * x14;
    x54 -= La13[2] * x14;
    x55 -= La13[3] * x14;
    x56 -= La14[0] * x14;
    x57 -= La14[1] * x14;
    x58 -= La14[2] * x14;
    x59 -= La14[3] * x14;
    x60 -= La15[0] * x14;
    x61 -= La15[1] * x14;
    x62 -= La15[2] * x14;
    x63 -= La15[3] * x14;
    __builtin_amdgcn_sched_barrier(0);
    La4 = *(const f32x4*)(Lt_s + 1104);
    La5 = *(const f32x4*)(Lt_s + 1108);
    La6 = *(const f32x4*)(Lt_s + 1112);
    La7 = *(const f32x4*)(Lt_s + 1116);
    La8 = *(const f32x4*)(Lt_s + 1120);
    La9 = *(const f32x4*)(Lt_s + 1124);
    La10 = *(const f32x4*)(Lt_s + 1128);
    La11 = *(const f32x4*)(Lt_s + 1132);
    La12 = *(const f32x4*)(Lt_s + 1136);
    La13 = *(const f32x4*)(Lt_s + 1140);
    La14 = *(const f32x4*)(Lt_s + 1144);
    La15 = *(const f32x4*)(Lt_s + 1148);
    __builtin_amdgcn_sched_barrier(0);
    x16 -= Lb4[0] * x15;
    x17 -= Lb4[1] * x15;
    x18 -= Lb4[2] * x15;
    x19 -= Lb4[3] * x15;
    x20 -= Lb5[0] * x15;
    x21 -= Lb5[1] * x15;
    x22 -= Lb5[2] * x15;
    x23 -= Lb5[3] * x15;
    x24 -= Lb6[0] * x15;
    x25 -= Lb6[1] * x15;
    x26 -= Lb6[2] * x15;
    x27 -= Lb6[3] * x15;
    x28 -= Lb7[0] * x15;
    x29 -= Lb7[1] * x15;
    x30 -= Lb7[2] * x15;
    x31 -= Lb7[3] * x15;
    x32 -= Lb8[0] * x15;
    x33 -= Lb8[1] * x15;
    x34 -= Lb8[2] * x15;
    x35 -= Lb8[3] * x15;
    x36 -= Lb9[0] * x15;
    x37 -= Lb9[1] * x15;
    x38 -= Lb9[2] * x15;
    x39 -= Lb9[3] * x15;
    x40 -= Lb10[0] * x15;
    x41 -= Lb10[1] * x15;
    x42 -= Lb10[2] * x15;
    x43 -= Lb10[3] * x15;
    x44 -= Lb11[0] * x15;
    x45 -= Lb11[1] * x15;
    x46 -= Lb11[2] * x15;
    x47 -= Lb11[3] * x15;
    x48 -= Lb12[0] * x15;
    x49 -= Lb12[1] * x15;
    x50 -= Lb12[2] * x15;
    x51 -= Lb12[3] * x15;
    x52 -= Lb13[0] * x15;
    x53 -= Lb13[1] * x15;
    x54 -= Lb13[2] * x15;
    x55 -= Lb13[3] * x15;
    x56 -= Lb14[0] * x15;
    x57 -= Lb14[1] * x15;
    x58 -= Lb14[2] * x15;
    x59 -= Lb14[3] * x15;
    x60 -= Lb15[0] * x15;
    x61 -= Lb15[1] * x15;
    x62 -= Lb15[2] * x15;
    x63 -= Lb15[3] * x15;
    __builtin_amdgcn_sched_barrier(0);
    Lb4 = *(const f32x4*)(Lt_s + 1172);
    Lb5 = *(const f32x4*)(Lt_s + 1176);
    Lb6 = *(const f32x4*)(Lt_s + 1180);
    Lb7 = *(const f32x4*)(Lt_s + 1184);
    Lb8 = *(const f32x4*)(Lt_s + 1188);
    Lb9 = *(const f32x4*)(Lt_s + 1192);
    Lb10 = *(const f32x4*)(Lt_s + 1196);
    Lb11 = *(const f32x4*)(Lt_s + 1200);
    Lb12 = *(const f32x4*)(Lt_s + 1204);
    Lb13 = *(const f32x4*)(Lt_s + 1208);
    Lb14 = *(const f32x4*)(Lt_s + 1212);
    Lb15 = *(const f32x4*)(Lt_s + 1216);
    __builtin_amdgcn_sched_barrier(0);
    x17 -= La4[1] * x16;
    x18 -= La4[2] * x16;
    x19 -= La4[3] * x16;
    x20 -= La5[0] * x16;
    x21 -= La5[1] * x16;
    x22 -= La5[2] * x16;
    x23 -= La5[3] * x16;
    x24 -= La6[0] * x16;
    x25 -= La6[1] * x16;
    x26 -= La6[2] * x16;
    x27 -= La6[3] * x16;
    x28 -= La7[0] * x16;
    x29 -= La7[1] * x16;
    x30 -= La7[2] * x16;
    x31 -= La7[3] * x16;
    x32 -= La8[0] * x16;
    x33 -= La8[1] * x16;
    x34 -= La8[2] * x16;
    x35 -= La8[3] * x16;
    x36 -= La9[0] * x16;
    x37 -= La9[1] * x16;
    x38 -= La9[2] * x16;
    x39 -= La9[3] * x16;
    x40 -= La10[0] * x16;
    x41 -= La10[1] * x16;
    x42 -= La10[2] * x16;
    x43 -= La10[3] * x16;
    x44 -= La11[0] * x16;
    x45 -= La11[1] * x16;
    x46 -= La11[2] * x16;
    x47 -= La11[3] * x16;
    x48 -= La12[0] * x16;
    x49 -= La12[1] * x16;
    x50 -= La12[2] * x16;
    x51 -= La12[3] * x16;
    x52 -= La13[0] * x16;
    x53 -= La13[1] * x16;
    x54 -= La13[2] * x16;
    x55 -= La13[3] * x16;
    x56 -= La14[0] * x16;
    x57 -= La14[1] * x16;
    x58 -= La14[2] * x16;
    x59 -= La14[3] * x16;
    x60 -= La15[0] * x16;
    x61 -= La15[1] * x16;
    x62 -= La15[2] * x16;
    x63 -= La15[3] * x16;
    __builtin_amdgcn_sched_barrier(0);
    La4 = *(const f32x4*)(Lt_s + 1240);
    La5 = *(const f32x4*)(Lt_s + 1244);
    La6 = *(const f32x4*)(Lt_s + 1248);
    La7 = *(const f32x4*)(Lt_s + 1252);
    La8 = *(const f32x4*)(Lt_s + 1256);
    La9 = *(const f32x4*)(Lt_s + 1260);
    La10 = *(const f32x4*)(Lt_s + 1264);
    La11 = *(const f32x4*)(Lt_s + 1268);
    La12 = *(const f32x4*)(Lt_s + 1272);
    La13 = *(const f32x4*)(Lt_s + 1276);
    La14 = *(const f32x4*)(Lt_s + 1280);
    La15 = *(const f32x4*)(Lt_s + 1284);
    __builtin_amdgcn_sched_barrier(0);
    x18 -= Lb4[2] * x17;
    x19 -= Lb4[3] * x17;
    x20 -= Lb5[0] * x17;
    x21 -= Lb5[1] * x17;
    x22 -= Lb5[2] * x17;
    x23 -= Lb5[3] * x17;
    x24 -= Lb6[0] * x17;
    x25 -= Lb6[1] * x17;
    x26 -= Lb6[2] * x17;
    x27 -= Lb6[3] * x17;
    x28 -= Lb7[0] * x17;
    x29 -= Lb7[1] * x17;
    x30 -= Lb7[2] * x17;
    x31 -= Lb7[3] * x17;
    x32 -= Lb8[0] * x17;
    x33 -= Lb8[1] * x17;
    x34 -= Lb8[2] * x17;
    x35 -= Lb8[3] * x17;
    x36 -= Lb9[0] * x17;
    x37 -= Lb9[1] * x17;
    x38 -= Lb9[2] * x17;
    x39 -= Lb9[3] * x17;
    x40 -= Lb10[0] * x17;
    x41 -= Lb10[1] * x17;
    x42 -= Lb10[2] * x17;
    x43 -= Lb10[3] * x17;
    x44 -= Lb11[0] * x17;
    x45 -= Lb11[1] * x17;
    x46 -= Lb11[2] * x17;
    x47 -= Lb11[3] * x17;
    x48 -= Lb12[0] * x17;
    x49 -= Lb12[1] * x17;
    x50 -= Lb12[2] * x17;
    x51 -= Lb12[3] * x17;
    x52 -= Lb13[0] * x17;
    x53 -= Lb13[1] * x17;
    x54 -= Lb13[2] * x17;
    x55 -= Lb13[3] * x17;
    x56 -= Lb14[0] * x17;
    x57 -= Lb14[1] * x17;
    x58 -= Lb14[2] * x17;
    x59 -= Lb14[3] * x17;
    x60 -= Lb15[0] * x17;
    x61 -= Lb15[1] * x17;
    x62 -= Lb15[2] * x17;
    x63 -= Lb15[3] * x17;
    __builtin_amdgcn_sched_barrier(0);
    Lb5 = *(const f32x4*)(Lt_s + 1312);
    Lb6 = *(const f32x4*)(Lt_s + 1316);
    Lb7 = *(const f32x4*)(Lt_s + 1320);
    Lb8 = *(const f32x4*)(Lt_s + 1324);
    Lb9 = *(const f32x4*)(Lt_s + 1328);
    Lb10 = *(const f32x4*)(Lt_s + 1332);
    Lb11 = *(const f32x4*)(Lt_s + 1336);
    Lb12 = *(const f32x4*)(Lt_s + 1340);
    Lb13 = *(const f32x4*)(Lt_s + 1344);
    Lb14 = *(const f32x4*)(Lt_s + 1348);
    Lb15 = *(const f32x4*)(Lt_s + 1352);
    __builtin_amdgcn_sched_barrier(0);
    x19 -= La4[3] * x18;
    x20 -= La5[0] * x18;
    x21 -= La5[1] * x18;
    x22 -= La5[2] * x18;
    x23 -= La5[3] * x18;
    x24 -= La6[0] * x18;
    x25 -= La6[1] * x18;
    x26 -= La6[2] * x18;
    x27 -= La6[3] * x18;
    x28 -= La7[0] * x18;
    x29 -= La7[1] * x18;
    x30 -= La7[2] * x18;
    x31 -= La7[3] * x18;
    x32 -= La8[0] * x18;
    x33 -= La8[1] * x18;
    x34 -= La8[2] * x18;
    x35 -= La8[3] * x18;
    x36 -= La9[0] * x18;
    x37 -= La9[1] * x18;
    x38 -= La9[2] * x18;
    x39 -= La9[3] * x18;
    x40 -= La10[0] * x18;
    x41 -= La10[1] * x18;
    x42 -= La10[2] * x18;
    x43 -= La10[3] * x18;
    x44 -= La11[0] * x18;
    x45 -= La11[1] * x18;
    x46 -= La11[2] * x18;
    x47 -= La11[3] * x18;
    x48 -= La12[0] * x18;
    x49 -= La12[1] * x18;
    x50 -= La12[2] * x18;
    x51 -= La12[3] * x18;
    x52 -= La13[0] * x18;
    x53 -= La13[1] * x18;
    x54 -= La13[2] * x18;
    x55 -= La13[3] * x18;
    x56 -= La14[0] * x18;
    x57 -= La14[1] * x18;
    x58 -= La14[2] * x18;
    x59 -= La14[3] * x18;
    x60 -= La15[0] * x18;
    x61 -= La15[1] * x18;
    x62 -= La15[2] * x18;
    x63 -= La15[3] * x18;
    __builtin_amdgcn_sched_barrier(0);
    La5 = *(const f32x4*)(Lt_s + 1380);
    La6 = *(const f32x4*)(Lt_s + 1384);
    La7 = *(const f32x4*)(Lt_s + 1388);
    La8 = *(const f32x4*)(Lt_s + 1392);
    La9 = *(const f32x4*)(Lt_s + 1396);
    La10 = *(const f32x4*)(Lt_s + 1400);
    La11 = *(const f32x4*)(Lt_s + 1404);
    La12 = *(const f32x4*)(Lt_s + 1408);
    La13 = *(const f32x4*)(Lt_s + 1412);
    La14 = *(const f32x4*)(Lt_s + 1416);
    La15 = *(const f32x4*)(Lt_s + 1420);
    __builtin_amdgcn_sched_barrier(0);
    x20 -= Lb5[0] * x19;
    x21 -= Lb5[1] * x19;
    x22 -= Lb5[2] * x19;
    x23 -= Lb5[3] * x19;
    x24 -= Lb6[0] * x19;
    x25 -= Lb6[1] * x19;
    x26 -= Lb6[2] * x19;
    x27 -= Lb6[3] * x19;
    x28 -= Lb7[0] * x19;
    x29 -= Lb7[1] * x19;
    x30 -= Lb7[2] * x19;
    x31 -= Lb7[3] * x19;
    x32 -= Lb8[0] * x19;
    x33 -= Lb8[1] * x19;
    x34 -= Lb8[2] * x19;
    x35 -= Lb8[3] * x19;
    x36 -= Lb9[0] * x19;
    x37 -= Lb9[1] * x19;
    x38 -= Lb9[2] * x19;
    x39 -= Lb9[3] * x19;
    x40 -= Lb10[0] * x19;
    x41 -= Lb10[1] * x19;
    x42 -= Lb10[2] * x19;
    x43 -= Lb10[3] * x19;
    x44 -= Lb11[0] * x19;
    x45 -= Lb11[1] * x19;
    x46 -= Lb11[2] * x19;
    x47 -= Lb11[3] * x19;
    x48 -= Lb12[0] * x19;
    x49 -= Lb12[1] * x19;
    x50 -= Lb12[2] * x19;
    x51 -= Lb12[3] * x19;
    x52 -= Lb13[0] * x19;
    x53 -= Lb13[1] * x19;
    x54 -= Lb13[2] * x19;
    x55 -= Lb13[3] * x19;
    x56 -= Lb14[0] * x19;
    x57 -= Lb14[1] * x19;
    x58 -= Lb14[2] * x19;
    x59 -= Lb14[3] * x19;
    x60 -= Lb15[0] * x19;
    x61 -= Lb15[1] * x19;
    x62 -= Lb15[2] * x19;
    x63 -= Lb15[3] * x19;
    __builtin_amdgcn_sched_barrier(0);
    Lb5 = *(const f32x4*)(Lt_s + 1448);
    Lb6 = *(const f32x4*)(Lt_s + 1452);
    Lb7 = *(const f32x4*)(Lt_s + 1456);
    Lb8 = *(const f32x4*)(Lt_s + 1460);
    Lb9 = *(const f32x4*)(Lt_s + 1464);
    Lb10 = *(const f32x4*)(Lt_s + 1468);
    Lb11 = *(const f32x4*)(Lt_s + 1472);
    Lb12 = *(const f32x4*)(Lt_s + 1476);
    Lb13 = *(const f32x4*)(Lt_s + 1480);
    Lb14 = *(const f32x4*)(Lt_s + 1484);
    Lb15 = *(const f32x4*)(Lt_s + 1488);
    __builtin_amdgcn_sched_barrier(0);
    x21 -= La5[1] * x20;
    x22 -= La5[2] * x20;
    x23 -= La5[3] * x20;
    x24 -= La6[0] * x20;
    x25 -= La6[1] * x20;
    x26 -= La6[2] * x20;
    x27 -= La6[3] * x20;
    x28 -= La7[0] * x20;
    x29 -= La7[1] * x20;
    x30 -= La7[2] * x20;
    x31 -= La7[3] * x20;
    x32 -= La8[0] * x20;
    x33 -= La8[1] * x20;
    x34 -= La8[2] * x20;
    x35 -= La8[3] * x20;
    x36 -= La9[0] * x20;
    x37 -= La9[1] * x20;
    x38 -= La9[2] * x20;
    x39 -= La9[3] * x20;
    x40 -= La10[0] * x20;
    x41 -= La10[1] * x20;
    x42 -= La10[2] * x20;
    x43 -= La10[3] * x20;
    x44 -= La11[0] * x20;
    x45 -= La11[1] * x20;
    x46 -= La11[2] * x20;
    x47 -= La11[3] * x20;
    x48 -= La12[0] * x20;
    x49 -= La12[1] * x20;
    x50 -= La12[2] * x20;
    x51 -= La12[3] * x20;
    x52 -= La13[0] * x20;
    x53 -= La13[1] * x20;
    x54 -= La13[2] * x20;
    x55 -= La13[3] * x20;
    x56 -= La14[0] * x20;
    x57 -= La14[1] * x20;
    x58 -= La14[2] * x20;
    x59 -= La14[3] * x20;
    x60 -= La15[0] * x20;
    x61 -= La15[1] * x20;
    x62 -= La15[2] * x20;
    x63 -= La15[3] * x20;
    __builtin_amdgcn_sched_barrier(0);
    La5 = *(const f32x4*)(Lt_s + 1516);
    La6 = *(const f32x4*)(Lt_s + 1520);
    La7 = *(const f32x4*)(Lt_s + 1524);
    La8 = *(const f32x4*)(Lt_s + 1528);
    La9 = *(const f32x4*)(Lt_s + 1532);
    La10 = *(const f32x4*)(Lt_s + 1536);
    La11 = *(const f32x4*)(Lt_s + 1540);
    La12 = *(const f32x4*)(Lt_s + 1544);
    La13 = *(const f32x4*)(Lt_s + 1548);
    La14 = *(const f32x4*)(Lt_s + 1552);
    La15 = *(const f32x4*)(Lt_s + 1556);
    __builtin_amdgcn_sched_barrier(0);
    x22 -= Lb5[2] * x21;
    x23 -= Lb5[3] * x21;
    x24 -= Lb6[0] * x21;
    x25 -= Lb6[1] * x21;
    x26 -= Lb6[2] * x21;
    x27 -= Lb6[3] * x21;
    x28 -= Lb7[0] * x21;
    x29 -= Lb7[1] * x21;
    x30 -= Lb7[2] * x21;
    x31 -= Lb7[3] * x21;
    x32 -= Lb8[0] * x21;
    x33 -= Lb8[1] * x21;
    x34 -= Lb8[2] * x21;
    x35 -= Lb8[3] * x21;
    x36 -= Lb9[0] * x21;
    x37 -= Lb9[1] * x21;
    x38 -= Lb9[2] * x21;
    x39 -= Lb9[3] * x21;
    x40 -= Lb10[0] * x21;
    x41 -= Lb10[1] * x21;
    x42 -= Lb10[2] * x21;
    x43 -= Lb10[3] * x21;
    x44 -= Lb11[0] * x21;
    x45 -= Lb11[1] * x21;
    x46 -= Lb11[2] * x21;
    x47 -= Lb11[3] * x21;
    x48 -= Lb12[0] * x21;
    x49 -= Lb12[1] * x21;
    x50 -= Lb12[2] * x21;
    x51 -= Lb12[3] * x21;
    x52 -= Lb13[0] * x21;
    x53 -= Lb13[1] * x21;
    x54 -= Lb13[2] * x21;
    x55 -= Lb13[3] * x21;
    x56 -= Lb14[0] * x21;
    x57 -= Lb14[1] * x21;
    x58 -= Lb14[2] * x21;
    x59 -= Lb14[3] * x21;
    x60 -= Lb15[0] * x21;
    x61 -= Lb15[1] * x21;
    x62 -= Lb15[2] * x21;
    x63 -= Lb15[3] * x21;
    __builtin_amdgcn_sched_barrier(0);
    Lb6 = *(const f32x4*)(Lt_s + 1588);
    Lb7 = *(const f32x4*)(Lt_s + 1592);
    Lb8 = *(const f32x4*)(Lt_s + 1596);
    Lb9 = *(const f32x4*)(Lt_s + 1600);
    Lb10 = *(const f32x4*)(Lt_s + 1604);
    Lb11 = *(const f32x4*)(Lt_s + 1608);
    Lb12 = *(const f32x4*)(Lt_s + 1612);
    Lb13 = *(const f32x4*)(Lt_s + 1616);
    Lb14 = *(const f32x4*)(Lt_s + 1620);
    Lb15 = *(const f32x4*)(Lt_s + 1624);
    __builtin_amdgcn_sched_barrier(0);
    x23 -= La5[3] * x22;
    x24 -= La6[0] * x22;
    x25 -= La6[1] * x22;
    x26 -= La6[2] * x22;
    x27 -= La6[3] * x22;
    x28 -= La7[0] * x22;
    x29 -= La7[1] * x22;
    x30 -= La7[2] * x22;
    x31 -= La7[3] * x22;
    x32 -= La8[0] * x22;
    x33 -= La8[1] * x22;
    x34 -= La8[2] * x22;
    x35 -= La8[3] * x22;
    x36 -= La9[0] * x22;
    x37 -= La9[1] * x22;
    x38 -= La9[2] * x22;
    x39 -= La9[3] * x22;
    x40 -= La10[0] * x22;
    x41 -= La10[1] * x22;
    x42 -= La10[2] * x22;
    x43 -= La10[3] * x22;
    x44 -= La11[0] * x22;
    x45 -= La11[1] * x22;
    x46 -= La11[2] * x22;
    x47 -= La11[3] * x22;
    x48 -= La12[0] * x22;
    x49 -= La12[1] * x22;
    x50 -= La12[2] * x22;
    x51 -= La12[3] * x22;
    x52 -= La13[0] * x22;
    x53 -= La13[1] * x22;
    x54 -= La13[2] * x22;
    x55 -= La13[3] * x22;
    x56 -= La14[0] * x22;
    x57 -= La14[1] * x22;
    x58 -= La14[2] * x22;
    x59 -= La14[3] * x22;
    x60 -= La15[0] * x22;
    x61 -= La15[1] * x22;
    x62 -= La15[2] * x22;
    x63 -= La15[3] * x22;
    __builtin_amdgcn_sched_barrier(0);
    La6 = *(const f32x4*)(Lt_s + 1656);
    La7 = *(const f32x4*)(Lt_s + 1660);
    La8 = *(const f32x4*)(Lt_s + 1664);
    La9 = *(const f32x4*)(Lt_s + 1668);
    La10 = *(const f32x4*)(Lt_s + 1672);
    La11 = *(const f32x4*)(Lt_s + 1676);
    La12 = *(const f32x4*)(Lt_s + 1680);
    La13 = *(const f32x4*)(Lt_s + 1684);
    La14 = *(const f32x4*)(Lt_s + 1688);
    La15 = *(const f32x4*)(Lt_s + 1692);
    __builtin_amdgcn_sched_barrier(0);
    x24 -= Lb6[0] * x23;
    x25 -= Lb6[1] * x23;
    x26 -= Lb6[2] * x23;
    x27 -= Lb6[3] * x23;
    x28 -= Lb7[0] * x23;
    x29 -= Lb7[1] * x23;
    x30 -= Lb7[2] * x23;
    x31 -= Lb7[3] * x23;
    x32 -= Lb8[0] * x23;
    x33 -= Lb8[1] * x23;
    x34 -= Lb8[2] * x23;
    x35 -= Lb8[3] * x23;
    x36 -= Lb9[0] * x23;
    x37 -= Lb9[1] * x23;
    x38 -= Lb9[2] * x23;
    x39 -= Lb9[3] * x23;
    x40 -= Lb10[0] * x23;
    x41 -= Lb10[1] * x23;
    x42 -= Lb10[2] * x23;
    x43 -= Lb10[3] * x23;
    x44 -= Lb11[0] * x23;
    x45 -= Lb11[1] * x23;
    x46 -= Lb11[2] * x23;
    x47 -= Lb11[3] * x23;
    x48 -= Lb12[0] * x23;
    x49 -= Lb12[1] * x23;
    x50 -= Lb12[2] * x23;
    x51 -= Lb12[3] * x23;
    x52 -= Lb13[0] * x23;
    x53 -= Lb13[1] * x23;
    x54 -= Lb13[2] * x23;
    x55 -= Lb13[3] * x23;
    x56 -= Lb14[0] * x23;
    x57 -= Lb14[1] * x23;
    x58 -= Lb14[2] * x23;
    x59 -= Lb14[3] * x23;
    x60 -= Lb15[0] * x23;
    x61 -= Lb15[1] * x23;
    x62 -= Lb15[2] * x23;
    x63 -= Lb15[3] * x23;
    __builtin_amdgcn_sched_barrier(0);
    Lb6 = *(const f32x4*)(Lt_s + 1724);
    Lb7 = *(const f32x4*)(Lt_s + 1728);
    Lb8 = *(const f32x4*)(Lt_s + 1732);
    Lb9 = *(const f32x4*)(Lt_s + 1736);
    Lb10 = *(const f32x4*)(Lt_s + 1740);
    Lb11 = *(const f32x4*)(Lt_s + 1744);
    Lb12 = *(const f32x4*)(Lt_s + 1748);
    Lb13 = *(const f32x4*)(Lt_s + 1752);
    Lb14 = *(const f32x4*)(Lt_s + 1756);
    Lb15 = *(const f32x4*)(Lt_s + 1760);
    __builtin_amdgcn_sched_barrier(0);
    x25 -= La6[1] * x24;
    x26 -= La6[2] * x24;
    x27 -= La6[3] * x24;
    x28 -= La7[0] * x24;
    x29 -= La7[1] * x24;
    x30 -= La7[2] * x24;
    x31 -= La7[3] * x24;
    x32 -= La8[0] * x24;
    x33 -= La8[1] * x24;
    x34 -= La8[2] * x24;
    x35 -= La8[3] * x24;
    x36 -= La9[0] * x24;
    x37 -= La9[1] * x24;
    x38 -= La9[2] * x24;
    x39 -= La9[3] * x24;
    x40 -= La10[0] * x24;
    x41 -= La10[1] * x24;
    x42 -= La10[2] * x24;
    x43 -= La10[3] * x24;
    x44 -= La11[0] * x24;
    x45 -= La11[1] * x24;
    x46 -= La11[2] * x24;
    x47 -= La11[3] * x24;
    x48 -= La12[0] * x24;
    x49 -= La12[1] * x24;
    x50 -= La12[2] * x24;
    x51 -= La12[3] * x24;
    x52 -= La13[0] * x24;
    x53 -= La13[1] * x24;
    x54 -= La13[2] * x24;
    x55 -= La13[3] * x24;
    x56 -= La14[0] * x24;
    x57 -= La14[1] * x24;
    x58 -= La14[2] * x24;
    x59 -= La14[3] * x24;
    x60 -= La15[0] * x24;
    x61 -= La15[1] * x24;
    x62 -= La15[2] * x24;
    x63 -= La15[3] * x24;
    __builtin_amdgcn_sched_barrier(0);
    La6 = *(const f32x4*)(Lt_s + 1792);
    La7 = *(const f32x4*)(Lt_s + 1796);
    La8 = *(const f32x4*)(Lt_s + 1800);
    La9 = *(const f32x4*)(Lt_s + 1804);
    La10 = *(const f32x4*)(Lt_s + 1808);
    La11 = *(const f32x4*)(Lt_s + 1812);
    La12 = *(const f32x4*)(Lt_s + 1816);
    La13 = *(const f32x4*)(Lt_s + 1820);
    La14 = *(const f32x4*)(Lt_s + 1824);
    La15 = *(const f32x4*)(Lt_s + 1828);
    __builtin_amdgcn_sched_barrier(0);
    x26 -= Lb6[2] * x25;
    x27 -= Lb6[3] * x25;
    x28 -= Lb7[0] * x25;
    x29 -= Lb7[1] * x25;
    x30 -= Lb7[2] * x25;
    x31 -= Lb7[3] * x25;
    x32 -= Lb8[0] * x25;
    x33 -= Lb8[1] * x25;
    x34 -= Lb8[2] * x25;
    x35 -= Lb8[3] * x25;
    x36 -= Lb9[0] * x25;
    x37 -= Lb9[1] * x25;
    x38 -= Lb9[2] * x25;
    x39 -= Lb9[3] * x25;
    x40 -= Lb10[0] * x25;
    x41 -= Lb10[1] * x25;
    x42 -= Lb10[2] * x25;
    x43 -= Lb10[3] * x25;
    x44 -= Lb11[0] * x25;
    x45 -= Lb11[1] * x25;
    x46 -= Lb11[2] * x25;
    x47 -= Lb11[3] * x25;
    x48 -= Lb12[0] * x25;
    x49 -= Lb12[1] * x25;
    x50 -= Lb12[2] * x25;
    x51 -= Lb12[3] * x25;
    x52 -= Lb13[0] * x25;
    x53 -= Lb13[1] * x25;
    x54 -= Lb13[2] * x25;
    x55 -= Lb13[3] * x25;
    x56 -= Lb14[0] * x25;
    x57 -= Lb14[1] * x25;
    x58 -= Lb14[2] * x25;
    x59 -= Lb14[3] * x25;
    x60 -= Lb15[0] * x25;
    x61 -= Lb15[1] * x25;
    x62 -= Lb15[2] * x25;
    x63 -= Lb15[3] * x25;
    __builtin_amdgcn_sched_barrier(0);
    Lb7 = *(const f32x4*)(Lt_s + 1864);
    Lb8 = *(const f32x4*)(Lt_s + 1868);
    Lb9 = *(const f32x4*)(Lt_s + 1872);
    Lb10 = *(const f32x4*)(Lt_s + 1876);
    Lb11 = *(const f32x4*)(Lt_s + 1880);
    Lb12 = *(const f32x4*)(Lt_s + 1884);
    Lb13 = *(const f32x4*)(Lt_s + 1888);
    Lb14 = *(const f32x4*)(Lt_s + 1892);
    Lb15 = *(const f32x4*)(Lt_s + 1896);
    __builtin_amdgcn_sched_barrier(0);
    x27 -= La6[3] * x26;
    x28 -= La7[0] * x26;
    x29 -= La7[1] * x26;
    x30 -= La7[2] * x26;
    x31 -= La7[3] * x26;
    x32 -= La8[0] * x26;
    x33 -= La8[1] * x26;
    x34 -= La8[2] * x26;
    x35 -= La8[3] * x26;
    x36 -= La9[0] * x26;
    x37 -= La9[1] * x26;
    x38 -= La9[2] * x26;
    x39 -= La9[3] * x26;
    x40 -= La10[0] * x26;
    x41 -= La10[1] * x26;
    x42 -= La10[2] * x26;
    x43 -= La10[3] * x26;
    x44 -= La11[0] * x26;
    x45 -= La11[1] * x26;
    x46 -= La11[2] * x26;
    x47 -= La11[3] * x26;
    x48 -= La12[0] * x26;
    x49 -= La12[1] * x26;
    x50 -= La12[2] * x26;
    x51 -= La12[3] * x26;
    x52 -= La13[0] * x26;
    x53 -= La13[1] * x26;
    x54 -= La13[2] * x26;
    x55 -= La13[3] * x26;
    x56 -= La14[0] * x26;
    x57 -= La14[1] * x26;
    x58 -= La14[2] * x26;
    x59 -= La14[3] * x26;
    x60 -= La15[0] * x26;
    x61 -= La15[1] * x26;
    x62 -= La15[2] * x26;
    x63 -= La15[3] * x26;
    __builtin_amdgcn_sched_barrier(0);
    La7 = *(const f32x4*)(Lt_s + 1932);
    La8 = *(const f32x4*)(Lt_s + 1936);
    La9 = *(const f32x4*)(Lt_s + 1940);
    La10 = *(const f32x4*)(Lt_s + 1944);
    La11 = *(const f32x4*)(Lt_s + 1948);
    La12 = *(const f32x4*)(Lt_s + 1952);
    La13 = *(const f32x4*)(Lt_s + 1956);
    La14 = *(const f32x4*)(Lt_s + 1960);
    La15 = *(const f32x4*)(Lt_s + 1964);
    __builtin_amdgcn_sched_barrier(0);
    x28 -= Lb7[0] * x27;
    x29 -= Lb7[1] * x27;
    x30 -= Lb7[2] * x27;
    x31 -= Lb7[3] * x27;
    x32 -= Lb8[0] * x27;
    x33 -= Lb8[1] * x27;
    x34 -= Lb8[2] * x27;
    x35 -= Lb8[3] * x27;
    x36 -= Lb9[0] * x27;
    x37 -= Lb9[1] * x27;
    x38 -= Lb9[2] * x27;
    x39 -= Lb9[3] * x27;
    x40 -= Lb10[0] * x27;
    x41 -= Lb10[1] * x27;
    x42 -= Lb10[2] * x27;
    x43 -= Lb10[3] * x27;
    x44 -= Lb11[0] * x27;
    x45 -= Lb11[1] * x27;
    x46 -= Lb11[2] * x27;
    x47 -= Lb11[3] * x27;
    x48 -= Lb12[0] * x27;
    x49 -= Lb12[1] * x27;
    x50 -= Lb12[2] * x27;
    x51 -= Lb12[3] * x27;
    x52 -= Lb13[0] * x27;
    x53 -= Lb13[1] * x27;
    x54 -= Lb13[2] * x27;
    x55 -= Lb13[3] * x27;
    x56 -= Lb14[0] * x27;
    x57 -= Lb14[1] * x27;
    x58 -= Lb14[2] * x27;
    x59 -= Lb14[3] * x27;
    x60 -= Lb15[0] * x27;
    x61 -= Lb15[1] * x27;
    x62 -= Lb15[2] * x27;
    x63 -= Lb15[3] * x27;
    __builtin_amdgcn_sched_barrier(0);
    Lb7 = *(const f32x4*)(Lt_s + 2000);
    Lb8 = *(const f32x4*)(Lt_s + 2004);
    Lb9 = *(const f32x4*)(Lt_s + 2008);
    Lb10 = *(const f32x4*)(Lt_s + 2012);
    Lb11 = *(const f32x4*)(Lt_s + 2016);
    Lb12 = *(const f32x4*)(Lt_s + 2020);
    Lb13 = *(const f32x4*)(Lt_s + 2024);
    Lb14 = *(const f32x4*)(Lt_s + 2028);
    Lb15 = *(const f32x4*)(Lt_s + 2032);
    __builtin_amdgcn_sched_barrier(0);
    x29 -= La7[1] * x28;
    x30 -= La7[2] * x28;
    x31 -= La7[3] * x28;
    x32 -= La8[0] * x28;
    x33 -= La8[1] * x28;
    x34 -= La8[2] * x28;
    x35 -= La8[3] * x28;
    x36 -= La9[0] * x28;
    x37 -= La9[1] * x28;
    x38 -= La9[2] * x28;
    x39 -= La9[3] * x28;
    x40 -= La10[0] * x28;
    x41 -= La10[1] * x28;
    x42 -= La10[2] * x28;
    x43 -= La10[3] * x28;
    x44 -= La11[0] * x28;
    x45 -= La11[1] * x28;
    x46 -= La11[2] * x28;
    x47 -= La11[3] * x28;
    x48 -= La12[0] * x28;
    x49 -= La12[1] * x28;
    x50 -= La12[2] * x28;
    x51 -= La12[3] * x28;
    x52 -= La13[0] * x28;
    x53 -= La13[1] * x28;
    x54 -= La13[2] * x28;
    x55 -= La13[3] * x28;
    x56 -= La14[0] * x28;
    x57 -= La14[1] * x28;
    x58 -= La14[2] * x28;
    x59 -= La14[3] * x28;
    x60 -= La15[0] * x28;
    x61 -= La15[1] * x28;
    x62 -= La15[2] * x28;
    x63 -= La15[3] * x28;
    __builtin_amdgcn_sched_barrier(0);
    La7 = *(const f32x4*)(Lt_s + 2068);
    La8 = *(const f32x4*)(Lt_s + 2072);
    La9 = *(const f32x4*)(Lt_s + 2076);
    La10 = *(const f32x4*)(Lt_s + 2080);
    La11 = *(const f32x4*)(Lt_s + 2084);
    La12 = *(const f32x4*)(Lt_s + 2088);
    La13 = *(const f32x4*)(Lt_s + 2092);
    La14 = *(const f32x4*)(Lt_s + 2096);
    La15 = *(const f32x4*)(Lt_s + 2100);
    __builtin_amdgcn_sched_barrier(0);
    x30 -= Lb7[2] * x29;
    x31 -= Lb7[3] * x29;
    x32 -= Lb8[0] * x29;
    x33 -= Lb8[1] * x29;
    x34 -= Lb8[2] * x29;
    x35 -= Lb8[3] * x29;
    x36 -= Lb9[0] * x29;
    x37 -= Lb9[1] * x29;
    x38 -= Lb9[2] * x29;
    x39 -= Lb9[3] * x29;
    x40 -= Lb10[0] * x29;
    x41 -= Lb10[1] * x29;
    x42 -= Lb10[2] * x29;
    x43 -= Lb10[3] * x29;
    x44 -= Lb11[0] * x29;
    x45 -= Lb11[1] * x29;
    x46 -= Lb11[2] * x29;
    x47 -= Lb11[3] * x29;
    x48 -= Lb12[0] * x29;
    x49 -= Lb12[1] * x29;
    x50 -= Lb12[2] * x29;
    x51 -= Lb12[3] * x29;
    x52 -= Lb13[0] * x29;
    x53 -= Lb13[1] * x29;
    x54 -= Lb13[2] * x29;
    x55 -= Lb13[3] * x29;
    x56 -= Lb14[0] * x29;
    x57 -= Lb14[1] * x29;
    x58 -= Lb14[2] * x29;
    x59 -= Lb14[3] * x29;
    x60 -= Lb15[0] * x29;
    x61 -= Lb15[1] * x29;
    x62 -= Lb15[2] * x29;
    x63 -= Lb15[3] * x29;
    __builtin_amdgcn_sched_barrier(0);
    Lb8 = *(const f32x4*)(Lt_s + 2140);
    Lb9 = *(const f32x4*)(Lt_s + 2144);
    Lb10 = *(const f32x4*)(Lt_s + 2148);
    Lb11 = *(const f32x4*)(Lt_s + 2152);
    Lb12 = *(const f32x4*)(Lt_s + 2156);
    Lb13 = *(const f32x4*)(Lt_s + 2160);
    Lb14 = *(const f32x4*)(Lt_s + 2164);
    Lb15 = *(const f32x4*)(Lt_s + 2168);
    __builtin_amdgcn_sched_barrier(0);
    x31 -= La7[3] * x30;
    x32 -= La8[0] * x30;
    x33 -= La8[1] * x30;
    x34 -= La8[2] * x30;
    x35 -= La8[3] * x30;
    x36 -= La9[0] * x30;
    x37 -= La9[1] * x30;
    x38 -= La9[2] * x30;
    x39 -= La9[3] * x30;
    x40 -= La10[0] * x30;
    x41 -= La10[1] * x30;
    x42 -= La10[2] * x30;
    x43 -= La10[3] * x30;
    x44 -= La11[0] * x30;
    x45 -= La11[1] * x30;
    x46 -= La11[2] * x30;
    x47 -= La11[3] * x30;
    x48 -= La12[0] * x30;
    x49 -= La12[1] * x30;
    x50 -= La12[2] * x30;
    x51 -= La12[3] * x30;
    x52 -= La13[0] * x30;
    x53 -= La13[1] * x30;
    x54 -= La13[2] * x30;
    x55 -= La13[3] * x30;
    x56 -= La14[0] * x30;
    x57 -= La14[1] * x30;
    x58 -= La14[2] * x30;
    x59 -= La14[3] * x30;
    x60 -= La15[0] * x30;
    x61 -= La15[1] * x30;
    x62 -= La15[2] * x30;
    x63 -= La15[3] * x30;
    __builtin_amdgcn_sched_barrier(0);
    La8 = *(const f32x4*)(Lt_s + 2208);
    La9 = *(const f32x4*)(Lt_s + 2212);
    La10 = *(const f32x4*)(Lt_s + 2216);
    La11 = *(const f32x4*)(Lt_s + 2220);
    La12 = *(const f32x4*)(Lt_s + 2224);
    La13 = *(const f32x4*)(Lt_s + 2228);
    La14 = *(const f32x4*)(Lt_s + 2232);
    La15 = *(const f32x4*)(Lt_s + 2236);
    __builtin_amdgcn_sched_barrier(0);
    x32 -= Lb8[0] * x31;
    x33 -= Lb8[1] * x31;
    x34 -= Lb8[2] * x31;
    x35 -= Lb8[3] * x31;
    x36 -= Lb9[0] * x31;
    x37 -= Lb9[1] * x31;
    x38 -= Lb9[2] * x31;
    x39 -= Lb9[3] * x31;
    x40 -= Lb10[0] * x31;
    x41 -= Lb10[1] * x31;
    x42 -= Lb10[2] * x31;
    x43 -= Lb10[3] * x31;
    x44 -= Lb11[0] * x31;
    x45 -= Lb11[1] * x31;
    x46 -= Lb11[2] * x31;
    x47 -= Lb11[3] * x31;
    x48 -= Lb12[0] * x31;
    x49 -= Lb12[1] * x31;
    x50 -= Lb12[2] * x31;
    x51 -= Lb12[3] * x31;
    x52 -= Lb13[0] * x31;
    x53 -= Lb13[1] * x31;
    x54 -= Lb13[2] * x31;
    x55 -= Lb13[3] * x31;
    x56 -= Lb14[0] * x31;
    x57 -= Lb14[1] * x31;
    x58 -= Lb14[2] * x31;
    x59 -= Lb14[3] * x31;
    x60 -= Lb15[0] * x31;
    x61 -= Lb15[1] * x31;
    x62 -= Lb15[2] * x31;
    x63 -= Lb15[3] * x31;
    __builtin_amdgcn_sched_barrier(0);
    Lb8 = *(const f32x4*)(Lt_s + 2276);
    Lb9 = *(const f32x4*)(Lt_s + 2280);
    Lb10 = *(const f32x4*)(Lt_s + 2284);
    Lb11 = *(const f32x4*)(Lt_s + 2288);
    Lb12 = *(const f32x4*)(Lt_s + 2292);
    Lb13 = *(const f32x4*)(Lt_s + 2296);
    Lb14 = *(const f32x4*)(Lt_s + 2300);
    Lb15 = *(const f32x4*)(Lt_s + 2304);
    __builtin_amdgcn_sched_barrier(0);
    x33 -= La8[1] * x32;
    x34 -= La8[2] * x32;
    x35 -= La8[3] * x32;
    x36 -= La9[0] * x32;
    x37 -= La9[1] * x32;
    x38 -= La9[2] * x32;
    x39 -= La9[3] * x32;
    x40 -= La10[0] * x32;
    x41 -= La10[1] * x32;
    x42 -= La10[2] * x32;
    x43 -= La10[3] * x32;
    x44 -= La11[0] * x32;
    x45 -= La11[1] * x32;
    x46 -= La11[2] * x32;
    x47 -= La11[3] * x32;
    x48 -= La12[0] * x32;
    x49 -= La12[1] * x32;
    x50 -= La12[2] * x32;
    x51 -= La12[3] * x32;
    x52 -= La13[0] * x32;
    x53 -= La13[1] * x32;
    x54 -= La13[2] * x32;
    x55 -= La13[3] * x32;
    x56 -= La14[0] * x32;
    x57 -= La14[1] * x32;
    x58 -= La14[2] * x32;
    x59 -= La14[3] * x32;
    x60 -= La15[0] * x32;
    x61 -= La15[1] * x32;
    x62 -= La15[2] * x32;
    x63 -= La15[3] * x32;
    __builtin_amdgcn_sched_barrier(0);
    La8 = *(const f32x4*)(Lt_s + 2344);
    La9 = *(const f32x4*)(Lt_s + 2348);
    La10 = *(const f32x4*)(Lt_s + 2352);
    La11 = *(const f32x4*)(Lt_s + 2356);
    La12 = *(const f32x4*)(Lt_s + 2360);
    La13 = *(const f32x4*)(Lt_s + 2364);
    La14 = *(const f32x4*)(Lt_s + 2368);
    La15 = *(const f32x4*)(Lt_s + 2372);
    __builtin_amdgcn_sched_barrier(0);
    x34 -= Lb8[2] * x33;
    x35 -= Lb8[3] * x33;
    x36 -= Lb9[0] * x33;
    x37 -= Lb9[1] * x33;
    x38 -= Lb9[2] * x33;
    x39 -= Lb9[3] * x33;
    x40 -= Lb10[0] * x33;
    x41 -= Lb10[1] * x33;
    x42 -= Lb10[2] * x33;
    x43 -= Lb10[3] * x33;
    x44 -= Lb11[0] * x33;
    x45 -= Lb11[1] * x33;
    x46 -= Lb11[2] * x33;
    x47 -= Lb11[3] * x33;
    x48 -= Lb12[0] * x33;
    x49 -= Lb12[1] * x33;
    x50 -= Lb12[2] * x33;
    x51 -= Lb12[3] * x33;
    x52 -= Lb13[0] * x33;
    x53 -= Lb13[1] * x33;
    x54 -= Lb13[2] * x33;
    x55 -= Lb13[3] * x33;
    x56 -= Lb14[0] * x33;
    x57 -= Lb14[1] * x33;
    x58 -= Lb14[2] * x33;
    x59 -= Lb14[3] * x33;
    x60 -= Lb15[0] * x33;
    x61 -= Lb15[1] * x33;
    x62 -= Lb15[2] * x33;
    x63 -= Lb15[3] * x33;
    __builtin_amdgcn_sched_barrier(0);
    Lb9 = *(const f32x4*)(Lt_s + 2416);
    Lb10 = *(const f32x4*)(Lt_s + 2420);
    Lb11 = *(const f32x4*)(Lt_s + 2424);
    Lb12 = *(const f32x4*)(Lt_s + 2428);
    Lb13 = *(const f32x4*)(Lt_s + 2432);
    Lb14 = *(const f32x4*)(Lt_s + 2436);
    Lb15 = *(const f32x4*)(Lt_s + 2440);
    __builtin_amdgcn_sched_barrier(0);
    x35 -= La8[3] * x34;
    x36 -= La9[0] * x34;
    x37 -= La9[1] * x34;
    x38 -= La9[2] * x34;
    x39 -= La9[3] * x34;
    x40 -= La10[0] * x34;
    x41 -= La10[1] * x34;
    x42 -= La10[2] * x34;
    x43 -= La10[3] * x34;
    x44 -= La11[0] * x34;
    x45 -= La11[1] * x34;
    x46 -= La11[2] * x34;
    x47 -= La11[3] * x34;
    x48 -= La12[0] * x34;
    x49 -= La12[1] * x34;
    x50 -= La12[2] * x34;
    x51 -= La12[3] * x34;
    x52 -= La13[0] * x34;
    x53 -= La13[1] * x34;
    x54 -= La13[2] * x34;
    x55 -= La13[3] * x34;
    x56 -= La14[0] * x34;
    x57 -= La14[1] * x34;
    x58 -= La14[2] * x34;
    x59 -= La14[3] * x34;
    x60 -= La15[0] * x34;
    x61 -= La15[1] * x34;
    x62 -= La15[2] * x34;
    x63 -= La15[3] * x34;
    __builtin_amdgcn_sched_barrier(0);
    La9 = *(const f32x4*)(Lt_s + 2484);
    La10 = *(const f32x4*)(Lt_s + 2488);
    La11 = *(const f32x4*)(Lt_s + 2492);
    La12 = *(const f32x4*)(Lt_s + 2496);
    La13 = *(const f32x4*)(Lt_s + 2500);
    La14 = *(const f32x4*)(Lt_s + 2504);
    La15 = *(const f32x4*)(Lt_s + 2508);
    __builtin_amdgcn_sched_barrier(0);
    x36 -= Lb9[0] * x35;
    x37 -= Lb9[1] * x35;
    x38 -= Lb9[2] * x35;
    x39 -= Lb9[3] * x35;
    x40 -= Lb10[0] * x35;
    x41 -= Lb10[1] * x35;
    x42 -= Lb10[2] * x35;
    x43 -= Lb10[3] * x35;
    x44 -= Lb11[0] * x35;
    x45 -= Lb11[1] * x35;
    x46 -= Lb11[2] * x35;
    x47 -= Lb11[3] * x35;
    x48 -= Lb12[0] * x35;
    x49 -= Lb12[1] * x35;
    x50 -= Lb12[2] * x35;
    x51 -= Lb12[3] * x35;
    x52 -= Lb13[0] * x35;
    x53 -= Lb13[1] * x35;
    x54 -= Lb13[2] * x35;
    x55 -= Lb13[3] * x35;
    x56 -= Lb14[0] * x35;
    x57 -= Lb14[1] * x35;
    x58 -= Lb14[2] * x35;
    x59 -= Lb14[3] * x35;
    x60 -= Lb15[0] * x35;
    x61 -= Lb15[1] * x35;
    x62 -= Lb15[2] * x35;
    x63 -= Lb15[3] * x35;
    __builtin_amdgcn_sched_barrier(0);
    Lb9 = *(const f32x4*)(Lt_s + 2552);
    Lb10 = *(const f32x4*)(Lt_s + 2556);
    Lb11 = *(const f32x4*)(Lt_s + 2560);
    Lb12 = *(const f32x4*)(Lt_s + 2564);
    Lb13 = *(const f32x4*)(Lt_s + 2568);
    Lb14 = *(const f32x4*)(Lt_s + 2572);
    Lb15 = *(const f32x4*)(Lt_s + 2576);
    __builtin_amdgcn_sched_barrier(0);
    x37 -= La9[1] * x36;
    x38 -= La9[2] * x36;
    x39 -= La9[3] * x36;
    x40 -= La10[0] * x36;
    x41 -= La10[1] * x36;
    x42 -= La10[2] * x36;
    x43 -= La10[3] * x36;
    x44 -= La11[0] * x36;
    x45 -= La11[1] * x36;
    x46 -= La11[2] * x36;
    x47 -= La11[3] * x36;
    x48 -= La12[0] * x36;
    x49 -= La12[1] * x36;
    x50 -= La12[2] * x36;
    x51 -= La12[3] * x36;
    x52 -= La13[0] * x36;
    x53 -= La13[1] * x36;
    x54 -= La13[2] * x36;
    x55 -= La13[3] * x36;
    x56 -= La14[0] * x36;
    x57 -= La14[1] * x36;
    x58 -= La14[2] * x36;
    x59 -= La14[3] * x36;
    x60 -= La15[0] * x36;
    x61 -= La15[1] * x36;
    x62 -= La15[2] * x36;
    x63 -= La15[3] * x36;
    __builtin_amdgcn_sched_barrier(0);
    La9 = *(const f32x4*)(Lt_s + 2620);
    La10 = *(const f32x4*)(Lt_s + 2624);
    La11 = *(const f32x4*)(Lt_s + 2628);
    La12 = *(const f32x4*)(Lt_s + 2632);
    La13 = *(const f32x4*)(Lt_s + 2636);
    La14 = *(const f32x4*)(Lt_s + 2640);
    La15 = *(const f32x4*)(Lt_s + 2644);
    __builtin_amdgcn_sched_barrier(0);
    x38 -= Lb9[2] * x37;
    x39 -= Lb9[3] * x37;
    x40 -= Lb10[0] * x37;
    x41 -= Lb10[1] * x37;
    x42 -= Lb10[2] * x37;
    x43 -= Lb10[3] * x37;
    x44 -= Lb11[0] * x37;
    x45 -= Lb11[1] * x37;
    x46 -= Lb11[2] * x37;
    x47 -= Lb11[3] * x37;
    x48 -= Lb12[0] * x37;
    x49 -= Lb12[1] * x37;
    x50 -= Lb12[2] * x37;
    x51 -= Lb12[3] * x37;
    x52 -= Lb13[0] * x37;
    x53 -= Lb13[1] * x37;
    x54 -= Lb13[2] * x37;
    x55 -= Lb13[3] * x37;
    x56 -= Lb14[0] * x37;
    x57 -= Lb14[1] * x37;
    x58 -= Lb14[2] * x37;
    x59 -= Lb14[3] * x37;
    x60 -= Lb15[0] * x37;
    x61 -= Lb15[1] * x37;
    x62 -= Lb15[2] * x37;
    x63 -= Lb15[3] * x37;
    __builtin_amdgcn_sched_barrier(0);
    Lb10 = *(const f32x4*)(Lt_s + 2692);
    Lb11 = *(const f32x4*)(Lt_s + 2696);
    Lb12 = *(const f32x4*)(Lt_s + 2700);
    Lb13 = *(const f32x4*)(Lt_s + 2704);
    Lb14 = *(const f32x4*)(Lt_s + 2708);
    Lb15 = *(const f32x4*)(Lt_s + 2712);
    __builtin_amdgcn_sched_barrier(0);
    x39 -= La9[3] * x38;
    x40 -= La10[0] * x38;
    x41 -= La10[1] * x38;
    x42 -= La10[2] * x38;
    x43 -= La10[3] * x38;
    x44 -= La11[0] * x38;
    x45 -= La11[1] * x38;
    x46 -= La11[2] * x38;
    x47 -= La11[3] * x38;
    x48 -= La12[0] * x38;
    x49 -= La12[1] * x38;
    x50 -= La12[2] * x38;
    x51 -= La12[3] * x38;
    x52 -= La13[0] * x38;
    x53 -= La13[1] * x38;
    x54 -= La13[2] * x38;
    x55 -= La13[3] * x38;
    x56 -= La14[0] * x38;
    x57 -= La14[1] * x38;
    x58 -= La14[2] * x38;
    x59 -= La14[3] * x38;
    x60 -= La15[0] * x38;
    x61 -= La15[1] * x38;
    x62 -= La15[2] * x38;
    x63 -= La15[3] * x38;
    __builtin_amdgcn_sched_barrier(0);
    La10 = *(const f32x4*)(Lt_s + 2760);
    La11 = *(const f32x4*)(Lt_s + 2764);
    La12 = *(const f32x4*)(Lt_s + 2768);
    La13 = *(const f32x4*)(Lt_s + 2772);
    La14 = *(const f32x4*)(Lt_s + 2776);
    La15 = *(const f32x4*)(Lt_s + 2780);
    __builtin_amdgcn_sched_barrier(0);
    x40 -= Lb10[0] * x39;
    x41 -= Lb10[1] * x39;
    x42 -= Lb10[2] * x39;
    x43 -= Lb10[3] * x39;
    x44 -= Lb11[0] * x39;
    x45 -= Lb11[1] * x39;
    x46 -= Lb11[2] * x39;
    x47 -= Lb11[3] * x39;
    x48 -= Lb12[0] * x39;
    x49 -= Lb12[1] * x39;
    x50 -= Lb12[2] * x39;
    x51 -= Lb12[3] * x39;
    x52 -= Lb13[0] * x39;
    x53 -= Lb13[1] * x39;
    x54 -= Lb13[2] * x39;
    x55 -= Lb13[3] * x39;
    x56 -= Lb14[0] * x39;
    x57 -= Lb14[1] * x39;
    x58 -= Lb14[2] * x39;
    x59 -= Lb14[3] * x39;
    x60 -= Lb15[0] * x39;
    x61 -= Lb15[1] * x39;
    x62 -= Lb15[2] * x39;
    x63 -= Lb15[3] * x39;
    __builtin_amdgcn_sched_barrier(0);
    Lb10 = *(const f32x4*)(Lt_s + 2828);
    Lb11 = *(const f32x4*)(Lt_s + 2832);
    Lb12 = *(const f32x4*)(Lt_s + 2836);
    Lb13 = *(const f32x4*)(Lt_s + 2840);
    Lb14 = *(const f32x4*)(Lt_s + 2844);
    Lb15 = *(const f32x4*)(Lt_s + 2848);
    __builtin_amdgcn_sched_barrier(0);
    x41 -= La10[1] * x40;
    x42 -= La10[2] * x40;
    x43 -= La10[3] * x40;
    x44 -= La11[0] * x40;
    x45 -= La11[1] * x40;
    x46 -= La11[2] * x40;
    x47 -= La11[3] * x40;
    x48 -= La12[0] * x40;
    x49 -= La12[1] * x40;
    x50 -= La12[2] * x40;
    x51 -= La12[3] * x40;
    x52 -= La13[0] * x40;
    x53 -= La13[1] * x40;
    x54 -= La13[2] * x40;
    x55 -= La13[3] * x40;
    x56 -= La14[0] * x40;
    x57 -= La14[1] * x40;
    x58 -= La14[2] * x40;
    x59 -= La14[3] * x40;
    x60 -= La15[0] * x40;
    x61 -= La15[1] * x40;
    x62 -= La15[2] * x40;
    x63 -= La15[3] * x40;
    __builtin_amdgcn_sched_barrier(0);
    La10 = *(const f32x4*)(Lt_s + 2896);
    La11 = *(const f32x4*)(Lt_s + 2900);
    La12 = *(const f32x4*)(Lt_s + 2904);
    La13 = *(const f32x4*)(Lt_s + 2908);
    La14 = *(const f32x4*)(Lt_s + 2912);
    La15 = *(const f32x4*)(Lt_s + 2916);
    __builtin_amdgcn_sched_barrier(0);
    x42 -= Lb10[2] * x41;
    x43 -= Lb10[3] * x41;
    x44 -= Lb11[0] * x41;
    x45 -= Lb11[1] * x41;
    x46 -= Lb11[2] * x41;
    x47 -= Lb11[3] * x41;
    x48 -= Lb12[0] * x41;
    x49 -= Lb12[1] * x41;
    x50 -= Lb12[2] * x41;
    x51 -= Lb12[3] * x41;
    x52 -= Lb13[0] * x41;
    x53 -= Lb13[1] * x41;
    x54 -= Lb13[2] * x41;
    x55 -= Lb13[3] * x41;
    x56 -= Lb14[0] * x41;
    x57 -= Lb14[1] * x41;
    x58 -= Lb14[2] * x41;
    x59 -= Lb14[3] * x41;
    x60 -= Lb15[0] * x41;
    x61 -= Lb15[1] * x41;
    x62 -= Lb15[2] * x41;
    x63 -= Lb15[3] * x41;
    __builtin_amdgcn_sched_barrier(0);
    Lb11 = *(const f32x4*)(Lt_s + 2968);
    Lb12 = *(const f32x4*)(Lt_s + 2972);
    Lb13 = *(const f32x4*)(Lt_s + 2976);
    Lb14 = *(const f32x4*)(Lt_s + 2980);
    Lb15 = *(const f32x4*)(Lt_s + 2984);
    __builtin_amdgcn_sched_barrier(0);
    x43 -= La10[3] * x42;
    x44 -= La11[0] * x42;
    x45 -= La11[1] * x42;
    x46 -= La11[2] * x42;
    x47 -= La11[3] * x42;
    x48 -= La12[0] * x42;
    x49 -= La12[1] * x42;
    x50 -= La12[2] * x42;
    x51 -= La12[3] * x42;
    x52 -= La13[0] * x42;
    x53 -= La13[1] * x42;
    x54 -= La13[2] * x42;
    x55 -= La13[3] * x42;
    x56 -= La14[0] * x42;
    x57 -= La14[1] * x42;
    x58 -= La14[2] * x42;
    x59 -= La14[3] * x42;
    x60 -= La15[0] * x42;
    x61 -= La15[1] * x42;
    x62 -= La15[2] * x42;
    x63 -= La15[3] * x42;
    __builtin_amdgcn_sched_barrier(0);
    La11 = *(const f32x4*)(Lt_s + 3036);
    La12 = *(const f32x4*)(Lt_s + 3040);
    La13 = *(const f32x4*)(Lt_s + 3044);
    La14 = *(const f32x4*)(Lt_s + 3048);
    La15 = *(const f32x4*)(Lt_s + 3052);
    __builtin_amdgcn_sched_barrier(0);
    x44 -= Lb11[0] * x43;
    x45 -= Lb11[1] * x43;
    x46 -= Lb11[2] * x43;
    x47 -= Lb11[3] * x43;
    x48 -= Lb12[0] * x43;
    x49 -= Lb12[1] * x43;
    x50 -= Lb12[2] * x43;
    x51 -= Lb12[3] * x43;
    x52 -= Lb13[0] * x43;
    x53 -= Lb13[1] * x43;
    x54 -= Lb13[2] * x43;
    x55 -= Lb13[3] * x43;
    x56 -= Lb14[0] * x43;
    x57 -= Lb14[1] * x43;
    x58 -= Lb14[2] * x43;
    x59 -= Lb14[3] * x43;
    x60 -= Lb15[0] * x43;
    x61 -= Lb15[1] * x43;
    x62 -= Lb15[2] * x43;
    x63 -= Lb15[3] * x43;
    __builtin_amdgcn_sched_barrier(0);
    Lb11 = *(const f32x4*)(Lt_s + 3104);
    Lb12 = *(const f32x4*)(Lt_s + 3108);
    Lb13 = *(const f32x4*)(Lt_s + 3112);
    Lb14 = *(const f32x4*)(Lt_s + 3116);
    Lb15 = *(const f32x4*)(Lt_s + 3120);
    __builtin_amdgcn_sched_barrier(0);
    x45 -= La11[1] * x44;
    x46 -= La11[2] * x44;
    x47 -= La11[3] * x44;
    x48 -= La12[0] * x44;
    x49 -= La12[1] * x44;
    x50 -= La12[2] * x44;
    x51 -= La12[3] * x44;
    x52 -= La13[0] * x44;
    x53 -= La13[1] * x44;
    x54 -= La13[2] * x44;
    x55 -= La13[3] * x44;
    x56 -= La14[0] * x44;
    x57 -= La14[1] * x44;
    x58 -= La14[2] * x44;
    x59 -= La14[3] * x44;
    x60 -= La15[0] * x44;
    x61 -= La15[1] * x44;
    x62 -= La15[2] * x44;
    x63 -= La15[3] * x44;
    __builtin_amdgcn_sched_barrier(0);
    La11 = *(const f32x4*)(Lt_s + 3172);
    La12 = *(const f32x4*)(Lt_s + 3176);
    La13 = *(const f32x4*)(Lt_s + 3180);
    La14 = *(const f32x4*)(Lt_s + 3184);
    La15 = *(const f32x4*)(Lt_s + 3188);
    __builtin_amdgcn_sched_barrier(0);
    x46 -= Lb11[2] * x45;
    x47 -= Lb11[3] * x45;
    x48 -= Lb12[0] * x45;
    x49 -= Lb12[1] * x45;
    x50 -= Lb12[2] * x45;
    x51 -= Lb12[3] * x45;
    x52 -= Lb13[0] * x45;
    x53 -= Lb13[1] * x45;
    x54 -= Lb13[2] * x45;
    x55 -= Lb13[3] * x45;
    x56 -= Lb14[0] * x45;
    x57 -= Lb14[1] * x45;
    x58 -= Lb14[2] * x45;
    x59 -= Lb14[3] * x45;
    x60 -= Lb15[0] * x45;
    x61 -= Lb15[1] * x45;
    x62 -= Lb15[2] * x45;
    x63 -= Lb15[3] * x45;
    __builtin_amdgcn_sched_barrier(0);
    Lb12 = *(const f32x4*)(Lt_s + 3244);
    Lb13 = *(const f32x4*)(Lt_s + 3248);
    Lb14 = *(const f32x4*)(Lt_s + 3252);
    Lb15 = *(const f32x4*)(Lt_s + 3256);
    __builtin_amdgcn_sched_barrier(0);
    x47 -= La11[3] * x46;
    x48 -= La12[0] * x46;
    x49 -= La12[1] * x46;
    x50 -= La12[2] * x46;
    x51 -= La12[3] * x46;
    x52 -= La13[0] * x46;
    x53 -= La13[1] * x46;
    x54 -= La13[2] * x46;
    x55 -= La13[3] * x46;
    x56 -= La14[0] * x46;
    x57 -= La14[1] * x46;
    x58 -= La14[2] * x46;
    x59 -= La14[3] * x46;
    x60 -= La15[0] * x46;
    x61 -= La15[1] * x46;
    x62 -= La15[2] * x46;
    x63 -= La15[3] * x46;
    __builtin_amdgcn_sched_barrier(0);
    La12 = *(const f32x4*)(Lt_s + 3312);
    La13 = *(const f32x4*)(Lt_s + 3316);
    La14 = *(const f32x4*)(Lt_s + 3320);
    La15 = *(const f32x4*)(Lt_s + 3324);
    __builtin_amdgcn_sched_barrier(0);
    x48 -= Lb12[0] * x47;
    x49 -= Lb12[1] * x47;
    x50 -= Lb12[2] * x47;
    x51 -= Lb12[3] * x47;
    x52 -= Lb13[0] * x47;
    x53 -= Lb13[1] * x47;
    x54 -= Lb13[2] * x47;
    x55 -= Lb13[3] * x47;
    x56 -= Lb14[0] * x47;
    x57 -= Lb14[1] * x47;
    x58 -= Lb14[2] * x47;
    x59 -= Lb14[3] * x47;
    x60 -= Lb15[0] * x47;
    x61 -= Lb15[1] * x47;
    x62 -= Lb15[2] * x47;
    x63 -= Lb15[3] * x47;
    __builtin_amdgcn_sched_barrier(0);
    Lb12 = *(const f32x4*)(Lt_s + 3380);
    Lb13 = *(const f32x4*)(Lt_s + 3384);
    Lb14 = *(const f32x4*)(Lt_s + 3388);
    Lb15 = *(const f32x4*)(Lt_s + 3392);
    __builtin_amdgcn_sched_barrier(0);
    x49 -= La12[1] * x48;
    x50 -= La12[2] * x48;
    x51 -= La12[3] * x48;
    x52 -= La13[0] * x48;
    x53 -= La13[1] * x48;
    x54 -= La13[2] * x48;
    x55 -= La13[3] * x48;
    x56 -= La14[0] * x48;
    x57 -= La14[1] * x48;
    x58 -= La14[2] * x48;
    x59 -= La14[3] * x48;
    x60 -= La15[0] * x48;
    x61 -= La15[1] * x48;
    x62 -= La15[2] * x48;
    x63 -= La15[3] * x48;
    __builtin_amdgcn_sched_barrier(0);
    La12 = *(const f32x4*)(Lt_s + 3448);
    La13 = *(const f32x4*)(Lt_s + 3452);
    La14 = *(const f32x4*)(Lt_s + 3456);
    La15 = *(const f32x4*)(Lt_s + 3460);
    __builtin_amdgcn_sched_barrier(0);
    x50 -= Lb12[2] * x49;
    x51 -= Lb12[3] * x49;
    x52 -= Lb13[0] * x49;
    x53 -= Lb13[1] * x49;
    x54 -= Lb13[2] * x49;
    x55 -= Lb13[3] * x49;
    x56 -= Lb14[0] * x49;
    x57 -= Lb14[1] * x49;
    x58 -= Lb14[2] * x49;
    x59 -= Lb14[3] * x49;
    x60 -= Lb15[0] * x49;
    x61 -= Lb15[1] * x49;
    x62 -= Lb15[2] * x49;
    x63 -= Lb15[3] * x49;
    __builtin_amdgcn_sched_barrier(0);
    Lb13 = *(const f32x4*)(Lt_s + 3520);
    Lb14 = *(const f32x4*)(Lt_s + 3524);
    Lb15 = *(const f32x4*)(Lt_s + 3528);
    __builtin_amdgcn_sched_barrier(0);
    x51 -= La12[3] * x50;
    x52 -= La13[0] * x50;
    x53 -= La13[1] * x50;
    x54 -= La13[2] * x50;
    x55 -= La13[3] * x50;
    x56 -= La14[0] * x50;
    x57 -= La14[1] * x50;
    x58 -= La14[2] * x50;
    x59 -= La14[3] * x50;
    x60 -= La15[0] * x50;
    x61 -= La15[1] * x50;
    x62 -= La15[2] * x50;
    x63 -= La15[3] * x50;
    __builtin_amdgcn_sched_barrier(0);
    La13 = *(const f32x4*)(Lt_s + 3588);
    La14 = *(const f32x4*)(Lt_s + 3592);
    La15 = *(const f32x4*)(Lt_s + 3596);
    __builtin_amdgcn_sched_barrier(0);
    x52 -= Lb13[0] * x51;
    x53 -= Lb13[1] * x51;
    x54 -= Lb13[2] * x51;
    x55 -= Lb13[3] * x51;
    x56 -= Lb14[0] * x51;
    x57 -= Lb14[1] * x51;
    x58 -= Lb14[2] * x51;
    x59 -= Lb14[3] * x51;
    x60 -= Lb15[0] * x51;
    x61 -= Lb15[1] * x51;
    x62 -= Lb15[2] * x51;
    x63 -= Lb15[3] * x51;
    __builtin_amdgcn_sched_barrier(0);
    Lb13 = *(const f32x4*)(Lt_s + 3656);
    Lb14 = *(const f32x4*)(Lt_s + 3660);
    Lb15 = *(const f32x4*)(Lt_s + 3664);
    __builtin_amdgcn_sched_barrier(0);
    x53 -= La13[1] * x52;
    x54 -= La13[2] * x52;
    x55 -= La13[3] * x52;
    x56 -= La14[0] * x52;
    x57 -= La14[1] * x52;
    x58 -= La14[2] * x52;
    x59 -= La14[3] * x52;
    x60 -= La15[0] * x52;
    x61 -= La15[1] * x52;
    x62 -= La15[2] * x52;
    x63 -= La15[3] * x52;
    __builtin_amdgcn_sched_barrier(0);
    La13 = *(const f32x4*)(Lt_s + 3724);
    La14 = *(const f32x4*)(Lt_s + 3728);
    La15 = *(const f32x4*)(Lt_s + 3732);
    __builtin_amdgcn_sched_barrier(0);
    x54 -= Lb13[2] * x53;
    x55 -= Lb13[3] * x53;
    x56 -= Lb14[0] * x53;
    x57 -= Lb14[1] * x53;
    x58 -= Lb14[2] * x53;
    x59 -= Lb14[3] * x53;
    x60 -= Lb15[0] * x53;
    x61 -= Lb15[1] * x53;
    x62 -= Lb15[2] * x53;
    x63 -= Lb15[3] * x53;
    __builtin_amdgcn_sched_barrier(0);
    Lb14 = *(const f32x4*)(Lt_s + 3796);
    Lb15 = *(const f32x4*)(Lt_s + 3800);
    __builtin_amdgcn_sched_barrier(0);
    x55 -= La13[3] * x54;
    x56 -= La14[0] * x54;
    x57 -= La14[1] * x54;
    x58 -= La14[2] * x54;
    x59 -= La14[3] * x54;
    x60 -= La15[0] * x54;
    x61 -= La15[1] * x54;
    x62 -= La15[2] * x54;
    x63 -= La15[3] * x54;
    __builtin_amdgcn_sched_barrier(0);
    La14 = *(const f32x4*)(Lt_s + 3864);
    La15 = *(const f32x4*)(Lt_s + 3868);
    __builtin_amdgcn_sched_barrier(0);
    x56 -= Lb14[0] * x55;
    x57 -= Lb14[1] * x55;
    x58 -= Lb14[2] * x55;
    x59 -= Lb14[3] * x55;
    x60 -= Lb15[0] * x55;
    x61 -= Lb15[1] * x55;
    x62 -= Lb15[2] * x55;
    x63 -= Lb15[3] * x55;
    __builtin_amdgcn_sched_barrier(0);
    Lb14 = *(const f32x4*)(Lt_s + 3932);
    Lb15 = *(const f32x4*)(Lt_s + 3936);
    __builtin_amdgcn_sched_barrier(0);
    x57 -= La14[1] * x56;
    x58 -= La14[2] * x56;
    x59 -= La14[3] * x56;
    x60 -= La15[0] * x56;
    x61 -= La15[1] * x56;
    x62 -= La15[2] * x56;
    x63 -= La15[3] * x56;
    __builtin_amdgcn_sched_barrier(0);
    La14 = *(const f32x4*)(Lt_s + 4000);
    La15 = *(const f32x4*)(Lt_s + 4004);
    __builtin_amdgcn_sched_barrier(0);
    x58 -= Lb14[2] * x57;
    x59 -= Lb14[3] * x57;
    x60 -= Lb15[0] * x57;
    x61 -= Lb15[1] * x57;
    x62 -= Lb15[2] * x57;
    x63 -= Lb15[3] * x57;
    __builtin_amdgcn_sched_barrier(0);
    Lb15 = *(const f32x4*)(Lt_s + 4072);
    __builtin_amdgcn_sched_barrier(0);
    x59 -= La14[3] * x58;
    x60 -= La15[0] * x58;
    x61 -= La15[1] * x58;
    x62 -= La15[2] * x58;
    x63 -= La15[3] * x58;
    __builtin_amdgcn_sched_barrier(0);
    La15 = *(const f32x4*)(Lt_s + 4140);
    __builtin_amdgcn_sched_barrier(0);
    x60 -= Lb15[0] * x59;
    x61 -= Lb15[1] * x59;
    x62 -= Lb15[2] * x59;
    x63 -= Lb15[3] * x59;
    __builtin_amdgcn_sched_barrier(0);
    Lb15 = *(const f32x4*)(Lt_s + 4208);
    __builtin_amdgcn_sched_barrier(0);
    x61 -= La15[1] * x60;
    x62 -= La15[2] * x60;
    x63 -= La15[3] * x60;
    __builtin_amdgcn_sched_barrier(0);
    La15 = *(const f32x4*)(Lt_s + 4276);
    __builtin_amdgcn_sched_barrier(0);
    x62 -= Lb15[2] * x61;
    x63 -= Lb15[3] * x61;
    __builtin_amdgcn_sched_barrier(0);
    __builtin_amdgcn_sched_barrier(0);
    x63 -= La15[3] * x62;
    __builtin_amdgcn_sched_barrier(0);
    __syncthreads();
    outp[0] = f2bf(sg * x0);
    outp[136] = f2bf(sg * x1);
    outp[272] = f2bf(sg * x2);
    outp[408] = f2bf(sg * x3);
    outp[544] = f2bf(sg * x4);
    outp[680] = f2bf(sg * x5);
    outp[816] = f2bf(sg * x6);
    outp[952] = f2bf(sg * x7);
    outp[1088] = f2bf(sg * x8);
    outp[1224] = f2bf(sg * x9);
    outp[1360] = f2bf(sg * x10);
    outp[1496] = f2bf(sg * x11);
    outp[1632] = f2bf(sg * x12);
    outp[1768] = f2bf(sg * x13);
    outp[1904] = f2bf(sg * x14);
    outp[2040] = f2bf(sg * x15);
    outp[2176] = f2bf(sg * x16);
    outp[2312] = f2bf(sg * x17);
    outp[2448] = f2bf(sg * x18);
    outp[2584] = f2bf(sg * x19);
    outp[2720] = f2bf(sg * x20);
    outp[2856] = f2bf(sg * x21);
    outp[2992] = f2bf(sg * x22);
    outp[3128] = f2bf(sg * x23);
    outp[3264] = f2bf(sg * x24);
    outp[3400] = f2bf(sg * x25);
    outp[3536] = f2bf(sg * x26);
    outp[3672] = f2bf(sg * x27);
    outp[3808] = f2bf(sg * x28);
    outp[3944] = f2bf(sg * x29);
    outp[4080] = f2bf(sg * x30);
    outp[4216] = f2bf(sg * x31);
    outp[4352] = f2bf(sg * x32);
    outp[4488] = f2bf(sg * x33);
    outp[4624] = f2bf(sg * x34);
    outp[4760] = f2bf(sg * x35);
    outp[4896] = f2bf(sg * x36);
    outp[5032] = f2bf(sg * x37);
    outp[5168] = f2bf(sg * x38);
    outp[5304] = f2bf(sg * x39);
    outp[5440] = f2bf(sg * x40);
    outp[5576] = f2bf(sg * x41);
    outp[5712] = f2bf(sg * x42);
    outp[5848] = f2bf(sg * x43);
    outp[5984] = f2bf(sg * x44);
    outp[6120] = f2bf(sg * x45);
    outp[6256] = f2bf(sg * x46);
    outp[6392] = f2bf(sg * x47);
    outp[6528] = f2bf(sg * x48);
    outp[6664] = f2bf(sg * x49);
    outp[6800] = f2bf(sg * x50);
    outp[6936] = f2bf(sg * x51);
    outp[7072] = f2bf(sg * x52);
    outp[7208] = f2bf(sg * x53);
    outp[7344] = f2bf(sg * x54);
    outp[7480] = f2bf(sg * x55);
    outp[7616] = f2bf(sg * x56);
    outp[7752] = f2bf(sg * x57);
    outp[7888] = f2bf(sg * x58);
    outp[8024] = f2bf(sg * x59);
    outp[8160] = f2bf(sg * x60);
    outp[8296] = f2bf(sg * x61);
    outp[8432] = f2bf(sg * x62);
    outp[8568] = f2bf(sg * x63);
}

DEV void dn_item(const Params& p, int l, int item, unsigned char* smem) {
    const int dir = item & 1, hh = (item >> 1) & 3, b = item >> 3;
    bf16_t* q_s = (bf16_t*)(smem);
    bf16_t* k_s = (bf16_t*)(smem + 17408);
    bf16_t* vnT_s = k_s;
    bf16_t* kT_s = (bf16_t*)(smem + 35840);
    bf16_t* v_s = (bf16_t*)(smem + 54272);
    bf16_t* u_s = v_s;
    float* L_s = (float*)(smem + 71680);
    bf16_t* w_s = (bf16_t*)(smem + 71680);
    bf16_t* qk_s = (bf16_t*)(smem + 89088);
    bf16_t* St_s = (bf16_t*)(smem + 98304);
    float* G_s = (float*)(smem + 133120);
    float* beta_s = G_s + 64;
    float* eG_s = G_s + 128;
    float* bw_s = G_s + 192;
    float* cw_s = G_s + 256;
    const int tid = get_tid(), lane = tid & 63, wv = tid >> 6, l15 = lane & 15, quad = lane >> 4;
    const float Aneg = -expf(p.in[I_DNALOG][(l * 2 + dir) * 4 + hh]);
    const float dtb = p.in[I_DNDT][(l * 2 + dir) * 4 + hh];
    const bf16_t* P = wsb(p, O_P);
    const float* AB = wsf(p, O_AB);
    bf16_t* TO = wsb(p, dir ? O_TA2 : O_TA);
    __syncthreads();
    for (int e = tid; e < 4 * 384; e += 256) { int j = e / 384, c = e % 384, mat = c >> 7, cc = c & 127; cw_s[e] = p.in[I_DNCONV][((size_t)l * 4 + j) * 1536 + mat * 512 + hh * 128 + cc]; }
    for (int e = tid; e < 128 * 136 / 2; e += 256) ((unsigned*)St_s)[e] = 0u;
    f32x4 Sacc[2][8];
#pragma unroll
    for (int a = 0; a < 2; ++a)
#pragma unroll
        for (int c = 0; c < 8; ++c) Sacc[a][c] = (f32x4){0.f, 0.f, 0.f, 0.f};

#pragma unroll 1
    for (int n = 0; n < 68; ++n) {
        const int c = chunk_of(dir, n);
        const int seg_lo = c < 4 ? 0 : CTXL, seg_hi = c < 4 ? CTXL : SB;
        const int base = c * 64;
        __syncthreads();
        if (wv == 0) {
            const int s = dir ? base + 63 - lane : base + lane;
            const size_t row = (size_t)b * SB + s;
            const float al = AB[row * 16 + dir * 4 + hh], bb = AB[row * 16 + 8 + dir * 4 + hh];
            float g = Aneg * softplus_fast(al + dtb);
#pragma unroll
            for (int o = 1; o < 64; o <<= 1) { float t = __shfl_up(g, o); if (lane >= o) g += t; }
            const float eg_ = expf(g), bt_ = sigm(bb); G_s[lane] = g; beta_s[lane] = bt_; eG_s[lane] = eg_; bw_s[lane] = bt_ * eg_;
        }
        __syncthreads();
        const float Glast = G_s[63];
        {
            const int i = tid >> 2, seg = tid & 3;
            const int s = dir ? base + 63 - i : base + i;
            const float kscale = expf(Glast - G_s[i]);
#pragma unroll 1
            for (int mat = 0; mat < 3; ++mat) {
                float v[32];
#pragma unroll
                for (int e = 0; e < 32; ++e) v[e] = 0.f;
#pragma unroll
                for (int j = 0; j < 4; ++j) {
                    const int ss = s + j - 1;
                    if (ss >= seg_lo && ss < seg_hi) {
                        const u32x4* src = (const u32x4*)(P + ((size_t)b * SB + ss) * PW + mat * 512 + hh * 128 + seg * 32);
                        const float* cw = cw_s + j * 384 + mat * 128 + seg * 32;
#pragma unroll
                        for (int q = 0; q < 4; ++q) { u32x4 x = src[q];
#pragma unroll
                            for (int e = 0; e < 4; ++e) { v[q * 8 + 2 * e] += cw[q * 8 + 2 * e] * lo16(x[e]); v[q * 8 + 2 * e + 1] += cw[q * 8 + 2 * e + 1] * hi16(x[e]); } }
                    }
                }
                float ss2 = 0.f;
#pragma unroll
                for (int e = 0; e < 32; ++e) { v[e] = silu(v[e]); ss2 += v[e] * v[e]; }
                ss2 += __shfl_xor(ss2, 1); ss2 += __shfl_xor(ss2, 2);
                if (mat == 0) {
                    const float sc = rsqrtf(ss2 + 1e-6f) * 0.08838834764831845f;
#pragma unroll
                    for (int e = 0; e < 32; ++e) q_s[i * 136 + seg * 32 + e] = f2bf(v[e] * sc);
                } else if (mat == 1) {
                    const float sc = rsqrtf(ss2 + 1e-6f);
#pragma unroll
                    for (int e = 0; e < 32; ++e) { const float kv = v[e] * sc; k_s[i * 136 + seg * 32 + e] = f2bf(kv); kT_s[(seg * 32 + e) * 72 + i] = f2bf(kv * kscale); }
                } else {
#pragma unroll
                    for (int e = 0; e < 32; ++e) v_s[i * 136 + seg * 32 + e] = f2bf(v[e]);
                }
            }
        }
        __syncthreads();
        {
            bf16x8 ak[4], aq[4];
#pragma unroll
            for (int ks = 0; ks < 4; ++ks) { ak[ks] = *(const bf16x8*)(k_s + (wv * 16 + l15) * 136 + ks * 32 + quad * 8); aq[ks] = *(const bf16x8*)(q_s + (wv * 16 + l15) * 136 + ks * 32 + quad * 8); }
#pragma unroll
            for (int nt = 0; nt < 4; ++nt) {
                f32x4 kk = {0.f, 0.f, 0.f, 0.f}, qq = {0.f, 0.f, 0.f, 0.f};
#pragma unroll
                for (int ks = 0; ks < 4; ++ks) { bf16x8 bk = *(const bf16x8*)(k_s + (nt * 16 + l15) * 136 + ks * 32 + quad * 8); kk = mfma16(ak[ks], bk, kk); qq = mfma16(aq[ks], bk, qq); }
                const int jj = nt * 16 + l15; const float Gj = G_s[jj];
                f32x4 lv;
#pragma unroll
                for (int j = 0; j < 4; ++j) {
                    const int i = wv * 16 + quad * 4 + j;
                    const float dec = jj <= i ? expf(G_s[i] - Gj) : 0.f;
                    lv[j] = jj < i ? beta_s[i] * kk[j] * dec : 0.f;
                    qk_s[i * 72 + jj] = f2bf(qq[j] * dec);
                }
                *(f32x4*)(L_s + jj * 68 + wv * 16 + quad * 4) = lv;
            }
        }
        __syncthreads();
        dn_solve(L_s, tid < 128 ? (k_s + tid) : (v_s + (tid - 128)), tid < 128 ? bw_s : beta_s, tid < 128 ? -1.f : 1.f, tid < 128 ? (w_s + tid) : (u_s + (tid - 128)));
        __syncthreads();
        {
            f32x4 vn[8], o1[8];
#pragma unroll
            for (int nt = 0; nt < 8; ++nt) {
#pragma unroll
                for (int j = 0; j < 4; ++j) vn[nt][j] = bf2f(u_s[(wv * 16 + quad * 4 + j) * 136 + nt * 16 + l15]);
                o1[nt] = (f32x4){0.f, 0.f, 0.f, 0.f};
            }
            bf16x8 aw[4], aq[4];
#pragma unroll
            for (int ks = 0; ks < 4; ++ks) { aw[ks] = *(const bf16x8*)(w_s + (wv * 16 + l15) * 136 + ks * 32 + quad * 8); aq[ks] = *(const bf16x8*)(q_s + (wv * 16 + l15) * 136 + ks * 32 + quad * 8); }
#pragma unroll
            for (int nt = 0; nt < 8; ++nt)
#pragma unroll
                for (int ks = 0; ks < 4; ++ks) { bf16x8 bs = *(const bf16x8*)(St_s + (nt * 16 + l15) * 136 + ks * 32 + quad * 8); vn[nt] = mfma16(aw[ks], bs, vn[nt]); o1[nt] = mfma16(aq[ks], bs, o1[nt]); }
#pragma unroll
            for (int nt = 0; nt < 8; ++nt) { u32x2 o; o.x = pack2(vn[nt][0], vn[nt][1]); o.y = pack2(vn[nt][2], vn[nt][3]); *(u32x2*)(vnT_s + (nt * 16 + l15) * 72 + wv * 16 + quad * 4) = o; }
            __syncthreads();
            float eg[4];
#pragma unroll
            for (int j = 0; j < 4; ++j) eg[j] = eG_s[wv * 16 + quad * 4 + j];
            bf16x8 aqk[2], akt[2][2];
#pragma unroll
            for (int ks = 0; ks < 2; ++ks) {
                aqk[ks] = *(const bf16x8*)(qk_s + (wv * 16 + l15) * 72 + ks * 32 + quad * 8);
                akt[0][ks] = *(const bf16x8*)(kT_s + (wv * 32 + l15) * 72 + ks * 32 + quad * 8);
                akt[1][ks] = *(const bf16x8*)(kT_s + (wv * 32 + 16 + l15) * 72 + ks * 32 + quad * 8);
            }
            const float gend = eG_s[63];
            const size_t orow0 = (size_t)b * SB;
#pragma unroll
            for (int nt = 0; nt < 8; ++nt) {
                f32x4 o;
#pragma unroll
                for (int j = 0; j < 4; ++j) { o[j] = o1[nt][j] * eg[j]; Sacc[0][nt][j] *= gend; Sacc[1][nt][j] *= gend; }
#pragma unroll
                for (int ks = 0; ks < 2; ++ks) {
                    bf16x8 bv = *(const bf16x8*)(vnT_s + (nt * 16 + l15) * 72 + ks * 32 + quad * 8);
                    o = mfma16(aqk[ks], bv, o);
                    Sacc[0][nt] = mfma16(akt[0][ks], bv, Sacc[0][nt]);
                    Sacc[1][nt] = mfma16(akt[1][ks], bv, Sacc[1][nt]);
                }
#pragma unroll
                for (int j = 0; j < 4; ++j) {
                    const int i = wv * 16 + quad * 4 + j;
                    const int s = dir ? base + 63 - i : base + i;
                    TO[(orow0 + s) * 512 + hh * 128 + nt * 16 + l15] = f2bf(o[j]);
                }
#pragma unroll
                for (int mt = 0; mt < 2; ++mt) { u32x2 sv; sv.x = pack2(Sacc[mt][nt][0], Sacc[mt][nt][1]); sv.y = pack2(Sacc[mt][nt][2], Sacc[mt][nt][3]);
                    *(u32x2*)(St_s + (nt * 16 + l15) * 136 + wv * 32 + mt * 16 + quad * 4) = sv; }
            }
        }
    }
}

DEV void lru_item(const Params& p, int l, int item, unsigned char* smem) {
    const int g = item & 7, b = item >> 3;
    bf16_t* Wt_s = (bf16_t*)smem;
    bf16_t* xbh_s = Wt_s + 2 * 128 * 72;
    float* xbf_s = (float*)(smem + 36864 + 18432);
    float* a_s = xbf_s + 2 * 64 * 65;
    float* cw_s = a_s + 2 * 64 * 65;
    const int tid = get_tid(), lane = tid & 63, wv = tid >> 6, l15 = lane & 15, quad = lane >> 4;
    bf16_t* P = wsb(p, O_P);
    bf16_t* HF = wsb(p, O_U);
    __syncthreads();
    for (int e = tid; e < 320; e += 256) cw_s[e] = e < 256 ? p.in[I_LCW][((size_t)l * 4 + (e >> 6)) * 512 + g * 64 + (e & 63)] : p.in[I_LCB][l * 512 + g * 64 + (e - 256)];
    for (int e = tid; e < 2 * 4096; e += 256) {
        const int d = e >> 12, ch = (e >> 6) & 63, j = e & 63;
        const size_t wi_ = (((size_t)l * 2 + d) * 8 + g) * 4096 + ch * 64 + j;
        Wt_s[(d * 128 + j) * 72 + ch] = f2bf(p.in[I_LWA][wi_]);
        Wt_s[(d * 128 + 64 + j) * 72 + ch] = f2bf(p.in[I_LWI][wi_]);
    }
    float ba_[2][4], bi_[2][4], sp_[2][4];
#pragma unroll
    for (int d = 0; d < 2; ++d)
#pragma unroll
        for (int nt = 0; nt < 4; ++nt) {
            const int ch = (l * 2 + d) * 512 + g * 64 + nt * 16 + l15;
            ba_[d][nt] = p.in[I_LBA][ch]; bi_[d][nt] = p.in[I_LBI][ch]; sp_[d][nt] = softplus(-p.in[I_LLAM][ch]);
        }
    float hc = 0.f;
    const int i = tid >> 2, seg = tid & 3, j0 = seg * 16;
#pragma unroll 1
    for (int n = 0; n < 68; ++n) {
        const int cf = n, cb = chunk_of(1, n);
        __syncthreads();
#pragma unroll
        for (int d = 0; d < 2; ++d) {
            const int c = d ? cb : cf;
            const int seg_lo = c < 4 ? 0 : CTXL, seg_hi = c < 4 ? CTXL : SB;
            const int s = d ? c * 64 + 63 - i : c * 64 + i;
            float v[16];
#pragma unroll
            for (int e = 0; e < 16; ++e) v[e] = cw_s[256 + j0 + e];
#pragma unroll
            for (int j = 0; j < 4; ++j) {
                const int ss = s + j - 1;
                if (ss >= seg_lo && ss < seg_hi) {
                    const u32x4* src = (const u32x4*)(P + ((size_t)b * SB + ss) * PW + C_LX + g * 64 + j0);
                    const float* cw = cw_s + j * 64 + j0;
#pragma unroll
                    for (int q = 0; q < 2; ++q) { u32x4 x = src[q];
#pragma unroll
                        for (int e = 0; e < 4; ++e) { v[q * 8 + 2 * e] += cw[q * 8 + 2 * e] * lo16(x[e]); v[q * 8 + 2 * e + 1] += cw[q * 8 + 2 * e + 1] * hi16(x[e]); } }
                }
            }
            u32x4 h0, h1;
#pragma unroll
            for (int e = 0; e < 4; ++e) { h0[e] = pack2(v[2 * e], v[2 * e + 1]); h1[e] = pack2(v[8 + 2 * e], v[8 + 2 * e + 1]); }
            *(u32x4*)(xbh_s + (d * 64 + i) * 72 + j0) = h0; *(u32x4*)(xbh_s + (d * 64 + i) * 72 + j0 + 8) = h1;
#pragma unroll
            for (int e = 0; e < 16; ++e) xbf_s[(d * 64 + i) * 65 + j0 + e] = v[e];
        }
        __syncthreads();
#pragma unroll
        for (int d = 0; d < 2; ++d) {
            f32x4 acc[8];
#pragma unroll
            for (int nt = 0; nt < 8; ++nt) acc[nt] = (f32x4){0.f, 0.f, 0.f, 0.f};
            bf16x8 af[2];
#pragma unroll
            for (int ks = 0; ks < 2; ++ks) af[ks] = *(const bf16x8*)(xbh_s + (d * 64 + wv * 16 + l15) * 72 + ks * 32 + quad * 8);
#pragma unroll
            for (int nt = 0; nt < 8; ++nt)
#pragma unroll
                for (int ks = 0; ks < 2; ++ks) { bf16x8 bw = *(const bf16x8*)(Wt_s + (d * 128 + nt * 16 + l15) * 72 + ks * 32 + quad * 8); acc[nt] = mfma16(af[ks], bw, acc[nt]); }
#pragma unroll
            for (int nt = 0; nt < 4; ++nt)
#pragma unroll
                for (int jj = 0; jj < 4; ++jj) {
                    const int idx = (d * 64 + wv * 16 + quad * 4 + jj) * 65 + nt * 16 + l15;
                    const float r = sigm(acc[nt][jj] + ba_[d][nt]), ig = sigm(acc[nt + 4][jj] + bi_[d][nt]);
                    const float la = -8.f * r * sp_[d][nt];
                    a_s[idx] = expf(la);
                    xbf_s[idx] = sqrtf(fmaxf(1.f - expf(2.f * la), 0.f)) * (ig * xbf_s[idx]);
                }
        }
        __syncthreads();
        if (wv < 2) {
            const int o = wv * 64 * 65 + lane;
#pragma unroll 16
            for (int r = 0; r < 64; ++r) { hc = a_s[o + r * 65] * hc + xbf_s[o + r * 65]; xbf_s[o + r * 65] = hc; }
        }
        __syncthreads();
#pragma unroll
        for (int d = 0; d < 2; ++d) {
            const int c = d ? cb : cf;
            const int s = d ? c * 64 + 63 - i : c * 64 + i;
            const bool second = d ? (cb < n) : ((cf < 4 ? 3 - cf : 71 - cf) < n);
            const size_t row = (size_t)b * SB + s;
            const float* hp = xbf_s + (d * 64 + i) * 65 + j0;
            bf16_t* hf = HF + row * 512 + g * 64 + j0;
            if (!second) {
                u32x4 o0, o1;
#pragma unroll
                for (int e = 0; e < 4; ++e) { o0[e] = pack2(hp[2 * e], hp[2 * e + 1]); o1[e] = pack2(hp[8 + 2 * e], hp[8 + 2 * e + 1]); }
                *(u32x4*)hf = o0; *(u32x4*)(hf + 8) = o1;
            } else {
                bf16_t* gp = P + row * PW + C_LG + g * 64 + j0;
                u32x4 f0 = *(const u32x4*)hf, f1 = *(const u32x4*)(hf + 8), g0 = *(const u32x4*)gp, g1 = *(const u32x4*)(gp + 8), o0, o1;
#pragma unroll
                for (int e = 0; e < 4; ++e) {
                    o0[e] = pack2((lo16(f0[e]) + hp[2 * e]) * gelu_tanh(lo16(g0[e])), (hi16(f0[e]) + hp[2 * e + 1]) * gelu_tanh(hi16(g0[e])));
                    o1[e] = pack2((lo16(f1[e]) + hp[8 + 2 * e]) * gelu_tanh(lo16(g1[e])), (hi16(f1[e]) + hp[8 + 2 * e + 1]) * gelu_tanh(hi16(g1[e])));
                }
                *(u32x4*)gp = o0; *(u32x4*)(gp + 8) = o1;
            }
        }
    }
}

DEV void att_item(const Params& p, int l, int b, int h, int qt, float lam_init, unsigned char* smem) {
    bf16_t* K_s = (bf16_t*)smem;
    bf16_t* V_s = (bf16_t*)(smem + 2 * 17408);
    const int tid = get_tid(), lane = tid & 63, wv = tid >> 6, l15 = lane & 15, quad = lane >> 4;
    bf16_t* P = wsb(p, O_P);
    const bf16_t* VT = wsb(p, O_VT) + (size_t)(b * 4 + h) * 128 * SB;
    const int nt_keys = (qt < 2 ? CTXL : SB) / 64;
    float lam;
    {
        const float* lv = p.in[I_DALAM] + l * 256;
        float s1 = lv[lane] * lv[64 + lane], s2 = lv[128 + lane] * lv[192 + lane];
#pragma unroll
        for (int o = 32; o >= 1; o >>= 1) { s1 += __shfl_xor(s1, o); s2 += __shfl_xor(s2, o); }
        lam = expf(s1) - expf(s2) + lam_init;
    }
    bf16x8* Qst = (bf16x8*)(smem + 71680) + (wv * 8) * 64 + lane;
#pragma unroll
    for (int qg = 0; qg < 2; ++qg) {
        const bf16_t* qp = P + ((size_t)b * SB + qt * 128 + wv * 32 + qg * 16 + l15) * PW + C_DAQ + h * 128;
#pragma unroll
        for (int wh = 0; wh < 2; ++wh)
#pragma unroll
            for (int ks = 0; ks < 2; ++ks) Qst[(wh * 4 + qg * 2 + ks) * 64] = *(const bf16x8*)(qp + wh * 64 + ks * 32 + quad * 8);
    }
    f32x4 O[2][8][2];
    float mrun[2][2], lrun[2][2];
#pragma unroll
    for (int wh = 0; wh < 2; ++wh)
#pragma unroll
        for (int qg = 0; qg < 2; ++qg) { mrun[wh][qg] = -1e30f; lrun[wh][qg] = 0.f;
#pragma unroll
            for (int dg = 0; dg < 8; ++dg) O[wh][dg][qg] = (f32x4){0.f, 0.f, 0.f, 0.f}; }
    const int kr = tid >> 2, kseg = (tid & 3) * 32;
    const int kpos = ((kr >> 5) * 2 + ((kr & 7) >> 2)) * 16 + ((kr & 31) >> 3) * 4 + (kr & 3);
    const bf16_t* kg_ = P + ((size_t)b * SB + kr) * PW + C_DAK + h * 128 + kseg;
    const int vr = tid >> 1, vh = (tid & 1) * 32;
    const bf16_t* vg_ = VT + (size_t)vr * SB + vh;
    u32x4 kreg[4], vreg[4];
#pragma unroll
    for (int i = 0; i < 4; ++i) { kreg[i] = *(const u32x4*)(kg_ + i * 8); vreg[i] = *(const u32x4*)(vg_ + i * 8); }
    __syncthreads();
#pragma unroll
    for (int i = 0; i < 4; ++i) { *(u32x4*)(K_s + kpos * 136 + kseg + i * 8) = kreg[i]; *(u32x4*)(V_s + vr * 72 + vh + i * 8) = vreg[i]; }
    __syncthreads();
    const float L2E = 1.4426950408889634f;
#pragma unroll 1
    for (int t = 0; t < nt_keys; ++t) {
        const bf16_t* Kb = K_s + (t & 1) * (64 * 136);
        const bf16_t* Vb = V_s + (t & 1) * (128 * 72);
        if (t + 1 < nt_keys) {
#pragma unroll
            for (int i = 0; i < 4; ++i) { kreg[i] = *(const u32x4*)(kg_ + (size_t)(t + 1) * 64 * PW + i * 8); vreg[i] = *(const u32x4*)(vg_ + (t + 1) * 64 + i * 8); }
        }
#pragma unroll
        for (int wh = 0; wh < 2; ++wh) {
            f32x4 S[4][2];
#pragma unroll
            for (int kg = 0; kg < 4; ++kg) { S[kg][0] = (f32x4){0.f, 0.f, 0.f, 0.f}; S[kg][1] = (f32x4){0.f, 0.f, 0.f, 0.f}; }
#pragma unroll
            for (int ks = 0; ks < 2; ++ks)
#pragma unroll
                for (int kg = 0; kg < 4; ++kg) {
                    bf16x8 kf = *(const bf16x8*)(Kb + (kg * 16 + l15) * 136 + wh * 64 + ks * 32 + quad * 8);
                    S[kg][0] = mfma16(kf, Qst[(wh * 4 + 0 + ks) * 64], S[kg][0]);
                    S[kg][1] = mfma16(kf, Qst[(wh * 4 + 2 + ks) * 64], S[kg][1]);
                }
            bf16x8 Pf[2][2];
#pragma unroll
            for (int qg = 0; qg < 2; ++qg) {
                float mx = -1e30f;
#pragma unroll
                for (int kg = 0; kg < 4; ++kg)
#pragma unroll
                    for (int j = 0; j < 4; ++j) mx = fmaxf(mx, S[kg][qg][j]);
                mx = fmaxf(mx, __shfl_xor(mx, 16)); mx = fmaxf(mx, __shfl_xor(mx, 32));
                const float mnew = fmaxf(mrun[wh][qg], mx * L2E);
                const float alpha = __builtin_amdgcn_exp2f(mrun[wh][qg] - mnew);
                mrun[wh][qg] = mnew;
                float ps = 0.f;
#pragma unroll
                for (int kg = 0; kg < 4; ++kg)
#pragma unroll
                    for (int j = 0; j < 4; ++j) { float pv = __builtin_amdgcn_exp2f(S[kg][qg][j] * L2E - mnew); ps += pv; S[kg][qg][j] = pv; }
                lrun[wh][qg] = lrun[wh][qg] * alpha + ps;
#pragma unroll
                for (int dg = 0; dg < 8; ++dg)
#pragma unroll
                    for (int j = 0; j < 4; ++j) O[wh][dg][qg][j] *= alpha;
#pragma unroll
                for (int s_ = 0; s_ < 2; ++s_) {
                    u32x4 pk; pk[0] = pack2(S[2 * s_][qg][0], S[2 * s_][qg][1]); pk[1] = pack2(S[2 * s_][qg][2], S[2 * s_][qg][3]);
                    pk[2] = pack2(S[2 * s_ + 1][qg][0], S[2 * s_ + 1][qg][1]); pk[3] = pack2(S[2 * s_ + 1][qg][2], S[2 * s_ + 1][qg][3]);
                    Pf[qg][s_] = __builtin_bit_cast(bf16x8, pk);
                }
            }
#pragma unroll
            for (int dg = 0; dg < 8; ++dg)
#pragma unroll
                for (int s_ = 0; s_ < 2; ++s_) {
                    bf16x8 vf = *(const bf16x8*)(Vb + (dg * 16 + l15) * 72 + s_ * 32 + quad * 8);
                    O[wh][dg][0] = mfma16(vf, Pf[0][s_], O[wh][dg][0]);
                    O[wh][dg][1] = mfma16(vf, Pf[1][s_], O[wh][dg][1]);
                }
        }
        if (t + 1 < nt_keys) {
            bf16_t* Kn = K_s + ((t + 1) & 1) * (64 * 136); bf16_t* Vn = V_s + ((t + 1) & 1) * (128 * 72);
#pragma unroll
            for (int i = 0; i < 4; ++i) { *(u32x4*)(Kn + kpos * 136 + kseg + i * 8) = kreg[i]; *(u32x4*)(Vn + vr * 72 + vh + i * 8) = vreg[i]; }
        }
        __syncthreads();
    }
    const float* dnw = p.in[I_DANORM] + l * 128;
#pragma unroll
    for (int qg = 0; qg < 2; ++qg) {
        float l1 = lrun[0][qg], l2 = lrun[1][qg];
        l1 += __shfl_xor(l1, 16); l1 += __shfl_xor(l1, 32); l2 += __shfl_xor(l2, 16); l2 += __shfl_xor(l2, 32);
        const float i1 = 1.f / l1, i2 = lam / l2;
        float ss = 0.f;
#pragma unroll
        for (int dg = 0; dg < 8; ++dg)
#pragma unroll
            for (int j = 0; j < 4; ++j) { float o = O[0][dg][qg][j] * i1 - O[1][dg][qg][j] * i2; O[0][dg][qg][j] = o; ss += o * o; }
        ss += __shfl_xor(ss, 16); ss += __shfl_xor(ss, 32);
        const float rstd = rsqrtf(ss * (1.f / 128.f) + 1e-5f) * (1.f - lam_init);
        bf16_t* op = P + ((size_t)b * SB + qt * 128 + wv * 32 + qg * 16 + l15) * PW + C_DAQ + h * 128;
#pragma unroll
        for (int dg = 0; dg < 8; ++dg) {
            const int dv0 = dg * 16 + quad * 4;
            u32x2 o; o.x = pack2(O[0][dg][qg][0] * rstd * dnw[dv0], O[0][dg][qg][1] * rstd * dnw[dv0 + 1]);
            o.y = pack2(O[0][dg][qg][2] * rstd * dnw[dv0 + 2], O[0][dg][qg][3] * rstd * dnw[dv0 + 3]);
            *(u32x2*)(op + dv0) = o;
        }
    }
}

DEV void phase_mix(const Params& p, int l, unsigned char* smem) {
    const bool need_ctx = l == 0;
    const float lam_init = l == 0 ? 0.2f : 0.35550906759096926f;
    unsigned* ctr = (unsigned*)(p.ws + O_CTL) + l;
    __shared__ int s_item;
    const int nqt = need_ctx ? 34 : 32;
    const int total = 64 + 64 + 32 * nqt;
    auto next = [&]() -> int {
        __syncthreads();
        if (threadIdx.x == 0) s_item = (int)atomicAdd(ctr, 1u);
        __syncthreads();
        return __builtin_amdgcn_readfirstlane(s_item);
    };
    int it = next();
#pragma unroll 1
    while (it < 64) { dn_item(p, l, it, smem); it = next(); }
#pragma unroll 1
    while (it < 128) { lru_item(p, l, it - 64, smem); it = next(); }
#pragma unroll 1
    while (it < total) {
        const int a = it - 128, bh = a / nqt, idx = a % nqt;
        const int qt = idx < 32 ? idx + 2 : idx - 32;
        att_item(p, l, bh >> 2, bh & 3, qt, lam_init, smem);
        it = next();
    }
}

constexpr int NPHASE = 1 + 2 * 9 + 1;
DEV void run_phase(const Params& p, int ph, unsigned char* smem) {
    if (ph == 0) { phase_mod(p, smem); phase_rope(p); __syncthreads(); phase_wconv(p, 0, smem); return; }
    if (ph == NPHASE - 1) { phase_final(p); return; }
    const int l = (ph - 1) / 9, q = (ph - 1) % 9;
    const bool first = l == 0, lat = l == 1;
    const bf16_t* W = wsb(p, O_WT);
    switch (q) {
        case 0: if (l == 1) phase_wconv(p, 1, smem); phase_norm(p, l, 0, first, false); break;
        case 1: phase_g1(p, smem); break;
        case 2: phase_mix(p, l, smem); break;
        case 3: phase_fin_norm(p, l, first, lat); break;
        case 4: phase_gate(p, lat, smem); break;
        case 5: phase_resid(p, l, wsb(p, O_U), D, W + W_OUT, 1024, 2, first, lat, smem); break;
        case 6: phase_norm(p, l, 1, false, lat); break;
        case 7: phase_gu(p, lat, smem); break;
        case 8: phase_resid(p, l, wsb(p, O_P), PW, W + W_DN, DFF, 5, false, lat, smem); break;
    }
}

#if MEGA
__global__ void __launch_bounds__(256) mega_kernel(Params p) {
    extern __shared__ __align__(16) unsigned char smem[];
    cg::grid_group grid = cg::this_grid();
    phase_mod(p, smem); phase_rope(p); __syncthreads(); phase_wconv(p, 0, smem);
    grid.sync();
    const bf16_t* W = wsb(p, O_WT);
#pragma unroll
    for (int l = 0; l < 2; ++l) {
        const bool first = l == 0, lat = l == 1;
        if (l == 1) phase_wconv(p, 1, smem);
        phase_norm(p, l, 0, first, false);
        grid.sync();
        phase_g1(p, smem);
        grid.sync();
        phase_mix(p, l, smem);
        grid.sync();
        phase_fin_norm(p, l, first, lat);
        grid.sync();
        phase_gate(p, lat, smem);
        grid.sync();
        phase_merge(p, lat, smem);
        grid.sync();
        phase_resid(p, l, wsb(p, O_U), D, W + W_OUT, 1024, 2, first, lat, smem);
        grid.sync();
        phase_norm(p, l, 1, false, lat);
        grid.sync();
        phase_gu(p, lat, smem);
        grid.sync();
        phase_resid(p, l, wsb(p, O_P), PW, W + W_DN, DFF, 5, false, lat, smem);
        grid.sync();
    }
    phase_final(p);
}
#else
__global__ void __launch_bounds__(256) phase_kernel(Params p, int ph) {
    extern __shared__ __align__(16) unsigned char smem[];
    run_phase(p, ph, smem);
}
#endif

extern "C" void kernel_launch(void* const* d_in, const int* in_sizes, int n_in, void* d_out, int out_size, void* d_ws, size_t ws_size, hipStream_t stream) {
    static int grid = 0;
    if (grid == 0) {
        if (n_in != 28 || ws_size < WS_END) { fprintf(stderr, "kernel_launch: unexpected n_in %d or ws_size %zu < %zu\n", n_in, ws_size, (size_t)WS_END); grid = -1; return; }
        int dev = 0, cus = 0, per_cu = 0;
        hipGetDevice(&dev);
        hipDeviceGetAttribute(&cus, hipDeviceAttributeMultiprocessorCount, dev);
#if MEGA
        hipFuncSetAttribute((const void*)mega_kernel, hipFuncAttributeMaxDynamicSharedMemorySize, LDS_BYTES);
        hipOccupancyMaxActiveBlocksPerMultiprocessor(&per_cu, (const void*)mega_kernel, 256, LDS_BYTES);
#else
        hipFuncSetAttribute((const void*)phase_kernel, hipFuncAttributeMaxDynamicSharedMemorySize, LDS_BYTES);
        hipOccupancyMaxActiveBlocksPerMultiprocessor(&per_cu, (const void*)phase_kernel, 256, LDS_BYTES);
#endif
        if (per_cu < 1) per_cu = 1;
        grid = cus * per_cu;
        fprintf(stderr, "kernel_launch: grid %d (%d CUs x %d)\n", grid, cus, per_cu);
    }
    if (grid < 0) return;
    hipMemsetAsync((char*)d_ws + O_CTL, 0, 4096, stream);
    Params p{};
    for (int i = 0; i < 28; ++i) p.in[i] = (const float*)d_in[i];
    p.out = (float*)d_out; p.ws = (unsigned char*)d_ws;
#if MEGA
    void* args[] = {&p};
    hipError_t e = hipLaunchCooperativeKernel((const void*)mega_kernel, dim3(grid), dim3(256), args, LDS_BYTES, stream);
    if (e != hipSuccess) fprintf(stderr, "cooperative launch failed: %s (grid %d)\n", hipGetErrorString(e), grid);
#else
    for (int ph = 0; ph < NPHASE; ++ph) hipLaunchKernelGGL(phase_kernel, dim3(grid), dim3(256), LDS_BYTES, stream, p, ph);
#endif
}
```

```cpp
#include <hip/hip_runtime.h>
#include <hip/hip_cooperative_groups.h>
#include <cstdio>
#include <cstdint>
namespace cg = cooperative_groups;

#ifndef MEGA
#define MEGA 1
#endif

typedef unsigned short bf16_t;
typedef short bf16x8 __attribute__((ext_vector_type(8)));
typedef float f32x4 __attribute__((ext_vector_type(4)));
typedef unsigned u32x4 __attribute__((ext_vector_type(4)));
typedef unsigned u32x2 __attribute__((ext_vector_type(2)));
#define DEV __device__ __forceinline__

constexpr int D = 1024, NB = 8, SEQ = 4096, CTXL = 256, SB = 4352, MR = NB * SB, PW = 4096, DFF = 2816;
constexpr int C_DNQ = 0, C_DNK = 512, C_DNV = 1024, C_DNZ = 1536, C_LX = 2048, C_LG = 2560, C_DAQ = 3072, C_DAK = 3584;
constexpr int NIN = 4736;
constexpr int GLD = 72;

enum { I_X = 0, I_C, I_CTX, I_CCTX, I_WMOD, I_BMOD, I_NMIX, I_NFFN, I_WIN, I_DNCONV, I_DNALOG, I_DNDT, I_DNNORM, I_LCW, I_LCB,
       I_LWA, I_LBA, I_LWI, I_LBI, I_LLAM, I_DALAM, I_DANORM, I_WBR, I_WOUT, I_WFG, I_WFU, I_WFD, I_NFIN };

constexpr size_t al256(size_t x) { return (x + 255) & ~(size_t)255; }
constexpr size_t O_CTL = 0;
constexpr size_t O_MOD = 4096;
constexpr size_t O_ROPE = al256(O_MOD + (size_t)2 * 9 * 6144 * 4);
constexpr size_t O_WT = al256(O_ROPE + 64 * 16 * 2 * 4);
constexpr size_t W_IN = 0, W_GATE = W_IN + (size_t)NIN * 1024, W_BR = W_GATE + (size_t)3072 * 1024, W_OUT = W_BR + (size_t)3 * 1024 * 512,
                 W_GU = W_OUT + (size_t)1024 * 1024, W_DN = W_GU + (size_t)5632 * 1024, W_END = W_DN + (size_t)1024 * 2816;
constexpr size_t O_HCTX = al256(O_WT + W_END * 2);
constexpr size_t O_U = al256(O_HCTX + (size_t)2048 * 1024 * 4);
constexpr size_t O_P = al256(O_U + (size_t)MR * 1024 * 2);
constexpr size_t O_AB = al256(O_P + (size_t)MR * PW * 2);
constexpr size_t O_TA = al256(O_AB + (size_t)MR * 16 * 4);
constexpr size_t O_TA2 = al256(O_TA + (size_t)MR * 512 * 2);
constexpr size_t O_VT = al256(O_TA2 + (size_t)MR * 512 * 2);
constexpr size_t WS_END = al256(O_VT + (size_t)MR * 512 * 2);

constexpr int LDS_BYTES = 140 * 1024;

struct Params {
    const float* in[28];
    float* out;
    unsigned char* ws;
};

DEV int get_tid() { int t = threadIdx.x; asm volatile("" : "+v"(t)); return t; }
DEV float bf2f(bf16_t h) { return __uint_as_float(((unsigned)h) << 16); }
DEV bf16_t f2bf(float f) { unsigned u = __float_as_uint(f); u += 0x7fffu + ((u >> 16) & 1u); return (bf16_t)(u >> 16); }
DEV unsigned pack2(float a, float b) { return (unsigned)f2bf(a) | ((unsigned)f2bf(b) << 16); }
DEV float sigm(float x) { return __builtin_amdgcn_rcpf(1.f + __expf(-x)); }
DEV float silu(float x) { return x * __builtin_amdgcn_rcpf(1.f + __expf(-x)); }
DEV float softplus(float x) { return x > 20.f ? x : log1pf(expf(x)); }
DEV float softplus_fast(float x) { const float e = __expf(x); return x > 15.f ? x : (e < 0.01f ? e * (1.f - e * (0.5f - e * 0.33333333f)) : __logf(1.f + e)); }
DEV float gelu_tanh(float x) { float u = 0.7978845608028654f * (x + 0.044715f * x * x * x); float t = 1.f - 2.f * __builtin_amdgcn_rcpf(1.f + __expf(2.f * u)); return 0.5f * x * (1.f + t); }
DEV f32x4 mfma16(bf16x8 a, bf16x8 b, f32x4 c) { return __builtin_amdgcn_mfma_f32_16x16x32_bf16(a, b, c, 0, 0, 0); }
DEV void mfma16a(f32x4& c, bf16x8 a, bf16x8 b) { asm volatile("v_mfma_f32_16x16x32_bf16 %0, %1, %2, %0" : "+a"(c) : "v"(a), "v"(b)); }
DEV float lo16(unsigned v) { return __uint_as_float(v << 16); }
DEV float hi16(unsigned v) { return __uint_as_float(v & 0xffff0000u); }

DEV bf16_t* wsb(const Params& p, size_t off) { return (bf16_t*)(p.ws + off); }
DEV float* wsf(const Params& p, size_t off) { return (float*)(p.ws + off); }
DEV float* hrow(const Params& p, int r) { int b = r / SB, s = r - b * SB; return s < CTXL ? wsf(p, O_HCTX) + (size_t)(b * CTXL + s) * D : p.out + (size_t)(b * SEQ + s - CTXL) * D; }
DEV const float* xrow(const Params& p, int r) { int b = r / SB, s = r - b * SB; return s < CTXL ? p.in[I_CTX] + (size_t)(b * CTXL + s) * D : p.in[I_X] + (size_t)(b * SEQ + s - CTXL) * D; }
DEV int modrow(int r) { int b = r / SB, s = r - b * SB; return s < CTXL ? 8 : b; }

template <int MT, int NT>
DEV void gemm_core(const bf16_t* __restrict__ A, int lda, const bf16_t* __restrict__ Bt, int ldb, int K, f32x4 (&acc)[MT][NT], bf16_t* smem_) {
    constexpr int SA = 32 * MT * GLD, SBB = 32 * NT * GLD;
    bf16_t* sA = smem_; bf16_t* sB = smem_ + 2 * SA;
    const int tid = get_tid(), lane = tid & 63, wv = tid >> 6, wr = wv >> 1, wc = wv & 1, l15 = lane & 15, quad = lane >> 4;
    const int lr = tid >> 3, lc = (tid & 7) * 8;
    u32x4 ra0[MT], rb0[NT], ra1[MT], rb1[NT];
    const bf16_t* Ap = A + (size_t)lr * lda + lc;
    const bf16_t* Bp = Bt + (size_t)lr * ldb + lc;
    const int nk = K >> 6;
#define GLOAD(RA, RB, KT) { const int ko_ = (KT) * 64; _Pragma("unroll") for (int i = 0; i < MT; ++i) RA[i] = *(const u32x4*)(Ap + (size_t)(32 * i) * lda + ko_); \
                            _Pragma("unroll") for (int i = 0; i < NT; ++i) RB[i] = *(const u32x4*)(Bp + (size_t)(32 * i) * ldb + ko_); }
#define LSTORE(RA, RB, BUF) { _Pragma("unroll") for (int i = 0; i < MT; ++i) *(u32x4*)(sA + (BUF) * SA + (lr + 32 * i) * GLD + lc) = RA[i]; \
                              _Pragma("unroll") for (int i = 0; i < NT; ++i) *(u32x4*)(sB + (BUF) * SBB + (lr + 32 * i) * GLD + lc) = RB[i]; }
#define COMPUTE(BUF) { _Pragma("unroll") for (int ks = 0; ks < 2; ++ks) { bf16x8 af[MT], bfr[NT]; \
        _Pragma("unroll") for (int mt = 0; mt < MT; ++mt) af[mt] = *(const bf16x8*)(sA + (BUF) * SA + (wr * MT * 16 + mt * 16 + l15) * GLD + ks * 32 + quad * 8); \
        _Pragma("unroll") for (int nt = 0; nt < NT; ++nt) bfr[nt] = *(const bf16x8*)(sB + (BUF) * SBB + (wc * NT * 16 + nt * 16 + l15) * GLD + ks * 32 + quad * 8); \
        _Pragma("unroll") for (int mt = 0; mt < MT; ++mt) _Pragma("unroll") for (int nt = 0; nt < NT; ++nt) mfma16a(acc[mt][nt], af[mt], bfr[nt]); } }
    GLOAD(ra0, rb0, 0);
    GLOAD(ra1, rb1, 1);
    __syncthreads();
    LSTORE(ra0, rb0, 0);
    GLOAD(ra0, rb0, 2);
    __syncthreads();
#pragma unroll 1
    for (int kt = 0; kt < nk; kt += 2) {
        COMPUTE(0);
        if (kt + 1 < nk) LSTORE(ra1, rb1, 1);
        if (kt + 3 < nk) GLOAD(ra1, rb1, kt + 3);
        __syncthreads();
        COMPUTE(1);
        if (kt + 2 < nk) LSTORE(ra0, rb0, 0);
        if (kt + 4 < nk) GLOAD(ra0, rb0, kt + 4);
        __syncthreads();
    }
#undef GLOAD
#undef LSTORE
#undef COMPUTE
    asm volatile("s_nop 15\n\ts_nop 15" ::: "memory");
}
template <int MT, int NT>
DEV void gemm_core1(const bf16_t* __restrict__ A, int lda, const bf16_t* __restrict__ Bt, int ldb, int K, f32x4 (&acc)[MT][NT], bf16_t* sA, bf16_t* sB) {
    const int tid = get_tid(), lane = tid & 63, wv = tid >> 6, wr = wv >> 1, wc = wv & 1, l15 = lane & 15, quad = lane >> 4;
    const int lr = tid >> 3, lc = (tid & 7) * 8;
    u32x4 ra[MT], rb[NT];
    const bf16_t* Ap = A + (size_t)lr * lda + lc;
    const bf16_t* Bp = Bt + (size_t)lr * ldb + lc;
#pragma unroll
    for (int i = 0; i < MT; ++i) ra[i] = *(const u32x4*)(Ap + (size_t)(32 * i) * lda);
#pragma unroll
    for (int i = 0; i < NT; ++i) rb[i] = *(const u32x4*)(Bp + (size_t)(32 * i) * ldb);
    const int nk = K >> 6;
    for (int kt = 0; kt < nk; ++kt) {
        __syncthreads();
#pragma unroll
        for (int i = 0; i < MT; ++i) *(u32x4*)(sA + (lr + 32 * i) * GLD + lc) = ra[i];
#pragma unroll
        for (int i = 0; i < NT; ++i) *(u32x4*)(sB + (lr + 32 * i) * GLD + lc) = rb[i];
        __syncthreads();
        if (kt + 1 < nk) {
            const int ko = (kt + 1) * 64;
#pragma unroll
            for (int i = 0; i < MT; ++i) ra[i] = *(const u32x4*)(Ap + (size_t)(32 * i) * lda + ko);
#pragma unroll
            for (int i = 0; i < NT; ++i) rb[i] = *(const u32x4*)(Bp + (size_t)(32 * i) * ldb + ko);
        }
#pragma unroll
        for (int ks = 0; ks < 2; ++ks) {
            bf16x8 af[MT], bfr[NT];
#pragma unroll
            for (int mt = 0; mt < MT; ++mt) af[mt] = *(const bf16x8*)(sA + (wr * MT * 16 + mt * 16 + l15) * GLD + ks * 32 + quad * 8);
#pragma unroll
            for (int nt = 0; nt < NT; ++nt) bfr[nt] = *(const bf16x8*)(sB + (wc * NT * 16 + nt * 16 + l15) * GLD + ks * 32 + quad * 8);
#pragma unroll
            for (int mt = 0; mt < MT; ++mt)
#pragma unroll
                for (int nt = 0; nt < NT; ++nt) mfma16a(acc[mt][nt], af[mt], bfr[nt]);
        }
    }
    asm volatile("s_nop 15\n\ts_nop 15" ::: "memory");
}
template <int MT, int NT>
DEV void zero_acc(f32x4 (&acc)[MT][NT]) {
#pragma unroll
    for (int mt = 0; mt < MT; ++mt)
#pragma unroll
        for (int nt = 0; nt < NT; ++nt) acc[mt][nt] = (f32x4){0.f, 0.f, 0.f, 0.f};
}

DEV void phase_mod(const Params& p, unsigned char* smem) {
    float* s_s = (float*)smem;
    float* red = s_s + 9 * 1024;
    const int tid = get_tid();
    bool loaded = false;
    for (int it = blockIdx.x; it < 2 * 96; it += gridDim.x) {
        if (!loaded) {
            for (int e = tid; e < 9 * 1024; e += 256) { float v = e < 8192 ? p.in[I_C][e] : p.in[I_CCTX][e - 8192]; s_s[e] = silu(v); }
            loaded = true;
        }
        __syncthreads();
        const int l = it / 96, cg_ = it % 96, cq = tid & 63, kq = tid >> 6, col = cg_ * 64 + cq;
        float acc[9];
#pragma unroll
        for (int r = 0; r < 9; ++r) acc[r] = 0.f;
        const float* wp = p.in[I_WMOD] + ((size_t)l * 1024 + kq * 256) * 6144 + col;
#pragma unroll 8
        for (int k = 0; k < 256; ++k) {
            float wv = wp[(size_t)k * 6144];
#pragma unroll
            for (int r = 0; r < 9; ++r) acc[r] += s_s[r * 1024 + kq * 256 + k] * wv;
        }
#pragma unroll
        for (int r = 0; r < 9; ++r) red[(kq * 9 + r) * 64 + cq] = acc[r];
        __syncthreads();
        for (int e = tid; e < 9 * 64; e += 256) {
            int r = e >> 6, c2 = e & 63;
            float v = red[(0 * 9 + r) * 64 + c2] + red[(1 * 9 + r) * 64 + c2] + red[(2 * 9 + r) * 64 + c2] + red[(3 * 9 + r) * 64 + c2];
            wsf(p, O_MOD)[((size_t)l * 9 + r) * 6144 + cg_ * 64 + c2] = v + p.in[I_BMOD][l * 6144 + cg_ * 64 + c2];
        }
        __syncthreads();
    }
}
DEV void phase_rope(const Params& p) {
    if (blockIdx.x == (gridDim.x - 1)) {
        for (int e = threadIdx.x; e < 1024; e += 256) {
            int pos = e >> 4, i = e & 15;
            float inv = powf(10000.f, -(float)i / 16.f);
            float ang = (float)pos * inv;
            float n = rintf(ang * 0.15915494309189535f);
            float r = fmaf(-n, 6.28125f, ang);
            r = fmaf(-n, 1.9353071795864769e-3f, r);
            wsf(p, O_ROPE)[e * 2] = cosf(r);
            wsf(p, O_ROPE)[e * 2 + 1] = sinf(r);
        }
    }
}
DEV void wconv_tile(const float* src0, const float* src1, int lds_, int K, bf16_t* dst, int kind, int kt, int nt, bf16_t* tile) {
    const int tid = get_tid();
    const int kk = tid >> 2, grp = tid & 3;
    const int n0 = nt * 64, k0 = kt * 64;
    const int ng = n0 + grp * 16;
    const float* src = src0; int sc;
    if (kind == 0) { sc = ng < 2048 ? ng : (ng < 4608 ? ng + 16 : (ng < 4624 ? 2048 : -1)); }
    else if (kind == 1) { sc = 4624 + ng; }
    else if (kind == 2) { sc = ng; }
    else { int gd = ng >> 4; src = (gd & 1) ? src1 : src0; sc = (gd >> 1) * 16; }
    __syncthreads();
    if (sc >= 0) {
        const float4* sp = (const float4*)(src + (size_t)(k0 + kk) * lds_ + sc);
#pragma unroll
        for (int q = 0; q < 4; ++q) { float4 v = sp[q]; int e = grp * 16 + q * 4;
            tile[(e + 0) * GLD + kk] = f2bf(v.x); tile[(e + 1) * GLD + kk] = f2bf(v.y); tile[(e + 2) * GLD + kk] = f2bf(v.z); tile[(e + 3) * GLD + kk] = f2bf(v.w); }
    } else {
#pragma unroll
        for (int e = 0; e < 16; ++e) tile[(grp * 16 + e) * GLD + kk] = 0;
    }
    __syncthreads();
    const int n = tid >> 2, kseg = (tid & 3) * 16;
    u32x4 a = *(const u32x4*)(tile + n * GLD + kseg), b = *(const u32x4*)(tile + n * GLD + kseg + 8);
    bf16_t* dp = dst + (size_t)(n0 + n) * K + k0 + kseg;
    *(u32x4*)dp = a; *(u32x4*)(dp + 8) = b;
}
DEV void phase_wconv(const Params& p, int l, unsigned char* smem) {
    bf16_t* tile = (bf16_t*)smem;
    bf16_t* W = wsb(p, O_WT);
    constexpr int T0 = 74 * 16, T1 = T0 + 48 * 16, T2 = T1 + 3 * 16 * 8, T3 = T2 + 16 * 16, T4 = T3 + 88 * 16, T5 = T4 + 16 * 44;
    for (int t = blockIdx.x; t < T5; t += gridDim.x) {
        if (t < T0) { wconv_tile(p.in[I_WIN] + (size_t)l * 1024 * 7696, nullptr, 7696, 1024, W + W_IN, 0, t % 16, t / 16, tile); }
        else if (t < T1) { int u = t - T0; wconv_tile(p.in[I_WIN] + (size_t)l * 1024 * 7696, nullptr, 7696, 1024, W + W_GATE, 1, u % 16, u / 16, tile); }
        else if (t < T2) { int u = t - T1; int n = u / 128, v = u % 128; wconv_tile(p.in[I_WBR] + ((size_t)l * 3 + n) * 512 * 1024, nullptr, 1024, 512, W + W_BR + (size_t)n * 1024 * 512, 2, v % 8, v / 8, tile); }
        else if (t < T3) { int u = t - T2; wconv_tile(p.in[I_WOUT] + (size_t)l * 1024 * 1024, nullptr, 1024, 1024, W + W_OUT, 2, u % 16, u / 16, tile); }
        else if (t < T4) { int u = t - T3; wconv_tile(p.in[I_WFG] + (size_t)l * 1024 * DFF, p.in[I_WFU] + (size_t)l * 1024 * DFF, DFF, 1024, W + W_GU, 3, u % 16, u / 16, tile); }
        else { int u = t - T4; wconv_tile(p.in[I_WFD] + (size_t)l * DFF * 1024, nullptr, 1024, DFF, W + W_DN, 2, u % 44, u / 44, tile); }
    }
}

DEV void norm_row(const Params& p, int l, int which, bool first, int r, int lane) {
    const float* h = first ? xrow(p, r) : hrow(p, r);
    const float* nw = p.in[which ? I_NFFN : I_NMIX] + l * D;
    const float* md = wsf(p, O_MOD) + ((size_t)l * 9 + modrow(r)) * 6144 + (which ? 3 * D : 0);
    float4 v[4]; float ss = 0.f;
#pragma unroll
    for (int i = 0; i < 4; ++i) { v[i] = *(const float4*)(h + i * 256 + lane * 4); ss += v[i].x * v[i].x + v[i].y * v[i].y + v[i].z * v[i].z + v[i].w * v[i].w; }
#pragma unroll
    for (int o = 32; o >= 1; o >>= 1) ss += __shfl_xor(ss, o);
    const float rstd = rsqrtf(ss * (1.f / D) + 1e-6f);
    bf16_t* up = wsb(p, O_U) + (size_t)r * D;
#pragma unroll
    for (int i = 0; i < 4; ++i) {
        const int c = i * 256 + lane * 4;
        float4 w4 = *(const float4*)(nw + c), sh = *(const float4*)(md + c), sc = *(const float4*)(md + D + c);
        float a = v[i].x * rstd * w4.x * (1.f + sc.x) + sh.x, b = v[i].y * rstd * w4.y * (1.f + sc.y) + sh.y;
        float c2 = v[i].z * rstd * w4.z * (1.f + sc.z) + sh.z, d = v[i].w * rstd * w4.w * (1.f + sc.w) + sh.w;
        u32x2 o; o.x = pack2(a, b); o.y = pack2(c2, d);
        *(u32x2*)(up + c) = o;
    }
}
DEV void phase_norm(const Params& p, int l, int which, bool first, bool skip_ctx) {
    const int tid_ = get_tid(); const int lane = tid_ & 63, wv = tid_ >> 6;
    for (int r = blockIdx.x * 4 + wv; r < MR; r += gridDim.x * 4) {
        if (skip_ctx && (r % SB) < CTXL) continue;
        norm_row(p, l, which, first, r, lane);
    }
}
DEV void phase_fin_norm(const Params& p, int l, bool first, bool skip_ctx) {
    const int tid_ = get_tid(); const int lane = tid_ & 63, wv = tid_ >> 6;
    const float* dnn = p.in[I_DNNORM] + l * 128;
    for (int r = blockIdx.x * 4 + wv; r < MR; r += gridDim.x * 4) {
        if (skip_ctx && (r % SB) < CTXL) continue;
        norm_row(p, l, 0, first, r, lane);
        bf16_t* ta = wsb(p, O_TA) + (size_t)r * 512 + lane * 8;
        const bf16_t* tb = wsb(p, O_TA2) + (size_t)r * 512 + lane * 8;
        const bf16_t* zz = wsb(p, O_P) + (size_t)r * PW + C_DNZ + lane * 8;
        u32x4 a = *(const u32x4*)ta, b = *(const u32x4*)tb, z = *(const u32x4*)zz;
        float o[8]; float ss = 0.f;
#pragma unroll
        for (int i = 0; i < 4; ++i) { o[2 * i] = lo16(a[i]) + lo16(b[i]); o[2 * i + 1] = hi16(a[i]) + hi16(b[i]); ss += o[2 * i] * o[2 * i] + o[2 * i + 1] * o[2 * i + 1]; }
#pragma unroll
        for (int of = 8; of >= 1; of >>= 1) ss += __shfl_xor(ss, of);
        const float rstd = rsqrtf(ss * (1.f / 128.f) + 1e-6f);
        const int dv0 = (lane & 15) * 8;
        u32x4 y;
#pragma unroll
        for (int i = 0; i < 4; ++i) {
            float y0 = o[2 * i] * rstd * dnn[dv0 + 2 * i] * silu(lo16(z[i]));
            float y1 = o[2 * i + 1] * rstd * dnn[dv0 + 2 * i + 1] * silu(hi16(z[i]));
            y[i] = pack2(y0, y1);
        }
        *(u32x4*)ta = y;
    }
}
DEV void phase_final(const Params& p) {
    const int tid_ = get_tid(); const int lane = tid_ & 63, wv = tid_ >> 6;
    const float* nw = p.in[I_NFIN];
    for (int r = blockIdx.x * 4 + wv; r < NB * SEQ; r += gridDim.x * 4) {
        float* h = p.out + (size_t)r * D;
        float4 v[4]; float ss = 0.f;
#pragma unroll
        for (int i = 0; i < 4; ++i) { v[i] = *(const float4*)(h + i * 256 + lane * 4); ss += v[i].x * v[i].x + v[i].y * v[i].y + v[i].z * v[i].z + v[i].w * v[i].w; }
#pragma unroll
        for (int o = 32; o >= 1; o >>= 1) ss += __shfl_xor(ss, o);
        const float rstd = rsqrtf(ss * (1.f / D) + 1e-6f);
#pragma unroll
        for (int i = 0; i < 4; ++i) {
            const int c = i * 256 + lane * 4;
            float4 w4 = *(const float4*)(nw + c);
            float4 o4; o4.x = v[i].x * rstd * w4.x; o4.y = v[i].y * rstd * w4.y; o4.z = v[i].z * rstd * w4.z; o4.w = v[i].w * rstd * w4.w;
            *(float4*)(h + c) = o4;
        }
    }
}

struct TileIter {
    int nn, total, nloc, L;
    DEV TileIter(int nm, int nn_) { nn = nn_; total = nm * nn_; nloc = gridDim.x >> 3; L = (blockIdx.x & 7) * nloc + (blockIdx.x >> 3); }
    DEV bool valid() const { return L < total; }
    DEV bool more() const { return (L - (int)(blockIdx.x >> 3)) < total; }
    DEV void next() { L += 8 * nloc; }
    DEV void get(int& tm, int& tn) const { const int pn = 4 * nn, panel = L / pn, rem = L - panel * pn; tn = rem >> 2; tm = panel * 4 + (rem & 3); }
};
DEV void phase_g1(const Params& p, unsigned char* smem) {
    bf16_t* sA = (bf16_t*)smem;
    const int tid = get_tid(), lane = tid & 63, wv = tid >> 6, wr = wv >> 1, wc = wv & 1, l15 = lane & 15, quad = lane >> 4;
    const bf16_t* U = wsb(p, O_U); const bf16_t* W = wsb(p, O_WT) + W_IN;
    bf16_t* P = wsb(p, O_P);
    const float* rope = wsf(p, O_ROPE);
    constexpr int NTN = NIN / 128;
    for (TileIter ti(MR / 256, NTN); ti.valid(); ti.next()) {
        int tm, tn; ti.get(tm, tn);
        const int row0 = tm * 256, col0 = tn * 128;
        f32x4 acc[8][4]; zero_acc(acc);
        gemm_core<8, 4>(U + (size_t)row0 * D, D, W + (size_t)col0 * D, D, D, acc, sA);
        if (tn < 24) {
#pragma unroll
            for (int mt = 0; mt < 8; ++mt)
#pragma unroll
                for (int nt = 0; nt < 4; ++nt)
#pragma unroll
                    for (int j = 0; j < 4; ++j) {
                        if (nt == 0 && j == 0) __builtin_amdgcn_sched_barrier(0);
                        const int row = row0 + wr * 128 + mt * 16 + quad * 4 + j, col = col0 + wc * 64 + nt * 16 + l15;
                        P[(size_t)row * PW + col] = f2bf(acc[mt][nt][j]);
                    }
        } else if (tn < 32) {
            const float qs = tn < 28 ? 0.125f : 1.f;
#pragma unroll
            for (int mt = 0; mt < 8; ++mt)
#pragma unroll
                for (int j = 0; j < 4; ++j) {
                    if (j == 0) __builtin_amdgcn_sched_barrier(0);
                    const int row = row0 + wr * 128 + mt * 16 + quad * 4 + j;
                    const int s = row % SB;
                    float c0 = 1.f, s0 = 0.f, c1 = 1.f, s1 = 0.f;
                    if (s >= CTXL) { const int tt = s - CTXL, pr = tt >> 6, pc = tt & 63;
                        c0 = rope[(pr * 16 + l15) * 2]; s0 = rope[(pr * 16 + l15) * 2 + 1]; c1 = rope[(pc * 16 + l15) * 2]; s1 = rope[(pc * 16 + l15) * 2 + 1]; }
                    const float x1 = acc[mt][0][j], x2 = acc[mt][1][j], y1 = acc[mt][2][j], y2 = acc[mt][3][j];
                    bf16_t* pp = P + (size_t)row * PW + col0 + wc * 64 + l15;
                    pp[0] = f2bf((x1 * c0 - x2 * s0) * qs);
                    pp[16] = f2bf((x2 * c0 + x1 * s0) * qs);
                    pp[32] = f2bf((y1 * c1 - y2 * s1) * qs);
                    pp[48] = f2bf((y2 * c1 + y1 * s1) * qs);
                }
        } else if (tn < 36) {
            bf16_t* VT = wsb(p, O_VT);
            const int b = row0 / SB, sbase = row0 - b * SB;
#pragma unroll
            for (int mt = 0; mt < 8; ++mt)
#pragma unroll
                for (int nt = 0; nt < 4; ++nt) {
                    if (nt == 0) __builtin_amdgcn_sched_barrier(0);
                    const int cc = col0 - 4096 + wc * 64 + nt * 16 + l15;
                    const int s = sbase + wr * 128 + mt * 16 + quad * 4;
                    u32x2 o; o.x = pack2(acc[mt][nt][0], acc[mt][nt][1]); o.y = pack2(acc[mt][nt][2], acc[mt][nt][3]);
                    *(u32x2*)(VT + ((size_t)(b * 512 + cc)) * SB + s) = o;
                }
        } else {
            if (wc == 0) {
                float* AB = wsf(p, O_AB);
#pragma unroll
                for (int mt = 0; mt < 8; ++mt)
#pragma unroll
                    for (int j = 0; j < 4; ++j) {
                        const int row = row0 + wr * 128 + mt * 16 + quad * 4 + j;
                        AB[(size_t)row * 16 + l15] = acc[mt][0][j];
                    }
            }
        }
    }
}

DEV int rowtile0(int ti, bool latent_only) { if (!latent_only) return ti * 256; int b = ti >> 4, tt = ti & 15; return b * SB + CTXL + tt * 256; }
DEV int sgcol(int n, int c) { return n < 2 ? n * 1024 + c : (c < 512 ? 2048 + c : 3584 + (c - 512)); }

DEV void phase_gate(const Params& p, bool latent_only, unsigned char* smem) {
    bf16_t* sA = (bf16_t*)smem;
    const int tid = get_tid(), lane = tid & 63, wv = tid >> 6, wr = wv >> 1, wc = wv & 1, l15 = lane & 15, quad = lane >> 4;
    const bf16_t* U = wsb(p, O_U); const bf16_t* W = wsb(p, O_WT) + W_GATE;
    bf16_t* P = wsb(p, O_P);
    const int nrt = latent_only ? 128 : 136;
    for (TileIter ti(nrt, 24); ti.valid(); ti.next()) {
        int tm, tn; ti.get(tm, tn);
        const int row0 = rowtile0(tm, latent_only);
        f32x4 acc[8][4]; zero_acc(acc);
        gemm_core<8, 4>(U + (size_t)row0 * D, D, W + (size_t)tn * 128 * D, D, D, acc, sA);
        const int dcol0 = sgcol(tn >> 3, (tn & 7) * 128);
#pragma unroll
        for (int mt = 0; mt < 8; ++mt)
#pragma unroll
            for (int nt = 0; nt < 4; ++nt)
#pragma unroll
                for (int j = 0; j < 4; ++j) {
                    if (nt == 0 && j == 0) __builtin_amdgcn_sched_barrier(0);
                    const int row = row0 + wr * 128 + mt * 16 + quad * 4 + j, col = dcol0 + wc * 64 + nt * 16 + l15;
                    P[(size_t)row * PW + col] = f2bf(sigm(acc[mt][nt][j]));
                }
    }
}

DEV void phase_merge(const Params& p, bool latent_only, unsigned char* smem) {
    bf16_t* sA = (bf16_t*)smem;
    const int tid = get_tid(), lane = tid & 63, wv = tid >> 6, wr = wv >> 1, wc = wv & 1, l15 = lane & 15, quad = lane >> 4;
    const bf16_t* W = wsb(p, O_WT);
    const bf16_t* P = wsb(p, O_P);
    bf16_t* U = wsb(p, O_U);
    const int nrt = latent_only ? 128 : 136;
    for (TileIter ti(nrt, 8); ti.valid(); ti.next()) {
        int tm, tn; ti.get(tm, tn);
        const int row0 = rowtile0(tm, latent_only), col0 = tn * 128;
        f32x4 m[8][4]; zero_acc(m);
#pragma unroll 1
        for (int n = 0; n < 3; ++n) {
            f32x4 au[8][4]; zero_acc(au);
            const bf16_t* Y; int ldy;
            if (n == 0) { Y = wsb(p, O_TA) + (size_t)row0 * 512; ldy = 512; }
            else if (n == 1) { Y = P + (size_t)row0 * PW + C_LG; ldy = PW; }
            else { Y = P + (size_t)row0 * PW + C_DAQ; ldy = PW; }
            gemm_core1<8, 4>(Y, ldy, W + W_BR + ((size_t)n * 1024 + col0) * 512, 512, 512, au, sA, sA + 256 * GLD);
            const int sc0 = sgcol(n, col0);
#pragma unroll
            for (int mt = 0; mt < 8; ++mt)
#pragma unroll
                for (int nt = 0; nt < 4; ++nt)
#pragma unroll
                    for (int j = 0; j < 4; ++j) {
                        if (nt == 0 && j == 0) __builtin_amdgcn_sched_barrier(0);
                        const int row = row0 + wr * 128 + mt * 16 + quad * 4 + j, col = sc0 + wc * 64 + nt * 16 + l15;
                        m[mt][nt][j] += bf2f(P[(size_t)row * PW + col]) * au[mt][nt][j];
                    }
        }
#pragma unroll
        for (int mt = 0; mt < 8; ++mt)
#pragma unroll
            for (int nt = 0; nt < 4; ++nt)
#pragma unroll
                for (int j = 0; j < 4; ++j) {
                    if (nt == 0 && j == 0) __builtin_amdgcn_sched_barrier(0);
                    const int row = row0 + wr * 128 + mt * 16 + quad * 4 + j, col = col0 + wc * 64 + nt * 16 + l15;
                    U[(size_t)row * D + col] = f2bf(m[mt][nt][j]);
                }
    }
}

DEV void phase_resid(const Params& p, int l, const bf16_t* A, int lda, const bf16_t* Wt, int K, int chunk, bool first, bool latent_only, unsigned char* smem) {
    bf16_t* sA = (bf16_t*)smem;
    const int tid = get_tid(), lane = tid & 63, wv = tid >> 6, wr = wv >> 1, wc = wv & 1, l15 = lane & 15, quad = lane >> 4;
    const int nrt = latent_only ? 128 : 136;
    for (TileIter ti(nrt, 8); ti.valid(); ti.next()) {
        int tm, tn; ti.get(tm, tn);
        const int row0 = rowtile0(tm, latent_only), col0 = tn * 128;
        f32x4 acc[8][4]; zero_acc(acc);
        gemm_core<8, 4>(A + (size_t)row0 * lda, lda, Wt + (size_t)col0 * K, K, K, acc, sA);
        const float* md = wsf(p, O_MOD) + ((size_t)l * 9 + modrow(row0)) * 6144 + chunk * D;
        const float* hs0 = first ? xrow(p, row0) : hrow(p, row0);
        float* hd0 = hrow(p, row0);
#pragma unroll
        for (int mt = 0; mt < 8; ++mt)
#pragma unroll
            for (int j = 0; j < 4; ++j) {
                if (j == 0) __builtin_amdgcn_sched_barrier(0);
                const int rl = wr * 128 + mt * 16 + quad * 4 + j;
                const float* hs = hs0 + (size_t)rl * D;
                float* hd = hd0 + (size_t)rl * D;
#pragma unroll
                for (int nt = 0; nt < 4; ++nt) { const int col = col0 + wc * 64 + nt * 16 + l15; hd[col] = hs[col] + md[col] * acc[mt][nt][j]; }
            }
    }
}
DEV void phase_gu(const Params& p, bool latent_only, unsigned char* smem) {
    bf16_t* sA = (bf16_t*)smem;
    const int tid = get_tid(), lane = tid & 63, wv = tid >> 6, wr = wv >> 1, wc = wv & 1, l15 = lane & 15, quad = lane >> 4;
    const bf16_t* U = wsb(p, O_U); const bf16_t* W = wsb(p, O_WT) + W_GU;
    bf16_t* P = wsb(p, O_P);
    const int nrt = latent_only ? 128 : 136;
    for (TileIter ti(nrt, 44); ti.valid(); ti.next()) {
        int tm, tn; ti.get(tm, tn);
        const int row0 = rowtile0(tm, latent_only);
        f32x4 acc[8][4]; zero_acc(acc);
        gemm_core<8, 4>(U + (size_t)row0 * D, D, W + (size_t)tn * 128 * D, D, D, acc, sA);
#pragma unroll
        for (int mt = 0; mt < 8; ++mt)
#pragma unroll
            for (int pr = 0; pr < 2; ++pr)
#pragma unroll
                for (int j = 0; j < 4; ++j) {
                    if (pr == 0 && j == 0) __builtin_amdgcn_sched_barrier(0);
                    const int row = row0 + wr * 128 + mt * 16 + quad * 4 + j, hc = (tn * 4 + wc * 2 + pr) * 16 + l15;
                    P[(size_t)row * PW + hc] = f2bf(silu(acc[mt][2 * pr][j]) * acc[mt][2 * pr + 1][j]);
                }
    }
}

DEV int chunk_of(int dir, int n) { return dir ? (n < 4 ? 3 - n : 71 - n) : n; }

DEV void dn_solve(const float* __restrict__ Lt_s0, const bf16_t* __restrict__ colp, const float* __restrict__ mulp0, const float sg, bf16_t* __restrict__ outp) {
    int vz = 0; asm volatile("" : "+v"(vz));
    const float* __restrict__ Lt_s = Lt_s0 + vz; const float* __restrict__ mulp = mulp0 + vz;
    float x0, x1, x2, x3, x4, x5, x6, x7, x8, x9, x10, x11, x12, x13, x14, x15, x16, x17, x18, x19, x20, x21, x22, x23, x24, x25, x26, x27, x28, x29, x30, x31, x32, x33, x34, x35, x36, x37, x38, x39, x40, x41, x42, x43, x44, x45, x46, x47, x48, x49, x50, x51, x52, x53, x54, x55, x56, x57, x58, x59, x60, x61, x62, x63;
    f32x4 La0, La1, La2, La3, La4, La5, La6, La7, La8, La9, La10, La11, La12, La13, La14, La15, Lb0, Lb1, Lb2, Lb3, Lb4, Lb5, Lb6, Lb7, Lb8, Lb9, Lb10, Lb11, Lb12, Lb13, Lb14, Lb15;
    x0 = bf2f(colp[0]) * mulp[0];
    x1 = bf2f(colp[136]) * mulp[1];
    x2 = bf2f(colp[272]) * mulp[2];
    x3 = bf2f(colp[408]) * mulp[3];
    x4 = bf2f(colp[544]) * mulp[4];
    x5 = bf2f(colp[680]) * mulp[5];
    x6 = bf2f(colp[816]) * mulp[6];
    x7 = bf2f(colp[952]) * mulp[7];
    x8 = bf2f(colp[1088]) * mulp[8];
    x9 = bf2f(colp[1224]) * mulp[9];
    x10 = bf2f(colp[1360]) * mulp[10];
    x11 = bf2f(colp[1496]) * mulp[11];
    x12 = bf2f(colp[1632]) * mulp[12];
    x13 = bf2f(colp[1768]) * mulp[13];
    x14 = bf2f(colp[1904]) * mulp[14];
    x15 = bf2f(colp[2040]) * mulp[15];
    x16 = bf2f(colp[2176]) * mulp[16];
    x17 = bf2f(colp[2312]) * mulp[17];
    x18 = bf2f(colp[2448]) * mulp[18];
    x19 = bf2f(colp[2584]) * mulp[19];
    x20 = bf2f(colp[2720]) * mulp[20];
    x21 = bf2f(colp[2856]) * mulp[21];
    x22 = bf2f(colp[2992]) * mulp[22];
    x23 = bf2f(colp[3128]) * mulp[23];
    x24 = bf2f(colp[3264]) * mulp[24];
    x25 = bf2f(colp[3400]) * mulp[25];
    x26 = bf2f(colp[3536]) * mulp[26];
    x27 = bf2f(colp[3672]) * mulp[27];
    x28 = bf2f(colp[3808]) * mulp[28];
    x29 = bf2f(colp[3944]) * mulp[29];
    x30 = bf2f(colp[4080]) * mulp[30];
    x31 = bf2f(colp[4216]) * mulp[31];
    x32 = bf2f(colp[4352]) * mulp[32];
    x33 = bf2f(colp[4488]) * mulp[33];
    x34 = bf2f(colp[4624]) * mulp[34];
    x35 = bf2f(colp[4760]) * mulp[35];
    x36 = bf2f(colp[4896]) * mulp[36];
    x37 = bf2f(colp[5032]) * mulp[37];
    x38 = bf2f(colp[5168]) * mulp[38];
    x39 = bf2f(colp[5304]) * mulp[39];
    x40 = bf2f(colp[5440]) * mulp[40];
    x41 = bf2f(colp[5576]) * mulp[41];
    x42 = bf2f(colp[5712]) * mulp[42];
    x43 = bf2f(colp[5848]) * mulp[43];
    x44 = bf2f(colp[5984]) * mulp[44];
    x45 = bf2f(colp[6120]) * mulp[45];
    x46 = bf2f(colp[6256]) * mulp[46];
    x47 = bf2f(colp[6392]) * mulp[47];
    x48 = bf2f(colp[6528]) * mulp[48];
    x49 = bf2f(colp[6664]) * mulp[49];
    x50 = bf2f(colp[6800]) * mulp[50];
    x51 = bf2f(colp[6936]) * mulp[51];
    x52 = bf2f(colp[7072]) * mulp[52];
    x53 = bf2f(colp[7208]) * mulp[53];
    x54 = bf2f(colp[7344]) * mulp[54];
    x55 = bf2f(colp[7480]) * mulp[55];
    x56 = bf2f(colp[7616]) * mulp[56];
    x57 = bf2f(colp[7752]) * mulp[57];
    x58 = bf2f(colp[7888]) * mulp[58];
    x59 = bf2f(colp[8024]) * mulp[59];
    x60 = bf2f(colp[8160]) * mulp[60];
    x61 = bf2f(colp[8296]) * mulp[61];
    x62 = bf2f(colp[8432]) * mulp[62];
    x63 = bf2f(colp[8568]) * mulp[63];
    La0 = *(const f32x4*)(Lt_s + 0);
    La1 = *(const f32x4*)(Lt_s + 4);
    La2 = *(const f32x4*)(Lt_s + 8);
    La3 = *(const f32x4*)(Lt_s + 12);
    La4 = *(const f32x4*)(Lt_s + 16);
    La5 = *(const f32x4*)(Lt_s + 20);
    La6 = *(const f32x4*)(Lt_s + 24);
    La7 = *(const f32x4*)(Lt_s + 28);
    La8 = *(const f32x4*)(Lt_s + 32);
    La9 = *(const f32x4*)(Lt_s + 36);
    La10 = *(const f32x4*)(Lt_s + 40);
    La11 = *(const f32x4*)(Lt_s + 44);
    La12 = *(const f32x4*)(Lt_s + 48);
    La13 = *(const f32x4*)(Lt_s + 52);
    La14 = *(const f32x4*)(Lt_s + 56);
    La15 = *(const f32x4*)(Lt_s + 60);
    Lb0 = *(const f32x4*)(Lt_s + 68);
    Lb1 = *(const f32x4*)(Lt_s + 72);
    Lb2 = *(const f32x4*)(Lt_s + 76);
    Lb3 = *(const f32x4*)(Lt_s + 80);
    Lb4 = *(const f32x4*)(Lt_s + 84);
    Lb5 = *(const f32x4*)(Lt_s + 88);
    Lb6 = *(const f32x4*)(Lt_s + 92);
    Lb7 = *(const f32x4*)(Lt_s + 96);
    Lb8 = *(const f32x4*)(Lt_s + 100);
    Lb9 = *(const f32x4*)(Lt_s + 104);
    Lb10 = *(const f32x4*)(Lt_s + 108);
    Lb11 = *(const f32x4*)(Lt_s + 112);
    Lb12 = *(const f32x4*)(Lt_s + 116);
    Lb13 = *(const f32x4*)(Lt_s + 120);
    Lb14 = *(const f32x4*)(Lt_s + 124);
    Lb15 = *(const f32x4*)(Lt_s + 128);
    __builtin_amdgcn_sched_barrier(0);
    x1 -= La0[1] * x0;
    x2 -= La0[2] * x0;
    x3 -= La0[3] * x0;
    x4 -= La1[0] * x0;
    x5 -= La1[1] * x0;
    x6 -= La1[2] * x0;
    x7 -= La1[3] * x0;
    x8 -= La2[0] * x0;
    x9 -= La2[1] * x0;
    x10 -= La2[2] * x0;
    x11 -= La2[3] * x0;
    x12 -= La3[0] * x0;
    x13 -= La3[1] * x0;
    x14 -= La3[2] * x0;
    x15 -= La3[3] * x0;
    x16 -= La4[0] * x0;
    x17 -= La4[1] * x0;
    x18 -= La4[2] * x0;
    x19 -= La4[3] * x0;
    x20 -= La5[0] * x0;
    x21 -= La5[1] * x0;
    x22 -= La5[2] * x0;
    x23 -= La5[3] * x0;
    x24 -= La6[0] * x0;
    x25 -= La6[1] * x0;
    x26 -= La6[2] * x0;
    x27 -= La6[3] * x0;
    x28 -= La7[0] * x0;
    x29 -= La7[1] * x0;
    x30 -= La7[2] * x0;
    x31 -= La7[3] * x0;
    x32 -= La8[0] * x0;
    x33 -= La8[1] * x0;
    x34 -= La8[2] * x0;
    x35 -= La8[3] * x0;
    x36 -= La9[0] * x0;
    x37 -= La9[1] * x0;
    x38 -= La9[2] * x0;
    x39 -= La9[3] * x0;
    x40 -= La10[0] * x0;
    x41 -= La10[1] * x0;
    x42 -= La10[2] * x0;
    x43 -= La10[3] * x0;
    x44 -= La11[0] * x0;
    x45 -= La11[1] * x0;
    x46 -= La11[2] * x0;
    x47 -= La11[3] * x0;
    x48 -= La12[0] * x0;
    x49 -= La12[1] * x0;
    x50 -= La12[2] * x0;
    x51 -= La12[3] * x0;
    x52 -= La13[0] * x0;
    x53 -= La13[1] * x0;
    x54 -= La13[2] * x0;
    x55 -= La13[3] * x0;
    x56 -= La14[0] * x0;
    x57 -= La14[1] * x0;
    x58 -= La14[2] * x0;
    x59 -= La14[3] * x0;
    x60 -= La15[0] * x0;
    x61 -= La15[1] * x0;
    x62 -= La15[2] * x0;
    x63 -= La15[3] * x0;
    __builtin_amdgcn_sched_barrier(0);
    La0 = *(const f32x4*)(Lt_s + 136);
    La1 = *(const f32x4*)(Lt_s + 140);
    La2 = *(const f32x4*)(Lt_s + 144);
    La3 = *(const f32x4*)(Lt_s + 148);
    La4 = *(const f32x4*)(Lt_s + 152);
    La5 = *(const f32x4*)(Lt_s + 156);
    La6 = *(const f32x4*)(Lt_s + 160);
    La7 = *(const f32x4*)(Lt_s + 164);
    La8 = *(const f32x4*)(Lt_s + 168);
    La9 = *(const f32x4*)(Lt_s + 172);
    La10 = *(const f32x4*)(Lt_s + 176);
    La11 = *(const f32x4*)(Lt_s + 180);
    La12 = *(const f32x4*)(Lt_s + 184);
    La13 = *(const f32x4*)(Lt_s + 188);
    La14 = *(const f32x4*)(Lt_s + 192);
    La15 = *(const f32x4*)(Lt_s + 196);
    __builtin_amdgcn_sched_barrier(0);
    x2 -= Lb0[2] * x1;
    x3 -= Lb0[3] * x1;
    x4 -= Lb1[0] * x1;
    x5 -= Lb1[1] * x1;
    x6 -= Lb1[2] * x1;
    x7 -= Lb1[3] * x1;
    x8 -= Lb2[0] * x1;
    x9 -= Lb2[1] * x1;
    x10 -= Lb2[2] * x1;
    x11 -= Lb2[3] * x1;
    x12 -= Lb3[0] * x1;
    x13 -= Lb3[1] * x1;
    x14 -= Lb3[2] * x1;
    x15 -= Lb3[3] * x1;
    x16 -= Lb4[0] * x1;
    x17 -= Lb4[1] * x1;
    x18 -= Lb4[2] * x1;
    x19 -= Lb4[3] * x1;
    x20 -= Lb5[0] * x1;
    x21 -= Lb5[1] * x1;
    x22 -= Lb5[2] * x1;
    x23 -= Lb5[3] * x1;
    x24 -= Lb6[0] * x1;
    x25 -= Lb6[1] * x1;
    x26 -= Lb6[2] * x1;
    x27 -= Lb6[3] * x1;
    x28 -= Lb7[0] * x1;
    x29 -= Lb7[1] * x1;
    x30 -= Lb7[2] * x1;
    x31 -= Lb7[3] * x1;
    x32 -= Lb8[0] * x1;
    x33 -= Lb8[1] * x1;
    x34 -= Lb8[2] * x1;
    x35 -= Lb8[3] * x1;
    x36 -= Lb9[0] * x1;
    x37 -= Lb9[1] * x1;
    x38 -= Lb9[2] * x1;
    x39 -= Lb9[3] * x1;
    x40 -= Lb10[0] * x1;
    x41 -= Lb10[1] * x1;
    x42 -= Lb10[2] * x1;
    x43 -= Lb10[3] * x1;
    x44 -= Lb11[0] * x1;
    x45 -= Lb11[1] * x1;
    x46 -= Lb11[2] * x1;
    x47 -= Lb11[3] * x1;
    x48 -= Lb12[0] * x1;
    x49 -= Lb12[1] * x1;
    x50 -= Lb12[2] * x1;
    x51 -= Lb12[3] * x1;
    x52 -= Lb13[0] * x1;
    x53 -= Lb13[1] * x1;
    x54 -= Lb13[2] * x1;
    x55 -= Lb13[3] * x1;
    x56 -= Lb14[0] * x1;
    x57 -= Lb14[1] * x1;
    x58 -= Lb14[2] * x1;
    x59 -= Lb14[3] * x1;
    x60 -= Lb15[0] * x1;
    x61 -= Lb15[1] * x1;
    x62 -= Lb15[2] * x1;
    x63 -= Lb15[3] * x1;
    __builtin_amdgcn_sched_barrier(0);
    Lb1 = *(const f32x4*)(Lt_s + 208);
    Lb2 = *(const f32x4*)(Lt_s + 212);
    Lb3 = *(const f32x4*)(Lt_s + 216);
    Lb4 = *(const f32x4*)(Lt_s + 220);
    Lb5 = *(const f32x4*)(Lt_s + 224);
    Lb6 = *(const f32x4*)(Lt_s + 228);
    Lb7 = *(const f32x4*)(Lt_s + 232);
    Lb8 = *(const f32x4*)(Lt_s + 236);
    Lb9 = *(const f32x4*)(Lt_s + 240);
    Lb10 = *(const f32x4*)(Lt_s + 244);
    Lb11 = *(const f32x4*)(Lt_s + 248);
    Lb12 = *(const f32x4*)(Lt_s + 252);
    Lb13 = *(const f32x4*)(Lt_s + 256);
    Lb14 = *(const f32x4*)(Lt_s + 260);
    Lb15 = *(const f32x4*)(Lt_s + 264);
    __builtin_amdgcn_sched_barrier(0);
    x3 -= La0[3] * x2;
    x4 -= La1[0] * x2;
    x5 -= La1[1] * x2;
    x6 -= La1[2] * x2;
    x7 -= La1[3] * x2;
    x8 -= La2[0] * x2;
    x9 -= La2[1] * x2;
    x10 -= La2[2] * x2;
    x11 -= La2[3] * x2;
    x12 -= La3[0] * x2;
    x13 -= La3[1] * x2;
    x14 -= La3[2] * x2;
    x15 -= La3[3] * x2;
    x16 -= La4[0] * x2;
    x17 -= La4[1] * x2;
    x18 -= La4[2] * x2;
    x19 -= La4[3] * x2;
    x20 -= La5[0] * x2;
    x21 -= La5[1] * x2;
    x22 -= La5[2] * x2;
    x23 -= La5[3] * x2;
    x24 -= La6[0] * x2;
    x25 -= La6[1] * x2;
    x26 -= La6[2] * x2;
    x27 -= La6[3] * x2;
    x28 -= La7[0] * x2;
    x29 -= La7[1] * x2;
    x30 -= La7[2] * x2;
    x31 -= La7[3] * x2;
    x32 -= La8[0] * x2;
    x33 -= La8[1] * x2;
    x34 -= La8[2] * x2;
    x35 -= La8[3] * x2;
    x36 -= La9[0] * x2;
    x37 -= La9[1] * x2;
    x38 -= La9[2] * x2;
    x39 -= La9[3] * x2;
    x40 -= La10[0] * x2;
    x41 -= La10[1] * x2;
    x42 -= La10[2] * x2;
    x43 -= La10[3] * x2;
    x44 -= La11[0] * x2;
    x45 -= La11[1] * x2;
    x46 -= La11[2] * x2;
    x47 -= La11[3] * x2;
    x48 -= La12[0] * x2;
    x49 -= La12[1] * x2;
    x50 -= La12[2] * x2;
    x51 -= La12[3] * x2;
    x52 -= La13[0] * x2;
    x53 -= La13[1] * x2;
    x54 -= La13[2] * x2;
    x55 -= La13[3] * x2;
    x56 -= La14[0] * x2;
    x57 -= La14[1] * x2;
    x58 -= La14[2] * x2;
    x59 -= La14[3] * x2;
    x60 -= La15[0] * x2;
    x61 -= La15[1] * x2;
    x62 -= La15[2] * x2;
    x63 -= La15[3] * x2;
    __builtin_amdgcn_sched_barrier(0);
    La1 = *(const f32x4*)(Lt_s + 276);
    La2 = *(const f32x4*)(Lt_s + 280);
    La3 = *(const f32x4*)(Lt_s + 284);
    La4 = *(const f32x4*)(Lt_s + 288);
    La5 = *(const f32x4*)(Lt_s + 292);
    La6 = *(const f32x4*)(Lt_s + 296);
    La7 = *(const f32x4*)(Lt_s + 300);
    La8 = *(const f32x4*)(Lt_s + 304);
    La9 = *(const f32x4*)(Lt_s + 308);
    La10 = *(const f32x4*)(Lt_s + 312);
    La11 = *(const f32x4*)(Lt_s + 316);
    La12 = *(const f32x4*)(Lt_s + 320);
    La13 = *(const f32x4*)(Lt_s + 324);
    La14 = *(const f32x4*)(Lt_s + 328);
    La15 = *(const f32x4*)(Lt_s + 332);
    __builtin_amdgcn_sched_barrier(0);
    x4 -= Lb1[0] * x3;
    x5 -= Lb1[1] * x3;
    x6 -= Lb1[2] * x3;
    x7 -= Lb1[3] * x3;
    x8 -= Lb2[0] * x3;
    x9 -= Lb2[1] * x3;
    x10 -= Lb2[2] * x3;
    x11 -= Lb2[3] * x3;
    x12 -= Lb3[0] * x3;
    x13 -= Lb3[1] * x3;
    x14 -= Lb3[2] * x3;
    x15 -= Lb3[3] * x3;
    x16 -= Lb4[0] * x3;
    x17 -= Lb4[1] * x3;
    x18 -= Lb4[2] * x3;
    x19 -= Lb4[3] * x3;
    x20 -= Lb5[0] * x3;
    x21 -= Lb5[1] * x3;
    x22 -= Lb5[2] * x3;
    x23 -= Lb5[3] * x3;
    x24 -= Lb6[0] * x3;
    x25 -= Lb6[1] * x3;
    x26 -= Lb6[2] * x3;
    x27 -= Lb6[3] * x3;
    x28 -= Lb7[0] * x3;
    x29 -= Lb7[1] * x3;
    x30 -= Lb7[2] * x3;
    x31 -= Lb7[3] * x3;
    x32 -= Lb8[0] * x3;
    x33 -= Lb8[1] * x3;
    x34 -= Lb8[2] * x3;
    x35 -= Lb8[3] * x3;
    x36 -= Lb9[0] * x3;
    x37 -= Lb9[1] * x3;
    x38 -= Lb9[2] * x3;
    x39 -= Lb9[3] * x3;
    x40 -= Lb10[0] * x3;
    x41 -= Lb10[1] * x3;
    x42 -= Lb10[2] * x3;
    x43 -= Lb10[3] * x3;
    x44 -= Lb11[0] * x3;
    x45 -= Lb11[1] * x3;
    x46 -= Lb11[2] * x3;
    x47 -= Lb11[3] * x3;
    x48 -= Lb12[0] * x3;
    x49 -= Lb12[1] * x3;
    x50 -= Lb12[2] * x3;
    x51 -= Lb12[3] * x3;
    x52 -= Lb13[0] * x3;
    x53 -= Lb13[1] * x3;
    x54 -= Lb13[2] * x3;
    x55 -= Lb13[3] * x3;
    x56 -= Lb14[0] * x3;
    x57 -= Lb14[1] * x3;
    x58 -= Lb14[2] * x3;
    x59 -= Lb14[3] * x3;
    x60 -= Lb15[0] * x3;
    x61 -= Lb15[1] * x3;
    x62 -= Lb15[2] * x3;
    x63 -= Lb15[3] * x3;
    __builtin_amdgcn_sched_barrier(0);
    Lb1 = *(const f32x4*)(Lt_s + 344);
    Lb2 = *(const f32x4*)(Lt_s + 348);
    Lb3 = *(const f32x4*)(Lt_s + 352);
    Lb4 = *(const f32x4*)(Lt_s + 356);
    Lb5 = *(const f32x4*)(Lt_s + 360);
    Lb6 = *(const f32x4*)(Lt_s + 364);
    Lb7 = *(const f32x4*)(Lt_s + 368);
    Lb8 = *(const f32x4*)(Lt_s + 372);
    Lb9 = *(const f32x4*)(Lt_s + 376);
    Lb10 = *(const f32x4*)(Lt_s + 380);
    Lb11 = *(const f32x4*)(Lt_s + 384);
    Lb12 = *(const f32x4*)(Lt_s + 388);
    Lb13 = *(const f32x4*)(Lt_s + 392);
    Lb14 = *(const f32x4*)(Lt_s + 396);
    Lb15 = *(const f32x4*)(Lt_s + 400);
    __builtin_amdgcn_sched_barrier(0);
    x5 -= La1[1] * x4;
    x6 -= La1[2] * x4;
    x7 -= La1[3] * x4;
    x8 -= La2[0] * x4;
    x9 -= La2[1] * x4;
    x10 -= La2[2] * x4;
    x11 -= La2[3] * x4;
    x12 -= La3[0] * x4;
    x13 -= La3[1] * x4;
    x14 -= La3[2] * x4;
    x15 -= La3[3] * x4;
    x16 -= La4[0] * x4;
    x17 -= La4[1] * x4;
    x18 -= La4[2] * x4;
    x19 -= La4[3] * x4;
    x20 -= La5[0] * x4;
    x21 -= La5[1] * x4;
    x22 -= La5[2] * x4;
    x23 -= La5[3] * x4;
    x24 -= La6[0] * x4;
    x25 -= La6[1] * x4;
    x26 -= La6[2] * x4;
    x27 -= La6[3] * x4;
    x28 -= La7[0] * x4;
    x29 -= La7[1] * x4;
    x30 -= La7[2] * x4;
    x31 -= La7[3] * x4;
    x32 -= La8[0] * x4;
    x33 -= La8[1] * x4;
    x34 -= La8[2] * x4;
    x35 -= La8[3] * x4;
    x36 -= La9[0] * x4;
    x37 -= La9[1] * x4;
    x38 -= La9[2] * x4;
    x39 -= La9[3] * x4;
    x40 -= La10[0] * x4;
    x41 -= La10[1] * x4;
    x42 -= La10[2] * x4;
    x43 -= La10[3] * x4;
    x44 -= La11[0] * x4;
    x45 -= La11[1] * x4;
    x46 -= La11[2] * x4;
    x47 -= La11[3] * x4;
    x48 -= La12[0] * x4;
    x49 -= La12[1] * x4;
    x50 -= La12[2] * x4;
    x51 -= La12[3] * x4;
    x52 -= La13[0] * x4;
    x53 -= La13[1] * x4;
    x54 -= La13[2] * x4;
    x55 -= La13[3] * x4;
    x56 -= La14[0] * x4;
    x57 -= La14[1] * x4;
    x58 -= La14[2] * x4;
    x59 -= La14[3] * x4;
    x60 -= La15[0] * x4;
    x61 -= La15[1] * x4;
    x62 -= La15[2] * x4;
    x63 -= La15[3] * x4;
    __builtin_amdgcn_sched_barrier(0);
    La1 = *(const f32x4*)(Lt_s + 412);
    La2 = *(const f32x4*)(Lt_s + 416);
    La3 = *(const f32x4*)(Lt_s + 420);
    La4 = *(const f32x4*)(Lt_s + 424);
    La5 = *(const f32x4*)(Lt_s + 428);
    La6 = *(const f32x4*)(Lt_s + 432);
    La7 = *(const f32x4*)(Lt_s + 436);
    La8 = *(const f32x4*)(Lt_s + 440);
    La9 = *(const f32x4*)(Lt_s + 444);
    La10 = *(const f32x4*)(Lt_s + 448);
    La11 = *(const f32x4*)(Lt_s + 452);
    La12 = *(const f32x4*)(Lt_s + 456);
    La13 = *(const f32x4*)(Lt_s + 460);
    La14 = *(const f32x4*)(Lt_s + 464);
    La15 = *(const f32x4*)(Lt_s + 468);
    __builtin_amdgcn_sched_barrier(0);
    x6 -= Lb1[2] * x5;
    x7 -= Lb1[3] * x5;
    x8 -= Lb2[0] * x5;
    x9 -= Lb2[1] * x5;
    x10 -= Lb2[2] * x5;
    x11 -= Lb2[3] * x5;
    x12 -= Lb3[0] * x5;
    x13 -= Lb3[1] * x5;
    x14 -= Lb3[2] * x5;
    x15 -= Lb3[3] * x5;
    x16 -= Lb4[0] * x5;
    x17 -= Lb4[1] * x5;
    x18 -= Lb4[2] * x5;
    x19 -= Lb4[3] * x5;
    x20 -= Lb5[0] * x5;
    x21 -= Lb5[1] * x5;
    x22 -= Lb5[2] * x5;
    x23 -= Lb5[3] * x5;
    x24 -= Lb6[0] * x5;
    x25 -= Lb6[1] * x5;
    x26 -= Lb6[2] * x5;
    x27 -= Lb6[3] * x5;
    x28 -= Lb7[0] * x5;
    x29 -= Lb7[1] * x5;
    x30 -= Lb7[2] * x5;
    x31 -= Lb7[3] * x5;
    x32 -= Lb8[0] * x5;
    x33 -= Lb8[1] * x5;
    x34 -= Lb8[2] * x5;
    x35 -= Lb8[3] * x5;
    x36 -= Lb9[0] * x5;
    x37 -= Lb9[1] * x5;
    x38 -= Lb9[2] * x5;
    x39 -= Lb9[3] * x5;
    x40 -= Lb10[0] * x5;
    x41 -= Lb10[1] * x5;
    x42 -= Lb10[2] * x5;
    x43 -= Lb10[3] * x5;
    x44 -= Lb11[0] * x5;
    x45 -= Lb11[1] * x5;
    x46 -= Lb11[2] * x5;
    x47 -= Lb11[3] * x5;
    x48 -= Lb12[0] * x5;
    x49 -= Lb12[1] * x5;
    x50 -= Lb12[2] * x5;
    x51 -= Lb12[3] * x5;
    x52 -= Lb13[0] * x5;
    x53 -= Lb13[1] * x5;
    x54 -= Lb13[2] * x5;
    x55 -= Lb13[3] * x5;
    x56 -= Lb14[0] * x5;
    x57 -= Lb14[1] * x5;
    x58 -= Lb14[2] * x5;
    x59 -= Lb14[3] * x5;
    x60 -= Lb15[0] * x5;
    x61 -= Lb15[1] * x5;
    x62 -= Lb15[2] * x5;
    x63 -= Lb15[3] * x5;
    __builtin_amdgcn_sched_barrier(0);
    Lb2 = *(const f32x4*)(Lt_s + 484);
    Lb3 = *(const f32x4*)(Lt_s + 488);
    Lb4 = *(const f32x4*)(Lt_s + 492);
    Lb5 = *(const f32x4*)(Lt_s + 496);
    Lb6 = *(const f32x4*)(Lt_s + 500);
    Lb7 = *(const f32x4*)(Lt_s + 504);
    Lb8 = *(const f32x4*)(Lt_s + 508);
    Lb9 = *(const f32x4*)(Lt_s + 512);
    Lb10 = *(const f32x4*)(Lt_s + 516);
    Lb11 = *(const f32x4*)(Lt_s + 520);
    Lb12 = *(const f32x4*)(Lt_s + 524);
    Lb13 = *(const f32x4*)(Lt_s + 528);
    Lb14 = *(const f32x4*)(Lt_s + 532);
    Lb15 = *(const f32x4*)(Lt_s + 536);
    __builtin_amdgcn_sched_barrier(0);
    x7 -= La1[3] * x6;
    x8 -= La2[0] * x6;
    x9 -= La2[1] * x6;
    x10 -= La2[2] * x6;
    x11 -= La2[3] * x6;
    x12 -= La3[0] * x6;
    x13 -= La3[1] * x6;
    x14 -= La3[2] * x6;
    x15 -= La3[3] * x6;
    x16 -= La4[0] * x6;
    x17 -= La4[1] * x6;
    x18 -= La4[2] * x6;
    x19 -= La4[3] * x6;
    x20 -= La5[0] * x6;
    x21 -= La5[1] * x6;
    x22 -= La5[2] * x6;
    x23 -= La5[3] * x6;
    x24 -= La6[0] * x6;
    x25 -= La6[1] * x6;
    x26 -= La6[2] * x6;
    x27 -= La6[3] * x6;
    x28 -= La7[0] * x6;
    x29 -= La7[1] * x6;
    x30 -= La7[2] * x6;
    x31 -= La7[3] * x6;
    x32 -= La8[0] * x6;
    x33 -= La8[1] * x6;
    x34 -= La8[2] * x6;
    x35 -= La8[3] * x6;
    x36 -= La9[0] * x6;
    x37 -= La9[1] * x6;
    x38 -= La9[2] * x6;
    x39 -= La9[3] * x6;
    x40 -= La10[0] * x6;
    x41 -= La10[1] * x6;
    x42 -= La10[2] * x6;
    x43 -= La10[3] * x6;
    x44 -= La11[0] * x6;
    x45 -= La11[1] * x6;
    x46 -= La11[2] * x6;
    x47 -= La11[3] * x6;
    x48 -= La12[0] * x6;
    x49 -= La12[1] * x6;
    x50 -= La12[2] * x6;
    x51 -= La12[3] * x6;
    x52 -= La13[0] * x6;
    x53 -= La13[1] * x6;
    x54 -= La13[2] * x6;
    x55 -= La13[3] * x6;
    x56 -= La14[0] * x6;
    x57 -= La14[1] * x6;
    x58 -= La14[2] * x6;
    x59 -= La14[3] * x6;
    x60 -= La15[0] * x6;
    x61 -= La15[1] * x6;
    x62 -= La15[2] * x6;
    x63 -= La15[3] * x6;
    __builtin_amdgcn_sched_barrier(0);
    La2 = *(const f32x4*)(Lt_s + 552);
    La3 = *(const f32x4*)(Lt_s + 556);
    La4 = *(const f32x4*)(Lt_s + 560);
    La5 = *(const f32x4*)(Lt_s + 564);
    La6 = *(const f32x4*)(Lt_s + 568);
    La7 = *(const f32x4*)(Lt_s + 572);
    La8 = *(const f32x4*)(Lt_s + 576);
    La9 = *(const f32x4*)(Lt_s + 580);
    La10 = *(const f32x4*)(Lt_s + 584);
    La11 = *(const f32x4*)(Lt_s + 588);
    La12 = *(const f32x4*)(Lt_s + 592);
    La13 = *(const f32x4*)(Lt_s + 596);
    La14 = *(const f32x4*)(Lt_s + 600);
    La15 = *(const f32x4*)(Lt_s + 604);
    __builtin_amdgcn_sched_barrier(0);
    x8 -= Lb2[0] * x7;
    x9 -= Lb2[1] * x7;
    x10 -= Lb2[2] * x7;
    x11 -= Lb2[3] * x7;
    x12 -= Lb3[0] * x7;
    x13 -= Lb3[1] * x7;
    x14 -= Lb3[2] * x7;
    x15 -= Lb3[3] * x7;
    x16 -= Lb4[0] * x7;
    x17 -= Lb4[1] * x7;
    x18 -= Lb4[2] * x7;
    x19 -= Lb4[3] * x7;
    x20 -= Lb5[0] * x7;
    x21 -= Lb5[1] * x7;
    x22 -= Lb5[2] * x7;
    x23 -= Lb5[3] * x7;
    x24 -= Lb6[0] * x7;
    x25 -= Lb6[1] * x7;
    x26 -= Lb6[2] * x7;
    x27 -= Lb6[3] * x7;
    x28 -= Lb7[0] * x7;
    x29 -= Lb7[1] * x7;
    x30 -= Lb7[2] * x7;
    x31 -= Lb7[3] * x7;
    x32 -= Lb8[0] * x7;
    x33 -= Lb8[1] * x7;
    x34 -= Lb8[2] * x7;
    x35 -= Lb8[3] * x7;
    x36 -= Lb9[0] * x7;
    x37 -= Lb9[1] * x7;
    x38 -= Lb9[2] * x7;
    x39 -= Lb9[3] * x7;
    x40 -= Lb10[0] * x7;
    x41 -= Lb10[1] * x7;
    x42 -= Lb10[2] * x7;
    x43 -= Lb10[3] * x7;
    x44 -= Lb11[0] * x7;
    x45 -= Lb11[1] * x7;
    x46 -= Lb11[2] * x7;
    x47 -= Lb11[3] * x7;
    x48 -= Lb12[0] * x7;
    x49 -= Lb12[1] * x7;
    x50 -= Lb12[2] * x7;
    x51 -= Lb12[3] * x7;
    x52 -= Lb13[0] * x7;
    x53 -= Lb13[1] * x7;
    x54 -= Lb13[2] * x7;
    x55 -= Lb13[3] * x7;
    x56 -= Lb14[0] * x7;
    x57 -= Lb14[1] * x7;
    x58 -= Lb14[2] * x7;
    x59 -= Lb14[3] * x7;
    x60 -= Lb15[0] * x7;
    x61 -= Lb15[1] * x7;
    x62 -= Lb15[2] * x7;
    x63 -= Lb15[3] * x7;
    __builtin_amdgcn_sched_barrier(0);
    Lb2 = *(const f32x4*)(Lt_s + 620);
    Lb3 = *(const f32x4*)(Lt_s + 624);
    Lb4 = *(const f32x4*)(Lt_s + 628);
    Lb5 = *(const f32x4*)(Lt_s + 632);
    Lb6 = *(const f32x4*)(Lt_s + 636);
    Lb7 = *(const f32x4*)(Lt_s + 640);
    Lb8 = *(const f32x4*)(Lt_s + 644);
    Lb9 = *(const f32x4*)(Lt_s + 648);
    Lb10 = *(const f32x4*)(Lt_s + 652);
    Lb11 = *(const f32x4*)(Lt_s + 656);
    Lb12 = *(const f32x4*)(Lt_s + 660);
    Lb13 = *(const f32x4*)(Lt_s + 664);
    Lb14 = *(const f32x4*)(Lt_s + 668);
    Lb15 = *(const f32x4*)(Lt_s + 672);
    __builtin_amdgcn_sched_barrier(0);
    x9 -= La2[1] * x8;
    x10 -= La2[2] * x8;
    x11 -= La2[3] * x8;
    x12 -= La3[0] * x8;
    x13 -= La3[1] * x8;
    x14 -= La3[2] * x8;
    x15 -= La3[3] * x8;
    x16 -= La4[0] * x8;
    x17 -= La4[1] * x8;
    x18 -= La4[2] * x8;
    x19 -= La4[3] * x8;
    x20 -= La5[0] * x8;
    x21 -= La5[1] * x8;
    x22 -= La5[2] * x8;
    x23 -= La5[3] * x8;
    x24 -= La6[0] * x8;
    x25 -= La6[1] * x8;
    x26 -= La6[2] * x8;
    x27 -= La6[3] * x8;
    x28 -= La7[0] * x8;
    x29 -= La7[1] * x8;
    x30 -= La7[2] * x8;
    x31 -= La7[3] * x8;
    x32 -= La8[0] * x8;
    x33 -= La8[1] * x8;
    x34 -= La8[2] * x8;
    x35 -= La8[3] * x8;
    x36 -= La9[0] * x8;
    x37 -= La9[1] * x8;
    x38 -= La9[2] * x8;
    x39 -= La9[3] * x8;
    x40 -= La10[0] * x8;
    x41 -= La10[1] * x8;
    x42 -= La10[2] * x8;
    x43 -= La10[3] * x8;
    x44 -= La11[0] * x8;
    x45 -= La11[1] * x8;
    x46 -= La11[2] * x8;
    x47 -= La11[3] * x8;
    x48 -= La12[0] * x8;
    x49 -= La12[1] * x8;
    x50 -= La12[2] * x8;
    x51 -= La12[3] * x8;
    x52 -= La13[0] * x8;
    x53 -= La13[1] * x8;
    x54 -= La13[2] * x8;
    x55 -= La13[3] * x8;
    x56 -= La14[0] * x8;
    x57 -= La14[1] * x8;
    x58 -= La14[2] * x8;
    x59 -= La14[3] * x8;
    x60 -= La15[0] * x8;
    x61 -= La15[1] * x8;
    x62 -= La15[2] * x8;
    x63 -= La15[3] * x8;
    __builtin_amdgcn_sched_barrier(0);
    La2 = *(const f32x4*)(Lt_s + 688);
    La3 = *(const f32x4*)(Lt_s + 692);
    La4 = *(const f32x4*)(Lt_s + 696);
    La5 = *(const f32x4*)(Lt_s + 700);
    La6 = *(const f32x4*)(Lt_s + 704);
    La7 = *(const f32x4*)(Lt_s + 708);
    La8 = *(const f32x4*)(Lt_s + 712);
    La9 = *(const f32x4*)(Lt_s + 716);
    La10 = *(const f32x4*)(Lt_s + 720);
    La11 = *(const f32x4*)(Lt_s + 724);
    La12 = *(const f32x4*)(Lt_s + 728);
    La13 = *(const f32x4*)(Lt_s + 732);
    La14 = *(const f32x4*)(Lt_s + 736);
    La15 = *(const f32x4*)(Lt_s + 740);
    __builtin_amdgcn_sched_barrier(0);
    x10 -= Lb2[2] * x9;
    x11 -= Lb2[3] * x9;
    x12 -= Lb3[0] * x9;
    x13 -= Lb3[1] * x9;
    x14 -= Lb3[2] * x9;
    x15 -= Lb3[3] * x9;
    x16 -= Lb4[0] * x9;
    x17 -= Lb4[1] * x9;
    x18 -= Lb4[2] * x9;
    x19 -= Lb4[3] * x9;
    x20 -= Lb5[0] * x9;
    x21 -= Lb5[1] * x9;
    x22 -= Lb5[2] * x9;
    x23 -= Lb5[3] * x9;
    x24 -= Lb6[0] * x9;
    x25 -= Lb6[1] * x9;
    x26 -= Lb6[2] * x9;
    x27 -= Lb6[3] * x9;
    x28 -= Lb7[0] * x9;
    x29 -= Lb7[1] * x9;
    x30 -= Lb7[2] * x9;
    x31 -= Lb7[3] * x9;
    x32 -= Lb8[0] * x9;
    x33 -= Lb8[1] * x9;
    x34 -= Lb8[2] * x9;
    x35 -= Lb8[3] * x9;
    x36 -= Lb9[0] * x9;
    x37 -= Lb9[1] * x9;
    x38 -= Lb9[2] * x9;
    x39 -= Lb9[3] * x9;
    x40 -= Lb10[0] * x9;
    x41 -= Lb10[1] * x9;
    x42 -= Lb10[2] * x9;
    x43 -= Lb10[3] * x9;
    x44 -= Lb11[0] * x9;
    x45 -= Lb11[1] * x9;
    x46 -= Lb11[2] * x9;
    x47 -= Lb11[3] * x9;
    x48 -= Lb12[0] * x9;
    x49 -= Lb12[1] * x9;
    x50 -= Lb12[2] * x9;
    x51 -= Lb12[3] * x9;
    x52 -= Lb13[0] * x9;
    x53 -= Lb13[1] * x9;
    x54 -= Lb13[2] * x9;
    x55 -= Lb13[3] * x9;
    x56 -= Lb14[0] * x9;
    x57 -= Lb14[1] * x9;
    x58 -= Lb14[2] * x9;
    x59 -= Lb14[3] * x9;
    x60 -= Lb15[0] * x9;
    x61 -= Lb15[1] * x9;
    x62 -= Lb15[2] * x9;
    x63 -= Lb15[3] * x9;
    __builtin_amdgcn_sched_barrier(0);
    Lb3 = *(const f32x4*)(Lt_s + 760);
    Lb4 = *(const f32x4*)(Lt_s + 764);
    Lb5 = *(const f32x4*)(Lt_s + 768);
    Lb6 = *(const f32x4*)(Lt_s + 772);
    Lb7 = *(const f32x4*)(Lt_s + 776);
    Lb8 = *(const f32x4*)(Lt_s + 780);
    Lb9 = *(const f32x4*)(Lt_s + 784);
    Lb10 = *(const f32x4*)(Lt_s + 788);
    Lb11 = *(const f32x4*)(Lt_s + 792);
    Lb12 = *(const f32x4*)(Lt_s + 796);
    Lb13 = *(const f32x4*)(Lt_s + 800);
    Lb14 = *(const f32x4*)(Lt_s + 804);
    Lb15 = *(const f32x4*)(Lt_s + 808);
    __builtin_amdgcn_sched_barrier(0);
    x11 -= La2[3] * x10;
    x12 -= La3[0] * x10;
    x13 -= La3[1] * x10;
    x14 -= La3[2] * x10;
    x15 -= La3[3] * x10;
    x16 -= La4[0] * x10;
    x17 -= La4[1] * x10;
    x18 -= La4[2] * x10;
    x19 -= La4[3] * x10;
    x20 -= La5[0] * x10;
    x21 -= La5[1] * x10;
    x22 -= La5[2] * x10;
    x23 -= La5[3] * x10;
    x24 -= La6[0] * x10;
    x25 -= La6[1] * x10;
    x26 -= La6[2] * x10;
    x27 -= La6[3] * x10;
    x28 -= La7[0] * x10;
    x29 -= La7[1] * x10;
    x30 -= La7[2] * x10;
    x31 -= La7[3] * x10;
    x32 -= La8[0] * x10;
    x33 -= La8[1] * x10;
    x34 -= La8[2] * x10;
    x35 -= La8[3] * x10;
    x36 -= La9[0] * x10;
    x37 -= La9[1] * x10;
    x38 -= La9[2] * x10;
    x39 -= La9[3] * x10;
    x40 -= La10[0] * x10;
    x41 -= La10[1] * x10;
    x42 -= La10[2] * x10;
    x43 -= La10[3] * x10;
    x44 -= La11[0] * x10;
    x45 -= La11[1] * x10;
    x46 -= La11[2] * x10;
    x47 -= La11[3] * x10;
    x48 -= La12[0] * x10;
    x49 -= La12[1] * x10;
    x50 -= La12[2] * x10;
    x51 -= La12[3] * x10;
    x52 -= La13[0] * x10;
    x53 -= La13[1] * x10;
    x54 -= La13[2] * x10;
    x55 -= La13[3] * x10;
    x56 -= La14[0] * x10;
    x57 -= La14[1] * x10;
    x58 -= La14[2] * x10;
    x59 -= La14[3] * x10;
    x60 -= La15[0] * x10;
    x61 -= La15[1] * x10;
    x62 -= La15[2] * x10;
    x63 -= La15[3] * x10;
    __builtin_amdgcn_sched_barrier(0);
    La3 = *(const f32x4*)(Lt_s + 828);
    La4 = *(const f32x4*)(Lt_s + 832);
    La5 = *(const f32x4*)(Lt_s + 836);
    La6 = *(const f32x4*)(Lt_s + 840);
    La7 = *(const f32x4*)(Lt_s + 844);
    La8 = *(const f32x4*)(Lt_s + 848);
    La9 = *(const f32x4*)(Lt_s + 852);
    La10 = *(const f32x4*)(Lt_s + 856);
    La11 = *(const f32x4*)(Lt_s + 860);
    La12 = *(const f32x4*)(Lt_s + 864);
    La13 = *(const f32x4*)(Lt_s + 868);
    La14 = *(const f32x4*)(Lt_s + 872);
    La15 = *(const f32x4*)(Lt_s + 876);
    __builtin_amdgcn_sched_barrier(0);
    x12 -= Lb3[0] * x11;
    x13 -= Lb3[1] * x11;
    x14 -= Lb3[2] * x11;
    x15 -= Lb3[3] * x11;
    x16 -= Lb4[0] * x11;
    x17 -= Lb4[1] * x11;
    x18 -= Lb4[2] * x11;
    x19 -= Lb4[3] * x11;
    x20 -= Lb5[0] * x11;
    x21 -= Lb5[1] * x11;
    x22 -= Lb5[2] * x11;
    x23 -= Lb5[3] * x11;
    x24 -= Lb6[0] * x11;
    x25 -= Lb6[1] * x11;
    x26 -= Lb6[2] * x11;
    x27 -= Lb6[3] * x11;
    x28 -= Lb7[0] * x11;
    x29 -= Lb7[1] * x11;
    x30 -= Lb7[2] * x11;
    x31 -= Lb7[3] * x11;
    x32 -= Lb8[0] * x11;
    x33 -= Lb8[1] * x11;
    x34 -= Lb8[2] * x11;
    x35 -= Lb8[3] * x11;
    x36 -= Lb9[0] * x11;
    x37 -= Lb9[1] * x11;
    x38 -= Lb9[2] * x11;
    x39 -= Lb9[3] * x11;
    x40 -= Lb10[0] * x11;
    x41 -= Lb10[1] * x11;
    x42 -= Lb10[2] * x11;
    x43 -= Lb10[3] * x11;
    x44 -= Lb11[0] * x11;
    x45 -= Lb11[1] * x11;
    x46 -= Lb11[2] * x11;
    x47 -= Lb11[3] * x11;
    x48 -= Lb12[0] * x11;
    x49 -= Lb12[1] * x11;
    x50 -= Lb12[2] * x11;
    x51 -= Lb12[3] * x11;
    x52 -= Lb13[0] * x11;
    x53 -= Lb13[1] * x11;
    x54 -= Lb13[2] * x11;
    x55 -= Lb13[3] * x11;
    x56 -= Lb14[0] * x11;
    x57 -= Lb14[1] * x11;
    x58 -= Lb14[2] * x11;
    x59 -= Lb14[3] * x11;
    x60 -= Lb15[0] * x11;
    x61 -= Lb15[1] * x11;
    x62 -= Lb15[2] * x11;
    x63 -= Lb15[3] * x11;
    __builtin_amdgcn_sched_barrier(0);
    Lb3 = *(const f32x4*)(Lt_s + 896);
    Lb4 = *(const f32x4*)(Lt_s + 900);
    Lb5 = *(const f32x4*)(Lt_s + 904);
    Lb6 = *(const f32x4*)(Lt_s + 908);
    Lb7 = *(const f32x4*)(Lt_s + 912);
    Lb8 = *(const f32x4*)(Lt_s + 916);
    Lb9 = *(const f32x4*)(Lt_s + 920);
    Lb10 = *(const f32x4*)(Lt_s + 924);
    Lb11 = *(const f32x4*)(Lt_s + 928);
    Lb12 = *(const f32x4*)(Lt_s + 932);
    Lb13 = *(const f32x4*)(Lt_s + 936);
    Lb14 = *(const f32x4*)(Lt_s + 940);
    Lb15 = *(const f32x4*)(Lt_s + 944);
    __builtin_amdgcn_sched_barrier(0);
    x13 -= La3[1] * x12;
    x14 -= La3[2] * x12;
    x15 -= La3[3] * x12;
    x16 -= La4[0] * x12;
    x17 -= La4[1] * x12;
    x18 -= La4[2] * x12;
    x19 -= La4[3] * x12;
    x20 -= La5[0] * x12;
    x21 -= La5[1] * x12;
    x22 -= La5[2] * x12;
    x23 -= La5[3] * x12;
    x24 -= La6[0] * x12;
    x25 -= La6[1] * x12;
    x26 -= La6[2] * x12;
    x27 -= La6[3] * x12;
    x28 -= La7[0] * x12;
    x29 -= La7[1] * x12;
    x30 -= La7[2] * x12;
    x31 -= La7[3] * x12;
    x32 -= La8[0] * x12;
    x33 -= La8[1] * x12;
    x34 -= La8[2] * x12;
    x35 -= La8[3] * x12;
    x36 -= La9[0] * x12;
    x37 -= La9[1] * x12;
    x38 -= La9[2] * x12;
    x39 -= La9[3] * x12;
    x40 -= La10[0] * x12;
    x41 -= La10[1] * x12;
    x42 -= La10[2] * x12;
    x43 -= La10[3] * x12;
    x44 -= La11[0] * x12;
    x45 -= La11[1] * x12;
    x46 -= La11[2] * x12;
    x47 -= La11[3] * x12;
    x48 -= La12[0] * x12;
    x49 -= La12[1] * x12;
    x50 -= La12[2] * x12;
    x51 -= La12[3] * x12;
    x52 -= La13[0] * x12;
    x53 -= La13[1] * x12;
    x54 -= La13[2] * x12;
    x55 -= La13[3] * x12;
    x56 -= La14[0] * x12;
    x57 -= La14[1] * x12;
    x58 -= La14[2] * x12;
    x59 -= La14[3] * x12;
    x60 -= La15[0] * x12;
    x61 -= La15[1] * x12;
    x62 -= La15[2] * x12;
    x63 -= La15[3] * x12;
    __builtin_amdgcn_sched_barrier(0);
    La3 = *(const f32x4*)(Lt_s + 964);
    La4 = *(const f32x4*)(Lt_s + 968);
    La5 = *(const f32x4*)(Lt_s + 972);
    La6 = *(const f32x4*)(Lt_s + 976);
    La7 = *(const f32x4*)(Lt_s + 980);
    La8 = *(const f32x4*)(Lt_s + 984);
    La9 = *(const f32x4*)(Lt_s + 988);
    La10 = *(const f32x4*)(Lt_s + 992);
    La11 = *(const f32x4*)(Lt_s + 996);
    La12 = *(const f32x4*)(Lt_s + 1000);
    La13 = *(const f32x4*)(Lt_s + 1004);
    La14 = *(const f32x4*)(Lt_s + 1008);
    La15 = *(const f32x4*)(Lt_s + 1012);
    __builtin_amdgcn_sched_barrier(0);
    x14 -= Lb3[2] * x13;
    x15 -= Lb3[3] * x13;
    x16 -= Lb4[0] * x13;
    x17 -= Lb4[1] * x13;
    x18 -= Lb4[2] * x13;
    x19 -= Lb4[3] * x13;
    x20 -= Lb5[0] * x13;
    x21 -= Lb5[1] * x13;
    x22 -= Lb5[2] * x13;
    x23 -= Lb5[3] * x13;
    x24 -= Lb6[0] * x13;
    x25 -= Lb6[1] * x13;
    x26 -= Lb6[2] * x13;
    x27 -= Lb6[3] * x13;
    x28 -= Lb7[0] * x13;
    x29 -= Lb7[1] * x13;
    x30 -= Lb7[2] * x13;
    x31 -= Lb7[3] * x13;
    x32 -= Lb8[0] * x13;
    x33 -= Lb8[1] * x13;
    x34 -= Lb8[2] * x13;
    x35 -= Lb8[3] * x13;
    x36 -= Lb9[0] * x13;
    x37 -= Lb9[1] * x13;
    x38 -= Lb9[2] * x13;
    x39 -= Lb9[3] * x13;
    x40 -= Lb10[0] * x13;
    x41 -= Lb10[1] * x13;
    x42 -= Lb10[2] * x13;
    x43 -= Lb10[3] * x13;
    x44 -= Lb11[0] * x13;
    x45 -= Lb11[1] * x13;
    x46 -= Lb11[2] * x13;
    x47 -= Lb11[3] * x13;
    x48 -= Lb12[0] * x13;
    x49 -= Lb12[1] * x13;
    x50 -= Lb12[2] * x13;
    x51 -= Lb12[3] * x13;
    x52 -= Lb13[0] * x13;
    x53 -= Lb13[1] * x13;
    x54 -= Lb13[2] * x13;
    x55 -= Lb13[3] * x13;
    x56 -= Lb14[0] * x13;
    x57 -= Lb14[1] * x13;
    x58 -= Lb14[2] * x13;
    x59 -= Lb14[3] * x13;
    x60 -= Lb15[0] * x13;
    x61 -= Lb15[1] * x13;
    x62 -= Lb15[2] * x13;
    x63 -= Lb15[3] * x13;
    __builtin_amdgcn_sched_barrier(0);
    Lb4 = *(const f32x4*)(Lt_s + 1036);
    Lb5 = *(const f32x4*)(Lt_s + 1040);
    Lb6 = *(const f32x4*)(Lt_s + 1044);
    Lb7 = *(const f32x4*)(Lt_s + 1048);
    Lb8 = *(const f32x4*)(Lt_s + 1052);
    Lb9 = *(const f32x4*)(Lt_s + 1056);
    Lb10 = *(const f32x4*)(Lt_s + 1060);
    Lb11 = *(const f32x4*)(Lt_s + 1064);
    Lb12 = *(const f32x4*)(Lt_s + 1068);
    Lb13 = *(const f32x4*)(Lt_s + 1072);
    Lb14 = *(const f32x4*)(Lt_s + 1076);
    Lb15 = *(const f32x4*)(Lt_s + 1080);
    __builtin_amdgcn_sched_barrier(0);
    x15 -= La3[3] * x14;
    x16 -= La4[0] * x14;
    x17 -= La4[1] * x14;
    x18 -= La4[2] * x14;
    x19 -= La4[3] * x14;
    x20 -= La5[0] * x14;
    x21 -= La5[1] * x14;
    x22 -= La5[2] * x14;
    x23 -= La5[3] * x14;
    x24 -= La6[0] * x14;
    x25 -= La6[1] * x14;
    x26 -= La6[2] * x14;
    x27 -= La6[3] * x14;
    x28 -= La7[0] * x14;
    x29 -= La7[1] * x14;
    x30 -= La7[2] * x14;
    x31 -= La7[3] * x14;
    x32 -= La8[0] * x14;
    x33 -= La8[1] * x14;
    x34 -= La8[2] * x14;
    x35 -= La8[3] * x14;
    x36 -= La9[0] * x14;
    x37 -= La9[1] * x14;
    x38 -= La9[2] * x14;
    x39 -= La9[3] * x14;
    x40 -= La10[0] * x14;
    x41 -= La10[1] * x14;
    x42 -= La10[2] * x14;
    x43 -= La10[3] * x14;
    x44 -= La11[0] * x14;
    x45 -= La11[1] * x14;
    x46 -= La11[2] * x14;
    x47 -= La11[3] * x14;
    x48 -= La12[0] * x14;
    x49 -= La12[1] * x14;
    x50 -= La12[2] * x14;
    x51 -= La12[3] * x14;
    x52 -= La13[0] * x14;
    x53 -= La13[1] * x14;
    x54 -= La13[2] * x14;
    x55 -= La13[3] * x14;
    x56 -= La14[0] * x14;
    x57 -= La14[1] * x14;
    x58 -= La14[2] * x14;
    x59 -= La14[3] * x14;
    x60 -= La15[0] * x14;
    x61 -= La15[1] * x14;
    x62 -= La15[2] * x14;
    x63 -= La15[3] * x14;
    __builtin_amdgcn_sched_barrier(0);
    La4 = *(const f32x4*)(Lt_s + 1104);
    La5 = *(const f32x4*)(Lt_s + 1108);
    La6 = *(const f32x4*)(Lt_s + 1112);
    La7 = *(const f32x4*)(Lt_s + 1116);
    La8 = *(const f32x4*)(Lt_s + 1120);
    La9 = *(const f32x4*)(Lt_s + 1124);
    La10 = *(const f32x4*)(Lt_s + 1128);
    La11 = *(const f32x4*)(Lt_s + 1132);
    La12 = *(const f32x4*)(Lt_s + 1136);
    La13 = *(const f32x4*)(Lt_s + 1140);
    La14 = *(const f32x4*)(Lt_s + 1144);
    La15 = *(const f32x4*)(Lt_s + 1148);
    __builtin_amdgcn_sched_barrier(0);
    x16 -= Lb4[0] * x15;
    x17 -= Lb4[1] * x15;
    x18 -= Lb4[2] * x15;
    x19 -= Lb4[3] * x15;
    x20 -= Lb5[0] * x15;
    x21 -= Lb5[1] * x15;
    x22 -= Lb5[2] * x15;
    x23 -= Lb5[3] * x15;
    x24 -= Lb6[0] * x15;
    x25 -= Lb6[1] * x15;
    x26 -= Lb6[2] * x15;
    x27 -= Lb6[3] * x15;
    x28 -= Lb7[0] * x15;
    x29 -= Lb7[1] * x15;
    x30 -= Lb7[2] * x15;
    x31 -= Lb7[3] * x15;
    x32 -= Lb8[0] * x15;
    x33 -= Lb8[1] * x15;
    x34 -= Lb8[2] * x15;
    x35 -= Lb8[3] * x15;
    x36 -= Lb9[0] * x15;
    x37 -= Lb9[1] * x15;
    x38 -= Lb9[2] * x15;
    x39 -= Lb9[3] * x15;
    x40 -= Lb10[0] * x15;
    x41 -= Lb10[1] * x15;
    x42 -= Lb10[2] * x15;
    x43 -= Lb10[3] * x15;
    x44 -= Lb11[0] * x15;
    x45 -= Lb11[1] * x15;
    x46 -= Lb11[2] * x15;
    x47 -= Lb11[3] * x15;
    x48 -= Lb12[0] * x15;
    x49 -= Lb12[1] * x15;
    x50 -= Lb12[2] * x15;
    x51 -= Lb12[3] * x15;
    x52 -= Lb13[0] * x15;
    x53 -= Lb13[1] * x15;
    x54 -= Lb13[2] * x15;
    x55 -= Lb13[3] * x15;
    x56 -= Lb14[0] * x15;
    x57 -= Lb14[1] * x15;
    x58 -= Lb14[2] * x15;
    x59 -= Lb14[3] * x15;
    x60 -= Lb15[0] * x15;
    x61 -= Lb15[1] * x15;
    x62 -= Lb15[2] * x15;
    x63 -= Lb15[3] * x15;
    __builtin_amdgcn_sched_barrier(0);
    Lb4 = *(const f32x4*)(Lt_s + 1172);
    Lb5 = *(const f32x4*)(Lt_s + 1176);
    Lb6 = *(const f32x4*)(Lt_s + 1180);
    Lb7 = *(const f32x4*)(Lt_s + 1184);
    Lb8 = *(const f32x4*)(Lt_s + 1188);
    Lb9 = *(const f32x4*)(Lt_s + 1192);
    Lb10 = *(const f32x4*)(Lt_s + 1196);
    Lb11 = *(const f32x4*)(Lt_s + 1200);
    Lb12 = *(const f32x4*)(Lt_s + 1204);
    Lb13 = *(const f32x4*)(Lt_s + 1208);
    Lb14 = *(const f32x4*)(Lt_s + 1212);
    Lb15 = *(const f32x4*)(Lt_s + 1216);
    __builtin_amdgcn_sched_barrier(0);
    x17 -= La4[1] * x16;
    x18 -= La4[2] * x16;
    x19 -= La4[3] * x16;
    x20 -= La5[0] * x16;
    x21 -= La5[1] * x16;
    x22 -= La5[2] * x16;
    x23 -= La5[3] * x16;
    x24 -= La6[0] * x16;
    x25 -= La6[1] * x16;
    x26 -= La6[2] * x16;
    x27 -= La6[3] * x16;
    x28 -= La7[0] * x16;
    x29 -= La7[1] * x16;
    x30 -= La7[2] * x16;
    x31 -= La7[3] * x16;
    x32 -= La8[0] * x16;
    x33 -= La8[1] * x16;
    x34 -= La8[2] * x16;
    x35 -= La8[3] * x16;
    x36 -= La9[0] * x16;
    x37 -= La9[1] * x16;
    x38 -= La9[2] * x16;
    x39 -= La9[3] * x16;
    x40 -= La10[0] * x16;
    x41 -= La10[1] * x16;
    x42 -= La10[2] * x16;
    x43 -= La10[3] * x16;
    x44 -= La11[0] * x16;
    x45 -= La11[1] * x16;
    x46 -= La11[2] * x16;
    x47 -= La11[3] * x16;
    x48 -= La12[0] * x16;
    x49 -= La12[1] * x16;
    x50 -= La12[2] * x16;
    x51 -= La12[3] * x16;
    x52 -= La13[0] * x16;
    x53 -= La13[1] * x16;
    x54 -= La13[2] * x16;
    x55 -= La13[3] * x16;
    x56 -= La14[0] * x16;
    x57 -= La14[1] * x16;
    x58 -= La14[2] * x16;
    x59 -= La14[3] * x16;
    x60 -= La15[0] * x16;
    x61 -= La15[1] * x16;
    x62 -= La15[2] * x16;
    x63 -= La15[3] * x16;
    __builtin_amdgcn_sched_barrier(0);
    La4 = *(const f32x4*)(Lt_s + 1240);
    La5 = *(const f32x4*)(Lt_s + 1244);
    La6 = *(const f32x4*)(Lt_s + 1248);
    La7 = *(const f32x4*)(Lt_s + 1252);
    La8 = *(const f32x4*)(Lt_s + 1256);
    La9 = *(const f32x4*)(Lt_s + 1260);
    La10 = *(const f32x4*)(Lt_s + 1264);
    La11 = *(const f32x4*)(Lt_s + 1268);
    La12 = *(const f32x4*)(Lt_s + 1272);
    La13 = *(const f32x4*)(Lt_s + 1276);
    La14 = *(const f32x4*)(Lt_s + 1280);
    La15 = *(const f32x4*)(Lt_s + 1284);
    __builtin_amdgcn_sched_barrier(0);
    x18 -= Lb4[2] * x17;
    x19 -= Lb4[3] * x17;
    x20 -= Lb5[0] * x17;
    x21 -= Lb5[1] * x17;
    x22 -= Lb5[2] * x17;
    x23 -= Lb5[3] * x17;
    x24 -= Lb6[0] * x17;
    x25 -= Lb6[1] * x17;
    x26 -= Lb6[2] * x17;
    x27 -= Lb6[3] * x17;
    x28 -= Lb7[0] * x17;
    x29 -= Lb7[1] * x17;
    x30 -= Lb7[2] * x17;
    x31 -= Lb7[3] * x17;
    x32 -= Lb8[0] * x17;
    x33 -= Lb8[1] * x17;
    x34 -= Lb8[2] * x17;
    x35 -= Lb8[3] * x17;
    x36 -= Lb9[0] * x17;
    x37 -= Lb9[1] * x17;
    x38 -= Lb9[2] * x17;
    x39 -= Lb9[3] * x17;
    x40 -= Lb10[0] * x17;
    x41 -= Lb10[1] * x17;
    x42 -= Lb10[2] * x17;
    x43 -= Lb10[3] * x17;
    x44 -= Lb11[0] * x17;
    x45 -= Lb11[1] * x17;
    x46 -= Lb11[2] * x17;
    x47 -= Lb11[3] * x17;
    x48 -= Lb12[0] * x17;
    x49 -= Lb12[1] * x17;
    x50 -= Lb12[2] * x17;
    x51 -= Lb12[3] * x17;
    x52 -= Lb13[0] * x17;
    x53 -= Lb13[1] * x17;
    x54 -= Lb13[2] * x17;
    x55 -= Lb13[3] * x17;
    x56 -= Lb14[0] * x17;
    x57 -= Lb14[1] * x17;
    x58 -= Lb14[2] * x17;
    x59 -= Lb14[3] * x17;
    x60 -= Lb15[0] * x17;
    x61 -= Lb15[1] * x17;
    x62 -= Lb15[2] * x17;
    x63 -= Lb15[3] * x17;
    __builtin_amdgcn_sched_barrier(0);
    Lb5 = *(const f32x4*)(Lt_s + 1312);
    Lb6 = *(const f32x4*)(Lt_s + 1316);
    Lb7 = *(const f32x4*)(Lt_s + 1320);
    Lb8 = *(const f32x4*)(Lt_s + 1324);
    Lb9 = *(const f32x4*)(Lt_s + 1328);
    Lb10 = *(const f32x4*)(Lt_s + 1332);
    Lb11 = *(const f32x4*)(Lt_s + 1336);
    Lb12 = *(const f32x4*)(Lt_s + 1340);
    Lb13 = *(const f32x4*)(Lt_s + 1344);
    Lb14 = *(const f32x4*)(Lt_s + 1348);
    Lb15 = *(const f32x4*)(Lt_s + 1352);
    __builtin_amdgcn_sched_barrier(0);
    x19 -= La4[3] * x18;
    x20 -= La5[0] * x18;
    x21 -= La5[1] * x18;
    x22 -= La5[2] * x18;
    x23 -= La5[3] * x18;
    x24 -= La6[0] * x18;
    x25 -= La6[1] * x18;
    x26 -= La6[2] * x18;
    x27 -= La6[3] * x18;
    x28 -= La7[0] * x18;
    x29 -= La7[1] * x18;
    x30 -= La7[2] * x18;
    x31 -= La7[3] * x18;
    x32 -= La8[0] * x18;
    x33 -= La8[1] * x18;
    x34 -= La8[2] * x18;
    x35 -= La8[3] * x18;
    x36 -= La9[0] * x18;
    x37 -= La9[1] * x18;
    x38 -= La9[2] * x18;
    x39 -= La9[3] * x18;
    x40 -= La10[0] * x18;
    x41 -= La10[1] * x18;
    x42 -= La10[2] * x18;
    x43 -= La10[3] * x18;
    x44 -= La11[0] * x18;
    x45 -= La11[1] * x18;
    x46 -= La11[2] * x18;
    x47 -= La11[3] * x18;
    x48 -= La12[0] * x18;
    x49 -= La12[1] * x18;
    x50 -= La12[2] * x18;
    x51 -= La12[3] * x18;
    x52 -= La13[0] * x18;
    x53 -= La13[1] * x18;
    x54 -= La13[2] * x18;
    x55 -= La13[3] * x18;
    x56 -= La14[0] * x18;
    x57 -= La14[1] * x18;
    x58 -= La14[2] * x18;
    x59 -= La14[3] * x18;
    x60 -= La15[0] * x18;
    x61 -= La15[1] * x18;
    x62 -= La15[2] * x18;
    x63 -= La15[3] * x18;
    __builtin_amdgcn_sched_barrier(0);
    La5 = *(const f32x4*)(Lt_s + 1380);
    La6 = *(const f32x4*)(Lt_s + 1384);
    La7 = *(const f32x4*)(Lt_s + 1388);
    La8 = *(const f32x4*)(Lt_s + 1392);
    La9 = *(const f32x4*)(Lt_s + 1396);
    La10 = *(const f32x4*)(Lt_s + 1400);
    La11 = *(const f32x4*)(Lt_s + 1404);
    La12 = *(const f32x4*)(Lt_s + 1408);
    La13 = *(const f32x4*)(Lt_s + 1412);
    La14 = *(const f32x4*)(Lt_s + 1416);
    La15 = *(const f32x4*)(Lt_s + 1420);
    __builtin_amdgcn_sched_barrier(0);
    x20 -= Lb5[0] * x19;
    x21 -= Lb5[1] * x19;
    x22 -= Lb5[2] * x19;
    x23 -= Lb5[3] * x19;
    x24 -= Lb6[0] * x19;
    x25 -= Lb6[1] * x19;
    x26 -= Lb6[2] * x19;
    x27 -= Lb6[3] * x19;
    x28 -= Lb7[0] * x19;
    x29 -= Lb7[1] * x19;
    x30 -= Lb7[2] * x19;
    x31 -= Lb7[3] * x19;
    x32 -= Lb8[0] * x19;
    x33 -= Lb8[1] * x19;
    x34 -= Lb8[2] * x19;
    x35 -= Lb8[3] * x19;
    x36 -= Lb9[0] * x19;
    x37 -= Lb9[1] * x19;
    x38 -= Lb9[2] * x19;
    x39 -= Lb9[3] * x19;
    x40 -= Lb10[0] * x19;
    x41 -= Lb10[1] * x19;
    x42 -= Lb10[2] * x19;
    x43 -= Lb10[3] * x19;
    x44 -= Lb11[0] * x19;
    x45 -= Lb11[1] * x19;
    x46 -= Lb11[2] * x19;
    x47 -= Lb11[3] * x19;
    x48 -= Lb12[0] * x19;
    x49 -= Lb12[1] * x19;
    x50 -= Lb12[2] * x19;
    x51 -= Lb12[3] * x19;
    x52 -= Lb13[0] * x19;
    x53 -= Lb13[1] * x19;
    x54 -= Lb13[2] * x19;
    x55 -= Lb13[3] * x19;
    x56 -= Lb14[0] * x19;
    x57 -= Lb14[1] * x19;
    x58 -= Lb14[2] * x19;
    x59 -= Lb14[3] * x19;
    x60 -= Lb15[0] * x19;
    x61 -= Lb15[1] * x19;
    x62 -= Lb15[2] * x19;
    x63 -= Lb15[3] * x19;
    __builtin_amdgcn_sched_barrier(0);
    Lb5 = *(const f32x4*)(Lt_s + 1448);
    Lb6 = *(const f32x4*)(Lt_s + 1452);
    Lb7 = *(const f32x4*)(Lt_s + 1456);
    Lb8 = *(const f32x4*)(Lt_s + 1460);
    Lb9 = *(const f32x4*)(Lt_s + 1464);
    Lb10 = *(const f32x4*)(Lt_s + 1468);
    Lb11 = *(const f32x4*)(Lt_s + 1472);
    Lb12 = *(const f32x4*)(Lt_s + 1476);
    Lb13 = *(const f32x4*)(Lt_s + 1480);
    Lb14 = *(const f32x4*)(Lt_s + 1484);
    Lb15 = *(const f32x4*)(Lt_s + 1488);
    __builtin_amdgcn_sched_barrier(0);
    x21 -= La5[1] * x20;
    x22 -= La5[2] * x20;
    x23 -= La5[3] * x20;
    x24 -= La6[0] * x20;
    x25 -= La6[1] * x20;
    x26 -= La6[2] * x20;
    x27 -= La6[3] * x20;
    x28 -= La7[0] * x20;
    x29 -= La7[1] * x20;
    x30 -= La7[2] * x20;
    x31 -= La7[3] * x20;
    x32 -= La8[0] * x20;
    x33 -= La8[1] * x20;
    x34 -= La8[2] * x20;
    x35 -= La8[3] * x20;
    x36 -= La9[0] * x20;
    x37 -= La9[1] * x20;
    x38 -= La9[2] * x20;
    x39 -= La9[3] * x20;
    x40 -= La10[0] * x20;
    x41 -= La10[1] * x20;
    x42 -= La10[2] * x20;
    x43 -= La10[3] * x20;
    x44 -= La11[0] * x20;
    x45 -= La11[1] * x20;
    x46 -= La11[2] * x20;
    x47 -= La11[3] * x20;
    x48 -= La12[0] * x20;
    x49 -= La12[1] * x20;
    x50 -= La12[2] * x20;
    x51 -= La12[3] * x20;
    x52 -= La13[0] * x20;
    x53 -= La13[1] * x20;
    x54 -= La13[2] * x20;
    x55 -= La13[3] * x20;
    x56 -= La14[0] * x20;
    x57 -= La14[1] * x20;
    x58 -= La14[2] * x20;
    x59 -= La14[3] * x20;
    x60 -= La15[0] * x20;
    x61 -= La15[1] * x20;
    x62 -= La15[2] * x20;
    x63 -= La15[3] * x20;
    __builtin_amdgcn_sched_barrier(0);
    La5 = *(const f32x4*)(Lt_s + 1516);
    La6 = *(const f32x4*)(Lt_s + 1520);
    La7 = *(const f32x4*)(Lt_s + 1524);
    La8 = *(const f32x4*)(Lt_s + 1528);
    La9 = *(const f32x4*)(Lt_s + 1532);
    La10 = *(const f32x4*)(Lt_s + 1536);
    La11 = *(const f32x4*)(Lt_s + 1540);
    La12 = *(const f32x4*)(Lt_s + 1544);
    La13 = *(const f32x4*)(Lt_s + 1548);
    La14 = *(const f32x4*)(Lt_s + 1552);
    La15 = *(const f32x4*)(Lt_s + 1556);
    __builtin_amdgcn_sched_barrier(0);
    x22 -= Lb5[2] * x21;
    x23 -= Lb5[3] * x21;
    x24 -= Lb6[0] * x21;
    x25 -= Lb6[1] * x21;
    x26 -= Lb6[2] * x21;
    x27 -= Lb6[3] * x21;
    x28 -= Lb7[0] * x21;
    x29 -= Lb7[1] * x21;
    x30 -= Lb7[2] * x21;
    x31 -= Lb7[3] * x21;
    x32 -= Lb8[0] * x21;
    x33 -= Lb8[1] * x21;
    x34 -= Lb8[2] * x21;
    x35 -= Lb8[3] * x21;
    x36 -= Lb9[0] * x21;
    x37 -= Lb9[1] * x21;
    x38 -= Lb9[2] * x21;
    x39 -= Lb9[3] * x21;
    x40 -= Lb10[0] * x21;
    x41 -= Lb10[1] * x21;
    x42 -= Lb10[2] * x21;
    x43 -= Lb10[3] * x21;
    x44 -= Lb11[0] * x21;
    x45 -= Lb11[1] * x21;
    x46 -= Lb11[2] * x21;
    x47 -= Lb11[3] * x21;
    x48 -= Lb12[0] * x21;
    x49 -= Lb12[1] * x21;
    x50 -= Lb12[2] * x21;
    x51 -= Lb12[3] * x21;
    x52 -= Lb13[0] * x21;
    x53 -= Lb13[1] * x21;
    x54 -= Lb13[2] * x21;
    x55 -= Lb13[3] * x21;
    x56 -= Lb14[0] * x21;
    x57 -= Lb14[1] * x21;
    x58 -= Lb14[2] * x21;
    x59 -= Lb14[3] * x21;
    x60 -= Lb15[0] * x21;
    x61 -= Lb15[1] * x21;
    x62 -= Lb15[2] * x21;
    x63 -= Lb15[3] * x21;
    __builtin_amdgcn_sched_barrier(0);
    Lb6 = *(const f32x4*)(Lt_s + 1588);
    Lb7 = *(const f32x4*)(Lt_s + 1592);
    Lb8 = *(const f32x4*)(Lt_s + 1596);
    Lb9 = *(const f32x4*)(Lt_s + 1600);
    Lb10 = *(const f32x4*)(Lt_s + 1604);
    Lb11 = *(const f32x4*)(Lt_s + 1608);
    Lb12 = *(const f32x4*)(Lt_s + 1612);
    Lb13 = *(const f32x4*)(Lt_s + 1616);
    Lb14 = *(const f32x4*)(Lt_s + 1620);
    Lb15 = *(const f32x4*)(Lt_s + 1624);
    __builtin_amdgcn_sched_barrier(0);
    x23 -= La5[3] * x22;
    x24 -= La6[0] * x22;
    x25 -= La6[1] * x22;
    x26 -= La6[2] * x22;
    x27 -= La6[3] * x22;
    x28 -= La7[0] * x22;
    x29 -= La7[1] * x22;
    x30 -= La7[2] * x22;
    x31 -= La7[3] * x22;
    x32 -= La8[0] * x22;
    x33 -= La8[1] * x22;
    x34 -= La8[2] * x22;
    x35 -= La8[3] * x22;
    x36 -= La9[0] * x22;
    x37 -= La9[1] * x22;
    x38 -= La9[2] * x22;
    x39 -= La9[3] * x22;
    x40 -= La10[0] * x22;
    x41 -= La10[1] * x22;
    x42 -= La10[2] * x22;
    x43 -= La10[3] * x22;
    x44 -= La11[0] * x22;
    x45 -= La11[1] * x22;
    x46 -= La11[2] * x22;
    x47 -= La11[3] * x22;
    x48 -= La12[0] * x22;
    x49 -= La12[1] * x22;
    x50 -= La12[2] * x22;
    x51 -= La12[3] * x22;
    x52 -= La13[0] * x22;
    x53 -= La13[1] * x22;
    x54 -= La13[2] * x22;
    x55 -= La13[3] * x22;
    x56 -= La14[0] * x22;
    x57 -= La14[1] * x22;
    x58 -= La14[2] * x22;
    x59 -= La14[3] * x22;
    x60 -= La15[0] * x22;
    x61 -= La15[1] * x22;
    x62 -= La15[2] * x22;
    x63 -= La15[3] * x22;
    __builtin_amdgcn_sched_barrier(0);
    La6 = *(const f32x4*)(Lt_s + 1656);
    La7 = *(const f32x4*)(Lt_s + 1660);
    La8 = *(const f32x4*)(Lt_s + 1664);
    La9 = *(const f32x4*)(Lt_s + 1668);
    La10 = *(const f32x4*)(Lt_s + 1672);
    La11 = *(const f32x4*)(Lt_s + 1676);
    La12 = *(const f32x4*)(Lt_s + 1680);
    La13 = *(const f32x4*)(Lt_s + 1684);
    La14 = *(const f32x4*)(Lt_s + 1688);
    La15 = *(const f32x4*)(Lt_s + 1692);
    __builtin_amdgcn_sched_barrier(0);
    x24 -= Lb6[0] * x23;
    x25 -= Lb6[1] * x23;
    x26 -= Lb6[2] * x23;
    x27 -= Lb6[3] * x23;
    x28 -= Lb7[0] * x23;
    x29 -= Lb7[1] * x23;
    x30 -= Lb7[2] * x23;
    x31 -= Lb7[3] * x23;
    x32 -= Lb8[0] * x23;
    x33 -= Lb8[1] * x23;
    x34 -= Lb8[2] * x23;
    x35 -= Lb8[3] * x23;
    x36 -= Lb9[0] * x23;
    x37 -= Lb9[1] * x23;
    x38 -= Lb9[2] * x23;
    x39 -= Lb9[3] * x23;
    x40 -= Lb10[0] * x23;
    x41 -= Lb10[1] * x23;
    x42 -= Lb10[2] * x23;
    x43 -= Lb10[3] * x23;
    x44 -= Lb11[0] * x23;
    x45 -= Lb11[1] * x23;
    x46 -= Lb11[2] * x23;
    x47 -= Lb11[3] * x23;
    x48 -= Lb12[0] * x23;
    x49 -= Lb12[1] * x23;
    x50 -= Lb12[2] * x23;
    x51 -= Lb12[3] * x23;
    x52 -= Lb13[0] * x23;
    x53 -= Lb13[1] * x23;
    x54 -= Lb13[2] * x23;
    x55 -= Lb13[3] * x23;
    x56 -= Lb14[0] * x23;
    x57 -= Lb14[1] * x23;
    x58 -= Lb14[2] * x23;
    x59 -= Lb14[3] * x23;
    x60 -= Lb15[0] * x23;
    x61 -= Lb15[1] * x23;
    x62 -= Lb15[2] * x23;
    x63 -= Lb15[3] * x23;
    __builtin_amdgcn_sched_barrier(0);
    Lb6 = *(const f32x4*)(Lt_s + 1724);
    Lb7 = *(const f32x4*)(Lt_s + 1728);
    Lb8 = *(const f32x4*)(Lt_s + 1732);
    Lb9 = *(const f32x4*)(Lt_s + 1736);
    Lb10 = *(const f32x4*)(Lt_s + 1740);
    Lb11 = *(const f32x4*)(Lt_s + 1744);
    Lb12 = *(const f32x4*)(Lt_s + 1748);
    Lb13 = *(const f32x4*)(Lt_s + 1752);
    Lb14 = *(const f32x4*)(Lt_s + 1756);
    Lb15 = *(const f32x4*)(Lt_s + 1760);
    __builtin_amdgcn_sched_barrier(0);
    x25 -= La6[1] * x24;
    x26 -= La6[2] * x24;
    x27 -= La6[3] * x24;
    x28 -= La7[0] * x24;
    x29 -= La7[1] * x24;
    x30 -= La7[2] * x24;
    x31 -= La7[3] * x24;
    x32 -= La8[0] * x24;
    x33 -= La8[1] * x24;
    x34 -= La8[2] * x24;
    x35 -= La8[3] * x24;
    x36 -= La9[0] * x24;
    x37 -= La9[1] * x24;
    x38 -= La9[2] * x24;
    x39 -= La9[3] * x24;
    x40 -= La10[0] * x24;
    x41 -= La10[1] * x24;
    x42 -= La10[2] * x24;
    x43 -= La10[3] * x24;
    x44 -= La11[0] * x24;
    x45 -= La11[1] * x24;
    x46 -= La11[2] * x24;
    x47 -= La11[3] * x24;
    x48 -= La12[0] * x24;
    x49 -= La12[1] * x24;
    x50 -= La12[2] * x24;
    x51 -= La12[3] * x24;
    x52 -= La13[0] * x24;
    x53 -= La13[1] * x24;
    x54 -= La13[2] * x24;
    x55 -= La13[3] * x24;
    x56 -= La14[0] * x24;
    x57 -= La14[1] * x24;
    x58 -= La14[2] * x24;
    x59 -= La14[3] * x24;
    x60 -= La15[0] * x24;
    x61 -= La15[1] * x24;
    x62 -= La15[2] * x24;
    x63 -= La15[3] * x24;
    __builtin_amdgcn_sched_barrier(0);
    La6 = *(const f32x4*)(Lt_s + 1792);
    La7 = *(const f32x4*)(Lt_s + 1796);
    La8 = *(const f32x4*)(Lt_s + 1800);
    La9 = *(const f32x4*)(Lt_s + 1804);
    La10 = *(const f32x4*)(Lt_s + 1808);
    La11 = *(const f32x4*)(Lt_s + 1812);
    La12 = *(const f32x4*)(Lt_s + 1816);
    La13 = *(const f32x4*)(Lt_s + 1820);
    La14 = *(const f32x4*)(Lt_s + 1824);
    La15 = *(const f32x4*)(Lt_s + 1828);
    __builtin_amdgcn_sched_barrier(0);
    x26 -= Lb6[2] * x25;
    x27 -= Lb6[3] * x25;
    x28 -= Lb7[0] * x25;
    x29 -= Lb7[1] * x25;
    x30 -= Lb7[2] * x25;
    x31 -= Lb7[3] * x25;
    x32 -= Lb8[0] * x25;
    x33 -= Lb8[1] * x25;
    x34 -= Lb8[2] * x25;
    x35 -= Lb8[3] * x25;
    x36 -= Lb9[0] * x25;
    x37 -= Lb9[1] * x25;
    x38 -= Lb9[2] * x25;
    x39 -= Lb9[3] * x25;
    x40 -= Lb10[0] * x25;
    x41 -= Lb10[1] * x25;
    x42 -= Lb10[2] * x25;
    x43 -= Lb10[3] * x25;
    x44 -= Lb11[0] * x25;
    x45 -= Lb11[1] * x25;
    x46 -= Lb11[2] * x25;
    x47 -= Lb11[3] * x25;
    x48 -= Lb12[0] * x25;
    x49 -= Lb12[1] * x25;
    x50 -= Lb12[2] * x25;
    x51 -= Lb12[3] * x25;
    x52 -= Lb13[0] * x25;
    x53 -= Lb13[1] * x25;
    x54 -= Lb13[2] * x25;
    x55 -= Lb13[3] * x25;
    x56 -= Lb14[0] * x25;
    x57 -= Lb14[1] * x25;
    x58 -= Lb14[2] * x25;
    x59 -= Lb14[3] * x25;
    x60 -= Lb15[0] * x25;
    x61 -= Lb15[1] * x25;
    x62 -= Lb15[2] * x25;
    x63 -= Lb15[3] * x25;
    __builtin_amdgcn_sched_barrier(0);
    Lb7 = *(const f32x4*)(Lt_s + 1864);
    Lb8 = *(const f32x4*)(Lt_s + 1868);
    Lb9 = *(const f32x4*)(Lt_s + 1872);
    Lb10 = *(const f32x4*)(Lt_s + 1876);
    Lb11 = *(const f32x4*)(Lt_s + 1880);
    Lb12 = *(const f32x4*)(Lt_s + 1884);
    Lb13 = *(const f32x4*)(Lt_s + 1888);
    Lb14 = *(const f32x4*)(Lt_s + 1892);
    Lb15 = *(const f32x4*)(Lt_s + 1896);
    __builtin_amdgcn_sched_barrier(0);
    x27 -= La6[3] * x26;
    x28 -= La7[0] * x26;
    x29 -= La7[1] * x26;
    x30 -= La7[2] * x26;
    x31 -= La7[3] * x26;
    x32 -= La8[0] * x26;
    x33 -= La8[1] * x26;
    x34 -= La8[2] * x26;
    x35 -= La8[3] * x26;
    x36 -= La9[0] * x26;
    x37 -= La9[1] * x26;
    x38 -= La9[2] * x26;
    x39 -= La9[3] * x26;
    x40 -= La10[0] * x26;
    x41 -= La10[1] * x26;
    x42 -= La10[2] * x26;
    x43 -= La10[3] * x26;
    x44 -= La11[0] * x26;
    x45 -= La11[1] * x26;
    x46 -= La11[2] * x26;
    x47 -= La11[3] * x26;
    x48 -= La12[0] * x26;
    x49 -= La12[1] * x26;
    x50 -= La12[2] * x26;
    x51 -= La12[3] * x26;
    x52 -= La13[0] * x26;
    x53 -= La13[1] * x26;
    x54 -= La13[2] * x26;
    x55 -= La13[3] * x26;
    x56 -= La14[0] * x26;
    x57 -= La14[1] * x26;
    x58 -= La14[2] * x26;
    x59 -= La14[3] * x26;
    x60 -= La15[0] * x26;
    x61 -= La15[1] * x26;
    x62 -= La15[2] * x26;
    x63 -= La15[3] * x26;
    __builtin_amdgcn_sched_barrier(0);
    La7 = *(const f32x4*)(Lt_s + 1932);
    La8 = *(const f32x4*)(Lt_s + 1936);
    La9 = *(const f32x4*)(Lt_s + 1940);
    La10 = *(const f32x4*)(Lt_s + 1944);
    La11 = *(const f32x4*)(Lt_s + 1948);
    La12 = *(const f32x4*)(Lt_s + 1952);
    La13 = *(const f32x4*)(Lt_s + 1956);
    La14 = *(const f32x4*)(Lt_s + 1960);
    La15 = *(const f32x4*)(Lt_s + 1964);
    __builtin_amdgcn_sched_barrier(0);
    x28 -= Lb7[0] * x27;
    x29 -= Lb7[1] * x27;
    x30 -= Lb7[2] * x27;
    x31 -= Lb7[3] * x27;
    x32 -= Lb8[0] * x27;
    x33 -= Lb8[1] * x27;
    x34 -= Lb8[2] * x27;
    x35 -= Lb8[3] * x27;
    x36 -= Lb9[0] * x27;
    x37 -= Lb9[1] * x27;
    x38 -= Lb9[2] * x27;
    x39 -= Lb9[3] * x27;
    x40 -= Lb10[0] * x27;
    x41 -= Lb10[1] * x27;
    x42 -= Lb10[2] * x27;
    x43 -= Lb10[3] * x27;
    x44 -= Lb11[0] * x27;
    x45 -= Lb11[1] * x27;
    x46 -= Lb11[2] * x27;
    x47 -= Lb11[3] * x27;
    x48 -= Lb12[0] * x27;
    x49 -= Lb12[1] * x27;
    x50 -= Lb12[2] * x27;
    x51 -= Lb12[3] * x27;
    x52 -= Lb13[0] * x27;
    x53 -= Lb13[1] * x27;
    x54 -= Lb13[2] * x27;
    x55 -= Lb13[3] * x27;
    x56 -= Lb14[0] * x27;
    x57 -= Lb14[1] * x27;
    x58 -= Lb14[2] * x27;
    x59 -= Lb14[3] * x27;
    x60 -= Lb15[0] * x27;
    x61 -= Lb15[1] * x27;
    x62 -= Lb15[2] * x27;
    x63 -= Lb15[3] * x27;
    __builtin_amdgcn_sched_barrier(0);
    Lb7 = *(const f32x4*)(Lt_s + 2000);
    Lb8 = *(const f32x4*)(Lt_s + 2004);
    Lb9 = *(const f32x4*)(Lt_s + 2008);
    Lb10 = *(const f32x4*)(Lt_s + 2012);
    Lb11 = *(const f32x4*)(Lt_s + 2016);
    Lb12 = *(const f32x4*)(Lt_s + 2020);
    Lb13 = *(const f32x4*)(Lt_s + 2024);
    Lb14 = *(const f32x4*)(Lt_s + 2028);
    Lb15 = *(const f32x4*)(Lt_s + 2032);
    __builtin_amdgcn_sched_barrier(0);
    x29 -= La7[1] * x28;
    x30 -= La7[2] * x28;
    x31 -= La7[3] * x28;
    x32 -= La8[0] * x28;
    x33 -= La8[1] * x28;
    x34 -= La8[2] * x28;
    x35 -= La8[3] * x28;
    x36 -= La9[0] * x28;
    x37 -= La9[1] * x28;
    x38 -= La9[2] * x28;
    x39 -= La9[3] * x28;
    x40 -= La10[0] * x28;
    x41 -= La10[1] * x28;
    x42 -= La10[2] * x28;
    x43 -= La10[3] * x28;
    x44 -= La11[0] * x28;
    x45 -= La11[1] * x28;
    x46 -= La11[2] * x28;
    x47 -= La11[3] * x28;
    x48 -= La12[0] * x28;
    x49 -= La12[1] * x28;
    x50 -= La12[2] * x28;
    x51 -= La12[3] * x28;
    x52 -= La13[0] * x28;
    x53 -= La13[1] * x28;
    x54 -= La13[2] * x28;
    x55 -= La13[3] * x28;
    x56 -= La14[0] * x28;
    x57 -= La14[1] * x28;
    x58 -= La14[2] * x28;
    x59 -= La14[3] * x28;
    x60 -= La15[0] * x28;
    x61 -= La15[1] * x28;
    x62 -= La15[2] * x28;
    x63 -= La15[3] * x28;
    __builtin_amdgcn_sched_barrier(0);
    La7 = *(const f32x4*)(Lt_s + 2068);
    La8 = *(const f32x4*)(Lt_s + 2072);
    La9 = *(const f32x4*)(Lt_s + 2076);
    La10 = *(const f32x4*)(Lt_s + 2080);
    La11 = *(const f32x4*)(Lt_s + 2084);
    La12 = *(const f32x4*)(Lt_s + 2088);
    La13 = *(const f32x4*)(Lt_s + 2092);
    La14 = *(const f32x4*)(Lt_s + 2096);
    La15 = *(const f32x4*)(Lt_s + 2100);
    __builtin_amdgcn_sched_barrier(0);
    x30 -= Lb7[2] * x29;
    x31 -= Lb7[3] * x29;
    x32 -= Lb8[0] * x29;
    x33 -= Lb8[1] * x29;
    x34 -= Lb8[2] * x29;
    x35 -= Lb8[3] * x29;
    x36 -= Lb9[0] * x29;
    x37 -= Lb9[1] * x29;
    x38 -= Lb9[2] * x29;
    x39 -= Lb9[3] * x29;
    x40 -= Lb10[0] * x29;
    x41 -= Lb10[1] * x29;
    x42 -= Lb10[2] * x29;
    x43 -= Lb10[3] * x29;
    x44 -= Lb11[0] * x29;
    x45 -= Lb11[1] * x29;
    x46 -= Lb11[2] * x29;
    x47 -= Lb11[3] * x29;
    x48 -= Lb12[0] * x29;
    x49 -= Lb12[1] * x29;
    x50 -= Lb12[2] * x29;
    x51 -= Lb12[3] * x29;
    x52 -= Lb13[0] * x29;
    x53 -= Lb13[1] * x29;
    x54 -= Lb13[2] * x29;
    x55 -= Lb13[3] * x29;
    x56 -= Lb14[0] * x29;
    x57 -= Lb14[1] * x29;
    x58 -= Lb14[2] * x29;
    x59 -= Lb14[3] * x29;
    x60 -= Lb15[0] * x29;
    x61 -= Lb15[1] * x29;
    x62 -= Lb15[2] * x29;
    x63 -= Lb15[3] * x29;
    __builtin_amdgcn_sched_barrier(0);
    Lb8 = *(const f32x4*)(Lt_s + 2140);
    Lb9 = *(const f32x4*)(Lt_s + 2144);
    Lb10 = *(const f32x4*)(Lt_s + 2148);
    Lb11 = *(const f32x4*)(Lt_s + 2152);
    Lb12 = *(const f32x4*)(Lt_s + 2156);
    Lb13 = *(const f32x4*)(Lt_s + 2160);
    Lb14 = *(const f32x4*)(Lt_s + 2164);
    Lb15 = *(const f32x4*)(Lt_s + 2168);
    __builtin_amdgcn_sched_barrier(0);
    x31 -= La7[3] * x30;
    x32 -= La8[0] * x30;
    x33 -= La8[1] * x30;
    x34 -= La8[2] * x30;
    x35 -= La8[3] * x30;
    x36 -= La9[0] * x30;
    x37 -= La9[1] * x30;
    x38 -= La9[2] * x30;
    x39 -= La9[3] * x30;
    x40 -= La10[0] * x30;
    x41 -= La10[1] * x30;
    x42 -= La10[2] * x30;
    x43 -= La10[3] * x30;
    x44 -= La11[0] * x30;
    x45 -= La11[1] * x30;
    x46 -= La11[2] * x30;
    x47 -= La11[3] * x30;
    x48 -= La12[0] * x30;
    x49 -= La12[1] * x30;
    x50 -= La12[2] * x30;
    x51 -= La12[3] * x30;
    x52 -= La13[0] * x30;
    x53 -= La13[1] * x30;
    x54 -= La13[2] * x30;
    x55 -= La13[3] * x30;
    x56 -= La14[0] * x30;
    x57 -= La14[1] * x30;
    x58 -= La14[2] * x30;
    x59 -= La14[3] * x30;
    x60 -= La15[0] * x30;
    x61 -= La15[1] * x30;
    x62 -= La15[2] * x30;
    x63 -= La15[3] * x30;
    __builtin_amdgcn_sched_barrier(0);
    La8 = *(const f32x4*)(Lt_s + 2208);
    La9 = *(const f32x4*)(Lt_s + 2212);
    La10 = *(const f32x4*)(Lt_s + 2216);
    La11 = *(const f32x4*)(Lt_s + 2220);
    La12 = *(const f32x4*)(Lt_s + 2224);
    La13 = *(const f32x4*)(Lt_s + 2228);
    La14 = *(const f32x4*)(Lt_s + 2232);
    La15 = *(const f32x4*)(Lt_s + 2236);
    __builtin_amdgcn_sched_barrier(0);
    x32 -= Lb8[0] * x31;
    x33 -= Lb8[1] * x31;
    x34 -= Lb8[2] * x31;
    x35 -= Lb8[3] * x31;
    x36 -= Lb9[0] * x31;
    x37 -= Lb9[1] * x31;
    x38 -= Lb9[2] * x31;
    x39 -= Lb9[3] * x31;
    x40 -= Lb10[0] * x31;
    x41 -= Lb10[1] * x31;
    x42 -= Lb10[2] * x31;
    x43 -= Lb10[3] * x31;
    x44 -= Lb11[0] * x31;
    x45 -= Lb11[1] * x31;
    x46 -= Lb11[2] * x31;
    x47 -= Lb11[3] * x31;
    x48 -= Lb12[0] * x31;
    x49 -= Lb12[1] * x31;
    x50 -= Lb12[2] * x31;
    x51 -= Lb12[3] * x31;
    x52 -= Lb13[0] * x31;
    x53 -= Lb13[1] * x31;
    x54 -= Lb13[2] * x31;
    x55 -= Lb13[3] * x31;
    x56 -= Lb14[0] * x31;
    x57 -= Lb14[1] * x31;
    x58 -= Lb14[2] * x31;
    x59 -= Lb14[3] * x31;
    x60 -= Lb15[0] * x31;
    x61 -= Lb15[1] * x31;
    x62 -= Lb15[2] * x31;
    x63 -= Lb15[3] * x31;
    __builtin_amdgcn_sched_barrier(0);
    Lb8 = *(const f32x4*)(Lt_s + 2276);
    Lb9 = *(const f32x4*)(Lt_s + 2280);
    Lb10 = *(const f32x4*)(Lt_s + 2284);
    Lb11 = *(const f32x4*)(Lt_s + 2288);
    Lb12 = *(const f32x4*)(Lt_s + 2292);
    Lb13 = *(const f32x4*)(Lt_s + 2296);
    Lb14 = *(const f32x4*)(Lt_s + 2300);
    Lb15 = *(const f32x4*)(Lt_s + 2304);
    __builtin_amdgcn_sched_barrier(0);
    x33 -= La8[1] * x32;
    x34 -= La8[2] * x32;
    x35 -= La8[3] * x32;
    x36 -= La9[0] * x32;
    x37 -= La9[1] * x32;
    x38 -= La9[2] * x32;
    x39 -= La9[3] * x32;
    x40 -= La10[0] * x32;
    x41 -= La10[1] * x32;
    x42 -= La10[2] * x32;
    x43 -= La10[3] * x32;
    x44 -= La11[0] * x32;
    x45 -= La11[1] * x32;
    x46 -= La11[2] * x32;
    x47 -= La11[3] * x32;
    x48 -= La12[0] * x32;
    x49 -= La12[1] * x32;
    x50 -= La12[2] * x32;
    x51 -= La12[3] * x32;
    x52 -= La13[0] * x32;
    x53 -= La13[1] * x32;
    x54 -= La13[2] * x32;
    x55 -= La13[3] * x32;
    x56 -= La14[0] * x32;
    x57 -= La14[1] * x32;
    x58 -= La14[2] * x32;
    x59 -= La14[3] * x32;
    x60 -= La15[0] * x32;
    x61 -= La15[1] * x32;
    x62 -= La15[2] * x32;
    x63 -= La15[3] * x32;
    __builtin_amdgcn_sched_barrier(0);
    La8 = *(const f32x4*)(Lt_s + 2344);
    La9 = *(const f32x4*)(Lt_s + 2348);
    La10 = *(const f32x4*)(Lt_s + 2352);
    La11 = *(const f32x4*)(Lt_s + 2356);
    La12 = *(const f32x4*)(Lt_s + 2360);
    La13 = *(const f32x4*)(Lt_s + 2364);
    La14 = *(const f32x4*)(Lt_s + 2368);
    La15 = *(const f32x4*)(Lt_s + 2372);
    __builtin_amdgcn_sched_barrier(0);
    x34 -= Lb8[2] * x33;
    x35 -= Lb8[3] * x33;
    x36 -= Lb9[0] * x33;
    x37 -= Lb9[1] * x33;
    x38 -= Lb9[2] * x33;
    x39 -= Lb9[3] * x33;
    x40 -= Lb10[0] * x33;
    x41 -= Lb10[1] * x33;
    x42 -= Lb10[2] * x33;
    x43 -= Lb10[3] * x33;
    x44 -= Lb11[0] * x33;
    x45 -= Lb11[1] * x33;
    x46 -= Lb11[2] * x33;
    x47 -= Lb11[3] * x33;
    x48 -= Lb12[0] * x33;
    x49 -= Lb12[1] * x33;
    x50 -= Lb12[2] * x33;
    x51 -= Lb12[3] * x33;
    x52 -= Lb13[0] * x33;
    x53 -= Lb13[1] * x33;
    x54 -= Lb13[2] * x33;
    x55 -= Lb13[3] * x33;
    x56 -= Lb14[0] * x33;
    x57 -= Lb14[1] * x33;
    x58 -= Lb14[2] * x33;
    x59 -= Lb14[3] * x33;
    x60 -= Lb15[0] * x33;
    x61 -= Lb15[1] * x33;
    x62 -= Lb15[2] * x33;
    x63 -= Lb15[3] * x33;
    __builtin_amdgcn_sched_barrier(0);
    Lb9 = *(const f32x4*)(Lt_s + 2416);
    Lb10 = *(const f32x4*)(Lt_s + 2420);
    Lb11 = *(const f32x4*)(Lt_s + 2424);
    Lb12 = *(const f32x4*)(Lt_s + 2428);
    Lb13 = *(const f32x4*)(Lt_s + 2432);
    Lb14 = *(const f32x4*)(Lt_s + 2436);
    Lb15 = *(const f32x4*)(Lt_s + 2440);
    __builtin_amdgcn_sched_barrier(0);
    x35 -= La8[3] * x34;
    x36 -= La9[0] * x34;
    x37 -= La9[1] * x34;
    x38 -= La9[2] * x34;
    x39 -= La9[3] * x34;
    x40 -= La10[0] * x34;
    x41 -= La10[1] * x34;
    x42 -= La10[2] * x34;
    x43 -= La10[3] * x34;
    x44 -= La11[0] * x34;
    x45 -= La11[1] * x34;
    x46 -= La11[2] * x34;
    x47 -= La11[3] * x34;
    x48 -= La12[0] * x34;
    x49 -= La12[1] * x34;
    x50 -= La12[2] * x34;
    x51 -= La12[3] * x34;
    x52 -= La13[0] * x34;
    x53 -= La13[1] * x34;
    x54 -= La13[2] * x34;
    x55 -= La13[3] * x34;
    x56 -= La14[0] * x34;
    x57 -= La14[1] * x34;
    x58 -= La14[2] * x34;
    x59 -= La14[3] * x34;
    x60 -= La15[0] * x34;
    x61 -= La15[1] * x34;
    x62 -= La15[2] * x34;
    x63 -= La15[3] * x34;
    __builtin_amdgcn_sched_barrier(0);
    La9 = *(const f32x4*)(Lt_s + 2484);
    La10 = *(const f32x4*)(Lt_s + 2488);
    La11 = *(const f32x4*)(Lt_s + 2492);
    La12 = *(const f32x4*)(Lt_s + 2496);
    La13 = *(const f32x4*)(Lt_s + 2500);
    La14 = *(const f32x4*)(Lt_s + 2504);
    La15 = *(const f32x4*)(Lt_s + 2508);
    __builtin_amdgcn_sched_barrier(0);
    x36 -= Lb9[0] * x35;
    x37 -= Lb9[1] * x35;
    x38 -= Lb9[2] * x35;
    x39 -= Lb9[3] * x35;
    x40 -= Lb10[0] * x35;
    x41 -= Lb10[1] * x35;
    x42 -= Lb10[2] * x35;
    x43 -= Lb10[3] * x35;
    x44 -= Lb11[0] * x35;
    x45 -= Lb11[1] * x35;
    x46 -= Lb11[2] * x35;
    x47 -= Lb11[3] * x35;
    x48 -= Lb12[0] * x35;
    x49 -= Lb12[1] * x35;
    x50 -= Lb12[2] * x35;
    x51 -= Lb12[3] * x35;
    x52 -= Lb13[0] * x35;
    x53 -= Lb13[1] * x35;
    x54 -= Lb13[2] * x35;
    x55 -= Lb13[3] * x35;
    x56 -= Lb14[0] * x35;
    x57 -= Lb14[1] * x35;
    x58 -= Lb14[2] * x35;
    x59 -= Lb14[3] * x35;
    x60 -= Lb15[0] * x35;
    x61 -= Lb15[1] * x35;
    x62 -= Lb15[2] * x35;
    x63 -= Lb15[3] * x35;
    __builtin_amdgcn_sched_barrier(0);
    Lb9 = *(const f32x4*)(Lt_s + 2552);
    Lb10 = *(const f32x4*)(Lt_s + 2556);
    Lb11 = *(const f32x4*)(Lt_s + 2560);
    Lb12 = *(const f32x4*)(Lt_s + 2564);
    Lb13 = *(const f32x4*)(Lt_s + 2568);
    Lb14 = *(const f32x4*)(Lt_s + 2572);
    Lb15 = *(const f32x4*)(Lt_s + 2576);
    __builtin_amdgcn_sched_barrier(0);
    x37 -= La9[1] * x36;
    x38 -= La9[2] * x36;
    x39 -= La9[3] * x36;
    x40 -= La10[0] * x36;
    x41 -= La10[1] * x36;
    x42 -= La10[2] * x36;
    x43 -= La10[3] * x36;
    x44 -= La11[0] * x36;
    x45 -= La11[1] * x36;
    x46 -= La11[2] * x36;
    x47 -= La11[3] * x36;
    x48 -= La12[0] * x36;
    x49 -= La12[1] * x36;
    x50 -= La12[2] * x36;
    x51 -= La12[3] * x36;
    x52 -= La13[0] * x36;
    x53 -= La13[1] * x36;
    x54 -= La13[2] * x36;
    x55 -= La13[3] * x36;
    x56 -= La14[0] * x36;
    x57 -= La14[1] * x36;
    x58 -= La14[2] * x36;
    x59 -= La14[3] * x36;
    x60 -= La15[0] * x36;
    x61 -= La15[1] * x36;
    x62 -= La15[2] * x36;
    x63 -= La15[3] * x36;
    __builtin_amdgcn_sched_barrier(0);
    La9 = *(const f32x4*)(Lt_s + 2620);
    La10 = *(const f32x4*)(Lt_s + 2624);
    La11 = *(const f32x4*)(Lt_s + 2628);
    La12 = *(const f32x4*)(Lt_s + 2632);
    La13 = *(const f32x4*)(Lt_s + 2636);
    La14 = *(const f32x4*)(Lt_s + 2640);
    La15 = *(const f32x4*)(Lt_s + 2644);
    __builtin_amdgcn_sched_barrier(0);
    x38 -= Lb9[2] * x37;
    x39 -= Lb9[3] * x37;
    x40 -= Lb10[0] * x37;
    x41 -= Lb10[1] * x37;
    x42 -= Lb10[2] * x37;
    x43 -= Lb10[3] * x37;
    x44 -= Lb11[0] * x37;
    x45 -= Lb11[1] * x37;
    x46 -= Lb11[2] * x37;
    x47 -= Lb11[3] * x37;
    x48 -= Lb12[0] * x37;
    x49 -= Lb12[1] * x37;
    x50 -= Lb12[2] * x37;
    x51 -= Lb12[3] * x37;
    x52 -= Lb13[0] * x37;
    x53 -= Lb13[1] * x37;
    x54 -= Lb13[2] * x37;
    x55 -= Lb13[3] * x37;
    x56 -= Lb14[0] * x37;
    x57 -= Lb14[1] * x37;
    x58 -= Lb14[2] * x37;
    x59 -= Lb14[3] * x37;
    x60 -= Lb15[0] * x37;
    x61 -= Lb15[1] * x37;
    x62 -= Lb15[2] * x37;
    x63 -= Lb15[3] * x37;
    __builtin_amdgcn_sched_barrier(0);
    Lb10 = *(const f32x4*)(Lt_s + 2692);
    Lb11 = *(const f32x4*)(Lt_s + 2696);
    Lb12 = *(const f32x4*)(Lt_s + 2700);
    Lb13 = *(const f32x4*)(Lt_s + 2704);
    Lb14 = *(const f32x4*)(Lt_s + 2708);
    Lb15 = *(const f32x4*)(Lt_s + 2712);
    __builtin_amdgcn_sched_barrier(0);
    x39 -= La9[3] * x38;
    x40 -= La10[0] * x38;
    x41 -= La10[1] * x38;
    x42 -= La10[2] * x38;
    x43 -= La10[3] * x38;
    x44 -= La11[0] * x38;
    x45 -= La11[1] * x38;
    x46 -= La11[2] * x38;
    x47 -= La11[3] * x38;
    x48 -= La12[0] * x38;
    x49 -= La12[1] * x38;
    x50 -= La12[2] * x38;
    x51 -= La12[3] * x38;
    x52 -= La13[0] * x38;
    x53 -= La13[1] * x38;
    x54 -= La13[2] * x38;
    x55 -= La13[3] * x38;
    x56 -= La14[0] * x38;
    x57 -= La14[1] * x38;
    x58 -= La14[2] * x38;
    x59 -= La14[3] * x38;
    x60 -= La15[0] * x38;
    x61 -= La15[1] * x38;
    x62 -= La15[2] * x38;
    x63 -= La15[3] * x38;
    __builtin_amdgcn_sched_barrier(0);
    La10 = *(const f32x4*)(Lt_s + 2760);
    La11 = *(const f32x4*)(Lt_s + 2764);
    La12 = *(const f32x4*)(Lt_s + 2768);
    La13 = *(const f32x4*)(Lt_s + 2772);
    La14 = *(const f32x4*)(Lt_s + 2776);
    La15 = *(const f32x4*)(Lt_s + 2780);
    __builtin_amdgcn_sched_barrier(0);
    x40 -= Lb10[0] * x39;
    x41 -= Lb10[1] * x39;
    x42 -= Lb10[2] * x39;
    x43 -= Lb10[3] * x39;
    x44 -= Lb11[0] * x39;
    x45 -= Lb11[1] * x39;
    x46 -= Lb11[2] * x39;
    x47 -= Lb11[3] * x39;
    x48 -= Lb12[0] * x39;
    x49 -= Lb12[1] * x39;
    x50 -= Lb12[2] * x39;
    x51 -= Lb12[3] * x39;
    x52 -= Lb13[0] * x39;
    x53 -= Lb13[1] * x39;
    x54 -= Lb13[2] * x39;
    x55 -= Lb13[3] * x39;
    x56 -= Lb14[0] * x39;
    x57 -= Lb14[1] * x39;
    x58 -= Lb14[2] * x39;
    x59 -= Lb14[3] * x39;
    x60 -= Lb15[0] * x39;
    x61 -= Lb15[1] * x39;
    x62 -= Lb15[2] * x39;
    x63 -= Lb15[3] * x39;
    __builtin_amdgcn_sched_barrier(0);
    Lb10 = *(const f32x4*)(Lt_s + 2828);
    Lb11 = *(const f32x4*)(Lt_s + 2832);
    Lb12 = *(const f32x4*)(Lt_s + 2836);
    Lb13 = *(const f32x4*)(Lt_s + 2840);
    Lb14 = *(const f32x4*)(Lt_s + 2844);
    Lb15 = *(const f32x4*)(Lt_s + 2848);
    __builtin_amdgcn_sched_barrier(0);
    x41 -= La10[1] * x40;
    x42 -= La10[2] * x40;
    x43 -= La10[3] * x40;
    x44 -= La11[0] * x40;
    x45 -= La11[1] * x40;
    x46 -= La11[2] * x40;
    x47 -= La11[3] * x40;
    x48 -= La12[0] * x40;
    x49 -= La12[1] * x40;
    x50 -= La12[2] * x40;
    x51 -= La12[3] * x40;
    x52 -= La13[0] * x40;
    x53 -= La13[1] * x40;
    x54 -= La13[2] * x40;
    x55 -= La13[3] * x40;
    x56 -= La14[0] * x40;
    x57 -= La14[1] * x40;
    x58 -= La14[2] * x40;
    x59 -= La14[3] * x40;
    x60 -= La15[0] * x40;
    x61 -= La15[1] * x40;
    x62 -= La15[2] * x40;
    x63 -= La15[3] * x40;
    __builtin_amdgcn_sched_barrier(0);
    La10 = *(const f32x4*)(Lt_s + 2896);
    La11 = *(const f32x4*)(Lt_s + 2900);
    La12 = *(const f32x4*)(Lt_s + 2904);
    La13 = *(const f32x4*)(Lt_s + 2908);
    La14 = *(const f32x4*)(Lt_s + 2912);
    La15 = *(const f32x4*)(Lt_s + 2916);
    __builtin_amdgcn_sched_barrier(0);
    x42 -= Lb10[2] * x41;
    x43 -= Lb10[3] * x41;
    x44 -= Lb11[0] * x41;
    x45 -= Lb11[1] * x41;
    x46 -= Lb11[2] * x41;
    x47 -= Lb11[3] * x41;
    x48 -= Lb12[0] * x41;
    x49 -= Lb12[1] * x41;
    x50 -= Lb12[2] * x41;
    x51 -= Lb12[3] * x41;
    x52 -= Lb13[0] * x41;
    x53 -= Lb13[1] * x41;
    x54 -= Lb13[2] * x41;
    x55 -= Lb13[3] * x41;
    x56 -= Lb14[0] * x41;
    x57 -= Lb14[1] * x41;
    x58 -= Lb14[2] * x41;
    x59 -= Lb14[3] * x41;
    x60 -= Lb15[0] * x41;
    x61 -= Lb15[1] * x41;
    x62 -= Lb15[2] * x41;
    x63 -= Lb15[3] * x41;
    __builtin_amdgcn_sched_barrier(0);
    Lb11 = *(const f32x4*)(Lt_s + 2968);
    Lb12 = *(const f32x4*)(Lt_s + 2972);
    Lb13 = *(const f32x4*)(Lt_s + 2976);
    Lb14 = *(const f32x4*)(Lt_s + 2980);
    Lb15 = *(const f32x4*)(Lt_s + 2984);
    __builtin_amdgcn_sched_barrier(0);
    x43 -= La10[3] * x42;
    x44 -= La11[0] * x42;
    x45 -= La11[1] * x42;
    x46 -= La11[2] * x42;
    x47 -= La11[3] * x42;
    x48 -= La12[0] * x42;
    x49 -= La12[1] * x42;
    x50 -= La12[2] * x42;
    x51 -= La12[3] * x42;
    x52 -= La13[0] * x42;
    x53 -= La13[1] * x42;
    x54 -= La13[2] * x42;
    x55 -= La13[3] * x42;
    x56 -= La14[0] * x42;
    x57 -= La14[1] * x42;
    x58 -= La14[2] * x42;
    x59 -= La14[3] * x42;
    x60 -= La15[0] * x42;
    x61 -= La15[1] * x42;
    x62 -= La15[2] * x42;
    x63 -= La15[3] * x42;
    __builtin_amdgcn_sched_barrier(0);
    La11 = *(const f32x4*)(Lt_s + 3036);
    La12 = *(const f32x4*)(Lt_s + 3040);
    La13 = *(const f32x4*)(Lt_s + 3044);
    La14 = *(const f32x4*)(Lt_s + 3048);
    La15 = *(const f32x4*)(Lt_s + 3052);
    __builtin_amdgcn_sched_barrier(0);
    x44 -= Lb11[0] * x43;
    x45 -= Lb11[1] * x43;
    x46 -= Lb11[2] * x43;
    x47 -= Lb11[3] * x43;
    x48 -= Lb12[0] * x43;
    x49 -= Lb12[1] * x43;
    x50 -= Lb12[2] * x43;
    x51 -= Lb12[3] * x43;
    x52 -= Lb13[0] * x43;
    x53 -= Lb13[1] * x43;
    x54 -= Lb13[2] * x43;
    x55 -= Lb13[3] * x43;
    x56 -= Lb14[0] * x43;
    x57 -= Lb14[1] * x43;
    x58 -= Lb14[2] * x43;
    x59 -= Lb14[3] * x43;
    x60 -= Lb15[0] * x43;
    x61 -= Lb15[1] * x43;
    x62 -= Lb15[2] * x43;
    x63 -= Lb15[3] * x43;
    __builtin_amdgcn_sched_barrier(0);
    Lb11 = *(const f32x4*)(Lt_s + 3104);
    Lb12 = *(const f32x4*)(Lt_s + 3108);
    Lb13 = *(const f32x4*)(Lt_s + 3112);
    Lb14 = *(const f32x4*)(Lt_s + 3116);
    Lb15 = *(const f32x4*)(Lt_s + 3120);
    __builtin_amdgcn_sched_barrier(0);
    x45 -= La11[1] * x44;
    x46 -= La11[2] * x44;
    x47 -= La11[3] * x44;
    x48 -= La12[0] * x44;
    x49 -= La12[1] * x44;
    x50 -= La12[2] * x44;
    x51 -= La12[3] * x44;
    x52 -= La13[0] * x44;
    x53 -= La13[1] * x44;
    x54 -= La13[2] * x44;
    x55 -= La13[3] * x44;
    x56 -= La14[0] * x44;
    x57 -= La14[1] * x44;
    x58 -= La14[2] * x44;
    x59 -= La14[3] * x44;
    x60 -= La15[0] * x44;
    x61 -= La15[1] * x44;
    x62 -= La15[2] * x44;
    x63 -= La15[3] * x44;
    __builtin_amdgcn_sched_barrier(0);
    La11 = *(const f32x4*)(Lt_s + 3172);
    La12 = *(const f32x4*)(Lt_s + 3176);
    La13 = *(const f32x4*)(Lt_s + 3180);
    La14 = *(const f32x4*)(Lt_s + 3184);
    La15 = *(const f32x4*)(Lt_s + 3188);
    __builtin_amdgcn_sched_barrier(0);
    x46 -= Lb11[2] * x45;
    x47 -= Lb11[3] * x45;
    x48 -= Lb12[0] * x45;
    x49 -= Lb12[1] * x45;
    x50 -= Lb12[2] * x45;
    x51 -= Lb12[3] * x45;
    x52 -= Lb13[0] * x45;
    x53 -= Lb13[1] * x45;
    x54 -= Lb13[2] * x45;
    x55 -= Lb13[3] * x45;
    x56 -= Lb14[0] * x45;
    x57 -= Lb14[1] * x45;
    x58 -= Lb14[2] * x45;
    x59 -= Lb14[3] * x45;
    x60 -= Lb15[0] * x45;
    x61 -= Lb15[1] * x45;
    x62 -= Lb15[2] * x45;
    x63 -= Lb15[3] * x45;
    __builtin_amdgcn_sched_barrier(0);
    Lb12 = *(const f32x4*)(Lt_s + 3244);
    Lb13 = *(const f32x4*)(Lt_s + 3248);
    Lb14 = *(const f32x4*)(Lt_s + 3252);
    Lb15 = *(const f32x4*)(Lt_s + 3256);
    __builtin_amdgcn_sched_barrier(0);
    x47 -= La11[3] * x46;
    x48 -= La12[0] * x46;
    x49 -= La12[1] * x46;
    x50 -= La12[2] * x46;
    x51 -= La12[3] * x46;
    x52 -= La13[0] * x46;
    x53 -= La13[1] * x46;
    x54 -= La13[2] * x46;
    x55 -= La13[3] * x46;
    x56 -= La14[0] * x46;
    x57 -= La14[1] * x46;
    x58 -= La14[2] * x46;
    x59 -= La14[3] * x46;
    x60 -= La15[0] * x46;
    x61 -= La15[1] * x46;
    x62 -= La15[2] * x46;
    x63 -= La15[3] * x46;
    __builtin_amdgcn_sched_barrier(0);
    La12 = *(const f32x4*)(Lt_s + 3312);
    La13 = *(const f32x4*)(Lt_s + 3316);
    La14 = *(const f32x4*)(Lt_s + 3320);
    La15 = *(const f32x4*)(Lt_s + 3324);
    __builtin_amdgcn_sched_barrier(0);
    x48 -= Lb12[0] * x47;
    x49 -= Lb12[1] * x47;
    x50 -= Lb12[2] * x47;
    x51 -= Lb12[3] * x47;
    x52 -= Lb13[0] * x47;
    x53 -= Lb13[1] * x47;
    x54 -= Lb13[2] * x47;
    x55 -= Lb13[3] * x47;
    x56 -= Lb14[0] * x47;
    x57 -= Lb14[1] * x47;
    x58 -= Lb14[2] * x47;
    x59 -= Lb14[3] * x47;
    x60 -= Lb15[0] * x47;
    x61 -= Lb15[1] * x47;
    x62 -= Lb15[2] * x47;
    x63 -= Lb15[3] * x47;
    __builtin_amdgcn_sched_barrier(0);
    Lb12 = *(const f32x4*)(Lt_s + 3380);
    Lb13 = *(const f32x4*)(Lt_s + 3384);
    Lb14 = *(const f32x4*)(Lt_s + 3388);
    Lb15 = *(const f32x4*)(Lt_s + 3392);
    __builtin_amdgcn_sched_barrier(0);
    x49 -= La12[1] * x48;
    x50 -= La12[2] * x48;
    x51 -= La12[3] * x48;
    x52 -= La13[0] * x48;
    x53 -= La13[1] * x48;
    x54 -= La13[2] * x48;
    x55 -= La13[3] * x48;
    x56 -= La14[0] * x48;
    x57 -= La14[1] * x48;
    x58 -= La14[2] * x48;
    x59 -= La14[3] * x48;
    x60 -= La15[0] * x48;
    x61 -= La15[1] * x48;
    x62 -= La15[2] * x48;
    x63 -= La15[3] * x48;
    __builtin_amdgcn_sched_barrier(0);
    La12 = *(const f32x4*)(Lt_s + 3448);
    La13 = *(const f32x4*)(Lt_s + 3452);
    La14 = *(const f32x4*)(Lt_s + 3456);
    La15 = *(const f32x4*)(Lt_s + 3460);
    __builtin_amdgcn_sched_barrier(0);
    x50 -= Lb12[2] * x49;
    x51 -= Lb12[3] * x49;
    x52 -= Lb13[0] * x49;
    x53 -= Lb13[1] * x49;
    x54 -= Lb13[2] * x49;
    x55 -= Lb13[3] * x49;
    x56 -= Lb14[0] * x49;
    x57 -= Lb14[1] * x49;
    x58 -= Lb14[2] * x49;
    x59 -= Lb14[3] * x49;
    x60 -= Lb15[0] * x49;
    x61 -= Lb15[1] * x49;
    x62 -= Lb15[2] * x49;
    x63 -= Lb15[3] * x49;
    __builtin_amdgcn_sched_barrier(0);
    Lb13 = *(const f32x4*)(Lt_s + 3520);
    Lb14 = *(const f32x4*)(Lt_s + 3524);
    Lb15 = *(const f32x4*)(Lt_s + 3528);
    __builtin_amdgcn_sched_barrier(0);
    x51 -= La12[3] * x50;
    x52 -= La13[0] * x50;
    x53 -= La13[1] * x50;
    x54 -= La13[2] * x50;
    x55 -= La13[3] * x50;
    x56 -= La14[0] * x50;
    x57 -= La14[1] * x50;
    x58 -= La14[2] * x50;
    x59 -= La14[3] * x50;
    x60 -= La15[0] * x50;
    x61 -= La15[1] * x50;
    x62 -= La15[2] * x50;
    x63 -= La15[3] * x50;
    __builtin_amdgcn_sched_barrier(0);
    La13 = *(const f32x4*)(Lt_s + 3588);
    La14 = *(const f32x4*)(Lt_s + 3592);
    La15 = *(const f32x4*)(Lt_s + 3596);
    __builtin_amdgcn_sched_barrier(0);
    x52 -= Lb13[0] * x51;
    x53 -= Lb13[1] * x51;
    x54 -= Lb13[2] * x51;
    x55 -= Lb13[3] * x51;
    x56 -= Lb14[0] * x51;
    x57 -= Lb14[1] * x51;
    x58 -= Lb14[2] * x51;
    x59 -= Lb14[3] * x51;
    x60 -= Lb15[0] * x51;
    x61 -= Lb15[1] * x51;
    x62 -= Lb15[2] * x51;
    x63 -= Lb15[3] * x51;
    __builtin_amdgcn_sched_barrier(0);
    Lb13 = *(const f32x4*)(Lt_s + 3656);
    Lb14 = *(const f32x4*)(Lt_s + 3660);
    Lb15 = *(const f32x4*)(Lt_s + 3664);
    __builtin_amdgcn_sched_barrier(0);
    x53 -= La13[1] * x52;
    x54 -= La13[2] * x52;
    x55 -= La13[3] * x52;
    x56 -= La14[0] * x52;
    x57 -= La14[1] * x52;
    x58 -= La14[2] * x52;
    x59 -= La14[3] * x52;
    x60 -= La15[0] * x52;
    x61 -= La15[1] * x52;
    x62 -= La15[2] * x52;
    x63 -= La15[3] * x52;
    __builtin_amdgcn_sched_barrier(0);
    La13 = *(const f32x4*)(Lt_s + 3724);
    La14 = *(const f32x4*)(Lt_s + 3728);
    La15 = *(const f32x4*)(Lt_s + 3732);
    __builtin_amdgcn_sched_barrier(0);
    x54 -= Lb13[2] * x53;
    x55 -= Lb13[3] * x53;
    x56 -= Lb14[0] * x53;
    x57 -= Lb14[1] * x53;
    x58 -= Lb14[2] * x53;
    x59 -= Lb14[3] * x53;
    x60 -= Lb15[0] * x53;
    x61 -= Lb15[1] * x53;
    x62 -= Lb15[2] * x53;
    x63 -= Lb15[3] * x53;
    __builtin_amdgcn_sched_barrier(0);
    Lb14 = *(const f32x4*)(Lt_s + 3796);
    Lb15 = *(const f32x4*)(Lt_s + 3800);
    __builtin_amdgcn_sched_barrier(0);
    x55 -= La13[3] * x54;
    x56 -= La14[0] * x54;
    x57 -= La14[1] * x54;
    x58 -= La14[2] * x54;
    x59 -= La14[3] * x54;
    x60 -= La15[0] * x54;
    x61 -= La15[1] * x54;
    x62 -= La15[2] * x54;
    x63 -= La15[3] * x54;
    __builtin_amdgcn_sched_barrier(0);
    La14 = *(const f32x4*)(Lt_s + 3864);
    La15 = *(const f32x4*)(Lt_s + 3868);
    __builtin_amdgcn_sched_barrier(0);
    x56 -= Lb14[0] * x55;
    x57 -= Lb14[1] * x55;
    x58 -= Lb14[2] * x55;
    x59 -= Lb14[3] * x55;
    x60 -= Lb15[0] * x55;
    x61 -= Lb15[1] * x55;
    x62 -= Lb15[2] * x55;
    x63 -= Lb15[3] * x55;
    __builtin_amdgcn_sched_barrier(0);
    Lb14 = *(const f32x4*)(Lt_s + 3932);
    Lb15 = *(const f32x4*)(Lt_s + 3936);
    __builtin_amdgcn_sched_barrier(0);
    x57 -= La14[1] * x56;
    x58 -= La14[2] * x56;
    x59 -= La14[3] * x56;
    x60 -= La15[0] * x56;
    x61 -= La15[1] * x56;
    x62 -= La15[2] * x56;
    x63 -= La15[3] * x56;
    __builtin_amdgcn_sched_barrier(0);
    La14 = *(const f32x4*)(Lt_s + 4000);
    La15 = *(const f32x4*)(Lt_s + 4004);
    __builtin_amdgcn_sched_barrier(0);
    x58 -= Lb14[2] * x57;
    x59 -= Lb14[3] * x57;
    x60 -= Lb15[0] * x57;
    x61 -= Lb15[1] * x57;
    x62 -= Lb15[2] * x57;
    x63 -= Lb15[3] * x57;
    __builtin_amdgcn_sched_barrier(0);
    Lb15 = *(const f32x4*)(Lt_s + 4072);
    __builtin_amdgcn_sched_barrier(0);
    x59 -= La14[3] * x58;
    x60 -= La15[0] * x58;
    x61 -= La15[1] * x58;
    x62 -= La15[2] * x58;
    x63 -= La15[3] * x58;
    __builtin_amdgcn_sched_barrier(0);
    La15 = *(const f32x4*)(Lt_s + 4140);
    __builtin_amdgcn_sched_barrier(0);
    x60 -= Lb15[0] * x59;
    x61 -= Lb15[1] * x59;
    x62 -= Lb15[2] * x59;
    x63 -= Lb15[3] * x59;
    __builtin_amdgcn_sched_barrier(0);
    Lb15 = *(const f32x4*)(Lt_s + 4208);
    __builtin_amdgcn_sched_barrier(0);
    x61 -= La15[1] * x60;
    x62 -= La15[2] * x60;
    x63 -= La15[3] * x60;
    __builtin_amdgcn_sched_barrier(0);
    La15 = *(const f32x4*)(Lt_s + 4276);
    __builtin_amdgcn_sched_barrier(0);
    x62 -= Lb15[2] * x61;
    x63 -= Lb15[3] * x61;
    __builtin_amdgcn_sched_barrier(0);
    __builtin_amdgcn_sched_barrier(0);
    x63 -= La15[3] * x62;
    __builtin_amdgcn_sched_barrier(0);
    __syncthreads();
    outp[0] = f2bf(sg * x0);
    outp[136] = f2bf(sg * x1);
    outp[272] = f2bf(sg * x2);
    outp[408] = f2bf(sg * x3);
    outp[544] = f2bf(sg * x4);
    outp[680] = f2bf(sg * x5);
    outp[816] = f2bf(sg * x6);
    outp[952] = f2bf(sg * x7);
    outp[1088] = f2bf(sg * x8);
    outp[1224] = f2bf(sg * x9);
    outp[1360] = f2bf(sg * x10);
    outp[1496] = f2bf(sg * x11);
    outp[1632] = f2bf(sg * x12);
    outp[1768] = f2bf(sg * x13);
    outp[1904] = f2bf(sg * x14);
    outp[2040] = f2bf(sg * x15);
    outp[2176] = f2bf(sg * x16);
    outp[2312] = f2bf(sg * x17);
    outp[2448] = f2bf(sg * x18);
    outp[2584] = f2bf(sg * x19);
    outp[2720] = f2bf(sg * x20);
    outp[2856] = f2bf(sg * x21);
    outp[2992] = f2bf(sg * x22);
    outp[3128] = f2bf(sg * x23);
    outp[3264] = f2bf(sg * x24);
    outp[3400] = f2bf(sg * x25);
    outp[3536] = f2bf(sg * x26);
    outp[3672] = f2bf(sg * x27);
    outp[3808] = f2bf(sg * x28);
    outp[3944] = f2bf(sg * x29);
    outp[4080] = f2bf(sg * x30);
    outp[4216] = f2bf(sg * x31);
    outp[4352] = f2bf(sg * x32);
    outp[4488] = f2bf(sg * x33);
    outp[4624] = f2bf(sg * x34);
    outp[4760] = f2bf(sg * x35);
    outp[4896] = f2bf(sg * x36);
    outp[5032] = f2bf(sg * x37);
    outp[5168] = f2bf(sg * x38);
    outp[5304] = f2bf(sg * x39);
    outp[5440] = f2bf(sg * x40);
    outp[5576] = f2bf(sg * x41);
    outp[5712] = f2bf(sg * x42);
    outp[5848] = f2bf(sg * x43);
    outp[5984] = f2bf(sg * x44);
    outp[6120] = f2bf(sg * x45);
    outp[6256] = f2bf(sg * x46);
    outp[6392] = f2bf(sg * x47);
    outp[6528] = f2bf(sg * x48);
    outp[6664] = f2bf(sg * x49);
    outp[6800] = f2bf(sg * x50);
    outp[6936] = f2bf(sg * x51);
    outp[7072] = f2bf(sg * x52);
    outp[7208] = f2bf(sg * x53);
    outp[7344] = f2bf(sg * x54);
    outp[7480] = f2bf(sg * x55);
    outp[7616] = f2bf(sg * x56);
    outp[7752] = f2bf(sg * x57);
    outp[7888] = f2bf(sg * x58);
    outp[8024] = f2bf(sg * x59);
    outp[8160] = f2bf(sg * x60);
    outp[8296] = f2bf(sg * x61);
    outp[8432] = f2bf(sg * x62);
    outp[8568] = f2bf(sg * x63);
}

DEV void dn_item(const Params& p, int l, int item, unsigned char* smem) {
    const int dir = item & 1, hh = (item >> 1) & 3, b = item >> 3;
    bf16_t* q_s = (bf16_t*)(smem);
    bf16_t* k_s = (bf16_t*)(smem + 17408);
    bf16_t* vnT_s = k_s;
    bf16_t* kT_s = (bf16_t*)(smem + 35840);
    bf16_t* v_s = (bf16_t*)(smem + 54272);
    bf16_t* u_s = v_s;
    float* L_s = (float*)(smem + 71680);
    bf16_t* w_s = (bf16_t*)(smem + 71680);
    bf16_t* qk_s = (bf16_t*)(smem + 89088);
    bf16_t* St_s = (bf16_t*)(smem + 98304);
    float* G_s = (float*)(smem + 133120);
    float* beta_s = G_s + 64;
    float* eG_s = G_s + 128;
    float* bw_s = G_s + 192;
    float* cw_s = G_s + 256;
    const int tid = get_tid(), lane = tid & 63, wv = tid >> 6, l15 = lane & 15, quad = lane >> 4;
    const float Aneg = -expf(p.in[I_DNALOG][(l * 2 + dir) * 4 + hh]);
    const float dtb = p.in[I_DNDT][(l * 2 + dir) * 4 + hh];
    const bf16_t* P = wsb(p, O_P);
    const float* AB = wsf(p, O_AB);
    bf16_t* TO = wsb(p, dir ? O_TA2 : O_TA);
    __syncthreads();
    for (int e = tid; e < 4 * 384; e += 256) { int j = e / 384, c = e % 384, mat = c >> 7, cc = c & 127; cw_s[e] = p.in[I_DNCONV][((size_t)l * 4 + j) * 1536 + mat * 512 + hh * 128 + cc]; }
    for (int e = tid; e < 128 * 136 / 2; e += 256) ((unsigned*)St_s)[e] = 0u;
    f32x4 Sacc[2][8];
#pragma unroll
    for (int a = 0; a < 2; ++a)
#pragma unroll
        for (int c = 0; c < 8; ++c) Sacc[a][c] = (f32x4){0.f, 0.f, 0.f, 0.f};

    const int rg = tid >> 4, cseg = tid & 15, i0 = rg * 4;
    u32x4 raw[3][7];
    float pf_al = 0.f, pf_bb = 0.f;
#define DN_PREFETCH(NN, M0, M1) { \
        const int c_ = chunk_of(dir, (NN)); const int lo_ = c_ < 4 ? 0 : CTXL, hi_ = c_ < 4 ? CTXL : SB, base_ = c_ * 64; \
        const int slo_ = dir ? base_ + 60 - i0 : base_ + i0; \
        _Pragma("unroll") for (int u = 0; u < 7; ++u) { const int ss_ = slo_ - 1 + u; const bool ok_ = ss_ >= lo_ && ss_ < hi_; \
            const bf16_t* rp_ = P + ((size_t)b * SB + (ok_ ? ss_ : base_)) * PW + hh * 128 + cseg * 8; \
            _Pragma("unroll") for (int mat = (M0); mat < (M1); ++mat) { u32x4 t_ = *(const u32x4*)(rp_ + mat * 512); raw[mat][u] = ok_ ? t_ : (u32x4){0u, 0u, 0u, 0u}; } } \
        if ((M0) == 0) { const int sa_ = dir ? base_ + 63 - lane : base_ + lane; \
        pf_al = AB[((size_t)b * SB + sa_) * 16 + dir * 4 + hh]; pf_bb = AB[((size_t)b * SB + sa_) * 16 + 8 + dir * 4 + hh]; } }
    DN_PREFETCH(0, 0, 3);
    const int wv0_ = wv, l150_ = l15, quad0_ = quad, lane0_ = lane;

#pragma unroll 1
    for (int n = 0; n < 68; ++n) {
        int tz0 = 0; asm volatile("" : "+v"(tz0));
        const int wv = wv0_ + tz0, l15 = l150_ + tz0, quad = quad0_ + tz0, lane = lane0_ + tz0;
        const int c = chunk_of(dir, n);
        const int base = c * 64;
        __syncthreads();
        if (wv == 0) {
            float g = Aneg * softplus_fast(pf_al + dtb);
#pragma unroll
            for (int o = 1; o < 64; o <<= 1) { float t = __shfl_up(g, o); if (lane >= o) g += t; }
            const float eg_ = expf(g), bt_ = sigm(pf_bb); G_s[lane] = g; beta_s[lane] = bt_; eG_s[lane] = eg_; bw_s[lane] = bt_ * eg_;
        }
        __syncthreads();
        const float Glast = G_s[63];
        {
            int tz = 0; asm volatile("" : "+v"(tz));
            const int i0l = i0 + tz, csl = cseg + tz;
            float ksc[4];
#pragma unroll
            for (int m = 0; m < 4; ++m) ksc[m] = expf(Glast - G_s[i0l + m]);
#pragma unroll
            for (int mat = 0; mat < 3; ++mat) {
                float w[4][8];
#pragma unroll
                for (int j = 0; j < 4; ++j) { const f32x4 w0 = *(const f32x4*)(cw_s + j * 384 + mat * 128 + csl * 8), w1 = *(const f32x4*)(cw_s + j * 384 + mat * 128 + csl * 8 + 4);
#pragma unroll
                    for (int e = 0; e < 4; ++e) { w[j][e] = w0[e]; w[j][4 + e] = w1[e]; } }
                float v[4][8];
#pragma unroll
                for (int t = 0; t < 4; ++t)
#pragma unroll
                    for (int e = 0; e < 8; ++e) v[t][e] = 0.f;
#pragma unroll
                for (int u = 0; u < 7; ++u) {
                    float x[8];
#pragma unroll
                    for (int e = 0; e < 4; ++e) { x[2 * e] = lo16(raw[mat][u][e]); x[2 * e + 1] = hi16(raw[mat][u][e]); }
#pragma unroll
                    for (int t = 0; t < 4; ++t) { const int j = u - t; if (j >= 0 && j < 4) {
#pragma unroll
                        for (int e = 0; e < 8; ++e) v[t][e] += w[j][e] * x[e]; } }
                }
                float sc[4];
#pragma unroll
                for (int t = 0; t < 4; ++t) {
                    float ss2 = 0.f;
#pragma unroll
                    for (int e = 0; e < 8; ++e) { v[t][e] = silu(v[t][e]); ss2 += v[t][e] * v[t][e]; }
                    if (mat < 2) { ss2 += __shfl_xor(ss2, 1); ss2 += __shfl_xor(ss2, 2); ss2 += __shfl_xor(ss2, 4); ss2 += __shfl_xor(ss2, 8); }
                    sc[t] = mat == 0 ? rsqrtf(ss2 + 1e-6f) * 0.08838834764831845f : (mat == 1 ? rsqrtf(ss2 + 1e-6f) : 1.f);
                }
                bf16_t* dst = mat == 0 ? q_s : (mat == 1 ? k_s : v_s);
#pragma unroll
                for (int t = 0; t < 4; ++t) {
                    const int it_ = dir ? i0l + 3 - t : i0l + t;
                    u32x4 o;
#pragma unroll
                    for (int e = 0; e < 4; ++e) o[e] = pack2(v[t][2 * e] * sc[t], v[t][2 * e + 1] * sc[t]);
                    *(u32x4*)(dst + it_ * 136 + csl * 8) = o;
                }
                if (mat == 1) {
#pragma unroll
                    for (int e = 0; e < 8; ++e) {
                        const float k0 = v[dir ? 3 : 0][e] * sc[dir ? 3 : 0] * ksc[0], k1 = v[dir ? 2 : 1][e] * sc[dir ? 2 : 1] * ksc[1];
                        const float k2 = v[dir ? 1 : 2][e] * sc[dir ? 1 : 2] * ksc[2], k3 = v[dir ? 0 : 3][e] * sc[dir ? 0 : 3] * ksc[3];
                        u32x2 o; o.x = pack2(k0, k1); o.y = pack2(k2, k3);
                        *(u32x2*)(kT_s + (csl * 8 + e) * 72 + i0l) = o;
                    }
                }
            }
        }
        __syncthreads();
        {
            bf16x8 ak[4], aq[4];
#pragma unroll
            for (int ks = 0; ks < 4; ++ks) { ak[ks] = *(const bf16x8*)(k_s + (wv * 16 + l15) * 136 + ks * 32 + quad * 8); aq[ks] = *(const bf16x8*)(q_s + (wv * 16 + l15) * 136 + ks * 32 + quad * 8); }
#pragma unroll
            for (int nt = 0; nt < 4; ++nt) {
                f32x4 kk = {0.f, 0.f, 0.f, 0.f}, qq = {0.f, 0.f, 0.f, 0.f};
#pragma unroll
                for (int ks = 0; ks < 4; ++ks) { bf16x8 bk = *(const bf16x8*)(k_s + (nt * 16 + l15) * 136 + ks * 32 + quad * 8); kk = mfma16(ak[ks], bk, kk); qq = mfma16(aq[ks], bk, qq); }
                const int jj = nt * 16 + l15; const float Gj = G_s[jj];
                f32x4 lv;
#pragma unroll
                for (int j = 0; j < 4; ++j) {
                    const int i = wv * 16 + quad * 4 + j;
                    const float dec = jj <= i ? expf(G_s[i] - Gj) : 0.f;
                    lv[j] = jj < i ? beta_s[i] * kk[j] * dec : 0.f;
                    qk_s[i * 72 + jj] = f2bf(qq[j] * dec);
                }
                *(f32x4*)(L_s + jj * 68 + wv * 16 + quad * 4) = lv;
            }
        }
        __syncthreads();
        dn_solve(L_s, tid < 128 ? (k_s + tid) : (v_s + (tid - 128)), tid < 128 ? bw_s : beta_s, tid < 128 ? -1.f : 1.f, tid < 128 ? (w_s + tid) : (u_s + (tid - 128)));
        __syncthreads();
        {
            f32x4 vn[8], o1[8];
#pragma unroll
            for (int nt = 0; nt < 8; ++nt) {
#pragma unroll
                for (int j = 0; j < 4; ++j) vn[nt][j] = bf2f(u_s[(wv * 16 + quad * 4 + j) * 136 + nt * 16 + l15]);
                o1[nt] = (f32x4){0.f, 0.f, 0.f, 0.f};
            }
            bf16x8 aw[4], aq[4];
#pragma unroll
            for (int ks = 0; ks < 4; ++ks) { aw[ks] = *(const bf16x8*)(w_s + (wv * 16 + l15) * 136 + ks * 32 + quad * 8); aq[ks] = *(const bf16x8*)(q_s + (wv * 16 + l15) * 136 + ks * 32 + quad * 8); }
#pragma unroll
            for (int nt = 0; nt < 8; ++nt)
#pragma unroll
                for (int ks = 0; ks < 4; ++ks) { bf16x8 bs = *(const bf16x8*)(St_s + (nt * 16 + l15) * 136 + ks * 32 + quad * 8); vn[nt] = mfma16(aw[ks], bs, vn[nt]); o1[nt] = mfma16(aq[ks], bs, o1[nt]); }
#pragma unroll
            for (int nt = 0; nt < 8; ++nt) { u32x2 o; o.x = pack2(vn[nt][0], vn[nt][1]); o.y = pack2(vn[nt][2], vn[nt][3]); *(u32x2*)(vnT_s + (nt * 16 + l15) * 72 + wv * 16 + quad * 4) = o; }
            __syncthreads();
            if (n + 1 < 68) DN_PREFETCH(n + 1, 0, 2);
            float eg[4];
#pragma unroll
            for (int j = 0; j < 4; ++j) eg[j] = eG_s[wv * 16 + quad * 4 + j];
            bf16x8 aqk[2], akt[2][2];
#pragma unroll
            for (int ks = 0; ks < 2; ++ks) {
                aqk[ks] = *(const bf16x8*)(qk_s + (wv * 16 + l15) * 72 + ks * 32 + quad * 8);
                akt[0][ks] = *(const bf16x8*)(kT_s + (wv * 32 + l15) * 72 + ks * 32 + quad * 8);
                akt[1][ks] = *(const bf16x8*)(kT_s + (wv * 32 + 16 + l15) * 72 + ks * 32 + quad * 8);
            }
            const float gend = eG_s[63];
            const size_t orow0 = (size_t)b * SB;
#pragma unroll
            for (int nt = 0; nt < 8; ++nt) {
                f32x4 o;
#pragma unroll
                for (int j = 0; j < 4; ++j) { o[j] = o1[nt][j] * eg[j]; Sacc[0][nt][j] *= gend; Sacc[1][nt][j] *= gend; }
#pragma unroll
                for (int ks = 0; ks < 2; ++ks) {
                    bf16x8 bv = *(const bf16x8*)(vnT_s + (nt * 16 + l15) * 72 + ks * 32 + quad * 8);
                    o = mfma16(aqk[ks], bv, o);
                    Sacc[0][nt] = mfma16(akt[0][ks], bv, Sacc[0][nt]);
                    Sacc[1][nt] = mfma16(akt[1][ks], bv, Sacc[1][nt]);
                }
#pragma unroll
                for (int j = 0; j < 4; ++j) {
                    const int i = wv * 16 + quad * 4 + j;
                    const int s = dir ? base + 63 - i : base + i;
                    TO[(orow0 + s) * 512 + hh * 128 + nt * 16 + l15] = f2bf(o[j]);
                }
#pragma unroll
                for (int mt = 0; mt < 2; ++mt) { u32x2 sv; sv.x = pack2(Sacc[mt][nt][0], Sacc[mt][nt][1]); sv.y = pack2(Sacc[mt][nt][2], Sacc[mt][nt][3]);
                    *(u32x2*)(St_s + (nt * 16 + l15) * 136 + wv * 32 + mt * 16 + quad * 4) = sv; }
            }
        }
        if (n + 1 < 68) DN_PREFETCH(n + 1, 2, 3);
    }
}

#undef DN_PREFETCH
DEV void lru_item(const Params& p, int l, int item, unsigned char* smem) {
    const int g = item & 7, b = item >> 3;
    bf16_t* Wt_s = (bf16_t*)smem;
    bf16_t* xbh_s = Wt_s + 2 * 128 * 72;
    float* xbf_s = (float*)(smem + 36864 + 18432);
    float* a_s = xbf_s + 2 * 64 * 65;
    float* cw_s = a_s + 2 * 64 * 65;
    const int tid = get_tid(), lane = tid & 63, wv = tid >> 6, l15 = lane & 15, quad = lane >> 4;
    bf16_t* P = wsb(p, O_P);
    bf16_t* HF = wsb(p, O_U);
    __syncthreads();
    for (int e = tid; e < 320; e += 256) cw_s[e] = e < 256 ? p.in[I_LCW][((size_t)l * 4 + (e >> 6)) * 512 + g * 64 + (e & 63)] : p.in[I_LCB][l * 512 + g * 64 + (e - 256)];
    for (int e = tid; e < 2 * 4096; e += 256) {
        const int d = e >> 12, ch = (e >> 6) & 63, j = e & 63;
        const size_t wi_ = (((size_t)l * 2 + d) * 8 + g) * 4096 + ch * 64 + j;
        Wt_s[(d * 128 + j) * 72 + ch] = f2bf(p.in[I_LWA][wi_]);
        Wt_s[(d * 128 + 64 + j) * 72 + ch] = f2bf(p.in[I_LWI][wi_]);
    }
    float ba_[2][4], bi_[2][4], sp_[2][4];
#pragma unroll
    for (int d = 0; d < 2; ++d)
#pragma unroll
        for (int nt = 0; nt < 4; ++nt) {
            const int ch = (l * 2 + d) * 512 + g * 64 + nt * 16 + l15;
            ba_[d][nt] = p.in[I_LBA][ch]; bi_[d][nt] = p.in[I_LBI][ch]; sp_[d][nt] = softplus(-p.in[I_LLAM][ch]);
        }
    float hc = 0.f;
    const int i = tid >> 2, seg = tid & 3, j0 = seg * 16;
#pragma unroll 1
    for (int n = 0; n < 68; ++n) {
        const int cf = n, cb = chunk_of(1, n);
        __syncthreads();
#pragma unroll
        for (int d = 0; d < 2; ++d) {
            const int c = d ? cb : cf;
            const int seg_lo = c < 4 ? 0 : CTXL, seg_hi = c < 4 ? CTXL : SB;
            const int s = d ? c * 64 + 63 - i : c * 64 + i;
            float v[16];
#pragma unroll
            for (int e = 0; e < 16; ++e) v[e] = cw_s[256 + j0 + e];
#pragma unroll
            for (int j = 0; j < 4; ++j) {
                const int ss = s + j - 1;
                if (ss >= seg_lo && ss < seg_hi) {
                    const u32x4* src = (const u32x4*)(P + ((size_t)b * SB + ss) * PW + C_LX + g * 64 + j0);
                    const float* cw = cw_s + j * 64 + j0;
#pragma unroll
                    for (int q = 0; q < 2; ++q) { u32x4 x = src[q];
#pragma unroll
                        for (int e = 0; e < 4; ++e) { v[q * 8 + 2 * e] += cw[q * 8 + 2 * e] * lo16(x[e]); v[q * 8 + 2 * e + 1] += cw[q * 8 + 2 * e + 1] * hi16(x[e]); } }
                }
            }
            u32x4 h0, h1;
#pragma unroll
            for (int e = 0; e < 4; ++e) { h0[e] = pack2(v[2 * e], v[2 * e + 1]); h1[e] = pack2(v[8 + 2 * e], v[8 + 2 * e + 1]); }
            *(u32x4*)(xbh_s + (d * 64 + i) * 72 + j0) = h0; *(u32x4*)(xbh_s + (d * 64 + i) * 72 + j0 + 8) = h1;
#pragma unroll
            for (int e = 0; e < 16; ++e) xbf_s[(d * 64 + i) * 65 + j0 + e] = v[e];
        }
        __syncthreads();
#pragma unroll
        for (int d = 0; d < 2; ++d) {
            f32x4 acc[8];
#pragma unroll
            for (int nt = 0; nt < 8; ++nt) acc[nt] = (f32x4){0.f, 0.f, 0.f, 0.f};
            bf16x8 af[2];
#pragma unroll
            for (int ks = 0; ks < 2; ++ks) af[ks] = *(const bf16x8*)(xbh_s + (d * 64 + wv * 16 + l15) * 72 + ks * 32 + quad * 8);
#pragma unroll
            for (int nt = 0; nt < 8; ++nt)
#pragma unroll
                for (int ks = 0; ks < 2; ++ks) { bf16x8 bw = *(const bf16x8*)(Wt_s + (d * 128 + nt * 16 + l15) * 72 + ks * 32 + quad * 8); acc[nt] = mfma16(af[ks], bw, acc[nt]); }
#pragma unroll
            for (int nt = 0; nt < 4; ++nt)
#pragma unroll
                for (int jj = 0; jj < 4; ++jj) {
                    const int idx = (d * 64 + wv * 16 + quad * 4 + jj) * 65 + nt * 16 + l15;
                    const float r = sigm(acc[nt][jj] + ba_[d][nt]), ig = sigm(acc[nt + 4][jj] + bi_[d][nt]);
                    const float la = -8.f * r * sp_[d][nt];
                    a_s[idx] = expf(la);
                    xbf_s[idx] = sqrtf(fmaxf(1.f - expf(2.f * la), 0.f)) * (ig * xbf_s[idx]);
                }
        }
        __syncthreads();
        if (wv < 2) {
            const int o = wv * 64 * 65 + lane;
#pragma unroll 16
            for (int r = 0; r < 64; ++r) { hc = a_s[o + r * 65] * hc + xbf_s[o + r * 65]; xbf_s[o + r * 65] = hc; }
        }
        __syncthreads();
#pragma unroll
        for (int d = 0; d < 2; ++d) {
            const int c = d ? cb : cf;
            const int s = d ? c * 64 + 63 - i : c * 64 + i;
            const bool second = d ? (cb < n) : ((cf < 4 ? 3 - cf : 71 - cf) < n);
            const size_t row = (size_t)b * SB + s;
            const float* hp = xbf_s + (d * 64 + i) * 65 + j0;
            bf16_t* hf = HF + row * 512 + g * 64 + j0;
            if (!second) {
                u32x4 o0, o1;
#pragma unroll
                for (int e = 0; e < 4; ++e) { o0[e] = pack2(hp[2 * e], hp[2 * e + 1]); o1[e] = pack2(hp[8 + 2 * e], hp[8 + 2 * e + 1]); }
                *(u32x4*)hf = o0; *(u32x4*)(hf + 8) = o1;
            } else {
                bf16_t* gp = P + row * PW + C_LG + g * 64 + j0;
                u32x4 f0 = *(const u32x4*)hf, f1 = *(const u32x4*)(hf + 8), g0 = *(const u32x4*)gp, g1 = *(const u32x4*)(gp + 8), o0, o1;
#pragma unroll
                for (int e = 0; e < 4; ++e) {
                    o0[e] = pack2((lo16(f0[e]) + hp[2 * e]) * gelu_tanh(lo16(g0[e])), (hi16(f0[e]) + hp[2 * e + 1]) * gelu_tanh(hi16(g0[e])));
                    o1[e] = pack2((lo16(f1[e]) + hp[8 + 2 * e]) * gelu_tanh(lo16(g1[e])), (hi16(f1[e]) + hp[8 + 2 * e + 1]) * gelu_tanh(hi16(g1[e])));
                }
                *(u32x4*)gp = o0; *(u32x4*)(gp + 8) = o1;
            }
        }
    }
}

DEV void att_item(const Params& p, int l, int b, int h, int qt, float lam_init, unsigned char* smem) {
    bf16_t* K_s = (bf16_t*)smem;
    bf16_t* V_s = (bf16_t*)(smem + 2 * 17408);
    const int tid = get_tid(), lane = tid & 63, wv = tid >> 6, l15 = lane & 15, quad = lane >> 4;
    bf16_t* P = wsb(p, O_P);
    const bf16_t* VT = wsb(p, O_VT) + (size_t)(b * 4 + h) * 128 * SB;
    const int nt_keys = (qt < 2 ? CTXL : SB) / 64;
    float lam;
    {
        const float* lv = p.in[I_DALAM] + l * 256;
        float s1 = lv[lane] * lv[64 + lane], s2 = lv[128 + lane] * lv[192 + lane];
#pragma unroll
        for (int o = 32; o >= 1; o >>= 1) { s1 += __shfl_xor(s1, o); s2 += __shfl_xor(s2, o); }
        lam = expf(s1) - expf(s2) + lam_init;
    }
    bf16x8* Qst = (bf16x8*)(smem + 71680) + (wv * 8) * 64 + lane;
#pragma unroll
    for (int qg = 0; qg < 2; ++qg) {
        const bf16_t* qp = P + ((size_t)b * SB + qt * 128 + wv * 32 + qg * 16 + l15) * PW + C_DAQ + h * 128;
#pragma unroll
        for (int wh = 0; wh < 2; ++wh)
#pragma unroll
            for (int ks = 0; ks < 2; ++ks) Qst[(wh * 4 + qg * 2 + ks) * 64] = *(const bf16x8*)(qp + wh * 64 + ks * 32 + quad * 8);
    }
    f32x4 O[2][8][2];
    float mrun[2][2], lrun[2][2];
#pragma unroll
    for (int wh = 0; wh < 2; ++wh)
#pragma unroll
        for (int qg = 0; qg < 2; ++qg) { mrun[wh][qg] = -1e30f; lrun[wh][qg] = 0.f;
#pragma unroll
            for (int dg = 0; dg < 8; ++dg) O[wh][dg][qg] = (f32x4){0.f, 0.f, 0.f, 0.f}; }
    const int kr = tid >> 2, kseg = (tid & 3) * 32;
    const int kpos = ((kr >> 5) * 2 + ((kr & 7) >> 2)) * 16 + ((kr & 31) >> 3) * 4 + (kr & 3);
    const bf16_t* kg_ = P + ((size_t)b * SB + kr) * PW + C_DAK + h * 128 + kseg;
    const int vr = tid >> 1, vh = (tid & 1) * 32;
    const bf16_t* vg_ = VT + (size_t)vr * SB + vh;
    u32x4 kreg[4], vreg[4];
#pragma unroll
    for (int i = 0; i < 4; ++i) { kreg[i] = *(const u32x4*)(kg_ + i * 8); vreg[i] = *(const u32x4*)(vg_ + i * 8); }
    __syncthreads();
#pragma unroll
    for (int i = 0; i < 4; ++i) { *(u32x4*)(K_s + kpos * 136 + kseg + i * 8) = kreg[i]; *(u32x4*)(V_s + vr * 72 + vh + i * 8) = vreg[i]; }
    __syncthreads();
    const float L2E = 1.4426950408889634f;
#pragma unroll 1
    for (int t = 0; t < nt_keys; ++t) {
        const bf16_t* Kb = K_s + (t & 1) * (64 * 136);
        const bf16_t* Vb = V_s + (t & 1) * (128 * 72);
        if (t + 1 < nt_keys) {
#pragma unroll
            for (int i = 0; i < 4; ++i) { kreg[i] = *(const u32x4*)(kg_ + (size_t)(t + 1) * 64 * PW + i * 8); vreg[i] = *(const u32x4*)(vg_ + (t + 1) * 64 + i * 8); }
        }
#pragma unroll
        for (int wh = 0; wh < 2; ++wh) {
            f32x4 S[4][2];
#pragma unroll
            for (int kg = 0; kg < 4; ++kg) { S[kg][0] = (f32x4){0.f, 0.f, 0.f, 0.f}; S[kg][1] = (f32x4){0.f, 0.f, 0.f, 0.f}; }
#pragma unroll
            for (int ks = 0; ks < 2; ++ks)
#pragma unroll
                for (int kg = 0; kg < 4; ++kg) {
                    bf16x8 kf = *(const bf16x8*)(Kb + (kg * 16 + l15) * 136 + wh * 64 + ks * 32 + quad * 8);
                    S[kg][0] = mfma16(kf, Qst[(wh * 4 + 0 + ks) * 64], S[kg][0]);
                    S[kg][1] = mfma16(kf, Qst[(wh * 4 + 2 + ks) * 64], S[kg][1]);
                }
            bf16x8 Pf[2][2];
#pragma unroll
            for (int qg = 0; qg < 2; ++qg) {
                float mx = -1e30f;
#pragma unroll
                for (int kg = 0; kg < 4; ++kg)
#pragma unroll
                    for (int j = 0; j < 4; ++j) mx = fmaxf(mx, S[kg][qg][j]);
                mx = fmaxf(mx, __shfl_xor(mx, 16)); mx = fmaxf(mx, __shfl_xor(mx, 32));
                const float mnew = fmaxf(mrun[wh][qg], mx * L2E);
                const float alpha = __builtin_amdgcn_exp2f(mrun[wh][qg] - mnew);
                mrun[wh][qg] = mnew;
                float ps = 0.f;
#pragma unroll
                for (int kg = 0; kg < 4; ++kg)
#pragma unroll
                    for (int j = 0; j < 4; ++j) { float pv = __builtin_amdgcn_exp2f(S[kg][qg][j] * L2E - mnew); ps += pv; S[kg][qg][j] = pv; }
                lrun[wh][qg] = lrun[wh][qg] * alpha + ps;
#pragma unroll
                for (int dg = 0; dg < 8; ++dg)
#pragma unroll
                    for (int j = 0; j < 4; ++j) O[wh][dg][qg][j] *= alpha;
#pragma unroll
                for (int s_ = 0; s_ < 2; ++s_) {
                    u32x4 pk; pk[0] = pack2(S[2 * s_][qg][0], S[2 * s_][qg][1]); pk[1] = pack2(S[2 * s_][qg][2], S[2 * s_][qg][3]);
                    pk[2] = pack2(S[2 * s_ + 1][qg][0], S[2 * s_ + 1][qg][1]); pk[3] = pack2(S[2 * s_ + 1][qg][2], S[2 * s_ + 1][qg][3]);
                    Pf[qg][s_] = __builtin_bit_cast(bf16x8, pk);
                }
            }
#pragma unroll
            for (int dg = 0; dg < 8; ++dg)
#pragma unroll
                for (int s_ = 0; s_ < 2; ++s_) {
                    bf16x8 vf = *(const bf16x8*)(Vb + (dg * 16 + l15) * 72 + s_ * 32 + quad * 8);
                    O[wh][dg][0] = mfma16(vf, Pf[0][s_], O[wh][dg][0]);
                    O[wh][dg][1] = mfma16(vf, Pf[1][s_], O[wh][dg][1]);
                }
        }
        if (t + 1 < nt_keys) {
            bf16_t* Kn = K_s + ((t + 1) & 1) * (64 * 136); bf16_t* Vn = V_s + ((t + 1) & 1) * (128 * 72);
#pragma unroll
            for (int i = 0; i < 4; ++i) { *(u32x4*)(Kn + kpos * 136 + kseg + i * 8) = kreg[i]; *(u32x4*)(Vn + vr * 72 + vh + i * 8) = vreg[i]; }
        }
        __syncthreads();
    }
    const float* dnw = p.in[I_DANORM] + l * 128;
#pragma unroll
    for (int qg = 0; qg < 2; ++qg) {
        float l1 = lrun[0][qg], l2 = lrun[1][qg];
        l1 += __shfl_xor(l1, 16); l1 += __shfl_xor(l1, 32); l2 += __shfl_xor(l2, 16); l2 += __shfl_xor(l2, 32);
        const float i1 = 1.f / l1, i2 = lam / l2;
        float ss = 0.f;
#pragma unroll
        for (int dg = 0; dg < 8; ++dg)
#pragma unroll
            for (int j = 0; j < 4; ++j) { float o = O[0][dg][qg][j] * i1 - O[1][dg][qg][j] * i2; O[0][dg][qg][j] = o; ss += o * o; }
        ss += __shfl_xor(ss, 16); ss += __shfl_xor(ss, 32);
        const float rstd = rsqrtf(ss * (1.f / 128.f) + 1e-5f) * (1.f - lam_init);
        bf16_t* op = P + ((size_t)b * SB + qt * 128 + wv * 32 + qg * 16 + l15) * PW + C_DAQ + h * 128;
#pragma unroll
        for (int dg = 0; dg < 8; ++dg) {
            const int dv0 = dg * 16 + quad * 4;
            u32x2 o; o.x = pack2(O[0][dg][qg][0] * rstd * dnw[dv0], O[0][dg][qg][1] * rstd * dnw[dv0 + 1]);
            o.y = pack2(O[0][dg][qg][2] * rstd * dnw[dv0 + 2], O[0][dg][qg][3] * rstd * dnw[dv0 + 3]);
            *(u32x2*)(op + dv0) = o;
        }
    }
}

DEV void phase_mix(const Params& p, int l, unsigned char* smem) {
    const bool need_ctx = l == 0;
    const float lam_init = l == 0 ? 0.2f : 0.35550906759096926f;
    unsigned* ctr = (unsigned*)(p.ws + O_CTL) + l;
    __shared__ int s_item;
    const int nqt = need_ctx ? 34 : 32;
    const int total = 64 + 64 + 32 * nqt;
    auto next = [&]() -> int {
        __syncthreads();
        if (threadIdx.x == 0) s_item = (int)atomicAdd(ctr, 1u);
        __syncthreads();
        return __builtin_amdgcn_readfirstlane(s_item);
    };
    int it = next();
#pragma unroll 1
    while (it < 64) { dn_item(p, l, it, smem); it = next(); }
#pragma unroll 1
    while (it < 128) { lru_item(p, l, it - 64, smem); it = next(); }
#pragma unroll 1
    while (it < total) {
        const int a = it - 128, bh = a / nqt, idx = a % nqt;
        const int qt = idx < 32 ? idx + 2 : idx - 32;
        att_item(p, l, bh >> 2, bh & 3, qt, lam_init, smem);
        it = next();
    }
}

constexpr int NPHASE = 1 + 2 * 9 + 1;
DEV void run_phase(const Params& p, int ph, unsigned char* smem) {
    if (ph == 0) { phase_mod(p, smem); phase_rope(p); __syncthreads(); phase_wconv(p, 0, smem); return; }
    if (ph == NPHASE - 1) { phase_final(p); return; }
    const int l = (ph - 1) / 9, q = (ph - 1) % 9;
    const bool first = l == 0, lat = l == 1;
    const bf16_t* W = wsb(p, O_WT);
    switch (q) {
        case 0: if (l == 1) phase_wconv(p, 1, smem); phase_norm(p, l, 0, first, false); break;
        case 1: phase_g1(p, smem); break;
        case 2: phase_mix(p, l, smem); break;
        case 3: phase_fin_norm(p, l, first, lat); break;
        case 4: phase_gate(p, lat, smem); break;
        case 5: phase_resid(p, l, wsb(p, O_U), D, W + W_OUT, 1024, 2, first, lat, smem); break;
        case 6: phase_norm(p, l, 1, false, lat); break;
        case 7: phase_gu(p, lat, smem); break;
        case 8: phase_resid(p, l, wsb(p, O_P), PW, W + W_DN, DFF, 5, false, lat, smem); break;
    }
}

#if MEGA
__global__ void __launch_bounds__(256) mega_kernel(Params p) {
    extern __shared__ __align__(16) unsigned char smem[];
    cg::grid_group grid = cg::this_grid();
    phase_mod(p, smem); phase_rope(p); __syncthreads(); phase_wconv(p, 0, smem);
    grid.sync();
    const bf16_t* W = wsb(p, O_WT);
#pragma unroll
    for (int l = 0; l < 2; ++l) {
        const bool first = l == 0, lat = l == 1;
        if (l == 1) phase_wconv(p, 1, smem);
        phase_norm(p, l, 0, first, false);
        grid.sync();
        phase_g1(p, smem);
        grid.sync();
        phase_mix(p, l, smem);
        grid.sync();
        phase_fin_norm(p, l, first, lat);
        grid.sync();
        phase_gate(p, lat, smem);
        grid.sync();
        phase_merge(p, lat, smem);
        grid.sync();
        phase_resid(p, l, wsb(p, O_U), D, W + W_OUT, 1024, 2, first, lat, smem);
        grid.sync();
        phase_norm(p, l, 1, false, lat);
        grid.sync();
        phase_gu(p, lat, smem);
        grid.sync();
        phase_resid(p, l, wsb(p, O_P), PW, W + W_DN, DFF, 5, false, lat, smem);
        grid.sync();
    }
    phase_final(p);
}
#else
__global__ void __launch_bounds__(256) phase_kernel(Params p, int ph) {
    extern __shared__ __align__(16) unsigned char smem[];
    run_phase(p, ph, smem);
}
#endif

extern "C" void kernel_launch(void* const* d_in, const int* in_sizes, int n_in, void* d_out, int out_size, void* d_ws, size_t ws_size, hipStream_t stream) {
    static int grid = 0;
    if (grid == 0) {
        if (n_in != 28 || ws_size < WS_END) { fprintf(stderr, "kernel_launch: unexpected n_in %d or ws_size %zu < %zu\n", n_in, ws_size, (size_t)WS_END); grid = -1; return; }
        int dev = 0, cus = 0, per_cu = 0;
        hipGetDevice(&dev);
        hipDeviceGetAttribute(&cus, hipDeviceAttributeMultiprocessorCount, dev);
#if MEGA
        hipFuncSetAttribute((const void*)mega_kernel, hipFuncAttributeMaxDynamicSharedMemorySize, LDS_BYTES);
        hipOccupancyMaxActiveBlocksPerMultiprocessor(&per_cu, (const void*)mega_kernel, 256, LDS_BYTES);
#else
        hipFuncSetAttribute((const void*)phase_kernel, hipFuncAttributeMaxDynamicSharedMemorySize, LDS_BYTES);
        hipOccupancyMaxActiveBlocksPerMultiprocessor(&per_cu, (const void*)phase_kernel, 256, LDS_BYTES);
#endif
        if (per_cu < 1) per_cu = 1;
        grid = cus * per_cu;
        fprintf(stderr, "kernel_launch: grid %d (%d CUs x %d)\n", grid, cus, per_cu);
    }
    if (grid < 0) return;
    hipMemsetAsync((char*)d_ws + O_CTL, 0, 4096, stream);
    Params p{};
    for (int i = 0; i < 28; ++i) p.in[i] = (const float*)d_in[i];
    p.out = (float*)d_out; p.ws = (unsigned char*)d_ws;
#if MEGA
    void* args[] = {&p};
    hipError_t e = hipLaunchCooperativeKernel((const void*)mega_kernel, dim3(grid), dim3(256), args, LDS_BYTES, stream);
    if (e != hipSuccess) fprintf(stderr, "cooperative launch failed: %s (grid %d)\n", hipGetErrorString(e), grid);
#else
    for (int ph = 0; ph < NPHASE; ++ph) hipLaunchKernelGGL(phase_kernel, dim3(grid), dim3(256), LDS_BYTES, stream, p, ph);
#endif
}
```

```cpp
#include <hip/hip_runtime.h>
#include <hip/hip_cooperative_groups.h>
#include <cstdio>
#include <cstdint>
namespace cg = cooperative_groups;

#ifndef MEGA
#define MEGA 1
#endif

typedef unsigned short bf16_t;
typedef short bf16x8 __attribute__((ext_vector_type(8)));
typedef float f32x4 __attribute__((ext_vector_type(4)));
typedef unsigned u32x4 __attribute__((ext_vector_type(4)));
typedef unsigned u32x2 __attribute__((ext_vector_type(2)));
#define DEV __device__ __forceinline__

constexpr int D = 1024, NB = 8, SEQ = 4096, CTXL = 256, SB = 4352, MR = NB * SB, PW = 4096, DFF = 2816;
constexpr int C_DNQ = 0, C_DNK = 512, C_DNV = 1024, C_DNZ = 1536, C_LX = 2048, C_LG = 2560, C_DAQ = 3072, C_DAK = 3584;
constexpr int NIN = 4736;
constexpr int GLD = 72;

enum { I_X = 0, I_C, I_CTX, I_CCTX, I_WMOD, I_BMOD, I_NMIX, I_NFFN, I_WIN, I_DNCONV, I_DNALOG, I_DNDT, I_DNNORM, I_LCW, I_LCB,
       I_LWA, I_LBA, I_LWI, I_LBI, I_LLAM, I_DALAM, I_DANORM, I_WBR, I_WOUT, I_WFG, I_WFU, I_WFD, I_NFIN };

constexpr size_t al256(size_t x) { return (x + 255) & ~(size_t)255; }
constexpr size_t O_CTL = 0;
constexpr size_t O_MOD = 4096;
constexpr size_t O_ROPE = al256(O_MOD + (size_t)2 * 9 * 6144 * 4);
constexpr size_t O_WT = al256(O_ROPE + 64 * 16 * 2 * 4);
constexpr size_t W_IN = 0, W_GATE = W_IN + (size_t)NIN * 1024, W_BR = W_GATE + (size_t)3072 * 1024, W_OUT = W_BR + (size_t)3 * 1024 * 512,
                 W_GU = W_OUT + (size_t)1024 * 1024, W_DN = W_GU + (size_t)5632 * 1024, W_END = W_DN + (size_t)1024 * 2816;
constexpr size_t O_HCTX = al256(O_WT + W_END * 2);
constexpr size_t O_U = al256(O_HCTX + (size_t)2048 * 1024 * 4);
constexpr size_t O_P = al256(O_U + (size_t)MR * 1024 * 2);
constexpr size_t O_AB = al256(O_P + (size_t)MR * PW * 2);
constexpr size_t O_TA = al256(O_AB + (size_t)MR * 16 * 4);
constexpr size_t O_TA2 = al256(O_TA + (size_t)MR * 512 * 2);
constexpr size_t O_VT = al256(O_TA2 + (size_t)MR * 512 * 2);
constexpr size_t WS_END = al256(O_VT + (size_t)MR * 512 * 2);

constexpr int LDS_BYTES = 140 * 1024;

struct Params {
    const float* in[28];
    float* out;
    unsigned char* ws;
};

DEV int get_tid() { int t = threadIdx.x; asm volatile("" : "+v"(t)); return t; }
DEV float bf2f(bf16_t h) { return __uint_as_float(((unsigned)h) << 16); }
DEV bf16_t f2bf(float f) { unsigned u = __float_as_uint(f); u += 0x7fffu + ((u >> 16) & 1u); return (bf16_t)(u >> 16); }
DEV unsigned pack2(float a, float b) { unsigned r; asm("v_cvt_pk_bf16_f32 %0, %1, %2" : "=v"(r) : "v"(a), "v"(b)); return r; }
DEV float sigm(float x) { return __builtin_amdgcn_rcpf(1.f + __expf(-x)); }
DEV float silu(float x) { return x * __builtin_amdgcn_rcpf(1.f + __expf(-x)); }
DEV float softplus(float x) { return x > 20.f ? x : log1pf(expf(x)); }
DEV float softplus_fast(float x) { const float e = __expf(x); return x > 15.f ? x : (e < 0.01f ? e * (1.f - e * (0.5f - e * 0.33333333f)) : __logf(1.f + e)); }
DEV float gelu_tanh(float x) { float u = 0.7978845608028654f * (x + 0.044715f * x * x * x); float t = 1.f - 2.f * __builtin_amdgcn_rcpf(1.f + __expf(2.f * u)); return 0.5f * x * (1.f + t); }
DEV f32x4 mfma16(bf16x8 a, bf16x8 b, f32x4 c) { return __builtin_amdgcn_mfma_f32_16x16x32_bf16(a, b, c, 0, 0, 0); }
DEV void mfma16a(f32x4& c, bf16x8 a, bf16x8 b) { asm volatile("v_mfma_f32_16x16x32_bf16 %0, %1, %2, %0" : "+a"(c) : "v"(a), "v"(b)); }
DEV float lo16(unsigned v) { return __uint_as_float(v << 16); }
DEV float hi16(unsigned v) { return __uint_as_float(v & 0xffff0000u); }

DEV bf16_t* wsb(const Params& p, size_t off) { return (bf16_t*)(p.ws + off); }
DEV float* wsf(const Params& p, size_t off) { return (float*)(p.ws + off); }
DEV float* hrow(const Params& p, int r) { int b = r / SB, s = r - b * SB; return s < CTXL ? wsf(p, O_HCTX) + (size_t)(b * CTXL + s) * D : p.out + (size_t)(b * SEQ + s - CTXL) * D; }
DEV const float* xrow(const Params& p, int r) { int b = r / SB, s = r - b * SB; return s < CTXL ? p.in[I_CTX] + (size_t)(b * CTXL + s) * D : p.in[I_X] + (size_t)(b * SEQ + s - CTXL) * D; }
DEV int modrow(int r) { int b = r / SB, s = r - b * SB; return s < CTXL ? 8 : b; }

template <int MT, int NT>
DEV void gemm_core(const bf16_t* __restrict__ A, int lda, const bf16_t* __restrict__ Bt, int ldb, int K, f32x4 (&acc)[MT][NT], bf16_t* smem_) {
    constexpr int SA = 32 * MT * GLD, SBB = 32 * NT * GLD;
    bf16_t* sA = smem_; bf16_t* sB = smem_ + 2 * SA;
    const int tid = get_tid(), lane = tid & 63, wv = tid >> 6, wr = wv >> 1, wc = wv & 1, l15 = lane & 15, quad = lane >> 4;
    const int lr = tid >> 3, lc = (tid & 7) * 8;
    u32x4 ra0[MT], rb0[NT], ra1[MT], rb1[NT];
    const bf16_t* Ap = A + (size_t)lr * lda + lc;
    const bf16_t* Bp = Bt + (size_t)lr * ldb + lc;
    const int nk = K >> 6;
#define GLOAD(RA, RB, KT) { const int ko_ = (KT) * 64; _Pragma("unroll") for (int i = 0; i < MT; ++i) RA[i] = *(const u32x4*)(Ap + (size_t)(32 * i) * lda + ko_); \
                            _Pragma("unroll") for (int i = 0; i < NT; ++i) RB[i] = *(const u32x4*)(Bp + (size_t)(32 * i) * ldb + ko_); }
#define LSTORE(RA, RB, BUF) { _Pragma("unroll") for (int i = 0; i < MT; ++i) *(u32x4*)(sA + (BUF) * SA + (lr + 32 * i) * GLD + lc) = RA[i]; \
                              _Pragma("unroll") for (int i = 0; i < NT; ++i) *(u32x4*)(sB + (BUF) * SBB + (lr + 32 * i) * GLD + lc) = RB[i]; }
#define COMPUTE(BUF) { _Pragma("unroll") for (int ks = 0; ks < 2; ++ks) { bf16x8 af[MT], bfr[NT]; \
        _Pragma("unroll") for (int mt = 0; mt < MT; ++mt) af[mt] = *(const bf16x8*)(sA + (BUF) * SA + (wr * MT * 16 + mt * 16 + l15) * GLD + ks * 32 + quad * 8); \
        _Pragma("unroll") for (int nt = 0; nt < NT; ++nt) bfr[nt] = *(const bf16x8*)(sB + (BUF) * SBB + (wc * NT * 16 + nt * 16 + l15) * GLD + ks * 32 + quad * 8); \
        _Pragma("unroll") for (int mt = 0; mt < MT; ++mt) _Pragma("unroll") for (int nt = 0; nt < NT; ++nt) mfma16a(acc[mt][nt], af[mt], bfr[nt]); } }
    GLOAD(ra0, rb0, 0);
    GLOAD(ra1, rb1, 1);
    __syncthreads();
    LSTORE(ra0, rb0, 0);
    GLOAD(ra0, rb0, 2);
    __syncthreads();
#pragma unroll 1
    for (int kt = 0; kt < nk; kt += 2) {
        COMPUTE(0);
        if (kt + 1 < nk) LSTORE(ra1, rb1, 1);
        if (kt + 3 < nk) GLOAD(ra1, rb1, kt + 3);
        __syncthreads();
        COMPUTE(1);
        if (kt + 2 < nk) LSTORE(ra0, rb0, 0);
        if (kt + 4 < nk) GLOAD(ra0, rb0, kt + 4);
        __syncthreads();
    }
#undef GLOAD
#undef LSTORE
#undef COMPUTE
    asm volatile("s_nop 15\n\ts_nop 15" ::: "memory");
}
template <int MT, int NT>
DEV void gemm_core1(const bf16_t* __restrict__ A, int lda, const bf16_t* __restrict__ Bt, int ldb, int K, f32x4 (&acc)[MT][NT], bf16_t* sA, bf16_t* sB) {
    const int tid = get_tid(), lane = tid & 63, wv = tid >> 6, wr = wv >> 1, wc = wv & 1, l15 = lane & 15, quad = lane >> 4;
    const int lr = tid >> 3, lc = (tid & 7) * 8;
    u32x4 ra[MT], rb[NT];
    const bf16_t* Ap = A + (size_t)lr * lda + lc;
    const bf16_t* Bp = Bt + (size_t)lr * ldb + lc;
#pragma unroll
    for (int i = 0; i < MT; ++i) ra[i] = *(const u32x4*)(Ap + (size_t)(32 * i) * lda);
#pragma unroll
    for (int i = 0; i < NT; ++i) rb[i] = *(const u32x4*)(Bp + (size_t)(32 * i) * ldb);
    const int nk = K >> 6;
    for (int kt = 0; kt < nk; ++kt) {
        __syncthreads();
#pragma unroll
        for (int i = 0; i < MT; ++i) *(u32x4*)(sA + (lr + 32 * i) * GLD + lc) = ra[i];
#pragma unroll
        for (int i = 0; i < NT; ++i) *(u32x4*)(sB + (lr + 32 * i) * GLD + lc) = rb[i];
        __syncthreads();
        if (kt + 1 < nk) {
            const int ko = (kt + 1) * 64;
#pragma unroll
            for (int i = 0; i < MT; ++i) ra[i] = *(const u32x4*)(Ap + (size_t)(32 * i) * lda + ko);
#pragma unroll
            for (int i = 0; i < NT; ++i) rb[i] = *(const u32x4*)(Bp + (size_t)(32 * i) * ldb + ko);
        }
#pragma unroll
        for (int ks = 0; ks < 2; ++ks) {
            bf16x8 af[MT], bfr[NT];
#pragma unroll
            for (int mt = 0; mt < MT; ++mt) af[mt] = *(const bf16x8*)(sA + (wr * MT * 16 + mt * 16 + l15) * GLD + ks * 32 + quad * 8);
#pragma unroll
            for (int nt = 0; nt < NT; ++nt) bfr[nt] = *(const bf16x8*)(sB + (wc * NT * 16 + nt * 16 + l15) * GLD + ks * 32 + quad * 8);
#pragma unroll
            for (int mt = 0; mt < MT; ++mt)
#pragma unroll
                for (int nt = 0; nt < NT; ++nt) mfma16a(acc[mt][nt], af[mt], bfr[nt]);
        }
    }
    asm volatile("s_nop 15\n\ts_nop 15" ::: "memory");
}
template <int MT, int NT>
DEV void zero_acc(f32x4 (&acc)[MT][NT]) {
#pragma unroll
    for (int mt = 0; mt < MT; ++mt)
#pragma unroll
        for (int nt = 0; nt < NT; ++nt) acc[mt][nt] = (f32x4){0.f, 0.f, 0.f, 0.f};
}

DEV void phase_mod(const Params& p, unsigned char* smem) {
    float* s_s = (float*)smem;
    float* red = s_s + 9 * 1024;
    const int tid = get_tid();
    bool loaded = false;
    for (int it = blockIdx.x; it < 2 * 96; it += gridDim.x) {
        if (!loaded) {
            for (int e = tid; e < 9 * 1024; e += 256) { float v = e < 8192 ? p.in[I_C][e] : p.in[I_CCTX][e - 8192]; s_s[e] = silu(v); }
            loaded = true;
        }
        __syncthreads();
        const int l = it / 96, cg_ = it % 96, cq = tid & 63, kq = tid >> 6, col = cg_ * 64 + cq;
        float acc[9];
#pragma unroll
        for (int r = 0; r < 9; ++r) acc[r] = 0.f;
        const float* wp = p.in[I_WMOD] + ((size_t)l * 1024 + kq * 256) * 6144 + col;
#pragma unroll 8
        for (int k = 0; k < 256; ++k) {
            float wv = wp[(size_t)k * 6144];
#pragma unroll
            for (int r = 0; r < 9; ++r) acc[r] += s_s[r * 1024 + kq * 256 + k] * wv;
        }
#pragma unroll
        for (int r = 0; r < 9; ++r) red[(kq * 9 + r) * 64 + cq] = acc[r];
        __syncthreads();
        for (int e = tid; e < 9 * 64; e += 256) {
            int r = e >> 6, c2 = e & 63;
            float v = red[(0 * 9 + r) * 64 + c2] + red[(1 * 9 + r) * 64 + c2] + red[(2 * 9 + r) * 64 + c2] + red[(3 * 9 + r) * 64 + c2];
            wsf(p, O_MOD)[((size_t)l * 9 + r) * 6144 + cg_ * 64 + c2] = v + p.in[I_BMOD][l * 6144 + cg_ * 64 + c2];
        }
        __syncthreads();
    }
}
DEV void phase_rope(const Params& p) {
    if (blockIdx.x == (gridDim.x - 1)) {
        for (int e = threadIdx.x; e < 1024; e += 256) {
            int pos = e >> 4, i = e & 15;
            float inv = powf(10000.f, -(float)i / 16.f);
            float ang = (float)pos * inv;
            float n = rintf(ang * 0.15915494309189535f);
            float r = fmaf(-n, 6.28125f, ang);
            r = fmaf(-n, 1.9353071795864769e-3f, r);
            wsf(p, O_ROPE)[e * 2] = cosf(r);
            wsf(p, O_ROPE)[e * 2 + 1] = sinf(r);
        }
    }
}
DEV void wconv_tile(const float* src0, const float* src1, int lds_, int K, bf16_t* dst, int kind, int kt, int nt, bf16_t* tile) {
    const int tid = get_tid();
    const int kk = tid >> 2, grp = tid & 3;
    const int n0 = nt * 64, k0 = kt * 64;
    const int ng = n0 + grp * 16;
    const float* src = src0; int sc;
    if (kind == 0) { sc = ng < 2048 ? ng : (ng < 4608 ? ng + 16 : (ng < 4624 ? 2048 : -1)); }
    else if (kind == 1) { sc = 4624 + ng; }
    else if (kind == 2) { sc = ng; }
    else { int gd = ng >> 4; src = (gd & 1) ? src1 : src0; sc = (gd >> 1) * 16; }
    __syncthreads();
    if (sc >= 0) {
        const float4* sp = (const float4*)(src + (size_t)(k0 + kk) * lds_ + sc);
#pragma unroll
        for (int q = 0; q < 4; ++q) { float4 v = sp[q]; int e = grp * 16 + q * 4;
            tile[(e + 0) * GLD + kk] = f2bf(v.x); tile[(e + 1) * GLD + kk] = f2bf(v.y); tile[(e + 2) * GLD + kk] = f2bf(v.z); tile[(e + 3) * GLD + kk] = f2bf(v.w); }
    } else {
#pragma unroll
        for (int e = 0; e < 16; ++e) tile[(grp * 16 + e) * GLD + kk] = 0;
    }
    __syncthreads();
    const int n = tid >> 2, kseg = (tid & 3) * 16;
    u32x4 a = *(const u32x4*)(tile + n * GLD + kseg), b = *(const u32x4*)(tile + n * GLD + kseg + 8);
    bf16_t* dp = dst + (size_t)(n0 + n) * K + k0 + kseg;
    *(u32x4*)dp = a; *(u32x4*)(dp + 8) = b;
}
DEV void phase_wconv(const Params& p, int l, unsigned char* smem) {
    bf16_t* tile = (bf16_t*)smem;
    bf16_t* W = wsb(p, O_WT);
    constexpr int T0 = 74 * 16, T1 = T0 + 48 * 16, T2 = T1 + 3 * 16 * 8, T3 = T2 + 16 * 16, T4 = T3 + 88 * 16, T5 = T4 + 16 * 44;
    for (int t = blockIdx.x; t < T5; t += gridDim.x) {
        if (t < T0) { wconv_tile(p.in[I_WIN] + (size_t)l * 1024 * 7696, nullptr, 7696, 1024, W + W_IN, 0, t % 16, t / 16, tile); }
        else if (t < T1) { int u = t - T0; wconv_tile(p.in[I_WIN] + (size_t)l * 1024 * 7696, nullptr, 7696, 1024, W + W_GATE, 1, u % 16, u / 16, tile); }
        else if (t < T2) { int u = t - T1; int n = u / 128, v = u % 128; wconv_tile(p.in[I_WBR] + ((size_t)l * 3 + n) * 512 * 1024, nullptr, 1024, 512, W + W_BR + (size_t)n * 1024 * 512, 2, v % 8, v / 8, tile); }
        else if (t < T3) { int u = t - T2; wconv_tile(p.in[I_WOUT] + (size_t)l * 1024 * 1024, nullptr, 1024, 1024, W + W_OUT, 2, u % 16, u / 16, tile); }
        else if (t < T4) { int u = t - T3; wconv_tile(p.in[I_WFG] + (size_t)l * 1024 * DFF, p.in[I_WFU] + (size_t)l * 1024 * DFF, DFF, 1024, W + W_GU, 3, u % 16, u / 16, tile); }
        else { int u = t - T4; wconv_tile(p.in[I_WFD] + (size_t)l * DFF * 1024, nullptr, 1024, DFF, W + W_DN, 2, u % 44, u / 44, tile); }
    }
}

DEV void norm_row(const Params& p, int l, int which, bool first, int r, int lane) {
    const float* h = first ? xrow(p, r) : hrow(p, r);
    const float* nw = p.in[which ? I_NFFN : I_NMIX] + l * D;
    const float* md = wsf(p, O_MOD) + ((size_t)l * 9 + modrow(r)) * 6144 + (which ? 3 * D : 0);
    float4 v[4]; float ss = 0.f;
#pragma unroll
    for (int i = 0; i < 4; ++i) { v[i] = *(const float4*)(h + i * 256 + lane * 4); ss += v[i].x * v[i].x + v[i].y * v[i].y + v[i].z * v[i].z + v[i].w * v[i].w; }
#pragma unroll
    for (int o = 32; o >= 1; o >>= 1) ss += __shfl_xor(ss, o);
    const float rstd = rsqrtf(ss * (1.f / D) + 1e-6f);
    bf16_t* up = wsb(p, O_U) + (size_t)r * D;
#pragma unroll
    for (int i = 0; i < 4; ++i) {
        const int c = i * 256 + lane * 4;
        float4 w4 = *(const float4*)(nw + c), sh = *(const float4*)(md + c), sc = *(const float4*)(md + D + c);
        float a = v[i].x * rstd * w4.x * (1.f + sc.x) + sh.x, b = v[i].y * rstd * w4.y * (1.f + sc.y) + sh.y;
        float c2 = v[i].z * rstd * w4.z * (1.f + sc.z) + sh.z, d = v[i].w * rstd * w4.w * (1.f + sc.w) + sh.w;
        u32x2 o; o.x = pack2(a, b); o.y = pack2(c2, d);
        *(u32x2*)(up + c) = o;
    }
}
DEV void phase_norm(const Params& p, int l, int which, bool first, bool skip_ctx) {
    const int tid_ = get_tid(); const int lane = tid_ & 63, wv = tid_ >> 6;
    for (int r = blockIdx.x * 4 + wv; r < MR; r += gridDim.x * 4) {
        if (skip_ctx && (r % SB) < CTXL) continue;
        norm_row(p, l, which, first, r, lane);
    }
}
DEV void phase_fin_norm(const Params& p, int l, bool first, bool skip_ctx) {
    const int tid_ = get_tid(); const int lane = tid_ & 63, wv = tid_ >> 6;
    const float* dnn = p.in[I_DNNORM] + l * 128;
    for (int r = blockIdx.x * 4 + wv; r < MR; r += gridDim.x * 4) {
        if (skip_ctx && (r % SB) < CTXL) continue;
        norm_row(p, l, 0, first, r, lane);
        bf16_t* ta = wsb(p, O_TA) + (size_t)r * 512 + lane * 8;
        const bf16_t* tb = wsb(p, O_TA2) + (size_t)r * 512 + lane * 8;
        const bf16_t* zz = wsb(p, O_P) + (size_t)r * PW + C_DNZ + lane * 8;
        u32x4 a = *(const u32x4*)ta, b = *(const u32x4*)tb, z = *(const u32x4*)zz;
        float o[8]; float ss = 0.f;
#pragma unroll
        for (int i = 0; i < 4; ++i) { o[2 * i] = lo16(a[i]) + lo16(b[i]); o[2 * i + 1] = hi16(a[i]) + hi16(b[i]); ss += o[2 * i] * o[2 * i] + o[2 * i + 1] * o[2 * i + 1]; }
#pragma unroll
        for (int of = 8; of >= 1; of >>= 1) ss += __shfl_xor(ss, of);
        const float rstd = rsqrtf(ss * (1.f / 128.f) + 1e-6f);
        const int dv0 = (lane & 15) * 8;
        u32x4 y;
#pragma unroll
        for (int i = 0; i < 4; ++i) {
            float y0 = o[2 * i] * rstd * dnn[dv0 + 2 * i] * silu(lo16(z[i]));
            float y1 = o[2 * i + 1] * rstd * dnn[dv0 + 2 * i + 1] * silu(hi16(z[i]));
            y[i] = pack2(y0, y1);
        }
        *(u32x4*)ta = y;
    }
}
DEV void phase_final(const Params& p) {
    const int tid_ = get_tid(); const int lane = tid_ & 63, wv = tid_ >> 6;
    const float* nw = p.in[I_NFIN];
    for (int r = blockIdx.x * 4 + wv; r < NB * SEQ; r += gridDim.x * 4) {
        float* h = p.out + (size_t)r * D;
        float4 v[4]; float ss = 0.f;
#pragma unroll
        for (int i = 0; i < 4; ++i) { v[i] = *(const float4*)(h + i * 256 + lane * 4); ss += v[i].x * v[i].x + v[i].y * v[i].y + v[i].z * v[i].z + v[i].w * v[i].w; }
#pragma unroll
        for (int o = 32; o >= 1; o >>= 1) ss += __shfl_xor(ss, o);
        const float rstd = rsqrtf(ss * (1.f / D) + 1e-6f);
#pragma unroll
        for (int i = 0; i < 4; ++i) {
            const int c = i * 256 + lane * 4;
            float4 w4 = *(const float4*)(nw + c);
            float4 o4; o4.x = v[i].x * rstd * w4.x; o4.y = v[i].y * rstd * w4.y; o4.z = v[i].z * rstd * w4.z; o4.w = v[i].w * rstd * w4.w;
            *(float4*)(h + c) = o4;
        }
    }
}

struct TileIter {
    int nn, total, nloc, L;
    DEV TileIter(int nm, int nn_) { nn = nn_; total = nm * nn_; nloc = gridDim.x >> 3; L = (blockIdx.x & 7) * nloc + (blockIdx.x >> 3); }
    DEV bool valid() const { return L < total; }
    DEV bool more() const { return (L - (int)(blockIdx.x >> 3)) < total; }
    DEV void next() { L += 8 * nloc; }
    DEV void get(int& tm, int& tn) const { const int pn = 4 * nn, panel = L / pn, rem = L - panel * pn; tn = rem >> 2; tm = panel * 4 + (rem & 3); }
};
DEV void phase_g1(const Params& p, unsigned char* smem) {
    bf16_t* sA = (bf16_t*)smem;
    const int tid = get_tid(), lane = tid & 63, wv = tid >> 6, wr = wv >> 1, wc = wv & 1, l15 = lane & 15, quad = lane >> 4;
    const bf16_t* U = wsb(p, O_U); const bf16_t* W = wsb(p, O_WT) + W_IN;
    bf16_t* P = wsb(p, O_P);
    const float* rope = wsf(p, O_ROPE);
    constexpr int NTN = NIN / 128;
    for (TileIter ti(MR / 256, NTN); ti.valid(); ti.next()) {
        int tm, tn; ti.get(tm, tn);
        const int row0 = tm * 256, col0 = tn * 128;
        f32x4 acc[8][4]; zero_acc(acc);
        gemm_core<8, 4>(U + (size_t)row0 * D, D, W + (size_t)col0 * D, D, D, acc, sA);
        if (tn < 24) {
#pragma unroll
            for (int mt = 0; mt < 8; ++mt)
#pragma unroll
                for (int nt = 0; nt < 4; ++nt)
#pragma unroll
                    for (int j = 0; j < 4; ++j) {
                        if (nt == 0 && j == 0) __builtin_amdgcn_sched_barrier(0);
                        const int row = row0 + wr * 128 + mt * 16 + quad * 4 + j, col = col0 + wc * 64 + nt * 16 + l15;
                        P[(size_t)row * PW + col] = f2bf(acc[mt][nt][j]);
                    }
        } else if (tn < 32) {
            const float qs = tn < 28 ? 0.125f : 1.f;
#pragma unroll
            for (int mt = 0; mt < 8; ++mt)
#pragma unroll
                for (int j = 0; j < 4; ++j) {
                    if (j == 0) __builtin_amdgcn_sched_barrier(0);
                    const int row = row0 + wr * 128 + mt * 16 + quad * 4 + j;
                    const int s = row % SB;
                    float c0 = 1.f, s0 = 0.f, c1 = 1.f, s1 = 0.f;
                    if (s >= CTXL) { const int tt = s - CTXL, pr = tt >> 6, pc = tt & 63;
                        c0 = rope[(pr * 16 + l15) * 2]; s0 = rope[(pr * 16 + l15) * 2 + 1]; c1 = rope[(pc * 16 + l15) * 2]; s1 = rope[(pc * 16 + l15) * 2 + 1]; }
                    const float x1 = acc[mt][0][j], x2 = acc[mt][1][j], y1 = acc[mt][2][j], y2 = acc[mt][3][j];
                    bf16_t* pp = P + (size_t)row * PW + col0 + wc * 64 + l15;
                    pp[0] = f2bf((x1 * c0 - x2 * s0) * qs);
                    pp[16] = f2bf((x2 * c0 + x1 * s0) * qs);
                    pp[32] = f2bf((y1 * c1 - y2 * s1) * qs);
                    pp[48] = f2bf((y2 * c1 + y1 * s1) * qs);
                }
        } else if (tn < 36) {
            bf16_t* VT = wsb(p, O_VT);
            const int b = row0 / SB, sbase = row0 - b * SB;
#pragma unroll
            for (int mt = 0; mt < 8; ++mt)
#pragma unroll
                for (int nt = 0; nt < 4; ++nt) {
                    if (nt == 0) __builtin_amdgcn_sched_barrier(0);
                    const int cc = col0 - 4096 + wc * 64 + nt * 16 + l15;
                    const int s = sbase + wr * 128 + mt * 16 + quad * 4;
                    u32x2 o; o.x = pack2(acc[mt][nt][0], acc[mt][nt][1]); o.y = pack2(acc[mt][nt][2], acc[mt][nt][3]);
                    *(u32x2*)(VT + ((size_t)(b * 512 + cc)) * SB + s) = o;
                }
        } else {
            if (wc == 0) {
                float* AB = wsf(p, O_AB);
#pragma unroll
                for (int mt = 0; mt < 8; ++mt)
#pragma unroll
                    for (int j = 0; j < 4; ++j) {
                        const int row = row0 + wr * 128 + mt * 16 + quad * 4 + j;
                        AB[(size_t)row * 16 + l15] = acc[mt][0][j];
                    }
            }
        }
    }
}

DEV int rowtile0(int ti, bool latent_only) { if (!latent_only) return ti * 256; int b = ti >> 4, tt = ti & 15; return b * SB + CTXL + tt * 256; }
DEV int sgcol(int n, int c) { return n < 2 ? n * 1024 + c : (c < 512 ? 2048 + c : 3584 + (c - 512)); }

DEV void phase_gate(const Params& p, bool latent_only, unsigned char* smem) {
    bf16_t* sA = (bf16_t*)smem;
    const int tid = get_tid(), lane = tid & 63, wv = tid >> 6, wr = wv >> 1, wc = wv & 1, l15 = lane & 15, quad = lane >> 4;
    const bf16_t* U = wsb(p, O_U); const bf16_t* W = wsb(p, O_WT) + W_GATE;
    bf16_t* P = wsb(p, O_P);
    const int nrt = latent_only ? 128 : 136;
    for (TileIter ti(nrt, 24); ti.valid(); ti.next()) {
        int tm, tn; ti.get(tm, tn);
        const int row0 = rowtile0(tm, latent_only);
        f32x4 acc[8][4]; zero_acc(acc);
        gemm_core<8, 4>(U + (size_t)row0 * D, D, W + (size_t)tn * 128 * D, D, D, acc, sA);
        const int dcol0 = sgcol(tn >> 3, (tn & 7) * 128);
#pragma unroll
        for (int mt = 0; mt < 8; ++mt)
#pragma unroll
            for (int nt = 0; nt < 4; ++nt)
#pragma unroll
                for (int j = 0; j < 4; ++j) {
                    if (nt == 0 && j == 0) __builtin_amdgcn_sched_barrier(0);
                    const int row = row0 + wr * 128 + mt * 16 + quad * 4 + j, col = dcol0 + wc * 64 + nt * 16 + l15;
                    P[(size_t)row * PW + col] = f2bf(sigm(acc[mt][nt][j]));
                }
    }
}

DEV void phase_merge(const Params& p, bool latent_only, unsigned char* smem) {
    bf16_t* sA = (bf16_t*)smem;
    const int tid = get_tid(), lane = tid & 63, wv = tid >> 6, wr = wv >> 1, wc = wv & 1, l15 = lane & 15, quad = lane >> 4;
    const bf16_t* W = wsb(p, O_WT);
    const bf16_t* P = wsb(p, O_P);
    bf16_t* U = wsb(p, O_U);
    const int nrt = latent_only ? 128 : 136;
    for (TileIter ti(nrt, 8); ti.valid(); ti.next()) {
        int tm, tn; ti.get(tm, tn);
        const int row0 = rowtile0(tm, latent_only), col0 = tn * 128;
        f32x4 m[8][4]; zero_acc(m);
#pragma unroll 1
        for (int n = 0; n < 3; ++n) {
            f32x4 au[8][4]; zero_acc(au);
            const bf16_t* Y; int ldy;
            if (n == 0) { Y = wsb(p, O_TA) + (size_t)row0 * 512; ldy = 512; }
            else if (n == 1) { Y = P + (size_t)row0 * PW + C_LG; ldy = PW; }
            else { Y = P + (size_t)row0 * PW + C_DAQ; ldy = PW; }
            gemm_core1<8, 4>(Y, ldy, W + W_BR + ((size_t)n * 1024 + col0) * 512, 512, 512, au, sA, sA + 256 * GLD);
            const int sc0 = sgcol(n, col0);
#pragma unroll
            for (int mt = 0; mt < 8; ++mt)
#pragma unroll
                for (int nt = 0; nt < 4; ++nt)
#pragma unroll
                    for (int j = 0; j < 4; ++j) {
                        if (nt == 0 && j == 0) __builtin_amdgcn_sched_barrier(0);
                        const int row = row0 + wr * 128 + mt * 16 + quad * 4 + j, col = sc0 + wc * 64 + nt * 16 + l15;
                        m[mt][nt][j] += bf2f(P[(size_t)row * PW + col]) * au[mt][nt][j];
                    }
        }
#pragma unroll
        for (int mt = 0; mt < 8; ++mt)
#pragma unroll
            for (int nt = 0; nt < 4; ++nt)
#pragma unroll
                for (int j = 0; j < 4; ++j) {
                    if (nt == 0 && j == 0) __builtin_amdgcn_sched_barrier(0);
                    const int row = row0 + wr * 128 + mt * 16 + quad * 4 + j, col = col0 + wc * 64 + nt * 16 + l15;
                    U[(size_t)row * D + col] = f2bf(m[mt][nt][j]);
                }
    }
}

DEV void phase_resid(const Params& p, int l, const bf16_t* A, int lda, const bf16_t* Wt, int K, int chunk, bool first, bool latent_only, unsigned char* smem) {
    bf16_t* sA = (bf16_t*)smem;
    const int tid = get_tid(), lane = tid & 63, wv = tid >> 6, wr = wv >> 1, wc = wv & 1, l15 = lane & 15, quad = lane >> 4;
    const int nrt = latent_only ? 128 : 136;
    for (TileIter ti(nrt, 8); ti.valid(); ti.next()) {
        int tm, tn; ti.get(tm, tn);
        const int row0 = rowtile0(tm, latent_only), col0 = tn * 128;
        f32x4 acc[8][4]; zero_acc(acc);
        gemm_core<8, 4>(A + (size_t)row0 * lda, lda, Wt + (size_t)col0 * K, K, K, acc, sA);
        const float* md = wsf(p, O_MOD) + ((size_t)l * 9 + modrow(row0)) * 6144 + chunk * D;
        const float* hs0 = first ? xrow(p, row0) : hrow(p, row0);
        float* hd0 = hrow(p, row0);
#pragma unroll
        for (int mt = 0; mt < 8; ++mt)
#pragma unroll
            for (int j = 0; j < 4; ++j) {
                if (j == 0) __builtin_amdgcn_sched_barrier(0);
                const int rl = wr * 128 + mt * 16 + quad * 4 + j;
                const float* hs = hs0 + (size_t)rl * D;
                float* hd = hd0 + (size_t)rl * D;
#pragma unroll
                for (int nt = 0; nt < 4; ++nt) { const int col = col0 + wc * 64 + nt * 16 + l15; hd[col] = hs[col] + md[col] * acc[mt][nt][j]; }
            }
    }
}
DEV void phase_gu(const Params& p, bool latent_only, unsigned char* smem) {
    bf16_t* sA = (bf16_t*)smem;
    const int tid = get_tid(), lane = tid & 63, wv = tid >> 6, wr = wv >> 1, wc = wv & 1, l15 = lane & 15, quad = lane >> 4;
    const bf16_t* U = wsb(p, O_U); const bf16_t* W = wsb(p, O_WT) + W_GU;
    bf16_t* P = wsb(p, O_P);
    const int nrt = latent_only ? 128 : 136;
    for (TileIter ti(nrt, 44); ti.valid(); ti.next()) {
        int tm, tn; ti.get(tm, tn);
        const int row0 = rowtile0(tm, latent_only);
        f32x4 acc[8][4]; zero_acc(acc);
        gemm_core<8, 4>(U + (size_t)row0 * D, D, W + (size_t)tn * 128 * D, D, D, acc, sA);
#pragma unroll
        for (int mt = 0; mt < 8; ++mt)
#pragma unroll
            for (int pr = 0; pr < 2; ++pr)
#pragma unroll
                for (int j = 0; j < 4; ++j) {
                    if (pr == 0 && j == 0) __builtin_amdgcn_sched_barrier(0);
                    const int row = row0 + wr * 128 + mt * 16 + quad * 4 + j, hc = (tn * 4 + wc * 2 + pr) * 16 + l15;
                    P[(size_t)row * PW + hc] = f2bf(silu(acc[mt][2 * pr][j]) * acc[mt][2 * pr + 1][j]);
                }
    }
}

DEV int chunk_of(int dir, int n) { return dir ? (n < 4 ? 3 - n : 71 - n) : n; }

typedef float f32x2 __attribute__((ext_vector_type(2)));
DEV void dn_solve(const float* __restrict__ Lt_s0, const bf16_t* __restrict__ colp, const float* __restrict__ mulp0, const float sg, bf16_t* __restrict__ outp) {
    int vz = 0; asm volatile("" : "+v"(vz));
    const float* __restrict__ Lt_s = Lt_s0 + vz; const float* __restrict__ mulp = mulp0 + vz;
    f32x2 X0, X1, X2, X3, X4, X5, X6, X7, X8, X9, X10, X11, X12, X13, X14, X15, X16, X17, X18, X19, X20, X21, X22, X23, X24, X25, X26, X27, X28, X29, X30, X31;
    f32x4 La0, La1, La2, La3, La4, La5, La6, La7, La8, La9, La10, La11, La12, La13, La14, La15, Lb0, Lb1, Lb2, Lb3, Lb4, Lb5, Lb6, Lb7, Lb8, Lb9, Lb10, Lb11, Lb12, Lb13, Lb14, Lb15;
    X0 = (f32x2){bf2f(colp[0]) * mulp[0], bf2f(colp[136]) * mulp[1]};
    X1 = (f32x2){bf2f(colp[272]) * mulp[2], bf2f(colp[408]) * mulp[3]};
    X2 = (f32x2){bf2f(colp[544]) * mulp[4], bf2f(colp[680]) * mulp[5]};
    X3 = (f32x2){bf2f(colp[816]) * mulp[6], bf2f(colp[952]) * mulp[7]};
    X4 = (f32x2){bf2f(colp[1088]) * mulp[8], bf2f(colp[1224]) * mulp[9]};
    X5 = (f32x2){bf2f(colp[1360]) * mulp[10], bf2f(colp[1496]) * mulp[11]};
    X6 = (f32x2){bf2f(colp[1632]) * mulp[12], bf2f(colp[1768]) * mulp[13]};
    X7 = (f32x2){bf2f(colp[1904]) * mulp[14], bf2f(colp[2040]) * mulp[15]};
    X8 = (f32x2){bf2f(colp[2176]) * mulp[16], bf2f(colp[2312]) * mulp[17]};
    X9 = (f32x2){bf2f(colp[2448]) * mulp[18], bf2f(colp[2584]) * mulp[19]};
    X10 = (f32x2){bf2f(colp[2720]) * mulp[20], bf2f(colp[2856]) * mulp[21]};
    X11 = (f32x2){bf2f(colp[2992]) * mulp[22], bf2f(colp[3128]) * mulp[23]};
    X12 = (f32x2){bf2f(colp[3264]) * mulp[24], bf2f(colp[3400]) * mulp[25]};
    X13 = (f32x2){bf2f(colp[3536]) * mulp[26], bf2f(colp[3672]) * mulp[27]};
    X14 = (f32x2){bf2f(colp[3808]) * mulp[28], bf2f(colp[3944]) * mulp[29]};
    X15 = (f32x2){bf2f(colp[4080]) * mulp[30], bf2f(colp[4216]) * mulp[31]};
    X16 = (f32x2){bf2f(colp[4352]) * mulp[32], bf2f(colp[4488]) * mulp[33]};
    X17 = (f32x2){bf2f(colp[4624]) * mulp[34], bf2f(colp[4760]) * mulp[35]};
    X18 = (f32x2){bf2f(colp[4896]) * mulp[36], bf2f(colp[5032]) * mulp[37]};
    X19 = (f32x2){bf2f(colp[5168]) * mulp[38], bf2f(colp[5304]) * mulp[39]};
    X20 = (f32x2){bf2f(colp[5440]) * mulp[40], bf2f(colp[5576]) * mulp[41]};
    X21 = (f32x2){bf2f(colp[5712]) * mulp[42], bf2f(colp[5848]) * mulp[43]};
    X22 = (f32x2){bf2f(colp[5984]) * mulp[44], bf2f(colp[6120]) * mulp[45]};
    X23 = (f32x2){bf2f(colp[6256]) * mulp[46], bf2f(colp[6392]) * mulp[47]};
    X24 = (f32x2){bf2f(colp[6528]) * mulp[48], bf2f(colp[6664]) * mulp[49]};
    X25 = (f32x2){bf2f(colp[6800]) * mulp[50], bf2f(colp[6936]) * mulp[51]};
    X26 = (f32x2){bf2f(colp[7072]) * mulp[52], bf2f(colp[7208]) * mulp[53]};
    X27 = (f32x2){bf2f(colp[7344]) * mulp[54], bf2f(colp[7480]) * mulp[55]};
    X28 = (f32x2){bf2f(colp[7616]) * mulp[56], bf2f(colp[7752]) * mulp[57]};
    X29 = (f32x2){bf2f(colp[7888]) * mulp[58], bf2f(colp[8024]) * mulp[59]};
    X30 = (f32x2){bf2f(colp[8160]) * mulp[60], bf2f(colp[8296]) * mulp[61]};
    X31 = (f32x2){bf2f(colp[8432]) * mulp[62], bf2f(colp[8568]) * mulp[63]};
    La0 = *(const f32x4*)(Lt_s + 0);
    La1 = *(const f32x4*)(Lt_s + 4);
    La2 = *(const f32x4*)(Lt_s + 8);
    La3 = *(const f32x4*)(Lt_s + 12);
    La4 = *(const f32x4*)(Lt_s + 16);
    La5 = *(const f32x4*)(Lt_s + 20);
    La6 = *(const f32x4*)(Lt_s + 24);
    La7 = *(const f32x4*)(Lt_s + 28);
    La8 = *(const f32x4*)(Lt_s + 32);
    La9 = *(const f32x4*)(Lt_s + 36);
    La10 = *(const f32x4*)(Lt_s + 40);
    La11 = *(const f32x4*)(Lt_s + 44);
    La12 = *(const f32x4*)(Lt_s + 48);
    La13 = *(const f32x4*)(Lt_s + 52);
    La14 = *(const f32x4*)(Lt_s + 56);
    La15 = *(const f32x4*)(Lt_s + 60);
    Lb0 = *(const f32x4*)(Lt_s + 68);
    Lb1 = *(const f32x4*)(Lt_s + 72);
    Lb2 = *(const f32x4*)(Lt_s + 76);
    Lb3 = *(const f32x4*)(Lt_s + 80);
    Lb4 = *(const f32x4*)(Lt_s + 84);
    Lb5 = *(const f32x4*)(Lt_s + 88);
    Lb6 = *(const f32x4*)(Lt_s + 92);
    Lb7 = *(const f32x4*)(Lt_s + 96);
    Lb8 = *(const f32x4*)(Lt_s + 100);
    Lb9 = *(const f32x4*)(Lt_s + 104);
    Lb10 = *(const f32x4*)(Lt_s + 108);
    Lb11 = *(const f32x4*)(Lt_s + 112);
    Lb12 = *(const f32x4*)(Lt_s + 116);
    Lb13 = *(const f32x4*)(Lt_s + 120);
    Lb14 = *(const f32x4*)(Lt_s + 124);
    Lb15 = *(const f32x4*)(Lt_s + 128);
    __builtin_amdgcn_sched_barrier(0);
    { const float xj = X0[0]; const f32x2 xj2 = (f32x2){xj, xj};
      X0 -= (f32x2){La0[0], La0[1]} * xj2;
      X1 -= (f32x2){La0[2], La0[3]} * xj2;
      X2 -= (f32x2){La1[0], La1[1]} * xj2;
      X3 -= (f32x2){La1[2], La1[3]} * xj2;
      X4 -= (f32x2){La2[0], La2[1]} * xj2;
      X5 -= (f32x2){La2[2], La2[3]} * xj2;
      X6 -= (f32x2){La3[0], La3[1]} * xj2;
      X7 -= (f32x2){La3[2], La3[3]} * xj2;
      X8 -= (f32x2){La4[0], La4[1]} * xj2;
      X9 -= (f32x2){La4[2], La4[3]} * xj2;
      X10 -= (f32x2){La5[0], La5[1]} * xj2;
      X11 -= (f32x2){La5[2], La5[3]} * xj2;
      X12 -= (f32x2){La6[0], La6[1]} * xj2;
      X13 -= (f32x2){La6[2], La6[3]} * xj2;
      X14 -= (f32x2){La7[0], La7[1]} * xj2;
      X15 -= (f32x2){La7[2], La7[3]} * xj2;
      X16 -= (f32x2){La8[0], La8[1]} * xj2;
      X17 -= (f32x2){La8[2], La8[3]} * xj2;
      X18 -= (f32x2){La9[0], La9[1]} * xj2;
      X19 -= (f32x2){La9[2], La9[3]} * xj2;
      X20 -= (f32x2){La10[0], La10[1]} * xj2;
      X21 -= (f32x2){La10[2], La10[3]} * xj2;
      X22 -= (f32x2){La11[0], La11[1]} * xj2;
      X23 -= (f32x2){La11[2], La11[3]} * xj2;
      X24 -= (f32x2){La12[0], La12[1]} * xj2;
      X25 -= (f32x2){La12[2], La12[3]} * xj2;
      X26 -= (f32x2){La13[0], La13[1]} * xj2;
      X27 -= (f32x2){La13[2], La13[3]} * xj2;
      X28 -= (f32x2){La14[0], La14[1]} * xj2;
      X29 -= (f32x2){La14[2], La14[3]} * xj2;
      X30 -= (f32x2){La15[0], La15[1]} * xj2;
      X31 -= (f32x2){La15[2], La15[3]} * xj2;
    }
    __builtin_amdgcn_sched_barrier(0);
    La0 = *(const f32x4*)(Lt_s + 136);
    La1 = *(const f32x4*)(Lt_s + 140);
    La2 = *(const f32x4*)(Lt_s + 144);
    La3 = *(const f32x4*)(Lt_s + 148);
    La4 = *(const f32x4*)(Lt_s + 152);
    La5 = *(const f32x4*)(Lt_s + 156);
    La6 = *(const f32x4*)(Lt_s + 160);
    La7 = *(const f32x4*)(Lt_s + 164);
    La8 = *(const f32x4*)(Lt_s + 168);
    La9 = *(const f32x4*)(Lt_s + 172);
    La10 = *(const f32x4*)(Lt_s + 176);
    La11 = *(const f32x4*)(Lt_s + 180);
    La12 = *(const f32x4*)(Lt_s + 184);
    La13 = *(const f32x4*)(Lt_s + 188);
    La14 = *(const f32x4*)(Lt_s + 192);
    La15 = *(const f32x4*)(Lt_s + 196);
    __builtin_amdgcn_sched_barrier(0);
    { const float xj = X0[1]; const f32x2 xj2 = (f32x2){xj, xj};
      X1 -= (f32x2){Lb0[2], Lb0[3]} * xj2;
      X2 -= (f32x2){Lb1[0], Lb1[1]} * xj2;
      X3 -= (f32x2){Lb1[2], Lb1[3]} * xj2;
      X4 -= (f32x2){Lb2[0], Lb2[1]} * xj2;
      X5 -= (f32x2){Lb2[2], Lb2[3]} * xj2;
      X6 -= (f32x2){Lb3[0], Lb3[1]} * xj2;
      X7 -= (f32x2){Lb3[2], Lb3[3]} * xj2;
      X8 -= (f32x2){Lb4[0], Lb4[1]} * xj2;
      X9 -= (f32x2){Lb4[2], Lb4[3]} * xj2;
      X10 -= (f32x2){Lb5[0], Lb5[1]} * xj2;
      X11 -= (f32x2){Lb5[2], Lb5[3]} * xj2;
      X12 -= (f32x2){Lb6[0], Lb6[1]} * xj2;
      X13 -= (f32x2){Lb6[2], Lb6[3]} * xj2;
      X14 -= (f32x2){Lb7[0], Lb7[1]} * xj2;
      X15 -= (f32x2){Lb7[2], Lb7[3]} * xj2;
      X16 -= (f32x2){Lb8[0], Lb8[1]} * xj2;
      X17 -= (f32x2){Lb8[2], Lb8[3]} * xj2;
      X18 -= (f32x2){Lb9[0], Lb9[1]} * xj2;
      X19 -= (f32x2){Lb9[2], Lb9[3]} * xj2;
      X20 -= (f32x2){Lb10[0], Lb10[1]} * xj2;
      X21 -= (f32x2){Lb10[2], Lb10[3]} * xj2;
      X22 -= (f32x2){Lb11[0], Lb11[1]} * xj2;
      X23 -= (f32x2){Lb11[2], Lb11[3]} * xj2;
      X24 -= (f32x2){Lb12[0], Lb12[1]} * xj2;
      X25 -= (f32x2){Lb12[2], Lb12[3]} * xj2;
      X26 -= (f32x2){Lb13[0], Lb13[1]} * xj2;
      X27 -= (f32x2){Lb13[2], Lb13[3]} * xj2;
      X28 -= (f32x2){Lb14[0], Lb14[1]} * xj2;
      X29 -= (f32x2){Lb14[2], Lb14[3]} * xj2;
      X30 -= (f32x2){Lb15[0], Lb15[1]} * xj2;
      X31 -= (f32x2){Lb15[2], Lb15[3]} * xj2;
    }
    __builtin_amdgcn_sched_barrier(0);
    Lb1 = *(const f32x4*)(Lt_s + 208);
    Lb2 = *(const f32x4*)(Lt_s + 212);
    Lb3 = *(const f32x4*)(Lt_s + 216);
    Lb4 = *(const f32x4*)(Lt_s + 220);
    Lb5 = *(const f32x4*)(Lt_s + 224);
    Lb6 = *(const f32x4*)(Lt_s + 228);
    Lb7 = *(const f32x4*)(Lt_s + 232);
    Lb8 = *(const f32x4*)(Lt_s + 236);
    Lb9 = *(const f32x4*)(Lt_s + 240);
    Lb10 = *(const f32x4*)(Lt_s + 244);
    Lb11 = *(const f32x4*)(Lt_s + 248);
    Lb12 = *(const f32x4*)(Lt_s + 252);
    Lb13 = *(const f32x4*)(Lt_s + 256);
    Lb14 = *(const f32x4*)(Lt_s + 260);
    Lb15 = *(const f32x4*)(Lt_s + 264);
    __builtin_amdgcn_sched_barrier(0);
    { const float xj = X1[0]; const f32x2 xj2 = (f32x2){xj, xj};
      X1 -= (f32x2){La0[2], La0[3]} * xj2;
      X2 -= (f32x2){La1[0], La1[1]} * xj2;
      X3 -= (f32x2){La1[2], La1[3]} * xj2;
      X4 -= (f32x2){La2[0], La2[1]} * xj2;
      X5 -= (f32x2){La2[2], La2[3]} * xj2;
      X6 -= (f32x2){La3[0], La3[1]} * xj2;
      X7 -= (f32x2){La3[2], La3[3]} * xj2;
      X8 -= (f32x2){La4[0], La4[1]} * xj2;
      X9 -= (f32x2){La4[2], La4[3]} * xj2;
      X10 -= (f32x2){La5[0], La5[1]} * xj2;
      X11 -= (f32x2){La5[2], La5[3]} * xj2;
      X12 -= (f32x2){La6[0], La6[1]} * xj2;
      X13 -= (f32x2){La6[2], La6[3]} * xj2;
      X14 -= (f32x2){La7[0], La7[1]} * xj2;
      X15 -= (f32x2){La7[2], La7[3]} * xj2;
      X16 -= (f32x2){La8[0], La8[1]} * xj2;
      X17 -= (f32x2){La8[2], La8[3]} * xj2;
      X18 -= (f32x2){La9[0], La9[1]} * xj2;
      X19 -= (f32x2){La9[2], La9[3]} * xj2;
      X20 -= (f32x2){La10[0], La10[1]} * xj2;
      X21 -= (f32x2){La10[2], La10[3]} * xj2;
      X22 -= (f32x2){La11[0], La11[1]} * xj2;
      X23 -= (f32x2){La11[2], La11[3]} * xj2;
      X24 -= (f32x2){La12[0], La12[1]} * xj2;
      X25 -= (f32x2){La12[2], La12[3]} * xj2;
      X26 -= (f32x2){La13[0], La13[1]} * xj2;
      X27 -= (f32x2){La13[2], La13[3]} * xj2;
      X28 -= (f32x2){La14[0], La14[1]} * xj2;
      X29 -= (f32x2){La14[2], La14[3]} * xj2;
      X30 -= (f32x2){La15[0], La15[1]} * xj2;
      X31 -= (f32x2){La15[2], La15[3]} * xj2;
    }
    __builtin_amdgcn_sched_barrier(0);
    La1 = *(const f32x4*)(Lt_s + 276);
    La2 = *(const f32x4*)(Lt_s + 280);
    La3 = *(const f32x4*)(Lt_s + 284);
    La4 = *(const f32x4*)(Lt_s + 288);
    La5 = *(const f32x4*)(Lt_s + 292);
    La6 = *(const f32x4*)(Lt_s + 296);
    La7 = *(const f32x4*)(Lt_s + 300);
    La8 = *(const f32x4*)(Lt_s + 304);
    La9 = *(const f32x4*)(Lt_s + 308);
    La10 = *(const f32x4*)(Lt_s + 312);
    La11 = *(const f32x4*)(Lt_s + 316);
    La12 = *(const f32x4*)(Lt_s + 320);
    La13 = *(const f32x4*)(Lt_s + 324);
    La14 = *(const f32x4*)(Lt_s + 328);
    La15 = *(const f32x4*)(Lt_s + 332);
    __builtin_amdgcn_sched_barrier(0);
    { const float xj = X1[1]; const f32x2 xj2 = (f32x2){xj, xj};
      X2 -= (f32x2){Lb1[0], Lb1[1]} * xj2;
      X3 -= (f32x2){Lb1[2], Lb1[3]} * xj2;
      X4 -= (f32x2){Lb2[0], Lb2[1]} * xj2;
      X5 -= (f32x2){Lb2[2], Lb2[3]} * xj2;
      X6 -= (f32x2){Lb3[0], Lb3[1]} * xj2;
      X7 -= (f32x2){Lb3[2], Lb3[3]} * xj2;
      X8 -= (f32x2){Lb4[0], Lb4[1]} * xj2;
      X9 -= (f32x2){Lb4[2], Lb4[3]} * xj2;
      X10 -= (f32x2){Lb5[0], Lb5[1]} * xj2;
      X11 -= (f32x2){Lb5[2], Lb5[3]} * xj2;
      X12 -= (f32x2){Lb6[0], Lb6[1]} * xj2;
      X13 -= (f32x2){Lb6[2], Lb6[3]} * xj2;
      X14 -= (f32x2){Lb7[0], Lb7[1]} * xj2;
      X15 -= (f32x2){Lb7[2], Lb7[3]} * xj2;
      X16 -= (f32x2){Lb8[0], Lb8[1]} * xj2;
      X17 -= (f32x2){Lb8[2], Lb8[3]} * xj2;
      X18 -= (f32x2){Lb9[0], Lb9[1]} * xj2;
      X19 -= (f32x2){Lb9[2], Lb9[3]} * xj2;
      X20 -= (f32x2){Lb10[0], Lb10[1]} * xj2;
      X21 -= (f32x2){Lb10[2], Lb10[3]} * xj2;
      X22 -= (f32x2){Lb11[0], Lb11[1]} * xj2;
      X23 -= (f32x2){Lb11[2], Lb11[3]} * xj2;
      X24 -= (f32x2){Lb12[0], Lb12[1]} * xj2;
      X25 -= (f32x2){Lb12[2], Lb12[3]} * xj2;
      X26 -= (f32x2){Lb13[0], Lb13[1]} * xj2;
      X27 -= (f32x2){Lb13[2], Lb13[3]} * xj2;
      X28 -= (f32x2){Lb14[0], Lb14[1]} * xj2;
      X29 -= (f32x2){Lb14[2], Lb14[3]} * xj2;
      X30 -= (f32x2){Lb15[0], Lb15[1]} * xj2;
      X31 -= (f32x2){Lb15[2], Lb15[3]} * xj2;
    }
    __builtin_amdgcn_sched_barrier(0);
    Lb1 = *(const f32x4*)(Lt_s + 344);
    Lb2 = *(const f32x4*)(Lt_s + 348);
    Lb3 = *(const f32x4*)(Lt_s + 352);
    Lb4 = *(const f32x4*)(Lt_s + 356);
    Lb5 = *(const f32x4*)(Lt_s + 360);
    Lb6 = *(const f32x4*)(Lt_s + 364);
    Lb7 = *(const f32x4*)(Lt_s + 368);
    Lb8 = *(const f32x4*)(Lt_s + 372);
    Lb9 = *(const f32x4*)(Lt_s + 376);
    Lb10 = *(const f32x4*)(Lt_s + 380);
    Lb11 = *(const f32x4*)(Lt_s + 384);
    Lb12 = *(const f32x4*)(Lt_s + 388);
    Lb13 = *(const f32x4*)(Lt_s + 392);
    Lb14 = *(const f32x4*)(Lt_s + 396);
    Lb15 = *(const f32x4*)(Lt_s + 400);
    __builtin_amdgcn_sched_barrier(0);
    { const float xj = X2[0]; const f32x2 xj2 = (f32x2){xj, xj};
      X2 -= (f32x2){La1[0], La1[1]} * xj2;
      X3 -= (f32x2){La1[2], La1[3]} * xj2;
      X4 -= (f32x2){La2[0], La2[1]} * xj2;
      X5 -= (f32x2){La2[2], La2[3]} * xj2;
      X6 -= (f32x2){La3[0], La3[1]} * xj2;
      X7 -= (f32x2){La3[2], La3[3]} * xj2;
      X8 -= (f32x2){La4[0], La4[1]} * xj2;
      X9 -= (f32x2){La4[2], La4[3]} * xj2;
      X10 -= (f32x2){La5[0], La5[1]} * xj2;
      X11 -= (f32x2){La5[2], La5[3]} * xj2;
      X12 -= (f32x2){La6[0], La6[1]} * xj2;
      X13 -= (f32x2){La6[2], La6[3]} * xj2;
      X14 -= (f32x2){La7[0], La7[1]} * xj2;
      X15 -= (f32x2){La7[2], La7[3]} * xj2;
      X16 -= (f32x2){La8[0], La8[1]} * xj2;
      X17 -= (f32x2){La8[2], La8[3]} * xj2;
      X18 -= (f32x2){La9[0], La9[1]} * xj2;
      X19 -= (f32x2){La9[2], La9[3]} * xj2;
      X20 -= (f32x2){La10[0], La10[1]} * xj2;
      X21 -= (f32x2){La10[2], La10[3]} * xj2;
      X22 -= (f32x2){La11[0], La11[1]} * xj2;
      X23 -= (f32x2){La11[2], La11[3]} * xj2;
      X24 -= (f32x2){La12[0], La12[1]} * xj2;
      X25 -= (f32x2){La12[2], La12[3]} * xj2;
      X26 -= (f32x2){La13[0], La13[1]} * xj2;
      X27 -= (f32x2){La13[2], La13[3]} * xj2;
      X28 -= (f32x2){La14[0], La14[1]} * xj2;
      X29 -= (f32x2){La14[2], La14[3]} * xj2;
      X30 -= (f32x2){La15[0], La15[1]} * xj2;
      X31 -= (f32x2){La15[2], La15[3]} * xj2;
    }
    __builtin_amdgcn_sched_barrier(0);
    La1 = *(const f32x4*)(Lt_s + 412);
    La2 = *(const f32x4*)(Lt_s + 416);
    La3 = *(const f32x4*)(Lt_s + 420);
    La4 = *(const f32x4*)(Lt_s + 424);
    La5 = *(const f32x4*)(Lt_s + 428);
    La6 = *(const f32x4*)(Lt_s + 432);
    La7 = *(const f32x4*)(Lt_s + 436);
    La8 = *(const f32x4*)(Lt_s + 440);
    La9 = *(const f32x4*)(Lt_s + 444);
    La10 = *(const f32x4*)(Lt_s + 448);
    La11 = *(const f32x4*)(Lt_s + 452);
    La12 = *(const f32x4*)(Lt_s + 456);
    La13 = *(const f32x4*)(Lt_s + 460);
    La14 = *(const f32x4*)(Lt_s + 464);
    La15 = *(const f32x4*)(Lt_s + 468);
    __builtin_amdgcn_sched_barrier(0);
    { const float xj = X2[1]; const f32x2 xj2 = (f32x2){xj, xj};
      X3 -= (f32x2){Lb1[2], Lb1[3]} * xj2;
      X4 -= (f32x2){Lb2[0], Lb2[1]} * xj2;
      X5 -= (f32x2){Lb2[2], Lb2[3]} * xj2;
      X6 -= (f32x2){Lb3[0], Lb3[1]} * xj2;
      X7 -= (f32x2){Lb3[2], Lb3[3]} * xj2;
      X8 -= (f32x2){Lb4[0], Lb4[1]} * xj2;
      X9 -= (f32x2){Lb4[2], Lb4[3]} * xj2;
      X10 -= (f32x2){Lb5[0], Lb5[1]} * xj2;
      X11 -= (f32x2){Lb5[2], Lb5[3]} * xj2;
      X12 -= (f32x2){Lb6[0], Lb6[1]} * xj2;
      X13 -= (f32x2){Lb6[2], Lb6[3]} * xj2;
      X14 -= (f32x2){Lb7[0], Lb7[1]} * xj2;
      X15 -= (f32x2){Lb7[2], Lb7[3]} * xj2;
      X16 -= (f32x2){Lb8[0], Lb8[1]} * xj2;
      X17 -= (f32x2){Lb8[2], Lb8[3]} * xj2;
      X18 -= (f32x2){Lb9[0], Lb9[1]} * xj2;
      X19 -= (f32x2){Lb9[2], Lb9[3]} * xj2;
      X20 -= (f32x2){Lb10[0], Lb10[1]} * xj2;
      X21 -= (f32x2){Lb10[2], Lb10[3]} * xj2;
      X22 -= (f32x2){Lb11[0], Lb11[1]} * xj2;
      X23 -= (f32x2){Lb11[2], Lb11[3]} * xj2;
      X24 -= (f32x2){Lb12[0], Lb12[1]} * xj2;
      X25 -= (f32x2){Lb12[2], Lb12[3]} * xj2;
      X26 -= (f32x2){Lb13[0], Lb13[1]} * xj2;
      X27 -= (f32x2){Lb13[2], Lb13[3]} * xj2;
      X28 -= (f32x2){Lb14[0], Lb14[1]} * xj2;
      X29 -= (f32x2){Lb14[2], Lb14[3]} * xj2;
      X30 -= (f32x2){Lb15[0], Lb15[1]} * xj2;
      X31 -= (f32x2){Lb15[2], Lb15[3]} * xj2;
    }
    __builtin_amdgcn_sched_barrier(0);
    Lb2 = *(const f32x4*)(Lt_s + 484);
    Lb3 = *(const f32x4*)(Lt_s + 488);
    Lb4 = *(const f32x4*)(Lt_s + 492);
    Lb5 = *(const f32x4*)(Lt_s + 496);
    Lb6 = *(const f32x4*)(Lt_s + 500);
    Lb7 = *(const f32x4*)(Lt_s + 504);
    Lb8 = *(const f32x4*)(Lt_s + 508);
    Lb9 = *(const f32x4*)(Lt_s + 512);
    Lb10 = *(const f32x4*)(Lt_s + 516);
    Lb11 = *(const f32x4*)(Lt_s + 520);
    Lb12 = *(const f32x4*)(Lt_s + 524);
    Lb13 = *(const f32x4*)(Lt_s + 528);
    Lb14 = *(const f32x4*)(Lt_s + 532);
    Lb15 = *(const f32x4*)(Lt_s + 536);
    __builtin_amdgcn_sched_barrier(0);
    { const float xj = X3[0]; const f32x2 xj2 = (f32x2){xj, xj};
      X3 -= (f32x2){La1[2], La1[3]} * xj2;
      X4 -= (f32x2){La2[0], La2[1]} * xj2;
      X5 -= (f32x2){La2[2], La2[3]} * xj2;
      X6 -= (f32x2){La3[0], La3[1]} * xj2;
      X7 -= (f32x2){La3[2], La3[3]} * xj2;
      X8 -= (f32x2){La4[0], La4[1]} * xj2;
      X9 -= (f32x2){La4[2], La4[3]} * xj2;
      X10 -= (f32x2){La5[0], La5[1]} * xj2;
      X11 -= (f32x2){La5[2], La5[3]} * xj2;
      X12 -= (f32x2){La6[0], La6[1]} * xj2;
      X13 -= (f32x2){La6[2], La6[3]} * xj2;
      X14 -= (f32x2){La7[0], La7[1]} * xj2;
      X15 -= (f32x2){La7[2], La7[3]} * xj2;
      X16 -= (f32x2){La8[0], La8[1]} * xj2;
      X17 -= (f32x2){La8[2], La8[3]} * xj2;
      X18 -= (f32x2){La9[0], La9[1]} * xj2;
      X19 -= (f32x2){La9[2], La9[3]} * xj2;
      X20 -= (f32x2){La10[0], La10[1]} * xj2;
      X21 -= (f32x2){La10[2], La10[3]} * xj2;
      X22 -= (f32x2){La11[0], La11[1]} * xj2;
      X23 -= (f32x2){La11[2], La11[3]} * xj2;
      X24 -= (f32x2){La12[0], La12[1]} * xj2;
      X25 -= (f32x2){La12[2], La12[3]} * xj2;
      X26 -= (f32x2){La13[0], La13[1]} * xj2;
      X27 -= (f32x2){La13[2], La13[3]} * xj2;
      X28 -= (f32x2){La14[0], La14[1]} * xj2;
      X29 -= (f32x2){La14[2], La14[3]} * xj2;
      X30 -= (f32x2){La15[0], La15[1]} * xj2;
      X31 -= (f32x2){La15[2], La15[3]} * xj2;
    }
    __builtin_amdgcn_sched_barrier(0);
    La2 = *(const f32x4*)(Lt_s + 552);
    La3 = *(const f32x4*)(Lt_s + 556);
    La4 = *(const f32x4*)(Lt_s + 560);
    La5 = *(const f32x4*)(Lt_s + 564);
    La6 = *(const f32x4*)(Lt_s + 568);
    La7 = *(const f32x4*)(Lt_s + 572);
    La8 = *(const f32x4*)(Lt_s + 576);
    La9 = *(const f32x4*)(Lt_s + 580);
    La10 = *(const f32x4*)(Lt_s + 584);
    La11 = *(const f32x4*)(Lt_s + 588);
    La12 = *(const f32x4*)(Lt_s + 592);
    La13 = *(const f32x4*)(Lt_s + 596);
    La14 = *(const f32x4*)(Lt_s + 600);
    La15 = *(const f32x4*)(Lt_s + 604);
    __builtin_amdgcn_sched_barrier(0);
    { const float xj = X3[1]; const f32x2 xj2 = (f32x2){xj, xj};
      X4 -= (f32x2){Lb2[0], Lb2[1]} * xj2;
      X5 -= (f32x2){Lb2[2], Lb2[3]} * xj2;
      X6 -= (f32x2){Lb3[0], Lb3[1]} * xj2;
      X7 -= (f32x2){Lb3[2], Lb3[3]} * xj2;
      X8 -= (f32x2){Lb4[0], Lb4[1]} * xj2;
      X9 -= (f32x2){Lb4[2], Lb4[3]} * xj2;
      X10 -= (f32x2){Lb5[0], Lb5[1]} * xj2;
      X11 -= (f32x2){Lb5[2], Lb5[3]} * xj2;
      X12 -= (f32x2){Lb6[0], Lb6[1]} * xj2;
      X13 -= (f32x2){Lb6[2], Lb6[3]} * xj2;
      X14 -= (f32x2){Lb7[0], Lb7[1]} * xj2;
      X15 -= (f32x2){Lb7[2], Lb7[3]} * xj2;
      X16 -= (f32x2){Lb8[0], Lb8[1]} * xj2;
      X17 -= (f32x2){Lb8[2], Lb8[3]} * xj2;
      X18 -= (f32x2){Lb9[0], Lb9[1]} * xj2;
      X19 -= (f32x2){Lb9[2], Lb9[3]} * xj2;
      X20 -= (f32x2){Lb10[0], Lb10[1]} * xj2;
      X21 -= (f32x2){Lb10[2], Lb10[3]} * xj2;
      X22 -= (f32x2){Lb11[0], Lb11[1]} * xj2;
      X23 -= (f32x2){Lb11[2], Lb11[3]} * xj2;
      X24 -= (f32x2){Lb12[0], Lb12[1]} * xj2;
      X25 -= (f32x2){Lb12[2], Lb12[3]} * xj2;
      X26 -= (f32x2){Lb13[0], Lb13[1]} * xj2;
      X27 -= (f32x2){Lb13[2], Lb13[3]} * xj2;
      X28 -= (f32x2){Lb14[0], Lb14[1]} * xj2;
      X29 -= (f32x2){Lb14[2], Lb14[3]} * xj2;
      X30 -= (f32x2){Lb15[0], Lb15[1]} * xj2;
      X31 -= (f32x2){Lb15[2], Lb15[3]} * xj2;
    }
    __builtin_amdgcn_sched_barrier(0);
    Lb2 = *(const f32x4*)(Lt_s + 620);
    Lb3 = *(const f32x4*)(Lt_s + 624);
    Lb4 = *(const f32x4*)(Lt_s + 628);
    Lb5 = *(const f32x4*)(Lt_s + 632);
    Lb6 = *(const f32x4*)(Lt_s + 636);
    Lb7 = *(const f32x4*)(Lt_s + 640);
    Lb8 = *(const f32x4*)(Lt_s + 644);
    Lb9 = *(const f32x4*)(Lt_s + 648);
    Lb10 = *(const f32x4*)(Lt_s + 652);
    Lb11 = *(const f32x4*)(Lt_s + 656);
    Lb12 = *(const f32x4*)(Lt_s + 660);
    Lb13 = *(const f32x4*)(Lt_s + 664);
    Lb14 = *(const f32x4*)(Lt_s + 668);
    Lb15 = *(const f32x4*)(Lt_s + 672);
    __builtin_amdgcn_sched_barrier(0);
    { const float xj = X4[0]; const f32x2 xj2 = (f32x2){xj, xj};
      X4 -= (f32x2){La2[0], La2[1]} * xj2;
      X5 -= (f32x2){La2[2], La2[3]} * xj2;
      X6 -= (f32x2){La3[0], La3[1]} * xj2;
      X7 -= (f32x2){La3[2], La3[3]} * xj2;
      X8 -= (f32x2){La4[0], La4[1]} * xj2;
      X9 -= (f32x2){La4[2], La4[3]} * xj2;
      X10 -= (f32x2){La5[0], La5[1]} * xj2;
      X11 -= (f32x2){La5[2], La5[3]} * xj2;
      X12 -= (f32x2){La6[0], La6[1]} * xj2;
      X13 -= (f32x2){La6[2], La6[3]} * xj2;
      X14 -= (f32x2){La7[0], La7[1]} * xj2;
      X15 -= (f32x2){La7[2], La7[3]} * xj2;
      X16 -= (f32x2){La8[0], La8[1]} * xj2;
      X17 -= (f32x2){La8[2], La8[3]} * xj2;
      X18 -= (f32x2){La9[0], La9[1]} * xj2;
      X19 -= (f32x2){La9[2], La9[3]} * xj2;
      X20 -= (f32x2){La10[0], La10[1]} * xj2;
      X21 -= (f32x2){La10[2], La10[3]} * xj2;
      X22 -= (f32x2){La11[0], La11[1]} * xj2;
      X23 -= (f32x2){La11[2], La11[3]} * xj2;
      X24 -= (f32x2){La12[0], La12[1]} * xj2;
      X25 -= (f32x2){La12[2], La12[3]} * xj2;
      X26 -= (f32x2){La13[0], La13[1]} * xj2;
      X27 -= (f32x2){La13[2], La13[3]} * xj2;
      X28 -= (f32x2){La14[0], La14[1]} * xj2;
      X29 -= (f32x2){La14[2], La14[3]} * xj2;
      X30 -= (f32x2){La15[0], La15[1]} * xj2;
      X31 -= (f32x2){La15[2], La15[3]} * xj2;
    }
    __builtin_amdgcn_sched_barrier(0);
    La2 = *(const f32x4*)(Lt_s + 688);
    La3 = *(const f32x4*)(Lt_s + 692);
    La4 = *(const f32x4*)(Lt_s + 696);
    La5 = *(const f32x4*)(Lt_s + 700);
    La6 = *(const f32x4*)(Lt_s + 704);
    La7 = *(const f32x4*)(Lt_s + 708);
    La8 = *(const f32x4*)(Lt_s + 712);
    La9 = *(const f32x4*)(Lt_s + 716);
    La10 = *(const f32x4*)(Lt_s + 720);
    La11 = *(const f32x4*)(Lt_s + 724);
    La12 = *(const f32x4*)(Lt_s + 728);
    La13 = *(const f32x4*)(Lt_s + 732);
    La14 = *(const f32x4*)(Lt_s + 736);
    La15 = *(const f32x4*)(Lt_s + 740);
    __builtin_amdgcn_sched_barrier(0);
    { const float xj = X4[1]; const f32x2 xj2 = (f32x2){xj, xj};
      X5 -= (f32x2){Lb2[2], Lb2[3]} * xj2;
      X6 -= (f32x2){Lb3[0], Lb3[1]} * xj2;
      X7 -= (f32x2){Lb3[2], Lb3[3]} * xj2;
      X8 -= (f32x2){Lb4[0], Lb4[1]} * xj2;
      X9 -= (f32x2){Lb4[2], Lb4[3]} * xj2;
      X10 -= (f32x2){Lb5[0], Lb5[1]} * xj2;
      X11 -= (f32x2){Lb5[2], Lb5[3]} * xj2;
      X12 -= (f32x2){Lb6[0], Lb6[1]} * xj2;
      X13 -= (f32x2){Lb6[2], Lb6[3]} * xj2;
      X14 -= (f32x2){Lb7[0], Lb7[1]} * xj2;
      X15 -= (f32x2){Lb7[2], Lb7[3]} * xj2;
      X16 -= (f32x2){Lb8[0], Lb8[1]} * xj2;
      X17 -= (f32x2){Lb8[2], Lb8[3]} * xj2;
      X18 -= (f32x2){Lb9[0], Lb9[1]} * xj2;
      X19 -= (f32x2){Lb9[2], Lb9[3]} * xj2;
      X20 -= (f32x2){Lb10[0], Lb10[1]} * xj2;
      X21 -= (f32x2){Lb10[2], Lb10[3]} * xj2;
      X22 -= (f32x2){Lb11[0], Lb11[1]} * xj2;
      X23 -= (f32x2){Lb11[2], Lb11[3]} * xj2;
      X24 -= (f32x2){Lb12[0], Lb12[1]} * xj2;
      X25 -= (f32x2){Lb12[2], Lb12[3]} * xj2;
      X26 -= (f32x2){Lb13[0], Lb13[1]} * xj2;
      X27 -= (f32x2){Lb13[2], Lb13[3]} * xj2;
      X28 -= (f32x2){Lb14[0], Lb14[1]} * xj2;
      X29 -= (f32x2){Lb14[2], Lb14[3]} * xj2;
      X30 -= (f32x2){Lb15[0], Lb15[1]} * xj2;
      X31 -= (f32x2){Lb15[2], Lb15[3]} * xj2;
    }
    __builtin_amdgcn_sched_barrier(0);
    Lb3 = *(const f32x4*)(Lt_s + 760);
    Lb4 = *(const f32x4*)(Lt_s + 764);
    Lb5 = *(const f32x4*)(Lt_s + 768);
    Lb6 = *(const f32x4*)(Lt_s + 772);
    Lb7 = *(const f32x4*)(Lt_s + 776);
    Lb8 = *(const f32x4*)(Lt_s + 780);
    Lb9 = *(const f32x4*)(Lt_s + 784);
    Lb10 = *(const f32x4*)(Lt_s + 788);
    Lb11 = *(const f32x4*)(Lt_s + 792);
    Lb12 = *(const f32x4*)(Lt_s + 796);
    Lb13 = *(const f32x4*)(Lt_s + 800);
    Lb14 = *(const f32x4*)(Lt_s + 804);
    Lb15 = *(const f32x4*)(Lt_s + 808);
    __builtin_amdgcn_sched_barrier(0);
    { const float xj = X5[0]; const f32x2 xj2 = (f32x2){xj, xj};
      X5 -= (f32x2){La2[2], La2[3]} * xj2;
      X6 -= (f32x2){La3[0], La3[1]} * xj2;
      X7 -= (f32x2){La3[2], La3[3]} * xj2;
      X8 -= (f32x2){La4[0], La4[1]} * xj2;
      X9 -= (f32x2){La4[2], La4[3]} * xj2;
      X10 -= (f32x2){La5[0], La5[1]} * xj2;
      X11 -= (f32x2){La5[2], La5[3]} * xj2;
      X12 -= (f32x2){La6[0], La6[1]} * xj2;
      X13 -= (f32x2){La6[2], La6[3]} * xj2;
      X14 -= (f32x2){La7[0], La7[1]} * xj2;
      X15 -= (f32x2){La7[2], La7[3]} * xj2;
      X16 -= (f32x2){La8[0], La8[1]} * xj2;
      X17 -= (f32x2){La8[2], La8[3]} * xj2;
      X18 -= (f32x2){La9[0], La9[1]} * xj2;
      X19 -= (f32x2){La9[2], La9[3]} * xj2;
      X20 -= (f32x2){La10[0], La10[1]} * xj2;
      X21 -= (f32x2){La10[2], La10[3]} * xj2;
      X22 -= (f32x2){La11[0], La11[1]} * xj2;
      X23 -= (f32x2){La11[2], La11[3]} * xj2;
      X24 -= (f32x2){La12[0], La12[1]} * xj2;
      X25 -= (f32x2){La12[2], La12[3]} * xj2;
      X26 -= (f32x2){La13[0], La13[1]} * xj2;
      X27 -= (f32x2){La13[2], La13[3]} * xj2;
      X28 -= (f32x2){La14[0], La14[1]} * xj2;
      X29 -= (f32x2){La14[2], La14[3]} * xj2;
      X30 -= (f32x2){La15[0], La15[1]} * xj2;
      X31 -= (f32x2){La15[2], La15[3]} * xj2;
    }
    __builtin_amdgcn_sched_barrier(0);
    La3 = *(const f32x4*)(Lt_s + 828);
    La4 = *(const f32x4*)(Lt_s + 832);
    La5 = *(const f32x4*)(Lt_s + 836);
    La6 = *(const f32x4*)(Lt_s + 840);
    La7 = *(const f32x4*)(Lt_s + 844);
    La8 = *(const f32x4*)(Lt_s + 848);
    La9 = *(const f32x4*)(Lt_s + 852);
    La10 = *(const f32x4*)(Lt_s + 856);
    La11 = *(const f32x4*)(Lt_s + 860);
    La12 = *(const f32x4*)(Lt_s + 864);
    La13 = *(const f32x4*)(Lt_s + 868);
    La14 = *(const f32x4*)(Lt_s + 872);
    La15 = *(const f32x4*)(Lt_s + 876);
    __builtin_amdgcn_sched_barrier(0);
    { const float xj = X5[1]; const f32x2 xj2 = (f32x2){xj, xj};
      X6 -= (f32x2){Lb3[0], Lb3[1]} * xj2;
      X7 -= (f32x2){Lb3[2], Lb3[3]} * xj2;
      X8 -= (f32x2){Lb4[0], Lb4[1]} * xj2;
      X9 -= (f32x2){Lb4[2], Lb4[3]} * xj2;
      X10 -= (f32x2){Lb5[0], Lb5[1]} * xj2;
      X11 -= (f32x2){Lb5[2], Lb5[3]} * xj2;
      X12 -= (f32x2){Lb6[0], Lb6[1]} * xj2;
      X13 -= (f32x2){Lb6[2], Lb6[3]} * xj2;
      X14 -= (f32x2){Lb7[0], Lb7[1]} * xj2;
      X15 -= (f32x2){Lb7[2], Lb7[3]} * xj2;
      X16 -= (f32x2){Lb8[0], Lb8[1]} * xj2;
      X17 -= (f32x2){Lb8[2], Lb8[3]} * xj2;
      X18 -= (f32x2){Lb9[0], Lb9[1]} * xj2;
      X19 -= (f32x2){Lb9[2], Lb9[3]} * xj2;
      X20 -= (f32x2){Lb10[0], Lb10[1]} * xj2;
      X21 -= (f32x2){Lb10[2], Lb10[3]} * xj2;
      X22 -= (f32x2){Lb11[0], Lb11[1]} * xj2;
      X23 -= (f32x2){Lb11[2], Lb11[3]} * xj2;
      X24 -= (f32x2){Lb12[0], Lb12[1]} * xj2;
      X25 -= (f32x2){Lb12[2], Lb12[3]} * xj2;
      X26 -= (f32x2){Lb13[0], Lb13[1]} * xj2;
      X27 -= (f32x2){Lb13[2], Lb13[3]} * xj2;
      X28 -= (f32x2){Lb14[0], Lb14[1]} * xj2;
      X29 -= (f32x2){Lb14[2], Lb14[3]} * xj2;
      X30 -= (f32x2){Lb15[0], Lb15[1]} * xj2;
      X31 -= (f32x2){Lb15[2], Lb15[3]} * xj2;
    }
    __builtin_amdgcn_sched_barrier(0);
    Lb3 = *(const f32x4*)(Lt_s + 896);
    Lb4 = *(const f32x4*)(Lt_s + 900);
    Lb5 = *(const f32x4*)(Lt_s + 904);
    Lb6 = *(const f32x4*)(Lt_s + 908);
    Lb7 = *(const f32x4*)(Lt_s + 912);
    Lb8 = *(const f32x4*)(Lt_s + 916);
    Lb9 = *(const f32x4*)(Lt_s + 920);
    Lb10 = *(const f32x4*)(Lt_s + 924);
    Lb11 = *(const f32x4*)(Lt_s + 928);
    Lb12 = *(const f32x4*)(Lt_s + 932);
    Lb13 = *(const f32x4*)(Lt_s + 936);
    Lb14 = *(const f32x4*)(Lt_s + 940);
    Lb15 = *(const f32x4*)(Lt_s + 944);
    __builtin_amdgcn_sched_barrier(0);
    { const float xj = X6[0]; const f32x2 xj2 = (f32x2){xj, xj};
      X6 -= (f32x2){La3[0], La3[1]} * xj2;
      X7 -= (f32x2){La3[2], La3[3]} * xj2;
      X8 -= (f32x2){La4[0], La4[1]} * xj2;
      X9 -= (f32x2){La4[2], La4[3]} * xj2;
      X10 -= (f32x2){La5[0], La5[1]} * xj2;
      X11 -= (f32x2){La5[2], La5[3]} * xj2;
      X12 -= (f32x2){La6[0], La6[1]} * xj2;
      X13 -= (f32x2){La6[2], La6[3]} * xj2;
      X14 -= (f32x2){La7[0], La7[1]} * xj2;
      X15 -= (f32x2){La7[2], La7[3]} * xj2;
      X16 -= (f32x2){La8[0], La8[1]} * xj2;
      X17 -= (f32x2){La8[2], La8[3]} * xj2;
      X18 -= (f32x2){La9[0], La9[1]} * xj2;
      X19 -= (f32x2){La9[2], La9[3]} * xj2;
      X20 -= (f32x2){La10[0], La10[1]} * xj2;
      X21 -= (f32x2){La10[2], La10[3]} * xj2;
      X22 -= (f32x2){La11[0], La11[1]} * xj2;
      X23 -= (f32x2){La11[2], La11[3]} * xj2;
      X24 -= (f32x2){La12[0], La12[1]} * xj2;
      X25 -= (f32x2){La12[2], La12[3]} * xj2;
      X26 -= (f32x2){La13[0], La13[1]} * xj2;
      X27 -= (f32x2){La13[2], La13[3]} * xj2;
      X28 -= (f32x2){La14[0], La14[1]} * xj2;
      X29 -= (f32x2){La14[2], La14[3]} * xj2;
      X30 -= (f32x2){La15[0], La15[1]} * xj2;
      X31 -= (f32x2){La15[2], La15[3]} * xj2;
    }
    __builtin_amdgcn_sched_barrier(0);
    La3 = *(const f32x4*)(Lt_s + 964);
    La4 = *(const f32x4*)(Lt_s + 968);
    La5 = *(const f32x4*)(Lt_s + 972);
    La6 = *(const f32x4*)(Lt_s + 976);
    La7 = *(const f32x4*)(Lt_s + 980);
    La8 = *(const f32x4*)(Lt_s + 984);
    La9 = *(const f32x4*)(Lt_s + 988);
    La10 = *(const f32x4*)(Lt_s + 992);
    La11 = *(const f32x4*)(Lt_s + 996);
    La12 = *(const f32x4*)(Lt_s + 1000);
    La13 = *(const f32x4*)(Lt_s + 1004);
    La14 = *(const f32x4*)(Lt_s + 1008);
    La15 = *(const f32x4*)(Lt_s + 1012);
    __builtin_amdgcn_sched_barrier(0);
    { const float xj = X6[1]; const f32x2 xj2 = (f32x2){xj, xj};
      X7 -= (f32x2){Lb3[2], Lb3[3]} * xj2;
      X8 -= (f32x2){Lb4[0], Lb4[1]} * xj2;
      X9 -= (f32x2){Lb4[2], Lb4[3]} * xj2;
      X10 -= (f32x2){Lb5[0], Lb5[1]} * xj2;
      X11 -= (f32x2){Lb5[2], Lb5[3]} * xj2;
      X12 -= (f32x2){Lb6[0], Lb6[1]} * xj2;
      X13 -= (f32x2){Lb6[2], Lb6[3]} * xj2;
      X14 -= (f32x2){Lb7[0], Lb7[1]} * xj2;
      X15 -= (f32x2){Lb7[2], Lb7[3]} * xj2;
      X16 -= (f32x2){Lb8[0], Lb8[1]} * xj2;
      X17 -= (f32x2){Lb8[2], Lb8[3]} * xj2;
      X18 -= (f32x2){Lb9[0], Lb9[1]} * xj2;
      X19 -= (f32x2){Lb9[2], Lb9[3]} * xj2;
      X20 -= (f32x2){Lb10[0], Lb10[1]} * xj2;
      X21 -= (f32x2){Lb10[2], Lb10[3]} * xj2;
      X22 -= (f32x2){Lb11[0], Lb11[1]} * xj2;
      X23 -= (f32x2){Lb11[2], Lb11[3]} * xj2;
      X24 -= (f32x2){Lb12[0], Lb12[1]} * xj2;
      X25 -= (f32x2){Lb12[2], Lb12[3]} * xj2;
      X26 -= (f32x2){Lb13[0], Lb13[1]} * xj2;
      X27 -= (f32x2){Lb13[2], Lb13[3]} * xj2;
      X28 -= (f32x2){Lb14[0], Lb14[1]} * xj2;
      X29 -= (f32x2){Lb14[2], Lb14[3]} * xj2;
      X30 -= (f32x2){Lb15[0], Lb15[1]} * xj2;
      X31 -= (f32x2){Lb15[2], Lb15[3]} * xj2;
    }
    __builtin_amdgcn_sched_barrier(0);
    Lb4 = *(const f32x4*)(Lt_s + 1036);
    Lb5 = *(const f32x4*)(Lt_s + 1040);
    Lb6 = *(const f32x4*)(Lt_s + 1044);
    Lb7 = *(const f32x4*)(Lt_s + 1048);
    Lb8 = *(const f32x4*)(Lt_s + 1052);
    Lb9 = *(const f32x4*)(Lt_s + 1056);
    Lb10 = *(const f32x4*)(Lt_s + 1060);
    Lb11 = *(const f32x4*)(Lt_s + 1064);
    Lb12 = *(const f32x4*)(Lt_s + 1068);
    Lb13 = *(const f32x4*)(Lt_s + 1072);
    Lb14 = *(const f32x4*)(Lt_s + 1076);
    Lb15 = *(const f32x4*)(Lt_s + 1080);
    __builtin_amdgcn_sched_barrier(0);
    { const float xj = X7[0]; const f32x2 xj2 = (f32x2){xj, xj};
      X7 -= (f32x2){La3[2], La3[3]} * xj2;
      X8 -= (f32x2){La4[0], La4[1]} * xj2;
      X9 -= (f32x2){La4[2], La4[3]} * xj2;
      X10 -= (f32x2){La5[0], La5[1]} * xj2;
      X11 -= (f32x2){La5[2], La5[3]} * xj2;
      X12 -= (f32x2){La6[0], La6[1]} * xj2;
      X13 -= (f32x2){La6[2], La6[3]} * xj2;
      X14 -= (f32x2){La7[0], La7[1]} * xj2;
      X15 -= (f32x2){La7[2], La7[3]} * xj2;
      X16 -= (f32x2){La8[0], La8[1]} * xj2;
      X17 -= (f32x2){La8[2], La8[3]} * xj2;
      X18 -= (f32x2){La9[0], La9[1]} * xj2;
      X19 -= (f32x2){La9[2], La9[3]} * xj2;
      X20 -= (f32x2){La10[0], La10[1]} * xj2;
      X21 -= (f32x2){La10[2], La10[3]} * xj2;
      X22 -= (f32x2){La11[0], La11[1]} * xj2;
      X23 -= (f32x2){La11[2], La11[3]} * xj2;
      X24 -= (f32x2){La12[0], La12[1]} * xj2;
      X25 -= (f32x2){La12[2], La12[3]} * xj2;
      X26 -= (f32x2){La13[0], La13[1]} * xj2;
      X27 -= (f32x2){La13[2], La13[3]} * xj2;
      X28 -= (f32x2){La14[0], La14[1]} * xj2;
      X29 -= (f32x2){La14[2], La14[3]} * xj2;
      X30 -= (f32x2){La15[0], La15[1]} * xj2;
      X31 -= (f32x2){La15[2], La15[3]} * xj2;
    }
    __builtin_amdgcn_sched_barrier(0);
    La4 = *(const f32x4*)(Lt_s + 1104);
    La5 = *(const f32x4*)(Lt_s + 1108);
    La6 = *(const f32x4*)(Lt_s + 1112);
    La7 = *(const f32x4*)(Lt_s + 1116);
    La8 = *(const f32x4*)(Lt_s + 1120);
    La9 = *(const f32x4*)(Lt_s + 1124);
    La10 = *(const f32x4*)(Lt_s + 1128);
    La11 = *(const f32x4*)(Lt_s + 1132);
    La12 = *(const f32x4*)(Lt_s + 1136);
    La13 = *(const f32x4*)(Lt_s + 1140);
    La14 = *(const f32x4*)(Lt_s + 1144);
    La15 = *(const f32x4*)(Lt_s + 1148);
    __builtin_amdgcn_sched_barrier(0);
    { const float xj = X7[1]; const f32x2 xj2 = (f32x2){xj, xj};
      X8 -= (f32x2){Lb4[0], Lb4[1]} * xj2;
      X9 -= (f32x2){Lb4[2], Lb4[3]} * xj2;
      X10 -= (f32x2){Lb5[0], Lb5[1]} * xj2;
      X11 -= (f32x2){Lb5[2], Lb5[3]} * xj2;
      X12 -= (f32x2){Lb6[0], Lb6[1]} * xj2;
      X13 -= (f32x2){Lb6[2], Lb6[3]} * xj2;
      X14 -= (f32x2){Lb7[0], Lb7[1]} * xj2;
      X15 -= (f32x2){Lb7[2], Lb7[3]} * xj2;
      X16 -= (f32x2){Lb8[0], Lb8[1]} * xj2;
      X17 -= (f32x2){Lb8[2], Lb8[3]} * xj2;
      X18 -= (f32x2){Lb9[0], Lb9[1]} * xj2;
      X19 -= (f32x2){Lb9[2], Lb9[3]} * xj2;
      X20 -= (f32x2){Lb10[0], Lb10[1]} * xj2;
      X21 -= (f32x2){Lb10[2], Lb10[3]} * xj2;
      X22 -= (f32x2){Lb11[0], Lb11[1]} * xj2;
      X23 -= (f32x2){Lb11[2], Lb11[3]} * xj2;
      X24 -= (f32x2){Lb12[0], Lb12[1]} * xj2;
      X25 -= (f32x2){Lb12[2], Lb12[3]} * xj2;
      X26 -= (f32x2){Lb13[0], Lb13[1]} * xj2;
      X27 -= (f32x2){Lb13[2], Lb13[3]} * xj2;
      X28 -= (f32x2){Lb14[0], Lb14[1]} * xj2;
      X29 -= (f32x2){Lb14[2], Lb14[3]} * xj2;
      X30 -= (f32x2){Lb15[0], Lb15[1]} * xj2;
      X31 -= (f32x2){Lb15[2], Lb15[3]} * xj2;
    }
    __builtin_amdgcn_sched_barrier(0);
    Lb4 = *(const f32x4*)(Lt_s + 1172);
    Lb5 = *(const f32x4*)(Lt_s + 1176);
    Lb6 = *(const f32x4*)(Lt_s + 1180);
    Lb7 = *(const f32x4*)(Lt_s + 1184);
    Lb8 = *(const f32x4*)(Lt_s + 1188);
    Lb9 = *(const f32x4*)(Lt_s + 1192);
    Lb10 = *(const f32x4*)(Lt_s + 1196);
    Lb11 = *(const f32x4*)(Lt_s + 1200);
    Lb12 = *(const f32x4*)(Lt_s + 1204);
    Lb13 = *(const f32x4*)(Lt_s + 1208);
    Lb14 = *(const f32x4*)(Lt_s + 1212);
    Lb15 = *(const f32x4*)(Lt_s + 1216);
    __builtin_amdgcn_sched_barrier(0);
    { const float xj = X8[0]; const f32x2 xj2 = (f32x2){xj, xj};
      X8 -= (f32x2){La4[0], La4[1]} * xj2;
      X9 -= (f32x2){La4[2], La4[3]} * xj2;
      X10 -= (f32x2){La5[0], La5[1]} * xj2;
      X11 -= (f32x2){La5[2], La5[3]} * xj2;
      X12 -= (f32x2){La6[0], La6[1]} * xj2;
      X13 -= (f32x2){La6[2], La6[3]} * xj2;
      X14 -= (f32x2){La7[0], La7[1]} * xj2;
      X15 -= (f32x2){La7[2], La7[3]} * xj2;
      X16 -= (f32x2){La8[0], La8[1]} * xj2;
      X17 -= (f32x2){La8[2], La8[3]} * xj2;
      X18 -= (f32x2){La9[0], La9[1]} * xj2;
      X19 -= (f32x2){La9[2], La9[3]} * xj2;
      X20 -= (f32x2){La10[0], La10[1]} * xj2;
      X21 -= (f32x2){La10[2], La10[3]} * xj2;
      X22 -= (f32x2){La11[0], La11[1]} * xj2;
      X23 -= (f32x2){La11[2], La11[3]} * xj2;
      X24 -= (f32x2){La12[0], La12[1]} * xj2;
      X25 -= (f32x2){La12[2], La12[3]} * xj2;
      X26 -= (f32x2){La13[0], La13[1]} * xj2;
      X27 -= (f32x2){La13[2], La13[3]} * xj2;
      X28 -= (f32x2){La14[0], La14[1]} * xj2;
      X29 -= (f32x2){La14[2], La14[3]} * xj2;
      X30 -= (f32x2){La15[0], La15[1]} * xj2;
      X31 -= (f32x2){La15[2], La15[3]} * xj2;
    }
    __builtin_amdgcn_sched_barrier(0);
    La4 = *(const f32x4*)(Lt_s + 1240);
    La5 = *(const f32x4*)(Lt_s + 1244);
    La6 = *(const f32x4*)(Lt_s + 1248);
    La7 = *(const f32x4*)(Lt_s + 1252);
    La8 = *(const f32x4*)(Lt_s + 1256);
    La9 = *(const f32x4*)(Lt_s + 1260);
    La10 = *(const f32x4*)(Lt_s + 1264);
    La11 = *(const f32x4*)(Lt_s + 1268);
    La12 = *(const f32x4*)(Lt_s + 1272);
    La13 = *(const f32x4*)(Lt_s + 1276);
    La14 = *(const f32x4*)(Lt_s + 1280);
    La15 = *(const f32x4*)(Lt_s + 1284);
    __builtin_amdgcn_sched_barrier(0);
    { const float xj = X8[1]; const f32x2 xj2 = (f32x2){xj, xj};
      X9 -= (f32x2){Lb4[2], Lb4[3]} * xj2;
      X10 -= (f32x2){Lb5[0], Lb5[1]} * xj2;
      X11 -= (f32x2){Lb5[2], Lb5[3]} * xj2;
      X12 -= (f32x2){Lb6[0], Lb6[1]} * xj2;
      X13 -= (f32x2){Lb6[2], Lb6[3]} * xj2;
      X14 -= (f32x2){Lb7[0], Lb7[1]} * xj2;
      X15 -= (f32x2){Lb7[2], Lb7[3]} * xj2;
      X16 -= (f32x2){Lb8[0], Lb8[1]} * xj2;
      X17 -= (f32x2){Lb8[2], Lb8[3]} * xj2;
      X18 -= (f32x2){Lb9[0], Lb9[1]} * xj2;
      X19 -= (f32x2){Lb9[2], Lb9[3]} * xj2;
      X20 -= (f32x2){Lb10[0], Lb10[1]} * xj2;
      X21 -= (f32x2){Lb10[2], Lb10[3]} * xj2;
      X22 -= (f32x2){Lb11[0], Lb11[1]} * xj2;
      X23 -= (f32x2){Lb11[2], Lb11[3]} * xj2;
      X24 -= (f32x2){Lb12[0], Lb12[1]} * xj2;
      X25 -= (f32x2){Lb12[2], Lb12[3]} * xj2;
      X26 -= (f32x2){Lb13[0], Lb13[1]} * xj2;
      X27 -= (f32x2){Lb13[2], Lb13[3]} * xj2;
      X28 -= (f32x2){Lb14[0], Lb14[1]} * xj2;
      X29 -= (f32x2){Lb14[2], Lb14[3]} * xj2;
      X30 -= (f32x2){Lb15[0], Lb15[1]} * xj2;
      X31 -= (f32x2){Lb15[2], Lb15[3]} * xj2;
    }
    __builtin_amdgcn_sched_barrier(0);
    Lb5 = *(const f32x4*)(Lt_s + 1312);
    Lb6 = *(const f32x4*)(Lt_s + 1316);
    Lb7 = *(const f32x4*)(Lt_s + 1320);
    Lb8 = *(const f32x4*)(Lt_s + 1324);
    Lb9 = *(const f32x4*)(Lt_s + 1328);
    Lb10 = *(const f32x4*)(Lt_s + 1332);
    Lb11 = *(const f32x4*)(Lt_s + 1336);
    Lb12 = *(const f32x4*)(Lt_s + 1340);
    Lb13 = *(const f32x4*)(Lt_s + 1344);
    Lb14 = *(const f32x4*)(Lt_s + 1348);
    Lb15 = *(const f32x4*)(Lt_s + 1352);
    __builtin_amdgcn_sched_barrier(0);
    { const float xj = X9[0]; const f32x2 xj2 = (f32x2){xj, xj};
      X9 -= (f32x2){La4[2], La4[3]} * xj2;
      X10 -= (f32x2){La5[0], La5[1]} * xj2;
      X11 -= (f32x2){La5[2], La5[3]} * xj2;
      X12 -= (f32x2){La6[0], La6[1]} * xj2;
      X13 -= (f32x2){La6[2], La6[3]} * xj2;
      X14 -= (f32x2){La7[0], La7[1]} * xj2;
      X15 -= (f32x2){La7[2], La7[3]} * xj2;
      X16 -= (f32x2){La8[0], La8[1]} * xj2;
      X17 -= (f32x2){La8[2], La8[3]} * xj2;
      X18 -= (f32x2){La9[0], La9[1]} * xj2;
      X19 -= (f32x2){La9[2], La9[3]} * xj2;
      X20 -= (f32x2){La10[0], La10[1]} * xj2;
      X21 -= (f32x2){La10[2], La10[3]} * xj2;
      X22 -= (f32x2){La11[0], La11[1]} * xj2;
      X23 -= (f32x2){La11[2], La11[3]} * xj2;
      X24 -= (f32x2){La12[0], La12[1]} * xj2;
      X25 -= (f32x2){La12[2], La12[3]} * xj2;
      X26 -= (f32x2){La13[0], La13[1]} * xj2;
      X27 -= (f32x2){La13[2], La13[3]} * xj2;
      X28 -= (f32x2){La14[0], La14[1]} * xj2;
      X29 -= (f32x2){La14[2], La14[3]} * xj2;
      X30 -= (f32x2){La15[0], La15[1]} * xj2;
      X31 -= (f32x2){La15[2], La15[3]} * xj2;
    }
    __builtin_amdgcn_sched_barrier(0);
    La5 = *(const f32x4*)(Lt_s + 1380);
    La6 = *(const f32x4*)(Lt_s + 1384);
    La7 = *(const f32x4*)(Lt_s + 1388);
    La8 = *(const f32x4*)(Lt_s + 1392);
    La9 = *(const f32x4*)(Lt_s + 1396);
    La10 = *(const f32x4*)(Lt_s + 1400);
    La11 = *(const f32x4*)(Lt_s + 1404);
    La12 = *(const f32x4*)(Lt_s + 1408);
    La13 = *(const f32x4*)(Lt_s + 1412);
    La14 = *(const f32x4*)(Lt_s + 1416);
    La15 = *(const f32x4*)(Lt_s + 1420);
    __builtin_amdgcn_sched_barrier(0);
    { const float xj = X9[1]; const f32x2 xj2 = (f32x2){xj, xj};
      X10 -= (f32x2){Lb5[0], Lb5[1]} * xj2;
      X11 -= (f32x2){Lb5[2], Lb5[3]} * xj2;
      X12 -= (f32x2){Lb6[0], Lb6[1]} * xj2;
      X13 -= (f32x2){Lb6[2], Lb6[3]} * xj2;
      X14 -= (f32x2){Lb7[0], Lb7[1]} * xj2;
      X15 -= (f32x2){Lb7[2], Lb7[3]} * xj2;
      X16 -= (f32x2){Lb8[0], Lb8[1]} * xj2;
      X17 -= (f32x2){Lb8[2], Lb8[3]} * xj2;
      X18 -= (f32x2){Lb9[0], Lb9[1]} * xj2;
      X19 -= (f32x2){Lb9[2], Lb9[3]} * xj2;
      X20 -= (f32x2){Lb10[0], Lb10[1]} * xj2;
      X21 -= (f32x2){Lb10[2], Lb10[3]} * xj2;
      X22 -= (f32x2){Lb11[0], Lb11[1]} * xj2;
      X23 -= (f32x2){Lb11[2], Lb11[3]} * xj2;
      X24 -= (f32x2){Lb12[0], Lb12[1]} * xj2;
      X25 -= (f32x2){Lb12[2], Lb12[3]} * xj2;
      X26 -= (f32x2){Lb13[0], Lb13[1]} * xj2;
      X27 -= (f32x2){Lb13[2], Lb13[3]} * xj2;
      X28 -= (f32x2){Lb14[0], Lb14[1]} * xj2;
      X29 -= (f32x2){Lb14[2], Lb14[3]} * xj2;
      X30 -= (f32x2){Lb15[0], Lb15[1]} * xj2;
      X31 -= (f32x2){Lb15[2], Lb15[3]} * xj2;
    }
    __builtin_amdgcn_sched_barrier(0);
    Lb5 = *(const f32x4*)(Lt_s + 1448);
    Lb6 = *(const f32x4*)(Lt_s + 1452);
    Lb7 = *(const f32x4*)(Lt_s + 1456);
    Lb8 = *(const f32x4*)(Lt_s + 1460);
    Lb9 = *(const f32x4*)(Lt_s + 1464);
    Lb10 = *(const f32x4*)(Lt_s + 1468);
    Lb11 = *(const f32x4*)(Lt_s + 1472);
    Lb12 = *(const f32x4*)(Lt_s + 1476);
    Lb13 = *(const f32x4*)(Lt_s + 1480);
    Lb14 = *(const f32x4*)(Lt_s + 1484);
    Lb15 = *(const f32x4*)(Lt_s + 1488);
    __builtin_amdgcn_sched_barrier(0);
    { const float xj = X10[0]; const f32x2 xj2 = (f32x2){xj, xj};
      X10 -= (f32x2){La5[0], La5[1]} * xj2;
      X11 -= (f32x2){La5[2], La5[3]} * xj2;
      X12 -= (f32x2){La6[0], La6[1]} * xj2;
      X13 -= (f32x2){La6[2], La6[3]} * xj2;
      X14 -= (f32x2){La7[0], La7[1]} * xj2;
      X15 -= (f32x2){La7[2], La7[3]} * xj2;
      X16 -= (f32x2){La8[0], La8[1]} * xj2;
      X17 -= (f32x2){La8[2], La8[3]} * xj2;
      X18 -= (f32x2){La9[0], La9[1]} * xj2;
      X19 -= (f32x2){La9[2], La9[3]} * xj2;
      X20 -= (f32x2){La10[0], La10[1]} * xj2;
      X21 -= (f32x2){La10[2], La10[3]} * xj2;
      X22 -= (f32x2){La11[0], La11[1]} * xj2;
      X23 -= (f32x2){La11[2], La11[3]} * xj2;
      X24 -= (f32x2){La12[0], La12[1]} * xj2;
      X25 -= (f32x2){La12[2], La12[3]} * xj2;
      X26 -= (f32x2){La13[0], La13[1]} * xj2;
      X27 -= (f32x2){La13[2], La13[3]} * xj2;
      X28 -= (f32x2){La14[0], La14[1]} * xj2;
      X29 -= (f32x2){La14[2], La14[3]} * xj2;
      X30 -= (f32x2){La15[0], La15[1]} * xj2;
      X31 -= (f32x2){La15[2], La15[3]} * xj2;
    }
    __builtin_amdgcn_sched_barrier(0);
    La5 = *(const f32x4*)(Lt_s + 1516);
    La6 = *(const f32x4*)(Lt_s + 1520);
    La7 = *(const f32x4*)(Lt_s + 1524);
    La8 = *(const f32x4*)(Lt_s + 1528);
    La9 = *(const f32x4*)(Lt_s + 1532);
    La10 = *(const f32x4*)(Lt_s + 1536);
    La11 = *(const f32x4*)(Lt_s + 1540);
    La12 = *(const f32x4*)(Lt_s + 1544);
    La13 = *(const f32x4*)(Lt_s + 1548);
    La14 = *(const f32x4*)(Lt_s + 1552);
    La15 = *(const f32x4*)(Lt_s + 1556);
    __builtin_amdgcn_sched_barrier(0);
    { const float xj = X10[1]; const f32x2 xj2 = (f32x2){xj, xj};
      X11 -= (f32x2){Lb5[2], Lb5[3]} * xj2;
      X12 -= (f32x2){Lb6[0], Lb6[1]} * xj2;
      X13 -= (f32x2){Lb6[2], Lb6[3]} * xj2;
      X14 -= (f32x2){Lb7[0], Lb7[1]} * xj2;
      X15 -= (f32x2){Lb7[2], Lb7[3]} * xj2;
      X16 -= (f32x2){Lb8[0], Lb8[1]} * xj2;
      X17 -= (f32x2){Lb8[2], Lb8[3]} * xj2;
      X18 -= (f32x2){Lb9[0], Lb9[1]} * xj2;
      X19 -= (f32x2){Lb9[2], Lb9[3]} * xj2;
      X20 -= (f32x2){Lb10[0], Lb10[1]} * xj2;
      X21 -= (f32x2){Lb10[2], Lb10[3]} * xj2;
      X22 -= (f32x2){Lb11[0], Lb11[1]} * xj2;
      X23 -= (f32x2){Lb11[2], Lb11[3]} * xj2;
      X24 -= (f32x2){Lb12[0], Lb12[1]} * xj2;
      X25 -= (f32x2){Lb12[2], Lb12[3]} * xj2;
      X26 -= (f32x2){Lb13[0], Lb13[1]} * xj2;
      X27 -= (f32x2){Lb13[2], Lb13[3]} * xj2;
      X28 -= (f32x2){Lb14[0], Lb14[1]} * xj2;
      X29 -= (f32x2){Lb14[2], Lb14[3]} * xj2;
      X30 -= (f32x2){Lb15[0], Lb15[1]} * xj2;
      X31 -= (f32x2){Lb15[2], Lb15[3]} * xj2;
    }
    __builtin_amdgcn_sched_barrier(0);
    Lb6 = *(const f32x4*)(Lt_s + 1588);
    Lb7 = *(const f32x4*)(Lt_s + 1592);
    Lb8 = *(const f32x4*)(Lt_s + 1596);
    Lb9 = *(const f32x4*)(Lt_s + 1600);
    Lb10 = *(const f32x4*)(Lt_s + 1604);
    Lb11 = *(const f32x4*)(Lt_s + 1608);
    Lb12 = *(const f32x4*)(Lt_s + 1612);
    Lb13 = *(const f32x4*)(Lt_s + 1616);
    Lb14 = *(const f32x4*)(Lt_s + 1620);
    Lb15 = *(const f32x4*)(Lt_s + 1624);
    __builtin_amdgcn_sched_barrier(0);
    { const float xj = X11[0]; const f32x2 xj2 = (f32x2){xj, xj};
      X11 -= (f32x2){La5[2], La5[3]} * xj2;
      X12 -= (f32x2){La6[0], La6[1]} * xj2;
      X13 -= (f32x2){La6[2], La6[3]} * xj2;
      X14 -= (f32x2){La7[0], La7[1]} * xj2;
      X15 -= (f32x2){La7[2], La7[3]} * xj2;
      X16 -= (f32x2){La8[0], La8[1]} * xj2;
      X17 -= (f32x2){La8[2], La8[3]} * xj2;
      X18 -= (f32x2){La9[0], La9[1]} * xj2;
      X19 -= (f32x2){La9[2], La9[3]} * xj2;
      X20 -= (f32x2){La10[0], La10[1]} * xj2;
      X21 -= (f32x2){La10[2], La10[3]} * xj2;
      X22 -= (f32x2){La11[0], La11[1]} * xj2;
      X23 -= (f32x2){La11[2], La11[3]} * xj2;
      X24 -= (f32x2){La12[0], La12[1]} * xj2;
      X25 -= (f32x2){La12[2], La12[3]} * xj2;
      X26 -= (f32x2){La13[0], La13[1]} * xj2;
      X27 -= (f32x2){La13[2], La13[3]} * xj2;
      X28 -= (f32x2){La14[0], La14[1]} * xj2;
      X29 -= (f32x2){La14[2], La14[3]} * xj2;
      X30 -= (f32x2){La15[0], La15[1]} * xj2;
      X31 -= (f32x2){La15[2], La15[3]} * xj2;
    }
    __builtin_amdgcn_sched_barrier(0);
    La6 = *(const f32x4*)(Lt_s + 1656);
    La7 = *(const f32x4*)(Lt_s + 1660);
    La8 = *(const f32x4*)(Lt_s + 1664);
    La9 = *(const f32x4*)(Lt_s + 1668);
    La10 = *(const f32x4*)(Lt_s + 1672);
    La11 = *(const f32x4*)(Lt_s + 1676);
    La12 = *(const f32x4*)(Lt_s + 1680);
    La13 = *(const f32x4*)(Lt_s + 1684);
    La14 = *(const f32x4*)(Lt_s + 1688);
    La15 = *(const f32x4*)(Lt_s + 1692);
    __builtin_amdgcn_sched_barrier(0);
    { const float xj = X11[1]; const f32x2 xj2 = (f32x2){xj, xj};
      X12 -= (f32x2){Lb6[0], Lb6[1]} * xj2;
      X13 -= (f32x2){Lb6[2], Lb6[3]} * xj2;
      X14 -= (f32x2){Lb7[0], Lb7[1]} * xj2;
      X15 -= (f32x2){Lb7[2], Lb7[3]} * xj2;
      X16 -= (f32x2){Lb8[0], Lb8[1]} * xj2;
      X17 -= (f32x2){Lb8[2], Lb8[3]} * xj2;
      X18 -= (f32x2){Lb9[0], Lb9[1]} * xj2;
      X19 -= (f32x2){Lb9[2], Lb9[3]} * xj2;
      X20 -= (f32x2){Lb10[0], Lb10[1]} * xj2;
      X21 -= (f32x2){Lb10[2], Lb10[3]} * xj2;
      X22 -= (f32x2){Lb11[0], Lb11[1]} * xj2;
      X23 -= (f32x2){Lb11[2], Lb11[3]} * xj2;
      X24 -= (f32x2){Lb12[0], Lb12[1]} * xj2;
      X25 -= (f32x2){Lb12[2], Lb12[3]} * xj2;
      X26 -= (f32x2){Lb13[0], Lb13[1]} * xj2;
      X27 -= (f32x2){Lb13[2], Lb13[3]} * xj2;
      X28 -= (f32x2){Lb14[0], Lb14[1]} * xj2;
      X29 -= (f32x2){Lb14[2], Lb14[3]} * xj2;
      X30 -= (f32x2){Lb15[0], Lb15[1]} * xj2;
      X31 -= (f32x2){Lb15[2], Lb15[3]} * xj2;
    }
    __builtin_amdgcn_sched_barrier(0);
    Lb6 = *(const f32x4*)(Lt_s + 1724);
    Lb7 = *(const f32x4*)(Lt_s + 1728);
    Lb8 = *(const f32x4*)(Lt_s + 1732);
    Lb9 = *(const f32x4*)(Lt_s + 1736);
    Lb10 = *(const f32x4*)(Lt_s + 1740);
    Lb11 = *(const f32x4*)(Lt_s + 1744);
    Lb12 = *(const f32x4*)(Lt_s + 1748);
    Lb13 = *(const f32x4*)(Lt_s + 1752);
    Lb14 = *(const f32x4*)(Lt_s + 1756);
    Lb15 = *(const f32x4*)(Lt_s + 1760);
    __builtin_amdgcn_sched_barrier(0);
    { const float xj = X12[0]; const f32x2 xj2 = (f32x2){xj, xj};
      X12 -= (f32x2){La6[0], La6[1]} * xj2;
      X13 -= (f32x2){La6[2], La6[3]} * xj2;
      X14 -= (f32x2){La7[0], La7[1]} * xj2;
      X15 -= (f32x2){La7[2], La7[3]} * xj2;
      X16 -= (f32x2){La8[0], La8[1]} * xj2;
      X17 -= (f32x2){La8[2], La8[3]} * xj2;
      X18 -= (f32x2){La9[0], La9[1]} * xj2;
      X19 -= (f32x2){La9[2], La9[3]} * xj2;
      X20 -= (f32x2){La10[0], La10[1]} * xj2;
      X21 -= (f32x2){La10[2], La10[3]} * xj2;
      X22 -= (f32x2){La11[0], La11[1]} * xj2;
      X23 -= (f32x2){La11[2], La11[3]} * xj2;
      X24 -= (f32x2){La12[0], La12[1]} * xj2;
      X25 -= (f32x2){La12[2], La12[3]} * xj2;
      X26 -= (f32x2){La13[0], La13[1]} * xj2;
      X27 -= (f32x2){La13[2], La13[3]} * xj2;
      X28 -= (f32x2){La14[0], La14[1]} * xj2;
      X29 -= (f32x2){La14[2], La14[3]} * xj2;
      X30 -= (f32x2){La15[0], La15[1]} * xj2;
      X31 -= (f32x2){La15[2], La15[3]} * xj2;
    }
    __builtin_amdgcn_sched_barrier(0);
    La6 = *(const f32x4*)(Lt_s + 1792);
    La7 = *(const f32x4*)(Lt_s + 1796);
    La8 = *(const f32x4*)(Lt_s + 1800);
    La9 = *(const f32x4*)(Lt_s + 1804);
    La10 = *(const f32x4*)(Lt_s + 1808);
    La11 = *(const f32x4*)(Lt_s + 1812);
    La12 = *(const f32x4*)(Lt_s + 1816);
    La13 = *(const f32x4*)(Lt_s + 1820);
    La14 = *(const f32x4*)(Lt_s + 1824);
    La15 = *(const f32x4*)(Lt_s + 1828);
    __builtin_amdgcn_sched_barrier(0);
    { const float xj = X12[1]; const f32x2 xj2 = (f32x2){xj, xj};
      X13 -= (f32x2){Lb6[2], Lb6[3]} * xj2;
      X14 -= (f32x2){Lb7[0], Lb7[1]} * xj2;
      X15 -= (f32x2){Lb7[2], Lb7[3]} * xj2;
      X16 -= (f32x2){Lb8[0], Lb8[1]} * xj2;
      X17 -= (f32x2){Lb8[2], Lb8[3]} * xj2;
      X18 -= (f32x2){Lb9[0], Lb9[1]} * xj2;
      X19 -= (f32x2){Lb9[2], Lb9[3]} * xj2;
      X20 -= (f32x2){Lb10[0], Lb10[1]} * xj2;
      X21 -= (f32x2){Lb10[2], Lb10[3]} * xj2;
      X22 -= (f32x2){Lb11[0], Lb11[1]} * xj2;
      X23 -= (f32x2){Lb11[2], Lb11[3]} * xj2;
      X24 -= (f32x2){Lb12[0], Lb12[1]} * xj2;
      X25 -= (f32x2){Lb12[2], Lb12[3]} * xj2;
      X26 -= (f32x2){Lb13[0], Lb13[1]} * xj2;
      X27 -= (f32x2){Lb13[2], Lb13[3]} * xj2;
      X28 -= (f32x2){Lb14[0], Lb14[1]} * xj2;
      X29 -= (f32x2){Lb14[2], Lb14[3]} * xj2;
      X30 -= (f32x2){Lb15[0], Lb15[1]} * xj2;
      X31 -= (f32x2){Lb15[2], Lb15[3]} * xj2;
    }
    __builtin_amdgcn_sched_barrier(0);
    Lb7 = *(const f32x4*)(Lt_s + 1864);
    Lb8 = *(const f32x4*)(Lt_s + 1868);
    Lb9 = *(const f32x4*)(Lt_s + 1872);
    Lb10 = *(const f32x4*)(Lt_s + 1876);
    Lb11 = *(const f32x4*)(Lt_s + 1880);
    Lb12 = *(const f32x4*)(Lt_s + 1884);
    Lb13 = *(const f32x4*)(Lt_s + 1888);
    Lb14 = *(const f32x4*)(Lt_s + 1892);
    Lb15 = *(const f32x4*)(Lt_s + 1896);
    __builtin_amdgcn_sched_barrier(0);
    { const float xj = X13[0]; const f32x2 xj2 = (f32x2){xj, xj};
      X13 -= (f32x2){La6[2], La6[3]} * xj2;
      X14 -= (f32x2){La7[0], La7[1]} * xj2;
      X15 -= (f32x2){La7[2], La7[3]} * xj2;
      X16 -= (f32x2){La8[0], La8[1]} * xj2;
      X17 -= (f32x2){La8[2], La8[3]} * xj2;
      X18 -= (f32x2){La9[0], La9[1]} * xj2;
      X19 -= (f32x2){La9[2], La9[3]} * xj2;
      X20 -= (f32x2){La10[0], La10[1]} * xj2;
      X21 -= (f32x2){La10[2], La10[3]} * xj2;
      X22 -= (f32x2){La11[0], La11[1]} * xj2;
      X23 -= (f32x2){La11[2], La11[3]} * xj2;
      X24 -= (f32x2){La12[0], La12[1]} * xj2;
      X25 -= (f32x2){La12[2], La12[3]} * xj2;
      X26 -= (f32x2){La13[0], La13[1]} * xj2;
      X27 -= (f32x2){La13[2], La13[3]} * xj2;
      X28 -= (f32x2){La14[0], La14[1]} * xj2;
      X29 -= (f32x2){La14[2], La14[3]} * xj2;
      X30 -= (f32x2){La15[0], La15[1]} * xj2;
      X31 -= (f32x2){La15[2], La15[3]} * xj2;
    }
    __builtin_amdgcn_sched_barrier(0);
    La7 = *(const f32x4*)(Lt_s + 1932);
    La8 = *(const f32x4*)(Lt_s + 1936);
    La9 = *(const f32x4*)(Lt_s + 1940);
    La10 = *(const f32x4*)(Lt_s + 1944);
    La11 = *(const f32x4*)(Lt_s + 1948);
    La12 = *(const f32x4*)(Lt_s + 1952);
    La13 = *(const f32x4*)(Lt_s + 1956);
    La14 = *(const f32x4*)(Lt_s + 1960);
    La15 = *(const f32x4*)(Lt_s + 1964);
    __builtin_amdgcn_sched_barrier(0);
    { const float xj = X13[1]; const f32x2 xj2 = (f32x2){xj, xj};
      X14 -= (f32x2){Lb7[0], Lb7[1]} * xj2;
      X15 -= (f32x2){Lb7[2], Lb7[3]} * xj2;
      X16 -= (f32x2){Lb8[0], Lb8[1]} * xj2;
      X17 -= (f32x2){Lb8[2], Lb8[3]} * xj2;
      X18 -= (f32x2){Lb9[0], Lb9[1]} * xj2;
      X19 -= (f32x2){Lb9[2], Lb9[3]} * xj2;
      X20 -= (f32x2){Lb10[0], Lb10[1]} * xj2;
      X21 -= (f32x2){Lb10[2], Lb10[3]} * xj2;
      X22 -= (f32x2){Lb11[0], Lb11[1]} * xj2;
      X23 -= (f32x2){Lb11[2], Lb11[3]} * xj2;
      X24 -= (f32x2){Lb12[0], Lb12[1]} * xj2;
      X25 -= (f32x2){Lb12[2], Lb12[3]} * xj2;
      X26 -= (f32x2){Lb13[0], Lb13[1]} * xj2;
      X27 -= (f32x2){Lb13[2], Lb13[3]} * xj2;
      X28 -= (f32x2){Lb14[0], Lb14[1]} * xj2;
      X29 -= (f32x2){Lb14[2], Lb14[3]} * xj2;
      X30 -= (f32x2){Lb15[0], Lb15[1]} * xj2;
      X31 -= (f32x2){Lb15[2], Lb15[3]} * xj2;
    }
    __builtin_amdgcn_sched_barrier(0);
    Lb7 = *(const f32x4*)(Lt_s + 2000);
    Lb8 = *(const f32x4*)(Lt_s + 2004);
    Lb9 = *(const f32x4*)(Lt_s + 2008);
    Lb10 = *(const f32x4*)(Lt_s + 2012);
    Lb11 = *(const f32x4*)(Lt_s + 2016);
    Lb12 = *(const f32x4*)(Lt_s + 2020);
    Lb13 = *(const f32x4*)(Lt_s + 2024);
    Lb14 = *(const f32x4*)(Lt_s + 2028);
    Lb15 = *(const f32x4*)(Lt_s + 2032);
    __builtin_amdgcn_sched_barrier(0);
    { const float xj = X14[0]; const f32x2 xj2 = (f32x2){xj, xj};
      X14 -= (f32x2){La7[0], La7[1]} * xj2;
      X15 -= (f32x2){La7[2], La7[3]} * xj2;
      X16 -= (f32x2){La8[0], La8[1]} * xj2;
      X17 -= (f32x2){La8[2], La8[3]} * xj2;
      X18 -= (f32x2){La9[0], La9[1]} * xj2;
      X19 -= (f32x2){La9[2], La9[3]} * xj2;
      X20 -= (f32x2){La10[0], La10[1]} * xj2;
      X21 -= (f32x2){La10[2], La10[3]} * xj2;
      X22 -= (f32x2){La11[0], La11[1]} * xj2;
      X23 -= (f32x2){La11[2], La11[3]} * xj2;
      X24 -= (f32x2){La12[0], La12[1]} * xj2;
      X25 -= (f32x2){La12[2], La12[3]} * xj2;
      X26 -= (f32x2){La13[0], La13[1]} * xj2;
      X27 -= (f32x2){La13[2], La13[3]} * xj2;
      X28 -= (f32x2){La14[0], La14[1]} * xj2;
      X29 -= (f32x2){La14[2], La14[3]} * xj2;
      X30 -= (f32x2){La15[0], La15[1]} * xj2;
      X31 -= (f32x2){La15[2], La15[3]} * xj2;
    }
    __builtin_amdgcn_sched_barrier(0);
    La7 = *(const f32x4*)(Lt_s + 2068);
    La8 = *(const f32x4*)(Lt_s + 2072);
    La9 = *(const f32x4*)(Lt_s + 2076);
    La10 = *(const f32x4*)(Lt_s + 2080);
    La11 = *(const f32x4*)(Lt_s + 2084);
    La12 = *(const f32x4*)(Lt_s + 2088);
    La13 = *(const f32x4*)(Lt_s + 2092);
    La14 = *(const f32x4*)(Lt_s + 2096);
    La15 = *(const f32x4*)(Lt_s + 2100);
    __builtin_amdgcn_sched_barrier(0);
    { const float xj = X14[1]; const f32x2 xj2 = (f32x2){xj, xj};
      X15 -= (f32x2){Lb7[2], Lb7[3]} * xj2;
      X16 -= (f32x2){Lb8[0], Lb8[1]} * xj2;
      X17 -= (f32x2){Lb8[2], Lb8[3]} * xj2;
      X18 -= (f32x2){Lb9[0], Lb9[1]} * xj2;
      X19 -= (f32x2){Lb9[2], Lb9[3]} * xj2;
      X20 -= (f32x2){Lb10[0], Lb10[1]} * xj2;
      X21 -= (f32x2){Lb10[2], Lb10[3]} * xj2;
      X22 -= (f32x2){Lb11[0], Lb11[1]} * xj2;
      X23 -= (f32x2){Lb11[2], Lb11[3]} * xj2;
      X24 -= (f32x2){Lb12[0], Lb12[1]} * xj2;
      X25 -= (f32x2){Lb12[2], Lb12[3]} * xj2;
      X26 -= (f32x2){Lb13[0], Lb13[1]} * xj2;
      X27 -= (f32x2){Lb13[2], Lb13[3]} * xj2;
      X28 -= (f32x2){Lb14[0], Lb14[1]} * xj2;
      X29 -= (f32x2){Lb14[2], Lb14[3]} * xj2;
      X30 -= (f32x2){Lb15[0], Lb15[1]} * xj2;
      X31 -= (f32x2){Lb15[2], Lb15[3]} * xj2;
    }
    __builtin_amdgcn_sched_barrier(0);
    Lb8 = *(const f32x4*)(Lt_s + 2140);
    Lb9 = *(const f32x4*)(Lt_s + 2144);
    Lb10 = *(const f32x4*)(Lt_s + 2148);
    Lb11 = *(const f32x4*)(Lt_s + 2152);
    Lb12 = *(const f32x4*)(Lt_s + 2156);
    Lb13 = *(const f32x4*)(Lt_s + 2160);
    Lb14 = *(const f32x4*)(Lt_s + 2164);
    Lb15 = *(const f32x4*)(Lt_s + 2168);
    __builtin_amdgcn_sched_barrier(0);
    { const float xj = X15[0]; const f32x2 xj2 = (f32x2){xj, xj};
      X15 -= (f32x2){La7[2], La7[3]} * xj2;
      X16 -= (f32x2){La8[0], La8[1]} * xj2;
      X17 -= (f32x2){La8[2], La8[3]} * xj2;
      X18 -= (f32x2){La9[0], La9[1]} * xj2;
      X19 -= (f32x2){La9[2], La9[3]} * xj2;
      X20 -= (f32x2){La10[0], La10[1]} * xj2;
      X21 -= (f32x2){La10[2], La10[3]} * xj2;
      X22 -= (f32x2){La11[0], La11[1]} * xj2;
      X23 -= (f32x2){La11[2], La11[3]} * xj2;
      X24 -= (f32x2){La12[0], La12[1]} * xj2;
      X25 -= (f32x2){La12[2], La12[3]} * xj2;
      X26 -= (f32x2){La13[0], La13[1]} * xj2;
      X27 -= (f32x2){La13[2], La13[3]} * xj2;
      X28 -= (f32x2){La14[0], La14[1]} * xj2;
      X29 -= (f32x2){La14[2], La14[3]} * xj2;
      X30 -= (f32x2){La15[0], La15[1]} * xj2;
      X31 -= (f32x2){La15[2], La15[3]} * xj2;
    }
    __builtin_amdgcn_sched_barrier(0);
    La8 = *(const f32x4*)(Lt_s + 2208);
    La9 = *(const f32x4*)(Lt_s + 2212);
    La10 = *(const f32x4*)(Lt_s + 2216);
    La11 = *(const f32x4*)(Lt_s + 2220);
    La12 = *(const f32x4*)(Lt_s + 2224);
    La13 = *(const f32x4*)(Lt_s + 2228);
    La14 = *(const f32x4*)(Lt_s + 2232);
    La15 = *(const f32x4*)(Lt_s + 2236);
    __builtin_amdgcn_sched_barrier(0);
    { const float xj = X15[1]; const f32x2 xj2 = (f32x2){xj, xj};
      X16 -= (f32x2){Lb8[0], Lb8[1]} * xj2;
      X17 -= (f32x2){Lb8[2], Lb8[3]} * xj2;
      X18 -= (f32x2){Lb9[0], Lb9[1]} * xj2;
      X19 -= (f32x2){Lb9[2], Lb9[3]} * xj2;
      X20 -= (f32x2){Lb10[0], Lb10[1]} * xj2;
      X21 -= (f32x2){Lb10[2], Lb10[3]} * xj2;
      X22 -= (f32x2){Lb11[0], Lb11[1]} * xj2;
      X23 -= (f32x2){Lb11[2], Lb11[3]} * xj2;
      X24 -= (f32x2){Lb12[0], Lb12[1]} * xj2;
      X25 -= (f32x2){Lb12[2], Lb12[3]} * xj2;
      X26 -= (f32x2){Lb13[0], Lb13[1]} * xj2;
      X27 -= (f32x2){Lb13[2], Lb13[3]} * xj2;
      X28 -= (f32x2){Lb14[0], Lb14[1]} * xj2;
      X29 -= (f32x2){Lb14[2], Lb14[3]} * xj2;
      X30 -= (f32x2){Lb15[0], Lb15[1]} * xj2;
      X31 -= (f32x2){Lb15[2], Lb15[3]} * xj2;
    }
    __builtin_amdgcn_sched_barrier(0);
    Lb8 = *(const f32x4*)(Lt_s + 2276);
    Lb9 = *(const f32x4*)(Lt_s + 2280);
    Lb10 = *(const f32x4*)(Lt_s + 2284);
    Lb11 = *(const f32x4*)(Lt_s + 2288);
    Lb12 = *(const f32x4*)(Lt_s + 2292);
    Lb13 = *(const f32x4*)(Lt_s + 2296);
    Lb14 = *(const f32x4*)(Lt_s + 2300);
    Lb15 = *(const f32x4*)(Lt_s + 2304);
    __builtin_amdgcn_sched_barrier(0);
    { const float xj = X16[0]; const f32x2 xj2 = (f32x2){xj, xj};
      X16 -= (f32x2){La8[0], La8[1]} * xj2;
      X17 -= (f32x2){La8[2], La8[3]} * xj2;
      X18 -= (f32x2){La9[0], La9[1]} * xj2;
      X19 -= (f32x2){La9[2], La9[3]} * xj2;
      X20 -= (f32x2){La10[0], La10[1]} * xj2;
      X21 -= (f32x2){La10[2], La10[3]} * xj2;
      X22 -= (f32x2){La11[0], La11[1]} * xj2;
      X23 -= (f32x2){La11[2], La11[3]} * xj2;
      X24 -= (f32x2){La12[0], La12[1]} * xj2;
      X25 -= (f32x2){La12[2], La12[3]} * xj2;
      X26 -= (f32x2){La13[0], La13[1]} * xj2;
      X27 -= (f32x2){La13[2], La13[3]} * xj2;
      X28 -= (f32x2){La14[0], La14[1]} * xj2;
      X29 -= (f32x2){La14[2], La14[3]} * xj2;
      X30 -= (f32x2){La15[0], La15[1]} * xj2;
      X31 -= (f32x2){La15[2], La15[3]} * xj2;
    }
    __builtin_amdgcn_sched_barrier(0);
    La8 = *(const f32x4*)(Lt_s + 2344);
    La9 = *(const f32x4*)(Lt_s + 2348);
    La10 = *(const f32x4*)(Lt_s + 2352);
    La11 = *(const f32x4*)(Lt_s + 2356);
    La12 = *(const f32x4*)(Lt_s + 2360);
    La13 = *(const f32x4*)(Lt_s + 2364);
    La14 = *(const f32x4*)(Lt_s + 2368);
    La15 = *(const f32x4*)(Lt_s + 2372);
    __builtin_amdgcn_sched_barrier(0);
    { const float xj = X16[1]; const f32x2 xj2 = (f32x2){xj, xj};
      X17 -= (f32x2){Lb8[2], Lb8[3]} * xj2;
      X18 -= (f32x2){Lb9[0], Lb9[1]} * xj2;
      X19 -= (f32x2){Lb9[2], Lb9[3]} * xj2;
      X20 -= (f32x2){Lb10[0], Lb10[1]} * xj2;
      X21 -= (f32x2){Lb10[2], Lb10[3]} * xj2;
      X22 -= (f32x2){Lb11[0], Lb11[1]} * xj2;
      X23 -= (f32x2){Lb11[2], Lb11[3]} * xj2;
      X24 -= (f32x2){Lb12[0], Lb12[1]} * xj2;
      X25 -= (f32x2){Lb12[2], Lb12[3]} * xj2;
      X26 -= (f32x2){Lb13[0], Lb13[1]} * xj2;
      X27 -= (f32x2){Lb13[2], Lb13[3]} * xj2;
      X28 -= (f32x2){Lb14[0], Lb14[1]} * xj2;
      X29 -= (f32x2){Lb14[2], Lb14[3]} * xj2;
      X30 -= (f32x2){Lb15[0], Lb15[1]} * xj2;
      X31 -= (f32x2){Lb15[2], Lb15[3]} * xj2;
    }
    __builtin_amdgcn_sched_barrier(0);
    Lb9 = *(const f32x4*)(Lt_s + 2416);
    Lb10 = *(const f32x4*)(Lt_s + 2420);
    Lb11 = *(const f32x4*)(Lt_s + 2424);
    Lb12 = *(const f32x4*)(Lt_s + 2428);
    Lb13 = *(const f32x4*)(Lt_s + 2432);
    Lb14 = *(const f32x4*)(Lt_s + 2436);
    Lb15 = *(const f32x4*)(Lt_s + 2440);
    __builtin_amdgcn_sched_barrier(0);
    { const float xj = X17[0]; const f32x2 xj2 = (f32x2){xj, xj};
      X17 -= (f32x2){La8[2], La8[3]} * xj2;
      X18 -= (f32x2){La9[0], La9[1]} * xj2;
      X19 -= (f32x2){La9[2], La9[3]} * xj2;
      X20 -= (f32x2){La10[0], La10[1]} * xj2;
      X21 -= (f32x2){La10[2], La10[3]} * xj2;
      X22 -= (f32x2){La11[0], La11[1]} * xj2;
      X23 -= (f32x2){La11[2], La11[3]} * xj2;
      X24 -= (f32x2){La12[0], La12[1]} * xj2;
      X25 -= (f32x2){La12[2], La12[3]} * xj2;
      X26 -= (f32x2){La13[0], La13[1]} * xj2;
      X27 -= (f32x2){La13[2], La13[3]} * xj2;
      X28 -= (f32x2){La14[0], La14[1]} * xj2;
      X29 -= (f32x2){La14[2], La14[3]} * xj2;
      X30 -= (f32x2){La15[0], La15[1]} * xj2;
      X31 -= (f32x2){La15[2], La15[3]} * xj2;
    }
    __builtin_amdgcn_sched_barrier(0);
    La9 = *(const f32x4*)(Lt_s + 2484);
    La10 = *(const f32x4*)(Lt_s + 2488);
    La11 = *(const f32x4*)(Lt_s + 2492);
    La12 = *(const f32x4*)(Lt_s + 2496);
    La13 = *(const f32x4*)(Lt_s + 2500);
    La14 = *(const f32x4*)(Lt_s + 2504);
    La15 = *(const f32x4*)(Lt_s + 2508);
    __builtin_amdgcn_sched_barrier(0);
    { const float xj = X17[1]; const f32x2 xj2 = (f32x2){xj, xj};
      X18 -= (f32x2){Lb9[0], Lb9[1]} * xj2;
      X19 -= (f32x2){Lb9[2], Lb9[3]} * xj2;
      X20 -= (f32x2){Lb10[0], Lb10[1]} * xj2;
      X21 -= (f32x2){Lb10[2], Lb10[3]} * xj2;
      X22 -= (f32x2){Lb11[0], Lb11[1]} * xj2;
      X23 -= (f32x2){Lb11[2], Lb11[3]} * xj2;
      X24 -= (f32x2){Lb12[0], Lb12[1]} * xj2;
      X25 -= (f32x2){Lb12[2], Lb12[3]} * xj2;
      X26 -= (f32x2){Lb13[0], Lb13[1]} * xj2;
      X27 -= (f32x2){Lb13[2], Lb13[3]} * xj2;
      X28 -= (f32x2){Lb14[0], Lb14[1]} * xj2;
      X29 -= (f32x2){Lb14[2], Lb14[3]} * xj2;
      X30 -= (f32x2){Lb15[0], Lb15[1]} * xj2;
      X31 -= (f32x2){Lb15[2], Lb15[3]} * xj2;
    }
    __builtin_amdgcn_sched_barrier(0);
    Lb9 = *(const f32x4*)(Lt_s + 2552);
    Lb10 = *(const f32x4*)(Lt_s + 2556);
    Lb11 = *(const f32x4*)(Lt_s + 2560);
    Lb12 = *(const f32x4*)(Lt_s + 2564);
    Lb13 = *(const f32x4*)(Lt_s + 2568);
    Lb14 = *(const f32x4*)(Lt_s + 2572);
    Lb15 = *(const f32x4*)(Lt_s + 2576);
    __builtin_amdgcn_sched_barrier(0);
    { const float xj = X18[0]; const f32x2 xj2 = (f32x2){xj, xj};
      X18 -= (f32x2){La9[0], La9[1]} * xj2;
      X19 -= (f32x2){La9[2], La9[3]} * xj2;
      X20 -= (f32x2){La10[0], La10[1]} * xj2;
      X21 -= (f32x2){La10[2], La10[3]} * xj2;
      X22 -= (f32x2){La11[0], La11[1]} * xj2;
      X23 -= (f32x2){La11[2], La11[3]} * xj2;
      X24 -= (f32x2){La12[0], La12[1]} * xj2;
      X25 -= (f32x2){La12[2], La12[3]} * xj2;
      X26 -= (f32x2){La13[0], La13[1]} * xj2;
      X27 -= (f32x2){La13[2], La13[3]} * xj2;
      X28 -= (f32x2){La14[0], La14[1]} * xj2;
      X29 -= (f32x2){La14[2], La14[3]} * xj2;
      X30 -= (f32x2){La15[0], La15[1]} * xj2;
      X31 -= (f32x2){La15[2], La15[3]} * xj2;
    }
    __builtin_amdgcn_sched_barrier(0);
    La9 = *(const f32x4*)(Lt_s + 2620);
    La10 = *(const f32x4*)(Lt_s + 2624);
    La11 = *(const f32x4*)(Lt_s + 2628);
    La12 = *(const f32x4*)(Lt_s + 2632);
    La13 = *(const f32x4*)(Lt_s + 2636);
    La14 = *(const f32x4*)(Lt_s + 2640);
    La15 = *(const f32x4*)(Lt_s + 2644);
    __builtin_amdgcn_sched_barrier(0);
    { const float xj = X18[1]; const f32x2 xj2 = (f32x2){xj, xj};
      X19 -= (f32x2){Lb9[2], Lb9[3]} * xj2;
      X20 -= (f32x2){Lb10[0], Lb10[1]} * xj2;
      X21 -= (f32x2){Lb10[2], Lb10[3]} * xj2;
      X22 -= (f32x2){Lb11[0], Lb11[1]} * xj2;
      X23 -= (f32x2){Lb11[2], Lb11[3]} * xj2;
      X24 -= (f32x2){Lb12[0], Lb12[1]} * xj2;
      X25 -= (f32x2){Lb12[2], Lb12[3]} * xj2;
      X26 -= (f32x2){Lb13[0], Lb13[1]} * xj2;
      X27 -= (f32x2){Lb13[2], Lb13[3]} * xj2;
      X28 -= (f32x2){Lb14[0], Lb14[1]} * xj2;
      X29 -= (f32x2){Lb14[2], Lb14[3]} * xj2;
      X30 -= (f32x2){Lb15[0], Lb15[1]} * xj2;
      X31 -= (f32x2){Lb15[2], Lb15[3]} * xj2;
    }
    __builtin_amdgcn_sched_barrier(0);
    Lb10 = *(const f32x4*)(Lt_s + 2692);
    Lb11 = *(const f32x4*)(Lt_s + 2696);
    Lb12 = *(const f32x4*)(Lt_s + 2700);
    Lb13 = *(const f32x4*)(Lt_s + 2704);
    Lb14 = *(const f32x4*)(Lt_s + 2708);
    Lb15 = *(const f32x4*)(Lt_s + 2712);
    __builtin_amdgcn_sched_barrier(0);
    { const float xj = X19[0]; const f32x2 xj2 = (f32x2){xj, xj};
      X19 -= (f32x2){La9[2], La9[3]} * xj2;
      X20 -= (f32x2){La10[0], La10[1]} * xj2;
      X21 -= (f32x2){La10[2], La10[3]} * xj2;
      X22 -= (f32x2){La11[0], La11[1]} * xj2;
      X23 -= (f32x2){La11[2], La11[3]} * xj2;
      X24 -= (f32x2){La12[0], La12[1]} * xj2;
      X25 -= (f32x2){La12[2], La12[3]} * xj2;
      X26 -= (f32x2){La13[0], La13[1]} * xj2;
      X27 -= (f32x2){La13[2], La13[3]} * xj2;
      X28 -= (f32x2){La14[0], La14[1]} * xj2;
      X29 -= (f32x2){La14[2], La14[3]} * xj2;
      X30 -= (f32x2){La15[0], La15[1]} * xj2;
      X31 -= (f32x2){La15[2], La15[3]} * xj2;
    }
    __builtin_amdgcn_sched_barrier(0);
    La10 = *(const f32x4*)(Lt_s + 2760);
    La11 = *(const f32x4*)(Lt_s + 2764);
    La12 = *(const f32x4*)(Lt_s + 2768);
    La13 = *(const f32x4*)(Lt_s + 2772);
    La14 = *(const f32x4*)(Lt_s + 2776);
    La15 = *(const f32x4*)(Lt_s + 2780);
    __builtin_amdgcn_sched_barrier(0);
    { const float xj = X19[1]; const f32x2 xj2 = (f32x2){xj, xj};
      X20 -= (f32x2){Lb10[0], Lb10[1]} * xj2;
      X21 -= (f32x2){Lb10[2], Lb10[3]} * xj2;
      X22 -= (f32x2){Lb11[0], Lb11[1]} * xj2;
      X23 -= (f32x2){Lb11[2], Lb11[3]} * xj2;
      X24 -= (f32x2){Lb12[0], Lb12[1]} * xj2;
      X25 -= (f32x2){Lb12[2], Lb12[3]} * xj2;
      X26 -= (f32x2){Lb13[0], Lb13[1]} * xj2;
      X27 -= (f32x2){Lb13[2], Lb13[3]} * xj2;
      X28 -= (f32x2){Lb14[0], Lb14[1]} * xj2;
      X29 -= (f32x2){Lb14[2], Lb14[3]} * xj2;
      X30 -= (f32x2){Lb15[0], Lb15[1]} * xj2;
      X31 -= (f32x2){Lb15[2], Lb15[3]} * xj2;
    }
    __builtin_amdgcn_sched_barrier(0);
    Lb10 = *(const f32x4*)(Lt_s + 2828);
    Lb11 = *(const f32x4*)(Lt_s + 2832);
    Lb12 = *(const f32x4*)(Lt_s + 2836);
    Lb13 = *(const f32x4*)(Lt_s + 2840);
    Lb14 = *(const f32x4*)(Lt_s + 2844);
    Lb15 = *(const f32x4*)(Lt_s + 2848);
    __builtin_amdgcn_sched_barrier(0);
    { const float xj = X20[0]; const f32x2 xj2 = (f32x2){xj, xj};
      X20 -= (f32x2){La10[0], La10[1]} * xj2;
      X21 -= (f32x2){La10[2], La10[3]} * xj2;
      X22 -= (f32x2){La11[0], La11[1]} * xj2;
      X23 -= (f32x2){La11[2], La11[3]} * xj2;
      X24 -= (f32x2){La12[0], La12[1]} * xj2;
      X25 -= (f32x2){La12[2], La12[3]} * xj2;
      X26 -= (f32x2){La13[0], La13[1]} * xj2;
      X27 -= (f32x2){La13[2], La13[3]} * xj2;
      X28 -= (f32x2){La14[0], La14[1]} * xj2;
      X29 -= (f32x2){La14[2], La14[3]} * xj2;
      X30 -= (f32x2){La15[0], La15[1]} * xj2;
      X31 -= (f32x2){La15[2], La15[3]} * xj2;
    }
    __builtin_amdgcn_sched_barrier(0);
    La10 = *(const f32x4*)(Lt_s + 2896);
    La11 = *(const f32x4*)(Lt_s + 2900);
    La12 = *(const f32x4*)(Lt_s + 2904);
    La13 = *(const f32x4*)(Lt_s + 2908);
    La14 = *(const f32x4*)(Lt_s + 2912);
    La15 = *(const f32x4*)(Lt_s + 2916);
    __builtin_amdgcn_sched_barrier(0);
    { const float xj = X20[1]; const f32x2 xj2 = (f32x2){xj, xj};
      X21 -= (f32x2){Lb10[2], Lb10[3]} * xj2;
      X22 -= (f32x2){Lb11[0], Lb11[1]} * xj2;
      X23 -= (f32x2){Lb11[2], Lb11[3]} * xj2;
      X24 -= (f32x2){Lb12[0], Lb12[1]} * xj2;
      X25 -= (f32x2){Lb12[2], Lb12[3]} * xj2;
      X26 -= (f32x2){Lb13[0], Lb13[1]} * xj2;
      X27 -= (f32x2){Lb13[2], Lb13[3]} * xj2;
      X28 -= (f32x2){Lb14[0], Lb14[1]} * xj2;
      X29 -= (f32x2){Lb14[2], Lb14[3]} * xj2;
      X30 -= (f32x2){Lb15[0], Lb15[1]} * xj2;
      X31 -= (f32x2){Lb15[2], Lb15[3]} * xj2;
    }
    __builtin_amdgcn_sched_barrier(0);
    Lb11 = *(const f32x4*)(Lt_s + 2968);
    Lb12 = *(const f32x4*)(Lt_s + 2972);
    Lb13 = *(const f32x4*)(Lt_s + 2976);
    Lb14 = *(const f32x4*)(Lt_s + 2980);
    Lb15 = *(const f32x4*)(Lt_s + 2984);
    __builtin_amdgcn_sched_barrier(0);
    { const float xj = X21[0]; const f32x2 xj2 = (f32x2){xj, xj};
      X21 -= (f32x2){La10[2], La10[3]} * xj2;
      X22 -= (f32x2){La11[0], La11[1]} * xj2;
      X23 -= (f32x2){La11[2], La11[3]} * xj2;
      X24 -= (f32x2){La12[0], La12[1]} * xj2;
      X25 -= (f32x2){La12[2], La12[3]} * xj2;
      X26 -= (f32x2){La13[0], La13[1]} * xj2;
      X27 -= (f32x2){La13[2], La13[3]} * xj2;
      X28 -= (f32x2){La14[0], La14[1]} * xj2;
      X29 -= (f32x2){La14[2], La14[3]} * xj2;
      X30 -= (f32x2){La15[0], La15[1]} * xj2;
      X31 -= (f32x2){La15[2], La15[3]} * xj2;
    }
    __builtin_amdgcn_sched_barrier(0);
    La11 = *(const f32x4*)(Lt_s + 3036);
    La12 = *(const f32x4*)(Lt_s + 3040);
    La13 = *(const f32x4*)(Lt_s + 3044);
    La14 = *(const f32x4*)(Lt_s + 3048);
    La15 = *(const f32x4*)(Lt_s + 3052);
    __builtin_amdgcn_sched_barrier(0);
    { const float xj = X21[1]; const f32x2 xj2 = (f32x2){xj, xj};
      X22 -= (f32x2){Lb11[0], Lb11[1]} * xj2;
      X23 -= (f32x2){Lb11[2], Lb11[3]} * xj2;
      X24 -= (f32x2){Lb12[0], Lb12[1]} * xj2;
      X25 -= (f32x2){Lb12[2], Lb12[3]} * xj2;
      X26 -= (f32x2){Lb13[0], Lb13[1]} * xj2;
      X27 -= (f32x2){Lb13[2], Lb13[3]} * xj2;
      X28 -= (f32x2){Lb14[0], Lb14[1]} * xj2;
      X29 -= (f32x2){Lb14[2], Lb14[3]} * xj2;
      X30 -= (f32x2){Lb15[0], Lb15[1]} * xj2;
      X31 -= (f32x2){Lb15[2], Lb15[3]} * xj2;
    }
    __builtin_amdgcn_sched_barrier(0);
    Lb11 = *(const f32x4*)(Lt_s + 3104);
    Lb12 = *(const f32x4*)(Lt_s + 3108);
    Lb13 = *(const f32x4*)(Lt_s + 3112);
    Lb14 = *(const f32x4*)(Lt_s + 3116);
    Lb15 = *(const f32x4*)(Lt_s + 3120);
    __builtin_amdgcn_sched_barrier(0);
    { const float xj = X22[0]; const f32x2 xj2 = (f32x2){xj, xj};
      X22 -= (f32x2){La11[0], La11[1]} * xj2;
      X23 -= (f32x2){La11[2], La11[3]} * xj2;
      X24 -= (f32x2){La12[0], La12[1]} * xj2;
      X25 -= (f32x2){La12[2], La12[3]} * xj2;
      X26 -= (f32x2){La13[0], La13[1]} * xj2;
      X27 -= (f32x2){La13[2], La13[3]} * xj2;
      X28 -= (f32x2){La14[0], La14[1]} * xj2;
      X29 -= (f32x2){La14[2], La14[3]} * xj2;
      X30 -= (f32x2){La15[0], La15[1]} * xj2;
      X31 -= (f32x2){La15[2], La15[3]} * xj2;
    }
    __builtin_amdgcn_sched_barrier(0);
    La11 = *(const f32x4*)(Lt_s + 3172);
    La12 = *(const f32x4*)(Lt_s + 3176);
    La13 = *(const f32x4*)(Lt_s + 3180);
    La14 = *(const f32x4*)(Lt_s + 3184);
    La15 = *(const f32x4*)(Lt_s + 3188);
    __builtin_amdgcn_sched_barrier(0);
    { const float xj = X22[1]; const f32x2 xj2 = (f32x2){xj, xj};
      X23 -= (f32x2){Lb11[2], Lb11[3]} * xj2;
      X24 -= (f32x2){Lb12[0], Lb12[1]} * xj2;
      X25 -= (f32x2){Lb12[2], Lb12[3]} * xj2;
      X26 -= (f32x2){Lb13[0], Lb13[1]} * xj2;
      X27 -= (f32x2){Lb13[2], Lb13[3]} * xj2;
      X28 -= (f32x2){Lb14[0], Lb14[1]} * xj2;
      X29 -= (f32x2){Lb14[2], Lb14[3]} * xj2;
      X30 -= (f32x2){Lb15[0], Lb15[1]} * xj2;
      X31 -= (f32x2){Lb15[2], Lb15[3]} * xj2;
    }
    __builtin_amdgcn_sched_barrier(0);
    Lb12 = *(const f32x4*)(Lt_s + 3244);
    Lb13 = *(const f32x4*)(Lt_s + 3248);
    Lb14 = *(const f32x4*)(Lt_s + 3252);
    Lb15 = *(const f32x4*)(Lt_s + 3256);
    __builtin_amdgcn_sched_barrier(0);
    { const float xj = X23[0]; const f32x2 xj2 = (f32x2){xj, xj};
      X23 -= (f32x2){La11[2], La11[3]} * xj2;
      X24 -= (f32x2){La12[0], La12[1]} * xj2;
      X25 -= (f32x2){La12[2], La12[3]} * xj2;
      X26 -= (f32x2){La13[0], La13[1]} * xj2;
      X27 -= (f32x2){La13[2], La13[3]} * xj2;
      X28 -= (f32x2){La14[0], La14[1]} * xj2;
      X29 -= (f32x2){La14[2], La14[3]} * xj2;
      X30 -= (f32x2){La15[0], La15[1]} * xj2;
      X31 -= (f32x2){La15[2], La15[3]} * xj2;
    }
    __builtin_amdgcn_sched_barrier(0);
    La12 = *(const f32x4*)(Lt_s + 3312);
    La13 = *(const f32x4*)(Lt_s + 3316);
    La14 = *(const f32x4*)(Lt_s + 3320);
    La15 = *(const f32x4*)(Lt_s + 3324);
    __builtin_amdgcn_sched_barrier(0);
    { const float xj = X23[1]; const f32x2 xj2 = (f32x2){xj, xj};
      X24 -= (f32x2){Lb12[0], Lb12[1]} * xj2;
      X25 -= (f32x2){Lb12[2], Lb12[3]} * xj2;
      X26 -= (f32x2){Lb13[0], Lb13[1]} * xj2;
      X27 -= (f32x2){Lb13[2], Lb13[3]} * xj2;
      X28 -= (f32x2){Lb14[0], Lb14[1]} * xj2;
      X29 -= (f32x2){Lb14[2], Lb14[3]} * xj2;
      X30 -= (f32x2){Lb15[0], Lb15[1]} * xj2;
      X31 -= (f32x2){Lb15[2], Lb15[3]} * xj2;
    }
    __builtin_amdgcn_sched_barrier(0);
    Lb12 = *(const f32x4*)(Lt_s + 3380);
    Lb13 = *(const f32x4*)(Lt_s + 3384);
    Lb14 = *(const f32x4*)(Lt_s + 3388);
    Lb15 = *(const f32x4*)(Lt_s + 3392);
    __builtin_amdgcn_sched_barrier(0);
    { const float xj = X24[0]; const f32x2 xj2 = (f32x2){xj, xj};
      X24 -= (f32x2){La12[0], La12[1]} * xj2;
      X25 -= (f32x2){La12[2], La12[3]} * xj2;
      X26 -= (f32x2){La13[0], La13[1]} * xj2;
      X27 -= (f32x2){La13[2], La13[3]} * xj2;
      X28 -= (f32x2){La14[0], La14[1]} * xj2;
      X29 -= (f32x2){La14[2], La14[3]} * xj2;
      X30 -= (f32x2){La15[0], La15[1]} * xj2;
      X31 -= (f32x2){La15[2], La15[3]} * xj2;
    }
    __builtin_amdgcn_sched_barrier(0);
    La12 = *(const f32x4*)(Lt_s + 3448);
    La13 = *(const f32x4*)(Lt_s + 3452);
    La14 = *(const f32x4*)(Lt_s + 3456);
    La15 = *(const f32x4*)(Lt_s + 3460);
    __builtin_amdgcn_sched_barrier(0);
    { const float xj = X24[1]; const f32x2 xj2 = (f32x2){xj, xj};
      X25 -= (f32x2){Lb12[2], Lb12[3]} * xj2;
      X26 -= (f32x2){Lb13[0], Lb13[1]} * xj2;
      X27 -= (f32x2){Lb13[2], Lb13[3]} * xj2;
      X28 -= (f32x2){Lb14[0], Lb14[1]} * xj2;
      X29 -= (f32x2){Lb14[2], Lb14[3]} * xj2;
      X30 -= (f32x2){Lb15[0], Lb15[1]} * xj2;
      X31 -= (f32x2){Lb15[2], Lb15[3]} * xj2;
    }
    __builtin_amdgcn_sched_barrier(0);
    Lb13 = *(const f32x4*)(Lt_s + 3520);
    Lb14 = *(const f32x4*)(Lt_s + 3524);
    Lb15 = *(const f32x4*)(Lt_s + 3528);
    __builtin_amdgcn_sched_barrier(0);
    { const float xj = X25[0]; const f32x2 xj2 = (f32x2){xj, xj};
      X25 -= (f32x2){La12[2], La12[3]} * xj2;
      X26 -= (f32x2){La13[0], La13[1]} * xj2;
      X27 -= (f32x2){La13[2], La13[3]} * xj2;
      X28 -= (f32x2){La14[0], La14[1]} * xj2;
      X29 -= (f32x2){La14[2], La14[3]} * xj2;
      X30 -= (f32x2){La15[0], La15[1]} * xj2;
      X31 -= (f32x2){La15[2], La15[3]} * xj2;
    }
    __builtin_amdgcn_sched_barrier(0);
    La13 = *(const f32x4*)(Lt_s + 3588);
    La14 = *(const f32x4*)(Lt_s + 3592);
    La15 = *(const f32x4*)(Lt_s + 3596);
    __builtin_amdgcn_sched_barrier(0);
    { const float xj = X25[1]; const f32x2 xj2 = (f32x2){xj, xj};
      X26 -= (f32x2){Lb13[0], Lb13[1]} * xj2;
      X27 -= (f32x2){Lb13[2], Lb13[3]} * xj2;
      X28 -= (f32x2){Lb14[0], Lb14[1]} * xj2;
      X29 -= (f32x2){Lb14[2], Lb14[3]} * xj2;
      X30 -= (f32x2){Lb15[0], Lb15[1]} * xj2;
      X31 -= (f32x2){Lb15[2], Lb15[3]} * xj2;
    }
    __builtin_amdgcn_sched_barrier(0);
    Lb13 = *(const f32x4*)(Lt_s + 3656);
    Lb14 = *(const f32x4*)(Lt_s + 3660);
    Lb15 = *(const f32x4*)(Lt_s + 3664);
    __builtin_amdgcn_sched_barrier(0);
    { const float xj = X26[0]; const f32x2 xj2 = (f32x2){xj, xj};
      X26 -= (f32x2){La13[0], La13[1]} * xj2;
      X27 -= (f32x2){La13[2], La13[3]} * xj2;
      X28 -= (f32x2){La14[0], La14[1]} * xj2;
      X29 -= (f32x2){La14[2], La14[3]} * xj2;
      X30 -= (f32x2){La15[0], La15[1]} * xj2;
      X31 -= (f32x2){La15[2], La15[3]} * xj2;
    }
    __builtin_amdgcn_sched_barrier(0);
    La13 = *(const f32x4*)(Lt_s + 3724);
    La14 = *(const f32x4*)(Lt_s + 3728);
    La15 = *(const f32x4*)(Lt_s + 3732);
    __builtin_amdgcn_sched_barrier(0);
    { const float xj = X26[1]; const f32x2 xj2 = (f32x2){xj, xj};
      X27 -= (f32x2){Lb13[2], Lb13[3]} * xj2;
      X28 -= (f32x2){Lb14[0], Lb14[1]} * xj2;
      X29 -= (f32x2){Lb14[2], Lb14[3]} * xj2;
      X30 -= (f32x2){Lb15[0], Lb15[1]} * xj2;
      X31 -= (f32x2){Lb15[2], Lb15[3]} * xj2;
    }
    __builtin_amdgcn_sched_barrier(0);
    Lb14 = *(const f32x4*)(Lt_s + 3796);
    Lb15 = *(const f32x4*)(Lt_s + 3800);
    __builtin_amdgcn_sched_barrier(0);
    { const float xj = X27[0]; const f32x2 xj2 = (f32x2){xj, xj};
      X27 -= (f32x2){La13[2], La13[3]} * xj2;
      X28 -= (f32x2){La14[0], La14[1]} * xj2;
      X29 -= (f32x2){La14[2], La14[3]} * xj2;
      X30 -= (f32x2){La15[0], La15[1]} * xj2;
      X31 -= (f32x2){La15[2], La15[3]} * xj2;
    }
    __builtin_amdgcn_sched_barrier(0);
    La14 = *(const f32x4*)(Lt_s + 3864);
    La15 = *(const f32x4*)(Lt_s + 3868);
    __builtin_amdgcn_sched_barrier(0);
    { const float xj = X27[1]; const f32x2 xj2 = (f32x2){xj, xj};
      X28 -= (f32x2){Lb14[0], Lb14[1]} * xj2;
      X29 -= (f32x2){Lb14[2], Lb14[3]} * xj2;
      X30 -= (f32x2){Lb15[0], Lb15[1]} * xj2;
      X31 -= (f32x2){Lb15[2], Lb15[3]} * xj2;
    }
    __builtin_amdgcn_sched_barrier(0);
    Lb14 = *(const f32x4*)(Lt_s + 3932);
    Lb15 = *(const f32x4*)(Lt_s + 3936);
    __builtin_amdgcn_sched_barrier(0);
    { const float xj = X28[0]; const f32x2 xj2 = (f32x2){xj, xj};
      X28 -= (f32x2){La14[0], La14[1]} * xj2;
      X29 -= (f32x2){La14[2], La14[3]} * xj2;
      X30 -= (f32x2){La15[0], La15[1]} * xj2;
      X31 -= (f32x2){La15[2], La15[3]} * xj2;
    }
    __builtin_amdgcn_sched_barrier(0);
    La14 = *(const f32x4*)(Lt_s + 4000);
    La15 = *(const f32x4*)(Lt_s + 4004);
    __builtin_amdgcn_sched_barrier(0);
    { const float xj = X28[1]; const f32x2 xj2 = (f32x2){xj, xj};
      X29 -= (f32x2){Lb14[2], Lb14[3]} * xj2;
      X30 -= (f32x2){Lb15[0], Lb15[1]} * xj2;
      X31 -= (f32x2){Lb15[2], Lb15[3]} * xj2;
    }
    __builtin_amdgcn_sched_barrier(0);
    Lb15 = *(const f32x4*)(Lt_s + 4072);
    __builtin_amdgcn_sched_barrier(0);
    { const float xj = X29[0]; const f32x2 xj2 = (f32x2){xj, xj};
      X29 -= (f32x2){La14[2], La14[3]} * xj2;
      X30 -= (f32x2){La15[0], La15[1]} * xj2;
      X31 -= (f32x2){La15[2], La15[3]} * xj2;
    }
    __builtin_amdgcn_sched_barrier(0);
    La15 = *(const f32x4*)(Lt_s + 4140);
    __builtin_amdgcn_sched_barrier(0);
    { const float xj = X29[1]; const f32x2 xj2 = (f32x2){xj, xj};
      X30 -= (f32x2){Lb15[0], Lb15[1]} * xj2;
      X31 -= (f32x2){Lb15[2], Lb15[3]} * xj2;
    }
    __builtin_amdgcn_sched_barrier(0);
    Lb15 = *(const f32x4*)(Lt_s + 4208);
    __builtin_amdgcn_sched_barrier(0);
    { const float xj = X30[0]; const f32x2 xj2 = (f32x2){xj, xj};
      X30 -= (f32x2){La15[0], La15[1]} * xj2;
      X31 -= (f32x2){La15[2], La15[3]} * xj2;
    }
    __builtin_amdgcn_sched_barrier(0);
    La15 = *(const f32x4*)(Lt_s + 4276);
    __builtin_amdgcn_sched_barrier(0);
    { const float xj = X30[1]; const f32x2 xj2 = (f32x2){xj, xj};
      X31 -= (f32x2){Lb15[2], Lb15[3]} * xj2;
    }
    __builtin_amdgcn_sched_barrier(0);
    __builtin_amdgcn_sched_barrier(0);
    { const float xj = X31[0]; const f32x2 xj2 = (f32x2){xj, xj};
      X31 -= (f32x2){La15[2], La15[3]} * xj2;
    }
    __builtin_amdgcn_sched_barrier(0);
    __syncthreads();
    outp[0] = f2bf(sg * X0[0]);
    outp[136] = f2bf(sg * X0[1]);
    outp[272] = f2bf(sg * X1[0]);
    outp[408] = f2bf(sg * X1[1]);
    outp[544] = f2bf(sg * X2[0]);
    outp[680] = f2bf(sg * X2[1]);
    outp[816] = f2bf(sg * X3[0]);
    outp[952] = f2bf(sg * X3[1]);
    outp[1088] = f2bf(sg * X4[0]);
    outp[1224] = f2bf(sg * X4[1]);
    outp[1360] = f2bf(sg * X5[0]);
    outp[1496] = f2bf(sg * X5[1]);
    outp[1632] = f2bf(sg * X6[0]);
    outp[1768] = f2bf(sg * X6[1]);
    outp[1904] = f2bf(sg * X7[0]);
    outp[2040] = f2bf(sg * X7[1]);
    outp[2176] = f2bf(sg * X8[0]);
    outp[2312] = f2bf(sg * X8[1]);
    outp[2448] = f2bf(sg * X9[0]);
    outp[2584] = f2bf(sg * X9[1]);
    outp[2720] = f2bf(sg * X10[0]);
    outp[2856] = f2bf(sg * X10[1]);
    outp[2992] = f2bf(sg * X11[0]);
    outp[3128] = f2bf(sg * X11[1]);
    outp[3264] = f2bf(sg * X12[0]);
    outp[3400] = f2bf(sg * X12[1]);
    outp[3536] = f2bf(sg * X13[0]);
    outp[3672] = f2bf(sg * X13[1]);
    outp[3808] = f2bf(sg * X14[0]);
    outp[3944] = f2bf(sg * X14[1]);
    outp[4080] = f2bf(sg * X15[0]);
    outp[4216] = f2bf(sg * X15[1]);
    outp[4352] = f2bf(sg * X16[0]);
    outp[4488] = f2bf(sg * X16[1]);
    outp[4624] = f2bf(sg * X17[0]);
    outp[4760] = f2bf(sg * X17[1]);
    outp[4896] = f2bf(sg * X18[0]);
    outp[5032] = f2bf(sg * X18[1]);
    outp[5168] = f2bf(sg * X19[0]);
    outp[5304] = f2bf(sg * X19[1]);
    outp[5440] = f2bf(sg * X20[0]);
    outp[5576] = f2bf(sg * X20[1]);
    outp[5712] = f2bf(sg * X21[0]);
    outp[5848] = f2bf(sg * X21[1]);
    outp[5984] = f2bf(sg * X22[0]);
    outp[6120] = f2bf(sg * X22[1]);
    outp[6256] = f2bf(sg * X23[0]);
    outp[6392] = f2bf(sg * X23[1]);
    outp[6528] = f2bf(sg * X24[0]);
    outp[6664] = f2bf(sg * X24[1]);
    outp[6800] = f2bf(sg * X25[0]);
    outp[6936] = f2bf(sg * X25[1]);
    outp[7072] = f2bf(sg * X26[0]);
    outp[7208] = f2bf(sg * X26[1]);
    outp[7344] = f2bf(sg * X27[0]);
    outp[7480] = f2bf(sg * X27[1]);
    outp[7616] = f2bf(sg * X28[0]);
    outp[7752] = f2bf(sg * X28[1]);
    outp[7888] = f2bf(sg * X29[0]);
    outp[8024] = f2bf(sg * X29[1]);
    outp[8160] = f2bf(sg * X30[0]);
    outp[8296] = f2bf(sg * X30[1]);
    outp[8432] = f2bf(sg * X31[0]);
    outp[8568] = f2bf(sg * X31[1]);
}

DEV void dn_item(const Params& p, int l, int item, unsigned char* smem) {
    const int dir = item & 1, hh = (item >> 1) & 3, b = item >> 3;
    bf16_t* q_s = (bf16_t*)(smem);
    bf16_t* k_s = (bf16_t*)(smem + 17408);
    bf16_t* vnT_s = k_s;
    bf16_t* kT_s = (bf16_t*)(smem + 35840);
    bf16_t* v_s = (bf16_t*)(smem + 54272);
    bf16_t* u_s = v_s;
    float* L_s = (float*)(smem + 71680);
    bf16_t* w_s = (bf16_t*)(smem + 71680);
    bf16_t* qk_s = (bf16_t*)(smem + 89088);
    bf16_t* St_s = (bf16_t*)(smem + 98304);
    float* G_s = (float*)(smem + 133120);
    float* beta_s = G_s + 64;
    float* eG_s = G_s + 128;
    float* bw_s = G_s + 192;
    float* cw_s = G_s + 256;
    const int tid = get_tid(), lane = tid & 63, wv = tid >> 6, l15 = lane & 15, quad = lane >> 4;
    const float Aneg = -expf(p.in[I_DNALOG][(l * 2 + dir) * 4 + hh]);
    const float dtb = p.in[I_DNDT][(l * 2 + dir) * 4 + hh];
    const bf16_t* P = wsb(p, O_P);
    const float* AB = wsf(p, O_AB);
    bf16_t* TO = wsb(p, dir ? O_TA2 : O_TA);
    __syncthreads();
    for (int e = tid; e < 4 * 384; e += 256) { int j = e / 384, c = e % 384, mat = c >> 7, cc = c & 127; cw_s[e] = p.in[I_DNCONV][((size_t)l * 4 + j) * 1536 + mat * 512 + hh * 128 + cc]; }
    for (int e = tid; e < 128 * 136 / 2; e += 256) ((unsigned*)St_s)[e] = 0u;
    f32x4 Sacc[2][8];
#pragma unroll
    for (int a = 0; a < 2; ++a)
#pragma unroll
        for (int c = 0; c < 8; ++c) Sacc[a][c] = (f32x4){0.f, 0.f, 0.f, 0.f};

    const int rg = tid >> 4, cseg = tid & 15, i0 = rg * 4;
    u32x4 raw[3][7];
    float pf_al = 0.f, pf_bb = 0.f;
#define DN_PREFETCH(NN, M0, M1) { \
        const int c_ = chunk_of(dir, (NN)); const int lo_ = c_ < 4 ? 0 : CTXL, hi_ = c_ < 4 ? CTXL : SB, base_ = c_ * 64; \
        const int slo_ = dir ? base_ + 60 - i0 : base_ + i0; \
        _Pragma("unroll") for (int u = 0; u < 7; ++u) { const int ss_ = slo_ - 1 + u; const bool ok_ = ss_ >= lo_ && ss_ < hi_; \
            const bf16_t* rp_ = P + ((size_t)b * SB + (ok_ ? ss_ : base_)) * PW + hh * 128 + cseg * 8; \
            _Pragma("unroll") for (int mat = (M0); mat < (M1); ++mat) { u32x4 t_ = *(const u32x4*)(rp_ + mat * 512); raw[mat][u] = ok_ ? t_ : (u32x4){0u, 0u, 0u, 0u}; } } \
        if ((M0) == 0) { const int sa_ = dir ? base_ + 63 - lane : base_ + lane; \
        pf_al = AB[((size_t)b * SB + sa_) * 16 + dir * 4 + hh]; pf_bb = AB[((size_t)b * SB + sa_) * 16 + 8 + dir * 4 + hh]; } }
    DN_PREFETCH(0, 0, 3);
    const int wv0_ = wv, l150_ = l15, quad0_ = quad, lane0_ = lane;

#pragma unroll 1
    for (int n = 0; n < 68; ++n) {
        int tz0 = 0; asm volatile("" : "+v"(tz0));
        const int wv = wv0_ + tz0, l15 = l150_ + tz0, quad = quad0_ + tz0, lane = lane0_ + tz0;
        const int c = chunk_of(dir, n);
        const int base = c * 64;
        __syncthreads();
        if (wv == 0) {
            float g = Aneg * softplus_fast(pf_al + dtb);
#pragma unroll
            for (int o = 1; o < 64; o <<= 1) { float t = __shfl_up(g, o); if (lane >= o) g += t; }
            const float eg_ = expf(g), bt_ = sigm(pf_bb); G_s[lane] = g; beta_s[lane] = bt_; eG_s[lane] = eg_; bw_s[lane] = bt_ * eg_;
        }
        __syncthreads();
        const float Glast = G_s[63];
        {
            int tz = 0; asm volatile("" : "+v"(tz));
            const int i0l = i0 + tz, csl = cseg + tz;
            float ksc[4];
#pragma unroll
            for (int m = 0; m < 4; ++m) ksc[m] = expf(Glast - G_s[i0l + m]);
#pragma unroll
            for (int mat = 0; mat < 3; ++mat) {
                float w[4][8];
#pragma unroll
                for (int j = 0; j < 4; ++j) { const f32x4 w0 = *(const f32x4*)(cw_s + j * 384 + mat * 128 + csl * 8), w1 = *(const f32x4*)(cw_s + j * 384 + mat * 128 + csl * 8 + 4);
#pragma unroll
                    for (int e = 0; e < 4; ++e) { w[j][e] = w0[e]; w[j][4 + e] = w1[e]; } }
                float v[4][8];
#pragma unroll
                for (int t = 0; t < 4; ++t)
#pragma unroll
                    for (int e = 0; e < 8; ++e) v[t][e] = 0.f;
#pragma unroll
                for (int u = 0; u < 7; ++u) {
                    float x[8];
#pragma unroll
                    for (int e = 0; e < 4; ++e) { x[2 * e] = lo16(raw[mat][u][e]); x[2 * e + 1] = hi16(raw[mat][u][e]); }
#pragma unroll
                    for (int t = 0; t < 4; ++t) { const int j = u - t; if (j >= 0 && j < 4) {
#pragma unroll
                        for (int e = 0; e < 8; ++e) v[t][e] += w[j][e] * x[e]; } }
                }
                float sc[4];
#pragma unroll
                for (int t = 0; t < 4; ++t) {
                    float ss2 = 0.f;
#pragma unroll
                    for (int e = 0; e < 8; ++e) { v[t][e] = silu(v[t][e]); ss2 += v[t][e] * v[t][e]; }
                    if (mat < 2) { ss2 += __shfl_xor(ss2, 1); ss2 += __shfl_xor(ss2, 2); ss2 += __shfl_xor(ss2, 4); ss2 += __shfl_xor(ss2, 8); }
                    sc[t] = mat == 0 ? rsqrtf(ss2 + 1e-6f) * 0.08838834764831845f : (mat == 1 ? rsqrtf(ss2 + 1e-6f) : 1.f);
                }
                bf16_t* dst = mat == 0 ? q_s : (mat == 1 ? k_s : v_s);
#pragma unroll
                for (int t = 0; t < 4; ++t) {
                    const int it_ = dir ? i0l + 3 - t : i0l + t;
                    u32x4 o;
#pragma unroll
                    for (int e = 0; e < 4; ++e) o[e] = pack2(v[t][2 * e] * sc[t], v[t][2 * e + 1] * sc[t]);
                    *(u32x4*)(dst + it_ * 136 + csl * 8) = o;
                }
                if (mat == 1) {
#pragma unroll
                    for (int e = 0; e < 8; ++e) {
                        const float k0 = v[dir ? 3 : 0][e] * sc[dir ? 3 : 0] * ksc[0], k1 = v[dir ? 2 : 1][e] * sc[dir ? 2 : 1] * ksc[1];
                        const float k2 = v[dir ? 1 : 2][e] * sc[dir ? 1 : 2] * ksc[2], k3 = v[dir ? 0 : 3][e] * sc[dir ? 0 : 3] * ksc[3];
                        u32x2 o; o.x = pack2(k0, k1); o.y = pack2(k2, k3);
                        *(u32x2*)(kT_s + (csl * 8 + e) * 72 + i0l) = o;
                    }
                }
            }
        }
        __syncthreads();
        {
            bf16x8 ak[4], aq[4];
#pragma unroll
            for (int ks = 0; ks < 4; ++ks) { ak[ks] = *(const bf16x8*)(k_s + (wv * 16 + l15) * 136 + ks * 32 + quad * 8); aq[ks] = *(const bf16x8*)(q_s + (wv * 16 + l15) * 136 + ks * 32 + quad * 8); }
#pragma unroll
            for (int nt = 0; nt < 4; ++nt) {
                f32x4 kk = {0.f, 0.f, 0.f, 0.f}, qq = {0.f, 0.f, 0.f, 0.f};
#pragma unroll
                for (int ks = 0; ks < 4; ++ks) { bf16x8 bk = *(const bf16x8*)(k_s + (nt * 16 + l15) * 136 + ks * 32 + quad * 8); kk = mfma16(ak[ks], bk, kk); qq = mfma16(aq[ks], bk, qq); }
                const int jj = nt * 16 + l15; const float Gj = G_s[jj];
                f32x4 lv;
#pragma unroll
                for (int j = 0; j < 4; ++j) {
                    const int i = wv * 16 + quad * 4 + j;
                    const float dec = jj <= i ? expf(G_s[i] - Gj) : 0.f;
                    lv[j] = jj < i ? beta_s[i] * kk[j] * dec : 0.f;
                    qk_s[i * 72 + jj] = f2bf(qq[j] * dec);
                }
                *(f32x4*)(L_s + jj * 68 + wv * 16 + quad * 4) = lv;
            }
        }
        __syncthreads();
        dn_solve(L_s, tid < 128 ? (k_s + tid) : (v_s + (tid - 128)), tid < 128 ? bw_s : beta_s, tid < 128 ? -1.f : 1.f, tid < 128 ? (w_s + tid) : (u_s + (tid - 128)));
        __syncthreads();
        {
            f32x4 vn[8], o1[8];
#pragma unroll
            for (int nt = 0; nt < 8; ++nt) {
#pragma unroll
                for (int j = 0; j < 4; ++j) vn[nt][j] = bf2f(u_s[(wv * 16 + quad * 4 + j) * 136 + nt * 16 + l15]);
                o1[nt] = (f32x4){0.f, 0.f, 0.f, 0.f};
            }
            bf16x8 aw[4], aq[4];
#pragma unroll
            for (int ks = 0; ks < 4; ++ks) { aw[ks] = *(const bf16x8*)(w_s + (wv * 16 + l15) * 136 + ks * 32 + quad * 8); aq[ks] = *(const bf16x8*)(q_s + (wv * 16 + l15) * 136 + ks * 32 + quad * 8); }
#pragma unroll
            for (int nt = 0; nt < 8; ++nt)
#pragma unroll
                for (int ks = 0; ks < 4; ++ks) { bf16x8 bs = *(const bf16x8*)(St_s + (nt * 16 + l15) * 136 + ks * 32 + quad * 8); vn[nt] = mfma16(aw[ks], bs, vn[nt]); o1[nt] = mfma16(aq[ks], bs, o1[nt]); }
#pragma unroll
            for (int nt = 0; nt < 8; ++nt) { u32x2 o; o.x = pack2(vn[nt][0], vn[nt][1]); o.y = pack2(vn[nt][2], vn[nt][3]); *(u32x2*)(vnT_s + (nt * 16 + l15) * 72 + wv * 16 + quad * 4) = o; }
            __syncthreads();
            if (n + 1 < 68) DN_PREFETCH(n + 1, 0, 2);
            float eg[4];
#pragma unroll
            for (int j = 0; j < 4; ++j) eg[j] = eG_s[wv * 16 + quad * 4 + j];
            bf16x8 aqk[2], akt[2][2];
#pragma unroll
            for (int ks = 0; ks < 2; ++ks) {
                aqk[ks] = *(const bf16x8*)(qk_s + (wv * 16 + l15) * 72 + ks * 32 + quad * 8);
                akt[0][ks] = *(const bf16x8*)(kT_s + (wv * 32 + l15) * 72 + ks * 32 + quad * 8);
                akt[1][ks] = *(const bf16x8*)(kT_s + (wv * 32 + 16 + l15) * 72 + ks * 32 + quad * 8);
            }
            const float gend = eG_s[63];
            const size_t orow0 = (size_t)b * SB;
#pragma unroll
            for (int nt = 0; nt < 8; ++nt) {
                f32x4 o;
#pragma unroll
                for (int j = 0; j < 4; ++j) { o[j] = o1[nt][j] * eg[j]; Sacc[0][nt][j] *= gend; Sacc[1][nt][j] *= gend; }
#pragma unroll
                for (int ks = 0; ks < 2; ++ks) {
                    bf16x8 bv = *(const bf16x8*)(vnT_s + (nt * 16 + l15) * 72 + ks * 32 + quad * 8);
                    o = mfma16(aqk[ks], bv, o);
                    Sacc[0][nt] = mfma16(akt[0][ks], bv, Sacc[0][nt]);
                    Sacc[1][nt] = mfma16(akt[1][ks], bv, Sacc[1][nt]);
                }
#pragma unroll
                for (int j = 0; j < 4; ++j) {
                    const int i = wv * 16 + quad * 4 + j;
                    const int s = dir ? base + 63 - i : base + i;
                    TO[(orow0 + s) * 512 + hh * 128 + nt * 16 + l15] = f2bf(o[j]);
                }
#pragma unroll
                for (int mt = 0; mt < 2; ++mt) { u32x2 sv; sv.x = pack2(Sacc[mt][nt][0], Sacc[mt][nt][1]); sv.y = pack2(Sacc[mt][nt][2], Sacc[mt][nt][3]);
                    *(u32x2*)(St_s + (nt * 16 + l15) * 136 + wv * 32 + mt * 16 + quad * 4) = sv; }
            }
        }
        if (n + 1 < 68) DN_PREFETCH(n + 1, 2, 3);
    }
}

#undef DN_PREFETCH
DEV void lru_item(const Params& p, int l, int item, unsigned char* smem) {
    const int g = item & 7, b = item >> 3;
    bf16_t* Wt_s = (bf16_t*)smem;
    bf16_t* xbh_s = Wt_s + 2 * 128 * 72;
    float* xbf_s = (float*)(smem + 36864 + 18432);
    float* a_s = xbf_s + 2 * 64 * 65;
    float* cw_s = a_s + 2 * 64 * 65;
    const int tid = get_tid(), lane = tid & 63, wv = tid >> 6, l15 = lane & 15, quad = lane >> 4;
    bf16_t* P = wsb(p, O_P);
    bf16_t* HF = wsb(p, O_U);
    __syncthreads();
    for (int e = tid; e < 320; e += 256) cw_s[e] = e < 256 ? p.in[I_LCW][((size_t)l * 4 + (e >> 6)) * 512 + g * 64 + (e & 63)] : p.in[I_LCB][l * 512 + g * 64 + (e - 256)];
    for (int e = tid; e < 2 * 4096; e += 256) {
        const int d = e >> 12, ch = (e >> 6) & 63, j = e & 63;
        const size_t wi_ = (((size_t)l * 2 + d) * 8 + g) * 4096 + ch * 64 + j;
        Wt_s[(d * 128 + j) * 72 + ch] = f2bf(p.in[I_LWA][wi_]);
        Wt_s[(d * 128 + 64 + j) * 72 + ch] = f2bf(p.in[I_LWI][wi_]);
    }
    float ba_[2][4], bi_[2][4], sp_[2][4];
#pragma unroll
    for (int d = 0; d < 2; ++d)
#pragma unroll
        for (int nt = 0; nt < 4; ++nt) {
            const int ch = (l * 2 + d) * 512 + g * 64 + nt * 16 + l15;
            ba_[d][nt] = p.in[I_LBA][ch]; bi_[d][nt] = p.in[I_LBI][ch]; sp_[d][nt] = softplus(-p.in[I_LLAM][ch]);
        }
    float hc = 0.f;
    const int i = tid >> 2, seg = tid & 3, j0 = seg * 16;
#pragma unroll 1
    for (int n = 0; n < 68; ++n) {
        const int cf = n, cb = chunk_of(1, n);
        __syncthreads();
#pragma unroll
        for (int d = 0; d < 2; ++d) {
            const int c = d ? cb : cf;
            const int seg_lo = c < 4 ? 0 : CTXL, seg_hi = c < 4 ? CTXL : SB;
            const int s = d ? c * 64 + 63 - i : c * 64 + i;
            float v[16];
#pragma unroll
            for (int e = 0; e < 16; ++e) v[e] = cw_s[256 + j0 + e];
#pragma unroll
            for (int j = 0; j < 4; ++j) {
                const int ss = s + j - 1;
                if (ss >= seg_lo && ss < seg_hi) {
                    const u32x4* src = (const u32x4*)(P + ((size_t)b * SB + ss) * PW + C_LX + g * 64 + j0);
                    const float* cw = cw_s + j * 64 + j0;
#pragma unroll
                    for (int q = 0; q < 2; ++q) { u32x4 x = src[q];
#pragma unroll
                        for (int e = 0; e < 4; ++e) { v[q * 8 + 2 * e] += cw[q * 8 + 2 * e] * lo16(x[e]); v[q * 8 + 2 * e + 1] += cw[q * 8 + 2 * e + 1] * hi16(x[e]); } }
                }
            }
            u32x4 h0, h1;
#pragma unroll
            for (int e = 0; e < 4; ++e) { h0[e] = pack2(v[2 * e], v[2 * e + 1]); h1[e] = pack2(v[8 + 2 * e], v[8 + 2 * e + 1]); }
            *(u32x4*)(xbh_s + (d * 64 + i) * 72 + j0) = h0; *(u32x4*)(xbh_s + (d * 64 + i) * 72 + j0 + 8) = h1;
#pragma unroll
            for (int e = 0; e < 16; ++e) xbf_s[(d * 64 + i) * 65 + j0 + e] = v[e];
        }
        __syncthreads();
#pragma unroll
        for (int d = 0; d < 2; ++d) {
            f32x4 acc[8];
#pragma unroll
            for (int nt = 0; nt < 8; ++nt) acc[nt] = (f32x4){0.f, 0.f, 0.f, 0.f};
            bf16x8 af[2];
#pragma unroll
            for (int ks = 0; ks < 2; ++ks) af[ks] = *(const bf16x8*)(xbh_s + (d * 64 + wv * 16 + l15) * 72 + ks * 32 + quad * 8);
#pragma unroll
            for (int nt = 0; nt < 8; ++nt)
#pragma unroll
                for (int ks = 0; ks < 2; ++ks) { bf16x8 bw = *(const bf16x8*)(Wt_s + (d * 128 + nt * 16 + l15) * 72 + ks * 32 + quad * 8); acc[nt] = mfma16(af[ks], bw, acc[nt]); }
#pragma unroll
            for (int nt = 0; nt < 4; ++nt)
#pragma unroll
                for (int jj = 0; jj < 4; ++jj) {
                    const int idx = (d * 64 + wv * 16 + quad * 4 + jj) * 65 + nt * 16 + l15;
                    const float r = sigm(acc[nt][jj] + ba_[d][nt]), ig = sigm(acc[nt + 4][jj] + bi_[d][nt]);
                    const float la = -8.f * r * sp_[d][nt];
                    a_s[idx] = expf(la);
                    xbf_s[idx] = sqrtf(fmaxf(1.f - expf(2.f * la), 0.f)) * (ig * xbf_s[idx]);
                }
        }
        __syncthreads();
        if (wv < 2) {
            const int o = wv * 64 * 65 + lane;
#pragma unroll 16
            for (int r = 0; r < 64; ++r) { hc = a_s[o + r * 65] * hc + xbf_s[o + r * 65]; xbf_s[o + r * 65] = hc; }
        }
        __syncthreads();
#pragma unroll
        for (int d = 0; d < 2; ++d) {
            const int c = d ? cb : cf;
            const int s = d ? c * 64 + 63 - i : c * 64 + i;
            const bool second = d ? (cb < n) : ((cf < 4 ? 3 - cf : 71 - cf) < n);
            const size_t row = (size_t)b * SB + s;
            const float* hp = xbf_s + (d * 64 + i) * 65 + j0;
            bf16_t* hf = HF + row * 512 + g * 64 + j0;
            if (!second) {
                u32x4 o0, o1;
#pragma unroll
                for (int e = 0; e < 4; ++e) { o0[e] = pack2(hp[2 * e], hp[2 * e + 1]); o1[e] = pack2(hp[8 + 2 * e], hp[8 + 2 * e + 1]); }
                *(u32x4*)hf = o0; *(u32x4*)(hf + 8) = o1;
            } else {
                bf16_t* gp = P + row * PW + C_LG + g * 64 + j0;
                u32x4 f0 = *(const u32x4*)hf, f1 = *(const u32x4*)(hf + 8), g0 = *(const u32x4*)gp, g1 = *(const u32x4*)(gp + 8), o0, o1;
#pragma unroll
                for (int e = 0; e < 4; ++e) {
                    o0[e] = pack2((lo16(f0[e]) + hp[2 * e]) * gelu_tanh(lo16(g0[e])), (hi16(f0[e]) + hp[2 * e + 1]) * gelu_tanh(hi16(g0[e])));
                    o1[e] = pack2((lo16(f1[e]) + hp[8 + 2 * e]) * gelu_tanh(lo16(g1[e])), (hi16(f1[e]) + hp[8 + 2 * e + 1]) * gelu_tanh(hi16(g1[e])));
                }
                *(u32x4*)gp = o0; *(u32x4*)(gp + 8) = o1;
            }
        }
    }
}

DEV void att_item(const Params& p, int l, int b, int h, int qt, float lam_init, unsigned char* smem) {
    bf16_t* K_s = (bf16_t*)smem;
    bf16_t* V_s = (bf16_t*)(smem + 2 * 17408);
    const int tid = get_tid(), lane = tid & 63, wv = tid >> 6, l15 = lane & 15, quad = lane >> 4;
    bf16_t* P = wsb(p, O_P);
    const bf16_t* VT = wsb(p, O_VT) + (size_t)(b * 4 + h) * 128 * SB;
    const int nt_keys = (qt < 2 ? CTXL : SB) / 64;
    float lam;
    {
        const float* lv = p.in[I_DALAM] + l * 256;
        float s1 = lv[lane] * lv[64 + lane], s2 = lv[128 + lane] * lv[192 + lane];
#pragma unroll
        for (int o = 32; o >= 1; o >>= 1) { s1 += __shfl_xor(s1, o); s2 += __shfl_xor(s2, o); }
        lam = expf(s1) - expf(s2) + lam_init;
    }
    bf16x8* Qst = (bf16x8*)(smem + 71680) + (wv * 8) * 64 + lane;
#pragma unroll
    for (int qg = 0; qg < 2; ++qg) {
        const bf16_t* qp = P + ((size_t)b * SB + qt * 128 + wv * 32 + qg * 16 + l15) * PW + C_DAQ + h * 128;
#pragma unroll
        for (int wh = 0; wh < 2; ++wh)
#pragma unroll
            for (int ks = 0; ks < 2; ++ks) Qst[(wh * 4 + qg * 2 + ks) * 64] = *(const bf16x8*)(qp + wh * 64 + ks * 32 + quad * 8);
    }
    f32x4 O[2][8][2];
    float mrun[2][2], lrun[2][2];
#pragma unroll
    for (int wh = 0; wh < 2; ++wh)
#pragma unroll
        for (int qg = 0; qg < 2; ++qg) { mrun[wh][qg] = -1e30f; lrun[wh][qg] = 0.f;
#pragma unroll
            for (int dg = 0; dg < 8; ++dg) O[wh][dg][qg] = (f32x4){0.f, 0.f, 0.f, 0.f}; }
    const int kr = tid >> 2, kseg = (tid & 3) * 32;
    const int kpos = ((kr >> 5) * 2 + ((kr & 7) >> 2)) * 16 + ((kr & 31) >> 3) * 4 + (kr & 3);
    const bf16_t* kg_ = P + ((size_t)b * SB + kr) * PW + C_DAK + h * 128 + kseg;
    const int vr = tid >> 1, vh = (tid & 1) * 32;
    const bf16_t* vg_ = VT + (size_t)vr * SB + vh;
    u32x4 kreg[4], vreg[4];
#pragma unroll
    for (int i = 0; i < 4; ++i) { kreg[i] = *(const u32x4*)(kg_ + i * 8); vreg[i] = *(const u32x4*)(vg_ + i * 8); }
    __syncthreads();
#pragma unroll
    for (int i = 0; i < 4; ++i) { *(u32x4*)(K_s + kpos * 136 + kseg + i * 8) = kreg[i]; *(u32x4*)(V_s + vr * 72 + vh + i * 8) = vreg[i]; }
    __syncthreads();
    const float L2E = 1.4426950408889634f;
#pragma unroll 1
    for (int t = 0; t < nt_keys; ++t) {
        const bf16_t* Kb = K_s + (t & 1) * (64 * 136);
        const bf16_t* Vb = V_s + (t & 1) * (128 * 72);
        if (t + 1 < nt_keys) {
#pragma unroll
            for (int i = 0; i < 4; ++i) { kreg[i] = *(const u32x4*)(kg_ + (size_t)(t + 1) * 64 * PW + i * 8); vreg[i] = *(const u32x4*)(vg_ + (t + 1) * 64 + i * 8); }
        }
#pragma unroll
        for (int wh = 0; wh < 2; ++wh) {
            f32x4 S[4][2];
#pragma unroll
            for (int kg = 0; kg < 4; ++kg) { S[kg][0] = (f32x4){0.f, 0.f, 0.f, 0.f}; S[kg][1] = (f32x4){0.f, 0.f, 0.f, 0.f}; }
#pragma unroll
            for (int ks = 0; ks < 2; ++ks)
#pragma unroll
                for (int kg = 0; kg < 4; ++kg) {
                    bf16x8 kf = *(const bf16x8*)(Kb + (kg * 16 + l15) * 136 + wh * 64 + ks * 32 + quad * 8);
                    S[kg][0] = mfma16(kf, Qst[(wh * 4 + 0 + ks) * 64], S[kg][0]);
                    S[kg][1] = mfma16(kf, Qst[(wh * 4 + 2 + ks) * 64], S[kg][1]);
                }
            bf16x8 Pf[2][2];
#pragma unroll
            for (int qg = 0; qg < 2; ++qg) {
                float mx = -1e30f;
#pragma unroll
                for (int kg = 0; kg < 4; ++kg)
#pragma unroll
                    for (int j = 0; j < 4; ++j) mx = fmaxf(mx, S[kg][qg][j]);
                mx = fmaxf(mx, __shfl_xor(mx, 16)); mx = fmaxf(mx, __shfl_xor(mx, 32));
                mx *= L2E;
                if (__builtin_amdgcn_ballot_w64(mx > mrun[wh][qg] + 8.f) != 0ull) {
                    const float mnew = fmaxf(mrun[wh][qg], mx);
                    const float alpha = __builtin_amdgcn_exp2f(mrun[wh][qg] - mnew);
                    mrun[wh][qg] = mnew;
                    lrun[wh][qg] *= alpha;
#pragma unroll
                    for (int dg = 0; dg < 8; ++dg)
#pragma unroll
                        for (int j = 0; j < 4; ++j) O[wh][dg][qg][j] *= alpha;
                }
                const float mref = mrun[wh][qg];
                float ps = 0.f;
#pragma unroll
                for (int kg = 0; kg < 4; ++kg)
#pragma unroll
                    for (int j = 0; j < 4; ++j) { float pv = __builtin_amdgcn_exp2f(S[kg][qg][j] * L2E - mref); ps += pv; S[kg][qg][j] = pv; }
                lrun[wh][qg] += ps;
#pragma unroll
                for (int s_ = 0; s_ < 2; ++s_) {
                    u32x4 pk; pk[0] = pack2(S[2 * s_][qg][0], S[2 * s_][qg][1]); pk[1] = pack2(S[2 * s_][qg][2], S[2 * s_][qg][3]);
                    pk[2] = pack2(S[2 * s_ + 1][qg][0], S[2 * s_ + 1][qg][1]); pk[3] = pack2(S[2 * s_ + 1][qg][2], S[2 * s_ + 1][qg][3]);
                    Pf[qg][s_] = __builtin_bit_cast(bf16x8, pk);
                }
            }
#pragma unroll
            for (int dg = 0; dg < 8; ++dg)
#pragma unroll
                for (int s_ = 0; s_ < 2; ++s_) {
                    bf16x8 vf = *(const bf16x8*)(Vb + (dg * 16 + l15) * 72 + s_ * 32 + quad * 8);
                    O[wh][dg][0] = mfma16(vf, Pf[0][s_], O[wh][dg][0]);
                    O[wh][dg][1] = mfma16(vf, Pf[1][s_], O[wh][dg][1]);
                }
        }
        if (t + 1 < nt_keys) {
            bf16_t* Kn = K_s + ((t + 1) & 1) * (64 * 136); bf16_t* Vn = V_s + ((t + 1) & 1) * (128 * 72);
#pragma unroll
            for (int i = 0; i < 4; ++i) { *(u32x4*)(Kn + kpos * 136 + kseg + i * 8) = kreg[i]; *(u32x4*)(Vn + vr * 72 + vh + i * 8) = vreg[i]; }
        }
        __syncthreads();
    }
    const float* dnw = p.in[I_DANORM] + l * 128;
#pragma unroll
    for (int qg = 0; qg < 2; ++qg) {
        float l1 = lrun[0][qg], l2 = lrun[1][qg];
        l1 += __shfl_xor(l1, 16); l1 += __shfl_xor(l1, 32); l2 += __shfl_xor(l2, 16); l2 += __shfl_xor(l2, 32);
        const float i1 = 1.f / l1, i2 = lam / l2;
        float ss = 0.f;
#pragma unroll
        for (int dg = 0; dg < 8; ++dg)
#pragma unroll
            for (int j = 0; j < 4; ++j) { float o = O[0][dg][qg][j] * i1 - O[1][dg][qg][j] * i2; O[0][dg][qg][j] = o; ss += o * o; }
        ss += __shfl_xor(ss, 16); ss += __shfl_xor(ss, 32);
        const float rstd = rsqrtf(ss * (1.f / 128.f) + 1e-5f) * (1.f - lam_init);
        bf16_t* op = P + ((size_t)b * SB + qt * 128 + wv * 32 + qg * 16 + l15) * PW + C_DAQ + h * 128;
#pragma unroll
        for (int dg = 0; dg < 8; ++dg) {
            const int dv0 = dg * 16 + quad * 4;
            u32x2 o; o.x = pack2(O[0][dg][qg][0] * rstd * dnw[dv0], O[0][dg][qg][1] * rstd * dnw[dv0 + 1]);
            o.y = pack2(O[0][dg][qg][2] * rstd * dnw[dv0 + 2], O[0][dg][qg][3] * rstd * dnw[dv0 + 3]);
            *(u32x2*)(op + dv0) = o;
        }
    }
}

DEV void phase_mix(const Params& p, int l, unsigned char* smem) {
    const bool need_ctx = l == 0;
    const float lam_init = l == 0 ? 0.2f : 0.35550906759096926f;
    unsigned* ctr = (unsigned*)(p.ws + O_CTL) + l;
    __shared__ int s_item;
    const int nqt = need_ctx ? 34 : 32;
    const int total = 64 + 64 + 32 * nqt;
    auto next = [&]() -> int {
        __syncthreads();
        if (threadIdx.x == 0) s_item = (int)atomicAdd(ctr, 1u);
        __syncthreads();
        return __builtin_amdgcn_readfirstlane(s_item);
    };
    int it = next();
#pragma unroll 1
    while (it < 64) { dn_item(p, l, it, smem); it = next(); }
#pragma unroll 1
    while (it < 128) { lru_item(p, l, it - 64, smem); it = next(); }
#pragma unroll 1
    while (it < total) {
        const int a = it - 128, bh = a / nqt, idx = a % nqt;
        const int qt = idx < 32 ? idx + 2 : idx - 32;
        att_item(p, l, bh >> 2, bh & 3, qt, lam_init, smem);
        it = next();
    }
}

constexpr int NPHASE = 1 + 2 * 9 + 1;
DEV void run_phase(const Params& p, int ph, unsigned char* smem) {
    if (ph == 0) { phase_mod(p, smem); phase_rope(p); __syncthreads(); phase_wconv(p, 0, smem); return; }
    if (ph == NPHASE - 1) { phase_final(p); return; }
    const int l = (ph - 1) / 9, q = (ph - 1) % 9;
    const bool first = l == 0, lat = l == 1;
    const bf16_t* W = wsb(p, O_WT);
    switch (q) {
        case 0: if (l == 1) phase_wconv(p, 1, smem); phase_norm(p, l, 0, first, false); break;
        case 1: phase_g1(p, smem); break;
        case 2: phase_mix(p, l, smem); break;
        case 3: phase_fin_norm(p, l, first, lat); break;
        case 4: phase_gate(p, lat, smem); break;
        case 5: phase_resid(p, l, wsb(p, O_U), D, W + W_OUT, 1024, 2, first, lat, smem); break;
        case 6: phase_norm(p, l, 1, false, lat); break;
        case 7: phase_gu(p, lat, smem); break;
        case 8: phase_resid(p, l, wsb(p, O_P), PW, W + W_DN, DFF, 5, false, lat, smem); break;
    }
}

#if MEGA
__global__ void __launch_bounds__(256) mega_kernel(Params p) {
    extern __shared__ __align__(16) unsigned char smem[];
    cg::grid_group grid = cg::this_grid();
    phase_mod(p, smem); phase_rope(p); __syncthreads(); phase_wconv(p, 0, smem);
    grid.sync();
    const bf16_t* W = wsb(p, O_WT);
#pragma unroll
    for (int l = 0; l < 2; ++l) {
        const bool first = l == 0, lat = l == 1;
        if (l == 1) phase_wconv(p, 1, smem);
        phase_norm(p, l, 0, first, false);
        grid.sync();
        phase_g1(p, smem);
        grid.sync();
        phase_mix(p, l, smem);
        grid.sync();
        phase_fin_norm(p, l, first, lat);
        grid.sync();
        phase_gate(p, lat, smem);
        grid.sync();
        phase_merge(p, lat, smem);
        grid.sync();
        phase_resid(p, l, wsb(p, O_U), D, W + W_OUT, 1024, 2, first, lat, smem);
        grid.sync();
        phase_norm(p, l, 1, false, lat);
        grid.sync();
        phase_gu(p, lat, smem);
        grid.sync();
        phase_resid(p, l, wsb(p, O_P), PW, W + W_DN, DFF, 5, false, lat, smem);
        grid.sync();
    }
    phase_final(p);
}
#else
__global__ void __launch_bounds__(256) phase_kernel(Params p, int ph) {
    extern __shared__ __align__(16) unsigned char smem[];
    run_phase(p, ph, smem);
}
#endif

extern "C" void kernel_launch(void* const* d_in, const int* in_sizes, int n_in, void* d_out, int out_size, void* d_ws, size_t ws_size, hipStream_t stream) {
    static int grid = 0;
    if (grid == 0) {
        if (n_in != 28 || ws_size < WS_END) { fprintf(stderr, "kernel_launch: unexpected n_in %d or ws_size %zu < %zu\n", n_in, ws_size, (size_t)WS_END); grid = -1; return; }
        int dev = 0, cus = 0, per_cu = 0;
        hipGetDevice(&dev);
        hipDeviceGetAttribute(&cus, hipDeviceAttributeMultiprocessorCount, dev);
#if MEGA
        hipFuncSetAttribute((const void*)mega_kernel, hipFuncAttributeMaxDynamicSharedMemorySize, LDS_BYTES);
        hipOccupancyMaxActiveBlocksPerMultiprocessor(&per_cu, (const void*)mega_kernel, 256, LDS_BYTES);
#else
        hipFuncSetAttribute((const void*)phase_kernel, hipFuncAttributeMaxDynamicSharedMemorySize, LDS_BYTES);
        hipOccupancyMaxActiveBlocksPerMultiprocessor(&per_cu, (const void*)phase_kernel, 256, LDS_BYTES);
#endif
        if (per_cu < 1) per_cu = 1;
        grid = cus * per_cu;
        fprintf(stderr, "kernel_launch: grid %d (%d CUs x %d)\n", grid, cus, per_cu);
    }
    if (grid < 0) return;
    hipMemsetAsync((char*)d_ws + O_CTL, 0, 4096, stream);
    Params p{};
    for (int i = 0; i < 28; ++i) p.in[i] = (const float*)d_in[i];
    p.out = (float*)d_out; p.ws = (unsigned char*)d_ws;
#if MEGA
    void* args[] = {&p};
    hipError_t e = hipLaunchCooperativeKernel((const void*)mega_kernel, dim3(grid), dim3(256), args, LDS_BYTES, stream);
    if (e != hipSuccess) fprintf(stderr, "cooperative launch failed: %s (grid %d)\n", hipGetErrorString(e), grid);
#else
    for (int ph = 0; ph < NPHASE; ++ph) hipLaunchKernelGGL(phase_kernel, dim3(grid), dim3(256), LDS_BYTES, stream, p, ph);
#endif
}
```

```cpp
#include <hip/hip_runtime.h>
#include <hip/hip_cooperative_groups.h>
#include <cstdio>
#include <cstdint>
namespace cg = cooperative_groups;

#ifndef MEGA
#define MEGA 1
#endif

typedef unsigned short bf16_t;
typedef short bf16x8 __attribute__((ext_vector_type(8)));
typedef float f32x4 __attribute__((ext_vector_type(4)));
typedef unsigned u32x4 __attribute__((ext_vector_type(4)));
typedef unsigned u32x2 __attribute__((ext_vector_type(2)));
#define DEV __device__ __forceinline__

constexpr int D = 1024, NB = 8, SEQ = 4096, CTXL = 256, SB = 4352, MR = NB * SB, PW = 4096, DFF = 2816;
constexpr int C_DNQ = 0, C_DNK = 512, C_DNV = 1024, C_DNZ = 1536, C_LX = 2048, C_LG = 2560, C_DAQ = 3072, C_DAK = 3584;
constexpr int NIN = 4736;
constexpr int GLD = 80;

enum { I_X = 0, I_C, I_CTX, I_CCTX, I_WMOD, I_BMOD, I_NMIX, I_NFFN, I_WIN, I_DNCONV, I_DNALOG, I_DNDT, I_DNNORM, I_LCW, I_LCB,
       I_LWA, I_LBA, I_LWI, I_LBI, I_LLAM, I_DALAM, I_DANORM, I_WBR, I_WOUT, I_WFG, I_WFU, I_WFD, I_NFIN };

constexpr size_t al256(size_t x) { return (x + 255) & ~(size_t)255; }
constexpr size_t O_CTL = 0;
constexpr size_t O_MOD = 4096;
constexpr size_t O_ROPE = al256(O_MOD + (size_t)2 * 9 * 6144 * 4);
constexpr size_t O_WT = al256(O_ROPE + 64 * 16 * 2 * 4);
constexpr size_t W_IN = 0, W_GATE = W_IN + (size_t)NIN * 1024, W_BR = W_GATE + (size_t)3072 * 1024, W_OUT = W_BR + (size_t)3 * 1024 * 512,
                 W_GU = W_OUT + (size_t)1024 * 1024, W_DN = W_GU + (size_t)5632 * 1024, W_END = W_DN + (size_t)1024 * 2816;
constexpr size_t O_HCTX = al256(O_WT + W_END * 2);
constexpr size_t O_U = al256(O_HCTX + (size_t)2048 * 1024 * 4);
constexpr size_t O_P = al256(O_U + (size_t)MR * 1024 * 2);
constexpr size_t O_AB = al256(O_P + (size_t)MR * PW * 2);
constexpr size_t O_TA = al256(O_AB + (size_t)MR * 16 * 4);
constexpr size_t O_TA2 = al256(O_TA + (size_t)MR * 512 * 2);
constexpr size_t O_VT = al256(O_TA2 + (size_t)MR * 512 * 2);
constexpr size_t WS_END = al256(O_VT + (size_t)MR * 512 * 2);

constexpr int LDS_BYTES = 140 * 1024;

struct Params {
    const float* in[28];
    float* out;
    unsigned char* ws;
};

DEV int get_tid() { int t = threadIdx.x; asm volatile("" : "+v"(t)); return t; }
DEV float bf2f(bf16_t h) { return __uint_as_float(((unsigned)h) << 16); }
DEV bf16_t f2bf(float f) { unsigned u = __float_as_uint(f); u += 0x7fffu + ((u >> 16) & 1u); return (bf16_t)(u >> 16); }
DEV unsigned pack2(float a, float b) { unsigned r; asm("v_cvt_pk_bf16_f32 %0, %1, %2" : "=v"(r) : "v"(a), "v"(b)); return r; }
DEV float sigm(float x) { return __builtin_amdgcn_rcpf(1.f + __expf(-x)); }
DEV float silu(float x) { return x * __builtin_amdgcn_rcpf(1.f + __expf(-x)); }
DEV float softplus(float x) { return x > 20.f ? x : log1pf(expf(x)); }
DEV float softplus_fast(float x) { const float e = __expf(x); return x > 15.f ? x : (e < 0.01f ? e * (1.f - e * (0.5f - e * 0.33333333f)) : __logf(1.f + e)); }
DEV float gelu_tanh(float x) { float u = 0.7978845608028654f * (x + 0.044715f * x * x * x); float t = 1.f - 2.f * __builtin_amdgcn_rcpf(1.f + __expf(2.f * u)); return 0.5f * x * (1.f + t); }
DEV f32x4 mfma16(bf16x8 a, bf16x8 b, f32x4 c) { return __builtin_amdgcn_mfma_f32_16x16x32_bf16(a, b, c, 0, 0, 0); }
DEV void mfma16a(f32x4& c, bf16x8 a, bf16x8 b) { asm volatile("v_mfma_f32_16x16x32_bf16 %0, %1, %2, %0" : "+a"(c) : "v"(a), "v"(b)); }
DEV float lo16(unsigned v) { return __uint_as_float(v << 16); }
DEV float hi16(unsigned v) { return __uint_as_float(v & 0xffff0000u); }

DEV bf16_t* wsb(const Params& p, size_t off) { return (bf16_t*)(p.ws + off); }
DEV float* wsf(const Params& p, size_t off) { return (float*)(p.ws + off); }
DEV float* hrow(const Params& p, int r) { int b = r / SB, s = r - b * SB; return s < CTXL ? wsf(p, O_HCTX) + (size_t)(b * CTXL + s) * D : p.out + (size_t)(b * SEQ + s - CTXL) * D; }
DEV const float* xrow(const Params& p, int r) { int b = r / SB, s = r - b * SB; return s < CTXL ? p.in[I_CTX] + (size_t)(b * CTXL + s) * D : p.in[I_X] + (size_t)(b * SEQ + s - CTXL) * D; }
DEV int modrow(int r) { int b = r / SB, s = r - b * SB; return s < CTXL ? 8 : b; }

template <int MT, int NT>
DEV void gemm_core(const bf16_t* __restrict__ A, int lda, const bf16_t* __restrict__ Bt, int ldb, int K, f32x4 (&acc)[MT][NT], bf16_t* smem_) {
    constexpr int SA = 32 * MT * GLD, SBB = 32 * NT * GLD;
    bf16_t* sA = smem_; bf16_t* sB = smem_ + 2 * SA;
    const int tid = get_tid(), lane = tid & 63, wv = tid >> 6, wr = wv >> 1, wc = wv & 1, l15 = lane & 15, quad = lane >> 4;
    const int lr = tid >> 3, lc = (tid & 7) * 8;
    u32x4 ra0[MT], rb0[NT], ra1[MT], rb1[NT];
    const bf16_t* Ap = A + (size_t)lr * lda + lc;
    const bf16_t* Bp = Bt + (size_t)lr * ldb + lc;
    const int nk = K >> 6;
#define GLOAD(RA, RB, KT) { const int ko_ = (KT) * 64; _Pragma("unroll") for (int i = 0; i < MT; ++i) RA[i] = *(const u32x4*)(Ap + (size_t)(32 * i) * lda + ko_); \
                            _Pragma("unroll") for (int i = 0; i < NT; ++i) RB[i] = *(const u32x4*)(Bp + (size_t)(32 * i) * ldb + ko_); }
#define LSTORE(RA, RB, BUF) { _Pragma("unroll") for (int i = 0; i < MT; ++i) *(u32x4*)(sA + (BUF) * SA + (lr + 32 * i) * GLD + lc) = RA[i]; \
                              _Pragma("unroll") for (int i = 0; i < NT; ++i) *(u32x4*)(sB + (BUF) * SBB + (lr + 32 * i) * GLD + lc) = RB[i]; }
#define COMPUTE(BUF) { _Pragma("unroll") for (int ks = 0; ks < 2; ++ks) { bf16x8 af[MT], bfr[NT]; \
        _Pragma("unroll") for (int mt = 0; mt < MT; ++mt) af[mt] = *(const bf16x8*)(sA + (BUF) * SA + (wr * MT * 16 + mt * 16 + l15) * GLD + ks * 32 + quad * 8); \
        _Pragma("unroll") for (int nt = 0; nt < NT; ++nt) bfr[nt] = *(const bf16x8*)(sB + (BUF) * SBB + (wc * NT * 16 + nt * 16 + l15) * GLD + ks * 32 + quad * 8); \
        _Pragma("unroll") for (int mt = 0; mt < MT; ++mt) _Pragma("unroll") for (int nt = 0; nt < NT; ++nt) mfma16a(acc[mt][nt], af[mt], bfr[nt]); } }
    GLOAD(ra0, rb0, 0);
    GLOAD(ra1, rb1, 1);
    __syncthreads();
    LSTORE(ra0, rb0, 0);
    GLOAD(ra0, rb0, 2);
    __syncthreads();
    int kt = 0;
#pragma unroll 1
    for (; kt + 4 < nk; kt += 2) {
        COMPUTE(0);
        LSTORE(ra1, rb1, 1);
        GLOAD(ra1, rb1, kt + 3);
        __syncthreads();
        COMPUTE(1);
        LSTORE(ra0, rb0, 0);
        GLOAD(ra0, rb0, kt + 4);
        __syncthreads();
    }
    COMPUTE(0);
    LSTORE(ra1, rb1, 1);
    GLOAD(ra1, rb1, kt + 3);
    __syncthreads();
    COMPUTE(1);
    LSTORE(ra0, rb0, 0);
    __syncthreads();
    COMPUTE(0);
    LSTORE(ra1, rb1, 1);
    __syncthreads();
    COMPUTE(1);
    __syncthreads();
#undef GLOAD
#undef LSTORE
#undef COMPUTE
    asm volatile("s_nop 15\n\ts_nop 15" ::: "memory");
}
template <int MT, int NT>
DEV void gemm_core1(const bf16_t* __restrict__ A, int lda, const bf16_t* __restrict__ Bt, int ldb, int K, f32x4 (&acc)[MT][NT], bf16_t* sA, bf16_t* sB) {
    const int tid = get_tid(), lane = tid & 63, wv = tid >> 6, wr = wv >> 1, wc = wv & 1, l15 = lane & 15, quad = lane >> 4;
    const int lr = tid >> 3, lc = (tid & 7) * 8;
    u32x4 ra[MT], rb[NT];
    const bf16_t* Ap = A + (size_t)lr * lda + lc;
    const bf16_t* Bp = Bt + (size_t)lr * ldb + lc;
#pragma unroll
    for (int i = 0; i < MT; ++i) ra[i] = *(const u32x4*)(Ap + (size_t)(32 * i) * lda);
#pragma unroll
    for (int i = 0; i < NT; ++i) rb[i] = *(const u32x4*)(Bp + (size_t)(32 * i) * ldb);
    const int nk = K >> 6;
    for (int kt = 0; kt < nk; ++kt) {
        __syncthreads();
#pragma unroll
        for (int i = 0; i < MT; ++i) *(u32x4*)(sA + (lr + 32 * i) * GLD + lc) = ra[i];
#pragma unroll
        for (int i = 0; i < NT; ++i) *(u32x4*)(sB + (lr + 32 * i) * GLD + lc) = rb[i];
        __syncthreads();
        if (kt + 1 < nk) {
            const int ko = (kt + 1) * 64;
#pragma unroll
            for (int i = 0; i < MT; ++i) ra[i] = *(const u32x4*)(Ap + (size_t)(32 * i) * lda + ko);
#pragma unroll
            for (int i = 0; i < NT; ++i) rb[i] = *(const u32x4*)(Bp + (size_t)(32 * i) * ldb + ko);
        }
#pragma unroll
        for (int ks = 0; ks < 2; ++ks) {
            bf16x8 af[MT], bfr[NT];
#pragma unroll
            for (int mt = 0; mt < MT; ++mt) af[mt] = *(const bf16x8*)(sA + (wr * MT * 16 + mt * 16 + l15) * GLD + ks * 32 + quad * 8);
#pragma unroll
            for (int nt = 0; nt < NT; ++nt) bfr[nt] = *(const bf16x8*)(sB + (wc * NT * 16 + nt * 16 + l15) * GLD + ks * 32 + quad * 8);
#pragma unroll
            for (int mt = 0; mt < MT; ++mt)
#pragma unroll
                for (int nt = 0; nt < NT; ++nt) mfma16a(acc[mt][nt], af[mt], bfr[nt]);
        }
    }
    asm volatile("s_nop 15\n\ts_nop 15" ::: "memory");
}
template <int MT, int NT>
DEV void zero_acc(f32x4 (&acc)[MT][NT]) {
#pragma unroll
    for (int mt = 0; mt < MT; ++mt)
#pragma unroll
        for (int nt = 0; nt < NT; ++nt) acc[mt][nt] = (f32x4){0.f, 0.f, 0.f, 0.f};
}

DEV void phase_mod(const Params& p, unsigned char* smem) {
    float* s_s = (float*)smem;
    float* red = s_s + 9 * 1024;
    const int tid = get_tid();
    bool loaded = false;
    for (int it = blockIdx.x; it < 2 * 96; it += gridDim.x) {
        if (!loaded) {
            for (int e = tid; e < 9 * 1024; e += 256) { float v = e < 8192 ? p.in[I_C][e] : p.in[I_CCTX][e - 8192]; s_s[e] = silu(v); }
            loaded = true;
        }
        __syncthreads();
        const int l = it / 96, cg_ = it % 96, cq = tid & 63, kq = tid >> 6, col = cg_ * 64 + cq;
        float acc[9];
#pragma unroll
        for (int r = 0; r < 9; ++r) acc[r] = 0.f;
        const float* wp = p.in[I_WMOD] + ((size_t)l * 1024 + kq * 256) * 6144 + col;
#pragma unroll 8
        for (int k = 0; k < 256; ++k) {
            float wv = wp[(size_t)k * 6144];
#pragma unroll
            for (int r = 0; r < 9; ++r) acc[r] += s_s[r * 1024 + kq * 256 + k] * wv;
        }
#pragma unroll
        for (int r = 0; r < 9; ++r) red[(kq * 9 + r) * 64 + cq] = acc[r];
        __syncthreads();
        for (int e = tid; e < 9 * 64; e += 256) {
            int r = e >> 6, c2 = e & 63;
            float v = red[(0 * 9 + r) * 64 + c2] + red[(1 * 9 + r) * 64 + c2] + red[(2 * 9 + r) * 64 + c2] + red[(3 * 9 + r) * 64 + c2];
            wsf(p, O_MOD)[((size_t)l * 9 + r) * 6144 + cg_ * 64 + c2] = v + p.in[I_BMOD][l * 6144 + cg_ * 64 + c2];
        }
        __syncthreads();
    }
}
DEV void phase_rope(const Params& p) {
    if (blockIdx.x == (gridDim.x - 1)) {
        for (int e = threadIdx.x; e < 1024; e += 256) {
            int pos = e >> 4, i = e & 15;
            float inv = powf(10000.f, -(float)i / 16.f);
            float ang = (float)pos * inv;
            float n = rintf(ang * 0.15915494309189535f);
            float r = fmaf(-n, 6.28125f, ang);
            r = fmaf(-n, 1.9353071795864769e-3f, r);
            wsf(p, O_ROPE)[e * 2] = cosf(r);
            wsf(p, O_ROPE)[e * 2 + 1] = sinf(r);
        }
    }
}
DEV void wconv_tile(const float* src0, const float* src1, int lds_, int K, bf16_t* dst, int kind, int kt, int nt, bf16_t* tile) {
    const int tid = get_tid();
    const int kk = tid >> 2, grp = tid & 3;
    const int n0 = nt * 64, k0 = kt * 64;
    const int ng = n0 + grp * 16;
    const float* src = src0; int sc;
    if (kind == 0) { sc = ng < 2048 ? ng : (ng < 4608 ? ng + 16 : (ng < 4624 ? 2048 : -1)); }
    else if (kind == 1) { sc = 4624 + ng; }
    else if (kind == 2) { sc = ng; }
    else { int gd = ng >> 4; src = (gd & 1) ? src1 : src0; sc = (gd >> 1) * 16; }
    __syncthreads();
    if (sc >= 0) {
        const float4* sp = (const float4*)(src + (size_t)(k0 + kk) * lds_ + sc);
#pragma unroll
        for (int q = 0; q < 4; ++q) { float4 v = sp[q]; int e = grp * 16 + q * 4;
            tile[(e + 0) * GLD + kk] = f2bf(v.x); tile[(e + 1) * GLD + kk] = f2bf(v.y); tile[(e + 2) * GLD + kk] = f2bf(v.z); tile[(e + 3) * GLD + kk] = f2bf(v.w); }
    } else {
#pragma unroll
        for (int e = 0; e < 16; ++e) tile[(grp * 16 + e) * GLD + kk] = 0;
    }
    __syncthreads();
    const int n = tid >> 2, kseg = (tid & 3) * 16;
    u32x4 a = *(const u32x4*)(tile + n * GLD + kseg), b = *(const u32x4*)(tile + n * GLD + kseg + 8);
    bf16_t* dp = dst + (size_t)(n0 + n) * K + k0 + kseg;
    *(u32x4*)dp = a; *(u32x4*)(dp + 8) = b;
}
DEV void phase_wconv(const Params& p, int l, unsigned char* smem) {
    bf16_t* tile = (bf16_t*)smem;
    bf16_t* W = wsb(p, O_WT);
    constexpr int T0 = 74 * 16, T1 = T0 + 48 * 16, T2 = T1 + 3 * 16 * 8, T3 = T2 + 16 * 16, T4 = T3 + 88 * 16, T5 = T4 + 16 * 44;
    for (int t = blockIdx.x; t < T5; t += gridDim.x) {
        if (t < T0) { wconv_tile(p.in[I_WIN] + (size_t)l * 1024 * 7696, nullptr, 7696, 1024, W + W_IN, 0, t % 16, t / 16, tile); }
        else if (t < T1) { int u = t - T0; wconv_tile(p.in[I_WIN] + (size_t)l * 1024 * 7696, nullptr, 7696, 1024, W + W_GATE, 1, u % 16, u / 16, tile); }
        else if (t < T2) { int u = t - T1; int n = u / 128, v = u % 128; wconv_tile(p.in[I_WBR] + ((size_t)l * 3 + n) * 512 * 1024, nullptr, 1024, 512, W + W_BR + (size_t)n * 1024 * 512, 2, v % 8, v / 8, tile); }
        else if (t < T3) { int u = t - T2; wconv_tile(p.in[I_WOUT] + (size_t)l * 1024 * 1024, nullptr, 1024, 1024, W + W_OUT, 2, u % 16, u / 16, tile); }
        else if (t < T4) { int u = t - T3; wconv_tile(p.in[I_WFG] + (size_t)l * 1024 * DFF, p.in[I_WFU] + (size_t)l * 1024 * DFF, DFF, 1024, W + W_GU, 3, u % 16, u / 16, tile); }
        else { int u = t - T4; wconv_tile(p.in[I_WFD] + (size_t)l * DFF * 1024, nullptr, 1024, DFF, W + W_DN, 2, u % 44, u / 44, tile); }
    }
}

DEV void norm_row(const Params& p, int l, int which, bool first, int r, int lane) {
    const float* h = first ? xrow(p, r) : hrow(p, r);
    const float* nw = p.in[which ? I_NFFN : I_NMIX] + l * D;
    const float* md = wsf(p, O_MOD) + ((size_t)l * 9 + modrow(r)) * 6144 + (which ? 3 * D : 0);
    float4 v[4]; float ss = 0.f;
#pragma unroll
    for (int i = 0; i < 4; ++i) { v[i] = *(const float4*)(h + i * 256 + lane * 4); ss += v[i].x * v[i].x + v[i].y * v[i].y + v[i].z * v[i].z + v[i].w * v[i].w; }
#pragma unroll
    for (int o = 32; o >= 1; o >>= 1) ss += __shfl_xor(ss, o);
    const float rstd = rsqrtf(ss * (1.f / D) + 1e-6f);
    bf16_t* up = wsb(p, O_U) + (size_t)r * D;
#pragma unroll
    for (int i = 0; i < 4; ++i) {
        const int c = i * 256 + lane * 4;
        float4 w4 = *(const float4*)(nw + c), sh = *(const float4*)(md + c), sc = *(const float4*)(md + D + c);
        float a = v[i].x * rstd * w4.x * (1.f + sc.x) + sh.x, b = v[i].y * rstd * w4.y * (1.f + sc.y) + sh.y;
        float c2 = v[i].z * rstd * w4.z * (1.f + sc.z) + sh.z, d = v[i].w * rstd * w4.w * (1.f + sc.w) + sh.w;
        u32x2 o; o.x = pack2(a, b); o.y = pack2(c2, d);
        *(u32x2*)(up + c) = o;
    }
}
DEV void phase_norm(const Params& p, int l, int which, bool first, bool skip_ctx) {
    const int tid_ = get_tid(); const int lane = tid_ & 63, wv = tid_ >> 6;
    for (int r = blockIdx.x * 4 + wv; r < MR; r += gridDim.x * 4) {
        if (skip_ctx && (r % SB) < CTXL) continue;
        norm_row(p, l, which, first, r, lane);
    }
}
DEV void phase_fin_norm(const Params& p, int l, bool first, bool skip_ctx) {
    const int tid_ = get_tid(); const int lane = tid_ & 63, wv = tid_ >> 6;
    const float* dnn = p.in[I_DNNORM] + l * 128;
    for (int r = blockIdx.x * 4 + wv; r < MR; r += gridDim.x * 4) {
        if (skip_ctx && (r % SB) < CTXL) continue;
        norm_row(p, l, 0, first, r, lane);
        bf16_t* ta = wsb(p, O_TA) + (size_t)r * 512 + lane * 8;
        const bf16_t* tb = wsb(p, O_TA2) + (size_t)r * 512 + lane * 8;
        const bf16_t* zz = wsb(p, O_P) + (size_t)r * PW + C_DNZ + lane * 8;
        u32x4 a = *(const u32x4*)ta, b = *(const u32x4*)tb, z = *(const u32x4*)zz;
        float o[8]; float ss = 0.f;
#pragma unroll
        for (int i = 0; i < 4; ++i) { o[2 * i] = lo16(a[i]) + lo16(b[i]); o[2 * i + 1] = hi16(a[i]) + hi16(b[i]); ss += o[2 * i] * o[2 * i] + o[2 * i + 1] * o[2 * i + 1]; }
#pragma unroll
        for (int of = 8; of >= 1; of >>= 1) ss += __shfl_xor(ss, of);
        const float rstd = rsqrtf(ss * (1.f / 128.f) + 1e-6f);
        const int dv0 = (lane & 15) * 8;
        u32x4 y;
#pragma unroll
        for (int i = 0; i < 4; ++i) {
            float y0 = o[2 * i] * rstd * dnn[dv0 + 2 * i] * silu(lo16(z[i]));
            float y1 = o[2 * i + 1] * rstd * dnn[dv0 + 2 * i + 1] * silu(hi16(z[i]));
            y[i] = pack2(y0, y1);
        }
        *(u32x4*)ta = y;
    }
}
DEV void phase_final(const Params& p) {
    const int tid_ = get_tid(); const int lane = tid_ & 63, wv = tid_ >> 6;
    const float* nw = p.in[I_NFIN];
    for (int r = blockIdx.x * 4 + wv; r < NB * SEQ; r += gridDim.x * 4) {
        float* h = p.out + (size_t)r * D;
        float4 v[4]; float ss = 0.f;
#pragma unroll
        for (int i = 0; i < 4; ++i) { v[i] = *(const float4*)(h + i * 256 + lane * 4); ss += v[i].x * v[i].x + v[i].y * v[i].y + v[i].z * v[i].z + v[i].w * v[i].w; }
#pragma unroll
        for (int o = 32; o >= 1; o >>= 1) ss += __shfl_xor(ss, o);
        const float rstd = rsqrtf(ss * (1.f / D) + 1e-6f);
#pragma unroll
        for (int i = 0; i < 4; ++i) {
            const int c = i * 256 + lane * 4;
            float4 w4 = *(const float4*)(nw + c);
            float4 o4; o4.x = v[i].x * rstd * w4.x; o4.y = v[i].y * rstd * w4.y; o4.z = v[i].z * rstd * w4.z; o4.w = v[i].w * rstd * w4.w;
            *(float4*)(h + c) = o4;
        }
    }
}

struct TileIter {
    int nn, total, nloc, L;
    DEV TileIter(int nm, int nn_) { nn = nn_; total = nm * nn_; nloc = gridDim.x >> 3; L = (blockIdx.x & 7) * nloc + (blockIdx.x >> 3); }
    DEV bool valid() const { return L < total; }
    DEV bool more() const { return (L - (int)(blockIdx.x >> 3)) < total; }
    DEV void next() { L += 8 * nloc; }
    DEV void get(int& tm, int& tn) const { const int pn = 4 * nn, panel = L / pn, rem = L - panel * pn; tn = rem >> 2; tm = panel * 4 + (rem & 3); }
};
DEV void phase_g1(const Params& p, unsigned char* smem) {
    bf16_t* sA = (bf16_t*)smem;
    const int tid = get_tid(), lane = tid & 63, wv = tid >> 6, wr = wv >> 1, wc = wv & 1, l15 = lane & 15, quad = lane >> 4;
    const bf16_t* U = wsb(p, O_U); const bf16_t* W = wsb(p, O_WT) + W_IN;
    bf16_t* P = wsb(p, O_P);
    const float* rope = wsf(p, O_ROPE);
    constexpr int NTN = NIN / 128;
    for (TileIter ti(MR / 256, NTN); ti.valid(); ti.next()) {
        int tm, tn; ti.get(tm, tn);
        const int row0 = tm * 256, col0 = tn * 128;
        f32x4 acc[8][4]; zero_acc(acc);
        gemm_core<8, 4>(U + (size_t)row0 * D, D, W + (size_t)col0 * D, D, D, acc, sA);
        if (tn < 24) {
#pragma unroll
            for (int mt = 0; mt < 8; ++mt)
#pragma unroll
                for (int nt = 0; nt < 4; ++nt)
#pragma unroll
                    for (int j = 0; j < 4; ++j) {
                        if (nt == 0 && j == 0) __builtin_amdgcn_sched_barrier(0);
                        const int row = row0 + wr * 128 + mt * 16 + quad * 4 + j, col = col0 + wc * 64 + nt * 16 + l15;
                        P[(size_t)row * PW + col] = f2bf(acc[mt][nt][j]);
                    }
        } else if (tn < 32) {
            const float qs = tn < 28 ? 0.125f : 1.f;
#pragma unroll
            for (int mt = 0; mt < 8; ++mt)
#pragma unroll
                for (int j = 0; j < 4; ++j) {
                    if (j == 0) __builtin_amdgcn_sched_barrier(0);
                    const int row = row0 + wr * 128 + mt * 16 + quad * 4 + j;
                    const int s = row % SB;
                    float c0 = 1.f, s0 = 0.f, c1 = 1.f, s1 = 0.f;
                    if (s >= CTXL) { const int tt = s - CTXL, pr = tt >> 6, pc = tt & 63;
                        c0 = rope[(pr * 16 + l15) * 2]; s0 = rope[(pr * 16 + l15) * 2 + 1]; c1 = rope[(pc * 16 + l15) * 2]; s1 = rope[(pc * 16 + l15) * 2 + 1]; }
                    const float x1 = acc[mt][0][j], x2 = acc[mt][1][j], y1 = acc[mt][2][j], y2 = acc[mt][3][j];
                    bf16_t* pp = P + (size_t)row * PW + col0 + wc * 64 + l15;
                    pp[0] = f2bf((x1 * c0 - x2 * s0) * qs);
                    pp[16] = f2bf((x2 * c0 + x1 * s0) * qs);
                    pp[32] = f2bf((y1 * c1 - y2 * s1) * qs);
                    pp[48] = f2bf((y2 * c1 + y1 * s1) * qs);
                }
        } else if (tn < 36) {
            bf16_t* VT = wsb(p, O_VT);
            const int b = row0 / SB, sbase = row0 - b * SB;
#pragma unroll
            for (int mt = 0; mt < 8; ++mt)
#pragma unroll
                for (int nt = 0; nt < 4; ++nt) {
                    if (nt == 0) __builtin_amdgcn_sched_barrier(0);
                    const int cc = col0 - 4096 + wc * 64 + nt * 16 + l15;
                    const int s = sbase + wr * 128 + mt * 16 + quad * 4;
                    u32x2 o; o.x = pack2(acc[mt][nt][0], acc[mt][nt][1]); o.y = pack2(acc[mt][nt][2], acc[mt][nt][3]);
                    *(u32x2*)(VT + ((size_t)(b * 512 + cc)) * SB + s) = o;
                }
        } else {
            if (wc == 0) {
                float* AB = wsf(p, O_AB);
#pragma unroll
                for (int mt = 0; mt < 8; ++mt)
#pragma unroll
                    for (int j = 0; j < 4; ++j) {
                        const int row = row0 + wr * 128 + mt * 16 + quad * 4 + j;
                        AB[(size_t)row * 16 + l15] = acc[mt][0][j];
                    }
            }
        }
    }
}

DEV int rowtile0(int ti, bool latent_only) { if (!latent_only) return ti * 256; int b = ti >> 4, tt = ti & 15; return b * SB + CTXL + tt * 256; }
DEV int sgcol(int n, int c) { return n < 2 ? n * 1024 + c : (c < 512 ? 2048 + c : 3584 + (c - 512)); }

DEV void phase_gate(const Params& p, bool latent_only, unsigned char* smem) {
    bf16_t* sA = (bf16_t*)smem;
    const int tid = get_tid(), lane = tid & 63, wv = tid >> 6, wr = wv >> 1, wc = wv & 1, l15 = lane & 15, quad = lane >> 4;
    const bf16_t* U = wsb(p, O_U); const bf16_t* W = wsb(p, O_WT) + W_GATE;
    bf16_t* P = wsb(p, O_P);
    const int nrt = latent_only ? 128 : 136;
    for (TileIter ti(nrt, 24); ti.valid(); ti.next()) {
        int tm, tn; ti.get(tm, tn);
        const int row0 = rowtile0(tm, latent_only);
        f32x4 acc[8][4]; zero_acc(acc);
        gemm_core<8, 4>(U + (size_t)row0 * D, D, W + (size_t)tn * 128 * D, D, D, acc, sA);
        const int dcol0 = sgcol(tn >> 3, (tn & 7) * 128);
#pragma unroll
        for (int mt = 0; mt < 8; ++mt)
#pragma unroll
            for (int nt = 0; nt < 4; ++nt)
#pragma unroll
                for (int j = 0; j < 4; ++j) {
                    if (nt == 0 && j == 0) __builtin_amdgcn_sched_barrier(0);
                    const int row = row0 + wr * 128 + mt * 16 + quad * 4 + j, col = dcol0 + wc * 64 + nt * 16 + l15;
                    P[(size_t)row * PW + col] = f2bf(sigm(acc[mt][nt][j]));
                }
    }
}

DEV void phase_merge(const Params& p, bool latent_only, unsigned char* smem) {
    bf16_t* sA = (bf16_t*)smem;
    const int tid = get_tid(), lane = tid & 63, wv = tid >> 6, wr = wv >> 1, wc = wv & 1, l15 = lane & 15, quad = lane >> 4;
    const bf16_t* W = wsb(p, O_WT);
    const bf16_t* P = wsb(p, O_P);
    bf16_t* U = wsb(p, O_U);
    const int nrt = latent_only ? 128 : 136;
    for (TileIter ti(nrt, 8); ti.valid(); ti.next()) {
        int tm, tn; ti.get(tm, tn);
        const int row0 = rowtile0(tm, latent_only), col0 = tn * 128;
        f32x4 m[8][4]; zero_acc(m);
#pragma unroll 1
        for (int n = 0; n < 3; ++n) {
            f32x4 au[8][4]; zero_acc(au);
            const bf16_t* Y; int ldy;
            if (n == 0) { Y = wsb(p, O_TA) + (size_t)row0 * 512; ldy = 512; }
            else if (n == 1) { Y = P + (size_t)row0 * PW + C_LG; ldy = PW; }
            else { Y = P + (size_t)row0 * PW + C_DAQ; ldy = PW; }
            gemm_core1<8, 4>(Y, ldy, W + W_BR + ((size_t)n * 1024 + col0) * 512, 512, 512, au, sA, sA + 256 * GLD);
            const int sc0 = sgcol(n, col0);
#pragma unroll
            for (int mt = 0; mt < 8; ++mt)
#pragma unroll
                for (int nt = 0; nt < 4; ++nt)
#pragma unroll
                    for (int j = 0; j < 4; ++j) {
                        if (nt == 0 && j == 0) __builtin_amdgcn_sched_barrier(0);
                        const int row = row0 + wr * 128 + mt * 16 + quad * 4 + j, col = sc0 + wc * 64 + nt * 16 + l15;
                        m[mt][nt][j] += bf2f(P[(size_t)row * PW + col]) * au[mt][nt][j];
                    }
        }
#pragma unroll
        for (int mt = 0; mt < 8; ++mt)
#pragma unroll
            for (int nt = 0; nt < 4; ++nt)
#pragma unroll
                for (int j = 0; j < 4; ++j) {
                    if (nt == 0 && j == 0) __builtin_amdgcn_sched_barrier(0);
                    const int row = row0 + wr * 128 + mt * 16 + quad * 4 + j, col = col0 + wc * 64 + nt * 16 + l15;
                    U[(size_t)row * D + col] = f2bf(m[mt][nt][j]);
                }
    }
}

DEV void phase_resid(const Params& p, int l, const bf16_t* A, int lda, const bf16_t* Wt, int K, int chunk, bool first, bool latent_only, unsigned char* smem) {
    bf16_t* sA = (bf16_t*)smem;
    const int tid = get_tid(), lane = tid & 63, wv = tid >> 6, wr = wv >> 1, wc = wv & 1, l15 = lane & 15, quad = lane >> 4;
    const int nrt = latent_only ? 128 : 136;
    for (TileIter ti(nrt, 8); ti.valid(); ti.next()) {
        int tm, tn; ti.get(tm, tn);
        const int row0 = rowtile0(tm, latent_only), col0 = tn * 128;
        f32x4 acc[8][4]; zero_acc(acc);
        gemm_core<8, 4>(A + (size_t)row0 * lda, lda, Wt + (size_t)col0 * K, K, K, acc, sA);
        const float* md = wsf(p, O_MOD) + ((size_t)l * 9 + modrow(row0)) * 6144 + chunk * D;
        const float* hs0 = first ? xrow(p, row0) : hrow(p, row0);
        float* hd0 = hrow(p, row0);
#pragma unroll
        for (int mt = 0; mt < 8; ++mt)
#pragma unroll
            for (int j = 0; j < 4; ++j) {
                if (j == 0) __builtin_amdgcn_sched_barrier(0);
                const int rl = wr * 128 + mt * 16 + quad * 4 + j;
                const float* hs = hs0 + (size_t)rl * D;
                float* hd = hd0 + (size_t)rl * D;
#pragma unroll
                for (int nt = 0; nt < 4; ++nt) { const int col = col0 + wc * 64 + nt * 16 + l15; hd[col] = hs[col] + md[col] * acc[mt][nt][j]; }
            }
    }
}
DEV void phase_gu(const Params& p, bool latent_only, unsigned char* smem) {
    bf16_t* sA = (bf16_t*)smem;
    const int tid = get_tid(), lane = tid & 63, wv = tid >> 6, wr = wv >> 1, wc = wv & 1, l15 = lane & 15, quad = lane >> 4;
    const bf16_t* U = wsb(p, O_U); const bf16_t* W = wsb(p, O_WT) + W_GU;
    bf16_t* P = wsb(p, O_P);
    const int nrt = latent_only ? 128 : 136;
    for (TileIter ti(nrt, 44); ti.valid(); ti.next()) {
        int tm, tn; ti.get(tm, tn);
        const int row0 = rowtile0(tm, latent_only);
        f32x4 acc[8][4]; zero_acc(acc);
        gemm_core<8, 4>(U + (size_t)row0 * D, D, W + (size_t)tn * 128 * D, D, D, acc, sA);
#pragma unroll
        for (int mt = 0; mt < 8; ++mt)
#pragma unroll
            for (int pr = 0; pr < 2; ++pr)
#pragma unroll
                for (int j = 0; j < 4; ++j) {
                    if (pr == 0 && j == 0) __builtin_amdgcn_sched_barrier(0);
                    const int row = row0 + wr * 128 + mt * 16 + quad * 4 + j, hc = (tn * 4 + wc * 2 + pr) * 16 + l15;
                    P[(size_t)row * PW + hc] = f2bf(silu(acc[mt][2 * pr][j]) * acc[mt][2 * pr + 1][j]);
                }
    }
}

DEV int chunk_of(int dir, int n) { return dir ? (n < 4 ? 3 - n : 71 - n) : n; }

typedef float f32x2 __attribute__((ext_vector_type(2)));
DEV void dn_solve(const float* __restrict__ Lt_s0, const bf16_t* __restrict__ colp, const float* __restrict__ mulp0, const float sg, bf16_t* __restrict__ outp) {
    int vz = 0; asm volatile("" : "+v"(vz));
    const float* __restrict__ Lt_s = Lt_s0 + vz; const float* __restrict__ mulp = mulp0 + vz;
    f32x2 X0, X1, X2, X3, X4, X5, X6, X7, X8, X9, X10, X11, X12, X13, X14, X15, X16, X17, X18, X19, X20, X21, X22, X23, X24, X25, X26, X27, X28, X29, X30, X31;
    f32x4 La0, La1, La2, La3, La4, La5, La6, La7, La8, La9, La10, La11, La12, La13, La14, La15, Lb0, Lb1, Lb2, Lb3, Lb4, Lb5, Lb6, Lb7, Lb8, Lb9, Lb10, Lb11, Lb12, Lb13, Lb14, Lb15;
    X0 = (f32x2){bf2f(colp[0]) * mulp[0], bf2f(colp[136]) * mulp[1]};
    X1 = (f32x2){bf2f(colp[272]) * mulp[2], bf2f(colp[408]) * mulp[3]};
    X2 = (f32x2){bf2f(colp[544]) * mulp[4], bf2f(colp[680]) * mulp[5]};
    X3 = (f32x2){bf2f(colp[816]) * mulp[6], bf2f(colp[952]) * mulp[7]};
    X4 = (f32x2){bf2f(colp[1088]) * mulp[8], bf2f(colp[1224]) * mulp[9]};
    X5 = (f32x2){bf2f(colp[1360]) * mulp[10], bf2f(colp[1496]) * mulp[11]};
    X6 = (f32x2){bf2f(colp[1632]) * mulp[12], bf2f(colp[1768]) * mulp[13]};
    X7 = (f32x2){bf2f(colp[1904]) * mulp[14], bf2f(colp[2040]) * mulp[15]};
    X8 = (f32x2){bf2f(colp[2176]) * mulp[16], bf2f(colp[2312]) * mulp[17]};
    X9 = (f32x2){bf2f(colp[2448]) * mulp[18], bf2f(colp[2584]) * mulp[19]};
    X10 = (f32x2){bf2f(colp[2720]) * mulp[20], bf2f(colp[2856]) * mulp[21]};
    X11 = (f32x2){bf2f(colp[2992]) * mulp[22], bf2f(colp[3128]) * mulp[23]};
    X12 = (f32x2){bf2f(colp[3264]) * mulp[24], bf2f(colp[3400]) * mulp[25]};
    X13 = (f32x2){bf2f(colp[3536]) * mulp[26], bf2f(colp[3672]) * mulp[27]};
    X14 = (f32x2){bf2f(colp[3808]) * mulp[28], bf2f(colp[3944]) * mulp[29]};
    X15 = (f32x2){bf2f(colp[4080]) * mulp[30], bf2f(colp[4216]) * mulp[31]};
    X16 = (f32x2){bf2f(colp[4352]) * mulp[32], bf2f(colp[4488]) * mulp[33]};
    X17 = (f32x2){bf2f(colp[4624]) * mulp[34], bf2f(colp[4760]) * mulp[35]};
    X18 = (f32x2){bf2f(colp[4896]) * mulp[36], bf2f(colp[5032]) * mulp[37]};
    X19 = (f32x2){bf2f(colp[5168]) * mulp[38], bf2f(colp[5304]) * mulp[39]};
    X20 = (f32x2){bf2f(colp[5440]) * mulp[40], bf2f(colp[5576]) * mulp[41]};
    X21 = (f32x2){bf2f(colp[5712]) * mulp[42], bf2f(colp[5848]) * mulp[43]};
    X22 = (f32x2){bf2f(colp[5984]) * mulp[44], bf2f(colp[6120]) * mulp[45]};
    X23 = (f32x2){bf2f(colp[6256]) * mulp[46], bf2f(colp[6392]) * mulp[47]};
    X24 = (f32x2){bf2f(colp[6528]) * mulp[48], bf2f(colp[6664]) * mulp[49]};
    X25 = (f32x2){bf2f(colp[6800]) * mulp[50], bf2f(colp[6936]) * mulp[51]};
    X26 = (f32x2){bf2f(colp[7072]) * mulp[52], bf2f(colp[7208]) * mulp[53]};
    X27 = (f32x2){bf2f(colp[7344]) * mulp[54], bf2f(colp[7480]) * mulp[55]};
    X28 = (f32x2){bf2f(colp[7616]) * mulp[56], bf2f(colp[7752]) * mulp[57]};
    X29 = (f32x2){bf2f(colp[7888]) * mulp[58], bf2f(colp[8024]) * mulp[59]};
    X30 = (f32x2){bf2f(colp[8160]) * mulp[60], bf2f(colp[8296]) * mulp[61]};
    X31 = (f32x2){bf2f(colp[8432]) * mulp[62], bf2f(colp[8568]) * mulp[63]};
    La0 = *(const f32x4*)(Lt_s + 0);
    La1 = *(const f32x4*)(Lt_s + 4);
    La2 = *(const f32x4*)(Lt_s + 8);
    La3 = *(const f32x4*)(Lt_s + 12);
    La4 = *(const f32x4*)(Lt_s + 16);
    La5 = *(const f32x4*)(Lt_s + 20);
    La6 = *(const f32x4*)(Lt_s + 24);
    La7 = *(const f32x4*)(Lt_s + 28);
    La8 = *(const f32x4*)(Lt_s + 32);
    La9 = *(const f32x4*)(Lt_s + 36);
    La10 = *(const f32x4*)(Lt_s + 40);
    La11 = *(const f32x4*)(Lt_s + 44);
    La12 = *(const f32x4*)(Lt_s + 48);
    La13 = *(const f32x4*)(Lt_s + 52);
    La14 = *(const f32x4*)(Lt_s + 56);
    La15 = *(const f32x4*)(Lt_s + 60);
    Lb0 = *(const f32x4*)(Lt_s + 68);
    Lb1 = *(const f32x4*)(Lt_s + 72);
    Lb2 = *(const f32x4*)(Lt_s + 76);
    Lb3 = *(const f32x4*)(Lt_s + 80);
    Lb4 = *(const f32x4*)(Lt_s + 84);
    Lb5 = *(const f32x4*)(Lt_s + 88);
    Lb6 = *(const f32x4*)(Lt_s + 92);
    Lb7 = *(const f32x4*)(Lt_s + 96);
    Lb8 = *(const f32x4*)(Lt_s + 100);
    Lb9 = *(const f32x4*)(Lt_s + 104);
    Lb10 = *(const f32x4*)(Lt_s + 108);
    Lb11 = *(const f32x4*)(Lt_s + 112);
    Lb12 = *(const f32x4*)(Lt_s + 116);
    Lb13 = *(const f32x4*)(Lt_s + 120);
    Lb14 = *(const f32x4*)(Lt_s + 124);
    Lb15 = *(const f32x4*)(Lt_s + 128);
    __builtin_amdgcn_sched_barrier(0);
    { const float xj = X0[0]; const f32x2 xj2 = (f32x2){xj, xj};
      X0 -= (f32x2){La0[0], La0[1]} * xj2;
      X1 -= (f32x2){La0[2], La0[3]} * xj2;
      X2 -= (f32x2){La1[0], La1[1]} * xj2;
      X3 -= (f32x2){La1[2], La1[3]} * xj2;
      X4 -= (f32x2){La2[0], La2[1]} * xj2;
      X5 -= (f32x2){La2[2], La2[3]} * xj2;
      X6 -= (f32x2){La3[0], La3[1]} * xj2;
      X7 -= (f32x2){La3[2], La3[3]} * xj2;
      X8 -= (f32x2){La4[0], La4[1]} * xj2;
      X9 -= (f32x2){La4[2], La4[3]} * xj2;
      X10 -= (f32x2){La5[0], La5[1]} * xj2;
      X11 -= (f32x2){La5[2], La5[3]} * xj2;
      X12 -= (f32x2){La6[0], La6[1]} * xj2;
      X13 -= (f32x2){La6[2], La6[3]} * xj2;
      X14 -= (f32x2){La7[0], La7[1]} * xj2;
      X15 -= (f32x2){La7[2], La7[3]} * xj2;
      X16 -= (f32x2){La8[0], La8[1]} * xj2;
      X17 -= (f32x2){La8[2], La8[3]} * xj2;
      X18 -= (f32x2){La9[0], La9[1]} * xj2;
      X19 -= (f32x2){La9[2], La9[3]} * xj2;
      X20 -= (f32x2){La10[0], La10[1]} * xj2;
      X21 -= (f32x2){La10[2], La10[3]} * xj2;
      X22 -= (f32x2){La11[0], La11[1]} * xj2;
      X23 -= (f32x2){La11[2], La11[3]} * xj2;
      X24 -= (f32x2){La12[0], La12[1]} * xj2;
      X25 -= (f32x2){La12[2], La12[3]} * xj2;
      X26 -= (f32x2){La13[0], La13[1]} * xj2;
      X27 -= (f32x2){La13[2], La13[3]} * xj2;
      X28 -= (f32x2){La14[0], La14[1]} * xj2;
      X29 -= (f32x2){La14[2], La14[3]} * xj2;
      X30 -= (f32x2){La15[0], La15[1]} * xj2;
      X31 -= (f32x2){La15[2], La15[3]} * xj2;
    }
    __builtin_amdgcn_sched_barrier(0);
    La0 = *(const f32x4*)(Lt_s + 136);
    La1 = *(const f32x4*)(Lt_s + 140);
    La2 = *(const f32x4*)(Lt_s + 144);
    La3 = *(const f32x4*)(Lt_s + 148);
    La4 = *(const f32x4*)(Lt_s + 152);
    La5 = *(const f32x4*)(Lt_s + 156);
    La6 = *(const f32x4*)(Lt_s + 160);
    La7 = *(const f32x4*)(Lt_s + 164);
    La8 = *(const f32x4*)(Lt_s + 168);
    La9 = *(const f32x4*)(Lt_s + 172);
    La10 = *(const f32x4*)(Lt_s + 176);
    La11 = *(const f32x4*)(Lt_s + 180);
    La12 = *(const f32x4*)(Lt_s + 184);
    La13 = *(const f32x4*)(Lt_s + 188);
    La14 = *(const f32x4*)(Lt_s + 192);
    La15 = *(const f32x4*)(Lt_s + 196);
    __builtin_amdgcn_sched_barrier(0);
    { const float xj = X0[1]; const f32x2 xj2 = (f32x2){xj, xj};
      X1 -= (f32x2){Lb0[2], Lb0[3]} * xj2;
      X2 -= (f32x2){Lb1[0], Lb1[1]} * xj2;
      X3 -= (f32x2){Lb1[2], Lb1[3]} * xj2;
      X4 -= (f32x2){Lb2[0], Lb2[1]} * xj2;
      X5 -= (f32x2){Lb2[2], Lb2[3]} * xj2;
      X6 -= (f32x2){Lb3[0], Lb3[1]} * xj2;
      X7 -= (f32x2){Lb3[2], Lb3[3]} * xj2;
      X8 -= (f32x2){Lb4[0], Lb4[1]} * xj2;
      X9 -= (f32x2){Lb4[2], Lb4[3]} * xj2;
      X10 -= (f32x2){Lb5[0], Lb5[1]} * xj2;
      X11 -= (f32x2){Lb5[2], Lb5[3]} * xj2;
      X12 -= (f32x2){Lb6[0], Lb6[1]} * xj2;
      X13 -= (f32x2){Lb6[2], Lb6[3]} * xj2;
      X14 -= (f32x2){Lb7[0], Lb7[1]} * xj2;
      X15 -= (f32x2){Lb7[2], Lb7[3]} * xj2;
      X16 -= (f32x2){Lb8[0], Lb8[1]} * xj2;
      X17 -= (f32x2){Lb8[2], Lb8[3]} * xj2;
      X18 -= (f32x2){Lb9[0], Lb9[1]} * xj2;
      X19 -= (f32x2){Lb9[2], Lb9[3]} * xj2;
      X20 -= (f32x2){Lb10[0], Lb10[1]} * xj2;
      X21 -= (f32x2){Lb10[2], Lb10[3]} * xj2;
      X22 -= (f32x2){Lb11[0], Lb11[1]} * xj2;
      X23 -= (f32x2){Lb11[2], Lb11[3]} * xj2;
      X24 -= (f32x2){Lb12[0], Lb12[1]} * xj2;
      X25 -= (f32x2){Lb12[2], Lb12[3]} * xj2;
      X26 -= (f32x2){Lb13[0], Lb13[1]} * xj2;
      X27 -= (f32x2){Lb13[2], Lb13[3]} * xj2;
      X28 -= (f32x2){Lb14[0], Lb14[1]} * xj2;
      X29 -= (f32x2){Lb14[2], Lb14[3]} * xj2;
      X30 -= (f32x2){Lb15[0], Lb15[1]} * xj2;
      X31 -= (f32x2){Lb15[2], Lb15[3]} * xj2;
    }
    __builtin_amdgcn_sched_barrier(0);
    Lb1 = *(const f32x4*)(Lt_s + 208);
    Lb2 = *(const f32x4*)(Lt_s + 212);
    Lb3 = *(const f32x4*)(Lt_s + 216);
    Lb4 = *(const f32x4*)(Lt_s + 220);
    Lb5 = *(const f32x4*)(Lt_s + 224);
    Lb6 = *(const f32x4*)(Lt_s + 228);
    Lb7 = *(const f32x4*)(Lt_s + 232);
    Lb8 = *(const f32x4*)(Lt_s + 236);
    Lb9 = *(const f32x4*)(Lt_s + 240);
    Lb10 = *(const f32x4*)(Lt_s + 244);
    Lb11 = *(const f32x4*)(Lt_s + 248);
    Lb12 = *(const f32x4*)(Lt_s + 252);
    Lb13 = *(const f32x4*)(Lt_s + 256);
    Lb14 = *(const f32x4*)(Lt_s + 260);
    Lb15 = *(const f32x4*)(Lt_s + 264);
    __builtin_amdgcn_sched_barrier(0);
    { const float xj = X1[0]; const f32x2 xj2 = (f32x2){xj, xj};
      X1 -= (f32x2){La0[2], La0[3]} * xj2;
      X2 -= (f32x2){La1[0], La1[1]} * xj2;
      X3 -= (f32x2){La1[2], La1[3]} * xj2;
      X4 -= (f32x2){La2[0], La2[1]} * xj2;
      X5 -= (f32x2){La2[2], La2[3]} * xj2;
      X6 -= (f32x2){La3[0], La3[1]} * xj2;
      X7 -= (f32x2){La3[2], La3[3]} * xj2;
      X8 -= (f32x2){La4[0], La4[1]} * xj2;
      X9 -= (f32x2){La4[2], La4[3]} * xj2;
      X10 -= (f32x2){La5[0], La5[1]} * xj2;
      X11 -= (f32x2){La5[2], La5[3]} * xj2;
      X12 -= (f32x2){La6[0], La6[1]} * xj2;
      X13 -= (f32x2){La6[2], La6[3]} * xj2;
      X14 -= (f32x2){La7[0], La7[1]} * xj2;
      X15 -= (f32x2){La7[2], La7[3]} * xj2;
      X16 -= (f32x2){La8[0], La8[1]} * xj2;
      X17 -= (f32x2){La8[2], La8[3]} * xj2;
      X18 -= (f32x2){La9[0], La9[1]} * xj2;
      X19 -= (f32x2){La9[2], La9[3]} * xj2;
      X20 -= (f32x2){La10[0], La10[1]} * xj2;
      X21 -= (f32x2){La10[2], La10[3]} * xj2;
      X22 -= (f32x2){La11[0], La11[1]} * xj2;
      X23 -= (f32x2){La11[2], La11[3]} * xj2;
      X24 -= (f32x2){La12[0], La12[1]} * xj2;
      X25 -= (f32x2){La12[2], La12[3]} * xj2;
      X26 -= (f32x2){La13[0], La13[1]} * xj2;
      X27 -= (f32x2){La13[2], La13[3]} * xj2;
      X28 -= (f32x2){La14[0], La14[1]} * xj2;
      X29 -= (f32x2){La14[2], La14[3]} * xj2;
      X30 -= (f32x2){La15[0], La15[1]} * xj2;
      X31 -= (f32x2){La15[2], La15[3]} * xj2;
    }
    __builtin_amdgcn_sched_barrier(0);
    La1 = *(const f32x4*)(Lt_s + 276);
    La2 = *(const f32x4*)(Lt_s + 280);
    La3 = *(const f32x4*)(Lt_s + 284);
    La4 = *(const f32x4*)(Lt_s + 288);
    La5 = *(const f32x4*)(Lt_s + 292);
    La6 = *(const f32x4*)(Lt_s + 296);
    La7 = *(const f32x4*)(Lt_s + 300);
    La8 = *(const f32x4*)(Lt_s + 304);
    La9 = *(const f32x4*)(Lt_s + 308);
    La10 = *(const f32x4*)(Lt_s + 312);
    La11 = *(const f32x4*)(Lt_s + 316);
    La12 = *(const f32x4*)(Lt_s + 320);
    La13 = *(const f32x4*)(Lt_s + 324);
    La14 = *(const f32x4*)(Lt_s + 328);
    La15 = *(const f32x4*)(Lt_s + 332);
    __builtin_amdgcn_sched_barrier(0);
    { const float xj = X1[1]; const f32x2 xj2 = (f32x2){xj, xj};
      X2 -= (f32x2){Lb1[0], Lb1[1]} * xj2;
      X3 -= (f32x2){Lb1[2], Lb1[3]} * xj2;
      X4 -= (f32x2){Lb2[0], Lb2[1]} * xj2;
      X5 -= (f32x2){Lb2[2], Lb2[3]} * xj2;
      X6 -= (f32x2){Lb3[0], Lb3[1]} * xj2;
      X7 -= (f32x2){Lb3[2], Lb3[3]} * xj2;
      X8 -= (f32x2){Lb4[0], Lb4[1]} * xj2;
      X9 -= (f32x2){Lb4[2], Lb4[3]} * xj2;
      X10 -= (f32x2){Lb5[0], Lb5[1]} * xj2;
      X11 -= (f32x2){Lb5[2], Lb5[3]} * xj2;
      X12 -= (f32x2){Lb6[0], Lb6[1]} * xj2;
      X13 -= (f32x2){Lb6[2], Lb6[3]} * xj2;
      X14 -= (f32x2){Lb7[0], Lb7[1]} * xj2;
      X15 -= (f32x2){Lb7[2], Lb7[3]} * xj2;
      X16 -= (f32x2){Lb8[0], Lb8[1]} * xj2;
      X17 -= (f32x2){Lb8[2], Lb8[3]} * xj2;
      X18 -= (f32x2){Lb9[0], Lb9[1]} * xj2;
      X19 -= (f32x2){Lb9[2], Lb9[3]} * xj2;
      X20 -= (f32x2){Lb10[0], Lb10[1]} * xj2;
      X21 -= (f32x2){Lb10[2], Lb10[3]} * xj2;
      X22 -= (f32x2){Lb11[0], Lb11[1]} * xj2;
      X23 -= (f32x2){Lb11[2], Lb11[3]} * xj2;
      X24 -= (f32x2){Lb12[0], Lb12[1]} * xj2;
      X25 -= (f32x2){Lb12[2], Lb12[3]} * xj2;
      X26 -= (f32x2){Lb13[0], Lb13[1]} * xj2;
      X27 -= (f32x2){Lb13[2], Lb13[3]} * xj2;
      X28 -= (f32x2){Lb14[0], Lb14[1]} * xj2;
      X29 -= (f32x2){Lb14[2], Lb14[3]} * xj2;
      X30 -= (f32x2){Lb15[0], Lb15[1]} * xj2;
      X31 -= (f32x2){Lb15[2], Lb15[3]} * xj2;
    }
    __builtin_amdgcn_sched_barrier(0);
    Lb1 = *(const f32x4*)(Lt_s + 344);
    Lb2 = *(const f32x4*)(Lt_s + 348);
    Lb3 = *(const f32x4*)(Lt_s + 352);
    Lb4 = *(const f32x4*)(Lt_s + 356);
    Lb5 = *(const f32x4*)(Lt_s + 360);
    Lb6 = *(const f32x4*)(Lt_s + 364);
    Lb7 = *(const f32x4*)(Lt_s + 368);
    Lb8 = *(const f32x4*)(Lt_s + 372);
    Lb9 = *(const f32x4*)(Lt_s + 376);
    Lb10 = *(const f32x4*)(Lt_s + 380);
    Lb11 = *(const f32x4*)(Lt_s + 384);
    Lb12 = *(const f32x4*)(Lt_s + 388);
    Lb13 = *(const f32x4*)(Lt_s + 392);
    Lb14 = *(const f32x4*)(Lt_s + 396);
    Lb15 = *(const f32x4*)(Lt_s + 400);
    __builtin_amdgcn_sched_barrier(0);
    { const float xj = X2[0]; const f32x2 xj2 = (f32x2){xj, xj};
      X2 -= (f32x2){La1[0], La1[1]} * xj2;
      X3 -= (f32x2){La1[2], La1[3]} * xj2;
      X4 -= (f32x2){La2[0], La2[1]} * xj2;
      X5 -= (f32x2){La2[2], La2[3]} * xj2;
      X6 -= (f32x2){La3[0], La3[1]} * xj2;
      X7 -= (f32x2){La3[2], La3[3]} * xj2;
      X8 -= (f32x2){La4[0], La4[1]} * xj2;
      X9 -= (f32x2){La4[2], La4[3]} * xj2;
      X10 -= (f32x2){La5[0], La5[1]} * xj2;
      X11 -= (f32x2){La5[2], La5[3]} * xj2;
      X12 -= (f32x2){La6[0], La6[1]} * xj2;
      X13 -= (f32x2){La6[2], La6[3]} * xj2;
      X14 -= (f32x2){La7[0], La7[1]} * xj2;
      X15 -= (f32x2){La7[2], La7[3]} * xj2;
      X16 -= (f32x2){La8[0], La8[1]} * xj2;
      X17 -= (f32x2){La8[2], La8[3]} * xj2;
      X18 -= (f32x2){La9[0], La9[1]} * xj2;
      X19 -= (f32x2){La9[2], La9[3]} * xj2;
      X20 -= (f32x2){La10[0], La10[1]} * xj2;
      X21 -= (f32x2){La10[2], La10[3]} * xj2;
      X22 -= (f32x2){La11[0], La11[1]} * xj2;
      X23 -= (f32x2){La11[2], La11[3]} * xj2;
      X24 -= (f32x2){La12[0], La12[1]} * xj2;
      X25 -= (f32x2){La12[2], La12[3]} * xj2;
      X26 -= (f32x2){La13[0], La13[1]} * xj2;
      X27 -= (f32x2){La13[2], La13[3]} * xj2;
      X28 -= (f32x2){La14[0], La14[1]} * xj2;
      X29 -= (f32x2){La14[2], La14[3]} * xj2;
      X30 -= (f32x2){La15[0], La15[1]} * xj2;
      X31 -= (f32x2){La15[2], La15[3]} * xj2;
    }
    __builtin_amdgcn_sched_barrier(0);
    La1 = *(const f32x4*)(Lt_s + 412);
    La2 = *(const f32x4*)(Lt_s + 416);
    La3 = *(const f32x4*)(Lt_s + 420);
    La4 = *(const f32x4*)(Lt_s + 424);
    La5 = *(const f32x4*)(Lt_s + 428);
    La6 = *(const f32x4*)(Lt_s + 432);
    La7 = *(const f32x4*)(Lt_s + 436);
    La8 = *(const f32x4*)(Lt_s + 440);
    La9 = *(const f32x4*)(Lt_s + 444);
    La10 = *(const f32x4*)(Lt_s + 448);
    La11 = *(const f32x4*)(Lt_s + 452);
    La12 = *(const f32x4*)(Lt_s + 456);
    La13 = *(const f32x4*)(Lt_s + 460);
    La14 = *(const f32x4*)(Lt_s + 464);
    La15 = *(const f32x4*)(Lt_s + 468);
    __builtin_amdgcn_sched_barrier(0);
    { const float xj = X2[1]; const f32x2 xj2 = (f32x2){xj, xj};
      X3 -= (f32x2){Lb1[2], Lb1[3]} * xj2;
      X4 -= (f32x2){Lb2[0], Lb2[1]} * xj2;
      X5 -= (f32x2){Lb2[2], Lb2[3]} * xj2;
      X6 -= (f32x2){Lb3[0], Lb3[1]} * xj2;
      X7 -= (f32x2){Lb3[2], Lb3[3]} * xj2;
      X8 -= (f32x2){Lb4[0], Lb4[1]} * xj2;
      X9 -= (f32x2){Lb4[2], Lb4[3]} * xj2;
      X10 -= (f32x2){Lb5[0], Lb5[1]} * xj2;
      X11 -= (f32x2){Lb5[2], Lb5[3]} * xj2;
      X12 -= (f32x2){Lb6[0], Lb6[1]} * xj2;
      X13 -= (f32x2){Lb6[2], Lb6[3]} * xj2;
      X14 -= (f32x2){Lb7[0], Lb7[1]} * xj2;
      X15 -= (f32x2){Lb7[2], Lb7[3]} * xj2;
      X16 -= (f32x2){Lb8[0], Lb8[1]} * xj2;
      X17 -= (f32x2){Lb8[2], Lb8[3]} * xj2;
      X18 -= (f32x2){Lb9[0], Lb9[1]} * xj2;
      X19 -= (f32x2){Lb9[2], Lb9[3]} * xj2;
      X20 -= (f32x2){Lb10[0], Lb10[1]} * xj2;
      X21 -= (f32x2){Lb10[2], Lb10[3]} * xj2;
      X22 -= (f32x2){Lb11[0], Lb11[1]} * xj2;
      X23 -= (f32x2){Lb11[2], Lb11[3]} * xj2;
      X24 -= (f32x2){Lb12[0], Lb12[1]} * xj2;
      X25 -= (f32x2){Lb12[2], Lb12[3]} * xj2;
      X26 -= (f32x2){Lb13[0], Lb13[1]} * xj2;
      X27 -= (f32x2){Lb13[2], Lb13[3]} * xj2;
      X28 -= (f32x2){Lb14[0], Lb14[1]} * xj2;
      X29 -= (f32x2){Lb14[2], Lb14[3]} * xj2;
      X30 -= (f32x2){Lb15[0], Lb15[1]} * xj2;
      X31 -= (f32x2){Lb15[2], Lb15[3]} * xj2;
    }
    __builtin_amdgcn_sched_barrier(0);
    Lb2 = *(const f32x4*)(Lt_s + 484);
    Lb3 = *(const f32x4*)(Lt_s + 488);
    Lb4 = *(const f32x4*)(Lt_s + 492);
    Lb5 = *(const f32x4*)(Lt_s + 496);
    Lb6 = *(const f32x4*)(Lt_s + 500);
    Lb7 = *(const f32x4*)(Lt_s + 504);
    Lb8 = *(const f32x4*)(Lt_s + 508);
    Lb9 = *(const f32x4*)(Lt_s + 512);
    Lb10 = *(const f32x4*)(Lt_s + 516);
    Lb11 = *(const f32x4*)(Lt_s + 520);
    Lb12 = *(const f32x4*)(Lt_s + 524);
    Lb13 = *(const f32x4*)(Lt_s + 528);
    Lb14 = *(const f32x4*)(Lt_s + 532);
    Lb15 = *(const f32x4*)(Lt_s + 536);
    __builtin_amdgcn_sched_barrier(0);
    { const float xj = X3[0]; const f32x2 xj2 = (f32x2){xj, xj};
      X3 -= (f32x2){La1[2], La1[3]} * xj2;
      X4 -= (f32x2){La2[0], La2[1]} * xj2;
      X5 -= (f32x2){La2[2], La2[3]} * xj2;
      X6 -= (f32x2){La3[0], La3[1]} * xj2;
      X7 -= (f32x2){La3[2], La3[3]} * xj2;
      X8 -= (f32x2){La4[0], La4[1]} * xj2;
      X9 -= (f32x2){La4[2], La4[3]} * xj2;
      X10 -= (f32x2){La5[0], La5[1]} * xj2;
      X11 -= (f32x2){La5[2], La5[3]} * xj2;
      X12 -= (f32x2){La6[0], La6[1]} * xj2;
      X13 -= (f32x2){La6[2], La6[3]} * xj2;
      X14 -= (f32x2){La7[0], La7[1]} * xj2;
      X15 -= (f32x2){La7[2], La7[3]} * xj2;
      X16 -= (f32x2){La8[0], La8[1]} * xj2;
      X17 -= (f32x2){La8[2], La8[3]} * xj2;
      X18 -= (f32x2){La9[0], La9[1]} * xj2;
      X19 -= (f32x2){La9[2], La9[3]} * xj2;
      X20 -= (f32x2){La10[0], La10[1]} * xj2;
      X21 -= (f32x2){La10[2], La10[3]} * xj2;
      X22 -= (f32x2){La11[0], La11[1]} * xj2;
      X23 -= (f32x2){La11[2], La11[3]} * xj2;
      X24 -= (f32x2){La12[0], La12[1]} * xj2;
      X25 -= (f32x2){La12[2], La12[3]} * xj2;
      X26 -= (f32x2){La13[0], La13[1]} * xj2;
      X27 -= (f32x2){La13[2], La13[3]} * xj2;
      X28 -= (f32x2){La14[0], La14[1]} * xj2;
      X29 -= (f32x2){La14[2], La14[3]} * xj2;
      X30 -= (f32x2){La15[0], La15[1]} * xj2;
      X31 -= (f32x2){La15[2], La15[3]} * xj2;
    }
    __builtin_amdgcn_sched_barrier(0);
    La2 = *(const f32x4*)(Lt_s + 552);
    La3 = *(const f32x4*)(Lt_s + 556);
    La4 = *(const f32x4*)(Lt_s + 560);
    La5 = *(const f32x4*)(Lt_s + 564);
    La6 = *(const f32x4*)(Lt_s + 568);
    La7 = *(const f32x4*)(Lt_s + 572);
    La8 = *(const f32x4*)(Lt_s + 576);
    La9 = *(const f32x4*)(Lt_s + 580);
    La10 = *(const f32x4*)(Lt_s + 584);
    La11 = *(const f32x4*)(Lt_s + 588);
    La12 = *(const f32x4*)(Lt_s + 592);
    La13 = *(const f32x4*)(Lt_s + 596);
    La14 = *(const f32x4*)(Lt_s + 600);
    La15 = *(const f32x4*)(Lt_s + 604);
    __builtin_amdgcn_sched_barrier(0);
    { const float xj = X3[1]; const f32x2 xj2 = (f32x2){xj, xj};
      X4 -= (f32x2){Lb2[0], Lb2[1]} * xj2;
      X5 -= (f32x2){Lb2[2], Lb2[3]} * xj2;
      X6 -= (f32x2){Lb3[0], Lb3[1]} * xj2;
      X7 -= (f32x2){Lb3[2], Lb3[3]} * xj2;
      X8 -= (f32x2){Lb4[0], Lb4[1]} * xj2;
      X9 -= (f32x2){Lb4[2], Lb4[3]} * xj2;
      X10 -= (f32x2){Lb5[0], Lb5[1]} * xj2;
      X11 -= (f32x2){Lb5[2], Lb5[3]} * xj2;
      X12 -= (f32x2){Lb6[0], Lb6[1]} * xj2;
      X13 -= (f32x2){Lb6[2], Lb6[3]} * xj2;
      X14 -= (f32x2){Lb7[0], Lb7[1]} * xj2;
      X15 -= (f32x2){Lb7[2], Lb7[3]} * xj2;
      X16 -= (f32x2){Lb8[0], Lb8[1]} * xj2;
      X17 -= (f32x2){Lb8[2], Lb8[3]} * xj2;
      X18 -= (f32x2){Lb9[0], Lb9[1]} * xj2;
      X19 -= (f32x2){Lb9[2], Lb9[3]} * xj2;
      X20 -= (f32x2){Lb10[0], Lb10[1]} * xj2;
      X21 -= (f32x2){Lb10[2], Lb10[3]} * xj2;
      X22 -= (f32x2){Lb11[0], Lb11[1]} * xj2;
      X23 -= (f32x2){Lb11[2], Lb11[3]} * xj2;
      X24 -= (f32x2){Lb12[0], Lb12[1]} * xj2;
      X25 -= (f32x2){Lb12[2], Lb12[3]} * xj2;
      X26 -= (f32x2){Lb13[0], Lb13[1]} * xj2;
      X27 -= (f32x2){Lb13[2], Lb13[3]} * xj2;
      X28 -= (f32x2){Lb14[0], Lb14[1]} * xj2;
      X29 -= (f32x2){Lb14[2], Lb14[3]} * xj2;
      X30 -= (f32x2){Lb15[0], Lb15[1]} * xj2;
      X31 -= (f32x2){Lb15[2], Lb15[3]} * xj2;
    }
    __builtin_amdgcn_sched_barrier(0);
    Lb2 = *(const f32x4*)(Lt_s + 620);
    Lb3 = *(const f32x4*)(Lt_s + 624);
    Lb4 = *(const f32x4*)(Lt_s + 628);
    Lb5 = *(const f32x4*)(Lt_s + 632);
    Lb6 = *(const f32x4*)(Lt_s + 636);
    Lb7 = *(const f32x4*)(Lt_s + 640);
    Lb8 = *(const f32x4*)(Lt_s + 644);
    Lb9 = *(const f32x4*)(Lt_s + 648);
    Lb10 = *(const f32x4*)(Lt_s + 652);
    Lb11 = *(const f32x4*)(Lt_s + 656);
    Lb12 = *(const f32x4*)(Lt_s + 660);
    Lb13 = *(const f32x4*)(Lt_s + 664);
    Lb14 = *(const f32x4*)(Lt_s + 668);
    Lb15 = *(const f32x4*)(Lt_s + 672);
    __builtin_amdgcn_sched_barrier(0);
    { const float xj = X4[0]; const f32x2 xj2 = (f32x2){xj, xj};
      X4 -= (f32x2){La2[0], La2[1]} * xj2;
      X5 -= (f32x2){La2[2], La2[3]} * xj2;
      X6 -= (f32x2){La3[0], La3[1]} * xj2;
      X7 -= (f32x2){La3[2], La3[3]} * xj2;
      X8 -= (f32x2){La4[0], La4[1]} * xj2;
      X9 -= (f32x2){La4[2], La4[3]} * xj2;
      X10 -= (f32x2){La5[0], La5[1]} * xj2;
      X11 -= (f32x2){La5[2], La5[3]} * xj2;
      X12 -= (f32x2){La6[0], La6[1]} * xj2;
      X13 -= (f32x2){La6[2], La6[3]} * xj2;
      X14 -= (f32x2){La7[0], La7[1]} * xj2;
      X15 -= (f32x2){La7[2], La7[3]} * xj2;
      X16 -= (f32x2){La8[0], La8[1]} * xj2;
      X17 -= (f32x2){La8[2], La8[3]} * xj2;
      X18 -= (f32x2){La9[0], La9[1]} * xj2;
      X19 -= (f32x2){La9[2], La9[3]} * xj2;
      X20 -= (f32x2){La10[0], La10[1]} * xj2;
      X21 -= (f32x2){La10[2], La10[3]} * xj2;
      X22 -= (f32x2){La11[0], La11[1]} * xj2;
      X23 -= (f32x2){La11[2], La11[3]} * xj2;
      X24 -= (f32x2){La12[0], La12[1]} * xj2;
      X25 -= (f32x2){La12[2], La12[3]} * xj2;
      X26 -= (f32x2){La13[0], La13[1]} * xj2;
      X27 -= (f32x2){La13[2], La13[3]} * xj2;
      X28 -= (f32x2){La14[0], La14[1]} * xj2;
      X29 -= (f32x2){La14[2], La14[3]} * xj2;
      X30 -= (f32x2){La15[0], La15[1]} * xj2;
      X31 -= (f32x2){La15[2], La15[3]} * xj2;
    }
    __builtin_amdgcn_sched_barrier(0);
    La2 = *(const f32x4*)(Lt_s + 688);
    La3 = *(const f32x4*)(Lt_s + 692);
    La4 = *(const f32x4*)(Lt_s + 696);
    La5 = *(const f32x4*)(Lt_s + 700);
    La6 = *(const f32x4*)(Lt_s + 704);
    La7 = *(const f32x4*)(Lt_s + 708);
    La8 = *(const f32x4*)(Lt_s + 712);
    La9 = *(const f32x4*)(Lt_s + 716);
    La10 = *(const f32x4*)(Lt_s + 720);
    La11 = *(const f32x4*)(Lt_s + 724);
    La12 = *(const f32x4*)(Lt_s + 728);
    La13 = *(const f32x4*)(Lt_s + 732);
    La14 = *(const f32x4*)(Lt_s + 736);
    La15 = *(const f32x4*)(Lt_s + 740);
    __builtin_amdgcn_sched_barrier(0);
    { const float xj = X4[1]; const f32x2 xj2 = (f32x2){xj, xj};
      X5 -= (f32x2){Lb2[2], Lb2[3]} * xj2;
      X6 -= (f32x2){Lb3[0], Lb3[1]} * xj2;
      X7 -= (f32x2){Lb3[2], Lb3[3]} * xj2;
      X8 -= (f32x2){Lb4[0], Lb4[1]} * xj2;
      X9 -= (f32x2){Lb4[2], Lb4[3]} * xj2;
      X10 -= (f32x2){Lb5[0], Lb5[1]} * xj2;
      X11 -= (f32x2){Lb5[2], Lb5[3]} * xj2;
      X12 -= (f32x2){Lb6[0], Lb6[1]} * xj2;
      X13 -= (f32x2){Lb6[2], Lb6[3]} * xj2;
      X14 -= (f32x2){Lb7[0], Lb7[1]} * xj2;
      X15 -= (f32x2){Lb7[2], Lb7[3]} * xj2;
      X16 -= (f32x2){Lb8[0], Lb8[1]} * xj2;
      X17 -= (f32x2){Lb8[2], Lb8[3]} * xj2;
      X18 -= (f32x2){Lb9[0], Lb9[1]} * xj2;
      X19 -= (f32x2){Lb9[2], Lb9[3]} * xj2;
      X20 -= (f32x2){Lb10[0], Lb10[1]} * xj2;
      X21 -= (f32x2){Lb10[2], Lb10[3]} * xj2;
      X22 -= (f32x2){Lb11[0], Lb11[1]} * xj2;
      X23 -= (f32x2){Lb11[2], Lb11[3]} * xj2;
      X24 -= (f32x2){Lb12[0], Lb12[1]} * xj2;
      X25 -= (f32x2){Lb12[2], Lb12[3]} * xj2;
      X26 -= (f32x2){Lb13[0], Lb13[1]} * xj2;
      X27 -= (f32x2){Lb13[2], Lb13[3]} * xj2;
      X28 -= (f32x2){Lb14[0], Lb14[1]} * xj2;
      X29 -= (f32x2){Lb14[2], Lb14[3]} * xj2;
      X30 -= (f32x2){Lb15[0], Lb15[1]} * xj2;
      X31 -= (f32x2){Lb15[2], Lb15[3]} * xj2;
    }
    __builtin_amdgcn_sched_barrier(0);
    Lb3 = *(const f32x4*)(Lt_s + 760);
    Lb4 = *(const f32x4*)(Lt_s + 764);
    Lb5 = *(const f32x4*)(Lt_s + 768);
    Lb6 = *(const f32x4*)(Lt_s + 772);
    Lb7 = *(const f32x4*)(Lt_s + 776);
    Lb8 = *(const f32x4*)(Lt_s + 780);
    Lb9 = *(const f32x4*)(Lt_s + 784);
    Lb10 = *(const f32x4*)(Lt_s + 788);
    Lb11 = *(const f32x4*)(Lt_s + 792);
    Lb12 = *(const f32x4*)(Lt_s + 796);
    Lb13 = *(const f32x4*)(Lt_s + 800);
    Lb14 = *(const f32x4*)(Lt_s + 804);
    Lb15 = *(const f32x4*)(Lt_s + 808);
    __builtin_amdgcn_sched_barrier(0);
    { const float xj = X5[0]; const f32x2 xj2 = (f32x2){xj, xj};
      X5 -= (f32x2){La2[2], La2[3]} * xj2;
      X6 -= (f32x2){La3[0], La3[1]} * xj2;
      X7 -= (f32x2){La3[2], La3[3]} * xj2;
      X8 -= (f32x2){La4[0], La4[1]} * xj2;
      X9 -= (f32x2){La4[2], La4[3]} * xj2;
      X10 -= (f32x2){La5[0], La5[1]} * xj2;
      X11 -= (f32x2){La5[2], La5[3]} * xj2;
      X12 -= (f32x2){La6[0], La6[1]} * xj2;
      X13 -= (f32x2){La6[2], La6[3]} * xj2;
      X14 -= (f32x2){La7[0], La7[1]} * xj2;
      X15 -= (f32x2){La7[2], La7[3]} * xj2;
      X16 -= (f32x2){La8[0], La8[1]} * xj2;
      X17 -= (f32x2){La8[2], La8[3]} * xj2;
      X18 -= (f32x2){La9[0], La9[1]} * xj2;
      X19 -= (f32x2){La9[2], La9[3]} * xj2;
      X20 -= (f32x2){La10[0], La10[1]} * xj2;
      X21 -= (f32x2){La10[2], La10[3]} * xj2;
      X22 -= (f32x2){La11[0], La11[1]} * xj2;
      X23 -= (f32x2){La11[2], La11[3]} * xj2;
      X24 -= (f32x2){La12[0], La12[1]} * xj2;
      X25 -= (f32x2){La12[2], La12[3]} * xj2;
      X26 -= (f32x2){La13[0], La13[1]} * xj2;
      X27 -= (f32x2){La13[2], La13[3]} * xj2;
      X28 -= (f32x2){La14[0], La14[1]} * xj2;
      X29 -= (f32x2){La14[2], La14[3]} * xj2;
      X30 -= (f32x2){La15[0], La15[1]} * xj2;
      X31 -= (f32x2){La15[2], La15[3]} * xj2;
    }
    __builtin_amdgcn_sched_barrier(0);
    La3 = *(const f32x4*)(Lt_s + 828);
    La4 = *(const f32x4*)(Lt_s + 832);
    La5 = *(const f32x4*)(Lt_s + 836);
    La6 = *(const f32x4*)(Lt_s + 840);
    La7 = *(const f32x4*)(Lt_s + 844);
    La8 = *(const f32x4*)(Lt_s + 848);
    La9 = *(const f32x4*)(Lt_s + 852);
    La10 = *(const f32x4*)(Lt_s + 856);
    La11 = *(const f32x4*)(Lt_s + 860);
    La12 = *(const f32x4*)(Lt_s + 864);
    La13 = *(const f32x4*)(Lt_s + 868);
    La14 = *(const f32x4*)(Lt_s + 872);
    La15 = *(const f32x4*)(Lt_s + 876);
    __builtin_amdgcn_sched_barrier(0);
    { const float xj = X5[1]; const f32x2 xj2 = (f32x2){xj, xj};
      X6 -= (f32x2){Lb3[0], Lb3[1]} * xj2;
      X7 -= (f32x2){Lb3[2], Lb3[3]} * xj2;
      X8 -= (f32x2){Lb4[0], Lb4[1]} * xj2;
      X9 -= (f32x2){Lb4[2], Lb4[3]} * xj2;
      X10 -= (f32x2){Lb5[0], Lb5[1]} * xj2;
      X11 -= (f32x2){Lb5[2], Lb5[3]} * xj2;
      X12 -= (f32x2){Lb6[0], Lb6[1]} * xj2;
      X13 -= (f32x2){Lb6[2], Lb6[3]} * xj2;
      X14 -= (f32x2){Lb7[0], Lb7[1]} * xj2;
      X15 -= (f32x2){Lb7[2], Lb7[3]} * xj2;
      X16 -= (f32x2){Lb8[0], Lb8[1]} * xj2;
      X17 -= (f32x2){Lb8[2], Lb8[3]} * xj2;
      X18 -= (f32x2){Lb9[0], Lb9[1]} * xj2;
      X19 -= (f32x2){Lb9[2], Lb9[3]} * xj2;
      X20 -= (f32x2){Lb10[0], Lb10[1]} * xj2;
      X21 -= (f32x2){Lb10[2], Lb10[3]} * xj2;
      X22 -= (f32x2){Lb11[0], Lb11[1]} * xj2;
      X23 -= (f32x2){Lb11[2], Lb11[3]} * xj2;
      X24 -= (f32x2){Lb12[0], Lb12[1]} * xj2;
      X25 -= (f32x2){Lb12[2], Lb12[3]} * xj2;
      X26 -= (f32x2){Lb13[0], Lb13[1]} * xj2;
      X27 -= (f32x2){Lb13[2], Lb13[3]} * xj2;
      X28 -= (f32x2){Lb14[0], Lb14[1]} * xj2;
      X29 -= (f32x2){Lb14[2], Lb14[3]} * xj2;
      X30 -= (f32x2){Lb15[0], Lb15[1]} * xj2;
      X31 -= (f32x2){Lb15[2], Lb15[3]} * xj2;
    }
    __builtin_amdgcn_sched_barrier(0);
    Lb3 = *(const f32x4*)(Lt_s + 896);
    Lb4 = *(const f32x4*)(Lt_s + 900);
    Lb5 = *(const f32x4*)(Lt_s + 904);
    Lb6 = *(const f32x4*)(Lt_s + 908);
    Lb7 = *(const f32x4*)(Lt_s + 912);
    Lb8 = *(const f32x4*)(Lt_s + 916);
    Lb9 = *(const f32x4*)(Lt_s + 920);
    Lb10 = *(const f32x4*)(Lt_s + 924);
    Lb11 = *(const f32x4*)(Lt_s + 928);
    Lb12 = *(const f32x4*)(Lt_s + 932);
    Lb13 = *(const f32x4*)(Lt_s + 936);
    Lb14 = *(const f32x4*)(Lt_s + 940);
    Lb15 = *(const f32x4*)(Lt_s + 944);
    __builtin_amdgcn_sched_barrier(0);
    { const float xj = X6[0]; const f32x2 xj2 = (f32x2){xj, xj};
      X6 -= (f32x2){La3[0], La3[1]} * xj2;
      X7 -= (f32x2){La3[2], La3[3]} * xj2;
      X8 -= (f32x2){La4[0], La4[1]} * xj2;
      X9 -= (f32x2){La4[2], La4[3]} * xj2;
      X10 -= (f32x2){La5[0], La5[1]} * xj2;
      X11 -= (f32x2){La5[2], La5[3]} * xj2;
      X12 -= (f32x2){La6[0], La6[1]} * xj2;
      X13 -= (f32x2){La6[2], La6[3]} * xj2;
      X14 -= (f32x2){La7[0], La7[1]} * xj2;
      X15 -= (f32x2){La7[2], La7[3]} * xj2;
      X16 -= (f32x2){La8[0], La8[1]} * xj2;
      X17 -= (f32x2){La8[2], La8[3]} * xj2;
      X18 -= (f32x2){La9[0], La9[1]} * xj2;
      X19 -= (f32x2){La9[2], La9[3]} * xj2;
      X20 -= (f32x2){La10[0], La10[1]} * xj2;
      X21 -= (f32x2){La10[2], La10[3]} * xj2;
      X22 -= (f32x2){La11[0], La11[1]} * xj2;
      X23 -= (f32x2){La11[2], La11[3]} * xj2;
      X24 -= (f32x2){La12[0], La12[1]} * xj2;
      X25 -= (f32x2){La12[2], La12[3]} * xj2;
      X26 -= (f32x2){La13[0], La13[1]} * xj2;
      X27 -= (f32x2){La13[2], La13[3]} * xj2;
      X28 -= (f32x2){La14[0], La14[1]} * xj2;
      X29 -= (f32x2){La14[2], La14[3]} * xj2;
      X30 -= (f32x2){La15[0], La15[1]} * xj2;
      X31 -= (f32x2){La15[2], La15[3]} * xj2;
    }
    __builtin_amdgcn_sched_barrier(0);
    La3 = *(const f32x4*)(Lt_s + 964);
    La4 = *(const f32x4*)(Lt_s + 968);
    La5 = *(const f32x4*)(Lt_s + 972);
    La6 = *(const f32x4*)(Lt_s + 976);
    La7 = *(const f32x4*)(Lt_s + 980);
    La8 = *(const f32x4*)(Lt_s + 984);
    La9 = *(const f32x4*)(Lt_s + 988);
    La10 = *(const f32x4*)(Lt_s + 992);
    La11 = *(const f32x4*)(Lt_s + 996);
    La12 = *(const f32x4*)(Lt_s + 1000);
    La13 = *(const f32x4*)(Lt_s + 1004);
    La14 = *(const f32x4*)(Lt_s + 1008);
    La15 = *(const f32x4*)(Lt_s + 1012);
    __builtin_amdgcn_sched_barrier(0);
    { const float xj = X6[1]; const f32x2 xj2 = (f32x2){xj, xj};
      X7 -= (f32x2){Lb3[2], Lb3[3]} * xj2;
      X8 -= (f32x2){Lb4[0], Lb4[1]} * xj2;
      X9 -= (f32x2){Lb4[2], Lb4[3]} * xj2;
      X10 -= (f32x2){Lb5[0], Lb5[1]} * xj2;
      X11 -= (f32x2){Lb5[2], Lb5[3]} * xj2;
      X12 -= (f32x2){Lb6[0], Lb6[1]} * xj2;
      X13 -= (f32x2){Lb6[2], Lb6[3]} * xj2;
      X14 -= (f32x2){Lb7[0], Lb7[1]} * xj2;
      X15 -= (f32x2){Lb7[2], Lb7[3]} * xj2;
      X16 -= (f32x2){Lb8[0], Lb8[1]} * xj2;
      X17 -= (f32x2){Lb8[2], Lb8[3]} * xj2;
      X18 -= (f32x2){Lb9[0], Lb9[1]} * xj2;
      X19 -= (f32x2){Lb9[2], Lb9[3]} * xj2;
      X20 -= (f32x2){Lb10[0], Lb10[1]} * xj2;
      X21 -= (f32x2){Lb10[2], Lb10[3]} * xj2;
      X22 -= (f32x2){Lb11[0], Lb11[1]} * xj2;
      X23 -= (f32x2){Lb11[2], Lb11[3]} * xj2;
      X24 -= (f32x2){Lb12[0], Lb12[1]} * xj2;
      X25 -= (f32x2){Lb12[2], Lb12[3]} * xj2;
      X26 -= (f32x2){Lb13[0], Lb13[1]} * xj2;
      X27 -= (f32x2){Lb13[2], Lb13[3]} * xj2;
      X28 -= (f32x2){Lb14[0], Lb14[1]} * xj2;
      X29 -= (f32x2){Lb14[2], Lb14[3]} * xj2;
      X30 -= (f32x2){Lb15[0], Lb15[1]} * xj2;
      X31 -= (f32x2){Lb15[2], Lb15[3]} * xj2;
    }
    __builtin_amdgcn_sched_barrier(0);
    Lb4 = *(const f32x4*)(Lt_s + 1036);
    Lb5 = *(const f32x4*)(Lt_s + 1040);
    Lb6 = *(const f32x4*)(Lt_s + 1044);
    Lb7 = *(const f32x4*)(Lt_s + 1048);
    Lb8 = *(const f32x4*)(Lt_s + 1052);
    Lb9 = *(const f32x4*)(Lt_s + 1056);
    Lb10 = *(const f32x4*)(Lt_s + 1060);
    Lb11 = *(const f32x4*)(Lt_s + 1064);
    Lb12 = *(const f32x4*)(Lt_s + 1068);
    Lb13 = *(const f32x4*)(Lt_s + 1072);
    Lb14 = *(const f32x4*)(Lt_s + 1076);
    Lb15 = *(const f32x4*)(Lt_s + 1080);
    __builtin_amdgcn_sched_barrier(0);
    { const float xj = X7[0]; const f32x2 xj2 = (f32x2){xj, xj};
      X7 -= (f32x2){La3[2], La3[3]} * xj2;
      X8 -= (f32x2){La4[0], La4[1]} * xj2;
      X9 -= (f32x2){La4[2], La4[3]} * xj2;
      X10 -= (f32x2){La5[0], La5[1]} * xj2;
      X11 -= (f32x2){La5[2], La5[3]} * xj2;
      X12 -= (f32x2){La6[0], La6[1]} * xj2;
      X13 -= (f32x2){La6[2], La6[3]} * xj2;
      X14 -= (f32x2){La7[0], La7[1]} * xj2;
      X15 -= (f32x2){La7[2], La7[3]} * xj2;
      X16 -= (f32x2){La8[0], La8[1]} * xj2;
      X17 -= (f32x2){La8[2], La8[3]} * xj2;
      X18 -= (f32x2){La9[0], La9[1]} * xj2;
      X19 -= (f32x2){La9[2], La9[3]} * xj2;
      X20 -= (f32x2){La10[0], La10[1]} * xj2;
      X21 -= (f32x2){La10[2], La10[3]} * xj2;
      X22 -= (f32x2){La11[0], La11[1]} * xj2;
      X23 -= (f32x2){La11[2], La11[3]} * xj2;
      X24 -= (f32x2){La12[0], La12[1]} * xj2;
      X25 -= (f32x2){La12[2], La12[3]} * xj2;
      X26 -= (f32x2){La13[0], La13[1]} * xj2;
      X27 -= (f32x2){La13[2], La13[3]} * xj2;
      X28 -= (f32x2){La14[0], La14[1]} * xj2;
      X29 -= (f32x2){La14[2], La14[3]} * xj2;
      X30 -= (f32x2){La15[0], La15[1]} * xj2;
      X31 -= (f32x2){La15[2], La15[3]} * xj2;
    }
    __builtin_amdgcn_sched_barrier(0);
    La4 = *(const f32x4*)(Lt_s + 1104);
    La5 = *(const f32x4*)(Lt_s + 1108);
    La6 = *(const f32x4*)(Lt_s + 1112);
    La7 = *(const f32x4*)(Lt_s + 1116);
    La8 = *(const f32x4*)(Lt_s + 1120);
    La9 = *(const f32x4*)(Lt_s + 1124);
    La10 = *(const f32x4*)(Lt_s + 1128);
    La11 = *(const f32x4*)(Lt_s + 1132);
    La12 = *(const f32x4*)(Lt_s + 1136);
    La13 = *(const f32x4*)(Lt_s + 1140);
    La14 = *(const f32x4*)(Lt_s + 1144);
    La15 = *(const f32x4*)(Lt_s + 1148);
    __builtin_amdgcn_sched_barrier(0);
    { const float xj = X7[1]; const f32x2 xj2 = (f32x2){xj, xj};
      X8 -= (f32x2){Lb4[0], Lb4[1]} * xj2;
      X9 -= (f32x2){Lb4[2], Lb4[3]} * xj2;
      X10 -= (f32x2){Lb5[0], Lb5[1]} * xj2;
      X11 -= (f32x2){Lb5[2], Lb5[3]} * xj2;
      X12 -= (f32x2){Lb6[0], Lb6[1]} * xj2;
      X13 -= (f32x2){Lb6[2], Lb6[3]} * xj2;
      X14 -= (f32x2){Lb7[0], Lb7[1]} * xj2;
      X15 -= (f32x2){Lb7[2], Lb7[3]} * xj2;
      X16 -= (f32x2){Lb8[0], Lb8[1]} * xj2;
      X17 -= (f32x2){Lb8[2], Lb8[3]} * xj2;
      X18 -= (f32x2){Lb9[0], Lb9[1]} * xj2;
      X19 -= (f32x2){Lb9[2], Lb9[3]} * xj2;
      X20 -= (f32x2){Lb10[0], Lb10[1]} * xj2;
      X21 -= (f32x2){Lb10[2], Lb10[3]} * xj2;
      X22 -= (f32x2){Lb11[0], Lb11[1]} * xj2;
      X23 -= (f32x2){Lb11[2], Lb11[3]} * xj2;
      X24 -= (f32x2){Lb12[0], Lb12[1]} * xj2;
      X25 -= (f32x2){Lb12[2], Lb12[3]} * xj2;
      X26 -= (f32x2){Lb13[0], Lb13[1]} * xj2;
      X27 -= (f32x2){Lb13[2], Lb13[3]} * xj2;
      X28 -= (f32x2){Lb14[0], Lb14[1]} * xj2;
      X29 -= (f32x2){Lb14[2], Lb14[3]} * xj2;
      X30 -= (f32x2){Lb15[0], Lb15[1]} * xj2;
      X31 -= (f32x2){Lb15[2], Lb15[3]} * xj2;
    }
    __builtin_amdgcn_sched_barrier(0);
    Lb4 = *(const f32x4*)(Lt_s + 1172);
    Lb5 = *(const f32x4*)(Lt_s + 1176);
    Lb6 = *(const f32x4*)(Lt_s + 1180);
    Lb7 = *(const f32x4*)(Lt_s + 1184);
    Lb8 = *(const f32x4*)(Lt_s + 1188);
    Lb9 = *(const f32x4*)(Lt_s + 1192);
    Lb10 = *(const f32x4*)(Lt_s + 1196);
    Lb11 = *(const f32x4*)(Lt_s + 1200);
    Lb12 = *(const f32x4*)(Lt_s + 1204);
    Lb13 = *(const f32x4*)(Lt_s + 1208);
    Lb14 = *(const f32x4*)(Lt_s + 1212);
    Lb15 = *(const f32x4*)(Lt_s + 1216);
    __builtin_amdgcn_sched_barrier(0);
    { const float xj = X8[0]; const f32x2 xj2 = (f32x2){xj, xj};
      X8 -= (f32x2){La4[0], La4[1]} * xj2;
      X9 -= (f32x2){La4[2], La4[3]} * xj2;
      X10 -= (f32x2){La5[0], La5[1]} * xj2;
      X11 -= (f32x2){La5[2], La5[3]} * xj2;
      X12 -= (f32x2){La6[0], La6[1]} * xj2;
      X13 -= (f32x2){La6[2], La6[3]} * xj2;
      X14 -= (f32x2){La7[0], La7[1]} * xj2;
      X15 -= (f32x2){La7[2], La7[3]} * xj2;
      X16 -= (f32x2){La8[0], La8[1]} * xj2;
      X17 -= (f32x2){La8[2], La8[3]} * xj2;
      X18 -= (f32x2){La9[0], La9[1]} * xj2;
      X19 -= (f32x2){La9[2], La9[3]} * xj2;
      X20 -= (f32x2){La10[0], La10[1]} * xj2;
      X21 -= (f32x2){La10[2], La10[3]} * xj2;
      X22 -= (f32x2){La11[0], La11[1]} * xj2;
      X23 -= (f32x2){La11[2], La11[3]} * xj2;
      X24 -= (f32x2){La12[0], La12[1]} * xj2;
      X25 -= (f32x2){La12[2], La12[3]} * xj2;
      X26 -= (f32x2){La13[0], La13[1]} * xj2;
      X27 -= (f32x2){La13[2], La13[3]} * xj2;
      X28 -= (f32x2){La14[0], La14[1]} * xj2;
      X29 -= (f32x2){La14[2], La14[3]} * xj2;
      X30 -= (f32x2){La15[0], La15[1]} * xj2;
      X31 -= (f32x2){La15[2], La15[3]} * xj2;
    }
    __builtin_amdgcn_sched_barrier(0);
    La4 = *(const f32x4*)(Lt_s + 1240);
    La5 = *(const f32x4*)(Lt_s + 1244);
    La6 = *(const f32x4*)(Lt_s + 1248);
    La7 = *(const f32x4*)(Lt_s + 1252);
    La8 = *(const f32x4*)(Lt_s + 1256);
    La9 = *(const f32x4*)(Lt_s + 1260);
    La10 = *(const f32x4*)(Lt_s + 1264);
    La11 = *(const f32x4*)(Lt_s + 1268);
    La12 = *(const f32x4*)(Lt_s + 1272);
    La13 = *(const f32x4*)(Lt_s + 1276);
    La14 = *(const f32x4*)(Lt_s + 1280);
    La15 = *(const f32x4*)(Lt_s + 1284);
    __builtin_amdgcn_sched_barrier(0);
    { const float xj = X8[1]; const f32x2 xj2 = (f32x2){xj, xj};
      X9 -= (f32x2){Lb4[2], Lb4[3]} * xj2;
      X10 -= (f32x2){Lb5[0], Lb5[1]} * xj2;
      X11 -= (f32x2){Lb5[2], Lb5[3]} * xj2;
      X12 -= (f32x2){Lb6[0], Lb6[1]} * xj2;
      X13 -= (f32x2){Lb6[2], Lb6[3]} * xj2;
      X14 -= (f32x2){Lb7[0], Lb7[1]} * xj2;
      X15 -= (f32x2){Lb7[2], Lb7[3]} * xj2;
      X16 -= (f32x2){Lb8[0], Lb8[1]} * xj2;
      X17 -= (f32x2){Lb8[2], Lb8[3]} * xj2;
      X18 -= (f32x2){Lb9[0], Lb9[1]} * xj2;
      X19 -= (f32x2){Lb9[2], Lb9[3]} * xj2;
      X20 -= (f32x2){Lb10[0], Lb10[1]} * xj2;
      X21 -= (f32x2){Lb10[2], Lb10[3]} * xj2;
      X22 -= (f32x2){Lb11[0], Lb11[1]} * xj2;
      X23 -= (f32x2){Lb11[2], Lb11[3]} * xj2;
      X24 -= (f32x2){Lb12[0], Lb12[1]} * xj2;
      X25 -= (f32x2){Lb12[2], Lb12[3]} * xj2;
      X26 -= (f32x2){Lb13[0], Lb13[1]} * xj2;
      X27 -= (f32x2){Lb13[2], Lb13[3]} * xj2;
      X28 -= (f32x2){Lb14[0], Lb14[1]} * xj2;
      X29 -= (f32x2){Lb14[2], Lb14[3]} * xj2;
      X30 -= (f32x2){Lb15[0], Lb15[1]} * xj2;
      X31 -= (f32x2){Lb15[2], Lb15[3]} * xj2;
    }
    __builtin_amdgcn_sched_barrier(0);
    Lb5 = *(const f32x4*)(Lt_s + 1312);
    Lb6 = *(const f32x4*)(Lt_s + 1316);
    Lb7 = *(const f32x4*)(Lt_s + 1320);
    Lb8 = *(const f32x4*)(Lt_s + 1324);
    Lb9 = *(const f32x4*)(Lt_s + 1328);
    Lb10 = *(const f32x4*)(Lt_s + 1332);
    Lb11 = *(const f32x4*)(Lt_s + 1336);
    Lb12 = *(const f32x4*)(Lt_s + 1340);
    Lb13 = *(const f32x4*)(Lt_s + 1344);
    Lb14 = *(const f32x4*)(Lt_s + 1348);
    Lb15 = *(const f32x4*)(Lt_s + 1352);
    __builtin_amdgcn_sched_barrier(0);
    { const float xj = X9[0]; const f32x2 xj2 = (f32x2){xj, xj};
      X9 -= (f32x2){La4[2], La4[3]} * xj2;
      X10 -= (f32x2){La5[0], La5[1]} * xj2;
      X11 -= (f32x2){La5[2], La5[3]} * xj2;
      X12 -= (f32x2){La6[0], La6[1]} * xj2;
      X13 -= (f32x2){La6[2], La6[3]} * xj2;
      X14 -= (f32x2){La7[0], La7[1]} * xj2;
      X15 -= (f32x2){La7[2], La7[3]} * xj2;
      X16 -= (f32x2){La8[0], La8[1]} * xj2;
      X17 -= (f32x2){La8[2], La8[3]} * xj2;
      X18 -= (f32x2){La9[0], La9[1]} * xj2;
      X19 -= (f32x2){La9[2], La9[3]} * xj2;
      X20 -= (f32x2){La10[0], La10[1]} * xj2;
      X21 -= (f32x2){La10[2], La10[3]} * xj2;
      X22 -= (f32x2){La11[0], La11[1]} * xj2;
      X23 -= (f32x2){La11[2], La11[3]} * xj2;
      X24 -= (f32x2){La12[0], La12[1]} * xj2;
      X25 -= (f32x2){La12[2], La12[3]} * xj2;
      X26 -= (f32x2){La13[0], La13[1]} * xj2;
      X27 -= (f32x2){La13[2], La13[3]} * xj2;
      X28 -= (f32x2){La14[0], La14[1]} * xj2;
      X29 -= (f32x2){La14[2], La14[3]} * xj2;
      X30 -= (f32x2){La15[0], La15[1]} * xj2;
      X31 -= (f32x2){La15[2], La15[3]} * xj2;
    }
    __builtin_amdgcn_sched_barrier(0);
    La5 = *(const f32x4*)(Lt_s + 1380);
    La6 = *(const f32x4*)(Lt_s + 1384);
    La7 = *(const f32x4*)(Lt_s + 1388);
    La8 = *(const f32x4*)(Lt_s + 1392);
    La9 = *(const f32x4*)(Lt_s + 1396);
    La10 = *(const f32x4*)(Lt_s + 1400);
    La11 = *(const f32x4*)(Lt_s + 1404);
    La12 = *(const f32x4*)(Lt_s + 1408);
    La13 = *(const f32x4*)(Lt_s + 1412);
    La14 = *(const f32x4*)(Lt_s + 1416);
    La15 = *(const f32x4*)(Lt_s + 1420);
    __builtin_amdgcn_sched_barrier(0);
    { const float xj = X9[1]; const f32x2 xj2 = (f32x2){xj, xj};
      X10 -= (f32x2){Lb5[0], Lb5[1]} * xj2;
      X11 -= (f32x2){Lb5[2], Lb5[3]} * xj2;
      X12 -= (f32x2){Lb6[0], Lb6[1]} * xj2;
      X13 -= (f32x2){Lb6[2], Lb6[3]} * xj2;
      X14 -= (f32x2){Lb7[0], Lb7[1]} * xj2;
      X15 -= (f32x2){Lb7[2], Lb7[3]} * xj2;
      X16 -= (f32x2){Lb8[0], Lb8[1]} * xj2;
      X17 -= (f32x2){Lb8[2], Lb8[3]} * xj2;
      X18 -= (f32x2){Lb9[0], Lb9[1]} * xj2;
      X19 -= (f32x2){Lb9[2], Lb9[3]} * xj2;
      X20 -= (f32x2){Lb10[0], Lb10[1]} * xj2;
      X21 -= (f32x2){Lb10[2], Lb10[3]} * xj2;
      X22 -= (f32x2){Lb11[0], Lb11[1]} * xj2;
      X23 -= (f32x2){Lb11[2], Lb11[3]} * xj2;
      X24 -= (f32x2){Lb12[0], Lb12[1]} * xj2;
      X25 -= (f32x2){Lb12[2], Lb12[3]} * xj2;
      X26 -= (f32x2){Lb13[0], Lb13[1]} * xj2;
      X27 -= (f32x2){Lb13[2], Lb13[3]} * xj2;
      X28 -= (f32x2){Lb14[0], Lb14[1]} * xj2;
      X29 -= (f32x2){Lb14[2], Lb14[3]} * xj2;
      X30 -= (f32x2){Lb15[0], Lb15[1]} * xj2;
      X31 -= (f32x2){Lb15[2], Lb15[3]} * xj2;
    }
    __builtin_amdgcn_sched_barrier(0);
    Lb5 = *(const f32x4*)(Lt_s + 1448);
    Lb6 = *(const f32x4*)(Lt_s + 1452);
    Lb7 = *(const f32x4*)(Lt_s + 1456);
    Lb8 = *(const f32x4*)(Lt_s + 1460);
    Lb9 = *(const f32x4*)(Lt_s + 1464);
    Lb10 = *(const f32x4*)(Lt_s + 1468);
    Lb11 = *(const f32x4*)(Lt_s + 1472);
    Lb12 = *(const f32x4*)(Lt_s + 1476);
    Lb13 = *(const f32x4*)(Lt_s + 1480);
    Lb14 = *(const f32x4*)(Lt_s + 1484);
    Lb15 = *(const f32x4*)(Lt_s + 1488);
    __builtin_amdgcn_sched_barrier(0);
    { const float xj = X10[0]; const f32x2 xj2 = (f32x2){xj, xj};
      X10 -= (f32x2){La5[0], La5[1]} * xj2;
      X11 -= (f32x2){La5[2], La5[3]} * xj2;
      X12 -= (f32x2){La6[0], La6[1]} * xj2;
      X13 -= (f32x2){La6[2], La6[3]} * xj2;
      X14 -= (f32x2){La7[0], La7[1]} * xj2;
      X15 -= (f32x2){La7[2], La7[3]} * xj2;
      X16 -= (f32x2){La8[0], La8[1]} * xj2;
      X17 -= (f32x2){La8[2], La8[3]} * xj2;
      X18 -= (f32x2){La9[0], La9[1]} * xj2;
      X19 -= (f32x2){La9[2], La9[3]} * xj2;
      X20 -= (f32x2){La10[0], La10[1]} * xj2;
      X21 -= (f32x2){La10[2], La10[3]} * xj2;
      X22 -= (f32x2){La11[0], La11[1]} * xj2;
      X23 -= (f32x2){La11[2], La11[3]} * xj2;
      X24 -= (f32x2){La12[0], La12[1]} * xj2;
      X25 -= (f32x2){La12[2], La12[3]} * xj2;
      X26 -= (f32x2){La13[0], La13[1]} * xj2;
      X27 -= (f32x2){La13[2], La13[3]} * xj2;
      X28 -= (f32x2){La14[0], La14[1]} * xj2;
      X29 -= (f32x2){La14[2], La14[3]} * xj2;
      X30 -= (f32x2){La15[0], La15[1]} * xj2;
      X31 -= (f32x2){La15[2], La15[3]} * xj2;
    }
    __builtin_amdgcn_sched_barrier(0);
    La5 = *(const f32x4*)(Lt_s + 1516);
    La6 = *(const f32x4*)(Lt_s + 1520);
    La7 = *(const f32x4*)(Lt_s + 1524);
    La8 = *(const f32x4*)(Lt_s + 1528);
    La9 = *(const f32x4*)(Lt_s + 1532);
    La10 = *(const f32x4*)(Lt_s + 1536);
    La11 = *(const f32x4*)(Lt_s + 1540);
    La12 = *(const f32x4*)(Lt_s + 1544);
    La13 = *(const f32x4*)(Lt_s + 1548);
    La14 = *(const f32x4*)(Lt_s + 1552);
    La15 = *(const f32x4*)(Lt_s + 1556);
    __builtin_amdgcn_sched_barrier(0);
    { const float xj = X10[1]; const f32x2 xj2 = (f32x2){xj, xj};
      X11 -= (f32x2){Lb5[2], Lb5[3]} * xj2;
      X12 -= (f32x2){Lb6[0], Lb6[1]} * xj2;
      X13 -= (f32x2){Lb6[2], Lb6[3]} * xj2;
      X14 -= (f32x2){Lb7[0], Lb7[1]} * xj2;
      X15 -= (f32x2){Lb7[2], Lb7[3]} * xj2;
      X16 -= (f32x2){Lb8[0], Lb8[1]} * xj2;
      X17 -= (f32x2){Lb8[2], Lb8[3]} * xj2;
      X18 -= (f32x2){Lb9[0], Lb9[1]} * xj2;
      X19 -= (f32x2){Lb9[2], Lb9[3]} * xj2;
      X20 -= (f32x2){Lb10[0], Lb10[1]} * xj2;
      X21 -= (f32x2){Lb10[2], Lb10[3]} * xj2;
      X22 -= (f32x2){Lb11[0], Lb11[1]} * xj2;
      X23 -= (f32x2){Lb11[2], Lb11[3]} * xj2;
      X24 -= (f32x2){Lb12[0], Lb12[1]} * xj2;
      X25 -= (f32x2){Lb12[2], Lb12[3]} * xj2;
      X26 -= (f32x2){Lb13[0], Lb13[1]} * xj2;
      X27 -= (f32x2){Lb13[2], Lb13[3]} * xj2;
      X28 -= (f32x2){Lb14[0], Lb14[1]} * xj2;
      X29 -= (f32x2){Lb14[2], Lb14[3]} * xj2;
      X30 -= (f32x2){Lb15[0], Lb15[1]} * xj2;
      X31 -= (f32x2){Lb15[2], Lb15[3]} * xj2;
    }
    __builtin_amdgcn_sched_barrier(0);
    Lb6 = *(const f32x4*)(Lt_s + 1588);
    Lb7 = *(const f32x4*)(Lt_s + 1592);
    Lb8 = *(const f32x4*)(Lt_s + 1596);
    Lb9 = *(const f32x4*)(Lt_s + 1600);
    Lb10 = *(const f32x4*)(Lt_s + 1604);
    Lb11 = *(const f32x4*)(Lt_s + 1608);
    Lb12 = *(const f32x4*)(Lt_s + 1612);
    Lb13 = *(const f32x4*)(Lt_s + 1616);
    Lb14 = *(const f32x4*)(Lt_s + 1620);
    Lb15 = *(const f32x4*)(Lt_s + 1624);
    __builtin_amdgcn_sched_barrier(0);
    { const float xj = X11[0]; const f32x2 xj2 = (f32x2){xj, xj};
      X11 -= (f32x2){La5[2], La5[3]} * xj2;
      X12 -= (f32x2){La6[0], La6[1]} * xj2;
      X13 -= (f32x2){La6[2], La6[3]} * xj2;
      X14 -= (f32x2){La7[0], La7[1]} * xj2;
      X15 -= (f32x2){La7[2], La7[3]} * xj2;
      X16 -= (f32x2){La8[0], La8[1]} * xj2;
      X17 -= (f32x2){La8[2], La8[3]} * xj2;
      X18 -= (f32x2){La9[0], La9[1]} * xj2;
      X19 -= (f32x2){La9[2], La9[3]} * xj2;
      X20 -= (f32x2){La10[0], La10[1]} * xj2;
      X21 -= (f32x2){La10[2], La10[3]} * xj2;
      X22 -= (f32x2){La11[0], La11[1]} * xj2;
      X23 -= (f32x2){La11[2], La11[3]} * xj2;
      X24 -= (f32x2){La12[0], La12[1]} * xj2;
      X25 -= (f32x2){La12[2], La12[3]} * xj2;
      X26 -= (f32x2){La13[0], La13[1]} * xj2;
      X27 -= (f32x2){La13[2], La13[3]} * xj2;
      X28 -= (f32x2){La14[0], La14[1]} * xj2;
      X29 -= (f32x2){La14[2], La14[3]} * xj2;
      X30 -= (f32x2){La15[0], La15[1]} * xj2;
      X31 -= (f32x2){La15[2], La15[3]} * xj2;
    }
    __builtin_amdgcn_sched_barrier(0);
    La6 = *(const f32x4*)(Lt_s + 1656);
    La7 = *(const f32x4*)(Lt_s + 1660);
    La8 = *(const f32x4*)(Lt_s + 1664);
    La9 = *(const f32x4*)(Lt_s + 1668);
    La10 = *(const f32x4*)(Lt_s + 1672);
    La11 = *(const f32x4*)(Lt_s + 1676);
    La12 = *(const f32x4*)(Lt_s + 1680);
    La13 = *(const f32x4*)(Lt_s + 1684);
    La14 = *(const f32x4*)(Lt_s + 1688);
    La15 = *(const f32x4*)(Lt_s + 1692);
    __builtin_amdgcn_sched_barrier(0);
    { const float xj = X11[1]; const f32x2 xj2 = (f32x2){xj, xj};
      X12 -= (f32x2){Lb6[0], Lb6[1]} * xj2;
      X13 -= (f32x2){Lb6[2], Lb6[3]} * xj2;
      X14 -= (f32x2){Lb7[0], Lb7[1]} * xj2;
      X15 -= (f32x2){Lb7[2], Lb7[3]} * xj2;
      X16 -= (f32x2){Lb8[0], Lb8[1]} * xj2;
      X17 -= (f32x2){Lb8[2], Lb8[3]} * xj2;
      X18 -= (f32x2){Lb9[0], Lb9[1]} * xj2;
      X19 -= (f32x2){Lb9[2], Lb9[3]} * xj2;
      X20 -= (f32x2){Lb10[0], Lb10[1]} * xj2;
      X21 -= (f32x2){Lb10[2], Lb10[3]} * xj2;
      X22 -= (f32x2){Lb11[0], Lb11[1]} * xj2;
      X23 -= (f32x2){Lb11[2], Lb11[3]} * xj2;
      X24 -= (f32x2){Lb12[0], Lb12[1]} * xj2;
      X25 -= (f32x2){Lb12[2], Lb12[3]} * xj2;
      X26 -= (f32x2){Lb13[0], Lb13[1]} * xj2;
      X27 -= (f32x2){Lb13[2], Lb13[3]} * xj2;
      X28 -= (f32x2){Lb14[0], Lb14[1]} * xj2;
      X29 -= (f32x2){Lb14[2], Lb14[3]} * xj2;
      X30 -= (f32x2){Lb15[0], Lb15[1]} * xj2;
      X31 -= (f32x2){Lb15[2], Lb15[3]} * xj2;
    }
    __builtin_amdgcn_sched_barrier(0);
    Lb6 = *(const f32x4*)(Lt_s + 1724);
    Lb7 = *(const f32x4*)(Lt_s + 1728);
    Lb8 = *(const f32x4*)(Lt_s + 1732);
    Lb9 = *(const f32x4*)(Lt_s + 1736);
    Lb10 = *(const f32x4*)(Lt_s + 1740);
    Lb11 = *(const f32x4*)(Lt_s + 1744);
    Lb12 = *(const f32x4*)(Lt_s + 1748);
    Lb13 = *(const f32x4*)(Lt_s + 1752);
    Lb14 = *(const f32x4*)(Lt_s + 1756);
    Lb15 = *(const f32x4*)(Lt_s + 1760);
    __builtin_amdgcn_sched_barrier(0);
    { const float xj = X12[0]; const f32x2 xj2 = (f32x2){xj, xj};
      X12 -= (f32x2){La6[0], La6[1]} * xj2;
      X13 -= (f32x2){La6[2], La6[3]} * xj2;
      X14 -= (f32x2){La7[0], La7[1]} * xj2;
      X15 -= (f32x2){La7[2], La7[3]} * xj2;
      X16 -= (f32x2){La8[0], La8[1]} * xj2;
      X17 -= (f32x2){La8[2], La8[3]} * xj2;
      X18 -= (f32x2){La9[0], La9[1]} * xj2;
      X19 -= (f32x2){La9[2], La9[3]} * xj2;
      X20 -= (f32x2){La10[0], La10[1]} * xj2;
      X21 -= (f32x2){La10[2], La10[3]} * xj2;
      X22 -= (f32x2){La11[0], La11[1]} * xj2;
      X23 -= (f32x2){La11[2], La11[3]} * xj2;
      X24 -= (f32x2){La12[0], La12[1]} * xj2;
      X25 -= (f32x2){La12[2], La12[3]} * xj2;
      X26 -= (f32x2){La13[0], La13[1]} * xj2;
      X27 -= (f32x2){La13[2], La13[3]} * xj2;
      X28 -= (f32x2){La14[0], La14[1]} * xj2;
      X29 -= (f32x2){La14[2], La14[3]} * xj2;
      X30 -= (f32x2){La15[0], La15[1]} * xj2;
      X31 -= (f32x2){La15[2], La15[3]} * xj2;
    }
    __builtin_amdgcn_sched_barrier(0);
    La6 = *(const f32x4*)(Lt_s + 1792);
    La7 = *(const f32x4*)(Lt_s + 1796);
    La8 = *(const f32x4*)(Lt_s + 1800);
    La9 = *(const f32x4*)(Lt_s + 1804);
    La10 = *(const f32x4*)(Lt_s + 1808);
    La11 = *(const f32x4*)(Lt_s + 1812);
    La12 = *(const f32x4*)(Lt_s + 1816);
    La13 = *(const f32x4*)(Lt_s + 1820);
    La14 = *(const f32x4*)(Lt_s + 1824);
    La15 = *(const f32x4*)(Lt_s + 1828);
    __builtin_amdgcn_sched_barrier(0);
    { const float xj = X12[1]; const f32x2 xj2 = (f32x2){xj, xj};
      X13 -= (f32x2){Lb6[2], Lb6[3]} * xj2;
      X14 -= (f32x2){Lb7[0], Lb7[1]} * xj2;
      X15 -= (f32x2){Lb7[2], Lb7[3]} * xj2;
      X16 -= (f32x2){Lb8[0], Lb8[1]} * xj2;
      X17 -= (f32x2){Lb8[2], Lb8[3]} * xj2;
      X18 -= (f32x2){Lb9[0], Lb9[1]} * xj2;
      X19 -= (f32x2){Lb9[2], Lb9[3]} * xj2;
      X20 -= (f32x2){Lb10[0], Lb10[1]} * xj2;
      X21 -= (f32x2){Lb10[2], Lb10[3]} * xj2;
      X22 -= (f32x2){Lb11[0], Lb11[1]} * xj2;
      X23 -= (f32x2){Lb11[2], Lb11[3]} * xj2;
      X24 -= (f32x2){Lb12[0], Lb12[1]} * xj2;
      X25 -= (f32x2){Lb12[2], Lb12[3]} * xj2;
      X26 -= (f32x2){Lb13[0], Lb13[1]} * xj2;
      X27 -= (f32x2){Lb13[2], Lb13[3]} * xj2;
      X28 -= (f32x2){Lb14[0], Lb14[1]} * xj2;
      X29 -= (f32x2){Lb14[2], Lb14[3]} * xj2;
      X30 -= (f32x2){Lb15[0], Lb15[1]} * xj2;
      X31 -= (f32x2){Lb15[2], Lb15[3]} * xj2;
    }
    __builtin_amdgcn_sched_barrier(0);
    Lb7 = *(const f32x4*)(Lt_s + 1864);
    Lb8 = *(const f32x4*)(Lt_s + 1868);
    Lb9 = *(const f32x4*)(Lt_s + 1872);
    Lb10 = *(const f32x4*)(Lt_s + 1876);
    Lb11 = *(const f32x4*)(Lt_s + 1880);
    Lb12 = *(const f32x4*)(Lt_s + 1884);
    Lb13 = *(const f32x4*)(Lt_s + 1888);
    Lb14 = *(const f32x4*)(Lt_s + 1892);
    Lb15 = *(const f32x4*)(Lt_s + 1896);
    __builtin_amdgcn_sched_barrier(0);
    { const float xj = X13[0]; const f32x2 xj2 = (f32x2){xj, xj};
      X13 -= (f32x2){La6[2], La6[3]} * xj2;
      X14 -= (f32x2){La7[0], La7[1]} * xj2;
      X15 -= (f32x2){La7[2], La7[3]} * xj2;
      X16 -= (f32x2){La8[0], La8[1]} * xj2;
      X17 -= (f32x2){La8[2], La8[3]} * xj2;
      X18 -= (f32x2){La9[0], La9[1]} * xj2;
      X19 -= (f32x2){La9[2], La9[3]} * xj2;
      X20 -= (f32x2){La10[0], La10[1]} * xj2;
      X21 -= (f32x2){La10[2], La10[3]} * xj2;
      X22 -= (f32x2){La11[0], La11[1]} * xj2;
      X23 -= (f32x2){La11[2], La11[3]} * xj2;
      X24 -= (f32x2){La12[0], La12[1]} * xj2;
      X25 -= (f32x2){La12[2], La12[3]} * xj2;
      X26 -= (f32x2){La13[0], La13[1]} * xj2;
      X27 -= (f32x2){La13[2], La13[3]} * xj2;
      X28 -= (f32x2){La14[0], La14[1]} * xj2;
      X29 -= (f32x2){La14[2], La14[3]} * xj2;
      X30 -= (f32x2){La15[0], La15[1]} * xj2;
      X31 -= (f32x2){La15[2], La15[3]} * xj2;
    }
    __builtin_amdgcn_sched_barrier(0);
    La7 = *(const f32x4*)(Lt_s + 1932);
    La8 = *(const f32x4*)(Lt_s + 1936);
    La9 = *(const f32x4*)(Lt_s + 1940);
    La10 = *(const f32x4*)(Lt_s + 1944);
    La11 = *(const f32x4*)(Lt_s + 1948);
    La12 = *(const f32x4*)(Lt_s + 1952);
    La13 = *(const f32x4*)(Lt_s + 1956);
    La14 = *(const f32x4*)(Lt_s + 1960);
    La15 = *(const f32x4*)(Lt_s + 1964);
    __builtin_amdgcn_sched_barrier(0);
    { const float xj = X13[1]; const f32x2 xj2 = (f32x2){xj, xj};
      X14 -= (f32x2){Lb7[0], Lb7[1]} * xj2;
      X15 -= (f32x2){Lb7[2], Lb7[3]} * xj2;
      X16 -= (f32x2){Lb8[0], Lb8[1]} * xj2;
      X17 -= (f32x2){Lb8[2], Lb8[3]} * xj2;
      X18 -= (f32x2){Lb9[0], Lb9[1]} * xj2;
      X19 -= (f32x2){Lb9[2], Lb9[3]} * xj2;
      X20 -= (f32x2){Lb10[0], Lb10[1]} * xj2;
      X21 -= (f32x2){Lb10[2], Lb10[3]} * xj2;
      X22 -= (f32x2){Lb11[0], Lb11[1]} * xj2;
      X23 -= (f32x2){Lb11[2], Lb11[3]} * xj2;
      X24 -= (f32x2){Lb12[0], Lb12[1]} * xj2;
      X25 -= (f32x2){Lb12[2], Lb12[3]} * xj2;
      X26 -= (f32x2){Lb13[0], Lb13[1]} * xj2;
      X27 -= (f32x2){Lb13[2], Lb13[3]} * xj2;
      X28 -= (f32x2){Lb14[0], Lb14[1]} * xj2;
      X29 -= (f32x2){Lb14[2], Lb14[3]} * xj2;
      X30 -= (f32x2){Lb15[0], Lb15[1]} * xj2;
      X31 -= (f32x2){Lb15[2], Lb15[3]} * xj2;
    }
    __builtin_amdgcn_sched_barrier(0);
    Lb7 = *(const f32x4*)(Lt_s + 2000);
    Lb8 = *(const f32x4*)(Lt_s + 2004);
    Lb9 = *(const f32x4*)(Lt_s + 2008);
    Lb10 = *(const f32x4*)(Lt_s + 2012);
    Lb11 = *(const f32x4*)(Lt_s + 2016);
    Lb12 = *(const f32x4*)(Lt_s + 2020);
    Lb13 = *(const f32x4*)(Lt_s + 2024);
    Lb14 = *(const f32x4*)(Lt_s + 2028);
    Lb15 = *(const f32x4*)(Lt_s + 2032);
    __builtin_amdgcn_sched_barrier(0);
    { const float xj = X14[0]; const f32x2 xj2 = (f32x2){xj, xj};
      X14 -= (f32x2){La7[0], La7[1]} * xj2;
      X15 -= (f32x2){La7[2], La7[3]} * xj2;
      X16 -= (f32x2){La8[0], La8[1]} * xj2;
      X17 -= (f32x2){La8[2], La8[3]} * xj2;
      X18 -= (f32x2){La9[0], La9[1]} * xj2;
      X19 -= (f32x2){La9[2], La9[3]} * xj2;
      X20 -= (f32x2){La10[0], La10[1]} * xj2;
      X21 -= (f32x2){La10[2], La10[3]} * xj2;
      X22 -= (f32x2){La11[0], La11[1]} * xj2;
      X23 -= (f32x2){La11[2], La11[3]} * xj2;
      X24 -= (f32x2){La12[0], La12[1]} * xj2;
      X25 -= (f32x2){La12[2], La12[3]} * xj2;
      X26 -= (f32x2){La13[0], La13[1]} * xj2;
      X27 -= (f32x2){La13[2], La13[3]} * xj2;
      X28 -= (f32x2){La14[0], La14[1]} * xj2;
      X29 -= (f32x2){La14[2], La14[3]} * xj2;
      X30 -= (f32x2){La15[0], La15[1]} * xj2;
      X31 -= (f32x2){La15[2], La15[3]} * xj2;
    }
    __builtin_amdgcn_sched_barrier(0);
    La7 = *(const f32x4*)(Lt_s + 2068);
    La8 = *(const f32x4*)(Lt_s + 2072);
    La9 = *(const f32x4*)(Lt_s + 2076);
    La10 = *(const f32x4*)(Lt_s + 2080);
    La11 = *(const f32x4*)(Lt_s + 2084);
    La12 = *(const f32x4*)(Lt_s + 2088);
    La13 = *(const f32x4*)(Lt_s + 2092);
    La14 = *(const f32x4*)(Lt_s + 2096);
    La15 = *(const f32x4*)(Lt_s + 2100);
    __builtin_amdgcn_sched_barrier(0);
    { const float xj = X14[1]; const f32x2 xj2 = (f32x2){xj, xj};
      X15 -= (f32x2){Lb7[2], Lb7[3]} * xj2;
      X16 -= (f32x2){Lb8[0], Lb8[1]} * xj2;
      X17 -= (f32x2){Lb8[2], Lb8[3]} * xj2;
      X18 -= (f32x2){Lb9[0], Lb9[1]} * xj2;
      X19 -= (f32x2){Lb9[2], Lb9[3]} * xj2;
      X20 -= (f32x2){Lb10[0], Lb10[1]} * xj2;
      X21 -= (f32x2){Lb10[2], Lb10[3]} * xj2;
      X22 -= (f32x2){Lb11[0], Lb11[1]} * xj2;
      X23 -= (f32x2){Lb11[2], Lb11[3]} * xj2;
      X24 -= (f32x2){Lb12[0], Lb12[1]} * xj2;
      X25 -= (f32x2){Lb12[2], Lb12[3]} * xj2;
      X26 -= (f32x2){Lb13[0], Lb13[1]} * xj2;
      X27 -= (f32x2){Lb13[2], Lb13[3]} * xj2;
      X28 -= (f32x2){Lb14[0], Lb14[1]} * xj2;
      X29 -= (f32x2){Lb14[2], Lb14[3]} * xj2;
      X30 -= (f32x2){Lb15[0], Lb15[1]} * xj2;
      X31 -= (f32x2){Lb15[2], Lb15[3]} * xj2;
    }
    __builtin_amdgcn_sched_barrier(0);
    Lb8 = *(const f32x4*)(Lt_s + 2140);
    Lb9 = *(const f32x4*)(Lt_s + 2144);
    Lb10 = *(const f32x4*)(Lt_s + 2148);
    Lb11 = *(const f32x4*)(Lt_s + 2152);
    Lb12 = *(const f32x4*)(Lt_s + 2156);
    Lb13 = *(const f32x4*)(Lt_s + 2160);
    Lb14 = *(const f32x4*)(Lt_s + 2164);
    Lb15 = *(const f32x4*)(Lt_s + 2168);
    __builtin_amdgcn_sched_barrier(0);
    { const float xj = X15[0]; const f32x2 xj2 = (f32x2){xj, xj};
      X15 -= (f32x2){La7[2], La7[3]} * xj2;
      X16 -= (f32x2){La8[0], La8[1]} * xj2;
      X17 -= (f32x2){La8[2], La8[3]} * xj2;
      X18 -= (f32x2){La9[0], La9[1]} * xj2;
      X19 -= (f32x2){La9[2], La9[3]} * xj2;
      X20 -= (f32x2){La10[0], La10[1]} * xj2;
      X21 -= (f32x2){La10[2], La10[3]} * xj2;
      X22 -= (f32x2){La11[0], La11[1]} * xj2;
      X23 -= (f32x2){La11[2], La11[3]} * xj2;
      X24 -= (f32x2){La12[0], La12[1]} * xj2;
      X25 -= (f32x2){La12[2], La12[3]} * xj2;
      X26 -= (f32x2){La13[0], La13[1]} * xj2;
      X27 -= (f32x2){La13[2], La13[3]} * xj2;
      X28 -= (f32x2){La14[0], La14[1]} * xj2;
      X29 -= (f32x2){La14[2], La14[3]} * xj2;
      X30 -= (f32x2){La15[0], La15[1]} * xj2;
      X31 -= (f32x2){La15[2], La15[3]} * xj2;
    }
    __builtin_amdgcn_sched_barrier(0);
    La8 = *(const f32x4*)(Lt_s + 2208);
    La9 = *(const f32x4*)(Lt_s + 2212);
    La10 = *(const f32x4*)(Lt_s + 2216);
    La11 = *(const f32x4*)(Lt_s + 2220);
    La12 = *(const f32x4*)(Lt_s + 2224);
    La13 = *(const f32x4*)(Lt_s + 2228);
    La14 = *(const f32x4*)(Lt_s + 2232);
    La15 = *(const f32x4*)(Lt_s + 2236);
    __builtin_amdgcn_sched_barrier(0);
    { const float xj = X15[1]; const f32x2 xj2 = (f32x2){xj, xj};
      X16 -= (f32x2){Lb8[0], Lb8[1]} * xj2;
      X17 -= (f32x2){Lb8[2], Lb8[3]} * xj2;
      X18 -= (f32x2){Lb9[0], Lb9[1]} * xj2;
      X19 -= (f32x2){Lb9[2], Lb9[3]} * xj2;
      X20 -= (f32x2){Lb10[0], Lb10[1]} * xj2;
      X21 -= (f32x2){Lb10[2], Lb10[3]} * xj2;
      X22 -= (f32x2){Lb11[0], Lb11[1]} * xj2;
      X23 -= (f32x2){Lb11[2], Lb11[3]} * xj2;
      X24 -= (f32x2){Lb12[0], Lb12[1]} * xj2;
      X25 -= (f32x2){Lb12[2], Lb12[3]} * xj2;
      X26 -= (f32x2){Lb13[0], Lb13[1]} * xj2;
      X27 -= (f32x2){Lb13[2], Lb13[3]} * xj2;
      X28 -= (f32x2){Lb14[0], Lb14[1]} * xj2;
      X29 -= (f32x2){Lb14[2], Lb14[3]} * xj2;
      X30 -= (f32x2){Lb15[0], Lb15[1]} * xj2;
      X31 -= (f32x2){Lb15[2], Lb15[3]} * xj2;
    }
    __builtin_amdgcn_sched_barrier(0);
    Lb8 = *(const f32x4*)(Lt_s + 2276);
    Lb9 = *(const f32x4*)(Lt_s + 2280);
    Lb10 = *(const f32x4*)(Lt_s + 2284);
    Lb11 = *(const f32x4*)(Lt_s + 2288);
    Lb12 = *(const f32x4*)(Lt_s + 2292);
    Lb13 = *(const f32x4*)(Lt_s + 2296);
    Lb14 = *(const f32x4*)(Lt_s + 2300);
    Lb15 = *(const f32x4*)(Lt_s + 2304);
    __builtin_amdgcn_sched_barrier(0);
    { const float xj = X16[0]; const f32x2 xj2 = (f32x2){xj, xj};
      X16 -= (f32x2){La8[0], La8[1]} * xj2;
      X17 -= (f32x2){La8[2], La8[3]} * xj2;
      X18 -= (f32x2){La9[0], La9[1]} * xj2;
      X19 -= (f32x2){La9[2], La9[3]} * xj2;
      X20 -= (f32x2){La10[0], La10[1]} * xj2;
      X21 -= (f32x2){La10[2], La10[3]} * xj2;
      X22 -= (f32x2){La11[0], La11[1]} * xj2;
      X23 -= (f32x2){La11[2], La11[3]} * xj2;
      X24 -= (f32x2){La12[0], La12[1]} * xj2;
      X25 -= (f32x2){La12[2], La12[3]} * xj2;
      X26 -= (f32x2){La13[0], La13[1]} * xj2;
      X27 -= (f32x2){La13[2], La13[3]} * xj2;
      X28 -= (f32x2){La14[0], La14[1]} * xj2;
      X29 -= (f32x2){La14[2], La14[3]} * xj2;
      X30 -= (f32x2){La15[0], La15[1]} * xj2;
      X31 -= (f32x2){La15[2], La15[3]} * xj2;
    }
    __builtin_amdgcn_sched_barrier(0);
    La8 = *(const f32x4*)(Lt_s + 2344);
    La9 = *(const f32x4*)(Lt_s + 2348);
    La10 = *(const f32x4*)(Lt_s + 2352);
    La11 = *(const f32x4*)(Lt_s + 2356);
    La12 = *(const f32x4*)(Lt_s + 2360);
    La13 = *(const f32x4*)(Lt_s + 2364);
    La14 = *(const f32x4*)(Lt_s + 2368);
    La15 = *(const f32x4*)(Lt_s + 2372);
    __builtin_amdgcn_sched_barrier(0);
    { const float xj = X16[1]; const f32x2 xj2 = (f32x2){xj, xj};
      X17 -= (f32x2){Lb8[2], Lb8[3]} * xj2;
      X18 -= (f32x2){Lb9[0], Lb9[1]} * xj2;
      X19 -= (f32x2){Lb9[2], Lb9[3]} * xj2;
      X20 -= (f32x2){Lb10[0], Lb10[1]} * xj2;
      X21 -= (f32x2){Lb10[2], Lb10[3]} * xj2;
      X22 -= (f32x2){Lb11[0], Lb11[1]} * xj2;
      X23 -= (f32x2){Lb11[2], Lb11[3]} * xj2;
      X24 -= (f32x2){Lb12[0], Lb12[1]} * xj2;
      X25 -= (f32x2){Lb12[2], Lb12[3]} * xj2;
      X26 -= (f32x2){Lb13[0], Lb13[1]} * xj2;
      X27 -= (f32x2){Lb13[2], Lb13[3]} * xj2;
      X28 -= (f32x2){Lb14[0], Lb14[1]} * xj2;
      X29 -= (f32x2){Lb14[2], Lb14[3]} * xj2;
      X30 -= (f32x2){Lb15[0], Lb15[1]} * xj2;
      X31 -= (f32x2){Lb15[2], Lb15[3]} * xj2;
    }
    __builtin_amdgcn_sched_barrier(0);
    Lb9 = *(const f32x4*)(Lt_s + 2416);
    Lb10 = *(const f32x4*)(Lt_s + 2420);
    Lb11 = *(const f32x4*)(Lt_s + 2424);
    Lb12 = *(const f32x4*)(Lt_s + 2428);
    Lb13 = *(const f32x4*)(Lt_s + 2432);
    Lb14 = *(const f32x4*)(Lt_s + 2436);
    Lb15 = *(const f32x4*)(Lt_s + 2440);
    __builtin_amdgcn_sched_barrier(0);
    { const float xj = X17[0]; const f32x2 xj2 = (f32x2){xj, xj};
      X17 -= (f32x2){La8[2], La8[3]} * xj2;
      X18 -= (f32x2){La9[0], La9[1]} * xj2;
      X19 -= (f32x2){La9[2], La9[3]} * xj2;
      X20 -= (f32x2){La10[0], La10[1]} * xj2;
      X21 -= (f32x2){La10[2], La10[3]} * xj2;
      X22 -= (f32x2){La11[0], La11[1]} * xj2;
      X23 -= (f32x2){La11[2], La11[3]} * xj2;
      X24 -= (f32x2){La12[0], La12[1]} * xj2;
      X25 -= (f32x2){La12[2], La12[3]} * xj2;
      X26 -= (f32x2){La13[0], La13[1]} * xj2;
      X27 -= (f32x2){La13[2], La13[3]} * xj2;
      X28 -= (f32x2){La14[0], La14[1]} * xj2;
      X29 -= (f32x2){La14[2], La14[3]} * xj2;
      X30 -= (f32x2){La15[0], La15[1]} * xj2;
      X31 -= (f32x2){La15[2], La15[3]} * xj2;
    }
    __builtin_amdgcn_sched_barrier(0);
    La9 = *(const f32x4*)(Lt_s + 2484);
    La10 = *(const f32x4*)(Lt_s + 2488);
    La11 = *(const f32x4*)(Lt_s + 2492);
    La12 = *(const f32x4*)(Lt_s + 2496);
    La13 = *(const f32x4*)(Lt_s + 2500);
    La14 = *(const f32x4*)(Lt_s + 2504);
    La15 = *(const f32x4*)(Lt_s + 2508);
    __builtin_amdgcn_sched_barrier(0);
    { const float xj = X17[1]; const f32x2 xj2 = (f32x2){xj, xj};
      X18 -= (f32x2){Lb9[0], Lb9[1]} * xj2;
      X19 -= (f32x2){Lb9[2], Lb9[3]} * xj2;
      X20 -= (f32x2){Lb10[0], Lb10[1]} * xj2;
      X21 -= (f32x2){Lb10[2], Lb10[3]} * xj2;
      X22 -= (f32x2){Lb11[0], Lb11[1]} * xj2;
      X23 -= (f32x2){Lb11[2], Lb11[3]} * xj2;
      X24 -= (f32x2){Lb12[0], Lb12[1]} * xj2;
      X25 -= (f32x2){Lb12[2], Lb12[3]} * xj2;
      X26 -= (f32x2){Lb13[0], Lb13[1]} * xj2;
      X27 -= (f32x2){Lb13[2], Lb13[3]} * xj2;
      X28 -= (f32x2){Lb14[0], Lb14[1]} * xj2;
      X29 -= (f32x2){Lb14[2], Lb14[3]} * xj2;
      X30 -= (f32x2){Lb15[0], Lb15[1]} * xj2;
      X31 -= (f32x2){Lb15[2], Lb15[3]} * xj2;
    }
    __builtin_amdgcn_sched_barrier(0);
    Lb9 = *(const f32x4*)(Lt_s + 2552);
    Lb10 = *(const f32x4*)(Lt_s + 2556);
    Lb11 = *(const f32x4*)(Lt_s + 2560);
    Lb12 = *(const f32x4*)(Lt_s + 2564);
    Lb13 = *(const f32x4*)(Lt_s + 2568);
    Lb14 = *(const f32x4*)(Lt_s + 2572);
    Lb15 = *(const f32x4*)(Lt_s + 2576);
    __builtin_amdgcn_sched_barrier(0);
    { const float xj = X18[0]; const f32x2 xj2 = (f32x2){xj, xj};
      X18 -= (f32x2){La9[0], La9[1]} * xj2;
      X19 -= (f32x2){La9[2], La9[3]} * xj2;
      X20 -= (f32x2){La10[0], La10[1]} * xj2;
      X21 -= (f32x2){La10[2], La10[3]} * xj2;
      X22 -= (f32x2){La11[0], La11[1]} * xj2;
      X23 -= (f32x2){La11[2], La11[3]} * xj2;
      X24 -= (f32x2){La12[0], La12[1]} * xj2;
      X25 -= (f32x2){La12[2], La12[3]} * xj2;
      X26 -= (f32x2){La13[0], La13[1]} * xj2;
      X27 -= (f32x2){La13[2], La13[3]} * xj2;
      X28 -= (f32x2){La14[0], La14[1]} * xj2;
      X29 -= (f32x2){La14[2], La14[3]} * xj2;
      X30 -= (f32x2){La15[0], La15[1]} * xj2;
      X31 -= (f32x2){La15[2], La15[3]} * xj2;
    }
    __builtin_amdgcn_sched_barrier(0);
    La9 = *(const f32x4*)(Lt_s + 2620);
    La10 = *(const f32x4*)(Lt_s + 2624);
    La11 = *(const f32x4*)(Lt_s + 2628);
    La12 = *(const f32x4*)(Lt_s + 2632);
    La13 = *(const f32x4*)(Lt_s + 2636);
    La14 = *(const f32x4*)(Lt_s + 2640);
    La15 = *(const f32x4*)(Lt_s + 2644);
    __builtin_amdgcn_sched_barrier(0);
    { const float xj = X18[1]; const f32x2 xj2 = (f32x2){xj, xj};
      X19 -= (f32x2){Lb9[2], Lb9[3]} * xj2;
      X20 -= (f32x2){Lb10[0], Lb10[1]} * xj2;
      X21 -= (f32x2){Lb10[2], Lb10[3]} * xj2;
      X22 -= (f32x2){Lb11[0], Lb11[1]} * xj2;
      X23 -= (f32x2){Lb11[2], Lb11[3]} * xj2;
      X24 -= (f32x2){Lb12[0], Lb12[1]} * xj2;
      X25 -= (f32x2){Lb12[2], Lb12[3]} * xj2;
      X26 -= (f32x2){Lb13[0], Lb13[1]} * xj2;
      X27 -= (f32x2){Lb13[2], Lb13[3]} * xj2;
      X28 -= (f32x2){Lb14[0], Lb14[1]} * xj2;
      X29 -= (f32x2){Lb14[2], Lb14[3]} * xj2;
      X30 -= (f32x2){Lb15[0], Lb15[1]} * xj2;
      X31 -= (f32x2){Lb15[2], Lb15[3]} * xj2;
    }
    __builtin_amdgcn_sched_barrier(0);
    Lb10 = *(const f32x4*)(Lt_s + 2692);
    Lb11 = *(const f32x4*)(Lt_s + 2696);
    Lb12 = *(const f32x4*)(Lt_s + 2700);
    Lb13 = *(const f32x4*)(Lt_s + 2704);
    Lb14 = *(const f32x4*)(Lt_s + 2708);
    Lb15 = *(const f32x4*)(Lt_s + 2712);
    __builtin_amdgcn_sched_barrier(0);
    { const float xj = X19[0]; const f32x2 xj2 = (f32x2){xj, xj};
      X19 -= (f32x2){La9[2], La9[3]} * xj2;
      X20 -= (f32x2){La10[0], La10[1]} * xj2;
      X21 -= (f32x2){La10[2], La10[3]} * xj2;
      X22 -= (f32x2){La11[0], La11[1]} * xj2;
      X23 -= (f32x2){La11[2], La11[3]} * xj2;
      X24 -= (f32x2){La12[0], La12[1]} * xj2;
      X25 -= (f32x2){La12[2], La12[3]} * xj2;
      X26 -= (f32x2){La13[0], La13[1]} * xj2;
      X27 -= (f32x2){La13[2], La13[3]} * xj2;
      X28 -= (f32x2){La14[0], La14[1]} * xj2;
      X29 -= (f32x2){La14[2], La14[3]} * xj2;
      X30 -= (f32x2){La15[0], La15[1]} * xj2;
      X31 -= (f32x2){La15[2], La15[3]} * xj2;
    }
    __builtin_amdgcn_sched_barrier(0);
    La10 = *(const f32x4*)(Lt_s + 2760);
    La11 = *(const f32x4*)(Lt_s + 2764);
    La12 = *(const f32x4*)(Lt_s + 2768);
    La13 = *(const f32x4*)(Lt_s + 2772);
    La14 = *(const f32x4*)(Lt_s + 2776);
    La15 = *(const f32x4*)(Lt_s + 2780);
    __builtin_amdgcn_sched_barrier(0);
    { const float xj = X19[1]; const f32x2 xj2 = (f32x2){xj, xj};
      X20 -= (f32x2){Lb10[0], Lb10[1]} * xj2;
      X21 -= (f32x2){Lb10[2], Lb10[3]} * xj2;
      X22 -= (f32x2){Lb11[0], Lb11[1]} * xj2;
      X23 -= (f32x2){Lb11[2], Lb11[3]} * xj2;
      X24 -= (f32x2){Lb12[0], Lb12[1]} * xj2;
      X25 -= (f32x2){Lb12[2], Lb12[3]} * xj2;
      X26 -= (f32x2){Lb13[0], Lb13[1]} * xj2;
      X27 -= (f32x2){Lb13[2], Lb13[3]} * xj2;
      X28 -= (f32x2){Lb14[0], Lb14[1]} * xj2;
      X29 -= (f32x2){Lb14[2], Lb14[3]} * xj2;
      X30 -= (f32x2){Lb15[0], Lb15[1]} * xj2;
      X31 -= (f32x2){Lb15[2], Lb15[3]} * xj2;
    }
    __builtin_amdgcn_sched_barrier(0);
    Lb10 = *(const f32x4*)(Lt_s + 2828);
    Lb11 = *(const f32x4*)(Lt_s + 2832);
    Lb12 = *(const f32x4*)(Lt_s + 2836);
    Lb13 = *(const f32x4*)(Lt_s + 2840);
    Lb14 = *(const f32x4*)(Lt_s + 2844);
    Lb15 = *(const f32x4*)(Lt_s + 2848);
    __builtin_amdgcn_sched_barrier(0);
    { const float xj = X20[0]; const f32x2 xj2 = (f32x2){xj, xj};
      X20 -= (f32x2){La10[0], La10[1]} * xj2;
      X21 -= (f32x2){La10[2], La10[3]} * xj2;
      X22 -= (f32x2){La11[0], La11[1]} * xj2;
      X23 -= (f32x2){La11[2], La11[3]} * xj2;
      X24 -= (f32x2){La12[0], La12[1]} * xj2;
      X25 -= (f32x2){La12[2], La12[3]} * xj2;
      X26 -= (f32x2){La13[0], La13[1]} * xj2;
      X27 -= (f32x2){La13[2], La13[3]} * xj2;
      X28 -= (f32x2){La14[0], La14[1]} * xj2;
      X29 -= (f32x2){La14[2], La14[3]} * xj2;
      X30 -= (f32x2){La15[0], La15[1]} * xj2;
      X31 -= (f32x2){La15[2], La15[3]} * xj2;
    }
    __builtin_amdgcn_sched_barrier(0);
    La10 = *(const f32x4*)(Lt_s + 2896);
    La11 = *(const f32x4*)(Lt_s + 2900);
    La12 = *(const f32x4*)(Lt_s + 2904);
    La13 = *(const f32x4*)(Lt_s + 2908);
    La14 = *(const f32x4*)(Lt_s + 2912);
    La15 = *(const f32x4*)(Lt_s + 2916);
    __builtin_amdgcn_sched_barrier(0);
    { const float xj = X20[1]; const f32x2 xj2 = (f32x2){xj, xj};
      X21 -= (f32x2){Lb10[2], Lb10[3]} * xj2;
      X22 -= (f32x2){Lb11[0], Lb11[1]} * xj2;
      X23 -= (f32x2){Lb11[2], Lb11[3]} * xj2;
      X24 -= (f32x2){Lb12[0], Lb12[1]} * xj2;
      X25 -= (f32x2){Lb12[2], Lb12[3]} * xj2;
      X26 -= (f32x2){Lb13[0], Lb13[1]} * xj2;
      X27 -= (f32x2){Lb13[2], Lb13[3]} * xj2;
      X28 -= (f32x2){Lb14[0], Lb14[1]} * xj2;
      X29 -= (f32x2){Lb14[2], Lb14[3]} * xj2;
      X30 -= (f32x2){Lb15[0], Lb15[1]} * xj2;
      X31 -= (f32x2){Lb15[2], Lb15[3]} * xj2;
    }
    __builtin_amdgcn_sched_barrier(0);
    Lb11 = *(const f32x4*)(Lt_s + 2968);
    Lb12 = *(const f32x4*)(Lt_s + 2972);
    Lb13 = *(const f32x4*)(Lt_s + 2976);
    Lb14 = *(const f32x4*)(Lt_s + 2980);
    Lb15 = *(const f32x4*)(Lt_s + 2984);
    __builtin_amdgcn_sched_barrier(0);
    { const float xj = X21[0]; const f32x2 xj2 = (f32x2){xj, xj};
      X21 -= (f32x2){La10[2], La10[3]} * xj2;
      X22 -= (f32x2){La11[0], La11[1]} * xj2;
      X23 -= (f32x2){La11[2], La11[3]} * xj2;
      X24 -= (f32x2){La12[0], La12[1]} * xj2;
      X25 -= (f32x2){La12[2], La12[3]} * xj2;
      X26 -= (f32x2){La13[0], La13[1]} * xj2;
      X27 -= (f32x2){La13[2], La13[3]} * xj2;
      X28 -= (f32x2){La14[0], La14[1]} * xj2;
      X29 -= (f32x2){La14[2], La14[3]} * xj2;
      X30 -= (f32x2){La15[0], La15[1]} * xj2;
      X31 -= (f32x2){La15[2], La15[3]} * xj2;
    }
    __builtin_amdgcn_sched_barrier(0);
    La11 = *(const f32x4*)(Lt_s + 3036);
    La12 = *(const f32x4*)(Lt_s + 3040);
    La13 = *(const f32x4*)(Lt_s + 3044);
    La14 = *(const f32x4*)(Lt_s + 3048);
    La15 = *(const f32x4*)(Lt_s + 3052);
    __builtin_amdgcn_sched_barrier(0);
    { const float xj = X21[1]; const f32x2 xj2 = (f32x2){xj, xj};
      X22 -= (f32x2){Lb11[0], Lb11[1]} * xj2;
      X23 -= (f32x2){Lb11[2], Lb11[3]} * xj2;
      X24 -= (f32x2){Lb12[0], Lb12[1]} * xj2;
      X25 -= (f32x2){Lb12[2], Lb12[3]} * xj2;
      X26 -= (f32x2){Lb13[0], Lb13[1]} * xj2;
      X27 -= (f32x2){Lb13[2], Lb13[3]} * xj2;
      X28 -= (f32x2){Lb14[0], Lb14[1]} * xj2;
      X29 -= (f32x2){Lb14[2], Lb14[3]} * xj2;
      X30 -= (f32x2){Lb15[0], Lb15[1]} * xj2;
      X31 -= (f32x2){Lb15[2], Lb15[3]} * xj2;
    }
    __builtin_amdgcn_sched_barrier(0);
    Lb11 = *(const f32x4*)(Lt_s + 3104);
    Lb12 = *(const f32x4*)(Lt_s + 3108);
    Lb13 = *(const f32x4*)(Lt_s + 3112);
    Lb14 = *(const f32x4*)(Lt_s + 3116);
    Lb15 = *(const f32x4*)(Lt_s + 3120);
    __builtin_amdgcn_sched_barrier(0);
    { const float xj = X22[0]; const f32x2 xj2 = (f32x2){xj, xj};
      X22 -= (f32x2){La11[0], La11[1]} * xj2;
      X23 -= (f32x2){La11[2], La11[3]} * xj2;
      X24 -= (f32x2){La12[0], La12[1]} * xj2;
      X25 -= (f32x2){La12[2], La12[3]} * xj2;
      X26 -= (f32x2){La13[0], La13[1]} * xj2;
      X27 -= (f32x2){La13[2], La13[3]} * xj2;
      X28 -= (f32x2){La14[0], La14[1]} * xj2;
      X29 -= (f32x2){La14[2], La14[3]} * xj2;
      X30 -= (f32x2){La15[0], La15[1]} * xj2;
      X31 -= (f32x2){La15[2], La15[3]} * xj2;
    }
    __builtin_amdgcn_sched_barrier(0);
    La11 = *(const f32x4*)(Lt_s + 3172);
    La12 = *(const f32x4*)(Lt_s + 3176);
    La13 = *(const f32x4*)(Lt_s + 3180);
    La14 = *(const f32x4*)(Lt_s + 3184);
    La15 = *(const f32x4*)(Lt_s + 3188);
    __builtin_amdgcn_sched_barrier(0);
    { const float xj = X22[1]; const f32x2 xj2 = (f32x2){xj, xj};
      X23 -= (f32x2){Lb11[2], Lb11[3]} * xj2;
      X24 -= (f32x2){Lb12[0], Lb12[1]} * xj2;
      X25 -= (f32x2){Lb12[2], Lb12[3]} * xj2;
      X26 -= (f32x2){Lb13[0], Lb13[1]} * xj2;
      X27 -= (f32x2){Lb13[2], Lb13[3]} * xj2;
      X28 -= (f32x2){Lb14[0], Lb14[1]} * xj2;
      X29 -= (f32x2){Lb14[2], Lb14[3]} * xj2;
      X30 -= (f32x2){Lb15[0], Lb15[1]} * xj2;
      X31 -= (f32x2){Lb15[2], Lb15[3]} * xj2;
    }
    __builtin_amdgcn_sched_barrier(0);
    Lb12 = *(const f32x4*)(Lt_s + 3244);
    Lb13 = *(const f32x4*)(Lt_s + 3248);
    Lb14 = *(const f32x4*)(Lt_s + 3252);
    Lb15 = *(const f32x4*)(Lt_s + 3256);
    __builtin_amdgcn_sched_barrier(0);
    { const float xj = X23[0]; const f32x2 xj2 = (f32x2){xj, xj};
      X23 -= (f32x2){La11[2], La11[3]} * xj2;
      X24 -= (f32x2){La12[0], La12[1]} * xj2;
      X25 -= (f32x2){La12[2], La12[3]} * xj2;
      X26 -= (f32x2){La13[0], La13[1]} * xj2;
      X27 -= (f32x2){La13[2], La13[3]} * xj2;
      X28 -= (f32x2){La14[0], La14[1]} * xj2;
      X29 -= (f32x2){La14[2], La14[3]} * xj2;
      X30 -= (f32x2){La15[0], La15[1]} * xj2;
      X31 -= (f32x2){La15[2], La15[3]} * xj2;
    }
    __builtin_amdgcn_sched_barrier(0);
    La12 = *(const f32x4*)(Lt_s + 3312);
    La13 = *(const f32x4*)(Lt_s + 3316);
    La14 = *(const f32x4*)(Lt_s + 3320);
    La15 = *(const f32x4*)(Lt_s + 3324);
    __builtin_amdgcn_sched_barrier(0);
    { const float xj = X23[1]; const f32x2 xj2 = (f32x2){xj, xj};
      X24 -= (f32x2){Lb12[0], Lb12[1]} * xj2;
      X25 -= (f32x2){Lb12[2], Lb12[3]} * xj2;
      X26 -= (f32x2){Lb13[0], Lb13[1]} * xj2;
      X27 -= (f32x2){Lb13[2], Lb13[3]} * xj2;
      X28 -= (f32x2){Lb14[0], Lb14[1]} * xj2;
      X29 -= (f32x2){Lb14[2], Lb14[3]} * xj2;
      X30 -= (f32x2){Lb15[0], Lb15[1]} * xj2;
      X31 -= (f32x2){Lb15[2], Lb15[3]} * xj2;
    }
    __builtin_amdgcn_sched_barrier(0);
    Lb12 = *(const f32x4*)(Lt_s + 3380);
    Lb13 = *(const f32x4*)(Lt_s + 3384);
    Lb14 = *(const f32x4*)(Lt_s + 3388);
    Lb15 = *(const f32x4*)(Lt_s + 3392);
    __builtin_amdgcn_sched_barrier(0);
    { const float xj = X24[0]; const f32x2 xj2 = (f32x2){xj, xj};
      X24 -= (f32x2){La12[0], La12[1]} * xj2;
      X25 -= (f32x2){La12[2], La12[3]} * xj2;
      X26 -= (f32x2){La13[0], La13[1]} * xj2;
      X27 -= (f32x2){La13[2], La13[3]} * xj2;
      X28 -= (f32x2){La14[0], La14[1]} * xj2;
      X29 -= (f32x2){La14[2], La14[3]} * xj2;
      X30 -= (f32x2){La15[0], La15[1]} * xj2;
      X31 -= (f32x2){La15[2], La15[3]} * xj2;
    }
    __builtin_amdgcn_sched_barrier(0);
    La12 = *(const f32x4*)(Lt_s + 3448);
    La13 = *(const f32x4*)(Lt_s + 3452);
    La14 = *(const f32x4*)(Lt_s + 3456);
    La15 = *(const f32x4*)(Lt_s + 3460);
    __builtin_amdgcn_sched_barrier(0);
    { const float xj = X24[1]; const f32x2 xj2 = (f32x2){xj, xj};
      X25 -= (f32x2){Lb12[2], Lb12[3]} * xj2;
      X26 -= (f32x2){Lb13[0], Lb13[1]} * xj2;
      X27 -= (f32x2){Lb13[2], Lb13[3]} * xj2;
      X28 -= (f32x2){Lb14[0], Lb14[1]} * xj2;
      X29 -= (f32x2){Lb14[2], Lb14[3]} * xj2;
      X30 -= (f32x2){Lb15[0], Lb15[1]} * xj2;
      X31 -= (f32x2){Lb15[2], Lb15[3]} * xj2;
    }
    __builtin_amdgcn_sched_barrier(0);
    Lb13 = *(const f32x4*)(Lt_s + 3520);
    Lb14 = *(const f32x4*)(Lt_s + 3524);
    Lb15 = *(const f32x4*)(Lt_s + 3528);
    __builtin_amdgcn_sched_barrier(0);
    { const float xj = X25[0]; const f32x2 xj2 = (f32x2){xj, xj};
      X25 -= (f32x2){La12[2], La12[3]} * xj2;
      X26 -= (f32x2){La13[0], La13[1]} * xj2;
      X27 -= (f32x2){La13[2], La13[3]} * xj2;
      X28 -= (f32x2){La14[0], La14[1]} * xj2;
      X29 -= (f32x2){La14[2], La14[3]} * xj2;
      X30 -= (f32x2){La15[0], La15[1]} * xj2;
      X31 -= (f32x2){La15[2], La15[3]} * xj2;
    }
    __builtin_amdgcn_sched_barrier(0);
    La13 = *(const f32x4*)(Lt_s + 3588);
    La14 = *(const f32x4*)(Lt_s + 3592);
    La15 = *(const f32x4*)(Lt_s + 3596);
    __builtin_amdgcn_sched_barrier(0);
    { const float xj = X25[1]; const f32x2 xj2 = (f32x2){xj, xj};
      X26 -= (f32x2){Lb13[0], Lb13[1]} * xj2;
      X27 -= (f32x2){Lb13[2], Lb13[3]} * xj2;
      X28 -= (f32x2){Lb14[0], Lb14[1]} * xj2;
      X29 -= (f32x2){Lb14[2], Lb14[3]} * xj2;
      X30 -= (f32x2){Lb15[0], Lb15[1]} * xj2;
      X31 -= (f32x2){Lb15[2], Lb15[3]} * xj2;
    }
    __builtin_amdgcn_sched_barrier(0);
    Lb13 = *(const f32x4*)(Lt_s + 3656);
    Lb14 = *(const f32x4*)(Lt_s + 3660);
    Lb15 = *(const f32x4*)(Lt_s + 3664);
    __builtin_amdgcn_sched_barrier(0);
    { const float xj = X26[0]; const f32x2 xj2 = (f32x2){xj, xj};
      X26 -= (f32x2){La13[0], La13[1]} * xj2;
      X27 -= (f32x2){La13[2], La13[3]} * xj2;
      X28 -= (f32x2){La14[0], La14[1]} * xj2;
      X29 -= (f32x2){La14[2], La14[3]} * xj2;
      X30 -= (f32x2){La15[0], La15[1]} * xj2;
      X31 -= (f32x2){La15[2], La15[3]} * xj2;
    }
    __builtin_amdgcn_sched_barrier(0);
    La13 = *(const f32x4*)(Lt_s + 3724);
    La14 = *(const f32x4*)(Lt_s + 3728);
    La15 = *(const f32x4*)(Lt_s + 3732);
    __builtin_amdgcn_sched_barrier(0);
    { const float xj = X26[1]; const f32x2 xj2 = (f32x2){xj, xj};
      X27 -= (f32x2){Lb13[2], Lb13[3]} * xj2;
      X28 -= (f32x2){Lb14[0], Lb14[1]} * xj2;
      X29 -= (f32x2){Lb14[2], Lb14[3]} * xj2;
      X30 -= (f32x2){Lb15[0], Lb15[1]} * xj2;
      X31 -= (f32x2){Lb15[2], Lb15[3]} * xj2;
    }
    __builtin_amdgcn_sched_barrier(0);
    Lb14 = *(const f32x4*)(Lt_s + 3796);
    Lb15 = *(const f32x4*)(Lt_s + 3800);
    __builtin_amdgcn_sched_barrier(0);
    { const float xj = X27[0]; const f32x2 xj2 = (f32x2){xj, xj};
      X27 -= (f32x2){La13[2], La13[3]} * xj2;
      X28 -= (f32x2){La14[0], La14[1]} * xj2;
      X29 -= (f32x2){La14[2], La14[3]} * xj2;
      X30 -= (f32x2){La15[0], La15[1]} * xj2;
      X31 -= (f32x2){La15[2], La15[3]} * xj2;
    }
    __builtin_amdgcn_sched_barrier(0);
    La14 = *(const f32x4*)(Lt_s + 3864);
    La15 = *(const f32x4*)(Lt_s + 3868);
    __builtin_amdgcn_sched_barrier(0);
    { const float xj = X27[1]; const f32x2 xj2 = (f32x2){xj, xj};
      X28 -= (f32x2){Lb14[0], Lb14[1]} * xj2;
      X29 -= (f32x2){Lb14[2], Lb14[3]} * xj2;
      X30 -= (f32x2){Lb15[0], Lb15[1]} * xj2;
      X31 -= (f32x2){Lb15[2], Lb15[3]} * xj2;
    }
    __builtin_amdgcn_sched_barrier(0);
    Lb14 = *(const f32x4*)(Lt_s + 3932);
    Lb15 = *(const f32x4*)(Lt_s + 3936);
    __builtin_amdgcn_sched_barrier(0);
    { const float xj = X28[0]; const f32x2 xj2 = (f32x2){xj, xj};
      X28 -= (f32x2){La14[0], La14[1]} * xj2;
      X29 -= (f32x2){La14[2], La14[3]} * xj2;
      X30 -= (f32x2){La15[0], La15[1]} * xj2;
      X31 -= (f32x2){La15[2], La15[3]} * xj2;
    }
    __builtin_amdgcn_sched_barrier(0);
    La14 = *(const f32x4*)(Lt_s + 4000);
    La15 = *(const f32x4*)(Lt_s + 4004);
    __builtin_amdgcn_sched_barrier(0);
    { const float xj = X28[1]; const f32x2 xj2 = (f32x2){xj, xj};
      X29 -= (f32x2){Lb14[2], Lb14[3]} * xj2;
      X30 -= (f32x2){Lb15[0], Lb15[1]} * xj2;
      X31 -= (f32x2){Lb15[2], Lb15[3]} * xj2;
    }
    __builtin_amdgcn_sched_barrier(0);
    Lb15 = *(const f32x4*)(Lt_s + 4072);
    __builtin_amdgcn_sched_barrier(0);
    { const float xj = X29[0]; const f32x2 xj2 = (f32x2){xj, xj};
      X29 -= (f32x2){La14[2], La14[3]} * xj2;
      X30 -= (f32x2){La15[0], La15[1]} * xj2;
      X31 -= (f32x2){La15[2], La15[3]} * xj2;
    }
    __builtin_amdgcn_sched_barrier(0);
    La15 = *(const f32x4*)(Lt_s + 4140);
    __builtin_amdgcn_sched_barrier(0);
    { const float xj = X29[1]; const f32x2 xj2 = (f32x2){xj, xj};
      X30 -= (f32x2){Lb15[0], Lb15[1]} * xj2;
      X31 -= (f32x2){Lb15[2], Lb15[3]} * xj2;
    }
    __builtin_amdgcn_sched_barrier(0);
    Lb15 = *(const f32x4*)(Lt_s + 4208);
    __builtin_amdgcn_sched_barrier(0);
    { const float xj = X30[0]; const f32x2 xj2 = (f32x2){xj, xj};
      X30 -= (f32x2){La15[0], La15[1]} * xj2;
      X31 -= (f32x2){La15[2], La15[3]} * xj2;
    }
    __builtin_amdgcn_sched_barrier(0);
    La15 = *(const f32x4*)(Lt_s + 4276);
    __builtin_amdgcn_sched_barrier(0);
    { const float xj = X30[1]; const f32x2 xj2 = (f32x2){xj, xj};
      X31 -= (f32x2){Lb15[2], Lb15[3]} * xj2;
    }
    __builtin_amdgcn_sched_barrier(0);
    __builtin_amdgcn_sched_barrier(0);
    { const float xj = X31[0]; const f32x2 xj2 = (f32x2){xj, xj};
      X31 -= (f32x2){La15[2], La15[3]} * xj2;
    }
    __builtin_amdgcn_sched_barrier(0);
    __syncthreads();
    outp[0] = f2bf(sg * X0[0]);
    outp[136] = f2bf(sg * X0[1]);
    outp[272] = f2bf(sg * X1[0]);
    outp[408] = f2bf(sg * X1[1]);
    outp[544] = f2bf(sg * X2[0]);
    outp[680] = f2bf(sg * X2[1]);
    outp[816] = f2bf(sg * X3[0]);
    outp[952] = f2bf(sg * X3[1]);
    outp[1088] = f2bf(sg * X4[0]);
    outp[1224] = f2bf(sg * X4[1]);
    outp[1360] = f2bf(sg * X5[0]);
    outp[1496] = f2bf(sg * X5[1]);
    outp[1632] = f2bf(sg * X6[0]);
    outp[1768] = f2bf(sg * X6[1]);
    outp[1904] = f2bf(sg * X7[0]);
    outp[2040] = f2bf(sg * X7[1]);
    outp[2176] = f2bf(sg * X8[0]);
    outp[2312] = f2bf(sg * X8[1]);
    outp[2448] = f2bf(sg * X9[0]);
    outp[2584] = f2bf(sg * X9[1]);
    outp[2720] = f2bf(sg * X10[0]);
    outp[2856] = f2bf(sg * X10[1]);
    outp[2992] = f2bf(sg * X11[0]);
    outp[3128] = f2bf(sg * X11[1]);
    outp[3264] = f2bf(sg * X12[0]);
    outp[3400] = f2bf(sg * X12[1]);
    outp[3536] = f2bf(sg * X13[0]);
    outp[3672] = f2bf(sg * X13[1]);
    outp[3808] = f2bf(sg * X14[0]);
    outp[3944] = f2bf(sg * X14[1]);
    outp[4080] = f2bf(sg * X15[0]);
    outp[4216] = f2bf(sg * X15[1]);
    outp[4352] = f2bf(sg * X16[0]);
    outp[4488] = f2bf(sg * X16[1]);
    outp[4624] = f2bf(sg * X17[0]);
    outp[4760] = f2bf(sg * X17[1]);
    outp[4896] = f2bf(sg * X18[0]);
    outp[5032] = f2bf(sg * X18[1]);
    outp[5168] = f2bf(sg * X19[0]);
    outp[5304] = f2bf(sg * X19[1]);
    outp[5440] = f2bf(sg * X20[0]);
    outp[5576] = f2bf(sg * X20[1]);
    outp[5712] = f2bf(sg * X21[0]);
    outp[5848] = f2bf(sg * X21[1]);
    outp[5984] = f2bf(sg * X22[0]);
    outp[6120] = f2bf(sg * X22[1]);
    outp[6256] = f2bf(sg * X23[0]);
    outp[6392] = f2bf(sg * X23[1]);
    outp[6528] = f2bf(sg * X24[0]);
    outp[6664] = f2bf(sg * X24[1]);
    outp[6800] = f2bf(sg * X25[0]);
    outp[6936] = f2bf(sg * X25[1]);
    outp[7072] = f2bf(sg * X26[0]);
    outp[7208] = f2bf(sg * X26[1]);
    outp[7344] = f2bf(sg * X27[0]);
    outp[7480] = f2bf(sg * X27[1]);
    outp[7616] = f2bf(sg * X28[0]);
    outp[7752] = f2bf(sg * X28[1]);
    outp[7888] = f2bf(sg * X29[0]);
    outp[8024] = f2bf(sg * X29[1]);
    outp[8160] = f2bf(sg * X30[0]);
    outp[8296] = f2bf(sg * X30[1]);
    outp[8432] = f2bf(sg * X31[0]);
    outp[8568] = f2bf(sg * X31[1]);
}

DEV void dn_item(const Params& p, int l, int item, unsigned char* smem) {
    const int dir = item & 1, hh = (item >> 1) & 3, b = item >> 3;
    bf16_t* q_s = (bf16_t*)(smem);
    bf16_t* k_s = (bf16_t*)(smem + 17408);
    bf16_t* vnT_s = k_s;
    bf16_t* kT_s = (bf16_t*)(smem + 35840);
    bf16_t* v_s = (bf16_t*)(smem + 54272);
    bf16_t* u_s = v_s;
    float* L_s = (float*)(smem + 71680);
    bf16_t* w_s = (bf16_t*)(smem + 71680);
    bf16_t* qk_s = (bf16_t*)(smem + 89088);
    bf16_t* St_s = (bf16_t*)(smem + 98304);
    float* G_s = (float*)(smem + 133120);
    float* beta_s = G_s + 64;
    float* eG_s = G_s + 128;
    float* bw_s = G_s + 192;
    float* cw_s = G_s + 256;
    const int tid = get_tid(), lane = tid & 63, wv = tid >> 6, l15 = lane & 15, quad = lane >> 4;
    const float Aneg = -expf(p.in[I_DNALOG][(l * 2 + dir) * 4 + hh]);
    const float dtb = p.in[I_DNDT][(l * 2 + dir) * 4 + hh];
    const bf16_t* P = wsb(p, O_P);
    const float* AB = wsf(p, O_AB);
    bf16_t* TO = wsb(p, dir ? O_TA2 : O_TA);
    __syncthreads();
    for (int e = tid; e < 4 * 384; e += 256) { int j = e / 384, c = e % 384, mat = c >> 7, cc = c & 127; cw_s[e] = p.in[I_DNCONV][((size_t)l * 4 + j) * 1536 + mat * 512 + hh * 128 + cc]; }
    for (int e = tid; e < 128 * 136 / 2; e += 256) ((unsigned*)St_s)[e] = 0u;
    f32x4 Sacc[2][8];
#pragma unroll
    for (int a = 0; a < 2; ++a)
#pragma unroll
        for (int c = 0; c < 8; ++c) Sacc[a][c] = (f32x4){0.f, 0.f, 0.f, 0.f};

    const int rg = tid >> 4, cseg = tid & 15, i0 = rg * 4;
    u32x4 raw[3][7];
    float pf_al = 0.f, pf_bb = 0.f;
#define DN_PREFETCH(NN, M0, M1) { \
        const int c_ = chunk_of(dir, (NN)); const int lo_ = c_ < 4 ? 0 : CTXL, hi_ = c_ < 4 ? CTXL : SB, base_ = c_ * 64; \
        const int slo_ = dir ? base_ + 60 - i0 : base_ + i0; \
        _Pragma("unroll") for (int u = 0; u < 7; ++u) { const int ss_ = slo_ - 1 + u; const bool ok_ = ss_ >= lo_ && ss_ < hi_; \
            const bf16_t* rp_ = P + ((size_t)b * SB + (ok_ ? ss_ : base_)) * PW + hh * 128 + cseg * 8; \
            _Pragma("unroll") for (int mat = (M0); mat < (M1); ++mat) { u32x4 t_ = *(const u32x4*)(rp_ + mat * 512); raw[mat][u] = ok_ ? t_ : (u32x4){0u, 0u, 0u, 0u}; } } \
        if ((M0) == 0) { const int sa_ = dir ? base_ + 63 - lane : base_ + lane; \
        pf_al = AB[((size_t)b * SB + sa_) * 16 + dir * 4 + hh]; pf_bb = AB[((size_t)b * SB + sa_) * 16 + 8 + dir * 4 + hh]; } }
    DN_PREFETCH(0, 0, 3);
    const int wv0_ = wv, l150_ = l15, quad0_ = quad, lane0_ = lane;

#pragma unroll 1
    for (int n = 0; n < 68; ++n) {
        int tz0 = 0; asm volatile("" : "+v"(tz0));
        const int wv = wv0_ + tz0, l15 = l150_ + tz0, quad = quad0_ + tz0, lane = lane0_ + tz0;
        const int c = chunk_of(dir, n);
        const int base = c * 64;
        __syncthreads();
        if (wv == 0) {
            float g = Aneg * softplus_fast(pf_al + dtb);
#pragma unroll
            for (int o = 1; o < 64; o <<= 1) { float t = __shfl_up(g, o); if (lane >= o) g += t; }
            const float eg_ = expf(g), bt_ = sigm(pf_bb); G_s[lane] = g; beta_s[lane] = bt_; eG_s[lane] = eg_; bw_s[lane] = bt_ * eg_;
        }
        __syncthreads();
        const float Glast = G_s[63];
        {
            int tz = 0; asm volatile("" : "+v"(tz));
            const int i0l = i0 + tz, csl = cseg + tz;
            float ksc[4];
#pragma unroll
            for (int m = 0; m < 4; ++m) ksc[m] = expf(Glast - G_s[i0l + m]);
#pragma unroll
            for (int mat = 0; mat < 3; ++mat) {
                float w[4][8];
#pragma unroll
                for (int j = 0; j < 4; ++j) { const f32x4 w0 = *(const f32x4*)(cw_s + j * 384 + mat * 128 + csl * 8), w1 = *(const f32x4*)(cw_s + j * 384 + mat * 128 + csl * 8 + 4);
#pragma unroll
                    for (int e = 0; e < 4; ++e) { w[j][e] = w0[e]; w[j][4 + e] = w1[e]; } }
                float v[4][8];
#pragma unroll
                for (int t = 0; t < 4; ++t)
#pragma unroll
                    for (int e = 0; e < 8; ++e) v[t][e] = 0.f;
#pragma unroll
                for (int u = 0; u < 7; ++u) {
                    float x[8];
#pragma unroll
                    for (int e = 0; e < 4; ++e) { x[2 * e] = lo16(raw[mat][u][e]); x[2 * e + 1] = hi16(raw[mat][u][e]); }
#pragma unroll
                    for (int t = 0; t < 4; ++t) { const int j = u - t; if (j >= 0 && j < 4) {
#pragma unroll
                        for (int e = 0; e < 8; ++e) v[t][e] += w[j][e] * x[e]; } }
                }
                float sc[4];
#pragma unroll
                for (int t = 0; t < 4; ++t) {
                    float ss2 = 0.f;
#pragma unroll
                    for (int e = 0; e < 8; ++e) { v[t][e] = silu(v[t][e]); ss2 += v[t][e] * v[t][e]; }
                    if (mat < 2) { ss2 += __shfl_xor(ss2, 1); ss2 += __shfl_xor(ss2, 2); ss2 += __shfl_xor(ss2, 4); ss2 += __shfl_xor(ss2, 8); }
                    sc[t] = mat == 0 ? rsqrtf(ss2 + 1e-6f) * 0.08838834764831845f : (mat == 1 ? rsqrtf(ss2 + 1e-6f) : 1.f);
                }
                bf16_t* dst = mat == 0 ? q_s : (mat == 1 ? k_s : v_s);
#pragma unroll
                for (int t = 0; t < 4; ++t) {
                    const int it_ = dir ? i0l + 3 - t : i0l + t;
                    u32x4 o;
#pragma unroll
                    for (int e = 0; e < 4; ++e) o[e] = pack2(v[t][2 * e] * sc[t], v[t][2 * e + 1] * sc[t]);
                    *(u32x4*)(dst + it_ * 136 + csl * 8) = o;
                }
                if (mat == 1) {
#pragma unroll
                    for (int e = 0; e < 8; ++e) {
                        const float k0 = v[dir ? 3 : 0][e] * sc[dir ? 3 : 0] * ksc[0], k1 = v[dir ? 2 : 1][e] * sc[dir ? 2 : 1] * ksc[1];
                        const float k2 = v[dir ? 1 : 2][e] * sc[dir ? 1 : 2] * ksc[2], k3 = v[dir ? 0 : 3][e] * sc[dir ? 0 : 3] * ksc[3];
                        u32x2 o; o.x = pack2(k0, k1); o.y = pack2(k2, k3);
                        *(u32x2*)(kT_s + (csl * 8 + e) * 72 + i0l) = o;
                    }
                }
            }
        }
        __syncthreads();
        {
            bf16x8 ak[4], aq[4];
#pragma unroll
            for (int ks = 0; ks < 4; ++ks) { ak[ks] = *(const bf16x8*)(k_s + (wv * 16 + l15) * 136 + ks * 32 + quad * 8); aq[ks] = *(const bf16x8*)(q_s + (wv * 16 + l15) * 136 + ks * 32 + quad * 8); }
#pragma unroll
            for (int nt = 0; nt < 4; ++nt) {
                f32x4 kk = {0.f, 0.f, 0.f, 0.f}, qq = {0.f, 0.f, 0.f, 0.f};
#pragma unroll
                for (int ks = 0; ks < 4; ++ks) { bf16x8 bk = *(const bf16x8*)(k_s + (nt * 16 + l15) * 136 + ks * 32 + quad * 8); kk = mfma16(ak[ks], bk, kk); qq = mfma16(aq[ks], bk, qq); }
                const int jj = nt * 16 + l15; const float Gj = G_s[jj];
                f32x4 lv;
#pragma unroll
                for (int j = 0; j < 4; ++j) {
                    const int i = wv * 16 + quad * 4 + j;
                    const float dec = jj <= i ? expf(G_s[i] - Gj) : 0.f;
                    lv[j] = jj < i ? beta_s[i] * kk[j] * dec : 0.f;
                    qk_s[i * 72 + jj] = f2bf(qq[j] * dec);
                }
                *(f32x4*)(L_s + jj * 68 + wv * 16 + quad * 4) = lv;
            }
        }
        __syncthreads();
        dn_solve(L_s, tid < 128 ? (k_s + tid) : (v_s + (tid - 128)), tid < 128 ? bw_s : beta_s, tid < 128 ? -1.f : 1.f, tid < 128 ? (w_s + tid) : (u_s + (tid - 128)));
        __syncthreads();
        {
            f32x4 vn[8], o1[8];
#pragma unroll
            for (int nt = 0; nt < 8; ++nt) {
#pragma unroll
                for (int j = 0; j < 4; ++j) vn[nt][j] = bf2f(u_s[(wv * 16 + quad * 4 + j) * 136 + nt * 16 + l15]);
                o1[nt] = (f32x4){0.f, 0.f, 0.f, 0.f};
            }
            bf16x8 aw[4], aq[4];
#pragma unroll
            for (int ks = 0; ks < 4; ++ks) { aw[ks] = *(const bf16x8*)(w_s + (wv * 16 + l15) * 136 + ks * 32 + quad * 8); aq[ks] = *(const bf16x8*)(q_s + (wv * 16 + l15) * 136 + ks * 32 + quad * 8); }
#pragma unroll
            for (int nt = 0; nt < 8; ++nt)
#pragma unroll
                for (int ks = 0; ks < 4; ++ks) { bf16x8 bs = *(const bf16x8*)(St_s + (nt * 16 + l15) * 136 + ks * 32 + quad * 8); vn[nt] = mfma16(aw[ks], bs, vn[nt]); o1[nt] = mfma16(aq[ks], bs, o1[nt]); }
#pragma unroll
            for (int nt = 0; nt < 8; ++nt) { u32x2 o; o.x = pack2(vn[nt][0], vn[nt][1]); o.y = pack2(vn[nt][2], vn[nt][3]); *(u32x2*)(vnT_s + (nt * 16 + l15) * 72 + wv * 16 + quad * 4) = o; }
            __syncthreads();
            if (n + 1 < 68) DN_PREFETCH(n + 1, 0, 2);
            float eg[4];
#pragma unroll
            for (int j = 0; j < 4; ++j) eg[j] = eG_s[wv * 16 + quad * 4 + j];
            bf16x8 aqk[2], akt[2][2];
#pragma unroll
            for (int ks = 0; ks < 2; ++ks) {
                aqk[ks] = *(const bf16x8*)(qk_s + (wv * 16 + l15) * 72 + ks * 32 + quad * 8);
                akt[0][ks] = *(const bf16x8*)(kT_s + (wv * 32 + l15) * 72 + ks * 32 + quad * 8);
                akt[1][ks] = *(const bf16x8*)(kT_s + (wv * 32 + 16 + l15) * 72 + ks * 32 + quad * 8);
            }
            const float gend = eG_s[63];
            const size_t orow0 = (size_t)b * SB;
#pragma unroll
            for (int nt = 0; nt < 8; ++nt) {
                f32x4 o;
#pragma unroll
                for (int j = 0; j < 4; ++j) { o[j] = o1[nt][j] * eg[j]; Sacc[0][nt][j] *= gend; Sacc[1][nt][j] *= gend; }
#pragma unroll
                for (int ks = 0; ks < 2; ++ks) {
                    bf16x8 bv = *(const bf16x8*)(vnT_s + (nt * 16 + l15) * 72 + ks * 32 + quad * 8);
                    o = mfma16(aqk[ks], bv, o);
                    Sacc[0][nt] = mfma16(akt[0][ks], bv, Sacc[0][nt]);
                    Sacc[1][nt] = mfma16(akt[1][ks], bv, Sacc[1][nt]);
                }
#pragma unroll
                for (int j = 0; j < 4; ++j) {
                    const int i = wv * 16 + quad * 4 + j;
                    const int s = dir ? base + 63 - i : base + i;
                    TO[(orow0 + s) * 512 + hh * 128 + nt * 16 + l15] = f2bf(o[j]);
                }
#pragma unroll
                for (int mt = 0; mt < 2; ++mt) { u32x2 sv; sv.x = pack2(Sacc[mt][nt][0], Sacc[mt][nt][1]); sv.y = pack2(Sacc[mt][nt][2], Sacc[mt][nt][3]);
                    *(u32x2*)(St_s + (nt * 16 + l15) * 136 + wv * 32 + mt * 16 + quad * 4) = sv; }
            }
        }
        if (n + 1 < 68) DN_PREFETCH(n + 1, 2, 3);
    }
}

#undef DN_PREFETCH
DEV void lru_item(const Params& p, int l, int item, unsigned char* smem) {
    const int g = item & 7, b = item >> 3;
    bf16_t* Wt_s = (bf16_t*)smem;
    bf16_t* xbh_s = Wt_s + 2 * 128 * 72;
    float* xbf_s = (float*)(smem + 36864 + 18432);
    float* a_s = xbf_s + 2 * 64 * 65;
    float* cw_s = a_s + 2 * 64 * 65;
    const int tid = get_tid(), lane = tid & 63, wv = tid >> 6, l15 = lane & 15, quad = lane >> 4;
    bf16_t* P = wsb(p, O_P);
    bf16_t* HF = wsb(p, O_U);
    __syncthreads();
    for (int e = tid; e < 320; e += 256) cw_s[e] = e < 256 ? p.in[I_LCW][((size_t)l * 4 + (e >> 6)) * 512 + g * 64 + (e & 63)] : p.in[I_LCB][l * 512 + g * 64 + (e - 256)];
    for (int e = tid; e < 2 * 4096; e += 256) {
        const int d = e >> 12, ch = (e >> 6) & 63, j = e & 63;
        const size_t wi_ = (((size_t)l * 2 + d) * 8 + g) * 4096 + ch * 64 + j;
        Wt_s[(d * 128 + j) * 72 + ch] = f2bf(p.in[I_LWA][wi_]);
        Wt_s[(d * 128 + 64 + j) * 72 + ch] = f2bf(p.in[I_LWI][wi_]);
    }
    float ba_[2][4], bi_[2][4], sp_[2][4];
#pragma unroll
    for (int d = 0; d < 2; ++d)
#pragma unroll
        for (int nt = 0; nt < 4; ++nt) {
            const int ch = (l * 2 + d) * 512 + g * 64 + nt * 16 + l15;
            ba_[d][nt] = p.in[I_LBA][ch]; bi_[d][nt] = p.in[I_LBI][ch]; sp_[d][nt] = softplus(-p.in[I_LLAM][ch]);
        }
    float hc = 0.f;
    const int i = tid >> 2, seg = tid & 3, j0 = seg * 16;
#pragma unroll 1
    for (int n = 0; n < 68; ++n) {
        const int cf = n, cb = chunk_of(1, n);
        __syncthreads();
#pragma unroll
        for (int d = 0; d < 2; ++d) {
            const int c = d ? cb : cf;
            const int seg_lo = c < 4 ? 0 : CTXL, seg_hi = c < 4 ? CTXL : SB;
            const int s = d ? c * 64 + 63 - i : c * 64 + i;
            float v[16];
#pragma unroll
            for (int e = 0; e < 16; ++e) v[e] = cw_s[256 + j0 + e];
#pragma unroll
            for (int j = 0; j < 4; ++j) {
                const int ss = s + j - 1;
                if (ss >= seg_lo && ss < seg_hi) {
                    const u32x4* src = (const u32x4*)(P + ((size_t)b * SB + ss) * PW + C_LX + g * 64 + j0);
                    const float* cw = cw_s + j * 64 + j0;
#pragma unroll
                    for (int q = 0; q < 2; ++q) { u32x4 x = src[q];
#pragma unroll
                        for (int e = 0; e < 4; ++e) { v[q * 8 + 2 * e] += cw[q * 8 + 2 * e] * lo16(x[e]); v[q * 8 + 2 * e + 1] += cw[q * 8 + 2 * e + 1] * hi16(x[e]); } }
                }
            }
            u32x4 h0, h1;
#pragma unroll
            for (int e = 0; e < 4; ++e) { h0[e] = pack2(v[2 * e], v[2 * e + 1]); h1[e] = pack2(v[8 + 2 * e], v[8 + 2 * e + 1]); }
            *(u32x4*)(xbh_s + (d * 64 + i) * 72 + j0) = h0; *(u32x4*)(xbh_s + (d * 64 + i) * 72 + j0 + 8) = h1;
#pragma unroll
            for (int e = 0; e < 16; ++e) xbf_s[(d * 64 + i) * 65 + j0 + e] = v[e];
        }
        __syncthreads();
#pragma unroll
        for (int d = 0; d < 2; ++d) {
            f32x4 acc[8];
#pragma unroll
            for (int nt = 0; nt < 8; ++nt) acc[nt] = (f32x4){0.f, 0.f, 0.f, 0.f};
            bf16x8 af[2];
#pragma unroll
            for (int ks = 0; ks < 2; ++ks) af[ks] = *(const bf16x8*)(xbh_s + (d * 64 + wv * 16 + l15) * 72 + ks * 32 + quad * 8);
#pragma unroll
            for (int nt = 0; nt < 8; ++nt)
#pragma unroll
                for (int ks = 0; ks < 2; ++ks) { bf16x8 bw = *(const bf16x8*)(Wt_s + (d * 128 + nt * 16 + l15) * 72 + ks * 32 + quad * 8); acc[nt] = mfma16(af[ks], bw, acc[nt]); }
#pragma unroll
            for (int nt = 0; nt < 4; ++nt)
#pragma unroll
                for (int jj = 0; jj < 4; ++jj) {
                    const int idx = (d * 64 + wv * 16 + quad * 4 + jj) * 65 + nt * 16 + l15;
                    const float r = sigm(acc[nt][jj] + ba_[d][nt]), ig = sigm(acc[nt + 4][jj] + bi_[d][nt]);
                    const float la = -8.f * r * sp_[d][nt];
                    a_s[idx] = expf(la);
                    xbf_s[idx] = sqrtf(fmaxf(1.f - expf(2.f * la), 0.f)) * (ig * xbf_s[idx]);
                }
        }
        __syncthreads();
        if (wv < 2) {
            const int o = wv * 64 * 65 + lane;
#pragma unroll 16
            for (int r = 0; r < 64; ++r) { hc = a_s[o + r * 65] * hc + xbf_s[o + r * 65]; xbf_s[o + r * 65] = hc; }
        }
        __syncthreads();
#pragma unroll
        for (int d = 0; d < 2; ++d) {
            const int c = d ? cb : cf;
            const int s = d ? c * 64 + 63 - i : c * 64 + i;
            const bool second = d ? (cb < n) : ((cf < 4 ? 3 - cf : 71 - cf) < n);
            const size_t row = (size_t)b * SB + s;
            const float* hp = xbf_s + (d * 64 + i) * 65 + j0;
            bf16_t* hf = HF + row * 512 + g * 64 + j0;
            if (!second) {
                u32x4 o0, o1;
#pragma unroll
                for (int e = 0; e < 4; ++e) { o0[e] = pack2(hp[2 * e], hp[2 * e + 1]); o1[e] = pack2(hp[8 + 2 * e], hp[8 + 2 * e + 1]); }
                *(u32x4*)hf = o0; *(u32x4*)(hf + 8) = o1;
            } else {
                bf16_t* gp = P + row * PW + C_LG + g * 64 + j0;
                u32x4 f0 = *(const u32x4*)hf, f1 = *(const u32x4*)(hf + 8), g0 = *(const u32x4*)gp, g1 = *(const u32x4*)(gp + 8), o0, o1;
#pragma unroll
                for (int e = 0; e < 4; ++e) {
                    o0[e] = pack2((lo16(f0[e]) + hp[2 * e]) * gelu_tanh(lo16(g0[e])), (hi16(f0[e]) + hp[2 * e + 1]) * gelu_tanh(hi16(g0[e])));
                    o1[e] = pack2((lo16(f1[e]) + hp[8 + 2 * e]) * gelu_tanh(lo16(g1[e])), (hi16(f1[e]) + hp[8 + 2 * e + 1]) * gelu_tanh(hi16(g1[e])));
                }
                *(u32x4*)gp = o0; *(u32x4*)(gp + 8) = o1;
            }
        }
    }
}

DEV void att_item(const Params& p, int l, int b, int h, int qt, float lam_init, unsigned char* smem) {
    bf16_t* K_s = (bf16_t*)smem;
    bf16_t* V_s = (bf16_t*)(smem + 2 * 17408);
    const int tid = get_tid(), lane = tid & 63, wv = tid >> 6, l15 = lane & 15, quad = lane >> 4;
    bf16_t* P = wsb(p, O_P);
    const bf16_t* VT = wsb(p, O_VT) + (size_t)(b * 4 + h) * 128 * SB;
    const int nt_keys = (qt < 2 ? CTXL : SB) / 64;
    float lam;
    {
        const float* lv = p.in[I_DALAM] + l * 256;
        float s1 = lv[lane] * lv[64 + lane], s2 = lv[128 + lane] * lv[192 + lane];
#pragma unroll
        for (int o = 32; o >= 1; o >>= 1) { s1 += __shfl_xor(s1, o); s2 += __shfl_xor(s2, o); }
        lam = expf(s1) - expf(s2) + lam_init;
    }
    bf16x8* Qst = (bf16x8*)(smem + 71680) + (wv * 8) * 64 + lane;
#pragma unroll
    for (int qg = 0; qg < 2; ++qg) {
        const bf16_t* qp = P + ((size_t)b * SB + qt * 128 + wv * 32 + qg * 16 + l15) * PW + C_DAQ + h * 128;
#pragma unroll
        for (int wh = 0; wh < 2; ++wh)
#pragma unroll
            for (int ks = 0; ks < 2; ++ks) Qst[(wh * 4 + qg * 2 + ks) * 64] = *(const bf16x8*)(qp + wh * 64 + ks * 32 + quad * 8);
    }
    f32x4 O[2][8][2];
    float mrun[2][2], lrun[2][2];
#pragma unroll
    for (int wh = 0; wh < 2; ++wh)
#pragma unroll
        for (int qg = 0; qg < 2; ++qg) { mrun[wh][qg] = -1e30f; lrun[wh][qg] = 0.f;
#pragma unroll
            for (int dg = 0; dg < 8; ++dg) O[wh][dg][qg] = (f32x4){0.f, 0.f, 0.f, 0.f}; }
    const int kr = tid >> 2, kseg = (tid & 3) * 32;
    const int kpos = ((kr >> 5) * 2 + ((kr & 7) >> 2)) * 16 + ((kr & 31) >> 3) * 4 + (kr & 3);
    const bf16_t* kg_ = P + ((size_t)b * SB + kr) * PW + C_DAK + h * 128 + kseg;
    const int vr = tid >> 1, vh = (tid & 1) * 32;
    const bf16_t* vg_ = VT + (size_t)vr * SB + vh;
    u32x4 kreg[4], vreg[4];
#pragma unroll
    for (int i = 0; i < 4; ++i) { kreg[i] = *(const u32x4*)(kg_ + i * 8); vreg[i] = *(const u32x4*)(vg_ + i * 8); }
    __syncthreads();
#pragma unroll
    for (int i = 0; i < 4; ++i) { *(u32x4*)(K_s + kpos * 136 + kseg + i * 8) = kreg[i]; *(u32x4*)(V_s + vr * 72 + vh + i * 8) = vreg[i]; }
    __syncthreads();
    const float L2E = 1.4426950408889634f;
#pragma unroll 1
    for (int t = 0; t < nt_keys; ++t) {
        const bf16_t* Kb = K_s + (t & 1) * (64 * 136);
        const bf16_t* Vb = V_s + (t & 1) * (128 * 72);
        if (t + 1 < nt_keys) {
#pragma unroll
            for (int i = 0; i < 4; ++i) { kreg[i] = *(const u32x4*)(kg_ + (size_t)(t + 1) * 64 * PW + i * 8); vreg[i] = *(const u32x4*)(vg_ + (t + 1) * 64 + i * 8); }
        }
#pragma unroll
        for (int wh = 0; wh < 2; ++wh) {
            f32x4 S[4][2];
#pragma unroll
            for (int kg = 0; kg < 4; ++kg) { S[kg][0] = (f32x4){0.f, 0.f, 0.f, 0.f}; S[kg][1] = (f32x4){0.f, 0.f, 0.f, 0.f}; }
#pragma unroll
            for (int ks = 0; ks < 2; ++ks)
#pragma unroll
                for (int kg = 0; kg < 4; ++kg) {
                    bf16x8 kf = *(const bf16x8*)(Kb + (kg * 16 + l15) * 136 + wh * 64 + ks * 32 + quad * 8);
                    S[kg][0] = mfma16(kf, Qst[(wh * 4 + 0 + ks) * 64], S[kg][0]);
                    S[kg][1] = mfma16(kf, Qst[(wh * 4 + 2 + ks) * 64], S[kg][1]);
                }
            bf16x8 Pf[2][2];
#pragma unroll
            for (int qg = 0; qg < 2; ++qg) {
                float mx = -1e30f;
#pragma unroll
                for (int kg = 0; kg < 4; ++kg)
#pragma unroll
                    for (int j = 0; j < 4; ++j) mx = fmaxf(mx, S[kg][qg][j]);
                mx = fmaxf(mx, __shfl_xor(mx, 16)); mx = fmaxf(mx, __shfl_xor(mx, 32));
                mx *= L2E;
                if (__builtin_amdgcn_ballot_w64(mx > mrun[wh][qg] + 8.f) != 0ull) {
                    const float mnew = fmaxf(mrun[wh][qg], mx);
                    const float alpha = __builtin_amdgcn_exp2f(mrun[wh][qg] - mnew);
                    mrun[wh][qg] = mnew;
                    lrun[wh][qg] *= alpha;
#pragma unroll
                    for (int dg = 0; dg < 8; ++dg)
#pragma unroll
                        for (int j = 0; j < 4; ++j) O[wh][dg][qg][j] *= alpha;
                }
                const float mref = mrun[wh][qg];
                float ps = 0.f;
#pragma unroll
                for (int kg = 0; kg < 4; ++kg)
#pragma unroll
                    for (int j = 0; j < 4; ++j) { float pv = __builtin_amdgcn_exp2f(S[kg][qg][j] * L2E - mref); ps += pv; S[kg][qg][j] = pv; }
                lrun[wh][qg] += ps;
#pragma unroll
                for (int s_ = 0; s_ < 2; ++s_) {
                    u32x4 pk; pk[0] = pack2(S[2 * s_][qg][0], S[2 * s_][qg][1]); pk[1] = pack2(S[2 * s_][qg][2], S[2 * s_][qg][3]);
                    pk[2] = pack2(S[2 * s_ + 1][qg][0], S[2 * s_ + 1][qg][1]); pk[3] = pack2(S[2 * s_ + 1][qg][2], S[2 * s_ + 1][qg][3]);
                    Pf[qg][s_] = __builtin_bit_cast(bf16x8, pk);
                }
            }
#pragma unroll
            for (int dg = 0; dg < 8; ++dg)
#pragma unroll
                for (int s_ = 0; s_ < 2; ++s_) {
                    bf16x8 vf = *(const bf16x8*)(Vb + (dg * 16 + l15) * 72 + s_ * 32 + quad * 8);
                    O[wh][dg][0] = mfma16(vf, Pf[0][s_], O[wh][dg][0]);
                    O[wh][dg][1] = mfma16(vf, Pf[1][s_], O[wh][dg][1]);
                }
        }
        if (t + 1 < nt_keys) {
            bf16_t* Kn = K_s + ((t + 1) & 1) * (64 * 136); bf16_t* Vn = V_s + ((t + 1) & 1) * (128 * 72);
#pragma unroll
            for (int i = 0; i < 4; ++i) { *(u32x4*)(Kn + kpos * 136 + kseg + i * 8) = kreg[i]; *(u32x4*)(Vn + vr * 72 + vh + i * 8) = vreg[i]; }
        }
        __syncthreads();
    }
    const float* dnw = p.in[I_DANORM] + l * 128;
#pragma unroll
    for (int qg = 0; qg < 2; ++qg) {
        float l1 = lrun[0][qg], l2 = lrun[1][qg];
        l1 += __shfl_xor(l1, 16); l1 += __shfl_xor(l1, 32); l2 += __shfl_xor(l2, 16); l2 += __shfl_xor(l2, 32);
        const float i1 = 1.f / l1, i2 = lam / l2;
        float ss = 0.f;
#pragma unroll
        for (int dg = 0; dg < 8; ++dg)
#pragma unroll
            for (int j = 0; j < 4; ++j) { float o = O[0][dg][qg][j] * i1 - O[1][dg][qg][j] * i2; O[0][dg][qg][j] = o; ss += o * o; }
        ss += __shfl_xor(ss, 16); ss += __shfl_xor(ss, 32);
        const float rstd = rsqrtf(ss * (1.f / 128.f) + 1e-5f) * (1.f - lam_init);
        bf16_t* op = P + ((size_t)b * SB + qt * 128 + wv * 32 + qg * 16 + l15) * PW + C_DAQ + h * 128;
#pragma unroll
        for (int dg = 0; dg < 8; ++dg) {
            const int dv0 = dg * 16 + quad * 4;
            u32x2 o; o.x = pack2(O[0][dg][qg][0] * rstd * dnw[dv0], O[0][dg][qg][1] * rstd * dnw[dv0 + 1]);
            o.y = pack2(O[0][dg][qg][2] * rstd * dnw[dv0 + 2], O[0][dg][qg][3] * rstd * dnw[dv0 + 3]);
            *(u32x2*)(op + dv0) = o;
        }
    }
}

DEV void phase_mix(const Params& p, int l, unsigned char* smem) {
    const bool need_ctx = l == 0;
    const float lam_init = l == 0 ? 0.2f : 0.35550906759096926f;
    unsigned* ctr = (unsigned*)(p.ws + O_CTL) + l;
    unsigned* actr = (unsigned*)(p.ws + O_CTL) + 16 + l * 8;
    __shared__ int s_item;
    const int nqt = need_ctx ? 34 : 32;
    auto next = [&](unsigned* c) -> int {
        __syncthreads();
        if (threadIdx.x == 0) s_item = (int)atomicAdd(c, 1u);
        __syncthreads();
        return __builtin_amdgcn_readfirstlane(s_item);
    };
    int it = next(ctr);
#pragma unroll 1
    while (it < 64) { dn_item(p, l, it, smem); it = next(ctr); }
#pragma unroll 1
    while (it < 128) { lru_item(p, l, it - 64, smem); it = next(ctr); }
    const int myx = blockIdx.x & 7;
#pragma unroll 1
    for (int k = 0; k < 8; ++k) {
        const int x = (myx + k) & 7;
        it = next(actr + x);
#pragma unroll 1
        while (it < 4 * nqt) {
            const int bh = x + 8 * (it / nqt), idx = it % nqt;
            const int qt = idx < 32 ? idx + 2 : idx - 32;
            att_item(p, l, bh >> 2, bh & 3, qt, lam_init, smem);
            it = next(actr + x);
        }
    }
}

constexpr int NPHASE = 1 + 2 * 9 + 1;
DEV void run_phase(const Params& p, int ph, unsigned char* smem) {
    if (ph == 0) { phase_mod(p, smem); phase_rope(p); __syncthreads(); phase_wconv(p, 0, smem); return; }
    if (ph == NPHASE - 1) { phase_final(p); return; }
    const int l = (ph - 1) / 9, q = (ph - 1) % 9;
    const bool first = l == 0, lat = l == 1;
    const bf16_t* W = wsb(p, O_WT);
    switch (q) {
        case 0: if (l == 1) phase_wconv(p, 1, smem); phase_norm(p, l, 0, first, false); break;
        case 1: phase_g1(p, smem); break;
        case 2: phase_mix(p, l, smem); break;
        case 3: phase_fin_norm(p, l, first, lat); break;
        case 4: phase_gate(p, lat, smem); break;
        case 5: phase_resid(p, l, wsb(p, O_U), D, W + W_OUT, 1024, 2, first, lat, smem); break;
        case 6: phase_norm(p, l, 1, false, lat); break;
        case 7: phase_gu(p, lat, smem); break;
        case 8: phase_resid(p, l, wsb(p, O_P), PW, W + W_DN, DFF, 5, false, lat, smem); break;
    }
}

#if MEGA
__global__ void __launch_bounds__(256) mega_kernel(Params p) {
    extern __shared__ __align__(16) unsigned char smem[];
    cg::grid_group grid = cg::this_grid();
    phase_mod(p, smem); phase_rope(p); __syncthreads(); phase_wconv(p, 0, smem);
    grid.sync();
    const bf16_t* W = wsb(p, O_WT);
#pragma unroll
    for (int l = 0; l < 2; ++l) {
        const bool first = l == 0, lat = l == 1;
        if (l == 1) phase_wconv(p, 1, smem);
        phase_norm(p, l, 0, first, false);
        grid.sync();
        phase_g1(p, smem);
        grid.sync();
        phase_mix(p, l, smem);
        grid.sync();
        phase_fin_norm(p, l, first, lat);
        grid.sync();
        phase_gate(p, lat, smem);
        grid.sync();
        phase_merge(p, lat, smem);
        grid.sync();
        phase_resid(p, l, wsb(p, O_U), D, W + W_OUT, 1024, 2, first, lat, smem);
        grid.sync();
        phase_norm(p, l, 1, false, lat);
        grid.sync();
        phase_gu(p, lat, smem);
        grid.sync();
        phase_resid(p, l, wsb(p, O_P), PW, W + W_DN, DFF, 5, false, lat, smem);
        grid.sync();
    }
    phase_final(p);
}
#else
__global__ void __launch_bounds__(256) phase_kernel(Params p, int ph) {
    extern __shared__ __align__(16) unsigned char smem[];
    run_phase(p, ph, smem);
}
#endif

extern "C" void kernel_launch(void* const* d_in, const int* in_sizes, int n_in, void* d_out, int out_size, void* d_ws, size_t ws_size, hipStream_t stream) {
    static int grid = 0;
    if (grid == 0) {
        if (n_in != 28 || ws_size < WS_END) { fprintf(stderr, "kernel_launch: unexpected n_in %d or ws_size %zu < %zu\n", n_in, ws_size, (size_t)WS_END); grid = -1; return; }
        int dev = 0, cus = 0, per_cu = 0;
        hipGetDevice(&dev);
        hipDeviceGetAttribute(&cus, hipDeviceAttributeMultiprocessorCount, dev);
#if MEGA
        hipFuncSetAttribute((const void*)mega_kernel, hipFuncAttributeMaxDynamicSharedMemorySize, LDS_BYTES);
        hipOccupancyMaxActiveBlocksPerMultiprocessor(&per_cu, (const void*)mega_kernel, 256, LDS_BYTES);
#else
        hipFuncSetAttribute((const void*)phase_kernel, hipFuncAttributeMaxDynamicSharedMemorySize, LDS_BYTES);
        hipOccupancyMaxActiveBlocksPerMultiprocessor(&per_cu, (const void*)phase_kernel, 256, LDS_BYTES);
#endif
        if (per_cu < 1) per_cu = 1;
        grid = cus * per_cu;
        fprintf(stderr, "kernel_launch: grid %d (%d CUs x %d)\n", grid, cus, per_cu);
    }
    if (grid < 0) return;
    hipMemsetAsync((char*)d_ws + O_CTL, 0, 4096, stream);
    Params p{};
    for (int i = 0; i < 28; ++i) p.in[i] = (const float*)d_in[i];
    p.out = (float*)d_out; p.ws = (unsigned char*)d_ws;
#if MEGA
    void* args[] = {&p};
    hipError_t e = hipLaunchCooperativeKernel((const void*)mega_kernel, dim3(grid), dim3(256), args, LDS_BYTES, stream);
    if (e != hipSuccess) fprintf(stderr, "cooperative launch failed: %s (grid %d)\n", hipGetErrorString(e), grid);
#else
    for (int ph = 0; ph < NPHASE; ++ph) hipLaunchKernelGGL(phase_kernel, dim3(grid), dim3(256), LDS_BYTES, stream, p, ph);
#endif
}
```

```cpp
#include <hip/hip_runtime.h>
#include <hip/hip_cooperative_groups.h>
#include <cstdio>
#include <cstdint>
namespace cg = cooperative_groups;

#ifndef MEGA
#define MEGA 1
#endif

typedef unsigned short bf16_t;
typedef short bf16x8 __attribute__((ext_vector_type(8)));
typedef float f32x4 __attribute__((ext_vector_type(4)));
typedef unsigned u32x4 __attribute__((ext_vector_type(4)));
typedef unsigned u32x2 __attribute__((ext_vector_type(2)));
#define DEV __device__ __forceinline__

constexpr int D = 1024, NB = 8, SEQ = 4096, CTXL = 256, SB = 4352, MR = NB * SB, PW = 4096, DFF = 2816;
constexpr int C_DNQ = 0, C_DNK = 512, C_DNV = 1024, C_DNZ = 1536, C_LX = 2048, C_LG = 2560, C_DAQ = 3072, C_DAK = 3584;
constexpr int NIN = 4736;
constexpr int GLD = 80;

enum { I_X = 0, I_C, I_CTX, I_CCTX, I_WMOD, I_BMOD, I_NMIX, I_NFFN, I_WIN, I_DNCONV, I_DNALOG, I_DNDT, I_DNNORM, I_LCW, I_LCB,
       I_LWA, I_LBA, I_LWI, I_LBI, I_LLAM, I_DALAM, I_DANORM, I_WBR, I_WOUT, I_WFG, I_WFU, I_WFD, I_NFIN };

constexpr size_t al256(size_t x) { return (x + 255) & ~(size_t)255; }
constexpr size_t O_CTL = 0;
constexpr size_t O_MOD = 4096;
constexpr size_t O_ROPE = al256(O_MOD + (size_t)2 * 9 * 6144 * 4);
constexpr size_t O_WT = al256(O_ROPE + 64 * 16 * 2 * 4);
constexpr size_t W_IN = 0, W_GATE = W_IN + (size_t)NIN * 1024, W_BR = W_GATE + (size_t)3072 * 1024, W_OUT = W_BR + (size_t)3 * 1024 * 512,
                 W_GU = W_OUT + (size_t)1024 * 1024, W_DN = W_GU + (size_t)5632 * 1024, W_END = W_DN + (size_t)1024 * 2816;
constexpr size_t O_HCTX = al256(O_WT + W_END * 2);
constexpr size_t O_U = al256(O_HCTX + (size_t)2048 * 1024 * 4);
constexpr size_t O_P = al256(O_U + (size_t)MR * 1024 * 2);
constexpr size_t O_AB = al256(O_P + (size_t)MR * PW * 2);
constexpr size_t O_TA = al256(O_AB + (size_t)MR * 16 * 4);
constexpr size_t O_TA2 = al256(O_TA + (size_t)MR * 512 * 2);
constexpr size_t O_VT = al256(O_TA2 + (size_t)MR * 512 * 2);
constexpr size_t WS_END = al256(O_VT + (size_t)MR * 512 * 2);

constexpr int LDS_BYTES = 140 * 1024;

struct Params {
    const float* in[28];
    float* out;
    unsigned char* ws;
};

DEV int get_tid() { int t = threadIdx.x; asm volatile("" : "+v"(t)); return t; }
DEV float bf2f(bf16_t h) { return __uint_as_float(((unsigned)h) << 16); }
DEV bf16_t f2bf(float f) { unsigned u = __float_as_uint(f); u += 0x7fffu + ((u >> 16) & 1u); return (bf16_t)(u >> 16); }
typedef float f32x2_ __attribute__((ext_vector_type(2)));
typedef __bf16 bf16x2_ __attribute__((ext_vector_type(2)));
DEV unsigned pack2(float a, float b) { const f32x2_ v = {a, b}; return __builtin_bit_cast(unsigned, __builtin_convertvector(v, bf16x2_)); }
DEV float sigm(float x) { return __builtin_amdgcn_rcpf(1.f + __expf(-x)); }
DEV float silu(float x) { return x * __builtin_amdgcn_rcpf(1.f + __expf(-x)); }
DEV float softplus(float x) { return x > 20.f ? x : log1pf(expf(x)); }
DEV float softplus_fast(float x) { const float e = __expf(x); return x > 15.f ? x : (e < 0.01f ? e * (1.f - e * (0.5f - e * 0.33333333f)) : __logf(1.f + e)); }
DEV float gelu_tanh(float x) { float u = 0.7978845608028654f * (x + 0.044715f * x * x * x); float t = 1.f - 2.f * __builtin_amdgcn_rcpf(1.f + __expf(2.f * u)); return 0.5f * x * (1.f + t); }
DEV f32x4 mfma16(bf16x8 a, bf16x8 b, f32x4 c) { return __builtin_amdgcn_mfma_f32_16x16x32_bf16(a, b, c, 0, 0, 0); }
DEV void mfma16a(f32x4& c, bf16x8 a, bf16x8 b) { asm volatile("v_mfma_f32_16x16x32_bf16 %0, %1, %2, %0" : "+a"(c) : "v"(a), "v"(b)); }
DEV float lo16(unsigned v) { return __uint_as_float(v << 16); }
DEV float hi16(unsigned v) { return __uint_as_float(v & 0xffff0000u); }

DEV bf16_t* wsb(const Params& p, size_t off) { return (bf16_t*)(p.ws + off); }
DEV float* wsf(const Params& p, size_t off) { return (float*)(p.ws + off); }
DEV float* hrow(const Params& p, int r) { int b = r / SB, s = r - b * SB; return s < CTXL ? wsf(p, O_HCTX) + (size_t)(b * CTXL + s) * D : p.out + (size_t)(b * SEQ + s - CTXL) * D; }
DEV const float* xrow(const Params& p, int r) { int b = r / SB, s = r - b * SB; return s < CTXL ? p.in[I_CTX] + (size_t)(b * CTXL + s) * D : p.in[I_X] + (size_t)(b * SEQ + s - CTXL) * D; }
DEV int modrow(int r) { int b = r / SB, s = r - b * SB; return s < CTXL ? 8 : b; }

template <int MT, int NT>
DEV void gemm_core(const bf16_t* __restrict__ A, int lda, const bf16_t* __restrict__ Bt, int ldb, int K, f32x4 (&acc)[MT][NT], bf16_t* smem_) {
    constexpr int SA = 32 * MT * GLD, SBB = 32 * NT * GLD;
    bf16_t* sA = smem_; bf16_t* sB = smem_ + 2 * SA;
    const int tid = get_tid(), lane = tid & 63, wv = tid >> 6, wr = wv >> 1, wc = wv & 1, l15 = lane & 15, quad = lane >> 4;
    const int lr = tid >> 3, lc = (tid & 7) * 8;
    u32x4 ra0[MT], rb0[NT], ra1[MT], rb1[NT];
    const bf16_t* Ap = A + (size_t)lr * lda + lc;
    const bf16_t* Bp = Bt + (size_t)lr * ldb + lc;
    const int nk = K >> 6;
#define GLOAD(RA, RB, KT) { const int ko_ = (KT) * 64; _Pragma("unroll") for (int i = 0; i < MT; ++i) RA[i] = *(const u32x4*)(Ap + (size_t)(32 * i) * lda + ko_); \
                            _Pragma("unroll") for (int i = 0; i < NT; ++i) RB[i] = *(const u32x4*)(Bp + (size_t)(32 * i) * ldb + ko_); }
#define LSTORE(RA, RB, BUF) { _Pragma("unroll") for (int i = 0; i < MT; ++i) *(u32x4*)(sA + (BUF) * SA + (lr + 32 * i) * GLD + lc) = RA[i]; \
                              _Pragma("unroll") for (int i = 0; i < NT; ++i) *(u32x4*)(sB + (BUF) * SBB + (lr + 32 * i) * GLD + lc) = RB[i]; }
#define COMPUTE(BUF) { _Pragma("unroll") for (int ks = 0; ks < 2; ++ks) { bf16x8 af[MT], bfr[NT]; \
        _Pragma("unroll") for (int mt = 0; mt < MT; ++mt) af[mt] = *(const bf16x8*)(sA + (BUF) * SA + (wr * MT * 16 + mt * 16 + l15) * GLD + ks * 32 + quad * 8); \
        _Pragma("unroll") for (int nt = 0; nt < NT; ++nt) bfr[nt] = *(const bf16x8*)(sB + (BUF) * SBB + (wc * NT * 16 + nt * 16 + l15) * GLD + ks * 32 + quad * 8); \
        _Pragma("unroll") for (int mt = 0; mt < MT; ++mt) _Pragma("unroll") for (int nt = 0; nt < NT; ++nt) mfma16a(acc[mt][nt], af[mt], bfr[nt]); } }
    GLOAD(ra0, rb0, 0);
    GLOAD(ra1, rb1, 1);
    __syncthreads();
    LSTORE(ra0, rb0, 0);
    GLOAD(ra0, rb0, 2);
    __syncthreads();
    int kt = 0;
#pragma unroll 1
    for (; kt + 4 < nk; kt += 2) {
        COMPUTE(0);
        LSTORE(ra1, rb1, 1);
        GLOAD(ra1, rb1, kt + 3);
        __syncthreads();
        COMPUTE(1);
        LSTORE(ra0, rb0, 0);
        GLOAD(ra0, rb0, kt + 4);
        __syncthreads();
    }
    COMPUTE(0);
    LSTORE(ra1, rb1, 1);
    GLOAD(ra1, rb1, kt + 3);
    __syncthreads();
    COMPUTE(1);
    LSTORE(ra0, rb0, 0);
    __syncthreads();
    COMPUTE(0);
    LSTORE(ra1, rb1, 1);
    __syncthreads();
    COMPUTE(1);
    __syncthreads();
#undef GLOAD
#undef LSTORE
#undef COMPUTE
    asm volatile("s_nop 15\n\ts_nop 15" ::: "memory");
}
template <int MT, int NT>
DEV void gemm_core1(const bf16_t* __restrict__ A, int lda, const bf16_t* __restrict__ Bt, int ldb, int K, f32x4 (&acc)[MT][NT], bf16_t* sA, bf16_t* sB) {
    const int tid = get_tid(), lane = tid & 63, wv = tid >> 6, wr = wv >> 1, wc = wv & 1, l15 = lane & 15, quad = lane >> 4;
    const int lr = tid >> 3, lc = (tid & 7) * 8;
    u32x4 ra[MT], rb[NT];
    const bf16_t* Ap = A + (size_t)lr * lda + lc;
    const bf16_t* Bp = Bt + (size_t)lr * ldb + lc;
#pragma unroll
    for (int i = 0; i < MT; ++i) ra[i] = *(const u32x4*)(Ap + (size_t)(32 * i) * lda);
#pragma unroll
    for (int i = 0; i < NT; ++i) rb[i] = *(const u32x4*)(Bp + (size_t)(32 * i) * ldb);
    const int nk = K >> 6;
    for (int kt = 0; kt < nk; ++kt) {
        __syncthreads();
#pragma unroll
        for (int i = 0; i < MT; ++i) *(u32x4*)(sA + (lr + 32 * i) * GLD + lc) = ra[i];
#pragma unroll
        for (int i = 0; i < NT; ++i) *(u32x4*)(sB + (lr + 32 * i) * GLD + lc) = rb[i];
        __syncthreads();
        if (kt + 1 < nk) {
            const int ko = (kt + 1) * 64;
#pragma unroll
            for (int i = 0; i < MT; ++i) ra[i] = *(const u32x4*)(Ap + (size_t)(32 * i) * lda + ko);
#pragma unroll
            for (int i = 0; i < NT; ++i) rb[i] = *(const u32x4*)(Bp + (size_t)(32 * i) * ldb + ko);
        }
#pragma unroll
        for (int ks = 0; ks < 2; ++ks) {
            bf16x8 af[MT], bfr[NT];
#pragma unroll
            for (int mt = 0; mt < MT; ++mt) af[mt] = *(const bf16x8*)(sA + (wr * MT * 16 + mt * 16 + l15) * GLD + ks * 32 + quad * 8);
#pragma unroll
            for (int nt = 0; nt < NT; ++nt) bfr[nt] = *(const bf16x8*)(sB + (wc * NT * 16 + nt * 16 + l15) * GLD + ks * 32 + quad * 8);
#pragma unroll
            for (int mt = 0; mt < MT; ++mt)
#pragma unroll
                for (int nt = 0; nt < NT; ++nt) mfma16a(acc[mt][nt], af[mt], bfr[nt]);
        }
    }
    asm volatile("s_nop 15\n\ts_nop 15" ::: "memory");
}
template <int MT, int NT>
DEV void zero_acc(f32x4 (&acc)[MT][NT]) {
#pragma unroll
    for (int mt = 0; mt < MT; ++mt)
#pragma unroll
        for (int nt = 0; nt < NT; ++nt) acc[mt][nt] = (f32x4){0.f, 0.f, 0.f, 0.f};
}

DEV void phase_mod(const Params& p, unsigned char* smem) {
    float* s_s = (float*)smem;
    float* red = s_s + 9 * 1024;
    const int tid = get_tid();
    bool loaded = false;
    for (int it = blockIdx.x; it < 2 * 96; it += gridDim.x) {
        if (!loaded) {
            for (int e = tid; e < 9 * 1024; e += 256) { float v = e < 8192 ? p.in[I_C][e] : p.in[I_CCTX][e - 8192]; s_s[e] = silu(v); }
            loaded = true;
        }
        __syncthreads();
        const int l = it / 96, cg_ = it % 96, cq = tid & 63, kq = tid >> 6, col = cg_ * 64 + cq;
        float acc[9];
#pragma unroll
        for (int r = 0; r < 9; ++r) acc[r] = 0.f;
        const float* wp = p.in[I_WMOD] + ((size_t)l * 1024 + kq * 256) * 6144 + col;
#pragma unroll 8
        for (int k = 0; k < 256; ++k) {
            float wv = wp[(size_t)k * 6144];
#pragma unroll
            for (int r = 0; r < 9; ++r) acc[r] += s_s[r * 1024 + kq * 256 + k] * wv;
        }
#pragma unroll
        for (int r = 0; r < 9; ++r) red[(kq * 9 + r) * 64 + cq] = acc[r];
        __syncthreads();
        for (int e = tid; e < 9 * 64; e += 256) {
            int r = e >> 6, c2 = e & 63;
            float v = red[(0 * 9 + r) * 64 + c2] + red[(1 * 9 + r) * 64 + c2] + red[(2 * 9 + r) * 64 + c2] + red[(3 * 9 + r) * 64 + c2];
            wsf(p, O_MOD)[((size_t)l * 9 + r) * 6144 + cg_ * 64 + c2] = v + p.in[I_BMOD][l * 6144 + cg_ * 64 + c2];
        }
        __syncthreads();
    }
}
DEV void phase_rope(const Params& p) {
    if (blockIdx.x == (gridDim.x - 1)) {
        for (int e = threadIdx.x; e < 1024; e += 256) {
            int pos = e >> 4, i = e & 15;
            float inv = powf(10000.f, -(float)i / 16.f);
            float ang = (float)pos * inv;
            float n = rintf(ang * 0.15915494309189535f);
            float r = fmaf(-n, 6.28125f, ang);
            r = fmaf(-n, 1.9353071795864769e-3f, r);
            wsf(p, O_ROPE)[e * 2] = cosf(r);
            wsf(p, O_ROPE)[e * 2 + 1] = sinf(r);
        }
    }
}
DEV void wconv_tile(const float* src0, const float* src1, int lds_, int K, bf16_t* dst, int kind, int kt, int nt, bf16_t* tile) {
    const int tid = get_tid();
    const int kk = tid >> 2, grp = tid & 3;
    const int n0 = nt * 64, k0 = kt * 64;
    const int ng = n0 + grp * 16;
    const float* src = src0; int sc;
    if (kind == 0) { sc = ng < 2048 ? ng : (ng < 4608 ? ng + 16 : (ng < 4624 ? 2048 : -1)); }
    else if (kind == 1) { sc = 4624 + ng; }
    else if (kind == 2) { sc = ng; }
    else { int gd = ng >> 4; src = (gd & 1) ? src1 : src0; sc = (gd >> 1) * 16; }
    __syncthreads();
    if (sc >= 0) {
        const float4* sp = (const float4*)(src + (size_t)(k0 + kk) * lds_ + sc);
#pragma unroll
        for (int q = 0; q < 4; ++q) { float4 v = sp[q]; int e = grp * 16 + q * 4;
            tile[(e + 0) * GLD + kk] = f2bf(v.x); tile[(e + 1) * GLD + kk] = f2bf(v.y); tile[(e + 2) * GLD + kk] = f2bf(v.z); tile[(e + 3) * GLD + kk] = f2bf(v.w); }
    } else {
#pragma unroll
        for (int e = 0; e < 16; ++e) tile[(grp * 16 + e) * GLD + kk] = 0;
    }
    __syncthreads();
    const int n = tid >> 2, kseg = (tid & 3) * 16;
    u32x4 a = *(const u32x4*)(tile + n * GLD + kseg), b = *(const u32x4*)(tile + n * GLD + kseg + 8);
    bf16_t* dp = dst + (size_t)(n0 + n) * K + k0 + kseg;
    *(u32x4*)dp = a; *(u32x4*)(dp + 8) = b;
}
DEV void phase_wconv(const Params& p, int l, unsigned char* smem) {
    bf16_t* tile = (bf16_t*)smem;
    bf16_t* W = wsb(p, O_WT);
    constexpr int T0 = 74 * 16, T1 = T0 + 48 * 16, T2 = T1 + 3 * 16 * 8, T3 = T2 + 16 * 16, T4 = T3 + 88 * 16, T5 = T4 + 16 * 44;
    for (int t = blockIdx.x; t < T5; t += gridDim.x) {
        if (t < T0) { wconv_tile(p.in[I_WIN] + (size_t)l * 1024 * 7696, nullptr, 7696, 1024, W + W_IN, 0, t % 16, t / 16, tile); }
        else if (t < T1) { int u = t - T0; wconv_tile(p.in[I_WIN] + (size_t)l * 1024 * 7696, nullptr, 7696, 1024, W + W_GATE, 1, u % 16, u / 16, tile); }
        else if (t < T2) { int u = t - T1; int n = u / 128, v = u % 128; wconv_tile(p.in[I_WBR] + ((size_t)l * 3 + n) * 512 * 1024, nullptr, 1024, 512, W + W_BR + (size_t)n * 1024 * 512, 2, v % 8, v / 8, tile); }
        else if (t < T3) { int u = t - T2; wconv_tile(p.in[I_WOUT] + (size_t)l * 1024 * 1024, nullptr, 1024, 1024, W + W_OUT, 2, u % 16, u / 16, tile); }
        else if (t < T4) { int u = t - T3; wconv_tile(p.in[I_WFG] + (size_t)l * 1024 * DFF, p.in[I_WFU] + (size_t)l * 1024 * DFF, DFF, 1024, W + W_GU, 3, u % 16, u / 16, tile); }
        else { int u = t - T4; wconv_tile(p.in[I_WFD] + (size_t)l * DFF * 1024, nullptr, 1024, DFF, W + W_DN, 2, u % 44, u / 44, tile); }
    }
}

DEV void norm_row(const Params& p, int l, int which, bool first, int r, int lane) {
    const float* h = first ? xrow(p, r) : hrow(p, r);
    const float* nw = p.in[which ? I_NFFN : I_NMIX] + l * D;
    const float* md = wsf(p, O_MOD) + ((size_t)l * 9 + modrow(r)) * 6144 + (which ? 3 * D : 0);
    float4 v[4]; float ss = 0.f;
#pragma unroll
    for (int i = 0; i < 4; ++i) { v[i] = *(const float4*)(h + i * 256 + lane * 4); ss += v[i].x * v[i].x + v[i].y * v[i].y + v[i].z * v[i].z + v[i].w * v[i].w; }
#pragma unroll
    for (int o = 32; o >= 1; o >>= 1) ss += __shfl_xor(ss, o);
    const float rstd = rsqrtf(ss * (1.f / D) + 1e-6f);
    bf16_t* up = wsb(p, O_U) + (size_t)r * D;
#pragma unroll
    for (int i = 0; i < 4; ++i) {
        const int c = i * 256 + lane * 4;
        float4 w4 = *(const float4*)(nw + c), sh = *(const float4*)(md + c), sc = *(const float4*)(md + D + c);
        float a = v[i].x * rstd * w4.x * (1.f + sc.x) + sh.x, b = v[i].y * rstd * w4.y * (1.f + sc.y) + sh.y;
        float c2 = v[i].z * rstd * w4.z * (1.f + sc.z) + sh.z, d = v[i].w * rstd * w4.w * (1.f + sc.w) + sh.w;
        u32x2 o; o.x = pack2(a, b); o.y = pack2(c2, d);
        *(u32x2*)(up + c) = o;
    }
}
DEV void phase_norm(const Params& p, int l, int which, bool first, bool skip_ctx) {
    const int tid_ = get_tid(); const int lane = tid_ & 63, wv = tid_ >> 6;
    for (int r = blockIdx.x * 4 + wv; r < MR; r += gridDim.x * 4) {
        if (skip_ctx && (r % SB) < CTXL) continue;
        norm_row(p, l, which, first, r, lane);
    }
}
DEV void phase_fin_norm(const Params& p, int l, bool first, bool skip_ctx) {
    const int tid_ = get_tid(); const int lane = tid_ & 63, wv = tid_ >> 6;
    const float* dnn = p.in[I_DNNORM] + l * 128;
    for (int r = blockIdx.x * 4 + wv; r < MR; r += gridDim.x * 4) {
        if (skip_ctx && (r % SB) < CTXL) continue;
        norm_row(p, l, 0, first, r, lane);
        bf16_t* ta = wsb(p, O_TA) + (size_t)r * 512 + lane * 8;
        const bf16_t* tb = wsb(p, O_TA2) + (size_t)r * 512 + lane * 8;
        const bf16_t* zz = wsb(p, O_P) + (size_t)r * PW + C_DNZ + lane * 8;
        u32x4 a = *(const u32x4*)ta, b = *(const u32x4*)tb, z = *(const u32x4*)zz;
        float o[8]; float ss = 0.f;
#pragma unroll
        for (int i = 0; i < 4; ++i) { o[2 * i] = lo16(a[i]) + lo16(b[i]); o[2 * i + 1] = hi16(a[i]) + hi16(b[i]); ss += o[2 * i] * o[2 * i] + o[2 * i + 1] * o[2 * i + 1]; }
#pragma unroll
        for (int of = 8; of >= 1; of >>= 1) ss += __shfl_xor(ss, of);
        const float rstd = rsqrtf(ss * (1.f / 128.f) + 1e-6f);
        const int dv0 = (lane & 15) * 8;
        u32x4 y;
#pragma unroll
        for (int i = 0; i < 4; ++i) {
            float y0 = o[2 * i] * rstd * dnn[dv0 + 2 * i] * silu(lo16(z[i]));
            float y1 = o[2 * i + 1] * rstd * dnn[dv0 + 2 * i + 1] * silu(hi16(z[i]));
            y[i] = pack2(y0, y1);
        }
        *(u32x4*)ta = y;
    }
}
DEV void phase_final(const Params& p) {
    const int tid_ = get_tid(); const int lane = tid_ & 63, wv = tid_ >> 6;
    const float* nw = p.in[I_NFIN];
    for (int r = blockIdx.x * 4 + wv; r < NB * SEQ; r += gridDim.x * 4) {
        float* h = p.out + (size_t)r * D;
        float4 v[4]; float ss = 0.f;
#pragma unroll
        for (int i = 0; i < 4; ++i) { v[i] = *(const float4*)(h + i * 256 + lane * 4); ss += v[i].x * v[i].x + v[i].y * v[i].y + v[i].z * v[i].z + v[i].w * v[i].w; }
#pragma unroll
        for (int o = 32; o >= 1; o >>= 1) ss += __shfl_xor(ss, o);
        const float rstd = rsqrtf(ss * (1.f / D) + 1e-6f);
#pragma unroll
        for (int i = 0; i < 4; ++i) {
            const int c = i * 256 + lane * 4;
            float4 w4 = *(const float4*)(nw + c);
            float4 o4; o4.x = v[i].x * rstd * w4.x; o4.y = v[i].y * rstd * w4.y; o4.z = v[i].z * rstd * w4.z; o4.w = v[i].w * rstd * w4.w;
            *(float4*)(h + c) = o4;
        }
    }
}

struct TileIter {
    int nn, total, nloc, L;
    DEV TileIter(int nm, int nn_) { nn = nn_; total = nm * nn_; nloc = gridDim.x >> 3; L = (blockIdx.x & 7) * nloc + (blockIdx.x >> 3); }
    DEV bool valid() const { return L < total; }
    DEV bool more() const { return (L - (int)(blockIdx.x >> 3)) < total; }
    DEV void next() { L += 8 * nloc; }
    DEV void get(int& tm, int& tn) const { const int pn = 4 * nn, panel = L / pn, rem = L - panel * pn; tn = rem >> 2; tm = panel * 4 + (rem & 3); }
};
DEV void phase_g1(const Params& p, unsigned char* smem) {
    bf16_t* sA = (bf16_t*)smem;
    const int tid = get_tid(), lane = tid & 63, wv = tid >> 6, wr = wv >> 1, wc = wv & 1, l15 = lane & 15, quad = lane >> 4;
    const bf16_t* U = wsb(p, O_U); const bf16_t* W = wsb(p, O_WT) + W_IN;
    bf16_t* P = wsb(p, O_P);
    const float* rope = wsf(p, O_ROPE);
    constexpr int NTN = NIN / 128;
    for (TileIter ti(MR / 256, NTN); ti.valid(); ti.next()) {
        int tm, tn; ti.get(tm, tn);
        const int row0 = tm * 256, col0 = tn * 128;
        f32x4 acc[8][4]; zero_acc(acc);
        gemm_core<8, 4>(U + (size_t)row0 * D, D, W + (size_t)col0 * D, D, D, acc, sA);
        if (tn < 24) {
#pragma unroll
            for (int mt = 0; mt < 8; ++mt)
#pragma unroll
                for (int nt = 0; nt < 4; ++nt)
#pragma unroll
                    for (int j = 0; j < 4; ++j) {
                        if (nt == 0 && j == 0) __builtin_amdgcn_sched_barrier(0);
                        const int row = row0 + wr * 128 + mt * 16 + quad * 4 + j, col = col0 + wc * 64 + nt * 16 + l15;
                        P[(size_t)row * PW + col] = f2bf(acc[mt][nt][j]);
                    }
        } else if (tn < 32) {
            const float qs = tn < 28 ? 0.125f : 1.f;
#pragma unroll
            for (int mt = 0; mt < 8; ++mt)
#pragma unroll
                for (int j = 0; j < 4; ++j) {
                    if (j == 0) __builtin_amdgcn_sched_barrier(0);
                    const int row = row0 + wr * 128 + mt * 16 + quad * 4 + j;
                    const int s = row % SB;
                    float c0 = 1.f, s0 = 0.f, c1 = 1.f, s1 = 0.f;
                    if (s >= CTXL) { const int tt = s - CTXL, pr = tt >> 6, pc = tt & 63;
                        c0 = rope[(pr * 16 + l15) * 2]; s0 = rope[(pr * 16 + l15) * 2 + 1]; c1 = rope[(pc * 16 + l15) * 2]; s1 = rope[(pc * 16 + l15) * 2 + 1]; }
                    const float x1 = acc[mt][0][j], x2 = acc[mt][1][j], y1 = acc[mt][2][j], y2 = acc[mt][3][j];
                    bf16_t* pp = P + (size_t)row * PW + col0 + wc * 64 + l15;
                    pp[0] = f2bf((x1 * c0 - x2 * s0) * qs);
                    pp[16] = f2bf((x2 * c0 + x1 * s0) * qs);
                    pp[32] = f2bf((y1 * c1 - y2 * s1) * qs);
                    pp[48] = f2bf((y2 * c1 + y1 * s1) * qs);
                }
        } else if (tn < 36) {
            bf16_t* VT = wsb(p, O_VT);
            const int b = row0 / SB, sbase = row0 - b * SB;
#pragma unroll
            for (int mt = 0; mt < 8; ++mt)
#pragma unroll
                for (int nt = 0; nt < 4; ++nt) {
                    if (nt == 0) __builtin_amdgcn_sched_barrier(0);
                    const int cc = col0 - 4096 + wc * 64 + nt * 16 + l15;
                    const int s = sbase + wr * 128 + mt * 16 + quad * 4;
                    u32x2 o; o.x = pack2(acc[mt][nt][0], acc[mt][nt][1]); o.y = pack2(acc[mt][nt][2], acc[mt][nt][3]);
                    *(u32x2*)(VT + ((size_t)(b * 512 + cc)) * SB + s) = o;
                }
        } else {
            if (wc == 0) {
                float* AB = wsf(p, O_AB);
#pragma unroll
                for (int mt = 0; mt < 8; ++mt)
#pragma unroll
                    for (int j = 0; j < 4; ++j) {
                        const int row = row0 + wr * 128 + mt * 16 + quad * 4 + j;
                        AB[(size_t)row * 16 + l15] = acc[mt][0][j];
                    }
            }
        }
    }
}

DEV int rowtile0(int ti, bool latent_only) { if (!latent_only) return ti * 256; int b = ti >> 4, tt = ti & 15; return b * SB + CTXL + tt * 256; }
DEV int sgcol(int n, int c) { return n < 2 ? n * 1024 + c : (c < 512 ? 2048 + c : 3584 + (c - 512)); }

DEV void phase_gate(const Params& p, bool latent_only, unsigned char* smem) {
    bf16_t* sA = (bf16_t*)smem;
    const int tid = get_tid(), lane = tid & 63, wv = tid >> 6, wr = wv >> 1, wc = wv & 1, l15 = lane & 15, quad = lane >> 4;
    const bf16_t* U = wsb(p, O_U); const bf16_t* W = wsb(p, O_WT) + W_GATE;
    bf16_t* P = wsb(p, O_P);
    const int nrt = latent_only ? 128 : 136;
    for (TileIter ti(nrt, 24); ti.valid(); ti.next()) {
        int tm, tn; ti.get(tm, tn);
        const int row0 = rowtile0(tm, latent_only);
        f32x4 acc[8][4]; zero_acc(acc);
        gemm_core<8, 4>(U + (size_t)row0 * D, D, W + (size_t)tn * 128 * D, D, D, acc, sA);
        const int dcol0 = sgcol(tn >> 3, (tn & 7) * 128);
        bf16_t* ip = P + (size_t)(row0 + tid) * PW + dcol0;
#pragma unroll
        for (int mt = 0; mt < 8; ++mt) {
            __builtin_amdgcn_sched_barrier(0);
#pragma unroll
            for (int hf = 0; hf < 2; ++hf) {
                u32x4 o;
                o[0] = pack2(sigm(acc[mt][2 * hf][0]), sigm(acc[mt][2 * hf][1])); o[1] = pack2(sigm(acc[mt][2 * hf][2]), sigm(acc[mt][2 * hf][3]));
                o[2] = pack2(sigm(acc[mt][2 * hf + 1][0]), sigm(acc[mt][2 * hf + 1][1])); o[3] = pack2(sigm(acc[mt][2 * hf + 1][2]), sigm(acc[mt][2 * hf + 1][3]));
                *(u32x4*)(ip + (mt * 2 + hf) * 8) = o;
            }
        }
    }
}

DEV void phase_merge(const Params& p, bool latent_only, unsigned char* smem) {
    bf16_t* sA = (bf16_t*)smem;
    const int tid = get_tid(), lane = tid & 63, wv = tid >> 6, wr = wv >> 1, wc = wv & 1, l15 = lane & 15, quad = lane >> 4;
    const bf16_t* W = wsb(p, O_WT);
    const bf16_t* P = wsb(p, O_P);
    bf16_t* U = wsb(p, O_U);
    const int nrt = latent_only ? 128 : 136;
    for (TileIter ti(nrt, 8); ti.valid(); ti.next()) {
        int tm, tn; ti.get(tm, tn);
        const int row0 = rowtile0(tm, latent_only), col0 = tn * 128;
        f32x4 m[8][4]; zero_acc(m);
#pragma unroll 1
        for (int n = 0; n < 3; ++n) {
            f32x4 au[8][4]; zero_acc(au);
            const bf16_t* Y; int ldy;
            if (n == 0) { Y = wsb(p, O_TA) + (size_t)row0 * 512; ldy = 512; }
            else if (n == 1) { Y = P + (size_t)row0 * PW + C_LG; ldy = PW; }
            else { Y = P + (size_t)row0 * PW + C_DAQ; ldy = PW; }
            const int sc0 = sgcol(n, col0);
            u32x4 sg[16];
            const bf16_t* ip = P + (size_t)(row0 + tid) * PW + sc0;
#pragma unroll
            for (int q = 0; q < 16; ++q) sg[q] = *(const u32x4*)(ip + q * 8);
            gemm_core1<8, 4>(Y, ldy, W + W_BR + ((size_t)n * 1024 + col0) * 512, 512, 512, au, sA, sA + 256 * GLD);
#pragma unroll
            for (int mt = 0; mt < 8; ++mt)
#pragma unroll
                for (int nt = 0; nt < 4; ++nt) {
                    const unsigned g01 = sg[mt * 2 + (nt >> 1)][(nt & 1) * 2], g23 = sg[mt * 2 + (nt >> 1)][(nt & 1) * 2 + 1];
                    m[mt][nt][0] += lo16(g01) * au[mt][nt][0]; m[mt][nt][1] += hi16(g01) * au[mt][nt][1];
                    m[mt][nt][2] += lo16(g23) * au[mt][nt][2]; m[mt][nt][3] += hi16(g23) * au[mt][nt][3];
                }
        }
#pragma unroll
        for (int mt = 0; mt < 8; ++mt)
#pragma unroll
            for (int nt = 0; nt < 4; ++nt)
#pragma unroll
                for (int j = 0; j < 4; ++j) {
                    if (nt == 0 && j == 0) __builtin_amdgcn_sched_barrier(0);
                    const int row = row0 + wr * 128 + mt * 16 + quad * 4 + j, col = col0 + wc * 64 + nt * 16 + l15;
                    U[(size_t)row * D + col] = f2bf(m[mt][nt][j]);
                }
    }
}

DEV void phase_resid(const Params& p, int l, const bf16_t* A, int lda, const bf16_t* Wt, int K, int chunk, bool first, bool latent_only, unsigned char* smem) {
    bf16_t* sA = (bf16_t*)smem;
    const int tid = get_tid(), lane = tid & 63, wv = tid >> 6, wr = wv >> 1, wc = wv & 1, l15 = lane & 15, quad = lane >> 4;
    const int nrt = latent_only ? 128 : 136;
    for (TileIter ti(nrt, 8); ti.valid(); ti.next()) {
        int tm, tn; ti.get(tm, tn);
        const int row0 = rowtile0(tm, latent_only), col0 = tn * 128;
        f32x4 acc[8][4]; zero_acc(acc);
        gemm_core<8, 4>(A + (size_t)row0 * lda, lda, Wt + (size_t)col0 * K, K, K, acc, sA);
        const float* md = wsf(p, O_MOD) + ((size_t)l * 9 + modrow(row0)) * 6144 + chunk * D;
        const float* hs0 = first ? xrow(p, row0) : hrow(p, row0);
        float* hd0 = hrow(p, row0);
#pragma unroll
        for (int mt = 0; mt < 8; ++mt)
#pragma unroll
            for (int j = 0; j < 4; ++j) {
                if (j == 0) __builtin_amdgcn_sched_barrier(0);
                const int rl = wr * 128 + mt * 16 + quad * 4 + j;
                const float* hs = hs0 + (size_t)rl * D;
                float* hd = hd0 + (size_t)rl * D;
#pragma unroll
                for (int nt = 0; nt < 4; ++nt) { const int col = col0 + wc * 64 + nt * 16 + l15; hd[col] = hs[col] + md[col] * acc[mt][nt][j]; }
            }
    }
}
DEV void phase_gu(const Params& p, bool latent_only, unsigned char* smem) {
    bf16_t* sA = (bf16_t*)smem;
    const int tid = get_tid(), lane = tid & 63, wv = tid >> 6, wr = wv >> 1, wc = wv & 1, l15 = lane & 15, quad = lane >> 4;
    const bf16_t* U = wsb(p, O_U); const bf16_t* W = wsb(p, O_WT) + W_GU;
    bf16_t* P = wsb(p, O_P);
    const int nrt = latent_only ? 128 : 136;
    for (TileIter ti(nrt, 44); ti.valid(); ti.next()) {
        int tm, tn; ti.get(tm, tn);
        const int row0 = rowtile0(tm, latent_only);
        f32x4 acc[8][4]; zero_acc(acc);
        gemm_core<8, 4>(U + (size_t)row0 * D, D, W + (size_t)tn * 128 * D, D, D, acc, sA);
#pragma unroll
        for (int mt = 0; mt < 8; ++mt)
#pragma unroll
            for (int pr = 0; pr < 2; ++pr)
#pragma unroll
                for (int j = 0; j < 4; ++j) {
                    if (pr == 0 && j == 0) __builtin_amdgcn_sched_barrier(0);
                    const int row = row0 + wr * 128 + mt * 16 + quad * 4 + j, hc = (tn * 4 + wc * 2 + pr) * 16 + l15;
                    P[(size_t)row * PW + hc] = f2bf(silu(acc[mt][2 * pr][j]) * acc[mt][2 * pr + 1][j]);
                }
    }
}

DEV int chunk_of(int dir, int n) { return dir ? (n < 4 ? 3 - n : 71 - n) : n; }

typedef float f32x2 __attribute__((ext_vector_type(2)));
DEV void dn_solve(const float* __restrict__ Lt_s0, const bf16_t* __restrict__ colp, const float* __restrict__ mulp0, const float sg, bf16_t* __restrict__ outp) {
    int vz = 0; asm volatile("" : "+v"(vz));
    const float* __restrict__ Lt_s = Lt_s0 + vz; const float* __restrict__ mulp = mulp0 + vz;
    f32x2 X0, X1, X2, X3, X4, X5, X6, X7, X8, X9, X10, X11, X12, X13, X14, X15, X16, X17, X18, X19, X20, X21, X22, X23, X24, X25, X26, X27, X28, X29, X30, X31;
    f32x4 La0, La1, La2, La3, La4, La5, La6, La7, La8, La9, La10, La11, La12, La13, La14, La15, Lb0, Lb1, Lb2, Lb3, Lb4, Lb5, Lb6, Lb7, Lb8, Lb9, Lb10, Lb11, Lb12, Lb13, Lb14, Lb15;
    X0 = (f32x2){bf2f(colp[0]) * mulp[0], bf2f(colp[136]) * mulp[1]};
    X1 = (f32x2){bf2f(colp[272]) * mulp[2], bf2f(colp[408]) * mulp[3]};
    X2 = (f32x2){bf2f(colp[544]) * mulp[4], bf2f(colp[680]) * mulp[5]};
    X3 = (f32x2){bf2f(colp[816]) * mulp[6], bf2f(colp[952]) * mulp[7]};
    X4 = (f32x2){bf2f(colp[1088]) * mulp[8], bf2f(colp[1224]) * mulp[9]};
    X5 = (f32x2){bf2f(colp[1360]) * mulp[10], bf2f(colp[1496]) * mulp[11]};
    X6 = (f32x2){bf2f(colp[1632]) * mulp[12], bf2f(colp[1768]) * mulp[13]};
    X7 = (f32x2){bf2f(colp[1904]) * mulp[14], bf2f(colp[2040]) * mulp[15]};
    X8 = (f32x2){bf2f(colp[2176]) * mulp[16], bf2f(colp[2312]) * mulp[17]};
    X9 = (f32x2){bf2f(colp[2448]) * mulp[18], bf2f(colp[2584]) * mulp[19]};
    X10 = (f32x2){bf2f(colp[2720]) * mulp[20], bf2f(colp[2856]) * mulp[21]};
    X11 = (f32x2){bf2f(colp[2992]) * mulp[22], bf2f(colp[3128]) * mulp[23]};
    X12 = (f32x2){bf2f(colp[3264]) * mulp[24], bf2f(colp[3400]) * mulp[25]};
    X13 = (f32x2){bf2f(colp[3536]) * mulp[26], bf2f(colp[3672]) * mulp[27]};
    X14 = (f32x2){bf2f(colp[3808]) * mulp[28], bf2f(colp[3944]) * mulp[29]};
    X15 = (f32x2){bf2f(colp[4080]) * mulp[30], bf2f(colp[4216]) * mulp[31]};
    X16 = (f32x2){bf2f(colp[4352]) * mulp[32], bf2f(colp[4488]) * mulp[33]};
    X17 = (f32x2){bf2f(colp[4624]) * mulp[34], bf2f(colp[4760]) * mulp[35]};
    X18 = (f32x2){bf2f(colp[4896]) * mulp[36], bf2f(colp[5032]) * mulp[37]};
    X19 = (f32x2){bf2f(colp[5168]) * mulp[38], bf2f(colp[5304]) * mulp[39]};
    X20 = (f32x2){bf2f(colp[5440]) * mulp[40], bf2f(colp[5576]) * mulp[41]};
    X21 = (f32x2){bf2f(colp[5712]) * mulp[42], bf2f(colp[5848]) * mulp[43]};
    X22 = (f32x2){bf2f(colp[5984]) * mulp[44], bf2f(colp[6120]) * mulp[45]};
    X23 = (f32x2){bf2f(colp[6256]) * mulp[46], bf2f(colp[6392]) * mulp[47]};
    X24 = (f32x2){bf2f(colp[6528]) * mulp[48], bf2f(colp[6664]) * mulp[49]};
    X25 = (f32x2){bf2f(colp[6800]) * mulp[50], bf2f(colp[6936]) * mulp[51]};
    X26 = (f32x2){bf2f(colp[7072]) * mulp[52], bf2f(colp[7208]) * mulp[53]};
    X27 = (f32x2){bf2f(colp[7344]) * mulp[54], bf2f(colp[7480]) * mulp[55]};
    X28 = (f32x2){bf2f(colp[7616]) * mulp[56], bf2f(colp[7752]) * mulp[57]};
    X29 = (f32x2){bf2f(colp[7888]) * mulp[58], bf2f(colp[8024]) * mulp[59]};
    X30 = (f32x2){bf2f(colp[8160]) * mulp[60], bf2f(colp[8296]) * mulp[61]};
    X31 = (f32x2){bf2f(colp[8432]) * mulp[62], bf2f(colp[8568]) * mulp[63]};
    La0 = *(const f32x4*)(Lt_s + 0);
    La1 = *(const f32x4*)(Lt_s + 4);
    La2 = *(const f32x4*)(Lt_s + 8);
    La3 = *(const f32x4*)(Lt_s + 12);
    La4 = *(const f32x4*)(Lt_s + 16);
    La5 = *(const f32x4*)(Lt_s + 20);
    La6 = *(const f32x4*)(Lt_s + 24);
    La7 = *(const f32x4*)(Lt_s + 28);
    La8 = *(const f32x4*)(Lt_s + 32);
    La9 = *(const f32x4*)(Lt_s + 36);
    La10 = *(const f32x4*)(Lt_s + 40);
    La11 = *(const f32x4*)(Lt_s + 44);
    La12 = *(const f32x4*)(Lt_s + 48);
    La13 = *(const f32x4*)(Lt_s + 52);
    La14 = *(const f32x4*)(Lt_s + 56);
    La15 = *(const f32x4*)(Lt_s + 60);
    Lb0 = *(const f32x4*)(Lt_s + 68);
    Lb1 = *(const f32x4*)(Lt_s + 72);
    Lb2 = *(const f32x4*)(Lt_s + 76);
    Lb3 = *(const f32x4*)(Lt_s + 80);
    Lb4 = *(const f32x4*)(Lt_s + 84);
    Lb5 = *(const f32x4*)(Lt_s + 88);
    Lb6 = *(const f32x4*)(Lt_s + 92);
    Lb7 = *(const f32x4*)(Lt_s + 96);
    Lb8 = *(const f32x4*)(Lt_s + 100);
    Lb9 = *(const f32x4*)(Lt_s + 104);
    Lb10 = *(const f32x4*)(Lt_s + 108);
    Lb11 = *(const f32x4*)(Lt_s + 112);
    Lb12 = *(const f32x4*)(Lt_s + 116);
    Lb13 = *(const f32x4*)(Lt_s + 120);
    Lb14 = *(const f32x4*)(Lt_s + 124);
    Lb15 = *(const f32x4*)(Lt_s + 128);
    __builtin_amdgcn_sched_barrier(0);
    { const float xj = X0[0]; const f32x2 xj2 = (f32x2){xj, xj};
      X0 -= (f32x2){La0[0], La0[1]} * xj2;
      X1 -= (f32x2){La0[2], La0[3]} * xj2;
      X2 -= (f32x2){La1[0], La1[1]} * xj2;
      X3 -= (f32x2){La1[2], La1[3]} * xj2;
      X4 -= (f32x2){La2[0], La2[1]} * xj2;
      X5 -= (f32x2){La2[2], La2[3]} * xj2;
      X6 -= (f32x2){La3[0], La3[1]} * xj2;
      X7 -= (f32x2){La3[2], La3[3]} * xj2;
      X8 -= (f32x2){La4[0], La4[1]} * xj2;
      X9 -= (f32x2){La4[2], La4[3]} * xj2;
      X10 -= (f32x2){La5[0], La5[1]} * xj2;
      X11 -= (f32x2){La5[2], La5[3]} * xj2;
      X12 -= (f32x2){La6[0], La6[1]} * xj2;
      X13 -= (f32x2){La6[2], La6[3]} * xj2;
      X14 -= (f32x2){La7[0], La7[1]} * xj2;
      X15 -= (f32x2){La7[2], La7[3]} * xj2;
      X16 -= (f32x2){La8[0], La8[1]} * xj2;
      X17 -= (f32x2){La8[2], La8[3]} * xj2;
      X18 -= (f32x2){La9[0], La9[1]} * xj2;
      X19 -= (f32x2){La9[2], La9[3]} * xj2;
      X20 -= (f32x2){La10[0], La10[1]} * xj2;
      X21 -= (f32x2){La10[2], La10[3]} * xj2;
      X22 -= (f32x2){La11[0], La11[1]} * xj2;
      X23 -= (f32x2){La11[2], La11[3]} * xj2;
      X24 -= (f32x2){La12[0], La12[1]} * xj2;
      X25 -= (f32x2){La12[2], La12[3]} * xj2;
      X26 -= (f32x2){La13[0], La13[1]} * xj2;
      X27 -= (f32x2){La13[2], La13[3]} * xj2;
      X28 -= (f32x2){La14[0], La14[1]} * xj2;
      X29 -= (f32x2){La14[2], La14[3]} * xj2;
      X30 -= (f32x2){La15[0], La15[1]} * xj2;
      X31 -= (f32x2){La15[2], La15[3]} * xj2;
    }
    __builtin_amdgcn_sched_barrier(0);
    La0 = *(const f32x4*)(Lt_s + 136);
    La1 = *(const f32x4*)(Lt_s + 140);
    La2 = *(const f32x4*)(Lt_s + 144);
    La3 = *(const f32x4*)(Lt_s + 148);
    La4 = *(const f32x4*)(Lt_s + 152);
    La5 = *(const f32x4*)(Lt_s + 156);
    La6 = *(const f32x4*)(Lt_s + 160);
    La7 = *(const f32x4*)(Lt_s + 164);
    La8 = *(const f32x4*)(Lt_s + 168);
    La9 = *(const f32x4*)(Lt_s + 172);
    La10 = *(const f32x4*)(Lt_s + 176);
    La11 = *(const f32x4*)(Lt_s + 180);
    La12 = *(const f32x4*)(Lt_s + 184);
    La13 = *(const f32x4*)(Lt_s + 188);
    La14 = *(const f32x4*)(Lt_s + 192);
    La15 = *(const f32x4*)(Lt_s + 196);
    __builtin_amdgcn_sched_barrier(0);
    { const float xj = X0[1]; const f32x2 xj2 = (f32x2){xj, xj};
      X1 -= (f32x2){Lb0[2], Lb0[3]} * xj2;
      X2 -= (f32x2){Lb1[0], Lb1[1]} * xj2;
      X3 -= (f32x2){Lb1[2], Lb1[3]} * xj2;
      X4 -= (f32x2){Lb2[0], Lb2[1]} * xj2;
      X5 -= (f32x2){Lb2[2], Lb2[3]} * xj2;
      X6 -= (f32x2){Lb3[0], Lb3[1]} * xj2;
      X7 -= (f32x2){Lb3[2], Lb3[3]} * xj2;
      X8 -= (f32x2){Lb4[0], Lb4[1]} * xj2;
      X9 -= (f32x2){Lb4[2], Lb4[3]} * xj2;
      X10 -= (f32x2){Lb5[0], Lb5[1]} * xj2;
      X11 -= (f32x2){Lb5[2], Lb5[3]} * xj2;
      X12 -= (f32x2){Lb6[0], Lb6[1]} * xj2;
      X13 -= (f32x2){Lb6[2], Lb6[3]} * xj2;
      X14 -= (f32x2){Lb7[0], Lb7[1]} * xj2;
      X15 -= (f32x2){Lb7[2], Lb7[3]} * xj2;
      X16 -= (f32x2){Lb8[0], Lb8[1]} * xj2;
      X17 -= (f32x2){Lb8[2], Lb8[3]} * xj2;
      X18 -= (f32x2){Lb9[0], Lb9[1]} * xj2;
      X19 -= (f32x2){Lb9[2], Lb9[3]} * xj2;
      X20 -= (f32x2){Lb10[0], Lb10[1]} * xj2;
      X21 -= (f32x2){Lb10[2], Lb10[3]} * xj2;
      X22 -= (f32x2){Lb11[0], Lb11[1]} * xj2;
      X23 -= (f32x2){Lb11[2], Lb11[3]} * xj2;
      X24 -= (f32x2){Lb12[0], Lb12[1]} * xj2;
      X25 -= (f32x2){Lb12[2], Lb12[3]} * xj2;
      X26 -= (f32x2){Lb13[0], Lb13[1]} * xj2;
      X27 -= (f32x2){Lb13[2], Lb13[3]} * xj2;
      X28 -= (f32x2){Lb14[0], Lb14[1]} * xj2;
      X29 -= (f32x2){Lb14[2], Lb14[3]} * xj2;
      X30 -= (f32x2){Lb15[0], Lb15[1]} * xj2;
      X31 -= (f32x2){Lb15[2], Lb15[3]} * xj2;
    }
    __builtin_amdgcn_sched_barrier(0);
    Lb1 = *(const f32x4*)(Lt_s + 208);
    Lb2 = *(const f32x4*)(Lt_s + 212);
    Lb3 = *(const f32x4*)(Lt_s + 216);
    Lb4 = *(const f32x4*)(Lt_s + 220);
    Lb5 = *(const f32x4*)(Lt_s + 224);
    Lb6 = *(const f32x4*)(Lt_s + 228);
    Lb7 = *(const f32x4*)(Lt_s + 232);
    Lb8 = *(const f32x4*)(Lt_s + 236);
    Lb9 = *(const f32x4*)(Lt_s + 240);
    Lb10 = *(const f32x4*)(Lt_s + 244);
    Lb11 = *(const f32x4*)(Lt_s + 248);
    Lb12 = *(const f32x4*)(Lt_s + 252);
    Lb13 = *(const f32x4*)(Lt_s + 256);
    Lb14 = *(const f32x4*)(Lt_s + 260);
    Lb15 = *(const f32x4*)(Lt_s + 264);
    __builtin_amdgcn_sched_barrier(0);
    { const float xj = X1[0]; const f32x2 xj2 = (f32x2){xj, xj};
      X1 -= (f32x2){La0[2], La0[3]} * xj2;
      X2 -= (f32x2){La1[0], La1[1]} * xj2;
      X3 -= (f32x2){La1[2], La1[3]} * xj2;
      X4 -= (f32x2){La2[0], La2[1]} * xj2;
      X5 -= (f32x2){La2[2], La2[3]} * xj2;
      X6 -= (f32x2){La3[0], La3[1]} * xj2;
      X7 -= (f32x2){La3[2], La3[3]} * xj2;
      X8 -= (f32x2){La4[0], La4[1]} * xj2;
      X9 -= (f32x2){La4[2], La4[3]} * xj2;
      X10 -= (f32x2){La5[0], La5[1]} * xj2;
      X11 -= (f32x2){La5[2], La5[3]} * xj2;
      X12 -= (f32x2){La6[0], La6[1]} * xj2;
      X13 -= (f32x2){La6[2], La6[3]} * xj2;
      X14 -= (f32x2){La7[0], La7[1]} * xj2;
      X15 -= (f32x2){La7[2], La7[3]} * xj2;
      X16 -= (f32x2){La8[0], La8[1]} * xj2;
      X17 -= (f32x2){La8[2], La8[3]} * xj2;
      X18 -= (f32x2){La9[0], La9[1]} * xj2;
      X19 -= (f32x2){La9[2], La9[3]} * xj2;
      X20 -= (f32x2){La10[0], La10[1]} * xj2;
      X21 -= (f32x2){La10[2], La10[3]} * xj2;
      X22 -= (f32x2){La11[0], La11[1]} * xj2;
      X23 -= (f32x2){La11[2], La11[3]} * xj2;
      X24 -= (f32x2){La12[0], La12[1]} * xj2;
      X25 -= (f32x2){La12[2], La12[3]} * xj2;
      X26 -= (f32x2){La13[0], La13[1]} * xj2;
      X27 -= (f32x2){La13[2], La13[3]} * xj2;
      X28 -= (f32x2){La14[0], La14[1]} * xj2;
      X29 -= (f32x2){La14[2], La14[3]} * xj2;
      X30 -= (f32x2){La15[0], La15[1]} * xj2;
      X31 -= (f32x2){La15[2], La15[3]} * xj2;
    }
    __builtin_amdgcn_sched_barrier(0);
    La1 = *(const f32x4*)(Lt_s + 276);
    La2 = *(const f32x4*)(Lt_s + 280);
    La3 = *(const f32x4*)(Lt_s + 284);
    La4 = *(const f32x4*)(Lt_s + 288);
    La5 = *(const f32x4*)(Lt_s + 292);
    La6 = *(const f32x4*)(Lt_s + 296);
    La7 = *(const f32x4*)(Lt_s + 300);
    La8 = *(const f32x4*)(Lt_s + 304);
    La9 = *(const f32x4*)(Lt_s + 308);
    La10 = *(const f32x4*)(Lt_s + 312);
    La11 = *(const f32x4*)(Lt_s + 316);
    La12 = *(const f32x4*)(Lt_s + 320);
    La13 = *(const f32x4*)(Lt_s + 324);
    La14 = *(const f32x4*)(Lt_s + 328);
    La15 = *(const f32x4*)(Lt_s + 332);
    __builtin_amdgcn_sched_barrier(0);
    { const float xj = X1[1]; const f32x2 xj2 = (f32x2){xj, xj};
      X2 -= (f32x2){Lb1[0], Lb1[1]} * xj2;
      X3 -= (f32x2){Lb1[2], Lb1[3]} * xj2;
      X4 -= (f32x2){Lb2[0], Lb2[1]} * xj2;
      X5 -= (f32x2){Lb2[2], Lb2[3]} * xj2;
      X6 -= (f32x2){Lb3[0], Lb3[1]} * xj2;
      X7 -= (f32x2){Lb3[2], Lb3[3]} * xj2;
      X8 -= (f32x2){Lb4[0], Lb4[1]} * xj2;
      X9 -= (f32x2){Lb4[2], Lb4[3]} * xj2;
      X10 -= (f32x2){Lb5[0], Lb5[1]} * xj2;
      X11 -= (f32x2){Lb5[2], Lb5[3]} * xj2;
      X12 -= (f32x2){Lb6[0], Lb6[1]} * xj2;
      X13 -= (f32x2){Lb6[2], Lb6[3]} * xj2;
      X14 -= (f32x2){Lb7[0], Lb7[1]} * xj2;
      X15 -= (f32x2){Lb7[2], Lb7[3]} * xj2;
      X16 -= (f32x2){Lb8[0], Lb8[1]} * xj2;
      X17 -= (f32x2){Lb8[2], Lb8[3]} * xj2;
      X18 -= (f32x2){Lb9[0], Lb9[1]} * xj2;
      X19 -= (f32x2){Lb9[2], Lb9[3]} * xj2;
      X20 -= (f32x2){Lb10[0], Lb10[1]} * xj2;
      X21 -= (f32x2){Lb10[2], Lb10[3]} * xj2;
      X22 -= (f32x2){Lb11[0], Lb11[1]} * xj2;
      X23 -= (f32x2){Lb11[2], Lb11[3]} * xj2;
      X24 -= (f32x2){Lb12[0], Lb12[1]} * xj2;
      X25 -= (f32x2){Lb12[2], Lb12[3]} * xj2;
      X26 -= (f32x2){Lb13[0], Lb13[1]} * xj2;
      X27 -= (f32x2){Lb13[2], Lb13[3]} * xj2;
      X28 -= (f32x2){Lb14[0], Lb14[1]} * xj2;
      X29 -= (f32x2){Lb14[2], Lb14[3]} * xj2;
      X30 -= (f32x2){Lb15[0], Lb15[1]} * xj2;
      X31 -= (f32x2){Lb15[2], Lb15[3]} * xj2;
    }
    __builtin_amdgcn_sched_barrier(0);
    Lb1 = *(const f32x4*)(Lt_s + 344);
    Lb2 = *(const f32x4*)(Lt_s + 348);
    Lb3 = *(const f32x4*)(Lt_s + 352);
    Lb4 = *(const f32x4*)(Lt_s + 356);
    Lb5 = *(const f32x4*)(Lt_s + 360);
    Lb6 = *(const f32x4*)(Lt_s + 364);
    Lb7 = *(const f32x4*)(Lt_s + 368);
    Lb8 = *(const f32x4*)(Lt_s + 372);
    Lb9 = *(const f32x4*)(Lt_s + 376);
    Lb10 = *(const f32x4*)(Lt_s + 380);
    Lb11 = *(const f32x4*)(Lt_s + 384);
    Lb12 = *(const f32x4*)(Lt_s + 388);
    Lb13 = *(const f32x4*)(Lt_s + 392);
    Lb14 = *(const f32x4*)(Lt_s + 396);
    Lb15 = *(const f32x4*)(Lt_s + 400);
    __builtin_amdgcn_sched_barrier(0);
    { const float xj = X2[0]; const f32x2 xj2 = (f32x2){xj, xj};
      X2 -= (f32x2){La1[0], La1[1]} * xj2;
      X3 -= (f32x2){La1[2], La1[3]} * xj2;
      X4 -= (f32x2){La2[0], La2[1]} * xj2;
      X5 -= (f32x2){La2[2], La2[3]} * xj2;
      X6 -= (f32x2){La3[0], La3[1]} * xj2;
      X7 -= (f32x2){La3[2], La3[3]} * xj2;
      X8 -= (f32x2){La4[0], La4[1]} * xj2;
      X9 -= (f32x2){La4[2], La4[3]} * xj2;
      X10 -= (f32x2){La5[0], La5[1]} * xj2;
      X11 -= (f32x2){La5[2], La5[3]} * xj2;
      X12 -= (f32x2){La6[0], La6[1]} * xj2;
      X13 -= (f32x2){La6[2], La6[3]} * xj2;
      X14 -= (f32x2){La7[0], La7[1]} * xj2;
      X15 -= (f32x2){La7[2], La7[3]} * xj2;
      X16 -= (f32x2){La8[0], La8[1]} * xj2;
      X17 -= (f32x2){La8[2], La8[3]} * xj2;
      X18 -= (f32x2){La9[0], La9[1]} * xj2;
      X19 -= (f32x2){La9[2], La9[3]} * xj2;
      X20 -= (f32x2){La10[0], La10[1]} * xj2;
      X21 -= (f32x2){La10[2], La10[3]} * xj2;
      X22 -= (f32x2){La11[0], La11[1]} * xj2;
      X23 -= (f32x2){La11[2], La11[3]} * xj2;
      X24 -= (f32x2){La12[0], La12[1]} * xj2;
      X25 -= (f32x2){La12[2], La12[3]} * xj2;
      X26 -= (f32x2){La13[0], La13[1]} * xj2;
      X27 -= (f32x2){La13[2], La13[3]} * xj2;
      X28 -= (f32x2){La14[0], La14[1]} * xj2;
      X29 -= (f32x2){La14[2], La14[3]} * xj2;
      X30 -= (f32x2){La15[0], La15[1]} * xj2;
      X31 -= (f32x2){La15[2], La15[3]} * xj2;
    }
    __builtin_amdgcn_sched_barrier(0);
    La1 = *(const f32x4*)(Lt_s + 412);
    La2 = *(const f32x4*)(Lt_s + 416);
    La3 = *(const f32x4*)(Lt_s + 420);
    La4 = *(const f32x4*)(Lt_s + 424);
    La5 = *(const f32x4*)(Lt_s + 428);
    La6 = *(const f32x4*)(Lt_s + 432);
    La7 = *(const f32x4*)(Lt_s + 436);
    La8 = *(const f32x4*)(Lt_s + 440);
    La9 = *(const f32x4*)(Lt_s + 444);
    La10 = *(const f32x4*)(Lt_s + 448);
    La11 = *(const f32x4*)(Lt_s + 452);
    La12 = *(const f32x4*)(Lt_s + 456);
    La13 = *(const f32x4*)(Lt_s + 460);
    La14 = *(const f32x4*)(Lt_s + 464);
    La15 = *(const f32x4*)(Lt_s + 468);
    __builtin_amdgcn_sched_barrier(0);
    { const float xj = X2[1]; const f32x2 xj2 = (f32x2){xj, xj};
      X3 -= (f32x2){Lb1[2], Lb1[3]} * xj2;
      X4 -= (f32x2){Lb2[0], Lb2[1]} * xj2;
      X5 -= (f32x2){Lb2[2], Lb2[3]} * xj2;
      X6 -= (f32x2){Lb3[0], Lb3[1]} * xj2;
      X7 -= (f32x2){Lb3[2], Lb3[3]} * xj2;
      X8 -= (f32x2){Lb4[0], Lb4[1]} * xj2;
      X9 -= (f32x2){Lb4[2], Lb4[3]} * xj2;
      X10 -= (f32x2){Lb5[0], Lb5[1]} * xj2;
      X11 -= (f32x2){Lb5[2], Lb5[3]} * xj2;
      X12 -= (f32x2){Lb6[0], Lb6[1]} * xj2;
      X13 -= (f32x2){Lb6[2], Lb6[3]} * xj2;
      X14 -= (f32x2){Lb7[0], Lb7[1]} * xj2;
      X15 -= (f32x2){Lb7[2], Lb7[3]} * xj2;
      X16 -= (f32x2){Lb8[0], Lb8[1]} * xj2;
      X17 -= (f32x2){Lb8[2], Lb8[3]} * xj2;
      X18 -= (f32x2){Lb9[0], Lb9[1]} * xj2;
      X19 -= (f32x2){Lb9[2], Lb9[3]} * xj2;
      X20 -= (f32x2){Lb10[0], Lb10[1]} * xj2;
      X21 -= (f32x2){Lb10[2], Lb10[3]} * xj2;
      X22 -= (f32x2){Lb11[0], Lb11[1]} * xj2;
      X23 -= (f32x2){Lb11[2], Lb11[3]} * xj2;
      X24 -= (f32x2){Lb12[0], Lb12[1]} * xj2;
      X25 -= (f32x2){Lb12[2], Lb12[3]} * xj2;
      X26 -= (f32x2){Lb13[0], Lb13[1]} * xj2;
      X27 -= (f32x2){Lb13[2], Lb13[3]} * xj2;
      X28 -= (f32x2){Lb14[0], Lb14[1]} * xj2;
      X29 -= (f32x2){Lb14[2], Lb14[3]} * xj2;
      X30 -= (f32x2){Lb15[0], Lb15[1]} * xj2;
      X31 -= (f32x2){Lb15[2], Lb15[3]} * xj2;
    }
    __builtin_amdgcn_sched_barrier(0);
    Lb2 = *(const f32x4*)(Lt_s + 484);
    Lb3 = *(const f32x4*)(Lt_s + 488);
    Lb4 = *(const f32x4*)(Lt_s + 492);
    Lb5 = *(const f32x4*)(Lt_s + 496);
    Lb6 = *(const f32x4*)(Lt_s + 500);
    Lb7 = *(const f32x4*)(Lt_s + 504);
    Lb8 = *(const f32x4*)(Lt_s + 508);
    Lb9 = *(const f32x4*)(Lt_s + 512);
    Lb10 = *(const f32x4*)(Lt_s + 516);
    Lb11 = *(const f32x4*)(Lt_s + 520);
    Lb12 = *(const f32x4*)(Lt_s + 524);
    Lb13 = *(const f32x4*)(Lt_s + 528);
    Lb14 = *(const f32x4*)(Lt_s + 532);
    Lb15 = *(const f32x4*)(Lt_s + 536);
    __builtin_amdgcn_sched_barrier(0);
    { const float xj = X3[0]; const f32x2 xj2 = (f32x2){xj, xj};
      X3 -= (f32x2){La1[2], La1[3]} * xj2;
      X4 -= (f32x2){La2[0], La2[1]} * xj2;
      X5 -= (f32x2){La2[2], La2[3]} * xj2;
      X6 -= (f32x2){La3[0], La3[1]} * xj2;
      X7 -= (f32x2){La3[2], La3[3]} * xj2;
      X8 -= (f32x2){La4[0], La4[1]} * xj2;
      X9 -= (f32x2){La4[2], La4[3]} * xj2;
      X10 -= (f32x2){La5[0], La5[1]} * xj2;
      X11 -= (f32x2){La5[2], La5[3]} * xj2;
      X12 -= (f32x2){La6[0], La6[1]} * xj2;
      X13 -= (f32x2){La6[2], La6[3]} * xj2;
      X14 -= (f32x2){La7[0], La7[1]} * xj2;
      X15 -= (f32x2){La7[2], La7[3]} * xj2;
      X16 -= (f32x2){La8[0], La8[1]} * xj2;
      X17 -= (f32x2){La8[2], La8[3]} * xj2;
      X18 -= (f32x2){La9[0], La9[1]} * xj2;
      X19 -= (f32x2){La9[2], La9[3]} * xj2;
      X20 -= (f32x2){La10[0], La10[1]} * xj2;
      X21 -= (f32x2){La10[2], La10[3]} * xj2;
      X22 -= (f32x2){La11[0], La11[1]} * xj2;
      X23 -= (f32x2){La11[2], La11[3]} * xj2;
      X24 -= (f32x2){La12[0], La12[1]} * xj2;
      X25 -= (f32x2){La12[2], La12[3]} * xj2;
      X26 -= (f32x2){La13[0], La13[1]} * xj2;
      X27 -= (f32x2){La13[2], La13[3]} * xj2;
      X28 -= (f32x2){La14[0], La14[1]} * xj2;
      X29 -= (f32x2){La14[2], La14[3]} * xj2;
      X30 -= (f32x2){La15[0], La15[1]} * xj2;
      X31 -= (f32x2){La15[2], La15[3]} * xj2;
    }
    __builtin_amdgcn_sched_barrier(0);
    La2 = *(const f32x4*)(Lt_s + 552);
    La3 = *(const f32x4*)(Lt_s + 556);
    La4 = *(const f32x4*)(Lt_s + 560);
    La5 = *(const f32x4*)(Lt_s + 564);
    La6 = *(const f32x4*)(Lt_s + 568);
    La7 = *(const f32x4*)(Lt_s + 572);
    La8 = *(const f32x4*)(Lt_s + 576);
    La9 = *(const f32x4*)(Lt_s + 580);
    La10 = *(const f32x4*)(Lt_s + 584);
    La11 = *(const f32x4*)(Lt_s + 588);
    La12 = *(const f32x4*)(Lt_s + 592);
    La13 = *(const f32x4*)(Lt_s + 596);
    La14 = *(const f32x4*)(Lt_s + 600);
    La15 = *(const f32x4*)(Lt_s + 604);
    __builtin_amdgcn_sched_barrier(0);
    { const float xj = X3[1]; const f32x2 xj2 = (f32x2){xj, xj};
      X4 -= (f32x2){Lb2[0], Lb2[1]} * xj2;
      X5 -= (f32x2){Lb2[2], Lb2[3]} * xj2;
      X6 -= (f32x2){Lb3[0], Lb3[1]} * xj2;
      X7 -= (f32x2){Lb3[2], Lb3[3]} * xj2;
      X8 -= (f32x2){Lb4[0], Lb4[1]} * xj2;
      X9 -= (f32x2){Lb4[2], Lb4[3]} * xj2;
      X10 -= (f32x2){Lb5[0], Lb5[1]} * xj2;
      X11 -= (f32x2){Lb5[2], Lb5[3]} * xj2;
      X12 -= (f32x2){Lb6[0], Lb6[1]} * xj2;
      X13 -= (f32x2){Lb6[2], Lb6[3]} * xj2;
      X14 -= (f32x2){Lb7[0], Lb7[1]} * xj2;
      X15 -= (f32x2){Lb7[2], Lb7[3]} * xj2;
      X16 -= (f32x2){Lb8[0], Lb8[1]} * xj2;
      X17 -= (f32x2){Lb8[2], Lb8[3]} * xj2;
      X18 -= (f32x2){Lb9[0], Lb9[1]} * xj2;
      X19 -= (f32x2){Lb9[2], Lb9[3]} * xj2;
      X20 -= (f32x2){Lb10[0], Lb10[1]} * xj2;
      X21 -= (f32x2){Lb10[2], Lb10[3]} * xj2;
      X22 -= (f32x2){Lb11[0], Lb11[1]} * xj2;
      X23 -= (f32x2){Lb11[2], Lb11[3]} * xj2;
      X24 -= (f32x2){Lb12[0], Lb12[1]} * xj2;
      X25 -= (f32x2){Lb12[2], Lb12[3]} * xj2;
      X26 -= (f32x2){Lb13[0], Lb13[1]} * xj2;
      X27 -= (f32x2){Lb13[2], Lb13[3]} * xj2;
      X28 -= (f32x2){Lb14[0], Lb14[1]} * xj2;
      X29 -= (f32x2){Lb14[2], Lb14[3]} * xj2;
      X30 -= (f32x2){Lb15[0], Lb15[1]} * xj2;
      X31 -= (f32x2){Lb15[2], Lb15[3]} * xj2;
    }
    __builtin_amdgcn_sched_barrier(0);
    Lb2 = *(const f32x4*)(Lt_s + 620);
    Lb3 = *(const f32x4*)(Lt_s + 624);
    Lb4 = *(const f32x4*)(Lt_s + 628);
    Lb5 = *(const f32x4*)(Lt_s + 632);
    Lb6 = *(const f32x4*)(Lt_s + 636);
    Lb7 = *(const f32x4*)(Lt_s + 640);
    Lb8 = *(const f32x4*)(Lt_s + 644);
    Lb9 = *(const f32x4*)(Lt_s + 648);
    Lb10 = *(const f32x4*)(Lt_s + 652);
    Lb11 = *(const f32x4*)(Lt_s + 656);
    Lb12 = *(const f32x4*)(Lt_s + 660);
    Lb13 = *(const f32x4*)(Lt_s + 664);
    Lb14 = *(const f32x4*)(Lt_s + 668);
    Lb15 = *(const f32x4*)(Lt_s + 672);
    __builtin_amdgcn_sched_barrier(0);
    { const float xj = X4[0]; const f32x2 xj2 = (f32x2){xj, xj};
      X4 -= (f32x2){La2[0], La2[1]} * xj2;
      X5 -= (f32x2){La2[2], La2[3]} * xj2;
      X6 -= (f32x2){La3[0], La3[1]} * xj2;
      X7 -= (f32x2){La3[2], La3[3]} * xj2;
      X8 -= (f32x2){La4[0], La4[1]} * xj2;
      X9 -= (f32x2){La4[2], La4[3]} * xj2;
      X10 -= (f32x2){La5[0], La5[1]} * xj2;
      X11 -= (f32x2){La5[2], La5[3]} * xj2;
      X12 -= (f32x2){La6[0], La6[1]} * xj2;
      X13 -= (f32x2){La6[2], La6[3]} * xj2;
      X14 -= (f32x2){La7[0], La7[1]} * xj2;
      X15 -= (f32x2){La7[2], La7[3]} * xj2;
      X16 -= (f32x2){La8[0], La8[1]} * xj2;
      X17 -= (f32x2){La8[2], La8[3]} * xj2;
      X18 -= (f32x2){La9[0], La9[1]} * xj2;
      X19 -= (f32x2){La9[2], La9[3]} * xj2;
      X20 -= (f32x2){La10[0], La10[1]} * xj2;
      X21 -= (f32x2){La10[2], La10[3]} * xj2;
      X22 -= (f32x2){La11[0], La11[1]} * xj2;
      X23 -= (f32x2){La11[2], La11[3]} * xj2;
      X24 -= (f32x2){La12[0], La12[1]} * xj2;
      X25 -= (f32x2){La12[2], La12[3]} * xj2;
      X26 -= (f32x2){La13[0], La13[1]} * xj2;
      X27 -= (f32x2){La13[2], La13[3]} * xj2;
      X28 -= (f32x2){La14[0], La14[1]} * xj2;
      X29 -= (f32x2){La14[2], La14[3]} * xj2;
      X30 -= (f32x2){La15[0], La15[1]} * xj2;
      X31 -= (f32x2){La15[2], La15[3]} * xj2;
    }
    __builtin_amdgcn_sched_barrier(0);
    La2 = *(const f32x4*)(Lt_s + 688);
    La3 = *(const f32x4*)(Lt_s + 692);
    La4 = *(const f32x4*)(Lt_s + 696);
    La5 = *(const f32x4*)(Lt_s + 700);
    La6 = *(const f32x4*)(Lt_s + 704);
    La7 = *(const f32x4*)(Lt_s + 708);
    La8 = *(const f32x4*)(Lt_s + 712);
    La9 = *(const f32x4*)(Lt_s + 716);
    La10 = *(const f32x4*)(Lt_s + 720);
    La11 = *(const f32x4*)(Lt_s + 724);
    La12 = *(const f32x4*)(Lt_s + 728);
    La13 = *(const f32x4*)(Lt_s + 732);
    La14 = *(const f32x4*)(Lt_s + 736);
    La15 = *(const f32x4*)(Lt_s + 740);
    __builtin_amdgcn_sched_barrier(0);
    { const float xj = X4[1]; const f32x2 xj2 = (f32x2){xj, xj};
      X5 -= (f32x2){Lb2[2], Lb2[3]} * xj2;
      X6 -= (f32x2){Lb3[0], Lb3[1]} * xj2;
      X7 -= (f32x2){Lb3[2], Lb3[3]} * xj2;
      X8 -= (f32x2){Lb4[0], Lb4[1]} * xj2;
      X9 -= (f32x2){Lb4[2], Lb4[3]} * xj2;
      X10 -= (f32x2){Lb5[0], Lb5[1]} * xj2;
      X11 -= (f32x2){Lb5[2], Lb5[3]} * xj2;
      X12 -= (f32x2){Lb6[0], Lb6[1]} * xj2;
      X13 -= (f32x2){Lb6[2], Lb6[3]} * xj2;
      X14 -= (f32x2){Lb7[0], Lb7[1]} * xj2;
      X15 -= (f32x2){Lb7[2], Lb7[3]} * xj2;
      X16 -= (f32x2){Lb8[0], Lb8[1]} * xj2;
      X17 -= (f32x2){Lb8[2], Lb8[3]} * xj2;
      X18 -= (f32x2){Lb9[0], Lb9[1]} * xj2;
      X19 -= (f32x2){Lb9[2], Lb9[3]} * xj2;
      X20 -= (f32x2){Lb10[0], Lb10[1]} * xj2;
      X21 -= (f32x2){Lb10[2], Lb10[3]} * xj2;
      X22 -= (f32x2){Lb11[0], Lb11[1]} * xj2;
      X23 -= (f32x2){Lb11[2], Lb11[3]} * xj2;
      X24 -= (f32x2){Lb12[0], Lb12[1]} * xj2;
      X25 -= (f32x2){Lb12[2], Lb12[3]} * xj2;
      X26 -= (f32x2){Lb13[0], Lb13[1]} * xj2;
      X27 -= (f32x2){Lb13[2], Lb13[3]} * xj2;
      X28 -= (f32x2){Lb14[0], Lb14[1]} * xj2;
      X29 -= (f32x2){Lb14[2], Lb14[3]} * xj2;
      X30 -= (f32x2){Lb15[0], Lb15[1]} * xj2;
      X31 -= (f32x2){Lb15[2], Lb15[3]} * xj2;
    }
    __builtin_amdgcn_sched_barrier(0);
    Lb3 = *(const f32x4*)(Lt_s + 760);
    Lb4 = *(const f32x4*)(Lt_s + 764);
    Lb5 = *(const f32x4*)(Lt_s + 768);
    Lb6 = *(const f32x4*)(Lt_s + 772);
    Lb7 = *(const f32x4*)(Lt_s + 776);
    Lb8 = *(const f32x4*)(Lt_s + 780);
    Lb9 = *(const f32x4*)(Lt_s + 784);
    Lb10 = *(const f32x4*)(Lt_s + 788);
    Lb11 = *(const f32x4*)(Lt_s + 792);
    Lb12 = *(const f32x4*)(Lt_s + 796);
    Lb13 = *(const f32x4*)(Lt_s + 800);
    Lb14 = *(const f32x4*)(Lt_s + 804);
    Lb15 = *(const f32x4*)(Lt_s + 808);
    __builtin_amdgcn_sched_barrier(0);
    { const float xj = X5[0]; const f32x2 xj2 = (f32x2){xj, xj};
      X5 -= (f32x2){La2[2], La2[3]} * xj2;
      X6 -= (f32x2){La3[0], La3[1]} * xj2;
      X7 -= (f32x2){La3[2], La3[3]} * xj2;
      X8 -= (f32x2){La4[0], La4[1]} * xj2;
      X9 -= (f32x2){La4[2], La4[3]} * xj2;
      X10 -= (f32x2){La5[0], La5[1]} * xj2;
      X11 -= (f32x2){La5[2], La5[3]} * xj2;
      X12 -= (f32x2){La6[0], La6[1]} * xj2;
      X13 -= (f32x2){La6[2], La6[3]} * xj2;
      X14 -= (f32x2){La7[0], La7[1]} * xj2;
      X15 -= (f32x2){La7[2], La7[3]} * xj2;
      X16 -= (f32x2){La8[0], La8[1]} * xj2;
      X17 -= (f32x2){La8[2], La8[3]} * xj2;
      X18 -= (f32x2){La9[0], La9[1]} * xj2;
      X19 -= (f32x2){La9[2], La9[3]} * xj2;
      X20 -= (f32x2){La10[0], La10[1]} * xj2;
      X21 -= (f32x2){La10[2], La10[3]} * xj2;
      X22 -= (f32x2){La11[0], La11[1]} * xj2;
      X23 -= (f32x2){La11[2], La11[3]} * xj2;
      X24 -= (f32x2){La12[0], La12[1]} * xj2;
      X25 -= (f32x2){La12[2], La12[3]} * xj2;
      X26 -= (f32x2){La13[0], La13[1]} * xj2;
      X27 -= (f32x2){La13[2], La13[3]} * xj2;
      X28 -= (f32x2){La14[0], La14[1]} * xj2;
      X29 -= (f32x2){La14[2], La14[3]} * xj2;
      X30 -= (f32x2){La15[0], La15[1]} * xj2;
      X31 -= (f32x2){La15[2], La15[3]} * xj2;
    }
    __builtin_amdgcn_sched_barrier(0);
    La3 = *(const f32x4*)(Lt_s + 828);
    La4 = *(const f32x4*)(Lt_s + 832);
    La5 = *(const f32x4*)(Lt_s + 836);
    La6 = *(const f32x4*)(Lt_s + 840);
    La7 = *(const f32x4*)(Lt_s + 844);
    La8 = *(const f32x4*)(Lt_s + 848);
    La9 = *(const f32x4*)(Lt_s + 852);
    La10 = *(const f32x4*)(Lt_s + 856);
    La11 = *(const f32x4*)(Lt_s + 860);
    La12 = *(const f32x4*)(Lt_s + 864);
    La13 = *(const f32x4*)(Lt_s + 868);
    La14 = *(const f32x4*)(Lt_s + 872);
    La15 = *(const f32x4*)(Lt_s + 876);
    __builtin_amdgcn_sched_barrier(0);
    { const float xj = X5[1]; const f32x2 xj2 = (f32x2){xj, xj};
      X6 -= (f32x2){Lb3[0], Lb3[1]} * xj2;
      X7 -= (f32x2){Lb3[2], Lb3[3]} * xj2;
      X8 -= (f32x2){Lb4[0], Lb4[1]} * xj2;
      X9 -= (f32x2){Lb4[2], Lb4[3]} * xj2;
      X10 -= (f32x2){Lb5[0], Lb5[1]} * xj2;
      X11 -= (f32x2){Lb5[2], Lb5[3]} * xj2;
      X12 -= (f32x2){Lb6[0], Lb6[1]} * xj2;
      X13 -= (f32x2){Lb6[2], Lb6[3]} * xj2;
      X14 -= (f32x2){Lb7[0], Lb7[1]} * xj2;
      X15 -= (f32x2){Lb7[2], Lb7[3]} * xj2;
      X16 -= (f32x2){Lb8[0], Lb8[1]} * xj2;
      X17 -= (f32x2){Lb8[2], Lb8[3]} * xj2;
      X18 -= (f32x2){Lb9[0], Lb9[1]} * xj2;
      X19 -= (f32x2){Lb9[2], Lb9[3]} * xj2;
      X20 -= (f32x2){Lb10[0], Lb10[1]} * xj2;
      X21 -= (f32x2){Lb10[2], Lb10[3]} * xj2;
      X22 -= (f32x2){Lb11[0], Lb11[1]} * xj2;
      X23 -= (f32x2){Lb11[2], Lb11[3]} * xj2;
      X24 -= (f32x2){Lb12[0], Lb12[1]} * xj2;
      X25 -= (f32x2){Lb12[2], Lb12[3]} * xj2;
      X26 -= (f32x2){Lb13[0], Lb13[1]} * xj2;
      X27 -= (f32x2){Lb13[2], Lb13[3]} * xj2;
      X28 -= (f32x2){Lb14[0], Lb14[1]} * xj2;
      X29 -= (f32x2){Lb14[2], Lb14[3]} * xj2;
      X30 -= (f32x2){Lb15[0], Lb15[1]} * xj2;
      X31 -= (f32x2){Lb15[2], Lb15[3]} * xj2;
    }
    __builtin_amdgcn_sched_barrier(0);
    Lb3 = *(const f32x4*)(Lt_s + 896);
    Lb4 = *(const f32x4*)(Lt_s + 900);
    Lb5 = *(const f32x4*)(Lt_s + 904);
    Lb6 = *(const f32x4*)(Lt_s + 908);
    Lb7 = *(const f32x4*)(Lt_s + 912);
    Lb8 = *(const f32x4*)(Lt_s + 916);
    Lb9 = *(const f32x4*)(Lt_s + 920);
    Lb10 = *(const f32x4*)(Lt_s + 924);
    Lb11 = *(const f32x4*)(Lt_s + 928);
    Lb12 = *(const f32x4*)(Lt_s + 932);
    Lb13 = *(const f32x4*)(Lt_s + 936);
    Lb14 = *(const f32x4*)(Lt_s + 940);
    Lb15 = *(const f32x4*)(Lt_s + 944);
    __builtin_amdgcn_sched_barrier(0);
    { const float xj = X6[0]; const f32x2 xj2 = (f32x2){xj, xj};
      X6 -= (f32x2){La3[0], La3[1]} * xj2;
      X7 -= (f32x2){La3[2], La3[3]} * xj2;
      X8 -= (f32x2){La4[0], La4[1]} * xj2;
      X9 -= (f32x2){La4[2], La4[3]} * xj2;
      X10 -= (f32x2){La5[0], La5[1]} * xj2;
      X11 -= (f32x2){La5[2], La5[3]} * xj2;
      X12 -= (f32x2){La6[0], La6[1]} * xj2;
      X13 -= (f32x2){La6[2], La6[3]} * xj2;
      X14 -= (f32x2){La7[0], La7[1]} * xj2;
      X15 -= (f32x2){La7[2], La7[3]} * xj2;
      X16 -= (f32x2){La8[0], La8[1]} * xj2;
      X17 -= (f32x2){La8[2], La8[3]} * xj2;
      X18 -= (f32x2){La9[0], La9[1]} * xj2;
      X19 -= (f32x2){La9[2], La9[3]} * xj2;
      X20 -= (f32x2){La10[0], La10[1]} * xj2;
      X21 -= (f32x2){La10[2], La10[3]} * xj2;
      X22 -= (f32x2){La11[0], La11[1]} * xj2;
      X23 -= (f32x2){La11[2], La11[3]} * xj2;
      X24 -= (f32x2){La12[0], La12[1]} * xj2;
      X25 -= (f32x2){La12[2], La12[3]} * xj2;
      X26 -= (f32x2){La13[0], La13[1]} * xj2;
      X27 -= (f32x2){La13[2], La13[3]} * xj2;
      X28 -= (f32x2){La14[0], La14[1]} * xj2;
      X29 -= (f32x2){La14[2], La14[3]} * xj2;
      X30 -= (f32x2){La15[0], La15[1]} * xj2;
      X31 -= (f32x2){La15[2], La15[3]} * xj2;
    }
    __builtin_amdgcn_sched_barrier(0);
    La3 = *(const f32x4*)(Lt_s + 964);
    La4 = *(const f32x4*)(Lt_s + 968);
    La5 = *(const f32x4*)(Lt_s + 972);
    La6 = *(const f32x4*)(Lt_s + 976);
    La7 = *(const f32x4*)(Lt_s + 980);
    La8 = *(const f32x4*)(Lt_s + 984);
    La9 = *(const f32x4*)(Lt_s + 988);
    La10 = *(const f32x4*)(Lt_s + 992);
    La11 = *(const f32x4*)(Lt_s + 996);
    La12 = *(const f32x4*)(Lt_s + 1000);
    La13 = *(const f32x4*)(Lt_s + 1004);
    La14 = *(const f32x4*)(Lt_s + 1008);
    La15 = *(const f32x4*)(Lt_s + 1012);
    __builtin_amdgcn_sched_barrier(0);
    { const float xj = X6[1]; const f32x2 xj2 = (f32x2){xj, xj};
      X7 -= (f32x2){Lb3[2], Lb3[3]} * xj2;
      X8 -= (f32x2){Lb4[0], Lb4[1]} * xj2;
      X9 -= (f32x2){Lb4[2], Lb4[3]} * xj2;
      X10 -= (f32x2){Lb5[0], Lb5[1]} * xj2;
      X11 -= (f32x2){Lb5[2], Lb5[3]} * xj2;
      X12 -= (f32x2){Lb6[0], Lb6[1]} * xj2;
      X13 -= (f32x2){Lb6[2], Lb6[3]} * xj2;
      X14 -= (f32x2){Lb7[0], Lb7[1]} * xj2;
      X15 -= (f32x2){Lb7[2], Lb7[3]} * xj2;
      X16 -= (f32x2){Lb8[0], Lb8[1]} * xj2;
      X17 -= (f32x2){Lb8[2], Lb8[3]} * xj2;
      X18 -= (f32x2){Lb9[0], Lb9[1]} * xj2;
      X19 -= (f32x2){Lb9[2], Lb9[3]} * xj2;
      X20 -= (f32x2){Lb10[0], Lb10[1]} * xj2;
      X21 -= (f32x2){Lb10[2], Lb10[3]} * xj2;
      X22 -= (f32x2){Lb11[0], Lb11[1]} * xj2;
      X23 -= (f32x2){Lb11[2], Lb11[3]} * xj2;
      X24 -= (f32x2){Lb12[0], Lb12[1]} * xj2;
      X25 -= (f32x2){Lb12[2], Lb12[3]} * xj2;
      X26 -= (f32x2){Lb13[0], Lb13[1]} * xj2;
      X27 -= (f32x2){Lb13[2], Lb13[3]} * xj2;
      X28 -= (f32x2){Lb14[0], Lb14[1]} * xj2;
      X29 -= (f32x2){Lb14[2], Lb14[3]} * xj2;
      X30 -= (f32x2){Lb15[0], Lb15[1]} * xj2;
      X31 -= (f32x2){Lb15[2], Lb15[3]} * xj2;
    }
    __builtin_amdgcn_sched_barrier(0);
    Lb4 = *(const f32x4*)(Lt_s + 1036);
    Lb5 = *(const f32x4*)(Lt_s + 1040);
    Lb6 = *(const f32x4*)(Lt_s + 1044);
    Lb7 = *(const f32x4*)(Lt_s + 1048);
    Lb8 = *(const f32x4*)(Lt_s + 1052);
    Lb9 = *(const f32x4*)(Lt_s + 1056);
    Lb10 = *(const f32x4*)(Lt_s + 1060);
    Lb11 = *(const f32x4*)(Lt_s + 1064);
    Lb12 = *(const f32x4*)(Lt_s + 1068);
    Lb13 = *(const f32x4*)(Lt_s + 1072);
    Lb14 = *(const f32x4*)(Lt_s + 1076);
    Lb15 = *(const f32x4*)(Lt_s + 1080);
    __builtin_amdgcn_sched_barrier(0);
    { const float xj = X7[0]; const f32x2 xj2 = (f32x2){xj, xj};
      X7 -= (f32x2){La3[2], La3[3]} * xj2;
      X8 -= (f32x2){La4[0], La4[1]} * xj2;
      X9 -= (f32x2){La4[2], La4[3]} * xj2;
      X10 -= (f32x2){La5[0], La5[1]} * xj2;
      X11 -= (f32x2){La5[2], La5[3]} * xj2;
      X12 -= (f32x2){La6[0], La6[1]} * xj2;
      X13 -= (f32x2){La6[2], La6[3]} * xj2;
      X14 -= (f32x2){La7[0], La7[1]} * xj2;
      X15 -= (f32x2){La7[2], La7[3]} * xj2;
      X16 -= (f32x2){La8[0], La8[1]} * xj2;
      X17 -= (f32x2){La8[2], La8[3]} * xj2;
      X18 -= (f32x2){La9[0], La9[1]} * xj2;
      X19 -= (f32x2){La9[2], La9[3]} * xj2;
      X20 -= (f32x2){La10[0], La10[1]} * xj2;
      X21 -= (f32x2){La10[2], La10[3]} * xj2;
      X22 -= (f32x2){La11[0], La11[1]} * xj2;
      X23 -= (f32x2){La11[2], La11[3]} * xj2;
      X24 -= (f32x2){La12[0], La12[1]} * xj2;
      X25 -= (f32x2){La12[2], La12[3]} * xj2;
      X26 -= (f32x2){La13[0], La13[1]} * xj2;
      X27 -= (f32x2){La13[2], La13[3]} * xj2;
      X28 -= (f32x2){La14[0], La14[1]} * xj2;
      X29 -= (f32x2){La14[2], La14[3]} * xj2;
      X30 -= (f32x2){La15[0], La15[1]} * xj2;
      X31 -= (f32x2){La15[2], La15[3]} * xj2;
    }
    __builtin_amdgcn_sched_barrier(0);
    La4 = *(const f32x4*)(Lt_s + 1104);
    La5 = *(const f32x4*)(Lt_s + 1108);
    La6 = *(const f32x4*)(Lt_s + 1112);
    La7 = *(const f32x4*)(Lt_s + 1116);
    La8 = *(const f32x4*)(Lt_s + 1120);
    La9 = *(const f32x4*)(Lt_s + 1124);
    La10 = *(const f32x4*)(Lt_s + 1128);
    La11 = *(const f32x4*)(Lt_s + 1132);
    La12 = *(const f32x4*)(Lt_s + 1136);
    La13 = *(const f32x4*)(Lt_s + 1140);
    La14 = *(const f32x4*)(Lt_s + 1144);
    La15 = *(const f32x4*)(Lt_s + 1148);
    __builtin_amdgcn_sched_barrier(0);
    { const float xj = X7[1]; const f32x2 xj2 = (f32x2){xj, xj};
      X8 -= (f32x2){Lb4[0], Lb4[1]} * xj2;
      X9 -= (f32x2){Lb4[2], Lb4[3]} * xj2;
      X10 -= (f32x2){Lb5[0], Lb5[1]} * xj2;
      X11 -= (f32x2){Lb5[2], Lb5[3]} * xj2;
      X12 -= (f32x2){Lb6[0], Lb6[1]} * xj2;
      X13 -= (f32x2){Lb6[2], Lb6[3]} * xj2;
      X14 -= (f32x2){Lb7[0], Lb7[1]} * xj2;
      X15 -= (f32x2){Lb7[2], Lb7[3]} * xj2;
      X16 -= (f32x2){Lb8[0], Lb8[1]} * xj2;
      X17 -= (f32x2){Lb8[2], Lb8[3]} * xj2;
      X18 -= (f32x2){Lb9[0], Lb9[1]} * xj2;
      X19 -= (f32x2){Lb9[2], Lb9[3]} * xj2;
      X20 -= (f32x2){Lb10[0], Lb10[1]} * xj2;
      X21 -= (f32x2){Lb10[2], Lb10[3]} * xj2;
      X22 -= (f32x2){Lb11[0], Lb11[1]} * xj2;
      X23 -= (f32x2){Lb11[2], Lb11[3]} * xj2;
      X24 -= (f32x2){Lb12[0], Lb12[1]} * xj2;
      X25 -= (f32x2){Lb12[2], Lb12[3]} * xj2;
      X26 -= (f32x2){Lb13[0], Lb13[1]} * xj2;
      X27 -= (f32x2){Lb13[2], Lb13[3]} * xj2;
      X28 -= (f32x2){Lb14[0], Lb14[1]} * xj2;
      X29 -= (f32x2){Lb14[2], Lb14[3]} * xj2;
      X30 -= (f32x2){Lb15[0], Lb15[1]} * xj2;
      X31 -= (f32x2){Lb15[2], Lb15[3]} * xj2;
    }
    __builtin_amdgcn_sched_barrier(0);
    Lb4 = *(const f32x4*)(Lt_s + 1172);
    Lb5 = *(const f32x4*)(Lt_s + 1176);
    Lb6 = *(const f32x4*)(Lt_s + 1180);
    Lb7 = *(const f32x4*)(Lt_s + 1184);
    Lb8 = *(const f32x4*)(Lt_s + 1188);
    Lb9 = *(const f32x4*)(Lt_s + 1192);
    Lb10 = *(const f32x4*)(Lt_s + 1196);
    Lb11 = *(const f32x4*)(Lt_s + 1200);
    Lb12 = *(const f32x4*)(Lt_s + 1204);
    Lb13 = *(const f32x4*)(Lt_s + 1208);
    Lb14 = *(const f32x4*)(Lt_s + 1212);
    Lb15 = *(const f32x4*)(Lt_s + 1216);
    __builtin_amdgcn_sched_barrier(0);
    { const float xj = X8[0]; const f32x2 xj2 = (f32x2){xj, xj};
      X8 -= (f32x2){La4[0], La4[1]} * xj2;
      X9 -= (f32x2){La4[2], La4[3]} * xj2;
      X10 -= (f32x2){La5[0], La5[1]} * xj2;
      X11 -= (f32x2){La5[2], La5[3]} * xj2;
      X12 -= (f32x2){La6[0], La6[1]} * xj2;
      X13 -= (f32x2){La6[2], La6[3]} * xj2;
      X14 -= (f32x2){La7[0], La7[1]} * xj2;
      X15 -= (f32x2){La7[2], La7[3]} * xj2;
      X16 -= (f32x2){La8[0], La8[1]} * xj2;
      X17 -= (f32x2){La8[2], La8[3]} * xj2;
      X18 -= (f32x2){La9[0], La9[1]} * xj2;
      X19 -= (f32x2){La9[2], La9[3]} * xj2;
      X20 -= (f32x2){La10[0], La10[1]} * xj2;
      X21 -= (f32x2){La10[2], La10[3]} * xj2;
      X22 -= (f32x2){La11[0], La11[1]} * xj2;
      X23 -= (f32x2){La11[2], La11[3]} * xj2;
      X24 -= (f32x2){La12[0], La12[1]} * xj2;
      X25 -= (f32x2){La12[2], La12[3]} * xj2;
      X26 -= (f32x2){La13[0], La13[1]} * xj2;
      X27 -= (f32x2){La13[2], La13[3]} * xj2;
      X28 -= (f32x2){La14[0], La14[1]} * xj2;
      X29 -= (f32x2){La14[2], La14[3]} * xj2;
      X30 -= (f32x2){La15[0], La15[1]} * xj2;
      X31 -= (f32x2){La15[2], La15[3]} * xj2;
    }
    __builtin_amdgcn_sched_barrier(0);
    La4 = *(const f32x4*)(Lt_s + 1240);
    La5 = *(const f32x4*)(Lt_s + 1244);
    La6 = *(const f32x4*)(Lt_s + 1248);
    La7 = *(const f32x4*)(Lt_s + 1252);
    La8 = *(const f32x4*)(Lt_s + 1256);
    La9 = *(const f32x4*)(Lt_s + 1260);
    La10 = *(const f32x4*)(Lt_s + 1264);
    La11 = *(const f32x4*)(Lt_s + 1268);
    La12 = *(const f32x4*)(Lt_s + 1272);
    La13 = *(const f32x4*)(Lt_s + 1276);
    La14 = *(const f32x4*)(Lt_s + 1280);
    La15 = *(const f32x4*)(Lt_s + 1284);
    __builtin_amdgcn_sched_barrier(0);
    { const float xj = X8[1]; const f32x2 xj2 = (f32x2){xj, xj};
      X9 -= (f32x2){Lb4[2], Lb4[3]} * xj2;
      X10 -= (f32x2){Lb5[0], Lb5[1]} * xj2;
      X11 -= (f32x2){Lb5[2], Lb5[3]} * xj2;
      X12 -= (f32x2){Lb6[0], Lb6[1]} * xj2;
      X13 -= (f32x2){Lb6[2], Lb6[3]} * xj2;
      X14 -= (f32x2){Lb7[0], Lb7[1]} * xj2;
      X15 -= (f32x2){Lb7[2], Lb7[3]} * xj2;
      X16 -= (f32x2){Lb8[0], Lb8[1]} * xj2;
      X17 -= (f32x2){Lb8[2], Lb8[3]} * xj2;
      X18 -= (f32x2){Lb9[0], Lb9[1]} * xj2;
      X19 -= (f32x2){Lb9[2], Lb9[3]} * xj2;
      X20 -= (f32x2){Lb10[0], Lb10[1]} * xj2;
      X21 -= (f32x2){Lb10[2], Lb10[3]} * xj2;
      X22 -= (f32x2){Lb11[0], Lb11[1]} * xj2;
      X23 -= (f32x2){Lb11[2], Lb11[3]} * xj2;
      X24 -= (f32x2){Lb12[0], Lb12[1]} * xj2;
      X25 -= (f32x2){Lb12[2], Lb12[3]} * xj2;
      X26 -= (f32x2){Lb13[0], Lb13[1]} * xj2;
      X27 -= (f32x2){Lb13[2], Lb13[3]} * xj2;
      X28 -= (f32x2){Lb14[0], Lb14[1]} * xj2;
      X29 -= (f32x2){Lb14[2], Lb14[3]} * xj2;
      X30 -= (f32x2){Lb15[0], Lb15[1]} * xj2;
      X31 -= (f32x2){Lb15[2], Lb15[3]} * xj2;
    }
    __builtin_amdgcn_sched_barrier(0);
    Lb5 = *(const f32x4*)(Lt_s + 1312);
    Lb6 = *(const f32x4*)(Lt_s + 1316);
    Lb7 = *(const f32x4*)(Lt_s + 1320);
    Lb8 = *(const f32x4*)(Lt_s + 1324);
    Lb9 = *(const f32x4*)(Lt_s + 1328);
    Lb10 = *(const f32x4*)(Lt_s + 1332);
    Lb11 = *(const f32x4*)(Lt_s + 1336);
    Lb12 = *(const f32x4*)(Lt_s + 1340);
    Lb13 = *(const f32x4*)(Lt_s + 1344);
    Lb14 = *(const f32x4*)(Lt_s + 1348);
    Lb15 = *(const f32x4*)(Lt_s + 1352);
    __builtin_amdgcn_sched_barrier(0);
    { const float xj = X9[0]; const f32x2 xj2 = (f32x2){xj, xj};
      X9 -= (f32x2){La4[2], La4[3]} * xj2;
      X10 -= (f32x2){La5[0], La5[1]} * xj2;
      X11 -= (f32x2){La5[2], La5[3]} * xj2;
      X12 -= (f32x2){La6[0], La6[1]} * xj2;
      X13 -= (f32x2){La6[2], La6[3]} * xj2;
      X14 -= (f32x2){La7[0], La7[1]} * xj2;
      X15 -= (f32x2){La7[2], La7[3]} * xj2;
      X16 -= (f32x2){La8[0], La8[1]} * xj2;
      X17 -= (f32x2){La8[2], La8[3]} * xj2;
      X18 -= (f32x2){La9[0], La9[1]} * xj2;
      X19 -= (f32x2){La9[2], La9[3]} * xj2;
      X20 -= (f32x2){La10[0], La10[1]} * xj2;
      X21 -= (f32x2){La10[2], La10[3]} * xj2;
      X22 -= (f32x2){La11[0], La11[1]} * xj2;
      X23 -= (f32x2){La11[2], La11[3]} * xj2;
      X24 -= (f32x2){La12[0], La12[1]} * xj2;
      X25 -= (f32x2){La12[2], La12[3]} * xj2;
      X26 -= (f32x2){La13[0], La13[1]} * xj2;
      X27 -= (f32x2){La13[2], La13[3]} * xj2;
      X28 -= (f32x2){La14[0], La14[1]} * xj2;
      X29 -= (f32x2){La14[2], La14[3]} * xj2;
      X30 -= (f32x2){La15[0], La15[1]} * xj2;
      X31 -= (f32x2){La15[2], La15[3]} * xj2;
    }
    __builtin_amdgcn_sched_barrier(0);
    La5 = *(const f32x4*)(Lt_s + 1380);
    La6 = *(const f32x4*)(Lt_s + 1384);
    La7 = *(const f32x4*)(Lt_s + 1388);
    La8 = *(const f32x4*)(Lt_s + 1392);
    La9 = *(const f32x4*)(Lt_s + 1396);
    La10 = *(const f32x4*)(Lt_s + 1400);
    La11 = *(const f32x4*)(Lt_s + 1404);
    La12 = *(const f32x4*)(Lt_s + 1408);
    La13 = *(const f32x4*)(Lt_s + 1412);
    La14 = *(const f32x4*)(Lt_s + 1416);
    La15 = *(const f32x4*)(Lt_s + 1420);
    __builtin_amdgcn_sched_barrier(0);
    { const float xj = X9[1]; const f32x2 xj2 = (f32x2){xj, xj};
      X10 -= (f32x2){Lb5[0], Lb5[1]} * xj2;
      X11 -= (f32x2){Lb5[2], Lb5[3]} * xj2;
      X12 -= (f32x2){Lb6[0], Lb6[1]} * xj2;
      X13 -= (f32x2){Lb6[2], Lb6[3]} * xj2;
      X14 -= (f32x2){Lb7[0], Lb7[1]} * xj2;
      X15 -= (f32x2){Lb7[2], Lb7[3]} * xj2;
      X16 -= (f32x2){Lb8[0], Lb8[1]} * xj2;
      X17 -= (f32x2){Lb8[2], Lb8[3]} * xj2;
      X18 -= (f32x2){Lb9[0], Lb9[1]} * xj2;
      X19 -= (f32x2){Lb9[2], Lb9[3]} * xj2;
      X20 -= (f32x2){Lb10[0], Lb10[1]} * xj2;
      X21 -= (f32x2){Lb10[2], Lb10[3]} * xj2;
      X22 -= (f32x2){Lb11[0], Lb11[1]} * xj2;
      X23 -= (f32x2){Lb11[2], Lb11[3]} * xj2;
      X24 -= (f32x2){Lb12[0], Lb12[1]} * xj2;
      X25 -= (f32x2){Lb12[2], Lb12[3]} * xj2;
      X26 -= (f32x2){Lb13[0], Lb13[1]} * xj2;
      X27 -= (f32x2){Lb13[2], Lb13[3]} * xj2;
      X28 -= (f32x2){Lb14[0], Lb14[1]} * xj2;
      X29 -= (f32x2){Lb14[2], Lb14[3]} * xj2;
      X30 -= (f32x2){Lb15[0], Lb15[1]} * xj2;
      X31 -= (f32x2){Lb15[2], Lb15[3]} * xj2;
    }
    __builtin_amdgcn_sched_barrier(0);
    Lb5 = *(const f32x4*)(Lt_s + 1448);
    Lb6 = *(const f32x4*)(Lt_s + 1452);
    Lb7 = *(const f32x4*)(Lt_s + 1456);
    Lb8 = *(const f32x4*)(Lt_s + 1460);
    Lb9 = *(const f32x4*)(Lt_s + 1464);
    Lb10 = *(const f32x4*)(Lt_s + 1468);
    Lb11 = *(const f32x4*)(Lt_s + 1472);
    Lb12 = *(const f32x4*)(Lt_s + 1476);
    Lb13 = *(const f32x4*)(Lt_s + 1480);
    Lb14 = *(const f32x4*)(Lt_s + 1484);
    Lb15 = *(const f32x4*)(Lt_s + 1488);
    __builtin_amdgcn_sched_barrier(0);
    { const float xj = X10[0]; const f32x2 xj2 = (f32x2){xj, xj};
      X10 -= (f32x2){La5[0], La5[1]} * xj2;
      X11 -= (f32x2){La5[2], La5[3]} * xj2;
      X12 -= (f32x2){La6[0], La6[1]} * xj2;
      X13 -= (f32x2){La6[2], La6[3]} * xj2;
      X14 -= (f32x2){La7[0], La7[1]} * xj2;
      X15 -= (f32x2){La7[2], La7[3]} * xj2;
      X16 -= (f32x2){La8[0], La8[1]} * xj2;
      X17 -= (f32x2){La8[2], La8[3]} * xj2;
      X18 -= (f32x2){La9[0], La9[1]} * xj2;
      X19 -= (f32x2){La9[2], La9[3]} * xj2;
      X20 -= (f32x2){La10[0], La10[1]} * xj2;
      X21 -= (f32x2){La10[2], La10[3]} * xj2;
      X22 -= (f32x2){La11[0], La11[1]} * xj2;
      X23 -= (f32x2){La11[2], La11[3]} * xj2;
      X24 -= (f32x2){La12[0], La12[1]} * xj2;
      X25 -= (f32x2){La12[2], La12[3]} * xj2;
      X26 -= (f32x2){La13[0], La13[1]} * xj2;
      X27 -= (f32x2){La13[2], La13[3]} * xj2;
      X28 -= (f32x2){La14[0], La14[1]} * xj2;
      X29 -= (f32x2){La14[2], La14[3]} * xj2;
      X30 -= (f32x2){La15[0], La15[1]} * xj2;
      X31 -= (f32x2){La15[2], La15[3]} * xj2;
    }
    __builtin_amdgcn_sched_barrier(0);
    La5 = *(const f32x4*)(Lt_s + 1516);
    La6 = *(const f32x4*)(Lt_s + 1520);
    La7 = *(const f32x4*)(Lt_s + 1524);
    La8 = *(const f32x4*)(Lt_s + 1528);
    La9 = *(const f32x4*)(Lt_s + 1532);
    La10 = *(const f32x4*)(Lt_s + 1536);
    La11 = *(const f32x4*)(Lt_s + 1540);
    La12 = *(const f32x4*)(Lt_s + 1544);
    La13 = *(const f32x4*)(Lt_s + 1548);
    La14 = *(const f32x4*)(Lt_s + 1552);
    La15 = *(const f32x4*)(Lt_s + 1556);
    __builtin_amdgcn_sched_barrier(0);
    { const float xj = X10[1]; const f32x2 xj2 = (f32x2){xj, xj};
      X11 -= (f32x2){Lb5[2], Lb5[3]} * xj2;
      X12 -= (f32x2){Lb6[0], Lb6[1]} * xj2;
      X13 -= (f32x2){Lb6[2], Lb6[3]} * xj2;
      X14 -= (f32x2){Lb7[0], Lb7[1]} * xj2;
      X15 -= (f32x2){Lb7[2], Lb7[3]} * xj2;
      X16 -= (f32x2){Lb8[0], Lb8[1]} * xj2;
      X17 -= (f32x2){Lb8[2], Lb8[3]} * xj2;
      X18 -= (f32x2){Lb9[0], Lb9[1]} * xj2;
      X19 -= (f32x2){Lb9[2], Lb9[3]} * xj2;
      X20 -= (f32x2){Lb10[0], Lb10[1]} * xj2;
      X21 -= (f32x2){Lb10[2], Lb10[3]} * xj2;
      X22 -= (f32x2){Lb11[0], Lb11[1]} * xj2;
      X23 -= (f32x2){Lb11[2], Lb11[3]} * xj2;
      X24 -= (f32x2){Lb12[0], Lb12[1]} * xj2;
      X25 -= (f32x2){Lb12[2], Lb12[3]} * xj2;
      X26 -= (f32x2){Lb13[0], Lb13[1]} * xj2;
      X27 -= (f32x2){Lb13[2], Lb13[3]} * xj2;
      X28 -= (f32x2){Lb14[0], Lb14[1]} * xj2;
      X29 -= (f32x2){Lb14[2], Lb14[3]} * xj2;
      X30 -= (f32x2){Lb15[0], Lb15[1]} * xj2;
      X31 -= (f32x2){Lb15[2], Lb15[3]} * xj2;
    }
    __builtin_amdgcn_sched_barrier(0);
    Lb6 = *(const f32x4*)(Lt_s + 1588);
    Lb7 = *(const f32x4*)(Lt_s + 1592);
    Lb8 = *(const f32x4*)(Lt_s + 1596);
    Lb9 = *(const f32x4*)(Lt_s + 1600);
    Lb10 = *(const f32x4*)(Lt_s + 1604);
    Lb11 = *(const f32x4*)(Lt_s + 1608);
    Lb12 = *(const f32x4*)(Lt_s + 1612);
    Lb13 = *(const f32x4*)(Lt_s + 1616);
    Lb14 = *(const f32x4*)(Lt_s + 1620);
    Lb15 = *(const f32x4*)(Lt_s + 1624);
    __builtin_amdgcn_sched_barrier(0);
    { const float xj = X11[0]; const f32x2 xj2 = (f32x2){xj, xj};
      X11 -= (f32x2){La5[2], La5[3]} * xj2;
      X12 -= (f32x2){La6[0], La6[1]} * xj2;
      X13 -= (f32x2){La6[2], La6[3]} * xj2;
      X14 -= (f32x2){La7[0], La7[1]} * xj2;
      X15 -= (f32x2){La7[2], La7[3]} * xj2;
      X16 -= (f32x2){La8[0], La8[1]} * xj2;
      X17 -= (f32x2){La8[2], La8[3]} * xj2;
      X18 -= (f32x2){La9[0], La9[1]} * xj2;
      X19 -= (f32x2){La9[2], La9[3]} * xj2;
      X20 -= (f32x2){La10[0], La10[1]} * xj2;
      X21 -= (f32x2){La10[2], La10[3]} * xj2;
      X22 -= (f32x2){La11[0], La11[1]} * xj2;
      X23 -= (f32x2){La11[2], La11[3]} * xj2;
      X24 -= (f32x2){La12[0], La12[1]} * xj2;
      X25 -= (f32x2){La12[2], La12[3]} * xj2;
      X26 -= (f32x2){La13[0], La13[1]} * xj2;
      X27 -= (f32x2){La13[2], La13[3]} * xj2;
      X28 -= (f32x2){La14[0], La14[1]} * xj2;
      X29 -= (f32x2){La14[2], La14[3]} * xj2;
      X30 -= (f32x2){La15[0], La15[1]} * xj2;
      X31 -= (f32x2){La15[2], La15[3]} * xj2;
    }
    __builtin_amdgcn_sched_barrier(0);
    La6 = *(const f32x4*)(Lt_s + 1656);
    La7 = *(const f32x4*)(Lt_s + 1660);
    La8 = *(const f32x4*)(Lt_s + 1664);
    La9 = *(const f32x4*)(Lt_s + 1668);
    La10 = *(const f32x4*)(Lt_s + 1672);
    La11 = *(const f32x4*)(Lt_s + 1676);
    La12 = *(const f32x4*)(Lt_s + 1680);
    La13 = *(const f32x4*)(Lt_s + 1684);
    La14 = *(const f32x4*)(Lt_s + 1688);
    La15 = *(const f32x4*)(Lt_s + 1692);
    __builtin_amdgcn_sched_barrier(0);
    { const float xj = X11[1]; const f32x2 xj2 = (f32x2){xj, xj};
      X12 -= (f32x2){Lb6[0], Lb6[1]} * xj2;
      X13 -= (f32x2){Lb6[2], Lb6[3]} * xj2;
      X14 -= (f32x2){Lb7[0], Lb7[1]} * xj2;
      X15 -= (f32x2){Lb7[2], Lb7[3]} * xj2;
      X16 -= (f32x2){Lb8[0], Lb8[1]} * xj2;
      X17 -= (f32x2){Lb8[2], Lb8[3]} * xj2;
      X18 -= (f32x2){Lb9[0], Lb9[1]} * xj2;
      X19 -= (f32x2){Lb9[2], Lb9[3]} * xj2;
      X20 -= (f32x2){Lb10[0], Lb10[1]} * xj2;
      X21 -= (f32x2){Lb10[2], Lb10[3]} * xj2;
      X22 -= (f32x2){Lb11[0], Lb11[1]} * xj2;
      X23 -= (f32x2){Lb11[2], Lb11[3]} * xj2;
      X24 -= (f32x2){Lb12[0], Lb12[1]} * xj2;
      X25 -= (f32x2){Lb12[2], Lb12[3]} * xj2;
      X26 -= (f32x2){Lb13[0], Lb13[1]} * xj2;
      X27 -= (f32x2){Lb13[2], Lb13[3]} * xj2;
      X28 -= (f32x2){Lb14[0], Lb14[1]} * xj2;
      X29 -= (f32x2){Lb14[2], Lb14[3]} * xj2;
      X30 -= (f32x2){Lb15[0], Lb15[1]} * xj2;
      X31 -= (f32x2){Lb15[2], Lb15[3]} * xj2;
    }
    __builtin_amdgcn_sched_barrier(0);
    Lb6 = *(const f32x4*)(Lt_s + 1724);
    Lb7 = *(const f32x4*)(Lt_s + 1728);
    Lb8 = *(const f32x4*)(Lt_s + 1732);
    Lb9 = *(const f32x4*)(Lt_s + 1736);
    Lb10 = *(const f32x4*)(Lt_s + 1740);
    Lb11 = *(const f32x4*)(Lt_s + 1744);
    Lb12 = *(const f32x4*)(Lt_s + 1748);
    Lb13 = *(const f32x4*)(Lt_s + 1752);
    Lb14 = *(const f32x4*)(Lt_s + 1756);
    Lb15 = *(const f32x4*)(Lt_s + 1760);
    __builtin_amdgcn_sched_barrier(0);
    { const float xj = X12[0]; const f32x2 xj2 = (f32x2){xj, xj};
      X12 -= (f32x2){La6[0], La6[1]} * xj2;
      X13 -= (f32x2){La6[2], La6[3]} * xj2;
      X14 -= (f32x2){La7[0], La7[1]} * xj2;
      X15 -= (f32x2){La7[2], La7[3]} * xj2;
      X16 -= (f32x2){La8[0], La8[1]} * xj2;
      X17 -= (f32x2){La8[2], La8[3]} * xj2;
      X18 -= (f32x2){La9[0], La9[1]} * xj2;
      X19 -= (f32x2){La9[2], La9[3]} * xj2;
      X20 -= (f32x2){La10[0], La10[1]} * xj2;
      X21 -= (f32x2){La10[2], La10[3]} * xj2;
      X22 -= (f32x2){La11[0], La11[1]} * xj2;
      X23 -= (f32x2){La11[2], La11[3]} * xj2;
      X24 -= (f32x2){La12[0], La12[1]} * xj2;
      X25 -= (f32x2){La12[2], La12[3]} * xj2;
      X26 -= (f32x2){La13[0], La13[1]} * xj2;
      X27 -= (f32x2){La13[2], La13[3]} * xj2;
      X28 -= (f32x2){La14[0], La14[1]} * xj2;
      X29 -= (f32x2){La14[2], La14[3]} * xj2;
      X30 -= (f32x2){La15[0], La15[1]} * xj2;
      X31 -= (f32x2){La15[2], La15[3]} * xj2;
    }
    __builtin_amdgcn_sched_barrier(0);
    La6 = *(const f32x4*)(Lt_s + 1792);
    La7 = *(const f32x4*)(Lt_s + 1796);
    La8 = *(const f32x4*)(Lt_s + 1800);
    La9 = *(const f32x4*)(Lt_s + 1804);
    La10 = *(const f32x4*)(Lt_s + 1808);
    La11 = *(const f32x4*)(Lt_s + 1812);
    La12 = *(const f32x4*)(Lt_s + 1816);
    La13 = *(const f32x4*)(Lt_s + 1820);
    La14 = *(const f32x4*)(Lt_s + 1824);
    La15 = *(const f32x4*)(Lt_s + 1828);
    __builtin_amdgcn_sched_barrier(0);
    { const float xj = X12[1]; const f32x2 xj2 = (f32x2){xj, xj};
      X13 -= (f32x2){Lb6[2], Lb6[3]} * xj2;
      X14 -= (f32x2){Lb7[0], Lb7[1]} * xj2;
      X15 -= (f32x2){Lb7[2], Lb7[3]} * xj2;
      X16 -= (f32x2){Lb8[0], Lb8[1]} * xj2;
      X17 -= (f32x2){Lb8[2], Lb8[3]} * xj2;
      X18 -= (f32x2){Lb9[0], Lb9[1]} * xj2;
      X19 -= (f32x2){Lb9[2], Lb9[3]} * xj2;
      X20 -= (f32x2){Lb10[0], Lb10[1]} * xj2;
      X21 -= (f32x2){Lb10[2], Lb10[3]} * xj2;
      X22 -= (f32x2){Lb11[0], Lb11[1]} * xj2;
      X23 -= (f32x2){Lb11[2], Lb11[3]} * xj2;
      X24 -= (f32x2){Lb12[0], Lb12[1]} * xj2;
      X25 -= (f32x2){Lb12[2], Lb12[3]} * xj2;
      X26 -= (f32x2){Lb13[0], Lb13[1]} * xj2;
      X27 -= (f32x2){Lb13[2], Lb13[3]} * xj2;
      X28 -= (f32x2){Lb14[0], Lb14[1]} * xj2;
      X29 -= (f32x2){Lb14[2], Lb14[3]} * xj2;
      X30 -= (f32x2){Lb15[0], Lb15[1]} * xj2;
      X31 -= (f32x2){Lb15[2], Lb15[3]} * xj2;
    }
    __builtin_amdgcn_sched_barrier(0);
    Lb7 = *(const f32x4*)(Lt_s + 1864);
    Lb8 = *(const f32x4*)(Lt_s + 1868);
    Lb9 = *(const f32x4*)(Lt_s + 1872);
    Lb10 = *(const f32x4*)(Lt_s + 1876);
    Lb11 = *(const f32x4*)(Lt_s + 1880);
    Lb12 = *(const f32x4*)(Lt_s + 1884);
    Lb13 = *(const f32x4*)(Lt_s + 1888);
    Lb14 = *(const f32x4*)(Lt_s + 1892);
    Lb15 = *(const f32x4*)(Lt_s + 1896);
    __builtin_amdgcn_sched_barrier(0);
    { const float xj = X13[0]; const f32x2 xj2 = (f32x2){xj, xj};
      X13 -= (f32x2){La6[2], La6[3]} * xj2;
      X14 -= (f32x2){La7[0], La7[1]} * xj2;
      X15 -= (f32x2){La7[2], La7[3]} * xj2;
      X16 -= (f32x2){La8[0], La8[1]} * xj2;
      X17 -= (f32x2){La8[2], La8[3]} * xj2;
      X18 -= (f32x2){La9[0], La9[1]} * xj2;
      X19 -= (f32x2){La9[2], La9[3]} * xj2;
      X20 -= (f32x2){La10[0], La10[1]} * xj2;
      X21 -= (f32x2){La10[2], La10[3]} * xj2;
      X22 -= (f32x2){La11[0], La11[1]} * xj2;
      X23 -= (f32x2){La11[2], La11[3]} * xj2;
      X24 -= (f32x2){La12[0], La12[1]} * xj2;
      X25 -= (f32x2){La12[2], La12[3]} * xj2;
      X26 -= (f32x2){La13[0], La13[1]} * xj2;
      X27 -= (f32x2){La13[2], La13[3]} * xj2;
      X28 -= (f32x2){La14[0], La14[1]} * xj2;
      X29 -= (f32x2){La14[2], La14[3]} * xj2;
      X30 -= (f32x2){La15[0], La15[1]} * xj2;
      X31 -= (f32x2){La15[2], La15[3]} * xj2;
    }
    __builtin_amdgcn_sched_barrier(0);
    La7 = *(const f32x4*)(Lt_s + 1932);
    La8 = *(const f32x4*)(Lt_s + 1936);
    La9 = *(const f32x4*)(Lt_s + 1940);
    La10 = *(const f32x4*)(Lt_s + 1944);
    La11 = *(const f32x4*)(Lt_s + 1948);
    La12 = *(const f32x4*)(Lt_s + 1952);
    La13 = *(const f32x4*)(Lt_s + 1956);
    La14 = *(const f32x4*)(Lt_s + 1960);
    La15 = *(const f32x4*)(Lt_s + 1964);
    __builtin_amdgcn_sched_barrier(0);
    { const float xj = X13[1]; const f32x2 xj2 = (f32x2){xj, xj};
      X14 -= (f32x2){Lb7[0], Lb7[1]} * xj2;
      X15 -= (f32x2){Lb7[2], Lb7[3]} * xj2;
      X16 -= (f32x2){Lb8[0], Lb8[1]} * xj2;
      X17 -= (f32x2){Lb8[2], Lb8[3]} * xj2;
      X18 -= (f32x2){Lb9[0], Lb9[1]} * xj2;
      X19 -= (f32x2){Lb9[2], Lb9[3]} * xj2;
      X20 -= (f32x2){Lb10[0], Lb10[1]} * xj2;
      X21 -= (f32x2){Lb10[2], Lb10[3]} * xj2;
      X22 -= (f32x2){Lb11[0], Lb11[1]} * xj2;
      X23 -= (f32x2){Lb11[2], Lb11[3]} * xj2;
      X24 -= (f32x2){Lb12[0], Lb12[1]} * xj2;
      X25 -= (f32x2){Lb12[2], Lb12[3]} * xj2;
      X26 -= (f32x2){Lb13[0], Lb13[1]} * xj2;
      X27 -= (f32x2){Lb13[2], Lb13[3]} * xj2;
      X28 -= (f32x2){Lb14[0], Lb14[1]} * xj2;
      X29 -= (f32x2){Lb14[2], Lb14[3]} * xj2;
      X30 -= (f32x2){Lb15[0], Lb15[1]} * xj2;
      X31 -= (f32x2){Lb15[2], Lb15[3]} * xj2;
    }
    __builtin_amdgcn_sched_barrier(0);
    Lb7 = *(const f32x4*)(Lt_s + 2000);
    Lb8 = *(const f32x4*)(Lt_s + 2004);
    Lb9 = *(const f32x4*)(Lt_s + 2008);
    Lb10 = *(const f32x4*)(Lt_s + 2012);
    Lb11 = *(const f32x4*)(Lt_s + 2016);
    Lb12 = *(const f32x4*)(Lt_s + 2020);
    Lb13 = *(const f32x4*)(Lt_s + 2024);
    Lb14 = *(const f32x4*)(Lt_s + 2028);
    Lb15 = *(const f32x4*)(Lt_s + 2032);
    __builtin_amdgcn_sched_barrier(0);
    { const float xj = X14[0]; const f32x2 xj2 = (f32x2){xj, xj};
      X14 -= (f32x2){La7[0], La7[1]} * xj2;
      X15 -= (f32x2){La7[2], La7[3]} * xj2;
      X16 -= (f32x2){La8[0], La8[1]} * xj2;
      X17 -= (f32x2){La8[2], La8[3]} * xj2;
      X18 -= (f32x2){La9[0], La9[1]} * xj2;
      X19 -= (f32x2){La9[2], La9[3]} * xj2;
      X20 -= (f32x2){La10[0], La10[1]} * xj2;
      X21 -= (f32x2){La10[2], La10[3]} * xj2;
      X22 -= (f32x2){La11[0], La11[1]} * xj2;
      X23 -= (f32x2){La11[2], La11[3]} * xj2;
      X24 -= (f32x2){La12[0], La12[1]} * xj2;
      X25 -= (f32x2){La12[2], La12[3]} * xj2;
      X26 -= (f32x2){La13[0], La13[1]} * xj2;
      X27 -= (f32x2){La13[2], La13[3]} * xj2;
      X28 -= (f32x2){La14[0], La14[1]} * xj2;
      X29 -= (f32x2){La14[2], La14[3]} * xj2;
      X30 -= (f32x2){La15[0], La15[1]} * xj2;
      X31 -= (f32x2){La15[2], La15[3]} * xj2;
    }
    __builtin_amdgcn_sched_barrier(0);
    La7 = *(const f32x4*)(Lt_s + 2068);
    La8 = *(const f32x4*)(Lt_s + 2072);
    La9 = *(const f32x4*)(Lt_s + 2076);
    La10 = *(const f32x4*)(Lt_s + 2080);
    La11 = *(const f32x4*)(Lt_s + 2084);
    La12 = *(const f32x4*)(Lt_s + 2088);
    La13 = *(const f32x4*)(Lt_s + 2092);
    La14 = *(const f32x4*)(Lt_s + 2096);
    La15 = *(const f32x4*)(Lt_s + 2100);
    __builtin_amdgcn_sched_barrier(0);
    { const float xj = X14[1]; const f32x2 xj2 = (f32x2){xj, xj};
      X15 -= (f32x2){Lb7[2], Lb7[3]} * xj2;
      X16 -= (f32x2){Lb8[0], Lb8[1]} * xj2;
      X17 -= (f32x2){Lb8[2], Lb8[3]} * xj2;
      X18 -= (f32x2){Lb9[0], Lb9[1]} * xj2;
      X19 -= (f32x2){Lb9[2], Lb9[3]} * xj2;
      X20 -= (f32x2){Lb10[0], Lb10[1]} * xj2;
      X21 -= (f32x2){Lb10[2], Lb10[3]} * xj2;
      X22 -= (f32x2){Lb11[0], Lb11[1]} * xj2;
      X23 -= (f32x2){Lb11[2], Lb11[3]} * xj2;
      X24 -= (f32x2){Lb12[0], Lb12[1]} * xj2;
      X25 -= (f32x2){Lb12[2], Lb12[3]} * xj2;
      X26 -= (f32x2){Lb13[0], Lb13[1]} * xj2;
      X27 -= (f32x2){Lb13[2], Lb13[3]} * xj2;
      X28 -= (f32x2){Lb14[0], Lb14[1]} * xj2;
      X29 -= (f32x2){Lb14[2], Lb14[3]} * xj2;
      X30 -= (f32x2){Lb15[0], Lb15[1]} * xj2;
      X31 -= (f32x2){Lb15[2], Lb15[3]} * xj2;
    }
    __builtin_amdgcn_sched_barrier(0);
    Lb8 = *(const f32x4*)(Lt_s + 2140);
    Lb9 = *(const f32x4*)(Lt_s + 2144);
    Lb10 = *(const f32x4*)(Lt_s + 2148);
    Lb11 = *(const f32x4*)(Lt_s + 2152);
    Lb12 = *(const f32x4*)(Lt_s + 2156);
    Lb13 = *(const f32x4*)(Lt_s + 2160);
    Lb14 = *(const f32x4*)(Lt_s + 2164);
    Lb15 = *(const f32x4*)(Lt_s + 2168);
    __builtin_amdgcn_sched_barrier(0);
    { const float xj = X15[0]; const f32x2 xj2 = (f32x2){xj, xj};
      X15 -= (f32x2){La7[2], La7[3]} * xj2;
      X16 -= (f32x2){La8[0], La8[1]} * xj2;
      X17 -= (f32x2){La8[2], La8[3]} * xj2;
      X18 -= (f32x2){La9[0], La9[1]} * xj2;
      X19 -= (f32x2){La9[2], La9[3]} * xj2;
      X20 -= (f32x2){La10[0], La10[1]} * xj2;
      X21 -= (f32x2){La10[2], La10[3]} * xj2;
      X22 -= (f32x2){La11[0], La11[1]} * xj2;
      X23 -= (f32x2){La11[2], La11[3]} * xj2;
      X24 -= (f32x2){La12[0], La12[1]} * xj2;
      X25 -= (f32x2){La12[2], La12[3]} * xj2;
      X26 -= (f32x2){La13[0], La13[1]} * xj2;
      X27 -= (f32x2){La13[2], La13[3]} * xj2;
      X28 -= (f32x2){La14[0], La14[1]} * xj2;
      X29 -= (f32x2){La14[2], La14[3]} * xj2;
      X30 -= (f32x2){La15[0], La15[1]} * xj2;
      X31 -= (f32x2){La15[2], La15[3]} * xj2;
    }
    __builtin_amdgcn_sched_barrier(0);
    La8 = *(const f32x4*)(Lt_s + 2208);
    La9 = *(const f32x4*)(Lt_s + 2212);
    La10 = *(const f32x4*)(Lt_s + 2216);
    La11 = *(const f32x4*)(Lt_s + 2220);
    La12 = *(const f32x4*)(Lt_s + 2224);
    La13 = *(const f32x4*)(Lt_s + 2228);
    La14 = *(const f32x4*)(Lt_s + 2232);
    La15 = *(const f32x4*)(Lt_s + 2236);
    __builtin_amdgcn_sched_barrier(0);
    { const float xj = X15[1]; const f32x2 xj2 = (f32x2){xj, xj};
      X16 -= (f32x2){Lb8[0], Lb8[1]} * xj2;
      X17 -= (f32x2){Lb8[2], Lb8[3]} * xj2;
      X18 -= (f32x2){Lb9[0], Lb9[1]} * xj2;
      X19 -= (f32x2){Lb9[2], Lb9[3]} * xj2;
      X20 -= (f32x2){Lb10[0], Lb10[1]} * xj2;
      X21 -= (f32x2){Lb10[2], Lb10[3]} * xj2;
      X22 -= (f32x2){Lb11[0], Lb11[1]} * xj2;
      X23 -= (f32x2){Lb11[2], Lb11[3]} * xj2;
      X24 -= (f32x2){Lb12[0], Lb12[1]} * xj2;
      X25 -= (f32x2){Lb12[2], Lb12[3]} * xj2;
      X26 -= (f32x2){Lb13[0], Lb13[1]} * xj2;
      X27 -= (f32x2){Lb13[2], Lb13[3]} * xj2;
      X28 -= (f32x2){Lb14[0], Lb14[1]} * xj2;
      X29 -= (f32x2){Lb14[2], Lb14[3]} * xj2;
      X30 -= (f32x2){Lb15[0], Lb15[1]} * xj2;
      X31 -= (f32x2){Lb15[2], Lb15[3]} * xj2;
    }
    __builtin_amdgcn_sched_barrier(0);
    Lb8 = *(const f32x4*)(Lt_s + 2276);
    Lb9 = *(const f32x4*)(Lt_s + 2280);
    Lb10 = *(const f32x4*)(Lt_s + 2284);
    Lb11 = *(const f32x4*)(Lt_s + 2288);
    Lb12 = *(const f32x4*)(Lt_s + 2292);
    Lb13 = *(const f32x4*)(Lt_s + 2296);
    Lb14 = *(const f32x4*)(Lt_s + 2300);
    Lb15 = *(const f32x4*)(Lt_s + 2304);
    __builtin_amdgcn_sched_barrier(0);
    { const float xj = X16[0]; const f32x2 xj2 = (f32x2){xj, xj};
      X16 -= (f32x2){La8[0], La8[1]} * xj2;
      X17 -= (f32x2){La8[2], La8[3]} * xj2;
      X18 -= (f32x2){La9[0], La9[1]} * xj2;
      X19 -= (f32x2){La9[2], La9[3]} * xj2;
      X20 -= (f32x2){La10[0], La10[1]} * xj2;
      X21 -= (f32x2){La10[2], La10[3]} * xj2;
      X22 -= (f32x2){La11[0], La11[1]} * xj2;
      X23 -= (f32x2){La11[2], La11[3]} * xj2;
      X24 -= (f32x2){La12[0], La12[1]} * xj2;
      X25 -= (f32x2){La12[2], La12[3]} * xj2;
      X26 -= (f32x2){La13[0], La13[1]} * xj2;
      X27 -= (f32x2){La13[2], La13[3]} * xj2;
      X28 -= (f32x2){La14[0], La14[1]} * xj2;
      X29 -= (f32x2){La14[2], La14[3]} * xj2;
      X30 -= (f32x2){La15[0], La15[1]} * xj2;
      X31 -= (f32x2){La15[2], La15[3]} * xj2;
    }
    __builtin_amdgcn_sched_barrier(0);
    La8 = *(const f32x4*)(Lt_s + 2344);
    La9 = *(const f32x4*)(Lt_s + 2348);
    La10 = *(const f32x4*)(Lt_s + 2352);
    La11 = *(const f32x4*)(Lt_s + 2356);
    La12 = *(const f32x4*)(Lt_s + 2360);
    La13 = *(const f32x4*)(Lt_s + 2364);
    La14 = *(const f32x4*)(Lt_s + 2368);
    La15 = *(const f32x4*)(Lt_s + 2372);
    __builtin_amdgcn_sched_barrier(0);
    { const float xj = X16[1]; const f32x2 xj2 = (f32x2){xj, xj};
      X17 -= (f32x2){Lb8[2], Lb8[3]} * xj2;
      X18 -= (f32x2){Lb9[0], Lb9[1]} * xj2;
      X19 -= (f32x2){Lb9[2], Lb9[3]} * xj2;
      X20 -= (f32x2){Lb10[0], Lb10[1]} * xj2;
      X21 -= (f32x2){Lb10[2], Lb10[3]} * xj2;
      X22 -= (f32x2){Lb11[0], Lb11[1]} * xj2;
      X23 -= (f32x2){Lb11[2], Lb11[3]} * xj2;
      X24 -= (f32x2){Lb12[0], Lb12[1]} * xj2;
      X25 -= (f32x2){Lb12[2], Lb12[3]} * xj2;
      X26 -= (f32x2){Lb13[0], Lb13[1]} * xj2;
      X27 -= (f32x2){Lb13[2], Lb13[3]} * xj2;
      X28 -= (f32x2){Lb14[0], Lb14[1]} * xj2;
      X29 -= (f32x2){Lb14[2], Lb14[3]} * xj2;
      X30 -= (f32x2){Lb15[0], Lb15[1]} * xj2;
      X31 -= (f32x2){Lb15[2], Lb15[3]} * xj2;
    }
    __builtin_amdgcn_sched_barrier(0);
    Lb9 = *(const f32x4*)(Lt_s + 2416);
    Lb10 = *(const f32x4*)(Lt_s + 2420);
    Lb11 = *(const f32x4*)(Lt_s + 2424);
    Lb12 = *(const f32x4*)(Lt_s + 2428);
    Lb13 = *(const f32x4*)(Lt_s + 2432);
    Lb14 = *(const f32x4*)(Lt_s + 2436);
    Lb15 = *(const f32x4*)(Lt_s + 2440);
    __builtin_amdgcn_sched_barrier(0);
    { const float xj = X17[0]; const f32x2 xj2 = (f32x2){xj, xj};
      X17 -= (f32x2){La8[2], La8[3]} * xj2;
      X18 -= (f32x2){La9[0], La9[1]} * xj2;
      X19 -= (f32x2){La9[2], La9[3]} * xj2;
      X20 -= (f32x2){La10[0], La10[1]} * xj2;
      X21 -= (f32x2){La10[2], La10[3]} * xj2;
      X22 -= (f32x2){La11[0], La11[1]} * xj2;
      X23 -= (f32x2){La11[2], La11[3]} * xj2;
      X24 -= (f32x2){La12[0], La12[1]} * xj2;
      X25 -= (f32x2){La12[2], La12[3]} * xj2;
      X26 -= (f32x2){La13[0], La13[1]} * xj2;
      X27 -= (f32x2){La13[2], La13[3]} * xj2;
      X28 -= (f32x2){La14[0], La14[1]} * xj2;
      X29 -= (f32x2){La14[2], La14[3]} * xj2;
      X30 -= (f32x2){La15[0], La15[1]} * xj2;
      X31 -= (f32x2){La15[2], La15[3]} * xj2;
    }
    __builtin_amdgcn_sched_barrier(0);
    La9 = *(const f32x4*)(Lt_s + 2484);
    La10 = *(const f32x4*)(Lt_s + 2488);
    La11 = *(const f32x4*)(Lt_s + 2492);
    La12 = *(const f32x4*)(Lt_s + 2496);
    La13 = *(const f32x4*)(Lt_s + 2500);
    La14 = *(const f32x4*)(Lt_s + 2504);
    La15 = *(const f32x4*)(Lt_s + 2508);
    __builtin_amdgcn_sched_barrier(0);
    { const float xj = X17[1]; const f32x2 xj2 = (f32x2){xj, xj};
      X18 -= (f32x2){Lb9[0], Lb9[1]} * xj2;
      X19 -= (f32x2){Lb9[2], Lb9[3]} * xj2;
      X20 -= (f32x2){Lb10[0], Lb10[1]} * xj2;
      X21 -= (f32x2){Lb10[2], Lb10[3]} * xj2;
      X22 -= (f32x2){Lb11[0], Lb11[1]} * xj2;
      X23 -= (f32x2){Lb11[2], Lb11[3]} * xj2;
      X24 -= (f32x2){Lb12[0], Lb12[1]} * xj2;
      X25 -= (f32x2){Lb12[2], Lb12[3]} * xj2;
      X26 -= (f32x2){Lb13[0], Lb13[1]} * xj2;
      X27 -= (f32x2){Lb13[2], Lb13[3]} * xj2;
      X28 -= (f32x2){Lb14[0], Lb14[1]} * xj2;
      X29 -= (f32x2){Lb14[2], Lb14[3]} * xj2;
      X30 -= (f32x2){Lb15[0], Lb15[1]} * xj2;
      X31 -= (f32x2){Lb15[2], Lb15[3]} * xj2;
    }
    __builtin_amdgcn_sched_barrier(0);
    Lb9 = *(const f32x4*)(Lt_s + 2552);
    Lb10 = *(const f32x4*)(Lt_s + 2556);
    Lb11 = *(const f32x4*)(Lt_s + 2560);
    Lb12 = *(const f32x4*)(Lt_s + 2564);
    Lb13 = *(const f32x4*)(Lt_s + 2568);
    Lb14 = *(const f32x4*)(Lt_s + 2572);
    Lb15 = *(const f32x4*)(Lt_s + 2576);
    __builtin_amdgcn_sched_barrier(0);
    { const float xj = X18[0]; const f32x2 xj2 = (f32x2){xj, xj};
      X18 -= (f32x2){La9[0], La9[1]} * xj2;
      X19 -= (f32x2){La9[2], La9[3]} * xj2;
      X20 -= (f32x2){La10[0], La10[1]} * xj2;
      X21 -= (f32x2){La10[2], La10[3]} * xj2;
      X22 -= (f32x2){La11[0], La11[1]} * xj2;
      X23 -= (f32x2){La11[2], La11[3]} * xj2;
      X24 -= (f32x2){La12[0], La12[1]} * xj2;
      X25 -= (f32x2){La12[2], La12[3]} * xj2;
      X26 -= (f32x2){La13[0], La13[1]} * xj2;
      X27 -= (f32x2){La13[2], La13[3]} * xj2;
      X28 -= (f32x2){La14[0], La14[1]} * xj2;
      X29 -= (f32x2){La14[2], La14[3]} * xj2;
      X30 -= (f32x2){La15[0], La15[1]} * xj2;
      X31 -= (f32x2){La15[2], La15[3]} * xj2;
    }
    __builtin_amdgcn_sched_barrier(0);
    La9 = *(const f32x4*)(Lt_s + 2620);
    La10 = *(const f32x4*)(Lt_s + 2624);
    La11 = *(const f32x4*)(Lt_s + 2628);
    La12 = *(const f32x4*)(Lt_s + 2632);
    La13 = *(const f32x4*)(Lt_s + 2636);
    La14 = *(const f32x4*)(Lt_s + 2640);
    La15 = *(const f32x4*)(Lt_s + 2644);
    __builtin_amdgcn_sched_barrier(0);
    { const float xj = X18[1]; const f32x2 xj2 = (f32x2){xj, xj};
      X19 -= (f32x2){Lb9[2], Lb9[3]} * xj2;
      X20 -= (f32x2){Lb10[0], Lb10[1]} * xj2;
      X21 -= (f32x2){Lb10[2], Lb10[3]} * xj2;
      X22 -= (f32x2){Lb11[0], Lb11[1]} * xj2;
      X23 -= (f32x2){Lb11[2], Lb11[3]} * xj2;
      X24 -= (f32x2){Lb12[0], Lb12[1]} * xj2;
      X25 -= (f32x2){Lb12[2], Lb12[3]} * xj2;
      X26 -= (f32x2){Lb13[0], Lb13[1]} * xj2;
      X27 -= (f32x2){Lb13[2], Lb13[3]} * xj2;
      X28 -= (f32x2){Lb14[0], Lb14[1]} * xj2;
      X29 -= (f32x2){Lb14[2], Lb14[3]} * xj2;
      X30 -= (f32x2){Lb15[0], Lb15[1]} * xj2;
      X31 -= (f32x2){Lb15[2], Lb15[3]} * xj2;
    }
    __builtin_amdgcn_sched_barrier(0);
    Lb10 = *(const f32x4*)(Lt_s + 2692);
    Lb11 = *(const f32x4*)(Lt_s + 2696);
    Lb12 = *(const f32x4*)(Lt_s + 2700);
    Lb13 = *(const f32x4*)(Lt_s + 2704);
    Lb14 = *(const f32x4*)(Lt_s + 2708);
    Lb15 = *(const f32x4*)(Lt_s + 2712);
    __builtin_amdgcn_sched_barrier(0);
    { const float xj = X19[0]; const f32x2 xj2 = (f32x2){xj, xj};
      X19 -= (f32x2){La9[2], La9[3]} * xj2;
      X20 -= (f32x2){La10[0], La10[1]} * xj2;
      X21 -= (f32x2){La10[2], La10[3]} * xj2;
      X22 -= (f32x2){La11[0], La11[1]} * xj2;
      X23 -= (f32x2){La11[2], La11[3]} * xj2;
      X24 -= (f32x2){La12[0], La12[1]} * xj2;
      X25 -= (f32x2){La12[2], La12[3]} * xj2;
      X26 -= (f32x2){La13[0], La13[1]} * xj2;
      X27 -= (f32x2){La13[2], La13[3]} * xj2;
      X28 -= (f32x2){La14[0], La14[1]} * xj2;
      X29 -= (f32x2){La14[2], La14[3]} * xj2;
      X30 -= (f32x2){La15[0], La15[1]} * xj2;
      X31 -= (f32x2){La15[2], La15[3]} * xj2;
    }
    __builtin_amdgcn_sched_barrier(0);
    La10 = *(const f32x4*)(Lt_s + 2760);
    La11 = *(const f32x4*)(Lt_s + 2764);
    La12 = *(const f32x4*)(Lt_s + 2768);
    La13 = *(const f32x4*)(Lt_s + 2772);
    La14 = *(const f32x4*)(Lt_s + 2776);
    La15 = *(const f32x4*)(Lt_s + 2780);
    __builtin_amdgcn_sched_barrier(0);
    { const float xj = X19[1]; const f32x2 xj2 = (f32x2){xj, xj};
      X20 -= (f32x2){Lb10[0], Lb10[1]} * xj2;
      X21 -= (f32x2){Lb10[2], Lb10[3]} * xj2;
      X22 -= (f32x2){Lb11[0], Lb11[1]} * xj2;
      X23 -= (f32x2){Lb11[2], Lb11[3]} * xj2;
      X24 -= (f32x2){Lb12[0], Lb12[1]} * xj2;
      X25 -= (f32x2){Lb12[2], Lb12[3]} * xj2;
      X26 -= (f32x2){Lb13[0], Lb13[1]} * xj2;
      X27 -= (f32x2){Lb13[2], Lb13[3]} * xj2;
      X28 -= (f32x2){Lb14[0], Lb14[1]} * xj2;
      X29 -= (f32x2){Lb14[2], Lb14[3]} * xj2;
      X30 -= (f32x2){Lb15[0], Lb15[1]} * xj2;
      X31 -= (f32x2){Lb15[2], Lb15[3]} * xj2;
    }
    __builtin_amdgcn_sched_barrier(0);
    Lb10 = *(const f32x4*)(Lt_s + 2828);
    Lb11 = *(const f32x4*)(Lt_s + 2832);
    Lb12 = *(const f32x4*)(Lt_s + 2836);
    Lb13 = *(const f32x4*)(Lt_s + 2840);
    Lb14 = *(const f32x4*)(Lt_s + 2844);
    Lb15 = *(const f32x4*)(Lt_s + 2848);
    __builtin_amdgcn_sched_barrier(0);
    { const float xj = X20[0]; const f32x2 xj2 = (f32x2){xj, xj};
      X20 -= (f32x2){La10[0], La10[1]} * xj2;
      X21 -= (f32x2){La10[2], La10[3]} * xj2;
      X22 -= (f32x2){La11[0], La11[1]} * xj2;
      X23 -= (f32x2){La11[2], La11[3]} * xj2;
      X24 -= (f32x2){La12[0], La12[1]} * xj2;
      X25 -= (f32x2){La12[2], La12[3]} * xj2;
      X26 -= (f32x2){La13[0], La13[1]} * xj2;
      X27 -= (f32x2){La13[2], La13[3]} * xj2;
      X28 -= (f32x2){La14[0], La14[1]} * xj2;
      X29 -= (f32x2){La14[2], La14[3]} * xj2;
      X30 -= (f32x2){La15[0], La15[1]} * xj2;
      X31 -= (f32x2){La15[2], La15[3]} * xj2;
    }
    __builtin_amdgcn_sched_barrier(0);
    La10 = *(const f32x4*)(Lt_s + 2896);
    La11 = *(const f32x4*)(Lt_s + 2900);
    La12 = *(const f32x4*)(Lt_s + 2904);
    La13 = *(const f32x4*)(Lt_s + 2908);
    La14 = *(const f32x4*)(Lt_s + 2912);
    La15 = *(const f32x4*)(Lt_s + 2916);
    __builtin_amdgcn_sched_barrier(0);
    { const float xj = X20[1]; const f32x2 xj2 = (f32x2){xj, xj};
      X21 -= (f32x2){Lb10[2], Lb10[3]} * xj2;
      X22 -= (f32x2){Lb11[0], Lb11[1]} * xj2;
      X23 -= (f32x2){Lb11[2], Lb11[3]} * xj2;
      X24 -= (f32x2){Lb12[0], Lb12[1]} * xj2;
      X25 -= (f32x2){Lb12[2], Lb12[3]} * xj2;
      X26 -= (f32x2){Lb13[0], Lb13[1]} * xj2;
      X27 -= (f32x2){Lb13[2], Lb13[3]} * xj2;
      X28 -= (f32x2){Lb14[0], Lb14[1]} * xj2;
      X29 -= (f32x2){Lb14[2], Lb14[3]} * xj2;
      X30 -= (f32x2){Lb15[0], Lb15[1]} * xj2;
      X31 -= (f32x2){Lb15[2], Lb15[3]} * xj2;
    }
    __builtin_amdgcn_sched_barrier(0);
    Lb11 = *(const f32x4*)(Lt_s + 2968);
    Lb12 = *(const f32x4*)(Lt_s + 2972);
    Lb13 = *(const f32x4*)(Lt_s + 2976);
    Lb14 = *(const f32x4*)(Lt_s + 2980);
    Lb15 = *(const f32x4*)(Lt_s + 2984);
    __builtin_amdgcn_sched_barrier(0);
    { const float xj = X21[0]; const f32x2 xj2 = (f32x2){xj, xj};
      X21 -= (f32x2){La10[2], La10[3]} * xj2;
      X22 -= (f32x2){La11[0], La11[1]} * xj2;
      X23 -= (f32x2){La11[2], La11[3]} * xj2;
      X24 -= (f32x2){La12[0], La12[1]} * xj2;
      X25 -= (f32x2){La12[2], La12[3]} * xj2;
      X26 -= (f32x2){La13[0], La13[1]} * xj2;
      X27 -= (f32x2){La13[2], La13[3]} * xj2;
      X28 -= (f32x2){La14[0], La14[1]} * xj2;
      X29 -= (f32x2){La14[2], La14[3]} * xj2;
      X30 -= (f32x2){La15[0], La15[1]} * xj2;
      X31 -= (f32x2){La15[2], La15[3]} * xj2;
    }
    __builtin_amdgcn_sched_barrier(0);
    La11 = *(const f32x4*)(Lt_s + 3036);
    La12 = *(const f32x4*)(Lt_s + 3040);
    La13 = *(const f32x4*)(Lt_s + 3044);
    La14 = *(const f32x4*)(Lt_s + 3048);
    La15 = *(const f32x4*)(Lt_s + 3052);
    __builtin_amdgcn_sched_barrier(0);
    { const float xj = X21[1]; const f32x2 xj2 = (f32x2){xj, xj};
      X22 -= (f32x2){Lb11[0], Lb11[1]} * xj2;
      X23 -= (f32x2){Lb11[2], Lb11[3]} * xj2;
      X24 -= (f32x2){Lb12[0], Lb12[1]} * xj2;
      X25 -= (f32x2){Lb12[2], Lb12[3]} * xj2;
      X26 -= (f32x2){Lb13[0], Lb13[1]} * xj2;
      X27 -= (f32x2){Lb13[2], Lb13[3]} * xj2;
      X28 -= (f32x2){Lb14[0], Lb14[1]} * xj2;
      X29 -= (f32x2){Lb14[2], Lb14[3]} * xj2;
      X30 -= (f32x2){Lb15[0], Lb15[1]} * xj2;
      X31 -= (f32x2){Lb15[2], Lb15[3]} * xj2;
    }
    __builtin_amdgcn_sched_barrier(0);
    Lb11 = *(const f32x4*)(Lt_s + 3104);
    Lb12 = *(const f32x4*)(Lt_s + 3108);
    Lb13 = *(const f32x4*)(Lt_s + 3112);
    Lb14 = *(const f32x4*)(Lt_s + 3116);
    Lb15 = *(const f32x4*)(Lt_s + 3120);
    __builtin_amdgcn_sched_barrier(0);
    { const float xj = X22[0]; const f32x2 xj2 = (f32x2){xj, xj};
      X22 -= (f32x2){La11[0], La11[1]} * xj2;
      X23 -= (f32x2){La11[2], La11[3]} * xj2;
      X24 -= (f32x2){La12[0], La12[1]} * xj2;
      X25 -= (f32x2){La12[2], La12[3]} * xj2;
      X26 -= (f32x2){La13[0], La13[1]} * xj2;
      X27 -= (f32x2){La13[2], La13[3]} * xj2;
      X28 -= (f32x2){La14[0], La14[1]} * xj2;
      X29 -= (f32x2){La14[2], La14[3]} * xj2;
      X30 -= (f32x2){La15[0], La15[1]} * xj2;
      X31 -= (f32x2){La15[2], La15[3]} * xj2;
    }
    __builtin_amdgcn_sched_barrier(0);
    La11 = *(const f32x4*)(Lt_s + 3172);
    La12 = *(const f32x4*)(Lt_s + 3176);
    La13 = *(const f32x4*)(Lt_s + 3180);
    La14 = *(const f32x4*)(Lt_s + 3184);
    La15 = *(const f32x4*)(Lt_s + 3188);
    __builtin_amdgcn_sched_barrier(0);
    { const float xj = X22[1]; const f32x2 xj2 = (f32x2){xj, xj};
      X23 -= (f32x2){Lb11[2], Lb11[3]} * xj2;
      X24 -= (f32x2){Lb12[0], Lb12[1]} * xj2;
      X25 -= (f32x2){Lb12[2], Lb12[3]} * xj2;
      X26 -= (f32x2){Lb13[0], Lb13[1]} * xj2;
      X27 -= (f32x2){Lb13[2], Lb13[3]} * xj2;
      X28 -= (f32x2){Lb14[0], Lb14[1]} * xj2;
      X29 -= (f32x2){Lb14[2], Lb14[3]} * xj2;
      X30 -= (f32x2){Lb15[0], Lb15[1]} * xj2;
      X31 -= (f32x2){Lb15[2], Lb15[3]} * xj2;
    }
    __builtin_amdgcn_sched_barrier(0);
    Lb12 = *(const f32x4*)(Lt_s + 3244);
    Lb13 = *(const f32x4*)(Lt_s + 3248);
    Lb14 = *(const f32x4*)(Lt_s + 3252);
    Lb15 = *(const f32x4*)(Lt_s + 3256);
    __builtin_amdgcn_sched_barrier(0);
    { const float xj = X23[0]; const f32x2 xj2 = (f32x2){xj, xj};
      X23 -= (f32x2){La11[2], La11[3]} * xj2;
      X24 -= (f32x2){La12[0], La12[1]} * xj2;
      X25 -= (f32x2){La12[2], La12[3]} * xj2;
      X26 -= (f32x2){La13[0], La13[1]} * xj2;
      X27 -= (f32x2){La13[2], La13[3]} * xj2;
      X28 -= (f32x2){La14[0], La14[1]} * xj2;
      X29 -= (f32x2){La14[2], La14[3]} * xj2;
      X30 -= (f32x2){La15[0], La15[1]} * xj2;
      X31 -= (f32x2){La15[2], La15[3]} * xj2;
    }
    __builtin_amdgcn_sched_barrier(0);
    La12 = *(const f32x4*)(Lt_s + 3312);
    La13 = *(const f32x4*)(Lt_s + 3316);
    La14 = *(const f32x4*)(Lt_s + 3320);
    La15 = *(const f32x4*)(Lt_s + 3324);
    __builtin_amdgcn_sched_barrier(0);
    { const float xj = X23[1]; const f32x2 xj2 = (f32x2){xj, xj};
      X24 -= (f32x2){Lb12[0], Lb12[1]} * xj2;
      X25 -= (f32x2){Lb12[2], Lb12[3]} * xj2;
      X26 -= (f32x2){Lb13[0], Lb13[1]} * xj2;
      X27 -= (f32x2){Lb13[2], Lb13[3]} * xj2;
      X28 -= (f32x2){Lb14[0], Lb14[1]} * xj2;
      X29 -= (f32x2){Lb14[2], Lb14[3]} * xj2;
      X30 -= (f32x2){Lb15[0], Lb15[1]} * xj2;
      X31 -= (f32x2){Lb15[2], Lb15[3]} * xj2;
    }
    __builtin_amdgcn_sched_barrier(0);
    Lb12 = *(const f32x4*)(Lt_s + 3380);
    Lb13 = *(const f32x4*)(Lt_s + 3384);
    Lb14 = *(const f32x4*)(Lt_s + 3388);
    Lb15 = *(const f32x4*)(Lt_s + 3392);
    __builtin_amdgcn_sched_barrier(0);
    { const float xj = X24[0]; const f32x2 xj2 = (f32x2){xj, xj};
      X24 -= (f32x2){La12[0], La12[1]} * xj2;
      X25 -= (f32x2){La12[2], La12[3]} * xj2;
      X26 -= (f32x2){La13[0], La13[1]} * xj2;
      X27 -= (f32x2){La13[2], La13[3]} * xj2;
      X28 -= (f32x2){La14[0], La14[1]} * xj2;
      X29 -= (f32x2){La14[2], La14[3]} * xj2;
      X30 -= (f32x2){La15[0], La15[1]} * xj2;
      X31 -= (f32x2){La15[2], La15[3]} * xj2;
    }
    __builtin_amdgcn_sched_barrier(0);
    La12 = *(const f32x4*)(Lt_s + 3448);
    La13 = *(const f32x4*)(Lt_s + 3452);
    La14 = *(const f32x4*)(Lt_s + 3456);
    La15 = *(const f32x4*)(Lt_s + 3460);
    __builtin_amdgcn_sched_barrier(0);
    { const float xj = X24[1]; const f32x2 xj2 = (f32x2){xj, xj};
      X25 -= (f32x2){Lb12[2], Lb12[3]} * xj2;
      X26 -= (f32x2){Lb13[0], Lb13[1]} * xj2;
      X27 -= (f32x2){Lb13[2], Lb13[3]} * xj2;
      X28 -= (f32x2){Lb14[0], Lb14[1]} * xj2;
      X29 -= (f32x2){Lb14[2], Lb14[3]} * xj2;
      X30 -= (f32x2){Lb15[0], Lb15[1]} * xj2;
      X31 -= (f32x2){Lb15[2], Lb15[3]} * xj2;
    }
    __builtin_amdgcn_sched_barrier(0);
    Lb13 = *(const f32x4*)(Lt_s + 3520);
    Lb14 = *(const f32x4*)(Lt_s + 3524);
    Lb15 = *(const f32x4*)(Lt_s + 3528);
    __builtin_amdgcn_sched_barrier(0);
    { const float xj = X25[0]; const f32x2 xj2 = (f32x2){xj, xj};
      X25 -= (f32x2){La12[2], La12[3]} * xj2;
      X26 -= (f32x2){La13[0], La13[1]} * xj2;
      X27 -= (f32x2){La13[2], La13[3]} * xj2;
      X28 -= (f32x2){La14[0], La14[1]} * xj2;
      X29 -= (f32x2){La14[2], La14[3]} * xj2;
      X30 -= (f32x2){La15[0], La15[1]} * xj2;
      X31 -= (f32x2){La15[2], La15[3]} * xj2;
    }
    __builtin_amdgcn_sched_barrier(0);
    La13 = *(const f32x4*)(Lt_s + 3588);
    La14 = *(const f32x4*)(Lt_s + 3592);
    La15 = *(const f32x4*)(Lt_s + 3596);
    __builtin_amdgcn_sched_barrier(0);
    { const float xj = X25[1]; const f32x2 xj2 = (f32x2){xj, xj};
      X26 -= (f32x2){Lb13[0], Lb13[1]} * xj2;
      X27 -= (f32x2){Lb13[2], Lb13[3]} * xj2;
      X28 -= (f32x2){Lb14[0], Lb14[1]} * xj2;
      X29 -= (f32x2){Lb14[2], Lb14[3]} * xj2;
      X30 -= (f32x2){Lb15[0], Lb15[1]} * xj2;
      X31 -= (f32x2){Lb15[2], Lb15[3]} * xj2;
    }
    __builtin_amdgcn_sched_barrier(0);
    Lb13 = *(const f32x4*)(Lt_s + 3656);
    Lb14 = *(const f32x4*)(Lt_s + 3660);
    Lb15 = *(const f32x4*)(Lt_s + 3664);
    __builtin_amdgcn_sched_barrier(0);
    { const float xj = X26[0]; const f32x2 xj2 = (f32x2){xj, xj};
      X26 -= (f32x2){La13[0], La13[1]} * xj2;
      X27 -= (f32x2){La13[2], La13[3]} * xj2;
      X28 -= (f32x2){La14[0], La14[1]} * xj2;
      X29 -= (f32x2){La14[2], La14[3]} * xj2;
      X30 -= (f32x2){La15[0], La15[1]} * xj2;
      X31 -= (f32x2){La15[2], La15[3]} * xj2;
    }
    __builtin_amdgcn_sched_barrier(0);
    La13 = *(const f32x4*)(Lt_s + 3724);
    La14 = *(const f32x4*)(Lt_s + 3728);
    La15 = *(const f32x4*)(Lt_s + 3732);
    __builtin_amdgcn_sched_barrier(0);
    { const float xj = X26[1]; const f32x2 xj2 = (f32x2){xj, xj};
      X27 -= (f32x2){Lb13[2], Lb13[3]} * xj2;
      X28 -= (f32x2){Lb14[0], Lb14[1]} * xj2;
      X29 -= (f32x2){Lb14[2], Lb14[3]} * xj2;
      X30 -= (f32x2){Lb15[0], Lb15[1]} * xj2;
      X31 -= (f32x2){Lb15[2], Lb15[3]} * xj2;
    }
    __builtin_amdgcn_sched_barrier(0);
    Lb14 = *(const f32x4*)(Lt_s + 3796);
    Lb15 = *(const f32x4*)(Lt_s + 3800);
    __builtin_amdgcn_sched_barrier(0);
    { const float xj = X27[0]; const f32x2 xj2 = (f32x2){xj, xj};
      X27 -= (f32x2){La13[2], La13[3]} * xj2;
      X28 -= (f32x2){La14[0], La14[1]} * xj2;
      X29 -= (f32x2){La14[2], La14[3]} * xj2;
      X30 -= (f32x2){La15[0], La15[1]} * xj2;
      X31 -= (f32x2){La15[2], La15[3]} * xj2;
    }
    __builtin_amdgcn_sched_barrier(0);
    La14 = *(const f32x4*)(Lt_s + 3864);
    La15 = *(const f32x4*)(Lt_s + 3868);
    __builtin_amdgcn_sched_barrier(0);
    { const float xj = X27[1]; const f32x2 xj2 = (f32x2){xj, xj};
      X28 -= (f32x2){Lb14[0], Lb14[1]} * xj2;
      X29 -= (f32x2){Lb14[2], Lb14[3]} * xj2;
      X30 -= (f32x2){Lb15[0], Lb15[1]} * xj2;
      X31 -= (f32x2){Lb15[2], Lb15[3]} * xj2;
    }
    __builtin_amdgcn_sched_barrier(0);
    Lb14 = *(const f32x4*)(Lt_s + 3932);
    Lb15 = *(const f32x4*)(Lt_s + 3936);
    __builtin_amdgcn_sched_barrier(0);
    { const float xj = X28[0]; const f32x2 xj2 = (f32x2){xj, xj};
      X28 -= (f32x2){La14[0], La14[1]} * xj2;
      X29 -= (f32x2){La14[2], La14[3]} * xj2;
      X30 -= (f32x2){La15[0], La15[1]} * xj2;
      X31 -= (f32x2){La15[2], La15[3]} * xj2;
    }
    __builtin_amdgcn_sched_barrier(0);
    La14 = *(const f32x4*)(Lt_s + 4000);
    La15 = *(const f32x4*)(Lt_s + 4004);
    __builtin_amdgcn_sched_barrier(0);
    { const float xj = X28[1]; const f32x2 xj2 = (f32x2){xj, xj};
      X29 -= (f32x2){Lb14[2], Lb14[3]} * xj2;
      X30 -= (f32x2){Lb15[0], Lb15[1]} * xj2;
      X31 -= (f32x2){Lb15[2], Lb15[3]} * xj2;
    }
    __builtin_amdgcn_sched_barrier(0);
    Lb15 = *(const f32x4*)(Lt_s + 4072);
    __builtin_amdgcn_sched_barrier(0);
    { const float xj = X29[0]; const f32x2 xj2 = (f32x2){xj, xj};
      X29 -= (f32x2){La14[2], La14[3]} * xj2;
      X30 -= (f32x2){La15[0], La15[1]} * xj2;
      X31 -= (f32x2){La15[2], La15[3]} * xj2;
    }
    __builtin_amdgcn_sched_barrier(0);
    La15 = *(const f32x4*)(Lt_s + 4140);
    __builtin_amdgcn_sched_barrier(0);
    { const float xj = X29[1]; const f32x2 xj2 = (f32x2){xj, xj};
      X30 -= (f32x2){Lb15[0], Lb15[1]} * xj2;
      X31 -= (f32x2){Lb15[2], Lb15[3]} * xj2;
    }
    __builtin_amdgcn_sched_barrier(0);
    Lb15 = *(const f32x4*)(Lt_s + 4208);
    __builtin_amdgcn_sched_barrier(0);
    { const float xj = X30[0]; const f32x2 xj2 = (f32x2){xj, xj};
      X30 -= (f32x2){La15[0], La15[1]} * xj2;
      X31 -= (f32x2){La15[2], La15[3]} * xj2;
    }
    __builtin_amdgcn_sched_barrier(0);
    La15 = *(const f32x4*)(Lt_s + 4276);
    __builtin_amdgcn_sched_barrier(0);
    { const float xj = X30[1]; const f32x2 xj2 = (f32x2){xj, xj};
      X31 -= (f32x2){Lb15[2], Lb15[3]} * xj2;
    }
    __builtin_amdgcn_sched_barrier(0);
    __builtin_amdgcn_sched_barrier(0);
    { const float xj = X31[0]; const f32x2 xj2 = (f32x2){xj, xj};
      X31 -= (f32x2){La15[2], La15[3]} * xj2;
    }
    __builtin_amdgcn_sched_barrier(0);
    __syncthreads();
    outp[0] = f2bf(sg * X0[0]);
    outp[136] = f2bf(sg * X0[1]);
    outp[272] = f2bf(sg * X1[0]);
    outp[408] = f2bf(sg * X1[1]);
    outp[544] = f2bf(sg * X2[0]);
    outp[680] = f2bf(sg * X2[1]);
    outp[816] = f2bf(sg * X3[0]);
    outp[952] = f2bf(sg * X3[1]);
    outp[1088] = f2bf(sg * X4[0]);
    outp[1224] = f2bf(sg * X4[1]);
    outp[1360] = f2bf(sg * X5[0]);
    outp[1496] = f2bf(sg * X5[1]);
    outp[1632] = f2bf(sg * X6[0]);
    outp[1768] = f2bf(sg * X6[1]);
    outp[1904] = f2bf(sg * X7[0]);
    outp[2040] = f2bf(sg * X7[1]);
    outp[2176] = f2bf(sg * X8[0]);
    outp[2312] = f2bf(sg * X8[1]);
    outp[2448] = f2bf(sg * X9[0]);
    outp[2584] = f2bf(sg * X9[1]);
    outp[2720] = f2bf(sg * X10[0]);
    outp[2856] = f2bf(sg * X10[1]);
    outp[2992] = f2bf(sg * X11[0]);
    outp[3128] = f2bf(sg * X11[1]);
    outp[3264] = f2bf(sg * X12[0]);
    outp[3400] = f2bf(sg * X12[1]);
    outp[3536] = f2bf(sg * X13[0]);
    outp[3672] = f2bf(sg * X13[1]);
    outp[3808] = f2bf(sg * X14[0]);
    outp[3944] = f2bf(sg * X14[1]);
    outp[4080] = f2bf(sg * X15[0]);
    outp[4216] = f2bf(sg * X15[1]);
    outp[4352] = f2bf(sg * X16[0]);
    outp[4488] = f2bf(sg * X16[1]);
    outp[4624] = f2bf(sg * X17[0]);
    outp[4760] = f2bf(sg * X17[1]);
    outp[4896] = f2bf(sg * X18[0]);
    outp[5032] = f2bf(sg * X18[1]);
    outp[5168] = f2bf(sg * X19[0]);
    outp[5304] = f2bf(sg * X19[1]);
    outp[5440] = f2bf(sg * X20[0]);
    outp[5576] = f2bf(sg * X20[1]);
    outp[5712] = f2bf(sg * X21[0]);
    outp[5848] = f2bf(sg * X21[1]);
    outp[5984] = f2bf(sg * X22[0]);
    outp[6120] = f2bf(sg * X22[1]);
    outp[6256] = f2bf(sg * X23[0]);
    outp[6392] = f2bf(sg * X23[1]);
    outp[6528] = f2bf(sg * X24[0]);
    outp[6664] = f2bf(sg * X24[1]);
    outp[6800] = f2bf(sg * X25[0]);
    outp[6936] = f2bf(sg * X25[1]);
    outp[7072] = f2bf(sg * X26[0]);
    outp[7208] = f2bf(sg * X26[1]);
    outp[7344] = f2bf(sg * X27[0]);
    outp[7480] = f2bf(sg * X27[1]);
    outp[7616] = f2bf(sg * X28[0]);
    outp[7752] = f2bf(sg * X28[1]);
    outp[7888] = f2bf(sg * X29[0]);
    outp[8024] = f2bf(sg * X29[1]);
    outp[8160] = f2bf(sg * X30[0]);
    outp[8296] = f2bf(sg * X30[1]);
    outp[8432] = f2bf(sg * X31[0]);
    outp[8568] = f2bf(sg * X31[1]);
}

DEV void dn_item(const Params& p, int l, int item, unsigned char* smem) {
    const int dir = item & 1, hh = (item >> 1) & 3, b = item >> 3;
    bf16_t* q_s = (bf16_t*)(smem);
    bf16_t* k_s = (bf16_t*)(smem + 17408);
    bf16_t* vnT_s = k_s;
    bf16_t* kT_s = (bf16_t*)(smem + 35840);
    bf16_t* v_s = (bf16_t*)(smem + 54272);
    bf16_t* u_s = v_s;
    float* L_s = (float*)(smem + 71680);
    bf16_t* w_s = (bf16_t*)(smem + 71680);
    bf16_t* qk_s = (bf16_t*)(smem + 89088);
    bf16_t* St_s = (bf16_t*)(smem + 98304);
    float* G_s = (float*)(smem + 133120);
    float* beta_s = G_s + 64;
    float* eG_s = G_s + 128;
    float* bw_s = G_s + 192;
    float* cw_s = G_s + 256;
    const int tid = get_tid(), lane = tid & 63, wv = tid >> 6, l15 = lane & 15, quad = lane >> 4;
    const float Aneg = -expf(p.in[I_DNALOG][(l * 2 + dir) * 4 + hh]);
    const float dtb = p.in[I_DNDT][(l * 2 + dir) * 4 + hh];
    const bf16_t* P = wsb(p, O_P);
    const float* AB = wsf(p, O_AB);
    bf16_t* TO = wsb(p, dir ? O_TA2 : O_TA);
    __syncthreads();
    for (int e = tid; e < 4 * 384; e += 256) { int j = e / 384, c = e % 384, mat = c >> 7, cc = c & 127; cw_s[e] = p.in[I_DNCONV][((size_t)l * 4 + j) * 1536 + mat * 512 + hh * 128 + cc]; }
    for (int e = tid; e < 128 * 136 / 2; e += 256) ((unsigned*)St_s)[e] = 0u;
    f32x4 Sacc[2][8];
#pragma unroll
    for (int a = 0; a < 2; ++a)
#pragma unroll
        for (int c = 0; c < 8; ++c) Sacc[a][c] = (f32x4){0.f, 0.f, 0.f, 0.f};

    const int rg = tid >> 4, cseg = tid & 15, i0 = rg * 4;
    u32x4 raw[3][7];
    float pf_al = 0.f, pf_bb = 0.f;
#define DN_PREFETCH(NN, M0, M1) { \
        const int c_ = chunk_of(dir, (NN)); const int lo_ = c_ < 4 ? 0 : CTXL, hi_ = c_ < 4 ? CTXL : SB, base_ = c_ * 64; \
        const int slo_ = dir ? base_ + 60 - i0 : base_ + i0; \
        _Pragma("unroll") for (int u = 0; u < 7; ++u) { const int ss_ = slo_ - 1 + u; const bool ok_ = ss_ >= lo_ && ss_ < hi_; \
            const bf16_t* rp_ = P + ((size_t)b * SB + (ok_ ? ss_ : base_)) * PW + hh * 128 + cseg * 8; \
            _Pragma("unroll") for (int mat = (M0); mat < (M1); ++mat) { u32x4 t_ = *(const u32x4*)(rp_ + mat * 512); raw[mat][u] = ok_ ? t_ : (u32x4){0u, 0u, 0u, 0u}; } } \
        if ((M0) == 0) { const int sa_ = dir ? base_ + 63 - lane : base_ + lane; \
        pf_al = AB[((size_t)b * SB + sa_) * 16 + dir * 4 + hh]; pf_bb = AB[((size_t)b * SB + sa_) * 16 + 8 + dir * 4 + hh]; } }
    DN_PREFETCH(0, 0, 3);
    const int wv0_ = wv, l150_ = l15, quad0_ = quad, lane0_ = lane;

#pragma unroll 1
    for (int n = 0; n < 68; ++n) {
        int tz0 = 0; asm volatile("" : "+v"(tz0));
        const int wv = wv0_ + tz0, l15 = l150_ + tz0, quad = quad0_ + tz0, lane = lane0_ + tz0;
        const int c = chunk_of(dir, n);
        const int base = c * 64;
        __syncthreads();
        if (wv == 0) {
            float g = Aneg * softplus_fast(pf_al + dtb);
#pragma unroll
            for (int o = 1; o < 64; o <<= 1) { float t = __shfl_up(g, o); if (lane >= o) g += t; }
            const float eg_ = expf(g), bt_ = sigm(pf_bb); G_s[lane] = g; beta_s[lane] = bt_; eG_s[lane] = eg_; bw_s[lane] = bt_ * eg_;
        }
        __syncthreads();
        const float Glast = G_s[63];
        {
            int tz = 0; asm volatile("" : "+v"(tz));
            const int i0l = i0 + tz, csl = cseg + tz;
            float ksc[4];
#pragma unroll
            for (int m = 0; m < 4; ++m) ksc[m] = expf(Glast - G_s[i0l + m]);
#pragma unroll
            for (int mat = 0; mat < 3; ++mat) {
                float w[4][8];
#pragma unroll
                for (int j = 0; j < 4; ++j) { const f32x4 w0 = *(const f32x4*)(cw_s + j * 384 + mat * 128 + csl * 8), w1 = *(const f32x4*)(cw_s + j * 384 + mat * 128 + csl * 8 + 4);
#pragma unroll
                    for (int e = 0; e < 4; ++e) { w[j][e] = w0[e]; w[j][4 + e] = w1[e]; } }
                float v[4][8];
#pragma unroll
                for (int t = 0; t < 4; ++t)
#pragma unroll
                    for (int e = 0; e < 8; ++e) v[t][e] = 0.f;
#pragma unroll
                for (int u = 0; u < 7; ++u) {
                    float x[8];
#pragma unroll
                    for (int e = 0; e < 4; ++e) { x[2 * e] = lo16(raw[mat][u][e]); x[2 * e + 1] = hi16(raw[mat][u][e]); }
#pragma unroll
                    for (int t = 0; t < 4; ++t) { const int j = u - t; if (j >= 0 && j < 4) {
#pragma unroll
                        for (int e = 0; e < 8; ++e) v[t][e] += w[j][e] * x[e]; } }
                }
                float sc[4];
#pragma unroll
                for (int t = 0; t < 4; ++t) {
                    float ss2 = 0.f;
#pragma unroll
                    for (int e = 0; e < 8; ++e) { v[t][e] = silu(v[t][e]); ss2 += v[t][e] * v[t][e]; }
                    if (mat < 2) { ss2 += __shfl_xor(ss2, 1); ss2 += __shfl_xor(ss2, 2); ss2 += __shfl_xor(ss2, 4); ss2 += __shfl_xor(ss2, 8); }
                    sc[t] = mat == 0 ? rsqrtf(ss2 + 1e-6f) * 0.08838834764831845f : (mat == 1 ? rsqrtf(ss2 + 1e-6f) : 1.f);
                }
                bf16_t* dst = mat == 0 ? q_s : (mat == 1 ? k_s : v_s);
#pragma unroll
                for (int t = 0; t < 4; ++t) {
                    const int it_ = dir ? i0l + 3 - t : i0l + t;
                    u32x4 o;
#pragma unroll
                    for (int e = 0; e < 4; ++e) o[e] = pack2(v[t][2 * e] * sc[t], v[t][2 * e + 1] * sc[t]);
                    *(u32x4*)(dst + it_ * 136 + csl * 8) = o;
                }
                if (mat == 1) {
#pragma unroll
                    for (int e = 0; e < 8; ++e) {
                        const float k0 = v[dir ? 3 : 0][e] * sc[dir ? 3 : 0] * ksc[0], k1 = v[dir ? 2 : 1][e] * sc[dir ? 2 : 1] * ksc[1];
                        const float k2 = v[dir ? 1 : 2][e] * sc[dir ? 1 : 2] * ksc[2], k3 = v[dir ? 0 : 3][e] * sc[dir ? 0 : 3] * ksc[3];
                        u32x2 o; o.x = pack2(k0, k1); o.y = pack2(k2, k3);
                        *(u32x2*)(kT_s + (csl * 8 + e) * 72 + i0l) = o;
                    }
                }
            }
        }
        __syncthreads();
        {
            bf16x8 ak[4], aq[4];
#pragma unroll
            for (int ks = 0; ks < 4; ++ks) { ak[ks] = *(const bf16x8*)(k_s + (wv * 16 + l15) * 136 + ks * 32 + quad * 8); aq[ks] = *(const bf16x8*)(q_s + (wv * 16 + l15) * 136 + ks * 32 + quad * 8); }
#pragma unroll
            for (int nt = 0; nt < 4; ++nt) {
                f32x4 kk = {0.f, 0.f, 0.f, 0.f}, qq = {0.f, 0.f, 0.f, 0.f};
#pragma unroll
                for (int ks = 0; ks < 4; ++ks) { bf16x8 bk = *(const bf16x8*)(k_s + (nt * 16 + l15) * 136 + ks * 32 + quad * 8); kk = mfma16(ak[ks], bk, kk); qq = mfma16(aq[ks], bk, qq); }
                const int jj = nt * 16 + l15; const float Gj = G_s[jj];
                f32x4 lv;
#pragma unroll
                for (int j = 0; j < 4; ++j) {
                    const int i = wv * 16 + quad * 4 + j;
                    const float dec = jj <= i ? expf(G_s[i] - Gj) : 0.f;
                    lv[j] = jj < i ? beta_s[i] * kk[j] * dec : 0.f;
                    qk_s[i * 72 + jj] = f2bf(qq[j] * dec);
                }
                *(f32x4*)(L_s + jj * 68 + wv * 16 + quad * 4) = lv;
            }
        }
        __syncthreads();
        dn_solve(L_s, tid < 128 ? (k_s + tid) : (v_s + (tid - 128)), tid < 128 ? bw_s : beta_s, tid < 128 ? -1.f : 1.f, tid < 128 ? (w_s + tid) : (u_s + (tid - 128)));
        __syncthreads();
        {
            f32x4 vn[8], o1[8];
#pragma unroll
            for (int nt = 0; nt < 8; ++nt) {
#pragma unroll
                for (int j = 0; j < 4; ++j) vn[nt][j] = bf2f(u_s[(wv * 16 + quad * 4 + j) * 136 + nt * 16 + l15]);
                o1[nt] = (f32x4){0.f, 0.f, 0.f, 0.f};
            }
            bf16x8 aw[4], aq[4];
#pragma unroll
            for (int ks = 0; ks < 4; ++ks) { aw[ks] = *(const bf16x8*)(w_s + (wv * 16 + l15) * 136 + ks * 32 + quad * 8); aq[ks] = *(const bf16x8*)(q_s + (wv * 16 + l15) * 136 + ks * 32 + quad * 8); }
#pragma unroll
            for (int nt = 0; nt < 8; ++nt)
#pragma unroll
                for (int ks = 0; ks < 4; ++ks) { bf16x8 bs = *(const bf16x8*)(St_s + (nt * 16 + l15) * 136 + ks * 32 + quad * 8); vn[nt] = mfma16(aw[ks], bs, vn[nt]); o1[nt] = mfma16(aq[ks], bs, o1[nt]); }
#pragma unroll
            for (int nt = 0; nt < 8; ++nt) { u32x2 o; o.x = pack2(vn[nt][0], vn[nt][1]); o.y = pack2(vn[nt][2], vn[nt][3]); *(u32x2*)(vnT_s + (nt * 16 + l15) * 72 + wv * 16 + quad * 4) = o; }
            __syncthreads();
            if (n + 1 < 68) DN_PREFETCH(n + 1, 0, 2);
            float eg[4];
#pragma unroll
            for (int j = 0; j < 4; ++j) eg[j] = eG_s[wv * 16 + quad * 4 + j];
            bf16x8 aqk[2], akt[2][2];
#pragma unroll
            for (int ks = 0; ks < 2; ++ks) {
                aqk[ks] = *(const bf16x8*)(qk_s + (wv * 16 + l15) * 72 + ks * 32 + quad * 8);
                akt[0][ks] = *(const bf16x8*)(kT_s + (wv * 32 + l15) * 72 + ks * 32 + quad * 8);
                akt[1][ks] = *(const bf16x8*)(kT_s + (wv * 32 + 16 + l15) * 72 + ks * 32 + quad * 8);
            }
            const float gend = eG_s[63];
            const size_t orow0 = (size_t)b * SB;
#pragma unroll
            for (int nt = 0; nt < 8; ++nt) {
                f32x4 o;
#pragma unroll
                for (int j = 0; j < 4; ++j) { o[j] = o1[nt][j] * eg[j]; Sacc[0][nt][j] *= gend; Sacc[1][nt][j] *= gend; }
#pragma unroll
                for (int ks = 0; ks < 2; ++ks) {
                    bf16x8 bv = *(const bf16x8*)(vnT_s + (nt * 16 + l15) * 72 + ks * 32 + quad * 8);
                    o = mfma16(aqk[ks], bv, o);
                    Sacc[0][nt] = mfma16(akt[0][ks], bv, Sacc[0][nt]);
                    Sacc[1][nt] = mfma16(akt[1][ks], bv, Sacc[1][nt]);
                }
#pragma unroll
                for (int j = 0; j < 4; ++j) {
                    const int i = wv * 16 + quad * 4 + j;
                    const int s = dir ? base + 63 - i : base + i;
                    TO[(orow0 + s) * 512 + hh * 128 + nt * 16 + l15] = f2bf(o[j]);
                }
#pragma unroll
                for (int mt = 0; mt < 2; ++mt) { u32x2 sv; sv.x = pack2(Sacc[mt][nt][0], Sacc[mt][nt][1]); sv.y = pack2(Sacc[mt][nt][2], Sacc[mt][nt][3]);
                    *(u32x2*)(St_s + (nt * 16 + l15) * 136 + wv * 32 + mt * 16 + quad * 4) = sv; }
            }
        }
        if (n + 1 < 68) DN_PREFETCH(n + 1, 2, 3);
    }
}

#undef DN_PREFETCH
DEV void lru_item(const Params& p, int l, int item, unsigned char* smem) {
    const int g = item & 7, b = item >> 3;
    bf16_t* Wt_s = (bf16_t*)smem;
    bf16_t* xbh_s = Wt_s + 2 * 128 * 72;
    float* xbf_s = (float*)(smem + 36864 + 18432);
    float* a_s = xbf_s + 2 * 64 * 65;
    float* cw_s = a_s + 2 * 64 * 65;
    const int tid = get_tid(), lane = tid & 63, wv = tid >> 6, l15 = lane & 15, quad = lane >> 4;
    bf16_t* P = wsb(p, O_P);
    bf16_t* HF = wsb(p, O_U);
    __syncthreads();
    for (int e = tid; e < 320; e += 256) cw_s[e] = e < 256 ? p.in[I_LCW][((size_t)l * 4 + (e >> 6)) * 512 + g * 64 + (e & 63)] : p.in[I_LCB][l * 512 + g * 64 + (e - 256)];
    for (int e = tid; e < 2 * 4096; e += 256) {
        const int d = e >> 12, ch = (e >> 6) & 63, j = e & 63;
        const size_t wi_ = (((size_t)l * 2 + d) * 8 + g) * 4096 + ch * 64 + j;
        Wt_s[(d * 128 + j) * 72 + ch] = f2bf(p.in[I_LWA][wi_]);
        Wt_s[(d * 128 + 64 + j) * 72 + ch] = f2bf(p.in[I_LWI][wi_]);
    }
    float ba_[2][4], bi_[2][4], sp_[2][4];
#pragma unroll
    for (int d = 0; d < 2; ++d)
#pragma unroll
        for (int nt = 0; nt < 4; ++nt) {
            const int ch = (l * 2 + d) * 512 + g * 64 + nt * 16 + l15;
            ba_[d][nt] = p.in[I_LBA][ch]; bi_[d][nt] = p.in[I_LBI][ch]; sp_[d][nt] = softplus(-p.in[I_LLAM][ch]);
        }
    float hc = 0.f;
    const int i = tid >> 2, seg = tid & 3, j0 = seg * 16;
#pragma unroll 1
    for (int n = 0; n < 68; ++n) {
        const int cf = n, cb = chunk_of(1, n);
        __syncthreads();
#pragma unroll
        for (int d = 0; d < 2; ++d) {
            const int c = d ? cb : cf;
            const int seg_lo = c < 4 ? 0 : CTXL, seg_hi = c < 4 ? CTXL : SB;
            const int s = d ? c * 64 + 63 - i : c * 64 + i;
            float v[16];
#pragma unroll
            for (int e = 0; e < 16; ++e) v[e] = cw_s[256 + j0 + e];
#pragma unroll
            for (int j = 0; j < 4; ++j) {
                const int ss = s + j - 1;
                if (ss >= seg_lo && ss < seg_hi) {
                    const u32x4* src = (const u32x4*)(P + ((size_t)b * SB + ss) * PW + C_LX + g * 64 + j0);
                    const float* cw = cw_s + j * 64 + j0;
#pragma unroll
                    for (int q = 0; q < 2; ++q) { u32x4 x = src[q];
#pragma unroll
                        for (int e = 0; e < 4; ++e) { v[q * 8 + 2 * e] += cw[q * 8 + 2 * e] * lo16(x[e]); v[q * 8 + 2 * e + 1] += cw[q * 8 + 2 * e + 1] * hi16(x[e]); } }
                }
            }
            u32x4 h0, h1;
#pragma unroll
            for (int e = 0; e < 4; ++e) { h0[e] = pack2(v[2 * e], v[2 * e + 1]); h1[e] = pack2(v[8 + 2 * e], v[8 + 2 * e + 1]); }
            *(u32x4*)(xbh_s + (d * 64 + i) * 72 + j0) = h0; *(u32x4*)(xbh_s + (d * 64 + i) * 72 + j0 + 8) = h1;
#pragma unroll
            for (int e = 0; e < 16; ++e) xbf_s[(d * 64 + i) * 65 + j0 + e] = v[e];
        }
        __syncthreads();
#pragma unroll
        for (int d = 0; d < 2; ++d) {
            f32x4 acc[8];
#pragma unroll
            for (int nt = 0; nt < 8; ++nt) acc[nt] = (f32x4){0.f, 0.f, 0.f, 0.f};
            bf16x8 af[2];
#pragma unroll
            for (int ks = 0; ks < 2; ++ks) af[ks] = *(const bf16x8*)(xbh_s + (d * 64 + wv * 16 + l15) * 72 + ks * 32 + quad * 8);
#pragma unroll
            for (int nt = 0; nt < 8; ++nt)
#pragma unroll
                for (int ks = 0; ks < 2; ++ks) { bf16x8 bw = *(const bf16x8*)(Wt_s + (d * 128 + nt * 16 + l15) * 72 + ks * 32 + quad * 8); acc[nt] = mfma16(af[ks], bw, acc[nt]); }
#pragma unroll
            for (int nt = 0; nt < 4; ++nt)
#pragma unroll
                for (int jj = 0; jj < 4; ++jj) {
                    const int idx = (d * 64 + wv * 16 + quad * 4 + jj) * 65 + nt * 16 + l15;
                    const float r = sigm(acc[nt][jj] + ba_[d][nt]), ig = sigm(acc[nt + 4][jj] + bi_[d][nt]);
                    const float la = -8.f * r * sp_[d][nt];
                    a_s[idx] = expf(la);
                    xbf_s[idx] = sqrtf(fmaxf(1.f - expf(2.f * la), 0.f)) * (ig * xbf_s[idx]);
                }
        }
        __syncthreads();
        if (wv < 2) {
            const int o = wv * 64 * 65 + lane;
#pragma unroll 16
            for (int r = 0; r < 64; ++r) { hc = a_s[o + r * 65] * hc + xbf_s[o + r * 65]; xbf_s[o + r * 65] = hc; }
        }
        __syncthreads();
#pragma unroll
        for (int d = 0; d < 2; ++d) {
            const int c = d ? cb : cf;
            const int s = d ? c * 64 + 63 - i : c * 64 + i;
            const bool second = d ? (cb < n) : ((cf < 4 ? 3 - cf : 71 - cf) < n);
            const size_t row = (size_t)b * SB + s;
            const float* hp = xbf_s + (d * 64 + i) * 65 + j0;
            bf16_t* hf = HF + row * 512 + g * 64 + j0;
            if (!second) {
                u32x4 o0, o1;
#pragma unroll
                for (int e = 0; e < 4; ++e) { o0[e] = pack2(hp[2 * e], hp[2 * e + 1]); o1[e] = pack2(hp[8 + 2 * e], hp[8 + 2 * e + 1]); }
                *(u32x4*)hf = o0; *(u32x4*)(hf + 8) = o1;
            } else {
                bf16_t* gp = P + row * PW + C_LG + g * 64 + j0;
                u32x4 f0 = *(const u32x4*)hf, f1 = *(const u32x4*)(hf + 8), g0 = *(const u32x4*)gp, g1 = *(const u32x4*)(gp + 8), o0, o1;
#pragma unroll
                for (int e = 0; e < 4; ++e) {
                    o0[e] = pack2((lo16(f0[e]) + hp[2 * e]) * gelu_tanh(lo16(g0[e])), (hi16(f0[e]) + hp[2 * e + 1]) * gelu_tanh(hi16(g0[e])));
                    o1[e] = pack2((lo16(f1[e]) + hp[8 + 2 * e]) * gelu_tanh(lo16(g1[e])), (hi16(f1[e]) + hp[8 + 2 * e + 1]) * gelu_tanh(hi16(g1[e])));
                }
                *(u32x4*)gp = o0; *(u32x4*)(gp + 8) = o1;
            }
        }
    }
}

DEV void att_item(const Params& p, int l, int b, int h, int qt, float lam_init, unsigned char* smem) {
    bf16_t* K_s = (bf16_t*)smem;
    bf16_t* V_s = (bf16_t*)(smem + 2 * 17408);
    const int tid = get_tid(), lane = tid & 63, wv = tid >> 6, l15 = lane & 15, quad = lane >> 4;
    bf16_t* P = wsb(p, O_P);
    const bf16_t* VT = wsb(p, O_VT) + (size_t)(b * 4 + h) * 128 * SB;
    const int nt_keys = (qt < 2 ? CTXL : SB) / 64;
    float lam;
    {
        const float* lv = p.in[I_DALAM] + l * 256;
        float s1 = lv[lane] * lv[64 + lane], s2 = lv[128 + lane] * lv[192 + lane];
#pragma unroll
        for (int o = 32; o >= 1; o >>= 1) { s1 += __shfl_xor(s1, o); s2 += __shfl_xor(s2, o); }
        lam = expf(s1) - expf(s2) + lam_init;
    }
    bf16x8* Qst = (bf16x8*)(smem + 71680) + (wv * 8) * 64 + lane;
#pragma unroll
    for (int qg = 0; qg < 2; ++qg) {
        const bf16_t* qp = P + ((size_t)b * SB + qt * 128 + wv * 32 + qg * 16 + l15) * PW + C_DAQ + h * 128;
#pragma unroll
        for (int wh = 0; wh < 2; ++wh)
#pragma unroll
            for (int ks = 0; ks < 2; ++ks) Qst[(wh * 4 + qg * 2 + ks) * 64] = *(const bf16x8*)(qp + wh * 64 + ks * 32 + quad * 8);
    }
    f32x4 O[2][8][2];
    float mrun[2][2], lrun[2][2];
#pragma unroll
    for (int wh = 0; wh < 2; ++wh)
#pragma unroll
        for (int qg = 0; qg < 2; ++qg) { mrun[wh][qg] = -1e30f; lrun[wh][qg] = 0.f;
#pragma unroll
            for (int dg = 0; dg < 8; ++dg) O[wh][dg][qg] = (f32x4){0.f, 0.f, 0.f, 0.f}; }
    const int kr = tid >> 2, kseg = (tid & 3) * 32;
    const int kpos = ((kr >> 5) * 2 + ((kr & 7) >> 2)) * 16 + ((kr & 31) >> 3) * 4 + (kr & 3);
    const bf16_t* kg_ = P + ((size_t)b * SB + kr) * PW + C_DAK + h * 128 + kseg;
    const int vr = tid >> 1, vh = (tid & 1) * 32;
    const bf16_t* vg_ = VT + (size_t)vr * SB + vh;
    u32x4 kreg[4], vreg[4];
#pragma unroll
    for (int i = 0; i < 4; ++i) { kreg[i] = *(const u32x4*)(kg_ + i * 8); vreg[i] = *(const u32x4*)(vg_ + i * 8); }
    __syncthreads();
#pragma unroll
    for (int i = 0; i < 4; ++i) { *(u32x4*)(K_s + kpos * 136 + kseg + i * 8) = kreg[i]; *(u32x4*)(V_s + vr * 72 + vh + i * 8) = vreg[i]; }
    __syncthreads();
    const float L2E = 1.4426950408889634f;
#pragma unroll 1
    for (int t = 0; t < nt_keys; ++t) {
        const bf16_t* Kb = K_s + (t & 1) * (64 * 136);
        const bf16_t* Vb = V_s + (t & 1) * (128 * 72);
        if (t + 1 < nt_keys) {
#pragma unroll
            for (int i = 0; i < 4; ++i) { kreg[i] = *(const u32x4*)(kg_ + (size_t)(t + 1) * 64 * PW + i * 8); vreg[i] = *(const u32x4*)(vg_ + (t + 1) * 64 + i * 8); }
        }
#pragma unroll
        for (int wh = 0; wh < 2; ++wh) {
            f32x4 S[4][2];
#pragma unroll
            for (int kg = 0; kg < 4; ++kg) { S[kg][0] = (f32x4){0.f, 0.f, 0.f, 0.f}; S[kg][1] = (f32x4){0.f, 0.f, 0.f, 0.f}; }
#pragma unroll
            for (int ks = 0; ks < 2; ++ks)
#pragma unroll
                for (int kg = 0; kg < 4; ++kg) {
                    bf16x8 kf = *(const bf16x8*)(Kb + (kg * 16 + l15) * 136 + wh * 64 + ks * 32 + quad * 8);
                    S[kg][0] = mfma16(kf, Qst[(wh * 4 + 0 + ks) * 64], S[kg][0]);
                    S[kg][1] = mfma16(kf, Qst[(wh * 4 + 2 + ks) * 64], S[kg][1]);
                }
            bf16x8 Pf[2][2];
#pragma unroll
            for (int qg = 0; qg < 2; ++qg) {
                float mx = -1e30f;
#pragma unroll
                for (int kg = 0; kg < 4; ++kg)
#pragma unroll
                    for (int j = 0; j < 4; ++j) mx = fmaxf(mx, S[kg][qg][j]);
                mx = fmaxf(mx, __shfl_xor(mx, 16)); mx = fmaxf(mx, __shfl_xor(mx, 32));
                mx *= L2E;
                if (__builtin_amdgcn_ballot_w64(mx > mrun[wh][qg] + 8.f) != 0ull) {
                    const float mnew = fmaxf(mrun[wh][qg], mx);
                    const float alpha = __builtin_amdgcn_exp2f(mrun[wh][qg] - mnew);
                    mrun[wh][qg] = mnew;
                    lrun[wh][qg] *= alpha;
#pragma unroll
                    for (int dg = 0; dg < 8; ++dg)
#pragma unroll
                        for (int j = 0; j < 4; ++j) O[wh][dg][qg][j] *= alpha;
                }
                const float mref = mrun[wh][qg];
                float ps = 0.f;
#pragma unroll
                for (int kg = 0; kg < 4; ++kg)
#pragma unroll
                    for (int j = 0; j < 4; ++j) { float pv = __builtin_amdgcn_exp2f(S[kg][qg][j] * L2E - mref); ps += pv; S[kg][qg][j] = pv; }
                lrun[wh][qg] += ps;
#pragma unroll
                for (int s_ = 0; s_ < 2; ++s_) {
                    u32x4 pk; pk[0] = pack2(S[2 * s_][qg][0], S[2 * s_][qg][1]); pk[1] = pack2(S[2 * s_][qg][2], S[2 * s_][qg][3]);
                    pk[2] = pack2(S[2 * s_ + 1][qg][0], S[2 * s_ + 1][qg][1]); pk[3] = pack2(S[2 * s_ + 1][qg][2], S[2 * s_ + 1][qg][3]);
                    Pf[qg][s_] = __builtin_bit_cast(bf16x8, pk);
                }
            }
#pragma unroll
            for (int dg = 0; dg < 8; ++dg)
#pragma unroll
                for (int s_ = 0; s_ < 2; ++s_) {
                    bf16x8 vf = *(const bf16x8*)(Vb + (dg * 16 + l15) * 72 + s_ * 32 + quad * 8);
                    O[wh][dg][0] = mfma16(vf, Pf[0][s_], O[wh][dg][0]);
                    O[wh][dg][1] = mfma16(vf, Pf[1][s_], O[wh][dg][1]);
                }
        }
        if (t + 1 < nt_keys) {
            bf16_t* Kn = K_s + ((t + 1) & 1) * (64 * 136); bf16_t* Vn = V_s + ((t + 1) & 1) * (128 * 72);
#pragma unroll
            for (int i = 0; i < 4; ++i) { *(u32x4*)(Kn + kpos * 136 + kseg + i * 8) = kreg[i]; *(u32x4*)(Vn + vr * 72 + vh + i * 8) = vreg[i]; }
        }
        __syncthreads();
    }
    const float* dnw = p.in[I_DANORM] + l * 128;
#pragma unroll
    for (int qg = 0; qg < 2; ++qg) {
        float l1 = lrun[0][qg], l2 = lrun[1][qg];
        l1 += __shfl_xor(l1, 16); l1 += __shfl_xor(l1, 32); l2 += __shfl_xor(l2, 16); l2 += __shfl_xor(l2, 32);
        const float i1 = 1.f / l1, i2 = lam / l2;
        float ss = 0.f;
#pragma unroll
        for (int dg = 0; dg < 8; ++dg)
#pragma unroll
            for (int j = 0; j < 4; ++j) { float o = O[0][dg][qg][j] * i1 - O[1][dg][qg][j] * i2; O[0][dg][qg][j] = o; ss += o * o; }
        ss += __shfl_xor(ss, 16); ss += __shfl_xor(ss, 32);
        const float rstd = rsqrtf(ss * (1.f / 128.f) + 1e-5f) * (1.f - lam_init);
        bf16_t* op = P + ((size_t)b * SB + qt * 128 + wv * 32 + qg * 16 + l15) * PW + C_DAQ + h * 128;
#pragma unroll
        for (int dg = 0; dg < 8; ++dg) {
            const int dv0 = dg * 16 + quad * 4;
            u32x2 o; o.x = pack2(O[0][dg][qg][0] * rstd * dnw[dv0], O[0][dg][qg][1] * rstd * dnw[dv0 + 1]);
            o.y = pack2(O[0][dg][qg][2] * rstd * dnw[dv0 + 2], O[0][dg][qg][3] * rstd * dnw[dv0 + 3]);
            *(u32x2*)(op + dv0) = o;
        }
    }
}

DEV void phase_mix(const Params& p, int l, unsigned char* smem) {
    const bool need_ctx = l == 0;
    const float lam_init = l == 0 ? 0.2f : 0.35550906759096926f;
    unsigned* ctr = (unsigned*)(p.ws + O_CTL) + l;
    unsigned* actr = (unsigned*)(p.ws + O_CTL) + 16 + l * 8;
    __shared__ int s_item;
    const int nqt = need_ctx ? 34 : 32;
    auto next = [&](unsigned* c) -> int {
        __syncthreads();
        if (threadIdx.x == 0) s_item = (int)atomicAdd(c, 1u);
        __syncthreads();
        return __builtin_amdgcn_readfirstlane(s_item);
    };
    int it = next(ctr);
#pragma unroll 1
    while (it < 64) { dn_item(p, l, it, smem); it = next(ctr); }
#pragma unroll 1
    while (it < 128) { lru_item(p, l, it - 64, smem); it = next(ctr); }
    const int myx = blockIdx.x & 7;
#pragma unroll 1
    for (int k = 0; k < 8; ++k) {
        const int x = (myx + k) & 7;
        it = next(actr + x);
#pragma unroll 1
        while (it < 4 * nqt) {
            const int bh = x + 8 * (it / nqt), idx = it % nqt;
            const int qt = idx < 32 ? idx + 2 : idx - 32;
            att_item(p, l, bh >> 2, bh & 3, qt, lam_init, smem);
            it = next(actr + x);
        }
    }
}

constexpr int NPHASE = 1 + 2 * 9 + 1;
DEV void run_phase(const Params& p, int ph, unsigned char* smem) {
    if (ph == 0) { phase_mod(p, smem); phase_rope(p); __syncthreads(); phase_wconv(p, 0, smem); return; }
    if (ph == NPHASE - 1) { phase_final(p); return; }
    const int l = (ph - 1) / 9, q = (ph - 1) % 9;
    const bool first = l == 0, lat = l == 1;
    const bf16_t* W = wsb(p, O_WT);
    switch (q) {
        case 0: if (l == 1) phase_wconv(p, 1, smem); phase_norm(p, l, 0, first, false); break;
        case 1: phase_g1(p, smem); break;
        case 2: phase_mix(p, l, smem); break;
        case 3: phase_fin_norm(p, l, first, lat); break;
        case 4: phase_gate(p, lat, smem); break;
        case 5: phase_resid(p, l, wsb(p, O_U), D, W + W_OUT, 1024, 2, first, lat, smem); break;
        case 6: phase_norm(p, l, 1, false, lat); break;
        case 7: phase_gu(p, lat, smem); break;
        case 8: phase_resid(p, l, wsb(p, O_P), PW, W + W_DN, DFF, 5, false, lat, smem); break;
    }
}

#if MEGA
__global__ void __launch_bounds__(256) mega_kernel(Params p) {
    extern __shared__ __align__(16) unsigned char smem[];
    cg::grid_group grid = cg::this_grid();
    phase_mod(p, smem); phase_rope(p); __syncthreads(); phase_wconv(p, 0, smem);
    grid.sync();
    const bf16_t* W = wsb(p, O_WT);
#pragma unroll
    for (int l = 0; l < 2; ++l) {
        const bool first = l == 0, lat = l == 1;
        if (l == 1) phase_wconv(p, 1, smem);
        phase_norm(p, l, 0, first, false);
        grid.sync();
        phase_g1(p, smem);
        grid.sync();
        phase_mix(p, l, smem);
        grid.sync();
        phase_fin_norm(p, l, first, lat);
        grid.sync();
        phase_gate(p, lat, smem);
        grid.sync();
        phase_merge(p, lat, smem);
        grid.sync();
        phase_resid(p, l, wsb(p, O_U), D, W + W_OUT, 1024, 2, first, lat, smem);
        grid.sync();
        phase_norm(p, l, 1, false, lat);
        grid.sync();
        phase_gu(p, lat, smem);
        grid.sync();
        phase_resid(p, l, wsb(p, O_P), PW, W + W_DN, DFF, 5, false, lat, smem);
        grid.sync();
    }
    phase_final(p);
}
#else
__global__ void __launch_bounds__(256) phase_kernel(Params p, int ph) {
    extern __shared__ __align__(16) unsigned char smem[];
    run_phase(p, ph, smem);
}
#endif

extern "C" void kernel_launch(void* const* d_in, const int* in_sizes, int n_in, void* d_out, int out_size, void* d_ws, size_t ws_size, hipStream_t stream) {
    static int grid = 0;
    if (grid == 0) {
        if (n_in != 28 || ws_size < WS_END) { fprintf(stderr, "kernel_launch: unexpected n_in %d or ws_size %zu < %zu\n", n_in, ws_size, (size_t)WS_END); grid = -1; return; }
        int dev = 0, cus = 0, per_cu = 0;
        hipGetDevice(&dev);
        hipDeviceGetAttribute(&cus, hipDeviceAttributeMultiprocessorCount, dev);
#if MEGA
        hipFuncSetAttribute((const void*)mega_kernel, hipFuncAttributeMaxDynamicSharedMemorySize, LDS_BYTES);
        hipOccupancyMaxActiveBlocksPerMultiprocessor(&per_cu, (const void*)mega_kernel, 256, LDS_BYTES);
#else
        hipFuncSetAttribute((const void*)phase_kernel, hipFuncAttributeMaxDynamicSharedMemorySize, LDS_BYTES);
        hipOccupancyMaxActiveBlocksPerMultiprocessor(&per_cu, (const void*)phase_kernel, 256, LDS_BYTES);
#endif
        if (per_cu < 1) per_cu = 1;
        grid = cus * per_cu;
        fprintf(stderr, "kernel_launch: grid %d (%d CUs x %d)\n", grid, cus, per_cu);
    }
    if (grid < 0) return;
    hipMemsetAsync((char*)d_ws + O_CTL, 0, 4096, stream);
    Params p{};
    for (int i = 0; i < 28; ++i) p.in[i] = (const float*)d_in[i];
    p.out = (float*)d_out; p.ws = (unsigned char*)d_ws;
#if MEGA
    void* args[] = {&p};
    hipError_t e = hipLaunchCooperativeKernel((const void*)mega_kernel, dim3(grid), dim3(256), args, LDS_BYTES, stream);
    if (e != hipSuccess) fprintf(stderr, "cooperative launch failed: %s (grid %d)\n", hipGetErrorString(e), grid);
#else
    for (int ph = 0; ph < NPHASE; ++ph) hipLaunchKernelGGL(phase_kernel, dim3(grid), dim3(256), LDS_BYTES, stream, p, ph);
#endif
}
```

```cpp
#include <hip/hip_runtime.h>
#include <hip/hip_cooperative_groups.h>
#include <cstdio>
#include <cstdint>
namespace cg = cooperative_groups;

#ifndef MEGA
#define MEGA 1
#endif

typedef unsigned short bf16_t;
typedef short bf16x8 __attribute__((ext_vector_type(8)));
typedef float f32x4 __attribute__((ext_vector_type(4)));
typedef unsigned u32x4 __attribute__((ext_vector_type(4)));
typedef unsigned u32x2 __attribute__((ext_vector_type(2)));
#define DEV __device__ __forceinline__

constexpr int D = 1024, NB = 8, SEQ = 4096, CTXL = 256, SB = 4352, MR = NB * SB, PW = 4096, DFF = 2816;
constexpr int C_DNQ = 0, C_DNK = 512, C_DNV = 1024, C_DNZ = 1536, C_LX = 2048, C_LG = 2560, C_DAQ = 3072, C_DAK = 3584;
constexpr int NIN = 4736;
constexpr int GLD = 80;

enum { I_X = 0, I_C, I_CTX, I_CCTX, I_WMOD, I_BMOD, I_NMIX, I_NFFN, I_WIN, I_DNCONV, I_DNALOG, I_DNDT, I_DNNORM, I_LCW, I_LCB,
       I_LWA, I_LBA, I_LWI, I_LBI, I_LLAM, I_DALAM, I_DANORM, I_WBR, I_WOUT, I_WFG, I_WFU, I_WFD, I_NFIN };

constexpr size_t al256(size_t x) { return (x + 255) & ~(size_t)255; }
constexpr size_t O_CTL = 0;
constexpr size_t O_MOD = 4096;
constexpr size_t O_ROPE = al256(O_MOD + (size_t)2 * 9 * 6144 * 4);
constexpr size_t O_WT = al256(O_ROPE + 64 * 16 * 2 * 4);
constexpr size_t W_IN = 0, W_GATE = W_IN + (size_t)NIN * 1024, W_BR = W_GATE + (size_t)3072 * 1024, W_OUT = W_BR + (size_t)3 * 1024 * 512,
                 W_GU = W_OUT + (size_t)1024 * 1024, W_DN = W_GU + (size_t)5632 * 1024, W_END = W_DN + (size_t)1024 * 2816;
constexpr size_t O_HCTX = al256(O_WT + W_END * 2);
constexpr size_t O_U = al256(O_HCTX + (size_t)2048 * 1024 * 4);
constexpr size_t O_P = al256(O_U + (size_t)MR * 1024 * 2);
constexpr size_t O_AB = al256(O_P + (size_t)MR * PW * 2);
constexpr size_t O_TA = al256(O_AB + (size_t)MR * 16 * 4);
constexpr size_t O_TA2 = al256(O_TA + (size_t)MR * 512 * 2);
constexpr size_t O_VT = al256(O_TA2 + (size_t)MR * 512 * 2);
constexpr size_t WS_END = al256(O_VT + (size_t)MR * 512 * 2);

constexpr int LDS_BYTES = 140 * 1024;

struct Params {
    const float* in[28];
    float* out;
    unsigned char* ws;
};

DEV int get_tid() { int t = threadIdx.x; asm volatile("" : "+v"(t)); return t; }
DEV float bf2f(bf16_t h) { return __uint_as_float(((unsigned)h) << 16); }
DEV bf16_t f2bf(float f) { unsigned u = __float_as_uint(f); u += 0x7fffu + ((u >> 16) & 1u); return (bf16_t)(u >> 16); }
typedef float f32x2_ __attribute__((ext_vector_type(2)));
typedef __bf16 bf16x2_ __attribute__((ext_vector_type(2)));
DEV unsigned pack2(float a, float b) { const f32x2_ v = {a, b}; return __builtin_bit_cast(unsigned, __builtin_convertvector(v, bf16x2_)); }
DEV float sigm(float x) { return __builtin_amdgcn_rcpf(1.f + __expf(-x)); }
DEV float silu(float x) { return x * __builtin_amdgcn_rcpf(1.f + __expf(-x)); }
DEV float softplus(float x) { return x > 20.f ? x : log1pf(expf(x)); }
DEV float softplus_fast(float x) { const float e = __expf(x); return x > 15.f ? x : (e < 0.01f ? e * (1.f - e * (0.5f - e * 0.33333333f)) : __logf(1.f + e)); }
DEV float gelu_tanh(float x) { float u = 0.7978845608028654f * (x + 0.044715f * x * x * x); float t = 1.f - 2.f * __builtin_amdgcn_rcpf(1.f + __expf(2.f * u)); return 0.5f * x * (1.f + t); }
DEV f32x4 mfma16(bf16x8 a, bf16x8 b, f32x4 c) { return __builtin_amdgcn_mfma_f32_16x16x32_bf16(a, b, c, 0, 0, 0); }
DEV void mfma16a(f32x4& c, bf16x8 a, bf16x8 b) { asm volatile("v_mfma_f32_16x16x32_bf16 %0, %1, %2, %0" : "+a"(c) : "v"(a), "v"(b)); }
DEV float lo16(unsigned v) { return __uint_as_float(v << 16); }
DEV float hi16(unsigned v) { return __uint_as_float(v & 0xffff0000u); }

DEV bf16_t* wsb(const Params& p, size_t off) { return (bf16_t*)(p.ws + off); }
DEV float* wsf(const Params& p, size_t off) { return (float*)(p.ws + off); }
DEV float* hrow(const Params& p, int r) { int b = r / SB, s = r - b * SB; return s < CTXL ? wsf(p, O_HCTX) + (size_t)(b * CTXL + s) * D : p.out + (size_t)(b * SEQ + s - CTXL) * D; }
DEV const float* xrow(const Params& p, int r) { int b = r / SB, s = r - b * SB; return s < CTXL ? p.in[I_CTX] + (size_t)(b * CTXL + s) * D : p.in[I_X] + (size_t)(b * SEQ + s - CTXL) * D; }
DEV int modrow(int r) { int b = r / SB, s = r - b * SB; return s < CTXL ? 8 : b; }

template <int MT, int NT>
DEV void gemm_core(const bf16_t* __restrict__ A, int lda, const bf16_t* __restrict__ Bt, int ldb, int K, f32x4 (&acc)[MT][NT], bf16_t* smem_) {
    constexpr int SA = 32 * MT * GLD, SBB = 32 * NT * GLD;
    bf16_t* sA = smem_; bf16_t* sB = smem_ + 2 * SA;
    const int tid = get_tid(), lane = tid & 63, wv = tid >> 6, wr = wv >> 1, wc = wv & 1, l15 = lane & 15, quad = lane >> 4;
    const int lr = tid >> 3, lc = (tid & 7) * 8;
    u32x4 ra0[MT], rb0[NT], ra1[MT], rb1[NT];
    const bf16_t* Ap = A + (size_t)lr * lda + lc;
    const bf16_t* Bp = Bt + (size_t)lr * ldb + lc;
    const int nk = K >> 6;
#define GLOAD(RA, RB, KT) { const int ko_ = (KT) * 64; _Pragma("unroll") for (int i = 0; i < MT; ++i) RA[i] = *(const u32x4*)(Ap + (size_t)(32 * i) * lda + ko_); \
                            _Pragma("unroll") for (int i = 0; i < NT; ++i) RB[i] = *(const u32x4*)(Bp + (size_t)(32 * i) * ldb + ko_); }
#define LSTORE(RA, RB, BUF) { _Pragma("unroll") for (int i = 0; i < MT; ++i) *(u32x4*)(sA + (BUF) * SA + (lr + 32 * i) * GLD + lc) = RA[i]; \
                              _Pragma("unroll") for (int i = 0; i < NT; ++i) *(u32x4*)(sB + (BUF) * SBB + (lr + 32 * i) * GLD + lc) = RB[i]; }
#define COMPUTE(BUF) { _Pragma("unroll") for (int ks = 0; ks < 2; ++ks) { bf16x8 af[MT], bfr[NT]; \
        _Pragma("unroll") for (int mt = 0; mt < MT; ++mt) af[mt] = *(const bf16x8*)(sA + (BUF) * SA + (wr * MT * 16 + mt * 16 + l15) * GLD + ks * 32 + quad * 8); \
        _Pragma("unroll") for (int nt = 0; nt < NT; ++nt) bfr[nt] = *(const bf16x8*)(sB + (BUF) * SBB + (wc * NT * 16 + nt * 16 + l15) * GLD + ks * 32 + quad * 8); \
        _Pragma("unroll") for (int mt = 0; mt < MT; ++mt) _Pragma("unroll") for (int nt = 0; nt < NT; ++nt) mfma16a(acc[mt][nt], bfr[nt], af[mt]); } }
    GLOAD(ra0, rb0, 0);
    GLOAD(ra1, rb1, 1);
    __syncthreads();
    LSTORE(ra0, rb0, 0);
    GLOAD(ra0, rb0, 2);
    __syncthreads();
    int kt = 0;
#pragma unroll 1
    for (; kt + 4 < nk; kt += 2) {
        COMPUTE(0);
        LSTORE(ra1, rb1, 1);
        GLOAD(ra1, rb1, kt + 3);
        __syncthreads();
        COMPUTE(1);
        LSTORE(ra0, rb0, 0);
        GLOAD(ra0, rb0, kt + 4);
        __syncthreads();
    }
    COMPUTE(0);
    LSTORE(ra1, rb1, 1);
    GLOAD(ra1, rb1, kt + 3);
    __syncthreads();
    COMPUTE(1);
    LSTORE(ra0, rb0, 0);
    __syncthreads();
    COMPUTE(0);
    LSTORE(ra1, rb1, 1);
    __syncthreads();
    COMPUTE(1);
    __syncthreads();
#undef GLOAD
#undef LSTORE
#undef COMPUTE
    asm volatile("s_nop 15\n\ts_nop 15" ::: "memory");
}
template <int MT, int NT>
DEV void gemm_core1(const bf16_t* __restrict__ A, int lda, const bf16_t* __restrict__ Bt, int ldb, int K, f32x4 (&acc)[MT][NT], bf16_t* sA, bf16_t* sB) {
    const int tid = get_tid(), lane = tid & 63, wv = tid >> 6, wr = wv >> 1, wc = wv & 1, l15 = lane & 15, quad = lane >> 4;
    const int lr = tid >> 3, lc = (tid & 7) * 8;
    u32x4 ra[MT], rb[NT];
    const bf16_t* Ap = A + (size_t)lr * lda + lc;
    const bf16_t* Bp = Bt + (size_t)lr * ldb + lc;
#pragma unroll
    for (int i = 0; i < MT; ++i) ra[i] = *(const u32x4*)(Ap + (size_t)(32 * i) * lda);
#pragma unroll
    for (int i = 0; i < NT; ++i) rb[i] = *(const u32x4*)(Bp + (size_t)(32 * i) * ldb);
    const int nk = K >> 6;
    for (int kt = 0; kt < nk; ++kt) {
        __syncthreads();
#pragma unroll
        for (int i = 0; i < MT; ++i) *(u32x4*)(sA + (lr + 32 * i) * GLD + lc) = ra[i];
#pragma unroll
        for (int i = 0; i < NT; ++i) *(u32x4*)(sB + (lr + 32 * i) * GLD + lc) = rb[i];
        __syncthreads();
        if (kt + 1 < nk) {
            const int ko = (kt + 1) * 64;
#pragma unroll
            for (int i = 0; i < MT; ++i) ra[i] = *(const u32x4*)(Ap + (size_t)(32 * i) * lda + ko);
#pragma unroll
            for (int i = 0; i < NT; ++i) rb[i] = *(const u32x4*)(Bp + (size_t)(32 * i) * ldb + ko);
        }
#pragma unroll
        for (int ks = 0; ks < 2; ++ks) {
            bf16x8 af[MT], bfr[NT];
#pragma unroll
            for (int mt = 0; mt < MT; ++mt) af[mt] = *(const bf16x8*)(sA + (wr * MT * 16 + mt * 16 + l15) * GLD + ks * 32 + quad * 8);
#pragma unroll
            for (int nt = 0; nt < NT; ++nt) bfr[nt] = *(const bf16x8*)(sB + (wc * NT * 16 + nt * 16 + l15) * GLD + ks * 32 + quad * 8);
#pragma unroll
            for (int mt = 0; mt < MT; ++mt)
#pragma unroll
                for (int nt = 0; nt < NT; ++nt) mfma16a(acc[mt][nt], bfr[nt], af[mt]);
        }
    }
    asm volatile("s_nop 15\n\ts_nop 15" ::: "memory");
}
template <int MT, int NT>
DEV void zero_acc(f32x4 (&acc)[MT][NT]) {
#pragma unroll
    for (int mt = 0; mt < MT; ++mt)
#pragma unroll
        for (int nt = 0; nt < NT; ++nt) acc[mt][nt] = (f32x4){0.f, 0.f, 0.f, 0.f};
}

DEV void phase_mod(const Params& p, unsigned char* smem) {
    float* s_s = (float*)smem;
    float* red = s_s + 9 * 1024;
    const int tid = get_tid();
    bool loaded = false;
    for (int it = blockIdx.x; it < 2 * 96; it += gridDim.x) {
        if (!loaded) {
            for (int e = tid; e < 9 * 1024; e += 256) { float v = e < 8192 ? p.in[I_C][e] : p.in[I_CCTX][e - 8192]; s_s[e] = silu(v); }
            loaded = true;
        }
        __syncthreads();
        const int l = it / 96, cg_ = it % 96, cq = tid & 63, kq = tid >> 6, col = cg_ * 64 + cq;
        float acc[9];
#pragma unroll
        for (int r = 0; r < 9; ++r) acc[r] = 0.f;
        const float* wp = p.in[I_WMOD] + ((size_t)l * 1024 + kq * 256) * 6144 + col;
#pragma unroll 8
        for (int k = 0; k < 256; ++k) {
            float wv = wp[(size_t)k * 6144];
#pragma unroll
            for (int r = 0; r < 9; ++r) acc[r] += s_s[r * 1024 + kq * 256 + k] * wv;
        }
#pragma unroll
        for (int r = 0; r < 9; ++r) red[(kq * 9 + r) * 64 + cq] = acc[r];
        __syncthreads();
        for (int e = tid; e < 9 * 64; e += 256) {
            int r = e >> 6, c2 = e & 63;
            float v = red[(0 * 9 + r) * 64 + c2] + red[(1 * 9 + r) * 64 + c2] + red[(2 * 9 + r) * 64 + c2] + red[(3 * 9 + r) * 64 + c2];
            wsf(p, O_MOD)[((size_t)l * 9 + r) * 6144 + cg_ * 64 + c2] = v + p.in[I_BMOD][l * 6144 + cg_ * 64 + c2];
        }
        __syncthreads();
    }
}
DEV void phase_rope(const Params& p) {
    if (blockIdx.x == (gridDim.x - 1)) {
        for (int e = threadIdx.x; e < 1024; e += 256) {
            int pos = e >> 4, i = e & 15;
            float inv = powf(10000.f, -(float)i / 16.f);
            float ang = (float)pos * inv;
            float n = rintf(ang * 0.15915494309189535f);
            float r = fmaf(-n, 6.28125f, ang);
            r = fmaf(-n, 1.9353071795864769e-3f, r);
            wsf(p, O_ROPE)[e * 2] = cosf(r);
            wsf(p, O_ROPE)[e * 2 + 1] = sinf(r);
        }
    }
}
DEV void wconv_tile(const float* src0, const float* src1, int lds_, int K, bf16_t* dst, int kind, int kt, int nt, bf16_t* tile) {
    const int tid = get_tid();
    const int kk = tid >> 2, grp = tid & 3;
    const int n0 = nt * 64, k0 = kt * 64;
    const int ng = n0 + grp * 16;
    const float* src = src0; int sc;
    if (kind == 0) { sc = ng < 2048 ? ng : (ng < 4608 ? ng + 16 : (ng < 4624 ? 2048 : -1)); }
    else if (kind == 1) { sc = 4624 + ng; }
    else if (kind == 2) { sc = ng; }
    else { int gd = ng >> 4; src = (gd & 1) ? src1 : src0; sc = (gd >> 1) * 16; }
    __syncthreads();
    if (sc >= 0) {
        const float4* sp = (const float4*)(src + (size_t)(k0 + kk) * lds_ + sc);
#pragma unroll
        for (int q = 0; q < 4; ++q) { float4 v = sp[q]; int e = grp * 16 + q * 4;
            tile[(e + 0) * GLD + kk] = f2bf(v.x); tile[(e + 1) * GLD + kk] = f2bf(v.y); tile[(e + 2) * GLD + kk] = f2bf(v.z); tile[(e + 3) * GLD + kk] = f2bf(v.w); }
    } else {
#pragma unroll
        for (int e = 0; e < 16; ++e) tile[(grp * 16 + e) * GLD + kk] = 0;
    }
    __syncthreads();
    const int n = tid >> 2, kseg = (tid & 3) * 16;
    u32x4 a = *(const u32x4*)(tile + n * GLD + kseg), b = *(const u32x4*)(tile + n * GLD + kseg + 8);
    bf16_t* dp = dst + (size_t)(n0 + n) * K + k0 + kseg;
    *(u32x4*)dp = a; *(u32x4*)(dp + 8) = b;
}
DEV void phase_wconv(const Params& p, int l, unsigned char* smem) {
    bf16_t* tile = (bf16_t*)smem;
    bf16_t* W = wsb(p, O_WT);
    constexpr int T0 = 74 * 16, T1 = T0 + 48 * 16, T2 = T1 + 3 * 16 * 8, T3 = T2 + 16 * 16, T4 = T3 + 88 * 16, T5 = T4 + 16 * 44;
    for (int t = blockIdx.x; t < T5; t += gridDim.x) {
        if (t < T0) { wconv_tile(p.in[I_WIN] + (size_t)l * 1024 * 7696, nullptr, 7696, 1024, W + W_IN, 0, t % 16, t / 16, tile); }
        else if (t < T1) { int u = t - T0; wconv_tile(p.in[I_WIN] + (size_t)l * 1024 * 7696, nullptr, 7696, 1024, W + W_GATE, 1, u % 16, u / 16, tile); }
        else if (t < T2) { int u = t - T1; int n = u / 128, v = u % 128; wconv_tile(p.in[I_WBR] + ((size_t)l * 3 + n) * 512 * 1024, nullptr, 1024, 512, W + W_BR + (size_t)n * 1024 * 512, 2, v % 8, v / 8, tile); }
        else if (t < T3) { int u = t - T2; wconv_tile(p.in[I_WOUT] + (size_t)l * 1024 * 1024, nullptr, 1024, 1024, W + W_OUT, 2, u % 16, u / 16, tile); }
        else if (t < T4) { int u = t - T3; wconv_tile(p.in[I_WFG] + (size_t)l * 1024 * DFF, p.in[I_WFU] + (size_t)l * 1024 * DFF, DFF, 1024, W + W_GU, 3, u % 16, u / 16, tile); }
        else { int u = t - T4; wconv_tile(p.in[I_WFD] + (size_t)l * DFF * 1024, nullptr, 1024, DFF, W + W_DN, 2, u % 44, u / 44, tile); }
    }
}

DEV void norm_row(const Params& p, int l, int which, bool first, int r, int lane) {
    const float* h = first ? xrow(p, r) : hrow(p, r);
    const float* nw = p.in[which ? I_NFFN : I_NMIX] + l * D;
    const float* md = wsf(p, O_MOD) + ((size_t)l * 9 + modrow(r)) * 6144 + (which ? 3 * D : 0);
    float4 v[4]; float ss = 0.f;
#pragma unroll
    for (int i = 0; i < 4; ++i) { v[i] = *(const float4*)(h + i * 256 + lane * 4); ss += v[i].x * v[i].x + v[i].y * v[i].y + v[i].z * v[i].z + v[i].w * v[i].w; }
#pragma unroll
    for (int o = 32; o >= 1; o >>= 1) ss += __shfl_xor(ss, o);
    const float rstd = rsqrtf(ss * (1.f / D) + 1e-6f);
    bf16_t* up = wsb(p, O_U) + (size_t)r * D;
#pragma unroll
    for (int i = 0; i < 4; ++i) {
        const int c = i * 256 + lane * 4;
        float4 w4 = *(const float4*)(nw + c), sh = *(const float4*)(md + c), sc = *(const float4*)(md + D + c);
        float a = v[i].x * rstd * w4.x * (1.f + sc.x) + sh.x, b = v[i].y * rstd * w4.y * (1.f + sc.y) + sh.y;
        float c2 = v[i].z * rstd * w4.z * (1.f + sc.z) + sh.z, d = v[i].w * rstd * w4.w * (1.f + sc.w) + sh.w;
        u32x2 o; o.x = pack2(a, b); o.y = pack2(c2, d);
        *(u32x2*)(up + c) = o;
    }
}
DEV void phase_norm(const Params& p, int l, int which, bool first, bool skip_ctx) {
    const int tid_ = get_tid(); const int lane = tid_ & 63, wv = tid_ >> 6;
    for (int r = blockIdx.x * 4 + wv; r < MR; r += gridDim.x * 4) {
        if (skip_ctx && (r % SB) < CTXL) continue;
        norm_row(p, l, which, first, r, lane);
    }
}
DEV void phase_fin_norm(const Params& p, int l, bool first, bool skip_ctx) {
    const int tid_ = get_tid(); const int lane = tid_ & 63, wv = tid_ >> 6;
    const float* dnn = p.in[I_DNNORM] + l * 128;
    for (int r = blockIdx.x * 4 + wv; r < MR; r += gridDim.x * 4) {
        if (skip_ctx && (r % SB) < CTXL) continue;
        norm_row(p, l, 0, first, r, lane);
        bf16_t* ta = wsb(p, O_TA) + (size_t)r * 512 + lane * 8;
        const bf16_t* tb = wsb(p, O_TA2) + (size_t)r * 512 + lane * 8;
        const bf16_t* zz = wsb(p, O_P) + (size_t)r * PW + C_DNZ + lane * 8;
        u32x4 a = *(const u32x4*)ta, b = *(const u32x4*)tb, z = *(const u32x4*)zz;
        float o[8]; float ss = 0.f;
#pragma unroll
        for (int i = 0; i < 4; ++i) { o[2 * i] = lo16(a[i]) + lo16(b[i]); o[2 * i + 1] = hi16(a[i]) + hi16(b[i]); ss += o[2 * i] * o[2 * i] + o[2 * i + 1] * o[2 * i + 1]; }
#pragma unroll
        for (int of = 8; of >= 1; of >>= 1) ss += __shfl_xor(ss, of);
        const float rstd = rsqrtf(ss * (1.f / 128.f) + 1e-6f);
        const int dv0 = (lane & 15) * 8;
        u32x4 y;
#pragma unroll
        for (int i = 0; i < 4; ++i) {
            float y0 = o[2 * i] * rstd * dnn[dv0 + 2 * i] * silu(lo16(z[i]));
            float y1 = o[2 * i + 1] * rstd * dnn[dv0 + 2 * i + 1] * silu(hi16(z[i]));
            y[i] = pack2(y0, y1);
        }
        *(u32x4*)ta = y;
    }
}
DEV void phase_final(const Params& p) {
    const int tid_ = get_tid(); const int lane = tid_ & 63, wv = tid_ >> 6;
    const float* nw = p.in[I_NFIN];
    for (int r = blockIdx.x * 4 + wv; r < NB * SEQ; r += gridDim.x * 4) {
        float* h = p.out + (size_t)r * D;
        float4 v[4]; float ss = 0.f;
#pragma unroll
        for (int i = 0; i < 4; ++i) { v[i] = *(const float4*)(h + i * 256 + lane * 4); ss += v[i].x * v[i].x + v[i].y * v[i].y + v[i].z * v[i].z + v[i].w * v[i].w; }
#pragma unroll
        for (int o = 32; o >= 1; o >>= 1) ss += __shfl_xor(ss, o);
        const float rstd = rsqrtf(ss * (1.f / D) + 1e-6f);
#pragma unroll
        for (int i = 0; i < 4; ++i) {
            const int c = i * 256 + lane * 4;
            float4 w4 = *(const float4*)(nw + c);
            float4 o4; o4.x = v[i].x * rstd * w4.x; o4.y = v[i].y * rstd * w4.y; o4.z = v[i].z * rstd * w4.z; o4.w = v[i].w * rstd * w4.w;
            *(float4*)(h + c) = o4;
        }
    }
}

struct TileIter {
    int nn, total, nloc, L;
    DEV TileIter(int nm, int nn_) { nn = nn_; total = nm * nn_; nloc = gridDim.x >> 3; L = (blockIdx.x & 7) * nloc + (blockIdx.x >> 3); }
    DEV bool valid() const { return L < total; }
    DEV bool more() const { return (L - (int)(blockIdx.x >> 3)) < total; }
    DEV void next() { L += 8 * nloc; }
    DEV void get(int& tm, int& tn) const { const int pn = 4 * nn, panel = L / pn, rem = L - panel * pn; tn = rem >> 2; tm = panel * 4 + (rem & 3); }
};
DEV void phase_g1(const Params& p, unsigned char* smem) {
    bf16_t* sA = (bf16_t*)smem;
    const int tid = get_tid(), lane = tid & 63, wv = tid >> 6, wr = wv >> 1, wc = wv & 1, l15 = lane & 15, quad = lane >> 4;
    const bf16_t* U = wsb(p, O_U); const bf16_t* W = wsb(p, O_WT) + W_IN;
    bf16_t* P = wsb(p, O_P);
    const float* rope = wsf(p, O_ROPE);
    constexpr int NTN = NIN / 128;
    const int wr0_ = wr, wc0_ = wc, l150_ = l15, quad0_ = quad;
    for (TileIter ti(MR / 256, NTN); ti.valid(); ti.next()) {
        int tm, tn; ti.get(tm, tn);
        const int row0 = tm * 256, col0 = tn * 128;
        f32x4 acc[8][4]; zero_acc(acc);
        gemm_core<8, 4>(U + (size_t)row0 * D, D, W + (size_t)col0 * D, D, D, acc, sA);
        int tz = 0; asm volatile("" : "+v"(tz));
        const int wr = wr0_ + tz, wc = wc0_ + tz, l15 = l150_ + tz, quad = quad0_ + tz;
        if (tn < 24) {
#pragma unroll
            for (int mt = 0; mt < 8; ++mt) {
                __builtin_amdgcn_sched_barrier(0);
                bf16_t* pp = P + (size_t)(row0 + wr * 128 + mt * 16 + l15) * PW + col0 + wc * 64 + quad * 4;
#pragma unroll
                for (int nt = 0; nt < 4; ++nt) { u32x2 o; o.x = pack2(acc[mt][nt][0], acc[mt][nt][1]); o.y = pack2(acc[mt][nt][2], acc[mt][nt][3]); *(u32x2*)(pp + nt * 16) = o; }
            }
        } else if (tn < 32) {
            const float qs = tn < 28 ? 0.125f : 1.f;
#pragma unroll
            for (int mt = 0; mt < 8; ++mt) {
                __builtin_amdgcn_sched_barrier(0);
                const int row = row0 + wr * 128 + mt * 16 + l15;
                const int s_ = row % SB;
                f32x4 ca = {1.f, 1.f, 1.f, 1.f}, sa = {0.f, 0.f, 0.f, 0.f}, cb = {1.f, 1.f, 1.f, 1.f}, sb = {0.f, 0.f, 0.f, 0.f};
                if (s_ >= CTXL) { const int tt = s_ - CTXL, pr = tt >> 6, pc = tt & 63;
                    const f32x4 r0 = *(const f32x4*)(rope + (pr * 16 + quad * 4) * 2), r1 = *(const f32x4*)(rope + (pr * 16 + quad * 4) * 2 + 4);
                    const f32x4 r2 = *(const f32x4*)(rope + (pc * 16 + quad * 4) * 2), r3 = *(const f32x4*)(rope + (pc * 16 + quad * 4) * 2 + 4);
                    ca = (f32x4){r0[0], r0[2], r1[0], r1[2]}; sa = (f32x4){r0[1], r0[3], r1[1], r1[3]};
                    cb = (f32x4){r2[0], r2[2], r3[0], r3[2]}; sb = (f32x4){r2[1], r2[3], r3[1], r3[3]}; }
                const f32x4 x1 = acc[mt][0], x2 = acc[mt][1], y1 = acc[mt][2], y2 = acc[mt][3];
                const f32x4 o0 = (x1 * ca - x2 * sa) * qs, o1 = (x2 * ca + x1 * sa) * qs, o2 = (y1 * cb - y2 * sb) * qs, o3 = (y2 * cb + y1 * sb) * qs;
                bf16_t* pp = P + (size_t)row * PW + col0 + wc * 64 + quad * 4;
                u32x2 o; o.x = pack2(o0[0], o0[1]); o.y = pack2(o0[2], o0[3]); *(u32x2*)(pp) = o;
                o.x = pack2(o1[0], o1[1]); o.y = pack2(o1[2], o1[3]); *(u32x2*)(pp + 16) = o;
                o.x = pack2(o2[0], o2[1]); o.y = pack2(o2[2], o2[3]); *(u32x2*)(pp + 32) = o;
                o.x = pack2(o3[0], o3[1]); o.y = pack2(o3[2], o3[3]); *(u32x2*)(pp + 48) = o;
            }
        } else if (tn < 36) {
            bf16_t* VT = wsb(p, O_VT);
            const int b = row0 / SB, sbase = row0 - b * SB;
#pragma unroll
            for (int mt = 0; mt < 8; ++mt) {
                __builtin_amdgcn_sched_barrier(0);
                const int s_ = sbase + wr * 128 + mt * 16 + l15;
                const int vi0 = (b * 512 + col0 - 4096 + wc * 64 + quad * 4) * SB + s_;
#pragma unroll
                for (int nt = 0; nt < 4; ++nt) {
                    const unsigned p01 = pack2(acc[mt][nt][0], acc[mt][nt][1]), p23 = pack2(acc[mt][nt][2], acc[mt][nt][3]);
                    VT[vi0 + (nt * 16 + 0) * SB] = (bf16_t)(p01 & 0xffffu); VT[vi0 + (nt * 16 + 1) * SB] = (bf16_t)(p01 >> 16);
                    VT[vi0 + (nt * 16 + 2) * SB] = (bf16_t)(p23 & 0xffffu); VT[vi0 + (nt * 16 + 3) * SB] = (bf16_t)(p23 >> 16);
                }
            }
        } else {
            if (wc == 0) {
                float* AB = wsf(p, O_AB);
#pragma unroll
                for (int mt = 0; mt < 8; ++mt) {
                    const int row = row0 + wr * 128 + mt * 16 + l15;
                    *(f32x4*)(AB + (size_t)row * 16 + quad * 4) = acc[mt][0];
                }
            }
        }
    }
}

DEV int rowtile0(int ti, bool latent_only) { if (!latent_only) return ti * 256; int b = ti >> 4, tt = ti & 15; return b * SB + CTXL + tt * 256; }
DEV int sgcol(int n, int c) { return n < 2 ? n * 1024 + c : (c < 512 ? 2048 + c : 3584 + (c - 512)); }

DEV void phase_gate(const Params& p, bool latent_only, unsigned char* smem) {
    bf16_t* sA = (bf16_t*)smem;
    const int tid = get_tid(), lane = tid & 63, wv = tid >> 6, wr = wv >> 1, wc = wv & 1, l15 = lane & 15, quad = lane >> 4;
    const bf16_t* U = wsb(p, O_U); const bf16_t* W = wsb(p, O_WT) + W_GATE;
    bf16_t* P = wsb(p, O_P);
    const int nrt = latent_only ? 128 : 136;
    for (TileIter ti(nrt, 24); ti.valid(); ti.next()) {
        int tm, tn; ti.get(tm, tn);
        const int row0 = rowtile0(tm, latent_only);
        f32x4 acc[8][4]; zero_acc(acc);
        gemm_core<8, 4>(U + (size_t)row0 * D, D, W + (size_t)tn * 128 * D, D, D, acc, sA);
        const int dcol0 = sgcol(tn >> 3, (tn & 7) * 128);
        bf16_t* ip = P + (size_t)(row0 + tid) * PW + dcol0;
#pragma unroll
        for (int mt = 0; mt < 8; ++mt) {
            __builtin_amdgcn_sched_barrier(0);
#pragma unroll
            for (int hf = 0; hf < 2; ++hf) {
                u32x4 o;
                o[0] = pack2(sigm(acc[mt][2 * hf][0]), sigm(acc[mt][2 * hf][1])); o[1] = pack2(sigm(acc[mt][2 * hf][2]), sigm(acc[mt][2 * hf][3]));
                o[2] = pack2(sigm(acc[mt][2 * hf + 1][0]), sigm(acc[mt][2 * hf + 1][1])); o[3] = pack2(sigm(acc[mt][2 * hf + 1][2]), sigm(acc[mt][2 * hf + 1][3]));
                *(u32x4*)(ip + (mt * 2 + hf) * 8) = o;
            }
        }
    }
}

DEV void phase_merge(const Params& p, bool latent_only, unsigned char* smem) {
    bf16_t* sA = (bf16_t*)smem;
    const int tid = get_tid(), lane = tid & 63, wv = tid >> 6, wr = wv >> 1, wc = wv & 1, l15 = lane & 15, quad = lane >> 4;
    const bf16_t* W = wsb(p, O_WT);
    const bf16_t* P = wsb(p, O_P);
    bf16_t* U = wsb(p, O_U);
    const int nrt = latent_only ? 128 : 136;
    for (TileIter ti(nrt, 8); ti.valid(); ti.next()) {
        int tm, tn; ti.get(tm, tn);
        const int row0 = rowtile0(tm, latent_only), col0 = tn * 128;
        f32x4 m[8][4]; zero_acc(m);
#pragma unroll 1
        for (int n = 0; n < 3; ++n) {
            f32x4 au[8][4]; zero_acc(au);
            const bf16_t* Y; int ldy;
            if (n == 0) { Y = wsb(p, O_TA) + (size_t)row0 * 512; ldy = 512; }
            else if (n == 1) { Y = P + (size_t)row0 * PW + C_LG; ldy = PW; }
            else { Y = P + (size_t)row0 * PW + C_DAQ; ldy = PW; }
            const int sc0 = sgcol(n, col0);
            u32x4 sg[16];
            const bf16_t* ip = P + (size_t)(row0 + tid) * PW + sc0;
#pragma unroll
            for (int q = 0; q < 16; ++q) sg[q] = *(const u32x4*)(ip + q * 8);
            gemm_core1<8, 4>(Y, ldy, W + W_BR + ((size_t)n * 1024 + col0) * 512, 512, 512, au, sA, sA + 256 * GLD);
#pragma unroll
            for (int mt = 0; mt < 8; ++mt)
#pragma unroll
                for (int nt = 0; nt < 4; ++nt) {
                    const unsigned g01 = sg[mt * 2 + (nt >> 1)][(nt & 1) * 2], g23 = sg[mt * 2 + (nt >> 1)][(nt & 1) * 2 + 1];
                    m[mt][nt][0] += lo16(g01) * au[mt][nt][0]; m[mt][nt][1] += hi16(g01) * au[mt][nt][1];
                    m[mt][nt][2] += lo16(g23) * au[mt][nt][2]; m[mt][nt][3] += hi16(g23) * au[mt][nt][3];
                }
        }
#pragma unroll
        for (int mt = 0; mt < 8; ++mt) {
            __builtin_amdgcn_sched_barrier(0);
            bf16_t* up = U + (size_t)(row0 + wr * 128 + mt * 16 + l15) * D + col0 + wc * 64 + quad * 4;
#pragma unroll
            for (int nt = 0; nt < 4; ++nt) { u32x2 o; o.x = pack2(m[mt][nt][0], m[mt][nt][1]); o.y = pack2(m[mt][nt][2], m[mt][nt][3]); *(u32x2*)(up + nt * 16) = o; }
        }
    }
}

DEV void phase_resid(const Params& p, int l, const bf16_t* A, int lda, const bf16_t* Wt, int K, int chunk, bool first, bool latent_only, unsigned char* smem) {
    bf16_t* sA = (bf16_t*)smem;
    const int tid = get_tid(), lane = tid & 63, wv = tid >> 6, wr = wv >> 1, wc = wv & 1, l15 = lane & 15, quad = lane >> 4;
    const int nrt = latent_only ? 128 : 136;
    for (TileIter ti(nrt, 8); ti.valid(); ti.next()) {
        int tm, tn; ti.get(tm, tn);
        const int row0 = rowtile0(tm, latent_only), col0 = tn * 128;
        f32x4 acc[8][4]; zero_acc(acc);
        gemm_core<8, 4>(A + (size_t)row0 * lda, lda, Wt + (size_t)col0 * K, K, K, acc, sA);
        const float* md = wsf(p, O_MOD) + ((size_t)l * 9 + modrow(row0)) * 6144 + chunk * D + col0 + wc * 64 + quad * 4;
        const float* hs0 = first ? xrow(p, row0) : hrow(p, row0);
        float* hd0 = hrow(p, row0);
        f32x4 mg[4];
#pragma unroll
        for (int nt = 0; nt < 4; ++nt) mg[nt] = *(const f32x4*)(md + nt * 16);
#pragma unroll
        for (int mt = 0; mt < 8; ++mt) {
            __builtin_amdgcn_sched_barrier(0);
            const size_t ro = (size_t)(wr * 128 + mt * 16 + l15) * D + col0 + wc * 64 + quad * 4;
#pragma unroll
            for (int nt = 0; nt < 4; ++nt) { const f32x4 h = *(const f32x4*)(hs0 + ro + nt * 16); *(f32x4*)(hd0 + ro + nt * 16) = h + mg[nt] * acc[mt][nt]; }
        }
    }
}
DEV void phase_gu(const Params& p, bool latent_only, unsigned char* smem) {
    bf16_t* sA = (bf16_t*)smem;
    const int tid = get_tid(), lane = tid & 63, wv = tid >> 6, wr = wv >> 1, wc = wv & 1, l15 = lane & 15, quad = lane >> 4;
    const bf16_t* U = wsb(p, O_U); const bf16_t* W = wsb(p, O_WT) + W_GU;
    bf16_t* P = wsb(p, O_P);
    const int nrt = latent_only ? 128 : 136;
    for (TileIter ti(nrt, 44); ti.valid(); ti.next()) {
        int tm, tn; ti.get(tm, tn);
        const int row0 = rowtile0(tm, latent_only);
        f32x4 acc[8][4]; zero_acc(acc);
        gemm_core<8, 4>(U + (size_t)row0 * D, D, W + (size_t)tn * 128 * D, D, D, acc, sA);
#pragma unroll
        for (int mt = 0; mt < 8; ++mt) {
            __builtin_amdgcn_sched_barrier(0);
            bf16_t* pp = P + (size_t)(row0 + wr * 128 + mt * 16 + l15) * PW + (tn * 4 + wc * 2) * 16 + quad * 4;
#pragma unroll
            for (int pr = 0; pr < 2; ++pr) {
                const f32x4 g = acc[mt][2 * pr], u = acc[mt][2 * pr + 1];
                u32x2 o; o.x = pack2(silu(g[0]) * u[0], silu(g[1]) * u[1]); o.y = pack2(silu(g[2]) * u[2], silu(g[3]) * u[3]);
                *(u32x2*)(pp + pr * 16) = o;
            }
        }
    }
}

DEV int chunk_of(int dir, int n) { return dir ? (n < 4 ? 3 - n : 71 - n) : n; }

typedef float f32x2 __attribute__((ext_vector_type(2)));
DEV void dn_solve(const float* __restrict__ Lt_s0, const bf16_t* __restrict__ colp, const float* __restrict__ mulp0, const float sg, bf16_t* __restrict__ outp) {
    int vz = 0; asm volatile("" : "+v"(vz));
    const float* __restrict__ Lt_s = Lt_s0 + vz; const float* __restrict__ mulp = mulp0 + vz;
    f32x2 X0, X1, X2, X3, X4, X5, X6, X7, X8, X9, X10, X11, X12, X13, X14, X15, X16, X17, X18, X19, X20, X21, X22, X23, X24, X25, X26, X27, X28, X29, X30, X31;
    f32x4 La0, La1, La2, La3, La4, La5, La6, La7, La8, La9, La10, La11, La12, La13, La14, La15, Lb0, Lb1, Lb2, Lb3, Lb4, Lb5, Lb6, Lb7, Lb8, Lb9, Lb10, Lb11, Lb12, Lb13, Lb14, Lb15;
    X0 = (f32x2){bf2f(colp[0]) * mulp[0], bf2f(colp[136]) * mulp[1]};
    X1 = (f32x2){bf2f(colp[272]) * mulp[2], bf2f(colp[408]) * mulp[3]};
    X2 = (f32x2){bf2f(colp[544]) * mulp[4], bf2f(colp[680]) * mulp[5]};
    X3 = (f32x2){bf2f(colp[816]) * mulp[6], bf2f(colp[952]) * mulp[7]};
    X4 = (f32x2){bf2f(colp[1088]) * mulp[8], bf2f(colp[1224]) * mulp[9]};
    X5 = (f32x2){bf2f(colp[1360]) * mulp[10], bf2f(colp[1496]) * mulp[11]};
    X6 = (f32x2){bf2f(colp[1632]) * mulp[12], bf2f(colp[1768]) * mulp[13]};
    X7 = (f32x2){bf2f(colp[1904]) * mulp[14], bf2f(colp[2040]) * mulp[15]};
    X8 = (f32x2){bf2f(colp[2176]) * mulp[16], bf2f(colp[2312]) * mulp[17]};
    X9 = (f32x2){bf2f(colp[2448]) * mulp[18], bf2f(colp[2584]) * mulp[19]};
    X10 = (f32x2){bf2f(colp[2720]) * mulp[20], bf2f(colp[2856]) * mulp[21]};
    X11 = (f32x2){bf2f(colp[2992]) * mulp[22], bf2f(colp[3128]) * mulp[23]};
    X12 = (f32x2){bf2f(colp[3264]) * mulp[24], bf2f(colp[3400]) * mulp[25]};
    X13 = (f32x2){bf2f(colp[3536]) * mulp[26], bf2f(colp[3672]) * mulp[27]};
    X14 = (f32x2){bf2f(colp[3808]) * mulp[28], bf2f(colp[3944]) * mulp[29]};
    X15 = (f32x2){bf2f(colp[4080]) * mulp[30], bf2f(colp[4216]) * mulp[31]};
    X16 = (f32x2){bf2f(colp[4352]) * mulp[32], bf2f(colp[4488]) * mulp[33]};
    X17 = (f32x2){bf2f(colp[4624]) * mulp[34], bf2f(colp[4760]) * mulp[35]};
    X18 = (f32x2){bf2f(colp[4896]) * mulp[36], bf2f(colp[5032]) * mulp[37]};
    X19 = (f32x2){bf2f(colp[5168]) * mulp[38], bf2f(colp[5304]) * mulp[39]};
    X20 = (f32x2){bf2f(colp[5440]) * mulp[40], bf2f(colp[5576]) * mulp[41]};
    X21 = (f32x2){bf2f(colp[5712]) * mulp[42], bf2f(colp[5848]) * mulp[43]};
    X22 = (f32x2){bf2f(colp[5984]) * mulp[44], bf2f(colp[6120]) * mulp[45]};
    X23 = (f32x2){bf2f(colp[6256]) * mulp[46], bf2f(colp[6392]) * mulp[47]};
    X24 = (f32x2){bf2f(colp[6528]) * mulp[48], bf2f(colp[6664]) * mulp[49]};
    X25 = (f32x2){bf2f(colp[6800]) * mulp[50], bf2f(colp[6936]) * mulp[51]};
    X26 = (f32x2){bf2f(colp[7072]) * mulp[52], bf2f(colp[7208]) * mulp[53]};
    X27 = (f32x2){bf2f(colp[7344]) * mulp[54], bf2f(colp[7480]) * mulp[55]};
    X28 = (f32x2){bf2f(colp[7616]) * mulp[56], bf2f(colp[7752]) * mulp[57]};
    X29 = (f32x2){bf2f(colp[7888]) * mulp[58], bf2f(colp[8024]) * mulp[59]};
    X30 = (f32x2){bf2f(colp[8160]) * mulp[60], bf2f(colp[8296]) * mulp[61]};
    X31 = (f32x2){bf2f(colp[8432]) * mulp[62], bf2f(colp[8568]) * mulp[63]};
    La0 = *(const f32x4*)(Lt_s + 0);
    La1 = *(const f32x4*)(Lt_s + 4);
    La2 = *(const f32x4*)(Lt_s + 8);
    La3 = *(const f32x4*)(Lt_s + 12);
    La4 = *(const f32x4*)(Lt_s + 16);
    La5 = *(const f32x4*)(Lt_s + 20);
    La6 = *(const f32x4*)(Lt_s + 24);
    La7 = *(const f32x4*)(Lt_s + 28);
    La8 = *(const f32x4*)(Lt_s + 32);
    La9 = *(const f32x4*)(Lt_s + 36);
    La10 = *(const f32x4*)(Lt_s + 40);
    La11 = *(const f32x4*)(Lt_s + 44);
    La12 = *(const f32x4*)(Lt_s + 48);
    La13 = *(const f32x4*)(Lt_s + 52);
    La14 = *(const f32x4*)(Lt_s + 56);
    La15 = *(const f32x4*)(Lt_s + 60);
    Lb0 = *(const f32x4*)(Lt_s + 68);
    Lb1 = *(const f32x4*)(Lt_s + 72);
    Lb2 = *(const f32x4*)(Lt_s + 76);
    Lb3 = *(const f32x4*)(Lt_s + 80);
    Lb4 = *(const f32x4*)(Lt_s + 84);
    Lb5 = *(const f32x4*)(Lt_s + 88);
    Lb6 = *(const f32x4*)(Lt_s + 92);
    Lb7 = *(const f32x4*)(Lt_s + 96);
    Lb8 = *(const f32x4*)(Lt_s + 100);
    Lb9 = *(const f32x4*)(Lt_s + 104);
    Lb10 = *(const f32x4*)(Lt_s + 108);
    Lb11 = *(const f32x4*)(Lt_s + 112);
    Lb12 = *(const f32x4*)(Lt_s + 116);
    Lb13 = *(const f32x4*)(Lt_s + 120);
    Lb14 = *(const f32x4*)(Lt_s + 124);
    Lb15 = *(const f32x4*)(Lt_s + 128);
    __builtin_amdgcn_sched_barrier(0);
    { const float xj = X0[0]; const f32x2 xj2 = (f32x2){xj, xj};
      X0 -= (f32x2){La0[0], La0[1]} * xj2;
      X1 -= (f32x2){La0[2], La0[3]} * xj2;
      X2 -= (f32x2){La1[0], La1[1]} * xj2;
      X3 -= (f32x2){La1[2], La1[3]} * xj2;
      X4 -= (f32x2){La2[0], La2[1]} * xj2;
      X5 -= (f32x2){La2[2], La2[3]} * xj2;
      X6 -= (f32x2){La3[0], La3[1]} * xj2;
      X7 -= (f32x2){La3[2], La3[3]} * xj2;
      X8 -= (f32x2){La4[0], La4[1]} * xj2;
      X9 -= (f32x2){La4[2], La4[3]} * xj2;
      X10 -= (f32x2){La5[0], La5[1]} * xj2;
      X11 -= (f32x2){La5[2], La5[3]} * xj2;
      X12 -= (f32x2){La6[0], La6[1]} * xj2;
      X13 -= (f32x2){La6[2], La6[3]} * xj2;
      X14 -= (f32x2){La7[0], La7[1]} * xj2;
      X15 -= (f32x2){La7[2], La7[3]} * xj2;
      X16 -= (f32x2){La8[0], La8[1]} * xj2;
      X17 -= (f32x2){La8[2], La8[3]} * xj2;
      X18 -= (f32x2){La9[0], La9[1]} * xj2;
      X19 -= (f32x2){La9[2], La9[3]} * xj2;
      X20 -= (f32x2){La10[0], La10[1]} * xj2;
      X21 -= (f32x2){La10[2], La10[3]} * xj2;
      X22 -= (f32x2){La11[0], La11[1]} * xj2;
      X23 -= (f32x2){La11[2], La11[3]} * xj2;
      X24 -= (f32x2){La12[0], La12[1]} * xj2;
      X25 -= (f32x2){La12[2], La12[3]} * xj2;
      X26 -= (f32x2){La13[0], La13[1]} * xj2;
      X27 -= (f32x2){La13[2], La13[3]} * xj2;
      X28 -= (f32x2){La14[0], La14[1]} * xj2;
      X29 -= (f32x2){La14[2], La14[3]} * xj2;
      X30 -= (f32x2){La15[0], La15[1]} * xj2;
      X31 -= (f32x2){La15[2], La15[3]} * xj2;
    }
    __builtin_amdgcn_sched_barrier(0);
    La0 = *(const f32x4*)(Lt_s + 136);
    La1 = *(const f32x4*)(Lt_s + 140);
    La2 = *(const f32x4*)(Lt_s + 144);
    La3 = *(const f32x4*)(Lt_s + 148);
    La4 = *(const f32x4*)(Lt_s + 152);
    La5 = *(const f32x4*)(Lt_s + 156);
    La6 = *(const f32x4*)(Lt_s + 160);
    La7 = *(const f32x4*)(Lt_s + 164);
    La8 = *(const f32x4*)(Lt_s + 168);
    La9 = *(const f32x4*)(Lt_s + 172);
    La10 = *(const f32x4*)(Lt_s + 176);
    La11 = *(const f32x4*)(Lt_s + 180);
    La12 = *(const f32x4*)(Lt_s + 184);
    La13 = *(const f32x4*)(Lt_s + 188);
    La14 = *(const f32x4*)(Lt_s + 192);
    La15 = *(const f32x4*)(Lt_s + 196);
    __builtin_amdgcn_sched_barrier(0);
    { const float xj = X0[1]; const f32x2 xj2 = (f32x2){xj, xj};
      X1 -= (f32x2){Lb0[2], Lb0[3]} * xj2;
      X2 -= (f32x2){Lb1[0], Lb1[1]} * xj2;
      X3 -= (f32x2){Lb1[2], Lb1[3]} * xj2;
      X4 -= (f32x2){Lb2[0], Lb2[1]} * xj2;
      X5 -= (f32x2){Lb2[2], Lb2[3]} * xj2;
      X6 -= (f32x2){Lb3[0], Lb3[1]} * xj2;
      X7 -= (f32x2){Lb3[2], Lb3[3]} * xj2;
      X8 -= (f32x2){Lb4[0], Lb4[1]} * xj2;
      X9 -= (f32x2){Lb4[2], Lb4[3]} * xj2;
      X10 -= (f32x2){Lb5[0], Lb5[1]} * xj2;
      X11 -= (f32x2){Lb5[2], Lb5[3]} * xj2;
      X12 -= (f32x2){Lb6[0], Lb6[1]} * xj2;
      X13 -= (f32x2){Lb6[2], Lb6[3]} * xj2;
      X14 -= (f32x2){Lb7[0], Lb7[1]} * xj2;
      X15 -= (f32x2){Lb7[2], Lb7[3]} * xj2;
      X16 -= (f32x2){Lb8[0], Lb8[1]} * xj2;
      X17 -= (f32x2){Lb8[2], Lb8[3]} * xj2;
      X18 -= (f32x2){Lb9[0], Lb9[1]} * xj2;
      X19 -= (f32x2){Lb9[2], Lb9[3]} * xj2;
      X20 -= (f32x2){Lb10[0], Lb10[1]} * xj2;
      X21 -= (f32x2){Lb10[2], Lb10[3]} * xj2;
      X22 -= (f32x2){Lb11[0], Lb11[1]} * xj2;
      X23 -= (f32x2){Lb11[2], Lb11[3]} * xj2;
      X24 -= (f32x2){Lb12[0], Lb12[1]} * xj2;
      X25 -= (f32x2){Lb12[2], Lb12[3]} * xj2;
      X26 -= (f32x2){Lb13[0], Lb13[1]} * xj2;
      X27 -= (f32x2){Lb13[2], Lb13[3]} * xj2;
      X28 -= (f32x2){Lb14[0], Lb14[1]} * xj2;
      X29 -= (f32x2){Lb14[2], Lb14[3]} * xj2;
      X30 -= (f32x2){Lb15[0], Lb15[1]} * xj2;
      X31 -= (f32x2){Lb15[2], Lb15[3]} * xj2;
    }
    __builtin_amdgcn_sched_barrier(0);
    Lb1 = *(const f32x4*)(Lt_s + 208);
    Lb2 = *(const f32x4*)(Lt_s + 212);
    Lb3 = *(const f32x4*)(Lt_s + 216);
    Lb4 = *(const f32x4*)(Lt_s + 220);
    Lb5 = *(const f32x4*)(Lt_s + 224);
    Lb6 = *(const f32x4*)(Lt_s + 228);
    Lb7 = *(const f32x4*)(Lt_s + 232);
    Lb8 = *(const f32x4*)(Lt_s + 236);
    Lb9 = *(const f32x4*)(Lt_s + 240);
    Lb10 = *(const f32x4*)(Lt_s + 244);
    Lb11 = *(const f32x4*)(Lt_s + 248);
    Lb12 = *(const f32x4*)(Lt_s + 252);
    Lb13 = *(const f32x4*)(Lt_s + 256);
    Lb14 = *(const f32x4*)(Lt_s + 260);
    Lb15 = *(const f32x4*)(Lt_s + 264);
    __builtin_amdgcn_sched_barrier(0);
    { const float xj = X1[0]; const f32x2 xj2 = (f32x2){xj, xj};
      X1 -= (f32x2){La0[2], La0[3]} * xj2;
      X2 -= (f32x2){La1[0], La1[1]} * xj2;
      X3 -= (f32x2){La1[2], La1[3]} * xj2;
      X4 -= (f32x2){La2[0], La2[1]} * xj2;
      X5 -= (f32x2){La2[2], La2[3]} * xj2;
      X6 -= (f32x2){La3[0], La3[1]} * xj2;
      X7 -= (f32x2){La3[2], La3[3]} * xj2;
      X8 -= (f32x2){La4[0], La4[1]} * xj2;
      X9 -= (f32x2){La4[2], La4[3]} * xj2;
      X10 -= (f32x2){La5[0], La5[1]} * xj2;
      X11 -= (f32x2){La5[2], La5[3]} * xj2;
      X12 -= (f32x2){La6[0], La6[1]} * xj2;
      X13 -= (f32x2){La6[2], La6[3]} * xj2;
      X14 -= (f32x2){La7[0], La7[1]} * xj2;
      X15 -= (f32x2){La7[2], La7[3]} * xj2;
      X16 -= (f32x2){La8[0], La8[1]} * xj2;
      X17 -= (f32x2){La8[2], La8[3]} * xj2;
      X18 -= (f32x2){La9[0], La9[1]} * xj2;
      X19 -= (f32x2){La9[2], La9[3]} * xj2;
      X20 -= (f32x2){La10[0], La10[1]} * xj2;
      X21 -= (f32x2){La10[2], La10[3]} * xj2;
      X22 -= (f32x2){La11[0], La11[1]} * xj2;
      X23 -= (f32x2){La11[2], La11[3]} * xj2;
      X24 -= (f32x2){La12[0], La12[1]} * xj2;
      X25 -= (f32x2){La12[2], La12[3]} * xj2;
      X26 -= (f32x2){La13[0], La13[1]} * xj2;
      X27 -= (f32x2){La13[2], La13[3]} * xj2;
      X28 -= (f32x2){La14[0], La14[1]} * xj2;
      X29 -= (f32x2){La14[2], La14[3]} * xj2;
      X30 -= (f32x2){La15[0], La15[1]} * xj2;
      X31 -= (f32x2){La15[2], La15[3]} * xj2;
    }
    __builtin_amdgcn_sched_barrier(0);
    La1 = *(const f32x4*)(Lt_s + 276);
    La2 = *(const f32x4*)(Lt_s + 280);
    La3 = *(const f32x4*)(Lt_s + 284);
    La4 = *(const f32x4*)(Lt_s + 288);
    La5 = *(const f32x4*)(Lt_s + 292);
    La6 = *(const f32x4*)(Lt_s + 296);
    La7 = *(const f32x4*)(Lt_s + 300);
    La8 = *(const f32x4*)(Lt_s + 304);
    La9 = *(const f32x4*)(Lt_s + 308);
    La10 = *(const f32x4*)(Lt_s + 312);
    La11 = *(const f32x4*)(Lt_s + 316);
    La12 = *(const f32x4*)(Lt_s + 320);
    La13 = *(const f32x4*)(Lt_s + 324);
    La14 = *(const f32x4*)(Lt_s + 328);
    La15 = *(const f32x4*)(Lt_s + 332);
    __builtin_amdgcn_sched_barrier(0);
    { const float xj = X1[1]; const f32x2 xj2 = (f32x2){xj, xj};
      X2 -= (f32x2){Lb1[0], Lb1[1]} * xj2;
      X3 -= (f32x2){Lb1[2], Lb1[3]} * xj2;
      X4 -= (f32x2){Lb2[0], Lb2[1]} * xj2;
      X5 -= (f32x2){Lb2[2], Lb2[3]} * xj2;
      X6 -= (f32x2){Lb3[0], Lb3[1]} * xj2;
      X7 -= (f32x2){Lb3[2], Lb3[3]} * xj2;
      X8 -= (f32x2){Lb4[0], Lb4[1]} * xj2;
      X9 -= (f32x2){Lb4[2], Lb4[3]} * xj2;
      X10 -= (f32x2){Lb5[0], Lb5[1]} * xj2;
      X11 -= (f32x2){Lb5[2], Lb5[3]} * xj2;
      X12 -= (f32x2){Lb6[0], Lb6[1]} * xj2;
      X13 -= (f32x2){Lb6[2], Lb6[3]} * xj2;
      X14 -= (f32x2){Lb7[0], Lb7[1]} * xj2;
      X15 -= (f32x2){Lb7[2], Lb7[3]} * xj2;
      X16 -= (f32x2){Lb8[0], Lb8[1]} * xj2;
      X17 -= (f32x2){Lb8[2], Lb8[3]} * xj2;
      X18 -= (f32x2){Lb9[0], Lb9[1]} * xj2;
      X19 -= (f32x2){Lb9[2], Lb9[3]} * xj2;
      X20 -= (f32x2){Lb10[0], Lb10[1]} * xj2;
      X21 -= (f32x2){Lb10[2], Lb10[3]} * xj2;
      X22 -= (f32x2){Lb11[0], Lb11[1]} * xj2;
      X23 -= (f32x2){Lb11[2], Lb11[3]} * xj2;
      X24 -= (f32x2){Lb12[0], Lb12[1]} * xj2;
      X25 -= (f32x2){Lb12[2], Lb12[3]} * xj2;
      X26 -= (f32x2){Lb13[0], Lb13[1]} * xj2;
      X27 -= (f32x2){Lb13[2], Lb13[3]} * xj2;
      X28 -= (f32x2){Lb14[0], Lb14[1]} * xj2;
      X29 -= (f32x2){Lb14[2], Lb14[3]} * xj2;
      X30 -= (f32x2){Lb15[0], Lb15[1]} * xj2;
      X31 -= (f32x2){Lb15[2], Lb15[3]} * xj2;
    }
    __builtin_amdgcn_sched_barrier(0);
    Lb1 = *(const f32x4*)(Lt_s + 344);
    Lb2 = *(const f32x4*)(Lt_s + 348);
    Lb3 = *(const f32x4*)(Lt_s + 352);
    Lb4 = *(const f32x4*)(Lt_s + 356);
    Lb5 = *(const f32x4*)(Lt_s + 360);
    Lb6 = *(const f32x4*)(Lt_s + 364);
    Lb7 = *(const f32x4*)(Lt_s + 368);
    Lb8 = *(const f32x4*)(Lt_s + 372);
    Lb9 = *(const f32x4*)(Lt_s + 376);
    Lb10 = *(const f32x4*)(Lt_s + 380);
    Lb11 = *(const f32x4*)(Lt_s + 384);
    Lb12 = *(const f32x4*)(Lt_s + 388);
    Lb13 = *(const f32x4*)(Lt_s + 392);
    Lb14 = *(const f32x4*)(Lt_s + 396);
    Lb15 = *(const f32x4*)(Lt_s + 400);
    __builtin_amdgcn_sched_barrier(0);
    { const float xj = X2[0]; const f32x2 xj2 = (f32x2){xj, xj};
      X2 -= (f32x2){La1[0], La1[1]} * xj2;
      X3 -= (f32x2){La1[2], La1[3]} * xj2;
      X4 -= (f32x2){La2[0], La2[1]} * xj2;
      X5 -= (f32x2){La2[2], La2[3]} * xj2;
      X6 -= (f32x2){La3[0], La3[1]} * xj2;
      X7 -= (f32x2){La3[2], La3[3]} * xj2;
      X8 -= (f32x2){La4[0], La4[1]} * xj2;
      X9 -= (f32x2){La4[2], La4[3]} * xj2;
      X10 -= (f32x2){La5[0], La5[1]} * xj2;
      X11 -= (f32x2){La5[2], La5[3]} * xj2;
      X12 -= (f32x2){La6[0], La6[1]} * xj2;
      X13 -= (f32x2){La6[2], La6[3]} * xj2;
      X14 -= (f32x2){La7[0], La7[1]} * xj2;
      X15 -= (f32x2){La7[2], La7[3]} * xj2;
      X16 -= (f32x2){La8[0], La8[1]} * xj2;
      X17 -= (f32x2){La8[2], La8[3]} * xj2;
      X18 -= (f32x2){La9[0], La9[1]} * xj2;
      X19 -= (f32x2){La9[2], La9[3]} * xj2;
      X20 -= (f32x2){La10[0], La10[1]} * xj2;
      X21 -= (f32x2){La10[2], La10[3]} * xj2;
      X22 -= (f32x2){La11[0], La11[1]} * xj2;
      X23 -= (f32x2){La11[2], La11[3]} * xj2;
      X24 -= (f32x2){La12[0], La12[1]} * xj2;
      X25 -= (f32x2){La12[2], La12[3]} * xj2;
      X26 -= (f32x2){La13[0], La13[1]} * xj2;
      X27 -= (f32x2){La13[2], La13[3]} * xj2;
      X28 -= (f32x2){La14[0], La14[1]} * xj2;
      X29 -= (f32x2){La14[2], La14[3]} * xj2;
      X30 -= (f32x2){La15[0], La15[1]} * xj2;
      X31 -= (f32x2){La15[2], La15[3]} * xj2;
    }
    __builtin_amdgcn_sched_barrier(0);
    La1 = *(const f32x4*)(Lt_s + 412);
    La2 = *(const f32x4*)(Lt_s + 416);
    La3 = *(const f32x4*)(Lt_s + 420);
    La4 = *(const f32x4*)(Lt_s + 424);
    La5 = *(const f32x4*)(Lt_s + 428);
    La6 = *(const f32x4*)(Lt_s + 432);
    La7 = *(const f32x4*)(Lt_s + 436);
    La8 = *(const f32x4*)(Lt_s + 440);
    La9 = *(const f32x4*)(Lt_s + 444);
    La10 = *(const f32x4*)(Lt_s + 448);
    La11 = *(const f32x4*)(Lt_s + 452);
    La12 = *(const f32x4*)(Lt_s + 456);
    La13 = *(const f32x4*)(Lt_s + 460);
    La14 = *(const f32x4*)(Lt_s + 464);
    La15 = *(const f32x4*)(Lt_s + 468);
    __builtin_amdgcn_sched_barrier(0);
    { const float xj = X2[1]; const f32x2 xj2 = (f32x2){xj, xj};
      X3 -= (f32x2){Lb1[2], Lb1[3]} * xj2;
      X4 -= (f32x2){Lb2[0], Lb2[1]} * xj2;
      X5 -= (f32x2){Lb2[2], Lb2[3]} * xj2;
      X6 -= (f32x2){Lb3[0], Lb3[1]} * xj2;
      X7 -= (f32x2){Lb3[2], Lb3[3]} * xj2;
      X8 -= (f32x2){Lb4[0], Lb4[1]} * xj2;
      X9 -= (f32x2){Lb4[2], Lb4[3]} * xj2;
      X10 -= (f32x2){Lb5[0], Lb5[1]} * xj2;
      X11 -= (f32x2){Lb5[2], Lb5[3]} * xj2;
      X12 -= (f32x2){Lb6[0], Lb6[1]} * xj2;
      X13 -= (f32x2){Lb6[2], Lb6[3]} * xj2;
      X14 -= (f32x2){Lb7[0], Lb7[1]} * xj2;
      X15 -= (f32x2){Lb7[2], Lb7[3]} * xj2;
      X16 -= (f32x2){Lb8[0], Lb8[1]} * xj2;
      X17 -= (f32x2){Lb8[2], Lb8[3]} * xj2;
      X18 -= (f32x2){Lb9[0], Lb9[1]} * xj2;
      X19 -= (f32x2){Lb9[2], Lb9[3]} * xj2;
      X20 -= (f32x2){Lb10[0], Lb10[1]} * xj2;
      X21 -= (f32x2){Lb10[2], Lb10[3]} * xj2;
      X22 -= (f32x2){Lb11[0], Lb11[1]} * xj2;
      X23 -= (f32x2){Lb11[2], Lb11[3]} * xj2;
      X24 -= (f32x2){Lb12[0], Lb12[1]} * xj2;
      X25 -= (f32x2){Lb12[2], Lb12[3]} * xj2;
      X26 -= (f32x2){Lb13[0], Lb13[1]} * xj2;
      X27 -= (f32x2){Lb13[2], Lb13[3]} * xj2;
      X28 -= (f32x2){Lb14[0], Lb14[1]} * xj2;
      X29 -= (f32x2){Lb14[2], Lb14[3]} * xj2;
      X30 -= (f32x2){Lb15[0], Lb15[1]} * xj2;
      X31 -= (f32x2){Lb15[2], Lb15[3]} * xj2;
    }
    __builtin_amdgcn_sched_barrier(0);
    Lb2 = *(const f32x4*)(Lt_s + 484);
    Lb3 = *(const f32x4*)(Lt_s + 488);
    Lb4 = *(const f32x4*)(Lt_s + 492);
    Lb5 = *(const f32x4*)(Lt_s + 496);
    Lb6 = *(const f32x4*)(Lt_s + 500);
    Lb7 = *(const f32x4*)(Lt_s + 504);
    Lb8 = *(const f32x4*)(Lt_s + 508);
    Lb9 = *(const f32x4*)(Lt_s + 512);
    Lb10 = *(const f32x4*)(Lt_s + 516);
    Lb11 = *(const f32x4*)(Lt_s + 520);
    Lb12 = *(const f32x4*)(Lt_s + 524);
    Lb13 = *(const f32x4*)(Lt_s + 528);
    Lb14 = *(const f32x4*)(Lt_s + 532);
    Lb15 = *(const f32x4*)(Lt_s + 536);
    __builtin_amdgcn_sched_barrier(0);
    { const float xj = X3[0]; const f32x2 xj2 = (f32x2){xj, xj};
      X3 -= (f32x2){La1[2], La1[3]} * xj2;
      X4 -= (f32x2){La2[0], La2[1]} * xj2;
      X5 -= (f32x2){La2[2], La2[3]} * xj2;
      X6 -= (f32x2){La3[0], La3[1]} * xj2;
      X7 -= (f32x2){La3[2], La3[3]} * xj2;
      X8 -= (f32x2){La4[0], La4[1]} * xj2;
      X9 -= (f32x2){La4[2], La4[3]} * xj2;
      X10 -= (f32x2){La5[0], La5[1]} * xj2;
      X11 -= (f32x2){La5[2], La5[3]} * xj2;
      X12 -= (f32x2){La6[0], La6[1]} * xj2;
      X13 -= (f32x2){La6[2], La6[3]} * xj2;
      X14 -= (f32x2){La7[0], La7[1]} * xj2;
      X15 -= (f32x2){La7[2], La7[3]} * xj2;
      X16 -= (f32x2){La8[0], La8[1]} * xj2;
      X17 -= (f32x2){La8[2], La8[3]} * xj2;
      X18 -= (f32x2){La9[0], La9[1]} * xj2;
      X19 -= (f32x2){La9[2], La9[3]} * xj2;
      X20 -= (f32x2){La10[0], La10[1]} * xj2;
      X21 -= (f32x2){La10[2], La10[3]} * xj2;
      X22 -= (f32x2){La11[0], La11[1]} * xj2;
      X23 -= (f32x2){La11[2], La11[3]} * xj2;
      X24 -= (f32x2){La12[0], La12[1]} * xj2;
      X25 -= (f32x2){La12[2], La12[3]} * xj2;
      X26 -= (f32x2){La13[0], La13[1]} * xj2;
      X27 -= (f32x2){La13[2], La13[3]} * xj2;
      X28 -= (f32x2){La14[0], La14[1]} * xj2;
      X29 -= (f32x2){La14[2], La14[3]} * xj2;
      X30 -= (f32x2){La15[0], La15[1]} * xj2;
      X31 -= (f32x2){La15[2], La15[3]} * xj2;
    }
    __builtin_amdgcn_sched_barrier(0);
    La2 = *(const f32x4*)(Lt_s + 552);
    La3 = *(const f32x4*)(Lt_s + 556);
    La4 = *(const f32x4*)(Lt_s + 560);
    La5 = *(const f32x4*)(Lt_s + 564);
    La6 = *(const f32x4*)(Lt_s + 568);
    La7 = *(const f32x4*)(Lt_s + 572);
    La8 = *(const f32x4*)(Lt_s + 576);
    La9 = *(const f32x4*)(Lt_s + 580);
    La10 = *(const f32x4*)(Lt_s + 584);
    La11 = *(const f32x4*)(Lt_s + 588);
    La12 = *(const f32x4*)(Lt_s + 592);
    La13 = *(const f32x4*)(Lt_s + 596);
    La14 = *(const f32x4*)(Lt_s + 600);
    La15 = *(const f32x4*)(Lt_s + 604);
    __builtin_amdgcn_sched_barrier(0);
    { const float xj = X3[1]; const f32x2 xj2 = (f32x2){xj, xj};
      X4 -= (f32x2){Lb2[0], Lb2[1]} * xj2;
      X5 -= (f32x2){Lb2[2], Lb2[3]} * xj2;
      X6 -= (f32x2){Lb3[0], Lb3[1]} * xj2;
      X7 -= (f32x2){Lb3[2], Lb3[3]} * xj2;
      X8 -= (f32x2){Lb4[0], Lb4[1]} * xj2;
      X9 -= (f32x2){Lb4[2], Lb4[3]} * xj2;
      X10 -= (f32x2){Lb5[0], Lb5[1]} * xj2;
      X11 -= (f32x2){Lb5[2], Lb5[3]} * xj2;
      X12 -= (f32x2){Lb6[0], Lb6[1]} * xj2;
      X13 -= (f32x2){Lb6[2], Lb6[3]} * xj2;
      X14 -= (f32x2){Lb7[0], Lb7[1]} * xj2;
      X15 -= (f32x2){Lb7[2], Lb7[3]} * xj2;
      X16 -= (f32x2){Lb8[0], Lb8[1]} * xj2;
      X17 -= (f32x2){Lb8[2], Lb8[3]} * xj2;
      X18 -= (f32x2){Lb9[0], Lb9[1]} * xj2;
      X19 -= (f32x2){Lb9[2], Lb9[3]} * xj2;
      X20 -= (f32x2){Lb10[0], Lb10[1]} * xj2;
      X21 -= (f32x2){Lb10[2], Lb10[3]} * xj2;
      X22 -= (f32x2){Lb11[0], Lb11[1]} * xj2;
      X23 -= (f32x2){Lb11[2], Lb11[3]} * xj2;
      X24 -= (f32x2){Lb12[0], Lb12[1]} * xj2;
      X25 -= (f32x2){Lb12[2], Lb12[3]} * xj2;
      X26 -= (f32x2){Lb13[0], Lb13[1]} * xj2;
      X27 -= (f32x2){Lb13[2], Lb13[3]} * xj2;
      X28 -= (f32x2){Lb14[0], Lb14[1]} * xj2;
      X29 -= (f32x2){Lb14[2], Lb14[3]} * xj2;
      X30 -= (f32x2){Lb15[0], Lb15[1]} * xj2;
      X31 -= (f32x2){Lb15[2], Lb15[3]} * xj2;
    }
    __builtin_amdgcn_sched_barrier(0);
    Lb2 = *(const f32x4*)(Lt_s + 620);
    Lb3 = *(const f32x4*)(Lt_s + 624);
    Lb4 = *(const f32x4*)(Lt_s + 628);
    Lb5 = *(const f32x4*)(Lt_s + 632);
    Lb6 = *(const f32x4*)(Lt_s + 636);
    Lb7 = *(const f32x4*)(Lt_s + 640);
    Lb8 = *(const f32x4*)(Lt_s + 644);
    Lb9 = *(const f32x4*)(Lt_s + 648);
    Lb10 = *(const f32x4*)(Lt_s + 652);
    Lb11 = *(const f32x4*)(Lt_s + 656);
    Lb12 = *(const f32x4*)(Lt_s + 660);
    Lb13 = *(const f32x4*)(Lt_s + 664);
    Lb14 = *(const f32x4*)(Lt_s + 668);
    Lb15 = *(const f32x4*)(Lt_s + 672);
    __builtin_amdgcn_sched_barrier(0);
    { const float xj = X4[0]; const f32x2 xj2 = (f32x2){xj, xj};
      X4 -= (f32x2){La2[0], La2[1]} * xj2;
      X5 -= (f32x2){La2[2], La2[3]} * xj2;
      X6 -= (f32x2){La3[0], La3[1]} * xj2;
      X7 -= (f32x2){La3[2], La3[3]} * xj2;
      X8 -= (f32x2){La4[0], La4[1]} * xj2;
      X9 -= (f32x2){La4[2], La4[3]} * xj2;
      X10 -= (f32x2){La5[0], La5[1]} * xj2;
      X11 -= (f32x2){La5[2], La5[3]} * xj2;
      X12 -= (f32x2){La6[0], La6[1]} * xj2;
      X13 -= (f32x2){La6[2], La6[3]} * xj2;
      X14 -= (f32x2){La7[0], La7[1]} * xj2;
      X15 -= (f32x2){La7[2], La7[3]} * xj2;
      X16 -= (f32x2){La8[0], La8[1]} * xj2;
      X17 -= (f32x2){La8[2], La8[3]} * xj2;
      X18 -= (f32x2){La9[0], La9[1]} * xj2;
      X19 -= (f32x2){La9[2], La9[3]} * xj2;
      X20 -= (f32x2){La10[0], La10[1]} * xj2;
      X21 -= (f32x2){La10[2], La10[3]} * xj2;
      X22 -= (f32x2){La11[0], La11[1]} * xj2;
      X23 -= (f32x2){La11[2], La11[3]} * xj2;
      X24 -= (f32x2){La12[0], La12[1]} * xj2;
      X25 -= (f32x2){La12[2], La12[3]} * xj2;
      X26 -= (f32x2){La13[0], La13[1]} * xj2;
      X27 -= (f32x2){La13[2], La13[3]} * xj2;
      X28 -= (f32x2){La14[0], La14[1]} * xj2;
      X29 -= (f32x2){La14[2], La14[3]} * xj2;
      X30 -= (f32x2){La15[0], La15[1]} * xj2;
      X31 -= (f32x2){La15[2], La15[3]} * xj2;
    }
    __builtin_amdgcn_sched_barrier(0);
    La2 = *(const f32x4*)(Lt_s + 688);
    La3 = *(const f32x4*)(Lt_s + 692);
    La4 = *(const f32x4*)(Lt_s + 696);
    La5 = *(const f32x4*)(Lt_s + 700);
    La6 = *(const f32x4*)(Lt_s + 704);
    La7 = *(const f32x4*)(Lt_s + 708);
    La8 = *(const f32x4*)(Lt_s + 712);
    La9 = *(const f32x4*)(Lt_s + 716);
    La10 = *(const f32x4*)(Lt_s + 720);
    La11 = *(const f32x4*)(Lt_s + 724);
    La12 = *(const f32x4*)(Lt_s + 728);
    La13 = *(const f32x4*)(Lt_s + 732);
    La14 = *(const f32x4*)(Lt_s + 736);
    La15 = *(const f32x4*)(Lt_s + 740);
    __builtin_amdgcn_sched_barrier(0);
    { const float xj = X4[1]; const f32x2 xj2 = (f32x2){xj, xj};
      X5 -= (f32x2){Lb2[2], Lb2[3]} * xj2;
      X6 -= (f32x2){Lb3[0], Lb3[1]} * xj2;
      X7 -= (f32x2){Lb3[2], Lb3[3]} * xj2;
      X8 -= (f32x2){Lb4[0], Lb4[1]} * xj2;
      X9 -= (f32x2){Lb4[2], Lb4[3]} * xj2;
      X10 -= (f32x2){Lb5[0], Lb5[1]} * xj2;
      X11 -= (f32x2){Lb5[2], Lb5[3]} * xj2;
      X12 -= (f32x2){Lb6[0], Lb6[1]} * xj2;
      X13 -= (f32x2){Lb6[2], Lb6[3]} * xj2;
      X14 -= (f32x2){Lb7[0], Lb7[1]} * xj2;
      X15 -= (f32x2){Lb7[2], Lb7[3]} * xj2;
      X16 -= (f32x2){Lb8[0], Lb8[1]} * xj2;
      X17 -= (f32x2){Lb8[2], Lb8[3]} * xj2;
      X18 -= (f32x2){Lb9[0], Lb9[1]} * xj2;
      X19 -= (f32x2){Lb9[2], Lb9[3]} * xj2;
      X20 -= (f32x2){Lb10[0], Lb10[1]} * xj2;
      X21 -= (f32x2){Lb10[2], Lb10[3]} * xj2;
      X22 -= (f32x2){Lb11[0], Lb11[1]} * xj2;
      X23 -= (f32x2){Lb11[2], Lb11[3]} * xj2;
      X24 -= (f32x2){Lb12[0], Lb12[1]} * xj2;
      X25 -= (f32x2){Lb12[2], Lb12[3]} * xj2;
      X26 -= (f32x2){Lb13[0], Lb13[1]} * xj2;
      X27 -= (f32x2){Lb13[2], Lb13[3]} * xj2;
      X28 -= (f32x2){Lb14[0], Lb14[1]} * xj2;
      X29 -= (f32x2){Lb14[2], Lb14[3]} * xj2;
      X30 -= (f32x2){Lb15[0], Lb15[1]} * xj2;
      X31 -= (f32x2){Lb15[2], Lb15[3]} * xj2;
    }
    __builtin_amdgcn_sched_barrier(0);
    Lb3 = *(const f32x4*)(Lt_s + 760);
    Lb4 = *(const f32x4*)(Lt_s + 764);
    Lb5 = *(const f32x4*)(Lt_s + 768);
    Lb6 = *(const f32x4*)(Lt_s + 772);
    Lb7 = *(const f32x4*)(Lt_s + 776);
    Lb8 = *(const f32x4*)(Lt_s + 780);
    Lb9 = *(const f32x4*)(Lt_s + 784);
    Lb10 = *(const f32x4*)(Lt_s + 788);
    Lb11 = *(const f32x4*)(Lt_s + 792);
    Lb12 = *(const f32x4*)(Lt_s + 796);
    Lb13 = *(const f32x4*)(Lt_s + 800);
    Lb14 = *(const f32x4*)(Lt_s + 804);
    Lb15 = *(const f32x4*)(Lt_s + 808);
    __builtin_amdgcn_sched_barrier(0);
    { const float xj = X5[0]; const f32x2 xj2 = (f32x2){xj, xj};
      X5 -= (f32x2){La2[2], La2[3]} * xj2;
      X6 -= (f32x2){La3[0], La3[1]} * xj2;
      X7 -= (f32x2){La3[2], La3[3]} * xj2;
      X8 -= (f32x2){La4[0], La4[1]} * xj2;
      X9 -= (f32x2){La4[2], La4[3]} * xj2;
      X10 -= (f32x2){La5[0], La5[1]} * xj2;
      X11 -= (f32x2){La5[2], La5[3]} * xj2;
      X12 -= (f32x2){La6[0], La6[1]} * xj2;
      X13 -= (f32x2){La6[2], La6[3]} * xj2;
      X14 -= (f32x2){La7[0], La7[1]} * xj2;
      X15 -= (f32x2){La7[2], La7[3]} * xj2;
      X16 -= (f32x2){La8[0], La8[1]} * xj2;
      X17 -= (f32x2){La8[2], La8[3]} * xj2;
      X18 -= (f32x2){La9[0], La9[1]} * xj2;
      X19 -= (f32x2){La9[2], La9[3]} * xj2;
      X20 -= (f32x2){La10[0], La10[1]} * xj2;
      X21 -= (f32x2){La10[2], La10[3]} * xj2;
      X22 -= (f32x2){La11[0], La11[1]} * xj2;
      X23 -= (f32x2){La11[2], La11[3]} * xj2;
      X24 -= (f32x2){La12[0], La12[1]} * xj2;
      X25 -= (f32x2){La12[2], La12[3]} * xj2;
      X26 -= (f32x2){La13[0], La13[1]} * xj2;
      X27 -= (f32x2){La13[2], La13[3]} * xj2;
      X28 -= (f32x2){La14[0], La14[1]} * xj2;
      X29 -= (f32x2){La14[2], La14[3]} * xj2;
      X30 -= (f32x2){La15[0], La15[1]} * xj2;
      X31 -= (f32x2){La15[2], La15[3]} * xj2;
    }
    __builtin_amdgcn_sched_barrier(0);
    La3 = *(const f32x4*)(Lt_s + 828);
    La4 = *(const f32x4*)(Lt_s + 832);
    La5 = *(const f32x4*)(Lt_s + 836);
    La6 = *(const f32x4*)(Lt_s + 840);
    La7 = *(const f32x4*)(Lt_s + 844);
    La8 = *(const f32x4*)(Lt_s + 848);
    La9 = *(const f32x4*)(Lt_s + 852);
    La10 = *(const f32x4*)(Lt_s + 856);
    La11 = *(const f32x4*)(Lt_s + 860);
    La12 = *(const f32x4*)(Lt_s + 864);
    La13 = *(const f32x4*)(Lt_s + 868);
    La14 = *(const f32x4*)(Lt_s + 872);
    La15 = *(const f32x4*)(Lt_s + 876);
    __builtin_amdgcn_sched_barrier(0);
    { const float xj = X5[1]; const f32x2 xj2 = (f32x2){xj, xj};
      X6 -= (f32x2){Lb3[0], Lb3[1]} * xj2;
      X7 -= (f32x2){Lb3[2], Lb3[3]} * xj2;
      X8 -= (f32x2){Lb4[0], Lb4[1]} * xj2;
      X9 -= (f32x2){Lb4[2], Lb4[3]} * xj2;
      X10 -= (f32x2){Lb5[0], Lb5[1]} * xj2;
      X11 -= (f32x2){Lb5[2], Lb5[3]} * xj2;
      X12 -= (f32x2){Lb6[0], Lb6[1]} * xj2;
      X13 -= (f32x2){Lb6[2], Lb6[3]} * xj2;
      X14 -= (f32x2){Lb7[0], Lb7[1]} * xj2;
      X15 -= (f32x2){Lb7[2], Lb7[3]} * xj2;
      X16 -= (f32x2){Lb8[0], Lb8[1]} * xj2;
      X17 -= (f32x2){Lb8[2], Lb8[3]} * xj2;
      X18 -= (f32x2){Lb9[0], Lb9[1]} * xj2;
      X19 -= (f32x2){Lb9[2], Lb9[3]} * xj2;
      X20 -= (f32x2){Lb10[0], Lb10[1]} * xj2;
      X21 -= (f32x2){Lb10[2], Lb10[3]} * xj2;
      X22 -= (f32x2){Lb11[0], Lb11[1]} * xj2;
      X23 -= (f32x2){Lb11[2], Lb11[3]} * xj2;
      X24 -= (f32x2){Lb12[0], Lb12[1]} * xj2;
      X25 -= (f32x2){Lb12[2], Lb12[3]} * xj2;
      X26 -= (f32x2){Lb13[0], Lb13[1]} * xj2;
      X27 -= (f32x2){Lb13[2], Lb13[3]} * xj2;
      X28 -= (f32x2){Lb14[0], Lb14[1]} * xj2;
      X29 -= (f32x2){Lb14[2], Lb14[3]} * xj2;
      X30 -= (f32x2){Lb15[0], Lb15[1]} * xj2;
      X31 -= (f32x2){Lb15[2], Lb15[3]} * xj2;
    }
    __builtin_amdgcn_sched_barrier(0);
    Lb3 = *(const f32x4*)(Lt_s + 896);
    Lb4 = *(const f32x4*)(Lt_s + 900);
    Lb5 = *(const f32x4*)(Lt_s + 904);
    Lb6 = *(const f32x4*)(Lt_s + 908);
    Lb7 = *(const f32x4*)(Lt_s + 912);
    Lb8 = *(const f32x4*)(Lt_s + 916);
    Lb9 = *(const f32x4*)(Lt_s + 920);
    Lb10 = *(const f32x4*)(Lt_s + 924);
    Lb11 = *(const f32x4*)(Lt_s + 928);
    Lb12 = *(const f32x4*)(Lt_s + 932);
    Lb13 = *(const f32x4*)(Lt_s + 936);
    Lb14 = *(const f32x4*)(Lt_s + 940);
    Lb15 = *(const f32x4*)(Lt_s + 944);
    __builtin_amdgcn_sched_barrier(0);
    { const float xj = X6[0]; const f32x2 xj2 = (f32x2){xj, xj};
      X6 -= (f32x2){La3[0], La3[1]} * xj2;
      X7 -= (f32x2){La3[2], La3[3]} * xj2;
      X8 -= (f32x2){La4[0], La4[1]} * xj2;
      X9 -= (f32x2){La4[2], La4[3]} * xj2;
      X10 -= (f32x2){La5[0], La5[1]} * xj2;
      X11 -= (f32x2){La5[2], La5[3]} * xj2;
      X12 -= (f32x2){La6[0], La6[1]} * xj2;
      X13 -= (f32x2){La6[2], La6[3]} * xj2;
      X14 -= (f32x2){La7[0], La7[1]} * xj2;
      X15 -= (f32x2){La7[2], La7[3]} * xj2;
      X16 -= (f32x2){La8[0], La8[1]} * xj2;
      X17 -= (f32x2){La8[2], La8[3]} * xj2;
      X18 -= (f32x2){La9[0], La9[1]} * xj2;
      X19 -= (f32x2){La9[2], La9[3]} * xj2;
      X20 -= (f32x2){La10[0], La10[1]} * xj2;
      X21 -= (f32x2){La10[2], La10[3]} * xj2;
      X22 -= (f32x2){La11[0], La11[1]} * xj2;
      X23 -= (f32x2){La11[2], La11[3]} * xj2;
      X24 -= (f32x2){La12[0], La12[1]} * xj2;
      X25 -= (f32x2){La12[2], La12[3]} * xj2;
      X26 -= (f32x2){La13[0], La13[1]} * xj2;
      X27 -= (f32x2){La13[2], La13[3]} * xj2;
      X28 -= (f32x2){La14[0], La14[1]} * xj2;
      X29 -= (f32x2){La14[2], La14[3]} * xj2;
      X30 -= (f32x2){La15[0], La15[1]} * xj2;
      X31 -= (f32x2){La15[2], La15[3]} * xj2;
    }
    __builtin_amdgcn_sched_barrier(0);
    La3 = *(const f32x4*)(Lt_s + 964);
    La4 = *(const f32x4*)(Lt_s + 968);
    La5 = *(const f32x4*)(Lt_s + 972);
    La6 = *(const f32x4*)(Lt_s + 976);
    La7 = *(const f32x4*)(Lt_s + 980);
    La8 = *(const f32x4*)(Lt_s + 984);
    La9 = *(const f32x4*)(Lt_s + 988);
    La10 = *(const f32x4*)(Lt_s + 992);
    La11 = *(const f32x4*)(Lt_s + 996);
    La12 = *(const f32x4*)(Lt_s + 1000);
    La13 = *(const f32x4*)(Lt_s + 1004);
    La14 = *(const f32x4*)(Lt_s + 1008);
    La15 = *(const f32x4*)(Lt_s + 1012);
    __builtin_amdgcn_sched_barrier(0);
    { const float xj = X6[1]; const f32x2 xj2 = (f32x2){xj, xj};
      X7 -= (f32x2){Lb3[2], Lb3[3]} * xj2;
      X8 -= (f32x2){Lb4[0], Lb4[1]} * xj2;
      X9 -= (f32x2){Lb4[2], Lb4[3]} * xj2;
      X10 -= (f32x2){Lb5[0], Lb5[1]} * xj2;
      X11 -= (f32x2){Lb5[2], Lb5[3]} * xj2;
      X12 -= (f32x2){Lb6[0], Lb6[1]} * xj2;
      X13 -= (f32x2){Lb6[2], Lb6[3]} * xj2;
      X14 -= (f32x2){Lb7[0], Lb7[1]} * xj2;
      X15 -= (f32x2){Lb7[2], Lb7[3]} * xj2;
      X16 -= (f32x2){Lb8[0], Lb8[1]} * xj2;
      X17 -= (f32x2){Lb8[2], Lb8[3]} * xj2;
      X18 -= (f32x2){Lb9[0], Lb9[1]} * xj2;
      X19 -= (f32x2){Lb9[2], Lb9[3]} * xj2;
      X20 -= (f32x2){Lb10[0], Lb10[1]} * xj2;
      X21 -= (f32x2){Lb10[2], Lb10[3]} * xj2;
      X22 -= (f32x2){Lb11[0], Lb11[1]} * xj2;
      X23 -= (f32x2){Lb11[2], Lb11[3]} * xj2;
      X24 -= (f32x2){Lb12[0], Lb12[1]} * xj2;
      X25 -= (f32x2){Lb12[2], Lb12[3]} * xj2;
      X26 -= (f32x2){Lb13[0], Lb13[1]} * xj2;
      X27 -= (f32x2){Lb13[2], Lb13[3]} * xj2;
      X28 -= (f32x2){Lb14[0], Lb14[1]} * xj2;
      X29 -= (f32x2){Lb14[2], Lb14[3]} * xj2;
      X30 -= (f32x2){Lb15[0], Lb15[1]} * xj2;
      X31 -= (f32x2){Lb15[2], Lb15[3]} * xj2;
    }
    __builtin_amdgcn_sched_barrier(0);
    Lb4 = *(const f32x4*)(Lt_s + 1036);
    Lb5 = *(const f32x4*)(Lt_s + 1040);
    Lb6 = *(const f32x4*)(Lt_s + 1044);
    Lb7 = *(const f32x4*)(Lt_s + 1048);
    Lb8 = *(const f32x4*)(Lt_s + 1052);
    Lb9 = *(const f32x4*)(Lt_s + 1056);
    Lb10 = *(const f32x4*)(Lt_s + 1060);
    Lb11 = *(const f32x4*)(Lt_s + 1064);
    Lb12 = *(const f32x4*)(Lt_s + 1068);
    Lb13 = *(const f32x4*)(Lt_s + 1072);
    Lb14 = *(const f32x4*)(Lt_s + 1076);
    Lb15 = *(const f32x4*)(Lt_s + 1080);
    __builtin_amdgcn_sched_barrier(0);
    { const float xj = X7[0]; const f32x2 xj2 = (f32x2){xj, xj};
      X7 -= (f32x2){La3[2], La3[3]} * xj2;
      X8 -= (f32x2){La4[0], La4[1]} * xj2;
      X9 -= (f32x2){La4[2], La4[3]} * xj2;
      X10 -= (f32x2){La5[0], La5[1]} * xj2;
      X11 -= (f32x2){La5[2], La5[3]} * xj2;
      X12 -= (f32x2){La6[0], La6[1]} * xj2;
      X13 -= (f32x2){La6[2], La6[3]} * xj2;
      X14 -= (f32x2){La7[0], La7[1]} * xj2;
      X15 -= (f32x2){La7[2], La7[3]} * xj2;
      X16 -= (f32x2){La8[0], La8[1]} * xj2;
      X17 -= (f32x2){La8[2], La8[3]} * xj2;
      X18 -= (f32x2){La9[0], La9[1]} * xj2;
      X19 -= (f32x2){La9[2], La9[3]} * xj2;
      X20 -= (f32x2){La10[0], La10[1]} * xj2;
      X21 -= (f32x2){La10[2], La10[3]} * xj2;
      X22 -= (f32x2){La11[0], La11[1]} * xj2;
      X23 -= (f32x2){La11[2], La11[3]} * xj2;
      X24 -= (f32x2){La12[0], La12[1]} * xj2;
      X25 -= (f32x2){La12[2], La12[3]} * xj2;
      X26 -= (f32x2){La13[0], La13[1]} * xj2;
      X27 -= (f32x2){La13[2], La13[3]} * xj2;
      X28 -= (f32x2){La14[0], La14[1]} * xj2;
      X29 -= (f32x2){La14[2], La14[3]} * xj2;
      X30 -= (f32x2){La15[0], La15[1]} * xj2;
      X31 -= (f32x2){La15[2], La15[3]} * xj2;
    }
    __builtin_amdgcn_sched_barrier(0);
    La4 = *(const f32x4*)(Lt_s + 1104);
    La5 = *(const f32x4*)(Lt_s + 1108);
    La6 = *(const f32x4*)(Lt_s + 1112);
    La7 = *(const f32x4*)(Lt_s + 1116);
    La8 = *(const f32x4*)(Lt_s + 1120);
    La9 = *(const f32x4*)(Lt_s + 1124);
    La10 = *(const f32x4*)(Lt_s + 1128);
    La11 = *(const f32x4*)(Lt_s + 1132);
    La12 = *(const f32x4*)(Lt_s + 1136);
    La13 = *(const f32x4*)(Lt_s + 1140);
    La14 = *(const f32x4*)(Lt_s + 1144);
    La15 = *(const f32x4*)(Lt_s + 1148);
    __builtin_amdgcn_sched_barrier(0);
    { const float xj = X7[1]; const f32x2 xj2 = (f32x2){xj, xj};
      X8 -= (f32x2){Lb4[0], Lb4[1]} * xj2;
      X9 -= (f32x2){Lb4[2], Lb4[3]} * xj2;
      X10 -= (f32x2){Lb5[0], Lb5[1]} * xj2;
      X11 -= (f32x2){Lb5[2], Lb5[3]} * xj2;
      X12 -= (f32x2){Lb6[0], Lb6[1]} * xj2;
      X13 -= (f32x2){Lb6[2], Lb6[3]} * xj2;
      X14 -= (f32x2){Lb7[0], Lb7[1]} * xj2;
      X15 -= (f32x2){Lb7[2], Lb7[3]} * xj2;
      X16 -= (f32x2){Lb8[0], Lb8[1]} * xj2;
      X17 -= (f32x2){Lb8[2], Lb8[3]} * xj2;
      X18 -= (f32x2){Lb9[0], Lb9[1]} * xj2;
      X19 -= (f32x2){Lb9[2], Lb9[3]} * xj2;
      X20 -= (f32x2){Lb10[0], Lb10[1]} * xj2;
      X21 -= (f32x2){Lb10[2], Lb10[3]} * xj2;
      X22 -= (f32x2){Lb11[0], Lb11[1]} * xj2;
      X23 -= (f32x2){Lb11[2], Lb11[3]} * xj2;
      X24 -= (f32x2){Lb12[0], Lb12[1]} * xj2;
      X25 -= (f32x2){Lb12[2], Lb12[3]} * xj2;
      X26 -= (f32x2){Lb13[0], Lb13[1]} * xj2;
      X27 -= (f32x2){Lb13[2], Lb13[3]} * xj2;
      X28 -= (f32x2){Lb14[0], Lb14[1]} * xj2;
      X29 -= (f32x2){Lb14[2], Lb14[3]} * xj2;
      X30 -= (f32x2){Lb15[0], Lb15[1]} * xj2;
      X31 -= (f32x2){Lb15[2], Lb15[3]} * xj2;
    }
    __builtin_amdgcn_sched_barrier(0);
    Lb4 = *(const f32x4*)(Lt_s + 1172);
    Lb5 = *(const f32x4*)(Lt_s + 1176);
    Lb6 = *(const f32x4*)(Lt_s + 1180);
    Lb7 = *(const f32x4*)(Lt_s + 1184);
    Lb8 = *(const f32x4*)(Lt_s + 1188);
    Lb9 = *(const f32x4*)(Lt_s + 1192);
    Lb10 = *(const f32x4*)(Lt_s + 1196);
    Lb11 = *(const f32x4*)(Lt_s + 1200);
    Lb12 = *(const f32x4*)(Lt_s + 1204);
    Lb13 = *(const f32x4*)(Lt_s + 1208);
    Lb14 = *(const f32x4*)(Lt_s + 1212);
    Lb15 = *(const f32x4*)(Lt_s + 1216);
    __builtin_amdgcn_sched_barrier(0);
    { const float xj = X8[0]; const f32x2 xj2 = (f32x2){xj, xj};
      X8 -= (f32x2){La4[0], La4[1]} * xj2;
      X9 -= (f32x2){La4[2], La4[3]} * xj2;
      X10 -= (f32x2){La5[0], La5[1]} * xj2;
      X11 -= (f32x2){La5[2], La5[3]} * xj2;
      X12 -= (f32x2){La6[0], La6[1]} * xj2;
      X13 -= (f32x2){La6[2], La6[3]} * xj2;
      X14 -= (f32x2){La7[0], La7[1]} * xj2;
      X15 -= (f32x2){La7[2], La7[3]} * xj2;
      X16 -= (f32x2){La8[0], La8[1]} * xj2;
      X17 -= (f32x2){La8[2], La8[3]} * xj2;
      X18 -= (f32x2){La9[0], La9[1]} * xj2;
      X19 -= (f32x2){La9[2], La9[3]} * xj2;
      X20 -= (f32x2){La10[0], La10[1]} * xj2;
      X21 -= (f32x2){La10[2], La10[3]} * xj2;
      X22 -= (f32x2){La11[0], La11[1]} * xj2;
      X23 -= (f32x2){La11[2], La11[3]} * xj2;
      X24 -= (f32x2){La12[0], La12[1]} * xj2;
      X25 -= (f32x2){La12[2], La12[3]} * xj2;
      X26 -= (f32x2){La13[0], La13[1]} * xj2;
      X27 -= (f32x2){La13[2], La13[3]} * xj2;
      X28 -= (f32x2){La14[0], La14[1]} * xj2;
      X29 -= (f32x2){La14[2], La14[3]} * xj2;
      X30 -= (f32x2){La15[0], La15[1]} * xj2;
      X31 -= (f32x2){La15[2], La15[3]} * xj2;
    }
    __builtin_amdgcn_sched_barrier(0);
    La4 = *(const f32x4*)(Lt_s + 1240);
    La5 = *(const f32x4*)(Lt_s + 1244);
    La6 = *(const f32x4*)(Lt_s + 1248);
    La7 = *(const f32x4*)(Lt_s + 1252);
    La8 = *(const f32x4*)(Lt_s + 1256);
    La9 = *(const f32x4*)(Lt_s + 1260);
    La10 = *(const f32x4*)(Lt_s + 1264);
    La11 = *(const f32x4*)(Lt_s + 1268);
    La12 = *(const f32x4*)(Lt_s + 1272);
    La13 = *(const f32x4*)(Lt_s + 1276);
    La14 = *(const f32x4*)(Lt_s + 1280);
    La15 = *(const f32x4*)(Lt_s + 1284);
    __builtin_amdgcn_sched_barrier(0);
    { const float xj = X8[1]; const f32x2 xj2 = (f32x2){xj, xj};
      X9 -= (f32x2){Lb4[2], Lb4[3]} * xj2;
      X10 -= (f32x2){Lb5[0], Lb5[1]} * xj2;
      X11 -= (f32x2){Lb5[2], Lb5[3]} * xj2;
      X12 -= (f32x2){Lb6[0], Lb6[1]} * xj2;
      X13 -= (f32x2){Lb6[2], Lb6[3]} * xj2;
      X14 -= (f32x2){Lb7[0], Lb7[1]} * xj2;
      X15 -= (f32x2){Lb7[2], Lb7[3]} * xj2;
      X16 -= (f32x2){Lb8[0], Lb8[1]} * xj2;
      X17 -= (f32x2){Lb8[2], Lb8[3]} * xj2;
      X18 -= (f32x2){Lb9[0], Lb9[1]} * xj2;
      X19 -= (f32x2){Lb9[2], Lb9[3]} * xj2;
      X20 -= (f32x2){Lb10[0], Lb10[1]} * xj2;
      X21 -= (f32x2){Lb10[2], Lb10[3]} * xj2;
      X22 -= (f32x2){Lb11[0], Lb11[1]} * xj2;
      X23 -= (f32x2){Lb11[2], Lb11[3]} * xj2;
      X24 -= (f32x2){Lb12[0], Lb12[1]} * xj2;
      X25 -= (f32x2){Lb12[2], Lb12[3]} * xj2;
      X26 -= (f32x2){Lb13[0], Lb13[1]} * xj2;
      X27 -= (f32x2){Lb13[2], Lb13[3]} * xj2;
      X28 -= (f32x2){Lb14[0], Lb14[1]} * xj2;
      X29 -= (f32x2){Lb14[2], Lb14[3]} * xj2;
      X30 -= (f32x2){Lb15[0], Lb15[1]} * xj2;
      X31 -= (f32x2){Lb15[2], Lb15[3]} * xj2;
    }
    __builtin_amdgcn_sched_barrier(0);
    Lb5 = *(const f32x4*)(Lt_s + 1312);
    Lb6 = *(const f32x4*)(Lt_s + 1316);
    Lb7 = *(const f32x4*)(Lt_s + 1320);
    Lb8 = *(const f32x4*)(Lt_s + 1324);
    Lb9 = *(const f32x4*)(Lt_s + 1328);
    Lb10 = *(const f32x4*)(Lt_s + 1332);
    Lb11 = *(const f32x4*)(Lt_s + 1336);
    Lb12 = *(const f32x4*)(Lt_s + 1340);
    Lb13 = *(const f32x4*)(Lt_s + 1344);
    Lb14 = *(const f32x4*)(Lt_s + 1348);
    Lb15 = *(const f32x4*)(Lt_s + 1352);
    __builtin_amdgcn_sched_barrier(0);
    { const float xj = X9[0]; const f32x2 xj2 = (f32x2){xj, xj};
      X9 -= (f32x2){La4[2], La4[3]} * xj2;
      X10 -= (f32x2){La5[0], La5[1]} * xj2;
      X11 -= (f32x2){La5[2], La5[3]} * xj2;
      X12 -= (f32x2){La6[0], La6[1]} * xj2;
      X13 -= (f32x2){La6[2], La6[3]} * xj2;
      X14 -= (f32x2){La7[0], La7[1]} * xj2;
      X15 -= (f32x2){La7[2], La7[3]} * xj2;
      X16 -= (f32x2){La8[0], La8[1]} * xj2;
      X17 -= (f32x2){La8[2], La8[3]} * xj2;
      X18 -= (f32x2){La9[0], La9[1]} * xj2;
      X19 -= (f32x2){La9[2], La9[3]} * xj2;
      X20 -= (f32x2){La10[0], La10[1]} * xj2;
      X21 -= (f32x2){La10[2], La10[3]} * xj2;
      X22 -= (f32x2){La11[0], La11[1]} * xj2;
      X23 -= (f32x2){La11[2], La11[3]} * xj2;
      X24 -= (f32x2){La12[0], La12[1]} * xj2;
      X25 -= (f32x2){La12[2], La12[3]} * xj2;
      X26 -= (f32x2){La13[0], La13[1]} * xj2;
      X27 -= (f32x2){La13[2], La13[3]} * xj2;
      X28 -= (f32x2){La14[0], La14[1]} * xj2;
      X29 -= (f32x2){La14[2], La14[3]} * xj2;
      X30 -= (f32x2){La15[0], La15[1]} * xj2;
      X31 -= (f32x2){La15[2], La15[3]} * xj2;
    }
    __builtin_amdgcn_sched_barrier(0);
    La5 = *(const f32x4*)(Lt_s + 1380);
    La6 = *(const f32x4*)(Lt_s + 1384);
    La7 = *(const f32x4*)(Lt_s + 1388);
    La8 = *(const f32x4*)(Lt_s + 1392);
    La9 = *(const f32x4*)(Lt_s + 1396);
    La10 = *(const f32x4*)(Lt_s + 1400);
    La11 = *(const f32x4*)(Lt_s + 1404);
    La12 = *(const f32x4*)(Lt_s + 1408);
    La13 = *(const f32x4*)(Lt_s + 1412);
    La14 = *(const f32x4*)(Lt_s + 1416);
    La15 = *(const f32x4*)(Lt_s + 1420);
    __builtin_amdgcn_sched_barrier(0);
    { const float xj = X9[1]; const f32x2 xj2 = (f32x2){xj, xj};
      X10 -= (f32x2){Lb5[0], Lb5[1]} * xj2;
      X11 -= (f32x2){Lb5[2], Lb5[3]} * xj2;
      X12 -= (f32x2){Lb6[0], Lb6[1]} * xj2;
      X13 -= (f32x2){Lb6[2], Lb6[3]} * xj2;
      X14 -= (f32x2){Lb7[0], Lb7[1]} * xj2;
      X15 -= (f32x2){Lb7[2], Lb7[3]} * xj2;
      X16 -= (f32x2){Lb8[0], Lb8[1]} * xj2;
      X17 -= (f32x2){Lb8[2], Lb8[3]} * xj2;
      X18 -= (f32x2){Lb9[0], Lb9[1]} * xj2;
      X19 -= (f32x2){Lb9[2], Lb9[3]} * xj2;
      X20 -= (f32x2){Lb10[0], Lb10[1]} * xj2;
      X21 -= (f32x2){Lb10[2], Lb10[3]} * xj2;
      X22 -= (f32x2){Lb11[0], Lb11[1]} * xj2;
      X23 -= (f32x2){Lb11[2], Lb11[3]} * xj2;
      X24 -= (f32x2){Lb12[0], Lb12[1]} * xj2;
      X25 -= (f32x2){Lb12[2], Lb12[3]} * xj2;
      X26 -= (f32x2){Lb13[0], Lb13[1]} * xj2;
      X27 -= (f32x2){Lb13[2], Lb13[3]} * xj2;
      X28 -= (f32x2){Lb14[0], Lb14[1]} * xj2;
      X29 -= (f32x2){Lb14[2], Lb14[3]} * xj2;
      X30 -= (f32x2){Lb15[0], Lb15[1]} * xj2;
      X31 -= (f32x2){Lb15[2], Lb15[3]} * xj2;
    }
    __builtin_amdgcn_sched_barrier(0);
    Lb5 = *(const f32x4*)(Lt_s + 1448);
    Lb6 = *(const f32x4*)(Lt_s + 1452);
    Lb7 = *(const f32x4*)(Lt_s + 1456);
    Lb8 = *(const f32x4*)(Lt_s + 1460);
    Lb9 = *(const f32x4*)(Lt_s + 1464);
    Lb10 = *(const f32x4*)(Lt_s + 1468);
    Lb11 = *(const f32x4*)(Lt_s + 1472);
    Lb12 = *(const f32x4*)(Lt_s + 1476);
    Lb13 = *(const f32x4*)(Lt_s + 1480);
    Lb14 = *(const f32x4*)(Lt_s + 1484);
    Lb15 = *(const f32x4*)(Lt_s + 1488);
    __builtin_amdgcn_sched_barrier(0);
    { const float xj = X10[0]; const f32x2 xj2 = (f32x2){xj, xj};
      X10 -= (f32x2){La5[0], La5[1]} * xj2;
      X11 -= (f32x2){La5[2], La5[3]} * xj2;
      X12 -= (f32x2){La6[0], La6[1]} * xj2;
      X13 -= (f32x2){La6[2], La6[3]} * xj2;
      X14 -= (f32x2){La7[0], La7[1]} * xj2;
      X15 -= (f32x2){La7[2], La7[3]} * xj2;
      X16 -= (f32x2){La8[0], La8[1]} * xj2;
      X17 -= (f32x2){La8[2], La8[3]} * xj2;
      X18 -= (f32x2){La9[0], La9[1]} * xj2;
      X19 -= (f32x2){La9[2], La9[3]} * xj2;
      X20 -= (f32x2){La10[0], La10[1]} * xj2;
      X21 -= (f32x2){La10[2], La10[3]} * xj2;
      X22 -= (f32x2){La11[0], La11[1]} * xj2;
      X23 -= (f32x2){La11[2], La11[3]} * xj2;
      X24 -= (f32x2){La12[0], La12[1]} * xj2;
      X25 -= (f32x2){La12[2], La12[3]} * xj2;
      X26 -= (f32x2){La13[0], La13[1]} * xj2;
      X27 -= (f32x2){La13[2], La13[3]} * xj2;
      X28 -= (f32x2){La14[0], La14[1]} * xj2;
      X29 -= (f32x2){La14[2], La14[3]} * xj2;
      X30 -= (f32x2){La15[0], La15[1]} * xj2;
      X31 -= (f32x2){La15[2], La15[3]} * xj2;
    }
    __builtin_amdgcn_sched_barrier(0);
    La5 = *(const f32x4*)(Lt_s + 1516);
    La6 = *(const f32x4*)(Lt_s + 1520);
    La7 = *(const f32x4*)(Lt_s + 1524);
    La8 = *(const f32x4*)(Lt_s + 1528);
    La9 = *(const f32x4*)(Lt_s + 1532);
    La10 = *(const f32x4*)(Lt_s + 1536);
    La11 = *(const f32x4*)(Lt_s + 1540);
    La12 = *(const f32x4*)(Lt_s + 1544);
    La13 = *(const f32x4*)(Lt_s + 1548);
    La14 = *(const f32x4*)(Lt_s + 1552);
    La15 = *(const f32x4*)(Lt_s + 1556);
    __builtin_amdgcn_sched_barrier(0);
    { const float xj = X10[1]; const f32x2 xj2 = (f32x2){xj, xj};
      X11 -= (f32x2){Lb5[2], Lb5[3]} * xj2;
      X12 -= (f32x2){Lb6[0], Lb6[1]} * xj2;
      X13 -= (f32x2){Lb6[2], Lb6[3]} * xj2;
      X14 -= (f32x2){Lb7[0], Lb7[1]} * xj2;
      X15 -= (f32x2){Lb7[2], Lb7[3]} * xj2;
      X16 -= (f32x2){Lb8[0], Lb8[1]} * xj2;
      X17 -= (f32x2){Lb8[2], Lb8[3]} * xj2;
      X18 -= (f32x2){Lb9[0], Lb9[1]} * xj2;
      X19 -= (f32x2){Lb9[2], Lb9[3]} * xj2;
      X20 -= (f32x2){Lb10[0], Lb10[1]} * xj2;
      X21 -= (f32x2){Lb10[2], Lb10[3]} * xj2;
      X22 -= (f32x2){Lb11[0], Lb11[1]} * xj2;
      X23 -= (f32x2){Lb11[2], Lb11[3]} * xj2;
      X24 -= (f32x2){Lb12[0], Lb12[1]} * xj2;
      X25 -= (f32x2){Lb12[2], Lb12[3]} * xj2;
      X26 -= (f32x2){Lb13[0], Lb13[1]} * xj2;
      X27 -= (f32x2){Lb13[2], Lb13[3]} * xj2;
      X28 -= (f32x2){Lb14[0], Lb14[1]} * xj2;
      X29 -= (f32x2){Lb14[2], Lb14[3]} * xj2;
      X30 -= (f32x2){Lb15[0], Lb15[1]} * xj2;
      X31 -= (f32x2){Lb15[2], Lb15[3]} * xj2;
    }
    __builtin_amdgcn_sched_barrier(0);
    Lb6 = *(const f32x4*)(Lt_s + 1588);
    Lb7 = *(const f32x4*)(Lt_s + 1592);
    Lb8 = *(const f32x4*)(Lt_s + 1596);
    Lb9 = *(const f32x4*)(Lt_s + 1600);
    Lb10 = *(const f32x4*)(Lt_s + 1604);
    Lb11 = *(const f32x4*)(Lt_s + 1608);
    Lb12 = *(const f32x4*)(Lt_s + 1612);
    Lb13 = *(const f32x4*)(Lt_s + 1616);
    Lb14 = *(const f32x4*)(Lt_s + 1620);
    Lb15 = *(const f32x4*)(Lt_s + 1624);
    __builtin_amdgcn_sched_barrier(0);
    { const float xj = X11[0]; const f32x2 xj2 = (f32x2){xj, xj};
      X11 -= (f32x2){La5[2], La5[3]} * xj2;
      X12 -= (f32x2){La6[0], La6[1]} * xj2;
      X13 -= (f32x2){La6[2], La6[3]} * xj2;
      X14 -= (f32x2){La7[0], La7[1]} * xj2;
      X15 -= (f32x2){La7[2], La7[3]} * xj2;
      X16 -= (f32x2){La8[0], La8[1]} * xj2;
      X17 -= (f32x2){La8[2], La8[3]} * xj2;
      X18 -= (f32x2){La9[0], La9[1]} * xj2;
      X19 -= (f32x2){La9[2], La9[3]} * xj2;
      X20 -= (f32x2){La10[0], La10[1]} * xj2;
      X21 -= (f32x2){La10[2], La10[3]} * xj2;
      X22 -= (f32x2){La11[0], La11[1]} * xj2;
      X23 -= (f32x2){La11[2], La11[3]} * xj2;
      X24 -= (f32x2){La12[0], La12[1]} * xj2;
      X25 -= (f32x2){La12[2], La12[3]} * xj2;
      X26 -= (f32x2){La13[0], La13[1]} * xj2;
      X27 -= (f32x2){La13[2], La13[3]} * xj2;
      X28 -= (f32x2){La14[0], La14[1]} * xj2;
      X29 -= (f32x2){La14[2], La14[3]} * xj2;
      X30 -= (f32x2){La15[0], La15[1]} * xj2;
      X31 -= (f32x2){La15[2], La15[3]} * xj2;
    }
    __builtin_amdgcn_sched_barrier(0);
    La6 = *(const f32x4*)(Lt_s + 1656);
    La7 = *(const f32x4*)(Lt_s + 1660);
    La8 = *(const f32x4*)(Lt_s + 1664);
    La9 = *(const f32x4*)(Lt_s + 1668);
    La10 = *(const f32x4*)(Lt_s + 1672);
    La11 = *(const f32x4*)(Lt_s + 1676);
    La12 = *(const f32x4*)(Lt_s + 1680);
    La13 = *(const f32x4*)(Lt_s + 1684);
    La14 = *(const f32x4*)(Lt_s + 1688);
    La15 = *(const f32x4*)(Lt_s + 1692);
    __builtin_amdgcn_sched_barrier(0);
    { const float xj = X11[1]; const f32x2 xj2 = (f32x2){xj, xj};
      X12 -= (f32x2){Lb6[0], Lb6[1]} * xj2;
      X13 -= (f32x2){Lb6[2], Lb6[3]} * xj2;
      X14 -= (f32x2){Lb7[0], Lb7[1]} * xj2;
      X15 -= (f32x2){Lb7[2], Lb7[3]} * xj2;
      X16 -= (f32x2){Lb8[0], Lb8[1]} * xj2;
      X17 -= (f32x2){Lb8[2], Lb8[3]} * xj2;
      X18 -= (f32x2){Lb9[0], Lb9[1]} * xj2;
      X19 -= (f32x2){Lb9[2], Lb9[3]} * xj2;
      X20 -= (f32x2){Lb10[0], Lb10[1]} * xj2;
      X21 -= (f32x2){Lb10[2], Lb10[3]} * xj2;
      X22 -= (f32x2){Lb11[0], Lb11[1]} * xj2;
      X23 -= (f32x2){Lb11[2], Lb11[3]} * xj2;
      X24 -= (f32x2){Lb12[0], Lb12[1]} * xj2;
      X25 -= (f32x2){Lb12[2], Lb12[3]} * xj2;
      X26 -= (f32x2){Lb13[0], Lb13[1]} * xj2;
      X27 -= (f32x2){Lb13[2], Lb13[3]} * xj2;
      X28 -= (f32x2){Lb14[0], Lb14[1]} * xj2;
      X29 -= (f32x2){Lb14[2], Lb14[3]} * xj2;
      X30 -= (f32x2){Lb15[0], Lb15[1]} * xj2;
      X31 -= (f32x2){Lb15[2], Lb15[3]} * xj2;
    }
    __builtin_amdgcn_sched_barrier(0);
    Lb6 = *(const f32x4*)(Lt_s + 1724);
    Lb7 = *(const f32x4*)(Lt_s + 1728);
    Lb8 = *(const f32x4*)(Lt_s + 1732);
    Lb9 = *(const f32x4*)(Lt_s + 1736);
    Lb10 = *(const f32x4*)(Lt_s + 1740);
    Lb11 = *(const f32x4*)(Lt_s + 1744);
    Lb12 = *(const f32x4*)(Lt_s + 1748);
    Lb13 = *(const f32x4*)(Lt_s + 1752);
    Lb14 = *(const f32x4*)(Lt_s + 1756);
    Lb15 = *(const f32x4*)(Lt_s + 1760);
    __builtin_amdgcn_sched_barrier(0);
    { const float xj = X12[0]; const f32x2 xj2 = (f32x2){xj, xj};
      X12 -= (f32x2){La6[0], La6[1]} * xj2;
      X13 -= (f32x2){La6[2], La6[3]} * xj2;
      X14 -= (f32x2){La7[0], La7[1]} * xj2;
      X15 -= (f32x2){La7[2], La7[3]} * xj2;
      X16 -= (f32x2){La8[0], La8[1]} * xj2;
      X17 -= (f32x2){La8[2], La8[3]} * xj2;
      X18 -= (f32x2){La9[0], La9[1]} * xj2;
      X19 -= (f32x2){La9[2], La9[3]} * xj2;
      X20 -= (f32x2){La10[0], La10[1]} * xj2;
      X21 -= (f32x2){La10[2], La10[3]} * xj2;
      X22 -= (f32x2){La11[0], La11[1]} * xj2;
      X23 -= (f32x2){La11[2], La11[3]} * xj2;
      X24 -= (f32x2){La12[0], La12[1]} * xj2;
      X25 -= (f32x2){La12[2], La12[3]} * xj2;
      X26 -= (f32x2){La13[0], La13[1]} * xj2;
      X27 -= (f32x2){La13[2], La13[3]} * xj2;
      X28 -= (f32x2){La14[0], La14[1]} * xj2;
      X29 -= (f32x2){La14[2], La14[3]} * xj2;
      X30 -= (f32x2){La15[0], La15[1]} * xj2;
      X31 -= (f32x2){La15[2], La15[3]} * xj2;
    }
    __builtin_amdgcn_sched_barrier(0);
    La6 = *(const f32x4*)(Lt_s + 1792);
    La7 = *(const f32x4*)(Lt_s + 1796);
    La8 = *(const f32x4*)(Lt_s + 1800);
    La9 = *(const f32x4*)(Lt_s + 1804);
    La10 = *(const f32x4*)(Lt_s + 1808);
    La11 = *(const f32x4*)(Lt_s + 1812);
    La12 = *(const f32x4*)(Lt_s + 1816);
    La13 = *(const f32x4*)(Lt_s + 1820);
    La14 = *(const f32x4*)(Lt_s + 1824);
    La15 = *(const f32x4*)(Lt_s + 1828);
    __builtin_amdgcn_sched_barrier(0);
    { const float xj = X12[1]; const f32x2 xj2 = (f32x2){xj, xj};
      X13 -= (f32x2){Lb6[2], Lb6[3]} * xj2;
      X14 -= (f32x2){Lb7[0], Lb7[1]} * xj2;
      X15 -= (f32x2){Lb7[2], Lb7[3]} * xj2;
      X16 -= (f32x2){Lb8[0], Lb8[1]} * xj2;
      X17 -= (f32x2){Lb8[2], Lb8[3]} * xj2;
      X18 -= (f32x2){Lb9[0], Lb9[1]} * xj2;
      X19 -= (f32x2){Lb9[2], Lb9[3]} * xj2;
      X20 -= (f32x2){Lb10[0], Lb10[1]} * xj2;
      X21 -= (f32x2){Lb10[2], Lb10[3]} * xj2;
      X22 -= (f32x2){Lb11[0], Lb11[1]} * xj2;
      X23 -= (f32x2){Lb11[2], Lb11[3]} * xj2;
      X24 -= (f32x2){Lb12[0], Lb12[1]} * xj2;
      X25 -= (f32x2){Lb12[2], Lb12[3]} * xj2;
      X26 -= (f32x2){Lb13[0], Lb13[1]} * xj2;
      X27 -= (f32x2){Lb13[2], Lb13[3]} * xj2;
      X28 -= (f32x2){Lb14[0], Lb14[1]} * xj2;
      X29 -= (f32x2){Lb14[2], Lb14[3]} * xj2;
      X30 -= (f32x2){Lb15[0], Lb15[1]} * xj2;
      X31 -= (f32x2){Lb15[2], Lb15[3]} * xj2;
    }
    __builtin_amdgcn_sched_barrier(0);
    Lb7 = *(const f32x4*)(Lt_s + 1864);
    Lb8 = *(const f32x4*)(Lt_s + 1868);
    Lb9 = *(const f32x4*)(Lt_s + 1872);
    Lb10 = *(const f32x4*)(Lt_s + 1876);
    Lb11 = *(const f32x4*)(Lt_s + 1880);
    Lb12 = *(const f32x4*)(Lt_s + 1884);
    Lb13 = *(const f32x4*)(Lt_s + 1888);
    Lb14 = *(const f32x4*)(Lt_s + 1892);
    Lb15 = *(const f32x4*)(Lt_s + 1896);
    __builtin_amdgcn_sched_barrier(0);
    { const float xj = X13[0]; const f32x2 xj2 = (f32x2){xj, xj};
      X13 -= (f32x2){La6[2], La6[3]} * xj2;
      X14 -= (f32x2){La7[0], La7[1]} * xj2;
      X15 -= (f32x2){La7[2], La7[3]} * xj2;
      X16 -= (f32x2){La8[0], La8[1]} * xj2;
      X17 -= (f32x2){La8[2], La8[3]} * xj2;
      X18 -= (f32x2){La9[0], La9[1]} * xj2;
      X19 -= (f32x2){La9[2], La9[3]} * xj2;
      X20 -= (f32x2){La10[0], La10[1]} * xj2;
      X21 -= (f32x2){La10[2], La10[3]} * xj2;
      X22 -= (f32x2){La11[0], La11[1]} * xj2;
      X23 -= (f32x2){La11[2], La11[3]} * xj2;
      X24 -= (f32x2){La12[0], La12[1]} * xj2;
      X25 -= (f32x2){La12[2], La12[3]} * xj2;
      X26 -= (f32x2){La13[0], La13[1]} * xj2;
      X27 -= (f32x2){La13[2], La13[3]} * xj2;
      X28 -= (f32x2){La14[0], La14[1]} * xj2;
      X29 -= (f32x2){La14[2], La14[3]} * xj2;
      X30 -= (f32x2){La15[0], La15[1]} * xj2;
      X31 -= (f32x2){La15[2], La15[3]} * xj2;
    }
    __builtin_amdgcn_sched_barrier(0);
    La7 = *(const f32x4*)(Lt_s + 1932);
    La8 = *(const f32x4*)(Lt_s + 1936);
    La9 = *(const f32x4*)(Lt_s + 1940);
    La10 = *(const f32x4*)(Lt_s + 1944);
    La11 = *(const f32x4*)(Lt_s + 1948);
    La12 = *(const f32x4*)(Lt_s + 1952);
    La13 = *(const f32x4*)(Lt_s + 1956);
    La14 = *(const f32x4*)(Lt_s + 1960);
    La15 = *(const f32x4*)(Lt_s + 1964);
    __builtin_amdgcn_sched_barrier(0);
    { const float xj = X13[1]; const f32x2 xj2 = (f32x2){xj, xj};
      X14 -= (f32x2){Lb7[0], Lb7[1]} * xj2;
      X15 -= (f32x2){Lb7[2], Lb7[3]} * xj2;
      X16 -= (f32x2){Lb8[0], Lb8[1]} * xj2;
      X17 -= (f32x2){Lb8[2], Lb8[3]} * xj2;
      X18 -= (f32x2){Lb9[0], Lb9[1]} * xj2;
      X19 -= (f32x2){Lb9[2], Lb9[3]} * xj2;
      X20 -= (f32x2){Lb10[0], Lb10[1]} * xj2;
      X21 -= (f32x2){Lb10[2], Lb10[3]} * xj2;
      X22 -= (f32x2){Lb11[0], Lb11[1]} * xj2;
      X23 -= (f32x2){Lb11[2], Lb11[3]} * xj2;
      X24 -= (f32x2){Lb12[0], Lb12[1]} * xj2;
      X25 -= (f32x2){Lb12[2], Lb12[3]} * xj2;
      X26 -= (f32x2){Lb13[0], Lb13[1]} * xj2;
      X27 -= (f32x2){Lb13[2], Lb13[3]} * xj2;
      X28 -= (f32x2){Lb14[0], Lb14[1]} * xj2;
      X29 -= (f32x2){Lb14[2], Lb14[3]} * xj2;
      X30 -= (f32x2){Lb15[0], Lb15[1]} * xj2;
      X31 -= (f32x2){Lb15[2], Lb15[3]} * xj2;
    }
    __builtin_amdgcn_sched_barrier(0);
    Lb7 = *(const f32x4*)(Lt_s + 2000);
    Lb8 = *(const f32x4*)(Lt_s + 2004);
    Lb9 = *(const f32x4*)(Lt_s + 2008);
    Lb10 = *(const f32x4*)(Lt_s + 2012);
    Lb11 = *(const f32x4*)(Lt_s + 2016);
    Lb12 = *(const f32x4*)(Lt_s + 2020);
    Lb13 = *(const f32x4*)(Lt_s + 2024);
    Lb14 = *(const f32x4*)(Lt_s + 2028);
    Lb15 = *(const f32x4*)(Lt_s + 2032);
    __builtin_amdgcn_sched_barrier(0);
    { const float xj = X14[0]; const f32x2 xj2 = (f32x2){xj, xj};
      X14 -= (f32x2){La7[0], La7[1]} * xj2;
      X15 -= (f32x2){La7[2], La7[3]} * xj2;
      X16 -= (f32x2){La8[0], La8[1]} * xj2;
      X17 -= (f32x2){La8[2], La8[3]} * xj2;
      X18 -= (f32x2){La9[0], La9[1]} * xj2;
      X19 -= (f32x2){La9[2], La9[3]} * xj2;
      X20 -= (f32x2){La10[0], La10[1]} * xj2;
      X21 -= (f32x2){La10[2], La10[3]} * xj2;
      X22 -= (f32x2){La11[0], La11[1]} * xj2;
      X23 -= (f32x2){La11[2], La11[3]} * xj2;
      X24 -= (f32x2){La12[0], La12[1]} * xj2;
      X25 -= (f32x2){La12[2], La12[3]} * xj2;
      X26 -= (f32x2){La13[0], La13[1]} * xj2;
      X27 -= (f32x2){La13[2], La13[3]} * xj2;
      X28 -= (f32x2){La14[0], La14[1]} * xj2;
      X29 -= (f32x2){La14[2], La14[3]} * xj2;
      X30 -= (f32x2){La15[0], La15[1]} * xj2;
      X31 -= (f32x2){La15[2], La15[3]} * xj2;
    }
    __builtin_amdgcn_sched_barrier(0);
    La7 = *(const f32x4*)(Lt_s + 2068);
    La8 = *(const f32x4*)(Lt_s + 2072);
    La9 = *(const f32x4*)(Lt_s + 2076);
    La10 = *(const f32x4*)(Lt_s + 2080);
    La11 = *(const f32x4*)(Lt_s + 2084);
    La12 = *(const f32x4*)(Lt_s + 2088);
    La13 = *(const f32x4*)(Lt_s + 2092);
    La14 = *(const f32x4*)(Lt_s + 2096);
    La15 = *(const f32x4*)(Lt_s + 2100);
    __builtin_amdgcn_sched_barrier(0);
    { const float xj = X14[1]; const f32x2 xj2 = (f32x2){xj, xj};
      X15 -= (f32x2){Lb7[2], Lb7[3]} * xj2;
      X16 -= (f32x2){Lb8[0], Lb8[1]} * xj2;
      X17 -= (f32x2){Lb8[2], Lb8[3]} * xj2;
      X18 -= (f32x2){Lb9[0], Lb9[1]} * xj2;
      X19 -= (f32x2){Lb9[2], Lb9[3]} * xj2;
      X20 -= (f32x2){Lb10[0], Lb10[1]} * xj2;
      X21 -= (f32x2){Lb10[2], Lb10[3]} * xj2;
      X22 -= (f32x2){Lb11[0], Lb11[1]} * xj2;
      X23 -= (f32x2){Lb11[2], Lb11[3]} * xj2;
      X24 -= (f32x2){Lb12[0], Lb12[1]} * xj2;
      X25 -= (f32x2){Lb12[2], Lb12[3]} * xj2;
      X26 -= (f32x2){Lb13[0], Lb13[1]} * xj2;
      X27 -= (f32x2){Lb13[2], Lb13[3]} * xj2;
      X28 -= (f32x2){Lb14[0], Lb14[1]} * xj2;
      X29 -= (f32x2){Lb14[2], Lb14[3]} * xj2;
      X30 -= (f32x2){Lb15[0], Lb15[1]} * xj2;
      X31 -= (f32x2){Lb15[2], Lb15[3]} * xj2;
    }
    __builtin_amdgcn_sched_barrier(0);
    Lb8 = *(const f32x4*)(Lt_s + 2140);
    Lb9 = *(const f32x4*)(Lt_s + 2144);
    Lb10 = *(const f32x4*)(Lt_s + 2148);
    Lb11 = *(const f32x4*)(Lt_s + 2152);
    Lb12 = *(const f32x4*)(Lt_s + 2156);
    Lb13 = *(const f32x4*)(Lt_s + 2160);
    Lb14 = *(const f32x4*)(Lt_s + 2164);
    Lb15 = *(const f32x4*)(Lt_s + 2168);
    __builtin_amdgcn_sched_barrier(0);
    { const float xj = X15[0]; const f32x2 xj2 = (f32x2){xj, xj};
      X15 -= (f32x2){La7[2], La7[3]} * xj2;
      X16 -= (f32x2){La8[0], La8[1]} * xj2;
      X17 -= (f32x2){La8[2], La8[3]} * xj2;
      X18 -= (f32x2){La9[0], La9[1]} * xj2;
      X19 -= (f32x2){La9[2], La9[3]} * xj2;
      X20 -= (f32x2){La10[0], La10[1]} * xj2;
      X21 -= (f32x2){La10[2], La10[3]} * xj2;
      X22 -= (f32x2){La11[0], La11[1]} * xj2;
      X23 -= (f32x2){La11[2], La11[3]} * xj2;
      X24 -= (f32x2){La12[0], La12[1]} * xj2;
      X25 -= (f32x2){La12[2], La12[3]} * xj2;
      X26 -= (f32x2){La13[0], La13[1]} * xj2;
      X27 -= (f32x2){La13[2], La13[3]} * xj2;
      X28 -= (f32x2){La14[0], La14[1]} * xj2;
      X29 -= (f32x2){La14[2], La14[3]} * xj2;
      X30 -= (f32x2){La15[0], La15[1]} * xj2;
      X31 -= (f32x2){La15[2], La15[3]} * xj2;
    }
    __builtin_amdgcn_sched_barrier(0);
    La8 = *(const f32x4*)(Lt_s + 2208);
    La9 = *(const f32x4*)(Lt_s + 2212);
    La10 = *(const f32x4*)(Lt_s + 2216);
    La11 = *(const f32x4*)(Lt_s + 2220);
    La12 = *(const f32x4*)(Lt_s + 2224);
    La13 = *(const f32x4*)(Lt_s + 2228);
    La14 = *(const f32x4*)(Lt_s + 2232);
    La15 = *(const f32x4*)(Lt_s + 2236);
    __builtin_amdgcn_sched_barrier(0);
    { const float xj = X15[1]; const f32x2 xj2 = (f32x2){xj, xj};
      X16 -= (f32x2){Lb8[0], Lb8[1]} * xj2;
      X17 -= (f32x2){Lb8[2], Lb8[3]} * xj2;
      X18 -= (f32x2){Lb9[0], Lb9[1]} * xj2;
      X19 -= (f32x2){Lb9[2], Lb9[3]} * xj2;
      X20 -= (f32x2){Lb10[0], Lb10[1]} * xj2;
      X21 -= (f32x2){Lb10[2], Lb10[3]} * xj2;
      X22 -= (f32x2){Lb11[0], Lb11[1]} * xj2;
      X23 -= (f32x2){Lb11[2], Lb11[3]} * xj2;
      X24 -= (f32x2){Lb12[0], Lb12[1]} * xj2;
      X25 -= (f32x2){Lb12[2], Lb12[3]} * xj2;
      X26 -= (f32x2){Lb13[0], Lb13[1]} * xj2;
      X27 -= (f32x2){Lb13[2], Lb13[3]} * xj2;
      X28 -= (f32x2){Lb14[0], Lb14[1]} * xj2;
      X29 -= (f32x2){Lb14[2], Lb14[3]} * xj2;
      X30 -= (f32x2){Lb15[0], Lb15[1]} * xj2;
      X31 -= (f32x2){Lb15[2], Lb15[3]} * xj2;
    }
    __builtin_amdgcn_sched_barrier(0);
    Lb8 = *(const f32x4*)(Lt_s + 2276);
    Lb9 = *(const f32x4*)(Lt_s + 2280);
    Lb10 = *(const f32x4*)(Lt_s + 2284);
    Lb11 = *(const f32x4*)(Lt_s + 2288);
    Lb12 = *(const f32x4*)(Lt_s + 2292);
    Lb13 = *(const f32x4*)(Lt_s + 2296);
    Lb14 = *(const f32x4*)(Lt_s + 2300);
    Lb15 = *(const f32x4*)(Lt_s + 2304);
    __builtin_amdgcn_sched_barrier(0);
    { const float xj = X16[0]; const f32x2 xj2 = (f32x2){xj, xj};
      X16 -= (f32x2){La8[0], La8[1]} * xj2;
      X17 -= (f32x2){La8[2], La8[3]} * xj2;
      X18 -= (f32x2){La9[0], La9[1]} * xj2;
      X19 -= (f32x2){La9[2], La9[3]} * xj2;
      X20 -= (f32x2){La10[0], La10[1]} * xj2;
      X21 -= (f32x2){La10[2], La10[3]} * xj2;
      X22 -= (f32x2){La11[0], La11[1]} * xj2;
      X23 -= (f32x2){La11[2], La11[3]} * xj2;
      X24 -= (f32x2){La12[0], La12[1]} * xj2;
      X25 -= (f32x2){La12[2], La12[3]} * xj2;
      X26 -= (f32x2){La13[0], La13[1]} * xj2;
      X27 -= (f32x2){La13[2], La13[3]} * xj2;
      X28 -= (f32x2){La14[0], La14[1]} * xj2;
      X29 -= (f32x2){La14[2], La14[3]} * xj2;
      X30 -= (f32x2){La15[0], La15[1]} * xj2;
      X31 -= (f32x2){La15[2], La15[3]} * xj2;
    }
    __builtin_amdgcn_sched_barrier(0);
    La8 = *(const f32x4*)(Lt_s + 2344);
    La9 = *(const f32x4*)(Lt_s + 2348);
    La10 = *(const f32x4*)(Lt_s + 2352);
    La11 = *(const f32x4*)(Lt_s + 2356);
    La12 = *(const f32x4*)(Lt_s + 2360);
    La13 = *(const f32x4*)(Lt_s + 2364);
    La14 = *(const f32x4*)(Lt_s + 2368);
    La15 = *(const f32x4*)(Lt_s + 2372);
    __builtin_amdgcn_sched_barrier(0);
    { const float xj = X16[1]; const f32x2 xj2 = (f32x2){xj, xj};
      X17 -= (f32x2){Lb8[2], Lb8[3]} * xj2;
      X18 -= (f32x2){Lb9[0], Lb9[1]} * xj2;
      X19 -= (f32x2){Lb9[2], Lb9[3]} * xj2;
      X20 -= (f32x2){Lb10[0], Lb10[1]} * xj2;
      X21 -= (f32x2){Lb10[2], Lb10[3]} * xj2;
      X22 -= (f32x2){Lb11[0], Lb11[1]} * xj2;
      X23 -= (f32x2){Lb11[2], Lb11[3]} * xj2;
      X24 -= (f32x2){Lb12[0], Lb12[1]} * xj2;
      X25 -= (f32x2){Lb12[2], Lb12[3]} * xj2;
      X26 -= (f32x2){Lb13[0], Lb13[1]} * xj2;
      X27 -= (f32x2){Lb13[2], Lb13[3]} * xj2;
      X28 -= (f32x2){Lb14[0], Lb14[1]} * xj2;
      X29 -= (f32x2){Lb14[2], Lb14[3]} * xj2;
      X30 -= (f32x2){Lb15[0], Lb15[1]} * xj2;
      X31 -= (f32x2){Lb15[2], Lb15[3]} * xj2;
    }
    __builtin_amdgcn_sched_barrier(0);
    Lb9 = *(const f32x4*)(Lt_s + 2416);
    Lb10 = *(const f32x4*)(Lt_s + 2420);
    Lb11 = *(const f32x4*)(Lt_s + 2424);
    Lb12 = *(const f32x4*)(Lt_s + 2428);
    Lb13 = *(const f32x4*)(Lt_s + 2432);
    Lb14 = *(const f32x4*)(Lt_s + 2436);
    Lb15 = *(const f32x4*)(Lt_s + 2440);
    __builtin_amdgcn_sched_barrier(0);
    { const float xj = X17[0]; const f32x2 xj2 = (f32x2){xj, xj};
      X17 -= (f32x2){La8[2], La8[3]} * xj2;
      X18 -= (f32x2){La9[0], La9[1]} * xj2;
      X19 -= (f32x2){La9[2], La9[3]} * xj2;
      X20 -= (f32x2){La10[0], La10[1]} * xj2;
      X21 -= (f32x2){La10[2], La10[3]} * xj2;
      X22 -= (f32x2){La11[0], La11[1]} * xj2;
      X23 -= (f32x2){La11[2], La11[3]} * xj2;
      X24 -= (f32x2){La12[0], La12[1]} * xj2;
      X25 -= (f32x2){La12[2], La12[3]} * xj2;
      X26 -= (f32x2){La13[0], La13[1]} * xj2;
      X27 -= (f32x2){La13[2], La13[3]} * xj2;
      X28 -= (f32x2){La14[0], La14[1]} * xj2;
      X29 -= (f32x2){La14[2], La14[3]} * xj2;
      X30 -= (f32x2){La15[0], La15[1]} * xj2;
      X31 -= (f32x2){La15[2], La15[3]} * xj2;
    }
    __builtin_amdgcn_sched_barrier(0);
    La9 = *(const f32x4*)(Lt_s + 2484);
    La10 = *(const f32x4*)(Lt_s + 2488);
    La11 = *(const f32x4*)(Lt_s + 2492);
    La12 = *(const f32x4*)(Lt_s + 2496);
    La13 = *(const f32x4*)(Lt_s + 2500);
    La14 = *(const f32x4*)(Lt_s + 2504);
    La15 = *(const f32x4*)(Lt_s + 2508);
    __builtin_amdgcn_sched_barrier(0);
    { const float xj = X17[1]; const f32x2 xj2 = (f32x2){xj, xj};
      X18 -= (f32x2){Lb9[0], Lb9[1]} * xj2;
      X19 -= (f32x2){Lb9[2], Lb9[3]} * xj2;
      X20 -= (f32x2){Lb10[0], Lb10[1]} * xj2;
      X21 -= (f32x2){Lb10[2], Lb10[3]} * xj2;
      X22 -= (f32x2){Lb11[0], Lb11[1]} * xj2;
      X23 -= (f32x2){Lb11[2], Lb11[3]} * xj2;
      X24 -= (f32x2){Lb12[0], Lb12[1]} * xj2;
      X25 -= (f32x2){Lb12[2], Lb12[3]} * xj2;
      X26 -= (f32x2){Lb13[0], Lb13[1]} * xj2;
      X27 -= (f32x2){Lb13[2], Lb13[3]} * xj2;
      X28 -= (f32x2){Lb14[0], Lb14[1]} * xj2;
      X29 -= (f32x2){Lb14[2], Lb14[3]} * xj2;
      X30 -= (f32x2){Lb15[0], Lb15[1]} * xj2;
      X31 -= (f32x2){Lb15[2], Lb15[3]} * xj2;
    }
    __builtin_amdgcn_sched_barrier(0);
    Lb9 = *(const f32x4*)(Lt_s + 2552);
    Lb10 = *(const f32x4*)(Lt_s + 2556);
    Lb11 = *(const f32x4*)(Lt_s + 2560);
    Lb12 = *(const f32x4*)(Lt_s + 2564);
    Lb13 = *(const f32x4*)(Lt_s + 2568);
    Lb14 = *(const f32x4*)(Lt_s + 2572);
    Lb15 = *(const f32x4*)(Lt_s + 2576);
    __builtin_amdgcn_sched_barrier(0);
    { const float xj = X18[0]; const f32x2 xj2 = (f32x2){xj, xj};
      X18 -= (f32x2){La9[0], La9[1]} * xj2;
      X19 -= (f32x2){La9[2], La9[3]} * xj2;
      X20 -= (f32x2){La10[0], La10[1]} * xj2;
      X21 -= (f32x2){La10[2], La10[3]} * xj2;
      X22 -= (f32x2){La11[0], La11[1]} * xj2;
      X23 -= (f32x2){La11[2], La11[3]} * xj2;
      X24 -= (f32x2){La12[0], La12[1]} * xj2;
      X25 -= (f32x2){La12[2], La12[3]} * xj2;
      X26 -= (f32x2){La13[0], La13[1]} * xj2;
      X27 -= (f32x2){La13[2], La13[3]} * xj2;
      X28 -= (f32x2){La14[0], La14[1]} * xj2;
      X29 -= (f32x2){La14[2], La14[3]} * xj2;
      X30 -= (f32x2){La15[0], La15[1]} * xj2;
      X31 -= (f32x2){La15[2], La15[3]} * xj2;
    }
    __builtin_amdgcn_sched_barrier(0);
    La9 = *(const f32x4*)(Lt_s + 2620);
    La10 = *(const f32x4*)(Lt_s + 2624);
    La11 = *(const f32x4*)(Lt_s + 2628);
    La12 = *(const f32x4*)(Lt_s + 2632);
    La13 = *(const f32x4*)(Lt_s + 2636);
    La14 = *(const f32x4*)(Lt_s + 2640);
    La15 = *(const f32x4*)(Lt_s + 2644);
    __builtin_amdgcn_sched_barrier(0);
    { const float xj = X18[1]; const f32x2 xj2 = (f32x2){xj, xj};
      X19 -= (f32x2){Lb9[2], Lb9[3]} * xj2;
      X20 -= (f32x2){Lb10[0], Lb10[1]} * xj2;
      X21 -= (f32x2){Lb10[2], Lb10[3]} * xj2;
      X22 -= (f32x2){Lb11[0], Lb11[1]} * xj2;
      X23 -= (f32x2){Lb11[2], Lb11[3]} * xj2;
      X24 -= (f32x2){Lb12[0], Lb12[1]} * xj2;
      X25 -= (f32x2){Lb12[2], Lb12[3]} * xj2;
      X26 -= (f32x2){Lb13[0], Lb13[1]} * xj2;
      X27 -= (f32x2){Lb13[2], Lb13[3]} * xj2;
      X28 -= (f32x2){Lb14[0], Lb14[1]} * xj2;
      X29 -= (f32x2){Lb14[2], Lb14[3]} * xj2;
      X30 -= (f32x2){Lb15[0], Lb15[1]} * xj2;
      X31 -= (f32x2){Lb15[2], Lb15[3]} * xj2;
    }
    __builtin_amdgcn_sched_barrier(0);
    Lb10 = *(const f32x4*)(Lt_s + 2692);
    Lb11 = *(const f32x4*)(Lt_s + 2696);
    Lb12 = *(const f32x4*)(Lt_s + 2700);
    Lb13 = *(const f32x4*)(Lt_s + 2704);
    Lb14 = *(const f32x4*)(Lt_s + 2708);
    Lb15 = *(const f32x4*)(Lt_s + 2712);
    __builtin_amdgcn_sched_barrier(0);
    { const float xj = X19[0]; const f32x2 xj2 = (f32x2){xj, xj};
      X19 -= (f32x2){La9[2], La9[3]} * xj2;
      X20 -= (f32x2){La10[0], La10[1]} * xj2;
      X21 -= (f32x2){La10[2], La10[3]} * xj2;
      X22 -= (f32x2){La11[0], La11[1]} * xj2;
      X23 -= (f32x2){La11[2], La11[3]} * xj2;
      X24 -= (f32x2){La12[0], La12[1]} * xj2;
      X25 -= (f32x2){La12[2], La12[3]} * xj2;
      X26 -= (f32x2){La13[0], La13[1]} * xj2;
      X27 -= (f32x2){La13[2], La13[3]} * xj2;
      X28 -= (f32x2){La14[0], La14[1]} * xj2;
      X29 -= (f32x2){La14[2], La14[3]} * xj2;
      X30 -= (f32x2){La15[0], La15[1]} * xj2;
      X31 -= (f32x2){La15[2], La15[3]} * xj2;
    }
    __builtin_amdgcn_sched_barrier(0);
    La10 = *(const f32x4*)(Lt_s + 2760);
    La11 = *(const f32x4*)(Lt_s + 2764);
    La12 = *(const f32x4*)(Lt_s + 2768);
    La13 = *(const f32x4*)(Lt_s + 2772);
    La14 = *(const f32x4*)(Lt_s + 2776);
    La15 = *(const f32x4*)(Lt_s + 2780);
    __builtin_amdgcn_sched_barrier(0);
    { const float xj = X19[1]; const f32x2 xj2 = (f32x2){xj, xj};
      X20 -= (f32x2){Lb10[0], Lb10[1]} * xj2;
      X21 -= (f32x2){Lb10[2], Lb10[3]} * xj2;
      X22 -= (f32x2){Lb11[0], Lb11[1]} * xj2;
      X23 -= (f32x2){Lb11[2], Lb11[3]} * xj2;
      X24 -= (f32x2){Lb12[0], Lb12[1]} * xj2;
      X25 -= (f32x2){Lb12[2], Lb12[3]} * xj2;
      X26 -= (f32x2){Lb13[0], Lb13[1]} * xj2;
      X27 -= (f32x2){Lb13[2], Lb13[3]} * xj2;
      X28 -= (f32x2){Lb14[0], Lb14[1]} * xj2;
      X29 -= (f32x2){Lb14[2], Lb14[3]} * xj2;
      X30 -= (f32x2){Lb15[0], Lb15[1]} * xj2;
      X31 -= (f32x2){Lb15[2], Lb15[3]} * xj2;
    }
    __builtin_amdgcn_sched_barrier(0);
    Lb10 = *(const f32x4*)(Lt_s + 2828);
    Lb11 = *(const f32x4*)(Lt_s + 2832);
    Lb12 = *(const f32x4*)(Lt_s + 2836);
    Lb13 = *(const f32x4*)(Lt_s + 2840);
    Lb14 = *(const f32x4*)(Lt_s + 2844);
    Lb15 = *(const f32x4*)(Lt_s + 2848);
    __builtin_amdgcn_sched_barrier(0);
    { const float xj = X20[0]; const f32x2 xj2 = (f32x2){xj, xj};
      X20 -= (f32x2){La10[0], La10[1]} * xj2;
      X21 -= (f32x2){La10[2], La10[3]} * xj2;
      X22 -= (f32x2){La11[0], La11[1]} * xj2;
      X23 -= (f32x2){La11[2], La11[3]} * xj2;
      X24 -= (f32x2){La12[0], La12[1]} * xj2;
      X25 -= (f32x2){La12[2], La12[3]} * xj2;
      X26 -= (f32x2){La13[0], La13[1]} * xj2;
      X27 -= (f32x2){La13[2], La13[3]} * xj2;
      X28 -= (f32x2){La14[0], La14[1]} * xj2;
      X29 -= (f32x2){La14[2], La14[3]} * xj2;
      X30 -= (f32x2){La15[0], La15[1]} * xj2;
      X31 -= (f32x2){La15[2], La15[3]} * xj2;
    }
    __builtin_amdgcn_sched_barrier(0);
    La10 = *(const f32x4*)(Lt_s + 2896);
    La11 = *(const f32x4*)(Lt_s + 2900);
    La12 = *(const f32x4*)(Lt_s + 2904);
    La13 = *(const f32x4*)(Lt_s + 2908);
    La14 = *(const f32x4*)(Lt_s + 2912);
    La15 = *(const f32x4*)(Lt_s + 2916);
    __builtin_amdgcn_sched_barrier(0);
    { const float xj = X20[1]; const f32x2 xj2 = (f32x2){xj, xj};
      X21 -= (f32x2){Lb10[2], Lb10[3]} * xj2;
      X22 -= (f32x2){Lb11[0], Lb11[1]} * xj2;
      X23 -= (f32x2){Lb11[2], Lb11[3]} * xj2;
      X24 -= (f32x2){Lb12[0], Lb12[1]} * xj2;
      X25 -= (f32x2){Lb12[2], Lb12[3]} * xj2;
      X26 -= (f32x2){Lb13[0], Lb13[1]} * xj2;
      X27 -= (f32x2){Lb13[2], Lb13[3]} * xj2;
      X28 -= (f32x2){Lb14[0], Lb14[1]} * xj2;
      X29 -= (f32x2){Lb14[2], Lb14[3]} * xj2;
      X30 -= (f32x2){Lb15[0], Lb15[1]} * xj2;
      X31 -= (f32x2){Lb15[2], Lb15[3]} * xj2;
    }
    __builtin_amdgcn_sched_barrier(0);
    Lb11 = *(const f32x4*)(Lt_s + 2968);
    Lb12 = *(const f32x4*)(Lt_s + 2972);
    Lb13 = *(const f32x4*)(Lt_s + 2976);
    Lb14 = *(const f32x4*)(Lt_s + 2980);
    Lb15 = *(const f32x4*)(Lt_s + 2984);
    __builtin_amdgcn_sched_barrier(0);
    { const float xj = X21[0]; const f32x2 xj2 = (f32x2){xj, xj};
      X21 -= (f32x2){La10[2], La10[3]} * xj2;
      X22 -= (f32x2){La11[0], La11[1]} * xj2;
      X23 -= (f32x2){La11[2], La11[3]} * xj2;
      X24 -= (f32x2){La12[0], La12[1]} * xj2;
      X25 -= (f32x2){La12[2], La12[3]} * xj2;
      X26 -= (f32x2){La13[0], La13[1]} * xj2;
      X27 -= (f32x2){La13[2], La13[3]} * xj2;
      X28 -= (f32x2){La14[0], La14[1]} * xj2;
      X29 -= (f32x2){La14[2], La14[3]} * xj2;
      X30 -= (f32x2){La15[0], La15[1]} * xj2;
      X31 -= (f32x2){La15[2], La15[3]} * xj2;
    }
    __builtin_amdgcn_sched_barrier(0);
    La11 = *(const f32x4*)(Lt_s + 3036);
    La12 = *(const f32x4*)(Lt_s + 3040);
    La13 = *(const f32x4*)(Lt_s + 3044);
    La14 = *(const f32x4*)(Lt_s + 3048);
    La15 = *(const f32x4*)(Lt_s + 3052);
    __builtin_amdgcn_sched_barrier(0);
    { const float xj = X21[1]; const f32x2 xj2 = (f32x2){xj, xj};
      X22 -= (f32x2){Lb11[0], Lb11[1]} * xj2;
      X23 -= (f32x2){Lb11[2], Lb11[3]} * xj2;
      X24 -= (f32x2){Lb12[0], Lb12[1]} * xj2;
      X25 -= (f32x2){Lb12[2], Lb12[3]} * xj2;
      X26 -= (f32x2){Lb13[0], Lb13[1]} * xj2;
      X27 -= (f32x2){Lb13[2], Lb13[3]} * xj2;
      X28 -= (f32x2){Lb14[0], Lb14[1]} * xj2;
      X29 -= (f32x2){Lb14[2], Lb14[3]} * xj2;
      X30 -= (f32x2){Lb15[0], Lb15[1]} * xj2;
      X31 -= (f32x2){Lb15[2], Lb15[3]} * xj2;
    }
    __builtin_amdgcn_sched_barrier(0);
    Lb11 = *(const f32x4*)(Lt_s + 3104);
    Lb12 = *(const f32x4*)(Lt_s + 3108);
    Lb13 = *(const f32x4*)(Lt_s + 3112);
    Lb14 = *(const f32x4*)(Lt_s + 3116);
    Lb15 = *(const f32x4*)(Lt_s + 3120);
    __builtin_amdgcn_sched_barrier(0);
    { const float xj = X22[0]; const f32x2 xj2 = (f32x2){xj, xj};
      X22 -= (f32x2){La11[0], La11[1]} * xj2;
      X23 -= (f32x2){La11[2], La11[3]} * xj2;
      X24 -= (f32x2){La12[0], La12[1]} * xj2;
      X25 -= (f32x2){La12[2], La12[3]} * xj2;
      X26 -= (f32x2){La13[0], La13[1]} * xj2;
      X27 -= (f32x2){La13[2], La13[3]} * xj2;
      X28 -= (f32x2){La14[0], La14[1]} * xj2;
      X29 -= (f32x2){La14[2], La14[3]} * xj2;
      X30 -= (f32x2){La15[0], La15[1]} * xj2;
      X31 -= (f32x2){La15[2], La15[3]} * xj2;
    }
    __builtin_amdgcn_sched_barrier(0);
    La11 = *(const f32x4*)(Lt_s + 3172);
    La12 = *(const f32x4*)(Lt_s + 3176);
    La13 = *(const f32x4*)(Lt_s + 3180);
    La14 = *(const f32x4*)(Lt_s + 3184);
    La15 = *(const f32x4*)(Lt_s + 3188);
    __builtin_amdgcn_sched_barrier(0);
    { const float xj = X22[1]; const f32x2 xj2 = (f32x2){xj, xj};
      X23 -= (f32x2){Lb11[2], Lb11[3]} * xj2;
      X24 -= (f32x2){Lb12[0], Lb12[1]} * xj2;
      X25 -= (f32x2){Lb12[2], Lb12[3]} * xj2;
      X26 -= (f32x2){Lb13[0], Lb13[1]} * xj2;
      X27 -= (f32x2){Lb13[2], Lb13[3]} * xj2;
      X28 -= (f32x2){Lb14[0], Lb14[1]} * xj2;
      X29 -= (f32x2){Lb14[2], Lb14[3]} * xj2;
      X30 -= (f32x2){Lb15[0], Lb15[1]} * xj2;
      X31 -= (f32x2){Lb15[2], Lb15[3]} * xj2;
    }
    __builtin_amdgcn_sched_barrier(0);
    Lb12 = *(const f32x4*)(Lt_s + 3244);
    Lb13 = *(const f32x4*)(Lt_s + 3248);
    Lb14 = *(const f32x4*)(Lt_s + 3252);
    Lb15 = *(const f32x4*)(Lt_s + 3256);
    __builtin_amdgcn_sched_barrier(0);
    { const float xj = X23[0]; const f32x2 xj2 = (f32x2){xj, xj};
      X23 -= (f32x2){La11[2], La11[3]} * xj2;
      X24 -= (f32x2){La12[0], La12[1]} * xj2;
      X25 -= (f32x2){La12[2], La12[3]} * xj2;
      X26 -= (f32x2){La13[0], La13[1]} * xj2;
      X27 -= (f32x2){La13[2], La13[3]} * xj2;
      X28 -= (f32x2){La14[0], La14[1]} * xj2;
      X29 -= (f32x2){La14[2], La14[3]} * xj2;
      X30 -= (f32x2){La15[0], La15[1]} * xj2;
      X31 -= (f32x2){La15[2], La15[3]} * xj2;
    }
    __builtin_amdgcn_sched_barrier(0);
    La12 = *(const f32x4*)(Lt_s + 3312);
    La13 = *(const f32x4*)(Lt_s + 3316);
    La14 = *(const f32x4*)(Lt_s + 3320);
    La15 = *(const f32x4*)(Lt_s + 3324);
    __builtin_amdgcn_sched_barrier(0);
    { const float xj = X23[1]; const f32x2 xj2 = (f32x2){xj, xj};
      X24 -= (f32x2){Lb12[0], Lb12[1]} * xj2;
      X25 -= (f32x2){Lb12[2], Lb12[3]} * xj2;
      X26 -= (f32x2){Lb13[0], Lb13[1]} * xj2;
      X27 -= (f32x2){Lb13[2], Lb13[3]} * xj2;
      X28 -= (f32x2){Lb14[0], Lb14[1]} * xj2;
      X29 -= (f32x2){Lb14[2], Lb14[3]} * xj2;
      X30 -= (f32x2){Lb15[0], Lb15[1]} * xj2;
      X31 -= (f32x2){Lb15[2], Lb15[3]} * xj2;
    }
    __builtin_amdgcn_sched_barrier(0);
    Lb12 = *(const f32x4*)(Lt_s + 3380);
    Lb13 = *(const f32x4*)(Lt_s + 3384);
    Lb14 = *(const f32x4*)(Lt_s + 3388);
    Lb15 = *(const f32x4*)(Lt_s + 3392);
    __builtin_amdgcn_sched_barrier(0);
    { const float xj = X24[0]; const f32x2 xj2 = (f32x2){xj, xj};
      X24 -= (f32x2){La12[0], La12[1]} * xj2;
      X25 -= (f32x2){La12[2], La12[3]} * xj2;
      X26 -= (f32x2){La13[0], La13[1]} * xj2;
      X27 -= (f32x2){La13[2], La13[3]} * xj2;
      X28 -= (f32x2){La14[0], La14[1]} * xj2;
      X29 -= (f32x2){La14[2], La14[3]} * xj2;
      X30 -= (f32x2){La15[0], La15[1]} * xj2;
      X31 -= (f32x2){La15[2], La15[3]} * xj2;
    }
    __builtin_amdgcn_sched_barrier(0);
    La12 = *(const f32x4*)(Lt_s + 3448);
    La13 = *(const f32x4*)(Lt_s + 3452);
    La14 = *(const f32x4*)(Lt_s + 3456);
    La15 = *(const f32x4*)(Lt_s + 3460);
    __builtin_amdgcn_sched_barrier(0);
    { const float xj = X24[1]; const f32x2 xj2 = (f32x2){xj, xj};
      X25 -= (f32x2){Lb12[2], Lb12[3]} * xj2;
      X26 -= (f32x2){Lb13[0], Lb13[1]} * xj2;
      X27 -= (f32x2){Lb13[2], Lb13[3]} * xj2;
      X28 -= (f32x2){Lb14[0], Lb14[1]} * xj2;
      X29 -= (f32x2){Lb14[2], Lb14[3]} * xj2;
      X30 -= (f32x2){Lb15[0], Lb15[1]} * xj2;
      X31 -= (f32x2){Lb15[2], Lb15[3]} * xj2;
    }
    __builtin_amdgcn_sched_barrier(0);
    Lb13 = *(const f32x4*)(Lt_s + 3520);
    Lb14 = *(const f32x4*)(Lt_s + 3524);
    Lb15 = *(const f32x4*)(Lt_s + 3528);
    __builtin_amdgcn_sched_barrier(0);
    { const float xj = X25[0]; const f32x2 xj2 = (f32x2){xj, xj};
      X25 -= (f32x2){La12[2], La12[3]} * xj2;
      X26 -= (f32x2){La13[0], La13[1]} * xj2;
      X27 -= (f32x2){La13[2], La13[3]} * xj2;
      X28 -= (f32x2){La14[0], La14[1]} * xj2;
      X29 -= (f32x2){La14[2], La14[3]} * xj2;
      X30 -= (f32x2){La15[0], La15[1]} * xj2;
      X31 -= (f32x2){La15[2], La15[3]} * xj2;
    }
    __builtin_amdgcn_sched_barrier(0);
    La13 = *(const f32x4*)(Lt_s + 3588);
    La14 = *(const f32x4*)(Lt_s + 3592);
    La15 = *(const f32x4*)(Lt_s + 3596);
    __builtin_amdgcn_sched_barrier(0);
    { const float xj = X25[1]; const f32x2 xj2 = (f32x2){xj, xj};
      X26 -= (f32x2){Lb13[0], Lb13[1]} * xj2;
      X27 -= (f32x2){Lb13[2], Lb13[3]} * xj2;
      X28 -= (f32x2){Lb14[0], Lb14[1]} * xj2;
      X29 -= (f32x2){Lb14[2], Lb14[3]} * xj2;
      X30 -= (f32x2){Lb15[0], Lb15[1]} * xj2;
      X31 -= (f32x2){Lb15[2], Lb15[3]} * xj2;
    }
    __builtin_amdgcn_sched_barrier(0);
    Lb13 = *(const f32x4*)(Lt_s + 3656);
    Lb14 = *(const f32x4*)(Lt_s + 3660);
    Lb15 = *(const f32x4*)(Lt_s + 3664);
    __builtin_amdgcn_sched_barrier(0);
    { const float xj = X26[0]; const f32x2 xj2 = (f32x2){xj, xj};
      X26 -= (f32x2){La13[0], La13[1]} * xj2;
      X27 -= (f32x2){La13[2], La13[3]} * xj2;
      X28 -= (f32x2){La14[0], La14[1]} * xj2;
      X29 -= (f32x2){La14[2], La14[3]} * xj2;
      X30 -= (f32x2){La15[0], La15[1]} * xj2;
      X31 -= (f32x2){La15[2], La15[3]} * xj2;
    }
    __builtin_amdgcn_sched_barrier(0);
    La13 = *(const f32x4*)(Lt_s + 3724);
    La14 = *(const f32x4*)(Lt_s + 3728);
    La15 = *(const f32x4*)(Lt_s + 3732);
    __builtin_amdgcn_sched_barrier(0);
    { const float xj = X26[1]; const f32x2 xj2 = (f32x2){xj, xj};
      X27 -= (f32x2){Lb13[2], Lb13[3]} * xj2;
      X28 -= (f32x2){Lb14[0], Lb14[1]} * xj2;
      X29 -= (f32x2){Lb14[2], Lb14[3]} * xj2;
      X30 -= (f32x2){Lb15[0], Lb15[1]} * xj2;
      X31 -= (f32x2){Lb15[2], Lb15[3]} * xj2;
    }
    __builtin_amdgcn_sched_barrier(0);
    Lb14 = *(const f32x4*)(Lt_s + 3796);
    Lb15 = *(const f32x4*)(Lt_s + 3800);
    __builtin_amdgcn_sched_barrier(0);
    { const float xj = X27[0]; const f32x2 xj2 = (f32x2){xj, xj};
      X27 -= (f32x2){La13[2], La13[3]} * xj2;
      X28 -= (f32x2){La14[0], La14[1]} * xj2;
      X29 -= (f32x2){La14[2], La14[3]} * xj2;
      X30 -= (f32x2){La15[0], La15[1]} * xj2;
      X31 -= (f32x2){La15[2], La15[3]} * xj2;
    }
    __builtin_amdgcn_sched_barrier(0);
    La14 = *(const f32x4*)(Lt_s + 3864);
    La15 = *(const f32x4*)(Lt_s + 3868);
    __builtin_amdgcn_sched_barrier(0);
    { const float xj = X27[1]; const f32x2 xj2 = (f32x2){xj, xj};
      X28 -= (f32x2){Lb14[0], Lb14[1]} * xj2;
      X29 -= (f32x2){Lb14[2], Lb14[3]} * xj2;
      X30 -= (f32x2){Lb15[0], Lb15[1]} * xj2;
      X31 -= (f32x2){Lb15[2], Lb15[3]} * xj2;
    }
    __builtin_amdgcn_sched_barrier(0);
    Lb14 = *(const f32x4*)(Lt_s + 3932);
    Lb15 = *(const f32x4*)(Lt_s + 3936);
    __builtin_amdgcn_sched_barrier(0);
    { const float xj = X28[0]; const f32x2 xj2 = (f32x2){xj, xj};
      X28 -= (f32x2){La14[0], La14[1]} * xj2;
      X29 -= (f32x2){La14[2], La14[3]} * xj2;
      X30 -= (f32x2){La15[0], La15[1]} * xj2;
      X31 -= (f32x2){La15[2], La15[3]} * xj2;
    }
    __builtin_amdgcn_sched_barrier(0);
    La14 = *(const f32x4*)(Lt_s + 4000);
    La15 = *(const f32x4*)(Lt_s + 4004);
    __builtin_amdgcn_sched_barrier(0);
    { const float xj = X28[1]; const f32x2 xj2 = (f32x2){xj, xj};
      X29 -= (f32x2){Lb14[2], Lb14[3]} * xj2;
      X30 -= (f32x2){Lb15[0], Lb15[1]} * xj2;
      X31 -= (f32x2){Lb15[2], Lb15[3]} * xj2;
    }
    __builtin_amdgcn_sched_barrier(0);
    Lb15 = *(const f32x4*)(Lt_s + 4072);
    __builtin_amdgcn_sched_barrier(0);
    { const float xj = X29[0]; const f32x2 xj2 = (f32x2){xj, xj};
      X29 -= (f32x2){La14[2], La14[3]} * xj2;
      X30 -= (f32x2){La15[0], La15[1]} * xj2;
      X31 -= (f32x2){La15[2], La15[3]} * xj2;
    }
    __builtin_amdgcn_sched_barrier(0);
    La15 = *(const f32x4*)(Lt_s + 4140);
    __builtin_amdgcn_sched_barrier(0);
    { const float xj = X29[1]; const f32x2 xj2 = (f32x2){xj, xj};
      X30 -= (f32x2){Lb15[0], Lb15[1]} * xj2;
      X31 -= (f32x2){Lb15[2], Lb15[3]} * xj2;
    }
    __builtin_amdgcn_sched_barrier(0);
    Lb15 = *(const f32x4*)(Lt_s + 4208);
    __builtin_amdgcn_sched_barrier(0);
    { const float xj = X30[0]; const f32x2 xj2 = (f32x2){xj, xj};
      X30 -= (f32x2){La15[0], La15[1]} * xj2;
      X31 -= (f32x2){La15[2], La15[3]} * xj2;
    }
    __builtin_amdgcn_sched_barrier(0);
    La15 = *(const f32x4*)(Lt_s + 4276);
    __builtin_amdgcn_sched_barrier(0);
    { const float xj = X30[1]; const f32x2 xj2 = (f32x2){xj, xj};
      X31 -= (f32x2){Lb15[2], Lb15[3]} * xj2;
    }
    __builtin_amdgcn_sched_barrier(0);
    __builtin_amdgcn_sched_barrier(0);
    { const float xj = X31[0]; const f32x2 xj2 = (f32x2){xj, xj};
      X31 -= (f32x2){La15[2], La15[3]} * xj2;
    }
    __builtin_amdgcn_sched_barrier(0);
    __syncthreads();
    outp[0] = f2bf(sg * X0[0]);
    outp[136] = f2bf(sg * X0[1]);
    outp[272] = f2bf(sg * X1[0]);
    outp[408] = f2bf(sg * X1[1]);
    outp[544] = f2bf(sg * X2[0]);
    outp[680] = f2bf(sg * X2[1]);
    outp[816] = f2bf(sg * X3[0]);
    outp[952] = f2bf(sg * X3[1]);
    outp[1088] = f2bf(sg * X4[0]);
    outp[1224] = f2bf(sg * X4[1]);
    outp[1360] = f2bf(sg * X5[0]);
    outp[1496] = f2bf(sg * X5[1]);
    outp[1632] = f2bf(sg * X6[0]);
    outp[1768] = f2bf(sg * X6[1]);
    outp[1904] = f2bf(sg * X7[0]);
    outp[2040] = f2bf(sg * X7[1]);
    outp[2176] = f2bf(sg * X8[0]);
    outp[2312] = f2bf(sg * X8[1]);
    outp[2448] = f2bf(sg * X9[0]);
    outp[2584] = f2bf(sg * X9[1]);
    outp[2720] = f2bf(sg * X10[0]);
    outp[2856] = f2bf(sg * X10[1]);
    outp[2992] = f2bf(sg * X11[0]);
    outp[3128] = f2bf(sg * X11[1]);
    outp[3264] = f2bf(sg * X12[0]);
    outp[3400] = f2bf(sg * X12[1]);
    outp[3536] = f2bf(sg * X13[0]);
    outp[3672] = f2bf(sg * X13[1]);
    outp[3808] = f2bf(sg * X14[0]);
    outp[3944] = f2bf(sg * X14[1]);
    outp[4080] = f2bf(sg * X15[0]);
    outp[4216] = f2bf(sg * X15[1]);
    outp[4352] = f2bf(sg * X16[0]);
    outp[4488] = f2bf(sg * X16[1]);
    outp[4624] = f2bf(sg * X17[0]);
    outp[4760] = f2bf(sg * X17[1]);
    outp[4896] = f2bf(sg * X18[0]);
    outp[5032] = f2bf(sg * X18[1]);
    outp[5168] = f2bf(sg * X19[0]);
    outp[5304] = f2bf(sg * X19[1]);
    outp[5440] = f2bf(sg * X20[0]);
    outp[5576] = f2bf(sg * X20[1]);
    outp[5712] = f2bf(sg * X21[0]);
    outp[5848] = f2bf(sg * X21[1]);
    outp[5984] = f2bf(sg * X22[0]);
    outp[6120] = f2bf(sg * X22[1]);
    outp[6256] = f2bf(sg * X23[0]);
    outp[6392] = f2bf(sg * X23[1]);
    outp[6528] = f2bf(sg * X24[0]);
    outp[6664] = f2bf(sg * X24[1]);
    outp[6800] = f2bf(sg * X25[0]);
    outp[6936] = f2bf(sg * X25[1]);
    outp[7072] = f2bf(sg * X26[0]);
    outp[7208] = f2bf(sg * X26[1]);
    outp[7344] = f2bf(sg * X27[0]);
    outp[7480] = f2bf(sg * X27[1]);
    outp[7616] = f2bf(sg * X28[0]);
    outp[7752] = f2bf(sg * X28[1]);
    outp[7888] = f2bf(sg * X29[0]);
    outp[8024] = f2bf(sg * X29[1]);
    outp[8160] = f2bf(sg * X30[0]);
    outp[8296] = f2bf(sg * X30[1]);
    outp[8432] = f2bf(sg * X31[0]);
    outp[8568] = f2bf(sg * X31[1]);
}

DEV void dn_item(const Params& p, int l, int item, unsigned char* smem) {
    const int dir = item & 1, hh = (item >> 1) & 3, b = item >> 3;
    bf16_t* q_s = (bf16_t*)(smem);
    bf16_t* k_s = (bf16_t*)(smem + 17408);
    bf16_t* vnT_s = k_s;
    bf16_t* kT_s = (bf16_t*)(smem + 35840);
    bf16_t* v_s = (bf16_t*)(smem + 54272);
    bf16_t* u_s = v_s;
    float* L_s = (float*)(smem + 71680);
    bf16_t* w_s = (bf16_t*)(smem + 71680);
    bf16_t* qk_s = (bf16_t*)(smem + 89088);
    bf16_t* St_s = (bf16_t*)(smem + 98304);
    float* G_s = (float*)(smem + 133120);
    float* beta_s = G_s + 64;
    float* eG_s = G_s + 128;
    float* bw_s = G_s + 192;
    float* cw_s = G_s + 256;
    const int tid = get_tid(), lane = tid & 63, wv = tid >> 6, l15 = lane & 15, quad = lane >> 4;
    const float Aneg = -expf(p.in[I_DNALOG][(l * 2 + dir) * 4 + hh]);
    const float dtb = p.in[I_DNDT][(l * 2 + dir) * 4 + hh];
    const bf16_t* P = wsb(p, O_P);
    const float* AB = wsf(p, O_AB);
    bf16_t* TO = wsb(p, dir ? O_TA2 : O_TA);
    __syncthreads();
    for (int e = tid; e < 4 * 384; e += 256) { int j = e / 384, c = e % 384, mat = c >> 7, cc = c & 127; cw_s[e] = p.in[I_DNCONV][((size_t)l * 4 + j) * 1536 + mat * 512 + hh * 128 + cc]; }
    for (int e = tid; e < 128 * 136 / 2; e += 256) ((unsigned*)St_s)[e] = 0u;
    f32x4 Sacc[2][8];
#pragma unroll
    for (int a = 0; a < 2; ++a)
#pragma unroll
        for (int c = 0; c < 8; ++c) Sacc[a][c] = (f32x4){0.f, 0.f, 0.f, 0.f};

    const int rg = tid >> 4, cseg = tid & 15, i0 = rg * 4;
    u32x4 raw[3][7];
    float pf_al = 0.f, pf_bb = 0.f;
#define DN_PREFETCH(NN, M0, M1) { \
        const int c_ = chunk_of(dir, (NN)); const int lo_ = c_ < 4 ? 0 : CTXL, hi_ = c_ < 4 ? CTXL : SB, base_ = c_ * 64; \
        const int slo_ = dir ? base_ + 60 - i0 : base_ + i0; \
        _Pragma("unroll") for (int u = 0; u < 7; ++u) { const int ss_ = slo_ - 1 + u; const bool ok_ = ss_ >= lo_ && ss_ < hi_; \
            const bf16_t* rp_ = P + ((size_t)b * SB + (ok_ ? ss_ : base_)) * PW + hh * 128 + cseg * 8; \
            _Pragma("unroll") for (int mat = (M0); mat < (M1); ++mat) { u32x4 t_ = *(const u32x4*)(rp_ + mat * 512); raw[mat][u] = ok_ ? t_ : (u32x4){0u, 0u, 0u, 0u}; } } \
        if ((M0) == 0) { const int sa_ = dir ? base_ + 63 - lane : base_ + lane; \
        pf_al = AB[((size_t)b * SB + sa_) * 16 + dir * 4 + hh]; pf_bb = AB[((size_t)b * SB + sa_) * 16 + 8 + dir * 4 + hh]; } }
    DN_PREFETCH(0, 0, 3);
    const int wv0_ = wv, l150_ = l15, quad0_ = quad, lane0_ = lane;

#pragma unroll 1
    for (int n = 0; n < 68; ++n) {
        int tz0 = 0; asm volatile("" : "+v"(tz0));
        const int wv = wv0_ + tz0, l15 = l150_ + tz0, quad = quad0_ + tz0, lane = lane0_ + tz0;
        const int c = chunk_of(dir, n);
        const int base = c * 64;
        __syncthreads();
        if (wv == 0) {
            float g = Aneg * softplus_fast(pf_al + dtb);
#pragma unroll
            for (int o = 1; o < 64; o <<= 1) { float t = __shfl_up(g, o); if (lane >= o) g += t; }
            const float eg_ = expf(g), bt_ = sigm(pf_bb); G_s[lane] = g; beta_s[lane] = bt_; eG_s[lane] = eg_; bw_s[lane] = bt_ * eg_;
        }
        __syncthreads();
        const float Glast = G_s[63];
        {
            int tz = 0; asm volatile("" : "+v"(tz));
            const int i0l = i0 + tz, csl = cseg + tz;
            float ksc[4];
#pragma unroll
            for (int m = 0; m < 4; ++m) ksc[m] = expf(Glast - G_s[i0l + m]);
#pragma unroll
            for (int mat = 0; mat < 3; ++mat) {
                float w[4][8];
#pragma unroll
                for (int j = 0; j < 4; ++j) { const f32x4 w0 = *(const f32x4*)(cw_s + j * 384 + mat * 128 + csl * 8), w1 = *(const f32x4*)(cw_s + j * 384 + mat * 128 + csl * 8 + 4);
#pragma unroll
                    for (int e = 0; e < 4; ++e) { w[j][e] = w0[e]; w[j][4 + e] = w1[e]; } }
                float v[4][8];
#pragma unroll
                for (int t = 0; t < 4; ++t)
#pragma unroll
                    for (int e = 0; e < 8; ++e) v[t][e] = 0.f;
#pragma unroll
                for (int u = 0; u < 7; ++u) {
                    float x[8];
#pragma unroll
                    for (int e = 0; e < 4; ++e) { x[2 * e] = lo16(raw[mat][u][e]); x[2 * e + 1] = hi16(raw[mat][u][e]); }
#pragma unroll
                    for (int t = 0; t < 4; ++t) { const int j = u - t; if (j >= 0 && j < 4) {
#pragma unroll
                        for (int e = 0; e < 8; ++e) v[t][e] += w[j][e] * x[e]; } }
                }
                float sc[4];
#pragma unroll
                for (int t = 0; t < 4; ++t) {
                    float ss2 = 0.f;
#pragma unroll
                    for (int e = 0; e < 8; ++e) { v[t][e] = silu(v[t][e]); ss2 += v[t][e] * v[t][e]; }
                    if (mat < 2) { ss2 += __shfl_xor(ss2, 1); ss2 += __shfl_xor(ss2, 2); ss2 += __shfl_xor(ss2, 4); ss2 += __shfl_xor(ss2, 8); }
                    sc[t] = mat == 0 ? rsqrtf(ss2 + 1e-6f) * 0.08838834764831845f : (mat == 1 ? rsqrtf(ss2 + 1e-6f) : 1.f);
                }
                bf16_t* dst = mat == 0 ? q_s : (mat == 1 ? k_s : v_s);
#pragma unroll
                for (int t = 0; t < 4; ++t) {
                    const int it_ = dir ? i0l + 3 - t : i0l + t;
                    u32x4 o;
#pragma unroll
                    for (int e = 0; e < 4; ++e) o[e] = pack2(v[t][2 * e] * sc[t], v[t][2 * e + 1] * sc[t]);
                    *(u32x4*)(dst + it_ * 136 + csl * 8) = o;
                }
                if (mat == 1) {
#pragma unroll
                    for (int e = 0; e < 8; ++e) {
                        const float k0 = v[dir ? 3 : 0][e] * sc[dir ? 3 : 0] * ksc[0], k1 = v[dir ? 2 : 1][e] * sc[dir ? 2 : 1] * ksc[1];
                        const float k2 = v[dir ? 1 : 2][e] * sc[dir ? 1 : 2] * ksc[2], k3 = v[dir ? 0 : 3][e] * sc[dir ? 0 : 3] * ksc[3];
                        u32x2 o; o.x = pack2(k0, k1); o.y = pack2(k2, k3);
                        *(u32x2*)(kT_s + (csl * 8 + e) * 72 + i0l) = o;
                    }
                }
            }
        }
        __syncthreads();
        {
            bf16x8 ak[4], aq[4];
#pragma unroll
            for (int ks = 0; ks < 4; ++ks) { ak[ks] = *(const bf16x8*)(k_s + (wv * 16 + l15) * 136 + ks * 32 + quad * 8); aq[ks] = *(const bf16x8*)(q_s + (wv * 16 + l15) * 136 + ks * 32 + quad * 8); }
#pragma unroll
            for (int nt = 0; nt < 4; ++nt) {
                f32x4 kk = {0.f, 0.f, 0.f, 0.f}, qq = {0.f, 0.f, 0.f, 0.f};
#pragma unroll
                for (int ks = 0; ks < 4; ++ks) { bf16x8 bk = *(const bf16x8*)(k_s + (nt * 16 + l15) * 136 + ks * 32 + quad * 8); kk = mfma16(ak[ks], bk, kk); qq = mfma16(aq[ks], bk, qq); }
                const int jj = nt * 16 + l15; const float Gj = G_s[jj];
                f32x4 lv;
#pragma unroll
                for (int j = 0; j < 4; ++j) {
                    const int i = wv * 16 + quad * 4 + j;
                    const float dec = jj <= i ? expf(G_s[i] - Gj) : 0.f;
                    lv[j] = jj < i ? beta_s[i] * kk[j] * dec : 0.f;
                    qk_s[i * 72 + jj] = f2bf(qq[j] * dec);
                }
                *(f32x4*)(L_s + jj * 68 + wv * 16 + quad * 4) = lv;
            }
        }
        __syncthreads();
        dn_solve(L_s, tid < 128 ? (k_s + tid) : (v_s + (tid - 128)), tid < 128 ? bw_s : beta_s, tid < 128 ? -1.f : 1.f, tid < 128 ? (w_s + tid) : (u_s + (tid - 128)));
        __syncthreads();
        {
            f32x4 vn[8], o1[8];
#pragma unroll
            for (int nt = 0; nt < 8; ++nt) {
#pragma unroll
                for (int j = 0; j < 4; ++j) vn[nt][j] = bf2f(u_s[(wv * 16 + quad * 4 + j) * 136 + nt * 16 + l15]);
                o1[nt] = (f32x4){0.f, 0.f, 0.f, 0.f};
            }
            bf16x8 aw[4], aq[4];
#pragma unroll
            for (int ks = 0; ks < 4; ++ks) { aw[ks] = *(const bf16x8*)(w_s + (wv * 16 + l15) * 136 + ks * 32 + quad * 8); aq[ks] = *(const bf16x8*)(q_s + (wv * 16 + l15) * 136 + ks * 32 + quad * 8); }
#pragma unroll
            for (int nt = 0; nt < 8; ++nt)
#pragma unroll
                for (int ks = 0; ks < 4; ++ks) { bf16x8 bs = *(const bf16x8*)(St_s + (nt * 16 + l15) * 136 + ks * 32 + quad * 8); vn[nt] = mfma16(aw[ks], bs, vn[nt]); o1[nt] = mfma16(aq[ks], bs, o1[nt]); }
#pragma unroll
            for (int nt = 0; nt < 8; ++nt) { u32x2 o; o.x = pack2(vn[nt][0], vn[nt][1]); o.y = pack2(vn[nt][2], vn[nt][3]); *(u32x2*)(vnT_s + (nt * 16 + l15) * 72 + wv * 16 + quad * 4) = o; }
            __syncthreads();
            if (n + 1 < 68) DN_PREFETCH(n + 1, 0, 2);
            float eg[4];
#pragma unroll
            for (int j = 0; j < 4; ++j) eg[j] = eG_s[wv * 16 + quad * 4 + j];
            bf16x8 aqk[2], akt[2][2];
#pragma unroll
            for (int ks = 0; ks < 2; ++ks) {
                aqk[ks] = *(const bf16x8*)(qk_s + (wv * 16 + l15) * 72 + ks * 32 + quad * 8);
                akt[0][ks] = *(const bf16x8*)(kT_s + (wv * 32 + l15) * 72 + ks * 32 + quad * 8);
                akt[1][ks] = *(const bf16x8*)(kT_s + (wv * 32 + 16 + l15) * 72 + ks * 32 + quad * 8);
            }
            const float gend = eG_s[63];
            const size_t orow0 = (size_t)b * SB;
#pragma unroll
            for (int nt = 0; nt < 8; ++nt) {
                f32x4 o;
#pragma unroll
                for (int j = 0; j < 4; ++j) { o[j] = o1[nt][j] * eg[j]; Sacc[0][nt][j] *= gend; Sacc[1][nt][j] *= gend; }
#pragma unroll
                for (int ks = 0; ks < 2; ++ks) {
                    bf16x8 bv = *(const bf16x8*)(vnT_s + (nt * 16 + l15) * 72 + ks * 32 + quad * 8);
                    o = mfma16(aqk[ks], bv, o);
                    Sacc[0][nt] = mfma16(akt[0][ks], bv, Sacc[0][nt]);
                    Sacc[1][nt] = mfma16(akt[1][ks], bv, Sacc[1][nt]);
                }
#pragma unroll
                for (int j = 0; j < 4; ++j) {
                    const int i = wv * 16 + quad * 4 + j;
                    const int s = dir ? base + 63 - i : base + i;
                    TO[(orow0 + s) * 512 + hh * 128 + nt * 16 + l15] = f2bf(o[j]);
                }
#pragma unroll
                for (int mt = 0; mt < 2; ++mt) { u32x2 sv; sv.x = pack2(Sacc[mt][nt][0], Sacc[mt][nt][1]); sv.y = pack2(Sacc[mt][nt][2], Sacc[mt][nt][3]);
                    *(u32x2*)(St_s + (nt * 16 + l15) * 136 + wv * 32 + mt * 16 + quad * 4) = sv; }
            }
        }
        if (n + 1 < 68) DN_PREFETCH(n + 1, 2, 3);
    }
}

#undef DN_PREFETCH
DEV void lru_item(const Params& p, int l, int item, unsigned char* smem) {
    const int g = item & 7, b = item >> 3;
    bf16_t* Wt_s = (bf16_t*)smem;
    bf16_t* xbh_s = Wt_s + 2 * 128 * 72;
    float* xbf_s = (float*)(smem + 36864 + 18432);
    float* a_s = xbf_s + 2 * 64 * 65;
    float* cw_s = a_s + 2 * 64 * 65;
    const int tid = get_tid(), lane = tid & 63, wv = tid >> 6, l15 = lane & 15, quad = lane >> 4;
    bf16_t* P = wsb(p, O_P);
    bf16_t* HF = wsb(p, O_U);
    __syncthreads();
    for (int e = tid; e < 320; e += 256) cw_s[e] = e < 256 ? p.in[I_LCW][((size_t)l * 4 + (e >> 6)) * 512 + g * 64 + (e & 63)] : p.in[I_LCB][l * 512 + g * 64 + (e - 256)];
    for (int e = tid; e < 2 * 4096; e += 256) {
        const int d = e >> 12, ch = (e >> 6) & 63, j = e & 63;
        const size_t wi_ = (((size_t)l * 2 + d) * 8 + g) * 4096 + ch * 64 + j;
        Wt_s[(d * 128 + j) * 72 + ch] = f2bf(p.in[I_LWA][wi_]);
        Wt_s[(d * 128 + 64 + j) * 72 + ch] = f2bf(p.in[I_LWI][wi_]);
    }
    float ba_[2][4], bi_[2][4], sp_[2][4];
#pragma unroll
    for (int d = 0; d < 2; ++d)
#pragma unroll
        for (int nt = 0; nt < 4; ++nt) {
            const int ch = (l * 2 + d) * 512 + g * 64 + nt * 16 + l15;
            ba_[d][nt] = p.in[I_LBA][ch]; bi_[d][nt] = p.in[I_LBI][ch]; sp_[d][nt] = softplus(-p.in[I_LLAM][ch]);
        }
    float hc = 0.f;
    const int i = tid >> 2, seg = tid & 3, j0 = seg * 16;
#pragma unroll 1
    for (int n = 0; n < 68; ++n) {
        const int cf = n, cb = chunk_of(1, n);
        __syncthreads();
#pragma unroll
        for (int d = 0; d < 2; ++d) {
            const int c = d ? cb : cf;
            const int seg_lo = c < 4 ? 0 : CTXL, seg_hi = c < 4 ? CTXL : SB;
            const int s = d ? c * 64 + 63 - i : c * 64 + i;
            float v[16];
#pragma unroll
            for (int e = 0; e < 16; ++e) v[e] = cw_s[256 + j0 + e];
#pragma unroll
            for (int j = 0; j < 4; ++j) {
                const int ss = s + j - 1;
                if (ss >= seg_lo && ss < seg_hi) {
                    const u32x4* src = (const u32x4*)(P + ((size_t)b * SB + ss) * PW + C_LX + g * 64 + j0);
                    const float* cw = cw_s + j * 64 + j0;
#pragma unroll
                    for (int q = 0; q < 2; ++q) { u32x4 x = src[q];
#pragma unroll
                        for (int e = 0; e < 4; ++e) { v[q * 8 + 2 * e] += cw[q * 8 + 2 * e] * lo16(x[e]); v[q * 8 + 2 * e + 1] += cw[q * 8 + 2 * e + 1] * hi16(x[e]); } }
                }
            }
            u32x4 h0, h1;
#pragma unroll
            for (int e = 0; e < 4; ++e) { h0[e] = pack2(v[2 * e], v[2 * e + 1]); h1[e] = pack2(v[8 + 2 * e], v[8 + 2 * e + 1]); }
            *(u32x4*)(xbh_s + (d * 64 + i) * 72 + j0) = h0; *(u32x4*)(xbh_s + (d * 64 + i) * 72 + j0 + 8) = h1;
#pragma unroll
            for (int e = 0; e < 16; ++e) xbf_s[(d * 64 + i) * 65 + j0 + e] = v[e];
        }
        __syncthreads();
#pragma unroll
        for (int d = 0; d < 2; ++d) {
            f32x4 acc[8];
#pragma unroll
            for (int nt = 0; nt < 8; ++nt) acc[nt] = (f32x4){0.f, 0.f, 0.f, 0.f};
            bf16x8 af[2];
#pragma unroll
            for (int ks = 0; ks < 2; ++ks) af[ks] = *(const bf16x8*)(xbh_s + (d * 64 + wv * 16 + l15) * 72 + ks * 32 + quad * 8);
#pragma unroll
            for (int nt = 0; nt < 8; ++nt)
#pragma unroll
                for (int ks = 0; ks < 2; ++ks) { bf16x8 bw = *(const bf16x8*)(Wt_s + (d * 128 + nt * 16 + l15) * 72 + ks * 32 + quad * 8); acc[nt] = mfma16(af[ks], bw, acc[nt]); }
#pragma unroll
            for (int nt = 0; nt < 4; ++nt)
#pragma unroll
                for (int jj = 0; jj < 4; ++jj) {
                    const int idx = (d * 64 + wv * 16 + quad * 4 + jj) * 65 + nt * 16 + l15;
                    const float r = sigm(acc[nt][jj] + ba_[d][nt]), ig = sigm(acc[nt + 4][jj] + bi_[d][nt]);
                    const float la = -8.f * r * sp_[d][nt];
                    a_s[idx] = expf(la);
                    xbf_s[idx] = sqrtf(fmaxf(1.f - expf(2.f * la), 0.f)) * (ig * xbf_s[idx]);
                }
        }
        __syncthreads();
        if (wv < 2) {
            const int o = wv * 64 * 65 + lane;
#pragma unroll 16
            for (int r = 0; r < 64; ++r) { hc = a_s[o + r * 65] * hc + xbf_s[o + r * 65]; xbf_s[o + r * 65] = hc; }
        }
        __syncthreads();
#pragma unroll
        for (int d = 0; d < 2; ++d) {
            const int c = d ? cb : cf;
            const int s = d ? c * 64 + 63 - i : c * 64 + i;
            const bool second = d ? (cb < n) : ((cf < 4 ? 3 - cf : 71 - cf) < n);
            const size_t row = (size_t)b * SB + s;
            const float* hp = xbf_s + (d * 64 + i) * 65 + j0;
            bf16_t* hf = HF + row * 512 + g * 64 + j0;
            if (!second) {
                u32x4 o0, o1;
#pragma unroll
                for (int e = 0; e < 4; ++e) { o0[e] = pack2(hp[2 * e], hp[2 * e + 1]); o1[e] = pack2(hp[8 + 2 * e], hp[8 + 2 * e + 1]); }
                *(u32x4*)hf = o0; *(u32x4*)(hf + 8) = o1;
            } else {
                bf16_t* gp = P + row * PW + C_LG + g * 64 + j0;
                u32x4 f0 = *(const u32x4*)hf, f1 = *(const u32x4*)(hf + 8), g0 = *(const u32x4*)gp, g1 = *(const u32x4*)(gp + 8), o0, o1;
#pragma unroll
                for (int e = 0; e < 4; ++e) {
                    o0[e] = pack2((lo16(f0[e]) + hp[2 * e]) * gelu_tanh(lo16(g0[e])), (hi16(f0[e]) + hp[2 * e + 1]) * gelu_tanh(hi16(g0[e])));
                    o1[e] = pack2((lo16(f1[e]) + hp[8 + 2 * e]) * gelu_tanh(lo16(g1[e])), (hi16(f1[e]) + hp[8 + 2 * e + 1]) * gelu_tanh(hi16(g1[e])));
                }
                *(u32x4*)gp = o0; *(u32x4*)(gp + 8) = o1;
            }
        }
    }
}

DEV void att_item(const Params& p, int l, int b, int h, int qt, float lam_init, unsigned char* smem) {
    bf16_t* K_s = (bf16_t*)smem;
    bf16_t* V_s = (bf16_t*)(smem + 2 * 17408);
    const int tid = get_tid(), lane = tid & 63, wv = tid >> 6, l15 = lane & 15, quad = lane >> 4;
    bf16_t* P = wsb(p, O_P);
    const bf16_t* VT = wsb(p, O_VT) + (size_t)(b * 4 + h) * 128 * SB;
    const int nt_keys = (qt < 2 ? CTXL : SB) / 64;
    float lam;
    {
        const float* lv = p.in[I_DALAM] + l * 256;
        float s1 = lv[lane] * lv[64 + lane], s2 = lv[128 + lane] * lv[192 + lane];
#pragma unroll
        for (int o = 32; o >= 1; o >>= 1) { s1 += __shfl_xor(s1, o); s2 += __shfl_xor(s2, o); }
        lam = expf(s1) - expf(s2) + lam_init;
    }
    bf16x8* Qst = (bf16x8*)(smem + 71680) + (wv * 8) * 64 + lane;
#pragma unroll
    for (int qg = 0; qg < 2; ++qg) {
        const bf16_t* qp = P + ((size_t)b * SB + qt * 128 + wv * 32 + qg * 16 + l15) * PW + C_DAQ + h * 128;
#pragma unroll
        for (int wh = 0; wh < 2; ++wh)
#pragma unroll
            for (int ks = 0; ks < 2; ++ks) Qst[(wh * 4 + qg * 2 + ks) * 64] = *(const bf16x8*)(qp + wh * 64 + ks * 32 + quad * 8);
    }
    f32x4 O[2][8][2];
    float mrun[2][2], lrun[2][2];
#pragma unroll
    for (int wh = 0; wh < 2; ++wh)
#pragma unroll
        for (int qg = 0; qg < 2; ++qg) { mrun[wh][qg] = -1e30f; lrun[wh][qg] = 0.f;
#pragma unroll
            for (int dg = 0; dg < 8; ++dg) O[wh][dg][qg] = (f32x4){0.f, 0.f, 0.f, 0.f}; }
    const int kr = tid >> 2, kseg = (tid & 3) * 32;
    const int kpos = ((kr >> 5) * 2 + ((kr & 7) >> 2)) * 16 + ((kr & 31) >> 3) * 4 + (kr & 3);
    const bf16_t* kg_ = P + ((size_t)b * SB + kr) * PW + C_DAK + h * 128 + kseg;
    const int vr = tid >> 1, vh = (tid & 1) * 32;
    const bf16_t* vg_ = VT + (size_t)vr * SB + vh;
    u32x4 kreg[4], vreg[4];
#pragma unroll
    for (int i = 0; i < 4; ++i) { kreg[i] = *(const u32x4*)(kg_ + i * 8); vreg[i] = *(const u32x4*)(vg_ + i * 8); }
    __syncthreads();
#pragma unroll
    for (int i = 0; i < 4; ++i) { *(u32x4*)(K_s + kpos * 136 + kseg + i * 8) = kreg[i]; *(u32x4*)(V_s + vr * 72 + vh + i * 8) = vreg[i]; }
    __syncthreads();
    const float L2E = 1.4426950408889634f;
#pragma unroll 1
    for (int t = 0; t < nt_keys; ++t) {
        const bf16_t* Kb = K_s + (t & 1) * (64 * 136);
        const bf16_t* Vb = V_s + (t & 1) * (128 * 72);
        if (t + 1 < nt_keys) {
#pragma unroll
            for (int i = 0; i < 4; ++i) { kreg[i] = *(const u32x4*)(kg_ + (size_t)(t + 1) * 64 * PW + i * 8); vreg[i] = *(const u32x4*)(vg_ + (t + 1) * 64 + i * 8); }
        }
#pragma unroll
        for (int wh = 0; wh < 2; ++wh) {
            f32x4 S[4][2];
#pragma unroll
            for (int kg = 0; kg < 4; ++kg) { S[kg][0] = (f32x4){0.f, 0.f, 0.f, 0.f}; S[kg][1] = (f32x4){0.f, 0.f, 0.f, 0.f}; }
#pragma unroll
            for (int ks = 0; ks < 2; ++ks)
#pragma unroll
                for (int kg = 0; kg < 4; ++kg) {
                    bf16x8 kf = *(const bf16x8*)(Kb + (kg * 16 + l15) * 136 + wh * 64 + ks * 32 + quad * 8);
                    S[kg][0] = mfma16(kf, Qst[(wh * 4 + 0 + ks) * 64], S[kg][0]);
                    S[kg][1] = mfma16(kf, Qst[(wh * 4 + 2 + ks) * 64], S[kg][1]);
                }
            bf16x8 Pf[2][2];
#pragma unroll
            for (int qg = 0; qg < 2; ++qg) {
                float mx = -1e30f;
#pragma unroll
                for (int kg = 0; kg < 4; ++kg)
#pragma unroll
                    for (int j = 0; j < 4; ++j) mx = fmaxf(mx, S[kg][qg][j]);
                mx = fmaxf(mx, __shfl_xor(mx, 16)); mx = fmaxf(mx, __shfl_xor(mx, 32));
                mx *= L2E;
                if (__builtin_amdgcn_ballot_w64(mx > mrun[wh][qg] + 8.f) != 0ull) {
                    const float mnew = fmaxf(mrun[wh][qg], mx);
                    const float alpha = __builtin_amdgcn_exp2f(mrun[wh][qg] - mnew);
                    mrun[wh][qg] = mnew;
                    lrun[wh][qg] *= alpha;
#pragma unroll
                    for (int dg = 0; dg < 8; ++dg)
#pragma unroll
                        for (int j = 0; j < 4; ++j) O[wh][dg][qg][j] *= alpha;
                }
                const float mref = mrun[wh][qg];
                float ps = 0.f;
#pragma unroll
                for (int kg = 0; kg < 4; ++kg)
#pragma unroll
                    for (int j = 0; j < 4; ++j) { float pv = __builtin_amdgcn_exp2f(S[kg][qg][j] * L2E - mref); ps += pv; S[kg][qg][j] = pv; }
                lrun[wh][qg] += ps;
#pragma unroll
                for (int s_ = 0; s_ < 2; ++s_) {
                    u32x4 pk; pk[0] = pack2(S[2 * s_][qg][0], S[2 * s_][qg][1]); pk[1] = pack2(S[2 * s_][qg][2], S[2 * s_][qg][3]);
                    pk[2] = pack2(S[2 * s_ + 1][qg][0], S[2 * s_ + 1][qg][1]); pk[3] = pack2(S[2 * s_ + 1][qg][2], S[2 * s_ + 1][qg][3]);
                    Pf[qg][s_] = __builtin_bit_cast(bf16x8, pk);
                }
            }
#pragma unroll
            for (int dg = 0; dg < 8; ++dg)
#pragma unroll
                for (int s_ = 0; s_ < 2; ++s_) {
                    bf16x8 vf = *(const bf16x8*)(Vb + (dg * 16 + l15) * 72 + s_ * 32 + quad * 8);
                    O[wh][dg][0] = mfma16(vf, Pf[0][s_], O[wh][dg][0]);
                    O[wh][dg][1] = mfma16(vf, Pf[1][s_], O[wh][dg][1]);
                }
        }
        if (t + 1 < nt_keys) {
            bf16_t* Kn = K_s + ((t + 1) & 1) * (64 * 136); bf16_t* Vn = V_s + ((t + 1) & 1) * (128 * 72);
#pragma unroll
            for (int i = 0; i < 4; ++i) { *(u32x4*)(Kn + kpos * 136 + kseg + i * 8) = kreg[i]; *(u32x4*)(Vn + vr * 72 + vh + i * 8) = vreg[i]; }
        }
        __syncthreads();
    }
    const float* dnw = p.in[I_DANORM] + l * 128;
#pragma unroll
    for (int qg = 0; qg < 2; ++qg) {
        float l1 = lrun[0][qg], l2 = lrun[1][qg];
        l1 += __shfl_xor(l1, 16); l1 += __shfl_xor(l1, 32); l2 += __shfl_xor(l2, 16); l2 += __shfl_xor(l2, 32);
        const float i1 = 1.f / l1, i2 = lam / l2;
        float ss = 0.f;
#pragma unroll
        for (int dg = 0; dg < 8; ++dg)
#pragma unroll
            for (int j = 0; j < 4; ++j) { float o = O[0][dg][qg][j] * i1 - O[1][dg][qg][j] * i2; O[0][dg][qg][j] = o; ss += o * o; }
        ss += __shfl_xor(ss, 16); ss += __shfl_xor(ss, 32);
        const float rstd = rsqrtf(ss * (1.f / 128.f) + 1e-5f) * (1.f - lam_init);
        bf16_t* op = P + ((size_t)b * SB + qt * 128 + wv * 32 + qg * 16 + l15) * PW + C_DAQ + h * 128;
#pragma unroll
        for (int dg = 0; dg < 8; ++dg) {
            const int dv0 = dg * 16 + quad * 4;
            u32x2 o; o.x = pack2(O[0][dg][qg][0] * rstd * dnw[dv0], O[0][dg][qg][1] * rstd * dnw[dv0 + 1]);
            o.y = pack2(O[0][dg][qg][2] * rstd * dnw[dv0 + 2], O[0][dg][qg][3] * rstd * dnw[dv0 + 3]);
            *(u32x2*)(op + dv0) = o;
        }
    }
}

DEV void phase_mix(const Params& p, int l, unsigned char* smem) {
    const bool need_ctx = l == 0;
    const float lam_init = l == 0 ? 0.2f : 0.35550906759096926f;
    unsigned* ctr = (unsigned*)(p.ws + O_CTL) + l;
    unsigned* actr = (unsigned*)(p.ws + O_CTL) + 16 + l * 8;
    __shared__ int s_item;
    const int nqt = need_ctx ? 34 : 32;
    auto next = [&](unsigned* c) -> int {
        __syncthreads();
        if (threadIdx.x == 0) s_item = (int)atomicAdd(c, 1u);
        __syncthreads();
        return __builtin_amdgcn_readfirstlane(s_item);
    };
    int it = next(ctr);
#pragma unroll 1
    while (it < 64) { dn_item(p, l, it, smem); it = next(ctr); }
#pragma unroll 1
    while (it < 128) { lru_item(p, l, it - 64, smem); it = next(ctr); }
    const int myx = blockIdx.x & 7;
#pragma unroll 1
    for (int k = 0; k < 8; ++k) {
        const int x = (myx + k) & 7;
        it = next(actr + x);
#pragma unroll 1
        while (it < 4 * nqt) {
            const int bh = x + 8 * (it / nqt), idx = it % nqt;
            const int qt = idx < 32 ? idx + 2 : idx - 32;
            att_item(p, l, bh >> 2, bh & 3, qt, lam_init, smem);
            it = next(actr + x);
        }
    }
}

constexpr int NPHASE = 1 + 2 * 9 + 1;
DEV void run_phase(const Params& p, int ph, unsigned char* smem) {
    if (ph == 0) { phase_mod(p, smem); phase_rope(p); __syncthreads(); phase_wconv(p, 0, smem); return; }
    if (ph == NPHASE - 1) { phase_final(p); return; }
    const int l = (ph - 1) / 9, q = (ph - 1) % 9;
    const bool first = l == 0, lat = l == 1;
    const bf16_t* W = wsb(p, O_WT);
    switch (q) {
        case 0: if (l == 1) phase_wconv(p, 1, smem); phase_norm(p, l, 0, first, false); break;
        case 1: phase_g1(p, smem); break;
        case 2: phase_mix(p, l, smem); break;
        case 3: phase_fin_norm(p, l, first, lat); break;
        case 4: phase_gate(p, lat, smem); break;
        case 5: phase_resid(p, l, wsb(p, O_U), D, W + W_OUT, 1024, 2, first, lat, smem); break;
        case 6: phase_norm(p, l, 1, false, lat); break;
        case 7: phase_gu(p, lat, smem); break;
        case 8: phase_resid(p, l, wsb(p, O_P), PW, W + W_DN, DFF, 5, false, lat, smem); break;
    }
}

#if MEGA
__global__ void __launch_bounds__(256) mega_kernel(Params p) {
    extern __shared__ __align__(16) unsigned char smem[];
    cg::grid_group grid = cg::this_grid();
    phase_mod(p, smem); phase_rope(p); __syncthreads(); phase_wconv(p, 0, smem);
    grid.sync();
    const bf16_t* W = wsb(p, O_WT);
#pragma unroll
    for (int l = 0; l < 2; ++l) {
        const bool first = l == 0, lat = l == 1;
        if (l == 1) phase_wconv(p, 1, smem);
        phase_norm(p, l, 0, first, false);
        grid.sync();
        phase_g1(p, smem);
        grid.sync();
        phase_mix(p, l, smem);
        grid.sync();
        phase_fin_norm(p, l, first, lat);
        grid.sync();
        phase_gate(p, lat, smem);
        grid.sync();
        phase_merge(p, lat, smem);
        grid.sync();
        phase_resid(p, l, wsb(p, O_U), D, W + W_OUT, 1024, 2, first, lat, smem);
        grid.sync();
        phase_norm(p, l, 1, false, lat);
        grid.sync();
        phase_gu(p, lat, smem);
        grid.sync();
        phase_resid(p, l, wsb(p, O_P), PW, W + W_DN, DFF, 5, false, lat, smem);
        grid.sync();
    }
    phase_final(p);
}
#else
__global__ void __launch_bounds__(256) phase_kernel(Params p, int ph) {
    extern __shared__ __align__(16) unsigned char smem[];
    run_phase(p, ph, smem);
}
#endif

extern "C" void kernel_launch(void* const* d_in, const int* in_sizes, int n_in, void* d_out, int out_size, void* d_ws, size_t ws_size, hipStream_t stream) {
    static int grid = 0;
    if (grid == 0) {
        if (n_in != 28 || ws_size < WS_END) { fprintf(stderr, "kernel_launch: unexpected n_in %d or ws_size %zu < %zu\n", n_in, ws_size, (size_t)WS_END); grid = -1; return; }
        int dev = 0, cus = 0, per_cu = 0;
        hipGetDevice(&dev);
        hipDeviceGetAttribute(&cus, hipDeviceAttributeMultiprocessorCount, dev);
#if MEGA
        hipFuncSetAttribute((const void*)mega_kernel, hipFuncAttributeMaxDynamicSharedMemorySize, LDS_BYTES);
        hipOccupancyMaxActiveBlocksPerMultiprocessor(&per_cu, (const void*)mega_kernel, 256, LDS_BYTES);
#else
        hipFuncSetAttribute((const void*)phase_kernel, hipFuncAttributeMaxDynamicSharedMemorySize, LDS_BYTES);
        hipOccupancyMaxActiveBlocksPerMultiprocessor(&per_cu, (const void*)phase_kernel, 256, LDS_BYTES);
#endif
        if (per_cu < 1) per_cu = 1;
        grid = cus * per_cu;
        fprintf(stderr, "kernel_launch: grid %d (%d CUs x %d)\n", grid, cus, per_cu);
    }
    if (grid < 0) return;
    hipMemsetAsync((char*)d_ws + O_CTL, 0, 4096, stream);
    Params p{};
    for (int i = 0; i < 28; ++i) p.in[i] = (const float*)d_in[i];
    p.out = (float*)d_out; p.ws = (unsigned char*)d_ws;
#if MEGA
    void* args[] = {&p};
    hipError_t e = hipLaunchCooperativeKernel((const void*)mega_kernel, dim3(grid), dim3(256), args, LDS_BYTES, stream);
    if (e != hipSuccess) fprintf(stderr, "cooperative launch failed: %s (grid %d)\n", hipGetErrorString(e), grid);
#else
    for (int ph = 0; ph < NPHASE; ++ph) hipLaunchKernelGGL(phase_kernel, dim3(grid), dim3(256), LDS_BYTES, stream, p, ph);
#endif
}
```

```cpp
#include <hip/hip_runtime.h>
#include <hip/hip_cooperative_groups.h>
#include <cstdio>
#include <cstdint>
namespace cg = cooperative_groups;

#ifndef MEGA
#define MEGA 1
#endif

typedef unsigned short bf16_t;
typedef short bf16x8 __attribute__((ext_vector_type(8)));
typedef float f32x4 __attribute__((ext_vector_type(4)));
typedef unsigned u32x4 __attribute__((ext_vector_type(4)));
typedef unsigned u32x2 __attribute__((ext_vector_type(2)));
#define DEV __device__ __forceinline__

constexpr int D = 1024, NB = 8, SEQ = 4096, CTXL = 256, SB = 4352, MR = NB * SB, PW = 4096, DFF = 2816;
constexpr int C_DNQ = 0, C_DNK = 512, C_DNV = 1024, C_DNZ = 1536, C_LX = 2048, C_LG = 2560, C_DAQ = 3072, C_DAK = 3584;
constexpr int NIN = 4736;
constexpr int GLD = 80;

enum { I_X = 0, I_C, I_CTX, I_CCTX, I_WMOD, I_BMOD, I_NMIX, I_NFFN, I_WIN, I_DNCONV, I_DNALOG, I_DNDT, I_DNNORM, I_LCW, I_LCB,
       I_LWA, I_LBA, I_LWI, I_LBI, I_LLAM, I_DALAM, I_DANORM, I_WBR, I_WOUT, I_WFG, I_WFU, I_WFD, I_NFIN };

constexpr size_t al256(size_t x) { return (x + 255) & ~(size_t)255; }
constexpr size_t O_CTL = 0;
constexpr size_t O_MOD = 4096;
constexpr size_t O_ROPE = al256(O_MOD + (size_t)2 * 9 * 6144 * 4);
constexpr size_t O_WT = al256(O_ROPE + 64 * 16 * 2 * 4);
constexpr size_t W_IN = 0, W_GATE = W_IN + (size_t)NIN * 1024, W_BR = W_GATE + (size_t)3072 * 1024, W_OUT = W_BR + (size_t)3 * 1024 * 512,
                 W_GU = W_OUT + (size_t)1024 * 1024, W_DN = W_GU + (size_t)5632 * 1024, W_END = W_DN + (size_t)1024 * 2816;
constexpr size_t O_HCTX = al256(O_WT + W_END * 2);
constexpr size_t O_U = al256(O_HCTX + (size_t)2048 * 1024 * 4);
constexpr size_t O_P = al256(O_U + (size_t)MR * 1024 * 2);
constexpr size_t O_AB = al256(O_P + (size_t)MR * PW * 2);
constexpr size_t O_TA = al256(O_AB + (size_t)MR * 16 * 4);
constexpr size_t O_TA2 = al256(O_TA + (size_t)MR * 512 * 2);
constexpr size_t O_VT = al256(O_TA2 + (size_t)MR * 512 * 2);
constexpr size_t WS_END = al256(O_VT + (size_t)MR * 512 * 2);

constexpr int LDS_BYTES = 140 * 1024;

struct Params {
    const float* in[28];
    float* out;
    unsigned char* ws;
};

DEV int get_tid() { int t = threadIdx.x; asm volatile("" : "+v"(t)); return t; }
DEV float bf2f(bf16_t h) { return __uint_as_float(((unsigned)h) << 16); }
DEV bf16_t f2bf(float f) { unsigned u = __float_as_uint(f); u += 0x7fffu + ((u >> 16) & 1u); return (bf16_t)(u >> 16); }
typedef float f32x2_ __attribute__((ext_vector_type(2)));
typedef __bf16 bf16x2_ __attribute__((ext_vector_type(2)));
DEV unsigned pack2(float a, float b) { const f32x2_ v = {a, b}; return __builtin_bit_cast(unsigned, __builtin_convertvector(v, bf16x2_)); }
DEV float sigm(float x) { return __builtin_amdgcn_rcpf(1.f + __expf(-x)); }
DEV float silu(float x) { return x * __builtin_amdgcn_rcpf(1.f + __expf(-x)); }
DEV float softplus(float x) { return x > 20.f ? x : log1pf(expf(x)); }
DEV float softplus_fast(float x) { const float e = __expf(x); return x > 15.f ? x : (e < 0.01f ? e * (1.f - e * (0.5f - e * 0.33333333f)) : __logf(1.f + e)); }
DEV float gelu_tanh(float x) { float u = 0.7978845608028654f * (x + 0.044715f * x * x * x); float t = 1.f - 2.f * __builtin_amdgcn_rcpf(1.f + __expf(2.f * u)); return 0.5f * x * (1.f + t); }
DEV f32x4 mfma16(bf16x8 a, bf16x8 b, f32x4 c) { return __builtin_amdgcn_mfma_f32_16x16x32_bf16(a, b, c, 0, 0, 0); }
DEV void mfma16a(f32x4& c, bf16x8 a, bf16x8 b) { asm volatile("v_mfma_f32_16x16x32_bf16 %0, %1, %2, %0" : "+a"(c) : "v"(a), "v"(b)); }
DEV float lo16(unsigned v) { return __uint_as_float(v << 16); }
DEV float hi16(unsigned v) { return __uint_as_float(v & 0xffff0000u); }

DEV bf16_t* wsb(const Params& p, size_t off) { return (bf16_t*)(p.ws + off); }
DEV float* wsf(const Params& p, size_t off) { return (float*)(p.ws + off); }
DEV float* hrow(const Params& p, int r) { int b = r / SB, s = r - b * SB; return s < CTXL ? wsf(p, O_HCTX) + (size_t)(b * CTXL + s) * D : p.out + (size_t)(b * SEQ + s - CTXL) * D; }
DEV const float* xrow(const Params& p, int r) { int b = r / SB, s = r - b * SB; return s < CTXL ? p.in[I_CTX] + (size_t)(b * CTXL + s) * D : p.in[I_X] + (size_t)(b * SEQ + s - CTXL) * D; }
DEV int modrow(int r) { int b = r / SB, s = r - b * SB; return s < CTXL ? 8 : b; }

template <int MT, int NT>
DEV void gemm_core(const bf16_t* __restrict__ A, int lda, const bf16_t* __restrict__ Bt, int ldb, int K, f32x4 (&acc)[MT][NT], bf16_t* smem_) {
    constexpr int SA = 32 * MT * GLD, SBB = 32 * NT * GLD;
    bf16_t* sA = smem_; bf16_t* sB = smem_ + 2 * SA;
    const int tid = get_tid(), lane = tid & 63, wv = tid >> 6, wr = wv >> 1, wc = wv & 1, l15 = lane & 15, quad = lane >> 4;
    const int lr = tid >> 3, lc = (tid & 7) * 8;
    u32x4 ra0[MT], rb0[NT], ra1[MT], rb1[NT];
    const bf16_t* Ap = A + (size_t)lr * lda + lc;
    const bf16_t* Bp = Bt + (size_t)lr * ldb + lc;
    const int nk = K >> 6;
#define GLOAD(RA, RB, KT) { const int ko_ = (KT) * 64; _Pragma("unroll") for (int i = 0; i < MT; ++i) RA[i] = *(const u32x4*)(Ap + (size_t)(32 * i) * lda + ko_); \
                            _Pragma("unroll") for (int i = 0; i < NT; ++i) RB[i] = *(const u32x4*)(Bp + (size_t)(32 * i) * ldb + ko_); }
#define LSTORE(RA, RB, BUF) { _Pragma("unroll") for (int i = 0; i < MT; ++i) *(u32x4*)(sA + (BUF) * SA + (lr + 32 * i) * GLD + lc) = RA[i]; \
                              _Pragma("unroll") for (int i = 0; i < NT; ++i) *(u32x4*)(sB + (BUF) * SBB + (lr + 32 * i) * GLD + lc) = RB[i]; }
#define COMPUTE(BUF) { _Pragma("unroll") for (int ks = 0; ks < 2; ++ks) { bf16x8 af[MT], bfr[NT]; \
        _Pragma("unroll") for (int mt = 0; mt < MT; ++mt) af[mt] = *(const bf16x8*)(sA + (BUF) * SA + (wr * MT * 16 + mt * 16 + l15) * GLD + ks * 32 + quad * 8); \
        _Pragma("unroll") for (int nt = 0; nt < NT; ++nt) bfr[nt] = *(const bf16x8*)(sB + (BUF) * SBB + (wc * NT * 16 + nt * 16 + l15) * GLD + ks * 32 + quad * 8); \
        _Pragma("unroll") for (int mt = 0; mt < MT; ++mt) _Pragma("unroll") for (int nt = 0; nt < NT; ++nt) mfma16a(acc[mt][nt], bfr[nt], af[mt]); } }
    GLOAD(ra0, rb0, 0);
    GLOAD(ra1, rb1, 1);
    __syncthreads();
    LSTORE(ra0, rb0, 0);
    GLOAD(ra0, rb0, 2);
    __syncthreads();
    int kt = 0;
#pragma unroll 1
    for (; kt + 4 < nk; kt += 2) {
        COMPUTE(0);
        LSTORE(ra1, rb1, 1);
        GLOAD(ra1, rb1, kt + 3);
        __syncthreads();
        COMPUTE(1);
        LSTORE(ra0, rb0, 0);
        GLOAD(ra0, rb0, kt + 4);
        __syncthreads();
    }
    COMPUTE(0);
    LSTORE(ra1, rb1, 1);
    GLOAD(ra1, rb1, kt + 3);
    __syncthreads();
    COMPUTE(1);
    LSTORE(ra0, rb0, 0);
    __syncthreads();
    COMPUTE(0);
    LSTORE(ra1, rb1, 1);
    __syncthreads();
    COMPUTE(1);
    __syncthreads();
#undef GLOAD
#undef LSTORE
#undef COMPUTE
    static_assert(NT == 4, "the accumulator fence is written for NT == 4");
#pragma unroll
    for (int mt = 0; mt < MT; ++mt) {
        if (mt == 0) asm volatile("s_nop 15\n\ts_nop 15" : "+a"(acc[mt][0]), "+a"(acc[mt][1]), "+a"(acc[mt][2]), "+a"(acc[mt][3]));
        else asm volatile("s_nop 0" : "+a"(acc[mt][0]), "+a"(acc[mt][1]), "+a"(acc[mt][2]), "+a"(acc[mt][3]));
    }
}
template <int MT, int NT>
DEV void gemm_core1(const bf16_t* __restrict__ A, int lda, const bf16_t* __restrict__ Bt, int ldb, int K, f32x4 (&acc)[MT][NT], bf16_t* sA, bf16_t* sB) {
    const int tid = get_tid(), lane = tid & 63, wv = tid >> 6, wr = wv >> 1, wc = wv & 1, l15 = lane & 15, quad = lane >> 4;
    const int lr = tid >> 3, lc = (tid & 7) * 8;
    u32x4 ra[MT], rb[NT];
    const bf16_t* Ap = A + (size_t)lr * lda + lc;
    const bf16_t* Bp = Bt + (size_t)lr * ldb + lc;
#pragma unroll
    for (int i = 0; i < MT; ++i) ra[i] = *(const u32x4*)(Ap + (size_t)(32 * i) * lda);
#pragma unroll
    for (int i = 0; i < NT; ++i) rb[i] = *(const u32x4*)(Bp + (size_t)(32 * i) * ldb);
    const int nk = K >> 6;
    for (int kt = 0; kt < nk; ++kt) {
        __syncthreads();
#pragma unroll
        for (int i = 0; i < MT; ++i) *(u32x4*)(sA + (lr + 32 * i) * GLD + lc) = ra[i];
#pragma unroll
        for (int i = 0; i < NT; ++i) *(u32x4*)(sB + (lr + 32 * i) * GLD + lc) = rb[i];
        __syncthreads();
        if (kt + 1 < nk) {
            const int ko = (kt + 1) * 64;
#pragma unroll
            for (int i = 0; i < MT; ++i) ra[i] = *(const u32x4*)(Ap + (size_t)(32 * i) * lda + ko);
#pragma unroll
            for (int i = 0; i < NT; ++i) rb[i] = *(const u32x4*)(Bp + (size_t)(32 * i) * ldb + ko);
        }
#pragma unroll
        for (int ks = 0; ks < 2; ++ks) {
            bf16x8 af[MT], bfr[NT];
#pragma unroll
            for (int mt = 0; mt < MT; ++mt) af[mt] = *(const bf16x8*)(sA + (wr * MT * 16 + mt * 16 + l15) * GLD + ks * 32 + quad * 8);
#pragma unroll
            for (int nt = 0; nt < NT; ++nt) bfr[nt] = *(const bf16x8*)(sB + (wc * NT * 16 + nt * 16 + l15) * GLD + ks * 32 + quad * 8);
#pragma unroll
            for (int mt = 0; mt < MT; ++mt)
#pragma unroll
                for (int nt = 0; nt < NT; ++nt) mfma16a(acc[mt][nt], bfr[nt], af[mt]);
        }
    }
    static_assert(NT == 4, "the accumulator fence is written for NT == 4");
#pragma unroll
    for (int mt = 0; mt < MT; ++mt) {
        if (mt == 0) asm volatile("s_nop 15\n\ts_nop 15" : "+a"(acc[mt][0]), "+a"(acc[mt][1]), "+a"(acc[mt][2]), "+a"(acc[mt][3]));
        else asm volatile("s_nop 0" : "+a"(acc[mt][0]), "+a"(acc[mt][1]), "+a"(acc[mt][2]), "+a"(acc[mt][3]));
    }
}
template <int MT, int NT>
DEV void zero_acc(f32x4 (&acc)[MT][NT]) {
#pragma unroll
    for (int mt = 0; mt < MT; ++mt)
#pragma unroll
        for (int nt = 0; nt < NT; ++nt) acc[mt][nt] = (f32x4){0.f, 0.f, 0.f, 0.f};
}

DEV void phase_mod(const Params& p, unsigned char* smem) {
    float* s_s = (float*)smem;
    float* red = s_s + 9 * 1024;
    const int tid = get_tid();
    bool loaded = false;
    for (int it = blockIdx.x; it < 2 * 96; it += gridDim.x) {
        if (!loaded) {
            for (int e = tid; e < 9 * 1024; e += 256) { float v = e < 8192 ? p.in[I_C][e] : p.in[I_CCTX][e - 8192]; s_s[e] = silu(v); }
            loaded = true;
        }
        __syncthreads();
        const int l = it / 96, cg_ = it % 96, cq = tid & 63, kq = tid >> 6, col = cg_ * 64 + cq;
        float acc[9];
#pragma unroll
        for (int r = 0; r < 9; ++r) acc[r] = 0.f;
        const float* wp = p.in[I_WMOD] + ((size_t)l * 1024 + kq * 256) * 6144 + col;
#pragma unroll 8
        for (int k = 0; k < 256; ++k) {
            float wv = wp[(size_t)k * 6144];
#pragma unroll
            for (int r = 0; r < 9; ++r) acc[r] += s_s[r * 1024 + kq * 256 + k] * wv;
        }
#pragma unroll
        for (int r = 0; r < 9; ++r) red[(kq * 9 + r) * 64 + cq] = acc[r];
        __syncthreads();
        for (int e = tid; e < 9 * 64; e += 256) {
            int r = e >> 6, c2 = e & 63;
            float v = red[(0 * 9 + r) * 64 + c2] + red[(1 * 9 + r) * 64 + c2] + red[(2 * 9 + r) * 64 + c2] + red[(3 * 9 + r) * 64 + c2];
            wsf(p, O_MOD)[((size_t)l * 9 + r) * 6144 + cg_ * 64 + c2] = v + p.in[I_BMOD][l * 6144 + cg_ * 64 + c2];
        }
        __syncthreads();
    }
}
DEV void phase_rope(const Params& p) {
    if (blockIdx.x == (gridDim.x - 1)) {
        for (int e = threadIdx.x; e < 1024; e += 256) {
            int pos = e >> 4, i = e & 15;
            float inv = powf(10000.f, -(float)i / 16.f);
            float ang = (float)pos * inv;
            float n = rintf(ang * 0.15915494309189535f);
            float r = fmaf(-n, 6.28125f, ang);
            r = fmaf(-n, 1.9353071795864769e-3f, r);
            wsf(p, O_ROPE)[e * 2] = cosf(r);
            wsf(p, O_ROPE)[e * 2 + 1] = sinf(r);
        }
    }
}
DEV void wconv_tile(const float* src0, const float* src1, int lds_, int K, bf16_t* dst, int kind, int kt, int nt, bf16_t* tile) {
    const int tid = get_tid();
    const int kk = tid >> 2, grp = tid & 3;
    const int n0 = nt * 64, k0 = kt * 64;
    const int ng = n0 + grp * 16;
    const float* src = src0; int sc;
    if (kind == 0) { sc = ng < 2048 ? ng : (ng < 4608 ? ng + 16 : (ng < 4624 ? 2048 : -1)); }
    else if (kind == 1) { sc = 4624 + ng; }
    else if (kind == 2) { sc = ng; }
    else { int gd = ng >> 4; src = (gd & 1) ? src1 : src0; sc = (gd >> 1) * 16; }
    __syncthreads();
    if (sc >= 0) {
        const float4* sp = (const float4*)(src + (size_t)(k0 + kk) * lds_ + sc);
#pragma unroll
        for (int q = 0; q < 4; ++q) { float4 v = sp[q]; int e = grp * 16 + q * 4;
            tile[(e + 0) * GLD + kk] = f2bf(v.x); tile[(e + 1) * GLD + kk] = f2bf(v.y); tile[(e + 2) * GLD + kk] = f2bf(v.z); tile[(e + 3) * GLD + kk] = f2bf(v.w); }
    } else {
#pragma unroll
        for (int e = 0; e < 16; ++e) tile[(grp * 16 + e) * GLD + kk] = 0;
    }
    __syncthreads();
    const int n = tid >> 2, kseg = (tid & 3) * 16;
    u32x4 a = *(const u32x4*)(tile + n * GLD + kseg), b = *(const u32x4*)(tile + n * GLD + kseg + 8);
    bf16_t* dp = dst + (size_t)(n0 + n) * K + k0 + kseg;
    *(u32x4*)dp = a; *(u32x4*)(dp + 8) = b;
}
DEV void phase_wconv(const Params& p, int l, unsigned char* smem) {
    bf16_t* tile = (bf16_t*)smem;
    bf16_t* W = wsb(p, O_WT);
    constexpr int T0 = 74 * 16, T1 = T0 + 48 * 16, T2 = T1 + 3 * 16 * 8, T3 = T2 + 16 * 16, T4 = T3 + 88 * 16, T5 = T4 + 16 * 44;
    for (int t = blockIdx.x; t < T5; t += gridDim.x) {
        if (t < T0) { wconv_tile(p.in[I_WIN] + (size_t)l * 1024 * 7696, nullptr, 7696, 1024, W + W_IN, 0, t % 16, t / 16, tile); }
        else if (t < T1) { int u = t - T0; wconv_tile(p.in[I_WIN] + (size_t)l * 1024 * 7696, nullptr, 7696, 1024, W + W_GATE, 1, u % 16, u / 16, tile); }
        else if (t < T2) { int u = t - T1; int n = u / 128, v = u % 128; wconv_tile(p.in[I_WBR] + ((size_t)l * 3 + n) * 512 * 1024, nullptr, 1024, 512, W + W_BR + (size_t)n * 1024 * 512, 2, v % 8, v / 8, tile); }
        else if (t < T3) { int u = t - T2; wconv_tile(p.in[I_WOUT] + (size_t)l * 1024 * 1024, nullptr, 1024, 1024, W + W_OUT, 2, u % 16, u / 16, tile); }
        else if (t < T4) { int u = t - T3; wconv_tile(p.in[I_WFG] + (size_t)l * 1024 * DFF, p.in[I_WFU] + (size_t)l * 1024 * DFF, DFF, 1024, W + W_GU, 3, u % 16, u / 16, tile); }
        else { int u = t - T4; wconv_tile(p.in[I_WFD] + (size_t)l * DFF * 1024, nullptr, 1024, DFF, W + W_DN, 2, u % 44, u / 44, tile); }
    }
}

DEV void norm_row(const Params& p, int l, int which, bool first, int r, int lane) {
    const float* h = first ? xrow(p, r) : hrow(p, r);
    const float* nw = p.in[which ? I_NFFN : I_NMIX] + l * D;
    const float* md = wsf(p, O_MOD) + ((size_t)l * 9 + modrow(r)) * 6144 + (which ? 3 * D : 0);
    float4 v[4]; float ss = 0.f;
#pragma unroll
    for (int i = 0; i < 4; ++i) { v[i] = *(const float4*)(h + i * 256 + lane * 4); ss += v[i].x * v[i].x + v[i].y * v[i].y + v[i].z * v[i].z + v[i].w * v[i].w; }
#pragma unroll
    for (int o = 32; o >= 1; o >>= 1) ss += __shfl_xor(ss, o);
    const float rstd = rsqrtf(ss * (1.f / D) + 1e-6f);
    bf16_t* up = wsb(p, O_U) + (size_t)r * D;
#pragma unroll
    for (int i = 0; i < 4; ++i) {
        const int c = i * 256 + lane * 4;
        float4 w4 = *(const float4*)(nw + c), sh = *(const float4*)(md + c), sc = *(const float4*)(md + D + c);
        float a = v[i].x * rstd * w4.x * (1.f + sc.x) + sh.x, b = v[i].y * rstd * w4.y * (1.f + sc.y) + sh.y;
        float c2 = v[i].z * rstd * w4.z * (1.f + sc.z) + sh.z, d = v[i].w * rstd * w4.w * (1.f + sc.w) + sh.w;
        u32x2 o; o.x = pack2(a, b); o.y = pack2(c2, d);
        *(u32x2*)(up + c) = o;
    }
}
DEV void phase_norm(const Params& p, int l, int which, bool first, bool skip_ctx) {
    const int tid_ = get_tid(); const int lane = tid_ & 63, wv = tid_ >> 6;
    for (int r = blockIdx.x * 4 + wv; r < MR; r += gridDim.x * 4) {
        if (skip_ctx && (r % SB) < CTXL) continue;
        norm_row(p, l, which, first, r, lane);
    }
}
DEV void phase_fin_norm(const Params& p, int l, bool first, bool skip_ctx) {
    const int tid_ = get_tid(); const int lane = tid_ & 63, wv = tid_ >> 6;
    const float* dnn = p.in[I_DNNORM] + l * 128;
    for (int r = blockIdx.x * 4 + wv; r < MR; r += gridDim.x * 4) {
        if (skip_ctx && (r % SB) < CTXL) continue;
        norm_row(p, l, 0, first, r, lane);
        bf16_t* ta = wsb(p, O_TA) + (size_t)r * 512 + lane * 8;
        const bf16_t* tb = wsb(p, O_TA2) + (size_t)r * 512 + lane * 8;
        const bf16_t* zz = wsb(p, O_P) + (size_t)r * PW + C_DNZ + lane * 8;
        u32x4 a = *(const u32x4*)ta, b = *(const u32x4*)tb, z = *(const u32x4*)zz;
        float o[8]; float ss = 0.f;
#pragma unroll
        for (int i = 0; i < 4; ++i) { o[2 * i] = lo16(a[i]) + lo16(b[i]); o[2 * i + 1] = hi16(a[i]) + hi16(b[i]); ss += o[2 * i] * o[2 * i] + o[2 * i + 1] * o[2 * i + 1]; }
#pragma unroll
        for (int of = 8; of >= 1; of >>= 1) ss += __shfl_xor(ss, of);
        const float rstd = rsqrtf(ss * (1.f / 128.f) + 1e-6f);
        const int dv0 = (lane & 15) * 8;
        u32x4 y;
#pragma unroll
        for (int i = 0; i < 4; ++i) {
            float y0 = o[2 * i] * rstd * dnn[dv0 + 2 * i] * silu(lo16(z[i]));
            float y1 = o[2 * i + 1] * rstd * dnn[dv0 + 2 * i + 1] * silu(hi16(z[i]));
            y[i] = pack2(y0, y1);
        }
        *(u32x4*)ta = y;
    }
}
DEV void phase_final(const Params& p) {
    const int tid_ = get_tid(); const int lane = tid_ & 63, wv = tid_ >> 6;
    const float* nw = p.in[I_NFIN];
    for (int r = blockIdx.x * 4 + wv; r < NB * SEQ; r += gridDim.x * 4) {
        float* h = p.out + (size_t)r * D;
        float4 v[4]; float ss = 0.f;
#pragma unroll
        for (int i = 0; i < 4; ++i) { v[i] = *(const float4*)(h + i * 256 + lane * 4); ss += v[i].x * v[i].x + v[i].y * v[i].y + v[i].z * v[i].z + v[i].w * v[i].w; }
#pragma unroll
        for (int o = 32; o >= 1; o >>= 1) ss += __shfl_xor(ss, o);
        const float rstd = rsqrtf(ss * (1.f / D) + 1e-6f);
#pragma unroll
        for (int i = 0; i < 4; ++i) {
            const int c = i * 256 + lane * 4;
            float4 w4 = *(const float4*)(nw + c);
            float4 o4; o4.x = v[i].x * rstd * w4.x; o4.y = v[i].y * rstd * w4.y; o4.z = v[i].z * rstd * w4.z; o4.w = v[i].w * rstd * w4.w;
            *(float4*)(h + c) = o4;
        }
    }
}

struct TileIter {
    int nn, total, nloc, L;
    DEV TileIter(int nm, int nn_) { nn = nn_; total = nm * nn_; nloc = gridDim.x >> 3; L = (blockIdx.x & 7) * nloc + (blockIdx.x >> 3); }
    DEV bool valid() const { return L < total; }
    DEV bool more() const { return (L - (int)(blockIdx.x >> 3)) < total; }
    DEV void next() { L += 8 * nloc; }
    DEV void get(int& tm, int& tn) const { const int pn = 4 * nn, panel = L / pn, rem = L - panel * pn; tn = rem >> 2; tm = panel * 4 + (rem & 3); }
};
DEV void phase_g1(const Params& p, unsigned char* smem) {
    bf16_t* sA = (bf16_t*)smem;
    const int tid = get_tid(), lane = tid & 63, wv = tid >> 6, wr = wv >> 1, wc = wv & 1, l15 = lane & 15, quad = lane >> 4;
    const bf16_t* U = wsb(p, O_U); const bf16_t* W = wsb(p, O_WT) + W_IN;
    bf16_t* P = wsb(p, O_P);
    const float* rope = wsf(p, O_ROPE);
    constexpr int NTN = NIN / 128;
    const int wr0_ = wr, wc0_ = wc, l150_ = l15, quad0_ = quad;
    for (TileIter ti(MR / 256, NTN); ti.valid(); ti.next()) {
        int tm, tn; ti.get(tm, tn);
        const int row0 = tm * 256, col0 = tn * 128;
        f32x4 acc[8][4]; zero_acc(acc);
        gemm_core<8, 4>(U + (size_t)row0 * D, D, W + (size_t)col0 * D, D, D, acc, sA);
        int tz = 0; asm volatile("" : "+v"(tz));
        const int wr = wr0_ + tz, wc = wc0_ + tz, l15 = l150_ + tz, quad = quad0_ + tz;
        if (tn < 24) {
#pragma unroll
            for (int mt = 0; mt < 8; ++mt) {
                __builtin_amdgcn_sched_barrier(0);
                bf16_t* pp = P + (size_t)(row0 + wr * 128 + mt * 16 + l15) * PW + col0 + wc * 64 + quad * 4;
#pragma unroll
                for (int nt = 0; nt < 4; ++nt) { u32x2 o; o.x = pack2(acc[mt][nt][0], acc[mt][nt][1]); o.y = pack2(acc[mt][nt][2], acc[mt][nt][3]); *(u32x2*)(pp + nt * 16) = o; }
            }
        } else if (tn < 32) {
            const float qs = tn < 28 ? 0.125f : 1.f;
#pragma unroll
            for (int mt = 0; mt < 8; ++mt) {
                __builtin_amdgcn_sched_barrier(0);
                const int row = row0 + wr * 128 + mt * 16 + l15;
                const int s_ = row % SB;
                f32x4 ca = {1.f, 1.f, 1.f, 1.f}, sa = {0.f, 0.f, 0.f, 0.f}, cb = {1.f, 1.f, 1.f, 1.f}, sb = {0.f, 0.f, 0.f, 0.f};
                if (s_ >= CTXL) { const int tt = s_ - CTXL, pr = tt >> 6, pc = tt & 63;
                    const f32x4 r0 = *(const f32x4*)(rope + (pr * 16 + quad * 4) * 2), r1 = *(const f32x4*)(rope + (pr * 16 + quad * 4) * 2 + 4);
                    const f32x4 r2 = *(const f32x4*)(rope + (pc * 16 + quad * 4) * 2), r3 = *(const f32x4*)(rope + (pc * 16 + quad * 4) * 2 + 4);
                    ca = (f32x4){r0[0], r0[2], r1[0], r1[2]}; sa = (f32x4){r0[1], r0[3], r1[1], r1[3]};
                    cb = (f32x4){r2[0], r2[2], r3[0], r3[2]}; sb = (f32x4){r2[1], r2[3], r3[1], r3[3]}; }
                const f32x4 x1 = acc[mt][0], x2 = acc[mt][1], y1 = acc[mt][2], y2 = acc[mt][3];
                const f32x4 o0 = (x1 * ca - x2 * sa) * qs, o1 = (x2 * ca + x1 * sa) * qs, o2 = (y1 * cb - y2 * sb) * qs, o3 = (y2 * cb + y1 * sb) * qs;
                bf16_t* pp = P + (size_t)row * PW + col0 + wc * 64 + quad * 4;
                u32x2 o; o.x = pack2(o0[0], o0[1]); o.y = pack2(o0[2], o0[3]); *(u32x2*)(pp) = o;
                o.x = pack2(o1[0], o1[1]); o.y = pack2(o1[2], o1[3]); *(u32x2*)(pp + 16) = o;
                o.x = pack2(o2[0], o2[1]); o.y = pack2(o2[2], o2[3]); *(u32x2*)(pp + 32) = o;
                o.x = pack2(o3[0], o3[1]); o.y = pack2(o3[2], o3[3]); *(u32x2*)(pp + 48) = o;
            }
        } else if (tn < 36) {
            bf16_t* VT = wsb(p, O_VT);
            const int b = row0 / SB, sbase = row0 - b * SB;
#pragma unroll
            for (int mt = 0; mt < 8; ++mt) {
                __builtin_amdgcn_sched_barrier(0);
                const int s_ = sbase + wr * 128 + mt * 16 + l15;
                const int vi0 = (b * 512 + col0 - 4096 + wc * 64 + quad * 4) * SB + s_;
#pragma unroll
                for (int nt = 0; nt < 4; ++nt) {
                    const unsigned p01 = pack2(acc[mt][nt][0], acc[mt][nt][1]), p23 = pack2(acc[mt][nt][2], acc[mt][nt][3]);
                    VT[vi0 + (nt * 16 + 0) * SB] = (bf16_t)(p01 & 0xffffu); VT[vi0 + (nt * 16 + 1) * SB] = (bf16_t)(p01 >> 16);
                    VT[vi0 + (nt * 16 + 2) * SB] = (bf16_t)(p23 & 0xffffu); VT[vi0 + (nt * 16 + 3) * SB] = (bf16_t)(p23 >> 16);
                }
            }
        } else {
            if (wc == 0) {
                float* AB = wsf(p, O_AB);
#pragma unroll
                for (int mt = 0; mt < 8; ++mt) {
                    const int row = row0 + wr * 128 + mt * 16 + l15;
                    *(f32x4*)(AB + (size_t)row * 16 + quad * 4) = acc[mt][0];
                }
            }
        }
    }
}

DEV int rowtile0(int ti, bool latent_only) { if (!latent_only) return ti * 256; int b = ti >> 4, tt = ti & 15; return b * SB + CTXL + tt * 256; }
DEV int sgcol(int n, int c) { return n < 2 ? n * 1024 + c : (c < 512 ? 2048 + c : 3584 + (c - 512)); }

DEV void phase_gate(const Params& p, bool latent_only, unsigned char* smem) {
    bf16_t* sA = (bf16_t*)smem;
    const int tid = get_tid(), lane = tid & 63, wv = tid >> 6, wr = wv >> 1, wc = wv & 1, l15 = lane & 15, quad = lane >> 4;
    const bf16_t* U = wsb(p, O_U); const bf16_t* W = wsb(p, O_WT) + W_GATE;
    bf16_t* P = wsb(p, O_P);
    const int nrt = latent_only ? 128 : 136;
    for (TileIter ti(nrt, 24); ti.valid(); ti.next()) {
        int tm, tn; ti.get(tm, tn);
        const int row0 = rowtile0(tm, latent_only);
        f32x4 acc[8][4]; zero_acc(acc);
        gemm_core<8, 4>(U + (size_t)row0 * D, D, W + (size_t)tn * 128 * D, D, D, acc, sA);
        const int dcol0 = sgcol(tn >> 3, (tn & 7) * 128);
        bf16_t* ip = P + (size_t)(row0 + tid) * PW + dcol0;
#pragma unroll
        for (int mt = 0; mt < 8; ++mt) {
            __builtin_amdgcn_sched_barrier(0);
#pragma unroll
            for (int hf = 0; hf < 2; ++hf) {
                u32x4 o;
                o[0] = pack2(sigm(acc[mt][2 * hf][0]), sigm(acc[mt][2 * hf][1])); o[1] = pack2(sigm(acc[mt][2 * hf][2]), sigm(acc[mt][2 * hf][3]));
                o[2] = pack2(sigm(acc[mt][2 * hf + 1][0]), sigm(acc[mt][2 * hf + 1][1])); o[3] = pack2(sigm(acc[mt][2 * hf + 1][2]), sigm(acc[mt][2 * hf + 1][3]));
                *(u32x4*)(ip + (mt * 2 + hf) * 8) = o;
            }
        }
    }
}

DEV void phase_merge(const Params& p, bool latent_only, unsigned char* smem) {
    bf16_t* sA = (bf16_t*)smem;
    const int tid = get_tid(), lane = tid & 63, wv = tid >> 6, wr = wv >> 1, wc = wv & 1, l15 = lane & 15, quad = lane >> 4;
    const bf16_t* W = wsb(p, O_WT);
    const bf16_t* P = wsb(p, O_P);
    bf16_t* U = wsb(p, O_U);
    const int nrt = latent_only ? 128 : 136;
    for (TileIter ti(nrt, 8); ti.valid(); ti.next()) {
        int tm, tn; ti.get(tm, tn);
        const int row0 = rowtile0(tm, latent_only), col0 = tn * 128;
        f32x4 m[8][4]; zero_acc(m);
#pragma unroll 1
        for (int n = 0; n < 3; ++n) {
            f32x4 au[8][4]; zero_acc(au);
            const bf16_t* Y; int ldy;
            if (n == 0) { Y = wsb(p, O_TA) + (size_t)row0 * 512; ldy = 512; }
            else if (n == 1) { Y = P + (size_t)row0 * PW + C_LG; ldy = PW; }
            else { Y = P + (size_t)row0 * PW + C_DAQ; ldy = PW; }
            const int sc0 = sgcol(n, col0);
            u32x4 sg[16];
            const bf16_t* ip = P + (size_t)(row0 + tid) * PW + sc0;
#pragma unroll
            for (int q = 0; q < 16; ++q) sg[q] = *(const u32x4*)(ip + q * 8);
            gemm_core1<8, 4>(Y, ldy, W + W_BR + ((size_t)n * 1024 + col0) * 512, 512, 512, au, sA, sA + 256 * GLD);
#pragma unroll
            for (int mt = 0; mt < 8; ++mt)
#pragma unroll
                for (int nt = 0; nt < 4; ++nt) {
                    const unsigned g01 = sg[mt * 2 + (nt >> 1)][(nt & 1) * 2], g23 = sg[mt * 2 + (nt >> 1)][(nt & 1) * 2 + 1];
                    m[mt][nt][0] += lo16(g01) * au[mt][nt][0]; m[mt][nt][1] += hi16(g01) * au[mt][nt][1];
                    m[mt][nt][2] += lo16(g23) * au[mt][nt][2]; m[mt][nt][3] += hi16(g23) * au[mt][nt][3];
                }
        }
#pragma unroll
        for (int mt = 0; mt < 8; ++mt) {
            __builtin_amdgcn_sched_barrier(0);
            bf16_t* up = U + (size_t)(row0 + wr * 128 + mt * 16 + l15) * D + col0 + wc * 64 + quad * 4;
#pragma unroll
            for (int nt = 0; nt < 4; ++nt) { u32x2 o; o.x = pack2(m[mt][nt][0], m[mt][nt][1]); o.y = pack2(m[mt][nt][2], m[mt][nt][3]); *(u32x2*)(up + nt * 16) = o; }
        }
    }
}

DEV void phase_resid(const Params& p, int l, const bf16_t* A, int lda, const bf16_t* Wt, int K, int chunk, bool first, bool latent_only, unsigned char* smem) {
    bf16_t* sA = (bf16_t*)smem;
    const int tid = get_tid(), lane = tid & 63, wv = tid >> 6, wr = wv >> 1, wc = wv & 1, l15 = lane & 15, quad = lane >> 4;
    const int nrt = latent_only ? 128 : 136;
    for (TileIter ti(nrt, 8); ti.valid(); ti.next()) {
        int tm, tn; ti.get(tm, tn);
        const int row0 = rowtile0(tm, latent_only), col0 = tn * 128;
        f32x4 acc[8][4]; zero_acc(acc);
        gemm_core<8, 4>(A + (size_t)row0 * lda, lda, Wt + (size_t)col0 * K, K, K, acc, sA);
        const float* md = wsf(p, O_MOD) + ((size_t)l * 9 + modrow(row0)) * 6144 + chunk * D + col0 + wc * 64 + quad * 4;
        const float* hs0 = first ? xrow(p, row0) : hrow(p, row0);
        float* hd0 = hrow(p, row0);
        f32x4 mg[4];
#pragma unroll
        for (int nt = 0; nt < 4; ++nt) mg[nt] = *(const f32x4*)(md + nt * 16);
#pragma unroll
        for (int mt = 0; mt < 8; ++mt) {
            __builtin_amdgcn_sched_barrier(0);
            const size_t ro = (size_t)(wr * 128 + mt * 16 + l15) * D + col0 + wc * 64 + quad * 4;
#pragma unroll
            for (int nt = 0; nt < 4; ++nt) { const f32x4 h = *(const f32x4*)(hs0 + ro + nt * 16); *(f32x4*)(hd0 + ro + nt * 16) = h + mg[nt] * acc[mt][nt]; }
        }
    }
}
DEV void phase_gu(const Params& p, bool latent_only, unsigned char* smem) {
    bf16_t* sA = (bf16_t*)smem;
    const int tid = get_tid(), lane = tid & 63, wv = tid >> 6, wr = wv >> 1, wc = wv & 1, l15 = lane & 15, quad = lane >> 4;
    const bf16_t* U = wsb(p, O_U); const bf16_t* W = wsb(p, O_WT) + W_GU;
    bf16_t* P = wsb(p, O_P);
    const int nrt = latent_only ? 128 : 136;
    for (TileIter ti(nrt, 44); ti.valid(); ti.next()) {
        int tm, tn; ti.get(tm, tn);
        const int row0 = rowtile0(tm, latent_only);
        f32x4 acc[8][4]; zero_acc(acc);
        gemm_core<8, 4>(U + (size_t)row0 * D, D, W + (size_t)tn * 128 * D, D, D, acc, sA);
#pragma unroll
        for (int mt = 0; mt < 8; ++mt) {
            __builtin_amdgcn_sched_barrier(0);
            bf16_t* pp = P + (size_t)(row0 + wr * 128 + mt * 16 + l15) * PW + (tn * 4 + wc * 2) * 16 + quad * 4;
#pragma unroll
            for (int pr = 0; pr < 2; ++pr) {
                const f32x4 g = acc[mt][2 * pr], u = acc[mt][2 * pr + 1];
                u32x2 o; o.x = pack2(silu(g[0]) * u[0], silu(g[1]) * u[1]); o.y = pack2(silu(g[2]) * u[2], silu(g[3]) * u[3]);
                *(u32x2*)(pp + pr * 16) = o;
            }
        }
    }
}

DEV int chunk_of(int dir, int n) { return dir ? (n < 4 ? 3 - n : 71 - n) : n; }

typedef float f32x2 __attribute__((ext_vector_type(2)));
DEV void dn_solve(const float* __restrict__ Lt_s0, const bf16_t* __restrict__ colp, const float* __restrict__ mulp0, const float sg, bf16_t* __restrict__ outp) {
    int vz = 0; asm volatile("" : "+v"(vz));
    const float* __restrict__ Lt_s = Lt_s0 + vz; const float* __restrict__ mulp = mulp0 + vz;
    f32x2 X0, X1, X2, X3, X4, X5, X6, X7, X8, X9, X10, X11, X12, X13, X14, X15, X16, X17, X18, X19, X20, X21, X22, X23, X24, X25, X26, X27, X28, X29, X30, X31;
    f32x4 La0, La1, La2, La3, La4, La5, La6, La7, La8, La9, La10, La11, La12, La13, La14, La15, Lb0, Lb1, Lb2, Lb3, Lb4, Lb5, Lb6, Lb7, Lb8, Lb9, Lb10, Lb11, Lb12, Lb13, Lb14, Lb15;
    X0 = (f32x2){bf2f(colp[0]) * mulp[0], bf2f(colp[136]) * mulp[1]};
    X1 = (f32x2){bf2f(colp[272]) * mulp[2], bf2f(colp[408]) * mulp[3]};
    X2 = (f32x2){bf2f(colp[544]) * mulp[4], bf2f(colp[680]) * mulp[5]};
    X3 = (f32x2){bf2f(colp[816]) * mulp[6], bf2f(colp[952]) * mulp[7]};
    X4 = (f32x2){bf2f(colp[1088]) * mulp[8], bf2f(colp[1224]) * mulp[9]};
    X5 = (f32x2){bf2f(colp[1360]) * mulp[10], bf2f(colp[1496]) * mulp[11]};
    X6 = (f32x2){bf2f(colp[1632]) * mulp[12], bf2f(colp[1768]) * mulp[13]};
    X7 = (f32x2){bf2f(colp[1904]) * mulp[14], bf2f(colp[2040]) * mulp[15]};
    X8 = (f32x2){bf2f(colp[2176]) * mulp[16], bf2f(colp[2312]) * mulp[17]};
    X9 = (f32x2){bf2f(colp[2448]) * mulp[18], bf2f(colp[2584]) * mulp[19]};
    X10 = (f32x2){bf2f(colp[2720]) * mulp[20], bf2f(colp[2856]) * mulp[21]};
    X11 = (f32x2){bf2f(colp[2992]) * mulp[22], bf2f(colp[3128]) * mulp[23]};
    X12 = (f32x2){bf2f(colp[3264]) * mulp[24], bf2f(colp[3400]) * mulp[25]};
    X13 = (f32x2){bf2f(colp[3536]) * mulp[26], bf2f(colp[3672]) * mulp[27]};
    X14 = (f32x2){bf2f(colp[3808]) * mulp[28], bf2f(colp[3944]) * mulp[29]};
    X15 = (f32x2){bf2f(colp[4080]) * mulp[30], bf2f(colp[4216]) * mulp[31]};
    X16 = (f32x2){bf2f(colp[4352]) * mulp[32], bf2f(colp[4488]) * mulp[33]};
    X17 = (f32x2){bf2f(colp[4624]) * mulp[34], bf2f(colp[4760]) * mulp[35]};
    X18 = (f32x2){bf2f(colp[4896]) * mulp[36], bf2f(colp[5032]) * mulp[37]};
    X19 = (f32x2){bf2f(colp[5168]) * mulp[38], bf2f(colp[5304]) * mulp[39]};
    X20 = (f32x2){bf2f(colp[5440]) * mulp[40], bf2f(colp[5576]) * mulp[41]};
    X21 = (f32x2){bf2f(colp[5712]) * mulp[42], bf2f(colp[5848]) * mulp[43]};
    X22 = (f32x2){bf2f(colp[5984]) * mulp[44], bf2f(colp[6120]) * mulp[45]};
    X23 = (f32x2){bf2f(colp[6256]) * mulp[46], bf2f(colp[6392]) * mulp[47]};
    X24 = (f32x2){bf2f(colp[6528]) * mulp[48], bf2f(colp[6664]) * mulp[49]};
    X25 = (f32x2){bf2f(colp[6800]) * mulp[50], bf2f(colp[6936]) * mulp[51]};
    X26 = (f32x2){bf2f(colp[7072]) * mulp[52], bf2f(colp[7208]) * mulp[53]};
    X27 = (f32x2){bf2f(colp[7344]) * mulp[54], bf2f(colp[7480]) * mulp[55]};
    X28 = (f32x2){bf2f(colp[7616]) * mulp[56], bf2f(colp[7752]) * mulp[57]};
    X29 = (f32x2){bf2f(colp[7888]) * mulp[58], bf2f(colp[8024]) * mulp[59]};
    X30 = (f32x2){bf2f(colp[8160]) * mulp[60], bf2f(colp[8296]) * mulp[61]};
    X31 = (f32x2){bf2f(colp[8432]) * mulp[62], bf2f(colp[8568]) * mulp[63]};
    La0 = *(const f32x4*)(Lt_s + 0);
    La1 = *(const f32x4*)(Lt_s + 4);
    La2 = *(const f32x4*)(Lt_s + 8);
    La3 = *(const f32x4*)(Lt_s + 12);
    La4 = *(const f32x4*)(Lt_s + 16);
    La5 = *(const f32x4*)(Lt_s + 20);
    La6 = *(const f32x4*)(Lt_s + 24);
    La7 = *(const f32x4*)(Lt_s + 28);
    La8 = *(const f32x4*)(Lt_s + 32);
    La9 = *(const f32x4*)(Lt_s + 36);
    La10 = *(const f32x4*)(Lt_s + 40);
    La11 = *(const f32x4*)(Lt_s + 44);
    La12 = *(const f32x4*)(Lt_s + 48);
    La13 = *(const f32x4*)(Lt_s + 52);
    La14 = *(const f32x4*)(Lt_s + 56);
    La15 = *(const f32x4*)(Lt_s + 60);
    Lb0 = *(const f32x4*)(Lt_s + 68);
    Lb1 = *(const f32x4*)(Lt_s + 72);
    Lb2 = *(const f32x4*)(Lt_s + 76);
    Lb3 = *(const f32x4*)(Lt_s + 80);
    Lb4 = *(const f32x4*)(Lt_s + 84);
    Lb5 = *(const f32x4*)(Lt_s + 88);
    Lb6 = *(const f32x4*)(Lt_s + 92);
    Lb7 = *(const f32x4*)(Lt_s + 96);
    Lb8 = *(const f32x4*)(Lt_s + 100);
    Lb9 = *(const f32x4*)(Lt_s + 104);
    Lb10 = *(const f32x4*)(Lt_s + 108);
    Lb11 = *(const f32x4*)(Lt_s + 112);
    Lb12 = *(const f32x4*)(Lt_s + 116);
    Lb13 = *(const f32x4*)(Lt_s + 120);
    Lb14 = *(const f32x4*)(Lt_s + 124);
    Lb15 = *(const f32x4*)(Lt_s + 128);
    __builtin_amdgcn_sched_barrier(0);
    { const float xj = X0[0]; const f32x2 xj2 = (f32x2){xj, xj};
      X0 -= (f32x2){La0[0], La0[1]} * xj2;
      X1 -= (f32x2){La0[2], La0[3]} * xj2;
      X2 -= (f32x2){La1[0], La1[1]} * xj2;
      X3 -= (f32x2){La1[2], La1[3]} * xj2;
      X4 -= (f32x2){La2[0], La2[1]} * xj2;
      X5 -= (f32x2){La2[2], La2[3]} * xj2;
      X6 -= (f32x2){La3[0], La3[1]} * xj2;
      X7 -= (f32x2){La3[2], La3[3]} * xj2;
      X8 -= (f32x2){La4[0], La4[1]} * xj2;
      X9 -= (f32x2){La4[2], La4[3]} * xj2;
      X10 -= (f32x2){La5[0], La5[1]} * xj2;
      X11 -= (f32x2){La5[2], La5[3]} * xj2;
      X12 -= (f32x2){La6[0], La6[1]} * xj2;
      X13 -= (f32x2){La6[2], La6[3]} * xj2;
      X14 -= (f32x2){La7[0], La7[1]} * xj2;
      X15 -= (f32x2){La7[2], La7[3]} * xj2;
      X16 -= (f32x2){La8[0], La8[1]} * xj2;
      X17 -= (f32x2){La8[2], La8[3]} * xj2;
      X18 -= (f32x2){La9[0], La9[1]} * xj2;
      X19 -= (f32x2){La9[2], La9[3]} * xj2;
      X20 -= (f32x2){La10[0], La10[1]} * xj2;
      X21 -= (f32x2){La10[2], La10[3]} * xj2;
      X22 -= (f32x2){La11[0], La11[1]} * xj2;
      X23 -= (f32x2){La11[2], La11[3]} * xj2;
      X24 -= (f32x2){La12[0], La12[1]} * xj2;
      X25 -= (f32x2){La12[2], La12[3]} * xj2;
      X26 -= (f32x2){La13[0], La13[1]} * xj2;
      X27 -= (f32x2){La13[2], La13[3]} * xj2;
      X28 -= (f32x2){La14[0], La14[1]} * xj2;
      X29 -= (f32x2){La14[2], La14[3]} * xj2;
      X30 -= (f32x2){La15[0], La15[1]} * xj2;
      X31 -= (f32x2){La15[2], La15[3]} * xj2;
    }
    __builtin_amdgcn_sched_barrier(0);
    La0 = *(const f32x4*)(Lt_s + 136);
    La1 = *(const f32x4*)(Lt_s + 140);
    La2 = *(const f32x4*)(Lt_s + 144);
    La3 = *(const f32x4*)(Lt_s + 148);
    La4 = *(const f32x4*)(Lt_s + 152);
    La5 = *(const f32x4*)(Lt_s + 156);
    La6 = *(const f32x4*)(Lt_s + 160);
    La7 = *(const f32x4*)(Lt_s + 164);
    La8 = *(const f32x4*)(Lt_s + 168);
    La9 = *(const f32x4*)(Lt_s + 172);
    La10 = *(const f32x4*)(Lt_s + 176);
    La11 = *(const f32x4*)(Lt_s + 180);
    La12 = *(const f32x4*)(Lt_s + 184);
    La13 = *(const f32x4*)(Lt_s + 188);
    La14 = *(const f32x4*)(Lt_s + 192);
    La15 = *(const f32x4*)(Lt_s + 196);
    __builtin_amdgcn_sched_barrier(0);
    { const float xj = X0[1]; const f32x2 xj2 = (f32x2){xj, xj};
      X1 -= (f32x2){Lb0[2], Lb0[3]} * xj2;
      X2 -= (f32x2){Lb1[0], Lb1[1]} * xj2;
      X3 -= (f32x2){Lb1[2], Lb1[3]} * xj2;
      X4 -= (f32x2){Lb2[0], Lb2[1]} * xj2;
      X5 -= (f32x2){Lb2[2], Lb2[3]} * xj2;
      X6 -= (f32x2){Lb3[0], Lb3[1]} * xj2;
      X7 -= (f32x2){Lb3[2], Lb3[3]} * xj2;
      X8 -= (f32x2){Lb4[0], Lb4[1]} * xj2;
      X9 -= (f32x2){Lb4[2], Lb4[3]} * xj2;
      X10 -= (f32x2){Lb5[0], Lb5[1]} * xj2;
      X11 -= (f32x2){Lb5[2], Lb5[3]} * xj2;
      X12 -= (f32x2){Lb6[0], Lb6[1]} * xj2;
      X13 -= (f32x2){Lb6[2], Lb6[3]} * xj2;
      X14 -= (f32x2){Lb7[0], Lb7[1]} * xj2;
      X15 -= (f32x2){Lb7[2], Lb7[3]} * xj2;
      X16 -= (f32x2){Lb8[0], Lb8[1]} * xj2;
      X17 -= (f32x2){Lb8[2], Lb8[3]} * xj2;
      X18 -= (f32x2){Lb9[0], Lb9[1]} * xj2;
      X19 -= (f32x2){Lb9[2], Lb9[3]} * xj2;
      X20 -= (f32x2){Lb10[0], Lb10[1]} * xj2;
      X21 -= (f32x2){Lb10[2], Lb10[3]} * xj2;
      X22 -= (f32x2){Lb11[0], Lb11[1]} * xj2;
      X23 -= (f32x2){Lb11[2], Lb11[3]} * xj2;
      X24 -= (f32x2){Lb12[0], Lb12[1]} * xj2;
      X25 -= (f32x2){Lb12[2], Lb12[3]} * xj2;
      X26 -= (f32x2){Lb13[0], Lb13[1]} * xj2;
      X27 -= (f32x2){Lb13[2], Lb13[3]} * xj2;
      X28 -= (f32x2){Lb14[0], Lb14[1]} * xj2;
      X29 -= (f32x2){Lb14[2], Lb14[3]} * xj2;
      X30 -= (f32x2){Lb15[0], Lb15[1]} * xj2;
      X31 -= (f32x2){Lb15[2], Lb15[3]} * xj2;
    }
    __builtin_amdgcn_sched_barrier(0);
    Lb1 = *(const f32x4*)(Lt_s + 208);
    Lb2 = *(const f32x4*)(Lt_s + 212);
    Lb3 = *(const f32x4*)(Lt_s + 216);
    Lb4 = *(const f32x4*)(Lt_s + 220);
    Lb5 = *(const f32x4*)(Lt_s + 224);
    Lb6 = *(const f32x4*)(Lt_s + 228);
    Lb7 = *(const f32x4*)(Lt_s + 232);
    Lb8 = *(const f32x4*)(Lt_s + 236);
    Lb9 = *(const f32x4*)(Lt_s + 240);
    Lb10 = *(const f32x4*)(Lt_s + 244);
    Lb11 = *(const f32x4*)(Lt_s + 248);
    Lb12 = *(const f32x4*)(Lt_s + 252);
    Lb13 = *(const f32x4*)(Lt_s + 256);
    Lb14 = *(const f32x4*)(Lt_s + 260);
    Lb15 = *(const f32x4*)(Lt_s + 264);
    __builtin_amdgcn_sched_barrier(0);
    { const float xj = X1[0]; const f32x2 xj2 = (f32x2){xj, xj};
      X1 -= (f32x2){La0[2], La0[3]} * xj2;
      X2 -= (f32x2){La1[0], La1[1]} * xj2;
      X3 -= (f32x2){La1[2], La1[3]} * xj2;
      X4 -= (f32x2){La2[0], La2[1]} * xj2;
      X5 -= (f32x2){La2[2], La2[3]} * xj2;
      X6 -= (f32x2){La3[0], La3[1]} * xj2;
      X7 -= (f32x2){La3[2], La3[3]} * xj2;
      X8 -= (f32x2){La4[0], La4[1]} * xj2;
      X9 -= (f32x2){La4[2], La4[3]} * xj2;
      X10 -= (f32x2){La5[0], La5[1]} * xj2;
      X11 -= (f32x2){La5[2], La5[3]} * xj2;
      X12 -= (f32x2){La6[0], La6[1]} * xj2;
      X13 -= (f32x2){La6[2], La6[3]} * xj2;
      X14 -= (f32x2){La7[0], La7[1]} * xj2;
      X15 -= (f32x2){La7[2], La7[3]} * xj2;
      X16 -= (f32x2){La8[0], La8[1]} * xj2;
      X17 -= (f32x2){La8[2], La8[3]} * xj2;
      X18 -= (f32x2){La9[0], La9[1]} * xj2;
      X19 -= (f32x2){La9[2], La9[3]} * xj2;
      X20 -= (f32x2){La10[0], La10[1]} * xj2;
      X21 -= (f32x2){La10[2], La10[3]} * xj2;
      X22 -= (f32x2){La11[0], La11[1]} * xj2;
      X23 -= (f32x2){La11[2], La11[3]} * xj2;
      X24 -= (f32x2){La12[0], La12[1]} * xj2;
      X25 -= (f32x2){La12[2], La12[3]} * xj2;
      X26 -= (f32x2){La13[0], La13[1]} * xj2;
      X27 -= (f32x2){La13[2], La13[3]} * xj2;
      X28 -= (f32x2){La14[0], La14[1]} * xj2;
      X29 -= (f32x2){La14[2], La14[3]} * xj2;
      X30 -= (f32x2){La15[0], La15[1]} * xj2;
      X31 -= (f32x2){La15[2], La15[3]} * xj2;
    }
    __builtin_amdgcn_sched_barrier(0);
    La1 = *(const f32x4*)(Lt_s + 276);
    La2 = *(const f32x4*)(Lt_s + 280);
    La3 = *(const f32x4*)(Lt_s + 284);
    La4 = *(const f32x4*)(Lt_s + 288);
    La5 = *(const f32x4*)(Lt_s + 292);
    La6 = *(const f32x4*)(Lt_s + 296);
    La7 = *(const f32x4*)(Lt_s + 300);
    La8 = *(const f32x4*)(Lt_s + 304);
    La9 = *(const f32x4*)(Lt_s + 308);
    La10 = *(const f32x4*)(Lt_s + 312);
    La11 = *(const f32x4*)(Lt_s + 316);
    La12 = *(const f32x4*)(Lt_s + 320);
    La13 = *(const f32x4*)(Lt_s + 324);
    La14 = *(const f32x4*)(Lt_s + 328);
    La15 = *(const f32x4*)(Lt_s + 332);
    __builtin_amdgcn_sched_barrier(0);
    { const float xj = X1[1]; const f32x2 xj2 = (f32x2){xj, xj};
      X2 -= (f32x2){Lb1[0], Lb1[1]} * xj2;
      X3 -= (f32x2){Lb1[2], Lb1[3]} * xj2;
      X4 -= (f32x2){Lb2[0], Lb2[1]} * xj2;
      X5 -= (f32x2){Lb2[2], Lb2[3]} * xj2;
      X6 -= (f32x2){Lb3[0], Lb3[1]} * xj2;
      X7 -= (f32x2){Lb3[2], Lb3[3]} * xj2;
      X8 -= (f32x2){Lb4[0], Lb4[1]} * xj2;
      X9 -= (f32x2){Lb4[2], Lb4[3]} * xj2;
      X10 -= (f32x2){Lb5[0], Lb5[1]} * xj2;
      X11 -= (f32x2){Lb5[2], Lb5[3]} * xj2;
      X12 -= (f32x2){Lb6[0], Lb6[1]} * xj2;
      X13 -= (f32x2){Lb6[2], Lb6[3]} * xj2;
      X14 -= (f32x2){Lb7[0], Lb7[1]} * xj2;
      X15 -= (f32x2){Lb7[2], Lb7[3]} * xj2;
      X16 -= (f32x2){Lb8[0], Lb8[1]} * xj2;
      X17 -= (f32x2){Lb8[2], Lb8[3]} * xj2;
      X18 -= (f32x2){Lb9[0], Lb9[1]} * xj2;
      X19 -= (f32x2){Lb9[2], Lb9[3]} * xj2;
      X20 -= (f32x2){Lb10[0], Lb10[1]} * xj2;
      X21 -= (f32x2){Lb10[2], Lb10[3]} * xj2;
      X22 -= (f32x2){Lb11[0], Lb11[1]} * xj2;
      X23 -= (f32x2){Lb11[2], Lb11[3]} * xj2;
      X24 -= (f32x2){Lb12[0], Lb12[1]} * xj2;
      X25 -= (f32x2){Lb12[2], Lb12[3]} * xj2;
      X26 -= (f32x2){Lb13[0], Lb13[1]} * xj2;
      X27 -= (f32x2){Lb13[2], Lb13[3]} * xj2;
      X28 -= (f32x2){Lb14[0], Lb14[1]} * xj2;
      X29 -= (f32x2){Lb14[2], Lb14[3]} * xj2;
      X30 -= (f32x2){Lb15[0], Lb15[1]} * xj2;
      X31 -= (f32x2){Lb15[2], Lb15[3]} * xj2;
    }
    __builtin_amdgcn_sched_barrier(0);
    Lb1 = *(const f32x4*)(Lt_s + 344);
    Lb2 = *(const f32x4*)(Lt_s + 348);
    Lb3 = *(const f32x4*)(Lt_s + 352);
    Lb4 = *(const f32x4*)(Lt_s + 356);
    Lb5 = *(const f32x4*)(Lt_s + 360);
    Lb6 = *(const f32x4*)(Lt_s + 364);
    Lb7 = *(const f32x4*)(Lt_s + 368);
    Lb8 = *(const f32x4*)(Lt_s + 372);
    Lb9 = *(const f32x4*)(Lt_s + 376);
    Lb10 = *(const f32x4*)(Lt_s + 380);
    Lb11 = *(const f32x4*)(Lt_s + 384);
    Lb12 = *(const f32x4*)(Lt_s + 388);
    Lb13 = *(const f32x4*)(Lt_s + 392);
    Lb14 = *(const f32x4*)(Lt_s + 396);
    Lb15 = *(const f32x4*)(Lt_s + 400);
    __builtin_amdgcn_sched_barrier(0);
    { const float xj = X2[0]; const f32x2 xj2 = (f32x2){xj, xj};
      X2 -= (f32x2){La1[0], La1[1]} * xj2;
      X3 -= (f32x2){La1[2], La1[3]} * xj2;
      X4 -= (f32x2){La2[0], La2[1]} * xj2;
      X5 -= (f32x2){La2[2], La2[3]} * xj2;
      X6 -= (f32x2){La3[0], La3[1]} * xj2;
      X7 -= (f32x2){La3[2], La3[3]} * xj2;
      X8 -= (f32x2){La4[0], La4[1]} * xj2;
      X9 -= (f32x2){La4[2], La4[3]} * xj2;
      X10 -= (f32x2){La5[0], La5[1]} * xj2;
      X11 -= (f32x2){La5[2], La5[3]} * xj2;
      X12 -= (f32x2){La6[0], La6[1]} * xj2;
      X13 -= (f32x2){La6[2], La6[3]} * xj2;
      X14 -= (f32x2){La7[0], La7[1]} * xj2;
      X15 -= (f32x2){La7[2], La7[3]} * xj2;
      X16 -= (f32x2){La8[0], La8[1]} * xj2;
      X17 -= (f32x2){La8[2], La8[3]} * xj2;
      X18 -= (f32x2){La9[0], La9[1]} * xj2;
      X19 -= (f32x2){La9[2], La9[3]} * xj2;
      X20 -= (f32x2){La10[0], La10[1]} * xj2;
      X21 -= (f32x2){La10[2], La10[3]} * xj2;
      X22 -= (f32x2){La11[0], La11[1]} * xj2;
      X23 -= (f32x2){La11[2], La11[3]} * xj2;
      X24 -= (f32x2){La12[0], La12[1]} * xj2;
      X25 -= (f32x2){La12[2], La12[3]} * xj2;
      X26 -= (f32x2){La13[0], La13[1]} * xj2;
      X27 -= (f32x2){La13[2], La13[3]} * xj2;
      X28 -= (f32x2){La14[0], La14[1]} * xj2;
      X29 -= (f32x2){La14[2], La14[3]} * xj2;
      X30 -= (f32x2){La15[0], La15[1]} * xj2;
      X31 -= (f32x2){La15[2], La15[3]} * xj2;
    }
    __builtin_amdgcn_sched_barrier(0);
    La1 = *(const f32x4*)(Lt_s + 412);
    La2 = *(const f32x4*)(Lt_s + 416);
    La3 = *(const f32x4*)(Lt_s + 420);
    La4 = *(const f32x4*)(Lt_s + 424);
    La5 = *(const f32x4*)(Lt_s + 428);
    La6 = *(const f32x4*)(Lt_s + 432);
    La7 = *(const f32x4*)(Lt_s + 436);
    La8 = *(const f32x4*)(Lt_s + 440);
    La9 = *(const f32x4*)(Lt_s + 444);
    La10 = *(const f32x4*)(Lt_s + 448);
    La11 = *(const f32x4*)(Lt_s + 452);
    La12 = *(const f32x4*)(Lt_s + 456);
    La13 = *(const f32x4*)(Lt_s + 460);
    La14 = *(const f32x4*)(Lt_s + 464);
    La15 = *(const f32x4*)(Lt_s + 468);
    __builtin_amdgcn_sched_barrier(0);
    { const float xj = X2[1]; const f32x2 xj2 = (f32x2){xj, xj};
      X3 -= (f32x2){Lb1[2], Lb1[3]} * xj2;
      X4 -= (f32x2){Lb2[0], Lb2[1]} * xj2;
      X5 -= (f32x2){Lb2[2], Lb2[3]} * xj2;
      X6 -= (f32x2){Lb3[0], Lb3[1]} * xj2;
      X7 -= (f32x2){Lb3[2], Lb3[3]} * xj2;
      X8 -= (f32x2){Lb4[0], Lb4[1]} * xj2;
      X9 -= (f32x2){Lb4[2], Lb4[3]} * xj2;
      X10 -= (f32x2){Lb5[0], Lb5[1]} * xj2;
      X11 -= (f32x2){Lb5[2], Lb5[3]} * xj2;
      X12 -= (f32x2){Lb6[0], Lb6[1]} * xj2;
      X13 -= (f32x2){Lb6[2], Lb6[3]} * xj2;
      X14 -= (f32x2){Lb7[0], Lb7[1]} * xj2;
      X15 -= (f32x2){Lb7[2], Lb7[3]} * xj2;
      X16 -= (f32x2){Lb8[0], Lb8[1]} * xj2;
      X17 -= (f32x2){Lb8[2], Lb8[3]} * xj2;
      X18 -= (f32x2){Lb9[0], Lb9[1]} * xj2;
      X19 -= (f32x2){Lb9[2], Lb9[3]} * xj2;
      X20 -= (f32x2){Lb10[0], Lb10[1]} * xj2;
      X21 -= (f32x2){Lb10[2], Lb10[3]} * xj2;
      X22 -= (f32x2){Lb11[0], Lb11[1]} * xj2;
      X23 -= (f32x2){Lb11[2], Lb11[3]} * xj2;
      X24 -= (f32x2){Lb12[0], Lb12[1]} * xj2;
      X25 -= (f32x2){Lb12[2], Lb12[3]} * xj2;
      X26 -= (f32x2){Lb13[0], Lb13[1]} * xj2;
      X27 -= (f32x2){Lb13[2], Lb13[3]} * xj2;
      X28 -= (f32x2){Lb14[0], Lb14[1]} * xj2;
      X29 -= (f32x2){Lb14[2], Lb14[3]} * xj2;
      X30 -= (f32x2){Lb15[0], Lb15[1]} * xj2;
      X31 -= (f32x2){Lb15[2], Lb15[3]} * xj2;
    }
    __builtin_amdgcn_sched_barrier(0);
    Lb2 = *(const f32x4*)(Lt_s + 484);
    Lb3 = *(const f32x4*)(Lt_s + 488);
    Lb4 = *(const f32x4*)(Lt_s + 492);
    Lb5 = *(const f32x4*)(Lt_s + 496);
    Lb6 = *(const f32x4*)(Lt_s + 500);
    Lb7 = *(const f32x4*)(Lt_s + 504);
    Lb8 = *(const f32x4*)(Lt_s + 508);
    Lb9 = *(const f32x4*)(Lt_s + 512);
    Lb10 = *(const f32x4*)(Lt_s + 516);
    Lb11 = *(const f32x4*)(Lt_s + 520);
    Lb12 = *(const f32x4*)(Lt_s + 524);
    Lb13 = *(const f32x4*)(Lt_s + 528);
    Lb14 = *(const f32x4*)(Lt_s + 532);
    Lb15 = *(const f32x4*)(Lt_s + 536);
    __builtin_amdgcn_sched_barrier(0);
    { const float xj = X3[0]; const f32x2 xj2 = (f32x2){xj, xj};
      X3 -= (f32x2){La1[2], La1[3]} * xj2;
      X4 -= (f32x2){La2[0], La2[1]} * xj2;
      X5 -= (f32x2){La2[2], La2[3]} * xj2;
      X6 -= (f32x2){La3[0], La3[1]} * xj2;
      X7 -= (f32x2){La3[2], La3[3]} * xj2;
      X8 -= (f32x2){La4[0], La4[1]} * xj2;
      X9 -= (f32x2){La4[2], La4[3]} * xj2;
      X10 -= (f32x2){La5[0], La5[1]} * xj2;
      X11 -= (f32x2){La5[2], La5[3]} * xj2;
      X12 -= (f32x2){La6[0], La6[1]} * xj2;
      X13 -= (f32x2){La6[2], La6[3]} * xj2;
      X14 -= (f32x2){La7[0], La7[1]} * xj2;
      X15 -= (f32x2){La7[2], La7[3]} * xj2;
      X16 -= (f32x2){La8[0], La8[1]} * xj2;
      X17 -= (f32x2){La8[2], La8[3]} * xj2;
      X18 -= (f32x2){La9[0], La9[1]} * xj2;
      X19 -= (f32x2){La9[2], La9[3]} * xj2;
      X20 -= (f32x2){La10[0], La10[1]} * xj2;
      X21 -= (f32x2){La10[2], La10[3]} * xj2;
      X22 -= (f32x2){La11[0], La11[1]} * xj2;
      X23 -= (f32x2){La11[2], La11[3]} * xj2;
      X24 -= (f32x2){La12[0], La12[1]} * xj2;
      X25 -= (f32x2){La12[2], La12[3]} * xj2;
      X26 -= (f32x2){La13[0], La13[1]} * xj2;
      X27 -= (f32x2){La13[2], La13[3]} * xj2;
      X28 -= (f32x2){La14[0], La14[1]} * xj2;
      X29 -= (f32x2){La14[2], La14[3]} * xj2;
      X30 -= (f32x2){La15[0], La15[1]} * xj2;
      X31 -= (f32x2){La15[2], La15[3]} * xj2;
    }
    __builtin_amdgcn_sched_barrier(0);
    La2 = *(const f32x4*)(Lt_s + 552);
    La3 = *(const f32x4*)(Lt_s + 556);
    La4 = *(const f32x4*)(Lt_s + 560);
    La5 = *(const f32x4*)(Lt_s + 564);
    La6 = *(const f32x4*)(Lt_s + 568);
    La7 = *(const f32x4*)(Lt_s + 572);
    La8 = *(const f32x4*)(Lt_s + 576);
    La9 = *(const f32x4*)(Lt_s + 580);
    La10 = *(const f32x4*)(Lt_s + 584);
    La11 = *(const f32x4*)(Lt_s + 588);
    La12 = *(const f32x4*)(Lt_s + 592);
    La13 = *(const f32x4*)(Lt_s + 596);
    La14 = *(const f32x4*)(Lt_s + 600);
    La15 = *(const f32x4*)(Lt_s + 604);
    __builtin_amdgcn_sched_barrier(0);
    { const float xj = X3[1]; const f32x2 xj2 = (f32x2){xj, xj};
      X4 -= (f32x2){Lb2[0], Lb2[1]} * xj2;
      X5 -= (f32x2){Lb2[2], Lb2[3]} * xj2;
      X6 -= (f32x2){Lb3[0], Lb3[1]} * xj2;
      X7 -= (f32x2){Lb3[2], Lb3[3]} * xj2;
      X8 -= (f32x2){Lb4[0], Lb4[1]} * xj2;
      X9 -= (f32x2){Lb4[2], Lb4[3]} * xj2;
      X10 -= (f32x2){Lb5[0], Lb5[1]} * xj2;
      X11 -= (f32x2){Lb5[2], Lb5[3]} * xj2;
      X12 -= (f32x2){Lb6[0], Lb6[1]} * xj2;
      X13 -= (f32x2){Lb6[2], Lb6[3]} * xj2;
      X14 -= (f32x2){Lb7[0], Lb7[1]} * xj2;
      X15 -= (f32x2){Lb7[2], Lb7[3]} * xj2;
      X16 -= (f32x2){Lb8[0], Lb8[1]} * xj2;
      X17 -= (f32x2){Lb8[2], Lb8[3]} * xj2;
      X18 -= (f32x2){Lb9[0], Lb9[1]} * xj2;
      X19 -= (f32x2){Lb9[2], Lb9[3]} * xj2;
      X20 -= (f32x2){Lb10[0], Lb10[1]} * xj2;
      X21 -= (f32x2){Lb10[2], Lb10[3]} * xj2;
      X22 -= (f32x2){Lb11[0], Lb11[1]} * xj2;
      X23 -= (f32x2){Lb11[2], Lb11[3]} * xj2;
      X24 -= (f32x2){Lb12[0], Lb12[1]} * xj2;
      X25 -= (f32x2){Lb12[2], Lb12[3]} * xj2;
      X26 -= (f32x2){Lb13[0], Lb13[1]} * xj2;
      X27 -= (f32x2){Lb13[2], Lb13[3]} * xj2;
      X28 -= (f32x2){Lb14[0], Lb14[1]} * xj2;
      X29 -= (f32x2){Lb14[2], Lb14[3]} * xj2;
      X30 -= (f32x2){Lb15[0], Lb15[1]} * xj2;
      X31 -= (f32x2){Lb15[2], Lb15[3]} * xj2;
    }
    __builtin_amdgcn_sched_barrier(0);
    Lb2 = *(const f32x4*)(Lt_s + 620);
    Lb3 = *(const f32x4*)(Lt_s + 624);
    Lb4 = *(const f32x4*)(Lt_s + 628);
    Lb5 = *(const f32x4*)(Lt_s + 632);
    Lb6 = *(const f32x4*)(Lt_s + 636);
    Lb7 = *(const f32x4*)(Lt_s + 640);
    Lb8 = *(const f32x4*)(Lt_s + 644);
    Lb9 = *(const f32x4*)(Lt_s + 648);
    Lb10 = *(const f32x4*)(Lt_s + 652);
    Lb11 = *(const f32x4*)(Lt_s + 656);
    Lb12 = *(const f32x4*)(Lt_s + 660);
    Lb13 = *(const f32x4*)(Lt_s + 664);
    Lb14 = *(const f32x4*)(Lt_s + 668);
    Lb15 = *(const f32x4*)(Lt_s + 672);
    __builtin_amdgcn_sched_barrier(0);
    { const float xj = X4[0]; const f32x2 xj2 = (f32x2){xj, xj};
      X4 -= (f32x2){La2[0], La2[1]} * xj2;
      X5 -= (f32x2){La2[2], La2[3]} * xj2;
      X6 -= (f32x2){La3[0], La3[1]} * xj2;
      X7 -= (f32x2){La3[2], La3[3]} * xj2;
      X8 -= (f32x2){La4[0], La4[1]} * xj2;
      X9 -= (f32x2){La4[2], La4[3]} * xj2;
      X10 -= (f32x2){La5[0], La5[1]} * xj2;
      X11 -= (f32x2){La5[2], La5[3]} * xj2;
      X12 -= (f32x2){La6[0], La6[1]} * xj2;
      X13 -= (f32x2){La6[2], La6[3]} * xj2;
      X14 -= (f32x2){La7[0], La7[1]} * xj2;
      X15 -= (f32x2){La7[2], La7[3]} * xj2;
      X16 -= (f32x2){La8[0], La8[1]} * xj2;
      X17 -= (f32x2){La8[2], La8[3]} * xj2;
      X18 -= (f32x2){La9[0], La9[1]} * xj2;
      X19 -= (f32x2){La9[2], La9[3]} * xj2;
      X20 -= (f32x2){La10[0], La10[1]} * xj2;
      X21 -= (f32x2){La10[2], La10[3]} * xj2;
      X22 -= (f32x2){La11[0], La11[1]} * xj2;
      X23 -= (f32x2){La11[2], La11[3]} * xj2;
      X24 -= (f32x2){La12[0], La12[1]} * xj2;
      X25 -= (f32x2){La12[2], La12[3]} * xj2;
      X26 -= (f32x2){La13[0], La13[1]} * xj2;
      X27 -= (f32x2){La13[2], La13[3]} * xj2;
      X28 -= (f32x2){La14[0], La14[1]} * xj2;
      X29 -= (f32x2){La14[2], La14[3]} * xj2;
      X30 -= (f32x2){La15[0], La15[1]} * xj2;
      X31 -= (f32x2){La15[2], La15[3]} * xj2;
    }
    __builtin_amdgcn_sched_barrier(0);
    La2 = *(const f32x4*)(Lt_s + 688);
    La3 = *(const f32x4*)(Lt_s + 692);
    La4 = *(const f32x4*)(Lt_s + 696);
    La5 = *(const f32x4*)(Lt_s + 700);
    La6 = *(const f32x4*)(Lt_s + 704);
    La7 = *(const f32x4*)(Lt_s + 708);
    La8 = *(const f32x4*)(Lt_s + 712);
    La9 = *(const f32x4*)(Lt_s + 716);
    La10 = *(const f32x4*)(Lt_s + 720);
    La11 = *(const f32x4*)(Lt_s + 724);
    La12 = *(const f32x4*)(Lt_s + 728);
    La13 = *(const f32x4*)(Lt_s + 732);
    La14 = *(const f32x4*)(Lt_s + 736);
    La15 = *(const f32x4*)(Lt_s + 740);
    __builtin_amdgcn_sched_barrier(0);
    { const float xj = X4[1]; const f32x2 xj2 = (f32x2){xj, xj};
      X5 -= (f32x2){Lb2[2], Lb2[3]} * xj2;
      X6 -= (f32x2){Lb3[0], Lb3[1]} * xj2;
      X7 -= (f32x2){Lb3[2], Lb3[3]} * xj2;
      X8 -= (f32x2){Lb4[0], Lb4[1]} * xj2;
      X9 -= (f32x2){Lb4[2], Lb4[3]} * xj2;
      X10 -= (f32x2){Lb5[0], Lb5[1]} * xj2;
      X11 -= (f32x2){Lb5[2], Lb5[3]} * xj2;
      X12 -= (f32x2){Lb6[0], Lb6[1]} * xj2;
      X13 -= (f32x2){Lb6[2], Lb6[3]} * xj2;
      X14 -= (f32x2){Lb7[0], Lb7[1]} * xj2;
      X15 -= (f32x2){Lb7[2], Lb7[3]} * xj2;
      X16 -= (f32x2){Lb8[0], Lb8[1]} * xj2;
      X17 -= (f32x2){Lb8[2], Lb8[3]} * xj2;
      X18 -= (f32x2){Lb9[0], Lb9[1]} * xj2;
      X19 -= (f32x2){Lb9[2], Lb9[3]} * xj2;
      X20 -= (f32x2){Lb10[0], Lb10[1]} * xj2;
      X21 -= (f32x2){Lb10[2], Lb10[3]} * xj2;
      X22 -= (f32x2){Lb11[0], Lb11[1]} * xj2;
      X23 -= (f32x2){Lb11[2], Lb11[3]} * xj2;
      X24 -= (f32x2){Lb12[0], Lb12[1]} * xj2;
      X25 -= (f32x2){Lb12[2], Lb12[3]} * xj2;
      X26 -= (f32x2){Lb13[0], Lb13[1]} * xj2;
      X27 -= (f32x2){Lb13[2], Lb13[3]} * xj2;
      X28 -= (f32x2){Lb14[0], Lb14[1]} * xj2;
      X29 -= (f32x2){Lb14[2], Lb14[3]} * xj2;
      X30 -= (f32x2){Lb15[0], Lb15[1]} * xj2;
      X31 -= (f32x2){Lb15[2], Lb15[3]} * xj2;
    }
    __builtin_amdgcn_sched_barrier(0);
    Lb3 = *(const f32x4*)(Lt_s + 760);
    Lb4 = *(const f32x4*)(Lt_s + 764);
    Lb5 = *(const f32x4*)(Lt_s + 768);
    Lb6 = *(const f32x4*)(Lt_s + 772);
    Lb7 = *(const f32x4*)(Lt_s + 776);
    Lb8 = *(const f32x4*)(Lt_s + 780);
    Lb9 = *(const f32x4*)(Lt_s + 784);
    Lb10 = *(const f32x4*)(Lt_s + 788);
    Lb11 = *(const f32x4*)(Lt_s + 792);
    Lb12 = *(const f32x4*)(Lt_s + 796);
    Lb13 = *(const f32x4*)(Lt_s + 800);
    Lb14 = *(const f32x4*)(Lt_s + 804);
    Lb15 = *(const f32x4*)(Lt_s + 808);
    __builtin_amdgcn_sched_barrier(0);
    { const float xj = X5[0]; const f32x2 xj2 = (f32x2){xj, xj};
      X5 -= (f32x2){La2[2], La2[3]} * xj2;
      X6 -= (f32x2){La3[0], La3[1]} * xj2;
      X7 -= (f32x2){La3[2], La3[3]} * xj2;
      X8 -= (f32x2){La4[0], La4[1]} * xj2;
      X9 -= (f32x2){La4[2], La4[3]} * xj2;
      X10 -= (f32x2){La5[0], La5[1]} * xj2;
      X11 -= (f32x2){La5[2], La5[3]} * xj2;
      X12 -= (f32x2){La6[0], La6[1]} * xj2;
      X13 -= (f32x2){La6[2], La6[3]} * xj2;
      X14 -= (f32x2){La7[0], La7[1]} * xj2;
      X15 -= (f32x2){La7[2], La7[3]} * xj2;
      X16 -= (f32x2){La8[0], La8[1]} * xj2;
      X17 -= (f32x2){La8[2], La8[3]} * xj2;
      X18 -= (f32x2){La9[0], La9[1]} * xj2;
      X19 -= (f32x2){La9[2], La9[3]} * xj2;
      X20 -= (f32x2){La10[0], La10[1]} * xj2;
      X21 -= (f32x2){La10[2], La10[3]} * xj2;
      X22 -= (f32x2){La11[0], La11[1]} * xj2;
      X23 -= (f32x2){La11[2], La11[3]} * xj2;
      X24 -= (f32x2){La12[0], La12[1]} * xj2;
      X25 -= (f32x2){La12[2], La12[3]} * xj2;
      X26 -= (f32x2){La13[0], La13[1]} * xj2;
      X27 -= (f32x2){La13[2], La13[3]} * xj2;
      X28 -= (f32x2){La14[0], La14[1]} * xj2;
      X29 -= (f32x2){La14[2], La14[3]} * xj2;
      X30 -= (f32x2){La15[0], La15[1]} * xj2;
      X31 -= (f32x2){La15[2], La15[3]} * xj2;
    }
    __builtin_amdgcn_sched_barrier(0);
    La3 = *(const f32x4*)(Lt_s + 828);
    La4 = *(const f32x4*)(Lt_s + 832);
    La5 = *(const f32x4*)(Lt_s + 836);
    La6 = *(const f32x4*)(Lt_s + 840);
    La7 = *(const f32x4*)(Lt_s + 844);
    La8 = *(const f32x4*)(Lt_s + 848);
    La9 = *(const f32x4*)(Lt_s + 852);
    La10 = *(const f32x4*)(Lt_s + 856);
    La11 = *(const f32x4*)(Lt_s + 860);
    La12 = *(const f32x4*)(Lt_s + 864);
    La13 = *(const f32x4*)(Lt_s + 868);
    La14 = *(const f32x4*)(Lt_s + 872);
    La15 = *(const f32x4*)(Lt_s + 876);
    __builtin_amdgcn_sched_barrier(0);
    { const float xj = X5[1]; const f32x2 xj2 = (f32x2){xj, xj};
      X6 -= (f32x2){Lb3[0], Lb3[1]} * xj2;
      X7 -= (f32x2){Lb3[2], Lb3[3]} * xj2;
      X8 -= (f32x2){Lb4[0], Lb4[1]} * xj2;
      X9 -= (f32x2){Lb4[2], Lb4[3]} * xj2;
      X10 -= (f32x2){Lb5[0], Lb5[1]} * xj2;
      X11 -= (f32x2){Lb5[2], Lb5[3]} * xj2;
      X12 -= (f32x2){Lb6[0], Lb6[1]} * xj2;
      X13 -= (f32x2){Lb6[2], Lb6[3]} * xj2;
      X14 -= (f32x2){Lb7[0], Lb7[1]} * xj2;
      X15 -= (f32x2){Lb7[2], Lb7[3]} * xj2;
      X16 -= (f32x2){Lb8[0], Lb8[1]} * xj2;
      X17 -= (f32x2){Lb8[2], Lb8[3]} * xj2;
      X18 -= (f32x2){Lb9[0], Lb9[1]} * xj2;
      X19 -= (f32x2){Lb9[2], Lb9[3]} * xj2;
      X20 -= (f32x2){Lb10[0], Lb10[1]} * xj2;
      X21 -= (f32x2){Lb10[2], Lb10[3]} * xj2;
      X22 -= (f32x2){Lb11[0], Lb11[1]} * xj2;
      X23 -= (f32x2){Lb11[2], Lb11[3]} * xj2;
      X24 -= (f32x2){Lb12[0], Lb12[1]} * xj2;
      X25 -= (f32x2){Lb12[2], Lb12[3]} * xj2;
      X26 -= (f32x2){Lb13[0], Lb13[1]} * xj2;
      X27 -= (f32x2){Lb13[2], Lb13[3]} * xj2;
      X28 -= (f32x2){Lb14[0], Lb14[1]} * xj2;
      X29 -= (f32x2){Lb14[2], Lb14[3]} * xj2;
      X30 -= (f32x2){Lb15[0], Lb15[1]} * xj2;
      X31 -= (f32x2){Lb15[2], Lb15[3]} * xj2;
    }
    __builtin_amdgcn_sched_barrier(0);
    Lb3 = *(const f32x4*)(Lt_s + 896);
    Lb4 = *(const f32x4*)(Lt_s + 900);
    Lb5 = *(const f32x4*)(Lt_s + 904);
    Lb6 = *(const f32x4*)(Lt_s + 908);
    Lb7 = *(const f32x4*)(Lt_s + 912);
    Lb8 = *(const f32x4*)(Lt_s + 916);
    Lb9 = *(const f32x4*)(Lt_s + 920);
    Lb10 = *(const f32x4*)(Lt_s + 924);
    Lb11 = *(const f32x4*)(Lt_s + 928);
    Lb12 = *(const f32x4*)(Lt_s + 932);
    Lb13 = *(const f32x4*)(Lt_s + 936);
    Lb14 = *(const f32x4*)(Lt_s + 940);
    Lb15 = *(const f32x4*)(Lt_s + 944);
    __builtin_amdgcn_sched_barrier(0);
    { const float xj = X6[0]; const f32x2 xj2 = (f32x2){xj, xj};
      X6 -= (f32x2){La3[0], La3[1]} * xj2;
      X7 -= (f32x2){La3[2], La3[3]} * xj2;
      X8 -= (f32x2){La4[0], La4[1]} * xj2;
      X9 -= (f32x2){La4[2], La4[3]} * xj2;
      X10 -= (f32x2){La5[0], La5[1]} * xj2;
      X11 -= (f32x2){La5[2], La5[3]} * xj2;
      X12 -= (f32x2){La6[0], La6[1]} * xj2;
      X13 -= (f32x2){La6[2], La6[3]} * xj2;
      X14 -= (f32x2){La7[0], La7[1]} * xj2;
      X15 -= (f32x2){La7[2], La7[3]} * xj2;
      X16 -= (f32x2){La8[0], La8[1]} * xj2;
      X17 -= (f32x2){La8[2], La8[3]} * xj2;
      X18 -= (f32x2){La9[0], La9[1]} * xj2;
      X19 -= (f32x2){La9[2], La9[3]} * xj2;
      X20 -= (f32x2){La10[0], La10[1]} * xj2;
      X21 -= (f32x2){La10[2], La10[3]} * xj2;
      X22 -= (f32x2){La11[0], La11[1]} * xj2;
      X23 -= (f32x2){La11[2], La11[3]} * xj2;
      X24 -= (f32x2){La12[0], La12[1]} * xj2;
      X25 -= (f32x2){La12[2], La12[3]} * xj2;
      X26 -= (f32x2){La13[0], La13[1]} * xj2;
      X27 -= (f32x2){La13[2], La13[3]} * xj2;
      X28 -= (f32x2){La14[0], La14[1]} * xj2;
      X29 -= (f32x2){La14[2], La14[3]} * xj2;
      X30 -= (f32x2){La15[0], La15[1]} * xj2;
      X31 -= (f32x2){La15[2], La15[3]} * xj2;
    }
    __builtin_amdgcn_sched_barrier(0);
    La3 = *(const f32x4*)(Lt_s + 964);
    La4 = *(const f32x4*)(Lt_s + 968);
    La5 = *(const f32x4*)(Lt_s + 972);
    La6 = *(const f32x4*)(Lt_s + 976);
    La7 = *(const f32x4*)(Lt_s + 980);
    La8 = *(const f32x4*)(Lt_s + 984);
    La9 = *(const f32x4*)(Lt_s + 988);
    La10 = *(const f32x4*)(Lt_s + 992);
    La11 = *(const f32x4*)(Lt_s + 996);
    La12 = *(const f32x4*)(Lt_s + 1000);
    La13 = *(const f32x4*)(Lt_s + 1004);
    La14 = *(const f32x4*)(Lt_s + 1008);
    La15 = *(const f32x4*)(Lt_s + 1012);
    __builtin_amdgcn_sched_barrier(0);
    { const float xj = X6[1]; const f32x2 xj2 = (f32x2){xj, xj};
      X7 -= (f32x2){Lb3[2], Lb3[3]} * xj2;
      X8 -= (f32x2){Lb4[0], Lb4[1]} * xj2;
      X9 -= (f32x2){Lb4[2], Lb4[3]} * xj2;
      X10 -= (f32x2){Lb5[0], Lb5[1]} * xj2;
      X11 -= (f32x2){Lb5[2], Lb5[3]} * xj2;
      X12 -= (f32x2){Lb6[0], Lb6[1]} * xj2;
      X13 -= (f32x2){Lb6[2], Lb6[3]} * xj2;
      X14 -= (f32x2){Lb7[0], Lb7[1]} * xj2;
      X15 -= (f32x2){Lb7[2], Lb7[3]} * xj2;
      X16 -= (f32x2){Lb8[0], Lb8[1]} * xj2;
      X17 -= (f32x2){Lb8[2], Lb8[3]} * xj2;
      X18 -= (f32x2){Lb9[0], Lb9[1]} * xj2;
      X19 -= (f32x2){Lb9[2], Lb9[3]} * xj2;
      X20 -= (f32x2){Lb10[0], Lb10[1]} * xj2;
      X21 -= (f32x2){Lb10[2], Lb10[3]} * xj2;
      X22 -= (f32x2){Lb11[0], Lb11[1]} * xj2;
      X23 -= (f32x2){Lb11[2], Lb11[3]} * xj2;
      X24 -= (f32x2){Lb12[0], Lb12[1]} * xj2;
      X25 -= (f32x2){Lb12[2], Lb12[3]} * xj2;
      X26 -= (f32x2){Lb13[0], Lb13[1]} * xj2;
      X27 -= (f32x2){Lb13[2], Lb13[3]} * xj2;
      X28 -= (f32x2){Lb14[0], Lb14[1]} * xj2;
      X29 -= (f32x2){Lb14[2], Lb14[3]} * xj2;
      X30 -= (f32x2){Lb15[0], Lb15[1]} * xj2;
      X31 -= (f32x2){Lb15[2], Lb15[3]} * xj2;
    }
    __builtin_amdgcn_sched_barrier(0);
    Lb4 = *(const f32x4*)(Lt_s + 1036);
    Lb5 = *(const f32x4*)(Lt_s + 1040);
    Lb6 = *(const f32x4*)(Lt_s + 1044);
    Lb7 = *(const f32x4*)(Lt_s + 1048);
    Lb8 = *(const f32x4*)(Lt_s + 1052);
    Lb9 = *(const f32x4*)(Lt_s + 1056);
    Lb10 = *(const f32x4*)(Lt_s + 1060);
    Lb11 = *(const f32x4*)(Lt_s + 1064);
    Lb12 = *(const f32x4*)(Lt_s + 1068);
    Lb13 = *(const f32x4*)(Lt_s + 1072);
    Lb14 = *(const f32x4*)(Lt_s + 1076);
    Lb15 = *(const f32x4*)(Lt_s + 1080);
    __builtin_amdgcn_sched_barrier(0);
    { const float xj = X7[0]; const f32x2 xj2 = (f32x2){xj, xj};
      X7 -= (f32x2){La3[2], La3[3]} * xj2;
      X8 -= (f32x2){La4[0], La4[1]} * xj2;
      X9 -= (f32x2){La4[2], La4[3]} * xj2;
      X10 -= (f32x2){La5[0], La5[1]} * xj2;
      X11 -= (f32x2){La5[2], La5[3]} * xj2;
      X12 -= (f32x2){La6[0], La6[1]} * xj2;
      X13 -= (f32x2){La6[2], La6[3]} * xj2;
      X14 -= (f32x2){La7[0], La7[1]} * xj2;
      X15 -= (f32x2){La7[2], La7[3]} * xj2;
      X16 -= (f32x2){La8[0], La8[1]} * xj2;
      X17 -= (f32x2){La8[2], La8[3]} * xj2;
      X18 -= (f32x2){La9[0], La9[1]} * xj2;
      X19 -= (f32x2){La9[2], La9[3]} * xj2;
      X20 -= (f32x2){La10[0], La10[1]} * xj2;
      X21 -= (f32x2){La10[2], La10[3]} * xj2;
      X22 -= (f32x2){La11[0], La11[1]} * xj2;
      X23 -= (f32x2){La11[2], La11[3]} * xj2;
      X24 -= (f32x2){La12[0], La12[1]} * xj2;
      X25 -= (f32x2){La12[2], La12[3]} * xj2;
      X26 -= (f32x2){La13[0], La13[1]} * xj2;
      X27 -= (f32x2){La13[2], La13[3]} * xj2;
      X28 -= (f32x2){La14[0], La14[1]} * xj2;
      X29 -= (f32x2){La14[2], La14[3]} * xj2;
      X30 -= (f32x2){La15[0], La15[1]} * xj2;
      X31 -= (f32x2){La15[2], La15[3]} * xj2;
    }
    __builtin_amdgcn_sched_barrier(0);
    La4 = *(const f32x4*)(Lt_s + 1104);
    La5 = *(const f32x4*)(Lt_s + 1108);
    La6 = *(const f32x4*)(Lt_s + 1112);
    La7 = *(const f32x4*)(Lt_s + 1116);
    La8 = *(const f32x4*)(Lt_s + 1120);
    La9 = *(const f32x4*)(Lt_s + 1124);
    La10 = *(const f32x4*)(Lt_s + 1128);
    La11 = *(const f32x4*)(Lt_s + 1132);
    La12 = *(const f32x4*)(Lt_s + 1136);
    La13 = *(const f32x4*)(Lt_s + 1140);
    La14 = *(const f32x4*)(Lt_s + 1144);
    La15 = *(const f32x4*)(Lt_s + 1148);
    __builtin_amdgcn_sched_barrier(0);
    { const float xj = X7[1]; const f32x2 xj2 = (f32x2){xj, xj};
      X8 -= (f32x2){Lb4[0], Lb4[1]} * xj2;
      X9 -= (f32x2){Lb4[2], Lb4[3]} * xj2;
      X10 -= (f32x2){Lb5[0], Lb5[1]} * xj2;
      X11 -= (f32x2){Lb5[2], Lb5[3]} * xj2;
      X12 -= (f32x2){Lb6[0], Lb6[1]} * xj2;
      X13 -= (f32x2){Lb6[2], Lb6[3]} * xj2;
      X14 -= (f32x2){Lb7[0], Lb7[1]} * xj2;
      X15 -= (f32x2){Lb7[2], Lb7[3]} * xj2;
      X16 -= (f32x2){Lb8[0], Lb8[1]} * xj2;
      X17 -= (f32x2){Lb8[2], Lb8[3]} * xj2;
      X18 -= (f32x2){Lb9[0], Lb9[1]} * xj2;
      X19 -= (f32x2){Lb9[2], Lb9[3]} * xj2;
      X20 -= (f32x2){Lb10[0], Lb10[1]} * xj2;
      X21 -= (f32x2){Lb10[2], Lb10[3]} * xj2;
      X22 -= (f32x2){Lb11[0], Lb11[1]} * xj2;
      X23 -= (f32x2){Lb11[2], Lb11[3]} * xj2;
      X24 -= (f32x2){Lb12[0], Lb12[1]} * xj2;
      X25 -= (f32x2){Lb12[2], Lb12[3]} * xj2;
      X26 -= (f32x2){Lb13[0], Lb13[1]} * xj2;
      X27 -= (f32x2){Lb13[2], Lb13[3]} * xj2;
      X28 -= (f32x2){Lb14[0], Lb14[1]} * xj2;
      X29 -= (f32x2){Lb14[2], Lb14[3]} * xj2;
      X30 -= (f32x2){Lb15[0], Lb15[1]} * xj2;
      X31 -= (f32x2){Lb15[2], Lb15[3]} * xj2;
    }
    __builtin_amdgcn_sched_barrier(0);
    Lb4 = *(const f32x4*)(Lt_s + 1172);
    Lb5 = *(const f32x4*)(Lt_s + 1176);
    Lb6 = *(const f32x4*)(Lt_s + 1180);
    Lb7 = *(const f32x4*)(Lt_s + 1184);
    Lb8 = *(const f32x4*)(Lt_s + 1188);
    Lb9 = *(const f32x4*)(Lt_s + 1192);
    Lb10 = *(const f32x4*)(Lt_s + 1196);
    Lb11 = *(const f32x4*)(Lt_s + 1200);
    Lb12 = *(const f32x4*)(Lt_s + 1204);
    Lb13 = *(const f32x4*)(Lt_s + 1208);
    Lb14 = *(const f32x4*)(Lt_s + 1212);
    Lb15 = *(const f32x4*)(Lt_s + 1216);
    __builtin_amdgcn_sched_barrier(0);
    { const float xj = X8[0]; const f32x2 xj2 = (f32x2){xj, xj};
      X8 -= (f32x2){La4[0], La4[1]} * xj2;
      X9 -= (f32x2){La4[2], La4[3]} * xj2;
      X10 -= (f32x2){La5[0], La5[1]} * xj2;
      X11 -= (f32x2){La5[2], La5[3]} * xj2;
      X12 -= (f32x2){La6[0], La6[1]} * xj2;
      X13 -= (f32x2){La6[2], La6[3]} * xj2;
      X14 -= (f32x2){La7[0], La7[1]} * xj2;
      X15 -= (f32x2){La7[2], La7[3]} * xj2;
      X16 -= (f32x2){La8[0], La8[1]} * xj2;
      X17 -= (f32x2){La8[2], La8[3]} * xj2;
      X18 -= (f32x2){La9[0], La9[1]} * xj2;
      X19 -= (f32x2){La9[2], La9[3]} * xj2;
      X20 -= (f32x2){La10[0], La10[1]} * xj2;
      X21 -= (f32x2){La10[2], La10[3]} * xj2;
      X22 -= (f32x2){La11[0], La11[1]} * xj2;
      X23 -= (f32x2){La11[2], La11[3]} * xj2;
      X24 -= (f32x2){La12[0], La12[1]} * xj2;
      X25 -= (f32x2){La12[2], La12[3]} * xj2;
      X26 -= (f32x2){La13[0], La13[1]} * xj2;
      X27 -= (f32x2){La13[2], La13[3]} * xj2;
      X28 -= (f32x2){La14[0], La14[1]} * xj2;
      X29 -= (f32x2){La14[2], La14[3]} * xj2;
      X30 -= (f32x2){La15[0], La15[1]} * xj2;
      X31 -= (f32x2){La15[2], La15[3]} * xj2;
    }
    __builtin_amdgcn_sched_barrier(0);
    La4 = *(const f32x4*)(Lt_s + 1240);
    La5 = *(const f32x4*)(Lt_s + 1244);
    La6 = *(const f32x4*)(Lt_s + 1248);
    La7 = *(const f32x4*)(Lt_s + 1252);
    La8 = *(const f32x4*)(Lt_s + 1256);
    La9 = *(const f32x4*)(Lt_s + 1260);
    La10 = *(const f32x4*)(Lt_s + 1264);
    La11 = *(const f32x4*)(Lt_s + 1268);
    La12 = *(const f32x4*)(Lt_s + 1272);
    La13 = *(const f32x4*)(Lt_s + 1276);
    La14 = *(const f32x4*)(Lt_s + 1280);
    La15 = *(const f32x4*)(Lt_s + 1284);
    __builtin_amdgcn_sched_barrier(0);
    { const float xj = X8[1]; const f32x2 xj2 = (f32x2){xj, xj};
      X9 -= (f32x2){Lb4[2], Lb4[3]} * xj2;
      X10 -= (f32x2){Lb5[0], Lb5[1]} * xj2;
      X11 -= (f32x2){Lb5[2], Lb5[3]} * xj2;
      X12 -= (f32x2){Lb6[0], Lb6[1]} * xj2;
      X13 -= (f32x2){Lb6[2], Lb6[3]} * xj2;
      X14 -= (f32x2){Lb7[0], Lb7[1]} * xj2;
      X15 -= (f32x2){Lb7[2], Lb7[3]} * xj2;
      X16 -= (f32x2){Lb8[0], Lb8[1]} * xj2;
      X17 -= (f32x2){Lb8[2], Lb8[3]} * xj2;
      X18 -= (f32x2){Lb9[0], Lb9[1]} * xj2;
      X19 -= (f32x2){Lb9[2], Lb9[3]} * xj2;
      X20 -= (f32x2){Lb10[0], Lb10[1]} * xj2;
      X21 -= (f32x2){Lb10[2], Lb10[3]} * xj2;
      X22 -= (f32x2){Lb11[0], Lb11[1]} * xj2;
      X23 -= (f32x2){Lb11[2], Lb11[3]} * xj2;
      X24 -= (f32x2){Lb12[0], Lb12[1]} * xj2;
      X25 -= (f32x2){Lb12[2], Lb12[3]} * xj2;
      X26 -= (f32x2){Lb13[0], Lb13[1]} * xj2;
      X27 -= (f32x2){Lb13[2], Lb13[3]} * xj2;
      X28 -= (f32x2){Lb14[0], Lb14[1]} * xj2;
      X29 -= (f32x2){Lb14[2], Lb14[3]} * xj2;
      X30 -= (f32x2){Lb15[0], Lb15[1]} * xj2;
      X31 -= (f32x2){Lb15[2], Lb15[3]} * xj2;
    }
    __builtin_amdgcn_sched_barrier(0);
    Lb5 = *(const f32x4*)(Lt_s + 1312);
    Lb6 = *(const f32x4*)(Lt_s + 1316);
    Lb7 = *(const f32x4*)(Lt_s + 1320);
    Lb8 = *(const f32x4*)(Lt_s + 1324);
    Lb9 = *(const f32x4*)(Lt_s + 1328);
    Lb10 = *(const f32x4*)(Lt_s + 1332);
    Lb11 = *(const f32x4*)(Lt_s + 1336);
    Lb12 = *(const f32x4*)(Lt_s + 1340);
    Lb13 = *(const f32x4*)(Lt_s + 1344);
    Lb14 = *(const f32x4*)(Lt_s + 1348);
    Lb15 = *(const f32x4*)(Lt_s + 1352);
    __builtin_amdgcn_sched_barrier(0);
    { const float xj = X9[0]; const f32x2 xj2 = (f32x2){xj, xj};
      X9 -= (f32x2){La4[2], La4[3]} * xj2;
      X10 -= (f32x2){La5[0], La5[1]} * xj2;
      X11 -= (f32x2){La5[2], La5[3]} * xj2;
      X12 -= (f32x2){La6[0], La6[1]} * xj2;
      X13 -= (f32x2){La6[2], La6[3]} * xj2;
      X14 -= (f32x2){La7[0], La7[1]} * xj2;
      X15 -= (f32x2){La7[2], La7[3]} * xj2;
      X16 -= (f32x2){La8[0], La8[1]} * xj2;
      X17 -= (f32x2){La8[2], La8[3]} * xj2;
      X18 -= (f32x2){La9[0], La9[1]} * xj2;
      X19 -= (f32x2){La9[2], La9[3]} * xj2;
      X20 -= (f32x2){La10[0], La10[1]} * xj2;
      X21 -= (f32x2){La10[2], La10[3]} * xj2;
      X22 -= (f32x2){La11[0], La11[1]} * xj2;
      X23 -= (f32x2){La11[2], La11[3]} * xj2;
      X24 -= (f32x2){La12[0], La12[1]} * xj2;
      X25 -= (f32x2){La12[2], La12[3]} * xj2;
      X26 -= (f32x2){La13[0], La13[1]} * xj2;
      X27 -= (f32x2){La13[2], La13[3]} * xj2;
      X28 -= (f32x2){La14[0], La14[1]} * xj2;
      X29 -= (f32x2){La14[2], La14[3]} * xj2;
      X30 -= (f32x2){La15[0], La15[1]} * xj2;
      X31 -= (f32x2){La15[2], La15[3]} * xj2;
    }
    __builtin_amdgcn_sched_barrier(0);
    La5 = *(const f32x4*)(Lt_s + 1380);
    La6 = *(const f32x4*)(Lt_s + 1384);
    La7 = *(const f32x4*)(Lt_s + 1388);
    La8 = *(const f32x4*)(Lt_s + 1392);
    La9 = *(const f32x4*)(Lt_s + 1396);
    La10 = *(const f32x4*)(Lt_s + 1400);
    La11 = *(const f32x4*)(Lt_s + 1404);
    La12 = *(const f32x4*)(Lt_s + 1408);
    La13 = *(const f32x4*)(Lt_s + 1412);
    La14 = *(const f32x4*)(Lt_s + 1416);
    La15 = *(const f32x4*)(Lt_s + 1420);
    __builtin_amdgcn_sched_barrier(0);
    { const float xj = X9[1]; const f32x2 xj2 = (f32x2){xj, xj};
      X10 -= (f32x2){Lb5[0], Lb5[1]} * xj2;
      X11 -= (f32x2){Lb5[2], Lb5[3]} * xj2;
      X12 -= (f32x2){Lb6[0], Lb6[1]} * xj2;
      X13 -= (f32x2){Lb6[2], Lb6[3]} * xj2;
      X14 -= (f32x2){Lb7[0], Lb7[1]} * xj2;
      X15 -= (f32x2){Lb7[2], Lb7[3]} * xj2;
      X16 -= (f32x2){Lb8[0], Lb8[1]} * xj2;
      X17 -= (f32x2){Lb8[2], Lb8[3]} * xj2;
      X18 -= (f32x2){Lb9[0], Lb9[1]} * xj2;
      X19 -= (f32x2){Lb9[2], Lb9[3]} * xj2;
      X20 -= (f32x2){Lb10[0], Lb10[1]} * xj2;
      X21 -= (f32x2){Lb10[2], Lb10[3]} * xj2;
      X22 -= (f32x2){Lb11[0], Lb11[1]} * xj2;
      X23 -= (f32x2){Lb11[2], Lb11[3]} * xj2;
      X24 -= (f32x2){Lb12[0], Lb12[1]} * xj2;
      X25 -= (f32x2){Lb12[2], Lb12[3]} * xj2;
      X26 -= (f32x2){Lb13[0], Lb13[1]} * xj2;
      X27 -= (f32x2){Lb13[2], Lb13[3]} * xj2;
      X28 -= (f32x2){Lb14[0], Lb14[1]} * xj2;
      X29 -= (f32x2){Lb14[2], Lb14[3]} * xj2;
      X30 -= (f32x2){Lb15[0], Lb15[1]} * xj2;
      X31 -= (f32x2){Lb15[2], Lb15[3]} * xj2;
    }
    __builtin_amdgcn_sched_barrier(0);
    Lb5 = *(const f32x4*)(Lt_s + 1448);
    Lb6 = *(const f32x4*)(Lt_s + 1452);
    Lb7 = *(const f32x4*)(Lt_s + 1456);
    Lb8 = *(const f32x4*)(Lt_s + 1460);
    Lb9 = *(const f32x4*)(Lt_s + 1464);
    Lb10 = *(const f32x4*)(Lt_s + 1468);
    Lb11 = *(const f32x4*)(Lt_s + 1472);
    Lb12 = *(const f32x4*)(Lt_s + 1476);
    Lb13 = *(const f32x4*)(Lt_s + 1480);
    Lb14 = *(const f32x4*)(Lt_s + 1484);
    Lb15 = *(const f32x4*)(Lt_s + 1488);
    __builtin_amdgcn_sched_barrier(0);
    { const float xj = X10[0]; const f32x2 xj2 = (f32x2){xj, xj};
      X10 -= (f32x2){La5[0], La5[1]} * xj2;
      X11 -= (f32x2){La5[2], La5[3]} * xj2;
      X12 -= (f32x2){La6[0], La6[1]} * xj2;
      X13 -= (f32x2){La6[2], La6[3]} * xj2;
      X14 -= (f32x2){La7[0], La7[1]} * xj2;
      X15 -= (f32x2){La7[2], La7[3]} * xj2;
      X16 -= (f32x2){La8[0], La8[1]} * xj2;
      X17 -= (f32x2){La8[2], La8[3]} * xj2;
      X18 -= (f32x2){La9[0], La9[1]} * xj2;
      X19 -= (f32x2){La9[2], La9[3]} * xj2;
      X20 -= (f32x2){La10[0], La10[1]} * xj2;
      X21 -= (f32x2){La10[2], La10[3]} * xj2;
      X22 -= (f32x2){La11[0], La11[1]} * xj2;
      X23 -= (f32x2){La11[2], La11[3]} * xj2;
      X24 -= (f32x2){La12[0], La12[1]} * xj2;
      X25 -= (f32x2){La12[2], La12[3]} * xj2;
      X26 -= (f32x2){La13[0], La13[1]} * xj2;
      X27 -= (f32x2){La13[2], La13[3]} * xj2;
      X28 -= (f32x2){La14[0], La14[1]} * xj2;
      X29 -= (f32x2){La14[2], La14[3]} * xj2;
      X30 -= (f32x2){La15[0], La15[1]} * xj2;
      X31 -= (f32x2){La15[2], La15[3]} * xj2;
    }
    __builtin_amdgcn_sched_barrier(0);
    La5 = *(const f32x4*)(Lt_s + 1516);
    La6 = *(const f32x4*)(Lt_s + 1520);
    La7 = *(const f32x4*)(Lt_s + 1524);
    La8 = *(const f32x4*)(Lt_s + 1528);
    La9 = *(const f32x4*)(Lt_s + 1532);
    La10 = *(const f32x4*)(Lt_s + 1536);
    La11 = *(const f32x4*)(Lt_s + 1540);
    La12 = *(const f32x4*)(Lt_s + 1544);
    La13 = *(const f32x4*)(Lt_s + 1548);
    La14 = *(const f32x4*)(Lt_s + 1552);
    La15 = *(const f32x4*)(Lt_s + 1556);
    __builtin_amdgcn_sched_barrier(0);
    { const float xj = X10[1]; const f32x2 xj2 = (f32x2){xj, xj};
      X11 -= (f32x2){Lb5[2], Lb5[3]} * xj2;
      X12 -= (f32x2){Lb6[0], Lb6[1]} * xj2;
      X13 -= (f32x2){Lb6[2], Lb6[3]} * xj2;
      X14 -= (f32x2){Lb7[0], Lb7[1]} * xj2;
      X15 -= (f32x2){Lb7[2], Lb7[3]} * xj2;
      X16 -= (f32x2){Lb8[0], Lb8[1]} * xj2;
      X17 -= (f32x2){Lb8[2], Lb8[3]} * xj2;
      X18 -= (f32x2){Lb9[0], Lb9[1]} * xj2;
      X19 -= (f32x2){Lb9[2], Lb9[3]} * xj2;
      X20 -= (f32x2){Lb10[0], Lb10[1]} * xj2;
      X21 -= (f32x2){Lb10[2], Lb10[3]} * xj2;
      X22 -= (f32x2){Lb11[0], Lb11[1]} * xj2;
      X23 -= (f32x2){Lb11[2], Lb11[3]} * xj2;
      X24 -= (f32x2){Lb12[0], Lb12[1]} * xj2;
      X25 -= (f32x2){Lb12[2], Lb12[3]} * xj2;
      X26 -= (f32x2){Lb13[0], Lb13[1]} * xj2;
      X27 -= (f32x2){Lb13[2], Lb13[3]} * xj2;
      X28 -= (f32x2){Lb14[0], Lb14[1]} * xj2;
      X29 -= (f32x2){Lb14[2], Lb14[3]} * xj2;
      X30 -= (f32x2){Lb15[0], Lb15[1]} * xj2;
      X31 -= (f32x2){Lb15[2], Lb15[3]} * xj2;
    }
    __builtin_amdgcn_sched_barrier(0);
    Lb6 = *(const f32x4*)(Lt_s + 1588);
    Lb7 = *(const f32x4*)(Lt_s + 1592);
    Lb8 = *(const f32x4*)(Lt_s + 1596);
    Lb9 = *(const f32x4*)(Lt_s + 1600);
    Lb10 = *(const f32x4*)(Lt_s + 1604);
    Lb11 = *(const f32x4*)(Lt_s + 1608);
    Lb12 = *(const f32x4*)(Lt_s + 1612);
    Lb13 = *(const f32x4*)(Lt_s + 1616);
    Lb14 = *(const f32x4*)(Lt_s + 1620);
    Lb15 = *(const f32x4*)(Lt_s + 1624);
    __builtin_amdgcn_sched_barrier(0);
    { const float xj = X11[0]; const f32x2 xj2 = (f32x2){xj, xj};
      X11 -= (f32x2){La5[2], La5[3]} * xj2;
      X12 -= (f32x2){La6[0], La6[1]} * xj2;
      X13 -= (f32x2){La6[2], La6[3]} * xj2;
      X14 -= (f32x2){La7[0], La7[1]} * xj2;
      X15 -= (f32x2){La7[2], La7[3]} * xj2;
      X16 -= (f32x2){La8[0], La8[1]} * xj2;
      X17 -= (f32x2){La8[2], La8[3]} * xj2;
      X18 -= (f32x2){La9[0], La9[1]} * xj2;
      X19 -= (f32x2){La9[2], La9[3]} * xj2;
      X20 -= (f32x2){La10[0], La10[1]} * xj2;
      X21 -= (f32x2){La10[2], La10[3]} * xj2;
      X22 -= (f32x2){La11[0], La11[1]} * xj2;
      X23 -= (f32x2){La11[2], La11[3]} * xj2;
      X24 -= (f32x2){La12[0], La12[1]} * xj2;
      X25 -= (f32x2){La12[2], La12[3]} * xj2;
      X26 -= (f32x2){La13[0], La13[1]} * xj2;
      X27 -= (f32x2){La13[2], La13[3]} * xj2;
      X28 -= (f32x2){La14[0], La14[1]} * xj2;
      X29 -= (f32x2){La14[2], La14[3]} * xj2;
      X30 -= (f32x2){La15[0], La15[1]} * xj2;
      X31 -= (f32x2){La15[2], La15[3]} * xj2;
    }
    __builtin_amdgcn_sched_barrier(0);
    La6 = *(const f32x4*)(Lt_s + 1656);
    La7 = *(const f32x4*)(Lt_s + 1660);
    La8 = *(const f32x4*)(Lt_s + 1664);
    La9 = *(const f32x4*)(Lt_s + 1668);
    La10 = *(const f32x4*)(Lt_s + 1672);
    La11 = *(const f32x4*)(Lt_s + 1676);
    La12 = *(const f32x4*)(Lt_s + 1680);
    La13 = *(const f32x4*)(Lt_s + 1684);
    La14 = *(const f32x4*)(Lt_s + 1688);
    La15 = *(const f32x4*)(Lt_s + 1692);
    __builtin_amdgcn_sched_barrier(0);
    { const float xj = X11[1]; const f32x2 xj2 = (f32x2){xj, xj};
      X12 -= (f32x2){Lb6[0], Lb6[1]} * xj2;
      X13 -= (f32x2){Lb6[2], Lb6[3]} * xj2;
      X14 -= (f32x2){Lb7[0], Lb7[1]} * xj2;
      X15 -= (f32x2){Lb7[2], Lb7[3]} * xj2;
      X16 -= (f32x2){Lb8[0], Lb8[1]} * xj2;
      X17 -= (f32x2){Lb8[2], Lb8[3]} * xj2;
      X18 -= (f32x2){Lb9[0], Lb9[1]} * xj2;
      X19 -= (f32x2){Lb9[2], Lb9[3]} * xj2;
      X20 -= (f32x2){Lb10[0], Lb10[1]} * xj2;
      X21 -= (f32x2){Lb10[2], Lb10[3]} * xj2;
      X22 -= (f32x2){Lb11[0], Lb11[1]} * xj2;
      X23 -= (f32x2){Lb11[2], Lb11[3]} * xj2;
      X24 -= (f32x2){Lb12[0], Lb12[1]} * xj2;
      X25 -= (f32x2){Lb12[2], Lb12[3]} * xj2;
      X26 -= (f32x2){Lb13[0], Lb13[1]} * xj2;
      X27 -= (f32x2){Lb13[2], Lb13[3]} * xj2;
      X28 -= (f32x2){Lb14[0], Lb14[1]} * xj2;
      X29 -= (f32x2){Lb14[2], Lb14[3]} * xj2;
      X30 -= (f32x2){Lb15[0], Lb15[1]} * xj2;
      X31 -= (f32x2){Lb15[2], Lb15[3]} * xj2;
    }
    __builtin_amdgcn_sched_barrier(0);
    Lb6 = *(const f32x4*)(Lt_s + 1724);
    Lb7 = *(const f32x4*)(Lt_s + 1728);
    Lb8 = *(const f32x4*)(Lt_s + 1732);
    Lb9 = *(const f32x4*)(Lt_s + 1736);
    Lb10 = *(const f32x4*)(Lt_s + 1740);
    Lb11 = *(const f32x4*)(Lt_s + 1744);
    Lb12 = *(const f32x4*)(Lt_s + 1748);
    Lb13 = *(const f32x4*)(Lt_s + 1752);
    Lb14 = *(const f32x4*)(Lt_s + 1756);
    Lb15 = *(const f32x4*)(Lt_s + 1760);
    __builtin_amdgcn_sched_barrier(0);
    { const float xj = X12[0]; const f32x2 xj2 = (f32x2){xj, xj};
      X12 -= (f32x2){La6[0], La6[1]} * xj2;
      X13 -= (f32x2){La6[2], La6[3]} * xj2;
      X14 -= (f32x2){La7[0], La7[1]} * xj2;
      X15 -= (f32x2){La7[2], La7[3]} * xj2;
      X16 -= (f32x2){La8[0], La8[1]} * xj2;
      X17 -= (f32x2){La8[2], La8[3]} * xj2;
      X18 -= (f32x2){La9[0], La9[1]} * xj2;
      X19 -= (f32x2){La9[2], La9[3]} * xj2;
      X20 -= (f32x2){La10[0], La10[1]} * xj2;
      X21 -= (f32x2){La10[2], La10[3]} * xj2;
      X22 -= (f32x2){La11[0], La11[1]} * xj2;
      X23 -= (f32x2){La11[2], La11[3]} * xj2;
      X24 -= (f32x2){La12[0], La12[1]} * xj2;
      X25 -= (f32x2){La12[2], La12[3]} * xj2;
      X26 -= (f32x2){La13[0], La13[1]} * xj2;
      X27 -= (f32x2){La13[2], La13[3]} * xj2;
      X28 -= (f32x2){La14[0], La14[1]} * xj2;
      X29 -= (f32x2){La14[2], La14[3]} * xj2;
      X30 -= (f32x2){La15[0], La15[1]} * xj2;
      X31 -= (f32x2){La15[2], La15[3]} * xj2;
    }
    __builtin_amdgcn_sched_barrier(0);
    La6 = *(const f32x4*)(Lt_s + 1792);
    La7 = *(const f32x4*)(Lt_s + 1796);
    La8 = *(const f32x4*)(Lt_s + 1800);
    La9 = *(const f32x4*)(Lt_s + 1804);
    La10 = *(const f32x4*)(Lt_s + 1808);
    La11 = *(const f32x4*)(Lt_s + 1812);
    La12 = *(const f32x4*)(Lt_s + 1816);
    La13 = *(const f32x4*)(Lt_s + 1820);
    La14 = *(const f32x4*)(Lt_s + 1824);
    La15 = *(const f32x4*)(Lt_s + 1828);
    __builtin_amdgcn_sched_barrier(0);
    { const float xj = X12[1]; const f32x2 xj2 = (f32x2){xj, xj};
      X13 -= (f32x2){Lb6[2], Lb6[3]} * xj2;
      X14 -= (f32x2){Lb7[0], Lb7[1]} * xj2;
      X15 -= (f32x2){Lb7[2], Lb7[3]} * xj2;
      X16 -= (f32x2){Lb8[0], Lb8[1]} * xj2;
      X17 -= (f32x2){Lb8[2], Lb8[3]} * xj2;
      X18 -= (f32x2){Lb9[0], Lb9[1]} * xj2;
      X19 -= (f32x2){Lb9[2], Lb9[3]} * xj2;
      X20 -= (f32x2){Lb10[0], Lb10[1]} * xj2;
      X21 -= (f32x2){Lb10[2], Lb10[3]} * xj2;
      X22 -= (f32x2){Lb11[0], Lb11[1]} * xj2;
      X23 -= (f32x2){Lb11[2], Lb11[3]} * xj2;
      X24 -= (f32x2){Lb12[0], Lb12[1]} * xj2;
      X25 -= (f32x2){Lb12[2], Lb12[3]} * xj2;
      X26 -= (f32x2){Lb13[0], Lb13[1]} * xj2;
      X27 -= (f32x2){Lb13[2], Lb13[3]} * xj2;
      X28 -= (f32x2){Lb14[0], Lb14[1]} * xj2;
      X29 -= (f32x2){Lb14[2], Lb14[3]} * xj2;
      X30 -= (f32x2){Lb15[0], Lb15[1]} * xj2;
      X31 -= (f32x2){Lb15[2], Lb15[3]} * xj2;
    }
    __builtin_amdgcn_sched_barrier(0);
    Lb7 = *(const f32x4*)(Lt_s + 1864);
    Lb8 = *(const f32x4*)(Lt_s + 1868);
    Lb9 = *(const f32x4*)(Lt_s + 1872);
    Lb10 = *(const f32x4*)(Lt_s + 1876);
    Lb11 = *(const f32x4*)(Lt_s + 1880);
    Lb12 = *(const f32x4*)(Lt_s + 1884);
    Lb13 = *(const f32x4*)(Lt_s + 1888);
    Lb14 = *(const f32x4*)(Lt_s + 1892);
    Lb15 = *(const f32x4*)(Lt_s + 1896);
    __builtin_amdgcn_sched_barrier(0);
    { const float xj = X13[0]; const f32x2 xj2 = (f32x2){xj, xj};
      X13 -= (f32x2){La6[2], La6[3]} * xj2;
      X14 -= (f32x2){La7[0], La7[1]} * xj2;
      X15 -= (f32x2){La7[2], La7[3]} * xj2;
      X16 -= (f32x2){La8[0], La8[1]} * xj2;
      X17 -= (f32x2){La8[2], La8[3]} * xj2;
      X18 -= (f32x2){La9[0], La9[1]} * xj2;
      X19 -= (f32x2){La9[2], La9[3]} * xj2;
      X20 -= (f32x2){La10[0], La10[1]} * xj2;
      X21 -= (f32x2){La10[2], La10[3]} * xj2;
      X22 -= (f32x2){La11[0], La11[1]} * xj2;
      X23 -= (f32x2){La11[2], La11[3]} * xj2;
      X24 -= (f32x2){La12[0], La12[1]} * xj2;
      X25 -= (f32x2){La12[2], La12[3]} * xj2;
      X26 -= (f32x2){La13[0], La13[1]} * xj2;
      X27 -= (f32x2){La13[2], La13[3]} * xj2;
      X28 -= (f32x2){La14[0], La14[1]} * xj2;
      X29 -= (f32x2){La14[2], La14[3]} * xj2;
      X30 -= (f32x2){La15[0], La15[1]} * xj2;
      X31 -= (f32x2){La15[2], La15[3]} * xj2;
    }
    __builtin_amdgcn_sched_barrier(0);
    La7 = *(const f32x4*)(Lt_s + 1932);
    La8 = *(const f32x4*)(Lt_s + 1936);
    La9 = *(const f32x4*)(Lt_s + 1940);
    La10 = *(const f32x4*)(Lt_s + 1944);
    La11 = *(const f32x4*)(Lt_s + 1948);
    La12 = *(const f32x4*)(Lt_s + 1952);
    La13 = *(const f32x4*)(Lt_s + 1956);
    La14 = *(const f32x4*)(Lt_s + 1960);
    La15 = *(const f32x4*)(Lt_s + 1964);
    __builtin_amdgcn_sched_barrier(0);
    { const float xj = X13[1]; const f32x2 xj2 = (f32x2){xj, xj};
      X14 -= (f32x2){Lb7[0], Lb7[1]} * xj2;
      X15 -= (f32x2){Lb7[2], Lb7[3]} * xj2;
      X16 -= (f32x2){Lb8[0], Lb8[1]} * xj2;
      X17 -= (f32x2){Lb8[2], Lb8[3]} * xj2;
      X18 -= (f32x2){Lb9[0], Lb9[1]} * xj2;
      X19 -= (f32x2){Lb9[2], Lb9[3]} * xj2;
      X20 -= (f32x2){Lb10[0], Lb10[1]} * xj2;
      X21 -= (f32x2){Lb10[2], Lb10[3]} * xj2;
      X22 -= (f32x2){Lb11[0], Lb11[1]} * xj2;
      X23 -= (f32x2){Lb11[2], Lb11[3]} * xj2;
      X24 -= (f32x2){Lb12[0], Lb12[1]} * xj2;
      X25 -= (f32x2){Lb12[2], Lb12[3]} * xj2;
      X26 -= (f32x2){Lb13[0], Lb13[1]} * xj2;
      X27 -= (f32x2){Lb13[2], Lb13[3]} * xj2;
      X28 -= (f32x2){Lb14[0], Lb14[1]} * xj2;
      X29 -= (f32x2){Lb14[2], Lb14[3]} * xj2;
      X30 -= (f32x2){Lb15[0], Lb15[1]} * xj2;
      X31 -= (f32x2){Lb15[2], Lb15[3]} * xj2;
    }
    __builtin_amdgcn_sched_barrier(0);
    Lb7 = *(const f32x4*)(Lt_s + 2000);
    Lb8 = *(const f32x4*)(Lt_s + 2004);
    Lb9 = *(const f32x4*)(Lt_s + 2008);
    Lb10 = *(const f32x4*)(Lt_s + 2012);
    Lb11 = *(const f32x4*)(Lt_s + 2016);
    Lb12 = *(const f32x4*)(Lt_s + 2020);
    Lb13 = *(const f32x4*)(Lt_s + 2024);
    Lb14 = *(const f32x4*)(Lt_s + 2028);
    Lb15 = *(const f32x4*)(Lt_s + 2032);
    __builtin_amdgcn_sched_barrier(0);
    { const float xj = X14[0]; const f32x2 xj2 = (f32x2){xj, xj};
      X14 -= (f32x2){La7[0], La7[1]} * xj2;
      X15 -= (f32x2){La7[2], La7[3]} * xj2;
      X16 -= (f32x2){La8[0], La8[1]} * xj2;
      X17 -= (f32x2){La8[2], La8[3]} * xj2;
      X18 -= (f32x2){La9[0], La9[1]} * xj2;
      X19 -= (f32x2){La9[2], La9[3]} * xj2;
      X20 -= (f32x2){La10[0], La10[1]} * xj2;
      X21 -= (f32x2){La10[2], La10[3]} * xj2;
      X22 -= (f32x2){La11[0], La11[1]} * xj2;
      X23 -= (f32x2){La11[2], La11[3]} * xj2;
      X24 -= (f32x2){La12[0], La12[1]} * xj2;
      X25 -= (f32x2){La12[2], La12[3]} * xj2;
      X26 -= (f32x2){La13[0], La13[1]} * xj2;
      X27 -= (f32x2){La13[2], La13[3]} * xj2;
      X28 -= (f32x2){La14[0], La14[1]} * xj2;
      X29 -= (f32x2){La14[2], La14[3]} * xj2;
      X30 -= (f32x2){La15[0], La15[1]} * xj2;
      X31 -= (f32x2){La15[2], La15[3]} * xj2;
    }
    __builtin_amdgcn_sched_barrier(0);
    La7 = *(const f32x4*)(Lt_s + 2068);
    La8 = *(const f32x4*)(Lt_s + 2072);
    La9 = *(const f32x4*)(Lt_s + 2076);
    La10 = *(const f32x4*)(Lt_s + 2080);
    La11 = *(const f32x4*)(Lt_s + 2084);
    La12 = *(const f32x4*)(Lt_s + 2088);
    La13 = *(const f32x4*)(Lt_s + 2092);
    La14 = *(const f32x4*)(Lt_s + 2096);
    La15 = *(const f32x4*)(Lt_s + 2100);
    __builtin_amdgcn_sched_barrier(0);
    { const float xj = X14[1]; const f32x2 xj2 = (f32x2){xj, xj};
      X15 -= (f32x2){Lb7[2], Lb7[3]} * xj2;
      X16 -= (f32x2){Lb8[0], Lb8[1]} * xj2;
      X17 -= (f32x2){Lb8[2], Lb8[3]} * xj2;
      X18 -= (f32x2){Lb9[0], Lb9[1]} * xj2;
      X19 -= (f32x2){Lb9[2], Lb9[3]} * xj2;
      X20 -= (f32x2){Lb10[0], Lb10[1]} * xj2;
      X21 -= (f32x2){Lb10[2], Lb10[3]} * xj2;
      X22 -= (f32x2){Lb11[0], Lb11[1]} * xj2;
      X23 -= (f32x2){Lb11[2], Lb11[3]} * xj2;
      X24 -= (f32x2){Lb12[0], Lb12[1]} * xj2;
      X25 -= (f32x2){Lb12[2], Lb12[3]} * xj2;
      X26 -= (f32x2){Lb13[0], Lb13[1]} * xj2;
      X27 -= (f32x2){Lb13[2], Lb13[3]} * xj2;
      X28 -= (f32x2){Lb14[0], Lb14[1]} * xj2;
      X29 -= (f32x2){Lb14[2], Lb14[3]} * xj2;
      X30 -= (f32x2){Lb15[0], Lb15[1]} * xj2;
      X31 -= (f32x2){Lb15[2], Lb15[3]} * xj2;
    }
    __builtin_amdgcn_sched_barrier(0);
    Lb8 = *(const f32x4*)(Lt_s + 2140);
    Lb9 = *(const f32x4*)(Lt_s + 2144);
    Lb10 = *(const f32x4*)(Lt_s + 2148);
    Lb11 = *(const f32x4*)(Lt_s + 2152);
    Lb12 = *(const f32x4*)(Lt_s + 2156);
    Lb13 = *(const f32x4*)(Lt_s + 2160);
    Lb14 = *(const f32x4*)(Lt_s + 2164);
    Lb15 = *(const f32x4*)(Lt_s + 2168);
    __builtin_amdgcn_sched_barrier(0);
    { const float xj = X15[0]; const f32x2 xj2 = (f32x2){xj, xj};
      X15 -= (f32x2){La7[2], La7[3]} * xj2;
      X16 -= (f32x2){La8[0], La8[1]} * xj2;
      X17 -= (f32x2){La8[2], La8[3]} * xj2;
      X18 -= (f32x2){La9[0], La9[1]} * xj2;
      X19 -= (f32x2){La9[2], La9[3]} * xj2;
      X20 -= (f32x2){La10[0], La10[1]} * xj2;
      X21 -= (f32x2){La10[2], La10[3]} * xj2;
      X22 -= (f32x2){La11[0], La11[1]} * xj2;
      X23 -= (f32x2){La11[2], La11[3]} * xj2;
      X24 -= (f32x2){La12[0], La12[1]} * xj2;
      X25 -= (f32x2){La12[2], La12[3]} * xj2;
      X26 -= (f32x2){La13[0], La13[1]} * xj2;
      X27 -= (f32x2){La13[2], La13[3]} * xj2;
      X28 -= (f32x2){La14[0], La14[1]} * xj2;
      X29 -= (f32x2){La14[2], La14[3]} * xj2;
      X30 -= (f32x2){La15[0], La15[1]} * xj2;
      X31 -= (f32x2){La15[2], La15[3]} * xj2;
    }
    __builtin_amdgcn_sched_barrier(0);
    La8 = *(const f32x4*)(Lt_s + 2208);
    La9 = *(const f32x4*)(Lt_s + 2212);
    La10 = *(const f32x4*)(Lt_s + 2216);
    La11 = *(const f32x4*)(Lt_s + 2220);
    La12 = *(const f32x4*)(Lt_s + 2224);
    La13 = *(const f32x4*)(Lt_s + 2228);
    La14 = *(const f32x4*)(Lt_s + 2232);
    La15 = *(const f32x4*)(Lt_s + 2236);
    __builtin_amdgcn_sched_barrier(0);
    { const float xj = X15[1]; const f32x2 xj2 = (f32x2){xj, xj};
      X16 -= (f32x2){Lb8[0], Lb8[1]} * xj2;
      X17 -= (f32x2){Lb8[2], Lb8[3]} * xj2;
      X18 -= (f32x2){Lb9[0], Lb9[1]} * xj2;
      X19 -= (f32x2){Lb9[2], Lb9[3]} * xj2;
      X20 -= (f32x2){Lb10[0], Lb10[1]} * xj2;
      X21 -= (f32x2){Lb10[2], Lb10[3]} * xj2;
      X22 -= (f32x2){Lb11[0], Lb11[1]} * xj2;
      X23 -= (f32x2){Lb11[2], Lb11[3]} * xj2;
      X24 -= (f32x2){Lb12[0], Lb12[1]} * xj2;
      X25 -= (f32x2){Lb12[2], Lb12[3]} * xj2;
      X26 -= (f32x2){Lb13[0], Lb13[1]} * xj2;
      X27 -= (f32x2){Lb13[2], Lb13[3]} * xj2;
      X28 -= (f32x2){Lb14[0], Lb14[1]} * xj2;
      X29 -= (f32x2){Lb14[2], Lb14[3]} * xj2;
      X30 -= (f32x2){Lb15[0], Lb15[1]} * xj2;
      X31 -= (f32x2){Lb15[2], Lb15[3]} * xj2;
    }
    __builtin_amdgcn_sched_barrier(0);
    Lb8 = *(const f32x4*)(Lt_s + 2276);
    Lb9 = *(const f32x4*)(Lt_s + 2280);
    Lb10 = *(const f32x4*)(Lt_s + 2284);
    Lb11 = *(const f32x4*)(Lt_s + 2288);
    Lb12 = *(const f32x4*)(Lt_s + 2292);
    Lb13 = *(const f32x4*)(Lt_s + 2296);
    Lb14 = *(const f32x4*)(Lt_s + 2300);
    Lb15 = *(const f32x4*)(Lt_s + 2304);
    __builtin_amdgcn_sched_barrier(0);
    { const float xj = X16[0]; const f32x2 xj2 = (f32x2){xj, xj};
      X16 -= (f32x2){La8[0], La8[1]} * xj2;
      X17 -= (f32x2){La8[2], La8[3]} * xj2;
      X18 -= (f32x2){La9[0], La9[1]} * xj2;
      X19 -= (f32x2){La9[2], La9[3]} * xj2;
      X20 -= (f32x2){La10[0], La10[1]} * xj2;
      X21 -= (f32x2){La10[2], La10[3]} * xj2;
      X22 -= (f32x2){La11[0], La11[1]} * xj2;
      X23 -= (f32x2){La11[2], La11[3]} * xj2;
      X24 -= (f32x2){La12[0], La12[1]} * xj2;
      X25 -= (f32x2){La12[2], La12[3]} * xj2;
      X26 -= (f32x2){La13[0], La13[1]} * xj2;
      X27 -= (f32x2){La13[2], La13[3]} * xj2;
      X28 -= (f32x2){La14[0], La14[1]} * xj2;
      X29 -= (f32x2){La14[2], La14[3]} * xj2;
      X30 -= (f32x2){La15[0], La15[1]} * xj2;
      X31 -= (f32x2){La15[2], La15[3]} * xj2;
    }
    __builtin_amdgcn_sched_barrier(0);
    La8 = *(const f32x4*)(Lt_s + 2344);
    La9 = *(const f32x4*)(Lt_s + 2348);
    La10 = *(const f32x4*)(Lt_s + 2352);
    La11 = *(const f32x4*)(Lt_s + 2356);
    La12 = *(const f32x4*)(Lt_s + 2360);
    La13 = *(const f32x4*)(Lt_s + 2364);
    La14 = *(const f32x4*)(Lt_s + 2368);
    La15 = *(const f32x4*)(Lt_s + 2372);
    __builtin_amdgcn_sched_barrier(0);
    { const float xj = X16[1]; const f32x2 xj2 = (f32x2){xj, xj};
      X17 -= (f32x2){Lb8[2], Lb8[3]} * xj2;
      X18 -= (f32x2){Lb9[0], Lb9[1]} * xj2;
      X19 -= (f32x2){Lb9[2], Lb9[3]} * xj2;
      X20 -= (f32x2){Lb10[0], Lb10[1]} * xj2;
      X21 -= (f32x2){Lb10[2], Lb10[3]} * xj2;
      X22 -= (f32x2){Lb11[0], Lb11[1]} * xj2;
      X23 -= (f32x2){Lb11[2], Lb11[3]} * xj2;
      X24 -= (f32x2){Lb12[0], Lb12[1]} * xj2;
      X25 -= (f32x2){Lb12[2], Lb12[3]} * xj2;
      X26 -= (f32x2){Lb13[0], Lb13[1]} * xj2;
      X27 -= (f32x2){Lb13[2], Lb13[3]} * xj2;
      X28 -= (f32x2){Lb14[0], Lb14[1]} * xj2;
      X29 -= (f32x2){Lb14[2], Lb14[3]} * xj2;
      X30 -= (f32x2){Lb15[0], Lb15[1]} * xj2;
      X31 -= (f32x2){Lb15[2], Lb15[3]} * xj2;
    }
    __builtin_amdgcn_sched_barrier(0);
    Lb9 = *(const f32x4*)(Lt_s + 2416);
    Lb10 = *(const f32x4*)(Lt_s + 2420);
    Lb11 = *(const f32x4*)(Lt_s + 2424);
    Lb12 = *(const f32x4*)(Lt_s + 2428);
    Lb13 = *(const f32x4*)(Lt_s + 2432);
    Lb14 = *(const f32x4*)(Lt_s + 2436);
    Lb15 = *(const f32x4*)(Lt_s + 2440);
    __builtin_amdgcn_sched_barrier(0);
    { const float xj = X17[0]; const f32x2 xj2 = (f32x2){xj, xj};
      X17 -= (f32x2){La8[2], La8[3]} * xj2;
      X18 -= (f32x2){La9[0], La9[1]} * xj2;
      X19 -= (f32x2){La9[2], La9[3]} * xj2;
      X20 -= (f32x2){La10[0], La10[1]} * xj2;
      X21 -= (f32x2){La10[2], La10[3]} * xj2;
      X22 -= (f32x2){La11[0], La11[1]} * xj2;
      X23 -= (f32x2){La11[2], La11[3]} * xj2;
      X24 -= (f32x2){La12[0], La12[1]} * xj2;
      X25 -= (f32x2){La12[2], La12[3]} * xj2;
      X26 -= (f32x2){La13[0], La13[1]} * xj2;
      X27 -= (f32x2){La13[2], La13[3]} * xj2;
      X28 -= (f32x2){La14[0], La14[1]} * xj2;
      X29 -= (f32x2){La14[2], La14[3]} * xj2;
      X30 -= (f32x2){La15[0], La15[1]} * xj2;
      X31 -= (f32x2){La15[2], La15[3]} * xj2;
    }
    __builtin_amdgcn_sched_barrier(0);
    La9 = *(const f32x4*)(Lt_s + 2484);
    La10 = *(const f32x4*)(Lt_s + 2488);
    La11 = *(const f32x4*)(Lt_s + 2492);
    La12 = *(const f32x4*)(Lt_s + 2496);
    La13 = *(const f32x4*)(Lt_s + 2500);
    La14 = *(const f32x4*)(Lt_s + 2504);
    La15 = *(const f32x4*)(Lt_s + 2508);
    __builtin_amdgcn_sched_barrier(0);
    { const float xj = X17[1]; const f32x2 xj2 = (f32x2){xj, xj};
      X18 -= (f32x2){Lb9[0], Lb9[1]} * xj2;
      X19 -= (f32x2){Lb9[2], Lb9[3]} * xj2;
      X20 -= (f32x2){Lb10[0], Lb10[1]} * xj2;
      X21 -= (f32x2){Lb10[2], Lb10[3]} * xj2;
      X22 -= (f32x2){Lb11[0], Lb11[1]} * xj2;
      X23 -= (f32x2){Lb11[2], Lb11[3]} * xj2;
      X24 -= (f32x2){Lb12[0], Lb12[1]} * xj2;
      X25 -= (f32x2){Lb12[2], Lb12[3]} * xj2;
      X26 -= (f32x2){Lb13[0], Lb13[1]} * xj2;
      X27 -= (f32x2){Lb13[2], Lb13[3]} * xj2;
      X28 -= (f32x2){Lb14[0], Lb14[1]} * xj2;
      X29 -= (f32x2){Lb14[2], Lb14[3]} * xj2;
      X30 -= (f32x2){Lb15[0], Lb15[1]} * xj2;
      X31 -= (f32x2){Lb15[2], Lb15[3]} * xj2;
    }
    __builtin_amdgcn_sched_barrier(0);
    Lb9 = *(const f32x4*)(Lt_s + 2552);
    Lb10 = *(const f32x4*)(Lt_s + 2556);
    Lb11 = *(const f32x4*)(Lt_s + 2560);
    Lb12 = *(const f32x4*)(Lt_s + 2564);
    Lb13 = *(const f32x4*)(Lt_s + 2568);
    Lb14 = *(const f32x4*)(Lt_s + 2572);
    Lb15 = *(const f32x4*)(Lt_s + 2576);
    __builtin_amdgcn_sched_barrier(0);
    { const float xj = X18[0]; const f32x2 xj2 = (f32x2){xj, xj};
      X18 -= (f32x2){La9[0], La9[1]} * xj2;
      X19 -= (f32x2){La9[2], La9[3]} * xj2;
      X20 -= (f32x2){La10[0], La10[1]} * xj2;
      X21 -= (f32x2){La10[2], La10[3]} * xj2;
      X22 -= (f32x2){La11[0], La11[1]} * xj2;
      X23 -= (f32x2){La11[2], La11[3]} * xj2;
      X24 -= (f32x2){La12[0], La12[1]} * xj2;
      X25 -= (f32x2){La12[2], La12[3]} * xj2;
      X26 -= (f32x2){La13[0], La13[1]} * xj2;
      X27 -= (f32x2){La13[2], La13[3]} * xj2;
      X28 -= (f32x2){La14[0], La14[1]} * xj2;
      X29 -= (f32x2){La14[2], La14[3]} * xj2;
      X30 -= (f32x2){La15[0], La15[1]} * xj2;
      X31 -= (f32x2){La15[2], La15[3]} * xj2;
    }
    __builtin_amdgcn_sched_barrier(0);
    La9 = *(const f32x4*)(Lt_s + 2620);
    La10 = *(const f32x4*)(Lt_s + 2624);
    La11 = *(const f32x4*)(Lt_s + 2628);
    La12 = *(const f32x4*)(Lt_s + 2632);
    La13 = *(const f32x4*)(Lt_s + 2636);
    La14 = *(const f32x4*)(Lt_s + 2640);
    La15 = *(const f32x4*)(Lt_s + 2644);
    __builtin_amdgcn_sched_barrier(0);
    { const float xj = X18[1]; const f32x2 xj2 = (f32x2){xj, xj};
      X19 -= (f32x2){Lb9[2], Lb9[3]} * xj2;
      X20 -= (f32x2){Lb10[0], Lb10[1]} * xj2;
      X21 -= (f32x2){Lb10[2], Lb10[3]} * xj2;
      X22 -= (f32x2){Lb11[0], Lb11[1]} * xj2;
      X23 -= (f32x2){Lb11[2], Lb11[3]} * xj2;
      X24 -= (f32x2){Lb12[0], Lb12[1]} * xj2;
      X25 -= (f32x2){Lb12[2], Lb12[3]} * xj2;
      X26 -= (f32x2){Lb13[0], Lb13[1]} * xj2;
      X27 -= (f32x2){Lb13[2], Lb13[3]} * xj2;
      X28 -= (f32x2){Lb14[0], Lb14[1]} * xj2;
      X29 -= (f32x2){Lb14[2], Lb14[3]} * xj2;
      X30 -= (f32x2){Lb15[0], Lb15[1]} * xj2;
      X31 -= (f32x2){Lb15[2], Lb15[3]} * xj2;
    }
    __builtin_amdgcn_sched_barrier(0);
    Lb10 = *(const f32x4*)(Lt_s + 2692);
    Lb11 = *(const f32x4*)(Lt_s + 2696);
    Lb12 = *(const f32x4*)(Lt_s + 2700);
    Lb13 = *(const f32x4*)(Lt_s + 2704);
    Lb14 = *(const f32x4*)(Lt_s + 2708);
    Lb15 = *(const f32x4*)(Lt_s + 2712);
    __builtin_amdgcn_sched_barrier(0);
    { const float xj = X19[0]; const f32x2 xj2 = (f32x2){xj, xj};
      X19 -= (f32x2){La9[2], La9[3]} * xj2;
      X20 -= (f32x2){La10[0], La10[1]} * xj2;
      X21 -= (f32x2){La10[2], La10[3]} * xj2;
      X22 -= (f32x2){La11[0], La11[1]} * xj2;
      X23 -= (f32x2){La11[2], La11[3]} * xj2;
      X24 -= (f32x2){La12[0], La12[1]} * xj2;
      X25 -= (f32x2){La12[2], La12[3]} * xj2;
      X26 -= (f32x2){La13[0], La13[1]} * xj2;
      X27 -= (f32x2){La13[2], La13[3]} * xj2;
      X28 -= (f32x2){La14[0], La14[1]} * xj2;
      X29 -= (f32x2){La14[2], La14[3]} * xj2;
      X30 -= (f32x2){La15[0], La15[1]} * xj2;
      X31 -= (f32x2){La15[2], La15[3]} * xj2;
    }
    __builtin_amdgcn_sched_barrier(0);
    La10 = *(const f32x4*)(Lt_s + 2760);
    La11 = *(const f32x4*)(Lt_s + 2764);
    La12 = *(const f32x4*)(Lt_s + 2768);
    La13 = *(const f32x4*)(Lt_s + 2772);
    La14 = *(const f32x4*)(Lt_s + 2776);
    La15 = *(const f32x4*)(Lt_s + 2780);
    __builtin_amdgcn_sched_barrier(0);
    { const float xj = X19[1]; const f32x2 xj2 = (f32x2){xj, xj};
      X20 -= (f32x2){Lb10[0], Lb10[1]} * xj2;
      X21 -= (f32x2){Lb10[2], Lb10[3]} * xj2;
      X22 -= (f32x2){Lb11[0], Lb11[1]} * xj2;
      X23 -= (f32x2){Lb11[2], Lb11[3]} * xj2;
      X24 -= (f32x2){Lb12[0], Lb12[1]} * xj2;
      X25 -= (f32x2){Lb12[2], Lb12[3]} * xj2;
      X26 -= (f32x2){Lb13[0], Lb13[1]} * xj2;
      X27 -= (f32x2){Lb13[2], Lb13[3]} * xj2;
      X28 -= (f32x2){Lb14[0], Lb14[1]} * xj2;
      X29 -= (f32x2){Lb14[2], Lb14[3]} * xj2;
      X30 -= (f32x2){Lb15[0], Lb15[1]} * xj2;
      X31 -= (f32x2){Lb15[2], Lb15[3]} * xj2;
    }
    __builtin_amdgcn_sched_barrier(0);
    Lb10 = *(const f32x4*)(Lt_s + 2828);
    Lb11 = *(const f32x4*)(Lt_s + 2832);
    Lb12 = *(const f32x4*)(Lt_s + 2836);
    Lb13 = *(const f32x4*)(Lt_s + 2840);
    Lb14 = *(const f32x4*)(Lt_s + 2844);
    Lb15 = *(const f32x4*)(Lt_s + 2848);
    __builtin_amdgcn_sched_barrier(0);
    { const float xj = X20[0]; const f32x2 xj2 = (f32x2){xj, xj};
      X20 -= (f32x2){La10[0], La10[1]} * xj2;
      X21 -= (f32x2){La10[2], La10[3]} * xj2;
      X22 -= (f32x2){La11[0], La11[1]} * xj2;
      X23 -= (f32x2){La11[2], La11[3]} * xj2;
      X24 -= (f32x2){La12[0], La12[1]} * xj2;
      X25 -= (f32x2){La12[2], La12[3]} * xj2;
      X26 -= (f32x2){La13[0], La13[1]} * xj2;
      X27 -= (f32x2){La13[2], La13[3]} * xj2;
      X28 -= (f32x2){La14[0], La14[1]} * xj2;
      X29 -= (f32x2){La14[2], La14[3]} * xj2;
      X30 -= (f32x2){La15[0], La15[1]} * xj2;
      X31 -= (f32x2){La15[2], La15[3]} * xj2;
    }
    __builtin_amdgcn_sched_barrier(0);
    La10 = *(const f32x4*)(Lt_s + 2896);
    La11 = *(const f32x4*)(Lt_s + 2900);
    La12 = *(const f32x4*)(Lt_s + 2904);
    La13 = *(const f32x4*)(Lt_s + 2908);
    La14 = *(const f32x4*)(Lt_s + 2912);
    La15 = *(const f32x4*)(Lt_s + 2916);
    __builtin_amdgcn_sched_barrier(0);
    { const float xj = X20[1]; const f32x2 xj2 = (f32x2){xj, xj};
      X21 -= (f32x2){Lb10[2], Lb10[3]} * xj2;
      X22 -= (f32x2){Lb11[0], Lb11[1]} * xj2;
      X23 -= (f32x2){Lb11[2], Lb11[3]} * xj2;
      X24 -= (f32x2){Lb12[0], Lb12[1]} * xj2;
      X25 -= (f32x2){Lb12[2], Lb12[3]} * xj2;
      X26 -= (f32x2){Lb13[0], Lb13[1]} * xj2;
      X27 -= (f32x2){Lb13[2], Lb13[3]} * xj2;
      X28 -= (f32x2){Lb14[0], Lb14[1]} * xj2;
      X29 -= (f32x2){Lb14[2], Lb14[3]} * xj2;
      X30 -= (f32x2){Lb15[0], Lb15[1]} * xj2;
      X31 -= (f32x2){Lb15[2], Lb15[3]} * xj2;
    }
    __builtin_amdgcn_sched_barrier(0);
    Lb11 = *(const f32x4*)(Lt_s + 2968);
    Lb12 = *(const f32x4*)(Lt_s + 2972);
    Lb13 = *(const f32x4*)(Lt_s + 2976);
    Lb14 = *(const f32x4*)(Lt_s + 2980);
    Lb15 = *(const f32x4*)(Lt_s + 2984);
    __builtin_amdgcn_sched_barrier(0);
    { const float xj = X21[0]; const f32x2 xj2 = (f32x2){xj, xj};
      X21 -= (f32x2){La10[2], La10[3]} * xj2;
      X22 -= (f32x2){La11[0], La11[1]} * xj2;
      X23 -= (f32x2){La11[2], La11[3]} * xj2;
      X24 -= (f32x2){La12[0], La12[1]} * xj2;
      X25 -= (f32x2){La12[2], La12[3]} * xj2;
      X26 -= (f32x2){La13[0], La13[1]} * xj2;
      X27 -= (f32x2){La13[2], La13[3]} * xj2;
      X28 -= (f32x2){La14[0], La14[1]} * xj2;
      X29 -= (f32x2){La14[2], La14[3]} * xj2;
      X30 -= (f32x2){La15[0], La15[1]} * xj2;
      X31 -= (f32x2){La15[2], La15[3]} * xj2;
    }
    __builtin_amdgcn_sched_barrier(0);
    La11 = *(const f32x4*)(Lt_s + 3036);
    La12 = *(const f32x4*)(Lt_s + 3040);
    La13 = *(const f32x4*)(Lt_s + 3044);
    La14 = *(const f32x4*)(Lt_s + 3048);
    La15 = *(const f32x4*)(Lt_s + 3052);
    __builtin_amdgcn_sched_barrier(0);
    { const float xj = X21[1]; const f32x2 xj2 = (f32x2){xj, xj};
      X22 -= (f32x2){Lb11[0], Lb11[1]} * xj2;
      X23 -= (f32x2){Lb11[2], Lb11[3]} * xj2;
      X24 -= (f32x2){Lb12[0], Lb12[1]} * xj2;
      X25 -= (f32x2){Lb12[2], Lb12[3]} * xj2;
      X26 -= (f32x2){Lb13[0], Lb13[1]} * xj2;
      X27 -= (f32x2){Lb13[2], Lb13[3]} * xj2;
      X28 -= (f32x2){Lb14[0], Lb14[1]} * xj2;
      X29 -= (f32x2){Lb14[2], Lb14[3]} * xj2;
      X30 -= (f32x2){Lb15[0], Lb15[1]} * xj2;
      X31 -= (f32x2){Lb15[2], Lb15[3]} * xj2;
    }
    __builtin_amdgcn_sched_barrier(0);
    Lb11 = *(const f32x4*)(Lt_s + 3104);
    Lb12 = *(const f32x4*)(Lt_s + 3108);
    Lb13 = *(const f32x4*)(Lt_s + 3112);
    Lb14 = *(const f32x4*)(Lt_s + 3116);
    Lb15 = *(const f32x4*)(Lt_s + 3120);
    __builtin_amdgcn_sched_barrier(0);
    { const float xj = X22[0]; const f32x2 xj2 = (f32x2){xj, xj};
      X22 -= (f32x2){La11[0], La11[1]} * xj2;
      X23 -= (f32x2){La11[2], La11[3]} * xj2;
      X24 -= (f32x2){La12[0], La12[1]} * xj2;
      X25 -= (f32x2){La12[2], La12[3]} * xj2;
      X26 -= (f32x2){La13[0], La13[1]} * xj2;
      X27 -= (f32x2){La13[2], La13[3]} * xj2;
      X28 -= (f32x2){La14[0], La14[1]} * xj2;
      X29 -= (f32x2){La14[2], La14[3]} * xj2;
      X30 -= (f32x2){La15[0], La15[1]} * xj2;
      X31 -= (f32x2){La15[2], La15[3]} * xj2;
    }
    __builtin_amdgcn_sched_barrier(0);
    La11 = *(const f32x4*)(Lt_s + 3172);
    La12 = *(const f32x4*)(Lt_s + 3176);
    La13 = *(const f32x4*)(Lt_s + 3180);
    La14 = *(const f32x4*)(Lt_s + 3184);
    La15 = *(const f32x4*)(Lt_s + 3188);
    __builtin_amdgcn_sched_barrier(0);
    { const float xj = X22[1]; const f32x2 xj2 = (f32x2){xj, xj};
      X23 -= (f32x2){Lb11[2], Lb11[3]} * xj2;
      X24 -= (f32x2){Lb12[0], Lb12[1]} * xj2;
      X25 -= (f32x2){Lb12[2], Lb12[3]} * xj2;
      X26 -= (f32x2){Lb13[0], Lb13[1]} * xj2;
      X27 -= (f32x2){Lb13[2], Lb13[3]} * xj2;
      X28 -= (f32x2){Lb14[0], Lb14[1]} * xj2;
      X29 -= (f32x2){Lb14[2], Lb14[3]} * xj2;
      X30 -= (f32x2){Lb15[0], Lb15[1]} * xj2;
      X31 -= (f32x2){Lb15[2], Lb15[3]} * xj2;
    }
    __builtin_amdgcn_sched_barrier(0);
    Lb12 = *(const f32x4*)(Lt_s + 3244);
    Lb13 = *(const f32x4*)(Lt_s + 3248);
    Lb14 = *(const f32x4*)(Lt_s + 3252);
    Lb15 = *(const f32x4*)(Lt_s + 3256);
    __builtin_amdgcn_sched_barrier(0);
    { const float xj = X23[0]; const f32x2 xj2 = (f32x2){xj, xj};
      X23 -= (f32x2){La11[2], La11[3]} * xj2;
      X24 -= (f32x2){La12[0], La12[1]} * xj2;
      X25 -= (f32x2){La12[2], La12[3]} * xj2;
      X26 -= (f32x2){La13[0], La13[1]} * xj2;
      X27 -= (f32x2){La13[2], La13[3]} * xj2;
      X28 -= (f32x2){La14[0], La14[1]} * xj2;
      X29 -= (f32x2){La14[2], La14[3]} * xj2;
      X30 -= (f32x2){La15[0], La15[1]} * xj2;
      X31 -= (f32x2){La15[2], La15[3]} * xj2;
    }
    __builtin_amdgcn_sched_barrier(0);
    La12 = *(const f32x4*)(Lt_s + 3312);
    La13 = *(const f32x4*)(Lt_s + 3316);
    La14 = *(const f32x4*)(Lt_s + 3320);
    La15 = *(const f32x4*)(Lt_s + 3324);
    __builtin_amdgcn_sched_barrier(0);
    { const float xj = X23[1]; const f32x2 xj2 = (f32x2){xj, xj};
      X24 -= (f32x2){Lb12[0], Lb12[1]} * xj2;
      X25 -= (f32x2){Lb12[2], Lb12[3]} * xj2;
      X26 -= (f32x2){Lb13[0], Lb13[1]} * xj2;
      X27 -= (f32x2){Lb13[2], Lb13[3]} * xj2;
      X28 -= (f32x2){Lb14[0], Lb14[1]} * xj2;
      X29 -= (f32x2){Lb14[2], Lb14[3]} * xj2;
      X30 -= (f32x2){Lb15[0], Lb15[1]} * xj2;
      X31 -= (f32x2){Lb15[2], Lb15[3]} * xj2;
    }
    __builtin_amdgcn_sched_barrier(0);
    Lb12 = *(const f32x4*)(Lt_s + 3380);
    Lb13 = *(const f32x4*)(Lt_s + 3384);
    Lb14 = *(const f32x4*)(Lt_s + 3388);
    Lb15 = *(const f32x4*)(Lt_s + 3392);
    __builtin_amdgcn_sched_barrier(0);
    { const float xj = X24[0]; const f32x2 xj2 = (f32x2){xj, xj};
      X24 -= (f32x2){La12[0], La12[1]} * xj2;
      X25 -= (f32x2){La12[2], La12[3]} * xj2;
      X26 -= (f32x2){La13[0], La13[1]} * xj2;
      X27 -= (f32x2){La13[2], La13[3]} * xj2;
      X28 -= (f32x2){La14[0], La14[1]} * xj2;
      X29 -= (f32x2){La14[2], La14[3]} * xj2;
      X30 -= (f32x2){La15[0], La15[1]} * xj2;
      X31 -= (f32x2){La15[2], La15[3]} * xj2;
    }
    __builtin_amdgcn_sched_barrier(0);
    La12 = *(const f32x4*)(Lt_s + 3448);
    La13 = *(const f32x4*)(Lt_s + 3452);
    La14 = *(const f32x4*)(Lt_s + 3456);
    La15 = *(const f32x4*)(Lt_s + 3460);
    __builtin_amdgcn_sched_barrier(0);
    { const float xj = X24[1]; const f32x2 xj2 = (f32x2){xj, xj};
      X25 -= (f32x2){Lb12[2], Lb12[3]} * xj2;
      X26 -= (f32x2){Lb13[0], Lb13[1]} * xj2;
      X27 -= (f32x2){Lb13[2], Lb13[3]} * xj2;
      X28 -= (f32x2){Lb14[0], Lb14[1]} * xj2;
      X29 -= (f32x2){Lb14[2], Lb14[3]} * xj2;
      X30 -= (f32x2){Lb15[0], Lb15[1]} * xj2;
      X31 -= (f32x2){Lb15[2], Lb15[3]} * xj2;
    }
    __builtin_amdgcn_sched_barrier(0);
    Lb13 = *(const f32x4*)(Lt_s + 3520);
    Lb14 = *(const f32x4*)(Lt_s + 3524);
    Lb15 = *(const f32x4*)(Lt_s + 3528);
    __builtin_amdgcn_sched_barrier(0);
    { const float xj = X25[0]; const f32x2 xj2 = (f32x2){xj, xj};
      X25 -= (f32x2){La12[2], La12[3]} * xj2;
      X26 -= (f32x2){La13[0], La13[1]} * xj2;
      X27 -= (f32x2){La13[2], La13[3]} * xj2;
      X28 -= (f32x2){La14[0], La14[1]} * xj2;
      X29 -= (f32x2){La14[2], La14[3]} * xj2;
      X30 -= (f32x2){La15[0], La15[1]} * xj2;
      X31 -= (f32x2){La15[2], La15[3]} * xj2;
    }
    __builtin_amdgcn_sched_barrier(0);
    La13 = *(const f32x4*)(Lt_s + 3588);
    La14 = *(const f32x4*)(Lt_s + 3592);
    La15 = *(const f32x4*)(Lt_s + 3596);
    __builtin_amdgcn_sched_barrier(0);
    { const float xj = X25[1]; const f32x2 xj2 = (f32x2){xj, xj};
      X26 -= (f32x2){Lb13[0], Lb13[1]} * xj2;
      X27 -= (f32x2){Lb13[2], Lb13[3]} * xj2;
      X28 -= (f32x2){Lb14[0], Lb14[1]} * xj2;
      X29 -= (f32x2){Lb14[2], Lb14[3]} * xj2;
      X30 -= (f32x2){Lb15[0], Lb15[1]} * xj2;
      X31 -= (f32x2){Lb15[2], Lb15[3]} * xj2;
    }
    __builtin_amdgcn_sched_barrier(0);
    Lb13 = *(const f32x4*)(Lt_s + 3656);
    Lb14 = *(const f32x4*)(Lt_s + 3660);
    Lb15 = *(const f32x4*)(Lt_s + 3664);
    __builtin_amdgcn_sched_barrier(0);
    { const float xj = X26[0]; const f32x2 xj2 = (f32x2){xj, xj};
      X26 -= (f32x2){La13[0], La13[1]} * xj2;
      X27 -= (f32x2){La13[2], La13[3]} * xj2;
      X28 -= (f32x2){La14[0], La14[1]} * xj2;
      X29 -= (f32x2){La14[2], La14[3]} * xj2;
      X30 -= (f32x2){La15[0], La15[1]} * xj2;
      X31 -= (f32x2){La15[2], La15[3]} * xj2;
    }
    __builtin_amdgcn_sched_barrier(0);
    La13 = *(const f32x4*)(Lt_s + 3724);
    La14 = *(const f32x4*)(Lt_s + 3728);
    La15 = *(const f32x4*)(Lt_s + 3732);
    __builtin_amdgcn_sched_barrier(0);
    { const float xj = X26[1]; const f32x2 xj2 = (f32x2){xj, xj};
      X27 -= (f32x2){Lb13[2], Lb13[3]} * xj2;
      X28 -= (f32x2){Lb14[0], Lb14[1]} * xj2;
      X29 -= (f32x2){Lb14[2], Lb14[3]} * xj2;
      X30 -= (f32x2){Lb15[0], Lb15[1]} * xj2;
      X31 -= (f32x2){Lb15[2], Lb15[3]} * xj2;
    }
    __builtin_amdgcn_sched_barrier(0);
    Lb14 = *(const f32x4*)(Lt_s + 3796);
    Lb15 = *(const f32x4*)(Lt_s + 3800);
    __builtin_amdgcn_sched_barrier(0);
    { const float xj = X27[0]; const f32x2 xj2 = (f32x2){xj, xj};
      X27 -= (f32x2){La13[2], La13[3]} * xj2;
      X28 -= (f32x2){La14[0], La14[1]} * xj2;
      X29 -= (f32x2){La14[2], La14[3]} * xj2;
      X30 -= (f32x2){La15[0], La15[1]} * xj2;
      X31 -= (f32x2){La15[2], La15[3]} * xj2;
    }
    __builtin_amdgcn_sched_barrier(0);
    La14 = *(const f32x4*)(Lt_s + 3864);
    La15 = *(const f32x4*)(Lt_s + 3868);
    __builtin_amdgcn_sched_barrier(0);
    { const float xj = X27[1]; const f32x2 xj2 = (f32x2){xj, xj};
      X28 -= (f32x2){Lb14[0], Lb14[1]} * xj2;
      X29 -= (f32x2){Lb14[2], Lb14[3]} * xj2;
      X30 -= (f32x2){Lb15[0], Lb15[1]} * xj2;
      X31 -= (f32x2){Lb15[2], Lb15[3]} * xj2;
    }
    __builtin_amdgcn_sched_barrier(0);
    Lb14 = *(const f32x4*)(Lt_s + 3932);
    Lb15 = *(const f32x4*)(Lt_s + 3936);
    __builtin_amdgcn_sched_barrier(0);
    { const float xj = X28[0]; const f32x2 xj2 = (f32x2){xj, xj};
      X28 -= (f32x2){La14[0], La14[1]} * xj2;
      X29 -= (f32x2){La14[2], La14[3]} * xj2;
      X30 -= (f32x2){La15[0], La15[1]} * xj2;
      X31 -= (f32x2){La15[2], La15[3]} * xj2;
    }
    __builtin_amdgcn_sched_barrier(0);
    La14 = *(const f32x4*)(Lt_s + 4000);
    La15 = *(const f32x4*)(Lt_s + 4004);
    __builtin_amdgcn_sched_barrier(0);
    { const float xj = X28[1]; const f32x2 xj2 = (f32x2){xj, xj};
      X29 -= (f32x2){Lb14[2], Lb14[3]} * xj2;
      X30 -= (f32x2){Lb15[0], Lb15[1]} * xj2;
      X31 -= (f32x2){Lb15[2], Lb15[3]} * xj2;
    }
    __builtin_amdgcn_sched_barrier(0);
    Lb15 = *(const f32x4*)(Lt_s + 4072);
    __builtin_amdgcn_sched_barrier(0);
    { const float xj = X29[0]; const f32x2 xj2 = (f32x2){xj, xj};
      X29 -= (f32x2){La14[2], La14[3]} * xj2;
      X30 -= (f32x2){La15[0], La15[1]} * xj2;
      X31 -= (f32x2){La15[2], La15[3]} * xj2;
    }
    __builtin_amdgcn_sched_barrier(0);
    La15 = *(const f32x4*)(Lt_s + 4140);
    __builtin_amdgcn_sched_barrier(0);
    { const float xj = X29[1]; const f32x2 xj2 = (f32x2){xj, xj};
      X30 -= (f32x2){Lb15[0], Lb15[1]} * xj2;
      X31 -= (f32x2){Lb15[2], Lb15[3]} * xj2;
    }
    __builtin_amdgcn_sched_barrier(0);
    Lb15 = *(const f32x4*)(Lt_s + 4208);
    __builtin_amdgcn_sched_barrier(0);
    { const float xj = X30[0]; const f32x2 xj2 = (f32x2){xj, xj};
      X30 -= (f32x2){La15[0], La15[1]} * xj2;
      X31 -= (f32x2){La15[2], La15[3]} * xj2;
    }
    __builtin_amdgcn_sched_barrier(0);
    La15 = *(const f32x4*)(Lt_s + 4276);
    __builtin_amdgcn_sched_barrier(0);
    { const float xj = X30[1]; const f32x2 xj2 = (f32x2){xj, xj};
      X31 -= (f32x2){Lb15[2], Lb15[3]} * xj2;
    }
    __builtin_amdgcn_sched_barrier(0);
    __builtin_amdgcn_sched_barrier(0);
    { const float xj = X31[0]; const f32x2 xj2 = (f32x2){xj, xj};
      X31 -= (f32x2){La15[2], La15[3]} * xj2;
    }
    __builtin_amdgcn_sched_barrier(0);
    __syncthreads();
    outp[0] = f2bf(sg * X0[0]);
    outp[136] = f2bf(sg * X0[1]);
    outp[272] = f2bf(sg * X1[0]);
    outp[408] = f2bf(sg * X1[1]);
    outp[544] = f2bf(sg * X2[0]);
    outp[680] = f2bf(sg * X2[1]);
    outp[816] = f2bf(sg * X3[0]);
    outp[952] = f2bf(sg * X3[1]);
    outp[1088] = f2bf(sg * X4[0]);
    outp[1224] = f2bf(sg * X4[1]);
    outp[1360] = f2bf(sg * X5[0]);
    outp[1496] = f2bf(sg * X5[1]);
    outp[1632] = f2bf(sg * X6[0]);
    outp[1768] = f2bf(sg * X6[1]);
    outp[1904] = f2bf(sg * X7[0]);
    outp[2040] = f2bf(sg * X7[1]);
    outp[2176] = f2bf(sg * X8[0]);
    outp[2312] = f2bf(sg * X8[1]);
    outp[2448] = f2bf(sg * X9[0]);
    outp[2584] = f2bf(sg * X9[1]);
    outp[2720] = f2bf(sg * X10[0]);
    outp[2856] = f2bf(sg * X10[1]);
    outp[2992] = f2bf(sg * X11[0]);
    outp[3128] = f2bf(sg * X11[1]);
    outp[3264] = f2bf(sg * X12[0]);
    outp[3400] = f2bf(sg * X12[1]);
    outp[3536] = f2bf(sg * X13[0]);
    outp[3672] = f2bf(sg * X13[1]);
    outp[3808] = f2bf(sg * X14[0]);
    outp[3944] = f2bf(sg * X14[1]);
    outp[4080] = f2bf(sg * X15[0]);
    outp[4216] = f2bf(sg * X15[1]);
    outp[4352] = f2bf(sg * X16[0]);
    outp[4488] = f2bf(sg * X16[1]);
    outp[4624] = f2bf(sg * X17[0]);
    outp[4760] = f2bf(sg * X17[1]);
    outp[4896] = f2bf(sg * X18[0]);
    outp[5032] = f2bf(sg * X18[1]);
    outp[5168] = f2bf(sg * X19[0]);
    outp[5304] = f2bf(sg * X19[1]);
    outp[5440] = f2bf(sg * X20[0]);
    outp[5576] = f2bf(sg * X20[1]);
    outp[5712] = f2bf(sg * X21[0]);
    outp[5848] = f2bf(sg * X21[1]);
    outp[5984] = f2bf(sg * X22[0]);
    outp[6120] = f2bf(sg * X22[1]);
    outp[6256] = f2bf(sg * X23[0]);
    outp[6392] = f2bf(sg * X23[1]);
    outp[6528] = f2bf(sg * X24[0]);
    outp[6664] = f2bf(sg * X24[1]);
    outp[6800] = f2bf(sg * X25[0]);
    outp[6936] = f2bf(sg * X25[1]);
    outp[7072] = f2bf(sg * X26[0]);
    outp[7208] = f2bf(sg * X26[1]);
    outp[7344] = f2bf(sg * X27[0]);
    outp[7480] = f2bf(sg * X27[1]);
    outp[7616] = f2bf(sg * X28[0]);
    outp[7752] = f2bf(sg * X28[1]);
    outp[7888] = f2bf(sg * X29[0]);
    outp[8024] = f2bf(sg * X29[1]);
    outp[8160] = f2bf(sg * X30[0]);
    outp[8296] = f2bf(sg * X30[1]);
    outp[8432] = f2bf(sg * X31[0]);
    outp[8568] = f2bf(sg * X31[1]);
}

DEV void dn_item(const Params& p, int l, int item, unsigned char* smem) {
    const int dir = item & 1, hh = (item >> 1) & 3, b = item >> 3;
    bf16_t* q_s = (bf16_t*)(smem);
    bf16_t* k_s = (bf16_t*)(smem + 17408);
    bf16_t* vnT_s = k_s;
    bf16_t* kT_s = (bf16_t*)(smem + 35840);
    bf16_t* v_s = (bf16_t*)(smem + 54272);
    bf16_t* u_s = v_s;
    float* L_s = (float*)(smem + 71680);
    bf16_t* w_s = (bf16_t*)(smem + 71680);
    bf16_t* qk_s = (bf16_t*)(smem + 89088);
    bf16_t* St_s = (bf16_t*)(smem + 98304);
    float* G_s = (float*)(smem + 133120);
    float* beta_s = G_s + 64;
    float* eG_s = G_s + 128;
    float* bw_s = G_s + 192;
    float* cw_s = G_s + 256;
    const int tid = get_tid(), lane = tid & 63, wv = tid >> 6, l15 = lane & 15, quad = lane >> 4;
    const float Aneg = -expf(p.in[I_DNALOG][(l * 2 + dir) * 4 + hh]);
    const float dtb = p.in[I_DNDT][(l * 2 + dir) * 4 + hh];
    const bf16_t* P = wsb(p, O_P);
    const float* AB = wsf(p, O_AB);
    bf16_t* TO = wsb(p, dir ? O_TA2 : O_TA);
    __syncthreads();
    for (int e = tid; e < 4 * 384; e += 256) { int j = e / 384, c = e % 384, mat = c >> 7, cc = c & 127; cw_s[e] = p.in[I_DNCONV][((size_t)l * 4 + j) * 1536 + mat * 512 + hh * 128 + cc]; }
    for (int e = tid; e < 128 * 136 / 2; e += 256) ((unsigned*)St_s)[e] = 0u;
    f32x4 Sacc[2][8];
#pragma unroll
    for (int a = 0; a < 2; ++a)
#pragma unroll
        for (int c = 0; c < 8; ++c) Sacc[a][c] = (f32x4){0.f, 0.f, 0.f, 0.f};

    const int rg = tid >> 4, cseg = tid & 15, i0 = rg * 4;
    u32x4 raw[3][7];
    float pf_al = 0.f, pf_bb = 0.f;
#define DN_PREFETCH(NN, M0, M1) { \
        const int c_ = chunk_of(dir, (NN)); const int lo_ = c_ < 4 ? 0 : CTXL, hi_ = c_ < 4 ? CTXL : SB, base_ = c_ * 64; \
        const int slo_ = dir ? base_ + 60 - i0 : base_ + i0; \
        _Pragma("unroll") for (int u = 0; u < 7; ++u) { const int ss_ = slo_ - 1 + u; const bool ok_ = ss_ >= lo_ && ss_ < hi_; \
            const bf16_t* rp_ = P + ((size_t)b * SB + (ok_ ? ss_ : base_)) * PW + hh * 128 + cseg * 8; \
            _Pragma("unroll") for (int mat = (M0); mat < (M1); ++mat) { u32x4 t_ = *(const u32x4*)(rp_ + mat * 512); raw[mat][u] = ok_ ? t_ : (u32x4){0u, 0u, 0u, 0u}; } } \
        if ((M0) == 0) { const int sa_ = dir ? base_ + 63 - lane : base_ + lane; \
        pf_al = AB[((size_t)b * SB + sa_) * 16 + dir * 4 + hh]; pf_bb = AB[((size_t)b * SB + sa_) * 16 + 8 + dir * 4 + hh]; } }
    DN_PREFETCH(0, 0, 3);
    const int wv0_ = wv, l150_ = l15, quad0_ = quad, lane0_ = lane;

#pragma unroll 1
    for (int n = 0; n < 68; ++n) {
        int tz0 = 0; asm volatile("" : "+v"(tz0));
        const int wv = wv0_ + tz0, l15 = l150_ + tz0, quad = quad0_ + tz0, lane = lane0_ + tz0;
        const int c = chunk_of(dir, n);
        const int base = c * 64;
        __syncthreads();
        if (wv == 0) {
            float g = Aneg * softplus_fast(pf_al + dtb);
#pragma unroll
            for (int o = 1; o < 64; o <<= 1) { float t = __shfl_up(g, o); if (lane >= o) g += t; }
            const float eg_ = expf(g), bt_ = sigm(pf_bb); G_s[lane] = g; beta_s[lane] = bt_; eG_s[lane] = eg_; bw_s[lane] = bt_ * eg_;
        }
        __syncthreads();
        const float Glast = G_s[63];
        {
            int tz = 0; asm volatile("" : "+v"(tz));
            const int i0l = i0 + tz, csl = cseg + tz;
            float ksc[4];
#pragma unroll
            for (int m = 0; m < 4; ++m) ksc[m] = expf(Glast - G_s[i0l + m]);
#pragma unroll
            for (int mat = 0; mat < 3; ++mat) {
                float w[4][8];
#pragma unroll
                for (int j = 0; j < 4; ++j) { const f32x4 w0 = *(const f32x4*)(cw_s + j * 384 + mat * 128 + csl * 8), w1 = *(const f32x4*)(cw_s + j * 384 + mat * 128 + csl * 8 + 4);
#pragma unroll
                    for (int e = 0; e < 4; ++e) { w[j][e] = w0[e]; w[j][4 + e] = w1[e]; } }
                float v[4][8];
#pragma unroll
                for (int t = 0; t < 4; ++t)
#pragma unroll
                    for (int e = 0; e < 8; ++e) v[t][e] = 0.f;
#pragma unroll
                for (int u = 0; u < 7; ++u) {
                    float x[8];
#pragma unroll
                    for (int e = 0; e < 4; ++e) { x[2 * e] = lo16(raw[mat][u][e]); x[2 * e + 1] = hi16(raw[mat][u][e]); }
#pragma unroll
                    for (int t = 0; t < 4; ++t) { const int j = u - t; if (j >= 0 && j < 4) {
#pragma unroll
                        for (int e = 0; e < 8; ++e) v[t][e] += w[j][e] * x[e]; } }
                }
                float sc[4];
#pragma unroll
                for (int t = 0; t < 4; ++t) {
                    float ss2 = 0.f;
#pragma unroll
                    for (int e = 0; e < 8; ++e) { v[t][e] = silu(v[t][e]); ss2 += v[t][e] * v[t][e]; }
                    if (mat < 2) { ss2 += __shfl_xor(ss2, 1); ss2 += __shfl_xor(ss2, 2); ss2 += __shfl_xor(ss2, 4); ss2 += __shfl_xor(ss2, 8); }
                    sc[t] = mat == 0 ? rsqrtf(ss2 + 1e-6f) * 0.08838834764831845f : (mat == 1 ? rsqrtf(ss2 + 1e-6f) : 1.f);
                }
                bf16_t* dst = mat == 0 ? q_s : (mat == 1 ? k_s : v_s);
#pragma unroll
                for (int t = 0; t < 4; ++t) {
                    const int it_ = dir ? i0l + 3 - t : i0l + t;
                    u32x4 o;
#pragma unroll
                    for (int e = 0; e < 4; ++e) o[e] = pack2(v[t][2 * e] * sc[t], v[t][2 * e + 1] * sc[t]);
                    *(u32x4*)(dst + it_ * 136 + csl * 8) = o;
                }
                if (mat == 1) {
#pragma unroll
                    for (int e = 0; e < 8; ++e) {
                        const float k0 = v[dir ? 3 : 0][e] * sc[dir ? 3 : 0] * ksc[0], k1 = v[dir ? 2 : 1][e] * sc[dir ? 2 : 1] * ksc[1];
                        const float k2 = v[dir ? 1 : 2][e] * sc[dir ? 1 : 2] * ksc[2], k3 = v[dir ? 0 : 3][e] * sc[dir ? 0 : 3] * ksc[3];
                        u32x2 o; o.x = pack2(k0, k1); o.y = pack2(k2, k3);
                        *(u32x2*)(kT_s + (csl * 8 + e) * 72 + i0l) = o;
                    }
                }
            }
        }
        __syncthreads();
        {
            bf16x8 ak[4], aq[4];
#pragma unroll
            for (int ks = 0; ks < 4; ++ks) { ak[ks] = *(const bf16x8*)(k_s + (wv * 16 + l15) * 136 + ks * 32 + quad * 8); aq[ks] = *(const bf16x8*)(q_s + (wv * 16 + l15) * 136 + ks * 32 + quad * 8); }
#pragma unroll
            for (int nt = 0; nt < 4; ++nt) {
                f32x4 kk = {0.f, 0.f, 0.f, 0.f}, qq = {0.f, 0.f, 0.f, 0.f};
#pragma unroll
                for (int ks = 0; ks < 4; ++ks) { bf16x8 bk = *(const bf16x8*)(k_s + (nt * 16 + l15) * 136 + ks * 32 + quad * 8); kk = mfma16(ak[ks], bk, kk); qq = mfma16(aq[ks], bk, qq); }
                const int jj = nt * 16 + l15; const float Gj = G_s[jj];
                f32x4 lv;
#pragma unroll
                for (int j = 0; j < 4; ++j) {
                    const int i = wv * 16 + quad * 4 + j;
                    const float dec = jj <= i ? expf(G_s[i] - Gj) : 0.f;
                    lv[j] = jj < i ? beta_s[i] * kk[j] * dec : 0.f;
                    qk_s[i * 72 + jj] = f2bf(qq[j] * dec);
                }
                *(f32x4*)(L_s + jj * 68 + wv * 16 + quad * 4) = lv;
            }
        }
        __syncthreads();
        dn_solve(L_s, tid < 128 ? (k_s + tid) : (v_s + (tid - 128)), tid < 128 ? bw_s : beta_s, tid < 128 ? -1.f : 1.f, tid < 128 ? (w_s + tid) : (u_s + (tid - 128)));
        __syncthreads();
        {
            f32x4 vn[8], o1[8];
#pragma unroll
            for (int nt = 0; nt < 8; ++nt) {
#pragma unroll
                for (int j = 0; j < 4; ++j) vn[nt][j] = bf2f(u_s[(wv * 16 + quad * 4 + j) * 136 + nt * 16 + l15]);
                o1[nt] = (f32x4){0.f, 0.f, 0.f, 0.f};
            }
            bf16x8 aw[4], aq[4];
#pragma unroll
            for (int ks = 0; ks < 4; ++ks) { aw[ks] = *(const bf16x8*)(w_s + (wv * 16 + l15) * 136 + ks * 32 + quad * 8); aq[ks] = *(const bf16x8*)(q_s + (wv * 16 + l15) * 136 + ks * 32 + quad * 8); }
#pragma unroll
            for (int nt = 0; nt < 8; ++nt)
#pragma unroll
                for (int ks = 0; ks < 4; ++ks) { bf16x8 bs = *(const bf16x8*)(St_s + (nt * 16 + l15) * 136 + ks * 32 + quad * 8); vn[nt] = mfma16(aw[ks], bs, vn[nt]); o1[nt] = mfma16(aq[ks], bs, o1[nt]); }
#pragma unroll
            for (int nt = 0; nt < 8; ++nt) { u32x2 o; o.x = pack2(vn[nt][0], vn[nt][1]); o.y = pack2(vn[nt][2], vn[nt][3]); *(u32x2*)(vnT_s + (nt * 16 + l15) * 72 + wv * 16 + quad * 4) = o; }
            __syncthreads();
            if (n + 1 < 68) DN_PREFETCH(n + 1, 0, 2);
            float eg[4];
#pragma unroll
            for (int j = 0; j < 4; ++j) eg[j] = eG_s[wv * 16 + quad * 4 + j];
            bf16x8 aqk[2], akt[2][2];
#pragma unroll
            for (int ks = 0; ks < 2; ++ks) {
                aqk[ks] = *(const bf16x8*)(qk_s + (wv * 16 + l15) * 72 + ks * 32 + quad * 8);
                akt[0][ks] = *(const bf16x8*)(kT_s + (wv * 32 + l15) * 72 + ks * 32 + quad * 8);
                akt[1][ks] = *(const bf16x8*)(kT_s + (wv * 32 + 16 + l15) * 72 + ks * 32 + quad * 8);
            }
            const float gend = eG_s[63];
            const size_t orow0 = (size_t)b * SB;
#pragma unroll
            for (int nt = 0; nt < 8; ++nt) {
                f32x4 o;
#pragma unroll
                for (int j = 0; j < 4; ++j) { o[j] = o1[nt][j] * eg[j]; Sacc[0][nt][j] *= gend; Sacc[1][nt][j] *= gend; }
#pragma unroll
                for (int ks = 0; ks < 2; ++ks) {
                    bf16x8 bv = *(const bf16x8*)(vnT_s + (nt * 16 + l15) * 72 + ks * 32 + quad * 8);
                    o = mfma16(aqk[ks], bv, o);
                    Sacc[0][nt] = mfma16(akt[0][ks], bv, Sacc[0][nt]);
                    Sacc[1][nt] = mfma16(akt[1][ks], bv, Sacc[1][nt]);
                }
#pragma unroll
                for (int j = 0; j < 4; ++j) {
                    const int i = wv * 16 + quad * 4 + j;
                    const int s = dir ? base + 63 - i : base + i;
                    TO[(orow0 + s) * 512 + hh * 128 + nt * 16 + l15] = f2bf(o[j]);
                }
#pragma unroll
                for (int mt = 0; mt < 2; ++mt) { u32x2 sv; sv.x = pack2(Sacc[mt][nt][0], Sacc[mt][nt][1]); sv.y = pack2(Sacc[mt][nt][2], Sacc[mt][nt][3]);
                    *(u32x2*)(St_s + (nt * 16 + l15) * 136 + wv * 32 + mt * 16 + quad * 4) = sv; }
            }
        }
        if (n + 1 < 68) DN_PREFETCH(n + 1, 2, 3);
    }
}

#undef DN_PREFETCH
DEV void lru_item(const Params& p, int l, int item, unsigned char* smem) {
    const int g = item & 7, b = item >> 3;
    bf16_t* Wt_s = (bf16_t*)smem;
    bf16_t* xbh_s = Wt_s + 2 * 128 * 72;
    float* xbf_s = (float*)(smem + 36864 + 18432);
    float* a_s = xbf_s + 2 * 64 * 65;
    float* cw_s = a_s + 2 * 64 * 65;
    const int tid = get_tid(), lane = tid & 63, wv = tid >> 6, l15 = lane & 15, quad = lane >> 4;
    bf16_t* P = wsb(p, O_P);
    bf16_t* HF = wsb(p, O_U);
    __syncthreads();
    for (int e = tid; e < 320; e += 256) cw_s[e] = e < 256 ? p.in[I_LCW][((size_t)l * 4 + (e >> 6)) * 512 + g * 64 + (e & 63)] : p.in[I_LCB][l * 512 + g * 64 + (e - 256)];
    for (int e = tid; e < 2 * 4096; e += 256) {
        const int d = e >> 12, ch = (e >> 6) & 63, j = e & 63;
        const size_t wi_ = (((size_t)l * 2 + d) * 8 + g) * 4096 + ch * 64 + j;
        Wt_s[(d * 128 + j) * 72 + ch] = f2bf(p.in[I_LWA][wi_]);
        Wt_s[(d * 128 + 64 + j) * 72 + ch] = f2bf(p.in[I_LWI][wi_]);
    }
    float ba_[2][4], bi_[2][4], sp_[2][4];
#pragma unroll
    for (int d = 0; d < 2; ++d)
#pragma unroll
        for (int nt = 0; nt < 4; ++nt) {
            const int ch = (l * 2 + d) * 512 + g * 64 + nt * 16 + l15;
            ba_[d][nt] = p.in[I_LBA][ch]; bi_[d][nt] = p.in[I_LBI][ch]; sp_[d][nt] = softplus(-p.in[I_LLAM][ch]);
        }
    float hc = 0.f;
    const int i = tid >> 2, seg = tid & 3, j0 = seg * 16;
#pragma unroll 1
    for (int n = 0; n < 68; ++n) {
        const int cf = n, cb = chunk_of(1, n);
        __syncthreads();
#pragma unroll
        for (int d = 0; d < 2; ++d) {
            const int c = d ? cb : cf;
            const int seg_lo = c < 4 ? 0 : CTXL, seg_hi = c < 4 ? CTXL : SB;
            const int s = d ? c * 64 + 63 - i : c * 64 + i;
            float v[16];
#pragma unroll
            for (int e = 0; e < 16; ++e) v[e] = cw_s[256 + j0 + e];
#pragma unroll
            for (int j = 0; j < 4; ++j) {
                const int ss = s + j - 1;
                if (ss >= seg_lo && ss < seg_hi) {
                    const u32x4* src = (const u32x4*)(P + ((size_t)b * SB + ss) * PW + C_LX + g * 64 + j0);
                    const float* cw = cw_s + j * 64 + j0;
#pragma unroll
                    for (int q = 0; q < 2; ++q) { u32x4 x = src[q];
#pragma unroll
                        for (int e = 0; e < 4; ++e) { v[q * 8 + 2 * e] += cw[q * 8 + 2 * e] * lo16(x[e]); v[q * 8 + 2 * e + 1] += cw[q * 8 + 2 * e + 1] * hi16(x[e]); } }
                }
            }
            u32x4 h0, h1;
#pragma unroll
            for (int e = 0; e < 4; ++e) { h0[e] = pack2(v[2 * e], v[2 * e + 1]); h1[e] = pack2(v[8 + 2 * e], v[8 + 2 * e + 1]); }
            *(u32x4*)(xbh_s + (d * 64 + i) * 72 + j0) = h0; *(u32x4*)(xbh_s + (d * 64 + i) * 72 + j0 + 8) = h1;
#pragma unroll
            for (int e = 0; e < 16; ++e) xbf_s[(d * 64 + i) * 65 + j0 + e] = v[e];
        }
        __syncthreads();
#pragma unroll
        for (int d = 0; d < 2; ++d) {
            f32x4 acc[8];
#pragma unroll
            for (int nt = 0; nt < 8; ++nt) acc[nt] = (f32x4){0.f, 0.f, 0.f, 0.f};
            bf16x8 af[2];
#pragma unroll
            for (int ks = 0; ks < 2; ++ks) af[ks] = *(const bf16x8*)(xbh_s + (d * 64 + wv * 16 + l15) * 72 + ks * 32 + quad * 8);
#pragma unroll
            for (int nt = 0; nt < 8; ++nt)
#pragma unroll
                for (int ks = 0; ks < 2; ++ks) { bf16x8 bw = *(const bf16x8*)(Wt_s + (d * 128 + nt * 16 + l15) * 72 + ks * 32 + quad * 8); acc[nt] = mfma16(af[ks], bw, acc[nt]); }
#pragma unroll
            for (int nt = 0; nt < 4; ++nt)
#pragma unroll
                for (int jj = 0; jj < 4; ++jj) {
                    const int idx = (d * 64 + wv * 16 + quad * 4 + jj) * 65 + nt * 16 + l15;
                    const float r = sigm(acc[nt][jj] + ba_[d][nt]), ig = sigm(acc[nt + 4][jj] + bi_[d][nt]);
                    const float la = -8.f * r * sp_[d][nt];
                    a_s[idx] = expf(la);
                    xbf_s[idx] = sqrtf(fmaxf(1.f - expf(2.f * la), 0.f)) * (ig * xbf_s[idx]);
                }
        }
        __syncthreads();
        if (wv < 2) {
            const int o = wv * 64 * 65 + lane;
#pragma unroll 16
            for (int r = 0; r < 64; ++r) { hc = a_s[o + r * 65] * hc + xbf_s[o + r * 65]; xbf_s[o + r * 65] = hc; }
        }
        __syncthreads();
#pragma unroll
        for (int d = 0; d < 2; ++d) {
            const int c = d ? cb : cf;
            const int s = d ? c * 64 + 63 - i : c * 64 + i;
            const bool second = d ? (cb < n) : ((cf < 4 ? 3 - cf : 71 - cf) < n);
            const size_t row = (size_t)b * SB + s;
            const float* hp = xbf_s + (d * 64 + i) * 65 + j0;
            bf16_t* hf = HF + row * 512 + g * 64 + j0;
            if (!second) {
                u32x4 o0, o1;
#pragma unroll
                for (int e = 0; e < 4; ++e) { o0[e] = pack2(hp[2 * e], hp[2 * e + 1]); o1[e] = pack2(hp[8 + 2 * e], hp[8 + 2 * e + 1]); }
                *(u32x4*)hf = o0; *(u32x4*)(hf + 8) = o1;
            } else {
                bf16_t* gp = P + row * PW + C_LG + g * 64 + j0;
                u32x4 f0 = *(const u32x4*)hf, f1 = *(const u32x4*)(hf + 8), g0 = *(const u32x4*)gp, g1 = *(const u32x4*)(gp + 8), o0, o1;
#pragma unroll
                for (int e = 0; e < 4; ++e) {
                    o0[e] = pack2((lo16(f0[e]) + hp[2 * e]) * gelu_tanh(lo16(g0[e])), (hi16(f0[e]) + hp[2 * e + 1]) * gelu_tanh(hi16(g0[e])));
                    o1[e] = pack2((lo16(f1[e]) + hp[8 + 2 * e]) * gelu_tanh(lo16(g1[e])), (hi16(f1[e]) + hp[8 + 2 * e + 1]) * gelu_tanh(hi16(g1[e])));
                }
                *(u32x4*)gp = o0; *(u32x4*)(gp + 8) = o1;
            }
        }
    }
}

DEV void att_item(const Params& p, int l, int b, int h, int qt, float lam_init, unsigned char* smem) {
    bf16_t* K_s = (bf16_t*)smem;
    bf16_t* V_s = (bf16_t*)(smem + 2 * 17408);
    const int tid = get_tid(), lane = tid & 63, wv = tid >> 6, l15 = lane & 15, quad = lane >> 4;
    bf16_t* P = wsb(p, O_P);
    const bf16_t* VT = wsb(p, O_VT) + (size_t)(b * 4 + h) * 128 * SB;
    const int nt_keys = (qt < 2 ? CTXL : SB) / 64;
    float lam;
    {
        const float* lv = p.in[I_DALAM] + l * 256;
        float s1 = lv[lane] * lv[64 + lane], s2 = lv[128 + lane] * lv[192 + lane];
#pragma unroll
        for (int o = 32; o >= 1; o >>= 1) { s1 += __shfl_xor(s1, o); s2 += __shfl_xor(s2, o); }
        lam = expf(s1) - expf(s2) + lam_init;
    }
    bf16x8* Qst = (bf16x8*)(smem + 71680) + (wv * 8) * 64 + lane;
#pragma unroll
    for (int qg = 0; qg < 2; ++qg) {
        const bf16_t* qp = P + ((size_t)b * SB + qt * 128 + wv * 32 + qg * 16 + l15) * PW + C_DAQ + h * 128;
#pragma unroll
        for (int wh = 0; wh < 2; ++wh)
#pragma unroll
            for (int ks = 0; ks < 2; ++ks) Qst[(wh * 4 + qg * 2 + ks) * 64] = *(const bf16x8*)(qp + wh * 64 + ks * 32 + quad * 8);
    }
    f32x4 O[2][8][2];
    float mrun[2][2], lrun[2][2];
#pragma unroll
    for (int wh = 0; wh < 2; ++wh)
#pragma unroll
        for (int qg = 0; qg < 2; ++qg) { mrun[wh][qg] = -1e30f; lrun[wh][qg] = 0.f;
#pragma unroll
            for (int dg = 0; dg < 8; ++dg) O[wh][dg][qg] = (f32x4){0.f, 0.f, 0.f, 0.f}; }
    const int kr = tid >> 2, kseg = (tid & 3) * 32;
    const int kpos = ((kr >> 5) * 2 + ((kr & 7) >> 2)) * 16 + ((kr & 31) >> 3) * 4 + (kr & 3);
    const bf16_t* kg_ = P + ((size_t)b * SB + kr) * PW + C_DAK + h * 128 + kseg;
    const int vr = tid >> 1, vh = (tid & 1) * 32;
    const bf16_t* vg_ = VT + (size_t)vr * SB + vh;
    u32x4 kreg[4], vreg[4];
#pragma unroll
    for (int i = 0; i < 4; ++i) { kreg[i] = *(const u32x4*)(kg_ + i * 8); vreg[i] = *(const u32x4*)(vg_ + i * 8); }
    __syncthreads();
#pragma unroll
    for (int i = 0; i < 4; ++i) { *(u32x4*)(K_s + kpos * 136 + kseg + i * 8) = kreg[i]; *(u32x4*)(V_s + vr * 72 + vh + i * 8) = vreg[i]; }
    __syncthreads();
    const float L2E = 1.4426950408889634f;
#pragma unroll 1
    for (int t = 0; t < nt_keys; ++t) {
        const bf16_t* Kb = K_s + (t & 1) * (64 * 136);
        const bf16_t* Vb = V_s + (t & 1) * (128 * 72);
        if (t + 1 < nt_keys) {
#pragma unroll
            for (int i = 0; i < 4; ++i) { kreg[i] = *(const u32x4*)(kg_ + (size_t)(t + 1) * 64 * PW + i * 8); vreg[i] = *(const u32x4*)(vg_ + (t + 1) * 64 + i * 8); }
        }
#pragma unroll
        for (int wh = 0; wh < 2; ++wh) {
            f32x4 S[4][2];
#pragma unroll
            for (int kg = 0; kg < 4; ++kg) { S[kg][0] = (f32x4){0.f, 0.f, 0.f, 0.f}; S[kg][1] = (f32x4){0.f, 0.f, 0.f, 0.f}; }
#pragma unroll
            for (int ks = 0; ks < 2; ++ks)
#pragma unroll
                for (int kg = 0; kg < 4; ++kg) {
                    bf16x8 kf = *(const bf16x8*)(Kb + (kg * 16 + l15) * 136 + wh * 64 + ks * 32 + quad * 8);
                    S[kg][0] = mfma16(kf, Qst[(wh * 4 + 0 + ks) * 64], S[kg][0]);
                    S[kg][1] = mfma16(kf, Qst[(wh * 4 + 2 + ks) * 64], S[kg][1]);
                }
            bf16x8 Pf[2][2];
#pragma unroll
            for (int qg = 0; qg < 2; ++qg) {
                float mx = -1e30f;
#pragma unroll
                for (int kg = 0; kg < 4; ++kg)
#pragma unroll
                    for (int j = 0; j < 4; ++j) mx = fmaxf(mx, S[kg][qg][j]);
                mx = fmaxf(mx, __shfl_xor(mx, 16)); mx = fmaxf(mx, __shfl_xor(mx, 32));
                mx *= L2E;
                if (__builtin_amdgcn_ballot_w64(mx > mrun[wh][qg] + 8.f) != 0ull) {
                    const float mnew = fmaxf(mrun[wh][qg], mx);
                    const float alpha = __builtin_amdgcn_exp2f(mrun[wh][qg] - mnew);
                    mrun[wh][qg] = mnew;
                    lrun[wh][qg] *= alpha;
#pragma unroll
                    for (int dg = 0; dg < 8; ++dg)
#pragma unroll
                        for (int j = 0; j < 4; ++j) O[wh][dg][qg][j] *= alpha;
                }
                const float mref = mrun[wh][qg];
                float ps = 0.f;
#pragma unroll
                for (int kg = 0; kg < 4; ++kg)
#pragma unroll
                    for (int j = 0; j < 4; ++j) { float pv = __builtin_amdgcn_exp2f(S[kg][qg][j] * L2E - mref); ps += pv; S[kg][qg][j] = pv; }
                lrun[wh][qg] += ps;
#pragma unroll
                for (int s_ = 0; s_ < 2; ++s_) {
                    u32x4 pk; pk[0] = pack2(S[2 * s_][qg][0], S[2 * s_][qg][1]); pk[1] = pack2(S[2 * s_][qg][2], S[2 * s_][qg][3]);
                    pk[2] = pack2(S[2 * s_ + 1][qg][0], S[2 * s_ + 1][qg][1]); pk[3] = pack2(S[2 * s_ + 1][qg][2], S[2 * s_ + 1][qg][3]);
                    Pf[qg][s_] = __builtin_bit_cast(bf16x8, pk);
                }
            }
#pragma unroll
            for (int dg = 0; dg < 8; ++dg)
#pragma unroll
                for (int s_ = 0; s_ < 2; ++s_) {
                    bf16x8 vf = *(const bf16x8*)(Vb + (dg * 16 + l15) * 72 + s_ * 32 + quad * 8);
                    O[wh][dg][0] = mfma16(vf, Pf[0][s_], O[wh][dg][0]);
                    O[wh][dg][1] = mfma16(vf, Pf[1][s_], O[wh][dg][1]);
                }
        }
        if (t + 1 < nt_keys) {
            bf16_t* Kn = K_s + ((t + 1) & 1) * (64 * 136); bf16_t* Vn = V_s + ((t + 1) & 1) * (128 * 72);
#pragma unroll
            for (int i = 0; i < 4; ++i) { *(u32x4*)(Kn + kpos * 136 + kseg + i * 8) = kreg[i]; *(u32x4*)(Vn + vr * 72 + vh + i * 8) = vreg[i]; }
        }
        __syncthreads();
    }
    const float* dnw = p.in[I_DANORM] + l * 128;
#pragma unroll
    for (int qg = 0; qg < 2; ++qg) {
        float l1 = lrun[0][qg], l2 = lrun[1][qg];
        l1 += __shfl_xor(l1, 16); l1 += __shfl_xor(l1, 32); l2 += __shfl_xor(l2, 16); l2 += __shfl_xor(l2, 32);
        const float i1 = 1.f / l1, i2 = lam / l2;
        float ss = 0.f;
#pragma unroll
        for (int dg = 0; dg < 8; ++dg)
#pragma unroll
            for (int j = 0; j < 4; ++j) { float o = O[0][dg][qg][j] * i1 - O[1][dg][qg][j] * i2; O[0][dg][qg][j] = o; ss += o * o; }
        ss += __shfl_xor(ss, 16); ss += __shfl_xor(ss, 32);
        const float rstd = rsqrtf(ss * (1.f / 128.f) + 1e-5f) * (1.f - lam_init);
        bf16_t* op = P + ((size_t)b * SB + qt * 128 + wv * 32 + qg * 16 + l15) * PW + C_DAQ + h * 128;
#pragma unroll
        for (int dg = 0; dg < 8; ++dg) {
            const int dv0 = dg * 16 + quad * 4;
            u32x2 o; o.x = pack2(O[0][dg][qg][0] * rstd * dnw[dv0], O[0][dg][qg][1] * rstd * dnw[dv0 + 1]);
            o.y = pack2(O[0][dg][qg][2] * rstd * dnw[dv0 + 2], O[0][dg][qg][3] * rstd * dnw[dv0 + 3]);
            *(u32x2*)(op + dv0) = o;
        }
    }
}

DEV void phase_mix(const Params& p, int l, unsigned char* smem) {
    const bool need_ctx = l == 0;
    const float lam_init = l == 0 ? 0.2f : 0.35550906759096926f;
    unsigned* ctr = (unsigned*)(p.ws + O_CTL) + l;
    unsigned* actr = (unsigned*)(p.ws + O_CTL) + 16 + l * 8;
    __shared__ int s_item;
    const int nqt = need_ctx ? 34 : 32;
    auto next = [&](unsigned* c) -> int {
        __syncthreads();
        if (threadIdx.x == 0) s_item = (int)atomicAdd(c, 1u);
        __syncthreads();
        return __builtin_amdgcn_readfirstlane(s_item);
    };
    int it = next(ctr);
#pragma unroll 1
    while (it < 64) { dn_item(p, l, it, smem); it = next(ctr); }
#pragma unroll 1
    while (it < 128) { lru_item(p, l, it - 64, smem); it = next(ctr); }
    const int myx = blockIdx.x & 7;
#pragma unroll 1
    for (int k = 0; k < 8; ++k) {
        const int x = (myx + k) & 7;
        it = next(actr + x);
#pragma unroll 1
        while (it < 4 * nqt) {
            const int bh = x + 8 * (it / nqt), idx = it % nqt;
            const int qt = idx < 32 ? idx + 2 : idx - 32;
            att_item(p, l, bh >> 2, bh & 3, qt, lam_init, smem);
            it = next(actr + x);
        }
    }
}

constexpr int NPHASE = 1 + 2 * 9 + 1;
DEV void run_phase(const Params& p, int ph, unsigned char* smem) {
    if (ph == 0) { phase_mod(p, smem); phase_rope(p); __syncthreads(); phase_wconv(p, 0, smem); return; }
    if (ph == NPHASE - 1) { phase_final(p); return; }
    const int l = (ph - 1) / 9, q = (ph - 1) % 9;
    const bool first = l == 0, lat = l == 1;
    const bf16_t* W = wsb(p, O_WT);
    switch (q) {
        case 0: if (l == 1) phase_wconv(p, 1, smem); phase_norm(p, l, 0, first, false); break;
        case 1: phase_g1(p, smem); break;
        case 2: phase_mix(p, l, smem); break;
        case 3: phase_fin_norm(p, l, first, lat); break;
        case 4: phase_gate(p, lat, smem); break;
        case 5: phase_resid(p, l, wsb(p, O_U), D, W + W_OUT, 1024, 2, first, lat, smem); break;
        case 6: phase_norm(p, l, 1, false, lat); break;
        case 7: phase_gu(p, lat, smem); break;
        case 8: phase_resid(p, l, wsb(p, O_P), PW, W + W_DN, DFF, 5, false, lat, smem); break;
    }
}

#if MEGA
__global__ void __launch_bounds__(256) mega_kernel(Params p) {
    extern __shared__ __align__(16) unsigned char smem[];
    cg::grid_group grid = cg::this_grid();
    phase_mod(p, smem); phase_rope(p); __syncthreads(); phase_wconv(p, 0, smem);
    grid.sync();
    const bf16_t* W = wsb(p, O_WT);
#pragma unroll
    for (int l = 0; l < 2; ++l) {
        const bool first = l == 0, lat = l == 1;
        if (l == 1) phase_wconv(p, 1, smem);
        phase_norm(p, l, 0, first, false);
        grid.sync();
        phase_g1(p, smem);
        grid.sync();
        phase_mix(p, l, smem);
        grid.sync();
        phase_fin_norm(p, l, first, lat);
        grid.sync();
        phase_gate(p, lat, smem);
        grid.sync();
        phase_merge(p, lat, smem);
        grid.sync();
        phase_resid(p, l, wsb(p, O_U), D, W + W_OUT, 1024, 2, first, lat, smem);
        grid.sync();
        phase_norm(p, l, 1, false, lat);
        grid.sync();
        phase_gu(p, lat, smem);
        grid.sync();
        phase_resid(p, l, wsb(p, O_P), PW, W + W_DN, DFF, 5, false, lat, smem);
        grid.sync();
    }
    phase_final(p);
}
#else
__global__ void __launch_bounds__(256) phase_kernel(Params p, int ph) {
    extern __shared__ __align__(16) unsigned char smem[];
    run_phase(p, ph, smem);
}
#endif

extern "C" void kernel_launch(void* const* d_in, const int* in_sizes, int n_in, void* d_out, int out_size, void* d_ws, size_t ws_size, hipStream_t stream) {
    static int grid = 0;
    if (grid == 0) {
        if (n_in != 28 || ws_size < WS_END) { fprintf(stderr, "kernel_launch: unexpected n_in %d or ws_size %zu < %zu\n", n_in, ws_size, (size_t)WS_END); grid = -1; return; }
        int dev = 0, cus = 0, per_cu = 0;
        hipGetDevice(&dev);
        hipDeviceGetAttribute(&cus, hipDeviceAttributeMultiprocessorCount, dev);
#if MEGA
        hipFuncSetAttribute((const void*)mega_kernel, hipFuncAttributeMaxDynamicSharedMemorySize, LDS_BYTES);
        hipOccupancyMaxActiveBlocksPerMultiprocessor(&per_cu, (const void*)mega_kernel, 256, LDS_BYTES);
#else
        hipFuncSetAttribute((const void*)phase_kernel, hipFuncAttributeMaxDynamicSharedMemorySize, LDS_BYTES);
        hipOccupancyMaxActiveBlocksPerMultiprocessor(&per_cu, (const void*)phase_kernel, 256, LDS_BYTES);
#endif
        if (per_cu < 1) per_cu = 1;
        grid = cus * per_cu;
        fprintf(stderr, "kernel_launch: grid %d (%d CUs x %d)\n", grid, cus, per_cu);
    }
    if (grid < 0) return;
    hipMemsetAsync((char*)d_ws + O_CTL, 0, 4096, stream);
    Params p{};
    for (int i = 0; i < 28; ++i) p.in[i] = (const float*)d_in[i];
    p.out = (float*)d_out; p.ws = (unsigned char*)d_ws;
#if MEGA
    void* args[] = {&p};
    hipError_t e = hipLaunchCooperativeKernel((const void*)mega_kernel, dim3(grid), dim3(256), args, LDS_BYTES, stream);
    if (e != hipSuccess) fprintf(stderr, "cooperative launch failed: %s (grid %d)\n", hipGetErrorString(e), grid);
#else
    for (int ph = 0; ph < NPHASE; ++ph) hipLaunchKernelGGL(phase_kernel, dim3(grid), dim3(256), LDS_BYTES, stream, p, ph);
#endif
}
```

```cpp
#include <hip/hip_runtime.h>
#include <hip/hip_cooperative_groups.h>
#include <cstdio>
#include <cstdint>
namespace cg = cooperative_groups;

#ifndef MEGA
#define MEGA 1
#endif

typedef unsigned short bf16_t;
typedef short bf16x8 __attribute__((ext_vector_type(8)));
typedef float f32x4 __attribute__((ext_vector_type(4)));
typedef unsigned u32x4 __attribute__((ext_vector_type(4)));
typedef unsigned u32x2 __attribute__((ext_vector_type(2)));
#define DEV __device__ __forceinline__

constexpr int D = 1024, NB = 8, SEQ = 4096, CTXL = 256, SB = 4352, MR = NB * SB, PW = 4096, DFF = 2816;
constexpr int C_DNQ = 0, C_DNK = 512, C_DNV = 1024, C_DNZ = 1536, C_LX = 2048, C_LG = 2560, C_DAQ = 3072, C_DAK = 3584;
constexpr int NIN = 4736;
constexpr int GLD = 80;

enum { I_X = 0, I_C, I_CTX, I_CCTX, I_WMOD, I_BMOD, I_NMIX, I_NFFN, I_WIN, I_DNCONV, I_DNALOG, I_DNDT, I_DNNORM, I_LCW, I_LCB,
       I_LWA, I_LBA, I_LWI, I_LBI, I_LLAM, I_DALAM, I_DANORM, I_WBR, I_WOUT, I_WFG, I_WFU, I_WFD, I_NFIN };

constexpr size_t al256(size_t x) { return (x + 255) & ~(size_t)255; }
constexpr size_t O_CTL = 0;
constexpr size_t O_BAR = 4096;
constexpr size_t O_MOD = 4096 + 16384;
constexpr size_t O_ROPE = al256(O_MOD + (size_t)2 * 9 * 6144 * 4);
constexpr size_t O_WT = al256(O_ROPE + 64 * 16 * 2 * 4);
constexpr size_t W_IN = 0, W_GATE = W_IN + (size_t)NIN * 1024, W_BR = W_GATE + (size_t)3072 * 1024, W_OUT = W_BR + (size_t)3 * 1024 * 512,
                 W_GU = W_OUT + (size_t)1024 * 1024, W_DN = W_GU + (size_t)5632 * 1024, W_END = W_DN + (size_t)1024 * 2816;
constexpr size_t O_HCTX = al256(O_WT + W_END * 2);
constexpr size_t O_U = al256(O_HCTX + (size_t)2048 * 1024 * 4);
constexpr size_t O_P = al256(O_U + (size_t)MR * 1024 * 2);
constexpr size_t O_AB = al256(O_P + (size_t)MR * PW * 2);
constexpr size_t O_TA = al256(O_AB + (size_t)MR * 16 * 4);
constexpr size_t O_TA2 = al256(O_TA + (size_t)MR * 512 * 2);
constexpr size_t O_VT = al256(O_TA2 + (size_t)MR * 512 * 2);
constexpr size_t WS_END = al256(O_VT + (size_t)MR * 512 * 2);

constexpr int LDS_BYTES = 140 * 1024;

struct Params {
    const float* in[28];
    float* out;
    unsigned char* ws;
};

DEV int get_tid() { int t = threadIdx.x; asm volatile("" : "+v"(t)); return t; }
DEV float bf2f(bf16_t h) { return __uint_as_float(((unsigned)h) << 16); }
DEV bf16_t f2bf(float f) { unsigned u = __float_as_uint(f); u += 0x7fffu + ((u >> 16) & 1u); return (bf16_t)(u >> 16); }
typedef float f32x2_ __attribute__((ext_vector_type(2)));
typedef __bf16 bf16x2_ __attribute__((ext_vector_type(2)));
DEV unsigned pack2(float a, float b) { const f32x2_ v = {a, b}; return __builtin_bit_cast(unsigned, __builtin_convertvector(v, bf16x2_)); }
DEV float sigm(float x) { return __builtin_amdgcn_rcpf(1.f + __expf(-x)); }
DEV float silu(float x) { return x * __builtin_amdgcn_rcpf(1.f + __expf(-x)); }
DEV float softplus(float x) { return x > 20.f ? x : log1pf(expf(x)); }
DEV float softplus_fast(float x) { const float e = __expf(x); return x > 15.f ? x : (e < 0.01f ? e * (1.f - e * (0.5f - e * 0.33333333f)) : __logf(1.f + e)); }
DEV float gelu_tanh(float x) { float u = 0.7978845608028654f * (x + 0.044715f * x * x * x); float t = 1.f - 2.f * __builtin_amdgcn_rcpf(1.f + __expf(2.f * u)); return 0.5f * x * (1.f + t); }
DEV f32x4 mfma16(bf16x8 a, bf16x8 b, f32x4 c) { return __builtin_amdgcn_mfma_f32_16x16x32_bf16(a, b, c, 0, 0, 0); }
DEV void mfma16a(f32x4& c, bf16x8 a, bf16x8 b) { asm volatile("v_mfma_f32_16x16x32_bf16 %0, %1, %2, %0" : "+a"(c) : "v"(a), "v"(b)); }
DEV float lo16(unsigned v) { return __uint_as_float(v << 16); }
DEV float hi16(unsigned v) { return __uint_as_float(v & 0xffff0000u); }

DEV bf16_t* wsb(const Params& p, size_t off) { return (bf16_t*)(p.ws + off); }
DEV float* wsf(const Params& p, size_t off) { return (float*)(p.ws + off); }
DEV float* hrow(const Params& p, int r) { int b = r / SB, s = r - b * SB; return s < CTXL ? wsf(p, O_HCTX) + (size_t)(b * CTXL + s) * D : p.out + (size_t)(b * SEQ + s - CTXL) * D; }
DEV const float* xrow(const Params& p, int r) { int b = r / SB, s = r - b * SB; return s < CTXL ? p.in[I_CTX] + (size_t)(b * CTXL + s) * D : p.in[I_X] + (size_t)(b * SEQ + s - CTXL) * D; }
DEV int modrow(int r) { int b = r / SB, s = r - b * SB; return s < CTXL ? 8 : b; }

template <int MT, int NT>
DEV void gemm_core(const bf16_t* __restrict__ A, int lda, const bf16_t* __restrict__ Bt, int ldb, int K, f32x4 (&acc)[MT][NT], bf16_t* smem_) {
    constexpr int SA = 32 * MT * GLD, SBB = 32 * NT * GLD;
    bf16_t* sA = smem_; bf16_t* sB = smem_ + 2 * SA;
    const int tid = get_tid(), lane = tid & 63, wv = tid >> 6, wr = wv >> 1, wc = wv & 1, l15 = lane & 15, quad = lane >> 4;
    const int lr = tid >> 3, lc = (tid & 7) * 8;
    u32x4 ra0[MT], rb0[NT], ra1[MT], rb1[NT];
    const bf16_t* Ap = A + (size_t)lr * lda + lc;
    const bf16_t* Bp = Bt + (size_t)lr * ldb + lc;
    const int nk = K >> 6;
#define GLOAD(RA, RB, KT) { const int ko_ = (KT) * 64; _Pragma("unroll") for (int i = 0; i < MT; ++i) RA[i] = *(const u32x4*)(Ap + (size_t)(32 * i) * lda + ko_); \
                            _Pragma("unroll") for (int i = 0; i < NT; ++i) RB[i] = *(const u32x4*)(Bp + (size_t)(32 * i) * ldb + ko_); }
#define LSTORE(RA, RB, BUF) { _Pragma("unroll") for (int i = 0; i < MT; ++i) *(u32x4*)(sA + (BUF) * SA + (lr + 32 * i) * GLD + lc) = RA[i]; \
                              _Pragma("unroll") for (int i = 0; i < NT; ++i) *(u32x4*)(sB + (BUF) * SBB + (lr + 32 * i) * GLD + lc) = RB[i]; }
#define COMPUTE(BUF) { _Pragma("unroll") for (int ks = 0; ks < 2; ++ks) { bf16x8 af[MT], bfr[NT]; \
        _Pragma("unroll") for (int mt = 0; mt < MT; ++mt) af[mt] = *(const bf16x8*)(sA + (BUF) * SA + (wr * MT * 16 + mt * 16 + l15) * GLD + ks * 32 + quad * 8); \
        _Pragma("unroll") for (int nt = 0; nt < NT; ++nt) bfr[nt] = *(const bf16x8*)(sB + (BUF) * SBB + (wc * NT * 16 + nt * 16 + l15) * GLD + ks * 32 + quad * 8); \
        _Pragma("unroll") for (int mt = 0; mt < MT; ++mt) _Pragma("unroll") for (int nt = 0; nt < NT; ++nt) mfma16a(acc[mt][nt], bfr[nt], af[mt]); } }
    GLOAD(ra0, rb0, 0);
    GLOAD(ra1, rb1, 1);
    __syncthreads();
    LSTORE(ra0, rb0, 0);
    GLOAD(ra0, rb0, 2);
    __syncthreads();
    int kt = 0;
#pragma unroll 1
    for (; kt + 4 < nk; kt += 2) {
        COMPUTE(0);
        LSTORE(ra1, rb1, 1);
        GLOAD(ra1, rb1, kt + 3);
        __syncthreads();
        COMPUTE(1);
        LSTORE(ra0, rb0, 0);
        GLOAD(ra0, rb0, kt + 4);
        __syncthreads();
    }
    COMPUTE(0);
    LSTORE(ra1, rb1, 1);
    GLOAD(ra1, rb1, kt + 3);
    __syncthreads();
    COMPUTE(1);
    LSTORE(ra0, rb0, 0);
    __syncthreads();
    COMPUTE(0);
    LSTORE(ra1, rb1, 1);
    __syncthreads();
    COMPUTE(1);
    __syncthreads();
#undef GLOAD
#undef LSTORE
#undef COMPUTE
    static_assert(NT == 4, "the accumulator fence is written for NT == 4");
#pragma unroll
    for (int mt = 0; mt < MT; ++mt) {
        if (mt == 0) asm volatile("s_nop 15\n\ts_nop 15" : "+a"(acc[mt][0]), "+a"(acc[mt][1]), "+a"(acc[mt][2]), "+a"(acc[mt][3]));
        else asm volatile("s_nop 0" : "+a"(acc[mt][0]), "+a"(acc[mt][1]), "+a"(acc[mt][2]), "+a"(acc[mt][3]));
    }
}
template <int MT, int NT>
DEV void gemm_core1(const bf16_t* __restrict__ A, int lda, const bf16_t* __restrict__ Bt, int ldb, int K, f32x4 (&acc)[MT][NT], bf16_t* sA, bf16_t* sB) {
    const int tid = get_tid(), lane = tid & 63, wv = tid >> 6, wr = wv >> 1, wc = wv & 1, l15 = lane & 15, quad = lane >> 4;
    const int lr = tid >> 3, lc = (tid & 7) * 8;
    u32x4 ra[MT], rb[NT];
    const bf16_t* Ap = A + (size_t)lr * lda + lc;
    const bf16_t* Bp = Bt + (size_t)lr * ldb + lc;
#pragma unroll
    for (int i = 0; i < MT; ++i) ra[i] = *(const u32x4*)(Ap + (size_t)(32 * i) * lda);
#pragma unroll
    for (int i = 0; i < NT; ++i) rb[i] = *(const u32x4*)(Bp + (size_t)(32 * i) * ldb);
    const int nk = K >> 6;
    for (int kt = 0; kt < nk; ++kt) {
        __syncthreads();
#pragma unroll
        for (int i = 0; i < MT; ++i) *(u32x4*)(sA + (lr + 32 * i) * GLD + lc) = ra[i];
#pragma unroll
        for (int i = 0; i < NT; ++i) *(u32x4*)(sB + (lr + 32 * i) * GLD + lc) = rb[i];
        __syncthreads();
        if (kt + 1 < nk) {
            const int ko = (kt + 1) * 64;
#pragma unroll
            for (int i = 0; i < MT; ++i) ra[i] = *(const u32x4*)(Ap + (size_t)(32 * i) * lda + ko);
#pragma unroll
            for (int i = 0; i < NT; ++i) rb[i] = *(const u32x4*)(Bp + (size_t)(32 * i) * ldb + ko);
        }
#pragma unroll
        for (int ks = 0; ks < 2; ++ks) {
            bf16x8 af[MT], bfr[NT];
#pragma unroll
            for (int mt = 0; mt < MT; ++mt) af[mt] = *(const bf16x8*)(sA + (wr * MT * 16 + mt * 16 + l15) * GLD + ks * 32 + quad * 8);
#pragma unroll
            for (int nt = 0; nt < NT; ++nt) bfr[nt] = *(const bf16x8*)(sB + (wc * NT * 16 + nt * 16 + l15) * GLD + ks * 32 + quad * 8);
#pragma unroll
            for (int mt = 0; mt < MT; ++mt)
#pragma unroll
                for (int nt = 0; nt < NT; ++nt) mfma16a(acc[mt][nt], bfr[nt], af[mt]);
        }
    }
    static_assert(NT == 4, "the accumulator fence is written for NT == 4");
#pragma unroll
    for (int mt = 0; mt < MT; ++mt) {
        if (mt == 0) asm volatile("s_nop 15\n\ts_nop 15" : "+a"(acc[mt][0]), "+a"(acc[mt][1]), "+a"(acc[mt][2]), "+a"(acc[mt][3]));
        else asm volatile("s_nop 0" : "+a"(acc[mt][0]), "+a"(acc[mt][1]), "+a"(acc[mt][2]), "+a"(acc[mt][3]));
    }
}
template <int MT, int NT>
DEV void zero_acc(f32x4 (&acc)[MT][NT]) {
#pragma unroll
    for (int mt = 0; mt < MT; ++mt)
#pragma unroll
        for (int nt = 0; nt < NT; ++nt) acc[mt][nt] = (f32x4){0.f, 0.f, 0.f, 0.f};
}

DEV void phase_mod(const Params& p, unsigned char* smem) {
    float* s_s = (float*)smem;
    float* red = s_s + 9 * 1024;
    const int tid = get_tid();
    bool loaded = false;
    for (int it = blockIdx.x; it < 2 * 96; it += gridDim.x) {
        if (!loaded) {
            for (int e = tid; e < 9 * 1024; e += 256) { float v = e < 8192 ? p.in[I_C][e] : p.in[I_CCTX][e - 8192]; s_s[e] = silu(v); }
            loaded = true;
        }
        __syncthreads();
        const int l = it / 96, cg_ = it % 96, cq = tid & 63, kq = tid >> 6, col = cg_ * 64 + cq;
        float acc[9];
#pragma unroll
        for (int r = 0; r < 9; ++r) acc[r] = 0.f;
        const float* wp = p.in[I_WMOD] + ((size_t)l * 1024 + kq * 256) * 6144 + col;
#pragma unroll 8
        for (int k = 0; k < 256; ++k) {
            float wv = wp[(size_t)k * 6144];
#pragma unroll
            for (int r = 0; r < 9; ++r) acc[r] += s_s[r * 1024 + kq * 256 + k] * wv;
        }
#pragma unroll
        for (int r = 0; r < 9; ++r) red[(kq * 9 + r) * 64 + cq] = acc[r];
        __syncthreads();
        for (int e = tid; e < 9 * 64; e += 256) {
            int r = e >> 6, c2 = e & 63;
            float v = red[(0 * 9 + r) * 64 + c2] + red[(1 * 9 + r) * 64 + c2] + red[(2 * 9 + r) * 64 + c2] + red[(3 * 9 + r) * 64 + c2];
            wsf(p, O_MOD)[((size_t)l * 9 + r) * 6144 + cg_ * 64 + c2] = v + p.in[I_BMOD][l * 6144 + cg_ * 64 + c2];
        }
        __syncthreads();
    }
}
DEV void phase_rope(const Params& p) {
    if (blockIdx.x == (gridDim.x - 1)) {
        for (int e = threadIdx.x; e < 1024; e += 256) {
            int pos = e >> 4, i = e & 15;
            float inv = powf(10000.f, -(float)i / 16.f);
            float ang = (float)pos * inv;
            float n = rintf(ang * 0.15915494309189535f);
            float r = fmaf(-n, 6.28125f, ang);
            r = fmaf(-n, 1.9353071795864769e-3f, r);
            wsf(p, O_ROPE)[e * 2] = cosf(r);
            wsf(p, O_ROPE)[e * 2 + 1] = sinf(r);
        }
    }
}
DEV void wconv_tile(const float* src0, const float* src1, int lds_, int K, bf16_t* dst, int kind, int kt, int nt, bf16_t* tile) {
    const int tid = get_tid();
    const int kk = tid >> 2, grp = tid & 3;
    const int n0 = nt * 64, k0 = kt * 64;
    const int ng = n0 + grp * 16;
    const float* src = src0; int sc;
    if (kind == 0) { sc = ng < 2048 ? ng : (ng < 4608 ? ng + 16 : (ng < 4624 ? 2048 : -1)); }
    else if (kind == 1) { sc = 4624 + ng; }
    else if (kind == 2) { sc = ng; }
    else { int gd = ng >> 4; src = (gd & 1) ? src1 : src0; sc = (gd >> 1) * 16; }
    __syncthreads();
    if (sc >= 0) {
        const float4* sp = (const float4*)(src + (size_t)(k0 + kk) * lds_ + sc);
#pragma unroll
        for (int q = 0; q < 4; ++q) { float4 v = sp[q]; int e = grp * 16 + q * 4;
            tile[(e + 0) * GLD + kk] = f2bf(v.x); tile[(e + 1) * GLD + kk] = f2bf(v.y); tile[(e + 2) * GLD + kk] = f2bf(v.z); tile[(e + 3) * GLD + kk] = f2bf(v.w); }
    } else {
#pragma unroll
        for (int e = 0; e < 16; ++e) tile[(grp * 16 + e) * GLD + kk] = 0;
    }
    __syncthreads();
    const int n = tid >> 2, kseg = (tid & 3) * 16;
    u32x4 a = *(const u32x4*)(tile + n * GLD + kseg), b = *(const u32x4*)(tile + n * GLD + kseg + 8);
    bf16_t* dp = dst + (size_t)(n0 + n) * K + k0 + kseg;
    *(u32x4*)dp = a; *(u32x4*)(dp + 8) = b;
}
DEV void phase_wconv(const Params& p, int l, unsigned char* smem) {
    bf16_t* tile = (bf16_t*)smem;
    bf16_t* W = wsb(p, O_WT);
    constexpr int T0 = 74 * 16, T1 = T0 + 48 * 16, T2 = T1 + 3 * 16 * 8, T3 = T2 + 16 * 16, T4 = T3 + 88 * 16, T5 = T4 + 16 * 44;
    for (int t = blockIdx.x; t < T5; t += gridDim.x) {
        if (t < T0) { wconv_tile(p.in[I_WIN] + (size_t)l * 1024 * 7696, nullptr, 7696, 1024, W + W_IN, 0, t % 16, t / 16, tile); }
        else if (t < T1) { int u = t - T0; wconv_tile(p.in[I_WIN] + (size_t)l * 1024 * 7696, nullptr, 7696, 1024, W + W_GATE, 1, u % 16, u / 16, tile); }
        else if (t < T2) { int u = t - T1; int n = u / 128, v = u % 128; wconv_tile(p.in[I_WBR] + ((size_t)l * 3 + n) * 512 * 1024, nullptr, 1024, 512, W + W_BR + (size_t)n * 1024 * 512, 2, v % 8, v / 8, tile); }
        else if (t < T3) { int u = t - T2; wconv_tile(p.in[I_WOUT] + (size_t)l * 1024 * 1024, nullptr, 1024, 1024, W + W_OUT, 2, u % 16, u / 16, tile); }
        else if (t < T4) { int u = t - T3; wconv_tile(p.in[I_WFG] + (size_t)l * 1024 * DFF, p.in[I_WFU] + (size_t)l * 1024 * DFF, DFF, 1024, W + W_GU, 3, u % 16, u / 16, tile); }
        else { int u = t - T4; wconv_tile(p.in[I_WFD] + (size_t)l * DFF * 1024, nullptr, 1024, DFF, W + W_DN, 2, u % 44, u / 44, tile); }
    }
}

DEV void norm_row(const Params& p, int l, int which, bool first, int r, int lane) {
    const float* h = first ? xrow(p, r) : hrow(p, r);
    const float* nw = p.in[which ? I_NFFN : I_NMIX] + l * D;
    const float* md = wsf(p, O_MOD) + ((size_t)l * 9 + modrow(r)) * 6144 + (which ? 3 * D : 0);
    float4 v[4]; float ss = 0.f;
#pragma unroll
    for (int i = 0; i < 4; ++i) { v[i] = *(const float4*)(h + i * 256 + lane * 4); ss += v[i].x * v[i].x + v[i].y * v[i].y + v[i].z * v[i].z + v[i].w * v[i].w; }
#pragma unroll
    for (int o = 32; o >= 1; o >>= 1) ss += __shfl_xor(ss, o);
    const float rstd = rsqrtf(ss * (1.f / D) + 1e-6f);
    bf16_t* up = wsb(p, O_U) + (size_t)r * D;
#pragma unroll
    for (int i = 0; i < 4; ++i) {
        const int c = i * 256 + lane * 4;
        float4 w4 = *(const float4*)(nw + c), sh = *(const float4*)(md + c), sc = *(const float4*)(md + D + c);
        float a = v[i].x * rstd * w4.x * (1.f + sc.x) + sh.x, b = v[i].y * rstd * w4.y * (1.f + sc.y) + sh.y;
        float c2 = v[i].z * rstd * w4.z * (1.f + sc.z) + sh.z, d = v[i].w * rstd * w4.w * (1.f + sc.w) + sh.w;
        u32x2 o; o.x = pack2(a, b); o.y = pack2(c2, d);
        *(u32x2*)(up + c) = o;
    }
}
DEV void phase_norm(const Params& p, int l, int which, bool first, bool skip_ctx) {
    const int tid_ = get_tid(); const int lane = tid_ & 63, wv = tid_ >> 6;
    for (int r = blockIdx.x * 4 + wv; r < MR; r += gridDim.x * 4) {
        if (skip_ctx && (r % SB) < CTXL) continue;
        norm_row(p, l, which, first, r, lane);
    }
}
DEV void phase_fin_norm(const Params& p, int l, bool first, bool skip_ctx) {
    const int tid_ = get_tid(); const int lane = tid_ & 63, wv = tid_ >> 6;
    const float* dnn = p.in[I_DNNORM] + l * 128;
    for (int r = blockIdx.x * 4 + wv; r < MR; r += gridDim.x * 4) {
        if (skip_ctx && (r % SB) < CTXL) continue;
        norm_row(p, l, 0, first, r, lane);
        bf16_t* ta = wsb(p, O_TA) + (size_t)r * 512 + lane * 8;
        const bf16_t* tb = wsb(p, O_TA2) + (size_t)r * 512 + lane * 8;
        const bf16_t* zz = wsb(p, O_P) + (size_t)r * PW + C_DNZ + lane * 8;
        u32x4 a = *(const u32x4*)ta, b = *(const u32x4*)tb, z = *(const u32x4*)zz;
        float o[8]; float ss = 0.f;
#pragma unroll
        for (int i = 0; i < 4; ++i) { o[2 * i] = lo16(a[i]) + lo16(b[i]); o[2 * i + 1] = hi16(a[i]) + hi16(b[i]); ss += o[2 * i] * o[2 * i] + o[2 * i + 1] * o[2 * i + 1]; }
#pragma unroll
        for (int of = 8; of >= 1; of >>= 1) ss += __shfl_xor(ss, of);
        const float rstd = rsqrtf(ss * (1.f / 128.f) + 1e-6f);
        const int dv0 = (lane & 15) * 8;
        u32x4 y;
#pragma unroll
        for (int i = 0; i < 4; ++i) {
            float y0 = o[2 * i] * rstd * dnn[dv0 + 2 * i] * silu(lo16(z[i]));
            float y1 = o[2 * i + 1] * rstd * dnn[dv0 + 2 * i + 1] * silu(hi16(z[i]));
            y[i] = pack2(y0, y1);
        }
        *(u32x4*)ta = y;
    }
}
DEV void phase_final(const Params& p) {
    const int tid_ = get_tid(); const int lane = tid_ & 63, wv = tid_ >> 6;
    const float* nw = p.in[I_NFIN];
    for (int r = blockIdx.x * 4 + wv; r < NB * SEQ; r += gridDim.x * 4) {
        float* h = p.out + (size_t)r * D;
        float4 v[4]; float ss = 0.f;
#pragma unroll
        for (int i = 0; i < 4; ++i) { v[i] = *(const float4*)(h + i * 256 + lane * 4); ss += v[i].x * v[i].x + v[i].y * v[i].y + v[i].z * v[i].z + v[i].w * v[i].w; }
#pragma unroll
        for (int o = 32; o >= 1; o >>= 1) ss += __shfl_xor(ss, o);
        const float rstd = rsqrtf(ss * (1.f / D) + 1e-6f);
#pragma unroll
        for (int i = 0; i < 4; ++i) {
            const int c = i * 256 + lane * 4;
            float4 w4 = *(const float4*)(nw + c);
            float4 o4; o4.x = v[i].x * rstd * w4.x; o4.y = v[i].y * rstd * w4.y; o4.z = v[i].z * rstd * w4.z; o4.w = v[i].w * rstd * w4.w;
            *(float4*)(h + c) = o4;
        }
    }
}

struct TileIter {
    int nn, total, nloc, L;
    DEV TileIter(int nm, int nn_) { nn = nn_; total = nm * nn_; nloc = gridDim.x >> 3; L = (blockIdx.x & 7) * nloc + (blockIdx.x >> 3); }
    DEV bool valid() const { return L < total; }
    DEV bool more() const { return (L - (int)(blockIdx.x >> 3)) < total; }
    DEV void next() { L += 8 * nloc; }
    DEV void get(int& tm, int& tn) const { const int pn = 4 * nn, panel = L / pn, rem = L - panel * pn; tn = rem >> 2; tm = panel * 4 + (rem & 3); }
};
DEV void phase_g1(const Params& p, unsigned char* smem) {
    bf16_t* sA = (bf16_t*)smem;
    const int tid = get_tid(), lane = tid & 63, wv = tid >> 6, wr = wv >> 1, wc = wv & 1, l15 = lane & 15, quad = lane >> 4;
    const bf16_t* U = wsb(p, O_U); const bf16_t* W = wsb(p, O_WT) + W_IN;
    bf16_t* P = wsb(p, O_P);
    const float* rope = wsf(p, O_ROPE);
    constexpr int NTN = NIN / 128;
    const int wr0_ = wr, wc0_ = wc, l150_ = l15, quad0_ = quad;
    for (TileIter ti(MR / 256, NTN); ti.valid(); ti.next()) {
        int tm, tn; ti.get(tm, tn);
        const int row0 = tm * 256, col0 = tn * 128;
        f32x4 acc[8][4]; zero_acc(acc);
        gemm_core<8, 4>(U + (size_t)row0 * D, D, W + (size_t)col0 * D, D, D, acc, sA);
        int tz = 0; asm volatile("" : "+v"(tz));
        const int wr = wr0_ + tz, wc = wc0_ + tz, l15 = l150_ + tz, quad = quad0_ + tz;
        if (tn < 24) {
#pragma unroll
            for (int mt = 0; mt < 8; ++mt) {
                __builtin_amdgcn_sched_barrier(0);
                bf16_t* pp = P + (size_t)(row0 + wr * 128 + mt * 16 + l15) * PW + col0 + wc * 64 + quad * 4;
#pragma unroll
                for (int nt = 0; nt < 4; ++nt) { u32x2 o; o.x = pack2(acc[mt][nt][0], acc[mt][nt][1]); o.y = pack2(acc[mt][nt][2], acc[mt][nt][3]); *(u32x2*)(pp + nt * 16) = o; }
            }
        } else if (tn < 32) {
            const float qs = tn < 28 ? 0.125f : 1.f;
#pragma unroll
            for (int mt = 0; mt < 8; ++mt) {
                __builtin_amdgcn_sched_barrier(0);
                const int row = row0 + wr * 128 + mt * 16 + l15;
                const int s_ = row % SB;
                f32x4 ca = {1.f, 1.f, 1.f, 1.f}, sa = {0.f, 0.f, 0.f, 0.f}, cb = {1.f, 1.f, 1.f, 1.f}, sb = {0.f, 0.f, 0.f, 0.f};
                if (s_ >= CTXL) { const int tt = s_ - CTXL, pr = tt >> 6, pc = tt & 63;
                    const f32x4 r0 = *(const f32x4*)(rope + (pr * 16 + quad * 4) * 2), r1 = *(const f32x4*)(rope + (pr * 16 + quad * 4) * 2 + 4);
                    const f32x4 r2 = *(const f32x4*)(rope + (pc * 16 + quad * 4) * 2), r3 = *(const f32x4*)(rope + (pc * 16 + quad * 4) * 2 + 4);
                    ca = (f32x4){r0[0], r0[2], r1[0], r1[2]}; sa = (f32x4){r0[1], r0[3], r1[1], r1[3]};
                    cb = (f32x4){r2[0], r2[2], r3[0], r3[2]}; sb = (f32x4){r2[1], r2[3], r3[1], r3[3]}; }
                const f32x4 x1 = acc[mt][0], x2 = acc[mt][1], y1 = acc[mt][2], y2 = acc[mt][3];
                const f32x4 o0 = (x1 * ca - x2 * sa) * qs, o1 = (x2 * ca + x1 * sa) * qs, o2 = (y1 * cb - y2 * sb) * qs, o3 = (y2 * cb + y1 * sb) * qs;
                bf16_t* pp = P + (size_t)row * PW + col0 + wc * 64 + quad * 4;
                u32x2 o; o.x = pack2(o0[0], o0[1]); o.y = pack2(o0[2], o0[3]); *(u32x2*)(pp) = o;
                o.x = pack2(o1[0], o1[1]); o.y = pack2(o1[2], o1[3]); *(u32x2*)(pp + 16) = o;
                o.x = pack2(o2[0], o2[1]); o.y = pack2(o2[2], o2[3]); *(u32x2*)(pp + 32) = o;
                o.x = pack2(o3[0], o3[1]); o.y = pack2(o3[2], o3[3]); *(u32x2*)(pp + 48) = o;
            }
        } else if (tn < 36) {
            bf16_t* VT = wsb(p, O_VT);
            const int b = row0 / SB, sbase = row0 - b * SB;
#pragma unroll
            for (int mt = 0; mt < 8; ++mt) {
                __builtin_amdgcn_sched_barrier(0);
                const int s_ = sbase + wr * 128 + mt * 16 + l15;
                const int vi0 = (b * 512 + col0 - 4096 + wc * 64 + quad * 4) * SB + s_;
#pragma unroll
                for (int nt = 0; nt < 4; ++nt) {
                    const unsigned p01 = pack2(acc[mt][nt][0], acc[mt][nt][1]), p23 = pack2(acc[mt][nt][2], acc[mt][nt][3]);
                    VT[vi0 + (nt * 16 + 0) * SB] = (bf16_t)(p01 & 0xffffu); VT[vi0 + (nt * 16 + 1) * SB] = (bf16_t)(p01 >> 16);
                    VT[vi0 + (nt * 16 + 2) * SB] = (bf16_t)(p23 & 0xffffu); VT[vi0 + (nt * 16 + 3) * SB] = (bf16_t)(p23 >> 16);
                }
            }
        } else {
            if (wc == 0) {
                float* AB = wsf(p, O_AB);
#pragma unroll
                for (int mt = 0; mt < 8; ++mt) {
                    const int row = row0 + wr * 128 + mt * 16 + l15;
                    *(f32x4*)(AB + (size_t)row * 16 + quad * 4) = acc[mt][0];
                }
            }
        }
    }
}

DEV int rowtile0(int ti, bool latent_only) { if (!latent_only) return ti * 256; int b = ti >> 4, tt = ti & 15; return b * SB + CTXL + tt * 256; }
DEV int sgcol(int n, int c) { return n < 2 ? n * 1024 + c : (c < 512 ? 2048 + c : 3584 + (c - 512)); }

DEV void phase_gate(const Params& p, bool latent_only, unsigned char* smem) {
    bf16_t* sA = (bf16_t*)smem;
    const int tid = get_tid(), lane = tid & 63, wv = tid >> 6, wr = wv >> 1, wc = wv & 1, l15 = lane & 15, quad = lane >> 4;
    const bf16_t* U = wsb(p, O_U); const bf16_t* W = wsb(p, O_WT) + W_GATE;
    bf16_t* P = wsb(p, O_P);
    const int nrt = latent_only ? 128 : 136;
    for (TileIter ti(nrt, 24); ti.valid(); ti.next()) {
        int tm, tn; ti.get(tm, tn);
        const int row0 = rowtile0(tm, latent_only);
        f32x4 acc[8][4]; zero_acc(acc);
        gemm_core<8, 4>(U + (size_t)row0 * D, D, W + (size_t)tn * 128 * D, D, D, acc, sA);
        const int dcol0 = sgcol(tn >> 3, (tn & 7) * 128);
        bf16_t* ip = P + (size_t)(row0 + tid) * PW + dcol0;
#pragma unroll
        for (int mt = 0; mt < 8; ++mt) {
            __builtin_amdgcn_sched_barrier(0);
#pragma unroll
            for (int hf = 0; hf < 2; ++hf) {
                u32x4 o;
                o[0] = pack2(sigm(acc[mt][2 * hf][0]), sigm(acc[mt][2 * hf][1])); o[1] = pack2(sigm(acc[mt][2 * hf][2]), sigm(acc[mt][2 * hf][3]));
                o[2] = pack2(sigm(acc[mt][2 * hf + 1][0]), sigm(acc[mt][2 * hf + 1][1])); o[3] = pack2(sigm(acc[mt][2 * hf + 1][2]), sigm(acc[mt][2 * hf + 1][3]));
                *(u32x4*)(ip + (mt * 2 + hf) * 8) = o;
            }
        }
    }
}

DEV void phase_merge(const Params& p, bool latent_only, unsigned char* smem) {
    bf16_t* sA = (bf16_t*)smem;
    const int tid = get_tid(), lane = tid & 63, wv = tid >> 6, wr = wv >> 1, wc = wv & 1, l15 = lane & 15, quad = lane >> 4;
    const bf16_t* W = wsb(p, O_WT);
    const bf16_t* P = wsb(p, O_P);
    bf16_t* U = wsb(p, O_U);
    const int nrt = latent_only ? 128 : 136;
    for (TileIter ti(nrt, 8); ti.valid(); ti.next()) {
        int tm, tn; ti.get(tm, tn);
        const int row0 = rowtile0(tm, latent_only), col0 = tn * 128;
        f32x4 m[8][4]; zero_acc(m);
#pragma unroll 1
        for (int n = 0; n < 3; ++n) {
            f32x4 au[8][4]; zero_acc(au);
            const bf16_t* Y; int ldy;
            if (n == 0) { Y = wsb(p, O_TA) + (size_t)row0 * 512; ldy = 512; }
            else if (n == 1) { Y = P + (size_t)row0 * PW + C_LG; ldy = PW; }
            else { Y = P + (size_t)row0 * PW + C_DAQ; ldy = PW; }
            const int sc0 = sgcol(n, col0);
            u32x4 sg[16];
            const bf16_t* ip = P + (size_t)(row0 + tid) * PW + sc0;
#pragma unroll
            for (int q = 0; q < 16; ++q) sg[q] = *(const u32x4*)(ip + q * 8);
            gemm_core1<8, 4>(Y, ldy, W + W_BR + ((size_t)n * 1024 + col0) * 512, 512, 512, au, sA, sA + 256 * GLD);
#pragma unroll
            for (int mt = 0; mt < 8; ++mt)
#pragma unroll
                for (int nt = 0; nt < 4; ++nt) {
                    const unsigned g01 = sg[mt * 2 + (nt >> 1)][(nt & 1) * 2], g23 = sg[mt * 2 + (nt >> 1)][(nt & 1) * 2 + 1];
                    m[mt][nt][0] += lo16(g01) * au[mt][nt][0]; m[mt][nt][1] += hi16(g01) * au[mt][nt][1];
                    m[mt][nt][2] += lo16(g23) * au[mt][nt][2]; m[mt][nt][3] += hi16(g23) * au[mt][nt][3];
                }
        }
#pragma unroll
        for (int mt = 0; mt < 8; ++mt) {
            __builtin_amdgcn_sched_barrier(0);
            bf16_t* up = U + (size_t)(row0 + wr * 128 + mt * 16 + l15) * D + col0 + wc * 64 + quad * 4;
#pragma unroll
            for (int nt = 0; nt < 4; ++nt) { u32x2 o; o.x = pack2(m[mt][nt][0], m[mt][nt][1]); o.y = pack2(m[mt][nt][2], m[mt][nt][3]); *(u32x2*)(up + nt * 16) = o; }
        }
    }
}

DEV void phase_resid(const Params& p, int l, const bf16_t* A, int lda, const bf16_t* Wt, int K, int chunk, bool first, bool latent_only, unsigned char* smem) {
    bf16_t* sA = (bf16_t*)smem;
    const int tid = get_tid(), lane = tid & 63, wv = tid >> 6, wr = wv >> 1, wc = wv & 1, l15 = lane & 15, quad = lane >> 4;
    const int nrt = latent_only ? 128 : 136;
    for (TileIter ti(nrt, 8); ti.valid(); ti.next()) {
        int tm, tn; ti.get(tm, tn);
        const int row0 = rowtile0(tm, latent_only), col0 = tn * 128;
        f32x4 acc[8][4]; zero_acc(acc);
        gemm_core<8, 4>(A + (size_t)row0 * lda, lda, Wt + (size_t)col0 * K, K, K, acc, sA);
        const float* md = wsf(p, O_MOD) + ((size_t)l * 9 + modrow(row0)) * 6144 + chunk * D + col0 + wc * 64 + quad * 4;
        const float* hs0 = first ? xrow(p, row0) : hrow(p, row0);
        float* hd0 = hrow(p, row0);
        f32x4 mg[4];
#pragma unroll
        for (int nt = 0; nt < 4; ++nt) mg[nt] = *(const f32x4*)(md + nt * 16);
#pragma unroll
        for (int mt = 0; mt < 8; ++mt) {
            __builtin_amdgcn_sched_barrier(0);
            const size_t ro = (size_t)(wr * 128 + mt * 16 + l15) * D + col0 + wc * 64 + quad * 4;
#pragma unroll
            for (int nt = 0; nt < 4; ++nt) { const f32x4 h = *(const f32x4*)(hs0 + ro + nt * 16); *(f32x4*)(hd0 + ro + nt * 16) = h + mg[nt] * acc[mt][nt]; }
        }
    }
}
DEV void phase_gu(const Params& p, bool latent_only, unsigned char* smem) {
    bf16_t* sA = (bf16_t*)smem;
    const int tid = get_tid(), lane = tid & 63, wv = tid >> 6, wr = wv >> 1, wc = wv & 1, l15 = lane & 15, quad = lane >> 4;
    const bf16_t* U = wsb(p, O_U); const bf16_t* W = wsb(p, O_WT) + W_GU;
    bf16_t* P = wsb(p, O_P);
    const int nrt = latent_only ? 128 : 136;
    for (TileIter ti(nrt, 44); ti.valid(); ti.next()) {
        int tm, tn; ti.get(tm, tn);
        const int row0 = rowtile0(tm, latent_only);
        f32x4 acc[8][4]; zero_acc(acc);
        gemm_core<8, 4>(U + (size_t)row0 * D, D, W + (size_t)tn * 128 * D, D, D, acc, sA);
#pragma unroll
        for (int mt = 0; mt < 8; ++mt) {
            __builtin_amdgcn_sched_barrier(0);
            bf16_t* pp = P + (size_t)(row0 + wr * 128 + mt * 16 + l15) * PW + (tn * 4 + wc * 2) * 16 + quad * 4;
#pragma unroll
            for (int pr = 0; pr < 2; ++pr) {
                const f32x4 g = acc[mt][2 * pr], u = acc[mt][2 * pr + 1];
                u32x2 o; o.x = pack2(silu(g[0]) * u[0], silu(g[1]) * u[1]); o.y = pack2(silu(g[2]) * u[2], silu(g[3]) * u[3]);
                *(u32x2*)(pp + pr * 16) = o;
            }
        }
    }
}

DEV int chunk_of(int dir, int n) { return dir ? (n < 4 ? 3 - n : 71 - n) : n; }

typedef float f32x2 __attribute__((ext_vector_type(2)));
DEV void dn_solve(const float* __restrict__ Lt_s0, const bf16_t* __restrict__ colp, const float* __restrict__ mulp0, const float sg, bf16_t* __restrict__ outp) {
    int vz = 0; asm volatile("" : "+v"(vz));
    const float* __restrict__ Lt_s = Lt_s0 + vz; const float* __restrict__ mulp = mulp0 + vz;
    f32x2 X0, X1, X2, X3, X4, X5, X6, X7, X8, X9, X10, X11, X12, X13, X14, X15, X16, X17, X18, X19, X20, X21, X22, X23, X24, X25, X26, X27, X28, X29, X30, X31;
    f32x4 La0, La1, La2, La3, La4, La5, La6, La7, La8, La9, La10, La11, La12, La13, La14, La15, Lb0, Lb1, Lb2, Lb3, Lb4, Lb5, Lb6, Lb7, Lb8, Lb9, Lb10, Lb11, Lb12, Lb13, Lb14, Lb15;
    X0 = (f32x2){bf2f(colp[0]) * mulp[0], bf2f(colp[136]) * mulp[1]};
    X1 = (f32x2){bf2f(colp[272]) * mulp[2], bf2f(colp[408]) * mulp[3]};
    X2 = (f32x2){bf2f(colp[544]) * mulp[4], bf2f(colp[680]) * mulp[5]};
    X3 = (f32x2){bf2f(colp[816]) * mulp[6], bf2f(colp[952]) * mulp[7]};
    X4 = (f32x2){bf2f(colp[1088]) * mulp[8], bf2f(colp[1224]) * mulp[9]};
    X5 = (f32x2){bf2f(colp[1360]) * mulp[10], bf2f(colp[1496]) * mulp[11]};
    X6 = (f32x2){bf2f(colp[1632]) * mulp[12], bf2f(colp[1768]) * mulp[13]};
    X7 = (f32x2){bf2f(colp[1904]) * mulp[14], bf2f(colp[2040]) * mulp[15]};
    X8 = (f32x2){bf2f(colp[2176]) * mulp[16], bf2f(colp[2312]) * mulp[17]};
    X9 = (f32x2){bf2f(colp[2448]) * mulp[18], bf2f(colp[2584]) * mulp[19]};
    X10 = (f32x2){bf2f(colp[2720]) * mulp[20], bf2f(colp[2856]) * mulp[21]};
    X11 = (f32x2){bf2f(colp[2992]) * mulp[22], bf2f(colp[3128]) * mulp[23]};
    X12 = (f32x2){bf2f(colp[3264]) * mulp[24], bf2f(colp[3400]) * mulp[25]};
    X13 = (f32x2){bf2f(colp[3536]) * mulp[26], bf2f(colp[3672]) * mulp[27]};
    X14 = (f32x2){bf2f(colp[3808]) * mulp[28], bf2f(colp[3944]) * mulp[29]};
    X15 = (f32x2){bf2f(colp[4080]) * mulp[30], bf2f(colp[4216]) * mulp[31]};
    X16 = (f32x2){bf2f(colp[4352]) * mulp[32], bf2f(colp[4488]) * mulp[33]};
    X17 = (f32x2){bf2f(colp[4624]) * mulp[34], bf2f(colp[4760]) * mulp[35]};
    X18 = (f32x2){bf2f(colp[4896]) * mulp[36], bf2f(colp[5032]) * mulp[37]};
    X19 = (f32x2){bf2f(colp[5168]) * mulp[38], bf2f(colp[5304]) * mulp[39]};
    X20 = (f32x2){bf2f(colp[5440]) * mulp[40], bf2f(colp[5576]) * mulp[41]};
    X21 = (f32x2){bf2f(colp[5712]) * mulp[42], bf2f(colp[5848]) * mulp[43]};
    X22 = (f32x2){bf2f(colp[5984]) * mulp[44], bf2f(colp[6120]) * mulp[45]};
    X23 = (f32x2){bf2f(colp[6256]) * mulp[46], bf2f(colp[6392]) * mulp[47]};
    X24 = (f32x2){bf2f(colp[6528]) * mulp[48], bf2f(colp[6664]) * mulp[49]};
    X25 = (f32x2){bf2f(colp[6800]) * mulp[50], bf2f(colp[6936]) * mulp[51]};
    X26 = (f32x2){bf2f(colp[7072]) * mulp[52], bf2f(colp[7208]) * mulp[53]};
    X27 = (f32x2){bf2f(colp[7344]) * mulp[54], bf2f(colp[7480]) * mulp[55]};
    X28 = (f32x2){bf2f(colp[7616]) * mulp[56], bf2f(colp[7752]) * mulp[57]};
    X29 = (f32x2){bf2f(colp[7888]) * mulp[58], bf2f(colp[8024]) * mulp[59]};
    X30 = (f32x2){bf2f(colp[8160]) * mulp[60], bf2f(colp[8296]) * mulp[61]};
    X31 = (f32x2){bf2f(colp[8432]) * mulp[62], bf2f(colp[8568]) * mulp[63]};
    La0 = *(const f32x4*)(Lt_s + 0);
    La1 = *(const f32x4*)(Lt_s + 4);
    La2 = *(const f32x4*)(Lt_s + 8);
    La3 = *(const f32x4*)(Lt_s + 12);
    La4 = *(const f32x4*)(Lt_s + 16);
    La5 = *(const f32x4*)(Lt_s + 20);
    La6 = *(const f32x4*)(Lt_s + 24);
    La7 = *(const f32x4*)(Lt_s + 28);
    La8 = *(const f32x4*)(Lt_s + 32);
    La9 = *(const f32x4*)(Lt_s + 36);
    La10 = *(const f32x4*)(Lt_s + 40);
    La11 = *(const f32x4*)(Lt_s + 44);
    La12 = *(const f32x4*)(Lt_s + 48);
    La13 = *(const f32x4*)(Lt_s + 52);
    La14 = *(const f32x4*)(Lt_s + 56);
    La15 = *(const f32x4*)(Lt_s + 60);
    Lb0 = *(const f32x4*)(Lt_s + 68);
    Lb1 = *(const f32x4*)(Lt_s + 72);
    Lb2 = *(const f32x4*)(Lt_s + 76);
    Lb3 = *(const f32x4*)(Lt_s + 80);
    Lb4 = *(const f32x4*)(Lt_s + 84);
    Lb5 = *(const f32x4*)(Lt_s + 88);
    Lb6 = *(const f32x4*)(Lt_s + 92);
    Lb7 = *(const f32x4*)(Lt_s + 96);
    Lb8 = *(const f32x4*)(Lt_s + 100);
    Lb9 = *(const f32x4*)(Lt_s + 104);
    Lb10 = *(const f32x4*)(Lt_s + 108);
    Lb11 = *(const f32x4*)(Lt_s + 112);
    Lb12 = *(const f32x4*)(Lt_s + 116);
    Lb13 = *(const f32x4*)(Lt_s + 120);
    Lb14 = *(const f32x4*)(Lt_s + 124);
    Lb15 = *(const f32x4*)(Lt_s + 128);
    __builtin_amdgcn_sched_barrier(0);
    { const float xj = X0[0]; const f32x2 xj2 = (f32x2){xj, xj};
      X0 -= (f32x2){La0[0], La0[1]} * xj2;
      X1 -= (f32x2){La0[2], La0[3]} * xj2;
      X2 -= (f32x2){La1[0], La1[1]} * xj2;
      X3 -= (f32x2){La1[2], La1[3]} * xj2;
      X4 -= (f32x2){La2[0], La2[1]} * xj2;
      X5 -= (f32x2){La2[2], La2[3]} * xj2;
      X6 -= (f32x2){La3[0], La3[1]} * xj2;
      X7 -= (f32x2){La3[2], La3[3]} * xj2;
      X8 -= (f32x2){La4[0], La4[1]} * xj2;
      X9 -= (f32x2){La4[2], La4[3]} * xj2;
      X10 -= (f32x2){La5[0], La5[1]} * xj2;
      X11 -= (f32x2){La5[2], La5[3]} * xj2;
      X12 -= (f32x2){La6[0], La6[1]} * xj2;
      X13 -= (f32x2){La6[2], La6[3]} * xj2;
      X14 -= (f32x2){La7[0], La7[1]} * xj2;
      X15 -= (f32x2){La7[2], La7[3]} * xj2;
      X16 -= (f32x2){La8[0], La8[1]} * xj2;
      X17 -= (f32x2){La8[2], La8[3]} * xj2;
      X18 -= (f32x2){La9[0], La9[1]} * xj2;
      X19 -= (f32x2){La9[2], La9[3]} * xj2;
      X20 -= (f32x2){La10[0], La10[1]} * xj2;
      X21 -= (f32x2){La10[2], La10[3]} * xj2;
      X22 -= (f32x2){La11[0], La11[1]} * xj2;
      X23 -= (f32x2){La11[2], La11[3]} * xj2;
      X24 -= (f32x2){La12[0], La12[1]} * xj2;
      X25 -= (f32x2){La12[2], La12[3]} * xj2;
      X26 -= (f32x2){La13[0], La13[1]} * xj2;
      X27 -= (f32x2){La13[2], La13[3]} * xj2;
      X28 -= (f32x2){La14[0], La14[1]} * xj2;
      X29 -= (f32x2){La14[2], La14[3]} * xj2;
      X30 -= (f32x2){La15[0], La15[1]} * xj2;
      X31 -= (f32x2){La15[2], La15[3]} * xj2;
    }
    __builtin_amdgcn_sched_barrier(0);
    La0 = *(const f32x4*)(Lt_s + 136);
    La1 = *(const f32x4*)(Lt_s + 140);
    La2 = *(const f32x4*)(Lt_s + 144);
    La3 = *(const f32x4*)(Lt_s + 148);
    La4 = *(const f32x4*)(Lt_s + 152);
    La5 = *(const f32x4*)(Lt_s + 156);
    La6 = *(const f32x4*)(Lt_s + 160);
    La7 = *(const f32x4*)(Lt_s + 164);
    La8 = *(const f32x4*)(Lt_s + 168);
    La9 = *(const f32x4*)(Lt_s + 172);
    La10 = *(const f32x4*)(Lt_s + 176);
    La11 = *(const f32x4*)(Lt_s + 180);
    La12 = *(const f32x4*)(Lt_s + 184);
    La13 = *(const f32x4*)(Lt_s + 188);
    La14 = *(const f32x4*)(Lt_s + 192);
    La15 = *(const f32x4*)(Lt_s + 196);
    __builtin_amdgcn_sched_barrier(0);
    { const float xj = X0[1]; const f32x2 xj2 = (f32x2){xj, xj};
      X1 -= (f32x2){Lb0[2], Lb0[3]} * xj2;
      X2 -= (f32x2){Lb1[0], Lb1[1]} * xj2;
      X3 -= (f32x2){Lb1[2], Lb1[3]} * xj2;
      X4 -= (f32x2){Lb2[0], Lb2[1]} * xj2;
      X5 -= (f32x2){Lb2[2], Lb2[3]} * xj2;
      X6 -= (f32x2){Lb3[0], Lb3[1]} * xj2;
      X7 -= (f32x2){Lb3[2], Lb3[3]} * xj2;
      X8 -= (f32x2){Lb4[0], Lb4[1]} * xj2;
      X9 -= (f32x2){Lb4[2], Lb4[3]} * xj2;
      X10 -= (f32x2){Lb5[0], Lb5[1]} * xj2;
      X11 -= (f32x2){Lb5[2], Lb5[3]} * xj2;
      X12 -= (f32x2){Lb6[0], Lb6[1]} * xj2;
      X13 -= (f32x2){Lb6[2], Lb6[3]} * xj2;
      X14 -= (f32x2){Lb7[0], Lb7[1]} * xj2;
      X15 -= (f32x2){Lb7[2], Lb7[3]} * xj2;
      X16 -= (f32x2){Lb8[0], Lb8[1]} * xj2;
      X17 -= (f32x2){Lb8[2], Lb8[3]} * xj2;
      X18 -= (f32x2){Lb9[0], Lb9[1]} * xj2;
      X19 -= (f32x2){Lb9[2], Lb9[3]} * xj2;
      X20 -= (f32x2){Lb10[0], Lb10[1]} * xj2;
      X21 -= (f32x2){Lb10[2], Lb10[3]} * xj2;
      X22 -= (f32x2){Lb11[0], Lb11[1]} * xj2;
      X23 -= (f32x2){Lb11[2], Lb11[3]} * xj2;
      X24 -= (f32x2){Lb12[0], Lb12[1]} * xj2;
      X25 -= (f32x2){Lb12[2], Lb12[3]} * xj2;
      X26 -= (f32x2){Lb13[0], Lb13[1]} * xj2;
      X27 -= (f32x2){Lb13[2], Lb13[3]} * xj2;
      X28 -= (f32x2){Lb14[0], Lb14[1]} * xj2;
      X29 -= (f32x2){Lb14[2], Lb14[3]} * xj2;
      X30 -= (f32x2){Lb15[0], Lb15[1]} * xj2;
      X31 -= (f32x2){Lb15[2], Lb15[3]} * xj2;
    }
    __builtin_amdgcn_sched_barrier(0);
    Lb1 = *(const f32x4*)(Lt_s + 208);
    Lb2 = *(const f32x4*)(Lt_s + 212);
    Lb3 = *(const f32x4*)(Lt_s + 216);
    Lb4 = *(const f32x4*)(Lt_s + 220);
    Lb5 = *(const f32x4*)(Lt_s + 224);
    Lb6 = *(const f32x4*)(Lt_s + 228);
    Lb7 = *(const f32x4*)(Lt_s + 232);
    Lb8 = *(const f32x4*)(Lt_s + 236);
    Lb9 = *(const f32x4*)(Lt_s + 240);
    Lb10 = *(const f32x4*)(Lt_s + 244);
    Lb11 = *(const f32x4*)(Lt_s + 248);
    Lb12 = *(const f32x4*)(Lt_s + 252);
    Lb13 = *(const f32x4*)(Lt_s + 256);
    Lb14 = *(const f32x4*)(Lt_s + 260);
    Lb15 = *(const f32x4*)(Lt_s + 264);
    __builtin_amdgcn_sched_barrier(0);
    { const float xj = X1[0]; const f32x2 xj2 = (f32x2){xj, xj};
      X1 -= (f32x2){La0[2], La0[3]} * xj2;
      X2 -= (f32x2){La1[0], La1[1]} * xj2;
      X3 -= (f32x2){La1[2], La1[3]} * xj2;
      X4 -= (f32x2){La2[0], La2[1]} * xj2;
      X5 -= (f32x2){La2[2], La2[3]} * xj2;
      X6 -= (f32x2){La3[0], La3[1]} * xj2;
      X7 -= (f32x2){La3[2], La3[3]} * xj2;
      X8 -= (f32x2){La4[0], La4[1]} * xj2;
      X9 -= (f32x2){La4[2], La4[3]} * xj2;
      X10 -= (f32x2){La5[0], La5[1]} * xj2;
      X11 -= (f32x2){La5[2], La5[3]} * xj2;
      X12 -= (f32x2){La6[0], La6[1]} * xj2;
      X13 -= (f32x2){La6[2], La6[3]} * xj2;
      X14 -= (f32x2){La7[0], La7[1]} * xj2;
      X15 -= (f32x2){La7[2], La7[3]} * xj2;
      X16 -= (f32x2){La8[0], La8[1]} * xj2;
      X17 -= (f32x2){La8[2], La8[3]} * xj2;
      X18 -= (f32x2){La9[0], La9[1]} * xj2;
      X19 -= (f32x2){La9[2], La9[3]} * xj2;
      X20 -= (f32x2){La10[0], La10[1]} * xj2;
      X21 -= (f32x2){La10[2], La10[3]} * xj2;
      X22 -= (f32x2){La11[0], La11[1]} * xj2;
      X23 -= (f32x2){La11[2], La11[3]} * xj2;
      X24 -= (f32x2){La12[0], La12[1]} * xj2;
      X25 -= (f32x2){La12[2], La12[3]} * xj2;
      X26 -= (f32x2){La13[0], La13[1]} * xj2;
      X27 -= (f32x2){La13[2], La13[3]} * xj2;
      X28 -= (f32x2){La14[0], La14[1]} * xj2;
      X29 -= (f32x2){La14[2], La14[3]} * xj2;
      X30 -= (f32x2){La15[0], La15[1]} * xj2;
      X31 -= (f32x2){La15[2], La15[3]} * xj2;
    }
    __builtin_amdgcn_sched_barrier(0);
    La1 = *(const f32x4*)(Lt_s + 276);
    La2 = *(const f32x4*)(Lt_s + 280);
    La3 = *(const f32x4*)(Lt_s + 284);
    La4 = *(const f32x4*)(Lt_s + 288);
    La5 = *(const f32x4*)(Lt_s + 292);
    La6 = *(const f32x4*)(Lt_s + 296);
    La7 = *(const f32x4*)(Lt_s + 300);
    La8 = *(const f32x4*)(Lt_s + 304);
    La9 = *(const f32x4*)(Lt_s + 308);
    La10 = *(const f32x4*)(Lt_s + 312);
    La11 = *(const f32x4*)(Lt_s + 316);
    La12 = *(const f32x4*)(Lt_s + 320);
    La13 = *(const f32x4*)(Lt_s + 324);
    La14 = *(const f32x4*)(Lt_s + 328);
    La15 = *(const f32x4*)(Lt_s + 332);
    __builtin_amdgcn_sched_barrier(0);
    { const float xj = X1[1]; const f32x2 xj2 = (f32x2){xj, xj};
      X2 -= (f32x2){Lb1[0], Lb1[1]} * xj2;
      X3 -= (f32x2){Lb1[2], Lb1[3]} * xj2;
      X4 -= (f32x2){Lb2[0], Lb2[1]} * xj2;
      X5 -= (f32x2){Lb2[2], Lb2[3]} * xj2;
      X6 -= (f32x2){Lb3[0], Lb3[1]} * xj2;
      X7 -= (f32x2){Lb3[2], Lb3[3]} * xj2;
      X8 -= (f32x2){Lb4[0], Lb4[1]} * xj2;
      X9 -= (f32x2){Lb4[2], Lb4[3]} * xj2;
      X10 -= (f32x2){Lb5[0], Lb5[1]} * xj2;
      X11 -= (f32x2){Lb5[2], Lb5[3]} * xj2;
      X12 -= (f32x2){Lb6[0], Lb6[1]} * xj2;
      X13 -= (f32x2){Lb6[2], Lb6[3]} * xj2;
      X14 -= (f32x2){Lb7[0], Lb7[1]} * xj2;
      X15 -= (f32x2){Lb7[2], Lb7[3]} * xj2;
      X16 -= (f32x2){Lb8[0], Lb8[1]} * xj2;
      X17 -= (f32x2){Lb8[2], Lb8[3]} * xj2;
      X18 -= (f32x2){Lb9[0], Lb9[1]} * xj2;
      X19 -= (f32x2){Lb9[2], Lb9[3]} * xj2;
      X20 -= (f32x2){Lb10[0], Lb10[1]} * xj2;
      X21 -= (f32x2){Lb10[2], Lb10[3]} * xj2;
      X22 -= (f32x2){Lb11[0], Lb11[1]} * xj2;
      X23 -= (f32x2){Lb11[2], Lb11[3]} * xj2;
      X24 -= (f32x2){Lb12[0], Lb12[1]} * xj2;
      X25 -= (f32x2){Lb12[2], Lb12[3]} * xj2;
      X26 -= (f32x2){Lb13[0], Lb13[1]} * xj2;
      X27 -= (f32x2){Lb13[2], Lb13[3]} * xj2;
      X28 -= (f32x2){Lb14[0], Lb14[1]} * xj2;
      X29 -= (f32x2){Lb14[2], Lb14[3]} * xj2;
      X30 -= (f32x2){Lb15[0], Lb15[1]} * xj2;
      X31 -= (f32x2){Lb15[2], Lb15[3]} * xj2;
    }
    __builtin_amdgcn_sched_barrier(0);
    Lb1 = *(const f32x4*)(Lt_s + 344);
    Lb2 = *(const f32x4*)(Lt_s + 348);
    Lb3 = *(const f32x4*)(Lt_s + 352);
    Lb4 = *(const f32x4*)(Lt_s + 356);
    Lb5 = *(const f32x4*)(Lt_s + 360);
    Lb6 = *(const f32x4*)(Lt_s + 364);
    Lb7 = *(const f32x4*)(Lt_s + 368);
    Lb8 = *(const f32x4*)(Lt_s + 372);
    Lb9 = *(const f32x4*)(Lt_s + 376);
    Lb10 = *(const f32x4*)(Lt_s + 380);
    Lb11 = *(const f32x4*)(Lt_s + 384);
    Lb12 = *(const f32x4*)(Lt_s + 388);
    Lb13 = *(const f32x4*)(Lt_s + 392);
    Lb14 = *(const f32x4*)(Lt_s + 396);
    Lb15 = *(const f32x4*)(Lt_s + 400);
    __builtin_amdgcn_sched_barrier(0);
    { const float xj = X2[0]; const f32x2 xj2 = (f32x2){xj, xj};
      X2 -= (f32x2){La1[0], La1[1]} * xj2;
      X3 -= (f32x2){La1[2], La1[3]} * xj2;
      X4 -= (f32x2){La2[0], La2[1]} * xj2;
      X5 -= (f32x2){La2[2], La2[3]} * xj2;
      X6 -= (f32x2){La3[0], La3[1]} * xj2;
      X7 -= (f32x2){La3[2], La3[3]} * xj2;
      X8 -= (f32x2){La4[0], La4[1]} * xj2;
      X9 -= (f32x2){La4[2], La4[3]} * xj2;
      X10 -= (f32x2){La5[0], La5[1]} * xj2;
      X11 -= (f32x2){La5[2], La5[3]} * xj2;
      X12 -= (f32x2){La6[0], La6[1]} * xj2;
      X13 -= (f32x2){La6[2], La6[3]} * xj2;
      X14 -= (f32x2){La7[0], La7[1]} * xj2;
      X15 -= (f32x2){La7[2], La7[3]} * xj2;
      X16 -= (f32x2){La8[0], La8[1]} * xj2;
      X17 -= (f32x2){La8[2], La8[3]} * xj2;
      X18 -= (f32x2){La9[0], La9[1]} * xj2;
      X19 -= (f32x2){La9[2], La9[3]} * xj2;
      X20 -= (f32x2){La10[0], La10[1]} * xj2;
      X21 -= (f32x2){La10[2], La10[3]} * xj2;
      X22 -= (f32x2){La11[0], La11[1]} * xj2;
      X23 -= (f32x2){La11[2], La11[3]} * xj2;
      X24 -= (f32x2){La12[0], La12[1]} * xj2;
      X25 -= (f32x2){La12[2], La12[3]} * xj2;
      X26 -= (f32x2){La13[0], La13[1]} * xj2;
      X27 -= (f32x2){La13[2], La13[3]} * xj2;
      X28 -= (f32x2){La14[0], La14[1]} * xj2;
      X29 -= (f32x2){La14[2], La14[3]} * xj2;
      X30 -= (f32x2){La15[0], La15[1]} * xj2;
      X31 -= (f32x2){La15[2], La15[3]} * xj2;
    }
    __builtin_amdgcn_sched_barrier(0);
    La1 = *(const f32x4*)(Lt_s + 412);
    La2 = *(const f32x4*)(Lt_s + 416);
    La3 = *(const f32x4*)(Lt_s + 420);
    La4 = *(const f32x4*)(Lt_s + 424);
    La5 = *(const f32x4*)(Lt_s + 428);
    La6 = *(const f32x4*)(Lt_s + 432);
    La7 = *(const f32x4*)(Lt_s + 436);
    La8 = *(const f32x4*)(Lt_s + 440);
    La9 = *(const f32x4*)(Lt_s + 444);
    La10 = *(const f32x4*)(Lt_s + 448);
    La11 = *(const f32x4*)(Lt_s + 452);
    La12 = *(const f32x4*)(Lt_s + 456);
    La13 = *(const f32x4*)(Lt_s + 460);
    La14 = *(const f32x4*)(Lt_s + 464);
    La15 = *(const f32x4*)(Lt_s + 468);
    __builtin_amdgcn_sched_barrier(0);
    { const float xj = X2[1]; const f32x2 xj2 = (f32x2){xj, xj};
      X3 -= (f32x2){Lb1[2], Lb1[3]} * xj2;
      X4 -= (f32x2){Lb2[0], Lb2[1]} * xj2;
      X5 -= (f32x2){Lb2[2], Lb2[3]} * xj2;
      X6 -= (f32x2){Lb3[0], Lb3[1]} * xj2;
      X7 -= (f32x2){Lb3[2], Lb3[3]} * xj2;
      X8 -= (f32x2){Lb4[0], Lb4[1]} * xj2;
      X9 -= (f32x2){Lb4[2], Lb4[3]} * xj2;
      X10 -= (f32x2){Lb5[0], Lb5[1]} * xj2;
      X11 -= (f32x2){Lb5[2], Lb5[3]} * xj2;
      X12 -= (f32x2){Lb6[0], Lb6[1]} * xj2;
      X13 -= (f32x2){Lb6[2], Lb6[3]} * xj2;
      X14 -= (f32x2){Lb7[0], Lb7[1]} * xj2;
      X15 -= (f32x2){Lb7[2], Lb7[3]} * xj2;
      X16 -= (f32x2){Lb8[0], Lb8[1]} * xj2;
      X17 -= (f32x2){Lb8[2], Lb8[3]} * xj2;
      X18 -= (f32x2){Lb9[0], Lb9[1]} * xj2;
      X19 -= (f32x2){Lb9[2], Lb9[3]} * xj2;
      X20 -= (f32x2){Lb10[0], Lb10[1]} * xj2;
      X21 -= (f32x2){Lb10[2], Lb10[3]} * xj2;
      X22 -= (f32x2){Lb11[0], Lb11[1]} * xj2;
      X23 -= (f32x2){Lb11[2], Lb11[3]} * xj2;
      X24 -= (f32x2){Lb12[0], Lb12[1]} * xj2;
      X25 -= (f32x2){Lb12[2], Lb12[3]} * xj2;
      X26 -= (f32x2){Lb13[0], Lb13[1]} * xj2;
      X27 -= (f32x2){Lb13[2], Lb13[3]} * xj2;
      X28 -= (f32x2){Lb14[0], Lb14[1]} * xj2;
      X29 -= (f32x2){Lb14[2], Lb14[3]} * xj2;
      X30 -= (f32x2){Lb15[0], Lb15[1]} * xj2;
      X31 -= (f32x2){Lb15[2], Lb15[3]} * xj2;
    }
    __builtin_amdgcn_sched_barrier(0);
    Lb2 = *(const f32x4*)(Lt_s + 484);
    Lb3 = *(const f32x4*)(Lt_s + 488);
    Lb4 = *(const f32x4*)(Lt_s + 492);
    Lb5 = *(const f32x4*)(Lt_s + 496);
    Lb6 = *(const f32x4*)(Lt_s + 500);
    Lb7 = *(const f32x4*)(Lt_s + 504);
    Lb8 = *(const f32x4*)(Lt_s + 508);
    Lb9 = *(const f32x4*)(Lt_s + 512);
    Lb10 = *(const f32x4*)(Lt_s + 516);
    Lb11 = *(const f32x4*)(Lt_s + 520);
    Lb12 = *(const f32x4*)(Lt_s + 524);
    Lb13 = *(const f32x4*)(Lt_s + 528);
    Lb14 = *(const f32x4*)(Lt_s + 532);
    Lb15 = *(const f32x4*)(Lt_s + 536);
    __builtin_amdgcn_sched_barrier(0);
    { const float xj = X3[0]; const f32x2 xj2 = (f32x2){xj, xj};
      X3 -= (f32x2){La1[2], La1[3]} * xj2;
      X4 -= (f32x2){La2[0], La2[1]} * xj2;
      X5 -= (f32x2){La2[2], La2[3]} * xj2;
      X6 -= (f32x2){La3[0], La3[1]} * xj2;
      X7 -= (f32x2){La3[2], La3[3]} * xj2;
      X8 -= (f32x2){La4[0], La4[1]} * xj2;
      X9 -= (f32x2){La4[2], La4[3]} * xj2;
      X10 -= (f32x2){La5[0], La5[1]} * xj2;
      X11 -= (f32x2){La5[2], La5[3]} * xj2;
      X12 -= (f32x2){La6[0], La6[1]} * xj2;
      X13 -= (f32x2){La6[2], La6[3]} * xj2;
      X14 -= (f32x2){La7[0], La7[1]} * xj2;
      X15 -= (f32x2){La7[2], La7[3]} * xj2;
      X16 -= (f32x2){La8[0], La8[1]} * xj2;
      X17 -= (f32x2){La8[2], La8[3]} * xj2;
      X18 -= (f32x2){La9[0], La9[1]} * xj2;
      X19 -= (f32x2){La9[2], La9[3]} * xj2;
      X20 -= (f32x2){La10[0], La10[1]} * xj2;
      X21 -= (f32x2){La10[2], La10[3]} * xj2;
      X22 -= (f32x2){La11[0], La11[1]} * xj2;
      X23 -= (f32x2){La11[2], La11[3]} * xj2;
      X24 -= (f32x2){La12[0], La12[1]} * xj2;
      X25 -= (f32x2){La12[2], La12[3]} * xj2;
      X26 -= (f32x2){La13[0], La13[1]} * xj2;
      X27 -= (f32x2){La13[2], La13[3]} * xj2;
      X28 -= (f32x2){La14[0], La14[1]} * xj2;
      X29 -= (f32x2){La14[2], La14[3]} * xj2;
      X30 -= (f32x2){La15[0], La15[1]} * xj2;
      X31 -= (f32x2){La15[2], La15[3]} * xj2;
    }
    __builtin_amdgcn_sched_barrier(0);
    La2 = *(const f32x4*)(Lt_s + 552);
    La3 = *(const f32x4*)(Lt_s + 556);
    La4 = *(const f32x4*)(Lt_s + 560);
    La5 = *(const f32x4*)(Lt_s + 564);
    La6 = *(const f32x4*)(Lt_s + 568);
    La7 = *(const f32x4*)(Lt_s + 572);
    La8 = *(const f32x4*)(Lt_s + 576);
    La9 = *(const f32x4*)(Lt_s + 580);
    La10 = *(const f32x4*)(Lt_s + 584);
    La11 = *(const f32x4*)(Lt_s + 588);
    La12 = *(const f32x4*)(Lt_s + 592);
    La13 = *(const f32x4*)(Lt_s + 596);
    La14 = *(const f32x4*)(Lt_s + 600);
    La15 = *(const f32x4*)(Lt_s + 604);
    __builtin_amdgcn_sched_barrier(0);
    { const float xj = X3[1]; const f32x2 xj2 = (f32x2){xj, xj};
      X4 -= (f32x2){Lb2[0], Lb2[1]} * xj2;
      X5 -= (f32x2){Lb2[2], Lb2[3]} * xj2;
      X6 -= (f32x2){Lb3[0], Lb3[1]} * xj2;
      X7 -= (f32x2){Lb3[2], Lb3[3]} * xj2;
      X8 -= (f32x2){Lb4[0], Lb4[1]} * xj2;
      X9 -= (f32x2){Lb4[2], Lb4[3]} * xj2;
      X10 -= (f32x2){Lb5[0], Lb5[1]} * xj2;
      X11 -= (f32x2){Lb5[2], Lb5[3]} * xj2;
      X12 -= (f32x2){Lb6[0], Lb6[1]} * xj2;
      X13 -= (f32x2){Lb6[2], Lb6[3]} * xj2;
      X14 -= (f32x2){Lb7[0], Lb7[1]} * xj2;
      X15 -= (f32x2){Lb7[2], Lb7[3]} * xj2;
      X16 -= (f32x2){Lb8[0], Lb8[1]} * xj2;
      X17 -= (f32x2){Lb8[2], Lb8[3]} * xj2;
      X18 -= (f32x2){Lb9[0], Lb9[1]} * xj2;
      X19 -= (f32x2){Lb9[2], Lb9[3]} * xj2;
      X20 -= (f32x2){Lb10[0], Lb10[1]} * xj2;
      X21 -= (f32x2){Lb10[2], Lb10[3]} * xj2;
      X22 -= (f32x2){Lb11[0], Lb11[1]} * xj2;
      X23 -= (f32x2){Lb11[2], Lb11[3]} * xj2;
      X24 -= (f32x2){Lb12[0], Lb12[1]} * xj2;
      X25 -= (f32x2){Lb12[2], Lb12[3]} * xj2;
      X26 -= (f32x2){Lb13[0], Lb13[1]} * xj2;
      X27 -= (f32x2){Lb13[2], Lb13[3]} * xj2;
      X28 -= (f32x2){Lb14[0], Lb14[1]} * xj2;
      X29 -= (f32x2){Lb14[2], Lb14[3]} * xj2;
      X30 -= (f32x2){Lb15[0], Lb15[1]} * xj2;
      X31 -= (f32x2){Lb15[2], Lb15[3]} * xj2;
    }
    __builtin_amdgcn_sched_barrier(0);
    Lb2 = *(const f32x4*)(Lt_s + 620);
    Lb3 = *(const f32x4*)(Lt_s + 624);
    Lb4 = *(const f32x4*)(Lt_s + 628);
    Lb5 = *(const f32x4*)(Lt_s + 632);
    Lb6 = *(const f32x4*)(Lt_s + 636);
    Lb7 = *(const f32x4*)(Lt_s + 640);
    Lb8 = *(const f32x4*)(Lt_s + 644);
    Lb9 = *(const f32x4*)(Lt_s + 648);
    Lb10 = *(const f32x4*)(Lt_s + 652);
    Lb11 = *(const f32x4*)(Lt_s + 656);
    Lb12 = *(const f32x4*)(Lt_s + 660);
    Lb13 = *(const f32x4*)(Lt_s + 664);
    Lb14 = *(const f32x4*)(Lt_s + 668);
    Lb15 = *(const f32x4*)(Lt_s + 672);
    __builtin_amdgcn_sched_barrier(0);
    { const float xj = X4[0]; const f32x2 xj2 = (f32x2){xj, xj};
      X4 -= (f32x2){La2[0], La2[1]} * xj2;
      X5 -= (f32x2){La2[2], La2[3]} * xj2;
      X6 -= (f32x2){La3[0], La3[1]} * xj2;
      X7 -= (f32x2){La3[2], La3[3]} * xj2;
      X8 -= (f32x2){La4[0], La4[1]} * xj2;
      X9 -= (f32x2){La4[2], La4[3]} * xj2;
      X10 -= (f32x2){La5[0], La5[1]} * xj2;
      X11 -= (f32x2){La5[2], La5[3]} * xj2;
      X12 -= (f32x2){La6[0], La6[1]} * xj2;
      X13 -= (f32x2){La6[2], La6[3]} * xj2;
      X14 -= (f32x2){La7[0], La7[1]} * xj2;
      X15 -= (f32x2){La7[2], La7[3]} * xj2;
      X16 -= (f32x2){La8[0], La8[1]} * xj2;
      X17 -= (f32x2){La8[2], La8[3]} * xj2;
      X18 -= (f32x2){La9[0], La9[1]} * xj2;
      X19 -= (f32x2){La9[2], La9[3]} * xj2;
      X20 -= (f32x2){La10[0], La10[1]} * xj2;
      X21 -= (f32x2){La10[2], La10[3]} * xj2;
      X22 -= (f32x2){La11[0], La11[1]} * xj2;
      X23 -= (f32x2){La11[2], La11[3]} * xj2;
      X24 -= (f32x2){La12[0], La12[1]} * xj2;
      X25 -= (f32x2){La12[2], La12[3]} * xj2;
      X26 -= (f32x2){La13[0], La13[1]} * xj2;
      X27 -= (f32x2){La13[2], La13[3]} * xj2;
      X28 -= (f32x2){La14[0], La14[1]} * xj2;
      X29 -= (f32x2){La14[2], La14[3]} * xj2;
      X30 -= (f32x2){La15[0], La15[1]} * xj2;
      X31 -= (f32x2){La15[2], La15[3]} * xj2;
    }
    __builtin_amdgcn_sched_barrier(0);
    La2 = *(const f32x4*)(Lt_s + 688);
    La3 = *(const f32x4*)(Lt_s + 692);
    La4 = *(const f32x4*)(Lt_s + 696);
    La5 = *(const f32x4*)(Lt_s + 700);
    La6 = *(const f32x4*)(Lt_s + 704);
    La7 = *(const f32x4*)(Lt_s + 708);
    La8 = *(const f32x4*)(Lt_s + 712);
    La9 = *(const f32x4*)(Lt_s + 716);
    La10 = *(const f32x4*)(Lt_s + 720);
    La11 = *(const f32x4*)(Lt_s + 724);
    La12 = *(const f32x4*)(Lt_s + 728);
    La13 = *(const f32x4*)(Lt_s + 732);
    La14 = *(const f32x4*)(Lt_s + 736);
    La15 = *(const f32x4*)(Lt_s + 740);
    __builtin_amdgcn_sched_barrier(0);
    { const float xj = X4[1]; const f32x2 xj2 = (f32x2){xj, xj};
      X5 -= (f32x2){Lb2[2], Lb2[3]} * xj2;
      X6 -= (f32x2){Lb3[0], Lb3[1]} * xj2;
      X7 -= (f32x2){Lb3[2], Lb3[3]} * xj2;
      X8 -= (f32x2){Lb4[0], Lb4[1]} * xj2;
      X9 -= (f32x2){Lb4[2], Lb4[3]} * xj2;
      X10 -= (f32x2){Lb5[0], Lb5[1]} * xj2;
      X11 -= (f32x2){Lb5[2], Lb5[3]} * xj2;
      X12 -= (f32x2){Lb6[0], Lb6[1]} * xj2;
      X13 -= (f32x2){Lb6[2], Lb6[3]} * xj2;
      X14 -= (f32x2){Lb7[0], Lb7[1]} * xj2;
      X15 -= (f32x2){Lb7[2], Lb7[3]} * xj2;
      X16 -= (f32x2){Lb8[0], Lb8[1]} * xj2;
      X17 -= (f32x2){Lb8[2], Lb8[3]} * xj2;
      X18 -= (f32x2){Lb9[0], Lb9[1]} * xj2;
      X19 -= (f32x2){Lb9[2], Lb9[3]} * xj2;
      X20 -= (f32x2){Lb10[0], Lb10[1]} * xj2;
      X21 -= (f32x2){Lb10[2], Lb10[3]} * xj2;
      X22 -= (f32x2){Lb11[0], Lb11[1]} * xj2;
      X23 -= (f32x2){Lb11[2], Lb11[3]} * xj2;
      X24 -= (f32x2){Lb12[0], Lb12[1]} * xj2;
      X25 -= (f32x2){Lb12[2], Lb12[3]} * xj2;
      X26 -= (f32x2){Lb13[0], Lb13[1]} * xj2;
      X27 -= (f32x2){Lb13[2], Lb13[3]} * xj2;
      X28 -= (f32x2){Lb14[0], Lb14[1]} * xj2;
      X29 -= (f32x2){Lb14[2], Lb14[3]} * xj2;
      X30 -= (f32x2){Lb15[0], Lb15[1]} * xj2;
      X31 -= (f32x2){Lb15[2], Lb15[3]} * xj2;
    }
    __builtin_amdgcn_sched_barrier(0);
    Lb3 = *(const f32x4*)(Lt_s + 760);
    Lb4 = *(const f32x4*)(Lt_s + 764);
    Lb5 = *(const f32x4*)(Lt_s + 768);
    Lb6 = *(const f32x4*)(Lt_s + 772);
    Lb7 = *(const f32x4*)(Lt_s + 776);
    Lb8 = *(const f32x4*)(Lt_s + 780);
    Lb9 = *(const f32x4*)(Lt_s + 784);
    Lb10 = *(const f32x4*)(Lt_s + 788);
    Lb11 = *(const f32x4*)(Lt_s + 792);
    Lb12 = *(const f32x4*)(Lt_s + 796);
    Lb13 = *(const f32x4*)(Lt_s + 800);
    Lb14 = *(const f32x4*)(Lt_s + 804);
    Lb15 = *(const f32x4*)(Lt_s + 808);
    __builtin_amdgcn_sched_barrier(0);
    { const float xj = X5[0]; const f32x2 xj2 = (f32x2){xj, xj};
      X5 -= (f32x2){La2[2], La2[3]} * xj2;
      X6 -= (f32x2){La3[0], La3[1]} * xj2;
      X7 -= (f32x2){La3[2], La3[3]} * xj2;
      X8 -= (f32x2){La4[0], La4[1]} * xj2;
      X9 -= (f32x2){La4[2], La4[3]} * xj2;
      X10 -= (f32x2){La5[0], La5[1]} * xj2;
      X11 -= (f32x2){La5[2], La5[3]} * xj2;
      X12 -= (f32x2){La6[0], La6[1]} * xj2;
      X13 -= (f32x2){La6[2], La6[3]} * xj2;
      X14 -= (f32x2){La7[0], La7[1]} * xj2;
      X15 -= (f32x2){La7[2], La7[3]} * xj2;
      X16 -= (f32x2){La8[0], La8[1]} * xj2;
      X17 -= (f32x2){La8[2], La8[3]} * xj2;
      X18 -= (f32x2){La9[0], La9[1]} * xj2;
      X19 -= (f32x2){La9[2], La9[3]} * xj2;
      X20 -= (f32x2){La10[0], La10[1]} * xj2;
      X21 -= (f32x2){La10[2], La10[3]} * xj2;
      X22 -= (f32x2){La11[0], La11[1]} * xj2;
      X23 -= (f32x2){La11[2], La11[3]} * xj2;
      X24 -= (f32x2){La12[0], La12[1]} * xj2;
      X25 -= (f32x2){La12[2], La12[3]} * xj2;
      X26 -= (f32x2){La13[0], La13[1]} * xj2;
      X27 -= (f32x2){La13[2], La13[3]} * xj2;
      X28 -= (f32x2){La14[0], La14[1]} * xj2;
      X29 -= (f32x2){La14[2], La14[3]} * xj2;
      X30 -= (f32x2){La15[0], La15[1]} * xj2;
      X31 -= (f32x2){La15[2], La15[3]} * xj2;
    }
    __builtin_amdgcn_sched_barrier(0);
    La3 = *(const f32x4*)(Lt_s + 828);
    La4 = *(const f32x4*)(Lt_s + 832);
    La5 = *(const f32x4*)(Lt_s + 836);
    La6 = *(const f32x4*)(Lt_s + 840);
    La7 = *(const f32x4*)(Lt_s + 844);
    La8 = *(const f32x4*)(Lt_s + 848);
    La9 = *(const f32x4*)(Lt_s + 852);
    La10 = *(const f32x4*)(Lt_s + 856);
    La11 = *(const f32x4*)(Lt_s + 860);
    La12 = *(const f32x4*)(Lt_s + 864);
    La13 = *(const f32x4*)(Lt_s + 868);
    La14 = *(const f32x4*)(Lt_s + 872);
    La15 = *(const f32x4*)(Lt_s + 876);
    __builtin_amdgcn_sched_barrier(0);
    { const float xj = X5[1]; const f32x2 xj2 = (f32x2){xj, xj};
      X6 -= (f32x2){Lb3[0], Lb3[1]} * xj2;
      X7 -= (f32x2){Lb3[2], Lb3[3]} * xj2;
      X8 -= (f32x2){Lb4[0], Lb4[1]} * xj2;
      X9 -= (f32x2){Lb4[2], Lb4[3]} * xj2;
      X10 -= (f32x2){Lb5[0], Lb5[1]} * xj2;
      X11 -= (f32x2){Lb5[2], Lb5[3]} * xj2;
      X12 -= (f32x2){Lb6[0], Lb6[1]} * xj2;
      X13 -= (f32x2){Lb6[2], Lb6[3]} * xj2;
      X14 -= (f32x2){Lb7[0], Lb7[1]} * xj2;
      X15 -= (f32x2){Lb7[2], Lb7[3]} * xj2;
      X16 -= (f32x2){Lb8[0], Lb8[1]} * xj2;
      X17 -= (f32x2){Lb8[2], Lb8[3]} * xj2;
      X18 -= (f32x2){Lb9[0], Lb9[1]} * xj2;
      X19 -= (f32x2){Lb9[2], Lb9[3]} * xj2;
      X20 -= (f32x2){Lb10[0], Lb10[1]} * xj2;
      X21 -= (f32x2){Lb10[2], Lb10[3]} * xj2;
      X22 -= (f32x2){Lb11[0], Lb11[1]} * xj2;
      X23 -= (f32x2){Lb11[2], Lb11[3]} * xj2;
      X24 -= (f32x2){Lb12[0], Lb12[1]} * xj2;
      X25 -= (f32x2){Lb12[2], Lb12[3]} * xj2;
      X26 -= (f32x2){Lb13[0], Lb13[1]} * xj2;
      X27 -= (f32x2){Lb13[2], Lb13[3]} * xj2;
      X28 -= (f32x2){Lb14[0], Lb14[1]} * xj2;
      X29 -= (f32x2){Lb14[2], Lb14[3]} * xj2;
      X30 -= (f32x2){Lb15[0], Lb15[1]} * xj2;
      X31 -= (f32x2){Lb15[2], Lb15[3]} * xj2;
    }
    __builtin_amdgcn_sched_barrier(0);
    Lb3 = *(const f32x4*)(Lt_s + 896);
    Lb4 = *(const f32x4*)(Lt_s + 900);
    Lb5 = *(const f32x4*)(Lt_s + 904);
    Lb6 = *(const f32x4*)(Lt_s + 908);
    Lb7 = *(const f32x4*)(Lt_s + 912);
    Lb8 = *(const f32x4*)(Lt_s + 916);
    Lb9 = *(const f32x4*)(Lt_s + 920);
    Lb10 = *(const f32x4*)(Lt_s + 924);
    Lb11 = *(const f32x4*)(Lt_s + 928);
    Lb12 = *(const f32x4*)(Lt_s + 932);
    Lb13 = *(const f32x4*)(Lt_s + 936);
    Lb14 = *(const f32x4*)(Lt_s + 940);
    Lb15 = *(const f32x4*)(Lt_s + 944);
    __builtin_amdgcn_sched_barrier(0);
    { const float xj = X6[0]; const f32x2 xj2 = (f32x2){xj, xj};
      X6 -= (f32x2){La3[0], La3[1]} * xj2;
      X7 -= (f32x2){La3[2], La3[3]} * xj2;
      X8 -= (f32x2){La4[0], La4[1]} * xj2;
      X9 -= (f32x2){La4[2], La4[3]} * xj2;
      X10 -= (f32x2){La5[0], La5[1]} * xj2;
      X11 -= (f32x2){La5[2], La5[3]} * xj2;
      X12 -= (f32x2){La6[0], La6[1]} * xj2;
      X13 -= (f32x2){La6[2], La6[3]} * xj2;
      X14 -= (f32x2){La7[0], La7[1]} * xj2;
      X15 -= (f32x2){La7[2], La7[3]} * xj2;
      X16 -= (f32x2){La8[0], La8[1]} * xj2;
      X17 -= (f32x2){La8[2], La8[3]} * xj2;
      X18 -= (f32x2){La9[0], La9[1]} * xj2;
      X19 -= (f32x2){La9[2], La9[3]} * xj2;
      X20 -= (f32x2){La10[0], La10[1]} * xj2;
      X21 -= (f32x2){La10[2], La10[3]} * xj2;
      X22 -= (f32x2){La11[0], La11[1]} * xj2;
      X23 -= (f32x2){La11[2], La11[3]} * xj2;
      X24 -= (f32x2){La12[0], La12[1]} * xj2;
      X25 -= (f32x2){La12[2], La12[3]} * xj2;
      X26 -= (f32x2){La13[0], La13[1]} * xj2;
      X27 -= (f32x2){La13[2], La13[3]} * xj2;
      X28 -= (f32x2){La14[0], La14[1]} * xj2;
      X29 -= (f32x2){La14[2], La14[3]} * xj2;
      X30 -= (f32x2){La15[0], La15[1]} * xj2;
      X31 -= (f32x2){La15[2], La15[3]} * xj2;
    }
    __builtin_amdgcn_sched_barrier(0);
    La3 = *(const f32x4*)(Lt_s + 964);
    La4 = *(const f32x4*)(Lt_s + 968);
    La5 = *(const f32x4*)(Lt_s + 972);
    La6 = *(const f32x4*)(Lt_s + 976);
    La7 = *(const f32x4*)(Lt_s + 980);
    La8 = *(const f32x4*)(Lt_s + 984);
    La9 = *(const f32x4*)(Lt_s + 988);
    La10 = *(const f32x4*)(Lt_s + 992);
    La11 = *(const f32x4*)(Lt_s + 996);
    La12 = *(const f32x4*)(Lt_s + 1000);
    La13 = *(const f32x4*)(Lt_s + 1004);
    La14 = *(const f32x4*)(Lt_s + 1008);
    La15 = *(const f32x4*)(Lt_s + 1012);
    __builtin_amdgcn_sched_barrier(0);
    { const float xj = X6[1]; const f32x2 xj2 = (f32x2){xj, xj};
      X7 -= (f32x2){Lb3[2], Lb3[3]} * xj2;
      X8 -= (f32x2){Lb4[0], Lb4[1]} * xj2;
      X9 -= (f32x2){Lb4[2], Lb4[3]} * xj2;
      X10 -= (f32x2){Lb5[0], Lb5[1]} * xj2;
      X11 -= (f32x2){Lb5[2], Lb5[3]} * xj2;
      X12 -= (f32x2){Lb6[0], Lb6[1]} * xj2;
      X13 -= (f32x2){Lb6[2], Lb6[3]} * xj2;
      X14 -= (f32x2){Lb7[0], Lb7[1]} * xj2;
      X15 -= (f32x2){Lb7[2], Lb7[3]} * xj2;
      X16 -= (f32x2){Lb8[0], Lb8[1]} * xj2;
      X17 -= (f32x2){Lb8[2], Lb8[3]} * xj2;
      X18 -= (f32x2){Lb9[0], Lb9[1]} * xj2;
      X19 -= (f32x2){Lb9[2], Lb9[3]} * xj2;
      X20 -= (f32x2){Lb10[0], Lb10[1]} * xj2;
      X21 -= (f32x2){Lb10[2], Lb10[3]} * xj2;
      X22 -= (f32x2){Lb11[0], Lb11[1]} * xj2;
      X23 -= (f32x2){Lb11[2], Lb11[3]} * xj2;
      X24 -= (f32x2){Lb12[0], Lb12[1]} * xj2;
      X25 -= (f32x2){Lb12[2], Lb12[3]} * xj2;
      X26 -= (f32x2){Lb13[0], Lb13[1]} * xj2;
      X27 -= (f32x2){Lb13[2], Lb13[3]} * xj2;
      X28 -= (f32x2){Lb14[0], Lb14[1]} * xj2;
      X29 -= (f32x2){Lb14[2], Lb14[3]} * xj2;
      X30 -= (f32x2){Lb15[0], Lb15[1]} * xj2;
      X31 -= (f32x2){Lb15[2], Lb15[3]} * xj2;
    }
    __builtin_amdgcn_sched_barrier(0);
    Lb4 = *(const f32x4*)(Lt_s + 1036);
    Lb5 = *(const f32x4*)(Lt_s + 1040);
    Lb6 = *(const f32x4*)(Lt_s + 1044);
    Lb7 = *(const f32x4*)(Lt_s + 1048);
    Lb8 = *(const f32x4*)(Lt_s + 1052);
    Lb9 = *(const f32x4*)(Lt_s + 1056);
    Lb10 = *(const f32x4*)(Lt_s + 1060);
    Lb11 = *(const f32x4*)(Lt_s + 1064);
    Lb12 = *(const f32x4*)(Lt_s + 1068);
    Lb13 = *(const f32x4*)(Lt_s + 1072);
    Lb14 = *(const f32x4*)(Lt_s + 1076);
    Lb15 = *(const f32x4*)(Lt_s + 1080);
    __builtin_amdgcn_sched_barrier(0);
    { const float xj = X7[0]; const f32x2 xj2 = (f32x2){xj, xj};
      X7 -= (f32x2){La3[2], La3[3]} * xj2;
      X8 -= (f32x2){La4[0], La4[1]} * xj2;
      X9 -= (f32x2){La4[2], La4[3]} * xj2;
      X10 -= (f32x2){La5[0], La5[1]} * xj2;
      X11 -= (f32x2){La5[2], La5[3]} * xj2;
      X12 -= (f32x2){La6[0], La6[1]} * xj2;
      X13 -= (f32x2){La6[2], La6[3]} * xj2;
      X14 -= (f32x2){La7[0], La7[1]} * xj2;
      X15 -= (f32x2){La7[2], La7[3]} * xj2;
      X16 -= (f32x2){La8[0], La8[1]} * xj2;
      X17 -= (f32x2){La8[2], La8[3]} * xj2;
      X18 -= (f32x2){La9[0], La9[1]} * xj2;
      X19 -= (f32x2){La9[2], La9[3]} * xj2;
      X20 -= (f32x2){La10[0], La10[1]} * xj2;
      X21 -= (f32x2){La10[2], La10[3]} * xj2;
      X22 -= (f32x2){La11[0], La11[1]} * xj2;
      X23 -= (f32x2){La11[2], La11[3]} * xj2;
      X24 -= (f32x2){La12[0], La12[1]} * xj2;
      X25 -= (f32x2){La12[2], La12[3]} * xj2;
      X26 -= (f32x2){La13[0], La13[1]} * xj2;
      X27 -= (f32x2){La13[2], La13[3]} * xj2;
      X28 -= (f32x2){La14[0], La14[1]} * xj2;
      X29 -= (f32x2){La14[2], La14[3]} * xj2;
      X30 -= (f32x2){La15[0], La15[1]} * xj2;
      X31 -= (f32x2){La15[2], La15[3]} * xj2;
    }
    __builtin_amdgcn_sched_barrier(0);
    La4 = *(const f32x4*)(Lt_s + 1104);
    La5 = *(const f32x4*)(Lt_s + 1108);
    La6 = *(const f32x4*)(Lt_s + 1112);
    La7 = *(const f32x4*)(Lt_s + 1116);
    La8 = *(const f32x4*)(Lt_s + 1120);
    La9 = *(const f32x4*)(Lt_s + 1124);
    La10 = *(const f32x4*)(Lt_s + 1128);
    La11 = *(const f32x4*)(Lt_s + 1132);
    La12 = *(const f32x4*)(Lt_s + 1136);
    La13 = *(const f32x4*)(Lt_s + 1140);
    La14 = *(const f32x4*)(Lt_s + 1144);
    La15 = *(const f32x4*)(Lt_s + 1148);
    __builtin_amdgcn_sched_barrier(0);
    { const float xj = X7[1]; const f32x2 xj2 = (f32x2){xj, xj};
      X8 -= (f32x2){Lb4[0], Lb4[1]} * xj2;
      X9 -= (f32x2){Lb4[2], Lb4[3]} * xj2;
      X10 -= (f32x2){Lb5[0], Lb5[1]} * xj2;
      X11 -= (f32x2){Lb5[2], Lb5[3]} * xj2;
      X12 -= (f32x2){Lb6[0], Lb6[1]} * xj2;
      X13 -= (f32x2){Lb6[2], Lb6[3]} * xj2;
      X14 -= (f32x2){Lb7[0], Lb7[1]} * xj2;
      X15 -= (f32x2){Lb7[2], Lb7[3]} * xj2;
      X16 -= (f32x2){Lb8[0], Lb8[1]} * xj2;
      X17 -= (f32x2){Lb8[2], Lb8[3]} * xj2;
      X18 -= (f32x2){Lb9[0], Lb9[1]} * xj2;
      X19 -= (f32x2){Lb9[2], Lb9[3]} * xj2;
      X20 -= (f32x2){Lb10[0], Lb10[1]} * xj2;
      X21 -= (f32x2){Lb10[2], Lb10[3]} * xj2;
      X22 -= (f32x2){Lb11[0], Lb11[1]} * xj2;
      X23 -= (f32x2){Lb11[2], Lb11[3]} * xj2;
      X24 -= (f32x2){Lb12[0], Lb12[1]} * xj2;
      X25 -= (f32x2){Lb12[2], Lb12[3]} * xj2;
      X26 -= (f32x2){Lb13[0], Lb13[1]} * xj2;
      X27 -= (f32x2){Lb13[2], Lb13[3]} * xj2;
      X28 -= (f32x2){Lb14[0], Lb14[1]} * xj2;
      X29 -= (f32x2){Lb14[2], Lb14[3]} * xj2;
      X30 -= (f32x2){Lb15[0], Lb15[1]} * xj2;
      X31 -= (f32x2){Lb15[2], Lb15[3]} * xj2;
    }
    __builtin_amdgcn_sched_barrier(0);
    Lb4 = *(const f32x4*)(Lt_s + 1172);
    Lb5 = *(const f32x4*)(Lt_s + 1176);
    Lb6 = *(const f32x4*)(Lt_s + 1180);
    Lb7 = *(const f32x4*)(Lt_s + 1184);
    Lb8 = *(const f32x4*)(Lt_s + 1188);
    Lb9 = *(const f32x4*)(Lt_s + 1192);
    Lb10 = *(const f32x4*)(Lt_s + 1196);
    Lb11 = *(const f32x4*)(Lt_s + 1200);
    Lb12 = *(const f32x4*)(Lt_s + 1204);
    Lb13 = *(const f32x4*)(Lt_s + 1208);
    Lb14 = *(const f32x4*)(Lt_s + 1212);
    Lb15 = *(const f32x4*)(Lt_s + 1216);
    __builtin_amdgcn_sched_barrier(0);
    { const float xj = X8[0]; const f32x2 xj2 = (f32x2){xj, xj};
      X8 -= (f32x2){La4[0], La4[1]} * xj2;
      X9 -= (f32x2){La4[2], La4[3]} * xj2;
      X10 -= (f32x2){La5[0], La5[1]} * xj2;
      X11 -= (f32x2){La5[2], La5[3]} * xj2;
      X12 -= (f32x2){La6[0], La6[1]} * xj2;
      X13 -= (f32x2){La6[2], La6[3]} * xj2;
      X14 -= (f32x2){La7[0], La7[1]} * xj2;
      X15 -= (f32x2){La7[2], La7[3]} * xj2;
      X16 -= (f32x2){La8[0], La8[1]} * xj2;
      X17 -= (f32x2){La8[2], La8[3]} * xj2;
      X18 -= (f32x2){La9[0], La9[1]} * xj2;
      X19 -= (f32x2){La9[2], La9[3]} * xj2;
      X20 -= (f32x2){La10[0], La10[1]} * xj2;
      X21 -= (f32x2){La10[2], La10[3]} * xj2;
      X22 -= (f32x2){La11[0], La11[1]} * xj2;
      X23 -= (f32x2){La11[2], La11[3]} * xj2;
      X24 -= (f32x2){La12[0], La12[1]} * xj2;
      X25 -= (f32x2){La12[2], La12[3]} * xj2;
      X26 -= (f32x2){La13[0], La13[1]} * xj2;
      X27 -= (f32x2){La13[2], La13[3]} * xj2;
      X28 -= (f32x2){La14[0], La14[1]} * xj2;
      X29 -= (f32x2){La14[2], La14[3]} * xj2;
      X30 -= (f32x2){La15[0], La15[1]} * xj2;
      X31 -= (f32x2){La15[2], La15[3]} * xj2;
    }
    __builtin_amdgcn_sched_barrier(0);
    La4 = *(const f32x4*)(Lt_s + 1240);
    La5 = *(const f32x4*)(Lt_s + 1244);
    La6 = *(const f32x4*)(Lt_s + 1248);
    La7 = *(const f32x4*)(Lt_s + 1252);
    La8 = *(const f32x4*)(Lt_s + 1256);
    La9 = *(const f32x4*)(Lt_s + 1260);
    La10 = *(const f32x4*)(Lt_s + 1264);
    La11 = *(const f32x4*)(Lt_s + 1268);
    La12 = *(const f32x4*)(Lt_s + 1272);
    La13 = *(const f32x4*)(Lt_s + 1276);
    La14 = *(const f32x4*)(Lt_s + 1280);
    La15 = *(const f32x4*)(Lt_s + 1284);
    __builtin_amdgcn_sched_barrier(0);
    { const float xj = X8[1]; const f32x2 xj2 = (f32x2){xj, xj};
      X9 -= (f32x2){Lb4[2], Lb4[3]} * xj2;
      X10 -= (f32x2){Lb5[0], Lb5[1]} * xj2;
      X11 -= (f32x2){Lb5[2], Lb5[3]} * xj2;
      X12 -= (f32x2){Lb6[0], Lb6[1]} * xj2;
      X13 -= (f32x2){Lb6[2], Lb6[3]} * xj2;
      X14 -= (f32x2){Lb7[0], Lb7[1]} * xj2;
      X15 -= (f32x2){Lb7[2], Lb7[3]} * xj2;
      X16 -= (f32x2){Lb8[0], Lb8[1]} * xj2;
      X17 -= (f32x2){Lb8[2], Lb8[3]} * xj2;
      X18 -= (f32x2){Lb9[0], Lb9[1]} * xj2;
      X19 -= (f32x2){Lb9[2], Lb9[3]} * xj2;
      X20 -= (f32x2){Lb10[0], Lb10[1]} * xj2;
      X21 -= (f32x2){Lb10[2], Lb10[3]} * xj2;
      X22 -= (f32x2){Lb11[0], Lb11[1]} * xj2;
      X23 -= (f32x2){Lb11[2], Lb11[3]} * xj2;
      X24 -= (f32x2){Lb12[0], Lb12[1]} * xj2;
      X25 -= (f32x2){Lb12[2], Lb12[3]} * xj2;
      X26 -= (f32x2){Lb13[0], Lb13[1]} * xj2;
      X27 -= (f32x2){Lb13[2], Lb13[3]} * xj2;
      X28 -= (f32x2){Lb14[0], Lb14[1]} * xj2;
      X29 -= (f32x2){Lb14[2], Lb14[3]} * xj2;
      X30 -= (f32x2){Lb15[0], Lb15[1]} * xj2;
      X31 -= (f32x2){Lb15[2], Lb15[3]} * xj2;
    }
    __builtin_amdgcn_sched_barrier(0);
    Lb5 = *(const f32x4*)(Lt_s + 1312);
    Lb6 = *(const f32x4*)(Lt_s + 1316);
    Lb7 = *(const f32x4*)(Lt_s + 1320);
    Lb8 = *(const f32x4*)(Lt_s + 1324);
    Lb9 = *(const f32x4*)(Lt_s + 1328);
    Lb10 = *(const f32x4*)(Lt_s + 1332);
    Lb11 = *(const f32x4*)(Lt_s + 1336);
    Lb12 = *(const f32x4*)(Lt_s + 1340);
    Lb13 = *(const f32x4*)(Lt_s + 1344);
    Lb14 = *(const f32x4*)(Lt_s + 1348);
    Lb15 = *(const f32x4*)(Lt_s + 1352);
    __builtin_amdgcn_sched_barrier(0);
    { const float xj = X9[0]; const f32x2 xj2 = (f32x2){xj, xj};
      X9 -= (f32x2){La4[2], La4[3]} * xj2;
      X10 -= (f32x2){La5[0], La5[1]} * xj2;
      X11 -= (f32x2){La5[2], La5[3]} * xj2;
      X12 -= (f32x2){La6[0], La6[1]} * xj2;
      X13 -= (f32x2){La6[2], La6[3]} * xj2;
      X14 -= (f32x2){La7[0], La7[1]} * xj2;
      X15 -= (f32x2){La7[2], La7[3]} * xj2;
      X16 -= (f32x2){La8[0], La8[1]} * xj2;
      X17 -= (f32x2){La8[2], La8[3]} * xj2;
      X18 -= (f32x2){La9[0], La9[1]} * xj2;
      X19 -= (f32x2){La9[2], La9[3]} * xj2;
      X20 -= (f32x2){La10[0], La10[1]} * xj2;
      X21 -= (f32x2){La10[2], La10[3]} * xj2;
      X22 -= (f32x2){La11[0], La11[1]} * xj2;
      X23 -= (f32x2){La11[2], La11[3]} * xj2;
      X24 -= (f32x2){La12[0], La12[1]} * xj2;
      X25 -= (f32x2){La12[2], La12[3]} * xj2;
      X26 -= (f32x2){La13[0], La13[1]} * xj2;
      X27 -= (f32x2){La13[2], La13[3]} * xj2;
      X28 -= (f32x2){La14[0], La14[1]} * xj2;
      X29 -= (f32x2){La14[2], La14[3]} * xj2;
      X30 -= (f32x2){La15[0], La15[1]} * xj2;
      X31 -= (f32x2){La15[2], La15[3]} * xj2;
    }
    __builtin_amdgcn_sched_barrier(0);
    La5 = *(const f32x4*)(Lt_s + 1380);
    La6 = *(const f32x4*)(Lt_s + 1384);
    La7 = *(const f32x4*)(Lt_s + 1388);
    La8 = *(const f32x4*)(Lt_s + 1392);
    La9 = *(const f32x4*)(Lt_s + 1396);
    La10 = *(const f32x4*)(Lt_s + 1400);
    La11 = *(const f32x4*)(Lt_s + 1404);
    La12 = *(const f32x4*)(Lt_s + 1408);
    La13 = *(const f32x4*)(Lt_s + 1412);
    La14 = *(const f32x4*)(Lt_s + 1416);
    La15 = *(const f32x4*)(Lt_s + 1420);
    __builtin_amdgcn_sched_barrier(0);
    { const float xj = X9[1]; const f32x2 xj2 = (f32x2){xj, xj};
      X10 -= (f32x2){Lb5[0], Lb5[1]} * xj2;
      X11 -= (f32x2){Lb5[2], Lb5[3]} * xj2;
      X12 -= (f32x2){Lb6[0], Lb6[1]} * xj2;
      X13 -= (f32x2){Lb6[2], Lb6[3]} * xj2;
      X14 -= (f32x2){Lb7[0], Lb7[1]} * xj2;
      X15 -= (f32x2){Lb7[2], Lb7[3]} * xj2;
      X16 -= (f32x2){Lb8[0], Lb8[1]} * xj2;
      X17 -= (f32x2){Lb8[2], Lb8[3]} * xj2;
      X18 -= (f32x2){Lb9[0], Lb9[1]} * xj2;
      X19 -= (f32x2){Lb9[2], Lb9[3]} * xj2;
      X20 -= (f32x2){Lb10[0], Lb10[1]} * xj2;
      X21 -= (f32x2){Lb10[2], Lb10[3]} * xj2;
      X22 -= (f32x2){Lb11[0], Lb11[1]} * xj2;
      X23 -= (f32x2){Lb11[2], Lb11[3]} * xj2;
      X24 -= (f32x2){Lb12[0], Lb12[1]} * xj2;
      X25 -= (f32x2){Lb12[2], Lb12[3]} * xj2;
      X26 -= (f32x2){Lb13[0], Lb13[1]} * xj2;
      X27 -= (f32x2){Lb13[2], Lb13[3]} * xj2;
      X28 -= (f32x2){Lb14[0], Lb14[1]} * xj2;
      X29 -= (f32x2){Lb14[2], Lb14[3]} * xj2;
      X30 -= (f32x2){Lb15[0], Lb15[1]} * xj2;
      X31 -= (f32x2){Lb15[2], Lb15[3]} * xj2;
    }
    __builtin_amdgcn_sched_barrier(0);
    Lb5 = *(const f32x4*)(Lt_s + 1448);
    Lb6 = *(const f32x4*)(Lt_s + 1452);
    Lb7 = *(const f32x4*)(Lt_s + 1456);
    Lb8 = *(const f32x4*)(Lt_s + 1460);
    Lb9 = *(const f32x4*)(Lt_s + 1464);
    Lb10 = *(const f32x4*)(Lt_s + 1468);
    Lb11 = *(const f32x4*)(Lt_s + 1472);
    Lb12 = *(const f32x4*)(Lt_s + 1476);
    Lb13 = *(const f32x4*)(Lt_s + 1480);
    Lb14 = *(const f32x4*)(Lt_s + 1484);
    Lb15 = *(const f32x4*)(Lt_s + 1488);
    __builtin_amdgcn_sched_barrier(0);
    { const float xj = X10[0]; const f32x2 xj2 = (f32x2){xj, xj};
      X10 -= (f32x2){La5[0], La5[1]} * xj2;
      X11 -= (f32x2){La5[2], La5[3]} * xj2;
      X12 -= (f32x2){La6[0], La6[1]} * xj2;
      X13 -= (f32x2){La6[2], La6[3]} * xj2;
      X14 -= (f32x2){La7[0], La7[1]} * xj2;
      X15 -= (f32x2){La7[2], La7[3]} * xj2;
      X16 -= (f32x2){La8[0], La8[1]} * xj2;
      X17 -= (f32x2){La8[2], La8[3]} * xj2;
      X18 -= (f32x2){La9[0], La9[1]} * xj2;
      X19 -= (f32x2){La9[2], La9[3]} * xj2;
      X20 -= (f32x2){La10[0], La10[1]} * xj2;
      X21 -= (f32x2){La10[2], La10[3]} * xj2;
      X22 -= (f32x2){La11[0], La11[1]} * xj2;
      X23 -= (f32x2){La11[2], La11[3]} * xj2;
      X24 -= (f32x2){La12[0], La12[1]} * xj2;
      X25 -= (f32x2){La12[2], La12[3]} * xj2;
      X26 -= (f32x2){La13[0], La13[1]} * xj2;
      X27 -= (f32x2){La13[2], La13[3]} * xj2;
      X28 -= (f32x2){La14[0], La14[1]} * xj2;
      X29 -= (f32x2){La14[2], La14[3]} * xj2;
      X30 -= (f32x2){La15[0], La15[1]} * xj2;
      X31 -= (f32x2){La15[2], La15[3]} * xj2;
    }
    __builtin_amdgcn_sched_barrier(0);
    La5 = *(const f32x4*)(Lt_s + 1516);
    La6 = *(const f32x4*)(Lt_s + 1520);
    La7 = *(const f32x4*)(Lt_s + 1524);
    La8 = *(const f32x4*)(Lt_s + 1528);
    La9 = *(const f32x4*)(Lt_s + 1532);
    La10 = *(const f32x4*)(Lt_s + 1536);
    La11 = *(const f32x4*)(Lt_s + 1540);
    La12 = *(const f32x4*)(Lt_s + 1544);
    La13 = *(const f32x4*)(Lt_s + 1548);
    La14 = *(const f32x4*)(Lt_s + 1552);
    La15 = *(const f32x4*)(Lt_s + 1556);
    __builtin_amdgcn_sched_barrier(0);
    { const float xj = X10[1]; const f32x2 xj2 = (f32x2){xj, xj};
      X11 -= (f32x2){Lb5[2], Lb5[3]} * xj2;
      X12 -= (f32x2){Lb6[0], Lb6[1]} * xj2;
      X13 -= (f32x2){Lb6[2], Lb6[3]} * xj2;
      X14 -= (f32x2){Lb7[0], Lb7[1]} * xj2;
      X15 -= (f32x2){Lb7[2], Lb7[3]} * xj2;
      X16 -= (f32x2){Lb8[0], Lb8[1]} * xj2;
      X17 -= (f32x2){Lb8[2], Lb8[3]} * xj2;
      X18 -= (f32x2){Lb9[0], Lb9[1]} * xj2;
      X19 -= (f32x2){Lb9[2], Lb9[3]} * xj2;
      X20 -= (f32x2){Lb10[0], Lb10[1]} * xj2;
      X21 -= (f32x2){Lb10[2], Lb10[3]} * xj2;
      X22 -= (f32x2){Lb11[0], Lb11[1]} * xj2;
      X23 -= (f32x2){Lb11[2], Lb11[3]} * xj2;
      X24 -= (f32x2){Lb12[0], Lb12[1]} * xj2;
      X25 -= (f32x2){Lb12[2], Lb12[3]} * xj2;
      X26 -= (f32x2){Lb13[0], Lb13[1]} * xj2;
      X27 -= (f32x2){Lb13[2], Lb13[3]} * xj2;
      X28 -= (f32x2){Lb14[0], Lb14[1]} * xj2;
      X29 -= (f32x2){Lb14[2], Lb14[3]} * xj2;
      X30 -= (f32x2){Lb15[0], Lb15[1]} * xj2;
      X31 -= (f32x2){Lb15[2], Lb15[3]} * xj2;
    }
    __builtin_amdgcn_sched_barrier(0);
    Lb6 = *(const f32x4*)(Lt_s + 1588);
    Lb7 = *(const f32x4*)(Lt_s + 1592);
    Lb8 = *(const f32x4*)(Lt_s + 1596);
    Lb9 = *(const f32x4*)(Lt_s + 1600);
    Lb10 = *(const f32x4*)(Lt_s + 1604);
    Lb11 = *(const f32x4*)(Lt_s + 1608);
    Lb12 = *(const f32x4*)(Lt_s + 1612);
    Lb13 = *(const f32x4*)(Lt_s + 1616);
    Lb14 = *(const f32x4*)(Lt_s + 1620);
    Lb15 = *(const f32x4*)(Lt_s + 1624);
    __builtin_amdgcn_sched_barrier(0);
    { const float xj = X11[0]; const f32x2 xj2 = (f32x2){xj, xj};
      X11 -= (f32x2){La5[2], La5[3]} * xj2;
      X12 -= (f32x2){La6[0], La6[1]} * xj2;
      X13 -= (f32x2){La6[2], La6[3]} * xj2;
      X14 -= (f32x2){La7[0], La7[1]} * xj2;
      X15 -= (f32x2){La7[2], La7[3]} * xj2;
      X16 -= (f32x2){La8[0], La8[1]} * xj2;
      X17 -= (f32x2){La8[2], La8[3]} * xj2;
      X18 -= (f32x2){La9[0], La9[1]} * xj2;
      X19 -= (f32x2){La9[2], La9[3]} * xj2;
      X20 -= (f32x2){La10[0], La10[1]} * xj2;
      X21 -= (f32x2){La10[2], La10[3]} * xj2;
      X22 -= (f32x2){La11[0], La11[1]} * xj2;
      X23 -= (f32x2){La11[2], La11[3]} * xj2;
      X24 -= (f32x2){La12[0], La12[1]} * xj2;
      X25 -= (f32x2){La12[2], La12[3]} * xj2;
      X26 -= (f32x2){La13[0], La13[1]} * xj2;
      X27 -= (f32x2){La13[2], La13[3]} * xj2;
      X28 -= (f32x2){La14[0], La14[1]} * xj2;
      X29 -= (f32x2){La14[2], La14[3]} * xj2;
      X30 -= (f32x2){La15[0], La15[1]} * xj2;
      X31 -= (f32x2){La15[2], La15[3]} * xj2;
    }
    __builtin_amdgcn_sched_barrier(0);
    La6 = *(const f32x4*)(Lt_s + 1656);
    La7 = *(const f32x4*)(Lt_s + 1660);
    La8 = *(const f32x4*)(Lt_s + 1664);
    La9 = *(const f32x4*)(Lt_s + 1668);
    La10 = *(const f32x4*)(Lt_s + 1672);
    La11 = *(const f32x4*)(Lt_s + 1676);
    La12 = *(const f32x4*)(Lt_s + 1680);
    La13 = *(const f32x4*)(Lt_s + 1684);
    La14 = *(const f32x4*)(Lt_s + 1688);
    La15 = *(const f32x4*)(Lt_s + 1692);
    __builtin_amdgcn_sched_barrier(0);
    { const float xj = X11[1]; const f32x2 xj2 = (f32x2){xj, xj};
      X12 -= (f32x2){Lb6[0], Lb6[1]} * xj2;
      X13 -= (f32x2){Lb6[2], Lb6[3]} * xj2;
      X14 -= (f32x2){Lb7[0], Lb7[1]} * xj2;
      X15 -= (f32x2){Lb7[2], Lb7[3]} * xj2;
      X16 -= (f32x2){Lb8[0], Lb8[1]} * xj2;
      X17 -= (f32x2){Lb8[2], Lb8[3]} * xj2;
      X18 -= (f32x2){Lb9[0], Lb9[1]} * xj2;
      X19 -= (f32x2){Lb9[2], Lb9[3]} * xj2;
      X20 -= (f32x2){Lb10[0], Lb10[1]} * xj2;
      X21 -= (f32x2){Lb10[2], Lb10[3]} * xj2;
      X22 -= (f32x2){Lb11[0], Lb11[1]} * xj2;
      X23 -= (f32x2){Lb11[2], Lb11[3]} * xj2;
      X24 -= (f32x2){Lb12[0], Lb12[1]} * xj2;
      X25 -= (f32x2){Lb12[2], Lb12[3]} * xj2;
      X26 -= (f32x2){Lb13[0], Lb13[1]} * xj2;
      X27 -= (f32x2){Lb13[2], Lb13[3]} * xj2;
      X28 -= (f32x2){Lb14[0], Lb14[1]} * xj2;
      X29 -= (f32x2){Lb14[2], Lb14[3]} * xj2;
      X30 -= (f32x2){Lb15[0], Lb15[1]} * xj2;
      X31 -= (f32x2){Lb15[2], Lb15[3]} * xj2;
    }
    __builtin_amdgcn_sched_barrier(0);
    Lb6 = *(const f32x4*)(Lt_s + 1724);
    Lb7 = *(const f32x4*)(Lt_s + 1728);
    Lb8 = *(const f32x4*)(Lt_s + 1732);
    Lb9 = *(const f32x4*)(Lt_s + 1736);
    Lb10 = *(const f32x4*)(Lt_s + 1740);
    Lb11 = *(const f32x4*)(Lt_s + 1744);
    Lb12 = *(const f32x4*)(Lt_s + 1748);
    Lb13 = *(const f32x4*)(Lt_s + 1752);
    Lb14 = *(const f32x4*)(Lt_s + 1756);
    Lb15 = *(const f32x4*)(Lt_s + 1760);
    __builtin_amdgcn_sched_barrier(0);
    { const float xj = X12[0]; const f32x2 xj2 = (f32x2){xj, xj};
      X12 -= (f32x2){La6[0], La6[1]} * xj2;
      X13 -= (f32x2){La6[2], La6[3]} * xj2;
      X14 -= (f32x2){La7[0], La7[1]} * xj2;
      X15 -= (f32x2){La7[2], La7[3]} * xj2;
      X16 -= (f32x2){La8[0], La8[1]} * xj2;
      X17 -= (f32x2){La8[2], La8[3]} * xj2;
      X18 -= (f32x2){La9[0], La9[1]} * xj2;
      X19 -= (f32x2){La9[2], La9[3]} * xj2;
      X20 -= (f32x2){La10[0], La10[1]} * xj2;
      X21 -= (f32x2){La10[2], La10[3]} * xj2;
      X22 -= (f32x2){La11[0], La11[1]} * xj2;
      X23 -= (f32x2){La11[2], La11[3]} * xj2;
      X24 -= (f32x2){La12[0], La12[1]} * xj2;
      X25 -= (f32x2){La12[2], La12[3]} * xj2;
      X26 -= (f32x2){La13[0], La13[1]} * xj2;
      X27 -= (f32x2){La13[2], La13[3]} * xj2;
      X28 -= (f32x2){La14[0], La14[1]} * xj2;
      X29 -= (f32x2){La14[2], La14[3]} * xj2;
      X30 -= (f32x2){La15[0], La15[1]} * xj2;
      X31 -= (f32x2){La15[2], La15[3]} * xj2;
    }
    __builtin_amdgcn_sched_barrier(0);
    La6 = *(const f32x4*)(Lt_s + 1792);
    La7 = *(const f32x4*)(Lt_s + 1796);
    La8 = *(const f32x4*)(Lt_s + 1800);
    La9 = *(const f32x4*)(Lt_s + 1804);
    La10 = *(const f32x4*)(Lt_s + 1808);
    La11 = *(const f32x4*)(Lt_s + 1812);
    La12 = *(const f32x4*)(Lt_s + 1816);
    La13 = *(const f32x4*)(Lt_s + 1820);
    La14 = *(const f32x4*)(Lt_s + 1824);
    La15 = *(const f32x4*)(Lt_s + 1828);
    __builtin_amdgcn_sched_barrier(0);
    { const float xj = X12[1]; const f32x2 xj2 = (f32x2){xj, xj};
      X13 -= (f32x2){Lb6[2], Lb6[3]} * xj2;
      X14 -= (f32x2){Lb7[0], Lb7[1]} * xj2;
      X15 -= (f32x2){Lb7[2], Lb7[3]} * xj2;
      X16 -= (f32x2){Lb8[0], Lb8[1]} * xj2;
      X17 -= (f32x2){Lb8[2], Lb8[3]} * xj2;
      X18 -= (f32x2){Lb9[0], Lb9[1]} * xj2;
      X19 -= (f32x2){Lb9[2], Lb9[3]} * xj2;
      X20 -= (f32x2){Lb10[0], Lb10[1]} * xj2;
      X21 -= (f32x2){Lb10[2], Lb10[3]} * xj2;
      X22 -= (f32x2){Lb11[0], Lb11[1]} * xj2;
      X23 -= (f32x2){Lb11[2], Lb11[3]} * xj2;
      X24 -= (f32x2){Lb12[0], Lb12[1]} * xj2;
      X25 -= (f32x2){Lb12[2], Lb12[3]} * xj2;
      X26 -= (f32x2){Lb13[0], Lb13[1]} * xj2;
      X27 -= (f32x2){Lb13[2], Lb13[3]} * xj2;
      X28 -= (f32x2){Lb14[0], Lb14[1]} * xj2;
      X29 -= (f32x2){Lb14[2], Lb14[3]} * xj2;
      X30 -= (f32x2){Lb15[0], Lb15[1]} * xj2;
      X31 -= (f32x2){Lb15[2], Lb15[3]} * xj2;
    }
    __builtin_amdgcn_sched_barrier(0);
    Lb7 = *(const f32x4*)(Lt_s + 1864);
    Lb8 = *(const f32x4*)(Lt_s + 1868);
    Lb9 = *(const f32x4*)(Lt_s + 1872);
    Lb10 = *(const f32x4*)(Lt_s + 1876);
    Lb11 = *(const f32x4*)(Lt_s + 1880);
    Lb12 = *(const f32x4*)(Lt_s + 1884);
    Lb13 = *(const f32x4*)(Lt_s + 1888);
    Lb14 = *(const f32x4*)(Lt_s + 1892);
    Lb15 = *(const f32x4*)(Lt_s + 1896);
    __builtin_amdgcn_sched_barrier(0);
    { const float xj = X13[0]; const f32x2 xj2 = (f32x2){xj, xj};
      X13 -= (f32x2){La6[2], La6[3]} * xj2;
      X14 -= (f32x2){La7[0], La7[1]} * xj2;
      X15 -= (f32x2){La7[2], La7[3]} * xj2;
      X16 -= (f32x2){La8[0], La8[1]} * xj2;
      X17 -= (f32x2){La8[2], La8[3]} * xj2;
      X18 -= (f32x2){La9[0], La9[1]} * xj2;
      X19 -= (f32x2){La9[2], La9[3]} * xj2;
      X20 -= (f32x2){La10[0], La10[1]} * xj2;
      X21 -= (f32x2){La10[2], La10[3]} * xj2;
      X22 -= (f32x2){La11[0], La11[1]} * xj2;
      X23 -= (f32x2){La11[2], La11[3]} * xj2;
      X24 -= (f32x2){La12[0], La12[1]} * xj2;
      X25 -= (f32x2){La12[2], La12[3]} * xj2;
      X26 -= (f32x2){La13[0], La13[1]} * xj2;
      X27 -= (f32x2){La13[2], La13[3]} * xj2;
      X28 -= (f32x2){La14[0], La14[1]} * xj2;
      X29 -= (f32x2){La14[2], La14[3]} * xj2;
      X30 -= (f32x2){La15[0], La15[1]} * xj2;
      X31 -= (f32x2){La15[2], La15[3]} * xj2;
    }
    __builtin_amdgcn_sched_barrier(0);
    La7 = *(const f32x4*)(Lt_s + 1932);
    La8 = *(const f32x4*)(Lt_s + 1936);
    La9 = *(const f32x4*)(Lt_s + 1940);
    La10 = *(const f32x4*)(Lt_s + 1944);
    La11 = *(const f32x4*)(Lt_s + 1948);
    La12 = *(const f32x4*)(Lt_s + 1952);
    La13 = *(const f32x4*)(Lt_s + 1956);
    La14 = *(const f32x4*)(Lt_s + 1960);
    La15 = *(const f32x4*)(Lt_s + 1964);
    __builtin_amdgcn_sched_barrier(0);
    { const float xj = X13[1]; const f32x2 xj2 = (f32x2){xj, xj};
      X14 -= (f32x2){Lb7[0], Lb7[1]} * xj2;
      X15 -= (f32x2){Lb7[2], Lb7[3]} * xj2;
      X16 -= (f32x2){Lb8[0], Lb8[1]} * xj2;
      X17 -= (f32x2){Lb8[2], Lb8[3]} * xj2;
      X18 -= (f32x2){Lb9[0], Lb9[1]} * xj2;
      X19 -= (f32x2){Lb9[2], Lb9[3]} * xj2;
      X20 -= (f32x2){Lb10[0], Lb10[1]} * xj2;
      X21 -= (f32x2){Lb10[2], Lb10[3]} * xj2;
      X22 -= (f32x2){Lb11[0], Lb11[1]} * xj2;
      X23 -= (f32x2){Lb11[2], Lb11[3]} * xj2;
      X24 -= (f32x2){Lb12[0], Lb12[1]} * xj2;
      X25 -= (f32x2){Lb12[2], Lb12[3]} * xj2;
      X26 -= (f32x2){Lb13[0], Lb13[1]} * xj2;
      X27 -= (f32x2){Lb13[2], Lb13[3]} * xj2;
      X28 -= (f32x2){Lb14[0], Lb14[1]} * xj2;
      X29 -= (f32x2){Lb14[2], Lb14[3]} * xj2;
      X30 -= (f32x2){Lb15[0], Lb15[1]} * xj2;
      X31 -= (f32x2){Lb15[2], Lb15[3]} * xj2;
    }
    __builtin_amdgcn_sched_barrier(0);
    Lb7 = *(const f32x4*)(Lt_s + 2000);
    Lb8 = *(const f32x4*)(Lt_s + 2004);
    Lb9 = *(const f32x4*)(Lt_s + 2008);
    Lb10 = *(const f32x4*)(Lt_s + 2012);
    Lb11 = *(const f32x4*)(Lt_s + 2016);
    Lb12 = *(const f32x4*)(Lt_s + 2020);
    Lb13 = *(const f32x4*)(Lt_s + 2024);
    Lb14 = *(const f32x4*)(Lt_s + 2028);
    Lb15 = *(const f32x4*)(Lt_s + 2032);
    __builtin_amdgcn_sched_barrier(0);
    { const float xj = X14[0]; const f32x2 xj2 = (f32x2){xj, xj};
      X14 -= (f32x2){La7[0], La7[1]} * xj2;
      X15 -= (f32x2){La7[2], La7[3]} * xj2;
      X16 -= (f32x2){La8[0], La8[1]} * xj2;
      X17 -= (f32x2){La8[2], La8[3]} * xj2;
      X18 -= (f32x2){La9[0], La9[1]} * xj2;
      X19 -= (f32x2){La9[2], La9[3]} * xj2;
      X20 -= (f32x2){La10[0], La10[1]} * xj2;
      X21 -= (f32x2){La10[2], La10[3]} * xj2;
      X22 -= (f32x2){La11[0], La11[1]} * xj2;
      X23 -= (f32x2){La11[2], La11[3]} * xj2;
      X24 -= (f32x2){La12[0], La12[1]} * xj2;
      X25 -= (f32x2){La12[2], La12[3]} * xj2;
      X26 -= (f32x2){La13[0], La13[1]} * xj2;
      X27 -= (f32x2){La13[2], La13[3]} * xj2;
      X28 -= (f32x2){La14[0], La14[1]} * xj2;
      X29 -= (f32x2){La14[2], La14[3]} * xj2;
      X30 -= (f32x2){La15[0], La15[1]} * xj2;
      X31 -= (f32x2){La15[2], La15[3]} * xj2;
    }
    __builtin_amdgcn_sched_barrier(0);
    La7 = *(const f32x4*)(Lt_s + 2068);
    La8 = *(const f32x4*)(Lt_s + 2072);
    La9 = *(const f32x4*)(Lt_s + 2076);
    La10 = *(const f32x4*)(Lt_s + 2080);
    La11 = *(const f32x4*)(Lt_s + 2084);
    La12 = *(const f32x4*)(Lt_s + 2088);
    La13 = *(const f32x4*)(Lt_s + 2092);
    La14 = *(const f32x4*)(Lt_s + 2096);
    La15 = *(const f32x4*)(Lt_s + 2100);
    __builtin_amdgcn_sched_barrier(0);
    { const float xj = X14[1]; const f32x2 xj2 = (f32x2){xj, xj};
      X15 -= (f32x2){Lb7[2], Lb7[3]} * xj2;
      X16 -= (f32x2){Lb8[0], Lb8[1]} * xj2;
      X17 -= (f32x2){Lb8[2], Lb8[3]} * xj2;
      X18 -= (f32x2){Lb9[0], Lb9[1]} * xj2;
      X19 -= (f32x2){Lb9[2], Lb9[3]} * xj2;
      X20 -= (f32x2){Lb10[0], Lb10[1]} * xj2;
      X21 -= (f32x2){Lb10[2], Lb10[3]} * xj2;
      X22 -= (f32x2){Lb11[0], Lb11[1]} * xj2;
      X23 -= (f32x2){Lb11[2], Lb11[3]} * xj2;
      X24 -= (f32x2){Lb12[0], Lb12[1]} * xj2;
      X25 -= (f32x2){Lb12[2], Lb12[3]} * xj2;
      X26 -= (f32x2){Lb13[0], Lb13[1]} * xj2;
      X27 -= (f32x2){Lb13[2], Lb13[3]} * xj2;
      X28 -= (f32x2){Lb14[0], Lb14[1]} * xj2;
      X29 -= (f32x2){Lb14[2], Lb14[3]} * xj2;
      X30 -= (f32x2){Lb15[0], Lb15[1]} * xj2;
      X31 -= (f32x2){Lb15[2], Lb15[3]} * xj2;
    }
    __builtin_amdgcn_sched_barrier(0);
    Lb8 = *(const f32x4*)(Lt_s + 2140);
    Lb9 = *(const f32x4*)(Lt_s + 2144);
    Lb10 = *(const f32x4*)(Lt_s + 2148);
    Lb11 = *(const f32x4*)(Lt_s + 2152);
    Lb12 = *(const f32x4*)(Lt_s + 2156);
    Lb13 = *(const f32x4*)(Lt_s + 2160);
    Lb14 = *(const f32x4*)(Lt_s + 2164);
    Lb15 = *(const f32x4*)(Lt_s + 2168);
    __builtin_amdgcn_sched_barrier(0);
    { const float xj = X15[0]; const f32x2 xj2 = (f32x2){xj, xj};
      X15 -= (f32x2){La7[2], La7[3]} * xj2;
      X16 -= (f32x2){La8[0], La8[1]} * xj2;
      X17 -= (f32x2){La8[2], La8[3]} * xj2;
      X18 -= (f32x2){La9[0], La9[1]} * xj2;
      X19 -= (f32x2){La9[2], La9[3]} * xj2;
      X20 -= (f32x2){La10[0], La10[1]} * xj2;
      X21 -= (f32x2){La10[2], La10[3]} * xj2;
      X22 -= (f32x2){La11[0], La11[1]} * xj2;
      X23 -= (f32x2){La11[2], La11[3]} * xj2;
      X24 -= (f32x2){La12[0], La12[1]} * xj2;
      X25 -= (f32x2){La12[2], La12[3]} * xj2;
      X26 -= (f32x2){La13[0], La13[1]} * xj2;
      X27 -= (f32x2){La13[2], La13[3]} * xj2;
      X28 -= (f32x2){La14[0], La14[1]} * xj2;
      X29 -= (f32x2){La14[2], La14[3]} * xj2;
      X30 -= (f32x2){La15[0], La15[1]} * xj2;
      X31 -= (f32x2){La15[2], La15[3]} * xj2;
    }
    __builtin_amdgcn_sched_barrier(0);
    La8 = *(const f32x4*)(Lt_s + 2208);
    La9 = *(const f32x4*)(Lt_s + 2212);
    La10 = *(const f32x4*)(Lt_s + 2216);
    La11 = *(const f32x4*)(Lt_s + 2220);
    La12 = *(const f32x4*)(Lt_s + 2224);
    La13 = *(const f32x4*)(Lt_s + 2228);
    La14 = *(const f32x4*)(Lt_s + 2232);
    La15 = *(const f32x4*)(Lt_s + 2236);
    __builtin_amdgcn_sched_barrier(0);
    { const float xj = X15[1]; const f32x2 xj2 = (f32x2){xj, xj};
      X16 -= (f32x2){Lb8[0], Lb8[1]} * xj2;
      X17 -= (f32x2){Lb8[2], Lb8[3]} * xj2;
      X18 -= (f32x2){Lb9[0], Lb9[1]} * xj2;
      X19 -= (f32x2){Lb9[2], Lb9[3]} * xj2;
      X20 -= (f32x2){Lb10[0], Lb10[1]} * xj2;
      X21 -= (f32x2){Lb10[2], Lb10[3]} * xj2;
      X22 -= (f32x2){Lb11[0], Lb11[1]} * xj2;
      X23 -= (f32x2){Lb11[2], Lb11[3]} * xj2;
      X24 -= (f32x2){Lb12[0], Lb12[1]} * xj2;
      X25 -= (f32x2){Lb12[2], Lb12[3]} * xj2;
      X26 -= (f32x2){Lb13[0], Lb13[1]} * xj2;
      X27 -= (f32x2){Lb13[2], Lb13[3]} * xj2;
      X28 -= (f32x2){Lb14[0], Lb14[1]} * xj2;
      X29 -= (f32x2){Lb14[2], Lb14[3]} * xj2;
      X30 -= (f32x2){Lb15[0], Lb15[1]} * xj2;
      X31 -= (f32x2){Lb15[2], Lb15[3]} * xj2;
    }
    __builtin_amdgcn_sched_barrier(0);
    Lb8 = *(const f32x4*)(Lt_s + 2276);
    Lb9 = *(const f32x4*)(Lt_s + 2280);
    Lb10 = *(const f32x4*)(Lt_s + 2284);
    Lb11 = *(const f32x4*)(Lt_s + 2288);
    Lb12 = *(const f32x4*)(Lt_s + 2292);
    Lb13 = *(const f32x4*)(Lt_s + 2296);
    Lb14 = *(const f32x4*)(Lt_s + 2300);
    Lb15 = *(const f32x4*)(Lt_s + 2304);
    __builtin_amdgcn_sched_barrier(0);
    { const float xj = X16[0]; const f32x2 xj2 = (f32x2){xj, xj};
      X16 -= (f32x2){La8[0], La8[1]} * xj2;
      X17 -= (f32x2){La8[2], La8[3]} * xj2;
      X18 -= (f32x2){La9[0], La9[1]} * xj2;
      X19 -= (f32x2){La9[2], La9[3]} * xj2;
      X20 -= (f32x2){La10[0], La10[1]} * xj2;
      X21 -= (f32x2){La10[2], La10[3]} * xj2;
      X22 -= (f32x2){La11[0], La11[1]} * xj2;
      X23 -= (f32x2){La11[2], La11[3]} * xj2;
      X24 -= (f32x2){La12[0], La12[1]} * xj2;
      X25 -= (f32x2){La12[2], La12[3]} * xj2;
      X26 -= (f32x2){La13[0], La13[1]} * xj2;
      X27 -= (f32x2){La13[2], La13[3]} * xj2;
      X28 -= (f32x2){La14[0], La14[1]} * xj2;
      X29 -= (f32x2){La14[2], La14[3]} * xj2;
      X30 -= (f32x2){La15[0], La15[1]} * xj2;
      X31 -= (f32x2){La15[2], La15[3]} * xj2;
    }
    __builtin_amdgcn_sched_barrier(0);
    La8 = *(const f32x4*)(Lt_s + 2344);
    La9 = *(const f32x4*)(Lt_s + 2348);
    La10 = *(const f32x4*)(Lt_s + 2352);
    La11 = *(const f32x4*)(Lt_s + 2356);
    La12 = *(const f32x4*)(Lt_s + 2360);
    La13 = *(const f32x4*)(Lt_s + 2364);
    La14 = *(const f32x4*)(Lt_s + 2368);
    La15 = *(const f32x4*)(Lt_s + 2372);
    __builtin_amdgcn_sched_barrier(0);
    { const float xj = X16[1]; const f32x2 xj2 = (f32x2){xj, xj};
      X17 -= (f32x2){Lb8[2], Lb8[3]} * xj2;
      X18 -= (f32x2){Lb9[0], Lb9[1]} * xj2;
      X19 -= (f32x2){Lb9[2], Lb9[3]} * xj2;
      X20 -= (f32x2){Lb10[0], Lb10[1]} * xj2;
      X21 -= (f32x2){Lb10[2], Lb10[3]} * xj2;
      X22 -= (f32x2){Lb11[0], Lb11[1]} * xj2;
      X23 -= (f32x2){Lb11[2], Lb11[3]} * xj2;
      X24 -= (f32x2){Lb12[0], Lb12[1]} * xj2;
      X25 -= (f32x2){Lb12[2], Lb12[3]} * xj2;
      X26 -= (f32x2){Lb13[0], Lb13[1]} * xj2;
      X27 -= (f32x2){Lb13[2], Lb13[3]} * xj2;
      X28 -= (f32x2){Lb14[0], Lb14[1]} * xj2;
      X29 -= (f32x2){Lb14[2], Lb14[3]} * xj2;
      X30 -= (f32x2){Lb15[0], Lb15[1]} * xj2;
      X31 -= (f32x2){Lb15[2], Lb15[3]} * xj2;
    }
    __builtin_amdgcn_sched_barrier(0);
    Lb9 = *(const f32x4*)(Lt_s + 2416);
    Lb10 = *(const f32x4*)(Lt_s + 2420);
    Lb11 = *(const f32x4*)(Lt_s + 2424);
    Lb12 = *(const f32x4*)(Lt_s + 2428);
    Lb13 = *(const f32x4*)(Lt_s + 2432);
    Lb14 = *(const f32x4*)(Lt_s + 2436);
    Lb15 = *(const f32x4*)(Lt_s + 2440);
    __builtin_amdgcn_sched_barrier(0);
    { const float xj = X17[0]; const f32x2 xj2 = (f32x2){xj, xj};
      X17 -= (f32x2){La8[2], La8[3]} * xj2;
      X18 -= (f32x2){La9[0], La9[1]} * xj2;
      X19 -= (f32x2){La9[2], La9[3]} * xj2;
      X20 -= (f32x2){La10[0], La10[1]} * xj2;
      X21 -= (f32x2){La10[2], La10[3]} * xj2;
      X22 -= (f32x2){La11[0], La11[1]} * xj2;
      X23 -= (f32x2){La11[2], La11[3]} * xj2;
      X24 -= (f32x2){La12[0], La12[1]} * xj2;
      X25 -= (f32x2){La12[2], La12[3]} * xj2;
      X26 -= (f32x2){La13[0], La13[1]} * xj2;
      X27 -= (f32x2){La13[2], La13[3]} * xj2;
      X28 -= (f32x2){La14[0], La14[1]} * xj2;
      X29 -= (f32x2){La14[2], La14[3]} * xj2;
      X30 -= (f32x2){La15[0], La15[1]} * xj2;
      X31 -= (f32x2){La15[2], La15[3]} * xj2;
    }
    __builtin_amdgcn_sched_barrier(0);
    La9 = *(const f32x4*)(Lt_s + 2484);
    La10 = *(const f32x4*)(Lt_s + 2488);
    La11 = *(const f32x4*)(Lt_s + 2492);
    La12 = *(const f32x4*)(Lt_s + 2496);
    La13 = *(const f32x4*)(Lt_s + 2500);
    La14 = *(const f32x4*)(Lt_s + 2504);
    La15 = *(const f32x4*)(Lt_s + 2508);
    __builtin_amdgcn_sched_barrier(0);
    { const float xj = X17[1]; const f32x2 xj2 = (f32x2){xj, xj};
      X18 -= (f32x2){Lb9[0], Lb9[1]} * xj2;
      X19 -= (f32x2){Lb9[2], Lb9[3]} * xj2;
      X20 -= (f32x2){Lb10[0], Lb10[1]} * xj2;
      X21 -= (f32x2){Lb10[2], Lb10[3]} * xj2;
      X22 -= (f32x2){Lb11[0], Lb11[1]} * xj2;
      X23 -= (f32x2){Lb11[2], Lb11[3]} * xj2;
      X24 -= (f32x2){Lb12[0], Lb12[1]} * xj2;
      X25 -= (f32x2){Lb12[2], Lb12[3]} * xj2;
      X26 -= (f32x2){Lb13[0], Lb13[1]} * xj2;
      X27 -= (f32x2){Lb13[2], Lb13[3]} * xj2;
      X28 -= (f32x2){Lb14[0], Lb14[1]} * xj2;
      X29 -= (f32x2){Lb14[2], Lb14[3]} * xj2;
      X30 -= (f32x2){Lb15[0], Lb15[1]} * xj2;
      X31 -= (f32x2){Lb15[2], Lb15[3]} * xj2;
    }
    __builtin_amdgcn_sched_barrier(0);
    Lb9 = *(const f32x4*)(Lt_s + 2552);
    Lb10 = *(const f32x4*)(Lt_s + 2556);
    Lb11 = *(const f32x4*)(Lt_s + 2560);
    Lb12 = *(const f32x4*)(Lt_s + 2564);
    Lb13 = *(const f32x4*)(Lt_s + 2568);
    Lb14 = *(const f32x4*)(Lt_s + 2572);
    Lb15 = *(const f32x4*)(Lt_s + 2576);
    __builtin_amdgcn_sched_barrier(0);
    { const float xj = X18[0]; const f32x2 xj2 = (f32x2){xj, xj};
      X18 -= (f32x2){La9[0], La9[1]} * xj2;
      X19 -= (f32x2){La9[2], La9[3]} * xj2;
      X20 -= (f32x2){La10[0], La10[1]} * xj2;
      X21 -= (f32x2){La10[2], La10[3]} * xj2;
      X22 -= (f32x2){La11[0], La11[1]} * xj2;
      X23 -= (f32x2){La11[2], La11[3]} * xj2;
      X24 -= (f32x2){La12[0], La12[1]} * xj2;
      X25 -= (f32x2){La12[2], La12[3]} * xj2;
      X26 -= (f32x2){La13[0], La13[1]} * xj2;
      X27 -= (f32x2){La13[2], La13[3]} * xj2;
      X28 -= (f32x2){La14[0], La14[1]} * xj2;
      X29 -= (f32x2){La14[2], La14[3]} * xj2;
      X30 -= (f32x2){La15[0], La15[1]} * xj2;
      X31 -= (f32x2){La15[2], La15[3]} * xj2;
    }
    __builtin_amdgcn_sched_barrier(0);
    La9 = *(const f32x4*)(Lt_s + 2620);
    La10 = *(const f32x4*)(Lt_s + 2624);
    La11 = *(const f32x4*)(Lt_s + 2628);
    La12 = *(const f32x4*)(Lt_s + 2632);
    La13 = *(const f32x4*)(Lt_s + 2636);
    La14 = *(const f32x4*)(Lt_s + 2640);
    La15 = *(const f32x4*)(Lt_s + 2644);
    __builtin_amdgcn_sched_barrier(0);
    { const float xj = X18[1]; const f32x2 xj2 = (f32x2){xj, xj};
      X19 -= (f32x2){Lb9[2], Lb9[3]} * xj2;
      X20 -= (f32x2){Lb10[0], Lb10[1]} * xj2;
      X21 -= (f32x2){Lb10[2], Lb10[3]} * xj2;
      X22 -= (f32x2){Lb11[0], Lb11[1]} * xj2;
      X23 -= (f32x2){Lb11[2], Lb11[3]} * xj2;
      X24 -= (f32x2){Lb12[0], Lb12[1]} * xj2;
      X25 -= (f32x2){Lb12[2], Lb12[3]} * xj2;
      X26 -= (f32x2){Lb13[0], Lb13[1]} * xj2;
      X27 -= (f32x2){Lb13[2], Lb13[3]} * xj2;
      X28 -= (f32x2){Lb14[0], Lb14[1]} * xj2;
      X29 -= (f32x2){Lb14[2], Lb14[3]} * xj2;
      X30 -= (f32x2){Lb15[0], Lb15[1]} * xj2;
      X31 -= (f32x2){Lb15[2], Lb15[3]} * xj2;
    }
    __builtin_amdgcn_sched_barrier(0);
    Lb10 = *(const f32x4*)(Lt_s + 2692);
    Lb11 = *(const f32x4*)(Lt_s + 2696);
    Lb12 = *(const f32x4*)(Lt_s + 2700);
    Lb13 = *(const f32x4*)(Lt_s + 2704);
    Lb14 = *(const f32x4*)(Lt_s + 2708);
    Lb15 = *(const f32x4*)(Lt_s + 2712);
    __builtin_amdgcn_sched_barrier(0);
    { const float xj = X19[0]; const f32x2 xj2 = (f32x2){xj, xj};
      X19 -= (f32x2){La9[2], La9[3]} * xj2;
      X20 -= (f32x2){La10[0], La10[1]} * xj2;
      X21 -= (f32x2){La10[2], La10[3]} * xj2;
      X22 -= (f32x2){La11[0], La11[1]} * xj2;
      X23 -= (f32x2){La11[2], La11[3]} * xj2;
      X24 -= (f32x2){La12[0], La12[1]} * xj2;
      X25 -= (f32x2){La12[2], La12[3]} * xj2;
      X26 -= (f32x2){La13[0], La13[1]} * xj2;
      X27 -= (f32x2){La13[2], La13[3]} * xj2;
      X28 -= (f32x2){La14[0], La14[1]} * xj2;
      X29 -= (f32x2){La14[2], La14[3]} * xj2;
      X30 -= (f32x2){La15[0], La15[1]} * xj2;
      X31 -= (f32x2){La15[2], La15[3]} * xj2;
    }
    __builtin_amdgcn_sched_barrier(0);
    La10 = *(const f32x4*)(Lt_s + 2760);
    La11 = *(const f32x4*)(Lt_s + 2764);
    La12 = *(const f32x4*)(Lt_s + 2768);
    La13 = *(const f32x4*)(Lt_s + 2772);
    La14 = *(const f32x4*)(Lt_s + 2776);
    La15 = *(const f32x4*)(Lt_s + 2780);
    __builtin_amdgcn_sched_barrier(0);
    { const float xj = X19[1]; const f32x2 xj2 = (f32x2){xj, xj};
      X20 -= (f32x2){Lb10[0], Lb10[1]} * xj2;
      X21 -= (f32x2){Lb10[2], Lb10[3]} * xj2;
      X22 -= (f32x2){Lb11[0], Lb11[1]} * xj2;
      X23 -= (f32x2){Lb11[2], Lb11[3]} * xj2;
      X24 -= (f32x2){Lb12[0], Lb12[1]} * xj2;
      X25 -= (f32x2){Lb12[2], Lb12[3]} * xj2;
      X26 -= (f32x2){Lb13[0], Lb13[1]} * xj2;
      X27 -= (f32x2){Lb13[2], Lb13[3]} * xj2;
      X28 -= (f32x2){Lb14[0], Lb14[1]} * xj2;
      X29 -= (f32x2){Lb14[2], Lb14[3]} * xj2;
      X30 -= (f32x2){Lb15[0], Lb15[1]} * xj2;
      X31 -= (f32x2){Lb15[2], Lb15[3]} * xj2;
    }
    __builtin_amdgcn_sched_barrier(0);
    Lb10 = *(const f32x4*)(Lt_s + 2828);
    Lb11 = *(const f32x4*)(Lt_s + 2832);
    Lb12 = *(const f32x4*)(Lt_s + 2836);
    Lb13 = *(const f32x4*)(Lt_s + 2840);
    Lb14 = *(const f32x4*)(Lt_s + 2844);
    Lb15 = *(const f32x4*)(Lt_s + 2848);
    __builtin_amdgcn_sched_barrier(0);
    { const float xj = X20[0]; const f32x2 xj2 = (f32x2){xj, xj};
      X20 -= (f32x2){La10[0], La10[1]} * xj2;
      X21 -= (f32x2){La10[2], La10[3]} * xj2;
      X22 -= (f32x2){La11[0], La11[1]} * xj2;
      X23 -= (f32x2){La11[2], La11[3]} * xj2;
      X24 -= (f32x2){La12[0], La12[1]} * xj2;
      X25 -= (f32x2){La12[2], La12[3]} * xj2;
      X26 -= (f32x2){La13[0], La13[1]} * xj2;
      X27 -= (f32x2){La13[2], La13[3]} * xj2;
      X28 -= (f32x2){La14[0], La14[1]} * xj2;
      X29 -= (f32x2){La14[2], La14[3]} * xj2;
      X30 -= (f32x2){La15[0], La15[1]} * xj2;
      X31 -= (f32x2){La15[2], La15[3]} * xj2;
    }
    __builtin_amdgcn_sched_barrier(0);
    La10 = *(const f32x4*)(Lt_s + 2896);
    La11 = *(const f32x4*)(Lt_s + 2900);
    La12 = *(const f32x4*)(Lt_s + 2904);
    La13 = *(const f32x4*)(Lt_s + 2908);
    La14 = *(const f32x4*)(Lt_s + 2912);
    La15 = *(const f32x4*)(Lt_s + 2916);
    __builtin_amdgcn_sched_barrier(0);
    { const float xj = X20[1]; const f32x2 xj2 = (f32x2){xj, xj};
      X21 -= (f32x2){Lb10[2], Lb10[3]} * xj2;
      X22 -= (f32x2){Lb11[0], Lb11[1]} * xj2;
      X23 -= (f32x2){Lb11[2], Lb11[3]} * xj2;
      X24 -= (f32x2){Lb12[0], Lb12[1]} * xj2;
      X25 -= (f32x2){Lb12[2], Lb12[3]} * xj2;
      X26 -= (f32x2){Lb13[0], Lb13[1]} * xj2;
      X27 -= (f32x2){Lb13[2], Lb13[3]} * xj2;
      X28 -= (f32x2){Lb14[0], Lb14[1]} * xj2;
      X29 -= (f32x2){Lb14[2], Lb14[3]} * xj2;
      X30 -= (f32x2){Lb15[0], Lb15[1]} * xj2;
      X31 -= (f32x2){Lb15[2], Lb15[3]} * xj2;
    }
    __builtin_amdgcn_sched_barrier(0);
    Lb11 = *(const f32x4*)(Lt_s + 2968);
    Lb12 = *(const f32x4*)(Lt_s + 2972);
    Lb13 = *(const f32x4*)(Lt_s + 2976);
    Lb14 = *(const f32x4*)(Lt_s + 2980);
    Lb15 = *(const f32x4*)(Lt_s + 2984);
    __builtin_amdgcn_sched_barrier(0);
    { const float xj = X21[0]; const f32x2 xj2 = (f32x2){xj, xj};
      X21 -= (f32x2){La10[2], La10[3]} * xj2;
      X22 -= (f32x2){La11[0], La11[1]} * xj2;
      X23 -= (f32x2){La11[2], La11[3]} * xj2;
      X24 -= (f32x2){La12[0], La12[1]} * xj2;
      X25 -= (f32x2){La12[2], La12[3]} * xj2;
      X26 -= (f32x2){La13[0], La13[1]} * xj2;
      X27 -= (f32x2){La13[2], La13[3]} * xj2;
      X28 -= (f32x2){La14[0], La14[1]} * xj2;
      X29 -= (f32x2){La14[2], La14[3]} * xj2;
      X30 -= (f32x2){La15[0], La15[1]} * xj2;
      X31 -= (f32x2){La15[2], La15[3]} * xj2;
    }
    __builtin_amdgcn_sched_barrier(0);
    La11 = *(const f32x4*)(Lt_s + 3036);
    La12 = *(const f32x4*)(Lt_s + 3040);
    La13 = *(const f32x4*)(Lt_s + 3044);
    La14 = *(const f32x4*)(Lt_s + 3048);
    La15 = *(const f32x4*)(Lt_s + 3052);
    __builtin_amdgcn_sched_barrier(0);
    { const float xj = X21[1]; const f32x2 xj2 = (f32x2){xj, xj};
      X22 -= (f32x2){Lb11[0], Lb11[1]} * xj2;
      X23 -= (f32x2){Lb11[2], Lb11[3]} * xj2;
      X24 -= (f32x2){Lb12[0], Lb12[1]} * xj2;
      X25 -= (f32x2){Lb12[2], Lb12[3]} * xj2;
      X26 -= (f32x2){Lb13[0], Lb13[1]} * xj2;
      X27 -= (f32x2){Lb13[2], Lb13[3]} * xj2;
      X28 -= (f32x2){Lb14[0], Lb14[1]} * xj2;
      X29 -= (f32x2){Lb14[2], Lb14[3]} * xj2;
      X30 -= (f32x2){Lb15[0], Lb15[1]} * xj2;
      X31 -= (f32x2){Lb15[2], Lb15[3]} * xj2;
    }
    __builtin_amdgcn_sched_barrier(0);
    Lb11 = *(const f32x4*)(Lt_s + 3104);
    Lb12 = *(const f32x4*)(Lt_s + 3108);
    Lb13 = *(const f32x4*)(Lt_s + 3112);
    Lb14 = *(const f32x4*)(Lt_s + 3116);
    Lb15 = *(const f32x4*)(Lt_s + 3120);
    __builtin_amdgcn_sched_barrier(0);
    { const float xj = X22[0]; const f32x2 xj2 = (f32x2){xj, xj};
      X22 -= (f32x2){La11[0], La11[1]} * xj2;
      X23 -= (f32x2){La11[2], La11[3]} * xj2;
      X24 -= (f32x2){La12[0], La12[1]} * xj2;
      X25 -= (f32x2){La12[2], La12[3]} * xj2;
      X26 -= (f32x2){La13[0], La13[1]} * xj2;
      X27 -= (f32x2){La13[2], La13[3]} * xj2;
      X28 -= (f32x2){La14[0], La14[1]} * xj2;
      X29 -= (f32x2){La14[2], La14[3]} * xj2;
      X30 -= (f32x2){La15[0], La15[1]} * xj2;
      X31 -= (f32x2){La15[2], La15[3]} * xj2;
    }
    __builtin_amdgcn_sched_barrier(0);
    La11 = *(const f32x4*)(Lt_s + 3172);
    La12 = *(const f32x4*)(Lt_s + 3176);
    La13 = *(const f32x4*)(Lt_s + 3180);
    La14 = *(const f32x4*)(Lt_s + 3184);
    La15 = *(const f32x4*)(Lt_s + 3188);
    __builtin_amdgcn_sched_barrier(0);
    { const float xj = X22[1]; const f32x2 xj2 = (f32x2){xj, xj};
      X23 -= (f32x2){Lb11[2], Lb11[3]} * xj2;
      X24 -= (f32x2){Lb12[0], Lb12[1]} * xj2;
      X25 -= (f32x2){Lb12[2], Lb12[3]} * xj2;
      X26 -= (f32x2){Lb13[0], Lb13[1]} * xj2;
      X27 -= (f32x2){Lb13[2], Lb13[3]} * xj2;
      X28 -= (f32x2){Lb14[0], Lb14[1]} * xj2;
      X29 -= (f32x2){Lb14[2], Lb14[3]} * xj2;
      X30 -= (f32x2){Lb15[0], Lb15[1]} * xj2;
      X31 -= (f32x2){Lb15[2], Lb15[3]} * xj2;
    }
    __builtin_amdgcn_sched_barrier(0);
    Lb12 = *(const f32x4*)(Lt_s + 3244);
    Lb13 = *(const f32x4*)(Lt_s + 3248);
    Lb14 = *(const f32x4*)(Lt_s + 3252);
    Lb15 = *(const f32x4*)(Lt_s + 3256);
    __builtin_amdgcn_sched_barrier(0);
    { const float xj = X23[0]; const f32x2 xj2 = (f32x2){xj, xj};
      X23 -= (f32x2){La11[2], La11[3]} * xj2;
      X24 -= (f32x2){La12[0], La12[1]} * xj2;
      X25 -= (f32x2){La12[2], La12[3]} * xj2;
      X26 -= (f32x2){La13[0], La13[1]} * xj2;
      X27 -= (f32x2){La13[2], La13[3]} * xj2;
      X28 -= (f32x2){La14[0], La14[1]} * xj2;
      X29 -= (f32x2){La14[2], La14[3]} * xj2;
      X30 -= (f32x2){La15[0], La15[1]} * xj2;
      X31 -= (f32x2){La15[2], La15[3]} * xj2;
    }
    __builtin_amdgcn_sched_barrier(0);
    La12 = *(const f32x4*)(Lt_s + 3312);
    La13 = *(const f32x4*)(Lt_s + 3316);
    La14 = *(const f32x4*)(Lt_s + 3320);
    La15 = *(const f32x4*)(Lt_s + 3324);
    __builtin_amdgcn_sched_barrier(0);
    { const float xj = X23[1]; const f32x2 xj2 = (f32x2){xj, xj};
      X24 -= (f32x2){Lb12[0], Lb12[1]} * xj2;
      X25 -= (f32x2){Lb12[2], Lb12[3]} * xj2;
      X26 -= (f32x2){Lb13[0], Lb13[1]} * xj2;
      X27 -= (f32x2){Lb13[2], Lb13[3]} * xj2;
      X28 -= (f32x2){Lb14[0], Lb14[1]} * xj2;
      X29 -= (f32x2){Lb14[2], Lb14[3]} * xj2;
      X30 -= (f32x2){Lb15[0], Lb15[1]} * xj2;
      X31 -= (f32x2){Lb15[2], Lb15[3]} * xj2;
    }
    __builtin_amdgcn_sched_barrier(0);
    Lb12 = *(const f32x4*)(Lt_s + 3380);
    Lb13 = *(const f32x4*)(Lt_s + 3384);
    Lb14 = *(const f32x4*)(Lt_s + 3388);
    Lb15 = *(const f32x4*)(Lt_s + 3392);
    __builtin_amdgcn_sched_barrier(0);
    { const float xj = X24[0]; const f32x2 xj2 = (f32x2){xj, xj};
      X24 -= (f32x2){La12[0], La12[1]} * xj2;
      X25 -= (f32x2){La12[2], La12[3]} * xj2;
      X26 -= (f32x2){La13[0], La13[1]} * xj2;
      X27 -= (f32x2){La13[2], La13[3]} * xj2;
      X28 -= (f32x2){La14[0], La14[1]} * xj2;
      X29 -= (f32x2){La14[2], La14[3]} * xj2;
      X30 -= (f32x2){La15[0], La15[1]} * xj2;
      X31 -= (f32x2){La15[2], La15[3]} * xj2;
    }
    __builtin_amdgcn_sched_barrier(0);
    La12 = *(const f32x4*)(Lt_s + 3448);
    La13 = *(const f32x4*)(Lt_s + 3452);
    La14 = *(const f32x4*)(Lt_s + 3456);
    La15 = *(const f32x4*)(Lt_s + 3460);
    __builtin_amdgcn_sched_barrier(0);
    { const float xj = X24[1]; const f32x2 xj2 = (f32x2){xj, xj};
      X25 -= (f32x2){Lb12[2], Lb12[3]} * xj2;
      X26 -= (f32x2){Lb13[0], Lb13[1]} * xj2;
      X27 -= (f32x2){Lb13[2], Lb13[3]} * xj2;
      X28 -= (f32x2){Lb14[0], Lb14[1]} * xj2;
      X29 -= (f32x2){Lb14[2], Lb14[3]} * xj2;
      X30 -= (f32x2){Lb15[0], Lb15[1]} * xj2;
      X31 -= (f32x2){Lb15[2], Lb15[3]} * xj2;
    }
    __builtin_amdgcn_sched_barrier(0);
    Lb13 = *(const f32x4*)(Lt_s + 3520);
    Lb14 = *(const f32x4*)(Lt_s + 3524);
    Lb15 = *(const f32x4*)(Lt_s + 3528);
    __builtin_amdgcn_sched_barrier(0);
    { const float xj = X25[0]; const f32x2 xj2 = (f32x2){xj, xj};
      X25 -= (f32x2){La12[2], La12[3]} * xj2;
      X26 -= (f32x2){La13[0], La13[1]} * xj2;
      X27 -= (f32x2){La13[2], La13[3]} * xj2;
      X28 -= (f32x2){La14[0], La14[1]} * xj2;
      X29 -= (f32x2){La14[2], La14[3]} * xj2;
      X30 -= (f32x2){La15[0], La15[1]} * xj2;
      X31 -= (f32x2){La15[2], La15[3]} * xj2;
    }
    __builtin_amdgcn_sched_barrier(0);
    La13 = *(const f32x4*)(Lt_s + 3588);
    La14 = *(const f32x4*)(Lt_s + 3592);
    La15 = *(const f32x4*)(Lt_s + 3596);
    __builtin_amdgcn_sched_barrier(0);
    { const float xj = X25[1]; const f32x2 xj2 = (f32x2){xj, xj};
      X26 -= (f32x2){Lb13[0], Lb13[1]} * xj2;
      X27 -= (f32x2){Lb13[2], Lb13[3]} * xj2;
      X28 -= (f32x2){Lb14[0], Lb14[1]} * xj2;
      X29 -= (f32x2){Lb14[2], Lb14[3]} * xj2;
      X30 -= (f32x2){Lb15[0], Lb15[1]} * xj2;
      X31 -= (f32x2){Lb15[2], Lb15[3]} * xj2;
    }
    __builtin_amdgcn_sched_barrier(0);
    Lb13 = *(const f32x4*)(Lt_s + 3656);
    Lb14 = *(const f32x4*)(Lt_s + 3660);
    Lb15 = *(const f32x4*)(Lt_s + 3664);
    __builtin_amdgcn_sched_barrier(0);
    { const float xj = X26[0]; const f32x2 xj2 = (f32x2){xj, xj};
      X26 -= (f32x2){La13[0], La13[1]} * xj2;
      X27 -= (f32x2){La13[2], La13[3]} * xj2;
      X28 -= (f32x2){La14[0], La14[1]} * xj2;
      X29 -= (f32x2){La14[2], La14[3]} * xj2;
      X30 -= (f32x2){La15[0], La15[1]} * xj2;
      X31 -= (f32x2){La15[2], La15[3]} * xj2;
    }
    __builtin_amdgcn_sched_barrier(0);
    La13 = *(const f32x4*)(Lt_s + 3724);
    La14 = *(const f32x4*)(Lt_s + 3728);
    La15 = *(const f32x4*)(Lt_s + 3732);
    __builtin_amdgcn_sched_barrier(0);
    { const float xj = X26[1]; const f32x2 xj2 = (f32x2){xj, xj};
      X27 -= (f32x2){Lb13[2], Lb13[3]} * xj2;
      X28 -= (f32x2){Lb14[0], Lb14[1]} * xj2;
      X29 -= (f32x2){Lb14[2], Lb14[3]} * xj2;
      X30 -= (f32x2){Lb15[0], Lb15[1]} * xj2;
      X31 -= (f32x2){Lb15[2], Lb15[3]} * xj2;
    }
    __builtin_amdgcn_sched_barrier(0);
    Lb14 = *(const f32x4*)(Lt_s + 3796);
    Lb15 = *(const f32x4*)(Lt_s + 3800);
    __builtin_amdgcn_sched_barrier(0);
    { const float xj = X27[0]; const f32x2 xj2 = (f32x2){xj, xj};
      X27 -= (f32x2){La13[2], La13[3]} * xj2;
      X28 -= (f32x2){La14[0], La14[1]} * xj2;
      X29 -= (f32x2){La14[2], La14[3]} * xj2;
      X30 -= (f32x2){La15[0], La15[1]} * xj2;
      X31 -= (f32x2){La15[2], La15[3]} * xj2;
    }
    __builtin_amdgcn_sched_barrier(0);
    La14 = *(const f32x4*)(Lt_s + 3864);
    La15 = *(const f32x4*)(Lt_s + 3868);
    __builtin_amdgcn_sched_barrier(0);
    { const float xj = X27[1]; const f32x2 xj2 = (f32x2){xj, xj};
      X28 -= (f32x2){Lb14[0], Lb14[1]} * xj2;
      X29 -= (f32x2){Lb14[2], Lb14[3]} * xj2;
      X30 -= (f32x2){Lb15[0], Lb15[1]} * xj2;
      X31 -= (f32x2){Lb15[2], Lb15[3]} * xj2;
    }
    __builtin_amdgcn_sched_barrier(0);
    Lb14 = *(const f32x4*)(Lt_s + 3932);
    Lb15 = *(const f32x4*)(Lt_s + 3936);
    __builtin_amdgcn_sched_barrier(0);
    { const float xj = X28[0]; const f32x2 xj2 = (f32x2){xj, xj};
      X28 -= (f32x2){La14[0], La14[1]} * xj2;
      X29 -= (f32x2){La14[2], La14[3]} * xj2;
      X30 -= (f32x2){La15[0], La15[1]} * xj2;
      X31 -= (f32x2){La15[2], La15[3]} * xj2;
    }
    __builtin_amdgcn_sched_barrier(0);
    La14 = *(const f32x4*)(Lt_s + 4000);
    La15 = *(const f32x4*)(Lt_s + 4004);
    __builtin_amdgcn_sched_barrier(0);
    { const float xj = X28[1]; const f32x2 xj2 = (f32x2){xj, xj};
      X29 -= (f32x2){Lb14[2], Lb14[3]} * xj2;
      X30 -= (f32x2){Lb15[0], Lb15[1]} * xj2;
      X31 -= (f32x2){Lb15[2], Lb15[3]} * xj2;
    }
    __builtin_amdgcn_sched_barrier(0);
    Lb15 = *(const f32x4*)(Lt_s + 4072);
    __builtin_amdgcn_sched_barrier(0);
    { const float xj = X29[0]; const f32x2 xj2 = (f32x2){xj, xj};
      X29 -= (f32x2){La14[2], La14[3]} * xj2;
      X30 -= (f32x2){La15[0], La15[1]} * xj2;
      X31 -= (f32x2){La15[2], La15[3]} * xj2;
    }
    __builtin_amdgcn_sched_barrier(0);
    La15 = *(const f32x4*)(Lt_s + 4140);
    __builtin_amdgcn_sched_barrier(0);
    { const float xj = X29[1]; const f32x2 xj2 = (f32x2){xj, xj};
      X30 -= (f32x2){Lb15[0], Lb15[1]} * xj2;
      X31 -= (f32x2){Lb15[2], Lb15[3]} * xj2;
    }
    __builtin_amdgcn_sched_barrier(0);
    Lb15 = *(const f32x4*)(Lt_s + 4208);
    __builtin_amdgcn_sched_barrier(0);
    { const float xj = X30[0]; const f32x2 xj2 = (f32x2){xj, xj};
      X30 -= (f32x2){La15[0], La15[1]} * xj2;
      X31 -= (f32x2){La15[2], La15[3]} * xj2;
    }
    __builtin_amdgcn_sched_barrier(0);
    La15 = *(const f32x4*)(Lt_s + 4276);
    __builtin_amdgcn_sched_barrier(0);
    { const float xj = X30[1]; const f32x2 xj2 = (f32x2){xj, xj};
      X31 -= (f32x2){Lb15[2], Lb15[3]} * xj2;
    }
    __builtin_amdgcn_sched_barrier(0);
    __builtin_amdgcn_sched_barrier(0);
    { const float xj = X31[0]; const f32x2 xj2 = (f32x2){xj, xj};
      X31 -= (f32x2){La15[2], La15[3]} * xj2;
    }
    __builtin_amdgcn_sched_barrier(0);
    __syncthreads();
    outp[0] = f2bf(sg * X0[0]);
    outp[136] = f2bf(sg * X0[1]);
    outp[272] = f2bf(sg * X1[0]);
    outp[408] = f2bf(sg * X1[1]);
    outp[544] = f2bf(sg * X2[0]);
    outp[680] = f2bf(sg * X2[1]);
    outp[816] = f2bf(sg * X3[0]);
    outp[952] = f2bf(sg * X3[1]);
    outp[1088] = f2bf(sg * X4[0]);
    outp[1224] = f2bf(sg * X4[1]);
    outp[1360] = f2bf(sg * X5[0]);
    outp[1496] = f2bf(sg * X5[1]);
    outp[1632] = f2bf(sg * X6[0]);
    outp[1768] = f2bf(sg * X6[1]);
    outp[1904] = f2bf(sg * X7[0]);
    outp[2040] = f2bf(sg * X7[1]);
    outp[2176] = f2bf(sg * X8[0]);
    outp[2312] = f2bf(sg * X8[1]);
    outp[2448] = f2bf(sg * X9[0]);
    outp[2584] = f2bf(sg * X9[1]);
    outp[2720] = f2bf(sg * X10[0]);
    outp[2856] = f2bf(sg * X10[1]);
    outp[2992] = f2bf(sg * X11[0]);
    outp[3128] = f2bf(sg * X11[1]);
    outp[3264] = f2bf(sg * X12[0]);
    outp[3400] = f2bf(sg * X12[1]);
    outp[3536] = f2bf(sg * X13[0]);
    outp[3672] = f2bf(sg * X13[1]);
    outp[3808] = f2bf(sg * X14[0]);
    outp[3944] = f2bf(sg * X14[1]);
    outp[4080] = f2bf(sg * X15[0]);
    outp[4216] = f2bf(sg * X15[1]);
    outp[4352] = f2bf(sg * X16[0]);
    outp[4488] = f2bf(sg * X16[1]);
    outp[4624] = f2bf(sg * X17[0]);
    outp[4760] = f2bf(sg * X17[1]);
    outp[4896] = f2bf(sg * X18[0]);
    outp[5032] = f2bf(sg * X18[1]);
    outp[5168] = f2bf(sg * X19[0]);
    outp[5304] = f2bf(sg * X19[1]);
    outp[5440] = f2bf(sg * X20[0]);
    outp[5576] = f2bf(sg * X20[1]);
    outp[5712] = f2bf(sg * X21[0]);
    outp[5848] = f2bf(sg * X21[1]);
    outp[5984] = f2bf(sg * X22[0]);
    outp[6120] = f2bf(sg * X22[1]);
    outp[6256] = f2bf(sg * X23[0]);
    outp[6392] = f2bf(sg * X23[1]);
    outp[6528] = f2bf(sg * X24[0]);
    outp[6664] = f2bf(sg * X24[1]);
    outp[6800] = f2bf(sg * X25[0]);
    outp[6936] = f2bf(sg * X25[1]);
    outp[7072] = f2bf(sg * X26[0]);
    outp[7208] = f2bf(sg * X26[1]);
    outp[7344] = f2bf(sg * X27[0]);
    outp[7480] = f2bf(sg * X27[1]);
    outp[7616] = f2bf(sg * X28[0]);
    outp[7752] = f2bf(sg * X28[1]);
    outp[7888] = f2bf(sg * X29[0]);
    outp[8024] = f2bf(sg * X29[1]);
    outp[8160] = f2bf(sg * X30[0]);
    outp[8296] = f2bf(sg * X30[1]);
    outp[8432] = f2bf(sg * X31[0]);
    outp[8568] = f2bf(sg * X31[1]);
}

DEV void dn_item(const Params& p, int l, int item, unsigned char* smem) {
    const int dir = item & 1, hh = (item >> 1) & 3, b = item >> 3;
    bf16_t* q_s = (bf16_t*)(smem);
    bf16_t* k_s = (bf16_t*)(smem + 17408);
    bf16_t* vnT_s = k_s;
    bf16_t* kT_s = (bf16_t*)(smem + 35840);
    bf16_t* v_s = (bf16_t*)(smem + 54272);
    bf16_t* u_s = v_s;
    float* L_s = (float*)(smem + 71680);
    bf16_t* w_s = (bf16_t*)(smem + 71680);
    bf16_t* qk_s = (bf16_t*)(smem + 89088);
    bf16_t* St_s = (bf16_t*)(smem + 98304);
    float* G_s = (float*)(smem + 133120);
    float* beta_s = G_s + 64;
    float* eG_s = G_s + 128;
    float* bw_s = G_s + 192;
    float* cw_s = G_s + 256;
    const int tid = get_tid(), lane = tid & 63, wv = tid >> 6, l15 = lane & 15, quad = lane >> 4;
    const float Aneg = -expf(p.in[I_DNALOG][(l * 2 + dir) * 4 + hh]);
    const float dtb = p.in[I_DNDT][(l * 2 + dir) * 4 + hh];
    const bf16_t* P = wsb(p, O_P);
    const float* AB = wsf(p, O_AB);
    bf16_t* TO = wsb(p, dir ? O_TA2 : O_TA);
    __syncthreads();
    for (int e = tid; e < 4 * 384; e += 256) { int j = e / 384, c = e % 384, mat = c >> 7, cc = c & 127; cw_s[e] = p.in[I_DNCONV][((size_t)l * 4 + j) * 1536 + mat * 512 + hh * 128 + cc]; }
    for (int e = tid; e < 128 * 136 / 2; e += 256) ((unsigned*)St_s)[e] = 0u;
    f32x4 Sacc[2][8];
#pragma unroll
    for (int a = 0; a < 2; ++a)
#pragma unroll
        for (int c = 0; c < 8; ++c) Sacc[a][c] = (f32x4){0.f, 0.f, 0.f, 0.f};

    const int rg = tid >> 4, cseg = tid & 15, i0 = rg * 4;
    u32x4 raw[3][7];
    float pf_al = 0.f, pf_bb = 0.f;
#define DN_PREFETCH(NN, M0, M1) { \
        const int c_ = chunk_of(dir, (NN)); const int lo_ = c_ < 4 ? 0 : CTXL, hi_ = c_ < 4 ? CTXL : SB, base_ = c_ * 64; \
        const int slo_ = dir ? base_ + 60 - i0 : base_ + i0; \
        _Pragma("unroll") for (int u = 0; u < 7; ++u) { const int ss_ = slo_ - 1 + u; const bool ok_ = ss_ >= lo_ && ss_ < hi_; \
            const bf16_t* rp_ = P + ((size_t)b * SB + (ok_ ? ss_ : base_)) * PW + hh * 128 + cseg * 8; \
            _Pragma("unroll") for (int mat = (M0); mat < (M1); ++mat) { u32x4 t_ = *(const u32x4*)(rp_ + mat * 512); raw[mat][u] = ok_ ? t_ : (u32x4){0u, 0u, 0u, 0u}; } } \
        if ((M0) == 0) { const int sa_ = dir ? base_ + 63 - lane : base_ + lane; \
        pf_al = AB[((size_t)b * SB + sa_) * 16 + dir * 4 + hh]; pf_bb = AB[((size_t)b * SB + sa_) * 16 + 8 + dir * 4 + hh]; } }
    DN_PREFETCH(0, 0, 3);
    const int wv0_ = wv, l150_ = l15, quad0_ = quad, lane0_ = lane;

#pragma unroll 1
    for (int n = 0; n < 68; ++n) {
        int tz0 = 0; asm volatile("" : "+v"(tz0));
        const int wv = wv0_ + tz0, l15 = l150_ + tz0, quad = quad0_ + tz0, lane = lane0_ + tz0;
        const int c = chunk_of(dir, n);
        const int base = c * 64;
        __syncthreads();
        if (wv == 0) {
            float g = Aneg * softplus_fast(pf_al + dtb);
#pragma unroll
            for (int o = 1; o < 64; o <<= 1) { float t = __shfl_up(g, o); if (lane >= o) g += t; }
            const float eg_ = expf(g), bt_ = sigm(pf_bb); G_s[lane] = g; beta_s[lane] = bt_; eG_s[lane] = eg_; bw_s[lane] = bt_ * eg_;
        }
        __syncthreads();
        const float Glast = G_s[63];
        {
            int tz = 0; asm volatile("" : "+v"(tz));
            const int i0l = i0 + tz, csl = cseg + tz;
            float ksc[4];
#pragma unroll
            for (int m = 0; m < 4; ++m) ksc[m] = expf(Glast - G_s[i0l + m]);
#pragma unroll
            for (int mat = 0; mat < 3; ++mat) {
                float w[4][8];
#pragma unroll
                for (int j = 0; j < 4; ++j) { const f32x4 w0 = *(const f32x4*)(cw_s + j * 384 + mat * 128 + csl * 8), w1 = *(const f32x4*)(cw_s + j * 384 + mat * 128 + csl * 8 + 4);
#pragma unroll
                    for (int e = 0; e < 4; ++e) { w[j][e] = w0[e]; w[j][4 + e] = w1[e]; } }
                float v[4][8];
#pragma unroll
                for (int t = 0; t < 4; ++t)
#pragma unroll
                    for (int e = 0; e < 8; ++e) v[t][e] = 0.f;
#pragma unroll
                for (int u = 0; u < 7; ++u) {
                    float x[8];
#pragma unroll
                    for (int e = 0; e < 4; ++e) { x[2 * e] = lo16(raw[mat][u][e]); x[2 * e + 1] = hi16(raw[mat][u][e]); }
#pragma unroll
                    for (int t = 0; t < 4; ++t) { const int j = u - t; if (j >= 0 && j < 4) {
#pragma unroll
                        for (int e = 0; e < 8; ++e) v[t][e] += w[j][e] * x[e]; } }
                }
                float sc[4];
#pragma unroll
                for (int t = 0; t < 4; ++t) {
                    float ss2 = 0.f;
#pragma unroll
                    for (int e = 0; e < 8; ++e) { v[t][e] = silu(v[t][e]); ss2 += v[t][e] * v[t][e]; }
                    if (mat < 2) { ss2 += __shfl_xor(ss2, 1); ss2 += __shfl_xor(ss2, 2); ss2 += __shfl_xor(ss2, 4); ss2 += __shfl_xor(ss2, 8); }
                    sc[t] = mat == 0 ? rsqrtf(ss2 + 1e-6f) * 0.08838834764831845f : (mat == 1 ? rsqrtf(ss2 + 1e-6f) : 1.f);
                }
                bf16_t* dst = mat == 0 ? q_s : (mat == 1 ? k_s : v_s);
#pragma unroll
                for (int t = 0; t < 4; ++t) {
                    const int it_ = dir ? i0l + 3 - t : i0l + t;
                    u32x4 o;
#pragma unroll
                    for (int e = 0; e < 4; ++e) o[e] = pack2(v[t][2 * e] * sc[t], v[t][2 * e + 1] * sc[t]);
                    *(u32x4*)(dst + it_ * 136 + csl * 8) = o;
                }
                if (mat == 1) {
#pragma unroll
                    for (int e = 0; e < 8; ++e) {
                        const float k0 = v[dir ? 3 : 0][e] * sc[dir ? 3 : 0] * ksc[0], k1 = v[dir ? 2 : 1][e] * sc[dir ? 2 : 1] * ksc[1];
                        const float k2 = v[dir ? 1 : 2][e] * sc[dir ? 1 : 2] * ksc[2], k3 = v[dir ? 0 : 3][e] * sc[dir ? 0 : 3] * ksc[3];
                        u32x2 o; o.x = pack2(k0, k1); o.y = pack2(k2, k3);
                        *(u32x2*)(kT_s + (csl * 8 + e) * 72 + i0l) = o;
                    }
                }
            }
        }
        __syncthreads();
        {
            bf16x8 ak[4], aq[4];
#pragma unroll
            for (int ks = 0; ks < 4; ++ks) { ak[ks] = *(const bf16x8*)(k_s + (wv * 16 + l15) * 136 + ks * 32 + quad * 8); aq[ks] = *(const bf16x8*)(q_s + (wv * 16 + l15) * 136 + ks * 32 + quad * 8); }
#pragma unroll
            for (int nt = 0; nt < 4; ++nt) {
                f32x4 kk = {0.f, 0.f, 0.f, 0.f}, qq = {0.f, 0.f, 0.f, 0.f};
#pragma unroll
                for (int ks = 0; ks < 4; ++ks) { bf16x8 bk = *(const bf16x8*)(k_s + (nt * 16 + l15) * 136 + ks * 32 + quad * 8); kk = mfma16(ak[ks], bk, kk); qq = mfma16(aq[ks], bk, qq); }
                const int jj = nt * 16 + l15; const float Gj = G_s[jj];
                f32x4 lv;
#pragma unroll
                for (int j = 0; j < 4; ++j) {
                    const int i = wv * 16 + quad * 4 + j;
                    const float dec = jj <= i ? expf(G_s[i] - Gj) : 0.f;
                    lv[j] = jj < i ? beta_s[i] * kk[j] * dec : 0.f;
                    qk_s[i * 72 + jj] = f2bf(qq[j] * dec);
                }
                *(f32x4*)(L_s + jj * 68 + wv * 16 + quad * 4) = lv;
            }
        }
        __syncthreads();
        dn_solve(L_s, tid < 128 ? (k_s + tid) : (v_s + (tid - 128)), tid < 128 ? bw_s : beta_s, tid < 128 ? -1.f : 1.f, tid < 128 ? (w_s + tid) : (u_s + (tid - 128)));
        __syncthreads();
        {
            f32x4 vn[8], o1[8];
#pragma unroll
            for (int nt = 0; nt < 8; ++nt) {
#pragma unroll
                for (int j = 0; j < 4; ++j) vn[nt][j] = bf2f(u_s[(wv * 16 + quad * 4 + j) * 136 + nt * 16 + l15]);
                o1[nt] = (f32x4){0.f, 0.f, 0.f, 0.f};
            }
            bf16x8 aw[4], aq[4];
#pragma unroll
            for (int ks = 0; ks < 4; ++ks) { aw[ks] = *(const bf16x8*)(w_s + (wv * 16 + l15) * 136 + ks * 32 + quad * 8); aq[ks] = *(const bf16x8*)(q_s + (wv * 16 + l15) * 136 + ks * 32 + quad * 8); }
#pragma unroll
            for (int nt = 0; nt < 8; ++nt)
#pragma unroll
                for (int ks = 0; ks < 4; ++ks) { bf16x8 bs = *(const bf16x8*)(St_s + (nt * 16 + l15) * 136 + ks * 32 + quad * 8); vn[nt] = mfma16(aw[ks], bs, vn[nt]); o1[nt] = mfma16(aq[ks], bs, o1[nt]); }
#pragma unroll
            for (int nt = 0; nt < 8; ++nt) { u32x2 o; o.x = pack2(vn[nt][0], vn[nt][1]); o.y = pack2(vn[nt][2], vn[nt][3]); *(u32x2*)(vnT_s + (nt * 16 + l15) * 72 + wv * 16 + quad * 4) = o; }
            __syncthreads();
            if (n + 1 < 68) DN_PREFETCH(n + 1, 0, 2);
            float eg[4];
#pragma unroll
            for (int j = 0; j < 4; ++j) eg[j] = eG_s[wv * 16 + quad * 4 + j];
            bf16x8 aqk[2], akt[2][2];
#pragma unroll
            for (int ks = 0; ks < 2; ++ks) {
                aqk[ks] = *(const bf16x8*)(qk_s + (wv * 16 + l15) * 72 + ks * 32 + quad * 8);
                akt[0][ks] = *(const bf16x8*)(kT_s + (wv * 32 + l15) * 72 + ks * 32 + quad * 8);
                akt[1][ks] = *(const bf16x8*)(kT_s + (wv * 32 + 16 + l15) * 72 + ks * 32 + quad * 8);
            }
            const float gend = eG_s[63];
            const size_t orow0 = (size_t)b * SB;
#pragma unroll
            for (int nt = 0; nt < 8; ++nt) {
                f32x4 o;
#pragma unroll
                for (int j = 0; j < 4; ++j) { o[j] = o1[nt][j] * eg[j]; Sacc[0][nt][j] *= gend; Sacc[1][nt][j] *= gend; }
#pragma unroll
                for (int ks = 0; ks < 2; ++ks) {
                    bf16x8 bv = *(const bf16x8*)(vnT_s + (nt * 16 + l15) * 72 + ks * 32 + quad * 8);
                    o = mfma16(aqk[ks], bv, o);
                    Sacc[0][nt] = mfma16(akt[0][ks], bv, Sacc[0][nt]);
                    Sacc[1][nt] = mfma16(akt[1][ks], bv, Sacc[1][nt]);
                }
#pragma unroll
                for (int j = 0; j < 4; ++j) {
                    const int i = wv * 16 + quad * 4 + j;
                    const int s = dir ? base + 63 - i : base + i;
                    TO[(orow0 + s) * 512 + hh * 128 + nt * 16 + l15] = f2bf(o[j]);
                }
#pragma unroll
                for (int mt = 0; mt < 2; ++mt) { u32x2 sv; sv.x = pack2(Sacc[mt][nt][0], Sacc[mt][nt][1]); sv.y = pack2(Sacc[mt][nt][2], Sacc[mt][nt][3]);
                    *(u32x2*)(St_s + (nt * 16 + l15) * 136 + wv * 32 + mt * 16 + quad * 4) = sv; }
            }
        }
        if (n + 1 < 68) DN_PREFETCH(n + 1, 2, 3);
    }
}

#undef DN_PREFETCH
DEV void lru_item(const Params& p, int l, int item, unsigned char* smem) {
    const int g = item & 7, b = item >> 3;
    bf16_t* Wt_s = (bf16_t*)smem;
    bf16_t* xbh_s = Wt_s + 2 * 128 * 72;
    float* xbf_s = (float*)(smem + 36864 + 18432);
    float* a_s = xbf_s + 2 * 64 * 65;
    float* cw_s = a_s + 2 * 64 * 65;
    const int tid = get_tid(), lane = tid & 63, wv = tid >> 6, l15 = lane & 15, quad = lane >> 4;
    bf16_t* P = wsb(p, O_P);
    bf16_t* HF = wsb(p, O_U);
    __syncthreads();
    for (int e = tid; e < 320; e += 256) cw_s[e] = e < 256 ? p.in[I_LCW][((size_t)l * 4 + (e >> 6)) * 512 + g * 64 + (e & 63)] : p.in[I_LCB][l * 512 + g * 64 + (e - 256)];
    for (int e = tid; e < 2 * 4096; e += 256) {
        const int d = e >> 12, ch = (e >> 6) & 63, j = e & 63;
        const size_t wi_ = (((size_t)l * 2 + d) * 8 + g) * 4096 + ch * 64 + j;
        Wt_s[(d * 128 + j) * 72 + ch] = f2bf(p.in[I_LWA][wi_]);
        Wt_s[(d * 128 + 64 + j) * 72 + ch] = f2bf(p.in[I_LWI][wi_]);
    }
    float ba_[2][4], bi_[2][4], sp_[2][4];
#pragma unroll
    for (int d = 0; d < 2; ++d)
#pragma unroll
        for (int nt = 0; nt < 4; ++nt) {
            const int ch = (l * 2 + d) * 512 + g * 64 + nt * 16 + l15;
            ba_[d][nt] = p.in[I_LBA][ch]; bi_[d][nt] = p.in[I_LBI][ch]; sp_[d][nt] = softplus(-p.in[I_LLAM][ch]);
        }
    float hc = 0.f;
    const int i = tid >> 2, seg = tid & 3, j0 = seg * 16;
#pragma unroll 1
    for (int n = 0; n < 68; ++n) {
        const int cf = n, cb = chunk_of(1, n);
        __syncthreads();
#pragma unroll
        for (int d = 0; d < 2; ++d) {
            const int c = d ? cb : cf;
            const int seg_lo = c < 4 ? 0 : CTXL, seg_hi = c < 4 ? CTXL : SB;
            const int s = d ? c * 64 + 63 - i : c * 64 + i;
            float v[16];
#pragma unroll
            for (int e = 0; e < 16; ++e) v[e] = cw_s[256 + j0 + e];
#pragma unroll
            for (int j = 0; j < 4; ++j) {
                const int ss = s + j - 1;
                if (ss >= seg_lo && ss < seg_hi) {
                    const u32x4* src = (const u32x4*)(P + ((size_t)b * SB + ss) * PW + C_LX + g * 64 + j0);
                    const float* cw = cw_s + j * 64 + j0;
#pragma unroll
                    for (int q = 0; q < 2; ++q) { u32x4 x = src[q];
#pragma unroll
                        for (int e = 0; e < 4; ++e) { v[q * 8 + 2 * e] += cw[q * 8 + 2 * e] * lo16(x[e]); v[q * 8 + 2 * e + 1] += cw[q * 8 + 2 * e + 1] * hi16(x[e]); } }
                }
            }
            u32x4 h0, h1;
#pragma unroll
            for (int e = 0; e < 4; ++e) { h0[e] = pack2(v[2 * e], v[2 * e + 1]); h1[e] = pack2(v[8 + 2 * e], v[8 + 2 * e + 1]); }
            *(u32x4*)(xbh_s + (d * 64 + i) * 72 + j0) = h0; *(u32x4*)(xbh_s + (d * 64 + i) * 72 + j0 + 8) = h1;
#pragma unroll
            for (int e = 0; e < 16; ++e) xbf_s[(d * 64 + i) * 65 + j0 + e] = v[e];
        }
        __syncthreads();
#pragma unroll
        for (int d = 0; d < 2; ++d) {
            f32x4 acc[8];
#pragma unroll
            for (int nt = 0; nt < 8; ++nt) acc[nt] = (f32x4){0.f, 0.f, 0.f, 0.f};
            bf16x8 af[2];
#pragma unroll
            for (int ks = 0; ks < 2; ++ks) af[ks] = *(const bf16x8*)(xbh_s + (d * 64 + wv * 16 + l15) * 72 + ks * 32 + quad * 8);
#pragma unroll
            for (int nt = 0; nt < 8; ++nt)
#pragma unroll
                for (int ks = 0; ks < 2; ++ks) { bf16x8 bw = *(const bf16x8*)(Wt_s + (d * 128 + nt * 16 + l15) * 72 + ks * 32 + quad * 8); acc[nt] = mfma16(af[ks], bw, acc[nt]); }
#pragma unroll
            for (int nt = 0; nt < 4; ++nt)
#pragma unroll
                for (int jj = 0; jj < 4; ++jj) {
                    const int idx = (d * 64 + wv * 16 + quad * 4 + jj) * 65 + nt * 16 + l15;
                    const float r = sigm(acc[nt][jj] + ba_[d][nt]), ig = sigm(acc[nt + 4][jj] + bi_[d][nt]);
                    const float la = -8.f * r * sp_[d][nt];
                    a_s[idx] = expf(la);
                    xbf_s[idx] = sqrtf(fmaxf(1.f - expf(2.f * la), 0.f)) * (ig * xbf_s[idx]);
                }
        }
        __syncthreads();
        if (wv < 2) {
            const int o = wv * 64 * 65 + lane;
#pragma unroll 16
            for (int r = 0; r < 64; ++r) { hc = a_s[o + r * 65] * hc + xbf_s[o + r * 65]; xbf_s[o + r * 65] = hc; }
        }
        __syncthreads();
#pragma unroll
        for (int d = 0; d < 2; ++d) {
            const int c = d ? cb : cf;
            const int s = d ? c * 64 + 63 - i : c * 64 + i;
            const bool second = d ? (cb < n) : ((cf < 4 ? 3 - cf : 71 - cf) < n);
            const size_t row = (size_t)b * SB + s;
            const float* hp = xbf_s + (d * 64 + i) * 65 + j0;
            bf16_t* hf = HF + row * 512 + g * 64 + j0;
            if (!second) {
                u32x4 o0, o1;
#pragma unroll
                for (int e = 0; e < 4; ++e) { o0[e] = pack2(hp[2 * e], hp[2 * e + 1]); o1[e] = pack2(hp[8 + 2 * e], hp[8 + 2 * e + 1]); }
                *(u32x4*)hf = o0; *(u32x4*)(hf + 8) = o1;
            } else {
                bf16_t* gp = P + row * PW + C_LG + g * 64 + j0;
                u32x4 f0 = *(const u32x4*)hf, f1 = *(const u32x4*)(hf + 8), g0 = *(const u32x4*)gp, g1 = *(const u32x4*)(gp + 8), o0, o1;
#pragma unroll
                for (int e = 0; e < 4; ++e) {
                    o0[e] = pack2((lo16(f0[e]) + hp[2 * e]) * gelu_tanh(lo16(g0[e])), (hi16(f0[e]) + hp[2 * e + 1]) * gelu_tanh(hi16(g0[e])));
                    o1[e] = pack2((lo16(f1[e]) + hp[8 + 2 * e]) * gelu_tanh(lo16(g1[e])), (hi16(f1[e]) + hp[8 + 2 * e + 1]) * gelu_tanh(hi16(g1[e])));
                }
                *(u32x4*)gp = o0; *(u32x4*)(gp + 8) = o1;
            }
        }
    }
}

DEV void att_item(const Params& p, int l, int b, int h, int qt, float lam_init, unsigned char* smem) {
    bf16_t* K_s = (bf16_t*)smem;
    bf16_t* V_s = (bf16_t*)(smem + 2 * 17408);
    const int tid = get_tid(), lane = tid & 63, wv = tid >> 6, l15 = lane & 15, quad = lane >> 4;
    bf16_t* P = wsb(p, O_P);
    const bf16_t* VT = wsb(p, O_VT) + (size_t)(b * 4 + h) * 128 * SB;
    const int nt_keys = (qt < 2 ? CTXL : SB) / 64;
    float lam;
    {
        const float* lv = p.in[I_DALAM] + l * 256;
        float s1 = lv[lane] * lv[64 + lane], s2 = lv[128 + lane] * lv[192 + lane];
#pragma unroll
        for (int o = 32; o >= 1; o >>= 1) { s1 += __shfl_xor(s1, o); s2 += __shfl_xor(s2, o); }
        lam = expf(s1) - expf(s2) + lam_init;
    }
    bf16x8* Qst = (bf16x8*)(smem + 71680) + (wv * 8) * 64 + lane;
#pragma unroll
    for (int qg = 0; qg < 2; ++qg) {
        const bf16_t* qp = P + ((size_t)b * SB + qt * 128 + wv * 32 + qg * 16 + l15) * PW + C_DAQ + h * 128;
#pragma unroll
        for (int wh = 0; wh < 2; ++wh)
#pragma unroll
            for (int ks = 0; ks < 2; ++ks) Qst[(wh * 4 + qg * 2 + ks) * 64] = *(const bf16x8*)(qp + wh * 64 + ks * 32 + quad * 8);
    }
    f32x4 O[2][8][2];
    float mrun[2][2], lrun[2][2];
#pragma unroll
    for (int wh = 0; wh < 2; ++wh)
#pragma unroll
        for (int qg = 0; qg < 2; ++qg) { mrun[wh][qg] = -1e30f; lrun[wh][qg] = 0.f;
#pragma unroll
            for (int dg = 0; dg < 8; ++dg) O[wh][dg][qg] = (f32x4){0.f, 0.f, 0.f, 0.f}; }
    const int kr = tid >> 2, kseg = (tid & 3) * 32;
    const int kpos = ((kr >> 5) * 2 + ((kr & 7) >> 2)) * 16 + ((kr & 31) >> 3) * 4 + (kr & 3);
    const bf16_t* kg_ = P + ((size_t)b * SB + kr) * PW + C_DAK + h * 128 + kseg;
    const int vr = tid >> 1, vh = (tid & 1) * 32;
    const bf16_t* vg_ = VT + (size_t)vr * SB + vh;
    u32x4 kreg[4], vreg[4];
#pragma unroll
    for (int i = 0; i < 4; ++i) { kreg[i] = *(const u32x4*)(kg_ + i * 8); vreg[i] = *(const u32x4*)(vg_ + i * 8); }
    __syncthreads();
#pragma unroll
    for (int i = 0; i < 4; ++i) { *(u32x4*)(K_s + kpos * 136 + kseg + i * 8) = kreg[i]; *(u32x4*)(V_s + vr * 72 + vh + i * 8) = vreg[i]; }
    __syncthreads();
    const float L2E = 1.4426950408889634f;
#pragma unroll 1
    for (int t = 0; t < nt_keys; ++t) {
        const bf16_t* Kb = K_s + (t & 1) * (64 * 136);
        const bf16_t* Vb = V_s + (t & 1) * (128 * 72);
        if (t + 1 < nt_keys) {
#pragma unroll
            for (int i = 0; i < 4; ++i) { kreg[i] = *(const u32x4*)(kg_ + (size_t)(t + 1) * 64 * PW + i * 8); vreg[i] = *(const u32x4*)(vg_ + (t + 1) * 64 + i * 8); }
        }
#pragma unroll
        for (int wh = 0; wh < 2; ++wh) {
            f32x4 S[4][2];
#pragma unroll
            for (int kg = 0; kg < 4; ++kg) { S[kg][0] = (f32x4){0.f, 0.f, 0.f, 0.f}; S[kg][1] = (f32x4){0.f, 0.f, 0.f, 0.f}; }
#pragma unroll
            for (int ks = 0; ks < 2; ++ks)
#pragma unroll
                for (int kg = 0; kg < 4; ++kg) {
                    bf16x8 kf = *(const bf16x8*)(Kb + (kg * 16 + l15) * 136 + wh * 64 + ks * 32 + quad * 8);
                    S[kg][0] = mfma16(kf, Qst[(wh * 4 + 0 + ks) * 64], S[kg][0]);
                    S[kg][1] = mfma16(kf, Qst[(wh * 4 + 2 + ks) * 64], S[kg][1]);
                }
            bf16x8 Pf[2][2];
#pragma unroll
            for (int qg = 0; qg < 2; ++qg) {
                float mx = -1e30f;
#pragma unroll
                for (int kg = 0; kg < 4; ++kg)
#pragma unroll
                    for (int j = 0; j < 4; ++j) mx = fmaxf(mx, S[kg][qg][j]);
                mx = fmaxf(mx, __shfl_xor(mx, 16)); mx = fmaxf(mx, __shfl_xor(mx, 32));
                mx *= L2E;
                if (__builtin_amdgcn_ballot_w64(mx > mrun[wh][qg] + 8.f) != 0ull) {
                    const float mnew = fmaxf(mrun[wh][qg], mx);
                    const float alpha = __builtin_amdgcn_exp2f(mrun[wh][qg] - mnew);
                    mrun[wh][qg] = mnew;
                    lrun[wh][qg] *= alpha;
#pragma unroll
                    for (int dg = 0; dg < 8; ++dg)
#pragma unroll
                        for (int j = 0; j < 4; ++j) O[wh][dg][qg][j] *= alpha;
                }
                const float mref = mrun[wh][qg];
                float ps = 0.f;
#pragma unroll
                for (int kg = 0; kg < 4; ++kg)
#pragma unroll
                    for (int j = 0; j < 4; ++j) { float pv = __builtin_amdgcn_exp2f(S[kg][qg][j] * L2E - mref); ps += pv; S[kg][qg][j] = pv; }
                lrun[wh][qg] += ps;
#pragma unroll
                for (int s_ = 0; s_ < 2; ++s_) {
                    u32x4 pk; pk[0] = pack2(S[2 * s_][qg][0], S[2 * s_][qg][1]); pk[1] = pack2(S[2 * s_][qg][2], S[2 * s_][qg][3]);
                    pk[2] = pack2(S[2 * s_ + 1][qg][0], S[2 * s_ + 1][qg][1]); pk[3] = pack2(S[2 * s_ + 1][qg][2], S[2 * s_ + 1][qg][3]);
                    Pf[qg][s_] = __builtin_bit_cast(bf16x8, pk);
                }
            }
#pragma unroll
            for (int dg = 0; dg < 8; ++dg)
#pragma unroll
                for (int s_ = 0; s_ < 2; ++s_) {
                    bf16x8 vf = *(const bf16x8*)(Vb + (dg * 16 + l15) * 72 + s_ * 32 + quad * 8);
                    O[wh][dg][0] = mfma16(vf, Pf[0][s_], O[wh][dg][0]);
                    O[wh][dg][1] = mfma16(vf, Pf[1][s_], O[wh][dg][1]);
                }
        }
        if (t + 1 < nt_keys) {
            bf16_t* Kn = K_s + ((t + 1) & 1) * (64 * 136); bf16_t* Vn = V_s + ((t + 1) & 1) * (128 * 72);
#pragma unroll
            for (int i = 0; i < 4; ++i) { *(u32x4*)(Kn + kpos * 136 + kseg + i * 8) = kreg[i]; *(u32x4*)(Vn + vr * 72 + vh + i * 8) = vreg[i]; }
        }
        __syncthreads();
    }
    const float* dnw = p.in[I_DANORM] + l * 128;
#pragma unroll
    for (int qg = 0; qg < 2; ++qg) {
        float l1 = lrun[0][qg], l2 = lrun[1][qg];
        l1 += __shfl_xor(l1, 16); l1 += __shfl_xor(l1, 32); l2 += __shfl_xor(l2, 16); l2 += __shfl_xor(l2, 32);
        const float i1 = 1.f / l1, i2 = lam / l2;
        float ss = 0.f;
#pragma unroll
        for (int dg = 0; dg < 8; ++dg)
#pragma unroll
            for (int j = 0; j < 4; ++j) { float o = O[0][dg][qg][j] * i1 - O[1][dg][qg][j] * i2; O[0][dg][qg][j] = o; ss += o * o; }
        ss += __shfl_xor(ss, 16); ss += __shfl_xor(ss, 32);
        const float rstd = rsqrtf(ss * (1.f / 128.f) + 1e-5f) * (1.f - lam_init);
        bf16_t* op = P + ((size_t)b * SB + qt * 128 + wv * 32 + qg * 16 + l15) * PW + C_DAQ + h * 128;
#pragma unroll
        for (int dg = 0; dg < 8; ++dg) {
            const int dv0 = dg * 16 + quad * 4;
            u32x2 o; o.x = pack2(O[0][dg][qg][0] * rstd * dnw[dv0], O[0][dg][qg][1] * rstd * dnw[dv0 + 1]);
            o.y = pack2(O[0][dg][qg][2] * rstd * dnw[dv0 + 2], O[0][dg][qg][3] * rstd * dnw[dv0 + 3]);
            *(u32x2*)(op + dv0) = o;
        }
    }
}

DEV void phase_mix(const Params& p, int l, unsigned char* smem) {
    const bool need_ctx = l == 0;
    const float lam_init = l == 0 ? 0.2f : 0.35550906759096926f;
    unsigned* ctr = (unsigned*)(p.ws + O_CTL) + l;
    unsigned* actr = (unsigned*)(p.ws + O_CTL) + 16 + l * 8;
    __shared__ int s_item;
    const int nqt = need_ctx ? 34 : 32;
    auto next = [&](unsigned* c) -> int {
        __syncthreads();
        if (threadIdx.x == 0) s_item = (int)atomicAdd(c, 1u);
        __syncthreads();
        return __builtin_amdgcn_readfirstlane(s_item);
    };
    int it = next(ctr);
#pragma unroll 1
    while (it < 64) { dn_item(p, l, it, smem); it = next(ctr); }
#pragma unroll 1
    while (it < 128) { lru_item(p, l, it - 64, smem); it = next(ctr); }
    const int myx = blockIdx.x & 7;
#pragma unroll 1
    for (int k = 0; k < 8; ++k) {
        const int x = (myx + k) & 7;
        it = next(actr + x);
#pragma unroll 1
        while (it < 4 * nqt) {
            const int bh = x + 8 * (it / nqt), idx = it % nqt;
            const int qt = idx < 32 ? idx + 2 : idx - 32;
            att_item(p, l, bh >> 2, bh & 3, qt, lam_init, smem);
            it = next(actr + x);
        }
    }
}

#define XB_TMO      128
#define XB_XCNT(j)  (256  + 64 * (j))
#define XB_XSUB(j)  (1280 + 64 * (j))
#define XB_XGEN(j)  (2304 + 64 * (j))
#define XB_TOP      3328
#define XB_TOPGEN   3392
#define XCD_BAR_WORDS 3456
#define XB_SPIN_CAP (1u << 18)
#define LAS __attribute__((address_space(3)))
DEV unsigned xb_ld(unsigned* p)              { return __hip_atomic_load(p, __ATOMIC_RELAXED, __HIP_MEMORY_SCOPE_AGENT); }
DEV unsigned xb_add(unsigned* p, unsigned v) { return __hip_atomic_fetch_add(p, v, __ATOMIC_RELAXED, __HIP_MEMORY_SCOPE_AGENT); }
DEV unsigned xb_xcc_id() { return (unsigned)__builtin_amdgcn_s_getreg((3 << 11) | 20) & 0xFu; }
#define XB_SPIN(cond, bar) do { unsigned _sp = 0; while (cond) { __builtin_amdgcn_s_sleep(1); \
    if ((++_sp & 255u) == 0u) { if (xb_ld(&(bar)[XB_TMO])) break; if (_sp > XB_SPIN_CAP) { atomicAdd(&(bar)[XB_TMO], 1u); break; } } } } while (0)
struct XcdBarrier { unsigned* bar; unsigned x; volatile LAS unsigned* st; };
DEV XcdBarrier xcd_barrier_post(unsigned* bar, volatile LAS unsigned* st) {
    XcdBarrier b; b.bar = bar; b.x = xb_xcc_id(); b.st = st;
    if (threadIdx.x == 0) (void)xb_add(&bar[XB_XCNT(b.x)], 1u);
    return b;
}
DEV void xcd_barrier_complete(unsigned* bar, unsigned x, unsigned& nloc, unsigned& nx) {
    const unsigned G = gridDim.x * gridDim.y * gridDim.z;
    unsigned sum, cnt, mine, sp = 0u;
    for (;;) {
        sum = 0u; cnt = 0u; mine = 0u;
#pragma unroll
        for (unsigned j = 0; j < 16; ++j) { const unsigned c = xb_ld(&bar[XB_XCNT(j)]); sum += c; cnt += (c > 0u) ? 1u : 0u; mine = (j == x) ? c : mine; }
        if (sum == G) break;
        __builtin_amdgcn_s_sleep(1);
        if ((++sp & 255u) == 0u) { if (xb_ld(&bar[XB_TMO])) break; if (sp > XB_SPIN_CAP) { atomicAdd(&bar[XB_TMO], 1u); break; } }
    }
    nloc = mine > 0u ? mine : 1u; nx = cnt > 0u ? cnt : 1u;
}
DEV void xcd_barrier(const XcdBarrier& b) {
    asm volatile("s_waitcnt vmcnt(0)" ::: "memory");
    __syncthreads();
    if (threadIdx.x == 0) {
        unsigned* bar = b.bar;
        __builtin_amdgcn_s_waitcnt(0);
        unsigned nloc = b.st[0], nx = b.st[1];
        if (nloc == 0u) { xcd_barrier_complete(bar, b.x, nloc, nx); b.st[0] = nloc; b.st[1] = nx; }
        const unsigned old = xb_add(&bar[XB_XSUB(b.x)], 1u);
        const unsigned gen = old / nloc;
        if (old + 1u == (gen + 1u) * nloc) {
            __builtin_amdgcn_fence(__ATOMIC_RELEASE, "agent");
            asm volatile("s_waitcnt vmcnt(0)" ::: "memory");
            const unsigned og = xb_add(&bar[XB_TOP], 1u);
            const unsigned tg = og / nx;
            if (og + 1u == (tg + 1u) * nx) xb_add(&bar[XB_TOPGEN], 1u);
            else XB_SPIN(xb_ld(&bar[XB_TOPGEN]) == tg, bar);
            __builtin_amdgcn_fence(__ATOMIC_ACQUIRE, "agent");
            xb_add(&bar[XB_XGEN(b.x)], 1u);
            asm volatile("s_waitcnt vmcnt(0)" ::: "memory");
        } else {
            XB_SPIN(xb_ld(&bar[XB_XGEN(b.x)]) == gen, bar);
            __builtin_amdgcn_fence(__ATOMIC_ACQUIRE, "agent");
            asm volatile("s_waitcnt vmcnt(0)" ::: "memory");
        }
    }
    __syncthreads();
}

constexpr int NPHASE = 1 + 2 * 9 + 1;
DEV void run_phase(const Params& p, int ph, unsigned char* smem) {
    if (ph == 0) { phase_mod(p, smem); phase_rope(p); __syncthreads(); phase_wconv(p, 0, smem); return; }
    if (ph == NPHASE - 1) { phase_final(p); return; }
    const int l = (ph - 1) / 9, q = (ph - 1) % 9;
    const bool first = l == 0, lat = l == 1;
    const bf16_t* W = wsb(p, O_WT);
    switch (q) {
        case 0: if (l == 1) phase_wconv(p, 1, smem); phase_norm(p, l, 0, first, false); break;
        case 1: phase_g1(p, smem); break;
        case 2: phase_mix(p, l, smem); break;
        case 3: phase_fin_norm(p, l, first, lat); break;
        case 4: phase_gate(p, lat, smem); break;
        case 5: phase_resid(p, l, wsb(p, O_U), D, W + W_OUT, 1024, 2, first, lat, smem); break;
        case 6: phase_norm(p, l, 1, false, lat); break;
        case 7: phase_gu(p, lat, smem); break;
        case 8: phase_resid(p, l, wsb(p, O_P), PW, W + W_DN, DFF, 5, false, lat, smem); break;
    }
}

#if MEGA
__global__ void __launch_bounds__(256) mega_kernel(Params p) {
    extern __shared__ __align__(16) unsigned char smem[];
    cg::grid_group grid = cg::this_grid();
    __shared__ uint4 xb_words;
    if (threadIdx.x == 0) xb_words = make_uint4(0u, 0u, 0u, 0u);
    __syncthreads();
    const XcdBarrier xb = xcd_barrier_post((unsigned*)(p.ws + O_BAR), (volatile LAS unsigned*)&xb_words);
    phase_mod(p, smem); phase_rope(p); __syncthreads(); phase_wconv(p, 0, smem);
    grid.sync();
    const bf16_t* W = wsb(p, O_WT);
#pragma unroll
    for (int l = 0; l < 2; ++l) {
        const bool first = l == 0, lat = l == 1;
        if (l == 1) phase_wconv(p, 1, smem);
        phase_norm(p, l, 0, first, false);
        xcd_barrier(xb);
        phase_g1(p, smem);
        xcd_barrier(xb);
        phase_mix(p, l, smem);
        xcd_barrier(xb);
        phase_fin_norm(p, l, first, lat);
        xcd_barrier(xb);
        phase_gate(p, lat, smem);
        xcd_barrier(xb);
        phase_merge(p, lat, smem);
        xcd_barrier(xb);
        phase_resid(p, l, wsb(p, O_U), D, W + W_OUT, 1024, 2, first, lat, smem);
        xcd_barrier(xb);
        phase_norm(p, l, 1, false, lat);
        xcd_barrier(xb);
        phase_gu(p, lat, smem);
        xcd_barrier(xb);
        phase_resid(p, l, wsb(p, O_P), PW, W + W_DN, DFF, 5, false, lat, smem);
        xcd_barrier(xb);
    }
    phase_final(p);
}
#else
__global__ void __launch_bounds__(256) phase_kernel(Params p, int ph) {
    extern __shared__ __align__(16) unsigned char smem[];
    run_phase(p, ph, smem);
}
#endif

extern "C" void kernel_launch(void* const* d_in, const int* in_sizes, int n_in, void* d_out, int out_size, void* d_ws, size_t ws_size, hipStream_t stream) {
    static int grid = 0;
    if (grid == 0) {
        if (n_in != 28 || ws_size < WS_END) { fprintf(stderr, "kernel_launch: unexpected n_in %d or ws_size %zu < %zu\n", n_in, ws_size, (size_t)WS_END); grid = -1; return; }
        int dev = 0, cus = 0, per_cu = 0;
        hipGetDevice(&dev);
        hipDeviceGetAttribute(&cus, hipDeviceAttributeMultiprocessorCount, dev);
#if MEGA
        hipFuncSetAttribute((const void*)mega_kernel, hipFuncAttributeMaxDynamicSharedMemorySize, LDS_BYTES);
        hipOccupancyMaxActiveBlocksPerMultiprocessor(&per_cu, (const void*)mega_kernel, 256, LDS_BYTES);
#else
        hipFuncSetAttribute((const void*)phase_kernel, hipFuncAttributeMaxDynamicSharedMemorySize, LDS_BYTES);
        hipOccupancyMaxActiveBlocksPerMultiprocessor(&per_cu, (const void*)phase_kernel, 256, LDS_BYTES);
#endif
        if (per_cu < 1) per_cu = 1;
        grid = cus * per_cu;
        fprintf(stderr, "kernel_launch: grid %d (%d CUs x %d)\n", grid, cus, per_cu);
    }
    if (grid < 0) return;
    hipMemsetAsync((char*)d_ws + O_CTL, 0, 4096 + 16384, stream);
    Params p{};
    for (int i = 0; i < 28; ++i) p.in[i] = (const float*)d_in[i];
    p.out = (float*)d_out; p.ws = (unsigned char*)d_ws;
#if MEGA
    void* args[] = {&p};
    hipError_t e = hipLaunchCooperativeKernel((const void*)mega_kernel, dim3(grid), dim3(256), args, LDS_BYTES, stream);
    if (e != hipSuccess) fprintf(stderr, "cooperative launch failed: %s (grid %d)\n", hipGetErrorString(e), grid);
#else
    for (int ph = 0; ph < NPHASE; ++ph) hipLaunchKernelGGL(phase_kernel, dim3(grid), dim3(256), LDS_BYTES, stream, p, ph);
#endif
}
```

```cpp
#include <hip/hip_runtime.h>
#include <hip/hip_cooperative_groups.h>
#include <cstdio>
#include <cstdint>
namespace cg = cooperative_groups;

#ifndef MEGA
#define MEGA 1
#endif

typedef unsigned short bf16_t;
typedef short bf16x8 __attribute__((ext_vector_type(8)));
typedef float f32x4 __attribute__((ext_vector_type(4)));
typedef unsigned u32x4 __attribute__((ext_vector_type(4)));
typedef unsigned u32x2 __attribute__((ext_vector_type(2)));
#define DEV __device__ __forceinline__

constexpr int D = 1024, NB = 8, SEQ = 4096, CTXL = 256, SB = 4352, MR = NB * SB, PW = 4096, DFF = 2816;
constexpr int C_DNQ = 0, C_DNK = 512, C_DNV = 1024, C_DNZ = 1536, C_LX = 2048, C_LG = 2560, C_DAQ = 3072, C_DAK = 3584;
constexpr int NIN = 4736;
constexpr int GLD = 80;

enum { I_X = 0, I_C, I_CTX, I_CCTX, I_WMOD, I_BMOD, I_NMIX, I_NFFN, I_WIN, I_DNCONV, I_DNALOG, I_DNDT, I_DNNORM, I_LCW, I_LCB,
       I_LWA, I_LBA, I_LWI, I_LBI, I_LLAM, I_DALAM, I_DANORM, I_WBR, I_WOUT, I_WFG, I_WFU, I_WFD, I_NFIN };

constexpr size_t al256(size_t x) { return (x + 255) & ~(size_t)255; }
constexpr size_t O_CTL = 0;
constexpr size_t O_BAR = 4096;
constexpr size_t O_MOD = 4096 + 16384;
constexpr size_t O_ROPE = al256(O_MOD + (size_t)2 * 9 * 6144 * 4);
constexpr size_t O_WT = al256(O_ROPE + 64 * 16 * 2 * 4);
constexpr size_t W_IN = 0, W_GATE = W_IN + (size_t)NIN * 1024, W_BR = W_GATE + (size_t)3072 * 1024, W_OUT = W_BR + (size_t)3 * 1024 * 512,
                 W_GU = W_OUT + (size_t)1024 * 1024, W_DN = W_GU + (size_t)5632 * 1024, W_END = W_DN + (size_t)1024 * 2816;
constexpr size_t O_HCTX = al256(O_WT + W_END * 2);
constexpr size_t O_U = al256(O_HCTX + (size_t)2048 * 1024 * 4);
constexpr size_t O_P = al256(O_U + (size_t)MR * 1024 * 2);
constexpr size_t O_AB = al256(O_P + (size_t)MR * PW * 2);
constexpr size_t O_TA = al256(O_AB + (size_t)MR * 16 * 4);
constexpr size_t O_TA2 = al256(O_TA + (size_t)MR * 512 * 2);
constexpr size_t O_VT = al256(O_TA2 + (size_t)MR * 512 * 2);
constexpr size_t WS_END = al256(O_VT + (size_t)MR * 512 * 2);

constexpr int LDS_BYTES = 140 * 1024;

struct Params {
    const float* in[28];
    float* out;
    unsigned char* ws;
};

DEV int get_tid() { int t = threadIdx.x; asm volatile("" : "+v"(t)); return t; }
DEV float bf2f(bf16_t h) { return __uint_as_float(((unsigned)h) << 16); }
DEV bf16_t f2bf(float f) { unsigned u = __float_as_uint(f); u += 0x7fffu + ((u >> 16) & 1u); return (bf16_t)(u >> 16); }
typedef float f32x2_ __attribute__((ext_vector_type(2)));
typedef __bf16 bf16x2_ __attribute__((ext_vector_type(2)));
DEV unsigned pack2(float a, float b) { const f32x2_ v = {a, b}; return __builtin_bit_cast(unsigned, __builtin_convertvector(v, bf16x2_)); }
DEV float sigm(float x) { return __builtin_amdgcn_rcpf(1.f + __expf(-x)); }
DEV float silu(float x) { return x * __builtin_amdgcn_rcpf(1.f + __expf(-x)); }
DEV float softplus(float x) { return x > 20.f ? x : log1pf(expf(x)); }
DEV float softplus_fast(float x) { const float e = __expf(x); return x > 15.f ? x : (e < 0.01f ? e * (1.f - e * (0.5f - e * 0.33333333f)) : __logf(1.f + e)); }
DEV float gelu_tanh(float x) { float u = 0.7978845608028654f * (x + 0.044715f * x * x * x); float t = 1.f - 2.f * __builtin_amdgcn_rcpf(1.f + __expf(2.f * u)); return 0.5f * x * (1.f + t); }
DEV f32x4 mfma16(bf16x8 a, bf16x8 b, f32x4 c) { return __builtin_amdgcn_mfma_f32_16x16x32_bf16(a, b, c, 0, 0, 0); }
DEV void mfma16a(f32x4& c, bf16x8 a, bf16x8 b) { asm volatile("v_mfma_f32_16x16x32_bf16 %0, %1, %2, %0" : "+a"(c) : "v"(a), "v"(b)); }
DEV float lo16(unsigned v) { return __uint_as_float(v << 16); }
DEV float hi16(unsigned v) { return __uint_as_float(v & 0xffff0000u); }

DEV bf16_t* wsb(const Params& p, size_t off) { return (bf16_t*)(p.ws + off); }
DEV float* wsf(const Params& p, size_t off) { return (float*)(p.ws + off); }
DEV float* hrow(const Params& p, int r) { int b = r / SB, s = r - b * SB; return s < CTXL ? wsf(p, O_HCTX) + (size_t)(b * CTXL + s) * D : p.out + (size_t)(b * SEQ + s - CTXL) * D; }
DEV const float* xrow(const Params& p, int r) { int b = r / SB, s = r - b * SB; return s < CTXL ? p.in[I_CTX] + (size_t)(b * CTXL + s) * D : p.in[I_X] + (size_t)(b * SEQ + s - CTXL) * D; }
DEV int modrow(int r) { int b = r / SB, s = r - b * SB; return s < CTXL ? 8 : b; }

template <int MT, int NT>
DEV void gemm_core(const bf16_t* __restrict__ A, int lda, const bf16_t* __restrict__ Bt, int ldb, int K, f32x4 (&acc)[MT][NT], bf16_t* smem_) {
    constexpr int SA = 32 * MT * GLD, SBB = 32 * NT * GLD;
    bf16_t* sA = smem_; bf16_t* sB = smem_ + 2 * SA;
    const int tid = get_tid(), lane = tid & 63, wv = tid >> 6, wr = wv >> 1, wc = wv & 1, l15 = lane & 15, quad = lane >> 4;
    const int lr = tid >> 3, lc = (tid & 7) * 8;
    u32x4 ra0[MT], rb0[NT], ra1[MT], rb1[NT];
    const bf16_t* Ap = A + (size_t)lr * lda + lc;
    const bf16_t* Bp = Bt + (size_t)lr * ldb + lc;
    const int nk = K >> 6;
#define GLOAD(RA, RB, KT) { const int ko_ = (KT) * 64; _Pragma("unroll") for (int i = 0; i < MT; ++i) RA[i] = *(const u32x4*)(Ap + (size_t)(32 * i) * lda + ko_); \
                            _Pragma("unroll") for (int i = 0; i < NT; ++i) RB[i] = *(const u32x4*)(Bp + (size_t)(32 * i) * ldb + ko_); }
#define LSTORE(RA, RB, BUF) { _Pragma("unroll") for (int i = 0; i < MT; ++i) *(u32x4*)(sA + (BUF) * SA + (lr + 32 * i) * GLD + lc) = RA[i]; \
                              _Pragma("unroll") for (int i = 0; i < NT; ++i) *(u32x4*)(sB + (BUF) * SBB + (lr + 32 * i) * GLD + lc) = RB[i]; }
#define AFRAG(BUF, MT_, KS) (*(const bf16x8*)(sA + (BUF) * SA + (wr * MT * 16 + (MT_) * 16 + l15) * GLD + (KS) * 32 + quad * 8))
#define HALF(BUFC, RA, RB, BUFS, DO_STORE, DO_LOAD, KT) { \
        bf16x8 bfr[2][NT]; \
        _Pragma("unroll") for (int ks = 0; ks < 2; ++ks) _Pragma("unroll") for (int nt = 0; nt < NT; ++nt) \
            bfr[ks][nt] = *(const bf16x8*)(sB + (BUFC) * SBB + (wc * NT * 16 + nt * 16 + l15) * GLD + ks * 32 + quad * 8); \
        bf16x8 a0 = AFRAG(BUFC, 0, 0), a1 = AFRAG(BUFC, 0, 1); \
        const int ko_ = (KT) * 64; \
        _Pragma("unroll") for (int mt = 0; mt < MT; ++mt) { \
            bf16x8 n0 = a0, n1 = a1; \
            if (mt + 1 < MT) { n0 = AFRAG(BUFC, mt + 1, 0); n1 = AFRAG(BUFC, mt + 1, 1); } \
            if (DO_STORE) { *(u32x4*)(sA + (BUFS) * SA + (lr + 32 * mt) * GLD + lc) = RA[mt]; if (mt < NT) *(u32x4*)(sB + (BUFS) * SBB + (lr + 32 * mt) * GLD + lc) = RB[mt]; } \
            if (DO_LOAD) { RA[mt] = *(const u32x4*)(Ap + (size_t)(32 * mt) * lda + ko_); if (mt < NT) RB[mt] = *(const u32x4*)(Bp + (size_t)(32 * mt) * ldb + ko_); } \
            _Pragma("unroll") for (int nt = 0; nt < NT; ++nt) mfma16a(acc[mt][nt], bfr[0][nt], a0); \
            _Pragma("unroll") for (int nt = 0; nt < NT; ++nt) mfma16a(acc[mt][nt], bfr[1][nt], a1); \
            a0 = n0; a1 = n1; \
        } }
    static_assert(NT <= MT, "HALF stages the B pieces alongside the first NT A pieces");
    GLOAD(ra0, rb0, 0);
    GLOAD(ra1, rb1, 1);
    __syncthreads();
    LSTORE(ra0, rb0, 0);
    GLOAD(ra0, rb0, 2);
    __syncthreads();
    int kt = 0;
#pragma unroll 1
    for (; kt + 4 < nk; kt += 2) {
        HALF(0, ra1, rb1, 1, true, true, kt + 3);
        __syncthreads();
        HALF(1, ra0, rb0, 0, true, true, kt + 4);
        __syncthreads();
    }
    HALF(0, ra1, rb1, 1, true, true, kt + 3);
    __syncthreads();
    HALF(1, ra0, rb0, 0, true, false, 0);
    __syncthreads();
    HALF(0, ra1, rb1, 1, true, false, 0);
    __syncthreads();
    HALF(1, ra0, rb0, 0, false, false, 0);
    __syncthreads();
#undef AFRAG
#undef HALF
#undef GLOAD
#undef LSTORE
    static_assert(NT == 4, "the accumulator fence is written for NT == 4");
#pragma unroll
    for (int mt = 0; mt < MT; ++mt) {
        if (mt == 0) asm volatile("s_nop 15\n\ts_nop 15" : "+a"(acc[mt][0]), "+a"(acc[mt][1]), "+a"(acc[mt][2]), "+a"(acc[mt][3]));
        else asm volatile("s_nop 0" : "+a"(acc[mt][0]), "+a"(acc[mt][1]), "+a"(acc[mt][2]), "+a"(acc[mt][3]));
    }
}
template <int MT, int NT>
DEV void gemm_core1(const bf16_t* __restrict__ A, int lda, const bf16_t* __restrict__ Bt, int ldb, int K, f32x4 (&acc)[MT][NT], bf16_t* sA, bf16_t* sB) {
    const int tid = get_tid(), lane = tid & 63, wv = tid >> 6, wr = wv >> 1, wc = wv & 1, l15 = lane & 15, quad = lane >> 4;
    const int lr = tid >> 3, lc = (tid & 7) * 8;
    u32x4 ra[MT], rb[NT];
    const bf16_t* Ap = A + (size_t)lr * lda + lc;
    const bf16_t* Bp = Bt + (size_t)lr * ldb + lc;
#pragma unroll
    for (int i = 0; i < MT; ++i) ra[i] = *(const u32x4*)(Ap + (size_t)(32 * i) * lda);
#pragma unroll
    for (int i = 0; i < NT; ++i) rb[i] = *(const u32x4*)(Bp + (size_t)(32 * i) * ldb);
    const int nk = K >> 6;
    for (int kt = 0; kt < nk; ++kt) {
        __syncthreads();
#pragma unroll
        for (int i = 0; i < MT; ++i) *(u32x4*)(sA + (lr + 32 * i) * GLD + lc) = ra[i];
#pragma unroll
        for (int i = 0; i < NT; ++i) *(u32x4*)(sB + (lr + 32 * i) * GLD + lc) = rb[i];
        __syncthreads();
        if (kt + 1 < nk) {
            const int ko = (kt + 1) * 64;
#pragma unroll
            for (int i = 0; i < MT; ++i) ra[i] = *(const u32x4*)(Ap + (size_t)(32 * i) * lda + ko);
#pragma unroll
            for (int i = 0; i < NT; ++i) rb[i] = *(const u32x4*)(Bp + (size_t)(32 * i) * ldb + ko);
        }
#pragma unroll
        for (int ks = 0; ks < 2; ++ks) {
            bf16x8 af[MT], bfr[NT];
#pragma unroll
            for (int mt = 0; mt < MT; ++mt) af[mt] = *(const bf16x8*)(sA + (wr * MT * 16 + mt * 16 + l15) * GLD + ks * 32 + quad * 8);
#pragma unroll
            for (int nt = 0; nt < NT; ++nt) bfr[nt] = *(const bf16x8*)(sB + (wc * NT * 16 + nt * 16 + l15) * GLD + ks * 32 + quad * 8);
#pragma unroll
            for (int mt = 0; mt < MT; ++mt)
#pragma unroll
                for (int nt = 0; nt < NT; ++nt) mfma16a(acc[mt][nt], bfr[nt], af[mt]);
        }
    }
    static_assert(NT == 4, "the accumulator fence is written for NT == 4");
#pragma unroll
    for (int mt = 0; mt < MT; ++mt) {
        if (mt == 0) asm volatile("s_nop 15\n\ts_nop 15" : "+a"(acc[mt][0]), "+a"(acc[mt][1]), "+a"(acc[mt][2]), "+a"(acc[mt][3]));
        else asm volatile("s_nop 0" : "+a"(acc[mt][0]), "+a"(acc[mt][1]), "+a"(acc[mt][2]), "+a"(acc[mt][3]));
    }
}
template <int MT, int NT>
DEV void zero_acc(f32x4 (&acc)[MT][NT]) {
#pragma unroll
    for (int mt = 0; mt < MT; ++mt)
#pragma unroll
        for (int nt = 0; nt < NT; ++nt) acc[mt][nt] = (f32x4){0.f, 0.f, 0.f, 0.f};
}

DEV void phase_mod(const Params& p, unsigned char* smem) {
    float* s_s = (float*)smem;
    float* red = s_s + 9 * 1024;
    const int tid = get_tid();
    bool loaded = false;
    for (int it = blockIdx.x; it < 2 * 96; it += gridDim.x) {
        if (!loaded) {
            for (int e = tid; e < 9 * 1024; e += 256) { float v = e < 8192 ? p.in[I_C][e] : p.in[I_CCTX][e - 8192]; s_s[e] = silu(v); }
            loaded = true;
        }
        __syncthreads();
        const int l = it / 96, cg_ = it % 96, cq = tid & 63, kq = tid >> 6, col = cg_ * 64 + cq;
        float acc[9];
#pragma unroll
        for (int r = 0; r < 9; ++r) acc[r] = 0.f;
        const float* wp = p.in[I_WMOD] + ((size_t)l * 1024 + kq * 256) * 6144 + col;
#pragma unroll 8
        for (int k = 0; k < 256; ++k) {
            float wv = wp[(size_t)k * 6144];
#pragma unroll
            for (int r = 0; r < 9; ++r) acc[r] += s_s[r * 1024 + kq * 256 + k] * wv;
        }
#pragma unroll
        for (int r = 0; r < 9; ++r) red[(kq * 9 + r) * 64 + cq] = acc[r];
        __syncthreads();
        for (int e = tid; e < 9 * 64; e += 256) {
            int r = e >> 6, c2 = e & 63;
            float v = red[(0 * 9 + r) * 64 + c2] + red[(1 * 9 + r) * 64 + c2] + red[(2 * 9 + r) * 64 + c2] + red[(3 * 9 + r) * 64 + c2];
            wsf(p, O_MOD)[((size_t)l * 9 + r) * 6144 + cg_ * 64 + c2] = v + p.in[I_BMOD][l * 6144 + cg_ * 64 + c2];
        }
        __syncthreads();
    }
}
DEV void phase_rope(const Params& p) {
    if (blockIdx.x == (gridDim.x - 1)) {
        for (int e = threadIdx.x; e < 1024; e += 256) {
            int pos = e >> 4, i = e & 15;
            float inv = powf(10000.f, -(float)i / 16.f);
            float ang = (float)pos * inv;
            float n = rintf(ang * 0.15915494309189535f);
            float r = fmaf(-n, 6.28125f, ang);
            r = fmaf(-n, 1.9353071795864769e-3f, r);
            wsf(p, O_ROPE)[e * 2] = cosf(r);
            wsf(p, O_ROPE)[e * 2 + 1] = sinf(r);
        }
    }
}
DEV void wconv_tile(const float* src0, const float* src1, int lds_, int K, bf16_t* dst, int kind, int kt, int nt, bf16_t* tile) {
    const int tid = get_tid();
    const int kk = tid >> 2, grp = tid & 3;
    const int n0 = nt * 64, k0 = kt * 64;
    const int ng = n0 + grp * 16;
    const float* src = src0; int sc;
    if (kind == 0) { sc = ng < 2048 ? ng : (ng < 4608 ? ng + 16 : (ng < 4624 ? 2048 : -1)); }
    else if (kind == 1) { sc = 4624 + ng; }
    else if (kind == 2) { sc = ng; }
    else { int gd = ng >> 4; src = (gd & 1) ? src1 : src0; sc = (gd >> 1) * 16; }
    __syncthreads();
    if (sc >= 0) {
        const float4* sp = (const float4*)(src + (size_t)(k0 + kk) * lds_ + sc);
#pragma unroll
        for (int q = 0; q < 4; ++q) { float4 v = sp[q]; int e = grp * 16 + q * 4;
            tile[(e + 0) * GLD + kk] = f2bf(v.x); tile[(e + 1) * GLD + kk] = f2bf(v.y); tile[(e + 2) * GLD + kk] = f2bf(v.z); tile[(e + 3) * GLD + kk] = f2bf(v.w); }
    } else {
#pragma unroll
        for (int e = 0; e < 16; ++e) tile[(grp * 16 + e) * GLD + kk] = 0;
    }
    __syncthreads();
    const int n = tid >> 2, kseg = (tid & 3) * 16;
    u32x4 a = *(const u32x4*)(tile + n * GLD + kseg), b = *(const u32x4*)(tile + n * GLD + kseg + 8);
    bf16_t* dp = dst + (size_t)(n0 + n) * K + k0 + kseg;
    *(u32x4*)dp = a; *(u32x4*)(dp + 8) = b;
}
DEV void phase_wconv(const Params& p, int l, unsigned char* smem) {
    bf16_t* tile = (bf16_t*)smem;
    bf16_t* W = wsb(p, O_WT);
    constexpr int T0 = 74 * 16, T1 = T0 + 48 * 16, T2 = T1 + 3 * 16 * 8, T3 = T2 + 16 * 16, T4 = T3 + 88 * 16, T5 = T4 + 16 * 44;
    for (int t = blockIdx.x; t < T5; t += gridDim.x) {
        if (t < T0) { wconv_tile(p.in[I_WIN] + (size_t)l * 1024 * 7696, nullptr, 7696, 1024, W + W_IN, 0, t % 16, t / 16, tile); }
        else if (t < T1) { int u = t - T0; wconv_tile(p.in[I_WIN] + (size_t)l * 1024 * 7696, nullptr, 7696, 1024, W + W_GATE, 1, u % 16, u / 16, tile); }
        else if (t < T2) { int u = t - T1; int n = u / 128, v = u % 128; wconv_tile(p.in[I_WBR] + ((size_t)l * 3 + n) * 512 * 1024, nullptr, 1024, 512, W + W_BR + (size_t)n * 1024 * 512, 2, v % 8, v / 8, tile); }
        else if (t < T3) { int u = t - T2; wconv_tile(p.in[I_WOUT] + (size_t)l * 1024 * 1024, nullptr, 1024, 1024, W + W_OUT, 2, u % 16, u / 16, tile); }
        else if (t < T4) { int u = t - T3; wconv_tile(p.in[I_WFG] + (size_t)l * 1024 * DFF, p.in[I_WFU] + (size_t)l * 1024 * DFF, DFF, 1024, W + W_GU, 3, u % 16, u / 16, tile); }
        else { int u = t - T4; wconv_tile(p.in[I_WFD] + (size_t)l * DFF * 1024, nullptr, 1024, DFF, W + W_DN, 2, u % 44, u / 44, tile); }
    }
}

DEV void norm_row(const Params& p, int l, int which, bool first, int r, int lane) {
    const float* h = first ? xrow(p, r) : hrow(p, r);
    const float* nw = p.in[which ? I_NFFN : I_NMIX] + l * D;
    const float* md = wsf(p, O_MOD) + ((size_t)l * 9 + modrow(r)) * 6144 + (which ? 3 * D : 0);
    float4 v[4]; float ss = 0.f;
#pragma unroll
    for (int i = 0; i < 4; ++i) { v[i] = *(const float4*)(h + i * 256 + lane * 4); ss += v[i].x * v[i].x + v[i].y * v[i].y + v[i].z * v[i].z + v[i].w * v[i].w; }
#pragma unroll
    for (int o = 32; o >= 1; o >>= 1) ss += __shfl_xor(ss, o);
    const float rstd = rsqrtf(ss * (1.f / D) + 1e-6f);
    bf16_t* up = wsb(p, O_U) + (size_t)r * D;
#pragma unroll
    for (int i = 0; i < 4; ++i) {
        const int c = i * 256 + lane * 4;
        float4 w4 = *(const float4*)(nw + c), sh = *(const float4*)(md + c), sc = *(const float4*)(md + D + c);
        float a = v[i].x * rstd * w4.x * (1.f + sc.x) + sh.x, b = v[i].y * rstd * w4.y * (1.f + sc.y) + sh.y;
        float c2 = v[i].z * rstd * w4.z * (1.f + sc.z) + sh.z, d = v[i].w * rstd * w4.w * (1.f + sc.w) + sh.w;
        u32x2 o; o.x = pack2(a, b); o.y = pack2(c2, d);
        *(u32x2*)(up + c) = o;
    }
}
DEV void phase_norm(const Params& p, int l, int which, bool first, bool skip_ctx) {
    const int tid_ = get_tid(); const int lane = tid_ & 63, wv = tid_ >> 6;
    for (int r = blockIdx.x * 4 + wv; r < MR; r += gridDim.x * 4) {
        if (skip_ctx && (r % SB) < CTXL) continue;
        norm_row(p, l, which, first, r, lane);
    }
}
DEV void phase_fin_norm(const Params& p, int l, bool first, bool skip_ctx) {
    const int tid_ = get_tid(); const int lane = tid_ & 63, wv = tid_ >> 6;
    const float* dnn = p.in[I_DNNORM] + l * 128;
    for (int r = blockIdx.x * 4 + wv; r < MR; r += gridDim.x * 4) {
        if (skip_ctx && (r % SB) < CTXL) continue;
        norm_row(p, l, 0, first, r, lane);
        bf16_t* ta = wsb(p, O_TA) + (size_t)r * 512 + lane * 8;
        const bf16_t* tb = wsb(p, O_TA2) + (size_t)r * 512 + lane * 8;
        const bf16_t* zz = wsb(p, O_P) + (size_t)r * PW + C_DNZ + lane * 8;
        u32x4 a = *(const u32x4*)ta, b = *(const u32x4*)tb, z = *(const u32x4*)zz;
        float o[8]; float ss = 0.f;
#pragma unroll
        for (int i = 0; i < 4; ++i) { o[2 * i] = lo16(a[i]) + lo16(b[i]); o[2 * i + 1] = hi16(a[i]) + hi16(b[i]); ss += o[2 * i] * o[2 * i] + o[2 * i + 1] * o[2 * i + 1]; }
#pragma unroll
        for (int of = 8; of >= 1; of >>= 1) ss += __shfl_xor(ss, of);
        const float rstd = rsqrtf(ss * (1.f / 128.f) + 1e-6f);
        const int dv0 = (lane & 15) * 8;
        u32x4 y;
#pragma unroll
        for (int i = 0; i < 4; ++i) {
            float y0 = o[2 * i] * rstd * dnn[dv0 + 2 * i] * silu(lo16(z[i]));
            float y1 = o[2 * i + 1] * rstd * dnn[dv0 + 2 * i + 1] * silu(hi16(z[i]));
            y[i] = pack2(y0, y1);
        }
        *(u32x4*)ta = y;
    }
}
DEV void phase_final(const Params& p) {
    const int tid_ = get_tid(); const int lane = tid_ & 63, wv = tid_ >> 6;
    const float* nw = p.in[I_NFIN];
    for (int r = blockIdx.x * 4 + wv; r < NB * SEQ; r += gridDim.x * 4) {
        float* h = p.out + (size_t)r * D;
        float4 v[4]; float ss = 0.f;
#pragma unroll
        for (int i = 0; i < 4; ++i) { v[i] = *(const float4*)(h + i * 256 + lane * 4); ss += v[i].x * v[i].x + v[i].y * v[i].y + v[i].z * v[i].z + v[i].w * v[i].w; }
#pragma unroll
        for (int o = 32; o >= 1; o >>= 1) ss += __shfl_xor(ss, o);
        const float rstd = rsqrtf(ss * (1.f / D) + 1e-6f);
#pragma unroll
        for (int i = 0; i < 4; ++i) {
            const int c = i * 256 + lane * 4;
            float4 w4 = *(const float4*)(nw + c);
            float4 o4; o4.x = v[i].x * rstd * w4.x; o4.y = v[i].y * rstd * w4.y; o4.z = v[i].z * rstd * w4.z; o4.w = v[i].w * rstd * w4.w;
            *(float4*)(h + c) = o4;
        }
    }
}

struct TileIter {
    int nn, total, nloc, L;
    DEV TileIter(int nm, int nn_) { nn = nn_; total = nm * nn_; nloc = gridDim.x >> 3; L = (blockIdx.x & 7) * nloc + (blockIdx.x >> 3); }
    DEV bool valid() const { return L < total; }
    DEV bool more() const { return (L - (int)(blockIdx.x >> 3)) < total; }
    DEV void next() { L += 8 * nloc; }
    DEV void get(int& tm, int& tn) const { const int pn = 4 * nn, panel = L / pn, rem = L - panel * pn; tn = rem >> 2; tm = panel * 4 + (rem & 3); }
};
DEV void phase_g1(const Params& p, unsigned char* smem) {
    bf16_t* sA = (bf16_t*)smem;
    const int tid = get_tid(), lane = tid & 63, wv = tid >> 6, wr = wv >> 1, wc = wv & 1, l15 = lane & 15, quad = lane >> 4;
    const bf16_t* U = wsb(p, O_U); const bf16_t* W = wsb(p, O_WT) + W_IN;
    bf16_t* P = wsb(p, O_P);
    const float* rope = wsf(p, O_ROPE);
    constexpr int NTN = NIN / 128;
    const int wr0_ = wr, wc0_ = wc, l150_ = l15, quad0_ = quad;
    for (TileIter ti(MR / 256, NTN); ti.valid(); ti.next()) {
        int tm, tn; ti.get(tm, tn);
        const int row0 = tm * 256, col0 = tn * 128;
        f32x4 acc[8][4]; zero_acc(acc);
        gemm_core<8, 4>(U + (size_t)row0 * D, D, W + (size_t)col0 * D, D, D, acc, sA);
        int tz = 0; asm volatile("" : "+v"(tz));
        const int wr = wr0_ + tz, wc = wc0_ + tz, l15 = l150_ + tz, quad = quad0_ + tz;
        if (tn < 24) {
#pragma unroll
            for (int mt = 0; mt < 8; ++mt) {
                __builtin_amdgcn_sched_barrier(0);
                bf16_t* pp = P + (size_t)(row0 + wr * 128 + mt * 16 + l15) * PW + col0 + wc * 64 + quad * 4;
#pragma unroll
                for (int nt = 0; nt < 4; ++nt) { u32x2 o; o.x = pack2(acc[mt][nt][0], acc[mt][nt][1]); o.y = pack2(acc[mt][nt][2], acc[mt][nt][3]); *(u32x2*)(pp + nt * 16) = o; }
            }
        } else if (tn < 32) {
            const float qs = tn < 28 ? 0.125f : 1.f;
#pragma unroll
            for (int mt = 0; mt < 8; ++mt) {
                __builtin_amdgcn_sched_barrier(0);
                const int row = row0 + wr * 128 + mt * 16 + l15;
                const int s_ = row % SB;
                f32x4 ca = {1.f, 1.f, 1.f, 1.f}, sa = {0.f, 0.f, 0.f, 0.f}, cb = {1.f, 1.f, 1.f, 1.f}, sb = {0.f, 0.f, 0.f, 0.f};
                if (s_ >= CTXL) { const int tt = s_ - CTXL, pr = tt >> 6, pc = tt & 63;
                    const f32x4 r0 = *(const f32x4*)(rope + (pr * 16 + quad * 4) * 2), r1 = *(const f32x4*)(rope + (pr * 16 + quad * 4) * 2 + 4);
                    const f32x4 r2 = *(const f32x4*)(rope + (pc * 16 + quad * 4) * 2), r3 = *(const f32x4*)(rope + (pc * 16 + quad * 4) * 2 + 4);
                    ca = (f32x4){r0[0], r0[2], r1[0], r1[2]}; sa = (f32x4){r0[1], r0[3], r1[1], r1[3]};
                    cb = (f32x4){r2[0], r2[2], r3[0], r3[2]}; sb = (f32x4){r2[1], r2[3], r3[1], r3[3]}; }
                const f32x4 x1 = acc[mt][0], x2 = acc[mt][1], y1 = acc[mt][2], y2 = acc[mt][3];
                const f32x4 o0 = (x1 * ca - x2 * sa) * qs, o1 = (x2 * ca + x1 * sa) * qs, o2 = (y1 * cb - y2 * sb) * qs, o3 = (y2 * cb + y1 * sb) * qs;
                bf16_t* pp = P + (size_t)row * PW + col0 + wc * 64 + quad * 4;
                u32x2 o; o.x = pack2(o0[0], o0[1]); o.y = pack2(o0[2], o0[3]); *(u32x2*)(pp) = o;
                o.x = pack2(o1[0], o1[1]); o.y = pack2(o1[2], o1[3]); *(u32x2*)(pp + 16) = o;
                o.x = pack2(o2[0], o2[1]); o.y = pack2(o2[2], o2[3]); *(u32x2*)(pp + 32) = o;
                o.x = pack2(o3[0], o3[1]); o.y = pack2(o3[2], o3[3]); *(u32x2*)(pp + 48) = o;
            }
        } else if (tn < 36) {
            bf16_t* VT = wsb(p, O_VT);
            const int b = row0 / SB, sbase = row0 - b * SB;
#pragma unroll
            for (int mt = 0; mt < 8; ++mt) {
                __builtin_amdgcn_sched_barrier(0);
                const int s_ = sbase + wr * 128 + mt * 16 + l15;
                const int vi0 = (b * 512 + col0 - 4096 + wc * 64 + quad * 4) * SB + s_;
#pragma unroll
                for (int nt = 0; nt < 4; ++nt) {
                    const unsigned p01 = pack2(acc[mt][nt][0], acc[mt][nt][1]), p23 = pack2(acc[mt][nt][2], acc[mt][nt][3]);
                    VT[vi0 + (nt * 16 + 0) * SB] = (bf16_t)(p01 & 0xffffu); VT[vi0 + (nt * 16 + 1) * SB] = (bf16_t)(p01 >> 16);
                    VT[vi0 + (nt * 16 + 2) * SB] = (bf16_t)(p23 & 0xffffu); VT[vi0 + (nt * 16 + 3) * SB] = (bf16_t)(p23 >> 16);
                }
            }
        } else {
            if (wc == 0) {
                float* AB = wsf(p, O_AB);
#pragma unroll
                for (int mt = 0; mt < 8; ++mt) {
                    const int row = row0 + wr * 128 + mt * 16 + l15;
                    *(f32x4*)(AB + (size_t)row * 16 + quad * 4) = acc[mt][0];
                }
            }
        }
    }
}

DEV int rowtile0(int ti, bool latent_only) { if (!latent_only) return ti * 256; int b = ti >> 4, tt = ti & 15; return b * SB + CTXL + tt * 256; }
DEV int sgcol(int n, int c) { return n < 2 ? n * 1024 + c : (c < 512 ? 2048 + c : 3584 + (c - 512)); }

DEV void phase_gate(const Params& p, bool latent_only, unsigned char* smem) {
    bf16_t* sA = (bf16_t*)smem;
    const int tid = get_tid(), lane = tid & 63, wv = tid >> 6, wr = wv >> 1, wc = wv & 1, l15 = lane & 15, quad = lane >> 4;
    const bf16_t* U = wsb(p, O_U); const bf16_t* W = wsb(p, O_WT) + W_GATE;
    bf16_t* P = wsb(p, O_P);
    const int nrt = latent_only ? 128 : 136;
    for (TileIter ti(nrt, 24); ti.valid(); ti.next()) {
        int tm, tn; ti.get(tm, tn);
        const int row0 = rowtile0(tm, latent_only);
        f32x4 acc[8][4]; zero_acc(acc);
        gemm_core<8, 4>(U + (size_t)row0 * D, D, W + (size_t)tn * 128 * D, D, D, acc, sA);
        const int dcol0 = sgcol(tn >> 3, (tn & 7) * 128);
        bf16_t* ip = P + (size_t)(row0 + tid) * PW + dcol0;
#pragma unroll
        for (int mt = 0; mt < 8; ++mt) {
            __builtin_amdgcn_sched_barrier(0);
#pragma unroll
            for (int hf = 0; hf < 2; ++hf) {
                u32x4 o;
                o[0] = pack2(sigm(acc[mt][2 * hf][0]), sigm(acc[mt][2 * hf][1])); o[1] = pack2(sigm(acc[mt][2 * hf][2]), sigm(acc[mt][2 * hf][3]));
                o[2] = pack2(sigm(acc[mt][2 * hf + 1][0]), sigm(acc[mt][2 * hf + 1][1])); o[3] = pack2(sigm(acc[mt][2 * hf + 1][2]), sigm(acc[mt][2 * hf + 1][3]));
                *(u32x4*)(ip + (mt * 2 + hf) * 8) = o;
            }
        }
    }
}

DEV void phase_merge(const Params& p, bool latent_only, unsigned char* smem) {
    bf16_t* sA = (bf16_t*)smem;
    const int tid = get_tid(), lane = tid & 63, wv = tid >> 6, wr = wv >> 1, wc = wv & 1, l15 = lane & 15, quad = lane >> 4;
    const bf16_t* W = wsb(p, O_WT);
    const bf16_t* P = wsb(p, O_P);
    bf16_t* U = wsb(p, O_U);
    const int nrt = latent_only ? 128 : 136;
    for (TileIter ti(nrt, 8); ti.valid(); ti.next()) {
        int tm, tn; ti.get(tm, tn);
        const int row0 = rowtile0(tm, latent_only), col0 = tn * 128;
        f32x4 m[8][4]; zero_acc(m);
#pragma unroll 1
        for (int n = 0; n < 3; ++n) {
            f32x4 au[8][4]; zero_acc(au);
            const bf16_t* Y; int ldy;
            if (n == 0) { Y = wsb(p, O_TA) + (size_t)row0 * 512; ldy = 512; }
            else if (n == 1) { Y = P + (size_t)row0 * PW + C_LG; ldy = PW; }
            else { Y = P + (size_t)row0 * PW + C_DAQ; ldy = PW; }
            const int sc0 = sgcol(n, col0);
            u32x4 sg[16];
            const bf16_t* ip = P + (size_t)(row0 + tid) * PW + sc0;
#pragma unroll
            for (int q = 0; q < 16; ++q) sg[q] = *(const u32x4*)(ip + q * 8);
            gemm_core1<8, 4>(Y, ldy, W + W_BR + ((size_t)n * 1024 + col0) * 512, 512, 512, au, sA, sA + 256 * GLD);
#pragma unroll
            for (int mt = 0; mt < 8; ++mt)
#pragma unroll
                for (int nt = 0; nt < 4; ++nt) {
                    const unsigned g01 = sg[mt * 2 + (nt >> 1)][(nt & 1) * 2], g23 = sg[mt * 2 + (nt >> 1)][(nt & 1) * 2 + 1];
                    m[mt][nt][0] += lo16(g01) * au[mt][nt][0]; m[mt][nt][1] += hi16(g01) * au[mt][nt][1];
                    m[mt][nt][2] += lo16(g23) * au[mt][nt][2]; m[mt][nt][3] += hi16(g23) * au[mt][nt][3];
                }
        }
#pragma unroll
        for (int mt = 0; mt < 8; ++mt) {
            __builtin_amdgcn_sched_barrier(0);
            bf16_t* up = U + (size_t)(row0 + wr * 128 + mt * 16 + l15) * D + col0 + wc * 64 + quad * 4;
#pragma unroll
            for (int nt = 0; nt < 4; ++nt) { u32x2 o; o.x = pack2(m[mt][nt][0], m[mt][nt][1]); o.y = pack2(m[mt][nt][2], m[mt][nt][3]); *(u32x2*)(up + nt * 16) = o; }
        }
    }
}

DEV void phase_resid(const Params& p, int l, const bf16_t* A, int lda, const bf16_t* Wt, int K, int chunk, bool first, bool latent_only, unsigned char* smem) {
    bf16_t* sA = (bf16_t*)smem;
    const int tid = get_tid(), lane = tid & 63, wv = tid >> 6, wr = wv >> 1, wc = wv & 1, l15 = lane & 15, quad = lane >> 4;
    const int nrt = latent_only ? 128 : 136;
    for (TileIter ti(nrt, 8); ti.valid(); ti.next()) {
        int tm, tn; ti.get(tm, tn);
        const int row0 = rowtile0(tm, latent_only), col0 = tn * 128;
        f32x4 acc[8][4]; zero_acc(acc);
        gemm_core<8, 4>(A + (size_t)row0 * lda, lda, Wt + (size_t)col0 * K, K, K, acc, sA);
        const float* md = wsf(p, O_MOD) + ((size_t)l * 9 + modrow(row0)) * 6144 + chunk * D + col0 + wc * 64 + quad * 4;
        const float* hs0 = first ? xrow(p, row0) : hrow(p, row0);
        float* hd0 = hrow(p, row0);
        f32x4 mg[4];
#pragma unroll
        for (int nt = 0; nt < 4; ++nt) mg[nt] = *(const f32x4*)(md + nt * 16);
#pragma unroll
        for (int mt = 0; mt < 8; ++mt) {
            __builtin_amdgcn_sched_barrier(0);
            const size_t ro = (size_t)(wr * 128 + mt * 16 + l15) * D + col0 + wc * 64 + quad * 4;
#pragma unroll
            for (int nt = 0; nt < 4; ++nt) { const f32x4 h = *(const f32x4*)(hs0 + ro + nt * 16); *(f32x4*)(hd0 + ro + nt * 16) = h + mg[nt] * acc[mt][nt]; }
        }
    }
}
DEV void phase_gu(const Params& p, bool latent_only, unsigned char* smem) {
    bf16_t* sA = (bf16_t*)smem;
    const int tid = get_tid(), lane = tid & 63, wv = tid >> 6, wr = wv >> 1, wc = wv & 1, l15 = lane & 15, quad = lane >> 4;
    const bf16_t* U = wsb(p, O_U); const bf16_t* W = wsb(p, O_WT) + W_GU;
    bf16_t* P = wsb(p, O_P);
    const int nrt = latent_only ? 128 : 136;
    for (TileIter ti(nrt, 44); ti.valid(); ti.next()) {
        int tm, tn; ti.get(tm, tn);
        const int row0 = rowtile0(tm, latent_only);
        f32x4 acc[8][4]; zero_acc(acc);
        gemm_core<8, 4>(U + (size_t)row0 * D, D, W + (size_t)tn * 128 * D, D, D, acc, sA);
#pragma unroll
        for (int mt = 0; mt < 8; ++mt) {
            __builtin_amdgcn_sched_barrier(0);
            bf16_t* pp = P + (size_t)(row0 + wr * 128 + mt * 16 + l15) * PW + (tn * 4 + wc * 2) * 16 + quad * 4;
#pragma unroll
            for (int pr = 0; pr < 2; ++pr) {
                const f32x4 g = acc[mt][2 * pr], u = acc[mt][2 * pr + 1];
                u32x2 o; o.x = pack2(silu(g[0]) * u[0], silu(g[1]) * u[1]); o.y = pack2(silu(g[2]) * u[2], silu(g[3]) * u[3]);
                *(u32x2*)(pp + pr * 16) = o;
            }
        }
    }
}

DEV int chunk_of(int dir, int n) { return dir ? (n < 4 ? 3 - n : 71 - n) : n; }

typedef float f32x2 __attribute__((ext_vector_type(2)));
DEV void dn_solve(const float* __restrict__ Lt_s0, const bf16_t* __restrict__ colp, const float* __restrict__ mulp0, const float sg, bf16_t* __restrict__ outp) {
    int vz = 0; asm volatile("" : "+v"(vz));
    const float* __restrict__ Lt_s = Lt_s0 + vz; const float* __restrict__ mulp = mulp0 + vz;
    f32x2 X0, X1, X2, X3, X4, X5, X6, X7, X8, X9, X10, X11, X12, X13, X14, X15, X16, X17, X18, X19, X20, X21, X22, X23, X24, X25, X26, X27, X28, X29, X30, X31;
    f32x4 La0, La1, La2, La3, La4, La5, La6, La7, La8, La9, La10, La11, La12, La13, La14, La15, Lb0, Lb1, Lb2, Lb3, Lb4, Lb5, Lb6, Lb7, Lb8, Lb9, Lb10, Lb11, Lb12, Lb13, Lb14, Lb15;
    X0 = (f32x2){bf2f(colp[0]) * mulp[0], bf2f(colp[136]) * mulp[1]};
    X1 = (f32x2){bf2f(colp[272]) * mulp[2], bf2f(colp[408]) * mulp[3]};
    X2 = (f32x2){bf2f(colp[544]) * mulp[4], bf2f(colp[680]) * mulp[5]};
    X3 = (f32x2){bf2f(colp[816]) * mulp[6], bf2f(colp[952]) * mulp[7]};
    X4 = (f32x2){bf2f(colp[1088]) * mulp[8], bf2f(colp[1224]) * mulp[9]};
    X5 = (f32x2){bf2f(colp[1360]) * mulp[10], bf2f(colp[1496]) * mulp[11]};
    X6 = (f32x2){bf2f(colp[1632]) * mulp[12], bf2f(colp[1768]) * mulp[13]};
    X7 = (f32x2){bf2f(colp[1904]) * mulp[14], bf2f(colp[2040]) * mulp[15]};
    X8 = (f32x2){bf2f(colp[2176]) * mulp[16], bf2f(colp[2312]) * mulp[17]};
    X9 = (f32x2){bf2f(colp[2448]) * mulp[18], bf2f(colp[2584]) * mulp[19]};
    X10 = (f32x2){bf2f(colp[2720]) * mulp[20], bf2f(colp[2856]) * mulp[21]};
    X11 = (f32x2){bf2f(colp[2992]) * mulp[22], bf2f(colp[3128]) * mulp[23]};
    X12 = (f32x2){bf2f(colp[3264]) * mulp[24], bf2f(colp[3400]) * mulp[25]};
    X13 = (f32x2){bf2f(colp[3536]) * mulp[26], bf2f(colp[3672]) * mulp[27]};
    X14 = (f32x2){bf2f(colp[3808]) * mulp[28], bf2f(colp[3944]) * mulp[29]};
    X15 = (f32x2){bf2f(colp[4080]) * mulp[30], bf2f(colp[4216]) * mulp[31]};
    X16 = (f32x2){bf2f(colp[4352]) * mulp[32], bf2f(colp[4488]) * mulp[33]};
    X17 = (f32x2){bf2f(colp[4624]) * mulp[34], bf2f(colp[4760]) * mulp[35]};
    X18 = (f32x2){bf2f(colp[4896]) * mulp[36], bf2f(colp[5032]) * mulp[37]};
    X19 = (f32x2){bf2f(colp[5168]) * mulp[38], bf2f(colp[5304]) * mulp[39]};
    X20 = (f32x2){bf2f(colp[5440]) * mulp[40], bf2f(colp[5576]) * mulp[41]};
    X21 = (f32x2){bf2f(colp[5712]) * mulp[42], bf2f(colp[5848]) * mulp[43]};
    X22 = (f32x2){bf2f(colp[5984]) * mulp[44], bf2f(colp[6120]) * mulp[45]};
    X23 = (f32x2){bf2f(colp[6256]) * mulp[46], bf2f(colp[6392]) * mulp[47]};
    X24 = (f32x2){bf2f(colp[6528]) * mulp[48], bf2f(colp[6664]) * mulp[49]};
    X25 = (f32x2){bf2f(colp[6800]) * mulp[50], bf2f(colp[6936]) * mulp[51]};
    X26 = (f32x2){bf2f(colp[7072]) * mulp[52], bf2f(colp[7208]) * mulp[53]};
    X27 = (f32x2){bf2f(colp[7344]) * mulp[54], bf2f(colp[7480]) * mulp[55]};
    X28 = (f32x2){bf2f(colp[7616]) * mulp[56], bf2f(colp[7752]) * mulp[57]};
    X29 = (f32x2){bf2f(colp[7888]) * mulp[58], bf2f(colp[8024]) * mulp[59]};
    X30 = (f32x2){bf2f(colp[8160]) * mulp[60], bf2f(colp[8296]) * mulp[61]};
    X31 = (f32x2){bf2f(colp[8432]) * mulp[62], bf2f(colp[8568]) * mulp[63]};
    La0 = *(const f32x4*)(Lt_s + 0);
    La1 = *(const f32x4*)(Lt_s + 4);
    La2 = *(const f32x4*)(Lt_s + 8);
    La3 = *(const f32x4*)(Lt_s + 12);
    La4 = *(const f32x4*)(Lt_s + 16);
    La5 = *(const f32x4*)(Lt_s + 20);
    La6 = *(const f32x4*)(Lt_s + 24);
    La7 = *(const f32x4*)(Lt_s + 28);
    La8 = *(const f32x4*)(Lt_s + 32);
    La9 = *(const f32x4*)(Lt_s + 36);
    La10 = *(const f32x4*)(Lt_s + 40);
    La11 = *(const f32x4*)(Lt_s + 44);
    La12 = *(const f32x4*)(Lt_s + 48);
    La13 = *(const f32x4*)(Lt_s + 52);
    La14 = *(const f32x4*)(Lt_s + 56);
    La15 = *(const f32x4*)(Lt_s + 60);
    Lb0 = *(const f32x4*)(Lt_s + 68);
    Lb1 = *(const f32x4*)(Lt_s + 72);
    Lb2 = *(const f32x4*)(Lt_s + 76);
    Lb3 = *(const f32x4*)(Lt_s + 80);
    Lb4 = *(const f32x4*)(Lt_s + 84);
    Lb5 = *(const f32x4*)(Lt_s + 88);
    Lb6 = *(const f32x4*)(Lt_s + 92);
    Lb7 = *(const f32x4*)(Lt_s + 96);
    Lb8 = *(const f32x4*)(Lt_s + 100);
    Lb9 = *(const f32x4*)(Lt_s + 104);
    Lb10 = *(const f32x4*)(Lt_s + 108);
    Lb11 = *(const f32x4*)(Lt_s + 112);
    Lb12 = *(const f32x4*)(Lt_s + 116);
    Lb13 = *(const f32x4*)(Lt_s + 120);
    Lb14 = *(const f32x4*)(Lt_s + 124);
    Lb15 = *(const f32x4*)(Lt_s + 128);
    __builtin_amdgcn_sched_barrier(0);
    { const float xj = X0[0]; const f32x2 xj2 = (f32x2){xj, xj};
      X0 -= (f32x2){La0[0], La0[1]} * xj2;
      X1 -= (f32x2){La0[2], La0[3]} * xj2;
      X2 -= (f32x2){La1[0], La1[1]} * xj2;
      X3 -= (f32x2){La1[2], La1[3]} * xj2;
      X4 -= (f32x2){La2[0], La2[1]} * xj2;
      X5 -= (f32x2){La2[2], La2[3]} * xj2;
      X6 -= (f32x2){La3[0], La3[1]} * xj2;
      X7 -= (f32x2){La3[2], La3[3]} * xj2;
      X8 -= (f32x2){La4[0], La4[1]} * xj2;
      X9 -= (f32x2){La4[2], La4[3]} * xj2;
      X10 -= (f32x2){La5[0], La5[1]} * xj2;
      X11 -= (f32x2){La5[2], La5[3]} * xj2;
      X12 -= (f32x2){La6[0], La6[1]} * xj2;
      X13 -= (f32x2){La6[2], La6[3]} * xj2;
      X14 -= (f32x2){La7[0], La7[1]} * xj2;
      X15 -= (f32x2){La7[2], La7[3]} * xj2;
      X16 -= (f32x2){La8[0], La8[1]} * xj2;
      X17 -= (f32x2){La8[2], La8[3]} * xj2;
      X18 -= (f32x2){La9[0], La9[1]} * xj2;
      X19 -= (f32x2){La9[2], La9[3]} * xj2;
      X20 -= (f32x2){La10[0], La10[1]} * xj2;
      X21 -= (f32x2){La10[2], La10[3]} * xj2;
      X22 -= (f32x2){La11[0], La11[1]} * xj2;
      X23 -= (f32x2){La11[2], La11[3]} * xj2;
      X24 -= (f32x2){La12[0], La12[1]} * xj2;
      X25 -= (f32x2){La12[2], La12[3]} * xj2;
      X26 -= (f32x2){La13[0], La13[1]} * xj2;
      X27 -= (f32x2){La13[2], La13[3]} * xj2;
      X28 -= (f32x2){La14[0], La14[1]} * xj2;
      X29 -= (f32x2){La14[2], La14[3]} * xj2;
      X30 -= (f32x2){La15[0], La15[1]} * xj2;
      X31 -= (f32x2){La15[2], La15[3]} * xj2;
    }
    __builtin_amdgcn_sched_barrier(0);
    La0 = *(const f32x4*)(Lt_s + 136);
    La1 = *(const f32x4*)(Lt_s + 140);
    La2 = *(const f32x4*)(Lt_s + 144);
    La3 = *(const f32x4*)(Lt_s + 148);
    La4 = *(const f32x4*)(Lt_s + 152);
    La5 = *(const f32x4*)(Lt_s + 156);
    La6 = *(const f32x4*)(Lt_s + 160);
    La7 = *(const f32x4*)(Lt_s + 164);
    La8 = *(const f32x4*)(Lt_s + 168);
    La9 = *(const f32x4*)(Lt_s + 172);
    La10 = *(const f32x4*)(Lt_s + 176);
    La11 = *(const f32x4*)(Lt_s + 180);
    La12 = *(const f32x4*)(Lt_s + 184);
    La13 = *(const f32x4*)(Lt_s + 188);
    La14 = *(const f32x4*)(Lt_s + 192);
    La15 = *(const f32x4*)(Lt_s + 196);
    __builtin_amdgcn_sched_barrier(0);
    { const float xj = X0[1]; const f32x2 xj2 = (f32x2){xj, xj};
      X1 -= (f32x2){Lb0[2], Lb0[3]} * xj2;
      X2 -= (f32x2){Lb1[0], Lb1[1]} * xj2;
      X3 -= (f32x2){Lb1[2], Lb1[3]} * xj2;
      X4 -= (f32x2){Lb2[0], Lb2[1]} * xj2;
      X5 -= (f32x2){Lb2[2], Lb2[3]} * xj2;
      X6 -= (f32x2){Lb3[0], Lb3[1]} * xj2;
      X7 -= (f32x2){Lb3[2], Lb3[3]} * xj2;
      X8 -= (f32x2){Lb4[0], Lb4[1]} * xj2;
      X9 -= (f32x2){Lb4[2], Lb4[3]} * xj2;
      X10 -= (f32x2){Lb5[0], Lb5[1]} * xj2;
      X11 -= (f32x2){Lb5[2], Lb5[3]} * xj2;
      X12 -= (f32x2){Lb6[0], Lb6[1]} * xj2;
      X13 -= (f32x2){Lb6[2], Lb6[3]} * xj2;
      X14 -= (f32x2){Lb7[0], Lb7[1]} * xj2;
      X15 -= (f32x2){Lb7[2], Lb7[3]} * xj2;
      X16 -= (f32x2){Lb8[0], Lb8[1]} * xj2;
      X17 -= (f32x2){Lb8[2], Lb8[3]} * xj2;
      X18 -= (f32x2){Lb9[0], Lb9[1]} * xj2;
      X19 -= (f32x2){Lb9[2], Lb9[3]} * xj2;
      X20 -= (f32x2){Lb10[0], Lb10[1]} * xj2;
      X21 -= (f32x2){Lb10[2], Lb10[3]} * xj2;
      X22 -= (f32x2){Lb11[0], Lb11[1]} * xj2;
      X23 -= (f32x2){Lb11[2], Lb11[3]} * xj2;
      X24 -= (f32x2){Lb12[0], Lb12[1]} * xj2;
      X25 -= (f32x2){Lb12[2], Lb12[3]} * xj2;
      X26 -= (f32x2){Lb13[0], Lb13[1]} * xj2;
      X27 -= (f32x2){Lb13[2], Lb13[3]} * xj2;
      X28 -= (f32x2){Lb14[0], Lb14[1]} * xj2;
      X29 -= (f32x2){Lb14[2], Lb14[3]} * xj2;
      X30 -= (f32x2){Lb15[0], Lb15[1]} * xj2;
      X31 -= (f32x2){Lb15[2], Lb15[3]} * xj2;
    }
    __builtin_amdgcn_sched_barrier(0);
    Lb1 = *(const f32x4*)(Lt_s + 208);
    Lb2 = *(const f32x4*)(Lt_s + 212);
    Lb3 = *(const f32x4*)(Lt_s + 216);
    Lb4 = *(const f32x4*)(Lt_s + 220);
    Lb5 = *(const f32x4*)(Lt_s + 224);
    Lb6 = *(const f32x4*)(Lt_s + 228);
    Lb7 = *(const f32x4*)(Lt_s + 232);
    Lb8 = *(const f32x4*)(Lt_s + 236);
    Lb9 = *(const f32x4*)(Lt_s + 240);
    Lb10 = *(const f32x4*)(Lt_s + 244);
    Lb11 = *(const f32x4*)(Lt_s + 248);
    Lb12 = *(const f32x4*)(Lt_s + 252);
    Lb13 = *(const f32x4*)(Lt_s + 256);
    Lb14 = *(const f32x4*)(Lt_s + 260);
    Lb15 = *(const f32x4*)(Lt_s + 264);
    __builtin_amdgcn_sched_barrier(0);
    { const float xj = X1[0]; const f32x2 xj2 = (f32x2){xj, xj};
      X1 -= (f32x2){La0[2], La0[3]} * xj2;
      X2 -= (f32x2){La1[0], La1[1]} * xj2;
      X3 -= (f32x2){La1[2], La1[3]} * xj2;
      X4 -= (f32x2){La2[0], La2[1]} * xj2;
      X5 -= (f32x2){La2[2], La2[3]} * xj2;
      X6 -= (f32x2){La3[0], La3[1]} * xj2;
      X7 -= (f32x2){La3[2], La3[3]} * xj2;
      X8 -= (f32x2){La4[0], La4[1]} * xj2;
      X9 -= (f32x2){La4[2], La4[3]} * xj2;
      X10 -= (f32x2){La5[0], La5[1]} * xj2;
      X11 -= (f32x2){La5[2], La5[3]} * xj2;
      X12 -= (f32x2){La6[0], La6[1]} * xj2;
      X13 -= (f32x2){La6[2], La6[3]} * xj2;
      X14 -= (f32x2){La7[0], La7[1]} * xj2;
      X15 -= (f32x2){La7[2], La7[3]} * xj2;
      X16 -= (f32x2){La8[0], La8[1]} * xj2;
      X17 -= (f32x2){La8[2], La8[3]} * xj2;
      X18 -= (f32x2){La9[0], La9[1]} * xj2;
      X19 -= (f32x2){La9[2], La9[3]} * xj2;
      X20 -= (f32x2){La10[0], La10[1]} * xj2;
      X21 -= (f32x2){La10[2], La10[3]} * xj2;
      X22 -= (f32x2){La11[0], La11[1]} * xj2;
      X23 -= (f32x2){La11[2], La11[3]} * xj2;
      X24 -= (f32x2){La12[0], La12[1]} * xj2;
      X25 -= (f32x2){La12[2], La12[3]} * xj2;
      X26 -= (f32x2){La13[0], La13[1]} * xj2;
      X27 -= (f32x2){La13[2], La13[3]} * xj2;
      X28 -= (f32x2){La14[0], La14[1]} * xj2;
      X29 -= (f32x2){La14[2], La14[3]} * xj2;
      X30 -= (f32x2){La15[0], La15[1]} * xj2;
      X31 -= (f32x2){La15[2], La15[3]} * xj2;
    }
    __builtin_amdgcn_sched_barrier(0);
    La1 = *(const f32x4*)(Lt_s + 276);
    La2 = *(const f32x4*)(Lt_s + 280);
    La3 = *(const f32x4*)(Lt_s + 284);
    La4 = *(const f32x4*)(Lt_s + 288);
    La5 = *(const f32x4*)(Lt_s + 292);
    La6 = *(const f32x4*)(Lt_s + 296);
    La7 = *(const f32x4*)(Lt_s + 300);
    La8 = *(const f32x4*)(Lt_s + 304);
    La9 = *(const f32x4*)(Lt_s + 308);
    La10 = *(const f32x4*)(Lt_s + 312);
    La11 = *(const f32x4*)(Lt_s + 316);
    La12 = *(const f32x4*)(Lt_s + 320);
    La13 = *(const f32x4*)(Lt_s + 324);
    La14 = *(const f32x4*)(Lt_s + 328);
    La15 = *(const f32x4*)(Lt_s + 332);
    __builtin_amdgcn_sched_barrier(0);
    { const float xj = X1[1]; const f32x2 xj2 = (f32x2){xj, xj};
      X2 -= (f32x2){Lb1[0], Lb1[1]} * xj2;
      X3 -= (f32x2){Lb1[2], Lb1[3]} * xj2;
      X4 -= (f32x2){Lb2[0], Lb2[1]} * xj2;
      X5 -= (f32x2){Lb2[2], Lb2[3]} * xj2;
      X6 -= (f32x2){Lb3[0], Lb3[1]} * xj2;
      X7 -= (f32x2){Lb3[2], Lb3[3]} * xj2;
      X8 -= (f32x2){Lb4[0], Lb4[1]} * xj2;
      X9 -= (f32x2){Lb4[2], Lb4[3]} * xj2;
      X10 -= (f32x2){Lb5[0], Lb5[1]} * xj2;
      X11 -= (f32x2){Lb5[2], Lb5[3]} * xj2;
      X12 -= (f32x2){Lb6[0], Lb6[1]} * xj2;
      X13 -= (f32x2){Lb6[2], Lb6[3]} * xj2;
      X14 -= (f32x2){Lb7[0], Lb7[1]} * xj2;
      X15 -= (f32x2){Lb7[2], Lb7[3]} * xj2;
      X16 -= (f32x2){Lb8[0], Lb8[1]} * xj2;
      X17 -= (f32x2){Lb8[2], Lb8[3]} * xj2;
      X18 -= (f32x2){Lb9[0], Lb9[1]} * xj2;
      X19 -= (f32x2){Lb9[2], Lb9[3]} * xj2;
      X20 -= (f32x2){Lb10[0], Lb10[1]} * xj2;
      X21 -= (f32x2){Lb10[2], Lb10[3]} * xj2;
      X22 -= (f32x2){Lb11[0], Lb11[1]} * xj2;
      X23 -= (f32x2){Lb11[2], Lb11[3]} * xj2;
      X24 -= (f32x2){Lb12[0], Lb12[1]} * xj2;
      X25 -= (f32x2){Lb12[2], Lb12[3]} * xj2;
      X26 -= (f32x2){Lb13[0], Lb13[1]} * xj2;
      X27 -= (f32x2){Lb13[2], Lb13[3]} * xj2;
      X28 -= (f32x2){Lb14[0], Lb14[1]} * xj2;
      X29 -= (f32x2){Lb14[2], Lb14[3]} * xj2;
      X30 -= (f32x2){Lb15[0], Lb15[1]} * xj2;
      X31 -= (f32x2){Lb15[2], Lb15[3]} * xj2;
    }
    __builtin_amdgcn_sched_barrier(0);
    Lb1 = *(const f32x4*)(Lt_s + 344);
    Lb2 = *(const f32x4*)(Lt_s + 348);
    Lb3 = *(const f32x4*)(Lt_s + 352);
    Lb4 = *(const f32x4*)(Lt_s + 356);
    Lb5 = *(const f32x4*)(Lt_s + 360);
    Lb6 = *(const f32x4*)(Lt_s + 364);
    Lb7 = *(const f32x4*)(Lt_s + 368);
    Lb8 = *(const f32x4*)(Lt_s + 372);
    Lb9 = *(const f32x4*)(Lt_s + 376);
    Lb10 = *(const f32x4*)(Lt_s + 380);
    Lb11 = *(const f32x4*)(Lt_s + 384);
    Lb12 = *(const f32x4*)(Lt_s + 388);
    Lb13 = *(const f32x4*)(Lt_s + 392);
    Lb14 = *(const f32x4*)(Lt_s + 396);
    Lb15 = *(const f32x4*)(Lt_s + 400);
    __builtin_amdgcn_sched_barrier(0);
    { const float xj = X2[0]; const f32x2 xj2 = (f32x2){xj, xj};
      X2 -= (f32x2){La1[0], La1[1]} * xj2;
      X3 -= (f32x2){La1[2], La1[3]} * xj2;
      X4 -= (f32x2){La2[0], La2[1]} * xj2;
      X5 -= (f32x2){La2[2], La2[3]} * xj2;
      X6 -= (f32x2){La3[0], La3[1]} * xj2;
      X7 -= (f32x2){La3[2], La3[3]} * xj2;
      X8 -= (f32x2){La4[0], La4[1]} * xj2;
      X9 -= (f32x2){La4[2], La4[3]} * xj2;
      X10 -= (f32x2){La5[0], La5[1]} * xj2;
      X11 -= (f32x2){La5[2], La5[3]} * xj2;
      X12 -= (f32x2){La6[0], La6[1]} * xj2;
      X13 -= (f32x2){La6[2], La6[3]} * xj2;
      X14 -= (f32x2){La7[0], La7[1]} * xj2;
      X15 -= (f32x2){La7[2], La7[3]} * xj2;
      X16 -= (f32x2){La8[0], La8[1]} * xj2;
      X17 -= (f32x2){La8[2], La8[3]} * xj2;
      X18 -= (f32x2){La9[0], La9[1]} * xj2;
      X19 -= (f32x2){La9[2], La9[3]} * xj2;
      X20 -= (f32x2){La10[0], La10[1]} * xj2;
      X21 -= (f32x2){La10[2], La10[3]} * xj2;
      X22 -= (f32x2){La11[0], La11[1]} * xj2;
      X23 -= (f32x2){La11[2], La11[3]} * xj2;
      X24 -= (f32x2){La12[0], La12[1]} * xj2;
      X25 -= (f32x2){La12[2], La12[3]} * xj2;
      X26 -= (f32x2){La13[0], La13[1]} * xj2;
      X27 -= (f32x2){La13[2], La13[3]} * xj2;
      X28 -= (f32x2){La14[0], La14[1]} * xj2;
      X29 -= (f32x2){La14[2], La14[3]} * xj2;
      X30 -= (f32x2){La15[0], La15[1]} * xj2;
      X31 -= (f32x2){La15[2], La15[3]} * xj2;
    }
    __builtin_amdgcn_sched_barrier(0);
    La1 = *(const f32x4*)(Lt_s + 412);
    La2 = *(const f32x4*)(Lt_s + 416);
    La3 = *(const f32x4*)(Lt_s + 420);
    La4 = *(const f32x4*)(Lt_s + 424);
    La5 = *(const f32x4*)(Lt_s + 428);
    La6 = *(const f32x4*)(Lt_s + 432);
    La7 = *(const f32x4*)(Lt_s + 436);
    La8 = *(const f32x4*)(Lt_s + 440);
    La9 = *(const f32x4*)(Lt_s + 444);
    La10 = *(const f32x4*)(Lt_s + 448);
    La11 = *(const f32x4*)(Lt_s + 452);
    La12 = *(const f32x4*)(Lt_s + 456);
    La13 = *(const f32x4*)(Lt_s + 460);
    La14 = *(const f32x4*)(Lt_s + 464);
    La15 = *(const f32x4*)(Lt_s + 468);
    __builtin_amdgcn_sched_barrier(0);
    { const float xj = X2[1]; const f32x2 xj2 = (f32x2){xj, xj};
      X3 -= (f32x2){Lb1[2], Lb1[3]} * xj2;
      X4 -= (f32x2){Lb2[0], Lb2[1]} * xj2;
      X5 -= (f32x2){Lb2[2], Lb2[3]} * xj2;
      X6 -= (f32x2){Lb3[0], Lb3[1]} * xj2;
      X7 -= (f32x2){Lb3[2], Lb3[3]} * xj2;
      X8 -= (f32x2){Lb4[0], Lb4[1]} * xj2;
      X9 -= (f32x2){Lb4[2], Lb4[3]} * xj2;
      X10 -= (f32x2){Lb5[0], Lb5[1]} * xj2;
      X11 -= (f32x2){Lb5[2], Lb5[3]} * xj2;
      X12 -= (f32x2){Lb6[0], Lb6[1]} * xj2;
      X13 -= (f32x2){Lb6[2], Lb6[3]} * xj2;
      X14 -= (f32x2){Lb7[0], Lb7[1]} * xj2;
      X15 -= (f32x2){Lb7[2], Lb7[3]} * xj2;
      X16 -= (f32x2){Lb8[0], Lb8[1]} * xj2;
      X17 -= (f32x2){Lb8[2], Lb8[3]} * xj2;
      X18 -= (f32x2){Lb9[0], Lb9[1]} * xj2;
      X19 -= (f32x2){Lb9[2], Lb9[3]} * xj2;
      X20 -= (f32x2){Lb10[0], Lb10[1]} * xj2;
      X21 -= (f32x2){Lb10[2], Lb10[3]} * xj2;
      X22 -= (f32x2){Lb11[0], Lb11[1]} * xj2;
      X23 -= (f32x2){Lb11[2], Lb11[3]} * xj2;
      X24 -= (f32x2){Lb12[0], Lb12[1]} * xj2;
      X25 -= (f32x2){Lb12[2], Lb12[3]} * xj2;
      X26 -= (f32x2){Lb13[0], Lb13[1]} * xj2;
      X27 -= (f32x2){Lb13[2], Lb13[3]} * xj2;
      X28 -= (f32x2){Lb14[0], Lb14[1]} * xj2;
      X29 -= (f32x2){Lb14[2], Lb14[3]} * xj2;
      X30 -= (f32x2){Lb15[0], Lb15[1]} * xj2;
      X31 -= (f32x2){Lb15[2], Lb15[3]} * xj2;
    }
    __builtin_amdgcn_sched_barrier(0);
    Lb2 = *(const f32x4*)(Lt_s + 484);
    Lb3 = *(const f32x4*)(Lt_s + 488);
    Lb4 = *(const f32x4*)(Lt_s + 492);
    Lb5 = *(const f32x4*)(Lt_s + 496);
    Lb6 = *(const f32x4*)(Lt_s + 500);
    Lb7 = *(const f32x4*)(Lt_s + 504);
    Lb8 = *(const f32x4*)(Lt_s + 508);
    Lb9 = *(const f32x4*)(Lt_s + 512);
    Lb10 = *(const f32x4*)(Lt_s + 516);
    Lb11 = *(const f32x4*)(Lt_s + 520);
    Lb12 = *(const f32x4*)(Lt_s + 524);
    Lb13 = *(const f32x4*)(Lt_s + 528);
    Lb14 = *(const f32x4*)(Lt_s + 532);
    Lb15 = *(const f32x4*)(Lt_s + 536);
    __builtin_amdgcn_sched_barrier(0);
    { const float xj = X3[0]; const f32x2 xj2 = (f32x2){xj, xj};
      X3 -= (f32x2){La1[2], La1[3]} * xj2;
      X4 -= (f32x2){La2[0], La2[1]} * xj2;
      X5 -= (f32x2){La2[2], La2[3]} * xj2;
      X6 -= (f32x2){La3[0], La3[1]} * xj2;
      X7 -= (f32x2){La3[2], La3[3]} * xj2;
      X8 -= (f32x2){La4[0], La4[1]} * xj2;
      X9 -= (f32x2){La4[2], La4[3]} * xj2;
      X10 -= (f32x2){La5[0], La5[1]} * xj2;
      X11 -= (f32x2){La5[2], La5[3]} * xj2;
      X12 -= (f32x2){La6[0], La6[1]} * xj2;
      X13 -= (f32x2){La6[2], La6[3]} * xj2;
      X14 -= (f32x2){La7[0], La7[1]} * xj2;
      X15 -= (f32x2){La7[2], La7[3]} * xj2;
      X16 -= (f32x2){La8[0], La8[1]} * xj2;
      X17 -= (f32x2){La8[2], La8[3]} * xj2;
      X18 -= (f32x2){La9[0], La9[1]} * xj2;
      X19 -= (f32x2){La9[2], La9[3]} * xj2;
      X20 -= (f32x2){La10[0], La10[1]} * xj2;
      X21 -= (f32x2){La10[2], La10[3]} * xj2;
      X22 -= (f32x2){La11[0], La11[1]} * xj2;
      X23 -= (f32x2){La11[2], La11[3]} * xj2;
      X24 -= (f32x2){La12[0], La12[1]} * xj2;
      X25 -= (f32x2){La12[2], La12[3]} * xj2;
      X26 -= (f32x2){La13[0], La13[1]} * xj2;
      X27 -= (f32x2){La13[2], La13[3]} * xj2;
      X28 -= (f32x2){La14[0], La14[1]} * xj2;
      X29 -= (f32x2){La14[2], La14[3]} * xj2;
      X30 -= (f32x2){La15[0], La15[1]} * xj2;
      X31 -= (f32x2){La15[2], La15[3]} * xj2;
    }
    __builtin_amdgcn_sched_barrier(0);
    La2 = *(const f32x4*)(Lt_s + 552);
    La3 = *(const f32x4*)(Lt_s + 556);
    La4 = *(const f32x4*)(Lt_s + 560);
    La5 = *(const f32x4*)(Lt_s + 564);
    La6 = *(const f32x4*)(Lt_s + 568);
    La7 = *(const f32x4*)(Lt_s + 572);
    La8 = *(const f32x4*)(Lt_s + 576);
    La9 = *(const f32x4*)(Lt_s + 580);
    La10 = *(const f32x4*)(Lt_s + 584);
    La11 = *(const f32x4*)(Lt_s + 588);
    La12 = *(const f32x4*)(Lt_s + 592);
    La13 = *(const f32x4*)(Lt_s + 596);
    La14 = *(const f32x4*)(Lt_s + 600);
    La15 = *(const f32x4*)(Lt_s + 604);
    __builtin_amdgcn_sched_barrier(0);
    { const float xj = X3[1]; const f32x2 xj2 = (f32x2){xj, xj};
      X4 -= (f32x2){Lb2[0], Lb2[1]} * xj2;
      X5 -= (f32x2){Lb2[2], Lb2[3]} * xj2;
      X6 -= (f32x2){Lb3[0], Lb3[1]} * xj2;
      X7 -= (f32x2){Lb3[2], Lb3[3]} * xj2;
      X8 -= (f32x2){Lb4[0], Lb4[1]} * xj2;
      X9 -= (f32x2){Lb4[2], Lb4[3]} * xj2;
      X10 -= (f32x2){Lb5[0], Lb5[1]} * xj2;
      X11 -= (f32x2){Lb5[2], Lb5[3]} * xj2;
      X12 -= (f32x2){Lb6[0], Lb6[1]} * xj2;
      X13 -= (f32x2){Lb6[2], Lb6[3]} * xj2;
      X14 -= (f32x2){Lb7[0], Lb7[1]} * xj2;
      X15 -= (f32x2){Lb7[2], Lb7[3]} * xj2;
      X16 -= (f32x2){Lb8[0], Lb8[1]} * xj2;
      X17 -= (f32x2){Lb8[2], Lb8[3]} * xj2;
      X18 -= (f32x2){Lb9[0], Lb9[1]} * xj2;
      X19 -= (f32x2){Lb9[2], Lb9[3]} * xj2;
      X20 -= (f32x2){Lb10[0], Lb10[1]} * xj2;
      X21 -= (f32x2){Lb10[2], Lb10[3]} * xj2;
      X22 -= (f32x2){Lb11[0], Lb11[1]} * xj2;
      X23 -= (f32x2){Lb11[2], Lb11[3]} * xj2;
      X24 -= (f32x2){Lb12[0], Lb12[1]} * xj2;
      X25 -= (f32x2){Lb12[2], Lb12[3]} * xj2;
      X26 -= (f32x2){Lb13[0], Lb13[1]} * xj2;
      X27 -= (f32x2){Lb13[2], Lb13[3]} * xj2;
      X28 -= (f32x2){Lb14[0], Lb14[1]} * xj2;
      X29 -= (f32x2){Lb14[2], Lb14[3]} * xj2;
      X30 -= (f32x2){Lb15[0], Lb15[1]} * xj2;
      X31 -= (f32x2){Lb15[2], Lb15[3]} * xj2;
    }
    __builtin_amdgcn_sched_barrier(0);
    Lb2 = *(const f32x4*)(Lt_s + 620);
    Lb3 = *(const f32x4*)(Lt_s + 624);
    Lb4 = *(const f32x4*)(Lt_s + 628);
    Lb5 = *(const f32x4*)(Lt_s + 632);
    Lb6 = *(const f32x4*)(Lt_s + 636);
    Lb7 = *(const f32x4*)(Lt_s + 640);
    Lb8 = *(const f32x4*)(Lt_s + 644);
    Lb9 = *(const f32x4*)(Lt_s + 648);
    Lb10 = *(const f32x4*)(Lt_s + 652);
    Lb11 = *(const f32x4*)(Lt_s + 656);
    Lb12 = *(const f32x4*)(Lt_s + 660);
    Lb13 = *(const f32x4*)(Lt_s + 664);
    Lb14 = *(const f32x4*)(Lt_s + 668);
    Lb15 = *(const f32x4*)(Lt_s + 672);
    __builtin_amdgcn_sched_barrier(0);
    { const float xj = X4[0]; const f32x2 xj2 = (f32x2){xj, xj};
      X4 -= (f32x2){La2[0], La2[1]} * xj2;
      X5 -= (f32x2){La2[2], La2[3]} * xj2;
      X6 -= (f32x2){La3[0], La3[1]} * xj2;
      X7 -= (f32x2){La3[2], La3[3]} * xj2;
      X8 -= (f32x2){La4[0], La4[1]} * xj2;
      X9 -= (f32x2){La4[2], La4[3]} * xj2;
      X10 -= (f32x2){La5[0], La5[1]} * xj2;
      X11 -= (f32x2){La5[2], La5[3]} * xj2;
      X12 -= (f32x2){La6[0], La6[1]} * xj2;
      X13 -= (f32x2){La6[2], La6[3]} * xj2;
      X14 -= (f32x2){La7[0], La7[1]} * xj2;
      X15 -= (f32x2){La7[2], La7[3]} * xj2;
      X16 -= (f32x2){La8[0], La8[1]} * xj2;
      X17 -= (f32x2){La8[2], La8[3]} * xj2;
      X18 -= (f32x2){La9[0], La9[1]} * xj2;
      X19 -= (f32x2){La9[2], La9[3]} * xj2;
      X20 -= (f32x2){La10[0], La10[1]} * xj2;
      X21 -= (f32x2){La10[2], La10[3]} * xj2;
      X22 -= (f32x2){La11[0], La11[1]} * xj2;
      X23 -= (f32x2){La11[2], La11[3]} * xj2;
      X24 -= (f32x2){La12[0], La12[1]} * xj2;
      X25 -= (f32x2){La12[2], La12[3]} * xj2;
      X26 -= (f32x2){La13[0], La13[1]} * xj2;
      X27 -= (f32x2){La13[2], La13[3]} * xj2;
      X28 -= (f32x2){La14[0], La14[1]} * xj2;
      X29 -= (f32x2){La14[2], La14[3]} * xj2;
      X30 -= (f32x2){La15[0], La15[1]} * xj2;
      X31 -= (f32x2){La15[2], La15[3]} * xj2;
    }
    __builtin_amdgcn_sched_barrier(0);
    La2 = *(const f32x4*)(Lt_s + 688);
    La3 = *(const f32x4*)(Lt_s + 692);
    La4 = *(const f32x4*)(Lt_s + 696);
    La5 = *(const f32x4*)(Lt_s + 700);
    La6 = *(const f32x4*)(Lt_s + 704);
    La7 = *(const f32x4*)(Lt_s + 708);
    La8 = *(const f32x4*)(Lt_s + 712);
    La9 = *(const f32x4*)(Lt_s + 716);
    La10 = *(const f32x4*)(Lt_s + 720);
    La11 = *(const f32x4*)(Lt_s + 724);
    La12 = *(const f32x4*)(Lt_s + 728);
    La13 = *(const f32x4*)(Lt_s + 732);
    La14 = *(const f32x4*)(Lt_s + 736);
    La15 = *(const f32x4*)(Lt_s + 740);
    __builtin_amdgcn_sched_barrier(0);
    { const float xj = X4[1]; const f32x2 xj2 = (f32x2){xj, xj};
      X5 -= (f32x2){Lb2[2], Lb2[3]} * xj2;
      X6 -= (f32x2){Lb3[0], Lb3[1]} * xj2;
      X7 -= (f32x2){Lb3[2], Lb3[3]} * xj2;
      X8 -= (f32x2){Lb4[0], Lb4[1]} * xj2;
      X9 -= (f32x2){Lb4[2], Lb4[3]} * xj2;
      X10 -= (f32x2){Lb5[0], Lb5[1]} * xj2;
      X11 -= (f32x2){Lb5[2], Lb5[3]} * xj2;
      X12 -= (f32x2){Lb6[0], Lb6[1]} * xj2;
      X13 -= (f32x2){Lb6[2], Lb6[3]} * xj2;
      X14 -= (f32x2){Lb7[0], Lb7[1]} * xj2;
      X15 -= (f32x2){Lb7[2], Lb7[3]} * xj2;
      X16 -= (f32x2){Lb8[0], Lb8[1]} * xj2;
      X17 -= (f32x2){Lb8[2], Lb8[3]} * xj2;
      X18 -= (f32x2){Lb9[0], Lb9[1]} * xj2;
      X19 -= (f32x2){Lb9[2], Lb9[3]} * xj2;
      X20 -= (f32x2){Lb10[0], Lb10[1]} * xj2;
      X21 -= (f32x2){Lb10[2], Lb10[3]} * xj2;
      X22 -= (f32x2){Lb11[0], Lb11[1]} * xj2;
      X23 -= (f32x2){Lb11[2], Lb11[3]} * xj2;
      X24 -= (f32x2){Lb12[0], Lb12[1]} * xj2;
      X25 -= (f32x2){Lb12[2], Lb12[3]} * xj2;
      X26 -= (f32x2){Lb13[0], Lb13[1]} * xj2;
      X27 -= (f32x2){Lb13[2], Lb13[3]} * xj2;
      X28 -= (f32x2){Lb14[0], Lb14[1]} * xj2;
      X29 -= (f32x2){Lb14[2], Lb14[3]} * xj2;
      X30 -= (f32x2){Lb15[0], Lb15[1]} * xj2;
      X31 -= (f32x2){Lb15[2], Lb15[3]} * xj2;
    }
    __builtin_amdgcn_sched_barrier(0);
    Lb3 = *(const f32x4*)(Lt_s + 760);
    Lb4 = *(const f32x4*)(Lt_s + 764);
    Lb5 = *(const f32x4*)(Lt_s + 768);
    Lb6 = *(const f32x4*)(Lt_s + 772);
    Lb7 = *(const f32x4*)(Lt_s + 776);
    Lb8 = *(const f32x4*)(Lt_s + 780);
    Lb9 = *(const f32x4*)(Lt_s + 784);
    Lb10 = *(const f32x4*)(Lt_s + 788);
    Lb11 = *(const f32x4*)(Lt_s + 792);
    Lb12 = *(const f32x4*)(Lt_s + 796);
    Lb13 = *(const f32x4*)(Lt_s + 800);
    Lb14 = *(const f32x4*)(Lt_s + 804);
    Lb15 = *(const f32x4*)(Lt_s + 808);
    __builtin_amdgcn_sched_barrier(0);
    { const float xj = X5[0]; const f32x2 xj2 = (f32x2){xj, xj};
      X5 -= (f32x2){La2[2], La2[3]} * xj2;
      X6 -= (f32x2){La3[0], La3[1]} * xj2;
      X7 -= (f32x2){La3[2], La3[3]} * xj2;
      X8 -= (f32x2){La4[0], La4[1]} * xj2;
      X9 -= (f32x2){La4[2], La4[3]} * xj2;
      X10 -= (f32x2){La5[0], La5[1]} * xj2;
      X11 -= (f32x2){La5[2], La5[3]} * xj2;
      X12 -= (f32x2){La6[0], La6[1]} * xj2;
      X13 -= (f32x2){La6[2], La6[3]} * xj2;
      X14 -= (f32x2){La7[0], La7[1]} * xj2;
      X15 -= (f32x2){La7[2], La7[3]} * xj2;
      X16 -= (f32x2){La8[0], La8[1]} * xj2;
      X17 -= (f32x2){La8[2], La8[3]} * xj2;
      X18 -= (f32x2){La9[0], La9[1]} * xj2;
      X19 -= (f32x2){La9[2], La9[3]} * xj2;
      X20 -= (f32x2){La10[0], La10[1]} * xj2;
      X21 -= (f32x2){La10[2], La10[3]} * xj2;
      X22 -= (f32x2){La11[0], La11[1]} * xj2;
      X23 -= (f32x2){La11[2], La11[3]} * xj2;
      X24 -= (f32x2){La12[0], La12[1]} * xj2;
      X25 -= (f32x2){La12[2], La12[3]} * xj2;
      X26 -= (f32x2){La13[0], La13[1]} * xj2;
      X27 -= (f32x2){La13[2], La13[3]} * xj2;
      X28 -= (f32x2){La14[0], La14[1]} * xj2;
      X29 -= (f32x2){La14[2], La14[3]} * xj2;
      X30 -= (f32x2){La15[0], La15[1]} * xj2;
      X31 -= (f32x2){La15[2], La15[3]} * xj2;
    }
    __builtin_amdgcn_sched_barrier(0);
    La3 = *(const f32x4*)(Lt_s + 828);
    La4 = *(const f32x4*)(Lt_s + 832);
    La5 = *(const f32x4*)(Lt_s + 836);
    La6 = *(const f32x4*)(Lt_s + 840);
    La7 = *(const f32x4*)(Lt_s + 844);
    La8 = *(const f32x4*)(Lt_s + 848);
    La9 = *(const f32x4*)(Lt_s + 852);
    La10 = *(const f32x4*)(Lt_s + 856);
    La11 = *(const f32x4*)(Lt_s + 860);
    La12 = *(const f32x4*)(Lt_s + 864);
    La13 = *(const f32x4*)(Lt_s + 868);
    La14 = *(const f32x4*)(Lt_s + 872);
    La15 = *(const f32x4*)(Lt_s + 876);
    __builtin_amdgcn_sched_barrier(0);
    { const float xj = X5[1]; const f32x2 xj2 = (f32x2){xj, xj};
      X6 -= (f32x2){Lb3[0], Lb3[1]} * xj2;
      X7 -= (f32x2){Lb3[2], Lb3[3]} * xj2;
      X8 -= (f32x2){Lb4[0], Lb4[1]} * xj2;
      X9 -= (f32x2){Lb4[2], Lb4[3]} * xj2;
      X10 -= (f32x2){Lb5[0], Lb5[1]} * xj2;
      X11 -= (f32x2){Lb5[2], Lb5[3]} * xj2;
      X12 -= (f32x2){Lb6[0], Lb6[1]} * xj2;
      X13 -= (f32x2){Lb6[2], Lb6[3]} * xj2;
      X14 -= (f32x2){Lb7[0], Lb7[1]} * xj2;
      X15 -= (f32x2){Lb7[2], Lb7[3]} * xj2;
      X16 -= (f32x2){Lb8[0], Lb8[1]} * xj2;
      X17 -= (f32x2){Lb8[2], Lb8[3]} * xj2;
      X18 -= (f32x2){Lb9[0], Lb9[1]} * xj2;
      X19 -= (f32x2){Lb9[2], Lb9[3]} * xj2;
      X20 -= (f32x2){Lb10[0], Lb10[1]} * xj2;
      X21 -= (f32x2){Lb10[2], Lb10[3]} * xj2;
      X22 -= (f32x2){Lb11[0], Lb11[1]} * xj2;
      X23 -= (f32x2){Lb11[2], Lb11[3]} * xj2;
      X24 -= (f32x2){Lb12[0], Lb12[1]} * xj2;
      X25 -= (f32x2){Lb12[2], Lb12[3]} * xj2;
      X26 -= (f32x2){Lb13[0], Lb13[1]} * xj2;
      X27 -= (f32x2){Lb13[2], Lb13[3]} * xj2;
      X28 -= (f32x2){Lb14[0], Lb14[1]} * xj2;
      X29 -= (f32x2){Lb14[2], Lb14[3]} * xj2;
      X30 -= (f32x2){Lb15[0], Lb15[1]} * xj2;
      X31 -= (f32x2){Lb15[2], Lb15[3]} * xj2;
    }
    __builtin_amdgcn_sched_barrier(0);
    Lb3 = *(const f32x4*)(Lt_s + 896);
    Lb4 = *(const f32x4*)(Lt_s + 900);
    Lb5 = *(const f32x4*)(Lt_s + 904);
    Lb6 = *(const f32x4*)(Lt_s + 908);
    Lb7 = *(const f32x4*)(Lt_s + 912);
    Lb8 = *(const f32x4*)(Lt_s + 916);
    Lb9 = *(const f32x4*)(Lt_s + 920);
    Lb10 = *(const f32x4*)(Lt_s + 924);
    Lb11 = *(const f32x4*)(Lt_s + 928);
    Lb12 = *(const f32x4*)(Lt_s + 932);
    Lb13 = *(const f32x4*)(Lt_s + 936);
    Lb14 = *(const f32x4*)(Lt_s + 940);
    Lb15 = *(const f32x4*)(Lt_s + 944);
    __builtin_amdgcn_sched_barrier(0);
    { const float xj = X6[0]; const f32x2 xj2 = (f32x2){xj, xj};
      X6 -= (f32x2){La3[0], La3[1]} * xj2;
      X7 -= (f32x2){La3[2], La3[3]} * xj2;
      X8 -= (f32x2){La4[0], La4[1]} * xj2;
      X9 -= (f32x2){La4[2], La4[3]} * xj2;
      X10 -= (f32x2){La5[0], La5[1]} * xj2;
      X11 -= (f32x2){La5[2], La5[3]} * xj2;
      X12 -= (f32x2){La6[0], La6[1]} * xj2;
      X13 -= (f32x2){La6[2], La6[3]} * xj2;
      X14 -= (f32x2){La7[0], La7[1]} * xj2;
      X15 -= (f32x2){La7[2], La7[3]} * xj2;
      X16 -= (f32x2){La8[0], La8[1]} * xj2;
      X17 -= (f32x2){La8[2], La8[3]} * xj2;
      X18 -= (f32x2){La9[0], La9[1]} * xj2;
      X19 -= (f32x2){La9[2], La9[3]} * xj2;
      X20 -= (f32x2){La10[0], La10[1]} * xj2;
      X21 -= (f32x2){La10[2], La10[3]} * xj2;
      X22 -= (f32x2){La11[0], La11[1]} * xj2;
      X23 -= (f32x2){La11[2], La11[3]} * xj2;
      X24 -= (f32x2){La12[0], La12[1]} * xj2;
      X25 -= (f32x2){La12[2], La12[3]} * xj2;
      X26 -= (f32x2){La13[0], La13[1]} * xj2;
      X27 -= (f32x2){La13[2], La13[3]} * xj2;
      X28 -= (f32x2){La14[0], La14[1]} * xj2;
      X29 -= (f32x2){La14[2], La14[3]} * xj2;
      X30 -= (f32x2){La15[0], La15[1]} * xj2;
      X31 -= (f32x2){La15[2], La15[3]} * xj2;
    }
    __builtin_amdgcn_sched_barrier(0);
    La3 = *(const f32x4*)(Lt_s + 964);
    La4 = *(const f32x4*)(Lt_s + 968);
    La5 = *(const f32x4*)(Lt_s + 972);
    La6 = *(const f32x4*)(Lt_s + 976);
    La7 = *(const f32x4*)(Lt_s + 980);
    La8 = *(const f32x4*)(Lt_s + 984);
    La9 = *(const f32x4*)(Lt_s + 988);
    La10 = *(const f32x4*)(Lt_s + 992);
    La11 = *(const f32x4*)(Lt_s + 996);
    La12 = *(const f32x4*)(Lt_s + 1000);
    La13 = *(const f32x4*)(Lt_s + 1004);
    La14 = *(const f32x4*)(Lt_s + 1008);
    La15 = *(const f32x4*)(Lt_s + 1012);
    __builtin_amdgcn_sched_barrier(0);
    { const float xj = X6[1]; const f32x2 xj2 = (f32x2){xj, xj};
      X7 -= (f32x2){Lb3[2], Lb3[3]} * xj2;
      X8 -= (f32x2){Lb4[0], Lb4[1]} * xj2;
      X9 -= (f32x2){Lb4[2], Lb4[3]} * xj2;
      X10 -= (f32x2){Lb5[0], Lb5[1]} * xj2;
      X11 -= (f32x2){Lb5[2], Lb5[3]} * xj2;
      X12 -= (f32x2){Lb6[0], Lb6[1]} * xj2;
      X13 -= (f32x2){Lb6[2], Lb6[3]} * xj2;
      X14 -= (f32x2){Lb7[0], Lb7[1]} * xj2;
      X15 -= (f32x2){Lb7[2], Lb7[3]} * xj2;
      X16 -= (f32x2){Lb8[0], Lb8[1]} * xj2;
      X17 -= (f32x2){Lb8[2], Lb8[3]} * xj2;
      X18 -= (f32x2){Lb9[0], Lb9[1]} * xj2;
      X19 -= (f32x2){Lb9[2], Lb9[3]} * xj2;
      X20 -= (f32x2){Lb10[0], Lb10[1]} * xj2;
      X21 -= (f32x2){Lb10[2], Lb10[3]} * xj2;
      X22 -= (f32x2){Lb11[0], Lb11[1]} * xj2;
      X23 -= (f32x2){Lb11[2], Lb11[3]} * xj2;
      X24 -= (f32x2){Lb12[0], Lb12[1]} * xj2;
      X25 -= (f32x2){Lb12[2], Lb12[3]} * xj2;
      X26 -= (f32x2){Lb13[0], Lb13[1]} * xj2;
      X27 -= (f32x2){Lb13[2], Lb13[3]} * xj2;
      X28 -= (f32x2){Lb14[0], Lb14[1]} * xj2;
      X29 -= (f32x2){Lb14[2], Lb14[3]} * xj2;
      X30 -= (f32x2){Lb15[0], Lb15[1]} * xj2;
      X31 -= (f32x2){Lb15[2], Lb15[3]} * xj2;
    }
    __builtin_amdgcn_sched_barrier(0);
    Lb4 = *(const f32x4*)(Lt_s + 1036);
    Lb5 = *(const f32x4*)(Lt_s + 1040);
    Lb6 = *(const f32x4*)(Lt_s + 1044);
    Lb7 = *(const f32x4*)(Lt_s + 1048);
    Lb8 = *(const f32x4*)(Lt_s + 1052);
    Lb9 = *(const f32x4*)(Lt_s + 1056);
    Lb10 = *(const f32x4*)(Lt_s + 1060);
    Lb11 = *(const f32x4*)(Lt_s + 1064);
    Lb12 = *(const f32x4*)(Lt_s + 1068);
    Lb13 = *(const f32x4*)(Lt_s + 1072);
    Lb14 = *(const f32x4*)(Lt_s + 1076);
    Lb15 = *(const f32x4*)(Lt_s + 1080);
    __builtin_amdgcn_sched_barrier(0);
    { const float xj = X7[0]; const f32x2 xj2 = (f32x2){xj, xj};
      X7 -= (f32x2){La3[2], La3[3]} * xj2;
      X8 -= (f32x2){La4[0], La4[1]} * xj2;
      X9 -= (f32x2){La4[2], La4[3]} * xj2;
      X10 -= (f32x2){La5[0], La5[1]} * xj2;
      X11 -= (f32x2){La5[2], La5[3]} * xj2;
      X12 -= (f32x2){La6[0], La6[1]} * xj2;
      X13 -= (f32x2){La6[2], La6[3]} * xj2;
      X14 -= (f32x2){La7[0], La7[1]} * xj2;
      X15 -= (f32x2){La7[2], La7[3]} * xj2;
      X16 -= (f32x2){La8[0], La8[1]} * xj2;
      X17 -= (f32x2){La8[2], La8[3]} * xj2;
      X18 -= (f32x2){La9[0], La9[1]} * xj2;
      X19 -= (f32x2){La9[2], La9[3]} * xj2;
      X20 -= (f32x2){La10[0], La10[1]} * xj2;
      X21 -= (f32x2){La10[2], La10[3]} * xj2;
      X22 -= (f32x2){La11[0], La11[1]} * xj2;
      X23 -= (f32x2){La11[2], La11[3]} * xj2;
      X24 -= (f32x2){La12[0], La12[1]} * xj2;
      X25 -= (f32x2){La12[2], La12[3]} * xj2;
      X26 -= (f32x2){La13[0], La13[1]} * xj2;
      X27 -= (f32x2){La13[2], La13[3]} * xj2;
      X28 -= (f32x2){La14[0], La14[1]} * xj2;
      X29 -= (f32x2){La14[2], La14[3]} * xj2;
      X30 -= (f32x2){La15[0], La15[1]} * xj2;
      X31 -= (f32x2){La15[2], La15[3]} * xj2;
    }
    __builtin_amdgcn_sched_barrier(0);
    La4 = *(const f32x4*)(Lt_s + 1104);
    La5 = *(const f32x4*)(Lt_s + 1108);
    La6 = *(const f32x4*)(Lt_s + 1112);
    La7 = *(const f32x4*)(Lt_s + 1116);
    La8 = *(const f32x4*)(Lt_s + 1120);
    La9 = *(const f32x4*)(Lt_s + 1124);
    La10 = *(const f32x4*)(Lt_s + 1128);
    La11 = *(const f32x4*)(Lt_s + 1132);
    La12 = *(const f32x4*)(Lt_s + 1136);
    La13 = *(const f32x4*)(Lt_s + 1140);
    La14 = *(const f32x4*)(Lt_s + 1144);
    La15 = *(const f32x4*)(Lt_s + 1148);
    __builtin_amdgcn_sched_barrier(0);
    { const float xj = X7[1]; const f32x2 xj2 = (f32x2){xj, xj};
      X8 -= (f32x2){Lb4[0], Lb4[1]} * xj2;
      X9 -= (f32x2){Lb4[2], Lb4[3]} * xj2;
      X10 -= (f32x2){Lb5[0], Lb5[1]} * xj2;
      X11 -= (f32x2){Lb5[2], Lb5[3]} * xj2;
      X12 -= (f32x2){Lb6[0], Lb6[1]} * xj2;
      X13 -= (f32x2){Lb6[2], Lb6[3]} * xj2;
      X14 -= (f32x2){Lb7[0], Lb7[1]} * xj2;
      X15 -= (f32x2){Lb7[2], Lb7[3]} * xj2;
      X16 -= (f32x2){Lb8[0], Lb8[1]} * xj2;
      X17 -= (f32x2){Lb8[2], Lb8[3]} * xj2;
      X18 -= (f32x2){Lb9[0], Lb9[1]} * xj2;
      X19 -= (f32x2){Lb9[2], Lb9[3]} * xj2;
      X20 -= (f32x2){Lb10[0], Lb10[1]} * xj2;
      X21 -= (f32x2){Lb10[2], Lb10[3]} * xj2;
      X22 -= (f32x2){Lb11[0], Lb11[1]} * xj2;
      X23 -= (f32x2){Lb11[2], Lb11[3]} * xj2;
      X24 -= (f32x2){Lb12[0], Lb12[1]} * xj2;
      X25 -= (f32x2){Lb12[2], Lb12[3]} * xj2;
      X26 -= (f32x2){Lb13[0], Lb13[1]} * xj2;
      X27 -= (f32x2){Lb13[2], Lb13[3]} * xj2;
      X28 -= (f32x2){Lb14[0], Lb14[1]} * xj2;
      X29 -= (f32x2){Lb14[2], Lb14[3]} * xj2;
      X30 -= (f32x2){Lb15[0], Lb15[1]} * xj2;
      X31 -= (f32x2){Lb15[2], Lb15[3]} * xj2;
    }
    __builtin_amdgcn_sched_barrier(0);
    Lb4 = *(const f32x4*)(Lt_s + 1172);
    Lb5 = *(const f32x4*)(Lt_s + 1176);
    Lb6 = *(const f32x4*)(Lt_s + 1180);
    Lb7 = *(const f32x4*)(Lt_s + 1184);
    Lb8 = *(const f32x4*)(Lt_s + 1188);
    Lb9 = *(const f32x4*)(Lt_s + 1192);
    Lb10 = *(const f32x4*)(Lt_s + 1196);
    Lb11 = *(const f32x4*)(Lt_s + 1200);
    Lb12 = *(const f32x4*)(Lt_s + 1204);
    Lb13 = *(const f32x4*)(Lt_s + 1208);
    Lb14 = *(const f32x4*)(Lt_s + 1212);
    Lb15 = *(const f32x4*)(Lt_s + 1216);
    __builtin_amdgcn_sched_barrier(0);
    { const float xj = X8[0]; const f32x2 xj2 = (f32x2){xj, xj};
      X8 -= (f32x2){La4[0], La4[1]} * xj2;
      X9 -= (f32x2){La4[2], La4[3]} * xj2;
      X10 -= (f32x2){La5[0], La5[1]} * xj2;
      X11 -= (f32x2){La5[2], La5[3]} * xj2;
      X12 -= (f32x2){La6[0], La6[1]} * xj2;
      X13 -= (f32x2){La6[2], La6[3]} * xj2;
      X14 -= (f32x2){La7[0], La7[1]} * xj2;
      X15 -= (f32x2){La7[2], La7[3]} * xj2;
      X16 -= (f32x2){La8[0], La8[1]} * xj2;
      X17 -= (f32x2){La8[2], La8[3]} * xj2;
      X18 -= (f32x2){La9[0], La9[1]} * xj2;
      X19 -= (f32x2){La9[2], La9[3]} * xj2;
      X20 -= (f32x2){La10[0], La10[1]} * xj2;
      X21 -= (f32x2){La10[2], La10[3]} * xj2;
      X22 -= (f32x2){La11[0], La11[1]} * xj2;
      X23 -= (f32x2){La11[2], La11[3]} * xj2;
      X24 -= (f32x2){La12[0], La12[1]} * xj2;
      X25 -= (f32x2){La12[2], La12[3]} * xj2;
      X26 -= (f32x2){La13[0], La13[1]} * xj2;
      X27 -= (f32x2){La13[2], La13[3]} * xj2;
      X28 -= (f32x2){La14[0], La14[1]} * xj2;
      X29 -= (f32x2){La14[2], La14[3]} * xj2;
      X30 -= (f32x2){La15[0], La15[1]} * xj2;
      X31 -= (f32x2){La15[2], La15[3]} * xj2;
    }
    __builtin_amdgcn_sched_barrier(0);
    La4 = *(const f32x4*)(Lt_s + 1240);
    La5 = *(const f32x4*)(Lt_s + 1244);
    La6 = *(const f32x4*)(Lt_s + 1248);
    La7 = *(const f32x4*)(Lt_s + 1252);
    La8 = *(const f32x4*)(Lt_s + 1256);
    La9 = *(const f32x4*)(Lt_s + 1260);
    La10 = *(const f32x4*)(Lt_s + 1264);
    La11 = *(const f32x4*)(Lt_s + 1268);
    La12 = *(const f32x4*)(Lt_s + 1272);
    La13 = *(const f32x4*)(Lt_s + 1276);
    La14 = *(const f32x4*)(Lt_s + 1280);
    La15 = *(const f32x4*)(Lt_s + 1284);
    __builtin_amdgcn_sched_barrier(0);
    { const float xj = X8[1]; const f32x2 xj2 = (f32x2){xj, xj};
      X9 -= (f32x2){Lb4[2], Lb4[3]} * xj2;
      X10 -= (f32x2){Lb5[0], Lb5[1]} * xj2;
      X11 -= (f32x2){Lb5[2], Lb5[3]} * xj2;
      X12 -= (f32x2){Lb6[0], Lb6[1]} * xj2;
      X13 -= (f32x2){Lb6[2], Lb6[3]} * xj2;
      X14 -= (f32x2){Lb7[0], Lb7[1]} * xj2;
      X15 -= (f32x2){Lb7[2], Lb7[3]} * xj2;
      X16 -= (f32x2){Lb8[0], Lb8[1]} * xj2;
      X17 -= (f32x2){Lb8[2], Lb8[3]} * xj2;
      X18 -= (f32x2){Lb9[0], Lb9[1]} * xj2;
      X19 -= (f32x2){Lb9[2], Lb9[3]} * xj2;
      X20 -= (f32x2){Lb10[0], Lb10[1]} * xj2;
      X21 -= (f32x2){Lb10[2], Lb10[3]} * xj2;
      X22 -= (f32x2){Lb11[0], Lb11[1]} * xj2;
      X23 -= (f32x2){Lb11[2], Lb11[3]} * xj2;
      X24 -= (f32x2){Lb12[0], Lb12[1]} * xj2;
      X25 -= (f32x2){Lb12[2], Lb12[3]} * xj2;
      X26 -= (f32x2){Lb13[0], Lb13[1]} * xj2;
      X27 -= (f32x2){Lb13[2], Lb13[3]} * xj2;
      X28 -= (f32x2){Lb14[0], Lb14[1]} * xj2;
      X29 -= (f32x2){Lb14[2], Lb14[3]} * xj2;
      X30 -= (f32x2){Lb15[0], Lb15[1]} * xj2;
      X31 -= (f32x2){Lb15[2], Lb15[3]} * xj2;
    }
    __builtin_amdgcn_sched_barrier(0);
    Lb5 = *(const f32x4*)(Lt_s + 1312);
    Lb6 = *(const f32x4*)(Lt_s + 1316);
    Lb7 = *(const f32x4*)(Lt_s + 1320);
    Lb8 = *(const f32x4*)(Lt_s + 1324);
    Lb9 = *(const f32x4*)(Lt_s + 1328);
    Lb10 = *(const f32x4*)(Lt_s + 1332);
    Lb11 = *(const f32x4*)(Lt_s + 1336);
    Lb12 = *(const f32x4*)(Lt_s + 1340);
    Lb13 = *(const f32x4*)(Lt_s + 1344);
    Lb14 = *(const f32x4*)(Lt_s + 1348);
    Lb15 = *(const f32x4*)(Lt_s + 1352);
    __builtin_amdgcn_sched_barrier(0);
    { const float xj = X9[0]; const f32x2 xj2 = (f32x2){xj, xj};
      X9 -= (f32x2){La4[2], La4[3]} * xj2;
      X10 -= (f32x2){La5[0], La5[1]} * xj2;
      X11 -= (f32x2){La5[2], La5[3]} * xj2;
      X12 -= (f32x2){La6[0], La6[1]} * xj2;
      X13 -= (f32x2){La6[2], La6[3]} * xj2;
      X14 -= (f32x2){La7[0], La7[1]} * xj2;
      X15 -= (f32x2){La7[2], La7[3]} * xj2;
      X16 -= (f32x2){La8[0], La8[1]} * xj2;
      X17 -= (f32x2){La8[2], La8[3]} * xj2;
      X18 -= (f32x2){La9[0], La9[1]} * xj2;
      X19 -= (f32x2){La9[2], La9[3]} * xj2;
      X20 -= (f32x2){La10[0], La10[1]} * xj2;
      X21 -= (f32x2){La10[2], La10[3]} * xj2;
      X22 -= (f32x2){La11[0], La11[1]} * xj2;
      X23 -= (f32x2){La11[2], La11[3]} * xj2;
      X24 -= (f32x2){La12[0], La12[1]} * xj2;
      X25 -= (f32x2){La12[2], La12[3]} * xj2;
      X26 -= (f32x2){La13[0], La13[1]} * xj2;
      X27 -= (f32x2){La13[2], La13[3]} * xj2;
      X28 -= (f32x2){La14[0], La14[1]} * xj2;
      X29 -= (f32x2){La14[2], La14[3]} * xj2;
      X30 -= (f32x2){La15[0], La15[1]} * xj2;
      X31 -= (f32x2){La15[2], La15[3]} * xj2;
    }
    __builtin_amdgcn_sched_barrier(0);
    La5 = *(const f32x4*)(Lt_s + 1380);
    La6 = *(const f32x4*)(Lt_s + 1384);
    La7 = *(const f32x4*)(Lt_s + 1388);
    La8 = *(const f32x4*)(Lt_s + 1392);
    La9 = *(const f32x4*)(Lt_s + 1396);
    La10 = *(const f32x4*)(Lt_s + 1400);
    La11 = *(const f32x4*)(Lt_s + 1404);
    La12 = *(const f32x4*)(Lt_s + 1408);
    La13 = *(const f32x4*)(Lt_s + 1412);
    La14 = *(const f32x4*)(Lt_s + 1416);
    La15 = *(const f32x4*)(Lt_s + 1420);
    __builtin_amdgcn_sched_barrier(0);
    { const float xj = X9[1]; const f32x2 xj2 = (f32x2){xj, xj};
      X10 -= (f32x2){Lb5[0], Lb5[1]} * xj2;
      X11 -= (f32x2){Lb5[2], Lb5[3]} * xj2;
      X12 -= (f32x2){Lb6[0], Lb6[1]} * xj2;
      X13 -= (f32x2){Lb6[2], Lb6[3]} * xj2;
      X14 -= (f32x2){Lb7[0], Lb7[1]} * xj2;
      X15 -= (f32x2){Lb7[2], Lb7[3]} * xj2;
      X16 -= (f32x2){Lb8[0], Lb8[1]} * xj2;
      X17 -= (f32x2){Lb8[2], Lb8[3]} * xj2;
      X18 -= (f32x2){Lb9[0], Lb9[1]} * xj2;
      X19 -= (f32x2){Lb9[2], Lb9[3]} * xj2;
      X20 -= (f32x2){Lb10[0], Lb10[1]} * xj2;
      X21 -= (f32x2){Lb10[2], Lb10[3]} * xj2;
      X22 -= (f32x2){Lb11[0], Lb11[1]} * xj2;
      X23 -= (f32x2){Lb11[2], Lb11[3]} * xj2;
      X24 -= (f32x2){Lb12[0], Lb12[1]} * xj2;
      X25 -= (f32x2){Lb12[2], Lb12[3]} * xj2;
      X26 -= (f32x2){Lb13[0], Lb13[1]} * xj2;
      X27 -= (f32x2){Lb13[2], Lb13[3]} * xj2;
      X28 -= (f32x2){Lb14[0], Lb14[1]} * xj2;
      X29 -= (f32x2){Lb14[2], Lb14[3]} * xj2;
      X30 -= (f32x2){Lb15[0], Lb15[1]} * xj2;
      X31 -= (f32x2){Lb15[2], Lb15[3]} * xj2;
    }
    __builtin_amdgcn_sched_barrier(0);
    Lb5 = *(const f32x4*)(Lt_s + 1448);
    Lb6 = *(const f32x4*)(Lt_s + 1452);
    Lb7 = *(const f32x4*)(Lt_s + 1456);
    Lb8 = *(const f32x4*)(Lt_s + 1460);
    Lb9 = *(const f32x4*)(Lt_s + 1464);
    Lb10 = *(const f32x4*)(Lt_s + 1468);
    Lb11 = *(const f32x4*)(Lt_s + 1472);
    Lb12 = *(const f32x4*)(Lt_s + 1476);
    Lb13 = *(const f32x4*)(Lt_s + 1480);
    Lb14 = *(const f32x4*)(Lt_s + 1484);
    Lb15 = *(const f32x4*)(Lt_s + 1488);
    __builtin_amdgcn_sched_barrier(0);
    { const float xj = X10[0]; const f32x2 xj2 = (f32x2){xj, xj};
      X10 -= (f32x2){La5[0], La5[1]} * xj2;
      X11 -= (f32x2){La5[2], La5[3]} * xj2;
      X12 -= (f32x2){La6[0], La6[1]} * xj2;
      X13 -= (f32x2){La6[2], La6[3]} * xj2;
      X14 -= (f32x2){La7[0], La7[1]} * xj2;
      X15 -= (f32x2){La7[2], La7[3]} * xj2;
      X16 -= (f32x2){La8[0], La8[1]} * xj2;
      X17 -= (f32x2){La8[2], La8[3]} * xj2;
      X18 -= (f32x2){La9[0], La9[1]} * xj2;
      X19 -= (f32x2){La9[2], La9[3]} * xj2;
      X20 -= (f32x2){La10[0], La10[1]} * xj2;
      X21 -= (f32x2){La10[2], La10[3]} * xj2;
      X22 -= (f32x2){La11[0], La11[1]} * xj2;
      X23 -= (f32x2){La11[2], La11[3]} * xj2;
      X24 -= (f32x2){La12[0], La12[1]} * xj2;
      X25 -= (f32x2){La12[2], La12[3]} * xj2;
      X26 -= (f32x2){La13[0], La13[1]} * xj2;
      X27 -= (f32x2){La13[2], La13[3]} * xj2;
      X28 -= (f32x2){La14[0], La14[1]} * xj2;
      X29 -= (f32x2){La14[2], La14[3]} * xj2;
      X30 -= (f32x2){La15[0], La15[1]} * xj2;
      X31 -= (f32x2){La15[2], La15[3]} * xj2;
    }
    __builtin_amdgcn_sched_barrier(0);
    La5 = *(const f32x4*)(Lt_s + 1516);
    La6 = *(const f32x4*)(Lt_s + 1520);
    La7 = *(const f32x4*)(Lt_s + 1524);
    La8 = *(const f32x4*)(Lt_s + 1528);
    La9 = *(const f32x4*)(Lt_s + 1532);
    La10 = *(const f32x4*)(Lt_s + 1536);
    La11 = *(const f32x4*)(Lt_s + 1540);
    La12 = *(const f32x4*)(Lt_s + 1544);
    La13 = *(const f32x4*)(Lt_s + 1548);
    La14 = *(const f32x4*)(Lt_s + 1552);
    La15 = *(const f32x4*)(Lt_s + 1556);
    __builtin_amdgcn_sched_barrier(0);
    { const float xj = X10[1]; const f32x2 xj2 = (f32x2){xj, xj};
      X11 -= (f32x2){Lb5[2], Lb5[3]} * xj2;
      X12 -= (f32x2){Lb6[0], Lb6[1]} * xj2;
      X13 -= (f32x2){Lb6[2], Lb6[3]} * xj2;
      X14 -= (f32x2){Lb7[0], Lb7[1]} * xj2;
      X15 -= (f32x2){Lb7[2], Lb7[3]} * xj2;
      X16 -= (f32x2){Lb8[0], Lb8[1]} * xj2;
      X17 -= (f32x2){Lb8[2], Lb8[3]} * xj2;
      X18 -= (f32x2){Lb9[0], Lb9[1]} * xj2;
      X19 -= (f32x2){Lb9[2], Lb9[3]} * xj2;
      X20 -= (f32x2){Lb10[0], Lb10[1]} * xj2;
      X21 -= (f32x2){Lb10[2], Lb10[3]} * xj2;
      X22 -= (f32x2){Lb11[0], Lb11[1]} * xj2;
      X23 -= (f32x2){Lb11[2], Lb11[3]} * xj2;
      X24 -= (f32x2){Lb12[0], Lb12[1]} * xj2;
      X25 -= (f32x2){Lb12[2], Lb12[3]} * xj2;
      X26 -= (f32x2){Lb13[0], Lb13[1]} * xj2;
      X27 -= (f32x2){Lb13[2], Lb13[3]} * xj2;
      X28 -= (f32x2){Lb14[0], Lb14[1]} * xj2;
      X29 -= (f32x2){Lb14[2], Lb14[3]} * xj2;
      X30 -= (f32x2){Lb15[0], Lb15[1]} * xj2;
      X31 -= (f32x2){Lb15[2], Lb15[3]} * xj2;
    }
    __builtin_amdgcn_sched_barrier(0);
    Lb6 = *(const f32x4*)(Lt_s + 1588);
    Lb7 = *(const f32x4*)(Lt_s + 1592);
    Lb8 = *(const f32x4*)(Lt_s + 1596);
    Lb9 = *(const f32x4*)(Lt_s + 1600);
    Lb10 = *(const f32x4*)(Lt_s + 1604);
    Lb11 = *(const f32x4*)(Lt_s + 1608);
    Lb12 = *(const f32x4*)(Lt_s + 1612);
    Lb13 = *(const f32x4*)(Lt_s + 1616);
    Lb14 = *(const f32x4*)(Lt_s + 1620);
    Lb15 = *(const f32x4*)(Lt_s + 1624);
    __builtin_amdgcn_sched_barrier(0);
    { const float xj = X11[0]; const f32x2 xj2 = (f32x2){xj, xj};
      X11 -= (f32x2){La5[2], La5[3]} * xj2;
      X12 -= (f32x2){La6[0], La6[1]} * xj2;
      X13 -= (f32x2){La6[2], La6[3]} * xj2;
      X14 -= (f32x2){La7[0], La7[1]} * xj2;
      X15 -= (f32x2){La7[2], La7[3]} * xj2;
      X16 -= (f32x2){La8[0], La8[1]} * xj2;
      X17 -= (f32x2){La8[2], La8[3]} * xj2;
      X18 -= (f32x2){La9[0], La9[1]} * xj2;
      X19 -= (f32x2){La9[2], La9[3]} * xj2;
      X20 -= (f32x2){La10[0], La10[1]} * xj2;
      X21 -= (f32x2){La10[2], La10[3]} * xj2;
      X22 -= (f32x2){La11[0], La11[1]} * xj2;
      X23 -= (f32x2){La11[2], La11[3]} * xj2;
      X24 -= (f32x2){La12[0], La12[1]} * xj2;
      X25 -= (f32x2){La12[2], La12[3]} * xj2;
      X26 -= (f32x2){La13[0], La13[1]} * xj2;
      X27 -= (f32x2){La13[2], La13[3]} * xj2;
      X28 -= (f32x2){La14[0], La14[1]} * xj2;
      X29 -= (f32x2){La14[2], La14[3]} * xj2;
      X30 -= (f32x2){La15[0], La15[1]} * xj2;
      X31 -= (f32x2){La15[2], La15[3]} * xj2;
    }
    __builtin_amdgcn_sched_barrier(0);
    La6 = *(const f32x4*)(Lt_s + 1656);
    La7 = *(const f32x4*)(Lt_s + 1660);
    La8 = *(const f32x4*)(Lt_s + 1664);
    La9 = *(const f32x4*)(Lt_s + 1668);
    La10 = *(const f32x4*)(Lt_s + 1672);
    La11 = *(const f32x4*)(Lt_s + 1676);
    La12 = *(const f32x4*)(Lt_s + 1680);
    La13 = *(const f32x4*)(Lt_s + 1684);
    La14 = *(const f32x4*)(Lt_s + 1688);
    La15 = *(const f32x4*)(Lt_s + 1692);
    __builtin_amdgcn_sched_barrier(0);
    { const float xj = X11[1]; const f32x2 xj2 = (f32x2){xj, xj};
      X12 -= (f32x2){Lb6[0], Lb6[1]} * xj2;
      X13 -= (f32x2){Lb6[2], Lb6[3]} * xj2;
      X14 -= (f32x2){Lb7[0], Lb7[1]} * xj2;
      X15 -= (f32x2){Lb7[2], Lb7[3]} * xj2;
      X16 -= (f32x2){Lb8[0], Lb8[1]} * xj2;
      X17 -= (f32x2){Lb8[2], Lb8[3]} * xj2;
      X18 -= (f32x2){Lb9[0], Lb9[1]} * xj2;
      X19 -= (f32x2){Lb9[2], Lb9[3]} * xj2;
      X20 -= (f32x2){Lb10[0], Lb10[1]} * xj2;
      X21 -= (f32x2){Lb10[2], Lb10[3]} * xj2;
      X22 -= (f32x2){Lb11[0], Lb11[1]} * xj2;
      X23 -= (f32x2){Lb11[2], Lb11[3]} * xj2;
      X24 -= (f32x2){Lb12[0], Lb12[1]} * xj2;
      X25 -= (f32x2){Lb12[2], Lb12[3]} * xj2;
      X26 -= (f32x2){Lb13[0], Lb13[1]} * xj2;
      X27 -= (f32x2){Lb13[2], Lb13[3]} * xj2;
      X28 -= (f32x2){Lb14[0], Lb14[1]} * xj2;
      X29 -= (f32x2){Lb14[2], Lb14[3]} * xj2;
      X30 -= (f32x2){Lb15[0], Lb15[1]} * xj2;
      X31 -= (f32x2){Lb15[2], Lb15[3]} * xj2;
    }
    __builtin_amdgcn_sched_barrier(0);
    Lb6 = *(const f32x4*)(Lt_s + 1724);
    Lb7 = *(const f32x4*)(Lt_s + 1728);
    Lb8 = *(const f32x4*)(Lt_s + 1732);
    Lb9 = *(const f32x4*)(Lt_s + 1736);
    Lb10 = *(const f32x4*)(Lt_s + 1740);
    Lb11 = *(const f32x4*)(Lt_s + 1744);
    Lb12 = *(const f32x4*)(Lt_s + 1748);
    Lb13 = *(const f32x4*)(Lt_s + 1752);
    Lb14 = *(const f32x4*)(Lt_s + 1756);
    Lb15 = *(const f32x4*)(Lt_s + 1760);
    __builtin_amdgcn_sched_barrier(0);
    { const float xj = X12[0]; const f32x2 xj2 = (f32x2){xj, xj};
      X12 -= (f32x2){La6[0], La6[1]} * xj2;
      X13 -= (f32x2){La6[2], La6[3]} * xj2;
      X14 -= (f32x2){La7[0], La7[1]} * xj2;
      X15 -= (f32x2){La7[2], La7[3]} * xj2;
      X16 -= (f32x2){La8[0], La8[1]} * xj2;
      X17 -= (f32x2){La8[2], La8[3]} * xj2;
      X18 -= (f32x2){La9[0], La9[1]} * xj2;
      X19 -= (f32x2){La9[2], La9[3]} * xj2;
      X20 -= (f32x2){La10[0], La10[1]} * xj2;
      X21 -= (f32x2){La10[2], La10[3]} * xj2;
      X22 -= (f32x2){La11[0], La11[1]} * xj2;
      X23 -= (f32x2){La11[2], La11[3]} * xj2;
      X24 -= (f32x2){La12[0], La12[1]} * xj2;
      X25 -= (f32x2){La12[2], La12[3]} * xj2;
      X26 -= (f32x2){La13[0], La13[1]} * xj2;
      X27 -= (f32x2){La13[2], La13[3]} * xj2;
      X28 -= (f32x2){La14[0], La14[1]} * xj2;
      X29 -= (f32x2){La14[2], La14[3]} * xj2;
      X30 -= (f32x2){La15[0], La15[1]} * xj2;
      X31 -= (f32x2){La15[2], La15[3]} * xj2;
    }
    __builtin_amdgcn_sched_barrier(0);
    La6 = *(const f32x4*)(Lt_s + 1792);
    La7 = *(const f32x4*)(Lt_s + 1796);
    La8 = *(const f32x4*)(Lt_s + 1800);
    La9 = *(const f32x4*)(Lt_s + 1804);
    La10 = *(const f32x4*)(Lt_s + 1808);
    La11 = *(const f32x4*)(Lt_s + 1812);
    La12 = *(const f32x4*)(Lt_s + 1816);
    La13 = *(const f32x4*)(Lt_s + 1820);
    La14 = *(const f32x4*)(Lt_s + 1824);
    La15 = *(const f32x4*)(Lt_s + 1828);
    __builtin_amdgcn_sched_barrier(0);
    { const float xj = X12[1]; const f32x2 xj2 = (f32x2){xj, xj};
      X13 -= (f32x2){Lb6[2], Lb6[3]} * xj2;
      X14 -= (f32x2){Lb7[0], Lb7[1]} * xj2;
      X15 -= (f32x2){Lb7[2], Lb7[3]} * xj2;
      X16 -= (f32x2){Lb8[0], Lb8[1]} * xj2;
      X17 -= (f32x2){Lb8[2], Lb8[3]} * xj2;
      X18 -= (f32x2){Lb9[0], Lb9[1]} * xj2;
      X19 -= (f32x2){Lb9[2], Lb9[3]} * xj2;
      X20 -= (f32x2){Lb10[0], Lb10[1]} * xj2;
      X21 -= (f32x2){Lb10[2], Lb10[3]} * xj2;
      X22 -= (f32x2){Lb11[0], Lb11[1]} * xj2;
      X23 -= (f32x2){Lb11[2], Lb11[3]} * xj2;
      X24 -= (f32x2){Lb12[0], Lb12[1]} * xj2;
      X25 -= (f32x2){Lb12[2], Lb12[3]} * xj2;
      X26 -= (f32x2){Lb13[0], Lb13[1]} * xj2;
      X27 -= (f32x2){Lb13[2], Lb13[3]} * xj2;
      X28 -= (f32x2){Lb14[0], Lb14[1]} * xj2;
      X29 -= (f32x2){Lb14[2], Lb14[3]} * xj2;
      X30 -= (f32x2){Lb15[0], Lb15[1]} * xj2;
      X31 -= (f32x2){Lb15[2], Lb15[3]} * xj2;
    }
    __builtin_amdgcn_sched_barrier(0);
    Lb7 = *(const f32x4*)(Lt_s + 1864);
    Lb8 = *(const f32x4*)(Lt_s + 1868);
    Lb9 = *(const f32x4*)(Lt_s + 1872);
    Lb10 = *(const f32x4*)(Lt_s + 1876);
    Lb11 = *(const f32x4*)(Lt_s + 1880);
    Lb12 = *(const f32x4*)(Lt_s + 1884);
    Lb13 = *(const f32x4*)(Lt_s + 1888);
    Lb14 = *(const f32x4*)(Lt_s + 1892);
    Lb15 = *(const f32x4*)(Lt_s + 1896);
    __builtin_amdgcn_sched_barrier(0);
    { const float xj = X13[0]; const f32x2 xj2 = (f32x2){xj, xj};
      X13 -= (f32x2){La6[2], La6[3]} * xj2;
      X14 -= (f32x2){La7[0], La7[1]} * xj2;
      X15 -= (f32x2){La7[2], La7[3]} * xj2;
      X16 -= (f32x2){La8[0], La8[1]} * xj2;
      X17 -= (f32x2){La8[2], La8[3]} * xj2;
      X18 -= (f32x2){La9[0], La9[1]} * xj2;
      X19 -= (f32x2){La9[2], La9[3]} * xj2;
      X20 -= (f32x2){La10[0], La10[1]} * xj2;
      X21 -= (f32x2){La10[2], La10[3]} * xj2;
      X22 -= (f32x2){La11[0], La11[1]} * xj2;
      X23 -= (f32x2){La11[2], La11[3]} * xj2;
      X24 -= (f32x2){La12[0], La12[1]} * xj2;
      X25 -= (f32x2){La12[2], La12[3]} * xj2;
      X26 -= (f32x2){La13[0], La13[1]} * xj2;
      X27 -= (f32x2){La13[2], La13[3]} * xj2;
      X28 -= (f32x2){La14[0], La14[1]} * xj2;
      X29 -= (f32x2){La14[2], La14[3]} * xj2;
      X30 -= (f32x2){La15[0], La15[1]} * xj2;
      X31 -= (f32x2){La15[2], La15[3]} * xj2;
    }
    __builtin_amdgcn_sched_barrier(0);
    La7 = *(const f32x4*)(Lt_s + 1932);
    La8 = *(const f32x4*)(Lt_s + 1936);
    La9 = *(const f32x4*)(Lt_s + 1940);
    La10 = *(const f32x4*)(Lt_s + 1944);
    La11 = *(const f32x4*)(Lt_s + 1948);
    La12 = *(const f32x4*)(Lt_s + 1952);
    La13 = *(const f32x4*)(Lt_s + 1956);
    La14 = *(const f32x4*)(Lt_s + 1960);
    La15 = *(const f32x4*)(Lt_s + 1964);
    __builtin_amdgcn_sched_barrier(0);
    { const float xj = X13[1]; const f32x2 xj2 = (f32x2){xj, xj};
      X14 -= (f32x2){Lb7[0], Lb7[1]} * xj2;
      X15 -= (f32x2){Lb7[2], Lb7[3]} * xj2;
      X16 -= (f32x2){Lb8[0], Lb8[1]} * xj2;
      X17 -= (f32x2){Lb8[2], Lb8[3]} * xj2;
      X18 -= (f32x2){Lb9[0], Lb9[1]} * xj2;
      X19 -= (f32x2){Lb9[2], Lb9[3]} * xj2;
      X20 -= (f32x2){Lb10[0], Lb10[1]} * xj2;
      X21 -= (f32x2){Lb10[2], Lb10[3]} * xj2;
      X22 -= (f32x2){Lb11[0], Lb11[1]} * xj2;
      X23 -= (f32x2){Lb11[2], Lb11[3]} * xj2;
      X24 -= (f32x2){Lb12[0], Lb12[1]} * xj2;
      X25 -= (f32x2){Lb12[2], Lb12[3]} * xj2;
      X26 -= (f32x2){Lb13[0], Lb13[1]} * xj2;
      X27 -= (f32x2){Lb13[2], Lb13[3]} * xj2;
      X28 -= (f32x2){Lb14[0], Lb14[1]} * xj2;
      X29 -= (f32x2){Lb14[2], Lb14[3]} * xj2;
      X30 -= (f32x2){Lb15[0], Lb15[1]} * xj2;
      X31 -= (f32x2){Lb15[2], Lb15[3]} * xj2;
    }
    __builtin_amdgcn_sched_barrier(0);
    Lb7 = *(const f32x4*)(Lt_s + 2000);
    Lb8 = *(const f32x4*)(Lt_s + 2004);
    Lb9 = *(const f32x4*)(Lt_s + 2008);
    Lb10 = *(const f32x4*)(Lt_s + 2012);
    Lb11 = *(const f32x4*)(Lt_s + 2016);
    Lb12 = *(const f32x4*)(Lt_s + 2020);
    Lb13 = *(const f32x4*)(Lt_s + 2024);
    Lb14 = *(const f32x4*)(Lt_s + 2028);
    Lb15 = *(const f32x4*)(Lt_s + 2032);
    __builtin_amdgcn_sched_barrier(0);
    { const float xj = X14[0]; const f32x2 xj2 = (f32x2){xj, xj};
      X14 -= (f32x2){La7[0], La7[1]} * xj2;
      X15 -= (f32x2){La7[2], La7[3]} * xj2;
      X16 -= (f32x2){La8[0], La8[1]} * xj2;
      X17 -= (f32x2){La8[2], La8[3]} * xj2;
      X18 -= (f32x2){La9[0], La9[1]} * xj2;
      X19 -= (f32x2){La9[2], La9[3]} * xj2;
      X20 -= (f32x2){La10[0], La10[1]} * xj2;
      X21 -= (f32x2){La10[2], La10[3]} * xj2;
      X22 -= (f32x2){La11[0], La11[1]} * xj2;
      X23 -= (f32x2){La11[2], La11[3]} * xj2;
      X24 -= (f32x2){La12[0], La12[1]} * xj2;
      X25 -= (f32x2){La12[2], La12[3]} * xj2;
      X26 -= (f32x2){La13[0], La13[1]} * xj2;
      X27 -= (f32x2){La13[2], La13[3]} * xj2;
      X28 -= (f32x2){La14[0], La14[1]} * xj2;
      X29 -= (f32x2){La14[2], La14[3]} * xj2;
      X30 -= (f32x2){La15[0], La15[1]} * xj2;
      X31 -= (f32x2){La15[2], La15[3]} * xj2;
    }
    __builtin_amdgcn_sched_barrier(0);
    La7 = *(const f32x4*)(Lt_s + 2068);
    La8 = *(const f32x4*)(Lt_s + 2072);
    La9 = *(const f32x4*)(Lt_s + 2076);
    La10 = *(const f32x4*)(Lt_s + 2080);
    La11 = *(const f32x4*)(Lt_s + 2084);
    La12 = *(const f32x4*)(Lt_s + 2088);
    La13 = *(const f32x4*)(Lt_s + 2092);
    La14 = *(const f32x4*)(Lt_s + 2096);
    La15 = *(const f32x4*)(Lt_s + 2100);
    __builtin_amdgcn_sched_barrier(0);
    { const float xj = X14[1]; const f32x2 xj2 = (f32x2){xj, xj};
      X15 -= (f32x2){Lb7[2], Lb7[3]} * xj2;
      X16 -= (f32x2){Lb8[0], Lb8[1]} * xj2;
      X17 -= (f32x2){Lb8[2], Lb8[3]} * xj2;
      X18 -= (f32x2){Lb9[0], Lb9[1]} * xj2;
      X19 -= (f32x2){Lb9[2], Lb9[3]} * xj2;
      X20 -= (f32x2){Lb10[0], Lb10[1]} * xj2;
      X21 -= (f32x2){Lb10[2], Lb10[3]} * xj2;
      X22 -= (f32x2){Lb11[0], Lb11[1]} * xj2;
      X23 -= (f32x2){Lb11[2], Lb11[3]} * xj2;
      X24 -= (f32x2){Lb12[0], Lb12[1]} * xj2;
      X25 -= (f32x2){Lb12[2], Lb12[3]} * xj2;
      X26 -= (f32x2){Lb13[0], Lb13[1]} * xj2;
      X27 -= (f32x2){Lb13[2], Lb13[3]} * xj2;
      X28 -= (f32x2){Lb14[0], Lb14[1]} * xj2;
      X29 -= (f32x2){Lb14[2], Lb14[3]} * xj2;
      X30 -= (f32x2){Lb15[0], Lb15[1]} * xj2;
      X31 -= (f32x2){Lb15[2], Lb15[3]} * xj2;
    }
    __builtin_amdgcn_sched_barrier(0);
    Lb8 = *(const f32x4*)(Lt_s + 2140);
    Lb9 = *(const f32x4*)(Lt_s + 2144);
    Lb10 = *(const f32x4*)(Lt_s + 2148);
    Lb11 = *(const f32x4*)(Lt_s + 2152);
    Lb12 = *(const f32x4*)(Lt_s + 2156);
    Lb13 = *(const f32x4*)(Lt_s + 2160);
    Lb14 = *(const f32x4*)(Lt_s + 2164);
    Lb15 = *(const f32x4*)(Lt_s + 2168);
    __builtin_amdgcn_sched_barrier(0);
    { const float xj = X15[0]; const f32x2 xj2 = (f32x2){xj, xj};
      X15 -= (f32x2){La7[2], La7[3]} * xj2;
      X16 -= (f32x2){La8[0], La8[1]} * xj2;
      X17 -= (f32x2){La8[2], La8[3]} * xj2;
      X18 -= (f32x2){La9[0], La9[1]} * xj2;
      X19 -= (f32x2){La9[2], La9[3]} * xj2;
      X20 -= (f32x2){La10[0], La10[1]} * xj2;
      X21 -= (f32x2){La10[2], La10[3]} * xj2;
      X22 -= (f32x2){La11[0], La11[1]} * xj2;
      X23 -= (f32x2){La11[2], La11[3]} * xj2;
      X24 -= (f32x2){La12[0], La12[1]} * xj2;
      X25 -= (f32x2){La12[2], La12[3]} * xj2;
      X26 -= (f32x2){La13[0], La13[1]} * xj2;
      X27 -= (f32x2){La13[2], La13[3]} * xj2;
      X28 -= (f32x2){La14[0], La14[1]} * xj2;
      X29 -= (f32x2){La14[2], La14[3]} * xj2;
      X30 -= (f32x2){La15[0], La15[1]} * xj2;
      X31 -= (f32x2){La15[2], La15[3]} * xj2;
    }
    __builtin_amdgcn_sched_barrier(0);
    La8 = *(const f32x4*)(Lt_s + 2208);
    La9 = *(const f32x4*)(Lt_s + 2212);
    La10 = *(const f32x4*)(Lt_s + 2216);
    La11 = *(const f32x4*)(Lt_s + 2220);
    La12 = *(const f32x4*)(Lt_s + 2224);
    La13 = *(const f32x4*)(Lt_s + 2228);
    La14 = *(const f32x4*)(Lt_s + 2232);
    La15 = *(const f32x4*)(Lt_s + 2236);
    __builtin_amdgcn_sched_barrier(0);
    { const float xj = X15[1]; const f32x2 xj2 = (f32x2){xj, xj};
      X16 -= (f32x2){Lb8[0], Lb8[1]} * xj2;
      X17 -= (f32x2){Lb8[2], Lb8[3]} * xj2;
      X18 -= (f32x2){Lb9[0], Lb9[1]} * xj2;
      X19 -= (f32x2){Lb9[2], Lb9[3]} * xj2;
      X20 -= (f32x2){Lb10[0], Lb10[1]} * xj2;
      X21 -= (f32x2){Lb10[2], Lb10[3]} * xj2;
      X22 -= (f32x2){Lb11[0], Lb11[1]} * xj2;
      X23 -= (f32x2){Lb11[2], Lb11[3]} * xj2;
      X24 -= (f32x2){Lb12[0], Lb12[1]} * xj2;
      X25 -= (f32x2){Lb12[2], Lb12[3]} * xj2;
      X26 -= (f32x2){Lb13[0], Lb13[1]} * xj2;
      X27 -= (f32x2){Lb13[2], Lb13[3]} * xj2;
      X28 -= (f32x2){Lb14[0], Lb14[1]} * xj2;
      X29 -= (f32x2){Lb14[2], Lb14[3]} * xj2;
      X30 -= (f32x2){Lb15[0], Lb15[1]} * xj2;
      X31 -= (f32x2){Lb15[2], Lb15[3]} * xj2;
    }
    __builtin_amdgcn_sched_barrier(0);
    Lb8 = *(const f32x4*)(Lt_s + 2276);
    Lb9 = *(const f32x4*)(Lt_s + 2280);
    Lb10 = *(const f32x4*)(Lt_s + 2284);
    Lb11 = *(const f32x4*)(Lt_s + 2288);
    Lb12 = *(const f32x4*)(Lt_s + 2292);
    Lb13 = *(const f32x4*)(Lt_s + 2296);
    Lb14 = *(const f32x4*)(Lt_s + 2300);
    Lb15 = *(const f32x4*)(Lt_s + 2304);
    __builtin_amdgcn_sched_barrier(0);
    { const float xj = X16[0]; const f32x2 xj2 = (f32x2){xj, xj};
      X16 -= (f32x2){La8[0], La8[1]} * xj2;
      X17 -= (f32x2){La8[2], La8[3]} * xj2;
      X18 -= (f32x2){La9[0], La9[1]} * xj2;
      X19 -= (f32x2){La9[2], La9[3]} * xj2;
      X20 -= (f32x2){La10[0], La10[1]} * xj2;
      X21 -= (f32x2){La10[2], La10[3]} * xj2;
      X22 -= (f32x2){La11[0], La11[1]} * xj2;
      X23 -= (f32x2){La11[2], La11[3]} * xj2;
      X24 -= (f32x2){La12[0], La12[1]} * xj2;
      X25 -= (f32x2){La12[2], La12[3]} * xj2;
      X26 -= (f32x2){La13[0], La13[1]} * xj2;
      X27 -= (f32x2){La13[2], La13[3]} * xj2;
      X28 -= (f32x2){La14[0], La14[1]} * xj2;
      X29 -= (f32x2){La14[2], La14[3]} * xj2;
      X30 -= (f32x2){La15[0], La15[1]} * xj2;
      X31 -= (f32x2){La15[2], La15[3]} * xj2;
    }
    __builtin_amdgcn_sched_barrier(0);
    La8 = *(const f32x4*)(Lt_s + 2344);
    La9 = *(const f32x4*)(Lt_s + 2348);
    La10 = *(const f32x4*)(Lt_s + 2352);
    La11 = *(const f32x4*)(Lt_s + 2356);
    La12 = *(const f32x4*)(Lt_s + 2360);
    La13 = *(const f32x4*)(Lt_s + 2364);
    La14 = *(const f32x4*)(Lt_s + 2368);
    La15 = *(const f32x4*)(Lt_s + 2372);
    __builtin_amdgcn_sched_barrier(0);
    { const float xj = X16[1]; const f32x2 xj2 = (f32x2){xj, xj};
      X17 -= (f32x2){Lb8[2], Lb8[3]} * xj2;
      X18 -= (f32x2){Lb9[0], Lb9[1]} * xj2;
      X19 -= (f32x2){Lb9[2], Lb9[3]} * xj2;
      X20 -= (f32x2){Lb10[0], Lb10[1]} * xj2;
      X21 -= (f32x2){Lb10[2], Lb10[3]} * xj2;
      X22 -= (f32x2){Lb11[0], Lb11[1]} * xj2;
      X23 -= (f32x2){Lb11[2], Lb11[3]} * xj2;
      X24 -= (f32x2){Lb12[0], Lb12[1]} * xj2;
      X25 -= (f32x2){Lb12[2], Lb12[3]} * xj2;
      X26 -= (f32x2){Lb13[0], Lb13[1]} * xj2;
      X27 -= (f32x2){Lb13[2], Lb13[3]} * xj2;
      X28 -= (f32x2){Lb14[0], Lb14[1]} * xj2;
      X29 -= (f32x2){Lb14[2], Lb14[3]} * xj2;
      X30 -= (f32x2){Lb15[0], Lb15[1]} * xj2;
      X31 -= (f32x2){Lb15[2], Lb15[3]} * xj2;
    }
    __builtin_amdgcn_sched_barrier(0);
    Lb9 = *(const f32x4*)(Lt_s + 2416);
    Lb10 = *(const f32x4*)(Lt_s + 2420);
    Lb11 = *(const f32x4*)(Lt_s + 2424);
    Lb12 = *(const f32x4*)(Lt_s + 2428);
    Lb13 = *(const f32x4*)(Lt_s + 2432);
    Lb14 = *(const f32x4*)(Lt_s + 2436);
    Lb15 = *(const f32x4*)(Lt_s + 2440);
    __builtin_amdgcn_sched_barrier(0);
    { const float xj = X17[0]; const f32x2 xj2 = (f32x2){xj, xj};
      X17 -= (f32x2){La8[2], La8[3]} * xj2;
      X18 -= (f32x2){La9[0], La9[1]} * xj2;
      X19 -= (f32x2){La9[2], La9[3]} * xj2;
      X20 -= (f32x2){La10[0], La10[1]} * xj2;
      X21 -= (f32x2){La10[2], La10[3]} * xj2;
      X22 -= (f32x2){La11[0], La11[1]} * xj2;
      X23 -= (f32x2){La11[2], La11[3]} * xj2;
      X24 -= (f32x2){La12[0], La12[1]} * xj2;
      X25 -= (f32x2){La12[2], La12[3]} * xj2;
      X26 -= (f32x2){La13[0], La13[1]} * xj2;
      X27 -= (f32x2){La13[2], La13[3]} * xj2;
      X28 -= (f32x2){La14[0], La14[1]} * xj2;
      X29 -= (f32x2){La14[2], La14[3]} * xj2;
      X30 -= (f32x2){La15[0], La15[1]} * xj2;
      X31 -= (f32x2){La15[2], La15[3]} * xj2;
    }
    __builtin_amdgcn_sched_barrier(0);
    La9 = *(const f32x4*)(Lt_s + 2484);
    La10 = *(const f32x4*)(Lt_s + 2488);
    La11 = *(const f32x4*)(Lt_s + 2492);
    La12 = *(const f32x4*)(Lt_s + 2496);
    La13 = *(const f32x4*)(Lt_s + 2500);
    La14 = *(const f32x4*)(Lt_s + 2504);
    La15 = *(const f32x4*)(Lt_s + 2508);
    __builtin_amdgcn_sched_barrier(0);
    { const float xj = X17[1]; const f32x2 xj2 = (f32x2){xj, xj};
      X18 -= (f32x2){Lb9[0], Lb9[1]} * xj2;
      X19 -= (f32x2){Lb9[2], Lb9[3]} * xj2;
      X20 -= (f32x2){Lb10[0], Lb10[1]} * xj2;
      X21 -= (f32x2){Lb10[2], Lb10[3]} * xj2;
      X22 -= (f32x2){Lb11[0], Lb11[1]} * xj2;
      X23 -= (f32x2){Lb11[2], Lb11[3]} * xj2;
      X24 -= (f32x2){Lb12[0], Lb12[1]} * xj2;
      X25 -= (f32x2){Lb12[2], Lb12[3]} * xj2;
      X26 -= (f32x2){Lb13[0], Lb13[1]} * xj2;
      X27 -= (f32x2){Lb13[2], Lb13[3]} * xj2;
      X28 -= (f32x2){Lb14[0], Lb14[1]} * xj2;
      X29 -= (f32x2){Lb14[2], Lb14[3]} * xj2;
      X30 -= (f32x2){Lb15[0], Lb15[1]} * xj2;
      X31 -= (f32x2){Lb15[2], Lb15[3]} * xj2;
    }
    __builtin_amdgcn_sched_barrier(0);
    Lb9 = *(const f32x4*)(Lt_s + 2552);
    Lb10 = *(const f32x4*)(Lt_s + 2556);
    Lb11 = *(const f32x4*)(Lt_s + 2560);
    Lb12 = *(const f32x4*)(Lt_s + 2564);
    Lb13 = *(const f32x4*)(Lt_s + 2568);
    Lb14 = *(const f32x4*)(Lt_s + 2572);
    Lb15 = *(const f32x4*)(Lt_s + 2576);
    __builtin_amdgcn_sched_barrier(0);
    { const float xj = X18[0]; const f32x2 xj2 = (f32x2){xj, xj};
      X18 -= (f32x2){La9[0], La9[1]} * xj2;
      X19 -= (f32x2){La9[2], La9[3]} * xj2;
      X20 -= (f32x2){La10[0], La10[1]} * xj2;
      X21 -= (f32x2){La10[2], La10[3]} * xj2;
      X22 -= (f32x2){La11[0], La11[1]} * xj2;
      X23 -= (f32x2){La11[2], La11[3]} * xj2;
      X24 -= (f32x2){La12[0], La12[1]} * xj2;
      X25 -= (f32x2){La12[2], La12[3]} * xj2;
      X26 -= (f32x2){La13[0], La13[1]} * xj2;
      X27 -= (f32x2){La13[2], La13[3]} * xj2;
      X28 -= (f32x2){La14[0], La14[1]} * xj2;
      X29 -= (f32x2){La14[2], La14[3]} * xj2;
      X30 -= (f32x2){La15[0], La15[1]} * xj2;
      X31 -= (f32x2){La15[2], La15[3]} * xj2;
    }
    __builtin_amdgcn_sched_barrier(0);
    La9 = *(const f32x4*)(Lt_s + 2620);
    La10 = *(const f32x4*)(Lt_s + 2624);
    La11 = *(const f32x4*)(Lt_s + 2628);
    La12 = *(const f32x4*)(Lt_s + 2632);
    La13 = *(const f32x4*)(Lt_s + 2636);
    La14 = *(const f32x4*)(Lt_s + 2640);
    La15 = *(const f32x4*)(Lt_s + 2644);
    __builtin_amdgcn_sched_barrier(0);
    { const float xj = X18[1]; const f32x2 xj2 = (f32x2){xj, xj};
      X19 -= (f32x2){Lb9[2], Lb9[3]} * xj2;
      X20 -= (f32x2){Lb10[0], Lb10[1]} * xj2;
      X21 -= (f32x2){Lb10[2], Lb10[3]} * xj2;
      X22 -= (f32x2){Lb11[0], Lb11[1]} * xj2;
      X23 -= (f32x2){Lb11[2], Lb11[3]} * xj2;
      X24 -= (f32x2){Lb12[0], Lb12[1]} * xj2;
      X25 -= (f32x2){Lb12[2], Lb12[3]} * xj2;
      X26 -= (f32x2){Lb13[0], Lb13[1]} * xj2;
      X27 -= (f32x2){Lb13[2], Lb13[3]} * xj2;
      X28 -= (f32x2){Lb14[0], Lb14[1]} * xj2;
      X29 -= (f32x2){Lb14[2], Lb14[3]} * xj2;
      X30 -= (f32x2){Lb15[0], Lb15[1]} * xj2;
      X31 -= (f32x2){Lb15[2], Lb15[3]} * xj2;
    }
    __builtin_amdgcn_sched_barrier(0);
    Lb10 = *(const f32x4*)(Lt_s + 2692);
    Lb11 = *(const f32x4*)(Lt_s + 2696);
    Lb12 = *(const f32x4*)(Lt_s + 2700);
    Lb13 = *(const f32x4*)(Lt_s + 2704);
    Lb14 = *(const f32x4*)(Lt_s + 2708);
    Lb15 = *(const f32x4*)(Lt_s + 2712);
    __builtin_amdgcn_sched_barrier(0);
    { const float xj = X19[0]; const f32x2 xj2 = (f32x2){xj, xj};
      X19 -= (f32x2){La9[2], La9[3]} * xj2;
      X20 -= (f32x2){La10[0], La10[1]} * xj2;
      X21 -= (f32x2){La10[2], La10[3]} * xj2;
      X22 -= (f32x2){La11[0], La11[1]} * xj2;
      X23 -= (f32x2){La11[2], La11[3]} * xj2;
      X24 -= (f32x2){La12[0], La12[1]} * xj2;
      X25 -= (f32x2){La12[2], La12[3]} * xj2;
      X26 -= (f32x2){La13[0], La13[1]} * xj2;
      X27 -= (f32x2){La13[2], La13[3]} * xj2;
      X28 -= (f32x2){La14[0], La14[1]} * xj2;
      X29 -= (f32x2){La14[2], La14[3]} * xj2;
      X30 -= (f32x2){La15[0], La15[1]} * xj2;
      X31 -= (f32x2){La15[2], La15[3]} * xj2;
    }
    __builtin_amdgcn_sched_barrier(0);
    La10 = *(const f32x4*)(Lt_s + 2760);
    La11 = *(const f32x4*)(Lt_s + 2764);
    La12 = *(const f32x4*)(Lt_s + 2768);
    La13 = *(const f32x4*)(Lt_s + 2772);
    La14 = *(const f32x4*)(Lt_s + 2776);
    La15 = *(const f32x4*)(Lt_s + 2780);
    __builtin_amdgcn_sched_barrier(0);
    { const float xj = X19[1]; const f32x2 xj2 = (f32x2){xj, xj};
      X20 -= (f32x2){Lb10[0], Lb10[1]} * xj2;
      X21 -= (f32x2){Lb10[2], Lb10[3]} * xj2;
      X22 -= (f32x2){Lb11[0], Lb11[1]} * xj2;
      X23 -= (f32x2){Lb11[2], Lb11[3]} * xj2;
      X24 -= (f32x2){Lb12[0], Lb12[1]} * xj2;
      X25 -= (f32x2){Lb12[2], Lb12[3]} * xj2;
      X26 -= (f32x2){Lb13[0], Lb13[1]} * xj2;
      X27 -= (f32x2){Lb13[2], Lb13[3]} * xj2;
      X28 -= (f32x2){Lb14[0], Lb14[1]} * xj2;
      X29 -= (f32x2){Lb14[2], Lb14[3]} * xj2;
      X30 -= (f32x2){Lb15[0], Lb15[1]} * xj2;
      X31 -= (f32x2){Lb15[2], Lb15[3]} * xj2;
    }
    __builtin_amdgcn_sched_barrier(0);
    Lb10 = *(const f32x4*)(Lt_s + 2828);
    Lb11 = *(const f32x4*)(Lt_s + 2832);
    Lb12 = *(const f32x4*)(Lt_s + 2836);
    Lb13 = *(const f32x4*)(Lt_s + 2840);
    Lb14 = *(const f32x4*)(Lt_s + 2844);
    Lb15 = *(const f32x4*)(Lt_s + 2848);
    __builtin_amdgcn_sched_barrier(0);
    { const float xj = X20[0]; const f32x2 xj2 = (f32x2){xj, xj};
      X20 -= (f32x2){La10[0], La10[1]} * xj2;
      X21 -= (f32x2){La10[2], La10[3]} * xj2;
      X22 -= (f32x2){La11[0], La11[1]} * xj2;
      X23 -= (f32x2){La11[2], La11[3]} * xj2;
      X24 -= (f32x2){La12[0], La12[1]} * xj2;
      X25 -= (f32x2){La12[2], La12[3]} * xj2;
      X26 -= (f32x2){La13[0], La13[1]} * xj2;
      X27 -= (f32x2){La13[2], La13[3]} * xj2;
      X28 -= (f32x2){La14[0], La14[1]} * xj2;
      X29 -= (f32x2){La14[2], La14[3]} * xj2;
      X30 -= (f32x2){La15[0], La15[1]} * xj2;
      X31 -= (f32x2){La15[2], La15[3]} * xj2;
    }
    __builtin_amdgcn_sched_barrier(0);
    La10 = *(const f32x4*)(Lt_s + 2896);
    La11 = *(const f32x4*)(Lt_s + 2900);
    La12 = *(const f32x4*)(Lt_s + 2904);
    La13 = *(const f32x4*)(Lt_s + 2908);
    La14 = *(const f32x4*)(Lt_s + 2912);
    La15 = *(const f32x4*)(Lt_s + 2916);
    __builtin_amdgcn_sched_barrier(0);
    { const float xj = X20[1]; const f32x2 xj2 = (f32x2){xj, xj};
      X21 -= (f32x2){Lb10[2], Lb10[3]} * xj2;
      X22 -= (f32x2){Lb11[0], Lb11[1]} * xj2;
      X23 -= (f32x2){Lb11[2], Lb11[3]} * xj2;
      X24 -= (f32x2){Lb12[0], Lb12[1]} * xj2;
      X25 -= (f32x2){Lb12[2], Lb12[3]} * xj2;
      X26 -= (f32x2){Lb13[0], Lb13[1]} * xj2;
      X27 -= (f32x2){Lb13[2], Lb13[3]} * xj2;
      X28 -= (f32x2){Lb14[0], Lb14[1]} * xj2;
      X29 -= (f32x2){Lb14[2], Lb14[3]} * xj2;
      X30 -= (f32x2){Lb15[0], Lb15[1]} * xj2;
      X31 -= (f32x2){Lb15[2], Lb15[3]} * xj2;
    }
    __builtin_amdgcn_sched_barrier(0);
    Lb11 = *(const f32x4*)(Lt_s + 2968);
    Lb12 = *(const f32x4*)(Lt_s + 2972);
    Lb13 = *(const f32x4*)(Lt_s + 2976);
    Lb14 = *(const f32x4*)(Lt_s + 2980);
    Lb15 = *(const f32x4*)(Lt_s + 2984);
    __builtin_amdgcn_sched_barrier(0);
    { const float xj = X21[0]; const f32x2 xj2 = (f32x2){xj, xj};
      X21 -= (f32x2){La10[2], La10[3]} * xj2;
      X22 -= (f32x2){La11[0], La11[1]} * xj2;
      X23 -= (f32x2){La11[2], La11[3]} * xj2;
      X24 -= (f32x2){La12[0], La12[1]} * xj2;
      X25 -= (f32x2){La12[2], La12[3]} * xj2;
      X26 -= (f32x2){La13[0], La13[1]} * xj2;
      X27 -= (f32x2){La13[2], La13[3]} * xj2;
      X28 -= (f32x2){La14[0], La14[1]} * xj2;
      X29 -= (f32x2){La14[2], La14[3]} * xj2;
      X30 -= (f32x2){La15[0], La15[1]} * xj2;
      X31 -= (f32x2){La15[2], La15[3]} * xj2;
    }
    __builtin_amdgcn_sched_barrier(0);
    La11 = *(const f32x4*)(Lt_s + 3036);
    La12 = *(const f32x4*)(Lt_s + 3040);
    La13 = *(const f32x4*)(Lt_s + 3044);
    La14 = *(const f32x4*)(Lt_s + 3048);
    La15 = *(const f32x4*)(Lt_s + 3052);
    __builtin_amdgcn_sched_barrier(0);
    { const float xj = X21[1]; const f32x2 xj2 = (f32x2){xj, xj};
      X22 -= (f32x2){Lb11[0], Lb11[1]} * xj2;
      X23 -= (f32x2){Lb11[2], Lb11[3]} * xj2;
      X24 -= (f32x2){Lb12[0], Lb12[1]} * xj2;
      X25 -= (f32x2){Lb12[2], Lb12[3]} * xj2;
      X26 -= (f32x2){Lb13[0], Lb13[1]} * xj2;
      X27 -= (f32x2){Lb13[2], Lb13[3]} * xj2;
      X28 -= (f32x2){Lb14[0], Lb14[1]} * xj2;
      X29 -= (f32x2){Lb14[2], Lb14[3]} * xj2;
      X30 -= (f32x2){Lb15[0], Lb15[1]} * xj2;
      X31 -= (f32x2){Lb15[2], Lb15[3]} * xj2;
    }
    __builtin_amdgcn_sched_barrier(0);
    Lb11 = *(const f32x4*)(Lt_s + 3104);
    Lb12 = *(const f32x4*)(Lt_s + 3108);
    Lb13 = *(const f32x4*)(Lt_s + 3112);
    Lb14 = *(const f32x4*)(Lt_s + 3116);
    Lb15 = *(const f32x4*)(Lt_s + 3120);
    __builtin_amdgcn_sched_barrier(0);
    { const float xj = X22[0]; const f32x2 xj2 = (f32x2){xj, xj};
      X22 -= (f32x2){La11[0], La11[1]} * xj2;
      X23 -= (f32x2){La11[2], La11[3]} * xj2;
      X24 -= (f32x2){La12[0], La12[1]} * xj2;
      X25 -= (f32x2){La12[2], La12[3]} * xj2;
      X26 -= (f32x2){La13[0], La13[1]} * xj2;
      X27 -= (f32x2){La13[2], La13[3]} * xj2;
      X28 -= (f32x2){La14[0], La14[1]} * xj2;
      X29 -= (f32x2){La14[2], La14[3]} * xj2;
      X30 -= (f32x2){La15[0], La15[1]} * xj2;
      X31 -= (f32x2){La15[2], La15[3]} * xj2;
    }
    __builtin_amdgcn_sched_barrier(0);
    La11 = *(const f32x4*)(Lt_s + 3172);
    La12 = *(const f32x4*)(Lt_s + 3176);
    La13 = *(const f32x4*)(Lt_s + 3180);
    La14 = *(const f32x4*)(Lt_s + 3184);
    La15 = *(const f32x4*)(Lt_s + 3188);
    __builtin_amdgcn_sched_barrier(0);
    { const float xj = X22[1]; const f32x2 xj2 = (f32x2){xj, xj};
      X23 -= (f32x2){Lb11[2], Lb11[3]} * xj2;
      X24 -= (f32x2){Lb12[0], Lb12[1]} * xj2;
      X25 -= (f32x2){Lb12[2], Lb12[3]} * xj2;
      X26 -= (f32x2){Lb13[0], Lb13[1]} * xj2;
      X27 -= (f32x2){Lb13[2], Lb13[3]} * xj2;
      X28 -= (f32x2){Lb14[0], Lb14[1]} * xj2;
      X29 -= (f32x2){Lb14[2], Lb14[3]} * xj2;
      X30 -= (f32x2){Lb15[0], Lb15[1]} * xj2;
      X31 -= (f32x2){Lb15[2], Lb15[3]} * xj2;
    }
    __builtin_amdgcn_sched_barrier(0);
    Lb12 = *(const f32x4*)(Lt_s + 3244);
    Lb13 = *(const f32x4*)(Lt_s + 3248);
    Lb14 = *(const f32x4*)(Lt_s + 3252);
    Lb15 = *(const f32x4*)(Lt_s + 3256);
    __builtin_amdgcn_sched_barrier(0);
    { const float xj = X23[0]; const f32x2 xj2 = (f32x2){xj, xj};
      X23 -= (f32x2){La11[2], La11[3]} * xj2;
      X24 -= (f32x2){La12[0], La12[1]} * xj2;
      X25 -= (f32x2){La12[2], La12[3]} * xj2;
      X26 -= (f32x2){La13[0], La13[1]} * xj2;
      X27 -= (f32x2){La13[2], La13[3]} * xj2;
      X28 -= (f32x2){La14[0], La14[1]} * xj2;
      X29 -= (f32x2){La14[2], La14[3]} * xj2;
      X30 -= (f32x2){La15[0], La15[1]} * xj2;
      X31 -= (f32x2){La15[2], La15[3]} * xj2;
    }
    __builtin_amdgcn_sched_barrier(0);
    La12 = *(const f32x4*)(Lt_s + 3312);
    La13 = *(const f32x4*)(Lt_s + 3316);
    La14 = *(const f32x4*)(Lt_s + 3320);
    La15 = *(const f32x4*)(Lt_s + 3324);
    __builtin_amdgcn_sched_barrier(0);
    { const float xj = X23[1]; const f32x2 xj2 = (f32x2){xj, xj};
      X24 -= (f32x2){Lb12[0], Lb12[1]} * xj2;
      X25 -= (f32x2){Lb12[2], Lb12[3]} * xj2;
      X26 -= (f32x2){Lb13[0], Lb13[1]} * xj2;
      X27 -= (f32x2){Lb13[2], Lb13[3]} * xj2;
      X28 -= (f32x2){Lb14[0], Lb14[1]} * xj2;
      X29 -= (f32x2){Lb14[2], Lb14[3]} * xj2;
      X30 -= (f32x2){Lb15[0], Lb15[1]} * xj2;
      X31 -= (f32x2){Lb15[2], Lb15[3]} * xj2;
    }
    __builtin_amdgcn_sched_barrier(0);
    Lb12 = *(const f32x4*)(Lt_s + 3380);
    Lb13 = *(const f32x4*)(Lt_s + 3384);
    Lb14 = *(const f32x4*)(Lt_s + 3388);
    Lb15 = *(const f32x4*)(Lt_s + 3392);
    __builtin_amdgcn_sched_barrier(0);
    { const float xj = X24[0]; const f32x2 xj2 = (f32x2){xj, xj};
      X24 -= (f32x2){La12[0], La12[1]} * xj2;
      X25 -= (f32x2){La12[2], La12[3]} * xj2;
      X26 -= (f32x2){La13[0], La13[1]} * xj2;
      X27 -= (f32x2){La13[2], La13[3]} * xj2;
      X28 -= (f32x2){La14[0], La14[1]} * xj2;
      X29 -= (f32x2){La14[2], La14[3]} * xj2;
      X30 -= (f32x2){La15[0], La15[1]} * xj2;
      X31 -= (f32x2){La15[2], La15[3]} * xj2;
    }
    __builtin_amdgcn_sched_barrier(0);
    La12 = *(const f32x4*)(Lt_s + 3448);
    La13 = *(const f32x4*)(Lt_s + 3452);
    La14 = *(const f32x4*)(Lt_s + 3456);
    La15 = *(const f32x4*)(Lt_s + 3460);
    __builtin_amdgcn_sched_barrier(0);
    { const float xj = X24[1]; const f32x2 xj2 = (f32x2){xj, xj};
      X25 -= (f32x2){Lb12[2], Lb12[3]} * xj2;
      X26 -= (f32x2){Lb13[0], Lb13[1]} * xj2;
      X27 -= (f32x2){Lb13[2], Lb13[3]} * xj2;
      X28 -= (f32x2){Lb14[0], Lb14[1]} * xj2;
      X29 -= (f32x2){Lb14[2], Lb14[3]} * xj2;
      X30 -= (f32x2){Lb15[0], Lb15[1]} * xj2;
      X31 -= (f32x2){Lb15[2], Lb15[3]} * xj2;
    }
    __builtin_amdgcn_sched_barrier(0);
    Lb13 = *(const f32x4*)(Lt_s + 3520);
    Lb14 = *(const f32x4*)(Lt_s + 3524);
    Lb15 = *(const f32x4*)(Lt_s + 3528);
    __builtin_amdgcn_sched_barrier(0);
    { const float xj = X25[0]; const f32x2 xj2 = (f32x2){xj, xj};
      X25 -= (f32x2){La12[2], La12[3]} * xj2;
      X26 -= (f32x2){La13[0], La13[1]} * xj2;
      X27 -= (f32x2){La13[2], La13[3]} * xj2;
      X28 -= (f32x2){La14[0], La14[1]} * xj2;
      X29 -= (f32x2){La14[2], La14[3]} * xj2;
      X30 -= (f32x2){La15[0], La15[1]} * xj2;
      X31 -= (f32x2){La15[2], La15[3]} * xj2;
    }
    __builtin_amdgcn_sched_barrier(0);
    La13 = *(const f32x4*)(Lt_s + 3588);
    La14 = *(const f32x4*)(Lt_s + 3592);
    La15 = *(const f32x4*)(Lt_s + 3596);
    __builtin_amdgcn_sched_barrier(0);
    { const float xj = X25[1]; const f32x2 xj2 = (f32x2){xj, xj};
      X26 -= (f32x2){Lb13[0], Lb13[1]} * xj2;
      X27 -= (f32x2){Lb13[2], Lb13[3]} * xj2;
      X28 -= (f32x2){Lb14[0], Lb14[1]} * xj2;
      X29 -= (f32x2){Lb14[2], Lb14[3]} * xj2;
      X30 -= (f32x2){Lb15[0], Lb15[1]} * xj2;
      X31 -= (f32x2){Lb15[2], Lb15[3]} * xj2;
    }
    __builtin_amdgcn_sched_barrier(0);
    Lb13 = *(const f32x4*)(Lt_s + 3656);
    Lb14 = *(const f32x4*)(Lt_s + 3660);
    Lb15 = *(const f32x4*)(Lt_s + 3664);
    __builtin_amdgcn_sched_barrier(0);
    { const float xj = X26[0]; const f32x2 xj2 = (f32x2){xj, xj};
      X26 -= (f32x2){La13[0], La13[1]} * xj2;
      X27 -= (f32x2){La13[2], La13[3]} * xj2;
      X28 -= (f32x2){La14[0], La14[1]} * xj2;
      X29 -= (f32x2){La14[2], La14[3]} * xj2;
      X30 -= (f32x2){La15[0], La15[1]} * xj2;
      X31 -= (f32x2){La15[2], La15[3]} * xj2;
    }
    __builtin_amdgcn_sched_barrier(0);
    La13 = *(const f32x4*)(Lt_s + 3724);
    La14 = *(const f32x4*)(Lt_s + 3728);
    La15 = *(const f32x4*)(Lt_s + 3732);
    __builtin_amdgcn_sched_barrier(0);
    { const float xj = X26[1]; const f32x2 xj2 = (f32x2){xj, xj};
      X27 -= (f32x2){Lb13[2], Lb13[3]} * xj2;
      X28 -= (f32x2){Lb14[0], Lb14[1]} * xj2;
      X29 -= (f32x2){Lb14[2], Lb14[3]} * xj2;
      X30 -= (f32x2){Lb15[0], Lb15[1]} * xj2;
      X31 -= (f32x2){Lb15[2], Lb15[3]} * xj2;
    }
    __builtin_amdgcn_sched_barrier(0);
    Lb14 = *(const f32x4*)(Lt_s + 3796);
    Lb15 = *(const f32x4*)(Lt_s + 3800);
    __builtin_amdgcn_sched_barrier(0);
    { const float xj = X27[0]; const f32x2 xj2 = (f32x2){xj, xj};
      X27 -= (f32x2){La13[2], La13[3]} * xj2;
      X28 -= (f32x2){La14[0], La14[1]} * xj2;
      X29 -= (f32x2){La14[2], La14[3]} * xj2;
      X30 -= (f32x2){La15[0], La15[1]} * xj2;
      X31 -= (f32x2){La15[2], La15[3]} * xj2;
    }
    __builtin_amdgcn_sched_barrier(0);
    La14 = *(const f32x4*)(Lt_s + 3864);
    La15 = *(const f32x4*)(Lt_s + 3868);
    __builtin_amdgcn_sched_barrier(0);
    { const float xj = X27[1]; const f32x2 xj2 = (f32x2){xj, xj};
      X28 -= (f32x2){Lb14[0], Lb14[1]} * xj2;
      X29 -= (f32x2){Lb14[2], Lb14[3]} * xj2;
      X30 -= (f32x2){Lb15[0], Lb15[1]} * xj2;
      X31 -= (f32x2){Lb15[2], Lb15[3]} * xj2;
    }
    __builtin_amdgcn_sched_barrier(0);
    Lb14 = *(const f32x4*)(Lt_s + 3932);
    Lb15 = *(const f32x4*)(Lt_s + 3936);
    __builtin_amdgcn_sched_barrier(0);
    { const float xj = X28[0]; const f32x2 xj2 = (f32x2){xj, xj};
      X28 -= (f32x2){La14[0], La14[1]} * xj2;
      X29 -= (f32x2){La14[2], La14[3]} * xj2;
      X30 -= (f32x2){La15[0], La15[1]} * xj2;
      X31 -= (f32x2){La15[2], La15[3]} * xj2;
    }
    __builtin_amdgcn_sched_barrier(0);
    La14 = *(const f32x4*)(Lt_s + 4000);
    La15 = *(const f32x4*)(Lt_s + 4004);
    __builtin_amdgcn_sched_barrier(0);
    { const float xj = X28[1]; const f32x2 xj2 = (f32x2){xj, xj};
      X29 -= (f32x2){Lb14[2], Lb14[3]} * xj2;
      X30 -= (f32x2){Lb15[0], Lb15[1]} * xj2;
      X31 -= (f32x2){Lb15[2], Lb15[3]} * xj2;
    }
    __builtin_amdgcn_sched_barrier(0);
    Lb15 = *(const f32x4*)(Lt_s + 4072);
    __builtin_amdgcn_sched_barrier(0);
    { const float xj = X29[0]; const f32x2 xj2 = (f32x2){xj, xj};
      X29 -= (f32x2){La14[2], La14[3]} * xj2;
      X30 -= (f32x2){La15[0], La15[1]} * xj2;
      X31 -= (f32x2){La15[2], La15[3]} * xj2;
    }
    __builtin_amdgcn_sched_barrier(0);
    La15 = *(const f32x4*)(Lt_s + 4140);
    __builtin_amdgcn_sched_barrier(0);
    { const float xj = X29[1]; const f32x2 xj2 = (f32x2){xj, xj};
      X30 -= (f32x2){Lb15[0], Lb15[1]} * xj2;
      X31 -= (f32x2){Lb15[2], Lb15[3]} * xj2;
    }
    __builtin_amdgcn_sched_barrier(0);
    Lb15 = *(const f32x4*)(Lt_s + 4208);
    __builtin_amdgcn_sched_barrier(0);
    { const float xj = X30[0]; const f32x2 xj2 = (f32x2){xj, xj};
      X30 -= (f32x2){La15[0], La15[1]} * xj2;
      X31 -= (f32x2){La15[2], La15[3]} * xj2;
    }
    __builtin_amdgcn_sched_barrier(0);
    La15 = *(const f32x4*)(Lt_s + 4276);
    __builtin_amdgcn_sched_barrier(0);
    { const float xj = X30[1]; const f32x2 xj2 = (f32x2){xj, xj};
      X31 -= (f32x2){Lb15[2], Lb15[3]} * xj2;
    }
    __builtin_amdgcn_sched_barrier(0);
    __builtin_amdgcn_sched_barrier(0);
    { const float xj = X31[0]; const f32x2 xj2 = (f32x2){xj, xj};
      X31 -= (f32x2){La15[2], La15[3]} * xj2;
    }
    __builtin_amdgcn_sched_barrier(0);
    __syncthreads();
    outp[0] = f2bf(sg * X0[0]);
    outp[136] = f2bf(sg * X0[1]);
    outp[272] = f2bf(sg * X1[0]);
    outp[408] = f2bf(sg * X1[1]);
    outp[544] = f2bf(sg * X2[0]);
    outp[680] = f2bf(sg * X2[1]);
    outp[816] = f2bf(sg * X3[0]);
    outp[952] = f2bf(sg * X3[1]);
    outp[1088] = f2bf(sg * X4[0]);
    outp[1224] = f2bf(sg * X4[1]);
    outp[1360] = f2bf(sg * X5[0]);
    outp[1496] = f2bf(sg * X5[1]);
    outp[1632] = f2bf(sg * X6[0]);
    outp[1768] = f2bf(sg * X6[1]);
    outp[1904] = f2bf(sg * X7[0]);
    outp[2040] = f2bf(sg * X7[1]);
    outp[2176] = f2bf(sg * X8[0]);
    outp[2312] = f2bf(sg * X8[1]);
    outp[2448] = f2bf(sg * X9[0]);
    outp[2584] = f2bf(sg * X9[1]);
    outp[2720] = f2bf(sg * X10[0]);
    outp[2856] = f2bf(sg * X10[1]);
    outp[2992] = f2bf(sg * X11[0]);
    outp[3128] = f2bf(sg * X11[1]);
    outp[3264] = f2bf(sg * X12[0]);
    outp[3400] = f2bf(sg * X12[1]);
    outp[3536] = f2bf(sg * X13[0]);
    outp[3672] = f2bf(sg * X13[1]);
    outp[3808] = f2bf(sg * X14[0]);
    outp[3944] = f2bf(sg * X14[1]);
    outp[4080] = f2bf(sg * X15[0]);
    outp[4216] = f2bf(sg * X15[1]);
    outp[4352] = f2bf(sg * X16[0]);
    outp[4488] = f2bf(sg * X16[1]);
    outp[4624] = f2bf(sg * X17[0]);
    outp[4760] = f2bf(sg * X17[1]);
    outp[4896] = f2bf(sg * X18[0]);
    outp[5032] = f2bf(sg * X18[1]);
    outp[5168] = f2bf(sg * X19[0]);
    outp[5304] = f2bf(sg * X19[1]);
    outp[5440] = f2bf(sg * X20[0]);
    outp[5576] = f2bf(sg * X20[1]);
    outp[5712] = f2bf(sg * X21[0]);
    outp[5848] = f2bf(sg * X21[1]);
    outp[5984] = f2bf(sg * X22[0]);
    outp[6120] = f2bf(sg * X22[1]);
    outp[6256] = f2bf(sg * X23[0]);
    outp[6392] = f2bf(sg * X23[1]);
    outp[6528] = f2bf(sg * X24[0]);
    outp[6664] = f2bf(sg * X24[1]);
    outp[6800] = f2bf(sg * X25[0]);
    outp[6936] = f2bf(sg * X25[1]);
    outp[7072] = f2bf(sg * X26[0]);
    outp[7208] = f2bf(sg * X26[1]);
    outp[7344] = f2bf(sg * X27[0]);
    outp[7480] = f2bf(sg * X27[1]);
    outp[7616] = f2bf(sg * X28[0]);
    outp[7752] = f2bf(sg * X28[1]);
    outp[7888] = f2bf(sg * X29[0]);
    outp[8024] = f2bf(sg * X29[1]);
    outp[8160] = f2bf(sg * X30[0]);
    outp[8296] = f2bf(sg * X30[1]);
    outp[8432] = f2bf(sg * X31[0]);
    outp[8568] = f2bf(sg * X31[1]);
}

DEV void dn_item(const Params& p, int l, int item, unsigned char* smem) {
    const int dir = item & 1, hh = (item >> 1) & 3, b = item >> 3;
    bf16_t* q_s = (bf16_t*)(smem);
    bf16_t* k_s = (bf16_t*)(smem + 17408);
    bf16_t* vnT_s = k_s;
    bf16_t* kT_s = (bf16_t*)(smem + 35840);
    bf16_t* v_s = (bf16_t*)(smem + 54272);
    bf16_t* u_s = v_s;
    float* L_s = (float*)(smem + 71680);
    bf16_t* w_s = (bf16_t*)(smem + 71680);
    bf16_t* qk_s = (bf16_t*)(smem + 89088);
    bf16_t* St_s = (bf16_t*)(smem + 98304);
    float* G_s = (float*)(smem + 133120);
    float* beta_s = G_s + 64;
    float* eG_s = G_s + 128;
    float* bw_s = G_s + 192;
    float* cw_s = G_s + 256;
    const int tid = get_tid(), lane = tid & 63, wv = tid >> 6, l15 = lane & 15, quad = lane >> 4;
    const float Aneg = -expf(p.in[I_DNALOG][(l * 2 + dir) * 4 + hh]);
    const float dtb = p.in[I_DNDT][(l * 2 + dir) * 4 + hh];
    const bf16_t* P = wsb(p, O_P);
    const float* AB = wsf(p, O_AB);
    bf16_t* TO = wsb(p, dir ? O_TA2 : O_TA);
    __syncthreads();
    for (int e = tid; e < 4 * 384; e += 256) { int j = e / 384, c = e % 384, mat = c >> 7, cc = c & 127; cw_s[e] = p.in[I_DNCONV][((size_t)l * 4 + j) * 1536 + mat * 512 + hh * 128 + cc]; }
    for (int e = tid; e < 128 * 136 / 2; e += 256) ((unsigned*)St_s)[e] = 0u;
    f32x4 Sacc[2][8];
#pragma unroll
    for (int a = 0; a < 2; ++a)
#pragma unroll
        for (int c = 0; c < 8; ++c) Sacc[a][c] = (f32x4){0.f, 0.f, 0.f, 0.f};

    const int rg = tid >> 4, cseg = tid & 15, i0 = rg * 4;
    u32x4 raw[3][7];
    float pf_al = 0.f, pf_bb = 0.f;
#define DN_PREFETCH(NN, M0, M1) { \
        const int c_ = chunk_of(dir, (NN)); const int lo_ = c_ < 4 ? 0 : CTXL, hi_ = c_ < 4 ? CTXL : SB, base_ = c_ * 64; \
        const int slo_ = dir ? base_ + 60 - i0 : base_ + i0; \
        _Pragma("unroll") for (int u = 0; u < 7; ++u) { const int ss_ = slo_ - 1 + u; const bool ok_ = ss_ >= lo_ && ss_ < hi_; \
            const bf16_t* rp_ = P + ((size_t)b * SB + (ok_ ? ss_ : base_)) * PW + hh * 128 + cseg * 8; \
            _Pragma("unroll") for (int mat = (M0); mat < (M1); ++mat) { u32x4 t_ = *(const u32x4*)(rp_ + mat * 512); raw[mat][u] = ok_ ? t_ : (u32x4){0u, 0u, 0u, 0u}; } } \
        if ((M0) == 0) { const int sa_ = dir ? base_ + 63 - lane : base_ + lane; \
        pf_al = AB[((size_t)b * SB + sa_) * 16 + dir * 4 + hh]; pf_bb = AB[((size_t)b * SB + sa_) * 16 + 8 + dir * 4 + hh]; } }
    DN_PREFETCH(0, 0, 3);
    const int wv0_ = wv, l150_ = l15, quad0_ = quad, lane0_ = lane;

#pragma unroll 1
    for (int n = 0; n < 68; ++n) {
        int tz0 = 0; asm volatile("" : "+v"(tz0));
        const int wv = wv0_ + tz0, l15 = l150_ + tz0, quad = quad0_ + tz0, lane = lane0_ + tz0;
        const int c = chunk_of(dir, n);
        const int base = c * 64;
        __syncthreads();
        if (wv == 0) {
            float g = Aneg * softplus_fast(pf_al + dtb);
#pragma unroll
            for (int o = 1; o < 64; o <<= 1) { float t = __shfl_up(g, o); if (lane >= o) g += t; }
            const float eg_ = expf(g), bt_ = sigm(pf_bb); G_s[lane] = g; beta_s[lane] = bt_; eG_s[lane] = eg_; bw_s[lane] = bt_ * eg_;
        }
        __syncthreads();
        const float Glast = G_s[63];
        {
            int tz = 0; asm volatile("" : "+v"(tz));
            const int i0l = i0 + tz, csl = cseg + tz;
            float ksc[4];
#pragma unroll
            for (int m = 0; m < 4; ++m) ksc[m] = expf(Glast - G_s[i0l + m]);
#pragma unroll
            for (int mat = 0; mat < 3; ++mat) {
                float w[4][8];
#pragma unroll
                for (int j = 0; j < 4; ++j) { const f32x4 w0 = *(const f32x4*)(cw_s + j * 384 + mat * 128 + csl * 8), w1 = *(const f32x4*)(cw_s + j * 384 + mat * 128 + csl * 8 + 4);
#pragma unroll
                    for (int e = 0; e < 4; ++e) { w[j][e] = w0[e]; w[j][4 + e] = w1[e]; } }
                float v[4][8];
#pragma unroll
                for (int t = 0; t < 4; ++t)
#pragma unroll
                    for (int e = 0; e < 8; ++e) v[t][e] = 0.f;
#pragma unroll
                for (int u = 0; u < 7; ++u) {
                    float x[8];
#pragma unroll
                    for (int e = 0; e < 4; ++e) { x[2 * e] = lo16(raw[mat][u][e]); x[2 * e + 1] = hi16(raw[mat][u][e]); }
#pragma unroll
                    for (int t = 0; t < 4; ++t) { const int j = u - t; if (j >= 0 && j < 4) {
#pragma unroll
                        for (int e = 0; e < 8; ++e) v[t][e] += w[j][e] * x[e]; } }
                }
                float sc[4];
#pragma unroll
                for (int t = 0; t < 4; ++t) {
                    float ss2 = 0.f;
#pragma unroll
                    for (int e = 0; e < 8; ++e) { v[t][e] = silu(v[t][e]); ss2 += v[t][e] * v[t][e]; }
                    if (mat < 2) { ss2 += __shfl_xor(ss2, 1); ss2 += __shfl_xor(ss2, 2); ss2 += __shfl_xor(ss2, 4); ss2 += __shfl_xor(ss2, 8); }
                    sc[t] = mat == 0 ? rsqrtf(ss2 + 1e-6f) * 0.08838834764831845f : (mat == 1 ? rsqrtf(ss2 + 1e-6f) : 1.f);
                }
                bf16_t* dst = mat == 0 ? q_s : (mat == 1 ? k_s : v_s);
#pragma unroll
                for (int t = 0; t < 4; ++t) {
                    const int it_ = dir ? i0l + 3 - t : i0l + t;
                    u32x4 o;
#pragma unroll
                    for (int e = 0; e < 4; ++e) o[e] = pack2(v[t][2 * e] * sc[t], v[t][2 * e + 1] * sc[t]);
                    *(u32x4*)(dst + it_ * 136 + csl * 8) = o;
                }
                if (mat == 1) {
#pragma unroll
                    for (int e = 0; e < 8; ++e) {
                        const float k0 = v[dir ? 3 : 0][e] * sc[dir ? 3 : 0] * ksc[0], k1 = v[dir ? 2 : 1][e] * sc[dir ? 2 : 1] * ksc[1];
                        const float k2 = v[dir ? 1 : 2][e] * sc[dir ? 1 : 2] * ksc[2], k3 = v[dir ? 0 : 3][e] * sc[dir ? 0 : 3] * ksc[3];
                        u32x2 o; o.x = pack2(k0, k1); o.y = pack2(k2, k3);
                        *(u32x2*)(kT_s + (csl * 8 + e) * 72 + i0l) = o;
                    }
                }
            }
        }
        __syncthreads();
        {
            bf16x8 ak[4], aq[4];
#pragma unroll
            for (int ks = 0; ks < 4; ++ks) { ak[ks] = *(const bf16x8*)(k_s + (wv * 16 + l15) * 136 + ks * 32 + quad * 8); aq[ks] = *(const bf16x8*)(q_s + (wv * 16 + l15) * 136 + ks * 32 + quad * 8); }
#pragma unroll
            for (int nt = 0; nt < 4; ++nt) {
                f32x4 kk = {0.f, 0.f, 0.f, 0.f}, qq = {0.f, 0.f, 0.f, 0.f};
#pragma unroll
                for (int ks = 0; ks < 4; ++ks) { bf16x8 bk = *(const bf16x8*)(k_s + (nt * 16 + l15) * 136 + ks * 32 + quad * 8); kk = mfma16(ak[ks], bk, kk); qq = mfma16(aq[ks], bk, qq); }
                const int jj = nt * 16 + l15; const float Gj = G_s[jj];
                f32x4 lv;
#pragma unroll
                for (int j = 0; j < 4; ++j) {
                    const int i = wv * 16 + quad * 4 + j;
                    const float dec = jj <= i ? expf(G_s[i] - Gj) : 0.f;
                    lv[j] = jj < i ? beta_s[i] * kk[j] * dec : 0.f;
                    qk_s[i * 72 + jj] = f2bf(qq[j] * dec);
                }
                *(f32x4*)(L_s + jj * 68 + wv * 16 + quad * 4) = lv;
            }
        }
        __syncthreads();
        dn_solve(L_s, tid < 128 ? (k_s + tid) : (v_s + (tid - 128)), tid < 128 ? bw_s : beta_s, tid < 128 ? -1.f : 1.f, tid < 128 ? (w_s + tid) : (u_s + (tid - 128)));
        __syncthreads();
        {
            f32x4 vn[8], o1[8];
#pragma unroll
            for (int nt = 0; nt < 8; ++nt) {
#pragma unroll
                for (int j = 0; j < 4; ++j) vn[nt][j] = bf2f(u_s[(wv * 16 + quad * 4 + j) * 136 + nt * 16 + l15]);
                o1[nt] = (f32x4){0.f, 0.f, 0.f, 0.f};
            }
            bf16x8 aw[4], aq[4];
#pragma unroll
            for (int ks = 0; ks < 4; ++ks) { aw[ks] = *(const bf16x8*)(w_s + (wv * 16 + l15) * 136 + ks * 32 + quad * 8); aq[ks] = *(const bf16x8*)(q_s + (wv * 16 + l15) * 136 + ks * 32 + quad * 8); }
#pragma unroll
            for (int nt = 0; nt < 8; ++nt)
#pragma unroll
                for (int ks = 0; ks < 4; ++ks) { bf16x8 bs = *(const bf16x8*)(St_s + (nt * 16 + l15) * 136 + ks * 32 + quad * 8); vn[nt] = mfma16(aw[ks], bs, vn[nt]); o1[nt] = mfma16(aq[ks], bs, o1[nt]); }
#pragma unroll
            for (int nt = 0; nt < 8; ++nt) { u32x2 o; o.x = pack2(vn[nt][0], vn[nt][1]); o.y = pack2(vn[nt][2], vn[nt][3]); *(u32x2*)(vnT_s + (nt * 16 + l15) * 72 + wv * 16 + quad * 4) = o; }
            __syncthreads();
            if (n + 1 < 68) DN_PREFETCH(n + 1, 0, 2);
            float eg[4];
#pragma unroll
            for (int j = 0; j < 4; ++j) eg[j] = eG_s[wv * 16 + quad * 4 + j];
            bf16x8 aqk[2], akt[2][2];
#pragma unroll
            for (int ks = 0; ks < 2; ++ks) {
                aqk[ks] = *(const bf16x8*)(qk_s + (wv * 16 + l15) * 72 + ks * 32 + quad * 8);
                akt[0][ks] = *(const bf16x8*)(kT_s + (wv * 32 + l15) * 72 + ks * 32 + quad * 8);
                akt[1][ks] = *(const bf16x8*)(kT_s + (wv * 32 + 16 + l15) * 72 + ks * 32 + quad * 8);
            }
            const float gend = eG_s[63];
            const size_t orow0 = (size_t)b * SB;
#pragma unroll
            for (int nt = 0; nt < 8; ++nt) {
                f32x4 o;
#pragma unroll
                for (int j = 0; j < 4; ++j) { o[j] = o1[nt][j] * eg[j]; Sacc[0][nt][j] *= gend; Sacc[1][nt][j] *= gend; }
#pragma unroll
                for (int ks = 0; ks < 2; ++ks) {
                    bf16x8 bv = *(const bf16x8*)(vnT_s + (nt * 16 + l15) * 72 + ks * 32 + quad * 8);
                    o = mfma16(aqk[ks], bv, o);
                    Sacc[0][nt] = mfma16(akt[0][ks], bv, Sacc[0][nt]);
                    Sacc[1][nt] = mfma16(akt[1][ks], bv, Sacc[1][nt]);
                }
#pragma unroll
                for (int j = 0; j < 4; ++j) {
                    const int i = wv * 16 + quad * 4 + j;
                    const int s = dir ? base + 63 - i : base + i;
                    TO[(orow0 + s) * 512 + hh * 128 + nt * 16 + l15] = f2bf(o[j]);
                }
#pragma unroll
                for (int mt = 0; mt < 2; ++mt) { u32x2 sv; sv.x = pack2(Sacc[mt][nt][0], Sacc[mt][nt][1]); sv.y = pack2(Sacc[mt][nt][2], Sacc[mt][nt][3]);
                    *(u32x2*)(St_s + (nt * 16 + l15) * 136 + wv * 32 + mt * 16 + quad * 4) = sv; }
            }
        }
        if (n + 1 < 68) DN_PREFETCH(n + 1, 2, 3);
    }
}

#undef DN_PREFETCH
DEV void lru_item(const Params& p, int l, int item, unsigned char* smem) {
    const int g = item & 7, b = item >> 3;
    bf16_t* Wt_s = (bf16_t*)smem;
    bf16_t* xbh_s = Wt_s + 2 * 128 * 72;
    float* xbf_s = (float*)(smem + 36864 + 18432);
    float* a_s = xbf_s + 2 * 64 * 65;
    float* cw_s = a_s + 2 * 64 * 65;
    const int tid = get_tid(), lane = tid & 63, wv = tid >> 6, l15 = lane & 15, quad = lane >> 4;
    bf16_t* P = wsb(p, O_P);
    bf16_t* HF = wsb(p, O_U);
    __syncthreads();
    for (int e = tid; e < 320; e += 256) cw_s[e] = e < 256 ? p.in[I_LCW][((size_t)l * 4 + (e >> 6)) * 512 + g * 64 + (e & 63)] : p.in[I_LCB][l * 512 + g * 64 + (e - 256)];
    for (int e = tid; e < 2 * 4096; e += 256) {
        const int d = e >> 12, ch = (e >> 6) & 63, j = e & 63;
        const size_t wi_ = (((size_t)l * 2 + d) * 8 + g) * 4096 + ch * 64 + j;
        Wt_s[(d * 128 + j) * 72 + ch] = f2bf(p.in[I_LWA][wi_]);
        Wt_s[(d * 128 + 64 + j) * 72 + ch] = f2bf(p.in[I_LWI][wi_]);
    }
    float ba_[2][4], bi_[2][4], sp_[2][4];
#pragma unroll
    for (int d = 0; d < 2; ++d)
#pragma unroll
        for (int nt = 0; nt < 4; ++nt) {
            const int ch = (l * 2 + d) * 512 + g * 64 + nt * 16 + l15;
            ba_[d][nt] = p.in[I_LBA][ch]; bi_[d][nt] = p.in[I_LBI][ch]; sp_[d][nt] = softplus(-p.in[I_LLAM][ch]);
        }
    float hc = 0.f;
    const int i = tid >> 2, seg = tid & 3, j0 = seg * 16;
#pragma unroll 1
    for (int n = 0; n < 68; ++n) {
        const int cf = n, cb = chunk_of(1, n);
        __syncthreads();
#pragma unroll
        for (int d = 0; d < 2; ++d) {
            const int c = d ? cb : cf;
            const int seg_lo = c < 4 ? 0 : CTXL, seg_hi = c < 4 ? CTXL : SB;
            const int s = d ? c * 64 + 63 - i : c * 64 + i;
            float v[16];
#pragma unroll
            for (int e = 0; e < 16; ++e) v[e] = cw_s[256 + j0 + e];
#pragma unroll
            for (int j = 0; j < 4; ++j) {
                const int ss = s + j - 1;
                if (ss >= seg_lo && ss < seg_hi) {
                    const u32x4* src = (const u32x4*)(P + ((size_t)b * SB + ss) * PW + C_LX + g * 64 + j0);
                    const float* cw = cw_s + j * 64 + j0;
#pragma unroll
                    for (int q = 0; q < 2; ++q) { u32x4 x = src[q];
#pragma unroll
                        for (int e = 0; e < 4; ++e) { v[q * 8 + 2 * e] += cw[q * 8 + 2 * e] * lo16(x[e]); v[q * 8 + 2 * e + 1] += cw[q * 8 + 2 * e + 1] * hi16(x[e]); } }
                }
            }
            u32x4 h0, h1;
#pragma unroll
            for (int e = 0; e < 4; ++e) { h0[e] = pack2(v[2 * e], v[2 * e + 1]); h1[e] = pack2(v[8 + 2 * e], v[8 + 2 * e + 1]); }
            *(u32x4*)(xbh_s + (d * 64 + i) * 72 + j0) = h0; *(u32x4*)(xbh_s + (d * 64 + i) * 72 + j0 + 8) = h1;
#pragma unroll
            for (int e = 0; e < 16; ++e) xbf_s[(d * 64 + i) * 65 + j0 + e] = v[e];
        }
        __syncthreads();
#pragma unroll
        for (int d = 0; d < 2; ++d) {
            f32x4 acc[8];
#pragma unroll
            for (int nt = 0; nt < 8; ++nt) acc[nt] = (f32x4){0.f, 0.f, 0.f, 0.f};
            bf16x8 af[2];
#pragma unroll
            for (int ks = 0; ks < 2; ++ks) af[ks] = *(const bf16x8*)(xbh_s + (d * 64 + wv * 16 + l15) * 72 + ks * 32 + quad * 8);
#pragma unroll
            for (int nt = 0; nt < 8; ++nt)
#pragma unroll
                for (int ks = 0; ks < 2; ++ks) { bf16x8 bw = *(const bf16x8*)(Wt_s + (d * 128 + nt * 16 + l15) * 72 + ks * 32 + quad * 8); acc[nt] = mfma16(af[ks], bw, acc[nt]); }
#pragma unroll
            for (int nt = 0; nt < 4; ++nt)
#pragma unroll
                for (int jj = 0; jj < 4; ++jj) {
                    const int idx = (d * 64 + wv * 16 + quad * 4 + jj) * 65 + nt * 16 + l15;
                    const float r = sigm(acc[nt][jj] + ba_[d][nt]), ig = sigm(acc[nt + 4][jj] + bi_[d][nt]);
                    const float la = -8.f * r * sp_[d][nt];
                    a_s[idx] = expf(la);
                    xbf_s[idx] = sqrtf(fmaxf(1.f - expf(2.f * la), 0.f)) * (ig * xbf_s[idx]);
                }
        }
        __syncthreads();
        if (wv < 2) {
            const int o = wv * 64 * 65 + lane;
#pragma unroll 16
            for (int r = 0; r < 64; ++r) { hc = a_s[o + r * 65] * hc + xbf_s[o + r * 65]; xbf_s[o + r * 65] = hc; }
        }
        __syncthreads();
#pragma unroll
        for (int d = 0; d < 2; ++d) {
            const int c = d ? cb : cf;
            const int s = d ? c * 64 + 63 - i : c * 64 + i;
            const bool second = d ? (cb < n) : ((cf < 4 ? 3 - cf : 71 - cf) < n);
            const size_t row = (size_t)b * SB + s;
            const float* hp = xbf_s + (d * 64 + i) * 65 + j0;
            bf16_t* hf = HF + row * 512 + g * 64 + j0;
            if (!second) {
                u32x4 o0, o1;
#pragma unroll
                for (int e = 0; e < 4; ++e) { o0[e] = pack2(hp[2 * e], hp[2 * e + 1]); o1[e] = pack2(hp[8 + 2 * e], hp[8 + 2 * e + 1]); }
                *(u32x4*)hf = o0; *(u32x4*)(hf + 8) = o1;
            } else {
                bf16_t* gp = P + row * PW + C_LG + g * 64 + j0;
                u32x4 f0 = *(const u32x4*)hf, f1 = *(const u32x4*)(hf + 8), g0 = *(const u32x4*)gp, g1 = *(const u32x4*)(gp + 8), o0, o1;
#pragma unroll
                for (int e = 0; e < 4; ++e) {
                    o0[e] = pack2((lo16(f0[e]) + hp[2 * e]) * gelu_tanh(lo16(g0[e])), (hi16(f0[e]) + hp[2 * e + 1]) * gelu_tanh(hi16(g0[e])));
                    o1[e] = pack2((lo16(f1[e]) + hp[8 + 2 * e]) * gelu_tanh(lo16(g1[e])), (hi16(f1[e]) + hp[8 + 2 * e + 1]) * gelu_tanh(hi16(g1[e])));
                }
                *(u32x4*)gp = o0; *(u32x4*)(gp + 8) = o1;
            }
        }
    }
}

DEV void att_item(const Params& p, int l, int b, int h, int qt, float lam_init, unsigned char* smem) {
    bf16_t* K_s = (bf16_t*)smem;
    bf16_t* V_s = (bf16_t*)(smem + 2 * 17408);
    const int tid = get_tid(), lane = tid & 63, wv = tid >> 6, l15 = lane & 15, quad = lane >> 4;
    bf16_t* P = wsb(p, O_P);
    const bf16_t* VT = wsb(p, O_VT) + (size_t)(b * 4 + h) * 128 * SB;
    const int nt_keys = (qt < 2 ? CTXL : SB) / 64;
    float lam;
    {
        const float* lv = p.in[I_DALAM] + l * 256;
        float s1 = lv[lane] * lv[64 + lane], s2 = lv[128 + lane] * lv[192 + lane];
#pragma unroll
        for (int o = 32; o >= 1; o >>= 1) { s1 += __shfl_xor(s1, o); s2 += __shfl_xor(s2, o); }
        lam = expf(s1) - expf(s2) + lam_init;
    }
    bf16x8* Qst = (bf16x8*)(smem + 71680) + (wv * 8) * 64 + lane;
#pragma unroll
    for (int qg = 0; qg < 2; ++qg) {
        const bf16_t* qp = P + ((size_t)b * SB + qt * 128 + wv * 32 + qg * 16 + l15) * PW + C_DAQ + h * 128;
#pragma unroll
        for (int wh = 0; wh < 2; ++wh)
#pragma unroll
            for (int ks = 0; ks < 2; ++ks) Qst[(wh * 4 + qg * 2 + ks) * 64] = *(const bf16x8*)(qp + wh * 64 + ks * 32 + quad * 8);
    }
    f32x4 O[2][8][2];
    float mrun[2][2], lrun[2][2];
#pragma unroll
    for (int wh = 0; wh < 2; ++wh)
#pragma unroll
        for (int qg = 0; qg < 2; ++qg) { mrun[wh][qg] = -1e30f; lrun[wh][qg] = 0.f;
#pragma unroll
            for (int dg = 0; dg < 8; ++dg) O[wh][dg][qg] = (f32x4){0.f, 0.f, 0.f, 0.f}; }
    const int kr = tid >> 2, kseg = (tid & 3) * 32;
    const int kpos = ((kr >> 5) * 2 + ((kr & 7) >> 2)) * 16 + ((kr & 31) >> 3) * 4 + (kr & 3);
    const bf16_t* kg_ = P + ((size_t)b * SB + kr) * PW + C_DAK + h * 128 + kseg;
    const int vr = tid >> 1, vh = (tid & 1) * 32;
    const bf16_t* vg_ = VT + (size_t)vr * SB + vh;
    u32x4 kreg[4], vreg[4];
#pragma unroll
    for (int i = 0; i < 4; ++i) { kreg[i] = *(const u32x4*)(kg_ + i * 8); vreg[i] = *(const u32x4*)(vg_ + i * 8); }
    __syncthreads();
#pragma unroll
    for (int i = 0; i < 4; ++i) { *(u32x4*)(K_s + kpos * 136 + kseg + i * 8) = kreg[i]; *(u32x4*)(V_s + vr * 72 + vh + i * 8) = vreg[i]; }
    __syncthreads();
    const float L2E = 1.4426950408889634f;
#pragma unroll 1
    for (int t = 0; t < nt_keys; ++t) {
        const bf16_t* Kb = K_s + (t & 1) * (64 * 136);
        const bf16_t* Vb = V_s + (t & 1) * (128 * 72);
        if (t + 1 < nt_keys) {
#pragma unroll
            for (int i = 0; i < 4; ++i) { kreg[i] = *(const u32x4*)(kg_ + (size_t)(t + 1) * 64 * PW + i * 8); vreg[i] = *(const u32x4*)(vg_ + (t + 1) * 64 + i * 8); }
        }
#pragma unroll
        for (int wh = 0; wh < 2; ++wh) {
            f32x4 S[4][2];
#pragma unroll
            for (int kg = 0; kg < 4; ++kg) { S[kg][0] = (f32x4){0.f, 0.f, 0.f, 0.f}; S[kg][1] = (f32x4){0.f, 0.f, 0.f, 0.f}; }
#pragma unroll
            for (int ks = 0; ks < 2; ++ks)
#pragma unroll
                for (int kg = 0; kg < 4; ++kg) {
                    bf16x8 kf = *(const bf16x8*)(Kb + (kg * 16 + l15) * 136 + wh * 64 + ks * 32 + quad * 8);
                    S[kg][0] = mfma16(kf, Qst[(wh * 4 + 0 + ks) * 64], S[kg][0]);
                    S[kg][1] = mfma16(kf, Qst[(wh * 4 + 2 + ks) * 64], S[kg][1]);
                }
            bf16x8 Pf[2][2];
#pragma unroll
            for (int qg = 0; qg < 2; ++qg) {
                float mx = -1e30f;
#pragma unroll
                for (int kg = 0; kg < 4; ++kg)
#pragma unroll
                    for (int j = 0; j < 4; ++j) mx = fmaxf(mx, S[kg][qg][j]);
                mx = fmaxf(mx, __shfl_xor(mx, 16)); mx = fmaxf(mx, __shfl_xor(mx, 32));
                mx *= L2E;
                if (__builtin_amdgcn_ballot_w64(mx > mrun[wh][qg] + 8.f) != 0ull) {
                    const float mnew = fmaxf(mrun[wh][qg], mx);
                    const float alpha = __builtin_amdgcn_exp2f(mrun[wh][qg] - mnew);
                    mrun[wh][qg] = mnew;
                    lrun[wh][qg] *= alpha;
#pragma unroll
                    for (int dg = 0; dg < 8; ++dg)
#pragma unroll
                        for (int j = 0; j < 4; ++j) O[wh][dg][qg][j] *= alpha;
                }
                const float mref = mrun[wh][qg];
                float ps = 0.f;
#pragma unroll
                for (int kg = 0; kg < 4; ++kg)
#pragma unroll
                    for (int j = 0; j < 4; ++j) { float pv = __builtin_amdgcn_exp2f(S[kg][qg][j] * L2E - mref); ps += pv; S[kg][qg][j] = pv; }
                lrun[wh][qg] += ps;
#pragma unroll
                for (int s_ = 0; s_ < 2; ++s_) {
                    u32x4 pk; pk[0] = pack2(S[2 * s_][qg][0], S[2 * s_][qg][1]); pk[1] = pack2(S[2 * s_][qg][2], S[2 * s_][qg][3]);
                    pk[2] = pack2(S[2 * s_ + 1][qg][0], S[2 * s_ + 1][qg][1]); pk[3] = pack2(S[2 * s_ + 1][qg][2], S[2 * s_ + 1][qg][3]);
                    Pf[qg][s_] = __builtin_bit_cast(bf16x8, pk);
                }
            }
#pragma unroll
            for (int dg = 0; dg < 8; ++dg)
#pragma unroll
                for (int s_ = 0; s_ < 2; ++s_) {
                    bf16x8 vf = *(const bf16x8*)(Vb + (dg * 16 + l15) * 72 + s_ * 32 + quad * 8);
                    O[wh][dg][0] = mfma16(vf, Pf[0][s_], O[wh][dg][0]);
                    O[wh][dg][1] = mfma16(vf, Pf[1][s_], O[wh][dg][1]);
                }
        }
        if (t + 1 < nt_keys) {
            bf16_t* Kn = K_s + ((t + 1) & 1) * (64 * 136); bf16_t* Vn = V_s + ((t + 1) & 1) * (128 * 72);
#pragma unroll
            for (int i = 0; i < 4; ++i) { *(u32x4*)(Kn + kpos * 136 + kseg + i * 8) = kreg[i]; *(u32x4*)(Vn + vr * 72 + vh + i * 8) = vreg[i]; }
        }
        __syncthreads();
    }
    const float* dnw = p.in[I_DANORM] + l * 128;
#pragma unroll
    for (int qg = 0; qg < 2; ++qg) {
        float l1 = lrun[0][qg], l2 = lrun[1][qg];
        l1 += __shfl_xor(l1, 16); l1 += __shfl_xor(l1, 32); l2 += __shfl_xor(l2, 16); l2 += __shfl_xor(l2, 32);
        const float i1 = 1.f / l1, i2 = lam / l2;
        float ss = 0.f;
#pragma unroll
        for (int dg = 0; dg < 8; ++dg)
#pragma unroll
            for (int j = 0; j < 4; ++j) { float o = O[0][dg][qg][j] * i1 - O[1][dg][qg][j] * i2; O[0][dg][qg][j] = o; ss += o * o; }
        ss += __shfl_xor(ss, 16); ss += __shfl_xor(ss, 32);
        const float rstd = rsqrtf(ss * (1.f / 128.f) + 1e-5f) * (1.f - lam_init);
        bf16_t* op = P + ((size_t)b * SB + qt * 128 + wv * 32 + qg * 16 + l15) * PW + C_DAQ + h * 128;
#pragma unroll
        for (int dg = 0; dg < 8; ++dg) {
            const int dv0 = dg * 16 + quad * 4;
            u32x2 o; o.x = pack2(O[0][dg][qg][0] * rstd * dnw[dv0], O[0][dg][qg][1] * rstd * dnw[dv0 + 1]);
            o.y = pack2(O[0][dg][qg][2] * rstd * dnw[dv0 + 2], O[0][dg][qg][3] * rstd * dnw[dv0 + 3]);
            *(u32x2*)(op + dv0) = o;
        }
    }
}

DEV void phase_mix(const Params& p, int l, unsigned char* smem) {
    const bool need_ctx = l == 0;
    const float lam_init = l == 0 ? 0.2f : 0.35550906759096926f;
    unsigned* ctr = (unsigned*)(p.ws + O_CTL) + l;
    unsigned* actr = (unsigned*)(p.ws + O_CTL) + 16 + l * 8;
    __shared__ int s_item;
    const int nqt = need_ctx ? 34 : 32;
    auto next = [&](unsigned* c) -> int {
        __syncthreads();
        if (threadIdx.x == 0) s_item = (int)atomicAdd(c, 1u);
        __syncthreads();
        return __builtin_amdgcn_readfirstlane(s_item);
    };
    int it = next(ctr);
#pragma unroll 1
    while (it < 64) { dn_item(p, l, it, smem); it = next(ctr); }
#pragma unroll 1
    while (it < 128) { lru_item(p, l, it - 64, smem); it = next(ctr); }
    const int myx = blockIdx.x & 7;
#pragma unroll 1
    for (int k = 0; k < 8; ++k) {
        const int x = (myx + k) & 7;
        it = next(actr + x);
#pragma unroll 1
        while (it < 4 * nqt) {
            const int bh = x + 8 * (it / nqt), idx = it % nqt;
            const int qt = idx < 32 ? idx + 2 : idx - 32;
            att_item(p, l, bh >> 2, bh & 3, qt, lam_init, smem);
            it = next(actr + x);
        }
    }
}

#define XB_TMO      128
#define XB_XCNT(j)  (256  + 64 * (j))
#define XB_XSUB(j)  (1280 + 64 * (j))
#define XB_XGEN(j)  (2304 + 64 * (j))
#define XB_TOP      3328
#define XB_TOPGEN   3392
#define XCD_BAR_WORDS 3456
#define XB_SPIN_CAP (1u << 18)
#define LAS __attribute__((address_space(3)))
DEV unsigned xb_ld(unsigned* p)              { return __hip_atomic_load(p, __ATOMIC_RELAXED, __HIP_MEMORY_SCOPE_AGENT); }
DEV unsigned xb_add(unsigned* p, unsigned v) { return __hip_atomic_fetch_add(p, v, __ATOMIC_RELAXED, __HIP_MEMORY_SCOPE_AGENT); }
DEV unsigned xb_xcc_id() { return (unsigned)__builtin_amdgcn_s_getreg((3 << 11) | 20) & 0xFu; }
#define XB_SPIN(cond, bar) do { unsigned _sp = 0; while (cond) { __builtin_amdgcn_s_sleep(1); \
    if ((++_sp & 255u) == 0u) { if (xb_ld(&(bar)[XB_TMO])) break; if (_sp > XB_SPIN_CAP) { atomicAdd(&(bar)[XB_TMO], 1u); break; } } } } while (0)
struct XcdBarrier { unsigned* bar; unsigned x; volatile LAS unsigned* st; };
DEV XcdBarrier xcd_barrier_post(unsigned* bar, volatile LAS unsigned* st) {
    XcdBarrier b; b.bar = bar; b.x = xb_xcc_id(); b.st = st;
    if (threadIdx.x == 0) (void)xb_add(&bar[XB_XCNT(b.x)], 1u);
    return b;
}
DEV void xcd_barrier_complete(unsigned* bar, unsigned x, unsigned& nloc, unsigned& nx) {
    const unsigned G = gridDim.x * gridDim.y * gridDim.z;
    unsigned sum, cnt, mine, sp = 0u;
    for (;;) {
        sum = 0u; cnt = 0u; mine = 0u;
#pragma unroll
        for (unsigned j = 0; j < 16; ++j) { const unsigned c = xb_ld(&bar[XB_XCNT(j)]); sum += c; cnt += (c > 0u) ? 1u : 0u; mine = (j == x) ? c : mine; }
        if (sum == G) break;
        __builtin_amdgcn_s_sleep(1);
        if ((++sp & 255u) == 0u) { if (xb_ld(&bar[XB_TMO])) break; if (sp > XB_SPIN_CAP) { atomicAdd(&bar[XB_TMO], 1u); break; } }
    }
    nloc = mine > 0u ? mine : 1u; nx = cnt > 0u ? cnt : 1u;
}
DEV void xcd_barrier(const XcdBarrier& b) {
    asm volatile("s_waitcnt vmcnt(0)" ::: "memory");
    __syncthreads();
    if (threadIdx.x == 0) {
        unsigned* bar = b.bar;
        __builtin_amdgcn_s_waitcnt(0);
        unsigned nloc = b.st[0], nx = b.st[1];
        if (nloc == 0u) { xcd_barrier_complete(bar, b.x, nloc, nx); b.st[0] = nloc; b.st[1] = nx; }
        const unsigned old = xb_add(&bar[XB_XSUB(b.x)], 1u);
        const unsigned gen = old / nloc;
        if (old + 1u == (gen + 1u) * nloc) {
            __builtin_amdgcn_fence(__ATOMIC_RELEASE, "agent");
            asm volatile("s_waitcnt vmcnt(0)" ::: "memory");
            const unsigned og = xb_add(&bar[XB_TOP], 1u);
            const unsigned tg = og / nx;
            if (og + 1u == (tg + 1u) * nx) xb_add(&bar[XB_TOPGEN], 1u);
            else XB_SPIN(xb_ld(&bar[XB_TOPGEN]) == tg, bar);
            __builtin_amdgcn_fence(__ATOMIC_ACQUIRE, "agent");
            xb_add(&bar[XB_XGEN(b.x)], 1u);
            asm volatile("s_waitcnt vmcnt(0)" ::: "memory");
        } else {
            XB_SPIN(xb_ld(&bar[XB_XGEN(b.x)]) == gen, bar);
            __builtin_amdgcn_fence(__ATOMIC_ACQUIRE, "agent");
            asm volatile("s_waitcnt vmcnt(0)" ::: "memory");
        }
    }
    __syncthreads();
}

constexpr int NPHASE = 1 + 2 * 9 + 1;
DEV void run_phase(const Params& p, int ph, unsigned char* smem) {
    if (ph == 0) { phase_mod(p, smem); phase_rope(p); __syncthreads(); phase_wconv(p, 0, smem); return; }
    if (ph == NPHASE - 1) { phase_final(p); return; }
    const int l = (ph - 1) / 9, q = (ph - 1) % 9;
    const bool first = l == 0, lat = l == 1;
    const bf16_t* W = wsb(p, O_WT);
    switch (q) {
        case 0: if (l == 1) phase_wconv(p, 1, smem); phase_norm(p, l, 0, first, false); break;
        case 1: phase_g1(p, smem); break;
        case 2: phase_mix(p, l, smem); break;
        case 3: phase_fin_norm(p, l, first, lat); break;
        case 4: phase_gate(p, lat, smem); break;
        case 5: phase_resid(p, l, wsb(p, O_U), D, W + W_OUT, 1024, 2, first, lat, smem); break;
        case 6: phase_norm(p, l, 1, false, lat); break;
        case 7: phase_gu(p, lat, smem); break;
        case 8: phase_resid(p, l, wsb(p, O_P), PW, W + W_DN, DFF, 5, false, lat, smem); break;
    }
}

#if MEGA
__global__ void __launch_bounds__(256) mega_kernel(Params p) {
    extern __shared__ __align__(16) unsigned char smem[];
    cg::grid_group grid = cg::this_grid();
    __shared__ uint4 xb_words;
    if (threadIdx.x == 0) xb_words = make_uint4(0u, 0u, 0u, 0u);
    __syncthreads();
    const XcdBarrier xb = xcd_barrier_post((unsigned*)(p.ws + O_BAR), (volatile LAS unsigned*)&xb_words);
    phase_mod(p, smem); phase_rope(p); __syncthreads(); phase_wconv(p, 0, smem);
    grid.sync();
    const bf16_t* W = wsb(p, O_WT);
#pragma unroll
    for (int l = 0; l < 2; ++l) {
        const bool first = l == 0, lat = l == 1;
        if (l == 1) phase_wconv(p, 1, smem);
        phase_norm(p, l, 0, first, false);
        xcd_barrier(xb);
        phase_g1(p, smem);
        xcd_barrier(xb);
        phase_mix(p, l, smem);
        xcd_barrier(xb);
        phase_fin_norm(p, l, first, lat);
        xcd_barrier(xb);
        phase_gate(p, lat, smem);
        xcd_barrier(xb);
        phase_merge(p, lat, smem);
        xcd_barrier(xb);
        phase_resid(p, l, wsb(p, O_U), D, W + W_OUT, 1024, 2, first, lat, smem);
        xcd_barrier(xb);
        phase_norm(p, l, 1, false, lat);
        xcd_barrier(xb);
        phase_gu(p, lat, smem);
        xcd_barrier(xb);
        phase_resid(p, l, wsb(p, O_P), PW, W + W_DN, DFF, 5, false, lat, smem);
        xcd_barrier(xb);
    }
    phase_final(p);
}
#else
__global__ void __launch_bounds__(256) phase_kernel(Params p, int ph) {
    extern __shared__ __align__(16) unsigned char smem[];
    run_phase(p, ph, smem);
}
#endif

extern "C" void kernel_launch(void* const* d_in, const int* in_sizes, int n_in, void* d_out, int out_size, void* d_ws, size_t ws_size, hipStream_t stream) {
    static int grid = 0;
    if (grid == 0) {
        if (n_in != 28 || ws_size < WS_END) { fprintf(stderr, "kernel_launch: unexpected n_in %d or ws_size %zu < %zu\n", n_in, ws_size, (size_t)WS_END); grid = -1; return; }
        int dev = 0, cus = 0, per_cu = 0;
        hipGetDevice(&dev);
        hipDeviceGetAttribute(&cus, hipDeviceAttributeMultiprocessorCount, dev);
#if MEGA
        hipFuncSetAttribute((const void*)mega_kernel, hipFuncAttributeMaxDynamicSharedMemorySize, LDS_BYTES);
        hipOccupancyMaxActiveBlocksPerMultiprocessor(&per_cu, (const void*)mega_kernel, 256, LDS_BYTES);
#else
        hipFuncSetAttribute((const void*)phase_kernel, hipFuncAttributeMaxDynamicSharedMemorySize, LDS_BYTES);
        hipOccupancyMaxActiveBlocksPerMultiprocessor(&per_cu, (const void*)phase_kernel, 256, LDS_BYTES);
#endif
        if (per_cu < 1) per_cu = 1;
        grid = cus * per_cu;
        fprintf(stderr, "kernel_launch: grid %d (%d CUs x %d)\n", grid, cus, per_cu);
    }
    if (grid < 0) return;
    hipMemsetAsync((char*)d_ws + O_CTL, 0, 4096 + 16384, stream);
    Params p{};
    for (int i = 0; i < 28; ++i) p.in[i] = (const float*)d_in[i];
    p.out = (float*)d_out; p.ws = (unsigned char*)d_ws;
#if MEGA
    void* args[] = {&p};
    hipError_t e = hipLaunchCooperativeKernel((const void*)mega_kernel, dim3(grid), dim3(256), args, LDS_BYTES, stream);
    if (e != hipSuccess) fprintf(stderr, "cooperative launch failed: %s (grid %d)\n", hipGetErrorString(e), grid);
#else
    for (int ph = 0; ph < NPHASE; ++ph) hipLaunchKernelGGL(phase_kernel, dim3(grid), dim3(256), LDS_BYTES, stream, p, ph);
#endif
}
```

```cpp
#include <hip/hip_runtime.h>
#include <hip/hip_cooperative_groups.h>
#include <cstdio>
#include <cstdint>
namespace cg = cooperative_groups;

#ifndef MEGA
#define MEGA 1
#endif

typedef unsigned short bf16_t;
typedef short bf16x8 __attribute__((ext_vector_type(8)));
typedef float f32x4 __attribute__((ext_vector_type(4)));
typedef unsigned u32x4 __attribute__((ext_vector_type(4)));
typedef unsigned u32x2 __attribute__((ext_vector_type(2)));
#define DEV __device__ __forceinline__

constexpr int D = 1024, NB = 8, SEQ = 4096, CTXL = 256, SB = 4352, MR = NB * SB, PW = 4096, DFF = 2816;
constexpr int C_DNQ = 0, C_DNK = 512, C_DNV = 1024, C_DNZ = 1536, C_LX = 2048, C_LG = 2560, C_DAQ = 3072, C_DAK = 3584;
constexpr int NIN = 4736;
constexpr int GLD = 80;

enum { I_X = 0, I_C, I_CTX, I_CCTX, I_WMOD, I_BMOD, I_NMIX, I_NFFN, I_WIN, I_DNCONV, I_DNALOG, I_DNDT, I_DNNORM, I_LCW, I_LCB,
       I_LWA, I_LBA, I_LWI, I_LBI, I_LLAM, I_DALAM, I_DANORM, I_WBR, I_WOUT, I_WFG, I_WFU, I_WFD, I_NFIN };

constexpr size_t al256(size_t x) { return (x + 255) & ~(size_t)255; }
constexpr size_t O_CTL = 0;
constexpr size_t O_BAR = 4096;
constexpr size_t O_MOD = 4096 + 16384;
constexpr size_t O_ROPE = al256(O_MOD + (size_t)2 * 9 * 6144 * 4);
constexpr size_t O_WT = al256(O_ROPE + 64 * 16 * 2 * 4);
constexpr size_t W_IN = 0, W_GATE = W_IN + (size_t)NIN * 1024, W_BR = W_GATE + (size_t)3072 * 1024, W_OUT = W_BR + (size_t)3 * 1024 * 512,
                 W_GU = W_OUT + (size_t)1024 * 1024, W_DN = W_GU + (size_t)5632 * 1024, W_END = W_DN + (size_t)1024 * 2816;
constexpr size_t O_HCTX = al256(O_WT + W_END * 2);
constexpr size_t O_U = al256(O_HCTX + (size_t)2048 * 1024 * 4);
constexpr size_t O_P = al256(O_U + (size_t)MR * 1024 * 2);
constexpr size_t O_AB = al256(O_P + (size_t)MR * PW * 2);
constexpr size_t O_TA = al256(O_AB + (size_t)MR * 16 * 4);
constexpr size_t O_TA2 = al256(O_TA + (size_t)MR * 512 * 2);
constexpr size_t O_VT = al256(O_TA2 + (size_t)MR * 512 * 2);
constexpr size_t WS_END = al256(O_VT + (size_t)MR * 512 * 2);

constexpr int LDS_BYTES = 140 * 1024;

struct Params {
    const float* in[28];
    float* out;
    unsigned char* ws;
};

DEV int get_tid() { int t = threadIdx.x; asm volatile("" : "+v"(t)); return t; }
DEV float bf2f(bf16_t h) { return __uint_as_float(((unsigned)h) << 16); }
DEV bf16_t f2bf(float f) { unsigned u = __float_as_uint(f); u += 0x7fffu + ((u >> 16) & 1u); return (bf16_t)(u >> 16); }
typedef float f32x2_ __attribute__((ext_vector_type(2)));
typedef __bf16 bf16x2_ __attribute__((ext_vector_type(2)));
DEV unsigned pack2(float a, float b) { const f32x2_ v = {a, b}; return __builtin_bit_cast(unsigned, __builtin_convertvector(v, bf16x2_)); }
DEV float sigm(float x) { return __builtin_amdgcn_rcpf(1.f + __expf(-x)); }
DEV float silu(float x) { return x * __builtin_amdgcn_rcpf(1.f + __expf(-x)); }
DEV float softplus(float x) { return x > 20.f ? x : log1pf(expf(x)); }
DEV float softplus_fast(float x) { const float e = __expf(x); return x > 15.f ? x : (e < 0.01f ? e * (1.f - e * (0.5f - e * 0.33333333f)) : __logf(1.f + e)); }
DEV float gelu_tanh(float x) { float u = 0.7978845608028654f * (x + 0.044715f * x * x * x); float t = 1.f - 2.f * __builtin_amdgcn_rcpf(1.f + __expf(2.f * u)); return 0.5f * x * (1.f + t); }
DEV f32x4 mfma16(bf16x8 a, bf16x8 b, f32x4 c) { return __builtin_amdgcn_mfma_f32_16x16x32_bf16(a, b, c, 0, 0, 0); }
DEV void mfma16a(f32x4& c, bf16x8 a, bf16x8 b) { asm volatile("v_mfma_f32_16x16x32_bf16 %0, %1, %2, %0" : "+a"(c) : "v"(a), "v"(b)); }
DEV float lo16(unsigned v) { return __uint_as_float(v << 16); }
DEV float hi16(unsigned v) { return __uint_as_float(v & 0xffff0000u); }

DEV bf16_t* wsb(const Params& p, size_t off) { return (bf16_t*)(p.ws + off); }
DEV float* wsf(const Params& p, size_t off) { return (float*)(p.ws + off); }
DEV float* hrow(const Params& p, int r) { int b = r / SB, s = r - b * SB; return s < CTXL ? wsf(p, O_HCTX) + (size_t)(b * CTXL + s) * D : p.out + (size_t)(b * SEQ + s - CTXL) * D; }
DEV const float* xrow(const Params& p, int r) { int b = r / SB, s = r - b * SB; return s < CTXL ? p.in[I_CTX] + (size_t)(b * CTXL + s) * D : p.in[I_X] + (size_t)(b * SEQ + s - CTXL) * D; }
DEV int modrow(int r) { int b = r / SB, s = r - b * SB; return s < CTXL ? 8 : b; }

template <int MT, int NT>
DEV void gemm_core(const bf16_t* __restrict__ A, int lda, const bf16_t* __restrict__ Bt, int ldb, int K, f32x4 (&acc)[MT][NT], bf16_t* smem_) {
    constexpr int SA = 32 * MT * GLD, SBB = 32 * NT * GLD;
    bf16_t* sA = smem_; bf16_t* sB = smem_ + 2 * SA;
    const int tid = get_tid(), lane = tid & 63, wv = tid >> 6, wr = wv >> 1, wc = wv & 1, l15 = lane & 15, quad = lane >> 4;
    const int lr = tid >> 3, lc = (tid & 7) * 8;
    u32x4 ra0[MT], rb0[NT], ra1[MT], rb1[NT];
    const bf16_t* Ap = A + (size_t)lr * lda + lc;
    const bf16_t* Bp = Bt + (size_t)lr * ldb + lc;
    const int nk = K >> 6;
#define GLOAD(RA, RB, KT) { const int ko_ = (KT) * 64; _Pragma("unroll") for (int i = 0; i < MT; ++i) RA[i] = *(const u32x4*)(Ap + (size_t)(32 * i) * lda + ko_); \
                            _Pragma("unroll") for (int i = 0; i < NT; ++i) RB[i] = *(const u32x4*)(Bp + (size_t)(32 * i) * ldb + ko_); }
#define LSTORE(RA, RB, BUF) { _Pragma("unroll") for (int i = 0; i < MT; ++i) *(u32x4*)(sA + (BUF) * SA + (lr + 32 * i) * GLD + lc) = RA[i]; \
                              _Pragma("unroll") for (int i = 0; i < NT; ++i) *(u32x4*)(sB + (BUF) * SBB + (lr + 32 * i) * GLD + lc) = RB[i]; }
#define AFRAG(BUF, MT_, KS) (*(const bf16x8*)(sA + (BUF) * SA + (wr * MT * 16 + (MT_) * 16 + l15) * GLD + (KS) * 32 + quad * 8))
#define HALF(BUFC, RA, RB, BUFS, DO_STORE, DO_LOAD, KT) { \
        bf16x8 bfr[2][NT]; \
        _Pragma("unroll") for (int ks = 0; ks < 2; ++ks) _Pragma("unroll") for (int nt = 0; nt < NT; ++nt) \
            bfr[ks][nt] = *(const bf16x8*)(sB + (BUFC) * SBB + (wc * NT * 16 + nt * 16 + l15) * GLD + ks * 32 + quad * 8); \
        bf16x8 a0 = AFRAG(BUFC, 0, 0), a1 = AFRAG(BUFC, 0, 1); \
        const int ko_ = (KT) * 64; \
        _Pragma("unroll") for (int mt = 0; mt < MT; ++mt) { \
            bf16x8 n0 = a0, n1 = a1; \
            if (mt + 1 < MT) { n0 = AFRAG(BUFC, mt + 1, 0); n1 = AFRAG(BUFC, mt + 1, 1); } \
            if (DO_STORE) { *(u32x4*)(sA + (BUFS) * SA + (lr + 32 * mt) * GLD + lc) = RA[mt]; if (mt < NT) *(u32x4*)(sB + (BUFS) * SBB + (lr + 32 * mt) * GLD + lc) = RB[mt]; } \
            if (DO_LOAD) { RA[mt] = *(const u32x4*)(Ap + (size_t)(32 * mt) * lda + ko_); if (mt < NT) RB[mt] = *(const u32x4*)(Bp + (size_t)(32 * mt) * ldb + ko_); } \
            _Pragma("unroll") for (int nt = 0; nt < NT; ++nt) mfma16a(acc[mt][nt], bfr[0][nt], a0); \
            _Pragma("unroll") for (int nt = 0; nt < NT; ++nt) mfma16a(acc[mt][nt], bfr[1][nt], a1); \
            a0 = n0; a1 = n1; \
        } }
    static_assert(NT <= MT, "HALF stages the B pieces alongside the first NT A pieces");
    GLOAD(ra0, rb0, 0);
    GLOAD(ra1, rb1, 1);
    __syncthreads();
    LSTORE(ra0, rb0, 0);
    GLOAD(ra0, rb0, 2);
    __syncthreads();
    int kt = 0;
#pragma unroll 1
    for (; kt + 4 < nk; kt += 2) {
        HALF(0, ra1, rb1, 1, true, true, kt + 3);
        __syncthreads();
        HALF(1, ra0, rb0, 0, true, true, kt + 4);
        __syncthreads();
    }
    HALF(0, ra1, rb1, 1, true, true, kt + 3);
    __syncthreads();
    HALF(1, ra0, rb0, 0, true, false, 0);
    __syncthreads();
    HALF(0, ra1, rb1, 1, true, false, 0);
    __syncthreads();
    HALF(1, ra0, rb0, 0, false, false, 0);
    __syncthreads();
#undef AFRAG
#undef HALF
#undef GLOAD
#undef LSTORE
    static_assert(NT == 4, "the accumulator fence is written for NT == 4");
#pragma unroll
    for (int mt = 0; mt < MT; ++mt) {
        if (mt == 0) asm volatile("s_nop 15\n\ts_nop 15" : "+a"(acc[mt][0]), "+a"(acc[mt][1]), "+a"(acc[mt][2]), "+a"(acc[mt][3]));
        else asm volatile("s_nop 0" : "+a"(acc[mt][0]), "+a"(acc[mt][1]), "+a"(acc[mt][2]), "+a"(acc[mt][3]));
    }
}
template <int MT, int NT>
DEV void gemm_core1(const bf16_t* __restrict__ A, int lda, const bf16_t* __restrict__ Bt, int ldb, int K, f32x4 (&acc)[MT][NT], bf16_t* sA, bf16_t* sB) {
    const int tid = get_tid(), lane = tid & 63, wv = tid >> 6, wr = wv >> 1, wc = wv & 1, l15 = lane & 15, quad = lane >> 4;
    const int lr = tid >> 3, lc = (tid & 7) * 8;
    u32x4 ra[MT], rb[NT];
    const bf16_t* Ap = A + (size_t)lr * lda + lc;
    const bf16_t* Bp = Bt + (size_t)lr * ldb + lc;
#pragma unroll
    for (int i = 0; i < MT; ++i) ra[i] = *(const u32x4*)(Ap + (size_t)(32 * i) * lda);
#pragma unroll
    for (int i = 0; i < NT; ++i) rb[i] = *(const u32x4*)(Bp + (size_t)(32 * i) * ldb);
    const int nk = K >> 6;
    for (int kt = 0; kt < nk; ++kt) {
        __syncthreads();
#pragma unroll
        for (int i = 0; i < MT; ++i) *(u32x4*)(sA + (lr + 32 * i) * GLD + lc) = ra[i];
#pragma unroll
        for (int i = 0; i < NT; ++i) *(u32x4*)(sB + (lr + 32 * i) * GLD + lc) = rb[i];
        __syncthreads();
        if (kt + 1 < nk) {
            const int ko = (kt + 1) * 64;
#pragma unroll
            for (int i = 0; i < MT; ++i) ra[i] = *(const u32x4*)(Ap + (size_t)(32 * i) * lda + ko);
#pragma unroll
            for (int i = 0; i < NT; ++i) rb[i] = *(const u32x4*)(Bp + (size_t)(32 * i) * ldb + ko);
        }
#pragma unroll
        for (int ks = 0; ks < 2; ++ks) {
            bf16x8 af[MT], bfr[NT];
#pragma unroll
            for (int mt = 0; mt < MT; ++mt) af[mt] = *(const bf16x8*)(sA + (wr * MT * 16 + mt * 16 + l15) * GLD + ks * 32 + quad * 8);
#pragma unroll
            for (int nt = 0; nt < NT; ++nt) bfr[nt] = *(const bf16x8*)(sB + (wc * NT * 16 + nt * 16 + l15) * GLD + ks * 32 + quad * 8);
#pragma unroll
            for (int mt = 0; mt < MT; ++mt)
#pragma unroll
                for (int nt = 0; nt < NT; ++nt) mfma16a(acc[mt][nt], bfr[nt], af[mt]);
        }
    }
    static_assert(NT == 4, "the accumulator fence is written for NT == 4");
#pragma unroll
    for (int mt = 0; mt < MT; ++mt) {
        if (mt == 0) asm volatile("s_nop 15\n\ts_nop 15" : "+a"(acc[mt][0]), "+a"(acc[mt][1]), "+a"(acc[mt][2]), "+a"(acc[mt][3]));
        else asm volatile("s_nop 0" : "+a"(acc[mt][0]), "+a"(acc[mt][1]), "+a"(acc[mt][2]), "+a"(acc[mt][3]));
    }
}
template <int MT, int NT>
DEV void zero_acc(f32x4 (&acc)[MT][NT]) {
#pragma unroll
    for (int mt = 0; mt < MT; ++mt)
#pragma unroll
        for (int nt = 0; nt < NT; ++nt) acc[mt][nt] = (f32x4){0.f, 0.f, 0.f, 0.f};
}

DEV void phase_mod(const Params& p, unsigned char* smem) {
    float* s_s = (float*)smem;
    float* red = s_s + 9 * 1024;
    const int tid = get_tid();
    bool loaded = false;
    for (int it = blockIdx.x; it < 2 * 96; it += gridDim.x) {
        if (!loaded) {
            for (int e = tid; e < 9 * 1024; e += 256) { float v = e < 8192 ? p.in[I_C][e] : p.in[I_CCTX][e - 8192]; s_s[e] = silu(v); }
            loaded = true;
        }
        __syncthreads();
        const int l = it / 96, cg_ = it % 96, cq = tid & 63, kq = tid >> 6, col = cg_ * 64 + cq;
        float acc[9];
#pragma unroll
        for (int r = 0; r < 9; ++r) acc[r] = 0.f;
        const float* wp = p.in[I_WMOD] + ((size_t)l * 1024 + kq * 256) * 6144 + col;
#pragma unroll 8
        for (int k = 0; k < 256; ++k) {
            float wv = wp[(size_t)k * 6144];
#pragma unroll
            for (int r = 0; r < 9; ++r) acc[r] += s_s[r * 1024 + kq * 256 + k] * wv;
        }
#pragma unroll
        for (int r = 0; r < 9; ++r) red[(kq * 9 + r) * 64 + cq] = acc[r];
        __syncthreads();
        for (int e = tid; e < 9 * 64; e += 256) {
            int r = e >> 6, c2 = e & 63;
            float v = red[(0 * 9 + r) * 64 + c2] + red[(1 * 9 + r) * 64 + c2] + red[(2 * 9 + r) * 64 + c2] + red[(3 * 9 + r) * 64 + c2];
            wsf(p, O_MOD)[((size_t)l * 9 + r) * 6144 + cg_ * 64 + c2] = v + p.in[I_BMOD][l * 6144 + cg_ * 64 + c2];
        }
        __syncthreads();
    }
}
DEV void phase_rope(const Params& p) {
    if (blockIdx.x == (gridDim.x - 1)) {
        for (int e = threadIdx.x; e < 1024; e += 256) {
            int pos = e >> 4, i = e & 15;
            float inv = powf(10000.f, -(float)i / 16.f);
            float ang = (float)pos * inv;
            float n = rintf(ang * 0.15915494309189535f);
            float r = fmaf(-n, 6.28125f, ang);
            r = fmaf(-n, 1.9353071795864769e-3f, r);
            wsf(p, O_ROPE)[e * 2] = cosf(r);
            wsf(p, O_ROPE)[e * 2 + 1] = sinf(r);
        }
    }
}
DEV void wconv_tile(const float* src0, const float* src1, int lds_, int K, bf16_t* dst, int kind, int kt, int nt, bf16_t* tile) {
    const int tid = get_tid();
    const int kk = tid >> 2, grp = tid & 3;
    const int n0 = nt * 64, k0 = kt * 64;
    const int ng = n0 + grp * 16;
    const float* src = src0; int sc;
    if (kind == 0) { sc = ng < 2048 ? ng : (ng < 4608 ? ng + 16 : (ng < 4624 ? 2048 : -1)); }
    else if (kind == 1) { sc = 4624 + ng; }
    else if (kind == 2) { sc = ng; }
    else { int gd = ng >> 4; src = (gd & 1) ? src1 : src0; sc = (gd >> 1) * 16; }
    __syncthreads();
    if (sc >= 0) {
        const float4* sp = (const float4*)(src + (size_t)(k0 + kk) * lds_ + sc);
#pragma unroll
        for (int q = 0; q < 4; ++q) { float4 v = sp[q]; int e = grp * 16 + q * 4;
            tile[(e + 0) * GLD + kk] = f2bf(v.x); tile[(e + 1) * GLD + kk] = f2bf(v.y); tile[(e + 2) * GLD + kk] = f2bf(v.z); tile[(e + 3) * GLD + kk] = f2bf(v.w); }
    } else {
#pragma unroll
        for (int e = 0; e < 16; ++e) tile[(grp * 16 + e) * GLD + kk] = 0;
    }
    __syncthreads();
    const int n = tid >> 2, kseg = (tid & 3) * 16;
    u32x4 a = *(const u32x4*)(tile + n * GLD + kseg), b = *(const u32x4*)(tile + n * GLD + kseg + 8);
    bf16_t* dp = dst + (size_t)(n0 + n) * K + k0 + kseg;
    *(u32x4*)dp = a; *(u32x4*)(dp + 8) = b;
}
DEV void phase_wconv(const Params& p, int l, unsigned char* smem) {
    bf16_t* tile = (bf16_t*)smem;
    bf16_t* W = wsb(p, O_WT);
    constexpr int T0 = 74 * 16, T1 = T0 + 48 * 16, T2 = T1 + 3 * 16 * 8, T3 = T2 + 16 * 16, T4 = T3 + 88 * 16, T5 = T4 + 16 * 44;
    for (int t = blockIdx.x; t < T5; t += gridDim.x) {
        if (t < T0) { wconv_tile(p.in[I_WIN] + (size_t)l * 1024 * 7696, nullptr, 7696, 1024, W + W_IN, 0, t % 16, t / 16, tile); }
        else if (t < T1) { int u = t - T0; wconv_tile(p.in[I_WIN] + (size_t)l * 1024 * 7696, nullptr, 7696, 1024, W + W_GATE, 1, u % 16, u / 16, tile); }
        else if (t < T2) { int u = t - T1; int n = u / 128, v = u % 128; wconv_tile(p.in[I_WBR] + ((size_t)l * 3 + n) * 512 * 1024, nullptr, 1024, 512, W + W_BR + (size_t)n * 1024 * 512, 2, v % 8, v / 8, tile); }
        else if (t < T3) { int u = t - T2; wconv_tile(p.in[I_WOUT] + (size_t)l * 1024 * 1024, nullptr, 1024, 1024, W + W_OUT, 2, u % 16, u / 16, tile); }
        else if (t < T4) { int u = t - T3; wconv_tile(p.in[I_WFG] + (size_t)l * 1024 * DFF, p.in[I_WFU] + (size_t)l * 1024 * DFF, DFF, 1024, W + W_GU, 3, u % 16, u / 16, tile); }
        else { int u = t - T4; wconv_tile(p.in[I_WFD] + (size_t)l * DFF * 1024, nullptr, 1024, DFF, W + W_DN, 2, u % 44, u / 44, tile); }
    }
}

DEV void norm_row(const Params& p, int l, int which, bool first, int r, int lane) {
    const float* h = first ? xrow(p, r) : hrow(p, r);
    const float* nw = p.in[which ? I_NFFN : I_NMIX] + l * D;
    const float* md = wsf(p, O_MOD) + ((size_t)l * 9 + modrow(r)) * 6144 + (which ? 3 * D : 0);
    float4 v[4]; float ss = 0.f;
#pragma unroll
    for (int i = 0; i < 4; ++i) { v[i] = *(const float4*)(h + i * 256 + lane * 4); ss += v[i].x * v[i].x + v[i].y * v[i].y + v[i].z * v[i].z + v[i].w * v[i].w; }
#pragma unroll
    for (int o = 32; o >= 1; o >>= 1) ss += __shfl_xor(ss, o);
    const float rstd = rsqrtf(ss * (1.f / D) + 1e-6f);
    bf16_t* up = wsb(p, O_U) + (size_t)r * D;
#pragma unroll
    for (int i = 0; i < 4; ++i) {
        const int c = i * 256 + lane * 4;
        float4 w4 = *(const float4*)(nw + c), sh = *(const float4*)(md + c), sc = *(const float4*)(md + D + c);
        float a = v[i].x * rstd * w4.x * (1.f + sc.x) + sh.x, b = v[i].y * rstd * w4.y * (1.f + sc.y) + sh.y;
        float c2 = v[i].z * rstd * w4.z * (1.f + sc.z) + sh.z, d = v[i].w * rstd * w4.w * (1.f + sc.w) + sh.w;
        u32x2 o; o.x = pack2(a, b); o.y = pack2(c2, d);
        *(u32x2*)(up + c) = o;
    }
}
DEV void phase_norm(const Params& p, int l, int which, bool first, bool skip_ctx) {
    const int tid_ = get_tid(); const int lane = tid_ & 63, wv = tid_ >> 6;
    for (int r = blockIdx.x * 4 + wv; r < MR; r += gridDim.x * 4) {
        if (skip_ctx && (r % SB) < CTXL) continue;
        norm_row(p, l, which, first, r, lane);
    }
}
DEV void phase_fin_norm(const Params& p, int l, bool first, bool skip_ctx) {
    const int tid_ = get_tid(); const int lane = tid_ & 63, wv = tid_ >> 6;
    const float* dnn = p.in[I_DNNORM] + l * 128;
    for (int r = blockIdx.x * 4 + wv; r < MR; r += gridDim.x * 4) {
        if (skip_ctx && (r % SB) < CTXL) continue;
        norm_row(p, l, 0, first, r, lane);
        bf16_t* ta = wsb(p, O_TA) + (size_t)r * 512 + lane * 8;
        const bf16_t* tb = wsb(p, O_TA2) + (size_t)r * 512 + lane * 8;
        const bf16_t* zz = wsb(p, O_P) + (size_t)r * PW + C_DNZ + lane * 8;
        u32x4 a = *(const u32x4*)ta, b = *(const u32x4*)tb, z = *(const u32x4*)zz;
        float o[8]; float ss = 0.f;
#pragma unroll
        for (int i = 0; i < 4; ++i) { o[2 * i] = lo16(a[i]) + lo16(b[i]); o[2 * i + 1] = hi16(a[i]) + hi16(b[i]); ss += o[2 * i] * o[2 * i] + o[2 * i + 1] * o[2 * i + 1]; }
#pragma unroll
        for (int of = 8; of >= 1; of >>= 1) ss += __shfl_xor(ss, of);
        const float rstd = rsqrtf(ss * (1.f / 128.f) + 1e-6f);
        const int dv0 = (lane & 15) * 8;
        u32x4 y;
#pragma unroll
        for (int i = 0; i < 4; ++i) {
            float y0 = o[2 * i] * rstd * dnn[dv0 + 2 * i] * silu(lo16(z[i]));
            float y1 = o[2 * i + 1] * rstd * dnn[dv0 + 2 * i + 1] * silu(hi16(z[i]));
            y[i] = pack2(y0, y1);
        }
        *(u32x4*)ta = y;
    }
}
DEV void phase_final(const Params& p) {
    const int tid_ = get_tid(); const int lane = tid_ & 63, wv = tid_ >> 6;
    const float* nw = p.in[I_NFIN];
    for (int r = blockIdx.x * 4 + wv; r < NB * SEQ; r += gridDim.x * 4) {
        float* h = p.out + (size_t)r * D;
        float4 v[4]; float ss = 0.f;
#pragma unroll
        for (int i = 0; i < 4; ++i) { v[i] = *(const float4*)(h + i * 256 + lane * 4); ss += v[i].x * v[i].x + v[i].y * v[i].y + v[i].z * v[i].z + v[i].w * v[i].w; }
#pragma unroll
        for (int o = 32; o >= 1; o >>= 1) ss += __shfl_xor(ss, o);
        const float rstd = rsqrtf(ss * (1.f / D) + 1e-6f);
#pragma unroll
        for (int i = 0; i < 4; ++i) {
            const int c = i * 256 + lane * 4;
            float4 w4 = *(const float4*)(nw + c);
            float4 o4; o4.x = v[i].x * rstd * w4.x; o4.y = v[i].y * rstd * w4.y; o4.z = v[i].z * rstd * w4.z; o4.w = v[i].w * rstd * w4.w;
            *(float4*)(h + c) = o4;
        }
    }
}

struct TileIter {
    int nn, total, nloc, L;
    DEV TileIter(int nm, int nn_) { nn = nn_; total = nm * nn_; nloc = gridDim.x >> 3; L = (blockIdx.x & 7) * nloc + (blockIdx.x >> 3); }
    DEV bool valid() const { return L < total; }
    DEV bool more() const { return (L - (int)(blockIdx.x >> 3)) < total; }
    DEV void next() { L += 8 * nloc; }
    DEV void get(int& tm, int& tn) const { const int pn = 4 * nn, panel = L / pn, rem = L - panel * pn; tn = rem >> 2; tm = panel * 4 + (rem & 3); }
};
DEV void phase_g1(const Params& p, unsigned char* smem) {
    bf16_t* sA = (bf16_t*)smem;
    const int tid = get_tid(), lane = tid & 63, wv = tid >> 6, wr = wv >> 1, wc = wv & 1, l15 = lane & 15, quad = lane >> 4;
    const bf16_t* U = wsb(p, O_U); const bf16_t* W = wsb(p, O_WT) + W_IN;
    bf16_t* P = wsb(p, O_P);
    const float* rope = wsf(p, O_ROPE);
    constexpr int NTN = NIN / 128;
    const int wr0_ = wr, wc0_ = wc, l150_ = l15, quad0_ = quad;
    for (TileIter ti(MR / 256, NTN); ti.valid(); ti.next()) {
        int tm, tn; ti.get(tm, tn);
        const int row0 = tm * 256, col0 = tn * 128;
        f32x4 acc[8][4]; zero_acc(acc);
        gemm_core<8, 4>(U + (size_t)row0 * D, D, W + (size_t)col0 * D, D, D, acc, sA);
        int tz = 0; asm volatile("" : "+v"(tz));
        const int wr = wr0_ + tz, wc = wc0_ + tz, l15 = l150_ + tz, quad = quad0_ + tz;
        if (tn < 24) {
#pragma unroll
            for (int mt = 0; mt < 8; ++mt) {
                __builtin_amdgcn_sched_barrier(0);
                bf16_t* pp = P + (size_t)(row0 + wr * 128 + mt * 16 + l15) * PW + col0 + wc * 64 + quad * 4;
#pragma unroll
                for (int nt = 0; nt < 4; ++nt) { u32x2 o; o.x = pack2(acc[mt][nt][0], acc[mt][nt][1]); o.y = pack2(acc[mt][nt][2], acc[mt][nt][3]); *(u32x2*)(pp + nt * 16) = o; }
            }
        } else if (tn < 32) {
            const float qs = tn < 28 ? 0.125f : 1.f;
#pragma unroll
            for (int mt = 0; mt < 8; ++mt) {
                __builtin_amdgcn_sched_barrier(0);
                const int row = row0 + wr * 128 + mt * 16 + l15;
                const int s_ = row % SB;
                f32x4 ca = {1.f, 1.f, 1.f, 1.f}, sa = {0.f, 0.f, 0.f, 0.f}, cb = {1.f, 1.f, 1.f, 1.f}, sb = {0.f, 0.f, 0.f, 0.f};
                if (s_ >= CTXL) { const int tt = s_ - CTXL, pr = tt >> 6, pc = tt & 63;
                    const f32x4 r0 = *(const f32x4*)(rope + (pr * 16 + quad * 4) * 2), r1 = *(const f32x4*)(rope + (pr * 16 + quad * 4) * 2 + 4);
                    const f32x4 r2 = *(const f32x4*)(rope + (pc * 16 + quad * 4) * 2), r3 = *(const f32x4*)(rope + (pc * 16 + quad * 4) * 2 + 4);
                    ca = (f32x4){r0[0], r0[2], r1[0], r1[2]}; sa = (f32x4){r0[1], r0[3], r1[1], r1[3]};
                    cb = (f32x4){r2[0], r2[2], r3[0], r3[2]}; sb = (f32x4){r2[1], r2[3], r3[1], r3[3]}; }
                const f32x4 x1 = acc[mt][0], x2 = acc[mt][1], y1 = acc[mt][2], y2 = acc[mt][3];
                const f32x4 o0 = (x1 * ca - x2 * sa) * qs, o1 = (x2 * ca + x1 * sa) * qs, o2 = (y1 * cb - y2 * sb) * qs, o3 = (y2 * cb + y1 * sb) * qs;
                bf16_t* pp = P + (size_t)row * PW + col0 + wc * 64 + quad * 4;
                u32x2 o; o.x = pack2(o0[0], o0[1]); o.y = pack2(o0[2], o0[3]); *(u32x2*)(pp) = o;
                o.x = pack2(o1[0], o1[1]); o.y = pack2(o1[2], o1[3]); *(u32x2*)(pp + 16) = o;
                o.x = pack2(o2[0], o2[1]); o.y = pack2(o2[2], o2[3]); *(u32x2*)(pp + 32) = o;
                o.x = pack2(o3[0], o3[1]); o.y = pack2(o3[2], o3[3]); *(u32x2*)(pp + 48) = o;
            }
        } else if (tn < 36) {
            bf16_t* VT = wsb(p, O_VT);
            const int b = row0 / SB, sbase = row0 - b * SB;
#pragma unroll
            for (int mt = 0; mt < 8; ++mt) {
                __builtin_amdgcn_sched_barrier(0);
                const int s_ = sbase + wr * 128 + mt * 16 + l15;
                const int vi0 = (b * 512 + col0 - 4096 + wc * 64 + quad * 4) * SB + s_;
#pragma unroll
                for (int nt = 0; nt < 4; ++nt) {
                    const unsigned p01 = pack2(acc[mt][nt][0], acc[mt][nt][1]), p23 = pack2(acc[mt][nt][2], acc[mt][nt][3]);
                    VT[vi0 + (nt * 16 + 0) * SB] = (bf16_t)(p01 & 0xffffu); VT[vi0 + (nt * 16 + 1) * SB] = (bf16_t)(p01 >> 16);
                    VT[vi0 + (nt * 16 + 2) * SB] = (bf16_t)(p23 & 0xffffu); VT[vi0 + (nt * 16 + 3) * SB] = (bf16_t)(p23 >> 16);
                }
            }
        } else {
            if (wc == 0) {
                float* AB = wsf(p, O_AB);
#pragma unroll
                for (int mt = 0; mt < 8; ++mt) {
                    const int row = row0 + wr * 128 + mt * 16 + l15;
                    *(f32x4*)(AB + (size_t)row * 16 + quad * 4) = acc[mt][0];
                }
            }
        }
    }
}

DEV int rowtile0(int ti, bool latent_only) { if (!latent_only) return ti * 256; int b = ti >> 4, tt = ti & 15; return b * SB + CTXL + tt * 256; }
DEV int sgcol(int n, int c) { return n < 2 ? n * 1024 + c : (c < 512 ? 2048 + c : 3584 + (c - 512)); }

DEV void phase_gate(const Params& p, bool latent_only, unsigned char* smem) {
    bf16_t* sA = (bf16_t*)smem;
    const int tid = get_tid(), lane = tid & 63, wv = tid >> 6, wr = wv >> 1, wc = wv & 1, l15 = lane & 15, quad = lane >> 4;
    const bf16_t* U = wsb(p, O_U); const bf16_t* W = wsb(p, O_WT) + W_GATE;
    bf16_t* P = wsb(p, O_P);
    const int nrt = latent_only ? 128 : 136;
    for (TileIter ti(nrt, 24); ti.valid(); ti.next()) {
        int tm, tn; ti.get(tm, tn);
        const int row0 = rowtile0(tm, latent_only);
        f32x4 acc[8][4]; zero_acc(acc);
        gemm_core<8, 4>(U + (size_t)row0 * D, D, W + (size_t)tn * 128 * D, D, D, acc, sA);
        const int dcol0 = sgcol(tn >> 3, (tn & 7) * 128);
        bf16_t* ip = P + (size_t)(row0 + tid) * PW + dcol0;
#pragma unroll
        for (int mt = 0; mt < 8; ++mt) {
            __builtin_amdgcn_sched_barrier(0);
#pragma unroll
            for (int hf = 0; hf < 2; ++hf) {
                u32x4 o;
                o[0] = pack2(sigm(acc[mt][2 * hf][0]), sigm(acc[mt][2 * hf][1])); o[1] = pack2(sigm(acc[mt][2 * hf][2]), sigm(acc[mt][2 * hf][3]));
                o[2] = pack2(sigm(acc[mt][2 * hf + 1][0]), sigm(acc[mt][2 * hf + 1][1])); o[3] = pack2(sigm(acc[mt][2 * hf + 1][2]), sigm(acc[mt][2 * hf + 1][3]));
                *(u32x4*)(ip + (mt * 2 + hf) * 8) = o;
            }
        }
    }
}

DEV void phase_merge(const Params& p, bool latent_only, unsigned char* smem) {
    bf16_t* sA = (bf16_t*)smem;
    const int tid = get_tid(), lane = tid & 63, wv = tid >> 6, wr = wv >> 1, wc = wv & 1, l15 = lane & 15, quad = lane >> 4;
    const bf16_t* W = wsb(p, O_WT);
    const bf16_t* P = wsb(p, O_P);
    bf16_t* U = wsb(p, O_U);
    const int nrt = latent_only ? 128 : 136;
    for (TileIter ti(nrt, 8); ti.valid(); ti.next()) {
        int tm, tn; ti.get(tm, tn);
        const int row0 = rowtile0(tm, latent_only), col0 = tn * 128;
        f32x4 m[8][4]; zero_acc(m);
#pragma unroll 1
        for (int n = 0; n < 3; ++n) {
            f32x4 au[8][4]; zero_acc(au);
            const bf16_t* Y; int ldy;
            if (n == 0) { Y = wsb(p, O_TA) + (size_t)row0 * 512; ldy = 512; }
            else if (n == 1) { Y = P + (size_t)row0 * PW + C_LG; ldy = PW; }
            else { Y = P + (size_t)row0 * PW + C_DAQ; ldy = PW; }
            const int sc0 = sgcol(n, col0);
            gemm_core<8, 4>(Y, ldy, W + W_BR + ((size_t)n * 1024 + col0) * 512, 512, 512, au, sA);
            u32x4 sg[16];
            const bf16_t* ip = P + (size_t)(row0 + tid) * PW + sc0;
#pragma unroll
            for (int q = 0; q < 16; ++q) sg[q] = *(const u32x4*)(ip + q * 8);
#pragma unroll
            for (int mt = 0; mt < 8; ++mt)
#pragma unroll
                for (int nt = 0; nt < 4; ++nt) {
                    const unsigned g01 = sg[mt * 2 + (nt >> 1)][(nt & 1) * 2], g23 = sg[mt * 2 + (nt >> 1)][(nt & 1) * 2 + 1];
                    m[mt][nt][0] += lo16(g01) * au[mt][nt][0]; m[mt][nt][1] += hi16(g01) * au[mt][nt][1];
                    m[mt][nt][2] += lo16(g23) * au[mt][nt][2]; m[mt][nt][3] += hi16(g23) * au[mt][nt][3];
                }
        }
#pragma unroll
        for (int mt = 0; mt < 8; ++mt) {
            __builtin_amdgcn_sched_barrier(0);
            bf16_t* up = U + (size_t)(row0 + wr * 128 + mt * 16 + l15) * D + col0 + wc * 64 + quad * 4;
#pragma unroll
            for (int nt = 0; nt < 4; ++nt) { u32x2 o; o.x = pack2(m[mt][nt][0], m[mt][nt][1]); o.y = pack2(m[mt][nt][2], m[mt][nt][3]); *(u32x2*)(up + nt * 16) = o; }
        }
    }
}

DEV void phase_resid(const Params& p, int l, const bf16_t* A, int lda, const bf16_t* Wt, int K, int chunk, bool first, bool latent_only, unsigned char* smem) {
    bf16_t* sA = (bf16_t*)smem;
    const int tid = get_tid(), lane = tid & 63, wv = tid >> 6, wr = wv >> 1, wc = wv & 1, l15 = lane & 15, quad = lane >> 4;
    const int nrt = latent_only ? 128 : 136;
    for (TileIter ti(nrt, 8); ti.valid(); ti.next()) {
        int tm, tn; ti.get(tm, tn);
        const int row0 = rowtile0(tm, latent_only), col0 = tn * 128;
        f32x4 acc[8][4]; zero_acc(acc);
        gemm_core<8, 4>(A + (size_t)row0 * lda, lda, Wt + (size_t)col0 * K, K, K, acc, sA);
        const float* md = wsf(p, O_MOD) + ((size_t)l * 9 + modrow(row0)) * 6144 + chunk * D + col0 + wc * 64 + quad * 4;
        const float* hs0 = first ? xrow(p, row0) : hrow(p, row0);
        float* hd0 = hrow(p, row0);
        f32x4 mg[4];
#pragma unroll
        for (int nt = 0; nt < 4; ++nt) mg[nt] = *(const f32x4*)(md + nt * 16);
#pragma unroll
        for (int mt = 0; mt < 8; ++mt) {
            __builtin_amdgcn_sched_barrier(0);
            const size_t ro = (size_t)(wr * 128 + mt * 16 + l15) * D + col0 + wc * 64 + quad * 4;
#pragma unroll
            for (int nt = 0; nt < 4; ++nt) { const f32x4 h = *(const f32x4*)(hs0 + ro + nt * 16); *(f32x4*)(hd0 + ro + nt * 16) = h + mg[nt] * acc[mt][nt]; }
        }
    }
}
DEV void phase_gu(const Params& p, bool latent_only, unsigned char* smem) {
    bf16_t* sA = (bf16_t*)smem;
    const int tid = get_tid(), lane = tid & 63, wv = tid >> 6, wr = wv >> 1, wc = wv & 1, l15 = lane & 15, quad = lane >> 4;
    const bf16_t* U = wsb(p, O_U); const bf16_t* W = wsb(p, O_WT) + W_GU;
    bf16_t* P = wsb(p, O_P);
    const int nrt = latent_only ? 128 : 136;
    for (TileIter ti(nrt, 44); ti.valid(); ti.next()) {
        int tm, tn; ti.get(tm, tn);
        const int row0 = rowtile0(tm, latent_only);
        f32x4 acc[8][4]; zero_acc(acc);
        gemm_core<8, 4>(U + (size_t)row0 * D, D, W + (size_t)tn * 128 * D, D, D, acc, sA);
#pragma unroll
        for (int mt = 0; mt < 8; ++mt) {
            __builtin_amdgcn_sched_barrier(0);
            bf16_t* pp = P + (size_t)(row0 + wr * 128 + mt * 16 + l15) * PW + (tn * 4 + wc * 2) * 16 + quad * 4;
#pragma unroll
            for (int pr = 0; pr < 2; ++pr) {
                const f32x4 g = acc[mt][2 * pr], u = acc[mt][2 * pr + 1];
                u32x2 o; o.x = pack2(silu(g[0]) * u[0], silu(g[1]) * u[1]); o.y = pack2(silu(g[2]) * u[2], silu(g[3]) * u[3]);
                *(u32x2*)(pp + pr * 16) = o;
            }
        }
    }
}

DEV int chunk_of(int dir, int n) { return dir ? (n < 4 ? 3 - n : 71 - n) : n; }

typedef float f32x2 __attribute__((ext_vector_type(2)));
DEV void dn_solve(const float* __restrict__ Lt_s0, const bf16_t* __restrict__ colp, const float* __restrict__ mulp0, const float sg, bf16_t* __restrict__ outp) {
    int vz = 0; asm volatile("" : "+v"(vz));
    const float* __restrict__ Lt_s = Lt_s0 + vz; const float* __restrict__ mulp = mulp0 + vz;
    f32x2 X0, X1, X2, X3, X4, X5, X6, X7, X8, X9, X10, X11, X12, X13, X14, X15, X16, X17, X18, X19, X20, X21, X22, X23, X24, X25, X26, X27, X28, X29, X30, X31;
    f32x4 La0, La1, La2, La3, La4, La5, La6, La7, La8, La9, La10, La11, La12, La13, La14, La15, Lb0, Lb1, Lb2, Lb3, Lb4, Lb5, Lb6, Lb7, Lb8, Lb9, Lb10, Lb11, Lb12, Lb13, Lb14, Lb15;
    X0 = (f32x2){bf2f(colp[0]) * mulp[0], bf2f(colp[136]) * mulp[1]};
    X1 = (f32x2){bf2f(colp[272]) * mulp[2], bf2f(colp[408]) * mulp[3]};
    X2 = (f32x2){bf2f(colp[544]) * mulp[4], bf2f(colp[680]) * mulp[5]};
    X3 = (f32x2){bf2f(colp[816]) * mulp[6], bf2f(colp[952]) * mulp[7]};
    X4 = (f32x2){bf2f(colp[1088]) * mulp[8], bf2f(colp[1224]) * mulp[9]};
    X5 = (f32x2){bf2f(colp[1360]) * mulp[10], bf2f(colp[1496]) * mulp[11]};
    X6 = (f32x2){bf2f(colp[1632]) * mulp[12], bf2f(colp[1768]) * mulp[13]};
    X7 = (f32x2){bf2f(colp[1904]) * mulp[14], bf2f(colp[2040]) * mulp[15]};
    X8 = (f32x2){bf2f(colp[2176]) * mulp[16], bf2f(colp[2312]) * mulp[17]};
    X9 = (f32x2){bf2f(colp[2448]) * mulp[18], bf2f(colp[2584]) * mulp[19]};
    X10 = (f32x2){bf2f(colp[2720]) * mulp[20], bf2f(colp[2856]) * mulp[21]};
    X11 = (f32x2){bf2f(colp[2992]) * mulp[22], bf2f(colp[3128]) * mulp[23]};
    X12 = (f32x2){bf2f(colp[3264]) * mulp[24], bf2f(colp[3400]) * mulp[25]};
    X13 = (f32x2){bf2f(colp[3536]) * mulp[26], bf2f(colp[3672]) * mulp[27]};
    X14 = (f32x2){bf2f(colp[3808]) * mulp[28], bf2f(colp[3944]) * mulp[29]};
    X15 = (f32x2){bf2f(colp[4080]) * mulp[30], bf2f(colp[4216]) * mulp[31]};
    X16 = (f32x2){bf2f(colp[4352]) * mulp[32], bf2f(colp[4488]) * mulp[33]};
    X17 = (f32x2){bf2f(colp[4624]) * mulp[34], bf2f(colp[4760]) * mulp[35]};
    X18 = (f32x2){bf2f(colp[4896]) * mulp[36], bf2f(colp[5032]) * mulp[37]};
    X19 = (f32x2){bf2f(colp[5168]) * mulp[38], bf2f(colp[5304]) * mulp[39]};
    X20 = (f32x2){bf2f(colp[5440]) * mulp[40], bf2f(colp[5576]) * mulp[41]};
    X21 = (f32x2){bf2f(colp[5712]) * mulp[42], bf2f(colp[5848]) * mulp[43]};
    X22 = (f32x2){bf2f(colp[5984]) * mulp[44], bf2f(colp[6120]) * mulp[45]};
    X23 = (f32x2){bf2f(colp[6256]) * mulp[46], bf2f(colp[6392]) * mulp[47]};
    X24 = (f32x2){bf2f(colp[6528]) * mulp[48], bf2f(colp[6664]) * mulp[49]};
    X25 = (f32x2){bf2f(colp[6800]) * mulp[50], bf2f(colp[6936]) * mulp[51]};
    X26 = (f32x2){bf2f(colp[7072]) * mulp[52], bf2f(colp[7208]) * mulp[53]};
    X27 = (f32x2){bf2f(colp[7344]) * mulp[54], bf2f(colp[7480]) * mulp[55]};
    X28 = (f32x2){bf2f(colp[7616]) * mulp[56], bf2f(colp[7752]) * mulp[57]};
    X29 = (f32x2){bf2f(colp[7888]) * mulp[58], bf2f(colp[8024]) * mulp[59]};
    X30 = (f32x2){bf2f(colp[8160]) * mulp[60], bf2f(colp[8296]) * mulp[61]};
    X31 = (f32x2){bf2f(colp[8432]) * mulp[62], bf2f(colp[8568]) * mulp[63]};
    La0 = *(const f32x4*)(Lt_s + 0);
    La1 = *(const f32x4*)(Lt_s + 4);
    La2 = *(const f32x4*)(Lt_s + 8);
    La3 = *(const f32x4*)(Lt_s + 12);
    La4 = *(const f32x4*)(Lt_s + 16);
    La5 = *(const f32x4*)(Lt_s + 20);
    La6 = *(const f32x4*)(Lt_s + 24);
    La7 = *(const f32x4*)(Lt_s + 28);
    La8 = *(const f32x4*)(Lt_s + 32);
    La9 = *(const f32x4*)(Lt_s + 36);
    La10 = *(const f32x4*)(Lt_s + 40);
    La11 = *(const f32x4*)(Lt_s + 44);
    La12 = *(const f32x4*)(Lt_s + 48);
    La13 = *(const f32x4*)(Lt_s + 52);
    La14 = *(const f32x4*)(Lt_s + 56);
    La15 = *(const f32x4*)(Lt_s + 60);
    Lb0 = *(const f32x4*)(Lt_s + 68);
    Lb1 = *(const f32x4*)(Lt_s + 72);
    Lb2 = *(const f32x4*)(Lt_s + 76);
    Lb3 = *(const f32x4*)(Lt_s + 80);
    Lb4 = *(const f32x4*)(Lt_s + 84);
    Lb5 = *(const f32x4*)(Lt_s + 88);
    Lb6 = *(const f32x4*)(Lt_s + 92);
    Lb7 = *(const f32x4*)(Lt_s + 96);
    Lb8 = *(const f32x4*)(Lt_s + 100);
    Lb9 = *(const f32x4*)(Lt_s + 104);
    Lb10 = *(const f32x4*)(Lt_s + 108);
    Lb11 = *(const f32x4*)(Lt_s + 112);
    Lb12 = *(const f32x4*)(Lt_s + 116);
    Lb13 = *(const f32x4*)(Lt_s + 120);
    Lb14 = *(const f32x4*)(Lt_s + 124);
    Lb15 = *(const f32x4*)(Lt_s + 128);
    __builtin_amdgcn_sched_barrier(0);
    { const float xj = X0[0]; const f32x2 xj2 = (f32x2){xj, xj};
      X0 -= (f32x2){La0[0], La0[1]} * xj2;
      X1 -= (f32x2){La0[2], La0[3]} * xj2;
      X2 -= (f32x2){La1[0], La1[1]} * xj2;
      X3 -= (f32x2){La1[2], La1[3]} * xj2;
      X4 -= (f32x2){La2[0], La2[1]} * xj2;
      X5 -= (f32x2){La2[2], La2[3]} * xj2;
      X6 -= (f32x2){La3[0], La3[1]} * xj2;
      X7 -= (f32x2){La3[2], La3[3]} * xj2;
      X8 -= (f32x2){La4[0], La4[1]} * xj2;
      X9 -= (f32x2){La4[2], La4[3]} * xj2;
      X10 -= (f32x2){La5[0], La5[1]} * xj2;
      X11 -= (f32x2){La5[2], La5[3]} * xj2;
      X12 -= (f32x2){La6[0], La6[1]} * xj2;
      X13 -= (f32x2){La6[2], La6[3]} * xj2;
      X14 -= (f32x2){La7[0], La7[1]} * xj2;
      X15 -= (f32x2){La7[2], La7[3]} * xj2;
      X16 -= (f32x2){La8[0], La8[1]} * xj2;
      X17 -= (f32x2){La8[2], La8[3]} * xj2;
      X18 -= (f32x2){La9[0], La9[1]} * xj2;
      X19 -= (f32x2){La9[2], La9[3]} * xj2;
      X20 -= (f32x2){La10[0], La10[1]} * xj2;
      X21 -= (f32x2){La10[2], La10[3]} * xj2;
      X22 -= (f32x2){La11[0], La11[1]} * xj2;
      X23 -= (f32x2){La11[2], La11[3]} * xj2;
      X24 -= (f32x2){La12[0], La12[1]} * xj2;
      X25 -= (f32x2){La12[2], La12[3]} * xj2;
      X26 -= (f32x2){La13[0], La13[1]} * xj2;
      X27 -= (f32x2){La13[2], La13[3]} * xj2;
      X28 -= (f32x2){La14[0], La14[1]} * xj2;
      X29 -= (f32x2){La14[2], La14[3]} * xj2;
      X30 -= (f32x2){La15[0], La15[1]} * xj2;
      X31 -= (f32x2){La15[2], La15[3]} * xj2;
    }
    __builtin_amdgcn_sched_barrier(0);
    La0 = *(const f32x4*)(Lt_s + 136);
    La1 = *(const f32x4*)(Lt_s + 140);
    La2 = *(const f32x4*)(Lt_s + 144);
    La3 = *(const f32x4*)(Lt_s + 148);
    La4 = *(const f32x4*)(Lt_s + 152);
    La5 = *(const f32x4*)(Lt_s + 156);
    La6 = *(const f32x4*)(Lt_s + 160);
    La7 = *(const f32x4*)(Lt_s + 164);
    La8 = *(const f32x4*)(Lt_s + 168);
    La9 = *(const f32x4*)(Lt_s + 172);
    La10 = *(const f32x4*)(Lt_s + 176);
    La11 = *(const f32x4*)(Lt_s + 180);
    La12 = *(const f32x4*)(Lt_s + 184);
    La13 = *(const f32x4*)(Lt_s + 188);
    La14 = *(const f32x4*)(Lt_s + 192);
    La15 = *(const f32x4*)(Lt_s + 196);
    __builtin_amdgcn_sched_barrier(0);
    { const float xj = X0[1]; const f32x2 xj2 = (f32x2){xj, xj};
      X1 -= (f32x2){Lb0[2], Lb0[3]} * xj2;
      X2 -= (f32x2){Lb1[0], Lb1[1]} * xj2;
      X3 -= (f32x2){Lb1[2], Lb1[3]} * xj2;
      X4 -= (f32x2){Lb2[0], Lb2[1]} * xj2;
      X5 -= (f32x2){Lb2[2], Lb2[3]} * xj2;
      X6 -= (f32x2){Lb3[0], Lb3[1]} * xj2;
      X7 -= (f32x2){Lb3[2], Lb3[3]} * xj2;
      X8 -= (f32x2){Lb4[0], Lb4[1]} * xj2;
      X9 -= (f32x2){Lb4[2], Lb4[3]} * xj2;
      X10 -= (f32x2){Lb5[0], Lb5[1]} * xj2;
      X11 -= (f32x2){Lb5[2], Lb5[3]} * xj2;
      X12 -= (f32x2){Lb6[0], Lb6[1]} * xj2;
      X13 -= (f32x2){Lb6[2], Lb6[3]} * xj2;
      X14 -= (f32x2){Lb7[0], Lb7[1]} * xj2;
      X15 -= (f32x2){Lb7[2], Lb7[3]} * xj2;
      X16 -= (f32x2){Lb8[0], Lb8[1]} * xj2;
      X17 -= (f32x2){Lb8[2], Lb8[3]} * xj2;
      X18 -= (f32x2){Lb9[0], Lb9[1]} * xj2;
      X19 -= (f32x2){Lb9[2], Lb9[3]} * xj2;
      X20 -= (f32x2){Lb10[0], Lb10[1]} * xj2;
      X21 -= (f32x2){Lb10[2], Lb10[3]} * xj2;
      X22 -= (f32x2){Lb11[0], Lb11[1]} * xj2;
      X23 -= (f32x2){Lb11[2], Lb11[3]} * xj2;
      X24 -= (f32x2){Lb12[0], Lb12[1]} * xj2;
      X25 -= (f32x2){Lb12[2], Lb12[3]} * xj2;
      X26 -= (f32x2){Lb13[0], Lb13[1]} * xj2;
      X27 -= (f32x2){Lb13[2], Lb13[3]} * xj2;
      X28 -= (f32x2){Lb14[0], Lb14[1]} * xj2;
      X29 -= (f32x2){Lb14[2], Lb14[3]} * xj2;
      X30 -= (f32x2){Lb15[0], Lb15[1]} * xj2;
      X31 -= (f32x2){Lb15[2], Lb15[3]} * xj2;
    }
    __builtin_amdgcn_sched_barrier(0);
    Lb1 = *(const f32x4*)(Lt_s + 208);
    Lb2 = *(const f32x4*)(Lt_s + 212);
    Lb3 = *(const f32x4*)(Lt_s + 216);
    Lb4 = *(const f32x4*)(Lt_s + 220);
    Lb5 = *(const f32x4*)(Lt_s + 224);
    Lb6 = *(const f32x4*)(Lt_s + 228);
    Lb7 = *(const f32x4*)(Lt_s + 232);
    Lb8 = *(const f32x4*)(Lt_s + 236);
    Lb9 = *(const f32x4*)(Lt_s + 240);
    Lb10 = *(const f32x4*)(Lt_s + 244);
    Lb11 = *(const f32x4*)(Lt_s + 248);
    Lb12 = *(const f32x4*)(Lt_s + 252);
    Lb13 = *(const f32x4*)(Lt_s + 256);
    Lb14 = *(const f32x4*)(Lt_s + 260);
    Lb15 = *(const f32x4*)(Lt_s + 264);
    __builtin_amdgcn_sched_barrier(0);
    { const float xj = X1[0]; const f32x2 xj2 = (f32x2){xj, xj};
      X1 -= (f32x2){La0[2], La0[3]} * xj2;
      X2 -= (f32x2){La1[0], La1[1]} * xj2;
      X3 -= (f32x2){La1[2], La1[3]} * xj2;
      X4 -= (f32x2){La2[0], La2[1]} * xj2;
      X5 -= (f32x2){La2[2], La2[3]} * xj2;
      X6 -= (f32x2){La3[0], La3[1]} * xj2;
      X7 -= (f32x2){La3[2], La3[3]} * xj2;
      X8 -= (f32x2){La4[0], La4[1]} * xj2;
      X9 -= (f32x2){La4[2], La4[3]} * xj2;
      X10 -= (f32x2){La5[0], La5[1]} * xj2;
      X11 -= (f32x2){La5[2], La5[3]} * xj2;
      X12 -= (f32x2){La6[0], La6[1]} * xj2;
      X13 -= (f32x2){La6[2], La6[3]} * xj2;
      X14 -= (f32x2){La7[0], La7[1]} * xj2;
      X15 -= (f32x2){La7[2], La7[3]} * xj2;
      X16 -= (f32x2){La8[0], La8[1]} * xj2;
      X17 -= (f32x2){La8[2], La8[3]} * xj2;
      X18 -= (f32x2){La9[0], La9[1]} * xj2;
      X19 -= (f32x2){La9[2], La9[3]} * xj2;
      X20 -= (f32x2){La10[0], La10[1]} * xj2;
      X21 -= (f32x2){La10[2], La10[3]} * xj2;
      X22 -= (f32x2){La11[0], La11[1]} * xj2;
      X23 -= (f32x2){La11[2], La11[3]} * xj2;
      X24 -= (f32x2){La12[0], La12[1]} * xj2;
      X25 -= (f32x2){La12[2], La12[3]} * xj2;
      X26 -= (f32x2){La13[0], La13[1]} * xj2;
      X27 -= (f32x2){La13[2], La13[3]} * xj2;
      X28 -= (f32x2){La14[0], La14[1]} * xj2;
      X29 -= (f32x2){La14[2], La14[3]} * xj2;
      X30 -= (f32x2){La15[0], La15[1]} * xj2;
      X31 -= (f32x2){La15[2], La15[3]} * xj2;
    }
    __builtin_amdgcn_sched_barrier(0);
    La1 = *(const f32x4*)(Lt_s + 276);
    La2 = *(const f32x4*)(Lt_s + 280);
    La3 = *(const f32x4*)(Lt_s + 284);
    La4 = *(const f32x4*)(Lt_s + 288);
    La5 = *(const f32x4*)(Lt_s + 292);
    La6 = *(const f32x4*)(Lt_s + 296);
    La7 = *(const f32x4*)(Lt_s + 300);
    La8 = *(const f32x4*)(Lt_s + 304);
    La9 = *(const f32x4*)(Lt_s + 308);
    La10 = *(const f32x4*)(Lt_s + 312);
    La11 = *(const f32x4*)(Lt_s + 316);
    La12 = *(const f32x4*)(Lt_s + 320);
    La13 = *(const f32x4*)(Lt_s + 324);
    La14 = *(const f32x4*)(Lt_s + 328);
    La15 = *(const f32x4*)(Lt_s + 332);
    __builtin_amdgcn_sched_barrier(0);
    { const float xj = X1[1]; const f32x2 xj2 = (f32x2){xj, xj};
      X2 -= (f32x2){Lb1[0], Lb1[1]} * xj2;
      X3 -= (f32x2){Lb1[2], Lb1[3]} * xj2;
      X4 -= (f32x2){Lb2[0], Lb2[1]} * xj2;
      X5 -= (f32x2){Lb2[2], Lb2[3]} * xj2;
      X6 -= (f32x2){Lb3[0], Lb3[1]} * xj2;
      X7 -= (f32x2){Lb3[2], Lb3[3]} * xj2;
      X8 -= (f32x2){Lb4[0], Lb4[1]} * xj2;
      X9 -= (f32x2){Lb4[2], Lb4[3]} * xj2;
      X10 -= (f32x2){Lb5[0], Lb5[1]} * xj2;
      X11 -= (f32x2){Lb5[2], Lb5[3]} * xj2;
      X12 -= (f32x2){Lb6[0], Lb6[1]} * xj2;
      X13 -= (f32x2){Lb6[2], Lb6[3]} * xj2;
      X14 -= (f32x2){Lb7[0], Lb7[1]} * xj2;
      X15 -= (f32x2){Lb7[2], Lb7[3]} * xj2;
      X16 -= (f32x2){Lb8[0], Lb8[1]} * xj2;
      X17 -= (f32x2){Lb8[2], Lb8[3]} * xj2;
      X18 -= (f32x2){Lb9[0], Lb9[1]} * xj2;
      X19 -= (f32x2){Lb9[2], Lb9[3]} * xj2;
      X20 -= (f32x2){Lb10[0], Lb10[1]} * xj2;
      X21 -= (f32x2){Lb10[2], Lb10[3]} * xj2;
      X22 -= (f32x2){Lb11[0], Lb11[1]} * xj2;
      X23 -= (f32x2){Lb11[2], Lb11[3]} * xj2;
      X24 -= (f32x2){Lb12[0], Lb12[1]} * xj2;
      X25 -= (f32x2){Lb12[2], Lb12[3]} * xj2;
      X26 -= (f32x2){Lb13[0], Lb13[1]} * xj2;
      X27 -= (f32x2){Lb13[2], Lb13[3]} * xj2;
      X28 -= (f32x2){Lb14[0], Lb14[1]} * xj2;
      X29 -= (f32x2){Lb14[2], Lb14[3]} * xj2;
      X30 -= (f32x2){Lb15[0], Lb15[1]} * xj2;
      X31 -= (f32x2){Lb15[2], Lb15[3]} * xj2;
    }
    __builtin_amdgcn_sched_barrier(0);
    Lb1 = *(const f32x4*)(Lt_s + 344);
    Lb2 = *(const f32x4*)(Lt_s + 348);
    Lb3 = *(const f32x4*)(Lt_s + 352);
    Lb4 = *(const f32x4*)(Lt_s + 356);
    Lb5 = *(const f32x4*)(Lt_s + 360);
    Lb6 = *(const f32x4*)(Lt_s + 364);
    Lb7 = *(const f32x4*)(Lt_s + 368);
    Lb8 = *(const f32x4*)(Lt_s + 372);
    Lb9 = *(const f32x4*)(Lt_s + 376);
    Lb10 = *(const f32x4*)(Lt_s + 380);
    Lb11 = *(const f32x4*)(Lt_s + 384);
    Lb12 = *(const f32x4*)(Lt_s + 388);
    Lb13 = *(const f32x4*)(Lt_s + 392);
    Lb14 = *(const f32x4*)(Lt_s + 396);
    Lb15 = *(const f32x4*)(Lt_s + 400);
    __builtin_amdgcn_sched_barrier(0);
    { const float xj = X2[0]; const f32x2 xj2 = (f32x2){xj, xj};
      X2 -= (f32x2){La1[0], La1[1]} * xj2;
      X3 -= (f32x2){La1[2], La1[3]} * xj2;
      X4 -= (f32x2){La2[0], La2[1]} * xj2;
      X5 -= (f32x2){La2[2], La2[3]} * xj2;
      X6 -= (f32x2){La3[0], La3[1]} * xj2;
      X7 -= (f32x2){La3[2], La3[3]} * xj2;
      X8 -= (f32x2){La4[0], La4[1]} * xj2;
      X9 -= (f32x2){La4[2], La4[3]} * xj2;
      X10 -= (f32x2){La5[0], La5[1]} * xj2;
      X11 -= (f32x2){La5[2], La5[3]} * xj2;
      X12 -= (f32x2){La6[0], La6[1]} * xj2;
      X13 -= (f32x2){La6[2], La6[3]} * xj2;
      X14 -= (f32x2){La7[0], La7[1]} * xj2;
      X15 -= (f32x2){La7[2], La7[3]} * xj2;
      X16 -= (f32x2){La8[0], La8[1]} * xj2;
      X17 -= (f32x2){La8[2], La8[3]} * xj2;
      X18 -= (f32x2){La9[0], La9[1]} * xj2;
      X19 -= (f32x2){La9[2], La9[3]} * xj2;
      X20 -= (f32x2){La10[0], La10[1]} * xj2;
      X21 -= (f32x2){La10[2], La10[3]} * xj2;
      X22 -= (f32x2){La11[0], La11[1]} * xj2;
      X23 -= (f32x2){La11[2], La11[3]} * xj2;
      X24 -= (f32x2){La12[0], La12[1]} * xj2;
      X25 -= (f32x2){La12[2], La12[3]} * xj2;
      X26 -= (f32x2){La13[0], La13[1]} * xj2;
      X27 -= (f32x2){La13[2], La13[3]} * xj2;
      X28 -= (f32x2){La14[0], La14[1]} * xj2;
      X29 -= (f32x2){La14[2], La14[3]} * xj2;
      X30 -= (f32x2){La15[0], La15[1]} * xj2;
      X31 -= (f32x2){La15[2], La15[3]} * xj2;
    }
    __builtin_amdgcn_sched_barrier(0);
    La1 = *(const f32x4*)(Lt_s + 412);
    La2 = *(const f32x4*)(Lt_s + 416);
    La3 = *(const f32x4*)(Lt_s + 420);
    La4 = *(const f32x4*)(Lt_s + 424);
    La5 = *(const f32x4*)(Lt_s + 428);
    La6 = *(const f32x4*)(Lt_s + 432);
    La7 = *(const f32x4*)(Lt_s + 436);
    La8 = *(const f32x4*)(Lt_s + 440);
    La9 = *(const f32x4*)(Lt_s + 444);
    La10 = *(const f32x4*)(Lt_s + 448);
    La11 = *(const f32x4*)(Lt_s + 452);
    La12 = *(const f32x4*)(Lt_s + 456);
    La13 = *(const f32x4*)(Lt_s + 460);
    La14 = *(const f32x4*)(Lt_s + 464);
    La15 = *(const f32x4*)(Lt_s + 468);
    __builtin_amdgcn_sched_barrier(0);
    { const float xj = X2[1]; const f32x2 xj2 = (f32x2){xj, xj};
      X3 -= (f32x2){Lb1[2], Lb1[3]} * xj2;
      X4 -= (f32x2){Lb2[0], Lb2[1]} * xj2;
      X5 -= (f32x2){Lb2[2], Lb2[3]} * xj2;
      X6 -= (f32x2){Lb3[0], Lb3[1]} * xj2;
      X7 -= (f32x2){Lb3[2], Lb3[3]} * xj2;
      X8 -= (f32x2){Lb4[0], Lb4[1]} * xj2;
      X9 -= (f32x2){Lb4[2], Lb4[3]} * xj2;
      X10 -= (f32x2){Lb5[0], Lb5[1]} * xj2;
      X11 -= (f32x2){Lb5[2], Lb5[3]} * xj2;
      X12 -= (f32x2){Lb6[0], Lb6[1]} * xj2;
      X13 -= (f32x2){Lb6[2], Lb6[3]} * xj2;
      X14 -= (f32x2){Lb7[0], Lb7[1]} * xj2;
      X15 -= (f32x2){Lb7[2], Lb7[3]} * xj2;
      X16 -= (f32x2){Lb8[0], Lb8[1]} * xj2;
      X17 -= (f32x2){Lb8[2], Lb8[3]} * xj2;
      X18 -= (f32x2){Lb9[0], Lb9[1]} * xj2;
      X19 -= (f32x2){Lb9[2], Lb9[3]} * xj2;
      X20 -= (f32x2){Lb10[0], Lb10[1]} * xj2;
      X21 -= (f32x2){Lb10[2], Lb10[3]} * xj2;
      X22 -= (f32x2){Lb11[0], Lb11[1]} * xj2;
      X23 -= (f32x2){Lb11[2], Lb11[3]} * xj2;
      X24 -= (f32x2){Lb12[0], Lb12[1]} * xj2;
      X25 -= (f32x2){Lb12[2], Lb12[3]} * xj2;
      X26 -= (f32x2){Lb13[0], Lb13[1]} * xj2;
      X27 -= (f32x2){Lb13[2], Lb13[3]} * xj2;
      X28 -= (f32x2){Lb14[0], Lb14[1]} * xj2;
      X29 -= (f32x2){Lb14[2], Lb14[3]} * xj2;
      X30 -= (f32x2){Lb15[0], Lb15[1]} * xj2;
      X31 -= (f32x2){Lb15[2], Lb15[3]} * xj2;
    }
    __builtin_amdgcn_sched_barrier(0);
    Lb2 = *(const f32x4*)(Lt_s + 484);
    Lb3 = *(const f32x4*)(Lt_s + 488);
    Lb4 = *(const f32x4*)(Lt_s + 492);
    Lb5 = *(const f32x4*)(Lt_s + 496);
    Lb6 = *(const f32x4*)(Lt_s + 500);
    Lb7 = *(const f32x4*)(Lt_s + 504);
    Lb8 = *(const f32x4*)(Lt_s + 508);
    Lb9 = *(const f32x4*)(Lt_s + 512);
    Lb10 = *(const f32x4*)(Lt_s + 516);
    Lb11 = *(const f32x4*)(Lt_s + 520);
    Lb12 = *(const f32x4*)(Lt_s + 524);
    Lb13 = *(const f32x4*)(Lt_s + 528);
    Lb14 = *(const f32x4*)(Lt_s + 532);
    Lb15 = *(const f32x4*)(Lt_s + 536);
    __builtin_amdgcn_sched_barrier(0);
    { const float xj = X3[0]; const f32x2 xj2 = (f32x2){xj, xj};
      X3 -= (f32x2){La1[2], La1[3]} * xj2;
      X4 -= (f32x2){La2[0], La2[1]} * xj2;
      X5 -= (f32x2){La2[2], La2[3]} * xj2;
      X6 -= (f32x2){La3[0], La3[1]} * xj2;
      X7 -= (f32x2){La3[2], La3[3]} * xj2;
      X8 -= (f32x2){La4[0], La4[1]} * xj2;
      X9 -= (f32x2){La4[2], La4[3]} * xj2;
      X10 -= (f32x2){La5[0], La5[1]} * xj2;
      X11 -= (f32x2){La5[2], La5[3]} * xj2;
      X12 -= (f32x2){La6[0], La6[1]} * xj2;
      X13 -= (f32x2){La6[2], La6[3]} * xj2;
      X14 -= (f32x2){La7[0], La7[1]} * xj2;
      X15 -= (f32x2){La7[2], La7[3]} * xj2;
      X16 -= (f32x2){La8[0], La8[1]} * xj2;
      X17 -= (f32x2){La8[2], La8[3]} * xj2;
      X18 -= (f32x2){La9[0], La9[1]} * xj2;
      X19 -= (f32x2){La9[2], La9[3]} * xj2;
      X20 -= (f32x2){La10[0], La10[1]} * xj2;
      X21 -= (f32x2){La10[2], La10[3]} * xj2;
      X22 -= (f32x2){La11[0], La11[1]} * xj2;
      X23 -= (f32x2){La11[2], La11[3]} * xj2;
      X24 -= (f32x2){La12[0], La12[1]} * xj2;
      X25 -= (f32x2){La12[2], La12[3]} * xj2;
      X26 -= (f32x2){La13[0], La13[1]} * xj2;
      X27 -= (f32x2){La13[2], La13[3]} * xj2;
      X28 -= (f32x2){La14[0], La14[1]} * xj2;
      X29 -= (f32x2){La14[2], La14[3]} * xj2;
      X30 -= (f32x2){La15[0], La15[1]} * xj2;
      X31 -= (f32x2){La15[2], La15[3]} * xj2;
    }
    __builtin_amdgcn_sched_barrier(0);
    La2 = *(const f32x4*)(Lt_s + 552);
    La3 = *(const f32x4*)(Lt_s + 556);
    La4 = *(const f32x4*)(Lt_s + 560);
    La5 = *(const f32x4*)(Lt_s + 564);
    La6 = *(const f32x4*)(Lt_s + 568);
    La7 = *(const f32x4*)(Lt_s + 572);
    La8 = *(const f32x4*)(Lt_s + 576);
    La9 = *(const f32x4*)(Lt_s + 580);
    La10 = *(const f32x4*)(Lt_s + 584);
    La11 = *(const f32x4*)(Lt_s + 588);
    La12 = *(const f32x4*)(Lt_s + 592);
    La13 = *(const f32x4*)(Lt_s + 596);
    La14 = *(const f32x4*)(Lt_s + 600);
    La15 = *(const f32x4*)(Lt_s + 604);
    __builtin_amdgcn_sched_barrier(0);
    { const float xj = X3[1]; const f32x2 xj2 = (f32x2){xj, xj};
      X4 -= (f32x2){Lb2[0], Lb2[1]} * xj2;
      X5 -= (f32x2){Lb2[2], Lb2[3]} * xj2;
      X6 -= (f32x2){Lb3[0], Lb3[1]} * xj2;
      X7 -= (f32x2){Lb3[2], Lb3[3]} * xj2;
      X8 -= (f32x2){Lb4[0], Lb4[1]} * xj2;
      X9 -= (f32x2){Lb4[2], Lb4[3]} * xj2;
      X10 -= (f32x2){Lb5[0], Lb5[1]} * xj2;
      X11 -= (f32x2){Lb5[2], Lb5[3]} * xj2;
      X12 -= (f32x2){Lb6[0], Lb6[1]} * xj2;
      X13 -= (f32x2){Lb6[2], Lb6[3]} * xj2;
      X14 -= (f32x2){Lb7[0], Lb7[1]} * xj2;
      X15 -= (f32x2){Lb7[2], Lb7[3]} * xj2;
      X16 -= (f32x2){Lb8[0], Lb8[1]} * xj2;
      X17 -= (f32x2){Lb8[2], Lb8[3]} * xj2;
      X18 -= (f32x2){Lb9[0], Lb9[1]} * xj2;
      X19 -= (f32x2){Lb9[2], Lb9[3]} * xj2;
      X20 -= (f32x2){Lb10[0], Lb10[1]} * xj2;
      X21 -= (f32x2){Lb10[2], Lb10[3]} * xj2;
      X22 -= (f32x2){Lb11[0], Lb11[1]} * xj2;
      X23 -= (f32x2){Lb11[2], Lb11[3]} * xj2;
      X24 -= (f32x2){Lb12[0], Lb12[1]} * xj2;
      X25 -= (f32x2){Lb12[2], Lb12[3]} * xj2;
      X26 -= (f32x2){Lb13[0], Lb13[1]} * xj2;
      X27 -= (f32x2){Lb13[2], Lb13[3]} * xj2;
      X28 -= (f32x2){Lb14[0], Lb14[1]} * xj2;
      X29 -= (f32x2){Lb14[2], Lb14[3]} * xj2;
      X30 -= (f32x2){Lb15[0], Lb15[1]} * xj2;
      X31 -= (f32x2){Lb15[2], Lb15[3]} * xj2;
    }
    __builtin_amdgcn_sched_barrier(0);
    Lb2 = *(const f32x4*)(Lt_s + 620);
    Lb3 = *(const f32x4*)(Lt_s + 624);
    Lb4 = *(const f32x4*)(Lt_s + 628);
    Lb5 = *(const f32x4*)(Lt_s + 632);
    Lb6 = *(const f32x4*)(Lt_s + 636);
    Lb7 = *(const f32x4*)(Lt_s + 640);
    Lb8 = *(const f32x4*)(Lt_s + 644);
    Lb9 = *(const f32x4*)(Lt_s + 648);
    Lb10 = *(const f32x4*)(Lt_s + 652);
    Lb11 = *(const f32x4*)(Lt_s + 656);
    Lb12 = *(const f32x4*)(Lt_s + 660);
    Lb13 = *(const f32x4*)(Lt_s + 664);
    Lb14 = *(const f32x4*)(Lt_s + 668);
    Lb15 = *(const f32x4*)(Lt_s + 672);
    __builtin_amdgcn_sched_barrier(0);
    { const float xj = X4[0]; const f32x2 xj2 = (f32x2){xj, xj};
      X4 -= (f32x2){La2[0], La2[1]} * xj2;
      X5 -= (f32x2){La2[2], La2[3]} * xj2;
      X6 -= (f32x2){La3[0], La3[1]} * xj2;
      X7 -= (f32x2){La3[2], La3[3]} * xj2;
      X8 -= (f32x2){La4[0], La4[1]} * xj2;
      X9 -= (f32x2){La4[2], La4[3]} * xj2;
      X10 -= (f32x2){La5[0], La5[1]} * xj2;
      X11 -= (f32x2){La5[2], La5[3]} * xj2;
      X12 -= (f32x2){La6[0], La6[1]} * xj2;
      X13 -= (f32x2){La6[2], La6[3]} * xj2;
      X14 -= (f32x2){La7[0], La7[1]} * xj2;
      X15 -= (f32x2){La7[2], La7[3]} * xj2;
      X16 -= (f32x2){La8[0], La8[1]} * xj2;
      X17 -= (f32x2){La8[2], La8[3]} * xj2;
      X18 -= (f32x2){La9[0], La9[1]} * xj2;
      X19 -= (f32x2){La9[2], La9[3]} * xj2;
      X20 -= (f32x2){La10[0], La10[1]} * xj2;
      X21 -= (f32x2){La10[2], La10[3]} * xj2;
      X22 -= (f32x2){La11[0], La11[1]} * xj2;
      X23 -= (f32x2){La11[2], La11[3]} * xj2;
      X24 -= (f32x2){La12[0], La12[1]} * xj2;
      X25 -= (f32x2){La12[2], La12[3]} * xj2;
      X26 -= (f32x2){La13[0], La13[1]} * xj2;
      X27 -= (f32x2){La13[2], La13[3]} * xj2;
      X28 -= (f32x2){La14[0], La14[1]} * xj2;
      X29 -= (f32x2){La14[2], La14[3]} * xj2;
      X30 -= (f32x2){La15[0], La15[1]} * xj2;
      X31 -= (f32x2){La15[2], La15[3]} * xj2;
    }
    __builtin_amdgcn_sched_barrier(0);
    La2 = *(const f32x4*)(Lt_s + 688);
    La3 = *(const f32x4*)(Lt_s + 692);
    La4 = *(const f32x4*)(Lt_s + 696);
    La5 = *(const f32x4*)(Lt_s + 700);
    La6 = *(const f32x4*)(Lt_s + 704);
    La7 = *(const f32x4*)(Lt_s + 708);
    La8 = *(const f32x4*)(Lt_s + 712);
    La9 = *(const f32x4*)(Lt_s + 716);
    La10 = *(const f32x4*)(Lt_s + 720);
    La11 = *(const f32x4*)(Lt_s + 724);
    La12 = *(const f32x4*)(Lt_s + 728);
    La13 = *(const f32x4*)(Lt_s + 732);
    La14 = *(const f32x4*)(Lt_s + 736);
    La15 = *(const f32x4*)(Lt_s + 740);
    __builtin_amdgcn_sched_barrier(0);
    { const float xj = X4[1]; const f32x2 xj2 = (f32x2){xj, xj};
      X5 -= (f32x2){Lb2[2], Lb2[3]} * xj2;
      X6 -= (f32x2){Lb3[0], Lb3[1]} * xj2;
      X7 -= (f32x2){Lb3[2], Lb3[3]} * xj2;
      X8 -= (f32x2){Lb4[0], Lb4[1]} * xj2;
      X9 -= (f32x2){Lb4[2], Lb4[3]} * xj2;
      X10 -= (f32x2){Lb5[0], Lb5[1]} * xj2;
      X11 -= (f32x2){Lb5[2], Lb5[3]} * xj2;
      X12 -= (f32x2){Lb6[0], Lb6[1]} * xj2;
      X13 -= (f32x2){Lb6[2], Lb6[3]} * xj2;
      X14 -= (f32x2){Lb7[0], Lb7[1]} * xj2;
      X15 -= (f32x2){Lb7[2], Lb7[3]} * xj2;
      X16 -= (f32x2){Lb8[0], Lb8[1]} * xj2;
      X17 -= (f32x2){Lb8[2], Lb8[3]} * xj2;
      X18 -= (f32x2){Lb9[0], Lb9[1]} * xj2;
      X19 -= (f32x2){Lb9[2], Lb9[3]} * xj2;
      X20 -= (f32x2){Lb10[0], Lb10[1]} * xj2;
      X21 -= (f32x2){Lb10[2], Lb10[3]} * xj2;
      X22 -= (f32x2){Lb11[0], Lb11[1]} * xj2;
      X23 -= (f32x2){Lb11[2], Lb11[3]} * xj2;
      X24 -= (f32x2){Lb12[0], Lb12[1]} * xj2;
      X25 -= (f32x2){Lb12[2], Lb12[3]} * xj2;
      X26 -= (f32x2){Lb13[0], Lb13[1]} * xj2;
      X27 -= (f32x2){Lb13[2], Lb13[3]} * xj2;
      X28 -= (f32x2){Lb14[0], Lb14[1]} * xj2;
      X29 -= (f32x2){Lb14[2], Lb14[3]} * xj2;
      X30 -= (f32x2){Lb15[0], Lb15[1]} * xj2;
      X31 -= (f32x2){Lb15[2], Lb15[3]} * xj2;
    }
    __builtin_amdgcn_sched_barrier(0);
    Lb3 = *(const f32x4*)(Lt_s + 760);
    Lb4 = *(const f32x4*)(Lt_s + 764);
    Lb5 = *(const f32x4*)(Lt_s + 768);
    Lb6 = *(const f32x4*)(Lt_s + 772);
    Lb7 = *(const f32x4*)(Lt_s + 776);
    Lb8 = *(const f32x4*)(Lt_s + 780);
    Lb9 = *(const f32x4*)(Lt_s + 784);
    Lb10 = *(const f32x4*)(Lt_s + 788);
    Lb11 = *(const f32x4*)(Lt_s + 792);
    Lb12 = *(const f32x4*)(Lt_s + 796);
    Lb13 = *(const f32x4*)(Lt_s + 800);
    Lb14 = *(const f32x4*)(Lt_s + 804);
    Lb15 = *(const f32x4*)(Lt_s + 808);
    __builtin_amdgcn_sched_barrier(0);
    { const float xj = X5[0]; const f32x2 xj2 = (f32x2){xj, xj};
      X5 -= (f32x2){La2[2], La2[3]} * xj2;
      X6 -= (f32x2){La3[0], La3[1]} * xj2;
      X7 -= (f32x2){La3[2], La3[3]} * xj2;
      X8 -= (f32x2){La4[0], La4[1]} * xj2;
      X9 -= (f32x2){La4[2], La4[3]} * xj2;
      X10 -= (f32x2){La5[0], La5[1]} * xj2;
      X11 -= (f32x2){La5[2], La5[3]} * xj2;
      X12 -= (f32x2){La6[0], La6[1]} * xj2;
      X13 -= (f32x2){La6[2], La6[3]} * xj2;
      X14 -= (f32x2){La7[0], La7[1]} * xj2;
      X15 -= (f32x2){La7[2], La7[3]} * xj2;
      X16 -= (f32x2){La8[0], La8[1]} * xj2;
      X17 -= (f32x2){La8[2], La8[3]} * xj2;
      X18 -= (f32x2){La9[0], La9[1]} * xj2;
      X19 -= (f32x2){La9[2], La9[3]} * xj2;
      X20 -= (f32x2){La10[0], La10[1]} * xj2;
      X21 -= (f32x2){La10[2], La10[3]} * xj2;
      X22 -= (f32x2){La11[0], La11[1]} * xj2;
      X23 -= (f32x2){La11[2], La11[3]} * xj2;
      X24 -= (f32x2){La12[0], La12[1]} * xj2;
      X25 -= (f32x2){La12[2], La12[3]} * xj2;
      X26 -= (f32x2){La13[0], La13[1]} * xj2;
      X27 -= (f32x2){La13[2], La13[3]} * xj2;
      X28 -= (f32x2){La14[0], La14[1]} * xj2;
      X29 -= (f32x2){La14[2], La14[3]} * xj2;
      X30 -= (f32x2){La15[0], La15[1]} * xj2;
      X31 -= (f32x2){La15[2], La15[3]} * xj2;
    }
    __builtin_amdgcn_sched_barrier(0);
    La3 = *(const f32x4*)(Lt_s + 828);
    La4 = *(const f32x4*)(Lt_s + 832);
    La5 = *(const f32x4*)(Lt_s + 836);
    La6 = *(const f32x4*)(Lt_s + 840);
    La7 = *(const f32x4*)(Lt_s + 844);
    La8 = *(const f32x4*)(Lt_s + 848);
    La9 = *(const f32x4*)(Lt_s + 852);
    La10 = *(const f32x4*)(Lt_s + 856);
    La11 = *(const f32x4*)(Lt_s + 860);
    La12 = *(const f32x4*)(Lt_s + 864);
    La13 = *(const f32x4*)(Lt_s + 868);
    La14 = *(const f32x4*)(Lt_s + 872);
    La15 = *(const f32x4*)(Lt_s + 876);
    __builtin_amdgcn_sched_barrier(0);
    { const float xj = X5[1]; const f32x2 xj2 = (f32x2){xj, xj};
      X6 -= (f32x2){Lb3[0], Lb3[1]} * xj2;
      X7 -= (f32x2){Lb3[2], Lb3[3]} * xj2;
      X8 -= (f32x2){Lb4[0], Lb4[1]} * xj2;
      X9 -= (f32x2){Lb4[2], Lb4[3]} * xj2;
      X10 -= (f32x2){Lb5[0], Lb5[1]} * xj2;
      X11 -= (f32x2){Lb5[2], Lb5[3]} * xj2;
      X12 -= (f32x2){Lb6[0], Lb6[1]} * xj2;
      X13 -= (f32x2){Lb6[2], Lb6[3]} * xj2;
      X14 -= (f32x2){Lb7[0], Lb7[1]} * xj2;
      X15 -= (f32x2){Lb7[2], Lb7[3]} * xj2;
      X16 -= (f32x2){Lb8[0], Lb8[1]} * xj2;
      X17 -= (f32x2){Lb8[2], Lb8[3]} * xj2;
      X18 -= (f32x2){Lb9[0], Lb9[1]} * xj2;
      X19 -= (f32x2){Lb9[2], Lb9[3]} * xj2;
      X20 -= (f32x2){Lb10[0], Lb10[1]} * xj2;
      X21 -= (f32x2){Lb10[2], Lb10[3]} * xj2;
      X22 -= (f32x2){Lb11[0], Lb11[1]} * xj2;
      X23 -= (f32x2){Lb11[2], Lb11[3]} * xj2;
      X24 -= (f32x2){Lb12[0], Lb12[1]} * xj2;
      X25 -= (f32x2){Lb12[2], Lb12[3]} * xj2;
      X26 -= (f32x2){Lb13[0], Lb13[1]} * xj2;
      X27 -= (f32x2){Lb13[2], Lb13[3]} * xj2;
      X28 -= (f32x2){Lb14[0], Lb14[1]} * xj2;
      X29 -= (f32x2){Lb14[2], Lb14[3]} * xj2;
      X30 -= (f32x2){Lb15[0], Lb15[1]} * xj2;
      X31 -= (f32x2){Lb15[2], Lb15[3]} * xj2;
    }
    __builtin_amdgcn_sched_barrier(0);
    Lb3 = *(const f32x4*)(Lt_s + 896);
    Lb4 = *(const f32x4*)(Lt_s + 900);
    Lb5 = *(const f32x4*)(Lt_s + 904);
    Lb6 = *(const f32x4*)(Lt_s + 908);
    Lb7 = *(const f32x4*)(Lt_s + 912);
    Lb8 = *(const f32x4*)(Lt_s + 916);
    Lb9 = *(const f32x4*)(Lt_s + 920);
    Lb10 = *(const f32x4*)(Lt_s + 924);
    Lb11 = *(const f32x4*)(Lt_s + 928);
    Lb12 = *(const f32x4*)(Lt_s + 932);
    Lb13 = *(const f32x4*)(Lt_s + 936);
    Lb14 = *(const f32x4*)(Lt_s + 940);
    Lb15 = *(const f32x4*)(Lt_s + 944);
    __builtin_amdgcn_sched_barrier(0);
    { const float xj = X6[0]; const f32x2 xj2 = (f32x2){xj, xj};
      X6 -= (f32x2){La3[0], La3[1]} * xj2;
      X7 -= (f32x2){La3[2], La3[3]} * xj2;
      X8 -= (f32x2){La4[0], La4[1]} * xj2;
      X9 -= (f32x2){La4[2], La4[3]} * xj2;
      X10 -= (f32x2){La5[0], La5[1]} * xj2;
      X11 -= (f32x2){La5[2], La5[3]} * xj2;
      X12 -= (f32x2){La6[0], La6[1]} * xj2;
      X13 -= (f32x2){La6[2], La6[3]} * xj2;
      X14 -= (f32x2){La7[0], La7[1]} * xj2;
      X15 -= (f32x2){La7[2], La7[3]} * xj2;
      X16 -= (f32x2){La8[0], La8[1]} * xj2;
      X17 -= (f32x2){La8[2], La8[3]} * xj2;
      X18 -= (f32x2){La9[0], La9[1]} * xj2;
      X19 -= (f32x2){La9[2], La9[3]} * xj2;
      X20 -= (f32x2){La10[0], La10[1]} * xj2;
      X21 -= (f32x2){La10[2], La10[3]} * xj2;
      X22 -= (f32x2){La11[0], La11[1]} * xj2;
      X23 -= (f32x2){La11[2], La11[3]} * xj2;
      X24 -= (f32x2){La12[0], La12[1]} * xj2;
      X25 -= (f32x2){La12[2], La12[3]} * xj2;
      X26 -= (f32x2){La13[0], La13[1]} * xj2;
      X27 -= (f32x2){La13[2], La13[3]} * xj2;
      X28 -= (f32x2){La14[0], La14[1]} * xj2;
      X29 -= (f32x2){La14[2], La14[3]} * xj2;
      X30 -= (f32x2){La15[0], La15[1]} * xj2;
      X31 -= (f32x2){La15[2], La15[3]} * xj2;
    }
    __builtin_amdgcn_sched_barrier(0);
    La3 = *(const f32x4*)(Lt_s + 964);
    La4 = *(const f32x4*)(Lt_s + 968);
    La5 = *(const f32x4*)(Lt_s + 972);
    La6 = *(const f32x4*)(Lt_s + 976);
    La7 = *(const f32x4*)(Lt_s + 980);
    La8 = *(const f32x4*)(Lt_s + 984);
    La9 = *(const f32x4*)(Lt_s + 988);
    La10 = *(const f32x4*)(Lt_s + 992);
    La11 = *(const f32x4*)(Lt_s + 996);
    La12 = *(const f32x4*)(Lt_s + 1000);
    La13 = *(const f32x4*)(Lt_s + 1004);
    La14 = *(const f32x4*)(Lt_s + 1008);
    La15 = *(const f32x4*)(Lt_s + 1012);
    __builtin_amdgcn_sched_barrier(0);
    { const float xj = X6[1]; const f32x2 xj2 = (f32x2){xj, xj};
      X7 -= (f32x2){Lb3[2], Lb3[3]} * xj2;
      X8 -= (f32x2){Lb4[0], Lb4[1]} * xj2;
      X9 -= (f32x2){Lb4[2], Lb4[3]} * xj2;
      X10 -= (f32x2){Lb5[0], Lb5[1]} * xj2;
      X11 -= (f32x2){Lb5[2], Lb5[3]} * xj2;
      X12 -= (f32x2){Lb6[0], Lb6[1]} * xj2;
      X13 -= (f32x2){Lb6[2], Lb6[3]} * xj2;
      X14 -= (f32x2){Lb7[0], Lb7[1]} * xj2;
      X15 -= (f32x2){Lb7[2], Lb7[3]} * xj2;
      X16 -= (f32x2){Lb8[0], Lb8[1]} * xj2;
      X17 -= (f32x2){Lb8[2], Lb8[3]} * xj2;
      X18 -= (f32x2){Lb9[0], Lb9[1]} * xj2;
      X19 -= (f32x2){Lb9[2], Lb9[3]} * xj2;
      X20 -= (f32x2){Lb10[0], Lb10[1]} * xj2;
      X21 -= (f32x2){Lb10[2], Lb10[3]} * xj2;
      X22 -= (f32x2){Lb11[0], Lb11[1]} * xj2;
      X23 -= (f32x2){Lb11[2], Lb11[3]} * xj2;
      X24 -= (f32x2){Lb12[0], Lb12[1]} * xj2;
      X25 -= (f32x2){Lb12[2], Lb12[3]} * xj2;
      X26 -= (f32x2){Lb13[0], Lb13[1]} * xj2;
      X27 -= (f32x2){Lb13[2], Lb13[3]} * xj2;
      X28 -= (f32x2){Lb14[0], Lb14[1]} * xj2;
      X29 -= (f32x2){Lb14[2], Lb14[3]} * xj2;
      X30 -= (f32x2){Lb15[0], Lb15[1]} * xj2;
      X31 -= (f32x2){Lb15[2], Lb15[3]} * xj2;
    }
    __builtin_amdgcn_sched_barrier(0);
    Lb4 = *(const f32x4*)(Lt_s + 1036);
    Lb5 = *(const f32x4*)(Lt_s + 1040);
    Lb6 = *(const f32x4*)(Lt_s + 1044);
    Lb7 = *(const f32x4*)(Lt_s + 1048);
    Lb8 = *(const f32x4*)(Lt_s + 1052);
    Lb9 = *(const f32x4*)(Lt_s + 1056);
    Lb10 = *(const f32x4*)(Lt_s + 1060);
    Lb11 = *(const f32x4*)(Lt_s + 1064);
    Lb12 = *(const f32x4*)(Lt_s + 1068);
    Lb13 = *(const f32x4*)(Lt_s + 1072);
    Lb14 = *(const f32x4*)(Lt_s + 1076);
    Lb15 = *(const f32x4*)(Lt_s + 1080);
    __builtin_amdgcn_sched_barrier(0);
    { const float xj = X7[0]; const f32x2 xj2 = (f32x2){xj, xj};
      X7 -= (f32x2){La3[2], La3[3]} * xj2;
      X8 -= (f32x2){La4[0], La4[1]} * xj2;
      X9 -= (f32x2){La4[2], La4[3]} * xj2;
      X10 -= (f32x2){La5[0], La5[1]} * xj2;
      X11 -= (f32x2){La5[2], La5[3]} * xj2;
      X12 -= (f32x2){La6[0], La6[1]} * xj2;
      X13 -= (f32x2){La6[2], La6[3]} * xj2;
      X14 -= (f32x2){La7[0], La7[1]} * xj2;
      X15 -= (f32x2){La7[2], La7[3]} * xj2;
      X16 -= (f32x2){La8[0], La8[1]} * xj2;
      X17 -= (f32x2){La8[2], La8[3]} * xj2;
      X18 -= (f32x2){La9[0], La9[1]} * xj2;
      X19 -= (f32x2){La9[2], La9[3]} * xj2;
      X20 -= (f32x2){La10[0], La10[1]} * xj2;
      X21 -= (f32x2){La10[2], La10[3]} * xj2;
      X22 -= (f32x2){La11[0], La11[1]} * xj2;
      X23 -= (f32x2){La11[2], La11[3]} * xj2;
      X24 -= (f32x2){La12[0], La12[1]} * xj2;
      X25 -= (f32x2){La12[2], La12[3]} * xj2;
      X26 -= (f32x2){La13[0], La13[1]} * xj2;
      X27 -= (f32x2){La13[2], La13[3]} * xj2;
      X28 -= (f32x2){La14[0], La14[1]} * xj2;
      X29 -= (f32x2){La14[2], La14[3]} * xj2;
      X30 -= (f32x2){La15[0], La15[1]} * xj2;
      X31 -= (f32x2){La15[2], La15[3]} * xj2;
    }
    __builtin_amdgcn_sched_barrier(0);
    La4 = *(const f32x4*)(Lt_s + 1104);
    La5 = *(const f32x4*)(Lt_s + 1108);
    La6 = *(const f32x4*)(Lt_s + 1112);
    La7 = *(const f32x4*)(Lt_s + 1116);
    La8 = *(const f32x4*)(Lt_s + 1120);
    La9 = *(const f32x4*)(Lt_s + 1124);
    La10 = *(const f32x4*)(Lt_s + 1128);
    La11 = *(const f32x4*)(Lt_s + 1132);
    La12 = *(const f32x4*)(Lt_s + 1136);
    La13 = *(const f32x4*)(Lt_s + 1140);
    La14 = *(const f32x4*)(Lt_s + 1144);
    La15 = *(const f32x4*)(Lt_s + 1148);
    __builtin_amdgcn_sched_barrier(0);
    { const float xj = X7[1]; const f32x2 xj2 = (f32x2){xj, xj};
      X8 -= (f32x2){Lb4[0], Lb4[1]} * xj2;
      X9 -= (f32x2){Lb4[2], Lb4[3]} * xj2;
      X10 -= (f32x2){Lb5[0], Lb5[1]} * xj2;
      X11 -= (f32x2){Lb5[2], Lb5[3]} * xj2;
      X12 -= (f32x2){Lb6[0], Lb6[1]} * xj2;
      X13 -= (f32x2){Lb6[2], Lb6[3]} * xj2;
      X14 -= (f32x2){Lb7[0], Lb7[1]} * xj2;
      X15 -= (f32x2){Lb7[2], Lb7[3]} * xj2;
      X16 -= (f32x2){Lb8[0], Lb8[1]} * xj2;
      X17 -= (f32x2){Lb8[2], Lb8[3]} * xj2;
      X18 -= (f32x2){Lb9[0], Lb9[1]} * xj2;
      X19 -= (f32x2){Lb9[2], Lb9[3]} * xj2;
      X20 -= (f32x2){Lb10[0], Lb10[1]} * xj2;
      X21 -= (f32x2){Lb10[2], Lb10[3]} * xj2;
      X22 -= (f32x2){Lb11[0], Lb11[1]} * xj2;
      X23 -= (f32x2){Lb11[2], Lb11[3]} * xj2;
      X24 -= (f32x2){Lb12[0], Lb12[1]} * xj2;
      X25 -= (f32x2){Lb12[2], Lb12[3]} * xj2;
      X26 -= (f32x2){Lb13[0], Lb13[1]} * xj2;
      X27 -= (f32x2){Lb13[2], Lb13[3]} * xj2;
      X28 -= (f32x2){Lb14[0], Lb14[1]} * xj2;
      X29 -= (f32x2){Lb14[2], Lb14[3]} * xj2;
      X30 -= (f32x2){Lb15[0], Lb15[1]} * xj2;
      X31 -= (f32x2){Lb15[2], Lb15[3]} * xj2;
    }
    __builtin_amdgcn_sched_barrier(0);
    Lb4 = *(const f32x4*)(Lt_s + 1172);
    Lb5 = *(const f32x4*)(Lt_s + 1176);
    Lb6 = *(const f32x4*)(Lt_s + 1180);
    Lb7 = *(const f32x4*)(Lt_s + 1184);
    Lb8 = *(const f32x4*)(Lt_s + 1188);
    Lb9 = *(const f32x4*)(Lt_s + 1192);
    Lb10 = *(const f32x4*)(Lt_s + 1196);
    Lb11 = *(const f32x4*)(Lt_s + 1200);
    Lb12 = *(const f32x4*)(Lt_s + 1204);
    Lb13 = *(const f32x4*)(Lt_s + 1208);
    Lb14 = *(const f32x4*)(Lt_s + 1212);
    Lb15 = *(const f32x4*)(Lt_s + 1216);
    __builtin_amdgcn_sched_barrier(0);
    { const float xj = X8[0]; const f32x2 xj2 = (f32x2){xj, xj};
      X8 -= (f32x2){La4[0], La4[1]} * xj2;
      X9 -= (f32x2){La4[2], La4[3]} * xj2;
      X10 -= (f32x2){La5[0], La5[1]} * xj2;
      X11 -= (f32x2){La5[2], La5[3]} * xj2;
      X12 -= (f32x2){La6[0], La6[1]} * xj2;
      X13 -= (f32x2){La6[2], La6[3]} * xj2;
      X14 -= (f32x2){La7[0], La7[1]} * xj2;
      X15 -= (f32x2){La7[2], La7[3]} * xj2;
      X16 -= (f32x2){La8[0], La8[1]} * xj2;
      X17 -= (f32x2){La8[2], La8[3]} * xj2;
      X18 -= (f32x2){La9[0], La9[1]} * xj2;
      X19 -= (f32x2){La9[2], La9[3]} * xj2;
      X20 -= (f32x2){La10[0], La10[1]} * xj2;
      X21 -= (f32x2){La10[2], La10[3]} * xj2;
      X22 -= (f32x2){La11[0], La11[1]} * xj2;
      X23 -= (f32x2){La11[2], La11[3]} * xj2;
      X24 -= (f32x2){La12[0], La12[1]} * xj2;
      X25 -= (f32x2){La12[2], La12[3]} * xj2;
      X26 -= (f32x2){La13[0], La13[1]} * xj2;
      X27 -= (f32x2){La13[2], La13[3]} * xj2;
      X28 -= (f32x2){La14[0], La14[1]} * xj2;
      X29 -= (f32x2){La14[2], La14[3]} * xj2;
      X30 -= (f32x2){La15[0], La15[1]} * xj2;
      X31 -= (f32x2){La15[2], La15[3]} * xj2;
    }
    __builtin_amdgcn_sched_barrier(0);
    La4 = *(const f32x4*)(Lt_s + 1240);
    La5 = *(const f32x4*)(Lt_s + 1244);
    La6 = *(const f32x4*)(Lt_s + 1248);
    La7 = *(const f32x4*)(Lt_s + 1252);
    La8 = *(const f32x4*)(Lt_s + 1256);
    La9 = *(const f32x4*)(Lt_s + 1260);
    La10 = *(const f32x4*)(Lt_s + 1264);
    La11 = *(const f32x4*)(Lt_s + 1268);
    La12 = *(const f32x4*)(Lt_s + 1272);
    La13 = *(const f32x4*)(Lt_s + 1276);
    La14 = *(const f32x4*)(Lt_s + 1280);
    La15 = *(const f32x4*)(Lt_s + 1284);
    __builtin_amdgcn_sched_barrier(0);
    { const float xj = X8[1]; const f32x2 xj2 = (f32x2){xj, xj};
      X9 -= (f32x2){Lb4[2], Lb4[3]} * xj2;
      X10 -= (f32x2){Lb5[0], Lb5[1]} * xj2;
      X11 -= (f32x2){Lb5[2], Lb5[3]} * xj2;
      X12 -= (f32x2){Lb6[0], Lb6[1]} * xj2;
      X13 -= (f32x2){Lb6[2], Lb6[3]} * xj2;
      X14 -= (f32x2){Lb7[0], Lb7[1]} * xj2;
      X15 -= (f32x2){Lb7[2], Lb7[3]} * xj2;
      X16 -= (f32x2){Lb8[0], Lb8[1]} * xj2;
      X17 -= (f32x2){Lb8[2], Lb8[3]} * xj2;
      X18 -= (f32x2){Lb9[0], Lb9[1]} * xj2;
      X19 -= (f32x2){Lb9[2], Lb9[3]} * xj2;
      X20 -= (f32x2){Lb10[0], Lb10[1]} * xj2;
      X21 -= (f32x2){Lb10[2], Lb10[3]} * xj2;
      X22 -= (f32x2){Lb11[0], Lb11[1]} * xj2;
      X23 -= (f32x2){Lb11[2], Lb11[3]} * xj2;
      X24 -= (f32x2){Lb12[0], Lb12[1]} * xj2;
      X25 -= (f32x2){Lb12[2], Lb12[3]} * xj2;
      X26 -= (f32x2){Lb13[0], Lb13[1]} * xj2;
      X27 -= (f32x2){Lb13[2], Lb13[3]} * xj2;
      X28 -= (f32x2){Lb14[0], Lb14[1]} * xj2;
      X29 -= (f32x2){Lb14[2], Lb14[3]} * xj2;
      X30 -= (f32x2){Lb15[0], Lb15[1]} * xj2;
      X31 -= (f32x2){Lb15[2], Lb15[3]} * xj2;
    }
    __builtin_amdgcn_sched_barrier(0);
    Lb5 = *(const f32x4*)(Lt_s + 1312);
    Lb6 = *(const f32x4*)(Lt_s + 1316);
    Lb7 = *(const f32x4*)(Lt_s + 1320);
    Lb8 = *(const f32x4*)(Lt_s + 1324);
    Lb9 = *(const f32x4*)(Lt_s + 1328);
    Lb10 = *(const f32x4*)(Lt_s + 1332);
    Lb11 = *(const f32x4*)(Lt_s + 1336);
    Lb12 = *(const f32x4*)(Lt_s + 1340);
    Lb13 = *(const f32x4*)(Lt_s + 1344);
    Lb14 = *(const f32x4*)(Lt_s + 1348);
    Lb15 = *(const f32x4*)(Lt_s + 1352);
    __builtin_amdgcn_sched_barrier(0);
    { const float xj = X9[0]; const f32x2 xj2 = (f32x2){xj, xj};
      X9 -= (f32x2){La4[2], La4[3]} * xj2;
      X10 -= (f32x2){La5[0], La5[1]} * xj2;
      X11 -= (f32x2){La5[2], La5[3]} * xj2;
      X12 -= (f32x2){La6[0], La6[1]} * xj2;
      X13 -= (f32x2){La6[2], La6[3]} * xj2;
      X14 -= (f32x2){La7[0], La7[1]} * xj2;
      X15 -= (f32x2){La7[2], La7[3]} * xj2;
      X16 -= (f32x2){La8[0], La8[1]} * xj2;
      X17 -= (f32x2){La8[2], La8[3]} * xj2;
      X18 -= (f32x2){La9[0], La9[1]} * xj2;
      X19 -= (f32x2){La9[2], La9[3]} * xj2;
      X20 -= (f32x2){La10[0], La10[1]} * xj2;
      X21 -= (f32x2){La10[2], La10[3]} * xj2;
      X22 -= (f32x2){La11[0], La11[1]} * xj2;
      X23 -= (f32x2){La11[2], La11[3]} * xj2;
      X24 -= (f32x2){La12[0], La12[1]} * xj2;
      X25 -= (f32x2){La12[2], La12[3]} * xj2;
      X26 -= (f32x2){La13[0], La13[1]} * xj2;
      X27 -= (f32x2){La13[2], La13[3]} * xj2;
      X28 -= (f32x2){La14[0], La14[1]} * xj2;
      X29 -= (f32x2){La14[2], La14[3]} * xj2;
      X30 -= (f32x2){La15[0], La15[1]} * xj2;
      X31 -= (f32x2){La15[2], La15[3]} * xj2;
    }
    __builtin_amdgcn_sched_barrier(0);
    La5 = *(const f32x4*)(Lt_s + 1380);
    La6 = *(const f32x4*)(Lt_s + 1384);
    La7 = *(const f32x4*)(Lt_s + 1388);
    La8 = *(const f32x4*)(Lt_s + 1392);
    La9 = *(const f32x4*)(Lt_s + 1396);
    La10 = *(const f32x4*)(Lt_s + 1400);
    La11 = *(const f32x4*)(Lt_s + 1404);
    La12 = *(const f32x4*)(Lt_s + 1408);
    La13 = *(const f32x4*)(Lt_s + 1412);
    La14 = *(const f32x4*)(Lt_s + 1416);
    La15 = *(const f32x4*)(Lt_s + 1420);
    __builtin_amdgcn_sched_barrier(0);
    { const float xj = X9[1]; const f32x2 xj2 = (f32x2){xj, xj};
      X10 -= (f32x2){Lb5[0], Lb5[1]} * xj2;
      X11 -= (f32x2){Lb5[2], Lb5[3]} * xj2;
      X12 -= (f32x2){Lb6[0], Lb6[1]} * xj2;
      X13 -= (f32x2){Lb6[2], Lb6[3]} * xj2;
      X14 -= (f32x2){Lb7[0], Lb7[1]} * xj2;
      X15 -= (f32x2){Lb7[2], Lb7[3]} * xj2;
      X16 -= (f32x2){Lb8[0], Lb8[1]} * xj2;
      X17 -= (f32x2){Lb8[2], Lb8[3]} * xj2;
      X18 -= (f32x2){Lb9[0], Lb9[1]} * xj2;
      X19 -= (f32x2){Lb9[2], Lb9[3]} * xj2;
      X20 -= (f32x2){Lb10[0], Lb10[1]} * xj2;
      X21 -= (f32x2){Lb10[2], Lb10[3]} * xj2;
      X22 -= (f32x2){Lb11[0], Lb11[1]} * xj2;
      X23 -= (f32x2){Lb11[2], Lb11[3]} * xj2;
      X24 -= (f32x2){Lb12[0], Lb12[1]} * xj2;
      X25 -= (f32x2){Lb12[2], Lb12[3]} * xj2;
      X26 -= (f32x2){Lb13[0], Lb13[1]} * xj2;
      X27 -= (f32x2){Lb13[2], Lb13[3]} * xj2;
      X28 -= (f32x2){Lb14[0], Lb14[1]} * xj2;
      X29 -= (f32x2){Lb14[2], Lb14[3]} * xj2;
      X30 -= (f32x2){Lb15[0], Lb15[1]} * xj2;
      X31 -= (f32x2){Lb15[2], Lb15[3]} * xj2;
    }
    __builtin_amdgcn_sched_barrier(0);
    Lb5 = *(const f32x4*)(Lt_s + 1448);
    Lb6 = *(const f32x4*)(Lt_s + 1452);
    Lb7 = *(const f32x4*)(Lt_s + 1456);
    Lb8 = *(const f32x4*)(Lt_s + 1460);
    Lb9 = *(const f32x4*)(Lt_s + 1464);
    Lb10 = *(const f32x4*)(Lt_s + 1468);
    Lb11 = *(const f32x4*)(Lt_s + 1472);
    Lb12 = *(const f32x4*)(Lt_s + 1476);
    Lb13 = *(const f32x4*)(Lt_s + 1480);
    Lb14 = *(const f32x4*)(Lt_s + 1484);
    Lb15 = *(const f32x4*)(Lt_s + 1488);
    __builtin_amdgcn_sched_barrier(0);
    { const float xj = X10[0]; const f32x2 xj2 = (f32x2){xj, xj};
      X10 -= (f32x2){La5[0], La5[1]} * xj2;
      X11 -= (f32x2){La5[2], La5[3]} * xj2;
      X12 -= (f32x2){La6[0], La6[1]} * xj2;
      X13 -= (f32x2){La6[2], La6[3]} * xj2;
      X14 -= (f32x2){La7[0], La7[1]} * xj2;
      X15 -= (f32x2){La7[2], La7[3]} * xj2;
      X16 -= (f32x2){La8[0], La8[1]} * xj2;
      X17 -= (f32x2){La8[2], La8[3]} * xj2;
      X18 -= (f32x2){La9[0], La9[1]} * xj2;
      X19 -= (f32x2){La9[2], La9[3]} * xj2;
      X20 -= (f32x2){La10[0], La10[1]} * xj2;
      X21 -= (f32x2){La10[2], La10[3]} * xj2;
      X22 -= (f32x2){La11[0], La11[1]} * xj2;
      X23 -= (f32x2){La11[2], La11[3]} * xj2;
      X24 -= (f32x2){La12[0], La12[1]} * xj2;
      X25 -= (f32x2){La12[2], La12[3]} * xj2;
      X26 -= (f32x2){La13[0], La13[1]} * xj2;
      X27 -= (f32x2){La13[2], La13[3]} * xj2;
      X28 -= (f32x2){La14[0], La14[1]} * xj2;
      X29 -= (f32x2){La14[2], La14[3]} * xj2;
      X30 -= (f32x2){La15[0], La15[1]} * xj2;
      X31 -= (f32x2){La15[2], La15[3]} * xj2;
    }
    __builtin_amdgcn_sched_barrier(0);
    La5 = *(const f32x4*)(Lt_s + 1516);
    La6 = *(const f32x4*)(Lt_s + 1520);
    La7 = *(const f32x4*)(Lt_s + 1524);
    La8 = *(const f32x4*)(Lt_s + 1528);
    La9 = *(const f32x4*)(Lt_s + 1532);
    La10 = *(const f32x4*)(Lt_s + 1536);
    La11 = *(const f32x4*)(Lt_s + 1540);
    La12 = *(const f32x4*)(Lt_s + 1544);
    La13 = *(const f32x4*)(Lt_s + 1548);
    La14 = *(const f32x4*)(Lt_s + 1552);
    La15 = *(const f32x4*)(Lt_s + 1556);
    __builtin_amdgcn_sched_barrier(0);
    { const float xj = X10[1]; const f32x2 xj2 = (f32x2){xj, xj};
      X11 -= (f32x2){Lb5[2], Lb5[3]} * xj2;
      X12 -= (f32x2){Lb6[0], Lb6[1]} * xj2;
      X13 -= (f32x2){Lb6[2], Lb6[3]} * xj2;
      X14 -= (f32x2){Lb7[0], Lb7[1]} * xj2;
      X15 -= (f32x2){Lb7[2], Lb7[3]} * xj2;
      X16 -= (f32x2){Lb8[0], Lb8[1]} * xj2;
      X17 -= (f32x2){Lb8[2], Lb8[3]} * xj2;
      X18 -= (f32x2){Lb9[0], Lb9[1]} * xj2;
      X19 -= (f32x2){Lb9[2], Lb9[3]} * xj2;
      X20 -= (f32x2){Lb10[0], Lb10[1]} * xj2;
      X21 -= (f32x2){Lb10[2], Lb10[3]} * xj2;
      X22 -= (f32x2){Lb11[0], Lb11[1]} * xj2;
      X23 -= (f32x2){Lb11[2], Lb11[3]} * xj2;
      X24 -= (f32x2){Lb12[0], Lb12[1]} * xj2;
      X25 -= (f32x2){Lb12[2], Lb12[3]} * xj2;
      X26 -= (f32x2){Lb13[0], Lb13[1]} * xj2;
      X27 -= (f32x2){Lb13[2], Lb13[3]} * xj2;
      X28 -= (f32x2){Lb14[0], Lb14[1]} * xj2;
      X29 -= (f32x2){Lb14[2], Lb14[3]} * xj2;
      X30 -= (f32x2){Lb15[0], Lb15[1]} * xj2;
      X31 -= (f32x2){Lb15[2], Lb15[3]} * xj2;
    }
    __builtin_amdgcn_sched_barrier(0);
    Lb6 = *(const f32x4*)(Lt_s + 1588);
    Lb7 = *(const f32x4*)(Lt_s + 1592);
    Lb8 = *(const f32x4*)(Lt_s + 1596);
    Lb9 = *(const f32x4*)(Lt_s + 1600);
    Lb10 = *(const f32x4*)(Lt_s + 1604);
    Lb11 = *(const f32x4*)(Lt_s + 1608);
    Lb12 = *(const f32x4*)(Lt_s + 1612);
    Lb13 = *(const f32x4*)(Lt_s + 1616);
    Lb14 = *(const f32x4*)(Lt_s + 1620);
    Lb15 = *(const f32x4*)(Lt_s + 1624);
    __builtin_amdgcn_sched_barrier(0);
    { const float xj = X11[0]; const f32x2 xj2 = (f32x2){xj, xj};
      X11 -= (f32x2){La5[2], La5[3]} * xj2;
      X12 -= (f32x2){La6[0], La6[1]} * xj2;
      X13 -= (f32x2){La6[2], La6[3]} * xj2;
      X14 -= (f32x2){La7[0], La7[1]} * xj2;
      X15 -= (f32x2){La7[2], La7[3]} * xj2;
      X16 -= (f32x2){La8[0], La8[1]} * xj2;
      X17 -= (f32x2){La8[2], La8[3]} * xj2;
      X18 -= (f32x2){La9[0], La9[1]} * xj2;
      X19 -= (f32x2){La9[2], La9[3]} * xj2;
      X20 -= (f32x2){La10[0], La10[1]} * xj2;
      X21 -= (f32x2){La10[2], La10[3]} * xj2;
      X22 -= (f32x2){La11[0], La11[1]} * xj2;
      X23 -= (f32x2){La11[2], La11[3]} * xj2;
      X24 -= (f32x2){La12[0], La12[1]} * xj2;
      X25 -= (f32x2){La12[2], La12[3]} * xj2;
      X26 -= (f32x2){La13[0], La13[1]} * xj2;
      X27 -= (f32x2){La13[2], La13[3]} * xj2;
      X28 -= (f32x2){La14[0], La14[1]} * xj2;
      X29 -= (f32x2){La14[2], La14[3]} * xj2;
      X30 -= (f32x2){La15[0], La15[1]} * xj2;
      X31 -= (f32x2){La15[2], La15[3]} * xj2;
    }
    __builtin_amdgcn_sched_barrier(0);
    La6 = *(const f32x4*)(Lt_s + 1656);
    La7 = *(const f32x4*)(Lt_s + 1660);
    La8 = *(const f32x4*)(Lt_s + 1664);
    La9 = *(const f32x4*)(Lt_s + 1668);
    La10 = *(const f32x4*)(Lt_s + 1672);
    La11 = *(const f32x4*)(Lt_s + 1676);
    La12 = *(const f32x4*)(Lt_s + 1680);
    La13 = *(const f32x4*)(Lt_s + 1684);
    La14 = *(const f32x4*)(Lt_s + 1688);
    La15 = *(const f32x4*)(Lt_s + 1692);
    __builtin_amdgcn_sched_barrier(0);
    { const float xj = X11[1]; const f32x2 xj2 = (f32x2){xj, xj};
      X12 -= (f32x2){Lb6[0], Lb6[1]} * xj2;
      X13 -= (f32x2){Lb6[2], Lb6[3]} * xj2;
      X14 -= (f32x2){Lb7[0], Lb7[1]} * xj2;
      X15 -= (f32x2){Lb7[2], Lb7[3]} * xj2;
      X16 -= (f32x2){Lb8[0], Lb8[1]} * xj2;
      X17 -= (f32x2){Lb8[2], Lb8[3]} * xj2;
      X18 -= (f32x2){Lb9[0], Lb9[1]} * xj2;
      X19 -= (f32x2){Lb9[2], Lb9[3]} * xj2;
      X20 -= (f32x2){Lb10[0], Lb10[1]} * xj2;
      X21 -= (f32x2){Lb10[2], Lb10[3]} * xj2;
      X22 -= (f32x2){Lb11[0], Lb11[1]} * xj2;
      X23 -= (f32x2){Lb11[2], Lb11[3]} * xj2;
      X24 -= (f32x2){Lb12[0], Lb12[1]} * xj2;
      X25 -= (f32x2){Lb12[2], Lb12[3]} * xj2;
      X26 -= (f32x2){Lb13[0], Lb13[1]} * xj2;
      X27 -= (f32x2){Lb13[2], Lb13[3]} * xj2;
      X28 -= (f32x2){Lb14[0], Lb14[1]} * xj2;
      X29 -= (f32x2){Lb14[2], Lb14[3]} * xj2;
      X30 -= (f32x2){Lb15[0], Lb15[1]} * xj2;
      X31 -= (f32x2){Lb15[2], Lb15[3]} * xj2;
    }
    __builtin_amdgcn_sched_barrier(0);
    Lb6 = *(const f32x4*)(Lt_s + 1724);
    Lb7 = *(const f32x4*)(Lt_s + 1728);
    Lb8 = *(const f32x4*)(Lt_s + 1732);
    Lb9 = *(const f32x4*)(Lt_s + 1736);
    Lb10 = *(const f32x4*)(Lt_s + 1740);
    Lb11 = *(const f32x4*)(Lt_s + 1744);
    Lb12 = *(const f32x4*)(Lt_s + 1748);
    Lb13 = *(const f32x4*)(Lt_s + 1752);
    Lb14 = *(const f32x4*)(Lt_s + 1756);
    Lb15 = *(const f32x4*)(Lt_s + 1760);
    __builtin_amdgcn_sched_barrier(0);
    { const float xj = X12[0]; const f32x2 xj2 = (f32x2){xj, xj};
      X12 -= (f32x2){La6[0], La6[1]} * xj2;
      X13 -= (f32x2){La6[2], La6[3]} * xj2;
      X14 -= (f32x2){La7[0], La7[1]} * xj2;
      X15 -= (f32x2){La7[2], La7[3]} * xj2;
      X16 -= (f32x2){La8[0], La8[1]} * xj2;
      X17 -= (f32x2){La8[2], La8[3]} * xj2;
      X18 -= (f32x2){La9[0], La9[1]} * xj2;
      X19 -= (f32x2){La9[2], La9[3]} * xj2;
      X20 -= (f32x2){La10[0], La10[1]} * xj2;
      X21 -= (f32x2){La10[2], La10[3]} * xj2;
      X22 -= (f32x2){La11[0], La11[1]} * xj2;
      X23 -= (f32x2){La11[2], La11[3]} * xj2;
      X24 -= (f32x2){La12[0], La12[1]} * xj2;
      X25 -= (f32x2){La12[2], La12[3]} * xj2;
      X26 -= (f32x2){La13[0], La13[1]} * xj2;
      X27 -= (f32x2){La13[2], La13[3]} * xj2;
      X28 -= (f32x2){La14[0], La14[1]} * xj2;
      X29 -= (f32x2){La14[2], La14[3]} * xj2;
      X30 -= (f32x2){La15[0], La15[1]} * xj2;
      X31 -= (f32x2){La15[2], La15[3]} * xj2;
    }
    __builtin_amdgcn_sched_barrier(0);
    La6 = *(const f32x4*)(Lt_s + 1792);
    La7 = *(const f32x4*)(Lt_s + 1796);
    La8 = *(const f32x4*)(Lt_s + 1800);
    La9 = *(const f32x4*)(Lt_s + 1804);
    La10 = *(const f32x4*)(Lt_s + 1808);
    La11 = *(const f32x4*)(Lt_s + 1812);
    La12 = *(const f32x4*)(Lt_s + 1816);
    La13 = *(const f32x4*)(Lt_s + 1820);
    La14 = *(const f32x4*)(Lt_s + 1824);
    La15 = *(const f32x4*)(Lt_s + 1828);
    __builtin_amdgcn_sched_barrier(0);
    { const float xj = X12[1]; const f32x2 xj2 = (f32x2){xj, xj};
      X13 -= (f32x2){Lb6[2], Lb6[3]} * xj2;
      X14 -= (f32x2){Lb7[0], Lb7[1]} * xj2;
      X15 -= (f32x2){Lb7[2], Lb7[3]} * xj2;
      X16 -= (f32x2){Lb8[0], Lb8[1]} * xj2;
      X17 -= (f32x2){Lb8[2], Lb8[3]} * xj2;
      X18 -= (f32x2){Lb9[0], Lb9[1]} * xj2;
      X19 -= (f32x2){Lb9[2], Lb9[3]} * xj2;
      X20 -= (f32x2){Lb10[0], Lb10[1]} * xj2;
      X21 -= (f32x2){Lb10[2], Lb10[3]} * xj2;
      X22 -= (f32x2){Lb11[0], Lb11[1]} * xj2;
      X23 -= (f32x2){Lb11[2], Lb11[3]} * xj2;
      X24 -= (f32x2){Lb12[0], Lb12[1]} * xj2;
      X25 -= (f32x2){Lb12[2], Lb12[3]} * xj2;
      X26 -= (f32x2){Lb13[0], Lb13[1]} * xj2;
      X27 -= (f32x2){Lb13[2], Lb13[3]} * xj2;
      X28 -= (f32x2){Lb14[0], Lb14[1]} * xj2;
      X29 -= (f32x2){Lb14[2], Lb14[3]} * xj2;
      X30 -= (f32x2){Lb15[0], Lb15[1]} * xj2;
      X31 -= (f32x2){Lb15[2], Lb15[3]} * xj2;
    }
    __builtin_amdgcn_sched_barrier(0);
    Lb7 = *(const f32x4*)(Lt_s + 1864);
    Lb8 = *(const f32x4*)(Lt_s + 1868);
    Lb9 = *(const f32x4*)(Lt_s + 1872);
    Lb10 = *(const f32x4*)(Lt_s + 1876);
    Lb11 = *(const f32x4*)(Lt_s + 1880);
    Lb12 = *(const f32x4*)(Lt_s + 1884);
    Lb13 = *(const f32x4*)(Lt_s + 1888);
    Lb14 = *(const f32x4*)(Lt_s + 1892);
    Lb15 = *(const f32x4*)(Lt_s + 1896);
    __builtin_amdgcn_sched_barrier(0);
    { const float xj = X13[0]; const f32x2 xj2 = (f32x2){xj, xj};
      X13 -= (f32x2){La6[2], La6[3]} * xj2;
      X14 -= (f32x2){La7[0], La7[1]} * xj2;
      X15 -= (f32x2){La7[2], La7[3]} * xj2;
      X16 -= (f32x2){La8[0], La8[1]} * xj2;
      X17 -= (f32x2){La8[2], La8[3]} * xj2;
      X18 -= (f32x2){La9[0], La9[1]} * xj2;
      X19 -= (f32x2){La9[2], La9[3]} * xj2;
      X20 -= (f32x2){La10[0], La10[1]} * xj2;
      X21 -= (f32x2){La10[2], La10[3]} * xj2;
      X22 -= (f32x2){La11[0], La11[1]} * xj2;
      X23 -= (f32x2){La11[2], La11[3]} * xj2;
      X24 -= (f32x2){La12[0], La12[1]} * xj2;
      X25 -= (f32x2){La12[2], La12[3]} * xj2;
      X26 -= (f32x2){La13[0], La13[1]} * xj2;
      X27 -= (f32x2){La13[2], La13[3]} * xj2;
      X28 -= (f32x2){La14[0], La14[1]} * xj2;
      X29 -= (f32x2){La14[2], La14[3]} * xj2;
      X30 -= (f32x2){La15[0], La15[1]} * xj2;
      X31 -= (f32x2){La15[2], La15[3]} * xj2;
    }
    __builtin_amdgcn_sched_barrier(0);
    La7 = *(const f32x4*)(Lt_s + 1932);
    La8 = *(const f32x4*)(Lt_s + 1936);
    La9 = *(const f32x4*)(Lt_s + 1940);
    La10 = *(const f32x4*)(Lt_s + 1944);
    La11 = *(const f32x4*)(Lt_s + 1948);
    La12 = *(const f32x4*)(Lt_s + 1952);
    La13 = *(const f32x4*)(Lt_s + 1956);
    La14 = *(const f32x4*)(Lt_s + 1960);
    La15 = *(const f32x4*)(Lt_s + 1964);
    __builtin_amdgcn_sched_barrier(0);
    { const float xj = X13[1]; const f32x2 xj2 = (f32x2){xj, xj};
      X14 -= (f32x2){Lb7[0], Lb7[1]} * xj2;
      X15 -= (f32x2){Lb7[2], Lb7[3]} * xj2;
      X16 -= (f32x2){Lb8[0], Lb8[1]} * xj2;
      X17 -= (f32x2){Lb8[2], Lb8[3]} * xj2;
      X18 -= (f32x2){Lb9[0], Lb9[1]} * xj2;
      X19 -= (f32x2){Lb9[2], Lb9[3]} * xj2;
      X20 -= (f32x2){Lb10[0], Lb10[1]} * xj2;
      X21 -= (f32x2){Lb10[2], Lb10[3]} * xj2;
      X22 -= (f32x2){Lb11[0], Lb11[1]} * xj2;
      X23 -= (f32x2){Lb11[2], Lb11[3]} * xj2;
      X24 -= (f32x2){Lb12[0], Lb12[1]} * xj2;
      X25 -= (f32x2){Lb12[2], Lb12[3]} * xj2;
      X26 -= (f32x2){Lb13[0], Lb13[1]} * xj2;
      X27 -= (f32x2){Lb13[2], Lb13[3]} * xj2;
      X28 -= (f32x2){Lb14[0], Lb14[1]} * xj2;
      X29 -= (f32x2){Lb14[2], Lb14[3]} * xj2;
      X30 -= (f32x2){Lb15[0], Lb15[1]} * xj2;
      X31 -= (f32x2){Lb15[2], Lb15[3]} * xj2;
    }
    __builtin_amdgcn_sched_barrier(0);
    Lb7 = *(const f32x4*)(Lt_s + 2000);
    Lb8 = *(const f32x4*)(Lt_s + 2004);
    Lb9 = *(const f32x4*)(Lt_s + 2008);
    Lb10 = *(const f32x4*)(Lt_s + 2012);
    Lb11 = *(const f32x4*)(Lt_s + 2016);
    Lb12 = *(const f32x4*)(Lt_s + 2020);
    Lb13 = *(const f32x4*)(Lt_s + 2024);
    Lb14 = *(const f32x4*)(Lt_s + 2028);
    Lb15 = *(const f32x4*)(Lt_s + 2032);
    __builtin_amdgcn_sched_barrier(0);
    { const float xj = X14[0]; const f32x2 xj2 = (f32x2){xj, xj};
      X14 -= (f32x2){La7[0], La7[1]} * xj2;
      X15 -= (f32x2){La7[2], La7[3]} * xj2;
      X16 -= (f32x2){La8[0], La8[1]} * xj2;
      X17 -= (f32x2){La8[2], La8[3]} * xj2;
      X18 -= (f32x2){La9[0], La9[1]} * xj2;
      X19 -= (f32x2){La9[2], La9[3]} * xj2;
      X20 -= (f32x2){La10[0], La10[1]} * xj2;
      X21 -= (f32x2){La10[2], La10[3]} * xj2;
      X22 -= (f32x2){La11[0], La11[1]} * xj2;
      X23 -= (f32x2){La11[2], La11[3]} * xj2;
      X24 -= (f32x2){La12[0], La12[1]} * xj2;
      X25 -= (f32x2){La12[2], La12[3]} * xj2;
      X26 -= (f32x2){La13[0], La13[1]} * xj2;
      X27 -= (f32x2){La13[2], La13[3]} * xj2;
      X28 -= (f32x2){La14[0], La14[1]} * xj2;
      X29 -= (f32x2){La14[2], La14[3]} * xj2;
      X30 -= (f32x2){La15[0], La15[1]} * xj2;
      X31 -= (f32x2){La15[2], La15[3]} * xj2;
    }
    __builtin_amdgcn_sched_barrier(0);
    La7 = *(const f32x4*)(Lt_s + 2068);
    La8 = *(const f32x4*)(Lt_s + 2072);
    La9 = *(const f32x4*)(Lt_s + 2076);
    La10 = *(const f32x4*)(Lt_s + 2080);
    La11 = *(const f32x4*)(Lt_s + 2084);
    La12 = *(const f32x4*)(Lt_s + 2088);
    La13 = *(const f32x4*)(Lt_s + 2092);
    La14 = *(const f32x4*)(Lt_s + 2096);
    La15 = *(const f32x4*)(Lt_s + 2100);
    __builtin_amdgcn_sched_barrier(0);
    { const float xj = X14[1]; const f32x2 xj2 = (f32x2){xj, xj};
      X15 -= (f32x2){Lb7[2], Lb7[3]} * xj2;
      X16 -= (f32x2){Lb8[0], Lb8[1]} * xj2;
      X17 -= (f32x2){Lb8[2], Lb8[3]} * xj2;
      X18 -= (f32x2){Lb9[0], Lb9[1]} * xj2;
      X19 -= (f32x2){Lb9[2], Lb9[3]} * xj2;
      X20 -= (f32x2){Lb10[0], Lb10[1]} * xj2;
      X21 -= (f32x2){Lb10[2], Lb10[3]} * xj2;
      X22 -= (f32x2){Lb11[0], Lb11[1]} * xj2;
      X23 -= (f32x2){Lb11[2], Lb11[3]} * xj2;
      X24 -= (f32x2){Lb12[0], Lb12[1]} * xj2;
      X25 -= (f32x2){Lb12[2], Lb12[3]} * xj2;
      X26 -= (f32x2){Lb13[0], Lb13[1]} * xj2;
      X27 -= (f32x2){Lb13[2], Lb13[3]} * xj2;
      X28 -= (f32x2){Lb14[0], Lb14[1]} * xj2;
      X29 -= (f32x2){Lb14[2], Lb14[3]} * xj2;
      X30 -= (f32x2){Lb15[0], Lb15[1]} * xj2;
      X31 -= (f32x2){Lb15[2], Lb15[3]} * xj2;
    }
    __builtin_amdgcn_sched_barrier(0);
    Lb8 = *(const f32x4*)(Lt_s + 2140);
    Lb9 = *(const f32x4*)(Lt_s + 2144);
    Lb10 = *(const f32x4*)(Lt_s + 2148);
    Lb11 = *(const f32x4*)(Lt_s + 2152);
    Lb12 = *(const f32x4*)(Lt_s + 2156);
    Lb13 = *(const f32x4*)(Lt_s + 2160);
    Lb14 = *(const f32x4*)(Lt_s + 2164);
    Lb15 = *(const f32x4*)(Lt_s + 2168);
    __builtin_amdgcn_sched_barrier(0);
    { const float xj = X15[0]; const f32x2 xj2 = (f32x2){xj, xj};
      X15 -= (f32x2){La7[2], La7[3]} * xj2;
      X16 -= (f32x2){La8[0], La8[1]} * xj2;
      X17 -= (f32x2){La8[2], La8[3]} * xj2;
      X18 -= (f32x2){La9[0], La9[1]} * xj2;
      X19 -= (f32x2){La9[2], La9[3]} * xj2;
      X20 -= (f32x2){La10[0], La10[1]} * xj2;
      X21 -= (f32x2){La10[2], La10[3]} * xj2;
      X22 -= (f32x2){La11[0], La11[1]} * xj2;
      X23 -= (f32x2){La11[2], La11[3]} * xj2;
      X24 -= (f32x2){La12[0], La12[1]} * xj2;
      X25 -= (f32x2){La12[2], La12[3]} * xj2;
      X26 -= (f32x2){La13[0], La13[1]} * xj2;
      X27 -= (f32x2){La13[2], La13[3]} * xj2;
      X28 -= (f32x2){La14[0], La14[1]} * xj2;
      X29 -= (f32x2){La14[2], La14[3]} * xj2;
      X30 -= (f32x2){La15[0], La15[1]} * xj2;
      X31 -= (f32x2){La15[2], La15[3]} * xj2;
    }
    __builtin_amdgcn_sched_barrier(0);
    La8 = *(const f32x4*)(Lt_s + 2208);
    La9 = *(const f32x4*)(Lt_s + 2212);
    La10 = *(const f32x4*)(Lt_s + 2216);
    La11 = *(const f32x4*)(Lt_s + 2220);
    La12 = *(const f32x4*)(Lt_s + 2224);
    La13 = *(const f32x4*)(Lt_s + 2228);
    La14 = *(const f32x4*)(Lt_s + 2232);
    La15 = *(const f32x4*)(Lt_s + 2236);
    __builtin_amdgcn_sched_barrier(0);
    { const float xj = X15[1]; const f32x2 xj2 = (f32x2){xj, xj};
      X16 -= (f32x2){Lb8[0], Lb8[1]} * xj2;
      X17 -= (f32x2){Lb8[2], Lb8[3]} * xj2;
      X18 -= (f32x2){Lb9[0], Lb9[1]} * xj2;
      X19 -= (f32x2){Lb9[2], Lb9[3]} * xj2;
      X20 -= (f32x2){Lb10[0], Lb10[1]} * xj2;
      X21 -= (f32x2){Lb10[2], Lb10[3]} * xj2;
      X22 -= (f32x2){Lb11[0], Lb11[1]} * xj2;
      X23 -= (f32x2){Lb11[2], Lb11[3]} * xj2;
      X24 -= (f32x2){Lb12[0], Lb12[1]} * xj2;
      X25 -= (f32x2){Lb12[2], Lb12[3]} * xj2;
      X26 -= (f32x2){Lb13[0], Lb13[1]} * xj2;
      X27 -= (f32x2){Lb13[2], Lb13[3]} * xj2;
      X28 -= (f32x2){Lb14[0], Lb14[1]} * xj2;
      X29 -= (f32x2){Lb14[2], Lb14[3]} * xj2;
      X30 -= (f32x2){Lb15[0], Lb15[1]} * xj2;
      X31 -= (f32x2){Lb15[2], Lb15[3]} * xj2;
    }
    __builtin_amdgcn_sched_barrier(0);
    Lb8 = *(const f32x4*)(Lt_s + 2276);
    Lb9 = *(const f32x4*)(Lt_s + 2280);
    Lb10 = *(const f32x4*)(Lt_s + 2284);
    Lb11 = *(const f32x4*)(Lt_s + 2288);
    Lb12 = *(const f32x4*)(Lt_s + 2292);
    Lb13 = *(const f32x4*)(Lt_s + 2296);
    Lb14 = *(const f32x4*)(Lt_s + 2300);
    Lb15 = *(const f32x4*)(Lt_s + 2304);
    __builtin_amdgcn_sched_barrier(0);
    { const float xj = X16[0]; const f32x2 xj2 = (f32x2){xj, xj};
      X16 -= (f32x2){La8[0], La8[1]} * xj2;
      X17 -= (f32x2){La8[2], La8[3]} * xj2;
      X18 -= (f32x2){La9[0], La9[1]} * xj2;
      X19 -= (f32x2){La9[2], La9[3]} * xj2;
      X20 -= (f32x2){La10[0], La10[1]} * xj2;
      X21 -= (f32x2){La10[2], La10[3]} * xj2;
      X22 -= (f32x2){La11[0], La11[1]} * xj2;
      X23 -= (f32x2){La11[2], La11[3]} * xj2;
      X24 -= (f32x2){La12[0], La12[1]} * xj2;
      X25 -= (f32x2){La12[2], La12[3]} * xj2;
      X26 -= (f32x2){La13[0], La13[1]} * xj2;
      X27 -= (f32x2){La13[2], La13[3]} * xj2;
      X28 -= (f32x2){La14[0], La14[1]} * xj2;
      X29 -= (f32x2){La14[2], La14[3]} * xj2;
      X30 -= (f32x2){La15[0], La15[1]} * xj2;
      X31 -= (f32x2){La15[2], La15[3]} * xj2;
    }
    __builtin_amdgcn_sched_barrier(0);
    La8 = *(const f32x4*)(Lt_s + 2344);
    La9 = *(const f32x4*)(Lt_s + 2348);
    La10 = *(const f32x4*)(Lt_s + 2352);
    La11 = *(const f32x4*)(Lt_s + 2356);
    La12 = *(const f32x4*)(Lt_s + 2360);
    La13 = *(const f32x4*)(Lt_s + 2364);
    La14 = *(const f32x4*)(Lt_s + 2368);
    La15 = *(const f32x4*)(Lt_s + 2372);
    __builtin_amdgcn_sched_barrier(0);
    { const float xj = X16[1]; const f32x2 xj2 = (f32x2){xj, xj};
      X17 -= (f32x2){Lb8[2], Lb8[3]} * xj2;
      X18 -= (f32x2){Lb9[0], Lb9[1]} * xj2;
      X19 -= (f32x2){Lb9[2], Lb9[3]} * xj2;
      X20 -= (f32x2){Lb10[0], Lb10[1]} * xj2;
      X21 -= (f32x2){Lb10[2], Lb10[3]} * xj2;
      X22 -= (f32x2){Lb11[0], Lb11[1]} * xj2;
      X23 -= (f32x2){Lb11[2], Lb11[3]} * xj2;
      X24 -= (f32x2){Lb12[0], Lb12[1]} * xj2;
      X25 -= (f32x2){Lb12[2], Lb12[3]} * xj2;
      X26 -= (f32x2){Lb13[0], Lb13[1]} * xj2;
      X27 -= (f32x2){Lb13[2], Lb13[3]} * xj2;
      X28 -= (f32x2){Lb14[0], Lb14[1]} * xj2;
      X29 -= (f32x2){Lb14[2], Lb14[3]} * xj2;
      X30 -= (f32x2){Lb15[0], Lb15[1]} * xj2;
      X31 -= (f32x2){Lb15[2], Lb15[3]} * xj2;
    }
    __builtin_amdgcn_sched_barrier(0);
    Lb9 = *(const f32x4*)(Lt_s + 2416);
    Lb10 = *(const f32x4*)(Lt_s + 2420);
    Lb11 = *(const f32x4*)(Lt_s + 2424);
    Lb12 = *(const f32x4*)(Lt_s + 2428);
    Lb13 = *(const f32x4*)(Lt_s + 2432);
    Lb14 = *(const f32x4*)(Lt_s + 2436);
    Lb15 = *(const f32x4*)(Lt_s + 2440);
    __builtin_amdgcn_sched_barrier(0);
    { const float xj = X17[0]; const f32x2 xj2 = (f32x2){xj, xj};
      X17 -= (f32x2){La8[2], La8[3]} * xj2;
      X18 -= (f32x2){La9[0], La9[1]} * xj2;
      X19 -= (f32x2){La9[2], La9[3]} * xj2;
      X20 -= (f32x2){La10[0], La10[1]} * xj2;
      X21 -= (f32x2){La10[2], La10[3]} * xj2;
      X22 -= (f32x2){La11[0], La11[1]} * xj2;
      X23 -= (f32x2){La11[2], La11[3]} * xj2;
      X24 -= (f32x2){La12[0], La12[1]} * xj2;
      X25 -= (f32x2){La12[2], La12[3]} * xj2;
      X26 -= (f32x2){La13[0], La13[1]} * xj2;
      X27 -= (f32x2){La13[2], La13[3]} * xj2;
      X28 -= (f32x2){La14[0], La14[1]} * xj2;
      X29 -= (f32x2){La14[2], La14[3]} * xj2;
      X30 -= (f32x2){La15[0], La15[1]} * xj2;
      X31 -= (f32x2){La15[2], La15[3]} * xj2;
    }
    __builtin_amdgcn_sched_barrier(0);
    La9 = *(const f32x4*)(Lt_s + 2484);
    La10 = *(const f32x4*)(Lt_s + 2488);
    La11 = *(const f32x4*)(Lt_s + 2492);
    La12 = *(const f32x4*)(Lt_s + 2496);
    La13 = *(const f32x4*)(Lt_s + 2500);
    La14 = *(const f32x4*)(Lt_s + 2504);
    La15 = *(const f32x4*)(Lt_s + 2508);
    __builtin_amdgcn_sched_barrier(0);
    { const float xj = X17[1]; const f32x2 xj2 = (f32x2){xj, xj};
      X18 -= (f32x2){Lb9[0], Lb9[1]} * xj2;
      X19 -= (f32x2){Lb9[2], Lb9[3]} * xj2;
      X20 -= (f32x2){Lb10[0], Lb10[1]} * xj2;
      X21 -= (f32x2){Lb10[2], Lb10[3]} * xj2;
      X22 -= (f32x2){Lb11[0], Lb11[1]} * xj2;
      X23 -= (f32x2){Lb11[2], Lb11[3]} * xj2;
      X24 -= (f32x2){Lb12[0], Lb12[1]} * xj2;
      X25 -= (f32x2){Lb12[2], Lb12[3]} * xj2;
      X26 -= (f32x2){Lb13[0], Lb13[1]} * xj2;
      X27 -= (f32x2){Lb13[2], Lb13[3]} * xj2;
      X28 -= (f32x2){Lb14[0], Lb14[1]} * xj2;
      X29 -= (f32x2){Lb14[2], Lb14[3]} * xj2;
      X30 -= (f32x2){Lb15[0], Lb15[1]} * xj2;
      X31 -= (f32x2){Lb15[2], Lb15[3]} * xj2;
    }
    __builtin_amdgcn_sched_barrier(0);
    Lb9 = *(const f32x4*)(Lt_s + 2552);
    Lb10 = *(const f32x4*)(Lt_s + 2556);
    Lb11 = *(const f32x4*)(Lt_s + 2560);
    Lb12 = *(const f32x4*)(Lt_s + 2564);
    Lb13 = *(const f32x4*)(Lt_s + 2568);
    Lb14 = *(const f32x4*)(Lt_s + 2572);
    Lb15 = *(const f32x4*)(Lt_s + 2576);
    __builtin_amdgcn_sched_barrier(0);
    { const float xj = X18[0]; const f32x2 xj2 = (f32x2){xj, xj};
      X18 -= (f32x2){La9[0], La9[1]} * xj2;
      X19 -= (f32x2){La9[2], La9[3]} * xj2;
      X20 -= (f32x2){La10[0], La10[1]} * xj2;
      X21 -= (f32x2){La10[2], La10[3]} * xj2;
      X22 -= (f32x2){La11[0], La11[1]} * xj2;
      X23 -= (f32x2){La11[2], La11[3]} * xj2;
      X24 -= (f32x2){La12[0], La12[1]} * xj2;
      X25 -= (f32x2){La12[2], La12[3]} * xj2;
      X26 -= (f32x2){La13[0], La13[1]} * xj2;
      X27 -= (f32x2){La13[2], La13[3]} * xj2;
      X28 -= (f32x2){La14[0], La14[1]} * xj2;
      X29 -= (f32x2){La14[2], La14[3]} * xj2;
      X30 -= (f32x2){La15[0], La15[1]} * xj2;
      X31 -= (f32x2){La15[2], La15[3]} * xj2;
    }
    __builtin_amdgcn_sched_barrier(0);
    La9 = *(const f32x4*)(Lt_s + 2620);
    La10 = *(const f32x4*)(Lt_s + 2624);
    La11 = *(const f32x4*)(Lt_s + 2628);
    La12 = *(const f32x4*)(Lt_s + 2632);
    La13 = *(const f32x4*)(Lt_s + 2636);
    La14 = *(const f32x4*)(Lt_s + 2640);
    La15 = *(const f32x4*)(Lt_s + 2644);
    __builtin_amdgcn_sched_barrier(0);
    { const float xj = X18[1]; const f32x2 xj2 = (f32x2){xj, xj};
      X19 -= (f32x2){Lb9[2], Lb9[3]} * xj2;
      X20 -= (f32x2){Lb10[0], Lb10[1]} * xj2;
      X21 -= (f32x2){Lb10[2], Lb10[3]} * xj2;
      X22 -= (f32x2){Lb11[0], Lb11[1]} * xj2;
      X23 -= (f32x2){Lb11[2], Lb11[3]} * xj2;
      X24 -= (f32x2){Lb12[0], Lb12[1]} * xj2;
      X25 -= (f32x2){Lb12[2], Lb12[3]} * xj2;
      X26 -= (f32x2){Lb13[0], Lb13[1]} * xj2;
      X27 -= (f32x2){Lb13[2], Lb13[3]} * xj2;
      X28 -= (f32x2){Lb14[0], Lb14[1]} * xj2;
      X29 -= (f32x2){Lb14[2], Lb14[3]} * xj2;
      X30 -= (f32x2){Lb15[0], Lb15[1]} * xj2;
      X31 -= (f32x2){Lb15[2], Lb15[3]} * xj2;
    }
    __builtin_amdgcn_sched_barrier(0);
    Lb10 = *(const f32x4*)(Lt_s + 2692);
    Lb11 = *(const f32x4*)(Lt_s + 2696);
    Lb12 = *(const f32x4*)(Lt_s + 2700);
    Lb13 = *(const f32x4*)(Lt_s + 2704);
    Lb14 = *(const f32x4*)(Lt_s + 2708);
    Lb15 = *(const f32x4*)(Lt_s + 2712);
    __builtin_amdgcn_sched_barrier(0);
    { const float xj = X19[0]; const f32x2 xj2 = (f32x2){xj, xj};
      X19 -= (f32x2){La9[2], La9[3]} * xj2;
      X20 -= (f32x2){La10[0], La10[1]} * xj2;
      X21 -= (f32x2){La10[2], La10[3]} * xj2;
      X22 -= (f32x2){La11[0], La11[1]} * xj2;
      X23 -= (f32x2){La11[2], La11[3]} * xj2;
      X24 -= (f32x2){La12[0], La12[1]} * xj2;
      X25 -= (f32x2){La12[2], La12[3]} * xj2;
      X26 -= (f32x2){La13[0], La13[1]} * xj2;
      X27 -= (f32x2){La13[2], La13[3]} * xj2;
      X28 -= (f32x2){La14[0], La14[1]} * xj2;
      X29 -= (f32x2){La14[2], La14[3]} * xj2;
      X30 -= (f32x2){La15[0], La15[1]} * xj2;
      X31 -= (f32x2){La15[2], La15[3]} * xj2;
    }
    __builtin_amdgcn_sched_barrier(0);
    La10 = *(const f32x4*)(Lt_s + 2760);
    La11 = *(const f32x4*)(Lt_s + 2764);
    La12 = *(const f32x4*)(Lt_s + 2768);
    La13 = *(const f32x4*)(Lt_s + 2772);
    La14 = *(const f32x4*)(Lt_s + 2776);
    La15 = *(const f32x4*)(Lt_s + 2780);
    __builtin_amdgcn_sched_barrier(0);
    { const float xj = X19[1]; const f32x2 xj2 = (f32x2){xj, xj};
      X20 -= (f32x2){Lb10[0], Lb10[1]} * xj2;
      X21 -= (f32x2){Lb10[2], Lb10[3]} * xj2;
      X22 -= (f32x2){Lb11[0], Lb11[1]} * xj2;
      X23 -= (f32x2){Lb11[2], Lb11[3]} * xj2;
      X24 -= (f32x2){Lb12[0], Lb12[1]} * xj2;
      X25 -= (f32x2){Lb12[2], Lb12[3]} * xj2;
      X26 -= (f32x2){Lb13[0], Lb13[1]} * xj2;
      X27 -= (f32x2){Lb13[2], Lb13[3]} * xj2;
      X28 -= (f32x2){Lb14[0], Lb14[1]} * xj2;
      X29 -= (f32x2){Lb14[2], Lb14[3]} * xj2;
      X30 -= (f32x2){Lb15[0], Lb15[1]} * xj2;
      X31 -= (f32x2){Lb15[2], Lb15[3]} * xj2;
    }
    __builtin_amdgcn_sched_barrier(0);
    Lb10 = *(const f32x4*)(Lt_s + 2828);
    Lb11 = *(const f32x4*)(Lt_s + 2832);
    Lb12 = *(const f32x4*)(Lt_s + 2836);
    Lb13 = *(const f32x4*)(Lt_s + 2840);
    Lb14 = *(const f32x4*)(Lt_s + 2844);
    Lb15 = *(const f32x4*)(Lt_s + 2848);
    __builtin_amdgcn_sched_barrier(0);
    { const float xj = X20[0]; const f32x2 xj2 = (f32x2){xj, xj};
      X20 -= (f32x2){La10[0], La10[1]} * xj2;
      X21 -= (f32x2){La10[2], La10[3]} * xj2;
      X22 -= (f32x2){La11[0], La11[1]} * xj2;
      X23 -= (f32x2){La11[2], La11[3]} * xj2;
      X24 -= (f32x2){La12[0], La12[1]} * xj2;
      X25 -= (f32x2){La12[2], La12[3]} * xj2;
      X26 -= (f32x2){La13[0], La13[1]} * xj2;
      X27 -= (f32x2){La13[2], La13[3]} * xj2;
      X28 -= (f32x2){La14[0], La14[1]} * xj2;
      X29 -= (f32x2){La14[2], La14[3]} * xj2;
      X30 -= (f32x2){La15[0], La15[1]} * xj2;
      X31 -= (f32x2){La15[2], La15[3]} * xj2;
    }
    __builtin_amdgcn_sched_barrier(0);
    La10 = *(const f32x4*)(Lt_s + 2896);
    La11 = *(const f32x4*)(Lt_s + 2900);
    La12 = *(const f32x4*)(Lt_s + 2904);
    La13 = *(const f32x4*)(Lt_s + 2908);
    La14 = *(const f32x4*)(Lt_s + 2912);
    La15 = *(const f32x4*)(Lt_s + 2916);
    __builtin_amdgcn_sched_barrier(0);
    { const float xj = X20[1]; const f32x2 xj2 = (f32x2){xj, xj};
      X21 -= (f32x2){Lb10[2], Lb10[3]} * xj2;
      X22 -= (f32x2){Lb11[0], Lb11[1]} * xj2;
      X23 -= (f32x2){Lb11[2], Lb11[3]} * xj2;
      X24 -= (f32x2){Lb12[0], Lb12[1]} * xj2;
      X25 -= (f32x2){Lb12[2], Lb12[3]} * xj2;
      X26 -= (f32x2){Lb13[0], Lb13[1]} * xj2;
      X27 -= (f32x2){Lb13[2], Lb13[3]} * xj2;
      X28 -= (f32x2){Lb14[0], Lb14[1]} * xj2;
      X29 -= (f32x2){Lb14[2], Lb14[3]} * xj2;
      X30 -= (f32x2){Lb15[0], Lb15[1]} * xj2;
      X31 -= (f32x2){Lb15[2], Lb15[3]} * xj2;
    }
    __builtin_amdgcn_sched_barrier(0);
    Lb11 = *(const f32x4*)(Lt_s + 2968);
    Lb12 = *(const f32x4*)(Lt_s + 2972);
    Lb13 = *(const f32x4*)(Lt_s + 2976);
    Lb14 = *(const f32x4*)(Lt_s + 2980);
    Lb15 = *(const f32x4*)(Lt_s + 2984);
    __builtin_amdgcn_sched_barrier(0);
    { const float xj = X21[0]; const f32x2 xj2 = (f32x2){xj, xj};
      X21 -= (f32x2){La10[2], La10[3]} * xj2;
      X22 -= (f32x2){La11[0], La11[1]} * xj2;
      X23 -= (f32x2){La11[2], La11[3]} * xj2;
      X24 -= (f32x2){La12[0], La12[1]} * xj2;
      X25 -= (f32x2){La12[2], La12[3]} * xj2;
      X26 -= (f32x2){La13[0], La13[1]} * xj2;
      X27 -= (f32x2){La13[2], La13[3]} * xj2;
      X28 -= (f32x2){La14[0], La14[1]} * xj2;
      X29 -= (f32x2){La14[2], La14[3]} * xj2;
      X30 -= (f32x2){La15[0], La15[1]} * xj2;
      X31 -= (f32x2){La15[2], La15[3]} * xj2;
    }
    __builtin_amdgcn_sched_barrier(0);
    La11 = *(const f32x4*)(Lt_s + 3036);
    La12 = *(const f32x4*)(Lt_s + 3040);
    La13 = *(const f32x4*)(Lt_s + 3044);
    La14 = *(const f32x4*)(Lt_s + 3048);
    La15 = *(const f32x4*)(Lt_s + 3052);
    __builtin_amdgcn_sched_barrier(0);
    { const float xj = X21[1]; const f32x2 xj2 = (f32x2){xj, xj};
      X22 -= (f32x2){Lb11[0], Lb11[1]} * xj2;
      X23 -= (f32x2){Lb11[2], Lb11[3]} * xj2;
      X24 -= (f32x2){Lb12[0], Lb12[1]} * xj2;
      X25 -= (f32x2){Lb12[2], Lb12[3]} * xj2;
      X26 -= (f32x2){Lb13[0], Lb13[1]} * xj2;
      X27 -= (f32x2){Lb13[2], Lb13[3]} * xj2;
      X28 -= (f32x2){Lb14[0], Lb14[1]} * xj2;
      X29 -= (f32x2){Lb14[2], Lb14[3]} * xj2;
      X30 -= (f32x2){Lb15[0], Lb15[1]} * xj2;
      X31 -= (f32x2){Lb15[2], Lb15[3]} * xj2;
    }
    __builtin_amdgcn_sched_barrier(0);
    Lb11 = *(const f32x4*)(Lt_s + 3104);
    Lb12 = *(const f32x4*)(Lt_s + 3108);
    Lb13 = *(const f32x4*)(Lt_s + 3112);
    Lb14 = *(const f32x4*)(Lt_s + 3116);
    Lb15 = *(const f32x4*)(Lt_s + 3120);
    __builtin_amdgcn_sched_barrier(0);
    { const float xj = X22[0]; const f32x2 xj2 = (f32x2){xj, xj};
      X22 -= (f32x2){La11[0], La11[1]} * xj2;
      X23 -= (f32x2){La11[2], La11[3]} * xj2;
      X24 -= (f32x2){La12[0], La12[1]} * xj2;
      X25 -= (f32x2){La12[2], La12[3]} * xj2;
      X26 -= (f32x2){La13[0], La13[1]} * xj2;
      X27 -= (f32x2){La13[2], La13[3]} * xj2;
      X28 -= (f32x2){La14[0], La14[1]} * xj2;
      X29 -= (f32x2){La14[2], La14[3]} * xj2;
      X30 -= (f32x2){La15[0], La15[1]} * xj2;
      X31 -= (f32x2){La15[2], La15[3]} * xj2;
    }
    __builtin_amdgcn_sched_barrier(0);
    La11 = *(const f32x4*)(Lt_s + 3172);
    La12 = *(const f32x4*)(Lt_s + 3176);
    La13 = *(const f32x4*)(Lt_s + 3180);
    La14 = *(const f32x4*)(Lt_s + 3184);
    La15 = *(const f32x4*)(Lt_s + 3188);
    __builtin_amdgcn_sched_barrier(0);
    { const float xj = X22[1]; const f32x2 xj2 = (f32x2){xj, xj};
      X23 -= (f32x2){Lb11[2], Lb11[3]} * xj2;
      X24 -= (f32x2){Lb12[0], Lb12[1]} * xj2;
      X25 -= (f32x2){Lb12[2], Lb12[3]} * xj2;
      X26 -= (f32x2){Lb13[0], Lb13[1]} * xj2;
      X27 -= (f32x2){Lb13[2], Lb13[3]} * xj2;
      X28 -= (f32x2){Lb14[0], Lb14[1]} * xj2;
      X29 -= (f32x2){Lb14[2], Lb14[3]} * xj2;
      X30 -= (f32x2){Lb15[0], Lb15[1]} * xj2;
      X31 -= (f32x2){Lb15[2], Lb15[3]} * xj2;
    }
    __builtin_amdgcn_sched_barrier(0);
    Lb12 = *(const f32x4*)(Lt_s + 3244);
    Lb13 = *(const f32x4*)(Lt_s + 3248);
    Lb14 = *(const f32x4*)(Lt_s + 3252);
    Lb15 = *(const f32x4*)(Lt_s + 3256);
    __builtin_amdgcn_sched_barrier(0);
    { const float xj = X23[0]; const f32x2 xj2 = (f32x2){xj, xj};
      X23 -= (f32x2){La11[2], La11[3]} * xj2;
      X24 -= (f32x2){La12[0], La12[1]} * xj2;
      X25 -= (f32x2){La12[2], La12[3]} * xj2;
      X26 -= (f32x2){La13[0], La13[1]} * xj2;
      X27 -= (f32x2){La13[2], La13[3]} * xj2;
      X28 -= (f32x2){La14[0], La14[1]} * xj2;
      X29 -= (f32x2){La14[2], La14[3]} * xj2;
      X30 -= (f32x2){La15[0], La15[1]} * xj2;
      X31 -= (f32x2){La15[2], La15[3]} * xj2;
    }
    __builtin_amdgcn_sched_barrier(0);
    La12 = *(const f32x4*)(Lt_s + 3312);
    La13 = *(const f32x4*)(Lt_s + 3316);
    La14 = *(const f32x4*)(Lt_s + 3320);
    La15 = *(const f32x4*)(Lt_s + 3324);
    __builtin_amdgcn_sched_barrier(0);
    { const float xj = X23[1]; const f32x2 xj2 = (f32x2){xj, xj};
      X24 -= (f32x2){Lb12[0], Lb12[1]} * xj2;
      X25 -= (f32x2){Lb12[2], Lb12[3]} * xj2;
      X26 -= (f32x2){Lb13[0], Lb13[1]} * xj2;
      X27 -= (f32x2){Lb13[2], Lb13[3]} * xj2;
      X28 -= (f32x2){Lb14[0], Lb14[1]} * xj2;
      X29 -= (f32x2){Lb14[2], Lb14[3]} * xj2;
      X30 -= (f32x2){Lb15[0], Lb15[1]} * xj2;
      X31 -= (f32x2){Lb15[2], Lb15[3]} * xj2;
    }
    __builtin_amdgcn_sched_barrier(0);
    Lb12 = *(const f32x4*)(Lt_s + 3380);
    Lb13 = *(const f32x4*)(Lt_s + 3384);
    Lb14 = *(const f32x4*)(Lt_s + 3388);
    Lb15 = *(const f32x4*)(Lt_s + 3392);
    __builtin_amdgcn_sched_barrier(0);
    { const float xj = X24[0]; const f32x2 xj2 = (f32x2){xj, xj};
      X24 -= (f32x2){La12[0], La12[1]} * xj2;
      X25 -= (f32x2){La12[2], La12[3]} * xj2;
      X26 -= (f32x2){La13[0], La13[1]} * xj2;
      X27 -= (f32x2){La13[2], La13[3]} * xj2;
      X28 -= (f32x2){La14[0], La14[1]} * xj2;
      X29 -= (f32x2){La14[2], La14[3]} * xj2;
      X30 -= (f32x2){La15[0], La15[1]} * xj2;
      X31 -= (f32x2){La15[2], La15[3]} * xj2;
    }
    __builtin_amdgcn_sched_barrier(0);
    La12 = *(const f32x4*)(Lt_s + 3448);
    La13 = *(const f32x4*)(Lt_s + 3452);
    La14 = *(const f32x4*)(Lt_s + 3456);
    La15 = *(const f32x4*)(Lt_s + 3460);
    __builtin_amdgcn_sched_barrier(0);
    { const float xj = X24[1]; const f32x2 xj2 = (f32x2){xj, xj};
      X25 -= (f32x2){Lb12[2], Lb12[3]} * xj2;
      X26 -= (f32x2){Lb13[0], Lb13[1]} * xj2;
      X27 -= (f32x2){Lb13[2], Lb13[3]} * xj2;
      X28 -= (f32x2){Lb14[0], Lb14[1]} * xj2;
      X29 -= (f32x2){Lb14[2], Lb14[3]} * xj2;
      X30 -= (f32x2){Lb15[0], Lb15[1]} * xj2;
      X31 -= (f32x2){Lb15[2], Lb15[3]} * xj2;
    }
    __builtin_amdgcn_sched_barrier(0);
    Lb13 = *(const f32x4*)(Lt_s + 3520);
    Lb14 = *(const f32x4*)(Lt_s + 3524);
    Lb15 = *(const f32x4*)(Lt_s + 3528);
    __builtin_amdgcn_sched_barrier(0);
    { const float xj = X25[0]; const f32x2 xj2 = (f32x2){xj, xj};
      X25 -= (f32x2){La12[2], La12[3]} * xj2;
      X26 -= (f32x2){La13[0], La13[1]} * xj2;
      X27 -= (f32x2){La13[2], La13[3]} * xj2;
      X28 -= (f32x2){La14[0], La14[1]} * xj2;
      X29 -= (f32x2){La14[2], La14[3]} * xj2;
      X30 -= (f32x2){La15[0], La15[1]} * xj2;
      X31 -= (f32x2){La15[2], La15[3]} * xj2;
    }
    __builtin_amdgcn_sched_barrier(0);
    La13 = *(const f32x4*)(Lt_s + 3588);
    La14 = *(const f32x4*)(Lt_s + 3592);
    La15 = *(const f32x4*)(Lt_s + 3596);
    __builtin_amdgcn_sched_barrier(0);
    { const float xj = X25[1]; const f32x2 xj2 = (f32x2){xj, xj};
      X26 -= (f32x2){Lb13[0], Lb13[1]} * xj2;
      X27 -= (f32x2){Lb13[2], Lb13[3]} * xj2;
      X28 -= (f32x2){Lb14[0], Lb14[1]} * xj2;
      X29 -= (f32x2){Lb14[2], Lb14[3]} * xj2;
      X30 -= (f32x2){Lb15[0], Lb15[1]} * xj2;
      X31 -= (f32x2){Lb15[2], Lb15[3]} * xj2;
    }
    __builtin_amdgcn_sched_barrier(0);
    Lb13 = *(const f32x4*)(Lt_s + 3656);
    Lb14 = *(const f32x4*)(Lt_s + 3660);
    Lb15 = *(const f32x4*)(Lt_s + 3664);
    __builtin_amdgcn_sched_barrier(0);
    { const float xj = X26[0]; const f32x2 xj2 = (f32x2){xj, xj};
      X26 -= (f32x2){La13[0], La13[1]} * xj2;
      X27 -= (f32x2){La13[2], La13[3]} * xj2;
      X28 -= (f32x2){La14[0], La14[1]} * xj2;
      X29 -= (f32x2){La14[2], La14[3]} * xj2;
      X30 -= (f32x2){La15[0], La15[1]} * xj2;
      X31 -= (f32x2){La15[2], La15[3]} * xj2;
    }
    __builtin_amdgcn_sched_barrier(0);
    La13 = *(const f32x4*)(Lt_s + 3724);
    La14 = *(const f32x4*)(Lt_s + 3728);
    La15 = *(const f32x4*)(Lt_s + 3732);
    __builtin_amdgcn_sched_barrier(0);
    { const float xj = X26[1]; const f32x2 xj2 = (f32x2){xj, xj};
      X27 -= (f32x2){Lb13[2], Lb13[3]} * xj2;
      X28 -= (f32x2){Lb14[0], Lb14[1]} * xj2;
      X29 -= (f32x2){Lb14[2], Lb14[3]} * xj2;
      X30 -= (f32x2){Lb15[0], Lb15[1]} * xj2;
      X31 -= (f32x2){Lb15[2], Lb15[3]} * xj2;
    }
    __builtin_amdgcn_sched_barrier(0);
    Lb14 = *(const f32x4*)(Lt_s + 3796);
    Lb15 = *(const f32x4*)(Lt_s + 3800);
    __builtin_amdgcn_sched_barrier(0);
    { const float xj = X27[0]; const f32x2 xj2 = (f32x2){xj, xj};
      X27 -= (f32x2){La13[2], La13[3]} * xj2;
      X28 -= (f32x2){La14[0], La14[1]} * xj2;
      X29 -= (f32x2){La14[2], La14[3]} * xj2;
      X30 -= (f32x2){La15[0], La15[1]} * xj2;
      X31 -= (f32x2){La15[2], La15[3]} * xj2;
    }
    __builtin_amdgcn_sched_barrier(0);
    La14 = *(const f32x4*)(Lt_s + 3864);
    La15 = *(const f32x4*)(Lt_s + 3868);
    __builtin_amdgcn_sched_barrier(0);
    { const float xj = X27[1]; const f32x2 xj2 = (f32x2){xj, xj};
      X28 -= (f32x2){Lb14[0], Lb14[1]} * xj2;
      X29 -= (f32x2){Lb14[2], Lb14[3]} * xj2;
      X30 -= (f32x2){Lb15[0], Lb15[1]} * xj2;
      X31 -= (f32x2){Lb15[2], Lb15[3]} * xj2;
    }
    __builtin_amdgcn_sched_barrier(0);
    Lb14 = *(const f32x4*)(Lt_s + 3932);
    Lb15 = *(const f32x4*)(Lt_s + 3936);
    __builtin_amdgcn_sched_barrier(0);
    { const float xj = X28[0]; const f32x2 xj2 = (f32x2){xj, xj};
      X28 -= (f32x2){La14[0], La14[1]} * xj2;
      X29 -= (f32x2){La14[2], La14[3]} * xj2;
      X30 -= (f32x2){La15[0], La15[1]} * xj2;
      X31 -= (f32x2){La15[2], La15[3]} * xj2;
    }
    __builtin_amdgcn_sched_barrier(0);
    La14 = *(const f32x4*)(Lt_s + 4000);
    La15 = *(const f32x4*)(Lt_s + 4004);
    __builtin_amdgcn_sched_barrier(0);
    { const float xj = X28[1]; const f32x2 xj2 = (f32x2){xj, xj};
      X29 -= (f32x2){Lb14[2], Lb14[3]} * xj2;
      X30 -= (f32x2){Lb15[0], Lb15[1]} * xj2;
      X31 -= (f32x2){Lb15[2], Lb15[3]} * xj2;
    }
    __builtin_amdgcn_sched_barrier(0);
    Lb15 = *(const f32x4*)(Lt_s + 4072);
    __builtin_amdgcn_sched_barrier(0);
    { const float xj = X29[0]; const f32x2 xj2 = (f32x2){xj, xj};
      X29 -= (f32x2){La14[2], La14[3]} * xj2;
      X30 -= (f32x2){La15[0], La15[1]} * xj2;
      X31 -= (f32x2){La15[2], La15[3]} * xj2;
    }
    __builtin_amdgcn_sched_barrier(0);
    La15 = *(const f32x4*)(Lt_s + 4140);
    __builtin_amdgcn_sched_barrier(0);
    { const float xj = X29[1]; const f32x2 xj2 = (f32x2){xj, xj};
      X30 -= (f32x2){Lb15[0], Lb15[1]} * xj2;
      X31 -= (f32x2){Lb15[2], Lb15[3]} * xj2;
    }
    __builtin_amdgcn_sched_barrier(0);
    Lb15 = *(const f32x4*)(Lt_s + 4208);
    __builtin_amdgcn_sched_barrier(0);
    { const float xj = X30[0]; const f32x2 xj2 = (f32x2){xj, xj};
      X30 -= (f32x2){La15[0], La15[1]} * xj2;
      X31 -= (f32x2){La15[2], La15[3]} * xj2;
    }
    __builtin_amdgcn_sched_barrier(0);
    La15 = *(const f32x4*)(Lt_s + 4276);
    __builtin_amdgcn_sched_barrier(0);
    { const float xj = X30[1]; const f32x2 xj2 = (f32x2){xj, xj};
      X31 -= (f32x2){Lb15[2], Lb15[3]} * xj2;
    }
    __builtin_amdgcn_sched_barrier(0);
    __builtin_amdgcn_sched_barrier(0);
    { const float xj = X31[0]; const f32x2 xj2 = (f32x2){xj, xj};
      X31 -= (f32x2){La15[2], La15[3]} * xj2;
    }
    __builtin_amdgcn_sched_barrier(0);
    __syncthreads();
    outp[0] = f2bf(sg * X0[0]);
    outp[136] = f2bf(sg * X0[1]);
    outp[272] = f2bf(sg * X1[0]);
    outp[408] = f2bf(sg * X1[1]);
    outp[544] = f2bf(sg * X2[0]);
    outp[680] = f2bf(sg * X2[1]);
    outp[816] = f2bf(sg * X3[0]);
    outp[952] = f2bf(sg * X3[1]);
    outp[1088] = f2bf(sg * X4[0]);
    outp[1224] = f2bf(sg * X4[1]);
    outp[1360] = f2bf(sg * X5[0]);
    outp[1496] = f2bf(sg * X5[1]);
    outp[1632] = f2bf(sg * X6[0]);
    outp[1768] = f2bf(sg * X6[1]);
    outp[1904] = f2bf(sg * X7[0]);
    outp[2040] = f2bf(sg * X7[1]);
    outp[2176] = f2bf(sg * X8[0]);
    outp[2312] = f2bf(sg * X8[1]);
    outp[2448] = f2bf(sg * X9[0]);
    outp[2584] = f2bf(sg * X9[1]);
    outp[2720] = f2bf(sg * X10[0]);
    outp[2856] = f2bf(sg * X10[1]);
    outp[2992] = f2bf(sg * X11[0]);
    outp[3128] = f2bf(sg * X11[1]);
    outp[3264] = f2bf(sg * X12[0]);
    outp[3400] = f2bf(sg * X12[1]);
    outp[3536] = f2bf(sg * X13[0]);
    outp[3672] = f2bf(sg * X13[1]);
    outp[3808] = f2bf(sg * X14[0]);
    outp[3944] = f2bf(sg * X14[1]);
    outp[4080] = f2bf(sg * X15[0]);
    outp[4216] = f2bf(sg * X15[1]);
    outp[4352] = f2bf(sg * X16[0]);
    outp[4488] = f2bf(sg * X16[1]);
    outp[4624] = f2bf(sg * X17[0]);
    outp[4760] = f2bf(sg * X17[1]);
    outp[4896] = f2bf(sg * X18[0]);
    outp[5032] = f2bf(sg * X18[1]);
    outp[5168] = f2bf(sg * X19[0]);
    outp[5304] = f2bf(sg * X19[1]);
    outp[5440] = f2bf(sg * X20[0]);
    outp[5576] = f2bf(sg * X20[1]);
    outp[5712] = f2bf(sg * X21[0]);
    outp[5848] = f2bf(sg * X21[1]);
    outp[5984] = f2bf(sg * X22[0]);
    outp[6120] = f2bf(sg * X22[1]);
    outp[6256] = f2bf(sg * X23[0]);
    outp[6392] = f2bf(sg * X23[1]);
    outp[6528] = f2bf(sg * X24[0]);
    outp[6664] = f2bf(sg * X24[1]);
    outp[6800] = f2bf(sg * X25[0]);
    outp[6936] = f2bf(sg * X25[1]);
    outp[7072] = f2bf(sg * X26[0]);
    outp[7208] = f2bf(sg * X26[1]);
    outp[7344] = f2bf(sg * X27[0]);
    outp[7480] = f2bf(sg * X27[1]);
    outp[7616] = f2bf(sg * X28[0]);
    outp[7752] = f2bf(sg * X28[1]);
    outp[7888] = f2bf(sg * X29[0]);
    outp[8024] = f2bf(sg * X29[1]);
    outp[8160] = f2bf(sg * X30[0]);
    outp[8296] = f2bf(sg * X30[1]);
    outp[8432] = f2bf(sg * X31[0]);
    outp[8568] = f2bf(sg * X31[1]);
}

DEV void dn_item(const Params& p, int l, int item, unsigned char* smem) {
    const int dir = item & 1, hh = (item >> 1) & 3, b = item >> 3;
    bf16_t* q_s = (bf16_t*)(smem);
    bf16_t* k_s = (bf16_t*)(smem + 17408);
    bf16_t* vnT_s = k_s;
    bf16_t* kT_s = (bf16_t*)(smem + 35840);
    bf16_t* v_s = (bf16_t*)(smem + 54272);
    bf16_t* u_s = v_s;
    float* L_s = (float*)(smem + 71680);
    bf16_t* w_s = (bf16_t*)(smem + 71680);
    bf16_t* qk_s = (bf16_t*)(smem + 89088);
    bf16_t* St_s = (bf16_t*)(smem + 98304);
    float* G_s = (float*)(smem + 133120);
    float* beta_s = G_s + 64;
    float* eG_s = G_s + 128;
    float* bw_s = G_s + 192;
    float* cw_s = G_s + 256;
    const int tid = get_tid(), lane = tid & 63, wv = tid >> 6, l15 = lane & 15, quad = lane >> 4;
    const float Aneg = -expf(p.in[I_DNALOG][(l * 2 + dir) * 4 + hh]);
    const float dtb = p.in[I_DNDT][(l * 2 + dir) * 4 + hh];
    const bf16_t* P = wsb(p, O_P);
    const float* AB = wsf(p, O_AB);
    bf16_t* TO = wsb(p, dir ? O_TA2 : O_TA);
    __syncthreads();
    for (int e = tid; e < 4 * 384; e += 256) { int j = e / 384, c = e % 384, mat = c >> 7, cc = c & 127; cw_s[e] = p.in[I_DNCONV][((size_t)l * 4 + j) * 1536 + mat * 512 + hh * 128 + cc]; }
    for (int e = tid; e < 128 * 136 / 2; e += 256) ((unsigned*)St_s)[e] = 0u;
    f32x4 Sacc[2][8];
#pragma unroll
    for (int a = 0; a < 2; ++a)
#pragma unroll
        for (int c = 0; c < 8; ++c) Sacc[a][c] = (f32x4){0.f, 0.f, 0.f, 0.f};

    const int rg = tid >> 4, cseg = tid & 15, i0 = rg * 4;
    u32x4 raw[3][7];
    float pf_al = 0.f, pf_bb = 0.f;
#define DN_PREFETCH(NN, M0, M1) { \
        const int c_ = chunk_of(dir, (NN)); const int lo_ = c_ < 4 ? 0 : CTXL, hi_ = c_ < 4 ? CTXL : SB, base_ = c_ * 64; \
        const int slo_ = dir ? base_ + 60 - i0 : base_ + i0; \
        _Pragma("unroll") for (int u = 0; u < 7; ++u) { const int ss_ = slo_ - 1 + u; const bool ok_ = ss_ >= lo_ && ss_ < hi_; \
            const bf16_t* rp_ = P + ((size_t)b * SB + (ok_ ? ss_ : base_)) * PW + hh * 128 + cseg * 8; \
            _Pragma("unroll") for (int mat = (M0); mat < (M1); ++mat) { u32x4 t_ = *(const u32x4*)(rp_ + mat * 512); raw[mat][u] = ok_ ? t_ : (u32x4){0u, 0u, 0u, 0u}; } } \
        if ((M0) == 0) { const int sa_ = dir ? base_ + 63 - lane : base_ + lane; \
        pf_al = AB[((size_t)b * SB + sa_) * 16 + dir * 4 + hh]; pf_bb = AB[((size_t)b * SB + sa_) * 16 + 8 + dir * 4 + hh]; } }
    DN_PREFETCH(0, 0, 3);
    const int wv0_ = wv, l150_ = l15, quad0_ = quad, lane0_ = lane;

#pragma unroll 1
    for (int n = 0; n < 68; ++n) {
        int tz0 = 0; asm volatile("" : "+v"(tz0));
        const int wv = wv0_ + tz0, l15 = l150_ + tz0, quad = quad0_ + tz0, lane = lane0_ + tz0;
        const int c = chunk_of(dir, n);
        const int base = c * 64;
        __syncthreads();
        if (wv == 0) {
            float g = Aneg * softplus_fast(pf_al + dtb);
#pragma unroll
            for (int o = 1; o < 64; o <<= 1) { float t = __shfl_up(g, o); if (lane >= o) g += t; }
            const float eg_ = expf(g), bt_ = sigm(pf_bb); G_s[lane] = g; beta_s[lane] = bt_; eG_s[lane] = eg_; bw_s[lane] = bt_ * eg_;
        }
        __syncthreads();
        const float Glast = G_s[63];
        {
            int tz = 0; asm volatile("" : "+v"(tz));
            const int i0l = i0 + tz, csl = cseg + tz;
            float ksc[4];
#pragma unroll
            for (int m = 0; m < 4; ++m) ksc[m] = expf(Glast - G_s[i0l + m]);
#pragma unroll
            for (int mat = 0; mat < 3; ++mat) {
                float w[4][8];
#pragma unroll
                for (int j = 0; j < 4; ++j) { const f32x4 w0 = *(const f32x4*)(cw_s + j * 384 + mat * 128 + csl * 8), w1 = *(const f32x4*)(cw_s + j * 384 + mat * 128 + csl * 8 + 4);
#pragma unroll
                    for (int e = 0; e < 4; ++e) { w[j][e] = w0[e]; w[j][4 + e] = w1[e]; } }
                float v[4][8];
#pragma unroll
                for (int t = 0; t < 4; ++t)
#pragma unroll
                    for (int e = 0; e < 8; ++e) v[t][e] = 0.f;
#pragma unroll
                for (int u = 0; u < 7; ++u) {
                    float x[8];
#pragma unroll
                    for (int e = 0; e < 4; ++e) { x[2 * e] = lo16(raw[mat][u][e]); x[2 * e + 1] = hi16(raw[mat][u][e]); }
#pragma unroll
                    for (int t = 0; t < 4; ++t) { const int j = u - t; if (j >= 0 && j < 4) {
#pragma unroll
                        for (int e = 0; e < 8; ++e) v[t][e] += w[j][e] * x[e]; } }
                }
                float sc[4];
#pragma unroll
                for (int t = 0; t < 4; ++t) {
                    float ss2 = 0.f;
#pragma unroll
                    for (int e = 0; e < 8; ++e) { v[t][e] = silu(v[t][e]); ss2 += v[t][e] * v[t][e]; }
                    if (mat < 2) { ss2 += __shfl_xor(ss2, 1); ss2 += __shfl_xor(ss2, 2); ss2 += __shfl_xor(ss2, 4); ss2 += __shfl_xor(ss2, 8); }
                    sc[t] = mat == 0 ? rsqrtf(ss2 + 1e-6f) * 0.08838834764831845f : (mat == 1 ? rsqrtf(ss2 + 1e-6f) : 1.f);
                }
                bf16_t* dst = mat == 0 ? q_s : (mat == 1 ? k_s : v_s);
#pragma unroll
                for (int t = 0; t < 4; ++t) {
                    const int it_ = dir ? i0l + 3 - t : i0l + t;
                    u32x4 o;
#pragma unroll
                    for (int e = 0; e < 4; ++e) o[e] = pack2(v[t][2 * e] * sc[t], v[t][2 * e + 1] * sc[t]);
                    *(u32x4*)(dst + it_ * 136 + csl * 8) = o;
                }
                if (mat == 1) {
#pragma unroll
                    for (int e = 0; e < 8; ++e) {
                        const float k0 = v[dir ? 3 : 0][e] * sc[dir ? 3 : 0] * ksc[0], k1 = v[dir ? 2 : 1][e] * sc[dir ? 2 : 1] * ksc[1];
                        const float k2 = v[dir ? 1 : 2][e] * sc[dir ? 1 : 2] * ksc[2], k3 = v[dir ? 0 : 3][e] * sc[dir ? 0 : 3] * ksc[3];
                        u32x2 o; o.x = pack2(k0, k1); o.y = pack2(k2, k3);
                        *(u32x2*)(kT_s + (csl * 8 + e) * 72 + i0l) = o;
                    }
                }
            }
        }
        __syncthreads();
        {
            bf16x8 ak[4], aq[4];
#pragma unroll
            for (int ks = 0; ks < 4; ++ks) { ak[ks] = *(const bf16x8*)(k_s + (wv * 16 + l15) * 136 + ks * 32 + quad * 8); aq[ks] = *(const bf16x8*)(q_s + (wv * 16 + l15) * 136 + ks * 32 + quad * 8); }
#pragma unroll
            for (int nt = 0; nt < 4; ++nt) {
                f32x4 kk = {0.f, 0.f, 0.f, 0.f}, qq = {0.f, 0.f, 0.f, 0.f};
#pragma unroll
                for (int ks = 0; ks < 4; ++ks) { bf16x8 bk = *(const bf16x8*)(k_s + (nt * 16 + l15) * 136 + ks * 32 + quad * 8); kk = mfma16(ak[ks], bk, kk); qq = mfma16(aq[ks], bk, qq); }
                const int jj = nt * 16 + l15; const float Gj = G_s[jj];
                f32x4 lv;
#pragma unroll
                for (int j = 0; j < 4; ++j) {
                    const int i = wv * 16 + quad * 4 + j;
                    const float dec = jj <= i ? expf(G_s[i] - Gj) : 0.f;
                    lv[j] = jj < i ? beta_s[i] * kk[j] * dec : 0.f;
                    qk_s[i * 72 + jj] = f2bf(qq[j] * dec);
                }
                *(f32x4*)(L_s + jj * 68 + wv * 16 + quad * 4) = lv;
            }
        }
        __syncthreads();
        dn_solve(L_s, tid < 128 ? (k_s + tid) : (v_s + (tid - 128)), tid < 128 ? bw_s : beta_s, tid < 128 ? -1.f : 1.f, tid < 128 ? (w_s + tid) : (u_s + (tid - 128)));
        __syncthreads();
        {
            f32x4 vn[8], o1[8];
#pragma unroll
            for (int nt = 0; nt < 8; ++nt) {
#pragma unroll
                for (int j = 0; j < 4; ++j) vn[nt][j] = bf2f(u_s[(wv * 16 + quad * 4 + j) * 136 + nt * 16 + l15]);
                o1[nt] = (f32x4){0.f, 0.f, 0.f, 0.f};
            }
            bf16x8 aw[4], aq[4];
#pragma unroll
            for (int ks = 0; ks < 4; ++ks) { aw[ks] = *(const bf16x8*)(w_s + (wv * 16 + l15) * 136 + ks * 32 + quad * 8); aq[ks] = *(const bf16x8*)(q_s + (wv * 16 + l15) * 136 + ks * 32 + quad * 8); }
#pragma unroll
            for (int nt = 0; nt < 8; ++nt)
#pragma unroll
                for (int ks = 0; ks < 4; ++ks) { bf16x8 bs = *(const bf16x8*)(St_s + (nt * 16 + l15) * 136 + ks * 32 + quad * 8); vn[nt] = mfma16(aw[ks], bs, vn[nt]); o1[nt] = mfma16(aq[ks], bs, o1[nt]); }
#pragma unroll
            for (int nt = 0; nt < 8; ++nt) { u32x2 o; o.x = pack2(vn[nt][0], vn[nt][1]); o.y = pack2(vn[nt][2], vn[nt][3]); *(u32x2*)(vnT_s + (nt * 16 + l15) * 72 + wv * 16 + quad * 4) = o; }
            __syncthreads();
            if (n + 1 < 68) DN_PREFETCH(n + 1, 0, 2);
            float eg[4];
#pragma unroll
            for (int j = 0; j < 4; ++j) eg[j] = eG_s[wv * 16 + quad * 4 + j];
            bf16x8 aqk[2], akt[2][2];
#pragma unroll
            for (int ks = 0; ks < 2; ++ks) {
                aqk[ks] = *(const bf16x8*)(qk_s + (wv * 16 + l15) * 72 + ks * 32 + quad * 8);
                akt[0][ks] = *(const bf16x8*)(kT_s + (wv * 32 + l15) * 72 + ks * 32 + quad * 8);
                akt[1][ks] = *(const bf16x8*)(kT_s + (wv * 32 + 16 + l15) * 72 + ks * 32 + quad * 8);
            }
            const float gend = eG_s[63];
            const size_t orow0 = (size_t)b * SB;
#pragma unroll
            for (int nt = 0; nt < 8; ++nt) {
                f32x4 o;
#pragma unroll
                for (int j = 0; j < 4; ++j) { o[j] = o1[nt][j] * eg[j]; Sacc[0][nt][j] *= gend; Sacc[1][nt][j] *= gend; }
#pragma unroll
                for (int ks = 0; ks < 2; ++ks) {
                    bf16x8 bv = *(const bf16x8*)(vnT_s + (nt * 16 + l15) * 72 + ks * 32 + quad * 8);
                    o = mfma16(aqk[ks], bv, o);
                    Sacc[0][nt] = mfma16(akt[0][ks], bv, Sacc[0][nt]);
                    Sacc[1][nt] = mfma16(akt[1][ks], bv, Sacc[1][nt]);
                }
#pragma unroll
                for (int j = 0; j < 4; ++j) {
                    const int i = wv * 16 + quad * 4 + j;
                    const int s = dir ? base + 63 - i : base + i;
                    TO[(orow0 + s) * 512 + hh * 128 + nt * 16 + l15] = f2bf(o[j]);
                }
#pragma unroll
                for (int mt = 0; mt < 2; ++mt) { u32x2 sv; sv.x = pack2(Sacc[mt][nt][0], Sacc[mt][nt][1]); sv.y = pack2(Sacc[mt][nt][2], Sacc[mt][nt][3]);
                    *(u32x2*)(St_s + (nt * 16 + l15) * 136 + wv * 32 + mt * 16 + quad * 4) = sv; }
            }
        }
        if (n + 1 < 68) DN_PREFETCH(n + 1, 2, 3);
    }
}

#undef DN_PREFETCH
DEV void lru_item(const Params& p, int l, int item, unsigned char* smem) {
    const int g = item & 7, b = item >> 3;
    bf16_t* Wt_s = (bf16_t*)smem;
    bf16_t* xbh_s = Wt_s + 2 * 128 * 72;
    float* xbf_s = (float*)(smem + 36864 + 18432);
    float* a_s = xbf_s + 2 * 64 * 65;
    float* cw_s = a_s + 2 * 64 * 65;
    const int tid = get_tid(), lane = tid & 63, wv = tid >> 6, l15 = lane & 15, quad = lane >> 4;
    bf16_t* P = wsb(p, O_P);
    bf16_t* HF = wsb(p, O_U);
    __syncthreads();
    for (int e = tid; e < 320; e += 256) cw_s[e] = e < 256 ? p.in[I_LCW][((size_t)l * 4 + (e >> 6)) * 512 + g * 64 + (e & 63)] : p.in[I_LCB][l * 512 + g * 64 + (e - 256)];
    for (int e = tid; e < 2 * 4096; e += 256) {
        const int d = e >> 12, ch = (e >> 6) & 63, j = e & 63;
        const size_t wi_ = (((size_t)l * 2 + d) * 8 + g) * 4096 + ch * 64 + j;
        Wt_s[(d * 128 + j) * 72 + ch] = f2bf(p.in[I_LWA][wi_]);
        Wt_s[(d * 128 + 64 + j) * 72 + ch] = f2bf(p.in[I_LWI][wi_]);
    }
    float ba_[2][4], bi_[2][4], sp_[2][4];
#pragma unroll
    for (int d = 0; d < 2; ++d)
#pragma unroll
        for (int nt = 0; nt < 4; ++nt) {
            const int ch = (l * 2 + d) * 512 + g * 64 + nt * 16 + l15;
            ba_[d][nt] = p.in[I_LBA][ch]; bi_[d][nt] = p.in[I_LBI][ch]; sp_[d][nt] = softplus(-p.in[I_LLAM][ch]);
        }
    float hc = 0.f;
    const int i = tid >> 2, seg = tid & 3, j0 = seg * 16;
#pragma unroll 1
    for (int n = 0; n < 68; ++n) {
        const int cf = n, cb = chunk_of(1, n);
        __syncthreads();
#pragma unroll
        for (int d = 0; d < 2; ++d) {
            const int c = d ? cb : cf;
            const int seg_lo = c < 4 ? 0 : CTXL, seg_hi = c < 4 ? CTXL : SB;
            const int s = d ? c * 64 + 63 - i : c * 64 + i;
            float v[16];
#pragma unroll
            for (int e = 0; e < 16; ++e) v[e] = cw_s[256 + j0 + e];
#pragma unroll
            for (int j = 0; j < 4; ++j) {
                const int ss = s + j - 1;
                if (ss >= seg_lo && ss < seg_hi) {
                    const u32x4* src = (const u32x4*)(P + ((size_t)b * SB + ss) * PW + C_LX + g * 64 + j0);
                    const float* cw = cw_s + j * 64 + j0;
#pragma unroll
                    for (int q = 0; q < 2; ++q) { u32x4 x = src[q];
#pragma unroll
                        for (int e = 0; e < 4; ++e) { v[q * 8 + 2 * e] += cw[q * 8 + 2 * e] * lo16(x[e]); v[q * 8 + 2 * e + 1] += cw[q * 8 + 2 * e + 1] * hi16(x[e]); } }
                }
            }
            u32x4 h0, h1;
#pragma unroll
            for (int e = 0; e < 4; ++e) { h0[e] = pack2(v[2 * e], v[2 * e + 1]); h1[e] = pack2(v[8 + 2 * e], v[8 + 2 * e + 1]); }
            *(u32x4*)(xbh_s + (d * 64 + i) * 72 + j0) = h0; *(u32x4*)(xbh_s + (d * 64 + i) * 72 + j0 + 8) = h1;
#pragma unroll
            for (int e = 0; e < 16; ++e) xbf_s[(d * 64 + i) * 65 + j0 + e] = v[e];
        }
        __syncthreads();
#pragma unroll
        for (int d = 0; d < 2; ++d) {
            f32x4 acc[8];
#pragma unroll
            for (int nt = 0; nt < 8; ++nt) acc[nt] = (f32x4){0.f, 0.f, 0.f, 0.f};
            bf16x8 af[2];
#pragma unroll
            for (int ks = 0; ks < 2; ++ks) af[ks] = *(const bf16x8*)(xbh_s + (d * 64 + wv * 16 + l15) * 72 + ks * 32 + quad * 8);
#pragma unroll
            for (int nt = 0; nt < 8; ++nt)
#pragma unroll
                for (int ks = 0; ks < 2; ++ks) { bf16x8 bw = *(const bf16x8*)(Wt_s + (d * 128 + nt * 16 + l15) * 72 + ks * 32 + quad * 8); acc[nt] = mfma16(af[ks], bw, acc[nt]); }
#pragma unroll
            for (int nt = 0; nt < 4; ++nt)
#pragma unroll
                for (int jj = 0; jj < 4; ++jj) {
                    const int idx = (d * 64 + wv * 16 + quad * 4 + jj) * 65 + nt * 16 + l15;
                    const float r = sigm(acc[nt][jj] + ba_[d][nt]), ig = sigm(acc[nt + 4][jj] + bi_[d][nt]);
                    const float la = -8.f * r * sp_[d][nt];
                    a_s[idx] = expf(la);
                    xbf_s[idx] = sqrtf(fmaxf(1.f - expf(2.f * la), 0.f)) * (ig * xbf_s[idx]);
                }
        }
        __syncthreads();
        if (wv < 2) {
            const int o = wv * 64 * 65 + lane;
#pragma unroll 16
            for (int r = 0; r < 64; ++r) { hc = a_s[o + r * 65] * hc + xbf_s[o + r * 65]; xbf_s[o + r * 65] = hc; }
        }
        __syncthreads();
#pragma unroll
        for (int d = 0; d < 2; ++d) {
            const int c = d ? cb : cf;
            const int s = d ? c * 64 + 63 - i : c * 64 + i;
            const bool second = d ? (cb < n) : ((cf < 4 ? 3 - cf : 71 - cf) < n);
            const size_t row = (size_t)b * SB + s;
            const float* hp = xbf_s + (d * 64 + i) * 65 + j0;
            bf16_t* hf = HF + row * 512 + g * 64 + j0;
            if (!second) {
                u32x4 o0, o1;
#pragma unroll
                for (int e = 0; e < 4; ++e) { o0[e] = pack2(hp[2 * e], hp[2 * e + 1]); o1[e] = pack2(hp[8 + 2 * e], hp[8 + 2 * e + 1]); }
                *(u32x4*)hf = o0; *(u32x4*)(hf + 8) = o1;
            } else {
                bf16_t* gp = P + row * PW + C_LG + g * 64 + j0;
                u32x4 f0 = *(const u32x4*)hf, f1 = *(const u32x4*)(hf + 8), g0 = *(const u32x4*)gp, g1 = *(const u32x4*)(gp + 8), o0, o1;
#pragma unroll
                for (int e = 0; e < 4; ++e) {
                    o0[e] = pack2((lo16(f0[e]) + hp[2 * e]) * gelu_tanh(lo16(g0[e])), (hi16(f0[e]) + hp[2 * e + 1]) * gelu_tanh(hi16(g0[e])));
                    o1[e] = pack2((lo16(f1[e]) + hp[8 + 2 * e]) * gelu_tanh(lo16(g1[e])), (hi16(f1[e]) + hp[8 + 2 * e + 1]) * gelu_tanh(hi16(g1[e])));
                }
                *(u32x4*)gp = o0; *(u32x4*)(gp + 8) = o1;
            }
        }
    }
}

DEV void att_item(const Params& p, int l, int b, int h, int qt, float lam_init, unsigned char* smem) {
    bf16_t* K_s = (bf16_t*)smem;
    bf16_t* V_s = (bf16_t*)(smem + 2 * 17408);
    const int tid = get_tid(), lane = tid & 63, wv = tid >> 6, l15 = lane & 15, quad = lane >> 4;
    bf16_t* P = wsb(p, O_P);
    const bf16_t* VT = wsb(p, O_VT) + (size_t)(b * 4 + h) * 128 * SB;
    const int nt_keys = (qt < 2 ? CTXL : SB) / 64;
    float lam;
    {
        const float* lv = p.in[I_DALAM] + l * 256;
        float s1 = lv[lane] * lv[64 + lane], s2 = lv[128 + lane] * lv[192 + lane];
#pragma unroll
        for (int o = 32; o >= 1; o >>= 1) { s1 += __shfl_xor(s1, o); s2 += __shfl_xor(s2, o); }
        lam = expf(s1) - expf(s2) + lam_init;
    }
    bf16x8* Qst = (bf16x8*)(smem + 71680) + (wv * 8) * 64 + lane;
#pragma unroll
    for (int qg = 0; qg < 2; ++qg) {
        const bf16_t* qp = P + ((size_t)b * SB + qt * 128 + wv * 32 + qg * 16 + l15) * PW + C_DAQ + h * 128;
#pragma unroll
        for (int wh = 0; wh < 2; ++wh)
#pragma unroll
            for (int ks = 0; ks < 2; ++ks) Qst[(wh * 4 + qg * 2 + ks) * 64] = *(const bf16x8*)(qp + wh * 64 + ks * 32 + quad * 8);
    }
    f32x4 O[2][8][2];
    float mrun[2][2], lrun[2][2];
#pragma unroll
    for (int wh = 0; wh < 2; ++wh)
#pragma unroll
        for (int qg = 0; qg < 2; ++qg) { mrun[wh][qg] = -1e30f; lrun[wh][qg] = 0.f;
#pragma unroll
            for (int dg = 0; dg < 8; ++dg) O[wh][dg][qg] = (f32x4){0.f, 0.f, 0.f, 0.f}; }
    const int kr = tid >> 2, kseg = (tid & 3) * 32;
    const int kpos = ((kr >> 5) * 2 + ((kr & 7) >> 2)) * 16 + ((kr & 31) >> 3) * 4 + (kr & 3);
    const bf16_t* kg_ = P + ((size_t)b * SB + kr) * PW + C_DAK + h * 128 + kseg;
    const int vr = tid >> 1, vh = (tid & 1) * 32;
    const bf16_t* vg_ = VT + (size_t)vr * SB + vh;
    u32x4 kreg[4], vreg[4];
#pragma unroll
    for (int i = 0; i < 4; ++i) { kreg[i] = *(const u32x4*)(kg_ + i * 8); vreg[i] = *(const u32x4*)(vg_ + i * 8); }
    __syncthreads();
#pragma unroll
    for (int i = 0; i < 4; ++i) { *(u32x4*)(K_s + kpos * 136 + kseg + i * 8) = kreg[i]; *(u32x4*)(V_s + vr * 72 + vh + i * 8) = vreg[i]; }
    __syncthreads();
    const float L2E = 1.4426950408889634f;
#pragma unroll 1
    for (int t = 0; t < nt_keys; ++t) {
        const bf16_t* Kb = K_s + (t & 1) * (64 * 136);
        const bf16_t* Vb = V_s + (t & 1) * (128 * 72);
        if (t + 1 < nt_keys) {
#pragma unroll
            for (int i = 0; i < 4; ++i) { kreg[i] = *(const u32x4*)(kg_ + (size_t)(t + 1) * 64 * PW + i * 8); vreg[i] = *(const u32x4*)(vg_ + (t + 1) * 64 + i * 8); }
        }
#pragma unroll
        for (int wh = 0; wh < 2; ++wh) {
            f32x4 S[4][2];
#pragma unroll
            for (int kg = 0; kg < 4; ++kg) { S[kg][0] = (f32x4){0.f, 0.f, 0.f, 0.f}; S[kg][1] = (f32x4){0.f, 0.f, 0.f, 0.f}; }
#pragma unroll
            for (int ks = 0; ks < 2; ++ks)
#pragma unroll
                for (int kg = 0; kg < 4; ++kg) {
                    bf16x8 kf = *(const bf16x8*)(Kb + (kg * 16 + l15) * 136 + wh * 64 + ks * 32 + quad * 8);
                    S[kg][0] = mfma16(kf, Qst[(wh * 4 + 0 + ks) * 64], S[kg][0]);
                    S[kg][1] = mfma16(kf, Qst[(wh * 4 + 2 + ks) * 64], S[kg][1]);
                }
            bf16x8 Pf[2][2];
#pragma unroll
            for (int qg = 0; qg < 2; ++qg) {
                float mx = -1e30f;
#pragma unroll
                for (int kg = 0; kg < 4; ++kg)
#pragma unroll
                    for (int j = 0; j < 4; ++j) mx = fmaxf(mx, S[kg][qg][j]);
                mx = fmaxf(mx, __shfl_xor(mx, 16)); mx = fmaxf(mx, __shfl_xor(mx, 32));
                mx *= L2E;
                if (__builtin_amdgcn_ballot_w64(mx > mrun[wh][qg] + 8.f) != 0ull) {
                    const float mnew = fmaxf(mrun[wh][qg], mx);
                    const float alpha = __builtin_amdgcn_exp2f(mrun[wh][qg] - mnew);
                    mrun[wh][qg] = mnew;
                    lrun[wh][qg] *= alpha;
#pragma unroll
                    for (int dg = 0; dg < 8; ++dg)
#pragma unroll
                        for (int j = 0; j < 4; ++j) O[wh][dg][qg][j] *= alpha;
                }
                const float mref = mrun[wh][qg];
                float ps = 0.f;
#pragma unroll
                for (int kg = 0; kg < 4; ++kg)
#pragma unroll
                    for (int j = 0; j < 4; ++j) { float pv = __builtin_amdgcn_exp2f(S[kg][qg][j] * L2E - mref); ps += pv; S[kg][qg][j] = pv; }
                lrun[wh][qg] += ps;
#pragma unroll
                for (int s_ = 0; s_ < 2; ++s_) {
                    u32x4 pk; pk[0] = pack2(S[2 * s_][qg][0], S[2 * s_][qg][1]); pk[1] = pack2(S[2 * s_][qg][2], S[2 * s_][qg][3]);
                    pk[2] = pack2(S[2 * s_ + 1][qg][0], S[2 * s_ + 1][qg][1]); pk[3] = pack2(S[2 * s_ + 1][qg][2], S[2 * s_ + 1][qg][3]);
                    Pf[qg][s_] = __builtin_bit_cast(bf16x8, pk);
                }
            }
#pragma unroll
            for (int dg = 0; dg < 8; ++dg)
#pragma unroll
                for (int s_ = 0; s_ < 2; ++s_) {
                    bf16x8 vf = *(const bf16x8*)(Vb + (dg * 16 + l15) * 72 + s_ * 32 + quad * 8);
                    O[wh][dg][0] = mfma16(vf, Pf[0][s_], O[wh][dg][0]);
                    O[wh][dg][1] = mfma16(vf, Pf[1][s_], O[wh][dg][1]);
                }
        }
        if (t + 1 < nt_keys) {
            bf16_t* Kn = K_s + ((t + 1) & 1) * (64 * 136); bf16_t* Vn = V_s + ((t + 1) & 1) * (128 * 72);
#pragma unroll
            for (int i = 0; i < 4; ++i) { *(u32x4*)(Kn + kpos * 136 + kseg + i * 8) = kreg[i]; *(u32x4*)(Vn + vr * 72 + vh + i * 8) = vreg[i]; }
        }
        __syncthreads();
    }
    const float* dnw = p.in[I_DANORM] + l * 128;
#pragma unroll
    for (int qg = 0; qg < 2; ++qg) {
        float l1 = lrun[0][qg], l2 = lrun[1][qg];
        l1 += __shfl_xor(l1, 16); l1 += __shfl_xor(l1, 32); l2 += __shfl_xor(l2, 16); l2 += __shfl_xor(l2, 32);
        const float i1 = 1.f / l1, i2 = lam / l2;
        float ss = 0.f;
#pragma unroll
        for (int dg = 0; dg < 8; ++dg)
#pragma unroll
            for (int j = 0; j < 4; ++j) { float o = O[0][dg][qg][j] * i1 - O[1][dg][qg][j] * i2; O[0][dg][qg][j] = o; ss += o * o; }
        ss += __shfl_xor(ss, 16); ss += __shfl_xor(ss, 32);
        const float rstd = rsqrtf(ss * (1.f / 128.f) + 1e-5f) * (1.f - lam_init);
        bf16_t* op = P + ((size_t)b * SB + qt * 128 + wv * 32 + qg * 16 + l15) * PW + C_DAQ + h * 128;
#pragma unroll
        for (int dg = 0; dg < 8; ++dg) {
            const int dv0 = dg * 16 + quad * 4;
            u32x2 o; o.x = pack2(O[0][dg][qg][0] * rstd * dnw[dv0], O[0][dg][qg][1] * rstd * dnw[dv0 + 1]);
            o.y = pack2(O[0][dg][qg][2] * rstd * dnw[dv0 + 2], O[0][dg][qg][3] * rstd * dnw[dv0 + 3]);
            *(u32x2*)(op + dv0) = o;
        }
    }
}

DEV void phase_mix(const Params& p, int l, unsigned char* smem) {
    const bool need_ctx = l == 0;
    const float lam_init = l == 0 ? 0.2f : 0.35550906759096926f;
    unsigned* ctr = (unsigned*)(p.ws + O_CTL) + l;
    unsigned* actr = (unsigned*)(p.ws + O_CTL) + 16 + l * 8;
    __shared__ int s_item;
    const int nqt = need_ctx ? 34 : 32;
    auto next = [&](unsigned* c) -> int {
        __syncthreads();
        if (threadIdx.x == 0) s_item = (int)atomicAdd(c, 1u);
        __syncthreads();
        return __builtin_amdgcn_readfirstlane(s_item);
    };
    int it = next(ctr);
#pragma unroll 1
    while (it < 64) { dn_item(p, l, it, smem); it = next(ctr); }
#pragma unroll 1
    while (it < 128) { lru_item(p, l, it - 64, smem); it = next(ctr); }
    const int myx = blockIdx.x & 7;
#pragma unroll 1
    for (int k = 0; k < 8; ++k) {
        const int x = (myx + k) & 7;
        it = next(actr + x);
#pragma unroll 1
        while (it < 4 * nqt) {
            const int bh = x + 8 * (it / nqt), idx = it % nqt;
            const int qt = idx < 32 ? idx + 2 : idx - 32;
            att_item(p, l, bh >> 2, bh & 3, qt, lam_init, smem);
            it = next(actr + x);
        }
    }
}

#define XB_TMO      128
#define XB_XCNT(j)  (256  + 64 * (j))
#define XB_XSUB(j)  (1280 + 64 * (j))
#define XB_XGEN(j)  (2304 + 64 * (j))
#define XB_TOP      3328
#define XB_TOPGEN   3392
#define XCD_BAR_WORDS 3456
#define XB_SPIN_CAP (1u << 18)
#define LAS __attribute__((address_space(3)))
DEV unsigned xb_ld(unsigned* p)              { return __hip_atomic_load(p, __ATOMIC_RELAXED, __HIP_MEMORY_SCOPE_AGENT); }
DEV unsigned xb_add(unsigned* p, unsigned v) { return __hip_atomic_fetch_add(p, v, __ATOMIC_RELAXED, __HIP_MEMORY_SCOPE_AGENT); }
DEV unsigned xb_xcc_id() { return (unsigned)__builtin_amdgcn_s_getreg((3 << 11) | 20) & 0xFu; }
#define XB_SPIN(cond, bar) do { unsigned _sp = 0; while (cond) { __builtin_amdgcn_s_sleep(1); \
    if ((++_sp & 255u) == 0u) { if (xb_ld(&(bar)[XB_TMO])) break; if (_sp > XB_SPIN_CAP) { atomicAdd(&(bar)[XB_TMO], 1u); break; } } } } while (0)
struct XcdBarrier { unsigned* bar; unsigned x; volatile LAS unsigned* st; };
DEV XcdBarrier xcd_barrier_post(unsigned* bar, volatile LAS unsigned* st) {
    XcdBarrier b; b.bar = bar; b.x = xb_xcc_id(); b.st = st;
    if (threadIdx.x == 0) (void)xb_add(&bar[XB_XCNT(b.x)], 1u);
    return b;
}
DEV void xcd_barrier_complete(unsigned* bar, unsigned x, unsigned& nloc, unsigned& nx) {
    const unsigned G = gridDim.x * gridDim.y * gridDim.z;
    unsigned sum, cnt, mine, sp = 0u;
    for (;;) {
        sum = 0u; cnt = 0u; mine = 0u;
#pragma unroll
        for (unsigned j = 0; j < 16; ++j) { const unsigned c = xb_ld(&bar[XB_XCNT(j)]); sum += c; cnt += (c > 0u) ? 1u : 0u; mine = (j == x) ? c : mine; }
        if (sum == G) break;
        __builtin_amdgcn_s_sleep(1);
        if ((++sp & 255u) == 0u) { if (xb_ld(&bar[XB_TMO])) break; if (sp > XB_SPIN_CAP) { atomicAdd(&bar[XB_TMO], 1u); break; } }
    }
    nloc = mine > 0u ? mine : 1u; nx = cnt > 0u ? cnt : 1u;
}
DEV void xcd_barrier(const XcdBarrier& b) {
    asm volatile("s_waitcnt vmcnt(0)" ::: "memory");
    __syncthreads();
    if (threadIdx.x == 0) {
        unsigned* bar = b.bar;
        __builtin_amdgcn_s_waitcnt(0);
        unsigned nloc = b.st[0], nx = b.st[1];
        if (nloc == 0u) { xcd_barrier_complete(bar, b.x, nloc, nx); b.st[0] = nloc; b.st[1] = nx; }
        const unsigned old = xb_add(&bar[XB_XSUB(b.x)], 1u);
        const unsigned gen = old / nloc;
        if (old + 1u == (gen + 1u) * nloc) {
            __builtin_amdgcn_fence(__ATOMIC_RELEASE, "agent");
            asm volatile("s_waitcnt vmcnt(0)" ::: "memory");
            const unsigned og = xb_add(&bar[XB_TOP], 1u);
            const unsigned tg = og / nx;
            if (og + 1u == (tg + 1u) * nx) xb_add(&bar[XB_TOPGEN], 1u);
            else XB_SPIN(xb_ld(&bar[XB_TOPGEN]) == tg, bar);
            __builtin_amdgcn_fence(__ATOMIC_ACQUIRE, "agent");
            xb_add(&bar[XB_XGEN(b.x)], 1u);
            asm volatile("s_waitcnt vmcnt(0)" ::: "memory");
        } else {
            XB_SPIN(xb_ld(&bar[XB_XGEN(b.x)]) == gen, bar);
            __builtin_amdgcn_fence(__ATOMIC_ACQUIRE, "agent");
            asm volatile("s_waitcnt vmcnt(0)" ::: "memory");
        }
    }
    __syncthreads();
}

constexpr int NPHASE = 1 + 2 * 9 + 1;
DEV void run_phase(const Params& p, int ph, unsigned char* smem) {
    if (ph == 0) { phase_mod(p, smem); phase_rope(p); __syncthreads(); phase_wconv(p, 0, smem); return; }
    if (ph == NPHASE - 1) { phase_final(p); return; }
    const int l = (ph - 1) / 9, q = (ph - 1) % 9;
    const bool first = l == 0, lat = l == 1;
    const bf16_t* W = wsb(p, O_WT);
    switch (q) {
        case 0: if (l == 1) phase_wconv(p, 1, smem); phase_norm(p, l, 0, first, false); break;
        case 1: phase_g1(p, smem); break;
        case 2: phase_mix(p, l, smem); break;
        case 3: phase_fin_norm(p, l, first, lat); break;
        case 4: phase_gate(p, lat, smem); break;
        case 5: phase_resid(p, l, wsb(p, O_U), D, W + W_OUT, 1024, 2, first, lat, smem); break;
        case 6: phase_norm(p, l, 1, false, lat); break;
        case 7: phase_gu(p, lat, smem); break;
        case 8: phase_resid(p, l, wsb(p, O_P), PW, W + W_DN, DFF, 5, false, lat, smem); break;
    }
}

#if MEGA
__global__ void __launch_bounds__(256) mega_kernel(Params p) {
    extern __shared__ __align__(16) unsigned char smem[];
    cg::grid_group grid = cg::this_grid();
    __shared__ uint4 xb_words;
    if (threadIdx.x == 0) xb_words = make_uint4(0u, 0u, 0u, 0u);
    __syncthreads();
    const XcdBarrier xb = xcd_barrier_post((unsigned*)(p.ws + O_BAR), (volatile LAS unsigned*)&xb_words);
    phase_mod(p, smem); phase_rope(p); __syncthreads(); phase_wconv(p, 0, smem);
    grid.sync();
    const bf16_t* W = wsb(p, O_WT);
#pragma unroll
    for (int l = 0; l < 2; ++l) {
        const bool first = l == 0, lat = l == 1;
        if (l == 1) phase_wconv(p, 1, smem);
        phase_norm(p, l, 0, first, false);
        xcd_barrier(xb);
        phase_g1(p, smem);
        xcd_barrier(xb);
        phase_mix(p, l, smem);
        xcd_barrier(xb);
        phase_fin_norm(p, l, first, lat);
        xcd_barrier(xb);
        phase_gate(p, lat, smem);
        xcd_barrier(xb);
        phase_merge(p, lat, smem);
        xcd_barrier(xb);
        phase_resid(p, l, wsb(p, O_U), D, W + W_OUT, 1024, 2, first, lat, smem);
        xcd_barrier(xb);
        phase_norm(p, l, 1, false, lat);
        xcd_barrier(xb);
        phase_gu(p, lat, smem);
        xcd_barrier(xb);
        phase_resid(p, l, wsb(p, O_P), PW, W + W_DN, DFF, 5, false, lat, smem);
        xcd_barrier(xb);
    }
    phase_final(p);
}
#else
__global__ void __launch_bounds__(256) phase_kernel(Params p, int ph) {
    extern __shared__ __align__(16) unsigned char smem[];
    run_phase(p, ph, smem);
}
#endif

extern "C" void kernel_launch(void* const* d_in, const int* in_sizes, int n_in, void* d_out, int out_size, void* d_ws, size_t ws_size, hipStream_t stream) {
    static int grid = 0;
    if (grid == 0) {
        if (n_in != 28 || ws_size < WS_END) { fprintf(stderr, "kernel_launch: unexpected n_in %d or ws_size %zu < %zu\n", n_in, ws_size, (size_t)WS_END); grid = -1; return; }
        int dev = 0, cus = 0, per_cu = 0;
        hipGetDevice(&dev);
        hipDeviceGetAttribute(&cus, hipDeviceAttributeMultiprocessorCount, dev);
#if MEGA
        hipFuncSetAttribute((const void*)mega_kernel, hipFuncAttributeMaxDynamicSharedMemorySize, LDS_BYTES);
        hipOccupancyMaxActiveBlocksPerMultiprocessor(&per_cu, (const void*)mega_kernel, 256, LDS_BYTES);
#else
        hipFuncSetAttribute((const void*)phase_kernel, hipFuncAttributeMaxDynamicSharedMemorySize, LDS_BYTES);
        hipOccupancyMaxActiveBlocksPerMultiprocessor(&per_cu, (const void*)phase_kernel, 256, LDS_BYTES);
#endif
        if (per_cu < 1) per_cu = 1;
        grid = cus * per_cu;
        fprintf(stderr, "kernel_launch: grid %d (%d CUs x %d)\n", grid, cus, per_cu);
    }
    if (grid < 0) return;
    hipMemsetAsync((char*)d_ws + O_CTL, 0, 4096 + 16384, stream);
    Params p{};
    for (int i = 0; i < 28; ++i) p.in[i] = (const float*)d_in[i];
    p.out = (float*)d_out; p.ws = (unsigned char*)d_ws;
#if MEGA
    void* args[] = {&p};
    hipError_t e = hipLaunchCooperativeKernel((const void*)mega_kernel, dim3(grid), dim3(256), args, LDS_BYTES, stream);
    if (e != hipSuccess) fprintf(stderr, "cooperative launch failed: %s (grid %d)\n", hipGetErrorString(e), grid);
#else
    for (int ph = 0; ph < NPHASE; ++ph) hipLaunchKernelGGL(phase_kernel, dim3(grid), dim3(256), LDS_BYTES, stream, p, ph);
#endif
}
```

```cpp
#include <hip/hip_runtime.h>
#include <hip/hip_cooperative_groups.h>
#include <cstdio>
#include <cstdint>
namespace cg = cooperative_groups;

#ifndef MEGA
#define MEGA 1
#endif

typedef unsigned short bf16_t;
typedef short bf16x8 __attribute__((ext_vector_type(8)));
typedef float f32x4 __attribute__((ext_vector_type(4)));
typedef unsigned u32x4 __attribute__((ext_vector_type(4)));
typedef unsigned u32x2 __attribute__((ext_vector_type(2)));
#define DEV __device__ __forceinline__

constexpr int D = 1024, NB = 8, SEQ = 4096, CTXL = 256, SB = 4352, MR = NB * SB, PW = 4096, DFF = 2816;
constexpr int C_DNQ = 0, C_DNK = 512, C_DNV = 1024, C_DNZ = 1536, C_LX = 2048, C_LG = 2560, C_DAQ = 3072, C_DAK = 3584;
constexpr int NIN = 4736;
constexpr int GLD = 80;

enum { I_X = 0, I_C, I_CTX, I_CCTX, I_WMOD, I_BMOD, I_NMIX, I_NFFN, I_WIN, I_DNCONV, I_DNALOG, I_DNDT, I_DNNORM, I_LCW, I_LCB,
       I_LWA, I_LBA, I_LWI, I_LBI, I_LLAM, I_DALAM, I_DANORM, I_WBR, I_WOUT, I_WFG, I_WFU, I_WFD, I_NFIN };

constexpr size_t al256(size_t x) { return (x + 255) & ~(size_t)255; }
constexpr size_t O_CTL = 0;
constexpr size_t O_BAR = 4096;
constexpr size_t O_MOD = 4096 + 16384;
constexpr size_t O_ROPE = al256(O_MOD + (size_t)2 * 9 * 6144 * 4);
constexpr size_t O_WT = al256(O_ROPE + 64 * 16 * 2 * 4);
constexpr size_t W_IN = 0, W_GATE = W_IN + (size_t)NIN * 1024, W_BR = W_GATE + (size_t)3072 * 1024, W_OUT = W_BR + (size_t)3 * 1024 * 512,
                 W_GU = W_OUT + (size_t)1024 * 1024, W_DN = W_GU + (size_t)5632 * 1024, W_END = W_DN + (size_t)1024 * 2816;
constexpr size_t O_HCTX = al256(O_WT + W_END * 2);
constexpr size_t O_U = al256(O_HCTX + (size_t)2048 * 1024 * 4);
constexpr size_t O_P = al256(O_U + (size_t)MR * 1024 * 2);
constexpr size_t O_AB = al256(O_P + (size_t)MR * PW * 2);
constexpr size_t O_TA = al256(O_AB + (size_t)MR * 16 * 4);
constexpr size_t O_TA2 = al256(O_TA + (size_t)MR * 512 * 2);
constexpr size_t O_VT = al256(O_TA2 + (size_t)MR * 512 * 2);
constexpr size_t WS_END = al256(O_VT + (size_t)MR * 512 * 2);

constexpr int LDS_BYTES = 140 * 1024;

struct Params {
    const float* in[28];
    float* out;
    unsigned char* ws;
};

DEV int get_tid() { int t = threadIdx.x; asm volatile("" : "+v"(t)); return t; }
DEV float bf2f(bf16_t h) { return __uint_as_float(((unsigned)h) << 16); }
DEV bf16_t f2bf(float f) { unsigned u = __float_as_uint(f); u += 0x7fffu + ((u >> 16) & 1u); return (bf16_t)(u >> 16); }
typedef float f32x2_ __attribute__((ext_vector_type(2)));
typedef __bf16 bf16x2_ __attribute__((ext_vector_type(2)));
DEV unsigned pack2(float a, float b) { const f32x2_ v = {a, b}; return __builtin_bit_cast(unsigned, __builtin_convertvector(v, bf16x2_)); }
DEV float sigm(float x) { return __builtin_amdgcn_rcpf(1.f + __expf(-x)); }
DEV float silu(float x) { return x * __builtin_amdgcn_rcpf(1.f + __expf(-x)); }
DEV float softplus(float x) { return x > 20.f ? x : log1pf(expf(x)); }
DEV float softplus_fast(float x) { const float e = __expf(x); return x > 15.f ? x : (e < 0.01f ? e * (1.f - e * (0.5f - e * 0.33333333f)) : __logf(1.f + e)); }
DEV float gelu_tanh(float x) { float u = 0.7978845608028654f * (x + 0.044715f * x * x * x); float t = 1.f - 2.f * __builtin_amdgcn_rcpf(1.f + __expf(2.f * u)); return 0.5f * x * (1.f + t); }
DEV f32x4 mfma16(bf16x8 a, bf16x8 b, f32x4 c) { return __builtin_amdgcn_mfma_f32_16x16x32_bf16(a, b, c, 0, 0, 0); }
DEV void mfma16a(f32x4& c, bf16x8 a, bf16x8 b) { asm volatile("v_mfma_f32_16x16x32_bf16 %0, %1, %2, %0" : "+a"(c) : "v"(a), "v"(b)); }
DEV float lo16(unsigned v) { return __uint_as_float(v << 16); }
DEV float hi16(unsigned v) { return __uint_as_float(v & 0xffff0000u); }

DEV bf16_t* wsb(const Params& p, size_t off) { return (bf16_t*)(p.ws + off); }
DEV float* wsf(const Params& p, size_t off) { return (float*)(p.ws + off); }
DEV float* hrow(const Params& p, int r) { int b = r / SB, s = r - b * SB; return s < CTXL ? wsf(p, O_HCTX) + (size_t)(b * CTXL + s) * D : p.out + (size_t)(b * SEQ + s - CTXL) * D; }
DEV const float* xrow(const Params& p, int r) { int b = r / SB, s = r - b * SB; return s < CTXL ? p.in[I_CTX] + (size_t)(b * CTXL + s) * D : p.in[I_X] + (size_t)(b * SEQ + s - CTXL) * D; }
DEV int modrow(int r) { int b = r / SB, s = r - b * SB; return s < CTXL ? 8 : b; }

template <int MT, int NT>
DEV void gemm_core(const bf16_t* __restrict__ A, int lda, const bf16_t* __restrict__ Bt, int ldb, int K, f32x4 (&acc)[MT][NT], bf16_t* smem_) {
    constexpr int SA = 32 * MT * GLD, SBB = 32 * NT * GLD;
    bf16_t* sA = smem_; bf16_t* sB = smem_ + 2 * SA;
    const int tid = get_tid(), lane = tid & 63, wv = tid >> 6, wr = wv >> 1, wc = wv & 1, l15 = lane & 15, quad = lane >> 4;
    const int lr = tid >> 3, lc = (tid & 7) * 8;
    u32x4 ra0[MT], rb0[NT], ra1[MT], rb1[NT];
    const bf16_t* Ap = A + (size_t)lr * lda + lc;
    const bf16_t* Bp = Bt + (size_t)lr * ldb + lc;
    const int nk = K >> 6;
#define GLOAD(RA, RB, KT) { const int ko_ = (KT) * 64; _Pragma("unroll") for (int i = 0; i < MT; ++i) RA[i] = *(const u32x4*)(Ap + (size_t)(32 * i) * lda + ko_); \
                            _Pragma("unroll") for (int i = 0; i < NT; ++i) RB[i] = *(const u32x4*)(Bp + (size_t)(32 * i) * ldb + ko_); }
#define LSTORE(RA, RB, BUF) { _Pragma("unroll") for (int i = 0; i < MT; ++i) *(u32x4*)(sA + (BUF) * SA + (lr + 32 * i) * GLD + lc) = RA[i]; \
                              _Pragma("unroll") for (int i = 0; i < NT; ++i) *(u32x4*)(sB + (BUF) * SBB + (lr + 32 * i) * GLD + lc) = RB[i]; }
#define AFRAG(BUF, MT_, KS) (*(const bf16x8*)(sA + (BUF) * SA + (wr * MT * 16 + (MT_) * 16 + l15) * GLD + (KS) * 32 + quad * 8))
#define HALF(BUFC, RA, RB, BUFS, DO_STORE, DO_LOAD, KT) { \
        bf16x8 bfr[2][NT]; \
        _Pragma("unroll") for (int ks = 0; ks < 2; ++ks) _Pragma("unroll") for (int nt = 0; nt < NT; ++nt) \
            bfr[ks][nt] = *(const bf16x8*)(sB + (BUFC) * SBB + (wc * NT * 16 + nt * 16 + l15) * GLD + ks * 32 + quad * 8); \
        bf16x8 a0 = AFRAG(BUFC, 0, 0), a1 = AFRAG(BUFC, 0, 1); \
        const int ko_ = (KT) * 64; \
        _Pragma("unroll") for (int mt = 0; mt < MT; ++mt) { \
            bf16x8 n0 = a0, n1 = a1; \
            if (mt + 1 < MT) { n0 = AFRAG(BUFC, mt + 1, 0); n1 = AFRAG(BUFC, mt + 1, 1); } \
            if (DO_STORE) { *(u32x4*)(sA + (BUFS) * SA + (lr + 32 * mt) * GLD + lc) = RA[mt]; } \
            if (DO_LOAD) { RA[mt] = *(const u32x4*)(Ap + (size_t)(32 * mt) * lda + ko_); } \
            _Pragma("unroll") for (int nt = 0; nt < NT; ++nt) mfma16a(acc[mt][nt], bfr[0][nt], a0); \
            if (DO_STORE) { if (mt < NT) *(u32x4*)(sB + (BUFS) * SBB + (lr + 32 * mt) * GLD + lc) = RB[mt]; } \
            if (DO_LOAD) { if (mt < NT) RB[mt] = *(const u32x4*)(Bp + (size_t)(32 * mt) * ldb + ko_); } \
            _Pragma("unroll") for (int nt = 0; nt < NT; ++nt) mfma16a(acc[mt][nt], bfr[1][nt], a1); \
            a0 = n0; a1 = n1; \
        } }
    static_assert(NT <= MT, "HALF stages the B pieces alongside the first NT A pieces");
    GLOAD(ra0, rb0, 0);
    GLOAD(ra1, rb1, 1);
    __syncthreads();
    LSTORE(ra0, rb0, 0);
    GLOAD(ra0, rb0, 2);
    __syncthreads();
    int kt = 0;
#pragma unroll 1
    for (; kt + 4 < nk; kt += 2) {
        HALF(0, ra1, rb1, 1, true, true, kt + 3);
        __syncthreads();
        HALF(1, ra0, rb0, 0, true, true, kt + 4);
        __syncthreads();
    }
    HALF(0, ra1, rb1, 1, true, true, kt + 3);
    __syncthreads();
    HALF(1, ra0, rb0, 0, true, false, 0);
    __syncthreads();
    HALF(0, ra1, rb1, 1, true, false, 0);
    __syncthreads();
    HALF(1, ra0, rb0, 0, false, false, 0);
    __syncthreads();
#undef AFRAG
#undef HALF
#undef GLOAD
#undef LSTORE
    static_assert(NT == 4, "the accumulator fence is written for NT == 4");
#pragma unroll
    for (int mt = 0; mt < MT; ++mt) {
        if (mt == 0) asm volatile("s_nop 15\n\ts_nop 15" : "+a"(acc[mt][0]), "+a"(acc[mt][1]), "+a"(acc[mt][2]), "+a"(acc[mt][3]));
        else asm volatile("s_nop 0" : "+a"(acc[mt][0]), "+a"(acc[mt][1]), "+a"(acc[mt][2]), "+a"(acc[mt][3]));
    }
}
template <int MT, int NT>
DEV void gemm_core1(const bf16_t* __restrict__ A, int lda, const bf16_t* __restrict__ Bt, int ldb, int K, f32x4 (&acc)[MT][NT], bf16_t* sA, bf16_t* sB) {
    const int tid = get_tid(), lane = tid & 63, wv = tid >> 6, wr = wv >> 1, wc = wv & 1, l15 = lane & 15, quad = lane >> 4;
    const int lr = tid >> 3, lc = (tid & 7) * 8;
    u32x4 ra[MT], rb[NT];
    const bf16_t* Ap = A + (size_t)lr * lda + lc;
    const bf16_t* Bp = Bt + (size_t)lr * ldb + lc;
#pragma unroll
    for (int i = 0; i < MT; ++i) ra[i] = *(const u32x4*)(Ap + (size_t)(32 * i) * lda);
#pragma unroll
    for (int i = 0; i < NT; ++i) rb[i] = *(const u32x4*)(Bp + (size_t)(32 * i) * ldb);
    const int nk = K >> 6;
    for (int kt = 0; kt < nk; ++kt) {
        __syncthreads();
#pragma unroll
        for (int i = 0; i < MT; ++i) *(u32x4*)(sA + (lr + 32 * i) * GLD + lc) = ra[i];
#pragma unroll
        for (int i = 0; i < NT; ++i) *(u32x4*)(sB + (lr + 32 * i) * GLD + lc) = rb[i];
        __syncthreads();
        if (kt + 1 < nk) {
            const int ko = (kt + 1) * 64;
#pragma unroll
            for (int i = 0; i < MT; ++i) ra[i] = *(const u32x4*)(Ap + (size_t)(32 * i) * lda + ko);
#pragma unroll
            for (int i = 0; i < NT; ++i) rb[i] = *(const u32x4*)(Bp + (size_t)(32 * i) * ldb + ko);
        }
#pragma unroll
        for (int ks = 0; ks < 2; ++ks) {
            bf16x8 af[MT], bfr[NT];
#pragma unroll
            for (int mt = 0; mt < MT; ++mt) af[mt] = *(const bf16x8*)(sA + (wr * MT * 16 + mt * 16 + l15) * GLD + ks * 32 + quad * 8);
#pragma unroll
            for (int nt = 0; nt < NT; ++nt) bfr[nt] = *(const bf16x8*)(sB + (wc * NT * 16 + nt * 16 + l15) * GLD + ks * 32 + quad * 8);
#pragma unroll
            for (int mt = 0; mt < MT; ++mt)
#pragma unroll
                for (int nt = 0; nt < NT; ++nt) mfma16a(acc[mt][nt], bfr[nt], af[mt]);
        }
    }
    static_assert(NT == 4, "the accumulator fence is written for NT == 4");
#pragma unroll
    for (int mt = 0; mt < MT; ++mt) {
        if (mt == 0) asm volatile("s_nop 15\n\ts_nop 15" : "+a"(acc[mt][0]), "+a"(acc[mt][1]), "+a"(acc[mt][2]), "+a"(acc[mt][3]));
        else asm volatile("s_nop 0" : "+a"(acc[mt][0]), "+a"(acc[mt][1]), "+a"(acc[mt][2]), "+a"(acc[mt][3]));
    }
}
template <int MT, int NT>
DEV void zero_acc(f32x4 (&acc)[MT][NT]) {
#pragma unroll
    for (int mt = 0; mt < MT; ++mt)
#pragma unroll
        for (int nt = 0; nt < NT; ++nt) acc[mt][nt] = (f32x4){0.f, 0.f, 0.f, 0.f};
}

DEV void phase_mod(const Params& p, unsigned char* smem) {
    float* s_s = (float*)smem;
    float* red = s_s + 9 * 1024;
    const int tid = get_tid();
    bool loaded = false;
    for (int it = blockIdx.x; it < 2 * 96; it += gridDim.x) {
        if (!loaded) {
            for (int e = tid; e < 9 * 1024; e += 256) { float v = e < 8192 ? p.in[I_C][e] : p.in[I_CCTX][e - 8192]; s_s[e] = silu(v); }
            loaded = true;
        }
        __syncthreads();
        const int l = it / 96, cg_ = it % 96, cq = tid & 63, kq = tid >> 6, col = cg_ * 64 + cq;
        float acc[9];
#pragma unroll
        for (int r = 0; r < 9; ++r) acc[r] = 0.f;
        const float* wp = p.in[I_WMOD] + ((size_t)l * 1024 + kq * 256) * 6144 + col;
#pragma unroll 8
        for (int k = 0; k < 256; ++k) {
            float wv = wp[(size_t)k * 6144];
#pragma unroll
            for (int r = 0; r < 9; ++r) acc[r] += s_s[r * 1024 + kq * 256 + k] * wv;
        }
#pragma unroll
        for (int r = 0; r < 9; ++r) red[(kq * 9 + r) * 64 + cq] = acc[r];
        __syncthreads();
        for (int e = tid; e < 9 * 64; e += 256) {
            int r = e >> 6, c2 = e & 63;
            float v = red[(0 * 9 + r) * 64 + c2] + red[(1 * 9 + r) * 64 + c2] + red[(2 * 9 + r) * 64 + c2] + red[(3 * 9 + r) * 64 + c2];
            wsf(p, O_MOD)[((size_t)l * 9 + r) * 6144 + cg_ * 64 + c2] = v + p.in[I_BMOD][l * 6144 + cg_ * 64 + c2];
        }
        __syncthreads();
    }
}
DEV void phase_rope(const Params& p) {
    if (blockIdx.x == (gridDim.x - 1)) {
        for (int e = threadIdx.x; e < 1024; e += 256) {
            int pos = e >> 4, i = e & 15;
            float inv = powf(10000.f, -(float)i / 16.f);
            float ang = (float)pos * inv;
            float n = rintf(ang * 0.15915494309189535f);
            float r = fmaf(-n, 6.28125f, ang);
            r = fmaf(-n, 1.9353071795864769e-3f, r);
            wsf(p, O_ROPE)[e * 2] = cosf(r);
            wsf(p, O_ROPE)[e * 2 + 1] = sinf(r);
        }
    }
}
DEV void wconv_tile(const float* src0, const float* src1, int lds_, int K, bf16_t* dst, int kind, int kt, int nt, bf16_t* tile) {
    const int tid = get_tid();
    const int kk = tid >> 2, grp = tid & 3;
    const int n0 = nt * 64, k0 = kt * 64;
    const int ng = n0 + grp * 16;
    const float* src = src0; int sc;
    if (kind == 0) { sc = ng < 2048 ? ng : (ng < 4608 ? ng + 16 : (ng < 4624 ? 2048 : -1)); }
    else if (kind == 1) { sc = 4624 + ng; }
    else if (kind == 2) { sc = ng; }
    else { int gd = ng >> 4; src = (gd & 1) ? src1 : src0; sc = (gd >> 1) * 16; }
    __syncthreads();
    if (sc >= 0) {
        const float4* sp = (const float4*)(src + (size_t)(k0 + kk) * lds_ + sc);
#pragma unroll
        for (int q = 0; q < 4; ++q) { float4 v = sp[q]; int e = grp * 16 + q * 4;
            tile[(e + 0) * GLD + kk] = f2bf(v.x); tile[(e + 1) * GLD + kk] = f2bf(v.y); tile[(e + 2) * GLD + kk] = f2bf(v.z); tile[(e + 3) * GLD + kk] = f2bf(v.w); }
    } else {
#pragma unroll
        for (int e = 0; e < 16; ++e) tile[(grp * 16 + e) * GLD + kk] = 0;
    }
    __syncthreads();
    const int n = tid >> 2, kseg = (tid & 3) * 16;
    u32x4 a = *(const u32x4*)(tile + n * GLD + kseg), b = *(const u32x4*)(tile + n * GLD + kseg + 8);
    bf16_t* dp = dst + (size_t)(n0 + n) * K + k0 + kseg;
    *(u32x4*)dp = a; *(u32x4*)(dp + 8) = b;
}
DEV void phase_wconv(const Params& p, int l, unsigned char* smem) {
    bf16_t* tile = (bf16_t*)smem;
    bf16_t* W = wsb(p, O_WT);
    constexpr int T0 = 74 * 16, T1 = T0 + 48 * 16, T2 = T1 + 3 * 16 * 8, T3 = T2 + 16 * 16, T4 = T3 + 88 * 16, T5 = T4 + 16 * 44;
    for (int t = blockIdx.x; t < T5; t += gridDim.x) {
        if (t < T0) { wconv_tile(p.in[I_WIN] + (size_t)l * 1024 * 7696, nullptr, 7696, 1024, W + W_IN, 0, t % 16, t / 16, tile); }
        else if (t < T1) { int u = t - T0; wconv_tile(p.in[I_WIN] + (size_t)l * 1024 * 7696, nullptr, 7696, 1024, W + W_GATE, 1, u % 16, u / 16, tile); }
        else if (t < T2) { int u = t - T1; int n = u / 128, v = u % 128; wconv_tile(p.in[I_WBR] + ((size_t)l * 3 + n) * 512 * 1024, nullptr, 1024, 512, W + W_BR + (size_t)n * 1024 * 512, 2, v % 8, v / 8, tile); }
        else if (t < T3) { int u = t - T2; wconv_tile(p.in[I_WOUT] + (size_t)l * 1024 * 1024, nullptr, 1024, 1024, W + W_OUT, 2, u % 16, u / 16, tile); }
        else if (t < T4) { int u = t - T3; wconv_tile(p.in[I_WFG] + (size_t)l * 1024 * DFF, p.in[I_WFU] + (size_t)l * 1024 * DFF, DFF, 1024, W + W_GU, 3, u % 16, u / 16, tile); }
        else { int u = t - T4; wconv_tile(p.in[I_WFD] + (size_t)l * DFF * 1024, nullptr, 1024, DFF, W + W_DN, 2, u % 44, u / 44, tile); }
    }
}

DEV void norm_row(const Params& p, int l, int which, bool first, int r, int lane) {
    const float* h = first ? xrow(p, r) : hrow(p, r);
    const float* nw = p.in[which ? I_NFFN : I_NMIX] + l * D;
    const float* md = wsf(p, O_MOD) + ((size_t)l * 9 + modrow(r)) * 6144 + (which ? 3 * D : 0);
    float4 v[4]; float ss = 0.f;
#pragma unroll
    for (int i = 0; i < 4; ++i) { v[i] = *(const float4*)(h + i * 256 + lane * 4); ss += v[i].x * v[i].x + v[i].y * v[i].y + v[i].z * v[i].z + v[i].w * v[i].w; }
#pragma unroll
    for (int o = 32; o >= 1; o >>= 1) ss += __shfl_xor(ss, o);
    const float rstd = rsqrtf(ss * (1.f / D) + 1e-6f);
    bf16_t* up = wsb(p, O_U) + (size_t)r * D;
#pragma unroll
    for (int i = 0; i < 4; ++i) {
        const int c = i * 256 + lane * 4;
        float4 w4 = *(const float4*)(nw + c), sh = *(const float4*)(md + c), sc = *(const float4*)(md + D + c);
        float a = v[i].x * rstd * w4.x * (1.f + sc.x) + sh.x, b = v[i].y * rstd * w4.y * (1.f + sc.y) + sh.y;
        float c2 = v[i].z * rstd * w4.z * (1.f + sc.z) + sh.z, d = v[i].w * rstd * w4.w * (1.f + sc.w) + sh.w;
        u32x2 o; o.x = pack2(a, b); o.y = pack2(c2, d);
        *(u32x2*)(up + c) = o;
    }
}
DEV void phase_norm(const Params& p, int l, int which, bool first, bool skip_ctx) {
    const int tid_ = get_tid(); const int lane = tid_ & 63, wv = tid_ >> 6;
    for (int r = blockIdx.x * 4 + wv; r < MR; r += gridDim.x * 4) {
        if (skip_ctx && (r % SB) < CTXL) continue;
        norm_row(p, l, which, first, r, lane);
    }
}
DEV void phase_fin_norm(const Params& p, int l, bool first, bool skip_ctx) {
    const int tid_ = get_tid(); const int lane = tid_ & 63, wv = tid_ >> 6;
    const float* dnn = p.in[I_DNNORM] + l * 128;
    for (int r = blockIdx.x * 4 + wv; r < MR; r += gridDim.x * 4) {
        if (skip_ctx && (r % SB) < CTXL) continue;
        norm_row(p, l, 0, first, r, lane);
        bf16_t* ta = wsb(p, O_TA) + (size_t)r * 512 + lane * 8;
        const bf16_t* tb = wsb(p, O_TA2) + (size_t)r * 512 + lane * 8;
        const bf16_t* zz = wsb(p, O_P) + (size_t)r * PW + C_DNZ + lane * 8;
        u32x4 a = *(const u32x4*)ta, b = *(const u32x4*)tb, z = *(const u32x4*)zz;
        float o[8]; float ss = 0.f;
#pragma unroll
        for (int i = 0; i < 4; ++i) { o[2 * i] = lo16(a[i]) + lo16(b[i]); o[2 * i + 1] = hi16(a[i]) + hi16(b[i]); ss += o[2 * i] * o[2 * i] + o[2 * i + 1] * o[2 * i + 1]; }
#pragma unroll
        for (int of = 8; of >= 1; of >>= 1) ss += __shfl_xor(ss, of);
        const float rstd = rsqrtf(ss * (1.f / 128.f) + 1e-6f);
        const int dv0 = (lane & 15) * 8;
        u32x4 y;
#pragma unroll
        for (int i = 0; i < 4; ++i) {
            float y0 = o[2 * i] * rstd * dnn[dv0 + 2 * i] * silu(lo16(z[i]));
            float y1 = o[2 * i + 1] * rstd * dnn[dv0 + 2 * i + 1] * silu(hi16(z[i]));
            y[i] = pack2(y0, y1);
        }
        *(u32x4*)ta = y;
    }
}
DEV void phase_final(const Params& p) {
    const int tid_ = get_tid(); const int lane = tid_ & 63, wv = tid_ >> 6;
    const float* nw = p.in[I_NFIN];
    for (int r = blockIdx.x * 4 + wv; r < NB * SEQ; r += gridDim.x * 4) {
        float* h = p.out + (size_t)r * D;
        float4 v[4]; float ss = 0.f;
#pragma unroll
        for (int i = 0; i < 4; ++i) { v[i] = *(const float4*)(h + i * 256 + lane * 4); ss += v[i].x * v[i].x + v[i].y * v[i].y + v[i].z * v[i].z + v[i].w * v[i].w; }
#pragma unroll
        for (int o = 32; o >= 1; o >>= 1) ss += __shfl_xor(ss, o);
        const float rstd = rsqrtf(ss * (1.f / D) + 1e-6f);
#pragma unroll
        for (int i = 0; i < 4; ++i) {
            const int c = i * 256 + lane * 4;
            float4 w4 = *(const float4*)(nw + c);
            float4 o4; o4.x = v[i].x * rstd * w4.x; o4.y = v[i].y * rstd * w4.y; o4.z = v[i].z * rstd * w4.z; o4.w = v[i].w * rstd * w4.w;
            *(float4*)(h + c) = o4;
        }
    }
}

struct TileIter {
    int nn, total, nloc, L;
    DEV TileIter(int nm, int nn_) { nn = nn_; total = nm * nn_; nloc = gridDim.x >> 3; L = (blockIdx.x & 7) * nloc + (blockIdx.x >> 3); }
    DEV bool valid() const { return L < total; }
    DEV bool more() const { return (L - (int)(blockIdx.x >> 3)) < total; }
    DEV void next() { L += 8 * nloc; }
    DEV void get(int& tm, int& tn) const { const int pn = 4 * nn, panel = L / pn, rem = L - panel * pn; tn = rem >> 2; tm = panel * 4 + (rem & 3); }
};
DEV void phase_g1(const Params& p, unsigned char* smem) {
    bf16_t* sA = (bf16_t*)smem;
    const int tid = get_tid(), lane = tid & 63, wv = tid >> 6, wr = wv >> 1, wc = wv & 1, l15 = lane & 15, quad = lane >> 4;
    const bf16_t* U = wsb(p, O_U); const bf16_t* W = wsb(p, O_WT) + W_IN;
    bf16_t* P = wsb(p, O_P);
    const float* rope = wsf(p, O_ROPE);
    constexpr int NTN = NIN / 128;
    const int wr0_ = wr, wc0_ = wc, l150_ = l15, quad0_ = quad;
    for (TileIter ti(MR / 256, NTN); ti.valid(); ti.next()) {
        int tm, tn; ti.get(tm, tn);
        const int row0 = tm * 256, col0 = tn * 128;
        f32x4 acc[8][4]; zero_acc(acc);
        gemm_core<8, 4>(U + (size_t)row0 * D, D, W + (size_t)col0 * D, D, D, acc, sA);
        int tz = 0; asm volatile("" : "+v"(tz));
        const int wr = wr0_ + tz, wc = wc0_ + tz, l15 = l150_ + tz, quad = quad0_ + tz;
        if (tn < 24) {
#pragma unroll
            for (int mt = 0; mt < 8; ++mt) {
                __builtin_amdgcn_sched_barrier(0);
                bf16_t* pp = P + (size_t)(row0 + wr * 128 + mt * 16 + l15) * PW + col0 + wc * 64 + quad * 4;
#pragma unroll
                for (int nt = 0; nt < 4; ++nt) { u32x2 o; o.x = pack2(acc[mt][nt][0], acc[mt][nt][1]); o.y = pack2(acc[mt][nt][2], acc[mt][nt][3]); *(u32x2*)(pp + nt * 16) = o; }
            }
        } else if (tn < 32) {
            const float qs = tn < 28 ? 0.125f : 1.f;
#pragma unroll
            for (int mt = 0; mt < 8; ++mt) {
                __builtin_amdgcn_sched_barrier(0);
                const int row = row0 + wr * 128 + mt * 16 + l15;
                const int s_ = row % SB;
                f32x4 ca = {1.f, 1.f, 1.f, 1.f}, sa = {0.f, 0.f, 0.f, 0.f}, cb = {1.f, 1.f, 1.f, 1.f}, sb = {0.f, 0.f, 0.f, 0.f};
                if (s_ >= CTXL) { const int tt = s_ - CTXL, pr = tt >> 6, pc = tt & 63;
                    const f32x4 r0 = *(const f32x4*)(rope + (pr * 16 + quad * 4) * 2), r1 = *(const f32x4*)(rope + (pr * 16 + quad * 4) * 2 + 4);
                    const f32x4 r2 = *(const f32x4*)(rope + (pc * 16 + quad * 4) * 2), r3 = *(const f32x4*)(rope + (pc * 16 + quad * 4) * 2 + 4);
                    ca = (f32x4){r0[0], r0[2], r1[0], r1[2]}; sa = (f32x4){r0[1], r0[3], r1[1], r1[3]};
                    cb = (f32x4){r2[0], r2[2], r3[0], r3[2]}; sb = (f32x4){r2[1], r2[3], r3[1], r3[3]}; }
                const f32x4 x1 = acc[mt][0], x2 = acc[mt][1], y1 = acc[mt][2], y2 = acc[mt][3];
                const f32x4 o0 = (x1 * ca - x2 * sa) * qs, o1 = (x2 * ca + x1 * sa) * qs, o2 = (y1 * cb - y2 * sb) * qs, o3 = (y2 * cb + y1 * sb) * qs;
                bf16_t* pp = P + (size_t)row * PW + col0 + wc * 64 + quad * 4;
                u32x2 o; o.x = pack2(o0[0], o0[1]); o.y = pack2(o0[2], o0[3]); *(u32x2*)(pp) = o;
                o.x = pack2(o1[0], o1[1]); o.y = pack2(o1[2], o1[3]); *(u32x2*)(pp + 16) = o;
                o.x = pack2(o2[0], o2[1]); o.y = pack2(o2[2], o2[3]); *(u32x2*)(pp + 32) = o;
                o.x = pack2(o3[0], o3[1]); o.y = pack2(o3[2], o3[3]); *(u32x2*)(pp + 48) = o;
            }
        } else if (tn < 36) {
            bf16_t* VT = wsb(p, O_VT);
            const int b = row0 / SB, sbase = row0 - b * SB;
#pragma unroll
            for (int mt = 0; mt < 8; ++mt) {
                __builtin_amdgcn_sched_barrier(0);
                const int s_ = sbase + wr * 128 + mt * 16 + l15;
                const int vi0 = (b * 512 + col0 - 4096 + wc * 64 + quad * 4) * SB + s_;
#pragma unroll
                for (int nt = 0; nt < 4; ++nt) {
                    const unsigned p01 = pack2(acc[mt][nt][0], acc[mt][nt][1]), p23 = pack2(acc[mt][nt][2], acc[mt][nt][3]);
                    VT[vi0 + (nt * 16 + 0) * SB] = (bf16_t)(p01 & 0xffffu); VT[vi0 + (nt * 16 + 1) * SB] = (bf16_t)(p01 >> 16);
                    VT[vi0 + (nt * 16 + 2) * SB] = (bf16_t)(p23 & 0xffffu); VT[vi0 + (nt * 16 + 3) * SB] = (bf16_t)(p23 >> 16);
                }
            }
        } else {
            if (wc == 0) {
                float* AB = wsf(p, O_AB);
#pragma unroll
                for (int mt = 0; mt < 8; ++mt) {
                    const int row = row0 + wr * 128 + mt * 16 + l15;
                    *(f32x4*)(AB + (size_t)row * 16 + quad * 4) = acc[mt][0];
                }
            }
        }
    }
}

DEV int rowtile0(int ti, bool latent_only) { if (!latent_only) return ti * 256; int b = ti >> 4, tt = ti & 15; return b * SB + CTXL + tt * 256; }
DEV int sgcol(int n, int c) { return n < 2 ? n * 1024 + c : (c < 512 ? 2048 + c : 3584 + (c - 512)); }

DEV void phase_gate(const Params& p, bool latent_only, unsigned char* smem) {
    bf16_t* sA = (bf16_t*)smem;
    const int tid = get_tid(), lane = tid & 63, wv = tid >> 6, wr = wv >> 1, wc = wv & 1, l15 = lane & 15, quad = lane >> 4;
    const bf16_t* U = wsb(p, O_U); const bf16_t* W = wsb(p, O_WT) + W_GATE;
    bf16_t* P = wsb(p, O_P);
    const int nrt = latent_only ? 128 : 136;
    for (TileIter ti(nrt, 24); ti.valid(); ti.next()) {
        int tm, tn; ti.get(tm, tn);
        const int row0 = rowtile0(tm, latent_only);
        f32x4 acc[8][4]; zero_acc(acc);
        gemm_core<8, 4>(U + (size_t)row0 * D, D, W + (size_t)tn * 128 * D, D, D, acc, sA);
        const int dcol0 = sgcol(tn >> 3, (tn & 7) * 128);
        bf16_t* ip = P + (size_t)(row0 + tid) * PW + dcol0;
#pragma unroll
        for (int mt = 0; mt < 8; ++mt) {
            __builtin_amdgcn_sched_barrier(0);
#pragma unroll
            for (int hf = 0; hf < 2; ++hf) {
                u32x4 o;
                o[0] = pack2(sigm(acc[mt][2 * hf][0]), sigm(acc[mt][2 * hf][1])); o[1] = pack2(sigm(acc[mt][2 * hf][2]), sigm(acc[mt][2 * hf][3]));
                o[2] = pack2(sigm(acc[mt][2 * hf + 1][0]), sigm(acc[mt][2 * hf + 1][1])); o[3] = pack2(sigm(acc[mt][2 * hf + 1][2]), sigm(acc[mt][2 * hf + 1][3]));
                *(u32x4*)(ip + (mt * 2 + hf) * 8) = o;
            }
        }
    }
}

DEV void phase_merge(const Params& p, bool latent_only, unsigned char* smem) {
    bf16_t* sA = (bf16_t*)smem;
    const int tid = get_tid(), lane = tid & 63, wv = tid >> 6, wr = wv >> 1, wc = wv & 1, l15 = lane & 15, quad = lane >> 4;
    const bf16_t* W = wsb(p, O_WT);
    const bf16_t* P = wsb(p, O_P);
    bf16_t* U = wsb(p, O_U);
    const int nrt = latent_only ? 128 : 136;
    for (TileIter ti(nrt, 8); ti.valid(); ti.next()) {
        int tm, tn; ti.get(tm, tn);
        const int row0 = rowtile0(tm, latent_only), col0 = tn * 128;
        f32x4 m[8][4]; zero_acc(m);
#pragma unroll 1
        for (int n = 0; n < 3; ++n) {
            f32x4 au[8][4]; zero_acc(au);
            const bf16_t* Y; int ldy;
            if (n == 0) { Y = wsb(p, O_TA) + (size_t)row0 * 512; ldy = 512; }
            else if (n == 1) { Y = P + (size_t)row0 * PW + C_LG; ldy = PW; }
            else { Y = P + (size_t)row0 * PW + C_DAQ; ldy = PW; }
            const int sc0 = sgcol(n, col0);
            gemm_core<8, 4>(Y, ldy, W + W_BR + ((size_t)n * 1024 + col0) * 512, 512, 512, au, sA);
            u32x4 sg[16];
            const bf16_t* ip = P + (size_t)(row0 + tid) * PW + sc0;
#pragma unroll
            for (int q = 0; q < 16; ++q) sg[q] = *(const u32x4*)(ip + q * 8);
#pragma unroll
            for (int mt = 0; mt < 8; ++mt)
#pragma unroll
                for (int nt = 0; nt < 4; ++nt) {
                    const unsigned g01 = sg[mt * 2 + (nt >> 1)][(nt & 1) * 2], g23 = sg[mt * 2 + (nt >> 1)][(nt & 1) * 2 + 1];
                    m[mt][nt][0] += lo16(g01) * au[mt][nt][0]; m[mt][nt][1] += hi16(g01) * au[mt][nt][1];
                    m[mt][nt][2] += lo16(g23) * au[mt][nt][2]; m[mt][nt][3] += hi16(g23) * au[mt][nt][3];
                }
        }
#pragma unroll
        for (int mt = 0; mt < 8; ++mt) {
            __builtin_amdgcn_sched_barrier(0);
            bf16_t* up = U + (size_t)(row0 + wr * 128 + mt * 16 + l15) * D + col0 + wc * 64 + quad * 4;
#pragma unroll
            for (int nt = 0; nt < 4; ++nt) { u32x2 o; o.x = pack2(m[mt][nt][0], m[mt][nt][1]); o.y = pack2(m[mt][nt][2], m[mt][nt][3]); *(u32x2*)(up + nt * 16) = o; }
        }
    }
}

DEV void phase_resid(const Params& p, int l, const bf16_t* A, int lda, const bf16_t* Wt, int K, int chunk, bool first, bool latent_only, unsigned char* smem) {
    bf16_t* sA = (bf16_t*)smem;
    const int tid = get_tid(), lane = tid & 63, wv = tid >> 6, wr = wv >> 1, wc = wv & 1, l15 = lane & 15, quad = lane >> 4;
    const int nrt = latent_only ? 128 : 136;
    for (TileIter ti(nrt, 8); ti.valid(); ti.next()) {
        int tm, tn; ti.get(tm, tn);
        const int row0 = rowtile0(tm, latent_only), col0 = tn * 128;
        f32x4 acc[8][4]; zero_acc(acc);
        gemm_core<8, 4>(A + (size_t)row0 * lda, lda, Wt + (size_t)col0 * K, K, K, acc, sA);
        const float* md = wsf(p, O_MOD) + ((size_t)l * 9 + modrow(row0)) * 6144 + chunk * D + col0 + wc * 64 + quad * 4;
        const float* hs0 = first ? xrow(p, row0) : hrow(p, row0);
        float* hd0 = hrow(p, row0);
        f32x4 mg[4];
#pragma unroll
        for (int nt = 0; nt < 4; ++nt) mg[nt] = *(const f32x4*)(md + nt * 16);
#pragma unroll
        for (int mt = 0; mt < 8; ++mt) {
            __builtin_amdgcn_sched_barrier(0);
            const size_t ro = (size_t)(wr * 128 + mt * 16 + l15) * D + col0 + wc * 64 + quad * 4;
#pragma unroll
            for (int nt = 0; nt < 4; ++nt) { const f32x4 h = *(const f32x4*)(hs0 + ro + nt * 16); *(f32x4*)(hd0 + ro + nt * 16) = h + mg[nt] * acc[mt][nt]; }
        }
    }
}
DEV void phase_gu(const Params& p, bool latent_only, unsigned char* smem) {
    bf16_t* sA = (bf16_t*)smem;
    const int tid = get_tid(), lane = tid & 63, wv = tid >> 6, wr = wv >> 1, wc = wv & 1, l15 = lane & 15, quad = lane >> 4;
    const bf16_t* U = wsb(p, O_U); const bf16_t* W = wsb(p, O_WT) + W_GU;
    bf16_t* P = wsb(p, O_P);
    const int nrt = latent_only ? 128 : 136;
    for (TileIter ti(nrt, 44); ti.valid(); ti.next()) {
        int tm, tn; ti.get(tm, tn);
        const int row0 = rowtile0(tm, latent_only);
        f32x4 acc[8][4]; zero_acc(acc);
        gemm_core<8, 4>(U + (size_t)row0 * D, D, W + (size_t)tn * 128 * D, D, D, acc, sA);
#pragma unroll
        for (int mt = 0; mt < 8; ++mt) {
            __builtin_amdgcn_sched_barrier(0);
            bf16_t* pp = P + (size_t)(row0 + wr * 128 + mt * 16 + l15) * PW + (tn * 4 + wc * 2) * 16 + quad * 4;
#pragma unroll
            for (int pr = 0; pr < 2; ++pr) {
                const f32x4 g = acc[mt][2 * pr], u = acc[mt][2 * pr + 1];
                u32x2 o; o.x = pack2(silu(g[0]) * u[0], silu(g[1]) * u[1]); o.y = pack2(silu(g[2]) * u[2], silu(g[3]) * u[3]);
                *(u32x2*)(pp + pr * 16) = o;
            }
        }
    }
}

DEV int chunk_of(int dir, int n) { return dir ? (n < 4 ? 3 - n : 71 - n) : n; }

typedef float f32x2 __attribute__((ext_vector_type(2)));
DEV void dn_solve(const float* __restrict__ Lt_s0, const bf16_t* __restrict__ colp, const float* __restrict__ mulp0, const float sg, bf16_t* __restrict__ outp) {
    int vz = 0; asm volatile("" : "+v"(vz));
    const float* __restrict__ Lt_s = Lt_s0 + vz; const float* __restrict__ mulp = mulp0 + vz;
    f32x2 X0, X1, X2, X3, X4, X5, X6, X7, X8, X9, X10, X11, X12, X13, X14, X15, X16, X17, X18, X19, X20, X21, X22, X23, X24, X25, X26, X27, X28, X29, X30, X31;
    f32x4 La0, La1, La2, La3, La4, La5, La6, La7, La8, La9, La10, La11, La12, La13, La14, La15, Lb0, Lb1, Lb2, Lb3, Lb4, Lb5, Lb6, Lb7, Lb8, Lb9, Lb10, Lb11, Lb12, Lb13, Lb14, Lb15;
    X0 = (f32x2){bf2f(colp[0]) * mulp[0], bf2f(colp[136]) * mulp[1]};
    X1 = (f32x2){bf2f(colp[272]) * mulp[2], bf2f(colp[408]) * mulp[3]};
    X2 = (f32x2){bf2f(colp[544]) * mulp[4], bf2f(colp[680]) * mulp[5]};
    X3 = (f32x2){bf2f(colp[816]) * mulp[6], bf2f(colp[952]) * mulp[7]};
    X4 = (f32x2){bf2f(colp[1088]) * mulp[8], bf2f(colp[1224]) * mulp[9]};
    X5 = (f32x2){bf2f(colp[1360]) * mulp[10], bf2f(colp[1496]) * mulp[11]};
    X6 = (f32x2){bf2f(colp[1632]) * mulp[12], bf2f(colp[1768]) * mulp[13]};
    X7 = (f32x2){bf2f(colp[1904]) * mulp[14], bf2f(colp[2040]) * mulp[15]};
    X8 = (f32x2){bf2f(colp[2176]) * mulp[16], bf2f(colp[2312]) * mulp[17]};
    X9 = (f32x2){bf2f(colp[2448]) * mulp[18], bf2f(colp[2584]) * mulp[19]};
    X10 = (f32x2){bf2f(colp[2720]) * mulp[20], bf2f(colp[2856]) * mulp[21]};
    X11 = (f32x2){bf2f(colp[2992]) * mulp[22], bf2f(colp[3128]) * mulp[23]};
    X12 = (f32x2){bf2f(colp[3264]) * mulp[24], bf2f(colp[3400]) * mulp[25]};
    X13 = (f32x2){bf2f(colp[3536]) * mulp[26], bf2f(colp[3672]) * mulp[27]};
    X14 = (f32x2){bf2f(colp[3808]) * mulp[28], bf2f(colp[3944]) * mulp[29]};
    X15 = (f32x2){bf2f(colp[4080]) * mulp[30], bf2f(colp[4216]) * mulp[31]};
    X16 = (f32x2){bf2f(colp[4352]) * mulp[32], bf2f(colp[4488]) * mulp[33]};
    X17 = (f32x2){bf2f(colp[4624]) * mulp[34], bf2f(colp[4760]) * mulp[35]};
    X18 = (f32x2){bf2f(colp[4896]) * mulp[36], bf2f(colp[5032]) * mulp[37]};
    X19 = (f32x2){bf2f(colp[5168]) * mulp[38], bf2f(colp[5304]) * mulp[39]};
    X20 = (f32x2){bf2f(colp[5440]) * mulp[40], bf2f(colp[5576]) * mulp[41]};
    X21 = (f32x2){bf2f(colp[5712]) * mulp[42], bf2f(colp[5848]) * mulp[43]};
    X22 = (f32x2){bf2f(colp[5984]) * mulp[44], bf2f(colp[6120]) * mulp[45]};
    X23 = (f32x2){bf2f(colp[6256]) * mulp[46], bf2f(colp[6392]) * mulp[47]};
    X24 = (f32x2){bf2f(colp[6528]) * mulp[48], bf2f(colp[6664]) * mulp[49]};
    X25 = (f32x2){bf2f(colp[6800]) * mulp[50], bf2f(colp[6936]) * mulp[51]};
    X26 = (f32x2){bf2f(colp[7072]) * mulp[52], bf2f(colp[7208]) * mulp[53]};
    X27 = (f32x2){bf2f(colp[7344]) * mulp[54], bf2f(colp[7480]) * mulp[55]};
    X28 = (f32x2){bf2f(colp[7616]) * mulp[56], bf2f(colp[7752]) * mulp[57]};
    X29 = (f32x2){bf2f(colp[7888]) * mulp[58], bf2f(colp[8024]) * mulp[59]};
    X30 = (f32x2){bf2f(colp[8160]) * mulp[60], bf2f(colp[8296]) * mulp[61]};
    X31 = (f32x2){bf2f(colp[8432]) * mulp[62], bf2f(colp[8568]) * mulp[63]};
    La0 = *(const f32x4*)(Lt_s + 0);
    La1 = *(const f32x4*)(Lt_s + 4);
    La2 = *(const f32x4*)(Lt_s + 8);
    La3 = *(const f32x4*)(Lt_s + 12);
    La4 = *(const f32x4*)(Lt_s + 16);
    La5 = *(const f32x4*)(Lt_s + 20);
    La6 = *(const f32x4*)(Lt_s + 24);
    La7 = *(const f32x4*)(Lt_s + 28);
    La8 = *(const f32x4*)(Lt_s + 32);
    La9 = *(const f32x4*)(Lt_s + 36);
    La10 = *(const f32x4*)(Lt_s + 40);
    La11 = *(const f32x4*)(Lt_s + 44);
    La12 = *(const f32x4*)(Lt_s + 48);
    La13 = *(const f32x4*)(Lt_s + 52);
    La14 = *(const f32x4*)(Lt_s + 56);
    La15 = *(const f32x4*)(Lt_s + 60);
    Lb0 = *(const f32x4*)(Lt_s + 68);
    Lb1 = *(const f32x4*)(Lt_s + 72);
    Lb2 = *(const f32x4*)(Lt_s + 76);
    Lb3 = *(const f32x4*)(Lt_s + 80);
    Lb4 = *(const f32x4*)(Lt_s + 84);
    Lb5 = *(const f32x4*)(Lt_s + 88);
    Lb6 = *(const f32x4*)(Lt_s + 92);
    Lb7 = *(const f32x4*)(Lt_s + 96);
    Lb8 = *(const f32x4*)(Lt_s + 100);
    Lb9 = *(const f32x4*)(Lt_s + 104);
    Lb10 = *(const f32x4*)(Lt_s + 108);
    Lb11 = *(const f32x4*)(Lt_s + 112);
    Lb12 = *(const f32x4*)(Lt_s + 116);
    Lb13 = *(const f32x4*)(Lt_s + 120);
    Lb14 = *(const f32x4*)(Lt_s + 124);
    Lb15 = *(const f32x4*)(Lt_s + 128);
    __builtin_amdgcn_sched_barrier(0);
    { const float xj = X0[0]; const f32x2 xj2 = (f32x2){xj, xj};
      X0 -= (f32x2){La0[0], La0[1]} * xj2;
      X1 -= (f32x2){La0[2], La0[3]} * xj2;
      X2 -= (f32x2){La1[0], La1[1]} * xj2;
      X3 -= (f32x2){La1[2], La1[3]} * xj2;
      X4 -= (f32x2){La2[0], La2[1]} * xj2;
      X5 -= (f32x2){La2[2], La2[3]} * xj2;
      X6 -= (f32x2){La3[0], La3[1]} * xj2;
      X7 -= (f32x2){La3[2], La3[3]} * xj2;
      X8 -= (f32x2){La4[0], La4[1]} * xj2;
      X9 -= (f32x2){La4[2], La4[3]} * xj2;
      X10 -= (f32x2){La5[0], La5[1]} * xj2;
      X11 -= (f32x2){La5[2], La5[3]} * xj2;
      X12 -= (f32x2){La6[0], La6[1]} * xj2;
      X13 -= (f32x2){La6[2], La6[3]} * xj2;
      X14 -= (f32x2){La7[0], La7[1]} * xj2;
      X15 -= (f32x2){La7[2], La7[3]} * xj2;
      X16 -= (f32x2){La8[0], La8[1]} * xj2;
      X17 -= (f32x2){La8[2], La8[3]} * xj2;
      X18 -= (f32x2){La9[0], La9[1]} * xj2;
      X19 -= (f32x2){La9[2], La9[3]} * xj2;
      X20 -= (f32x2){La10[0], La10[1]} * xj2;
      X21 -= (f32x2){La10[2], La10[3]} * xj2;
      X22 -= (f32x2){La11[0], La11[1]} * xj2;
      X23 -= (f32x2){La11[2], La11[3]} * xj2;
      X24 -= (f32x2){La12[0], La12[1]} * xj2;
      X25 -= (f32x2){La12[2], La12[3]} * xj2;
      X26 -= (f32x2){La13[0], La13[1]} * xj2;
      X27 -= (f32x2){La13[2], La13[3]} * xj2;
      X28 -= (f32x2){La14[0], La14[1]} * xj2;
      X29 -= (f32x2){La14[2], La14[3]} * xj2;
      X30 -= (f32x2){La15[0], La15[1]} * xj2;
      X31 -= (f32x2){La15[2], La15[3]} * xj2;
    }
    __builtin_amdgcn_sched_barrier(0);
    La0 = *(const f32x4*)(Lt_s + 136);
    La1 = *(const f32x4*)(Lt_s + 140);
    La2 = *(const f32x4*)(Lt_s + 144);
    La3 = *(const f32x4*)(Lt_s + 148);
    La4 = *(const f32x4*)(Lt_s + 152);
    La5 = *(const f32x4*)(Lt_s + 156);
    La6 = *(const f32x4*)(Lt_s + 160);
    La7 = *(const f32x4*)(Lt_s + 164);
    La8 = *(const f32x4*)(Lt_s + 168);
    La9 = *(const f32x4*)(Lt_s + 172);
    La10 = *(const f32x4*)(Lt_s + 176);
    La11 = *(const f32x4*)(Lt_s + 180);
    La12 = *(const f32x4*)(Lt_s + 184);
    La13 = *(const f32x4*)(Lt_s + 188);
    La14 = *(const f32x4*)(Lt_s + 192);
    La15 = *(const f32x4*)(Lt_s + 196);
    __builtin_amdgcn_sched_barrier(0);
    { const float xj = X0[1]; const f32x2 xj2 = (f32x2){xj, xj};
      X1 -= (f32x2){Lb0[2], Lb0[3]} * xj2;
      X2 -= (f32x2){Lb1[0], Lb1[1]} * xj2;
      X3 -= (f32x2){Lb1[2], Lb1[3]} * xj2;
      X4 -= (f32x2){Lb2[0], Lb2[1]} * xj2;
      X5 -= (f32x2){Lb2[2], Lb2[3]} * xj2;
      X6 -= (f32x2){Lb3[0], Lb3[1]} * xj2;
      X7 -= (f32x2){Lb3[2], Lb3[3]} * xj2;
      X8 -= (f32x2){Lb4[0], Lb4[1]} * xj2;
      X9 -= (f32x2){Lb4[2], Lb4[3]} * xj2;
      X10 -= (f32x2){Lb5[0], Lb5[1]} * xj2;
      X11 -= (f32x2){Lb5[2], Lb5[3]} * xj2;
      X12 -= (f32x2){Lb6[0], Lb6[1]} * xj2;
      X13 -= (f32x2){Lb6[2], Lb6[3]} * xj2;
      X14 -= (f32x2){Lb7[0], Lb7[1]} * xj2;
      X15 -= (f32x2){Lb7[2], Lb7[3]} * xj2;
      X16 -= (f32x2){Lb8[0], Lb8[1]} * xj2;
      X17 -= (f32x2){Lb8[2], Lb8[3]} * xj2;
      X18 -= (f32x2){Lb9[0], Lb9[1]} * xj2;
      X19 -= (f32x2){Lb9[2], Lb9[3]} * xj2;
      X20 -= (f32x2){Lb10[0], Lb10[1]} * xj2;
      X21 -= (f32x2){Lb10[2], Lb10[3]} * xj2;
      X22 -= (f32x2){Lb11[0], Lb11[1]} * xj2;
      X23 -= (f32x2){Lb11[2], Lb11[3]} * xj2;
      X24 -= (f32x2){Lb12[0], Lb12[1]} * xj2;
      X25 -= (f32x2){Lb12[2], Lb12[3]} * xj2;
      X26 -= (f32x2){Lb13[0], Lb13[1]} * xj2;
      X27 -= (f32x2){Lb13[2], Lb13[3]} * xj2;
      X28 -= (f32x2){Lb14[0], Lb14[1]} * xj2;
      X29 -= (f32x2){Lb14[2], Lb14[3]} * xj2;
      X30 -= (f32x2){Lb15[0], Lb15[1]} * xj2;
      X31 -= (f32x2){Lb15[2], Lb15[3]} * xj2;
    }
    __builtin_amdgcn_sched_barrier(0);
    Lb1 = *(const f32x4*)(Lt_s + 208);
    Lb2 = *(const f32x4*)(Lt_s + 212);
    Lb3 = *(const f32x4*)(Lt_s + 216);
    Lb4 = *(const f32x4*)(Lt_s + 220);
    Lb5 = *(const f32x4*)(Lt_s + 224);
    Lb6 = *(const f32x4*)(Lt_s + 228);
    Lb7 = *(const f32x4*)(Lt_s + 232);
    Lb8 = *(const f32x4*)(Lt_s + 236);
    Lb9 = *(const f32x4*)(Lt_s + 240);
    Lb10 = *(const f32x4*)(Lt_s + 244);
    Lb11 = *(const f32x4*)(Lt_s + 248);
    Lb12 = *(const f32x4*)(Lt_s + 252);
    Lb13 = *(const f32x4*)(Lt_s + 256);
    Lb14 = *(const f32x4*)(Lt_s + 260);
    Lb15 = *(const f32x4*)(Lt_s + 264);
    __builtin_amdgcn_sched_barrier(0);
    { const float xj = X1[0]; const f32x2 xj2 = (f32x2){xj, xj};
      X1 -= (f32x2){La0[2], La0[3]} * xj2;
      X2 -= (f32x2){La1[0], La1[1]} * xj2;
      X3 -= (f32x2){La1[2], La1[3]} * xj2;
      X4 -= (f32x2){La2[0], La2[1]} * xj2;
      X5 -= (f32x2){La2[2], La2[3]} * xj2;
      X6 -= (f32x2){La3[0], La3[1]} * xj2;
      X7 -= (f32x2){La3[2], La3[3]} * xj2;
      X8 -= (f32x2){La4[0], La4[1]} * xj2;
      X9 -= (f32x2){La4[2], La4[3]} * xj2;
      X10 -= (f32x2){La5[0], La5[1]} * xj2;
      X11 -= (f32x2){La5[2], La5[3]} * xj2;
      X12 -= (f32x2){La6[0], La6[1]} * xj2;
      X13 -= (f32x2){La6[2], La6[3]} * xj2;
      X14 -= (f32x2){La7[0], La7[1]} * xj2;
      X15 -= (f32x2){La7[2], La7[3]} * xj2;
      X16 -= (f32x2){La8[0], La8[1]} * xj2;
      X17 -= (f32x2){La8[2], La8[3]} * xj2;
      X18 -= (f32x2){La9[0], La9[1]} * xj2;
      X19 -= (f32x2){La9[2], La9[3]} * xj2;
      X20 -= (f32x2){La10[0], La10[1]} * xj2;
      X21 -= (f32x2){La10[2], La10[3]} * xj2;
      X22 -= (f32x2){La11[0], La11[1]} * xj2;
      X23 -= (f32x2){La11[2], La11[3]} * xj2;
      X24 -= (f32x2){La12[0], La12[1]} * xj2;
      X25 -= (f32x2){La12[2], La12[3]} * xj2;
      X26 -= (f32x2){La13[0], La13[1]} * xj2;
      X27 -= (f32x2){La13[2], La13[3]} * xj2;
      X28 -= (f32x2){La14[0], La14[1]} * xj2;
      X29 -= (f32x2){La14[2], La14[3]} * xj2;
      X30 -= (f32x2){La15[0], La15[1]} * xj2;
      X31 -= (f32x2){La15[2], La15[3]} * xj2;
    }
    __builtin_amdgcn_sched_barrier(0);
    La1 = *(const f32x4*)(Lt_s + 276);
    La2 = *(const f32x4*)(Lt_s + 280);
    La3 = *(const f32x4*)(Lt_s + 284);
    La4 = *(const f32x4*)(Lt_s + 288);
    La5 = *(const f32x4*)(Lt_s + 292);
    La6 = *(const f32x4*)(Lt_s + 296);
    La7 = *(const f32x4*)(Lt_s + 300);
    La8 = *(const f32x4*)(Lt_s + 304);
    La9 = *(const f32x4*)(Lt_s + 308);
    La10 = *(const f32x4*)(Lt_s + 312);
    La11 = *(const f32x4*)(Lt_s + 316);
    La12 = *(const f32x4*)(Lt_s + 320);
    La13 = *(const f32x4*)(Lt_s + 324);
    La14 = *(const f32x4*)(Lt_s + 328);
    La15 = *(const f32x4*)(Lt_s + 332);
    __builtin_amdgcn_sched_barrier(0);
    { const float xj = X1[1]; const f32x2 xj2 = (f32x2){xj, xj};
      X2 -= (f32x2){Lb1[0], Lb1[1]} * xj2;
      X3 -= (f32x2){Lb1[2], Lb1[3]} * xj2;
      X4 -= (f32x2){Lb2[0], Lb2[1]} * xj2;
      X5 -= (f32x2){Lb2[2], Lb2[3]} * xj2;
      X6 -= (f32x2){Lb3[0], Lb3[1]} * xj2;
      X7 -= (f32x2){Lb3[2], Lb3[3]} * xj2;
      X8 -= (f32x2){Lb4[0], Lb4[1]} * xj2;
      X9 -= (f32x2){Lb4[2], Lb4[3]} * xj2;
      X10 -= (f32x2){Lb5[0], Lb5[1]} * xj2;
      X11 -= (f32x2){Lb5[2], Lb5[3]} * xj2;
      X12 -= (f32x2){Lb6[0], Lb6[1]} * xj2;
      X13 -= (f32x2){Lb6[2], Lb6[3]} * xj2;
      X14 -= (f32x2){Lb7[0], Lb7[1]} * xj2;
      X15 -= (f32x2){Lb7[2], Lb7[3]} * xj2;
      X16 -= (f32x2){Lb8[0], Lb8[1]} * xj2;
      X17 -= (f32x2){Lb8[2], Lb8[3]} * xj2;
      X18 -= (f32x2){Lb9[0], Lb9[1]} * xj2;
      X19 -= (f32x2){Lb9[2], Lb9[3]} * xj2;
      X20 -= (f32x2){Lb10[0], Lb10[1]} * xj2;
      X21 -= (f32x2){Lb10[2], Lb10[3]} * xj2;
      X22 -= (f32x2){Lb11[0], Lb11[1]} * xj2;
      X23 -= (f32x2){Lb11[2], Lb11[3]} * xj2;
      X24 -= (f32x2){Lb12[0], Lb12[1]} * xj2;
      X25 -= (f32x2){Lb12[2], Lb12[3]} * xj2;
      X26 -= (f32x2){Lb13[0], Lb13[1]} * xj2;
      X27 -= (f32x2){Lb13[2], Lb13[3]} * xj2;
      X28 -= (f32x2){Lb14[0], Lb14[1]} * xj2;
      X29 -= (f32x2){Lb14[2], Lb14[3]} * xj2;
      X30 -= (f32x2){Lb15[0], Lb15[1]} * xj2;
      X31 -= (f32x2){Lb15[2], Lb15[3]} * xj2;
    }
    __builtin_amdgcn_sched_barrier(0);
    Lb1 = *(const f32x4*)(Lt_s + 344);
    Lb2 = *(const f32x4*)(Lt_s + 348);
    Lb3 = *(const f32x4*)(Lt_s + 352);
    Lb4 = *(const f32x4*)(Lt_s + 356);
    Lb5 = *(const f32x4*)(Lt_s + 360);
    Lb6 = *(const f32x4*)(Lt_s + 364);
    Lb7 = *(const f32x4*)(Lt_s + 368);
    Lb8 = *(const f32x4*)(Lt_s + 372);
    Lb9 = *(const f32x4*)(Lt_s + 376);
    Lb10 = *(const f32x4*)(Lt_s + 380);
    Lb11 = *(const f32x4*)(Lt_s + 384);
    Lb12 = *(const f32x4*)(Lt_s + 388);
    Lb13 = *(const f32x4*)(Lt_s + 392);
    Lb14 = *(const f32x4*)(Lt_s + 396);
    Lb15 = *(const f32x4*)(Lt_s + 400);
    __builtin_amdgcn_sched_barrier(0);
    { const float xj = X2[0]; const f32x2 xj2 = (f32x2){xj, xj};
      X2 -= (f32x2){La1[0], La1[1]} * xj2;
      X3 -= (f32x2){La1[2], La1[3]} * xj2;
      X4 -= (f32x2){La2[0], La2[1]} * xj2;
      X5 -= (f32x2){La2[2], La2[3]} * xj2;
      X6 -= (f32x2){La3[0], La3[1]} * xj2;
      X7 -= (f32x2){La3[2], La3[3]} * xj2;
      X8 -= (f32x2){La4[0], La4[1]} * xj2;
      X9 -= (f32x2){La4[2], La4[3]} * xj2;
      X10 -= (f32x2){La5[0], La5[1]} * xj2;
      X11 -= (f32x2){La5[2], La5[3]} * xj2;
      X12 -= (f32x2){La6[0], La6[1]} * xj2;
      X13 -= (f32x2){La6[2], La6[3]} * xj2;
      X14 -= (f32x2){La7[0], La7[1]} * xj2;
      X15 -= (f32x2){La7[2], La7[3]} * xj2;
      X16 -= (f32x2){La8[0], La8[1]} * xj2;
      X17 -= (f32x2){La8[2], La8[3]} * xj2;
      X18 -= (f32x2){La9[0], La9[1]} * xj2;
      X19 -= (f32x2){La9[2], La9[3]} * xj2;
      X20 -= (f32x2){La10[0], La10[1]} * xj2;
      X21 -= (f32x2){La10[2], La10[3]} * xj2;
      X22 -= (f32x2){La11[0], La11[1]} * xj2;
      X23 -= (f32x2){La11[2], La11[3]} * xj2;
      X24 -= (f32x2){La12[0], La12[1]} * xj2;
      X25 -= (f32x2){La12[2], La12[3]} * xj2;
      X26 -= (f32x2){La13[0], La13[1]} * xj2;
      X27 -= (f32x2){La13[2], La13[3]} * xj2;
      X28 -= (f32x2){La14[0], La14[1]} * xj2;
      X29 -= (f32x2){La14[2], La14[3]} * xj2;
      X30 -= (f32x2){La15[0], La15[1]} * xj2;
      X31 -= (f32x2){La15[2], La15[3]} * xj2;
    }
    __builtin_amdgcn_sched_barrier(0);
    La1 = *(const f32x4*)(Lt_s + 412);
    La2 = *(const f32x4*)(Lt_s + 416);
    La3 = *(const f32x4*)(Lt_s + 420);
    La4 = *(const f32x4*)(Lt_s + 424);
    La5 = *(const f32x4*)(Lt_s + 428);
    La6 = *(const f32x4*)(Lt_s + 432);
    La7 = *(const f32x4*)(Lt_s + 436);
    La8 = *(const f32x4*)(Lt_s + 440);
    La9 = *(const f32x4*)(Lt_s + 444);
    La10 = *(const f32x4*)(Lt_s + 448);
    La11 = *(const f32x4*)(Lt_s + 452);
    La12 = *(const f32x4*)(Lt_s + 456);
    La13 = *(const f32x4*)(Lt_s + 460);
    La14 = *(const f32x4*)(Lt_s + 464);
    La15 = *(const f32x4*)(Lt_s + 468);
    __builtin_amdgcn_sched_barrier(0);
    { const float xj = X2[1]; const f32x2 xj2 = (f32x2){xj, xj};
      X3 -= (f32x2){Lb1[2], Lb1[3]} * xj2;
      X4 -= (f32x2){Lb2[0], Lb2[1]} * xj2;
      X5 -= (f32x2){Lb2[2], Lb2[3]} * xj2;
      X6 -= (f32x2){Lb3[0], Lb3[1]} * xj2;
      X7 -= (f32x2){Lb3[2], Lb3[3]} * xj2;
      X8 -= (f32x2){Lb4[0], Lb4[1]} * xj2;
      X9 -= (f32x2){Lb4[2], Lb4[3]} * xj2;
      X10 -= (f32x2){Lb5[0], Lb5[1]} * xj2;
      X11 -= (f32x2){Lb5[2], Lb5[3]} * xj2;
      X12 -= (f32x2){Lb6[0], Lb6[1]} * xj2;
      X13 -= (f32x2){Lb6[2], Lb6[3]} * xj2;
      X14 -= (f32x2){Lb7[0], Lb7[1]} * xj2;
      X15 -= (f32x2){Lb7[2], Lb7[3]} * xj2;
      X16 -= (f32x2){Lb8[0], Lb8[1]} * xj2;
      X17 -= (f32x2){Lb8[2], Lb8[3]} * xj2;
      X18 -= (f32x2){Lb9[0], Lb9[1]} * xj2;
      X19 -= (f32x2){Lb9[2], Lb9[3]} * xj2;
      X20 -= (f32x2){Lb10[0], Lb10[1]} * xj2;
      X21 -= (f32x2){Lb10[2], Lb10[3]} * xj2;
      X22 -= (f32x2){Lb11[0], Lb11[1]} * xj2;
      X23 -= (f32x2){Lb11[2], Lb11[3]} * xj2;
      X24 -= (f32x2){Lb12[0], Lb12[1]} * xj2;
      X25 -= (f32x2){Lb12[2], Lb12[3]} * xj2;
      X26 -= (f32x2){Lb13[0], Lb13[1]} * xj2;
      X27 -= (f32x2){Lb13[2], Lb13[3]} * xj2;
      X28 -= (f32x2){Lb14[0], Lb14[1]} * xj2;
      X29 -= (f32x2){Lb14[2], Lb14[3]} * xj2;
      X30 -= (f32x2){Lb15[0], Lb15[1]} * xj2;
      X31 -= (f32x2){Lb15[2], Lb15[3]} * xj2;
    }
    __builtin_amdgcn_sched_barrier(0);
    Lb2 = *(const f32x4*)(Lt_s + 484);
    Lb3 = *(const f32x4*)(Lt_s + 488);
    Lb4 = *(const f32x4*)(Lt_s + 492);
    Lb5 = *(const f32x4*)(Lt_s + 496);
    Lb6 = *(const f32x4*)(Lt_s + 500);
    Lb7 = *(const f32x4*)(Lt_s + 504);
    Lb8 = *(const f32x4*)(Lt_s + 508);
    Lb9 = *(const f32x4*)(Lt_s + 512);
    Lb10 = *(const f32x4*)(Lt_s + 516);
    Lb11 = *(const f32x4*)(Lt_s + 520);
    Lb12 = *(const f32x4*)(Lt_s + 524);
    Lb13 = *(const f32x4*)(Lt_s + 528);
    Lb14 = *(const f32x4*)(Lt_s + 532);
    Lb15 = *(const f32x4*)(Lt_s + 536);
    __builtin_amdgcn_sched_barrier(0);
    { const float xj = X3[0]; const f32x2 xj2 = (f32x2){xj, xj};
      X3 -= (f32x2){La1[2], La1[3]} * xj2;
      X4 -= (f32x2){La2[0], La2[1]} * xj2;
      X5 -= (f32x2){La2[2], La2[3]} * xj2;
      X6 -= (f32x2){La3[0], La3[1]} * xj2;
      X7 -= (f32x2){La3[2], La3[3]} * xj2;
      X8 -= (f32x2){La4[0], La4[1]} * xj2;
      X9 -= (f32x2){La4[2], La4[3]} * xj2;
      X10 -= (f32x2){La5[0], La5[1]} * xj2;
      X11 -= (f32x2){La5[2], La5[3]} * xj2;
      X12 -= (f32x2){La6[0], La6[1]} * xj2;
      X13 -= (f32x2){La6[2], La6[3]} * xj2;
      X14 -= (f32x2){La7[0], La7[1]} * xj2;
      X15 -= (f32x2){La7[2], La7[3]} * xj2;
      X16 -= (f32x2){La8[0], La8[1]} * xj2;
      X17 -= (f32x2){La8[2], La8[3]} * xj2;
      X18 -= (f32x2){La9[0], La9[1]} * xj2;
      X19 -= (f32x2){La9[2], La9[3]} * xj2;
      X20 -= (f32x2){La10[0], La10[1]} * xj2;
      X21 -= (f32x2){La10[2], La10[3]} * xj2;
      X22 -= (f32x2){La11[0], La11[1]} * xj2;
      X23 -= (f32x2){La11[2], La11[3]} * xj2;
      X24 -= (f32x2){La12[0], La12[1]} * xj2;
      X25 -= (f32x2){La12[2], La12[3]} * xj2;
      X26 -= (f32x2){La13[0], La13[1]} * xj2;
      X27 -= (f32x2){La13[2], La13[3]} * xj2;
      X28 -= (f32x2){La14[0], La14[1]} * xj2;
      X29 -= (f32x2){La14[2], La14[3]} * xj2;
      X30 -= (f32x2){La15[0], La15[1]} * xj2;
      X31 -= (f32x2){La15[2], La15[3]} * xj2;
    }
    __builtin_amdgcn_sched_barrier(0);
    La2 = *(const f32x4*)(Lt_s + 552);
    La3 = *(const f32x4*)(Lt_s + 556);
    La4 = *(const f32x4*)(Lt_s + 560);
    La5 = *(const f32x4*)(Lt_s + 564);
    La6 = *(const f32x4*)(Lt_s + 568);
    La7 = *(const f32x4*)(Lt_s + 572);
    La8 = *(const f32x4*)(Lt_s + 576);
    La9 = *(const f32x4*)(Lt_s + 580);
    La10 = *(const f32x4*)(Lt_s + 584);
    La11 = *(const f32x4*)(Lt_s + 588);
    La12 = *(const f32x4*)(Lt_s + 592);
    La13 = *(const f32x4*)(Lt_s + 596);
    La14 = *(const f32x4*)(Lt_s + 600);
    La15 = *(const f32x4*)(Lt_s + 604);
    __builtin_amdgcn_sched_barrier(0);
    { const float xj = X3[1]; const f32x2 xj2 = (f32x2){xj, xj};
      X4 -= (f32x2){Lb2[0], Lb2[1]} * xj2;
      X5 -= (f32x2){Lb2[2], Lb2[3]} * xj2;
      X6 -= (f32x2){Lb3[0], Lb3[1]} * xj2;
      X7 -= (f32x2){Lb3[2], Lb3[3]} * xj2;
      X8 -= (f32x2){Lb4[0], Lb4[1]} * xj2;
      X9 -= (f32x2){Lb4[2], Lb4[3]} * xj2;
      X10 -= (f32x2){Lb5[0], Lb5[1]} * xj2;
      X11 -= (f32x2){Lb5[2], Lb5[3]} * xj2;
      X12 -= (f32x2){Lb6[0], Lb6[1]} * xj2;
      X13 -= (f32x2){Lb6[2], Lb6[3]} * xj2;
      X14 -= (f32x2){Lb7[0], Lb7[1]} * xj2;
      X15 -= (f32x2){Lb7[2], Lb7[3]} * xj2;
      X16 -= (f32x2){Lb8[0], Lb8[1]} * xj2;
      X17 -= (f32x2){Lb8[2], Lb8[3]} * xj2;
      X18 -= (f32x2){Lb9[0], Lb9[1]} * xj2;
      X19 -= (f32x2){Lb9[2], Lb9[3]} * xj2;
      X20 -= (f32x2){Lb10[0], Lb10[1]} * xj2;
      X21 -= (f32x2){Lb10[2], Lb10[3]} * xj2;
      X22 -= (f32x2){Lb11[0], Lb11[1]} * xj2;
      X23 -= (f32x2){Lb11[2], Lb11[3]} * xj2;
      X24 -= (f32x2){Lb12[0], Lb12[1]} * xj2;
      X25 -= (f32x2){Lb12[2], Lb12[3]} * xj2;
      X26 -= (f32x2){Lb13[0], Lb13[1]} * xj2;
      X27 -= (f32x2){Lb13[2], Lb13[3]} * xj2;
      X28 -= (f32x2){Lb14[0], Lb14[1]} * xj2;
      X29 -= (f32x2){Lb14[2], Lb14[3]} * xj2;
      X30 -= (f32x2){Lb15[0], Lb15[1]} * xj2;
      X31 -= (f32x2){Lb15[2], Lb15[3]} * xj2;
    }
    __builtin_amdgcn_sched_barrier(0);
    Lb2 = *(const f32x4*)(Lt_s + 620);
    Lb3 = *(const f32x4*)(Lt_s + 624);
    Lb4 = *(const f32x4*)(Lt_s + 628);
    Lb5 = *(const f32x4*)(Lt_s + 632);
    Lb6 = *(const f32x4*)(Lt_s + 636);
    Lb7 = *(const f32x4*)(Lt_s + 640);
    Lb8 = *(const f32x4*)(Lt_s + 644);
    Lb9 = *(const f32x4*)(Lt_s + 648);
    Lb10 = *(const f32x4*)(Lt_s + 652);
    Lb11 = *(const f32x4*)(Lt_s + 656);
    Lb12 = *(const f32x4*)(Lt_s + 660);
    Lb13 = *(const f32x4*)(Lt_s + 664);
    Lb14 = *(const f32x4*)(Lt_s + 668);
    Lb15 = *(const f32x4*)(Lt_s + 672);
    __builtin_amdgcn_sched_barrier(0);
    { const float xj = X4[0]; const f32x2 xj2 = (f32x2){xj, xj};
      X4 -= (f32x2){La2[0], La2[1]} * xj2;
      X5 -= (f32x2){La2[2], La2[3]} * xj2;
      X6 -= (f32x2){La3[0], La3[1]} * xj2;
      X7 -= (f32x2){La3[2], La3[3]} * xj2;
      X8 -= (f32x2){La4[0], La4[1]} * xj2;
      X9 -= (f32x2){La4[2], La4[3]} * xj2;
      X10 -= (f32x2){La5[0], La5[1]} * xj2;
      X11 -= (f32x2){La5[2], La5[3]} * xj2;
      X12 -= (f32x2){La6[0], La6[1]} * xj2;
      X13 -= (f32x2){La6[2], La6[3]} * xj2;
      X14 -= (f32x2){La7[0], La7[1]} * xj2;
      X15 -= (f32x2){La7[2], La7[3]} * xj2;
      X16 -= (f32x2){La8[0], La8[1]} * xj2;
      X17 -= (f32x2){La8[2], La8[3]} * xj2;
      X18 -= (f32x2){La9[0], La9[1]} * xj2;
      X19 -= (f32x2){La9[2], La9[3]} * xj2;
      X20 -= (f32x2){La10[0], La10[1]} * xj2;
      X21 -= (f32x2){La10[2], La10[3]} * xj2;
      X22 -= (f32x2){La11[0], La11[1]} * xj2;
      X23 -= (f32x2){La11[2], La11[3]} * xj2;
      X24 -= (f32x2){La12[0], La12[1]} * xj2;
      X25 -= (f32x2){La12[2], La12[3]} * xj2;
      X26 -= (f32x2){La13[0], La13[1]} * xj2;
      X27 -= (f32x2){La13[2], La13[3]} * xj2;
      X28 -= (f32x2){La14[0], La14[1]} * xj2;
      X29 -= (f32x2){La14[2], La14[3]} * xj2;
      X30 -= (f32x2){La15[0], La15[1]} * xj2;
      X31 -= (f32x2){La15[2], La15[3]} * xj2;
    }
    __builtin_amdgcn_sched_barrier(0);
    La2 = *(const f32x4*)(Lt_s + 688);
    La3 = *(const f32x4*)(Lt_s + 692);
    La4 = *(const f32x4*)(Lt_s + 696);
    La5 = *(const f32x4*)(Lt_s + 700);
    La6 = *(const f32x4*)(Lt_s + 704);
    La7 = *(const f32x4*)(Lt_s + 708);
    La8 = *(const f32x4*)(Lt_s + 712);
    La9 = *(const f32x4*)(Lt_s + 716);
    La10 = *(const f32x4*)(Lt_s + 720);
    La11 = *(const f32x4*)(Lt_s + 724);
    La12 = *(const f32x4*)(Lt_s + 728);
    La13 = *(const f32x4*)(Lt_s + 732);
    La14 = *(const f32x4*)(Lt_s + 736);
    La15 = *(const f32x4*)(Lt_s + 740);
    __builtin_amdgcn_sched_barrier(0);
    { const float xj = X4[1]; const f32x2 xj2 = (f32x2){xj, xj};
      X5 -= (f32x2){Lb2[2], Lb2[3]} * xj2;
      X6 -= (f32x2){Lb3[0], Lb3[1]} * xj2;
      X7 -= (f32x2){Lb3[2], Lb3[3]} * xj2;
      X8 -= (f32x2){Lb4[0], Lb4[1]} * xj2;
      X9 -= (f32x2){Lb4[2], Lb4[3]} * xj2;
      X10 -= (f32x2){Lb5[0], Lb5[1]} * xj2;
      X11 -= (f32x2){Lb5[2], Lb5[3]} * xj2;
      X12 -= (f32x2){Lb6[0], Lb6[1]} * xj2;
      X13 -= (f32x2){Lb6[2], Lb6[3]} * xj2;
      X14 -= (f32x2){Lb7[0], Lb7[1]} * xj2;
      X15 -= (f32x2){Lb7[2], Lb7[3]} * xj2;
      X16 -= (f32x2){Lb8[0], Lb8[1]} * xj2;
      X17 -= (f32x2){Lb8[2], Lb8[3]} * xj2;
      X18 -= (f32x2){Lb9[0], Lb9[1]} * xj2;
      X19 -= (f32x2){Lb9[2], Lb9[3]} * xj2;
      X20 -= (f32x2){Lb10[0], Lb10[1]} * xj2;
      X21 -= (f32x2){Lb10[2], Lb10[3]} * xj2;
      X22 -= (f32x2){Lb11[0], Lb11[1]} * xj2;
      X23 -= (f32x2){Lb11[2], Lb11[3]} * xj2;
      X24 -= (f32x2){Lb12[0], Lb12[1]} * xj2;
      X25 -= (f32x2){Lb12[2], Lb12[3]} * xj2;
      X26 -= (f32x2){Lb13[0], Lb13[1]} * xj2;
      X27 -= (f32x2){Lb13[2], Lb13[3]} * xj2;
      X28 -= (f32x2){Lb14[0], Lb14[1]} * xj2;
      X29 -= (f32x2){Lb14[2], Lb14[3]} * xj2;
      X30 -= (f32x2){Lb15[0], Lb15[1]} * xj2;
      X31 -= (f32x2){Lb15[2], Lb15[3]} * xj2;
    }
    __builtin_amdgcn_sched_barrier(0);
    Lb3 = *(const f32x4*)(Lt_s + 760);
    Lb4 = *(const f32x4*)(Lt_s + 764);
    Lb5 = *(const f32x4*)(Lt_s + 768);
    Lb6 = *(const f32x4*)(Lt_s + 772);
    Lb7 = *(const f32x4*)(Lt_s + 776);
    Lb8 = *(const f32x4*)(Lt_s + 780);
    Lb9 = *(const f32x4*)(Lt_s + 784);
    Lb10 = *(const f32x4*)(Lt_s + 788);
    Lb11 = *(const f32x4*)(Lt_s + 792);
    Lb12 = *(const f32x4*)(Lt_s + 796);
    Lb13 = *(const f32x4*)(Lt_s + 800);
    Lb14 = *(const f32x4*)(Lt_s + 804);
    Lb15 = *(const f32x4*)(Lt_s + 808);
    __builtin_amdgcn_sched_barrier(0);
    { const float xj = X5[0]; const f32x2 xj2 = (f32x2){xj, xj};
      X5 -= (f32x2){La2[2], La2[3]} * xj2;
      X6 -= (f32x2){La3[0], La3[1]} * xj2;
      X7 -= (f32x2){La3[2], La3[3]} * xj2;
      X8 -= (f32x2){La4[0], La4[1]} * xj2;
      X9 -= (f32x2){La4[2], La4[3]} * xj2;
      X10 -= (f32x2){La5[0], La5[1]} * xj2;
      X11 -= (f32x2){La5[2], La5[3]} * xj2;
      X12 -= (f32x2){La6[0], La6[1]} * xj2;
      X13 -= (f32x2){La6[2], La6[3]} * xj2;
      X14 -= (f32x2){La7[0], La7[1]} * xj2;
      X15 -= (f32x2){La7[2], La7[3]} * xj2;
      X16 -= (f32x2){La8[0], La8[1]} * xj2;
      X17 -= (f32x2){La8[2], La8[3]} * xj2;
      X18 -= (f32x2){La9[0], La9[1]} * xj2;
      X19 -= (f32x2){La9[2], La9[3]} * xj2;
      X20 -= (f32x2){La10[0], La10[1]} * xj2;
      X21 -= (f32x2){La10[2], La10[3]} * xj2;
      X22 -= (f32x2){La11[0], La11[1]} * xj2;
      X23 -= (f32x2){La11[2], La11[3]} * xj2;
      X24 -= (f32x2){La12[0], La12[1]} * xj2;
      X25 -= (f32x2){La12[2], La12[3]} * xj2;
      X26 -= (f32x2){La13[0], La13[1]} * xj2;
      X27 -= (f32x2){La13[2], La13[3]} * xj2;
      X28 -= (f32x2){La14[0], La14[1]} * xj2;
      X29 -= (f32x2){La14[2], La14[3]} * xj2;
      X30 -= (f32x2){La15[0], La15[1]} * xj2;
      X31 -= (f32x2){La15[2], La15[3]} * xj2;
    }
    __builtin_amdgcn_sched_barrier(0);
    La3 = *(const f32x4*)(Lt_s + 828);
    La4 = *(const f32x4*)(Lt_s + 832);
    La5 = *(const f32x4*)(Lt_s + 836);
    La6 = *(const f32x4*)(Lt_s + 840);
    La7 = *(const f32x4*)(Lt_s + 844);
    La8 = *(const f32x4*)(Lt_s + 848);
    La9 = *(const f32x4*)(Lt_s + 852);
    La10 = *(const f32x4*)(Lt_s + 856);
    La11 = *(const f32x4*)(Lt_s + 860);
    La12 = *(const f32x4*)(Lt_s + 864);
    La13 = *(const f32x4*)(Lt_s + 868);
    La14 = *(const f32x4*)(Lt_s + 872);
    La15 = *(const f32x4*)(Lt_s + 876);
    __builtin_amdgcn_sched_barrier(0);
    { const float xj = X5[1]; const f32x2 xj2 = (f32x2){xj, xj};
      X6 -= (f32x2){Lb3[0], Lb3[1]} * xj2;
      X7 -= (f32x2){Lb3[2], Lb3[3]} * xj2;
      X8 -= (f32x2){Lb4[0], Lb4[1]} * xj2;
      X9 -= (f32x2){Lb4[2], Lb4[3]} * xj2;
      X10 -= (f32x2){Lb5[0], Lb5[1]} * xj2;
      X11 -= (f32x2){Lb5[2], Lb5[3]} * xj2;
      X12 -= (f32x2){Lb6[0], Lb6[1]} * xj2;
      X13 -= (f32x2){Lb6[2], Lb6[3]} * xj2;
      X14 -= (f32x2){Lb7[0], Lb7[1]} * xj2;
      X15 -= (f32x2){Lb7[2], Lb7[3]} * xj2;
      X16 -= (f32x2){Lb8[0], Lb8[1]} * xj2;
      X17 -= (f32x2){Lb8[2], Lb8[3]} * xj2;
      X18 -= (f32x2){Lb9[0], Lb9[1]} * xj2;
      X19 -= (f32x2){Lb9[2], Lb9[3]} * xj2;
      X20 -= (f32x2){Lb10[0], Lb10[1]} * xj2;
      X21 -= (f32x2){Lb10[2], Lb10[3]} * xj2;
      X22 -= (f32x2){Lb11[0], Lb11[1]} * xj2;
      X23 -= (f32x2){Lb11[2], Lb11[3]} * xj2;
      X24 -= (f32x2){Lb12[0], Lb12[1]} * xj2;
      X25 -= (f32x2){Lb12[2], Lb12[3]} * xj2;
      X26 -= (f32x2){Lb13[0], Lb13[1]} * xj2;
      X27 -= (f32x2){Lb13[2], Lb13[3]} * xj2;
      X28 -= (f32x2){Lb14[0], Lb14[1]} * xj2;
      X29 -= (f32x2){Lb14[2], Lb14[3]} * xj2;
      X30 -= (f32x2){Lb15[0], Lb15[1]} * xj2;
      X31 -= (f32x2){Lb15[2], Lb15[3]} * xj2;
    }
    __builtin_amdgcn_sched_barrier(0);
    Lb3 = *(const f32x4*)(Lt_s + 896);
    Lb4 = *(const f32x4*)(Lt_s + 900);
    Lb5 = *(const f32x4*)(Lt_s + 904);
    Lb6 = *(const f32x4*)(Lt_s + 908);
    Lb7 = *(const f32x4*)(Lt_s + 912);
    Lb8 = *(const f32x4*)(Lt_s + 916);
    Lb9 = *(const f32x4*)(Lt_s + 920);
    Lb10 = *(const f32x4*)(Lt_s + 924);
    Lb11 = *(const f32x4*)(Lt_s + 928);
    Lb12 = *(const f32x4*)(Lt_s + 932);
    Lb13 = *(const f32x4*)(Lt_s + 936);
    Lb14 = *(const f32x4*)(Lt_s + 940);
    Lb15 = *(const f32x4*)(Lt_s + 944);
    __builtin_amdgcn_sched_barrier(0);
    { const float xj = X6[0]; const f32x2 xj2 = (f32x2){xj, xj};
      X6 -= (f32x2){La3[0], La3[1]} * xj2;
      X7 -= (f32x2){La3[2], La3[3]} * xj2;
      X8 -= (f32x2){La4[0], La4[1]} * xj2;
      X9 -= (f32x2){La4[2], La4[3]} * xj2;
      X10 -= (f32x2){La5[0], La5[1]} * xj2;
      X11 -= (f32x2){La5[2], La5[3]} * xj2;
      X12 -= (f32x2){La6[0], La6[1]} * xj2;
      X13 -= (f32x2){La6[2], La6[3]} * xj2;
      X14 -= (f32x2){La7[0], La7[1]} * xj2;
      X15 -= (f32x2){La7[2], La7[3]} * xj2;
      X16 -= (f32x2){La8[0], La8[1]} * xj2;
      X17 -= (f32x2){La8[2], La8[3]} * xj2;
      X18 -= (f32x2){La9[0], La9[1]} * xj2;
      X19 -= (f32x2){La9[2], La9[3]} * xj2;
      X20 -= (f32x2){La10[0], La10[1]} * xj2;
      X21 -= (f32x2){La10[2], La10[3]} * xj2;
      X22 -= (f32x2){La11[0], La11[1]} * xj2;
      X23 -= (f32x2){La11[2], La11[3]} * xj2;
      X24 -= (f32x2){La12[0], La12[1]} * xj2;
      X25 -= (f32x2){La12[2], La12[3]} * xj2;
      X26 -= (f32x2){La13[0], La13[1]} * xj2;
      X27 -= (f32x2){La13[2], La13[3]} * xj2;
      X28 -= (f32x2){La14[0], La14[1]} * xj2;
      X29 -= (f32x2){La14[2], La14[3]} * xj2;
      X30 -= (f32x2){La15[0], La15[1]} * xj2;
      X31 -= (f32x2){La15[2], La15[3]} * xj2;
    }
    __builtin_amdgcn_sched_barrier(0);
    La3 = *(const f32x4*)(Lt_s + 964);
    La4 = *(const f32x4*)(Lt_s + 968);
    La5 = *(const f32x4*)(Lt_s + 972);
    La6 = *(const f32x4*)(Lt_s + 976);
    La7 = *(const f32x4*)(Lt_s + 980);
    La8 = *(const f32x4*)(Lt_s + 984);
    La9 = *(const f32x4*)(Lt_s + 988);
    La10 = *(const f32x4*)(Lt_s + 992);
    La11 = *(const f32x4*)(Lt_s + 996);
    La12 = *(const f32x4*)(Lt_s + 1000);
    La13 = *(const f32x4*)(Lt_s + 1004);
    La14 = *(const f32x4*)(Lt_s + 1008);
    La15 = *(const f32x4*)(Lt_s + 1012);
    __builtin_amdgcn_sched_barrier(0);
    { const float xj = X6[1]; const f32x2 xj2 = (f32x2){xj, xj};
      X7 -= (f32x2){Lb3[2], Lb3[3]} * xj2;
      X8 -= (f32x2){Lb4[0], Lb4[1]} * xj2;
      X9 -= (f32x2){Lb4[2], Lb4[3]} * xj2;
      X10 -= (f32x2){Lb5[0], Lb5[1]} * xj2;
      X11 -= (f32x2){Lb5[2], Lb5[3]} * xj2;
      X12 -= (f32x2){Lb6[0], Lb6[1]} * xj2;
      X13 -= (f32x2){Lb6[2], Lb6[3]} * xj2;
      X14 -= (f32x2){Lb7[0], Lb7[1]} * xj2;
      X15 -= (f32x2){Lb7[2], Lb7[3]} * xj2;
      X16 -= (f32x2){Lb8[0], Lb8[1]} * xj2;
      X17 -= (f32x2){Lb8[2], Lb8[3]} * xj2;
      X18 -= (f32x2){Lb9[0], Lb9[1]} * xj2;
      X19 -= (f32x2){Lb9[2], Lb9[3]} * xj2;
      X20 -= (f32x2){Lb10[0], Lb10[1]} * xj2;
      X21 -= (f32x2){Lb10[2], Lb10[3]} * xj2;
      X22 -= (f32x2){Lb11[0], Lb11[1]} * xj2;
      X23 -= (f32x2){Lb11[2], Lb11[3]} * xj2;
      X24 -= (f32x2){Lb12[0], Lb12[1]} * xj2;
      X25 -= (f32x2){Lb12[2], Lb12[3]} * xj2;
      X26 -= (f32x2){Lb13[0], Lb13[1]} * xj2;
      X27 -= (f32x2){Lb13[2], Lb13[3]} * xj2;
      X28 -= (f32x2){Lb14[0], Lb14[1]} * xj2;
      X29 -= (f32x2){Lb14[2], Lb14[3]} * xj2;
      X30 -= (f32x2){Lb15[0], Lb15[1]} * xj2;
      X31 -= (f32x2){Lb15[2], Lb15[3]} * xj2;
    }
    __builtin_amdgcn_sched_barrier(0);
    Lb4 = *(const f32x4*)(Lt_s + 1036);
    Lb5 = *(const f32x4*)(Lt_s + 1040);
    Lb6 = *(const f32x4*)(Lt_s + 1044);
    Lb7 = *(const f32x4*)(Lt_s + 1048);
    Lb8 = *(const f32x4*)(Lt_s + 1052);
    Lb9 = *(const f32x4*)(Lt_s + 1056);
    Lb10 = *(const f32x4*)(Lt_s + 1060);
    Lb11 = *(const f32x4*)(Lt_s + 1064);
    Lb12 = *(const f32x4*)(Lt_s + 1068);
    Lb13 = *(const f32x4*)(Lt_s + 1072);
    Lb14 = *(const f32x4*)(Lt_s + 1076);
    Lb15 = *(const f32x4*)(Lt_s + 1080);
    __builtin_amdgcn_sched_barrier(0);
    { const float xj = X7[0]; const f32x2 xj2 = (f32x2){xj, xj};
      X7 -= (f32x2){La3[2], La3[3]} * xj2;
      X8 -= (f32x2){La4[0], La4[1]} * xj2;
      X9 -= (f32x2){La4[2], La4[3]} * xj2;
      X10 -= (f32x2){La5[0], La5[1]} * xj2;
      X11 -= (f32x2){La5[2], La5[3]} * xj2;
      X12 -= (f32x2){La6[0], La6[1]} * xj2;
      X13 -= (f32x2){La6[2], La6[3]} * xj2;
      X14 -= (f32x2){La7[0], La7[1]} * xj2;
      X15 -= (f32x2){La7[2], La7[3]} * xj2;
      X16 -= (f32x2){La8[0], La8[1]} * xj2;
      X17 -= (f32x2){La8[2], La8[3]} * xj2;
      X18 -= (f32x2){La9[0], La9[1]} * xj2;
      X19 -= (f32x2){La9[2], La9[3]} * xj2;
      X20 -= (f32x2){La10[0], La10[1]} * xj2;
      X21 -= (f32x2){La10[2], La10[3]} * xj2;
      X22 -= (f32x2){La11[0], La11[1]} * xj2;
      X23 -= (f32x2){La11[2], La11[3]} * xj2;
      X24 -= (f32x2){La12[0], La12[1]} * xj2;
      X25 -= (f32x2){La12[2], La12[3]} * xj2;
      X26 -= (f32x2){La13[0], La13[1]} * xj2;
      X27 -= (f32x2){La13[2], La13[3]} * xj2;
      X28 -= (f32x2){La14[0], La14[1]} * xj2;
      X29 -= (f32x2){La14[2], La14[3]} * xj2;
      X30 -= (f32x2){La15[0], La15[1]} * xj2;
      X31 -= (f32x2){La15[2], La15[3]} * xj2;
    }
    __builtin_amdgcn_sched_barrier(0);
    La4 = *(const f32x4*)(Lt_s + 1104);
    La5 = *(const f32x4*)(Lt_s + 1108);
    La6 = *(const f32x4*)(Lt_s + 1112);
    La7 = *(const f32x4*)(Lt_s + 1116);
    La8 = *(const f32x4*)(Lt_s + 1120);
    La9 = *(const f32x4*)(Lt_s + 1124);
    La10 = *(const f32x4*)(Lt_s + 1128);
    La11 = *(const f32x4*)(Lt_s + 1132);
    La12 = *(const f32x4*)(Lt_s + 1136);
    La13 = *(const f32x4*)(Lt_s + 1140);
    La14 = *(const f32x4*)(Lt_s + 1144);
    La15 = *(const f32x4*)(Lt_s + 1148);
    __builtin_amdgcn_sched_barrier(0);
    { const float xj = X7[1]; const f32x2 xj2 = (f32x2){xj, xj};
      X8 -= (f32x2){Lb4[0], Lb4[1]} * xj2;
      X9 -= (f32x2){Lb4[2], Lb4[3]} * xj2;
      X10 -= (f32x2){Lb5[0], Lb5[1]} * xj2;
      X11 -= (f32x2){Lb5[2], Lb5[3]} * xj2;
      X12 -= (f32x2){Lb6[0], Lb6[1]} * xj2;
      X13 -= (f32x2){Lb6[2], Lb6[3]} * xj2;
      X14 -= (f32x2){Lb7[0], Lb7[1]} * xj2;
      X15 -= (f32x2){Lb7[2], Lb7[3]} * xj2;
      X16 -= (f32x2){Lb8[0], Lb8[1]} * xj2;
      X17 -= (f32x2){Lb8[2], Lb8[3]} * xj2;
      X18 -= (f32x2){Lb9[0], Lb9[1]} * xj2;
      X19 -= (f32x2){Lb9[2], Lb9[3]} * xj2;
      X20 -= (f32x2){Lb10[0], Lb10[1]} * xj2;
      X21 -= (f32x2){Lb10[2], Lb10[3]} * xj2;
      X22 -= (f32x2){Lb11[0], Lb11[1]} * xj2;
      X23 -= (f32x2){Lb11[2], Lb11[3]} * xj2;
      X24 -= (f32x2){Lb12[0], Lb12[1]} * xj2;
      X25 -= (f32x2){Lb12[2], Lb12[3]} * xj2;
      X26 -= (f32x2){Lb13[0], Lb13[1]} * xj2;
      X27 -= (f32x2){Lb13[2], Lb13[3]} * xj2;
      X28 -= (f32x2){Lb14[0], Lb14[1]} * xj2;
      X29 -= (f32x2){Lb14[2], Lb14[3]} * xj2;
      X30 -= (f32x2){Lb15[0], Lb15[1]} * xj2;
      X31 -= (f32x2){Lb15[2], Lb15[3]} * xj2;
    }
    __builtin_amdgcn_sched_barrier(0);
    Lb4 = *(const f32x4*)(Lt_s + 1172);
    Lb5 = *(const f32x4*)(Lt_s + 1176);
    Lb6 = *(const f32x4*)(Lt_s + 1180);
    Lb7 = *(const f32x4*)(Lt_s + 1184);
    Lb8 = *(const f32x4*)(Lt_s + 1188);
    Lb9 = *(const f32x4*)(Lt_s + 1192);
    Lb10 = *(const f32x4*)(Lt_s + 1196);
    Lb11 = *(const f32x4*)(Lt_s + 1200);
    Lb12 = *(const f32x4*)(Lt_s + 1204);
    Lb13 = *(const f32x4*)(Lt_s + 1208);
    Lb14 = *(const f32x4*)(Lt_s + 1212);
    Lb15 = *(const f32x4*)(Lt_s + 1216);
    __builtin_amdgcn_sched_barrier(0);
    { const float xj = X8[0]; const f32x2 xj2 = (f32x2){xj, xj};
      X8 -= (f32x2){La4[0], La4[1]} * xj2;
      X9 -= (f32x2){La4[2], La4[3]} * xj2;
      X10 -= (f32x2){La5[0], La5[1]} * xj2;
      X11 -= (f32x2){La5[2], La5[3]} * xj2;
      X12 -= (f32x2){La6[0], La6[1]} * xj2;
      X13 -= (f32x2){La6[2], La6[3]} * xj2;
      X14 -= (f32x2){La7[0], La7[1]} * xj2;
      X15 -= (f32x2){La7[2], La7[3]} * xj2;
      X16 -= (f32x2){La8[0], La8[1]} * xj2;
      X17 -= (f32x2){La8[2], La8[3]} * xj2;
      X18 -= (f32x2){La9[0], La9[1]} * xj2;
      X19 -= (f32x2){La9[2], La9[3]} * xj2;
      X20 -= (f32x2){La10[0], La10[1]} * xj2;
      X21 -= (f32x2){La10[2], La10[3]} * xj2;
      X22 -= (f32x2){La11[0], La11[1]} * xj2;
      X23 -= (f32x2){La11[2], La11[3]} * xj2;
      X24 -= (f32x2){La12[0], La12[1]} * xj2;
      X25 -= (f32x2){La12[2], La12[3]} * xj2;
      X26 -= (f32x2){La13[0], La13[1]} * xj2;
      X27 -= (f32x2){La13[2], La13[3]} * xj2;
      X28 -= (f32x2){La14[0], La14[1]} * xj2;
      X29 -= (f32x2){La14[2], La14[3]} * xj2;
      X30 -= (f32x2){La15[0], La15[1]} * xj2;
      X31 -= (f32x2){La15[2], La15[3]} * xj2;
    }
    __builtin_amdgcn_sched_barrier(0);
    La4 = *(const f32x4*)(Lt_s + 1240);
    La5 = *(const f32x4*)(Lt_s + 1244);
    La6 = *(const f32x4*)(Lt_s + 1248);
    La7 = *(const f32x4*)(Lt_s + 1252);
    La8 = *(const f32x4*)(Lt_s + 1256);
    La9 = *(const f32x4*)(Lt_s + 1260);
    La10 = *(const f32x4*)(Lt_s + 1264);
    La11 = *(const f32x4*)(Lt_s + 1268);
    La12 = *(const f32x4*)(Lt_s + 1272);
    La13 = *(const f32x4*)(Lt_s + 1276);
    La14 = *(const f32x4*)(Lt_s + 1280);
    La15 = *(const f32x4*)(Lt_s + 1284);
    __builtin_amdgcn_sched_barrier(0);
    { const float xj = X8[1]; const f32x2 xj2 = (f32x2){xj, xj};
      X9 -= (f32x2){Lb4[2], Lb4[3]} * xj2;
      X10 -= (f32x2){Lb5[0], Lb5[1]} * xj2;
      X11 -= (f32x2){Lb5[2], Lb5[3]} * xj2;
      X12 -= (f32x2){Lb6[0], Lb6[1]} * xj2;
      X13 -= (f32x2){Lb6[2], Lb6[3]} * xj2;
      X14 -= (f32x2){Lb7[0], Lb7[1]} * xj2;
      X15 -= (f32x2){Lb7[2], Lb7[3]} * xj2;
      X16 -= (f32x2){Lb8[0], Lb8[1]} * xj2;
      X17 -= (f32x2){Lb8[2], Lb8[3]} * xj2;
      X18 -= (f32x2){Lb9[0], Lb9[1]} * xj2;
      X19 -= (f32x2){Lb9[2], Lb9[3]} * xj2;
      X20 -= (f32x2){Lb10[0], Lb10[1]} * xj2;
      X21 -= (f32x2){Lb10[2], Lb10[3]} * xj2;
      X22 -= (f32x2){Lb11[0], Lb11[1]} * xj2;
      X23 -= (f32x2){Lb11[2], Lb11[3]} * xj2;
      X24 -= (f32x2){Lb12[0], Lb12[1]} * xj2;
      X25 -= (f32x2){Lb12[2], Lb12[3]} * xj2;
      X26 -= (f32x2){Lb13[0], Lb13[1]} * xj2;
      X27 -= (f32x2){Lb13[2], Lb13[3]} * xj2;
      X28 -= (f32x2){Lb14[0], Lb14[1]} * xj2;
      X29 -= (f32x2){Lb14[2], Lb14[3]} * xj2;
      X30 -= (f32x2){Lb15[0], Lb15[1]} * xj2;
      X31 -= (f32x2){Lb15[2], Lb15[3]} * xj2;
    }
    __builtin_amdgcn_sched_barrier(0);
    Lb5 = *(const f32x4*)(Lt_s + 1312);
    Lb6 = *(const f32x4*)(Lt_s + 1316);
    Lb7 = *(const f32x4*)(Lt_s + 1320);
    Lb8 = *(const f32x4*)(Lt_s + 1324);
    Lb9 = *(const f32x4*)(Lt_s + 1328);
    Lb10 = *(const f32x4*)(Lt_s + 1332);
    Lb11 = *(const f32x4*)(Lt_s + 1336);
    Lb12 = *(const f32x4*)(Lt_s + 1340);
    Lb13 = *(const f32x4*)(Lt_s + 1344);
    Lb14 = *(const f32x4*)(Lt_s + 1348);
    Lb15 = *(const f32x4*)(Lt_s + 1352);
    __builtin_amdgcn_sched_barrier(0);
    { const float xj = X9[0]; const f32x2 xj2 = (f32x2){xj, xj};
      X9 -= (f32x2){La4[2], La4[3]} * xj2;
      X10 -= (f32x2){La5[0], La5[1]} * xj2;
      X11 -= (f32x2){La5[2], La5[3]} * xj2;
      X12 -= (f32x2){La6[0], La6[1]} * xj2;
      X13 -= (f32x2){La6[2], La6[3]} * xj2;
      X14 -= (f32x2){La7[0], La7[1]} * xj2;
      X15 -= (f32x2){La7[2], La7[3]} * xj2;
      X16 -= (f32x2){La8[0], La8[1]} * xj2;
      X17 -= (f32x2){La8[2], La8[3]} * xj2;
      X18 -= (f32x2){La9[0], La9[1]} * xj2;
      X19 -= (f32x2){La9[2], La9[3]} * xj2;
      X20 -= (f32x2){La10[0], La10[1]} * xj2;
      X21 -= (f32x2){La10[2], La10[3]} * xj2;
      X22 -= (f32x2){La11[0], La11[1]} * xj2;
      X23 -= (f32x2){La11[2], La11[3]} * xj2;
      X24 -= (f32x2){La12[0], La12[1]} * xj2;
      X25 -= (f32x2){La12[2], La12[3]} * xj2;
      X26 -= (f32x2){La13[0], La13[1]} * xj2;
      X27 -= (f32x2){La13[2], La13[3]} * xj2;
      X28 -= (f32x2){La14[0], La14[1]} * xj2;
      X29 -= (f32x2){La14[2], La14[3]} * xj2;
      X30 -= (f32x2){La15[0], La15[1]} * xj2;
      X31 -= (f32x2){La15[2], La15[3]} * xj2;
    }
    __builtin_amdgcn_sched_barrier(0);
    La5 = *(const f32x4*)(Lt_s + 1380);
    La6 = *(const f32x4*)(Lt_s + 1384);
    La7 = *(const f32x4*)(Lt_s + 1388);
    La8 = *(const f32x4*)(Lt_s + 1392);
    La9 = *(const f32x4*)(Lt_s + 1396);
    La10 = *(const f32x4*)(Lt_s + 1400);
    La11 = *(const f32x4*)(Lt_s + 1404);
    La12 = *(const f32x4*)(Lt_s + 1408);
    La13 = *(const f32x4*)(Lt_s + 1412);
    La14 = *(const f32x4*)(Lt_s + 1416);
    La15 = *(const f32x4*)(Lt_s + 1420);
    __builtin_amdgcn_sched_barrier(0);
    { const float xj = X9[1]; const f32x2 xj2 = (f32x2){xj, xj};
      X10 -= (f32x2){Lb5[0], Lb5[1]} * xj2;
      X11 -= (f32x2){Lb5[2], Lb5[3]} * xj2;
      X12 -= (f32x2){Lb6[0], Lb6[1]} * xj2;
      X13 -= (f32x2){Lb6[2], Lb6[3]} * xj2;
      X14 -= (f32x2){Lb7[0], Lb7[1]} * xj2;
      X15 -= (f32x2){Lb7[2], Lb7[3]} * xj2;
      X16 -= (f32x2){Lb8[0], Lb8[1]} * xj2;
      X17 -= (f32x2){Lb8[2], Lb8[3]} * xj2;
      X18 -= (f32x2){Lb9[0], Lb9[1]} * xj2;
      X19 -= (f32x2){Lb9[2], Lb9[3]} * xj2;
      X20 -= (f32x2){Lb10[0], Lb10[1]} * xj2;
      X21 -= (f32x2){Lb10[2], Lb10[3]} * xj2;
      X22 -= (f32x2){Lb11[0], Lb11[1]} * xj2;
      X23 -= (f32x2){Lb11[2], Lb11[3]} * xj2;
      X24 -= (f32x2){Lb12[0], Lb12[1]} * xj2;
      X25 -= (f32x2){Lb12[2], Lb12[3]} * xj2;
      X26 -= (f32x2){Lb13[0], Lb13[1]} * xj2;
      X27 -= (f32x2){Lb13[2], Lb13[3]} * xj2;
      X28 -= (f32x2){Lb14[0], Lb14[1]} * xj2;
      X29 -= (f32x2){Lb14[2], Lb14[3]} * xj2;
      X30 -= (f32x2){Lb15[0], Lb15[1]} * xj2;
      X31 -= (f32x2){Lb15[2], Lb15[3]} * xj2;
    }
    __builtin_amdgcn_sched_barrier(0);
    Lb5 = *(const f32x4*)(Lt_s + 1448);
    Lb6 = *(const f32x4*)(Lt_s + 1452);
    Lb7 = *(const f32x4*)(Lt_s + 1456);
    Lb8 = *(const f32x4*)(Lt_s + 1460);
    Lb9 = *(const f32x4*)(Lt_s + 1464);
    Lb10 = *(const f32x4*)(Lt_s + 1468);
    Lb11 = *(const f32x4*)(Lt_s + 1472);
    Lb12 = *(const f32x4*)(Lt_s + 1476);
    Lb13 = *(const f32x4*)(Lt_s + 1480);
    Lb14 = *(const f32x4*)(Lt_s + 1484);
    Lb15 = *(const f32x4*)(Lt_s + 1488);
    __builtin_amdgcn_sched_barrier(0);
    { const float xj = X10[0]; const f32x2 xj2 = (f32x2){xj, xj};
      X10 -= (f32x2){La5[0], La5[1]} * xj2;
      X11 -= (f32x2){La5[2], La5[3]} * xj2;
      X12 -= (f32x2){La6[0], La6[1]} * xj2;
      X13 -= (f32x2){La6[2], La6[3]} * xj2;
      X14 -= (f32x2){La7[0], La7[1]} * xj2;
      X15 -= (f32x2){La7[2], La7[3]} * xj2;
      X16 -= (f32x2){La8[0], La8[1]} * xj2;
      X17 -= (f32x2){La8[2], La8[3]} * xj2;
      X18 -= (f32x2){La9[0], La9[1]} * xj2;
      X19 -= (f32x2){La9[2], La9[3]} * xj2;
      X20 -= (f32x2){La10[0], La10[1]} * xj2;
      X21 -= (f32x2){La10[2], La10[3]} * xj2;
      X22 -= (f32x2){La11[0], La11[1]} * xj2;
      X23 -= (f32x2){La11[2], La11[3]} * xj2;
      X24 -= (f32x2){La12[0], La12[1]} * xj2;
      X25 -= (f32x2){La12[2], La12[3]} * xj2;
      X26 -= (f32x2){La13[0], La13[1]} * xj2;
      X27 -= (f32x2){La13[2], La13[3]} * xj2;
      X28 -= (f32x2){La14[0], La14[1]} * xj2;
      X29 -= (f32x2){La14[2], La14[3]} * xj2;
      X30 -= (f32x2){La15[0], La15[1]} * xj2;
      X31 -= (f32x2){La15[2], La15[3]} * xj2;
    }
    __builtin_amdgcn_sched_barrier(0);
    La5 = *(const f32x4*)(Lt_s + 1516);
    La6 = *(const f32x4*)(Lt_s + 1520);
    La7 = *(const f32x4*)(Lt_s + 1524);
    La8 = *(const f32x4*)(Lt_s + 1528);
    La9 = *(const f32x4*)(Lt_s + 1532);
    La10 = *(const f32x4*)(Lt_s + 1536);
    La11 = *(const f32x4*)(Lt_s + 1540);
    La12 = *(const f32x4*)(Lt_s + 1544);
    La13 = *(const f32x4*)(Lt_s + 1548);
    La14 = *(const f32x4*)(Lt_s + 1552);
    La15 = *(const f32x4*)(Lt_s + 1556);
    __builtin_amdgcn_sched_barrier(0);
    { const float xj = X10[1]; const f32x2 xj2 = (f32x2){xj, xj};
      X11 -= (f32x2){Lb5[2], Lb5[3]} * xj2;
      X12 -= (f32x2){Lb6[0], Lb6[1]} * xj2;
      X13 -= (f32x2){Lb6[2], Lb6[3]} * xj2;
      X14 -= (f32x2){Lb7[0], Lb7[1]} * xj2;
      X15 -= (f32x2){Lb7[2], Lb7[3]} * xj2;
      X16 -= (f32x2){Lb8[0], Lb8[1]} * xj2;
      X17 -= (f32x2){Lb8[2], Lb8[3]} * xj2;
      X18 -= (f32x2){Lb9[0], Lb9[1]} * xj2;
      X19 -= (f32x2){Lb9[2], Lb9[3]} * xj2;
      X20 -= (f32x2){Lb10[0], Lb10[1]} * xj2;
      X21 -= (f32x2){Lb10[2], Lb10[3]} * xj2;
      X22 -= (f32x2){Lb11[0], Lb11[1]} * xj2;
      X23 -= (f32x2){Lb11[2], Lb11[3]} * xj2;
      X24 -= (f32x2){Lb12[0], Lb12[1]} * xj2;
      X25 -= (f32x2){Lb12[2], Lb12[3]} * xj2;
      X26 -= (f32x2){Lb13[0], Lb13[1]} * xj2;
      X27 -= (f32x2){Lb13[2], Lb13[3]} * xj2;
      X28 -= (f32x2){Lb14[0], Lb14[1]} * xj2;
      X29 -= (f32x2){Lb14[2], Lb14[3]} * xj2;
      X30 -= (f32x2){Lb15[0], Lb15[1]} * xj2;
      X31 -= (f32x2){Lb15[2], Lb15[3]} * xj2;
    }
    __builtin_amdgcn_sched_barrier(0);
    Lb6 = *(const f32x4*)(Lt_s + 1588);
    Lb7 = *(const f32x4*)(Lt_s + 1592);
    Lb8 = *(const f32x4*)(Lt_s + 1596);
    Lb9 = *(const f32x4*)(Lt_s + 1600);
    Lb10 = *(const f32x4*)(Lt_s + 1604);
    Lb11 = *(const f32x4*)(Lt_s + 1608);
    Lb12 = *(const f32x4*)(Lt_s + 1612);
    Lb13 = *(const f32x4*)(Lt_s + 1616);
    Lb14 = *(const f32x4*)(Lt_s + 1620);
    Lb15 = *(const f32x4*)(Lt_s + 1624);
    __builtin_amdgcn_sched_barrier(0);
    { const float xj = X11[0]; const f32x2 xj2 = (f32x2){xj, xj};
      X11 -= (f32x2){La5[2], La5[3]} * xj2;
      X12 -= (f32x2){La6[0], La6[1]} * xj2;
      X13 -= (f32x2){La6[2], La6[3]} * xj2;
      X14 -= (f32x2){La7[0], La7[1]} * xj2;
      X15 -= (f32x2){La7[2], La7[3]} * xj2;
      X16 -= (f32x2){La8[0], La8[1]} * xj2;
      X17 -= (f32x2){La8[2], La8[3]} * xj2;
      X18 -= (f32x2){La9[0], La9[1]} * xj2;
      X19 -= (f32x2){La9[2], La9[3]} * xj2;
      X20 -= (f32x2){La10[0], La10[1]} * xj2;
      X21 -= (f32x2){La10[2], La10[3]} * xj2;
      X22 -= (f32x2){La11[0], La11[1]} * xj2;
      X23 -= (f32x2){La11[2], La11[3]} * xj2;
      X24 -= (f32x2){La12[0], La12[1]} * xj2;
      X25 -= (f32x2){La12[2], La12[3]} * xj2;
      X26 -= (f32x2){La13[0], La13[1]} * xj2;
      X27 -= (f32x2){La13[2], La13[3]} * xj2;
      X28 -= (f32x2){La14[0], La14[1]} * xj2;
      X29 -= (f32x2){La14[2], La14[3]} * xj2;
      X30 -= (f32x2){La15[0], La15[1]} * xj2;
      X31 -= (f32x2){La15[2], La15[3]} * xj2;
    }
    __builtin_amdgcn_sched_barrier(0);
    La6 = *(const f32x4*)(Lt_s + 1656);
    La7 = *(const f32x4*)(Lt_s + 1660);
    La8 = *(const f32x4*)(Lt_s + 1664);
    La9 = *(const f32x4*)(Lt_s + 1668);
    La10 = *(const f32x4*)(Lt_s + 1672);
    La11 = *(const f32x4*)(Lt_s + 1676);
    La12 = *(const f32x4*)(Lt_s + 1680);
    La13 = *(const f32x4*)(Lt_s + 1684);
    La14 = *(const f32x4*)(Lt_s + 1688);
    La15 = *(const f32x4*)(Lt_s + 1692);
    __builtin_amdgcn_sched_barrier(0);
    { const float xj = X11[1]; const f32x2 xj2 = (f32x2){xj, xj};
      X12 -= (f32x2){Lb6[0], Lb6[1]} * xj2;
      X13 -= (f32x2){Lb6[2], Lb6[3]} * xj2;
      X14 -= (f32x2){Lb7[0], Lb7[1]} * xj2;
      X15 -= (f32x2){Lb7[2], Lb7[3]} * xj2;
      X16 -= (f32x2){Lb8[0], Lb8[1]} * xj2;
      X17 -= (f32x2){Lb8[2], Lb8[3]} * xj2;
      X18 -= (f32x2){Lb9[0], Lb9[1]} * xj2;
      X19 -= (f32x2){Lb9[2], Lb9[3]} * xj2;
      X20 -= (f32x2){Lb10[0], Lb10[1]} * xj2;
      X21 -= (f32x2){Lb10[2], Lb10[3]} * xj2;
      X22 -= (f32x2){Lb11[0], Lb11[1]} * xj2;
      X23 -= (f32x2){Lb11[2], Lb11[3]} * xj2;
      X24 -= (f32x2){Lb12[0], Lb12[1]} * xj2;
      X25 -= (f32x2){Lb12[2], Lb12[3]} * xj2;
      X26 -= (f32x2){Lb13[0], Lb13[1]} * xj2;
      X27 -= (f32x2){Lb13[2], Lb13[3]} * xj2;
      X28 -= (f32x2){Lb14[0], Lb14[1]} * xj2;
      X29 -= (f32x2){Lb14[2], Lb14[3]} * xj2;
      X30 -= (f32x2){Lb15[0], Lb15[1]} * xj2;
      X31 -= (f32x2){Lb15[2], Lb15[3]} * xj2;
    }
    __builtin_amdgcn_sched_barrier(0);
    Lb6 = *(const f32x4*)(Lt_s + 1724);
    Lb7 = *(const f32x4*)(Lt_s + 1728);
    Lb8 = *(const f32x4*)(Lt_s + 1732);
    Lb9 = *(const f32x4*)(Lt_s + 1736);
    Lb10 = *(const f32x4*)(Lt_s + 1740);
    Lb11 = *(const f32x4*)(Lt_s + 1744);
    Lb12 = *(const f32x4*)(Lt_s + 1748);
    Lb13 = *(const f32x4*)(Lt_s + 1752);
    Lb14 = *(const f32x4*)(Lt_s + 1756);
    Lb15 = *(const f32x4*)(Lt_s + 1760);
    __builtin_amdgcn_sched_barrier(0);
    { const float xj = X12[0]; const f32x2 xj2 = (f32x2){xj, xj};
      X12 -= (f32x2){La6[0], La6[1]} * xj2;
      X13 -= (f32x2){La6[2], La6[3]} * xj2;
      X14 -= (f32x2){La7[0], La7[1]} * xj2;
      X15 -= (f32x2){La7[2], La7[3]} * xj2;
      X16 -= (f32x2){La8[0], La8[1]} * xj2;
      X17 -= (f32x2){La8[2], La8[3]} * xj2;
      X18 -= (f32x2){La9[0], La9[1]} * xj2;
      X19 -= (f32x2){La9[2], La9[3]} * xj2;
      X20 -= (f32x2){La10[0], La10[1]} * xj2;
      X21 -= (f32x2){La10[2], La10[3]} * xj2;
      X22 -= (f32x2){La11[0], La11[1]} * xj2;
      X23 -= (f32x2){La11[2], La11[3]} * xj2;
      X24 -= (f32x2){La12[0], La12[1]} * xj2;
      X25 -= (f32x2){La12[2], La12[3]} * xj2;
      X26 -= (f32x2){La13[0], La13[1]} * xj2;
      X27 -= (f32x2){La13[2], La13[3]} * xj2;
      X28 -= (f32x2){La14[0], La14[1]} * xj2;
      X29 -= (f32x2){La14[2], La14[3]} * xj2;
      X30 -= (f32x2){La15[0], La15[1]} * xj2;
      X31 -= (f32x2){La15[2], La15[3]} * xj2;
    }
    __builtin_amdgcn_sched_barrier(0);
    La6 = *(const f32x4*)(Lt_s + 1792);
    La7 = *(const f32x4*)(Lt_s + 1796);
    La8 = *(const f32x4*)(Lt_s + 1800);
    La9 = *(const f32x4*)(Lt_s + 1804);
    La10 = *(const f32x4*)(Lt_s + 1808);
    La11 = *(const f32x4*)(Lt_s + 1812);
    La12 = *(const f32x4*)(Lt_s + 1816);
    La13 = *(const f32x4*)(Lt_s + 1820);
    La14 = *(const f32x4*)(Lt_s + 1824);
    La15 = *(const f32x4*)(Lt_s + 1828);
    __builtin_amdgcn_sched_barrier(0);
    { const float xj = X12[1]; const f32x2 xj2 = (f32x2){xj, xj};
      X13 -= (f32x2){Lb6[2], Lb6[3]} * xj2;
      X14 -= (f32x2){Lb7[0], Lb7[1]} * xj2;
      X15 -= (f32x2){Lb7[2], Lb7[3]} * xj2;
      X16 -= (f32x2){Lb8[0], Lb8[1]} * xj2;
      X17 -= (f32x2){Lb8[2], Lb8[3]} * xj2;
      X18 -= (f32x2){Lb9[0], Lb9[1]} * xj2;
      X19 -= (f32x2){Lb9[2], Lb9[3]} * xj2;
      X20 -= (f32x2){Lb10[0], Lb10[1]} * xj2;
      X21 -= (f32x2){Lb10[2], Lb10[3]} * xj2;
      X22 -= (f32x2){Lb11[0], Lb11[1]} * xj2;
      X23 -= (f32x2){Lb11[2], Lb11[3]} * xj2;
      X24 -= (f32x2){Lb12[0], Lb12[1]} * xj2;
      X25 -= (f32x2){Lb12[2], Lb12[3]} * xj2;
      X26 -= (f32x2){Lb13[0], Lb13[1]} * xj2;
      X27 -= (f32x2){Lb13[2], Lb13[3]} * xj2;
      X28 -= (f32x2){Lb14[0], Lb14[1]} * xj2;
      X29 -= (f32x2){Lb14[2], Lb14[3]} * xj2;
      X30 -= (f32x2){Lb15[0], Lb15[1]} * xj2;
      X31 -= (f32x2){Lb15[2], Lb15[3]} * xj2;
    }
    __builtin_amdgcn_sched_barrier(0);
    Lb7 = *(const f32x4*)(Lt_s + 1864);
    Lb8 = *(const f32x4*)(Lt_s + 1868);
    Lb9 = *(const f32x4*)(Lt_s + 1872);
    Lb10 = *(const f32x4*)(Lt_s + 1876);
    Lb11 = *(const f32x4*)(Lt_s + 1880);
    Lb12 = *(const f32x4*)(Lt_s + 1884);
    Lb13 = *(const f32x4*)(Lt_s + 1888);
    Lb14 = *(const f32x4*)(Lt_s + 1892);
    Lb15 = *(const f32x4*)(Lt_s + 1896);
    __builtin_amdgcn_sched_barrier(0);
    { const float xj = X13[0]; const f32x2 xj2 = (f32x2){xj, xj};
      X13 -= (f32x2){La6[2], La6[3]} * xj2;
      X14 -= (f32x2){La7[0], La7[1]} * xj2;
      X15 -= (f32x2){La7[2], La7[3]} * xj2;
      X16 -= (f32x2){La8[0], La8[1]} * xj2;
      X17 -= (f32x2){La8[2], La8[3]} * xj2;
      X18 -= (f32x2){La9[0], La9[1]} * xj2;
      X19 -= (f32x2){La9[2], La9[3]} * xj2;
      X20 -= (f32x2){La10[0], La10[1]} * xj2;
      X21 -= (f32x2){La10[2], La10[3]} * xj2;
      X22 -= (f32x2){La11[0], La11[1]} * xj2;
      X23 -= (f32x2){La11[2], La11[3]} * xj2;
      X24 -= (f32x2){La12[0], La12[1]} * xj2;
      X25 -= (f32x2){La12[2], La12[3]} * xj2;
      X26 -= (f32x2){La13[0], La13[1]} * xj2;
      X27 -= (f32x2){La13[2], La13[3]} * xj2;
      X28 -= (f32x2){La14[0], La14[1]} * xj2;
      X29 -= (f32x2){La14[2], La14[3]} * xj2;
      X30 -= (f32x2){La15[0], La15[1]} * xj2;
      X31 -= (f32x2){La15[2], La15[3]} * xj2;
    }
    __builtin_amdgcn_sched_barrier(0);
    La7 = *(const f32x4*)(Lt_s + 1932);
    La8 = *(const f32x4*)(Lt_s + 1936);
    La9 = *(const f32x4*)(Lt_s + 1940);
    La10 = *(const f32x4*)(Lt_s + 1944);
    La11 = *(const f32x4*)(Lt_s + 1948);
    La12 = *(const f32x4*)(Lt_s + 1952);
    La13 = *(const f32x4*)(Lt_s + 1956);
    La14 = *(const f32x4*)(Lt_s + 1960);
    La15 = *(const f32x4*)(Lt_s + 1964);
    __builtin_amdgcn_sched_barrier(0);
    { const float xj = X13[1]; const f32x2 xj2 = (f32x2){xj, xj};
      X14 -= (f32x2){Lb7[0], Lb7[1]} * xj2;
      X15 -= (f32x2){Lb7[2], Lb7[3]} * xj2;
      X16 -= (f32x2){Lb8[0], Lb8[1]} * xj2;
      X17 -= (f32x2){Lb8[2], Lb8[3]} * xj2;
      X18 -= (f32x2){Lb9[0], Lb9[1]} * xj2;
      X19 -= (f32x2){Lb9[2], Lb9[3]} * xj2;
      X20 -= (f32x2){Lb10[0], Lb10[1]} * xj2;
      X21 -= (f32x2){Lb10[2], Lb10[3]} * xj2;
      X22 -= (f32x2){Lb11[0], Lb11[1]} * xj2;
      X23 -= (f32x2){Lb11[2], Lb11[3]} * xj2;
      X24 -= (f32x2){Lb12[0], Lb12[1]} * xj2;
      X25 -= (f32x2){Lb12[2], Lb12[3]} * xj2;
      X26 -= (f32x2){Lb13[0], Lb13[1]} * xj2;
      X27 -= (f32x2){Lb13[2], Lb13[3]} * xj2;
      X28 -= (f32x2){Lb14[0], Lb14[1]} * xj2;
      X29 -= (f32x2){Lb14[2], Lb14[3]} * xj2;
      X30 -= (f32x2){Lb15[0], Lb15[1]} * xj2;
      X31 -= (f32x2){Lb15[2], Lb15[3]} * xj2;
    }
    __builtin_amdgcn_sched_barrier(0);
    Lb7 = *(const f32x4*)(Lt_s + 2000);
    Lb8 = *(const f32x4*)(Lt_s + 2004);
    Lb9 = *(const f32x4*)(Lt_s + 2008);
    Lb10 = *(const f32x4*)(Lt_s + 2012);
    Lb11 = *(const f32x4*)(Lt_s + 2016);
    Lb12 = *(const f32x4*)(Lt_s + 2020);
    Lb13 = *(const f32x4*)(Lt_s + 2024);
    Lb14 = *(const f32x4*)(Lt_s + 2028);
    Lb15 = *(const f32x4*)(Lt_s + 2032);
    __builtin_amdgcn_sched_barrier(0);
    { const float xj = X14[0]; const f32x2 xj2 = (f32x2){xj, xj};
      X14 -= (f32x2){La7[0], La7[1]} * xj2;
      X15 -= (f32x2){La7[2], La7[3]} * xj2;
      X16 -= (f32x2){La8[0], La8[1]} * xj2;
      X17 -= (f32x2){La8[2], La8[3]} * xj2;
      X18 -= (f32x2){La9[0], La9[1]} * xj2;
      X19 -= (f32x2){La9[2], La9[3]} * xj2;
      X20 -= (f32x2){La10[0], La10[1]} * xj2;
      X21 -= (f32x2){La10[2], La10[3]} * xj2;
      X22 -= (f32x2){La11[0], La11[1]} * xj2;
      X23 -= (f32x2){La11[2], La11[3]} * xj2;
      X24 -= (f32x2){La12[0], La12[1]} * xj2;
      X25 -= (f32x2){La12[2], La12[3]} * xj2;
      X26 -= (f32x2){La13[0], La13[1]} * xj2;
      X27 -= (f32x2){La13[2], La13[3]} * xj2;
      X28 -= (f32x2){La14[0], La14[1]} * xj2;
      X29 -= (f32x2){La14[2], La14[3]} * xj2;
      X30 -= (f32x2){La15[0], La15[1]} * xj2;
      X31 -= (f32x2){La15[2], La15[3]} * xj2;
    }
    __builtin_amdgcn_sched_barrier(0);
    La7 = *(const f32x4*)(Lt_s + 2068);
    La8 = *(const f32x4*)(Lt_s + 2072);
    La9 = *(const f32x4*)(Lt_s + 2076);
    La10 = *(const f32x4*)(Lt_s + 2080);
    La11 = *(const f32x4*)(Lt_s + 2084);
    La12 = *(const f32x4*)(Lt_s + 2088);
    La13 = *(const f32x4*)(Lt_s + 2092);
    La14 = *(const f32x4*)(Lt_s + 2096);
    La15 = *(const f32x4*)(Lt_s + 2100);
    __builtin_amdgcn_sched_barrier(0);
    { const float xj = X14[1]; const f32x2 xj2 = (f32x2){xj, xj};
      X15 -= (f32x2){Lb7[2], Lb7[3]} * xj2;
      X16 -= (f32x2){Lb8[0], Lb8[1]} * xj2;
      X17 -= (f32x2){Lb8[2], Lb8[3]} * xj2;
      X18 -= (f32x2){Lb9[0], Lb9[1]} * xj2;
      X19 -= (f32x2){Lb9[2], Lb9[3]} * xj2;
      X20 -= (f32x2){Lb10[0], Lb10[1]} * xj2;
      X21 -= (f32x2){Lb10[2], Lb10[3]} * xj2;
      X22 -= (f32x2){Lb11[0], Lb11[1]} * xj2;
      X23 -= (f32x2){Lb11[2], Lb11[3]} * xj2;
      X24 -= (f32x2){Lb12[0], Lb12[1]} * xj2;
      X25 -= (f32x2){Lb12[2], Lb12[3]} * xj2;
      X26 -= (f32x2){Lb13[0], Lb13[1]} * xj2;
      X27 -= (f32x2){Lb13[2], Lb13[3]} * xj2;
      X28 -= (f32x2){Lb14[0], Lb14[1]} * xj2;
      X29 -= (f32x2){Lb14[2], Lb14[3]} * xj2;
      X30 -= (f32x2){Lb15[0], Lb15[1]} * xj2;
      X31 -= (f32x2){Lb15[2], Lb15[3]} * xj2;
    }
    __builtin_amdgcn_sched_barrier(0);
    Lb8 = *(const f32x4*)(Lt_s + 2140);
    Lb9 = *(const f32x4*)(Lt_s + 2144);
    Lb10 = *(const f32x4*)(Lt_s + 2148);
    Lb11 = *(const f32x4*)(Lt_s + 2152);
    Lb12 = *(const f32x4*)(Lt_s + 2156);
    Lb13 = *(const f32x4*)(Lt_s + 2160);
    Lb14 = *(const f32x4*)(Lt_s + 2164);
    Lb15 = *(const f32x4*)(Lt_s + 2168);
    __builtin_amdgcn_sched_barrier(0);
    { const float xj = X15[0]; const f32x2 xj2 = (f32x2){xj, xj};
      X15 -= (f32x2){La7[2], La7[3]} * xj2;
      X16 -= (f32x2){La8[0], La8[1]} * xj2;
      X17 -= (f32x2){La8[2], La8[3]} * xj2;
      X18 -= (f32x2){La9[0], La9[1]} * xj2;
      X19 -= (f32x2){La9[2], La9[3]} * xj2;
      X20 -= (f32x2){La10[0], La10[1]} * xj2;
      X21 -= (f32x2){La10[2], La10[3]} * xj2;
      X22 -= (f32x2){La11[0], La11[1]} * xj2;
      X23 -= (f32x2){La11[2], La11[3]} * xj2;
      X24 -= (f32x2){La12[0], La12[1]} * xj2;
      X25 -= (f32x2){La12[2], La12[3]} * xj2;
      X26 -= (f32x2){La13[0], La13[1]} * xj2;
      X27 -= (f32x2){La13[2], La13[3]} * xj2;
      X28 -= (f32x2){La14[0], La14[1]} * xj2;
      X29 -= (f32x2){La14[2], La14[3]} * xj2;
      X30 -= (f32x2){La15[0], La15[1]} * xj2;
      X31 -= (f32x2){La15[2], La15[3]} * xj2;
    }
    __builtin_amdgcn_sched_barrier(0);
    La8 = *(const f32x4*)(Lt_s + 2208);
    La9 = *(const f32x4*)(Lt_s + 2212);
    La10 = *(const f32x4*)(Lt_s + 2216);
    La11 = *(const f32x4*)(Lt_s + 2220);
    La12 = *(const f32x4*)(Lt_s + 2224);
    La13 = *(const f32x4*)(Lt_s + 2228);
    La14 = *(const f32x4*)(Lt_s + 2232);
    La15 = *(const f32x4*)(Lt_s + 2236);
    __builtin_amdgcn_sched_barrier(0);
    { const float xj = X15[1]; const f32x2 xj2 = (f32x2){xj, xj};
      X16 -= (f32x2){Lb8[0], Lb8[1]} * xj2;
      X17 -= (f32x2){Lb8[2], Lb8[3]} * xj2;
      X18 -= (f32x2){Lb9[0], Lb9[1]} * xj2;
      X19 -= (f32x2){Lb9[2], Lb9[3]} * xj2;
      X20 -= (f32x2){Lb10[0], Lb10[1]} * xj2;
      X21 -= (f32x2){Lb10[2], Lb10[3]} * xj2;
      X22 -= (f32x2){Lb11[0], Lb11[1]} * xj2;
      X23 -= (f32x2){Lb11[2], Lb11[3]} * xj2;
      X24 -= (f32x2){Lb12[0], Lb12[1]} * xj2;
      X25 -= (f32x2){Lb12[2], Lb12[3]} * xj2;
      X26 -= (f32x2){Lb13[0], Lb13[1]} * xj2;
      X27 -= (f32x2){Lb13[2], Lb13[3]} * xj2;
      X28 -= (f32x2){Lb14[0], Lb14[1]} * xj2;
      X29 -= (f32x2){Lb14[2], Lb14[3]} * xj2;
      X30 -= (f32x2){Lb15[0], Lb15[1]} * xj2;
      X31 -= (f32x2){Lb15[2], Lb15[3]} * xj2;
    }
    __builtin_amdgcn_sched_barrier(0);
    Lb8 = *(const f32x4*)(Lt_s + 2276);
    Lb9 = *(const f32x4*)(Lt_s + 2280);
    Lb10 = *(const f32x4*)(Lt_s + 2284);
    Lb11 = *(const f32x4*)(Lt_s + 2288);
    Lb12 = *(const f32x4*)(Lt_s + 2292);
    Lb13 = *(const f32x4*)(Lt_s + 2296);
    Lb14 = *(const f32x4*)(Lt_s + 2300);
    Lb15 = *(const f32x4*)(Lt_s + 2304);
    __builtin_amdgcn_sched_barrier(0);
    { const float xj = X16[0]; const f32x2 xj2 = (f32x2){xj, xj};
      X16 -= (f32x2){La8[0], La8[1]} * xj2;
      X17 -= (f32x2){La8[2], La8[3]} * xj2;
      X18 -= (f32x2){La9[0], La9[1]} * xj2;
      X19 -= (f32x2){La9[2], La9[3]} * xj2;
      X20 -= (f32x2){La10[0], La10[1]} * xj2;
      X21 -= (f32x2){La10[2], La10[3]} * xj2;
      X22 -= (f32x2){La11[0], La11[1]} * xj2;
      X23 -= (f32x2){La11[2], La11[3]} * xj2;
      X24 -= (f32x2){La12[0], La12[1]} * xj2;
      X25 -= (f32x2){La12[2], La12[3]} * xj2;
      X26 -= (f32x2){La13[0], La13[1]} * xj2;
      X27 -= (f32x2){La13[2], La13[3]} * xj2;
      X28 -= (f32x2){La14[0], La14[1]} * xj2;
      X29 -= (f32x2){La14[2], La14[3]} * xj2;
      X30 -= (f32x2){La15[0], La15[1]} * xj2;
      X31 -= (f32x2){La15[2], La15[3]} * xj2;
    }
    __builtin_amdgcn_sched_barrier(0);
    La8 = *(const f32x4*)(Lt_s + 2344);
    La9 = *(const f32x4*)(Lt_s + 2348);
    La10 = *(const f32x4*)(Lt_s + 2352);
    La11 = *(const f32x4*)(Lt_s + 2356);
    La12 = *(const f32x4*)(Lt_s + 2360);
    La13 = *(const f32x4*)(Lt_s + 2364);
    La14 = *(const f32x4*)(Lt_s + 2368);
    La15 = *(const f32x4*)(Lt_s + 2372);
    __builtin_amdgcn_sched_barrier(0);
    { const float xj = X16[1]; const f32x2 xj2 = (f32x2){xj, xj};
      X17 -= (f32x2){Lb8[2], Lb8[3]} * xj2;
      X18 -= (f32x2){Lb9[0], Lb9[1]} * xj2;
      X19 -= (f32x2){Lb9[2], Lb9[3]} * xj2;
      X20 -= (f32x2){Lb10[0], Lb10[1]} * xj2;
      X21 -= (f32x2){Lb10[2], Lb10[3]} * xj2;
      X22 -= (f32x2){Lb11[0], Lb11[1]} * xj2;
      X23 -= (f32x2){Lb11[2], Lb11[3]} * xj2;
      X24 -= (f32x2){Lb12[0], Lb12[1]} * xj2;
      X25 -= (f32x2){Lb12[2], Lb12[3]} * xj2;
      X26 -= (f32x2){Lb13[0], Lb13[1]} * xj2;
      X27 -= (f32x2){Lb13[2], Lb13[3]} * xj2;
      X28 -= (f32x2){Lb14[0], Lb14[1]} * xj2;
      X29 -= (f32x2){Lb14[2], Lb14[3]} * xj2;
      X30 -= (f32x2){Lb15[0], Lb15[1]} * xj2;
      X31 -= (f32x2){Lb15[2], Lb15[3]} * xj2;
    }
    __builtin_amdgcn_sched_barrier(0);
    Lb9 = *(const f32x4*)(Lt_s + 2416);
    Lb10 = *(const f32x4*)(Lt_s + 2420);
    Lb11 = *(const f32x4*)(Lt_s + 2424);
    Lb12 = *(const f32x4*)(Lt_s + 2428);
    Lb13 = *(const f32x4*)(Lt_s + 2432);
    Lb14 = *(const f32x4*)(Lt_s + 2436);
    Lb15 = *(const f32x4*)(Lt_s + 2440);
    __builtin_amdgcn_sched_barrier(0);
    { const float xj = X17[0]; const f32x2 xj2 = (f32x2){xj, xj};
      X17 -= (f32x2){La8[2], La8[3]} * xj2;
      X18 -= (f32x2){La9[0], La9[1]} * xj2;
      X19 -= (f32x2){La9[2], La9[3]} * xj2;
      X20 -= (f32x2){La10[0], La10[1]} * xj2;
      X21 -= (f32x2){La10[2], La10[3]} * xj2;
      X22 -= (f32x2){La11[0], La11[1]} * xj2;
      X23 -= (f32x2){La11[2], La11[3]} * xj2;
      X24 -= (f32x2){La12[0], La12[1]} * xj2;
      X25 -= (f32x2){La12[2], La12[3]} * xj2;
      X26 -= (f32x2){La13[0], La13[1]} * xj2;
      X27 -= (f32x2){La13[2], La13[3]} * xj2;
      X28 -= (f32x2){La14[0], La14[1]} * xj2;
      X29 -= (f32x2){La14[2], La14[3]} * xj2;
      X30 -= (f32x2){La15[0], La15[1]} * xj2;
      X31 -= (f32x2){La15[2], La15[3]} * xj2;
    }
    __builtin_amdgcn_sched_barrier(0);
    La9 = *(const f32x4*)(Lt_s + 2484);
    La10 = *(const f32x4*)(Lt_s + 2488);
    La11 = *(const f32x4*)(Lt_s + 2492);
    La12 = *(const f32x4*)(Lt_s + 2496);
    La13 = *(const f32x4*)(Lt_s + 2500);
    La14 = *(const f32x4*)(Lt_s + 2504);
    La15 = *(const f32x4*)(Lt_s + 2508);
    __builtin_amdgcn_sched_barrier(0);
    { const float xj = X17[1]; const f32x2 xj2 = (f32x2){xj, xj};
      X18 -= (f32x2){Lb9[0], Lb9[1]} * xj2;
      X19 -= (f32x2){Lb9[2], Lb9[3]} * xj2;
      X20 -= (f32x2){Lb10[0], Lb10[1]} * xj2;
      X21 -= (f32x2){Lb10[2], Lb10[3]} * xj2;
      X22 -= (f32x2){Lb11[0], Lb11[1]} * xj2;
      X23 -= (f32x2){Lb11[2], Lb11[3]} * xj2;
      X24 -= (f32x2){Lb12[0], Lb12[1]} * xj2;
      X25 -= (f32x2){Lb12[2], Lb12[3]} * xj2;
      X26 -= (f32x2){Lb13[0], Lb13[1]} * xj2;
      X27 -= (f32x2){Lb13[2], Lb13[3]} * xj2;
      X28 -= (f32x2){Lb14[0], Lb14[1]} * xj2;
      X29 -= (f32x2){Lb14[2], Lb14[3]} * xj2;
      X30 -= (f32x2){Lb15[0], Lb15[1]} * xj2;
      X31 -= (f32x2){Lb15[2], Lb15[3]} * xj2;
    }
    __builtin_amdgcn_sched_barrier(0);
    Lb9 = *(const f32x4*)(Lt_s + 2552);
    Lb10 = *(const f32x4*)(Lt_s + 2556);
    Lb11 = *(const f32x4*)(Lt_s + 2560);
    Lb12 = *(const f32x4*)(Lt_s + 2564);
    Lb13 = *(const f32x4*)(Lt_s + 2568);
    Lb14 = *(const f32x4*)(Lt_s + 2572);
    Lb15 = *(const f32x4*)(Lt_s + 2576);
    __builtin_amdgcn_sched_barrier(0);
    { const float xj = X18[0]; const f32x2 xj2 = (f32x2){xj, xj};
      X18 -= (f32x2){La9[0], La9[1]} * xj2;
      X19 -= (f32x2){La9[2], La9[3]} * xj2;
      X20 -= (f32x2){La10[0], La10[1]} * xj2;
      X21 -= (f32x2){La10[2], La10[3]} * xj2;
      X22 -= (f32x2){La11[0], La11[1]} * xj2;
      X23 -= (f32x2){La11[2], La11[3]} * xj2;
      X24 -= (f32x2){La12[0], La12[1]} * xj2;
      X25 -= (f32x2){La12[2], La12[3]} * xj2;
      X26 -= (f32x2){La13[0], La13[1]} * xj2;
      X27 -= (f32x2){La13[2], La13[3]} * xj2;
      X28 -= (f32x2){La14[0], La14[1]} * xj2;
      X29 -= (f32x2){La14[2], La14[3]} * xj2;
      X30 -= (f32x2){La15[0], La15[1]} * xj2;
      X31 -= (f32x2){La15[2], La15[3]} * xj2;
    }
    __builtin_amdgcn_sched_barrier(0);
    La9 = *(const f32x4*)(Lt_s + 2620);
    La10 = *(const f32x4*)(Lt_s + 2624);
    La11 = *(const f32x4*)(Lt_s + 2628);
    La12 = *(const f32x4*)(Lt_s + 2632);
    La13 = *(const f32x4*)(Lt_s + 2636);
    La14 = *(const f32x4*)(Lt_s + 2640);
    La15 = *(const f32x4*)(Lt_s + 2644);
    __builtin_amdgcn_sched_barrier(0);
    { const float xj = X18[1]; const f32x2 xj2 = (f32x2){xj, xj};
      X19 -= (f32x2){Lb9[2], Lb9[3]} * xj2;
      X20 -= (f32x2){Lb10[0], Lb10[1]} * xj2;
      X21 -= (f32x2){Lb10[2], Lb10[3]} * xj2;
      X22 -= (f32x2){Lb11[0], Lb11[1]} * xj2;
      X23 -= (f32x2){Lb11[2], Lb11[3]} * xj2;
      X24 -= (f32x2){Lb12[0], Lb12[1]} * xj2;
      X25 -= (f32x2){Lb12[2], Lb12[3]} * xj2;
      X26 -= (f32x2){Lb13[0], Lb13[1]} * xj2;
      X27 -= (f32x2){Lb13[2], Lb13[3]} * xj2;
      X28 -= (f32x2){Lb14[0], Lb14[1]} * xj2;
      X29 -= (f32x2){Lb14[2], Lb14[3]} * xj2;
      X30 -= (f32x2){Lb15[0], Lb15[1]} * xj2;
      X31 -= (f32x2){Lb15[2], Lb15[3]} * xj2;
    }
    __builtin_amdgcn_sched_barrier(0);
    Lb10 = *(const f32x4*)(Lt_s + 2692);
    Lb11 = *(const f32x4*)(Lt_s + 2696);
    Lb12 = *(const f32x4*)(Lt_s + 2700);
    Lb13 = *(const f32x4*)(Lt_s + 2704);
    Lb14 = *(const f32x4*)(Lt_s + 2708);
    Lb15 = *(const f32x4*)(Lt_s + 2712);
    __builtin_amdgcn_sched_barrier(0);
    { const float xj = X19[0]; const f32x2 xj2 = (f32x2){xj, xj};
      X19 -= (f32x2){La9[2], La9[3]} * xj2;
      X20 -= (f32x2){La10[0], La10[1]} * xj2;
      X21 -= (f32x2){La10[2], La10[3]} * xj2;
      X22 -= (f32x2){La11[0], La11[1]} * xj2;
      X23 -= (f32x2){La11[2], La11[3]} * xj2;
      X24 -= (f32x2){La12[0], La12[1]} * xj2;
      X25 -= (f32x2){La12[2], La12[3]} * xj2;
      X26 -= (f32x2){La13[0], La13[1]} * xj2;
      X27 -= (f32x2){La13[2], La13[3]} * xj2;
      X28 -= (f32x2){La14[0], La14[1]} * xj2;
      X29 -= (f32x2){La14[2], La14[3]} * xj2;
      X30 -= (f32x2){La15[0], La15[1]} * xj2;
      X31 -= (f32x2){La15[2], La15[3]} * xj2;
    }
    __builtin_amdgcn_sched_barrier(0);
    La10 = *(const f32x4*)(Lt_s + 2760);
    La11 = *(const f32x4*)(Lt_s + 2764);
    La12 = *(const f32x4*)(Lt_s + 2768);
    La13 = *(const f32x4*)(Lt_s + 2772);
    La14 = *(const f32x4*)(Lt_s + 2776);
    La15 = *(const f32x4*)(Lt_s + 2780);
    __builtin_amdgcn_sched_barrier(0);
    { const float xj = X19[1]; const f32x2 xj2 = (f32x2){xj, xj};
      X20 -= (f32x2){Lb10[0], Lb10[1]} * xj2;
      X21 -= (f32x2){Lb10[2], Lb10[3]} * xj2;
      X22 -= (f32x2){Lb11[0], Lb11[1]} * xj2;
      X23 -= (f32x2){Lb11[2], Lb11[3]} * xj2;
      X24 -= (f32x2){Lb12[0], Lb12[1]} * xj2;
      X25 -= (f32x2){Lb12[2], Lb12[3]} * xj2;
      X26 -= (f32x2){Lb13[0], Lb13[1]} * xj2;
      X27 -= (f32x2){Lb13[2], Lb13[3]} * xj2;
      X28 -= (f32x2){Lb14[0], Lb14[1]} * xj2;
      X29 -= (f32x2){Lb14[2], Lb14[3]} * xj2;
      X30 -= (f32x2){Lb15[0], Lb15[1]} * xj2;
      X31 -= (f32x2){Lb15[2], Lb15[3]} * xj2;
    }
    __builtin_amdgcn_sched_barrier(0);
    Lb10 = *(const f32x4*)(Lt_s + 2828);
    Lb11 = *(const f32x4*)(Lt_s + 2832);
    Lb12 = *(const f32x4*)(Lt_s + 2836);
    Lb13 = *(const f32x4*)(Lt_s + 2840);
    Lb14 = *(const f32x4*)(Lt_s + 2844);
    Lb15 = *(const f32x4*)(Lt_s + 2848);
    __builtin_amdgcn_sched_barrier(0);
    { const float xj = X20[0]; const f32x2 xj2 = (f32x2){xj, xj};
      X20 -= (f32x2){La10[0], La10[1]} * xj2;
      X21 -= (f32x2){La10[2], La10[3]} * xj2;
      X22 -= (f32x2){La11[0], La11[1]} * xj2;
      X23 -= (f32x2){La11[2], La11[3]} * xj2;
      X24 -= (f32x2){La12[0], La12[1]} * xj2;
      X25 -= (f32x2){La12[2], La12[3]} * xj2;
      X26 -= (f32x2){La13[0], La13[1]} * xj2;
      X27 -= (f32x2){La13[2], La13[3]} * xj2;
      X28 -= (f32x2){La14[0], La14[1]} * xj2;
      X29 -= (f32x2){La14[2], La14[3]} * xj2;
      X30 -= (f32x2){La15[0], La15[1]} * xj2;
      X31 -= (f32x2){La15[2], La15[3]} * xj2;
    }
    __builtin_amdgcn_sched_barrier(0);
    La10 = *(const f32x4*)(Lt_s + 2896);
    La11 = *(const f32x4*)(Lt_s + 2900);
    La12 = *(const f32x4*)(Lt_s + 2904);
    La13 = *(const f32x4*)(Lt_s + 2908);
    La14 = *(const f32x4*)(Lt_s + 2912);
    La15 = *(const f32x4*)(Lt_s + 2916);
    __builtin_amdgcn_sched_barrier(0);
    { const float xj = X20[1]; const f32x2 xj2 = (f32x2){xj, xj};
      X21 -= (f32x2){Lb10[2], Lb10[3]} * xj2;
      X22 -= (f32x2){Lb11[0], Lb11[1]} * xj2;
      X23 -= (f32x2){Lb11[2], Lb11[3]} * xj2;
      X24 -= (f32x2){Lb12[0], Lb12[1]} * xj2;
      X25 -= (f32x2){Lb12[2], Lb12[3]} * xj2;
      X26 -= (f32x2){Lb13[0], Lb13[1]} * xj2;
      X27 -= (f32x2){Lb13[2], Lb13[3]} * xj2;
      X28 -= (f32x2){Lb14[0], Lb14[1]} * xj2;
      X29 -= (f32x2){Lb14[2], Lb14[3]} * xj2;
      X30 -= (f32x2){Lb15[0], Lb15[1]} * xj2;
      X31 -= (f32x2){Lb15[2], Lb15[3]} * xj2;
    }
    __builtin_amdgcn_sched_barrier(0);
    Lb11 = *(const f32x4*)(Lt_s + 2968);
    Lb12 = *(const f32x4*)(Lt_s + 2972);
    Lb13 = *(const f32x4*)(Lt_s + 2976);
    Lb14 = *(const f32x4*)(Lt_s + 2980);
    Lb15 = *(const f32x4*)(Lt_s + 2984);
    __builtin_amdgcn_sched_barrier(0);
    { const float xj = X21[0]; const f32x2 xj2 = (f32x2){xj, xj};
      X21 -= (f32x2){La10[2], La10[3]} * xj2;
      X22 -= (f32x2){La11[0], La11[1]} * xj2;
      X23 -= (f32x2){La11[2], La11[3]} * xj2;
      X24 -= (f32x2){La12[0], La12[1]} * xj2;
      X25 -= (f32x2){La12[2], La12[3]} * xj2;
      X26 -= (f32x2){La13[0], La13[1]} * xj2;
      X27 -= (f32x2){La13[2], La13[3]} * xj2;
      X28 -= (f32x2){La14[0], La14[1]} * xj2;
      X29 -= (f32x2){La14[2], La14[3]} * xj2;
      X30 -= (f32x2){La15[0], La15[1]} * xj2;
      X31 -= (f32x2){La15[2], La15[3]} * xj2;
    }
    __builtin_amdgcn_sched_barrier(0);
    La11 = *(const f32x4*)(Lt_s + 3036);
    La12 = *(const f32x4*)(Lt_s + 3040);
    La13 = *(const f32x4*)(Lt_s + 3044);
    La14 = *(const f32x4*)(Lt_s + 3048);
    La15 = *(const f32x4*)(Lt_s + 3052);
    __builtin_amdgcn_sched_barrier(0);
    { const float xj = X21[1]; const f32x2 xj2 = (f32x2){xj, xj};
      X22 -= (f32x2){Lb11[0], Lb11[1]} * xj2;
      X23 -= (f32x2){Lb11[2], Lb11[3]} * xj2;
      X24 -= (f32x2){Lb12[0], Lb12[1]} * xj2;
      X25 -= (f32x2){Lb12[2], Lb12[3]} * xj2;
      X26 -= (f32x2){Lb13[0], Lb13[1]} * xj2;
      X27 -= (f32x2){Lb13[2], Lb13[3]} * xj2;
      X28 -= (f32x2){Lb14[0], Lb14[1]} * xj2;
      X29 -= (f32x2){Lb14[2], Lb14[3]} * xj2;
      X30 -= (f32x2){Lb15[0], Lb15[1]} * xj2;
      X31 -= (f32x2){Lb15[2], Lb15[3]} * xj2;
    }
    __builtin_amdgcn_sched_barrier(0);
    Lb11 = *(const f32x4*)(Lt_s + 3104);
    Lb12 = *(const f32x4*)(Lt_s + 3108);
    Lb13 = *(const f32x4*)(Lt_s + 3112);
    Lb14 = *(const f32x4*)(Lt_s + 3116);
    Lb15 = *(const f32x4*)(Lt_s + 3120);
    __builtin_amdgcn_sched_barrier(0);
    { const float xj = X22[0]; const f32x2 xj2 = (f32x2){xj, xj};
      X22 -= (f32x2){La11[0], La11[1]} * xj2;
      X23 -= (f32x2){La11[2], La11[3]} * xj2;
      X24 -= (f32x2){La12[0], La12[1]} * xj2;
      X25 -= (f32x2){La12[2], La12[3]} * xj2;
      X26 -= (f32x2){La13[0], La13[1]} * xj2;
      X27 -= (f32x2){La13[2], La13[3]} * xj2;
      X28 -= (f32x2){La14[0], La14[1]} * xj2;
      X29 -= (f32x2){La14[2], La14[3]} * xj2;
      X30 -= (f32x2){La15[0], La15[1]} * xj2;
      X31 -= (f32x2){La15[2], La15[3]} * xj2;
    }
    __builtin_amdgcn_sched_barrier(0);
    La11 = *(const f32x4*)(Lt_s + 3172);
    La12 = *(const f32x4*)(Lt_s + 3176);
    La13 = *(const f32x4*)(Lt_s + 3180);
    La14 = *(const f32x4*)(Lt_s + 3184);
    La15 = *(const f32x4*)(Lt_s + 3188);
    __builtin_amdgcn_sched_barrier(0);
    { const float xj = X22[1]; const f32x2 xj2 = (f32x2){xj, xj};
      X23 -= (f32x2){Lb11[2], Lb11[3]} * xj2;
      X24 -= (f32x2){Lb12[0], Lb12[1]} * xj2;
      X25 -= (f32x2){Lb12[2], Lb12[3]} * xj2;
      X26 -= (f32x2){Lb13[0], Lb13[1]} * xj2;
      X27 -= (f32x2){Lb13[2], Lb13[3]} * xj2;
      X28 -= (f32x2){Lb14[0], Lb14[1]} * xj2;
      X29 -= (f32x2){Lb14[2], Lb14[3]} * xj2;
      X30 -= (f32x2){Lb15[0], Lb15[1]} * xj2;
      X31 -= (f32x2){Lb15[2], Lb15[3]} * xj2;
    }
    __builtin_amdgcn_sched_barrier(0);
    Lb12 = *(const f32x4*)(Lt_s + 3244);
    Lb13 = *(const f32x4*)(Lt_s + 3248);
    Lb14 = *(const f32x4*)(Lt_s + 3252);
    Lb15 = *(const f32x4*)(Lt_s + 3256);
    __builtin_amdgcn_sched_barrier(0);
    { const float xj = X23[0]; const f32x2 xj2 = (f32x2){xj, xj};
      X23 -= (f32x2){La11[2], La11[3]} * xj2;
      X24 -= (f32x2){La12[0], La12[1]} * xj2;
      X25 -= (f32x2){La12[2], La12[3]} * xj2;
      X26 -= (f32x2){La13[0], La13[1]} * xj2;
      X27 -= (f32x2){La13[2], La13[3]} * xj2;
      X28 -= (f32x2){La14[0], La14[1]} * xj2;
      X29 -= (f32x2){La14[2], La14[3]} * xj2;
      X30 -= (f32x2){La15[0], La15[1]} * xj2;
      X31 -= (f32x2){La15[2], La15[3]} * xj2;
    }
    __builtin_amdgcn_sched_barrier(0);
    La12 = *(const f32x4*)(Lt_s + 3312);
    La13 = *(const f32x4*)(Lt_s + 3316);
    La14 = *(const f32x4*)(Lt_s + 3320);
    La15 = *(const f32x4*)(Lt_s + 3324);
    __builtin_amdgcn_sched_barrier(0);
    { const float xj = X23[1]; const f32x2 xj2 = (f32x2){xj, xj};
      X24 -= (f32x2){Lb12[0], Lb12[1]} * xj2;
      X25 -= (f32x2){Lb12[2], Lb12[3]} * xj2;
      X26 -= (f32x2){Lb13[0], Lb13[1]} * xj2;
      X27 -= (f32x2){Lb13[2], Lb13[3]} * xj2;
      X28 -= (f32x2){Lb14[0], Lb14[1]} * xj2;
      X29 -= (f32x2){Lb14[2], Lb14[3]} * xj2;
      X30 -= (f32x2){Lb15[0], Lb15[1]} * xj2;
      X31 -= (f32x2){Lb15[2], Lb15[3]} * xj2;
    }
    __builtin_amdgcn_sched_barrier(0);
    Lb12 = *(const f32x4*)(Lt_s + 3380);
    Lb13 = *(const f32x4*)(Lt_s + 3384);
    Lb14 = *(const f32x4*)(Lt_s + 3388);
    Lb15 = *(const f32x4*)(Lt_s + 3392);
    __builtin_amdgcn_sched_barrier(0);
    { const float xj = X24[0]; const f32x2 xj2 = (f32x2){xj, xj};
      X24 -= (f32x2){La12[0], La12[1]} * xj2;
      X25 -= (f32x2){La12[2], La12[3]} * xj2;
      X26 -= (f32x2){La13[0], La13[1]} * xj2;
      X27 -= (f32x2){La13[2], La13[3]} * xj2;
      X28 -= (f32x2){La14[0], La14[1]} * xj2;
      X29 -= (f32x2){La14[2], La14[3]} * xj2;
      X30 -= (f32x2){La15[0], La15[1]} * xj2;
      X31 -= (f32x2){La15[2], La15[3]} * xj2;
    }
    __builtin_amdgcn_sched_barrier(0);
    La12 = *(const f32x4*)(Lt_s + 3448);
    La13 = *(const f32x4*)(Lt_s + 3452);
    La14 = *(const f32x4*)(Lt_s + 3456);
    La15 = *(const f32x4*)(Lt_s + 3460);
    __builtin_amdgcn_sched_barrier(0);
    { const float xj = X24[1]; const f32x2 xj2 = (f32x2){xj, xj};
      X25 -= (f32x2){Lb12[2], Lb12[3]} * xj2;
      X26 -= (f32x2){Lb13[0], Lb13[1]} * xj2;
      X27 -= (f32x2){Lb13[2], Lb13[3]} * xj2;
      X28 -= (f32x2){Lb14[0], Lb14[1]} * xj2;
      X29 -= (f32x2){Lb14[2], Lb14[3]} * xj2;
      X30 -= (f32x2){Lb15[0], Lb15[1]} * xj2;
      X31 -= (f32x2){Lb15[2], Lb15[3]} * xj2;
    }
    __builtin_amdgcn_sched_barrier(0);
    Lb13 = *(const f32x4*)(Lt_s + 3520);
    Lb14 = *(const f32x4*)(Lt_s + 3524);
    Lb15 = *(const f32x4*)(Lt_s + 3528);
    __builtin_amdgcn_sched_barrier(0);
    { const float xj = X25[0]; const f32x2 xj2 = (f32x2){xj, xj};
      X25 -= (f32x2){La12[2], La12[3]} * xj2;
      X26 -= (f32x2){La13[0], La13[1]} * xj2;
      X27 -= (f32x2){La13[2], La13[3]} * xj2;
      X28 -= (f32x2){La14[0], La14[1]} * xj2;
      X29 -= (f32x2){La14[2], La14[3]} * xj2;
      X30 -= (f32x2){La15[0], La15[1]} * xj2;
      X31 -= (f32x2){La15[2], La15[3]} * xj2;
    }
    __builtin_amdgcn_sched_barrier(0);
    La13 = *(const f32x4*)(Lt_s + 3588);
    La14 = *(const f32x4*)(Lt_s + 3592);
    La15 = *(const f32x4*)(Lt_s + 3596);
    __builtin_amdgcn_sched_barrier(0);
    { const float xj = X25[1]; const f32x2 xj2 = (f32x2){xj, xj};
      X26 -= (f32x2){Lb13[0], Lb13[1]} * xj2;
      X27 -= (f32x2){Lb13[2], Lb13[3]} * xj2;
      X28 -= (f32x2){Lb14[0], Lb14[1]} * xj2;
      X29 -= (f32x2){Lb14[2], Lb14[3]} * xj2;
      X30 -= (f32x2){Lb15[0], Lb15[1]} * xj2;
      X31 -= (f32x2){Lb15[2], Lb15[3]} * xj2;
    }
    __builtin_amdgcn_sched_barrier(0);
    Lb13 = *(const f32x4*)(Lt_s + 3656);
    Lb14 = *(const f32x4*)(Lt_s + 3660);
    Lb15 = *(const f32x4*)(Lt_s + 3664);
    __builtin_amdgcn_sched_barrier(0);
    { const float xj = X26[0]; const f32x2 xj2 = (f32x2){xj, xj};
      X26 -= (f32x2){La13[0], La13[1]} * xj2;
      X27 -= (f32x2){La13[2], La13[3]} * xj2;
      X28 -= (f32x2){La14[0], La14[1]} * xj2;
      X29 -= (f32x2){La14[2], La14[3]} * xj2;
      X30 -= (f32x2){La15[0], La15[1]} * xj2;
      X31 -= (f32x2){La15[2], La15[3]} * xj2;
    }
    __builtin_amdgcn_sched_barrier(0);
    La13 = *(const f32x4*)(Lt_s + 3724);
    La14 = *(const f32x4*)(Lt_s + 3728);
    La15 = *(const f32x4*)(Lt_s + 3732);
    __builtin_amdgcn_sched_barrier(0);
    { const float xj = X26[1]; const f32x2 xj2 = (f32x2){xj, xj};
      X27 -= (f32x2){Lb13[2], Lb13[3]} * xj2;
      X28 -= (f32x2){Lb14[0], Lb14[1]} * xj2;
      X29 -= (f32x2){Lb14[2], Lb14[3]} * xj2;
      X30 -= (f32x2){Lb15[0], Lb15[1]} * xj2;
      X31 -= (f32x2){Lb15[2], Lb15[3]} * xj2;
    }
    __builtin_amdgcn_sched_barrier(0);
    Lb14 = *(const f32x4*)(Lt_s + 3796);
    Lb15 = *(const f32x4*)(Lt_s + 3800);
    __builtin_amdgcn_sched_barrier(0);
    { const float xj = X27[0]; const f32x2 xj2 = (f32x2){xj, xj};
      X27 -= (f32x2){La13[2], La13[3]} * xj2;
      X28 -= (f32x2){La14[0], La14[1]} * xj2;
      X29 -= (f32x2){La14[2], La14[3]} * xj2;
      X30 -= (f32x2){La15[0], La15[1]} * xj2;
      X31 -= (f32x2){La15[2], La15[3]} * xj2;
    }
    __builtin_amdgcn_sched_barrier(0);
    La14 = *(const f32x4*)(Lt_s + 3864);
    La15 = *(const f32x4*)(Lt_s + 3868);
    __builtin_amdgcn_sched_barrier(0);
    { const float xj = X27[1]; const f32x2 xj2 = (f32x2){xj, xj};
      X28 -= (f32x2){Lb14[0], Lb14[1]} * xj2;
      X29 -= (f32x2){Lb14[2], Lb14[3]} * xj2;
      X30 -= (f32x2){Lb15[0], Lb15[1]} * xj2;
      X31 -= (f32x2){Lb15[2], Lb15[3]} * xj2;
    }
    __builtin_amdgcn_sched_barrier(0);
    Lb14 = *(const f32x4*)(Lt_s + 3932);
    Lb15 = *(const f32x4*)(Lt_s + 3936);
    __builtin_amdgcn_sched_barrier(0);
    { const float xj = X28[0]; const f32x2 xj2 = (f32x2){xj, xj};
      X28 -= (f32x2){La14[0], La14[1]} * xj2;
      X29 -= (f32x2){La14[2], La14[3]} * xj2;
      X30 -= (f32x2){La15[0], La15[1]} * xj2;
      X31 -= (f32x2){La15[2], La15[3]} * xj2;
    }
    __builtin_amdgcn_sched_barrier(0);
    La14 = *(const f32x4*)(Lt_s + 4000);
    La15 = *(const f32x4*)(Lt_s + 4004);
    __builtin_amdgcn_sched_barrier(0);
    { const float xj = X28[1]; const f32x2 xj2 = (f32x2){xj, xj};
      X29 -= (f32x2){Lb14[2], Lb14[3]} * xj2;
      X30 -= (f32x2){Lb15[0], Lb15[1]} * xj2;
      X31 -= (f32x2){Lb15[2], Lb15[3]} * xj2;
    }
    __builtin_amdgcn_sched_barrier(0);
    Lb15 = *(const f32x4*)(Lt_s + 4072);
    __builtin_amdgcn_sched_barrier(0);
    { const float xj = X29[0]; const f32x2 xj2 = (f32x2){xj, xj};
      X29 -= (f32x2){La14[2], La14[3]} * xj2;
      X30 -= (f32x2){La15[0], La15[1]} * xj2;
      X31 -= (f32x2){La15[2], La15[3]} * xj2;
    }
    __builtin_amdgcn_sched_barrier(0);
    La15 = *(const f32x4*)(Lt_s + 4140);
    __builtin_amdgcn_sched_barrier(0);
    { const float xj = X29[1]; const f32x2 xj2 = (f32x2){xj, xj};
      X30 -= (f32x2){Lb15[0], Lb15[1]} * xj2;
      X31 -= (f32x2){Lb15[2], Lb15[3]} * xj2;
    }
    __builtin_amdgcn_sched_barrier(0);
    Lb15 = *(const f32x4*)(Lt_s + 4208);
    __builtin_amdgcn_sched_barrier(0);
    { const float xj = X30[0]; const f32x2 xj2 = (f32x2){xj, xj};
      X30 -= (f32x2){La15[0], La15[1]} * xj2;
      X31 -= (f32x2){La15[2], La15[3]} * xj2;
    }
    __builtin_amdgcn_sched_barrier(0);
    La15 = *(const f32x4*)(Lt_s + 4276);
    __builtin_amdgcn_sched_barrier(0);
    { const float xj = X30[1]; const f32x2 xj2 = (f32x2){xj, xj};
      X31 -= (f32x2){Lb15[2], Lb15[3]} * xj2;
    }
    __builtin_amdgcn_sched_barrier(0);
    __builtin_amdgcn_sched_barrier(0);
    { const float xj = X31[0]; const f32x2 xj2 = (f32x2){xj, xj};
      X31 -= (f32x2){La15[2], La15[3]} * xj2;
    }
    __builtin_amdgcn_sched_barrier(0);
    __syncthreads();
    outp[0] = f2bf(sg * X0[0]);
    outp[136] = f2bf(sg * X0[1]);
    outp[272] = f2bf(sg * X1[0]);
    outp[408] = f2bf(sg * X1[1]);
    outp[544] = f2bf(sg * X2[0]);
    outp[680] = f2bf(sg * X2[1]);
    outp[816] = f2bf(sg * X3[0]);
    outp[952] = f2bf(sg * X3[1]);
    outp[1088] = f2bf(sg * X4[0]);
    outp[1224] = f2bf(sg * X4[1]);
    outp[1360] = f2bf(sg * X5[0]);
    outp[1496] = f2bf(sg * X5[1]);
    outp[1632] = f2bf(sg * X6[0]);
    outp[1768] = f2bf(sg * X6[1]);
    outp[1904] = f2bf(sg * X7[0]);
    outp[2040] = f2bf(sg * X7[1]);
    outp[2176] = f2bf(sg * X8[0]);
    outp[2312] = f2bf(sg * X8[1]);
    outp[2448] = f2bf(sg * X9[0]);
    outp[2584] = f2bf(sg * X9[1]);
    outp[2720] = f2bf(sg * X10[0]);
    outp[2856] = f2bf(sg * X10[1]);
    outp[2992] = f2bf(sg * X11[0]);
    outp[3128] = f2bf(sg * X11[1]);
    outp[3264] = f2bf(sg * X12[0]);
    outp[3400] = f2bf(sg * X12[1]);
    outp[3536] = f2bf(sg * X13[0]);
    outp[3672] = f2bf(sg * X13[1]);
    outp[3808] = f2bf(sg * X14[0]);
    outp[3944] = f2bf(sg * X14[1]);
    outp[4080] = f2bf(sg * X15[0]);
    outp[4216] = f2bf(sg * X15[1]);
    outp[4352] = f2bf(sg * X16[0]);
    outp[4488] = f2bf(sg * X16[1]);
    outp[4624] = f2bf(sg * X17[0]);
    outp[4760] = f2bf(sg * X17[1]);
    outp[4896] = f2bf(sg * X18[0]);
    outp[5032] = f2bf(sg * X18[1]);
    outp[5168] = f2bf(sg * X19[0]);
    outp[5304] = f2bf(sg * X19[1]);
    outp[5440] = f2bf(sg * X20[0]);
    outp[5576] = f2bf(sg * X20[1]);
    outp[5712] = f2bf(sg * X21[0]);
    outp[5848] = f2bf(sg * X21[1]);
    outp[5984] = f2bf(sg * X22[0]);
    outp[6120] = f2bf(sg * X22[1]);
    outp[6256] = f2bf(sg * X23[0]);
    outp[6392] = f2bf(sg * X23[1]);
    outp[6528] = f2bf(sg * X24[0]);
    outp[6664] = f2bf(sg * X24[1]);
    outp[6800] = f2bf(sg * X25[0]);
    outp[6936] = f2bf(sg * X25[1]);
    outp[7072] = f2bf(sg * X26[0]);
    outp[7208] = f2bf(sg * X26[1]);
    outp[7344] = f2bf(sg * X27[0]);
    outp[7480] = f2bf(sg * X27[1]);
    outp[7616] = f2bf(sg * X28[0]);
    outp[7752] = f2bf(sg * X28[1]);
    outp[7888] = f2bf(sg * X29[0]);
    outp[8024] = f2bf(sg * X29[1]);
    outp[8160] = f2bf(sg * X30[0]);
    outp[8296] = f2bf(sg * X30[1]);
    outp[8432] = f2bf(sg * X31[0]);
    outp[8568] = f2bf(sg * X31[1]);
}

DEV void dn_item(const Params& p, int l, int item, unsigned char* smem) {
    const int dir = item & 1, hh = (item >> 1) & 3, b = item >> 3;
    bf16_t* q_s = (bf16_t*)(smem);
    bf16_t* k_s = (bf16_t*)(smem + 17408);
    bf16_t* vnT_s = k_s;
    bf16_t* kT_s = (bf16_t*)(smem + 35840);
    bf16_t* v_s = (bf16_t*)(smem + 54272);
    bf16_t* u_s = v_s;
    float* L_s = (float*)(smem + 71680);
    bf16_t* w_s = (bf16_t*)(smem + 71680);
    bf16_t* qk_s = (bf16_t*)(smem + 89088);
    bf16_t* St_s = (bf16_t*)(smem + 98304);
    float* G_s = (float*)(smem + 133120);
    float* beta_s = G_s + 64;
    float* eG_s = G_s + 128;
    float* bw_s = G_s + 192;
    float* cw_s = G_s + 256;
    const int tid = get_tid(), lane = tid & 63, wv = tid >> 6, l15 = lane & 15, quad = lane >> 4;
    const float Aneg = -expf(p.in[I_DNALOG][(l * 2 + dir) * 4 + hh]);
    const float dtb = p.in[I_DNDT][(l * 2 + dir) * 4 + hh];
    const bf16_t* P = wsb(p, O_P);
    const float* AB = wsf(p, O_AB);
    bf16_t* TO = wsb(p, dir ? O_TA2 : O_TA);
    __syncthreads();
    for (int e = tid; e < 4 * 384; e += 256) { int j = e / 384, c = e % 384, mat = c >> 7, cc = c & 127; cw_s[e] = p.in[I_DNCONV][((size_t)l * 4 + j) * 1536 + mat * 512 + hh * 128 + cc]; }
    for (int e = tid; e < 128 * 136 / 2; e += 256) ((unsigned*)St_s)[e] = 0u;
    f32x4 Sacc[2][8];
#pragma unroll
    for (int a = 0; a < 2; ++a)
#pragma unroll
        for (int c = 0; c < 8; ++c) Sacc[a][c] = (f32x4){0.f, 0.f, 0.f, 0.f};

    const int rg = tid >> 4, cseg = tid & 15, i0 = rg * 4;
    u32x4 raw[3][7];
    float pf_al = 0.f, pf_bb = 0.f;
#define DN_PREFETCH(NN, M0, M1) { \
        const int c_ = chunk_of(dir, (NN)); const int lo_ = c_ < 4 ? 0 : CTXL, hi_ = c_ < 4 ? CTXL : SB, base_ = c_ * 64; \
        const int slo_ = dir ? base_ + 60 - i0 : base_ + i0; \
        _Pragma("unroll") for (int u = 0; u < 7; ++u) { const int ss_ = slo_ - 1 + u; const bool ok_ = ss_ >= lo_ && ss_ < hi_; \
            const bf16_t* rp_ = P + ((size_t)b * SB + (ok_ ? ss_ : base_)) * PW + hh * 128 + cseg * 8; \
            _Pragma("unroll") for (int mat = (M0); mat < (M1); ++mat) { u32x4 t_ = *(const u32x4*)(rp_ + mat * 512); raw[mat][u] = ok_ ? t_ : (u32x4){0u, 0u, 0u, 0u}; } } \
        if ((M0) == 0) { const int sa_ = dir ? base_ + 63 - lane : base_ + lane; \
        pf_al = AB[((size_t)b * SB + sa_) * 16 + dir * 4 + hh]; pf_bb = AB[((size_t)b * SB + sa_) * 16 + 8 + dir * 4 + hh]; } }
    DN_PREFETCH(0, 0, 3);
    const int wv0_ = wv, l150_ = l15, quad0_ = quad, lane0_ = lane;

#pragma unroll 1
    for (int n = 0; n < 68; ++n) {
        int tz0 = 0; asm volatile("" : "+v"(tz0));
        const int wv = wv0_ + tz0, l15 = l150_ + tz0, quad = quad0_ + tz0, lane = lane0_ + tz0;
        const int c = chunk_of(dir, n);
        const int base = c * 64;
        __syncthreads();
        if (wv == 0) {
            float g = Aneg * softplus_fast(pf_al + dtb);
#pragma unroll
            for (int o = 1; o < 64; o <<= 1) { float t = __shfl_up(g, o); if (lane >= o) g += t; }
            const float eg_ = expf(g), bt_ = sigm(pf_bb); G_s[lane] = g; beta_s[lane] = bt_; eG_s[lane] = eg_; bw_s[lane] = bt_ * eg_;
        }
        __syncthreads();
        const float Glast = G_s[63];
        {
            int tz = 0; asm volatile("" : "+v"(tz));
            const int i0l = i0 + tz, csl = cseg + tz;
            float ksc[4];
#pragma unroll
            for (int m = 0; m < 4; ++m) ksc[m] = expf(Glast - G_s[i0l + m]);
#pragma unroll
            for (int mat = 0; mat < 3; ++mat) {
                float w[4][8];
#pragma unroll
                for (int j = 0; j < 4; ++j) { const f32x4 w0 = *(const f32x4*)(cw_s + j * 384 + mat * 128 + csl * 8), w1 = *(const f32x4*)(cw_s + j * 384 + mat * 128 + csl * 8 + 4);
#pragma unroll
                    for (int e = 0; e < 4; ++e) { w[j][e] = w0[e]; w[j][4 + e] = w1[e]; } }
                float v[4][8];
#pragma unroll
                for (int t = 0; t < 4; ++t)
#pragma unroll
                    for (int e = 0; e < 8; ++e) v[t][e] = 0.f;
#pragma unroll
                for (int u = 0; u < 7; ++u) {
                    float x[8];
#pragma unroll
                    for (int e = 0; e < 4; ++e) { x[2 * e] = lo16(raw[mat][u][e]); x[2 * e + 1] = hi16(raw[mat][u][e]); }
#pragma unroll
                    for (int t = 0; t < 4; ++t) { const int j = u - t; if (j >= 0 && j < 4) {
#pragma unroll
                        for (int e = 0; e < 8; ++e) v[t][e] += w[j][e] * x[e]; } }
                }
                float sc[4];
#pragma unroll
                for (int t = 0; t < 4; ++t) {
                    float ss2 = 0.f;
#pragma unroll
                    for (int e = 0; e < 8; ++e) { v[t][e] = silu(v[t][e]); ss2 += v[t][e] * v[t][e]; }
                    if (mat < 2) { ss2 += __shfl_xor(ss2, 1); ss2 += __shfl_xor(ss2, 2); ss2 += __shfl_xor(ss2, 4); ss2 += __shfl_xor(ss2, 8); }
                    sc[t] = mat == 0 ? rsqrtf(ss2 + 1e-6f) * 0.08838834764831845f : (mat == 1 ? rsqrtf(ss2 + 1e-6f) : 1.f);
                }
                bf16_t* dst = mat == 0 ? q_s : (mat == 1 ? k_s : v_s);
#pragma unroll
                for (int t = 0; t < 4; ++t) {
                    const int it_ = dir ? i0l + 3 - t : i0l + t;
                    u32x4 o;
#pragma unroll
                    for (int e = 0; e < 4; ++e) o[e] = pack2(v[t][2 * e] * sc[t], v[t][2 * e + 1] * sc[t]);
                    *(u32x4*)(dst + it_ * 136 + csl * 8) = o;
                }
                if (mat == 1) {
#pragma unroll
                    for (int e = 0; e < 8; ++e) {
                        const float k0 = v[dir ? 3 : 0][e] * sc[dir ? 3 : 0] * ksc[0], k1 = v[dir ? 2 : 1][e] * sc[dir ? 2 : 1] * ksc[1];
                        const float k2 = v[dir ? 1 : 2][e] * sc[dir ? 1 : 2] * ksc[2], k3 = v[dir ? 0 : 3][e] * sc[dir ? 0 : 3] * ksc[3];
                        u32x2 o; o.x = pack2(k0, k1); o.y = pack2(k2, k3);
                        *(u32x2*)(kT_s + (csl * 8 + e) * 72 + i0l) = o;
                    }
                }
            }
        }
        __syncthreads();
        {
            bf16x8 ak[4], aq[4];
#pragma unroll
            for (int ks = 0; ks < 4; ++ks) { ak[ks] = *(const bf16x8*)(k_s + (wv * 16 + l15) * 136 + ks * 32 + quad * 8); aq[ks] = *(const bf16x8*)(q_s + (wv * 16 + l15) * 136 + ks * 32 + quad * 8); }
#pragma unroll
            for (int nt = 0; nt < 4; ++nt) {
                f32x4 kk = {0.f, 0.f, 0.f, 0.f}, qq = {0.f, 0.f, 0.f, 0.f};
#pragma unroll
                for (int ks = 0; ks < 4; ++ks) { bf16x8 bk = *(const bf16x8*)(k_s + (nt * 16 + l15) * 136 + ks * 32 + quad * 8); kk = mfma16(ak[ks], bk, kk); qq = mfma16(aq[ks], bk, qq); }
                const int jj = nt * 16 + l15; const float Gj = G_s[jj];
                f32x4 lv;
#pragma unroll
                for (int j = 0; j < 4; ++j) {
                    const int i = wv * 16 + quad * 4 + j;
                    const float dec = jj <= i ? expf(G_s[i] - Gj) : 0.f;
                    lv[j] = jj < i ? beta_s[i] * kk[j] * dec : 0.f;
                    qk_s[i * 72 + jj] = f2bf(qq[j] * dec);
                }
                *(f32x4*)(L_s + jj * 68 + wv * 16 + quad * 4) = lv;
            }
        }
        __syncthreads();
        dn_solve(L_s, tid < 128 ? (k_s + tid) : (v_s + (tid - 128)), tid < 128 ? bw_s : beta_s, tid < 128 ? -1.f : 1.f, tid < 128 ? (w_s + tid) : (u_s + (tid - 128)));
        __syncthreads();
        {
            f32x4 vn[8], o1[8];
#pragma unroll
            for (int nt = 0; nt < 8; ++nt) {
#pragma unroll
                for (int j = 0; j < 4; ++j) vn[nt][j] = bf2f(u_s[(wv * 16 + quad * 4 + j) * 136 + nt * 16 + l15]);
                o1[nt] = (f32x4){0.f, 0.f, 0.f, 0.f};
            }
            bf16x8 aw[4], aq[4];
#pragma unroll
            for (int ks = 0; ks < 4; ++ks) { aw[ks] = *(const bf16x8*)(w_s + (wv * 16 + l15) * 136 + ks * 32 + quad * 8); aq[ks] = *(const bf16x8*)(q_s + (wv * 16 + l15) * 136 + ks * 32 + quad * 8); }
#pragma unroll
            for (int nt = 0; nt < 8; ++nt)
#pragma unroll
                for (int ks = 0; ks < 4; ++ks) { bf16x8 bs = *(const bf16x8*)(St_s + (nt * 16 + l15) * 136 + ks * 32 + quad * 8); vn[nt] = mfma16(aw[ks], bs, vn[nt]); o1[nt] = mfma16(aq[ks], bs, o1[nt]); }
#pragma unroll
            for (int nt = 0; nt < 8; ++nt) { u32x2 o; o.x = pack2(vn[nt][0], vn[nt][1]); o.y = pack2(vn[nt][2], vn[nt][3]); *(u32x2*)(vnT_s + (nt * 16 + l15) * 72 + wv * 16 + quad * 4) = o; }
            __syncthreads();
            if (n + 1 < 68) DN_PREFETCH(n + 1, 0, 2);
            float eg[4];
#pragma unroll
            for (int j = 0; j < 4; ++j) eg[j] = eG_s[wv * 16 + quad * 4 + j];
            bf16x8 aqk[2], akt[2][2];
#pragma unroll
            for (int ks = 0; ks < 2; ++ks) {
                aqk[ks] = *(const bf16x8*)(qk_s + (wv * 16 + l15) * 72 + ks * 32 + quad * 8);
                akt[0][ks] = *(const bf16x8*)(kT_s + (wv * 32 + l15) * 72 + ks * 32 + quad * 8);
                akt[1][ks] = *(const bf16x8*)(kT_s + (wv * 32 + 16 + l15) * 72 + ks * 32 + quad * 8);
            }
            const float gend = eG_s[63];
            const size_t orow0 = (size_t)b * SB;
#pragma unroll
            for (int nt = 0; nt < 8; ++nt) {
                f32x4 o;
#pragma unroll
                for (int j = 0; j < 4; ++j) { o[j] = o1[nt][j] * eg[j]; Sacc[0][nt][j] *= gend; Sacc[1][nt][j] *= gend; }
#pragma unroll
                for (int ks = 0; ks < 2; ++ks) {
                    bf16x8 bv = *(const bf16x8*)(vnT_s + (nt * 16 + l15) * 72 + ks * 32 + quad * 8);
                    o = mfma16(aqk[ks], bv, o);
                    Sacc[0][nt] = mfma16(akt[0][ks], bv, Sacc[0][nt]);
                    Sacc[1][nt] = mfma16(akt[1][ks], bv, Sacc[1][nt]);
                }
#pragma unroll
                for (int j = 0; j < 4; ++j) {
                    const int i = wv * 16 + quad * 4 + j;
                    const int s = dir ? base + 63 - i : base + i;
                    TO[(orow0 + s) * 512 + hh * 128 + nt * 16 + l15] = f2bf(o[j]);
                }
#pragma unroll
                for (int mt = 0; mt < 2; ++mt) { u32x2 sv; sv.x = pack2(Sacc[mt][nt][0], Sacc[mt][nt][1]); sv.y = pack2(Sacc[mt][nt][2], Sacc[mt][nt][3]);
                    *(u32x2*)(St_s + (nt * 16 + l15) * 136 + wv * 32 + mt * 16 + quad * 4) = sv; }
            }
        }
        if (n + 1 < 68) DN_PREFETCH(n + 1, 2, 3);
    }
}

#undef DN_PREFETCH
DEV void lru_item(const Params& p, int l, int item, unsigned char* smem) {
    const int g = item & 7, b = item >> 3;
    bf16_t* Wt_s = (bf16_t*)smem;
    bf16_t* xbh_s = Wt_s + 2 * 128 * 72;
    float* xbf_s = (float*)(smem + 36864 + 18432);
    float* a_s = xbf_s + 2 * 64 * 65;
    float* cw_s = a_s + 2 * 64 * 65;
    const int tid = get_tid(), lane = tid & 63, wv = tid >> 6, l15 = lane & 15, quad = lane >> 4;
    bf16_t* P = wsb(p, O_P);
    bf16_t* HF = wsb(p, O_U);
    __syncthreads();
    for (int e = tid; e < 320; e += 256) cw_s[e] = e < 256 ? p.in[I_LCW][((size_t)l * 4 + (e >> 6)) * 512 + g * 64 + (e & 63)] : p.in[I_LCB][l * 512 + g * 64 + (e - 256)];
    for (int e = tid; e < 2 * 4096; e += 256) {
        const int d = e >> 12, ch = (e >> 6) & 63, j = e & 63;
        const size_t wi_ = (((size_t)l * 2 + d) * 8 + g) * 4096 + ch * 64 + j;
        Wt_s[(d * 128 + j) * 72 + ch] = f2bf(p.in[I_LWA][wi_]);
        Wt_s[(d * 128 + 64 + j) * 72 + ch] = f2bf(p.in[I_LWI][wi_]);
    }
    float ba_[2][4], bi_[2][4], sp_[2][4];
#pragma unroll
    for (int d = 0; d < 2; ++d)
#pragma unroll
        for (int nt = 0; nt < 4; ++nt) {
            const int ch = (l * 2 + d) * 512 + g * 64 + nt * 16 + l15;
            ba_[d][nt] = p.in[I_LBA][ch]; bi_[d][nt] = p.in[I_LBI][ch]; sp_[d][nt] = softplus(-p.in[I_LLAM][ch]);
        }
    float hc = 0.f;
    const int i = tid >> 2, seg = tid & 3, j0 = seg * 16;
#pragma unroll 1
    for (int n = 0; n < 68; ++n) {
        const int cf = n, cb = chunk_of(1, n);
        __syncthreads();
#pragma unroll
        for (int d = 0; d < 2; ++d) {
            const int c = d ? cb : cf;
            const int seg_lo = c < 4 ? 0 : CTXL, seg_hi = c < 4 ? CTXL : SB;
            const int s = d ? c * 64 + 63 - i : c * 64 + i;
            float v[16];
#pragma unroll
            for (int e = 0; e < 16; ++e) v[e] = cw_s[256 + j0 + e];
#pragma unroll
            for (int j = 0; j < 4; ++j) {
                const int ss = s + j - 1;
                if (ss >= seg_lo && ss < seg_hi) {
                    const u32x4* src = (const u32x4*)(P + ((size_t)b * SB + ss) * PW + C_LX + g * 64 + j0);
                    const float* cw = cw_s + j * 64 + j0;
#pragma unroll
                    for (int q = 0; q < 2; ++q) { u32x4 x = src[q];
#pragma unroll
                        for (int e = 0; e < 4; ++e) { v[q * 8 + 2 * e] += cw[q * 8 + 2 * e] * lo16(x[e]); v[q * 8 + 2 * e + 1] += cw[q * 8 + 2 * e + 1] * hi16(x[e]); } }
                }
            }
            u32x4 h0, h1;
#pragma unroll
            for (int e = 0; e < 4; ++e) { h0[e] = pack2(v[2 * e], v[2 * e + 1]); h1[e] = pack2(v[8 + 2 * e], v[8 + 2 * e + 1]); }
            *(u32x4*)(xbh_s + (d * 64 + i) * 72 + j0) = h0; *(u32x4*)(xbh_s + (d * 64 + i) * 72 + j0 + 8) = h1;
#pragma unroll
            for (int e = 0; e < 16; ++e) xbf_s[(d * 64 + i) * 65 + j0 + e] = v[e];
        }
        __syncthreads();
#pragma unroll
        for (int d = 0; d < 2; ++d) {
            f32x4 acc[8];
#pragma unroll
            for (int nt = 0; nt < 8; ++nt) acc[nt] = (f32x4){0.f, 0.f, 0.f, 0.f};
            bf16x8 af[2];
#pragma unroll
            for (int ks = 0; ks < 2; ++ks) af[ks] = *(const bf16x8*)(xbh_s + (d * 64 + wv * 16 + l15) * 72 + ks * 32 + quad * 8);
#pragma unroll
            for (int nt = 0; nt < 8; ++nt)
#pragma unroll
                for (int ks = 0; ks < 2; ++ks) { bf16x8 bw = *(const bf16x8*)(Wt_s + (d * 128 + nt * 16 + l15) * 72 + ks * 32 + quad * 8); acc[nt] = mfma16(af[ks], bw, acc[nt]); }
#pragma unroll
            for (int nt = 0; nt < 4; ++nt)
#pragma unroll
                for (int jj = 0; jj < 4; ++jj) {
                    const int idx = (d * 64 + wv * 16 + quad * 4 + jj) * 65 + nt * 16 + l15;
                    const float r = sigm(acc[nt][jj] + ba_[d][nt]), ig = sigm(acc[nt + 4][jj] + bi_[d][nt]);
                    const float la = -8.f * r * sp_[d][nt];
                    a_s[idx] = expf(la);
                    xbf_s[idx] = sqrtf(fmaxf(1.f - expf(2.f * la), 0.f)) * (ig * xbf_s[idx]);
                }
        }
        __syncthreads();
        if (wv < 2) {
            const int o = wv * 64 * 65 + lane;
#pragma unroll 16
            for (int r = 0; r < 64; ++r) { hc = a_s[o + r * 65] * hc + xbf_s[o + r * 65]; xbf_s[o + r * 65] = hc; }
        }
        __syncthreads();
#pragma unroll
        for (int d = 0; d < 2; ++d) {
            const int c = d ? cb : cf;
            const int s = d ? c * 64 + 63 - i : c * 64 + i;
            const bool second = d ? (cb < n) : ((cf < 4 ? 3 - cf : 71 - cf) < n);
            const size_t row = (size_t)b * SB + s;
            const float* hp = xbf_s + (d * 64 + i) * 65 + j0;
            bf16_t* hf = HF + row * 512 + g * 64 + j0;
            if (!second) {
                u32x4 o0, o1;
#pragma unroll
                for (int e = 0; e < 4; ++e) { o0[e] = pack2(hp[2 * e], hp[2 * e + 1]); o1[e] = pack2(hp[8 + 2 * e], hp[8 + 2 * e + 1]); }
                *(u32x4*)hf = o0; *(u32x4*)(hf + 8) = o1;
            } else {
                bf16_t* gp = P + row * PW + C_LG + g * 64 + j0;
                u32x4 f0 = *(const u32x4*)hf, f1 = *(const u32x4*)(hf + 8), g0 = *(const u32x4*)gp, g1 = *(const u32x4*)(gp + 8), o0, o1;
#pragma unroll
                for (int e = 0; e < 4; ++e) {
                    o0[e] = pack2((lo16(f0[e]) + hp[2 * e]) * gelu_tanh(lo16(g0[e])), (hi16(f0[e]) + hp[2 * e + 1]) * gelu_tanh(hi16(g0[e])));
                    o1[e] = pack2((lo16(f1[e]) + hp[8 + 2 * e]) * gelu_tanh(lo16(g1[e])), (hi16(f1[e]) + hp[8 + 2 * e + 1]) * gelu_tanh(hi16(g1[e])));
                }
                *(u32x4*)gp = o0; *(u32x4*)(gp + 8) = o1;
            }
        }
    }
}

DEV void att_item(const Params& p, int l, int b, int h, int qt, float lam_init, unsigned char* smem) {
    bf16_t* K_s = (bf16_t*)smem;
    bf16_t* V_s = (bf16_t*)(smem + 2 * 17408);
    const int tid = get_tid(), lane = tid & 63, wv = tid >> 6, l15 = lane & 15, quad = lane >> 4;
    bf16_t* P = wsb(p, O_P);
    const bf16_t* VT = wsb(p, O_VT) + (size_t)(b * 4 + h) * 128 * SB;
    const int nt_keys = (qt < 2 ? CTXL : SB) / 64;
    float lam;
    {
        const float* lv = p.in[I_DALAM] + l * 256;
        float s1 = lv[lane] * lv[64 + lane], s2 = lv[128 + lane] * lv[192 + lane];
#pragma unroll
        for (int o = 32; o >= 1; o >>= 1) { s1 += __shfl_xor(s1, o); s2 += __shfl_xor(s2, o); }
        lam = expf(s1) - expf(s2) + lam_init;
    }
    bf16x8* Qst = (bf16x8*)(smem + 71680) + (wv * 8) * 64 + lane;
#pragma unroll
    for (int qg = 0; qg < 2; ++qg) {
        const bf16_t* qp = P + ((size_t)b * SB + qt * 128 + wv * 32 + qg * 16 + l15) * PW + C_DAQ + h * 128;
#pragma unroll
        for (int wh = 0; wh < 2; ++wh)
#pragma unroll
            for (int ks = 0; ks < 2; ++ks) Qst[(wh * 4 + qg * 2 + ks) * 64] = *(const bf16x8*)(qp + wh * 64 + ks * 32 + quad * 8);
    }
    f32x4 O[2][8][2];
    float mrun[2][2], lrun[2][2];
#pragma unroll
    for (int wh = 0; wh < 2; ++wh)
#pragma unroll
        for (int qg = 0; qg < 2; ++qg) { mrun[wh][qg] = -1e30f; lrun[wh][qg] = 0.f;
#pragma unroll
            for (int dg = 0; dg < 8; ++dg) O[wh][dg][qg] = (f32x4){0.f, 0.f, 0.f, 0.f}; }
    const int kr = tid >> 2, kseg = (tid & 3) * 32;
    const int kpos = ((kr >> 5) * 2 + ((kr & 7) >> 2)) * 16 + ((kr & 31) >> 3) * 4 + (kr & 3);
    const bf16_t* kg_ = P + ((size_t)b * SB + kr) * PW + C_DAK + h * 128 + kseg;
    const int vr = tid >> 1, vh = (tid & 1) * 32;
    const bf16_t* vg_ = VT + (size_t)vr * SB + vh;
    u32x4 kreg[4], vreg[4];
#pragma unroll
    for (int i = 0; i < 4; ++i) { kreg[i] = *(const u32x4*)(kg_ + i * 8); vreg[i] = *(const u32x4*)(vg_ + i * 8); }
    __syncthreads();
#pragma unroll
    for (int i = 0; i < 4; ++i) { *(u32x4*)(K_s + kpos * 136 + kseg + i * 8) = kreg[i]; *(u32x4*)(V_s + vr * 72 + vh + i * 8) = vreg[i]; }
    __syncthreads();
    const float L2E = 1.4426950408889634f;
#pragma unroll 1
    for (int t = 0; t < nt_keys; ++t) {
        const bf16_t* Kb = K_s + (t & 1) * (64 * 136);
        const bf16_t* Vb = V_s + (t & 1) * (128 * 72);
        if (t + 1 < nt_keys) {
#pragma unroll
            for (int i = 0; i < 4; ++i) { kreg[i] = *(const u32x4*)(kg_ + (size_t)(t + 1) * 64 * PW + i * 8); vreg[i] = *(const u32x4*)(vg_ + (t + 1) * 64 + i * 8); }
        }
#pragma unroll
        for (int wh = 0; wh < 2; ++wh) {
            f32x4 S[4][2];
#pragma unroll
            for (int kg = 0; kg < 4; ++kg) { S[kg][0] = (f32x4){0.f, 0.f, 0.f, 0.f}; S[kg][1] = (f32x4){0.f, 0.f, 0.f, 0.f}; }
#pragma unroll
            for (int ks = 0; ks < 2; ++ks)
#pragma unroll
                for (int kg = 0; kg < 4; ++kg) {
                    bf16x8 kf = *(const bf16x8*)(Kb + (kg * 16 + l15) * 136 + wh * 64 + ks * 32 + quad * 8);
                    S[kg][0] = mfma16(kf, Qst[(wh * 4 + 0 + ks) * 64], S[kg][0]);
                    S[kg][1] = mfma16(kf, Qst[(wh * 4 + 2 + ks) * 64], S[kg][1]);
                }
            bf16x8 Pf[2][2];
#pragma unroll
            for (int qg = 0; qg < 2; ++qg) {
                float mx = -1e30f;
#pragma unroll
                for (int kg = 0; kg < 4; ++kg)
#pragma unroll
                    for (int j = 0; j < 4; ++j) mx = fmaxf(mx, S[kg][qg][j]);
                mx = fmaxf(mx, __shfl_xor(mx, 16)); mx = fmaxf(mx, __shfl_xor(mx, 32));
                mx *= L2E;
                if (__builtin_amdgcn_ballot_w64(mx > mrun[wh][qg] + 8.f) != 0ull) {
                    const float mnew = fmaxf(mrun[wh][qg], mx);
                    const float alpha = __builtin_amdgcn_exp2f(mrun[wh][qg] - mnew);
                    mrun[wh][qg] = mnew;
                    lrun[wh][qg] *= alpha;
#pragma unroll
                    for (int dg = 0; dg < 8; ++dg)
#pragma unroll
                        for (int j = 0; j < 4; ++j) O[wh][dg][qg][j] *= alpha;
                }
                const float mref = mrun[wh][qg];
                float ps = 0.f;
#pragma unroll
                for (int kg = 0; kg < 4; ++kg)
#pragma unroll
                    for (int j = 0; j < 4; ++j) { float pv = __builtin_amdgcn_exp2f(S[kg][qg][j] * L2E - mref); ps += pv; S[kg][qg][j] = pv; }
                lrun[wh][qg] += ps;
#pragma unroll
                for (int s_ = 0; s_ < 2; ++s_) {
                    u32x4 pk; pk[0] = pack2(S[2 * s_][qg][0], S[2 * s_][qg][1]); pk[1] = pack2(S[2 * s_][qg][2], S[2 * s_][qg][3]);
                    pk[2] = pack2(S[2 * s_ + 1][qg][0], S[2 * s_ + 1][qg][1]); pk[3] = pack2(S[2 * s_ + 1][qg][2], S[2 * s_ + 1][qg][3]);
                    Pf[qg][s_] = __builtin_bit_cast(bf16x8, pk);
                }
            }
#pragma unroll
            for (int dg = 0; dg < 8; ++dg)
#pragma unroll
                for (int s_ = 0; s_ < 2; ++s_) {
                    bf16x8 vf = *(const bf16x8*)(Vb + (dg * 16 + l15) * 72 + s_ * 32 + quad * 8);
                    O[wh][dg][0] = mfma16(vf, Pf[0][s_], O[wh][dg][0]);
                    O[wh][dg][1] = mfma16(vf, Pf[1][s_], O[wh][dg][1]);
                }
        }
        if (t + 1 < nt_keys) {
            bf16_t* Kn = K_s + ((t + 1) & 1) * (64 * 136); bf16_t* Vn = V_s + ((t + 1) & 1) * (128 * 72);
#pragma unroll
            for (int i = 0; i < 4; ++i) { *(u32x4*)(Kn + kpos * 136 + kseg + i * 8) = kreg[i]; *(u32x4*)(Vn + vr * 72 + vh + i * 8) = vreg[i]; }
        }
        __syncthreads();
    }
    const float* dnw = p.in[I_DANORM] + l * 128;
#pragma unroll
    for (int qg = 0; qg < 2; ++qg) {
        float l1 = lrun[0][qg], l2 = lrun[1][qg];
        l1 += __shfl_xor(l1, 16); l1 += __shfl_xor(l1, 32); l2 += __shfl_xor(l2, 16); l2 += __shfl_xor(l2, 32);
        const float i1 = 1.f / l1, i2 = lam / l2;
        float ss = 0.f;
#pragma unroll
        for (int dg = 0; dg < 8; ++dg)
#pragma unroll
            for (int j = 0; j < 4; ++j) { float o = O[0][dg][qg][j] * i1 - O[1][dg][qg][j] * i2; O[0][dg][qg][j] = o; ss += o * o; }
        ss += __shfl_xor(ss, 16); ss += __shfl_xor(ss, 32);
        const float rstd = rsqrtf(ss * (1.f / 128.f) + 1e-5f) * (1.f - lam_init);
        bf16_t* op = P + ((size_t)b * SB + qt * 128 + wv * 32 + qg * 16 + l15) * PW + C_DAQ + h * 128;
#pragma unroll
        for (int dg = 0; dg < 8; ++dg) {
            const int dv0 = dg * 16 + quad * 4;
            u32x2 o; o.x = pack2(O[0][dg][qg][0] * rstd * dnw[dv0], O[0][dg][qg][1] * rstd * dnw[dv0 + 1]);
            o.y = pack2(O[0][dg][qg][2] * rstd * dnw[dv0 + 2], O[0][dg][qg][3] * rstd * dnw[dv0 + 3]);
            *(u32x2*)(op + dv0) = o;
        }
    }
}

DEV void phase_mix(const Params& p, int l, unsigned char* smem) {
    const bool need_ctx = l == 0;
    const float lam_init = l == 0 ? 0.2f : 0.35550906759096926f;
    unsigned* ctr = (unsigned*)(p.ws + O_CTL) + l;
    unsigned* actr = (unsigned*)(p.ws + O_CTL) + 16 + l * 8;
    __shared__ int s_item;
    const int nqt = need_ctx ? 34 : 32;
    auto next = [&](unsigned* c) -> int {
        __syncthreads();
        if (threadIdx.x == 0) s_item = (int)atomicAdd(c, 1u);
        __syncthreads();
        return __builtin_amdgcn_readfirstlane(s_item);
    };
    int it = next(ctr);
#pragma unroll 1
    while (it < 64) { dn_item(p, l, it, smem); it = next(ctr); }
#pragma unroll 1
    while (it < 128) { lru_item(p, l, it - 64, smem); it = next(ctr); }
    const int myx = blockIdx.x & 7;
#pragma unroll 1
    for (int k = 0; k < 8; ++k) {
        const int x = (myx + k) & 7;
        it = next(actr + x);
#pragma unroll 1
        while (it < 4 * nqt) {
            const int bh = x + 8 * (it / nqt), idx = it % nqt;
            const int qt = idx < 32 ? idx + 2 : idx - 32;
            att_item(p, l, bh >> 2, bh & 3, qt, lam_init, smem);
            it = next(actr + x);
        }
    }
}

#define XB_TMO      128
#define XB_XCNT(j)  (256  + 64 * (j))
#define XB_XSUB(j)  (1280 + 64 * (j))
#define XB_XGEN(j)  (2304 + 64 * (j))
#define XB_TOP      3328
#define XB_TOPGEN   3392
#define XCD_BAR_WORDS 3456
#define XB_SPIN_CAP (1u << 18)
#define LAS __attribute__((address_space(3)))
DEV unsigned xb_ld(unsigned* p)              { return __hip_atomic_load(p, __ATOMIC_RELAXED, __HIP_MEMORY_SCOPE_AGENT); }
DEV unsigned xb_add(unsigned* p, unsigned v) { return __hip_atomic_fetch_add(p, v, __ATOMIC_RELAXED, __HIP_MEMORY_SCOPE_AGENT); }
DEV unsigned xb_xcc_id() { return (unsigned)__builtin_amdgcn_s_getreg((3 << 11) | 20) & 0xFu; }
#define XB_SPIN(cond, bar) do { unsigned _sp = 0; while (cond) { __builtin_amdgcn_s_sleep(1); \
    if ((++_sp & 255u) == 0u) { if (xb_ld(&(bar)[XB_TMO])) break; if (_sp > XB_SPIN_CAP) { atomicAdd(&(bar)[XB_TMO], 1u); break; } } } } while (0)
struct XcdBarrier { unsigned* bar; unsigned x; volatile LAS unsigned* st; };
DEV XcdBarrier xcd_barrier_post(unsigned* bar, volatile LAS unsigned* st) {
    XcdBarrier b; b.bar = bar; b.x = xb_xcc_id(); b.st = st;
    if (threadIdx.x == 0) (void)xb_add(&bar[XB_XCNT(b.x)], 1u);
    return b;
}
DEV void xcd_barrier_complete(unsigned* bar, unsigned x, unsigned& nloc, unsigned& nx) {
    const unsigned G = gridDim.x * gridDim.y * gridDim.z;
    unsigned sum, cnt, mine, sp = 0u;
    for (;;) {
        sum = 0u; cnt = 0u; mine = 0u;
#pragma unroll
        for (unsigned j = 0; j < 16; ++j) { const unsigned c = xb_ld(&bar[XB_XCNT(j)]); sum += c; cnt += (c > 0u) ? 1u : 0u; mine = (j == x) ? c : mine; }
        if (sum == G) break;
        __builtin_amdgcn_s_sleep(1);
        if ((++sp & 255u) == 0u) { if (xb_ld(&bar[XB_TMO])) break; if (sp > XB_SPIN_CAP) { atomicAdd(&bar[XB_TMO], 1u); break; } }
    }
    nloc = mine > 0u ? mine : 1u; nx = cnt > 0u ? cnt : 1u;
}
DEV void xcd_barrier(const XcdBarrier& b) {
    asm volatile("s_waitcnt vmcnt(0)" ::: "memory");
    __syncthreads();
    if (threadIdx.x == 0) {
        unsigned* bar = b.bar;
        __builtin_amdgcn_s_waitcnt(0);
        unsigned nloc = b.st[0], nx = b.st[1];
        if (nloc == 0u) { xcd_barrier_complete(bar, b.x, nloc, nx); b.st[0] = nloc; b.st[1] = nx; }
        const unsigned old = xb_add(&bar[XB_XSUB(b.x)], 1u);
        const unsigned gen = old / nloc;
        if (old + 1u == (gen + 1u) * nloc) {
            __builtin_amdgcn_fence(__ATOMIC_RELEASE, "agent");
            asm volatile("s_waitcnt vmcnt(0)" ::: "memory");
            const unsigned og = xb_add(&bar[XB_TOP], 1u);
            const unsigned tg = og / nx;
            if (og + 1u == (tg + 1u) * nx) xb_add(&bar[XB_TOPGEN], 1u);
            else XB_SPIN(xb_ld(&bar[XB_TOPGEN]) == tg, bar);
            __builtin_amdgcn_fence(__ATOMIC_ACQUIRE, "agent");
            xb_add(&bar[XB_XGEN(b.x)], 1u);
            asm volatile("s_waitcnt vmcnt(0)" ::: "memory");
        } else {
            XB_SPIN(xb_ld(&bar[XB_XGEN(b.x)]) == gen, bar);
            __builtin_amdgcn_fence(__ATOMIC_ACQUIRE, "agent");
            asm volatile("s_waitcnt vmcnt(0)" ::: "memory");
        }
    }
    __syncthreads();
}

constexpr int NPHASE = 1 + 2 * 9 + 1;
DEV void run_phase(const Params& p, int ph, unsigned char* smem) {
    if (ph == 0) { phase_mod(p, smem); phase_rope(p); __syncthreads(); phase_wconv(p, 0, smem); return; }
    if (ph == NPHASE - 1) { phase_final(p); return; }
    const int l = (ph - 1) / 9, q = (ph - 1) % 9;
    const bool first = l == 0, lat = l == 1;
    const bf16_t* W = wsb(p, O_WT);
    switch (q) {
        case 0: if (l == 1) phase_wconv(p, 1, smem); phase_norm(p, l, 0, first, false); break;
        case 1: phase_g1(p, smem); break;
        case 2: phase_mix(p, l, smem); break;
        case 3: phase_fin_norm(p, l, first, lat); break;
        case 4: phase_gate(p, lat, smem); break;
        case 5: phase_resid(p, l, wsb(p, O_U), D, W + W_OUT, 1024, 2, first, lat, smem); break;
        case 6: phase_norm(p, l, 1, false, lat); break;
        case 7: phase_gu(p, lat, smem); break;
        case 8: phase_resid(p, l, wsb(p, O_P), PW, W + W_DN, DFF, 5, false, lat, smem); break;
    }
}

#if MEGA
__global__ void __launch_bounds__(256) mega_kernel(Params p) {
    extern __shared__ __align__(16) unsigned char smem[];
    cg::grid_group grid = cg::this_grid();
    __shared__ uint4 xb_words;
    if (threadIdx.x == 0) xb_words = make_uint4(0u, 0u, 0u, 0u);
    __syncthreads();
    const XcdBarrier xb = xcd_barrier_post((unsigned*)(p.ws + O_BAR), (volatile LAS unsigned*)&xb_words);
    phase_mod(p, smem); phase_rope(p); __syncthreads(); phase_wconv(p, 0, smem);
    grid.sync();
    const bf16_t* W = wsb(p, O_WT);
#pragma unroll
    for (int l = 0; l < 2; ++l) {
        const bool first = l == 0, lat = l == 1;
        if (l == 1) phase_wconv(p, 1, smem);
        phase_norm(p, l, 0, first, false);
        xcd_barrier(xb);
        phase_g1(p, smem);
        xcd_barrier(xb);
        phase_mix(p, l, smem);
        xcd_barrier(xb);
        phase_fin_norm(p, l, first, lat);
        xcd_barrier(xb);
        phase_gate(p, lat, smem);
        xcd_barrier(xb);
        phase_merge(p, lat, smem);
        xcd_barrier(xb);
        phase_resid(p, l, wsb(p, O_U), D, W + W_OUT, 1024, 2, first, lat, smem);
        xcd_barrier(xb);
        phase_norm(p, l, 1, false, lat);
        xcd_barrier(xb);
        phase_gu(p, lat, smem);
        xcd_barrier(xb);
        phase_resid(p, l, wsb(p, O_P), PW, W + W_DN, DFF, 5, false, lat, smem);
        xcd_barrier(xb);
    }
    phase_final(p);
}
#else
__global__ void __launch_bounds__(256) phase_kernel(Params p, int ph) {
    extern __shared__ __align__(16) unsigned char smem[];
    run_phase(p, ph, smem);
}
#endif

extern "C" void kernel_launch(void* const* d_in, const int* in_sizes, int n_in, void* d_out, int out_size, void* d_ws, size_t ws_size, hipStream_t stream) {
    static int grid = 0;
    if (grid == 0) {
        if (n_in != 28 || ws_size < WS_END) { fprintf(stderr, "kernel_launch: unexpected n_in %d or ws_size %zu < %zu\n", n_in, ws_size, (size_t)WS_END); grid = -1; return; }
        int dev = 0, cus = 0, per_cu = 0;
        hipGetDevice(&dev);
        hipDeviceGetAttribute(&cus, hipDeviceAttributeMultiprocessorCount, dev);
#if MEGA
        hipFuncSetAttribute((const void*)mega_kernel, hipFuncAttributeMaxDynamicSharedMemorySize, LDS_BYTES);
        hipOccupancyMaxActiveBlocksPerMultiprocessor(&per_cu, (const void*)mega_kernel, 256, LDS_BYTES);
#else
        hipFuncSetAttribute((const void*)phase_kernel, hipFuncAttributeMaxDynamicSharedMemorySize, LDS_BYTES);
        hipOccupancyMaxActiveBlocksPerMultiprocessor(&per_cu, (const void*)phase_kernel, 256, LDS_BYTES);
#endif
        if (per_cu < 1) per_cu = 1;
        grid = cus * per_cu;
        fprintf(stderr, "kernel_launch: grid %d (%d CUs x %d)\n", grid, cus, per_cu);
    }
    if (grid < 0) return;
    hipMemsetAsync((char*)d_ws + O_CTL, 0, 4096 + 16384, stream);
    Params p{};
    for (int i = 0; i < 28; ++i) p.in[i] = (const float*)d_in[i];
    p.out = (float*)d_out; p.ws = (unsigned char*)d_ws;
#if MEGA
    void* args[] = {&p};
    hipError_t e = hipLaunchCooperativeKernel((const void*)mega_kernel, dim3(grid), dim3(256), args, LDS_BYTES, stream);
    if (e != hipSuccess) fprintf(stderr, "cooperative launch failed: %s (grid %d)\n", hipGetErrorString(e), grid);
#else
    for (int ph = 0; ph < NPHASE; ++ph) hipLaunchKernelGGL(phase_kernel, dim3(grid), dim3(256), LDS_BYTES, stream, p, ph);
#endif
}
```

```cpp
#include <hip/hip_runtime.h>
#include <hip/hip_cooperative_groups.h>
#include <cstdio>
#include <cstdint>
namespace cg = cooperative_groups;

#ifndef MEGA
#define MEGA 1
#endif

typedef unsigned short bf16_t;
typedef short bf16x8 __attribute__((ext_vector_type(8)));
typedef float f32x4 __attribute__((ext_vector_type(4)));
typedef unsigned u32x4 __attribute__((ext_vector_type(4)));
typedef unsigned u32x2 __attribute__((ext_vector_type(2)));
#define DEV __device__ __forceinline__

constexpr int D = 1024, NB = 8, SEQ = 4096, CTXL = 256, SB = 4352, MR = NB * SB, PW = 4096, DFF = 2816;
constexpr int C_DNQ = 0, C_DNK = 512, C_DNV = 1024, C_DNZ = 1536, C_LX = 2048, C_LG = 2560, C_DAQ = 3072, C_DAK = 3584;
constexpr int NIN = 4736;
constexpr int GLD = 80;

enum { I_X = 0, I_C, I_CTX, I_CCTX, I_WMOD, I_BMOD, I_NMIX, I_NFFN, I_WIN, I_DNCONV, I_DNALOG, I_DNDT, I_DNNORM, I_LCW, I_LCB,
       I_LWA, I_LBA, I_LWI, I_LBI, I_LLAM, I_DALAM, I_DANORM, I_WBR, I_WOUT, I_WFG, I_WFU, I_WFD, I_NFIN };

constexpr size_t al256(size_t x) { return (x + 255) & ~(size_t)255; }
constexpr size_t O_CTL = 0;
constexpr size_t O_BAR = 4096;
constexpr size_t O_MOD = 4096 + 16384;
constexpr size_t O_ROPE = al256(O_MOD + (size_t)2 * 9 * 6144 * 4);
constexpr size_t O_WT = al256(O_ROPE + 64 * 16 * 2 * 4);
constexpr size_t W_IN = 0, W_GATE = W_IN + (size_t)NIN * 1024, W_BR = W_GATE + (size_t)3072 * 1024, W_OUT = W_BR + (size_t)3 * 1024 * 512,
                 W_GU = W_OUT + (size_t)1024 * 1024, W_DN = W_GU + (size_t)5632 * 1024, W_END = W_DN + (size_t)1024 * 2816;
constexpr size_t O_HCTX = al256(O_WT + W_END * 2);
constexpr size_t O_U = al256(O_HCTX + (size_t)2048 * 1024 * 4);
constexpr size_t O_P = al256(O_U + (size_t)MR * 1024 * 2);
constexpr size_t O_AB = al256(O_P + (size_t)MR * PW * 2);
constexpr size_t O_TA = al256(O_AB + (size_t)MR * 16 * 4);
constexpr size_t O_TA2 = al256(O_TA + (size_t)MR * 512 * 2);
constexpr size_t O_VT = al256(O_TA2 + (size_t)MR * 512 * 2);
constexpr size_t WS_END = al256(O_VT + (size_t)MR * 512 * 2);

constexpr int LDS_BYTES = 140 * 1024;

struct Params {
    const float* in[28];
    float* out;
    unsigned char* ws;
};

DEV int get_tid() { int t = threadIdx.x; asm volatile("" : "+v"(t)); return t; }
DEV float bf2f(bf16_t h) { return __uint_as_float(((unsigned)h) << 16); }
DEV bf16_t f2bf(float f) { unsigned u = __float_as_uint(f); u += 0x7fffu + ((u >> 16) & 1u); return (bf16_t)(u >> 16); }
typedef float f32x2_ __attribute__((ext_vector_type(2)));
typedef __bf16 bf16x2_ __attribute__((ext_vector_type(2)));
DEV unsigned pack2(float a, float b) { const f32x2_ v = {a, b}; return __builtin_bit_cast(unsigned, __builtin_convertvector(v, bf16x2_)); }
DEV float sigm(float x) { return __builtin_amdgcn_rcpf(1.f + __expf(-x)); }
DEV float silu(float x) { return x * __builtin_amdgcn_rcpf(1.f + __expf(-x)); }
DEV float softplus(float x) { return x > 20.f ? x : log1pf(expf(x)); }
DEV float softplus_fast(float x) { const float e = __expf(x); return x > 15.f ? x : (e < 0.01f ? e * (1.f - e * (0.5f - e * 0.33333333f)) : __logf(1.f + e)); }
DEV float gelu_tanh(float x) { float u = 0.7978845608028654f * (x + 0.044715f * x * x * x); float t = 1.f - 2.f * __builtin_amdgcn_rcpf(1.f + __expf(2.f * u)); return 0.5f * x * (1.f + t); }
DEV f32x4 mfma16(bf16x8 a, bf16x8 b, f32x4 c) { return __builtin_amdgcn_mfma_f32_16x16x32_bf16(a, b, c, 0, 0, 0); }
DEV void mfma16a(f32x4& c, bf16x8 a, bf16x8 b) { asm volatile("v_mfma_f32_16x16x32_bf16 %0, %1, %2, %0" : "+a"(c) : "v"(a), "v"(b)); }
DEV float lo16(unsigned v) { return __uint_as_float(v << 16); }
DEV float hi16(unsigned v) { return __uint_as_float(v & 0xffff0000u); }

DEV bf16_t* wsb(const Params& p, size_t off) { return (bf16_t*)(p.ws + off); }
DEV float* wsf(const Params& p, size_t off) { return (float*)(p.ws + off); }
DEV float* hrow(const Params& p, int r) { int b = r / SB, s = r - b * SB; return s < CTXL ? wsf(p, O_HCTX) + (size_t)(b * CTXL + s) * D : p.out + (size_t)(b * SEQ + s - CTXL) * D; }
DEV const float* xrow(const Params& p, int r) { int b = r / SB, s = r - b * SB; return s < CTXL ? p.in[I_CTX] + (size_t)(b * CTXL + s) * D : p.in[I_X] + (size_t)(b * SEQ + s - CTXL) * D; }
DEV int modrow(int r) { int b = r / SB, s = r - b * SB; return s < CTXL ? 8 : b; }

template <int MT, int NT>
DEV void gemm_core(const bf16_t* __restrict__ A, int lda, const bf16_t* __restrict__ Bt, int ldb, int K, f32x4 (&acc)[MT][NT], bf16_t* smem_) {
    constexpr int SA = 32 * MT * GLD, SBB = 32 * NT * GLD;
    bf16_t* sA = smem_; bf16_t* sB = smem_ + 2 * SA;
    const int tid = get_tid(), lane = tid & 63, wv = tid >> 6, wr = wv >> 1, wc = wv & 1, l15 = lane & 15, quad = lane >> 4;
    const int lr = tid >> 3, lc = (tid & 7) * 8;
    u32x4 ra0[MT], rb0[NT], ra1[MT], rb1[NT];
    const bf16_t* Ap = A + (size_t)lr * lda + lc;
    const bf16_t* Bp = Bt + (size_t)lr * ldb + lc;
    const int nk = K >> 6;
#define GLOAD(RA, RB, KT) { const int ko_ = (KT) * 64; _Pragma("unroll") for (int i = 0; i < MT; ++i) RA[i] = *(const u32x4*)(Ap + (size_t)(32 * i) * lda + ko_); \
                            _Pragma("unroll") for (int i = 0; i < NT; ++i) RB[i] = *(const u32x4*)(Bp + (size_t)(32 * i) * ldb + ko_); }
#define LSTORE(RA, RB, BUF) { _Pragma("unroll") for (int i = 0; i < MT; ++i) *(u32x4*)(sA + (BUF) * SA + (lr + 32 * i) * GLD + lc) = RA[i]; \
                              _Pragma("unroll") for (int i = 0; i < NT; ++i) *(u32x4*)(sB + (BUF) * SBB + (lr + 32 * i) * GLD + lc) = RB[i]; }
#define AFRAG(BUF, MT_, KS) (*(const bf16x8*)(sA + (BUF) * SA + (wr * MT * 16 + (MT_) * 16 + l15) * GLD + (KS) * 32 + quad * 8))
#define HALF(BUFC, RA, RB, BUFS, DO_STORE, DO_LOAD, KT) { \
        bf16x8 bfr[2][NT]; \
        _Pragma("unroll") for (int ks = 0; ks < 2; ++ks) _Pragma("unroll") for (int nt = 0; nt < NT; ++nt) \
            bfr[ks][nt] = *(const bf16x8*)(sB + (BUFC) * SBB + (wc * NT * 16 + nt * 16 + l15) * GLD + ks * 32 + quad * 8); \
        bf16x8 a0 = AFRAG(BUFC, 0, 0), a1 = AFRAG(BUFC, 0, 1); \
        const int ko_ = (KT) * 64; \
        _Pragma("unroll") for (int mt = 0; mt < MT; ++mt) { \
            bf16x8 n0 = a0, n1 = a1; \
            if (mt + 1 < MT) { n0 = AFRAG(BUFC, mt + 1, 0); n1 = AFRAG(BUFC, mt + 1, 1); } \
            if (DO_STORE) { *(u32x4*)(sA + (BUFS) * SA + (lr + 32 * mt) * GLD + lc) = RA[mt]; } \
            if (DO_LOAD) { RA[mt] = *(const u32x4*)(Ap + (size_t)(32 * mt) * lda + ko_); } \
            _Pragma("unroll") for (int nt = 0; nt < NT; ++nt) mfma16a(acc[mt][nt], bfr[0][nt], a0); \
            if (DO_STORE) { if (mt < NT) *(u32x4*)(sB + (BUFS) * SBB + (lr + 32 * mt) * GLD + lc) = RB[mt]; } \
            if (DO_LOAD) { if (mt < NT) RB[mt] = *(const u32x4*)(Bp + (size_t)(32 * mt) * ldb + ko_); } \
            _Pragma("unroll") for (int nt = 0; nt < NT; ++nt) mfma16a(acc[mt][nt], bfr[1][nt], a1); \
            a0 = n0; a1 = n1; \
        } }
    static_assert(NT <= MT, "HALF stages the B pieces alongside the first NT A pieces");
    GLOAD(ra0, rb0, 0);
    GLOAD(ra1, rb1, 1);
    __syncthreads();
    LSTORE(ra0, rb0, 0);
    GLOAD(ra0, rb0, 2);
    __syncthreads();
    int kt = 0;
#pragma unroll 1
    for (; kt + 4 < nk; kt += 2) {
        HALF(0, ra1, rb1, 1, true, true, kt + 3);
        __syncthreads();
        HALF(1, ra0, rb0, 0, true, true, kt + 4);
        __syncthreads();
    }
    HALF(0, ra1, rb1, 1, true, true, kt + 3);
    __syncthreads();
    HALF(1, ra0, rb0, 0, true, false, 0);
    __syncthreads();
    HALF(0, ra1, rb1, 1, true, false, 0);
    __syncthreads();
    HALF(1, ra0, rb0, 0, false, false, 0);
    __syncthreads();
#undef AFRAG
#undef HALF
#undef GLOAD
#undef LSTORE
    static_assert(NT == 4, "the accumulator fence is written for NT == 4");
#pragma unroll
    for (int mt = 0; mt < MT; ++mt) {
        if (mt == 0) asm volatile("s_nop 15\n\ts_nop 15" : "+a"(acc[mt][0]), "+a"(acc[mt][1]), "+a"(acc[mt][2]), "+a"(acc[mt][3]));
        else asm volatile("s_nop 0" : "+a"(acc[mt][0]), "+a"(acc[mt][1]), "+a"(acc[mt][2]), "+a"(acc[mt][3]));
    }
}
template <int MT, int NT>
DEV void gemm_core1(const bf16_t* __restrict__ A, int lda, const bf16_t* __restrict__ Bt, int ldb, int K, f32x4 (&acc)[MT][NT], bf16_t* sA, bf16_t* sB) {
    const int tid = get_tid(), lane = tid & 63, wv = tid >> 6, wr = wv >> 1, wc = wv & 1, l15 = lane & 15, quad = lane >> 4;
    const int lr = tid >> 3, lc = (tid & 7) * 8;
    u32x4 ra[MT], rb[NT];
    const bf16_t* Ap = A + (size_t)lr * lda + lc;
    const bf16_t* Bp = Bt + (size_t)lr * ldb + lc;
#pragma unroll
    for (int i = 0; i < MT; ++i) ra[i] = *(const u32x4*)(Ap + (size_t)(32 * i) * lda);
#pragma unroll
    for (int i = 0; i < NT; ++i) rb[i] = *(const u32x4*)(Bp + (size_t)(32 * i) * ldb);
    const int nk = K >> 6;
    for (int kt = 0; kt < nk; ++kt) {
        __syncthreads();
#pragma unroll
        for (int i = 0; i < MT; ++i) *(u32x4*)(sA + (lr + 32 * i) * GLD + lc) = ra[i];
#pragma unroll
        for (int i = 0; i < NT; ++i) *(u32x4*)(sB + (lr + 32 * i) * GLD + lc) = rb[i];
        __syncthreads();
        if (kt + 1 < nk) {
            const int ko = (kt + 1) * 64;
#pragma unroll
            for (int i = 0; i < MT; ++i) ra[i] = *(const u32x4*)(Ap + (size_t)(32 * i) * lda + ko);
#pragma unroll
            for (int i = 0; i < NT; ++i) rb[i] = *(const u32x4*)(Bp + (size_t)(32 * i) * ldb + ko);
        }
#pragma unroll
        for (int ks = 0; ks < 2; ++ks) {
            bf16x8 af[MT], bfr[NT];
#pragma unroll
            for (int mt = 0; mt < MT; ++mt) af[mt] = *(const bf16x8*)(sA + (wr * MT * 16 + mt * 16 + l15) * GLD + ks * 32 + quad * 8);
#pragma unroll
            for (int nt = 0; nt < NT; ++nt) bfr[nt] = *(const bf16x8*)(sB + (wc * NT * 16 + nt * 16 + l15) * GLD + ks * 32 + quad * 8);
#pragma unroll
            for (int mt = 0; mt < MT; ++mt)
#pragma unroll
                for (int nt = 0; nt < NT; ++nt) mfma16a(acc[mt][nt], bfr[nt], af[mt]);
        }
    }
    static_assert(NT == 4, "the accumulator fence is written for NT == 4");
#pragma unroll
    for (int mt = 0; mt < MT; ++mt) {
        if (mt == 0) asm volatile("s_nop 15\n\ts_nop 15" : "+a"(acc[mt][0]), "+a"(acc[mt][1]), "+a"(acc[mt][2]), "+a"(acc[mt][3]));
        else asm volatile("s_nop 0" : "+a"(acc[mt][0]), "+a"(acc[mt][1]), "+a"(acc[mt][2]), "+a"(acc[mt][3]));
    }
}
template <int MT, int NT>
DEV void zero_acc(f32x4 (&acc)[MT][NT]) {
#pragma unroll
    for (int mt = 0; mt < MT; ++mt)
#pragma unroll
        for (int nt = 0; nt < NT; ++nt) acc[mt][nt] = (f32x4){0.f, 0.f, 0.f, 0.f};
}

DEV void phase_mod(const Params& p, unsigned char* smem) {
    float* s_s = (float*)smem;
    float* red = s_s + 9 * 1024;
    const int tid = get_tid();
    bool loaded = false;
    for (int it = blockIdx.x; it < 2 * 96; it += gridDim.x) {
        if (!loaded) {
            for (int e = tid; e < 9 * 1024; e += 256) { float v = e < 8192 ? p.in[I_C][e] : p.in[I_CCTX][e - 8192]; s_s[e] = silu(v); }
            loaded = true;
        }
        __syncthreads();
        const int l = it / 96, cg_ = it % 96, cq = tid & 63, kq = tid >> 6, col = cg_ * 64 + cq;
        float acc[9];
#pragma unroll
        for (int r = 0; r < 9; ++r) acc[r] = 0.f;
        const float* wp = p.in[I_WMOD] + ((size_t)l * 1024 + kq * 256) * 6144 + col;
#pragma unroll 8
        for (int k = 0; k < 256; ++k) {
            float wv = wp[(size_t)k * 6144];
#pragma unroll
            for (int r = 0; r < 9; ++r) acc[r] += s_s[r * 1024 + kq * 256 + k] * wv;
        }
#pragma unroll
        for (int r = 0; r < 9; ++r) red[(kq * 9 + r) * 64 + cq] = acc[r];
        __syncthreads();
        for (int e = tid; e < 9 * 64; e += 256) {
            int r = e >> 6, c2 = e & 63;
            float v = red[(0 * 9 + r) * 64 + c2] + red[(1 * 9 + r) * 64 + c2] + red[(2 * 9 + r) * 64 + c2] + red[(3 * 9 + r) * 64 + c2];
            wsf(p, O_MOD)[((size_t)l * 9 + r) * 6144 + cg_ * 64 + c2] = v + p.in[I_BMOD][l * 6144 + cg_ * 64 + c2];
        }
        __syncthreads();
    }
}
DEV void phase_rope(const Params& p) {
    if (blockIdx.x == (gridDim.x - 1)) {
        for (int e = threadIdx.x; e < 1024; e += 256) {
            int pos = e >> 4, i = e & 15;
            float inv = powf(10000.f, -(float)i / 16.f);
            float ang = (float)pos * inv;
            float n = rintf(ang * 0.15915494309189535f);
            float r = fmaf(-n, 6.28125f, ang);
            r = fmaf(-n, 1.9353071795864769e-3f, r);
            wsf(p, O_ROPE)[e * 2] = cosf(r);
            wsf(p, O_ROPE)[e * 2 + 1] = sinf(r);
        }
    }
}
DEV void wconv_tile(const float* src0, const float* src1, int lds_, int K, bf16_t* dst, int kind, int kt, int nt, bf16_t* tile) {
    const int tid = get_tid();
    const int kk = tid >> 2, grp = tid & 3;
    const int n0 = nt * 64, k0 = kt * 64;
    const int ng = n0 + grp * 16;
    const float* src = src0; int sc;
    if (kind == 0) { sc = ng < 2048 ? ng : (ng < 4608 ? ng + 16 : (ng < 4624 ? 2048 : -1)); }
    else if (kind == 1) { sc = 4624 + ng; }
    else if (kind == 2) { sc = ng; }
    else { int gd = ng >> 4; src = (gd & 1) ? src1 : src0; sc = (gd >> 1) * 16; }
    __syncthreads();
    if (sc >= 0) {
        const float4* sp = (const float4*)(src + (size_t)(k0 + kk) * lds_ + sc);
#pragma unroll
        for (int q = 0; q < 4; ++q) { float4 v = sp[q]; int e = grp * 16 + q * 4;
            tile[(e + 0) * GLD + kk] = f2bf(v.x); tile[(e + 1) * GLD + kk] = f2bf(v.y); tile[(e + 2) * GLD + kk] = f2bf(v.z); tile[(e + 3) * GLD + kk] = f2bf(v.w); }
    } else {
#pragma unroll
        for (int e = 0; e < 16; ++e) tile[(grp * 16 + e) * GLD + kk] = 0;
    }
    __syncthreads();
    const int n = tid >> 2, kseg = (tid & 3) * 16;
    u32x4 a = *(const u32x4*)(tile + n * GLD + kseg), b = *(const u32x4*)(tile + n * GLD + kseg + 8);
    bf16_t* dp = dst + (size_t)(n0 + n) * K + k0 + kseg;
    *(u32x4*)dp = a; *(u32x4*)(dp + 8) = b;
}
DEV void phase_wconv(const Params& p, int l, unsigned char* smem) {
    bf16_t* tile = (bf16_t*)smem;
    bf16_t* W = wsb(p, O_WT);
    constexpr int T0 = 74 * 16, T1 = T0 + 48 * 16, T2 = T1 + 3 * 16 * 8, T3 = T2 + 16 * 16, T4 = T3 + 88 * 16, T5 = T4 + 16 * 44;
    for (int t = blockIdx.x; t < T5; t += gridDim.x) {
        if (t < T0) { wconv_tile(p.in[I_WIN] + (size_t)l * 1024 * 7696, nullptr, 7696, 1024, W + W_IN, 0, t % 16, t / 16, tile); }
        else if (t < T1) { int u = t - T0; wconv_tile(p.in[I_WIN] + (size_t)l * 1024 * 7696, nullptr, 7696, 1024, W + W_GATE, 1, u % 16, u / 16, tile); }
        else if (t < T2) { int u = t - T1; int n = u / 128, v = u % 128; wconv_tile(p.in[I_WBR] + ((size_t)l * 3 + n) * 512 * 1024, nullptr, 1024, 512, W + W_BR + (size_t)n * 1024 * 512, 2, v % 8, v / 8, tile); }
        else if (t < T3) { int u = t - T2; wconv_tile(p.in[I_WOUT] + (size_t)l * 1024 * 1024, nullptr, 1024, 1024, W + W_OUT, 2, u % 16, u / 16, tile); }
        else if (t < T4) { int u = t - T3; wconv_tile(p.in[I_WFG] + (size_t)l * 1024 * DFF, p.in[I_WFU] + (size_t)l * 1024 * DFF, DFF, 1024, W + W_GU, 3, u % 16, u / 16, tile); }
        else { int u = t - T4; wconv_tile(p.in[I_WFD] + (size_t)l * DFF * 1024, nullptr, 1024, DFF, W + W_DN, 2, u % 44, u / 44, tile); }
    }
}

DEV void norm_row(const Params& p, int l, int which, bool first, int r, int lane) {
    const float* h = first ? xrow(p, r) : hrow(p, r);
    const float* nw = p.in[which ? I_NFFN : I_NMIX] + l * D;
    const float* md = wsf(p, O_MOD) + ((size_t)l * 9 + modrow(r)) * 6144 + (which ? 3 * D : 0);
    float4 v[4]; float ss = 0.f;
#pragma unroll
    for (int i = 0; i < 4; ++i) { v[i] = *(const float4*)(h + i * 256 + lane * 4); ss += v[i].x * v[i].x + v[i].y * v[i].y + v[i].z * v[i].z + v[i].w * v[i].w; }
#pragma unroll
    for (int o = 32; o >= 1; o >>= 1) ss += __shfl_xor(ss, o);
    const float rstd = rsqrtf(ss * (1.f / D) + 1e-6f);
    bf16_t* up = wsb(p, O_U) + (size_t)r * D;
#pragma unroll
    for (int i = 0; i < 4; ++i) {
        const int c = i * 256 + lane * 4;
        float4 w4 = *(const float4*)(nw + c), sh = *(const float4*)(md + c), sc = *(const float4*)(md + D + c);
        float a = v[i].x * rstd * w4.x * (1.f + sc.x) + sh.x, b = v[i].y * rstd * w4.y * (1.f + sc.y) + sh.y;
        float c2 = v[i].z * rstd * w4.z * (1.f + sc.z) + sh.z, d = v[i].w * rstd * w4.w * (1.f + sc.w) + sh.w;
        u32x2 o; o.x = pack2(a, b); o.y = pack2(c2, d);
        *(u32x2*)(up + c) = o;
    }
}
DEV void phase_norm(const Params& p, int l, int which, bool first, bool skip_ctx) {
    const int tid_ = get_tid(); const int lane = tid_ & 63, wv = tid_ >> 6;
    for (int r = blockIdx.x * 4 + wv; r < MR; r += gridDim.x * 4) {
        if (skip_ctx && (r % SB) < CTXL) continue;
        norm_row(p, l, which, first, r, lane);
    }
}
DEV void phase_fin_norm(const Params& p, int l, bool first, bool skip_ctx) {
    const int tid_ = get_tid(); const int lane = tid_ & 63, wv = tid_ >> 6;
    const float* dnn = p.in[I_DNNORM] + l * 128;
    for (int r = blockIdx.x * 4 + wv; r < MR; r += gridDim.x * 4) {
        if (skip_ctx && (r % SB) < CTXL) continue;
        norm_row(p, l, 0, first, r, lane);
        bf16_t* ta = wsb(p, O_TA) + (size_t)r * 512 + lane * 8;
        const bf16_t* tb = wsb(p, O_TA2) + (size_t)r * 512 + lane * 8;
        const bf16_t* zz = wsb(p, O_P) + (size_t)r * PW + C_DNZ + lane * 8;
        u32x4 a = *(const u32x4*)ta, b = *(const u32x4*)tb, z = *(const u32x4*)zz;
        float o[8]; float ss = 0.f;
#pragma unroll
        for (int i = 0; i < 4; ++i) { o[2 * i] = lo16(a[i]) + lo16(b[i]); o[2 * i + 1] = hi16(a[i]) + hi16(b[i]); ss += o[2 * i] * o[2 * i] + o[2 * i + 1] * o[2 * i + 1]; }
#pragma unroll
        for (int of = 8; of >= 1; of >>= 1) ss += __shfl_xor(ss, of);
        const float rstd = rsqrtf(ss * (1.f / 128.f) + 1e-6f);
        const int dv0 = (lane & 15) * 8;
        u32x4 y;
#pragma unroll
        for (int i = 0; i < 4; ++i) {
            float y0 = o[2 * i] * rstd * dnn[dv0 + 2 * i] * silu(lo16(z[i]));
            float y1 = o[2 * i + 1] * rstd * dnn[dv0 + 2 * i + 1] * silu(hi16(z[i]));
            y[i] = pack2(y0, y1);
        }
        *(u32x4*)ta = y;
    }
}
DEV void phase_final(const Params& p) {
    const int tid_ = get_tid(); const int lane = tid_ & 63, wv = tid_ >> 6;
    const float* nw = p.in[I_NFIN];
    for (int r = blockIdx.x * 4 + wv; r < NB * SEQ; r += gridDim.x * 4) {
        float* h = p.out + (size_t)r * D;
        float4 v[4]; float ss = 0.f;
#pragma unroll
        for (int i = 0; i < 4; ++i) { v[i] = *(const float4*)(h + i * 256 + lane * 4); ss += v[i].x * v[i].x + v[i].y * v[i].y + v[i].z * v[i].z + v[i].w * v[i].w; }
#pragma unroll
        for (int o = 32; o >= 1; o >>= 1) ss += __shfl_xor(ss, o);
        const float rstd = rsqrtf(ss * (1.f / D) + 1e-6f);
#pragma unroll
        for (int i = 0; i < 4; ++i) {
            const int c = i * 256 + lane * 4;
            float4 w4 = *(const float4*)(nw + c);
            float4 o4; o4.x = v[i].x * rstd * w4.x; o4.y = v[i].y * rstd * w4.y; o4.z = v[i].z * rstd * w4.z; o4.w = v[i].w * rstd * w4.w;
            *(float4*)(h + c) = o4;
        }
    }
}

struct TileIter {
    int nn, total, nloc, L;
    DEV TileIter(int nm, int nn_) { nn = nn_; total = nm * nn_; nloc = gridDim.x >> 3; L = (blockIdx.x & 7) * nloc + (blockIdx.x >> 3); }
    DEV bool valid() const { return L < total; }
    DEV bool more() const { return (L - (int)(blockIdx.x >> 3)) < total; }
    DEV void next() { L += 8 * nloc; }
    DEV void get(int& tm, int& tn) const { const int pn = 4 * nn, panel = L / pn, rem = L - panel * pn; tn = rem >> 2; tm = panel * 4 + (rem & 3); }
};
DEV void phase_g1(const Params& p, unsigned char* smem) {
    bf16_t* sA = (bf16_t*)smem;
    const int tid = get_tid(), lane = tid & 63, wv = tid >> 6, wr = wv >> 1, wc = wv & 1, l15 = lane & 15, quad = lane >> 4;
    const bf16_t* U = wsb(p, O_U); const bf16_t* W = wsb(p, O_WT) + W_IN;
    bf16_t* P = wsb(p, O_P);
    const float* rope = wsf(p, O_ROPE);
    constexpr int NTN = NIN / 128;
    const int wr0_ = wr, wc0_ = wc, l150_ = l15, quad0_ = quad;
    for (TileIter ti(MR / 256, NTN); ti.valid(); ti.next()) {
        int tm, tn; ti.get(tm, tn);
        const int row0 = tm * 256, col0 = tn * 128;
        f32x4 acc[8][4]; zero_acc(acc);
        gemm_core<8, 4>(U + (size_t)row0 * D, D, W + (size_t)col0 * D, D, D, acc, sA);
        int tz = 0; asm volatile("" : "+v"(tz));
        const int wr = wr0_ + tz, wc = wc0_ + tz, l15 = l150_ + tz, quad = quad0_ + tz;
        if (tn < 24) {
#pragma unroll
            for (int mt = 0; mt < 8; ++mt) {
                __builtin_amdgcn_sched_barrier(0);
                bf16_t* pp = P + (size_t)(row0 + wr * 128 + mt * 16 + l15) * PW + col0 + wc * 64 + quad * 4;
#pragma unroll
                for (int nt = 0; nt < 4; ++nt) { u32x2 o; o.x = pack2(acc[mt][nt][0], acc[mt][nt][1]); o.y = pack2(acc[mt][nt][2], acc[mt][nt][3]); *(u32x2*)(pp + nt * 16) = o; }
            }
        } else if (tn < 32) {
            const float qs = tn < 28 ? 0.125f : 1.f;
#pragma unroll
            for (int mt = 0; mt < 8; ++mt) {
                __builtin_amdgcn_sched_barrier(0);
                const int row = row0 + wr * 128 + mt * 16 + l15;
                const int s_ = row % SB;
                f32x4 ca = {1.f, 1.f, 1.f, 1.f}, sa = {0.f, 0.f, 0.f, 0.f}, cb = {1.f, 1.f, 1.f, 1.f}, sb = {0.f, 0.f, 0.f, 0.f};
                if (s_ >= CTXL) { const int tt = s_ - CTXL, pr = tt >> 6, pc = tt & 63;
                    const f32x4 r0 = *(const f32x4*)(rope + (pr * 16 + quad * 4) * 2), r1 = *(const f32x4*)(rope + (pr * 16 + quad * 4) * 2 + 4);
                    const f32x4 r2 = *(const f32x4*)(rope + (pc * 16 + quad * 4) * 2), r3 = *(const f32x4*)(rope + (pc * 16 + quad * 4) * 2 + 4);
                    ca = (f32x4){r0[0], r0[2], r1[0], r1[2]}; sa = (f32x4){r0[1], r0[3], r1[1], r1[3]};
                    cb = (f32x4){r2[0], r2[2], r3[0], r3[2]}; sb = (f32x4){r2[1], r2[3], r3[1], r3[3]}; }
                const f32x4 x1 = acc[mt][0], x2 = acc[mt][1], y1 = acc[mt][2], y2 = acc[mt][3];
                const f32x4 o0 = (x1 * ca - x2 * sa) * qs, o1 = (x2 * ca + x1 * sa) * qs, o2 = (y1 * cb - y2 * sb) * qs, o3 = (y2 * cb + y1 * sb) * qs;
                bf16_t* pp = P + (size_t)row * PW + col0 + wc * 64 + quad * 4;
                u32x2 o; o.x = pack2(o0[0], o0[1]); o.y = pack2(o0[2], o0[3]); *(u32x2*)(pp) = o;
                o.x = pack2(o1[0], o1[1]); o.y = pack2(o1[2], o1[3]); *(u32x2*)(pp + 16) = o;
                o.x = pack2(o2[0], o2[1]); o.y = pack2(o2[2], o2[3]); *(u32x2*)(pp + 32) = o;
                o.x = pack2(o3[0], o3[1]); o.y = pack2(o3[2], o3[3]); *(u32x2*)(pp + 48) = o;
            }
        } else if (tn < 36) {
            bf16_t* VT = wsb(p, O_VT);
            const int b = row0 / SB, sbase = row0 - b * SB;
#pragma unroll
            for (int mt = 0; mt < 8; ++mt) {
                __builtin_amdgcn_sched_barrier(0);
                const int s_ = sbase + wr * 128 + mt * 16 + l15;
                const int vi0 = (b * 512 + col0 - 4096 + wc * 64 + quad * 4) * SB + s_;
#pragma unroll
                for (int nt = 0; nt < 4; ++nt) {
                    const unsigned p01 = pack2(acc[mt][nt][0], acc[mt][nt][1]), p23 = pack2(acc[mt][nt][2], acc[mt][nt][3]);
                    VT[vi0 + (nt * 16 + 0) * SB] = (bf16_t)(p01 & 0xffffu); VT[vi0 + (nt * 16 + 1) * SB] = (bf16_t)(p01 >> 16);
                    VT[vi0 + (nt * 16 + 2) * SB] = (bf16_t)(p23 & 0xffffu); VT[vi0 + (nt * 16 + 3) * SB] = (bf16_t)(p23 >> 16);
                }
            }
        } else {
            if (wc == 0) {
                float* AB = wsf(p, O_AB);
#pragma unroll
                for (int mt = 0; mt < 8; ++mt) {
                    const int row = row0 + wr * 128 + mt * 16 + l15;
                    *(f32x4*)(AB + (size_t)row * 16 + quad * 4) = acc[mt][0];
                }
            }
        }
    }
}

DEV int rowtile0(int ti, bool latent_only) { if (!latent_only) return ti * 256; int b = ti >> 4, tt = ti & 15; return b * SB + CTXL + tt * 256; }
DEV int sgcol(int n, int c) { return n < 2 ? n * 1024 + c : (c < 512 ? 2048 + c : 3584 + (c - 512)); }

DEV void phase_gate(const Params& p, bool latent_only, unsigned char* smem) {
    bf16_t* sA = (bf16_t*)smem;
    const int tid = get_tid(), lane = tid & 63, wv = tid >> 6, wr = wv >> 1, wc = wv & 1, l15 = lane & 15, quad = lane >> 4;
    const bf16_t* U = wsb(p, O_U); const bf16_t* W = wsb(p, O_WT) + W_GATE;
    bf16_t* P = wsb(p, O_P);
    const int nrt = latent_only ? 128 : 136;
    for (TileIter ti(nrt, 24); ti.valid(); ti.next()) {
        int tm, tn; ti.get(tm, tn);
        const int row0 = rowtile0(tm, latent_only);
        f32x4 acc[8][4]; zero_acc(acc);
        gemm_core<8, 4>(U + (size_t)row0 * D, D, W + (size_t)tn * 128 * D, D, D, acc, sA);
        const int dcol0 = sgcol(tn >> 3, (tn & 7) * 128);
        bf16_t* ip = P + (size_t)(row0 + tid) * PW + dcol0;
#pragma unroll
        for (int mt = 0; mt < 8; ++mt) {
            __builtin_amdgcn_sched_barrier(0);
#pragma unroll
            for (int hf = 0; hf < 2; ++hf) {
                u32x4 o;
                o[0] = pack2(sigm(acc[mt][2 * hf][0]), sigm(acc[mt][2 * hf][1])); o[1] = pack2(sigm(acc[mt][2 * hf][2]), sigm(acc[mt][2 * hf][3]));
                o[2] = pack2(sigm(acc[mt][2 * hf + 1][0]), sigm(acc[mt][2 * hf + 1][1])); o[3] = pack2(sigm(acc[mt][2 * hf + 1][2]), sigm(acc[mt][2 * hf + 1][3]));
                *(u32x4*)(ip + (mt * 2 + hf) * 8) = o;
            }
        }
    }
}

DEV void phase_merge(const Params& p, bool latent_only, unsigned char* smem) {
    bf16_t* sA = (bf16_t*)smem;
    const int tid = get_tid(), lane = tid & 63, wv = tid >> 6, wr = wv >> 1, wc = wv & 1, l15 = lane & 15, quad = lane >> 4;
    const bf16_t* W = wsb(p, O_WT);
    const bf16_t* P = wsb(p, O_P);
    bf16_t* U = wsb(p, O_U);
    const int nrt = latent_only ? 128 : 136;
    for (TileIter ti(nrt, 8); ti.valid(); ti.next()) {
        int tm, tn; ti.get(tm, tn);
        const int row0 = rowtile0(tm, latent_only), col0 = tn * 128;
        f32x4 m[8][4]; zero_acc(m);
#pragma unroll 1
        for (int n = 0; n < 3; ++n) {
            f32x4 au[8][4]; zero_acc(au);
            const bf16_t* Y; int ldy;
            if (n == 0) { Y = wsb(p, O_TA) + (size_t)row0 * 512; ldy = 512; }
            else if (n == 1) { Y = P + (size_t)row0 * PW + C_LG; ldy = PW; }
            else { Y = P + (size_t)row0 * PW + C_DAQ; ldy = PW; }
            const int sc0 = sgcol(n, col0);
            gemm_core<8, 4>(Y, ldy, W + W_BR + ((size_t)n * 1024 + col0) * 512, 512, 512, au, sA);
            u32x4 sg[16];
            const bf16_t* ip = P + (size_t)(row0 + tid) * PW + sc0;
#pragma unroll
            for (int q = 0; q < 16; ++q) sg[q] = *(const u32x4*)(ip + q * 8);
#pragma unroll
            for (int mt = 0; mt < 8; ++mt)
#pragma unroll
                for (int nt = 0; nt < 4; ++nt) {
                    const unsigned g01 = sg[mt * 2 + (nt >> 1)][(nt & 1) * 2], g23 = sg[mt * 2 + (nt >> 1)][(nt & 1) * 2 + 1];
                    m[mt][nt][0] += lo16(g01) * au[mt][nt][0]; m[mt][nt][1] += hi16(g01) * au[mt][nt][1];
                    m[mt][nt][2] += lo16(g23) * au[mt][nt][2]; m[mt][nt][3] += hi16(g23) * au[mt][nt][3];
                }
        }
#pragma unroll
        for (int mt = 0; mt < 8; ++mt) {
            __builtin_amdgcn_sched_barrier(0);
            bf16_t* up = U + (size_t)(row0 + wr * 128 + mt * 16 + l15) * D + col0 + wc * 64 + quad * 4;
#pragma unroll
            for (int nt = 0; nt < 4; ++nt) { u32x2 o; o.x = pack2(m[mt][nt][0], m[mt][nt][1]); o.y = pack2(m[mt][nt][2], m[mt][nt][3]); *(u32x2*)(up + nt * 16) = o; }
        }
    }
}

DEV void phase_resid(const Params& p, int l, const bf16_t* A, int lda, const bf16_t* Wt, int K, int chunk, bool first, bool latent_only, unsigned char* smem) {
    bf16_t* sA = (bf16_t*)smem;
    const int tid = get_tid(), lane = tid & 63, wv = tid >> 6, wr = wv >> 1, wc = wv & 1, l15 = lane & 15, quad = lane >> 4;
    const int nrt = latent_only ? 128 : 136;
    for (TileIter ti(nrt, 8); ti.valid(); ti.next()) {
        int tm, tn; ti.get(tm, tn);
        const int row0 = rowtile0(tm, latent_only), col0 = tn * 128;
        f32x4 acc[8][4]; zero_acc(acc);
        gemm_core<8, 4>(A + (size_t)row0 * lda, lda, Wt + (size_t)col0 * K, K, K, acc, sA);
        const float* md = wsf(p, O_MOD) + ((size_t)l * 9 + modrow(row0)) * 6144 + chunk * D + col0 + wc * 64 + quad * 4;
        const float* hs0 = first ? xrow(p, row0) : hrow(p, row0);
        float* hd0 = hrow(p, row0);
        f32x4 mg[4];
#pragma unroll
        for (int nt = 0; nt < 4; ++nt) mg[nt] = *(const f32x4*)(md + nt * 16);
#pragma unroll
        for (int mt = 0; mt < 8; ++mt) {
            __builtin_amdgcn_sched_barrier(0);
            const size_t ro = (size_t)(wr * 128 + mt * 16 + l15) * D + col0 + wc * 64 + quad * 4;
#pragma unroll
            for (int nt = 0; nt < 4; ++nt) { const f32x4 h = *(const f32x4*)(hs0 + ro + nt * 16); *(f32x4*)(hd0 + ro + nt * 16) = h + mg[nt] * acc[mt][nt]; }
        }
    }
}
DEV void phase_gu(const Params& p, bool latent_only, unsigned char* smem) {
    bf16_t* sA = (bf16_t*)smem;
    const int tid = get_tid(), lane = tid & 63, wv = tid >> 6, wr = wv >> 1, wc = wv & 1, l15 = lane & 15, quad = lane >> 4;
    const bf16_t* U = wsb(p, O_U); const bf16_t* W = wsb(p, O_WT) + W_GU;
    bf16_t* P = wsb(p, O_P);
    const int nrt = latent_only ? 128 : 136;
    for (TileIter ti(nrt, 44); ti.valid(); ti.next()) {
        int tm, tn; ti.get(tm, tn);
        const int row0 = rowtile0(tm, latent_only);
        f32x4 acc[8][4]; zero_acc(acc);
        gemm_core<8, 4>(U + (size_t)row0 * D, D, W + (size_t)tn * 128 * D, D, D, acc, sA);
#pragma unroll
        for (int mt = 0; mt < 8; ++mt) {
            __builtin_amdgcn_sched_barrier(0);
            bf16_t* pp = P + (size_t)(row0 + wr * 128 + mt * 16 + l15) * PW + (tn * 4 + wc * 2) * 16 + quad * 4;
#pragma unroll
            for (int pr = 0; pr < 2; ++pr) {
                const f32x4 g = acc[mt][2 * pr], u = acc[mt][2 * pr + 1];
                u32x2 o; o.x = pack2(silu(g[0]) * u[0], silu(g[1]) * u[1]); o.y = pack2(silu(g[2]) * u[2], silu(g[3]) * u[3]);
                *(u32x2*)(pp + pr * 16) = o;
            }
        }
    }
}

DEV int chunk_of(int dir, int n) { return dir ? (n < 4 ? 3 - n : 71 - n) : n; }

typedef float f32x2 __attribute__((ext_vector_type(2)));
DEV void dn_solve(const float* __restrict__ Lt_s0, const bf16_t* __restrict__ colp, const float* __restrict__ mulp0, const float sg, bf16_t* __restrict__ outp,
                  bf16_t* XT_s, const bf16_t* Lb_s, const int tid, const int wv, const int l15, const int quad) {
    int vz = 0; asm volatile("" : "+v"(vz));
    const float* __restrict__ Lt_s = Lt_s0 + vz; const float* __restrict__ mulp = mulp0 + vz;
    f32x2 X0, X1, X2, X3, X4, X5, X6, X7, X8, X9, X10, X11, X12, X13, X14, X15, X16, X17, X18, X19, X20, X21, X22, X23, X24, X25, X26, X27, X28, X29, X30, X31;
    f32x4 La0, La1, La2, La3, La4, La5, La6, La7, La8, La9, La10, La11, La12, La13, La14, La15, Lb0, Lb1, Lb2, Lb3, Lb4, Lb5, Lb6, Lb7, Lb8, Lb9, Lb10, Lb11, Lb12, Lb13, Lb14, Lb15;
    X0 = (f32x2){bf2f(colp[0]) * mulp[0], bf2f(colp[136]) * mulp[1]};
    X1 = (f32x2){bf2f(colp[272]) * mulp[2], bf2f(colp[408]) * mulp[3]};
    X2 = (f32x2){bf2f(colp[544]) * mulp[4], bf2f(colp[680]) * mulp[5]};
    X3 = (f32x2){bf2f(colp[816]) * mulp[6], bf2f(colp[952]) * mulp[7]};
    X4 = (f32x2){bf2f(colp[1088]) * mulp[8], bf2f(colp[1224]) * mulp[9]};
    X5 = (f32x2){bf2f(colp[1360]) * mulp[10], bf2f(colp[1496]) * mulp[11]};
    X6 = (f32x2){bf2f(colp[1632]) * mulp[12], bf2f(colp[1768]) * mulp[13]};
    X7 = (f32x2){bf2f(colp[1904]) * mulp[14], bf2f(colp[2040]) * mulp[15]};
    X8 = (f32x2){bf2f(colp[2176]) * mulp[16], bf2f(colp[2312]) * mulp[17]};
    X9 = (f32x2){bf2f(colp[2448]) * mulp[18], bf2f(colp[2584]) * mulp[19]};
    X10 = (f32x2){bf2f(colp[2720]) * mulp[20], bf2f(colp[2856]) * mulp[21]};
    X11 = (f32x2){bf2f(colp[2992]) * mulp[22], bf2f(colp[3128]) * mulp[23]};
    X12 = (f32x2){bf2f(colp[3264]) * mulp[24], bf2f(colp[3400]) * mulp[25]};
    X13 = (f32x2){bf2f(colp[3536]) * mulp[26], bf2f(colp[3672]) * mulp[27]};
    X14 = (f32x2){bf2f(colp[3808]) * mulp[28], bf2f(colp[3944]) * mulp[29]};
    X15 = (f32x2){bf2f(colp[4080]) * mulp[30], bf2f(colp[4216]) * mulp[31]};
    X16 = (f32x2){bf2f(colp[4352]) * mulp[32], bf2f(colp[4488]) * mulp[33]};
    X17 = (f32x2){bf2f(colp[4624]) * mulp[34], bf2f(colp[4760]) * mulp[35]};
    X18 = (f32x2){bf2f(colp[4896]) * mulp[36], bf2f(colp[5032]) * mulp[37]};
    X19 = (f32x2){bf2f(colp[5168]) * mulp[38], bf2f(colp[5304]) * mulp[39]};
    X20 = (f32x2){bf2f(colp[5440]) * mulp[40], bf2f(colp[5576]) * mulp[41]};
    X21 = (f32x2){bf2f(colp[5712]) * mulp[42], bf2f(colp[5848]) * mulp[43]};
    X22 = (f32x2){bf2f(colp[5984]) * mulp[44], bf2f(colp[6120]) * mulp[45]};
    X23 = (f32x2){bf2f(colp[6256]) * mulp[46], bf2f(colp[6392]) * mulp[47]};
    X24 = (f32x2){bf2f(colp[6528]) * mulp[48], bf2f(colp[6664]) * mulp[49]};
    X25 = (f32x2){bf2f(colp[6800]) * mulp[50], bf2f(colp[6936]) * mulp[51]};
    X26 = (f32x2){bf2f(colp[7072]) * mulp[52], bf2f(colp[7208]) * mulp[53]};
    X27 = (f32x2){bf2f(colp[7344]) * mulp[54], bf2f(colp[7480]) * mulp[55]};
    X28 = (f32x2){bf2f(colp[7616]) * mulp[56], bf2f(colp[7752]) * mulp[57]};
    X29 = (f32x2){bf2f(colp[7888]) * mulp[58], bf2f(colp[8024]) * mulp[59]};
    X30 = (f32x2){bf2f(colp[8160]) * mulp[60], bf2f(colp[8296]) * mulp[61]};
    X31 = (f32x2){bf2f(colp[8432]) * mulp[62], bf2f(colp[8568]) * mulp[63]};
    __syncthreads();
    La0 = *(const f32x4*)(Lt_s + 0);
    La1 = *(const f32x4*)(Lt_s + 4);
    La2 = *(const f32x4*)(Lt_s + 8);
    La3 = *(const f32x4*)(Lt_s + 12);
    La4 = *(const f32x4*)(Lt_s + 16);
    La5 = *(const f32x4*)(Lt_s + 20);
    La6 = *(const f32x4*)(Lt_s + 24);
    La7 = *(const f32x4*)(Lt_s + 28);
    Lb0 = *(const f32x4*)(Lt_s + 68);
    Lb1 = *(const f32x4*)(Lt_s + 72);
    Lb2 = *(const f32x4*)(Lt_s + 76);
    Lb3 = *(const f32x4*)(Lt_s + 80);
    Lb4 = *(const f32x4*)(Lt_s + 84);
    Lb5 = *(const f32x4*)(Lt_s + 88);
    Lb6 = *(const f32x4*)(Lt_s + 92);
    Lb7 = *(const f32x4*)(Lt_s + 96);
    __builtin_amdgcn_sched_barrier(0);
    { const float xj = X0[0]; const f32x2 xj2 = (f32x2){xj, xj};
      X0 -= (f32x2){La0[0], La0[1]} * xj2;
      X1 -= (f32x2){La0[2], La0[3]} * xj2;
      X2 -= (f32x2){La1[0], La1[1]} * xj2;
      X3 -= (f32x2){La1[2], La1[3]} * xj2;
      X4 -= (f32x2){La2[0], La2[1]} * xj2;
      X5 -= (f32x2){La2[2], La2[3]} * xj2;
      X6 -= (f32x2){La3[0], La3[1]} * xj2;
      X7 -= (f32x2){La3[2], La3[3]} * xj2;
      X8 -= (f32x2){La4[0], La4[1]} * xj2;
      X9 -= (f32x2){La4[2], La4[3]} * xj2;
      X10 -= (f32x2){La5[0], La5[1]} * xj2;
      X11 -= (f32x2){La5[2], La5[3]} * xj2;
      X12 -= (f32x2){La6[0], La6[1]} * xj2;
      X13 -= (f32x2){La6[2], La6[3]} * xj2;
      X14 -= (f32x2){La7[0], La7[1]} * xj2;
      X15 -= (f32x2){La7[2], La7[3]} * xj2;
    }
    __builtin_amdgcn_sched_barrier(0);
    La0 = *(const f32x4*)(Lt_s + 136);
    La1 = *(const f32x4*)(Lt_s + 140);
    La2 = *(const f32x4*)(Lt_s + 144);
    La3 = *(const f32x4*)(Lt_s + 148);
    La4 = *(const f32x4*)(Lt_s + 152);
    La5 = *(const f32x4*)(Lt_s + 156);
    La6 = *(const f32x4*)(Lt_s + 160);
    La7 = *(const f32x4*)(Lt_s + 164);
    __builtin_amdgcn_sched_barrier(0);
    { const float xj = X0[1]; const f32x2 xj2 = (f32x2){xj, xj};
      X1 -= (f32x2){Lb0[2], Lb0[3]} * xj2;
      X2 -= (f32x2){Lb1[0], Lb1[1]} * xj2;
      X3 -= (f32x2){Lb1[2], Lb1[3]} * xj2;
      X4 -= (f32x2){Lb2[0], Lb2[1]} * xj2;
      X5 -= (f32x2){Lb2[2], Lb2[3]} * xj2;
      X6 -= (f32x2){Lb3[0], Lb3[1]} * xj2;
      X7 -= (f32x2){Lb3[2], Lb3[3]} * xj2;
      X8 -= (f32x2){Lb4[0], Lb4[1]} * xj2;
      X9 -= (f32x2){Lb4[2], Lb4[3]} * xj2;
      X10 -= (f32x2){Lb5[0], Lb5[1]} * xj2;
      X11 -= (f32x2){Lb5[2], Lb5[3]} * xj2;
      X12 -= (f32x2){Lb6[0], Lb6[1]} * xj2;
      X13 -= (f32x2){Lb6[2], Lb6[3]} * xj2;
      X14 -= (f32x2){Lb7[0], Lb7[1]} * xj2;
      X15 -= (f32x2){Lb7[2], Lb7[3]} * xj2;
    }
    __builtin_amdgcn_sched_barrier(0);
    Lb1 = *(const f32x4*)(Lt_s + 208);
    Lb2 = *(const f32x4*)(Lt_s + 212);
    Lb3 = *(const f32x4*)(Lt_s + 216);
    Lb4 = *(const f32x4*)(Lt_s + 220);
    Lb5 = *(const f32x4*)(Lt_s + 224);
    Lb6 = *(const f32x4*)(Lt_s + 228);
    Lb7 = *(const f32x4*)(Lt_s + 232);
    __builtin_amdgcn_sched_barrier(0);
    { const float xj = X1[0]; const f32x2 xj2 = (f32x2){xj, xj};
      X1 -= (f32x2){La0[2], La0[3]} * xj2;
      X2 -= (f32x2){La1[0], La1[1]} * xj2;
      X3 -= (f32x2){La1[2], La1[3]} * xj2;
      X4 -= (f32x2){La2[0], La2[1]} * xj2;
      X5 -= (f32x2){La2[2], La2[3]} * xj2;
      X6 -= (f32x2){La3[0], La3[1]} * xj2;
      X7 -= (f32x2){La3[2], La3[3]} * xj2;
      X8 -= (f32x2){La4[0], La4[1]} * xj2;
      X9 -= (f32x2){La4[2], La4[3]} * xj2;
      X10 -= (f32x2){La5[0], La5[1]} * xj2;
      X11 -= (f32x2){La5[2], La5[3]} * xj2;
      X12 -= (f32x2){La6[0], La6[1]} * xj2;
      X13 -= (f32x2){La6[2], La6[3]} * xj2;
      X14 -= (f32x2){La7[0], La7[1]} * xj2;
      X15 -= (f32x2){La7[2], La7[3]} * xj2;
    }
    __builtin_amdgcn_sched_barrier(0);
    La1 = *(const f32x4*)(Lt_s + 276);
    La2 = *(const f32x4*)(Lt_s + 280);
    La3 = *(const f32x4*)(Lt_s + 284);
    La4 = *(const f32x4*)(Lt_s + 288);
    La5 = *(const f32x4*)(Lt_s + 292);
    La6 = *(const f32x4*)(Lt_s + 296);
    La7 = *(const f32x4*)(Lt_s + 300);
    __builtin_amdgcn_sched_barrier(0);
    { const float xj = X1[1]; const f32x2 xj2 = (f32x2){xj, xj};
      X2 -= (f32x2){Lb1[0], Lb1[1]} * xj2;
      X3 -= (f32x2){Lb1[2], Lb1[3]} * xj2;
      X4 -= (f32x2){Lb2[0], Lb2[1]} * xj2;
      X5 -= (f32x2){Lb2[2], Lb2[3]} * xj2;
      X6 -= (f32x2){Lb3[0], Lb3[1]} * xj2;
      X7 -= (f32x2){Lb3[2], Lb3[3]} * xj2;
      X8 -= (f32x2){Lb4[0], Lb4[1]} * xj2;
      X9 -= (f32x2){Lb4[2], Lb4[3]} * xj2;
      X10 -= (f32x2){Lb5[0], Lb5[1]} * xj2;
      X11 -= (f32x2){Lb5[2], Lb5[3]} * xj2;
      X12 -= (f32x2){Lb6[0], Lb6[1]} * xj2;
      X13 -= (f32x2){Lb6[2], Lb6[3]} * xj2;
      X14 -= (f32x2){Lb7[0], Lb7[1]} * xj2;
      X15 -= (f32x2){Lb7[2], Lb7[3]} * xj2;
    }
    __builtin_amdgcn_sched_barrier(0);
    Lb1 = *(const f32x4*)(Lt_s + 344);
    Lb2 = *(const f32x4*)(Lt_s + 348);
    Lb3 = *(const f32x4*)(Lt_s + 352);
    Lb4 = *(const f32x4*)(Lt_s + 356);
    Lb5 = *(const f32x4*)(Lt_s + 360);
    Lb6 = *(const f32x4*)(Lt_s + 364);
    Lb7 = *(const f32x4*)(Lt_s + 368);
    __builtin_amdgcn_sched_barrier(0);
    { const float xj = X2[0]; const f32x2 xj2 = (f32x2){xj, xj};
      X2 -= (f32x2){La1[0], La1[1]} * xj2;
      X3 -= (f32x2){La1[2], La1[3]} * xj2;
      X4 -= (f32x2){La2[0], La2[1]} * xj2;
      X5 -= (f32x2){La2[2], La2[3]} * xj2;
      X6 -= (f32x2){La3[0], La3[1]} * xj2;
      X7 -= (f32x2){La3[2], La3[3]} * xj2;
      X8 -= (f32x2){La4[0], La4[1]} * xj2;
      X9 -= (f32x2){La4[2], La4[3]} * xj2;
      X10 -= (f32x2){La5[0], La5[1]} * xj2;
      X11 -= (f32x2){La5[2], La5[3]} * xj2;
      X12 -= (f32x2){La6[0], La6[1]} * xj2;
      X13 -= (f32x2){La6[2], La6[3]} * xj2;
      X14 -= (f32x2){La7[0], La7[1]} * xj2;
      X15 -= (f32x2){La7[2], La7[3]} * xj2;
    }
    __builtin_amdgcn_sched_barrier(0);
    La1 = *(const f32x4*)(Lt_s + 412);
    La2 = *(const f32x4*)(Lt_s + 416);
    La3 = *(const f32x4*)(Lt_s + 420);
    La4 = *(const f32x4*)(Lt_s + 424);
    La5 = *(const f32x4*)(Lt_s + 428);
    La6 = *(const f32x4*)(Lt_s + 432);
    La7 = *(const f32x4*)(Lt_s + 436);
    __builtin_amdgcn_sched_barrier(0);
    { const float xj = X2[1]; const f32x2 xj2 = (f32x2){xj, xj};
      X3 -= (f32x2){Lb1[2], Lb1[3]} * xj2;
      X4 -= (f32x2){Lb2[0], Lb2[1]} * xj2;
      X5 -= (f32x2){Lb2[2], Lb2[3]} * xj2;
      X6 -= (f32x2){Lb3[0], Lb3[1]} * xj2;
      X7 -= (f32x2){Lb3[2], Lb3[3]} * xj2;
      X8 -= (f32x2){Lb4[0], Lb4[1]} * xj2;
      X9 -= (f32x2){Lb4[2], Lb4[3]} * xj2;
      X10 -= (f32x2){Lb5[0], Lb5[1]} * xj2;
      X11 -= (f32x2){Lb5[2], Lb5[3]} * xj2;
      X12 -= (f32x2){Lb6[0], Lb6[1]} * xj2;
      X13 -= (f32x2){Lb6[2], Lb6[3]} * xj2;
      X14 -= (f32x2){Lb7[0], Lb7[1]} * xj2;
      X15 -= (f32x2){Lb7[2], Lb7[3]} * xj2;
    }
    __builtin_amdgcn_sched_barrier(0);
    Lb2 = *(const f32x4*)(Lt_s + 484);
    Lb3 = *(const f32x4*)(Lt_s + 488);
    Lb4 = *(const f32x4*)(Lt_s + 492);
    Lb5 = *(const f32x4*)(Lt_s + 496);
    Lb6 = *(const f32x4*)(Lt_s + 500);
    Lb7 = *(const f32x4*)(Lt_s + 504);
    __builtin_amdgcn_sched_barrier(0);
    { const float xj = X3[0]; const f32x2 xj2 = (f32x2){xj, xj};
      X3 -= (f32x2){La1[2], La1[3]} * xj2;
      X4 -= (f32x2){La2[0], La2[1]} * xj2;
      X5 -= (f32x2){La2[2], La2[3]} * xj2;
      X6 -= (f32x2){La3[0], La3[1]} * xj2;
      X7 -= (f32x2){La3[2], La3[3]} * xj2;
      X8 -= (f32x2){La4[0], La4[1]} * xj2;
      X9 -= (f32x2){La4[2], La4[3]} * xj2;
      X10 -= (f32x2){La5[0], La5[1]} * xj2;
      X11 -= (f32x2){La5[2], La5[3]} * xj2;
      X12 -= (f32x2){La6[0], La6[1]} * xj2;
      X13 -= (f32x2){La6[2], La6[3]} * xj2;
      X14 -= (f32x2){La7[0], La7[1]} * xj2;
      X15 -= (f32x2){La7[2], La7[3]} * xj2;
    }
    __builtin_amdgcn_sched_barrier(0);
    La2 = *(const f32x4*)(Lt_s + 552);
    La3 = *(const f32x4*)(Lt_s + 556);
    La4 = *(const f32x4*)(Lt_s + 560);
    La5 = *(const f32x4*)(Lt_s + 564);
    La6 = *(const f32x4*)(Lt_s + 568);
    La7 = *(const f32x4*)(Lt_s + 572);
    __builtin_amdgcn_sched_barrier(0);
    { const float xj = X3[1]; const f32x2 xj2 = (f32x2){xj, xj};
      X4 -= (f32x2){Lb2[0], Lb2[1]} * xj2;
      X5 -= (f32x2){Lb2[2], Lb2[3]} * xj2;
      X6 -= (f32x2){Lb3[0], Lb3[1]} * xj2;
      X7 -= (f32x2){Lb3[2], Lb3[3]} * xj2;
      X8 -= (f32x2){Lb4[0], Lb4[1]} * xj2;
      X9 -= (f32x2){Lb4[2], Lb4[3]} * xj2;
      X10 -= (f32x2){Lb5[0], Lb5[1]} * xj2;
      X11 -= (f32x2){Lb5[2], Lb5[3]} * xj2;
      X12 -= (f32x2){Lb6[0], Lb6[1]} * xj2;
      X13 -= (f32x2){Lb6[2], Lb6[3]} * xj2;
      X14 -= (f32x2){Lb7[0], Lb7[1]} * xj2;
      X15 -= (f32x2){Lb7[2], Lb7[3]} * xj2;
    }
    __builtin_amdgcn_sched_barrier(0);
    Lb2 = *(const f32x4*)(Lt_s + 620);
    Lb3 = *(const f32x4*)(Lt_s + 624);
    Lb4 = *(const f32x4*)(Lt_s + 628);
    Lb5 = *(const f32x4*)(Lt_s + 632);
    Lb6 = *(const f32x4*)(Lt_s + 636);
    Lb7 = *(const f32x4*)(Lt_s + 640);
    __builtin_amdgcn_sched_barrier(0);
    { const float xj = X4[0]; const f32x2 xj2 = (f32x2){xj, xj};
      X4 -= (f32x2){La2[0], La2[1]} * xj2;
      X5 -= (f32x2){La2[2], La2[3]} * xj2;
      X6 -= (f32x2){La3[0], La3[1]} * xj2;
      X7 -= (f32x2){La3[2], La3[3]} * xj2;
      X8 -= (f32x2){La4[0], La4[1]} * xj2;
      X9 -= (f32x2){La4[2], La4[3]} * xj2;
      X10 -= (f32x2){La5[0], La5[1]} * xj2;
      X11 -= (f32x2){La5[2], La5[3]} * xj2;
      X12 -= (f32x2){La6[0], La6[1]} * xj2;
      X13 -= (f32x2){La6[2], La6[3]} * xj2;
      X14 -= (f32x2){La7[0], La7[1]} * xj2;
      X15 -= (f32x2){La7[2], La7[3]} * xj2;
    }
    __builtin_amdgcn_sched_barrier(0);
    La2 = *(const f32x4*)(Lt_s + 688);
    La3 = *(const f32x4*)(Lt_s + 692);
    La4 = *(const f32x4*)(Lt_s + 696);
    La5 = *(const f32x4*)(Lt_s + 700);
    La6 = *(const f32x4*)(Lt_s + 704);
    La7 = *(const f32x4*)(Lt_s + 708);
    __builtin_amdgcn_sched_barrier(0);
    { const float xj = X4[1]; const f32x2 xj2 = (f32x2){xj, xj};
      X5 -= (f32x2){Lb2[2], Lb2[3]} * xj2;
      X6 -= (f32x2){Lb3[0], Lb3[1]} * xj2;
      X7 -= (f32x2){Lb3[2], Lb3[3]} * xj2;
      X8 -= (f32x2){Lb4[0], Lb4[1]} * xj2;
      X9 -= (f32x2){Lb4[2], Lb4[3]} * xj2;
      X10 -= (f32x2){Lb5[0], Lb5[1]} * xj2;
      X11 -= (f32x2){Lb5[2], Lb5[3]} * xj2;
      X12 -= (f32x2){Lb6[0], Lb6[1]} * xj2;
      X13 -= (f32x2){Lb6[2], Lb6[3]} * xj2;
      X14 -= (f32x2){Lb7[0], Lb7[1]} * xj2;
      X15 -= (f32x2){Lb7[2], Lb7[3]} * xj2;
    }
    __builtin_amdgcn_sched_barrier(0);
    Lb3 = *(const f32x4*)(Lt_s + 760);
    Lb4 = *(const f32x4*)(Lt_s + 764);
    Lb5 = *(const f32x4*)(Lt_s + 768);
    Lb6 = *(const f32x4*)(Lt_s + 772);
    Lb7 = *(const f32x4*)(Lt_s + 776);
    __builtin_amdgcn_sched_barrier(0);
    { const float xj = X5[0]; const f32x2 xj2 = (f32x2){xj, xj};
      X5 -= (f32x2){La2[2], La2[3]} * xj2;
      X6 -= (f32x2){La3[0], La3[1]} * xj2;
      X7 -= (f32x2){La3[2], La3[3]} * xj2;
      X8 -= (f32x2){La4[0], La4[1]} * xj2;
      X9 -= (f32x2){La4[2], La4[3]} * xj2;
      X10 -= (f32x2){La5[0], La5[1]} * xj2;
      X11 -= (f32x2){La5[2], La5[3]} * xj2;
      X12 -= (f32x2){La6[0], La6[1]} * xj2;
      X13 -= (f32x2){La6[2], La6[3]} * xj2;
      X14 -= (f32x2){La7[0], La7[1]} * xj2;
      X15 -= (f32x2){La7[2], La7[3]} * xj2;
    }
    __builtin_amdgcn_sched_barrier(0);
    La3 = *(const f32x4*)(Lt_s + 828);
    La4 = *(const f32x4*)(Lt_s + 832);
    La5 = *(const f32x4*)(Lt_s + 836);
    La6 = *(const f32x4*)(Lt_s + 840);
    La7 = *(const f32x4*)(Lt_s + 844);
    __builtin_amdgcn_sched_barrier(0);
    { const float xj = X5[1]; const f32x2 xj2 = (f32x2){xj, xj};
      X6 -= (f32x2){Lb3[0], Lb3[1]} * xj2;
      X7 -= (f32x2){Lb3[2], Lb3[3]} * xj2;
      X8 -= (f32x2){Lb4[0], Lb4[1]} * xj2;
      X9 -= (f32x2){Lb4[2], Lb4[3]} * xj2;
      X10 -= (f32x2){Lb5[0], Lb5[1]} * xj2;
      X11 -= (f32x2){Lb5[2], Lb5[3]} * xj2;
      X12 -= (f32x2){Lb6[0], Lb6[1]} * xj2;
      X13 -= (f32x2){Lb6[2], Lb6[3]} * xj2;
      X14 -= (f32x2){Lb7[0], Lb7[1]} * xj2;
      X15 -= (f32x2){Lb7[2], Lb7[3]} * xj2;
    }
    __builtin_amdgcn_sched_barrier(0);
    Lb3 = *(const f32x4*)(Lt_s + 896);
    Lb4 = *(const f32x4*)(Lt_s + 900);
    Lb5 = *(const f32x4*)(Lt_s + 904);
    Lb6 = *(const f32x4*)(Lt_s + 908);
    Lb7 = *(const f32x4*)(Lt_s + 912);
    __builtin_amdgcn_sched_barrier(0);
    { const float xj = X6[0]; const f32x2 xj2 = (f32x2){xj, xj};
      X6 -= (f32x2){La3[0], La3[1]} * xj2;
      X7 -= (f32x2){La3[2], La3[3]} * xj2;
      X8 -= (f32x2){La4[0], La4[1]} * xj2;
      X9 -= (f32x2){La4[2], La4[3]} * xj2;
      X10 -= (f32x2){La5[0], La5[1]} * xj2;
      X11 -= (f32x2){La5[2], La5[3]} * xj2;
      X12 -= (f32x2){La6[0], La6[1]} * xj2;
      X13 -= (f32x2){La6[2], La6[3]} * xj2;
      X14 -= (f32x2){La7[0], La7[1]} * xj2;
      X15 -= (f32x2){La7[2], La7[3]} * xj2;
    }
    __builtin_amdgcn_sched_barrier(0);
    La3 = *(const f32x4*)(Lt_s + 964);
    La4 = *(const f32x4*)(Lt_s + 968);
    La5 = *(const f32x4*)(Lt_s + 972);
    La6 = *(const f32x4*)(Lt_s + 976);
    La7 = *(const f32x4*)(Lt_s + 980);
    __builtin_amdgcn_sched_barrier(0);
    { const float xj = X6[1]; const f32x2 xj2 = (f32x2){xj, xj};
      X7 -= (f32x2){Lb3[2], Lb3[3]} * xj2;
      X8 -= (f32x2){Lb4[0], Lb4[1]} * xj2;
      X9 -= (f32x2){Lb4[2], Lb4[3]} * xj2;
      X10 -= (f32x2){Lb5[0], Lb5[1]} * xj2;
      X11 -= (f32x2){Lb5[2], Lb5[3]} * xj2;
      X12 -= (f32x2){Lb6[0], Lb6[1]} * xj2;
      X13 -= (f32x2){Lb6[2], Lb6[3]} * xj2;
      X14 -= (f32x2){Lb7[0], Lb7[1]} * xj2;
      X15 -= (f32x2){Lb7[2], Lb7[3]} * xj2;
    }
    __builtin_amdgcn_sched_barrier(0);
    Lb4 = *(const f32x4*)(Lt_s + 1036);
    Lb5 = *(const f32x4*)(Lt_s + 1040);
    Lb6 = *(const f32x4*)(Lt_s + 1044);
    Lb7 = *(const f32x4*)(Lt_s + 1048);
    __builtin_amdgcn_sched_barrier(0);
    { const float xj = X7[0]; const f32x2 xj2 = (f32x2){xj, xj};
      X7 -= (f32x2){La3[2], La3[3]} * xj2;
      X8 -= (f32x2){La4[0], La4[1]} * xj2;
      X9 -= (f32x2){La4[2], La4[3]} * xj2;
      X10 -= (f32x2){La5[0], La5[1]} * xj2;
      X11 -= (f32x2){La5[2], La5[3]} * xj2;
      X12 -= (f32x2){La6[0], La6[1]} * xj2;
      X13 -= (f32x2){La6[2], La6[3]} * xj2;
      X14 -= (f32x2){La7[0], La7[1]} * xj2;
      X15 -= (f32x2){La7[2], La7[3]} * xj2;
    }
    __builtin_amdgcn_sched_barrier(0);
    La4 = *(const f32x4*)(Lt_s + 1104);
    La5 = *(const f32x4*)(Lt_s + 1108);
    La6 = *(const f32x4*)(Lt_s + 1112);
    La7 = *(const f32x4*)(Lt_s + 1116);
    __builtin_amdgcn_sched_barrier(0);
    { const float xj = X7[1]; const f32x2 xj2 = (f32x2){xj, xj};
      X8 -= (f32x2){Lb4[0], Lb4[1]} * xj2;
      X9 -= (f32x2){Lb4[2], Lb4[3]} * xj2;
      X10 -= (f32x2){Lb5[0], Lb5[1]} * xj2;
      X11 -= (f32x2){Lb5[2], Lb5[3]} * xj2;
      X12 -= (f32x2){Lb6[0], Lb6[1]} * xj2;
      X13 -= (f32x2){Lb6[2], Lb6[3]} * xj2;
      X14 -= (f32x2){Lb7[0], Lb7[1]} * xj2;
      X15 -= (f32x2){Lb7[2], Lb7[3]} * xj2;
    }
    __builtin_amdgcn_sched_barrier(0);
    Lb4 = *(const f32x4*)(Lt_s + 1172);
    Lb5 = *(const f32x4*)(Lt_s + 1176);
    Lb6 = *(const f32x4*)(Lt_s + 1180);
    Lb7 = *(const f32x4*)(Lt_s + 1184);
    __builtin_amdgcn_sched_barrier(0);
    { const float xj = X8[0]; const f32x2 xj2 = (f32x2){xj, xj};
      X8 -= (f32x2){La4[0], La4[1]} * xj2;
      X9 -= (f32x2){La4[2], La4[3]} * xj2;
      X10 -= (f32x2){La5[0], La5[1]} * xj2;
      X11 -= (f32x2){La5[2], La5[3]} * xj2;
      X12 -= (f32x2){La6[0], La6[1]} * xj2;
      X13 -= (f32x2){La6[2], La6[3]} * xj2;
      X14 -= (f32x2){La7[0], La7[1]} * xj2;
      X15 -= (f32x2){La7[2], La7[3]} * xj2;
    }
    __builtin_amdgcn_sched_barrier(0);
    La4 = *(const f32x4*)(Lt_s + 1240);
    La5 = *(const f32x4*)(Lt_s + 1244);
    La6 = *(const f32x4*)(Lt_s + 1248);
    La7 = *(const f32x4*)(Lt_s + 1252);
    __builtin_amdgcn_sched_barrier(0);
    { const float xj = X8[1]; const f32x2 xj2 = (f32x2){xj, xj};
      X9 -= (f32x2){Lb4[2], Lb4[3]} * xj2;
      X10 -= (f32x2){Lb5[0], Lb5[1]} * xj2;
      X11 -= (f32x2){Lb5[2], Lb5[3]} * xj2;
      X12 -= (f32x2){Lb6[0], Lb6[1]} * xj2;
      X13 -= (f32x2){Lb6[2], Lb6[3]} * xj2;
      X14 -= (f32x2){Lb7[0], Lb7[1]} * xj2;
      X15 -= (f32x2){Lb7[2], Lb7[3]} * xj2;
    }
    __builtin_amdgcn_sched_barrier(0);
    Lb5 = *(const f32x4*)(Lt_s + 1312);
    Lb6 = *(const f32x4*)(Lt_s + 1316);
    Lb7 = *(const f32x4*)(Lt_s + 1320);
    __builtin_amdgcn_sched_barrier(0);
    { const float xj = X9[0]; const f32x2 xj2 = (f32x2){xj, xj};
      X9 -= (f32x2){La4[2], La4[3]} * xj2;
      X10 -= (f32x2){La5[0], La5[1]} * xj2;
      X11 -= (f32x2){La5[2], La5[3]} * xj2;
      X12 -= (f32x2){La6[0], La6[1]} * xj2;
      X13 -= (f32x2){La6[2], La6[3]} * xj2;
      X14 -= (f32x2){La7[0], La7[1]} * xj2;
      X15 -= (f32x2){La7[2], La7[3]} * xj2;
    }
    __builtin_amdgcn_sched_barrier(0);
    La5 = *(const f32x4*)(Lt_s + 1380);
    La6 = *(const f32x4*)(Lt_s + 1384);
    La7 = *(const f32x4*)(Lt_s + 1388);
    __builtin_amdgcn_sched_barrier(0);
    { const float xj = X9[1]; const f32x2 xj2 = (f32x2){xj, xj};
      X10 -= (f32x2){Lb5[0], Lb5[1]} * xj2;
      X11 -= (f32x2){Lb5[2], Lb5[3]} * xj2;
      X12 -= (f32x2){Lb6[0], Lb6[1]} * xj2;
      X13 -= (f32x2){Lb6[2], Lb6[3]} * xj2;
      X14 -= (f32x2){Lb7[0], Lb7[1]} * xj2;
      X15 -= (f32x2){Lb7[2], Lb7[3]} * xj2;
    }
    __builtin_amdgcn_sched_barrier(0);
    Lb5 = *(const f32x4*)(Lt_s + 1448);
    Lb6 = *(const f32x4*)(Lt_s + 1452);
    Lb7 = *(const f32x4*)(Lt_s + 1456);
    __builtin_amdgcn_sched_barrier(0);
    { const float xj = X10[0]; const f32x2 xj2 = (f32x2){xj, xj};
      X10 -= (f32x2){La5[0], La5[1]} * xj2;
      X11 -= (f32x2){La5[2], La5[3]} * xj2;
      X12 -= (f32x2){La6[0], La6[1]} * xj2;
      X13 -= (f32x2){La6[2], La6[3]} * xj2;
      X14 -= (f32x2){La7[0], La7[1]} * xj2;
      X15 -= (f32x2){La7[2], La7[3]} * xj2;
    }
    __builtin_amdgcn_sched_barrier(0);
    La5 = *(const f32x4*)(Lt_s + 1516);
    La6 = *(const f32x4*)(Lt_s + 1520);
    La7 = *(const f32x4*)(Lt_s + 1524);
    __builtin_amdgcn_sched_barrier(0);
    { const float xj = X10[1]; const f32x2 xj2 = (f32x2){xj, xj};
      X11 -= (f32x2){Lb5[2], Lb5[3]} * xj2;
      X12 -= (f32x2){Lb6[0], Lb6[1]} * xj2;
      X13 -= (f32x2){Lb6[2], Lb6[3]} * xj2;
      X14 -= (f32x2){Lb7[0], Lb7[1]} * xj2;
      X15 -= (f32x2){Lb7[2], Lb7[3]} * xj2;
    }
    __builtin_amdgcn_sched_barrier(0);
    Lb6 = *(const f32x4*)(Lt_s + 1588);
    Lb7 = *(const f32x4*)(Lt_s + 1592);
    __builtin_amdgcn_sched_barrier(0);
    { const float xj = X11[0]; const f32x2 xj2 = (f32x2){xj, xj};
      X11 -= (f32x2){La5[2], La5[3]} * xj2;
      X12 -= (f32x2){La6[0], La6[1]} * xj2;
      X13 -= (f32x2){La6[2], La6[3]} * xj2;
      X14 -= (f32x2){La7[0], La7[1]} * xj2;
      X15 -= (f32x2){La7[2], La7[3]} * xj2;
    }
    __builtin_amdgcn_sched_barrier(0);
    La6 = *(const f32x4*)(Lt_s + 1656);
    La7 = *(const f32x4*)(Lt_s + 1660);
    __builtin_amdgcn_sched_barrier(0);
    { const float xj = X11[1]; const f32x2 xj2 = (f32x2){xj, xj};
      X12 -= (f32x2){Lb6[0], Lb6[1]} * xj2;
      X13 -= (f32x2){Lb6[2], Lb6[3]} * xj2;
      X14 -= (f32x2){Lb7[0], Lb7[1]} * xj2;
      X15 -= (f32x2){Lb7[2], Lb7[3]} * xj2;
    }
    __builtin_amdgcn_sched_barrier(0);
    Lb6 = *(const f32x4*)(Lt_s + 1724);
    Lb7 = *(const f32x4*)(Lt_s + 1728);
    __builtin_amdgcn_sched_barrier(0);
    { const float xj = X12[0]; const f32x2 xj2 = (f32x2){xj, xj};
      X12 -= (f32x2){La6[0], La6[1]} * xj2;
      X13 -= (f32x2){La6[2], La6[3]} * xj2;
      X14 -= (f32x2){La7[0], La7[1]} * xj2;
      X15 -= (f32x2){La7[2], La7[3]} * xj2;
    }
    __builtin_amdgcn_sched_barrier(0);
    La6 = *(const f32x4*)(Lt_s + 1792);
    La7 = *(const f32x4*)(Lt_s + 1796);
    __builtin_amdgcn_sched_barrier(0);
    { const float xj = X12[1]; const f32x2 xj2 = (f32x2){xj, xj};
      X13 -= (f32x2){Lb6[2], Lb6[3]} * xj2;
      X14 -= (f32x2){Lb7[0], Lb7[1]} * xj2;
      X15 -= (f32x2){Lb7[2], Lb7[3]} * xj2;
    }
    __builtin_amdgcn_sched_barrier(0);
    Lb7 = *(const f32x4*)(Lt_s + 1864);
    __builtin_amdgcn_sched_barrier(0);
    { const float xj = X13[0]; const f32x2 xj2 = (f32x2){xj, xj};
      X13 -= (f32x2){La6[2], La6[3]} * xj2;
      X14 -= (f32x2){La7[0], La7[1]} * xj2;
      X15 -= (f32x2){La7[2], La7[3]} * xj2;
    }
    __builtin_amdgcn_sched_barrier(0);
    La7 = *(const f32x4*)(Lt_s + 1932);
    __builtin_amdgcn_sched_barrier(0);
    { const float xj = X13[1]; const f32x2 xj2 = (f32x2){xj, xj};
      X14 -= (f32x2){Lb7[0], Lb7[1]} * xj2;
      X15 -= (f32x2){Lb7[2], Lb7[3]} * xj2;
    }
    __builtin_amdgcn_sched_barrier(0);
    Lb7 = *(const f32x4*)(Lt_s + 2000);
    __builtin_amdgcn_sched_barrier(0);
    { const float xj = X14[0]; const f32x2 xj2 = (f32x2){xj, xj};
      X14 -= (f32x2){La7[0], La7[1]} * xj2;
      X15 -= (f32x2){La7[2], La7[3]} * xj2;
    }
    __builtin_amdgcn_sched_barrier(0);
    La7 = *(const f32x4*)(Lt_s + 2068);
    __builtin_amdgcn_sched_barrier(0);
    { const float xj = X14[1]; const f32x2 xj2 = (f32x2){xj, xj};
      X15 -= (f32x2){Lb7[2], Lb7[3]} * xj2;
    }
    __builtin_amdgcn_sched_barrier(0);
    __builtin_amdgcn_sched_barrier(0);
    { const float xj = X15[0]; const f32x2 xj2 = (f32x2){xj, xj};
      X15 -= (f32x2){La7[2], La7[3]} * xj2;
    }
    __builtin_amdgcn_sched_barrier(0);
    {
        bf16_t* xr = XT_s + tid * 32;
        { u32x4 o = {pack2(X0[0], X0[1]), pack2(X1[0], X1[1]), pack2(X2[0], X2[1]), pack2(X3[0], X3[1])}; *(u32x4*)(xr + 0) = o; }
        { u32x4 o = {pack2(X4[0], X4[1]), pack2(X5[0], X5[1]), pack2(X6[0], X6[1]), pack2(X7[0], X7[1])}; *(u32x4*)(xr + 8) = o; }
        { u32x4 o = {pack2(X8[0], X8[1]), pack2(X9[0], X9[1]), pack2(X10[0], X10[1]), pack2(X11[0], X11[1])}; *(u32x4*)(xr + 16) = o; }
        { u32x4 o = {pack2(X12[0], X12[1]), pack2(X13[0], X13[1]), pack2(X14[0], X14[1]), pack2(X15[0], X15[1])}; *(u32x4*)(xr + 24) = o; }
        bf16x8 lb0 = *(const bf16x8*)(Lb_s + (0 + l15) * 40 + quad * 8), lb1 = *(const bf16x8*)(Lb_s + (16 + l15) * 40 + quad * 8);
        f32x4 d[4][2];
#pragma unroll
        for (int ct = 0; ct < 4; ++ct) {
            const bf16x8 xt = *(const bf16x8*)(XT_s + (wv * 64 + ct * 16 + l15) * 32 + quad * 8);
            d[ct][0] = mfma16(lb0, xt, (f32x4){0.f, 0.f, 0.f, 0.f}); d[ct][1] = mfma16(lb1, xt, (f32x4){0.f, 0.f, 0.f, 0.f});
        }
#pragma unroll
        for (int ct = 0; ct < 4; ++ct)
#pragma unroll
            for (int it = 0; it < 2; ++it) { u32x2 o; o.x = pack2(d[ct][it][0], d[ct][it][1]); o.y = pack2(d[ct][it][2], d[ct][it][3]);
                *(u32x2*)(XT_s + (wv * 64 + ct * 16 + l15) * 32 + it * 16 + quad * 4) = o; }
        { const u32x4 u = *(const u32x4*)(xr + 0);
          X16 -= (f32x2){lo16(u[0]), hi16(u[0])};
          X17 -= (f32x2){lo16(u[1]), hi16(u[1])};
          X18 -= (f32x2){lo16(u[2]), hi16(u[2])};
          X19 -= (f32x2){lo16(u[3]), hi16(u[3])};
        }
        { const u32x4 u = *(const u32x4*)(xr + 8);
          X20 -= (f32x2){lo16(u[0]), hi16(u[0])};
          X21 -= (f32x2){lo16(u[1]), hi16(u[1])};
          X22 -= (f32x2){lo16(u[2]), hi16(u[2])};
          X23 -= (f32x2){lo16(u[3]), hi16(u[3])};
        }
        { const u32x4 u = *(const u32x4*)(xr + 16);
          X24 -= (f32x2){lo16(u[0]), hi16(u[0])};
          X25 -= (f32x2){lo16(u[1]), hi16(u[1])};
          X26 -= (f32x2){lo16(u[2]), hi16(u[2])};
          X27 -= (f32x2){lo16(u[3]), hi16(u[3])};
        }
        { const u32x4 u = *(const u32x4*)(xr + 24);
          X28 -= (f32x2){lo16(u[0]), hi16(u[0])};
          X29 -= (f32x2){lo16(u[1]), hi16(u[1])};
          X30 -= (f32x2){lo16(u[2]), hi16(u[2])};
          X31 -= (f32x2){lo16(u[3]), hi16(u[3])};
        }
    }
    La8 = *(const f32x4*)(Lt_s + 2208);
    La9 = *(const f32x4*)(Lt_s + 2212);
    La10 = *(const f32x4*)(Lt_s + 2216);
    La11 = *(const f32x4*)(Lt_s + 2220);
    La12 = *(const f32x4*)(Lt_s + 2224);
    La13 = *(const f32x4*)(Lt_s + 2228);
    La14 = *(const f32x4*)(Lt_s + 2232);
    La15 = *(const f32x4*)(Lt_s + 2236);
    Lb8 = *(const f32x4*)(Lt_s + 2276);
    Lb9 = *(const f32x4*)(Lt_s + 2280);
    Lb10 = *(const f32x4*)(Lt_s + 2284);
    Lb11 = *(const f32x4*)(Lt_s + 2288);
    Lb12 = *(const f32x4*)(Lt_s + 2292);
    Lb13 = *(const f32x4*)(Lt_s + 2296);
    Lb14 = *(const f32x4*)(Lt_s + 2300);
    Lb15 = *(const f32x4*)(Lt_s + 2304);
    __builtin_amdgcn_sched_barrier(0);
    { const float xj = X16[0]; const f32x2 xj2 = (f32x2){xj, xj};
      X16 -= (f32x2){La8[0], La8[1]} * xj2;
      X17 -= (f32x2){La8[2], La8[3]} * xj2;
      X18 -= (f32x2){La9[0], La9[1]} * xj2;
      X19 -= (f32x2){La9[2], La9[3]} * xj2;
      X20 -= (f32x2){La10[0], La10[1]} * xj2;
      X21 -= (f32x2){La10[2], La10[3]} * xj2;
      X22 -= (f32x2){La11[0], La11[1]} * xj2;
      X23 -= (f32x2){La11[2], La11[3]} * xj2;
      X24 -= (f32x2){La12[0], La12[1]} * xj2;
      X25 -= (f32x2){La12[2], La12[3]} * xj2;
      X26 -= (f32x2){La13[0], La13[1]} * xj2;
      X27 -= (f32x2){La13[2], La13[3]} * xj2;
      X28 -= (f32x2){La14[0], La14[1]} * xj2;
      X29 -= (f32x2){La14[2], La14[3]} * xj2;
      X30 -= (f32x2){La15[0], La15[1]} * xj2;
      X31 -= (f32x2){La15[2], La15[3]} * xj2;
    }
    __builtin_amdgcn_sched_barrier(0);
    La8 = *(const f32x4*)(Lt_s + 2344);
    La9 = *(const f32x4*)(Lt_s + 2348);
    La10 = *(const f32x4*)(Lt_s + 2352);
    La11 = *(const f32x4*)(Lt_s + 2356);
    La12 = *(const f32x4*)(Lt_s + 2360);
    La13 = *(const f32x4*)(Lt_s + 2364);
    La14 = *(const f32x4*)(Lt_s + 2368);
    La15 = *(const f32x4*)(Lt_s + 2372);
    __builtin_amdgcn_sched_barrier(0);
    { const float xj = X16[1]; const f32x2 xj2 = (f32x2){xj, xj};
      X17 -= (f32x2){Lb8[2], Lb8[3]} * xj2;
      X18 -= (f32x2){Lb9[0], Lb9[1]} * xj2;
      X19 -= (f32x2){Lb9[2], Lb9[3]} * xj2;
      X20 -= (f32x2){Lb10[0], Lb10[1]} * xj2;
      X21 -= (f32x2){Lb10[2], Lb10[3]} * xj2;
      X22 -= (f32x2){Lb11[0], Lb11[1]} * xj2;
      X23 -= (f32x2){Lb11[2], Lb11[3]} * xj2;
      X24 -= (f32x2){Lb12[0], Lb12[1]} * xj2;
      X25 -= (f32x2){Lb12[2], Lb12[3]} * xj2;
      X26 -= (f32x2){Lb13[0], Lb13[1]} * xj2;
      X27 -= (f32x2){Lb13[2], Lb13[3]} * xj2;
      X28 -= (f32x2){Lb14[0], Lb14[1]} * xj2;
      X29 -= (f32x2){Lb14[2], Lb14[3]} * xj2;
      X30 -= (f32x2){Lb15[0], Lb15[1]} * xj2;
      X31 -= (f32x2){Lb15[2], Lb15[3]} * xj2;
    }
    __builtin_amdgcn_sched_barrier(0);
    Lb9 = *(const f32x4*)(Lt_s + 2416);
    Lb10 = *(const f32x4*)(Lt_s + 2420);
    Lb11 = *(const f32x4*)(Lt_s + 2424);
    Lb12 = *(const f32x4*)(Lt_s + 2428);
    Lb13 = *(const f32x4*)(Lt_s + 2432);
    Lb14 = *(const f32x4*)(Lt_s + 2436);
    Lb15 = *(const f32x4*)(Lt_s + 2440);
    __builtin_amdgcn_sched_barrier(0);
    { const float xj = X17[0]; const f32x2 xj2 = (f32x2){xj, xj};
      X17 -= (f32x2){La8[2], La8[3]} * xj2;
      X18 -= (f32x2){La9[0], La9[1]} * xj2;
      X19 -= (f32x2){La9[2], La9[3]} * xj2;
      X20 -= (f32x2){La10[0], La10[1]} * xj2;
      X21 -= (f32x2){La10[2], La10[3]} * xj2;
      X22 -= (f32x2){La11[0], La11[1]} * xj2;
      X23 -= (f32x2){La11[2], La11[3]} * xj2;
      X24 -= (f32x2){La12[0], La12[1]} * xj2;
      X25 -= (f32x2){La12[2], La12[3]} * xj2;
      X26 -= (f32x2){La13[0], La13[1]} * xj2;
      X27 -= (f32x2){La13[2], La13[3]} * xj2;
      X28 -= (f32x2){La14[0], La14[1]} * xj2;
      X29 -= (f32x2){La14[2], La14[3]} * xj2;
      X30 -= (f32x2){La15[0], La15[1]} * xj2;
      X31 -= (f32x2){La15[2], La15[3]} * xj2;
    }
    __builtin_amdgcn_sched_barrier(0);
    La9 = *(const f32x4*)(Lt_s + 2484);
    La10 = *(const f32x4*)(Lt_s + 2488);
    La11 = *(const f32x4*)(Lt_s + 2492);
    La12 = *(const f32x4*)(Lt_s + 2496);
    La13 = *(const f32x4*)(Lt_s + 2500);
    La14 = *(const f32x4*)(Lt_s + 2504);
    La15 = *(const f32x4*)(Lt_s + 2508);
    __builtin_amdgcn_sched_barrier(0);
    { const float xj = X17[1]; const f32x2 xj2 = (f32x2){xj, xj};
      X18 -= (f32x2){Lb9[0], Lb9[1]} * xj2;
      X19 -= (f32x2){Lb9[2], Lb9[3]} * xj2;
      X20 -= (f32x2){Lb10[0], Lb10[1]} * xj2;
      X21 -= (f32x2){Lb10[2], Lb10[3]} * xj2;
      X22 -= (f32x2){Lb11[0], Lb11[1]} * xj2;
      X23 -= (f32x2){Lb11[2], Lb11[3]} * xj2;
      X24 -= (f32x2){Lb12[0], Lb12[1]} * xj2;
      X25 -= (f32x2){Lb12[2], Lb12[3]} * xj2;
      X26 -= (f32x2){Lb13[0], Lb13[1]} * xj2;
      X27 -= (f32x2){Lb13[2], Lb13[3]} * xj2;
      X28 -= (f32x2){Lb14[0], Lb14[1]} * xj2;
      X29 -= (f32x2){Lb14[2], Lb14[3]} * xj2;
      X30 -= (f32x2){Lb15[0], Lb15[1]} * xj2;
      X31 -= (f32x2){Lb15[2], Lb15[3]} * xj2;
    }
    __builtin_amdgcn_sched_barrier(0);
    Lb9 = *(const f32x4*)(Lt_s + 2552);
    Lb10 = *(const f32x4*)(Lt_s + 2556);
    Lb11 = *(const f32x4*)(Lt_s + 2560);
    Lb12 = *(const f32x4*)(Lt_s + 2564);
    Lb13 = *(const f32x4*)(Lt_s + 2568);
    Lb14 = *(const f32x4*)(Lt_s + 2572);
    Lb15 = *(const f32x4*)(Lt_s + 2576);
    __builtin_amdgcn_sched_barrier(0);
    { const float xj = X18[0]; const f32x2 xj2 = (f32x2){xj, xj};
      X18 -= (f32x2){La9[0], La9[1]} * xj2;
      X19 -= (f32x2){La9[2], La9[3]} * xj2;
      X20 -= (f32x2){La10[0], La10[1]} * xj2;
      X21 -= (f32x2){La10[2], La10[3]} * xj2;
      X22 -= (f32x2){La11[0], La11[1]} * xj2;
      X23 -= (f32x2){La11[2], La11[3]} * xj2;
      X24 -= (f32x2){La12[0], La12[1]} * xj2;
      X25 -= (f32x2){La12[2], La12[3]} * xj2;
      X26 -= (f32x2){La13[0], La13[1]} * xj2;
      X27 -= (f32x2){La13[2], La13[3]} * xj2;
      X28 -= (f32x2){La14[0], La14[1]} * xj2;
      X29 -= (f32x2){La14[2], La14[3]} * xj2;
      X30 -= (f32x2){La15[0], La15[1]} * xj2;
      X31 -= (f32x2){La15[2], La15[3]} * xj2;
    }
    __builtin_amdgcn_sched_barrier(0);
    La9 = *(const f32x4*)(Lt_s + 2620);
    La10 = *(const f32x4*)(Lt_s + 2624);
    La11 = *(const f32x4*)(Lt_s + 2628);
    La12 = *(const f32x4*)(Lt_s + 2632);
    La13 = *(const f32x4*)(Lt_s + 2636);
    La14 = *(const f32x4*)(Lt_s + 2640);
    La15 = *(const f32x4*)(Lt_s + 2644);
    __builtin_amdgcn_sched_barrier(0);
    { const float xj = X18[1]; const f32x2 xj2 = (f32x2){xj, xj};
      X19 -= (f32x2){Lb9[2], Lb9[3]} * xj2;
      X20 -= (f32x2){Lb10[0], Lb10[1]} * xj2;
      X21 -= (f32x2){Lb10[2], Lb10[3]} * xj2;
      X22 -= (f32x2){Lb11[0], Lb11[1]} * xj2;
      X23 -= (f32x2){Lb11[2], Lb11[3]} * xj2;
      X24 -= (f32x2){Lb12[0], Lb12[1]} * xj2;
      X25 -= (f32x2){Lb12[2], Lb12[3]} * xj2;
      X26 -= (f32x2){Lb13[0], Lb13[1]} * xj2;
      X27 -= (f32x2){Lb13[2], Lb13[3]} * xj2;
      X28 -= (f32x2){Lb14[0], Lb14[1]} * xj2;
      X29 -= (f32x2){Lb14[2], Lb14[3]} * xj2;
      X30 -= (f32x2){Lb15[0], Lb15[1]} * xj2;
      X31 -= (f32x2){Lb15[2], Lb15[3]} * xj2;
    }
    __builtin_amdgcn_sched_barrier(0);
    Lb10 = *(const f32x4*)(Lt_s + 2692);
    Lb11 = *(const f32x4*)(Lt_s + 2696);
    Lb12 = *(const f32x4*)(Lt_s + 2700);
    Lb13 = *(const f32x4*)(Lt_s + 2704);
    Lb14 = *(const f32x4*)(Lt_s + 2708);
    Lb15 = *(const f32x4*)(Lt_s + 2712);
    __builtin_amdgcn_sched_barrier(0);
    { const float xj = X19[0]; const f32x2 xj2 = (f32x2){xj, xj};
      X19 -= (f32x2){La9[2], La9[3]} * xj2;
      X20 -= (f32x2){La10[0], La10[1]} * xj2;
      X21 -= (f32x2){La10[2], La10[3]} * xj2;
      X22 -= (f32x2){La11[0], La11[1]} * xj2;
      X23 -= (f32x2){La11[2], La11[3]} * xj2;
      X24 -= (f32x2){La12[0], La12[1]} * xj2;
      X25 -= (f32x2){La12[2], La12[3]} * xj2;
      X26 -= (f32x2){La13[0], La13[1]} * xj2;
      X27 -= (f32x2){La13[2], La13[3]} * xj2;
      X28 -= (f32x2){La14[0], La14[1]} * xj2;
      X29 -= (f32x2){La14[2], La14[3]} * xj2;
      X30 -= (f32x2){La15[0], La15[1]} * xj2;
      X31 -= (f32x2){La15[2], La15[3]} * xj2;
    }
    __builtin_amdgcn_sched_barrier(0);
    La10 = *(const f32x4*)(Lt_s + 2760);
    La11 = *(const f32x4*)(Lt_s + 2764);
    La12 = *(const f32x4*)(Lt_s + 2768);
    La13 = *(const f32x4*)(Lt_s + 2772);
    La14 = *(const f32x4*)(Lt_s + 2776);
    La15 = *(const f32x4*)(Lt_s + 2780);
    __builtin_amdgcn_sched_barrier(0);
    { const float xj = X19[1]; const f32x2 xj2 = (f32x2){xj, xj};
      X20 -= (f32x2){Lb10[0], Lb10[1]} * xj2;
      X21 -= (f32x2){Lb10[2], Lb10[3]} * xj2;
      X22 -= (f32x2){Lb11[0], Lb11[1]} * xj2;
      X23 -= (f32x2){Lb11[2], Lb11[3]} * xj2;
      X24 -= (f32x2){Lb12[0], Lb12[1]} * xj2;
      X25 -= (f32x2){Lb12[2], Lb12[3]} * xj2;
      X26 -= (f32x2){Lb13[0], Lb13[1]} * xj2;
      X27 -= (f32x2){Lb13[2], Lb13[3]} * xj2;
      X28 -= (f32x2){Lb14[0], Lb14[1]} * xj2;
      X29 -= (f32x2){Lb14[2], Lb14[3]} * xj2;
      X30 -= (f32x2){Lb15[0], Lb15[1]} * xj2;
      X31 -= (f32x2){Lb15[2], Lb15[3]} * xj2;
    }
    __builtin_amdgcn_sched_barrier(0);
    Lb10 = *(const f32x4*)(Lt_s + 2828);
    Lb11 = *(const f32x4*)(Lt_s + 2832);
    Lb12 = *(const f32x4*)(Lt_s + 2836);
    Lb13 = *(const f32x4*)(Lt_s + 2840);
    Lb14 = *(const f32x4*)(Lt_s + 2844);
    Lb15 = *(const f32x4*)(Lt_s + 2848);
    __builtin_amdgcn_sched_barrier(0);
    { const float xj = X20[0]; const f32x2 xj2 = (f32x2){xj, xj};
      X20 -= (f32x2){La10[0], La10[1]} * xj2;
      X21 -= (f32x2){La10[2], La10[3]} * xj2;
      X22 -= (f32x2){La11[0], La11[1]} * xj2;
      X23 -= (f32x2){La11[2], La11[3]} * xj2;
      X24 -= (f32x2){La12[0], La12[1]} * xj2;
      X25 -= (f32x2){La12[2], La12[3]} * xj2;
      X26 -= (f32x2){La13[0], La13[1]} * xj2;
      X27 -= (f32x2){La13[2], La13[3]} * xj2;
      X28 -= (f32x2){La14[0], La14[1]} * xj2;
      X29 -= (f32x2){La14[2], La14[3]} * xj2;
      X30 -= (f32x2){La15[0], La15[1]} * xj2;
      X31 -= (f32x2){La15[2], La15[3]} * xj2;
    }
    __builtin_amdgcn_sched_barrier(0);
    La10 = *(const f32x4*)(Lt_s + 2896);
    La11 = *(const f32x4*)(Lt_s + 2900);
    La12 = *(const f32x4*)(Lt_s + 2904);
    La13 = *(const f32x4*)(Lt_s + 2908);
    La14 = *(const f32x4*)(Lt_s + 2912);
    La15 = *(const f32x4*)(Lt_s + 2916);
    __builtin_amdgcn_sched_barrier(0);
    { const float xj = X20[1]; const f32x2 xj2 = (f32x2){xj, xj};
      X21 -= (f32x2){Lb10[2], Lb10[3]} * xj2;
      X22 -= (f32x2){Lb11[0], Lb11[1]} * xj2;
      X23 -= (f32x2){Lb11[2], Lb11[3]} * xj2;
      X24 -= (f32x2){Lb12[0], Lb12[1]} * xj2;
      X25 -= (f32x2){Lb12[2], Lb12[3]} * xj2;
      X26 -= (f32x2){Lb13[0], Lb13[1]} * xj2;
      X27 -= (f32x2){Lb13[2], Lb13[3]} * xj2;
      X28 -= (f32x2){Lb14[0], Lb14[1]} * xj2;
      X29 -= (f32x2){Lb14[2], Lb14[3]} * xj2;
      X30 -= (f32x2){Lb15[0], Lb15[1]} * xj2;
      X31 -= (f32x2){Lb15[2], Lb15[3]} * xj2;
    }
    __builtin_amdgcn_sched_barrier(0);
    Lb11 = *(const f32x4*)(Lt_s + 2968);
    Lb12 = *(const f32x4*)(Lt_s + 2972);
    Lb13 = *(const f32x4*)(Lt_s + 2976);
    Lb14 = *(const f32x4*)(Lt_s + 2980);
    Lb15 = *(const f32x4*)(Lt_s + 2984);
    __builtin_amdgcn_sched_barrier(0);
    { const float xj = X21[0]; const f32x2 xj2 = (f32x2){xj, xj};
      X21 -= (f32x2){La10[2], La10[3]} * xj2;
      X22 -= (f32x2){La11[0], La11[1]} * xj2;
      X23 -= (f32x2){La11[2], La11[3]} * xj2;
      X24 -= (f32x2){La12[0], La12[1]} * xj2;
      X25 -= (f32x2){La12[2], La12[3]} * xj2;
      X26 -= (f32x2){La13[0], La13[1]} * xj2;
      X27 -= (f32x2){La13[2], La13[3]} * xj2;
      X28 -= (f32x2){La14[0], La14[1]} * xj2;
      X29 -= (f32x2){La14[2], La14[3]} * xj2;
      X30 -= (f32x2){La15[0], La15[1]} * xj2;
      X31 -= (f32x2){La15[2], La15[3]} * xj2;
    }
    __builtin_amdgcn_sched_barrier(0);
    La11 = *(const f32x4*)(Lt_s + 3036);
    La12 = *(const f32x4*)(Lt_s + 3040);
    La13 = *(const f32x4*)(Lt_s + 3044);
    La14 = *(const f32x4*)(Lt_s + 3048);
    La15 = *(const f32x4*)(Lt_s + 3052);
    __builtin_amdgcn_sched_barrier(0);
    { const float xj = X21[1]; const f32x2 xj2 = (f32x2){xj, xj};
      X22 -= (f32x2){Lb11[0], Lb11[1]} * xj2;
      X23 -= (f32x2){Lb11[2], Lb11[3]} * xj2;
      X24 -= (f32x2){Lb12[0], Lb12[1]} * xj2;
      X25 -= (f32x2){Lb12[2], Lb12[3]} * xj2;
      X26 -= (f32x2){Lb13[0], Lb13[1]} * xj2;
      X27 -= (f32x2){Lb13[2], Lb13[3]} * xj2;
      X28 -= (f32x2){Lb14[0], Lb14[1]} * xj2;
      X29 -= (f32x2){Lb14[2], Lb14[3]} * xj2;
      X30 -= (f32x2){Lb15[0], Lb15[1]} * xj2;
      X31 -= (f32x2){Lb15[2], Lb15[3]} * xj2;
    }
    __builtin_amdgcn_sched_barrier(0);
    Lb11 = *(const f32x4*)(Lt_s + 3104);
    Lb12 = *(const f32x4*)(Lt_s + 3108);
    Lb13 = *(const f32x4*)(Lt_s + 3112);
    Lb14 = *(const f32x4*)(Lt_s + 3116);
    Lb15 = *(const f32x4*)(Lt_s + 3120);
    __builtin_amdgcn_sched_barrier(0);
    { const float xj = X22[0]; const f32x2 xj2 = (f32x2){xj, xj};
      X22 -= (f32x2){La11[0], La11[1]} * xj2;
      X23 -= (f32x2){La11[2], La11[3]} * xj2;
      X24 -= (f32x2){La12[0], La12[1]} * xj2;
      X25 -= (f32x2){La12[2], La12[3]} * xj2;
      X26 -= (f32x2){La13[0], La13[1]} * xj2;
      X27 -= (f32x2){La13[2], La13[3]} * xj2;
      X28 -= (f32x2){La14[0], La14[1]} * xj2;
      X29 -= (f32x2){La14[2], La14[3]} * xj2;
      X30 -= (f32x2){La15[0], La15[1]} * xj2;
      X31 -= (f32x2){La15[2], La15[3]} * xj2;
    }
    __builtin_amdgcn_sched_barrier(0);
    La11 = *(const f32x4*)(Lt_s + 3172);
    La12 = *(const f32x4*)(Lt_s + 3176);
    La13 = *(const f32x4*)(Lt_s + 3180);
    La14 = *(const f32x4*)(Lt_s + 3184);
    La15 = *(const f32x4*)(Lt_s + 3188);
    __builtin_amdgcn_sched_barrier(0);
    { const float xj = X22[1]; const f32x2 xj2 = (f32x2){xj, xj};
      X23 -= (f32x2){Lb11[2], Lb11[3]} * xj2;
      X24 -= (f32x2){Lb12[0], Lb12[1]} * xj2;
      X25 -= (f32x2){Lb12[2], Lb12[3]} * xj2;
      X26 -= (f32x2){Lb13[0], Lb13[1]} * xj2;
      X27 -= (f32x2){Lb13[2], Lb13[3]} * xj2;
      X28 -= (f32x2){Lb14[0], Lb14[1]} * xj2;
      X29 -= (f32x2){Lb14[2], Lb14[3]} * xj2;
      X30 -= (f32x2){Lb15[0], Lb15[1]} * xj2;
      X31 -= (f32x2){Lb15[2], Lb15[3]} * xj2;
    }
    __builtin_amdgcn_sched_barrier(0);
    Lb12 = *(const f32x4*)(Lt_s + 3244);
    Lb13 = *(const f32x4*)(Lt_s + 3248);
    Lb14 = *(const f32x4*)(Lt_s + 3252);
    Lb15 = *(const f32x4*)(Lt_s + 3256);
    __builtin_amdgcn_sched_barrier(0);
    { const float xj = X23[0]; const f32x2 xj2 = (f32x2){xj, xj};
      X23 -= (f32x2){La11[2], La11[3]} * xj2;
      X24 -= (f32x2){La12[0], La12[1]} * xj2;
      X25 -= (f32x2){La12[2], La12[3]} * xj2;
      X26 -= (f32x2){La13[0], La13[1]} * xj2;
      X27 -= (f32x2){La13[2], La13[3]} * xj2;
      X28 -= (f32x2){La14[0], La14[1]} * xj2;
      X29 -= (f32x2){La14[2], La14[3]} * xj2;
      X30 -= (f32x2){La15[0], La15[1]} * xj2;
      X31 -= (f32x2){La15[2], La15[3]} * xj2;
    }
    __builtin_amdgcn_sched_barrier(0);
    La12 = *(const f32x4*)(Lt_s + 3312);
    La13 = *(const f32x4*)(Lt_s + 3316);
    La14 = *(const f32x4*)(Lt_s + 3320);
    La15 = *(const f32x4*)(Lt_s + 3324);
    __builtin_amdgcn_sched_barrier(0);
    { const float xj = X23[1]; const f32x2 xj2 = (f32x2){xj, xj};
      X24 -= (f32x2){Lb12[0], Lb12[1]} * xj2;
      X25 -= (f32x2){Lb12[2], Lb12[3]} * xj2;
      X26 -= (f32x2){Lb13[0], Lb13[1]} * xj2;
      X27 -= (f32x2){Lb13[2], Lb13[3]} * xj2;
      X28 -= (f32x2){Lb14[0], Lb14[1]} * xj2;
      X29 -= (f32x2){Lb14[2], Lb14[3]} * xj2;
      X30 -= (f32x2){Lb15[0], Lb15[1]} * xj2;
      X31 -= (f32x2){Lb15[2], Lb15[3]} * xj2;
    }
    __builtin_amdgcn_sched_barrier(0);
    Lb12 = *(const f32x4*)(Lt_s + 3380);
    Lb13 = *(const f32x4*)(Lt_s + 3384);
    Lb14 = *(const f32x4*)(Lt_s + 3388);
    Lb15 = *(const f32x4*)(Lt_s + 3392);
    __builtin_amdgcn_sched_barrier(0);
    { const float xj = X24[0]; const f32x2 xj2 = (f32x2){xj, xj};
      X24 -= (f32x2){La12[0], La12[1]} * xj2;
      X25 -= (f32x2){La12[2], La12[3]} * xj2;
      X26 -= (f32x2){La13[0], La13[1]} * xj2;
      X27 -= (f32x2){La13[2], La13[3]} * xj2;
      X28 -= (f32x2){La14[0], La14[1]} * xj2;
      X29 -= (f32x2){La14[2], La14[3]} * xj2;
      X30 -= (f32x2){La15[0], La15[1]} * xj2;
      X31 -= (f32x2){La15[2], La15[3]} * xj2;
    }
    __builtin_amdgcn_sched_barrier(0);
    La12 = *(const f32x4*)(Lt_s + 3448);
    La13 = *(const f32x4*)(Lt_s + 3452);
    La14 = *(const f32x4*)(Lt_s + 3456);
    La15 = *(const f32x4*)(Lt_s + 3460);
    __builtin_amdgcn_sched_barrier(0);
    { const float xj = X24[1]; const f32x2 xj2 = (f32x2){xj, xj};
      X25 -= (f32x2){Lb12[2], Lb12[3]} * xj2;
      X26 -= (f32x2){Lb13[0], Lb13[1]} * xj2;
      X27 -= (f32x2){Lb13[2], Lb13[3]} * xj2;
      X28 -= (f32x2){Lb14[0], Lb14[1]} * xj2;
      X29 -= (f32x2){Lb14[2], Lb14[3]} * xj2;
      X30 -= (f32x2){Lb15[0], Lb15[1]} * xj2;
      X31 -= (f32x2){Lb15[2], Lb15[3]} * xj2;
    }
    __builtin_amdgcn_sched_barrier(0);
    Lb13 = *(const f32x4*)(Lt_s + 3520);
    Lb14 = *(const f32x4*)(Lt_s + 3524);
    Lb15 = *(const f32x4*)(Lt_s + 3528);
    __builtin_amdgcn_sched_barrier(0);
    { const float xj = X25[0]; const f32x2 xj2 = (f32x2){xj, xj};
      X25 -= (f32x2){La12[2], La12[3]} * xj2;
      X26 -= (f32x2){La13[0], La13[1]} * xj2;
      X27 -= (f32x2){La13[2], La13[3]} * xj2;
      X28 -= (f32x2){La14[0], La14[1]} * xj2;
      X29 -= (f32x2){La14[2], La14[3]} * xj2;
      X30 -= (f32x2){La15[0], La15[1]} * xj2;
      X31 -= (f32x2){La15[2], La15[3]} * xj2;
    }
    __builtin_amdgcn_sched_barrier(0);
    La13 = *(const f32x4*)(Lt_s + 3588);
    La14 = *(const f32x4*)(Lt_s + 3592);
    La15 = *(const f32x4*)(Lt_s + 3596);
    __builtin_amdgcn_sched_barrier(0);
    { const float xj = X25[1]; const f32x2 xj2 = (f32x2){xj, xj};
      X26 -= (f32x2){Lb13[0], Lb13[1]} * xj2;
      X27 -= (f32x2){Lb13[2], Lb13[3]} * xj2;
      X28 -= (f32x2){Lb14[0], Lb14[1]} * xj2;
      X29 -= (f32x2){Lb14[2], Lb14[3]} * xj2;
      X30 -= (f32x2){Lb15[0], Lb15[1]} * xj2;
      X31 -= (f32x2){Lb15[2], Lb15[3]} * xj2;
    }
    __builtin_amdgcn_sched_barrier(0);
    Lb13 = *(const f32x4*)(Lt_s + 3656);
    Lb14 = *(const f32x4*)(Lt_s + 3660);
    Lb15 = *(const f32x4*)(Lt_s + 3664);
    __builtin_amdgcn_sched_barrier(0);
    { const float xj = X26[0]; const f32x2 xj2 = (f32x2){xj, xj};
      X26 -= (f32x2){La13[0], La13[1]} * xj2;
      X27 -= (f32x2){La13[2], La13[3]} * xj2;
      X28 -= (f32x2){La14[0], La14[1]} * xj2;
      X29 -= (f32x2){La14[2], La14[3]} * xj2;
      X30 -= (f32x2){La15[0], La15[1]} * xj2;
      X31 -= (f32x2){La15[2], La15[3]} * xj2;
    }
    __builtin_amdgcn_sched_barrier(0);
    La13 = *(const f32x4*)(Lt_s + 3724);
    La14 = *(const f32x4*)(Lt_s + 3728);
    La15 = *(const f32x4*)(Lt_s + 3732);
    __builtin_amdgcn_sched_barrier(0);
    { const float xj = X26[1]; const f32x2 xj2 = (f32x2){xj, xj};
      X27 -= (f32x2){Lb13[2], Lb13[3]} * xj2;
      X28 -= (f32x2){Lb14[0], Lb14[1]} * xj2;
      X29 -= (f32x2){Lb14[2], Lb14[3]} * xj2;
      X30 -= (f32x2){Lb15[0], Lb15[1]} * xj2;
      X31 -= (f32x2){Lb15[2], Lb15[3]} * xj2;
    }
    __builtin_amdgcn_sched_barrier(0);
    Lb14 = *(const f32x4*)(Lt_s + 3796);
    Lb15 = *(const f32x4*)(Lt_s + 3800);
    __builtin_amdgcn_sched_barrier(0);
    { const float xj = X27[0]; const f32x2 xj2 = (f32x2){xj, xj};
      X27 -= (f32x2){La13[2], La13[3]} * xj2;
      X28 -= (f32x2){La14[0], La14[1]} * xj2;
      X29 -= (f32x2){La14[2], La14[3]} * xj2;
      X30 -= (f32x2){La15[0], La15[1]} * xj2;
      X31 -= (f32x2){La15[2], La15[3]} * xj2;
    }
    __builtin_amdgcn_sched_barrier(0);
    La14 = *(const f32x4*)(Lt_s + 3864);
    La15 = *(const f32x4*)(Lt_s + 3868);
    __builtin_amdgcn_sched_barrier(0);
    { const float xj = X27[1]; const f32x2 xj2 = (f32x2){xj, xj};
      X28 -= (f32x2){Lb14[0], Lb14[1]} * xj2;
      X29 -= (f32x2){Lb14[2], Lb14[3]} * xj2;
      X30 -= (f32x2){Lb15[0], Lb15[1]} * xj2;
      X31 -= (f32x2){Lb15[2], Lb15[3]} * xj2;
    }
    __builtin_amdgcn_sched_barrier(0);
    Lb14 = *(const f32x4*)(Lt_s + 3932);
    Lb15 = *(const f32x4*)(Lt_s + 3936);
    __builtin_amdgcn_sched_barrier(0);
    { const float xj = X28[0]; const f32x2 xj2 = (f32x2){xj, xj};
      X28 -= (f32x2){La14[0], La14[1]} * xj2;
      X29 -= (f32x2){La14[2], La14[3]} * xj2;
      X30 -= (f32x2){La15[0], La15[1]} * xj2;
      X31 -= (f32x2){La15[2], La15[3]} * xj2;
    }
    __builtin_amdgcn_sched_barrier(0);
    La14 = *(const f32x4*)(Lt_s + 4000);
    La15 = *(const f32x4*)(Lt_s + 4004);
    __builtin_amdgcn_sched_barrier(0);
    { const float xj = X28[1]; const f32x2 xj2 = (f32x2){xj, xj};
      X29 -= (f32x2){Lb14[2], Lb14[3]} * xj2;
      X30 -= (f32x2){Lb15[0], Lb15[1]} * xj2;
      X31 -= (f32x2){Lb15[2], Lb15[3]} * xj2;
    }
    __builtin_amdgcn_sched_barrier(0);
    Lb15 = *(const f32x4*)(Lt_s + 4072);
    __builtin_amdgcn_sched_barrier(0);
    { const float xj = X29[0]; const f32x2 xj2 = (f32x2){xj, xj};
      X29 -= (f32x2){La14[2], La14[3]} * xj2;
      X30 -= (f32x2){La15[0], La15[1]} * xj2;
      X31 -= (f32x2){La15[2], La15[3]} * xj2;
    }
    __builtin_amdgcn_sched_barrier(0);
    La15 = *(const f32x4*)(Lt_s + 4140);
    __builtin_amdgcn_sched_barrier(0);
    { const float xj = X29[1]; const f32x2 xj2 = (f32x2){xj, xj};
      X30 -= (f32x2){Lb15[0], Lb15[1]} * xj2;
      X31 -= (f32x2){Lb15[2], Lb15[3]} * xj2;
    }
    __builtin_amdgcn_sched_barrier(0);
    Lb15 = *(const f32x4*)(Lt_s + 4208);
    __builtin_amdgcn_sched_barrier(0);
    { const float xj = X30[0]; const f32x2 xj2 = (f32x2){xj, xj};
      X30 -= (f32x2){La15[0], La15[1]} * xj2;
      X31 -= (f32x2){La15[2], La15[3]} * xj2;
    }
    __builtin_amdgcn_sched_barrier(0);
    La15 = *(const f32x4*)(Lt_s + 4276);
    __builtin_amdgcn_sched_barrier(0);
    { const float xj = X30[1]; const f32x2 xj2 = (f32x2){xj, xj};
      X31 -= (f32x2){Lb15[2], Lb15[3]} * xj2;
    }
    __builtin_amdgcn_sched_barrier(0);
    __builtin_amdgcn_sched_barrier(0);
    { const float xj = X31[0]; const f32x2 xj2 = (f32x2){xj, xj};
      X31 -= (f32x2){La15[2], La15[3]} * xj2;
    }
    __builtin_amdgcn_sched_barrier(0);
    __syncthreads();
    outp[0] = f2bf(sg * X0[0]);
    outp[136] = f2bf(sg * X0[1]);
    outp[272] = f2bf(sg * X1[0]);
    outp[408] = f2bf(sg * X1[1]);
    outp[544] = f2bf(sg * X2[0]);
    outp[680] = f2bf(sg * X2[1]);
    outp[816] = f2bf(sg * X3[0]);
    outp[952] = f2bf(sg * X3[1]);
    outp[1088] = f2bf(sg * X4[0]);
    outp[1224] = f2bf(sg * X4[1]);
    outp[1360] = f2bf(sg * X5[0]);
    outp[1496] = f2bf(sg * X5[1]);
    outp[1632] = f2bf(sg * X6[0]);
    outp[1768] = f2bf(sg * X6[1]);
    outp[1904] = f2bf(sg * X7[0]);
    outp[2040] = f2bf(sg * X7[1]);
    outp[2176] = f2bf(sg * X8[0]);
    outp[2312] = f2bf(sg * X8[1]);
    outp[2448] = f2bf(sg * X9[0]);
    outp[2584] = f2bf(sg * X9[1]);
    outp[2720] = f2bf(sg * X10[0]);
    outp[2856] = f2bf(sg * X10[1]);
    outp[2992] = f2bf(sg * X11[0]);
    outp[3128] = f2bf(sg * X11[1]);
    outp[3264] = f2bf(sg * X12[0]);
    outp[3400] = f2bf(sg * X12[1]);
    outp[3536] = f2bf(sg * X13[0]);
    outp[3672] = f2bf(sg * X13[1]);
    outp[3808] = f2bf(sg * X14[0]);
    outp[3944] = f2bf(sg * X14[1]);
    outp[4080] = f2bf(sg * X15[0]);
    outp[4216] = f2bf(sg * X15[1]);
    outp[4352] = f2bf(sg * X16[0]);
    outp[4488] = f2bf(sg * X16[1]);
    outp[4624] = f2bf(sg * X17[0]);
    outp[4760] = f2bf(sg * X17[1]);
    outp[4896] = f2bf(sg * X18[0]);
    outp[5032] = f2bf(sg * X18[1]);
    outp[5168] = f2bf(sg * X19[0]);
    outp[5304] = f2bf(sg * X19[1]);
    outp[5440] = f2bf(sg * X20[0]);
    outp[5576] = f2bf(sg * X20[1]);
    outp[5712] = f2bf(sg * X21[0]);
    outp[5848] = f2bf(sg * X21[1]);
    outp[5984] = f2bf(sg * X22[0]);
    outp[6120] = f2bf(sg * X22[1]);
    outp[6256] = f2bf(sg * X23[0]);
    outp[6392] = f2bf(sg * X23[1]);
    outp[6528] = f2bf(sg * X24[0]);
    outp[6664] = f2bf(sg * X24[1]);
    outp[6800] = f2bf(sg * X25[0]);
    outp[6936] = f2bf(sg * X25[1]);
    outp[7072] = f2bf(sg * X26[0]);
    outp[7208] = f2bf(sg * X26[1]);
    outp[7344] = f2bf(sg * X27[0]);
    outp[7480] = f2bf(sg * X27[1]);
    outp[7616] = f2bf(sg * X28[0]);
    outp[7752] = f2bf(sg * X28[1]);
    outp[7888] = f2bf(sg * X29[0]);
    outp[8024] = f2bf(sg * X29[1]);
    outp[8160] = f2bf(sg * X30[0]);
    outp[8296] = f2bf(sg * X30[1]);
    outp[8432] = f2bf(sg * X31[0]);
    outp[8568] = f2bf(sg * X31[1]);
}

DEV void dn_item(const Params& p, int l, int item, unsigned char* smem) {
    const int dir = item & 1, hh = (item >> 1) & 3, b = item >> 3;
    bf16_t* q_s = (bf16_t*)(smem);
    bf16_t* k_s = (bf16_t*)(smem + 17408);
    bf16_t* vnT_s = k_s;
    bf16_t* kT_s = (bf16_t*)(smem + 35840);
    bf16_t* v_s = (bf16_t*)(smem + 54272);
    bf16_t* u_s = v_s;
    float* L_s = (float*)(smem + 71680);
    bf16_t* w_s = (bf16_t*)(smem + 71680);
    bf16_t* qk_s = (bf16_t*)(smem + 89088);
    bf16_t* St_s = (bf16_t*)(smem + 98304);
    float* G_s = (float*)(smem + 133120);
    float* beta_s = G_s + 64;
    float* eG_s = G_s + 128;
    float* bw_s = G_s + 192;
    float* cw_s = G_s + 256;
    bf16_t* XT_s = k_s;
    bf16_t* Lb_s = (bf16_t*)(smem + 140288);
    const int tid = get_tid(), lane = tid & 63, wv = tid >> 6, l15 = lane & 15, quad = lane >> 4;
    const float Aneg = -expf(p.in[I_DNALOG][(l * 2 + dir) * 4 + hh]);
    const float dtb = p.in[I_DNDT][(l * 2 + dir) * 4 + hh];
    const bf16_t* P = wsb(p, O_P);
    const float* AB = wsf(p, O_AB);
    bf16_t* TO = wsb(p, dir ? O_TA2 : O_TA);
    __syncthreads();
    for (int e = tid; e < 4 * 384; e += 256) { int j = e / 384, c = e % 384, mat = c >> 7, cc = c & 127; cw_s[e] = p.in[I_DNCONV][((size_t)l * 4 + j) * 1536 + mat * 512 + hh * 128 + cc]; }
    for (int e = tid; e < 128 * 136 / 2; e += 256) ((unsigned*)St_s)[e] = 0u;
    f32x4 Sacc[2][8];
#pragma unroll
    for (int a = 0; a < 2; ++a)
#pragma unroll
        for (int c = 0; c < 8; ++c) Sacc[a][c] = (f32x4){0.f, 0.f, 0.f, 0.f};

    const int rg = tid >> 4, cseg = tid & 15, i0 = rg * 4;
    u32x4 raw[3][7];
    float pf_al = 0.f, pf_bb = 0.f;
#define DN_PREFETCH(NN, M0, M1) { \
        const int c_ = chunk_of(dir, (NN)); const int lo_ = c_ < 4 ? 0 : CTXL, hi_ = c_ < 4 ? CTXL : SB, base_ = c_ * 64; \
        const int slo_ = dir ? base_ + 60 - i0 : base_ + i0; \
        _Pragma("unroll") for (int u = 0; u < 7; ++u) { const int ss_ = slo_ - 1 + u; const bool ok_ = ss_ >= lo_ && ss_ < hi_; \
            const bf16_t* rp_ = P + ((size_t)b * SB + (ok_ ? ss_ : base_)) * PW + hh * 128 + cseg * 8; \
            _Pragma("unroll") for (int mat = (M0); mat < (M1); ++mat) { u32x4 t_ = *(const u32x4*)(rp_ + mat * 512); raw[mat][u] = ok_ ? t_ : (u32x4){0u, 0u, 0u, 0u}; } } \
        if ((M0) == 0) { const int sa_ = dir ? base_ + 63 - lane : base_ + lane; \
        pf_al = AB[((size_t)b * SB + sa_) * 16 + dir * 4 + hh]; pf_bb = AB[((size_t)b * SB + sa_) * 16 + 8 + dir * 4 + hh]; } }
    DN_PREFETCH(0, 0, 3);
    const int wv0_ = wv, l150_ = l15, quad0_ = quad, lane0_ = lane;

#pragma unroll 1
    for (int n = 0; n < 68; ++n) {
        int tz0 = 0; asm volatile("" : "+v"(tz0));
        const int wv = wv0_ + tz0, l15 = l150_ + tz0, quad = quad0_ + tz0, lane = lane0_ + tz0;
        const int c = chunk_of(dir, n);
        const int base = c * 64;
        __syncthreads();
        if (wv == 0) {
            float g = Aneg * softplus_fast(pf_al + dtb);
#pragma unroll
            for (int o = 1; o < 64; o <<= 1) { float t = __shfl_up(g, o); if (lane >= o) g += t; }
            const float eg_ = expf(g), bt_ = sigm(pf_bb); G_s[lane] = g; beta_s[lane] = bt_; eG_s[lane] = eg_; bw_s[lane] = bt_ * eg_;
        }
        __syncthreads();
        const float Glast = G_s[63];
        {
            int tz = 0; asm volatile("" : "+v"(tz));
            const int i0l = i0 + tz, csl = cseg + tz;
            float ksc[4];
#pragma unroll
            for (int m = 0; m < 4; ++m) ksc[m] = expf(Glast - G_s[i0l + m]);
#pragma unroll
            for (int mat = 0; mat < 3; ++mat) {
                float w[4][8];
#pragma unroll
                for (int j = 0; j < 4; ++j) { const f32x4 w0 = *(const f32x4*)(cw_s + j * 384 + mat * 128 + csl * 8), w1 = *(const f32x4*)(cw_s + j * 384 + mat * 128 + csl * 8 + 4);
#pragma unroll
                    for (int e = 0; e < 4; ++e) { w[j][e] = w0[e]; w[j][4 + e] = w1[e]; } }
                float v[4][8];
#pragma unroll
                for (int t = 0; t < 4; ++t)
#pragma unroll
                    for (int e = 0; e < 8; ++e) v[t][e] = 0.f;
#pragma unroll
                for (int u = 0; u < 7; ++u) {
                    float x[8];
#pragma unroll
                    for (int e = 0; e < 4; ++e) { x[2 * e] = lo16(raw[mat][u][e]); x[2 * e + 1] = hi16(raw[mat][u][e]); }
#pragma unroll
                    for (int t = 0; t < 4; ++t) { const int j = u - t; if (j >= 0 && j < 4) {
#pragma unroll
                        for (int e = 0; e < 8; ++e) v[t][e] += w[j][e] * x[e]; } }
                }
                float sc[4];
#pragma unroll
                for (int t = 0; t < 4; ++t) {
                    float ss2 = 0.f;
#pragma unroll
                    for (int e = 0; e < 8; ++e) { v[t][e] = silu(v[t][e]); ss2 += v[t][e] * v[t][e]; }
                    if (mat < 2) { ss2 += __shfl_xor(ss2, 1); ss2 += __shfl_xor(ss2, 2); ss2 += __shfl_xor(ss2, 4); ss2 += __shfl_xor(ss2, 8); }
                    sc[t] = mat == 0 ? rsqrtf(ss2 + 1e-6f) * 0.08838834764831845f : (mat == 1 ? rsqrtf(ss2 + 1e-6f) : 1.f);
                }
                bf16_t* dst = mat == 0 ? q_s : (mat == 1 ? k_s : v_s);
#pragma unroll
                for (int t = 0; t < 4; ++t) {
                    const int it_ = dir ? i0l + 3 - t : i0l + t;
                    u32x4 o;
#pragma unroll
                    for (int e = 0; e < 4; ++e) o[e] = pack2(v[t][2 * e] * sc[t], v[t][2 * e + 1] * sc[t]);
                    *(u32x4*)(dst + it_ * 136 + csl * 8) = o;
                }
                if (mat == 1) {
#pragma unroll
                    for (int e = 0; e < 8; ++e) {
                        const float k0 = v[dir ? 3 : 0][e] * sc[dir ? 3 : 0] * ksc[0], k1 = v[dir ? 2 : 1][e] * sc[dir ? 2 : 1] * ksc[1];
                        const float k2 = v[dir ? 1 : 2][e] * sc[dir ? 1 : 2] * ksc[2], k3 = v[dir ? 0 : 3][e] * sc[dir ? 0 : 3] * ksc[3];
                        u32x2 o; o.x = pack2(k0, k1); o.y = pack2(k2, k3);
                        *(u32x2*)(kT_s + (csl * 8 + e) * 72 + i0l) = o;
                    }
                }
            }
        }
        __syncthreads();
        {
            bf16x8 ak[4], aq[4];
#pragma unroll
            for (int ks = 0; ks < 4; ++ks) { ak[ks] = *(const bf16x8*)(k_s + (wv * 16 + l15) * 136 + ks * 32 + quad * 8); aq[ks] = *(const bf16x8*)(q_s + (wv * 16 + l15) * 136 + ks * 32 + quad * 8); }
#pragma unroll
            for (int nt = 0; nt < 4; ++nt) {
                f32x4 kk = {0.f, 0.f, 0.f, 0.f}, qq = {0.f, 0.f, 0.f, 0.f};
#pragma unroll
                for (int ks = 0; ks < 4; ++ks) { bf16x8 bk = *(const bf16x8*)(k_s + (nt * 16 + l15) * 136 + ks * 32 + quad * 8); kk = mfma16(ak[ks], bk, kk); qq = mfma16(aq[ks], bk, qq); }
                const int jj = nt * 16 + l15; const float Gj = G_s[jj];
                f32x4 lv;
#pragma unroll
                for (int j = 0; j < 4; ++j) {
                    const int i = wv * 16 + quad * 4 + j;
                    const float dec = jj <= i ? expf(G_s[i] - Gj) : 0.f;
                    lv[j] = jj < i ? beta_s[i] * kk[j] * dec : 0.f;
                    qk_s[i * 72 + jj] = f2bf(qq[j] * dec);
                }
                *(f32x4*)(L_s + jj * 68 + wv * 16 + quad * 4) = lv;
                if (wv >= 2 && nt < 2) {
#pragma unroll
                    for (int j = 0; j < 4; ++j) Lb_s[(wv * 16 - 32 + quad * 4 + j) * 40 + jj] = f2bf(lv[j]);
                }
            }
        }
        __syncthreads();
        dn_solve(L_s, tid < 128 ? (k_s + tid) : (v_s + (tid - 128)), tid < 128 ? bw_s : beta_s, tid < 128 ? -1.f : 1.f, tid < 128 ? (w_s + tid) : (u_s + (tid - 128)), XT_s, Lb_s, tid, wv, l15, quad);
        __syncthreads();
        {
            f32x4 vn[8], o1[8];
#pragma unroll
            for (int nt = 0; nt < 8; ++nt) {
#pragma unroll
                for (int j = 0; j < 4; ++j) vn[nt][j] = bf2f(u_s[(wv * 16 + quad * 4 + j) * 136 + nt * 16 + l15]);
                o1[nt] = (f32x4){0.f, 0.f, 0.f, 0.f};
            }
            bf16x8 aw[4], aq[4];
#pragma unroll
            for (int ks = 0; ks < 4; ++ks) { aw[ks] = *(const bf16x8*)(w_s + (wv * 16 + l15) * 136 + ks * 32 + quad * 8); aq[ks] = *(const bf16x8*)(q_s + (wv * 16 + l15) * 136 + ks * 32 + quad * 8); }
#pragma unroll
            for (int nt = 0; nt < 8; ++nt)
#pragma unroll
                for (int ks = 0; ks < 4; ++ks) { bf16x8 bs = *(const bf16x8*)(St_s + (nt * 16 + l15) * 136 + ks * 32 + quad * 8); vn[nt] = mfma16(aw[ks], bs, vn[nt]); o1[nt] = mfma16(aq[ks], bs, o1[nt]); }
#pragma unroll
            for (int nt = 0; nt < 8; ++nt) { u32x2 o; o.x = pack2(vn[nt][0], vn[nt][1]); o.y = pack2(vn[nt][2], vn[nt][3]); *(u32x2*)(vnT_s + (nt * 16 + l15) * 72 + wv * 16 + quad * 4) = o; }
            __syncthreads();
            if (n + 1 < 68) DN_PREFETCH(n + 1, 0, 2);
            float eg[4];
#pragma unroll
            for (int j = 0; j < 4; ++j) eg[j] = eG_s[wv * 16 + quad * 4 + j];
            bf16x8 aqk[2], akt[2][2];
#pragma unroll
            for (int ks = 0; ks < 2; ++ks) {
                aqk[ks] = *(const bf16x8*)(qk_s + (wv * 16 + l15) * 72 + ks * 32 + quad * 8);
                akt[0][ks] = *(const bf16x8*)(kT_s + (wv * 32 + l15) * 72 + ks * 32 + quad * 8);
                akt[1][ks] = *(const bf16x8*)(kT_s + (wv * 32 + 16 + l15) * 72 + ks * 32 + quad * 8);
            }
            const float gend = eG_s[63];
            const size_t orow0 = (size_t)b * SB;
#pragma unroll
            for (int nt = 0; nt < 8; ++nt) {
                f32x4 o;
#pragma unroll
                for (int j = 0; j < 4; ++j) { o[j] = o1[nt][j] * eg[j]; Sacc[0][nt][j] *= gend; Sacc[1][nt][j] *= gend; }
#pragma unroll
                for (int ks = 0; ks < 2; ++ks) {
                    bf16x8 bv = *(const bf16x8*)(vnT_s + (nt * 16 + l15) * 72 + ks * 32 + quad * 8);
                    o = mfma16(aqk[ks], bv, o);
                    Sacc[0][nt] = mfma16(akt[0][ks], bv, Sacc[0][nt]);
                    Sacc[1][nt] = mfma16(akt[1][ks], bv, Sacc[1][nt]);
                }
#pragma unroll
                for (int j = 0; j < 4; ++j) {
                    const int i = wv * 16 + quad * 4 + j;
                    const int s = dir ? base + 63 - i : base + i;
                    TO[(orow0 + s) * 512 + hh * 128 + nt * 16 + l15] = f2bf(o[j]);
                }
#pragma unroll
                for (int mt = 0; mt < 2; ++mt) { u32x2 sv; sv.x = pack2(Sacc[mt][nt][0], Sacc[mt][nt][1]); sv.y = pack2(Sacc[mt][nt][2], Sacc[mt][nt][3]);
                    *(u32x2*)(St_s + (nt * 16 + l15) * 136 + wv * 32 + mt * 16 + quad * 4) = sv; }
            }
        }
        if (n + 1 < 68) DN_PREFETCH(n + 1, 2, 3);
    }
}

#undef DN_PREFETCH
DEV void lru_item(const Params& p, int l, int item, unsigned char* smem) {
    const int g = item & 7, b = item >> 3;
    bf16_t* Wt_s = (bf16_t*)smem;
    bf16_t* xbh_s = Wt_s + 2 * 128 * 72;
    float* xbf_s = (float*)(smem + 36864 + 18432);
    float* a_s = xbf_s + 2 * 64 * 65;
    float* cw_s = a_s + 2 * 64 * 65;
    const int tid = get_tid(), lane = tid & 63, wv = tid >> 6, l15 = lane & 15, quad = lane >> 4;
    bf16_t* P = wsb(p, O_P);
    bf16_t* HF = wsb(p, O_U);
    __syncthreads();
    for (int e = tid; e < 320; e += 256) cw_s[e] = e < 256 ? p.in[I_LCW][((size_t)l * 4 + (e >> 6)) * 512 + g * 64 + (e & 63)] : p.in[I_LCB][l * 512 + g * 64 + (e - 256)];
    for (int e = tid; e < 2 * 4096; e += 256) {
        const int d = e >> 12, ch = (e >> 6) & 63, j = e & 63;
        const size_t wi_ = (((size_t)l * 2 + d) * 8 + g) * 4096 + ch * 64 + j;
        Wt_s[(d * 128 + j) * 72 + ch] = f2bf(p.in[I_LWA][wi_]);
        Wt_s[(d * 128 + 64 + j) * 72 + ch] = f2bf(p.in[I_LWI][wi_]);
    }
    float ba_[2][4], bi_[2][4], sp_[2][4];
#pragma unroll
    for (int d = 0; d < 2; ++d)
#pragma unroll
        for (int nt = 0; nt < 4; ++nt) {
            const int ch = (l * 2 + d) * 512 + g * 64 + nt * 16 + l15;
            ba_[d][nt] = p.in[I_LBA][ch]; bi_[d][nt] = p.in[I_LBI][ch]; sp_[d][nt] = softplus(-p.in[I_LLAM][ch]);
        }
    float hc = 0.f;
    const int i = tid >> 2, seg = tid & 3, j0 = seg * 16;
#pragma unroll 1
    for (int n = 0; n < 68; ++n) {
        const int cf = n, cb = chunk_of(1, n);
        __syncthreads();
#pragma unroll
        for (int d = 0; d < 2; ++d) {
            const int c = d ? cb : cf;
            const int seg_lo = c < 4 ? 0 : CTXL, seg_hi = c < 4 ? CTXL : SB;
            const int s = d ? c * 64 + 63 - i : c * 64 + i;
            float v[16];
#pragma unroll
            for (int e = 0; e < 16; ++e) v[e] = cw_s[256 + j0 + e];
#pragma unroll
            for (int j = 0; j < 4; ++j) {
                const int ss = s + j - 1;
                if (ss >= seg_lo && ss < seg_hi) {
                    const u32x4* src = (const u32x4*)(P + ((size_t)b * SB + ss) * PW + C_LX + g * 64 + j0);
                    const float* cw = cw_s + j * 64 + j0;
#pragma unroll
                    for (int q = 0; q < 2; ++q) { u32x4 x = src[q];
#pragma unroll
                        for (int e = 0; e < 4; ++e) { v[q * 8 + 2 * e] += cw[q * 8 + 2 * e] * lo16(x[e]); v[q * 8 + 2 * e + 1] += cw[q * 8 + 2 * e + 1] * hi16(x[e]); } }
                }
            }
            u32x4 h0, h1;
#pragma unroll
            for (int e = 0; e < 4; ++e) { h0[e] = pack2(v[2 * e], v[2 * e + 1]); h1[e] = pack2(v[8 + 2 * e], v[8 + 2 * e + 1]); }
            *(u32x4*)(xbh_s + (d * 64 + i) * 72 + j0) = h0; *(u32x4*)(xbh_s + (d * 64 + i) * 72 + j0 + 8) = h1;
#pragma unroll
            for (int e = 0; e < 16; ++e) xbf_s[(d * 64 + i) * 65 + j0 + e] = v[e];
        }
        __syncthreads();
#pragma unroll
        for (int d = 0; d < 2; ++d) {
            f32x4 acc[8];
#pragma unroll
            for (int nt = 0; nt < 8; ++nt) acc[nt] = (f32x4){0.f, 0.f, 0.f, 0.f};
            bf16x8 af[2];
#pragma unroll
            for (int ks = 0; ks < 2; ++ks) af[ks] = *(const bf16x8*)(xbh_s + (d * 64 + wv * 16 + l15) * 72 + ks * 32 + quad * 8);
#pragma unroll
            for (int nt = 0; nt < 8; ++nt)
#pragma unroll
                for (int ks = 0; ks < 2; ++ks) { bf16x8 bw = *(const bf16x8*)(Wt_s + (d * 128 + nt * 16 + l15) * 72 + ks * 32 + quad * 8); acc[nt] = mfma16(af[ks], bw, acc[nt]); }
#pragma unroll
            for (int nt = 0; nt < 4; ++nt)
#pragma unroll
                for (int jj = 0; jj < 4; ++jj) {
                    const int idx = (d * 64 + wv * 16 + quad * 4 + jj) * 65 + nt * 16 + l15;
                    const float r = sigm(acc[nt][jj] + ba_[d][nt]), ig = sigm(acc[nt + 4][jj] + bi_[d][nt]);
                    const float la = -8.f * r * sp_[d][nt];
                    a_s[idx] = expf(la);
                    xbf_s[idx] = sqrtf(fmaxf(1.f - expf(2.f * la), 0.f)) * (ig * xbf_s[idx]);
                }
        }
        __syncthreads();
        if (wv < 2) {
            const int o = wv * 64 * 65 + lane;
#pragma unroll 16
            for (int r = 0; r < 64; ++r) { hc = a_s[o + r * 65] * hc + xbf_s[o + r * 65]; xbf_s[o + r * 65] = hc; }
        }
        __syncthreads();
#pragma unroll
        for (int d = 0; d < 2; ++d) {
            const int c = d ? cb : cf;
            const int s = d ? c * 64 + 63 - i : c * 64 + i;
            const bool second = d ? (cb < n) : ((cf < 4 ? 3 - cf : 71 - cf) < n);
            const size_t row = (size_t)b * SB + s;
            const float* hp = xbf_s + (d * 64 + i) * 65 + j0;
            bf16_t* hf = HF + row * 512 + g * 64 + j0;
            if (!second) {
                u32x4 o0, o1;
#pragma unroll
                for (int e = 0; e < 4; ++e) { o0[e] = pack2(hp[2 * e], hp[2 * e + 1]); o1[e] = pack2(hp[8 + 2 * e], hp[8 + 2 * e + 1]); }
                *(u32x4*)hf = o0; *(u32x4*)(hf + 8) = o1;
            } else {
                bf16_t* gp = P + row * PW + C_LG + g * 64 + j0;
                u32x4 f0 = *(const u32x4*)hf, f1 = *(const u32x4*)(hf + 8), g0 = *(const u32x4*)gp, g1 = *(const u32x4*)(gp + 8), o0, o1;
#pragma unroll
                for (int e = 0; e < 4; ++e) {
                    o0[e] = pack2((lo16(f0[e]) + hp[2 * e]) * gelu_tanh(lo16(g0[e])), (hi16(f0[e]) + hp[2 * e + 1]) * gelu_tanh(hi16(g0[e])));
                    o1[e] = pack2((lo16(f1[e]) + hp[8 + 2 * e]) * gelu_tanh(lo16(g1[e])), (hi16(f1[e]) + hp[8 + 2 * e + 1]) * gelu_tanh(hi16(g1[e])));
                }
                *(u32x4*)gp = o0; *(u32x4*)(gp + 8) = o1;
            }
        }
    }
}

DEV void att_item(const Params& p, int l, int b, int h, int qt, float lam_init, unsigned char* smem) {
    bf16_t* K_s = (bf16_t*)smem;
    bf16_t* V_s = (bf16_t*)(smem + 2 * 17408);
    const int tid = get_tid(), lane = tid & 63, wv = tid >> 6, l15 = lane & 15, quad = lane >> 4;
    bf16_t* P = wsb(p, O_P);
    const bf16_t* VT = wsb(p, O_VT) + (size_t)(b * 4 + h) * 128 * SB;
    const int nt_keys = (qt < 2 ? CTXL : SB) / 64;
    float lam;
    {
        const float* lv = p.in[I_DALAM] + l * 256;
        float s1 = lv[lane] * lv[64 + lane], s2 = lv[128 + lane] * lv[192 + lane];
#pragma unroll
        for (int o = 32; o >= 1; o >>= 1) { s1 += __shfl_xor(s1, o); s2 += __shfl_xor(s2, o); }
        lam = expf(s1) - expf(s2) + lam_init;
    }
    bf16x8* Qst = (bf16x8*)(smem + 71680) + (wv * 8) * 64 + lane;
#pragma unroll
    for (int qg = 0; qg < 2; ++qg) {
        const bf16_t* qp = P + ((size_t)b * SB + qt * 128 + wv * 32 + qg * 16 + l15) * PW + C_DAQ + h * 128;
#pragma unroll
        for (int wh = 0; wh < 2; ++wh)
#pragma unroll
            for (int ks = 0; ks < 2; ++ks) Qst[(wh * 4 + qg * 2 + ks) * 64] = *(const bf16x8*)(qp + wh * 64 + ks * 32 + quad * 8);
    }
    f32x4 O[2][8][2];
    float mrun[2][2], lrun[2][2];
#pragma unroll
    for (int wh = 0; wh < 2; ++wh)
#pragma unroll
        for (int qg = 0; qg < 2; ++qg) { mrun[wh][qg] = -1e30f; lrun[wh][qg] = 0.f;
#pragma unroll
            for (int dg = 0; dg < 8; ++dg) O[wh][dg][qg] = (f32x4){0.f, 0.f, 0.f, 0.f}; }
    const int kr = tid >> 2, kseg = (tid & 3) * 32;
    const int kpos = ((kr >> 5) * 2 + ((kr & 7) >> 2)) * 16 + ((kr & 31) >> 3) * 4 + (kr & 3);
    const bf16_t* kg_ = P + ((size_t)b * SB + kr) * PW + C_DAK + h * 128 + kseg;
    const int vr = tid >> 1, vh = (tid & 1) * 32;
    const bf16_t* vg_ = VT + (size_t)vr * SB + vh;
    u32x4 kreg[4], vreg[4];
#pragma unroll
    for (int i = 0; i < 4; ++i) { kreg[i] = *(const u32x4*)(kg_ + i * 8); vreg[i] = *(const u32x4*)(vg_ + i * 8); }
    __syncthreads();
#pragma unroll
    for (int i = 0; i < 4; ++i) { *(u32x4*)(K_s + kpos * 136 + kseg + i * 8) = kreg[i]; *(u32x4*)(V_s + vr * 72 + vh + i * 8) = vreg[i]; }
    __syncthreads();
    const float L2E = 1.4426950408889634f;
#pragma unroll 1
    for (int t = 0; t < nt_keys; ++t) {
        const bf16_t* Kb = K_s + (t & 1) * (64 * 136);
        const bf16_t* Vb = V_s + (t & 1) * (128 * 72);
        if (t + 1 < nt_keys) {
#pragma unroll
            for (int i = 0; i < 4; ++i) { kreg[i] = *(const u32x4*)(kg_ + (size_t)(t + 1) * 64 * PW + i * 8); vreg[i] = *(const u32x4*)(vg_ + (t + 1) * 64 + i * 8); }
        }
#pragma unroll
        for (int wh = 0; wh < 2; ++wh) {
            f32x4 S[4][2];
#pragma unroll
            for (int kg = 0; kg < 4; ++kg) { S[kg][0] = (f32x4){0.f, 0.f, 0.f, 0.f}; S[kg][1] = (f32x4){0.f, 0.f, 0.f, 0.f}; }
#pragma unroll
            for (int ks = 0; ks < 2; ++ks)
#pragma unroll
                for (int kg = 0; kg < 4; ++kg) {
                    bf16x8 kf = *(const bf16x8*)(Kb + (kg * 16 + l15) * 136 + wh * 64 + ks * 32 + quad * 8);
                    S[kg][0] = mfma16(kf, Qst[(wh * 4 + 0 + ks) * 64], S[kg][0]);
                    S[kg][1] = mfma16(kf, Qst[(wh * 4 + 2 + ks) * 64], S[kg][1]);
                }
            bf16x8 Pf[2][2];
#pragma unroll
            for (int qg = 0; qg < 2; ++qg) {
                float mx = -1e30f;
#pragma unroll
                for (int kg = 0; kg < 4; ++kg)
#pragma unroll
                    for (int j = 0; j < 4; ++j) mx = fmaxf(mx, S[kg][qg][j]);
                mx = fmaxf(mx, __shfl_xor(mx, 16)); mx = fmaxf(mx, __shfl_xor(mx, 32));
                mx *= L2E;
                if (__builtin_amdgcn_ballot_w64(mx > mrun[wh][qg] + 8.f) != 0ull) {
                    const float mnew = fmaxf(mrun[wh][qg], mx);
                    const float alpha = __builtin_amdgcn_exp2f(mrun[wh][qg] - mnew);
                    mrun[wh][qg] = mnew;
                    lrun[wh][qg] *= alpha;
#pragma unroll
                    for (int dg = 0; dg < 8; ++dg)
#pragma unroll
                        for (int j = 0; j < 4; ++j) O[wh][dg][qg][j] *= alpha;
                }
                const float mref = mrun[wh][qg];
                float ps = 0.f;
#pragma unroll
                for (int kg = 0; kg < 4; ++kg)
#pragma unroll
                    for (int j = 0; j < 4; ++j) { float pv = __builtin_amdgcn_exp2f(S[kg][qg][j] * L2E - mref); ps += pv; S[kg][qg][j] = pv; }
                lrun[wh][qg] += ps;
#pragma unroll
                for (int s_ = 0; s_ < 2; ++s_) {
                    u32x4 pk; pk[0] = pack2(S[2 * s_][qg][0], S[2 * s_][qg][1]); pk[1] = pack2(S[2 * s_][qg][2], S[2 * s_][qg][3]);
                    pk[2] = pack2(S[2 * s_ + 1][qg][0], S[2 * s_ + 1][qg][1]); pk[3] = pack2(S[2 * s_ + 1][qg][2], S[2 * s_ + 1][qg][3]);
                    Pf[qg][s_] = __builtin_bit_cast(bf16x8, pk);
                }
            }
#pragma unroll
            for (int dg = 0; dg < 8; ++dg)
#pragma unroll
                for (int s_ = 0; s_ < 2; ++s_) {
                    bf16x8 vf = *(const bf16x8*)(Vb + (dg * 16 + l15) * 72 + s_ * 32 + quad * 8);
                    O[wh][dg][0] = mfma16(vf, Pf[0][s_], O[wh][dg][0]);
                    O[wh][dg][1] = mfma16(vf, Pf[1][s_], O[wh][dg][1]);
                }
        }
        if (t + 1 < nt_keys) {
            bf16_t* Kn = K_s + ((t + 1) & 1) * (64 * 136); bf16_t* Vn = V_s + ((t + 1) & 1) * (128 * 72);
#pragma unroll
            for (int i = 0; i < 4; ++i) { *(u32x4*)(Kn + kpos * 136 + kseg + i * 8) = kreg[i]; *(u32x4*)(Vn + vr * 72 + vh + i * 8) = vreg[i]; }
        }
        __syncthreads();
    }
    const float* dnw = p.in[I_DANORM] + l * 128;
#pragma unroll
    for (int qg = 0; qg < 2; ++qg) {
        float l1 = lrun[0][qg], l2 = lrun[1][qg];
        l1 += __shfl_xor(l1, 16); l1 += __shfl_xor(l1, 32); l2 += __shfl_xor(l2, 16); l2 += __shfl_xor(l2, 32);
        const float i1 = 1.f / l1, i2 = lam / l2;
        float ss = 0.f;
#pragma unroll
        for (int dg = 0; dg < 8; ++dg)
#pragma unroll
            for (int j = 0; j < 4; ++j) { float o = O[0][dg][qg][j] * i1 - O[1][dg][qg][j] * i2; O[0][dg][qg][j] = o; ss += o * o; }
        ss += __shfl_xor(ss, 16); ss += __shfl_xor(ss, 32);
        const float rstd = rsqrtf(ss * (1.f / 128.f) + 1e-5f) * (1.f - lam_init);
        bf16_t* op = P + ((size_t)b * SB + qt * 128 + wv * 32 + qg * 16 + l15) * PW + C_DAQ + h * 128;
#pragma unroll
        for (int dg = 0; dg < 8; ++dg) {
            const int dv0 = dg * 16 + quad * 4;
            u32x2 o; o.x = pack2(O[0][dg][qg][0] * rstd * dnw[dv0], O[0][dg][qg][1] * rstd * dnw[dv0 + 1]);
            o.y = pack2(O[0][dg][qg][2] * rstd * dnw[dv0 + 2], O[0][dg][qg][3] * rstd * dnw[dv0 + 3]);
            *(u32x2*)(op + dv0) = o;
        }
    }
}

DEV void phase_mix(const Params& p, int l, unsigned char* smem) {
    const bool need_ctx = l == 0;
    const float lam_init = l == 0 ? 0.2f : 0.35550906759096926f;
    unsigned* ctr = (unsigned*)(p.ws + O_CTL) + l;
    unsigned* actr = (unsigned*)(p.ws + O_CTL) + 16 + l * 8;
    __shared__ int s_item;
    const int nqt = need_ctx ? 34 : 32;
    auto next = [&](unsigned* c) -> int {
        __syncthreads();
        if (threadIdx.x == 0) s_item = (int)atomicAdd(c, 1u);
        __syncthreads();
        return __builtin_amdgcn_readfirstlane(s_item);
    };
    int it = next(ctr);
#pragma unroll 1
    while (it < 64) { dn_item(p, l, it, smem); it = next(ctr); }
#pragma unroll 1
    while (it < 128) { lru_item(p, l, it - 64, smem); it = next(ctr); }
    const int myx = blockIdx.x & 7;
#pragma unroll 1
    for (int k = 0; k < 8; ++k) {
        const int x = (myx + k) & 7;
        it = next(actr + x);
#pragma unroll 1
        while (it < 4 * nqt) {
            const int bh = x + 8 * (it / nqt), idx = it % nqt;
            const int qt = idx < 32 ? idx + 2 : idx - 32;
            att_item(p, l, bh >> 2, bh & 3, qt, lam_init, smem);
            it = next(actr + x);
        }
    }
}

#define XB_TMO      128
#define XB_XCNT(j)  (256  + 64 * (j))
#define XB_XSUB(j)  (1280 + 64 * (j))
#define XB_XGEN(j)  (2304 + 64 * (j))
#define XB_TOP      3328
#define XB_TOPGEN   3392
#define XCD_BAR_WORDS 3456
#define XB_SPIN_CAP (1u << 18)
#define LAS __attribute__((address_space(3)))
DEV unsigned xb_ld(unsigned* p)              { return __hip_atomic_load(p, __ATOMIC_RELAXED, __HIP_MEMORY_SCOPE_AGENT); }
DEV unsigned xb_add(unsigned* p, unsigned v) { return __hip_atomic_fetch_add(p, v, __ATOMIC_RELAXED, __HIP_MEMORY_SCOPE_AGENT); }
DEV unsigned xb_xcc_id() { return (unsigned)__builtin_amdgcn_s_getreg((3 << 11) | 20) & 0xFu; }
#define XB_SPIN(cond, bar) do { unsigned _sp = 0; while (cond) { __builtin_amdgcn_s_sleep(1); \
    if ((++_sp & 255u) == 0u) { if (xb_ld(&(bar)[XB_TMO])) break; if (_sp > XB_SPIN_CAP) { atomicAdd(&(bar)[XB_TMO], 1u); break; } } } } while (0)
struct XcdBarrier { unsigned* bar; unsigned x; volatile LAS unsigned* st; };
DEV XcdBarrier xcd_barrier_post(unsigned* bar, volatile LAS unsigned* st) {
    XcdBarrier b; b.bar = bar; b.x = xb_xcc_id(); b.st = st;
    if (threadIdx.x == 0) (void)xb_add(&bar[XB_XCNT(b.x)], 1u);
    return b;
}
DEV void xcd_barrier_complete(unsigned* bar, unsigned x, unsigned& nloc, unsigned& nx) {
    const unsigned G = gridDim.x * gridDim.y * gridDim.z;
    unsigned sum, cnt, mine, sp = 0u;
    for (;;) {
        sum = 0u; cnt = 0u; mine = 0u;
#pragma unroll
        for (unsigned j = 0; j < 16; ++j) { const unsigned c = xb_ld(&bar[XB_XCNT(j)]); sum += c; cnt += (c > 0u) ? 1u : 0u; mine = (j == x) ? c : mine; }
        if (sum == G) break;
        __builtin_amdgcn_s_sleep(1);
        if ((++sp & 255u) == 0u) { if (xb_ld(&bar[XB_TMO])) break; if (sp > XB_SPIN_CAP) { atomicAdd(&bar[XB_TMO], 1u); break; } }
    }
    nloc = mine > 0u ? mine : 1u; nx = cnt > 0u ? cnt : 1u;
}
DEV void xcd_barrier(const XcdBarrier& b) {
    asm volatile("s_waitcnt vmcnt(0)" ::: "memory");
    __syncthreads();
    if (threadIdx.x == 0) {
        unsigned* bar = b.bar;
        __builtin_amdgcn_s_waitcnt(0);
        unsigned nloc = b.st[0], nx = b.st[1];
        if (nloc == 0u) { xcd_barrier_complete(bar, b.x, nloc, nx); b.st[0] = nloc; b.st[1] = nx; }
        const unsigned old = xb_add(&bar[XB_XSUB(b.x)], 1u);
        const unsigned gen = old / nloc;
        if (old + 1u == (gen + 1u) * nloc) {
            __builtin_amdgcn_fence(__ATOMIC_RELEASE, "agent");
            asm volatile("s_waitcnt vmcnt(0)" ::: "memory");
            const unsigned og = xb_add(&bar[XB_TOP], 1u);
            const unsigned tg = og / nx;
            if (og + 1u == (tg + 1u) * nx) xb_add(&bar[XB_TOPGEN], 1u);
            else XB_SPIN(xb_ld(&bar[XB_TOPGEN]) == tg, bar);
            __builtin_amdgcn_fence(__ATOMIC_ACQUIRE, "agent");
            xb_add(&bar[XB_XGEN(b.x)], 1u);
            asm volatile("s_waitcnt vmcnt(0)" ::: "memory");
        } else {
            XB_SPIN(xb_ld(&bar[XB_XGEN(b.x)]) == gen, bar);
            __builtin_amdgcn_fence(__ATOMIC_ACQUIRE, "agent");
            asm volatile("s_waitcnt vmcnt(0)" ::: "memory");
        }
    }
    __syncthreads();
}

constexpr int NPHASE = 1 + 2 * 9 + 1;
DEV void run_phase(const Params& p, int ph, unsigned char* smem) {
    if (ph == 0) { phase_mod(p, smem); phase_rope(p); __syncthreads(); phase_wconv(p, 0, smem); return; }
    if (ph == NPHASE - 1) { phase_final(p); return; }
    const int l = (ph - 1) / 9, q = (ph - 1) % 9;
    const bool first = l == 0, lat = l == 1;
    const bf16_t* W = wsb(p, O_WT);
    switch (q) {
        case 0: if (l == 1) phase_wconv(p, 1, smem); phase_norm(p, l, 0, first, false); break;
        case 1: phase_g1(p, smem); break;
        case 2: phase_mix(p, l, smem); break;
        case 3: phase_fin_norm(p, l, first, lat); break;
        case 4: phase_gate(p, lat, smem); break;
        case 5: phase_resid(p, l, wsb(p, O_U), D, W + W_OUT, 1024, 2, first, lat, smem); break;
        case 6: phase_norm(p, l, 1, false, lat); break;
        case 7: phase_gu(p, lat, smem); break;
        case 8: phase_resid(p, l, wsb(p, O_P), PW, W + W_DN, DFF, 5, false, lat, smem); break;
    }
}

#if MEGA
__global__ void __launch_bounds__(256) mega_kernel(Params p) {
    extern __shared__ __align__(16) unsigned char smem[];
    cg::grid_group grid = cg::this_grid();
    __shared__ uint4 xb_words;
    if (threadIdx.x == 0) xb_words = make_uint4(0u, 0u, 0u, 0u);
    __syncthreads();
    const XcdBarrier xb = xcd_barrier_post((unsigned*)(p.ws + O_BAR), (volatile LAS unsigned*)&xb_words);
    phase_mod(p, smem); phase_rope(p); __syncthreads(); phase_wconv(p, 0, smem);
    grid.sync();
    const bf16_t* W = wsb(p, O_WT);
#pragma unroll
    for (int l = 0; l < 2; ++l) {
        const bool first = l == 0, lat = l == 1;
        if (l == 1) phase_wconv(p, 1, smem);
        phase_norm(p, l, 0, first, false);
        xcd_barrier(xb);
        phase_g1(p, smem);
        xcd_barrier(xb);
        phase_mix(p, l, smem);
        xcd_barrier(xb);
        phase_fin_norm(p, l, first, lat);
        xcd_barrier(xb);
        phase_gate(p, lat, smem);
        xcd_barrier(xb);
        phase_merge(p, lat, smem);
        xcd_barrier(xb);
        phase_resid(p, l, wsb(p, O_U), D, W + W_OUT, 1024, 2, first, lat, smem);
        xcd_barrier(xb);
        phase_norm(p, l, 1, false, lat);
        xcd_barrier(xb);
        phase_gu(p, lat, smem);
        xcd_barrier(xb);
        phase_resid(p, l, wsb(p, O_P), PW, W + W_DN, DFF, 5, false, lat, smem);
        xcd_barrier(xb);
    }
    phase_final(p);
}
#else
__global__ void __launch_bounds__(256) phase_kernel(Params p, int ph) {
    extern __shared__ __align__(16) unsigned char smem[];
    run_phase(p, ph, smem);
}
#endif

extern "C" void kernel_launch(void* const* d_in, const int* in_sizes, int n_in, void* d_out, int out_size, void* d_ws, size_t ws_size, hipStream_t stream) {
    static int grid = 0;
    if (grid == 0) {
        if (n_in != 28 || ws_size < WS_END) { fprintf(stderr, "kernel_launch: unexpected n_in %d or ws_size %zu < %zu\n", n_in, ws_size, (size_t)WS_END); grid = -1; return; }
        int dev = 0, cus = 0, per_cu = 0;
        hipGetDevice(&dev);
        hipDeviceGetAttribute(&cus, hipDeviceAttributeMultiprocessorCount, dev);
#if MEGA
        hipFuncSetAttribute((const void*)mega_kernel, hipFuncAttributeMaxDynamicSharedMemorySize, LDS_BYTES);
        hipOccupancyMaxActiveBlocksPerMultiprocessor(&per_cu, (const void*)mega_kernel, 256, LDS_BYTES);
#else
        hipFuncSetAttribute((const void*)phase_kernel, hipFuncAttributeMaxDynamicSharedMemorySize, LDS_BYTES);
        hipOccupancyMaxActiveBlocksPerMultiprocessor(&per_cu, (const void*)phase_kernel, 256, LDS_BYTES);
#endif
        if (per_cu < 1) per_cu = 1;
        grid = cus * per_cu;
        fprintf(stderr, "kernel_launch: grid %d (%d CUs x %d)\n", grid, cus, per_cu);
    }
    if (grid < 0) return;
    hipMemsetAsync((char*)d_ws + O_CTL, 0, 4096 + 16384, stream);
    Params p{};
    for (int i = 0; i < 28; ++i) p.in[i] = (const float*)d_in[i];
    p.out = (float*)d_out; p.ws = (unsigned char*)d_ws;
#if MEGA
    void* args[] = {&p};
    hipError_t e = hipLaunchCooperativeKernel((const void*)mega_kernel, dim3(grid), dim3(256), args, LDS_BYTES, stream);
    if (e != hipSuccess) fprintf(stderr, "cooperative launch failed: %s (grid %d)\n", hipGetErrorString(e), grid);
#else
    for (int ph = 0; ph < NPHASE; ++ph) hipLaunchKernelGGL(phase_kernel, dim3(grid), dim3(256), LDS_BYTES, stream, p, ph);
#endif
}
```

```cpp
#include <hip/hip_runtime.h>
#include <hip/hip_cooperative_groups.h>
#include <cstdio>
#include <cstdint>
namespace cg = cooperative_groups;

#ifndef MEGA
#define MEGA 1
#endif

typedef unsigned short bf16_t;
typedef short bf16x8 __attribute__((ext_vector_type(8)));
typedef float f32x4 __attribute__((ext_vector_type(4)));
typedef unsigned u32x4 __attribute__((ext_vector_type(4)));
typedef unsigned u32x2 __attribute__((ext_vector_type(2)));
#define DEV __device__ __forceinline__

constexpr int D = 1024, NB = 8, SEQ = 4096, CTXL = 256, SB = 4352, MR = NB * SB, PW = 4096, DFF = 2816;
constexpr int C_DNQ = 0, C_DNK = 512, C_DNV = 1024, C_DNZ = 1536, C_LX = 2048, C_LG = 2560, C_DAQ = 3072, C_DAK = 3584;
constexpr int NIN = 4736;
constexpr int GLD = 80;

enum { I_X = 0, I_C, I_CTX, I_CCTX, I_WMOD, I_BMOD, I_NMIX, I_NFFN, I_WIN, I_DNCONV, I_DNALOG, I_DNDT, I_DNNORM, I_LCW, I_LCB,
       I_LWA, I_LBA, I_LWI, I_LBI, I_LLAM, I_DALAM, I_DANORM, I_WBR, I_WOUT, I_WFG, I_WFU, I_WFD, I_NFIN };

constexpr size_t al256(size_t x) { return (x + 255) & ~(size_t)255; }
constexpr size_t O_CTL = 0;
constexpr size_t O_BAR = 4096;
constexpr size_t O_MOD = 4096 + 16384;
constexpr size_t O_ROPE = al256(O_MOD + (size_t)2 * 9 * 6144 * 4);
constexpr size_t O_WT = al256(O_ROPE + 64 * 16 * 2 * 4);
constexpr size_t W_IN = 0, W_GATE = W_IN + (size_t)NIN * 1024, W_BR = W_GATE + (size_t)3072 * 1024, W_OUT = W_BR + (size_t)3 * 1024 * 512,
                 W_GU = W_OUT + (size_t)1024 * 1024, W_DN = W_GU + (size_t)5632 * 1024, W_END = W_DN + (size_t)1024 * 2816;
constexpr size_t O_HCTX = al256(O_WT + W_END * 2);
constexpr size_t O_U = al256(O_HCTX + (size_t)2048 * 1024 * 4);
constexpr size_t O_P = al256(O_U + (size_t)MR * 1024 * 2);
constexpr size_t O_AB = al256(O_P + (size_t)MR * PW * 2);
constexpr size_t O_TA = al256(O_AB + (size_t)MR * 16 * 4);
constexpr size_t O_TA2 = al256(O_TA + (size_t)MR * 512 * 2);
constexpr size_t O_VT = al256(O_TA2 + (size_t)MR * 512 * 2);
constexpr size_t WS_END = al256(O_VT + (size_t)MR * 512 * 2);

constexpr int LDS_BYTES = 140 * 1024;

struct Params {
    const float* in[28];
    float* out;
    unsigned char* ws;
};

DEV int get_tid() { int t = threadIdx.x; asm volatile("" : "+v"(t)); return t; }
DEV float bf2f(bf16_t h) { return __uint_as_float(((unsigned)h) << 16); }
DEV bf16_t f2bf(float f) { unsigned u = __float_as_uint(f); u += 0x7fffu + ((u >> 16) & 1u); return (bf16_t)(u >> 16); }
typedef float f32x2_ __attribute__((ext_vector_type(2)));
typedef __bf16 bf16x2_ __attribute__((ext_vector_type(2)));
DEV unsigned pack2(float a, float b) { const f32x2_ v = {a, b}; return __builtin_bit_cast(unsigned, __builtin_convertvector(v, bf16x2_)); }
DEV float sigm(float x) { return __builtin_amdgcn_rcpf(1.f + __expf(-x)); }
DEV float silu(float x) { return x * __builtin_amdgcn_rcpf(1.f + __expf(-x)); }
DEV float softplus(float x) { return x > 20.f ? x : log1pf(expf(x)); }
DEV float softplus_fast(float x) { const float e = __expf(x); return x > 15.f ? x : (e < 0.01f ? e * (1.f - e * (0.5f - e * 0.33333333f)) : __logf(1.f + e)); }
DEV float gelu_tanh(float x) { float u = 0.7978845608028654f * (x + 0.044715f * x * x * x); float t = 1.f - 2.f * __builtin_amdgcn_rcpf(1.f + __expf(2.f * u)); return 0.5f * x * (1.f + t); }
DEV f32x4 mfma16(bf16x8 a, bf16x8 b, f32x4 c) { return __builtin_amdgcn_mfma_f32_16x16x32_bf16(a, b, c, 0, 0, 0); }
DEV void mfma16a(f32x4& c, bf16x8 a, bf16x8 b) { asm volatile("v_mfma_f32_16x16x32_bf16 %0, %1, %2, %0" : "+a"(c) : "v"(a), "v"(b)); }
DEV float lo16(unsigned v) { return __uint_as_float(v << 16); }
DEV float hi16(unsigned v) { return __uint_as_float(v & 0xffff0000u); }

DEV bf16_t* wsb(const Params& p, size_t off) { return (bf16_t*)(p.ws + off); }
DEV float* wsf(const Params& p, size_t off) { return (float*)(p.ws + off); }
DEV float* hrow(const Params& p, int r) { int b = r / SB, s = r - b * SB; return s < CTXL ? wsf(p, O_HCTX) + (size_t)(b * CTXL + s) * D : p.out + (size_t)(b * SEQ + s - CTXL) * D; }
DEV const float* xrow(const Params& p, int r) { int b = r / SB, s = r - b * SB; return s < CTXL ? p.in[I_CTX] + (size_t)(b * CTXL + s) * D : p.in[I_X] + (size_t)(b * SEQ + s - CTXL) * D; }
DEV int modrow(int r) { int b = r / SB, s = r - b * SB; return s < CTXL ? 8 : b; }

template <int MT, int NT>
DEV void gemm_core(const bf16_t* __restrict__ A, int lda, const bf16_t* __restrict__ Bt, int ldb, int K, f32x4 (&acc)[MT][NT], bf16_t* smem_) {
    constexpr int SA = 32 * MT * GLD, SBB = 32 * NT * GLD;
    bf16_t* sA = smem_; bf16_t* sB = smem_ + 2 * SA;
    const int tid = get_tid(), lane = tid & 63, wv = tid >> 6, wr = wv >> 1, wc = wv & 1, l15 = lane & 15, quad = lane >> 4;
    const int lr = tid >> 3, lc = (tid & 7) * 8;
    u32x4 ra0[MT], rb0[NT], ra1[MT], rb1[NT];
    const bf16_t* Ap = A + (size_t)lr * lda + lc;
    const bf16_t* Bp = Bt + (size_t)lr * ldb + lc;
    const int nk = K >> 6;
#define GLOAD(RA, RB, KT) { const int ko_ = (KT) * 64; _Pragma("unroll") for (int i = 0; i < MT; ++i) RA[i] = *(const u32x4*)(Ap + (size_t)(32 * i) * lda + ko_); \
                            _Pragma("unroll") for (int i = 0; i < NT; ++i) RB[i] = *(const u32x4*)(Bp + (size_t)(32 * i) * ldb + ko_); }
#define LSTORE(RA, RB, BUF) { _Pragma("unroll") for (int i = 0; i < MT; ++i) *(u32x4*)(sA + (BUF) * SA + (lr + 32 * i) * GLD + lc) = RA[i]; \
                              _Pragma("unroll") for (int i = 0; i < NT; ++i) *(u32x4*)(sB + (BUF) * SBB + (lr + 32 * i) * GLD + lc) = RB[i]; }
#define AFRAG(BUF, MT_, KS) (*(const bf16x8*)(sA + (BUF) * SA + (wr * MT * 16 + (MT_) * 16 + l15) * GLD + (KS) * 32 + quad * 8))
#define HALF(BUFC, RA, RB, BUFS, DO_STORE, DO_LOAD, KT) { \
        bf16x8 bfr[2][NT]; \
        _Pragma("unroll") for (int ks = 0; ks < 2; ++ks) _Pragma("unroll") for (int nt = 0; nt < NT; ++nt) \
            bfr[ks][nt] = *(const bf16x8*)(sB + (BUFC) * SBB + (wc * NT * 16 + nt * 16 + l15) * GLD + ks * 32 + quad * 8); \
        bf16x8 a0 = AFRAG(BUFC, 0, 0), a1 = AFRAG(BUFC, 0, 1); \
        const int ko_ = (KT) * 64; \
        _Pragma("unroll") for (int mt = 0; mt < MT; ++mt) { \
            bf16x8 n0 = a0, n1 = a1; \
            if (DO_STORE) { *(u32x4*)(sA + (BUFS) * SA + (lr + 32 * mt) * GLD + lc) = RA[mt]; } \
            if (DO_LOAD) { RA[mt] = *(const u32x4*)(Ap + (size_t)(32 * mt) * lda + ko_); } \
            _Pragma("unroll") for (int nt = 0; nt < NT; ++nt) mfma16a(acc[mt][nt], bfr[0][nt], a0); \
            if (mt + 1 < MT) { n0 = AFRAG(BUFC, mt + 1, 0); n1 = AFRAG(BUFC, mt + 1, 1); } \
            if (DO_STORE) { if (mt < NT) *(u32x4*)(sB + (BUFS) * SBB + (lr + 32 * mt) * GLD + lc) = RB[mt]; } \
            if (DO_LOAD) { if (mt < NT) RB[mt] = *(const u32x4*)(Bp + (size_t)(32 * mt) * ldb + ko_); } \
            _Pragma("unroll") for (int nt = 0; nt < NT; ++nt) mfma16a(acc[mt][nt], bfr[1][nt], a1); \
            a0 = n0; a1 = n1; \
        } }
    static_assert(NT <= MT, "HALF stages the B pieces alongside the first NT A pieces");
    GLOAD(ra0, rb0, 0);
    GLOAD(ra1, rb1, 1);
    __syncthreads();
    LSTORE(ra0, rb0, 0);
    GLOAD(ra0, rb0, 2);
    __syncthreads();
    int kt = 0;
#pragma unroll 1
    for (; kt + 4 < nk; kt += 2) {
        HALF(0, ra1, rb1, 1, true, true, kt + 3);
        __syncthreads();
        HALF(1, ra0, rb0, 0, true, true, kt + 4);
        __syncthreads();
    }
    HALF(0, ra1, rb1, 1, true, true, kt + 3);
    __syncthreads();
    HALF(1, ra0, rb0, 0, true, false, 0);
    __syncthreads();
    HALF(0, ra1, rb1, 1, true, false, 0);
    __syncthreads();
    HALF(1, ra0, rb0, 0, false, false, 0);
    __syncthreads();
#undef AFRAG
#undef HALF
#undef GLOAD
#undef LSTORE
    static_assert(NT == 4, "the accumulator fence is written for NT == 4");
#pragma unroll
    for (int mt = 0; mt < MT; ++mt) {
        if (mt == 0) asm volatile("s_nop 15\n\ts_nop 15" : "+a"(acc[mt][0]), "+a"(acc[mt][1]), "+a"(acc[mt][2]), "+a"(acc[mt][3]));
        else asm volatile("s_nop 0" : "+a"(acc[mt][0]), "+a"(acc[mt][1]), "+a"(acc[mt][2]), "+a"(acc[mt][3]));
    }
}
template <int MT, int NT>
DEV void gemm_core1(const bf16_t* __restrict__ A, int lda, const bf16_t* __restrict__ Bt, int ldb, int K, f32x4 (&acc)[MT][NT], bf16_t* sA, bf16_t* sB) {
    const int tid = get_tid(), lane = tid & 63, wv = tid >> 6, wr = wv >> 1, wc = wv & 1, l15 = lane & 15, quad = lane >> 4;
    const int lr = tid >> 3, lc = (tid & 7) * 8;
    u32x4 ra[MT], rb[NT];
    const bf16_t* Ap = A + (size_t)lr * lda + lc;
    const bf16_t* Bp = Bt + (size_t)lr * ldb + lc;
#pragma unroll
    for (int i = 0; i < MT; ++i) ra[i] = *(const u32x4*)(Ap + (size_t)(32 * i) * lda);
#pragma unroll
    for (int i = 0; i < NT; ++i) rb[i] = *(const u32x4*)(Bp + (size_t)(32 * i) * ldb);
    const int nk = K >> 6;
    for (int kt = 0; kt < nk; ++kt) {
        __syncthreads();
#pragma unroll
        for (int i = 0; i < MT; ++i) *(u32x4*)(sA + (lr + 32 * i) * GLD + lc) = ra[i];
#pragma unroll
        for (int i = 0; i < NT; ++i) *(u32x4*)(sB + (lr + 32 * i) * GLD + lc) = rb[i];
        __syncthreads();
        if (kt + 1 < nk) {
            const int ko = (kt + 1) * 64;
#pragma unroll
            for (int i = 0; i < MT; ++i) ra[i] = *(const u32x4*)(Ap + (size_t)(32 * i) * lda + ko);
#pragma unroll
            for (int i = 0; i < NT; ++i) rb[i] = *(const u32x4*)(Bp + (size_t)(32 * i) * ldb + ko);
        }
#pragma unroll
        for (int ks = 0; ks < 2; ++ks) {
            bf16x8 af[MT], bfr[NT];
#pragma unroll
            for (int mt = 0; mt < MT; ++mt) af[mt] = *(const bf16x8*)(sA + (wr * MT * 16 + mt * 16 + l15) * GLD + ks * 32 + quad * 8);
#pragma unroll
            for (int nt = 0; nt < NT; ++nt) bfr[nt] = *(const bf16x8*)(sB + (wc * NT * 16 + nt * 16 + l15) * GLD + ks * 32 + quad * 8);
#pragma unroll
            for (int mt = 0; mt < MT; ++mt)
#pragma unroll
                for (int nt = 0; nt < NT; ++nt) mfma16a(acc[mt][nt], bfr[nt], af[mt]);
        }
    }
    static_assert(NT == 4, "the accumulator fence is written for NT == 4");
#pragma unroll
    for (int mt = 0; mt < MT; ++mt) {
        if (mt == 0) asm volatile("s_nop 15\n\ts_nop 15" : "+a"(acc[mt][0]), "+a"(acc[mt][1]), "+a"(acc[mt][2]), "+a"(acc[mt][3]));
        else asm volatile("s_nop 0" : "+a"(acc[mt][0]), "+a"(acc[mt][1]), "+a"(acc[mt][2]), "+a"(acc[mt][3]));
    }
}
template <int MT, int NT>
DEV void zero_acc(f32x4 (&acc)[MT][NT]) {
#pragma unroll
    for (int mt = 0; mt < MT; ++mt)
#pragma unroll
        for (int nt = 0; nt < NT; ++nt) acc[mt][nt] = (f32x4){0.f, 0.f, 0.f, 0.f};
}

DEV void phase_mod(const Params& p, unsigned char* smem) {
    float* s_s = (float*)smem;
    float* red = s_s + 9 * 1024;
    const int tid = get_tid();
    bool loaded = false;
    for (int it = blockIdx.x; it < 2 * 96; it += gridDim.x) {
        if (!loaded) {
            for (int e = tid; e < 9 * 1024; e += 256) { float v = e < 8192 ? p.in[I_C][e] : p.in[I_CCTX][e - 8192]; s_s[e] = silu(v); }
            loaded = true;
        }
        __syncthreads();
        const int l = it / 96, cg_ = it % 96, cq = tid & 63, kq = tid >> 6, col = cg_ * 64 + cq;
        float acc[9];
#pragma unroll
        for (int r = 0; r < 9; ++r) acc[r] = 0.f;
        const float* wp = p.in[I_WMOD] + ((size_t)l * 1024 + kq * 256) * 6144 + col;
#pragma unroll 8
        for (int k = 0; k < 256; ++k) {
            float wv = wp[(size_t)k * 6144];
#pragma unroll
            for (int r = 0; r < 9; ++r) acc[r] += s_s[r * 1024 + kq * 256 + k] * wv;
        }
#pragma unroll
        for (int r = 0; r < 9; ++r) red[(kq * 9 + r) * 64 + cq] = acc[r];
        __syncthreads();
        for (int e = tid; e < 9 * 64; e += 256) {
            int r = e >> 6, c2 = e & 63;
            float v = red[(0 * 9 + r) * 64 + c2] + red[(1 * 9 + r) * 64 + c2] + red[(2 * 9 + r) * 64 + c2] + red[(3 * 9 + r) * 64 + c2];
            wsf(p, O_MOD)[((size_t)l * 9 + r) * 6144 + cg_ * 64 + c2] = v + p.in[I_BMOD][l * 6144 + cg_ * 64 + c2];
        }
        __syncthreads();
    }
}
DEV void phase_rope(const Params& p) {
    if (blockIdx.x == (gridDim.x - 1)) {
        for (int e = threadIdx.x; e < 1024; e += 256) {
            int pos = e >> 4, i = e & 15;
            float inv = powf(10000.f, -(float)i / 16.f);
            float ang = (float)pos * inv;
            float n = rintf(ang * 0.15915494309189535f);
            float r = fmaf(-n, 6.28125f, ang);
            r = fmaf(-n, 1.9353071795864769e-3f, r);
            wsf(p, O_ROPE)[e * 2] = cosf(r);
            wsf(p, O_ROPE)[e * 2 + 1] = sinf(r);
        }
    }
}
DEV void wconv_tile(const float* src0, const float* src1, int lds_, int K, bf16_t* dst, int kind, int kt, int nt, bf16_t* tile) {
    const int tid = get_tid();
    const int kk = tid >> 2, grp = tid & 3;
    const int n0 = nt * 64, k0 = kt * 64;
    const int ng = n0 + grp * 16;
    const float* src = src0; int sc;
    if (kind == 0) { sc = ng < 2048 ? ng : (ng < 4608 ? ng + 16 : (ng < 4624 ? 2048 : -1)); }
    else if (kind == 1) { sc = 4624 + ng; }
    else if (kind == 2) { sc = ng; }
    else { int gd = ng >> 4; src = (gd & 1) ? src1 : src0; sc = (gd >> 1) * 16; }
    __syncthreads();
    if (sc >= 0) {
        const float4* sp = (const float4*)(src + (size_t)(k0 + kk) * lds_ + sc);
#pragma unroll
        for (int q = 0; q < 4; ++q) { float4 v = sp[q]; int e = grp * 16 + q * 4;
            tile[(e + 0) * GLD + kk] = f2bf(v.x); tile[(e + 1) * GLD + kk] = f2bf(v.y); tile[(e + 2) * GLD + kk] = f2bf(v.z); tile[(e + 3) * GLD + kk] = f2bf(v.w); }
    } else {
#pragma unroll
        for (int e = 0; e < 16; ++e) tile[(grp * 16 + e) * GLD + kk] = 0;
    }
    __syncthreads();
    const int n = tid >> 2, kseg = (tid & 3) * 16;
    u32x4 a = *(const u32x4*)(tile + n * GLD + kseg), b = *(const u32x4*)(tile + n * GLD + kseg + 8);
    bf16_t* dp = dst + (size_t)(n0 + n) * K + k0 + kseg;
    *(u32x4*)dp = a; *(u32x4*)(dp + 8) = b;
}
DEV void phase_wconv(const Params& p, int l, unsigned char* smem) {
    bf16_t* tile = (bf16_t*)smem;
    bf16_t* W = wsb(p, O_WT);
    constexpr int T0 = 74 * 16, T1 = T0 + 48 * 16, T2 = T1 + 3 * 16 * 8, T3 = T2 + 16 * 16, T4 = T3 + 88 * 16, T5 = T4 + 16 * 44;
    for (int t = blockIdx.x; t < T5; t += gridDim.x) {
        if (t < T0) { wconv_tile(p.in[I_WIN] + (size_t)l * 1024 * 7696, nullptr, 7696, 1024, W + W_IN, 0, t % 16, t / 16, tile); }
        else if (t < T1) { int u = t - T0; wconv_tile(p.in[I_WIN] + (size_t)l * 1024 * 7696, nullptr, 7696, 1024, W + W_GATE, 1, u % 16, u / 16, tile); }
        else if (t < T2) { int u = t - T1; int n = u / 128, v = u % 128; wconv_tile(p.in[I_WBR] + ((size_t)l * 3 + n) * 512 * 1024, nullptr, 1024, 512, W + W_BR + (size_t)n * 1024 * 512, 2, v % 8, v / 8, tile); }
        else if (t < T3) { int u = t - T2; wconv_tile(p.in[I_WOUT] + (size_t)l * 1024 * 1024, nullptr, 1024, 1024, W + W_OUT, 2, u % 16, u / 16, tile); }
        else if (t < T4) { int u = t - T3; wconv_tile(p.in[I_WFG] + (size_t)l * 1024 * DFF, p.in[I_WFU] + (size_t)l * 1024 * DFF, DFF, 1024, W + W_GU, 3, u % 16, u / 16, tile); }
        else { int u = t - T4; wconv_tile(p.in[I_WFD] + (size_t)l * DFF * 1024, nullptr, 1024, DFF, W + W_DN, 2, u % 44, u / 44, tile); }
    }
}

DEV void norm_row(const Params& p, int l, int which, bool first, int r, int lane) {
    const float* h = first ? xrow(p, r) : hrow(p, r);
    const float* nw = p.in[which ? I_NFFN : I_NMIX] + l * D;
    const float* md = wsf(p, O_MOD) + ((size_t)l * 9 + modrow(r)) * 6144 + (which ? 3 * D : 0);
    float4 v[4]; float ss = 0.f;
#pragma unroll
    for (int i = 0; i < 4; ++i) { v[i] = *(const float4*)(h + i * 256 + lane * 4); ss += v[i].x * v[i].x + v[i].y * v[i].y + v[i].z * v[i].z + v[i].w * v[i].w; }
#pragma unroll
    for (int o = 32; o >= 1; o >>= 1) ss += __shfl_xor(ss, o);
    const float rstd = rsqrtf(ss * (1.f / D) + 1e-6f);
    bf16_t* up = wsb(p, O_U) + (size_t)r * D;
#pragma unroll
    for (int i = 0; i < 4; ++i) {
        const int c = i * 256 + lane * 4;
        float4 w4 = *(const float4*)(nw + c), sh = *(const float4*)(md + c), sc = *(const float4*)(md + D + c);
        float a = v[i].x * rstd * w4.x * (1.f + sc.x) + sh.x, b = v[i].y * rstd * w4.y * (1.f + sc.y) + sh.y;
        float c2 = v[i].z * rstd * w4.z * (1.f + sc.z) + sh.z, d = v[i].w * rstd * w4.w * (1.f + sc.w) + sh.w;
        u32x2 o; o.x = pack2(a, b); o.y = pack2(c2, d);
        *(u32x2*)(up + c) = o;
    }
}
DEV void phase_norm(const Params& p, int l, int which, bool first, bool skip_ctx) {
    const int tid_ = get_tid(); const int lane = tid_ & 63, wv = tid_ >> 6;
    for (int r = blockIdx.x * 4 + wv; r < MR; r += gridDim.x * 4) {
        if (skip_ctx && (r % SB) < CTXL) continue;
        norm_row(p, l, which, first, r, lane);
    }
}
DEV void phase_fin_norm(const Params& p, int l, bool first, bool skip_ctx) {
    const int tid_ = get_tid(); const int lane = tid_ & 63, wv = tid_ >> 6;
    const float* dnn = p.in[I_DNNORM] + l * 128;
    for (int r = blockIdx.x * 4 + wv; r < MR; r += gridDim.x * 4) {
        if (skip_ctx && (r % SB) < CTXL) continue;
        norm_row(p, l, 0, first, r, lane);
        bf16_t* ta = wsb(p, O_TA) + (size_t)r * 512 + lane * 8;
        const bf16_t* tb = wsb(p, O_TA2) + (size_t)r * 512 + lane * 8;
        const bf16_t* zz = wsb(p, O_P) + (size_t)r * PW + C_DNZ + lane * 8;
        u32x4 a = *(const u32x4*)ta, b = *(const u32x4*)tb, z = *(const u32x4*)zz;
        float o[8]; float ss = 0.f;
#pragma unroll
        for (int i = 0; i < 4; ++i) { o[2 * i] = lo16(a[i]) + lo16(b[i]); o[2 * i + 1] = hi16(a[i]) + hi16(b[i]); ss += o[2 * i] * o[2 * i] + o[2 * i + 1] * o[2 * i + 1]; }
#pragma unroll
        for (int of = 8; of >= 1; of >>= 1) ss += __shfl_xor(ss, of);
        const float rstd = rsqrtf(ss * (1.f / 128.f) + 1e-6f);
        const int dv0 = (lane & 15) * 8;
        u32x4 y;
#pragma unroll
        for (int i = 0; i < 4; ++i) {
            float y0 = o[2 * i] * rstd * dnn[dv0 + 2 * i] * silu(lo16(z[i]));
            float y1 = o[2 * i + 1] * rstd * dnn[dv0 + 2 * i + 1] * silu(hi16(z[i]));
            y[i] = pack2(y0, y1);
        }
        *(u32x4*)ta = y;
    }
}
DEV void phase_final(const Params& p) {
    const int tid_ = get_tid(); const int lane = tid_ & 63, wv = tid_ >> 6;
    const float* nw = p.in[I_NFIN];
    for (int r = blockIdx.x * 4 + wv; r < NB * SEQ; r += gridDim.x * 4) {
        float* h = p.out + (size_t)r * D;
        float4 v[4]; float ss = 0.f;
#pragma unroll
        for (int i = 0; i < 4; ++i) { v[i] = *(const float4*)(h + i * 256 + lane * 4); ss += v[i].x * v[i].x + v[i].y * v[i].y + v[i].z * v[i].z + v[i].w * v[i].w; }
#pragma unroll
        for (int o = 32; o >= 1; o >>= 1) ss += __shfl_xor(ss, o);
        const float rstd = rsqrtf(ss * (1.f / D) + 1e-6f);
#pragma unroll
        for (int i = 0; i < 4; ++i) {
            const int c = i * 256 + lane * 4;
            float4 w4 = *(const float4*)(nw + c);
            float4 o4; o4.x = v[i].x * rstd * w4.x; o4.y = v[i].y * rstd * w4.y; o4.z = v[i].z * rstd * w4.z; o4.w = v[i].w * rstd * w4.w;
            *(float4*)(h + c) = o4;
        }
    }
}

struct TileIter {
    int nn, total, nloc, L;
    DEV TileIter(int nm, int nn_) { nn = nn_; total = nm * nn_; nloc = gridDim.x >> 3; L = (blockIdx.x & 7) * nloc + (blockIdx.x >> 3); }
    DEV bool valid() const { return L < total; }
    DEV bool more() const { return (L - (int)(blockIdx.x >> 3)) < total; }
    DEV void next() { L += 8 * nloc; }
    DEV void get(int& tm, int& tn) const { const int pn = 4 * nn, panel = L / pn, rem = L - panel * pn; tn = rem >> 2; tm = panel * 4 + (rem & 3); }
};
DEV void phase_g1(const Params& p, unsigned char* smem) {
    bf16_t* sA = (bf16_t*)smem;
    const int tid = get_tid(), lane = tid & 63, wv = tid >> 6, wr = wv >> 1, wc = wv & 1, l15 = lane & 15, quad = lane >> 4;
    const bf16_t* U = wsb(p, O_U); const bf16_t* W = wsb(p, O_WT) + W_IN;
    bf16_t* P = wsb(p, O_P);
    const float* rope = wsf(p, O_ROPE);
    constexpr int NTN = NIN / 128;
    const int wr0_ = wr, wc0_ = wc, l150_ = l15, quad0_ = quad;
    for (TileIter ti(MR / 256, NTN); ti.valid(); ti.next()) {
        int tm, tn; ti.get(tm, tn);
        const int row0 = tm * 256, col0 = tn * 128;
        f32x4 acc[8][4]; zero_acc(acc);
        gemm_core<8, 4>(U + (size_t)row0 * D, D, W + (size_t)col0 * D, D, D, acc, sA);
        int tz = 0; asm volatile("" : "+v"(tz));
        const int wr = wr0_ + tz, wc = wc0_ + tz, l15 = l150_ + tz, quad = quad0_ + tz;
        if (tn < 24) {
#pragma unroll
            for (int mt = 0; mt < 8; ++mt) {
                __builtin_amdgcn_sched_barrier(0);
                bf16_t* pp = P + (size_t)(row0 + wr * 128 + mt * 16 + l15) * PW + col0 + wc * 64 + quad * 4;
#pragma unroll
                for (int nt = 0; nt < 4; ++nt) { u32x2 o; o.x = pack2(acc[mt][nt][0], acc[mt][nt][1]); o.y = pack2(acc[mt][nt][2], acc[mt][nt][3]); *(u32x2*)(pp + nt * 16) = o; }
            }
        } else if (tn < 32) {
            const float qs = tn < 28 ? 0.125f : 1.f;
#pragma unroll
            for (int mt = 0; mt < 8; ++mt) {
                __builtin_amdgcn_sched_barrier(0);
                const int row = row0 + wr * 128 + mt * 16 + l15;
                const int s_ = row % SB;
                f32x4 ca = {1.f, 1.f, 1.f, 1.f}, sa = {0.f, 0.f, 0.f, 0.f}, cb = {1.f, 1.f, 1.f, 1.f}, sb = {0.f, 0.f, 0.f, 0.f};
                if (s_ >= CTXL) { const int tt = s_ - CTXL, pr = tt >> 6, pc = tt & 63;
                    const f32x4 r0 = *(const f32x4*)(rope + (pr * 16 + quad * 4) * 2), r1 = *(const f32x4*)(rope + (pr * 16 + quad * 4) * 2 + 4);
                    const f32x4 r2 = *(const f32x4*)(rope + (pc * 16 + quad * 4) * 2), r3 = *(const f32x4*)(rope + (pc * 16 + quad * 4) * 2 + 4);
                    ca = (f32x4){r0[0], r0[2], r1[0], r1[2]}; sa = (f32x4){r0[1], r0[3], r1[1], r1[3]};
                    cb = (f32x4){r2[0], r2[2], r3[0], r3[2]}; sb = (f32x4){r2[1], r2[3], r3[1], r3[3]}; }
                const f32x4 x1 = acc[mt][0], x2 = acc[mt][1], y1 = acc[mt][2], y2 = acc[mt][3];
                const f32x4 o0 = (x1 * ca - x2 * sa) * qs, o1 = (x2 * ca + x1 * sa) * qs, o2 = (y1 * cb - y2 * sb) * qs, o3 = (y2 * cb + y1 * sb) * qs;
                bf16_t* pp = P + (size_t)row * PW + col0 + wc * 64 + quad * 4;
                u32x2 o; o.x = pack2(o0[0], o0[1]); o.y = pack2(o0[2], o0[3]); *(u32x2*)(pp) = o;
                o.x = pack2(o1[0], o1[1]); o.y = pack2(o1[2], o1[3]); *(u32x2*)(pp + 16) = o;
                o.x = pack2(o2[0], o2[1]); o.y = pack2(o2[2], o2[3]); *(u32x2*)(pp + 32) = o;
                o.x = pack2(o3[0], o3[1]); o.y = pack2(o3[2], o3[3]); *(u32x2*)(pp + 48) = o;
            }
        } else if (tn < 36) {
            bf16_t* VT = wsb(p, O_VT);
            const int b = row0 / SB, sbase = row0 - b * SB;
#pragma unroll
            for (int mt = 0; mt < 8; ++mt) {
                __builtin_amdgcn_sched_barrier(0);
                const int s_ = sbase + wr * 128 + mt * 16 + l15;
                const int vi0 = (b * 512 + col0 - 4096 + wc * 64 + quad * 4) * SB + s_;
#pragma unroll
                for (int nt = 0; nt < 4; ++nt) {
                    const unsigned p01 = pack2(acc[mt][nt][0], acc[mt][nt][1]), p23 = pack2(acc[mt][nt][2], acc[mt][nt][3]);
                    VT[vi0 + (nt * 16 + 0) * SB] = (bf16_t)(p01 & 0xffffu); VT[vi0 + (nt * 16 + 1) * SB] = (bf16_t)(p01 >> 16);
                    VT[vi0 + (nt * 16 + 2) * SB] = (bf16_t)(p23 & 0xffffu); VT[vi0 + (nt * 16 + 3) * SB] = (bf16_t)(p23 >> 16);
                }
            }
        } else {
            if (wc == 0) {
                float* AB = wsf(p, O_AB);
#pragma unroll
                for (int mt = 0; mt < 8; ++mt) {
                    const int row = row0 + wr * 128 + mt * 16 + l15;
                    *(f32x4*)(AB + (size_t)row * 16 + quad * 4) = acc[mt][0];
                }
            }
        }
    }
}

DEV int rowtile0(int ti, bool latent_only) { if (!latent_only) return ti * 256; int b = ti >> 4, tt = ti & 15; return b * SB + CTXL + tt * 256; }
DEV int sgcol(int n, int c) { return n < 2 ? n * 1024 + c : (c < 512 ? 2048 + c : 3584 + (c - 512)); }

DEV void phase_gate(const Params& p, bool latent_only, unsigned char* smem) {
    bf16_t* sA = (bf16_t*)smem;
    const int tid = get_tid(), lane = tid & 63, wv = tid >> 6, wr = wv >> 1, wc = wv & 1, l15 = lane & 15, quad = lane >> 4;
    const bf16_t* U = wsb(p, O_U); const bf16_t* W = wsb(p, O_WT) + W_GATE;
    bf16_t* P = wsb(p, O_P);
    const int nrt = latent_only ? 128 : 136;
    for (TileIter ti(nrt, 24); ti.valid(); ti.next()) {
        int tm, tn; ti.get(tm, tn);
        const int row0 = rowtile0(tm, latent_only);
        f32x4 acc[8][4]; zero_acc(acc);
        gemm_core<8, 4>(U + (size_t)row0 * D, D, W + (size_t)tn * 128 * D, D, D, acc, sA);
        const int dcol0 = sgcol(tn >> 3, (tn & 7) * 128);
        bf16_t* ip = P + (size_t)(row0 + tid) * PW + dcol0;
#pragma unroll
        for (int mt = 0; mt < 8; ++mt) {
            __builtin_amdgcn_sched_barrier(0);
#pragma unroll
            for (int hf = 0; hf < 2; ++hf) {
                u32x4 o;
                o[0] = pack2(sigm(acc[mt][2 * hf][0]), sigm(acc[mt][2 * hf][1])); o[1] = pack2(sigm(acc[mt][2 * hf][2]), sigm(acc[mt][2 * hf][3]));
                o[2] = pack2(sigm(acc[mt][2 * hf + 1][0]), sigm(acc[mt][2 * hf + 1][1])); o[3] = pack2(sigm(acc[mt][2 * hf + 1][2]), sigm(acc[mt][2 * hf + 1][3]));
                *(u32x4*)(ip + (mt * 2 + hf) * 8) = o;
            }
        }
    }
}

DEV void phase_merge(const Params& p, bool latent_only, unsigned char* smem) {
    bf16_t* sA = (bf16_t*)smem;
    const int tid = get_tid(), lane = tid & 63, wv = tid >> 6, wr = wv >> 1, wc = wv & 1, l15 = lane & 15, quad = lane >> 4;
    const bf16_t* W = wsb(p, O_WT);
    const bf16_t* P = wsb(p, O_P);
    bf16_t* U = wsb(p, O_U);
    const int nrt = latent_only ? 128 : 136;
    for (TileIter ti(nrt, 8); ti.valid(); ti.next()) {
        int tm, tn; ti.get(tm, tn);
        const int row0 = rowtile0(tm, latent_only), col0 = tn * 128;
        f32x4 m[8][4]; zero_acc(m);
#pragma unroll 1
        for (int n = 0; n < 3; ++n) {
            f32x4 au[8][4]; zero_acc(au);
            const bf16_t* Y; int ldy;
            if (n == 0) { Y = wsb(p, O_TA) + (size_t)row0 * 512; ldy = 512; }
            else if (n == 1) { Y = P + (size_t)row0 * PW + C_LG; ldy = PW; }
            else { Y = P + (size_t)row0 * PW + C_DAQ; ldy = PW; }
            const int sc0 = sgcol(n, col0);
            gemm_core<8, 4>(Y, ldy, W + W_BR + ((size_t)n * 1024 + col0) * 512, 512, 512, au, sA);
            u32x4 sg[16];
            const bf16_t* ip = P + (size_t)(row0 + tid) * PW + sc0;
#pragma unroll
            for (int q = 0; q < 16; ++q) sg[q] = *(const u32x4*)(ip + q * 8);
#pragma unroll
            for (int mt = 0; mt < 8; ++mt)
#pragma unroll
                for (int nt = 0; nt < 4; ++nt) {
                    const unsigned g01 = sg[mt * 2 + (nt >> 1)][(nt & 1) * 2], g23 = sg[mt * 2 + (nt >> 1)][(nt & 1) * 2 + 1];
                    m[mt][nt][0] += lo16(g01) * au[mt][nt][0]; m[mt][nt][1] += hi16(g01) * au[mt][nt][1];
                    m[mt][nt][2] += lo16(g23) * au[mt][nt][2]; m[mt][nt][3] += hi16(g23) * au[mt][nt][3];
                }
        }
#pragma unroll
        for (int mt = 0; mt < 8; ++mt) {
            __builtin_amdgcn_sched_barrier(0);
            bf16_t* up = U + (size_t)(row0 + wr * 128 + mt * 16 + l15) * D + col0 + wc * 64 + quad * 4;
#pragma unroll
            for (int nt = 0; nt < 4; ++nt) { u32x2 o; o.x = pack2(m[mt][nt][0], m[mt][nt][1]); o.y = pack2(m[mt][nt][2], m[mt][nt][3]); *(u32x2*)(up + nt * 16) = o; }
        }
    }
}

DEV void phase_resid(const Params& p, int l, const bf16_t* A, int lda, const bf16_t* Wt, int K, int chunk, bool first, bool latent_only, unsigned char* smem) {
    bf16_t* sA = (bf16_t*)smem;
    const int tid = get_tid(), lane = tid & 63, wv = tid >> 6, wr = wv >> 1, wc = wv & 1, l15 = lane & 15, quad = lane >> 4;
    const int nrt = latent_only ? 128 : 136;
    for (TileIter ti(nrt, 8); ti.valid(); ti.next()) {
        int tm, tn; ti.get(tm, tn);
        const int row0 = rowtile0(tm, latent_only), col0 = tn * 128;
        f32x4 acc[8][4]; zero_acc(acc);
        gemm_core<8, 4>(A + (size_t)row0 * lda, lda, Wt + (size_t)col0 * K, K, K, acc, sA);
        const float* md = wsf(p, O_MOD) + ((size_t)l * 9 + modrow(row0)) * 6144 + chunk * D + col0 + wc * 64 + quad * 4;
        const float* hs0 = first ? xrow(p, row0) : hrow(p, row0);
        float* hd0 = hrow(p, row0);
        f32x4 mg[4];
#pragma unroll
        for (int nt = 0; nt < 4; ++nt) mg[nt] = *(const f32x4*)(md + nt * 16);
#pragma unroll
        for (int mt = 0; mt < 8; ++mt) {
            __builtin_amdgcn_sched_barrier(0);
            const size_t ro = (size_t)(wr * 128 + mt * 16 + l15) * D + col0 + wc * 64 + quad * 4;
#pragma unroll
            for (int nt = 0; nt < 4; ++nt) { const f32x4 h = *(const f32x4*)(hs0 + ro + nt * 16); *(f32x4*)(hd0 + ro + nt * 16) = h + mg[nt] * acc[mt][nt]; }
        }
    }
}
DEV void phase_gu(const Params& p, bool latent_only, unsigned char* smem) {
    bf16_t* sA = (bf16_t*)smem;
    const int tid = get_tid(), lane = tid & 63, wv = tid >> 6, wr = wv >> 1, wc = wv & 1, l15 = lane & 15, quad = lane >> 4;
    const bf16_t* U = wsb(p, O_U); const bf16_t* W = wsb(p, O_WT) + W_GU;
    bf16_t* P = wsb(p, O_P);
    const int nrt = latent_only ? 128 : 136;
    for (TileIter ti(nrt, 44); ti.valid(); ti.next()) {
        int tm, tn; ti.get(tm, tn);
        const int row0 = rowtile0(tm, latent_only);
        f32x4 acc[8][4]; zero_acc(acc);
        gemm_core<8, 4>(U + (size_t)row0 * D, D, W + (size_t)tn * 128 * D, D, D, acc, sA);
#pragma unroll
        for (int mt = 0; mt < 8; ++mt) {
            __builtin_amdgcn_sched_barrier(0);
            bf16_t* pp = P + (size_t)(row0 + wr * 128 + mt * 16 + l15) * PW + (tn * 4 + wc * 2) * 16 + quad * 4;
#pragma unroll
            for (int pr = 0; pr < 2; ++pr) {
                const f32x4 g = acc[mt][2 * pr], u = acc[mt][2 * pr + 1];
                u32x2 o; o.x = pack2(silu(g[0]) * u[0], silu(g[1]) * u[1]); o.y = pack2(silu(g[2]) * u[2], silu(g[3]) * u[3]);
                *(u32x2*)(pp + pr * 16) = o;
            }
        }
    }
}

DEV int chunk_of(int dir, int n) { return dir ? (n < 4 ? 3 - n : 71 - n) : n; }

typedef float f32x2 __attribute__((ext_vector_type(2)));
DEV void dn_solve(const float* __restrict__ Lt_s0, const bf16_t* __restrict__ colp, const float* __restrict__ mulp0, const float sg, bf16_t* __restrict__ outp,
                  bf16_t* XT_s, const bf16_t* Lb_s, const int tid, const int wv, const int l15, const int quad) {
    int vz = 0; asm volatile("" : "+v"(vz));
    const float* __restrict__ Lt_s = Lt_s0 + vz; const float* __restrict__ mulp = mulp0 + vz;
    f32x2 X0, X1, X2, X3, X4, X5, X6, X7, X8, X9, X10, X11, X12, X13, X14, X15, X16, X17, X18, X19, X20, X21, X22, X23, X24, X25, X26, X27, X28, X29, X30, X31;
    f32x4 La0, La1, La2, La3, La4, La5, La6, La7, La8, La9, La10, La11, La12, La13, La14, La15, Lb0, Lb1, Lb2, Lb3, Lb4, Lb5, Lb6, Lb7, Lb8, Lb9, Lb10, Lb11, Lb12, Lb13, Lb14, Lb15;
    X0 = (f32x2){bf2f(colp[0]) * mulp[0], bf2f(colp[136]) * mulp[1]};
    X1 = (f32x2){bf2f(colp[272]) * mulp[2], bf2f(colp[408]) * mulp[3]};
    X2 = (f32x2){bf2f(colp[544]) * mulp[4], bf2f(colp[680]) * mulp[5]};
    X3 = (f32x2){bf2f(colp[816]) * mulp[6], bf2f(colp[952]) * mulp[7]};
    X4 = (f32x2){bf2f(colp[1088]) * mulp[8], bf2f(colp[1224]) * mulp[9]};
    X5 = (f32x2){bf2f(colp[1360]) * mulp[10], bf2f(colp[1496]) * mulp[11]};
    X6 = (f32x2){bf2f(colp[1632]) * mulp[12], bf2f(colp[1768]) * mulp[13]};
    X7 = (f32x2){bf2f(colp[1904]) * mulp[14], bf2f(colp[2040]) * mulp[15]};
    X8 = (f32x2){bf2f(colp[2176]) * mulp[16], bf2f(colp[2312]) * mulp[17]};
    X9 = (f32x2){bf2f(colp[2448]) * mulp[18], bf2f(colp[2584]) * mulp[19]};
    X10 = (f32x2){bf2f(colp[2720]) * mulp[20], bf2f(colp[2856]) * mulp[21]};
    X11 = (f32x2){bf2f(colp[2992]) * mulp[22], bf2f(colp[3128]) * mulp[23]};
    X12 = (f32x2){bf2f(colp[3264]) * mulp[24], bf2f(colp[3400]) * mulp[25]};
    X13 = (f32x2){bf2f(colp[3536]) * mulp[26], bf2f(colp[3672]) * mulp[27]};
    X14 = (f32x2){bf2f(colp[3808]) * mulp[28], bf2f(colp[3944]) * mulp[29]};
    X15 = (f32x2){bf2f(colp[4080]) * mulp[30], bf2f(colp[4216]) * mulp[31]};
    X16 = (f32x2){bf2f(colp[4352]) * mulp[32], bf2f(colp[4488]) * mulp[33]};
    X17 = (f32x2){bf2f(colp[4624]) * mulp[34], bf2f(colp[4760]) * mulp[35]};
    X18 = (f32x2){bf2f(colp[4896]) * mulp[36], bf2f(colp[5032]) * mulp[37]};
    X19 = (f32x2){bf2f(colp[5168]) * mulp[38], bf2f(colp[5304]) * mulp[39]};
    X20 = (f32x2){bf2f(colp[5440]) * mulp[40], bf2f(colp[5576]) * mulp[41]};
    X21 = (f32x2){bf2f(colp[5712]) * mulp[42], bf2f(colp[5848]) * mulp[43]};
    X22 = (f32x2){bf2f(colp[5984]) * mulp[44], bf2f(colp[6120]) * mulp[45]};
    X23 = (f32x2){bf2f(colp[6256]) * mulp[46], bf2f(colp[6392]) * mulp[47]};
    X24 = (f32x2){bf2f(colp[6528]) * mulp[48], bf2f(colp[6664]) * mulp[49]};
    X25 = (f32x2){bf2f(colp[6800]) * mulp[50], bf2f(colp[6936]) * mulp[51]};
    X26 = (f32x2){bf2f(colp[7072]) * mulp[52], bf2f(colp[7208]) * mulp[53]};
    X27 = (f32x2){bf2f(colp[7344]) * mulp[54], bf2f(colp[7480]) * mulp[55]};
    X28 = (f32x2){bf2f(colp[7616]) * mulp[56], bf2f(colp[7752]) * mulp[57]};
    X29 = (f32x2){bf2f(colp[7888]) * mulp[58], bf2f(colp[8024]) * mulp[59]};
    X30 = (f32x2){bf2f(colp[8160]) * mulp[60], bf2f(colp[8296]) * mulp[61]};
    X31 = (f32x2){bf2f(colp[8432]) * mulp[62], bf2f(colp[8568]) * mulp[63]};
    __syncthreads();
    La0 = *(const f32x4*)(Lt_s + 0);
    La1 = *(const f32x4*)(Lt_s + 4);
    La2 = *(const f32x4*)(Lt_s + 8);
    La3 = *(const f32x4*)(Lt_s + 12);
    La4 = *(const f32x4*)(Lt_s + 16);
    La5 = *(const f32x4*)(Lt_s + 20);
    La6 = *(const f32x4*)(Lt_s + 24);
    La7 = *(const f32x4*)(Lt_s + 28);
    Lb0 = *(const f32x4*)(Lt_s + 68);
    Lb1 = *(const f32x4*)(Lt_s + 72);
    Lb2 = *(const f32x4*)(Lt_s + 76);
    Lb3 = *(const f32x4*)(Lt_s + 80);
    Lb4 = *(const f32x4*)(Lt_s + 84);
    Lb5 = *(const f32x4*)(Lt_s + 88);
    Lb6 = *(const f32x4*)(Lt_s + 92);
    Lb7 = *(const f32x4*)(Lt_s + 96);
    __builtin_amdgcn_sched_barrier(0);
    { const float xj = X0[0]; const f32x2 xj2 = (f32x2){xj, xj};
      X0 -= (f32x2){La0[0], La0[1]} * xj2;
      X1 -= (f32x2){La0[2], La0[3]} * xj2;
      X2 -= (f32x2){La1[0], La1[1]} * xj2;
      X3 -= (f32x2){La1[2], La1[3]} * xj2;
      X4 -= (f32x2){La2[0], La2[1]} * xj2;
      X5 -= (f32x2){La2[2], La2[3]} * xj2;
      X6 -= (f32x2){La3[0], La3[1]} * xj2;
      X7 -= (f32x2){La3[2], La3[3]} * xj2;
      X8 -= (f32x2){La4[0], La4[1]} * xj2;
      X9 -= (f32x2){La4[2], La4[3]} * xj2;
      X10 -= (f32x2){La5[0], La5[1]} * xj2;
      X11 -= (f32x2){La5[2], La5[3]} * xj2;
      X12 -= (f32x2){La6[0], La6[1]} * xj2;
      X13 -= (f32x2){La6[2], La6[3]} * xj2;
      X14 -= (f32x2){La7[0], La7[1]} * xj2;
      X15 -= (f32x2){La7[2], La7[3]} * xj2;
    }
    __builtin_amdgcn_sched_barrier(0);
    La0 = *(const f32x4*)(Lt_s + 136);
    La1 = *(const f32x4*)(Lt_s + 140);
    La2 = *(const f32x4*)(Lt_s + 144);
    La3 = *(const f32x4*)(Lt_s + 148);
    La4 = *(const f32x4*)(Lt_s + 152);
    La5 = *(const f32x4*)(Lt_s + 156);
    La6 = *(const f32x4*)(Lt_s + 160);
    La7 = *(const f32x4*)(Lt_s + 164);
    __builtin_amdgcn_sched_barrier(0);
    { const float xj = X0[1]; const f32x2 xj2 = (f32x2){xj, xj};
      X1 -= (f32x2){Lb0[2], Lb0[3]} * xj2;
      X2 -= (f32x2){Lb1[0], Lb1[1]} * xj2;
      X3 -= (f32x2){Lb1[2], Lb1[3]} * xj2;
      X4 -= (f32x2){Lb2[0], Lb2[1]} * xj2;
      X5 -= (f32x2){Lb2[2], Lb2[3]} * xj2;
      X6 -= (f32x2){Lb3[0], Lb3[1]} * xj2;
      X7 -= (f32x2){Lb3[2], Lb3[3]} * xj2;
      X8 -= (f32x2){Lb4[0], Lb4[1]} * xj2;
      X9 -= (f32x2){Lb4[2], Lb4[3]} * xj2;
      X10 -= (f32x2){Lb5[0], Lb5[1]} * xj2;
      X11 -= (f32x2){Lb5[2], Lb5[3]} * xj2;
      X12 -= (f32x2){Lb6[0], Lb6[1]} * xj2;
      X13 -= (f32x2){Lb6[2], Lb6[3]} * xj2;
      X14 -= (f32x2){Lb7[0], Lb7[1]} * xj2;
      X15 -= (f32x2){Lb7[2], Lb7[3]} * xj2;
    }
    __builtin_amdgcn_sched_barrier(0);
    Lb1 = *(const f32x4*)(Lt_s + 208);
    Lb2 = *(const f32x4*)(Lt_s + 212);
    Lb3 = *(const f32x4*)(Lt_s + 216);
    Lb4 = *(const f32x4*)(Lt_s + 220);
    Lb5 = *(const f32x4*)(Lt_s + 224);
    Lb6 = *(const f32x4*)(Lt_s + 228);
    Lb7 = *(const f32x4*)(Lt_s + 232);
    __builtin_amdgcn_sched_barrier(0);
    { const float xj = X1[0]; const f32x2 xj2 = (f32x2){xj, xj};
      X1 -= (f32x2){La0[2], La0[3]} * xj2;
      X2 -= (f32x2){La1[0], La1[1]} * xj2;
      X3 -= (f32x2){La1[2], La1[3]} * xj2;
      X4 -= (f32x2){La2[0], La2[1]} * xj2;
      X5 -= (f32x2){La2[2], La2[3]} * xj2;
      X6 -= (f32x2){La3[0], La3[1]} * xj2;
      X7 -= (f32x2){La3[2], La3[3]} * xj2;
      X8 -= (f32x2){La4[0], La4[1]} * xj2;
      X9 -= (f32x2){La4[2], La4[3]} * xj2;
      X10 -= (f32x2){La5[0], La5[1]} * xj2;
      X11 -= (f32x2){La5[2], La5[3]} * xj2;
      X12 -= (f32x2){La6[0], La6[1]} * xj2;
      X13 -= (f32x2){La6[2], La6[3]} * xj2;
      X14 -= (f32x2){La7[0], La7[1]} * xj2;
      X15 -= (f32x2){La7[2], La7[3]} * xj2;
    }
    __builtin_amdgcn_sched_barrier(0);
    La1 = *(const f32x4*)(Lt_s + 276);
    La2 = *(const f32x4*)(Lt_s + 280);
    La3 = *(const f32x4*)(Lt_s + 284);
    La4 = *(const f32x4*)(Lt_s + 288);
    La5 = *(const f32x4*)(Lt_s + 292);
    La6 = *(const f32x4*)(Lt_s + 296);
    La7 = *(const f32x4*)(Lt_s + 300);
    __builtin_amdgcn_sched_barrier(0);
    { const float xj = X1[1]; const f32x2 xj2 = (f32x2){xj, xj};
      X2 -= (f32x2){Lb1[0], Lb1[1]} * xj2;
      X3 -= (f32x2){Lb1[2], Lb1[3]} * xj2;
      X4 -= (f32x2){Lb2[0], Lb2[1]} * xj2;
      X5 -= (f32x2){Lb2[2], Lb2[3]} * xj2;
      X6 -= (f32x2){Lb3[0], Lb3[1]} * xj2;
      X7 -= (f32x2){Lb3[2], Lb3[3]} * xj2;
      X8 -= (f32x2){Lb4[0], Lb4[1]} * xj2;
      X9 -= (f32x2){Lb4[2], Lb4[3]} * xj2;
      X10 -= (f32x2){Lb5[0], Lb5[1]} * xj2;
      X11 -= (f32x2){Lb5[2], Lb5[3]} * xj2;
      X12 -= (f32x2){Lb6[0], Lb6[1]} * xj2;
      X13 -= (f32x2){Lb6[2], Lb6[3]} * xj2;
      X14 -= (f32x2){Lb7[0], Lb7[1]} * xj2;
      X15 -= (f32x2){Lb7[2], Lb7[3]} * xj2;
    }
    __builtin_amdgcn_sched_barrier(0);
    Lb1 = *(const f32x4*)(Lt_s + 344);
    Lb2 = *(const f32x4*)(Lt_s + 348);
    Lb3 = *(const f32x4*)(Lt_s + 352);
    Lb4 = *(const f32x4*)(Lt_s + 356);
    Lb5 = *(const f32x4*)(Lt_s + 360);
    Lb6 = *(const f32x4*)(Lt_s + 364);
    Lb7 = *(const f32x4*)(Lt_s + 368);
    __builtin_amdgcn_sched_barrier(0);
    { const float xj = X2[0]; const f32x2 xj2 = (f32x2){xj, xj};
      X2 -= (f32x2){La1[0], La1[1]} * xj2;
      X3 -= (f32x2){La1[2], La1[3]} * xj2;
      X4 -= (f32x2){La2[0], La2[1]} * xj2;
      X5 -= (f32x2){La2[2], La2[3]} * xj2;
      X6 -= (f32x2){La3[0], La3[1]} * xj2;
      X7 -= (f32x2){La3[2], La3[3]} * xj2;
      X8 -= (f32x2){La4[0], La4[1]} * xj2;
      X9 -= (f32x2){La4[2], La4[3]} * xj2;
      X10 -= (f32x2){La5[0], La5[1]} * xj2;
      X11 -= (f32x2){La5[2], La5[3]} * xj2;
      X12 -= (f32x2){La6[0], La6[1]} * xj2;
      X13 -= (f32x2){La6[2], La6[3]} * xj2;
      X14 -= (f32x2){La7[0], La7[1]} * xj2;
      X15 -= (f32x2){La7[2], La7[3]} * xj2;
    }
    __builtin_amdgcn_sched_barrier(0);
    La1 = *(const f32x4*)(Lt_s + 412);
    La2 = *(const f32x4*)(Lt_s + 416);
    La3 = *(const f32x4*)(Lt_s + 420);
    La4 = *(const f32x4*)(Lt_s + 424);
    La5 = *(const f32x4*)(Lt_s + 428);
    La6 = *(const f32x4*)(Lt_s + 432);
    La7 = *(const f32x4*)(Lt_s + 436);
    __builtin_amdgcn_sched_barrier(0);
    { const float xj = X2[1]; const f32x2 xj2 = (f32x2){xj, xj};
      X3 -= (f32x2){Lb1[2], Lb1[3]} * xj2;
      X4 -= (f32x2){Lb2[0], Lb2[1]} * xj2;
      X5 -= (f32x2){Lb2[2], Lb2[3]} * xj2;
      X6 -= (f32x2){Lb3[0], Lb3[1]} * xj2;
      X7 -= (f32x2){Lb3[2], Lb3[3]} * xj2;
      X8 -= (f32x2){Lb4[0], Lb4[1]} * xj2;
      X9 -= (f32x2){Lb4[2], Lb4[3]} * xj2;
      X10 -= (f32x2){Lb5[0], Lb5[1]} * xj2;
      X11 -= (f32x2){Lb5[2], Lb5[3]} * xj2;
      X12 -= (f32x2){Lb6[0], Lb6[1]} * xj2;
      X13 -= (f32x2){Lb6[2], Lb6[3]} * xj2;
      X14 -= (f32x2){Lb7[0], Lb7[1]} * xj2;
      X15 -= (f32x2){Lb7[2], Lb7[3]} * xj2;
    }
    __builtin_amdgcn_sched_barrier(0);
    Lb2 = *(const f32x4*)(Lt_s + 484);
    Lb3 = *(const f32x4*)(Lt_s + 488);
    Lb4 = *(const f32x4*)(Lt_s + 492);
    Lb5 = *(const f32x4*)(Lt_s + 496);
    Lb6 = *(const f32x4*)(Lt_s + 500);
    Lb7 = *(const f32x4*)(Lt_s + 504);
    __builtin_amdgcn_sched_barrier(0);
    { const float xj = X3[0]; const f32x2 xj2 = (f32x2){xj, xj};
      X3 -= (f32x2){La1[2], La1[3]} * xj2;
      X4 -= (f32x2){La2[0], La2[1]} * xj2;
      X5 -= (f32x2){La2[2], La2[3]} * xj2;
      X6 -= (f32x2){La3[0], La3[1]} * xj2;
      X7 -= (f32x2){La3[2], La3[3]} * xj2;
      X8 -= (f32x2){La4[0], La4[1]} * xj2;
      X9 -= (f32x2){La4[2], La4[3]} * xj2;
      X10 -= (f32x2){La5[0], La5[1]} * xj2;
      X11 -= (f32x2){La5[2], La5[3]} * xj2;
      X12 -= (f32x2){La6[0], La6[1]} * xj2;
      X13 -= (f32x2){La6[2], La6[3]} * xj2;
      X14 -= (f32x2){La7[0], La7[1]} * xj2;
      X15 -= (f32x2){La7[2], La7[3]} * xj2;
    }
    __builtin_amdgcn_sched_barrier(0);
    La2 = *(const f32x4*)(Lt_s + 552);
    La3 = *(const f32x4*)(Lt_s + 556);
    La4 = *(const f32x4*)(Lt_s + 560);
    La5 = *(const f32x4*)(Lt_s + 564);
    La6 = *(const f32x4*)(Lt_s + 568);
    La7 = *(const f32x4*)(Lt_s + 572);
    __builtin_amdgcn_sched_barrier(0);
    { const float xj = X3[1]; const f32x2 xj2 = (f32x2){xj, xj};
      X4 -= (f32x2){Lb2[0], Lb2[1]} * xj2;
      X5 -= (f32x2){Lb2[2], Lb2[3]} * xj2;
      X6 -= (f32x2){Lb3[0], Lb3[1]} * xj2;
      X7 -= (f32x2){Lb3[2], Lb3[3]} * xj2;
      X8 -= (f32x2){Lb4[0], Lb4[1]} * xj2;
      X9 -= (f32x2){Lb4[2], Lb4[3]} * xj2;
      X10 -= (f32x2){Lb5[0], Lb5[1]} * xj2;
      X11 -= (f32x2){Lb5[2], Lb5[3]} * xj2;
      X12 -= (f32x2){Lb6[0], Lb6[1]} * xj2;
      X13 -= (f32x2){Lb6[2], Lb6[3]} * xj2;
      X14 -= (f32x2){Lb7[0], Lb7[1]} * xj2;
      X15 -= (f32x2){Lb7[2], Lb7[3]} * xj2;
    }
    __builtin_amdgcn_sched_barrier(0);
    Lb2 = *(const f32x4*)(Lt_s + 620);
    Lb3 = *(const f32x4*)(Lt_s + 624);
    Lb4 = *(const f32x4*)(Lt_s + 628);
    Lb5 = *(const f32x4*)(Lt_s + 632);
    Lb6 = *(const f32x4*)(Lt_s + 636);
    Lb7 = *(const f32x4*)(Lt_s + 640);
    __builtin_amdgcn_sched_barrier(0);
    { const float xj = X4[0]; const f32x2 xj2 = (f32x2){xj, xj};
      X4 -= (f32x2){La2[0], La2[1]} * xj2;
      X5 -= (f32x2){La2[2], La2[3]} * xj2;
      X6 -= (f32x2){La3[0], La3[1]} * xj2;
      X7 -= (f32x2){La3[2], La3[3]} * xj2;
      X8 -= (f32x2){La4[0], La4[1]} * xj2;
      X9 -= (f32x2){La4[2], La4[3]} * xj2;
      X10 -= (f32x2){La5[0], La5[1]} * xj2;
      X11 -= (f32x2){La5[2], La5[3]} * xj2;
      X12 -= (f32x2){La6[0], La6[1]} * xj2;
      X13 -= (f32x2){La6[2], La6[3]} * xj2;
      X14 -= (f32x2){La7[0], La7[1]} * xj2;
      X15 -= (f32x2){La7[2], La7[3]} * xj2;
    }
    __builtin_amdgcn_sched_barrier(0);
    La2 = *(const f32x4*)(Lt_s + 688);
    La3 = *(const f32x4*)(Lt_s + 692);
    La4 = *(const f32x4*)(Lt_s + 696);
    La5 = *(const f32x4*)(Lt_s + 700);
    La6 = *(const f32x4*)(Lt_s + 704);
    La7 = *(const f32x4*)(Lt_s + 708);
    __builtin_amdgcn_sched_barrier(0);
    { const float xj = X4[1]; const f32x2 xj2 = (f32x2){xj, xj};
      X5 -= (f32x2){Lb2[2], Lb2[3]} * xj2;
      X6 -= (f32x2){Lb3[0], Lb3[1]} * xj2;
      X7 -= (f32x2){Lb3[2], Lb3[3]} * xj2;
      X8 -= (f32x2){Lb4[0], Lb4[1]} * xj2;
      X9 -= (f32x2){Lb4[2], Lb4[3]} * xj2;
      X10 -= (f32x2){Lb5[0], Lb5[1]} * xj2;
      X11 -= (f32x2){Lb5[2], Lb5[3]} * xj2;
      X12 -= (f32x2){Lb6[0], Lb6[1]} * xj2;
      X13 -= (f32x2){Lb6[2], Lb6[3]} * xj2;
      X14 -= (f32x2){Lb7[0], Lb7[1]} * xj2;
      X15 -= (f32x2){Lb7[2], Lb7[3]} * xj2;
    }
    __builtin_amdgcn_sched_barrier(0);
    Lb3 = *(const f32x4*)(Lt_s + 760);
    Lb4 = *(const f32x4*)(Lt_s + 764);
    Lb5 = *(const f32x4*)(Lt_s + 768);
    Lb6 = *(const f32x4*)(Lt_s + 772);
    Lb7 = *(const f32x4*)(Lt_s + 776);
    __builtin_amdgcn_sched_barrier(0);
    { const float xj = X5[0]; const f32x2 xj2 = (f32x2){xj, xj};
      X5 -= (f32x2){La2[2], La2[3]} * xj2;
      X6 -= (f32x2){La3[0], La3[1]} * xj2;
      X7 -= (f32x2){La3[2], La3[3]} * xj2;
      X8 -= (f32x2){La4[0], La4[1]} * xj2;
      X9 -= (f32x2){La4[2], La4[3]} * xj2;
      X10 -= (f32x2){La5[0], La5[1]} * xj2;
      X11 -= (f32x2){La5[2], La5[3]} * xj2;
      X12 -= (f32x2){La6[0], La6[1]} * xj2;
      X13 -= (f32x2){La6[2], La6[3]} * xj2;
      X14 -= (f32x2){La7[0], La7[1]} * xj2;
      X15 -= (f32x2){La7[2], La7[3]} * xj2;
    }
    __builtin_amdgcn_sched_barrier(0);
    La3 = *(const f32x4*)(Lt_s + 828);
    La4 = *(const f32x4*)(Lt_s + 832);
    La5 = *(const f32x4*)(Lt_s + 836);
    La6 = *(const f32x4*)(Lt_s + 840);
    La7 = *(const f32x4*)(Lt_s + 844);
    __builtin_amdgcn_sched_barrier(0);
    { const float xj = X5[1]; const f32x2 xj2 = (f32x2){xj, xj};
      X6 -= (f32x2){Lb3[0], Lb3[1]} * xj2;
      X7 -= (f32x2){Lb3[2], Lb3[3]} * xj2;
      X8 -= (f32x2){Lb4[0], Lb4[1]} * xj2;
      X9 -= (f32x2){Lb4[2], Lb4[3]} * xj2;
      X10 -= (f32x2){Lb5[0], Lb5[1]} * xj2;
      X11 -= (f32x2){Lb5[2], Lb5[3]} * xj2;
      X12 -= (f32x2){Lb6[0], Lb6[1]} * xj2;
      X13 -= (f32x2){Lb6[2], Lb6[3]} * xj2;
      X14 -= (f32x2){Lb7[0], Lb7[1]} * xj2;
      X15 -= (f32x2){Lb7[2], Lb7[3]} * xj2;
    }
    __builtin_amdgcn_sched_barrier(0);
    Lb3 = *(const f32x4*)(Lt_s + 896);
    Lb4 = *(const f32x4*)(Lt_s + 900);
    Lb5 = *(const f32x4*)(Lt_s + 904);
    Lb6 = *(const f32x4*)(Lt_s + 908);
    Lb7 = *(const f32x4*)(Lt_s + 912);
    __builtin_amdgcn_sched_barrier(0);
    { const float xj = X6[0]; const f32x2 xj2 = (f32x2){xj, xj};
      X6 -= (f32x2){La3[0], La3[1]} * xj2;
      X7 -= (f32x2){La3[2], La3[3]} * xj2;
      X8 -= (f32x2){La4[0], La4[1]} * xj2;
      X9 -= (f32x2){La4[2], La4[3]} * xj2;
      X10 -= (f32x2){La5[0], La5[1]} * xj2;
      X11 -= (f32x2){La5[2], La5[3]} * xj2;
      X12 -= (f32x2){La6[0], La6[1]} * xj2;
      X13 -= (f32x2){La6[2], La6[3]} * xj2;
      X14 -= (f32x2){La7[0], La7[1]} * xj2;
      X15 -= (f32x2){La7[2], La7[3]} * xj2;
    }
    __builtin_amdgcn_sched_barrier(0);
    La3 = *(const f32x4*)(Lt_s + 964);
    La4 = *(const f32x4*)(Lt_s + 968);
    La5 = *(const f32x4*)(Lt_s + 972);
    La6 = *(const f32x4*)(Lt_s + 976);
    La7 = *(const f32x4*)(Lt_s + 980);
    __builtin_amdgcn_sched_barrier(0);
    { const float xj = X6[1]; const f32x2 xj2 = (f32x2){xj, xj};
      X7 -= (f32x2){Lb3[2], Lb3[3]} * xj2;
      X8 -= (f32x2){Lb4[0], Lb4[1]} * xj2;
      X9 -= (f32x2){Lb4[2], Lb4[3]} * xj2;
      X10 -= (f32x2){Lb5[0], Lb5[1]} * xj2;
      X11 -= (f32x2){Lb5[2], Lb5[3]} * xj2;
      X12 -= (f32x2){Lb6[0], Lb6[1]} * xj2;
      X13 -= (f32x2){Lb6[2], Lb6[3]} * xj2;
      X14 -= (f32x2){Lb7[0], Lb7[1]} * xj2;
      X15 -= (f32x2){Lb7[2], Lb7[3]} * xj2;
    }
    __builtin_amdgcn_sched_barrier(0);
    Lb4 = *(const f32x4*)(Lt_s + 1036);
    Lb5 = *(const f32x4*)(Lt_s + 1040);
    Lb6 = *(const f32x4*)(Lt_s + 1044);
    Lb7 = *(const f32x4*)(Lt_s + 1048);
    __builtin_amdgcn_sched_barrier(0);
    { const float xj = X7[0]; const f32x2 xj2 = (f32x2){xj, xj};
      X7 -= (f32x2){La3[2], La3[3]} * xj2;
      X8 -= (f32x2){La4[0], La4[1]} * xj2;
      X9 -= (f32x2){La4[2], La4[3]} * xj2;
      X10 -= (f32x2){La5[0], La5[1]} * xj2;
      X11 -= (f32x2){La5[2], La5[3]} * xj2;
      X12 -= (f32x2){La6[0], La6[1]} * xj2;
      X13 -= (f32x2){La6[2], La6[3]} * xj2;
      X14 -= (f32x2){La7[0], La7[1]} * xj2;
      X15 -= (f32x2){La7[2], La7[3]} * xj2;
    }
    __builtin_amdgcn_sched_barrier(0);
    La4 = *(const f32x4*)(Lt_s + 1104);
    La5 = *(const f32x4*)(Lt_s + 1108);
    La6 = *(const f32x4*)(Lt_s + 1112);
    La7 = *(const f32x4*)(Lt_s + 1116);
    __builtin_amdgcn_sched_barrier(0);
    { const float xj = X7[1]; const f32x2 xj2 = (f32x2){xj, xj};
      X8 -= (f32x2){Lb4[0], Lb4[1]} * xj2;
      X9 -= (f32x2){Lb4[2], Lb4[3]} * xj2;
      X10 -= (f32x2){Lb5[0], Lb5[1]} * xj2;
      X11 -= (f32x2){Lb5[2], Lb5[3]} * xj2;
      X12 -= (f32x2){Lb6[0], Lb6[1]} * xj2;
      X13 -= (f32x2){Lb6[2], Lb6[3]} * xj2;
      X14 -= (f32x2){Lb7[0], Lb7[1]} * xj2;
      X15 -= (f32x2){Lb7[2], Lb7[3]} * xj2;
    }
    __builtin_amdgcn_sched_barrier(0);
    Lb4 = *(const f32x4*)(Lt_s + 1172);
    Lb5 = *(const f32x4*)(Lt_s + 1176);
    Lb6 = *(const f32x4*)(Lt_s + 1180);
    Lb7 = *(const f32x4*)(Lt_s + 1184);
    __builtin_amdgcn_sched_barrier(0);
    { const float xj = X8[0]; const f32x2 xj2 = (f32x2){xj, xj};
      X8 -= (f32x2){La4[0], La4[1]} * xj2;
      X9 -= (f32x2){La4[2], La4[3]} * xj2;
      X10 -= (f32x2){La5[0], La5[1]} * xj2;
      X11 -= (f32x2){La5[2], La5[3]} * xj2;
      X12 -= (f32x2){La6[0], La6[1]} * xj2;
      X13 -= (f32x2){La6[2], La6[3]} * xj2;
      X14 -= (f32x2){La7[0], La7[1]} * xj2;
      X15 -= (f32x2){La7[2], La7[3]} * xj2;
    }
    __builtin_amdgcn_sched_barrier(0);
    La4 = *(const f32x4*)(Lt_s + 1240);
    La5 = *(const f32x4*)(Lt_s + 1244);
    La6 = *(const f32x4*)(Lt_s + 1248);
    La7 = *(const f32x4*)(Lt_s + 1252);
    __builtin_amdgcn_sched_barrier(0);
    { const float xj = X8[1]; const f32x2 xj2 = (f32x2){xj, xj};
      X9 -= (f32x2){Lb4[2], Lb4[3]} * xj2;
      X10 -= (f32x2){Lb5[0], Lb5[1]} * xj2;
      X11 -= (f32x2){Lb5[2], Lb5[3]} * xj2;
      X12 -= (f32x2){Lb6[0], Lb6[1]} * xj2;
      X13 -= (f32x2){Lb6[2], Lb6[3]} * xj2;
      X14 -= (f32x2){Lb7[0], Lb7[1]} * xj2;
      X15 -= (f32x2){Lb7[2], Lb7[3]} * xj2;
    }
    __builtin_amdgcn_sched_barrier(0);
    Lb5 = *(const f32x4*)(Lt_s + 1312);
    Lb6 = *(const f32x4*)(Lt_s + 1316);
    Lb7 = *(const f32x4*)(Lt_s + 1320);
    __builtin_amdgcn_sched_barrier(0);
    { const float xj = X9[0]; const f32x2 xj2 = (f32x2){xj, xj};
      X9 -= (f32x2){La4[2], La4[3]} * xj2;
      X10 -= (f32x2){La5[0], La5[1]} * xj2;
      X11 -= (f32x2){La5[2], La5[3]} * xj2;
      X12 -= (f32x2){La6[0], La6[1]} * xj2;
      X13 -= (f32x2){La6[2], La6[3]} * xj2;
      X14 -= (f32x2){La7[0], La7[1]} * xj2;
      X15 -= (f32x2){La7[2], La7[3]} * xj2;
    }
    __builtin_amdgcn_sched_barrier(0);
    La5 = *(const f32x4*)(Lt_s + 1380);
    La6 = *(const f32x4*)(Lt_s + 1384);
    La7 = *(const f32x4*)(Lt_s + 1388);
    __builtin_amdgcn_sched_barrier(0);
    { const float xj = X9[1]; const f32x2 xj2 = (f32x2){xj, xj};
      X10 -= (f32x2){Lb5[0], Lb5[1]} * xj2;
      X11 -= (f32x2){Lb5[2], Lb5[3]} * xj2;
      X12 -= (f32x2){Lb6[0], Lb6[1]} * xj2;
      X13 -= (f32x2){Lb6[2], Lb6[3]} * xj2;
      X14 -= (f32x2){Lb7[0], Lb7[1]} * xj2;
      X15 -= (f32x2){Lb7[2], Lb7[3]} * xj2;
    }
    __builtin_amdgcn_sched_barrier(0);
    Lb5 = *(const f32x4*)(Lt_s + 1448);
    Lb6 = *(const f32x4*)(Lt_s + 1452);
    Lb7 = *(const f32x4*)(Lt_s + 1456);
    __builtin_amdgcn_sched_barrier(0);
    { const float xj = X10[0]; const f32x2 xj2 = (f32x2){xj, xj};
      X10 -= (f32x2){La5[0], La5[1]} * xj2;
      X11 -= (f32x2){La5[2], La5[3]} * xj2;
      X12 -= (f32x2){La6[0], La6[1]} * xj2;
      X13 -= (f32x2){La6[2], La6[3]} * xj2;
      X14 -= (f32x2){La7[0], La7[1]} * xj2;
      X15 -= (f32x2){La7[2], La7[3]} * xj2;
    }
    __builtin_amdgcn_sched_barrier(0);
    La5 = *(const f32x4*)(Lt_s + 1516);
    La6 = *(const f32x4*)(Lt_s + 1520);
    La7 = *(const f32x4*)(Lt_s + 1524);
    __builtin_amdgcn_sched_barrier(0);
    { const float xj = X10[1]; const f32x2 xj2 = (f32x2){xj, xj};
      X11 -= (f32x2){Lb5[2], Lb5[3]} * xj2;
      X12 -= (f32x2){Lb6[0], Lb6[1]} * xj2;
      X13 -= (f32x2){Lb6[2], Lb6[3]} * xj2;
      X14 -= (f32x2){Lb7[0], Lb7[1]} * xj2;
      X15 -= (f32x2){Lb7[2], Lb7[3]} * xj2;
    }
    __builtin_amdgcn_sched_barrier(0);
    Lb6 = *(const f32x4*)(Lt_s + 1588);
    Lb7 = *(const f32x4*)(Lt_s + 1592);
    __builtin_amdgcn_sched_barrier(0);
    { const float xj = X11[0]; const f32x2 xj2 = (f32x2){xj, xj};
      X11 -= (f32x2){La5[2], La5[3]} * xj2;
      X12 -= (f32x2){La6[0], La6[1]} * xj2;
      X13 -= (f32x2){La6[2], La6[3]} * xj2;
      X14 -= (f32x2){La7[0], La7[1]} * xj2;
      X15 -= (f32x2){La7[2], La7[3]} * xj2;
    }
    __builtin_amdgcn_sched_barrier(0);
    La6 = *(const f32x4*)(Lt_s + 1656);
    La7 = *(const f32x4*)(Lt_s + 1660);
    __builtin_amdgcn_sched_barrier(0);
    { const float xj = X11[1]; const f32x2 xj2 = (f32x2){xj, xj};
      X12 -= (f32x2){Lb6[0], Lb6[1]} * xj2;
      X13 -= (f32x2){Lb6[2], Lb6[3]} * xj2;
      X14 -= (f32x2){Lb7[0], Lb7[1]} * xj2;
      X15 -= (f32x2){Lb7[2], Lb7[3]} * xj2;
    }
    __builtin_amdgcn_sched_barrier(0);
    Lb6 = *(const f32x4*)(Lt_s + 1724);
    Lb7 = *(const f32x4*)(Lt_s + 1728);
    __builtin_amdgcn_sched_barrier(0);
    { const float xj = X12[0]; const f32x2 xj2 = (f32x2){xj, xj};
      X12 -= (f32x2){La6[0], La6[1]} * xj2;
      X13 -= (f32x2){La6[2], La6[3]} * xj2;
      X14 -= (f32x2){La7[0], La7[1]} * xj2;
      X15 -= (f32x2){La7[2], La7[3]} * xj2;
    }
    __builtin_amdgcn_sched_barrier(0);
    La6 = *(const f32x4*)(Lt_s + 1792);
    La7 = *(const f32x4*)(Lt_s + 1796);
    __builtin_amdgcn_sched_barrier(0);
    { const float xj = X12[1]; const f32x2 xj2 = (f32x2){xj, xj};
      X13 -= (f32x2){Lb6[2], Lb6[3]} * xj2;
      X14 -= (f32x2){Lb7[0], Lb7[1]} * xj2;
      X15 -= (f32x2){Lb7[2], Lb7[3]} * xj2;
    }
    __builtin_amdgcn_sched_barrier(0);
    Lb7 = *(const f32x4*)(Lt_s + 1864);
    __builtin_amdgcn_sched_barrier(0);
    { const float xj = X13[0]; const f32x2 xj2 = (f32x2){xj, xj};
      X13 -= (f32x2){La6[2], La6[3]} * xj2;
      X14 -= (f32x2){La7[0], La7[1]} * xj2;
      X15 -= (f32x2){La7[2], La7[3]} * xj2;
    }
    __builtin_amdgcn_sched_barrier(0);
    La7 = *(const f32x4*)(Lt_s + 1932);
    __builtin_amdgcn_sched_barrier(0);
    { const float xj = X13[1]; const f32x2 xj2 = (f32x2){xj, xj};
      X14 -= (f32x2){Lb7[0], Lb7[1]} * xj2;
      X15 -= (f32x2){Lb7[2], Lb7[3]} * xj2;
    }
    __builtin_amdgcn_sched_barrier(0);
    Lb7 = *(const f32x4*)(Lt_s + 2000);
    __builtin_amdgcn_sched_barrier(0);
    { const float xj = X14[0]; const f32x2 xj2 = (f32x2){xj, xj};
      X14 -= (f32x2){La7[0], La7[1]} * xj2;
      X15 -= (f32x2){La7[2], La7[3]} * xj2;
    }
    __builtin_amdgcn_sched_barrier(0);
    La7 = *(const f32x4*)(Lt_s + 2068);
    __builtin_amdgcn_sched_barrier(0);
    { const float xj = X14[1]; const f32x2 xj2 = (f32x2){xj, xj};
      X15 -= (f32x2){Lb7[2], Lb7[3]} * xj2;
    }
    __builtin_amdgcn_sched_barrier(0);
    __builtin_amdgcn_sched_barrier(0);
    { const float xj = X15[0]; const f32x2 xj2 = (f32x2){xj, xj};
      X15 -= (f32x2){La7[2], La7[3]} * xj2;
    }
    __builtin_amdgcn_sched_barrier(0);
    {
        bf16_t* xr = XT_s + tid * 32;
        { u32x4 o = {pack2(X0[0], X0[1]), pack2(X1[0], X1[1]), pack2(X2[0], X2[1]), pack2(X3[0], X3[1])}; *(u32x4*)(xr + 0) = o; }
        { u32x4 o = {pack2(X4[0], X4[1]), pack2(X5[0], X5[1]), pack2(X6[0], X6[1]), pack2(X7[0], X7[1])}; *(u32x4*)(xr + 8) = o; }
        { u32x4 o = {pack2(X8[0], X8[1]), pack2(X9[0], X9[1]), pack2(X10[0], X10[1]), pack2(X11[0], X11[1])}; *(u32x4*)(xr + 16) = o; }
        { u32x4 o = {pack2(X12[0], X12[1]), pack2(X13[0], X13[1]), pack2(X14[0], X14[1]), pack2(X15[0], X15[1])}; *(u32x4*)(xr + 24) = o; }
        bf16x8 lb0 = *(const bf16x8*)(Lb_s + (0 + l15) * 40 + quad * 8), lb1 = *(const bf16x8*)(Lb_s + (16 + l15) * 40 + quad * 8);
        f32x4 d[4][2];
#pragma unroll
        for (int ct = 0; ct < 4; ++ct) {
            const bf16x8 xt = *(const bf16x8*)(XT_s + (wv * 64 + ct * 16 + l15) * 32 + quad * 8);
            d[ct][0] = mfma16(lb0, xt, (f32x4){0.f, 0.f, 0.f, 0.f}); d[ct][1] = mfma16(lb1, xt, (f32x4){0.f, 0.f, 0.f, 0.f});
        }
#pragma unroll
        for (int ct = 0; ct < 4; ++ct)
#pragma unroll
            for (int it = 0; it < 2; ++it) { u32x2 o; o.x = pack2(d[ct][it][0], d[ct][it][1]); o.y = pack2(d[ct][it][2], d[ct][it][3]);
                *(u32x2*)(XT_s + (wv * 64 + ct * 16 + l15) * 32 + it * 16 + quad * 4) = o; }
        { const u32x4 u = *(const u32x4*)(xr + 0);
          X16 -= (f32x2){lo16(u[0]), hi16(u[0])};
          X17 -= (f32x2){lo16(u[1]), hi16(u[1])};
          X18 -= (f32x2){lo16(u[2]), hi16(u[2])};
          X19 -= (f32x2){lo16(u[3]), hi16(u[3])};
        }
        { const u32x4 u = *(const u32x4*)(xr + 8);
          X20 -= (f32x2){lo16(u[0]), hi16(u[0])};
          X21 -= (f32x2){lo16(u[1]), hi16(u[1])};
          X22 -= (f32x2){lo16(u[2]), hi16(u[2])};
          X23 -= (f32x2){lo16(u[3]), hi16(u[3])};
        }
        { const u32x4 u = *(const u32x4*)(xr + 16);
          X24 -= (f32x2){lo16(u[0]), hi16(u[0])};
          X25 -= (f32x2){lo16(u[1]), hi16(u[1])};
          X26 -= (f32x2){lo16(u[2]), hi16(u[2])};
          X27 -= (f32x2){lo16(u[3]), hi16(u[3])};
        }
        { const u32x4 u = *(const u32x4*)(xr + 24);
          X28 -= (f32x2){lo16(u[0]), hi16(u[0])};
          X29 -= (f32x2){lo16(u[1]), hi16(u[1])};
          X30 -= (f32x2){lo16(u[2]), hi16(u[2])};
          X31 -= (f32x2){lo16(u[3]), hi16(u[3])};
        }
    }
    La8 = *(const f32x4*)(Lt_s + 2208);
    La9 = *(const f32x4*)(Lt_s + 2212);
    La10 = *(const f32x4*)(Lt_s + 2216);
    La11 = *(const f32x4*)(Lt_s + 2220);
    La12 = *(const f32x4*)(Lt_s + 2224);
    La13 = *(const f32x4*)(Lt_s + 2228);
    La14 = *(const f32x4*)(Lt_s + 2232);
    La15 = *(const f32x4*)(Lt_s + 2236);
    Lb8 = *(const f32x4*)(Lt_s + 2276);
    Lb9 = *(const f32x4*)(Lt_s + 2280);
    Lb10 = *(const f32x4*)(Lt_s + 2284);
    Lb11 = *(const f32x4*)(Lt_s + 2288);
    Lb12 = *(const f32x4*)(Lt_s + 2292);
    Lb13 = *(const f32x4*)(Lt_s + 2296);
    Lb14 = *(const f32x4*)(Lt_s + 2300);
    Lb15 = *(const f32x4*)(Lt_s + 2304);
    __builtin_amdgcn_sched_barrier(0);
    { const float xj = X16[0]; const f32x2 xj2 = (f32x2){xj, xj};
      X16 -= (f32x2){La8[0], La8[1]} * xj2;
      X17 -= (f32x2){La8[2], La8[3]} * xj2;
      X18 -= (f32x2){La9[0], La9[1]} * xj2;
      X19 -= (f32x2){La9[2], La9[3]} * xj2;
      X20 -= (f32x2){La10[0], La10[1]} * xj2;
      X21 -= (f32x2){La10[2], La10[3]} * xj2;
      X22 -= (f32x2){La11[0], La11[1]} * xj2;
      X23 -= (f32x2){La11[2], La11[3]} * xj2;
      X24 -= (f32x2){La12[0], La12[1]} * xj2;
      X25 -= (f32x2){La12[2], La12[3]} * xj2;
      X26 -= (f32x2){La13[0], La13[1]} * xj2;
      X27 -= (f32x2){La13[2], La13[3]} * xj2;
      X28 -= (f32x2){La14[0], La14[1]} * xj2;
      X29 -= (f32x2){La14[2], La14[3]} * xj2;
      X30 -= (f32x2){La15[0], La15[1]} * xj2;
      X31 -= (f32x2){La15[2], La15[3]} * xj2;
    }
    __builtin_amdgcn_sched_barrier(0);
    La8 = *(const f32x4*)(Lt_s + 2344);
    La9 = *(const f32x4*)(Lt_s + 2348);
    La10 = *(const f32x4*)(Lt_s + 2352);
    La11 = *(const f32x4*)(Lt_s + 2356);
    La12 = *(const f32x4*)(Lt_s + 2360);
    La13 = *(const f32x4*)(Lt_s + 2364);
    La14 = *(const f32x4*)(Lt_s + 2368);
    La15 = *(const f32x4*)(Lt_s + 2372);
    __builtin_amdgcn_sched_barrier(0);
    { const float xj = X16[1]; const f32x2 xj2 = (f32x2){xj, xj};
      X17 -= (f32x2){Lb8[2], Lb8[3]} * xj2;
      X18 -= (f32x2){Lb9[0], Lb9[1]} * xj2;
      X19 -= (f32x2){Lb9[2], Lb9[3]} * xj2;
      X20 -= (f32x2){Lb10[0], Lb10[1]} * xj2;
      X21 -= (f32x2){Lb10[2], Lb10[3]} * xj2;
      X22 -= (f32x2){Lb11[0], Lb11[1]} * xj2;
      X23 -= (f32x2){Lb11[2], Lb11[3]} * xj2;
      X24 -= (f32x2){Lb12[0], Lb12[1]} * xj2;
      X25 -= (f32x2){Lb12[2], Lb12[3]} * xj2;
      X26 -= (f32x2){Lb13[0], Lb13[1]} * xj2;
      X27 -= (f32x2){Lb13[2], Lb13[3]} * xj2;
      X28 -= (f32x2){Lb14[0], Lb14[1]} * xj2;
      X29 -= (f32x2){Lb14[2], Lb14[3]} * xj2;
      X30 -= (f32x2){Lb15[0], Lb15[1]} * xj2;
      X31 -= (f32x2){Lb15[2], Lb15[3]} * xj2;
    }
    __builtin_amdgcn_sched_barrier(0);
    Lb9 = *(const f32x4*)(Lt_s + 2416);
    Lb10 = *(const f32x4*)(Lt_s + 2420);
    Lb11 = *(const f32x4*)(Lt_s + 2424);
    Lb12 = *(const f32x4*)(Lt_s + 2428);
    Lb13 = *(const f32x4*)(Lt_s + 2432);
    Lb14 = *(const f32x4*)(Lt_s + 2436);
    Lb15 = *(const f32x4*)(Lt_s + 2440);
    __builtin_amdgcn_sched_barrier(0);
    { const float xj = X17[0]; const f32x2 xj2 = (f32x2){xj, xj};
      X17 -= (f32x2){La8[2], La8[3]} * xj2;
      X18 -= (f32x2){La9[0], La9[1]} * xj2;
      X19 -= (f32x2){La9[2], La9[3]} * xj2;
      X20 -= (f32x2){La10[0], La10[1]} * xj2;
      X21 -= (f32x2){La10[2], La10[3]} * xj2;
      X22 -= (f32x2){La11[0], La11[1]} * xj2;
      X23 -= (f32x2){La11[2], La11[3]} * xj2;
      X24 -= (f32x2){La12[0], La12[1]} * xj2;
      X25 -= (f32x2){La12[2], La12[3]} * xj2;
      X26 -= (f32x2){La13[0], La13[1]} * xj2;
      X27 -= (f32x2){La13[2], La13[3]} * xj2;
      X28 -= (f32x2){La14[0], La14[1]} * xj2;
      X29 -= (f32x2){La14[2], La14[3]} * xj2;
      X30 -= (f32x2){La15[0], La15[1]} * xj2;
      X31 -= (f32x2){La15[2], La15[3]} * xj2;
    }
    __builtin_amdgcn_sched_barrier(0);
    La9 = *(const f32x4*)(Lt_s + 2484);
    La10 = *(const f32x4*)(Lt_s + 2488);
    La11 = *(const f32x4*)(Lt_s + 2492);
    La12 = *(const f32x4*)(Lt_s + 2496);
    La13 = *(const f32x4*)(Lt_s + 2500);
    La14 = *(const f32x4*)(Lt_s + 2504);
    La15 = *(const f32x4*)(Lt_s + 2508);
    __builtin_amdgcn_sched_barrier(0);
    { const float xj = X17[1]; const f32x2 xj2 = (f32x2){xj, xj};
      X18 -= (f32x2){Lb9[0], Lb9[1]} * xj2;
      X19 -= (f32x2){Lb9[2], Lb9[3]} * xj2;
      X20 -= (f32x2){Lb10[0], Lb10[1]} * xj2;
      X21 -= (f32x2){Lb10[2], Lb10[3]} * xj2;
      X22 -= (f32x2){Lb11[0], Lb11[1]} * xj2;
      X23 -= (f32x2){Lb11[2], Lb11[3]} * xj2;
      X24 -= (f32x2){Lb12[0], Lb12[1]} * xj2;
      X25 -= (f32x2){Lb12[2], Lb12[3]} * xj2;
      X26 -= (f32x2){Lb13[0], Lb13[1]} * xj2;
      X27 -= (f32x2){Lb13[2], Lb13[3]} * xj2;
      X28 -= (f32x2){Lb14[0], Lb14[1]} * xj2;
      X29 -= (f32x2){Lb14[2], Lb14[3]} * xj2;
      X30 -= (f32x2){Lb15[0], Lb15[1]} * xj2;
      X31 -= (f32x2){Lb15[2], Lb15[3]} * xj2;
    }
    __builtin_amdgcn_sched_barrier(0);
    Lb9 = *(const f32x4*)(Lt_s + 2552);
    Lb10 = *(const f32x4*)(Lt_s + 2556);
    Lb11 = *(const f32x4*)(Lt_s + 2560);
    Lb12 = *(const f32x4*)(Lt_s + 2564);
    Lb13 = *(const f32x4*)(Lt_s + 2568);
    Lb14 = *(const f32x4*)(Lt_s + 2572);
    Lb15 = *(const f32x4*)(Lt_s + 2576);
    __builtin_amdgcn_sched_barrier(0);
    { const float xj = X18[0]; const f32x2 xj2 = (f32x2){xj, xj};
      X18 -= (f32x2){La9[0], La9[1]} * xj2;
      X19 -= (f32x2){La9[2], La9[3]} * xj2;
      X20 -= (f32x2){La10[0], La10[1]} * xj2;
      X21 -= (f32x2){La10[2], La10[3]} * xj2;
      X22 -= (f32x2){La11[0], La11[1]} * xj2;
      X23 -= (f32x2){La11[2], La11[3]} * xj2;
      X24 -= (f32x2){La12[0], La12[1]} * xj2;
      X25 -= (f32x2){La12[2], La12[3]} * xj2;
      X26 -= (f32x2){La13[0], La13[1]} * xj2;
      X27 -= (f32x2){La13[2], La13[3]} * xj2;
      X28 -= (f32x2){La14[0], La14[1]} * xj2;
      X29 -= (f32x2){La14[2], La14[3]} * xj2;
      X30 -= (f32x2){La15[0], La15[1]} * xj2;
      X31 -= (f32x2){La15[2], La15[3]} * xj2;
    }
    __builtin_amdgcn_sched_barrier(0);
    La9 = *(const f32x4*)(Lt_s + 2620);
    La10 = *(const f32x4*)(Lt_s + 2624);
    La11 = *(const f32x4*)(Lt_s + 2628);
    La12 = *(const f32x4*)(Lt_s + 2632);
    La13 = *(const f32x4*)(Lt_s + 2636);
    La14 = *(const f32x4*)(Lt_s + 2640);
    La15 = *(const f32x4*)(Lt_s + 2644);
    __builtin_amdgcn_sched_barrier(0);
    { const float xj = X18[1]; const f32x2 xj2 = (f32x2){xj, xj};
      X19 -= (f32x2){Lb9[2], Lb9[3]} * xj2;
      X20 -= (f32x2){Lb10[0], Lb10[1]} * xj2;
      X21 -= (f32x2){Lb10[2], Lb10[3]} * xj2;
      X22 -= (f32x2){Lb11[0], Lb11[1]} * xj2;
      X23 -= (f32x2){Lb11[2], Lb11[3]} * xj2;
      X24 -= (f32x2){Lb12[0], Lb12[1]} * xj2;
      X25 -= (f32x2){Lb12[2], Lb12[3]} * xj2;
      X26 -= (f32x2){Lb13[0], Lb13[1]} * xj2;
      X27 -= (f32x2){Lb13[2], Lb13[3]} * xj2;
      X28 -= (f32x2){Lb14[0], Lb14[1]} * xj2;
      X29 -= (f32x2){Lb14[2], Lb14[3]} * xj2;
      X30 -= (f32x2){Lb15[0], Lb15[1]} * xj2;
      X31 -= (f32x2){Lb15[2], Lb15[3]} * xj2;
    }
    __builtin_amdgcn_sched_barrier(0);
    Lb10 = *(const f32x4*)(Lt_s + 2692);
    Lb11 = *(const f32x4*)(Lt_s + 2696);
    Lb12 = *(const f32x4*)(Lt_s + 2700);
    Lb13 = *(const f32x4*)(Lt_s + 2704);
    Lb14 = *(const f32x4*)(Lt_s + 2708);
    Lb15 = *(const f32x4*)(Lt_s + 2712);
    __builtin_amdgcn_sched_barrier(0);
    { const float xj = X19[0]; const f32x2 xj2 = (f32x2){xj, xj};
      X19 -= (f32x2){La9[2], La9[3]} * xj2;
      X20 -= (f32x2){La10[0], La10[1]} * xj2;
      X21 -= (f32x2){La10[2], La10[3]} * xj2;
      X22 -= (f32x2){La11[0], La11[1]} * xj2;
      X23 -= (f32x2){La11[2], La11[3]} * xj2;
      X24 -= (f32x2){La12[0], La12[1]} * xj2;
      X25 -= (f32x2){La12[2], La12[3]} * xj2;
      X26 -= (f32x2){La13[0], La13[1]} * xj2;
      X27 -= (f32x2){La13[2], La13[3]} * xj2;
      X28 -= (f32x2){La14[0], La14[1]} * xj2;
      X29 -= (f32x2){La14[2], La14[3]} * xj2;
      X30 -= (f32x2){La15[0], La15[1]} * xj2;
      X31 -= (f32x2){La15[2], La15[3]} * xj2;
    }
    __builtin_amdgcn_sched_barrier(0);
    La10 = *(const f32x4*)(Lt_s + 2760);
    La11 = *(const f32x4*)(Lt_s + 2764);
    La12 = *(const f32x4*)(Lt_s + 2768);
    La13 = *(const f32x4*)(Lt_s + 2772);
    La14 = *(const f32x4*)(Lt_s + 2776);
    La15 = *(const f32x4*)(Lt_s + 2780);
    __builtin_amdgcn_sched_barrier(0);
    { const float xj = X19[1]; const f32x2 xj2 = (f32x2){xj, xj};
      X20 -= (f32x2){Lb10[0], Lb10[1]} * xj2;
      X21 -= (f32x2){Lb10[2], Lb10[3]} * xj2;
      X22 -= (f32x2){Lb11[0], Lb11[1]} * xj2;
      X23 -= (f32x2){Lb11[2], Lb11[3]} * xj2;
      X24 -= (f32x2){Lb12[0], Lb12[1]} * xj2;
      X25 -= (f32x2){Lb12[2], Lb12[3]} * xj2;
      X26 -= (f32x2){Lb13[0], Lb13[1]} * xj2;
      X27 -= (f32x2){Lb13[2], Lb13[3]} * xj2;
      X28 -= (f32x2){Lb14[0], Lb14[1]} * xj2;
      X29 -= (f32x2){Lb14[2], Lb14[3]} * xj2;
      X30 -= (f32x2){Lb15[0], Lb15[1]} * xj2;
      X31 -= (f32x2){Lb15[2], Lb15[3]} * xj2;
    }
    __builtin_amdgcn_sched_barrier(0);
    Lb10 = *(const f32x4*)(Lt_s + 2828);
    Lb11 = *(const f32x4*)(Lt_s + 2832);
    Lb12 = *(const f32x4*)(Lt_s + 2836);
    Lb13 = *(const f32x4*)(Lt_s + 2840);
    Lb14 = *(const f32x4*)(Lt_s + 2844);
    Lb15 = *(const f32x4*)(Lt_s + 2848);
    __builtin_amdgcn_sched_barrier(0);
    { const float xj = X20[0]; const f32x2 xj2 = (f32x2){xj, xj};
      X20 -= (f32x2){La10[0], La10[1]} * xj2;
      X21 -= (f32x2){La10[2], La10[3]} * xj2;
      X22 -= (f32x2){La11[0], La11[1]} * xj2;
      X23 -= (f32x2){La11[2], La11[3]} * xj2;
      X24 -= (f32x2){La12[0], La12[1]} * xj2;
      X25 -= (f32x2){La12[2], La12[3]} * xj2;
      X26 -= (f32x2){La13[0], La13[1]} * xj2;
      X27 -= (f32x2){La13[2], La13[3]} * xj2;
      X28 -= (f32x2){La14[0], La14[1]} * xj2;
      X29 -= (f32x2){La14[2], La14[3]} * xj2;
      X30 -= (f32x2){La15[0], La15[1]} * xj2;
      X31 -= (f32x2){La15[2], La15[3]} * xj2;
    }
    __builtin_amdgcn_sched_barrier(0);
    La10 = *(const f32x4*)(Lt_s + 2896);
    La11 = *(const f32x4*)(Lt_s + 2900);
    La12 = *(const f32x4*)(Lt_s + 2904);
    La13 = *(const f32x4*)(Lt_s + 2908);
    La14 = *(const f32x4*)(Lt_s + 2912);
    La15 = *(const f32x4*)(Lt_s + 2916);
    __builtin_amdgcn_sched_barrier(0);
    { const float xj = X20[1]; const f32x2 xj2 = (f32x2){xj, xj};
      X21 -= (f32x2){Lb10[2], Lb10[3]} * xj2;
      X22 -= (f32x2){Lb11[0], Lb11[1]} * xj2;
      X23 -= (f32x2){Lb11[2], Lb11[3]} * xj2;
      X24 -= (f32x2){Lb12[0], Lb12[1]} * xj2;
      X25 -= (f32x2){Lb12[2], Lb12[3]} * xj2;
      X26 -= (f32x2){Lb13[0], Lb13[1]} * xj2;
      X27 -= (f32x2){Lb13[2], Lb13[3]} * xj2;
      X28 -= (f32x2){Lb14[0], Lb14[1]} * xj2;
      X29 -= (f32x2){Lb14[2], Lb14[3]} * xj2;
      X30 -= (f32x2){Lb15[0], Lb15[1]} * xj2;
      X31 -= (f32x2){Lb15[2], Lb15[3]} * xj2;
    }
    __builtin_amdgcn_sched_barrier(0);
    Lb11 = *(const f32x4*)(Lt_s + 2968);
    Lb12 = *(const f32x4*)(Lt_s + 2972);
    Lb13 = *(const f32x4*)(Lt_s + 2976);
    Lb14 = *(const f32x4*)(Lt_s + 2980);
    Lb15 = *(const f32x4*)(Lt_s + 2984);
    __builtin_amdgcn_sched_barrier(0);
    { const float xj = X21[0]; const f32x2 xj2 = (f32x2){xj, xj};
      X21 -= (f32x2){La10[2], La10[3]} * xj2;
      X22 -= (f32x2){La11[0], La11[1]} * xj2;
      X23 -= (f32x2){La11[2], La11[3]} * xj2;
      X24 -= (f32x2){La12[0], La12[1]} * xj2;
      X25 -= (f32x2){La12[2], La12[3]} * xj2;
      X26 -= (f32x2){La13[0], La13[1]} * xj2;
      X27 -= (f32x2){La13[2], La13[3]} * xj2;
      X28 -= (f32x2){La14[0], La14[1]} * xj2;
      X29 -= (f32x2){La14[2], La14[3]} * xj2;
      X30 -= (f32x2){La15[0], La15[1]} * xj2;
      X31 -= (f32x2){La15[2], La15[3]} * xj2;
    }
    __builtin_amdgcn_sched_barrier(0);
    La11 = *(const f32x4*)(Lt_s + 3036);
    La12 = *(const f32x4*)(Lt_s + 3040);
    La13 = *(const f32x4*)(Lt_s + 3044);
    La14 = *(const f32x4*)(Lt_s + 3048);
    La15 = *(const f32x4*)(Lt_s + 3052);
    __builtin_amdgcn_sched_barrier(0);
    { const float xj = X21[1]; const f32x2 xj2 = (f32x2){xj, xj};
      X22 -= (f32x2){Lb11[0], Lb11[1]} * xj2;
      X23 -= (f32x2){Lb11[2], Lb11[3]} * xj2;
      X24 -= (f32x2){Lb12[0], Lb12[1]} * xj2;
      X25 -= (f32x2){Lb12[2], Lb12[3]} * xj2;
      X26 -= (f32x2){Lb13[0], Lb13[1]} * xj2;
      X27 -= (f32x2){Lb13[2], Lb13[3]} * xj2;
      X28 -= (f32x2){Lb14[0], Lb14[1]} * xj2;
      X29 -= (f32x2){Lb14[2], Lb14[3]} * xj2;
      X30 -= (f32x2){Lb15[0], Lb15[1]} * xj2;
      X31 -= (f32x2){Lb15[2], Lb15[3]} * xj2;
    }
    __builtin_amdgcn_sched_barrier(0);
    Lb11 = *(const f32x4*)(Lt_s + 3104);
    Lb12 = *(const f32x4*)(Lt_s + 3108);
    Lb13 = *(const f32x4*)(Lt_s + 3112);
    Lb14 = *(const f32x4*)(Lt_s + 3116);
    Lb15 = *(const f32x4*)(Lt_s + 3120);
    __builtin_amdgcn_sched_barrier(0);
    { const float xj = X22[0]; const f32x2 xj2 = (f32x2){xj, xj};
      X22 -= (f32x2){La11[0], La11[1]} * xj2;
      X23 -= (f32x2){La11[2], La11[3]} * xj2;
      X24 -= (f32x2){La12[0], La12[1]} * xj2;
      X25 -= (f32x2){La12[2], La12[3]} * xj2;
      X26 -= (f32x2){La13[0], La13[1]} * xj2;
      X27 -= (f32x2){La13[2], La13[3]} * xj2;
      X28 -= (f32x2){La14[0], La14[1]} * xj2;
      X29 -= (f32x2){La14[2], La14[3]} * xj2;
      X30 -= (f32x2){La15[0], La15[1]} * xj2;
      X31 -= (f32x2){La15[2], La15[3]} * xj2;
    }
    __builtin_amdgcn_sched_barrier(0);
    La11 = *(const f32x4*)(Lt_s + 3172);
    La12 = *(const f32x4*)(Lt_s + 3176);
    La13 = *(const f32x4*)(Lt_s + 3180);
    La14 = *(const f32x4*)(Lt_s + 3184);
    La15 = *(const f32x4*)(Lt_s + 3188);
    __builtin_amdgcn_sched_barrier(0);
    { const float xj = X22[1]; const f32x2 xj2 = (f32x2){xj, xj};
      X23 -= (f32x2){Lb11[2], Lb11[3]} * xj2;
      X24 -= (f32x2){Lb12[0], Lb12[1]} * xj2;
      X25 -= (f32x2){Lb12[2], Lb12[3]} * xj2;
      X26 -= (f32x2){Lb13[0], Lb13[1]} * xj2;
      X27 -= (f32x2){Lb13[2], Lb13[3]} * xj2;
      X28 -= (f32x2){Lb14[0], Lb14[1]} * xj2;
      X29 -= (f32x2){Lb14[2], Lb14[3]} * xj2;
      X30 -= (f32x2){Lb15[0], Lb15[1]} * xj2;
      X31 -= (f32x2){Lb15[2], Lb15[3]} * xj2;
    }
    __builtin_amdgcn_sched_barrier(0);
    Lb12 = *(const f32x4*)(Lt_s + 3244);
    Lb13 = *(const f32x4*)(Lt_s + 3248);
    Lb14 = *(const f32x4*)(Lt_s + 3252);
    Lb15 = *(const f32x4*)(Lt_s + 3256);
    __builtin_amdgcn_sched_barrier(0);
    { const float xj = X23[0]; const f32x2 xj2 = (f32x2){xj, xj};
      X23 -= (f32x2){La11[2], La11[3]} * xj2;
      X24 -= (f32x2){La12[0], La12[1]} * xj2;
      X25 -= (f32x2){La12[2], La12[3]} * xj2;
      X26 -= (f32x2){La13[0], La13[1]} * xj2;
      X27 -= (f32x2){La13[2], La13[3]} * xj2;
      X28 -= (f32x2){La14[0], La14[1]} * xj2;
      X29 -= (f32x2){La14[2], La14[3]} * xj2;
      X30 -= (f32x2){La15[0], La15[1]} * xj2;
      X31 -= (f32x2){La15[2], La15[3]} * xj2;
    }
    __builtin_amdgcn_sched_barrier(0);
    La12 = *(const f32x4*)(Lt_s + 3312);
    La13 = *(const f32x4*)(Lt_s + 3316);
    La14 = *(const f32x4*)(Lt_s + 3320);
    La15 = *(const f32x4*)(Lt_s + 3324);
    __builtin_amdgcn_sched_barrier(0);
    { const float xj = X23[1]; const f32x2 xj2 = (f32x2){xj, xj};
      X24 -= (f32x2){Lb12[0], Lb12[1]} * xj2;
      X25 -= (f32x2){Lb12[2], Lb12[3]} * xj2;
      X26 -= (f32x2){Lb13[0], Lb13[1]} * xj2;
      X27 -= (f32x2){Lb13[2], Lb13[3]} * xj2;
      X28 -= (f32x2){Lb14[0], Lb14[1]} * xj2;
      X29 -= (f32x2){Lb14[2], Lb14[3]} * xj2;
      X30 -= (f32x2){Lb15[0], Lb15[1]} * xj2;
      X31 -= (f32x2){Lb15[2], Lb15[3]} * xj2;
    }
    __builtin_amdgcn_sched_barrier(0);
    Lb12 = *(const f32x4*)(Lt_s + 3380);
    Lb13 = *(const f32x4*)(Lt_s + 3384);
    Lb14 = *(const f32x4*)(Lt_s + 3388);
    Lb15 = *(const f32x4*)(Lt_s + 3392);
    __builtin_amdgcn_sched_barrier(0);
    { const float xj = X24[0]; const f32x2 xj2 = (f32x2){xj, xj};
      X24 -= (f32x2){La12[0], La12[1]} * xj2;
      X25 -= (f32x2){La12[2], La12[3]} * xj2;
      X26 -= (f32x2){La13[0], La13[1]} * xj2;
      X27 -= (f32x2){La13[2], La13[3]} * xj2;
      X28 -= (f32x2){La14[0], La14[1]} * xj2;
      X29 -= (f32x2){La14[2], La14[3]} * xj2;
      X30 -= (f32x2){La15[0], La15[1]} * xj2;
      X31 -= (f32x2){La15[2], La15[3]} * xj2;
    }
    __builtin_amdgcn_sched_barrier(0);
    La12 = *(const f32x4*)(Lt_s + 3448);
    La13 = *(const f32x4*)(Lt_s + 3452);
    La14 = *(const f32x4*)(Lt_s + 3456);
    La15 = *(const f32x4*)(Lt_s + 3460);
    __builtin_amdgcn_sched_barrier(0);
    { const float xj = X24[1]; const f32x2 xj2 = (f32x2){xj, xj};
      X25 -= (f32x2){Lb12[2], Lb12[3]} * xj2;
      X26 -= (f32x2){Lb13[0], Lb13[1]} * xj2;
      X27 -= (f32x2){Lb13[2], Lb13[3]} * xj2;
      X28 -= (f32x2){Lb14[0], Lb14[1]} * xj2;
      X29 -= (f32x2){Lb14[2], Lb14[3]} * xj2;
      X30 -= (f32x2){Lb15[0], Lb15[1]} * xj2;
      X31 -= (f32x2){Lb15[2], Lb15[3]} * xj2;
    }
    __builtin_amdgcn_sched_barrier(0);
    Lb13 = *(const f32x4*)(Lt_s + 3520);
    Lb14 = *(const f32x4*)(Lt_s + 3524);
    Lb15 = *(const f32x4*)(Lt_s + 3528);
    __builtin_amdgcn_sched_barrier(0);
    { const float xj = X25[0]; const f32x2 xj2 = (f32x2){xj, xj};
      X25 -= (f32x2){La12[2], La12[3]} * xj2;
      X26 -= (f32x2){La13[0], La13[1]} * xj2;
      X27 -= (f32x2){La13[2], La13[3]} * xj2;
      X28 -= (f32x2){La14[0], La14[1]} * xj2;
      X29 -= (f32x2){La14[2], La14[3]} * xj2;
      X30 -= (f32x2){La15[0], La15[1]} * xj2;
      X31 -= (f32x2){La15[2], La15[3]} * xj2;
    }
    __builtin_amdgcn_sched_barrier(0);
    La13 = *(const f32x4*)(Lt_s + 3588);
    La14 = *(const f32x4*)(Lt_s + 3592);
    La15 = *(const f32x4*)(Lt_s + 3596);
    __builtin_amdgcn_sched_barrier(0);
    { const float xj = X25[1]; const f32x2 xj2 = (f32x2){xj, xj};
      X26 -= (f32x2){Lb13[0], Lb13[1]} * xj2;
      X27 -= (f32x2){Lb13[2], Lb13[3]} * xj2;
      X28 -= (f32x2){Lb14[0], Lb14[1]} * xj2;
      X29 -= (f32x2){Lb14[2], Lb14[3]} * xj2;
      X30 -= (f32x2){Lb15[0], Lb15[1]} * xj2;
      X31 -= (f32x2){Lb15[2], Lb15[3]} * xj2;
    }
    __builtin_amdgcn_sched_barrier(0);
    Lb13 = *(const f32x4*)(Lt_s + 3656);
    Lb14 = *(const f32x4*)(Lt_s + 3660);
    Lb15 = *(const f32x4*)(Lt_s + 3664);
    __builtin_amdgcn_sched_barrier(0);
    { const float xj = X26[0]; const f32x2 xj2 = (f32x2){xj, xj};
      X26 -= (f32x2){La13[0], La13[1]} * xj2;
      X27 -= (f32x2){La13[2], La13[3]} * xj2;
      X28 -= (f32x2){La14[0], La14[1]} * xj2;
      X29 -= (f32x2){La14[2], La14[3]} * xj2;
      X30 -= (f32x2){La15[0], La15[1]} * xj2;
      X31 -= (f32x2){La15[2], La15[3]} * xj2;
    }
    __builtin_amdgcn_sched_barrier(0);
    La13 = *(const f32x4*)(Lt_s + 3724);
    La14 = *(const f32x4*)(Lt_s + 3728);
    La15 = *(const f32x4*)(Lt_s + 3732);
    __builtin_amdgcn_sched_barrier(0);
    { const float xj = X26[1]; const f32x2 xj2 = (f32x2){xj, xj};
      X27 -= (f32x2){Lb13[2], Lb13[3]} * xj2;
      X28 -= (f32x2){Lb14[0], Lb14[1]} * xj2;
      X29 -= (f32x2){Lb14[2], Lb14[3]} * xj2;
      X30 -= (f32x2){Lb15[0], Lb15[1]} * xj2;
      X31 -= (f32x2){Lb15[2], Lb15[3]} * xj2;
    }
    __builtin_amdgcn_sched_barrier(0);
    Lb14 = *(const f32x4*)(Lt_s + 3796);
    Lb15 = *(const f32x4*)(Lt_s + 3800);
    __builtin_amdgcn_sched_barrier(0);
    { const float xj = X27[0]; const f32x2 xj2 = (f32x2){xj, xj};
      X27 -= (f32x2){La13[2], La13[3]} * xj2;
      X28 -= (f32x2){La14[0], La14[1]} * xj2;
      X29 -= (f32x2){La14[2], La14[3]} * xj2;
      X30 -= (f32x2){La15[0], La15[1]} * xj2;
      X31 -= (f32x2){La15[2], La15[3]} * xj2;
    }
    __builtin_amdgcn_sched_barrier(0);
    La14 = *(const f32x4*)(Lt_s + 3864);
    La15 = *(const f32x4*)(Lt_s + 3868);
    __builtin_amdgcn_sched_barrier(0);
    { const float xj = X27[1]; const f32x2 xj2 = (f32x2){xj, xj};
      X28 -= (f32x2){Lb14[0], Lb14[1]} * xj2;
      X29 -= (f32x2){Lb14[2], Lb14[3]} * xj2;
      X30 -= (f32x2){Lb15[0], Lb15[1]} * xj2;
      X31 -= (f32x2){Lb15[2], Lb15[3]} * xj2;
    }
    __builtin_amdgcn_sched_barrier(0);
    Lb14 = *(const f32x4*)(Lt_s + 3932);
    Lb15 = *(const f32x4*)(Lt_s + 3936);
    __builtin_amdgcn_sched_barrier(0);
    { const float xj = X28[0]; const f32x2 xj2 = (f32x2){xj, xj};
      X28 -= (f32x2){La14[0], La14[1]} * xj2;
      X29 -= (f32x2){La14[2], La14[3]} * xj2;
      X30 -= (f32x2){La15[0], La15[1]} * xj2;
      X31 -= (f32x2){La15[2], La15[3]} * xj2;
    }
    __builtin_amdgcn_sched_barrier(0);
    La14 = *(const f32x4*)(Lt_s + 4000);
    La15 = *(const f32x4*)(Lt_s + 4004);
    __builtin_amdgcn_sched_barrier(0);
    { const float xj = X28[1]; const f32x2 xj2 = (f32x2){xj, xj};
      X29 -= (f32x2){Lb14[2], Lb14[3]} * xj2;
      X30 -= (f32x2){Lb15[0], Lb15[1]} * xj2;
      X31 -= (f32x2){Lb15[2], Lb15[3]} * xj2;
    }
    __builtin_amdgcn_sched_barrier(0);
    Lb15 = *(const f32x4*)(Lt_s + 4072);
    __builtin_amdgcn_sched_barrier(0);
    { const float xj = X29[0]; const f32x2 xj2 = (f32x2){xj, xj};
      X29 -= (f32x2){La14[2], La14[3]} * xj2;
      X30 -= (f32x2){La15[0], La15[1]} * xj2;
      X31 -= (f32x2){La15[2], La15[3]} * xj2;
    }
    __builtin_amdgcn_sched_barrier(0);
    La15 = *(const f32x4*)(Lt_s + 4140);
    __builtin_amdgcn_sched_barrier(0);
    { const float xj = X29[1]; const f32x2 xj2 = (f32x2){xj, xj};
      X30 -= (f32x2){Lb15[0], Lb15[1]} * xj2;
      X31 -= (f32x2){Lb15[2], Lb15[3]} * xj2;
    }
    __builtin_amdgcn_sched_barrier(0);
    Lb15 = *(const f32x4*)(Lt_s + 4208);
    __builtin_amdgcn_sched_barrier(0);
    { const float xj = X30[0]; const f32x2 xj2 = (f32x2){xj, xj};
      X30 -= (f32x2){La15[0], La15[1]} * xj2;
      X31 -= (f32x2){La15[2], La15[3]} * xj2;
    }
    __builtin_amdgcn_sched_barrier(0);
    La15 = *(const f32x4*)(Lt_s + 4276);
    __builtin_amdgcn_sched_barrier(0);
    { const float xj = X30[1]; const f32x2 xj2 = (f32x2){xj, xj};
      X31 -= (f32x2){Lb15[2], Lb15[3]} * xj2;
    }
    __builtin_amdgcn_sched_barrier(0);
    __builtin_amdgcn_sched_barrier(0);
    { const float xj = X31[0]; const f32x2 xj2 = (f32x2){xj, xj};
      X31 -= (f32x2){La15[2], La15[3]} * xj2;
    }
    __builtin_amdgcn_sched_barrier(0);
    __syncthreads();
    outp[0] = f2bf(sg * X0[0]);
    outp[136] = f2bf(sg * X0[1]);
    outp[272] = f2bf(sg * X1[0]);
    outp[408] = f2bf(sg * X1[1]);
    outp[544] = f2bf(sg * X2[0]);
    outp[680] = f2bf(sg * X2[1]);
    outp[816] = f2bf(sg * X3[0]);
    outp[952] = f2bf(sg * X3[1]);
    outp[1088] = f2bf(sg * X4[0]);
    outp[1224] = f2bf(sg * X4[1]);
    outp[1360] = f2bf(sg * X5[0]);
    outp[1496] = f2bf(sg * X5[1]);
    outp[1632] = f2bf(sg * X6[0]);
    outp[1768] = f2bf(sg * X6[1]);
    outp[1904] = f2bf(sg * X7[0]);
    outp[2040] = f2bf(sg * X7[1]);
    outp[2176] = f2bf(sg * X8[0]);
    outp[2312] = f2bf(sg * X8[1]);
    outp[2448] = f2bf(sg * X9[0]);
    outp[2584] = f2bf(sg * X9[1]);
    outp[2720] = f2bf(sg * X10[0]);
    outp[2856] = f2bf(sg * X10[1]);
    outp[2992] = f2bf(sg * X11[0]);
    outp[3128] = f2bf(sg * X11[1]);
    outp[3264] = f2bf(sg * X12[0]);
    outp[3400] = f2bf(sg * X12[1]);
    outp[3536] = f2bf(sg * X13[0]);
    outp[3672] = f2bf(sg * X13[1]);
    outp[3808] = f2bf(sg * X14[0]);
    outp[3944] = f2bf(sg * X14[1]);
    outp[4080] = f2bf(sg * X15[0]);
    outp[4216] = f2bf(sg * X15[1]);
    outp[4352] = f2bf(sg * X16[0]);
    outp[4488] = f2bf(sg * X16[1]);
    outp[4624] = f2bf(sg * X17[0]);
    outp[4760] = f2bf(sg * X17[1]);
    outp[4896] = f2bf(sg * X18[0]);
    outp[5032] = f2bf(sg * X18[1]);
    outp[5168] = f2bf(sg * X19[0]);
    outp[5304] = f2bf(sg * X19[1]);
    outp[5440] = f2bf(sg * X20[0]);
    outp[5576] = f2bf(sg * X20[1]);
    outp[5712] = f2bf(sg * X21[0]);
    outp[5848] = f2bf(sg * X21[1]);
    outp[5984] = f2bf(sg * X22[0]);
    outp[6120] = f2bf(sg * X22[1]);
    outp[6256] = f2bf(sg * X23[0]);
    outp[6392] = f2bf(sg * X23[1]);
    outp[6528] = f2bf(sg * X24[0]);
    outp[6664] = f2bf(sg * X24[1]);
    outp[6800] = f2bf(sg * X25[0]);
    outp[6936] = f2bf(sg * X25[1]);
    outp[7072] = f2bf(sg * X26[0]);
    outp[7208] = f2bf(sg * X26[1]);
    outp[7344] = f2bf(sg * X27[0]);
    outp[7480] = f2bf(sg * X27[1]);
    outp[7616] = f2bf(sg * X28[0]);
    outp[7752] = f2bf(sg * X28[1]);
    outp[7888] = f2bf(sg * X29[0]);
    outp[8024] = f2bf(sg * X29[1]);
    outp[8160] = f2bf(sg * X30[0]);
    outp[8296] = f2bf(sg * X30[1]);
    outp[8432] = f2bf(sg * X31[0]);
    outp[8568] = f2bf(sg * X31[1]);
}

DEV void dn_item(const Params& p, int l, int item, unsigned char* smem) {
    const int dir = item & 1, hh = (item >> 1) & 3, b = item >> 3;
    bf16_t* q_s = (bf16_t*)(smem);
    bf16_t* k_s = (bf16_t*)(smem + 17408);
    bf16_t* vnT_s = k_s;
    bf16_t* kT_s = (bf16_t*)(smem + 35840);
    bf16_t* v_s = (bf16_t*)(smem + 54272);
    bf16_t* u_s = v_s;
    float* L_s = (float*)(smem + 71680);
    bf16_t* w_s = (bf16_t*)(smem + 71680);
    bf16_t* qk_s = (bf16_t*)(smem + 89088);
    bf16_t* St_s = (bf16_t*)(smem + 98304);
    float* G_s = (float*)(smem + 133120);
    float* beta_s = G_s + 64;
    float* eG_s = G_s + 128;
    float* bw_s = G_s + 192;
    float* cw_s = G_s + 256;
    bf16_t* XT_s = k_s;
    bf16_t* Lb_s = (bf16_t*)(smem + 140288);
    const int tid = get_tid(), lane = tid & 63, wv = tid >> 6, l15 = lane & 15, quad = lane >> 4;
    const float Aneg = -expf(p.in[I_DNALOG][(l * 2 + dir) * 4 + hh]);
    const float dtb = p.in[I_DNDT][(l * 2 + dir) * 4 + hh];
    const bf16_t* P = wsb(p, O_P);
    const float* AB = wsf(p, O_AB);
    bf16_t* TO = wsb(p, dir ? O_TA2 : O_TA);
    __syncthreads();
    for (int e = tid; e < 4 * 384; e += 256) { int j = e / 384, c = e % 384, mat = c >> 7, cc = c & 127; cw_s[e] = p.in[I_DNCONV][((size_t)l * 4 + j) * 1536 + mat * 512 + hh * 128 + cc]; }
    for (int e = tid; e < 128 * 136 / 2; e += 256) ((unsigned*)St_s)[e] = 0u;
    f32x4 Sacc[2][8];
#pragma unroll
    for (int a = 0; a < 2; ++a)
#pragma unroll
        for (int c = 0; c < 8; ++c) Sacc[a][c] = (f32x4){0.f, 0.f, 0.f, 0.f};

    const int rg = tid >> 4, cseg = tid & 15, i0 = rg * 4;
    u32x4 raw[3][7];
    float pf_al = 0.f, pf_bb = 0.f;
#define DN_PREFETCH(NN, M0, M1) { \
        const int c_ = chunk_of(dir, (NN)); const int lo_ = c_ < 4 ? 0 : CTXL, hi_ = c_ < 4 ? CTXL : SB, base_ = c_ * 64; \
        const int slo_ = dir ? base_ + 60 - i0 : base_ + i0; \
        _Pragma("unroll") for (int u = 0; u < 7; ++u) { const int ss_ = slo_ - 1 + u; const bool ok_ = ss_ >= lo_ && ss_ < hi_; \
            const bf16_t* rp_ = P + ((size_t)b * SB + (ok_ ? ss_ : base_)) * PW + hh * 128 + cseg * 8; \
            _Pragma("unroll") for (int mat = (M0); mat < (M1); ++mat) { u32x4 t_ = *(const u32x4*)(rp_ + mat * 512); raw[mat][u] = ok_ ? t_ : (u32x4){0u, 0u, 0u, 0u}; } } \
        if ((M0) == 0) { const int sa_ = dir ? base_ + 63 - lane : base_ + lane; \
        pf_al = AB[((size_t)b * SB + sa_) * 16 + dir * 4 + hh]; pf_bb = AB[((size_t)b * SB + sa_) * 16 + 8 + dir * 4 + hh]; } }
    DN_PREFETCH(0, 0, 3);
    const int wv0_ = wv, l150_ = l15, quad0_ = quad, lane0_ = lane;

#pragma unroll 1
    for (int n = 0; n < 68; ++n) {
        int tz0 = 0; asm volatile("" : "+v"(tz0));
        const int wv = wv0_ + tz0, l15 = l150_ + tz0, quad = quad0_ + tz0, lane = lane0_ + tz0;
        const int c = chunk_of(dir, n);
        const int base = c * 64;
        __syncthreads();
        if (wv == 0) {
            float g = Aneg * softplus_fast(pf_al + dtb);
#pragma unroll
            for (int o = 1; o < 64; o <<= 1) { float t = __shfl_up(g, o); if (lane >= o) g += t; }
            const float eg_ = expf(g), bt_ = sigm(pf_bb); G_s[lane] = g; beta_s[lane] = bt_; eG_s[lane] = eg_; bw_s[lane] = bt_ * eg_;
        }
        __syncthreads();
        const float Glast = G_s[63];
        {
            int tz = 0; asm volatile("" : "+v"(tz));
            const int i0l = i0 + tz, csl = cseg + tz;
            float ksc[4];
#pragma unroll
            for (int m = 0; m < 4; ++m) ksc[m] = expf(Glast - G_s[i0l + m]);
#pragma unroll
            for (int mat = 0; mat < 3; ++mat) {
                float w[4][8];
#pragma unroll
                for (int j = 0; j < 4; ++j) { const f32x4 w0 = *(const f32x4*)(cw_s + j * 384 + mat * 128 + csl * 8), w1 = *(const f32x4*)(cw_s + j * 384 + mat * 128 + csl * 8 + 4);
#pragma unroll
                    for (int e = 0; e < 4; ++e) { w[j][e] = w0[e]; w[j][4 + e] = w1[e]; } }
                float v[4][8];
#pragma unroll
                for (int t = 0; t < 4; ++t)
#pragma unroll
                    for (int e = 0; e < 8; ++e) v[t][e] = 0.f;
#pragma unroll
                for (int u = 0; u < 7; ++u) {
                    float x[8];
#pragma unroll
                    for (int e = 0; e < 4; ++e) { x[2 * e] = lo16(raw[mat][u][e]); x[2 * e + 1] = hi16(raw[mat][u][e]); }
#pragma unroll
                    for (int t = 0; t < 4; ++t) { const int j = u - t; if (j >= 0 && j < 4) {
#pragma unroll
                        for (int e = 0; e < 8; ++e) v[t][e] += w[j][e] * x[e]; } }
                }
                float sc[4];
#pragma unroll
                for (int t = 0; t < 4; ++t) {
                    float ss2 = 0.f;
#pragma unroll
                    for (int e = 0; e < 8; ++e) { v[t][e] = silu(v[t][e]); ss2 += v[t][e] * v[t][e]; }
                    if (mat < 2) { ss2 += __shfl_xor(ss2, 1); ss2 += __shfl_xor(ss2, 2); ss2 += __shfl_xor(ss2, 4); ss2 += __shfl_xor(ss2, 8); }
                    sc[t] = mat == 0 ? rsqrtf(ss2 + 1e-6f) * 0.08838834764831845f : (mat == 1 ? rsqrtf(ss2 + 1e-6f) : 1.f);
                }
                bf16_t* dst = mat == 0 ? q_s : (mat == 1 ? k_s : v_s);
#pragma unroll
                for (int t = 0; t < 4; ++t) {
                    const int it_ = dir ? i0l + 3 - t : i0l + t;
                    u32x4 o;
#pragma unroll
                    for (int e = 0; e < 4; ++e) o[e] = pack2(v[t][2 * e] * sc[t], v[t][2 * e + 1] * sc[t]);
                    *(u32x4*)(dst + it_ * 136 + csl * 8) = o;
                }
                if (mat == 1) {
#pragma unroll
                    for (int e = 0; e < 8; ++e) {
                        const float k0 = v[dir ? 3 : 0][e] * sc[dir ? 3 : 0] * ksc[0], k1 = v[dir ? 2 : 1][e] * sc[dir ? 2 : 1] * ksc[1];
                        const float k2 = v[dir ? 1 : 2][e] * sc[dir ? 1 : 2] * ksc[2], k3 = v[dir ? 0 : 3][e] * sc[dir ? 0 : 3] * ksc[3];
                        u32x2 o; o.x = pack2(k0, k1); o.y = pack2(k2, k3);
                        *(u32x2*)(kT_s + (csl * 8 + e) * 72 + i0l) = o;
                    }
                }
            }
        }
        __syncthreads();
        {
            bf16x8 ak[4], aq[4];
#pragma unroll
            for (int ks = 0; ks < 4; ++ks) { ak[ks] = *(const bf16x8*)(k_s + (wv * 16 + l15) * 136 + ks * 32 + quad * 8); aq[ks] = *(const bf16x8*)(q_s + (wv * 16 + l15) * 136 + ks * 32 + quad * 8); }
#pragma unroll
            for (int nt = 0; nt < 4; ++nt) {
                f32x4 kk = {0.f, 0.f, 0.f, 0.f}, qq = {0.f, 0.f, 0.f, 0.f};
#pragma unroll
                for (int ks = 0; ks < 4; ++ks) { bf16x8 bk = *(const bf16x8*)(k_s + (nt * 16 + l15) * 136 + ks * 32 + quad * 8); kk = mfma16(ak[ks], bk, kk); qq = mfma16(aq[ks], bk, qq); }
                const int jj = nt * 16 + l15; const float Gj = G_s[jj];
                f32x4 lv;
#pragma unroll
                for (int j = 0; j < 4; ++j) {
                    const int i = wv * 16 + quad * 4 + j;
                    const float dec = jj <= i ? expf(G_s[i] - Gj) : 0.f;
                    lv[j] = jj < i ? beta_s[i] * kk[j] * dec : 0.f;
                    qk_s[i * 72 + jj] = f2bf(qq[j] * dec);
                }
                *(f32x4*)(L_s + jj * 68 + wv * 16 + quad * 4) = lv;
                if (wv >= 2 && nt < 2) {
#pragma unroll
                    for (int j = 0; j < 4; ++j) Lb_s[(wv * 16 - 32 + quad * 4 + j) * 40 + jj] = f2bf(lv[j]);
                }
            }
        }
        __syncthreads();
        dn_solve(L_s, tid < 128 ? (k_s + tid) : (v_s + (tid - 128)), tid < 128 ? bw_s : beta_s, tid < 128 ? -1.f : 1.f, tid < 128 ? (w_s + tid) : (u_s + (tid - 128)), XT_s, Lb_s, tid, wv, l15, quad);
        __syncthreads();
        {
            f32x4 vn[8], o1[8];
#pragma unroll
            for (int nt = 0; nt < 8; ++nt) {
#pragma unroll
                for (int j = 0; j < 4; ++j) vn[nt][j] = bf2f(u_s[(wv * 16 + quad * 4 + j) * 136 + nt * 16 + l15]);
                o1[nt] = (f32x4){0.f, 0.f, 0.f, 0.f};
            }
            bf16x8 aw[4], aq[4];
#pragma unroll
            for (int ks = 0; ks < 4; ++ks) { aw[ks] = *(const bf16x8*)(w_s + (wv * 16 + l15) * 136 + ks * 32 + quad * 8); aq[ks] = *(const bf16x8*)(q_s + (wv * 16 + l15) * 136 + ks * 32 + quad * 8); }
#pragma unroll
            for (int nt = 0; nt < 8; ++nt)
#pragma unroll
                for (int ks = 0; ks < 4; ++ks) { bf16x8 bs = *(const bf16x8*)(St_s + (nt * 16 + l15) * 136 + ks * 32 + quad * 8); vn[nt] = mfma16(aw[ks], bs, vn[nt]); o1[nt] = mfma16(aq[ks], bs, o1[nt]); }
#pragma unroll
            for (int nt = 0; nt < 8; ++nt) { u32x2 o; o.x = pack2(vn[nt][0], vn[nt][1]); o.y = pack2(vn[nt][2], vn[nt][3]); *(u32x2*)(vnT_s + (nt * 16 + l15) * 72 + wv * 16 + quad * 4) = o; }
            __syncthreads();
            if (n + 1 < 68) DN_PREFETCH(n + 1, 0, 2);
            float eg[4];
#pragma unroll
            for (int j = 0; j < 4; ++j) eg[j] = eG_s[wv * 16 + quad * 4 + j];
            bf16x8 aqk[2], akt[2][2];
#pragma unroll
            for (int ks = 0; ks < 2; ++ks) {
                aqk[ks] = *(const bf16x8*)(qk_s + (wv * 16 + l15) * 72 + ks * 32 + quad * 8);
                akt[0][ks] = *(const bf16x8*)(kT_s + (wv * 32 + l15) * 72 + ks * 32 + quad * 8);
                akt[1][ks] = *(const bf16x8*)(kT_s + (wv * 32 + 16 + l15) * 72 + ks * 32 + quad * 8);
            }
            const float gend = eG_s[63];
            const size_t orow0 = (size_t)b * SB;
#pragma unroll
            for (int nt = 0; nt < 8; ++nt) {
                f32x4 o;
#pragma unroll
                for (int j = 0; j < 4; ++j) { o[j] = o1[nt][j] * eg[j]; Sacc[0][nt][j] *= gend; Sacc[1][nt][j] *= gend; }
#pragma unroll
                for (int ks = 0; ks < 2; ++ks) {
                    bf16x8 bv = *(const bf16x8*)(vnT_s + (nt * 16 + l15) * 72 + ks * 32 + quad * 8);
                    o = mfma16(aqk[ks], bv, o);
                    Sacc[0][nt] = mfma16(akt[0][ks], bv, Sacc[0][nt]);
                    Sacc[1][nt] = mfma16(akt[1][ks], bv, Sacc[1][nt]);
                }
#pragma unroll
                for (int j = 0; j < 4; ++j) {
                    const int i = wv * 16 + quad * 4 + j;
                    const int s = dir ? base + 63 - i : base + i;
                    TO[(orow0 + s) * 512 + hh * 128 + nt * 16 + l15] = f2bf(o[j]);
                }
#pragma unroll
                for (int mt = 0; mt < 2; ++mt) { u32x2 sv; sv.x = pack2(Sacc[mt][nt][0], Sacc[mt][nt][1]); sv.y = pack2(Sacc[mt][nt][2], Sacc[mt][nt][3]);
                    *(u32x2*)(St_s + (nt * 16 + l15) * 136 + wv * 32 + mt * 16 + quad * 4) = sv; }
            }
        }
        if (n + 1 < 68) DN_PREFETCH(n + 1, 2, 3);
    }
}

#undef DN_PREFETCH
DEV void lru_item(const Params& p, int l, int item, unsigned char* smem) {
    const int g = item & 7, b = item >> 3;
    bf16_t* Wt_s = (bf16_t*)smem;
    bf16_t* xbh_s = Wt_s + 2 * 128 * 72;
    float* xbf_s = (float*)(smem + 36864 + 18432);
    float* a_s = xbf_s + 2 * 64 * 65;
    float* cw_s = a_s + 2 * 64 * 65;
    const int tid = get_tid(), lane = tid & 63, wv = tid >> 6, l15 = lane & 15, quad = lane >> 4;
    bf16_t* P = wsb(p, O_P);
    bf16_t* HF = wsb(p, O_U);
    __syncthreads();
    for (int e = tid; e < 320; e += 256) cw_s[e] = e < 256 ? p.in[I_LCW][((size_t)l * 4 + (e >> 6)) * 512 + g * 64 + (e & 63)] : p.in[I_LCB][l * 512 + g * 64 + (e - 256)];
    for (int e = tid; e < 2 * 4096; e += 256) {
        const int d = e >> 12, ch = (e >> 6) & 63, j = e & 63;
        const size_t wi_ = (((size_t)l * 2 + d) * 8 + g) * 4096 + ch * 64 + j;
        Wt_s[(d * 128 + j) * 72 + ch] = f2bf(p.in[I_LWA][wi_]);
        Wt_s[(d * 128 + 64 + j) * 72 + ch] = f2bf(p.in[I_LWI][wi_]);
    }
    float ba_[2][4], bi_[2][4], sp_[2][4];
#pragma unroll
    for (int d = 0; d < 2; ++d)
#pragma unroll
        for (int nt = 0; nt < 4; ++nt) {
            const int ch = (l * 2 + d) * 512 + g * 64 + nt * 16 + l15;
            ba_[d][nt] = p.in[I_LBA][ch]; bi_[d][nt] = p.in[I_LBI][ch]; sp_[d][nt] = softplus(-p.in[I_LLAM][ch]);
        }
    float hc = 0.f;
    const int i = tid >> 2, seg = tid & 3, j0 = seg * 16;
#pragma unroll 1
    for (int n = 0; n < 68; ++n) {
        const int cf = n, cb = chunk_of(1, n);
        __syncthreads();
#pragma unroll
        for (int d = 0; d < 2; ++d) {
            const int c = d ? cb : cf;
            const int seg_lo = c < 4 ? 0 : CTXL, seg_hi = c < 4 ? CTXL : SB;
            const int s = d ? c * 64 + 63 - i : c * 64 + i;
            float v[16];
#pragma unroll
            for (int e = 0; e < 16; ++e) v[e] = cw_s[256 + j0 + e];
#pragma unroll
            for (int j = 0; j < 4; ++j) {
                const int ss = s + j - 1;
                if (ss >= seg_lo && ss < seg_hi) {
                    const u32x4* src = (const u32x4*)(P + ((size_t)b * SB + ss) * PW + C_LX + g * 64 + j0);
                    const float* cw = cw_s + j * 64 + j0;
#pragma unroll
                    for (int q = 0; q < 2; ++q) { u32x4 x = src[q];
#pragma unroll
                        for (int e = 0; e < 4; ++e) { v[q * 8 + 2 * e] += cw[q * 8 + 2 * e] * lo16(x[e]); v[q * 8 + 2 * e + 1] += cw[q * 8 + 2 * e + 1] * hi16(x[e]); } }
                }
            }
            u32x4 h0, h1;
#pragma unroll
            for (int e = 0; e < 4; ++e) { h0[e] = pack2(v[2 * e], v[2 * e + 1]); h1[e] = pack2(v[8 + 2 * e], v[8 + 2 * e + 1]); }
            *(u32x4*)(xbh_s + (d * 64 + i) * 72 + j0) = h0; *(u32x4*)(xbh_s + (d * 64 + i) * 72 + j0 + 8) = h1;
#pragma unroll
            for (int e = 0; e < 16; ++e) xbf_s[(d * 64 + i) * 65 + j0 + e] = v[e];
        }
        __syncthreads();
#pragma unroll
        for (int d = 0; d < 2; ++d) {
            f32x4 acc[8];
#pragma unroll
            for (int nt = 0; nt < 8; ++nt) acc[nt] = (f32x4){0.f, 0.f, 0.f, 0.f};
            bf16x8 af[2];
#pragma unroll
            for (int ks = 0; ks < 2; ++ks) af[ks] = *(const bf16x8*)(xbh_s + (d * 64 + wv * 16 + l15) * 72 + ks * 32 + quad * 8);
#pragma unroll
            for (int nt = 0; nt < 8; ++nt)
#pragma unroll
                for (int ks = 0; ks < 2; ++ks) { bf16x8 bw = *(const bf16x8*)(Wt_s + (d * 128 + nt * 16 + l15) * 72 + ks * 32 + quad * 8); acc[nt] = mfma16(af[ks], bw, acc[nt]); }
#pragma unroll
            for (int nt = 0; nt < 4; ++nt)
#pragma unroll
                for (int jj = 0; jj < 4; ++jj) {
                    const int idx = (d * 64 + wv * 16 + quad * 4 + jj) * 65 + nt * 16 + l15;
                    const float r = sigm(acc[nt][jj] + ba_[d][nt]), ig = sigm(acc[nt + 4][jj] + bi_[d][nt]);
                    const float la = -8.f * r * sp_[d][nt];
                    a_s[idx] = expf(la);
                    xbf_s[idx] = sqrtf(fmaxf(1.f - expf(2.f * la), 0.f)) * (ig * xbf_s[idx]);
                }
        }
        __syncthreads();
        if (wv < 2) {
            const int o = wv * 64 * 65 + lane;
#pragma unroll 16
            for (int r = 0; r < 64; ++r) { hc = a_s[o + r * 65] * hc + xbf_s[o + r * 65]; xbf_s[o + r * 65] = hc; }
        }
        __syncthreads();
#pragma unroll
        for (int d = 0; d < 2; ++d) {
            const int c = d ? cb : cf;
            const int s = d ? c * 64 + 63 - i : c * 64 + i;
            const bool second = d ? (cb < n) : ((cf < 4 ? 3 - cf : 71 - cf) < n);
            const size_t row = (size_t)b * SB + s;
            const float* hp = xbf_s + (d * 64 + i) * 65 + j0;
            bf16_t* hf = HF + row * 512 + g * 64 + j0;
            if (!second) {
                u32x4 o0, o1;
#pragma unroll
                for (int e = 0; e < 4; ++e) { o0[e] = pack2(hp[2 * e], hp[2 * e + 1]); o1[e] = pack2(hp[8 + 2 * e], hp[8 + 2 * e + 1]); }
                *(u32x4*)hf = o0; *(u32x4*)(hf + 8) = o1;
            } else {
                bf16_t* gp = P + row * PW + C_LG + g * 64 + j0;
                u32x4 f0 = *(const u32x4*)hf, f1 = *(const u32x4*)(hf + 8), g0 = *(const u32x4*)gp, g1 = *(const u32x4*)(gp + 8), o0, o1;
#pragma unroll
                for (int e = 0; e < 4; ++e) {
                    o0[e] = pack2((lo16(f0[e]) + hp[2 * e]) * gelu_tanh(lo16(g0[e])), (hi16(f0[e]) + hp[2 * e + 1]) * gelu_tanh(hi16(g0[e])));
                    o1[e] = pack2((lo16(f1[e]) + hp[8 + 2 * e]) * gelu_tanh(lo16(g1[e])), (hi16(f1[e]) + hp[8 + 2 * e + 1]) * gelu_tanh(hi16(g1[e])));
                }
                *(u32x4*)gp = o0; *(u32x4*)(gp + 8) = o1;
            }
        }
    }
}

DEV void att_item(const Params& p, int l, int b, int h, int qt, float lam_init, unsigned char* smem) {
    bf16_t* K_s = (bf16_t*)smem;
    bf16_t* V_s = (bf16_t*)(smem + 2 * 17408);
    const int tid = get_tid(), lane = tid & 63, wv = tid >> 6, l15 = lane & 15, quad = lane >> 4;
    bf16_t* P = wsb(p, O_P);
    const bf16_t* VT = wsb(p, O_VT) + (size_t)(b * 4 + h) * 128 * SB;
    const int nt_keys = (qt < 2 ? CTXL : SB) / 64;
    float lam;
    {
        const float* lv = p.in[I_DALAM] + l * 256;
        float s1 = lv[lane] * lv[64 + lane], s2 = lv[128 + lane] * lv[192 + lane];
#pragma unroll
        for (int o = 32; o >= 1; o >>= 1) { s1 += __shfl_xor(s1, o); s2 += __shfl_xor(s2, o); }
        lam = expf(s1) - expf(s2) + lam_init;
    }
    bf16x8* Qst = (bf16x8*)(smem + 71680) + (wv * 8) * 64 + lane;
#pragma unroll
    for (int qg = 0; qg < 2; ++qg) {
        const bf16_t* qp = P + ((size_t)b * SB + qt * 128 + wv * 32 + qg * 16 + l15) * PW + C_DAQ + h * 128;
#pragma unroll
        for (int wh = 0; wh < 2; ++wh)
#pragma unroll
            for (int ks = 0; ks < 2; ++ks) Qst[(wh * 4 + qg * 2 + ks) * 64] = *(const bf16x8*)(qp + wh * 64 + ks * 32 + quad * 8);
    }
    f32x4 O[2][8][2];
    float mrun[2][2], lrun[2][2];
#pragma unroll
    for (int wh = 0; wh < 2; ++wh)
#pragma unroll
        for (int qg = 0; qg < 2; ++qg) { mrun[wh][qg] = -1e30f; lrun[wh][qg] = 0.f;
#pragma unroll
            for (int dg = 0; dg < 8; ++dg) O[wh][dg][qg] = (f32x4){0.f, 0.f, 0.f, 0.f}; }
    const int kr = tid >> 2, kseg = (tid & 3) * 32;
    const int kpos = ((kr >> 5) * 2 + ((kr & 7) >> 2)) * 16 + ((kr & 31) >> 3) * 4 + (kr & 3);
    const bf16_t* kg_ = P + ((size_t)b * SB + kr) * PW + C_DAK + h * 128 + kseg;
    const int vr = tid >> 1, vh = (tid & 1) * 32;
    const bf16_t* vg_ = VT + (size_t)vr * SB + vh;
    u32x4 kreg[4], vreg[4];
#pragma unroll
    for (int i = 0; i < 4; ++i) { kreg[i] = *(const u32x4*)(kg_ + i * 8); vreg[i] = *(const u32x4*)(vg_ + i * 8); }
    __syncthreads();
#pragma unroll
    for (int i = 0; i < 4; ++i) { *(u32x4*)(K_s + kpos * 136 + kseg + i * 8) = kreg[i]; *(u32x4*)(V_s + vr * 72 + vh + i * 8) = vreg[i]; }
    __syncthreads();
    const float L2E = 1.4426950408889634f;
#pragma unroll 1
    for (int t = 0; t < nt_keys; ++t) {
        const bf16_t* Kb = K_s + (t & 1) * (64 * 136);
        const bf16_t* Vb = V_s + (t & 1) * (128 * 72);
        if (t + 1 < nt_keys) {
#pragma unroll
            for (int i = 0; i < 4; ++i) { kreg[i] = *(const u32x4*)(kg_ + (size_t)(t + 1) * 64 * PW + i * 8); vreg[i] = *(const u32x4*)(vg_ + (t + 1) * 64 + i * 8); }
        }
#pragma unroll
        for (int wh = 0; wh < 2; ++wh) {
            f32x4 S[4][2];
#pragma unroll
            for (int kg = 0; kg < 4; ++kg) { S[kg][0] = (f32x4){0.f, 0.f, 0.f, 0.f}; S[kg][1] = (f32x4){0.f, 0.f, 0.f, 0.f}; }
#pragma unroll
            for (int ks = 0; ks < 2; ++ks)
#pragma unroll
                for (int kg = 0; kg < 4; ++kg) {
                    bf16x8 kf = *(const bf16x8*)(Kb + (kg * 16 + l15) * 136 + wh * 64 + ks * 32 + quad * 8);
                    S[kg][0] = mfma16(kf, Qst[(wh * 4 + 0 + ks) * 64], S[kg][0]);
                    S[kg][1] = mfma16(kf, Qst[(wh * 4 + 2 + ks) * 64], S[kg][1]);
                }
            bf16x8 Pf[2][2];
#pragma unroll
            for (int qg = 0; qg < 2; ++qg) {
                float mx = -1e30f;
#pragma unroll
                for (int kg = 0; kg < 4; ++kg)
#pragma unroll
                    for (int j = 0; j < 4; ++j) mx = fmaxf(mx, S[kg][qg][j]);
                mx = fmaxf(mx, __shfl_xor(mx, 16)); mx = fmaxf(mx, __shfl_xor(mx, 32));
                mx *= L2E;
                if (__builtin_amdgcn_ballot_w64(mx > mrun[wh][qg] + 8.f) != 0ull) {
                    const float mnew = fmaxf(mrun[wh][qg], mx);
                    const float alpha = __builtin_amdgcn_exp2f(mrun[wh][qg] - mnew);
                    mrun[wh][qg] = mnew;
                    lrun[wh][qg] *= alpha;
#pragma unroll
                    for (int dg = 0; dg < 8; ++dg)
#pragma unroll
                        for (int j = 0; j < 4; ++j) O[wh][dg][qg][j] *= alpha;
                }
                const float mref = mrun[wh][qg];
                float ps = 0.f;
#pragma unroll
                for (int kg = 0; kg < 4; ++kg)
#pragma unroll
                    for (int j = 0; j < 4; ++j) { float pv = __builtin_amdgcn_exp2f(S[kg][qg][j] * L2E - mref); ps += pv; S[kg][qg][j] = pv; }
                lrun[wh][qg] += ps;
#pragma unroll
                for (int s_ = 0; s_ < 2; ++s_) {
                    u32x4 pk; pk[0] = pack2(S[2 * s_][qg][0], S[2 * s_][qg][1]); pk[1] = pack2(S[2 * s_][qg][2], S[2 * s_][qg][3]);
                    pk[2] = pack2(S[2 * s_ + 1][qg][0], S[2 * s_ + 1][qg][1]); pk[3] = pack2(S[2 * s_ + 1][qg][2], S[2 * s_ + 1][qg][3]);
                    Pf[qg][s_] = __builtin_bit_cast(bf16x8, pk);
                }
            }
#pragma unroll
            for (int dg = 0; dg < 8; ++dg)
#pragma unroll
                for (int s_ = 0; s_ < 2; ++s_) {
                    bf16x8 vf = *(const bf16x8*)(Vb + (dg * 16 + l15) * 72 + s_ * 32 + quad * 8);
                    O[wh][dg][0] = mfma16(vf, Pf[0][s_], O[wh][dg][0]);
                    O[wh][dg][1] = mfma16(vf, Pf[1][s_], O[wh][dg][1]);
                }
        }
        if (t + 1 < nt_keys) {
            bf16_t* Kn = K_s + ((t + 1) & 1) * (64 * 136); bf16_t* Vn = V_s + ((t + 1) & 1) * (128 * 72);
#pragma unroll
            for (int i = 0; i < 4; ++i) { *(u32x4*)(Kn + kpos * 136 + kseg + i * 8) = kreg[i]; *(u32x4*)(Vn + vr * 72 + vh + i * 8) = vreg[i]; }
        }
        __syncthreads();
    }
    const float* dnw = p.in[I_DANORM] + l * 128;
#pragma unroll
    for (int qg = 0; qg < 2; ++qg) {
        float l1 = lrun[0][qg], l2 = lrun[1][qg];
        l1 += __shfl_xor(l1, 16); l1 += __shfl_xor(l1, 32); l2 += __shfl_xor(l2, 16); l2 += __shfl_xor(l2, 32);
        const float i1 = 1.f / l1, i2 = lam / l2;
        float ss = 0.f;
#pragma unroll
        for (int dg = 0; dg < 8; ++dg)
#pragma unroll
            for (int j = 0; j < 4; ++j) { float o = O[0][dg][qg][j] * i1 - O[1][dg][qg][j] * i2; O[0][dg][qg][j] = o; ss += o * o; }
        ss += __shfl_xor(ss, 16); ss += __shfl_xor(ss, 32);
        const float rstd = rsqrtf(ss * (1.f / 128.f) + 1e-5f) * (1.f - lam_init);
        bf16_t* op = P + ((size_t)b * SB + qt * 128 + wv * 32 + qg * 16 + l15) * PW + C_DAQ + h * 128;
#pragma unroll
        for (int dg = 0; dg < 8; ++dg) {
            const int dv0 = dg * 16 + quad * 4;
            u32x2 o; o.x = pack2(O[0][dg][qg][0] * rstd * dnw[dv0], O[0][dg][qg][1] * rstd * dnw[dv0 + 1]);
            o.y = pack2(O[0][dg][qg][2] * rstd * dnw[dv0 + 2], O[0][dg][qg][3] * rstd * dnw[dv0 + 3]);
            *(u32x2*)(op + dv0) = o;
        }
    }
}

DEV void phase_mix(const Params& p, int l, unsigned char* smem) {
    const bool need_ctx = l == 0;
    const float lam_init = l == 0 ? 0.2f : 0.35550906759096926f;
    unsigned* ctr = (unsigned*)(p.ws + O_CTL) + l;
    unsigned* actr = (unsigned*)(p.ws + O_CTL) + 16 + l * 8;
    __shared__ int s_item;
    const int nqt = need_ctx ? 34 : 32;
    auto next = [&](unsigned* c) -> int {
        __syncthreads();
        if (threadIdx.x == 0) s_item = (int)atomicAdd(c, 1u);
        __syncthreads();
        return __builtin_amdgcn_readfirstlane(s_item);
    };
    int it = next(ctr);
#pragma unroll 1
    while (it < 64) { dn_item(p, l, it, smem); it = next(ctr); }
#pragma unroll 1
    while (it < 128) { lru_item(p, l, it - 64, smem); it = next(ctr); }
    const int myx = blockIdx.x & 7;
#pragma unroll 1
    for (int k = 0; k < 8; ++k) {
        const int x = (myx + k) & 7;
        it = next(actr + x);
#pragma unroll 1
        while (it < 4 * nqt) {
            const int bh = x + 8 * (it / nqt), idx = it % nqt;
            const int qt = idx < 32 ? idx + 2 : idx - 32;
            att_item(p, l, bh >> 2, bh & 3, qt, lam_init, smem);
            it = next(actr + x);
        }
    }
}

#define XB_TMO      128
#define XB_XCNT(j)  (256  + 64 * (j))
#define XB_XSUB(j)  (1280 + 64 * (j))
#define XB_XGEN(j)  (2304 + 64 * (j))
#define XB_TOP      3328
#define XB_TOPGEN   3392
#define XCD_BAR_WORDS 3456
#define XB_SPIN_CAP (1u << 18)
#define LAS __attribute__((address_space(3)))
DEV unsigned xb_ld(unsigned* p)              { return __hip_atomic_load(p, __ATOMIC_RELAXED, __HIP_MEMORY_SCOPE_AGENT); }
DEV unsigned xb_add(unsigned* p, unsigned v) { return __hip_atomic_fetch_add(p, v, __ATOMIC_RELAXED, __HIP_MEMORY_SCOPE_AGENT); }
DEV unsigned xb_xcc_id() { return (unsigned)__builtin_amdgcn_s_getreg((3 << 11) | 20) & 0xFu; }
#define XB_SPIN(cond, bar) do { unsigned _sp = 0; while (cond) { __builtin_amdgcn_s_sleep(1); \
    if ((++_sp & 255u) == 0u) { if (xb_ld(&(bar)[XB_TMO])) break; if (_sp > XB_SPIN_CAP) { atomicAdd(&(bar)[XB_TMO], 1u); break; } } } } while (0)
struct XcdBarrier { unsigned* bar; unsigned x; volatile LAS unsigned* st; };
DEV XcdBarrier xcd_barrier_post(unsigned* bar, volatile LAS unsigned* st) {
    XcdBarrier b; b.bar = bar; b.x = xb_xcc_id(); b.st = st;
    if (threadIdx.x == 0) (void)xb_add(&bar[XB_XCNT(b.x)], 1u);
    return b;
}
DEV void xcd_barrier_complete(unsigned* bar, unsigned x, unsigned& nloc, unsigned& nx) {
    const unsigned G = gridDim.x * gridDim.y * gridDim.z;
    unsigned sum, cnt, mine, sp = 0u;
    for (;;) {
        sum = 0u; cnt = 0u; mine = 0u;
#pragma unroll
        for (unsigned j = 0; j < 16; ++j) { const unsigned c = xb_ld(&bar[XB_XCNT(j)]); sum += c; cnt += (c > 0u) ? 1u : 0u; mine = (j == x) ? c : mine; }
        if (sum == G) break;
        __builtin_amdgcn_s_sleep(1);
        if ((++sp & 255u) == 0u) { if (xb_ld(&bar[XB_TMO])) break; if (sp > XB_SPIN_CAP) { atomicAdd(&bar[XB_TMO], 1u); break; } }
    }
    nloc = mine > 0u ? mine : 1u; nx = cnt > 0u ? cnt : 1u;
}
DEV void xcd_barrier(const XcdBarrier& b) {
    asm volatile("s_waitcnt vmcnt(0)" ::: "memory");
    __syncthreads();
    if (threadIdx.x == 0) {
        unsigned* bar = b.bar;
        __builtin_amdgcn_s_waitcnt(0);
        unsigned nloc = b.st[0], nx = b.st[1];
        if (nloc == 0u) { xcd_barrier_complete(bar, b.x, nloc, nx); b.st[0] = nloc; b.st[1] = nx; }
        const unsigned old = xb_add(&bar[XB_XSUB(b.x)], 1u);
        const unsigned gen = old / nloc;
        if (old + 1u == (gen + 1u) * nloc) {
            __builtin_amdgcn_fence(__ATOMIC_RELEASE, "agent");
            asm volatile("s_waitcnt vmcnt(0)" ::: "memory");
            const unsigned og = xb_add(&bar[XB_TOP], 1u);
            const unsigned tg = og / nx;
            if (og + 1u == (tg + 1u) * nx) xb_add(&bar[XB_TOPGEN], 1u);
            else XB_SPIN(xb_ld(&bar[XB_TOPGEN]) == tg, bar);
            __builtin_amdgcn_fence(__ATOMIC_ACQUIRE, "agent");
            xb_add(&bar[XB_XGEN(b.x)], 1u);
            asm volatile("s_waitcnt vmcnt(0)" ::: "memory");
        } else {
            XB_SPIN(xb_ld(&bar[XB_XGEN(b.x)]) == gen, bar);
            __builtin_amdgcn_fence(__ATOMIC_ACQUIRE, "agent");
            asm volatile("s_waitcnt vmcnt(0)" ::: "memory");
        }
    }
    __syncthreads();
}

constexpr int NPHASE = 1 + 2 * 9 + 1;
DEV void run_phase(const Params& p, int ph, unsigned char* smem) {
    if (ph == 0) { phase_mod(p, smem); phase_rope(p); __syncthreads(); phase_wconv(p, 0, smem); return; }
    if (ph == NPHASE - 1) { phase_final(p); return; }
    const int l = (ph - 1) / 9, q = (ph - 1) % 9;
    const bool first = l == 0, lat = l == 1;
    const bf16_t* W = wsb(p, O_WT);
    switch (q) {
        case 0: if (l == 1) phase_wconv(p, 1, smem); phase_norm(p, l, 0, first, false); break;
        case 1: phase_g1(p, smem); break;
        case 2: phase_mix(p, l, smem); break;
        case 3: phase_fin_norm(p, l, first, lat); break;
        case 4: phase_gate(p, lat, smem); break;
        case 5: phase_resid(p, l, wsb(p, O_U), D, W + W_OUT, 1024, 2, first, lat, smem); break;
        case 6: phase_norm(p, l, 1, false, lat); break;
        case 7: phase_gu(p, lat, smem); break;
        case 8: phase_resid(p, l, wsb(p, O_P), PW, W + W_DN, DFF, 5, false, lat, smem); break;
    }
}

#if MEGA
__global__ void __launch_bounds__(256) mega_kernel(Params p) {
    extern __shared__ __align__(16) unsigned char smem[];
    cg::grid_group grid = cg::this_grid();
    __shared__ uint4 xb_words;
    if (threadIdx.x == 0) xb_words = make_uint4(0u, 0u, 0u, 0u);
    __syncthreads();
    const XcdBarrier xb = xcd_barrier_post((unsigned*)(p.ws + O_BAR), (volatile LAS unsigned*)&xb_words);
    phase_mod(p, smem); phase_rope(p); __syncthreads(); phase_wconv(p, 0, smem);
    grid.sync();
    const bf16_t* W = wsb(p, O_WT);
#pragma unroll
    for (int l = 0; l < 2; ++l) {
        const bool first = l == 0, lat = l == 1;
        if (l == 1) phase_wconv(p, 1, smem);
        phase_norm(p, l, 0, first, false);
        xcd_barrier(xb);
        phase_g1(p, smem);
        xcd_barrier(xb);
        phase_mix(p, l, smem);
        xcd_barrier(xb);
        phase_fin_norm(p, l, first, lat);
        xcd_barrier(xb);
        phase_gate(p, lat, smem);
        xcd_barrier(xb);
        phase_merge(p, lat, smem);
        xcd_barrier(xb);
        phase_resid(p, l, wsb(p, O_U), D, W + W_OUT, 1024, 2, first, lat, smem);
        xcd_barrier(xb);
        phase_norm(p, l, 1, false, lat);
        xcd_barrier(xb);
        phase_gu(p, lat, smem);
        xcd_barrier(xb);
        phase_resid(p, l, wsb(p, O_P), PW, W + W_DN, DFF, 5, false, lat, smem);
        xcd_barrier(xb);
    }
    phase_final(p);
}
#else
__global__ void __launch_bounds__(256) phase_kernel(Params p, int ph) {
    extern __shared__ __align__(16) unsigned char smem[];
    run_phase(p, ph, smem);
}
#endif

extern "C" void kernel_launch(void* const* d_in, const int* in_sizes, int n_in, void* d_out, int out_size, void* d_ws, size_t ws_size, hipStream_t stream) {
    static int grid = 0;
    if (grid == 0) {
        if (n_in != 28 || ws_size < WS_END) { fprintf(stderr, "kernel_launch: unexpected n_in %d or ws_size %zu < %zu\n", n_in, ws_size, (size_t)WS_END); grid = -1; return; }
        int dev = 0, cus = 0, per_cu = 0;
        hipGetDevice(&dev);
        hipDeviceGetAttribute(&cus, hipDeviceAttributeMultiprocessorCount, dev);
#if MEGA
        hipFuncSetAttribute((const void*)mega_kernel, hipFuncAttributeMaxDynamicSharedMemorySize, LDS_BYTES);
        hipOccupancyMaxActiveBlocksPerMultiprocessor(&per_cu, (const void*)mega_kernel, 256, LDS_BYTES);
#else
        hipFuncSetAttribute((const void*)phase_kernel, hipFuncAttributeMaxDynamicSharedMemorySize, LDS_BYTES);
        hipOccupancyMaxActiveBlocksPerMultiprocessor(&per_cu, (const void*)phase_kernel, 256, LDS_BYTES);
#endif
        if (per_cu < 1) per_cu = 1;
        grid = cus * per_cu;
        fprintf(stderr, "kernel_launch: grid %d (%d CUs x %d)\n", grid, cus, per_cu);
    }
    if (grid < 0) return;
    hipMemsetAsync((char*)d_ws + O_CTL, 0, 4096 + 16384, stream);
    Params p{};
    for (int i = 0; i < 28; ++i) p.in[i] = (const float*)d_in[i];
    p.out = (float*)d_out; p.ws = (unsigned char*)d_ws;
#if MEGA
    void* args[] = {&p};
    hipError_t e = hipLaunchCooperativeKernel((const void*)mega_kernel, dim3(grid), dim3(256), args, LDS_BYTES, stream);
    if (e != hipSuccess) fprintf(stderr, "cooperative launch failed: %s (grid %d)\n", hipGetErrorString(e), grid);
#else
    for (int ph = 0; ph < NPHASE; ++ph) hipLaunchKernelGGL(phase_kernel, dim3(grid), dim3(256), LDS_BYTES, stream, p, ph);
#endif
}
```

```cpp
#include <hip/hip_runtime.h>
#include <hip/hip_cooperative_groups.h>
#include <cstdio>
#include <cstdint>
namespace cg = cooperative_groups;

#ifndef MEGA
#define MEGA 1
#endif

typedef unsigned short bf16_t;
typedef short bf16x8 __attribute__((ext_vector_type(8)));
typedef float f32x4 __attribute__((ext_vector_type(4)));
typedef unsigned u32x4 __attribute__((ext_vector_type(4)));
typedef unsigned u32x2 __attribute__((ext_vector_type(2)));
#define DEV __device__ __forceinline__

constexpr int D = 1024, NB = 8, SEQ = 4096, CTXL = 256, SB = 4352, MR = NB * SB, PW = 4096, DFF = 2816;
constexpr int C_DNQ = 0, C_DNK = 512, C_DNV = 1024, C_DNZ = 1536, C_LX = 2048, C_LG = 2560, C_DAQ = 3072, C_DAK = 3584;
constexpr int NIN = 4736;
constexpr int GLD = 80;

enum { I_X = 0, I_C, I_CTX, I_CCTX, I_WMOD, I_BMOD, I_NMIX, I_NFFN, I_WIN, I_DNCONV, I_DNALOG, I_DNDT, I_DNNORM, I_LCW, I_LCB,
       I_LWA, I_LBA, I_LWI, I_LBI, I_LLAM, I_DALAM, I_DANORM, I_WBR, I_WOUT, I_WFG, I_WFU, I_WFD, I_NFIN };

constexpr size_t al256(size_t x) { return (x + 255) & ~(size_t)255; }
constexpr size_t O_CTL = 0;
constexpr size_t O_BAR = 4096;
constexpr size_t O_MOD = 4096 + 16384;
constexpr size_t O_ROPE = al256(O_MOD + (size_t)2 * 9 * 6144 * 4);
constexpr size_t O_WT = al256(O_ROPE + 64 * 16 * 2 * 4);
constexpr size_t W_IN = 0, W_GATE = W_IN + (size_t)NIN * 1024, W_BR = W_GATE + (size_t)3072 * 1024, W_OUT = W_BR + (size_t)3 * 1024 * 512,
                 W_GU = W_OUT + (size_t)1024 * 1024, W_DN = W_GU + (size_t)5632 * 1024, W_END = W_DN + (size_t)1024 * 2816;
constexpr size_t O_HCTX = al256(O_WT + W_END * 2);
constexpr size_t O_U = al256(O_HCTX + (size_t)2048 * 1024 * 4);
constexpr size_t O_P = al256(O_U + (size_t)MR * 1024 * 2);
constexpr size_t O_AB = al256(O_P + (size_t)MR * PW * 2);
constexpr size_t O_TA = al256(O_AB + (size_t)MR * 16 * 4);
constexpr size_t O_TA2 = al256(O_TA + (size_t)MR * 512 * 2);
constexpr size_t O_VT = al256(O_TA2 + (size_t)MR * 512 * 2);
constexpr size_t WS_END = al256(O_VT + (size_t)MR * 512 * 2);

constexpr int LDS_BYTES = 140 * 1024;

struct Params {
    const float* in[28];
    float* out;
    unsigned char* ws;
};

DEV int get_tid() { int t = threadIdx.x; asm volatile("" : "+v"(t)); return t; }
DEV float bf2f(bf16_t h) { return __uint_as_float(((unsigned)h) << 16); }
DEV bf16_t f2bf(float f) { unsigned u = __float_as_uint(f); u += 0x7fffu + ((u >> 16) & 1u); return (bf16_t)(u >> 16); }
typedef float f32x2_ __attribute__((ext_vector_type(2)));
typedef __bf16 bf16x2_ __attribute__((ext_vector_type(2)));
DEV unsigned pack2(float a, float b) { const f32x2_ v = {a, b}; return __builtin_bit_cast(unsigned, __builtin_convertvector(v, bf16x2_)); }
DEV float sigm(float x) { return __builtin_amdgcn_rcpf(1.f + __expf(-x)); }
DEV float silu(float x) { return x * __builtin_amdgcn_rcpf(1.f + __expf(-x)); }
DEV float softplus(float x) { return x > 20.f ? x : log1pf(expf(x)); }
DEV float softplus_fast(float x) { const float e = __expf(x); return x > 15.f ? x : (e < 0.01f ? e * (1.f - e * (0.5f - e * 0.33333333f)) : __logf(1.f + e)); }
DEV float gelu_tanh(float x) { float u = 0.7978845608028654f * (x + 0.044715f * x * x * x); float t = 1.f - 2.f * __builtin_amdgcn_rcpf(1.f + __expf(2.f * u)); return 0.5f * x * (1.f + t); }
DEV f32x4 mfma16(bf16x8 a, bf16x8 b, f32x4 c) { return __builtin_amdgcn_mfma_f32_16x16x32_bf16(a, b, c, 0, 0, 0); }
DEV void mfma16a(f32x4& c, bf16x8 a, bf16x8 b) { asm volatile("v_mfma_f32_16x16x32_bf16 %0, %1, %2, %0" : "+a"(c) : "v"(a), "v"(b)); }
DEV float lo16(unsigned v) { return __uint_as_float(v << 16); }
DEV float hi16(unsigned v) { return __uint_as_float(v & 0xffff0000u); }

DEV bf16_t* wsb(const Params& p, size_t off) { return (bf16_t*)(p.ws + off); }
DEV float* wsf(const Params& p, size_t off) { return (float*)(p.ws + off); }
DEV float* hrow(const Params& p, int r) { int b = r / SB, s = r - b * SB; return s < CTXL ? wsf(p, O_HCTX) + (size_t)(b * CTXL + s) * D : p.out + (size_t)(b * SEQ + s - CTXL) * D; }
DEV const float* xrow(const Params& p, int r) { int b = r / SB, s = r - b * SB; return s < CTXL ? p.in[I_CTX] + (size_t)(b * CTXL + s) * D : p.in[I_X] + (size_t)(b * SEQ + s - CTXL) * D; }
DEV int modrow(int r) { int b = r / SB, s = r - b * SB; return s < CTXL ? 8 : b; }

template <int MT, int NT>
DEV void gemm_core(const bf16_t* __restrict__ A, int lda, const bf16_t* __restrict__ Bt, int ldb, int K, f32x4 (&acc)[MT][NT], bf16_t* smem_) {
    constexpr int SA = 32 * MT * GLD, SBB = 32 * NT * GLD;
    bf16_t* sA = smem_; bf16_t* sB = smem_ + 2 * SA;
    const int tid = get_tid(), lane = tid & 63, wv = tid >> 6, wr = wv >> 1, wc = wv & 1, l15 = lane & 15, quad = lane >> 4;
    const int lr = tid >> 3, lc = (tid & 7) * 8;
    u32x4 ra0[MT], rb0[NT], ra1[MT], rb1[NT];
    const bf16_t* Ap = A + (size_t)lr * lda + lc;
    const bf16_t* Bp = Bt + (size_t)lr * ldb + lc;
    const int nk = K >> 6;
#define GLOAD(RA, RB, KT) { const int ko_ = (KT) * 64; _Pragma("unroll") for (int i = 0; i < MT; ++i) RA[i] = *(const u32x4*)(Ap + (size_t)(32 * i) * lda + ko_); \
                            _Pragma("unroll") for (int i = 0; i < NT; ++i) RB[i] = *(const u32x4*)(Bp + (size_t)(32 * i) * ldb + ko_); }
#define LSTORE(RA, RB, BUF) { _Pragma("unroll") for (int i = 0; i < MT; ++i) *(u32x4*)(sA + (BUF) * SA + (lr + 32 * i) * GLD + lc) = RA[i]; \
                              _Pragma("unroll") for (int i = 0; i < NT; ++i) *(u32x4*)(sB + (BUF) * SBB + (lr + 32 * i) * GLD + lc) = RB[i]; }
#define AFRAG(BUF, MT_, KS) (*(const bf16x8*)(sA + (BUF) * SA + (wr * MT * 16 + (MT_) * 16 + l15) * GLD + (KS) * 32 + quad * 8))
#define HALF(BUFC, RA, RB, BUFS, DO_STORE, DO_LOAD, KT) { \
        bf16x8 bfr[2][NT]; \
        _Pragma("unroll") for (int ks = 0; ks < 2; ++ks) _Pragma("unroll") for (int nt = 0; nt < NT; ++nt) \
            bfr[ks][nt] = *(const bf16x8*)(sB + (BUFC) * SBB + (wc * NT * 16 + nt * 16 + l15) * GLD + ks * 32 + quad * 8); \
        bf16x8 a0 = AFRAG(BUFC, 0, 0), a1 = AFRAG(BUFC, 0, 1); \
        const int ko_ = (KT) * 64; \
        _Pragma("unroll") for (int mt = 0; mt < MT; ++mt) { \
            bf16x8 n0 = a0, n1 = a1; \
            if (DO_STORE) { *(u32x4*)(sA + (BUFS) * SA + (lr + 32 * mt) * GLD + lc) = RA[mt]; } \
            if (DO_LOAD) { RA[mt] = *(const u32x4*)(Ap + (size_t)(32 * mt) * lda + ko_); } \
            _Pragma("unroll") for (int nt = 0; nt < NT; ++nt) mfma16a(acc[mt][nt], bfr[0][nt], a0); \
            if (mt + 1 < MT) { n0 = AFRAG(BUFC, mt + 1, 0); n1 = AFRAG(BUFC, mt + 1, 1); } \
            if (DO_STORE) { if (mt < NT) *(u32x4*)(sB + (BUFS) * SBB + (lr + 32 * mt) * GLD + lc) = RB[mt]; } \
            if (DO_LOAD) { if (mt < NT) RB[mt] = *(const u32x4*)(Bp + (size_t)(32 * mt) * ldb + ko_); } \
            _Pragma("unroll") for (int nt = 0; nt < NT; ++nt) mfma16a(acc[mt][nt], bfr[1][nt], a1); \
            a0 = n0; a1 = n1; \
        } }
    static_assert(NT <= MT, "HALF stages the B pieces alongside the first NT A pieces");
    GLOAD(ra0, rb0, 0);
    GLOAD(ra1, rb1, 1);
    __syncthreads();
    LSTORE(ra0, rb0, 0);
    GLOAD(ra0, rb0, 2);
    __syncthreads();
    int kt = 0;
#pragma unroll 1
    for (; kt + 4 < nk; kt += 2) {
        HALF(0, ra1, rb1, 1, true, true, kt + 3);
        __syncthreads();
        HALF(1, ra0, rb0, 0, true, true, kt + 4);
        __syncthreads();
    }
    HALF(0, ra1, rb1, 1, true, true, kt + 3);
    __syncthreads();
    HALF(1, ra0, rb0, 0, true, false, 0);
    __syncthreads();
    HALF(0, ra1, rb1, 1, true, false, 0);
    __syncthreads();
    HALF(1, ra0, rb0, 0, false, false, 0);
    __syncthreads();
#undef AFRAG
#undef HALF
#undef GLOAD
#undef LSTORE
    static_assert(NT == 4, "the accumulator fence is written for NT == 4");
#pragma unroll
    for (int mt = 0; mt < MT; ++mt) {
        if (mt == 0) asm volatile("s_nop 15\n\ts_nop 15" : "+a"(acc[mt][0]), "+a"(acc[mt][1]), "+a"(acc[mt][2]), "+a"(acc[mt][3]));
        else asm volatile("s_nop 0" : "+a"(acc[mt][0]), "+a"(acc[mt][1]), "+a"(acc[mt][2]), "+a"(acc[mt][3]));
    }
}
template <int MT, int NT>
DEV void gemm_core1(const bf16_t* __restrict__ A, int lda, const bf16_t* __restrict__ Bt, int ldb, int K, f32x4 (&acc)[MT][NT], bf16_t* sA, bf16_t* sB) {
    const int tid = get_tid(), lane = tid & 63, wv = tid >> 6, wr = wv >> 1, wc = wv & 1, l15 = lane & 15, quad = lane >> 4;
    const int lr = tid >> 3, lc = (tid & 7) * 8;
    u32x4 ra[MT], rb[NT];
    const bf16_t* Ap = A + (size_t)lr * lda + lc;
    const bf16_t* Bp = Bt + (size_t)lr * ldb + lc;
#pragma unroll
    for (int i = 0; i < MT; ++i) ra[i] = *(const u32x4*)(Ap + (size_t)(32 * i) * lda);
#pragma unroll
    for (int i = 0; i < NT; ++i) rb[i] = *(const u32x4*)(Bp + (size_t)(32 * i) * ldb);
    const int nk = K >> 6;
    for (int kt = 0; kt < nk; ++kt) {
        __syncthreads();
#pragma unroll
        for (int i = 0; i < MT; ++i) *(u32x4*)(sA + (lr + 32 * i) * GLD + lc) = ra[i];
#pragma unroll
        for (int i = 0; i < NT; ++i) *(u32x4*)(sB + (lr + 32 * i) * GLD + lc) = rb[i];
        __syncthreads();
        if (kt + 1 < nk) {
            const int ko = (kt + 1) * 64;
#pragma unroll
            for (int i = 0; i < MT; ++i) ra[i] = *(const u32x4*)(Ap + (size_t)(32 * i) * lda + ko);
#pragma unroll
            for (int i = 0; i < NT; ++i) rb[i] = *(const u32x4*)(Bp + (size_t)(32 * i) * ldb + ko);
        }
#pragma unroll
        for (int ks = 0; ks < 2; ++ks) {
            bf16x8 af[MT], bfr[NT];
#pragma unroll
            for (int mt = 0; mt < MT; ++mt) af[mt] = *(const bf16x8*)(sA + (wr * MT * 16 + mt * 16 + l15) * GLD + ks * 32 + quad * 8);
#pragma unroll
            for (int nt = 0; nt < NT; ++nt) bfr[nt] = *(const bf16x8*)(sB + (wc * NT * 16 + nt * 16 + l15) * GLD + ks * 32 + quad * 8);
#pragma unroll
            for (int mt = 0; mt < MT; ++mt)
#pragma unroll
                for (int nt = 0; nt < NT; ++nt) mfma16a(acc[mt][nt], bfr[nt], af[mt]);
        }
    }
    static_assert(NT == 4, "the accumulator fence is written for NT == 4");
#pragma unroll
    for (int mt = 0; mt < MT; ++mt) {
        if (mt == 0) asm volatile("s_nop 15\n\ts_nop 15" : "+a"(acc[mt][0]), "+a"(acc[mt][1]), "+a"(acc[mt][2]), "+a"(acc[mt][3]));
        else asm volatile("s_nop 0" : "+a"(acc[mt][0]), "+a"(acc[mt][1]), "+a"(acc[mt][2]), "+a"(acc[mt][3]));
    }
}
template <int MT, int NT>
DEV void zero_acc(f32x4 (&acc)[MT][NT]) {
#pragma unroll
    for (int mt = 0; mt < MT; ++mt)
#pragma unroll
        for (int nt = 0; nt < NT; ++nt) acc[mt][nt] = (f32x4){0.f, 0.f, 0.f, 0.f};
}

DEV void phase_mod(const Params& p, unsigned char* smem) {
    float* s_s = (float*)smem;
    float* red = s_s + 9 * 1024;
    const int tid = get_tid();
    bool loaded = false;
    for (int it = blockIdx.x; it < 2 * 96; it += gridDim.x) {
        if (!loaded) {
            for (int e = tid; e < 9 * 1024; e += 256) { float v = e < 8192 ? p.in[I_C][e] : p.in[I_CCTX][e - 8192]; s_s[e] = silu(v); }
            loaded = true;
        }
        __syncthreads();
        const int l = it / 96, cg_ = it % 96, cq = tid & 63, kq = tid >> 6, col = cg_ * 64 + cq;
        float acc[9];
#pragma unroll
        for (int r = 0; r < 9; ++r) acc[r] = 0.f;
        const float* wp = p.in[I_WMOD] + ((size_t)l * 1024 + kq * 256) * 6144 + col;
#pragma unroll 8
        for (int k = 0; k < 256; ++k) {
            float wv = wp[(size_t)k * 6144];
#pragma unroll
            for (int r = 0; r < 9; ++r) acc[r] += s_s[r * 1024 + kq * 256 + k] * wv;
        }
#pragma unroll
        for (int r = 0; r < 9; ++r) red[(kq * 9 + r) * 64 + cq] = acc[r];
        __syncthreads();
        for (int e = tid; e < 9 * 64; e += 256) {
            int r = e >> 6, c2 = e & 63;
            float v = red[(0 * 9 + r) * 64 + c2] + red[(1 * 9 + r) * 64 + c2] + red[(2 * 9 + r) * 64 + c2] + red[(3 * 9 + r) * 64 + c2];
            wsf(p, O_MOD)[((size_t)l * 9 + r) * 6144 + cg_ * 64 + c2] = v + p.in[I_BMOD][l * 6144 + cg_ * 64 + c2];
        }
        __syncthreads();
    }
}
DEV void phase_rope(const Params& p) {
    if (blockIdx.x == (gridDim.x - 1)) {
        for (int e = threadIdx.x; e < 1024; e += 256) {
            int pos = e >> 4, i = e & 15;
            float inv = powf(10000.f, -(float)i / 16.f);
            float ang = (float)pos * inv;
            float n = rintf(ang * 0.15915494309189535f);
            float r = fmaf(-n, 6.28125f, ang);
            r = fmaf(-n, 1.9353071795864769e-3f, r);
            wsf(p, O_ROPE)[e * 2] = cosf(r);
            wsf(p, O_ROPE)[e * 2 + 1] = sinf(r);
        }
    }
}
DEV void wconv_tile(const float* src0, const float* src1, int lds_, int K, bf16_t* dst, int kind, int kt, int nt, bf16_t* tile) {
    const int tid = get_tid();
    const int kk = tid >> 2, grp = tid & 3;
    const int n0 = nt * 64, k0 = kt * 64;
    const int ng = n0 + grp * 16;
    const float* src = src0; int sc;
    if (kind == 0) { sc = ng < 2048 ? ng : (ng < 4608 ? ng + 16 : (ng < 4624 ? 2048 : -1)); }
    else if (kind == 1) { sc = 4624 + ng; }
    else if (kind == 2) { sc = ng; }
    else { int gd = ng >> 4; src = (gd & 1) ? src1 : src0; sc = (gd >> 1) * 16; }
    __syncthreads();
    if (sc >= 0) {
        const float4* sp = (const float4*)(src + (size_t)(k0 + kk) * lds_ + sc);
#pragma unroll
        for (int q = 0; q < 4; ++q) { float4 v = sp[q]; int e = grp * 16 + q * 4;
            tile[(e + 0) * GLD + kk] = f2bf(v.x); tile[(e + 1) * GLD + kk] = f2bf(v.y); tile[(e + 2) * GLD + kk] = f2bf(v.z); tile[(e + 3) * GLD + kk] = f2bf(v.w); }
    } else {
#pragma unroll
        for (int e = 0; e < 16; ++e) tile[(grp * 16 + e) * GLD + kk] = 0;
    }
    __syncthreads();
    const int n = tid >> 2, kseg = (tid & 3) * 16;
    u32x4 a = *(const u32x4*)(tile + n * GLD + kseg), b = *(const u32x4*)(tile + n * GLD + kseg + 8);
    bf16_t* dp = dst + (size_t)(n0 + n) * K + k0 + kseg;
    *(u32x4*)dp = a; *(u32x4*)(dp + 8) = b;
}
DEV void phase_wconv(const Params& p, int l, unsigned char* smem) {
    bf16_t* tile = (bf16_t*)smem;
    bf16_t* W = wsb(p, O_WT);
    constexpr int T0 = 74 * 16, T1 = T0 + 48 * 16, T2 = T1 + 3 * 16 * 8, T3 = T2 + 16 * 16, T4 = T3 + 88 * 16, T5 = T4 + 16 * 44;
    for (int t = blockIdx.x; t < T5; t += gridDim.x) {
        if (t < T0) { wconv_tile(p.in[I_WIN] + (size_t)l * 1024 * 7696, nullptr, 7696, 1024, W + W_IN, 0, t % 16, t / 16, tile); }
        else if (t < T1) { int u = t - T0; wconv_tile(p.in[I_WIN] + (size_t)l * 1024 * 7696, nullptr, 7696, 1024, W + W_GATE, 1, u % 16, u / 16, tile); }
        else if (t < T2) { int u = t - T1; int n = u / 128, v = u % 128; wconv_tile(p.in[I_WBR] + ((size_t)l * 3 + n) * 512 * 1024, nullptr, 1024, 512, W + W_BR + (size_t)n * 1024 * 512, 2, v % 8, v / 8, tile); }
        else if (t < T3) { int u = t - T2; wconv_tile(p.in[I_WOUT] + (size_t)l * 1024 * 1024, nullptr, 1024, 1024, W + W_OUT, 2, u % 16, u / 16, tile); }
        else if (t < T4) { int u = t - T3; wconv_tile(p.in[I_WFG] + (size_t)l * 1024 * DFF, p.in[I_WFU] + (size_t)l * 1024 * DFF, DFF, 1024, W + W_GU, 3, u % 16, u / 16, tile); }
        else { int u = t - T4; wconv_tile(p.in[I_WFD] + (size_t)l * DFF * 1024, nullptr, 1024, DFF, W + W_DN, 2, u % 44, u / 44, tile); }
    }
}

DEV void norm_row(const Params& p, int l, int which, bool first, int r, int lane) {
    const float* h = first ? xrow(p, r) : hrow(p, r);
    const float* nw = p.in[which ? I_NFFN : I_NMIX] + l * D;
    const float* md = wsf(p, O_MOD) + ((size_t)l * 9 + modrow(r)) * 6144 + (which ? 3 * D : 0);
    float4 v[4]; float ss = 0.f;
#pragma unroll
    for (int i = 0; i < 4; ++i) { v[i] = *(const float4*)(h + i * 256 + lane * 4); ss += v[i].x * v[i].x + v[i].y * v[i].y + v[i].z * v[i].z + v[i].w * v[i].w; }
#pragma unroll
    for (int o = 32; o >= 1; o >>= 1) ss += __shfl_xor(ss, o);
    const float rstd = rsqrtf(ss * (1.f / D) + 1e-6f);
    bf16_t* up = wsb(p, O_U) + (size_t)r * D;
#pragma unroll
    for (int i = 0; i < 4; ++i) {
        const int c = i * 256 + lane * 4;
        float4 w4 = *(const float4*)(nw + c), sh = *(const float4*)(md + c), sc = *(const float4*)(md + D + c);
        float a = v[i].x * rstd * w4.x * (1.f + sc.x) + sh.x, b = v[i].y * rstd * w4.y * (1.f + sc.y) + sh.y;
        float c2 = v[i].z * rstd * w4.z * (1.f + sc.z) + sh.z, d = v[i].w * rstd * w4.w * (1.f + sc.w) + sh.w;
        u32x2 o; o.x = pack2(a, b); o.y = pack2(c2, d);
        *(u32x2*)(up + c) = o;
    }
}
DEV void phase_norm(const Params& p, int l, int which, bool first, bool skip_ctx) {
    const int tid_ = get_tid(); const int lane = tid_ & 63, wv = tid_ >> 6;
    for (int r = blockIdx.x * 4 + wv; r < MR; r += gridDim.x * 4) {
        if (skip_ctx && (r % SB) < CTXL) continue;
        norm_row(p, l, which, first, r, lane);
    }
}
DEV void phase_fin_norm(const Params& p, int l, bool first, bool skip_ctx) {
    const int tid_ = get_tid(); const int lane = tid_ & 63, wv = tid_ >> 6;
    const float* dnn = p.in[I_DNNORM] + l * 128;
    for (int r = blockIdx.x * 4 + wv; r < MR; r += gridDim.x * 4) {
        if (skip_ctx && (r % SB) < CTXL) continue;
        norm_row(p, l, 0, first, r, lane);
        bf16_t* ta = wsb(p, O_TA) + (size_t)r * 512 + lane * 8;
        const bf16_t* tb = wsb(p, O_TA2) + (size_t)r * 512 + lane * 8;
        const bf16_t* zz = wsb(p, O_P) + (size_t)r * PW + C_DNZ + lane * 8;
        u32x4 a = *(const u32x4*)ta, b = *(const u32x4*)tb, z = *(const u32x4*)zz;
        float o[8]; float ss = 0.f;
#pragma unroll
        for (int i = 0; i < 4; ++i) { o[2 * i] = lo16(a[i]) + lo16(b[i]); o[2 * i + 1] = hi16(a[i]) + hi16(b[i]); ss += o[2 * i] * o[2 * i] + o[2 * i + 1] * o[2 * i + 1]; }
#pragma unroll
        for (int of = 8; of >= 1; of >>= 1) ss += __shfl_xor(ss, of);
        const float rstd = rsqrtf(ss * (1.f / 128.f) + 1e-6f);
        const int dv0 = (lane & 15) * 8;
        u32x4 y;
#pragma unroll
        for (int i = 0; i < 4; ++i) {
            float y0 = o[2 * i] * rstd * dnn[dv0 + 2 * i] * silu(lo16(z[i]));
            float y1 = o[2 * i + 1] * rstd * dnn[dv0 + 2 * i + 1] * silu(hi16(z[i]));
            y[i] = pack2(y0, y1);
        }
        *(u32x4*)ta = y;
    }
}
DEV void phase_final(const Params& p) {
    const int tid_ = get_tid(); const int lane = tid_ & 63, wv = tid_ >> 6;
    const float* nw = p.in[I_NFIN];
    for (int r = blockIdx.x * 4 + wv; r < NB * SEQ; r += gridDim.x * 4) {
        float* h = p.out + (size_t)r * D;
        float4 v[4]; float ss = 0.f;
#pragma unroll
        for (int i = 0; i < 4; ++i) { v[i] = *(const float4*)(h + i * 256 + lane * 4); ss += v[i].x * v[i].x + v[i].y * v[i].y + v[i].z * v[i].z + v[i].w * v[i].w; }
#pragma unroll
        for (int o = 32; o >= 1; o >>= 1) ss += __shfl_xor(ss, o);
        const float rstd = rsqrtf(ss * (1.f / D) + 1e-6f);
#pragma unroll
        for (int i = 0; i < 4; ++i) {
            const int c = i * 256 + lane * 4;
            float4 w4 = *(const float4*)(nw + c);
            float4 o4; o4.x = v[i].x * rstd * w4.x; o4.y = v[i].y * rstd * w4.y; o4.z = v[i].z * rstd * w4.z; o4.w = v[i].w * rstd * w4.w;
            *(float4*)(h + c) = o4;
        }
    }
}

struct TileIter {
    int nn, total, nloc, L;
    DEV TileIter(int nm, int nn_) { nn = nn_; total = nm * nn_; nloc = gridDim.x >> 3; L = (blockIdx.x & 7) * nloc + (blockIdx.x >> 3); }
    DEV bool valid() const { return L < total; }
    DEV bool more() const { return (L - (int)(blockIdx.x >> 3)) < total; }
    DEV void next() { L += 8 * nloc; }
    DEV void get(int& tm, int& tn) const { const int pn = 4 * nn, panel = L / pn, rem = L - panel * pn; tn = rem >> 2; tm = panel * 4 + (rem & 3); }
};
DEV void phase_g1(const Params& p, unsigned char* smem) {
    bf16_t* sA = (bf16_t*)smem;
    const int tid = get_tid(), lane = tid & 63, wv = tid >> 6, wr = wv >> 1, wc = wv & 1, l15 = lane & 15, quad = lane >> 4;
    const bf16_t* U = wsb(p, O_U); const bf16_t* W = wsb(p, O_WT) + W_IN;
    bf16_t* P = wsb(p, O_P);
    const float* rope = wsf(p, O_ROPE);
    constexpr int NTN = NIN / 128;
    const int wr0_ = wr, wc0_ = wc, l150_ = l15, quad0_ = quad;
    for (TileIter ti(MR / 256, NTN); ti.valid(); ti.next()) {
        int tm, tn; ti.get(tm, tn);
        const int row0 = tm * 256, col0 = tn * 128;
        f32x4 acc[8][4]; zero_acc(acc);
        gemm_core<8, 4>(U + (size_t)row0 * D, D, W + (size_t)col0 * D, D, D, acc, sA);
        int tz = 0; asm volatile("" : "+v"(tz));
        const int wr = wr0_ + tz, wc = wc0_ + tz, l15 = l150_ + tz, quad = quad0_ + tz;
        if (tn < 24) {
#pragma unroll
            for (int mt = 0; mt < 8; ++mt) {
                __builtin_amdgcn_sched_barrier(0);
                bf16_t* pp = P + (size_t)(row0 + wr * 128 + mt * 16 + l15) * PW + col0 + wc * 64 + quad * 4;
#pragma unroll
                for (int nt = 0; nt < 4; ++nt) { u32x2 o; o.x = pack2(acc[mt][nt][0], acc[mt][nt][1]); o.y = pack2(acc[mt][nt][2], acc[mt][nt][3]); *(u32x2*)(pp + nt * 16) = o; }
            }
        } else if (tn < 32) {
            const float qs = tn < 28 ? 0.125f : 1.f;
#pragma unroll
            for (int mt = 0; mt < 8; ++mt) {
                __builtin_amdgcn_sched_barrier(0);
                const int row = row0 + wr * 128 + mt * 16 + l15;
                const int s_ = row % SB;
                f32x4 ca = {1.f, 1.f, 1.f, 1.f}, sa = {0.f, 0.f, 0.f, 0.f}, cb = {1.f, 1.f, 1.f, 1.f}, sb = {0.f, 0.f, 0.f, 0.f};
                if (s_ >= CTXL) { const int tt = s_ - CTXL, pr = tt >> 6, pc = tt & 63;
                    const f32x4 r0 = *(const f32x4*)(rope + (pr * 16 + quad * 4) * 2), r1 = *(const f32x4*)(rope + (pr * 16 + quad * 4) * 2 + 4);
                    const f32x4 r2 = *(const f32x4*)(rope + (pc * 16 + quad * 4) * 2), r3 = *(const f32x4*)(rope + (pc * 16 + quad * 4) * 2 + 4);
                    ca = (f32x4){r0[0], r0[2], r1[0], r1[2]}; sa = (f32x4){r0[1], r0[3], r1[1], r1[3]};
                    cb = (f32x4){r2[0], r2[2], r3[0], r3[2]}; sb = (f32x4){r2[1], r2[3], r3[1], r3[3]}; }
                const f32x4 x1 = acc[mt][0], x2 = acc[mt][1], y1 = acc[mt][2], y2 = acc[mt][3];
                const f32x4 o0 = (x1 * ca - x2 * sa) * qs, o1 = (x2 * ca + x1 * sa) * qs, o2 = (y1 * cb - y2 * sb) * qs, o3 = (y2 * cb + y1 * sb) * qs;
                bf16_t* pp = P + (size_t)row * PW + col0 + wc * 64 + quad * 4;
                u32x2 o; o.x = pack2(o0[0], o0[1]); o.y = pack2(o0[2], o0[3]); *(u32x2*)(pp) = o;
                o.x = pack2(o1[0], o1[1]); o.y = pack2(o1[2], o1[3]); *(u32x2*)(pp + 16) = o;
                o.x = pack2(o2[0], o2[1]); o.y = pack2(o2[2], o2[3]); *(u32x2*)(pp + 32) = o;
                o.x = pack2(o3[0], o3[1]); o.y = pack2(o3[2], o3[3]); *(u32x2*)(pp + 48) = o;
            }
        } else if (tn < 36) {
            bf16_t* VT = wsb(p, O_VT);
            const int b = row0 / SB, sbase = row0 - b * SB;
#pragma unroll
            for (int mt = 0; mt < 8; ++mt) {
                __builtin_amdgcn_sched_barrier(0);
                const int s_ = sbase + wr * 128 + mt * 16 + l15;
                const int vi0 = (b * 512 + col0 - 4096 + wc * 64 + quad * 4) * SB + s_;
#pragma unroll
                for (int nt = 0; nt < 4; ++nt) {
                    const unsigned p01 = pack2(acc[mt][nt][0], acc[mt][nt][1]), p23 = pack2(acc[mt][nt][2], acc[mt][nt][3]);
                    VT[vi0 + (nt * 16 + 0) * SB] = (bf16_t)(p01 & 0xffffu); VT[vi0 + (nt * 16 + 1) * SB] = (bf16_t)(p01 >> 16);
                    VT[vi0 + (nt * 16 + 2) * SB] = (bf16_t)(p23 & 0xffffu); VT[vi0 + (nt * 16 + 3) * SB] = (bf16_t)(p23 >> 16);
                }
            }
        } else {
            if (wc == 0) {
                float* AB = wsf(p, O_AB);
#pragma unroll
                for (int mt = 0; mt < 8; ++mt) {
                    const int row = row0 + wr * 128 + mt * 16 + l15;
                    *(f32x4*)(AB + (size_t)row * 16 + quad * 4) = acc[mt][0];
                }
            }
        }
    }
}

DEV int rowtile0(int ti, bool latent_only) { if (!latent_only) return ti * 256; int b = ti >> 4, tt = ti & 15; return b * SB + CTXL + tt * 256; }
DEV int sgcol(int n, int c) { return n < 2 ? n * 1024 + c : (c < 512 ? 2048 + c : 3584 + (c - 512)); }

DEV void phase_gate(const Params& p, bool latent_only, unsigned char* smem) {
    bf16_t* sA = (bf16_t*)smem;
    const int tid = get_tid(), lane = tid & 63, wv = tid >> 6, wr = wv >> 1, wc = wv & 1, l15 = lane & 15, quad = lane >> 4;
    const bf16_t* U = wsb(p, O_U); const bf16_t* W = wsb(p, O_WT) + W_GATE;
    bf16_t* P = wsb(p, O_P);
    const int nrt = latent_only ? 128 : 136;
    for (TileIter ti(nrt, 24); ti.valid(); ti.next()) {
        int tm, tn; ti.get(tm, tn);
        const int row0 = rowtile0(tm, latent_only);
        f32x4 acc[8][4]; zero_acc(acc);
        gemm_core<8, 4>(U + (size_t)row0 * D, D, W + (size_t)tn * 128 * D, D, D, acc, sA);
        const int dcol0 = sgcol(tn >> 3, (tn & 7) * 128);
        bf16_t* ip = P + (size_t)(row0 + tid) * PW + dcol0;
#pragma unroll
        for (int mt = 0; mt < 8; ++mt) {
            __builtin_amdgcn_sched_barrier(0);
#pragma unroll
            for (int hf = 0; hf < 2; ++hf) {
                u32x4 o;
                o[0] = pack2(sigm(acc[mt][2 * hf][0]), sigm(acc[mt][2 * hf][1])); o[1] = pack2(sigm(acc[mt][2 * hf][2]), sigm(acc[mt][2 * hf][3]));
                o[2] = pack2(sigm(acc[mt][2 * hf + 1][0]), sigm(acc[mt][2 * hf + 1][1])); o[3] = pack2(sigm(acc[mt][2 * hf + 1][2]), sigm(acc[mt][2 * hf + 1][3]));
                *(u32x4*)(ip + (mt * 2 + hf) * 8) = o;
            }
        }
    }
}

DEV void phase_merge(const Params& p, bool latent_only, unsigned char* smem) {
    bf16_t* sA = (bf16_t*)smem;
    const int tid = get_tid(), lane = tid & 63, wv = tid >> 6, wr = wv >> 1, wc = wv & 1, l15 = lane & 15, quad = lane >> 4;
    const bf16_t* W = wsb(p, O_WT);
    const bf16_t* P = wsb(p, O_P);
    bf16_t* U = wsb(p, O_U);
    const int nrt = latent_only ? 128 : 136;
    for (TileIter ti(nrt, 8); ti.valid(); ti.next()) {
        int tm, tn; ti.get(tm, tn);
        const int row0 = rowtile0(tm, latent_only), col0 = tn * 128;
        f32x4 m[8][4]; zero_acc(m);
#pragma unroll 1
        for (int n = 0; n < 3; ++n) {
            f32x4 au[8][4]; zero_acc(au);
            const bf16_t* Y; int ldy;
            if (n == 0) { Y = wsb(p, O_TA) + (size_t)row0 * 512; ldy = 512; }
            else if (n == 1) { Y = P + (size_t)row0 * PW + C_LG; ldy = PW; }
            else { Y = P + (size_t)row0 * PW + C_DAQ; ldy = PW; }
            const int sc0 = sgcol(n, col0);
            gemm_core<8, 4>(Y, ldy, W + W_BR + ((size_t)n * 1024 + col0) * 512, 512, 512, au, sA);
            u32x4 sg[16];
            const bf16_t* ip = P + (size_t)(row0 + tid) * PW + sc0;
#pragma unroll
            for (int q = 0; q < 16; ++q) sg[q] = *(const u32x4*)(ip + q * 8);
#pragma unroll
            for (int mt = 0; mt < 8; ++mt)
#pragma unroll
                for (int nt = 0; nt < 4; ++nt) {
                    const unsigned g01 = sg[mt * 2 + (nt >> 1)][(nt & 1) * 2], g23 = sg[mt * 2 + (nt >> 1)][(nt & 1) * 2 + 1];
                    m[mt][nt][0] += lo16(g01) * au[mt][nt][0]; m[mt][nt][1] += hi16(g01) * au[mt][nt][1];
                    m[mt][nt][2] += lo16(g23) * au[mt][nt][2]; m[mt][nt][3] += hi16(g23) * au[mt][nt][3];
                }
        }
#pragma unroll
        for (int mt = 0; mt < 8; ++mt) {
            __builtin_amdgcn_sched_barrier(0);
            bf16_t* up = U + (size_t)(row0 + wr * 128 + mt * 16 + l15) * D + col0 + wc * 64 + quad * 4;
#pragma unroll
            for (int nt = 0; nt < 4; ++nt) { u32x2 o; o.x = pack2(m[mt][nt][0], m[mt][nt][1]); o.y = pack2(m[mt][nt][2], m[mt][nt][3]); *(u32x2*)(up + nt * 16) = o; }
        }
    }
}

DEV void phase_resid(const Params& p, int l, const bf16_t* A, int lda, const bf16_t* Wt, int K, int chunk, bool first, bool latent_only, unsigned char* smem) {
    bf16_t* sA = (bf16_t*)smem;
    const int tid = get_tid(), lane = tid & 63, wv = tid >> 6, wr = wv >> 1, wc = wv & 1, l15 = lane & 15, quad = lane >> 4;
    const int nrt = latent_only ? 128 : 136;
    for (TileIter ti(nrt, 8); ti.valid(); ti.next()) {
        int tm, tn; ti.get(tm, tn);
        const int row0 = rowtile0(tm, latent_only), col0 = tn * 128;
        f32x4 acc[8][4]; zero_acc(acc);
        gemm_core<8, 4>(A + (size_t)row0 * lda, lda, Wt + (size_t)col0 * K, K, K, acc, sA);
        const float* md = wsf(p, O_MOD) + ((size_t)l * 9 + modrow(row0)) * 6144 + chunk * D + col0 + wc * 64 + quad * 4;
        const float* hs0 = first ? xrow(p, row0) : hrow(p, row0);
        float* hd0 = hrow(p, row0);
        f32x4 mg[4];
#pragma unroll
        for (int nt = 0; nt < 4; ++nt) mg[nt] = *(const f32x4*)(md + nt * 16);
#pragma unroll
        for (int mt = 0; mt < 8; ++mt) {
            __builtin_amdgcn_sched_barrier(0);
            const size_t ro = (size_t)(wr * 128 + mt * 16 + l15) * D + col0 + wc * 64 + quad * 4;
#pragma unroll
            for (int nt = 0; nt < 4; ++nt) { const f32x4 h = *(const f32x4*)(hs0 + ro + nt * 16); *(f32x4*)(hd0 + ro + nt * 16) = h + mg[nt] * acc[mt][nt]; }
        }
    }
}
DEV void phase_gu(const Params& p, bool latent_only, unsigned char* smem) {
    bf16_t* sA = (bf16_t*)smem;
    const int tid = get_tid(), lane = tid & 63, wv = tid >> 6, wr = wv >> 1, wc = wv & 1, l15 = lane & 15, quad = lane >> 4;
    const bf16_t* U = wsb(p, O_U); const bf16_t* W = wsb(p, O_WT) + W_GU;
    bf16_t* P = wsb(p, O_P);
    const int nrt = latent_only ? 128 : 136;
    for (TileIter ti(nrt, 44); ti.valid(); ti.next()) {
        int tm, tn; ti.get(tm, tn);
        const int row0 = rowtile0(tm, latent_only);
        f32x4 acc[8][4]; zero_acc(acc);
        gemm_core<8, 4>(U + (size_t)row0 * D, D, W + (size_t)tn * 128 * D, D, D, acc, sA);
#pragma unroll
        for (int mt = 0; mt < 8; ++mt) {
            __builtin_amdgcn_sched_barrier(0);
            bf16_t* pp = P + (size_t)(row0 + wr * 128 + mt * 16 + l15) * PW + (tn * 4 + wc * 2) * 16 + quad * 4;
#pragma unroll
            for (int pr = 0; pr < 2; ++pr) {
                const f32x4 g = acc[mt][2 * pr], u = acc[mt][2 * pr + 1];
                u32x2 o; o.x = pack2(silu(g[0]) * u[0], silu(g[1]) * u[1]); o.y = pack2(silu(g[2]) * u[2], silu(g[3]) * u[3]);
                *(u32x2*)(pp + pr * 16) = o;
            }
        }
    }
}

DEV int chunk_of(int dir, int n) { return dir ? (n < 4 ? 3 - n : 71 - n) : n; }

typedef float f32x2 __attribute__((ext_vector_type(2)));
DEV void dn_solve(const float* __restrict__ Lt_s0, const bf16_t* __restrict__ colp, const float* __restrict__ mulp0, const float sg, bf16_t* __restrict__ outp,
                  bf16_t* XT_s, const bf16_t* Lb_s, const int tid, const int wv, const int l15, const int quad) {
    int vz = 0; asm volatile("" : "+v"(vz));
    const float* __restrict__ Lt_s = Lt_s0 + vz; const float* __restrict__ mulp = mulp0 + vz;
    f32x2 X0, X1, X2, X3, X4, X5, X6, X7, X8, X9, X10, X11, X12, X13, X14, X15, X16, X17, X18, X19, X20, X21, X22, X23, X24, X25, X26, X27, X28, X29, X30, X31;
    f32x4 La0, La1, La2, La3, La4, La5, La6, La7, La8, La9, La10, La11, La12, La13, La14, La15, Lb0, Lb1, Lb2, Lb3, Lb4, Lb5, Lb6, Lb7, Lb8, Lb9, Lb10, Lb11, Lb12, Lb13, Lb14, Lb15;
    X0 = (f32x2){bf2f(colp[0]) * mulp[0], bf2f(colp[136]) * mulp[1]};
    X1 = (f32x2){bf2f(colp[272]) * mulp[2], bf2f(colp[408]) * mulp[3]};
    X2 = (f32x2){bf2f(colp[544]) * mulp[4], bf2f(colp[680]) * mulp[5]};
    X3 = (f32x2){bf2f(colp[816]) * mulp[6], bf2f(colp[952]) * mulp[7]};
    X4 = (f32x2){bf2f(colp[1088]) * mulp[8], bf2f(colp[1224]) * mulp[9]};
    X5 = (f32x2){bf2f(colp[1360]) * mulp[10], bf2f(colp[1496]) * mulp[11]};
    X6 = (f32x2){bf2f(colp[1632]) * mulp[12], bf2f(colp[1768]) * mulp[13]};
    X7 = (f32x2){bf2f(colp[1904]) * mulp[14], bf2f(colp[2040]) * mulp[15]};
    X8 = (f32x2){bf2f(colp[2176]) * mulp[16], bf2f(colp[2312]) * mulp[17]};
    X9 = (f32x2){bf2f(colp[2448]) * mulp[18], bf2f(colp[2584]) * mulp[19]};
    X10 = (f32x2){bf2f(colp[2720]) * mulp[20], bf2f(colp[2856]) * mulp[21]};
    X11 = (f32x2){bf2f(colp[2992]) * mulp[22], bf2f(colp[3128]) * mulp[23]};
    X12 = (f32x2){bf2f(colp[3264]) * mulp[24], bf2f(colp[3400]) * mulp[25]};
    X13 = (f32x2){bf2f(colp[3536]) * mulp[26], bf2f(colp[3672]) * mulp[27]};
    X14 = (f32x2){bf2f(colp[3808]) * mulp[28], bf2f(colp[3944]) * mulp[29]};
    X15 = (f32x2){bf2f(colp[4080]) * mulp[30], bf2f(colp[4216]) * mulp[31]};
    X16 = (f32x2){bf2f(colp[4352]) * mulp[32], bf2f(colp[4488]) * mulp[33]};
    X17 = (f32x2){bf2f(colp[4624]) * mulp[34], bf2f(colp[4760]) * mulp[35]};
    X18 = (f32x2){bf2f(colp[4896]) * mulp[36], bf2f(colp[5032]) * mulp[37]};
    X19 = (f32x2){bf2f(colp[5168]) * mulp[38], bf2f(colp[5304]) * mulp[39]};
    X20 = (f32x2){bf2f(colp[5440]) * mulp[40], bf2f(colp[5576]) * mulp[41]};
    X21 = (f32x2){bf2f(colp[5712]) * mulp[42], bf2f(colp[5848]) * mulp[43]};
    X22 = (f32x2){bf2f(colp[5984]) * mulp[44], bf2f(colp[6120]) * mulp[45]};
    X23 = (f32x2){bf2f(colp[6256]) * mulp[46], bf2f(colp[6392]) * mulp[47]};
    X24 = (f32x2){bf2f(colp[6528]) * mulp[48], bf2f(colp[6664]) * mulp[49]};
    X25 = (f32x2){bf2f(colp[6800]) * mulp[50], bf2f(colp[6936]) * mulp[51]};
    X26 = (f32x2){bf2f(colp[7072]) * mulp[52], bf2f(colp[7208]) * mulp[53]};
    X27 = (f32x2){bf2f(colp[7344]) * mulp[54], bf2f(colp[7480]) * mulp[55]};
    X28 = (f32x2){bf2f(colp[7616]) * mulp[56], bf2f(colp[7752]) * mulp[57]};
    X29 = (f32x2){bf2f(colp[7888]) * mulp[58], bf2f(colp[8024]) * mulp[59]};
    X30 = (f32x2){bf2f(colp[8160]) * mulp[60], bf2f(colp[8296]) * mulp[61]};
    X31 = (f32x2){bf2f(colp[8432]) * mulp[62], bf2f(colp[8568]) * mulp[63]};
    __syncthreads();
    La0 = *(const f32x4*)(Lt_s + 0);
    La1 = *(const f32x4*)(Lt_s + 4);
    La2 = *(const f32x4*)(Lt_s + 8);
    La3 = *(const f32x4*)(Lt_s + 12);
    La4 = *(const f32x4*)(Lt_s + 16);
    La5 = *(const f32x4*)(Lt_s + 20);
    La6 = *(const f32x4*)(Lt_s + 24);
    La7 = *(const f32x4*)(Lt_s + 28);
    Lb0 = *(const f32x4*)(Lt_s + 68);
    Lb1 = *(const f32x4*)(Lt_s + 72);
    Lb2 = *(const f32x4*)(Lt_s + 76);
    Lb3 = *(const f32x4*)(Lt_s + 80);
    Lb4 = *(const f32x4*)(Lt_s + 84);
    Lb5 = *(const f32x4*)(Lt_s + 88);
    Lb6 = *(const f32x4*)(Lt_s + 92);
    Lb7 = *(const f32x4*)(Lt_s + 96);
    __builtin_amdgcn_sched_barrier(0);
    { const float xj = X0[0]; const f32x2 xj2 = (f32x2){xj, xj};
      X0 -= (f32x2){La0[0], La0[1]} * xj2;
      X1 -= (f32x2){La0[2], La0[3]} * xj2;
      X2 -= (f32x2){La1[0], La1[1]} * xj2;
      X3 -= (f32x2){La1[2], La1[3]} * xj2;
      X4 -= (f32x2){La2[0], La2[1]} * xj2;
      X5 -= (f32x2){La2[2], La2[3]} * xj2;
      X6 -= (f32x2){La3[0], La3[1]} * xj2;
      X7 -= (f32x2){La3[2], La3[3]} * xj2;
      X8 -= (f32x2){La4[0], La4[1]} * xj2;
      X9 -= (f32x2){La4[2], La4[3]} * xj2;
      X10 -= (f32x2){La5[0], La5[1]} * xj2;
      X11 -= (f32x2){La5[2], La5[3]} * xj2;
      X12 -= (f32x2){La6[0], La6[1]} * xj2;
      X13 -= (f32x2){La6[2], La6[3]} * xj2;
      X14 -= (f32x2){La7[0], La7[1]} * xj2;
      X15 -= (f32x2){La7[2], La7[3]} * xj2;
    }
    __builtin_amdgcn_sched_barrier(0);
    La0 = *(const f32x4*)(Lt_s + 136);
    La1 = *(const f32x4*)(Lt_s + 140);
    La2 = *(const f32x4*)(Lt_s + 144);
    La3 = *(const f32x4*)(Lt_s + 148);
    La4 = *(const f32x4*)(Lt_s + 152);
    La5 = *(const f32x4*)(Lt_s + 156);
    La6 = *(const f32x4*)(Lt_s + 160);
    La7 = *(const f32x4*)(Lt_s + 164);
    __builtin_amdgcn_sched_barrier(0);
    { const float xj = X0[1]; const f32x2 xj2 = (f32x2){xj, xj};
      X1 -= (f32x2){Lb0[2], Lb0[3]} * xj2;
      X2 -= (f32x2){Lb1[0], Lb1[1]} * xj2;
      X3 -= (f32x2){Lb1[2], Lb1[3]} * xj2;
      X4 -= (f32x2){Lb2[0], Lb2[1]} * xj2;
      X5 -= (f32x2){Lb2[2], Lb2[3]} * xj2;
      X6 -= (f32x2){Lb3[0], Lb3[1]} * xj2;
      X7 -= (f32x2){Lb3[2], Lb3[3]} * xj2;
      X8 -= (f32x2){Lb4[0], Lb4[1]} * xj2;
      X9 -= (f32x2){Lb4[2], Lb4[3]} * xj2;
      X10 -= (f32x2){Lb5[0], Lb5[1]} * xj2;
      X11 -= (f32x2){Lb5[2], Lb5[3]} * xj2;
      X12 -= (f32x2){Lb6[0], Lb6[1]} * xj2;
      X13 -= (f32x2){Lb6[2], Lb6[3]} * xj2;
      X14 -= (f32x2){Lb7[0], Lb7[1]} * xj2;
      X15 -= (f32x2){Lb7[2], Lb7[3]} * xj2;
    }
    __builtin_amdgcn_sched_barrier(0);
    Lb1 = *(const f32x4*)(Lt_s + 208);
    Lb2 = *(const f32x4*)(Lt_s + 212);
    Lb3 = *(const f32x4*)(Lt_s + 216);
    Lb4 = *(const f32x4*)(Lt_s + 220);
    Lb5 = *(const f32x4*)(Lt_s + 224);
    Lb6 = *(const f32x4*)(Lt_s + 228);
    Lb7 = *(const f32x4*)(Lt_s + 232);
    __builtin_amdgcn_sched_barrier(0);
    { const float xj = X1[0]; const f32x2 xj2 = (f32x2){xj, xj};
      X1 -= (f32x2){La0[2], La0[3]} * xj2;
      X2 -= (f32x2){La1[0], La1[1]} * xj2;
      X3 -= (f32x2){La1[2], La1[3]} * xj2;
      X4 -= (f32x2){La2[0], La2[1]} * xj2;
      X5 -= (f32x2){La2[2], La2[3]} * xj2;
      X6 -= (f32x2){La3[0], La3[1]} * xj2;
      X7 -= (f32x2){La3[2], La3[3]} * xj2;
      X8 -= (f32x2){La4[0], La4[1]} * xj2;
      X9 -= (f32x2){La4[2], La4[3]} * xj2;
      X10 -= (f32x2){La5[0], La5[1]} * xj2;
      X11 -= (f32x2){La5[2], La5[3]} * xj2;
      X12 -= (f32x2){La6[0], La6[1]} * xj2;
      X13 -= (f32x2){La6[2], La6[3]} * xj2;
      X14 -= (f32x2){La7[0], La7[1]} * xj2;
      X15 -= (f32x2){La7[2], La7[3]} * xj2;
    }
    __builtin_amdgcn_sched_barrier(0);
    La1 = *(const f32x4*)(Lt_s + 276);
    La2 = *(const f32x4*)(Lt_s + 280);
    La3 = *(const f32x4*)(Lt_s + 284);
    La4 = *(const f32x4*)(Lt_s + 288);
    La5 = *(const f32x4*)(Lt_s + 292);
    La6 = *(const f32x4*)(Lt_s + 296);
    La7 = *(const f32x4*)(Lt_s + 300);
    __builtin_amdgcn_sched_barrier(0);
    { const float xj = X1[1]; const f32x2 xj2 = (f32x2){xj, xj};
      X2 -= (f32x2){Lb1[0], Lb1[1]} * xj2;
      X3 -= (f32x2){Lb1[2], Lb1[3]} * xj2;
      X4 -= (f32x2){Lb2[0], Lb2[1]} * xj2;
      X5 -= (f32x2){Lb2[2], Lb2[3]} * xj2;
      X6 -= (f32x2){Lb3[0], Lb3[1]} * xj2;
      X7 -= (f32x2){Lb3[2], Lb3[3]} * xj2;
      X8 -= (f32x2){Lb4[0], Lb4[1]} * xj2;
      X9 -= (f32x2){Lb4[2], Lb4[3]} * xj2;
      X10 -= (f32x2){Lb5[0], Lb5[1]} * xj2;
      X11 -= (f32x2){Lb5[2], Lb5[3]} * xj2;
      X12 -= (f32x2){Lb6[0], Lb6[1]} * xj2;
      X13 -= (f32x2){Lb6[2], Lb6[3]} * xj2;
      X14 -= (f32x2){Lb7[0], Lb7[1]} * xj2;
      X15 -= (f32x2){Lb7[2], Lb7[3]} * xj2;
    }
    __builtin_amdgcn_sched_barrier(0);
    Lb1 = *(const f32x4*)(Lt_s + 344);
    Lb2 = *(const f32x4*)(Lt_s + 348);
    Lb3 = *(const f32x4*)(Lt_s + 352);
    Lb4 = *(const f32x4*)(Lt_s + 356);
    Lb5 = *(const f32x4*)(Lt_s + 360);
    Lb6 = *(const f32x4*)(Lt_s + 364);
    Lb7 = *(const f32x4*)(Lt_s + 368);
    __builtin_amdgcn_sched_barrier(0);
    { const float xj = X2[0]; const f32x2 xj2 = (f32x2){xj, xj};
      X2 -= (f32x2){La1[0], La1[1]} * xj2;
      X3 -= (f32x2){La1[2], La1[3]} * xj2;
      X4 -= (f32x2){La2[0], La2[1]} * xj2;
      X5 -= (f32x2){La2[2], La2[3]} * xj2;
      X6 -= (f32x2){La3[0], La3[1]} * xj2;
      X7 -= (f32x2){La3[2], La3[3]} * xj2;
      X8 -= (f32x2){La4[0], La4[1]} * xj2;
      X9 -= (f32x2){La4[2], La4[3]} * xj2;
      X10 -= (f32x2){La5[0], La5[1]} * xj2;
      X11 -= (f32x2){La5[2], La5[3]} * xj2;
      X12 -= (f32x2){La6[0], La6[1]} * xj2;
      X13 -= (f32x2){La6[2], La6[3]} * xj2;
      X14 -= (f32x2){La7[0], La7[1]} * xj2;
      X15 -= (f32x2){La7[2], La7[3]} * xj2;
    }
    __builtin_amdgcn_sched_barrier(0);
    La1 = *(const f32x4*)(Lt_s + 412);
    La2 = *(const f32x4*)(Lt_s + 416);
    La3 = *(const f32x4*)(Lt_s + 420);
    La4 = *(const f32x4*)(Lt_s + 424);
    La5 = *(const f32x4*)(Lt_s + 428);
    La6 = *(const f32x4*)(Lt_s + 432);
    La7 = *(const f32x4*)(Lt_s + 436);
    __builtin_amdgcn_sched_barrier(0);
    { const float xj = X2[1]; const f32x2 xj2 = (f32x2){xj, xj};
      X3 -= (f32x2){Lb1[2], Lb1[3]} * xj2;
      X4 -= (f32x2){Lb2[0], Lb2[1]} * xj2;
      X5 -= (f32x2){Lb2[2], Lb2[3]} * xj2;
      X6 -= (f32x2){Lb3[0], Lb3[1]} * xj2;
      X7 -= (f32x2){Lb3[2], Lb3[3]} * xj2;
      X8 -= (f32x2){Lb4[0], Lb4[1]} * xj2;
      X9 -= (f32x2){Lb4[2], Lb4[3]} * xj2;
      X10 -= (f32x2){Lb5[0], Lb5[1]} * xj2;
      X11 -= (f32x2){Lb5[2], Lb5[3]} * xj2;
      X12 -= (f32x2){Lb6[0], Lb6[1]} * xj2;
      X13 -= (f32x2){Lb6[2], Lb6[3]} * xj2;
      X14 -= (f32x2){Lb7[0], Lb7[1]} * xj2;
      X15 -= (f32x2){Lb7[2], Lb7[3]} * xj2;
    }
    __builtin_amdgcn_sched_barrier(0);
    Lb2 = *(const f32x4*)(Lt_s + 484);
    Lb3 = *(const f32x4*)(Lt_s + 488);
    Lb4 = *(const f32x4*)(Lt_s + 492);
    Lb5 = *(const f32x4*)(Lt_s + 496);
    Lb6 = *(const f32x4*)(Lt_s + 500);
    Lb7 = *(const f32x4*)(Lt_s + 504);
    __builtin_amdgcn_sched_barrier(0);
    { const float xj = X3[0]; const f32x2 xj2 = (f32x2){xj, xj};
      X3 -= (f32x2){La1[2], La1[3]} * xj2;
      X4 -= (f32x2){La2[0], La2[1]} * xj2;
      X5 -= (f32x2){La2[2], La2[3]} * xj2;
      X6 -= (f32x2){La3[0], La3[1]} * xj2;
      X7 -= (f32x2){La3[2], La3[3]} * xj2;
      X8 -= (f32x2){La4[0], La4[1]} * xj2;
      X9 -= (f32x2){La4[2], La4[3]} * xj2;
      X10 -= (f32x2){La5[0], La5[1]} * xj2;
      X11 -= (f32x2){La5[2], La5[3]} * xj2;
      X12 -= (f32x2){La6[0], La6[1]} * xj2;
      X13 -= (f32x2){La6[2], La6[3]} * xj2;
      X14 -= (f32x2){La7[0], La7[1]} * xj2;
      X15 -= (f32x2){La7[2], La7[3]} * xj2;
    }
    __builtin_amdgcn_sched_barrier(0);
    La2 = *(const f32x4*)(Lt_s + 552);
    La3 = *(const f32x4*)(Lt_s + 556);
    La4 = *(const f32x4*)(Lt_s + 560);
    La5 = *(const f32x4*)(Lt_s + 564);
    La6 = *(const f32x4*)(Lt_s + 568);
    La7 = *(const f32x4*)(Lt_s + 572);
    __builtin_amdgcn_sched_barrier(0);
    { const float xj = X3[1]; const f32x2 xj2 = (f32x2){xj, xj};
      X4 -= (f32x2){Lb2[0], Lb2[1]} * xj2;
      X5 -= (f32x2){Lb2[2], Lb2[3]} * xj2;
      X6 -= (f32x2){Lb3[0], Lb3[1]} * xj2;
      X7 -= (f32x2){Lb3[2], Lb3[3]} * xj2;
      X8 -= (f32x2){Lb4[0], Lb4[1]} * xj2;
      X9 -= (f32x2){Lb4[2], Lb4[3]} * xj2;
      X10 -= (f32x2){Lb5[0], Lb5[1]} * xj2;
      X11 -= (f32x2){Lb5[2], Lb5[3]} * xj2;
      X12 -= (f32x2){Lb6[0], Lb6[1]} * xj2;
      X13 -= (f32x2){Lb6[2], Lb6[3]} * xj2;
      X14 -= (f32x2){Lb7[0], Lb7[1]} * xj2;
      X15 -= (f32x2){Lb7[2], Lb7[3]} * xj2;
    }
    __builtin_amdgcn_sched_barrier(0);
    Lb2 = *(const f32x4*)(Lt_s + 620);
    Lb3 = *(const f32x4*)(Lt_s + 624);
    Lb4 = *(const f32x4*)(Lt_s + 628);
    Lb5 = *(const f32x4*)(Lt_s + 632);
    Lb6 = *(const f32x4*)(Lt_s + 636);
    Lb7 = *(const f32x4*)(Lt_s + 640);
    __builtin_amdgcn_sched_barrier(0);
    { const float xj = X4[0]; const f32x2 xj2 = (f32x2){xj, xj};
      X4 -= (f32x2){La2[0], La2[1]} * xj2;
      X5 -= (f32x2){La2[2], La2[3]} * xj2;
      X6 -= (f32x2){La3[0], La3[1]} * xj2;
      X7 -= (f32x2){La3[2], La3[3]} * xj2;
      X8 -= (f32x2){La4[0], La4[1]} * xj2;
      X9 -= (f32x2){La4[2], La4[3]} * xj2;
      X10 -= (f32x2){La5[0], La5[1]} * xj2;
      X11 -= (f32x2){La5[2], La5[3]} * xj2;
      X12 -= (f32x2){La6[0], La6[1]} * xj2;
      X13 -= (f32x2){La6[2], La6[3]} * xj2;
      X14 -= (f32x2){La7[0], La7[1]} * xj2;
      X15 -= (f32x2){La7[2], La7[3]} * xj2;
    }
    __builtin_amdgcn_sched_barrier(0);
    La2 = *(const f32x4*)(Lt_s + 688);
    La3 = *(const f32x4*)(Lt_s + 692);
    La4 = *(const f32x4*)(Lt_s + 696);
    La5 = *(const f32x4*)(Lt_s + 700);
    La6 = *(const f32x4*)(Lt_s + 704);
    La7 = *(const f32x4*)(Lt_s + 708);
    __builtin_amdgcn_sched_barrier(0);
    { const float xj = X4[1]; const f32x2 xj2 = (f32x2){xj, xj};
      X5 -= (f32x2){Lb2[2], Lb2[3]} * xj2;
      X6 -= (f32x2){Lb3[0], Lb3[1]} * xj2;
      X7 -= (f32x2){Lb3[2], Lb3[3]} * xj2;
      X8 -= (f32x2){Lb4[0], Lb4[1]} * xj2;
      X9 -= (f32x2){Lb4[2], Lb4[3]} * xj2;
      X10 -= (f32x2){Lb5[0], Lb5[1]} * xj2;
      X11 -= (f32x2){Lb5[2], Lb5[3]} * xj2;
      X12 -= (f32x2){Lb6[0], Lb6[1]} * xj2;
      X13 -= (f32x2){Lb6[2], Lb6[3]} * xj2;
      X14 -= (f32x2){Lb7[0], Lb7[1]} * xj2;
      X15 -= (f32x2){Lb7[2], Lb7[3]} * xj2;
    }
    __builtin_amdgcn_sched_barrier(0);
    Lb3 = *(const f32x4*)(Lt_s + 760);
    Lb4 = *(const f32x4*)(Lt_s + 764);
    Lb5 = *(const f32x4*)(Lt_s + 768);
    Lb6 = *(const f32x4*)(Lt_s + 772);
    Lb7 = *(const f32x4*)(Lt_s + 776);
    __builtin_amdgcn_sched_barrier(0);
    { const float xj = X5[0]; const f32x2 xj2 = (f32x2){xj, xj};
      X5 -= (f32x2){La2[2], La2[3]} * xj2;
      X6 -= (f32x2){La3[0], La3[1]} * xj2;
      X7 -= (f32x2){La3[2], La3[3]} * xj2;
      X8 -= (f32x2){La4[0], La4[1]} * xj2;
      X9 -= (f32x2){La4[2], La4[3]} * xj2;
      X10 -= (f32x2){La5[0], La5[1]} * xj2;
      X11 -= (f32x2){La5[2], La5[3]} * xj2;
      X12 -= (f32x2){La6[0], La6[1]} * xj2;
      X13 -= (f32x2){La6[2], La6[3]} * xj2;
      X14 -= (f32x2){La7[0], La7[1]} * xj2;
      X15 -= (f32x2){La7[2], La7[3]} * xj2;
    }
    __builtin_amdgcn_sched_barrier(0);
    La3 = *(const f32x4*)(Lt_s + 828);
    La4 = *(const f32x4*)(Lt_s + 832);
    La5 = *(const f32x4*)(Lt_s + 836);
    La6 = *(const f32x4*)(Lt_s + 840);
    La7 = *(const f32x4*)(Lt_s + 844);
    __builtin_amdgcn_sched_barrier(0);
    { const float xj = X5[1]; const f32x2 xj2 = (f32x2){xj, xj};
      X6 -= (f32x2){Lb3[0], Lb3[1]} * xj2;
      X7 -= (f32x2){Lb3[2], Lb3[3]} * xj2;
      X8 -= (f32x2){Lb4[0], Lb4[1]} * xj2;
      X9 -= (f32x2){Lb4[2], Lb4[3]} * xj2;
      X10 -= (f32x2){Lb5[0], Lb5[1]} * xj2;
      X11 -= (f32x2){Lb5[2], Lb5[3]} * xj2;
      X12 -= (f32x2){Lb6[0], Lb6[1]} * xj2;
      X13 -= (f32x2){Lb6[2], Lb6[3]} * xj2;
      X14 -= (f32x2){Lb7[0], Lb7[1]} * xj2;
      X15 -= (f32x2){Lb7[2], Lb7[3]} * xj2;
    }
    __builtin_amdgcn_sched_barrier(0);
    Lb3 = *(const f32x4*)(Lt_s + 896);
    Lb4 = *(const f32x4*)(Lt_s + 900);
    Lb5 = *(const f32x4*)(Lt_s + 904);
    Lb6 = *(const f32x4*)(Lt_s + 908);
    Lb7 = *(const f32x4*)(Lt_s + 912);
    __builtin_amdgcn_sched_barrier(0);
    { const float xj = X6[0]; const f32x2 xj2 = (f32x2){xj, xj};
      X6 -= (f32x2){La3[0], La3[1]} * xj2;
      X7 -= (f32x2){La3[2], La3[3]} * xj2;
      X8 -= (f32x2){La4[0], La4[1]} * xj2;
      X9 -= (f32x2){La4[2], La4[3]} * xj2;
      X10 -= (f32x2){La5[0], La5[1]} * xj2;
      X11 -= (f32x2){La5[2], La5[3]} * xj2;
      X12 -= (f32x2){La6[0], La6[1]} * xj2;
      X13 -= (f32x2){La6[2], La6[3]} * xj2;
      X14 -= (f32x2){La7[0], La7[1]} * xj2;
      X15 -= (f32x2){La7[2], La7[3]} * xj2;
    }
    __builtin_amdgcn_sched_barrier(0);
    La3 = *(const f32x4*)(Lt_s + 964);
    La4 = *(const f32x4*)(Lt_s + 968);
    La5 = *(const f32x4*)(Lt_s + 972);
    La6 = *(const f32x4*)(Lt_s + 976);
    La7 = *(const f32x4*)(Lt_s + 980);
    __builtin_amdgcn_sched_barrier(0);
    { const float xj = X6[1]; const f32x2 xj2 = (f32x2){xj, xj};
      X7 -= (f32x2){Lb3[2], Lb3[3]} * xj2;
      X8 -= (f32x2){Lb4[0], Lb4[1]} * xj2;
      X9 -= (f32x2){Lb4[2], Lb4[3]} * xj2;
      X10 -= (f32x2){Lb5[0], Lb5[1]} * xj2;
      X11 -= (f32x2){Lb5[2], Lb5[3]} * xj2;
      X12 -= (f32x2){Lb6[0], Lb6[1]} * xj2;
      X13 -= (f32x2){Lb6[2], Lb6[3]} * xj2;
      X14 -= (f32x2){Lb7[0], Lb7[1]} * xj2;
      X15 -= (f32x2){Lb7[2], Lb7[3]} * xj2;
    }
    __builtin_amdgcn_sched_barrier(0);
    Lb4 = *(const f32x4*)(Lt_s + 1036);
    Lb5 = *(const f32x4*)(Lt_s + 1040);
    Lb6 = *(const f32x4*)(Lt_s + 1044);
    Lb7 = *(const f32x4*)(Lt_s + 1048);
    __builtin_amdgcn_sched_barrier(0);
    { const float xj = X7[0]; const f32x2 xj2 = (f32x2){xj, xj};
      X7 -= (f32x2){La3[2], La3[3]} * xj2;
      X8 -= (f32x2){La4[0], La4[1]} * xj2;
      X9 -= (f32x2){La4[2], La4[3]} * xj2;
      X10 -= (f32x2){La5[0], La5[1]} * xj2;
      X11 -= (f32x2){La5[2], La5[3]} * xj2;
      X12 -= (f32x2){La6[0], La6[1]} * xj2;
      X13 -= (f32x2){La6[2], La6[3]} * xj2;
      X14 -= (f32x2){La7[0], La7[1]} * xj2;
      X15 -= (f32x2){La7[2], La7[3]} * xj2;
    }
    __builtin_amdgcn_sched_barrier(0);
    La4 = *(const f32x4*)(Lt_s + 1104);
    La5 = *(const f32x4*)(Lt_s + 1108);
    La6 = *(const f32x4*)(Lt_s + 1112);
    La7 = *(const f32x4*)(Lt_s + 1116);
    __builtin_amdgcn_sched_barrier(0);
    { const float xj = X7[1]; const f32x2 xj2 = (f32x2){xj, xj};
      X8 -= (f32x2){Lb4[0], Lb4[1]} * xj2;
      X9 -= (f32x2){Lb4[2], Lb4[3]} * xj2;
      X10 -= (f32x2){Lb5[0], Lb5[1]} * xj2;
      X11 -= (f32x2){Lb5[2], Lb5[3]} * xj2;
      X12 -= (f32x2){Lb6[0], Lb6[1]} * xj2;
      X13 -= (f32x2){Lb6[2], Lb6[3]} * xj2;
      X14 -= (f32x2){Lb7[0], Lb7[1]} * xj2;
      X15 -= (f32x2){Lb7[2], Lb7[3]} * xj2;
    }
    __builtin_amdgcn_sched_barrier(0);
    Lb4 = *(const f32x4*)(Lt_s + 1172);
    Lb5 = *(const f32x4*)(Lt_s + 1176);
    Lb6 = *(const f32x4*)(Lt_s + 1180);
    Lb7 = *(const f32x4*)(Lt_s + 1184);
    __builtin_amdgcn_sched_barrier(0);
    { const float xj = X8[0]; const f32x2 xj2 = (f32x2){xj, xj};
      X8 -= (f32x2){La4[0], La4[1]} * xj2;
      X9 -= (f32x2){La4[2], La4[3]} * xj2;
      X10 -= (f32x2){La5[0], La5[1]} * xj2;
      X11 -= (f32x2){La5[2], La5[3]} * xj2;
      X12 -= (f32x2){La6[0], La6[1]} * xj2;
      X13 -= (f32x2){La6[2], La6[3]} * xj2;
      X14 -= (f32x2){La7[0], La7[1]} * xj2;
      X15 -= (f32x2){La7[2], La7[3]} * xj2;
    }
    __builtin_amdgcn_sched_barrier(0);
    La4 = *(const f32x4*)(Lt_s + 1240);
    La5 = *(const f32x4*)(Lt_s + 1244);
    La6 = *(const f32x4*)(Lt_s + 1248);
    La7 = *(const f32x4*)(Lt_s + 1252);
    __builtin_amdgcn_sched_barrier(0);
    { const float xj = X8[1]; const f32x2 xj2 = (f32x2){xj, xj};
      X9 -= (f32x2){Lb4[2], Lb4[3]} * xj2;
      X10 -= (f32x2){Lb5[0], Lb5[1]} * xj2;
      X11 -= (f32x2){Lb5[2], Lb5[3]} * xj2;
      X12 -= (f32x2){Lb6[0], Lb6[1]} * xj2;
      X13 -= (f32x2){Lb6[2], Lb6[3]} * xj2;
      X14 -= (f32x2){Lb7[0], Lb7[1]} * xj2;
      X15 -= (f32x2){Lb7[2], Lb7[3]} * xj2;
    }
    __builtin_amdgcn_sched_barrier(0);
    Lb5 = *(const f32x4*)(Lt_s + 1312);
    Lb6 = *(const f32x4*)(Lt_s + 1316);
    Lb7 = *(const f32x4*)(Lt_s + 1320);
    __builtin_amdgcn_sched_barrier(0);
    { const float xj = X9[0]; const f32x2 xj2 = (f32x2){xj, xj};
      X9 -= (f32x2){La4[2], La4[3]} * xj2;
      X10 -= (f32x2){La5[0], La5[1]} * xj2;
      X11 -= (f32x2){La5[2], La5[3]} * xj2;
      X12 -= (f32x2){La6[0], La6[1]} * xj2;
      X13 -= (f32x2){La6[2], La6[3]} * xj2;
      X14 -= (f32x2){La7[0], La7[1]} * xj2;
      X15 -= (f32x2){La7[2], La7[3]} * xj2;
    }
    __builtin_amdgcn_sched_barrier(0);
    La5 = *(const f32x4*)(Lt_s + 1380);
    La6 = *(const f32x4*)(Lt_s + 1384);
    La7 = *(const f32x4*)(Lt_s + 1388);
    __builtin_amdgcn_sched_barrier(0);
    { const float xj = X9[1]; const f32x2 xj2 = (f32x2){xj, xj};
      X10 -= (f32x2){Lb5[0], Lb5[1]} * xj2;
      X11 -= (f32x2){Lb5[2], Lb5[3]} * xj2;
      X12 -= (f32x2){Lb6[0], Lb6[1]} * xj2;
      X13 -= (f32x2){Lb6[2], Lb6[3]} * xj2;
      X14 -= (f32x2){Lb7[0], Lb7[1]} * xj2;
      X15 -= (f32x2){Lb7[2], Lb7[3]} * xj2;
    }
    __builtin_amdgcn_sched_barrier(0);
    Lb5 = *(const f32x4*)(Lt_s + 1448);
    Lb6 = *(const f32x4*)(Lt_s + 1452);
    Lb7 = *(const f32x4*)(Lt_s + 1456);
    __builtin_amdgcn_sched_barrier(0);
    { const float xj = X10[0]; const f32x2 xj2 = (f32x2){xj, xj};
      X10 -= (f32x2){La5[0], La5[1]} * xj2;
      X11 -= (f32x2){La5[2], La5[3]} * xj2;
      X12 -= (f32x2){La6[0], La6[1]} * xj2;
      X13 -= (f32x2){La6[2], La6[3]} * xj2;
      X14 -= (f32x2){La7[0], La7[1]} * xj2;
      X15 -= (f32x2){La7[2], La7[3]} * xj2;
    }
    __builtin_amdgcn_sched_barrier(0);
    La5 = *(const f32x4*)(Lt_s + 1516);
    La6 = *(const f32x4*)(Lt_s + 1520);
    La7 = *(const f32x4*)(Lt_s + 1524);
    __builtin_amdgcn_sched_barrier(0);
    { const float xj = X10[1]; const f32x2 xj2 = (f32x2){xj, xj};
      X11 -= (f32x2){Lb5[2], Lb5[3]} * xj2;
      X12 -= (f32x2){Lb6[0], Lb6[1]} * xj2;
      X13 -= (f32x2){Lb6[2], Lb6[3]} * xj2;
      X14 -= (f32x2){Lb7[0], Lb7[1]} * xj2;
      X15 -= (f32x2){Lb7[2], Lb7[3]} * xj2;
    }
    __builtin_amdgcn_sched_barrier(0);
    Lb6 = *(const f32x4*)(Lt_s + 1588);
    Lb7 = *(const f32x4*)(Lt_s + 1592);
    __builtin_amdgcn_sched_barrier(0);
    { const float xj = X11[0]; const f32x2 xj2 = (f32x2){xj, xj};
      X11 -= (f32x2){La5[2], La5[3]} * xj2;
      X12 -= (f32x2){La6[0], La6[1]} * xj2;
      X13 -= (f32x2){La6[2], La6[3]} * xj2;
      X14 -= (f32x2){La7[0], La7[1]} * xj2;
      X15 -= (f32x2){La7[2], La7[3]} * xj2;
    }
    __builtin_amdgcn_sched_barrier(0);
    La6 = *(const f32x4*)(Lt_s + 1656);
    La7 = *(const f32x4*)(Lt_s + 1660);
    __builtin_amdgcn_sched_barrier(0);
    { const float xj = X11[1]; const f32x2 xj2 = (f32x2){xj, xj};
      X12 -= (f32x2){Lb6[0], Lb6[1]} * xj2;
      X13 -= (f32x2){Lb6[2], Lb6[3]} * xj2;
      X14 -= (f32x2){Lb7[0], Lb7[1]} * xj2;
      X15 -= (f32x2){Lb7[2], Lb7[3]} * xj2;
    }
    __builtin_amdgcn_sched_barrier(0);
    Lb6 = *(const f32x4*)(Lt_s + 1724);
    Lb7 = *(const f32x4*)(Lt_s + 1728);
    __builtin_amdgcn_sched_barrier(0);
    { const float xj = X12[0]; const f32x2 xj2 = (f32x2){xj, xj};
      X12 -= (f32x2){La6[0], La6[1]} * xj2;
      X13 -= (f32x2){La6[2], La6[3]} * xj2;
      X14 -= (f32x2){La7[0], La7[1]} * xj2;
      X15 -= (f32x2){La7[2], La7[3]} * xj2;
    }
    __builtin_amdgcn_sched_barrier(0);
    La6 = *(const f32x4*)(Lt_s + 1792);
    La7 = *(const f32x4*)(Lt_s + 1796);
    __builtin_amdgcn_sched_barrier(0);
    { const float xj = X12[1]; const f32x2 xj2 = (f32x2){xj, xj};
      X13 -= (f32x2){Lb6[2], Lb6[3]} * xj2;
      X14 -= (f32x2){Lb7[0], Lb7[1]} * xj2;
      X15 -= (f32x2){Lb7[2], Lb7[3]} * xj2;
    }
    __builtin_amdgcn_sched_barrier(0);
    Lb7 = *(const f32x4*)(Lt_s + 1864);
    __builtin_amdgcn_sched_barrier(0);
    { const float xj = X13[0]; const f32x2 xj2 = (f32x2){xj, xj};
      X13 -= (f32x2){La6[2], La6[3]} * xj2;
      X14 -= (f32x2){La7[0], La7[1]} * xj2;
      X15 -= (f32x2){La7[2], La7[3]} * xj2;
    }
    __builtin_amdgcn_sched_barrier(0);
    La7 = *(const f32x4*)(Lt_s + 1932);
    __builtin_amdgcn_sched_barrier(0);
    { const float xj = X13[1]; const f32x2 xj2 = (f32x2){xj, xj};
      X14 -= (f32x2){Lb7[0], Lb7[1]} * xj2;
      X15 -= (f32x2){Lb7[2], Lb7[3]} * xj2;
    }
    __builtin_amdgcn_sched_barrier(0);
    Lb7 = *(const f32x4*)(Lt_s + 2000);
    __builtin_amdgcn_sched_barrier(0);
    { const float xj = X14[0]; const f32x2 xj2 = (f32x2){xj, xj};
      X14 -= (f32x2){La7[0], La7[1]} * xj2;
      X15 -= (f32x2){La7[2], La7[3]} * xj2;
    }
    __builtin_amdgcn_sched_barrier(0);
    La7 = *(const f32x4*)(Lt_s + 2068);
    __builtin_amdgcn_sched_barrier(0);
    { const float xj = X14[1]; const f32x2 xj2 = (f32x2){xj, xj};
      X15 -= (f32x2){Lb7[2], Lb7[3]} * xj2;
    }
    __builtin_amdgcn_sched_barrier(0);
    __builtin_amdgcn_sched_barrier(0);
    { const float xj = X15[0]; const f32x2 xj2 = (f32x2){xj, xj};
      X15 -= (f32x2){La7[2], La7[3]} * xj2;
    }
    __builtin_amdgcn_sched_barrier(0);
    {
        bf16_t* xr = XT_s + tid * 32;
        { u32x4 o = {pack2(X0[0], X0[1]), pack2(X1[0], X1[1]), pack2(X2[0], X2[1]), pack2(X3[0], X3[1])}; *(u32x4*)(xr + 0) = o; }
        { u32x4 o = {pack2(X4[0], X4[1]), pack2(X5[0], X5[1]), pack2(X6[0], X6[1]), pack2(X7[0], X7[1])}; *(u32x4*)(xr + 8) = o; }
        { u32x4 o = {pack2(X8[0], X8[1]), pack2(X9[0], X9[1]), pack2(X10[0], X10[1]), pack2(X11[0], X11[1])}; *(u32x4*)(xr + 16) = o; }
        { u32x4 o = {pack2(X12[0], X12[1]), pack2(X13[0], X13[1]), pack2(X14[0], X14[1]), pack2(X15[0], X15[1])}; *(u32x4*)(xr + 24) = o; }
        bf16x8 lb0 = *(const bf16x8*)(Lb_s + (0 + l15) * 40 + quad * 8), lb1 = *(const bf16x8*)(Lb_s + (16 + l15) * 40 + quad * 8);
        f32x4 d[4][2];
#pragma unroll
        for (int ct = 0; ct < 4; ++ct) {
            const bf16x8 xt = *(const bf16x8*)(XT_s + (wv * 64 + ct * 16 + l15) * 32 + quad * 8);
            d[ct][0] = mfma16(lb0, xt, (f32x4){0.f, 0.f, 0.f, 0.f}); d[ct][1] = mfma16(lb1, xt, (f32x4){0.f, 0.f, 0.f, 0.f});
        }
#pragma unroll
        for (int ct = 0; ct < 4; ++ct)
#pragma unroll
            for (int it = 0; it < 2; ++it) { u32x2 o; o.x = pack2(d[ct][it][0], d[ct][it][1]); o.y = pack2(d[ct][it][2], d[ct][it][3]);
                *(u32x2*)(XT_s + (wv * 64 + ct * 16 + l15) * 32 + it * 16 + quad * 4) = o; }
        { const u32x4 u = *(const u32x4*)(xr + 0);
          X16 -= (f32x2){lo16(u[0]), hi16(u[0])};
          X17 -= (f32x2){lo16(u[1]), hi16(u[1])};
          X18 -= (f32x2){lo16(u[2]), hi16(u[2])};
          X19 -= (f32x2){lo16(u[3]), hi16(u[3])};
        }
        { const u32x4 u = *(const u32x4*)(xr + 8);
          X20 -= (f32x2){lo16(u[0]), hi16(u[0])};
          X21 -= (f32x2){lo16(u[1]), hi16(u[1])};
          X22 -= (f32x2){lo16(u[2]), hi16(u[2])};
          X23 -= (f32x2){lo16(u[3]), hi16(u[3])};
        }
        { const u32x4 u = *(const u32x4*)(xr + 16);
          X24 -= (f32x2){lo16(u[0]), hi16(u[0])};
          X25 -= (f32x2){lo16(u[1]), hi16(u[1])};
          X26 -= (f32x2){lo16(u[2]), hi16(u[2])};
          X27 -= (f32x2){lo16(u[3]), hi16(u[3])};
        }
        { const u32x4 u = *(const u32x4*)(xr + 24);
          X28 -= (f32x2){lo16(u[0]), hi16(u[0])};
          X29 -= (f32x2){lo16(u[1]), hi16(u[1])};
          X30 -= (f32x2){lo16(u[2]), hi16(u[2])};
          X31 -= (f32x2){lo16(u[3]), hi16(u[3])};
        }
    }
    La8 = *(const f32x4*)(Lt_s + 2208);
    La9 = *(const f32x4*)(Lt_s + 2212);
    La10 = *(const f32x4*)(Lt_s + 2216);
    La11 = *(const f32x4*)(Lt_s + 2220);
    La12 = *(const f32x4*)(Lt_s + 2224);
    La13 = *(const f32x4*)(Lt_s + 2228);
    La14 = *(const f32x4*)(Lt_s + 2232);
    La15 = *(const f32x4*)(Lt_s + 2236);
    Lb8 = *(const f32x4*)(Lt_s + 2276);
    Lb9 = *(const f32x4*)(Lt_s + 2280);
    Lb10 = *(const f32x4*)(Lt_s + 2284);
    Lb11 = *(const f32x4*)(Lt_s + 2288);
    Lb12 = *(const f32x4*)(Lt_s + 2292);
    Lb13 = *(const f32x4*)(Lt_s + 2296);
    Lb14 = *(const f32x4*)(Lt_s + 2300);
    Lb15 = *(const f32x4*)(Lt_s + 2304);
    __builtin_amdgcn_sched_barrier(0);
    { const float xj = X16[0]; const f32x2 xj2 = (f32x2){xj, xj};
      X16 -= (f32x2){La8[0], La8[1]} * xj2;
      X17 -= (f32x2){La8[2], La8[3]} * xj2;
      X18 -= (f32x2){La9[0], La9[1]} * xj2;
      X19 -= (f32x2){La9[2], La9[3]} * xj2;
      X20 -= (f32x2){La10[0], La10[1]} * xj2;
      X21 -= (f32x2){La10[2], La10[3]} * xj2;
      X22 -= (f32x2){La11[0], La11[1]} * xj2;
      X23 -= (f32x2){La11[2], La11[3]} * xj2;
      X24 -= (f32x2){La12[0], La12[1]} * xj2;
      X25 -= (f32x2){La12[2], La12[3]} * xj2;
      X26 -= (f32x2){La13[0], La13[1]} * xj2;
      X27 -= (f32x2){La13[2], La13[3]} * xj2;
      X28 -= (f32x2){La14[0], La14[1]} * xj2;
      X29 -= (f32x2){La14[2], La14[3]} * xj2;
      X30 -= (f32x2){La15[0], La15[1]} * xj2;
      X31 -= (f32x2){La15[2], La15[3]} * xj2;
    }
    __builtin_amdgcn_sched_barrier(0);
    La8 = *(const f32x4*)(Lt_s + 2344);
    La9 = *(const f32x4*)(Lt_s + 2348);
    La10 = *(const f32x4*)(Lt_s + 2352);
    La11 = *(const f32x4*)(Lt_s + 2356);
    La12 = *(const f32x4*)(Lt_s + 2360);
    La13 = *(const f32x4*)(Lt_s + 2364);
    La14 = *(const f32x4*)(Lt_s + 2368);
    La15 = *(const f32x4*)(Lt_s + 2372);
    __builtin_amdgcn_sched_barrier(0);
    { const float xj = X16[1]; const f32x2 xj2 = (f32x2){xj, xj};
      X17 -= (f32x2){Lb8[2], Lb8[3]} * xj2;
      X18 -= (f32x2){Lb9[0], Lb9[1]} * xj2;
      X19 -= (f32x2){Lb9[2], Lb9[3]} * xj2;
      X20 -= (f32x2){Lb10[0], Lb10[1]} * xj2;
      X21 -= (f32x2){Lb10[2], Lb10[3]} * xj2;
      X22 -= (f32x2){Lb11[0], Lb11[1]} * xj2;
      X23 -= (f32x2){Lb11[2], Lb11[3]} * xj2;
      X24 -= (f32x2){Lb12[0], Lb12[1]} * xj2;
      X25 -= (f32x2){Lb12[2], Lb12[3]} * xj2;
      X26 -= (f32x2){Lb13[0], Lb13[1]} * xj2;
      X27 -= (f32x2){Lb13[2], Lb13[3]} * xj2;
      X28 -= (f32x2){Lb14[0], Lb14[1]} * xj2;
      X29 -= (f32x2){Lb14[2], Lb14[3]} * xj2;
      X30 -= (f32x2){Lb15[0], Lb15[1]} * xj2;
      X31 -= (f32x2){Lb15[2], Lb15[3]} * xj2;
    }
    __builtin_amdgcn_sched_barrier(0);
    Lb9 = *(const f32x4*)(Lt_s + 2416);
    Lb10 = *(const f32x4*)(Lt_s + 2420);
    Lb11 = *(const f32x4*)(Lt_s + 2424);
    Lb12 = *(const f32x4*)(Lt_s + 2428);
    Lb13 = *(const f32x4*)(Lt_s + 2432);
    Lb14 = *(const f32x4*)(Lt_s + 2436);
    Lb15 = *(const f32x4*)(Lt_s + 2440);
    __builtin_amdgcn_sched_barrier(0);
    { const float xj = X17[0]; const f32x2 xj2 = (f32x2){xj, xj};
      X17 -= (f32x2){La8[2], La8[3]} * xj2;
      X18 -= (f32x2){La9[0], La9[1]} * xj2;
      X19 -= (f32x2){La9[2], La9[3]} * xj2;
      X20 -= (f32x2){La10[0], La10[1]} * xj2;
      X21 -= (f32x2){La10[2], La10[3]} * xj2;
      X22 -= (f32x2){La11[0], La11[1]} * xj2;
      X23 -= (f32x2){La11[2], La11[3]} * xj2;
      X24 -= (f32x2){La12[0], La12[1]} * xj2;
      X25 -= (f32x2){La12[2], La12[3]} * xj2;
      X26 -= (f32x2){La13[0], La13[1]} * xj2;
      X27 -= (f32x2){La13[2], La13[3]} * xj2;
      X28 -= (f32x2){La14[0], La14[1]} * xj2;
      X29 -= (f32x2){La14[2], La14[3]} * xj2;
      X30 -= (f32x2){La15[0], La15[1]} * xj2;
      X31 -= (f32x2){La15[2], La15[3]} * xj2;
    }
    __builtin_amdgcn_sched_barrier(0);
    La9 = *(const f32x4*)(Lt_s + 2484);
    La10 = *(const f32x4*)(Lt_s + 2488);
    La11 = *(const f32x4*)(Lt_s + 2492);
    La12 = *(const f32x4*)(Lt_s + 2496);
    La13 = *(const f32x4*)(Lt_s + 2500);
    La14 = *(const f32x4*)(Lt_s + 2504);
    La15 = *(const f32x4*)(Lt_s + 2508);
    __builtin_amdgcn_sched_barrier(0);
    { const float xj = X17[1]; const f32x2 xj2 = (f32x2){xj, xj};
      X18 -= (f32x2){Lb9[0], Lb9[1]} * xj2;
      X19 -= (f32x2){Lb9[2], Lb9[3]} * xj2;
      X20 -= (f32x2){Lb10[0], Lb10[1]} * xj2;
      X21 -= (f32x2){Lb10[2], Lb10[3]} * xj2;
      X22 -= (f32x2){Lb11[0], Lb11[1]} * xj2;
      X23 -= (f32x2){Lb11[2], Lb11[3]} * xj2;
      X24 -= (f32x2){Lb12[0], Lb12[1]} * xj2;
      X25 -= (f32x2){Lb12[2], Lb12[3]} * xj2;
      X26 -= (f32x2){Lb13[0], Lb13[1]} * xj2;
      X27 -= (f32x2){Lb13[2], Lb13[3]} * xj2;
      X28 -= (f32x2){Lb14[0], Lb14[1]} * xj2;
      X29 -= (f32x2){Lb14[2], Lb14[3]} * xj2;
      X30 -= (f32x2){Lb15[0], Lb15[1]} * xj2;
      X31 -= (f32x2){Lb15[2], Lb15[3]} * xj2;
    }
    __builtin_amdgcn_sched_barrier(0);
    Lb9 = *(const f32x4*)(Lt_s + 2552);
    Lb10 = *(const f32x4*)(Lt_s + 2556);
    Lb11 = *(const f32x4*)(Lt_s + 2560);
    Lb12 = *(const f32x4*)(Lt_s + 2564);
    Lb13 = *(const f32x4*)(Lt_s + 2568);
    Lb14 = *(const f32x4*)(Lt_s + 2572);
    Lb15 = *(const f32x4*)(Lt_s + 2576);
    __builtin_amdgcn_sched_barrier(0);
    { const float xj = X18[0]; const f32x2 xj2 = (f32x2){xj, xj};
      X18 -= (f32x2){La9[0], La9[1]} * xj2;
      X19 -= (f32x2){La9[2], La9[3]} * xj2;
      X20 -= (f32x2){La10[0], La10[1]} * xj2;
      X21 -= (f32x2){La10[2], La10[3]} * xj2;
      X22 -= (f32x2){La11[0], La11[1]} * xj2;
      X23 -= (f32x2){La11[2], La11[3]} * xj2;
      X24 -= (f32x2){La12[0], La12[1]} * xj2;
      X25 -= (f32x2){La12[2], La12[3]} * xj2;
      X26 -= (f32x2){La13[0], La13[1]} * xj2;
      X27 -= (f32x2){La13[2], La13[3]} * xj2;
      X28 -= (f32x2){La14[0], La14[1]} * xj2;
      X29 -= (f32x2){La14[2], La14[3]} * xj2;
      X30 -= (f32x2){La15[0], La15[1]} * xj2;
      X31 -= (f32x2){La15[2], La15[3]} * xj2;
    }
    __builtin_amdgcn_sched_barrier(0);
    La9 = *(const f32x4*)(Lt_s + 2620);
    La10 = *(const f32x4*)(Lt_s + 2624);
    La11 = *(const f32x4*)(Lt_s + 2628);
    La12 = *(const f32x4*)(Lt_s + 2632);
    La13 = *(const f32x4*)(Lt_s + 2636);
    La14 = *(const f32x4*)(Lt_s + 2640);
    La15 = *(const f32x4*)(Lt_s + 2644);
    __builtin_amdgcn_sched_barrier(0);
    { const float xj = X18[1]; const f32x2 xj2 = (f32x2){xj, xj};
      X19 -= (f32x2){Lb9[2], Lb9[3]} * xj2;
      X20 -= (f32x2){Lb10[0], Lb10[1]} * xj2;
      X21 -= (f32x2){Lb10[2], Lb10[3]} * xj2;
      X22 -= (f32x2){Lb11[0], Lb11[1]} * xj2;
      X23 -= (f32x2){Lb11[2], Lb11[3]} * xj2;
      X24 -= (f32x2){Lb12[0], Lb12[1]} * xj2;
      X25 -= (f32x2){Lb12[2], Lb12[3]} * xj2;
      X26 -= (f32x2){Lb13[0], Lb13[1]} * xj2;
      X27 -= (f32x2){Lb13[2], Lb13[3]} * xj2;
      X28 -= (f32x2){Lb14[0], Lb14[1]} * xj2;
      X29 -= (f32x2){Lb14[2], Lb14[3]} * xj2;
      X30 -= (f32x2){Lb15[0], Lb15[1]} * xj2;
      X31 -= (f32x2){Lb15[2], Lb15[3]} * xj2;
    }
    __builtin_amdgcn_sched_barrier(0);
    Lb10 = *(const f32x4*)(Lt_s + 2692);
    Lb11 = *(const f32x4*)(Lt_s + 2696);
    Lb12 = *(const f32x4*)(Lt_s + 2700);
    Lb13 = *(const f32x4*)(Lt_s + 2704);
    Lb14 = *(const f32x4*)(Lt_s + 2708);
    Lb15 = *(const f32x4*)(Lt_s + 2712);
    __builtin_amdgcn_sched_barrier(0);
    { const float xj = X19[0]; const f32x2 xj2 = (f32x2){xj, xj};
      X19 -= (f32x2){La9[2], La9[3]} * xj2;
      X20 -= (f32x2){La10[0], La10[1]} * xj2;
      X21 -= (f32x2){La10[2], La10[3]} * xj2;
      X22 -= (f32x2){La11[0], La11[1]} * xj2;
      X23 -= (f32x2){La11[2], La11[3]} * xj2;
      X24 -= (f32x2){La12[0], La12[1]} * xj2;
      X25 -= (f32x2){La12[2], La12[3]} * xj2;
      X26 -= (f32x2){La13[0], La13[1]} * xj2;
      X27 -= (f32x2){La13[2], La13[3]} * xj2;
      X28 -= (f32x2){La14[0], La14[1]} * xj2;
      X29 -= (f32x2){La14[2], La14[3]} * xj2;
      X30 -= (f32x2){La15[0], La15[1]} * xj2;
      X31 -= (f32x2){La15[2], La15[3]} * xj2;
    }
    __builtin_amdgcn_sched_barrier(0);
    La10 = *(const f32x4*)(Lt_s + 2760);
    La11 = *(const f32x4*)(Lt_s + 2764);
    La12 = *(const f32x4*)(Lt_s + 2768);
    La13 = *(const f32x4*)(Lt_s + 2772);
    La14 = *(const f32x4*)(Lt_s + 2776);
    La15 = *(const f32x4*)(Lt_s + 2780);
    __builtin_amdgcn_sched_barrier(0);
    { const float xj = X19[1]; const f32x2 xj2 = (f32x2){xj, xj};
      X20 -= (f32x2){Lb10[0], Lb10[1]} * xj2;
      X21 -= (f32x2){Lb10[2], Lb10[3]} * xj2;
      X22 -= (f32x2){Lb11[0], Lb11[1]} * xj2;
      X23 -= (f32x2){Lb11[2], Lb11[3]} * xj2;
      X24 -= (f32x2){Lb12[0], Lb12[1]} * xj2;
      X25 -= (f32x2){Lb12[2], Lb12[3]} * xj2;
      X26 -= (f32x2){Lb13[0], Lb13[1]} * xj2;
      X27 -= (f32x2){Lb13[2], Lb13[3]} * xj2;
      X28 -= (f32x2){Lb14[0], Lb14[1]} * xj2;
      X29 -= (f32x2){Lb14[2], Lb14[3]} * xj2;
      X30 -= (f32x2){Lb15[0], Lb15[1]} * xj2;
      X31 -= (f32x2){Lb15[2], Lb15[3]} * xj2;
    }
    __builtin_amdgcn_sched_barrier(0);
    Lb10 = *(const f32x4*)(Lt_s + 2828);
    Lb11 = *(const f32x4*)(Lt_s + 2832);
    Lb12 = *(const f32x4*)(Lt_s + 2836);
    Lb13 = *(const f32x4*)(Lt_s + 2840);
    Lb14 = *(const f32x4*)(Lt_s + 2844);
    Lb15 = *(const f32x4*)(Lt_s + 2848);
    __builtin_amdgcn_sched_barrier(0);
    { const float xj = X20[0]; const f32x2 xj2 = (f32x2){xj, xj};
      X20 -= (f32x2){La10[0], La10[1]} * xj2;
      X21 -= (f32x2){La10[2], La10[3]} * xj2;
      X22 -= (f32x2){La11[0], La11[1]} * xj2;
      X23 -= (f32x2){La11[2], La11[3]} * xj2;
      X24 -= (f32x2){La12[0], La12[1]} * xj2;
      X25 -= (f32x2){La12[2], La12[3]} * xj2;
      X26 -= (f32x2){La13[0], La13[1]} * xj2;
      X27 -= (f32x2){La13[2], La13[3]} * xj2;
      X28 -= (f32x2){La14[0], La14[1]} * xj2;
      X29 -= (f32x2){La14[2], La14[3]} * xj2;
      X30 -= (f32x2){La15[0], La15[1]} * xj2;
      X31 -= (f32x2){La15[2], La15[3]} * xj2;
    }
    __builtin_amdgcn_sched_barrier(0);
    La10 = *(const f32x4*)(Lt_s + 2896);
    La11 = *(const f32x4*)(Lt_s + 2900);
    La12 = *(const f32x4*)(Lt_s + 2904);
    La13 = *(const f32x4*)(Lt_s + 2908);
    La14 = *(const f32x4*)(Lt_s + 2912);
    La15 = *(const f32x4*)(Lt_s + 2916);
    __builtin_amdgcn_sched_barrier(0);
    { const float xj = X20[1]; const f32x2 xj2 = (f32x2){xj, xj};
      X21 -= (f32x2){Lb10[2], Lb10[3]} * xj2;
      X22 -= (f32x2){Lb11[0], Lb11[1]} * xj2;
      X23 -= (f32x2){Lb11[2], Lb11[3]} * xj2;
      X24 -= (f32x2){Lb12[0], Lb12[1]} * xj2;
      X25 -= (f32x2){Lb12[2], Lb12[3]} * xj2;
      X26 -= (f32x2){Lb13[0], Lb13[1]} * xj2;
      X27 -= (f32x2){Lb13[2], Lb13[3]} * xj2;
      X28 -= (f32x2){Lb14[0], Lb14[1]} * xj2;
      X29 -= (f32x2){Lb14[2], Lb14[3]} * xj2;
      X30 -= (f32x2){Lb15[0], Lb15[1]} * xj2;
      X31 -= (f32x2){Lb15[2], Lb15[3]} * xj2;
    }
    __builtin_amdgcn_sched_barrier(0);
    Lb11 = *(const f32x4*)(Lt_s + 2968);
    Lb12 = *(const f32x4*)(Lt_s + 2972);
    Lb13 = *(const f32x4*)(Lt_s + 2976);
    Lb14 = *(const f32x4*)(Lt_s + 2980);
    Lb15 = *(const f32x4*)(Lt_s + 2984);
    __builtin_amdgcn_sched_barrier(0);
    { const float xj = X21[0]; const f32x2 xj2 = (f32x2){xj, xj};
      X21 -= (f32x2){La10[2], La10[3]} * xj2;
      X22 -= (f32x2){La11[0], La11[1]} * xj2;
      X23 -= (f32x2){La11[2], La11[3]} * xj2;
      X24 -= (f32x2){La12[0], La12[1]} * xj2;
      X25 -= (f32x2){La12[2], La12[3]} * xj2;
      X26 -= (f32x2){La13[0], La13[1]} * xj2;
      X27 -= (f32x2){La13[2], La13[3]} * xj2;
      X28 -= (f32x2){La14[0], La14[1]} * xj2;
      X29 -= (f32x2){La14[2], La14[3]} * xj2;
      X30 -= (f32x2){La15[0], La15[1]} * xj2;
      X31 -= (f32x2){La15[2], La15[3]} * xj2;
    }
    __builtin_amdgcn_sched_barrier(0);
    La11 = *(const f32x4*)(Lt_s + 3036);
    La12 = *(const f32x4*)(Lt_s + 3040);
    La13 = *(const f32x4*)(Lt_s + 3044);
    La14 = *(const f32x4*)(Lt_s + 3048);
    La15 = *(const f32x4*)(Lt_s + 3052);
    __builtin_amdgcn_sched_barrier(0);
    { const float xj = X21[1]; const f32x2 xj2 = (f32x2){xj, xj};
      X22 -= (f32x2){Lb11[0], Lb11[1]} * xj2;
      X23 -= (f32x2){Lb11[2], Lb11[3]} * xj2;
      X24 -= (f32x2){Lb12[0], Lb12[1]} * xj2;
      X25 -= (f32x2){Lb12[2], Lb12[3]} * xj2;
      X26 -= (f32x2){Lb13[0], Lb13[1]} * xj2;
      X27 -= (f32x2){Lb13[2], Lb13[3]} * xj2;
      X28 -= (f32x2){Lb14[0], Lb14[1]} * xj2;
      X29 -= (f32x2){Lb14[2], Lb14[3]} * xj2;
      X30 -= (f32x2){Lb15[0], Lb15[1]} * xj2;
      X31 -= (f32x2){Lb15[2], Lb15[3]} * xj2;
    }
    __builtin_amdgcn_sched_barrier(0);
    Lb11 = *(const f32x4*)(Lt_s + 3104);
    Lb12 = *(const f32x4*)(Lt_s + 3108);
    Lb13 = *(const f32x4*)(Lt_s + 3112);
    Lb14 = *(const f32x4*)(Lt_s + 3116);
    Lb15 = *(const f32x4*)(Lt_s + 3120);
    __builtin_amdgcn_sched_barrier(0);
    { const float xj = X22[0]; const f32x2 xj2 = (f32x2){xj, xj};
      X22 -= (f32x2){La11[0], La11[1]} * xj2;
      X23 -= (f32x2){La11[2], La11[3]} * xj2;
      X24 -= (f32x2){La12[0], La12[1]} * xj2;
      X25 -= (f32x2){La12[2], La12[3]} * xj2;
      X26 -= (f32x2){La13[0], La13[1]} * xj2;
      X27 -= (f32x2){La13[2], La13[3]} * xj2;
      X28 -= (f32x2){La14[0], La14[1]} * xj2;
      X29 -= (f32x2){La14[2], La14[3]} * xj2;
      X30 -= (f32x2){La15[0], La15[1]} * xj2;
      X31 -= (f32x2){La15[2], La15[3]} * xj2;
    }
    __builtin_amdgcn_sched_barrier(0);
    La11 = *(const f32x4*)(Lt_s + 3172);
    La12 = *(const f32x4*)(Lt_s + 3176);
    La13 = *(const f32x4*)(Lt_s + 3180);
    La14 = *(const f32x4*)(Lt_s + 3184);
    La15 = *(const f32x4*)(Lt_s + 3188);
    __builtin_amdgcn_sched_barrier(0);
    { const float xj = X22[1]; const f32x2 xj2 = (f32x2){xj, xj};
      X23 -= (f32x2){Lb11[2], Lb11[3]} * xj2;
      X24 -= (f32x2){Lb12[0], Lb12[1]} * xj2;
      X25 -= (f32x2){Lb12[2], Lb12[3]} * xj2;
      X26 -= (f32x2){Lb13[0], Lb13[1]} * xj2;
      X27 -= (f32x2){Lb13[2], Lb13[3]} * xj2;
      X28 -= (f32x2){Lb14[0], Lb14[1]} * xj2;
      X29 -= (f32x2){Lb14[2], Lb14[3]} * xj2;
      X30 -= (f32x2){Lb15[0], Lb15[1]} * xj2;
      X31 -= (f32x2){Lb15[2], Lb15[3]} * xj2;
    }
    __builtin_amdgcn_sched_barrier(0);
    Lb12 = *(const f32x4*)(Lt_s + 3244);
    Lb13 = *(const f32x4*)(Lt_s + 3248);
    Lb14 = *(const f32x4*)(Lt_s + 3252);
    Lb15 = *(const f32x4*)(Lt_s + 3256);
    __builtin_amdgcn_sched_barrier(0);
    { const float xj = X23[0]; const f32x2 xj2 = (f32x2){xj, xj};
      X23 -= (f32x2){La11[2], La11[3]} * xj2;
      X24 -= (f32x2){La12[0], La12[1]} * xj2;
      X25 -= (f32x2){La12[2], La12[3]} * xj2;
      X26 -= (f32x2){La13[0], La13[1]} * xj2;
      X27 -= (f32x2){La13[2], La13[3]} * xj2;
      X28 -= (f32x2){La14[0], La14[1]} * xj2;
      X29 -= (f32x2){La14[2], La14[3]} * xj2;
      X30 -= (f32x2){La15[0], La15[1]} * xj2;
      X31 -= (f32x2){La15[2], La15[3]} * xj2;
    }
    __builtin_amdgcn_sched_barrier(0);
    La12 = *(const f32x4*)(Lt_s + 3312);
    La13 = *(const f32x4*)(Lt_s + 3316);
    La14 = *(const f32x4*)(Lt_s + 3320);
    La15 = *(const f32x4*)(Lt_s + 3324);
    __builtin_amdgcn_sched_barrier(0);
    { const float xj = X23[1]; const f32x2 xj2 = (f32x2){xj, xj};
      X24 -= (f32x2){Lb12[0], Lb12[1]} * xj2;
      X25 -= (f32x2){Lb12[2], Lb12[3]} * xj2;
      X26 -= (f32x2){Lb13[0], Lb13[1]} * xj2;
      X27 -= (f32x2){Lb13[2], Lb13[3]} * xj2;
      X28 -= (f32x2){Lb14[0], Lb14[1]} * xj2;
      X29 -= (f32x2){Lb14[2], Lb14[3]} * xj2;
      X30 -= (f32x2){Lb15[0], Lb15[1]} * xj2;
      X31 -= (f32x2){Lb15[2], Lb15[3]} * xj2;
    }
    __builtin_amdgcn_sched_barrier(0);
    Lb12 = *(const f32x4*)(Lt_s + 3380);
    Lb13 = *(const f32x4*)(Lt_s + 3384);
    Lb14 = *(const f32x4*)(Lt_s + 3388);
    Lb15 = *(const f32x4*)(Lt_s + 3392);
    __builtin_amdgcn_sched_barrier(0);
    { const float xj = X24[0]; const f32x2 xj2 = (f32x2){xj, xj};
      X24 -= (f32x2){La12[0], La12[1]} * xj2;
      X25 -= (f32x2){La12[2], La12[3]} * xj2;
      X26 -= (f32x2){La13[0], La13[1]} * xj2;
      X27 -= (f32x2){La13[2], La13[3]} * xj2;
      X28 -= (f32x2){La14[0], La14[1]} * xj2;
      X29 -= (f32x2){La14[2], La14[3]} * xj2;
      X30 -= (f32x2){La15[0], La15[1]} * xj2;
      X31 -= (f32x2){La15[2], La15[3]} * xj2;
    }
    __builtin_amdgcn_sched_barrier(0);
    La12 = *(const f32x4*)(Lt_s + 3448);
    La13 = *(const f32x4*)(Lt_s + 3452);
    La14 = *(const f32x4*)(Lt_s + 3456);
    La15 = *(const f32x4*)(Lt_s + 3460);
    __builtin_amdgcn_sched_barrier(0);
    { const float xj = X24[1]; const f32x2 xj2 = (f32x2){xj, xj};
      X25 -= (f32x2){Lb12[2], Lb12[3]} * xj2;
      X26 -= (f32x2){Lb13[0], Lb13[1]} * xj2;
      X27 -= (f32x2){Lb13[2], Lb13[3]} * xj2;
      X28 -= (f32x2){Lb14[0], Lb14[1]} * xj2;
      X29 -= (f32x2){Lb14[2], Lb14[3]} * xj2;
      X30 -= (f32x2){Lb15[0], Lb15[1]} * xj2;
      X31 -= (f32x2){Lb15[2], Lb15[3]} * xj2;
    }
    __builtin_amdgcn_sched_barrier(0);
    Lb13 = *(const f32x4*)(Lt_s + 3520);
    Lb14 = *(const f32x4*)(Lt_s + 3524);
    Lb15 = *(const f32x4*)(Lt_s + 3528);
    __builtin_amdgcn_sched_barrier(0);
    { const float xj = X25[0]; const f32x2 xj2 = (f32x2){xj, xj};
      X25 -= (f32x2){La12[2], La12[3]} * xj2;
      X26 -= (f32x2){La13[0], La13[1]} * xj2;
      X27 -= (f32x2){La13[2], La13[3]} * xj2;
      X28 -= (f32x2){La14[0], La14[1]} * xj2;
      X29 -= (f32x2){La14[2], La14[3]} * xj2;
      X30 -= (f32x2){La15[0], La15[1]} * xj2;
      X31 -= (f32x2){La15[2], La15[3]} * xj2;
    }
    __builtin_amdgcn_sched_barrier(0);
    La13 = *(const f32x4*)(Lt_s + 3588);
    La14 = *(const f32x4*)(Lt_s + 3592);
    La15 = *(const f32x4*)(Lt_s + 3596);
    __builtin_amdgcn_sched_barrier(0);
    { const float xj = X25[1]; const f32x2 xj2 = (f32x2){xj, xj};
      X26 -= (f32x2){Lb13[0], Lb13[1]} * xj2;
      X27 -= (f32x2){Lb13[2], Lb13[3]} * xj2;
      X28 -= (f32x2){Lb14[0], Lb14[1]} * xj2;
      X29 -= (f32x2){Lb14[2], Lb14[3]} * xj2;
      X30 -= (f32x2){Lb15[0], Lb15[1]} * xj2;
      X31 -= (f32x2){Lb15[2], Lb15[3]} * xj2;
    }
    __builtin_amdgcn_sched_barrier(0);
    Lb13 = *(const f32x4*)(Lt_s + 3656);
    Lb14 = *(const f32x4*)(Lt_s + 3660);
    Lb15 = *(const f32x4*)(Lt_s + 3664);
    __builtin_amdgcn_sched_barrier(0);
    { const float xj = X26[0]; const f32x2 xj2 = (f32x2){xj, xj};
      X26 -= (f32x2){La13[0], La13[1]} * xj2;
      X27 -= (f32x2){La13[2], La13[3]} * xj2;
      X28 -= (f32x2){La14[0], La14[1]} * xj2;
      X29 -= (f32x2){La14[2], La14[3]} * xj2;
      X30 -= (f32x2){La15[0], La15[1]} * xj2;
      X31 -= (f32x2){La15[2], La15[3]} * xj2;
    }
    __builtin_amdgcn_sched_barrier(0);
    La13 = *(const f32x4*)(Lt_s + 3724);
    La14 = *(const f32x4*)(Lt_s + 3728);
    La15 = *(const f32x4*)(Lt_s + 3732);
    __builtin_amdgcn_sched_barrier(0);
    { const float xj = X26[1]; const f32x2 xj2 = (f32x2){xj, xj};
      X27 -= (f32x2){Lb13[2], Lb13[3]} * xj2;
      X28 -= (f32x2){Lb14[0], Lb14[1]} * xj2;
      X29 -= (f32x2){Lb14[2], Lb14[3]} * xj2;
      X30 -= (f32x2){Lb15[0], Lb15[1]} * xj2;
      X31 -= (f32x2){Lb15[2], Lb15[3]} * xj2;
    }
    __builtin_amdgcn_sched_barrier(0);
    Lb14 = *(const f32x4*)(Lt_s + 3796);
    Lb15 = *(const f32x4*)(Lt_s + 3800);
    __builtin_amdgcn_sched_barrier(0);
    { const float xj = X27[0]; const f32x2 xj2 = (f32x2){xj, xj};
      X27 -= (f32x2){La13[2], La13[3]} * xj2;
      X28 -= (f32x2){La14[0], La14[1]} * xj2;
      X29 -= (f32x2){La14[2], La14[3]} * xj2;
      X30 -= (f32x2){La15[0], La15[1]} * xj2;
      X31 -= (f32x2){La15[2], La15[3]} * xj2;
    }
    __builtin_amdgcn_sched_barrier(0);
    La14 = *(const f32x4*)(Lt_s + 3864);
    La15 = *(const f32x4*)(Lt_s + 3868);
    __builtin_amdgcn_sched_barrier(0);
    { const float xj = X27[1]; const f32x2 xj2 = (f32x2){xj, xj};
      X28 -= (f32x2){Lb14[0], Lb14[1]} * xj2;
      X29 -= (f32x2){Lb14[2], Lb14[3]} * xj2;
      X30 -= (f32x2){Lb15[0], Lb15[1]} * xj2;
      X31 -= (f32x2){Lb15[2], Lb15[3]} * xj2;
    }
    __builtin_amdgcn_sched_barrier(0);
    Lb14 = *(const f32x4*)(Lt_s + 3932);
    Lb15 = *(const f32x4*)(Lt_s + 3936);
    __builtin_amdgcn_sched_barrier(0);
    { const float xj = X28[0]; const f32x2 xj2 = (f32x2){xj, xj};
      X28 -= (f32x2){La14[0], La14[1]} * xj2;
      X29 -= (f32x2){La14[2], La14[3]} * xj2;
      X30 -= (f32x2){La15[0], La15[1]} * xj2;
      X31 -= (f32x2){La15[2], La15[3]} * xj2;
    }
    __builtin_amdgcn_sched_barrier(0);
    La14 = *(const f32x4*)(Lt_s + 4000);
    La15 = *(const f32x4*)(Lt_s + 4004);
    __builtin_amdgcn_sched_barrier(0);
    { const float xj = X28[1]; const f32x2 xj2 = (f32x2){xj, xj};
      X29 -= (f32x2){Lb14[2], Lb14[3]} * xj2;
      X30 -= (f32x2){Lb15[0], Lb15[1]} * xj2;
      X31 -= (f32x2){Lb15[2], Lb15[3]} * xj2;
    }
    __builtin_amdgcn_sched_barrier(0);
    Lb15 = *(const f32x4*)(Lt_s + 4072);
    __builtin_amdgcn_sched_barrier(0);
    { const float xj = X29[0]; const f32x2 xj2 = (f32x2){xj, xj};
      X29 -= (f32x2){La14[2], La14[3]} * xj2;
      X30 -= (f32x2){La15[0], La15[1]} * xj2;
      X31 -= (f32x2){La15[2], La15[3]} * xj2;
    }
    __builtin_amdgcn_sched_barrier(0);
    La15 = *(const f32x4*)(Lt_s + 4140);
    __builtin_amdgcn_sched_barrier(0);
    { const float xj = X29[1]; const f32x2 xj2 = (f32x2){xj, xj};
      X30 -= (f32x2){Lb15[0], Lb15[1]} * xj2;
      X31 -= (f32x2){Lb15[2], Lb15[3]} * xj2;
    }
    __builtin_amdgcn_sched_barrier(0);
    Lb15 = *(const f32x4*)(Lt_s + 4208);
    __builtin_amdgcn_sched_barrier(0);
    { const float xj = X30[0]; const f32x2 xj2 = (f32x2){xj, xj};
      X30 -= (f32x2){La15[0], La15[1]} * xj2;
      X31 -= (f32x2){La15[2], La15[3]} * xj2;
    }
    __builtin_amdgcn_sched_barrier(0);
    La15 = *(const f32x4*)(Lt_s + 4276);
    __builtin_amdgcn_sched_barrier(0);
    { const float xj = X30[1]; const f32x2 xj2 = (f32x2){xj, xj};
      X31 -= (f32x2){Lb15[2], Lb15[3]} * xj2;
    }
    __builtin_amdgcn_sched_barrier(0);
    __builtin_amdgcn_sched_barrier(0);
    { const float xj = X31[0]; const f32x2 xj2 = (f32x2){xj, xj};
      X31 -= (f32x2){La15[2], La15[3]} * xj2;
    }
    __builtin_amdgcn_sched_barrier(0);
    __syncthreads();
    outp[0] = f2bf(sg * X0[0]);
    outp[136] = f2bf(sg * X0[1]);
    outp[272] = f2bf(sg * X1[0]);
    outp[408] = f2bf(sg * X1[1]);
    outp[544] = f2bf(sg * X2[0]);
    outp[680] = f2bf(sg * X2[1]);
    outp[816] = f2bf(sg * X3[0]);
    outp[952] = f2bf(sg * X3[1]);
    outp[1088] = f2bf(sg * X4[0]);
    outp[1224] = f2bf(sg * X4[1]);
    outp[1360] = f2bf(sg * X5[0]);
    outp[1496] = f2bf(sg * X5[1]);
    outp[1632] = f2bf(sg * X6[0]);
    outp[1768] = f2bf(sg * X6[1]);
    outp[1904] = f2bf(sg * X7[0]);
    outp[2040] = f2bf(sg * X7[1]);
    outp[2176] = f2bf(sg * X8[0]);
    outp[2312] = f2bf(sg * X8[1]);
    outp[2448] = f2bf(sg * X9[0]);
    outp[2584] = f2bf(sg * X9[1]);
    outp[2720] = f2bf(sg * X10[0]);
    outp[2856] = f2bf(sg * X10[1]);
    outp[2992] = f2bf(sg * X11[0]);
    outp[3128] = f2bf(sg * X11[1]);
    outp[3264] = f2bf(sg * X12[0]);
    outp[3400] = f2bf(sg * X12[1]);
    outp[3536] = f2bf(sg * X13[0]);
    outp[3672] = f2bf(sg * X13[1]);
    outp[3808] = f2bf(sg * X14[0]);
    outp[3944] = f2bf(sg * X14[1]);
    outp[4080] = f2bf(sg * X15[0]);
    outp[4216] = f2bf(sg * X15[1]);
    outp[4352] = f2bf(sg * X16[0]);
    outp[4488] = f2bf(sg * X16[1]);
    outp[4624] = f2bf(sg * X17[0]);
    outp[4760] = f2bf(sg * X17[1]);
    outp[4896] = f2bf(sg * X18[0]);
    outp[5032] = f2bf(sg * X18[1]);
    outp[5168] = f2bf(sg * X19[0]);
    outp[5304] = f2bf(sg * X19[1]);
    outp[5440] = f2bf(sg * X20[0]);
    outp[5576] = f2bf(sg * X20[1]);
    outp[5712] = f2bf(sg * X21[0]);
    outp[5848] = f2bf(sg * X21[1]);
    outp[5984] = f2bf(sg * X22[0]);
    outp[6120] = f2bf(sg * X22[1]);
    outp[6256] = f2bf(sg * X23[0]);
    outp[6392] = f2bf(sg * X23[1]);
    outp[6528] = f2bf(sg * X24[0]);
    outp[6664] = f2bf(sg * X24[1]);
    outp[6800] = f2bf(sg * X25[0]);
    outp[6936] = f2bf(sg * X25[1]);
    outp[7072] = f2bf(sg * X26[0]);
    outp[7208] = f2bf(sg * X26[1]);
    outp[7344] = f2bf(sg * X27[0]);
    outp[7480] = f2bf(sg * X27[1]);
    outp[7616] = f2bf(sg * X28[0]);
    outp[7752] = f2bf(sg * X28[1]);
    outp[7888] = f2bf(sg * X29[0]);
    outp[8024] = f2bf(sg * X29[1]);
    outp[8160] = f2bf(sg * X30[0]);
    outp[8296] = f2bf(sg * X30[1]);
    outp[8432] = f2bf(sg * X31[0]);
    outp[8568] = f2bf(sg * X31[1]);
}

DEV void dn_item(const Params& p, int l, int item, unsigned char* smem) {
    const int dir = item & 1, hh = (item >> 1) & 3, b = item >> 3;
    bf16_t* q_s = (bf16_t*)(smem);
    bf16_t* k_s = (bf16_t*)(smem + 17408);
    bf16_t* vnT_s = k_s;
    bf16_t* kT_s = (bf16_t*)(smem + 35840);
    bf16_t* v_s = (bf16_t*)(smem + 54272);
    bf16_t* u_s = v_s;
    float* L_s = (float*)(smem + 71680);
    bf16_t* w_s = (bf16_t*)(smem + 71680);
    bf16_t* qk_s = (bf16_t*)(smem + 89088);
    bf16_t* St_s = (bf16_t*)(smem + 98304);
    float* G_s = (float*)(smem + 133120);
    float* beta_s = G_s + 64;
    float* eG_s = G_s + 128;
    float* bw_s = G_s + 192;
    float* cw_s = G_s + 256;
    bf16_t* XT_s = k_s;
    bf16_t* Lb_s = (bf16_t*)(smem + 140288);
    const int tid = get_tid(), lane = tid & 63, wv = tid >> 6, l15 = lane & 15, quad = lane >> 4;
    const float Aneg = -expf(p.in[I_DNALOG][(l * 2 + dir) * 4 + hh]);
    const float dtb = p.in[I_DNDT][(l * 2 + dir) * 4 + hh];
    const bf16_t* P = wsb(p, O_P);
    const float* AB = wsf(p, O_AB);
    bf16_t* TO = wsb(p, dir ? O_TA2 : O_TA);
    __syncthreads();
    for (int e = tid; e < 4 * 384; e += 256) { int j = e / 384, c = e % 384, mat = c >> 7, cc = c & 127; cw_s[e] = p.in[I_DNCONV][((size_t)l * 4 + j) * 1536 + mat * 512 + hh * 128 + cc]; }
    for (int e = tid; e < 128 * 136 / 2; e += 256) ((unsigned*)St_s)[e] = 0u;
    f32x4 Sacc[2][8];
#pragma unroll
    for (int a = 0; a < 2; ++a)
#pragma unroll
        for (int c = 0; c < 8; ++c) Sacc[a][c] = (f32x4){0.f, 0.f, 0.f, 0.f};

    const int rg = tid >> 4, cseg = tid & 15, i0 = rg * 4;
    u32x4 raw[3][7];
    float pf_al = 0.f, pf_bb = 0.f;
#define DN_PREFETCH(NN, M0, M1) { \
        const int c_ = chunk_of(dir, (NN)); const int lo_ = c_ < 4 ? 0 : CTXL, hi_ = c_ < 4 ? CTXL : SB, base_ = c_ * 64; \
        const int slo_ = dir ? base_ + 60 - i0 : base_ + i0; \
        _Pragma("unroll") for (int u = 0; u < 7; ++u) { const int ss_ = slo_ - 1 + u; const bool ok_ = ss_ >= lo_ && ss_ < hi_; \
            const bf16_t* rp_ = P + ((size_t)b * SB + (ok_ ? ss_ : base_)) * PW + hh * 128 + cseg * 8; \
            _Pragma("unroll") for (int mat = (M0); mat < (M1); ++mat) { u32x4 t_ = *(const u32x4*)(rp_ + mat * 512); raw[mat][u] = ok_ ? t_ : (u32x4){0u, 0u, 0u, 0u}; } } \
        if ((M0) == 0) { const int sa_ = dir ? base_ + 63 - lane : base_ + lane; \
        pf_al = AB[((size_t)b * SB + sa_) * 16 + dir * 4 + hh]; pf_bb = AB[((size_t)b * SB + sa_) * 16 + 8 + dir * 4 + hh]; } }
    DN_PREFETCH(0, 0, 3);
    const int wv0_ = wv, l150_ = l15, quad0_ = quad, lane0_ = lane;

#pragma unroll 1
    for (int n = 0; n < 68; ++n) {
        int tz0 = 0; asm volatile("" : "+v"(tz0));
        const int wv = wv0_ + tz0, l15 = l150_ + tz0, quad = quad0_ + tz0, lane = lane0_ + tz0;
        const int c = chunk_of(dir, n);
        const int base = c * 64;
        __syncthreads();
        if (wv == 0) {
            float g = Aneg * softplus_fast(pf_al + dtb);
#pragma unroll
            for (int o = 1; o < 64; o <<= 1) { float t = __shfl_up(g, o); if (lane >= o) g += t; }
            const float eg_ = expf(g), bt_ = sigm(pf_bb); G_s[lane] = g; beta_s[lane] = bt_; eG_s[lane] = eg_; bw_s[lane] = bt_ * eg_;
        }
        __syncthreads();
        const float Glast = G_s[63];
        {
            int tz = 0; asm volatile("" : "+v"(tz));
            const int i0l = i0 + tz, csl = cseg + tz;
            float ksc[4];
#pragma unroll
            for (int m = 0; m < 4; ++m) ksc[m] = expf(Glast - G_s[i0l + m]);
#pragma unroll
            for (int mat = 0; mat < 3; ++mat) {
                float w[4][8];
#pragma unroll
                for (int j = 0; j < 4; ++j) { const f32x4 w0 = *(const f32x4*)(cw_s + j * 384 + mat * 128 + csl * 8), w1 = *(const f32x4*)(cw_s + j * 384 + mat * 128 + csl * 8 + 4);
#pragma unroll
                    for (int e = 0; e < 4; ++e) { w[j][e] = w0[e]; w[j][4 + e] = w1[e]; } }
                float v[4][8];
#pragma unroll
                for (int t = 0; t < 4; ++t)
#pragma unroll
                    for (int e = 0; e < 8; ++e) v[t][e] = 0.f;
#pragma unroll
                for (int u = 0; u < 7; ++u) {
                    float x[8];
#pragma unroll
                    for (int e = 0; e < 4; ++e) { x[2 * e] = lo16(raw[mat][u][e]); x[2 * e + 1] = hi16(raw[mat][u][e]); }
#pragma unroll
                    for (int t = 0; t < 4; ++t) { const int j = u - t; if (j >= 0 && j < 4) {
#pragma unroll
                        for (int e = 0; e < 8; ++e) v[t][e] += w[j][e] * x[e]; } }
                }
                float sc[4];
#pragma unroll
                for (int t = 0; t < 4; ++t) {
                    float ss2 = 0.f;
#pragma unroll
                    for (int e = 0; e < 8; ++e) { v[t][e] = silu(v[t][e]); ss2 += v[t][e] * v[t][e]; }
                    if (mat < 2) { ss2 += __shfl_xor(ss2, 1); ss2 += __shfl_xor(ss2, 2); ss2 += __shfl_xor(ss2, 4); ss2 += __shfl_xor(ss2, 8); }
                    sc[t] = mat == 0 ? rsqrtf(ss2 + 1e-6f) * 0.08838834764831845f : (mat == 1 ? rsqrtf(ss2 + 1e-6f) : 1.f);
                }
                bf16_t* dst = mat == 0 ? q_s : (mat == 1 ? k_s : v_s);
#pragma unroll
                for (int t = 0; t < 4; ++t) {
                    const int it_ = dir ? i0l + 3 - t : i0l + t;
                    u32x4 o;
#pragma unroll
                    for (int e = 0; e < 4; ++e) o[e] = pack2(v[t][2 * e] * sc[t], v[t][2 * e + 1] * sc[t]);
                    *(u32x4*)(dst + it_ * 136 + csl * 8) = o;
                }
                if (mat == 1) {
#pragma unroll
                    for (int e = 0; e < 8; ++e) {
                        const float k0 = v[dir ? 3 : 0][e] * sc[dir ? 3 : 0] * ksc[0], k1 = v[dir ? 2 : 1][e] * sc[dir ? 2 : 1] * ksc[1];
                        const float k2 = v[dir ? 1 : 2][e] * sc[dir ? 1 : 2] * ksc[2], k3 = v[dir ? 0 : 3][e] * sc[dir ? 0 : 3] * ksc[3];
                        u32x2 o; o.x = pack2(k0, k1); o.y = pack2(k2, k3);
                        *(u32x2*)(kT_s + (csl * 8 + e) * 72 + i0l) = o;
                    }
                }
            }
        }
        __syncthreads();
        {
            bf16x8 ak[4], aq[4];
#pragma unroll
            for (int ks = 0; ks < 4; ++ks) { ak[ks] = *(const bf16x8*)(k_s + (wv * 16 + l15) * 136 + ks * 32 + quad * 8); aq[ks] = *(const bf16x8*)(q_s + (wv * 16 + l15) * 136 + ks * 32 + quad * 8); }
#pragma unroll
            for (int nt = 0; nt < 4; ++nt) {
                f32x4 kk = {0.f, 0.f, 0.f, 0.f}, qq = {0.f, 0.f, 0.f, 0.f};
#pragma unroll
                for (int ks = 0; ks < 4; ++ks) { bf16x8 bk = *(const bf16x8*)(k_s + (nt * 16 + l15) * 136 + ks * 32 + quad * 8); kk = mfma16(ak[ks], bk, kk); qq = mfma16(aq[ks], bk, qq); }
                const int jj = nt * 16 + l15; const float Gj = G_s[jj];
                f32x4 lv;
#pragma unroll
                for (int j = 0; j < 4; ++j) {
                    const int i = wv * 16 + quad * 4 + j;
                    const float dec = jj <= i ? expf(G_s[i] - Gj) : 0.f;
                    lv[j] = jj < i ? beta_s[i] * kk[j] * dec : 0.f;
                    qk_s[i * 72 + jj] = f2bf(qq[j] * dec);
                }
                *(f32x4*)(L_s + jj * 68 + wv * 16 + quad * 4) = lv;
                if (wv >= 2 && nt < 2) {
#pragma unroll
                    for (int j = 0; j < 4; ++j) Lb_s[(wv * 16 - 32 + quad * 4 + j) * 40 + jj] = f2bf(lv[j]);
                }
            }
        }
        __syncthreads();
        dn_solve(L_s, tid < 128 ? (k_s + tid) : (v_s + (tid - 128)), tid < 128 ? bw_s : beta_s, tid < 128 ? -1.f : 1.f, tid < 128 ? (w_s + tid) : (u_s + (tid - 128)), XT_s, Lb_s, tid, wv, l15, quad);
        __syncthreads();
        {
            f32x4 vn[8], o1[8];
#pragma unroll
            for (int nt = 0; nt < 8; ++nt) {
#pragma unroll
                for (int j = 0; j < 4; ++j) vn[nt][j] = bf2f(u_s[(wv * 16 + quad * 4 + j) * 136 + nt * 16 + l15]);
                o1[nt] = (f32x4){0.f, 0.f, 0.f, 0.f};
            }
            bf16x8 aw[4], aq[4];
#pragma unroll
            for (int ks = 0; ks < 4; ++ks) { aw[ks] = *(const bf16x8*)(w_s + (wv * 16 + l15) * 136 + ks * 32 + quad * 8); aq[ks] = *(const bf16x8*)(q_s + (wv * 16 + l15) * 136 + ks * 32 + quad * 8); }
#pragma unroll
            for (int nt = 0; nt < 8; ++nt)
#pragma unroll
                for (int ks = 0; ks < 4; ++ks) { bf16x8 bs = *(const bf16x8*)(St_s + (nt * 16 + l15) * 136 + ks * 32 + quad * 8); vn[nt] = mfma16(aw[ks], bs, vn[nt]); o1[nt] = mfma16(aq[ks], bs, o1[nt]); }
#pragma unroll
            for (int nt = 0; nt < 8; ++nt) { u32x2 o; o.x = pack2(vn[nt][0], vn[nt][1]); o.y = pack2(vn[nt][2], vn[nt][3]); *(u32x2*)(vnT_s + (nt * 16 + l15) * 72 + wv * 16 + quad * 4) = o; }
            __syncthreads();
            if (n + 1 < 68) DN_PREFETCH(n + 1, 0, 2);
            float eg[4];
#pragma unroll
            for (int j = 0; j < 4; ++j) eg[j] = eG_s[wv * 16 + quad * 4 + j];
            bf16x8 aqk[2], akt[2][2];
#pragma unroll
            for (int ks = 0; ks < 2; ++ks) {
                aqk[ks] = *(const bf16x8*)(qk_s + (wv * 16 + l15) * 72 + ks * 32 + quad * 8);
                akt[0][ks] = *(const bf16x8*)(kT_s + (wv * 32 + l15) * 72 + ks * 32 + quad * 8);
                akt[1][ks] = *(const bf16x8*)(kT_s + (wv * 32 + 16 + l15) * 72 + ks * 32 + quad * 8);
            }
            const float gend = eG_s[63];
            const size_t orow0 = (size_t)b * SB;
#pragma unroll
            for (int nt = 0; nt < 8; ++nt) {
                f32x4 o;
#pragma unroll
                for (int j = 0; j < 4; ++j) { o[j] = o1[nt][j] * eg[j]; Sacc[0][nt][j] *= gend; Sacc[1][nt][j] *= gend; }
#pragma unroll
                for (int ks = 0; ks < 2; ++ks) {
                    bf16x8 bv = *(const bf16x8*)(vnT_s + (nt * 16 + l15) * 72 + ks * 32 + quad * 8);
                    o = mfma16(aqk[ks], bv, o);
                    Sacc[0][nt] = mfma16(akt[0][ks], bv, Sacc[0][nt]);
                    Sacc[1][nt] = mfma16(akt[1][ks], bv, Sacc[1][nt]);
                }
#pragma unroll
                for (int j = 0; j < 4; ++j) {
                    const int i = wv * 16 + quad * 4 + j;
                    const int s = dir ? base + 63 - i : base + i;
                    TO[(orow0 + s) * 512 + hh * 128 + nt * 16 + l15] = f2bf(o[j]);
                }
#pragma unroll
                for (int mt = 0; mt < 2; ++mt) { u32x2 sv; sv.x = pack2(Sacc[mt][nt][0], Sacc[mt][nt][1]); sv.y = pack2(Sacc[mt][nt][2], Sacc[mt][nt][3]);
                    *(u32x2*)(St_s + (nt * 16 + l15) * 136 + wv * 32 + mt * 16 + quad * 4) = sv; }
            }
        }
        if (n + 1 < 68) DN_PREFETCH(n + 1, 2, 3);
    }
}

#undef DN_PREFETCH
DEV void lru_item(const Params& p, int l, int item, unsigned char* smem) {
    const int g = item & 7, b = item >> 3;
    bf16_t* Wt_s = (bf16_t*)smem;
    bf16_t* xbh_s = Wt_s + 2 * 128 * 72;
    float* xbf_s = (float*)(smem + 36864 + 18432);
    float* a_s = xbf_s + 2 * 64 * 65;
    float* cw_s = a_s + 2 * 64 * 65;
    const int tid = get_tid(), lane = tid & 63, wv = tid >> 6, l15 = lane & 15, quad = lane >> 4;
    bf16_t* P = wsb(p, O_P);
    bf16_t* HF = wsb(p, O_U);
    __syncthreads();
    for (int e = tid; e < 320; e += 256) cw_s[e] = e < 256 ? p.in[I_LCW][((size_t)l * 4 + (e >> 6)) * 512 + g * 64 + (e & 63)] : p.in[I_LCB][l * 512 + g * 64 + (e - 256)];
    for (int e = tid; e < 2 * 4096; e += 256) {
        const int d = e >> 12, ch = (e >> 6) & 63, j = e & 63;
        const size_t wi_ = (((size_t)l * 2 + d) * 8 + g) * 4096 + ch * 64 + j;
        Wt_s[(d * 128 + j) * 72 + ch] = f2bf(p.in[I_LWA][wi_]);
        Wt_s[(d * 128 + 64 + j) * 72 + ch] = f2bf(p.in[I_LWI][wi_]);
    }
    float ba_[2][4], bi_[2][4], sp_[2][4];
#pragma unroll
    for (int d = 0; d < 2; ++d)
#pragma unroll
        for (int nt = 0; nt < 4; ++nt) {
            const int ch = (l * 2 + d) * 512 + g * 64 + nt * 16 + l15;
            ba_[d][nt] = p.in[I_LBA][ch]; bi_[d][nt] = p.in[I_LBI][ch]; sp_[d][nt] = softplus(-p.in[I_LLAM][ch]);
        }
    float hc = 0.f;
    const int i = tid >> 2, seg = tid & 3, j0 = seg * 16;
#pragma unroll 1
    for (int n = 0; n < 68; ++n) {
        const int cf = n, cb = chunk_of(1, n);
        __syncthreads();
#pragma unroll
        for (int d = 0; d < 2; ++d) {
            const int c = d ? cb : cf;
            const int seg_lo = c < 4 ? 0 : CTXL, seg_hi = c < 4 ? CTXL : SB;
            const int s = d ? c * 64 + 63 - i : c * 64 + i;
            float v[16];
#pragma unroll
            for (int e = 0; e < 16; ++e) v[e] = cw_s[256 + j0 + e];
#pragma unroll
            for (int j = 0; j < 4; ++j) {
                const int ss = s + j - 1;
                if (ss >= seg_lo && ss < seg_hi) {
                    const u32x4* src = (const u32x4*)(P + ((size_t)b * SB + ss) * PW + C_LX + g * 64 + j0);
                    const float* cw = cw_s + j * 64 + j0;
#pragma unroll
                    for (int q = 0; q < 2; ++q) { u32x4 x = src[q];
#pragma unroll
                        for (int e = 0; e < 4; ++e) { v[q * 8 + 2 * e] += cw[q * 8 + 2 * e] * lo16(x[e]); v[q * 8 + 2 * e + 1] += cw[q * 8 + 2 * e + 1] * hi16(x[e]); } }
                }
            }
            u32x4 h0, h1;
#pragma unroll
            for (int e = 0; e < 4; ++e) { h0[e] = pack2(v[2 * e], v[2 * e + 1]); h1[e] = pack2(v[8 + 2 * e], v[8 + 2 * e + 1]); }
            *(u32x4*)(xbh_s + (d * 64 + i) * 72 + j0) = h0; *(u32x4*)(xbh_s + (d * 64 + i) * 72 + j0 + 8) = h1;
#pragma unroll
            for (int e = 0; e < 16; ++e) xbf_s[(d * 64 + i) * 65 + j0 + e] = v[e];
        }
        __syncthreads();
#pragma unroll
        for (int d = 0; d < 2; ++d) {
            f32x4 acc[8];
#pragma unroll
            for (int nt = 0; nt < 8; ++nt) acc[nt] = (f32x4){0.f, 0.f, 0.f, 0.f};
            bf16x8 af[2];
#pragma unroll
            for (int ks = 0; ks < 2; ++ks) af[ks] = *(const bf16x8*)(xbh_s + (d * 64 + wv * 16 + l15) * 72 + ks * 32 + quad * 8);
#pragma unroll
            for (int nt = 0; nt < 8; ++nt)
#pragma unroll
                for (int ks = 0; ks < 2; ++ks) { bf16x8 bw = *(const bf16x8*)(Wt_s + (d * 128 + nt * 16 + l15) * 72 + ks * 32 + quad * 8); acc[nt] = mfma16(af[ks], bw, acc[nt]); }
#pragma unroll
            for (int nt = 0; nt < 4; ++nt)
#pragma unroll
                for (int jj = 0; jj < 4; ++jj) {
                    const int idx = (d * 64 + wv * 16 + quad * 4 + jj) * 65 + nt * 16 + l15;
                    const float r = sigm(acc[nt][jj] + ba_[d][nt]), ig = sigm(acc[nt + 4][jj] + bi_[d][nt]);
                    const float la = -8.f * r * sp_[d][nt];
                    a_s[idx] = expf(la);
                    xbf_s[idx] = sqrtf(fmaxf(1.f - expf(2.f * la), 0.f)) * (ig * xbf_s[idx]);
                }
        }
        __syncthreads();
        if (wv < 2) {
            const int o = wv * 64 * 65 + lane;
#pragma unroll 16
            for (int r = 0; r < 64; ++r) { hc = a_s[o + r * 65] * hc + xbf_s[o + r * 65]; xbf_s[o + r * 65] = hc; }
        }
        __syncthreads();
#pragma unroll
        for (int d = 0; d < 2; ++d) {
            const int c = d ? cb : cf;
            const int s = d ? c * 64 + 63 - i : c * 64 + i;
            const bool second = d ? (cb < n) : ((cf < 4 ? 3 - cf : 71 - cf) < n);
            const size_t row = (size_t)b * SB + s;
            const float* hp = xbf_s + (d * 64 + i) * 65 + j0;
            bf16_t* hf = HF + row * 512 + g * 64 + j0;
            if (!second) {
                u32x4 o0, o1;
#pragma unroll
                for (int e = 0; e < 4; ++e) { o0[e] = pack2(hp[2 * e], hp[2 * e + 1]); o1[e] = pack2(hp[8 + 2 * e], hp[8 + 2 * e + 1]); }
                *(u32x4*)hf = o0; *(u32x4*)(hf + 8) = o1;
            } else {
                bf16_t* gp = P + row * PW + C_LG + g * 64 + j0;
                u32x4 f0 = *(const u32x4*)hf, f1 = *(const u32x4*)(hf + 8), g0 = *(const u32x4*)gp, g1 = *(const u32x4*)(gp + 8), o0, o1;
#pragma unroll
                for (int e = 0; e < 4; ++e) {
                    o0[e] = pack2((lo16(f0[e]) + hp[2 * e]) * gelu_tanh(lo16(g0[e])), (hi16(f0[e]) + hp[2 * e + 1]) * gelu_tanh(hi16(g0[e])));
                    o1[e] = pack2((lo16(f1[e]) + hp[8 + 2 * e]) * gelu_tanh(lo16(g1[e])), (hi16(f1[e]) + hp[8 + 2 * e + 1]) * gelu_tanh(hi16(g1[e])));
                }
                *(u32x4*)gp = o0; *(u32x4*)(gp + 8) = o1;
            }
        }
    }
}

DEV void att_item(const Params& p, int l, int b, int h, int qt, float lam_init, unsigned char* smem) {
    bf16_t* K_s = (bf16_t*)smem;
    bf16_t* V_s = (bf16_t*)(smem + 2 * 17408);
    const int tid = get_tid(), lane = tid & 63, wv = tid >> 6, l15 = lane & 15, quad = lane >> 4;
    bf16_t* P = wsb(p, O_P);
    const bf16_t* VT = wsb(p, O_VT) + (size_t)(b * 4 + h) * 128 * SB;
    const int nt_keys = (qt < 2 ? CTXL : SB) / 64;
    float lam;
    {
        const float* lv = p.in[I_DALAM] + l * 256;
        float s1 = lv[lane] * lv[64 + lane], s2 = lv[128 + lane] * lv[192 + lane];
#pragma unroll
        for (int o = 32; o >= 1; o >>= 1) { s1 += __shfl_xor(s1, o); s2 += __shfl_xor(s2, o); }
        lam = expf(s1) - expf(s2) + lam_init;
    }
    bf16x8* Qst = (bf16x8*)(smem + 71680) + (wv * 8) * 64 + lane;
#pragma unroll
    for (int qg = 0; qg < 2; ++qg) {
        const bf16_t* qp = P + ((size_t)b * SB + qt * 128 + wv * 32 + qg * 16 + l15) * PW + C_DAQ + h * 128;
#pragma unroll
        for (int wh = 0; wh < 2; ++wh)
#pragma unroll
            for (int ks = 0; ks < 2; ++ks) Qst[(wh * 4 + qg * 2 + ks) * 64] = *(const bf16x8*)(qp + wh * 64 + ks * 32 + quad * 8);
    }
    f32x4 O[2][8][2];
    float mrun[2][2], lrun[2][2];
#pragma unroll
    for (int wh = 0; wh < 2; ++wh)
#pragma unroll
        for (int qg = 0; qg < 2; ++qg) { mrun[wh][qg] = -1e30f; lrun[wh][qg] = 0.f;
#pragma unroll
            for (int dg = 0; dg < 8; ++dg) O[wh][dg][qg] = (f32x4){0.f, 0.f, 0.f, 0.f}; }
    const int kr = tid >> 2, kseg = (tid & 3) * 32;
    const int kpos = ((kr >> 5) * 2 + ((kr & 7) >> 2)) * 16 + ((kr & 31) >> 3) * 4 + (kr & 3);
    const bf16_t* kg_ = P + ((size_t)b * SB + kr) * PW + C_DAK + h * 128 + kseg;
    const int vr = tid >> 1, vh = (tid & 1) * 32;
    const bf16_t* vg_ = VT + (size_t)vr * SB + vh;
    u32x4 kreg[4], vreg[4];
#pragma unroll
    for (int i = 0; i < 4; ++i) { kreg[i] = *(const u32x4*)(kg_ + i * 8); vreg[i] = *(const u32x4*)(vg_ + i * 8); }
    __syncthreads();
#pragma unroll
    for (int i = 0; i < 4; ++i) { *(u32x4*)(K_s + kpos * 136 + kseg + i * 8) = kreg[i]; *(u32x4*)(V_s + vr * 72 + vh + i * 8) = vreg[i]; }
    __syncthreads();
    const float L2E = 1.4426950408889634f;
#pragma unroll 1
    for (int t = 0; t < nt_keys; ++t) {
        const bf16_t* Kb = K_s + (t & 1) * (64 * 136);
        const bf16_t* Vb = V_s + (t & 1) * (128 * 72);
        if (t + 1 < nt_keys) {
#pragma unroll
            for (int i = 0; i < 4; ++i) { kreg[i] = *(const u32x4*)(kg_ + (size_t)(t + 1) * 64 * PW + i * 8); vreg[i] = *(const u32x4*)(vg_ + (t + 1) * 64 + i * 8); }
        }
#pragma unroll
        for (int wh = 0; wh < 2; ++wh) {
            f32x4 S[4][2];
#pragma unroll
            for (int kg = 0; kg < 4; ++kg) { S[kg][0] = (f32x4){0.f, 0.f, 0.f, 0.f}; S[kg][1] = (f32x4){0.f, 0.f, 0.f, 0.f}; }
#pragma unroll
            for (int ks = 0; ks < 2; ++ks)
#pragma unroll
                for (int kg = 0; kg < 4; ++kg) {
                    bf16x8 kf = *(const bf16x8*)(Kb + (kg * 16 + l15) * 136 + wh * 64 + ks * 32 + quad * 8);
                    S[kg][0] = mfma16(kf, Qst[(wh * 4 + 0 + ks) * 64], S[kg][0]);
                    S[kg][1] = mfma16(kf, Qst[(wh * 4 + 2 + ks) * 64], S[kg][1]);
                }
            bf16x8 Pf[2][2];
#pragma unroll
            for (int qg = 0; qg < 2; ++qg) {
                float mx = -1e30f;
#pragma unroll
                for (int kg = 0; kg < 4; ++kg)
#pragma unroll
                    for (int j = 0; j < 4; ++j) mx = fmaxf(mx, S[kg][qg][j]);
                mx = fmaxf(mx, __shfl_xor(mx, 16)); mx = fmaxf(mx, __shfl_xor(mx, 32));
                mx *= L2E;
                if (__builtin_amdgcn_ballot_w64(mx > mrun[wh][qg] + 8.f) != 0ull) {
                    const float mnew = fmaxf(mrun[wh][qg], mx);
                    const float alpha = __builtin_amdgcn_exp2f(mrun[wh][qg] - mnew);
                    mrun[wh][qg] = mnew;
                    lrun[wh][qg] *= alpha;
#pragma unroll
                    for (int dg = 0; dg < 8; ++dg)
#pragma unroll
                        for (int j = 0; j < 4; ++j) O[wh][dg][qg][j] *= alpha;
                }
                const float mref = mrun[wh][qg];
                float ps = 0.f;
#pragma unroll
                for (int kg = 0; kg < 4; ++kg)
#pragma unroll
                    for (int j = 0; j < 4; ++j) { float pv = __builtin_amdgcn_exp2f(S[kg][qg][j] * L2E - mref); ps += pv; S[kg][qg][j] = pv; }
                lrun[wh][qg] += ps;
#pragma unroll
                for (int s_ = 0; s_ < 2; ++s_) {
                    u32x4 pk; pk[0] = pack2(S[2 * s_][qg][0], S[2 * s_][qg][1]); pk[1] = pack2(S[2 * s_][qg][2], S[2 * s_][qg][3]);
                    pk[2] = pack2(S[2 * s_ + 1][qg][0], S[2 * s_ + 1][qg][1]); pk[3] = pack2(S[2 * s_ + 1][qg][2], S[2 * s_ + 1][qg][3]);
                    Pf[qg][s_] = __builtin_bit_cast(bf16x8, pk);
                }
            }
#pragma unroll
            for (int dg = 0; dg < 8; ++dg)
#pragma unroll
                for (int s_ = 0; s_ < 2; ++s_) {
                    bf16x8 vf = *(const bf16x8*)(Vb + (dg * 16 + l15) * 72 + s_ * 32 + quad * 8);
                    O[wh][dg][0] = mfma16(vf, Pf[0][s_], O[wh][dg][0]);
                    O[wh][dg][1] = mfma16(vf, Pf[1][s_], O[wh][dg][1]);
                }
        }
        if (t + 1 < nt_keys) {
            bf16_t* Kn = K_s + ((t + 1) & 1) * (64 * 136); bf16_t* Vn = V_s + ((t + 1) & 1) * (128 * 72);
#pragma unroll
            for (int i = 0; i < 4; ++i) { *(u32x4*)(Kn + kpos * 136 + kseg + i * 8) = kreg[i]; *(u32x4*)(Vn + vr * 72 + vh + i * 8) = vreg[i]; }
        }
        __syncthreads();
    }
    const float* dnw = p.in[I_DANORM] + l * 128;
#pragma unroll
    for (int qg = 0; qg < 2; ++qg) {
        float l1 = lrun[0][qg], l2 = lrun[1][qg];
        l1 += __shfl_xor(l1, 16); l1 += __shfl_xor(l1, 32); l2 += __shfl_xor(l2, 16); l2 += __shfl_xor(l2, 32);
        const float i1 = 1.f / l1, i2 = lam / l2;
        float ss = 0.f;
#pragma unroll
        for (int dg = 0; dg < 8; ++dg)
#pragma unroll
            for (int j = 0; j < 4; ++j) { float o = O[0][dg][qg][j] * i1 - O[1][dg][qg][j] * i2; O[0][dg][qg][j] = o; ss += o * o; }
        ss += __shfl_xor(ss, 16); ss += __shfl_xor(ss, 32);
        const float rstd = rsqrtf(ss * (1.f / 128.f) + 1e-5f) * (1.f - lam_init);
        bf16_t* op = P + ((size_t)b * SB + qt * 128 + wv * 32 + qg * 16 + l15) * PW + C_DAQ + h * 128;
#pragma unroll
        for (int dg = 0; dg < 8; ++dg) {
            const int dv0 = dg * 16 + quad * 4;
            u32x2 o; o.x = pack2(O[0][dg][qg][0] * rstd * dnw[dv0], O[0][dg][qg][1] * rstd * dnw[dv0 + 1]);
            o.y = pack2(O[0][dg][qg][2] * rstd * dnw[dv0 + 2], O[0][dg][qg][3] * rstd * dnw[dv0 + 3]);
            *(u32x2*)(op + dv0) = o;
        }
    }
}

DEV void phase_mix(const Params& p, int l, unsigned char* smem) {
    const bool need_ctx = l == 0;
    const float lam_init = l == 0 ? 0.2f : 0.35550906759096926f;
    unsigned* ctr = (unsigned*)(p.ws + O_CTL) + l;
    unsigned* actr = (unsigned*)(p.ws + O_CTL) + 16 + l * 8;
    __shared__ int s_item;
    const int nqt = need_ctx ? 34 : 32;
    auto next = [&](unsigned* c) -> int {
        __syncthreads();
        if (threadIdx.x == 0) s_item = (int)atomicAdd(c, 1u);
        __syncthreads();
        return __builtin_amdgcn_readfirstlane(s_item);
    };
    int it = next(ctr);
#pragma unroll 1
    while (it < 64) { dn_item(p, l, it, smem); it = next(ctr); }
#pragma unroll 1
    while (it < 128) { lru_item(p, l, it - 64, smem); it = next(ctr); }
    const int myx = blockIdx.x & 7;
#pragma unroll 1
    for (int k = 0; k < 8; ++k) {
        const int x = (myx + k) & 7;
        it = next(actr + x);
#pragma unroll 1
        while (it < 4 * nqt) {
            const int bh = x + 8 * (it / nqt), idx = it % nqt;
            const int qt = idx < 32 ? idx + 2 : idx - 32;
            att_item(p, l, bh >> 2, bh & 3, qt, lam_init, smem);
            it = next(actr + x);
        }
    }
}

#define XB_TMO      128
#define XB_XCNT(j)  (256  + 64 * (j))
#define XB_XSUB(j)  (1280 + 64 * (j))
#define XB_XGEN(j)  (2304 + 64 * (j))
#define XB_TOP      3328
#define XB_TOPGEN   3392
#define XCD_BAR_WORDS 3456
#define XB_SPIN_CAP (1u << 18)
#define LAS __attribute__((address_space(3)))
DEV unsigned xb_ld(unsigned* p)              { return __hip_atomic_load(p, __ATOMIC_RELAXED, __HIP_MEMORY_SCOPE_AGENT); }
DEV unsigned xb_add(unsigned* p, unsigned v) { return __hip_atomic_fetch_add(p, v, __ATOMIC_RELAXED, __HIP_MEMORY_SCOPE_AGENT); }
DEV unsigned xb_xcc_id() { return (unsigned)__builtin_amdgcn_s_getreg((3 << 11) | 20) & 0xFu; }
#define XB_SPIN(cond, bar) do { unsigned _sp = 0; while (cond) { __builtin_amdgcn_s_sleep(1); \
    if ((++_sp & 255u) == 0u) { if (xb_ld(&(bar)[XB_TMO])) break; if (_sp > XB_SPIN_CAP) { atomicAdd(&(bar)[XB_TMO], 1u); break; } } } } while (0)
struct XcdBarrier { unsigned* bar; unsigned x; volatile LAS unsigned* st; };
DEV XcdBarrier xcd_barrier_post(unsigned* bar, volatile LAS unsigned* st) {
    XcdBarrier b; b.bar = bar; b.x = xb_xcc_id(); b.st = st;
    if (threadIdx.x == 0) (void)xb_add(&bar[XB_XCNT(b.x)], 1u);
    return b;
}
DEV void xcd_barrier_complete(unsigned* bar, unsigned x, unsigned& nloc, unsigned& nx) {
    const unsigned G = gridDim.x * gridDim.y * gridDim.z;
    unsigned sum, cnt, mine, sp = 0u;
    for (;;) {
        sum = 0u; cnt = 0u; mine = 0u;
#pragma unroll
        for (unsigned j = 0; j < 16; ++j) { const unsigned c = xb_ld(&bar[XB_XCNT(j)]); sum += c; cnt += (c > 0u) ? 1u : 0u; mine = (j == x) ? c : mine; }
        if (sum == G) break;
        __builtin_amdgcn_s_sleep(1);
        if ((++sp & 255u) == 0u) { if (xb_ld(&bar[XB_TMO])) break; if (sp > XB_SPIN_CAP) { atomicAdd(&bar[XB_TMO], 1u); break; } }
    }
    nloc = mine > 0u ? mine : 1u; nx = cnt > 0u ? cnt : 1u;
}
DEV void xcd_barrier(const XcdBarrier& b) {
    asm volatile("s_waitcnt vmcnt(0)" ::: "memory");
    __syncthreads();
    if (threadIdx.x == 0) {
        unsigned* bar = b.bar;
        __builtin_amdgcn_s_waitcnt(0);
        unsigned nloc = b.st[0], nx = b.st[1];
        if (nloc == 0u) { xcd_barrier_complete(bar, b.x, nloc, nx); b.st[0] = nloc; b.st[1] = nx; }
        const unsigned old = xb_add(&bar[XB_XSUB(b.x)], 1u);
        const unsigned gen = old / nloc;
        if (old + 1u == (gen + 1u) * nloc) {
            __builtin_amdgcn_fence(__ATOMIC_RELEASE, "agent");
            asm volatile("s_waitcnt vmcnt(0)" ::: "memory");
            const unsigned og = xb_add(&bar[XB_TOP], 1u);
            const unsigned tg = og / nx;
            if (og + 1u == (tg + 1u) * nx) xb_add(&bar[XB_TOPGEN], 1u);
            else XB_SPIN(xb_ld(&bar[XB_TOPGEN]) == tg, bar);
            __builtin_amdgcn_fence(__ATOMIC_ACQUIRE, "agent");
            xb_add(&bar[XB_XGEN(b.x)], 1u);
            asm volatile("s_waitcnt vmcnt(0)" ::: "memory");
        } else {
            XB_SPIN(xb_ld(&bar[XB_XGEN(b.x)]) == gen, bar);
            __builtin_amdgcn_fence(__ATOMIC_ACQUIRE, "agent");
            asm volatile("s_waitcnt vmcnt(0)" ::: "memory");
        }
    }
    __syncthreads();
}

constexpr int NPHASE = 1 + 2 * 9 + 1;
DEV void run_phase(const Params& p, int ph, unsigned char* smem) {
    if (ph == 0) { phase_mod(p, smem); phase_rope(p); __syncthreads(); phase_wconv(p, 0, smem); return; }
    if (ph == NPHASE - 1) { phase_final(p); return; }
    const int l = (ph - 1) / 9, q = (ph - 1) % 9;
    const bool first = l == 0, lat = l == 1;
    const bf16_t* W = wsb(p, O_WT);
    switch (q) {
        case 0: if (l == 1) phase_wconv(p, 1, smem); phase_norm(p, l, 0, first, false); break;
        case 1: phase_g1(p, smem); break;
        case 2: phase_mix(p, l, smem); break;
        case 3: phase_fin_norm(p, l, first, lat); break;
        case 4: phase_gate(p, lat, smem); break;
        case 5: phase_resid(p, l, wsb(p, O_U), D, W + W_OUT, 1024, 2, first, lat, smem); break;
        case 6: phase_norm(p, l, 1, false, lat); break;
        case 7: phase_gu(p, lat, smem); break;
        case 8: phase_resid(p, l, wsb(p, O_P), PW, W + W_DN, DFF, 5, false, lat, smem); break;
    }
}

#if MEGA
__global__ void __launch_bounds__(256) mega_kernel(Params p) {
    extern __shared__ __align__(16) unsigned char smem[];
    cg::grid_group grid = cg::this_grid();
    __shared__ uint4 xb_words;
    if (threadIdx.x == 0) xb_words = make_uint4(0u, 0u, 0u, 0u);
    __syncthreads();
    const XcdBarrier xb = xcd_barrier_post((unsigned*)(p.ws + O_BAR), (volatile LAS unsigned*)&xb_words);
    phase_mod(p, smem); phase_rope(p); __syncthreads(); phase_wconv(p, 0, smem);
    xcd_barrier(xb);
    const bf16_t* W = wsb(p, O_WT);
#pragma unroll
    for (int l = 0; l < 2; ++l) {
        const bool first = l == 0, lat = l == 1;
        if (l == 1) phase_wconv(p, 1, smem);
        phase_norm(p, l, 0, first, false);
        xcd_barrier(xb);
        phase_g1(p, smem);
        xcd_barrier(xb);
        phase_mix(p, l, smem);
        if (l == 0) grid.sync(); else xcd_barrier(xb);
        phase_fin_norm(p, l, first, lat);
        xcd_barrier(xb);
        phase_gate(p, lat, smem);
        xcd_barrier(xb);
        phase_merge(p, lat, smem);
        xcd_barrier(xb);
        phase_resid(p, l, wsb(p, O_U), D, W + W_OUT, 1024, 2, first, lat, smem);
        xcd_barrier(xb);
        phase_norm(p, l, 1, false, lat);
        xcd_barrier(xb);
        phase_gu(p, lat, smem);
        xcd_barrier(xb);
        phase_resid(p, l, wsb(p, O_P), PW, W + W_DN, DFF, 5, false, lat, smem);
        xcd_barrier(xb);
    }
    phase_final(p);
}
#else
__global__ void __launch_bounds__(256) phase_kernel(Params p, int ph) {
    extern __shared__ __align__(16) unsigned char smem[];
    run_phase(p, ph, smem);
}
#endif

extern "C" void kernel_launch(void* const* d_in, const int* in_sizes, int n_in, void* d_out, int out_size, void* d_ws, size_t ws_size, hipStream_t stream) {
    static int grid = 0;
    if (grid == 0) {
        if (n_in != 28 || ws_size < WS_END) { fprintf(stderr, "kernel_launch: unexpected n_in %d or ws_size %zu < %zu\n", n_in, ws_size, (size_t)WS_END); grid = -1; return; }
        int dev = 0, cus = 0, per_cu = 0;
        hipGetDevice(&dev);
        hipDeviceGetAttribute(&cus, hipDeviceAttributeMultiprocessorCount, dev);
#if MEGA
        hipFuncSetAttribute((const void*)mega_kernel, hipFuncAttributeMaxDynamicSharedMemorySize, LDS_BYTES);
        hipOccupancyMaxActiveBlocksPerMultiprocessor(&per_cu, (const void*)mega_kernel, 256, LDS_BYTES);
#else
        hipFuncSetAttribute((const void*)phase_kernel, hipFuncAttributeMaxDynamicSharedMemorySize, LDS_BYTES);
        hipOccupancyMaxActiveBlocksPerMultiprocessor(&per_cu, (const void*)phase_kernel, 256, LDS_BYTES);
#endif
        if (per_cu < 1) per_cu = 1;
        grid = cus * per_cu;
        fprintf(stderr, "kernel_launch: grid %d (%d CUs x %d)\n", grid, cus, per_cu);
    }
    if (grid < 0) return;
    hipMemsetAsync((char*)d_ws + O_CTL, 0, 4096 + 16384, stream);
    Params p{};
    for (int i = 0; i < 28; ++i) p.in[i] = (const float*)d_in[i];
    p.out = (float*)d_out; p.ws = (unsigned char*)d_ws;
#if MEGA
    void* args[] = {&p};
    hipError_t e = hipLaunchCooperativeKernel((const void*)mega_kernel, dim3(grid), dim3(256), args, LDS_BYTES, stream);
    if (e != hipSuccess) fprintf(stderr, "cooperative launch failed: %s (grid %d)\n", hipGetErrorString(e), grid);
#else
    for (int ph = 0; ph < NPHASE; ++ph) hipLaunchKernelGGL(phase_kernel, dim3(grid), dim3(256), LDS_BYTES, stream, p, ph);
#endif
}
```

```cpp
#include <hip/hip_runtime.h>
#include <hip/hip_cooperative_groups.h>
#include <cstdio>
#include <cstdint>
namespace cg = cooperative_groups;

#ifndef MEGA
#define MEGA 1
#endif

typedef unsigned short bf16_t;
typedef short bf16x8 __attribute__((ext_vector_type(8)));
typedef float f32x4 __attribute__((ext_vector_type(4)));
typedef unsigned u32x4 __attribute__((ext_vector_type(4)));
typedef unsigned u32x2 __attribute__((ext_vector_type(2)));
#define DEV __device__ __forceinline__

constexpr int D = 1024, NB = 8, SEQ = 4096, CTXL = 256, SB = 4352, MR = NB * SB, PW = 4096, DFF = 2816;
constexpr int C_DNQ = 0, C_DNK = 512, C_DNV = 1024, C_DNZ = 1536, C_LX = 2048, C_LG = 2560, C_DAQ = 3072, C_DAK = 3584;
constexpr int NIN = 4736;
constexpr int GLD = 80;

enum { I_X = 0, I_C, I_CTX, I_CCTX, I_WMOD, I_BMOD, I_NMIX, I_NFFN, I_WIN, I_DNCONV, I_DNALOG, I_DNDT, I_DNNORM, I_LCW, I_LCB,
       I_LWA, I_LBA, I_LWI, I_LBI, I_LLAM, I_DALAM, I_DANORM, I_WBR, I_WOUT, I_WFG, I_WFU, I_WFD, I_NFIN };

constexpr size_t al256(size_t x) { return (x + 255) & ~(size_t)255; }
constexpr size_t O_CTL = 0;
constexpr size_t O_BAR = 4096;
constexpr size_t O_MOD = 4096 + 16384;
constexpr size_t O_ROPE = al256(O_MOD + (size_t)2 * 9 * 6144 * 4);
constexpr size_t O_WT = al256(O_ROPE + 64 * 16 * 2 * 4);
constexpr size_t W_IN = 0, W_GATE = W_IN + (size_t)NIN * 1024, W_BR = W_GATE + (size_t)3072 * 1024, W_OUT = W_BR + (size_t)3 * 1024 * 512,
                 W_GU = W_OUT + (size_t)1024 * 1024, W_DN = W_GU + (size_t)5632 * 1024, W_END = W_DN + (size_t)1024 * 2816;
constexpr size_t O_HCTX = al256(O_WT + W_END * 2);
constexpr size_t O_U = al256(O_HCTX + (size_t)2048 * 1024 * 4);
constexpr size_t O_P = al256(O_U + (size_t)MR * 1024 * 2);
constexpr size_t O_AB = al256(O_P + (size_t)MR * PW * 2);
constexpr size_t O_TA = al256(O_AB + (size_t)MR * 16 * 4);
constexpr size_t O_TA2 = al256(O_TA + (size_t)MR * 512 * 2);
constexpr size_t O_VT = al256(O_TA2 + (size_t)MR * 512 * 2);
constexpr size_t WS_END = al256(O_VT + (size_t)MR * 512 * 2);

constexpr int LDS_BYTES = 140 * 1024;

struct Params {
    const float* in[28];
    float* out;
    unsigned char* ws;
};

DEV int get_tid() { int t = threadIdx.x; asm volatile("" : "+v"(t)); return t; }
DEV float bf2f(bf16_t h) { return __uint_as_float(((unsigned)h) << 16); }
DEV bf16_t f2bf(float f) { unsigned u = __float_as_uint(f); u += 0x7fffu + ((u >> 16) & 1u); return (bf16_t)(u >> 16); }
typedef float f32x2_ __attribute__((ext_vector_type(2)));
typedef __bf16 bf16x2_ __attribute__((ext_vector_type(2)));
DEV unsigned pack2(float a, float b) { const f32x2_ v = {a, b}; return __builtin_bit_cast(unsigned, __builtin_convertvector(v, bf16x2_)); }
DEV float sigm(float x) { return __builtin_amdgcn_rcpf(1.f + __expf(-x)); }
DEV float silu(float x) { return x * __builtin_amdgcn_rcpf(1.f + __expf(-x)); }
DEV float softplus(float x) { return x > 20.f ? x : log1pf(expf(x)); }
DEV float softplus_fast(float x) { const float e = __expf(x); return x > 15.f ? x : (e < 0.01f ? e * (1.f - e * (0.5f - e * 0.33333333f)) : __logf(1.f + e)); }
DEV float gelu_tanh(float x) { float u = 0.7978845608028654f * (x + 0.044715f * x * x * x); float t = 1.f - 2.f * __builtin_amdgcn_rcpf(1.f + __expf(2.f * u)); return 0.5f * x * (1.f + t); }
DEV f32x4 mfma16(bf16x8 a, bf16x8 b, f32x4 c) { return __builtin_amdgcn_mfma_f32_16x16x32_bf16(a, b, c, 0, 0, 0); }
DEV void mfma16a(f32x4& c, bf16x8 a, bf16x8 b) { asm volatile("v_mfma_f32_16x16x32_bf16 %0, %1, %2, %0" : "+a"(c) : "v"(a), "v"(b)); }
DEV float lo16(unsigned v) { return __uint_as_float(v << 16); }
DEV float hi16(unsigned v) { return __uint_as_float(v & 0xffff0000u); }

DEV bf16_t* wsb(const Params& p, size_t off) { return (bf16_t*)(p.ws + off); }
DEV float* wsf(const Params& p, size_t off) { return (float*)(p.ws + off); }
DEV float* hrow(const Params& p, int r) { int b = r / SB, s = r - b * SB; return s < CTXL ? wsf(p, O_HCTX) + (size_t)(b * CTXL + s) * D : p.out + (size_t)(b * SEQ + s - CTXL) * D; }
DEV const float* xrow(const Params& p, int r) { int b = r / SB, s = r - b * SB; return s < CTXL ? p.in[I_CTX] + (size_t)(b * CTXL + s) * D : p.in[I_X] + (size_t)(b * SEQ + s - CTXL) * D; }
DEV int modrow(int r) { int b = r / SB, s = r - b * SB; return s < CTXL ? 8 : b; }

template <int MT, int NT>
DEV void gemm_core(const bf16_t* __restrict__ A, int lda, const bf16_t* __restrict__ Bt, int ldb, int K, f32x4 (&acc)[MT][NT], bf16_t* smem_) {
    constexpr int SA = 32 * MT * GLD, SBB = 32 * NT * GLD;
    bf16_t* sA = smem_; bf16_t* sB = smem_ + 2 * SA;
    const int tid = get_tid(), lane = tid & 63, wv = tid >> 6, wr = wv >> 1, wc = wv & 1, l15 = lane & 15, quad = lane >> 4;
    const int lr = tid >> 3, lc = (tid & 7) * 8;
    u32x4 ra0[MT], rb0[NT], ra1[MT], rb1[NT];
    const bf16_t* Ap = A + (size_t)lr * lda + lc;
    const bf16_t* Bp = Bt + (size_t)lr * ldb + lc;
    const int nk = K >> 6;
#define GLOAD(RA, RB, KT) { const int ko_ = (KT) * 64; _Pragma("unroll") for (int i = 0; i < MT; ++i) RA[i] = *(const u32x4*)(Ap + (size_t)(32 * i) * lda + ko_); \
                            _Pragma("unroll") for (int i = 0; i < NT; ++i) RB[i] = *(const u32x4*)(Bp + (size_t)(32 * i) * ldb + ko_); }
#define LSTORE(RA, RB, BUF) { _Pragma("unroll") for (int i = 0; i < MT; ++i) *(u32x4*)(sA + (BUF) * SA + (lr + 32 * i) * GLD + lc) = RA[i]; \
                              _Pragma("unroll") for (int i = 0; i < NT; ++i) *(u32x4*)(sB + (BUF) * SBB + (lr + 32 * i) * GLD + lc) = RB[i]; }
#define AFRAG(BUF, MT_, KS) (*(const bf16x8*)(sA + (BUF) * SA + (wr * MT * 16 + (MT_) * 16 + l15) * GLD + (KS) * 32 + quad * 8))
#define HALF(BUFC, RA, RB, BUFS, DO_STORE, DO_LOAD, KT) { \
        bf16x8 bfr[2][NT]; \
        _Pragma("unroll") for (int ks = 0; ks < 2; ++ks) _Pragma("unroll") for (int nt = 0; nt < NT; ++nt) \
            bfr[ks][nt] = *(const bf16x8*)(sB + (BUFC) * SBB + (wc * NT * 16 + nt * 16 + l15) * GLD + ks * 32 + quad * 8); \
        bf16x8 a0 = AFRAG(BUFC, 0, 0), a1 = AFRAG(BUFC, 0, 1); \
        const int ko_ = (KT) * 64; \
        _Pragma("unroll") for (int mt = 0; mt < MT; ++mt) { \
            bf16x8 n0 = a0, n1 = a1; \
            if (DO_STORE) { *(u32x4*)(sA + (BUFS) * SA + (lr + 32 * mt) * GLD + lc) = RA[mt]; } \
            if (DO_LOAD) { RA[mt] = *(const u32x4*)(Ap + (size_t)(32 * mt) * lda + ko_); } \
            _Pragma("unroll") for (int nt = 0; nt < NT; ++nt) mfma16a(acc[mt][nt], bfr[0][nt], a0); \
            if (mt + 1 < MT) { n0 = AFRAG(BUFC, mt + 1, 0); n1 = AFRAG(BUFC, mt + 1, 1); } \
            if (DO_STORE) { if (mt < NT) *(u32x4*)(sB + (BUFS) * SBB + (lr + 32 * mt) * GLD + lc) = RB[mt]; } \
            if (DO_LOAD) { if (mt < NT) RB[mt] = *(const u32x4*)(Bp + (size_t)(32 * mt) * ldb + ko_); } \
            _Pragma("unroll") for (int nt = 0; nt < NT; ++nt) mfma16a(acc[mt][nt], bfr[1][nt], a1); \
            a0 = n0; a1 = n1; \
        } }
    static_assert(NT <= MT, "HALF stages the B pieces alongside the first NT A pieces");
    GLOAD(ra0, rb0, 0);
    GLOAD(ra1, rb1, 1);
    __syncthreads();
    LSTORE(ra0, rb0, 0);
    GLOAD(ra0, rb0, 2);
    __syncthreads();
    int kt = 0;
#pragma unroll 1
    for (; kt + 4 < nk; kt += 2) {
        HALF(0, ra1, rb1, 1, true, true, kt + 3);
        __syncthreads();
        HALF(1, ra0, rb0, 0, true, true, kt + 4);
        __syncthreads();
    }
    HALF(0, ra1, rb1, 1, true, true, kt + 3);
    __syncthreads();
    HALF(1, ra0, rb0, 0, true, false, 0);
    __syncthreads();
    HALF(0, ra1, rb1, 1, true, false, 0);
    __syncthreads();
    HALF(1, ra0, rb0, 0, false, false, 0);
    __syncthreads();
#undef AFRAG
#undef HALF
#undef GLOAD
#undef LSTORE
    static_assert(NT == 4, "the accumulator fence is written for NT == 4");
#pragma unroll
    for (int mt = 0; mt < MT; ++mt) {
        if (mt == 0) asm volatile("s_nop 15\n\ts_nop 15" : "+a"(acc[mt][0]), "+a"(acc[mt][1]), "+a"(acc[mt][2]), "+a"(acc[mt][3]));
        else asm volatile("s_nop 0" : "+a"(acc[mt][0]), "+a"(acc[mt][1]), "+a"(acc[mt][2]), "+a"(acc[mt][3]));
    }
}
template <int MT, int NT>
DEV void gemm_core1(const bf16_t* __restrict__ A, int lda, const bf16_t* __restrict__ Bt, int ldb, int K, f32x4 (&acc)[MT][NT], bf16_t* sA, bf16_t* sB) {
    const int tid = get_tid(), lane = tid & 63, wv = tid >> 6, wr = wv >> 1, wc = wv & 1, l15 = lane & 15, quad = lane >> 4;
    const int lr = tid >> 3, lc = (tid & 7) * 8;
    u32x4 ra[MT], rb[NT];
    const bf16_t* Ap = A + (size_t)lr * lda + lc;
    const bf16_t* Bp = Bt + (size_t)lr * ldb + lc;
#pragma unroll
    for (int i = 0; i < MT; ++i) ra[i] = *(const u32x4*)(Ap + (size_t)(32 * i) * lda);
#pragma unroll
    for (int i = 0; i < NT; ++i) rb[i] = *(const u32x4*)(Bp + (size_t)(32 * i) * ldb);
    const int nk = K >> 6;
    for (int kt = 0; kt < nk; ++kt) {
        __syncthreads();
#pragma unroll
        for (int i = 0; i < MT; ++i) *(u32x4*)(sA + (lr + 32 * i) * GLD + lc) = ra[i];
#pragma unroll
        for (int i = 0; i < NT; ++i) *(u32x4*)(sB + (lr + 32 * i) * GLD + lc) = rb[i];
        __syncthreads();
        if (kt + 1 < nk) {
            const int ko = (kt + 1) * 64;
#pragma unroll
            for (int i = 0; i < MT; ++i) ra[i] = *(const u32x4*)(Ap + (size_t)(32 * i) * lda + ko);
#pragma unroll
            for (int i = 0; i < NT; ++i) rb[i] = *(const u32x4*)(Bp + (size_t)(32 * i) * ldb + ko);
        }
#pragma unroll
        for (int ks = 0; ks < 2; ++ks) {
            bf16x8 af[MT], bfr[NT];
#pragma unroll
            for (int mt = 0; mt < MT; ++mt) af[mt] = *(const bf16x8*)(sA + (wr * MT * 16 + mt * 16 + l15) * GLD + ks * 32 + quad * 8);
#pragma unroll
            for (int nt = 0; nt < NT; ++nt) bfr[nt] = *(const bf16x8*)(sB + (wc * NT * 16 + nt * 16 + l15) * GLD + ks * 32 + quad * 8);
#pragma unroll
            for (int mt = 0; mt < MT; ++mt)
#pragma unroll
                for (int nt = 0; nt < NT; ++nt) mfma16a(acc[mt][nt], bfr[nt], af[mt]);
        }
    }
    static_assert(NT == 4, "the accumulator fence is written for NT == 4");
#pragma unroll
    for (int mt = 0; mt < MT; ++mt) {
        if (mt == 0) asm volatile("s_nop 15\n\ts_nop 15" : "+a"(acc[mt][0]), "+a"(acc[mt][1]), "+a"(acc[mt][2]), "+a"(acc[mt][3]));
        else asm volatile("s_nop 0" : "+a"(acc[mt][0]), "+a"(acc[mt][1]), "+a"(acc[mt][2]), "+a"(acc[mt][3]));
    }
}
template <int MT, int NT>
DEV void zero_acc(f32x4 (&acc)[MT][NT]) {
#pragma unroll
    for (int mt = 0; mt < MT; ++mt)
#pragma unroll
        for (int nt = 0; nt < NT; ++nt) acc[mt][nt] = (f32x4){0.f, 0.f, 0.f, 0.f};
}

DEV void phase_mod(const Params& p, unsigned char* smem) {
    float* s_s = (float*)smem;
    float* red = s_s + 9 * 1024;
    const int tid = get_tid();
    bool loaded = false;
    for (int it = blockIdx.x; it < 2 * 96; it += gridDim.x) {
        if (!loaded) {
            for (int e = tid; e < 9 * 1024; e += 256) { float v = e < 8192 ? p.in[I_C][e] : p.in[I_CCTX][e - 8192]; s_s[e] = silu(v); }
            loaded = true;
        }
        __syncthreads();
        const int l = it / 96, cg_ = it % 96, cq = tid & 63, kq = tid >> 6, col = cg_ * 64 + cq;
        float acc[9];
#pragma unroll
        for (int r = 0; r < 9; ++r) acc[r] = 0.f;
        const float* wp = p.in[I_WMOD] + ((size_t)l * 1024 + kq * 256) * 6144 + col;
#pragma unroll 8
        for (int k = 0; k < 256; ++k) {
            float wv = wp[(size_t)k * 6144];
#pragma unroll
            for (int r = 0; r < 9; ++r) acc[r] += s_s[r * 1024 + kq * 256 + k] * wv;
        }
#pragma unroll
        for (int r = 0; r < 9; ++r) red[(kq * 9 + r) * 64 + cq] = acc[r];
        __syncthreads();
        for (int e = tid; e < 9 * 64; e += 256) {
            int r = e >> 6, c2 = e & 63;
            float v = red[(0 * 9 + r) * 64 + c2] + red[(1 * 9 + r) * 64 + c2] + red[(2 * 9 + r) * 64 + c2] + red[(3 * 9 + r) * 64 + c2];
            wsf(p, O_MOD)[((size_t)l * 9 + r) * 6144 + cg_ * 64 + c2] = v + p.in[I_BMOD][l * 6144 + cg_ * 64 + c2];
        }
        __syncthreads();
    }
}
DEV void phase_rope(const Params& p) {
    if (blockIdx.x == (gridDim.x - 1)) {
        for (int e = threadIdx.x; e < 1024; e += 256) {
            int pos = e >> 4, i = e & 15;
            float inv = powf(10000.f, -(float)i / 16.f);
            float ang = (float)pos * inv;
            float n = rintf(ang * 0.15915494309189535f);
            float r = fmaf(-n, 6.28125f, ang);
            r = fmaf(-n, 1.9353071795864769e-3f, r);
            wsf(p, O_ROPE)[e * 2] = cosf(r);
            wsf(p, O_ROPE)[e * 2 + 1] = sinf(r);
        }
    }
}
DEV void wconv_tile(const float* src0, const float* src1, int lds_, int K, bf16_t* dst, int kind, int kt, int nt, bf16_t* tile) {
    const int tid = get_tid();
    const int kk = tid >> 2, grp = tid & 3;
    const int n0 = nt * 64, k0 = kt * 64;
    const int ng = n0 + grp * 16;
    const float* src = src0; int sc;
    if (kind == 0) { sc = ng < 2048 ? ng : (ng < 4608 ? ng + 16 : (ng < 4624 ? 2048 : -1)); }
    else if (kind == 1) { sc = 4624 + ng; }
    else if (kind == 2) { sc = ng; }
    else { int gd = ng >> 4; src = (gd & 1) ? src1 : src0; sc = (gd >> 1) * 16; }
    __syncthreads();
    if (sc >= 0) {
        const float4* sp = (const float4*)(src + (size_t)(k0 + kk) * lds_ + sc);
#pragma unroll
        for (int q = 0; q < 4; ++q) { float4 v = sp[q]; int e = grp * 16 + q * 4;
            tile[(e + 0) * GLD + kk] = f2bf(v.x); tile[(e + 1) * GLD + kk] = f2bf(v.y); tile[(e + 2) * GLD + kk] = f2bf(v.z); tile[(e + 3) * GLD + kk] = f2bf(v.w); }
    } else {
#pragma unroll
        for (int e = 0; e < 16; ++e) tile[(grp * 16 + e) * GLD + kk] = 0;
    }
    __syncthreads();
    const int n = tid >> 2, kseg = (tid & 3) * 16;
    u32x4 a = *(const u32x4*)(tile + n * GLD + kseg), b = *(const u32x4*)(tile + n * GLD + kseg + 8);
    bf16_t* dp = dst + (size_t)(n0 + n) * K + k0 + kseg;
    *(u32x4*)dp = a; *(u32x4*)(dp + 8) = b;
}
DEV void phase_wconv(const Params& p, int l, unsigned char* smem) {
    bf16_t* tile = (bf16_t*)smem;
    bf16_t* W = wsb(p, O_WT);
    constexpr int T0 = 74 * 16, T1 = T0 + 48 * 16, T2 = T1 + 3 * 16 * 8, T3 = T2 + 16 * 16, T4 = T3 + 88 * 16, T5 = T4 + 16 * 44;
    for (int t = blockIdx.x; t < T5; t += gridDim.x) {
        if (t < T0) { wconv_tile(p.in[I_WIN] + (size_t)l * 1024 * 7696, nullptr, 7696, 1024, W + W_IN, 0, t % 16, t / 16, tile); }
        else if (t < T1) { int u = t - T0; wconv_tile(p.in[I_WIN] + (size_t)l * 1024 * 7696, nullptr, 7696, 1024, W + W_GATE, 1, u % 16, u / 16, tile); }
        else if (t < T2) { int u = t - T1; int n = u / 128, v = u % 128; wconv_tile(p.in[I_WBR] + ((size_t)l * 3 + n) * 512 * 1024, nullptr, 1024, 512, W + W_BR + (size_t)n * 1024 * 512, 2, v % 8, v / 8, tile); }
        else if (t < T3) { int u = t - T2; wconv_tile(p.in[I_WOUT] + (size_t)l * 1024 * 1024, nullptr, 1024, 1024, W + W_OUT, 2, u % 16, u / 16, tile); }
        else if (t < T4) { int u = t - T3; wconv_tile(p.in[I_WFG] + (size_t)l * 1024 * DFF, p.in[I_WFU] + (size_t)l * 1024 * DFF, DFF, 1024, W + W_GU, 3, u % 16, u / 16, tile); }
        else { int u = t - T4; wconv_tile(p.in[I_WFD] + (size_t)l * DFF * 1024, nullptr, 1024, DFF, W + W_DN, 2, u % 44, u / 44, tile); }
    }
}

DEV void norm_row(const Params& p, int l, int which, bool first, int r, int lane) {
    const float* h = first ? xrow(p, r) : hrow(p, r);
    const float* nw = p.in[which ? I_NFFN : I_NMIX] + l * D;
    const float* md = wsf(p, O_MOD) + ((size_t)l * 9 + modrow(r)) * 6144 + (which ? 3 * D : 0);
    float4 v[4]; float ss = 0.f;
#pragma unroll
    for (int i = 0; i < 4; ++i) { v[i] = *(const float4*)(h + i * 256 + lane * 4); ss += v[i].x * v[i].x + v[i].y * v[i].y + v[i].z * v[i].z + v[i].w * v[i].w; }
#pragma unroll
    for (int o = 32; o >= 1; o >>= 1) ss += __shfl_xor(ss, o);
    const float rstd = rsqrtf(ss * (1.f / D) + 1e-6f);
    bf16_t* up = wsb(p, O_U) + (size_t)r * D;
#pragma unroll
    for (int i = 0; i < 4; ++i) {
        const int c = i * 256 + lane * 4;
        float4 w4 = *(const float4*)(nw + c), sh = *(const float4*)(md + c), sc = *(const float4*)(md + D + c);
        float a = v[i].x * rstd * w4.x * (1.f + sc.x) + sh.x, b = v[i].y * rstd * w4.y * (1.f + sc.y) + sh.y;
        float c2 = v[i].z * rstd * w4.z * (1.f + sc.z) + sh.z, d = v[i].w * rstd * w4.w * (1.f + sc.w) + sh.w;
        u32x2 o; o.x = pack2(a, b); o.y = pack2(c2, d);
        *(u32x2*)(up + c) = o;
    }
}
DEV void phase_norm(const Params& p, int l, int which, bool first, bool skip_ctx) {
    const int tid_ = get_tid(); const int lane = tid_ & 63, wv = tid_ >> 6;
    for (int r = blockIdx.x * 4 + wv; r < MR; r += gridDim.x * 4) {
        if (skip_ctx && (r % SB) < CTXL) continue;
        norm_row(p, l, which, first, r, lane);
    }
}
DEV void phase_fin_norm(const Params& p, int l, bool first, bool skip_ctx) {
    const int tid_ = get_tid(); const int lane = tid_ & 63, wv = tid_ >> 6;
    const float* dnn = p.in[I_DNNORM] + l * 128;
    for (int r = blockIdx.x * 4 + wv; r < MR; r += gridDim.x * 4) {
        if (skip_ctx && (r % SB) < CTXL) continue;
        norm_row(p, l, 0, first, r, lane);
        bf16_t* ta = wsb(p, O_TA) + (size_t)r * 512 + lane * 8;
        const bf16_t* tb = wsb(p, O_TA2) + (size_t)r * 512 + lane * 8;
        const bf16_t* zz = wsb(p, O_P) + (size_t)r * PW + C_DNZ + lane * 8;
        u32x4 a = *(const u32x4*)ta, b = *(const u32x4*)tb, z = *(const u32x4*)zz;
        float o[8]; float ss = 0.f;
#pragma unroll
        for (int i = 0; i < 4; ++i) { o[2 * i] = lo16(a[i]) + lo16(b[i]); o[2 * i + 1] = hi16(a[i]) + hi16(b[i]); ss += o[2 * i] * o[2 * i] + o[2 * i + 1] * o[2 * i + 1]; }
#pragma unroll
        for (int of = 8; of >= 1; of >>= 1) ss += __shfl_xor(ss, of);
        const float rstd = rsqrtf(ss * (1.f / 128.f) + 1e-6f);
        const int dv0 = (lane & 15) * 8;
        u32x4 y;
#pragma unroll
        for (int i = 0; i < 4; ++i) {
            float y0 = o[2 * i] * rstd * dnn[dv0 + 2 * i] * silu(lo16(z[i]));
            float y1 = o[2 * i + 1] * rstd * dnn[dv0 + 2 * i + 1] * silu(hi16(z[i]));
            y[i] = pack2(y0, y1);
        }
        *(u32x4*)ta = y;
    }
}
DEV void phase_final(const Params& p) {
    const int tid_ = get_tid(); const int lane = tid_ & 63, wv = tid_ >> 6;
    const float* nw = p.in[I_NFIN];
    for (int r = blockIdx.x * 4 + wv; r < NB * SEQ; r += gridDim.x * 4) {
        float* h = p.out + (size_t)r * D;
        float4 v[4]; float ss = 0.f;
#pragma unroll
        for (int i = 0; i < 4; ++i) { v[i] = *(const float4*)(h + i * 256 + lane * 4); ss += v[i].x * v[i].x + v[i].y * v[i].y + v[i].z * v[i].z + v[i].w * v[i].w; }
#pragma unroll
        for (int o = 32; o >= 1; o >>= 1) ss += __shfl_xor(ss, o);
        const float rstd = rsqrtf(ss * (1.f / D) + 1e-6f);
#pragma unroll
        for (int i = 0; i < 4; ++i) {
            const int c = i * 256 + lane * 4;
            float4 w4 = *(const float4*)(nw + c);
            float4 o4; o4.x = v[i].x * rstd * w4.x; o4.y = v[i].y * rstd * w4.y; o4.z = v[i].z * rstd * w4.z; o4.w = v[i].w * rstd * w4.w;
            *(float4*)(h + c) = o4;
        }
    }
}

struct TileIter {
    int nn, total, nloc, L;
    DEV TileIter(int nm, int nn_) { nn = nn_; total = nm * nn_; nloc = gridDim.x >> 3; L = (blockIdx.x & 7) * nloc + (blockIdx.x >> 3); }
    DEV bool valid() const { return L < total; }
    DEV bool more() const { return (L - (int)(blockIdx.x >> 3)) < total; }
    DEV void next() { L += 8 * nloc; }
    DEV void get(int& tm, int& tn) const { const int pn = 4 * nn, panel = L / pn, rem = L - panel * pn; tn = rem >> 2; tm = panel * 4 + (rem & 3); }
};
DEV void phase_g1(const Params& p, unsigned char* smem) {
    bf16_t* sA = (bf16_t*)smem;
    const int tid = get_tid(), lane = tid & 63, wv = tid >> 6, wr = wv >> 1, wc = wv & 1, l15 = lane & 15, quad = lane >> 4;
    const bf16_t* U = wsb(p, O_U); const bf16_t* W = wsb(p, O_WT) + W_IN;
    bf16_t* P = wsb(p, O_P);
    const float* rope = wsf(p, O_ROPE);
    constexpr int NTN = NIN / 128;
    const int wr0_ = wr, wc0_ = wc, l150_ = l15, quad0_ = quad;
    for (TileIter ti(MR / 256, NTN); ti.valid(); ti.next()) {
        int tm, tn; ti.get(tm, tn);
        const int row0 = tm * 256, col0 = tn * 128;
        f32x4 acc[8][4]; zero_acc(acc);
        gemm_core<8, 4>(U + (size_t)row0 * D, D, W + (size_t)col0 * D, D, D, acc, sA);
        int tz = 0; asm volatile("" : "+v"(tz));
        const int wr = wr0_ + tz, wc = wc0_ + tz, l15 = l150_ + tz, quad = quad0_ + tz;
        if (tn < 24) {
#pragma unroll
            for (int mt = 0; mt < 8; ++mt) {
                __builtin_amdgcn_sched_barrier(0);
                bf16_t* pp = P + (size_t)(row0 + wr * 128 + mt * 16 + l15) * PW + col0 + wc * 64 + quad * 4;
#pragma unroll
                for (int nt = 0; nt < 4; ++nt) { u32x2 o; o.x = pack2(acc[mt][nt][0], acc[mt][nt][1]); o.y = pack2(acc[mt][nt][2], acc[mt][nt][3]); *(u32x2*)(pp + nt * 16) = o; }
            }
        } else if (tn < 32) {
            const float qs = tn < 28 ? 0.125f : 1.f;
#pragma unroll
            for (int mt = 0; mt < 8; ++mt) {
                __builtin_amdgcn_sched_barrier(0);
                const int row = row0 + wr * 128 + mt * 16 + l15;
                const int s_ = row % SB;
                f32x4 ca = {1.f, 1.f, 1.f, 1.f}, sa = {0.f, 0.f, 0.f, 0.f}, cb = {1.f, 1.f, 1.f, 1.f}, sb = {0.f, 0.f, 0.f, 0.f};
                if (s_ >= CTXL) { const int tt = s_ - CTXL, pr = tt >> 6, pc = tt & 63;
                    const f32x4 r0 = *(const f32x4*)(rope + (pr * 16 + quad * 4) * 2), r1 = *(const f32x4*)(rope + (pr * 16 + quad * 4) * 2 + 4);
                    const f32x4 r2 = *(const f32x4*)(rope + (pc * 16 + quad * 4) * 2), r3 = *(const f32x4*)(rope + (pc * 16 + quad * 4) * 2 + 4);
                    ca = (f32x4){r0[0], r0[2], r1[0], r1[2]}; sa = (f32x4){r0[1], r0[3], r1[1], r1[3]};
                    cb = (f32x4){r2[0], r2[2], r3[0], r3[2]}; sb = (f32x4){r2[1], r2[3], r3[1], r3[3]}; }
                const f32x4 x1 = acc[mt][0], x2 = acc[mt][1], y1 = acc[mt][2], y2 = acc[mt][3];
                const f32x4 o0 = (x1 * ca - x2 * sa) * qs, o1 = (x2 * ca + x1 * sa) * qs, o2 = (y1 * cb - y2 * sb) * qs, o3 = (y2 * cb + y1 * sb) * qs;
                bf16_t* pp = P + (size_t)row * PW + col0 + wc * 64 + quad * 4;
                u32x2 o; o.x = pack2(o0[0], o0[1]); o.y = pack2(o0[2], o0[3]); *(u32x2*)(pp) = o;
                o.x = pack2(o1[0], o1[1]); o.y = pack2(o1[2], o1[3]); *(u32x2*)(pp + 16) = o;
                o.x = pack2(o2[0], o2[1]); o.y = pack2(o2[2], o2[3]); *(u32x2*)(pp + 32) = o;
                o.x = pack2(o3[0], o3[1]); o.y = pack2(o3[2], o3[3]); *(u32x2*)(pp + 48) = o;
            }
        } else if (tn < 36) {
            bf16_t* VT = wsb(p, O_VT);
            const int b = row0 / SB, sbase = row0 - b * SB;
#pragma unroll
            for (int mt = 0; mt < 8; ++mt) {
                __builtin_amdgcn_sched_barrier(0);
                const int s_ = sbase + wr * 128 + mt * 16 + l15;
                const int vi0 = (b * 512 + col0 - 4096 + wc * 64 + quad * 4) * SB + s_;
#pragma unroll
                for (int nt = 0; nt < 4; ++nt) {
                    const unsigned p01 = pack2(acc[mt][nt][0], acc[mt][nt][1]), p23 = pack2(acc[mt][nt][2], acc[mt][nt][3]);
                    VT[vi0 + (nt * 16 + 0) * SB] = (bf16_t)(p01 & 0xffffu); VT[vi0 + (nt * 16 + 1) * SB] = (bf16_t)(p01 >> 16);
                    VT[vi0 + (nt * 16 + 2) * SB] = (bf16_t)(p23 & 0xffffu); VT[vi0 + (nt * 16 + 3) * SB] = (bf16_t)(p23 >> 16);
                }
            }
        } else {
            if (wc == 0) {
                float* AB = wsf(p, O_AB);
#pragma unroll
                for (int mt = 0; mt < 8; ++mt) {
                    const int row = row0 + wr * 128 + mt * 16 + l15;
                    *(f32x4*)(AB + (size_t)row * 16 + quad * 4) = acc[mt][0];
                }
            }
        }
    }
}

DEV int rowtile0(int ti, bool latent_only) { if (!latent_only) return ti * 256; int b = ti >> 4, tt = ti & 15; return b * SB + CTXL + tt * 256; }
DEV int sgcol(int n, int c) { return n < 2 ? n * 1024 + c : (c < 512 ? 2048 + c : 3584 + (c - 512)); }

DEV void phase_gate(const Params& p, bool latent_only, unsigned char* smem) {
    bf16_t* sA = (bf16_t*)smem;
    const int tid = get_tid(), lane = tid & 63, wv = tid >> 6, wr = wv >> 1, wc = wv & 1, l15 = lane & 15, quad = lane >> 4;
    const bf16_t* U = wsb(p, O_U); const bf16_t* W = wsb(p, O_WT) + W_GATE;
    bf16_t* P = wsb(p, O_P);
    const int nrt = latent_only ? 128 : 136;
    for (TileIter ti(nrt, 24); ti.valid(); ti.next()) {
        int tm, tn; ti.get(tm, tn);
        const int row0 = rowtile0(tm, latent_only);
        f32x4 acc[8][4]; zero_acc(acc);
        gemm_core<8, 4>(U + (size_t)row0 * D, D, W + (size_t)tn * 128 * D, D, D, acc, sA);
        const int dcol0 = sgcol(tn >> 3, (tn & 7) * 128);
        bf16_t* ip = P + (size_t)(row0 + tid) * PW + dcol0;
#pragma unroll
        for (int mt = 0; mt < 8; ++mt) {
            __builtin_amdgcn_sched_barrier(0);
#pragma unroll
            for (int hf = 0; hf < 2; ++hf) {
                u32x4 o;
                o[0] = pack2(sigm(acc[mt][2 * hf][0]), sigm(acc[mt][2 * hf][1])); o[1] = pack2(sigm(acc[mt][2 * hf][2]), sigm(acc[mt][2 * hf][3]));
                o[2] = pack2(sigm(acc[mt][2 * hf + 1][0]), sigm(acc[mt][2 * hf + 1][1])); o[3] = pack2(sigm(acc[mt][2 * hf + 1][2]), sigm(acc[mt][2 * hf + 1][3]));
                *(u32x4*)(ip + (mt * 2 + hf) * 8) = o;
            }
        }
    }
}

DEV void phase_merge(const Params& p, bool latent_only, unsigned char* smem) {
    bf16_t* sA = (bf16_t*)smem;
    const int tid = get_tid(), lane = tid & 63, wv = tid >> 6, wr = wv >> 1, wc = wv & 1, l15 = lane & 15, quad = lane >> 4;
    const bf16_t* W = wsb(p, O_WT);
    const bf16_t* P = wsb(p, O_P);
    bf16_t* U = wsb(p, O_U);
    const int nrt = latent_only ? 128 : 136;
    for (TileIter ti(nrt, 8); ti.valid(); ti.next()) {
        int tm, tn; ti.get(tm, tn);
        const int row0 = rowtile0(tm, latent_only), col0 = tn * 128;
        f32x4 m[8][4]; zero_acc(m);
#pragma unroll 1
        for (int n = 0; n < 3; ++n) {
            f32x4 au[8][4]; zero_acc(au);
            const bf16_t* Y; int ldy;
            if (n == 0) { Y = wsb(p, O_TA) + (size_t)row0 * 512; ldy = 512; }
            else if (n == 1) { Y = P + (size_t)row0 * PW + C_LG; ldy = PW; }
            else { Y = P + (size_t)row0 * PW + C_DAQ; ldy = PW; }
            const int sc0 = sgcol(n, col0);
            gemm_core<8, 4>(Y, ldy, W + W_BR + ((size_t)n * 1024 + col0) * 512, 512, 512, au, sA);
            u32x4 sg[16];
            const bf16_t* ip = P + (size_t)(row0 + tid) * PW + sc0;
#pragma unroll
            for (int q = 0; q < 16; ++q) sg[q] = *(const u32x4*)(ip + q * 8);
#pragma unroll
            for (int mt = 0; mt < 8; ++mt)
#pragma unroll
                for (int nt = 0; nt < 4; ++nt) {
                    const unsigned g01 = sg[mt * 2 + (nt >> 1)][(nt & 1) * 2], g23 = sg[mt * 2 + (nt >> 1)][(nt & 1) * 2 + 1];
                    m[mt][nt][0] += lo16(g01) * au[mt][nt][0]; m[mt][nt][1] += hi16(g01) * au[mt][nt][1];
                    m[mt][nt][2] += lo16(g23) * au[mt][nt][2]; m[mt][nt][3] += hi16(g23) * au[mt][nt][3];
                }
        }
#pragma unroll
        for (int mt = 0; mt < 8; ++mt) {
            __builtin_amdgcn_sched_barrier(0);
            bf16_t* up = U + (size_t)(row0 + wr * 128 + mt * 16 + l15) * D + col0 + wc * 64 + quad * 4;
#pragma unroll
            for (int nt = 0; nt < 4; ++nt) { u32x2 o; o.x = pack2(m[mt][nt][0], m[mt][nt][1]); o.y = pack2(m[mt][nt][2], m[mt][nt][3]); *(u32x2*)(up + nt * 16) = o; }
        }
    }
}

DEV void phase_resid(const Params& p, int l, const bf16_t* A, int lda, const bf16_t* Wt, int K, int chunk, bool first, bool latent_only, unsigned char* smem) {
    bf16_t* sA = (bf16_t*)smem;
    const int tid = get_tid(), lane = tid & 63, wv = tid >> 6, wr = wv >> 1, wc = wv & 1, l15 = lane & 15, quad = lane >> 4;
    const int nrt = latent_only ? 128 : 136;
    for (TileIter ti(nrt, 8); ti.valid(); ti.next()) {
        int tm, tn; ti.get(tm, tn);
        const int row0 = rowtile0(tm, latent_only), col0 = tn * 128;
        f32x4 acc[8][4]; zero_acc(acc);
        gemm_core<8, 4>(A + (size_t)row0 * lda, lda, Wt + (size_t)col0 * K, K, K, acc, sA);
        const float* md = wsf(p, O_MOD) + ((size_t)l * 9 + modrow(row0)) * 6144 + chunk * D + col0 + wc * 64 + quad * 4;
        const float* hs0 = first ? xrow(p, row0) : hrow(p, row0);
        float* hd0 = hrow(p, row0);
        f32x4 mg[4];
#pragma unroll
        for (int nt = 0; nt < 4; ++nt) mg[nt] = *(const f32x4*)(md + nt * 16);
#pragma unroll
        for (int mt = 0; mt < 8; ++mt) {
            __builtin_amdgcn_sched_barrier(0);
            const size_t ro = (size_t)(wr * 128 + mt * 16 + l15) * D + col0 + wc * 64 + quad * 4;
#pragma unroll
            for (int nt = 0; nt < 4; ++nt) { const f32x4 h = *(const f32x4*)(hs0 + ro + nt * 16); *(f32x4*)(hd0 + ro + nt * 16) = h + mg[nt] * acc[mt][nt]; }
        }
    }
}
DEV void phase_gu(const Params& p, bool latent_only, unsigned char* smem) {
    bf16_t* sA = (bf16_t*)smem;
    const int tid = get_tid(), lane = tid & 63, wv = tid >> 6, wr = wv >> 1, wc = wv & 1, l15 = lane & 15, quad = lane >> 4;
    const bf16_t* U = wsb(p, O_U); const bf16_t* W = wsb(p, O_WT) + W_GU;
    bf16_t* P = wsb(p, O_P);
    const int nrt = latent_only ? 128 : 136;
    for (TileIter ti(nrt, 44); ti.valid(); ti.next()) {
        int tm, tn; ti.get(tm, tn);
        const int row0 = rowtile0(tm, latent_only);
        f32x4 acc[8][4]; zero_acc(acc);
        gemm_core<8, 4>(U + (size_t)row0 * D, D, W + (size_t)tn * 128 * D, D, D, acc, sA);
#pragma unroll
        for (int mt = 0; mt < 8; ++mt) {
            __builtin_amdgcn_sched_barrier(0);
            bf16_t* pp = P + (size_t)(row0 + wr * 128 + mt * 16 + l15) * PW + (tn * 4 + wc * 2) * 16 + quad * 4;
#pragma unroll
            for (int pr = 0; pr < 2; ++pr) {
                const f32x4 g = acc[mt][2 * pr], u = acc[mt][2 * pr + 1];
                u32x2 o; o.x = pack2(silu(g[0]) * u[0], silu(g[1]) * u[1]); o.y = pack2(silu(g[2]) * u[2], silu(g[3]) * u[3]);
                *(u32x2*)(pp + pr * 16) = o;
            }
        }
    }
}

DEV int chunk_of(int dir, int n) { return dir ? (n < 4 ? 3 - n : 71 - n) : n; }

typedef float f32x2 __attribute__((ext_vector_type(2)));
DEV void dn_solve(const float* __restrict__ Lt_s0, const bf16_t* __restrict__ colp, const float* __restrict__ mulp0, const float sg, bf16_t* __restrict__ outp,
                  bf16_t* XT_s, const bf16_t* Lb_s, const int tid, const int wv, const int l15, const int quad) {
    int vz = 0; asm volatile("" : "+v"(vz));
    const float* __restrict__ Lt_s = Lt_s0 + vz; const float* __restrict__ mulp = mulp0 + vz;
    f32x2 X0, X1, X2, X3, X4, X5, X6, X7, X8, X9, X10, X11, X12, X13, X14, X15, X16, X17, X18, X19, X20, X21, X22, X23, X24, X25, X26, X27, X28, X29, X30, X31;
    f32x4 La0, La1, La2, La3, La4, La5, La6, La7, La8, La9, La10, La11, La12, La13, La14, La15, Lb0, Lb1, Lb2, Lb3, Lb4, Lb5, Lb6, Lb7, Lb8, Lb9, Lb10, Lb11, Lb12, Lb13, Lb14, Lb15;
    X0 = (f32x2){bf2f(colp[0]) * mulp[0], bf2f(colp[136]) * mulp[1]};
    X1 = (f32x2){bf2f(colp[272]) * mulp[2], bf2f(colp[408]) * mulp[3]};
    X2 = (f32x2){bf2f(colp[544]) * mulp[4], bf2f(colp[680]) * mulp[5]};
    X3 = (f32x2){bf2f(colp[816]) * mulp[6], bf2f(colp[952]) * mulp[7]};
    X4 = (f32x2){bf2f(colp[1088]) * mulp[8], bf2f(colp[1224]) * mulp[9]};
    X5 = (f32x2){bf2f(colp[1360]) * mulp[10], bf2f(colp[1496]) * mulp[11]};
    X6 = (f32x2){bf2f(colp[1632]) * mulp[12], bf2f(colp[1768]) * mulp[13]};
    X7 = (f32x2){bf2f(colp[1904]) * mulp[14], bf2f(colp[2040]) * mulp[15]};
    X8 = (f32x2){bf2f(colp[2176]) * mulp[16], bf2f(colp[2312]) * mulp[17]};
    X9 = (f32x2){bf2f(colp[2448]) * mulp[18], bf2f(colp[2584]) * mulp[19]};
    X10 = (f32x2){bf2f(colp[2720]) * mulp[20], bf2f(colp[2856]) * mulp[21]};
    X11 = (f32x2){bf2f(colp[2992]) * mulp[22], bf2f(colp[3128]) * mulp[23]};
    X12 = (f32x2){bf2f(colp[3264]) * mulp[24], bf2f(colp[3400]) * mulp[25]};
    X13 = (f32x2){bf2f(colp[3536]) * mulp[26], bf2f(colp[3672]) * mulp[27]};
    X14 = (f32x2){bf2f(colp[3808]) * mulp[28], bf2f(colp[3944]) * mulp[29]};
    X15 = (f32x2){bf2f(colp[4080]) * mulp[30], bf2f(colp[4216]) * mulp[31]};
    X16 = (f32x2){bf2f(colp[4352]) * mulp[32], bf2f(colp[4488]) * mulp[33]};
    X17 = (f32x2){bf2f(colp[4624]) * mulp[34], bf2f(colp[4760]) * mulp[35]};
    X18 = (f32x2){bf2f(colp[4896]) * mulp[36], bf2f(colp[5032]) * mulp[37]};
    X19 = (f32x2){bf2f(colp[5168]) * mulp[38], bf2f(colp[5304]) * mulp[39]};
    X20 = (f32x2){bf2f(colp[5440]) * mulp[40], bf2f(colp[5576]) * mulp[41]};
    X21 = (f32x2){bf2f(colp[5712]) * mulp[42], bf2f(colp[5848]) * mulp[43]};
    X22 = (f32x2){bf2f(colp[5984]) * mulp[44], bf2f(colp[6120]) * mulp[45]};
    X23 = (f32x2){bf2f(colp[6256]) * mulp[46], bf2f(colp[6392]) * mulp[47]};
    X24 = (f32x2){bf2f(colp[6528]) * mulp[48], bf2f(colp[6664]) * mulp[49]};
    X25 = (f32x2){bf2f(colp[6800]) * mulp[50], bf2f(colp[6936]) * mulp[51]};
    X26 = (f32x2){bf2f(colp[7072]) * mulp[52], bf2f(colp[7208]) * mulp[53]};
    X27 = (f32x2){bf2f(colp[7344]) * mulp[54], bf2f(colp[7480]) * mulp[55]};
    X28 = (f32x2){bf2f(colp[7616]) * mulp[56], bf2f(colp[7752]) * mulp[57]};
    X29 = (f32x2){bf2f(colp[7888]) * mulp[58], bf2f(colp[8024]) * mulp[59]};
    X30 = (f32x2){bf2f(colp[8160]) * mulp[60], bf2f(colp[8296]) * mulp[61]};
    X31 = (f32x2){bf2f(colp[8432]) * mulp[62], bf2f(colp[8568]) * mulp[63]};
    __syncthreads();
    La0 = *(const f32x4*)(Lt_s + 0);
    La1 = *(const f32x4*)(Lt_s + 4);
    La2 = *(const f32x4*)(Lt_s + 8);
    La3 = *(const f32x4*)(Lt_s + 12);
    La4 = *(const f32x4*)(Lt_s + 16);
    La5 = *(const f32x4*)(Lt_s + 20);
    La6 = *(const f32x4*)(Lt_s + 24);
    La7 = *(const f32x4*)(Lt_s + 28);
    Lb0 = *(const f32x4*)(Lt_s + 68);
    Lb1 = *(const f32x4*)(Lt_s + 72);
    Lb2 = *(const f32x4*)(Lt_s + 76);
    Lb3 = *(const f32x4*)(Lt_s + 80);
    Lb4 = *(const f32x4*)(Lt_s + 84);
    Lb5 = *(const f32x4*)(Lt_s + 88);
    Lb6 = *(const f32x4*)(Lt_s + 92);
    Lb7 = *(const f32x4*)(Lt_s + 96);
    __builtin_amdgcn_sched_barrier(0);
    { const float xj = X0[0]; const f32x2 xj2 = (f32x2){xj, xj};
      X0 -= (f32x2){La0[0], La0[1]} * xj2;
      X1 -= (f32x2){La0[2], La0[3]} * xj2;
      X2 -= (f32x2){La1[0], La1[1]} * xj2;
      X3 -= (f32x2){La1[2], La1[3]} * xj2;
      X4 -= (f32x2){La2[0], La2[1]} * xj2;
      X5 -= (f32x2){La2[2], La2[3]} * xj2;
      X6 -= (f32x2){La3[0], La3[1]} * xj2;
      X7 -= (f32x2){La3[2], La3[3]} * xj2;
      X8 -= (f32x2){La4[0], La4[1]} * xj2;
      X9 -= (f32x2){La4[2], La4[3]} * xj2;
      X10 -= (f32x2){La5[0], La5[1]} * xj2;
      X11 -= (f32x2){La5[2], La5[3]} * xj2;
      X12 -= (f32x2){La6[0], La6[1]} * xj2;
      X13 -= (f32x2){La6[2], La6[3]} * xj2;
      X14 -= (f32x2){La7[0], La7[1]} * xj2;
      X15 -= (f32x2){La7[2], La7[3]} * xj2;
    }
    __builtin_amdgcn_sched_barrier(0);
    La0 = *(const f32x4*)(Lt_s + 136);
    La1 = *(const f32x4*)(Lt_s + 140);
    La2 = *(const f32x4*)(Lt_s + 144);
    La3 = *(const f32x4*)(Lt_s + 148);
    La4 = *(const f32x4*)(Lt_s + 152);
    La5 = *(const f32x4*)(Lt_s + 156);
    La6 = *(const f32x4*)(Lt_s + 160);
    La7 = *(const f32x4*)(Lt_s + 164);
    __builtin_amdgcn_sched_barrier(0);
    { const float xj = X0[1]; const f32x2 xj2 = (f32x2){xj, xj};
      X1 -= (f32x2){Lb0[2], Lb0[3]} * xj2;
      X2 -= (f32x2){Lb1[0], Lb1[1]} * xj2;
      X3 -= (f32x2){Lb1[2], Lb1[3]} * xj2;
      X4 -= (f32x2){Lb2[0], Lb2[1]} * xj2;
      X5 -= (f32x2){Lb2[2], Lb2[3]} * xj2;
      X6 -= (f32x2){Lb3[0], Lb3[1]} * xj2;
      X7 -= (f32x2){Lb3[2], Lb3[3]} * xj2;
      X8 -= (f32x2){Lb4[0], Lb4[1]} * xj2;
      X9 -= (f32x2){Lb4[2], Lb4[3]} * xj2;
      X10 -= (f32x2){Lb5[0], Lb5[1]} * xj2;
      X11 -= (f32x2){Lb5[2], Lb5[3]} * xj2;
      X12 -= (f32x2){Lb6[0], Lb6[1]} * xj2;
      X13 -= (f32x2){Lb6[2], Lb6[3]} * xj2;
      X14 -= (f32x2){Lb7[0], Lb7[1]} * xj2;
      X15 -= (f32x2){Lb7[2], Lb7[3]} * xj2;
    }
    __builtin_amdgcn_sched_barrier(0);
    Lb1 = *(const f32x4*)(Lt_s + 208);
    Lb2 = *(const f32x4*)(Lt_s + 212);
    Lb3 = *(const f32x4*)(Lt_s + 216);
    Lb4 = *(const f32x4*)(Lt_s + 220);
    Lb5 = *(const f32x4*)(Lt_s + 224);
    Lb6 = *(const f32x4*)(Lt_s + 228);
    Lb7 = *(const f32x4*)(Lt_s + 232);
    __builtin_amdgcn_sched_barrier(0);
    { const float xj = X1[0]; const f32x2 xj2 = (f32x2){xj, xj};
      X1 -= (f32x2){La0[2], La0[3]} * xj2;
      X2 -= (f32x2){La1[0], La1[1]} * xj2;
      X3 -= (f32x2){La1[2], La1[3]} * xj2;
      X4 -= (f32x2){La2[0], La2[1]} * xj2;
      X5 -= (f32x2){La2[2], La2[3]} * xj2;
      X6 -= (f32x2){La3[0], La3[1]} * xj2;
      X7 -= (f32x2){La3[2], La3[3]} * xj2;
      X8 -= (f32x2){La4[0], La4[1]} * xj2;
      X9 -= (f32x2){La4[2], La4[3]} * xj2;
      X10 -= (f32x2){La5[0], La5[1]} * xj2;
      X11 -= (f32x2){La5[2], La5[3]} * xj2;
      X12 -= (f32x2){La6[0], La6[1]} * xj2;
      X13 -= (f32x2){La6[2], La6[3]} * xj2;
      X14 -= (f32x2){La7[0], La7[1]} * xj2;
      X15 -= (f32x2){La7[2], La7[3]} * xj2;
    }
    __builtin_amdgcn_sched_barrier(0);
    La1 = *(const f32x4*)(Lt_s + 276);
    La2 = *(const f32x4*)(Lt_s + 280);
    La3 = *(const f32x4*)(Lt_s + 284);
    La4 = *(const f32x4*)(Lt_s + 288);
    La5 = *(const f32x4*)(Lt_s + 292);
    La6 = *(const f32x4*)(Lt_s + 296);
    La7 = *(const f32x4*)(Lt_s + 300);
    __builtin_amdgcn_sched_barrier(0);
    { const float xj = X1[1]; const f32x2 xj2 = (f32x2){xj, xj};
      X2 -= (f32x2){Lb1[0], Lb1[1]} * xj2;
      X3 -= (f32x2){Lb1[2], Lb1[3]} * xj2;
      X4 -= (f32x2){Lb2[0], Lb2[1]} * xj2;
      X5 -= (f32x2){Lb2[2], Lb2[3]} * xj2;
      X6 -= (f32x2){Lb3[0], Lb3[1]} * xj2;
      X7 -= (f32x2){Lb3[2], Lb3[3]} * xj2;
      X8 -= (f32x2){Lb4[0], Lb4[1]} * xj2;
      X9 -= (f32x2){Lb4[2], Lb4[3]} * xj2;
      X10 -= (f32x2){Lb5[0], Lb5[1]} * xj2;
      X11 -= (f32x2){Lb5[2], Lb5[3]} * xj2;
      X12 -= (f32x2){Lb6[0], Lb6[1]} * xj2;
      X13 -= (f32x2){Lb6[2], Lb6[3]} * xj2;
      X14 -= (f32x2){Lb7[0], Lb7[1]} * xj2;
      X15 -= (f32x2){Lb7[2], Lb7[3]} * xj2;
    }
    __builtin_amdgcn_sched_barrier(0);
    Lb1 = *(const f32x4*)(Lt_s + 344);
    Lb2 = *(const f32x4*)(Lt_s + 348);
    Lb3 = *(const f32x4*)(Lt_s + 352);
    Lb4 = *(const f32x4*)(Lt_s + 356);
    Lb5 = *(const f32x4*)(Lt_s + 360);
    Lb6 = *(const f32x4*)(Lt_s + 364);
    Lb7 = *(const f32x4*)(Lt_s + 368);
    __builtin_amdgcn_sched_barrier(0);
    { const float xj = X2[0]; const f32x2 xj2 = (f32x2){xj, xj};
      X2 -= (f32x2){La1[0], La1[1]} * xj2;
      X3 -= (f32x2){La1[2], La1[3]} * xj2;
      X4 -= (f32x2){La2[0], La2[1]} * xj2;
      X5 -= (f32x2){La2[2], La2[3]} * xj2;
      X6 -= (f32x2){La3[0], La3[1]} * xj2;
      X7 -= (f32x2){La3[2], La3[3]} * xj2;
      X8 -= (f32x2){La4[0], La4[1]} * xj2;
      X9 -= (f32x2){La4[2], La4[3]} * xj2;
      X10 -= (f32x2){La5[0], La5[1]} * xj2;
      X11 -= (f32x2){La5[2], La5[3]} * xj2;
      X12 -= (f32x2){La6[0], La6[1]} * xj2;
      X13 -= (f32x2){La6[2], La6[3]} * xj2;
      X14 -= (f32x2){La7[0], La7[1]} * xj2;
      X15 -= (f32x2){La7[2], La7[3]} * xj2;
    }
    __builtin_amdgcn_sched_barrier(0);
    La1 = *(const f32x4*)(Lt_s + 412);
    La2 = *(const f32x4*)(Lt_s + 416);
    La3 = *(const f32x4*)(Lt_s + 420);
    La4 = *(const f32x4*)(Lt_s + 424);
    La5 = *(const f32x4*)(Lt_s + 428);
    La6 = *(const f32x4*)(Lt_s + 432);
    La7 = *(const f32x4*)(Lt_s + 436);
    __builtin_amdgcn_sched_barrier(0);
    { const float xj = X2[1]; const f32x2 xj2 = (f32x2){xj, xj};
      X3 -= (f32x2){Lb1[2], Lb1[3]} * xj2;
      X4 -= (f32x2){Lb2[0], Lb2[1]} * xj2;
      X5 -= (f32x2){Lb2[2], Lb2[3]} * xj2;
      X6 -= (f32x2){Lb3[0], Lb3[1]} * xj2;
      X7 -= (f32x2){Lb3[2], Lb3[3]} * xj2;
      X8 -= (f32x2){Lb4[0], Lb4[1]} * xj2;
      X9 -= (f32x2){Lb4[2], Lb4[3]} * xj2;
      X10 -= (f32x2){Lb5[0], Lb5[1]} * xj2;
      X11 -= (f32x2){Lb5[2], Lb5[3]} * xj2;
      X12 -= (f32x2){Lb6[0], Lb6[1]} * xj2;
      X13 -= (f32x2){Lb6[2], Lb6[3]} * xj2;
      X14 -= (f32x2){Lb7[0], Lb7[1]} * xj2;
      X15 -= (f32x2){Lb7[2], Lb7[3]} * xj2;
    }
    __builtin_amdgcn_sched_barrier(0);
    Lb2 = *(const f32x4*)(Lt_s + 484);
    Lb3 = *(const f32x4*)(Lt_s + 488);
    Lb4 = *(const f32x4*)(Lt_s + 492);
    Lb5 = *(const f32x4*)(Lt_s + 496);
    Lb6 = *(const f32x4*)(Lt_s + 500);
    Lb7 = *(const f32x4*)(Lt_s + 504);
    __builtin_amdgcn_sched_barrier(0);
    { const float xj = X3[0]; const f32x2 xj2 = (f32x2){xj, xj};
      X3 -= (f32x2){La1[2], La1[3]} * xj2;
      X4 -= (f32x2){La2[0], La2[1]} * xj2;
      X5 -= (f32x2){La2[2], La2[3]} * xj2;
      X6 -= (f32x2){La3[0], La3[1]} * xj2;
      X7 -= (f32x2){La3[2], La3[3]} * xj2;
      X8 -= (f32x2){La4[0], La4[1]} * xj2;
      X9 -= (f32x2){La4[2], La4[3]} * xj2;
      X10 -= (f32x2){La5[0], La5[1]} * xj2;
      X11 -= (f32x2){La5[2], La5[3]} * xj2;
      X12 -= (f32x2){La6[0], La6[1]} * xj2;
      X13 -= (f32x2){La6[2], La6[3]} * xj2;
      X14 -= (f32x2){La7[0], La7[1]} * xj2;
      X15 -= (f32x2){La7[2], La7[3]} * xj2;
    }
    __builtin_amdgcn_sched_barrier(0);
    La2 = *(const f32x4*)(Lt_s + 552);
    La3 = *(const f32x4*)(Lt_s + 556);
    La4 = *(const f32x4*)(Lt_s + 560);
    La5 = *(const f32x4*)(Lt_s + 564);
    La6 = *(const f32x4*)(Lt_s + 568);
    La7 = *(const f32x4*)(Lt_s + 572);
    __builtin_amdgcn_sched_barrier(0);
    { const float xj = X3[1]; const f32x2 xj2 = (f32x2){xj, xj};
      X4 -= (f32x2){Lb2[0], Lb2[1]} * xj2;
      X5 -= (f32x2){Lb2[2], Lb2[3]} * xj2;
      X6 -= (f32x2){Lb3[0], Lb3[1]} * xj2;
      X7 -= (f32x2){Lb3[2], Lb3[3]} * xj2;
      X8 -= (f32x2){Lb4[0], Lb4[1]} * xj2;
      X9 -= (f32x2){Lb4[2], Lb4[3]} * xj2;
      X10 -= (f32x2){Lb5[0], Lb5[1]} * xj2;
      X11 -= (f32x2){Lb5[2], Lb5[3]} * xj2;
      X12 -= (f32x2){Lb6[0], Lb6[1]} * xj2;
      X13 -= (f32x2){Lb6[2], Lb6[3]} * xj2;
      X14 -= (f32x2){Lb7[0], Lb7[1]} * xj2;
      X15 -= (f32x2){Lb7[2], Lb7[3]} * xj2;
    }
    __builtin_amdgcn_sched_barrier(0);
    Lb2 = *(const f32x4*)(Lt_s + 620);
    Lb3 = *(const f32x4*)(Lt_s + 624);
    Lb4 = *(const f32x4*)(Lt_s + 628);
    Lb5 = *(const f32x4*)(Lt_s + 632);
    Lb6 = *(const f32x4*)(Lt_s + 636);
    Lb7 = *(const f32x4*)(Lt_s + 640);
    __builtin_amdgcn_sched_barrier(0);
    { const float xj = X4[0]; const f32x2 xj2 = (f32x2){xj, xj};
      X4 -= (f32x2){La2[0], La2[1]} * xj2;
      X5 -= (f32x2){La2[2], La2[3]} * xj2;
      X6 -= (f32x2){La3[0], La3[1]} * xj2;
      X7 -= (f32x2){La3[2], La3[3]} * xj2;
      X8 -= (f32x2){La4[0], La4[1]} * xj2;
      X9 -= (f32x2){La4[2], La4[3]} * xj2;
      X10 -= (f32x2){La5[0], La5[1]} * xj2;
      X11 -= (f32x2){La5[2], La5[3]} * xj2;
      X12 -= (f32x2){La6[0], La6[1]} * xj2;
      X13 -= (f32x2){La6[2], La6[3]} * xj2;
      X14 -= (f32x2){La7[0], La7[1]} * xj2;
      X15 -= (f32x2){La7[2], La7[3]} * xj2;
    }
    __builtin_amdgcn_sched_barrier(0);
    La2 = *(const f32x4*)(Lt_s + 688);
    La3 = *(const f32x4*)(Lt_s + 692);
    La4 = *(const f32x4*)(Lt_s + 696);
    La5 = *(const f32x4*)(Lt_s + 700);
    La6 = *(const f32x4*)(Lt_s + 704);
    La7 = *(const f32x4*)(Lt_s + 708);
    __builtin_amdgcn_sched_barrier(0);
    { const float xj = X4[1]; const f32x2 xj2 = (f32x2){xj, xj};
      X5 -= (f32x2){Lb2[2], Lb2[3]} * xj2;
      X6 -= (f32x2){Lb3[0], Lb3[1]} * xj2;
      X7 -= (f32x2){Lb3[2], Lb3[3]} * xj2;
      X8 -= (f32x2){Lb4[0], Lb4[1]} * xj2;
      X9 -= (f32x2){Lb4[2], Lb4[3]} * xj2;
      X10 -= (f32x2){Lb5[0], Lb5[1]} * xj2;
      X11 -= (f32x2){Lb5[2], Lb5[3]} * xj2;
      X12 -= (f32x2){Lb6[0], Lb6[1]} * xj2;
      X13 -= (f32x2){Lb6[2], Lb6[3]} * xj2;
      X14 -= (f32x2){Lb7[0], Lb7[1]} * xj2;
      X15 -= (f32x2){Lb7[2], Lb7[3]} * xj2;
    }
    __builtin_amdgcn_sched_barrier(0);
    Lb3 = *(const f32x4*)(Lt_s + 760);
    Lb4 = *(const f32x4*)(Lt_s + 764);
    Lb5 = *(const f32x4*)(Lt_s + 768);
    Lb6 = *(const f32x4*)(Lt_s + 772);
    Lb7 = *(const f32x4*)(Lt_s + 776);
    __builtin_amdgcn_sched_barrier(0);
    { const float xj = X5[0]; const f32x2 xj2 = (f32x2){xj, xj};
      X5 -= (f32x2){La2[2], La2[3]} * xj2;
      X6 -= (f32x2){La3[0], La3[1]} * xj2;
      X7 -= (f32x2){La3[2], La3[3]} * xj2;
      X8 -= (f32x2){La4[0], La4[1]} * xj2;
      X9 -= (f32x2){La4[2], La4[3]} * xj2;
      X10 -= (f32x2){La5[0], La5[1]} * xj2;
      X11 -= (f32x2){La5[2], La5[3]} * xj2;
      X12 -= (f32x2){La6[0], La6[1]} * xj2;
      X13 -= (f32x2){La6[2], La6[3]} * xj2;
      X14 -= (f32x2){La7[0], La7[1]} * xj2;
      X15 -= (f32x2){La7[2], La7[3]} * xj2;
    }
    __builtin_amdgcn_sched_barrier(0);
    La3 = *(const f32x4*)(Lt_s + 828);
    La4 = *(const f32x4*)(Lt_s + 832);
    La5 = *(const f32x4*)(Lt_s + 836);
    La6 = *(const f32x4*)(Lt_s + 840);
    La7 = *(const f32x4*)(Lt_s + 844);
    __builtin_amdgcn_sched_barrier(0);
    { const float xj = X5[1]; const f32x2 xj2 = (f32x2){xj, xj};
      X6 -= (f32x2){Lb3[0], Lb3[1]} * xj2;
      X7 -= (f32x2){Lb3[2], Lb3[3]} * xj2;
      X8 -= (f32x2){Lb4[0], Lb4[1]} * xj2;
      X9 -= (f32x2){Lb4[2], Lb4[3]} * xj2;
      X10 -= (f32x2){Lb5[0], Lb5[1]} * xj2;
      X11 -= (f32x2){Lb5[2], Lb5[3]} * xj2;
      X12 -= (f32x2){Lb6[0], Lb6[1]} * xj2;
      X13 -= (f32x2){Lb6[2], Lb6[3]} * xj2;
      X14 -= (f32x2){Lb7[0], Lb7[1]} * xj2;
      X15 -= (f32x2){Lb7[2], Lb7[3]} * xj2;
    }
    __builtin_amdgcn_sched_barrier(0);
    Lb3 = *(const f32x4*)(Lt_s + 896);
    Lb4 = *(const f32x4*)(Lt_s + 900);
    Lb5 = *(const f32x4*)(Lt_s + 904);
    Lb6 = *(const f32x4*)(Lt_s + 908);
    Lb7 = *(const f32x4*)(Lt_s + 912);
    __builtin_amdgcn_sched_barrier(0);
    { const float xj = X6[0]; const f32x2 xj2 = (f32x2){xj, xj};
      X6 -= (f32x2){La3[0], La3[1]} * xj2;
      X7 -= (f32x2){La3[2], La3[3]} * xj2;
      X8 -= (f32x2){La4[0], La4[1]} * xj2;
      X9 -= (f32x2){La4[2], La4[3]} * xj2;
      X10 -= (f32x2){La5[0], La5[1]} * xj2;
      X11 -= (f32x2){La5[2], La5[3]} * xj2;
      X12 -= (f32x2){La6[0], La6[1]} * xj2;
      X13 -= (f32x2){La6[2], La6[3]} * xj2;
      X14 -= (f32x2){La7[0], La7[1]} * xj2;
      X15 -= (f32x2){La7[2], La7[3]} * xj2;
    }
    __builtin_amdgcn_sched_barrier(0);
    La3 = *(const f32x4*)(Lt_s + 964);
    La4 = *(const f32x4*)(Lt_s + 968);
    La5 = *(const f32x4*)(Lt_s + 972);
    La6 = *(const f32x4*)(Lt_s + 976);
    La7 = *(const f32x4*)(Lt_s + 980);
    __builtin_amdgcn_sched_barrier(0);
    { const float xj = X6[1]; const f32x2 xj2 = (f32x2){xj, xj};
      X7 -= (f32x2){Lb3[2], Lb3[3]} * xj2;
      X8 -= (f32x2){Lb4[0], Lb4[1]} * xj2;
      X9 -= (f32x2){Lb4[2], Lb4[3]} * xj2;
      X10 -= (f32x2){Lb5[0], Lb5[1]} * xj2;
      X11 -= (f32x2){Lb5[2], Lb5[3]} * xj2;
      X12 -= (f32x2){Lb6[0], Lb6[1]} * xj2;
      X13 -= (f32x2){Lb6[2], Lb6[3]} * xj2;
      X14 -= (f32x2){Lb7[0], Lb7[1]} * xj2;
      X15 -= (f32x2){Lb7[2], Lb7[3]} * xj2;
    }
    __builtin_amdgcn_sched_barrier(0);
    Lb4 = *(const f32x4*)(Lt_s + 1036);
    Lb5 = *(const f32x4*)(Lt_s + 1040);
    Lb6 = *(const f32x4*)(Lt_s + 1044);
    Lb7 = *(const f32x4*)(Lt_s + 1048);
    __builtin_amdgcn_sched_barrier(0);
    { const float xj = X7[0]; const f32x2 xj2 = (f32x2){xj, xj};
      X7 -= (f32x2){La3[2], La3[3]} * xj2;
      X8 -= (f32x2){La4[0], La4[1]} * xj2;
      X9 -= (f32x2){La4[2], La4[3]} * xj2;
      X10 -= (f32x2){La5[0], La5[1]} * xj2;
      X11 -= (f32x2){La5[2], La5[3]} * xj2;
      X12 -= (f32x2){La6[0], La6[1]} * xj2;
      X13 -= (f32x2){La6[2], La6[3]} * xj2;
      X14 -= (f32x2){La7[0], La7[1]} * xj2;
      X15 -= (f32x2){La7[2], La7[3]} * xj2;
    }
    __builtin_amdgcn_sched_barrier(0);
    La4 = *(const f32x4*)(Lt_s + 1104);
    La5 = *(const f32x4*)(Lt_s + 1108);
    La6 = *(const f32x4*)(Lt_s + 1112);
    La7 = *(const f32x4*)(Lt_s + 1116);
    __builtin_amdgcn_sched_barrier(0);
    { const float xj = X7[1]; const f32x2 xj2 = (f32x2){xj, xj};
      X8 -= (f32x2){Lb4[0], Lb4[1]} * xj2;
      X9 -= (f32x2){Lb4[2], Lb4[3]} * xj2;
      X10 -= (f32x2){Lb5[0], Lb5[1]} * xj2;
      X11 -= (f32x2){Lb5[2], Lb5[3]} * xj2;
      X12 -= (f32x2){Lb6[0], Lb6[1]} * xj2;
      X13 -= (f32x2){Lb6[2], Lb6[3]} * xj2;
      X14 -= (f32x2){Lb7[0], Lb7[1]} * xj2;
      X15 -= (f32x2){Lb7[2], Lb7[3]} * xj2;
    }
    __builtin_amdgcn_sched_barrier(0);
    Lb4 = *(const f32x4*)(Lt_s + 1172);
    Lb5 = *(const f32x4*)(Lt_s + 1176);
    Lb6 = *(const f32x4*)(Lt_s + 1180);
    Lb7 = *(const f32x4*)(Lt_s + 1184);
    __builtin_amdgcn_sched_barrier(0);
    { const float xj = X8[0]; const f32x2 xj2 = (f32x2){xj, xj};
      X8 -= (f32x2){La4[0], La4[1]} * xj2;
      X9 -= (f32x2){La4[2], La4[3]} * xj2;
      X10 -= (f32x2){La5[0], La5[1]} * xj2;
      X11 -= (f32x2){La5[2], La5[3]} * xj2;
      X12 -= (f32x2){La6[0], La6[1]} * xj2;
      X13 -= (f32x2){La6[2], La6[3]} * xj2;
      X14 -= (f32x2){La7[0], La7[1]} * xj2;
      X15 -= (f32x2){La7[2], La7[3]} * xj2;
    }
    __builtin_amdgcn_sched_barrier(0);
    La4 = *(const f32x4*)(Lt_s + 1240);
    La5 = *(const f32x4*)(Lt_s + 1244);
    La6 = *(const f32x4*)(Lt_s + 1248);
    La7 = *(const f32x4*)(Lt_s + 1252);
    __builtin_amdgcn_sched_barrier(0);
    { const float xj = X8[1]; const f32x2 xj2 = (f32x2){xj, xj};
      X9 -= (f32x2){Lb4[2], Lb4[3]} * xj2;
      X10 -= (f32x2){Lb5[0], Lb5[1]} * xj2;
      X11 -= (f32x2){Lb5[2], Lb5[3]} * xj2;
      X12 -= (f32x2){Lb6[0], Lb6[1]} * xj2;
      X13 -= (f32x2){Lb6[2], Lb6[3]} * xj2;
      X14 -= (f32x2){Lb7[0], Lb7[1]} * xj2;
      X15 -= (f32x2){Lb7[2], Lb7[3]} * xj2;
    }
    __builtin_amdgcn_sched_barrier(0);
    Lb5 = *(const f32x4*)(Lt_s + 1312);
    Lb6 = *(const f32x4*)(Lt_s + 1316);
    Lb7 = *(const f32x4*)(Lt_s + 1320);
    __builtin_amdgcn_sched_barrier(0);
    { const float xj = X9[0]; const f32x2 xj2 = (f32x2){xj, xj};
      X9 -= (f32x2){La4[2], La4[3]} * xj2;
      X10 -= (f32x2){La5[0], La5[1]} * xj2;
      X11 -= (f32x2){La5[2], La5[3]} * xj2;
      X12 -= (f32x2){La6[0], La6[1]} * xj2;
      X13 -= (f32x2){La6[2], La6[3]} * xj2;
      X14 -= (f32x2){La7[0], La7[1]} * xj2;
      X15 -= (f32x2){La7[2], La7[3]} * xj2;
    }
    __builtin_amdgcn_sched_barrier(0);
    La5 = *(const f32x4*)(Lt_s + 1380);
    La6 = *(const f32x4*)(Lt_s + 1384);
    La7 = *(const f32x4*)(Lt_s + 1388);
    __builtin_amdgcn_sched_barrier(0);
    { const float xj = X9[1]; const f32x2 xj2 = (f32x2){xj, xj};
      X10 -= (f32x2){Lb5[0], Lb5[1]} * xj2;
      X11 -= (f32x2){Lb5[2], Lb5[3]} * xj2;
      X12 -= (f32x2){Lb6[0], Lb6[1]} * xj2;
      X13 -= (f32x2){Lb6[2], Lb6[3]} * xj2;
      X14 -= (f32x2){Lb7[0], Lb7[1]} * xj2;
      X15 -= (f32x2){Lb7[2], Lb7[3]} * xj2;
    }
    __builtin_amdgcn_sched_barrier(0);
    Lb5 = *(const f32x4*)(Lt_s + 1448);
    Lb6 = *(const f32x4*)(Lt_s + 1452);
    Lb7 = *(const f32x4*)(Lt_s + 1456);
    __builtin_amdgcn_sched_barrier(0);
    { const float xj = X10[0]; const f32x2 xj2 = (f32x2){xj, xj};
      X10 -= (f32x2){La5[0], La5[1]} * xj2;
      X11 -= (f32x2){La5[2], La5[3]} * xj2;
      X12 -= (f32x2){La6[0], La6[1]} * xj2;
      X13 -= (f32x2){La6[2], La6[3]} * xj2;
      X14 -= (f32x2){La7[0], La7[1]} * xj2;
      X15 -= (f32x2){La7[2], La7[3]} * xj2;
    }
    __builtin_amdgcn_sched_barrier(0);
    La5 = *(const f32x4*)(Lt_s + 1516);
    La6 = *(const f32x4*)(Lt_s + 1520);
    La7 = *(const f32x4*)(Lt_s + 1524);
    __builtin_amdgcn_sched_barrier(0);
    { const float xj = X10[1]; const f32x2 xj2 = (f32x2){xj, xj};
      X11 -= (f32x2){Lb5[2], Lb5[3]} * xj2;
      X12 -= (f32x2){Lb6[0], Lb6[1]} * xj2;
      X13 -= (f32x2){Lb6[2], Lb6[3]} * xj2;
      X14 -= (f32x2){Lb7[0], Lb7[1]} * xj2;
      X15 -= (f32x2){Lb7[2], Lb7[3]} * xj2;
    }
    __builtin_amdgcn_sched_barrier(0);
    Lb6 = *(const f32x4*)(Lt_s + 1588);
    Lb7 = *(const f32x4*)(Lt_s + 1592);
    __builtin_amdgcn_sched_barrier(0);
    { const float xj = X11[0]; const f32x2 xj2 = (f32x2){xj, xj};
      X11 -= (f32x2){La5[2], La5[3]} * xj2;
      X12 -= (f32x2){La6[0], La6[1]} * xj2;
      X13 -= (f32x2){La6[2], La6[3]} * xj2;
      X14 -= (f32x2){La7[0], La7[1]} * xj2;
      X15 -= (f32x2){La7[2], La7[3]} * xj2;
    }
    __builtin_amdgcn_sched_barrier(0);
    La6 = *(const f32x4*)(Lt_s + 1656);
    La7 = *(const f32x4*)(Lt_s + 1660);
    __builtin_amdgcn_sched_barrier(0);
    { const float xj = X11[1]; const f32x2 xj2 = (f32x2){xj, xj};
      X12 -= (f32x2){Lb6[0], Lb6[1]} * xj2;
      X13 -= (f32x2){Lb6[2], Lb6[3]} * xj2;
      X14 -= (f32x2){Lb7[0], Lb7[1]} * xj2;
      X15 -= (f32x2){Lb7[2], Lb7[3]} * xj2;
    }
    __builtin_amdgcn_sched_barrier(0);
    Lb6 = *(const f32x4*)(Lt_s + 1724);
    Lb7 = *(const f32x4*)(Lt_s + 1728);
    __builtin_amdgcn_sched_barrier(0);
    { const float xj = X12[0]; const f32x2 xj2 = (f32x2){xj, xj};
      X12 -= (f32x2){La6[0], La6[1]} * xj2;
      X13 -= (f32x2){La6[2], La6[3]} * xj2;
      X14 -= (f32x2){La7[0], La7[1]} * xj2;
      X15 -= (f32x2){La7[2], La7[3]} * xj2;
    }
    __builtin_amdgcn_sched_barrier(0);
    La6 = *(const f32x4*)(Lt_s + 1792);
    La7 = *(const f32x4*)(Lt_s + 1796);
    __builtin_amdgcn_sched_barrier(0);
    { const float xj = X12[1]; const f32x2 xj2 = (f32x2){xj, xj};
      X13 -= (f32x2){Lb6[2], Lb6[3]} * xj2;
      X14 -= (f32x2){Lb7[0], Lb7[1]} * xj2;
      X15 -= (f32x2){Lb7[2], Lb7[3]} * xj2;
    }
    __builtin_amdgcn_sched_barrier(0);
    Lb7 = *(const f32x4*)(Lt_s + 1864);
    __builtin_amdgcn_sched_barrier(0);
    { const float xj = X13[0]; const f32x2 xj2 = (f32x2){xj, xj};
      X13 -= (f32x2){La6[2], La6[3]} * xj2;
      X14 -= (f32x2){La7[0], La7[1]} * xj2;
      X15 -= (f32x2){La7[2], La7[3]} * xj2;
    }
    __builtin_amdgcn_sched_barrier(0);
    La7 = *(const f32x4*)(Lt_s + 1932);
    __builtin_amdgcn_sched_barrier(0);
    { const float xj = X13[1]; const f32x2 xj2 = (f32x2){xj, xj};
      X14 -= (f32x2){Lb7[0], Lb7[1]} * xj2;
      X15 -= (f32x2){Lb7[2], Lb7[3]} * xj2;
    }
    __builtin_amdgcn_sched_barrier(0);
    Lb7 = *(const f32x4*)(Lt_s + 2000);
    __builtin_amdgcn_sched_barrier(0);
    { const float xj = X14[0]; const f32x2 xj2 = (f32x2){xj, xj};
      X14 -= (f32x2){La7[0], La7[1]} * xj2;
      X15 -= (f32x2){La7[2], La7[3]} * xj2;
    }
    __builtin_amdgcn_sched_barrier(0);
    La7 = *(const f32x4*)(Lt_s + 2068);
    __builtin_amdgcn_sched_barrier(0);
    { const float xj = X14[1]; const f32x2 xj2 = (f32x2){xj, xj};
      X15 -= (f32x2){Lb7[2], Lb7[3]} * xj2;
    }
    __builtin_amdgcn_sched_barrier(0);
    __builtin_amdgcn_sched_barrier(0);
    { const float xj = X15[0]; const f32x2 xj2 = (f32x2){xj, xj};
      X15 -= (f32x2){La7[2], La7[3]} * xj2;
    }
    __builtin_amdgcn_sched_barrier(0);
    {
        bf16_t* xr = XT_s + tid * 32;
        { u32x4 o = {pack2(X0[0], X0[1]), pack2(X1[0], X1[1]), pack2(X2[0], X2[1]), pack2(X3[0], X3[1])}; *(u32x4*)(xr + 0) = o; }
        { u32x4 o = {pack2(X4[0], X4[1]), pack2(X5[0], X5[1]), pack2(X6[0], X6[1]), pack2(X7[0], X7[1])}; *(u32x4*)(xr + 8) = o; }
        { u32x4 o = {pack2(X8[0], X8[1]), pack2(X9[0], X9[1]), pack2(X10[0], X10[1]), pack2(X11[0], X11[1])}; *(u32x4*)(xr + 16) = o; }
        { u32x4 o = {pack2(X12[0], X12[1]), pack2(X13[0], X13[1]), pack2(X14[0], X14[1]), pack2(X15[0], X15[1])}; *(u32x4*)(xr + 24) = o; }
        bf16x8 lb0 = *(const bf16x8*)(Lb_s + (0 + l15) * 40 + quad * 8), lb1 = *(const bf16x8*)(Lb_s + (16 + l15) * 40 + quad * 8);
        f32x4 d[4][2];
#pragma unroll
        for (int ct = 0; ct < 4; ++ct) {
            const bf16x8 xt = *(const bf16x8*)(XT_s + (wv * 64 + ct * 16 + l15) * 32 + quad * 8);
            d[ct][0] = mfma16(lb0, xt, (f32x4){0.f, 0.f, 0.f, 0.f}); d[ct][1] = mfma16(lb1, xt, (f32x4){0.f, 0.f, 0.f, 0.f});
        }
#pragma unroll
        for (int ct = 0; ct < 4; ++ct)
#pragma unroll
            for (int it = 0; it < 2; ++it) { u32x2 o; o.x = pack2(d[ct][it][0], d[ct][it][1]); o.y = pack2(d[ct][it][2], d[ct][it][3]);
                *(u32x2*)(XT_s + (wv * 64 + ct * 16 + l15) * 32 + it * 16 + quad * 4) = o; }
        { const u32x4 u = *(const u32x4*)(xr + 0);
          X16 -= (f32x2){lo16(u[0]), hi16(u[0])};
          X17 -= (f32x2){lo16(u[1]), hi16(u[1])};
          X18 -= (f32x2){lo16(u[2]), hi16(u[2])};
          X19 -= (f32x2){lo16(u[3]), hi16(u[3])};
        }
        { const u32x4 u = *(const u32x4*)(xr + 8);
          X20 -= (f32x2){lo16(u[0]), hi16(u[0])};
          X21 -= (f32x2){lo16(u[1]), hi16(u[1])};
          X22 -= (f32x2){lo16(u[2]), hi16(u[2])};
          X23 -= (f32x2){lo16(u[3]), hi16(u[3])};
        }
        { const u32x4 u = *(const u32x4*)(xr + 16);
          X24 -= (f32x2){lo16(u[0]), hi16(u[0])};
          X25 -= (f32x2){lo16(u[1]), hi16(u[1])};
          X26 -= (f32x2){lo16(u[2]), hi16(u[2])};
          X27 -= (f32x2){lo16(u[3]), hi16(u[3])};
        }
        { const u32x4 u = *(const u32x4*)(xr + 24);
          X28 -= (f32x2){lo16(u[0]), hi16(u[0])};
          X29 -= (f32x2){lo16(u[1]), hi16(u[1])};
          X30 -= (f32x2){lo16(u[2]), hi16(u[2])};
          X31 -= (f32x2){lo16(u[3]), hi16(u[3])};
        }
    }
    La8 = *(const f32x4*)(Lt_s + 2208);
    La9 = *(const f32x4*)(Lt_s + 2212);
    La10 = *(const f32x4*)(Lt_s + 2216);
    La11 = *(const f32x4*)(Lt_s + 2220);
    La12 = *(const f32x4*)(Lt_s + 2224);
    La13 = *(const f32x4*)(Lt_s + 2228);
    La14 = *(const f32x4*)(Lt_s + 2232);
    La15 = *(const f32x4*)(Lt_s + 2236);
    Lb8 = *(const f32x4*)(Lt_s + 2276);
    Lb9 = *(const f32x4*)(Lt_s + 2280);
    Lb10 = *(const f32x4*)(Lt_s + 2284);
    Lb11 = *(const f32x4*)(Lt_s + 2288);
    Lb12 = *(const f32x4*)(Lt_s + 2292);
    Lb13 = *(const f32x4*)(Lt_s + 2296);
    Lb14 = *(const f32x4*)(Lt_s + 2300);
    Lb15 = *(const f32x4*)(Lt_s + 2304);
    __builtin_amdgcn_sched_barrier(0);
    { const float xj = X16[0]; const f32x2 xj2 = (f32x2){xj, xj};
      X16 -= (f32x2){La8[0], La8[1]} * xj2;
      X17 -= (f32x2){La8[2], La8[3]} * xj2;
      X18 -= (f32x2){La9[0], La9[1]} * xj2;
      X19 -= (f32x2){La9[2], La9[3]} * xj2;
      X20 -= (f32x2){La10[0], La10[1]} * xj2;
      X21 -= (f32x2){La10[2], La10[3]} * xj2;
      X22 -= (f32x2){La11[0], La11[1]} * xj2;
      X23 -= (f32x2){La11[2], La11[3]} * xj2;
      X24 -= (f32x2){La12[0], La12[1]} * xj2;
      X25 -= (f32x2){La12[2], La12[3]} * xj2;
      X26 -= (f32x2){La13[0], La13[1]} * xj2;
      X27 -= (f32x2){La13[2], La13[3]} * xj2;
      X28 -= (f32x2){La14[0], La14[1]} * xj2;
      X29 -= (f32x2){La14[2], La14[3]} * xj2;
      X30 -= (f32x2){La15[0], La15[1]} * xj2;
      X31 -= (f32x2){La15[2], La15[3]} * xj2;
    }
    __builtin_amdgcn_sched_barrier(0);
    La8 = *(const f32x4*)(Lt_s + 2344);
    La9 = *(const f32x4*)(Lt_s + 2348);
    La10 = *(const f32x4*)(Lt_s + 2352);
    La11 = *(const f32x4*)(Lt_s + 2356);
    La12 = *(const f32x4*)(Lt_s + 2360);
    La13 = *(const f32x4*)(Lt_s + 2364);
    La14 = *(const f32x4*)(Lt_s + 2368);
    La15 = *(const f32x4*)(Lt_s + 2372);
    __builtin_amdgcn_sched_barrier(0);
    { const float xj = X16[1]; const f32x2 xj2 = (f32x2){xj, xj};
      X17 -= (f32x2){Lb8[2], Lb8[3]} * xj2;
      X18 -= (f32x2){Lb9[0], Lb9[1]} * xj2;
      X19 -= (f32x2){Lb9[2], Lb9[3]} * xj2;
      X20 -= (f32x2){Lb10[0], Lb10[1]} * xj2;
      X21 -= (f32x2){Lb10[2], Lb10[3]} * xj2;
      X22 -= (f32x2){Lb11[0], Lb11[1]} * xj2;
      X23 -= (f32x2){Lb11[2], Lb11[3]} * xj2;
      X24 -= (f32x2){Lb12[0], Lb12[1]} * xj2;
      X25 -= (f32x2){Lb12[2], Lb12[3]} * xj2;
      X26 -= (f32x2){Lb13[0], Lb13[1]} * xj2;
      X27 -= (f32x2){Lb13[2], Lb13[3]} * xj2;
      X28 -= (f32x2){Lb14[0], Lb14[1]} * xj2;
      X29 -= (f32x2){Lb14[2], Lb14[3]} * xj2;
      X30 -= (f32x2){Lb15[0], Lb15[1]} * xj2;
      X31 -= (f32x2){Lb15[2], Lb15[3]} * xj2;
    }
    __builtin_amdgcn_sched_barrier(0);
    Lb9 = *(const f32x4*)(Lt_s + 2416);
    Lb10 = *(const f32x4*)(Lt_s + 2420);
    Lb11 = *(const f32x4*)(Lt_s + 2424);
    Lb12 = *(const f32x4*)(Lt_s + 2428);
    Lb13 = *(const f32x4*)(Lt_s + 2432);
    Lb14 = *(const f32x4*)(Lt_s + 2436);
    Lb15 = *(const f32x4*)(Lt_s + 2440);
    __builtin_amdgcn_sched_barrier(0);
    { const float xj = X17[0]; const f32x2 xj2 = (f32x2){xj, xj};
      X17 -= (f32x2){La8[2], La8[3]} * xj2;
      X18 -= (f32x2){La9[0], La9[1]} * xj2;
      X19 -= (f32x2){La9[2], La9[3]} * xj2;
      X20 -= (f32x2){La10[0], La10[1]} * xj2;
      X21 -= (f32x2){La10[2], La10[3]} * xj2;
      X22 -= (f32x2){La11[0], La11[1]} * xj2;
      X23 -= (f32x2){La11[2], La11[3]} * xj2;
      X24 -= (f32x2){La12[0], La12[1]} * xj2;
      X25 -= (f32x2){La12[2], La12[3]} * xj2;
      X26 -= (f32x2){La13[0], La13[1]} * xj2;
      X27 -= (f32x2){La13[2], La13[3]} * xj2;
      X28 -= (f32x2){La14[0], La14[1]} * xj2;
      X29 -= (f32x2){La14[2], La14[3]} * xj2;
      X30 -= (f32x2){La15[0], La15[1]} * xj2;
      X31 -= (f32x2){La15[2], La15[3]} * xj2;
    }
    __builtin_amdgcn_sched_barrier(0);
    La9 = *(const f32x4*)(Lt_s + 2484);
    La10 = *(const f32x4*)(Lt_s + 2488);
    La11 = *(const f32x4*)(Lt_s + 2492);
    La12 = *(const f32x4*)(Lt_s + 2496);
    La13 = *(const f32x4*)(Lt_s + 2500);
    La14 = *(const f32x4*)(Lt_s + 2504);
    La15 = *(const f32x4*)(Lt_s + 2508);
    __builtin_amdgcn_sched_barrier(0);
    { const float xj = X17[1]; const f32x2 xj2 = (f32x2){xj, xj};
      X18 -= (f32x2){Lb9[0], Lb9[1]} * xj2;
      X19 -= (f32x2){Lb9[2], Lb9[3]} * xj2;
      X20 -= (f32x2){Lb10[0], Lb10[1]} * xj2;
      X21 -= (f32x2){Lb10[2], Lb10[3]} * xj2;
      X22 -= (f32x2){Lb11[0], Lb11[1]} * xj2;
      X23 -= (f32x2){Lb11[2], Lb11[3]} * xj2;
      X24 -= (f32x2){Lb12[0], Lb12[1]} * xj2;
      X25 -= (f32x2){Lb12[2], Lb12[3]} * xj2;
      X26 -= (f32x2){Lb13[0], Lb13[1]} * xj2;
      X27 -= (f32x2){Lb13[2], Lb13[3]} * xj2;
      X28 -= (f32x2){Lb14[0], Lb14[1]} * xj2;
      X29 -= (f32x2){Lb14[2], Lb14[3]} * xj2;
      X30 -= (f32x2){Lb15[0], Lb15[1]} * xj2;
      X31 -= (f32x2){Lb15[2], Lb15[3]} * xj2;
    }
    __builtin_amdgcn_sched_barrier(0);
    Lb9 = *(const f32x4*)(Lt_s + 2552);
    Lb10 = *(const f32x4*)(Lt_s + 2556);
    Lb11 = *(const f32x4*)(Lt_s + 2560);
    Lb12 = *(const f32x4*)(Lt_s + 2564);
    Lb13 = *(const f32x4*)(Lt_s + 2568);
    Lb14 = *(const f32x4*)(Lt_s + 2572);
    Lb15 = *(const f32x4*)(Lt_s + 2576);
    __builtin_amdgcn_sched_barrier(0);
    { const float xj = X18[0]; const f32x2 xj2 = (f32x2){xj, xj};
      X18 -= (f32x2){La9[0], La9[1]} * xj2;
      X19 -= (f32x2){La9[2], La9[3]} * xj2;
      X20 -= (f32x2){La10[0], La10[1]} * xj2;
      X21 -= (f32x2){La10[2], La10[3]} * xj2;
      X22 -= (f32x2){La11[0], La11[1]} * xj2;
      X23 -= (f32x2){La11[2], La11[3]} * xj2;
      X24 -= (f32x2){La12[0], La12[1]} * xj2;
      X25 -= (f32x2){La12[2], La12[3]} * xj2;
      X26 -= (f32x2){La13[0], La13[1]} * xj2;
      X27 -= (f32x2){La13[2], La13[3]} * xj2;
      X28 -= (f32x2){La14[0], La14[1]} * xj2;
      X29 -= (f32x2){La14[2], La14[3]} * xj2;
      X30 -= (f32x2){La15[0], La15[1]} * xj2;
      X31 -= (f32x2){La15[2], La15[3]} * xj2;
    }
    __builtin_amdgcn_sched_barrier(0);
    La9 = *(const f32x4*)(Lt_s + 2620);
    La10 = *(const f32x4*)(Lt_s + 2624);
    La11 = *(const f32x4*)(Lt_s + 2628);
    La12 = *(const f32x4*)(Lt_s + 2632);
    La13 = *(const f32x4*)(Lt_s + 2636);
    La14 = *(const f32x4*)(Lt_s + 2640);
    La15 = *(const f32x4*)(Lt_s + 2644);
    __builtin_amdgcn_sched_barrier(0);
    { const float xj = X18[1]; const f32x2 xj2 = (f32x2){xj, xj};
      X19 -= (f32x2){Lb9[2], Lb9[3]} * xj2;
      X20 -= (f32x2){Lb10[0], Lb10[1]} * xj2;
      X21 -= (f32x2){Lb10[2], Lb10[3]} * xj2;
      X22 -= (f32x2){Lb11[0], Lb11[1]} * xj2;
      X23 -= (f32x2){Lb11[2], Lb11[3]} * xj2;
      X24 -= (f32x2){Lb12[0], Lb12[1]} * xj2;
      X25 -= (f32x2){Lb12[2], Lb12[3]} * xj2;
      X26 -= (f32x2){Lb13[0], Lb13[1]} * xj2;
      X27 -= (f32x2){Lb13[2], Lb13[3]} * xj2;
      X28 -= (f32x2){Lb14[0], Lb14[1]} * xj2;
      X29 -= (f32x2){Lb14[2], Lb14[3]} * xj2;
      X30 -= (f32x2){Lb15[0], Lb15[1]} * xj2;
      X31 -= (f32x2){Lb15[2], Lb15[3]} * xj2;
    }
    __builtin_amdgcn_sched_barrier(0);
    Lb10 = *(const f32x4*)(Lt_s + 2692);
    Lb11 = *(const f32x4*)(Lt_s + 2696);
    Lb12 = *(const f32x4*)(Lt_s + 2700);
    Lb13 = *(const f32x4*)(Lt_s + 2704);
    Lb14 = *(const f32x4*)(Lt_s + 2708);
    Lb15 = *(const f32x4*)(Lt_s + 2712);
    __builtin_amdgcn_sched_barrier(0);
    { const float xj = X19[0]; const f32x2 xj2 = (f32x2){xj, xj};
      X19 -= (f32x2){La9[2], La9[3]} * xj2;
      X20 -= (f32x2){La10[0], La10[1]} * xj2;
      X21 -= (f32x2){La10[2], La10[3]} * xj2;
      X22 -= (f32x2){La11[0], La11[1]} * xj2;
      X23 -= (f32x2){La11[2], La11[3]} * xj2;
      X24 -= (f32x2){La12[0], La12[1]} * xj2;
      X25 -= (f32x2){La12[2], La12[3]} * xj2;
      X26 -= (f32x2){La13[0], La13[1]} * xj2;
      X27 -= (f32x2){La13[2], La13[3]} * xj2;
      X28 -= (f32x2){La14[0], La14[1]} * xj2;
      X29 -= (f32x2){La14[2], La14[3]} * xj2;
      X30 -= (f32x2){La15[0], La15[1]} * xj2;
      X31 -= (f32x2){La15[2], La15[3]} * xj2;
    }
    __builtin_amdgcn_sched_barrier(0);
    La10 = *(const f32x4*)(Lt_s + 2760);
    La11 = *(const f32x4*)(Lt_s + 2764);
    La12 = *(const f32x4*)(Lt_s + 2768);
    La13 = *(const f32x4*)(Lt_s + 2772);
    La14 = *(const f32x4*)(Lt_s + 2776);
    La15 = *(const f32x4*)(Lt_s + 2780);
    __builtin_amdgcn_sched_barrier(0);
    { const float xj = X19[1]; const f32x2 xj2 = (f32x2){xj, xj};
      X20 -= (f32x2){Lb10[0], Lb10[1]} * xj2;
      X21 -= (f32x2){Lb10[2], Lb10[3]} * xj2;
      X22 -= (f32x2){Lb11[0], Lb11[1]} * xj2;
      X23 -= (f32x2){Lb11[2], Lb11[3]} * xj2;
      X24 -= (f32x2){Lb12[0], Lb12[1]} * xj2;
      X25 -= (f32x2){Lb12[2], Lb12[3]} * xj2;
      X26 -= (f32x2){Lb13[0], Lb13[1]} * xj2;
      X27 -= (f32x2){Lb13[2], Lb13[3]} * xj2;
      X28 -= (f32x2){Lb14[0], Lb14[1]} * xj2;
      X29 -= (f32x2){Lb14[2], Lb14[3]} * xj2;
      X30 -= (f32x2){Lb15[0], Lb15[1]} * xj2;
      X31 -= (f32x2){Lb15[2], Lb15[3]} * xj2;
    }
    __builtin_amdgcn_sched_barrier(0);
    Lb10 = *(const f32x4*)(Lt_s + 2828);
    Lb11 = *(const f32x4*)(Lt_s + 2832);
    Lb12 = *(const f32x4*)(Lt_s + 2836);
    Lb13 = *(const f32x4*)(Lt_s + 2840);
    Lb14 = *(const f32x4*)(Lt_s + 2844);
    Lb15 = *(const f32x4*)(Lt_s + 2848);
    __builtin_amdgcn_sched_barrier(0);
    { const float xj = X20[0]; const f32x2 xj2 = (f32x2){xj, xj};
      X20 -= (f32x2){La10[0], La10[1]} * xj2;
      X21 -= (f32x2){La10[2], La10[3]} * xj2;
      X22 -= (f32x2){La11[0], La11[1]} * xj2;
      X23 -= (f32x2){La11[2], La11[3]} * xj2;
      X24 -= (f32x2){La12[0], La12[1]} * xj2;
      X25 -= (f32x2){La12[2], La12[3]} * xj2;
      X26 -= (f32x2){La13[0], La13[1]} * xj2;
      X27 -= (f32x2){La13[2], La13[3]} * xj2;
      X28 -= (f32x2){La14[0], La14[1]} * xj2;
      X29 -= (f32x2){La14[2], La14[3]} * xj2;
      X30 -= (f32x2){La15[0], La15[1]} * xj2;
      X31 -= (f32x2){La15[2], La15[3]} * xj2;
    }
    __builtin_amdgcn_sched_barrier(0);
    La10 = *(const f32x4*)(Lt_s + 2896);
    La11 = *(const f32x4*)(Lt_s + 2900);
    La12 = *(const f32x4*)(Lt_s + 2904);
    La13 = *(const f32x4*)(Lt_s + 2908);
    La14 = *(const f32x4*)(Lt_s + 2912);
    La15 = *(const f32x4*)(Lt_s + 2916);
    __builtin_amdgcn_sched_barrier(0);
    { const float xj = X20[1]; const f32x2 xj2 = (f32x2){xj, xj};
      X21 -= (f32x2){Lb10[2], Lb10[3]} * xj2;
      X22 -= (f32x2){Lb11[0], Lb11[1]} * xj2;
      X23 -= (f32x2){Lb11[2], Lb11[3]} * xj2;
      X24 -= (f32x2){Lb12[0], Lb12[1]} * xj2;
      X25 -= (f32x2){Lb12[2], Lb12[3]} * xj2;
      X26 -= (f32x2){Lb13[0], Lb13[1]} * xj2;
      X27 -= (f32x2){Lb13[2], Lb13[3]} * xj2;
      X28 -= (f32x2){Lb14[0], Lb14[1]} * xj2;
      X29 -= (f32x2){Lb14[2], Lb14[3]} * xj2;
      X30 -= (f32x2){Lb15[0], Lb15[1]} * xj2;
      X31 -= (f32x2){Lb15[2], Lb15[3]} * xj2;
    }
    __builtin_amdgcn_sched_barrier(0);
    Lb11 = *(const f32x4*)(Lt_s + 2968);
    Lb12 = *(const f32x4*)(Lt_s + 2972);
    Lb13 = *(const f32x4*)(Lt_s + 2976);
    Lb14 = *(const f32x4*)(Lt_s + 2980);
    Lb15 = *(const f32x4*)(Lt_s + 2984);
    __builtin_amdgcn_sched_barrier(0);
    { const float xj = X21[0]; const f32x2 xj2 = (f32x2){xj, xj};
      X21 -= (f32x2){La10[2], La10[3]} * xj2;
      X22 -= (f32x2){La11[0], La11[1]} * xj2;
      X23 -= (f32x2){La11[2], La11[3]} * xj2;
      X24 -= (f32x2){La12[0], La12[1]} * xj2;
      X25 -= (f32x2){La12[2], La12[3]} * xj2;
      X26 -= (f32x2){La13[0], La13[1]} * xj2;
      X27 -= (f32x2){La13[2], La13[3]} * xj2;
      X28 -= (f32x2){La14[0], La14[1]} * xj2;
      X29 -= (f32x2){La14[2], La14[3]} * xj2;
      X30 -= (f32x2){La15[0], La15[1]} * xj2;
      X31 -= (f32x2){La15[2], La15[3]} * xj2;
    }
    __builtin_amdgcn_sched_barrier(0);
    La11 = *(const f32x4*)(Lt_s + 3036);
    La12 = *(const f32x4*)(Lt_s + 3040);
    La13 = *(const f32x4*)(Lt_s + 3044);
    La14 = *(const f32x4*)(Lt_s + 3048);
    La15 = *(const f32x4*)(Lt_s + 3052);
    __builtin_amdgcn_sched_barrier(0);
    { const float xj = X21[1]; const f32x2 xj2 = (f32x2){xj, xj};
      X22 -= (f32x2){Lb11[0], Lb11[1]} * xj2;
      X23 -= (f32x2){Lb11[2], Lb11[3]} * xj2;
      X24 -= (f32x2){Lb12[0], Lb12[1]} * xj2;
      X25 -= (f32x2){Lb12[2], Lb12[3]} * xj2;
      X26 -= (f32x2){Lb13[0], Lb13[1]} * xj2;
      X27 -= (f32x2){Lb13[2], Lb13[3]} * xj2;
      X28 -= (f32x2){Lb14[0], Lb14[1]} * xj2;
      X29 -= (f32x2){Lb14[2], Lb14[3]} * xj2;
      X30 -= (f32x2){Lb15[0], Lb15[1]} * xj2;
      X31 -= (f32x2){Lb15[2], Lb15[3]} * xj2;
    }
    __builtin_amdgcn_sched_barrier(0);
    Lb11 = *(const f32x4*)(Lt_s + 3104);
    Lb12 = *(const f32x4*)(Lt_s + 3108);
    Lb13 = *(const f32x4*)(Lt_s + 3112);
    Lb14 = *(const f32x4*)(Lt_s + 3116);
    Lb15 = *(const f32x4*)(Lt_s + 3120);
    __builtin_amdgcn_sched_barrier(0);
    { const float xj = X22[0]; const f32x2 xj2 = (f32x2){xj, xj};
      X22 -= (f32x2){La11[0], La11[1]} * xj2;
      X23 -= (f32x2){La11[2], La11[3]} * xj2;
      X24 -= (f32x2){La12[0], La12[1]} * xj2;
      X25 -= (f32x2){La12[2], La12[3]} * xj2;
      X26 -= (f32x2){La13[0], La13[1]} * xj2;
      X27 -= (f32x2){La13[2], La13[3]} * xj2;
      X28 -= (f32x2){La14[0], La14[1]} * xj2;
      X29 -= (f32x2){La14[2], La14[3]} * xj2;
      X30 -= (f32x2){La15[0], La15[1]} * xj2;
      X31 -= (f32x2){La15[2], La15[3]} * xj2;
    }
    __builtin_amdgcn_sched_barrier(0);
    La11 = *(const f32x4*)(Lt_s + 3172);
    La12 = *(const f32x4*)(Lt_s + 3176);
    La13 = *(const f32x4*)(Lt_s + 3180);
    La14 = *(const f32x4*)(Lt_s + 3184);
    La15 = *(const f32x4*)(Lt_s + 3188);
    __builtin_amdgcn_sched_barrier(0);
    { const float xj = X22[1]; const f32x2 xj2 = (f32x2){xj, xj};
      X23 -= (f32x2){Lb11[2], Lb11[3]} * xj2;
      X24 -= (f32x2){Lb12[0], Lb12[1]} * xj2;
      X25 -= (f32x2){Lb12[2], Lb12[3]} * xj2;
      X26 -= (f32x2){Lb13[0], Lb13[1]} * xj2;
      X27 -= (f32x2){Lb13[2], Lb13[3]} * xj2;
      X28 -= (f32x2){Lb14[0], Lb14[1]} * xj2;
      X29 -= (f32x2){Lb14[2], Lb14[3]} * xj2;
      X30 -= (f32x2){Lb15[0], Lb15[1]} * xj2;
      X31 -= (f32x2){Lb15[2], Lb15[3]} * xj2;
    }
    __builtin_amdgcn_sched_barrier(0);
    Lb12 = *(const f32x4*)(Lt_s + 3244);
    Lb13 = *(const f32x4*)(Lt_s + 3248);
    Lb14 = *(const f32x4*)(Lt_s + 3252);
    Lb15 = *(const f32x4*)(Lt_s + 3256);
    __builtin_amdgcn_sched_barrier(0);
    { const float xj = X23[0]; const f32x2 xj2 = (f32x2){xj, xj};
      X23 -= (f32x2){La11[2], La11[3]} * xj2;
      X24 -= (f32x2){La12[0], La12[1]} * xj2;
      X25 -= (f32x2){La12[2], La12[3]} * xj2;
      X26 -= (f32x2){La13[0], La13[1]} * xj2;
      X27 -= (f32x2){La13[2], La13[3]} * xj2;
      X28 -= (f32x2){La14[0], La14[1]} * xj2;
      X29 -= (f32x2){La14[2], La14[3]} * xj2;
      X30 -= (f32x2){La15[0], La15[1]} * xj2;
      X31 -= (f32x2){La15[2], La15[3]} * xj2;
    }
    __builtin_amdgcn_sched_barrier(0);
    La12 = *(const f32x4*)(Lt_s + 3312);
    La13 = *(const f32x4*)(Lt_s + 3316);
    La14 = *(const f32x4*)(Lt_s + 3320);
    La15 = *(const f32x4*)(Lt_s + 3324);
    __builtin_amdgcn_sched_barrier(0);
    { const float xj = X23[1]; const f32x2 xj2 = (f32x2){xj, xj};
      X24 -= (f32x2){Lb12[0], Lb12[1]} * xj2;
      X25 -= (f32x2){Lb12[2], Lb12[3]} * xj2;
      X26 -= (f32x2){Lb13[0], Lb13[1]} * xj2;
      X27 -= (f32x2){Lb13[2], Lb13[3]} * xj2;
      X28 -= (f32x2){Lb14[0], Lb14[1]} * xj2;
      X29 -= (f32x2){Lb14[2], Lb14[3]} * xj2;
      X30 -= (f32x2){Lb15[0], Lb15[1]} * xj2;
      X31 -= (f32x2){Lb15[2], Lb15[3]} * xj2;
    }
    __builtin_amdgcn_sched_barrier(0);
    Lb12 = *(const f32x4*)(Lt_s + 3380);
    Lb13 = *(const f32x4*)(Lt_s + 3384);
    Lb14 = *(const f32x4*)(Lt_s + 3388);
    Lb15 = *(const f32x4*)(Lt_s + 3392);
    __builtin_amdgcn_sched_barrier(0);
    { const float xj = X24[0]; const f32x2 xj2 = (f32x2){xj, xj};
      X24 -= (f32x2){La12[0], La12[1]} * xj2;
      X25 -= (f32x2){La12[2], La12[3]} * xj2;
      X26 -= (f32x2){La13[0], La13[1]} * xj2;
      X27 -= (f32x2){La13[2], La13[3]} * xj2;
      X28 -= (f32x2){La14[0], La14[1]} * xj2;
      X29 -= (f32x2){La14[2], La14[3]} * xj2;
      X30 -= (f32x2){La15[0], La15[1]} * xj2;
      X31 -= (f32x2){La15[2], La15[3]} * xj2;
    }
    __builtin_amdgcn_sched_barrier(0);
    La12 = *(const f32x4*)(Lt_s + 3448);
    La13 = *(const f32x4*)(Lt_s + 3452);
    La14 = *(const f32x4*)(Lt_s + 3456);
    La15 = *(const f32x4*)(Lt_s + 3460);
    __builtin_amdgcn_sched_barrier(0);
    { const float xj = X24[1]; const f32x2 xj2 = (f32x2){xj, xj};
      X25 -= (f32x2){Lb12[2], Lb12[3]} * xj2;
      X26 -= (f32x2){Lb13[0], Lb13[1]} * xj2;
      X27 -= (f32x2){Lb13[2], Lb13[3]} * xj2;
      X28 -= (f32x2){Lb14[0], Lb14[1]} * xj2;
      X29 -= (f32x2){Lb14[2], Lb14[3]} * xj2;
      X30 -= (f32x2){Lb15[0], Lb15[1]} * xj2;
      X31 -= (f32x2){Lb15[2], Lb15[3]} * xj2;
    }
    __builtin_amdgcn_sched_barrier(0);
    Lb13 = *(const f32x4*)(Lt_s + 3520);
    Lb14 = *(const f32x4*)(Lt_s + 3524);
    Lb15 = *(const f32x4*)(Lt_s + 3528);
    __builtin_amdgcn_sched_barrier(0);
    { const float xj = X25[0]; const f32x2 xj2 = (f32x2){xj, xj};
      X25 -= (f32x2){La12[2], La12[3]} * xj2;
      X26 -= (f32x2){La13[0], La13[1]} * xj2;
      X27 -= (f32x2){La13[2], La13[3]} * xj2;
      X28 -= (f32x2){La14[0], La14[1]} * xj2;
      X29 -= (f32x2){La14[2], La14[3]} * xj2;
      X30 -= (f32x2){La15[0], La15[1]} * xj2;
      X31 -= (f32x2){La15[2], La15[3]} * xj2;
    }
    __builtin_amdgcn_sched_barrier(0);
    La13 = *(const f32x4*)(Lt_s + 3588);
    La14 = *(const f32x4*)(Lt_s + 3592);
    La15 = *(const f32x4*)(Lt_s + 3596);
    __builtin_amdgcn_sched_barrier(0);
    { const float xj = X25[1]; const f32x2 xj2 = (f32x2){xj, xj};
      X26 -= (f32x2){Lb13[0], Lb13[1]} * xj2;
      X27 -= (f32x2){Lb13[2], Lb13[3]} * xj2;
      X28 -= (f32x2){Lb14[0], Lb14[1]} * xj2;
      X29 -= (f32x2){Lb14[2], Lb14[3]} * xj2;
      X30 -= (f32x2){Lb15[0], Lb15[1]} * xj2;
      X31 -= (f32x2){Lb15[2], Lb15[3]} * xj2;
    }
    __builtin_amdgcn_sched_barrier(0);
    Lb13 = *(const f32x4*)(Lt_s + 3656);
    Lb14 = *(const f32x4*)(Lt_s + 3660);
    Lb15 = *(const f32x4*)(Lt_s + 3664);
    __builtin_amdgcn_sched_barrier(0);
    { const float xj = X26[0]; const f32x2 xj2 = (f32x2){xj, xj};
      X26 -= (f32x2){La13[0], La13[1]} * xj2;
      X27 -= (f32x2){La13[2], La13[3]} * xj2;
      X28 -= (f32x2){La14[0], La14[1]} * xj2;
      X29 -= (f32x2){La14[2], La14[3]} * xj2;
      X30 -= (f32x2){La15[0], La15[1]} * xj2;
      X31 -= (f32x2){La15[2], La15[3]} * xj2;
    }
    __builtin_amdgcn_sched_barrier(0);
    La13 = *(const f32x4*)(Lt_s + 3724);
    La14 = *(const f32x4*)(Lt_s + 3728);
    La15 = *(const f32x4*)(Lt_s + 3732);
    __builtin_amdgcn_sched_barrier(0);
    { const float xj = X26[1]; const f32x2 xj2 = (f32x2){xj, xj};
      X27 -= (f32x2){Lb13[2], Lb13[3]} * xj2;
      X28 -= (f32x2){Lb14[0], Lb14[1]} * xj2;
      X29 -= (f32x2){Lb14[2], Lb14[3]} * xj2;
      X30 -= (f32x2){Lb15[0], Lb15[1]} * xj2;
      X31 -= (f32x2){Lb15[2], Lb15[3]} * xj2;
    }
    __builtin_amdgcn_sched_barrier(0);
    Lb14 = *(const f32x4*)(Lt_s + 3796);
    Lb15 = *(const f32x4*)(Lt_s + 3800);
    __builtin_amdgcn_sched_barrier(0);
    { const float xj = X27[0]; const f32x2 xj2 = (f32x2){xj, xj};
      X27 -= (f32x2){La13[2], La13[3]} * xj2;
      X28 -= (f32x2){La14[0], La14[1]} * xj2;
      X29 -= (f32x2){La14[2], La14[3]} * xj2;
      X30 -= (f32x2){La15[0], La15[1]} * xj2;
      X31 -= (f32x2){La15[2], La15[3]} * xj2;
    }
    __builtin_amdgcn_sched_barrier(0);
    La14 = *(const f32x4*)(Lt_s + 3864);
    La15 = *(const f32x4*)(Lt_s + 3868);
    __builtin_amdgcn_sched_barrier(0);
    { const float xj = X27[1]; const f32x2 xj2 = (f32x2){xj, xj};
      X28 -= (f32x2){Lb14[0], Lb14[1]} * xj2;
      X29 -= (f32x2){Lb14[2], Lb14[3]} * xj2;
      X30 -= (f32x2){Lb15[0], Lb15[1]} * xj2;
      X31 -= (f32x2){Lb15[2], Lb15[3]} * xj2;
    }
    __builtin_amdgcn_sched_barrier(0);
    Lb14 = *(const f32x4*)(Lt_s + 3932);
    Lb15 = *(const f32x4*)(Lt_s + 3936);
    __builtin_amdgcn_sched_barrier(0);
    { const float xj = X28[0]; const f32x2 xj2 = (f32x2){xj, xj};
      X28 -= (f32x2){La14[0], La14[1]} * xj2;
      X29 -= (f32x2){La14[2], La14[3]} * xj2;
      X30 -= (f32x2){La15[0], La15[1]} * xj2;
      X31 -= (f32x2){La15[2], La15[3]} * xj2;
    }
    __builtin_amdgcn_sched_barrier(0);
    La14 = *(const f32x4*)(Lt_s + 4000);
    La15 = *(const f32x4*)(Lt_s + 4004);
    __builtin_amdgcn_sched_barrier(0);
    { const float xj = X28[1]; const f32x2 xj2 = (f32x2){xj, xj};
      X29 -= (f32x2){Lb14[2], Lb14[3]} * xj2;
      X30 -= (f32x2){Lb15[0], Lb15[1]} * xj2;
      X31 -= (f32x2){Lb15[2], Lb15[3]} * xj2;
    }
    __builtin_amdgcn_sched_barrier(0);
    Lb15 = *(const f32x4*)(Lt_s + 4072);
    __builtin_amdgcn_sched_barrier(0);
    { const float xj = X29[0]; const f32x2 xj2 = (f32x2){xj, xj};
      X29 -= (f32x2){La14[2], La14[3]} * xj2;
      X30 -= (f32x2){La15[0], La15[1]} * xj2;
      X31 -= (f32x2){La15[2], La15[3]} * xj2;
    }
    __builtin_amdgcn_sched_barrier(0);
    La15 = *(const f32x4*)(Lt_s + 4140);
    __builtin_amdgcn_sched_barrier(0);
    { const float xj = X29[1]; const f32x2 xj2 = (f32x2){xj, xj};
      X30 -= (f32x2){Lb15[0], Lb15[1]} * xj2;
      X31 -= (f32x2){Lb15[2], Lb15[3]} * xj2;
    }
    __builtin_amdgcn_sched_barrier(0);
    Lb15 = *(const f32x4*)(Lt_s + 4208);
    __builtin_amdgcn_sched_barrier(0);
    { const float xj = X30[0]; const f32x2 xj2 = (f32x2){xj, xj};
      X30 -= (f32x2){La15[0], La15[1]} * xj2;
      X31 -= (f32x2){La15[2], La15[3]} * xj2;
    }
    __builtin_amdgcn_sched_barrier(0);
    La15 = *(const f32x4*)(Lt_s + 4276);
    __builtin_amdgcn_sched_barrier(0);
    { const float xj = X30[1]; const f32x2 xj2 = (f32x2){xj, xj};
      X31 -= (f32x2){Lb15[2], Lb15[3]} * xj2;
    }
    __builtin_amdgcn_sched_barrier(0);
    __builtin_amdgcn_sched_barrier(0);
    { const float xj = X31[0]; const f32x2 xj2 = (f32x2){xj, xj};
      X31 -= (f32x2){La15[2], La15[3]} * xj2;
    }
    __builtin_amdgcn_sched_barrier(0);
    __syncthreads();
    outp[0] = f2bf(sg * X0[0]);
    outp[136] = f2bf(sg * X0[1]);
    outp[272] = f2bf(sg * X1[0]);
    outp[408] = f2bf(sg * X1[1]);
    outp[544] = f2bf(sg * X2[0]);
    outp[680] = f2bf(sg * X2[1]);
    outp[816] = f2bf(sg * X3[0]);
    outp[952] = f2bf(sg * X3[1]);
    outp[1088] = f2bf(sg * X4[0]);
    outp[1224] = f2bf(sg * X4[1]);
    outp[1360] = f2bf(sg * X5[0]);
    outp[1496] = f2bf(sg * X5[1]);
    outp[1632] = f2bf(sg * X6[0]);
    outp[1768] = f2bf(sg * X6[1]);
    outp[1904] = f2bf(sg * X7[0]);
    outp[2040] = f2bf(sg * X7[1]);
    outp[2176] = f2bf(sg * X8[0]);
    outp[2312] = f2bf(sg * X8[1]);
    outp[2448] = f2bf(sg * X9[0]);
    outp[2584] = f2bf(sg * X9[1]);
    outp[2720] = f2bf(sg * X10[0]);
    outp[2856] = f2bf(sg * X10[1]);
    outp[2992] = f2bf(sg * X11[0]);
    outp[3128] = f2bf(sg * X11[1]);
    outp[3264] = f2bf(sg * X12[0]);
    outp[3400] = f2bf(sg * X12[1]);
    outp[3536] = f2bf(sg * X13[0]);
    outp[3672] = f2bf(sg * X13[1]);
    outp[3808] = f2bf(sg * X14[0]);
    outp[3944] = f2bf(sg * X14[1]);
    outp[4080] = f2bf(sg * X15[0]);
    outp[4216] = f2bf(sg * X15[1]);
    outp[4352] = f2bf(sg * X16[0]);
    outp[4488] = f2bf(sg * X16[1]);
    outp[4624] = f2bf(sg * X17[0]);
    outp[4760] = f2bf(sg * X17[1]);
    outp[4896] = f2bf(sg * X18[0]);
    outp[5032] = f2bf(sg * X18[1]);
    outp[5168] = f2bf(sg * X19[0]);
    outp[5304] = f2bf(sg * X19[1]);
    outp[5440] = f2bf(sg * X20[0]);
    outp[5576] = f2bf(sg * X20[1]);
    outp[5712] = f2bf(sg * X21[0]);
    outp[5848] = f2bf(sg * X21[1]);
    outp[5984] = f2bf(sg * X22[0]);
    outp[6120] = f2bf(sg * X22[1]);
    outp[6256] = f2bf(sg * X23[0]);
    outp[6392] = f2bf(sg * X23[1]);
    outp[6528] = f2bf(sg * X24[0]);
    outp[6664] = f2bf(sg * X24[1]);
    outp[6800] = f2bf(sg * X25[0]);
    outp[6936] = f2bf(sg * X25[1]);
    outp[7072] = f2bf(sg * X26[0]);
    outp[7208] = f2bf(sg * X26[1]);
    outp[7344] = f2bf(sg * X27[0]);
    outp[7480] = f2bf(sg * X27[1]);
    outp[7616] = f2bf(sg * X28[0]);
    outp[7752] = f2bf(sg * X28[1]);
    outp[7888] = f2bf(sg * X29[0]);
    outp[8024] = f2bf(sg * X29[1]);
    outp[8160] = f2bf(sg * X30[0]);
    outp[8296] = f2bf(sg * X30[1]);
    outp[8432] = f2bf(sg * X31[0]);
    outp[8568] = f2bf(sg * X31[1]);
}

DEV void dn_item(const Params& p, int l, int item, unsigned char* smem) {
    const int dir = item & 1, hh = (item >> 1) & 3, b = item >> 3;
    bf16_t* q_s = (bf16_t*)(smem);
    bf16_t* k_s = (bf16_t*)(smem + 17408);
    bf16_t* vnT_s = k_s;
    bf16_t* kT_s = (bf16_t*)(smem + 35840);
    bf16_t* v_s = (bf16_t*)(smem + 54272);
    bf16_t* u_s = v_s;
    float* L_s = (float*)(smem + 71680);
    bf16_t* w_s = (bf16_t*)(smem + 71680);
    bf16_t* qk_s = (bf16_t*)(smem + 89088);
    bf16_t* St_s = (bf16_t*)(smem + 98304);
    float* G_s = (float*)(smem + 133120);
    float* beta_s = G_s + 64;
    float* eG_s = G_s + 128;
    float* bw_s = G_s + 192;
    float* cw_s = G_s + 256;
    bf16_t* XT_s = k_s;
    bf16_t* Lb_s = (bf16_t*)(smem + 140288);
    const int tid = get_tid(), lane = tid & 63, wv = tid >> 6, l15 = lane & 15, quad = lane >> 4;
    const float Aneg = -expf(p.in[I_DNALOG][(l * 2 + dir) * 4 + hh]);
    const float dtb = p.in[I_DNDT][(l * 2 + dir) * 4 + hh];
    const bf16_t* P = wsb(p, O_P);
    const float* AB = wsf(p, O_AB);
    bf16_t* TO = wsb(p, dir ? O_TA2 : O_TA);
    __syncthreads();
    for (int e = tid; e < 4 * 384; e += 256) { int j = e / 384, c = e % 384, mat = c >> 7, cc = c & 127; cw_s[e] = p.in[I_DNCONV][((size_t)l * 4 + j) * 1536 + mat * 512 + hh * 128 + cc]; }
    for (int e = tid; e < 128 * 136 / 2; e += 256) ((unsigned*)St_s)[e] = 0u;
    f32x4 Sacc[2][8];
#pragma unroll
    for (int a = 0; a < 2; ++a)
#pragma unroll
        for (int c = 0; c < 8; ++c) Sacc[a][c] = (f32x4){0.f, 0.f, 0.f, 0.f};

    const int rg = tid >> 4, cseg = tid & 15, i0 = rg * 4;
    u32x4 raw[3][7];
    float pf_al = 0.f, pf_bb = 0.f;
#define DN_PREFETCH(NN, M0, M1) { \
        const int c_ = chunk_of(dir, (NN)); const int lo_ = c_ < 4 ? 0 : CTXL, hi_ = c_ < 4 ? CTXL : SB, base_ = c_ * 64; \
        const int slo_ = dir ? base_ + 60 - i0 : base_ + i0; \
        _Pragma("unroll") for (int u = 0; u < 7; ++u) { const int ss_ = slo_ - 1 + u; const bool ok_ = ss_ >= lo_ && ss_ < hi_; \
            const bf16_t* rp_ = P + ((size_t)b * SB + (ok_ ? ss_ : base_)) * PW + hh * 128 + cseg * 8; \
            _Pragma("unroll") for (int mat = (M0); mat < (M1); ++mat) { u32x4 t_ = *(const u32x4*)(rp_ + mat * 512); raw[mat][u] = ok_ ? t_ : (u32x4){0u, 0u, 0u, 0u}; } } \
        if ((M0) == 0) { const int sa_ = dir ? base_ + 63 - lane : base_ + lane; \
        pf_al = AB[((size_t)b * SB + sa_) * 16 + dir * 4 + hh]; pf_bb = AB[((size_t)b * SB + sa_) * 16 + 8 + dir * 4 + hh]; } }
    DN_PREFETCH(0, 0, 3);
    const int wv0_ = wv, l150_ = l15, quad0_ = quad, lane0_ = lane;

#pragma unroll 1
    for (int n = 0; n < 68; ++n) {
        int tz0 = 0; asm volatile("" : "+v"(tz0));
        const int wv = wv0_ + tz0, l15 = l150_ + tz0, quad = quad0_ + tz0, lane = lane0_ + tz0;
        const int c = chunk_of(dir, n);
        const int base = c * 64;
        __syncthreads();
        if (wv == 0) {
            float g = Aneg * softplus_fast(pf_al + dtb);
#pragma unroll
            for (int o = 1; o < 64; o <<= 1) { float t = __shfl_up(g, o); if (lane >= o) g += t; }
            const float eg_ = __expf(g), bt_ = sigm(pf_bb); G_s[lane] = g; beta_s[lane] = bt_; eG_s[lane] = eg_; bw_s[lane] = bt_ * eg_;
        }
        __syncthreads();
        const float Glast = G_s[63];
        {
            int tz = 0; asm volatile("" : "+v"(tz));
            const int i0l = i0 + tz, csl = cseg + tz;
            float ksc[4];
#pragma unroll
            for (int m = 0; m < 4; ++m) ksc[m] = __expf(Glast - G_s[i0l + m]);
#pragma unroll
            for (int mat = 0; mat < 3; ++mat) {
                float w[4][8];
#pragma unroll
                for (int j = 0; j < 4; ++j) { const f32x4 w0 = *(const f32x4*)(cw_s + j * 384 + mat * 128 + csl * 8), w1 = *(const f32x4*)(cw_s + j * 384 + mat * 128 + csl * 8 + 4);
#pragma unroll
                    for (int e = 0; e < 4; ++e) { w[j][e] = w0[e]; w[j][4 + e] = w1[e]; } }
                float v[4][8];
#pragma unroll
                for (int t = 0; t < 4; ++t)
#pragma unroll
                    for (int e = 0; e < 8; ++e) v[t][e] = 0.f;
#pragma unroll
                for (int u = 0; u < 7; ++u) {
                    float x[8];
#pragma unroll
                    for (int e = 0; e < 4; ++e) { x[2 * e] = lo16(raw[mat][u][e]); x[2 * e + 1] = hi16(raw[mat][u][e]); }
#pragma unroll
                    for (int t = 0; t < 4; ++t) { const int j = u - t; if (j >= 0 && j < 4) {
#pragma unroll
                        for (int e = 0; e < 8; ++e) v[t][e] += w[j][e] * x[e]; } }
                }
                float sc[4];
#pragma unroll
                for (int t = 0; t < 4; ++t) {
                    float ss2 = 0.f;
#pragma unroll
                    for (int e = 0; e < 8; ++e) { v[t][e] = silu(v[t][e]); ss2 += v[t][e] * v[t][e]; }
                    if (mat < 2) { ss2 += __shfl_xor(ss2, 1); ss2 += __shfl_xor(ss2, 2); ss2 += __shfl_xor(ss2, 4); ss2 += __shfl_xor(ss2, 8); }
                    sc[t] = mat == 0 ? rsqrtf(ss2 + 1e-6f) * 0.08838834764831845f : (mat == 1 ? rsqrtf(ss2 + 1e-6f) : 1.f);
                }
                bf16_t* dst = mat == 0 ? q_s : (mat == 1 ? k_s : v_s);
#pragma unroll
                for (int t = 0; t < 4; ++t) {
                    const int it_ = dir ? i0l + 3 - t : i0l + t;
                    u32x4 o;
#pragma unroll
                    for (int e = 0; e < 4; ++e) o[e] = pack2(v[t][2 * e] * sc[t], v[t][2 * e + 1] * sc[t]);
                    *(u32x4*)(dst + it_ * 136 + csl * 8) = o;
                }
                if (mat == 1) {
#pragma unroll
                    for (int e = 0; e < 8; ++e) {
                        const float k0 = v[dir ? 3 : 0][e] * sc[dir ? 3 : 0] * ksc[0], k1 = v[dir ? 2 : 1][e] * sc[dir ? 2 : 1] * ksc[1];
                        const float k2 = v[dir ? 1 : 2][e] * sc[dir ? 1 : 2] * ksc[2], k3 = v[dir ? 0 : 3][e] * sc[dir ? 0 : 3] * ksc[3];
                        u32x2 o; o.x = pack2(k0, k1); o.y = pack2(k2, k3);
                        *(u32x2*)(kT_s + (csl * 8 + e) * 72 + i0l) = o;
                    }
                }
            }
        }
        __syncthreads();
        {
            bf16x8 ak[4], aq[4];
#pragma unroll
            for (int ks = 0; ks < 4; ++ks) { ak[ks] = *(const bf16x8*)(k_s + (wv * 16 + l15) * 136 + ks * 32 + quad * 8); aq[ks] = *(const bf16x8*)(q_s + (wv * 16 + l15) * 136 + ks * 32 + quad * 8); }
#pragma unroll
            for (int nt = 0; nt < 4; ++nt) {
                f32x4 kk = {0.f, 0.f, 0.f, 0.f}, qq = {0.f, 0.f, 0.f, 0.f};
#pragma unroll
                for (int ks = 0; ks < 4; ++ks) { bf16x8 bk = *(const bf16x8*)(k_s + (nt * 16 + l15) * 136 + ks * 32 + quad * 8); kk = mfma16(ak[ks], bk, kk); qq = mfma16(aq[ks], bk, qq); }
                const int jj = nt * 16 + l15; const float Gj = G_s[jj];
                f32x4 lv;
#pragma unroll
                for (int j = 0; j < 4; ++j) {
                    const int i = wv * 16 + quad * 4 + j;
                    const float dec = jj <= i ? __expf(G_s[i] - Gj) : 0.f;
                    lv[j] = jj < i ? beta_s[i] * kk[j] * dec : 0.f;
                    qk_s[i * 72 + jj] = f2bf(qq[j] * dec);
                }
                *(f32x4*)(L_s + jj * 68 + wv * 16 + quad * 4) = lv;
                if (wv >= 2 && nt < 2) {
#pragma unroll
                    for (int j = 0; j < 4; ++j) Lb_s[(wv * 16 - 32 + quad * 4 + j) * 40 + jj] = f2bf(lv[j]);
                }
            }
        }
        __syncthreads();
        dn_solve(L_s, tid < 128 ? (k_s + tid) : (v_s + (tid - 128)), tid < 128 ? bw_s : beta_s, tid < 128 ? -1.f : 1.f, tid < 128 ? (w_s + tid) : (u_s + (tid - 128)), XT_s, Lb_s, tid, wv, l15, quad);
        __syncthreads();
        {
            f32x4 vn[8], o1[8];
#pragma unroll
            for (int nt = 0; nt < 8; ++nt) {
#pragma unroll
                for (int j = 0; j < 4; ++j) vn[nt][j] = bf2f(u_s[(wv * 16 + quad * 4 + j) * 136 + nt * 16 + l15]);
                o1[nt] = (f32x4){0.f, 0.f, 0.f, 0.f};
            }
            bf16x8 aw[4], aq[4];
#pragma unroll
            for (int ks = 0; ks < 4; ++ks) { aw[ks] = *(const bf16x8*)(w_s + (wv * 16 + l15) * 136 + ks * 32 + quad * 8); aq[ks] = *(const bf16x8*)(q_s + (wv * 16 + l15) * 136 + ks * 32 + quad * 8); }
#pragma unroll
            for (int nt = 0; nt < 8; ++nt)
#pragma unroll
                for (int ks = 0; ks < 4; ++ks) { bf16x8 bs = *(const bf16x8*)(St_s + (nt * 16 + l15) * 136 + ks * 32 + quad * 8); vn[nt] = mfma16(aw[ks], bs, vn[nt]); o1[nt] = mfma16(aq[ks], bs, o1[nt]); }
#pragma unroll
            for (int nt = 0; nt < 8; ++nt) { u32x2 o; o.x = pack2(vn[nt][0], vn[nt][1]); o.y = pack2(vn[nt][2], vn[nt][3]); *(u32x2*)(vnT_s + (nt * 16 + l15) * 72 + wv * 16 + quad * 4) = o; }
            __syncthreads();
            if (n + 1 < 68) DN_PREFETCH(n + 1, 0, 2);
            float eg[4];
#pragma unroll
            for (int j = 0; j < 4; ++j) eg[j] = eG_s[wv * 16 + quad * 4 + j];
            bf16x8 aqk[2], akt[2][2];
#pragma unroll
            for (int ks = 0; ks < 2; ++ks) {
                aqk[ks] = *(const bf16x8*)(qk_s + (wv * 16 + l15) * 72 + ks * 32 + quad * 8);
                akt[0][ks] = *(const bf16x8*)(kT_s + (wv * 32 + l15) * 72 + ks * 32 + quad * 8);
                akt[1][ks] = *(const bf16x8*)(kT_s + (wv * 32 + 16 + l15) * 72 + ks * 32 + quad * 8);
            }
            const float gend = eG_s[63];
            const size_t orow0 = (size_t)b * SB;
#pragma unroll
            for (int nt = 0; nt < 8; ++nt) {
                f32x4 o;
#pragma unroll
                for (int j = 0; j < 4; ++j) { o[j] = o1[nt][j] * eg[j]; Sacc[0][nt][j] *= gend; Sacc[1][nt][j] *= gend; }
#pragma unroll
                for (int ks = 0; ks < 2; ++ks) {
                    bf16x8 bv = *(const bf16x8*)(vnT_s + (nt * 16 + l15) * 72 + ks * 32 + quad * 8);
                    o = mfma16(aqk[ks], bv, o);
                    Sacc[0][nt] = mfma16(akt[0][ks], bv, Sacc[0][nt]);
                    Sacc[1][nt] = mfma16(akt[1][ks], bv, Sacc[1][nt]);
                }
#pragma unroll
                for (int j = 0; j < 4; ++j) {
                    const int i = wv * 16 + quad * 4 + j;
                    const int s = dir ? base + 63 - i : base + i;
                    TO[(orow0 + s) * 512 + hh * 128 + nt * 16 + l15] = f2bf(o[j]);
                }
#pragma unroll
                for (int mt = 0; mt < 2; ++mt) { u32x2 sv; sv.x = pack2(Sacc[mt][nt][0], Sacc[mt][nt][1]); sv.y = pack2(Sacc[mt][nt][2], Sacc[mt][nt][3]);
                    *(u32x2*)(St_s + (nt * 16 + l15) * 136 + wv * 32 + mt * 16 + quad * 4) = sv; }
            }
        }
        if (n + 1 < 68) DN_PREFETCH(n + 1, 2, 3);
    }
}

#undef DN_PREFETCH
DEV void lru_item(const Params& p, int l, int item, unsigned char* smem) {
    const int g = item & 7, b = item >> 3;
    bf16_t* Wt_s = (bf16_t*)smem;
    bf16_t* xbh_s = Wt_s + 2 * 128 * 72;
    float* xbf_s = (float*)(smem + 36864 + 18432);
    float* a_s = xbf_s + 2 * 64 * 65;
    float* cw_s = a_s + 2 * 64 * 65;
    const int tid = get_tid(), lane = tid & 63, wv = tid >> 6, l15 = lane & 15, quad = lane >> 4;
    bf16_t* P = wsb(p, O_P);
    bf16_t* HF = wsb(p, O_U);
    __syncthreads();
    for (int e = tid; e < 320; e += 256) cw_s[e] = e < 256 ? p.in[I_LCW][((size_t)l * 4 + (e >> 6)) * 512 + g * 64 + (e & 63)] : p.in[I_LCB][l * 512 + g * 64 + (e - 256)];
    for (int e = tid; e < 2 * 4096; e += 256) {
        const int d = e >> 12, ch = (e >> 6) & 63, j = e & 63;
        const size_t wi_ = (((size_t)l * 2 + d) * 8 + g) * 4096 + ch * 64 + j;
        Wt_s[(d * 128 + j) * 72 + ch] = f2bf(p.in[I_LWA][wi_]);
        Wt_s[(d * 128 + 64 + j) * 72 + ch] = f2bf(p.in[I_LWI][wi_]);
    }
    float ba_[2][4], bi_[2][4], sp_[2][4];
#pragma unroll
    for (int d = 0; d < 2; ++d)
#pragma unroll
        for (int nt = 0; nt < 4; ++nt) {
            const int ch = (l * 2 + d) * 512 + g * 64 + nt * 16 + l15;
            ba_[d][nt] = p.in[I_LBA][ch]; bi_[d][nt] = p.in[I_LBI][ch]; sp_[d][nt] = softplus(-p.in[I_LLAM][ch]);
        }
    float hc = 0.f;
    const int i = tid >> 2, seg = tid & 3, j0 = seg * 16;
#pragma unroll 1
    for (int n = 0; n < 68; ++n) {
        const int cf = n, cb = chunk_of(1, n);
        __syncthreads();
#pragma unroll
        for (int d = 0; d < 2; ++d) {
            const int c = d ? cb : cf;
            const int seg_lo = c < 4 ? 0 : CTXL, seg_hi = c < 4 ? CTXL : SB;
            const int s = d ? c * 64 + 63 - i : c * 64 + i;
            float v[16];
#pragma unroll
            for (int e = 0; e < 16; ++e) v[e] = cw_s[256 + j0 + e];
#pragma unroll
            for (int j = 0; j < 4; ++j) {
                const int ss = s + j - 1;
                if (ss >= seg_lo && ss < seg_hi) {
                    const u32x4* src = (const u32x4*)(P + ((size_t)b * SB + ss) * PW + C_LX + g * 64 + j0);
                    const float* cw = cw_s + j * 64 + j0;
#pragma unroll
                    for (int q = 0; q < 2; ++q) { u32x4 x = src[q];
#pragma unroll
                        for (int e = 0; e < 4; ++e) { v[q * 8 + 2 * e] += cw[q * 8 + 2 * e] * lo16(x[e]); v[q * 8 + 2 * e + 1] += cw[q * 8 + 2 * e + 1] * hi16(x[e]); } }
                }
            }
            u32x4 h0, h1;
#pragma unroll
            for (int e = 0; e < 4; ++e) { h0[e] = pack2(v[2 * e], v[2 * e + 1]); h1[e] = pack2(v[8 + 2 * e], v[8 + 2 * e + 1]); }
            *(u32x4*)(xbh_s + (d * 64 + i) * 72 + j0) = h0; *(u32x4*)(xbh_s + (d * 64 + i) * 72 + j0 + 8) = h1;
#pragma unroll
            for (int e = 0; e < 16; ++e) xbf_s[(d * 64 + i) * 65 + j0 + e] = v[e];
        }
        __syncthreads();
#pragma unroll
        for (int d = 0; d < 2; ++d) {
            f32x4 acc[8];
#pragma unroll
            for (int nt = 0; nt < 8; ++nt) acc[nt] = (f32x4){0.f, 0.f, 0.f, 0.f};
            bf16x8 af[2];
#pragma unroll
            for (int ks = 0; ks < 2; ++ks) af[ks] = *(const bf16x8*)(xbh_s + (d * 64 + wv * 16 + l15) * 72 + ks * 32 + quad * 8);
#pragma unroll
            for (int nt = 0; nt < 8; ++nt)
#pragma unroll
                for (int ks = 0; ks < 2; ++ks) { bf16x8 bw = *(const bf16x8*)(Wt_s + (d * 128 + nt * 16 + l15) * 72 + ks * 32 + quad * 8); acc[nt] = mfma16(af[ks], bw, acc[nt]); }
#pragma unroll
            for (int nt = 0; nt < 4; ++nt)
#pragma unroll
                for (int jj = 0; jj < 4; ++jj) {
                    const int idx = (d * 64 + wv * 16 + quad * 4 + jj) * 65 + nt * 16 + l15;
                    const float r = sigm(acc[nt][jj] + ba_[d][nt]), ig = sigm(acc[nt + 4][jj] + bi_[d][nt]);
                    const float la = -8.f * r * sp_[d][nt];
                    a_s[idx] = __expf(la);
                    xbf_s[idx] = __builtin_amdgcn_sqrtf(fmaxf(1.f - __expf(2.f * la), 0.f)) * (ig * xbf_s[idx]);
                }
        }
        __syncthreads();
        if (wv < 2) {
            const int o = wv * 64 * 65 + lane;
#pragma unroll 16
            for (int r = 0; r < 64; ++r) { hc = a_s[o + r * 65] * hc + xbf_s[o + r * 65]; xbf_s[o + r * 65] = hc; }
        }
        __syncthreads();
#pragma unroll
        for (int d = 0; d < 2; ++d) {
            const int c = d ? cb : cf;
            const int s = d ? c * 64 + 63 - i : c * 64 + i;
            const bool second = d ? (cb < n) : ((cf < 4 ? 3 - cf : 71 - cf) < n);
            const size_t row = (size_t)b * SB + s;
            const float* hp = xbf_s + (d * 64 + i) * 65 + j0;
            bf16_t* hf = HF + row * 512 + g * 64 + j0;
            if (!second) {
                u32x4 o0, o1;
#pragma unroll
                for (int e = 0; e < 4; ++e) { o0[e] = pack2(hp[2 * e], hp[2 * e + 1]); o1[e] = pack2(hp[8 + 2 * e], hp[8 + 2 * e + 1]); }
                *(u32x4*)hf = o0; *(u32x4*)(hf + 8) = o1;
            } else {
                bf16_t* gp = P + row * PW + C_LG + g * 64 + j0;
                u32x4 f0 = *(const u32x4*)hf, f1 = *(const u32x4*)(hf + 8), g0 = *(const u32x4*)gp, g1 = *(const u32x4*)(gp + 8), o0, o1;
#pragma unroll
                for (int e = 0; e < 4; ++e) {
                    o0[e] = pack2((lo16(f0[e]) + hp[2 * e]) * gelu_tanh(lo16(g0[e])), (hi16(f0[e]) + hp[2 * e + 1]) * gelu_tanh(hi16(g0[e])));
                    o1[e] = pack2((lo16(f1[e]) + hp[8 + 2 * e]) * gelu_tanh(lo16(g1[e])), (hi16(f1[e]) + hp[8 + 2 * e + 1]) * gelu_tanh(hi16(g1[e])));
                }
                *(u32x4*)gp = o0; *(u32x4*)(gp + 8) = o1;
            }
        }
    }
}

DEV void att_item(const Params& p, int l, int b, int h, int qt, float lam_init, unsigned char* smem) {
    bf16_t* K_s = (bf16_t*)smem;
    bf16_t* V_s = (bf16_t*)(smem + 2 * 17408);
    const int tid = get_tid(), lane = tid & 63, wv = tid >> 6, l15 = lane & 15, quad = lane >> 4;
    bf16_t* P = wsb(p, O_P);
    const bf16_t* VT = wsb(p, O_VT) + (size_t)(b * 4 + h) * 128 * SB;
    const int nt_keys = (qt < 2 ? CTXL : SB) / 64;
    float lam;
    {
        const float* lv = p.in[I_DALAM] + l * 256;
        float s1 = lv[lane] * lv[64 + lane], s2 = lv[128 + lane] * lv[192 + lane];
#pragma unroll
        for (int o = 32; o >= 1; o >>= 1) { s1 += __shfl_xor(s1, o); s2 += __shfl_xor(s2, o); }
        lam = expf(s1) - expf(s2) + lam_init;
    }
    bf16x8* Qst = (bf16x8*)(smem + 71680) + (wv * 8) * 64 + lane;
#pragma unroll
    for (int qg = 0; qg < 2; ++qg) {
        const bf16_t* qp = P + ((size_t)b * SB + qt * 128 + wv * 32 + qg * 16 + l15) * PW + C_DAQ + h * 128;
#pragma unroll
        for (int wh = 0; wh < 2; ++wh)
#pragma unroll
            for (int ks = 0; ks < 2; ++ks) Qst[(wh * 4 + qg * 2 + ks) * 64] = *(const bf16x8*)(qp + wh * 64 + ks * 32 + quad * 8);
    }
    f32x4 O[2][8][2];
    float mrun[2][2], lrun[2][2];
#pragma unroll
    for (int wh = 0; wh < 2; ++wh)
#pragma unroll
        for (int qg = 0; qg < 2; ++qg) { mrun[wh][qg] = -1e30f; lrun[wh][qg] = 0.f;
#pragma unroll
            for (int dg = 0; dg < 8; ++dg) O[wh][dg][qg] = (f32x4){0.f, 0.f, 0.f, 0.f}; }
    const int kr = tid >> 2, kseg = (tid & 3) * 32;
    const int kpos = ((kr >> 5) * 2 + ((kr & 7) >> 2)) * 16 + ((kr & 31) >> 3) * 4 + (kr & 3);
    const bf16_t* kg_ = P + ((size_t)b * SB + kr) * PW + C_DAK + h * 128 + kseg;
    const int vr = tid >> 1, vh = (tid & 1) * 32;
    const bf16_t* vg_ = VT + (size_t)vr * SB + vh;
    u32x4 kreg[4], vreg[4];
#pragma unroll
    for (int i = 0; i < 4; ++i) { kreg[i] = *(const u32x4*)(kg_ + i * 8); vreg[i] = *(const u32x4*)(vg_ + i * 8); }
    __syncthreads();
#pragma unroll
    for (int i = 0; i < 4; ++i) { *(u32x4*)(K_s + kpos * 136 + kseg + i * 8) = kreg[i]; *(u32x4*)(V_s + vr * 72 + vh + i * 8) = vreg[i]; }
    __syncthreads();
    const float L2E = 1.4426950408889634f;
#pragma unroll 1
    for (int t = 0; t < nt_keys; ++t) {
        const bf16_t* Kb = K_s + (t & 1) * (64 * 136);
        const bf16_t* Vb = V_s + (t & 1) * (128 * 72);
        if (t + 1 < nt_keys) {
#pragma unroll
            for (int i = 0; i < 4; ++i) { kreg[i] = *(const u32x4*)(kg_ + (size_t)(t + 1) * 64 * PW + i * 8); vreg[i] = *(const u32x4*)(vg_ + (t + 1) * 64 + i * 8); }
        }
#pragma unroll
        for (int wh = 0; wh < 2; ++wh) {
            f32x4 S[4][2];
#pragma unroll
            for (int kg = 0; kg < 4; ++kg) { S[kg][0] = (f32x4){0.f, 0.f, 0.f, 0.f}; S[kg][1] = (f32x4){0.f, 0.f, 0.f, 0.f}; }
#pragma unroll
            for (int ks = 0; ks < 2; ++ks)
#pragma unroll
                for (int kg = 0; kg < 4; ++kg) {
                    bf16x8 kf = *(const bf16x8*)(Kb + (kg * 16 + l15) * 136 + wh * 64 + ks * 32 + quad * 8);
                    S[kg][0] = mfma16(kf, Qst[(wh * 4 + 0 + ks) * 64], S[kg][0]);
                    S[kg][1] = mfma16(kf, Qst[(wh * 4 + 2 + ks) * 64], S[kg][1]);
                }
            bf16x8 Pf[2][2];
#pragma unroll
            for (int qg = 0; qg < 2; ++qg) {
                float mx = -1e30f;
#pragma unroll
                for (int kg = 0; kg < 4; ++kg)
#pragma unroll
                    for (int j = 0; j < 4; ++j) mx = fmaxf(mx, S[kg][qg][j]);
                mx = fmaxf(mx, __shfl_xor(mx, 16)); mx = fmaxf(mx, __shfl_xor(mx, 32));
                mx *= L2E;
                if (__builtin_amdgcn_ballot_w64(mx > mrun[wh][qg] + 8.f) != 0ull) {
                    const float mnew = fmaxf(mrun[wh][qg], mx);
                    const float alpha = __builtin_amdgcn_exp2f(mrun[wh][qg] - mnew);
                    mrun[wh][qg] = mnew;
                    lrun[wh][qg] *= alpha;
#pragma unroll
                    for (int dg = 0; dg < 8; ++dg)
#pragma unroll
                        for (int j = 0; j < 4; ++j) O[wh][dg][qg][j] *= alpha;
                }
                const float mref = mrun[wh][qg];
                float ps = 0.f;
#pragma unroll
                for (int kg = 0; kg < 4; ++kg)
#pragma unroll
                    for (int j = 0; j < 4; ++j) { float pv = __builtin_amdgcn_exp2f(S[kg][qg][j] * L2E - mref); ps += pv; S[kg][qg][j] = pv; }
                lrun[wh][qg] += ps;
#pragma unroll
                for (int s_ = 0; s_ < 2; ++s_) {
                    u32x4 pk; pk[0] = pack2(S[2 * s_][qg][0], S[2 * s_][qg][1]); pk[1] = pack2(S[2 * s_][qg][2], S[2 * s_][qg][3]);
                    pk[2] = pack2(S[2 * s_ + 1][qg][0], S[2 * s_ + 1][qg][1]); pk[3] = pack2(S[2 * s_ + 1][qg][2], S[2 * s_ + 1][qg][3]);
                    Pf[qg][s_] = __builtin_bit_cast(bf16x8, pk);
                }
            }
#pragma unroll
            for (int dg = 0; dg < 8; ++dg)
#pragma unroll
                for (int s_ = 0; s_ < 2; ++s_) {
                    bf16x8 vf = *(const bf16x8*)(Vb + (dg * 16 + l15) * 72 + s_ * 32 + quad * 8);
                    O[wh][dg][0] = mfma16(vf, Pf[0][s_], O[wh][dg][0]);
                    O[wh][dg][1] = mfma16(vf, Pf[1][s_], O[wh][dg][1]);
                }
        }
        if (t + 1 < nt_keys) {
            bf16_t* Kn = K_s + ((t + 1) & 1) * (64 * 136); bf16_t* Vn = V_s + ((t + 1) & 1) * (128 * 72);
#pragma unroll
            for (int i = 0; i < 4; ++i) { *(u32x4*)(Kn + kpos * 136 + kseg + i * 8) = kreg[i]; *(u32x4*)(Vn + vr * 72 + vh + i * 8) = vreg[i]; }
        }
        __syncthreads();
    }
    const float* dnw = p.in[I_DANORM] + l * 128;
#pragma unroll
    for (int qg = 0; qg < 2; ++qg) {
        float l1 = lrun[0][qg], l2 = lrun[1][qg];
        l1 += __shfl_xor(l1, 16); l1 += __shfl_xor(l1, 32); l2 += __shfl_xor(l2, 16); l2 += __shfl_xor(l2, 32);
        const float i1 = 1.f / l1, i2 = lam / l2;
        float ss = 0.f;
#pragma unroll
        for (int dg = 0; dg < 8; ++dg)
#pragma unroll
            for (int j = 0; j < 4; ++j) { float o = O[0][dg][qg][j] * i1 - O[1][dg][qg][j] * i2; O[0][dg][qg][j] = o; ss += o * o; }
        ss += __shfl_xor(ss, 16); ss += __shfl_xor(ss, 32);
        const float rstd = rsqrtf(ss * (1.f / 128.f) + 1e-5f) * (1.f - lam_init);
        bf16_t* op = P + ((size_t)b * SB + qt * 128 + wv * 32 + qg * 16 + l15) * PW + C_DAQ + h * 128;
#pragma unroll
        for (int dg = 0; dg < 8; ++dg) {
            const int dv0 = dg * 16 + quad * 4;
            u32x2 o; o.x = pack2(O[0][dg][qg][0] * rstd * dnw[dv0], O[0][dg][qg][1] * rstd * dnw[dv0 + 1]);
            o.y = pack2(O[0][dg][qg][2] * rstd * dnw[dv0 + 2], O[0][dg][qg][3] * rstd * dnw[dv0 + 3]);
            *(u32x2*)(op + dv0) = o;
        }
    }
}

DEV void phase_mix(const Params& p, int l, unsigned char* smem) {
    const bool need_ctx = l == 0;
    const float lam_init = l == 0 ? 0.2f : 0.35550906759096926f;
    unsigned* ctr = (unsigned*)(p.ws + O_CTL) + l;
    unsigned* actr = (unsigned*)(p.ws + O_CTL) + 16 + l * 8;
    __shared__ int s_item;
    const int nqt = need_ctx ? 34 : 32;
    auto next = [&](unsigned* c) -> int {
        __syncthreads();
        if (threadIdx.x == 0) s_item = (int)atomicAdd(c, 1u);
        __syncthreads();
        return __builtin_amdgcn_readfirstlane(s_item);
    };
    int it = next(ctr);
#pragma unroll 1
    while (it < 64) { dn_item(p, l, it, smem); it = next(ctr); }
#pragma unroll 1
    while (it < 128) { lru_item(p, l, it - 64, smem); it = next(ctr); }
    const int myx = blockIdx.x & 7;
#pragma unroll 1
    for (int k = 0; k < 8; ++k) {
        const int x = (myx + k) & 7;
        it = next(actr + x);
#pragma unroll 1
        while (it < 4 * nqt) {
            const int bh = x + 8 * (it / nqt), idx = it % nqt;
            const int qt = idx < 32 ? idx + 2 : idx - 32;
            att_item(p, l, bh >> 2, bh & 3, qt, lam_init, smem);
            it = next(actr + x);
        }
    }
}

#define XB_TMO      128
#define XB_XCNT(j)  (256  + 64 * (j))
#define XB_XSUB(j)  (1280 + 64 * (j))
#define XB_XGEN(j)  (2304 + 64 * (j))
#define XB_TOP      3328
#define XB_TOPGEN   3392
#define XCD_BAR_WORDS 3456
#define XB_SPIN_CAP (1u << 18)
#define LAS __attribute__((address_space(3)))
DEV unsigned xb_ld(unsigned* p)              { return __hip_atomic_load(p, __ATOMIC_RELAXED, __HIP_MEMORY_SCOPE_AGENT); }
DEV unsigned xb_add(unsigned* p, unsigned v) { return __hip_atomic_fetch_add(p, v, __ATOMIC_RELAXED, __HIP_MEMORY_SCOPE_AGENT); }
DEV unsigned xb_xcc_id() { return (unsigned)__builtin_amdgcn_s_getreg((3 << 11) | 20) & 0xFu; }
#define XB_SPIN(cond, bar) do { unsigned _sp = 0; while (cond) { __builtin_amdgcn_s_sleep(1); \
    if ((++_sp & 255u) == 0u) { if (xb_ld(&(bar)[XB_TMO])) break; if (_sp > XB_SPIN_CAP) { atomicAdd(&(bar)[XB_TMO], 1u); break; } } } } while (0)
struct XcdBarrier { unsigned* bar; unsigned x; volatile LAS unsigned* st; };
DEV XcdBarrier xcd_barrier_post(unsigned* bar, volatile LAS unsigned* st) {
    XcdBarrier b; b.bar = bar; b.x = xb_xcc_id(); b.st = st;
    if (threadIdx.x == 0) (void)xb_add(&bar[XB_XCNT(b.x)], 1u);
    return b;
}
DEV void xcd_barrier_complete(unsigned* bar, unsigned x, unsigned& nloc, unsigned& nx) {
    const unsigned G = gridDim.x * gridDim.y * gridDim.z;
    unsigned sum, cnt, mine, sp = 0u;
    for (;;) {
        sum = 0u; cnt = 0u; mine = 0u;
#pragma unroll
        for (unsigned j = 0; j < 16; ++j) { const unsigned c = xb_ld(&bar[XB_XCNT(j)]); sum += c; cnt += (c > 0u) ? 1u : 0u; mine = (j == x) ? c : mine; }
        if (sum == G) break;
        __builtin_amdgcn_s_sleep(1);
        if ((++sp & 255u) == 0u) { if (xb_ld(&bar[XB_TMO])) break; if (sp > XB_SPIN_CAP) { atomicAdd(&bar[XB_TMO], 1u); break; } }
    }
    nloc = mine > 0u ? mine : 1u; nx = cnt > 0u ? cnt : 1u;
}
DEV void xcd_barrier(const XcdBarrier& b) {
    asm volatile("s_waitcnt vmcnt(0)" ::: "memory");
    __syncthreads();
    if (threadIdx.x == 0) {
        unsigned* bar = b.bar;
        __builtin_amdgcn_s_waitcnt(0);
        unsigned nloc = b.st[0], nx = b.st[1];
        if (nloc == 0u) { xcd_barrier_complete(bar, b.x, nloc, nx); b.st[0] = nloc; b.st[1] = nx; }
        const unsigned old = xb_add(&bar[XB_XSUB(b.x)], 1u);
        const unsigned gen = old / nloc;
        if (old + 1u == (gen + 1u) * nloc) {
            __builtin_amdgcn_fence(__ATOMIC_RELEASE, "agent");
            asm volatile("s_waitcnt vmcnt(0)" ::: "memory");
            const unsigned og = xb_add(&bar[XB_TOP], 1u);
            const unsigned tg = og / nx;
            if (og + 1u == (tg + 1u) * nx) xb_add(&bar[XB_TOPGEN], 1u);
            else XB_SPIN(xb_ld(&bar[XB_TOPGEN]) == tg, bar);
            __builtin_amdgcn_fence(__ATOMIC_ACQUIRE, "agent");
            xb_add(&bar[XB_XGEN(b.x)], 1u);
            asm volatile("s_waitcnt vmcnt(0)" ::: "memory");
        } else {
            XB_SPIN(xb_ld(&bar[XB_XGEN(b.x)]) == gen, bar);
            __builtin_amdgcn_fence(__ATOMIC_ACQUIRE, "agent");
            asm volatile("s_waitcnt vmcnt(0)" ::: "memory");
        }
    }
    __syncthreads();
}

constexpr int NPHASE = 1 + 2 * 9 + 1;
DEV void run_phase(const Params& p, int ph, unsigned char* smem) {
    if (ph == 0) { phase_mod(p, smem); phase_rope(p); __syncthreads(); phase_wconv(p, 0, smem); return; }
    if (ph == NPHASE - 1) { phase_final(p); return; }
    const int l = (ph - 1) / 9, q = (ph - 1) % 9;
    const bool first = l == 0, lat = l == 1;
    const bf16_t* W = wsb(p, O_WT);
    switch (q) {
        case 0: if (l == 1) phase_wconv(p, 1, smem); phase_norm(p, l, 0, first, false); break;
        case 1: phase_g1(p, smem); break;
        case 2: phase_mix(p, l, smem); break;
        case 3: phase_fin_norm(p, l, first, lat); break;
        case 4: phase_gate(p, lat, smem); break;
        case 5: phase_resid(p, l, wsb(p, O_U), D, W + W_OUT, 1024, 2, first, lat, smem); break;
        case 6: phase_norm(p, l, 1, false, lat); break;
        case 7: phase_gu(p, lat, smem); break;
        case 8: phase_resid(p, l, wsb(p, O_P), PW, W + W_DN, DFF, 5, false, lat, smem); break;
    }
}

#if MEGA
__global__ void __launch_bounds__(256) mega_kernel(Params p) {
    extern __shared__ __align__(16) unsigned char smem[];
    cg::grid_group grid = cg::this_grid();
    __shared__ uint4 xb_words;
    if (threadIdx.x == 0) xb_words = make_uint4(0u, 0u, 0u, 0u);
    __syncthreads();
    const XcdBarrier xb = xcd_barrier_post((unsigned*)(p.ws + O_BAR), (volatile LAS unsigned*)&xb_words);
    phase_mod(p, smem); phase_rope(p); __syncthreads(); phase_wconv(p, 0, smem);
    grid.sync();
    const bf16_t* W = wsb(p, O_WT);
#pragma unroll
    for (int l = 0; l < 2; ++l) {
        const bool first = l == 0, lat = l == 1;
        if (l == 1) phase_wconv(p, 1, smem);
        phase_norm(p, l, 0, first, false);
        xcd_barrier(xb);
        phase_g1(p, smem);
        xcd_barrier(xb);
        phase_mix(p, l, smem);
        xcd_barrier(xb);
        phase_fin_norm(p, l, first, lat);
        xcd_barrier(xb);
        phase_gate(p, lat, smem);
        xcd_barrier(xb);
        phase_merge(p, lat, smem);
        xcd_barrier(xb);
        phase_resid(p, l, wsb(p, O_U), D, W + W_OUT, 1024, 2, first, lat, smem);
        xcd_barrier(xb);
        phase_norm(p, l, 1, false, lat);
        xcd_barrier(xb);
        phase_gu(p, lat, smem);
        xcd_barrier(xb);
        phase_resid(p, l, wsb(p, O_P), PW, W + W_DN, DFF, 5, false, lat, smem);
        xcd_barrier(xb);
    }
    phase_final(p);
}
#else
__global__ void __launch_bounds__(256) phase_kernel(Params p, int ph) {
    extern __shared__ __align__(16) unsigned char smem[];
    run_phase(p, ph, smem);
}
#endif

extern "C" void kernel_launch(void* const* d_in, const int* in_sizes, int n_in, void* d_out, int out_size, void* d_ws, size_t ws_size, hipStream_t stream) {
    static int grid = 0;
    if (grid == 0) {
        if (n_in != 28 || ws_size < WS_END) { fprintf(stderr, "kernel_launch: unexpected n_in %d or ws_size %zu < %zu\n", n_in, ws_size, (size_t)WS_END); grid = -1; return; }
        int dev = 0, cus = 0, per_cu = 0;
        hipGetDevice(&dev);
        hipDeviceGetAttribute(&cus, hipDeviceAttributeMultiprocessorCount, dev);
#if MEGA
        hipFuncSetAttribute((const void*)mega_kernel, hipFuncAttributeMaxDynamicSharedMemorySize, LDS_BYTES);
        hipOccupancyMaxActiveBlocksPerMultiprocessor(&per_cu, (const void*)mega_kernel, 256, LDS_BYTES);
#else
        hipFuncSetAttribute((const void*)phase_kernel, hipFuncAttributeMaxDynamicSharedMemorySize, LDS_BYTES);
        hipOccupancyMaxActiveBlocksPerMultiprocessor(&per_cu, (const void*)phase_kernel, 256, LDS_BYTES);
#endif
        if (per_cu < 1) per_cu = 1;
        grid = cus * per_cu;
        fprintf(stderr, "kernel_launch: grid %d (%d CUs x %d)\n", grid, cus, per_cu);
    }
    if (grid < 0) return;
    hipMemsetAsync((char*)d_ws + O_CTL, 0, 4096 + 16384, stream);
    Params p{};
    for (int i = 0; i < 28; ++i) p.in[i] = (const float*)d_in[i];
    p.out = (float*)d_out; p.ws = (unsigned char*)d_ws;
#if MEGA
    void* args[] = {&p};
    hipError_t e = hipLaunchCooperativeKernel((const void*)mega_kernel, dim3(grid), dim3(256), args, LDS_BYTES, stream);
    if (e != hipSuccess) fprintf(stderr, "cooperative launch failed: %s (grid %d)\n", hipGetErrorString(e), grid);
#else
    for (int ph = 0; ph < NPHASE; ++ph) hipLaunchKernelGGL(phase_kernel, dim3(grid), dim3(256), LDS_BYTES, stream, p, ph);
#endif
}
```

```cpp
#include <hip/hip_runtime.h>
#include <hip/hip_cooperative_groups.h>
#include <cstdio>
#include <cstdint>
namespace cg = cooperative_groups;

#ifndef MEGA
#define MEGA 1
#endif

typedef unsigned short bf16_t;
typedef short bf16x8 __attribute__((ext_vector_type(8)));
typedef float f32x4 __attribute__((ext_vector_type(4)));
typedef unsigned u32x4 __attribute__((ext_vector_type(4)));
typedef unsigned u32x2 __attribute__((ext_vector_type(2)));
#define DEV __device__ __forceinline__

constexpr int D = 1024, NB = 8, SEQ = 4096, CTXL = 256, SB = 4352, MR = NB * SB, PW = 4096, DFF = 2816;
constexpr int C_DNQ = 0, C_DNK = 512, C_DNV = 1024, C_DNZ = 1536, C_LX = 2048, C_LG = 2560, C_DAQ = 3072, C_DAK = 3584;
constexpr int NIN = 4736;
constexpr int GLD = 80;

enum { I_X = 0, I_C, I_CTX, I_CCTX, I_WMOD, I_BMOD, I_NMIX, I_NFFN, I_WIN, I_DNCONV, I_DNALOG, I_DNDT, I_DNNORM, I_LCW, I_LCB,
       I_LWA, I_LBA, I_LWI, I_LBI, I_LLAM, I_DALAM, I_DANORM, I_WBR, I_WOUT, I_WFG, I_WFU, I_WFD, I_NFIN };

constexpr size_t al256(size_t x) { return (x + 255) & ~(size_t)255; }
constexpr size_t O_CTL = 0;
constexpr size_t O_BAR = 4096;
constexpr size_t O_MOD = 4096 + 16384;
constexpr size_t O_ROPE = al256(O_MOD + (size_t)2 * 9 * 6144 * 4);
constexpr size_t O_WT = al256(O_ROPE + 64 * 16 * 2 * 4);
constexpr size_t W_IN = 0, W_GATE = W_IN + (size_t)NIN * 1024, W_BR = W_GATE + (size_t)3072 * 1024, W_OUT = W_BR + (size_t)3 * 1024 * 512,
                 W_GU = W_OUT + (size_t)1024 * 1024, W_DN = W_GU + (size_t)5632 * 1024, W_END = W_DN + (size_t)1024 * 2816;
constexpr size_t O_HCTX = al256(O_WT + W_END * 2);
constexpr size_t O_U = al256(O_HCTX + (size_t)2048 * 1024 * 4);
constexpr size_t O_P = al256(O_U + (size_t)MR * 1024 * 2);
constexpr size_t O_AB = al256(O_P + (size_t)MR * PW * 2);
constexpr size_t O_TA = al256(O_AB + (size_t)MR * 16 * 4);
constexpr size_t O_TA2 = al256(O_TA + (size_t)MR * 512 * 2);
constexpr size_t O_VT = al256(O_TA2 + (size_t)MR * 512 * 2);
constexpr size_t WS_END = al256(O_VT + (size_t)MR * 512 * 2);

constexpr int LDS_BYTES = 140 * 1024;

struct Params {
    const float* in[28];
    float* out;
    unsigned char* ws;
};

DEV int get_tid() { int t = threadIdx.x; asm volatile("" : "+v"(t)); return t; }
DEV float bf2f(bf16_t h) { return __uint_as_float(((unsigned)h) << 16); }
DEV bf16_t f2bf(float f) { unsigned u = __float_as_uint(f); u += 0x7fffu + ((u >> 16) & 1u); return (bf16_t)(u >> 16); }
typedef float f32x2_ __attribute__((ext_vector_type(2)));
typedef __bf16 bf16x2_ __attribute__((ext_vector_type(2)));
DEV unsigned pack2(float a, float b) { const f32x2_ v = {a, b}; return __builtin_bit_cast(unsigned, __builtin_convertvector(v, bf16x2_)); }
DEV float sigm(float x) { return __builtin_amdgcn_rcpf(1.f + __expf(-x)); }
DEV float silu(float x) { return x * __builtin_amdgcn_rcpf(1.f + __expf(-x)); }
DEV float softplus(float x) { return x > 20.f ? x : log1pf(expf(x)); }
DEV float softplus_fast(float x) { const float e = __expf(x); return x > 15.f ? x : (e < 0.01f ? e * (1.f - e * (0.5f - e * 0.33333333f)) : __logf(1.f + e)); }
DEV float gelu_tanh(float x) { float u = 0.7978845608028654f * (x + 0.044715f * x * x * x); float t = 1.f - 2.f * __builtin_amdgcn_rcpf(1.f + __expf(2.f * u)); return 0.5f * x * (1.f + t); }
DEV f32x4 mfma16(bf16x8 a, bf16x8 b, f32x4 c) { return __builtin_amdgcn_mfma_f32_16x16x32_bf16(a, b, c, 0, 0, 0); }
DEV void mfma16a(f32x4& c, bf16x8 a, bf16x8 b) { asm volatile("v_mfma_f32_16x16x32_bf16 %0, %1, %2, %0" : "+a"(c) : "v"(a), "v"(b)); }
DEV float lo16(unsigned v) { return __uint_as_float(v << 16); }
DEV float hi16(unsigned v) { return __uint_as_float(v & 0xffff0000u); }

DEV bf16_t* wsb(const Params& p, size_t off) { return (bf16_t*)(p.ws + off); }
DEV float* wsf(const Params& p, size_t off) { return (float*)(p.ws + off); }
DEV float* hrow(const Params& p, int r) { int b = r / SB, s = r - b * SB; return s < CTXL ? wsf(p, O_HCTX) + (size_t)(b * CTXL + s) * D : p.out + (size_t)(b * SEQ + s - CTXL) * D; }
DEV const float* xrow(const Params& p, int r) { int b = r / SB, s = r - b * SB; return s < CTXL ? p.in[I_CTX] + (size_t)(b * CTXL + s) * D : p.in[I_X] + (size_t)(b * SEQ + s - CTXL) * D; }
DEV int modrow(int r) { int b = r / SB, s = r - b * SB; return s < CTXL ? 8 : b; }

template <int MT, int NT>
DEV void gemm_core(const bf16_t* __restrict__ A, int lda, const bf16_t* __restrict__ Bt, int ldb, int K, f32x4 (&acc)[MT][NT], bf16_t* smem_) {
    constexpr int SA = 32 * MT * GLD, SBB = 32 * NT * GLD;
    bf16_t* sA = smem_; bf16_t* sB = smem_ + 2 * SA;
    const int tid = get_tid(), lane = tid & 63, wv = tid >> 6, wr = wv >> 1, wc = wv & 1, l15 = lane & 15, quad = lane >> 4;
    const int lr = tid >> 3, lc = (tid & 7) * 8;
    u32x4 ra0[MT], rb0[NT], ra1[MT], rb1[NT];
    const bf16_t* Ap = A + (size_t)lr * lda + lc;
    const bf16_t* Bp = Bt + (size_t)lr * ldb + lc;
    const int nk = K >> 6;
#define GLOAD(RA, RB, KT) { const int ko_ = (KT) * 64; _Pragma("unroll") for (int i = 0; i < MT; ++i) RA[i] = *(const u32x4*)(Ap + (size_t)(32 * i) * lda + ko_); \
                            _Pragma("unroll") for (int i = 0; i < NT; ++i) RB[i] = *(const u32x4*)(Bp + (size_t)(32 * i) * ldb + ko_); }
#define LSTORE(RA, RB, BUF) { _Pragma("unroll") for (int i = 0; i < MT; ++i) *(u32x4*)(sA + (BUF) * SA + (lr + 32 * i) * GLD + lc) = RA[i]; \
                              _Pragma("unroll") for (int i = 0; i < NT; ++i) *(u32x4*)(sB + (BUF) * SBB + (lr + 32 * i) * GLD + lc) = RB[i]; }
#define AFRAG(BUF, MT_, KS) (*(const bf16x8*)(sA + (BUF) * SA + (wr * MT * 16 + (MT_) * 16 + l15) * GLD + (KS) * 32 + quad * 8))
#define HALF(BUFC, RA, RB, BUFS, DO_STORE, DO_LOAD, KT) { \
        bf16x8 bfr[2][NT]; \
        _Pragma("unroll") for (int ks = 0; ks < 2; ++ks) _Pragma("unroll") for (int nt = 0; nt < NT; ++nt) \
            bfr[ks][nt] = *(const bf16x8*)(sB + (BUFC) * SBB + (wc * NT * 16 + nt * 16 + l15) * GLD + ks * 32 + quad * 8); \
        bf16x8 a0 = AFRAG(BUFC, 0, 0), a1 = AFRAG(BUFC, 0, 1); \
        const int ko_ = (KT) * 64; \
        _Pragma("unroll") for (int mt = 0; mt < MT; ++mt) { \
            bf16x8 n0 = a0, n1 = a1; \
            if (DO_STORE) { *(u32x4*)(sA + (BUFS) * SA + (lr + 32 * mt) * GLD + lc) = RA[mt]; } \
            if (DO_LOAD) { RA[mt] = *(const u32x4*)(Ap + (size_t)(32 * mt) * lda + ko_); } \
            _Pragma("unroll") for (int nt = 0; nt < NT; ++nt) mfma16a(acc[mt][nt], bfr[0][nt], a0); \
            if (mt + 1 < MT) { n0 = AFRAG(BUFC, mt + 1, 0); n1 = AFRAG(BUFC, mt + 1, 1); } \
            if (DO_STORE) { if (mt < NT) *(u32x4*)(sB + (BUFS) * SBB + (lr + 32 * mt) * GLD + lc) = RB[mt]; } \
            if (DO_LOAD) { if (mt < NT) RB[mt] = *(const u32x4*)(Bp + (size_t)(32 * mt) * ldb + ko_); } \
            _Pragma("unroll") for (int nt = 0; nt < NT; ++nt) mfma16a(acc[mt][nt], bfr[1][nt], a1); \
            a0 = n0; a1 = n1; \
        } }
    static_assert(NT <= MT, "HALF stages the B pieces alongside the first NT A pieces");
    GLOAD(ra0, rb0, 0);
    GLOAD(ra1, rb1, 1);
    __syncthreads();
    LSTORE(ra0, rb0, 0);
    GLOAD(ra0, rb0, 2);
    __syncthreads();
    int kt = 0;
#pragma unroll 1
    for (; kt + 4 < nk; kt += 2) {
        HALF(0, ra1, rb1, 1, true, true, kt + 3);
        __syncthreads();
        HALF(1, ra0, rb0, 0, true, true, kt + 4);
        __syncthreads();
    }
    HALF(0, ra1, rb1, 1, true, true, kt + 3);
    __syncthreads();
    HALF(1, ra0, rb0, 0, true, false, 0);
    __syncthreads();
    HALF(0, ra1, rb1, 1, true, false, 0);
    __syncthreads();
    HALF(1, ra0, rb0, 0, false, false, 0);
    __syncthreads();
#undef AFRAG
#undef HALF
#undef GLOAD
#undef LSTORE
    static_assert(NT == 4, "the accumulator fence is written for NT == 4");
#pragma unroll
    for (int mt = 0; mt < MT; ++mt) {
        if (mt == 0) asm volatile("s_nop 15\n\ts_nop 15" : "+a"(acc[mt][0]), "+a"(acc[mt][1]), "+a"(acc[mt][2]), "+a"(acc[mt][3]));
        else asm volatile("s_nop 0" : "+a"(acc[mt][0]), "+a"(acc[mt][1]), "+a"(acc[mt][2]), "+a"(acc[mt][3]));
    }
}
template <int MT, int NT>
DEV void gemm_core1(const bf16_t* __restrict__ A, int lda, const bf16_t* __restrict__ Bt, int ldb, int K, f32x4 (&acc)[MT][NT], bf16_t* sA, bf16_t* sB) {
    const int tid = get_tid(), lane = tid & 63, wv = tid >> 6, wr = wv >> 1, wc = wv & 1, l15 = lane & 15, quad = lane >> 4;
    const int lr = tid >> 3, lc = (tid & 7) * 8;
    u32x4 ra[MT], rb[NT];
    const bf16_t* Ap = A + (size_t)lr * lda + lc;
    const bf16_t* Bp = Bt + (size_t)lr * ldb + lc;
#pragma unroll
    for (int i = 0; i < MT; ++i) ra[i] = *(const u32x4*)(Ap + (size_t)(32 * i) * lda);
#pragma unroll
    for (int i = 0; i < NT; ++i) rb[i] = *(const u32x4*)(Bp + (size_t)(32 * i) * ldb);
    const int nk = K >> 6;
    for (int kt = 0; kt < nk; ++kt) {
        __syncthreads();
#pragma unroll
        for (int i = 0; i < MT; ++i) *(u32x4*)(sA + (lr + 32 * i) * GLD + lc) = ra[i];
#pragma unroll
        for (int i = 0; i < NT; ++i) *(u32x4*)(sB + (lr + 32 * i) * GLD + lc) = rb[i];
        __syncthreads();
        if (kt + 1 < nk) {
            const int ko = (kt + 1) * 64;
#pragma unroll
            for (int i = 0; i < MT; ++i) ra[i] = *(const u32x4*)(Ap + (size_t)(32 * i) * lda + ko);
#pragma unroll
            for (int i = 0; i < NT; ++i) rb[i] = *(const u32x4*)(Bp + (size_t)(32 * i) * ldb + ko);
        }
#pragma unroll
        for (int ks = 0; ks < 2; ++ks) {
            bf16x8 af[MT], bfr[NT];
#pragma unroll
            for (int mt = 0; mt < MT; ++mt) af[mt] = *(const bf16x8*)(sA + (wr * MT * 16 + mt * 16 + l15) * GLD + ks * 32 + quad * 8);
#pragma unroll
            for (int nt = 0; nt < NT; ++nt) bfr[nt] = *(const bf16x8*)(sB + (wc * NT * 16 + nt * 16 + l15) * GLD + ks * 32 + quad * 8);
#pragma unroll
            for (int mt = 0; mt < MT; ++mt)
#pragma unroll
                for (int nt = 0; nt < NT; ++nt) mfma16a(acc[mt][nt], bfr[nt], af[mt]);
        }
    }
    static_assert(NT == 4, "the accumulator fence is written for NT == 4");
#pragma unroll
    for (int mt = 0; mt < MT; ++mt) {
        if (mt == 0) asm volatile("s_nop 15\n\ts_nop 15" : "+a"(acc[mt][0]), "+a"(acc[mt][1]), "+a"(acc[mt][2]), "+a"(acc[mt][3]));
        else asm volatile("s_nop 0" : "+a"(acc[mt][0]), "+a"(acc[mt][1]), "+a"(acc[mt][2]), "+a"(acc[mt][3]));
    }
}
template <int MT, int NT>
DEV void zero_acc(f32x4 (&acc)[MT][NT]) {
#pragma unroll
    for (int mt = 0; mt < MT; ++mt)
#pragma unroll
        for (int nt = 0; nt < NT; ++nt) acc[mt][nt] = (f32x4){0.f, 0.f, 0.f, 0.f};
}

DEV void phase_mod(const Params& p, unsigned char* smem) {
    float* s_s = (float*)smem;
    float* red = s_s + 9 * 1024;
    const int tid = get_tid();
    bool loaded = false;
    for (int it = blockIdx.x; it < 2 * 96; it += gridDim.x) {
        if (!loaded) {
            for (int e = tid; e < 9 * 1024; e += 256) { float v = e < 8192 ? p.in[I_C][e] : p.in[I_CCTX][e - 8192]; s_s[e] = silu(v); }
            loaded = true;
        }
        __syncthreads();
        const int l = it / 96, cg_ = it % 96, cq = tid & 63, kq = tid >> 6, col = cg_ * 64 + cq;
        float acc[9];
#pragma unroll
        for (int r = 0; r < 9; ++r) acc[r] = 0.f;
        const float* wp = p.in[I_WMOD] + ((size_t)l * 1024 + kq * 256) * 6144 + col;
#pragma unroll 8
        for (int k = 0; k < 256; ++k) {
            float wv = wp[(size_t)k * 6144];
#pragma unroll
            for (int r = 0; r < 9; ++r) acc[r] += s_s[r * 1024 + kq * 256 + k] * wv;
        }
#pragma unroll
        for (int r = 0; r < 9; ++r) red[(kq * 9 + r) * 64 + cq] = acc[r];
        __syncthreads();
        for (int e = tid; e < 9 * 64; e += 256) {
            int r = e >> 6, c2 = e & 63;
            float v = red[(0 * 9 + r) * 64 + c2] + red[(1 * 9 + r) * 64 + c2] + red[(2 * 9 + r) * 64 + c2] + red[(3 * 9 + r) * 64 + c2];
            wsf(p, O_MOD)[((size_t)l * 9 + r) * 6144 + cg_ * 64 + c2] = v + p.in[I_BMOD][l * 6144 + cg_ * 64 + c2];
        }
        __syncthreads();
    }
}
DEV void phase_rope(const Params& p) {
    if (blockIdx.x == (gridDim.x - 1)) {
        for (int e = threadIdx.x; e < 1024; e += 256) {
            int pos = e >> 4, i = e & 15;
            float inv = powf(10000.f, -(float)i / 16.f);
            float ang = (float)pos * inv;
            float n = rintf(ang * 0.15915494309189535f);
            float r = fmaf(-n, 6.28125f, ang);
            r = fmaf(-n, 1.9353071795864769e-3f, r);
            wsf(p, O_ROPE)[e * 2] = cosf(r);
            wsf(p, O_ROPE)[e * 2 + 1] = sinf(r);
        }
    }
}
DEV void wconv_tile(const float* src0, const float* src1, int lds_, int K, bf16_t* dst, int kind, int kt, int nt, bf16_t* tile) {
    const int tid = get_tid();
    const int kk = tid >> 2, grp = tid & 3;
    const int n0 = nt * 64, k0 = kt * 64;
    const int ng = n0 + grp * 16;
    const float* src = src0; int sc;
    if (kind == 0) { sc = ng < 2048 ? ng : (ng < 4608 ? ng + 16 : (ng < 4624 ? 2048 : -1)); }
    else if (kind == 1) { sc = 4624 + ng; }
    else if (kind == 2) { sc = ng; }
    else { int gd = ng >> 4; src = (gd & 1) ? src1 : src0; sc = (gd >> 1) * 16; }
    __syncthreads();
    if (sc >= 0) {
        const float4* sp = (const float4*)(src + (size_t)(k0 + kk) * lds_ + sc);
#pragma unroll
        for (int q = 0; q < 4; ++q) { float4 v = sp[q]; int e = grp * 16 + q * 4;
            tile[(e + 0) * GLD + kk] = f2bf(v.x); tile[(e + 1) * GLD + kk] = f2bf(v.y); tile[(e + 2) * GLD + kk] = f2bf(v.z); tile[(e + 3) * GLD + kk] = f2bf(v.w); }
    } else {
#pragma unroll
        for (int e = 0; e < 16; ++e) tile[(grp * 16 + e) * GLD + kk] = 0;
    }
    __syncthreads();
    const int n = tid >> 2, kseg = (tid & 3) * 16;
    u32x4 a = *(const u32x4*)(tile + n * GLD + kseg), b = *(const u32x4*)(tile + n * GLD + kseg + 8);
    bf16_t* dp = dst + (size_t)(n0 + n) * K + k0 + kseg;
    *(u32x4*)dp = a; *(u32x4*)(dp + 8) = b;
}
DEV void phase_wconv(const Params& p, int l, unsigned char* smem) {
    bf16_t* tile = (bf16_t*)smem;
    bf16_t* W = wsb(p, O_WT);
    constexpr int T0 = 74 * 16, T1 = T0 + 48 * 16, T2 = T1 + 3 * 16 * 8, T3 = T2 + 16 * 16, T4 = T3 + 88 * 16, T5 = T4 + 16 * 44;
    for (int t = blockIdx.x; t < T5; t += gridDim.x) {
        if (t < T0) { wconv_tile(p.in[I_WIN] + (size_t)l * 1024 * 7696, nullptr, 7696, 1024, W + W_IN, 0, t % 16, t / 16, tile); }
        else if (t < T1) { int u = t - T0; wconv_tile(p.in[I_WIN] + (size_t)l * 1024 * 7696, nullptr, 7696, 1024, W + W_GATE, 1, u % 16, u / 16, tile); }
        else if (t < T2) { int u = t - T1; int n = u / 128, v = u % 128; wconv_tile(p.in[I_WBR] + ((size_t)l * 3 + n) * 512 * 1024, nullptr, 1024, 512, W + W_BR + (size_t)n * 1024 * 512, 2, v % 8, v / 8, tile); }
        else if (t < T3) { int u = t - T2; wconv_tile(p.in[I_WOUT] + (size_t)l * 1024 * 1024, nullptr, 1024, 1024, W + W_OUT, 2, u % 16, u / 16, tile); }
        else if (t < T4) { int u = t - T3; wconv_tile(p.in[I_WFG] + (size_t)l * 1024 * DFF, p.in[I_WFU] + (size_t)l * 1024 * DFF, DFF, 1024, W + W_GU, 3, u % 16, u / 16, tile); }
        else { int u = t - T4; wconv_tile(p.in[I_WFD] + (size_t)l * DFF * 1024, nullptr, 1024, DFF, W + W_DN, 2, u % 44, u / 44, tile); }
    }
}

DEV void norm_row(const Params& p, int l, int which, bool first, int r, int lane) {
    const float* h = first ? xrow(p, r) : hrow(p, r);
    const float* nw = p.in[which ? I_NFFN : I_NMIX] + l * D;
    const float* md = wsf(p, O_MOD) + ((size_t)l * 9 + modrow(r)) * 6144 + (which ? 3 * D : 0);
    float4 v[4]; float ss = 0.f;
#pragma unroll
    for (int i = 0; i < 4; ++i) { v[i] = *(const float4*)(h + i * 256 + lane * 4); ss += v[i].x * v[i].x + v[i].y * v[i].y + v[i].z * v[i].z + v[i].w * v[i].w; }
#pragma unroll
    for (int o = 32; o >= 1; o >>= 1) ss += __shfl_xor(ss, o);
    const float rstd = rsqrtf(ss * (1.f / D) + 1e-6f);
    bf16_t* up = wsb(p, O_U) + (size_t)r * D;
#pragma unroll
    for (int i = 0; i < 4; ++i) {
        const int c = i * 256 + lane * 4;
        float4 w4 = *(const float4*)(nw + c), sh = *(const float4*)(md + c), sc = *(const float4*)(md + D + c);
        float a = v[i].x * rstd * w4.x * (1.f + sc.x) + sh.x, b = v[i].y * rstd * w4.y * (1.f + sc.y) + sh.y;
        float c2 = v[i].z * rstd * w4.z * (1.f + sc.z) + sh.z, d = v[i].w * rstd * w4.w * (1.f + sc.w) + sh.w;
        u32x2 o; o.x = pack2(a, b); o.y = pack2(c2, d);
        *(u32x2*)(up + c) = o;
    }
}
DEV void phase_norm(const Params& p, int l, int which, bool first, bool skip_ctx) {
    const int tid_ = get_tid(); const int lane = tid_ & 63, wv = tid_ >> 6;
    for (int r = blockIdx.x * 4 + wv; r < MR; r += gridDim.x * 4) {
        if (skip_ctx && (r % SB) < CTXL) continue;
        norm_row(p, l, which, first, r, lane);
    }
}
DEV void phase_fin_norm(const Params& p, int l, bool first, bool skip_ctx) {
    const int tid_ = get_tid(); const int lane = tid_ & 63, wv = tid_ >> 6;
    const float* dnn = p.in[I_DNNORM] + l * 128;
    for (int r = blockIdx.x * 4 + wv; r < MR; r += gridDim.x * 4) {
        if (skip_ctx && (r % SB) < CTXL) continue;
        norm_row(p, l, 0, first, r, lane);
        bf16_t* ta = wsb(p, O_TA) + (size_t)r * 512 + lane * 8;
        const bf16_t* tb = wsb(p, O_TA2) + (size_t)r * 512 + lane * 8;
        const bf16_t* zz = wsb(p, O_P) + (size_t)r * PW + C_DNZ + lane * 8;
        u32x4 a = *(const u32x4*)ta, b = *(const u32x4*)tb, z = *(const u32x4*)zz;
        float o[8]; float ss = 0.f;
#pragma unroll
        for (int i = 0; i < 4; ++i) { o[2 * i] = lo16(a[i]) + lo16(b[i]); o[2 * i + 1] = hi16(a[i]) + hi16(b[i]); ss += o[2 * i] * o[2 * i] + o[2 * i + 1] * o[2 * i + 1]; }
#pragma unroll
        for (int of = 8; of >= 1; of >>= 1) ss += __shfl_xor(ss, of);
        const float rstd = rsqrtf(ss * (1.f / 128.f) + 1e-6f);
        const int dv0 = (lane & 15) * 8;
        u32x4 y;
#pragma unroll
        for (int i = 0; i < 4; ++i) {
            float y0 = o[2 * i] * rstd * dnn[dv0 + 2 * i] * silu(lo16(z[i]));
            float y1 = o[2 * i + 1] * rstd * dnn[dv0 + 2 * i + 1] * silu(hi16(z[i]));
            y[i] = pack2(y0, y1);
        }
        *(u32x4*)ta = y;
    }
}
DEV void phase_final(const Params& p) {
    const int tid_ = get_tid(); const int lane = tid_ & 63, wv = tid_ >> 6;
    const float* nw = p.in[I_NFIN];
    for (int r = blockIdx.x * 4 + wv; r < NB * SEQ; r += gridDim.x * 4) {
        float* h = p.out + (size_t)r * D;
        float4 v[4]; float ss = 0.f;
#pragma unroll
        for (int i = 0; i < 4; ++i) { v[i] = *(const float4*)(h + i * 256 + lane * 4); ss += v[i].x * v[i].x + v[i].y * v[i].y + v[i].z * v[i].z + v[i].w * v[i].w; }
#pragma unroll
        for (int o = 32; o >= 1; o >>= 1) ss += __shfl_xor(ss, o);
        const float rstd = rsqrtf(ss * (1.f / D) + 1e-6f);
#pragma unroll
        for (int i = 0; i < 4; ++i) {
            const int c = i * 256 + lane * 4;
            float4 w4 = *(const float4*)(nw + c);
            float4 o4; o4.x = v[i].x * rstd * w4.x; o4.y = v[i].y * rstd * w4.y; o4.z = v[i].z * rstd * w4.z; o4.w = v[i].w * rstd * w4.w;
            *(float4*)(h + c) = o4;
        }
    }
}

struct TileIter {
    int nn, total, nloc, L;
    DEV TileIter(int nm, int nn_) { nn = nn_; total = nm * nn_; nloc = gridDim.x >> 3; L = (blockIdx.x & 7) * nloc + (blockIdx.x >> 3); }
    DEV bool valid() const { return L < total; }
    DEV bool more() const { return (L - (int)(blockIdx.x >> 3)) < total; }
    DEV void next() { L += 8 * nloc; }
    DEV void get(int& tm, int& tn) const { const int pn = 4 * nn, panel = L / pn, rem = L - panel * pn; tn = rem >> 2; tm = panel * 4 + (rem & 3); }
};
DEV void phase_g1(const Params& p, unsigned char* smem) {
    bf16_t* sA = (bf16_t*)smem;
    const int tid = get_tid(), lane = tid & 63, wv = tid >> 6, wr = wv >> 1, wc = wv & 1, l15 = lane & 15, quad = lane >> 4;
    const bf16_t* U = wsb(p, O_U); const bf16_t* W = wsb(p, O_WT) + W_IN;
    bf16_t* P = wsb(p, O_P);
    const float* rope = wsf(p, O_ROPE);
    constexpr int NTN = NIN / 128;
    const int wr0_ = wr, wc0_ = wc, l150_ = l15, quad0_ = quad;
    for (TileIter ti(MR / 256, NTN); ti.valid(); ti.next()) {
        int tm, tn; ti.get(tm, tn);
        const int row0 = tm * 256, col0 = tn * 128;
        f32x4 acc[8][4]; zero_acc(acc);
        gemm_core<8, 4>(U + (size_t)row0 * D, D, W + (size_t)col0 * D, D, D, acc, sA);
        int tz = 0; asm volatile("" : "+v"(tz));
        const int wr = wr0_ + tz, wc = wc0_ + tz, l15 = l150_ + tz, quad = quad0_ + tz;
        if (tn < 24) {
#pragma unroll
            for (int mt = 0; mt < 8; ++mt) {
                __builtin_amdgcn_sched_barrier(0);
                bf16_t* pp = P + (size_t)(row0 + wr * 128 + mt * 16 + l15) * PW + col0 + wc * 64 + quad * 4;
#pragma unroll
                for (int nt = 0; nt < 4; ++nt) { u32x2 o; o.x = pack2(acc[mt][nt][0], acc[mt][nt][1]); o.y = pack2(acc[mt][nt][2], acc[mt][nt][3]); *(u32x2*)(pp + nt * 16) = o; }
            }
        } else if (tn < 32) {
            const float qs = tn < 28 ? 0.125f : 1.f;
#pragma unroll
            for (int mt = 0; mt < 8; ++mt) {
                __builtin_amdgcn_sched_barrier(0);
                const int row = row0 + wr * 128 + mt * 16 + l15;
                const int s_ = row % SB;
                f32x4 ca = {1.f, 1.f, 1.f, 1.f}, sa = {0.f, 0.f, 0.f, 0.f}, cb = {1.f, 1.f, 1.f, 1.f}, sb = {0.f, 0.f, 0.f, 0.f};
                if (s_ >= CTXL) { const int tt = s_ - CTXL, pr = tt >> 6, pc = tt & 63;
                    const f32x4 r0 = *(const f32x4*)(rope + (pr * 16 + quad * 4) * 2), r1 = *(const f32x4*)(rope + (pr * 16 + quad * 4) * 2 + 4);
                    const f32x4 r2 = *(const f32x4*)(rope + (pc * 16 + quad * 4) * 2), r3 = *(const f32x4*)(rope + (pc * 16 + quad * 4) * 2 + 4);
                    ca = (f32x4){r0[0], r0[2], r1[0], r1[2]}; sa = (f32x4){r0[1], r0[3], r1[1], r1[3]};
                    cb = (f32x4){r2[0], r2[2], r3[0], r3[2]}; sb = (f32x4){r2[1], r2[3], r3[1], r3[3]}; }
                const f32x4 x1 = acc[mt][0], x2 = acc[mt][1], y1 = acc[mt][2], y2 = acc[mt][3];
                const f32x4 o0 = (x1 * ca - x2 * sa) * qs, o1 = (x2 * ca + x1 * sa) * qs, o2 = (y1 * cb - y2 * sb) * qs, o3 = (y2 * cb + y1 * sb) * qs;
                bf16_t* pp = P + (size_t)row * PW + col0 + wc * 64 + quad * 4;
                u32x2 o; o.x = pack2(o0[0], o0[1]); o.y = pack2(o0[2], o0[3]); *(u32x2*)(pp) = o;
                o.x = pack2(o1[0], o1[1]); o.y = pack2(o1[2], o1[3]); *(u32x2*)(pp + 16) = o;
                o.x = pack2(o2[0], o2[1]); o.y = pack2(o2[2], o2[3]); *(u32x2*)(pp + 32) = o;
                o.x = pack2(o3[0], o3[1]); o.y = pack2(o3[2], o3[3]); *(u32x2*)(pp + 48) = o;
            }
        } else if (tn < 36) {
            bf16_t* VT = wsb(p, O_VT);
            const int b = row0 / SB, sbase = row0 - b * SB;
#pragma unroll
            for (int mt = 0; mt < 8; ++mt) {
                __builtin_amdgcn_sched_barrier(0);
                const int s_ = sbase + wr * 128 + mt * 16 + l15;
                const int vi0 = (b * 512 + col0 - 4096 + wc * 64 + quad * 4) * SB + s_;
#pragma unroll
                for (int nt = 0; nt < 4; ++nt) {
                    const unsigned p01 = pack2(acc[mt][nt][0], acc[mt][nt][1]), p23 = pack2(acc[mt][nt][2], acc[mt][nt][3]);
                    VT[vi0 + (nt * 16 + 0) * SB] = (bf16_t)(p01 & 0xffffu); VT[vi0 + (nt * 16 + 1) * SB] = (bf16_t)(p01 >> 16);
                    VT[vi0 + (nt * 16 + 2) * SB] = (bf16_t)(p23 & 0xffffu); VT[vi0 + (nt * 16 + 3) * SB] = (bf16_t)(p23 >> 16);
                }
            }
        } else {
            if (wc == 0) {
                float* AB = wsf(p, O_AB);
#pragma unroll
                for (int mt = 0; mt < 8; ++mt) {
                    const int row = row0 + wr * 128 + mt * 16 + l15;
                    *(f32x4*)(AB + (size_t)row * 16 + quad * 4) = acc[mt][0];
                }
            }
        }
    }
}

DEV int rowtile0(int ti, bool latent_only) { if (!latent_only) return ti * 256; int b = ti >> 4, tt = ti & 15; return b * SB + CTXL + tt * 256; }
DEV int sgcol(int n, int c) { return n < 2 ? n * 1024 + c : (c < 512 ? 2048 + c : 3584 + (c - 512)); }

DEV void phase_gate(const Params& p, bool latent_only, unsigned char* smem) {
    bf16_t* sA = (bf16_t*)smem;
    const int tid = get_tid(), lane = tid & 63, wv = tid >> 6, wr = wv >> 1, wc = wv & 1, l15 = lane & 15, quad = lane >> 4;
    const bf16_t* U = wsb(p, O_U); const bf16_t* W = wsb(p, O_WT) + W_GATE;
    bf16_t* P = wsb(p, O_P);
    const int nrt = latent_only ? 128 : 136;
    for (TileIter ti(nrt, 24); ti.valid(); ti.next()) {
        int tm, tn; ti.get(tm, tn);
        const int row0 = rowtile0(tm, latent_only);
        f32x4 acc[8][4]; zero_acc(acc);
        gemm_core<8, 4>(U + (size_t)row0 * D, D, W + (size_t)tn * 128 * D, D, D, acc, sA);
        const int dcol0 = sgcol(tn >> 3, (tn & 7) * 128);
        bf16_t* ip = P + (size_t)(row0 + tid) * PW + dcol0;
#pragma unroll
        for (int mt = 0; mt < 8; ++mt) {
            __builtin_amdgcn_sched_barrier(0);
#pragma unroll
            for (int hf = 0; hf < 2; ++hf) {
                u32x4 o;
                o[0] = pack2(sigm(acc[mt][2 * hf][0]), sigm(acc[mt][2 * hf][1])); o[1] = pack2(sigm(acc[mt][2 * hf][2]), sigm(acc[mt][2 * hf][3]));
                o[2] = pack2(sigm(acc[mt][2 * hf + 1][0]), sigm(acc[mt][2 * hf + 1][1])); o[3] = pack2(sigm(acc[mt][2 * hf + 1][2]), sigm(acc[mt][2 * hf + 1][3]));
                *(u32x4*)(ip + (mt * 2 + hf) * 8) = o;
            }
        }
    }
}

DEV void phase_merge(const Params& p, bool latent_only, unsigned char* smem) {
    bf16_t* sA = (bf16_t*)smem;
    const int tid = get_tid(), lane = tid & 63, wv = tid >> 6, wr = wv >> 1, wc = wv & 1, l15 = lane & 15, quad = lane >> 4;
    const bf16_t* W = wsb(p, O_WT);
    const bf16_t* P = wsb(p, O_P);
    bf16_t* U = wsb(p, O_U);
    const int nrt = latent_only ? 128 : 136;
    for (TileIter ti(nrt, 8); ti.valid(); ti.next()) {
        int tm, tn; ti.get(tm, tn);
        const int row0 = rowtile0(tm, latent_only), col0 = tn * 128;
        f32x4 m[8][4]; zero_acc(m);
#pragma unroll 1
        for (int n = 0; n < 3; ++n) {
            f32x4 au[8][4]; zero_acc(au);
            const bf16_t* Y; int ldy;
            if (n == 0) { Y = wsb(p, O_TA) + (size_t)row0 * 512; ldy = 512; }
            else if (n == 1) { Y = P + (size_t)row0 * PW + C_LG; ldy = PW; }
            else { Y = P + (size_t)row0 * PW + C_DAQ; ldy = PW; }
            const int sc0 = sgcol(n, col0);
            gemm_core<8, 4>(Y, ldy, W + W_BR + ((size_t)n * 1024 + col0) * 512, 512, 512, au, sA);
            u32x4 sg[16];
            const bf16_t* ip = P + (size_t)(row0 + tid) * PW + sc0;
#pragma unroll
            for (int q = 0; q < 16; ++q) sg[q] = *(const u32x4*)(ip + q * 8);
#pragma unroll
            for (int mt = 0; mt < 8; ++mt)
#pragma unroll
                for (int nt = 0; nt < 4; ++nt) {
                    const unsigned g01 = sg[mt * 2 + (nt >> 1)][(nt & 1) * 2], g23 = sg[mt * 2 + (nt >> 1)][(nt & 1) * 2 + 1];
                    m[mt][nt][0] += lo16(g01) * au[mt][nt][0]; m[mt][nt][1] += hi16(g01) * au[mt][nt][1];
                    m[mt][nt][2] += lo16(g23) * au[mt][nt][2]; m[mt][nt][3] += hi16(g23) * au[mt][nt][3];
                }
        }
#pragma unroll
        for (int mt = 0; mt < 8; ++mt) {
            __builtin_amdgcn_sched_barrier(0);
            bf16_t* up = U + (size_t)(row0 + wr * 128 + mt * 16 + l15) * D + col0 + wc * 64 + quad * 4;
#pragma unroll
            for (int nt = 0; nt < 4; ++nt) { u32x2 o; o.x = pack2(m[mt][nt][0], m[mt][nt][1]); o.y = pack2(m[mt][nt][2], m[mt][nt][3]); *(u32x2*)(up + nt * 16) = o; }
        }
    }
}

DEV void phase_resid(const Params& p, int l, const bf16_t* A, int lda, const bf16_t* Wt, int K, int chunk, bool first, bool latent_only, unsigned char* smem) {
    bf16_t* sA = (bf16_t*)smem;
    const int tid = get_tid(), lane = tid & 63, wv = tid >> 6, wr = wv >> 1, wc = wv & 1, l15 = lane & 15, quad = lane >> 4;
    const int nrt = latent_only ? 128 : 136;
    for (TileIter ti(nrt, 8); ti.valid(); ti.next()) {
        int tm, tn; ti.get(tm, tn);
        const int row0 = rowtile0(tm, latent_only), col0 = tn * 128;
        f32x4 acc[8][4]; zero_acc(acc);
        gemm_core<8, 4>(A + (size_t)row0 * lda, lda, Wt + (size_t)col0 * K, K, K, acc, sA);
        const float* md = wsf(p, O_MOD) + ((size_t)l * 9 + modrow(row0)) * 6144 + chunk * D + col0 + wc * 64 + quad * 4;
        const float* hs0 = first ? xrow(p, row0) : hrow(p, row0);
        float* hd0 = hrow(p, row0);
        f32x4 mg[4];
#pragma unroll
        for (int nt = 0; nt < 4; ++nt) mg[nt] = *(const f32x4*)(md + nt * 16);
#pragma unroll
        for (int mt = 0; mt < 8; ++mt) {
            __builtin_amdgcn_sched_barrier(0);
            const size_t ro = (size_t)(wr * 128 + mt * 16 + l15) * D + col0 + wc * 64 + quad * 4;
#pragma unroll
            for (int nt = 0; nt < 4; ++nt) { const f32x4 h = *(const f32x4*)(hs0 + ro + nt * 16); *(f32x4*)(hd0 + ro + nt * 16) = h + mg[nt] * acc[mt][nt]; }
        }
    }
}
DEV void phase_gu(const Params& p, bool latent_only, unsigned char* smem) {
    bf16_t* sA = (bf16_t*)smem;
    const int tid = get_tid(), lane = tid & 63, wv = tid >> 6, wr = wv >> 1, wc = wv & 1, l15 = lane & 15, quad = lane >> 4;
    const bf16_t* U = wsb(p, O_U); const bf16_t* W = wsb(p, O_WT) + W_GU;
    bf16_t* P = wsb(p, O_P);
    const int nrt = latent_only ? 128 : 136;
    for (TileIter ti(nrt, 44); ti.valid(); ti.next()) {
        int tm, tn; ti.get(tm, tn);
        const int row0 = rowtile0(tm, latent_only);
        f32x4 acc[8][4]; zero_acc(acc);
        gemm_core<8, 4>(U + (size_t)row0 * D, D, W + (size_t)tn * 128 * D, D, D, acc, sA);
#pragma unroll
        for (int mt = 0; mt < 8; ++mt) {
            __builtin_amdgcn_sched_barrier(0);
            bf16_t* pp = P + (size_t)(row0 + wr * 128 + mt * 16 + l15) * PW + (tn * 4 + wc * 2) * 16 + quad * 4;
#pragma unroll
            for (int pr = 0; pr < 2; ++pr) {
                const f32x4 g = acc[mt][2 * pr], u = acc[mt][2 * pr + 1];
                u32x2 o; o.x = pack2(silu(g[0]) * u[0], silu(g[1]) * u[1]); o.y = pack2(silu(g[2]) * u[2], silu(g[3]) * u[3]);
                *(u32x2*)(pp + pr * 16) = o;
            }
        }
    }
}

DEV int chunk_of(int dir, int n) { return dir ? (n < 4 ? 3 - n : 71 - n) : n; }

typedef float f32x2 __attribute__((ext_vector_type(2)));
DEV void dn_solve(const float* __restrict__ Lt_s0, const bf16_t* __restrict__ colp, const float* __restrict__ mulp0, const float sg, bf16_t* __restrict__ outp,
                  bf16_t* XT_s, const bf16_t* Lb_s, const int tid, const int wv, const int l15, const int quad) {
    int vz = 0; asm volatile("" : "+v"(vz));
    const float* __restrict__ Lt_s = Lt_s0 + vz; const float* __restrict__ mulp = mulp0 + vz;
    f32x2 X0, X1, X2, X3, X4, X5, X6, X7, X8, X9, X10, X11, X12, X13, X14, X15, X16, X17, X18, X19, X20, X21, X22, X23, X24, X25, X26, X27, X28, X29, X30, X31;
    f32x4 La0, La1, La2, La3, La4, La5, La6, La7, La8, La9, La10, La11, La12, La13, La14, La15, Lb0, Lb1, Lb2, Lb3, Lb4, Lb5, Lb6, Lb7, Lb8, Lb9, Lb10, Lb11, Lb12, Lb13, Lb14, Lb15;
    X0 = (f32x2){bf2f(colp[0]) * mulp[0], bf2f(colp[136]) * mulp[1]};
    X1 = (f32x2){bf2f(colp[272]) * mulp[2], bf2f(colp[408]) * mulp[3]};
    X2 = (f32x2){bf2f(colp[544]) * mulp[4], bf2f(colp[680]) * mulp[5]};
    X3 = (f32x2){bf2f(colp[816]) * mulp[6], bf2f(colp[952]) * mulp[7]};
    X4 = (f32x2){bf2f(colp[1088]) * mulp[8], bf2f(colp[1224]) * mulp[9]};
    X5 = (f32x2){bf2f(colp[1360]) * mulp[10], bf2f(colp[1496]) * mulp[11]};
    X6 = (f32x2){bf2f(colp[1632]) * mulp[12], bf2f(colp[1768]) * mulp[13]};
    X7 = (f32x2){bf2f(colp[1904]) * mulp[14], bf2f(colp[2040]) * mulp[15]};
    X8 = (f32x2){bf2f(colp[2176]) * mulp[16], bf2f(colp[2312]) * mulp[17]};
    X9 = (f32x2){bf2f(colp[2448]) * mulp[18], bf2f(colp[2584]) * mulp[19]};
    X10 = (f32x2){bf2f(colp[2720]) * mulp[20], bf2f(colp[2856]) * mulp[21]};
    X11 = (f32x2){bf2f(colp[2992]) * mulp[22], bf2f(colp[3128]) * mulp[23]};
    X12 = (f32x2){bf2f(colp[3264]) * mulp[24], bf2f(colp[3400]) * mulp[25]};
    X13 = (f32x2){bf2f(colp[3536]) * mulp[26], bf2f(colp[3672]) * mulp[27]};
    X14 = (f32x2){bf2f(colp[3808]) * mulp[28], bf2f(colp[3944]) * mulp[29]};
    X15 = (f32x2){bf2f(colp[4080]) * mulp[30], bf2f(colp[4216]) * mulp[31]};
    X16 = (f32x2){bf2f(colp[4352]) * mulp[32], bf2f(colp[4488]) * mulp[33]};
    X17 = (f32x2){bf2f(colp[4624]) * mulp[34], bf2f(colp[4760]) * mulp[35]};
    X18 = (f32x2){bf2f(colp[4896]) * mulp[36], bf2f(colp[5032]) * mulp[37]};
    X19 = (f32x2){bf2f(colp[5168]) * mulp[38], bf2f(colp[5304]) * mulp[39]};
    X20 = (f32x2){bf2f(colp[5440]) * mulp[40], bf2f(colp[5576]) * mulp[41]};
    X21 = (f32x2){bf2f(colp[5712]) * mulp[42], bf2f(colp[5848]) * mulp[43]};
    X22 = (f32x2){bf2f(colp[5984]) * mulp[44], bf2f(colp[6120]) * mulp[45]};
    X23 = (f32x2){bf2f(colp[6256]) * mulp[46], bf2f(colp[6392]) * mulp[47]};
    X24 = (f32x2){bf2f(colp[6528]) * mulp[48], bf2f(colp[6664]) * mulp[49]};
    X25 = (f32x2){bf2f(colp[6800]) * mulp[50], bf2f(colp[6936]) * mulp[51]};
    X26 = (f32x2){bf2f(colp[7072]) * mulp[52], bf2f(colp[7208]) * mulp[53]};
    X27 = (f32x2){bf2f(colp[7344]) * mulp[54], bf2f(colp[7480]) * mulp[55]};
    X28 = (f32x2){bf2f(colp[7616]) * mulp[56], bf2f(colp[7752]) * mulp[57]};
    X29 = (f32x2){bf2f(colp[7888]) * mulp[58], bf2f(colp[8024]) * mulp[59]};
    X30 = (f32x2){bf2f(colp[8160]) * mulp[60], bf2f(colp[8296]) * mulp[61]};
    X31 = (f32x2){bf2f(colp[8432]) * mulp[62], bf2f(colp[8568]) * mulp[63]};
    __syncthreads();
    La0 = *(const f32x4*)(Lt_s + 0);
    La1 = *(const f32x4*)(Lt_s + 4);
    La2 = *(const f32x4*)(Lt_s + 8);
    La3 = *(const f32x4*)(Lt_s + 12);
    La4 = *(const f32x4*)(Lt_s + 16);
    La5 = *(const f32x4*)(Lt_s + 20);
    La6 = *(const f32x4*)(Lt_s + 24);
    La7 = *(const f32x4*)(Lt_s + 28);
    Lb0 = *(const f32x4*)(Lt_s + 68);
    Lb1 = *(const f32x4*)(Lt_s + 72);
    Lb2 = *(const f32x4*)(Lt_s + 76);
    Lb3 = *(const f32x4*)(Lt_s + 80);
    Lb4 = *(const f32x4*)(Lt_s + 84);
    Lb5 = *(const f32x4*)(Lt_s + 88);
    Lb6 = *(const f32x4*)(Lt_s + 92);
    Lb7 = *(const f32x4*)(Lt_s + 96);
    __builtin_amdgcn_sched_barrier(0);
    { const float xj = X0[0]; const f32x2 xj2 = (f32x2){xj, xj};
      X0 -= (f32x2){La0[0], La0[1]} * xj2;
      X1 -= (f32x2){La0[2], La0[3]} * xj2;
      X2 -= (f32x2){La1[0], La1[1]} * xj2;
      X3 -= (f32x2){La1[2], La1[3]} * xj2;
      X4 -= (f32x2){La2[0], La2[1]} * xj2;
      X5 -= (f32x2){La2[2], La2[3]} * xj2;
      X6 -= (f32x2){La3[0], La3[1]} * xj2;
      X7 -= (f32x2){La3[2], La3[3]} * xj2;
      X8 -= (f32x2){La4[0], La4[1]} * xj2;
      X9 -= (f32x2){La4[2], La4[3]} * xj2;
      X10 -= (f32x2){La5[0], La5[1]} * xj2;
      X11 -= (f32x2){La5[2], La5[3]} * xj2;
      X12 -= (f32x2){La6[0], La6[1]} * xj2;
      X13 -= (f32x2){La6[2], La6[3]} * xj2;
      X14 -= (f32x2){La7[0], La7[1]} * xj2;
      X15 -= (f32x2){La7[2], La7[3]} * xj2;
    }
    __builtin_amdgcn_sched_barrier(0);
    La0 = *(const f32x4*)(Lt_s + 136);
    La1 = *(const f32x4*)(Lt_s + 140);
    La2 = *(const f32x4*)(Lt_s + 144);
    La3 = *(const f32x4*)(Lt_s + 148);
    La4 = *(const f32x4*)(Lt_s + 152);
    La5 = *(const f32x4*)(Lt_s + 156);
    La6 = *(const f32x4*)(Lt_s + 160);
    La7 = *(const f32x4*)(Lt_s + 164);
    __builtin_amdgcn_sched_barrier(0);
    { const float xj = X0[1]; const f32x2 xj2 = (f32x2){xj, xj};
      X1 -= (f32x2){Lb0[2], Lb0[3]} * xj2;
      X2 -= (f32x2){Lb1[0], Lb1[1]} * xj2;
      X3 -= (f32x2){Lb1[2], Lb1[3]} * xj2;
      X4 -= (f32x2){Lb2[0], Lb2[1]} * xj2;
      X5 -= (f32x2){Lb2[2], Lb2[3]} * xj2;
      X6 -= (f32x2){Lb3[0], Lb3[1]} * xj2;
      X7 -= (f32x2){Lb3[2], Lb3[3]} * xj2;
      X8 -= (f32x2){Lb4[0], Lb4[1]} * xj2;
      X9 -= (f32x2){Lb4[2], Lb4[3]} * xj2;
      X10 -= (f32x2){Lb5[0], Lb5[1]} * xj2;
      X11 -= (f32x2){Lb5[2], Lb5[3]} * xj2;
      X12 -= (f32x2){Lb6[0], Lb6[1]} * xj2;
      X13 -= (f32x2){Lb6[2], Lb6[3]} * xj2;
      X14 -= (f32x2){Lb7[0], Lb7[1]} * xj2;
      X15 -= (f32x2){Lb7[2], Lb7[3]} * xj2;
    }
    __builtin_amdgcn_sched_barrier(0);
    Lb1 = *(const f32x4*)(Lt_s + 208);
    Lb2 = *(const f32x4*)(Lt_s + 212);
    Lb3 = *(const f32x4*)(Lt_s + 216);
    Lb4 = *(const f32x4*)(Lt_s + 220);
    Lb5 = *(const f32x4*)(Lt_s + 224);
    Lb6 = *(const f32x4*)(Lt_s + 228);
    Lb7 = *(const f32x4*)(Lt_s + 232);
    __builtin_amdgcn_sched_barrier(0);
    { const float xj = X1[0]; const f32x2 xj2 = (f32x2){xj, xj};
      X1 -= (f32x2){La0[2], La0[3]} * xj2;
      X2 -= (f32x2){La1[0], La1[1]} * xj2;
      X3 -= (f32x2){La1[2], La1[3]} * xj2;
      X4 -= (f32x2){La2[0], La2[1]} * xj2;
      X5 -= (f32x2){La2[2], La2[3]} * xj2;
      X6 -= (f32x2){La3[0], La3[1]} * xj2;
      X7 -= (f32x2){La3[2], La3[3]} * xj2;
      X8 -= (f32x2){La4[0], La4[1]} * xj2;
      X9 -= (f32x2){La4[2], La4[3]} * xj2;
      X10 -= (f32x2){La5[0], La5[1]} * xj2;
      X11 -= (f32x2){La5[2], La5[3]} * xj2;
      X12 -= (f32x2){La6[0], La6[1]} * xj2;
      X13 -= (f32x2){La6[2], La6[3]} * xj2;
      X14 -= (f32x2){La7[0], La7[1]} * xj2;
      X15 -= (f32x2){La7[2], La7[3]} * xj2;
    }
    __builtin_amdgcn_sched_barrier(0);
    La1 = *(const f32x4*)(Lt_s + 276);
    La2 = *(const f32x4*)(Lt_s + 280);
    La3 = *(const f32x4*)(Lt_s + 284);
    La4 = *(const f32x4*)(Lt_s + 288);
    La5 = *(const f32x4*)(Lt_s + 292);
    La6 = *(const f32x4*)(Lt_s + 296);
    La7 = *(const f32x4*)(Lt_s + 300);
    __builtin_amdgcn_sched_barrier(0);
    { const float xj = X1[1]; const f32x2 xj2 = (f32x2){xj, xj};
      X2 -= (f32x2){Lb1[0], Lb1[1]} * xj2;
      X3 -= (f32x2){Lb1[2], Lb1[3]} * xj2;
      X4 -= (f32x2){Lb2[0], Lb2[1]} * xj2;
      X5 -= (f32x2){Lb2[2], Lb2[3]} * xj2;
      X6 -= (f32x2){Lb3[0], Lb3[1]} * xj2;
      X7 -= (f32x2){Lb3[2], Lb3[3]} * xj2;
      X8 -= (f32x2){Lb4[0], Lb4[1]} * xj2;
      X9 -= (f32x2){Lb4[2], Lb4[3]} * xj2;
      X10 -= (f32x2){Lb5[0], Lb5[1]} * xj2;
      X11 -= (f32x2){Lb5[2], Lb5[3]} * xj2;
      X12 -= (f32x2){Lb6[0], Lb6[1]} * xj2;
      X13 -= (f32x2){Lb6[2], Lb6[3]} * xj2;
      X14 -= (f32x2){Lb7[0], Lb7[1]} * xj2;
      X15 -= (f32x2){Lb7[2], Lb7[3]} * xj2;
    }
    __builtin_amdgcn_sched_barrier(0);
    Lb1 = *(const f32x4*)(Lt_s + 344);
    Lb2 = *(const f32x4*)(Lt_s + 348);
    Lb3 = *(const f32x4*)(Lt_s + 352);
    Lb4 = *(const f32x4*)(Lt_s + 356);
    Lb5 = *(const f32x4*)(Lt_s + 360);
    Lb6 = *(const f32x4*)(Lt_s + 364);
    Lb7 = *(const f32x4*)(Lt_s + 368);
    __builtin_amdgcn_sched_barrier(0);
    { const float xj = X2[0]; const f32x2 xj2 = (f32x2){xj, xj};
      X2 -= (f32x2){La1[0], La1[1]} * xj2;
      X3 -= (f32x2){La1[2], La1[3]} * xj2;
      X4 -= (f32x2){La2[0], La2[1]} * xj2;
      X5 -= (f32x2){La2[2], La2[3]} * xj2;
      X6 -= (f32x2){La3[0], La3[1]} * xj2;
      X7 -= (f32x2){La3[2], La3[3]} * xj2;
      X8 -= (f32x2){La4[0], La4[1]} * xj2;
      X9 -= (f32x2){La4[2], La4[3]} * xj2;
      X10 -= (f32x2){La5[0], La5[1]} * xj2;
      X11 -= (f32x2){La5[2], La5[3]} * xj2;
      X12 -= (f32x2){La6[0], La6[1]} * xj2;
      X13 -= (f32x2){La6[2], La6[3]} * xj2;
      X14 -= (f32x2){La7[0], La7[1]} * xj2;
      X15 -= (f32x2){La7[2], La7[3]} * xj2;
    }
    __builtin_amdgcn_sched_barrier(0);
    La1 = *(const f32x4*)(Lt_s + 412);
    La2 = *(const f32x4*)(Lt_s + 416);
    La3 = *(const f32x4*)(Lt_s + 420);
    La4 = *(const f32x4*)(Lt_s + 424);
    La5 = *(const f32x4*)(Lt_s + 428);
    La6 = *(const f32x4*)(Lt_s + 432);
    La7 = *(const f32x4*)(Lt_s + 436);
    __builtin_amdgcn_sched_barrier(0);
    { const float xj = X2[1]; const f32x2 xj2 = (f32x2){xj, xj};
      X3 -= (f32x2){Lb1[2], Lb1[3]} * xj2;
      X4 -= (f32x2){Lb2[0], Lb2[1]} * xj2;
      X5 -= (f32x2){Lb2[2], Lb2[3]} * xj2;
      X6 -= (f32x2){Lb3[0], Lb3[1]} * xj2;
      X7 -= (f32x2){Lb3[2], Lb3[3]} * xj2;
      X8 -= (f32x2){Lb4[0], Lb4[1]} * xj2;
      X9 -= (f32x2){Lb4[2], Lb4[3]} * xj2;
      X10 -= (f32x2){Lb5[0], Lb5[1]} * xj2;
      X11 -= (f32x2){Lb5[2], Lb5[3]} * xj2;
      X12 -= (f32x2){Lb6[0], Lb6[1]} * xj2;
      X13 -= (f32x2){Lb6[2], Lb6[3]} * xj2;
      X14 -= (f32x2){Lb7[0], Lb7[1]} * xj2;
      X15 -= (f32x2){Lb7[2], Lb7[3]} * xj2;
    }
    __builtin_amdgcn_sched_barrier(0);
    Lb2 = *(const f32x4*)(Lt_s + 484);
    Lb3 = *(const f32x4*)(Lt_s + 488);
    Lb4 = *(const f32x4*)(Lt_s + 492);
    Lb5 = *(const f32x4*)(Lt_s + 496);
    Lb6 = *(const f32x4*)(Lt_s + 500);
    Lb7 = *(const f32x4*)(Lt_s + 504);
    __builtin_amdgcn_sched_barrier(0);
    { const float xj = X3[0]; const f32x2 xj2 = (f32x2){xj, xj};
      X3 -= (f32x2){La1[2], La1[3]} * xj2;
      X4 -= (f32x2){La2[0], La2[1]} * xj2;
      X5 -= (f32x2){La2[2], La2[3]} * xj2;
      X6 -= (f32x2){La3[0], La3[1]} * xj2;
      X7 -= (f32x2){La3[2], La3[3]} * xj2;
      X8 -= (f32x2){La4[0], La4[1]} * xj2;
      X9 -= (f32x2){La4[2], La4[3]} * xj2;
      X10 -= (f32x2){La5[0], La5[1]} * xj2;
      X11 -= (f32x2){La5[2], La5[3]} * xj2;
      X12 -= (f32x2){La6[0], La6[1]} * xj2;
      X13 -= (f32x2){La6[2], La6[3]} * xj2;
      X14 -= (f32x2){La7[0], La7[1]} * xj2;
      X15 -= (f32x2){La7[2], La7[3]} * xj2;
    }
    __builtin_amdgcn_sched_barrier(0);
    La2 = *(const f32x4*)(Lt_s + 552);
    La3 = *(const f32x4*)(Lt_s + 556);
    La4 = *(const f32x4*)(Lt_s + 560);
    La5 = *(const f32x4*)(Lt_s + 564);
    La6 = *(const f32x4*)(Lt_s + 568);
    La7 = *(const f32x4*)(Lt_s + 572);
    __builtin_amdgcn_sched_barrier(0);
    { const float xj = X3[1]; const f32x2 xj2 = (f32x2){xj, xj};
      X4 -= (f32x2){Lb2[0], Lb2[1]} * xj2;
      X5 -= (f32x2){Lb2[2], Lb2[3]} * xj2;
      X6 -= (f32x2){Lb3[0], Lb3[1]} * xj2;
      X7 -= (f32x2){Lb3[2], Lb3[3]} * xj2;
      X8 -= (f32x2){Lb4[0], Lb4[1]} * xj2;
      X9 -= (f32x2){Lb4[2], Lb4[3]} * xj2;
      X10 -= (f32x2){Lb5[0], Lb5[1]} * xj2;
      X11 -= (f32x2){Lb5[2], Lb5[3]} * xj2;
      X12 -= (f32x2){Lb6[0], Lb6[1]} * xj2;
      X13 -= (f32x2){Lb6[2], Lb6[3]} * xj2;
      X14 -= (f32x2){Lb7[0], Lb7[1]} * xj2;
      X15 -= (f32x2){Lb7[2], Lb7[3]} * xj2;
    }
    __builtin_amdgcn_sched_barrier(0);
    Lb2 = *(const f32x4*)(Lt_s + 620);
    Lb3 = *(const f32x4*)(Lt_s + 624);
    Lb4 = *(const f32x4*)(Lt_s + 628);
    Lb5 = *(const f32x4*)(Lt_s + 632);
    Lb6 = *(const f32x4*)(Lt_s + 636);
    Lb7 = *(const f32x4*)(Lt_s + 640);
    __builtin_amdgcn_sched_barrier(0);
    { const float xj = X4[0]; const f32x2 xj2 = (f32x2){xj, xj};
      X4 -= (f32x2){La2[0], La2[1]} * xj2;
      X5 -= (f32x2){La2[2], La2[3]} * xj2;
      X6 -= (f32x2){La3[0], La3[1]} * xj2;
      X7 -= (f32x2){La3[2], La3[3]} * xj2;
      X8 -= (f32x2){La4[0], La4[1]} * xj2;
      X9 -= (f32x2){La4[2], La4[3]} * xj2;
      X10 -= (f32x2){La5[0], La5[1]} * xj2;
      X11 -= (f32x2){La5[2], La5[3]} * xj2;
      X12 -= (f32x2){La6[0], La6[1]} * xj2;
      X13 -= (f32x2){La6[2], La6[3]} * xj2;
      X14 -= (f32x2){La7[0], La7[1]} * xj2;
      X15 -= (f32x2){La7[2], La7[3]} * xj2;
    }
    __builtin_amdgcn_sched_barrier(0);
    La2 = *(const f32x4*)(Lt_s + 688);
    La3 = *(const f32x4*)(Lt_s + 692);
    La4 = *(const f32x4*)(Lt_s + 696);
    La5 = *(const f32x4*)(Lt_s + 700);
    La6 = *(const f32x4*)(Lt_s + 704);
    La7 = *(const f32x4*)(Lt_s + 708);
    __builtin_amdgcn_sched_barrier(0);
    { const float xj = X4[1]; const f32x2 xj2 = (f32x2){xj, xj};
      X5 -= (f32x2){Lb2[2], Lb2[3]} * xj2;
      X6 -= (f32x2){Lb3[0], Lb3[1]} * xj2;
      X7 -= (f32x2){Lb3[2], Lb3[3]} * xj2;
      X8 -= (f32x2){Lb4[0], Lb4[1]} * xj2;
      X9 -= (f32x2){Lb4[2], Lb4[3]} * xj2;
      X10 -= (f32x2){Lb5[0], Lb5[1]} * xj2;
      X11 -= (f32x2){Lb5[2], Lb5[3]} * xj2;
      X12 -= (f32x2){Lb6[0], Lb6[1]} * xj2;
      X13 -= (f32x2){Lb6[2], Lb6[3]} * xj2;
      X14 -= (f32x2){Lb7[0], Lb7[1]} * xj2;
      X15 -= (f32x2){Lb7[2], Lb7[3]} * xj2;
    }
    __builtin_amdgcn_sched_barrier(0);
    Lb3 = *(const f32x4*)(Lt_s + 760);
    Lb4 = *(const f32x4*)(Lt_s + 764);
    Lb5 = *(const f32x4*)(Lt_s + 768);
    Lb6 = *(const f32x4*)(Lt_s + 772);
    Lb7 = *(const f32x4*)(Lt_s + 776);
    __builtin_amdgcn_sched_barrier(0);
    { const float xj = X5[0]; const f32x2 xj2 = (f32x2){xj, xj};
      X5 -= (f32x2){La2[2], La2[3]} * xj2;
      X6 -= (f32x2){La3[0], La3[1]} * xj2;
      X7 -= (f32x2){La3[2], La3[3]} * xj2;
      X8 -= (f32x2){La4[0], La4[1]} * xj2;
      X9 -= (f32x2){La4[2], La4[3]} * xj2;
      X10 -= (f32x2){La5[0], La5[1]} * xj2;
      X11 -= (f32x2){La5[2], La5[3]} * xj2;
      X12 -= (f32x2){La6[0], La6[1]} * xj2;
      X13 -= (f32x2){La6[2], La6[3]} * xj2;
      X14 -= (f32x2){La7[0], La7[1]} * xj2;
      X15 -= (f32x2){La7[2], La7[3]} * xj2;
    }
    __builtin_amdgcn_sched_barrier(0);
    La3 = *(const f32x4*)(Lt_s + 828);
    La4 = *(const f32x4*)(Lt_s + 832);
    La5 = *(const f32x4*)(Lt_s + 836);
    La6 = *(const f32x4*)(Lt_s + 840);
    La7 = *(const f32x4*)(Lt_s + 844);
    __builtin_amdgcn_sched_barrier(0);
    { const float xj = X5[1]; const f32x2 xj2 = (f32x2){xj, xj};
      X6 -= (f32x2){Lb3[0], Lb3[1]} * xj2;
      X7 -= (f32x2){Lb3[2], Lb3[3]} * xj2;
      X8 -= (f32x2){Lb4[0], Lb4[1]} * xj2;
      X9 -= (f32x2){Lb4[2], Lb4[3]} * xj2;
      X10 -= (f32x2){Lb5[0], Lb5[1]} * xj2;
      X11 -= (f32x2){Lb5[2], Lb5[3]} * xj2;
      X12 -= (f32x2){Lb6[0], Lb6[1]} * xj2;
      X13 -= (f32x2){Lb6[2], Lb6[3]} * xj2;
      X14 -= (f32x2){Lb7[0], Lb7[1]} * xj2;
      X15 -= (f32x2){Lb7[2], Lb7[3]} * xj2;
    }
    __builtin_amdgcn_sched_barrier(0);
    Lb3 = *(const f32x4*)(Lt_s + 896);
    Lb4 = *(const f32x4*)(Lt_s + 900);
    Lb5 = *(const f32x4*)(Lt_s + 904);
    Lb6 = *(const f32x4*)(Lt_s + 908);
    Lb7 = *(const f32x4*)(Lt_s + 912);
    __builtin_amdgcn_sched_barrier(0);
    { const float xj = X6[0]; const f32x2 xj2 = (f32x2){xj, xj};
      X6 -= (f32x2){La3[0], La3[1]} * xj2;
      X7 -= (f32x2){La3[2], La3[3]} * xj2;
      X8 -= (f32x2){La4[0], La4[1]} * xj2;
      X9 -= (f32x2){La4[2], La4[3]} * xj2;
      X10 -= (f32x2){La5[0], La5[1]} * xj2;
      X11 -= (f32x2){La5[2], La5[3]} * xj2;
      X12 -= (f32x2){La6[0], La6[1]} * xj2;
      X13 -= (f32x2){La6[2], La6[3]} * xj2;
      X14 -= (f32x2){La7[0], La7[1]} * xj2;
      X15 -= (f32x2){La7[2], La7[3]} * xj2;
    }
    __builtin_amdgcn_sched_barrier(0);
    La3 = *(const f32x4*)(Lt_s + 964);
    La4 = *(const f32x4*)(Lt_s + 968);
    La5 = *(const f32x4*)(Lt_s + 972);
    La6 = *(const f32x4*)(Lt_s + 976);
    La7 = *(const f32x4*)(Lt_s + 980);
    __builtin_amdgcn_sched_barrier(0);
    { const float xj = X6[1]; const f32x2 xj2 = (f32x2){xj, xj};
      X7 -= (f32x2){Lb3[2], Lb3[3]} * xj2;
      X8 -= (f32x2){Lb4[0], Lb4[1]} * xj2;
      X9 -= (f32x2){Lb4[2], Lb4[3]} * xj2;
      X10 -= (f32x2){Lb5[0], Lb5[1]} * xj2;
      X11 -= (f32x2){Lb5[2], Lb5[3]} * xj2;
      X12 -= (f32x2){Lb6[0], Lb6[1]} * xj2;
      X13 -= (f32x2){Lb6[2], Lb6[3]} * xj2;
      X14 -= (f32x2){Lb7[0], Lb7[1]} * xj2;
      X15 -= (f32x2){Lb7[2], Lb7[3]} * xj2;
    }
    __builtin_amdgcn_sched_barrier(0);
    Lb4 = *(const f32x4*)(Lt_s + 1036);
    Lb5 = *(const f32x4*)(Lt_s + 1040);
    Lb6 = *(const f32x4*)(Lt_s + 1044);
    Lb7 = *(const f32x4*)(Lt_s + 1048);
    __builtin_amdgcn_sched_barrier(0);
    { const float xj = X7[0]; const f32x2 xj2 = (f32x2){xj, xj};
      X7 -= (f32x2){La3[2], La3[3]} * xj2;
      X8 -= (f32x2){La4[0], La4[1]} * xj2;
      X9 -= (f32x2){La4[2], La4[3]} * xj2;
      X10 -= (f32x2){La5[0], La5[1]} * xj2;
      X11 -= (f32x2){La5[2], La5[3]} * xj2;
      X12 -= (f32x2){La6[0], La6[1]} * xj2;
      X13 -= (f32x2){La6[2], La6[3]} * xj2;
      X14 -= (f32x2){La7[0], La7[1]} * xj2;
      X15 -= (f32x2){La7[2], La7[3]} * xj2;
    }
    __builtin_amdgcn_sched_barrier(0);
    La4 = *(const f32x4*)(Lt_s + 1104);
    La5 = *(const f32x4*)(Lt_s + 1108);
    La6 = *(const f32x4*)(Lt_s + 1112);
    La7 = *(const f32x4*)(Lt_s + 1116);
    __builtin_amdgcn_sched_barrier(0);
    { const float xj = X7[1]; const f32x2 xj2 = (f32x2){xj, xj};
      X8 -= (f32x2){Lb4[0], Lb4[1]} * xj2;
      X9 -= (f32x2){Lb4[2], Lb4[3]} * xj2;
      X10 -= (f32x2){Lb5[0], Lb5[1]} * xj2;
      X11 -= (f32x2){Lb5[2], Lb5[3]} * xj2;
      X12 -= (f32x2){Lb6[0], Lb6[1]} * xj2;
      X13 -= (f32x2){Lb6[2], Lb6[3]} * xj2;
      X14 -= (f32x2){Lb7[0], Lb7[1]} * xj2;
      X15 -= (f32x2){Lb7[2], Lb7[3]} * xj2;
    }
    __builtin_amdgcn_sched_barrier(0);
    Lb4 = *(const f32x4*)(Lt_s + 1172);
    Lb5 = *(const f32x4*)(Lt_s + 1176);
    Lb6 = *(const f32x4*)(Lt_s + 1180);
    Lb7 = *(const f32x4*)(Lt_s + 1184);
    __builtin_amdgcn_sched_barrier(0);
    { const float xj = X8[0]; const f32x2 xj2 = (f32x2){xj, xj};
      X8 -= (f32x2){La4[0], La4[1]} * xj2;
      X9 -= (f32x2){La4[2], La4[3]} * xj2;
      X10 -= (f32x2){La5[0], La5[1]} * xj2;
      X11 -= (f32x2){La5[2], La5[3]} * xj2;
      X12 -= (f32x2){La6[0], La6[1]} * xj2;
      X13 -= (f32x2){La6[2], La6[3]} * xj2;
      X14 -= (f32x2){La7[0], La7[1]} * xj2;
      X15 -= (f32x2){La7[2], La7[3]} * xj2;
    }
    __builtin_amdgcn_sched_barrier(0);
    La4 = *(const f32x4*)(Lt_s + 1240);
    La5 = *(const f32x4*)(Lt_s + 1244);
    La6 = *(const f32x4*)(Lt_s + 1248);
    La7 = *(const f32x4*)(Lt_s + 1252);
    __builtin_amdgcn_sched_barrier(0);
    { const float xj = X8[1]; const f32x2 xj2 = (f32x2){xj, xj};
      X9 -= (f32x2){Lb4[2], Lb4[3]} * xj2;
      X10 -= (f32x2){Lb5[0], Lb5[1]} * xj2;
      X11 -= (f32x2){Lb5[2], Lb5[3]} * xj2;
      X12 -= (f32x2){Lb6[0], Lb6[1]} * xj2;
      X13 -= (f32x2){Lb6[2], Lb6[3]} * xj2;
      X14 -= (f32x2){Lb7[0], Lb7[1]} * xj2;
      X15 -= (f32x2){Lb7[2], Lb7[3]} * xj2;
    }
    __builtin_amdgcn_sched_barrier(0);
    Lb5 = *(const f32x4*)(Lt_s + 1312);
    Lb6 = *(const f32x4*)(Lt_s + 1316);
    Lb7 = *(const f32x4*)(Lt_s + 1320);
    __builtin_amdgcn_sched_barrier(0);
    { const float xj = X9[0]; const f32x2 xj2 = (f32x2){xj, xj};
      X9 -= (f32x2){La4[2], La4[3]} * xj2;
      X10 -= (f32x2){La5[0], La5[1]} * xj2;
      X11 -= (f32x2){La5[2], La5[3]} * xj2;
      X12 -= (f32x2){La6[0], La6[1]} * xj2;
      X13 -= (f32x2){La6[2], La6[3]} * xj2;
      X14 -= (f32x2){La7[0], La7[1]} * xj2;
      X15 -= (f32x2){La7[2], La7[3]} * xj2;
    }
    __builtin_amdgcn_sched_barrier(0);
    La5 = *(const f32x4*)(Lt_s + 1380);
    La6 = *(const f32x4*)(Lt_s + 1384);
    La7 = *(const f32x4*)(Lt_s + 1388);
    __builtin_amdgcn_sched_barrier(0);
    { const float xj = X9[1]; const f32x2 xj2 = (f32x2){xj, xj};
      X10 -= (f32x2){Lb5[0], Lb5[1]} * xj2;
      X11 -= (f32x2){Lb5[2], Lb5[3]} * xj2;
      X12 -= (f32x2){Lb6[0], Lb6[1]} * xj2;
      X13 -= (f32x2){Lb6[2], Lb6[3]} * xj2;
      X14 -= (f32x2){Lb7[0], Lb7[1]} * xj2;
      X15 -= (f32x2){Lb7[2], Lb7[3]} * xj2;
    }
    __builtin_amdgcn_sched_barrier(0);
    Lb5 = *(const f32x4*)(Lt_s + 1448);
    Lb6 = *(const f32x4*)(Lt_s + 1452);
    Lb7 = *(const f32x4*)(Lt_s + 1456);
    __builtin_amdgcn_sched_barrier(0);
    { const float xj = X10[0]; const f32x2 xj2 = (f32x2){xj, xj};
      X10 -= (f32x2){La5[0], La5[1]} * xj2;
      X11 -= (f32x2){La5[2], La5[3]} * xj2;
      X12 -= (f32x2){La6[0], La6[1]} * xj2;
      X13 -= (f32x2){La6[2], La6[3]} * xj2;
      X14 -= (f32x2){La7[0], La7[1]} * xj2;
      X15 -= (f32x2){La7[2], La7[3]} * xj2;
    }
    __builtin_amdgcn_sched_barrier(0);
    La5 = *(const f32x4*)(Lt_s + 1516);
    La6 = *(const f32x4*)(Lt_s + 1520);
    La7 = *(const f32x4*)(Lt_s + 1524);
    __builtin_amdgcn_sched_barrier(0);
    { const float xj = X10[1]; const f32x2 xj2 = (f32x2){xj, xj};
      X11 -= (f32x2){Lb5[2], Lb5[3]} * xj2;
      X12 -= (f32x2){Lb6[0], Lb6[1]} * xj2;
      X13 -= (f32x2){Lb6[2], Lb6[3]} * xj2;
      X14 -= (f32x2){Lb7[0], Lb7[1]} * xj2;
      X15 -= (f32x2){Lb7[2], Lb7[3]} * xj2;
    }
    __builtin_amdgcn_sched_barrier(0);
    Lb6 = *(const f32x4*)(Lt_s + 1588);
    Lb7 = *(const f32x4*)(Lt_s + 1592);
    __builtin_amdgcn_sched_barrier(0);
    { const float xj = X11[0]; const f32x2 xj2 = (f32x2){xj, xj};
      X11 -= (f32x2){La5[2], La5[3]} * xj2;
      X12 -= (f32x2){La6[0], La6[1]} * xj2;
      X13 -= (f32x2){La6[2], La6[3]} * xj2;
      X14 -= (f32x2){La7[0], La7[1]} * xj2;
      X15 -= (f32x2){La7[2], La7[3]} * xj2;
    }
    __builtin_amdgcn_sched_barrier(0);
    La6 = *(const f32x4*)(Lt_s + 1656);
    La7 = *(const f32x4*)(Lt_s + 1660);
    __builtin_amdgcn_sched_barrier(0);
    { const float xj = X11[1]; const f32x2 xj2 = (f32x2){xj, xj};
      X12 -= (f32x2){Lb6[0], Lb6[1]} * xj2;
      X13 -= (f32x2){Lb6[2], Lb6[3]} * xj2;
      X14 -= (f32x2){Lb7[0], Lb7[1]} * xj2;
      X15 -= (f32x2){Lb7[2], Lb7[3]} * xj2;
    }
    __builtin_amdgcn_sched_barrier(0);
    Lb6 = *(const f32x4*)(Lt_s + 1724);
    Lb7 = *(const f32x4*)(Lt_s + 1728);
    __builtin_amdgcn_sched_barrier(0);
    { const float xj = X12[0]; const f32x2 xj2 = (f32x2){xj, xj};
      X12 -= (f32x2){La6[0], La6[1]} * xj2;
      X13 -= (f32x2){La6[2], La6[3]} * xj2;
      X14 -= (f32x2){La7[0], La7[1]} * xj2;
      X15 -= (f32x2){La7[2], La7[3]} * xj2;
    }
    __builtin_amdgcn_sched_barrier(0);
    La6 = *(const f32x4*)(Lt_s + 1792);
    La7 = *(const f32x4*)(Lt_s + 1796);
    __builtin_amdgcn_sched_barrier(0);
    { const float xj = X12[1]; const f32x2 xj2 = (f32x2){xj, xj};
      X13 -= (f32x2){Lb6[2], Lb6[3]} * xj2;
      X14 -= (f32x2){Lb7[0], Lb7[1]} * xj2;
      X15 -= (f32x2){Lb7[2], Lb7[3]} * xj2;
    }
    __builtin_amdgcn_sched_barrier(0);
    Lb7 = *(const f32x4*)(Lt_s + 1864);
    __builtin_amdgcn_sched_barrier(0);
    { const float xj = X13[0]; const f32x2 xj2 = (f32x2){xj, xj};
      X13 -= (f32x2){La6[2], La6[3]} * xj2;
      X14 -= (f32x2){La7[0], La7[1]} * xj2;
      X15 -= (f32x2){La7[2], La7[3]} * xj2;
    }
    __builtin_amdgcn_sched_barrier(0);
    La7 = *(const f32x4*)(Lt_s + 1932);
    __builtin_amdgcn_sched_barrier(0);
    { const float xj = X13[1]; const f32x2 xj2 = (f32x2){xj, xj};
      X14 -= (f32x2){Lb7[0], Lb7[1]} * xj2;
      X15 -= (f32x2){Lb7[2], Lb7[3]} * xj2;
    }
    __builtin_amdgcn_sched_barrier(0);
    Lb7 = *(const f32x4*)(Lt_s + 2000);
    __builtin_amdgcn_sched_barrier(0);
    { const float xj = X14[0]; const f32x2 xj2 = (f32x2){xj, xj};
      X14 -= (f32x2){La7[0], La7[1]} * xj2;
      X15 -= (f32x2){La7[2], La7[3]} * xj2;
    }
    __builtin_amdgcn_sched_barrier(0);
    La7 = *(const f32x4*)(Lt_s + 2068);
    __builtin_amdgcn_sched_barrier(0);
    { const float xj = X14[1]; const f32x2 xj2 = (f32x2){xj, xj};
      X15 -= (f32x2){Lb7[2], Lb7[3]} * xj2;
    }
    __builtin_amdgcn_sched_barrier(0);
    __builtin_amdgcn_sched_barrier(0);
    { const float xj = X15[0]; const f32x2 xj2 = (f32x2){xj, xj};
      X15 -= (f32x2){La7[2], La7[3]} * xj2;
    }
    __builtin_amdgcn_sched_barrier(0);
    {
        bf16_t* xr = XT_s + tid * 32;
        { u32x4 o = {pack2(X0[0], X0[1]), pack2(X1[0], X1[1]), pack2(X2[0], X2[1]), pack2(X3[0], X3[1])}; *(u32x4*)(xr + 0) = o; }
        { u32x4 o = {pack2(X4[0], X4[1]), pack2(X5[0], X5[1]), pack2(X6[0], X6[1]), pack2(X7[0], X7[1])}; *(u32x4*)(xr + 8) = o; }
        { u32x4 o = {pack2(X8[0], X8[1]), pack2(X9[0], X9[1]), pack2(X10[0], X10[1]), pack2(X11[0], X11[1])}; *(u32x4*)(xr + 16) = o; }
        { u32x4 o = {pack2(X12[0], X12[1]), pack2(X13[0], X13[1]), pack2(X14[0], X14[1]), pack2(X15[0], X15[1])}; *(u32x4*)(xr + 24) = o; }
        bf16x8 lb0 = *(const bf16x8*)(Lb_s + (0 + l15) * 40 + quad * 8), lb1 = *(const bf16x8*)(Lb_s + (16 + l15) * 40 + quad * 8);
        f32x4 d[4][2];
#pragma unroll
        for (int ct = 0; ct < 4; ++ct) {
            const bf16x8 xt = *(const bf16x8*)(XT_s + (wv * 64 + ct * 16 + l15) * 32 + quad * 8);
            d[ct][0] = mfma16(lb0, xt, (f32x4){0.f, 0.f, 0.f, 0.f}); d[ct][1] = mfma16(lb1, xt, (f32x4){0.f, 0.f, 0.f, 0.f});
        }
#pragma unroll
        for (int ct = 0; ct < 4; ++ct)
#pragma unroll
            for (int it = 0; it < 2; ++it) { u32x2 o; o.x = pack2(d[ct][it][0], d[ct][it][1]); o.y = pack2(d[ct][it][2], d[ct][it][3]);
                *(u32x2*)(XT_s + (wv * 64 + ct * 16 + l15) * 32 + it * 16 + quad * 4) = o; }
        { const u32x4 u = *(const u32x4*)(xr + 0);
          X16 -= (f32x2){lo16(u[0]), hi16(u[0])};
          X17 -= (f32x2){lo16(u[1]), hi16(u[1])};
          X18 -= (f32x2){lo16(u[2]), hi16(u[2])};
          X19 -= (f32x2){lo16(u[3]), hi16(u[3])};
        }
        { const u32x4 u = *(const u32x4*)(xr + 8);
          X20 -= (f32x2){lo16(u[0]), hi16(u[0])};
          X21 -= (f32x2){lo16(u[1]), hi16(u[1])};
          X22 -= (f32x2){lo16(u[2]), hi16(u[2])};
          X23 -= (f32x2){lo16(u[3]), hi16(u[3])};
        }
        { const u32x4 u = *(const u32x4*)(xr + 16);
          X24 -= (f32x2){lo16(u[0]), hi16(u[0])};
          X25 -= (f32x2){lo16(u[1]), hi16(u[1])};
          X26 -= (f32x2){lo16(u[2]), hi16(u[2])};
          X27 -= (f32x2){lo16(u[3]), hi16(u[3])};
        }
        { const u32x4 u = *(const u32x4*)(xr + 24);
          X28 -= (f32x2){lo16(u[0]), hi16(u[0])};
          X29 -= (f32x2){lo16(u[1]), hi16(u[1])};
          X30 -= (f32x2){lo16(u[2]), hi16(u[2])};
          X31 -= (f32x2){lo16(u[3]), hi16(u[3])};
        }
    }
    La8 = *(const f32x4*)(Lt_s + 2208);
    La9 = *(const f32x4*)(Lt_s + 2212);
    La10 = *(const f32x4*)(Lt_s + 2216);
    La11 = *(const f32x4*)(Lt_s + 2220);
    La12 = *(const f32x4*)(Lt_s + 2224);
    La13 = *(const f32x4*)(Lt_s + 2228);
    La14 = *(const f32x4*)(Lt_s + 2232);
    La15 = *(const f32x4*)(Lt_s + 2236);
    Lb8 = *(const f32x4*)(Lt_s + 2276);
    Lb9 = *(const f32x4*)(Lt_s + 2280);
    Lb10 = *(const f32x4*)(Lt_s + 2284);
    Lb11 = *(const f32x4*)(Lt_s + 2288);
    Lb12 = *(const f32x4*)(Lt_s + 2292);
    Lb13 = *(const f32x4*)(Lt_s + 2296);
    Lb14 = *(const f32x4*)(Lt_s + 2300);
    Lb15 = *(const f32x4*)(Lt_s + 2304);
    __builtin_amdgcn_sched_barrier(0);
    { const float xj = X16[0]; const f32x2 xj2 = (f32x2){xj, xj};
      X16 -= (f32x2){La8[0], La8[1]} * xj2;
      X17 -= (f32x2){La8[2], La8[3]} * xj2;
      X18 -= (f32x2){La9[0], La9[1]} * xj2;
      X19 -= (f32x2){La9[2], La9[3]} * xj2;
      X20 -= (f32x2){La10[0], La10[1]} * xj2;
      X21 -= (f32x2){La10[2], La10[3]} * xj2;
      X22 -= (f32x2){La11[0], La11[1]} * xj2;
      X23 -= (f32x2){La11[2], La11[3]} * xj2;
      X24 -= (f32x2){La12[0], La12[1]} * xj2;
      X25 -= (f32x2){La12[2], La12[3]} * xj2;
      X26 -= (f32x2){La13[0], La13[1]} * xj2;
      X27 -= (f32x2){La13[2], La13[3]} * xj2;
      X28 -= (f32x2){La14[0], La14[1]} * xj2;
      X29 -= (f32x2){La14[2], La14[3]} * xj2;
      X30 -= (f32x2){La15[0], La15[1]} * xj2;
      X31 -= (f32x2){La15[2], La15[3]} * xj2;
    }
    __builtin_amdgcn_sched_barrier(0);
    La8 = *(const f32x4*)(Lt_s + 2344);
    La9 = *(const f32x4*)(Lt_s + 2348);
    La10 = *(const f32x4*)(Lt_s + 2352);
    La11 = *(const f32x4*)(Lt_s + 2356);
    La12 = *(const f32x4*)(Lt_s + 2360);
    La13 = *(const f32x4*)(Lt_s + 2364);
    La14 = *(const f32x4*)(Lt_s + 2368);
    La15 = *(const f32x4*)(Lt_s + 2372);
    __builtin_amdgcn_sched_barrier(0);
    { const float xj = X16[1]; const f32x2 xj2 = (f32x2){xj, xj};
      X17 -= (f32x2){Lb8[2], Lb8[3]} * xj2;
      X18 -= (f32x2){Lb9[0], Lb9[1]} * xj2;
      X19 -= (f32x2){Lb9[2], Lb9[3]} * xj2;
      X20 -= (f32x2){Lb10[0], Lb10[1]} * xj2;
      X21 -= (f32x2){Lb10[2], Lb10[3]} * xj2;
      X22 -= (f32x2){Lb11[0], Lb11[1]} * xj2;
      X23 -= (f32x2){Lb11[2], Lb11[3]} * xj2;
      X24 -= (f32x2){Lb12[0], Lb12[1]} * xj2;
      X25 -= (f32x2){Lb12[2], Lb12[3]} * xj2;
      X26 -= (f32x2){Lb13[0], Lb13[1]} * xj2;
      X27 -= (f32x2){Lb13[2], Lb13[3]} * xj2;
      X28 -= (f32x2){Lb14[0], Lb14[1]} * xj2;
      X29 -= (f32x2){Lb14[2], Lb14[3]} * xj2;
      X30 -= (f32x2){Lb15[0], Lb15[1]} * xj2;
      X31 -= (f32x2){Lb15[2], Lb15[3]} * xj2;
    }
    __builtin_amdgcn_sched_barrier(0);
    Lb9 = *(const f32x4*)(Lt_s + 2416);
    Lb10 = *(const f32x4*)(Lt_s + 2420);
    Lb11 = *(const f32x4*)(Lt_s + 2424);
    Lb12 = *(const f32x4*)(Lt_s + 2428);
    Lb13 = *(const f32x4*)(Lt_s + 2432);
    Lb14 = *(const f32x4*)(Lt_s + 2436);
    Lb15 = *(const f32x4*)(Lt_s + 2440);
    __builtin_amdgcn_sched_barrier(0);
    { const float xj = X17[0]; const f32x2 xj2 = (f32x2){xj, xj};
      X17 -= (f32x2){La8[2], La8[3]} * xj2;
      X18 -= (f32x2){La9[0], La9[1]} * xj2;
      X19 -= (f32x2){La9[2], La9[3]} * xj2;
      X20 -= (f32x2){La10[0], La10[1]} * xj2;
      X21 -= (f32x2){La10[2], La10[3]} * xj2;
      X22 -= (f32x2){La11[0], La11[1]} * xj2;
      X23 -= (f32x2){La11[2], La11[3]} * xj2;
      X24 -= (f32x2){La12[0], La12[1]} * xj2;
      X25 -= (f32x2){La12[2], La12[3]} * xj2;
      X26 -= (f32x2){La13[0], La13[1]} * xj2;
      X27 -= (f32x2){La13[2], La13[3]} * xj2;
      X28 -= (f32x2){La14[0], La14[1]} * xj2;
      X29 -= (f32x2){La14[2], La14[3]} * xj2;
      X30 -= (f32x2){La15[0], La15[1]} * xj2;
      X31 -= (f32x2){La15[2], La15[3]} * xj2;
    }
    __builtin_amdgcn_sched_barrier(0);
    La9 = *(const f32x4*)(Lt_s + 2484);
    La10 = *(const f32x4*)(Lt_s + 2488);
    La11 = *(const f32x4*)(Lt_s + 2492);
    La12 = *(const f32x4*)(Lt_s + 2496);
    La13 = *(const f32x4*)(Lt_s + 2500);
    La14 = *(const f32x4*)(Lt_s + 2504);
    La15 = *(const f32x4*)(Lt_s + 2508);
    __builtin_amdgcn_sched_barrier(0);
    { const float xj = X17[1]; const f32x2 xj2 = (f32x2){xj, xj};
      X18 -= (f32x2){Lb9[0], Lb9[1]} * xj2;
      X19 -= (f32x2){Lb9[2], Lb9[3]} * xj2;
      X20 -= (f32x2){Lb10[0], Lb10[1]} * xj2;
      X21 -= (f32x2){Lb10[2], Lb10[3]} * xj2;
      X22 -= (f32x2){Lb11[0], Lb11[1]} * xj2;
      X23 -= (f32x2){Lb11[2], Lb11[3]} * xj2;
      X24 -= (f32x2){Lb12[0], Lb12[1]} * xj2;
      X25 -= (f32x2){Lb12[2], Lb12[3]} * xj2;
      X26 -= (f32x2){Lb13[0], Lb13[1]} * xj2;
      X27 -= (f32x2){Lb13[2], Lb13[3]} * xj2;
      X28 -= (f32x2){Lb14[0], Lb14[1]} * xj2;
      X29 -= (f32x2){Lb14[2], Lb14[3]} * xj2;
      X30 -= (f32x2){Lb15[0], Lb15[1]} * xj2;
      X31 -= (f32x2){Lb15[2], Lb15[3]} * xj2;
    }
    __builtin_amdgcn_sched_barrier(0);
    Lb9 = *(const f32x4*)(Lt_s + 2552);
    Lb10 = *(const f32x4*)(Lt_s + 2556);
    Lb11 = *(const f32x4*)(Lt_s + 2560);
    Lb12 = *(const f32x4*)(Lt_s + 2564);
    Lb13 = *(const f32x4*)(Lt_s + 2568);
    Lb14 = *(const f32x4*)(Lt_s + 2572);
    Lb15 = *(const f32x4*)(Lt_s + 2576);
    __builtin_amdgcn_sched_barrier(0);
    { const float xj = X18[0]; const f32x2 xj2 = (f32x2){xj, xj};
      X18 -= (f32x2){La9[0], La9[1]} * xj2;
      X19 -= (f32x2){La9[2], La9[3]} * xj2;
      X20 -= (f32x2){La10[0], La10[1]} * xj2;
      X21 -= (f32x2){La10[2], La10[3]} * xj2;
      X22 -= (f32x2){La11[0], La11[1]} * xj2;
      X23 -= (f32x2){La11[2], La11[3]} * xj2;
      X24 -= (f32x2){La12[0], La12[1]} * xj2;
      X25 -= (f32x2){La12[2], La12[3]} * xj2;
      X26 -= (f32x2){La13[0], La13[1]} * xj2;
      X27 -= (f32x2){La13[2], La13[3]} * xj2;
      X28 -= (f32x2){La14[0], La14[1]} * xj2;
      X29 -= (f32x2){La14[2], La14[3]} * xj2;
      X30 -= (f32x2){La15[0], La15[1]} * xj2;
      X31 -= (f32x2){La15[2], La15[3]} * xj2;
    }
    __builtin_amdgcn_sched_barrier(0);
    La9 = *(const f32x4*)(Lt_s + 2620);
    La10 = *(const f32x4*)(Lt_s + 2624);
    La11 = *(const f32x4*)(Lt_s + 2628);
    La12 = *(const f32x4*)(Lt_s + 2632);
    La13 = *(const f32x4*)(Lt_s + 2636);
    La14 = *(const f32x4*)(Lt_s + 2640);
    La15 = *(const f32x4*)(Lt_s + 2644);
    __builtin_amdgcn_sched_barrier(0);
    { const float xj = X18[1]; const f32x2 xj2 = (f32x2){xj, xj};
      X19 -= (f32x2){Lb9[2], Lb9[3]} * xj2;
      X20 -= (f32x2){Lb10[0], Lb10[1]} * xj2;
      X21 -= (f32x2){Lb10[2], Lb10[3]} * xj2;
      X22 -= (f32x2){Lb11[0], Lb11[1]} * xj2;
      X23 -= (f32x2){Lb11[2], Lb11[3]} * xj2;
      X24 -= (f32x2){Lb12[0], Lb12[1]} * xj2;
      X25 -= (f32x2){Lb12[2], Lb12[3]} * xj2;
      X26 -= (f32x2){Lb13[0], Lb13[1]} * xj2;
      X27 -= (f32x2){Lb13[2], Lb13[3]} * xj2;
      X28 -= (f32x2){Lb14[0], Lb14[1]} * xj2;
      X29 -= (f32x2){Lb14[2], Lb14[3]} * xj2;
      X30 -= (f32x2){Lb15[0], Lb15[1]} * xj2;
      X31 -= (f32x2){Lb15[2], Lb15[3]} * xj2;
    }
    __builtin_amdgcn_sched_barrier(0);
    Lb10 = *(const f32x4*)(Lt_s + 2692);
    Lb11 = *(const f32x4*)(Lt_s + 2696);
    Lb12 = *(const f32x4*)(Lt_s + 2700);
    Lb13 = *(const f32x4*)(Lt_s + 2704);
    Lb14 = *(const f32x4*)(Lt_s + 2708);
    Lb15 = *(const f32x4*)(Lt_s + 2712);
    __builtin_amdgcn_sched_barrier(0);
    { const float xj = X19[0]; const f32x2 xj2 = (f32x2){xj, xj};
      X19 -= (f32x2){La9[2], La9[3]} * xj2;
      X20 -= (f32x2){La10[0], La10[1]} * xj2;
      X21 -= (f32x2){La10[2], La10[3]} * xj2;
      X22 -= (f32x2){La11[0], La11[1]} * xj2;
      X23 -= (f32x2){La11[2], La11[3]} * xj2;
      X24 -= (f32x2){La12[0], La12[1]} * xj2;
      X25 -= (f32x2){La12[2], La12[3]} * xj2;
      X26 -= (f32x2){La13[0], La13[1]} * xj2;
      X27 -= (f32x2){La13[2], La13[3]} * xj2;
      X28 -= (f32x2){La14[0], La14[1]} * xj2;
      X29 -= (f32x2){La14[2], La14[3]} * xj2;
      X30 -= (f32x2){La15[0], La15[1]} * xj2;
      X31 -= (f32x2){La15[2], La15[3]} * xj2;
    }
    __builtin_amdgcn_sched_barrier(0);
    La10 = *(const f32x4*)(Lt_s + 2760);
    La11 = *(const f32x4*)(Lt_s + 2764);
    La12 = *(const f32x4*)(Lt_s + 2768);
    La13 = *(const f32x4*)(Lt_s + 2772);
    La14 = *(const f32x4*)(Lt_s + 2776);
    La15 = *(const f32x4*)(Lt_s + 2780);
    __builtin_amdgcn_sched_barrier(0);
    { const float xj = X19[1]; const f32x2 xj2 = (f32x2){xj, xj};
      X20 -= (f32x2){Lb10[0], Lb10[1]} * xj2;
      X21 -= (f32x2){Lb10[2], Lb10[3]} * xj2;
      X22 -= (f32x2){Lb11[0], Lb11[1]} * xj2;
      X23 -= (f32x2){Lb11[2], Lb11[3]} * xj2;
      X24 -= (f32x2){Lb12[0], Lb12[1]} * xj2;
      X25 -= (f32x2){Lb12[2], Lb12[3]} * xj2;
      X26 -= (f32x2){Lb13[0], Lb13[1]} * xj2;
      X27 -= (f32x2){Lb13[2], Lb13[3]} * xj2;
      X28 -= (f32x2){Lb14[0], Lb14[1]} * xj2;
      X29 -= (f32x2){Lb14[2], Lb14[3]} * xj2;
      X30 -= (f32x2){Lb15[0], Lb15[1]} * xj2;
      X31 -= (f32x2){Lb15[2], Lb15[3]} * xj2;
    }
    __builtin_amdgcn_sched_barrier(0);
    Lb10 = *(const f32x4*)(Lt_s + 2828);
    Lb11 = *(const f32x4*)(Lt_s + 2832);
    Lb12 = *(const f32x4*)(Lt_s + 2836);
    Lb13 = *(const f32x4*)(Lt_s + 2840);
    Lb14 = *(const f32x4*)(Lt_s + 2844);
    Lb15 = *(const f32x4*)(Lt_s + 2848);
    __builtin_amdgcn_sched_barrier(0);
    { const float xj = X20[0]; const f32x2 xj2 = (f32x2){xj, xj};
      X20 -= (f32x2){La10[0], La10[1]} * xj2;
      X21 -= (f32x2){La10[2], La10[3]} * xj2;
      X22 -= (f32x2){La11[0], La11[1]} * xj2;
      X23 -= (f32x2){La11[2], La11[3]} * xj2;
      X24 -= (f32x2){La12[0], La12[1]} * xj2;
      X25 -= (f32x2){La12[2], La12[3]} * xj2;
      X26 -= (f32x2){La13[0], La13[1]} * xj2;
      X27 -= (f32x2){La13[2], La13[3]} * xj2;
      X28 -= (f32x2){La14[0], La14[1]} * xj2;
      X29 -= (f32x2){La14[2], La14[3]} * xj2;
      X30 -= (f32x2){La15[0], La15[1]} * xj2;
      X31 -= (f32x2){La15[2], La15[3]} * xj2;
    }
    __builtin_amdgcn_sched_barrier(0);
    La10 = *(const f32x4*)(Lt_s + 2896);
    La11 = *(const f32x4*)(Lt_s + 2900);
    La12 = *(const f32x4*)(Lt_s + 2904);
    La13 = *(const f32x4*)(Lt_s + 2908);
    La14 = *(const f32x4*)(Lt_s + 2912);
    La15 = *(const f32x4*)(Lt_s + 2916);
    __builtin_amdgcn_sched_barrier(0);
    { const float xj = X20[1]; const f32x2 xj2 = (f32x2){xj, xj};
      X21 -= (f32x2){Lb10[2], Lb10[3]} * xj2;
      X22 -= (f32x2){Lb11[0], Lb11[1]} * xj2;
      X23 -= (f32x2){Lb11[2], Lb11[3]} * xj2;
      X24 -= (f32x2){Lb12[0], Lb12[1]} * xj2;
      X25 -= (f32x2){Lb12[2], Lb12[3]} * xj2;
      X26 -= (f32x2){Lb13[0], Lb13[1]} * xj2;
      X27 -= (f32x2){Lb13[2], Lb13[3]} * xj2;
      X28 -= (f32x2){Lb14[0], Lb14[1]} * xj2;
      X29 -= (f32x2){Lb14[2], Lb14[3]} * xj2;
      X30 -= (f32x2){Lb15[0], Lb15[1]} * xj2;
      X31 -= (f32x2){Lb15[2], Lb15[3]} * xj2;
    }
    __builtin_amdgcn_sched_barrier(0);
    Lb11 = *(const f32x4*)(Lt_s + 2968);
    Lb12 = *(const f32x4*)(Lt_s + 2972);
    Lb13 = *(const f32x4*)(Lt_s + 2976);
    Lb14 = *(const f32x4*)(Lt_s + 2980);
    Lb15 = *(const f32x4*)(Lt_s + 2984);
    __builtin_amdgcn_sched_barrier(0);
    { const float xj = X21[0]; const f32x2 xj2 = (f32x2){xj, xj};
      X21 -= (f32x2){La10[2], La10[3]} * xj2;
      X22 -= (f32x2){La11[0], La11[1]} * xj2;
      X23 -= (f32x2){La11[2], La11[3]} * xj2;
      X24 -= (f32x2){La12[0], La12[1]} * xj2;
      X25 -= (f32x2){La12[2], La12[3]} * xj2;
      X26 -= (f32x2){La13[0], La13[1]} * xj2;
      X27 -= (f32x2){La13[2], La13[3]} * xj2;
      X28 -= (f32x2){La14[0], La14[1]} * xj2;
      X29 -= (f32x2){La14[2], La14[3]} * xj2;
      X30 -= (f32x2){La15[0], La15[1]} * xj2;
      X31 -= (f32x2){La15[2], La15[3]} * xj2;
    }
    __builtin_amdgcn_sched_barrier(0);
    La11 = *(const f32x4*)(Lt_s + 3036);
    La12 = *(const f32x4*)(Lt_s + 3040);
    La13 = *(const f32x4*)(Lt_s + 3044);
    La14 = *(const f32x4*)(Lt_s + 3048);
    La15 = *(const f32x4*)(Lt_s + 3052);
    __builtin_amdgcn_sched_barrier(0);
    { const float xj = X21[1]; const f32x2 xj2 = (f32x2){xj, xj};
      X22 -= (f32x2){Lb11[0], Lb11[1]} * xj2;
      X23 -= (f32x2){Lb11[2], Lb11[3]} * xj2;
      X24 -= (f32x2){Lb12[0], Lb12[1]} * xj2;
      X25 -= (f32x2){Lb12[2], Lb12[3]} * xj2;
      X26 -= (f32x2){Lb13[0], Lb13[1]} * xj2;
      X27 -= (f32x2){Lb13[2], Lb13[3]} * xj2;
      X28 -= (f32x2){Lb14[0], Lb14[1]} * xj2;
      X29 -= (f32x2){Lb14[2], Lb14[3]} * xj2;
      X30 -= (f32x2){Lb15[0], Lb15[1]} * xj2;
      X31 -= (f32x2){Lb15[2], Lb15[3]} * xj2;
    }
    __builtin_amdgcn_sched_barrier(0);
    Lb11 = *(const f32x4*)(Lt_s + 3104);
    Lb12 = *(const f32x4*)(Lt_s + 3108);
    Lb13 = *(const f32x4*)(Lt_s + 3112);
    Lb14 = *(const f32x4*)(Lt_s + 3116);
    Lb15 = *(const f32x4*)(Lt_s + 3120);
    __builtin_amdgcn_sched_barrier(0);
    { const float xj = X22[0]; const f32x2 xj2 = (f32x2){xj, xj};
      X22 -= (f32x2){La11[0], La11[1]} * xj2;
      X23 -= (f32x2){La11[2], La11[3]} * xj2;
      X24 -= (f32x2){La12[0], La12[1]} * xj2;
      X25 -= (f32x2){La12[2], La12[3]} * xj2;
      X26 -= (f32x2){La13[0], La13[1]} * xj2;
      X27 -= (f32x2){La13[2], La13[3]} * xj2;
      X28 -= (f32x2){La14[0], La14[1]} * xj2;
      X29 -= (f32x2){La14[2], La14[3]} * xj2;
      X30 -= (f32x2){La15[0], La15[1]} * xj2;
      X31 -= (f32x2){La15[2], La15[3]} * xj2;
    }
    __builtin_amdgcn_sched_barrier(0);
    La11 = *(const f32x4*)(Lt_s + 3172);
    La12 = *(const f32x4*)(Lt_s + 3176);
    La13 = *(const f32x4*)(Lt_s + 3180);
    La14 = *(const f32x4*)(Lt_s + 3184);
    La15 = *(const f32x4*)(Lt_s + 3188);
    __builtin_amdgcn_sched_barrier(0);
    { const float xj = X22[1]; const f32x2 xj2 = (f32x2){xj, xj};
      X23 -= (f32x2){Lb11[2], Lb11[3]} * xj2;
      X24 -= (f32x2){Lb12[0], Lb12[1]} * xj2;
      X25 -= (f32x2){Lb12[2], Lb12[3]} * xj2;
      X26 -= (f32x2){Lb13[0], Lb13[1]} * xj2;
      X27 -= (f32x2){Lb13[2], Lb13[3]} * xj2;
      X28 -= (f32x2){Lb14[0], Lb14[1]} * xj2;
      X29 -= (f32x2){Lb14[2], Lb14[3]} * xj2;
      X30 -= (f32x2){Lb15[0], Lb15[1]} * xj2;
      X31 -= (f32x2){Lb15[2], Lb15[3]} * xj2;
    }
    __builtin_amdgcn_sched_barrier(0);
    Lb12 = *(const f32x4*)(Lt_s + 3244);
    Lb13 = *(const f32x4*)(Lt_s + 3248);
    Lb14 = *(const f32x4*)(Lt_s + 3252);
    Lb15 = *(const f32x4*)(Lt_s + 3256);
    __builtin_amdgcn_sched_barrier(0);
    { const float xj = X23[0]; const f32x2 xj2 = (f32x2){xj, xj};
      X23 -= (f32x2){La11[2], La11[3]} * xj2;
      X24 -= (f32x2){La12[0], La12[1]} * xj2;
      X25 -= (f32x2){La12[2], La12[3]} * xj2;
      X26 -= (f32x2){La13[0], La13[1]} * xj2;
      X27 -= (f32x2){La13[2], La13[3]} * xj2;
      X28 -= (f32x2){La14[0], La14[1]} * xj2;
      X29 -= (f32x2){La14[2], La14[3]} * xj2;
      X30 -= (f32x2){La15[0], La15[1]} * xj2;
      X31 -= (f32x2){La15[2], La15[3]} * xj2;
    }
    __builtin_amdgcn_sched_barrier(0);
    La12 = *(const f32x4*)(Lt_s + 3312);
    La13 = *(const f32x4*)(Lt_s + 3316);
    La14 = *(const f32x4*)(Lt_s + 3320);
    La15 = *(const f32x4*)(Lt_s + 3324);
    __builtin_amdgcn_sched_barrier(0);
    { const float xj = X23[1]; const f32x2 xj2 = (f32x2){xj, xj};
      X24 -= (f32x2){Lb12[0], Lb12[1]} * xj2;
      X25 -= (f32x2){Lb12[2], Lb12[3]} * xj2;
      X26 -= (f32x2){Lb13[0], Lb13[1]} * xj2;
      X27 -= (f32x2){Lb13[2], Lb13[3]} * xj2;
      X28 -= (f32x2){Lb14[0], Lb14[1]} * xj2;
      X29 -= (f32x2){Lb14[2], Lb14[3]} * xj2;
      X30 -= (f32x2){Lb15[0], Lb15[1]} * xj2;
      X31 -= (f32x2){Lb15[2], Lb15[3]} * xj2;
    }
    __builtin_amdgcn_sched_barrier(0);
    Lb12 = *(const f32x4*)(Lt_s + 3380);
    Lb13 = *(const f32x4*)(Lt_s + 3384);
    Lb14 = *(const f32x4*)(Lt_s + 3388);
    Lb15 = *(const f32x4*)(Lt_s + 3392);
    __builtin_amdgcn_sched_barrier(0);
    { const float xj = X24[0]; const f32x2 xj2 = (f32x2){xj, xj};
      X24 -= (f32x2){La12[0], La12[1]} * xj2;
      X25 -= (f32x2){La12[2], La12[3]} * xj2;
      X26 -= (f32x2){La13[0], La13[1]} * xj2;
      X27 -= (f32x2){La13[2], La13[3]} * xj2;
      X28 -= (f32x2){La14[0], La14[1]} * xj2;
      X29 -= (f32x2){La14[2], La14[3]} * xj2;
      X30 -= (f32x2){La15[0], La15[1]} * xj2;
      X31 -= (f32x2){La15[2], La15[3]} * xj2;
    }
    __builtin_amdgcn_sched_barrier(0);
    La12 = *(const f32x4*)(Lt_s + 3448);
    La13 = *(const f32x4*)(Lt_s + 3452);
    La14 = *(const f32x4*)(Lt_s + 3456);
    La15 = *(const f32x4*)(Lt_s + 3460);
    __builtin_amdgcn_sched_barrier(0);
    { const float xj = X24[1]; const f32x2 xj2 = (f32x2){xj, xj};
      X25 -= (f32x2){Lb12[2], Lb12[3]} * xj2;
      X26 -= (f32x2){Lb13[0], Lb13[1]} * xj2;
      X27 -= (f32x2){Lb13[2], Lb13[3]} * xj2;
      X28 -= (f32x2){Lb14[0], Lb14[1]} * xj2;
      X29 -= (f32x2){Lb14[2], Lb14[3]} * xj2;
      X30 -= (f32x2){Lb15[0], Lb15[1]} * xj2;
      X31 -= (f32x2){Lb15[2], Lb15[3]} * xj2;
    }
    __builtin_amdgcn_sched_barrier(0);
    Lb13 = *(const f32x4*)(Lt_s + 3520);
    Lb14 = *(const f32x4*)(Lt_s + 3524);
    Lb15 = *(const f32x4*)(Lt_s + 3528);
    __builtin_amdgcn_sched_barrier(0);
    { const float xj = X25[0]; const f32x2 xj2 = (f32x2){xj, xj};
      X25 -= (f32x2){La12[2], La12[3]} * xj2;
      X26 -= (f32x2){La13[0], La13[1]} * xj2;
      X27 -= (f32x2){La13[2], La13[3]} * xj2;
      X28 -= (f32x2){La14[0], La14[1]} * xj2;
      X29 -= (f32x2){La14[2], La14[3]} * xj2;
      X30 -= (f32x2){La15[0], La15[1]} * xj2;
      X31 -= (f32x2){La15[2], La15[3]} * xj2;
    }
    __builtin_amdgcn_sched_barrier(0);
    La13 = *(const f32x4*)(Lt_s + 3588);
    La14 = *(const f32x4*)(Lt_s + 3592);
    La15 = *(const f32x4*)(Lt_s + 3596);
    __builtin_amdgcn_sched_barrier(0);
    { const float xj = X25[1]; const f32x2 xj2 = (f32x2){xj, xj};
      X26 -= (f32x2){Lb13[0], Lb13[1]} * xj2;
      X27 -= (f32x2){Lb13[2], Lb13[3]} * xj2;
      X28 -= (f32x2){Lb14[0], Lb14[1]} * xj2;
      X29 -= (f32x2){Lb14[2], Lb14[3]} * xj2;
      X30 -= (f32x2){Lb15[0], Lb15[1]} * xj2;
      X31 -= (f32x2){Lb15[2], Lb15[3]} * xj2;
    }
    __builtin_amdgcn_sched_barrier(0);
    Lb13 = *(const f32x4*)(Lt_s + 3656);
    Lb14 = *(const f32x4*)(Lt_s + 3660);
    Lb15 = *(const f32x4*)(Lt_s + 3664);
    __builtin_amdgcn_sched_barrier(0);
    { const float xj = X26[0]; const f32x2 xj2 = (f32x2){xj, xj};
      X26 -= (f32x2){La13[0], La13[1]} * xj2;
      X27 -= (f32x2){La13[2], La13[3]} * xj2;
      X28 -= (f32x2){La14[0], La14[1]} * xj2;
      X29 -= (f32x2){La14[2], La14[3]} * xj2;
      X30 -= (f32x2){La15[0], La15[1]} * xj2;
      X31 -= (f32x2){La15[2], La15[3]} * xj2;
    }
    __builtin_amdgcn_sched_barrier(0);
    La13 = *(const f32x4*)(Lt_s + 3724);
    La14 = *(const f32x4*)(Lt_s + 3728);
    La15 = *(const f32x4*)(Lt_s + 3732);
    __builtin_amdgcn_sched_barrier(0);
    { const float xj = X26[1]; const f32x2 xj2 = (f32x2){xj, xj};
      X27 -= (f32x2){Lb13[2], Lb13[3]} * xj2;
      X28 -= (f32x2){Lb14[0], Lb14[1]} * xj2;
      X29 -= (f32x2){Lb14[2], Lb14[3]} * xj2;
      X30 -= (f32x2){Lb15[0], Lb15[1]} * xj2;
      X31 -= (f32x2){Lb15[2], Lb15[3]} * xj2;
    }
    __builtin_amdgcn_sched_barrier(0);
    Lb14 = *(const f32x4*)(Lt_s + 3796);
    Lb15 = *(const f32x4*)(Lt_s + 3800);
    __builtin_amdgcn_sched_barrier(0);
    { const float xj = X27[0]; const f32x2 xj2 = (f32x2){xj, xj};
      X27 -= (f32x2){La13[2], La13[3]} * xj2;
      X28 -= (f32x2){La14[0], La14[1]} * xj2;
      X29 -= (f32x2){La14[2], La14[3]} * xj2;
      X30 -= (f32x2){La15[0], La15[1]} * xj2;
      X31 -= (f32x2){La15[2], La15[3]} * xj2;
    }
    __builtin_amdgcn_sched_barrier(0);
    La14 = *(const f32x4*)(Lt_s + 3864);
    La15 = *(const f32x4*)(Lt_s + 3868);
    __builtin_amdgcn_sched_barrier(0);
    { const float xj = X27[1]; const f32x2 xj2 = (f32x2){xj, xj};
      X28 -= (f32x2){Lb14[0], Lb14[1]} * xj2;
      X29 -= (f32x2){Lb14[2], Lb14[3]} * xj2;
      X30 -= (f32x2){Lb15[0], Lb15[1]} * xj2;
      X31 -= (f32x2){Lb15[2], Lb15[3]} * xj2;
    }
    __builtin_amdgcn_sched_barrier(0);
    Lb14 = *(const f32x4*)(Lt_s + 3932);
    Lb15 = *(const f32x4*)(Lt_s + 3936);
    __builtin_amdgcn_sched_barrier(0);
    { const float xj = X28[0]; const f32x2 xj2 = (f32x2){xj, xj};
      X28 -= (f32x2){La14[0], La14[1]} * xj2;
      X29 -= (f32x2){La14[2], La14[3]} * xj2;
      X30 -= (f32x2){La15[0], La15[1]} * xj2;
      X31 -= (f32x2){La15[2], La15[3]} * xj2;
    }
    __builtin_amdgcn_sched_barrier(0);
    La14 = *(const f32x4*)(Lt_s + 4000);
    La15 = *(const f32x4*)(Lt_s + 4004);
    __builtin_amdgcn_sched_barrier(0);
    { const float xj = X28[1]; const f32x2 xj2 = (f32x2){xj, xj};
      X29 -= (f32x2){Lb14[2], Lb14[3]} * xj2;
      X30 -= (f32x2){Lb15[0], Lb15[1]} * xj2;
      X31 -= (f32x2){Lb15[2], Lb15[3]} * xj2;
    }
    __builtin_amdgcn_sched_barrier(0);
    Lb15 = *(const f32x4*)(Lt_s + 4072);
    __builtin_amdgcn_sched_barrier(0);
    { const float xj = X29[0]; const f32x2 xj2 = (f32x2){xj, xj};
      X29 -= (f32x2){La14[2], La14[3]} * xj2;
      X30 -= (f32x2){La15[0], La15[1]} * xj2;
      X31 -= (f32x2){La15[2], La15[3]} * xj2;
    }
    __builtin_amdgcn_sched_barrier(0);
    La15 = *(const f32x4*)(Lt_s + 4140);
    __builtin_amdgcn_sched_barrier(0);
    { const float xj = X29[1]; const f32x2 xj2 = (f32x2){xj, xj};
      X30 -= (f32x2){Lb15[0], Lb15[1]} * xj2;
      X31 -= (f32x2){Lb15[2], Lb15[3]} * xj2;
    }
    __builtin_amdgcn_sched_barrier(0);
    Lb15 = *(const f32x4*)(Lt_s + 4208);
    __builtin_amdgcn_sched_barrier(0);
    { const float xj = X30[0]; const f32x2 xj2 = (f32x2){xj, xj};
      X30 -= (f32x2){La15[0], La15[1]} * xj2;
      X31 -= (f32x2){La15[2], La15[3]} * xj2;
    }
    __builtin_amdgcn_sched_barrier(0);
    La15 = *(const f32x4*)(Lt_s + 4276);
    __builtin_amdgcn_sched_barrier(0);
    { const float xj = X30[1]; const f32x2 xj2 = (f32x2){xj, xj};
      X31 -= (f32x2){Lb15[2], Lb15[3]} * xj2;
    }
    __builtin_amdgcn_sched_barrier(0);
    __builtin_amdgcn_sched_barrier(0);
    { const float xj = X31[0]; const f32x2 xj2 = (f32x2){xj, xj};
      X31 -= (f32x2){La15[2], La15[3]} * xj2;
    }
    __builtin_amdgcn_sched_barrier(0);
    __syncthreads();
    outp[0] = f2bf(sg * X0[0]);
    outp[136] = f2bf(sg * X0[1]);
    outp[272] = f2bf(sg * X1[0]);
    outp[408] = f2bf(sg * X1[1]);
    outp[544] = f2bf(sg * X2[0]);
    outp[680] = f2bf(sg * X2[1]);
    outp[816] = f2bf(sg * X3[0]);
    outp[952] = f2bf(sg * X3[1]);
    outp[1088] = f2bf(sg * X4[0]);
    outp[1224] = f2bf(sg * X4[1]);
    outp[1360] = f2bf(sg * X5[0]);
    outp[1496] = f2bf(sg * X5[1]);
    outp[1632] = f2bf(sg * X6[0]);
    outp[1768] = f2bf(sg * X6[1]);
    outp[1904] = f2bf(sg * X7[0]);
    outp[2040] = f2bf(sg * X7[1]);
    outp[2176] = f2bf(sg * X8[0]);
    outp[2312] = f2bf(sg * X8[1]);
    outp[2448] = f2bf(sg * X9[0]);
    outp[2584] = f2bf(sg * X9[1]);
    outp[2720] = f2bf(sg * X10[0]);
    outp[2856] = f2bf(sg * X10[1]);
    outp[2992] = f2bf(sg * X11[0]);
    outp[3128] = f2bf(sg * X11[1]);
    outp[3264] = f2bf(sg * X12[0]);
    outp[3400] = f2bf(sg * X12[1]);
    outp[3536] = f2bf(sg * X13[0]);
    outp[3672] = f2bf(sg * X13[1]);
    outp[3808] = f2bf(sg * X14[0]);
    outp[3944] = f2bf(sg * X14[1]);
    outp[4080] = f2bf(sg * X15[0]);
    outp[4216] = f2bf(sg * X15[1]);
    outp[4352] = f2bf(sg * X16[0]);
    outp[4488] = f2bf(sg * X16[1]);
    outp[4624] = f2bf(sg * X17[0]);
    outp[4760] = f2bf(sg * X17[1]);
    outp[4896] = f2bf(sg * X18[0]);
    outp[5032] = f2bf(sg * X18[1]);
    outp[5168] = f2bf(sg * X19[0]);
    outp[5304] = f2bf(sg * X19[1]);
    outp[5440] = f2bf(sg * X20[0]);
    outp[5576] = f2bf(sg * X20[1]);
    outp[5712] = f2bf(sg * X21[0]);
    outp[5848] = f2bf(sg * X21[1]);
    outp[5984] = f2bf(sg * X22[0]);
    outp[6120] = f2bf(sg * X22[1]);
    outp[6256] = f2bf(sg * X23[0]);
    outp[6392] = f2bf(sg * X23[1]);
    outp[6528] = f2bf(sg * X24[0]);
    outp[6664] = f2bf(sg * X24[1]);
    outp[6800] = f2bf(sg * X25[0]);
    outp[6936] = f2bf(sg * X25[1]);
    outp[7072] = f2bf(sg * X26[0]);
    outp[7208] = f2bf(sg * X26[1]);
    outp[7344] = f2bf(sg * X27[0]);
    outp[7480] = f2bf(sg * X27[1]);
    outp[7616] = f2bf(sg * X28[0]);
    outp[7752] = f2bf(sg * X28[1]);
    outp[7888] = f2bf(sg * X29[0]);
    outp[8024] = f2bf(sg * X29[1]);
    outp[8160] = f2bf(sg * X30[0]);
    outp[8296] = f2bf(sg * X30[1]);
    outp[8432] = f2bf(sg * X31[0]);
    outp[8568] = f2bf(sg * X31[1]);
}

DEV void dn_item(const Params& p, int l, int item, unsigned char* smem) {
    const int dir = item & 1, hh = (item >> 1) & 3, b = item >> 3;
    bf16_t* q_s = (bf16_t*)(smem);
    bf16_t* k_s = (bf16_t*)(smem + 17408);
    bf16_t* vnT_s = k_s;
    bf16_t* kT_s = (bf16_t*)(smem + 35840);
    bf16_t* v_s = (bf16_t*)(smem + 54272);
    bf16_t* u_s = v_s;
    float* L_s = (float*)(smem + 71680);
    bf16_t* w_s = (bf16_t*)(smem + 71680);
    bf16_t* qk_s = (bf16_t*)(smem + 89088);
    bf16_t* St_s = (bf16_t*)(smem + 98304);
    float* G_s = (float*)(smem + 133120);
    float* beta_s = G_s + 64;
    float* eG_s = G_s + 128;
    float* bw_s = G_s + 192;
    float* cw_s = G_s + 256;
    bf16_t* XT_s = k_s;
    bf16_t* Lb_s = (bf16_t*)(smem + 140288);
    const int tid = get_tid(), lane = tid & 63, wv = tid >> 6, l15 = lane & 15, quad = lane >> 4;
    const float Aneg = -expf(p.in[I_DNALOG][(l * 2 + dir) * 4 + hh]);
    const float dtb = p.in[I_DNDT][(l * 2 + dir) * 4 + hh];
    const bf16_t* P = wsb(p, O_P);
    const float* AB = wsf(p, O_AB);
    bf16_t* TO = wsb(p, dir ? O_TA2 : O_TA);
    __syncthreads();
    for (int e = tid; e < 4 * 384; e += 256) { int j = e / 384, c = e % 384, mat = c >> 7, cc = c & 127; cw_s[e] = p.in[I_DNCONV][((size_t)l * 4 + j) * 1536 + mat * 512 + hh * 128 + cc]; }
    for (int e = tid; e < 128 * 136 / 2; e += 256) ((unsigned*)St_s)[e] = 0u;
    f32x4 Sacc[2][8];
#pragma unroll
    for (int a = 0; a < 2; ++a)
#pragma unroll
        for (int c = 0; c < 8; ++c) Sacc[a][c] = (f32x4){0.f, 0.f, 0.f, 0.f};

    const int rg = tid >> 4, cseg = tid & 15, i0 = rg * 4;
    u32x4 raw[3][7];
    float pf_al = 0.f, pf_bb = 0.f;
#define DN_PREFETCH(NN, M0, M1) { \
        const int c_ = chunk_of(dir, (NN)); const int lo_ = c_ < 4 ? 0 : CTXL, hi_ = c_ < 4 ? CTXL : SB, base_ = c_ * 64; \
        const int slo_ = dir ? base_ + 60 - i0 : base_ + i0; \
        _Pragma("unroll") for (int u = 0; u < 7; ++u) { const int ss_ = slo_ - 1 + u; const bool ok_ = ss_ >= lo_ && ss_ < hi_; \
            const bf16_t* rp_ = P + ((size_t)b * SB + (ok_ ? ss_ : base_)) * PW + hh * 128 + cseg * 8; \
            _Pragma("unroll") for (int mat = (M0); mat < (M1); ++mat) { u32x4 t_ = *(const u32x4*)(rp_ + mat * 512); raw[mat][u] = ok_ ? t_ : (u32x4){0u, 0u, 0u, 0u}; } } \
        if ((M0) == 0) { const int sa_ = dir ? base_ + 63 - lane : base_ + lane; \
        pf_al = AB[((size_t)b * SB + sa_) * 16 + dir * 4 + hh]; pf_bb = AB[((size_t)b * SB + sa_) * 16 + 8 + dir * 4 + hh]; } }
    DN_PREFETCH(0, 0, 3);
    const int wv0_ = wv, l150_ = l15, quad0_ = quad, lane0_ = lane;

#pragma unroll 1
    for (int n = 0; n < 68; ++n) {
        int tz0 = 0; asm volatile("" : "+v"(tz0));
        const int wv = wv0_ + tz0, l15 = l150_ + tz0, quad = quad0_ + tz0, lane = lane0_ + tz0;
        const int c = chunk_of(dir, n);
        const int base = c * 64;
        __syncthreads();
        if (wv == 0) {
            float g = Aneg * softplus_fast(pf_al + dtb);
#pragma unroll
            for (int o = 1; o < 64; o <<= 1) { float t = __shfl_up(g, o); if (lane >= o) g += t; }
            const float eg_ = __expf(g), bt_ = sigm(pf_bb); G_s[lane] = g; beta_s[lane] = bt_; eG_s[lane] = eg_; bw_s[lane] = bt_ * eg_;
        }
        __syncthreads();
        const float Glast = G_s[63];
        {
            int tz = 0; asm volatile("" : "+v"(tz));
            const int i0l = i0 + tz, csl = cseg + tz;
            float ksc[4];
#pragma unroll
            for (int m = 0; m < 4; ++m) ksc[m] = __expf(Glast - G_s[i0l + m]);
#pragma unroll
            for (int mat = 0; mat < 3; ++mat) {
                float w[4][8];
#pragma unroll
                for (int j = 0; j < 4; ++j) { const f32x4 w0 = *(const f32x4*)(cw_s + j * 384 + mat * 128 + csl * 8), w1 = *(const f32x4*)(cw_s + j * 384 + mat * 128 + csl * 8 + 4);
#pragma unroll
                    for (int e = 0; e < 4; ++e) { w[j][e] = w0[e]; w[j][4 + e] = w1[e]; } }
                float v[4][8];
#pragma unroll
                for (int t = 0; t < 4; ++t)
#pragma unroll
                    for (int e = 0; e < 8; ++e) v[t][e] = 0.f;
#pragma unroll
                for (int u = 0; u < 7; ++u) {
                    float x[8];
#pragma unroll
                    for (int e = 0; e < 4; ++e) { x[2 * e] = lo16(raw[mat][u][e]); x[2 * e + 1] = hi16(raw[mat][u][e]); }
#pragma unroll
                    for (int t = 0; t < 4; ++t) { const int j = u - t; if (j >= 0 && j < 4) {
#pragma unroll
                        for (int e = 0; e < 8; ++e) v[t][e] += w[j][e] * x[e]; } }
                }
                float sc[4];
#pragma unroll
                for (int t = 0; t < 4; ++t) {
                    float ss2 = 0.f;
#pragma unroll
                    for (int e = 0; e < 8; ++e) { v[t][e] = silu(v[t][e]); ss2 += v[t][e] * v[t][e]; }
                    if (mat < 2) { ss2 += __shfl_xor(ss2, 1); ss2 += __shfl_xor(ss2, 2); ss2 += __shfl_xor(ss2, 4); ss2 += __shfl_xor(ss2, 8); }
                    sc[t] = mat == 0 ? rsqrtf(ss2 + 1e-6f) * 0.08838834764831845f : (mat == 1 ? rsqrtf(ss2 + 1e-6f) : 1.f);
                }
                bf16_t* dst = mat == 0 ? q_s : (mat == 1 ? k_s : v_s);
#pragma unroll
                for (int t = 0; t < 4; ++t) {
                    const int it_ = dir ? i0l + 3 - t : i0l + t;
                    u32x4 o;
#pragma unroll
                    for (int e = 0; e < 4; ++e) o[e] = pack2(v[t][2 * e] * sc[t], v[t][2 * e + 1] * sc[t]);
                    *(u32x4*)(dst + it_ * 136 + csl * 8) = o;
                }
                if (mat == 1) {
#pragma unroll
                    for (int e = 0; e < 8; ++e) {
                        const float k0 = v[dir ? 3 : 0][e] * sc[dir ? 3 : 0] * ksc[0], k1 = v[dir ? 2 : 1][e] * sc[dir ? 2 : 1] * ksc[1];
                        const float k2 = v[dir ? 1 : 2][e] * sc[dir ? 1 : 2] * ksc[2], k3 = v[dir ? 0 : 3][e] * sc[dir ? 0 : 3] * ksc[3];
                        u32x2 o; o.x = pack2(k0, k1); o.y = pack2(k2, k3);
                        *(u32x2*)(kT_s + (csl * 8 + e) * 72 + i0l) = o;
                    }
                }
            }
        }
        __syncthreads();
        {
            bf16x8 ak[4], aq[4];
#pragma unroll
            for (int ks = 0; ks < 4; ++ks) { ak[ks] = *(const bf16x8*)(k_s + (wv * 16 + l15) * 136 + ks * 32 + quad * 8); aq[ks] = *(const bf16x8*)(q_s + (wv * 16 + l15) * 136 + ks * 32 + quad * 8); }
#pragma unroll
            for (int nt = 0; nt < 4; ++nt) {
                f32x4 kk = {0.f, 0.f, 0.f, 0.f}, qq = {0.f, 0.f, 0.f, 0.f};
#pragma unroll
                for (int ks = 0; ks < 4; ++ks) { bf16x8 bk = *(const bf16x8*)(k_s + (nt * 16 + l15) * 136 + ks * 32 + quad * 8); kk = mfma16(ak[ks], bk, kk); qq = mfma16(aq[ks], bk, qq); }
                const int jj = nt * 16 + l15; const float Gj = G_s[jj];
                f32x4 lv;
#pragma unroll
                for (int j = 0; j < 4; ++j) {
                    const int i = wv * 16 + quad * 4 + j;
                    const float dec = jj <= i ? __expf(G_s[i] - Gj) : 0.f;
                    lv[j] = jj < i ? beta_s[i] * kk[j] * dec : 0.f;
                    qk_s[i * 72 + jj] = f2bf(qq[j] * dec);
                }
                *(f32x4*)(L_s + jj * 68 + wv * 16 + quad * 4) = lv;
                if (wv >= 2 && nt < 2) {
#pragma unroll
                    for (int j = 0; j < 4; ++j) Lb_s[(wv * 16 - 32 + quad * 4 + j) * 40 + jj] = f2bf(lv[j]);
                }
            }
        }
        __syncthreads();
        dn_solve(L_s, tid < 128 ? (k_s + tid) : (v_s + (tid - 128)), tid < 128 ? bw_s : beta_s, tid < 128 ? -1.f : 1.f, tid < 128 ? (w_s + tid) : (u_s + (tid - 128)), XT_s, Lb_s, tid, wv, l15, quad);
        __syncthreads();
        {
            f32x4 vn[8], o1[8];
#pragma unroll
            for (int nt = 0; nt < 8; ++nt) {
#pragma unroll
                for (int j = 0; j < 4; ++j) vn[nt][j] = bf2f(u_s[(wv * 16 + quad * 4 + j) * 136 + nt * 16 + l15]);
                o1[nt] = (f32x4){0.f, 0.f, 0.f, 0.f};
            }
            bf16x8 aw[4], aq[4];
#pragma unroll
            for (int ks = 0; ks < 4; ++ks) { aw[ks] = *(const bf16x8*)(w_s + (wv * 16 + l15) * 136 + ks * 32 + quad * 8); aq[ks] = *(const bf16x8*)(q_s + (wv * 16 + l15) * 136 + ks * 32 + quad * 8); }
#pragma unroll
            for (int nt = 0; nt < 8; ++nt)
#pragma unroll
                for (int ks = 0; ks < 4; ++ks) { bf16x8 bs = *(const bf16x8*)(St_s + (nt * 16 + l15) * 136 + ks * 32 + quad * 8); vn[nt] = mfma16(aw[ks], bs, vn[nt]); o1[nt] = mfma16(aq[ks], bs, o1[nt]); }
#pragma unroll
            for (int nt = 0; nt < 8; ++nt) { u32x2 o; o.x = pack2(vn[nt][0], vn[nt][1]); o.y = pack2(vn[nt][2], vn[nt][3]); *(u32x2*)(vnT_s + (nt * 16 + l15) * 72 + wv * 16 + quad * 4) = o; }
            __syncthreads();
            if (n + 1 < 68) DN_PREFETCH(n + 1, 0, 2);
            float eg[4];
#pragma unroll
            for (int j = 0; j < 4; ++j) eg[j] = eG_s[wv * 16 + quad * 4 + j];
            bf16x8 aqk[2], akt[2][2];
#pragma unroll
            for (int ks = 0; ks < 2; ++ks) {
                aqk[ks] = *(const bf16x8*)(qk_s + (wv * 16 + l15) * 72 + ks * 32 + quad * 8);
                akt[0][ks] = *(const bf16x8*)(kT_s + (wv * 32 + l15) * 72 + ks * 32 + quad * 8);
                akt[1][ks] = *(const bf16x8*)(kT_s + (wv * 32 + 16 + l15) * 72 + ks * 32 + quad * 8);
            }
            const float gend = eG_s[63];
            const size_t orow0 = (size_t)b * SB;
#pragma unroll
            for (int nt = 0; nt < 8; ++nt) {
                f32x4 o;
#pragma unroll
                for (int j = 0; j < 4; ++j) { o[j] = o1[nt][j] * eg[j]; Sacc[0][nt][j] *= gend; Sacc[1][nt][j] *= gend; }
#pragma unroll
                for (int ks = 0; ks < 2; ++ks) {
                    bf16x8 bv = *(const bf16x8*)(vnT_s + (nt * 16 + l15) * 72 + ks * 32 + quad * 8);
                    o = mfma16(aqk[ks], bv, o);
                    Sacc[0][nt] = mfma16(akt[0][ks], bv, Sacc[0][nt]);
                    Sacc[1][nt] = mfma16(akt[1][ks], bv, Sacc[1][nt]);
                }
#pragma unroll
                for (int j = 0; j < 4; ++j) {
                    const int i = wv * 16 + quad * 4 + j;
                    const int s = dir ? base + 63 - i : base + i;
                    TO[(orow0 + s) * 512 + hh * 128 + nt * 16 + l15] = f2bf(o[j]);
                }
#pragma unroll
                for (int mt = 0; mt < 2; ++mt) { u32x2 sv; sv.x = pack2(Sacc[mt][nt][0], Sacc[mt][nt][1]); sv.y = pack2(Sacc[mt][nt][2], Sacc[mt][nt][3]);
                    *(u32x2*)(St_s + (nt * 16 + l15) * 136 + wv * 32 + mt * 16 + quad * 4) = sv; }
            }
        }
        if (n + 1 < 68) DN_PREFETCH(n + 1, 2, 3);
    }
}

#undef DN_PREFETCH
DEV void lru_item(const Params& p, int l, int item, unsigned char* smem) {
    const int g = item & 7, b = item >> 3;
    bf16_t* Wt_s = (bf16_t*)smem;
    bf16_t* xbh_s = Wt_s + 2 * 128 * 72;
    float* xbf_s = (float*)(smem + 36864 + 18432);
    float* a_s = xbf_s + 2 * 64 * 65;
    float* cw_s = a_s + 2 * 64 * 65;
    const int tid = get_tid(), lane = tid & 63, wv = tid >> 6, l15 = lane & 15, quad = lane >> 4;
    bf16_t* P = wsb(p, O_P);
    bf16_t* HF = wsb(p, O_U);
    __syncthreads();
    for (int e = tid; e < 320; e += 256) cw_s[e] = e < 256 ? p.in[I_LCW][((size_t)l * 4 + (e >> 6)) * 512 + g * 64 + (e & 63)] : p.in[I_LCB][l * 512 + g * 64 + (e - 256)];
    for (int e = tid; e < 2 * 4096; e += 256) {
        const int d = e >> 12, ch = (e >> 6) & 63, j = e & 63;
        const size_t wi_ = (((size_t)l * 2 + d) * 8 + g) * 4096 + ch * 64 + j;
        Wt_s[(d * 128 + j) * 72 + ch] = f2bf(p.in[I_LWA][wi_]);
        Wt_s[(d * 128 + 64 + j) * 72 + ch] = f2bf(p.in[I_LWI][wi_]);
    }
    float ba_[2][4], bi_[2][4], sp_[2][4];
#pragma unroll
    for (int d = 0; d < 2; ++d)
#pragma unroll
        for (int nt = 0; nt < 4; ++nt) {
            const int ch = (l * 2 + d) * 512 + g * 64 + nt * 16 + l15;
            ba_[d][nt] = p.in[I_LBA][ch]; bi_[d][nt] = p.in[I_LBI][ch]; sp_[d][nt] = softplus(-p.in[I_LLAM][ch]);
        }
    float hc = 0.f;
    const int i = tid >> 2, seg = tid & 3, j0 = seg * 16;
#pragma unroll 1
    for (int n = 0; n < 68; ++n) {
        const int cf = n, cb = chunk_of(1, n);
        __syncthreads();
#pragma unroll
        for (int d = 0; d < 2; ++d) {
            const int c = d ? cb : cf;
            const int seg_lo = c < 4 ? 0 : CTXL, seg_hi = c < 4 ? CTXL : SB;
            const int s = d ? c * 64 + 63 - i : c * 64 + i;
            float v[16];
#pragma unroll
            for (int e = 0; e < 16; ++e) v[e] = cw_s[256 + j0 + e];
#pragma unroll
            for (int j = 0; j < 4; ++j) {
                const int ss = s + j - 1;
                if (ss >= seg_lo && ss < seg_hi) {
                    const u32x4* src = (const u32x4*)(P + ((size_t)b * SB + ss) * PW + C_LX + g * 64 + j0);
                    const float* cw = cw_s + j * 64 + j0;
#pragma unroll
                    for (int q = 0; q < 2; ++q) { u32x4 x = src[q];
#pragma unroll
                        for (int e = 0; e < 4; ++e) { v[q * 8 + 2 * e] += cw[q * 8 + 2 * e] * lo16(x[e]); v[q * 8 + 2 * e + 1] += cw[q * 8 + 2 * e + 1] * hi16(x[e]); } }
                }
            }
            u32x4 h0, h1;
#pragma unroll
            for (int e = 0; e < 4; ++e) { h0[e] = pack2(v[2 * e], v[2 * e + 1]); h1[e] = pack2(v[8 + 2 * e], v[8 + 2 * e + 1]); }
            *(u32x4*)(xbh_s + (d * 64 + i) * 72 + j0) = h0; *(u32x4*)(xbh_s + (d * 64 + i) * 72 + j0 + 8) = h1;
#pragma unroll
            for (int e = 0; e < 16; ++e) xbf_s[(d * 64 + i) * 65 + j0 + e] = v[e];
        }
        __syncthreads();
#pragma unroll
        for (int d = 0; d < 2; ++d) {
            f32x4 acc[8];
#pragma unroll
            for (int nt = 0; nt < 8; ++nt) acc[nt] = (f32x4){0.f, 0.f, 0.f, 0.f};
            bf16x8 af[2];
#pragma unroll
            for (int ks = 0; ks < 2; ++ks) af[ks] = *(const bf16x8*)(xbh_s + (d * 64 + wv * 16 + l15) * 72 + ks * 32 + quad * 8);
#pragma unroll
            for (int nt = 0; nt < 8; ++nt)
#pragma unroll
                for (int ks = 0; ks < 2; ++ks) { bf16x8 bw = *(const bf16x8*)(Wt_s + (d * 128 + nt * 16 + l15) * 72 + ks * 32 + quad * 8); acc[nt] = mfma16(af[ks], bw, acc[nt]); }
#pragma unroll
            for (int nt = 0; nt < 4; ++nt)
#pragma unroll
                for (int jj = 0; jj < 4; ++jj) {
                    const int idx = (d * 64 + wv * 16 + quad * 4 + jj) * 65 + nt * 16 + l15;
                    const float r = sigm(acc[nt][jj] + ba_[d][nt]), ig = sigm(acc[nt + 4][jj] + bi_[d][nt]);
                    const float la = -8.f * r * sp_[d][nt];
                    a_s[idx] = __expf(la);
                    xbf_s[idx] = __builtin_amdgcn_sqrtf(fmaxf(1.f - __expf(2.f * la), 0.f)) * (ig * xbf_s[idx]);
                }
        }
        __syncthreads();
        if (wv < 2) {
            const int o = wv * 64 * 65 + lane;
#pragma unroll 16
            for (int r = 0; r < 64; ++r) { hc = a_s[o + r * 65] * hc + xbf_s[o + r * 65]; xbf_s[o + r * 65] = hc; }
        }
        __syncthreads();
#pragma unroll
        for (int d = 0; d < 2; ++d) {
            const int c = d ? cb : cf;
            const int s = d ? c * 64 + 63 - i : c * 64 + i;
            const bool second = d ? (cb < n) : ((cf < 4 ? 3 - cf : 71 - cf) < n);
            const size_t row = (size_t)b * SB + s;
            const float* hp = xbf_s + (d * 64 + i) * 65 + j0;
            bf16_t* hf = HF + row * 512 + g * 64 + j0;
            if (!second) {
                u32x4 o0, o1;
#pragma unroll
                for (int e = 0; e < 4; ++e) { o0[e] = pack2(hp[2 * e], hp[2 * e + 1]); o1[e] = pack2(hp[8 + 2 * e], hp[8 + 2 * e + 1]); }
                *(u32x4*)hf = o0; *(u32x4*)(hf + 8) = o1;
            } else {
                bf16_t* gp = P + row * PW + C_LG + g * 64 + j0;
                u32x4 f0 = *(const u32x4*)hf, f1 = *(const u32x4*)(hf + 8), g0 = *(const u32x4*)gp, g1 = *(const u32x4*)(gp + 8), o0, o1;
#pragma unroll
                for (int e = 0; e < 4; ++e) {
                    o0[e] = pack2((lo16(f0[e]) + hp[2 * e]) * gelu_tanh(lo16(g0[e])), (hi16(f0[e]) + hp[2 * e + 1]) * gelu_tanh(hi16(g0[e])));
                    o1[e] = pack2((lo16(f1[e]) + hp[8 + 2 * e]) * gelu_tanh(lo16(g1[e])), (hi16(f1[e]) + hp[8 + 2 * e + 1]) * gelu_tanh(hi16(g1[e])));
                }
                *(u32x4*)gp = o0; *(u32x4*)(gp + 8) = o1;
            }
        }
    }
}

DEV void att_item(const Params& p, int l, int b, int h, int qt, float lam_init, unsigned char* smem) {
    bf16_t* K_s = (bf16_t*)smem;
    bf16_t* V_s = (bf16_t*)(smem + 2 * 17408);
    const int tid = get_tid(), lane = tid & 63, wv = tid >> 6, l15 = lane & 15, quad = lane >> 4;
    bf16_t* P = wsb(p, O_P);
    const bf16_t* VT = wsb(p, O_VT) + (size_t)(b * 4 + h) * 128 * SB;
    const int nt_keys = (qt < 2 ? CTXL : SB) / 64;
    float lam;
    {
        const float* lv = p.in[I_DALAM] + l * 256;
        float s1 = lv[lane] * lv[64 + lane], s2 = lv[128 + lane] * lv[192 + lane];
#pragma unroll
        for (int o = 32; o >= 1; o >>= 1) { s1 += __shfl_xor(s1, o); s2 += __shfl_xor(s2, o); }
        lam = expf(s1) - expf(s2) + lam_init;
    }
    bf16x8* Qst = (bf16x8*)(smem + 71680) + (wv * 8) * 64 + lane;
#pragma unroll
    for (int qg = 0; qg < 2; ++qg) {
        const bf16_t* qp = P + ((size_t)b * SB + qt * 128 + wv * 32 + qg * 16 + l15) * PW + C_DAQ + h * 128;
#pragma unroll
        for (int wh = 0; wh < 2; ++wh)
#pragma unroll
            for (int ks = 0; ks < 2; ++ks) Qst[(wh * 4 + qg * 2 + ks) * 64] = *(const bf16x8*)(qp + wh * 64 + ks * 32 + quad * 8);
    }
    f32x4 O[2][8][2];
    float mrun[2][2], lrun[2][2];
#pragma unroll
    for (int wh = 0; wh < 2; ++wh)
#pragma unroll
        for (int qg = 0; qg < 2; ++qg) { mrun[wh][qg] = -1e30f; lrun[wh][qg] = 0.f;
#pragma unroll
            for (int dg = 0; dg < 8; ++dg) O[wh][dg][qg] = (f32x4){0.f, 0.f, 0.f, 0.f}; }
    const int kr = tid >> 2, kseg = (tid & 3) * 32;
    const int kpos = ((kr >> 5) * 2 + ((kr & 7) >> 2)) * 16 + ((kr & 31) >> 3) * 4 + (kr & 3);
    const bf16_t* kg_ = P + ((size_t)b * SB + kr) * PW + C_DAK + h * 128 + kseg;
    const int vr = tid >> 1, vh = (tid & 1) * 32;
    const bf16_t* vg_ = VT + (size_t)vr * SB + vh;
    u32x4 kreg[4], vreg[4];
#pragma unroll
    for (int i = 0; i < 4; ++i) { kreg[i] = *(const u32x4*)(kg_ + i * 8); vreg[i] = *(const u32x4*)(vg_ + i * 8); }
    __syncthreads();
#pragma unroll
    for (int i = 0; i < 4; ++i) { *(u32x4*)(K_s + kpos * 136 + kseg + i * 8) = kreg[i]; *(u32x4*)(V_s + vr * 72 + vh + i * 8) = vreg[i]; }
    __syncthreads();
    const float L2E = 1.4426950408889634f;
#pragma unroll 1
    for (int t = 0; t < nt_keys; ++t) {
        const bf16_t* Kb = K_s + (t & 1) * (64 * 136);
        const bf16_t* Vb = V_s + (t & 1) * (128 * 72);
        if (t + 1 < nt_keys) {
#pragma unroll
            for (int i = 0; i < 4; ++i) { kreg[i] = *(const u32x4*)(kg_ + (size_t)(t + 1) * 64 * PW + i * 8); vreg[i] = *(const u32x4*)(vg_ + (t + 1) * 64 + i * 8); }
        }
#pragma unroll
        for (int wh = 0; wh < 2; ++wh) {
            f32x4 S[4][2];
#pragma unroll
            for (int kg = 0; kg < 4; ++kg) { S[kg][0] = (f32x4){0.f, 0.f, 0.f, 0.f}; S[kg][1] = (f32x4){0.f, 0.f, 0.f, 0.f}; }
#pragma unroll
            for (int ks = 0; ks < 2; ++ks)
#pragma unroll
                for (int kg = 0; kg < 4; ++kg) {
                    bf16x8 kf = *(const bf16x8*)(Kb + (kg * 16 + l15) * 136 + wh * 64 + ks * 32 + quad * 8);
                    S[kg][0] = mfma16(kf, Qst[(wh * 4 + 0 + ks) * 64], S[kg][0]);
                    S[kg][1] = mfma16(kf, Qst[(wh * 4 + 2 + ks) * 64], S[kg][1]);
                }
            bf16x8 Pf[2][2];
#pragma unroll
            for (int qg = 0; qg < 2; ++qg) {
                float mx = -1e30f;
#pragma unroll
                for (int kg = 0; kg < 4; ++kg)
#pragma unroll
                    for (int j = 0; j < 4; ++j) mx = fmaxf(mx, S[kg][qg][j]);
                mx *= L2E;
                if (__builtin_amdgcn_ballot_w64(mx > mrun[wh][qg] + 8.f) != 0ull) {
                    mx = fmaxf(mx, __shfl_xor(mx, 16)); mx = fmaxf(mx, __shfl_xor(mx, 32));
                    const float mnew = fmaxf(mrun[wh][qg], mx);
                    const float alpha = __builtin_amdgcn_exp2f(mrun[wh][qg] - mnew);
                    mrun[wh][qg] = mnew;
                    lrun[wh][qg] *= alpha;
#pragma unroll
                    for (int dg = 0; dg < 8; ++dg)
#pragma unroll
                        for (int j = 0; j < 4; ++j) O[wh][dg][qg][j] *= alpha;
                }
                const float mref = mrun[wh][qg];
                float ps = 0.f;
#pragma unroll
                for (int kg = 0; kg < 4; ++kg)
#pragma unroll
                    for (int j = 0; j < 4; ++j) { float pv = __builtin_amdgcn_exp2f(S[kg][qg][j] * L2E - mref); ps += pv; S[kg][qg][j] = pv; }
                lrun[wh][qg] += ps;
#pragma unroll
                for (int s_ = 0; s_ < 2; ++s_) {
                    u32x4 pk; pk[0] = pack2(S[2 * s_][qg][0], S[2 * s_][qg][1]); pk[1] = pack2(S[2 * s_][qg][2], S[2 * s_][qg][3]);
                    pk[2] = pack2(S[2 * s_ + 1][qg][0], S[2 * s_ + 1][qg][1]); pk[3] = pack2(S[2 * s_ + 1][qg][2], S[2 * s_ + 1][qg][3]);
                    Pf[qg][s_] = __builtin_bit_cast(bf16x8, pk);
                }
            }
#pragma unroll
            for (int dg = 0; dg < 8; ++dg)
#pragma unroll
                for (int s_ = 0; s_ < 2; ++s_) {
                    bf16x8 vf = *(const bf16x8*)(Vb + (dg * 16 + l15) * 72 + s_ * 32 + quad * 8);
                    O[wh][dg][0] = mfma16(vf, Pf[0][s_], O[wh][dg][0]);
                    O[wh][dg][1] = mfma16(vf, Pf[1][s_], O[wh][dg][1]);
                }
        }
        if (t + 1 < nt_keys) {
            bf16_t* Kn = K_s + ((t + 1) & 1) * (64 * 136); bf16_t* Vn = V_s + ((t + 1) & 1) * (128 * 72);
#pragma unroll
            for (int i = 0; i < 4; ++i) { *(u32x4*)(Kn + kpos * 136 + kseg + i * 8) = kreg[i]; *(u32x4*)(Vn + vr * 72 + vh + i * 8) = vreg[i]; }
        }
        __syncthreads();
    }
    const float* dnw = p.in[I_DANORM] + l * 128;
#pragma unroll
    for (int qg = 0; qg < 2; ++qg) {
        float l1 = lrun[0][qg], l2 = lrun[1][qg];
        l1 += __shfl_xor(l1, 16); l1 += __shfl_xor(l1, 32); l2 += __shfl_xor(l2, 16); l2 += __shfl_xor(l2, 32);
        const float i1 = 1.f / l1, i2 = lam / l2;
        float ss = 0.f;
#pragma unroll
        for (int dg = 0; dg < 8; ++dg)
#pragma unroll
            for (int j = 0; j < 4; ++j) { float o = O[0][dg][qg][j] * i1 - O[1][dg][qg][j] * i2; O[0][dg][qg][j] = o; ss += o * o; }
        ss += __shfl_xor(ss, 16); ss += __shfl_xor(ss, 32);
        const float rstd = rsqrtf(ss * (1.f / 128.f) + 1e-5f) * (1.f - lam_init);
        bf16_t* op = P + ((size_t)b * SB + qt * 128 + wv * 32 + qg * 16 + l15) * PW + C_DAQ + h * 128;
#pragma unroll
        for (int dg = 0; dg < 8; ++dg) {
            const int dv0 = dg * 16 + quad * 4;
            u32x2 o; o.x = pack2(O[0][dg][qg][0] * rstd * dnw[dv0], O[0][dg][qg][1] * rstd * dnw[dv0 + 1]);
            o.y = pack2(O[0][dg][qg][2] * rstd * dnw[dv0 + 2], O[0][dg][qg][3] * rstd * dnw[dv0 + 3]);
            *(u32x2*)(op + dv0) = o;
        }
    }
}

DEV void phase_mix(const Params& p, int l, unsigned char* smem) {
    const bool need_ctx = l == 0;
    const float lam_init = l == 0 ? 0.2f : 0.35550906759096926f;
    unsigned* ctr = (unsigned*)(p.ws + O_CTL) + l;
    unsigned* actr = (unsigned*)(p.ws + O_CTL) + 16 + l * 8;
    __shared__ int s_item;
    const int nqt = need_ctx ? 34 : 32;
    auto next = [&](unsigned* c) -> int {
        __syncthreads();
        if (threadIdx.x == 0) s_item = (int)atomicAdd(c, 1u);
        __syncthreads();
        return __builtin_amdgcn_readfirstlane(s_item);
    };
    int it = next(ctr);
#pragma unroll 1
    while (it < 64) { dn_item(p, l, it, smem); it = next(ctr); }
#pragma unroll 1
    while (it < 128) { lru_item(p, l, it - 64, smem); it = next(ctr); }
    const int myx = blockIdx.x & 7;
#pragma unroll 1
    for (int k = 0; k < 8; ++k) {
        const int x = (myx + k) & 7;
        it = next(actr + x);
#pragma unroll 1
        while (it < 4 * nqt) {
            const int bh = x + 8 * (it / nqt), idx = it % nqt;
            const int qt = idx < 32 ? idx + 2 : idx - 32;
            att_item(p, l, bh >> 2, bh & 3, qt, lam_init, smem);
            it = next(actr + x);
        }
    }
}

#define XB_TMO      128
#define XB_XCNT(j)  (256  + 64 * (j))
#define XB_XSUB(j)  (1280 + 64 * (j))
#define XB_XGEN(j)  (2304 + 64 * (j))
#define XB_TOP      3328
#define XB_TOPGEN   3392
#define XCD_BAR_WORDS 3456
#define XB_SPIN_CAP (1u << 18)
#define LAS __attribute__((address_space(3)))
DEV unsigned xb_ld(unsigned* p)              { return __hip_atomic_load(p, __ATOMIC_RELAXED, __HIP_MEMORY_SCOPE_AGENT); }
DEV unsigned xb_add(unsigned* p, unsigned v) { return __hip_atomic_fetch_add(p, v, __ATOMIC_RELAXED, __HIP_MEMORY_SCOPE_AGENT); }
DEV unsigned xb_xcc_id() { return (unsigned)__builtin_amdgcn_s_getreg((3 << 11) | 20) & 0xFu; }
#define XB_SPIN(cond, bar) do { unsigned _sp = 0; while (cond) { __builtin_amdgcn_s_sleep(1); \
    if ((++_sp & 255u) == 0u) { if (xb_ld(&(bar)[XB_TMO])) break; if (_sp > XB_SPIN_CAP) { atomicAdd(&(bar)[XB_TMO], 1u); break; } } } } while (0)
struct XcdBarrier { unsigned* bar; unsigned x; volatile LAS unsigned* st; };
DEV XcdBarrier xcd_barrier_post(unsigned* bar, volatile LAS unsigned* st) {
    XcdBarrier b; b.bar = bar; b.x = xb_xcc_id(); b.st = st;
    if (threadIdx.x == 0) (void)xb_add(&bar[XB_XCNT(b.x)], 1u);
    return b;
}
DEV void xcd_barrier_complete(unsigned* bar, unsigned x, unsigned& nloc, unsigned& nx) {
    const unsigned G = gridDim.x * gridDim.y * gridDim.z;
    unsigned sum, cnt, mine, sp = 0u;
    for (;;) {
        sum = 0u; cnt = 0u; mine = 0u;
#pragma unroll
        for (unsigned j = 0; j < 16; ++j) { const unsigned c = xb_ld(&bar[XB_XCNT(j)]); sum += c; cnt += (c > 0u) ? 1u : 0u; mine = (j == x) ? c : mine; }
        if (sum == G) break;
        __builtin_amdgcn_s_sleep(1);
        if ((++sp & 255u) == 0u) { if (xb_ld(&bar[XB_TMO])) break; if (sp > XB_SPIN_CAP) { atomicAdd(&bar[XB_TMO], 1u); break; } }
    }
    nloc = mine > 0u ? mine : 1u; nx = cnt > 0u ? cnt : 1u;
}
DEV void xcd_barrier(const XcdBarrier& b) {
    asm volatile("s_waitcnt vmcnt(0)" ::: "memory");
    __syncthreads();
    if (threadIdx.x == 0) {
        unsigned* bar = b.bar;
        __builtin_amdgcn_s_waitcnt(0);
        unsigned nloc = b.st[0], nx = b.st[1];
        if (nloc == 0u) { xcd_barrier_complete(bar, b.x, nloc, nx); b.st[0] = nloc; b.st[1] = nx; }
        const unsigned old = xb_add(&bar[XB_XSUB(b.x)], 1u);
        const unsigned gen = old / nloc;
        if (old + 1u == (gen + 1u) * nloc) {
            __builtin_amdgcn_fence(__ATOMIC_RELEASE, "agent");
            asm volatile("s_waitcnt vmcnt(0)" ::: "memory");
            const unsigned og = xb_add(&bar[XB_TOP], 1u);
            const unsigned tg = og / nx;
            if (og + 1u == (tg + 1u) * nx) xb_add(&bar[XB_TOPGEN], 1u);
            else XB_SPIN(xb_ld(&bar[XB_TOPGEN]) == tg, bar);
            __builtin_amdgcn_fence(__ATOMIC_ACQUIRE, "agent");
            xb_add(&bar[XB_XGEN(b.x)], 1u);
            asm volatile("s_waitcnt vmcnt(0)" ::: "memory");
        } else {
            XB_SPIN(xb_ld(&bar[XB_XGEN(b.x)]) == gen, bar);
            __builtin_amdgcn_fence(__ATOMIC_ACQUIRE, "agent");
            asm volatile("s_waitcnt vmcnt(0)" ::: "memory");
        }
    }
    __syncthreads();
}

constexpr int NPHASE = 1 + 2 * 9 + 1;
DEV void run_phase(const Params& p, int ph, unsigned char* smem) {
    if (ph == 0) { phase_mod(p, smem); phase_rope(p); __syncthreads(); phase_wconv(p, 0, smem); return; }
    if (ph == NPHASE - 1) { phase_final(p); return; }
    const int l = (ph - 1) / 9, q = (ph - 1) % 9;
    const bool first = l == 0, lat = l == 1;
    const bf16_t* W = wsb(p, O_WT);
    switch (q) {
        case 0: if (l == 1) phase_wconv(p, 1, smem); phase_norm(p, l, 0, first, false); break;
        case 1: phase_g1(p, smem); break;
        case 2: phase_mix(p, l, smem); break;
        case 3: phase_fin_norm(p, l, first, lat); break;
        case 4: phase_gate(p, lat, smem); break;
        case 5: phase_resid(p, l, wsb(p, O_U), D, W + W_OUT, 1024, 2, first, lat, smem); break;
        case 6: phase_norm(p, l, 1, false, lat); break;
        case 7: phase_gu(p, lat, smem); break;
        case 8: phase_resid(p, l, wsb(p, O_P), PW, W + W_DN, DFF, 5, false, lat, smem); break;
    }
}

#if MEGA
__global__ void __launch_bounds__(256) mega_kernel(Params p) {
    extern __shared__ __align__(16) unsigned char smem[];
    cg::grid_group grid = cg::this_grid();
    __shared__ uint4 xb_words;
    if (threadIdx.x == 0) xb_words = make_uint4(0u, 0u, 0u, 0u);
    __syncthreads();
    const XcdBarrier xb = xcd_barrier_post((unsigned*)(p.ws + O_BAR), (volatile LAS unsigned*)&xb_words);
    phase_mod(p, smem); phase_rope(p); __syncthreads(); phase_wconv(p, 0, smem);
    grid.sync();
    const bf16_t* W = wsb(p, O_WT);
#pragma unroll
    for (int l = 0; l < 2; ++l) {
        const bool first = l == 0, lat = l == 1;
        if (l == 1) phase_wconv(p, 1, smem);
        phase_norm(p, l, 0, first, false);
        xcd_barrier(xb);
        phase_g1(p, smem);
        xcd_barrier(xb);
        phase_mix(p, l, smem);
        xcd_barrier(xb);
        phase_fin_norm(p, l, first, lat);
        xcd_barrier(xb);
        phase_gate(p, lat, smem);
        xcd_barrier(xb);
        phase_merge(p, lat, smem);
        xcd_barrier(xb);
        phase_resid(p, l, wsb(p, O_U), D, W + W_OUT, 1024, 2, first, lat, smem);
        xcd_barrier(xb);
        phase_norm(p, l, 1, false, lat);
        xcd_barrier(xb);
        phase_gu(p, lat, smem);
        xcd_barrier(xb);
        phase_resid(p, l, wsb(p, O_P), PW, W + W_DN, DFF, 5, false, lat, smem);
        xcd_barrier(xb);
    }
    phase_final(p);
}
#else
__global__ void __launch_bounds__(256) phase_kernel(Params p, int ph) {
    extern __shared__ __align__(16) unsigned char smem[];
    run_phase(p, ph, smem);
}
#endif

extern "C" void kernel_launch(void* const* d_in, const int* in_sizes, int n_in, void* d_out, int out_size, void* d_ws, size_t ws_size, hipStream_t stream) {
    static int grid = 0;
    if (grid == 0) {
        if (n_in != 28 || ws_size < WS_END) { fprintf(stderr, "kernel_launch: unexpected n_in %d or ws_size %zu < %zu\n", n_in, ws_size, (size_t)WS_END); grid = -1; return; }
        int dev = 0, cus = 0, per_cu = 0;
        hipGetDevice(&dev);
        hipDeviceGetAttribute(&cus, hipDeviceAttributeMultiprocessorCount, dev);
#if MEGA
        hipFuncSetAttribute((const void*)mega_kernel, hipFuncAttributeMaxDynamicSharedMemorySize, LDS_BYTES);
        hipOccupancyMaxActiveBlocksPerMultiprocessor(&per_cu, (const void*)mega_kernel, 256, LDS_BYTES);
#else
        hipFuncSetAttribute((const void*)phase_kernel, hipFuncAttributeMaxDynamicSharedMemorySize, LDS_BYTES);
        hipOccupancyMaxActiveBlocksPerMultiprocessor(&per_cu, (const void*)phase_kernel, 256, LDS_BYTES);
#endif
        if (per_cu < 1) per_cu = 1;
        grid = cus * per_cu;
        fprintf(stderr, "kernel_launch: grid %d (%d CUs x %d)\n", grid, cus, per_cu);
    }
    if (grid < 0) return;
    hipMemsetAsync((char*)d_ws + O_CTL, 0, 4096 + 16384, stream);
    Params p{};
    for (int i = 0; i < 28; ++i) p.in[i] = (const float*)d_in[i];
    p.out = (float*)d_out; p.ws = (unsigned char*)d_ws;
#if MEGA
    void* args[] = {&p};
    hipError_t e = hipLaunchCooperativeKernel((const void*)mega_kernel, dim3(grid), dim3(256), args, LDS_BYTES, stream);
    if (e != hipSuccess) fprintf(stderr, "cooperative launch failed: %s (grid %d)\n", hipGetErrorString(e), grid);
#else
    for (int ph = 0; ph < NPHASE; ++ph) hipLaunchKernelGGL(phase_kernel, dim3(grid), dim3(256), LDS_BYTES, stream, p, ph);
#endif
}
```
